# Optimizing an MI355X kernel written in HIP

```python
import math
import jax
import jax.numpy as jnp
from jax import lax
import numpy as np

D_MODEL = 1024
BATCH = 8
SEQ = 4096
DEPTH = 2

GRID_W = 64
CTX_LEN = 256
SHORT_CONV = 3
NORM_EPS = 1e-6
N_BRANCH = 3
MIX_WIDTH = 512

HY_WIDTH = MIX_WIDTH
HY_ORDER = 2
HY_FILTER_DIM = 64
HY_BANDS = 16
HY_EMB = 2 * HY_BANDS + 1
HY_DECAY_TARGET = 1e-2
HY_FAST_PCT = 0.3
HY_SLOW_PCT = 1.5

RW_HEAD = 64
RW_HEADS = MIX_WIDTH // RW_HEAD
RW_WIDTH = RW_HEADS * RW_HEAD
RW_DECAY_RANK = 64
RW_ICLR_RANK = 64
RW_GATE_RANK = 128
RW_LN_EPS = 64e-5

S5_GROUP = 16
S5_GROUPS = MIX_WIDTH // S5_GROUP
S5_WIDTH = S5_GROUPS * S5_GROUP
S5_STATE = 64

N_EXPERTS = 32
TOP_K = 4
D_EXPERT = 1024
SWIGLU_LIMIT = 7.0
SWIGLU_ALPHA = 1.702
MOE_BLOCK = 128

HY_COLS = (HY_ORDER + 1) * HY_WIDTH
RW_COLS = 3 * RW_WIDTH + RW_DECAY_RANK + RW_ICLR_RANK + RW_GATE_RANK
S5_COLS = S5_WIDTH
GATE_COLS = N_BRANCH * D_MODEL
IN_COLS = HY_COLS + RW_COLS + S5_COLS + GATE_COLS
RW_SPLITS = (RW_WIDTH, 2 * RW_WIDTH, 3 * RW_WIDTH, 3 * RW_WIDTH + RW_DECAY_RANK,
             3 * RW_WIDTH + RW_DECAY_RANK + RW_ICLR_RANK)

kernel_name = 'hybrid_hyena_rwkv7_s5_moe_dit'


def rmsnorm(x, g):
    xf = x.astype(jnp.float32)
    y = xf * lax.rsqrt(jnp.mean(xf * xf, axis=-1, keepdims=True) + NORM_EPS)
    return (y * g.astype(jnp.float32)).astype(x.dtype)


def modulate(x, g, shift, scale):
    return rmsnorm(x, g) * (1 + scale) + shift


def short_conv(z, w, b):
    n = z.shape[1]
    half = SHORT_CONV // 2
    zp = jnp.pad(z, ((0, 0), (half, half), (0, 0)))
    return sum(zp[:, j:j + n] * w[j] for j in range(SHORT_CONV)) + b


def grid_pos_embed(n_tokens):
    rows = n_tokens // GRID_W
    row_id, col_id = jnp.meshgrid(jnp.arange(rows), jnp.arange(GRID_W), indexing='ij')
    quarter = D_MODEL // 4
    omega = 1.0 / (10000.0 ** (jnp.arange(quarter, dtype=jnp.float32) / quarter))

    def enc(p):
        ang = p.reshape(-1)[:, None].astype(jnp.float32) * omega
        return jnp.concatenate([jnp.sin(ang), jnp.cos(ang)], axis=-1)

    return jnp.concatenate([enc(row_id), enc(col_id)], axis=-1)


def hyena_filters(n, w1, b1, f1, w2, b2, f2, w3, b3):
    f32 = jnp.float32
    t = jnp.linspace(0.0, 1.0, n, dtype=f32)[:, None]
    bands = jnp.linspace(1e-4, HY_BANDS - 1, HY_BANDS, dtype=f32)
    ang = (2 * math.pi * jnp.arange(n, dtype=f32) / n)[:, None] * bands
    feats = jnp.concatenate([t, jnp.cos(ang), -jnp.sin(ang)], axis=-1)
    hf = jnp.sin(f1.astype(f32) * (feats @ w1.astype(f32) + b1.astype(f32)))
    hf = jnp.sin(f2.astype(f32) * (hf @ w2.astype(f32) + b2.astype(f32)))
    hf = (hf @ w3.astype(f32) + b3.astype(f32)).reshape(n, HY_ORDER, 2, HY_WIDTH)
    deltas = jnp.abs(jnp.linspace(math.log(HY_DECAY_TARGET) / HY_SLOW_PCT,
                                  math.log(HY_DECAY_TARGET) / HY_FAST_PCT, HY_WIDTH, dtype=f32))
    hf = hf * jnp.exp(-t * deltas)[:, None, None, :]
    fwd = hf[:, :, 0]
    bwd = hf[1:, :, 1][::-1]
    return jnp.concatenate([fwd, jnp.zeros((1, HY_ORDER, HY_WIDTH), f32), bwd], axis=0)


def fft_long_conv(z, filt, bias):
    n = z.shape[1]
    zf = z.astype(jnp.float32)
    spec = jnp.fft.rfft(zf, n=2 * n, axis=1) * jnp.fft.rfft(filt, n=2 * n, axis=0)[None]
    y = jnp.fft.irfft(spec, n=2 * n, axis=1)[:, :n]
    return (y + zf * bias.astype(jnp.float32)).astype(z.dtype)


def hyena_branch(z, conv_w, conv_b, w1, b1, f1, w2, b2, f2, w3, b3, bias):
    u = short_conv(z, conv_w, conv_b)
    x1, x2, v = jnp.split(u, 3, axis=-1)
    filt = hyena_filters(z.shape[1], w1, b1, f1, w2, b2, f2, w3, b3)
    y = x1 * fft_long_conv(v, filt[:, 0], bias[0])
    return x2 * fft_long_conv(y, filt[:, 1], bias[1])


def _heads(t):
    return t.reshape(t.shape[:-1] + (RW_HEADS, RW_HEAD))


def rwkv_prep(z, conv_w, conv_b, w_up, w0, a_up, a0, g_up, k_k, k_a):
    u = short_conv(z, conv_w, conv_b).astype(jnp.float32)
    r, k, v, xw, xa, xg = jnp.split(u, RW_SPLITS, axis=-1)
    g = jax.nn.sigmoid(xg) @ g_up.astype(jnp.float32)
    kk = _heads(k * k_k)
    kk = kk * lax.rsqrt(jnp.maximum(jnp.sum(kk * kk, axis=-1, keepdims=True), 1e-24))
    w = -jax.nn.softplus(-(w0[:, None, None, :] + jnp.einsum('blr,drc->dblc', jnp.tanh(xw), w_up))) - 0.5
    decay = _heads(jnp.exp(-jnp.exp(w)))
    a = _heads(jax.nn.sigmoid(a0[:, None, None, :] + jnp.einsum('blr,drc->dblc', xa, a_up)))
    k_dir = _heads(k) * (1 + (a - 1) * _heads(k_a))
    return _heads(r), _heads(v), g, kk, decay, a, k_dir


def wkv_scan(r, decay, k, v, kk, a, s0, reverse, with_output):
    xs = tuple(jnp.moveaxis(t, 1, 0) for t in (r, decay, k, v, -kk, kk * a))

    def step(s, inp):
        r_t, w_t, k_t, v_t, a_t, b_t = inp
        sa = jnp.einsum('bhvk,bhk->bhv', s, a_t)
        s = s * w_t[:, :, None, :] + sa[..., None] * b_t[:, :, None, :] + v_t[..., None] * k_t[:, :, None, :]
        y = jnp.einsum('bhvk,bhk->bhv', s, r_t) if with_output else None
        return s, y

    s, ys = lax.scan(step, s0, xs, reverse=reverse)
    return s, (jnp.moveaxis(ys, 0, 1) if with_output else None)


def rwkv_readout(r, v, g, k_dir, y_dirs, r_k, ln_g, ln_b, dtype):
    bonus = jnp.sum(r * k_dir * r_k, axis=(0, -1))[..., None] * v
    y = y_dirs[0] + y_dirs[1] + bonus
    mu = jnp.mean(y, axis=-1, keepdims=True)
    var = jnp.mean(jnp.square(y - mu), axis=-1, keepdims=True)
    y = ((y - mu) * lax.rsqrt(var + RW_LN_EPS)).reshape(y.shape[:2] + (RW_WIDTH,))
    return ((y * ln_g + ln_b) * g).astype(dtype)


def rwkv_branch(z, zc, need_ctx, conv_w, conv_b, w_up, w0, a_up, a0, g_up, k_k, k_a, r_k, ln_g, ln_b):
    r, v, g, kk, decay, a, k_dir = rwkv_prep(z, conv_w, conv_b, w_up, w0, a_up, a0, g_up, k_k, k_a)
    rc, vc, gc, kkc, decayc, ac, k_dirc = rwkv_prep(zc, conv_w, conv_b, w_up, w0, a_up, a0, g_up, k_k, k_a)
    s0 = jnp.zeros((z.shape[0], RW_HEADS, RW_HEAD, RW_HEAD), jnp.float32)
    y_lat, y_ctx = [], []
    for d, rev in enumerate((False, True)):
        s_ctx, yc_d = wkv_scan(rc, decayc[d], k_dirc[d], vc, kkc, ac[d], s0, rev, need_ctx)
        _, yl_d = wkv_scan(r, decay[d], k_dir[d], v, kk, a[d], s_ctx, rev, True)
        y_lat.append(yl_d)
        y_ctx.append(yc_d)
    out = rwkv_readout(r, v, g, k_dir, y_lat, r_k, ln_g, ln_b, z.dtype)
    out_c = rwkv_readout(rc, vc, gc, k_dirc, y_ctx, r_k, ln_g, ln_b, zc.dtype) if need_ctx else None
    return out, out_c


def s5_discretise(a_re, a_im, log_dt, b_re, b_im):
    f32 = jnp.float32
    a_re, a_im, b_re, b_im = (t.astype(f32) for t in (a_re, a_im, b_re, b_im))
    dt = jnp.exp(log_dt.astype(f32))[:, None]
    mag = jnp.exp(a_re * dt)
    lb_re, lb_im = mag * jnp.cos(a_im * dt), mag * jnp.sin(a_im * dt)
    den = a_re * a_re + a_im * a_im
    nr = lb_re - 1.0
    cr = (nr * a_re + lb_im * a_im) / den
    ci = (lb_im * a_re - nr * a_im) / den
    bb_re = cr[..., None] * b_re - ci[..., None] * b_im
    bb_im = cr[..., None] * b_im + ci[..., None] * b_re
    return lb_re, lb_im, bb_re, bb_im


def _linear_recurrence_combine(e_i, e_j):
    ar_i, ai_i, br_i, bi_i = e_i
    ar_j, ai_j, br_j, bi_j = e_j
    return (ar_j * ar_i - ai_j * ai_i,
            ar_j * ai_i + ai_j * ar_i,
            ar_j * br_i - ai_j * bi_i + br_j,
            ar_j * bi_i + ai_j * br_i + bi_j)


def s5_scan(u, lb_re, lb_im, bb_re, bb_im, s0_re, s0_im, reverse):
    n = u.shape[1]
    bu_re = jnp.einsum('blgh,gph->blgp', u, bb_re)
    bu_im = jnp.einsum('blgh,gph->blgp', u, bb_im)
    edge = n - 1 if reverse else 0
    bu_re = bu_re.at[:, edge].add(lb_re * s0_re - lb_im * s0_im)
    bu_im = bu_im.at[:, edge].add(lb_re * s0_im + lb_im * s0_re)
    shape = (1, n) + lb_re.shape
    elems = (jnp.broadcast_to(lb_re, shape), jnp.broadcast_to(lb_im, shape), bu_re, bu_im)
    _, _, h_re, h_im = lax.associative_scan(_linear_recurrence_combine, elems, reverse=reverse, axis=1)
    return h_re, h_im


def s5_readout(h_re, h_im, u_g, c_re, c_im, d_skip, glu_w, glu_b, dtype):
    f32 = jnp.float32
    y = (jnp.einsum('blgp,ghp->blgh', h_re, c_re.astype(f32))
         - jnp.einsum('blgp,ghp->blgh', h_im, c_im.astype(f32))
         + u_g * d_skip.astype(f32).reshape(S5_GROUPS, S5_GROUP))
    y = jax.nn.gelu(y.reshape(y.shape[:2] + (S5_WIDTH,)))
    lin, gate = jnp.split(y @ glu_w.astype(f32) + glu_b.astype(f32), 2, axis=-1)
    return (lin * jax.nn.sigmoid(gate)).astype(dtype)


def s5_branch(u, uc, need_ctx, a_re, a_im, log_dt, b_re, b_im, c_re, c_im, d_skip, glu_w, glu_b):
    def groups(t):
        return t.astype(jnp.float32).reshape(t.shape[:2] + (S5_GROUPS, S5_GROUP))

    ul, ucg = groups(u), groups(uc)
    s0 = jnp.zeros((u.shape[0], S5_GROUPS, S5_STATE), jnp.float32)
    lat_re, lat_im, ctx_re, ctx_im = [], [], [], []
    for d, rev in enumerate((False, True)):
        lb_re, lb_im, bb_re, bb_im = s5_discretise(a_re[d], a_im[d], log_dt[d], b_re, b_im)
        hc_re, hc_im = s5_scan(ucg, lb_re, lb_im, bb_re, bb_im, s0, s0, rev)
        edge = 0 if rev else -1
        hl_re, hl_im = s5_scan(ul, lb_re, lb_im, bb_re, bb_im, hc_re[:, edge], hc_im[:, edge], rev)
        lat_re.append(hl_re)
        lat_im.append(hl_im)
        ctx_re.append(hc_re)
        ctx_im.append(hc_im)
    out = s5_readout(lat_re[0] + lat_re[1], lat_im[0] + lat_im[1], ul, c_re, c_im, d_skip, glu_w, glu_b, u.dtype)
    if not need_ctx:
        return out, None
    out_c = s5_readout(ctx_re[0] + ctx_re[1], ctx_im[0] + ctx_im[1], ucg, c_re, c_im, d_skip, glu_w, glu_b, uc.dtype)
    return out, out_c


def merge_branches(zg, y_hy, y_rw, y_s5, w_branch, w_out):
    g_hy, g_rw, g_s5 = jnp.split(jax.nn.sigmoid(zg), N_BRANCH, axis=-1)
    m = g_hy * (y_hy @ w_branch[0]) + g_rw * (y_rw @ w_branch[1]) + g_s5 * (y_s5 @ w_branch[2])
    return m @ w_out


def token_mixer(h, hc, need_ctx, w_in, hy_conv_w, hy_conv_b, hy_w1, hy_b1, hy_f1, hy_w2, hy_b2, hy_f2,
                hy_w3, hy_b3, hy_bias, rw_conv_w, rw_conv_b, rw_w_up, rw_w0, rw_a_up, rw_a0, rw_g_up,
                rw_k_k, rw_k_a, rw_r_k, rw_ln_g, rw_ln_b, s5_a_re, s5_a_im, s5_log_dt, s5_b_re, s5_b_im,
                s5_c_re, s5_c_im, s5_d, s5_glu_w, s5_glu_b, w_branch, w_out):
    bounds = (HY_COLS, HY_COLS + RW_COLS, HY_COLS + RW_COLS + S5_COLS)
    z_hy, z_rw, z_s5, z_gate = jnp.split(h @ w_in, bounds, axis=-1)
    zc_hy, zc_rw, zc_s5, zc_gate = jnp.split(hc @ w_in, bounds, axis=-1)
    hyena_args = (hy_conv_w, hy_conv_b, hy_w1, hy_b1, hy_f1, hy_w2, hy_b2, hy_f2, hy_w3, hy_b3, hy_bias)
    y_hy = hyena_branch(z_hy, *hyena_args)
    y_rw, yc_rw = rwkv_branch(z_rw, zc_rw, need_ctx, rw_conv_w, rw_conv_b, rw_w_up, rw_w0, rw_a_up, rw_a0,
                              rw_g_up, rw_k_k, rw_k_a, rw_r_k, rw_ln_g, rw_ln_b)
    y_s5, yc_s5 = s5_branch(z_s5, zc_s5, need_ctx, s5_a_re, s5_a_im, s5_log_dt, s5_b_re, s5_b_im,
                            s5_c_re, s5_c_im, s5_d, s5_glu_w, s5_glu_b)
    y = merge_branches(z_gate, y_hy, y_rw, y_s5, w_branch, w_out)
    if not need_ctx:
        return y, None
    yc = merge_branches(zc_gate, hyena_branch(zc_hy, *hyena_args), yc_rw, yc_s5, w_branch, w_out)
    return y, yc


def moe_ffn(h, router_w, router_b, w1, b1, w2, b2):
    bsz, n, dm = h.shape
    xt = h.reshape(-1, dm)
    n_tok = xt.shape[0]
    n_asg = n_tok * TOP_K
    logits = (xt @ router_w + router_b).astype(jnp.float32)
    top_val, top_idx = lax.top_k(logits, TOP_K)
    gate = jax.nn.softmax(top_val, axis=-1).astype(h.dtype)
    flat_e = top_idx.reshape(-1)
    flat_tok = jnp.repeat(jnp.arange(n_tok, dtype=jnp.int32), TOP_K)
    flat_w = gate.reshape(-1)
    order = jnp.argsort(flat_e)
    sorted_e = flat_e[order]
    counts = jnp.bincount(flat_e, length=N_EXPERTS)
    padded = (counts + MOE_BLOCK - 1) // MOE_BLOCK * MOE_BLOCK
    pad_end = jnp.cumsum(padded)
    pad_start = pad_end - padded
    grp_start = jnp.cumsum(counts) - counts
    dest = pad_start[sorted_e] + jnp.arange(n_asg, dtype=jnp.int32) - grp_start[sorted_e]
    n_blocks = -(-n_asg // MOE_BLOCK) + N_EXPERTS
    n_slots = n_blocks * MOE_BLOCK
    slot_tok = jnp.zeros((n_slots,), jnp.int32).at[dest].set(flat_tok[order])
    slot_w = jnp.zeros((n_slots,), h.dtype).at[dest].set(flat_w[order])
    blk_e = jnp.minimum(jnp.searchsorted(pad_end, jnp.arange(n_blocks) * MOE_BLOCK, side='right'), N_EXPERTS - 1)
    xs = xt[slot_tok].reshape(n_blocks, MOE_BLOCK, dm)

    def expert_block(args):
        xb, e = args
        gl, up = jnp.split(xb @ w1[e] + b1[e], 2, axis=-1)
        gl = jnp.minimum(gl, SWIGLU_LIMIT)
        up = jnp.clip(up, -SWIGLU_LIMIT, SWIGLU_LIMIT)
        act = (up + 1) * gl * jax.nn.sigmoid(SWIGLU_ALPHA * gl)
        return act @ w2[e] + b2[e]

    ys = lax.map(expert_block, (xs, blk_e)).reshape(n_slots, dm)
    out = jax.ops.segment_sum(ys * slot_w[:, None], slot_tok, num_segments=n_tok)
    return out.reshape(bsz, n, dm)


def setup_inputs(seed: int = 0) -> dict:
    key = jax.random.key(seed)
    ks = iter(jax.random.split(key, 64))
    f32 = jnp.float32

    def nrm(shape, scale):
        return jax.random.normal(next(ks), shape, f32) * scale

    def uni(shape, lo, hi):
        return jax.random.uniform(next(ks), shape, f32, minval=lo, maxval=hi)

    L, D = DEPTH, D_MODEL
    G, P, H = S5_GROUPS, S5_STATE, S5_GROUP
    return {
        'x': nrm((BATCH, SEQ, D), 1.0),
        'c': nrm((BATCH, D), 1.0),
        'ctx': nrm((BATCH, CTX_LEN, D), 1.0),
        'c_ctx': nrm((D,), 1.0),
        'ada_w': nrm((L, D, 6 * D), D ** -0.5),
        'ada_b': nrm((L, 6 * D), 0.02),
        'norm1_g': 1.0 + nrm((L, D), 0.02),
        'norm2_g': 1.0 + nrm((L, D), 0.02),
        'w_in': nrm((L, D, IN_COLS), D ** -0.5),
        'hy_conv_w': nrm((L, SHORT_CONV, HY_COLS), SHORT_CONV ** -0.5),
        'hy_conv_b': nrm((L, HY_COLS), 0.02),
        'hy_w1': nrm((L, HY_EMB, HY_FILTER_DIM), HY_EMB ** -0.5),
        'hy_b1': nrm((L, HY_FILTER_DIM), 0.02),
        'hy_f1': 1.0 + nrm((L, HY_FILTER_DIM), 0.02),
        'hy_w2': nrm((L, HY_FILTER_DIM, HY_FILTER_DIM), HY_FILTER_DIM ** -0.5),
        'hy_b2': nrm((L, HY_FILTER_DIM), 0.02),
        'hy_f2': 1.0 + nrm((L, HY_FILTER_DIM), 0.02),
        'hy_w3': nrm((L, HY_FILTER_DIM, HY_ORDER * 2 * HY_WIDTH), 0.005),
        'hy_b3': nrm((L, HY_ORDER * 2 * HY_WIDTH), 0.002),
        'hy_bias': nrm((L, HY_ORDER, HY_WIDTH), 0.1),
        'rw_conv_w': nrm((L, SHORT_CONV, RW_COLS), SHORT_CONV ** -0.5),
        'rw_conv_b': nrm((L, RW_COLS), 0.02),
        'rw_w_up': nrm((L, 2, RW_DECAY_RANK, RW_WIDTH), 0.5 * RW_DECAY_RANK ** -0.5),
        'rw_w0': uni((L, 2, RW_WIDTH), -6.0, 0.0),
        'rw_a_up': nrm((L, 2, RW_ICLR_RANK, RW_WIDTH), 0.5 * RW_ICLR_RANK ** -0.5),
        'rw_a0': nrm((L, 2, RW_WIDTH), 0.1),
        'rw_g_up': nrm((L, RW_GATE_RANK, RW_WIDTH), RW_GATE_RANK ** -0.5),
        'rw_k_k': 0.85 + nrm((L, RW_WIDTH), 0.02),
        'rw_k_a': 1.0 + nrm((L, RW_WIDTH), 0.02),
        'rw_r_k': nrm((L, RW_HEADS, RW_HEAD), 0.1),
        'rw_ln_g': 1.0 + nrm((L, RW_WIDTH), 0.02),
        'rw_ln_b': nrm((L, RW_WIDTH), 0.02),
        's5_a_re': -0.5 + nrm((L, 2, G, P), 0.01),
        's5_a_im': math.pi * jnp.arange(P, dtype=f32) + nrm((L, 2, G, P), 0.01),
        's5_log_dt': uni((L, 2, G), math.log(1e-3), math.log(1e-1)),
        's5_b_re': nrm((L, G, P, H), H ** -0.5),
        's5_b_im': nrm((L, G, P, H), H ** -0.5),
        's5_c_re': nrm((L, G, H, P), P ** -0.5),
        's5_c_im': nrm((L, G, H, P), P ** -0.5),
        's5_d': nrm((L, S5_WIDTH), 0.5),
        's5_glu_w': nrm((L, S5_WIDTH, 2 * S5_WIDTH), S5_WIDTH ** -0.5),
        's5_glu_b': nrm((L, 2 * S5_WIDTH), 0.02),
        'w_branch': nrm((L, N_BRANCH, MIX_WIDTH, D), MIX_WIDTH ** -0.5),
        'w_out': nrm((L, D, D), D ** -0.5),
        'router_w': nrm((L, D, N_EXPERTS), D ** -0.5),
        'router_b': nrm((L, N_EXPERTS), 0.01),
        'moe_w1': nrm((L, N_EXPERTS, D, 2 * D_EXPERT), D ** -0.5),
        'moe_b1': nrm((L, N_EXPERTS, 2 * D_EXPERT), 0.02),
        'moe_w2': nrm((L, N_EXPERTS, D_EXPERT, D), D_EXPERT ** -0.5),
        'moe_b2': nrm((L, N_EXPERTS, D), 0.02),
        'final_g': 1.0 + nrm((D,), 0.02),
    }


def reference(x, c, ctx, c_ctx, ada_w, ada_b, norm1_g, norm2_g, w_in, hy_conv_w, hy_conv_b, hy_w1, hy_b1,
              hy_f1, hy_w2, hy_b2, hy_f2, hy_w3, hy_b3, hy_bias, rw_conv_w, rw_conv_b, rw_w_up, rw_w0,
              rw_a_up, rw_a0, rw_g_up, rw_k_k, rw_k_a, rw_r_k, rw_ln_g, rw_ln_b, s5_a_re, s5_a_im,
              s5_log_dt, s5_b_re, s5_b_im, s5_c_re, s5_c_im, s5_d, s5_glu_w, s5_glu_b, w_branch, w_out,
              router_w, router_b, moe_w1, moe_b1, moe_w2, moe_b2, final_g):
    x = x + grid_pos_embed(x.shape[1]).astype(x.dtype)
    xc = ctx
    cond = jax.nn.silu(c)[:, None, :]
    cond_ctx = jax.nn.silu(c_ctx)
    for l in range(DEPTH):
        need_ctx = l < DEPTH - 1
        sh1, sc1, g1, sh2, sc2, g2 = jnp.split(cond @ ada_w[l] + ada_b[l], 6, axis=-1)
        csh1, csc1, cg1, csh2, csc2, cg2 = jnp.split(cond_ctx @ ada_w[l] + ada_b[l], 6, axis=-1)
        y, yc = token_mixer(
            modulate(x, norm1_g[l], sh1, sc1), modulate(xc, norm1_g[l], csh1, csc1), need_ctx,
            w_in[l], hy_conv_w[l], hy_conv_b[l], hy_w1[l], hy_b1[l], hy_f1[l], hy_w2[l], hy_b2[l], hy_f2[l],
            hy_w3[l], hy_b3[l], hy_bias[l], rw_conv_w[l], rw_conv_b[l], rw_w_up[l], rw_w0[l], rw_a_up[l],
            rw_a0[l], rw_g_up[l], rw_k_k[l], rw_k_a[l], rw_r_k[l], rw_ln_g[l], rw_ln_b[l], s5_a_re[l],
            s5_a_im[l], s5_log_dt[l], s5_b_re[l], s5_b_im[l], s5_c_re[l], s5_c_im[l], s5_d[l], s5_glu_w[l],
            s5_glu_b[l], w_branch[l], w_out[l])
        x = x + g1 * y
        x = x + g2 * moe_ffn(modulate(x, norm2_g[l], sh2, sc2), router_w[l], router_b[l],
                             moe_w1[l], moe_b1[l], moe_w2[l], moe_b2[l])
        if need_ctx:
            xc = xc + cg1 * yc
            xc = xc + cg2 * moe_ffn(modulate(xc, norm2_g[l], csh2, csc2), router_w[l], router_b[l],
                                    moe_w1[l], moe_b1[l], moe_w2[l], moe_b2[l])
    return rmsnorm(x, final_g)
```

```cpp
#include <hip/hip_runtime.h>
#include <cstdio>
#include <cstdint>

#ifndef MK_PER_STAGE
#define MK_PER_STAGE 0
#endif

#define GAS __attribute__((address_space(1)))
#define LAS __attribute__((address_space(3)))
typedef unsigned short bf16;
typedef unsigned v4u __attribute__((ext_vector_type(4)));
typedef unsigned v2u __attribute__((ext_vector_type(2)));
typedef float f32x4 __attribute__((ext_vector_type(4)));
typedef float f32x2 __attribute__((ext_vector_type(2)));
typedef short bf16x8 __attribute__((ext_vector_type(8)));

constexpr int D = 1024, BATCH = 8, SEQ = 4096, CTXL = 256, DEPTH = 2;
constexpr int T_LAT = BATCH * SEQ, T_CTX = BATCH * CTXL, T_ALL = T_LAT + T_CTX;
constexpr int IN_COLS = 6912, HY_OFF = 0, RW_OFF = 1536, S5_OFF = 3328, GATE_OFF = 3840;
constexpr int NE = 32, TOPK = 4;
constexpr int MAXSLOT = 147456;
constexpr int NWAVES = 8, NTHREADS = 512;

constexpr size_t MiB = 1ull << 20;
constexpr size_t WS_CTL = 0, CTL_ZERO_BYTES = 1 * MiB;
constexpr size_t WS_MOD = 1 * MiB;
constexpr size_t WS_BLKCNT = 2 * MiB;
constexpr size_t WS_META = 2 * MiB + 512 * 1024;
constexpr size_t WS_EIDX = 3 * MiB, WS_GATE = 4 * MiB, WS_POS = 5 * MiB;
constexpr size_t WS_WTS = 8 * MiB, WL_STRIDE = 214 * MiB;
constexpr size_t WO_WIN = 0, WO_RWCAT = 14 * MiB, WO_GLU = 16 * MiB, WO_WBR = 17 * MiB, WO_WOUT = 20 * MiB, WO_W1 = 22 * MiB, WO_W2 = 150 * MiB;
constexpr size_t WS_GF = 436 * MiB, GF_STRIDE = 34 * MiB, GF_CTX = 32 * MiB;
constexpr size_t WS_X = 504 * MiB;
constexpr size_t WS_H = 640 * MiB;
constexpr size_t WS_BIG = 708 * MiB;
constexpr size_t WS_Z = WS_BIG;
constexpr size_t WS_SCN = 1167 * MiB;
constexpr size_t WS_MTMP = WS_SCN;
constexpr size_t WS_P = 1473 * MiB;
constexpr size_t WS_ARW = 1643 * MiB;
constexpr size_t WS_YP = 1660 * MiB;
constexpr size_t WS_YDIR = WS_YP;
constexpr size_t WS_Y1 = 1796 * MiB;
constexpr size_t WS_AS5 = 1864 * MiB;
constexpr size_t WS_YHY = 1898 * MiB, WS_YRW = 1932 * MiB, WS_YS5 = 1966 * MiB;
constexpr size_t WS_XS = WS_BIG;
constexpr size_t WS_ACT = WS_BIG + 288 * MiB;
constexpr size_t WS_END = 2000 * MiB;
constexpr int CW_BAR = 4096;

constexpr int RING_BYTES = 131072;
constexpr int LDSCTL_OFF = RING_BYTES;
constexpr int LDS_BYTES = 147456;

__device__ __forceinline__ unsigned f2bf(float f) { unsigned u = __builtin_bit_cast(unsigned, f); return (u + 0x7fffu + ((u >> 16) & 1u)) >> 16; }
__device__ __forceinline__ unsigned pk2(float lo, float hi) { return f2bf(lo) | (f2bf(hi) << 16); }
__device__ __forceinline__ float bf2f(bf16 b) { return __builtin_bit_cast(float, ((unsigned)b) << 16); }
__device__ __forceinline__ float bflo(unsigned w) { return __builtin_bit_cast(float, w << 16); }
__device__ __forceinline__ float bfhi(unsigned w) { return __builtin_bit_cast(float, w & 0xffff0000u); }
__device__ __forceinline__ float wave_sum(float v) {
#pragma unroll
    for (int o = 1; o < 64; o <<= 1) v += __shfl_xor(v, o);
    return v;
}
__device__ __forceinline__ float sigm(float x) { return 1.f / (1.f + __expf(-x)); }
#define LDS_WAIT() asm volatile("s_waitcnt lgkmcnt(0)" ::: "memory")

#define XB_TMO      128
#define XB_XCNT(j)  (256  + 64 * (j))
#define XB_XSUB(j)  (1280 + 64 * (j))
#define XB_XGEN(j)  (2304 + 64 * (j))
#define XB_TOP      3328
#define XB_TOPGEN   3392
#define XCD_BAR_WORDS 3456
#define XB_SPIN_CAP (1u << 22)
__device__ __forceinline__ unsigned xb_ld(unsigned* p)              { return __hip_atomic_load(p, __ATOMIC_RELAXED, __HIP_MEMORY_SCOPE_AGENT); }
__device__ __forceinline__ unsigned xb_add(unsigned* p, unsigned v) { return __hip_atomic_fetch_add(p, v, __ATOMIC_RELAXED, __HIP_MEMORY_SCOPE_AGENT); }
__device__ __forceinline__ unsigned xb_xcc_id() { return (unsigned)__builtin_amdgcn_s_getreg((3 << 11) | 20) & 0xFu; }
#define XB_SPIN(cond, bar) do { unsigned _sp = 0; while (cond) { __builtin_amdgcn_s_sleep(1); \
    if ((++_sp & 255u) == 0u) { if (xb_ld(&(bar)[XB_TMO])) break; if (_sp > XB_SPIN_CAP) { atomicAdd(&(bar)[XB_TMO], 1u); break; } } } } while (0)
struct XcdBarrier { unsigned* bar; unsigned x; volatile LAS unsigned* st; };
__device__ __forceinline__ XcdBarrier xcd_barrier_post(unsigned* bar, volatile LAS unsigned* st) {
    XcdBarrier b; b.bar = bar; b.x = xb_xcc_id(); b.st = st;
    if (threadIdx.x == 0) (void)xb_add(&bar[XB_XCNT(b.x)], 1u);
    return b;
}
__device__ __forceinline__ void xcd_barrier_complete(unsigned* bar, unsigned x, unsigned& nloc, unsigned& nx) {
    const unsigned G = gridDim.x * gridDim.y * gridDim.z;
    unsigned sum, cnt, mine, sp = 0u;
    for (;;) {
        sum = 0u; cnt = 0u; mine = 0u;
#pragma unroll
        for (unsigned j = 0; j < 16; ++j) { const unsigned c = xb_ld(&bar[XB_XCNT(j)]); sum += c; cnt += (c > 0u) ? 1u : 0u; mine = (j == x) ? c : mine; }
        if (sum == G) break;
        __builtin_amdgcn_s_sleep(1);
        if ((++sp & 255u) == 0u) { if (xb_ld(&bar[XB_TMO])) break; if (sp > XB_SPIN_CAP) { atomicAdd(&bar[XB_TMO], 1u); break; } }
    }
    nloc = mine > 0u ? mine : 1u; nx = cnt > 0u ? cnt : 1u;
}
__device__ __forceinline__ void xcd_barrier(const XcdBarrier& b) {
    asm volatile("s_waitcnt vmcnt(0)" ::: "memory");
    __syncthreads();
    if (threadIdx.x == 0) {
        unsigned* bar = b.bar;
        __builtin_amdgcn_s_waitcnt(0);
        unsigned nloc = b.st[0], nx = b.st[1];
        if (nloc == 0u) { xcd_barrier_complete(bar, b.x, nloc, nx); b.st[0] = nloc; b.st[1] = nx; }
        const unsigned old = xb_add(&bar[XB_XSUB(b.x)], 1u);
        const unsigned gen = old / nloc;
        if (old + 1u == (gen + 1u) * nloc) {
            __builtin_amdgcn_fence(__ATOMIC_RELEASE, "agent");
            asm volatile("s_waitcnt vmcnt(0)" ::: "memory");
            const unsigned og = xb_add(&bar[XB_TOP], 1u);
            const unsigned tg = og / nx;
            if (og + 1u == (tg + 1u) * nx) xb_add(&bar[XB_TOPGEN], 1u);
            else XB_SPIN(xb_ld(&bar[XB_TOPGEN]) == tg, bar);
            __builtin_amdgcn_fence(__ATOMIC_ACQUIRE, "agent");
            xb_add(&bar[XB_XGEN(b.x)], 1u);
            asm volatile("s_waitcnt vmcnt(0)" ::: "memory");
        } else {
            XB_SPIN(xb_ld(&bar[XB_XGEN(b.x)]) == gen, bar);
            __builtin_amdgcn_fence(__ATOMIC_ACQUIRE, "agent");
            asm volatile("s_waitcnt vmcnt(0)" ::: "memory");
        }
    }
    __syncthreads();
}

namespace pg8 {
constexpr int BM = 256, BK = 64, HALF = 128, HTB = HALF * BK * 2, STAGE_BYTES = 8 * HTB, NXCD = 8, WGM = 8;
__host__ __device__ __forceinline__ int lds_byte(int r, int c) { const int st = (r >> 4) * 2 + (c >> 5), rr = r & 15, cc = c & 31, ob = rr * 64 + cc * 2; return st * 1024 + (ob ^ (((ob >> 9) & 1) << 5)); }
__host__ __device__ __forceinline__ void stage_rc(int b, int& R, int& C) { const int st = b / 1024, sb = b % 1024, swz = sb ^ (((sb >> 9) & 1) << 5); R = (st >> 1) * 16 + swz / 64; C = (st & 1) * 32 + (swz % 64) / 2; }
__host__ __device__ __forceinline__ int perm32(int rho) { const int n = rho >> 4, i = rho & 15; return 8 * (i >> 2) + 4 * n + (i & 3); }
struct Unit { int pm, pn, e; };
__device__ __forceinline__ unsigned cvt_pk_bf16(float lo, float hi) { unsigned r; asm volatile("v_cvt_pk_bf16_f32 %0, %1, %2" : "=v"(r) : "v"(lo), "v"(hi)); return r; }

__device__ __forceinline__ void tile_of(int L, int nM, int nN, int& pm, int& pn) {
    const int nwg = nM * nN; int wgid = L;
    { const int q = nwg / NXCD, r = nwg % NXCD, xcd = wgid % NXCD, off = wgid / NXCD; wgid = (xcd < r ? xcd * (q + 1) : r * (q + 1) + (xcd - r) * q) + off; }
    const int nig = WGM * nN, gid = wgid / nig, fm = gid * WGM, gsz = (nM - fm) < WGM ? (nM - fm) : WGM;
    pm = fm + ((wgid % nig) % gsz); pn = (wgid % nig) / gsz;
}
struct SchedStatic {
    const char* A; const char* Bt; size_t tstep; int nM, nN, G, c;
    __device__ __forceinline__ void init(const void* A_, const void* Bt_, int M, int N, int K, int G_, int c_) { A = (const char*)A_; Bt = (const char*)Bt_; tstep = (size_t)BM * K * 2; nM = M / BM; nN = N / BM; G = G_; c = c_; }
    __device__ __forceinline__ bool next(int i, Unit& u) const { const long L = (long)i * G + c; if (L >= (long)nM * nN) return false; tile_of((int)L, nM, nN, u.pm, u.pn); u.e = 0; return true; }
    __device__ __forceinline__ const char* aptr(const Unit& u) const { return A + (size_t)u.pm * tstep; }
    __device__ __forceinline__ const char* bptr(const Unit& u) const { return Bt + (size_t)u.pn * tstep; }
};
struct SchedMerge {
    const char* A0; const char* A1; const char* A2; const char* Bt; size_t tstep, bstride; int nM, nN, G, c;
    __device__ __forceinline__ bool next(int i, Unit& u) const { const int j = i / 3, br = i - 3 * j; const long L = (long)j * G + c; if (L >= (long)nM * nN) return false; tile_of((int)L, nM, nN, u.pm, u.pn); u.e = br; return true; }
    __device__ __forceinline__ const char* aptr(const Unit& u) const { return (u.e == 0 ? A0 : (u.e == 1 ? A1 : A2)) + (size_t)u.pm * tstep; }
    __device__ __forceinline__ const char* bptr(const Unit& u) const { return Bt + (size_t)u.e * bstride + (size_t)u.pn * tstep; }
};
struct SchedMoe {
    const char* A; const char* Bt; size_t tstep, estride; int NPN, G, c; const LAS int* base;
    __device__ __forceinline__ bool next(int i, Unit& u) const {
        const int ntiles = base[32] >> 8; const long L = (long)i * G + c; if (L >= (long)ntiles * NPN) return false;
        u.pm = (int)(L / NPN); u.pn = (int)(L % NPN); const int r0 = u.pm << 8; int e = 0;
#pragma unroll 1
        for (int k = 1; k < 32; ++k) e += (r0 >= base[k]) ? 1 : 0;
        u.e = e; return true;
    }
    __device__ __forceinline__ const char* aptr(const Unit& u) const { return A + (size_t)u.pm * tstep; }
    __device__ __forceinline__ const char* bptr(const Unit& u) const { return Bt + (size_t)u.e * estride + (size_t)u.pn * tstep; }
};

template <class Epi, class Sched>
__device__ __forceinline__ void gemm_phase(LAS unsigned char* lds, const int tid, const int K, const Sched& S, const Epi& E) {
    const int wid = __builtin_amdgcn_readfirstlane(tid >> 6), lane = tid & 63, wr = wid >> 2, wc = wid & 3, fr = lane & 15, fq = lane >> 4;
    const int nt = K / BK;
    unsigned voffA[2], voffB[2];
#pragma unroll
    for (int i = 0; i < 2; ++i) { int R, C; stage_rc(tid * 16 + i * 8192, R, C); const int Rb = Epi::PERM ? ((R & ~31) + perm32(R & 31)) : R;
        voffA[i] = (unsigned)(R * K + C) * 2u; voffB[i] = (unsigned)(Rb * K + C) * 2u; }
    const size_t kstep = (size_t)(BK * 2);
    const size_t hstep = (size_t)HALF * K * 2;
    const unsigned ldsw = (unsigned)wid * 1024u;
    const int aoff = lds_byte(wr * 64 + fr, fq * 8), boff = lds_byte(wc * 32 + fr, fq * 8);
#define PG8_SA(b, h) (((b) * 2 + (h)) * HTB)
#define PG8_SB(b, h) ((4 + (b) * 2 + (h)) * HTB)
#define PG8_STAGE(bufoff, gbase, voff) do { _Pragma("unroll") for (int _i = 0; _i < 2; ++_i) \
        __builtin_amdgcn_global_load_lds((const unsigned*)((const char*)(gbase) + (voff)[_i]), (LAS unsigned*)(lds + (bufoff) + ldsw + _i * 8192), 16, 0, 0); } while (0)
#define PG8_LDA(dst, b, h) do { _Pragma("unroll") for (int m = 0; m < 4; ++m) _Pragma("unroll") for (int k = 0; k < 2; ++k) dst[m][k] = *(const LAS bf16x8*)(lds + PG8_SA(b, h) + aoff + m * 2048 + k * 1024); } while (0)
#define PG8_LDB(dst, b, h) do { _Pragma("unroll") for (int n = 0; n < 2; ++n) _Pragma("unroll") for (int k = 0; k < 2; ++k) dst[n][k] = *(const LAS bf16x8*)(lds + PG8_SB(b, h) + boff + n * 2048 + k * 1024); } while (0)
#define PG8_MMA(ai, bj, At, Bt) do { __builtin_amdgcn_s_setprio(1); _Pragma("unroll") for (int m = 0; m < 4; ++m) _Pragma("unroll") for (int n = 0; n < 2; ++n) _Pragma("unroll") for (int k = 0; k < 2; ++k) \
        acc[ai][bj][m][n] = __builtin_amdgcn_mfma_f32_16x16x32_bf16(Bt[n][k], At[m][k], acc[ai][bj][m][n], 0, 0, 0); __builtin_amdgcn_s_setprio(0); } while (0)
#define PG8_WAIT_V(n) asm volatile("s_waitcnt vmcnt(" #n ")" ::: "memory")
#define PG8_WAIT_L(n) asm volatile("s_waitcnt lgkmcnt(" #n ")" ::: "memory")
#define PG8_BAR __builtin_amdgcn_s_barrier()
#define PG8_SCHED __builtin_amdgcn_sched_barrier(0)
    Unit cur, nxt; int ui = 0;
    if (!S.next(0, cur)) return;
    f32x4 acc[2][2][4][2];
#pragma unroll
    for (int a = 0; a < 2; ++a)
#pragma unroll
        for (int b = 0; b < 2; ++b)
#pragma unroll
            for (int m = 0; m < 4; ++m)
#pragma unroll
                for (int n = 0; n < 2; ++n) acc[a][b][m][n] = (f32x4){0.f, 0.f, 0.f, 0.f};
    bf16x8 At[4][2], B0[2][2], B1[2][2];
    const char* cA = S.aptr(cur); const char* cB = S.bptr(cur);
    PG8_STAGE(PG8_SB(0, 0), cB, voffB); PG8_STAGE(PG8_SB(0, 1), cB + hstep, voffB); PG8_STAGE(PG8_SA(0, 0), cA, voffA); PG8_STAGE(PG8_SA(0, 1), cA + hstep, voffA);
    if (wr == 1) PG8_BAR;
    PG8_WAIT_V(2); PG8_BAR;
    PG8_STAGE(PG8_SB(1, 0), cB + kstep, voffB); PG8_STAGE(PG8_SA(1, 0), cA + kstep, voffA); PG8_STAGE(PG8_SB(1, 1), cB + hstep + kstep, voffB);
    PG8_WAIT_V(6); PG8_BAR;
    for (;;) {
        const bool has_next = S.next(ui + 1, nxt);
        const char* nA = has_next ? S.aptr(nxt) : cA; const char* nB = has_next ? S.bptr(nxt) : cB;
        for (int t = 0; t < nt; t += 2) {
            const bool last = (t == nt - 2);
            const char* a1 = cA + (size_t)(t + 1) * kstep;
            const char* a2 = last ? nA : cA + (size_t)(t + 2) * kstep; const char* b2 = last ? nB : cB + (size_t)(t + 2) * kstep;
            const char* a3 = a2 + kstep; const char* b3 = b2 + kstep;
            PG8_LDB(B0, 0, 0); PG8_LDB(B1, 0, 1); PG8_SCHED; PG8_LDA(At, 0, 0); PG8_STAGE(PG8_SA(1, 1), a1 + hstep, voffA);
            PG8_WAIT_V(8); PG8_WAIT_L(0); PG8_BAR; PG8_MMA(0, 0, At, B0); PG8_MMA(0, 1, At, B1); PG8_BAR; PG8_SCHED;
            PG8_LDA(At, 0, 1); PG8_STAGE(PG8_SB(0, 0), b2, voffB); PG8_STAGE(PG8_SB(0, 1), b2 + hstep, voffB); PG8_STAGE(PG8_SA(0, 0), a2, voffA);
            PG8_WAIT_V(8); PG8_WAIT_L(0); PG8_BAR; PG8_MMA(1, 0, At, B0); PG8_MMA(1, 1, At, B1); PG8_BAR; PG8_SCHED;
            PG8_LDB(B0, 1, 0); PG8_LDB(B1, 1, 1); PG8_SCHED; PG8_LDA(At, 1, 0); PG8_STAGE(PG8_SA(0, 1), a2 + hstep, voffA);
            PG8_WAIT_V(8); PG8_WAIT_L(0); PG8_BAR; PG8_MMA(0, 0, At, B0); PG8_MMA(0, 1, At, B1); PG8_BAR; PG8_SCHED;
            PG8_LDA(At, 1, 1); PG8_STAGE(PG8_SB(1, 0), b3, voffB); PG8_STAGE(PG8_SB(1, 1), b3 + hstep, voffB); PG8_STAGE(PG8_SA(1, 0), a3, voffA);
            PG8_WAIT_V(8); PG8_WAIT_L(0); PG8_BAR; PG8_MMA(1, 0, At, B0); PG8_MMA(1, 1, At, B1); PG8_BAR; PG8_SCHED;
        }
        if (wr == 0) PG8_BAR;
        E(acc, cur, wr, wc, fr, fq);
        if (!has_next) break;
#pragma unroll
        for (int a = 0; a < 2; ++a)
#pragma unroll
            for (int b = 0; b < 2; ++b)
#pragma unroll
                for (int m = 0; m < 4; ++m)
#pragma unroll
                    for (int n = 0; n < 2; ++n) acc[a][b][m][n] = (f32x4){0.f, 0.f, 0.f, 0.f};
        cur = nxt; cA = nA; cB = nB; ++ui;
        if (wr == 1) PG8_BAR;
    }
    PG8_WAIT_V(0);
    PG8_BAR;
#undef PG8_SA
#undef PG8_SB
#undef PG8_STAGE
#undef PG8_LDA
#undef PG8_LDB
#undef PG8_MMA
#undef PG8_WAIT_V
#undef PG8_WAIT_L
#undef PG8_BAR
#undef PG8_SCHED
}

struct EpiBf16 {
    static constexpr bool PERM = true;
    bf16* O; int ldc; const float* bias; int bias_stride;
    __device__ __forceinline__ void operator()(const f32x4 (&acc)[2][2][4][2], const Unit& u, int wr, int wc, int fr, int fq) const {
        const int row0 = u.pm * BM + wr * 64 + fr, col0 = u.pn * BM + wc * 32 + 8 * fq;
        f32x4 bv[2][2];
#pragma unroll
        for (int bj = 0; bj < 2; ++bj)
#pragma unroll
            for (int n = 0; n < 2; ++n) bv[bj][n] = bias ? *(const f32x4*)(bias + (size_t)u.e * bias_stride + col0 + bj * HALF + 4 * n) : (f32x4){0.f, 0.f, 0.f, 0.f};
#pragma unroll
        for (int ai = 0; ai < 2; ++ai)
#pragma unroll
            for (int m = 0; m < 4; ++m) { bf16* rowp = O + (size_t)(row0 + ai * HALF + m * 16) * ldc + col0;
#pragma unroll
                for (int bj = 0; bj < 2; ++bj) { const f32x4 v0 = acc[ai][bj][m][0] + bv[bj][0], v1 = acc[ai][bj][m][1] + bv[bj][1];
                    v4u w; w.x = cvt_pk_bf16(v0[0], v0[1]); w.y = cvt_pk_bf16(v0[2], v0[3]); w.z = cvt_pk_bf16(v1[0], v1[1]); w.w = cvt_pk_bf16(v1[2], v1[3]);
                    *(v4u*)(rowp + bj * HALF) = w; } }
    }
};
template <int MODE> struct EpiGlu {
    static constexpr bool PERM = true;
    bf16* O; int ldc; const float* bias; int bias_stride, hs;
    __device__ __forceinline__ void operator()(const f32x4 (&acc)[2][2][4][2], const Unit& u, int wr, int wc, int fr, int fq) const {
        const int row0 = u.pm * BM + wr * 64 + fr, col0 = u.pn * HALF + wc * 32 + 8 * fq;
        const float* bp = bias + (size_t)u.e * bias_stride + col0;
        f32x4 ba[2], bb[2];
#pragma unroll
        for (int n = 0; n < 2; ++n) { ba[n] = *(const f32x4*)(bp + 4 * n); bb[n] = *(const f32x4*)(bp + hs + 4 * n); }
#pragma unroll
        for (int ai = 0; ai < 2; ++ai)
#pragma unroll
            for (int m = 0; m < 4; ++m) { bf16* rowp = O + (size_t)(row0 + ai * HALF + m * 16) * ldc + col0;
                float o[8];
#pragma unroll
                for (int n = 0; n < 2; ++n) { const f32x4 a = acc[ai][0][m][n] + ba[n], b = acc[ai][1][m][n] + bb[n];
#pragma unroll
                    for (int j = 0; j < 4; ++j) {
                        if (MODE == 0) o[4 * n + j] = a[j] * sigm(b[j]);
                        else { const float g = fminf(a[j], 7.f), up = fminf(fmaxf(b[j], -7.f), 7.f); o[4 * n + j] = (up + 1.f) * g * sigm(1.702f * g); } } }
                v4u w; w.x = cvt_pk_bf16(o[0], o[1]); w.y = cvt_pk_bf16(o[2], o[3]); w.z = cvt_pk_bf16(o[4], o[5]); w.w = cvt_pk_bf16(o[6], o[7]);
                *(v4u*)rowp = w; }
    }
};
struct EpiMerge {
    static constexpr bool PERM = true;
    float* mtmp; bf16* Mo; const bf16* zg;
    __device__ __forceinline__ void operator()(const f32x4 (&acc)[2][2][4][2], const Unit& u, int wr, int wc, int fr, int fq) const {
        const int row0 = u.pm * BM + wr * 64 + fr, col0 = u.pn * BM + wc * 32 + 8 * fq;
#pragma unroll
        for (int ai = 0; ai < 2; ++ai)
#pragma unroll
            for (int m = 0; m < 4; ++m) { const size_t r = (size_t)(row0 + ai * HALF + m * 16);
#pragma unroll
                for (int bj = 0; bj < 2; ++bj) { const int c = col0 + bj * HALF;
                    const v4u gz = *(const v4u*)(zg + r * IN_COLS + u.e * 1024 + c);
                    float g[8] = {bflo(gz.x), bfhi(gz.x), bflo(gz.y), bfhi(gz.y), bflo(gz.z), bfhi(gz.z), bflo(gz.w), bfhi(gz.w)};
                    f32x4 t0, t1; float* tp = mtmp + r * 1024 + c;
                    if (u.e == 0) { t0 = (f32x4){0.f, 0.f, 0.f, 0.f}; t1 = t0; } else { t0 = *(const f32x4*)tp; t1 = *(const f32x4*)(tp + 4); }
#pragma unroll
                    for (int j = 0; j < 4; ++j) { t0[j] += sigm(g[j]) * acc[ai][bj][m][0][j]; t1[j] += sigm(g[4 + j]) * acc[ai][bj][m][1][j]; }
                    if (u.e < 2) { *(f32x4*)tp = t0; *(f32x4*)(tp + 4) = t1; }
                    else { v4u w; w.x = cvt_pk_bf16(t0[0], t0[1]); w.y = cvt_pk_bf16(t0[2], t0[3]); w.z = cvt_pk_bf16(t1[0], t1[1]); w.w = cvt_pk_bf16(t1[2], t1[3]);
                        *(v4u*)(Mo + r * 1024 + c) = w; } } }
    }
};
struct EpiResid {
    static constexpr bool PERM = false;
    float* X; const float* gmod;
    __device__ __forceinline__ void operator()(const f32x4 (&acc)[2][2][4][2], const Unit& u, int wr, int wc, int fr, int fq) const {
        const int row0 = u.pm * BM + wr * 64 + fr, col0 = u.pn * BM + wc * 32 + 4 * fq;
        const int r00 = u.pm * BM; const int w = r00 < T_LAT ? (r00 >> 12) : 8;
        f32x4 gv[2][2];
#pragma unroll
        for (int bj = 0; bj < 2; ++bj)
#pragma unroll
            for (int n = 0; n < 2; ++n) gv[bj][n] = *(const f32x4*)(gmod + (size_t)w * 6144 + col0 + bj * HALF + n * 16);
#pragma unroll
        for (int ai = 0; ai < 2; ++ai)
#pragma unroll
            for (int m = 0; m < 4; ++m) { float* rowp = X + (size_t)(row0 + ai * HALF + m * 16) * 1024 + col0;
#pragma unroll
                for (int bj = 0; bj < 2; ++bj)
#pragma unroll
                    for (int n = 0; n < 2; ++n) { f32x4* p = (f32x4*)(rowp + bj * HALF + n * 16); *p = *p + gv[bj][n] * acc[ai][bj][m][n]; } }
    }
};
}

struct Args { const float* in[51]; float* out; unsigned char* ws; int ph_lo, ph_hi; };
enum { I_X = 0, I_C, I_CTX, I_CCTX, I_ADAW, I_ADAB, I_N1G, I_N2G, I_WIN, I_HYCW, I_HYCB, I_HYW1, I_HYB1, I_HYF1, I_HYW2, I_HYB2, I_HYF2, I_HYW3, I_HYB3, I_HYBIAS,
       I_RWCW, I_RWCB, I_RWWUP, I_RWW0, I_RWAUP, I_RWA0, I_RWGUP, I_RWKK, I_RWKA, I_RWRK, I_RWLNG, I_RWLNB, I_S5ARE, I_S5AIM, I_S5LDT, I_S5BRE, I_S5BIM, I_S5CRE, I_S5CIM, I_S5D,
       I_S5GLUW, I_S5GLUB, I_WBR, I_WOUT, I_RTW, I_RTB, I_W1, I_B1, I_W2, I_B2, I_FING };

typedef const __attribute__((address_space(4))) Args* CArgsP;
__device__ __forceinline__ CArgsP kargs() { CArgsP p = (CArgsP)__builtin_amdgcn_kernarg_segment_ptr(); asm volatile("" : "+s"(p)); return p; }
__device__ __forceinline__ int opaque(int v) { asm volatile("" : "+s"(v)); return v; }
__device__ __forceinline__ int opaque_v(int v) { asm volatile("" : "+v"(v)); return v; }
struct Ctx { CArgsP a; LAS unsigned char* lds; int tid, lane, wave, bid, G; };

__device__ __forceinline__ void row_seq(int row, int& base, int& pos, int& n) {
    if (row < T_LAT) { base = row & ~(SEQ - 1); pos = row & (SEQ - 1); n = SEQ; }
    else { const int r = row - T_LAT; base = T_LAT + (r & ~(CTXL - 1)); pos = r & (CTXL - 1); n = CTXL; }
}
__device__ __forceinline__ float conv3z(const bf16* zc, int pos, int n, float w0, float w1, float w2, float b) {
    const float zm = pos > 0 ? bf2f(zc[(size_t)(pos - 1) * IN_COLS]) : 0.f, z0 = bf2f(zc[(size_t)pos * IN_COLS]), zp = pos < n - 1 ? bf2f(zc[(size_t)(pos + 1) * IN_COLS]) : 0.f;
    return zm * w0 + z0 * w1 + zp * w2 + b;
}

template <int MODE>
__device__ __forceinline__ void transpose_item(const float* W, int K, int N, bf16* WT, int Hs, LAS float* scr, int item, int lane) {
    const int nblk = N / 32, kb = item / nblk, nb = item % nblk, k0 = 64 * kb, n0 = 32 * nb;
#pragma unroll 8
    for (int i = 0; i < 32; ++i) { const int kk = 2 * i + (lane >> 5); scr[kk * 33 + (lane & 31)] = W[(size_t)(k0 + kk) * N + n0 + (lane & 31)]; }
    LDS_WAIT(); asm volatile("" ::: "memory");
    const int c = lane & 7;
#pragma unroll
    for (int j = 0; j < 4; ++j) { const int n = (lane >> 3) + 8 * j; const LAS float* s = scr + (8 * c) * 33 + n;
        v4u o; o.x = pk2(s[0 * 33], s[1 * 33]); o.y = pk2(s[2 * 33], s[3 * 33]); o.z = pk2(s[4 * 33], s[5 * 33]); o.w = pk2(s[6 * 33], s[7 * 33]);
        int dr = n0 + n;
        if (MODE == 1) { const int nc = n0 + n; const int jx = nc < Hs ? nc : nc - Hs; dr = (jx >> 7) * 256 + (nc < Hs ? 0 : 128) + (jx & 127); }
        *(v4u*)(WT + (size_t)dr * K + k0 + 8 * c) = o; }
    LDS_WAIT(); asm volatile("" ::: "memory");
}

__device__ __forceinline__ void p0_prologue(const Ctx& F) {
    const auto& a = *F.a; unsigned char* ws = a.ws;
    const int gw = F.bid * NWAVES + F.wave, NGW = F.G * NWAVES, lane = F.lane;
    float* X = (float*)(ws + WS_X);
    for (int row = gw; row < T_ALL; row += NGW) {
        f32x4* xo = (f32x4*)(X + (size_t)row * D) + lane;
        if (row < T_LAT) {
            const f32x4* xi = (const f32x4*)(a.in[I_X] + (size_t)row * D) + lane;
            const int t = row & (SEQ - 1); const float pr = (float)(t >> 6), pc = (float)(t & 63);
#pragma unroll
            for (int j = 0; j < 4; ++j) { f32x4 v = xi[64 * j];
#pragma unroll
                for (int e = 0; e < 4; ++e) { const float om = 1.0f / powf(10000.0f, (float)(4 * lane + e) / 256.0f); const float ang = ((j < 2) ? pr : pc) * om; v[e] += (j & 1) ? cosf(ang) : sinf(ang); }
                xo[64 * j] = v; }
        } else {
            const f32x4* xi = (const f32x4*)(a.in[I_CTX] + (size_t)(row - T_LAT) * D) + lane;
#pragma unroll
            for (int j = 0; j < 4; ++j) xo[64 * j] = xi[64 * j];
        }
    }
    {
        LAS float* condl = (LAS float*)F.lds; LAS float* psum = (LAS float*)(F.lds + 40960);
        for (int i = F.tid; i < 9 * 1024; i += NTHREADS) { const int w = i >> 10, k = i & 1023; const float cv = (w < 8) ? a.in[I_C][w * 1024 + k] : a.in[I_CCTX][k]; condl[i] = cv / (1.f + expf(-cv)); }
        __syncthreads();
        float* MOD = (float*)(ws + WS_MOD);
        for (int it = F.bid; it < 2 * 96; it += F.G) {
            const int l = it / 96, cg = it % 96, col = cg * 64 + lane;
            float acc[9];
#pragma unroll
            for (int w = 0; w < 9; ++w) acc[w] = 0.f;
            const float* wp = a.in[I_ADAW] + ((size_t)l * 1024 + F.wave * 128) * 6144 + col;
            for (int k = 0; k < 128; ++k) { const float wv = wp[(size_t)k * 6144];
#pragma unroll
                for (int w = 0; w < 9; ++w) acc[w] += condl[w * 1024 + F.wave * 128 + k] * wv; }
#pragma unroll
            for (int w = 0; w < 9; ++w) psum[(F.wave * 9 + w) * 64 + lane] = acc[w];
            __syncthreads();
            if (F.wave == 0) {
#pragma unroll
                for (int w = 0; w < 9; ++w) { float s = 0.f;
#pragma unroll
                    for (int wv = 0; wv < 8; ++wv) s += psum[(wv * 9 + w) * 64 + lane];
                    MOD[(size_t)(l * 9 + w) * 6144 + col] = s + a.in[I_ADAB][l * 6144 + col]; }
            }
            __syncthreads();
        }
    }
    {
        LAS float* scr = (LAS float*)(F.lds + F.wave * 16384);
        constexpr int IT_W1 = 16 * 64, IT_W2 = 16 * 32, IT_WIN = 16 * 216, IT_GLU = 8 * 32, IT_WBR = 8 * 32, IT_WOUT = 16 * 32;
        constexpr int N_W1 = 64 * IT_W1, N_W2 = 64 * IT_W2, N_WIN = 2 * IT_WIN, N_GLU = 2 * IT_GLU, N_WBR = 6 * IT_WBR, N_WOUT = 2 * IT_WOUT;
        constexpr int NITEMS = N_W1 + N_W2 + N_WIN + N_GLU + N_WBR + N_WOUT;
        for (int it = gw; it < NITEMS; it += NGW) {
            int r = it;
            if (r < N_W1) { const int mtx = r / IT_W1, l = mtx >> 5, e = mtx & 31; transpose_item<1>(a.in[I_W1] + (size_t)mtx * 1024 * 2048, 1024, 2048, (bf16*)(ws + WS_WTS + l * WL_STRIDE + WO_W1) + (size_t)e * 2048 * 1024, 1024, scr, r % IT_W1, lane); continue; } r -= N_W1;
            if (r < N_W2) { const int mtx = r / IT_W2, l = mtx >> 5, e = mtx & 31; transpose_item<0>(a.in[I_W2] + (size_t)mtx * 1024 * 1024, 1024, 1024, (bf16*)(ws + WS_WTS + l * WL_STRIDE + WO_W2) + (size_t)e * 1024 * 1024, 0, scr, r % IT_W2, lane); continue; } r -= N_W2;
            if (r < N_WIN) { const int l = r / IT_WIN; transpose_item<0>(a.in[I_WIN] + (size_t)l * 1024 * IN_COLS, 1024, IN_COLS, (bf16*)(ws + WS_WTS + l * WL_STRIDE + WO_WIN), 0, scr, r % IT_WIN, lane); continue; } r -= N_WIN;
            if (r < N_GLU) { const int l = r / IT_GLU; transpose_item<1>(a.in[I_S5GLUW] + (size_t)l * 512 * 1024, 512, 1024, (bf16*)(ws + WS_WTS + l * WL_STRIDE + WO_GLU), 512, scr, r % IT_GLU, lane); continue; } r -= N_GLU;
            if (r < N_WBR) { const int mtx = r / IT_WBR, l = mtx / 3, br = mtx % 3; transpose_item<0>(a.in[I_WBR] + (size_t)mtx * 512 * 1024, 512, 1024, (bf16*)(ws + WS_WTS + l * WL_STRIDE + WO_WBR) + (size_t)br * 1024 * 512, 0, scr, r % IT_WBR, lane); continue; } r -= N_WBR;
            { const int l = r / IT_WOUT; transpose_item<0>(a.in[I_WOUT] + (size_t)l * 1024 * 1024, 1024, 1024, (bf16*)(ws + WS_WTS + l * WL_STRIDE + WO_WOUT), 0, scr, r % IT_WOUT, lane); }
        }
        for (int i = F.bid * NTHREADS + F.tid; i < 2 * 2560 * 256; i += F.G * NTHREADS) {
            const int l = i / (2560 * 256), r = i % (2560 * 256), n = r >> 8, k = r & 255; float v = 0.f;
            if (n < 1024) { if (k < 64) v = a.in[I_RWWUP][(((size_t)l * 2 + (n >> 9)) * 64 + k) * 512 + (n & 511)]; }
            else if (n < 2048) { if (k >= 64 && k < 128) v = a.in[I_RWAUP][(((size_t)l * 2 + ((n - 1024) >> 9)) * 64 + (k - 64)) * 512 + (n & 511)]; }
            else { if (k >= 128) v = a.in[I_RWGUP][((size_t)l * 128 + (k - 128)) * 512 + (n - 2048)]; }
            ((bf16*)(ws + WS_WTS + l * WL_STRIDE + WO_RWCAT))[r] = (bf16)f2bf(v);
        }
    }
    __syncthreads();
    {
        LAS float* feats = (LAS float*)F.lds; LAS float* h1 = feats + 8 * 33; LAS float* h2 = h1 + 8 * 64;
        constexpr int NIT = 2 * (512 + 32);
        for (int it = F.bid; it < NIT; it += F.G) {
            const int l = it / 544, r = it % 544, nsel = r >= 512, n = nsel ? CTXL : SEQ, p0 = (nsel ? r - 512 : r) * 8;
            if (F.tid < 8 * 33) { const int p = F.tid / 33, i = F.tid % 33, pos = p0 + p; float f;
                if (i == 0) f = (float)pos / (float)(n - 1);
                else { const int k = (i - 1) & 15; const float band = 1e-4f + (float)k * ((15.0f - 1e-4f) / 15.0f); const float ang = (6.283185307179586f * (float)pos / (float)n) * band; f = (i <= 16) ? cosf(ang) : -sinf(ang); }
                feats[p * 33 + i] = f; }
            __syncthreads();
            { const int p = F.tid >> 6, j = F.tid & 63; float s = a.in[I_HYB1][l * 64 + j];
                for (int i = 0; i < 33; ++i) s += feats[p * 33 + i] * a.in[I_HYW1][((size_t)l * 33 + i) * 64 + j];
                h1[p * 64 + j] = sinf(a.in[I_HYF1][l * 64 + j] * s); }
            __syncthreads();
            { const int p = F.tid >> 6, j = F.tid & 63; float s = a.in[I_HYB2][l * 64 + j];
                for (int i = 0; i < 64; ++i) s += h1[p * 64 + i] * a.in[I_HYW2][((size_t)l * 64 + i) * 64 + j];
                h2[p * 64 + j] = sinf(a.in[I_HYF2][l * 64 + j] * s); }
            __syncthreads();
            float acc[4][8];
#pragma unroll
            for (int q = 0; q < 4; ++q)
#pragma unroll
                for (int p = 0; p < 8; ++p) acc[q][p] = 0.f;
            const float* w3 = a.in[I_HYW3] + (size_t)l * 64 * 2048 + F.tid;
            for (int i = 0; i < 64; ++i) { float wv[4];
#pragma unroll
                for (int q = 0; q < 4; ++q) wv[q] = w3[(size_t)i * 2048 + q * 512];
#pragma unroll
                for (int p = 0; p < 8; ++p) { const float hv = h2[p * 64 + i];
#pragma unroll
                    for (int q = 0; q < 4; ++q) acc[q][p] += hv * wv[q]; } }
            const int c = F.tid; const float dstart = logf(0.01f) / 1.5f, dstop = logf(0.01f) / 0.3f; const float delta = fabsf(dstart + (float)c * ((dstop - dstart) / 511.0f));
            float* Gb = (float*)(ws + WS_GF + l * GF_STRIDE + (nsel ? GF_CTX : 0)); const int NQ = nsel ? 512 : 8192;
#pragma unroll
            for (int q = 0; q < 4; ++q) { const int o = q >> 1, side = q & 1; const float b3 = a.in[I_HYB3][l * 2048 + q * 512 + c];
#pragma unroll
                for (int p = 0; p < 8; ++p) { const int pos = p0 + p; const float t = (float)pos / (float)(n - 1); const float val = (acc[q][p] + b3) * expf(-t * delta);
                    if (side == 0) Gb[((size_t)o * NQ + (pos + n - 1)) * 512 + c] = val;
                    else if (pos >= 1) Gb[((size_t)o * NQ + (n - 1 - pos)) * 512 + c] = val; } }
            __syncthreads();
        }
    }
}

__device__ __forceinline__ void stage_norm1(const Ctx& F, int l) {
    const auto& a = *F.a; unsigned char* ws = a.ws; const int lane = F.lane;
    const int gw = F.bid * NWAVES + F.wave, NGW = F.G * NWAVES;
    float* X = (float*)(ws + WS_X); bf16* H = (bf16*)(ws + WS_H); const float* MOD = (const float*)(ws + WS_MOD);
    const bf16* YS = (const bf16*)(ws + WS_XS); const int* POS = (const int*)(ws + WS_POS); const float* GATE = (const float*)(ws + WS_GATE);
    const int nrows = (l == DEPTH) ? T_LAT : T_ALL;
    for (int row = gw; row < nrows; row += NGW) {
        const int w = row < T_LAT ? (row >> 12) : 8;
        f32x4* xr = (f32x4*)(X + (size_t)row * D) + lane;
        f32x4 v[4];
#pragma unroll
        for (int j = 0; j < 4; ++j) v[j] = xr[64 * j];
        if (l > 0) {
            f32x4 mo[4];
#pragma unroll
            for (int j = 0; j < 4; ++j) mo[j] = (f32x4){0.f, 0.f, 0.f, 0.f};
#pragma unroll
            for (int k = 0; k < TOPK; ++k) { const int p = POS[row * 4 + k]; const float g = GATE[row * 4 + k];
                const v2u* yr = (const v2u*)(YS + (size_t)p * D) + lane;
#pragma unroll
                for (int j = 0; j < 4; ++j) { const v2u y = yr[64 * j]; mo[j][0] += g * bflo(y.x); mo[j][1] += g * bfhi(y.x); mo[j][2] += g * bflo(y.y); mo[j][3] += g * bfhi(y.y); } }
            const f32x4* g2 = (const f32x4*)(MOD + (size_t)((l - 1) * 9 + w) * 6144 + 5120) + lane;
#pragma unroll
            for (int j = 0; j < 4; ++j) { v[j] = v[j] + g2[64 * j] * mo[j]; xr[64 * j] = v[j]; }
        }
        float ss = 0.f;
#pragma unroll
        for (int j = 0; j < 4; ++j) ss += (v[j][0] * v[j][0] + v[j][1] * v[j][1]) + (v[j][2] * v[j][2] + v[j][3] * v[j][3]);
        const float rstd = 1.0f / sqrtf(wave_sum(ss) * (1.f / D) + 1e-6f);
        if (l == DEPTH) {
            const f32x4* fg = (const f32x4*)a.in[I_FING] + lane; f32x4* o = (f32x4*)(a.out + (size_t)row * D) + lane;
#pragma unroll
            for (int j = 0; j < 4; ++j) o[64 * j] = v[j] * rstd * fg[64 * j];
        } else {
            const f32x4* ng = (const f32x4*)(a.in[I_N1G] + l * D) + lane;
            const f32x4* sh = (const f32x4*)(MOD + (size_t)(l * 9 + w) * 6144) + lane; const f32x4* sc = (const f32x4*)(MOD + (size_t)(l * 9 + w) * 6144 + 1024) + lane;
            v2u* ho = (v2u*)(H + (size_t)row * D) + lane;
#pragma unroll
            for (int j = 0; j < 4; ++j) { const f32x4 h = v[j] * rstd * ng[64 * j] * (sc[64 * j] + 1.0f) + sh[64 * j]; v2u o; o.x = pk2(h[0], h[1]); o.y = pk2(h[2], h[3]); ho[64 * j] = o; }
        }
    }
}

__device__ __forceinline__ void stage_rw_prep1(const Ctx& F, int l) {
    const auto& a = *F.a; unsigned char* ws = a.ws;
    const bf16* Z = (const bf16*)(ws + WS_Z); bf16* ARW = (bf16*)(ws + WS_ARW);
    const int j = F.tid & 255, col = 1536 + j;
    const float* cw = a.in[I_RWCW] + (size_t)l * 3 * 1792; const float w0 = cw[col], w1 = cw[1792 + col], w2 = cw[2 * 1792 + col], cb = a.in[I_RWCB][l * 1792 + col];
    for (int row = F.bid * 2 + (F.tid >> 8); row < T_ALL; row += F.G * 2) {
        int base, pos, n; row_seq(row, base, pos, n);
        float v = conv3z(Z + (size_t)base * IN_COLS + RW_OFF + col, pos, n, w0, w1, w2, cb);
        if (j < 64) v = tanhf(v); else if (j >= 128) v = sigm(v);
        ARW[(size_t)row * 256 + j] = (bf16)f2bf(v);
    }
}

__device__ __forceinline__ void stage_rw_prep2(const Ctx& F, int l) {
    const auto& a = *F.a; unsigned char* ws = a.ws; const int lane = F.lane;
    const bf16* Z = (const bf16*)(ws + WS_Z); const bf16* P = (const bf16*)(ws + WS_P); bf16* SCN = (bf16*)(ws + WS_SCN);
    const int gw = F.bid * NWAVES + F.wave, NGW = F.G * NWAVES;
    const float* cw = a.in[I_RWCW] + (size_t)l * 3 * 1792; const float* cbp = a.in[I_RWCB] + l * 1792;
    for (int it = gw; it < T_ALL * 8; it += NGW) {
        const int row = it >> 3, h = it & 7, c = h * 64 + lane;
        int base, pos, n; row_seq(row, base, pos, n);
        const bf16* zb = Z + (size_t)base * IN_COLS + RW_OFF;
        const float r = conv3z(zb + c, pos, n, cw[c], cw[1792 + c], cw[2 * 1792 + c], cbp[c]);
        const float k = conv3z(zb + 512 + c, pos, n, cw[512 + c], cw[1792 + 512 + c], cw[2 * 1792 + 512 + c], cbp[512 + c]);
        const float v = conv3z(zb + 1024 + c, pos, n, cw[1024 + c], cw[1792 + 1024 + c], cw[2 * 1792 + 1024 + c], cbp[1024 + c]);
        float kk = k * a.in[I_RWKK][l * 512 + c];
        const float ss = wave_sum(kk * kk);
        kk = kk * (1.0f / sqrtf(fmaxf(ss, 1e-24f)));
        const bf16* pr = P + (size_t)row * 2560;
        const float ka = a.in[I_RWKA][l * 512 + c];
        bf16* o = SCN + (size_t)row * 9 * 512 + c;
        o[0] = (bf16)f2bf(r); o[512] = (bf16)f2bf(v); o[2 * 512] = (bf16)f2bf(kk);
#pragma unroll
        for (int d = 0; d < 2; ++d) {
            const float u = a.in[I_RWW0][(l * 2 + d) * 512 + c] + bf2f(pr[d * 512 + c]);
            const float sp = fmaxf(-u, 0.f) + log1pf(expf(-fabsf(u)));
            const float w = -sp - 0.5f;
            const float ld = -expf(w);
            const float av = sigm(a.in[I_RWA0][(l * 2 + d) * 512 + c] + bf2f(pr[1024 + d * 512 + c]));
            const float kd = k * (1.f + (av - 1.f) * ka);
            o[(3 + 3 * d) * 512] = (bf16)f2bf(ld); o[(4 + 3 * d) * 512] = (bf16)f2bf(kd); o[(5 + 3 * d) * 512] = (bf16)f2bf(kk * av);
        }
    }
}

__device__ __forceinline__ int seq_row(int b, int d, int sidx) {
    if (sidx < CTXL) { const int t = d ? (CTXL - 1 - sidx) : sidx; return T_LAT + b * CTXL + t; }
    const int tl = sidx - CTXL; const int t = d ? (SEQ - 1 - tl) : tl; return b * SEQ + t;
}

__device__ __forceinline__ void stage_rw_scan(const Ctx& F, int l) {
    const auto& a = *F.a; unsigned char* ws = a.ws; const int lane = F.lane;
    const bf16* SCN = (const bf16*)(ws + WS_SCN); float* YD = (float*)(ws + WS_YDIR);
    if (F.wave != 0) return;
    LAS float* buf = (LAS float*)F.lds;
    for (int it = F.bid; it < BATCH * 8 * 2; it += F.G) {
        const int d = it & 1, h = (it >> 1) & 7, b = it >> 4;
        float S[64];
#pragma unroll
        for (int k = 0; k < 64; ++k) S[k] = 0.f;
        for (int s0 = 0; s0 < CTXL + SEQ; s0 += 8) {
#pragma unroll
            for (int s = 0; s < 8; ++s) {
                const int row = seq_row(b, d, s0 + s); const bf16* p = SCN + (size_t)row * 9 * 512 + h * 64 + lane;
                buf[(s * 6 + 0) * 64 + lane] = -bf2f(p[2 * 512]);
                buf[(s * 6 + 1) * 64 + lane] = expf(bf2f(p[(3 + 3 * d) * 512]));
                buf[(s * 6 + 2) * 64 + lane] = bf2f(p[(5 + 3 * d) * 512]);
                buf[(s * 6 + 3) * 64 + lane] = bf2f(p[(4 + 3 * d) * 512]);
                buf[(s * 6 + 4) * 64 + lane] = bf2f(p[0]);
                buf[(s * 6 + 5) * 64 + lane] = bf2f(p[512]);
            }
            LDS_WAIT(); asm volatile("" ::: "memory");
#pragma unroll 1
            for (int s = 0; s < 8; ++s) {
                const LAS f32x4* al = (const LAS f32x4*)(buf + (s * 6 + 0) * 64); const LAS f32x4* dc = (const LAS f32x4*)(buf + (s * 6 + 1) * 64);
                const LAS f32x4* be = (const LAS f32x4*)(buf + (s * 6 + 2) * 64); const LAS f32x4* kd = (const LAS f32x4*)(buf + (s * 6 + 3) * 64);
                const LAS f32x4* rr = (const LAS f32x4*)(buf + (s * 6 + 4) * 64); const float vv = buf[(s * 6 + 5) * 64 + lane];
                float sa = 0.f;
#pragma unroll
                for (int q = 0; q < 16; ++q) { const f32x4 x = al[q]; sa += S[4 * q] * x[0] + S[4 * q + 1] * x[1] + S[4 * q + 2] * x[2] + S[4 * q + 3] * x[3]; }
                float y = 0.f;
                asm volatile("" : "+v"(sa) :: "memory");
#pragma unroll
                for (int q = 0; q < 16; ++q) { const f32x4 w = dc[q], bq = be[q], kq = kd[q], rq = rr[q];
#pragma unroll
                    for (int j = 0; j < 4; ++j) { const float sn = S[4 * q + j] * w[j] + sa * bq[j] + vv * kq[j]; S[4 * q + j] = sn; y += sn * rq[j]; }
                    if ((q & 3) == 3) { constexpr int dummy = 0; (void)dummy;
                        asm volatile("" : "+v"(S[4 * q - 12]), "+v"(S[4 * q - 11]), "+v"(S[4 * q - 10]), "+v"(S[4 * q - 9]), "+v"(S[4 * q - 8]), "+v"(S[4 * q - 7]), "+v"(S[4 * q - 6]), "+v"(S[4 * q - 5]),
                                          "+v"(S[4 * q - 4]), "+v"(S[4 * q - 3]), "+v"(S[4 * q - 2]), "+v"(S[4 * q - 1]), "+v"(S[4 * q]), "+v"(S[4 * q + 1]), "+v"(S[4 * q + 2]), "+v"(S[4 * q + 3]), "+v"(y) :: "memory"); } }
                const int row = seq_row(b, d, s0 + s);
                YD[((size_t)d * T_ALL + row) * 512 + h * 64 + lane] = y;
            }
            asm volatile("" ::: "memory");
        }
    }
}

__device__ __forceinline__ void stage_rw_readout(const Ctx& F, int l) {
    const auto& a = *F.a; unsigned char* ws = a.ws; const int lane = F.lane;
    const bf16* SCN = (const bf16*)(ws + WS_SCN); const bf16* P = (const bf16*)(ws + WS_P); const float* YD = (const float*)(ws + WS_YDIR); bf16* YRW = (bf16*)(ws + WS_YRW);
    const int gw = F.bid * NWAVES + F.wave, NGW = F.G * NWAVES;
    for (int it = gw; it < T_ALL * 8; it += NGW) {
        const int row = it >> 3, h = it & 7, c = h * 64 + lane;
        const bf16* p = SCN + (size_t)row * 9 * 512 + c;
        const float r = bf2f(p[0]), v = bf2f(p[512]), kd0 = bf2f(p[4 * 512]), kd1 = bf2f(p[7 * 512]);
        const float bon = wave_sum(r * (kd0 + kd1) * a.in[I_RWRK][l * 512 + c]);
        float y = YD[(size_t)row * 512 + c] + YD[((size_t)T_ALL + row) * 512 + c] + bon * v;
        const float mu = wave_sum(y) * (1.f / 64.f); const float dv = y - mu; const float var = wave_sum(dv * dv) * (1.f / 64.f);
        const float yn = dv * (1.0f / sqrtf(var + 64e-5f));
        const float g = bf2f(P[(size_t)row * 2560 + 2048 + c]);
        YRW[(size_t)row * 512 + c] = (bf16)f2bf((yn * a.in[I_RWLNG][l * 512 + c] + a.in[I_RWLNB][l * 512 + c]) * g);
    }
}

__device__ __forceinline__ void stage_s5_scan(const Ctx& F, int l) {
    const auto& a = *F.a; unsigned char* ws = a.ws; const int lane = F.lane;
    const bf16* Z = (const bf16*)(ws + WS_Z); float* YP = (float*)(ws + WS_YP);
    LAS float* wl = (LAS float*)(F.lds + F.wave * 16384);
    LAS float* cbuf = wl;
    LAS float* hbuf = wl + 2048;
    LAS float* ubuf = wl + 2048 + 1040;
    for (int it = F.wave * F.G + F.bid; it < BATCH * 32 * 2; it += NWAVES * F.G) {
        const int d = it & 1, g = (it >> 1) & 31, b = it >> 6, p = lane;
        const size_t gi = ((size_t)(l * 2 + d) * 32 + g) * 64 + p;
        const float are = a.in[I_S5ARE][gi], aim = a.in[I_S5AIM][gi], dt = expf(a.in[I_S5LDT][(l * 2 + d) * 32 + g]);
        const float mag = expf(are * dt), lbr = mag * cosf(aim * dt), lbi = mag * sinf(aim * dt);
        const float den = are * are + aim * aim, nr = lbr - 1.0f, cr = (nr * are + lbi * aim) / den, ci = (lbi * are - nr * aim) / den;
        float bbr[16], bbi[16];
        { const float* br = a.in[I_S5BRE] + (((size_t)l * 32 + g) * 64 + p) * 16; const float* bi = a.in[I_S5BIM] + (((size_t)l * 32 + g) * 64 + p) * 16;
#pragma unroll
          for (int h = 0; h < 16; ++h) { const float x = br[h], y = bi[h]; bbr[h] = cr * x - ci * y; bbi[h] = cr * y + ci * x; } }
#pragma unroll
        for (int h = 0; h < 16; ++h) { const size_t ci2 = (((size_t)l * 32 + g) * 16 + h) * 64 + p; cbuf[(p * 16 + h) * 2] = a.in[I_S5CRE][ci2]; cbuf[(p * 16 + h) * 2 + 1] = a.in[I_S5CIM][ci2]; }
        float hr = 0.f, hi = 0.f;
        for (int s0 = 0; s0 < CTXL + SEQ; s0 += 8) {
            if (lane < 16) { const int s = lane >> 1, half = lane & 1; const int row = seq_row(b, d, s0 + s);
                const v4u uu = *(const v4u*)(Z + (size_t)row * IN_COLS + S5_OFF + g * 16 + half * 8);
                LAS float* up = ubuf + s * 16 + half * 8;
                up[0] = bflo(uu.x); up[1] = bfhi(uu.x); up[2] = bflo(uu.y); up[3] = bfhi(uu.y); up[4] = bflo(uu.z); up[5] = bfhi(uu.z); up[6] = bflo(uu.w); up[7] = bfhi(uu.w); }
            LDS_WAIT(); asm volatile("" ::: "memory");
#pragma unroll 4
            for (int s = 0; s < 8; ++s) {
                float br_ = 0.f, bi_ = 0.f;
#pragma unroll
                for (int q = 0; q < 4; ++q) { const f32x4 u4 = *(const LAS f32x4*)(ubuf + s * 16 + 4 * q);
#pragma unroll
                    for (int j = 0; j < 4; ++j) { br_ += u4[j] * bbr[4 * q + j]; bi_ += u4[j] * bbi[4 * q + j]; } }
                const float nhr = lbr * hr - lbi * hi + br_, nhi = lbr * hi + lbi * hr + bi_;
                hr = nhr; hi = nhi;
                *(LAS f32x2*)(hbuf + s * 130 + 2 * p) = (f32x2){hr, hi};
            }
            LDS_WAIT(); asm volatile("" ::: "memory");
            { const int s = lane >> 3, hq = lane & 7;
              float acc0 = 0.f, acc1 = 0.f;
#pragma unroll 8
              for (int pp = 0; pp < 64; ++pp) { const f32x2 hv = *(const LAS f32x2*)(hbuf + s * 130 + 2 * pp);
                  const f32x4 c0 = *(const LAS f32x4*)(cbuf + (pp * 16 + 2 * hq) * 2);
                  acc0 += hv.x * c0[0] - hv.y * c0[1]; acc1 += hv.x * c0[2] - hv.y * c0[3]; }
              const int row = seq_row(b, d, s0 + s);
              *(f32x2*)(YP + ((size_t)d * T_ALL + row) * 512 + g * 16 + 2 * hq) = (f32x2){acc0, acc1}; }
            LDS_WAIT(); asm volatile("" ::: "memory");
        }
    }
}

__device__ __forceinline__ void stage_s5_prep(const Ctx& F, int l) {
    const auto& a = *F.a; unsigned char* ws = a.ws;
    const bf16* Z = (const bf16*)(ws + WS_Z); const float* YP = (const float*)(ws + WS_YP); bf16* AS5 = (bf16*)(ws + WS_AS5);
    const float dsk = a.in[I_S5D][l * 512 + F.tid];
    for (int row = F.bid; row < T_ALL; row += F.G) {
        const int c = F.tid;
        const float u = bf2f(Z[(size_t)row * IN_COLS + S5_OFF + c]);
        const float y = YP[(size_t)row * 512 + c] + YP[((size_t)T_ALL + row) * 512 + c] + u * dsk;
        const float ge = 0.5f * y * (1.f + tanhf(0.7978845608028654f * (y + 0.044715f * y * y * y)));
        AS5[(size_t)row * 512 + c] = (bf16)f2bf(ge);
    }
}

template <int CONV>
__device__ __forceinline__ void stage_hyena(const Ctx& F, int l) {
    const auto& a = *F.a; unsigned char* ws = a.ws; const int lane = F.lane;
    const bf16* Z = (const bf16*)(ws + WS_Z); float* Y1 = (float*)(ws + WS_Y1); bf16* YHY = (bf16*)(ws + WS_YHY);
    const float* cw = a.in[I_HYCW] + (size_t)l * 3 * 1536; const float* cbp = a.in[I_HYCB] + l * 1536;
    constexpr int N_LAT = BATCH * 8 * 32, N_CTXI = BATCH * 8 * 2;
    for (int it = F.bid; it < N_LAT + N_CTXI; it += F.G) {
        int b, cg, tile, n, base; const float* Gp;
        if (it < N_LAT) { tile = it & 31; cg = (it >> 5) & 7; b = it >> 8; n = SEQ; base = b * SEQ; Gp = (const float*)(ws + WS_GF + l * GF_STRIDE) + (size_t)CONV * 8192 * 512; }
        else { const int r = it - N_LAT; tile = r & 1; cg = (r >> 1) & 7; b = r >> 4; n = CTXL; base = T_LAT + b * CTXL; Gp = (const float*)(ws + WS_GF + l * GF_STRIDE + GF_CTX) + (size_t)CONV * 512 * 512; }
        const int c = cg * 64 + lane, t0 = tile * 128 + F.wave * 16;
        Gp += c;
        const bf16* zv = Z + (size_t)base * IN_COLS + HY_OFF + 1024 + c;
        const float* yin = Y1 + (size_t)base * 512 + c;
        const float vw0 = cw[1024 + c], vw1 = cw[1536 + 1024 + c], vw2 = cw[2 * 1536 + 1024 + c], vb = cbp[1024 + c];
        float acc[16], r[16];
#pragma unroll
        for (int i = 0; i < 16; ++i) acc[i] = 0.f;
        const int Q0 = t0 + n - 1;
#pragma unroll
        for (int m = 0; m < 16; ++m) r[m] = Gp[(size_t)(Q0 + m) * 512];
        float zprev = 0.f, zcur = (CONV == 0) ? bf2f(zv[0]) : 0.f;
        for (int s0 = 0; s0 < n; s0 += 16) {
            float gl[16], xin[16];
#pragma unroll
            for (int j = 0; j < 16; ++j) gl[j] = Gp[(size_t)(Q0 - s0 - j) * 512];
#pragma unroll
            for (int j = 0; j < 16; ++j) {
                if (CONV == 0) xin[j] = (s0 + j + 1 < n) ? bf2f(zv[(size_t)(s0 + j + 1) * IN_COLS]) : 0.f;
                else xin[j] = yin[(size_t)(s0 + j) * 512];
            }
#pragma unroll
            for (int j = 0; j < 16; ++j) {
                r[(16 - j) & 15] = gl[j];
                float v;
                if (CONV == 0) { const float zp = xin[j]; v = vw0 * zprev + vw1 * zcur + vw2 * zp + vb; zprev = zcur; zcur = zp; }
                else v = xin[j];
#pragma unroll
                for (int i = 0; i < 16; ++i) acc[i] += r[(i - j) & 15] * v;
            }
        }
        if (CONV == 0) {
            const float xw0 = cw[c], xw1 = cw[1536 + c], xw2 = cw[2 * 1536 + c], xb = cbp[c], bias0 = a.in[I_HYBIAS][(l * 2 + 0) * 512 + c];
            const bf16* zx = Z + (size_t)base * IN_COLS + HY_OFF + c;
#pragma unroll
            for (int i = 0; i < 16; ++i) { const int t = t0 + i; const float x1 = conv3z(zx, t, n, xw0, xw1, xw2, xb), vt = conv3z(zv, t, n, vw0, vw1, vw2, vb);
                Y1[(size_t)(base + t) * 512 + c] = x1 * (acc[i] + bias0 * vt); }
        } else {
            const float xw0 = cw[512 + c], xw1 = cw[1536 + 512 + c], xw2 = cw[2 * 1536 + 512 + c], xb = cbp[512 + c], bias1 = a.in[I_HYBIAS][(l * 2 + 1) * 512 + c];
            const bf16* zx = Z + (size_t)base * IN_COLS + HY_OFF + 512 + c;
#pragma unroll
            for (int i = 0; i < 16; ++i) { const int t = t0 + i; const float x2 = conv3z(zx, t, n, xw0, xw1, xw2, xb);
                YHY[(size_t)(base + t) * 512 + c] = (bf16)f2bf(x2 * (acc[i] + bias1 * yin[(size_t)t * 512])); }
        }
    }
}

__device__ __forceinline__ void stage_norm2_router(const Ctx& F, int l) {
    const auto& a = *F.a; unsigned char* ws = a.ws; const int lane = F.lane;
    const float* X = (const float*)(ws + WS_X); bf16* H = (bf16*)(ws + WS_H); const float* MOD = (const float*)(ws + WS_MOD);
    int* EIDX = (int*)(ws + WS_EIDX); float* GATE = (float*)(ws + WS_GATE); int* BLKCNT = (int*)(ws + WS_BLKCNT);
    LAS float* hb = (LAS float*)(F.lds + F.wave * 4096);
    LAS int* hist = (LAS int*)(F.lds + 32768);
    if (F.tid < 32) hist[F.tid] = 0;
    __syncthreads();
    const int rpb = (T_ALL + F.G - 1) / F.G, r0 = F.bid * rpb, r1 = (r0 + rpb < T_ALL) ? r0 + rpb : T_ALL;
    const float* rw = a.in[I_RTW] + (size_t)l * 1024 * 32;
    for (int row = r0 + F.wave; row < r1; row += NWAVES) {
        const int w = row < T_LAT ? (row >> 12) : 8;
        const f32x4* xr = (const f32x4*)(X + (size_t)row * D) + lane;
        f32x4 v[4];
#pragma unroll
        for (int j = 0; j < 4; ++j) v[j] = xr[64 * j];
        float ss = 0.f;
#pragma unroll
        for (int j = 0; j < 4; ++j) ss += (v[j][0] * v[j][0] + v[j][1] * v[j][1]) + (v[j][2] * v[j][2] + v[j][3] * v[j][3]);
        const float rstd = 1.0f / sqrtf(wave_sum(ss) * (1.f / D) + 1e-6f);
        const f32x4* ng = (const f32x4*)(a.in[I_N2G] + l * D) + lane;
        const f32x4* sh = (const f32x4*)(MOD + (size_t)(l * 9 + w) * 6144 + 3072) + lane; const f32x4* sc = (const f32x4*)(MOD + (size_t)(l * 9 + w) * 6144 + 4096) + lane;
        v2u* ho = (v2u*)(H + (size_t)row * D) + lane;
#pragma unroll
        for (int j = 0; j < 4; ++j) { const f32x4 h = v[j] * rstd * ng[64 * j] * (sc[64 * j] + 1.0f) + sh[64 * j]; v2u o; o.x = pk2(h[0], h[1]); o.y = pk2(h[2], h[3]); ho[64 * j] = o;
            *(LAS f32x4*)(hb + 4 * lane + 256 * j) = h; }
        LDS_WAIT(); asm volatile("" ::: "memory");
        const int e = lane & 31, half = lane >> 5;
        float acc = 0.f; const float* rp = rw + (size_t)(half * 512) * 32 + e; const LAS float* hp = hb + half * 512;
#pragma unroll 8
        for (int k = 0; k < 512; ++k) acc += hp[k] * rp[(size_t)k * 32];
        acc += __shfl_xor(acc, 32);
        const float logit = acc + a.in[I_RTB][l * 32 + e];
        float val = lane < 32 ? logit : -INFINITY; const int idx = e;
        float tv[4]; int ti[4];
#pragma unroll
        for (int r = 0; r < 4; ++r) { float bv = val; int bi = idx;
#pragma unroll
            for (int o = 1; o < 64; o <<= 1) { const float ov = __shfl_xor(bv, o); const int oi = __shfl_xor(bi, o); if (ov > bv || (ov == bv && oi < bi)) { bv = ov; bi = oi; } }
            tv[r] = bv; ti[r] = bi; if (lane == bi) val = -INFINITY; }
        if (lane == 0) { const float e1 = expf(tv[1] - tv[0]), e2 = expf(tv[2] - tv[0]), e3 = expf(tv[3] - tv[0]); const float inv = 1.0f / (1.0f + e1 + e2 + e3);
            *(int4*)(EIDX + row * 4) = make_int4(ti[0], ti[1], ti[2], ti[3]); *(f32x4*)(GATE + row * 4) = (f32x4){inv, e1 * inv, e2 * inv, e3 * inv};
            __hip_atomic_fetch_add(&hist[ti[0]], 1, __ATOMIC_RELAXED, __HIP_MEMORY_SCOPE_WORKGROUP); __hip_atomic_fetch_add(&hist[ti[1]], 1, __ATOMIC_RELAXED, __HIP_MEMORY_SCOPE_WORKGROUP); __hip_atomic_fetch_add(&hist[ti[2]], 1, __ATOMIC_RELAXED, __HIP_MEMORY_SCOPE_WORKGROUP); __hip_atomic_fetch_add(&hist[ti[3]], 1, __ATOMIC_RELAXED, __HIP_MEMORY_SCOPE_WORKGROUP); }
        LDS_WAIT(); asm volatile("" ::: "memory");
    }
    __syncthreads();
    if (F.tid < 32) BLKCNT[F.bid * 32 + F.tid] = hist[F.tid];
    __syncthreads();
}

__device__ __forceinline__ void stage_moe_scatter(const Ctx& F, int l) {
    const auto& a = *F.a; unsigned char* ws = a.ws; const int lane = F.lane;
    const bf16* H = (const bf16*)(ws + WS_H); bf16* XS = (bf16*)(ws + WS_XS);
    const int* EIDX = (const int*)(ws + WS_EIDX); int* POS = (int*)(ws + WS_POS); const int* BLKCNT = (const int*)(ws + WS_BLKCNT); int* META = (int*)(ws + WS_META);
    LAS int* tot = (LAS int*)F.lds; LAS int* off = tot + 32; LAS int* base = tot + 64; LAS int* posl = tot + 128; LAS int* eloc = tot + 4096;
    const int rpb = (T_ALL + F.G - 1) / F.G, r0 = F.bid * rpb, r1 = (r0 + rpb < T_ALL) ? r0 + rpb : T_ALL; const int na = (r1 > r0) ? (r1 - r0) * 4 : 0;
    for (int i = F.tid; i < na; i += NTHREADS) eloc[i] = EIDX[r0 * 4 + i];
    if (F.tid < 32) { int t = 0, o = 0; for (int b2 = 0; b2 < F.G; ++b2) { const int c = BLKCNT[b2 * 32 + F.tid]; t += c; o += (b2 < F.bid) ? c : 0; } tot[F.tid] = t; off[F.tid] = o; }
    __syncthreads();
    if (F.tid == 0) { int acc = 0; for (int e = 0; e < 32; ++e) { base[e] = acc; acc += (tot[e] + 255) & ~255; } base[32] = acc; }
    __syncthreads();
    if (F.bid == 0 && F.tid < 33) META[F.tid] = base[F.tid];
    if (F.tid < 32) { int run = base[F.tid] + off[F.tid]; for (int i = 0; i < na; ++i) { if (eloc[i] == F.tid) { posl[i] = run; POS[r0 * 4 + i] = run; ++run; } } }
    __syncthreads();
    for (int i = F.wave; i < na; i += NWAVES) { const int row = r0 + (i >> 2); const int p = posl[i];
        const v4u* s = (const v4u*)(H + (size_t)row * D) + lane; v4u* dp = (v4u*)(XS + (size_t)p * D) + lane;
        dp[0] = s[0]; dp[64] = s[64]; }
    __syncthreads();
}
__device__ __forceinline__ LAS int* load_moe_base(const Ctx& F) {
    LAS int* base = (LAS int*)(F.lds + LDSCTL_OFF + 256);
    const int* META = (const int*)(F.a->ws + WS_META);
    if (F.tid < 33) base[F.tid] = META[F.tid];
    __syncthreads();
    return base;
}

constexpr int NSTAGE_L = 13, NSTAGES = 1 + DEPTH * NSTAGE_L + 1;
__global__ void __launch_bounds__(NTHREADS, 2) mk_fwd(Args args) {
    extern __shared__ __attribute__((aligned(16))) unsigned char lds_raw[];
    Ctx F; F.a = kargs(); F.lds = (LAS unsigned char*)lds_raw; F.tid = threadIdx.x; F.lane = F.tid & 63; F.wave = __builtin_amdgcn_readfirstlane(F.tid >> 6); F.bid = blockIdx.x; F.G = gridDim.x;
    volatile LAS unsigned* MISC = (volatile LAS unsigned*)(F.lds + LDSCTL_OFF);
    for (int u = F.tid; u < (LDS_BYTES - LDSCTL_OFF) / 4; u += NTHREADS) ((LAS unsigned*)(F.lds + LDSCTL_OFF))[u] = 0u;
    __syncthreads();
#if MK_PER_STAGE
#define GRID_BAR() do { } while (0)
#else
    XcdBarrier bar = xcd_barrier_post((unsigned*)(F.a->ws + WS_CTL) + CW_BAR, MISC + 8);
#define GRID_BAR() xcd_barrier(bar)
#endif
#ifndef ONLY_S
#define ONLY_S -1
#endif
#define STG_SEL(k) (ONLY_S < 0 || ONLY_S == (((k) == 0) ? 0 : ((k) == NSTAGES - 1 ? 14 : (((k) - 1) % NSTAGE_L) + 1)))
#if MK_PER_STAGE
#define IN(k) (STG_SEL(k) && kargs()->ph_lo == (k))
#else
#define IN(k) STG_SEL(k)
#endif
#if MK_PER_STAGE
#define SEAM(k) do { } while (0)
#else
#define SEAM(k) do { if ((k) + 1 < NSTAGES) GRID_BAR(); } while (0)
#endif
#define STAGE(k) if (IN(k)) { F.a = kargs(); F.tid = opaque_v((int)threadIdx.x); F.lane = F.tid & 63; F.wave = __builtin_amdgcn_readfirstlane(F.tid >> 6); F.bid = opaque((int)blockIdx.x); F.G = opaque((int)gridDim.x); F.lds = (LAS unsigned char*)lds_raw + opaque(0); unsigned char* ws = F.a->ws; const int l = opaque(lq); unsigned char* wl = ws + WS_WTS + (size_t)l * WL_STRIDE; (void)wl; (void)ws;
#define STAGE_END(k) } SEAM(k);
    int lq = 0;
    STAGE(0) p0_prologue(F); STAGE_END(0)
    for (lq = 0; lq < DEPTH; ++lq) {
        const int sb = 1 + lq * NSTAGE_L;
        STAGE(sb + 0) stage_norm1(F, l); STAGE_END(sb + 0)
        STAGE(sb + 1) pg8::SchedStatic S; S.init(ws + WS_H, wl + WO_WIN, T_ALL, IN_COLS, 1024, F.G, F.bid); pg8::EpiBf16 E{(bf16*)(ws + WS_Z), IN_COLS, nullptr, 0};
            pg8::gemm_phase(F.lds, F.tid, 1024, S, E); STAGE_END(sb + 1)
        STAGE(sb + 2) stage_rw_prep1(F, l); stage_s5_scan(F, l); __syncthreads(); stage_hyena<0>(F, l); STAGE_END(sb + 2)
        STAGE(sb + 3) { pg8::SchedStatic S; S.init(ws + WS_ARW, wl + WO_RWCAT, T_ALL, 2560, 256, F.G, F.bid); pg8::EpiBf16 E{(bf16*)(ws + WS_P), 2560, nullptr, 0}; pg8::gemm_phase(F.lds, F.tid, 256, S, E); }
            stage_s5_prep(F, l); stage_hyena<1>(F, l); STAGE_END(sb + 3)
        STAGE(sb + 4) stage_rw_prep2(F, l);
            pg8::SchedStatic S; S.init(ws + WS_AS5, wl + WO_GLU, T_ALL, 1024, 512, F.G, F.bid); pg8::EpiGlu<0> E{(bf16*)(ws + WS_YS5), 512, F.a->in[I_S5GLUB] + l * 1024, 0, 512}; pg8::gemm_phase(F.lds, F.tid, 512, S, E); STAGE_END(sb + 4)
        STAGE(sb + 5) stage_rw_scan(F, l); STAGE_END(sb + 5)
        STAGE(sb + 6) stage_rw_readout(F, l); STAGE_END(sb + 6)
        STAGE(sb + 7) pg8::SchedMerge S; S.A0 = (const char*)(ws + WS_YHY); S.A1 = (const char*)(ws + WS_YRW); S.A2 = (const char*)(ws + WS_YS5); S.Bt = (const char*)(wl + WO_WBR); S.tstep = (size_t)256 * 512 * 2; S.bstride = (size_t)1024 * 512 * 2;
            S.nM = T_ALL / 256; S.nN = 4; S.G = F.G; S.c = F.bid;
            pg8::EpiMerge E{(float*)(ws + WS_MTMP), (bf16*)(ws + WS_H), (const bf16*)(ws + WS_Z) + GATE_OFF}; pg8::gemm_phase(F.lds, F.tid, 512, S, E); STAGE_END(sb + 7)
        STAGE(sb + 8) pg8::SchedStatic S; S.init(ws + WS_H, wl + WO_WOUT, T_ALL, 1024, 1024, F.G, F.bid); pg8::EpiResid E{(float*)(ws + WS_X), (const float*)(ws + WS_MOD) + (size_t)l * 9 * 6144 + 2048};
            pg8::gemm_phase(F.lds, F.tid, 1024, S, E); STAGE_END(sb + 8)
        STAGE(sb + 9) stage_norm2_router(F, l); STAGE_END(sb + 9)
        STAGE(sb + 10) stage_moe_scatter(F, l); STAGE_END(sb + 10)
        STAGE(sb + 11) LAS int* base = load_moe_base(F);
            pg8::SchedMoe S; S.A = (const char*)(ws + WS_XS); S.Bt = (const char*)(wl + WO_W1); S.tstep = (size_t)256 * 1024 * 2; S.estride = (size_t)2048 * 1024 * 2; S.NPN = 8; S.G = F.G; S.c = F.bid; S.base = base;
            pg8::EpiGlu<1> E{(bf16*)(ws + WS_ACT), 1024, F.a->in[I_B1] + (size_t)l * 32 * 2048, 2048, 1024}; pg8::gemm_phase(F.lds, F.tid, 1024, S, E); STAGE_END(sb + 11)
        STAGE(sb + 12) LAS int* base = load_moe_base(F);
            pg8::SchedMoe S; S.A = (const char*)(ws + WS_ACT); S.Bt = (const char*)(wl + WO_W2); S.tstep = (size_t)256 * 1024 * 2; S.estride = (size_t)1024 * 1024 * 2; S.NPN = 4; S.G = F.G; S.c = F.bid; S.base = base;
            pg8::EpiBf16 E{(bf16*)(ws + WS_XS), 1024, F.a->in[I_B2] + (size_t)l * 32 * 1024, 1024}; pg8::gemm_phase(F.lds, F.tid, 1024, S, E); STAGE_END(sb + 12)
    }
    lq = DEPTH;
    STAGE(NSTAGES - 1) stage_norm1(F, l); }
#undef IN
#undef SEAM
}

extern "C" void kernel_launch(void* const* d_in, const int* in_sizes, int n_in, void* d_out, int out_size, void* d_ws, size_t ws_size, hipStream_t stream) {
    static int grid = 0;
    if (grid == 0) {
        if (n_in != 51 || out_size != T_LAT * D || ws_size < WS_END) { fprintf(stderr, "kernel_launch: unexpected shapes (n_in %d out %d ws %zu, need %zu)\n", n_in, out_size, ws_size, (size_t)WS_END); grid = -1; return; }
        int dev = 0, cus = 0, per_cu = 0;
        if (hipGetDevice(&dev) != hipSuccess || hipDeviceGetAttribute(&cus, hipDeviceAttributeMultiprocessorCount, dev) != hipSuccess) { grid = -1; return; }
        if (hipFuncSetAttribute((const void*)mk_fwd, hipFuncAttributeMaxDynamicSharedMemorySize, LDS_BYTES) != hipSuccess) { fprintf(stderr, "kernel_launch: hipFuncSetAttribute failed\n"); grid = -1; return; }
        if (hipOccupancyMaxActiveBlocksPerMultiprocessor(&per_cu, (const void*)mk_fwd, NTHREADS, LDS_BYTES) != hipSuccess || per_cu < 1) fprintf(stderr, "kernel_launch: occupancy query says %d\n", per_cu);
        (void)hipGetLastError();
        grid = cus;
    }
    if (grid < 0) return;
    if (hipMemsetAsync((char*)d_ws + WS_CTL, 0, CTL_ZERO_BYTES, stream) != hipSuccess) return;
    Args a{};
    for (int i = 0; i < 51; ++i) a.in[i] = (const float*)d_in[i];
    a.out = (float*)d_out; a.ws = (unsigned char*)d_ws;
#if MK_PER_STAGE
    for (int s = 0; s < NSTAGES; ++s) { a.ph_lo = s; a.ph_hi = s + 1; hipLaunchKernelGGL(mk_fwd, dim3(grid), dim3(NTHREADS), LDS_BYTES, stream, a); }
#else
    a.ph_lo = 0; a.ph_hi = NSTAGES; hipLaunchKernelGGL(mk_fwd, dim3(grid), dim3(NTHREADS), LDS_BYTES, stream, a);
#endif
}
```

```cpp
#include <hip/hip_runtime.h>
#include <cstdio>
#include <cstdint>

#ifndef REP_GEMM
#define REP_GEMM 1
#endif
#ifndef REP_LIGHT
#define REP_LIGHT 1
#endif
#ifndef REP_PRO
#define REP_PRO 1
#endif
#ifndef MK_PER_STAGE
#define MK_PER_STAGE 0
#endif

#define GAS __attribute__((address_space(1)))
#define LAS __attribute__((address_space(3)))
typedef unsigned short bf16;
typedef unsigned v4u __attribute__((ext_vector_type(4)));
typedef unsigned v2u __attribute__((ext_vector_type(2)));
typedef float f32x4 __attribute__((ext_vector_type(4)));
typedef float f32x2 __attribute__((ext_vector_type(2)));
typedef short bf16x8 __attribute__((ext_vector_type(8)));

constexpr int D = 1024, BATCH = 8, SEQ = 4096, CTXL = 256, DEPTH = 2;
constexpr int T_LAT = BATCH * SEQ, T_CTX = BATCH * CTXL, T_ALL = T_LAT + T_CTX;
constexpr int IN_COLS = 6912, HY_OFF = 0, RW_OFF = 1536, S5_OFF = 3328, GATE_OFF = 3840;
constexpr int NE = 32, TOPK = 4;
constexpr int MAXSLOT = 147456;
constexpr int NWAVES = 8, NTHREADS = 512;
constexpr int HY_MARG = 128, HY_ROWB = 8720, HY_RLEN = 8272, HY_RLENC = 592;
constexpr int HY_R1_OFF = 8 * HY_ROWB, HY_R2_OFF = HY_R1_OFF + HY_RLEN * 2;

constexpr size_t MiB = 1ull << 20;
constexpr size_t WS_CTL = 0, CTL_ZERO_BYTES = 1 * MiB;
constexpr size_t WS_MOD = 1 * MiB;
constexpr size_t WS_BLKCNT = 2 * MiB;
constexpr size_t WS_META = 2 * MiB + 512 * 1024;
constexpr size_t WS_EIDX = 3 * MiB, WS_GATE = 4 * MiB, WS_POS = 5 * MiB;
constexpr size_t WS_WTS = 8 * MiB, WL_STRIDE = 214 * MiB;
constexpr size_t WO_WIN = 0, WO_RWCAT = 14 * MiB, WO_GLU = 16 * MiB, WO_WBR = 17 * MiB, WO_WOUT = 20 * MiB, WO_W1 = 22 * MiB, WO_W2 = 150 * MiB;
constexpr size_t WS_GF = 436 * MiB, GF_STRIDE = 20 * MiB, GF_CTX = 17 * MiB;
constexpr size_t WS_X = 504 * MiB;
constexpr size_t WS_H = 640 * MiB;
constexpr size_t WS_BIG = 708 * MiB;
constexpr size_t WS_Z = WS_BIG;
constexpr size_t WS_SCN = 1167 * MiB;
constexpr size_t WS_MTMP = WS_SCN;
constexpr size_t WS_P = 1473 * MiB;
constexpr size_t WS_ARW = 1643 * MiB;
constexpr size_t WS_YP = 1660 * MiB;
constexpr size_t WS_YDIR = WS_YP;
constexpr size_t WS_UT = 1796 * MiB;
constexpr size_t WS_AS5 = 2000 * MiB;
constexpr size_t WS_YHY = 1898 * MiB, WS_YRW = 1932 * MiB, WS_YS5 = 1966 * MiB;
constexpr size_t WS_XS = WS_BIG;
constexpr size_t WS_ACT = WS_BIG + 288 * MiB;
constexpr size_t WS_END = 2034 * MiB;
constexpr int CW_BAR = 4096;

constexpr int RING_BYTES = 131072;
constexpr int LDSCTL_OFF = RING_BYTES;
constexpr int LDS_BYTES = 147456;

__device__ __forceinline__ unsigned f2bf(float f) { unsigned u = __builtin_bit_cast(unsigned, f); return (u + 0x7fffu + ((u >> 16) & 1u)) >> 16; }
__device__ __forceinline__ unsigned pk2(float lo, float hi) { return f2bf(lo) | (f2bf(hi) << 16); }
__device__ __forceinline__ float bf2f(bf16 b) { return __builtin_bit_cast(float, ((unsigned)b) << 16); }
__device__ __forceinline__ float bflo(unsigned w) { return __builtin_bit_cast(float, w << 16); }
__device__ __forceinline__ float bfhi(unsigned w) { return __builtin_bit_cast(float, w & 0xffff0000u); }
__device__ __forceinline__ float wave_sum(float v) {
#pragma unroll
    for (int o = 1; o < 64; o <<= 1) v += __shfl_xor(v, o);
    return v;
}
__device__ __forceinline__ float sigm(float x) { return 1.f / (1.f + __expf(-x)); }
#define LDS_WAIT() asm volatile("s_waitcnt lgkmcnt(0)" ::: "memory")

#define XB_TMO      128
#define XB_XCNT(j)  (256  + 64 * (j))
#define XB_XSUB(j)  (1280 + 64 * (j))
#define XB_XGEN(j)  (2304 + 64 * (j))
#define XB_TOP      3328
#define XB_TOPGEN   3392
#define XCD_BAR_WORDS 3456
#define XB_SPIN_CAP (1u << 22)
__device__ __forceinline__ unsigned xb_ld(unsigned* p)              { return __hip_atomic_load(p, __ATOMIC_RELAXED, __HIP_MEMORY_SCOPE_AGENT); }
__device__ __forceinline__ unsigned xb_add(unsigned* p, unsigned v) { return __hip_atomic_fetch_add(p, v, __ATOMIC_RELAXED, __HIP_MEMORY_SCOPE_AGENT); }
__device__ __forceinline__ unsigned xb_xcc_id() { return (unsigned)__builtin_amdgcn_s_getreg((3 << 11) | 20) & 0xFu; }
#define XB_SPIN(cond, bar) do { unsigned _sp = 0; while (cond) { __builtin_amdgcn_s_sleep(1); \
    if ((++_sp & 255u) == 0u) { if (xb_ld(&(bar)[XB_TMO])) break; if (_sp > XB_SPIN_CAP) { atomicAdd(&(bar)[XB_TMO], 1u); break; } } } } while (0)
struct XcdBarrier { unsigned* bar; unsigned x; volatile LAS unsigned* st; };
__device__ __forceinline__ XcdBarrier xcd_barrier_post(unsigned* bar, volatile LAS unsigned* st) {
    XcdBarrier b; b.bar = bar; b.x = xb_xcc_id(); b.st = st;
    if (threadIdx.x == 0) (void)xb_add(&bar[XB_XCNT(b.x)], 1u);
    return b;
}
__device__ __forceinline__ void xcd_barrier_complete(unsigned* bar, unsigned x, unsigned& nloc, unsigned& nx) {
    const unsigned G = gridDim.x * gridDim.y * gridDim.z;
    unsigned sum, cnt, mine, sp = 0u;
    for (;;) {
        sum = 0u; cnt = 0u; mine = 0u;
#pragma unroll
        for (unsigned j = 0; j < 16; ++j) { const unsigned c = xb_ld(&bar[XB_XCNT(j)]); sum += c; cnt += (c > 0u) ? 1u : 0u; mine = (j == x) ? c : mine; }
        if (sum == G) break;
        __builtin_amdgcn_s_sleep(1);
        if ((++sp & 255u) == 0u) { if (xb_ld(&bar[XB_TMO])) break; if (sp > XB_SPIN_CAP) { atomicAdd(&bar[XB_TMO], 1u); break; } }
    }
    nloc = mine > 0u ? mine : 1u; nx = cnt > 0u ? cnt : 1u;
}
__device__ __forceinline__ void xcd_barrier(const XcdBarrier& b) {
    asm volatile("s_waitcnt vmcnt(0)" ::: "memory");
    __syncthreads();
    if (threadIdx.x == 0) {
        unsigned* bar = b.bar;
        __builtin_amdgcn_s_waitcnt(0);
        unsigned nloc = b.st[0], nx = b.st[1];
        if (nloc == 0u) { xcd_barrier_complete(bar, b.x, nloc, nx); b.st[0] = nloc; b.st[1] = nx; }
        const unsigned old = xb_add(&bar[XB_XSUB(b.x)], 1u);
        const unsigned gen = old / nloc;
        if (old + 1u == (gen + 1u) * nloc) {
            __builtin_amdgcn_fence(__ATOMIC_RELEASE, "agent");
            asm volatile("s_waitcnt vmcnt(0)" ::: "memory");
            const unsigned og = xb_add(&bar[XB_TOP], 1u);
            const unsigned tg = og / nx;
            if (og + 1u == (tg + 1u) * nx) xb_add(&bar[XB_TOPGEN], 1u);
            else XB_SPIN(xb_ld(&bar[XB_TOPGEN]) == tg, bar);
            __builtin_amdgcn_fence(__ATOMIC_ACQUIRE, "agent");
            xb_add(&bar[XB_XGEN(b.x)], 1u);
            asm volatile("s_waitcnt vmcnt(0)" ::: "memory");
        } else {
            XB_SPIN(xb_ld(&bar[XB_XGEN(b.x)]) == gen, bar);
            __builtin_amdgcn_fence(__ATOMIC_ACQUIRE, "agent");
            asm volatile("s_waitcnt vmcnt(0)" ::: "memory");
        }
    }
    __syncthreads();
}

namespace pg8 {
constexpr int BM = 256, BK = 64, HALF = 128, HTB = HALF * BK * 2, STAGE_BYTES = 8 * HTB, NXCD = 8, WGM = 8;
__host__ __device__ __forceinline__ int lds_byte(int r, int c) { const int st = (r >> 4) * 2 + (c >> 5), rr = r & 15, cc = c & 31, ob = rr * 64 + cc * 2; return st * 1024 + (ob ^ (((ob >> 9) & 1) << 5)); }
__host__ __device__ __forceinline__ void stage_rc(int b, int& R, int& C) { const int st = b / 1024, sb = b % 1024, swz = sb ^ (((sb >> 9) & 1) << 5); R = (st >> 1) * 16 + swz / 64; C = (st & 1) * 32 + (swz % 64) / 2; }
__host__ __device__ __forceinline__ int perm32(int rho) { const int n = rho >> 4, i = rho & 15; return 8 * (i >> 2) + 4 * n + (i & 3); }
struct Unit { int pm, pn, e; };
__device__ __forceinline__ unsigned cvt_pk_bf16(float lo, float hi) { unsigned r; asm volatile("v_cvt_pk_bf16_f32 %0, %1, %2" : "=v"(r) : "v"(lo), "v"(hi)); return r; }

__device__ __forceinline__ void tile_of(int L, int nM, int nN, int& pm, int& pn) {
    const int nwg = nM * nN; int wgid = L;
    { const int q = nwg / NXCD, r = nwg % NXCD, xcd = wgid % NXCD, off = wgid / NXCD; wgid = (xcd < r ? xcd * (q + 1) : r * (q + 1) + (xcd - r) * q) + off; }
    const int nig = WGM * nN, gid = wgid / nig, fm = gid * WGM, gsz = (nM - fm) < WGM ? (nM - fm) : WGM;
    pm = fm + ((wgid % nig) % gsz); pn = (wgid % nig) / gsz;
}
struct SchedStatic {
    const char* A; const char* Bt; size_t tstep; int nM, nN, G, c;
    __device__ __forceinline__ void init(const void* A_, const void* Bt_, int M, int N, int K, int G_, int c_) { A = (const char*)A_; Bt = (const char*)Bt_; tstep = (size_t)BM * K * 2; nM = M / BM; nN = N / BM; G = G_; c = c_; }
    __device__ __forceinline__ bool next(int i, Unit& u) const { const long L = (long)i * G + c; if (L >= (long)nM * nN) return false; tile_of((int)L, nM, nN, u.pm, u.pn); u.e = 0; return true; }
    __device__ __forceinline__ const char* aptr(const Unit& u) const { return A + (size_t)u.pm * tstep; }
    __device__ __forceinline__ const char* bptr(const Unit& u) const { return Bt + (size_t)u.pn * tstep; }
};
struct SchedMerge {
    const char* A0; const char* A1; const char* A2; const char* Bt; size_t tstep, bstride; int nM, nN, G, c;
    __device__ __forceinline__ bool next(int i, Unit& u) const { const int j = i / 3, br = i - 3 * j; const long L = (long)j * G + c; if (L >= (long)nM * nN) return false; tile_of((int)L, nM, nN, u.pm, u.pn); u.e = br; return true; }
    __device__ __forceinline__ const char* aptr(const Unit& u) const { return (u.e == 0 ? A0 : (u.e == 1 ? A1 : A2)) + (size_t)u.pm * tstep; }
    __device__ __forceinline__ const char* bptr(const Unit& u) const { return Bt + (size_t)u.e * bstride + (size_t)u.pn * tstep; }
};
struct SchedMoe {
    const char* A; const char* Bt; size_t tstep, estride; int NPN, G, c; const LAS int* base;
    __device__ __forceinline__ bool next(int i, Unit& u) const {
        const int ntiles = base[32] >> 8; const long L = (long)i * G + c; if (L >= (long)ntiles * NPN) return false;
        u.pm = (int)(L / NPN); u.pn = (int)(L % NPN); const int r0 = u.pm << 8; int e = 0;
#pragma unroll 1
        for (int k = 1; k < 32; ++k) e += (r0 >= base[k]) ? 1 : 0;
        u.e = e; return true;
    }
    __device__ __forceinline__ const char* aptr(const Unit& u) const { return A + (size_t)u.pm * tstep; }
    __device__ __forceinline__ const char* bptr(const Unit& u) const { return Bt + (size_t)u.e * estride + (size_t)u.pn * tstep; }
};

template <class Epi, class Sched>
__device__ __forceinline__ void gemm_phase(LAS unsigned char* lds, const int tid, const int K, const Sched& S, const Epi& E) {
    const int wid = __builtin_amdgcn_readfirstlane(tid >> 6), lane = tid & 63, wr = wid >> 2, wc = wid & 3, fr = lane & 15, fq = lane >> 4;
    const int nt = K / BK;
    unsigned voffA[2], voffB[2];
#pragma unroll
    for (int i = 0; i < 2; ++i) { int R, C; stage_rc(tid * 16 + i * 8192, R, C); const int Rb = Epi::PERM ? ((R & ~31) + perm32(R & 31)) : R;
        voffA[i] = (unsigned)(R * K + C) * 2u; voffB[i] = (unsigned)(Rb * K + C) * 2u; }
    const size_t kstep = (size_t)(BK * 2);
    const size_t hstep = (size_t)HALF * K * 2;
    const unsigned ldsw = (unsigned)wid * 1024u;
    const int aoff = lds_byte(wr * 64 + fr, fq * 8), boff = lds_byte(wc * 32 + fr, fq * 8);
#define PG8_SA(b, h) (((b) * 2 + (h)) * HTB)
#define PG8_SB(b, h) ((4 + (b) * 2 + (h)) * HTB)
#define PG8_STAGE(bufoff, gbase, voff) do { _Pragma("unroll") for (int _i = 0; _i < 2; ++_i) \
        __builtin_amdgcn_global_load_lds((const unsigned*)((const char*)(gbase) + (voff)[_i]), (LAS unsigned*)(lds + (bufoff) + ldsw + _i * 8192), 16, 0, 0); } while (0)
#define PG8_LDA(dst, b, h) do { _Pragma("unroll") for (int m = 0; m < 4; ++m) _Pragma("unroll") for (int k = 0; k < 2; ++k) dst[m][k] = *(const LAS bf16x8*)(lds + PG8_SA(b, h) + aoff + m * 2048 + k * 1024); } while (0)
#define PG8_LDB(dst, b, h) do { _Pragma("unroll") for (int n = 0; n < 2; ++n) _Pragma("unroll") for (int k = 0; k < 2; ++k) dst[n][k] = *(const LAS bf16x8*)(lds + PG8_SB(b, h) + boff + n * 2048 + k * 1024); } while (0)
#define PG8_MMA(ai, bj, At, Bt) do { __builtin_amdgcn_s_setprio(1); _Pragma("unroll") for (int m = 0; m < 4; ++m) _Pragma("unroll") for (int n = 0; n < 2; ++n) _Pragma("unroll") for (int k = 0; k < 2; ++k) \
        acc[ai][bj][m][n] = __builtin_amdgcn_mfma_f32_16x16x32_bf16(Bt[n][k], At[m][k], acc[ai][bj][m][n], 0, 0, 0); __builtin_amdgcn_s_setprio(0); } while (0)
#define PG8_WAIT_V(n) asm volatile("s_waitcnt vmcnt(" #n ")" ::: "memory")
#define PG8_WAIT_L(n) asm volatile("s_waitcnt lgkmcnt(" #n ")" ::: "memory")
#define PG8_BAR __builtin_amdgcn_s_barrier()
#define PG8_SCHED __builtin_amdgcn_sched_barrier(0)
    Unit cur, nxt; int ui = 0;
    if (!S.next(0, cur)) return;
    f32x4 acc[2][2][4][2];
#pragma unroll
    for (int a = 0; a < 2; ++a)
#pragma unroll
        for (int b = 0; b < 2; ++b)
#pragma unroll
            for (int m = 0; m < 4; ++m)
#pragma unroll
                for (int n = 0; n < 2; ++n) acc[a][b][m][n] = (f32x4){0.f, 0.f, 0.f, 0.f};
    bf16x8 At[4][2], B0[2][2], B1[2][2];
    const char* cA = S.aptr(cur); const char* cB = S.bptr(cur);
    PG8_STAGE(PG8_SB(0, 0), cB, voffB); PG8_STAGE(PG8_SB(0, 1), cB + hstep, voffB); PG8_STAGE(PG8_SA(0, 0), cA, voffA); PG8_STAGE(PG8_SA(0, 1), cA + hstep, voffA);
    if (wr == 1) PG8_BAR;
    PG8_WAIT_V(2); PG8_BAR;
    PG8_STAGE(PG8_SB(1, 0), cB + kstep, voffB); PG8_STAGE(PG8_SA(1, 0), cA + kstep, voffA); PG8_STAGE(PG8_SB(1, 1), cB + hstep + kstep, voffB);
    PG8_WAIT_V(6); PG8_BAR;
    for (;;) {
        const bool has_next = S.next(ui + 1, nxt);
        const char* nA = has_next ? S.aptr(nxt) : cA; const char* nB = has_next ? S.bptr(nxt) : cB;
        for (int t = 0; t < nt; t += 2) {
            const bool last = (t == nt - 2);
            const char* a1 = cA + (size_t)(t + 1) * kstep;
            const char* a2 = last ? nA : cA + (size_t)(t + 2) * kstep; const char* b2 = last ? nB : cB + (size_t)(t + 2) * kstep;
            const char* a3 = a2 + kstep; const char* b3 = b2 + kstep;
            PG8_LDB(B0, 0, 0); PG8_LDB(B1, 0, 1); PG8_SCHED; PG8_LDA(At, 0, 0); PG8_STAGE(PG8_SA(1, 1), a1 + hstep, voffA);
            PG8_WAIT_V(8); PG8_WAIT_L(0); PG8_BAR; PG8_MMA(0, 0, At, B0); PG8_MMA(0, 1, At, B1); PG8_BAR; PG8_SCHED;
            PG8_LDA(At, 0, 1); PG8_STAGE(PG8_SB(0, 0), b2, voffB); PG8_STAGE(PG8_SB(0, 1), b2 + hstep, voffB); PG8_STAGE(PG8_SA(0, 0), a2, voffA);
            PG8_WAIT_V(8); PG8_WAIT_L(0); PG8_BAR; PG8_MMA(1, 0, At, B0); PG8_MMA(1, 1, At, B1); PG8_BAR; PG8_SCHED;
            PG8_LDB(B0, 1, 0); PG8_LDB(B1, 1, 1); PG8_SCHED; PG8_LDA(At, 1, 0); PG8_STAGE(PG8_SA(0, 1), a2 + hstep, voffA);
            PG8_WAIT_V(8); PG8_WAIT_L(0); PG8_BAR; PG8_MMA(0, 0, At, B0); PG8_MMA(0, 1, At, B1); PG8_BAR; PG8_SCHED;
            PG8_LDA(At, 1, 1); PG8_STAGE(PG8_SB(1, 0), b3, voffB); PG8_STAGE(PG8_SB(1, 1), b3 + hstep, voffB); PG8_STAGE(PG8_SA(1, 0), a3, voffA);
            PG8_WAIT_V(8); PG8_WAIT_L(0); PG8_BAR; PG8_MMA(1, 0, At, B0); PG8_MMA(1, 1, At, B1); PG8_BAR; PG8_SCHED;
        }
        if (wr == 0) PG8_BAR;
        E(acc, cur, wr, wc, fr, fq);
        if (!has_next) break;
#pragma unroll
        for (int a = 0; a < 2; ++a)
#pragma unroll
            for (int b = 0; b < 2; ++b)
#pragma unroll
                for (int m = 0; m < 4; ++m)
#pragma unroll
                    for (int n = 0; n < 2; ++n) acc[a][b][m][n] = (f32x4){0.f, 0.f, 0.f, 0.f};
        cur = nxt; cA = nA; cB = nB; ++ui;
        if (wr == 1) PG8_BAR;
    }
    PG8_WAIT_V(0);
    PG8_BAR;
#undef PG8_SA
#undef PG8_SB
#undef PG8_STAGE
#undef PG8_LDA
#undef PG8_LDB
#undef PG8_MMA
#undef PG8_WAIT_V
#undef PG8_WAIT_L
#undef PG8_BAR
#undef PG8_SCHED
}

struct EpiBf16 {
    static constexpr bool PERM = true;
    bf16* O; int ldc; const float* bias; int bias_stride;
    __device__ __forceinline__ void operator()(const f32x4 (&acc)[2][2][4][2], const Unit& u, int wr, int wc, int fr, int fq) const {
        const int row0 = u.pm * BM + wr * 64 + fr, col0 = u.pn * BM + wc * 32 + 8 * fq;
        f32x4 bv[2][2];
#pragma unroll
        for (int bj = 0; bj < 2; ++bj)
#pragma unroll
            for (int n = 0; n < 2; ++n) bv[bj][n] = bias ? *(const f32x4*)(bias + (size_t)u.e * bias_stride + col0 + bj * HALF + 4 * n) : (f32x4){0.f, 0.f, 0.f, 0.f};
#pragma unroll
        for (int ai = 0; ai < 2; ++ai)
#pragma unroll
            for (int m = 0; m < 4; ++m) { bf16* rowp = O + (size_t)(row0 + ai * HALF + m * 16) * ldc + col0;
#pragma unroll
                for (int bj = 0; bj < 2; ++bj) { const f32x4 v0 = acc[ai][bj][m][0] + bv[bj][0], v1 = acc[ai][bj][m][1] + bv[bj][1];
                    v4u w; w.x = cvt_pk_bf16(v0[0], v0[1]); w.y = cvt_pk_bf16(v0[2], v0[3]); w.z = cvt_pk_bf16(v1[0], v1[1]); w.w = cvt_pk_bf16(v1[2], v1[3]);
                    *(v4u*)(rowp + bj * HALF) = w; } }
    }
};
template <int MODE> struct EpiGlu {
    static constexpr bool PERM = true;
    bf16* O; int ldc; const float* bias; int bias_stride, hs;
    __device__ __forceinline__ void operator()(const f32x4 (&acc)[2][2][4][2], const Unit& u, int wr, int wc, int fr, int fq) const {
        const int row0 = u.pm * BM + wr * 64 + fr, col0 = u.pn * HALF + wc * 32 + 8 * fq;
        const float* bp = bias + (size_t)u.e * bias_stride + col0;
        f32x4 ba[2], bb[2];
#pragma unroll
        for (int n = 0; n < 2; ++n) { ba[n] = *(const f32x4*)(bp + 4 * n); bb[n] = *(const f32x4*)(bp + hs + 4 * n); }
#pragma unroll
        for (int ai = 0; ai < 2; ++ai)
#pragma unroll
            for (int m = 0; m < 4; ++m) { bf16* rowp = O + (size_t)(row0 + ai * HALF + m * 16) * ldc + col0;
                float o[8];
#pragma unroll
                for (int n = 0; n < 2; ++n) { const f32x4 a = acc[ai][0][m][n] + ba[n], b = acc[ai][1][m][n] + bb[n];
#pragma unroll
                    for (int j = 0; j < 4; ++j) {
                        if (MODE == 0) o[4 * n + j] = a[j] * sigm(b[j]);
                        else { const float g = fminf(a[j], 7.f), up = fminf(fmaxf(b[j], -7.f), 7.f); o[4 * n + j] = (up + 1.f) * g * sigm(1.702f * g); } } }
                v4u w; w.x = cvt_pk_bf16(o[0], o[1]); w.y = cvt_pk_bf16(o[2], o[3]); w.z = cvt_pk_bf16(o[4], o[5]); w.w = cvt_pk_bf16(o[6], o[7]);
                *(v4u*)rowp = w; }
    }
};
struct EpiMerge {
    static constexpr bool PERM = true;
    float* mtmp; bf16* Mo; const bf16* zg;
    __device__ __forceinline__ void operator()(const f32x4 (&acc)[2][2][4][2], const Unit& u, int wr, int wc, int fr, int fq) const {
        const int row0 = u.pm * BM + wr * 64 + fr, col0 = u.pn * BM + wc * 32 + 8 * fq;
#pragma unroll
        for (int ai = 0; ai < 2; ++ai)
#pragma unroll
            for (int m = 0; m < 4; ++m) { const size_t r = (size_t)(row0 + ai * HALF + m * 16);
#pragma unroll
                for (int bj = 0; bj < 2; ++bj) { const int c = col0 + bj * HALF;
                    const v4u gz = *(const v4u*)(zg + r * IN_COLS + u.e * 1024 + c);
                    float g[8] = {bflo(gz.x), bfhi(gz.x), bflo(gz.y), bfhi(gz.y), bflo(gz.z), bfhi(gz.z), bflo(gz.w), bfhi(gz.w)};
                    f32x4 t0, t1; float* tp = mtmp + r * 1024 + c;
                    if (u.e == 0) { t0 = (f32x4){0.f, 0.f, 0.f, 0.f}; t1 = t0; } else { t0 = *(const f32x4*)tp; t1 = *(const f32x4*)(tp + 4); }
#pragma unroll
                    for (int j = 0; j < 4; ++j) { t0[j] += sigm(g[j]) * acc[ai][bj][m][0][j]; t1[j] += sigm(g[4 + j]) * acc[ai][bj][m][1][j]; }
                    if (u.e < 2) { *(f32x4*)tp = t0; *(f32x4*)(tp + 4) = t1; }
                    else { v4u w; w.x = cvt_pk_bf16(t0[0], t0[1]); w.y = cvt_pk_bf16(t0[2], t0[3]); w.z = cvt_pk_bf16(t1[0], t1[1]); w.w = cvt_pk_bf16(t1[2], t1[3]);
                        *(v4u*)(Mo + r * 1024 + c) = w; } } }
    }
};
struct EpiResid {
    static constexpr bool PERM = false;
    float* X; const float* gmod;
    __device__ __forceinline__ void operator()(const f32x4 (&acc)[2][2][4][2], const Unit& u, int wr, int wc, int fr, int fq) const {
        const int row0 = u.pm * BM + wr * 64 + fr, col0 = u.pn * BM + wc * 32 + 4 * fq;
        const int r00 = u.pm * BM; const int w = r00 < T_LAT ? (r00 >> 12) : 8;
        f32x4 gv[2][2];
#pragma unroll
        for (int bj = 0; bj < 2; ++bj)
#pragma unroll
            for (int n = 0; n < 2; ++n) gv[bj][n] = *(const f32x4*)(gmod + (size_t)w * 6144 + col0 + bj * HALF + n * 16);
#pragma unroll
        for (int ai = 0; ai < 2; ++ai)
#pragma unroll
            for (int m = 0; m < 4; ++m) { float* rowp = X + (size_t)(row0 + ai * HALF + m * 16) * 1024 + col0;
#pragma unroll
                for (int bj = 0; bj < 2; ++bj)
#pragma unroll
                    for (int n = 0; n < 2; ++n) { f32x4* p = (f32x4*)(rowp + bj * HALF + n * 16); *p = *p + gv[bj][n] * acc[ai][bj][m][n]; } }
    }
};
}

struct Args { const float* in[51]; float* out; unsigned char* ws; int ph_lo, ph_hi; };
enum { I_X = 0, I_C, I_CTX, I_CCTX, I_ADAW, I_ADAB, I_N1G, I_N2G, I_WIN, I_HYCW, I_HYCB, I_HYW1, I_HYB1, I_HYF1, I_HYW2, I_HYB2, I_HYF2, I_HYW3, I_HYB3, I_HYBIAS,
       I_RWCW, I_RWCB, I_RWWUP, I_RWW0, I_RWAUP, I_RWA0, I_RWGUP, I_RWKK, I_RWKA, I_RWRK, I_RWLNG, I_RWLNB, I_S5ARE, I_S5AIM, I_S5LDT, I_S5BRE, I_S5BIM, I_S5CRE, I_S5CIM, I_S5D,
       I_S5GLUW, I_S5GLUB, I_WBR, I_WOUT, I_RTW, I_RTB, I_W1, I_B1, I_W2, I_B2, I_FING };

typedef const __attribute__((address_space(4))) Args* CArgsP;
__device__ __forceinline__ CArgsP kargs() { CArgsP p = (CArgsP)__builtin_amdgcn_kernarg_segment_ptr(); asm volatile("" : "+s"(p)); return p; }
__device__ __forceinline__ int opaque(int v) { asm volatile("" : "+s"(v)); return v; }
__device__ __forceinline__ int opaque_v(int v) { asm volatile("" : "+v"(v)); return v; }
struct Ctx { CArgsP a; LAS unsigned char* lds; int tid, lane, wave, bid, G; };

__device__ __forceinline__ void row_seq(int row, int& base, int& pos, int& n) {
    if (row < T_LAT) { base = row & ~(SEQ - 1); pos = row & (SEQ - 1); n = SEQ; }
    else { const int r = row - T_LAT; base = T_LAT + (r & ~(CTXL - 1)); pos = r & (CTXL - 1); n = CTXL; }
}
__device__ __forceinline__ float conv3z(const bf16* zc, int pos, int n, float w0, float w1, float w2, float b) {
    const float zm = pos > 0 ? bf2f(zc[(size_t)(pos - 1) * IN_COLS]) : 0.f, z0 = bf2f(zc[(size_t)pos * IN_COLS]), zp = pos < n - 1 ? bf2f(zc[(size_t)(pos + 1) * IN_COLS]) : 0.f;
    return zm * w0 + z0 * w1 + zp * w2 + b;
}

template <int MODE>
__device__ __forceinline__ void transpose_item(const float* W, int K, int N, bf16* WT, int Hs, LAS float* scr, int item, int lane) {
    const int nblk = N / 32, kb = item / nblk, nb = item % nblk, k0 = 64 * kb, n0 = 32 * nb;
#pragma unroll 8
    for (int i = 0; i < 32; ++i) { const int kk = 2 * i + (lane >> 5); scr[kk * 33 + (lane & 31)] = W[(size_t)(k0 + kk) * N + n0 + (lane & 31)]; }
    LDS_WAIT(); asm volatile("" ::: "memory");
    const int c = lane & 7;
#pragma unroll
    for (int j = 0; j < 4; ++j) { const int n = (lane >> 3) + 8 * j; const LAS float* s = scr + (8 * c) * 33 + n;
        v4u o; o.x = pk2(s[0 * 33], s[1 * 33]); o.y = pk2(s[2 * 33], s[3 * 33]); o.z = pk2(s[4 * 33], s[5 * 33]); o.w = pk2(s[6 * 33], s[7 * 33]);
        int dr = n0 + n;
        if (MODE == 1) { const int nc = n0 + n; const int jx = nc < Hs ? nc : nc - Hs; dr = (jx >> 7) * 256 + (nc < Hs ? 0 : 128) + (jx & 127); }
        *(v4u*)(WT + (size_t)dr * K + k0 + 8 * c) = o; }
    LDS_WAIT(); asm volatile("" ::: "memory");
}

__device__ __forceinline__ void p0_prologue(const Ctx& F) {
    const auto& a = *F.a; unsigned char* ws = a.ws;
    const int gw = F.bid * NWAVES + F.wave, NGW = F.G * NWAVES, lane = F.lane;
    float* X = (float*)(ws + WS_X);
    for (int row = gw; row < T_ALL; row += NGW) {
        f32x4* xo = (f32x4*)(X + (size_t)row * D) + lane;
        if (row < T_LAT) {
            const f32x4* xi = (const f32x4*)(a.in[I_X] + (size_t)row * D) + lane;
            const int t = row & (SEQ - 1); const float pr = (float)(t >> 6), pc = (float)(t & 63);
#pragma unroll
            for (int j = 0; j < 4; ++j) { f32x4 v = xi[64 * j];
#pragma unroll
                for (int e = 0; e < 4; ++e) { const float om = 1.0f / powf(10000.0f, (float)(4 * lane + e) / 256.0f); const float ang = ((j < 2) ? pr : pc) * om; v[e] += (j & 1) ? cosf(ang) : sinf(ang); }
                xo[64 * j] = v; }
        } else {
            const f32x4* xi = (const f32x4*)(a.in[I_CTX] + (size_t)(row - T_LAT) * D) + lane;
#pragma unroll
            for (int j = 0; j < 4; ++j) xo[64 * j] = xi[64 * j];
        }
    }
    {
        LAS float* condl = (LAS float*)F.lds; LAS float* psum = (LAS float*)(F.lds + 40960);
        for (int i = F.tid; i < 9 * 1024; i += NTHREADS) { const int w = i >> 10, k = i & 1023; const float cv = (w < 8) ? a.in[I_C][w * 1024 + k] : a.in[I_CCTX][k]; condl[i] = cv / (1.f + expf(-cv)); }
        __syncthreads();
        float* MOD = (float*)(ws + WS_MOD);
        for (int it = F.bid; it < 2 * 96; it += F.G) {
            const int l = it / 96, cg = it % 96, col = cg * 64 + lane;
            float acc[9];
#pragma unroll
            for (int w = 0; w < 9; ++w) acc[w] = 0.f;
            const float* wp = a.in[I_ADAW] + ((size_t)l * 1024 + F.wave * 128) * 6144 + col;
            for (int k = 0; k < 128; ++k) { const float wv = wp[(size_t)k * 6144];
#pragma unroll
                for (int w = 0; w < 9; ++w) acc[w] += condl[w * 1024 + F.wave * 128 + k] * wv; }
#pragma unroll
            for (int w = 0; w < 9; ++w) psum[(F.wave * 9 + w) * 64 + lane] = acc[w];
            __syncthreads();
            if (F.wave == 0) {
#pragma unroll
                for (int w = 0; w < 9; ++w) { float s = 0.f;
#pragma unroll
                    for (int wv = 0; wv < 8; ++wv) s += psum[(wv * 9 + w) * 64 + lane];
                    MOD[(size_t)(l * 9 + w) * 6144 + col] = s + a.in[I_ADAB][l * 6144 + col]; }
            }
            __syncthreads();
        }
    }
    {
        LAS float* scr = (LAS float*)(F.lds + F.wave * 16384);
        constexpr int IT_W1 = 16 * 64, IT_W2 = 16 * 32, IT_WIN = 16 * 216, IT_GLU = 8 * 32, IT_WBR = 8 * 32, IT_WOUT = 16 * 32;
        constexpr int N_W1 = 64 * IT_W1, N_W2 = 64 * IT_W2, N_WIN = 2 * IT_WIN, N_GLU = 2 * IT_GLU, N_WBR = 6 * IT_WBR, N_WOUT = 2 * IT_WOUT;
        constexpr int NITEMS = N_W1 + N_W2 + N_WIN + N_GLU + N_WBR + N_WOUT;
        for (int it = gw; it < NITEMS; it += NGW) {
            int r = it;
            if (r < N_W1) { const int mtx = r / IT_W1, l = mtx >> 5, e = mtx & 31; transpose_item<1>(a.in[I_W1] + (size_t)mtx * 1024 * 2048, 1024, 2048, (bf16*)(ws + WS_WTS + l * WL_STRIDE + WO_W1) + (size_t)e * 2048 * 1024, 1024, scr, r % IT_W1, lane); continue; } r -= N_W1;
            if (r < N_W2) { const int mtx = r / IT_W2, l = mtx >> 5, e = mtx & 31; transpose_item<0>(a.in[I_W2] + (size_t)mtx * 1024 * 1024, 1024, 1024, (bf16*)(ws + WS_WTS + l * WL_STRIDE + WO_W2) + (size_t)e * 1024 * 1024, 0, scr, r % IT_W2, lane); continue; } r -= N_W2;
            if (r < N_WIN) { const int l = r / IT_WIN; transpose_item<0>(a.in[I_WIN] + (size_t)l * 1024 * IN_COLS, 1024, IN_COLS, (bf16*)(ws + WS_WTS + l * WL_STRIDE + WO_WIN), 0, scr, r % IT_WIN, lane); continue; } r -= N_WIN;
            if (r < N_GLU) { const int l = r / IT_GLU; transpose_item<1>(a.in[I_S5GLUW] + (size_t)l * 512 * 1024, 512, 1024, (bf16*)(ws + WS_WTS + l * WL_STRIDE + WO_GLU), 512, scr, r % IT_GLU, lane); continue; } r -= N_GLU;
            if (r < N_WBR) { const int mtx = r / IT_WBR, l = mtx / 3, br = mtx % 3; transpose_item<0>(a.in[I_WBR] + (size_t)mtx * 512 * 1024, 512, 1024, (bf16*)(ws + WS_WTS + l * WL_STRIDE + WO_WBR) + (size_t)br * 1024 * 512, 0, scr, r % IT_WBR, lane); continue; } r -= N_WBR;
            { const int l = r / IT_WOUT; transpose_item<0>(a.in[I_WOUT] + (size_t)l * 1024 * 1024, 1024, 1024, (bf16*)(ws + WS_WTS + l * WL_STRIDE + WO_WOUT), 0, scr, r % IT_WOUT, lane); }
        }
        for (int i = F.bid * NTHREADS + F.tid; i < 2 * 2560 * 256; i += F.G * NTHREADS) {
            const int l = i / (2560 * 256), r = i % (2560 * 256), n = r >> 8, k = r & 255; float v = 0.f;
            if (n < 1024) { if (k < 64) v = a.in[I_RWWUP][(((size_t)l * 2 + (n >> 9)) * 64 + k) * 512 + (n & 511)]; }
            else if (n < 2048) { if (k >= 64 && k < 128) v = a.in[I_RWAUP][(((size_t)l * 2 + ((n - 1024) >> 9)) * 64 + (k - 64)) * 512 + (n & 511)]; }
            else { if (k >= 128) v = a.in[I_RWGUP][((size_t)l * 128 + (k - 128)) * 512 + (n - 2048)]; }
            ((bf16*)(ws + WS_WTS + l * WL_STRIDE + WO_RWCAT))[r] = (bf16)f2bf(v);
        }
    }
    __syncthreads();
    {
        LAS float* feats = (LAS float*)F.lds; LAS float* h1 = feats + 8 * 33; LAS float* h2 = h1 + 8 * 64;
        constexpr int NIT = 2 * (512 + 32);
        for (int it = F.bid; it < NIT; it += F.G) {
            const int l = it / 544, r = it % 544, nsel = r >= 512, n = nsel ? CTXL : SEQ, p0 = (nsel ? r - 512 : r) * 8;
            if (F.tid < 8 * 33) { const int p = F.tid / 33, i = F.tid % 33, pos = p0 + p; float f;
                if (i == 0) f = (float)pos / (float)(n - 1);
                else { const int k = (i - 1) & 15; const float band = 1e-4f + (float)k * ((15.0f - 1e-4f) / 15.0f); const float ang = (6.283185307179586f * (float)pos / (float)n) * band; f = (i <= 16) ? cosf(ang) : -sinf(ang); }
                feats[p * 33 + i] = f; }
            __syncthreads();
            { const int p = F.tid >> 6, j = F.tid & 63; float s = a.in[I_HYB1][l * 64 + j];
                for (int i = 0; i < 33; ++i) s += feats[p * 33 + i] * a.in[I_HYW1][((size_t)l * 33 + i) * 64 + j];
                h1[p * 64 + j] = sinf(a.in[I_HYF1][l * 64 + j] * s); }
            __syncthreads();
            { const int p = F.tid >> 6, j = F.tid & 63; float s = a.in[I_HYB2][l * 64 + j];
                for (int i = 0; i < 64; ++i) s += h1[p * 64 + i] * a.in[I_HYW2][((size_t)l * 64 + i) * 64 + j];
                h2[p * 64 + j] = sinf(a.in[I_HYF2][l * 64 + j] * s); }
            __syncthreads();
            float acc[4][8];
#pragma unroll
            for (int q = 0; q < 4; ++q)
#pragma unroll
                for (int p = 0; p < 8; ++p) acc[q][p] = 0.f;
            const float* w3 = a.in[I_HYW3] + (size_t)l * 64 * 2048 + F.tid;
            for (int i = 0; i < 64; ++i) { float wv[4];
#pragma unroll
                for (int q = 0; q < 4; ++q) wv[q] = w3[(size_t)i * 2048 + q * 512];
#pragma unroll
                for (int p = 0; p < 8; ++p) { const float hv = h2[p * 64 + i];
#pragma unroll
                    for (int q = 0; q < 4; ++q) acc[q][p] += hv * wv[q]; } }
            const int c = F.tid; const float dstart = logf(0.01f) / 1.5f, dstop = logf(0.01f) / 0.3f; const float delta = fabsf(dstart + (float)c * ((dstop - dstart) / 511.0f));
            const int RL = nsel ? HY_RLENC : HY_RLEN, off = n + 47;
            bf16* Rb = (bf16*)(ws + WS_GF + l * GF_STRIDE + (nsel ? GF_CTX : 0));
#pragma unroll
            for (int q = 0; q < 4; ++q) { const int o = q >> 1, side = q & 1; const float b3 = a.in[I_HYB3][l * 2048 + q * 512 + c];
                bf16* Rc = Rb + ((size_t)o * 512 + c) * RL;
#pragma unroll
                for (int p = 0; p < 8; ++p) { const int pos = p0 + p; const float t = (float)pos / (float)(n - 1); const float val = (acc[q][p] + b3) * expf(-t * delta);
                    if (side == 0) Rc[off - pos] = (bf16)f2bf(val);
                    else if (pos >= 1) Rc[off + pos] = (bf16)f2bf(val); }
                if (p0 == 0 && side == 0) { for (int m = 0; m < 48; ++m) Rc[m] = 0; for (int m = off + n; m < RL; ++m) Rc[m] = 0; } }
            __syncthreads();
        }
    }
}

__device__ __forceinline__ void stage_norm1(const Ctx& F, int l) {
    const auto& a = *F.a; unsigned char* ws = a.ws; const int lane = F.lane;
    const int gw = F.bid * NWAVES + F.wave, NGW = F.G * NWAVES;
    float* X = (float*)(ws + WS_X); bf16* H = (bf16*)(ws + WS_H); const float* MOD = (const float*)(ws + WS_MOD);
    const bf16* YS = (const bf16*)(ws + WS_XS); const int* POS = (const int*)(ws + WS_POS); const float* GATE = (const float*)(ws + WS_GATE);
    const int nrows = (l == DEPTH) ? T_LAT : T_ALL;
    for (int row = gw; row < nrows; row += NGW) {
        const int w = row < T_LAT ? (row >> 12) : 8;
        f32x4* xr = (f32x4*)(X + (size_t)row * D) + lane;
        f32x4 v[4];
#pragma unroll
        for (int j = 0; j < 4; ++j) v[j] = xr[64 * j];
        if (l > 0) {
            f32x4 mo[4];
#pragma unroll
            for (int j = 0; j < 4; ++j) mo[j] = (f32x4){0.f, 0.f, 0.f, 0.f};
#pragma unroll
            for (int k = 0; k < TOPK; ++k) { const int p = POS[row * 4 + k]; const float g = GATE[row * 4 + k];
                const v2u* yr = (const v2u*)(YS + (size_t)p * D) + lane;
#pragma unroll
                for (int j = 0; j < 4; ++j) { const v2u y = yr[64 * j]; mo[j][0] += g * bflo(y.x); mo[j][1] += g * bfhi(y.x); mo[j][2] += g * bflo(y.y); mo[j][3] += g * bfhi(y.y); } }
            const f32x4* g2 = (const f32x4*)(MOD + (size_t)((l - 1) * 9 + w) * 6144 + 5120) + lane;
#pragma unroll
            for (int j = 0; j < 4; ++j) { v[j] = v[j] + g2[64 * j] * mo[j]; xr[64 * j] = v[j]; }
        }
        float ss = 0.f;
#pragma unroll
        for (int j = 0; j < 4; ++j) ss += (v[j][0] * v[j][0] + v[j][1] * v[j][1]) + (v[j][2] * v[j][2] + v[j][3] * v[j][3]);
        const float rstd = 1.0f / sqrtf(wave_sum(ss) * (1.f / D) + 1e-6f);
        if (l == DEPTH) {
            const f32x4* fg = (const f32x4*)a.in[I_FING] + lane; f32x4* o = (f32x4*)(a.out + (size_t)row * D) + lane;
#pragma unroll
            for (int j = 0; j < 4; ++j) o[64 * j] = v[j] * rstd * fg[64 * j];
        } else {
            const f32x4* ng = (const f32x4*)(a.in[I_N1G] + l * D) + lane;
            const f32x4* sh = (const f32x4*)(MOD + (size_t)(l * 9 + w) * 6144) + lane; const f32x4* sc = (const f32x4*)(MOD + (size_t)(l * 9 + w) * 6144 + 1024) + lane;
            v2u* ho = (v2u*)(H + (size_t)row * D) + lane;
#pragma unroll
            for (int j = 0; j < 4; ++j) { const f32x4 h = v[j] * rstd * ng[64 * j] * (sc[64 * j] + 1.0f) + sh[64 * j]; v2u o; o.x = pk2(h[0], h[1]); o.y = pk2(h[2], h[3]); ho[64 * j] = o; }
        }
    }
}

__device__ __forceinline__ void stage_rw_prep1(const Ctx& F, int l) {
    const auto& a = *F.a; unsigned char* ws = a.ws;
    const bf16* Z = (const bf16*)(ws + WS_Z); bf16* ARW = (bf16*)(ws + WS_ARW);
    const int j = F.tid & 255, col = 1536 + j;
    const float* cw = a.in[I_RWCW] + (size_t)l * 3 * 1792; const float w0 = cw[col], w1 = cw[1792 + col], w2 = cw[2 * 1792 + col], cb = a.in[I_RWCB][l * 1792 + col];
    for (int row = F.bid * 2 + (F.tid >> 8); row < T_ALL; row += F.G * 2) {
        int base, pos, n; row_seq(row, base, pos, n);
        float v = conv3z(Z + (size_t)base * IN_COLS + RW_OFF + col, pos, n, w0, w1, w2, cb);
        if (j < 64) v = tanhf(v); else if (j >= 128) v = sigm(v);
        ARW[(size_t)row * 256 + j] = (bf16)f2bf(v);
    }
}

__device__ __forceinline__ void stage_rw_prep2(const Ctx& F, int l) {
    const auto& a = *F.a; unsigned char* ws = a.ws; const int lane = F.lane;
    const bf16* Z = (const bf16*)(ws + WS_Z); const bf16* P = (const bf16*)(ws + WS_P); bf16* SCN = (bf16*)(ws + WS_SCN);
    const int gw = F.bid * NWAVES + F.wave, NGW = F.G * NWAVES;
    const float* cw = a.in[I_RWCW] + (size_t)l * 3 * 1792; const float* cbp = a.in[I_RWCB] + l * 1792;
    for (int it = gw; it < T_ALL * 8; it += NGW) {
        const int row = it >> 3, h = it & 7, c = h * 64 + lane;
        int base, pos, n; row_seq(row, base, pos, n);
        const bf16* zb = Z + (size_t)base * IN_COLS + RW_OFF;
        const float r = conv3z(zb + c, pos, n, cw[c], cw[1792 + c], cw[2 * 1792 + c], cbp[c]);
        const float k = conv3z(zb + 512 + c, pos, n, cw[512 + c], cw[1792 + 512 + c], cw[2 * 1792 + 512 + c], cbp[512 + c]);
        const float v = conv3z(zb + 1024 + c, pos, n, cw[1024 + c], cw[1792 + 1024 + c], cw[2 * 1792 + 1024 + c], cbp[1024 + c]);
        float kk = k * a.in[I_RWKK][l * 512 + c];
        const float ss = wave_sum(kk * kk);
        kk = kk * (1.0f / sqrtf(fmaxf(ss, 1e-24f)));
        const bf16* pr = P + (size_t)row * 2560;
        const float ka = a.in[I_RWKA][l * 512 + c];
        bf16* o = SCN + (size_t)row * 9 * 512 + c;
        o[0] = (bf16)f2bf(r); o[512] = (bf16)f2bf(v); o[2 * 512] = (bf16)f2bf(kk);
#pragma unroll
        for (int d = 0; d < 2; ++d) {
            const float u = a.in[I_RWW0][(l * 2 + d) * 512 + c] + bf2f(pr[d * 512 + c]);
            const float sp = fmaxf(-u, 0.f) + log1pf(expf(-fabsf(u)));
            const float w = -sp - 0.5f;
            const float ld = -expf(w);
            const float av = sigm(a.in[I_RWA0][(l * 2 + d) * 512 + c] + bf2f(pr[1024 + d * 512 + c]));
            const float kd = k * (1.f + (av - 1.f) * ka);
            o[(3 + 3 * d) * 512] = (bf16)f2bf(ld); o[(4 + 3 * d) * 512] = (bf16)f2bf(kd); o[(5 + 3 * d) * 512] = (bf16)f2bf(kk * av);
        }
    }
}

__device__ __forceinline__ int seq_row(int b, int d, int sidx) {
    if (sidx < CTXL) { const int t = d ? (CTXL - 1 - sidx) : sidx; return T_LAT + b * CTXL + t; }
    const int tl = sidx - CTXL; const int t = d ? (SEQ - 1 - tl) : tl; return b * SEQ + t;
}

__device__ __forceinline__ float dpp_f(float x, const int ctrl_sel) {
    const int v = __builtin_bit_cast(int, x);
    int r;
    if (ctrl_sel == 0) r = __builtin_amdgcn_update_dpp(0, v, 0xB1, 0xF, 0xF, true);
    else if (ctrl_sel == 1) r = __builtin_amdgcn_update_dpp(0, v, 0x4E, 0xF, 0xF, true);
    else r = __builtin_amdgcn_update_dpp(0, v, 0x141, 0xF, 0xF, true);
    return __builtin_bit_cast(float, r);
}
__device__ __forceinline__ float red8(float x) { x += dpp_f(x, 0); x += dpp_f(x, 1); x += dpp_f(x, 2); return x; }
constexpr int CW_WORK = 16384;
__device__ __forceinline__ void rw_scan_item(const Ctx& F, int l, int it) {
    const auto& a = *F.a; unsigned char* ws = a.ws; const int tid = F.tid, lane = F.lane;
    const bf16* SCN = (const bf16*)(ws + WS_SCN); float* YD = (float*)(ws + WS_YDIR);
    LAS float* sbuf = (LAS float*)F.lds;
    LAS float* ybuf = (LAS float*)(F.lds + 49152);
    const int ls = tid >> 5, lj = tid & 31;
    const int vl = lane >> 3, kq = lane & 7, vrow = F.wave * 8 + vl;
    constexpr int NCH = (CTXL + SEQ) / 16;
    const int d = it & 1, h = (it >> 1) & 7, b = it >> 4;
    f32x2 S[4];
#pragma unroll
    for (int q = 0; q < 4; ++q) S[q] = (f32x2){0.f, 0.f};
    unsigned ldr[6];
#define RW_ISSUE(c) do { const int row_ = seq_row(b, d, (c) * 16 + ls); const unsigned* p_ = (const unsigned*)(SCN + (size_t)row_ * 9 * 512 + h * 64) + lj; \
        ldr[0] = p_[2 * 256]; ldr[1] = p_[(3 + 3 * d) * 256]; ldr[2] = p_[(5 + 3 * d) * 256]; ldr[3] = p_[(4 + 3 * d) * 256]; ldr[4] = p_[0]; ldr[5] = p_[256]; } while (0)
#define RW_WRITE(bufi) do { LAS float* o_ = sbuf + (((bufi) * 16 + ls) * 6) * 64 + 2 * lj; \
        *(LAS f32x2*)(o_) = (f32x2){-bflo(ldr[0]), -bfhi(ldr[0])}; *(LAS f32x2*)(o_ + 64) = (f32x2){__expf(bflo(ldr[1])), __expf(bfhi(ldr[1]))}; \
        *(LAS f32x2*)(o_ + 128) = (f32x2){bflo(ldr[2]), bfhi(ldr[2])}; *(LAS f32x2*)(o_ + 192) = (f32x2){bflo(ldr[3]), bfhi(ldr[3])}; \
        *(LAS f32x2*)(o_ + 256) = (f32x2){bflo(ldr[4]), bfhi(ldr[4])}; *(LAS f32x2*)(o_ + 320) = (f32x2){bflo(ldr[5]), bfhi(ldr[5])}; } while (0)
#define RW_FLUSH(c) do { const int row_ = seq_row(b, d, (c) * 16 + ls); \
        *(f32x2*)(YD + ((size_t)d * T_ALL + row_) * 512 + h * 64 + 2 * lj) = *(const LAS f32x2*)(ybuf + ((((c) & 1) * 16 + ls) * 64) + 2 * lj); } while (0)
    RW_ISSUE(0); RW_WRITE(0);
    __syncthreads();
#pragma unroll 1
    for (int c = 0; c < NCH; ++c) {
        const int bi = c & 1;
        if (c + 1 < NCH) RW_ISSUE(c + 1);
        if (c > 0) RW_FLUSH(c - 1);
#pragma unroll 4
        for (int s = 0; s < 16; ++s) {
            const LAS float* sp = sbuf + ((bi * 16 + s) * 6) * 64 + 8 * kq;
            const f32x4 a0 = *(const LAS f32x4*)(sp), a1 = *(const LAS f32x4*)(sp + 4);
            const f32x4 w0 = *(const LAS f32x4*)(sp + 64), w1 = *(const LAS f32x4*)(sp + 68);
            const f32x4 b0 = *(const LAS f32x4*)(sp + 128), b1 = *(const LAS f32x4*)(sp + 132);
            const f32x4 k0 = *(const LAS f32x4*)(sp + 192), k1 = *(const LAS f32x4*)(sp + 196);
            const f32x4 r0 = *(const LAS f32x4*)(sp + 256), r1 = *(const LAS f32x4*)(sp + 260);
            const float vv = sbuf[((bi * 16 + s) * 6 + 5) * 64 + vrow];
            f32x2 ac = S[0] * (f32x2){a0[0], a0[1]} + S[1] * (f32x2){a0[2], a0[3]} + S[2] * (f32x2){a1[0], a1[1]} + S[3] * (f32x2){a1[2], a1[3]};
            const float sa = red8(ac[0] + ac[1]);
            const f32x2 sa2 = (f32x2){sa, sa}, vv2 = (f32x2){vv, vv};
            S[0] = S[0] * (f32x2){w0[0], w0[1]} + (sa2 * (f32x2){b0[0], b0[1]} + vv2 * (f32x2){k0[0], k0[1]});
            S[1] = S[1] * (f32x2){w0[2], w0[3]} + (sa2 * (f32x2){b0[2], b0[3]} + vv2 * (f32x2){k0[2], k0[3]});
            S[2] = S[2] * (f32x2){w1[0], w1[1]} + (sa2 * (f32x2){b1[0], b1[1]} + vv2 * (f32x2){k1[0], k1[1]});
            S[3] = S[3] * (f32x2){w1[2], w1[3]} + (sa2 * (f32x2){b1[2], b1[3]} + vv2 * (f32x2){k1[2], k1[3]});
            f32x2 yc = S[0] * (f32x2){r0[0], r0[1]} + S[1] * (f32x2){r0[2], r0[3]} + S[2] * (f32x2){r1[0], r1[1]} + S[3] * (f32x2){r1[2], r1[3]};
            const float y = red8(yc[0] + yc[1]);
            if (kq == 0) ybuf[((bi * 16 + s) * 64) + vrow] = y;
        }
        if (c + 1 < NCH) RW_WRITE(bi ^ 1);
        __syncthreads();
    }
    RW_FLUSH(NCH - 1);
    __syncthreads();
#undef RW_ISSUE
#undef RW_WRITE
#undef RW_FLUSH
}

__device__ __forceinline__ void stage_rw_readout(const Ctx& F, int l) {
    const auto& a = *F.a; unsigned char* ws = a.ws; const int lane = F.lane;
    const bf16* SCN = (const bf16*)(ws + WS_SCN); const bf16* P = (const bf16*)(ws + WS_P); const float* YD = (const float*)(ws + WS_YDIR); bf16* YRW = (bf16*)(ws + WS_YRW);
    const int gw = F.bid * NWAVES + F.wave, NGW = F.G * NWAVES;
    for (int it = gw; it < T_ALL * 8; it += NGW) {
        const int row = it >> 3, h = it & 7, c = h * 64 + lane;
        const bf16* p = SCN + (size_t)row * 9 * 512 + c;
        const float r = bf2f(p[0]), v = bf2f(p[512]), kd0 = bf2f(p[4 * 512]), kd1 = bf2f(p[7 * 512]);
        const float bon = wave_sum(r * (kd0 + kd1) * a.in[I_RWRK][l * 512 + c]);
        float y = YD[(size_t)row * 512 + c] + YD[((size_t)T_ALL + row) * 512 + c] + bon * v;
        const float mu = wave_sum(y) * (1.f / 64.f); const float dv = y - mu; const float var = wave_sum(dv * dv) * (1.f / 64.f);
        const float yn = dv * (1.0f / sqrtf(var + 64e-5f));
        const float g = bf2f(P[(size_t)row * 2560 + 2048 + c]);
        YRW[(size_t)row * 512 + c] = (bf16)f2bf((yn * a.in[I_RWLNG][l * 512 + c] + a.in[I_RWLNB][l * 512 + c]) * g);
    }
}

__device__ __forceinline__ void stage_s5_scan(const Ctx& F, int l) {
    const auto& a = *F.a; unsigned char* ws = a.ws; const int lane = F.lane;
    const bf16* Z = (const bf16*)(ws + WS_Z); float* YP = (float*)(ws + WS_YP);
    LAS float* wl = (LAS float*)(F.lds + F.wave * 16384);
    LAS float* cbuf = wl;
    LAS float* hbuf = wl + 2048;
    LAS float* ubuf = wl + 2048 + 1040;
    for (int it = F.wave * F.G + F.bid; it < BATCH * 32 * 2; it += NWAVES * F.G) {
        const int d = it & 1, g = (it >> 1) & 31, b = it >> 6, p = lane;
        const size_t gi = ((size_t)(l * 2 + d) * 32 + g) * 64 + p;
        const float are = a.in[I_S5ARE][gi], aim = a.in[I_S5AIM][gi], dt = expf(a.in[I_S5LDT][(l * 2 + d) * 32 + g]);
        const float mag = expf(are * dt), lbr = mag * cosf(aim * dt), lbi = mag * sinf(aim * dt);
        const float den = are * are + aim * aim, nr = lbr - 1.0f, cr = (nr * are + lbi * aim) / den, ci = (lbi * are - nr * aim) / den;
        float bbr[16], bbi[16];
        { const float* br = a.in[I_S5BRE] + (((size_t)l * 32 + g) * 64 + p) * 16; const float* bi = a.in[I_S5BIM] + (((size_t)l * 32 + g) * 64 + p) * 16;
#pragma unroll
          for (int h = 0; h < 16; ++h) { const float x = br[h], y = bi[h]; bbr[h] = cr * x - ci * y; bbi[h] = cr * y + ci * x; } }
#pragma unroll
        for (int h = 0; h < 16; ++h) { const size_t ci2 = (((size_t)l * 32 + g) * 16 + h) * 64 + p; cbuf[(p * 16 + h) * 2] = a.in[I_S5CRE][ci2]; cbuf[(p * 16 + h) * 2 + 1] = a.in[I_S5CIM][ci2]; }
        float hr = 0.f, hi = 0.f;
        for (int s0 = 0; s0 < CTXL + SEQ; s0 += 8) {
            if (lane < 16) { const int s = lane >> 1, half = lane & 1; const int row = seq_row(b, d, s0 + s);
                const v4u uu = *(const v4u*)(Z + (size_t)row * IN_COLS + S5_OFF + g * 16 + half * 8);
                LAS float* up = ubuf + s * 16 + half * 8;
                up[0] = bflo(uu.x); up[1] = bfhi(uu.x); up[2] = bflo(uu.y); up[3] = bfhi(uu.y); up[4] = bflo(uu.z); up[5] = bfhi(uu.z); up[6] = bflo(uu.w); up[7] = bfhi(uu.w); }
            LDS_WAIT(); asm volatile("" ::: "memory");
#pragma unroll 4
            for (int s = 0; s < 8; ++s) {
                float br_ = 0.f, bi_ = 0.f;
#pragma unroll
                for (int q = 0; q < 4; ++q) { const f32x4 u4 = *(const LAS f32x4*)(ubuf + s * 16 + 4 * q);
#pragma unroll
                    for (int j = 0; j < 4; ++j) { br_ += u4[j] * bbr[4 * q + j]; bi_ += u4[j] * bbi[4 * q + j]; } }
                const float nhr = lbr * hr - lbi * hi + br_, nhi = lbr * hi + lbi * hr + bi_;
                hr = nhr; hi = nhi;
                *(LAS f32x2*)(hbuf + s * 130 + 2 * p) = (f32x2){hr, hi};
            }
            LDS_WAIT(); asm volatile("" ::: "memory");
            { const int s = lane >> 3, hq = lane & 7;
              float acc0 = 0.f, acc1 = 0.f;
#pragma unroll 8
              for (int pp = 0; pp < 64; ++pp) { const f32x2 hv = *(const LAS f32x2*)(hbuf + s * 130 + 2 * pp);
                  const f32x4 c0 = *(const LAS f32x4*)(cbuf + (pp * 16 + 2 * hq) * 2);
                  acc0 += hv.x * c0[0] - hv.y * c0[1]; acc1 += hv.x * c0[2] - hv.y * c0[3]; }
              const int row = seq_row(b, d, s0 + s);
              *(f32x2*)(YP + ((size_t)d * T_ALL + row) * 512 + g * 16 + 2 * hq) = (f32x2){acc0, acc1}; }
            LDS_WAIT(); asm volatile("" ::: "memory");
        }
    }
}

__device__ __forceinline__ void stage_s5_prep(const Ctx& F, int l) {
    const auto& a = *F.a; unsigned char* ws = a.ws;
    const bf16* Z = (const bf16*)(ws + WS_Z); const float* YP = (const float*)(ws + WS_YP); bf16* AS5 = (bf16*)(ws + WS_AS5);
    const float dsk = a.in[I_S5D][l * 512 + F.tid];
    for (int row = F.bid; row < T_ALL; row += F.G) {
        const int c = F.tid;
        const float u = bf2f(Z[(size_t)row * IN_COLS + S5_OFF + c]);
        const float y = YP[(size_t)row * 512 + c] + YP[((size_t)T_ALL + row) * 512 + c] + u * dsk;
        const float ge = 0.5f * y * (1.f + tanhf(0.7978845608028654f * (y + 0.044715f * y * y * y)));
        AS5[(size_t)row * 512 + c] = (bf16)f2bf(ge);
    }
}

__device__ __forceinline__ void stage_hy_pre(const Ctx& F, int l) {
    const auto& a = *F.a; unsigned char* ws = a.ws; const int lane = F.lane;
    const bf16* Z = (const bf16*)(ws + WS_Z); bf16* UT = (bf16*)(ws + WS_UT);
    LAS bf16* tl = (LAS bf16*)(F.lds + 32768 + F.wave * 8448);
    const float* cw = a.in[I_HYCW] + (size_t)l * 3 * 1536; const float* cbp = a.in[I_HYCB] + l * 1536;
    const int gw = F.bid * NWAVES + F.wave, NGW = F.G * NWAVES;
    for (int tile = gw; tile < (T_ALL / 64) * 24; tile += NGW) {
        const int rt = tile / 24, ct = tile % 24, row0 = rt * 64, col = ct * 64 + lane;
        int base, pos0, n; row_seq(row0, base, pos0, n);
        const bf16* zc = Z + (size_t)base * IN_COLS + HY_OFF + col;
        const float w0 = cw[col], w1 = cw[1536 + col], w2 = cw[2 * 1536 + col], cb = cbp[col];
        float zm = pos0 > 0 ? bf2f(zc[(size_t)(pos0 - 1) * IN_COLS]) : 0.f, z0 = bf2f(zc[(size_t)pos0 * IN_COLS]);
#pragma unroll 8
        for (int r = 0; r < 64; ++r) { const float zp = (pos0 + r + 1 < n) ? bf2f(zc[(size_t)(pos0 + r + 1) * IN_COLS]) : 0.f;
            tl[lane * 66 + r] = (bf16)f2bf(w0 * zm + w1 * z0 + w2 * zp + cb); zm = z0; z0 = zp; }
        LDS_WAIT(); asm volatile("" ::: "memory");
        bf16* up = UT + (size_t)(ct * 64) * T_ALL + row0 + lane;
#pragma unroll 8
        for (int cc = 0; cc < 64; ++cc) up[(size_t)cc * T_ALL] = tl[cc * 66 + lane];
        LDS_WAIT(); asm volatile("" ::: "memory");
    }
}
__device__ __forceinline__ void stage_hy_post(const Ctx& F, int l) {
    const auto& a = *F.a; unsigned char* ws = a.ws; const int lane = F.lane;
    const bf16* YT = (const bf16*)(ws + WS_UT) + (size_t)1024 * T_ALL; bf16* YHY = (bf16*)(ws + WS_YHY);
    LAS bf16* tl = (LAS bf16*)(F.lds + F.wave * 8448);
    const int gw = F.bid * NWAVES + F.wave, NGW = F.G * NWAVES;
    for (int tile = gw; tile < (T_ALL / 64) * 8; tile += NGW) {
        const int rt = tile >> 3, ct = tile & 7, row0 = rt * 64, c0 = ct * 64;
        const bf16* yp = YT + (size_t)c0 * T_ALL + row0 + lane;
#pragma unroll 8
        for (int cc = 0; cc < 64; ++cc) tl[cc * 66 + lane] = yp[(size_t)cc * T_ALL];
        LDS_WAIT(); asm volatile("" ::: "memory");
        bf16* op = YHY + (size_t)row0 * 512 + c0 + lane;
#pragma unroll 8
        for (int r = 0; r < 64; ++r) op[(size_t)r * 512] = tl[lane * 66 + r];
        LDS_WAIT(); asm volatile("" ::: "memory");
    }
}
typedef float f32x16 __attribute__((ext_vector_type(16)));
__device__ __forceinline__ void hyena_item(const Ctx& F, int l, int c, int isctx) {
    const auto& a = *F.a; unsigned char* ws = a.ws; const int tid = F.tid, lane = F.lane;
    const int n = isctx ? CTXL : SEQ, rowbase = isctx ? T_LAT : 0, RL = isctx ? HY_RLENC : HY_RLEN, off = n + 47;
    const bf16* UT = (const bf16*)(ws + WS_UT);
    const bf16* x1g = UT + (size_t)c * T_ALL + rowbase; const bf16* x2g = UT + (size_t)(512 + c) * T_ALL + rowbase; bf16* vg = (bf16*)UT + (size_t)(1024 + c) * T_ALL + rowbase;
    const bf16* Rg = (const bf16*)(ws + WS_GF + l * GF_STRIDE + (isctx ? GF_CTX : 0)) + (size_t)c * RL;
    LAS unsigned char* XB = F.lds; LAS unsigned char* R1 = F.lds + HY_R1_OFF; LAS unsigned char* R2 = F.lds + HY_R2_OFF;
    { const int cpb = n / 8;
      for (int q = tid; q < 8 * cpb; q += NTHREADS) { const int b = q / cpb, ch = q % cpb; *(LAS v4u*)(XB + b * HY_ROWB + 2 * HY_MARG + 16 * ch) = *(const v4u*)(vg + (size_t)b * n + 8 * ch); }
      if (tid < 256) { const int b = tid >> 5, side = (tid >> 4) & 1, ch = tid & 15; *(LAS v4u*)(XB + b * HY_ROWB + (side ? 2 * (HY_MARG + n) : 0) + 16 * ch) = (v4u){0u, 0u, 0u, 0u}; }
      const int rch = RL / 8;
      for (int q = tid; q < rch; q += NTHREADS) { *(LAS v4u*)(R1 + 16 * q) = *(const v4u*)(Rg + 8 * q); *(LAS v4u*)(R2 + 16 * q) = *(const v4u*)(Rg + (size_t)512 * RL + 8 * q); } }
    __syncthreads();
    const int i = lane & 31, kg = lane >> 5, jb = lane & 3, bb = (lane & 31) >> 2;
    const int rsh = (off - i) & 7, rd = rsh >> 1; const bool s1 = rd & 1, s2 = rd & 2; const unsigned sh = (rsh & 1) ? 16u : 0u;
    const int aconst = 2 * (off - i + 8 * kg - rsh), bconst = bb * HY_ROWB + 2 * (HY_MARG + 32 * jb + 8 * kg);
    const int T0w = 512 * F.wave; const int ntile = (n - T0w) >= 512 ? 4 : ((n - T0w) > 0 ? (n - T0w) / 128 : 0);
    const float bias0 = a.in[I_HYBIAS][(l * 2 + 0) * 512 + c], bias1 = a.in[I_HYBIAS][(l * 2 + 1) * 512 + c];
    f32x16 acc[4];
    v2u y1p[4][4];
#define HY_CONV(RB) do { \
        _Pragma("unroll") for (int m = 0; m < 4; ++m) _Pragma("unroll") for (int e = 0; e < 16; ++e) acc[m][e] = 0.f; \
        if (ntile > 0) { const int dhi = T0w + 128 * (ntile - 1) + 96; \
            _Pragma("unroll 1") for (int d = T0w - n + 16; d <= dhi; d += 16) { \
                const v4u wa = *(const LAS v4u*)((RB) + aconst - 2 * d), wb = *(const LAS v4u*)((RB) + aconst - 2 * d + 16); \
                const unsigned a0 = s1 ? wa.y : wa.x, a1 = s1 ? wa.z : wa.y, a2 = s1 ? wa.w : wa.z, a3 = s1 ? wb.x : wa.w, a4 = s1 ? wb.y : wb.x, a5 = s1 ? wb.z : wb.y, a6 = s1 ? wb.w : wb.z; \
                const unsigned b0 = s2 ? a2 : a0, b1 = s2 ? a3 : a1, b2 = s2 ? a4 : a2, b3 = s2 ? a5 : a3, b4 = s2 ? a6 : a4; \
                v4u af; af.x = __builtin_amdgcn_alignbit(b1, b0, sh); af.y = __builtin_amdgcn_alignbit(b2, b1, sh); af.z = __builtin_amdgcn_alignbit(b3, b2, sh); af.w = __builtin_amdgcn_alignbit(b4, b3, sh); \
                const bf16x8 afr = __builtin_bit_cast(bf16x8, af); \
                _Pragma("unroll") for (int m = 0; m < 4; ++m) { const int T0 = T0w + 128 * m; \
                    if (m < ntile && d >= T0 - n + 16 && d <= T0 + 96) { const bf16x8 bfr = *(const LAS bf16x8*)(XB + bconst + 2 * (T0 - d)); \
                        acc[m] = __builtin_amdgcn_mfma_f32_32x32x16_bf16(afr, bfr, acc[m], 0, 0, 0); } } } } } while (0)
    HY_CONV(R1);
#pragma unroll
    for (int m = 0; m < 4; ++m) if (m < ntile) {
#pragma unroll
        for (int rg = 0; rg < 4; ++rg) { const int t4 = T0w + 128 * m + 32 * jb + 8 * rg + 4 * kg;
            const v2u xv = *(const v2u*)(x1g + (size_t)bb * n + t4); const v2u vv = *(const LAS v2u*)(XB + bb * HY_ROWB + 2 * (HY_MARG + t4));
            const float y0 = bflo(xv.x) * (acc[m][4 * rg + 0] + bias0 * bflo(vv.x)), y1 = bfhi(xv.x) * (acc[m][4 * rg + 1] + bias0 * bfhi(vv.x));
            const float y2 = bflo(xv.y) * (acc[m][4 * rg + 2] + bias0 * bflo(vv.y)), y3 = bfhi(xv.y) * (acc[m][4 * rg + 3] + bias0 * bfhi(vv.y));
            y1p[m][rg].x = pk2(y0, y1); y1p[m][rg].y = pk2(y2, y3); } }
    __syncthreads();
#pragma unroll
    for (int m = 0; m < 4; ++m) if (m < ntile) {
#pragma unroll
        for (int rg = 0; rg < 4; ++rg) { const int t4 = T0w + 128 * m + 32 * jb + 8 * rg + 4 * kg; *(LAS v2u*)(XB + bb * HY_ROWB + 2 * (HY_MARG + t4)) = y1p[m][rg]; } }
    __syncthreads();
    HY_CONV(R2);
#pragma unroll
    for (int m = 0; m < 4; ++m) if (m < ntile) {
#pragma unroll
        for (int rg = 0; rg < 4; ++rg) { const int t4 = T0w + 128 * m + 32 * jb + 8 * rg + 4 * kg;
            const v2u xv = *(const v2u*)(x2g + (size_t)bb * n + t4); const v2u yv = y1p[m][rg];
            const float o0 = bflo(xv.x) * (acc[m][4 * rg + 0] + bias1 * bflo(yv.x)), o1 = bfhi(xv.x) * (acc[m][4 * rg + 1] + bias1 * bfhi(yv.x));
            const float o2 = bflo(xv.y) * (acc[m][4 * rg + 2] + bias1 * bflo(yv.y)), o3 = bfhi(xv.y) * (acc[m][4 * rg + 3] + bias1 * bfhi(yv.y));
            v2u ov; ov.x = pk2(o0, o1); ov.y = pk2(o2, o3); *(v2u*)(vg + (size_t)bb * n + t4) = ov; } }
    __syncthreads();
#undef HY_CONV
}
__device__ __forceinline__ void stage_mixer(const Ctx& F, int l) {
    unsigned* ctr = (unsigned*)(F.a->ws + WS_CTL) + CW_WORK + 64 * l;
    LAS int* itb = (LAS int*)(F.lds + LDSCTL_OFF + 512);
    const int nit = 128 + 512 + (l == 0 ? 512 : 0);
#ifdef PROBE_STATIC
    if (F.bid < 128) { for (int it = F.bid; it < 128; it += 128) rw_scan_item(F, l, it); }
    else { for (int it = 128 + (F.bid - 128); it < nit; it += F.G - 128) { if (it < 640) hyena_item(F, l, it - 128, 0); else hyena_item(F, l, it - 640, 1); } }
    return;
#endif
    for (;;) {
        if (F.tid == 0) *itb = (int)__hip_atomic_fetch_add(ctr, 1u, __ATOMIC_RELAXED, __HIP_MEMORY_SCOPE_AGENT);
        __syncthreads();
        const int it = *itb;
        __syncthreads();
        if (it >= nit) break;
        if (it < 128) rw_scan_item(F, l, it);
        else if (it < 640) hyena_item(F, l, it - 128, 0);
        else hyena_item(F, l, it - 640, 1);
    }
}

__device__ __forceinline__ void stage_norm2_router(const Ctx& F, int l) {
    const auto& a = *F.a; unsigned char* ws = a.ws; const int lane = F.lane;
    const float* X = (const float*)(ws + WS_X); bf16* H = (bf16*)(ws + WS_H); const float* MOD = (const float*)(ws + WS_MOD);
    int* EIDX = (int*)(ws + WS_EIDX); float* GATE = (float*)(ws + WS_GATE); int* BLKCNT = (int*)(ws + WS_BLKCNT);
    LAS float* hb = (LAS float*)(F.lds + F.wave * 4096);
    LAS int* hist = (LAS int*)(F.lds + 32768);
    if (F.tid < 32) hist[F.tid] = 0;
    __syncthreads();
    const int rpb = (T_ALL + F.G - 1) / F.G, r0 = F.bid * rpb, r1 = (r0 + rpb < T_ALL) ? r0 + rpb : T_ALL;
    const float* rw = a.in[I_RTW] + (size_t)l * 1024 * 32;
    for (int row = r0 + F.wave; row < r1; row += NWAVES) {
        const int w = row < T_LAT ? (row >> 12) : 8;
        const f32x4* xr = (const f32x4*)(X + (size_t)row * D) + lane;
        f32x4 v[4];
#pragma unroll
        for (int j = 0; j < 4; ++j) v[j] = xr[64 * j];
        float ss = 0.f;
#pragma unroll
        for (int j = 0; j < 4; ++j) ss += (v[j][0] * v[j][0] + v[j][1] * v[j][1]) + (v[j][2] * v[j][2] + v[j][3] * v[j][3]);
        const float rstd = 1.0f / sqrtf(wave_sum(ss) * (1.f / D) + 1e-6f);
        const f32x4* ng = (const f32x4*)(a.in[I_N2G] + l * D) + lane;
        const f32x4* sh = (const f32x4*)(MOD + (size_t)(l * 9 + w) * 6144 + 3072) + lane; const f32x4* sc = (const f32x4*)(MOD + (size_t)(l * 9 + w) * 6144 + 4096) + lane;
        v2u* ho = (v2u*)(H + (size_t)row * D) + lane;
#pragma unroll
        for (int j = 0; j < 4; ++j) { const f32x4 h = v[j] * rstd * ng[64 * j] * (sc[64 * j] + 1.0f) + sh[64 * j]; v2u o; o.x = pk2(h[0], h[1]); o.y = pk2(h[2], h[3]); ho[64 * j] = o;
            *(LAS f32x4*)(hb + 4 * lane + 256 * j) = h; }
        LDS_WAIT(); asm volatile("" ::: "memory");
        const int e = lane & 31, half = lane >> 5;
        float acc = 0.f; const float* rp = rw + (size_t)(half * 512) * 32 + e; const LAS float* hp = hb + half * 512;
#pragma unroll 8
        for (int k = 0; k < 512; ++k) acc += hp[k] * rp[(size_t)k * 32];
        acc += __shfl_xor(acc, 32);
        const float logit = acc + a.in[I_RTB][l * 32 + e];
        float val = lane < 32 ? logit : -INFINITY; const int idx = e;
        float tv[4]; int ti[4];
#pragma unroll
        for (int r = 0; r < 4; ++r) { float bv = val; int bi = idx;
#pragma unroll
            for (int o = 1; o < 64; o <<= 1) { const float ov = __shfl_xor(bv, o); const int oi = __shfl_xor(bi, o); if (ov > bv || (ov == bv && oi < bi)) { bv = ov; bi = oi; } }
            tv[r] = bv; ti[r] = bi; if (lane == bi) val = -INFINITY; }
        if (lane == 0) { const float e1 = expf(tv[1] - tv[0]), e2 = expf(tv[2] - tv[0]), e3 = expf(tv[3] - tv[0]); const float inv = 1.0f / (1.0f + e1 + e2 + e3);
            *(int4*)(EIDX + row * 4) = make_int4(ti[0], ti[1], ti[2], ti[3]); *(f32x4*)(GATE + row * 4) = (f32x4){inv, e1 * inv, e2 * inv, e3 * inv};
            __hip_atomic_fetch_add(&hist[ti[0]], 1, __ATOMIC_RELAXED, __HIP_MEMORY_SCOPE_WORKGROUP); __hip_atomic_fetch_add(&hist[ti[1]], 1, __ATOMIC_RELAXED, __HIP_MEMORY_SCOPE_WORKGROUP); __hip_atomic_fetch_add(&hist[ti[2]], 1, __ATOMIC_RELAXED, __HIP_MEMORY_SCOPE_WORKGROUP); __hip_atomic_fetch_add(&hist[ti[3]], 1, __ATOMIC_RELAXED, __HIP_MEMORY_SCOPE_WORKGROUP); }
        LDS_WAIT(); asm volatile("" ::: "memory");
    }
    __syncthreads();
    if (F.tid < 32) BLKCNT[F.bid * 32 + F.tid] = hist[F.tid];
    __syncthreads();
}

__device__ __forceinline__ void stage_moe_scatter(const Ctx& F, int l) {
    const auto& a = *F.a; unsigned char* ws = a.ws; const int lane = F.lane;
    const bf16* H = (const bf16*)(ws + WS_H); bf16* XS = (bf16*)(ws + WS_XS);
    const int* EIDX = (const int*)(ws + WS_EIDX); int* POS = (int*)(ws + WS_POS); const int* BLKCNT = (const int*)(ws + WS_BLKCNT); int* META = (int*)(ws + WS_META);
    LAS int* tot = (LAS int*)F.lds; LAS int* off = tot + 32; LAS int* base = tot + 64; LAS int* posl = tot + 128; LAS int* eloc = tot + 4096;
    const int rpb = (T_ALL + F.G - 1) / F.G, r0 = F.bid * rpb, r1 = (r0 + rpb < T_ALL) ? r0 + rpb : T_ALL; const int na = (r1 > r0) ? (r1 - r0) * 4 : 0;
    for (int i = F.tid; i < na; i += NTHREADS) eloc[i] = EIDX[r0 * 4 + i];
    { LAS int* part = tot + 8192; const int e = F.tid & 31, pt = F.tid >> 5; int t = 0, o = 0;
      for (int b2 = pt; b2 < F.G; b2 += 16) { const int c = BLKCNT[b2 * 32 + e]; t += c; o += (b2 < F.bid) ? c : 0; }
      part[pt * 32 + e] = t; part[512 + pt * 32 + e] = o; }
    __syncthreads();
    if (F.tid < 32) { LAS int* part = tot + 8192; int t = 0, o = 0;
#pragma unroll
        for (int pt = 0; pt < 16; ++pt) { t += part[pt * 32 + F.tid]; o += part[512 + pt * 32 + F.tid]; }
        tot[F.tid] = t; off[F.tid] = o; }
    __syncthreads();
    if (F.tid == 0) { int acc = 0; for (int e = 0; e < 32; ++e) { base[e] = acc; acc += (tot[e] + 255) & ~255; } base[32] = acc; }
    __syncthreads();
    if (F.bid == 0 && F.tid < 33) META[F.tid] = base[F.tid];
    if (F.tid < 32) { int run = base[F.tid] + off[F.tid]; for (int i = 0; i < na; ++i) { if (eloc[i] == F.tid) { posl[i] = run; POS[r0 * 4 + i] = run; ++run; } } }
    __syncthreads();
    for (int i = F.wave; i < na; i += NWAVES) { const int row = r0 + (i >> 2); const int p = posl[i];
        const v4u* s = (const v4u*)(H + (size_t)row * D) + lane; v4u* dp = (v4u*)(XS + (size_t)p * D) + lane;
        dp[0] = s[0]; dp[64] = s[64]; }
    __syncthreads();
}
__device__ __forceinline__ LAS int* load_moe_base(const Ctx& F) {
    LAS int* base = (LAS int*)(F.lds + LDSCTL_OFF + 256);
    const int* META = (const int*)(F.a->ws + WS_META);
    if (F.tid < 33) base[F.tid] = META[F.tid];
    __syncthreads();
    return base;
}

constexpr int NSTAGE_L = 13, NSTAGES = 1 + DEPTH * NSTAGE_L + 1;
__global__ void __launch_bounds__(NTHREADS, 2) mk_fwd(Args args) {
    extern __shared__ __attribute__((aligned(16))) unsigned char lds_raw[];
    Ctx F; F.a = kargs(); F.lds = (LAS unsigned char*)lds_raw; F.tid = threadIdx.x; F.lane = F.tid & 63; F.wave = __builtin_amdgcn_readfirstlane(F.tid >> 6); F.bid = blockIdx.x; F.G = gridDim.x;
    volatile LAS unsigned* MISC = (volatile LAS unsigned*)(F.lds + LDSCTL_OFF);
    for (int u = F.tid; u < (LDS_BYTES - LDSCTL_OFF) / 4; u += NTHREADS) ((LAS unsigned*)(F.lds + LDSCTL_OFF))[u] = 0u;
    __syncthreads();
#if MK_PER_STAGE
#define GRID_BAR() do { } while (0)
#else
    XcdBarrier bar = xcd_barrier_post((unsigned*)(F.a->ws + WS_CTL) + CW_BAR, MISC + 8);
#define GRID_BAR() xcd_barrier(bar)
#endif
#ifndef ONLY_S
#define ONLY_S -1
#endif
#define STG_SEL(k) (ONLY_S < 0 || ONLY_S == (((k) == 0) ? 0 : ((k) == NSTAGES - 1 ? 14 : (((k) - 1) % NSTAGE_L) + 1)))
#if MK_PER_STAGE
#define IN(k) (STG_SEL(k) && kargs()->ph_lo == (k))
#else
#define IN(k) STG_SEL(k)
#endif
#if MK_PER_STAGE
#define SEAM(k) do { } while (0)
#else
#define SEAM(k) do { if ((k) + 1 < NSTAGES) GRID_BAR(); } while (0)
#endif
#define STAGE(k) if (IN(k)) { F.a = kargs(); F.tid = opaque_v((int)threadIdx.x); F.lane = F.tid & 63; F.wave = __builtin_amdgcn_readfirstlane(F.tid >> 6); F.bid = opaque((int)blockIdx.x); F.G = opaque((int)gridDim.x); F.lds = (LAS unsigned char*)lds_raw + opaque(0); unsigned char* ws = F.a->ws; const int l = opaque(lq); unsigned char* wl = ws + WS_WTS + (size_t)l * WL_STRIDE; (void)wl; (void)ws;
#define STAGE_END(k) } SEAM(k);
    int lq = 0;
    STAGE(0) p0_prologue(F); STAGE_END(0)
    for (lq = 0; lq < DEPTH; ++lq) {
        const int sb = 1 + lq * NSTAGE_L;
        STAGE(sb + 0) stage_norm1(F, l); STAGE_END(sb + 0)
        STAGE(sb + 1) pg8::SchedStatic S; S.init(ws + WS_H, wl + WO_WIN, T_ALL, IN_COLS, 1024, F.G, F.bid); pg8::EpiBf16 E{(bf16*)(ws + WS_Z), IN_COLS, nullptr, 0};
            pg8::gemm_phase(F.lds, F.tid, 1024, S, E); STAGE_END(sb + 1)
        STAGE(sb + 2) stage_rw_prep1(F, l); stage_s5_scan(F, l); stage_hy_pre(F, l); STAGE_END(sb + 2)
        STAGE(sb + 3) { pg8::SchedStatic S; S.init(ws + WS_ARW, wl + WO_RWCAT, T_ALL, 2560, 256, F.G, F.bid); pg8::EpiBf16 E{(bf16*)(ws + WS_P), 2560, nullptr, 0}; pg8::gemm_phase(F.lds, F.tid, 256, S, E); }
            stage_s5_prep(F, l); STAGE_END(sb + 3)
        STAGE(sb + 4) stage_rw_prep2(F, l);
            pg8::SchedStatic S; S.init(ws + WS_AS5, wl + WO_GLU, T_ALL, 1024, 512, F.G, F.bid); pg8::EpiGlu<0> E{(bf16*)(ws + WS_YS5), 512, F.a->in[I_S5GLUB] + l * 1024, 0, 512}; pg8::gemm_phase(F.lds, F.tid, 512, S, E); STAGE_END(sb + 4)
        STAGE(sb + 5) stage_mixer(F, l); STAGE_END(sb + 5)
        STAGE(sb + 6) stage_rw_readout(F, l); stage_hy_post(F, l); STAGE_END(sb + 6)
        STAGE(sb + 7) pg8::SchedMerge S; S.A0 = (const char*)(ws + WS_YHY); S.A1 = (const char*)(ws + WS_YRW); S.A2 = (const char*)(ws + WS_YS5); S.Bt = (const char*)(wl + WO_WBR); S.tstep = (size_t)256 * 512 * 2; S.bstride = (size_t)1024 * 512 * 2;
            S.nM = T_ALL / 256; S.nN = 4; S.G = F.G; S.c = F.bid;
            pg8::EpiMerge E{(float*)(ws + WS_MTMP), (bf16*)(ws + WS_H), (const bf16*)(ws + WS_Z) + GATE_OFF}; pg8::gemm_phase(F.lds, F.tid, 512, S, E); STAGE_END(sb + 7)
        STAGE(sb + 8) pg8::SchedStatic S; S.init(ws + WS_H, wl + WO_WOUT, T_ALL, 1024, 1024, F.G, F.bid); pg8::EpiResid E{(float*)(ws + WS_X), (const float*)(ws + WS_MOD) + (size_t)l * 9 * 6144 + 2048};
            pg8::gemm_phase(F.lds, F.tid, 1024, S, E); STAGE_END(sb + 8)
        STAGE(sb + 9) stage_norm2_router(F, l); STAGE_END(sb + 9)
        STAGE(sb + 10) stage_moe_scatter(F, l); STAGE_END(sb + 10)
        STAGE(sb + 11) LAS int* base = load_moe_base(F);
            pg8::SchedMoe S; S.A = (const char*)(ws + WS_XS); S.Bt = (const char*)(wl + WO_W1); S.tstep = (size_t)256 * 1024 * 2; S.estride = (size_t)2048 * 1024 * 2; S.NPN = 8; S.G = F.G; S.c = F.bid; S.base = base;
            pg8::EpiGlu<1> E{(bf16*)(ws + WS_ACT), 1024, F.a->in[I_B1] + (size_t)l * 32 * 2048, 2048, 1024}; pg8::gemm_phase(F.lds, F.tid, 1024, S, E); STAGE_END(sb + 11)
        STAGE(sb + 12) LAS int* base = load_moe_base(F);
            pg8::SchedMoe S; S.A = (const char*)(ws + WS_ACT); S.Bt = (const char*)(wl + WO_W2); S.tstep = (size_t)256 * 1024 * 2; S.estride = (size_t)1024 * 1024 * 2; S.NPN = 4; S.G = F.G; S.c = F.bid; S.base = base;
            pg8::EpiBf16 E{(bf16*)(ws + WS_XS), 1024, F.a->in[I_B2] + (size_t)l * 32 * 1024, 1024}; pg8::gemm_phase(F.lds, F.tid, 1024, S, E); STAGE_END(sb + 12)
    }
    lq = DEPTH;
    STAGE(NSTAGES - 1) stage_norm1(F, l); }
#undef IN
#undef SEAM
}

extern "C" void kernel_launch(void* const* d_in, const int* in_sizes, int n_in, void* d_out, int out_size, void* d_ws, size_t ws_size, hipStream_t stream) {
    static int grid = 0;
    if (grid == 0) {
        if (n_in != 51 || out_size != T_LAT * D || ws_size < WS_END) { fprintf(stderr, "kernel_launch: unexpected shapes (n_in %d out %d ws %zu, need %zu)\n", n_in, out_size, ws_size, (size_t)WS_END); grid = -1; return; }
        int dev = 0, cus = 0, per_cu = 0;
        if (hipGetDevice(&dev) != hipSuccess || hipDeviceGetAttribute(&cus, hipDeviceAttributeMultiprocessorCount, dev) != hipSuccess) { grid = -1; return; }
        if (hipFuncSetAttribute((const void*)mk_fwd, hipFuncAttributeMaxDynamicSharedMemorySize, LDS_BYTES) != hipSuccess) { fprintf(stderr, "kernel_launch: hipFuncSetAttribute failed\n"); grid = -1; return; }
        if (hipOccupancyMaxActiveBlocksPerMultiprocessor(&per_cu, (const void*)mk_fwd, NTHREADS, LDS_BYTES) != hipSuccess || per_cu < 1) fprintf(stderr, "kernel_launch: occupancy query says %d\n", per_cu);
        (void)hipGetLastError();
        grid = cus;
    }
    if (grid < 0) return;
    if (hipMemsetAsync((char*)d_ws + WS_CTL, 0, CTL_ZERO_BYTES, stream) != hipSuccess) return;
    Args a{};
    for (int i = 0; i < 51; ++i) a.in[i] = (const float*)d_in[i];
    a.out = (float*)d_out; a.ws = (unsigned char*)d_ws;
#if MK_PER_STAGE
    for (int s = 0; s < NSTAGES; ++s) { a.ph_lo = s; a.ph_hi = s + 1; int reps = 1;
#ifdef PROBE_SET
        { const int ls = (s == 0 || s == NSTAGES - 1) ? -1 : (s - 1) % NSTAGE_L;
          if (PROBE_SET == 1 && (ls == 1 || ls == 7 || ls == 11 || ls == 12)) reps = 2;
          if (PROBE_SET == 2 && s == 0) reps = 2;
          if (PROBE_SET == 3 && (ls == 4 || ls == 6 || ls == 9 || ls == 10)) reps = 2;
          if (PROBE_SET == 4 && (ls == 11)) reps = 2;
          if (PROBE_SET == 5 && (ls == 1)) reps = 2;
          if (PROBE_SET == 6 && (ls == 4)) reps = 2;
          if (PROBE_SET == 7 && (ls == 9 || ls == 10)) reps = 2; }
#endif
        for (int r = 0; r < reps; ++r) hipLaunchKernelGGL(mk_fwd, dim3(grid), dim3(NTHREADS), LDS_BYTES, stream, a); }
#else
    a.ph_lo = 0; a.ph_hi = NSTAGES; hipLaunchKernelGGL(mk_fwd, dim3(grid), dim3(NTHREADS), LDS_BYTES, stream, a);
#endif
}
```

```cpp
#include <hip/hip_runtime.h>
#include <cstdio>
#include <cstdint>

#ifndef REP_GEMM
#define REP_GEMM 1
#endif
#ifndef REP_LIGHT
#define REP_LIGHT 1
#endif
#ifndef REP_PRO
#define REP_PRO 1
#endif
#ifndef MK_PER_STAGE
#define MK_PER_STAGE 0
#endif

#define GAS __attribute__((address_space(1)))
#define LAS __attribute__((address_space(3)))
typedef unsigned short bf16;
typedef unsigned v4u __attribute__((ext_vector_type(4)));
typedef unsigned v2u __attribute__((ext_vector_type(2)));
typedef float f32x4 __attribute__((ext_vector_type(4)));
typedef float f32x2 __attribute__((ext_vector_type(2)));
typedef short bf16x8 __attribute__((ext_vector_type(8)));

constexpr int D = 1024, BATCH = 8, SEQ = 4096, CTXL = 256, DEPTH = 2;
constexpr int T_LAT = BATCH * SEQ, T_CTX = BATCH * CTXL, T_ALL = T_LAT + T_CTX;
constexpr int IN_COLS = 6912, HY_OFF = 0, RW_OFF = 1536, S5_OFF = 3328, GATE_OFF = 3840;
constexpr int NE = 32, TOPK = 4;
constexpr int MAXSLOT = 147456;
constexpr int NWAVES = 8, NTHREADS = 512;
constexpr int HY_MARG = 128, HY_ROWB = 8720, HY_RLEN = 8272, HY_RLENC = 592;
constexpr int HY_R1_OFF = 8 * HY_ROWB, HY_R2_OFF = HY_R1_OFF + HY_RLEN * 2;

constexpr size_t MiB = 1ull << 20;
constexpr size_t WS_CTL = 0, CTL_ZERO_BYTES = 1 * MiB;
constexpr size_t WS_MOD = 1 * MiB;
constexpr size_t WS_BLKCNT = 2 * MiB;
constexpr size_t WS_META = 2 * MiB + 512 * 1024;
constexpr size_t WS_EIDX = 3 * MiB, WS_GATE = 4 * MiB, WS_POS = 5 * MiB;
constexpr size_t WS_WTS = 8 * MiB, WL_STRIDE = 214 * MiB;
constexpr size_t WO_WIN = 0, WO_RWCAT = 14 * MiB, WO_GLU = 16 * MiB, WO_WBR = 17 * MiB, WO_WOUT = 20 * MiB, WO_W1 = 22 * MiB, WO_W2 = 150 * MiB;
constexpr size_t WS_GF = 436 * MiB, GF_STRIDE = 20 * MiB, GF_CTX = 17 * MiB;
constexpr size_t WS_X = 504 * MiB;
constexpr size_t WS_H = 640 * MiB;
constexpr size_t WS_BIG = 708 * MiB;
constexpr size_t WS_Z = WS_BIG;
constexpr size_t WS_SCN = 1167 * MiB;
constexpr size_t WS_MTMP = WS_SCN;
constexpr size_t WS_P = 1473 * MiB;
constexpr size_t WS_ARW = 1643 * MiB;
constexpr size_t WS_YP = 1660 * MiB;
constexpr size_t WS_YDIR = WS_YP;
constexpr size_t WS_UT = 1796 * MiB;
constexpr size_t WS_AS5 = 2000 * MiB;
constexpr size_t WS_YHY = 1898 * MiB, WS_YRW = 1932 * MiB, WS_YS5 = 1966 * MiB;
constexpr size_t WS_XS = WS_BIG;
constexpr size_t WS_ACT = WS_BIG + 288 * MiB;
constexpr size_t WS_END = 2034 * MiB;
constexpr int CW_BAR = 4096;

constexpr int RING_BYTES = 131072;
constexpr int LDSCTL_OFF = RING_BYTES;
constexpr int LDS_BYTES = 147456;

__device__ __forceinline__ unsigned f2bf(float f) { unsigned u = __builtin_bit_cast(unsigned, f); return (u + 0x7fffu + ((u >> 16) & 1u)) >> 16; }
__device__ __forceinline__ unsigned pk2(float lo, float hi) { return f2bf(lo) | (f2bf(hi) << 16); }
__device__ __forceinline__ float bf2f(bf16 b) { return __builtin_bit_cast(float, ((unsigned)b) << 16); }
__device__ __forceinline__ float bflo(unsigned w) { return __builtin_bit_cast(float, w << 16); }
__device__ __forceinline__ float bfhi(unsigned w) { return __builtin_bit_cast(float, w & 0xffff0000u); }
__device__ __forceinline__ float sigm(float x) { return 1.f / (1.f + __expf(-x)); }
#define LDS_WAIT() asm volatile("s_waitcnt lgkmcnt(0)" ::: "memory")
__device__ __forceinline__ float dpp_f(float x, const int ctrl_sel) {
    const int v = __builtin_bit_cast(int, x);
    int r;
    if (ctrl_sel == 0) r = __builtin_amdgcn_update_dpp(0, v, 0xB1, 0xF, 0xF, true);
    else if (ctrl_sel == 1) r = __builtin_amdgcn_update_dpp(0, v, 0x4E, 0xF, 0xF, true);
    else r = __builtin_amdgcn_update_dpp(0, v, 0x141, 0xF, 0xF, true);
    return __builtin_bit_cast(float, r);
}
__device__ __forceinline__ float red32(float x) {
    x += dpp_f(x, 0); x += dpp_f(x, 1); x += dpp_f(x, 2);
    x += __builtin_bit_cast(float, __builtin_amdgcn_update_dpp(0, __builtin_bit_cast(int, x), 0x128, 0xF, 0xF, true));
    x += __builtin_bit_cast(float, __builtin_amdgcn_ds_swizzle(__builtin_bit_cast(int, x), 0x401F));
    return x;
}
__device__ __forceinline__ float wave_sum(float v) {
    v = red32(v);
    return __builtin_bit_cast(float, __builtin_amdgcn_readlane(__builtin_bit_cast(int, v), 0)) + __builtin_bit_cast(float, __builtin_amdgcn_readlane(__builtin_bit_cast(int, v), 32));
}
__device__ __forceinline__ int xch32(int v, const int step) {
    if (step == 0) return __builtin_amdgcn_update_dpp(0, v, 0xB1, 0xF, 0xF, true);
    if (step == 1) return __builtin_amdgcn_update_dpp(0, v, 0x4E, 0xF, 0xF, true);
    if (step == 2) return __builtin_amdgcn_update_dpp(0, v, 0x141, 0xF, 0xF, true);
    if (step == 3) return __builtin_amdgcn_update_dpp(0, v, 0x128, 0xF, 0xF, true);
    return __builtin_amdgcn_ds_swizzle(v, 0x401F);
}
__device__ __forceinline__ float red8(float x) { x += dpp_f(x, 0); x += dpp_f(x, 1); x += dpp_f(x, 2); return x; }

#define XB_TMO      128
#define XB_XCNT(j)  (256  + 64 * (j))
#define XB_XSUB(j)  (1280 + 64 * (j))
#define XB_XGEN(j)  (2304 + 64 * (j))
#define XB_TOP      3328
#define XB_TOPGEN   3392
#define XCD_BAR_WORDS 3456
#define XB_SPIN_CAP (1u << 22)
__device__ __forceinline__ unsigned xb_ld(unsigned* p)              { return __hip_atomic_load(p, __ATOMIC_RELAXED, __HIP_MEMORY_SCOPE_AGENT); }
__device__ __forceinline__ unsigned xb_add(unsigned* p, unsigned v) { return __hip_atomic_fetch_add(p, v, __ATOMIC_RELAXED, __HIP_MEMORY_SCOPE_AGENT); }
__device__ __forceinline__ unsigned xb_xcc_id() { return (unsigned)__builtin_amdgcn_s_getreg((3 << 11) | 20) & 0xFu; }
#define XB_SPIN(cond, bar) do { unsigned _sp = 0; while (cond) { __builtin_amdgcn_s_sleep(1); \
    if ((++_sp & 255u) == 0u) { if (xb_ld(&(bar)[XB_TMO])) break; if (_sp > XB_SPIN_CAP) { atomicAdd(&(bar)[XB_TMO], 1u); break; } } } } while (0)
struct XcdBarrier { unsigned* bar; unsigned x; volatile LAS unsigned* st; };
__device__ __forceinline__ XcdBarrier xcd_barrier_post(unsigned* bar, volatile LAS unsigned* st) {
    XcdBarrier b; b.bar = bar; b.x = xb_xcc_id(); b.st = st;
    if (threadIdx.x == 0) (void)xb_add(&bar[XB_XCNT(b.x)], 1u);
    return b;
}
__device__ __forceinline__ void xcd_barrier_complete(unsigned* bar, unsigned x, unsigned& nloc, unsigned& nx) {
    const unsigned G = gridDim.x * gridDim.y * gridDim.z;
    unsigned sum, cnt, mine, sp = 0u;
    for (;;) {
        sum = 0u; cnt = 0u; mine = 0u;
#pragma unroll
        for (unsigned j = 0; j < 16; ++j) { const unsigned c = xb_ld(&bar[XB_XCNT(j)]); sum += c; cnt += (c > 0u) ? 1u : 0u; mine = (j == x) ? c : mine; }
        if (sum == G) break;
        __builtin_amdgcn_s_sleep(1);
        if ((++sp & 255u) == 0u) { if (xb_ld(&bar[XB_TMO])) break; if (sp > XB_SPIN_CAP) { atomicAdd(&bar[XB_TMO], 1u); break; } }
    }
    nloc = mine > 0u ? mine : 1u; nx = cnt > 0u ? cnt : 1u;
}
__device__ __forceinline__ void xcd_barrier(const XcdBarrier& b) {
    asm volatile("s_waitcnt vmcnt(0)" ::: "memory");
    __syncthreads();
    if (threadIdx.x == 0) {
        unsigned* bar = b.bar;
        __builtin_amdgcn_s_waitcnt(0);
        unsigned nloc = b.st[0], nx = b.st[1];
        if (nloc == 0u) { xcd_barrier_complete(bar, b.x, nloc, nx); b.st[0] = nloc; b.st[1] = nx; }
        const unsigned old = xb_add(&bar[XB_XSUB(b.x)], 1u);
        const unsigned gen = old / nloc;
        if (old + 1u == (gen + 1u) * nloc) {
            __builtin_amdgcn_fence(__ATOMIC_RELEASE, "agent");
            asm volatile("s_waitcnt vmcnt(0)" ::: "memory");
            const unsigned og = xb_add(&bar[XB_TOP], 1u);
            const unsigned tg = og / nx;
            if (og + 1u == (tg + 1u) * nx) xb_add(&bar[XB_TOPGEN], 1u);
            else XB_SPIN(xb_ld(&bar[XB_TOPGEN]) == tg, bar);
            __builtin_amdgcn_fence(__ATOMIC_ACQUIRE, "agent");
            xb_add(&bar[XB_XGEN(b.x)], 1u);
            asm volatile("s_waitcnt vmcnt(0)" ::: "memory");
        } else {
            XB_SPIN(xb_ld(&bar[XB_XGEN(b.x)]) == gen, bar);
            __builtin_amdgcn_fence(__ATOMIC_ACQUIRE, "agent");
            asm volatile("s_waitcnt vmcnt(0)" ::: "memory");
        }
    }
    __syncthreads();
}

namespace pg8 {
constexpr int BM = 256, BK = 64, HALF = 128, HTB = HALF * BK * 2, STAGE_BYTES = 8 * HTB, NXCD = 8, WGM = 8;
__host__ __device__ __forceinline__ int lds_byte(int r, int c) { const int st = (r >> 4) * 2 + (c >> 5), rr = r & 15, cc = c & 31, ob = rr * 64 + cc * 2; return st * 1024 + (ob ^ (((ob >> 9) & 1) << 5)); }
__host__ __device__ __forceinline__ void stage_rc(int b, int& R, int& C) { const int st = b / 1024, sb = b % 1024, swz = sb ^ (((sb >> 9) & 1) << 5); R = (st >> 1) * 16 + swz / 64; C = (st & 1) * 32 + (swz % 64) / 2; }
__host__ __device__ __forceinline__ int perm32(int rho) { const int n = rho >> 4, i = rho & 15; return 8 * (i >> 2) + 4 * n + (i & 3); }
struct Unit { int pm, pn, e; };
__device__ __forceinline__ unsigned cvt_pk_bf16(float lo, float hi) { unsigned r; asm volatile("v_cvt_pk_bf16_f32 %0, %1, %2" : "=v"(r) : "v"(lo), "v"(hi)); return r; }

__device__ __forceinline__ void tile_of(int L, int nM, int nN, int& pm, int& pn) {
    const int nwg = nM * nN; int wgid = L;
    { const int q = nwg / NXCD, r = nwg % NXCD, xcd = wgid % NXCD, off = wgid / NXCD; wgid = (xcd < r ? xcd * (q + 1) : r * (q + 1) + (xcd - r) * q) + off; }
    const int nig = WGM * nN, gid = wgid / nig, fm = gid * WGM, gsz = (nM - fm) < WGM ? (nM - fm) : WGM;
    pm = fm + ((wgid % nig) % gsz); pn = (wgid % nig) / gsz;
}
struct SchedStatic {
    const char* A; const char* Bt; size_t tstep; int nM, nN, G, c;
    __device__ __forceinline__ void init(const void* A_, const void* Bt_, int M, int N, int K, int G_, int c_) { A = (const char*)A_; Bt = (const char*)Bt_; tstep = (size_t)BM * K * 2; nM = M / BM; nN = N / BM; G = G_; c = c_; }
    __device__ __forceinline__ bool next(int i, Unit& u) const { const long L = (long)i * G + c; if (L >= (long)nM * nN) return false; tile_of((int)L, nM, nN, u.pm, u.pn); u.e = 0; return true; }
    __device__ __forceinline__ const char* aptr(const Unit& u) const { return A + (size_t)u.pm * tstep; }
    __device__ __forceinline__ const char* bptr(const Unit& u) const { return Bt + (size_t)u.pn * tstep; }
};
struct SchedMerge {
    const char* A0; const char* A1; const char* A2; const char* Bt; size_t tstep, bstride; int nM, nN, G, c;
    __device__ __forceinline__ bool next(int i, Unit& u) const { const int j = i / 3, br = i - 3 * j; const long L = (long)j * G + c; if (L >= (long)nM * nN) return false; tile_of((int)L, nM, nN, u.pm, u.pn); u.e = br; return true; }
    __device__ __forceinline__ const char* aptr(const Unit& u) const { return (u.e == 0 ? A0 : (u.e == 1 ? A1 : A2)) + (size_t)u.pm * tstep; }
    __device__ __forceinline__ const char* bptr(const Unit& u) const { return Bt + (size_t)u.e * bstride + (size_t)u.pn * tstep; }
};
struct SchedMoe {
    const char* A; const char* Bt; size_t tstep, estride; int NPN, G, c; const LAS int* base;
    __device__ __forceinline__ bool next(int i, Unit& u) const {
        const int ntiles = base[32] >> 8; const long L = (long)i * G + c; if (L >= (long)ntiles * NPN) return false;
        u.pm = (int)(L / NPN); u.pn = (int)(L % NPN); const int r0 = u.pm << 8; int e = 0;
#pragma unroll 1
        for (int k = 1; k < 32; ++k) e += (r0 >= base[k]) ? 1 : 0;
        u.e = e; return true;
    }
    __device__ __forceinline__ const char* aptr(const Unit& u) const { return A + (size_t)u.pm * tstep; }
    __device__ __forceinline__ const char* bptr(const Unit& u) const { return Bt + (size_t)u.e * estride + (size_t)u.pn * tstep; }
};

template <class Epi, class Sched>
__device__ __forceinline__ void gemm_phase(LAS unsigned char* lds, const int tid, const int K, const Sched& S, const Epi& E) {
    const int wid = __builtin_amdgcn_readfirstlane(tid >> 6), lane = tid & 63, wr = wid >> 2, wc = wid & 3, fr = lane & 15, fq = lane >> 4;
    const int nt = K / BK;
    unsigned voffA[2], voffB[2];
#pragma unroll
    for (int i = 0; i < 2; ++i) { int R, C; stage_rc(tid * 16 + i * 8192, R, C); const int Rb = Epi::PERM ? ((R & ~31) + perm32(R & 31)) : R;
        voffA[i] = (unsigned)(R * K + C) * 2u; voffB[i] = (unsigned)(Rb * K + C) * 2u; }
    const size_t kstep = (size_t)(BK * 2);
    const size_t hstep = (size_t)HALF * K * 2;
    const unsigned ldsw = (unsigned)wid * 1024u;
    const int aoff = lds_byte(wr * 64 + fr, fq * 8), boff = lds_byte(wc * 32 + fr, fq * 8);
#define PG8_SA(b, h) (((b) * 2 + (h)) * HTB)
#define PG8_SB(b, h) ((4 + (b) * 2 + (h)) * HTB)
#define PG8_STAGE(bufoff, gbase, voff) do { _Pragma("unroll") for (int _i = 0; _i < 2; ++_i) \
        __builtin_amdgcn_global_load_lds((const unsigned*)((const char*)(gbase) + (voff)[_i]), (LAS unsigned*)(lds + (bufoff) + ldsw + _i * 8192), 16, 0, 0); } while (0)
#define PG8_LDA(dst, b, h) do { _Pragma("unroll") for (int m = 0; m < 4; ++m) _Pragma("unroll") for (int k = 0; k < 2; ++k) dst[m][k] = *(const LAS bf16x8*)(lds + PG8_SA(b, h) + aoff + m * 2048 + k * 1024); } while (0)
#define PG8_LDB(dst, b, h) do { _Pragma("unroll") for (int n = 0; n < 2; ++n) _Pragma("unroll") for (int k = 0; k < 2; ++k) dst[n][k] = *(const LAS bf16x8*)(lds + PG8_SB(b, h) + boff + n * 2048 + k * 1024); } while (0)
#define PG8_MMA(ai, bj, At, Bt) do { __builtin_amdgcn_s_setprio(1); _Pragma("unroll") for (int m = 0; m < 4; ++m) _Pragma("unroll") for (int n = 0; n < 2; ++n) _Pragma("unroll") for (int k = 0; k < 2; ++k) \
        acc[ai][bj][m][n] = __builtin_amdgcn_mfma_f32_16x16x32_bf16(Bt[n][k], At[m][k], acc[ai][bj][m][n], 0, 0, 0); __builtin_amdgcn_s_setprio(0); } while (0)
#define PG8_WAIT_V(n) asm volatile("s_waitcnt vmcnt(" #n ")" ::: "memory")
#define PG8_WAIT_L(n) asm volatile("s_waitcnt lgkmcnt(" #n ")" ::: "memory")
#define PG8_BAR __builtin_amdgcn_s_barrier()
#define PG8_SCHED __builtin_amdgcn_sched_barrier(0)
    Unit cur, nxt; int ui = 0;
    if (!S.next(0, cur)) return;
    f32x4 acc[2][2][4][2];
#pragma unroll
    for (int a = 0; a < 2; ++a)
#pragma unroll
        for (int b = 0; b < 2; ++b)
#pragma unroll
            for (int m = 0; m < 4; ++m)
#pragma unroll
                for (int n = 0; n < 2; ++n) acc[a][b][m][n] = (f32x4){0.f, 0.f, 0.f, 0.f};
    bf16x8 At[4][2], B0[2][2], B1[2][2];
    const char* cA = S.aptr(cur); const char* cB = S.bptr(cur);
    PG8_STAGE(PG8_SB(0, 0), cB, voffB); PG8_STAGE(PG8_SB(0, 1), cB + hstep, voffB); PG8_STAGE(PG8_SA(0, 0), cA, voffA); PG8_STAGE(PG8_SA(0, 1), cA + hstep, voffA);
    if (wr == 1) PG8_BAR;
    PG8_WAIT_V(2); PG8_BAR;
    PG8_STAGE(PG8_SB(1, 0), cB + kstep, voffB); PG8_STAGE(PG8_SA(1, 0), cA + kstep, voffA); PG8_STAGE(PG8_SB(1, 1), cB + hstep + kstep, voffB);
    PG8_WAIT_V(6); PG8_BAR;
    for (;;) {
        const bool has_next = S.next(ui + 1, nxt);
        const char* nA = has_next ? S.aptr(nxt) : cA; const char* nB = has_next ? S.bptr(nxt) : cB;
        for (int t = 0; t < nt; t += 2) {
            const bool last = (t == nt - 2);
            const char* a1 = cA + (size_t)(t + 1) * kstep;
            const char* a2 = last ? nA : cA + (size_t)(t + 2) * kstep; const char* b2 = last ? nB : cB + (size_t)(t + 2) * kstep;
            const char* a3 = a2 + kstep; const char* b3 = b2 + kstep;
            PG8_LDB(B0, 0, 0); PG8_LDB(B1, 0, 1); PG8_SCHED; PG8_LDA(At, 0, 0); PG8_STAGE(PG8_SA(1, 1), a1 + hstep, voffA);
            PG8_WAIT_V(8); PG8_WAIT_L(0); PG8_BAR; PG8_MMA(0, 0, At, B0); PG8_MMA(0, 1, At, B1); PG8_BAR; PG8_SCHED;
            PG8_LDA(At, 0, 1); PG8_STAGE(PG8_SB(0, 0), b2, voffB); PG8_STAGE(PG8_SB(0, 1), b2 + hstep, voffB); PG8_STAGE(PG8_SA(0, 0), a2, voffA);
            PG8_WAIT_V(8); PG8_WAIT_L(0); PG8_BAR; PG8_MMA(1, 0, At, B0); PG8_MMA(1, 1, At, B1); PG8_BAR; PG8_SCHED;
            PG8_LDB(B0, 1, 0); PG8_LDB(B1, 1, 1); PG8_SCHED; PG8_LDA(At, 1, 0); PG8_STAGE(PG8_SA(0, 1), a2 + hstep, voffA);
            PG8_WAIT_V(8); PG8_WAIT_L(0); PG8_BAR; PG8_MMA(0, 0, At, B0); PG8_MMA(0, 1, At, B1); PG8_BAR; PG8_SCHED;
            PG8_LDA(At, 1, 1); PG8_STAGE(PG8_SB(1, 0), b3, voffB); PG8_STAGE(PG8_SB(1, 1), b3 + hstep, voffB); PG8_STAGE(PG8_SA(1, 0), a3, voffA);
            PG8_WAIT_V(8); PG8_WAIT_L(0); PG8_BAR; PG8_MMA(1, 0, At, B0); PG8_MMA(1, 1, At, B1); PG8_BAR; PG8_SCHED;
        }
        if (wr == 0) PG8_BAR;
        E(acc, cur, wr, wc, fr, fq);
        if (!has_next) break;
#pragma unroll
        for (int a = 0; a < 2; ++a)
#pragma unroll
            for (int b = 0; b < 2; ++b)
#pragma unroll
                for (int m = 0; m < 4; ++m)
#pragma unroll
                    for (int n = 0; n < 2; ++n) acc[a][b][m][n] = (f32x4){0.f, 0.f, 0.f, 0.f};
        cur = nxt; cA = nA; cB = nB; ++ui;
        if (wr == 1) PG8_BAR;
    }
    PG8_WAIT_V(0);
    PG8_BAR;
#undef PG8_SA
#undef PG8_SB
#undef PG8_STAGE
#undef PG8_LDA
#undef PG8_LDB
#undef PG8_MMA
#undef PG8_WAIT_V
#undef PG8_WAIT_L
#undef PG8_BAR
#undef PG8_SCHED
}

struct EpiBf16 {
    static constexpr bool PERM = true;
    bf16* O; int ldc; const float* bias; int bias_stride;
    __device__ __forceinline__ void operator()(const f32x4 (&acc)[2][2][4][2], const Unit& u, int wr, int wc, int fr, int fq) const {
        const int row0 = u.pm * BM + wr * 64 + fr, col0 = u.pn * BM + wc * 32 + 8 * fq;
        f32x4 bv[2][2];
#pragma unroll
        for (int bj = 0; bj < 2; ++bj)
#pragma unroll
            for (int n = 0; n < 2; ++n) bv[bj][n] = bias ? *(const f32x4*)(bias + (size_t)u.e * bias_stride + col0 + bj * HALF + 4 * n) : (f32x4){0.f, 0.f, 0.f, 0.f};
#pragma unroll
        for (int ai = 0; ai < 2; ++ai)
#pragma unroll
            for (int m = 0; m < 4; ++m) { bf16* rowp = O + (size_t)(row0 + ai * HALF + m * 16) * ldc + col0;
#pragma unroll
                for (int bj = 0; bj < 2; ++bj) { const f32x4 v0 = acc[ai][bj][m][0] + bv[bj][0], v1 = acc[ai][bj][m][1] + bv[bj][1];
                    v4u w; w.x = cvt_pk_bf16(v0[0], v0[1]); w.y = cvt_pk_bf16(v0[2], v0[3]); w.z = cvt_pk_bf16(v1[0], v1[1]); w.w = cvt_pk_bf16(v1[2], v1[3]);
                    *(v4u*)(rowp + bj * HALF) = w; } }
    }
};
template <int MODE> struct EpiGlu {
    static constexpr bool PERM = true;
    bf16* O; int ldc; const float* bias; int bias_stride, hs;
    __device__ __forceinline__ void operator()(const f32x4 (&acc)[2][2][4][2], const Unit& u, int wr, int wc, int fr, int fq) const {
        const int row0 = u.pm * BM + wr * 64 + fr, col0 = u.pn * HALF + wc * 32 + 8 * fq;
        const float* bp = bias + (size_t)u.e * bias_stride + col0;
        f32x4 ba[2], bb[2];
#pragma unroll
        for (int n = 0; n < 2; ++n) { ba[n] = *(const f32x4*)(bp + 4 * n); bb[n] = *(const f32x4*)(bp + hs + 4 * n); }
#pragma unroll
        for (int ai = 0; ai < 2; ++ai)
#pragma unroll
            for (int m = 0; m < 4; ++m) { bf16* rowp = O + (size_t)(row0 + ai * HALF + m * 16) * ldc + col0;
                float o[8];
#pragma unroll
                for (int n = 0; n < 2; ++n) { const f32x4 a = acc[ai][0][m][n] + ba[n], b = acc[ai][1][m][n] + bb[n];
#pragma unroll
                    for (int j = 0; j < 4; ++j) {
                        if (MODE == 0) o[4 * n + j] = a[j] * sigm(b[j]);
                        else { const float g = fminf(a[j], 7.f), up = fminf(fmaxf(b[j], -7.f), 7.f); o[4 * n + j] = (up + 1.f) * g * sigm(1.702f * g); } } }
                v4u w; w.x = cvt_pk_bf16(o[0], o[1]); w.y = cvt_pk_bf16(o[2], o[3]); w.z = cvt_pk_bf16(o[4], o[5]); w.w = cvt_pk_bf16(o[6], o[7]);
                *(v4u*)rowp = w; }
    }
};
struct EpiMerge {
    static constexpr bool PERM = true;
    float* mtmp; bf16* Mo; const bf16* zg;
    __device__ __forceinline__ void operator()(const f32x4 (&acc)[2][2][4][2], const Unit& u, int wr, int wc, int fr, int fq) const {
        const int row0 = u.pm * BM + wr * 64 + fr, col0 = u.pn * BM + wc * 32 + 8 * fq;
#pragma unroll
        for (int ai = 0; ai < 2; ++ai)
#pragma unroll
            for (int m = 0; m < 4; ++m) { const size_t r = (size_t)(row0 + ai * HALF + m * 16);
#pragma unroll
                for (int bj = 0; bj < 2; ++bj) { const int c = col0 + bj * HALF;
                    const v4u gz = *(const v4u*)(zg + r * IN_COLS + u.e * 1024 + c);
                    float g[8] = {bflo(gz.x), bfhi(gz.x), bflo(gz.y), bfhi(gz.y), bflo(gz.z), bfhi(gz.z), bflo(gz.w), bfhi(gz.w)};
                    f32x4 t0, t1; float* tp = mtmp + r * 1024 + c;
                    if (u.e == 0) { t0 = (f32x4){0.f, 0.f, 0.f, 0.f}; t1 = t0; } else { t0 = *(const f32x4*)tp; t1 = *(const f32x4*)(tp + 4); }
#pragma unroll
                    for (int j = 0; j < 4; ++j) { t0[j] += sigm(g[j]) * acc[ai][bj][m][0][j]; t1[j] += sigm(g[4 + j]) * acc[ai][bj][m][1][j]; }
                    if (u.e < 2) { *(f32x4*)tp = t0; *(f32x4*)(tp + 4) = t1; }
                    else { v4u w; w.x = cvt_pk_bf16(t0[0], t0[1]); w.y = cvt_pk_bf16(t0[2], t0[3]); w.z = cvt_pk_bf16(t1[0], t1[1]); w.w = cvt_pk_bf16(t1[2], t1[3]);
                        *(v4u*)(Mo + r * 1024 + c) = w; } } }
    }
};
struct EpiResid {
    static constexpr bool PERM = false;
    float* X; const float* gmod;
    __device__ __forceinline__ void operator()(const f32x4 (&acc)[2][2][4][2], const Unit& u, int wr, int wc, int fr, int fq) const {
        const int row0 = u.pm * BM + wr * 64 + fr, col0 = u.pn * BM + wc * 32 + 4 * fq;
        const int r00 = u.pm * BM; const int w = r00 < T_LAT ? (r00 >> 12) : 8;
        f32x4 gv[2][2];
#pragma unroll
        for (int bj = 0; bj < 2; ++bj)
#pragma unroll
            for (int n = 0; n < 2; ++n) gv[bj][n] = *(const f32x4*)(gmod + (size_t)w * 6144 + col0 + bj * HALF + n * 16);
#pragma unroll
        for (int ai = 0; ai < 2; ++ai)
#pragma unroll
            for (int m = 0; m < 4; ++m) { float* rowp = X + (size_t)(row0 + ai * HALF + m * 16) * 1024 + col0;
#pragma unroll
                for (int bj = 0; bj < 2; ++bj)
#pragma unroll
                    for (int n = 0; n < 2; ++n) { f32x4* p = (f32x4*)(rowp + bj * HALF + n * 16); *p = *p + gv[bj][n] * acc[ai][bj][m][n]; } }
    }
};
}

struct Args { const float* in[51]; float* out; unsigned char* ws; int ph_lo, ph_hi; };
enum { I_X = 0, I_C, I_CTX, I_CCTX, I_ADAW, I_ADAB, I_N1G, I_N2G, I_WIN, I_HYCW, I_HYCB, I_HYW1, I_HYB1, I_HYF1, I_HYW2, I_HYB2, I_HYF2, I_HYW3, I_HYB3, I_HYBIAS,
       I_RWCW, I_RWCB, I_RWWUP, I_RWW0, I_RWAUP, I_RWA0, I_RWGUP, I_RWKK, I_RWKA, I_RWRK, I_RWLNG, I_RWLNB, I_S5ARE, I_S5AIM, I_S5LDT, I_S5BRE, I_S5BIM, I_S5CRE, I_S5CIM, I_S5D,
       I_S5GLUW, I_S5GLUB, I_WBR, I_WOUT, I_RTW, I_RTB, I_W1, I_B1, I_W2, I_B2, I_FING };

typedef const __attribute__((address_space(4))) Args* CArgsP;
__device__ __forceinline__ CArgsP kargs() { CArgsP p = (CArgsP)__builtin_amdgcn_kernarg_segment_ptr(); asm volatile("" : "+s"(p)); return p; }
__device__ __forceinline__ int opaque(int v) { asm volatile("" : "+s"(v)); return v; }
__device__ __forceinline__ int opaque_v(int v) { asm volatile("" : "+v"(v)); return v; }
struct Ctx { CArgsP a; LAS unsigned char* lds; int tid, lane, wave, bid, G; };

__device__ __forceinline__ void row_seq(int row, int& base, int& pos, int& n) {
    if (row < T_LAT) { base = row & ~(SEQ - 1); pos = row & (SEQ - 1); n = SEQ; }
    else { const int r = row - T_LAT; base = T_LAT + (r & ~(CTXL - 1)); pos = r & (CTXL - 1); n = CTXL; }
}
__device__ __forceinline__ float conv3z(const bf16* zc, int pos, int n, float w0, float w1, float w2, float b) {
    const float zm = pos > 0 ? bf2f(zc[(size_t)(pos - 1) * IN_COLS]) : 0.f, z0 = bf2f(zc[(size_t)pos * IN_COLS]), zp = pos < n - 1 ? bf2f(zc[(size_t)(pos + 1) * IN_COLS]) : 0.f;
    return zm * w0 + z0 * w1 + zp * w2 + b;
}

template <int MODE>
__device__ __forceinline__ void transpose_item(const float* W, int K, int N, bf16* WT, int Hs, LAS float* scr, int item, int lane) {
    const int nblk = N / 32, kb = item / nblk, nb = item % nblk, k0 = 64 * kb, n0 = 32 * nb;
#pragma unroll 8
    for (int i = 0; i < 32; ++i) { const int kk = 2 * i + (lane >> 5); scr[kk * 33 + (lane & 31)] = W[(size_t)(k0 + kk) * N + n0 + (lane & 31)]; }
    LDS_WAIT(); asm volatile("" ::: "memory");
    const int c = lane & 7;
#pragma unroll
    for (int j = 0; j < 4; ++j) { const int n = (lane >> 3) + 8 * j; const LAS float* s = scr + (8 * c) * 33 + n;
        v4u o; o.x = pk2(s[0 * 33], s[1 * 33]); o.y = pk2(s[2 * 33], s[3 * 33]); o.z = pk2(s[4 * 33], s[5 * 33]); o.w = pk2(s[6 * 33], s[7 * 33]);
        int dr = n0 + n;
        if (MODE == 1) { const int nc = n0 + n; const int jx = nc < Hs ? nc : nc - Hs; dr = (jx >> 7) * 256 + (nc < Hs ? 0 : 128) + (jx & 127); }
        *(v4u*)(WT + (size_t)dr * K + k0 + 8 * c) = o; }
    LDS_WAIT(); asm volatile("" ::: "memory");
}

__device__ __forceinline__ void p0_prologue(const Ctx& F) {
    const auto& a = *F.a; unsigned char* ws = a.ws;
    const int gw = F.bid * NWAVES + F.wave, NGW = F.G * NWAVES, lane = F.lane;
    float* X = (float*)(ws + WS_X);
    for (int row = gw; row < T_ALL; row += NGW) {
        f32x4* xo = (f32x4*)(X + (size_t)row * D) + lane;
        if (row < T_LAT) {
            const f32x4* xi = (const f32x4*)(a.in[I_X] + (size_t)row * D) + lane;
            const int t = row & (SEQ - 1); const float pr = (float)(t >> 6), pc = (float)(t & 63);
#pragma unroll
            for (int j = 0; j < 4; ++j) { f32x4 v = xi[64 * j];
#pragma unroll
                for (int e = 0; e < 4; ++e) { const float om = 1.0f / powf(10000.0f, (float)(4 * lane + e) / 256.0f); const float ang = ((j < 2) ? pr : pc) * om; v[e] += (j & 1) ? cosf(ang) : sinf(ang); }
                xo[64 * j] = v; }
        } else {
            const f32x4* xi = (const f32x4*)(a.in[I_CTX] + (size_t)(row - T_LAT) * D) + lane;
#pragma unroll
            for (int j = 0; j < 4; ++j) xo[64 * j] = xi[64 * j];
        }
    }
    {
        LAS float* condl = (LAS float*)F.lds; LAS float* psum = (LAS float*)(F.lds + 40960);
        for (int i = F.tid; i < 9 * 1024; i += NTHREADS) { const int w = i >> 10, k = i & 1023; const float cv = (w < 8) ? a.in[I_C][w * 1024 + k] : a.in[I_CCTX][k]; condl[i] = cv / (1.f + expf(-cv)); }
        __syncthreads();
        float* MOD = (float*)(ws + WS_MOD);
        for (int it = F.bid; it < 2 * 96; it += F.G) {
            const int l = it / 96, cg = it % 96, col = cg * 64 + lane;
            float acc[9];
#pragma unroll
            for (int w = 0; w < 9; ++w) acc[w] = 0.f;
            const float* wp = a.in[I_ADAW] + ((size_t)l * 1024 + F.wave * 128) * 6144 + col;
            for (int k = 0; k < 128; ++k) { const float wv = wp[(size_t)k * 6144];
#pragma unroll
                for (int w = 0; w < 9; ++w) acc[w] += condl[w * 1024 + F.wave * 128 + k] * wv; }
#pragma unroll
            for (int w = 0; w < 9; ++w) psum[(F.wave * 9 + w) * 64 + lane] = acc[w];
            __syncthreads();
            if (F.wave == 0) {
#pragma unroll
                for (int w = 0; w < 9; ++w) { float s = 0.f;
#pragma unroll
                    for (int wv = 0; wv < 8; ++wv) s += psum[(wv * 9 + w) * 64 + lane];
                    MOD[(size_t)(l * 9 + w) * 6144 + col] = s + a.in[I_ADAB][l * 6144 + col]; }
            }
            __syncthreads();
        }
    }
    {
        LAS float* scr = (LAS float*)(F.lds + F.wave * 16384);
        constexpr int IT_W1 = 16 * 64, IT_W2 = 16 * 32, IT_WIN = 16 * 216, IT_GLU = 8 * 32, IT_WBR = 8 * 32, IT_WOUT = 16 * 32;
        constexpr int N_W1 = 64 * IT_W1, N_W2 = 64 * IT_W2, N_WIN = 2 * IT_WIN, N_GLU = 2 * IT_GLU, N_WBR = 6 * IT_WBR, N_WOUT = 2 * IT_WOUT;
        constexpr int NITEMS = N_W1 + N_W2 + N_WIN + N_GLU + N_WBR + N_WOUT;
        for (int it = gw; it < NITEMS; it += NGW) {
            int r = it;
            if (r < N_W1) { const int mtx = r / IT_W1, l = mtx >> 5, e = mtx & 31; transpose_item<1>(a.in[I_W1] + (size_t)mtx * 1024 * 2048, 1024, 2048, (bf16*)(ws + WS_WTS + l * WL_STRIDE + WO_W1) + (size_t)e * 2048 * 1024, 1024, scr, r % IT_W1, lane); continue; } r -= N_W1;
            if (r < N_W2) { const int mtx = r / IT_W2, l = mtx >> 5, e = mtx & 31; transpose_item<0>(a.in[I_W2] + (size_t)mtx * 1024 * 1024, 1024, 1024, (bf16*)(ws + WS_WTS + l * WL_STRIDE + WO_W2) + (size_t)e * 1024 * 1024, 0, scr, r % IT_W2, lane); continue; } r -= N_W2;
            if (r < N_WIN) { const int l = r / IT_WIN; transpose_item<0>(a.in[I_WIN] + (size_t)l * 1024 * IN_COLS, 1024, IN_COLS, (bf16*)(ws + WS_WTS + l * WL_STRIDE + WO_WIN), 0, scr, r % IT_WIN, lane); continue; } r -= N_WIN;
            if (r < N_GLU) { const int l = r / IT_GLU; transpose_item<1>(a.in[I_S5GLUW] + (size_t)l * 512 * 1024, 512, 1024, (bf16*)(ws + WS_WTS + l * WL_STRIDE + WO_GLU), 512, scr, r % IT_GLU, lane); continue; } r -= N_GLU;
            if (r < N_WBR) { const int mtx = r / IT_WBR, l = mtx / 3, br = mtx % 3; transpose_item<0>(a.in[I_WBR] + (size_t)mtx * 512 * 1024, 512, 1024, (bf16*)(ws + WS_WTS + l * WL_STRIDE + WO_WBR) + (size_t)br * 1024 * 512, 0, scr, r % IT_WBR, lane); continue; } r -= N_WBR;
            { const int l = r / IT_WOUT; transpose_item<0>(a.in[I_WOUT] + (size_t)l * 1024 * 1024, 1024, 1024, (bf16*)(ws + WS_WTS + l * WL_STRIDE + WO_WOUT), 0, scr, r % IT_WOUT, lane); }
        }
        for (int i = F.bid * NTHREADS + F.tid; i < 2 * 2560 * 256; i += F.G * NTHREADS) {
            const int l = i / (2560 * 256), r = i % (2560 * 256), n = r >> 8, k = r & 255; float v = 0.f;
            if (n < 1024) { if (k < 64) v = a.in[I_RWWUP][(((size_t)l * 2 + (n >> 9)) * 64 + k) * 512 + (n & 511)]; }
            else if (n < 2048) { if (k >= 64 && k < 128) v = a.in[I_RWAUP][(((size_t)l * 2 + ((n - 1024) >> 9)) * 64 + (k - 64)) * 512 + (n & 511)]; }
            else { if (k >= 128) v = a.in[I_RWGUP][((size_t)l * 128 + (k - 128)) * 512 + (n - 2048)]; }
            ((bf16*)(ws + WS_WTS + l * WL_STRIDE + WO_RWCAT))[r] = (bf16)f2bf(v);
        }
    }
    __syncthreads();
    {
        LAS float* feats = (LAS float*)F.lds; LAS float* h1 = feats + 8 * 33; LAS float* h2 = h1 + 8 * 64;
        constexpr int NIT = 2 * (512 + 32);
        for (int it = F.bid; it < NIT; it += F.G) {
            const int l = it / 544, r = it % 544, nsel = r >= 512, n = nsel ? CTXL : SEQ, p0 = (nsel ? r - 512 : r) * 8;
            if (F.tid < 8 * 33) { const int p = F.tid / 33, i = F.tid % 33, pos = p0 + p; float f;
                if (i == 0) f = (float)pos / (float)(n - 1);
                else { const int k = (i - 1) & 15; const float band = 1e-4f + (float)k * ((15.0f - 1e-4f) / 15.0f); const float ang = (6.283185307179586f * (float)pos / (float)n) * band; f = (i <= 16) ? cosf(ang) : -sinf(ang); }
                feats[p * 33 + i] = f; }
            __syncthreads();
            { const int p = F.tid >> 6, j = F.tid & 63; float s = a.in[I_HYB1][l * 64 + j];
                for (int i = 0; i < 33; ++i) s += feats[p * 33 + i] * a.in[I_HYW1][((size_t)l * 33 + i) * 64 + j];
                h1[p * 64 + j] = sinf(a.in[I_HYF1][l * 64 + j] * s); }
            __syncthreads();
            { const int p = F.tid >> 6, j = F.tid & 63; float s = a.in[I_HYB2][l * 64 + j];
                for (int i = 0; i < 64; ++i) s += h1[p * 64 + i] * a.in[I_HYW2][((size_t)l * 64 + i) * 64 + j];
                h2[p * 64 + j] = sinf(a.in[I_HYF2][l * 64 + j] * s); }
            __syncthreads();
            float acc[4][8];
#pragma unroll
            for (int q = 0; q < 4; ++q)
#pragma unroll
                for (int p = 0; p < 8; ++p) acc[q][p] = 0.f;
            const float* w3 = a.in[I_HYW3] + (size_t)l * 64 * 2048 + F.tid;
            for (int i = 0; i < 64; ++i) { float wv[4];
#pragma unroll
                for (int q = 0; q < 4; ++q) wv[q] = w3[(size_t)i * 2048 + q * 512];
#pragma unroll
                for (int p = 0; p < 8; ++p) { const float hv = h2[p * 64 + i];
#pragma unroll
                    for (int q = 0; q < 4; ++q) acc[q][p] += hv * wv[q]; } }
            const int c = F.tid; const float dstart = logf(0.01f) / 1.5f, dstop = logf(0.01f) / 0.3f; const float delta = fabsf(dstart + (float)c * ((dstop - dstart) / 511.0f));
            const int RL = nsel ? HY_RLENC : HY_RLEN, off = n + 47;
            bf16* Rb = (bf16*)(ws + WS_GF + l * GF_STRIDE + (nsel ? GF_CTX : 0));
#pragma unroll
            for (int q = 0; q < 4; ++q) { const int o = q >> 1, side = q & 1; const float b3 = a.in[I_HYB3][l * 2048 + q * 512 + c];
                bf16* Rc = Rb + ((size_t)o * 512 + c) * RL;
#pragma unroll
                for (int p = 0; p < 8; ++p) { const int pos = p0 + p; const float t = (float)pos / (float)(n - 1); const float val = (acc[q][p] + b3) * expf(-t * delta);
                    if (side == 0) Rc[off - pos] = (bf16)f2bf(val);
                    else if (pos >= 1) Rc[off + pos] = (bf16)f2bf(val); }
                if (p0 == 0 && side == 0) { for (int m = 0; m < 48; ++m) Rc[m] = 0; for (int m = off + n; m < RL; ++m) Rc[m] = 0; } }
            __syncthreads();
        }
    }
}

__device__ __forceinline__ void stage_norm1(const Ctx& F, int l) {
    const auto& a = *F.a; unsigned char* ws = a.ws; const int lane = F.lane;
    const int gw = F.bid * NWAVES + F.wave, NGW = F.G * NWAVES;
    float* X = (float*)(ws + WS_X); bf16* H = (bf16*)(ws + WS_H); const float* MOD = (const float*)(ws + WS_MOD);
    const bf16* YS = (const bf16*)(ws + WS_XS); const int* POS = (const int*)(ws + WS_POS); const float* GATE = (const float*)(ws + WS_GATE);
    const int nrows = (l == DEPTH) ? T_LAT : T_ALL;
    for (int row = gw; row < nrows; row += NGW) {
        const int w = row < T_LAT ? (row >> 12) : 8;
        f32x4* xr = (f32x4*)(X + (size_t)row * D) + lane;
        f32x4 v[4];
#pragma unroll
        for (int j = 0; j < 4; ++j) v[j] = xr[64 * j];
        if (l > 0) {
            f32x4 mo[4];
#pragma unroll
            for (int j = 0; j < 4; ++j) mo[j] = (f32x4){0.f, 0.f, 0.f, 0.f};
#pragma unroll
            for (int k = 0; k < TOPK; ++k) { const int p = POS[row * 4 + k]; const float g = GATE[row * 4 + k];
                const v2u* yr = (const v2u*)(YS + (size_t)p * D) + lane;
#pragma unroll
                for (int j = 0; j < 4; ++j) { const v2u y = yr[64 * j]; mo[j][0] += g * bflo(y.x); mo[j][1] += g * bfhi(y.x); mo[j][2] += g * bflo(y.y); mo[j][3] += g * bfhi(y.y); } }
            const f32x4* g2 = (const f32x4*)(MOD + (size_t)((l - 1) * 9 + w) * 6144 + 5120) + lane;
#pragma unroll
            for (int j = 0; j < 4; ++j) { v[j] = v[j] + g2[64 * j] * mo[j]; xr[64 * j] = v[j]; }
        }
        float ss = 0.f;
#pragma unroll
        for (int j = 0; j < 4; ++j) ss += (v[j][0] * v[j][0] + v[j][1] * v[j][1]) + (v[j][2] * v[j][2] + v[j][3] * v[j][3]);
        const float rstd = 1.0f / sqrtf(wave_sum(ss) * (1.f / D) + 1e-6f);
        if (l == DEPTH) {
            const f32x4* fg = (const f32x4*)a.in[I_FING] + lane; f32x4* o = (f32x4*)(a.out + (size_t)row * D) + lane;
#pragma unroll
            for (int j = 0; j < 4; ++j) o[64 * j] = v[j] * rstd * fg[64 * j];
        } else {
            const f32x4* ng = (const f32x4*)(a.in[I_N1G] + l * D) + lane;
            const f32x4* sh = (const f32x4*)(MOD + (size_t)(l * 9 + w) * 6144) + lane; const f32x4* sc = (const f32x4*)(MOD + (size_t)(l * 9 + w) * 6144 + 1024) + lane;
            v2u* ho = (v2u*)(H + (size_t)row * D) + lane;
#pragma unroll
            for (int j = 0; j < 4; ++j) { const f32x4 h = v[j] * rstd * ng[64 * j] * (sc[64 * j] + 1.0f) + sh[64 * j]; v2u o; o.x = pk2(h[0], h[1]); o.y = pk2(h[2], h[3]); ho[64 * j] = o; }
        }
    }
}

__device__ __forceinline__ void stage_rw_prep1(const Ctx& F, int l) {
    const auto& a = *F.a; unsigned char* ws = a.ws;
    const bf16* Z = (const bf16*)(ws + WS_Z); bf16* ARW = (bf16*)(ws + WS_ARW);
    const int j = F.tid & 255, col = 1536 + j;
    const float* cw = a.in[I_RWCW] + (size_t)l * 3 * 1792; const float w0 = cw[col], w1 = cw[1792 + col], w2 = cw[2 * 1792 + col], cb = a.in[I_RWCB][l * 1792 + col];
    for (int row = F.bid * 2 + (F.tid >> 8); row < T_ALL; row += F.G * 2) {
        int base, pos, n; row_seq(row, base, pos, n);
        float v = conv3z(Z + (size_t)base * IN_COLS + RW_OFF + col, pos, n, w0, w1, w2, cb);
        if (j < 64) v = tanhf(v); else if (j >= 128) v = sigm(v);
        ARW[(size_t)row * 256 + j] = (bf16)f2bf(v);
    }
}

__device__ __forceinline__ void stage_rw_prep2(const Ctx& F, int l) {
    const auto& a = *F.a; unsigned char* ws = a.ws; const int lane = F.lane;
    const bf16* Z = (const bf16*)(ws + WS_Z); const bf16* P = (const bf16*)(ws + WS_P); bf16* SCN = (bf16*)(ws + WS_SCN);
    const int gw = F.bid * NWAVES + F.wave, NGW = F.G * NWAVES;
    constexpr int TR = 17, NRT = T_ALL / TR;
    const float* cw = a.in[I_RWCW] + (size_t)l * 3 * 1792; const float* cbp = a.in[I_RWCB] + l * 1792;
    for (int tile = gw; tile < NRT * 4; tile += NGW) {
        const int rt = tile % NRT, hp = tile / NRT, row0 = rt * TR, c0 = hp * 128 + 2 * lane;
        f32x2 w[3][3], cb[3];
#pragma unroll
        for (int s = 0; s < 3; ++s) { cb[s] = *(const f32x2*)(cbp + s * 512 + c0);
#pragma unroll
            for (int j = 0; j < 3; ++j) w[s][j] = *(const f32x2*)(cw + j * 1792 + s * 512 + c0); }
        const f32x2 KKw = *(const f32x2*)(a.in[I_RWKK] + l * 512 + c0), KAw = *(const f32x2*)(a.in[I_RWKA] + l * 512 + c0);
        f32x2 W0[2], A0[2];
#pragma unroll
        for (int d = 0; d < 2; ++d) { W0[d] = *(const f32x2*)(a.in[I_RWW0] + (l * 2 + d) * 512 + c0); A0[d] = *(const f32x2*)(a.in[I_RWA0] + (l * 2 + d) * 512 + c0); }
        const unsigned* zb = (const unsigned*)(Z + RW_OFF + c0);
        unsigned zm[3], z0[3], zp[3];
#pragma unroll
        for (int s = 0; s < 3; ++s) { zm[s] = row0 > 0 ? zb[(size_t)(row0 - 1) * (IN_COLS / 2) + s * 256] : 0u; z0[s] = zb[(size_t)row0 * (IN_COLS / 2) + s * 256]; }
#pragma unroll 1
        for (int i = 0; i < TR; ++i) {
            const int row = row0 + i; int base, pos, n; row_seq(row, base, pos, n);
#pragma unroll
            for (int s = 0; s < 3; ++s) zp[s] = (row + 1 < T_ALL) ? zb[(size_t)(row + 1) * (IN_COLS / 2) + s * 256] : 0u;
            const float mlo = pos > 0 ? 1.f : 0.f, mhi = pos < n - 1 ? 1.f : 0.f;
            f32x2 u[3];
#pragma unroll
            for (int s = 0; s < 3; ++s) { u[s] = (f32x2){bflo(zm[s]), bfhi(zm[s])} * mlo * w[s][0] + (f32x2){bflo(z0[s]), bfhi(z0[s])} * w[s][1] + (f32x2){bflo(zp[s]), bfhi(zp[s])} * mhi * w[s][2] + cb[s]; zm[s] = z0[s]; z0[s] = zp[s]; }
            const f32x2 r = u[0], k = u[1], v = u[2];
            f32x2 kk = k * KKw;
            const float ss = red32(kk[0] * kk[0] + kk[1] * kk[1]);
            kk = kk * (1.0f / sqrtf(fmaxf(ss, 1e-24f)));
            const unsigned* pr = (const unsigned*)(P + (size_t)row * 2560 + c0);
            unsigned* o = (unsigned*)(SCN + (size_t)row * 9 * 512 + c0);
            o[0] = pk2(r[0], r[1]); o[256] = pk2(v[0], v[1]); o[2 * 256] = pk2(kk[0], kk[1]);
#pragma unroll
            for (int d = 0; d < 2; ++d) {
                const unsigned pw = pr[d * 256], pa = pr[512 + d * 256];
                float ld[2], kd[2], be[2];
#pragma unroll
                for (int e = 0; e < 2; ++e) {
                    const float uu = W0[d][e] + (e ? bfhi(pw) : bflo(pw));
                    const float sp = fmaxf(-uu, 0.f) + log1pf(expf(-fabsf(uu)));
                    ld[e] = -expf(-sp - 0.5f);
                    const float av = sigm(A0[d][e] + (e ? bfhi(pa) : bflo(pa)));
                    kd[e] = k[e] * (1.f + (av - 1.f) * KAw[e]); be[e] = kk[e] * av; }
                o[(3 + 3 * d) * 256] = pk2(ld[0], ld[1]); o[(4 + 3 * d) * 256] = pk2(kd[0], kd[1]); o[(5 + 3 * d) * 256] = pk2(be[0], be[1]);
            }
        }
    }
}

__device__ __forceinline__ int seq_row(int b, int d, int sidx) {
    if (sidx < CTXL) { const int t = d ? (CTXL - 1 - sidx) : sidx; return T_LAT + b * CTXL + t; }
    const int tl = sidx - CTXL; const int t = d ? (SEQ - 1 - tl) : tl; return b * SEQ + t;
}

constexpr int CW_WORK = 16384;
__device__ __forceinline__ void rw_scan_item(const Ctx& F, int l, int it) {
    const auto& a = *F.a; unsigned char* ws = a.ws; const int tid = F.tid, lane = F.lane;
    const bf16* SCN = (const bf16*)(ws + WS_SCN); float* YD = (float*)(ws + WS_YDIR);
    LAS float* sbuf = (LAS float*)F.lds;
    LAS float* ybuf = (LAS float*)(F.lds + 49152);
    const int ls = tid >> 5, lj = tid & 31;
    const int vl = lane >> 3, kq = lane & 7, vrow = F.wave * 8 + vl;
    constexpr int NCH = (CTXL + SEQ) / 16;
    const int d = it & 1, h = (it >> 1) & 7, b = it >> 4;
    f32x2 S[4];
#pragma unroll
    for (int q = 0; q < 4; ++q) S[q] = (f32x2){0.f, 0.f};
    unsigned ldr[6];
#define RW_ISSUE(c) do { const int row_ = seq_row(b, d, (c) * 16 + ls); const unsigned* p_ = (const unsigned*)(SCN + (size_t)row_ * 9 * 512 + h * 64) + lj; \
        ldr[0] = p_[2 * 256]; ldr[1] = p_[(3 + 3 * d) * 256]; ldr[2] = p_[(5 + 3 * d) * 256]; ldr[3] = p_[(4 + 3 * d) * 256]; ldr[4] = p_[0]; ldr[5] = p_[256]; } while (0)
#define RW_WRITE(bufi) do { LAS float* o_ = sbuf + (((bufi) * 16 + ls) * 6) * 64 + 2 * lj; \
        *(LAS f32x2*)(o_) = (f32x2){-bflo(ldr[0]), -bfhi(ldr[0])}; *(LAS f32x2*)(o_ + 64) = (f32x2){__expf(bflo(ldr[1])), __expf(bfhi(ldr[1]))}; \
        *(LAS f32x2*)(o_ + 128) = (f32x2){bflo(ldr[2]), bfhi(ldr[2])}; *(LAS f32x2*)(o_ + 192) = (f32x2){bflo(ldr[3]), bfhi(ldr[3])}; \
        *(LAS f32x2*)(o_ + 256) = (f32x2){bflo(ldr[4]), bfhi(ldr[4])}; *(LAS f32x2*)(o_ + 320) = (f32x2){bflo(ldr[5]), bfhi(ldr[5])}; } while (0)
#define RW_FLUSH(c) do { const int row_ = seq_row(b, d, (c) * 16 + ls); \
        *(f32x2*)(YD + ((size_t)d * T_ALL + row_) * 512 + h * 64 + 2 * lj) = *(const LAS f32x2*)(ybuf + ((((c) & 1) * 16 + ls) * 64) + 2 * lj); } while (0)
    RW_ISSUE(0); RW_WRITE(0);
    __syncthreads();
#pragma unroll 1
    for (int c = 0; c < NCH; ++c) {
        const int bi = c & 1;
        if (c + 1 < NCH) RW_ISSUE(c + 1);
        if (c > 0) RW_FLUSH(c - 1);
#pragma unroll 4
        for (int s = 0; s < 16; ++s) {
            const LAS float* sp = sbuf + ((bi * 16 + s) * 6) * 64 + 8 * kq;
            const f32x4 a0 = *(const LAS f32x4*)(sp), a1 = *(const LAS f32x4*)(sp + 4);
            const f32x4 w0 = *(const LAS f32x4*)(sp + 64), w1 = *(const LAS f32x4*)(sp + 68);
            const f32x4 b0 = *(const LAS f32x4*)(sp + 128), b1 = *(const LAS f32x4*)(sp + 132);
            const f32x4 k0 = *(const LAS f32x4*)(sp + 192), k1 = *(const LAS f32x4*)(sp + 196);
            const f32x4 r0 = *(const LAS f32x4*)(sp + 256), r1 = *(const LAS f32x4*)(sp + 260);
            const float vv = sbuf[((bi * 16 + s) * 6 + 5) * 64 + vrow];
            f32x2 ac = S[0] * (f32x2){a0[0], a0[1]} + S[1] * (f32x2){a0[2], a0[3]} + S[2] * (f32x2){a1[0], a1[1]} + S[3] * (f32x2){a1[2], a1[3]};
            const float sa = red8(ac[0] + ac[1]);
            const f32x2 sa2 = (f32x2){sa, sa}, vv2 = (f32x2){vv, vv};
            S[0] = S[0] * (f32x2){w0[0], w0[1]} + (sa2 * (f32x2){b0[0], b0[1]} + vv2 * (f32x2){k0[0], k0[1]});
            S[1] = S[1] * (f32x2){w0[2], w0[3]} + (sa2 * (f32x2){b0[2], b0[3]} + vv2 * (f32x2){k0[2], k0[3]});
            S[2] = S[2] * (f32x2){w1[0], w1[1]} + (sa2 * (f32x2){b1[0], b1[1]} + vv2 * (f32x2){k1[0], k1[1]});
            S[3] = S[3] * (f32x2){w1[2], w1[3]} + (sa2 * (f32x2){b1[2], b1[3]} + vv2 * (f32x2){k1[2], k1[3]});
            f32x2 yc = S[0] * (f32x2){r0[0], r0[1]} + S[1] * (f32x2){r0[2], r0[3]} + S[2] * (f32x2){r1[0], r1[1]} + S[3] * (f32x2){r1[2], r1[3]};
            const float y = red8(yc[0] + yc[1]);
            if (kq == 0) ybuf[((bi * 16 + s) * 64) + vrow] = y;
        }
        if (c + 1 < NCH) RW_WRITE(bi ^ 1);
        __syncthreads();
    }
    RW_FLUSH(NCH - 1);
    __syncthreads();
#undef RW_ISSUE
#undef RW_WRITE
#undef RW_FLUSH
}

__device__ __forceinline__ void stage_rw_readout(const Ctx& F, int l) {
    const auto& a = *F.a; unsigned char* ws = a.ws; const int lane = F.lane;
    const bf16* SCN = (const bf16*)(ws + WS_SCN); const bf16* P = (const bf16*)(ws + WS_P); const float* YD = (const float*)(ws + WS_YDIR); bf16* YRW = (bf16*)(ws + WS_YRW);
    const int gw = F.bid * NWAVES + F.wave, NGW = F.G * NWAVES;
    constexpr int TR = 17, NRT = T_ALL / TR;
    for (int tile = gw; tile < NRT * 4; tile += NGW) {
        const int rt = tile % NRT, hp = tile / NRT, row0 = rt * TR, c0 = hp * 128 + 2 * lane;
        const f32x2 rk = *(const f32x2*)(a.in[I_RWRK] + l * 512 + c0), lng = *(const f32x2*)(a.in[I_RWLNG] + l * 512 + c0), lnb = *(const f32x2*)(a.in[I_RWLNB] + l * 512 + c0);
#pragma unroll 4
        for (int i = 0; i < TR; ++i) {
            const int row = row0 + i;
            const unsigned* sp = (const unsigned*)(SCN + (size_t)row * 9 * 512 + c0);
            const unsigned ru = sp[0], vu = sp[256], k0u = sp[4 * 256], k1u = sp[7 * 256];
            const f32x2 y0 = *(const f32x2*)(YD + (size_t)row * 512 + c0), y1 = *(const f32x2*)(YD + ((size_t)T_ALL + row) * 512 + c0);
            const unsigned gu = *(const unsigned*)(P + (size_t)row * 2560 + 2048 + c0);
            const float bon = red32(bflo(ru) * (bflo(k0u) + bflo(k1u)) * rk[0] + bfhi(ru) * (bfhi(k0u) + bfhi(k1u)) * rk[1]);
            f32x2 y = y0 + y1 + (f32x2){bflo(vu), bfhi(vu)} * bon;
            const float mu = red32(y[0] + y[1]) * (1.f / 64.f);
            y = y - mu;
            const float var = red32(y[0] * y[0] + y[1] * y[1]) * (1.f / 64.f);
            const f32x2 yn = y * (1.0f / sqrtf(var + 64e-5f));
            const f32x2 ov = (yn * lng + lnb) * (f32x2){bflo(gu), bfhi(gu)};
            *(unsigned*)(YRW + (size_t)row * 512 + c0) = pk2(ov[0], ov[1]);
        }
    }
}

constexpr size_t WS_S5E = 6 * MiB;
constexpr int S5_NSEG = 4, S5_SEGLEN = (CTXL + SEQ) / S5_NSEG;
template <int PASS>
__device__ __forceinline__ void stage_s5_scan(const Ctx& F, int l) {
    const auto& a = *F.a; unsigned char* ws = a.ws; const int lane = F.lane;
    const bf16* Z = (const bf16*)(ws + WS_Z); float* YP = (float*)(ws + WS_YP); f32x2* S5E = (f32x2*)(ws + WS_S5E);
    LAS unsigned char* wl = F.lds + F.wave * 5632;
    LAS bf16* Hs = (LAS bf16*)wl;
    LAS float* ubuf = (LAS float*)(wl + 4352);
    for (int itx = F.bid * NWAVES + F.wave; itx < BATCH * 32 * 2 * S5_NSEG; itx += NWAVES * F.G) {
        const int seg = itx & (S5_NSEG - 1), it = itx >> 2;
        const int d = it & 1, g = (it >> 1) & 31, b = it >> 6, p = lane;
        const size_t gi = ((size_t)(l * 2 + d) * 32 + g) * 64 + p;
        const float are = a.in[I_S5ARE][gi], aim = a.in[I_S5AIM][gi], dt = expf(a.in[I_S5LDT][(l * 2 + d) * 32 + g]);
        const float mag = expf(are * dt), lbr = mag * cosf(aim * dt), lbi = mag * sinf(aim * dt);
        const float den = are * are + aim * aim, nr = lbr - 1.0f, cr = (nr * are + lbi * aim) / den, ci = (lbi * are - nr * aim) / den;
        f32x2 bb2[16];
        { const float* br = a.in[I_S5BRE] + (((size_t)l * 32 + g) * 64 + p) * 16; const float* bi = a.in[I_S5BIM] + (((size_t)l * 32 + g) * 64 + p) * 16;
#pragma unroll
          for (int h = 0; h < 16; ++h) { const float x = br[h], y = bi[h]; bb2[h] = (f32x2){cr * x - ci * y, cr * y + ci * x}; } }
        bf16x8 cf[4];
        f32x2 hst = (f32x2){0.f, 0.f};
        if (PASS == 1) {
            const int h = lane & 15, kg = lane >> 4;
#pragma unroll
            for (int kk = 0; kk < 4; ++kk) { const int k0 = 32 * kk + 8 * kg; const float sg = (kk < 2) ? 1.f : -1.f;
                const float* srcp = ((kk < 2) ? a.in[I_S5CRE] : a.in[I_S5CIM]) + (((size_t)l * 32 + g) * 16 + h) * 64 + (k0 & 63);
                const f32x4 c0 = *(const f32x4*)srcp, c1 = *(const f32x4*)(srcp + 4);
                v4u pk; pk.x = pk2(sg * c0[0], sg * c0[1]); pk.y = pk2(sg * c0[2], sg * c0[3]); pk.z = pk2(sg * c1[0], sg * c1[1]); pk.w = pk2(sg * c1[2], sg * c1[3]);
                cf[kk] = __builtin_bit_cast(bf16x8, pk); }
            float pr_ = lbr, pi_ = lbi, l64r = 1.f, l64i = 0.f;
#pragma unroll 1
            for (int q = 0; q < 10; ++q) { const float nr2 = pr_ * pr_ - pi_ * pi_, ni2 = 2.f * pr_ * pi_; pr_ = nr2; pi_ = ni2; if (q == 5) { l64r = pr_; l64i = pi_; } }
            const float lLr = pr_ * l64r - pi_ * l64i, lLi = pr_ * l64i + pi_ * l64r;
#pragma unroll 1
            for (int sgi = 0; sgi < seg; ++sgi) { const f32x2 ev = S5E[((size_t)it * S5_NSEG + sgi) * 64 + p];
                hst = (f32x2){lLr * hst[0] - lLi * hst[1] + ev[0], lLr * hst[1] + lLi * hst[0] + ev[1]}; }
        }
        const f32x2 lbr2 = (f32x2){lbr, lbr}, lbi2 = (f32x2){lbi, lbi};
        v4u un = (v4u){0u, 0u, 0u, 0u};
        const int sbeg = seg * S5_SEGLEN, send = sbeg + S5_SEGLEN;
#define S5_LOADU(s0_) do { if (lane < 32) { const int row_ = seq_row(b, d, (s0_) + (lane >> 1)); un = *(const v4u*)(Z + (size_t)row_ * IN_COLS + S5_OFF + g * 16 + (lane & 1) * 8); } } while (0)
#define S5_WRITEU() do { if (lane < 32) { LAS float* up_ = ubuf + (lane >> 1) * 16 + (lane & 1) * 8; \
            *(LAS f32x4*)up_ = (f32x4){bflo(un.x), bfhi(un.x), bflo(un.y), bfhi(un.y)}; *(LAS f32x4*)(up_ + 4) = (f32x4){bflo(un.z), bfhi(un.z), bflo(un.w), bfhi(un.w)}; } } while (0)
        S5_LOADU(sbeg); S5_WRITEU();
#pragma unroll 1
        for (int s0 = sbeg; s0 < send; s0 += 16) {
            if (s0 + 16 < send) S5_LOADU(s0 + 16);
            LDS_WAIT(); asm volatile("" ::: "memory");
#pragma unroll 4
            for (int s = 0; s < 16; ++s) {
                f32x2 bu = (f32x2){0.f, 0.f};
#pragma unroll
                for (int q = 0; q < 4; ++q) { const f32x4 u4 = *(const LAS f32x4*)(ubuf + s * 16 + 4 * q);
#pragma unroll
                    for (int j = 0; j < 4; ++j) bu += (f32x2){u4[j], u4[j]} * bb2[4 * q + j]; }
                const f32x2 sw = (f32x2){-hst[1], hst[0]};
                hst = lbr2 * hst + (lbi2 * sw + bu);
                if (PASS == 1) { Hs[s * 136 + p] = (bf16)f2bf(hst[0]); Hs[s * 136 + 64 + p] = (bf16)f2bf(hst[1]); }
            }
            LDS_WAIT(); asm volatile("" ::: "memory");
            if (PASS == 1) {
                f32x4 acc = (f32x4){0.f, 0.f, 0.f, 0.f};
#pragma unroll
                for (int kk = 0; kk < 4; ++kk) { const bf16x8 af = *(const LAS bf16x8*)(Hs + (lane & 15) * 136 + 32 * kk + 8 * (lane >> 4)); acc = __builtin_amdgcn_mfma_f32_16x16x32_bf16(af, cf[kk], acc, 0, 0, 0); }
#pragma unroll
                for (int r = 0; r < 4; ++r) { const int row = seq_row(b, d, s0 + 4 * (lane >> 4) + r); YP[((size_t)d * T_ALL + row) * 512 + g * 16 + (lane & 15)] = acc[r]; }
                LDS_WAIT(); asm volatile("" ::: "memory");
            }
            if (s0 + 16 < send) S5_WRITEU();
        }
        if (PASS == 0) S5E[((size_t)it * S5_NSEG + seg) * 64 + p] = hst;
#undef S5_LOADU
#undef S5_WRITEU
    }
}

__device__ __forceinline__ void stage_s5_prep(const Ctx& F, int l) {
    const auto& a = *F.a; unsigned char* ws = a.ws;
    const bf16* Z = (const bf16*)(ws + WS_Z); const float* YP = (const float*)(ws + WS_YP); bf16* AS5 = (bf16*)(ws + WS_AS5);
    const float dsk = a.in[I_S5D][l * 512 + F.tid];
    for (int row = F.bid; row < T_ALL; row += F.G) {
        const int c = F.tid;
        const float u = bf2f(Z[(size_t)row * IN_COLS + S5_OFF + c]);
        const float y = YP[(size_t)row * 512 + c] + YP[((size_t)T_ALL + row) * 512 + c] + u * dsk;
        const float ge = 0.5f * y * (1.f + tanhf(0.7978845608028654f * (y + 0.044715f * y * y * y)));
        AS5[(size_t)row * 512 + c] = (bf16)f2bf(ge);
    }
}

__device__ __forceinline__ void stage_hy_pre(const Ctx& F, int l) {
    const auto& a = *F.a; unsigned char* ws = a.ws; const int lane = F.lane;
    const bf16* Z = (const bf16*)(ws + WS_Z); bf16* UT = (bf16*)(ws + WS_UT);
    LAS bf16* tl = (LAS bf16*)(F.lds + 45056 + F.wave * 8448);
    const float* cw = a.in[I_HYCW] + (size_t)l * 3 * 1536; const float* cbp = a.in[I_HYCB] + l * 1536;
    const int gw = F.bid * NWAVES + F.wave, NGW = F.G * NWAVES;
    for (int tile = gw; tile < (T_ALL / 64) * 24; tile += NGW) {
        const int rt = tile / 24, ct = tile % 24, row0 = rt * 64, col = ct * 64 + lane;
        int base, pos0, n; row_seq(row0, base, pos0, n);
        const bf16* zc = Z + (size_t)base * IN_COLS + HY_OFF + col;
        const float w0 = cw[col], w1 = cw[1536 + col], w2 = cw[2 * 1536 + col], cb = cbp[col];
        float zm = pos0 > 0 ? bf2f(zc[(size_t)(pos0 - 1) * IN_COLS]) : 0.f, z0 = bf2f(zc[(size_t)pos0 * IN_COLS]);
#pragma unroll 8
        for (int r = 0; r < 64; ++r) { const float zp = (pos0 + r + 1 < n) ? bf2f(zc[(size_t)(pos0 + r + 1) * IN_COLS]) : 0.f;
            tl[lane * 66 + r] = (bf16)f2bf(w0 * zm + w1 * z0 + w2 * zp + cb); zm = z0; z0 = zp; }
        LDS_WAIT(); asm volatile("" ::: "memory");
        bf16* up = UT + (size_t)(ct * 64) * T_ALL + row0 + lane;
#pragma unroll 8
        for (int cc = 0; cc < 64; ++cc) up[(size_t)cc * T_ALL] = tl[cc * 66 + lane];
        LDS_WAIT(); asm volatile("" ::: "memory");
    }
}
__device__ __forceinline__ void stage_hy_post(const Ctx& F, int l) {
    const auto& a = *F.a; unsigned char* ws = a.ws; const int lane = F.lane;
    const bf16* YT = (const bf16*)(ws + WS_UT) + (size_t)1024 * T_ALL; bf16* YHY = (bf16*)(ws + WS_YHY);
    LAS bf16* tl = (LAS bf16*)(F.lds + F.wave * 8448);
    const int gw = F.bid * NWAVES + F.wave, NGW = F.G * NWAVES;
    for (int tile = gw; tile < (T_ALL / 64) * 8; tile += NGW) {
        const int rt = tile >> 3, ct = tile & 7, row0 = rt * 64, c0 = ct * 64;
        const bf16* yp = YT + (size_t)c0 * T_ALL + row0 + lane;
#pragma unroll 8
        for (int cc = 0; cc < 64; ++cc) tl[cc * 66 + lane] = yp[(size_t)cc * T_ALL];
        LDS_WAIT(); asm volatile("" ::: "memory");
        bf16* op = YHY + (size_t)row0 * 512 + c0 + lane;
#pragma unroll 8
        for (int r = 0; r < 64; ++r) op[(size_t)r * 512] = tl[lane * 66 + r];
        LDS_WAIT(); asm volatile("" ::: "memory");
    }
}
typedef float f32x16 __attribute__((ext_vector_type(16)));
__device__ __forceinline__ void hyena_item(const Ctx& F, int l, int c, int isctx) {
    const auto& a = *F.a; unsigned char* ws = a.ws; const int tid = F.tid, lane = F.lane;
    const int n = isctx ? CTXL : SEQ, rowbase = isctx ? T_LAT : 0, RL = isctx ? HY_RLENC : HY_RLEN, off = n + 47;
    const bf16* UT = (const bf16*)(ws + WS_UT);
    const bf16* x1g = UT + (size_t)c * T_ALL + rowbase; const bf16* x2g = UT + (size_t)(512 + c) * T_ALL + rowbase; bf16* vg = (bf16*)UT + (size_t)(1024 + c) * T_ALL + rowbase;
    const bf16* Rg = (const bf16*)(ws + WS_GF + l * GF_STRIDE + (isctx ? GF_CTX : 0)) + (size_t)c * RL;
    LAS unsigned char* XB = F.lds; LAS unsigned char* R1 = F.lds + HY_R1_OFF; LAS unsigned char* R2 = F.lds + HY_R2_OFF;
    { const int cpb = n / 8;
      for (int q = tid; q < 8 * cpb; q += NTHREADS) { const int b = q / cpb, ch = q % cpb; *(LAS v4u*)(XB + b * HY_ROWB + 2 * HY_MARG + 16 * ch) = *(const v4u*)(vg + (size_t)b * n + 8 * ch); }
      if (tid < 256) { const int b = tid >> 5, side = (tid >> 4) & 1, ch = tid & 15; *(LAS v4u*)(XB + b * HY_ROWB + (side ? 2 * (HY_MARG + n) : 0) + 16 * ch) = (v4u){0u, 0u, 0u, 0u}; }
      const int rch = RL / 8;
      for (int q = tid; q < rch; q += NTHREADS) { *(LAS v4u*)(R1 + 16 * q) = *(const v4u*)(Rg + 8 * q); *(LAS v4u*)(R2 + 16 * q) = *(const v4u*)(Rg + (size_t)512 * RL + 8 * q); } }
    __syncthreads();
    const int i = lane & 31, kg = lane >> 5, jb = lane & 3, bb = (lane & 31) >> 2;
    const int rsh = (off - i) & 7, rd = rsh >> 1; const bool s1 = rd & 1, s2 = rd & 2; const unsigned sh = (rsh & 1) ? 16u : 0u;
    const int aconst = 2 * (off - i + 8 * kg - rsh), bconst = bb * HY_ROWB + 2 * (HY_MARG + 32 * jb + 8 * kg);
    const int T0w = 512 * F.wave; const int ntile = (n - T0w) >= 512 ? 4 : ((n - T0w) > 0 ? (n - T0w) / 128 : 0);
    const float bias0 = a.in[I_HYBIAS][(l * 2 + 0) * 512 + c], bias1 = a.in[I_HYBIAS][(l * 2 + 1) * 512 + c];
    f32x16 acc[4];
    v2u y1p[4][4];
#define HY_CONV(RB) do { \
        _Pragma("unroll") for (int m = 0; m < 4; ++m) _Pragma("unroll") for (int e = 0; e < 16; ++e) acc[m][e] = 0.f; \
        if (ntile > 0) { const int dhi = T0w + 128 * (ntile - 1) + 96; \
            _Pragma("unroll 1") for (int d = T0w - n + 16; d <= dhi; d += 16) { \
                const v4u wa = *(const LAS v4u*)((RB) + aconst - 2 * d), wb = *(const LAS v4u*)((RB) + aconst - 2 * d + 16); \
                const unsigned a0 = s1 ? wa.y : wa.x, a1 = s1 ? wa.z : wa.y, a2 = s1 ? wa.w : wa.z, a3 = s1 ? wb.x : wa.w, a4 = s1 ? wb.y : wb.x, a5 = s1 ? wb.z : wb.y, a6 = s1 ? wb.w : wb.z; \
                const unsigned b0 = s2 ? a2 : a0, b1 = s2 ? a3 : a1, b2 = s2 ? a4 : a2, b3 = s2 ? a5 : a3, b4 = s2 ? a6 : a4; \
                v4u af; af.x = __builtin_amdgcn_alignbit(b1, b0, sh); af.y = __builtin_amdgcn_alignbit(b2, b1, sh); af.z = __builtin_amdgcn_alignbit(b3, b2, sh); af.w = __builtin_amdgcn_alignbit(b4, b3, sh); \
                const bf16x8 afr = __builtin_bit_cast(bf16x8, af); \
                _Pragma("unroll") for (int m = 0; m < 4; ++m) { const int T0 = T0w + 128 * m; \
                    if (m < ntile && d >= T0 - n + 16 && d <= T0 + 96) { const bf16x8 bfr = *(const LAS bf16x8*)(XB + bconst + 2 * (T0 - d)); \
                        acc[m] = __builtin_amdgcn_mfma_f32_32x32x16_bf16(afr, bfr, acc[m], 0, 0, 0); } } } } } while (0)
    HY_CONV(R1);
#pragma unroll
    for (int m = 0; m < 4; ++m) if (m < ntile) {
#pragma unroll
        for (int rg = 0; rg < 4; ++rg) { const int t4 = T0w + 128 * m + 32 * jb + 8 * rg + 4 * kg;
            const v2u xv = *(const v2u*)(x1g + (size_t)bb * n + t4); const v2u vv = *(const LAS v2u*)(XB + bb * HY_ROWB + 2 * (HY_MARG + t4));
            const float y0 = bflo(xv.x) * (acc[m][4 * rg + 0] + bias0 * bflo(vv.x)), y1 = bfhi(xv.x) * (acc[m][4 * rg + 1] + bias0 * bfhi(vv.x));
            const float y2 = bflo(xv.y) * (acc[m][4 * rg + 2] + bias0 * bflo(vv.y)), y3 = bfhi(xv.y) * (acc[m][4 * rg + 3] + bias0 * bfhi(vv.y));
            y1p[m][rg].x = pk2(y0, y1); y1p[m][rg].y = pk2(y2, y3); } }
    __syncthreads();
#pragma unroll
    for (int m = 0; m < 4; ++m) if (m < ntile) {
#pragma unroll
        for (int rg = 0; rg < 4; ++rg) { const int t4 = T0w + 128 * m + 32 * jb + 8 * rg + 4 * kg; *(LAS v2u*)(XB + bb * HY_ROWB + 2 * (HY_MARG + t4)) = y1p[m][rg]; } }
    __syncthreads();
    HY_CONV(R2);
#pragma unroll
    for (int m = 0; m < 4; ++m) if (m < ntile) {
#pragma unroll
        for (int rg = 0; rg < 4; ++rg) { const int t4 = T0w + 128 * m + 32 * jb + 8 * rg + 4 * kg;
            const v2u xv = *(const v2u*)(x2g + (size_t)bb * n + t4); const v2u yv = y1p[m][rg];
            const float o0 = bflo(xv.x) * (acc[m][4 * rg + 0] + bias1 * bflo(yv.x)), o1 = bfhi(xv.x) * (acc[m][4 * rg + 1] + bias1 * bfhi(yv.x));
            const float o2 = bflo(xv.y) * (acc[m][4 * rg + 2] + bias1 * bflo(yv.y)), o3 = bfhi(xv.y) * (acc[m][4 * rg + 3] + bias1 * bfhi(yv.y));
            v2u ov; ov.x = pk2(o0, o1); ov.y = pk2(o2, o3); *(v2u*)(vg + (size_t)bb * n + t4) = ov; } }
    __syncthreads();
#undef HY_CONV
}
__device__ __forceinline__ void stage_mixer(const Ctx& F, int l) {
    unsigned* ctr = (unsigned*)(F.a->ws + WS_CTL) + CW_WORK + 64 * l;
    LAS int* itb = (LAS int*)(F.lds + LDSCTL_OFF + 512);
    const int nit = 128 + 512 + (l == 0 ? 512 : 0);
#ifdef PROBE_STATIC
    if (F.bid < 128) { for (int it = F.bid; it < 128; it += 128) rw_scan_item(F, l, it); }
    else { for (int it = 128 + (F.bid - 128); it < nit; it += F.G - 128) { if (it < 640) hyena_item(F, l, it - 128, 0); else hyena_item(F, l, it - 640, 1); } }
    return;
#endif
    for (;;) {
        if (F.tid == 0) *itb = (int)__hip_atomic_fetch_add(ctr, 1u, __ATOMIC_RELAXED, __HIP_MEMORY_SCOPE_AGENT);
        __syncthreads();
        const int it = *itb;
        __syncthreads();
        if (it >= nit) break;
        if (it < 128) rw_scan_item(F, l, it);
        else if (it < 640) hyena_item(F, l, it - 128, 0);
        else hyena_item(F, l, it - 640, 1);
    }
}

__device__ __forceinline__ void stage_norm2_router(const Ctx& F, int l) {
    const auto& a = *F.a; unsigned char* ws = a.ws; const int lane = F.lane;
    const float* X = (const float*)(ws + WS_X); bf16* H = (bf16*)(ws + WS_H); const float* MOD = (const float*)(ws + WS_MOD);
    int* EIDX = (int*)(ws + WS_EIDX); float* GATE = (float*)(ws + WS_GATE); int* BLKCNT = (int*)(ws + WS_BLKCNT);
    LAS float* hb = (LAS float*)(F.lds + F.wave * 16384);
    LAS int* hist = (LAS int*)(F.lds + LDSCTL_OFF + 1024);
    if (F.tid < 32) hist[F.tid] = 0;
    __syncthreads();
    const int rpb = (T_ALL + F.G - 1) / F.G, r0 = F.bid * rpb, r1 = (r0 + rpb < T_ALL) ? r0 + rpb : T_ALL;
    const int nrb = r1 > r0 ? r1 - r0 : 0, per = (nrb + NWAVES - 1) / NWAVES, wr0 = r0 + F.wave * per, wr1 = (wr0 + per < r1) ? wr0 + per : r1;
    const float* rw = a.in[I_RTW] + (size_t)l * 1024 * 32;
    const f32x4* ng = (const f32x4*)(a.in[I_N2G] + l * D) + lane;
    const int e = lane & 31, half = lane >> 5;
    const float rbias = a.in[I_RTB][l * 32 + e];
    for (int rg = wr0; rg < wr1; rg += 4) {
        const int nr = (wr1 - rg) < 4 ? (wr1 - rg) : 4;
#pragma unroll
        for (int j4 = 0; j4 < 4; ++j4) if (j4 < nr) {
            const int row = rg + j4; const int w = row < T_LAT ? (row >> 12) : 8;
            const f32x4* xr = (const f32x4*)(X + (size_t)row * D) + lane;
            f32x4 v[4];
#pragma unroll
            for (int j = 0; j < 4; ++j) v[j] = xr[64 * j];
            float ss = 0.f;
#pragma unroll
            for (int j = 0; j < 4; ++j) ss += (v[j][0] * v[j][0] + v[j][1] * v[j][1]) + (v[j][2] * v[j][2] + v[j][3] * v[j][3]);
            const float rstd = 1.0f / sqrtf(wave_sum(ss) * (1.f / D) + 1e-6f);
            const f32x4* sh = (const f32x4*)(MOD + (size_t)(l * 9 + w) * 6144 + 3072) + lane; const f32x4* sc = (const f32x4*)(MOD + (size_t)(l * 9 + w) * 6144 + 4096) + lane;
            v2u* ho = (v2u*)(H + (size_t)row * D) + lane;
#pragma unroll
            for (int j = 0; j < 4; ++j) { const f32x4 h = v[j] * rstd * ng[64 * j] * (sc[64 * j] + 1.0f) + sh[64 * j]; v2u o; o.x = pk2(h[0], h[1]); o.y = pk2(h[2], h[3]); ho[64 * j] = o;
                *(LAS f32x4*)(hb + j4 * 1024 + 4 * lane + 256 * j) = h; }
        }
        LDS_WAIT(); asm volatile("" ::: "memory");
        float acc[4] = {0.f, 0.f, 0.f, 0.f};
        const float* rp = rw + (size_t)(half * 512) * 32 + e; const LAS float* hp = hb + half * 512;
#pragma unroll 2
        for (int k = 0; k < 512; k += 4) {
            const float w0 = rp[(size_t)k * 32], w1 = rp[(size_t)(k + 1) * 32], w2 = rp[(size_t)(k + 2) * 32], w3 = rp[(size_t)(k + 3) * 32];
#pragma unroll
            for (int j4 = 0; j4 < 4; ++j4) { const f32x4 hv = *(const LAS f32x4*)(hp + j4 * 1024 + k); acc[j4] += (hv[0] * w0 + hv[1] * w1) + (hv[2] * w2 + hv[3] * w3); }
        }
#pragma unroll
        for (int j4 = 0; j4 < 4; ++j4) if (j4 < nr) {
            const int row = rg + j4;
            const float ahi = __builtin_bit_cast(float, __builtin_amdgcn_ds_bpermute(((lane ^ 32) << 2), __builtin_bit_cast(int, acc[j4])));
            const float logit = acc[j4] + ahi + rbias;
            float val = lane < 32 ? logit : -INFINITY; const int idx = e;
            float tv[4]; int ti[4];
#pragma unroll
            for (int r = 0; r < 4; ++r) { float bv = val; int bi = idx;
#pragma unroll
                for (int st = 0; st < 5; ++st) { const float ov = __builtin_bit_cast(float, xch32(__builtin_bit_cast(int, bv), st)); const int oi = xch32(bi, st); if (ov > bv || (ov == bv && oi < bi)) { bv = ov; bi = oi; } }
                bv = __builtin_bit_cast(float, __builtin_amdgcn_readlane(__builtin_bit_cast(int, bv), 0)); bi = __builtin_amdgcn_readlane(bi, 0);
                tv[r] = bv; ti[r] = bi; if (lane == bi) val = -INFINITY; }
            if (lane == 0) { const float e1 = expf(tv[1] - tv[0]), e2 = expf(tv[2] - tv[0]), e3 = expf(tv[3] - tv[0]); const float inv = 1.0f / (1.0f + e1 + e2 + e3);
                *(int4*)(EIDX + row * 4) = make_int4(ti[0], ti[1], ti[2], ti[3]); *(f32x4*)(GATE + row * 4) = (f32x4){inv, e1 * inv, e2 * inv, e3 * inv};
                __hip_atomic_fetch_add(&hist[ti[0]], 1, __ATOMIC_RELAXED, __HIP_MEMORY_SCOPE_WORKGROUP); __hip_atomic_fetch_add(&hist[ti[1]], 1, __ATOMIC_RELAXED, __HIP_MEMORY_SCOPE_WORKGROUP); __hip_atomic_fetch_add(&hist[ti[2]], 1, __ATOMIC_RELAXED, __HIP_MEMORY_SCOPE_WORKGROUP); __hip_atomic_fetch_add(&hist[ti[3]], 1, __ATOMIC_RELAXED, __HIP_MEMORY_SCOPE_WORKGROUP); }
        }
        LDS_WAIT(); asm volatile("" ::: "memory");
    }
    __syncthreads();
    if (F.tid < 32) BLKCNT[F.bid * 32 + F.tid] = hist[F.tid];
    __syncthreads();
}

__device__ __forceinline__ void stage_moe_scatter(const Ctx& F, int l) {
    const auto& a = *F.a; unsigned char* ws = a.ws; const int lane = F.lane;
    const bf16* H = (const bf16*)(ws + WS_H); bf16* XS = (bf16*)(ws + WS_XS);
    const int* EIDX = (const int*)(ws + WS_EIDX); int* POS = (int*)(ws + WS_POS); const int* BLKCNT = (const int*)(ws + WS_BLKCNT); int* META = (int*)(ws + WS_META);
    LAS int* tot = (LAS int*)F.lds; LAS int* off = tot + 32; LAS int* base = tot + 64; LAS int* posl = tot + 128; LAS int* eloc = tot + 4096;
    const int rpb = (T_ALL + F.G - 1) / F.G, r0 = F.bid * rpb, r1 = (r0 + rpb < T_ALL) ? r0 + rpb : T_ALL; const int na = (r1 > r0) ? (r1 - r0) * 4 : 0;
    for (int i = F.tid; i < na; i += NTHREADS) eloc[i] = EIDX[r0 * 4 + i];
    { LAS int* part = tot + 8192; const int e = F.tid & 31, pt = F.tid >> 5; int t = 0, o = 0;
      for (int b2 = pt; b2 < F.G; b2 += 16) { const int c = BLKCNT[b2 * 32 + e]; t += c; o += (b2 < F.bid) ? c : 0; }
      part[pt * 32 + e] = t; part[512 + pt * 32 + e] = o; }
    __syncthreads();
    if (F.tid < 32) { LAS int* part = tot + 8192; int t = 0, o = 0;
#pragma unroll
        for (int pt = 0; pt < 16; ++pt) { t += part[pt * 32 + F.tid]; o += part[512 + pt * 32 + F.tid]; }
        tot[F.tid] = t; off[F.tid] = o; }
    __syncthreads();
    if (F.tid == 0) { int acc = 0; for (int e = 0; e < 32; ++e) { base[e] = acc; acc += (tot[e] + 255) & ~255; } base[32] = acc; }
    __syncthreads();
    if (F.bid == 0 && F.tid < 33) META[F.tid] = base[F.tid];
    if (F.tid < 32) { int run = base[F.tid] + off[F.tid]; for (int i = 0; i < na; ++i) { if (eloc[i] == F.tid) { posl[i] = run; POS[r0 * 4 + i] = run; ++run; } } }
    __syncthreads();
    for (int i = F.wave; i < na; i += NWAVES) { const int row = r0 + (i >> 2); const int p = posl[i];
        const v4u* s = (const v4u*)(H + (size_t)row * D) + lane; v4u* dp = (v4u*)(XS + (size_t)p * D) + lane;
        dp[0] = s[0]; dp[64] = s[64]; }
    __syncthreads();
}
__device__ __forceinline__ LAS int* load_moe_base(const Ctx& F) {
    LAS int* base = (LAS int*)(F.lds + LDSCTL_OFF + 256);
    const int* META = (const int*)(F.a->ws + WS_META);
    if (F.tid < 33) base[F.tid] = META[F.tid];
    __syncthreads();
    return base;
}

constexpr int NSTAGE_L = 13, NSTAGES = 1 + DEPTH * NSTAGE_L + 1;
__global__ void __launch_bounds__(NTHREADS, 2) mk_fwd(Args args) {
    extern __shared__ __attribute__((aligned(16))) unsigned char lds_raw[];
    Ctx F; F.a = kargs(); F.lds = (LAS unsigned char*)lds_raw; F.tid = threadIdx.x; F.lane = F.tid & 63; F.wave = __builtin_amdgcn_readfirstlane(F.tid >> 6); F.bid = blockIdx.x; F.G = gridDim.x;
    volatile LAS unsigned* MISC = (volatile LAS unsigned*)(F.lds + LDSCTL_OFF);
    for (int u = F.tid; u < (LDS_BYTES - LDSCTL_OFF) / 4; u += NTHREADS) ((LAS unsigned*)(F.lds + LDSCTL_OFF))[u] = 0u;
    __syncthreads();
#if MK_PER_STAGE
#define GRID_BAR() do { } while (0)
#else
    (void)xcd_barrier_post((unsigned*)(F.a->ws + WS_CTL) + CW_BAR, MISC + 8);
#define GRID_BAR() do { XcdBarrier b_; b_.bar = (unsigned*)(kargs()->ws + WS_CTL) + CW_BAR; b_.x = xb_xcc_id(); b_.st = (volatile LAS unsigned*)((LAS unsigned char*)lds_raw + LDSCTL_OFF + opaque(32)); xcd_barrier(b_); } while (0)
#endif
#ifndef ONLY_S
#define ONLY_S -1
#endif
#define STG_SEL(k) (ONLY_S < 0 || ONLY_S == (((k) == 0) ? 0 : ((k) == NSTAGES - 1 ? 14 : (((k) - 1) % NSTAGE_L) + 1)))
#if MK_PER_STAGE
#define IN(k) (STG_SEL(k) && kargs()->ph_lo == (k))
#else
#define IN(k) STG_SEL(k)
#endif
#if MK_PER_STAGE
#define SEAM(k) do { } while (0)
#else
#define SEAM(k) do { if ((k) + 1 < NSTAGES) GRID_BAR(); } while (0)
#endif
#define STAGE(k) if (IN(k)) { F.a = kargs(); F.tid = opaque_v((int)threadIdx.x); F.lane = F.tid & 63; F.wave = __builtin_amdgcn_readfirstlane(F.tid >> 6); F.bid = opaque((int)blockIdx.x); F.G = opaque((int)gridDim.x); F.lds = (LAS unsigned char*)lds_raw + opaque(0); unsigned char* ws = F.a->ws; const int l = opaque(lq); unsigned char* wl = ws + WS_WTS + (size_t)l * WL_STRIDE; (void)wl; (void)ws;
#define STAGE_END(k) } SEAM(k);
    int lq = 0;
    STAGE(0) p0_prologue(F); STAGE_END(0)
    for (lq = 0; lq < DEPTH; ++lq) {
        const int sb = 1 + lq * NSTAGE_L;
        STAGE(sb + 0) stage_norm1(F, l); STAGE_END(sb + 0)
        STAGE(sb + 1) pg8::SchedStatic S; S.init(ws + WS_H, wl + WO_WIN, T_ALL, IN_COLS, 1024, F.G, F.bid); pg8::EpiBf16 E{(bf16*)(ws + WS_Z), IN_COLS, nullptr, 0};
            pg8::gemm_phase(F.lds, F.tid, 1024, S, E); STAGE_END(sb + 1)
        STAGE(sb + 2) stage_rw_prep1(F, l); stage_s5_scan<0>(F, l); stage_hy_pre(F, l); STAGE_END(sb + 2)
        STAGE(sb + 3) { pg8::SchedStatic S; S.init(ws + WS_ARW, wl + WO_RWCAT, T_ALL, 2560, 256, F.G, F.bid); pg8::EpiBf16 E{(bf16*)(ws + WS_P), 2560, nullptr, 0}; pg8::gemm_phase(F.lds, F.tid, 256, S, E); }
            stage_s5_scan<1>(F, l); STAGE_END(sb + 3)
        STAGE(sb + 4) stage_rw_prep2(F, l); stage_s5_prep(F, l); STAGE_END(sb + 4)
        STAGE(sb + 5) stage_mixer(F, l); STAGE_END(sb + 5)
        STAGE(sb + 6) { pg8::SchedStatic S; S.init(ws + WS_AS5, wl + WO_GLU, T_ALL, 1024, 512, F.G, F.bid); pg8::EpiGlu<0> E{(bf16*)(ws + WS_YS5), 512, F.a->in[I_S5GLUB] + l * 1024, 0, 512}; pg8::gemm_phase(F.lds, F.tid, 512, S, E); }
            stage_rw_readout(F, l); stage_hy_post(F, l); STAGE_END(sb + 6)
        STAGE(sb + 7) pg8::SchedMerge S; S.A0 = (const char*)(ws + WS_YHY); S.A1 = (const char*)(ws + WS_YRW); S.A2 = (const char*)(ws + WS_YS5); S.Bt = (const char*)(wl + WO_WBR); S.tstep = (size_t)256 * 512 * 2; S.bstride = (size_t)1024 * 512 * 2;
            S.nM = T_ALL / 256; S.nN = 4; S.G = F.G; S.c = F.bid;
            pg8::EpiMerge E{(float*)(ws + WS_MTMP), (bf16*)(ws + WS_H), (const bf16*)(ws + WS_Z) + GATE_OFF}; pg8::gemm_phase(F.lds, F.tid, 512, S, E); STAGE_END(sb + 7)
        STAGE(sb + 8) pg8::SchedStatic S; S.init(ws + WS_H, wl + WO_WOUT, T_ALL, 1024, 1024, F.G, F.bid); pg8::EpiResid E{(float*)(ws + WS_X), (const float*)(ws + WS_MOD) + (size_t)l * 9 * 6144 + 2048};
            pg8::gemm_phase(F.lds, F.tid, 1024, S, E); STAGE_END(sb + 8)
        STAGE(sb + 9) stage_norm2_router(F, l); STAGE_END(sb + 9)
        STAGE(sb + 10) stage_moe_scatter(F, l); STAGE_END(sb + 10)
        STAGE(sb + 11) LAS int* base = load_moe_base(F);
            pg8::SchedMoe S; S.A = (const char*)(ws + WS_XS); S.Bt = (const char*)(wl + WO_W1); S.tstep = (size_t)256 * 1024 * 2; S.estride = (size_t)2048 * 1024 * 2; S.NPN = 8; S.G = F.G; S.c = F.bid; S.base = base;
            pg8::EpiGlu<1> E{(bf16*)(ws + WS_ACT), 1024, F.a->in[I_B1] + (size_t)l * 32 * 2048, 2048, 1024}; pg8::gemm_phase(F.lds, F.tid, 1024, S, E); STAGE_END(sb + 11)
        STAGE(sb + 12) LAS int* base = load_moe_base(F);
            pg8::SchedMoe S; S.A = (const char*)(ws + WS_ACT); S.Bt = (const char*)(wl + WO_W2); S.tstep = (size_t)256 * 1024 * 2; S.estride = (size_t)1024 * 1024 * 2; S.NPN = 4; S.G = F.G; S.c = F.bid; S.base = base;
            pg8::EpiBf16 E{(bf16*)(ws + WS_XS), 1024, F.a->in[I_B2] + (size_t)l * 32 * 1024, 1024}; pg8::gemm_phase(F.lds, F.tid, 1024, S, E); STAGE_END(sb + 12)
    }
    lq = DEPTH;
    STAGE(NSTAGES - 1) stage_norm1(F, l); }
#undef IN
#undef SEAM
}

extern "C" void kernel_launch(void* const* d_in, const int* in_sizes, int n_in, void* d_out, int out_size, void* d_ws, size_t ws_size, hipStream_t stream) {
    static int grid = 0;
    if (grid == 0) {
        if (n_in != 51 || out_size != T_LAT * D || ws_size < WS_END) { fprintf(stderr, "kernel_launch: unexpected shapes (n_in %d out %d ws %zu, need %zu)\n", n_in, out_size, ws_size, (size_t)WS_END); grid = -1; return; }
        int dev = 0, cus = 0, per_cu = 0;
        if (hipGetDevice(&dev) != hipSuccess || hipDeviceGetAttribute(&cus, hipDeviceAttributeMultiprocessorCount, dev) != hipSuccess) { grid = -1; return; }
        if (hipFuncSetAttribute((const void*)mk_fwd, hipFuncAttributeMaxDynamicSharedMemorySize, LDS_BYTES) != hipSuccess) { fprintf(stderr, "kernel_launch: hipFuncSetAttribute failed\n"); grid = -1; return; }
        if (hipOccupancyMaxActiveBlocksPerMultiprocessor(&per_cu, (const void*)mk_fwd, NTHREADS, LDS_BYTES) != hipSuccess || per_cu < 1) fprintf(stderr, "kernel_launch: occupancy query says %d\n", per_cu);
        (void)hipGetLastError();
        grid = cus;
    }
    if (grid < 0) return;
    if (hipMemsetAsync((char*)d_ws + WS_CTL, 0, CTL_ZERO_BYTES, stream) != hipSuccess) return;
    Args a{};
    for (int i = 0; i < 51; ++i) a.in[i] = (const float*)d_in[i];
    a.out = (float*)d_out; a.ws = (unsigned char*)d_ws;
#if MK_PER_STAGE
    for (int s = 0; s < NSTAGES; ++s) { a.ph_lo = s; a.ph_hi = s + 1; int reps = 1;
#ifdef PROBE_SET
        { const int ls = (s == 0 || s == NSTAGES - 1) ? -1 : (s - 1) % NSTAGE_L;
          if (PROBE_SET == 1 && ls == 1) reps = 2;
          if (PROBE_SET == 2 && ls == 2) reps = 2;
          if (PROBE_SET == 3 && (ls == 3 || ls == 4)) reps = 2;
          if (PROBE_SET == 4 && (ls == 6 || ls == 7)) reps = 2;
          if (PROBE_SET == 5 && (ls == 9 || ls == 10)) reps = 2;
          if (PROBE_SET == 6 && (ls == 11 || ls == 12)) reps = 2;
          if (PROBE_SET == 7 && s == 0) reps = 2; }
#endif
        for (int r = 0; r < reps; ++r) hipLaunchKernelGGL(mk_fwd, dim3(grid), dim3(NTHREADS), LDS_BYTES, stream, a); }
#else
    a.ph_lo = 0; a.ph_hi = NSTAGES; hipLaunchKernelGGL(mk_fwd, dim3(grid), dim3(NTHREADS), LDS_BYTES, stream, a);
#endif
}
```

```cpp
#include <hip/hip_runtime.h>
#include <cstdio>
#include <cstdint>

#ifndef DUPK
#define DUPK 0
#endif
#define REPN(k) ((DUPK == (k)) ? 3 : 1)
#ifndef REP_GEMM
#define REP_GEMM 1
#endif
#ifndef REP_LIGHT
#define REP_LIGHT 1
#endif
#ifndef REP_PRO
#define REP_PRO 1
#endif
#ifndef MK_PER_STAGE
#define MK_PER_STAGE 0
#endif

#define GAS __attribute__((address_space(1)))
#define LAS __attribute__((address_space(3)))
typedef unsigned short bf16;
typedef unsigned v4u __attribute__((ext_vector_type(4)));
typedef unsigned v2u __attribute__((ext_vector_type(2)));
typedef float f32x4 __attribute__((ext_vector_type(4)));
typedef float f32x2 __attribute__((ext_vector_type(2)));
typedef short bf16x8 __attribute__((ext_vector_type(8)));

constexpr int D = 1024, BATCH = 8, SEQ = 4096, CTXL = 256, DEPTH = 2;
constexpr int T_LAT = BATCH * SEQ, T_CTX = BATCH * CTXL, T_ALL = T_LAT + T_CTX;
constexpr int IN_COLS = 6912, HY_OFF = 0, RW_OFF = 1536, S5_OFF = 3328, GATE_OFF = 3840;
constexpr int NE = 32, TOPK = 4;
constexpr int MAXSLOT = 147456;
constexpr int NWAVES = 8, NTHREADS = 512;
constexpr int HY_MARG = 128, HY_ROWB = 8720, HY_RLEN = 8272, HY_RLENC = 592;
constexpr int HY_R1_OFF = 8 * HY_ROWB, HY_R2_OFF = HY_R1_OFF + HY_RLEN * 2;

constexpr size_t MiB = 1ull << 20;
constexpr size_t WS_CTL = 0, CTL_ZERO_BYTES = 1 * MiB;
constexpr size_t WS_MOD = 1 * MiB;
constexpr size_t WS_BLKCNT = 2 * MiB;
constexpr size_t WS_META = 2 * MiB + 512 * 1024;
constexpr size_t WS_EIDX = 3 * MiB, WS_GATE = 4 * MiB, WS_POS = 5 * MiB;
constexpr size_t WS_WTS = 8 * MiB, WL_STRIDE = 214 * MiB;
constexpr size_t WO_WIN = 0, WO_RWCAT = 14 * MiB, WO_GLU = 16 * MiB, WO_WBR = 17 * MiB, WO_WOUT = 20 * MiB, WO_W1 = 22 * MiB, WO_W2 = 150 * MiB;
constexpr size_t WS_GF = 436 * MiB, GF_STRIDE = 20 * MiB, GF_CTX = 17 * MiB;
constexpr size_t WS_X = 504 * MiB;
constexpr size_t WS_H = 640 * MiB;
constexpr size_t WS_BIG = 708 * MiB;
constexpr size_t WS_Z = WS_BIG;
constexpr size_t WS_SCN = 1167 * MiB;
constexpr size_t WS_MTMP = WS_SCN;
constexpr size_t WS_P = 1473 * MiB;
constexpr size_t WS_ARW = 1643 * MiB;
constexpr size_t WS_YP = 1660 * MiB;
constexpr size_t WS_YDIR = WS_YP;
constexpr size_t WS_UT = 1796 * MiB;
constexpr size_t WS_AS5 = 2000 * MiB;
constexpr size_t WS_YHY = 1898 * MiB, WS_YRW = 1932 * MiB, WS_YS5 = 1966 * MiB;
constexpr size_t WS_XS = WS_BIG;
constexpr size_t WS_ACT = WS_BIG + 288 * MiB;
constexpr size_t WS_END = 2034 * MiB;
constexpr int CW_BAR = 4096;

constexpr int RING_BYTES = 131072;
constexpr int LDSCTL_OFF = RING_BYTES;
constexpr int LDS_BYTES = 147456;

__device__ __forceinline__ unsigned f2bf(float f) { unsigned u = __builtin_bit_cast(unsigned, f); return (u + 0x7fffu + ((u >> 16) & 1u)) >> 16; }
__device__ __forceinline__ unsigned pk2(float lo, float hi) { return f2bf(lo) | (f2bf(hi) << 16); }
__device__ __forceinline__ float bf2f(bf16 b) { return __builtin_bit_cast(float, ((unsigned)b) << 16); }
__device__ __forceinline__ float bflo(unsigned w) { return __builtin_bit_cast(float, w << 16); }
__device__ __forceinline__ float bfhi(unsigned w) { return __builtin_bit_cast(float, w & 0xffff0000u); }
__device__ __forceinline__ float sigm(float x) { return 1.f / (1.f + __expf(-x)); }
#define LDS_WAIT() asm volatile("s_waitcnt lgkmcnt(0)" ::: "memory")
__device__ __forceinline__ float dpp_f(float x, const int ctrl_sel) {
    const int v = __builtin_bit_cast(int, x);
    int r;
    if (ctrl_sel == 0) r = __builtin_amdgcn_update_dpp(0, v, 0xB1, 0xF, 0xF, true);
    else if (ctrl_sel == 1) r = __builtin_amdgcn_update_dpp(0, v, 0x4E, 0xF, 0xF, true);
    else r = __builtin_amdgcn_update_dpp(0, v, 0x141, 0xF, 0xF, true);
    return __builtin_bit_cast(float, r);
}
__device__ __forceinline__ float red32(float x) {
    x += dpp_f(x, 0); x += dpp_f(x, 1); x += dpp_f(x, 2);
    x += __builtin_bit_cast(float, __builtin_amdgcn_update_dpp(0, __builtin_bit_cast(int, x), 0x128, 0xF, 0xF, true));
    x += __builtin_bit_cast(float, __builtin_amdgcn_ds_swizzle(__builtin_bit_cast(int, x), 0x401F));
    return x;
}
__device__ __forceinline__ float wave_sum(float v) {
    v = red32(v);
    return __builtin_bit_cast(float, __builtin_amdgcn_readlane(__builtin_bit_cast(int, v), 0)) + __builtin_bit_cast(float, __builtin_amdgcn_readlane(__builtin_bit_cast(int, v), 32));
}
__device__ __forceinline__ int xch32(int v, const int step) {
    if (step == 0) return __builtin_amdgcn_update_dpp(0, v, 0xB1, 0xF, 0xF, true);
    if (step == 1) return __builtin_amdgcn_update_dpp(0, v, 0x4E, 0xF, 0xF, true);
    if (step == 2) return __builtin_amdgcn_update_dpp(0, v, 0x141, 0xF, 0xF, true);
    if (step == 3) return __builtin_amdgcn_update_dpp(0, v, 0x128, 0xF, 0xF, true);
    return __builtin_amdgcn_ds_swizzle(v, 0x401F);
}
__device__ __forceinline__ float red8(float x) { x += dpp_f(x, 0); x += dpp_f(x, 1); x += dpp_f(x, 2); return x; }

#define XB_TMO      128
#define XB_XCNT(j)  (256  + 64 * (j))
#define XB_XSUB(j)  (1280 + 64 * (j))
#define XB_XGEN(j)  (2304 + 64 * (j))
#define XB_TOP      3328
#define XB_TOPGEN   3392
#define XCD_BAR_WORDS 3456
#define XB_SPIN_CAP (1u << 22)
__device__ __forceinline__ unsigned xb_ld(unsigned* p)              { return __hip_atomic_load(p, __ATOMIC_RELAXED, __HIP_MEMORY_SCOPE_AGENT); }
__device__ __forceinline__ unsigned xb_add(unsigned* p, unsigned v) { return __hip_atomic_fetch_add(p, v, __ATOMIC_RELAXED, __HIP_MEMORY_SCOPE_AGENT); }
__device__ __forceinline__ unsigned xb_xcc_id() { return (unsigned)__builtin_amdgcn_s_getreg((3 << 11) | 20) & 0xFu; }
#define XB_SPIN(cond, bar) do { unsigned _sp = 0; while (cond) { __builtin_amdgcn_s_sleep(1); \
    if ((++_sp & 255u) == 0u) { if (xb_ld(&(bar)[XB_TMO])) break; if (_sp > XB_SPIN_CAP) { atomicAdd(&(bar)[XB_TMO], 1u); break; } } } } while (0)
struct XcdBarrier { unsigned* bar; unsigned x; volatile LAS unsigned* st; };
__device__ __forceinline__ XcdBarrier xcd_barrier_post(unsigned* bar, volatile LAS unsigned* st) {
    XcdBarrier b; b.bar = bar; b.x = xb_xcc_id(); b.st = st;
    if (threadIdx.x == 0) (void)xb_add(&bar[XB_XCNT(b.x)], 1u);
    return b;
}
__device__ __forceinline__ void xcd_barrier_complete(unsigned* bar, unsigned x, unsigned& nloc, unsigned& nx) {
    const unsigned G = gridDim.x * gridDim.y * gridDim.z;
    unsigned sum, cnt, mine, sp = 0u;
    for (;;) {
        sum = 0u; cnt = 0u; mine = 0u;
#pragma unroll
        for (unsigned j = 0; j < 16; ++j) { const unsigned c = xb_ld(&bar[XB_XCNT(j)]); sum += c; cnt += (c > 0u) ? 1u : 0u; mine = (j == x) ? c : mine; }
        if (sum == G) break;
        __builtin_amdgcn_s_sleep(1);
        if ((++sp & 255u) == 0u) { if (xb_ld(&bar[XB_TMO])) break; if (sp > XB_SPIN_CAP) { atomicAdd(&bar[XB_TMO], 1u); break; } }
    }
    nloc = mine > 0u ? mine : 1u; nx = cnt > 0u ? cnt : 1u;
}
__device__ __forceinline__ void xcd_barrier(const XcdBarrier& b) {
    asm volatile("s_waitcnt vmcnt(0)" ::: "memory");
    __syncthreads();
    if (threadIdx.x == 0) {
        unsigned* bar = b.bar;
        __builtin_amdgcn_s_waitcnt(0);
        unsigned nloc = b.st[0], nx = b.st[1];
        if (nloc == 0u) { xcd_barrier_complete(bar, b.x, nloc, nx); b.st[0] = nloc; b.st[1] = nx; }
        const unsigned old = xb_add(&bar[XB_XSUB(b.x)], 1u);
        const unsigned gen = old / nloc;
        if (old + 1u == (gen + 1u) * nloc) {
            __builtin_amdgcn_fence(__ATOMIC_RELEASE, "agent");
            asm volatile("s_waitcnt vmcnt(0)" ::: "memory");
            const unsigned og = xb_add(&bar[XB_TOP], 1u);
            const unsigned tg = og / nx;
            if (og + 1u == (tg + 1u) * nx) xb_add(&bar[XB_TOPGEN], 1u);
            else XB_SPIN(xb_ld(&bar[XB_TOPGEN]) == tg, bar);
            __builtin_amdgcn_fence(__ATOMIC_ACQUIRE, "agent");
            xb_add(&bar[XB_XGEN(b.x)], 1u);
            asm volatile("s_waitcnt vmcnt(0)" ::: "memory");
        } else {
            XB_SPIN(xb_ld(&bar[XB_XGEN(b.x)]) == gen, bar);
            __builtin_amdgcn_fence(__ATOMIC_ACQUIRE, "agent");
            asm volatile("s_waitcnt vmcnt(0)" ::: "memory");
        }
    }
    __syncthreads();
}

namespace pg8 {
constexpr int BM = 256, BK = 64, HALF = 128, HTB = HALF * BK * 2, STAGE_BYTES = 8 * HTB, NXCD = 8, WGM = 8;
__host__ __device__ __forceinline__ int lds_byte(int r, int c) { const int st = (r >> 4) * 2 + (c >> 5), rr = r & 15, cc = c & 31, ob = rr * 64 + cc * 2; return st * 1024 + (ob ^ (((ob >> 9) & 1) << 5)); }
__host__ __device__ __forceinline__ void stage_rc(int b, int& R, int& C) { const int st = b / 1024, sb = b % 1024, swz = sb ^ (((sb >> 9) & 1) << 5); R = (st >> 1) * 16 + swz / 64; C = (st & 1) * 32 + (swz % 64) / 2; }
__host__ __device__ __forceinline__ int perm32(int rho) { const int n = rho >> 4, i = rho & 15; return 8 * (i >> 2) + 4 * n + (i & 3); }
struct Unit { int pm, pn, e; };
__device__ __forceinline__ unsigned cvt_pk_bf16(float lo, float hi) { unsigned r; asm volatile("v_cvt_pk_bf16_f32 %0, %1, %2" : "=v"(r) : "v"(lo), "v"(hi)); return r; }

__device__ __forceinline__ void tile_of(int L, int nM, int nN, int& pm, int& pn) {
    const int nwg = nM * nN; int wgid = L;
    { const int q = nwg / NXCD, r = nwg % NXCD, xcd = wgid % NXCD, off = wgid / NXCD; wgid = (xcd < r ? xcd * (q + 1) : r * (q + 1) + (xcd - r) * q) + off; }
    const int nig = WGM * nN, gid = wgid / nig, fm = gid * WGM, gsz = (nM - fm) < WGM ? (nM - fm) : WGM;
    pm = fm + ((wgid % nig) % gsz); pn = (wgid % nig) / gsz;
}
struct SchedStatic {
    const char* A; const char* Bt; size_t tstep; int nM, nN, G, c;
    __device__ __forceinline__ void init(const void* A_, const void* Bt_, int M, int N, int K, int G_, int c_) { A = (const char*)A_; Bt = (const char*)Bt_; tstep = (size_t)BM * K * 2; nM = M / BM; nN = N / BM; G = G_; c = c_; }
    __device__ __forceinline__ bool next(int i, Unit& u) const { const long L = (long)i * G + c; if (L >= (long)nM * nN) return false; tile_of((int)L, nM, nN, u.pm, u.pn); u.e = 0; return true; }
    __device__ __forceinline__ const char* aptr(const Unit& u) const { return A + (size_t)u.pm * tstep; }
    __device__ __forceinline__ const char* bptr(const Unit& u) const { return Bt + (size_t)u.pn * tstep; }
};
struct SchedMerge {
    const char* A0; const char* A1; const char* A2; const char* Bt; size_t tstep, bstride; int nM, nN, G, c;
    __device__ __forceinline__ bool next(int i, Unit& u) const { const int j = i / 3, br = i - 3 * j; const long L = (long)j * G + c; if (L >= (long)nM * nN) return false; tile_of((int)L, nM, nN, u.pm, u.pn); u.e = br; return true; }
    __device__ __forceinline__ const char* aptr(const Unit& u) const { return (u.e == 0 ? A0 : (u.e == 1 ? A1 : A2)) + (size_t)u.pm * tstep; }
    __device__ __forceinline__ const char* bptr(const Unit& u) const { return Bt + (size_t)u.e * bstride + (size_t)u.pn * tstep; }
};
struct SchedMoe {
    const char* A; const char* Bt; size_t tstep, estride; int NPN, G, c; const LAS int* base;
    __device__ __forceinline__ bool next(int i, Unit& u) const {
        const int ntiles = base[32] >> 8; const long L = (long)i * G + c; if (L >= (long)ntiles * NPN) return false;
        u.pm = (int)(L / NPN); u.pn = (int)(L % NPN); const int r0 = u.pm << 8; int e = 0;
#pragma unroll 1
        for (int k = 1; k < 32; ++k) e += (r0 >= base[k]) ? 1 : 0;
        u.e = e; return true;
    }
    __device__ __forceinline__ const char* aptr(const Unit& u) const { return A + (size_t)u.pm * tstep; }
    __device__ __forceinline__ const char* bptr(const Unit& u) const { return Bt + (size_t)u.e * estride + (size_t)u.pn * tstep; }
};

template <class Epi, class Sched>
__device__ __forceinline__ void gemm_phase(LAS unsigned char* lds, const int tid, const int K, const Sched& S, const Epi& E) {
    const int wid = __builtin_amdgcn_readfirstlane(tid >> 6), lane = tid & 63, wr = wid >> 2, wc = wid & 3, fr = lane & 15, fq = lane >> 4;
    const int nt = K / BK;
    unsigned voffA[2], voffB[2];
#pragma unroll
    for (int i = 0; i < 2; ++i) { int R, C; stage_rc(tid * 16 + i * 8192, R, C); const int Rb = Epi::PERM ? ((R & ~31) + perm32(R & 31)) : R;
        voffA[i] = (unsigned)(R * K + C) * 2u; voffB[i] = (unsigned)(Rb * K + C) * 2u; }
    const size_t kstep = (size_t)(BK * 2);
    const size_t hstep = (size_t)HALF * K * 2;
    const unsigned ldsw = (unsigned)wid * 1024u;
    const int aoff = lds_byte(wr * 64 + fr, fq * 8), boff = lds_byte(wc * 32 + fr, fq * 8);
#define PG8_SA(b, h) (((b) * 2 + (h)) * HTB)
#define PG8_SB(b, h) ((4 + (b) * 2 + (h)) * HTB)
#define PG8_STAGE(bufoff, gbase, voff) do { _Pragma("unroll") for (int _i = 0; _i < 2; ++_i) \
        __builtin_amdgcn_global_load_lds((const unsigned*)((const char*)(gbase) + (voff)[_i]), (LAS unsigned*)(lds + (bufoff) + ldsw + _i * 8192), 16, 0, 0); } while (0)
#define PG8_LDA(dst, b, h) do { _Pragma("unroll") for (int m = 0; m < 4; ++m) _Pragma("unroll") for (int k = 0; k < 2; ++k) dst[m][k] = *(const LAS bf16x8*)(lds + PG8_SA(b, h) + aoff + m * 2048 + k * 1024); } while (0)
#define PG8_LDB(dst, b, h) do { _Pragma("unroll") for (int n = 0; n < 2; ++n) _Pragma("unroll") for (int k = 0; k < 2; ++k) dst[n][k] = *(const LAS bf16x8*)(lds + PG8_SB(b, h) + boff + n * 2048 + k * 1024); } while (0)
#define PG8_MMA(ai, bj, At, Bt) do { __builtin_amdgcn_s_setprio(1); _Pragma("unroll") for (int m = 0; m < 4; ++m) _Pragma("unroll") for (int n = 0; n < 2; ++n) _Pragma("unroll") for (int k = 0; k < 2; ++k) \
        acc[ai][bj][m][n] = __builtin_amdgcn_mfma_f32_16x16x32_bf16(Bt[n][k], At[m][k], acc[ai][bj][m][n], 0, 0, 0); __builtin_amdgcn_s_setprio(0); } while (0)
#define PG8_WAIT_V(n) asm volatile("s_waitcnt vmcnt(" #n ")" ::: "memory")
#define PG8_WAIT_L(n) asm volatile("s_waitcnt lgkmcnt(" #n ")" ::: "memory")
#define PG8_BAR __builtin_amdgcn_s_barrier()
#define PG8_SCHED __builtin_amdgcn_sched_barrier(0)
    Unit cur, nxt; int ui = 0;
    if (!S.next(0, cur)) return;
    f32x4 acc[2][2][4][2];
#pragma unroll
    for (int a = 0; a < 2; ++a)
#pragma unroll
        for (int b = 0; b < 2; ++b)
#pragma unroll
            for (int m = 0; m < 4; ++m)
#pragma unroll
                for (int n = 0; n < 2; ++n) acc[a][b][m][n] = (f32x4){0.f, 0.f, 0.f, 0.f};
    bf16x8 At[4][2], B0[2][2], B1[2][2];
    const char* cA = S.aptr(cur); const char* cB = S.bptr(cur);
    PG8_STAGE(PG8_SB(0, 0), cB, voffB); PG8_STAGE(PG8_SB(0, 1), cB + hstep, voffB); PG8_STAGE(PG8_SA(0, 0), cA, voffA); PG8_STAGE(PG8_SA(0, 1), cA + hstep, voffA);
    if (wr == 1) PG8_BAR;
    PG8_WAIT_V(2); PG8_BAR;
    PG8_STAGE(PG8_SB(1, 0), cB + kstep, voffB); PG8_STAGE(PG8_SA(1, 0), cA + kstep, voffA); PG8_STAGE(PG8_SB(1, 1), cB + hstep + kstep, voffB);
    PG8_WAIT_V(6); PG8_BAR;
    for (;;) {
        const bool has_next = S.next(ui + 1, nxt);
        const char* nA = has_next ? S.aptr(nxt) : cA; const char* nB = has_next ? S.bptr(nxt) : cB;
        for (int t = 0; t < nt; t += 2) {
            const bool last = (t == nt - 2);
            const char* a1 = cA + (size_t)(t + 1) * kstep;
            const char* a2 = last ? nA : cA + (size_t)(t + 2) * kstep; const char* b2 = last ? nB : cB + (size_t)(t + 2) * kstep;
            const char* a3 = a2 + kstep; const char* b3 = b2 + kstep;
            PG8_LDB(B0, 0, 0); PG8_LDB(B1, 0, 1); PG8_SCHED; PG8_LDA(At, 0, 0); PG8_STAGE(PG8_SA(1, 1), a1 + hstep, voffA);
            PG8_WAIT_V(8); PG8_WAIT_L(0); PG8_BAR; PG8_MMA(0, 0, At, B0); PG8_MMA(0, 1, At, B1); PG8_BAR; PG8_SCHED;
            PG8_LDA(At, 0, 1); PG8_STAGE(PG8_SB(0, 0), b2, voffB); PG8_STAGE(PG8_SB(0, 1), b2 + hstep, voffB); PG8_STAGE(PG8_SA(0, 0), a2, voffA);
            PG8_WAIT_V(8); PG8_WAIT_L(0); PG8_BAR; PG8_MMA(1, 0, At, B0); PG8_MMA(1, 1, At, B1); PG8_BAR; PG8_SCHED;
            PG8_LDB(B0, 1, 0); PG8_LDB(B1, 1, 1); PG8_SCHED; PG8_LDA(At, 1, 0); PG8_STAGE(PG8_SA(0, 1), a2 + hstep, voffA);
            PG8_WAIT_V(8); PG8_WAIT_L(0); PG8_BAR; PG8_MMA(0, 0, At, B0); PG8_MMA(0, 1, At, B1); PG8_BAR; PG8_SCHED;
            PG8_LDA(At, 1, 1); PG8_STAGE(PG8_SB(1, 0), b3, voffB); PG8_STAGE(PG8_SB(1, 1), b3 + hstep, voffB); PG8_STAGE(PG8_SA(1, 0), a3, voffA);
            PG8_WAIT_V(8); PG8_WAIT_L(0); PG8_BAR; PG8_MMA(1, 0, At, B0); PG8_MMA(1, 1, At, B1); PG8_BAR; PG8_SCHED;
        }
        if (wr == 0) PG8_BAR;
        E(acc, cur, wr, wc, fr, fq);
        if (!has_next) break;
#pragma unroll
        for (int a = 0; a < 2; ++a)
#pragma unroll
            for (int b = 0; b < 2; ++b)
#pragma unroll
                for (int m = 0; m < 4; ++m)
#pragma unroll
                    for (int n = 0; n < 2; ++n) acc[a][b][m][n] = (f32x4){0.f, 0.f, 0.f, 0.f};
        cur = nxt; cA = nA; cB = nB; ++ui;
        if (wr == 1) PG8_BAR;
    }
    PG8_WAIT_V(0);
    PG8_BAR;
#undef PG8_SA
#undef PG8_SB
#undef PG8_STAGE
#undef PG8_LDA
#undef PG8_LDB
#undef PG8_MMA
#undef PG8_WAIT_V
#undef PG8_WAIT_L
#undef PG8_BAR
#undef PG8_SCHED
}

struct EpiBf16 {
    static constexpr bool PERM = true;
    bf16* O; int ldc; const float* bias; int bias_stride;
    __device__ __forceinline__ void operator()(const f32x4 (&acc)[2][2][4][2], const Unit& u, int wr, int wc, int fr, int fq) const {
        const int row0 = u.pm * BM + wr * 64 + fr, col0 = u.pn * BM + wc * 32 + 8 * fq;
        f32x4 bv[2][2];
#pragma unroll
        for (int bj = 0; bj < 2; ++bj)
#pragma unroll
            for (int n = 0; n < 2; ++n) bv[bj][n] = bias ? *(const f32x4*)(bias + (size_t)u.e * bias_stride + col0 + bj * HALF + 4 * n) : (f32x4){0.f, 0.f, 0.f, 0.f};
#pragma unroll
        for (int ai = 0; ai < 2; ++ai)
#pragma unroll
            for (int m = 0; m < 4; ++m) { bf16* rowp = O + (size_t)(row0 + ai * HALF + m * 16) * ldc + col0;
#pragma unroll
                for (int bj = 0; bj < 2; ++bj) { const f32x4 v0 = acc[ai][bj][m][0] + bv[bj][0], v1 = acc[ai][bj][m][1] + bv[bj][1];
                    v4u w; w.x = cvt_pk_bf16(v0[0], v0[1]); w.y = cvt_pk_bf16(v0[2], v0[3]); w.z = cvt_pk_bf16(v1[0], v1[1]); w.w = cvt_pk_bf16(v1[2], v1[3]);
                    *(v4u*)(rowp + bj * HALF) = w; } }
    }
};
template <int MODE> struct EpiGlu {
    static constexpr bool PERM = true;
    bf16* O; int ldc; const float* bias; int bias_stride, hs;
    __device__ __forceinline__ void operator()(const f32x4 (&acc)[2][2][4][2], const Unit& u, int wr, int wc, int fr, int fq) const {
        const int row0 = u.pm * BM + wr * 64 + fr, col0 = u.pn * HALF + wc * 32 + 8 * fq;
        const float* bp = bias + (size_t)u.e * bias_stride + col0;
        f32x4 ba[2], bb[2];
#pragma unroll
        for (int n = 0; n < 2; ++n) { ba[n] = *(const f32x4*)(bp + 4 * n); bb[n] = *(const f32x4*)(bp + hs + 4 * n); }
#pragma unroll
        for (int ai = 0; ai < 2; ++ai)
#pragma unroll
            for (int m = 0; m < 4; ++m) { bf16* rowp = O + (size_t)(row0 + ai * HALF + m * 16) * ldc + col0;
                float o[8];
#pragma unroll
                for (int n = 0; n < 2; ++n) { const f32x4 a = acc[ai][0][m][n] + ba[n], b = acc[ai][1][m][n] + bb[n];
#pragma unroll
                    for (int j = 0; j < 4; ++j) {
                        if (MODE == 0) o[4 * n + j] = a[j] * sigm(b[j]);
                        else { const float g = fminf(a[j], 7.f), up = fminf(fmaxf(b[j], -7.f), 7.f); o[4 * n + j] = (up + 1.f) * g * sigm(1.702f * g); } } }
                v4u w; w.x = cvt_pk_bf16(o[0], o[1]); w.y = cvt_pk_bf16(o[2], o[3]); w.z = cvt_pk_bf16(o[4], o[5]); w.w = cvt_pk_bf16(o[6], o[7]);
                *(v4u*)rowp = w; }
    }
};
struct EpiMerge {
    static constexpr bool PERM = true;
    float* mtmp; bf16* Mo; const bf16* zg;
    __device__ __forceinline__ void operator()(const f32x4 (&acc)[2][2][4][2], const Unit& u, int wr, int wc, int fr, int fq) const {
        const int row0 = u.pm * BM + wr * 64 + fr, col0 = u.pn * BM + wc * 32 + 8 * fq;
#pragma unroll
        for (int ai = 0; ai < 2; ++ai)
#pragma unroll
            for (int m = 0; m < 4; ++m) { const size_t r = (size_t)(row0 + ai * HALF + m * 16);
#pragma unroll
                for (int bj = 0; bj < 2; ++bj) { const int c = col0 + bj * HALF;
                    const v4u gz = *(const v4u*)(zg + r * IN_COLS + u.e * 1024 + c);
                    float g[8] = {bflo(gz.x), bfhi(gz.x), bflo(gz.y), bfhi(gz.y), bflo(gz.z), bfhi(gz.z), bflo(gz.w), bfhi(gz.w)};
                    f32x4 t0, t1; float* tp = mtmp + r * 1024 + c;
                    if (u.e == 0) { t0 = (f32x4){0.f, 0.f, 0.f, 0.f}; t1 = t0; } else { t0 = *(const f32x4*)tp; t1 = *(const f32x4*)(tp + 4); }
#pragma unroll
                    for (int j = 0; j < 4; ++j) { t0[j] += sigm(g[j]) * acc[ai][bj][m][0][j]; t1[j] += sigm(g[4 + j]) * acc[ai][bj][m][1][j]; }
                    if (u.e < 2) { *(f32x4*)tp = t0; *(f32x4*)(tp + 4) = t1; }
                    else { v4u w; w.x = cvt_pk_bf16(t0[0], t0[1]); w.y = cvt_pk_bf16(t0[2], t0[3]); w.z = cvt_pk_bf16(t1[0], t1[1]); w.w = cvt_pk_bf16(t1[2], t1[3]);
                        *(v4u*)(Mo + r * 1024 + c) = w; } } }
    }
};
struct EpiResid {
    static constexpr bool PERM = false;
    float* X; const float* gmod;
    __device__ __forceinline__ void operator()(const f32x4 (&acc)[2][2][4][2], const Unit& u, int wr, int wc, int fr, int fq) const {
        const int row0 = u.pm * BM + wr * 64 + fr, col0 = u.pn * BM + wc * 32 + 4 * fq;
        const int r00 = u.pm * BM; const int w = r00 < T_LAT ? (r00 >> 12) : 8;
        f32x4 gv[2][2];
#pragma unroll
        for (int bj = 0; bj < 2; ++bj)
#pragma unroll
            for (int n = 0; n < 2; ++n) gv[bj][n] = *(const f32x4*)(gmod + (size_t)w * 6144 + col0 + bj * HALF + n * 16);
#pragma unroll
        for (int ai = 0; ai < 2; ++ai)
#pragma unroll
            for (int m = 0; m < 4; ++m) { float* rowp = X + (size_t)(row0 + ai * HALF + m * 16) * 1024 + col0;
#pragma unroll
                for (int bj = 0; bj < 2; ++bj)
#pragma unroll
                    for (int n = 0; n < 2; ++n) { f32x4* p = (f32x4*)(rowp + bj * HALF + n * 16); *p = *p + gv[bj][n] * acc[ai][bj][m][n]; } }
    }
};
}

struct Args { const float* in[51]; float* out; unsigned char* ws; int ph_lo, ph_hi; };
enum { I_X = 0, I_C, I_CTX, I_CCTX, I_ADAW, I_ADAB, I_N1G, I_N2G, I_WIN, I_HYCW, I_HYCB, I_HYW1, I_HYB1, I_HYF1, I_HYW2, I_HYB2, I_HYF2, I_HYW3, I_HYB3, I_HYBIAS,
       I_RWCW, I_RWCB, I_RWWUP, I_RWW0, I_RWAUP, I_RWA0, I_RWGUP, I_RWKK, I_RWKA, I_RWRK, I_RWLNG, I_RWLNB, I_S5ARE, I_S5AIM, I_S5LDT, I_S5BRE, I_S5BIM, I_S5CRE, I_S5CIM, I_S5D,
       I_S5GLUW, I_S5GLUB, I_WBR, I_WOUT, I_RTW, I_RTB, I_W1, I_B1, I_W2, I_B2, I_FING };

typedef const __attribute__((address_space(4))) Args* CArgsP;
__device__ __forceinline__ CArgsP kargs() { CArgsP p = (CArgsP)__builtin_amdgcn_kernarg_segment_ptr(); asm volatile("" : "+s"(p)); return p; }
__device__ __forceinline__ int opaque(int v) { asm volatile("" : "+s"(v)); return v; }
__device__ __forceinline__ int opaque_v(int v) { asm volatile("" : "+v"(v)); return v; }
struct Ctx { CArgsP a; LAS unsigned char* lds; int tid, lane, wave, bid, G; };

__device__ __forceinline__ void row_seq(int row, int& base, int& pos, int& n) {
    if (row < T_LAT) { base = row & ~(SEQ - 1); pos = row & (SEQ - 1); n = SEQ; }
    else { const int r = row - T_LAT; base = T_LAT + (r & ~(CTXL - 1)); pos = r & (CTXL - 1); n = CTXL; }
}
__device__ __forceinline__ float conv3z(const bf16* zc, int pos, int n, float w0, float w1, float w2, float b) {
    const float zm = pos > 0 ? bf2f(zc[(size_t)(pos - 1) * IN_COLS]) : 0.f, z0 = bf2f(zc[(size_t)pos * IN_COLS]), zp = pos < n - 1 ? bf2f(zc[(size_t)(pos + 1) * IN_COLS]) : 0.f;
    return zm * w0 + z0 * w1 + zp * w2 + b;
}

template <int MODE>
__device__ __forceinline__ void transpose_item(const float* W, int K, int N, bf16* WT, int Hs, LAS float* scr, int item, int lane) {
    const int nblk = N / 32, kb = item / nblk, nb = item % nblk, k0 = 64 * kb, n0 = 32 * nb;
#pragma unroll 8
    for (int i = 0; i < 32; ++i) { const int kk = 2 * i + (lane >> 5); scr[kk * 33 + (lane & 31)] = W[(size_t)(k0 + kk) * N + n0 + (lane & 31)]; }
    LDS_WAIT(); asm volatile("" ::: "memory");
    const int c = lane & 7;
#pragma unroll
    for (int j = 0; j < 4; ++j) { const int n = (lane >> 3) + 8 * j; const LAS float* s = scr + (8 * c) * 33 + n;
        v4u o; o.x = pk2(s[0 * 33], s[1 * 33]); o.y = pk2(s[2 * 33], s[3 * 33]); o.z = pk2(s[4 * 33], s[5 * 33]); o.w = pk2(s[6 * 33], s[7 * 33]);
        int dr = n0 + n;
        if (MODE == 1) { const int nc = n0 + n; const int jx = nc < Hs ? nc : nc - Hs; dr = (jx >> 7) * 256 + (nc < Hs ? 0 : 128) + (jx & 127); }
        *(v4u*)(WT + (size_t)dr * K + k0 + 8 * c) = o; }
    LDS_WAIT(); asm volatile("" ::: "memory");
}

__device__ __forceinline__ void p0_prologue(const Ctx& F) {
    const auto& a = *F.a; unsigned char* ws = a.ws;
    const int gw = F.bid * NWAVES + F.wave, NGW = F.G * NWAVES, lane = F.lane;
    float* X = (float*)(ws + WS_X);
    for (int row = gw; row < T_ALL; row += NGW) {
        f32x4* xo = (f32x4*)(X + (size_t)row * D) + lane;
        if (row < T_LAT) {
            const f32x4* xi = (const f32x4*)(a.in[I_X] + (size_t)row * D) + lane;
            const int t = row & (SEQ - 1); const float pr = (float)(t >> 6), pc = (float)(t & 63);
#pragma unroll
            for (int j = 0; j < 4; ++j) { f32x4 v = xi[64 * j];
#pragma unroll
                for (int e = 0; e < 4; ++e) { const float om = 1.0f / powf(10000.0f, (float)(4 * lane + e) / 256.0f); const float ang = ((j < 2) ? pr : pc) * om; v[e] += (j & 1) ? cosf(ang) : sinf(ang); }
                xo[64 * j] = v; }
        } else {
            const f32x4* xi = (const f32x4*)(a.in[I_CTX] + (size_t)(row - T_LAT) * D) + lane;
#pragma unroll
            for (int j = 0; j < 4; ++j) xo[64 * j] = xi[64 * j];
        }
    }
    {
        LAS float* condl = (LAS float*)F.lds; LAS float* psum = (LAS float*)(F.lds + 40960);
        for (int i = F.tid; i < 9 * 1024; i += NTHREADS) { const int w = i >> 10, k = i & 1023; const float cv = (w < 8) ? a.in[I_C][w * 1024 + k] : a.in[I_CCTX][k]; condl[i] = cv / (1.f + expf(-cv)); }
        __syncthreads();
        float* MOD = (float*)(ws + WS_MOD);
        for (int it = F.bid; it < 2 * 96; it += F.G) {
            const int l = it / 96, cg = it % 96, col = cg * 64 + lane;
            float acc[9];
#pragma unroll
            for (int w = 0; w < 9; ++w) acc[w] = 0.f;
            const float* wp = a.in[I_ADAW] + ((size_t)l * 1024 + F.wave * 128) * 6144 + col;
            for (int k = 0; k < 128; ++k) { const float wv = wp[(size_t)k * 6144];
#pragma unroll
                for (int w = 0; w < 9; ++w) acc[w] += condl[w * 1024 + F.wave * 128 + k] * wv; }
#pragma unroll
            for (int w = 0; w < 9; ++w) psum[(F.wave * 9 + w) * 64 + lane] = acc[w];
            __syncthreads();
            if (F.wave == 0) {
#pragma unroll
                for (int w = 0; w < 9; ++w) { float s = 0.f;
#pragma unroll
                    for (int wv = 0; wv < 8; ++wv) s += psum[(wv * 9 + w) * 64 + lane];
                    MOD[(size_t)(l * 9 + w) * 6144 + col] = s + a.in[I_ADAB][l * 6144 + col]; }
            }
            __syncthreads();
        }
    }
    {
        LAS float* scr = (LAS float*)(F.lds + F.wave * 16384);
        constexpr int IT_W1 = 16 * 64, IT_W2 = 16 * 32, IT_WIN = 16 * 216, IT_GLU = 8 * 32, IT_WBR = 8 * 32, IT_WOUT = 16 * 32;
        constexpr int N_W1 = 64 * IT_W1, N_W2 = 64 * IT_W2, N_WIN = 2 * IT_WIN, N_GLU = 2 * IT_GLU, N_WBR = 6 * IT_WBR, N_WOUT = 2 * IT_WOUT;
        constexpr int NITEMS = N_W1 + N_W2 + N_WIN + N_GLU + N_WBR + N_WOUT;
        for (int it = gw; it < NITEMS; it += NGW) {
            int r = it;
            if (r < N_W1) { const int mtx = r / IT_W1, l = mtx >> 5, e = mtx & 31; transpose_item<1>(a.in[I_W1] + (size_t)mtx * 1024 * 2048, 1024, 2048, (bf16*)(ws + WS_WTS + l * WL_STRIDE + WO_W1) + (size_t)e * 2048 * 1024, 1024, scr, r % IT_W1, lane); continue; } r -= N_W1;
            if (r < N_W2) { const int mtx = r / IT_W2, l = mtx >> 5, e = mtx & 31; transpose_item<0>(a.in[I_W2] + (size_t)mtx * 1024 * 1024, 1024, 1024, (bf16*)(ws + WS_WTS + l * WL_STRIDE + WO_W2) + (size_t)e * 1024 * 1024, 0, scr, r % IT_W2, lane); continue; } r -= N_W2;
            if (r < N_WIN) { const int l = r / IT_WIN; transpose_item<0>(a.in[I_WIN] + (size_t)l * 1024 * IN_COLS, 1024, IN_COLS, (bf16*)(ws + WS_WTS + l * WL_STRIDE + WO_WIN), 0, scr, r % IT_WIN, lane); continue; } r -= N_WIN;
            if (r < N_GLU) { const int l = r / IT_GLU; transpose_item<1>(a.in[I_S5GLUW] + (size_t)l * 512 * 1024, 512, 1024, (bf16*)(ws + WS_WTS + l * WL_STRIDE + WO_GLU), 512, scr, r % IT_GLU, lane); continue; } r -= N_GLU;
            if (r < N_WBR) { const int mtx = r / IT_WBR, l = mtx / 3, br = mtx % 3; transpose_item<0>(a.in[I_WBR] + (size_t)mtx * 512 * 1024, 512, 1024, (bf16*)(ws + WS_WTS + l * WL_STRIDE + WO_WBR) + (size_t)br * 1024 * 512, 0, scr, r % IT_WBR, lane); continue; } r -= N_WBR;
            { const int l = r / IT_WOUT; transpose_item<0>(a.in[I_WOUT] + (size_t)l * 1024 * 1024, 1024, 1024, (bf16*)(ws + WS_WTS + l * WL_STRIDE + WO_WOUT), 0, scr, r % IT_WOUT, lane); }
        }
        for (int i = F.bid * NTHREADS + F.tid; i < 2 * 2560 * 256; i += F.G * NTHREADS) {
            const int l = i / (2560 * 256), r = i % (2560 * 256), n = r >> 8, k = r & 255; float v = 0.f;
            if (n < 1024) { if (k < 64) v = a.in[I_RWWUP][(((size_t)l * 2 + (n >> 9)) * 64 + k) * 512 + (n & 511)]; }
            else if (n < 2048) { if (k >= 64 && k < 128) v = a.in[I_RWAUP][(((size_t)l * 2 + ((n - 1024) >> 9)) * 64 + (k - 64)) * 512 + (n & 511)]; }
            else { if (k >= 128) v = a.in[I_RWGUP][((size_t)l * 128 + (k - 128)) * 512 + (n - 2048)]; }
            ((bf16*)(ws + WS_WTS + l * WL_STRIDE + WO_RWCAT))[r] = (bf16)f2bf(v);
        }
    }
    __syncthreads();
    {
        LAS float* feats = (LAS float*)F.lds; LAS float* h1 = feats + 8 * 33; LAS float* h2 = h1 + 8 * 64;
        constexpr int NIT = 2 * (512 + 32);
        for (int it = F.bid; it < NIT; it += F.G) {
            const int l = it / 544, r = it % 544, nsel = r >= 512, n = nsel ? CTXL : SEQ, p0 = (nsel ? r - 512 : r) * 8;
            if (F.tid < 8 * 33) { const int p = F.tid / 33, i = F.tid % 33, pos = p0 + p; float f;
                if (i == 0) f = (float)pos / (float)(n - 1);
                else { const int k = (i - 1) & 15; const float band = 1e-4f + (float)k * ((15.0f - 1e-4f) / 15.0f); const float ang = (6.283185307179586f * (float)pos / (float)n) * band; f = (i <= 16) ? cosf(ang) : -sinf(ang); }
                feats[p * 33 + i] = f; }
            __syncthreads();
            { const int p = F.tid >> 6, j = F.tid & 63; float s = a.in[I_HYB1][l * 64 + j];
                for (int i = 0; i < 33; ++i) s += feats[p * 33 + i] * a.in[I_HYW1][((size_t)l * 33 + i) * 64 + j];
                h1[p * 64 + j] = sinf(a.in[I_HYF1][l * 64 + j] * s); }
            __syncthreads();
            { const int p = F.tid >> 6, j = F.tid & 63; float s = a.in[I_HYB2][l * 64 + j];
                for (int i = 0; i < 64; ++i) s += h1[p * 64 + i] * a.in[I_HYW2][((size_t)l * 64 + i) * 64 + j];
                h2[p * 64 + j] = sinf(a.in[I_HYF2][l * 64 + j] * s); }
            __syncthreads();
            float acc[4][8];
#pragma unroll
            for (int q = 0; q < 4; ++q)
#pragma unroll
                for (int p = 0; p < 8; ++p) acc[q][p] = 0.f;
            const float* w3 = a.in[I_HYW3] + (size_t)l * 64 * 2048 + F.tid;
            for (int i = 0; i < 64; ++i) { float wv[4];
#pragma unroll
                for (int q = 0; q < 4; ++q) wv[q] = w3[(size_t)i * 2048 + q * 512];
#pragma unroll
                for (int p = 0; p < 8; ++p) { const float hv = h2[p * 64 + i];
#pragma unroll
                    for (int q = 0; q < 4; ++q) acc[q][p] += hv * wv[q]; } }
            const int c = F.tid; const float dstart = logf(0.01f) / 1.5f, dstop = logf(0.01f) / 0.3f; const float delta = fabsf(dstart + (float)c * ((dstop - dstart) / 511.0f));
            const int RL = nsel ? HY_RLENC : HY_RLEN, off = n + 47;
            bf16* Rb = (bf16*)(ws + WS_GF + l * GF_STRIDE + (nsel ? GF_CTX : 0));
#pragma unroll
            for (int q = 0; q < 4; ++q) { const int o = q >> 1, side = q & 1; const float b3 = a.in[I_HYB3][l * 2048 + q * 512 + c];
                bf16* Rc = Rb + ((size_t)o * 512 + c) * RL;
#pragma unroll
                for (int p = 0; p < 8; ++p) { const int pos = p0 + p; const float t = (float)pos / (float)(n - 1); const float val = (acc[q][p] + b3) * expf(-t * delta);
                    if (side == 0) Rc[off - pos] = (bf16)f2bf(val);
                    else if (pos >= 1) Rc[off + pos] = (bf16)f2bf(val); }
                if (p0 == 0 && side == 0) { for (int m = 0; m < 48; ++m) Rc[m] = 0; for (int m = off + n; m < RL; ++m) Rc[m] = 0; } }
            __syncthreads();
        }
    }
}

__device__ __forceinline__ void stage_norm1(const Ctx& F, int l) {
    const auto& a = *F.a; unsigned char* ws = a.ws; const int lane = F.lane;
    const int gw = F.bid * NWAVES + F.wave, NGW = F.G * NWAVES;
    float* X = (float*)(ws + WS_X); bf16* H = (bf16*)(ws + WS_H); const float* MOD = (const float*)(ws + WS_MOD);
    const bf16* YS = (const bf16*)(ws + WS_XS); const int* POS = (const int*)(ws + WS_POS); const float* GATE = (const float*)(ws + WS_GATE);
    const int nrows = (l == DEPTH) ? T_LAT : T_ALL;
    for (int row = gw; row < nrows; row += NGW) {
        const int w = row < T_LAT ? (row >> 12) : 8;
        f32x4* xr = (f32x4*)(X + (size_t)row * D) + lane;
        f32x4 v[4];
#pragma unroll
        for (int j = 0; j < 4; ++j) v[j] = xr[64 * j];
        if (l > 0) {
            f32x4 mo[4];
#pragma unroll
            for (int j = 0; j < 4; ++j) mo[j] = (f32x4){0.f, 0.f, 0.f, 0.f};
#pragma unroll
            for (int k = 0; k < TOPK; ++k) { const int p = POS[row * 4 + k]; const float g = GATE[row * 4 + k];
                const v2u* yr = (const v2u*)(YS + (size_t)p * D) + lane;
#pragma unroll
                for (int j = 0; j < 4; ++j) { const v2u y = yr[64 * j]; mo[j][0] += g * bflo(y.x); mo[j][1] += g * bfhi(y.x); mo[j][2] += g * bflo(y.y); mo[j][3] += g * bfhi(y.y); } }
            const f32x4* g2 = (const f32x4*)(MOD + (size_t)((l - 1) * 9 + w) * 6144 + 5120) + lane;
#pragma unroll
            for (int j = 0; j < 4; ++j) { v[j] = v[j] + g2[64 * j] * mo[j]; xr[64 * j] = v[j]; }
        }
        float ss = 0.f;
#pragma unroll
        for (int j = 0; j < 4; ++j) ss += (v[j][0] * v[j][0] + v[j][1] * v[j][1]) + (v[j][2] * v[j][2] + v[j][3] * v[j][3]);
        const float rstd = 1.0f / sqrtf(wave_sum(ss) * (1.f / D) + 1e-6f);
        if (l == DEPTH) {
            const f32x4* fg = (const f32x4*)a.in[I_FING] + lane; f32x4* o = (f32x4*)(a.out + (size_t)row * D) + lane;
#pragma unroll
            for (int j = 0; j < 4; ++j) o[64 * j] = v[j] * rstd * fg[64 * j];
        } else {
            const f32x4* ng = (const f32x4*)(a.in[I_N1G] + l * D) + lane;
            const f32x4* sh = (const f32x4*)(MOD + (size_t)(l * 9 + w) * 6144) + lane; const f32x4* sc = (const f32x4*)(MOD + (size_t)(l * 9 + w) * 6144 + 1024) + lane;
            v2u* ho = (v2u*)(H + (size_t)row * D) + lane;
#pragma unroll
            for (int j = 0; j < 4; ++j) { const f32x4 h = v[j] * rstd * ng[64 * j] * (sc[64 * j] + 1.0f) + sh[64 * j]; v2u o; o.x = pk2(h[0], h[1]); o.y = pk2(h[2], h[3]); ho[64 * j] = o; }
        }
    }
}

__device__ __forceinline__ void stage_rw_prep1(const Ctx& F, int l) {
    const auto& a = *F.a; unsigned char* ws = a.ws;
    const bf16* Z = (const bf16*)(ws + WS_Z); bf16* ARW = (bf16*)(ws + WS_ARW);
    const int j = F.tid & 255, col = 1536 + j;
    const float* cw = a.in[I_RWCW] + (size_t)l * 3 * 1792; const float w0 = cw[col], w1 = cw[1792 + col], w2 = cw[2 * 1792 + col], cb = a.in[I_RWCB][l * 1792 + col];
    for (int row = F.bid * 2 + (F.tid >> 8); row < T_ALL; row += F.G * 2) {
        int base, pos, n; row_seq(row, base, pos, n);
        float v = conv3z(Z + (size_t)base * IN_COLS + RW_OFF + col, pos, n, w0, w1, w2, cb);
        if (j < 64) v = tanhf(v); else if (j >= 128) v = sigm(v);
        ARW[(size_t)row * 256 + j] = (bf16)f2bf(v);
    }
}

__device__ __forceinline__ void stage_rw_prep2(const Ctx& F, int l) {
    const auto& a = *F.a; unsigned char* ws = a.ws; const int lane = F.lane;
    const bf16* Z = (const bf16*)(ws + WS_Z); const bf16* P = (const bf16*)(ws + WS_P); bf16* SCN = (bf16*)(ws + WS_SCN);
    const int gw = F.bid * NWAVES + F.wave, NGW = F.G * NWAVES;
    constexpr int TR = 17, NRT = T_ALL / TR;
    const float* cw = a.in[I_RWCW] + (size_t)l * 3 * 1792; const float* cbp = a.in[I_RWCB] + l * 1792;
    for (int tile = gw; tile < NRT * 4; tile += NGW) {
        const int rt = tile % NRT, hp = tile / NRT, row0 = rt * TR, c0 = hp * 128 + 2 * lane;
        f32x2 w[3][3], cb[3];
#pragma unroll
        for (int s = 0; s < 3; ++s) { cb[s] = *(const f32x2*)(cbp + s * 512 + c0);
#pragma unroll
            for (int j = 0; j < 3; ++j) w[s][j] = *(const f32x2*)(cw + j * 1792 + s * 512 + c0); }
        const f32x2 KKw = *(const f32x2*)(a.in[I_RWKK] + l * 512 + c0), KAw = *(const f32x2*)(a.in[I_RWKA] + l * 512 + c0);
        f32x2 W0[2], A0[2];
#pragma unroll
        for (int d = 0; d < 2; ++d) { W0[d] = *(const f32x2*)(a.in[I_RWW0] + (l * 2 + d) * 512 + c0); A0[d] = *(const f32x2*)(a.in[I_RWA0] + (l * 2 + d) * 512 + c0); }
        const unsigned* zb = (const unsigned*)(Z + RW_OFF + c0);
        unsigned zm[3], z0[3], zp[3];
#pragma unroll
        for (int s = 0; s < 3; ++s) { zm[s] = row0 > 0 ? zb[(size_t)(row0 - 1) * (IN_COLS / 2) + s * 256] : 0u; z0[s] = zb[(size_t)row0 * (IN_COLS / 2) + s * 256]; }
#pragma unroll 1
        for (int i = 0; i < TR; ++i) {
            const int row = row0 + i; int base, pos, n; row_seq(row, base, pos, n);
#pragma unroll
            for (int s = 0; s < 3; ++s) zp[s] = (row + 1 < T_ALL) ? zb[(size_t)(row + 1) * (IN_COLS / 2) + s * 256] : 0u;
            const float mlo = pos > 0 ? 1.f : 0.f, mhi = pos < n - 1 ? 1.f : 0.f;
            f32x2 u[3];
#pragma unroll
            for (int s = 0; s < 3; ++s) { u[s] = (f32x2){bflo(zm[s]), bfhi(zm[s])} * mlo * w[s][0] + (f32x2){bflo(z0[s]), bfhi(z0[s])} * w[s][1] + (f32x2){bflo(zp[s]), bfhi(zp[s])} * mhi * w[s][2] + cb[s]; zm[s] = z0[s]; z0[s] = zp[s]; }
            const f32x2 r = u[0], k = u[1], v = u[2];
            f32x2 kk = k * KKw;
            const float ss = red32(kk[0] * kk[0] + kk[1] * kk[1]);
            kk = kk * (1.0f / sqrtf(fmaxf(ss, 1e-24f)));
            const unsigned* pr = (const unsigned*)(P + (size_t)row * 2560 + c0);
            unsigned* o = (unsigned*)(SCN + (size_t)row * 9 * 512 + c0);
            o[0] = pk2(r[0], r[1]); o[256] = pk2(v[0], v[1]); o[2 * 256] = pk2(kk[0], kk[1]);
#pragma unroll
            for (int d = 0; d < 2; ++d) {
                const unsigned pw = pr[d * 256], pa = pr[512 + d * 256];
                float ld[2], kd[2], be[2];
#pragma unroll
                for (int e = 0; e < 2; ++e) {
                    const float uu = W0[d][e] + (e ? bfhi(pw) : bflo(pw));
                    ld[e] = -0.60653065971263342f * sigm(uu);
                    const float av = sigm(A0[d][e] + (e ? bfhi(pa) : bflo(pa)));
                    kd[e] = k[e] * (1.f + (av - 1.f) * KAw[e]); be[e] = kk[e] * av; }
                o[(3 + 3 * d) * 256] = pk2(ld[0], ld[1]); o[(4 + 3 * d) * 256] = pk2(kd[0], kd[1]); o[(5 + 3 * d) * 256] = pk2(be[0], be[1]);
            }
        }
    }
}

__device__ __forceinline__ int seq_row(int b, int d, int sidx) {
    if (sidx < CTXL) { const int t = d ? (CTXL - 1 - sidx) : sidx; return T_LAT + b * CTXL + t; }
    const int tl = sidx - CTXL; const int t = d ? (SEQ - 1 - tl) : tl; return b * SEQ + t;
}

constexpr int CW_WORK = 16384;
constexpr int CW_STAMP = 20480;
#ifdef PROBE_T
#ifndef PROBE_BID
#define PROBE_BID 0
#endif
#define PT(k) do { if (F.bid == PROBE_BID && F.tid == 0 && l == 0) ((unsigned long long*)(F.a->ws + WS_CTL + CW_STAMP * 4))[k] = __builtin_amdgcn_s_memrealtime(); } while (0)
#else
#define PT(k) do { } while (0)
#endif
__device__ __forceinline__ void rw_scan_item(const Ctx& F, int l, int it2) {
    const int it = it2 >> 1, half = it2 & 1;
    const auto& a = *F.a; unsigned char* ws = a.ws; const int tid = F.tid, lane = F.lane;
    const bf16* SCN = (const bf16*)(ws + WS_SCN); float* YD = (float*)(ws + WS_YDIR);
    LAS float* sbuf = (LAS float*)F.lds;
    LAS float* ybuf = (LAS float*)(F.lds + 49152);
    const bool comp = F.wave < 4;
    const int lt = tid & 255, ls = lt >> 4, lj = lt & 15;
    const int vl = lane >> 3, kq = lane & 7, vrow = half * 32 + (F.wave & 3) * 8 + vl;
    constexpr int NCH = (CTXL + SEQ) / 16;
    const int d = it & 1, h = (it >> 1) & 7, b = it >> 4;
    f32x2 S[4];
#pragma unroll
    for (int q = 0; q < 4; ++q) S[q] = (f32x2){0.f, 0.f};
    v2u ldr[6];
#define RW_ISSUE(c) do { const int row_ = seq_row(b, d, (c) * 16 + ls); const v2u* p_ = (const v2u*)(SCN + (size_t)row_ * 9 * 512 + h * 64) + lj; \
        ldr[0] = p_[2 * 128]; ldr[1] = p_[(3 + 3 * d) * 128]; ldr[2] = p_[(5 + 3 * d) * 128]; ldr[3] = p_[(4 + 3 * d) * 128]; ldr[4] = p_[0]; ldr[5] = p_[128]; } while (0)
#define RW_WRITE(bufi) do { LAS float* o_ = sbuf + (((bufi) * 16 + ls) * 6) * 64 + 4 * lj; \
        *(LAS f32x4*)(o_) = (f32x4){-bflo(ldr[0].x), -bfhi(ldr[0].x), -bflo(ldr[0].y), -bfhi(ldr[0].y)}; \
        *(LAS f32x4*)(o_ + 64) = (f32x4){__expf(bflo(ldr[1].x)), __expf(bfhi(ldr[1].x)), __expf(bflo(ldr[1].y)), __expf(bfhi(ldr[1].y))}; \
        *(LAS f32x4*)(o_ + 128) = (f32x4){bflo(ldr[2].x), bfhi(ldr[2].x), bflo(ldr[2].y), bfhi(ldr[2].y)}; *(LAS f32x4*)(o_ + 192) = (f32x4){bflo(ldr[3].x), bfhi(ldr[3].x), bflo(ldr[3].y), bfhi(ldr[3].y)}; \
        *(LAS f32x4*)(o_ + 256) = (f32x4){bflo(ldr[4].x), bfhi(ldr[4].x), bflo(ldr[4].y), bfhi(ldr[4].y)}; *(LAS f32x4*)(o_ + 320) = (f32x4){bflo(ldr[5].x), bfhi(ldr[5].x), bflo(ldr[5].y), bfhi(ldr[5].y)}; } while (0)
#define RW_FLUSH(c) do { const int row_ = seq_row(b, d, (c) * 16 + ls); \
        *(f32x2*)(YD + ((size_t)d * T_ALL + row_) * 512 + h * 64 + half * 32 + 2 * lj) = *(const LAS f32x2*)(ybuf + ((((c) & 1) * 16 + ls) * 64) + half * 32 + 2 * lj); } while (0)
    if (!comp) { RW_ISSUE(0); RW_WRITE(0); RW_ISSUE(1); }
    __syncthreads();
#pragma unroll 1
    for (int c = 0; c < NCH; ++c) {
        const int bi = c & 1;
        if (!comp) {
            if (c + 1 < NCH) RW_WRITE(bi ^ 1);
            if (c + 2 < NCH) RW_ISSUE(c + 2);
            if (c > 0) RW_FLUSH(c - 1);
        } else {
        float yv[16];
        f32x4 opA[10], opB[10]; float vvA, vvB;
#define RW_LD(op, vvx, s_) do { const LAS float* sp_ = sbuf + ((bi * 16 + (s_)) * 6) * 64 + 8 * kq; \
            _Pragma("unroll") for (int q_ = 0; q_ < 5; ++q_) { op[2 * q_] = *(const LAS f32x4*)(sp_ + 64 * q_); op[2 * q_ + 1] = *(const LAS f32x4*)(sp_ + 64 * q_ + 4); } \
            vvx = sbuf[((bi * 16 + (s_)) * 6 + 5) * 64 + vrow]; } while (0)
#define RW_COMP(op, vvx, s_) do { \
            const f32x4 a0 = op[0], a1 = op[1], w0 = op[2], w1 = op[3], b0 = op[4], b1 = op[5], k0 = op[6], k1 = op[7], r0 = op[8], r1 = op[9]; \
            const f32x2 vv2 = (f32x2){vvx, vvx}; \
            const f32x2 p0 = S[1] * (f32x2){a0[2], a0[3]} + S[0] * (f32x2){a0[0], a0[1]}; \
            const f32x2 p1 = S[3] * (f32x2){a1[2], a1[3]} + S[2] * (f32x2){a1[0], a1[1]}; \
            const f32x2 t0 = S[0] * (f32x2){w0[0], w0[1]} + vv2 * (f32x2){k0[0], k0[1]}; \
            const f32x2 t1 = S[1] * (f32x2){w0[2], w0[3]} + vv2 * (f32x2){k0[2], k0[3]}; \
            const f32x2 t2 = S[2] * (f32x2){w1[0], w1[1]} + vv2 * (f32x2){k1[0], k1[1]}; \
            const f32x2 t3 = S[3] * (f32x2){w1[2], w1[3]} + vv2 * (f32x2){k1[2], k1[3]}; \
            const f32x2 ac = p0 + p1; \
            const float sa = red8(ac[0] + ac[1]); \
            const f32x2 sa2 = (f32x2){sa, sa}; \
            S[0] = sa2 * (f32x2){b0[0], b0[1]} + t0; S[1] = sa2 * (f32x2){b0[2], b0[3]} + t1; \
            S[2] = sa2 * (f32x2){b1[0], b1[1]} + t2; S[3] = sa2 * (f32x2){b1[2], b1[3]} + t3; \
            const f32x2 q0 = S[1] * (f32x2){r0[2], r0[3]} + S[0] * (f32x2){r0[0], r0[1]}; \
            const f32x2 q1 = S[3] * (f32x2){r1[2], r1[3]} + S[2] * (f32x2){r1[0], r1[1]}; \
            const f32x2 yc = q0 + q1; \
            yv[s_] = red8(yc[0] + yc[1]); } while (0)
        RW_LD(opA, vvA, 0);
#pragma unroll
        for (int s = 0; s < 16; s += 2) {
            RW_LD(opB, vvB, s + 1);
            __builtin_amdgcn_sched_barrier(0);
            RW_COMP(opA, vvA, s);
            __builtin_amdgcn_sched_barrier(0);
            if (s + 2 < 16) RW_LD(opA, vvA, s + 2);
            __builtin_amdgcn_sched_barrier(0);
            RW_COMP(opB, vvB, s + 1);
            __builtin_amdgcn_sched_barrier(0);
        }
#undef RW_LD
#undef RW_COMP
#pragma unroll
        for (int s = 0; s < 16; ++s) if ((s & 7) == kq) ybuf[((bi * 16 + s) * 64) + vrow] = yv[s];
        }
        __syncthreads();
    }
    if (!comp) RW_FLUSH(NCH - 1);
    __syncthreads();
#undef RW_ISSUE
#undef RW_WRITE
#undef RW_FLUSH
}

__device__ __forceinline__ void stage_rw_readout(const Ctx& F, int l) {
    const auto& a = *F.a; unsigned char* ws = a.ws; const int lane = F.lane;
    const bf16* SCN = (const bf16*)(ws + WS_SCN); const bf16* P = (const bf16*)(ws + WS_P); const float* YD = (const float*)(ws + WS_YDIR); bf16* YRW = (bf16*)(ws + WS_YRW);
    const int gw = F.bid * NWAVES + F.wave, NGW = F.G * NWAVES;
    constexpr int TR = 17, NRT = T_ALL / TR;
    for (int tile = gw; tile < NRT * 4; tile += NGW) {
        const int rt = tile % NRT, hp = tile / NRT, row0 = rt * TR, c0 = hp * 128 + 2 * lane;
        const f32x2 rk = *(const f32x2*)(a.in[I_RWRK] + l * 512 + c0), lng = *(const f32x2*)(a.in[I_RWLNG] + l * 512 + c0), lnb = *(const f32x2*)(a.in[I_RWLNB] + l * 512 + c0);
#pragma unroll 4
        for (int i = 0; i < TR; ++i) {
            const int row = row0 + i;
            const unsigned* sp = (const unsigned*)(SCN + (size_t)row * 9 * 512 + c0);
            const unsigned ru = sp[0], vu = sp[256], k0u = sp[4 * 256], k1u = sp[7 * 256];
            const f32x2 y0 = *(const f32x2*)(YD + (size_t)row * 512 + c0), y1 = *(const f32x2*)(YD + ((size_t)T_ALL + row) * 512 + c0);
            const unsigned gu = *(const unsigned*)(P + (size_t)row * 2560 + 2048 + c0);
            const float bon = red32(bflo(ru) * (bflo(k0u) + bflo(k1u)) * rk[0] + bfhi(ru) * (bfhi(k0u) + bfhi(k1u)) * rk[1]);
            f32x2 y = y0 + y1 + (f32x2){bflo(vu), bfhi(vu)} * bon;
            const float mu = red32(y[0] + y[1]) * (1.f / 64.f);
            y = y - mu;
            const float var = red32(y[0] * y[0] + y[1] * y[1]) * (1.f / 64.f);
            const f32x2 yn = y * (1.0f / sqrtf(var + 64e-5f));
            const f32x2 ov = (yn * lng + lnb) * (f32x2){bflo(gu), bfhi(gu)};
            *(unsigned*)(YRW + (size_t)row * 512 + c0) = pk2(ov[0], ov[1]);
        }
    }
}

constexpr size_t WS_S5E = 6 * MiB;
constexpr int S5_NSEG = 4, S5_SEGLEN = (CTXL + SEQ) / S5_NSEG;
__device__ __forceinline__ void s5_disc(const float are, const float aim, const float dt, float& lbr, float& lbi, float& cr, float& ci) {
    const float mag = expf(are * dt); lbr = mag * cosf(aim * dt); lbi = mag * sinf(aim * dt);
    const float den = are * are + aim * aim, nr = lbr - 1.0f; cr = (nr * are + lbi * aim) / den; ci = (lbi * are - nr * aim) / den;
}
template <int PASS>
__device__ __forceinline__ void stage_s5_scan(const Ctx& F, int l) {
    const auto& a = *F.a; unsigned char* ws = a.ws; const int lane = F.lane;
    const bf16* Z = (const bf16*)(ws + WS_Z); float* YP = (float*)(ws + WS_YP); f32x2* S5E = (f32x2*)(ws + WS_S5E);
    LAS unsigned char* wl = F.lds + F.wave * 16384;
    LAS float* buL = (LAS float*)wl;
    LAS bf16* Hs = (LAS bf16*)(wl + 8704);
    const int fr = lane & 15, kg = lane >> 4;
    for (int itx = F.bid * NWAVES + F.wave; itx < BATCH * 32 * 2 * S5_NSEG; itx += NWAVES * F.G) {
        const int seg = itx & (S5_NSEG - 1), it = itx >> 2;
        const int d = it & 1, g = (it >> 1) & 31, b = it >> 6, p = lane;
        const float dt = expf(a.in[I_S5LDT][(l * 2 + d) * 32 + g]);
        const float* arep = a.in[I_S5ARE] + ((size_t)(l * 2 + d) * 32 + g) * 64; const float* aimp = a.in[I_S5AIM] + ((size_t)(l * 2 + d) * 32 + g) * 64;
        float lbr, lbi, cr_, ci_; s5_disc(arep[p], aimp[p], dt, lbr, lbi, cr_, ci_);
        bf16x8 afr[2][4];
#pragma unroll
        for (int tl = 0; tl < 4; ++tl) { const int pp = 16 * tl + fr; float r0_, r1_, cr, ci; s5_disc(arep[pp], aimp[pp], dt, r0_, r1_, cr, ci);
            v4u pr = (v4u){0u, 0u, 0u, 0u}, pi = (v4u){0u, 0u, 0u, 0u};
            if (kg < 2) { const float* br = a.in[I_S5BRE] + (((size_t)l * 32 + g) * 64 + pp) * 16 + 8 * kg; const float* bi = a.in[I_S5BIM] + (((size_t)l * 32 + g) * 64 + pp) * 16 + 8 * kg;
                const f32x4 x0 = *(const f32x4*)br, x1 = *(const f32x4*)(br + 4), y0 = *(const f32x4*)bi, y1 = *(const f32x4*)(bi + 4);
                pr.x = pk2(cr * x0[0] - ci * y0[0], cr * x0[1] - ci * y0[1]); pr.y = pk2(cr * x0[2] - ci * y0[2], cr * x0[3] - ci * y0[3]);
                pr.z = pk2(cr * x1[0] - ci * y1[0], cr * x1[1] - ci * y1[1]); pr.w = pk2(cr * x1[2] - ci * y1[2], cr * x1[3] - ci * y1[3]);
                pi.x = pk2(cr * y0[0] + ci * x0[0], cr * y0[1] + ci * x0[1]); pi.y = pk2(cr * y0[2] + ci * x0[2], cr * y0[3] + ci * x0[3]);
                pi.z = pk2(cr * y1[0] + ci * x1[0], cr * y1[1] + ci * x1[1]); pi.w = pk2(cr * y1[2] + ci * x1[2], cr * y1[3] + ci * x1[3]); }
            afr[0][tl] = __builtin_bit_cast(bf16x8, pr); afr[1][tl] = __builtin_bit_cast(bf16x8, pi); }
        bf16x8 cf[4];
        f32x2 hst = (f32x2){0.f, 0.f};
        if (PASS == 1) {
#pragma unroll
            for (int kk = 0; kk < 4; ++kk) { const int p0 = 16 * kk + 4 * kg;
                const f32x4 c0 = *(const f32x4*)(a.in[I_S5CRE] + (((size_t)l * 32 + g) * 16 + fr) * 64 + p0), c1 = *(const f32x4*)(a.in[I_S5CIM] + (((size_t)l * 32 + g) * 16 + fr) * 64 + p0);
                v4u pk; pk.x = pk2(c0[0], -c1[0]); pk.y = pk2(c0[1], -c1[1]); pk.z = pk2(c0[2], -c1[2]); pk.w = pk2(c0[3], -c1[3]);
                cf[kk] = __builtin_bit_cast(bf16x8, pk); }
            float pr_ = lbr, pi_ = lbi, l64r = 1.f, l64i = 0.f;
#pragma unroll 1
            for (int q = 0; q < 10; ++q) { const float nr2 = pr_ * pr_ - pi_ * pi_, ni2 = 2.f * pr_ * pi_; pr_ = nr2; pi_ = ni2; if (q == 5) { l64r = pr_; l64i = pi_; } }
            const float lLr = pr_ * l64r - pi_ * l64i, lLi = pr_ * l64i + pi_ * l64r;
#pragma unroll 1
            for (int sgi = 0; sgi < seg; ++sgi) { const f32x2 ev = S5E[((size_t)it * S5_NSEG + sgi) * 64 + p];
                hst = (f32x2){lLr * hst[0] - lLi * hst[1] + ev[0], lLr * hst[1] + lLi * hst[0] + ev[1]}; }
        }
        const f32x2 lbr2 = (f32x2){lbr, lbr}, lbi2 = (f32x2){lbi, lbi};
        const int sbeg = seg * S5_SEGLEN, send = sbeg + S5_SEGLEN;
        v4u un = (v4u){0u, 0u, 0u, 0u}, uc;
#define S5_LOADU(s0_) do { if (kg < 2) { const int row_ = seq_row(b, d, (s0_) + fr); un = *(const v4u*)(Z + (size_t)row_ * IN_COLS + S5_OFF + g * 16 + kg * 8); } } while (0)
        S5_LOADU(sbeg);
#pragma unroll 1
        for (int s0 = sbeg; s0 < send; s0 += 16) {
            uc = un;
            if (s0 + 16 < send) S5_LOADU(s0 + 16);
            const bf16x8 ufr = __builtin_bit_cast(bf16x8, uc);
#pragma unroll
            for (int c = 0; c < 2; ++c)
#pragma unroll
                for (int tl = 0; tl < 4; ++tl) { const f32x4 dd = __builtin_amdgcn_mfma_f32_16x16x32_bf16(afr[c][tl], ufr, (f32x4){0.f, 0.f, 0.f, 0.f}, 0, 0, 0);
                    *(LAS f32x4*)(buL + (c * 16 + fr) * 68 + 16 * tl + 4 * kg) = dd; }
            LDS_WAIT(); asm volatile("" ::: "memory");
            f32x2 bu[16];
#pragma unroll
            for (int s = 0; s < 16; ++s) bu[s] = (f32x2){buL[s * 68 + p], buL[(16 + s) * 68 + p]};
#pragma unroll
            for (int s = 0; s < 16; ++s) {
                const f32x2 sw = (f32x2){-hst[1], hst[0]};
                hst = lbr2 * hst + (lbi2 * sw + bu[s]);
                if (PASS == 1) *(LAS unsigned*)(Hs + s * 136 + 2 * p) = pg8::cvt_pk_bf16(hst[0], hst[1]);
            }
            if (PASS == 1) {
                LDS_WAIT(); asm volatile("" ::: "memory");
                f32x4 acc = (f32x4){0.f, 0.f, 0.f, 0.f};
#pragma unroll
                for (int kk = 0; kk < 4; ++kk) { const bf16x8 af = *(const LAS bf16x8*)(Hs + fr * 136 + 32 * kk + 8 * kg); acc = __builtin_amdgcn_mfma_f32_16x16x32_bf16(af, cf[kk], acc, 0, 0, 0); }
#pragma unroll
                for (int r = 0; r < 4; ++r) { const int row = seq_row(b, d, s0 + 4 * kg + r); YP[((size_t)d * T_ALL + row) * 512 + g * 16 + fr] = acc[r]; }
            }
            LDS_WAIT(); asm volatile("" ::: "memory");
        }
        if (PASS == 0) S5E[((size_t)it * S5_NSEG + seg) * 64 + p] = hst;
#undef S5_LOADU
    }
}

__device__ __forceinline__ void stage_s5_prep(const Ctx& F, int l) {
    const auto& a = *F.a; unsigned char* ws = a.ws;
    const bf16* Z = (const bf16*)(ws + WS_Z); const float* YP = (const float*)(ws + WS_YP); bf16* AS5 = (bf16*)(ws + WS_AS5);
    const float dsk = a.in[I_S5D][l * 512 + F.tid];
    for (int row = F.bid; row < T_ALL; row += F.G) {
        const int c = F.tid;
        const float u = bf2f(Z[(size_t)row * IN_COLS + S5_OFF + c]);
        const float y = YP[(size_t)row * 512 + c] + YP[((size_t)T_ALL + row) * 512 + c] + u * dsk;
        const float ge = 0.5f * y * (1.f + tanhf(0.7978845608028654f * (y + 0.044715f * y * y * y)));
        AS5[(size_t)row * 512 + c] = (bf16)f2bf(ge);
    }
}

__device__ __forceinline__ void stage_hy_pre(const Ctx& F, int l) {
    const auto& a = *F.a; unsigned char* ws = a.ws; const int lane = F.lane;
    const bf16* Z = (const bf16*)(ws + WS_Z); bf16* UT = (bf16*)(ws + WS_UT);
    LAS bf16* tl = (LAS bf16*)(F.lds + F.wave * 16384);
    const float* cw = a.in[I_HYCW] + (size_t)l * 3 * 1536; const float* cbp = a.in[I_HYCB] + l * 1536;
    const int gw = F.bid * NWAVES + F.wave, NGW = F.G * NWAVES;
    for (int tile = gw; tile < (T_ALL / 64) * 24; tile += NGW) {
        const int rt = tile / 24, ct = tile % 24, row0 = rt * 64, col = ct * 64 + lane;
        int base, pos0, n; row_seq(row0, base, pos0, n);
        const bf16* zc = Z + (size_t)base * IN_COLS + HY_OFF + col;
        const float w0 = cw[col], w1 = cw[1536 + col], w2 = cw[2 * 1536 + col], cb = cbp[col];
        float zm = pos0 > 0 ? bf2f(zc[(size_t)(pos0 - 1) * IN_COLS]) : 0.f, z0 = bf2f(zc[(size_t)pos0 * IN_COLS]);
#pragma unroll 8
        for (int r = 0; r < 64; ++r) { const float zp = (pos0 + r + 1 < n) ? bf2f(zc[(size_t)(pos0 + r + 1) * IN_COLS]) : 0.f;
            tl[lane * 66 + r] = (bf16)f2bf(w0 * zm + w1 * z0 + w2 * zp + cb); zm = z0; z0 = zp; }
        LDS_WAIT(); asm volatile("" ::: "memory");
        bf16* up = UT + (size_t)(ct * 64) * T_ALL + row0 + lane;
#pragma unroll 8
        for (int cc = 0; cc < 64; ++cc) up[(size_t)cc * T_ALL] = tl[cc * 66 + lane];
        LDS_WAIT(); asm volatile("" ::: "memory");
    }
}
__device__ __forceinline__ void stage_hy_post(const Ctx& F, int l) {
    const auto& a = *F.a; unsigned char* ws = a.ws; const int lane = F.lane;
    const bf16* YT = (const bf16*)(ws + WS_UT) + (size_t)1024 * T_ALL; bf16* YHY = (bf16*)(ws + WS_YHY);
    LAS bf16* tl = (LAS bf16*)(F.lds + F.wave * 8448);
    const int gw = F.bid * NWAVES + F.wave, NGW = F.G * NWAVES;
    for (int tile = gw; tile < (T_ALL / 64) * 8; tile += NGW) {
        const int rt = tile >> 3, ct = tile & 7, row0 = rt * 64, c0 = ct * 64;
        const bf16* yp = YT + (size_t)c0 * T_ALL + row0 + lane;
#pragma unroll 8
        for (int cc = 0; cc < 64; ++cc) tl[cc * 66 + lane] = yp[(size_t)cc * T_ALL];
        LDS_WAIT(); asm volatile("" ::: "memory");
        bf16* op = YHY + (size_t)row0 * 512 + c0 + lane;
#pragma unroll 8
        for (int r = 0; r < 64; ++r) op[(size_t)r * 512] = tl[lane * 66 + r];
        LDS_WAIT(); asm volatile("" ::: "memory");
    }
}
typedef float f32x16 __attribute__((ext_vector_type(16)));
__device__ __forceinline__ void hyena_item(const Ctx& F, int l, int c, int isctx) {
    const auto& a = *F.a; unsigned char* ws = a.ws; const int tid = F.tid, lane = F.lane;
    const int n = isctx ? CTXL : SEQ, rowbase = isctx ? T_LAT : 0, RL = isctx ? HY_RLENC : HY_RLEN, off = n + 47;
    const bf16* UT = (const bf16*)(ws + WS_UT);
    const bf16* x1g = UT + (size_t)c * T_ALL + rowbase; const bf16* x2g = UT + (size_t)(512 + c) * T_ALL + rowbase; bf16* vg = (bf16*)UT + (size_t)(1024 + c) * T_ALL + rowbase;
    const bf16* Rg = (const bf16*)(ws + WS_GF + l * GF_STRIDE + (isctx ? GF_CTX : 0)) + (size_t)c * RL;
    LAS unsigned char* XB = F.lds; LAS unsigned char* R1 = F.lds + HY_R1_OFF; LAS unsigned char* R2 = F.lds + HY_R2_OFF;
    { const int cpb = n / 8;
      for (int q = tid; q < 8 * cpb; q += NTHREADS) { const int b = q / cpb, ch = q % cpb; *(LAS v4u*)(XB + b * HY_ROWB + 2 * HY_MARG + 16 * ch) = *(const v4u*)(vg + (size_t)b * n + 8 * ch); }
      if (tid < 256) { const int b = tid >> 5, side = (tid >> 4) & 1, ch = tid & 15; *(LAS v4u*)(XB + b * HY_ROWB + (side ? 2 * (HY_MARG + n) : 0) + 16 * ch) = (v4u){0u, 0u, 0u, 0u}; }
      const int rch = RL / 8;
      for (int q = tid; q < rch; q += NTHREADS) { *(LAS v4u*)(R1 + 16 * q) = *(const v4u*)(Rg + 8 * q); *(LAS v4u*)(R2 + 16 * q) = *(const v4u*)(Rg + (size_t)512 * RL + 8 * q); } }
    __syncthreads();
    const int i = lane & 31, kg = lane >> 5, jb = lane & 3, bb = (lane & 31) >> 2;
    const int rsh = (off - i) & 7, rd = rsh >> 1; const bool s1 = rd & 1, s2 = rd & 2; const unsigned sh = (rsh & 1) ? 16u : 0u;
    const int aconst = 2 * (off - i + 8 * kg - rsh), bconst = bb * HY_ROWB + 2 * (HY_MARG + 32 * jb + 8 * kg);
    const int T0w = 512 * F.wave; const int ntile = (n - T0w) >= 512 ? 4 : ((n - T0w) > 0 ? (n - T0w) / 128 : 0);
    const float bias0 = a.in[I_HYBIAS][(l * 2 + 0) * 512 + c], bias1 = a.in[I_HYBIAS][(l * 2 + 1) * 512 + c];
    f32x16 acc[4];
    v2u y1p[4][4];
#define HY_AFRAG(wa, wb, afr) do { \
        const unsigned a0 = s1 ? wa.y : wa.x, a1 = s1 ? wa.z : wa.y, a2 = s1 ? wa.w : wa.z, a3 = s1 ? wb.x : wa.w, a4 = s1 ? wb.y : wb.x, a5 = s1 ? wb.z : wb.y, a6 = s1 ? wb.w : wb.z; \
        const unsigned b0 = s2 ? a2 : a0, b1 = s2 ? a3 : a1, b2 = s2 ? a4 : a2, b3 = s2 ? a5 : a3, b4 = s2 ? a6 : a4; \
        v4u af_; af_.x = __builtin_amdgcn_alignbit(b1, b0, sh); af_.y = __builtin_amdgcn_alignbit(b2, b1, sh); af_.z = __builtin_amdgcn_alignbit(b3, b2, sh); af_.w = __builtin_amdgcn_alignbit(b4, b3, sh); \
        afr = __builtin_bit_cast(bf16x8, af_); } while (0)
#define HY_STEP_COND(RB, d) do { \
        const v4u wa = *(const LAS v4u*)((RB) + aconst - 2 * (d)), wb = *(const LAS v4u*)((RB) + aconst - 2 * (d) + 16); bf16x8 afr; HY_AFRAG(wa, wb, afr); \
        _Pragma("unroll") for (int m = 0; m < 4; ++m) { const int T0 = T0w + 128 * m; \
            if (m < ntile && (d) >= T0 - n + 16 && (d) <= T0 + 96) { const bf16x8 bfr = *(const LAS bf16x8*)(XB + bconst + 2 * (T0 - (d))); \
                acc[m] = __builtin_amdgcn_mfma_f32_32x32x16_bf16(afr, bfr, acc[m], 0, 0, 0); } } } while (0)
#define HY_LOAD(RB, d, wa, wb, bq) do { wa = *(const LAS v4u*)((RB) + aconst - 2 * (d)); wb = *(const LAS v4u*)((RB) + aconst - 2 * (d) + 16); \
        _Pragma("unroll") for (int m = 0; m < 4; ++m) bq[m] = *(const LAS bf16x8*)(XB + bconst + 2 * (T0w + 128 * m - (d))); } while (0)
#define HY_MMA(wa, wb, bq) do { bf16x8 afr; HY_AFRAG(wa, wb, afr); \
        _Pragma("unroll") for (int m = 0; m < 4; ++m) acc[m] = __builtin_amdgcn_mfma_f32_32x32x16_bf16(afr, bq[m], acc[m], 0, 0, 0); } while (0)
#define HY_CONV(RB) do { \
        _Pragma("unroll") for (int m = 0; m < 4; ++m) _Pragma("unroll") for (int e = 0; e < 16; ++e) acc[m][e] = 0.f; \
        if (ntile == 4) { \
            const int dA = T0w - n + 16, dB = T0w + 384 - n + 16, dC = T0w + 96, dD = T0w + 384 + 96;     \
            _Pragma("unroll 1") for (int d = dA; d < dB; d += 16) HY_STEP_COND(RB, d); \
            { v4u waA, wbA, waB, wbB; bf16x8 bqA[4], bqB[4]; \
              HY_LOAD(RB, dB, waA, wbA, bqA); \
              _Pragma("unroll 1") for (int d = dB; d <= dC; d += 32) { \
                  if (d + 16 <= dC) HY_LOAD(RB, d + 16, waB, wbB, bqB); \
                  __builtin_amdgcn_sched_barrier(0); \
                  HY_MMA(waA, wbA, bqA); \
                  __builtin_amdgcn_sched_barrier(0); \
                  if (d + 32 <= dC) HY_LOAD(RB, d + 32, waA, wbA, bqA); \
                  __builtin_amdgcn_sched_barrier(0); \
                  if (d + 16 <= dC) HY_MMA(waB, wbB, bqB); \
                  __builtin_amdgcn_sched_barrier(0); } } \
            _Pragma("unroll 1") for (int d = dC + 16; d <= dD; d += 16) HY_STEP_COND(RB, d); \
        } else if (ntile > 0) { const int dhi = T0w + 128 * (ntile - 1) + 96; \
            _Pragma("unroll 1") for (int d = T0w - n + 16; d <= dhi; d += 16) HY_STEP_COND(RB, d); } } while (0)
    HY_CONV(R1);
#pragma unroll
    for (int m = 0; m < 4; ++m) if (m < ntile) {
#pragma unroll
        for (int rg = 0; rg < 4; ++rg) { const int t4 = T0w + 128 * m + 32 * jb + 8 * rg + 4 * kg;
            const v2u xv = *(const v2u*)(x1g + (size_t)bb * n + t4); const v2u vv = *(const LAS v2u*)(XB + bb * HY_ROWB + 2 * (HY_MARG + t4));
            const float y0 = bflo(xv.x) * (acc[m][4 * rg + 0] + bias0 * bflo(vv.x)), y1 = bfhi(xv.x) * (acc[m][4 * rg + 1] + bias0 * bfhi(vv.x));
            const float y2 = bflo(xv.y) * (acc[m][4 * rg + 2] + bias0 * bflo(vv.y)), y3 = bfhi(xv.y) * (acc[m][4 * rg + 3] + bias0 * bfhi(vv.y));
            y1p[m][rg].x = pk2(y0, y1); y1p[m][rg].y = pk2(y2, y3); } }
    __syncthreads();
#pragma unroll
    for (int m = 0; m < 4; ++m) if (m < ntile) {
#pragma unroll
        for (int rg = 0; rg < 4; ++rg) { const int t4 = T0w + 128 * m + 32 * jb + 8 * rg + 4 * kg; *(LAS v2u*)(XB + bb * HY_ROWB + 2 * (HY_MARG + t4)) = y1p[m][rg]; } }
    __syncthreads();
    HY_CONV(R2);
#pragma unroll
    for (int m = 0; m < 4; ++m) if (m < ntile) {
#pragma unroll
        for (int rg = 0; rg < 4; ++rg) { const int t4 = T0w + 128 * m + 32 * jb + 8 * rg + 4 * kg;
            const v2u xv = *(const v2u*)(x2g + (size_t)bb * n + t4); const v2u yv = y1p[m][rg];
            const float o0 = bflo(xv.x) * (acc[m][4 * rg + 0] + bias1 * bflo(yv.x)), o1 = bfhi(xv.x) * (acc[m][4 * rg + 1] + bias1 * bfhi(yv.x));
            const float o2 = bflo(xv.y) * (acc[m][4 * rg + 2] + bias1 * bflo(yv.y)), o3 = bfhi(xv.y) * (acc[m][4 * rg + 3] + bias1 * bfhi(yv.y));
            v2u ov; ov.x = pk2(o0, o1); ov.y = pk2(o2, o3); *(v2u*)(vg + (size_t)bb * n + t4) = ov; } }
    __syncthreads();
#undef HY_CONV
#undef HY_AFRAG
#undef HY_STEP_COND
#undef HY_LOAD
#undef HY_MMA
}
__device__ __forceinline__ void stage_mixer(const Ctx& F, int l) {
    unsigned* ctr = (unsigned*)(F.a->ws + WS_CTL) + CW_WORK + 64 * l;
    LAS int* itb = (LAS int*)(F.lds + LDSCTL_OFF + 512);
    const int nit = 256 + 512 + (l == 0 ? 512 : 0);
#ifdef PROBE_STATIC
    return;
#endif
    for (;;) {
        if (F.tid == 0) *itb = (int)__hip_atomic_fetch_add(ctr, 1u, __ATOMIC_RELAXED, __HIP_MEMORY_SCOPE_AGENT);
        __syncthreads();
        const int it = *itb;
        __syncthreads();
        if (it >= nit) break;
#ifdef PROBE_T
        if (l == 0 && F.tid == 0 && it == 5) ((unsigned long long*)(F.a->ws + WS_CTL + CW_STAMP * 4))[21] = __builtin_amdgcn_s_memrealtime();
        if (l == 0 && F.tid == 0 && it == 300) ((unsigned long long*)(F.a->ws + WS_CTL + CW_STAMP * 4))[23] = __builtin_amdgcn_s_memrealtime();
#endif
        if (it < 256) { for (int rep = 0; rep < ((DUPK == 9) ? 2 : 1); ++rep) rw_scan_item(F, l, it); }
        else if (it < 768) hyena_item(F, l, it - 256, 0);
        else hyena_item(F, l, it - 768, 1);
#ifdef PROBE_T
        if (l == 0 && F.tid == 0 && it == 5) ((unsigned long long*)(F.a->ws + WS_CTL + CW_STAMP * 4))[22] = __builtin_amdgcn_s_memrealtime();
        if (l == 0 && F.tid == 0 && it == 300) ((unsigned long long*)(F.a->ws + WS_CTL + CW_STAMP * 4))[24] = __builtin_amdgcn_s_memrealtime();
#endif
    }
}

typedef float f32x16r __attribute__((ext_vector_type(16)));
__device__ __forceinline__ void stage_norm2_router(const Ctx& F, int l) {
    const auto& a = *F.a; unsigned char* ws = a.ws; const int lane = F.lane;
    const float* X = (const float*)(ws + WS_X); bf16* H = (bf16*)(ws + WS_H); const float* MOD = (const float*)(ws + WS_MOD);
    int* EIDX = (int*)(ws + WS_EIDX); float* GATE = (float*)(ws + WS_GATE); int* BLKCNT = (int*)(ws + WS_BLKCNT);
    LAS float* lg = (LAS float*)(F.lds + F.wave * 4352);
    LAS int* hist = (LAS int*)(F.lds + LDSCTL_OFF + 1024);
    if (F.tid < 32) hist[F.tid] = 0;
    __syncthreads();
    const int rpb = (T_ALL + F.G - 1) / F.G, r0 = F.bid * rpb, r1 = (r0 + rpb < T_ALL) ? r0 + rpb : T_ALL;
    const float* rw = a.in[I_RTW] + (size_t)l * 1024 * 32;
    const int i = lane & 31, kk = lane >> 5;
    const f32x4* ng = (const f32x4*)(a.in[I_N2G] + l * D) + kk;
    for (int rb = r0 + F.wave * 32; rb < r1; rb += NWAVES * 32) {
        const int nrow = (r1 - rb) < 32 ? (r1 - rb) : 32; const bool live = i < nrow;
        const int row = live ? rb + i : r1 - 1; const int w = row < T_LAT ? (row >> 12) : 8;
        const f32x4* xr = (const f32x4*)(X + (size_t)row * D) + kk;
        float ss = 0.f;
#pragma unroll 8
        for (int q = 0; q < 128; ++q) { const f32x4 v = xr[2 * q]; ss += (v[0] * v[0] + v[1] * v[1]) + (v[2] * v[2] + v[3] * v[3]); }
        ss += __builtin_bit_cast(float, __builtin_amdgcn_ds_bpermute((lane ^ 32) << 2, __builtin_bit_cast(int, ss)));
        const float rstd = 1.0f / sqrtf(ss * (1.f / D) + 1e-6f);
        const f32x4* sh = (const f32x4*)(MOD + (size_t)(l * 9 + w) * 6144 + 3072) + kk; const f32x4* sc = (const f32x4*)(MOD + (size_t)(l * 9 + w) * 6144 + 4096) + kk;
        v2u* ho = (v2u*)(H + (size_t)row * D) + kk;
        f32x16r acc;
#pragma unroll
        for (int e = 0; e < 16; ++e) acc[e] = 0.f;
        const float* wp = rw + (size_t)(4 * kk) * 32 + i;
#pragma unroll 2
        for (int q = 0; q < 128; ++q) {
            const f32x4 xv = xr[2 * q]; const f32x4 h4 = xv * rstd * ng[2 * q] * (sc[2 * q] + 1.0f) + sh[2 * q];
            const float w0 = wp[(size_t)(8 * q) * 32], w1 = wp[(size_t)(8 * q + 1) * 32], w2 = wp[(size_t)(8 * q + 2) * 32], w3 = wp[(size_t)(8 * q + 3) * 32];
            if (live) { v2u o; o.x = pk2(h4[0], h4[1]); o.y = pk2(h4[2], h4[3]); ho[2 * q] = o; }
            acc = __builtin_amdgcn_mfma_f32_32x32x2f32(h4[0], w0, acc, 0, 0, 0);
            acc = __builtin_amdgcn_mfma_f32_32x32x2f32(h4[1], w1, acc, 0, 0, 0);
            acc = __builtin_amdgcn_mfma_f32_32x32x2f32(h4[2], w2, acc, 0, 0, 0);
            acc = __builtin_amdgcn_mfma_f32_32x32x2f32(h4[3], w3, acc, 0, 0, 0);
        }
        const float rbias = a.in[I_RTB][l * 32 + i];
#pragma unroll
        for (int r = 0; r < 16; ++r) { const int ri = (r & 3) + 8 * (r >> 2) + 4 * kk; lg[ri * 33 + i] = acc[r] + rbias; }
        LDS_WAIT(); asm volatile("" ::: "memory");
        if (lane < nrow) {
            LAS float* lr = lg + lane * 33; const int orow = rb + lane;
            float tv[4]; int ti[4];
#pragma unroll
            for (int r = 0; r < 4; ++r) { float bv = -INFINITY; int bi = 0;
#pragma unroll 8
                for (int e = 0; e < 32; ++e) { const float v = lr[e]; if (v > bv) { bv = v; bi = e; } }
                tv[r] = bv; ti[r] = bi; lr[bi] = -INFINITY; }
            const float e1 = expf(tv[1] - tv[0]), e2 = expf(tv[2] - tv[0]), e3 = expf(tv[3] - tv[0]); const float inv = 1.0f / (1.0f + e1 + e2 + e3);
            *(int4*)(EIDX + orow * 4) = make_int4(ti[0], ti[1], ti[2], ti[3]); *(f32x4*)(GATE + orow * 4) = (f32x4){inv, e1 * inv, e2 * inv, e3 * inv};
#pragma unroll
            for (int r = 0; r < 4; ++r) __hip_atomic_fetch_add(&hist[ti[r]], 1, __ATOMIC_RELAXED, __HIP_MEMORY_SCOPE_WORKGROUP);
        }
        LDS_WAIT(); asm volatile("" ::: "memory");
    }
    __syncthreads();
    if (F.tid < 32) BLKCNT[F.bid * 32 + F.tid] = hist[F.tid];
    __syncthreads();
}

__device__ __forceinline__ void stage_moe_scatter(const Ctx& F, int l) {
    const auto& a = *F.a; unsigned char* ws = a.ws; const int lane = F.lane;
    const bf16* H = (const bf16*)(ws + WS_H); bf16* XS = (bf16*)(ws + WS_XS);
    const int* EIDX = (const int*)(ws + WS_EIDX); int* POS = (int*)(ws + WS_POS); const int* BLKCNT = (const int*)(ws + WS_BLKCNT); int* META = (int*)(ws + WS_META);
    LAS int* tot = (LAS int*)F.lds; LAS int* off = tot + 32; LAS int* base = tot + 64; LAS int* posl = tot + 128; LAS int* eloc = tot + 4096;
    const int rpb = (T_ALL + F.G - 1) / F.G, r0 = F.bid * rpb, r1 = (r0 + rpb < T_ALL) ? r0 + rpb : T_ALL; const int na = (r1 > r0) ? (r1 - r0) * 4 : 0;
    for (int i = F.tid; i < na; i += NTHREADS) eloc[i] = EIDX[r0 * 4 + i];
    { LAS int* part = tot + 8192; const int e = F.tid & 31, pt = F.tid >> 5; int t = 0, o = 0;
      for (int b2 = pt; b2 < F.G; b2 += 16) { const int c = BLKCNT[b2 * 32 + e]; t += c; o += (b2 < F.bid) ? c : 0; }
      part[pt * 32 + e] = t; part[512 + pt * 32 + e] = o; }
    __syncthreads();
    if (F.tid < 32) { LAS int* part = tot + 8192; int t = 0, o = 0;
#pragma unroll
        for (int pt = 0; pt < 16; ++pt) { t += part[pt * 32 + F.tid]; o += part[512 + pt * 32 + F.tid]; }
        tot[F.tid] = t; off[F.tid] = o; }
    __syncthreads();
    if (F.tid == 0) { int acc = 0; for (int e = 0; e < 32; ++e) { base[e] = acc; acc += (tot[e] + 255) & ~255; } base[32] = acc; }
    __syncthreads();
    if (F.bid == 0 && F.tid < 33) META[F.tid] = base[F.tid];
    if (F.tid < 32) { int run = base[F.tid] + off[F.tid]; for (int i = 0; i < na; ++i) { if (eloc[i] == F.tid) { posl[i] = run; POS[r0 * 4 + i] = run; ++run; } } }
    __syncthreads();
    for (int i = F.wave; i < na; i += NWAVES) { const int row = r0 + (i >> 2); const int p = posl[i];
        const v4u* s = (const v4u*)(H + (size_t)row * D) + lane; v4u* dp = (v4u*)(XS + (size_t)p * D) + lane;
        dp[0] = s[0]; dp[64] = s[64]; }
    __syncthreads();
}
__device__ __forceinline__ LAS int* load_moe_base(const Ctx& F) {
    LAS int* base = (LAS int*)(F.lds + LDSCTL_OFF + 256);
    const int* META = (const int*)(F.a->ws + WS_META);
    if (F.tid < 33) base[F.tid] = META[F.tid];
    __syncthreads();
    return base;
}

constexpr int NSTAGE_L = 13, NSTAGES = 1 + DEPTH * NSTAGE_L + 1;
__global__ void __launch_bounds__(NTHREADS, 2) mk_fwd(Args args) {
    extern __shared__ __attribute__((aligned(16))) unsigned char lds_raw[];
    Ctx F; F.a = kargs(); F.lds = (LAS unsigned char*)lds_raw; F.tid = threadIdx.x; F.lane = F.tid & 63; F.wave = __builtin_amdgcn_readfirstlane(F.tid >> 6); F.bid = blockIdx.x; F.G = gridDim.x;
    volatile LAS unsigned* MISC = (volatile LAS unsigned*)(F.lds + LDSCTL_OFF);
    for (int u = F.tid; u < (LDS_BYTES - LDSCTL_OFF) / 4; u += NTHREADS) ((LAS unsigned*)(F.lds + LDSCTL_OFF))[u] = 0u;
    __syncthreads();
#if MK_PER_STAGE
#define GRID_BAR() do { } while (0)
#else
    (void)xcd_barrier_post((unsigned*)(F.a->ws + WS_CTL) + CW_BAR, MISC + 8);
#define GRID_BAR() do { XcdBarrier b_; b_.bar = (unsigned*)(kargs()->ws + WS_CTL) + CW_BAR; b_.x = xb_xcc_id(); b_.st = (volatile LAS unsigned*)((LAS unsigned char*)lds_raw + LDSCTL_OFF + opaque(32)); xcd_barrier(b_); } while (0)
#endif
#ifndef ONLY_S
#define ONLY_S -1
#endif
#define STG_SEL(k) (ONLY_S < 0 || ONLY_S == (((k) == 0) ? 0 : ((k) == NSTAGES - 1 ? 14 : (((k) - 1) % NSTAGE_L) + 1)))
#if MK_PER_STAGE
#define IN(k) (STG_SEL(k) && kargs()->ph_lo == (k))
#else
#define IN(k) STG_SEL(k)
#endif
#if MK_PER_STAGE
#define SEAM(k) do { } while (0)
#else
#define SEAM(k) do { if ((k) + 1 < NSTAGES) GRID_BAR(); } while (0)
#endif
#define STAGE(k) if (IN(k)) { F.a = kargs(); F.tid = opaque_v((int)threadIdx.x); F.lane = F.tid & 63; F.wave = __builtin_amdgcn_readfirstlane(F.tid >> 6); F.bid = opaque((int)blockIdx.x); F.G = opaque((int)gridDim.x); F.lds = (LAS unsigned char*)lds_raw + opaque(0); unsigned char* ws = F.a->ws; const int l = opaque(lq); unsigned char* wl = ws + WS_WTS + (size_t)l * WL_STRIDE; (void)wl; (void)ws;
#define STAGE_END(k) } SEAM(k);
    int lq = 0;
    STAGE(0) p0_prologue(F); STAGE_END(0)
    for (lq = 0; lq < DEPTH; ++lq) {
        const int sb = 1 + lq * NSTAGE_L;
        STAGE(sb + 0) stage_norm1(F, l); STAGE_END(sb + 0)
        STAGE(sb + 1) pg8::SchedStatic S; S.init(ws + WS_H, wl + WO_WIN, T_ALL, IN_COLS, 1024, F.G, F.bid); pg8::EpiBf16 E{(bf16*)(ws + WS_Z), IN_COLS, nullptr, 0};
            pg8::gemm_phase(F.lds, F.tid, 1024, S, E); STAGE_END(sb + 1)
        STAGE(sb + 2) for (int rep = 0; rep < REPN(1); ++rep) stage_rw_prep1(F, l); for (int rep = 0; rep < REPN(2); ++rep) stage_s5_scan<0>(F, l); for (int rep = 0; rep < REPN(3); ++rep) stage_hy_pre(F, l); STAGE_END(sb + 2)
        STAGE(sb + 3) { pg8::SchedStatic S; S.init(ws + WS_ARW, wl + WO_RWCAT, T_ALL, 2560, 256, F.G, F.bid); pg8::EpiBf16 E{(bf16*)(ws + WS_P), 2560, nullptr, 0}; PT(4); pg8::gemm_phase(F.lds, F.tid, 256, S, E); PT(5); }
            for (int rep = 0; rep < REPN(4); ++rep) stage_s5_scan<1>(F, l); STAGE_END(sb + 3)
        STAGE(sb + 4) for (int rep = 0; rep < REPN(5); ++rep) stage_rw_prep2(F, l); for (int rep = 0; rep < REPN(6); ++rep) stage_s5_prep(F, l); STAGE_END(sb + 4)
        STAGE(sb + 5) PT(10); stage_mixer(F, l); PT(11); STAGE_END(sb + 5) STAGE(sb + 5) PT(12); }
        STAGE(sb + 6) { pg8::SchedStatic S; S.init(ws + WS_AS5, wl + WO_GLU, T_ALL, 1024, 512, F.G, F.bid); pg8::EpiGlu<0> E{(bf16*)(ws + WS_YS5), 512, F.a->in[I_S5GLUB] + l * 1024, 0, 512}; PT(13); pg8::gemm_phase(F.lds, F.tid, 512, S, E); PT(14); }
            for (int rep = 0; rep < REPN(7); ++rep) stage_rw_readout(F, l); for (int rep = 0; rep < REPN(8); ++rep) stage_hy_post(F, l); STAGE_END(sb + 6)
        STAGE(sb + 7) pg8::SchedMerge S; S.A0 = (const char*)(ws + WS_YHY); S.A1 = (const char*)(ws + WS_YRW); S.A2 = (const char*)(ws + WS_YS5); S.Bt = (const char*)(wl + WO_WBR); S.tstep = (size_t)256 * 512 * 2; S.bstride = (size_t)1024 * 512 * 2;
            S.nM = T_ALL / 256; S.nN = 4; S.G = F.G; S.c = F.bid;
            pg8::EpiMerge E{(float*)(ws + WS_MTMP), (bf16*)(ws + WS_H), (const bf16*)(ws + WS_Z) + GATE_OFF}; pg8::gemm_phase(F.lds, F.tid, 512, S, E); STAGE_END(sb + 7)
        STAGE(sb + 8) pg8::SchedStatic S; S.init(ws + WS_H, wl + WO_WOUT, T_ALL, 1024, 1024, F.G, F.bid); pg8::EpiResid E{(float*)(ws + WS_X), (const float*)(ws + WS_MOD) + (size_t)l * 9 * 6144 + 2048};
            pg8::gemm_phase(F.lds, F.tid, 1024, S, E); STAGE_END(sb + 8)
        STAGE(sb + 9) PT(17); stage_norm2_router(F, l); PT(18); STAGE_END(sb + 9)
        STAGE(sb + 10) PT(19); stage_moe_scatter(F, l); PT(20); STAGE_END(sb + 10)
        STAGE(sb + 11) LAS int* base = load_moe_base(F);
            pg8::SchedMoe S; S.A = (const char*)(ws + WS_XS); S.Bt = (const char*)(wl + WO_W1); S.tstep = (size_t)256 * 1024 * 2; S.estride = (size_t)2048 * 1024 * 2; S.NPN = 8; S.G = F.G; S.c = F.bid; S.base = base;
            pg8::EpiGlu<1> E{(bf16*)(ws + WS_ACT), 1024, F.a->in[I_B1] + (size_t)l * 32 * 2048, 2048, 1024}; pg8::gemm_phase(F.lds, F.tid, 1024, S, E); STAGE_END(sb + 11)
        STAGE(sb + 12) LAS int* base = load_moe_base(F);
            pg8::SchedMoe S; S.A = (const char*)(ws + WS_ACT); S.Bt = (const char*)(wl + WO_W2); S.tstep = (size_t)256 * 1024 * 2; S.estride = (size_t)1024 * 1024 * 2; S.NPN = 4; S.G = F.G; S.c = F.bid; S.base = base;
            pg8::EpiBf16 E{(bf16*)(ws + WS_XS), 1024, F.a->in[I_B2] + (size_t)l * 32 * 1024, 1024}; pg8::gemm_phase(F.lds, F.tid, 1024, S, E); STAGE_END(sb + 12)
    }
    lq = DEPTH;
    STAGE(NSTAGES - 1)
#ifndef PROBE_T
        stage_norm1(F, l);
#endif
#ifdef PROBE_T
        { const unsigned long long* st = (const unsigned long long*)(F.a->ws + WS_CTL + CW_STAMP * 4); const float cval = (float)(long long)(st[PROBE_B] - st[PROBE_A]) * (1.0f / (100.0f * PROBE_DIV));
          __syncthreads(); for (size_t i = (size_t)F.bid * NTHREADS + F.tid; i < (size_t)T_LAT * D; i += (size_t)F.G * NTHREADS) F.a->out[i] = cval; }
#endif
    }
#undef IN
#undef SEAM
}

extern "C" void kernel_launch(void* const* d_in, const int* in_sizes, int n_in, void* d_out, int out_size, void* d_ws, size_t ws_size, hipStream_t stream) {
    static int grid = 0;
    if (grid == 0) {
        if (n_in != 51 || out_size != T_LAT * D || ws_size < WS_END) { fprintf(stderr, "kernel_launch: unexpected shapes (n_in %d out %d ws %zu, need %zu)\n", n_in, out_size, ws_size, (size_t)WS_END); grid = -1; return; }
        int dev = 0, cus = 0, per_cu = 0;
        if (hipGetDevice(&dev) != hipSuccess || hipDeviceGetAttribute(&cus, hipDeviceAttributeMultiprocessorCount, dev) != hipSuccess) { grid = -1; return; }
        if (hipFuncSetAttribute((const void*)mk_fwd, hipFuncAttributeMaxDynamicSharedMemorySize, LDS_BYTES) != hipSuccess) { fprintf(stderr, "kernel_launch: hipFuncSetAttribute failed\n"); grid = -1; return; }
        if (hipOccupancyMaxActiveBlocksPerMultiprocessor(&per_cu, (const void*)mk_fwd, NTHREADS, LDS_BYTES) != hipSuccess || per_cu < 1) fprintf(stderr, "kernel_launch: occupancy query says %d\n", per_cu);
        (void)hipGetLastError();
        grid = cus;
    }
    if (grid < 0) return;
    if (hipMemsetAsync((char*)d_ws + WS_CTL, 0, CTL_ZERO_BYTES, stream) != hipSuccess) return;
    Args a{};
    for (int i = 0; i < 51; ++i) a.in[i] = (const float*)d_in[i];
    a.out = (float*)d_out; a.ws = (unsigned char*)d_ws;
#if MK_PER_STAGE
    for (int s = 0; s < NSTAGES; ++s) { a.ph_lo = s; a.ph_hi = s + 1; int reps = 1;
#ifdef PROBE_SET
        { const int ls = (s == 0 || s == NSTAGES - 1) ? -1 : (s - 1) % NSTAGE_L;
          if (PROBE_SET >= 1 && PROBE_SET <= 13 && ls == PROBE_SET - 1 && ls != 5 && ls != 8 && !(ls == 0 && s > 1)) reps = 3;
          if (PROBE_SET == 14 && s == 0) reps = 3; }
#endif
        for (int r = 0; r < reps; ++r) hipLaunchKernelGGL(mk_fwd, dim3(grid), dim3(NTHREADS), LDS_BYTES, stream, a); }
#else
    a.ph_lo = 0; a.ph_hi = NSTAGES; hipLaunchKernelGGL(mk_fwd, dim3(grid), dim3(NTHREADS), LDS_BYTES, stream, a);
#endif
}
```

```cpp
#include <hip/hip_runtime.h>
#include <cstdio>
#include <cstdint>

#ifndef DUPK
#define DUPK 0
#endif
#define REPN(k) ((DUPK == (k)) ? 3 : 1)
#ifndef REP_GEMM
#define REP_GEMM 1
#endif
#ifndef REP_LIGHT
#define REP_LIGHT 1
#endif
#ifndef REP_PRO
#define REP_PRO 1
#endif
#ifndef MK_PER_STAGE
#define MK_PER_STAGE 0
#endif

#define GAS __attribute__((address_space(1)))
#define LAS __attribute__((address_space(3)))
typedef unsigned short bf16;
typedef unsigned v4u __attribute__((ext_vector_type(4)));
typedef unsigned v2u __attribute__((ext_vector_type(2)));
typedef float f32x4 __attribute__((ext_vector_type(4)));
typedef float f32x2 __attribute__((ext_vector_type(2)));
typedef short bf16x8 __attribute__((ext_vector_type(8)));

constexpr int D = 1024, BATCH = 8, SEQ = 4096, CTXL = 256, DEPTH = 2;
constexpr int T_LAT = BATCH * SEQ, T_CTX = BATCH * CTXL, T_ALL = T_LAT + T_CTX;
constexpr int IN_COLS = 6912, HY_OFF = 0, RW_OFF = 1536, S5_OFF = 3328, GATE_OFF = 3840;
constexpr int NE = 32, TOPK = 4;
constexpr int MAXSLOT = 147456;
constexpr int NWAVES = 8, NTHREADS = 512;
constexpr int HY_MARG = 128, HY_ROWB = 8720, HY_RLEN = 8272, HY_RLENC = 592;
constexpr int HY_R1_OFF = 8 * HY_ROWB, HY_R2_OFF = HY_R1_OFF + HY_RLEN * 2;

constexpr size_t MiB = 1ull << 20;
constexpr size_t WS_CTL = 0, CTL_ZERO_BYTES = 1 * MiB;
constexpr size_t WS_MOD = 1 * MiB;
constexpr size_t WS_BLKCNT = 2 * MiB;
constexpr size_t WS_META = 2 * MiB + 512 * 1024;
constexpr size_t WS_EIDX = 3 * MiB, WS_GATE = 4 * MiB, WS_POS = 5 * MiB;
constexpr size_t WS_WTS = 8 * MiB, WL_STRIDE = 214 * MiB;
constexpr size_t WO_WIN = 0, WO_RWCAT = 14 * MiB, WO_GLU = 16 * MiB, WO_WBR = 17 * MiB, WO_WOUT = 20 * MiB, WO_W1 = 22 * MiB, WO_W2 = 150 * MiB;
constexpr size_t WS_GF = 436 * MiB, GF_STRIDE = 20 * MiB, GF_CTX = 17 * MiB;
constexpr size_t WS_X = 504 * MiB;
constexpr size_t WS_H = 640 * MiB;
constexpr size_t WS_BIG = 708 * MiB;
constexpr size_t WS_Z = WS_BIG;
constexpr size_t WS_SCN = 1167 * MiB;
constexpr size_t WS_MTMP = WS_SCN;
constexpr size_t WS_P = 1473 * MiB;
constexpr size_t WS_ARW = 1643 * MiB;
constexpr size_t WS_YP = 1660 * MiB;
constexpr size_t WS_YDIR = WS_YP;
constexpr size_t WS_UT = 1796 * MiB;
constexpr size_t WS_AS5 = 2000 * MiB;
constexpr size_t WS_YHY = 1898 * MiB, WS_YRW = 1932 * MiB, WS_YS5 = 1966 * MiB;
constexpr size_t WS_XS = WS_BIG;
constexpr size_t WS_ACT = WS_BIG + 288 * MiB;
constexpr size_t WS_END = 2034 * MiB;
constexpr int CW_BAR = 4096;

constexpr int RING_BYTES = 131072;
constexpr int LDSCTL_OFF = RING_BYTES;
constexpr int LDS_BYTES = 147456;

typedef __bf16 bf16x2_t __attribute__((ext_vector_type(2)));
__device__ __forceinline__ unsigned pk2(float lo, float hi) { const bf16x2_t v = __builtin_convertvector((f32x2){lo, hi}, bf16x2_t); return __builtin_bit_cast(unsigned, v); }
__device__ __forceinline__ unsigned f2bf(float f) { return pk2(f, 0.f) & 0xffffu; }
__device__ __forceinline__ float bf2f(bf16 b) { return __builtin_bit_cast(float, ((unsigned)b) << 16); }
__device__ __forceinline__ float bflo(unsigned w) { return __builtin_bit_cast(float, w << 16); }
__device__ __forceinline__ float bfhi(unsigned w) { return __builtin_bit_cast(float, w & 0xffff0000u); }
__device__ __forceinline__ float sigm(float x) { return 1.f / (1.f + __expf(-x)); }
#define LDS_WAIT() asm volatile("s_waitcnt lgkmcnt(0)" ::: "memory")
__device__ __forceinline__ float dpp_f(float x, const int ctrl_sel) {
    const int v = __builtin_bit_cast(int, x);
    int r;
    if (ctrl_sel == 0) r = __builtin_amdgcn_update_dpp(0, v, 0xB1, 0xF, 0xF, true);
    else if (ctrl_sel == 1) r = __builtin_amdgcn_update_dpp(0, v, 0x4E, 0xF, 0xF, true);
    else r = __builtin_amdgcn_update_dpp(0, v, 0x141, 0xF, 0xF, true);
    return __builtin_bit_cast(float, r);
}
__device__ __forceinline__ float red32(float x) {
    x += dpp_f(x, 0); x += dpp_f(x, 1); x += dpp_f(x, 2);
    x += __builtin_bit_cast(float, __builtin_amdgcn_update_dpp(0, __builtin_bit_cast(int, x), 0x128, 0xF, 0xF, true));
    x += __builtin_bit_cast(float, __builtin_amdgcn_ds_swizzle(__builtin_bit_cast(int, x), 0x401F));
    return x;
}
__device__ __forceinline__ float wave_sum(float v) {
    v = red32(v);
    return __builtin_bit_cast(float, __builtin_amdgcn_readlane(__builtin_bit_cast(int, v), 0)) + __builtin_bit_cast(float, __builtin_amdgcn_readlane(__builtin_bit_cast(int, v), 32));
}
__device__ __forceinline__ int xch32(int v, const int step) {
    if (step == 0) return __builtin_amdgcn_update_dpp(0, v, 0xB1, 0xF, 0xF, true);
    if (step == 1) return __builtin_amdgcn_update_dpp(0, v, 0x4E, 0xF, 0xF, true);
    if (step == 2) return __builtin_amdgcn_update_dpp(0, v, 0x141, 0xF, 0xF, true);
    if (step == 3) return __builtin_amdgcn_update_dpp(0, v, 0x128, 0xF, 0xF, true);
    return __builtin_amdgcn_ds_swizzle(v, 0x401F);
}
__device__ __forceinline__ float red8(float x) { x += dpp_f(x, 0); x += dpp_f(x, 1); x += dpp_f(x, 2); return x; }

#define XB_TMO      128
#define XB_XCNT(j)  (256  + 64 * (j))
#define XB_XSUB(j)  (1280 + 64 * (j))
#define XB_XGEN(j)  (2304 + 64 * (j))
#define XB_TOP      3328
#define XB_TOPGEN   3392
#define XCD_BAR_WORDS 3456
#define XB_SPIN_CAP (1u << 22)
__device__ __forceinline__ unsigned xb_ld(unsigned* p)              { return __hip_atomic_load(p, __ATOMIC_RELAXED, __HIP_MEMORY_SCOPE_AGENT); }
__device__ __forceinline__ unsigned xb_add(unsigned* p, unsigned v) { return __hip_atomic_fetch_add(p, v, __ATOMIC_RELAXED, __HIP_MEMORY_SCOPE_AGENT); }
__device__ __forceinline__ unsigned xb_xcc_id() { return (unsigned)__builtin_amdgcn_s_getreg((3 << 11) | 20) & 0xFu; }
#define XB_SPIN(cond, bar) do { unsigned _sp = 0; while (cond) { __builtin_amdgcn_s_sleep(1); \
    if ((++_sp & 255u) == 0u) { if (xb_ld(&(bar)[XB_TMO])) break; if (_sp > XB_SPIN_CAP) { atomicAdd(&(bar)[XB_TMO], 1u); break; } } } } while (0)
struct XcdBarrier { unsigned* bar; unsigned x; volatile LAS unsigned* st; };
__device__ __forceinline__ XcdBarrier xcd_barrier_post(unsigned* bar, volatile LAS unsigned* st) {
    XcdBarrier b; b.bar = bar; b.x = xb_xcc_id(); b.st = st;
    if (threadIdx.x == 0) (void)xb_add(&bar[XB_XCNT(b.x)], 1u);
    return b;
}
__device__ __forceinline__ void xcd_barrier_complete(unsigned* bar, unsigned x, unsigned& nloc, unsigned& nx) {
    const unsigned G = gridDim.x * gridDim.y * gridDim.z;
    unsigned sum, cnt, mine, sp = 0u;
    for (;;) {
        sum = 0u; cnt = 0u; mine = 0u;
#pragma unroll
        for (unsigned j = 0; j < 16; ++j) { const unsigned c = xb_ld(&bar[XB_XCNT(j)]); sum += c; cnt += (c > 0u) ? 1u : 0u; mine = (j == x) ? c : mine; }
        if (sum == G) break;
        __builtin_amdgcn_s_sleep(1);
        if ((++sp & 255u) == 0u) { if (xb_ld(&bar[XB_TMO])) break; if (sp > XB_SPIN_CAP) { atomicAdd(&bar[XB_TMO], 1u); break; } }
    }
    nloc = mine > 0u ? mine : 1u; nx = cnt > 0u ? cnt : 1u;
}
__device__ __forceinline__ void xcd_barrier(const XcdBarrier& b) {
    asm volatile("s_waitcnt vmcnt(0)" ::: "memory");
    __syncthreads();
    if (threadIdx.x == 0) {
        unsigned* bar = b.bar;
        __builtin_amdgcn_s_waitcnt(0);
        unsigned nloc = b.st[0], nx = b.st[1];
        if (nloc == 0u) { xcd_barrier_complete(bar, b.x, nloc, nx); b.st[0] = nloc; b.st[1] = nx; }
        const unsigned old = xb_add(&bar[XB_XSUB(b.x)], 1u);
        const unsigned gen = old / nloc;
        if (old + 1u == (gen + 1u) * nloc) {
            __builtin_amdgcn_fence(__ATOMIC_RELEASE, "agent");
            asm volatile("s_waitcnt vmcnt(0)" ::: "memory");
            const unsigned og = xb_add(&bar[XB_TOP], 1u);
            const unsigned tg = og / nx;
            if (og + 1u == (tg + 1u) * nx) xb_add(&bar[XB_TOPGEN], 1u);
            else XB_SPIN(xb_ld(&bar[XB_TOPGEN]) == tg, bar);
            __builtin_amdgcn_fence(__ATOMIC_ACQUIRE, "agent");
            xb_add(&bar[XB_XGEN(b.x)], 1u);
            asm volatile("s_waitcnt vmcnt(0)" ::: "memory");
        } else {
            XB_SPIN(xb_ld(&bar[XB_XGEN(b.x)]) == gen, bar);
            __builtin_amdgcn_fence(__ATOMIC_ACQUIRE, "agent");
            asm volatile("s_waitcnt vmcnt(0)" ::: "memory");
        }
    }
    __syncthreads();
}

namespace pg8 {
constexpr int BM = 256, BK = 64, HALF = 128, HTB = HALF * BK * 2, STAGE_BYTES = 8 * HTB, NXCD = 8, WGM = 8;
__host__ __device__ __forceinline__ int lds_byte(int r, int c) { const int st = (r >> 4) * 2 + (c >> 5), rr = r & 15, cc = c & 31, ob = rr * 64 + cc * 2; return st * 1024 + (ob ^ (((ob >> 9) & 1) << 5)); }
__host__ __device__ __forceinline__ void stage_rc(int b, int& R, int& C) { const int st = b / 1024, sb = b % 1024, swz = sb ^ (((sb >> 9) & 1) << 5); R = (st >> 1) * 16 + swz / 64; C = (st & 1) * 32 + (swz % 64) / 2; }
__host__ __device__ __forceinline__ int perm32(int rho) { const int n = rho >> 4, i = rho & 15; return 8 * (i >> 2) + 4 * n + (i & 3); }
struct Unit { int pm, pn, e; };
__device__ __forceinline__ unsigned cvt_pk_bf16(float lo, float hi) { return pk2(lo, hi); }

__device__ __forceinline__ void tile_of(int L, int nM, int nN, int& pm, int& pn) {
    const int nwg = nM * nN; int wgid = L;
    { const int q = nwg / NXCD, r = nwg % NXCD, xcd = wgid % NXCD, off = wgid / NXCD; wgid = (xcd < r ? xcd * (q + 1) : r * (q + 1) + (xcd - r) * q) + off; }
    const int nig = WGM * nN, gid = wgid / nig, fm = gid * WGM, gsz = (nM - fm) < WGM ? (nM - fm) : WGM;
    pm = fm + ((wgid % nig) % gsz); pn = (wgid % nig) / gsz;
}
struct SchedStatic {
    const char* A; const char* Bt; size_t tstep; int nM, nN, G, c;
    __device__ __forceinline__ void init(const void* A_, const void* Bt_, int M, int N, int K, int G_, int c_) { A = (const char*)A_; Bt = (const char*)Bt_; tstep = (size_t)BM * K * 2; nM = M / BM; nN = N / BM; G = G_; c = c_; }
    __device__ __forceinline__ bool next(int i, Unit& u) const { const long L = (long)i * G + c; if (L >= (long)nM * nN) return false; tile_of((int)L, nM, nN, u.pm, u.pn); u.e = 0; return true; }
    __device__ __forceinline__ const char* aptr(const Unit& u) const { return A + (size_t)u.pm * tstep; }
    __device__ __forceinline__ const char* bptr(const Unit& u) const { return Bt + (size_t)u.pn * tstep; }
};
struct SchedMerge {
    const char* A0; const char* A1; const char* A2; const char* Bt; size_t tstep, bstride; int nM, nN, G, c;
    __device__ __forceinline__ bool next(int i, Unit& u) const { const int j = i / 3, br = i - 3 * j; const long L = (long)j * G + c; if (L >= (long)nM * nN) return false; tile_of((int)L, nM, nN, u.pm, u.pn); u.e = br; return true; }
    __device__ __forceinline__ const char* aptr(const Unit& u) const { return (u.e == 0 ? A0 : (u.e == 1 ? A1 : A2)) + (size_t)u.pm * tstep; }
    __device__ __forceinline__ const char* bptr(const Unit& u) const { return Bt + (size_t)u.e * bstride + (size_t)u.pn * tstep; }
};
struct SchedMoe {
    const char* A; const char* Bt; size_t tstep, estride; int NPN, G, c; const LAS int* base;
    __device__ __forceinline__ bool next(int i, Unit& u) const {
        const int ntiles = base[32] >> 8; const long L = (long)i * G + c; if (L >= (long)ntiles * NPN) return false;
        u.pm = (int)(L / NPN); u.pn = (int)(L % NPN); const int r0 = u.pm << 8; int e = 0;
#pragma unroll 1
        for (int k = 1; k < 32; ++k) e += (r0 >= base[k]) ? 1 : 0;
        u.e = e; return true;
    }
    __device__ __forceinline__ const char* aptr(const Unit& u) const { return A + (size_t)u.pm * tstep; }
    __device__ __forceinline__ const char* bptr(const Unit& u) const { return Bt + (size_t)u.e * estride + (size_t)u.pn * tstep; }
};

template <class Epi, class Sched>
__device__ __forceinline__ void gemm_phase(LAS unsigned char* lds, const int tid, const int K, const Sched& S, const Epi& E) {
    const int wid = __builtin_amdgcn_readfirstlane(tid >> 6), lane = tid & 63, wr = wid >> 2, wc = wid & 3, fr = lane & 15, fq = lane >> 4;
    const int nt = K / BK;
    unsigned voffA[2], voffB[2];
#pragma unroll
    for (int i = 0; i < 2; ++i) { int R, C; stage_rc(tid * 16 + i * 8192, R, C); const int Rb = Epi::PERM ? ((R & ~31) + perm32(R & 31)) : R;
        voffA[i] = (unsigned)(R * K + C) * 2u; voffB[i] = (unsigned)(Rb * K + C) * 2u; }
    const size_t kstep = (size_t)(BK * 2);
    const size_t hstep = (size_t)HALF * K * 2;
    const unsigned ldsw = (unsigned)wid * 1024u;
    const int aoff = lds_byte(wr * 64 + fr, fq * 8), boff = lds_byte(wc * 32 + fr, fq * 8);
#define PG8_SA(b, h) (((b) * 2 + (h)) * HTB)
#define PG8_SB(b, h) ((4 + (b) * 2 + (h)) * HTB)
#define PG8_STAGE(bufoff, gbase, voff) do { _Pragma("unroll") for (int _i = 0; _i < 2; ++_i) \
        __builtin_amdgcn_global_load_lds((const unsigned*)((const char*)(gbase) + (voff)[_i]), (LAS unsigned*)(lds + (bufoff) + ldsw + _i * 8192), 16, 0, 0); } while (0)
#define PG8_LDA(dst, b, h) do { _Pragma("unroll") for (int m = 0; m < 4; ++m) _Pragma("unroll") for (int k = 0; k < 2; ++k) dst[m][k] = *(const LAS bf16x8*)(lds + PG8_SA(b, h) + aoff + m * 2048 + k * 1024); } while (0)
#define PG8_LDB(dst, b, h) do { _Pragma("unroll") for (int n = 0; n < 2; ++n) _Pragma("unroll") for (int k = 0; k < 2; ++k) dst[n][k] = *(const LAS bf16x8*)(lds + PG8_SB(b, h) + boff + n * 2048 + k * 1024); } while (0)
#define PG8_MMA(ai, bj, At, Bt) do { __builtin_amdgcn_s_setprio(1); _Pragma("unroll") for (int m = 0; m < 4; ++m) _Pragma("unroll") for (int n = 0; n < 2; ++n) _Pragma("unroll") for (int k = 0; k < 2; ++k) \
        acc[ai][bj][m][n] = __builtin_amdgcn_mfma_f32_16x16x32_bf16(Bt[n][k], At[m][k], acc[ai][bj][m][n], 0, 0, 0); __builtin_amdgcn_s_setprio(0); } while (0)
#define PG8_WAIT_V(n) asm volatile("s_waitcnt vmcnt(" #n ")" ::: "memory")
#define PG8_WAIT_L(n) asm volatile("s_waitcnt lgkmcnt(" #n ")" ::: "memory")
#define PG8_BAR __builtin_amdgcn_s_barrier()
#define PG8_SCHED __builtin_amdgcn_sched_barrier(0)
    Unit cur, nxt; int ui = 0;
    if (!S.next(0, cur)) return;
    f32x4 acc[2][2][4][2];
#pragma unroll
    for (int a = 0; a < 2; ++a)
#pragma unroll
        for (int b = 0; b < 2; ++b)
#pragma unroll
            for (int m = 0; m < 4; ++m)
#pragma unroll
                for (int n = 0; n < 2; ++n) acc[a][b][m][n] = (f32x4){0.f, 0.f, 0.f, 0.f};
    bf16x8 At[4][2], B0[2][2], B1[2][2];
    const char* cA = S.aptr(cur); const char* cB = S.bptr(cur);
    PG8_STAGE(PG8_SB(0, 0), cB, voffB); PG8_STAGE(PG8_SB(0, 1), cB + hstep, voffB); PG8_STAGE(PG8_SA(0, 0), cA, voffA); PG8_STAGE(PG8_SA(0, 1), cA + hstep, voffA);
    if (wr == 1) PG8_BAR;
    PG8_WAIT_V(2); PG8_BAR;
    PG8_STAGE(PG8_SB(1, 0), cB + kstep, voffB); PG8_STAGE(PG8_SA(1, 0), cA + kstep, voffA); PG8_STAGE(PG8_SB(1, 1), cB + hstep + kstep, voffB);
    PG8_WAIT_V(6); PG8_BAR;
    for (;;) {
        const bool has_next = S.next(ui + 1, nxt);
        const char* nA = has_next ? S.aptr(nxt) : cA; const char* nB = has_next ? S.bptr(nxt) : cB;
        for (int t = 0; t < nt; t += 2) {
            const bool last = (t == nt - 2);
            const char* a1 = cA + (size_t)(t + 1) * kstep;
            const char* a2 = last ? nA : cA + (size_t)(t + 2) * kstep; const char* b2 = last ? nB : cB + (size_t)(t + 2) * kstep;
            const char* a3 = a2 + kstep; const char* b3 = b2 + kstep;
            PG8_LDB(B0, 0, 0); PG8_LDB(B1, 0, 1); PG8_SCHED; PG8_LDA(At, 0, 0); PG8_STAGE(PG8_SA(1, 1), a1 + hstep, voffA);
            PG8_WAIT_V(8); PG8_WAIT_L(0); PG8_BAR; PG8_MMA(0, 0, At, B0); PG8_MMA(0, 1, At, B1); PG8_BAR; PG8_SCHED;
            PG8_LDA(At, 0, 1); PG8_STAGE(PG8_SB(0, 0), b2, voffB); PG8_STAGE(PG8_SB(0, 1), b2 + hstep, voffB); PG8_STAGE(PG8_SA(0, 0), a2, voffA);
            PG8_WAIT_V(8); PG8_WAIT_L(0); PG8_BAR; PG8_MMA(1, 0, At, B0); PG8_MMA(1, 1, At, B1); PG8_BAR; PG8_SCHED;
            PG8_LDB(B0, 1, 0); PG8_LDB(B1, 1, 1); PG8_SCHED; PG8_LDA(At, 1, 0); PG8_STAGE(PG8_SA(0, 1), a2 + hstep, voffA);
            PG8_WAIT_V(8); PG8_WAIT_L(0); PG8_BAR; PG8_MMA(0, 0, At, B0); PG8_MMA(0, 1, At, B1); PG8_BAR; PG8_SCHED;
            PG8_LDA(At, 1, 1); PG8_STAGE(PG8_SB(1, 0), b3, voffB); PG8_STAGE(PG8_SB(1, 1), b3 + hstep, voffB); PG8_STAGE(PG8_SA(1, 0), a3, voffA);
            PG8_WAIT_V(8); PG8_WAIT_L(0); PG8_BAR; PG8_MMA(1, 0, At, B0); PG8_MMA(1, 1, At, B1); PG8_BAR; PG8_SCHED;
        }
        if (wr == 0) PG8_BAR;
        E(acc, cur, wr, wc, fr, fq);
        if (!has_next) break;
#pragma unroll
        for (int a = 0; a < 2; ++a)
#pragma unroll
            for (int b = 0; b < 2; ++b)
#pragma unroll
                for (int m = 0; m < 4; ++m)
#pragma unroll
                    for (int n = 0; n < 2; ++n) acc[a][b][m][n] = (f32x4){0.f, 0.f, 0.f, 0.f};
        cur = nxt; cA = nA; cB = nB; ++ui;
        if (wr == 1) PG8_BAR;
    }
    PG8_WAIT_V(0);
    PG8_BAR;
#undef PG8_SA
#undef PG8_SB
#undef PG8_STAGE
#undef PG8_LDA
#undef PG8_LDB
#undef PG8_MMA
#undef PG8_WAIT_V
#undef PG8_WAIT_L
#undef PG8_BAR
#undef PG8_SCHED
}

struct EpiBf16 {
    static constexpr bool PERM = true;
    bf16* O; int ldc; const float* bias; int bias_stride;
    __device__ __forceinline__ void operator()(const f32x4 (&acc)[2][2][4][2], const Unit& u, int wr, int wc, int fr, int fq) const {
        const int row0 = u.pm * BM + wr * 64 + fr, col0 = u.pn * BM + wc * 32 + 8 * fq;
        f32x4 bv[2][2];
#pragma unroll
        for (int bj = 0; bj < 2; ++bj)
#pragma unroll
            for (int n = 0; n < 2; ++n) bv[bj][n] = bias ? *(const f32x4*)(bias + (size_t)u.e * bias_stride + col0 + bj * HALF + 4 * n) : (f32x4){0.f, 0.f, 0.f, 0.f};
#pragma unroll
        for (int ai = 0; ai < 2; ++ai)
#pragma unroll
            for (int m = 0; m < 4; ++m) { bf16* rowp = O + (size_t)(row0 + ai * HALF + m * 16) * ldc + col0;
#pragma unroll
                for (int bj = 0; bj < 2; ++bj) { const f32x4 v0 = acc[ai][bj][m][0] + bv[bj][0], v1 = acc[ai][bj][m][1] + bv[bj][1];
                    v4u w; w.x = cvt_pk_bf16(v0[0], v0[1]); w.y = cvt_pk_bf16(v0[2], v0[3]); w.z = cvt_pk_bf16(v1[0], v1[1]); w.w = cvt_pk_bf16(v1[2], v1[3]);
                    *(v4u*)(rowp + bj * HALF) = w; } }
    }
};
template <int MODE> struct EpiGlu {
    static constexpr bool PERM = true;
    bf16* O; int ldc; const float* bias; int bias_stride, hs;
    __device__ __forceinline__ void operator()(const f32x4 (&acc)[2][2][4][2], const Unit& u, int wr, int wc, int fr, int fq) const {
        const int row0 = u.pm * BM + wr * 64 + fr, col0 = u.pn * HALF + wc * 32 + 8 * fq;
        const float* bp = bias + (size_t)u.e * bias_stride + col0;
        f32x4 ba[2], bb[2];
#pragma unroll
        for (int n = 0; n < 2; ++n) { ba[n] = *(const f32x4*)(bp + 4 * n); bb[n] = *(const f32x4*)(bp + hs + 4 * n); }
#pragma unroll
        for (int ai = 0; ai < 2; ++ai)
#pragma unroll
            for (int m = 0; m < 4; ++m) { bf16* rowp = O + (size_t)(row0 + ai * HALF + m * 16) * ldc + col0;
                float o[8];
#pragma unroll
                for (int n = 0; n < 2; ++n) { const f32x4 a = acc[ai][0][m][n] + ba[n], b = acc[ai][1][m][n] + bb[n];
#pragma unroll
                    for (int j = 0; j < 4; ++j) {
                        if (MODE == 0) o[4 * n + j] = a[j] * sigm(b[j]);
                        else { const float g = fminf(a[j], 7.f), up = fminf(fmaxf(b[j], -7.f), 7.f); o[4 * n + j] = (up + 1.f) * g * sigm(1.702f * g); } } }
                v4u w; w.x = cvt_pk_bf16(o[0], o[1]); w.y = cvt_pk_bf16(o[2], o[3]); w.z = cvt_pk_bf16(o[4], o[5]); w.w = cvt_pk_bf16(o[6], o[7]);
                *(v4u*)rowp = w; }
    }
};
struct EpiMerge {
    static constexpr bool PERM = true;
    float* mtmp; bf16* Mo; const bf16* zg;
    __device__ __forceinline__ void operator()(const f32x4 (&acc)[2][2][4][2], const Unit& u, int wr, int wc, int fr, int fq) const {
        const int row0 = u.pm * BM + wr * 64 + fr, col0 = u.pn * BM + wc * 32 + 8 * fq;
#pragma unroll
        for (int ai = 0; ai < 2; ++ai)
#pragma unroll
            for (int m = 0; m < 4; ++m) { const size_t r = (size_t)(row0 + ai * HALF + m * 16);
#pragma unroll
                for (int bj = 0; bj < 2; ++bj) { const int c = col0 + bj * HALF;
                    const v4u gz = *(const v4u*)(zg + r * IN_COLS + u.e * 1024 + c);
                    float g[8] = {bflo(gz.x), bfhi(gz.x), bflo(gz.y), bfhi(gz.y), bflo(gz.z), bfhi(gz.z), bflo(gz.w), bfhi(gz.w)};
                    f32x4 t0, t1; float* tp = mtmp + r * 1024 + c;
                    if (u.e == 0) { t0 = (f32x4){0.f, 0.f, 0.f, 0.f}; t1 = t0; } else { t0 = *(const f32x4*)tp; t1 = *(const f32x4*)(tp + 4); }
#pragma unroll
                    for (int j = 0; j < 4; ++j) { t0[j] += sigm(g[j]) * acc[ai][bj][m][0][j]; t1[j] += sigm(g[4 + j]) * acc[ai][bj][m][1][j]; }
                    if (u.e < 2) { *(f32x4*)tp = t0; *(f32x4*)(tp + 4) = t1; }
                    else { v4u w; w.x = cvt_pk_bf16(t0[0], t0[1]); w.y = cvt_pk_bf16(t0[2], t0[3]); w.z = cvt_pk_bf16(t1[0], t1[1]); w.w = cvt_pk_bf16(t1[2], t1[3]);
                        *(v4u*)(Mo + r * 1024 + c) = w; } } }
    }
};
struct EpiResid {
    static constexpr bool PERM = false;
    float* X; const float* gmod;
    __device__ __forceinline__ void operator()(const f32x4 (&acc)[2][2][4][2], const Unit& u, int wr, int wc, int fr, int fq) const {
        const int row0 = u.pm * BM + wr * 64 + fr, col0 = u.pn * BM + wc * 32 + 4 * fq;
        const int r00 = u.pm * BM; const int w = r00 < T_LAT ? (r00 >> 12) : 8;
        f32x4 gv[2][2];
#pragma unroll
        for (int bj = 0; bj < 2; ++bj)
#pragma unroll
            for (int n = 0; n < 2; ++n) gv[bj][n] = *(const f32x4*)(gmod + (size_t)w * 6144 + col0 + bj * HALF + n * 16);
#pragma unroll
        for (int ai = 0; ai < 2; ++ai)
#pragma unroll
            for (int m = 0; m < 4; ++m) { float* rowp = X + (size_t)(row0 + ai * HALF + m * 16) * 1024 + col0;
#pragma unroll
                for (int bj = 0; bj < 2; ++bj)
#pragma unroll
                    for (int n = 0; n < 2; ++n) { f32x4* p = (f32x4*)(rowp + bj * HALF + n * 16); *p = *p + gv[bj][n] * acc[ai][bj][m][n]; } }
    }
};
}

struct Args { const float* in[51]; float* out; unsigned char* ws; int ph_lo, ph_hi; };
enum { I_X = 0, I_C, I_CTX, I_CCTX, I_ADAW, I_ADAB, I_N1G, I_N2G, I_WIN, I_HYCW, I_HYCB, I_HYW1, I_HYB1, I_HYF1, I_HYW2, I_HYB2, I_HYF2, I_HYW3, I_HYB3, I_HYBIAS,
       I_RWCW, I_RWCB, I_RWWUP, I_RWW0, I_RWAUP, I_RWA0, I_RWGUP, I_RWKK, I_RWKA, I_RWRK, I_RWLNG, I_RWLNB, I_S5ARE, I_S5AIM, I_S5LDT, I_S5BRE, I_S5BIM, I_S5CRE, I_S5CIM, I_S5D,
       I_S5GLUW, I_S5GLUB, I_WBR, I_WOUT, I_RTW, I_RTB, I_W1, I_B1, I_W2, I_B2, I_FING };

typedef const __attribute__((address_space(4))) Args* CArgsP;
__device__ __forceinline__ CArgsP kargs() { CArgsP p = (CArgsP)__builtin_amdgcn_kernarg_segment_ptr(); asm volatile("" : "+s"(p)); return p; }
__device__ __forceinline__ int opaque(int v) { asm volatile("" : "+s"(v)); return v; }
__device__ __forceinline__ int opaque_v(int v) { asm volatile("" : "+v"(v)); return v; }
struct Ctx { CArgsP a; LAS unsigned char* lds; int tid, lane, wave, bid, G; };

__device__ __forceinline__ void row_seq(int row, int& base, int& pos, int& n) {
    if (row < T_LAT) { base = row & ~(SEQ - 1); pos = row & (SEQ - 1); n = SEQ; }
    else { const int r = row - T_LAT; base = T_LAT + (r & ~(CTXL - 1)); pos = r & (CTXL - 1); n = CTXL; }
}
__device__ __forceinline__ float conv3z(const bf16* zc, int pos, int n, float w0, float w1, float w2, float b) {
    const float zm = pos > 0 ? bf2f(zc[(size_t)(pos - 1) * IN_COLS]) : 0.f, z0 = bf2f(zc[(size_t)pos * IN_COLS]), zp = pos < n - 1 ? bf2f(zc[(size_t)(pos + 1) * IN_COLS]) : 0.f;
    return zm * w0 + z0 * w1 + zp * w2 + b;
}

template <int MODE>
__device__ __forceinline__ void transpose_item(const float* W, int K, int N, bf16* WT, int Hs, LAS float* scr, int item, int lane) {
    const int nblk = N / 32, kb = item / nblk, nb = item % nblk, k0 = 64 * kb, n0 = 32 * nb;
#pragma unroll 8
    for (int i = 0; i < 32; ++i) { const int kk = 2 * i + (lane >> 5); scr[kk * 33 + (lane & 31)] = W[(size_t)(k0 + kk) * N + n0 + (lane & 31)]; }
    LDS_WAIT(); asm volatile("" ::: "memory");
    const int c = lane & 7;
#pragma unroll
    for (int j = 0; j < 4; ++j) { const int n = (lane >> 3) + 8 * j; const LAS float* s = scr + (8 * c) * 33 + n;
        v4u o; o.x = pk2(s[0 * 33], s[1 * 33]); o.y = pk2(s[2 * 33], s[3 * 33]); o.z = pk2(s[4 * 33], s[5 * 33]); o.w = pk2(s[6 * 33], s[7 * 33]);
        int dr = n0 + n;
        if (MODE == 1) { const int nc = n0 + n; const int jx = nc < Hs ? nc : nc - Hs; dr = (jx >> 7) * 256 + (nc < Hs ? 0 : 128) + (jx & 127); }
        *(v4u*)(WT + (size_t)dr * K + k0 + 8 * c) = o; }
    LDS_WAIT(); asm volatile("" ::: "memory");
}

__device__ __forceinline__ void p0_prologue(const Ctx& F) {
    const auto& a = *F.a; unsigned char* ws = a.ws;
    const int gw = F.bid * NWAVES + F.wave, NGW = F.G * NWAVES, lane = F.lane;
    float* X = (float*)(ws + WS_X);
    for (int row = gw; row < T_ALL; row += NGW) {
        f32x4* xo = (f32x4*)(X + (size_t)row * D) + lane;
        if (row < T_LAT) {
            const f32x4* xi = (const f32x4*)(a.in[I_X] + (size_t)row * D) + lane;
            const int t = row & (SEQ - 1); const float pr = (float)(t >> 6), pc = (float)(t & 63);
#pragma unroll
            for (int j = 0; j < 4; ++j) { f32x4 v = xi[64 * j];
#pragma unroll
                for (int e = 0; e < 4; ++e) { const float om = 1.0f / powf(10000.0f, (float)(4 * lane + e) / 256.0f); const float ang = ((j < 2) ? pr : pc) * om; v[e] += (j & 1) ? cosf(ang) : sinf(ang); }
                xo[64 * j] = v; }
        } else {
            const f32x4* xi = (const f32x4*)(a.in[I_CTX] + (size_t)(row - T_LAT) * D) + lane;
#pragma unroll
            for (int j = 0; j < 4; ++j) xo[64 * j] = xi[64 * j];
        }
    }
    {
        LAS float* condl = (LAS float*)F.lds; LAS float* psum = (LAS float*)(F.lds + 40960);
        for (int i = F.tid; i < 9 * 1024; i += NTHREADS) { const int w = i >> 10, k = i & 1023; const float cv = (w < 8) ? a.in[I_C][w * 1024 + k] : a.in[I_CCTX][k]; condl[i] = cv / (1.f + expf(-cv)); }
        __syncthreads();
        float* MOD = (float*)(ws + WS_MOD);
        for (int it = F.bid; it < 2 * 96; it += F.G) {
            const int l = it / 96, cg = it % 96, col = cg * 64 + lane;
            float acc[9];
#pragma unroll
            for (int w = 0; w < 9; ++w) acc[w] = 0.f;
            const float* wp = a.in[I_ADAW] + ((size_t)l * 1024 + F.wave * 128) * 6144 + col;
            for (int k = 0; k < 128; ++k) { const float wv = wp[(size_t)k * 6144];
#pragma unroll
                for (int w = 0; w < 9; ++w) acc[w] += condl[w * 1024 + F.wave * 128 + k] * wv; }
#pragma unroll
            for (int w = 0; w < 9; ++w) psum[(F.wave * 9 + w) * 64 + lane] = acc[w];
            __syncthreads();
            if (F.wave == 0) {
#pragma unroll
                for (int w = 0; w < 9; ++w) { float s = 0.f;
#pragma unroll
                    for (int wv = 0; wv < 8; ++wv) s += psum[(wv * 9 + w) * 64 + lane];
                    MOD[(size_t)(l * 9 + w) * 6144 + col] = s + a.in[I_ADAB][l * 6144 + col]; }
            }
            __syncthreads();
        }
    }
    {
        LAS float* scr = (LAS float*)(F.lds + F.wave * 16384);
        constexpr int IT_W1 = 16 * 64, IT_W2 = 16 * 32, IT_WIN = 16 * 216, IT_GLU = 8 * 32, IT_WBR = 8 * 32, IT_WOUT = 16 * 32;
        constexpr int N_W1 = 64 * IT_W1, N_W2 = 64 * IT_W2, N_WIN = 2 * IT_WIN, N_GLU = 2 * IT_GLU, N_WBR = 6 * IT_WBR, N_WOUT = 2 * IT_WOUT;
        constexpr int NITEMS = N_W1 + N_W2 + N_WIN + N_GLU + N_WBR + N_WOUT;
        for (int it = gw; it < NITEMS; it += NGW) {
            int r = it;
            if (r < N_W1) { const int mtx = r / IT_W1, l = mtx >> 5, e = mtx & 31; transpose_item<1>(a.in[I_W1] + (size_t)mtx * 1024 * 2048, 1024, 2048, (bf16*)(ws + WS_WTS + l * WL_STRIDE + WO_W1) + (size_t)e * 2048 * 1024, 1024, scr, r % IT_W1, lane); continue; } r -= N_W1;
            if (r < N_W2) { const int mtx = r / IT_W2, l = mtx >> 5, e = mtx & 31; transpose_item<0>(a.in[I_W2] + (size_t)mtx * 1024 * 1024, 1024, 1024, (bf16*)(ws + WS_WTS + l * WL_STRIDE + WO_W2) + (size_t)e * 1024 * 1024, 0, scr, r % IT_W2, lane); continue; } r -= N_W2;
            if (r < N_WIN) { const int l = r / IT_WIN; transpose_item<0>(a.in[I_WIN] + (size_t)l * 1024 * IN_COLS, 1024, IN_COLS, (bf16*)(ws + WS_WTS + l * WL_STRIDE + WO_WIN), 0, scr, r % IT_WIN, lane); continue; } r -= N_WIN;
            if (r < N_GLU) { const int l = r / IT_GLU; transpose_item<1>(a.in[I_S5GLUW] + (size_t)l * 512 * 1024, 512, 1024, (bf16*)(ws + WS_WTS + l * WL_STRIDE + WO_GLU), 512, scr, r % IT_GLU, lane); continue; } r -= N_GLU;
            if (r < N_WBR) { const int mtx = r / IT_WBR, l = mtx / 3, br = mtx % 3; transpose_item<0>(a.in[I_WBR] + (size_t)mtx * 512 * 1024, 512, 1024, (bf16*)(ws + WS_WTS + l * WL_STRIDE + WO_WBR) + (size_t)br * 1024 * 512, 0, scr, r % IT_WBR, lane); continue; } r -= N_WBR;
            { const int l = r / IT_WOUT; transpose_item<0>(a.in[I_WOUT] + (size_t)l * 1024 * 1024, 1024, 1024, (bf16*)(ws + WS_WTS + l * WL_STRIDE + WO_WOUT), 0, scr, r % IT_WOUT, lane); }
        }
        for (int i = F.bid * NTHREADS + F.tid; i < 2 * 2560 * 256; i += F.G * NTHREADS) {
            const int l = i / (2560 * 256), r = i % (2560 * 256), n = r >> 8, k = r & 255; float v = 0.f;
            if (n < 1024) { if (k < 64) v = a.in[I_RWWUP][(((size_t)l * 2 + (n >> 9)) * 64 + k) * 512 + (n & 511)]; }
            else if (n < 2048) { if (k >= 64 && k < 128) v = a.in[I_RWAUP][(((size_t)l * 2 + ((n - 1024) >> 9)) * 64 + (k - 64)) * 512 + (n & 511)]; }
            else { if (k >= 128) v = a.in[I_RWGUP][((size_t)l * 128 + (k - 128)) * 512 + (n - 2048)]; }
            ((bf16*)(ws + WS_WTS + l * WL_STRIDE + WO_RWCAT))[r] = (bf16)f2bf(v);
        }
    }
    __syncthreads();
    {
        LAS float* feats = (LAS float*)F.lds; LAS float* h1 = feats + 8 * 33; LAS float* h2 = h1 + 8 * 64;
        constexpr int NIT = 2 * (512 + 32);
        for (int it = F.bid; it < NIT; it += F.G) {
            const int l = it / 544, r = it % 544, nsel = r >= 512, n = nsel ? CTXL : SEQ, p0 = (nsel ? r - 512 : r) * 8;
            if (F.tid < 8 * 33) { const int p = F.tid / 33, i = F.tid % 33, pos = p0 + p; float f;
                if (i == 0) f = (float)pos / (float)(n - 1);
                else { const int k = (i - 1) & 15; const float band = 1e-4f + (float)k * ((15.0f - 1e-4f) / 15.0f); const float ang = (6.283185307179586f * (float)pos / (float)n) * band; f = (i <= 16) ? cosf(ang) : -sinf(ang); }
                feats[p * 33 + i] = f; }
            __syncthreads();
            { const int p = F.tid >> 6, j = F.tid & 63; float s = a.in[I_HYB1][l * 64 + j];
                for (int i = 0; i < 33; ++i) s += feats[p * 33 + i] * a.in[I_HYW1][((size_t)l * 33 + i) * 64 + j];
                h1[p * 64 + j] = sinf(a.in[I_HYF1][l * 64 + j] * s); }
            __syncthreads();
            { const int p = F.tid >> 6, j = F.tid & 63; float s = a.in[I_HYB2][l * 64 + j];
                for (int i = 0; i < 64; ++i) s += h1[p * 64 + i] * a.in[I_HYW2][((size_t)l * 64 + i) * 64 + j];
                h2[p * 64 + j] = sinf(a.in[I_HYF2][l * 64 + j] * s); }
            __syncthreads();
            float acc[4][8];
#pragma unroll
            for (int q = 0; q < 4; ++q)
#pragma unroll
                for (int p = 0; p < 8; ++p) acc[q][p] = 0.f;
            const float* w3 = a.in[I_HYW3] + (size_t)l * 64 * 2048 + F.tid;
            for (int i = 0; i < 64; ++i) { float wv[4];
#pragma unroll
                for (int q = 0; q < 4; ++q) wv[q] = w3[(size_t)i * 2048 + q * 512];
#pragma unroll
                for (int p = 0; p < 8; ++p) { const float hv = h2[p * 64 + i];
#pragma unroll
                    for (int q = 0; q < 4; ++q) acc[q][p] += hv * wv[q]; } }
            const int c = F.tid; const float dstart = logf(0.01f) / 1.5f, dstop = logf(0.01f) / 0.3f; const float delta = fabsf(dstart + (float)c * ((dstop - dstart) / 511.0f));
            const int RL = nsel ? HY_RLENC : HY_RLEN, off = n + 47;
            bf16* Rb = (bf16*)(ws + WS_GF + l * GF_STRIDE + (nsel ? GF_CTX : 0));
#pragma unroll
            for (int q = 0; q < 4; ++q) { const int o = q >> 1, side = q & 1; const float b3 = a.in[I_HYB3][l * 2048 + q * 512 + c];
                bf16* Rc = Rb + ((size_t)o * 512 + c) * RL;
#pragma unroll
                for (int p = 0; p < 8; ++p) { const int pos = p0 + p; const float t = (float)pos / (float)(n - 1); const float val = (acc[q][p] + b3) * expf(-t * delta);
                    if (side == 0) Rc[off - pos] = (bf16)f2bf(val);
                    else if (pos >= 1) Rc[off + pos] = (bf16)f2bf(val); }
                if (p0 == 0 && side == 0) { for (int m = 0; m < 48; ++m) Rc[m] = 0; for (int m = off + n; m < RL; ++m) Rc[m] = 0; } }
            __syncthreads();
        }
    }
}

__device__ __forceinline__ void stage_norm1(const Ctx& F, int l) {
    const auto& a = *F.a; unsigned char* ws = a.ws; const int lane = F.lane;
    const int gw = F.bid * NWAVES + F.wave, NGW = F.G * NWAVES;
    float* X = (float*)(ws + WS_X); bf16* H = (bf16*)(ws + WS_H); const float* MOD = (const float*)(ws + WS_MOD);
    const bf16* YS = (const bf16*)(ws + WS_XS); const int* POS = (const int*)(ws + WS_POS); const float* GATE = (const float*)(ws + WS_GATE);
    const int nrows = (l == DEPTH) ? T_LAT : T_ALL;
    for (int row = gw; row < nrows; row += NGW) {
        const int w = row < T_LAT ? (row >> 12) : 8;
        f32x4* xr = (f32x4*)(X + (size_t)row * D) + lane;
        f32x4 v[4];
#pragma unroll
        for (int j = 0; j < 4; ++j) v[j] = xr[64 * j];
        if (l > 0) {
            f32x4 mo[4];
#pragma unroll
            for (int j = 0; j < 4; ++j) mo[j] = (f32x4){0.f, 0.f, 0.f, 0.f};
#pragma unroll
            for (int k = 0; k < TOPK; ++k) { const int p = POS[row * 4 + k]; const float g = GATE[row * 4 + k];
                const v2u* yr = (const v2u*)(YS + (size_t)p * D) + lane;
#pragma unroll
                for (int j = 0; j < 4; ++j) { const v2u y = yr[64 * j]; mo[j][0] += g * bflo(y.x); mo[j][1] += g * bfhi(y.x); mo[j][2] += g * bflo(y.y); mo[j][3] += g * bfhi(y.y); } }
            const f32x4* g2 = (const f32x4*)(MOD + (size_t)((l - 1) * 9 + w) * 6144 + 5120) + lane;
#pragma unroll
            for (int j = 0; j < 4; ++j) { v[j] = v[j] + g2[64 * j] * mo[j]; xr[64 * j] = v[j]; }
        }
        float ss = 0.f;
#pragma unroll
        for (int j = 0; j < 4; ++j) ss += (v[j][0] * v[j][0] + v[j][1] * v[j][1]) + (v[j][2] * v[j][2] + v[j][3] * v[j][3]);
        const float rstd = 1.0f / sqrtf(wave_sum(ss) * (1.f / D) + 1e-6f);
        if (l == DEPTH) {
            const f32x4* fg = (const f32x4*)a.in[I_FING] + lane; f32x4* o = (f32x4*)(a.out + (size_t)row * D) + lane;
#pragma unroll
            for (int j = 0; j < 4; ++j) o[64 * j] = v[j] * rstd * fg[64 * j];
        } else {
            const f32x4* ng = (const f32x4*)(a.in[I_N1G] + l * D) + lane;
            const f32x4* sh = (const f32x4*)(MOD + (size_t)(l * 9 + w) * 6144) + lane; const f32x4* sc = (const f32x4*)(MOD + (size_t)(l * 9 + w) * 6144 + 1024) + lane;
            v2u* ho = (v2u*)(H + (size_t)row * D) + lane;
#pragma unroll
            for (int j = 0; j < 4; ++j) { const f32x4 h = v[j] * rstd * ng[64 * j] * (sc[64 * j] + 1.0f) + sh[64 * j]; v2u o; o.x = pk2(h[0], h[1]); o.y = pk2(h[2], h[3]); ho[64 * j] = o; }
        }
    }
}

__device__ __forceinline__ void stage_rw_prep1(const Ctx& F, int l) {
    const auto& a = *F.a; unsigned char* ws = a.ws;
    const bf16* Z = (const bf16*)(ws + WS_Z); bf16* ARW = (bf16*)(ws + WS_ARW);
    const int j = F.tid & 255, col = 1536 + j;
    const float* cw = a.in[I_RWCW] + (size_t)l * 3 * 1792; const float w0 = cw[col], w1 = cw[1792 + col], w2 = cw[2 * 1792 + col], cb = a.in[I_RWCB][l * 1792 + col];
    for (int row = F.bid * 2 + (F.tid >> 8); row < T_ALL; row += F.G * 2) {
        int base, pos, n; row_seq(row, base, pos, n);
        float v = conv3z(Z + (size_t)base * IN_COLS + RW_OFF + col, pos, n, w0, w1, w2, cb);
        if (j < 64) v = tanhf(v); else if (j >= 128) v = sigm(v);
        ARW[(size_t)row * 256 + j] = (bf16)f2bf(v);
    }
}

__device__ __forceinline__ void stage_rw_prep2(const Ctx& F, int l) {
    const auto& a = *F.a; unsigned char* ws = a.ws; const int lane = F.lane;
    const bf16* Z = (const bf16*)(ws + WS_Z); const bf16* P = (const bf16*)(ws + WS_P); bf16* SCN = (bf16*)(ws + WS_SCN);
    const int gw = F.bid * NWAVES + F.wave, NGW = F.G * NWAVES;
    constexpr int TR = 17, NRT = T_ALL / TR;
    const float* cw = a.in[I_RWCW] + (size_t)l * 3 * 1792; const float* cbp = a.in[I_RWCB] + l * 1792;
    for (int tile = gw; tile < NRT * 4; tile += NGW) {
        const int rt = tile % NRT, hp = tile / NRT, row0 = rt * TR, c0 = hp * 128 + 2 * lane;
        f32x2 w[3][3], cb[3];
#pragma unroll
        for (int s = 0; s < 3; ++s) { cb[s] = *(const f32x2*)(cbp + s * 512 + c0);
#pragma unroll
            for (int j = 0; j < 3; ++j) w[s][j] = *(const f32x2*)(cw + j * 1792 + s * 512 + c0); }
        const f32x2 KKw = *(const f32x2*)(a.in[I_RWKK] + l * 512 + c0), KAw = *(const f32x2*)(a.in[I_RWKA] + l * 512 + c0);
        f32x2 W0[2], A0[2];
#pragma unroll
        for (int d = 0; d < 2; ++d) { W0[d] = *(const f32x2*)(a.in[I_RWW0] + (l * 2 + d) * 512 + c0); A0[d] = *(const f32x2*)(a.in[I_RWA0] + (l * 2 + d) * 512 + c0); }
        const unsigned* zb = (const unsigned*)(Z + RW_OFF + c0);
        unsigned zm[3], z0[3], zp[3];
#pragma unroll
        for (int s = 0; s < 3; ++s) { zm[s] = row0 > 0 ? zb[(size_t)(row0 - 1) * (IN_COLS / 2) + s * 256] : 0u; z0[s] = zb[(size_t)row0 * (IN_COLS / 2) + s * 256]; }
#pragma unroll 1
        for (int i = 0; i < TR; ++i) {
            const int row = row0 + i; int base, pos, n; row_seq(row, base, pos, n);
#pragma unroll
            for (int s = 0; s < 3; ++s) zp[s] = (row + 1 < T_ALL) ? zb[(size_t)(row + 1) * (IN_COLS / 2) + s * 256] : 0u;
            const float mlo = pos > 0 ? 1.f : 0.f, mhi = pos < n - 1 ? 1.f : 0.f;
            f32x2 u[3];
#pragma unroll
            for (int s = 0; s < 3; ++s) { u[s] = (f32x2){bflo(zm[s]), bfhi(zm[s])} * mlo * w[s][0] + (f32x2){bflo(z0[s]), bfhi(z0[s])} * w[s][1] + (f32x2){bflo(zp[s]), bfhi(zp[s])} * mhi * w[s][2] + cb[s]; zm[s] = z0[s]; z0[s] = zp[s]; }
            const f32x2 r = u[0], k = u[1], v = u[2];
            f32x2 kk = k * KKw;
            const float ss = red32(kk[0] * kk[0] + kk[1] * kk[1]);
            kk = kk * (1.0f / sqrtf(fmaxf(ss, 1e-24f)));
            const unsigned* pr = (const unsigned*)(P + (size_t)row * 2560 + c0);
            unsigned* o = (unsigned*)(SCN + (size_t)row * 9 * 512 + c0);
            o[0] = pk2(r[0], r[1]); o[256] = pk2(v[0], v[1]); o[2 * 256] = pk2(kk[0], kk[1]);
#pragma unroll
            for (int d = 0; d < 2; ++d) {
                const unsigned pw = pr[d * 256], pa = pr[512 + d * 256];
                float ld[2], kd[2], be[2];
#pragma unroll
                for (int e = 0; e < 2; ++e) {
                    const float uu = W0[d][e] + (e ? bfhi(pw) : bflo(pw));
                    ld[e] = -0.60653065971263342f * sigm(uu);
                    const float av = sigm(A0[d][e] + (e ? bfhi(pa) : bflo(pa)));
                    kd[e] = k[e] * (1.f + (av - 1.f) * KAw[e]); be[e] = kk[e] * av; }
                o[(3 + 3 * d) * 256] = pk2(ld[0], ld[1]); o[(4 + 3 * d) * 256] = pk2(kd[0], kd[1]); o[(5 + 3 * d) * 256] = pk2(be[0], be[1]);
            }
        }
    }
}

__device__ __forceinline__ int seq_row(int b, int d, int sidx) {
    if (sidx < CTXL) { const int t = d ? (CTXL - 1 - sidx) : sidx; return T_LAT + b * CTXL + t; }
    const int tl = sidx - CTXL; const int t = d ? (SEQ - 1 - tl) : tl; return b * SEQ + t;
}

constexpr int CW_WORK = 16384;
constexpr int CW_STAMP = 20480;
#ifdef PROBE_T
#ifndef PROBE_BID
#define PROBE_BID 0
#endif
#define PT(k) do { if (F.bid == PROBE_BID && F.tid == 0 && l == 0) ((unsigned long long*)(F.a->ws + WS_CTL + CW_STAMP * 4))[k] = __builtin_amdgcn_s_memrealtime(); } while (0)
#else
#define PT(k) do { } while (0)
#endif
__device__ __forceinline__ void rw_scan_item(const Ctx& F, int l, int it2) {
    const int it = it2 >> 1, half = it2 & 1;
    const auto& a = *F.a; unsigned char* ws = a.ws; const int tid = F.tid, lane = F.lane;
    const bf16* SCN = (const bf16*)(ws + WS_SCN); float* YD = (float*)(ws + WS_YDIR);
    LAS float* sbuf = (LAS float*)F.lds;
    LAS float* ybuf = (LAS float*)(F.lds + 49152);
    const bool comp = F.wave < 4;
    const int lt = tid & 255, ls = lt >> 4, lj = lt & 15;
    const int vl = lane >> 3, kq = lane & 7, vrow = half * 32 + (F.wave & 3) * 8 + vl;
    constexpr int NCH = (CTXL + SEQ) / 16;
    const int d = it & 1, h = (it >> 1) & 7, b = it >> 4;
    f32x2 S[4];
#pragma unroll
    for (int q = 0; q < 4; ++q) S[q] = (f32x2){0.f, 0.f};
    v2u ldr[6];
#define RW_ISSUE(c) do { const int row_ = seq_row(b, d, (c) * 16 + ls); const v2u* p_ = (const v2u*)(SCN + (size_t)row_ * 9 * 512 + h * 64) + lj; \
        ldr[0] = p_[2 * 128]; ldr[1] = p_[(3 + 3 * d) * 128]; ldr[2] = p_[(5 + 3 * d) * 128]; ldr[3] = p_[(4 + 3 * d) * 128]; ldr[4] = p_[0]; ldr[5] = p_[128]; } while (0)
#define RW_WRITE(bufi) do { LAS float* o_ = sbuf + (((bufi) * 16 + ls) * 6) * 64 + 4 * lj; \
        *(LAS f32x4*)(o_) = (f32x4){-bflo(ldr[0].x), -bfhi(ldr[0].x), -bflo(ldr[0].y), -bfhi(ldr[0].y)}; \
        *(LAS f32x4*)(o_ + 64) = (f32x4){__expf(bflo(ldr[1].x)), __expf(bfhi(ldr[1].x)), __expf(bflo(ldr[1].y)), __expf(bfhi(ldr[1].y))}; \
        *(LAS f32x4*)(o_ + 128) = (f32x4){bflo(ldr[2].x), bfhi(ldr[2].x), bflo(ldr[2].y), bfhi(ldr[2].y)}; *(LAS f32x4*)(o_ + 192) = (f32x4){bflo(ldr[3].x), bfhi(ldr[3].x), bflo(ldr[3].y), bfhi(ldr[3].y)}; \
        *(LAS f32x4*)(o_ + 256) = (f32x4){bflo(ldr[4].x), bfhi(ldr[4].x), bflo(ldr[4].y), bfhi(ldr[4].y)}; *(LAS f32x4*)(o_ + 320) = (f32x4){bflo(ldr[5].x), bfhi(ldr[5].x), bflo(ldr[5].y), bfhi(ldr[5].y)}; } while (0)
#define RW_FLUSH(c) do { const int row_ = seq_row(b, d, (c) * 16 + ls); \
        *(f32x2*)(YD + ((size_t)d * T_ALL + row_) * 512 + h * 64 + half * 32 + 2 * lj) = *(const LAS f32x2*)(ybuf + ((((c) & 1) * 16 + ls) * 64) + half * 32 + 2 * lj); } while (0)
    if (!comp) { RW_ISSUE(0); RW_WRITE(0); RW_ISSUE(1); }
    __syncthreads();
#pragma unroll 1
    for (int c = 0; c < NCH; ++c) {
        const int bi = c & 1;
        if (!comp) {
            if (c + 1 < NCH) RW_WRITE(bi ^ 1);
            if (c + 2 < NCH) RW_ISSUE(c + 2);
            if (c > 0) RW_FLUSH(c - 1);
        } else {
        float yv[16];
        f32x4 opA[10], opB[10]; float vvA, vvB;
#define RW_LD(op, vvx, s_) do { const LAS float* sp_ = sbuf + ((bi * 16 + (s_)) * 6) * 64 + 8 * kq; \
            _Pragma("unroll") for (int q_ = 0; q_ < 5; ++q_) { op[2 * q_] = *(const LAS f32x4*)(sp_ + 64 * q_); op[2 * q_ + 1] = *(const LAS f32x4*)(sp_ + 64 * q_ + 4); } \
            vvx = sbuf[((bi * 16 + (s_)) * 6 + 5) * 64 + vrow]; } while (0)
#define RW_COMP(op, vvx, s_) do { \
            const f32x4 a0 = op[0], a1 = op[1], w0 = op[2], w1 = op[3], b0 = op[4], b1 = op[5], k0 = op[6], k1 = op[7], r0 = op[8], r1 = op[9]; \
            const f32x2 vv2 = (f32x2){vvx, vvx}; \
            const f32x2 p0 = S[1] * (f32x2){a0[2], a0[3]} + S[0] * (f32x2){a0[0], a0[1]}; \
            const f32x2 p1 = S[3] * (f32x2){a1[2], a1[3]} + S[2] * (f32x2){a1[0], a1[1]}; \
            const f32x2 t0 = S[0] * (f32x2){w0[0], w0[1]} + vv2 * (f32x2){k0[0], k0[1]}; \
            const f32x2 t1 = S[1] * (f32x2){w0[2], w0[3]} + vv2 * (f32x2){k0[2], k0[3]}; \
            const f32x2 t2 = S[2] * (f32x2){w1[0], w1[1]} + vv2 * (f32x2){k1[0], k1[1]}; \
            const f32x2 t3 = S[3] * (f32x2){w1[2], w1[3]} + vv2 * (f32x2){k1[2], k1[3]}; \
            const f32x2 ac = p0 + p1; \
            const float sa = red8(ac[0] + ac[1]); \
            const f32x2 sa2 = (f32x2){sa, sa}; \
            S[0] = sa2 * (f32x2){b0[0], b0[1]} + t0; S[1] = sa2 * (f32x2){b0[2], b0[3]} + t1; \
            S[2] = sa2 * (f32x2){b1[0], b1[1]} + t2; S[3] = sa2 * (f32x2){b1[2], b1[3]} + t3; \
            const f32x2 q0 = S[1] * (f32x2){r0[2], r0[3]} + S[0] * (f32x2){r0[0], r0[1]}; \
            const f32x2 q1 = S[3] * (f32x2){r1[2], r1[3]} + S[2] * (f32x2){r1[0], r1[1]}; \
            const f32x2 yc = q0 + q1; \
            yv[s_] = red8(yc[0] + yc[1]); } while (0)
        RW_LD(opA, vvA, 0);
#pragma unroll
        for (int s = 0; s < 16; s += 2) {
            RW_LD(opB, vvB, s + 1);
            __builtin_amdgcn_sched_barrier(0);
            RW_COMP(opA, vvA, s);
            __builtin_amdgcn_sched_barrier(0);
            if (s + 2 < 16) RW_LD(opA, vvA, s + 2);
            __builtin_amdgcn_sched_barrier(0);
            RW_COMP(opB, vvB, s + 1);
            __builtin_amdgcn_sched_barrier(0);
        }
#undef RW_LD
#undef RW_COMP
#pragma unroll
        for (int s = 0; s < 16; ++s) if ((s & 7) == kq) ybuf[((bi * 16 + s) * 64) + vrow] = yv[s];
        }
        __syncthreads();
    }
    if (!comp) RW_FLUSH(NCH - 1);
    __syncthreads();
#undef RW_ISSUE
#undef RW_WRITE
#undef RW_FLUSH
}

constexpr size_t WS_RWSCR = WS_YHY;
constexpr int RWS_QY = 0, RWS_YV = 2048, RWS_PZ = 4096, RWS_ZV = 12288, RWS_SLOT = 20480;
typedef __bf16 bf16x8n __attribute__((ext_vector_type(8)));
__device__ __forceinline__ f32x4 mma16(const bf16x8 a, const bf16x8 b, const f32x4 c) { return __builtin_amdgcn_mfma_f32_16x16x32_bf16(a, b, c, 0, 0, 0); }
__device__ __forceinline__ float dpp_shr(float x, const int n) {
    const int v = __builtin_bit_cast(int, x); int r;
    if (n == 1) r = __builtin_amdgcn_update_dpp(0, v, 0x111, 0xF, 0xF, true); else if (n == 2) r = __builtin_amdgcn_update_dpp(0, v, 0x112, 0xF, 0xF, true);
    else if (n == 4) r = __builtin_amdgcn_update_dpp(0, v, 0x114, 0xF, 0xF, true); else r = __builtin_amdgcn_update_dpp(0, v, 0x118, 0xF, 0xF, true);
    return __builtin_bit_cast(float, r);
}
__device__ __forceinline__ v4u pack8(const float (&x)[8]) { v4u o; o.x = pk2(x[0], x[1]); o.y = pk2(x[2], x[3]); o.z = pk2(x[4], x[5]); o.w = pk2(x[6], x[7]); return o; }
__device__ __forceinline__ void unpack8(const v4u u, float (&x)[8]) { x[0] = bflo(u.x); x[1] = bfhi(u.x); x[2] = bflo(u.y); x[3] = bfhi(u.y); x[4] = bflo(u.z); x[5] = bfhi(u.z); x[6] = bflo(u.w); x[7] = bfhi(u.w); }
__device__ __forceinline__ bf16x8 frag16(const LAS bf16* m, int rowbase, int lane) {
    v4u v = (v4u){0u, 0u, 0u, 0u}; if ((lane >> 4) < 2) v = *(const LAS v4u*)(m + (rowbase + (lane & 15)) * 16 + 8 * (lane >> 4)); return __builtin_bit_cast(bf16x8, v); }
__device__ __forceinline__ void st_colmaj(LAS bf16* m, int colbase, const f32x4 d, int lane) {
    v2u o; o.x = pk2(d[0], d[1]); o.y = pk2(d[2], d[3]); *(LAS v2u*)(m + (colbase + (lane & 15)) * 16 + 4 * (lane >> 4)) = o; }
__device__ __forceinline__ void st_rowmaj(LAS bf16* m, const f32x4 d, int lane) {
#pragma unroll
    for (int r = 0; r < 4; ++r) m[(4 * (lane >> 4) + r) * 16 + (lane & 15)] = (bf16)f2bf(d[r]); }
template <int KS0, int KS1>
__device__ __forceinline__ void rw_chunk_load(const Ctx& F, int b, int h, int d, int cidx, v4u (&raw)[12]) {
    const int lane = opaque_v(F.lane), t = lane & 15, kg = lane >> 4;
    const bf16* base = (const bf16*)(F.a->ws + WS_SCN) + (size_t)seq_row(b, d, 16 * cidx + t) * 9 * 512 + h * 64;
#pragma unroll
    for (int ks = KS0; ks < KS1; ++ks) { const int off = 32 * ks + 8 * kg;
        raw[6 * ks + 0] = *(const v4u*)(base + (3 + 3 * d) * 512 + off); raw[6 * ks + 1] = *(const v4u*)(base + 2 * 512 + off); raw[6 * ks + 2] = *(const v4u*)(base + off);
        raw[6 * ks + 3] = *(const v4u*)(base + (5 + 3 * d) * 512 + off); raw[6 * ks + 4] = *(const v4u*)(base + (4 + 3 * d) * 512 + off); raw[6 * ks + 5] = *(const v4u*)(base + 512 + off); }
}
__device__ __forceinline__ void rw_chunk_task(const Ctx& F, const v4u (&raw)[12], LAS unsigned char* wl, unsigned char* slot) {
    const int lane = opaque_v(F.lane), t = lane & 15, kg = lane >> 4;
    LAS bf16* ATt = (LAS bf16*)(wl); LAS bf16* RBr = (LAS bf16*)(wl + 2048); LAS bf16* BHt = (LAS bf16*)(wl + 4096); LAS bf16* KHt = (LAS bf16*)(wl + 6144); LAS bf16* VTt = (LAS bf16*)(wl + 8192);
    LAS bf16* WAt = (LAS bf16*)(wl + 10240); LAS bf16* N_r = (LAS bf16*)(wl + 12288); LAS bf16* N_c = (LAS bf16*)(wl + 12800); LAS bf16* T_r = (LAS bf16*)(wl + 13312);
    LAS bf16* AK_r = (LAS bf16*)(wl + 13824); LAS bf16* RB2 = (LAS bf16*)(wl + 14336); LAS bf16* RK_r = (LAS bf16*)(wl + 14848); LAS float* GCl = (LAS float*)(wl + 15360);
    bf16x8 fAb[2], fRb[2], fBb[2], fKb[2];
#pragma unroll
    for (int ks = 0; ks < 2; ++ks) {
        const int off = 32 * ks + 8 * kg;
        float ea[8], er[8], eb[8], eh[8];
        { const v4u uld = raw[6 * ks + 0]; float ld[8]; unpack8(uld, ld);
#pragma unroll
          for (int j = 0; j < 8; ++j) { float c = ld[j]; c += dpp_shr(c, 1); c += dpp_shr(c, 2); c += dpp_shr(c, 4); c += dpp_shr(c, 8);
              const float tot = __builtin_bit_cast(float, __builtin_amdgcn_ds_bpermute((lane | 15) << 2, __builtin_bit_cast(int, c)));
              ea[j] = __expf(c - ld[j]); er[j] = __expf(c); eb[j] = __expf(-c); eh[j] = __expf(tot - c);
              if (t == 0) GCl[off + j] = __expf(tot); } }
        { const v4u u = raw[6 * ks + 1]; float x[8]; unpack8(u, x);
#pragma unroll
          for (int j = 0; j < 8; ++j) { x[j] = -x[j] * ea[j]; ATt[(off + j) * 16 + t] = (bf16)f2bf(x[j]); }
          const v4u p = pack8(x); fAb[ks] = __builtin_bit_cast(bf16x8, p); }
        { const v4u u = raw[6 * ks + 2]; float x[8]; unpack8(u, x);
#pragma unroll
          for (int j = 0; j < 8; ++j) x[j] = x[j] * er[j];
          const v4u p = pack8(x); fRb[ks] = __builtin_bit_cast(bf16x8, p); *(LAS v4u*)(RBr + t * 64 + off) = p; }
        { const v4u u = raw[6 * ks + 3]; float x[8], y[8]; unpack8(u, x);
#pragma unroll
          for (int j = 0; j < 8; ++j) { y[j] = x[j] * eb[j]; BHt[(off + j) * 16 + t] = (bf16)f2bf(x[j] * eh[j]); }
          const v4u p = pack8(y); fBb[ks] = __builtin_bit_cast(bf16x8, p); }
        { const v4u u = raw[6 * ks + 4]; float x[8], y[8]; unpack8(u, x);
#pragma unroll
          for (int j = 0; j < 8; ++j) { y[j] = x[j] * eb[j]; KHt[(off + j) * 16 + t] = (bf16)f2bf(x[j] * eh[j]); }
          const v4u p = pack8(y); fKb[ks] = __builtin_bit_cast(bf16x8, p); }
        { const v4u u = raw[6 * ks + 5];
          const bf16 e0 = (bf16)(u.x & 0xffff), e1 = (bf16)(u.x >> 16), e2 = (bf16)(u.y & 0xffff), e3 = (bf16)(u.y >> 16), e4 = (bf16)(u.z & 0xffff), e5 = (bf16)(u.z >> 16), e6 = (bf16)(u.w & 0xffff), e7 = (bf16)(u.w >> 16);
          VTt[(off + 0) * 16 + t] = e0; VTt[(off + 1) * 16 + t] = e1; VTt[(off + 2) * 16 + t] = e2; VTt[(off + 3) * 16 + t] = e3; VTt[(off + 4) * 16 + t] = e4; VTt[(off + 5) * 16 + t] = e5; VTt[(off + 6) * 16 + t] = e6; VTt[(off + 7) * 16 + t] = e7; }
        __builtin_amdgcn_sched_barrier(0);
    }
    asm volatile("" ::: "memory");
    const f32x4 z4 = (f32x4){0.f, 0.f, 0.f, 0.f};
    f32x4 n0 = mma16(fAb[1], fBb[1], mma16(fAb[0], fBb[0], z4)), aak = mma16(fAb[1], fKb[1], mma16(fAb[0], fKb[0], z4));
    f32x4 arb = mma16(fRb[1], fBb[1], mma16(fRb[0], fBb[0], z4)), ark = mma16(fRb[1], fKb[1], mma16(fRb[0], fKb[0], z4));
#pragma unroll
    for (int r = 0; r < 4; ++r) { const int tt = 4 * kg + r; if (!(t < tt)) { n0[r] = 0.f; aak[r] = 0.f; } if (!(t <= tt)) { arb[r] = 0.f; ark[r] = 0.f; } }
    st_rowmaj(AK_r, aak, lane); st_rowmaj(RB2, arb, lane); st_rowmaj(RK_r, ark, lane); asm volatile("" ::: "memory");
    f32x4 accT = n0;
#pragma unroll
    for (int r = 0; r < 4; ++r) accT[r] += (4 * kg + r == t) ? 1.f : 0.f;
    f32x4 nn = n0;
#pragma unroll
    for (int itn = 0; itn < 3; ++itn) {
        st_rowmaj(N_r, nn, lane); st_colmaj(N_c, 0, nn, lane); st_rowmaj(T_r, accT, lane); asm volatile("" ::: "memory");
        const bf16x8 fa = frag16(N_r, 0, lane), fb = frag16(N_c, 0, lane), ft = frag16(T_r, 0, lane);
        nn = mma16(fa, fb, z4); asm volatile("" ::: "memory");
        st_colmaj(N_c, 0, nn, lane); asm volatile("" ::: "memory");
        const bf16x8 fb2 = frag16(N_c, 0, lane);
        accT = mma16(ft, fb2, accT); asm volatile("" ::: "memory");
    }
    st_rowmaj(T_r, accT, lane); asm volatile("" ::: "memory");
    const bf16x8 fT = frag16(T_r, 0, lane), fAK = frag16(AK_r, 0, lane), fARB = frag16(RB2, 0, lane), fARK = frag16(RK_r, 0, lane);
#pragma unroll
    for (int kt = 0; kt < 4; ++kt) { const f32x4 dd = mma16(fT, frag16(ATt, 16 * kt, lane), z4); st_colmaj(WAt, 16 * kt, dd, lane); } asm volatile("" ::: "memory");
    { const bf16x8 fArbT = frag16(RB2, 0, lane);
#pragma unroll
      for (int kt = 0; kt < 4; ++kt) { const v2u ri = *(const LAS v2u*)(RBr + t * 64 + 16 * kt + 4 * kg);
          f32x4 c0 = (f32x4){bflo(ri.x), bfhi(ri.x), bflo(ri.y), bfhi(ri.y)};
          c0 = mma16(frag16(WAt, 16 * kt, lane), fArbT, c0);
          v2u o; o.x = pk2(c0[0], c0[1]); o.y = pk2(c0[2], c0[3]); *(v2u*)(slot + RWS_QY + (t * 64 + 16 * kt + 4 * kg) * 2) = o; } }
    asm volatile("" ::: "memory");
#pragma unroll
    for (int vt = 0; vt < 4; ++vt) { const f32x4 dd = mma16(fAK, frag16(VTt, 16 * vt, lane), z4); st_colmaj(ATt, 16 * vt, dd, lane); } asm volatile("" ::: "memory");
    asm volatile("" ::: "memory");
    LAS bf16* UVt = RBr;
#pragma unroll
    for (int vt = 0; vt < 4; ++vt) { const f32x4 dd = mma16(fT, frag16(ATt, 16 * vt, lane), z4); st_colmaj(UVt, 16 * vt, dd, lane); } asm volatile("" ::: "memory");
#pragma unroll
    for (int vt = 0; vt < 4; ++vt) { const f32x4 dd = mma16(fARK, frag16(VTt, 16 * vt, lane), mma16(fARB, frag16(UVt, 16 * vt, lane), z4));
        v2u o; o.x = pk2(dd[0], dd[1]); o.y = pk2(dd[2], dd[3]); *(v2u*)(slot + RWS_YV + ((16 * vt + t) * 16 + 4 * kg) * 2) = o; }
#pragma unroll
    for (int ktp = 0; ktp < 4; ++ktp) { const bf16x8 fBh = frag16(BHt, 16 * ktp, lane);
#pragma unroll
        for (int kt = 0; kt < 4; ++kt) { f32x4 dd = mma16(frag16(WAt, 16 * kt, lane), fBh, z4);
            if (kt == ktp) {
#pragma unroll
                for (int r = 0; r < 4; ++r) if (4 * kg + r == t) dd[r] += GCl[16 * kt + t]; }
            v2u o; o.x = pk2(dd[0], dd[1]); o.y = pk2(dd[2], dd[3]); *(v2u*)(slot + RWS_PZ + ((16 * ktp + t) * 64 + 16 * kt + 4 * kg) * 2) = o; } }
#pragma unroll
    for (int vt = 0; vt < 4; ++vt) { const bf16x8 fU = frag16(UVt, 16 * vt, lane), fV = frag16(VTt, 16 * vt, lane);
#pragma unroll
        for (int ktp = 0; ktp < 4; ++ktp) { const f32x4 dd = mma16(frag16(KHt, 16 * ktp, lane), fV, mma16(frag16(BHt, 16 * ktp, lane), fU, z4));
            v2u o; o.x = pk2(dd[0], dd[1]); o.y = pk2(dd[2], dd[3]); *(v2u*)(slot + RWS_ZV + ((16 * vt + t) * 64 + 16 * ktp + 4 * kg) * 2) = o; } }
}
__device__ __forceinline__ v2u ld_sc1_8(const void* p) { const unsigned long long v = __hip_atomic_load((const unsigned long long*)p, __ATOMIC_RELAXED, __HIP_MEMORY_SCOPE_AGENT); v2u o; o.x = (unsigned)v; o.y = (unsigned)(v >> 32); return o; }
__device__ __forceinline__ v4u ld_sc1_16(const void* p) { const v2u a = ld_sc1_8(p), b = ld_sc1_8((const char*)p + 8); return (v4u){a.x, a.y, b.x, b.y}; }
__device__ __forceinline__ void rw_chunk_item(const Ctx& F, int l, int it) {
    const auto& a = *F.a; unsigned char* ws = a.ws; const int lane = F.lane, t = lane & 15, kg = lane >> 4;
    const int d = it & 1, h = (it >> 1) & 7, b = it >> 4;
    float* YD = (float*)(ws + WS_YDIR);
    unsigned char* scr = ws + WS_RWSCR + (size_t)F.bid * 16 * RWS_SLOT;
    LAS unsigned char* wl = F.lds + F.wave * 15616;
    LAS bf16* ZL = (LAS bf16*)(F.lds + LDSCTL_OFF + 4096 + (F.wave & 3) * 2048);
    if (F.wave < 4) { for (int i = lane; i < 512; i += 64) ((LAS unsigned*)ZL)[i] = 0u; }
    asm volatile("" ::: "memory");
    constexpr int NCHK = (CTXL + SEQ) / 16, NB = NCHK / 16;
#pragma unroll 1
    for (int bt = 0; bt < NB; ++bt) {
        { v4u cur[12];
#pragma unroll 1
          for (int jj = 0; jj < 2; ++jj) { rw_chunk_load<0, 2>(F, b, h, d, bt * 16 + F.wave + 8 * jj, cur); rw_chunk_task(F, cur, wl, scr + (size_t)(F.wave + 8 * jj) * RWS_SLOT); } }
        asm volatile("s_waitcnt vmcnt(0)" ::: "memory");
        __syncthreads();
        {
            const int t = opaque_v(lane & 15), kg = opaque_v(lane >> 4), vb = opaque(F.wave) & 3;
            const unsigned char* scrb = F.a->ws + WS_RWSCR + (size_t)opaque(F.bid) * 16 * RWS_SLOT;
            LAS unsigned char* sbuf = F.lds;
            const int lt = opaque_v(F.tid) & 255; const bool loader = F.wave >= 4;
            v4u s0[5], s1[5], s2[5], s3[5];
#define RWB_LD(set_, j_) do { if ((j_) < 16) { const v4u* gp_ = (const v4u*)(scrb + (size_t)(j_) * RWS_SLOT) + lt; _Pragma("unroll") for (int q = 0; q < 5; ++q) set_[q] = __builtin_nontemporal_load(gp_ + 256 * q); } } while (0)
#define RWB_ST(set_, bi_) do { LAS v4u* lp_ = (LAS v4u*)(sbuf + (bi_) * RWS_SLOT) + lt; _Pragma("unroll") for (int q = 0; q < 5; ++q) lp_[256 * q] = set_[q]; } while (0)
#define RWB_COMP(bi_, j_) do { const LAS unsigned char* sl_ = sbuf + (bi_) * RWS_SLOT; bf16x8 zb[2], qf[2]; \
                _Pragma("unroll") for (int ks = 0; ks < 2; ++ks) { zb[ks] = *(const LAS bf16x8*)(ZL + t * 64 + 32 * ks + 8 * kg); qf[ks] = *(const LAS bf16x8*)(sl_ + RWS_QY + (t * 64 + 32 * ks + 8 * kg) * 2); } \
                const v2u y_ = *(const LAS v2u*)(sl_ + RWS_YV + ((16 * vb + t) * 16 + 4 * kg) * 2); \
                f32x4 yacc = (f32x4){bflo(y_.x), bfhi(y_.x), bflo(y_.y), bfhi(y_.y)}; \
                yacc = mma16(qf[1], zb[1], mma16(qf[0], zb[0], yacc)); \
                f32x4 zn[4]; \
                _Pragma("unroll") for (int ktp = 0; ktp < 4; ++ktp) { const v2u z_ = *(const LAS v2u*)(sl_ + RWS_ZV + ((16 * vb + t) * 64 + 16 * ktp + 4 * kg) * 2); \
                    f32x4 zc = (f32x4){bflo(z_.x), bfhi(z_.x), bflo(z_.y), bfhi(z_.y)}; \
                    _Pragma("unroll") for (int ks = 0; ks < 2; ++ks) zc = mma16(*(const LAS bf16x8*)(sl_ + RWS_PZ + ((16 * ktp + t) * 64 + 32 * ks + 8 * kg) * 2), zb[ks], zc); \
                    zn[ktp] = zc; } \
                _Pragma("unroll") for (int r = 0; r < 4; ++r) { const int row = seq_row(b, d, (bt * 16 + (j_)) * 16 + 4 * kg + r); YD[((size_t)d * T_ALL + row) * 512 + h * 64 + 16 * vb + t] = yacc[r]; } \
                asm volatile("s_waitcnt lgkmcnt(0)" ::: "memory"); \
                _Pragma("unroll") for (int ktp = 0; ktp < 4; ++ktp) { v2u o; o.x = pk2(zn[ktp][0], zn[ktp][1]); o.y = pk2(zn[ktp][2], zn[ktp][3]); *(LAS v2u*)(ZL + t * 64 + 16 * ktp + 4 * kg) = o; } \
                asm volatile("s_waitcnt lgkmcnt(0)" ::: "memory"); } while (0)
            if (loader) { RWB_LD(s0, 0); RWB_ST(s0, 0); RWB_LD(s1, 1); RWB_LD(s2, 2); RWB_LD(s3, 3); RWB_LD(s0, 4); }
            __syncthreads();
#pragma unroll 1
            for (int j = 0; j < 16; j += 4) {
                if (loader) { RWB_ST(s1, 1); RWB_LD(s1, j + 5); } else { RWB_COMP(0, j); }
                __syncthreads();
                if (loader) { RWB_ST(s2, 0); RWB_LD(s2, j + 6); } else { RWB_COMP(1, j + 1); }
                __syncthreads();
                if (loader) { RWB_ST(s3, 1); RWB_LD(s3, j + 7); } else { RWB_COMP(0, j + 2); }
                __syncthreads();
                if (loader) { if (j + 4 < 16) RWB_ST(s0, 0); RWB_LD(s0, j + 8); } else { RWB_COMP(1, j + 3); }
                __syncthreads();
            }
#undef RWB_LD
#undef RWB_ST
#undef RWB_COMP
        }
        __syncthreads();
    }
}

__device__ __forceinline__ void stage_rw_readout(const Ctx& F, int l) {
    const auto& a = *F.a; unsigned char* ws = a.ws; const int lane = F.lane;
    const bf16* SCN = (const bf16*)(ws + WS_SCN); const bf16* P = (const bf16*)(ws + WS_P); const float* YD = (const float*)(ws + WS_YDIR); bf16* YRW = (bf16*)(ws + WS_YRW);
    const int gw = F.bid * NWAVES + F.wave, NGW = F.G * NWAVES;
    constexpr int TR = 17, NRT = T_ALL / TR;
    for (int tile = gw; tile < NRT * 4; tile += NGW) {
        const int rt = tile % NRT, hp = tile / NRT, row0 = rt * TR, c0 = hp * 128 + 2 * lane;
        const f32x2 rk = *(const f32x2*)(a.in[I_RWRK] + l * 512 + c0), lng = *(const f32x2*)(a.in[I_RWLNG] + l * 512 + c0), lnb = *(const f32x2*)(a.in[I_RWLNB] + l * 512 + c0);
#pragma unroll 4
        for (int i = 0; i < TR; ++i) {
            const int row = row0 + i;
            const unsigned* sp = (const unsigned*)(SCN + (size_t)row * 9 * 512 + c0);
            const unsigned ru = sp[0], vu = sp[256], k0u = sp[4 * 256], k1u = sp[7 * 256];
            const f32x2 y0 = *(const f32x2*)(YD + (size_t)row * 512 + c0), y1 = *(const f32x2*)(YD + ((size_t)T_ALL + row) * 512 + c0);
            const unsigned gu = *(const unsigned*)(P + (size_t)row * 2560 + 2048 + c0);
            const float bon = red32(bflo(ru) * (bflo(k0u) + bflo(k1u)) * rk[0] + bfhi(ru) * (bfhi(k0u) + bfhi(k1u)) * rk[1]);
            f32x2 y = y0 + y1 + (f32x2){bflo(vu), bfhi(vu)} * bon;
            const float mu = red32(y[0] + y[1]) * (1.f / 64.f);
            y = y - mu;
            const float var = red32(y[0] * y[0] + y[1] * y[1]) * (1.f / 64.f);
            const f32x2 yn = y * (1.0f / sqrtf(var + 64e-5f));
            const f32x2 ov = (yn * lng + lnb) * (f32x2){bflo(gu), bfhi(gu)};
            *(unsigned*)(YRW + (size_t)row * 512 + c0) = pk2(ov[0], ov[1]);
        }
    }
}

constexpr size_t WS_S5E = 6 * MiB;
constexpr int S5_NSEG = 4, S5_SEGLEN = (CTXL + SEQ) / S5_NSEG;
__device__ __forceinline__ void s5_disc(const float are, const float aim, const float dt, float& lbr, float& lbi, float& cr, float& ci) {
    const float mag = expf(are * dt); lbr = mag * cosf(aim * dt); lbi = mag * sinf(aim * dt);
    const float den = are * are + aim * aim, nr = lbr - 1.0f; cr = (nr * are + lbi * aim) / den; ci = (lbi * are - nr * aim) / den;
}
template <int PASS>
__device__ __forceinline__ void stage_s5_scan(const Ctx& F, int l) {
    const auto& a = *F.a; unsigned char* ws = a.ws; const int lane = F.lane;
    const bf16* Z = (const bf16*)(ws + WS_Z); float* YP = (float*)(ws + WS_YP); f32x2* S5E = (f32x2*)(ws + WS_S5E);
    LAS unsigned char* wl = F.lds + F.wave * 16384;
    LAS float* buL = (LAS float*)wl;
    LAS bf16* Hs = (LAS bf16*)(wl + 8704);
    const int fr = lane & 15, kg = lane >> 4;
    for (int itx = F.bid * NWAVES + F.wave; itx < BATCH * 32 * 2 * S5_NSEG; itx += NWAVES * F.G) {
        const int seg = itx & (S5_NSEG - 1), it = itx >> 2;
        const int d = it & 1, g = (it >> 1) & 31, b = it >> 6, p = lane;
        const float dt = expf(a.in[I_S5LDT][(l * 2 + d) * 32 + g]);
        const float* arep = a.in[I_S5ARE] + ((size_t)(l * 2 + d) * 32 + g) * 64; const float* aimp = a.in[I_S5AIM] + ((size_t)(l * 2 + d) * 32 + g) * 64;
        float lbr, lbi, cr_, ci_; s5_disc(arep[p], aimp[p], dt, lbr, lbi, cr_, ci_);
        bf16x8 afr[2][4];
#pragma unroll
        for (int tl = 0; tl < 4; ++tl) { const int pp = 16 * tl + fr; float r0_, r1_, cr, ci; s5_disc(arep[pp], aimp[pp], dt, r0_, r1_, cr, ci);
            v4u pr = (v4u){0u, 0u, 0u, 0u}, pi = (v4u){0u, 0u, 0u, 0u};
            if (kg < 2) { const float* br = a.in[I_S5BRE] + (((size_t)l * 32 + g) * 64 + pp) * 16 + 8 * kg; const float* bi = a.in[I_S5BIM] + (((size_t)l * 32 + g) * 64 + pp) * 16 + 8 * kg;
                const f32x4 x0 = *(const f32x4*)br, x1 = *(const f32x4*)(br + 4), y0 = *(const f32x4*)bi, y1 = *(const f32x4*)(bi + 4);
                pr.x = pk2(cr * x0[0] - ci * y0[0], cr * x0[1] - ci * y0[1]); pr.y = pk2(cr * x0[2] - ci * y0[2], cr * x0[3] - ci * y0[3]);
                pr.z = pk2(cr * x1[0] - ci * y1[0], cr * x1[1] - ci * y1[1]); pr.w = pk2(cr * x1[2] - ci * y1[2], cr * x1[3] - ci * y1[3]);
                pi.x = pk2(cr * y0[0] + ci * x0[0], cr * y0[1] + ci * x0[1]); pi.y = pk2(cr * y0[2] + ci * x0[2], cr * y0[3] + ci * x0[3]);
                pi.z = pk2(cr * y1[0] + ci * x1[0], cr * y1[1] + ci * x1[1]); pi.w = pk2(cr * y1[2] + ci * x1[2], cr * y1[3] + ci * x1[3]); }
            afr[0][tl] = __builtin_bit_cast(bf16x8, pr); afr[1][tl] = __builtin_bit_cast(bf16x8, pi); }
        bf16x8 cf[4];
        f32x2 hst = (f32x2){0.f, 0.f};
        if (PASS == 1) {
#pragma unroll
            for (int kk = 0; kk < 4; ++kk) { const int p0 = 16 * kk + 4 * kg;
                const f32x4 c0 = *(const f32x4*)(a.in[I_S5CRE] + (((size_t)l * 32 + g) * 16 + fr) * 64 + p0), c1 = *(const f32x4*)(a.in[I_S5CIM] + (((size_t)l * 32 + g) * 16 + fr) * 64 + p0);
                v4u pk; pk.x = pk2(c0[0], -c1[0]); pk.y = pk2(c0[1], -c1[1]); pk.z = pk2(c0[2], -c1[2]); pk.w = pk2(c0[3], -c1[3]);
                cf[kk] = __builtin_bit_cast(bf16x8, pk); }
            float pr_ = lbr, pi_ = lbi, l64r = 1.f, l64i = 0.f;
#pragma unroll 1
            for (int q = 0; q < 10; ++q) { const float nr2 = pr_ * pr_ - pi_ * pi_, ni2 = 2.f * pr_ * pi_; pr_ = nr2; pi_ = ni2; if (q == 5) { l64r = pr_; l64i = pi_; } }
            const float lLr = pr_ * l64r - pi_ * l64i, lLi = pr_ * l64i + pi_ * l64r;
#pragma unroll 1
            for (int sgi = 0; sgi < seg; ++sgi) { const f32x2 ev = S5E[((size_t)it * S5_NSEG + sgi) * 64 + p];
                hst = (f32x2){lLr * hst[0] - lLi * hst[1] + ev[0], lLr * hst[1] + lLi * hst[0] + ev[1]}; }
        }
        const f32x2 lbr2 = (f32x2){lbr, lbr}, lbi2 = (f32x2){lbi, lbi};
        const int sbeg = seg * S5_SEGLEN, send = sbeg + S5_SEGLEN;
        v4u un = (v4u){0u, 0u, 0u, 0u}, uc;
#define S5_LOADU(s0_) do { if (kg < 2) { const int row_ = seq_row(b, d, (s0_) + fr); un = *(const v4u*)(Z + (size_t)row_ * IN_COLS + S5_OFF + g * 16 + kg * 8); } } while (0)
        S5_LOADU(sbeg);
#pragma unroll 1
        for (int s0 = sbeg; s0 < send; s0 += 16) {
            uc = un;
            if (s0 + 16 < send) S5_LOADU(s0 + 16);
            const bf16x8 ufr = __builtin_bit_cast(bf16x8, uc);
#pragma unroll
            for (int c = 0; c < 2; ++c)
#pragma unroll
                for (int tl = 0; tl < 4; ++tl) { const f32x4 dd = __builtin_amdgcn_mfma_f32_16x16x32_bf16(afr[c][tl], ufr, (f32x4){0.f, 0.f, 0.f, 0.f}, 0, 0, 0);
                    *(LAS f32x4*)(buL + (c * 16 + fr) * 68 + 16 * tl + 4 * kg) = dd; }
            LDS_WAIT(); asm volatile("" ::: "memory");
            f32x2 bu[16];
#pragma unroll
            for (int s = 0; s < 16; ++s) bu[s] = (f32x2){buL[s * 68 + p], buL[(16 + s) * 68 + p]};
#pragma unroll
            for (int s = 0; s < 16; ++s) {
                const f32x2 sw = (f32x2){-hst[1], hst[0]};
                hst = lbr2 * hst + (lbi2 * sw + bu[s]);
                if (PASS == 1) *(LAS unsigned*)(Hs + s * 136 + 2 * p) = pg8::cvt_pk_bf16(hst[0], hst[1]);
            }
            if (PASS == 1) {
                LDS_WAIT(); asm volatile("" ::: "memory");
                f32x4 acc = (f32x4){0.f, 0.f, 0.f, 0.f};
#pragma unroll
                for (int kk = 0; kk < 4; ++kk) { const bf16x8 af = *(const LAS bf16x8*)(Hs + fr * 136 + 32 * kk + 8 * kg); acc = __builtin_amdgcn_mfma_f32_16x16x32_bf16(af, cf[kk], acc, 0, 0, 0); }
#pragma unroll
                for (int r = 0; r < 4; ++r) { const int row = seq_row(b, d, s0 + 4 * kg + r); YP[((size_t)d * T_ALL + row) * 512 + g * 16 + fr] = acc[r]; }
            }
            LDS_WAIT(); asm volatile("" ::: "memory");
        }
        if (PASS == 0) S5E[((size_t)it * S5_NSEG + seg) * 64 + p] = hst;
#undef S5_LOADU
    }
}

__device__ __forceinline__ void stage_s5_prep(const Ctx& F, int l) {
    const auto& a = *F.a; unsigned char* ws = a.ws;
    const bf16* Z = (const bf16*)(ws + WS_Z); const float* YP = (const float*)(ws + WS_YP); bf16* AS5 = (bf16*)(ws + WS_AS5);
    const float dsk = a.in[I_S5D][l * 512 + F.tid];
    for (int row = F.bid; row < T_ALL; row += F.G) {
        const int c = F.tid;
        const float u = bf2f(Z[(size_t)row * IN_COLS + S5_OFF + c]);
        const float y = YP[(size_t)row * 512 + c] + YP[((size_t)T_ALL + row) * 512 + c] + u * dsk;
        const float ge = 0.5f * y * (1.f + tanhf(0.7978845608028654f * (y + 0.044715f * y * y * y)));
        AS5[(size_t)row * 512 + c] = (bf16)f2bf(ge);
    }
}

__device__ __forceinline__ void stage_hy_pre(const Ctx& F, int l) {
    const auto& a = *F.a; unsigned char* ws = a.ws; const int lane = F.lane;
    const bf16* Z = (const bf16*)(ws + WS_Z); bf16* UT = (bf16*)(ws + WS_UT);
    LAS bf16* tl = (LAS bf16*)(F.lds + F.wave * 16384);
    const float* cw = a.in[I_HYCW] + (size_t)l * 3 * 1536; const float* cbp = a.in[I_HYCB] + l * 1536;
    const int gw = F.bid * NWAVES + F.wave, NGW = F.G * NWAVES;
    for (int tile = gw; tile < (T_ALL / 64) * 24; tile += NGW) {
        const int rt = tile / 24, ct = tile % 24, row0 = rt * 64, col = ct * 64 + lane;
        int base, pos0, n; row_seq(row0, base, pos0, n);
        const bf16* zc = Z + (size_t)base * IN_COLS + HY_OFF + col;
        const float w0 = cw[col], w1 = cw[1536 + col], w2 = cw[2 * 1536 + col], cb = cbp[col];
        float zm = pos0 > 0 ? bf2f(zc[(size_t)(pos0 - 1) * IN_COLS]) : 0.f, z0 = bf2f(zc[(size_t)pos0 * IN_COLS]);
#pragma unroll 8
        for (int r = 0; r < 64; ++r) { const float zp = (pos0 + r + 1 < n) ? bf2f(zc[(size_t)(pos0 + r + 1) * IN_COLS]) : 0.f;
            tl[lane * 66 + r] = (bf16)f2bf(w0 * zm + w1 * z0 + w2 * zp + cb); zm = z0; z0 = zp; }
        LDS_WAIT(); asm volatile("" ::: "memory");
        bf16* up = UT + (size_t)(ct * 64) * T_ALL + row0 + lane;
#pragma unroll 8
        for (int cc = 0; cc < 64; ++cc) up[(size_t)cc * T_ALL] = tl[cc * 66 + lane];
        LDS_WAIT(); asm volatile("" ::: "memory");
    }
}
__device__ __forceinline__ void stage_hy_post(const Ctx& F, int l) {
    const auto& a = *F.a; unsigned char* ws = a.ws; const int lane = F.lane;
    const bf16* YT = (const bf16*)(ws + WS_UT) + (size_t)1024 * T_ALL; bf16* YHY = (bf16*)(ws + WS_YHY);
    LAS bf16* tl = (LAS bf16*)(F.lds + F.wave * 8448);
    const int gw = F.bid * NWAVES + F.wave, NGW = F.G * NWAVES;
    for (int tile = gw; tile < (T_ALL / 64) * 8; tile += NGW) {
        const int rt = tile >> 3, ct = tile & 7, row0 = rt * 64, c0 = ct * 64;
        const bf16* yp = YT + (size_t)c0 * T_ALL + row0 + lane;
#pragma unroll 8
        for (int cc = 0; cc < 64; ++cc) tl[cc * 66 + lane] = yp[(size_t)cc * T_ALL];
        LDS_WAIT(); asm volatile("" ::: "memory");
        bf16* op = YHY + (size_t)row0 * 512 + c0 + lane;
#pragma unroll 8
        for (int r = 0; r < 64; ++r) op[(size_t)r * 512] = tl[lane * 66 + r];
        LDS_WAIT(); asm volatile("" ::: "memory");
    }
}
typedef float f32x16 __attribute__((ext_vector_type(16)));
__device__ __forceinline__ void hyena_item(const Ctx& F, int l, int c, int isctx) {
    const auto& a = *F.a; unsigned char* ws = a.ws; const int tid = F.tid, lane = F.lane;
    const int n = isctx ? CTXL : SEQ, rowbase = isctx ? T_LAT : 0, RL = isctx ? HY_RLENC : HY_RLEN, off = n + 47;
    const bf16* UT = (const bf16*)(ws + WS_UT);
    const bf16* x1g = UT + (size_t)c * T_ALL + rowbase; const bf16* x2g = UT + (size_t)(512 + c) * T_ALL + rowbase; bf16* vg = (bf16*)UT + (size_t)(1024 + c) * T_ALL + rowbase;
    const bf16* Rg = (const bf16*)(ws + WS_GF + l * GF_STRIDE + (isctx ? GF_CTX : 0)) + (size_t)c * RL;
    LAS unsigned char* XB = F.lds; LAS unsigned char* R1 = F.lds + HY_R1_OFF; LAS unsigned char* R2 = F.lds + HY_R2_OFF;
    { const int cpb = n / 8;
      for (int q = tid; q < 8 * cpb; q += NTHREADS) { const int b = q / cpb, ch = q % cpb; *(LAS v4u*)(XB + b * HY_ROWB + 2 * HY_MARG + 16 * ch) = *(const v4u*)(vg + (size_t)b * n + 8 * ch); }
      if (tid < 256) { const int b = tid >> 5, side = (tid >> 4) & 1, ch = tid & 15; *(LAS v4u*)(XB + b * HY_ROWB + (side ? 2 * (HY_MARG + n) : 0) + 16 * ch) = (v4u){0u, 0u, 0u, 0u}; }
      const int rch = RL / 8;
      for (int q = tid; q < rch; q += NTHREADS) { *(LAS v4u*)(R1 + 16 * q) = *(const v4u*)(Rg + 8 * q); *(LAS v4u*)(R2 + 16 * q) = *(const v4u*)(Rg + (size_t)512 * RL + 8 * q); } }
    __syncthreads();
    const int i = lane & 31, kg = lane >> 5, jb = lane & 3, bb = (lane & 31) >> 2;
    const int rsh = (off - i) & 7, rd = rsh >> 1; const bool s1 = rd & 1, s2 = rd & 2; const unsigned sh = (rsh & 1) ? 16u : 0u;
    const int aconst = 2 * (off - i + 8 * kg - rsh), bconst = bb * HY_ROWB + 2 * (HY_MARG + 32 * jb + 8 * kg);
    const int T0w = 512 * F.wave; const int ntile = (n - T0w) >= 512 ? 4 : ((n - T0w) > 0 ? (n - T0w) / 128 : 0);
    const float bias0 = a.in[I_HYBIAS][(l * 2 + 0) * 512 + c], bias1 = a.in[I_HYBIAS][(l * 2 + 1) * 512 + c];
    f32x16 acc[4];
    v2u y1p[4][4];
#define HY_AFRAG(wa, wb, afr) do { \
        const unsigned a0 = s1 ? wa.y : wa.x, a1 = s1 ? wa.z : wa.y, a2 = s1 ? wa.w : wa.z, a3 = s1 ? wb.x : wa.w, a4 = s1 ? wb.y : wb.x, a5 = s1 ? wb.z : wb.y, a6 = s1 ? wb.w : wb.z; \
        const unsigned b0 = s2 ? a2 : a0, b1 = s2 ? a3 : a1, b2 = s2 ? a4 : a2, b3 = s2 ? a5 : a3, b4 = s2 ? a6 : a4; \
        v4u af_; af_.x = __builtin_amdgcn_alignbit(b1, b0, sh); af_.y = __builtin_amdgcn_alignbit(b2, b1, sh); af_.z = __builtin_amdgcn_alignbit(b3, b2, sh); af_.w = __builtin_amdgcn_alignbit(b4, b3, sh); \
        afr = __builtin_bit_cast(bf16x8, af_); } while (0)
#define HY_STEP_COND(RB, d) do { \
        const v4u wa = *(const LAS v4u*)((RB) + aconst - 2 * (d)), wb = *(const LAS v4u*)((RB) + aconst - 2 * (d) + 16); bf16x8 afr; HY_AFRAG(wa, wb, afr); \
        _Pragma("unroll") for (int m = 0; m < 4; ++m) { const int T0 = T0w + 128 * m; \
            if (m < ntile && (d) >= T0 - n + 16 && (d) <= T0 + 96) { const bf16x8 bfr = *(const LAS bf16x8*)(XB + bconst + 2 * (T0 - (d))); \
                acc[m] = __builtin_amdgcn_mfma_f32_32x32x16_bf16(afr, bfr, acc[m], 0, 0, 0); } } } while (0)
#define HY_LOAD(RB, d, wa, wb, bq) do { wa = *(const LAS v4u*)((RB) + aconst - 2 * (d)); wb = *(const LAS v4u*)((RB) + aconst - 2 * (d) + 16); \
        _Pragma("unroll") for (int m = 0; m < 4; ++m) bq[m] = *(const LAS bf16x8*)(XB + bconst + 2 * (T0w + 128 * m - (d))); } while (0)
#define HY_MMA(wa, wb, bq) do { bf16x8 afr; HY_AFRAG(wa, wb, afr); \
        _Pragma("unroll") for (int m = 0; m < 4; ++m) acc[m] = __builtin_amdgcn_mfma_f32_32x32x16_bf16(afr, bq[m], acc[m], 0, 0, 0); } while (0)
#define HY_CONV(RB) do { \
        _Pragma("unroll") for (int m = 0; m < 4; ++m) _Pragma("unroll") for (int e = 0; e < 16; ++e) acc[m][e] = 0.f; \
        if (ntile == 4) { \
            const int dA = T0w - n + 16, dB = T0w + 384 - n + 16, dC = T0w + 96, dD = T0w + 384 + 96;     \
            _Pragma("unroll 1") for (int d = dA; d < dB; d += 16) HY_STEP_COND(RB, d); \
            { v4u waA, wbA, waB, wbB; bf16x8 bqA[4], bqB[4]; \
              HY_LOAD(RB, dB, waA, wbA, bqA); \
              _Pragma("unroll 1") for (int d = dB; d <= dC; d += 32) { \
                  if (d + 16 <= dC) HY_LOAD(RB, d + 16, waB, wbB, bqB); \
                  __builtin_amdgcn_sched_barrier(0); \
                  HY_MMA(waA, wbA, bqA); \
                  __builtin_amdgcn_sched_barrier(0); \
                  if (d + 32 <= dC) HY_LOAD(RB, d + 32, waA, wbA, bqA); \
                  __builtin_amdgcn_sched_barrier(0); \
                  if (d + 16 <= dC) HY_MMA(waB, wbB, bqB); \
                  __builtin_amdgcn_sched_barrier(0); } } \
            _Pragma("unroll 1") for (int d = dC + 16; d <= dD; d += 16) HY_STEP_COND(RB, d); \
        } else if (ntile > 0) { const int dhi = T0w + 128 * (ntile - 1) + 96; \
            _Pragma("unroll 1") for (int d = T0w - n + 16; d <= dhi; d += 16) HY_STEP_COND(RB, d); } } while (0)
    HY_CONV(R1);
#pragma unroll
    for (int m = 0; m < 4; ++m) if (m < ntile) {
#pragma unroll
        for (int rg = 0; rg < 4; ++rg) { const int t4 = T0w + 128 * m + 32 * jb + 8 * rg + 4 * kg;
            const v2u xv = *(const v2u*)(x1g + (size_t)bb * n + t4); const v2u vv = *(const LAS v2u*)(XB + bb * HY_ROWB + 2 * (HY_MARG + t4));
            const float y0 = bflo(xv.x) * (acc[m][4 * rg + 0] + bias0 * bflo(vv.x)), y1 = bfhi(xv.x) * (acc[m][4 * rg + 1] + bias0 * bfhi(vv.x));
            const float y2 = bflo(xv.y) * (acc[m][4 * rg + 2] + bias0 * bflo(vv.y)), y3 = bfhi(xv.y) * (acc[m][4 * rg + 3] + bias0 * bfhi(vv.y));
            y1p[m][rg].x = pk2(y0, y1); y1p[m][rg].y = pk2(y2, y3); } }
    __syncthreads();
#pragma unroll
    for (int m = 0; m < 4; ++m) if (m < ntile) {
#pragma unroll
        for (int rg = 0; rg < 4; ++rg) { const int t4 = T0w + 128 * m + 32 * jb + 8 * rg + 4 * kg; *(LAS v2u*)(XB + bb * HY_ROWB + 2 * (HY_MARG + t4)) = y1p[m][rg]; } }
    __syncthreads();
    HY_CONV(R2);
#pragma unroll
    for (int m = 0; m < 4; ++m) if (m < ntile) {
#pragma unroll
        for (int rg = 0; rg < 4; ++rg) { const int t4 = T0w + 128 * m + 32 * jb + 8 * rg + 4 * kg;
            const v2u xv = *(const v2u*)(x2g + (size_t)bb * n + t4); const v2u yv = y1p[m][rg];
            const float o0 = bflo(xv.x) * (acc[m][4 * rg + 0] + bias1 * bflo(yv.x)), o1 = bfhi(xv.x) * (acc[m][4 * rg + 1] + bias1 * bfhi(yv.x));
            const float o2 = bflo(xv.y) * (acc[m][4 * rg + 2] + bias1 * bflo(yv.y)), o3 = bfhi(xv.y) * (acc[m][4 * rg + 3] + bias1 * bfhi(yv.y));
            v2u ov; ov.x = pk2(o0, o1); ov.y = pk2(o2, o3); *(v2u*)(vg + (size_t)bb * n + t4) = ov; } }
    __syncthreads();
#undef HY_CONV
#undef HY_AFRAG
#undef HY_STEP_COND
#undef HY_LOAD
#undef HY_MMA
}
__device__ __forceinline__ void stage_mixer(const Ctx& F, int l) {
    unsigned* ctr = (unsigned*)(F.a->ws + WS_CTL) + CW_WORK + 64 * l;
    LAS int* itb = (LAS int*)(F.lds + LDSCTL_OFF + 512);
    const int nit = 128 + 512 + (l == 0 ? 512 : 0);
#ifdef PROBE_STATIC
    return;
#endif
    for (;;) {
        if (F.tid == 0) *itb = (int)__hip_atomic_fetch_add(ctr, 1u, __ATOMIC_RELAXED, __HIP_MEMORY_SCOPE_AGENT);
        __syncthreads();
        const int it = *itb;
        __syncthreads();
        if (it >= nit) break;
        Ctx Fi; Fi.a = kargs(); Fi.tid = opaque_v((int)threadIdx.x); Fi.lane = Fi.tid & 63; Fi.wave = __builtin_amdgcn_readfirstlane(Fi.tid >> 6); Fi.bid = opaque((int)blockIdx.x); Fi.G = opaque((int)gridDim.x);
        Fi.lds = (LAS unsigned char*)((LAS unsigned char*)0 + opaque(0)) + (F.lds - (LAS unsigned char*)0);
#ifdef PROBE_T
        if (l == 0 && F.tid == 0 && it == 5) ((unsigned long long*)(F.a->ws + WS_CTL + CW_STAMP * 4))[21] = __builtin_amdgcn_s_memrealtime();
        if (l == 0 && F.tid == 0 && it == 300) ((unsigned long long*)(F.a->ws + WS_CTL + CW_STAMP * 4))[23] = __builtin_amdgcn_s_memrealtime();
#endif
        if (it < 128) { for (int rep = 0; rep < ((DUPK == 9) ? 2 : 1); ++rep) rw_chunk_item(Fi, opaque(l), it); }
        else if (it < 640) hyena_item(Fi, opaque(l), it - 128, 0);
        else hyena_item(Fi, opaque(l), it - 640, 1);
#ifdef PROBE_T
        if (l == 0 && F.tid == 0 && it == 5) ((unsigned long long*)(F.a->ws + WS_CTL + CW_STAMP * 4))[22] = __builtin_amdgcn_s_memrealtime();
        if (l == 0 && F.tid == 0 && it == 300) ((unsigned long long*)(F.a->ws + WS_CTL + CW_STAMP * 4))[24] = __builtin_amdgcn_s_memrealtime();
#endif
    }
}

typedef float f32x16r __attribute__((ext_vector_type(16)));
__device__ __forceinline__ void stage_norm2_router(const Ctx& F, int l) {
    const auto& a = *F.a; unsigned char* ws = a.ws; const int lane = F.lane;
    const float* X = (const float*)(ws + WS_X); bf16* H = (bf16*)(ws + WS_H); const float* MOD = (const float*)(ws + WS_MOD);
    int* EIDX = (int*)(ws + WS_EIDX); float* GATE = (float*)(ws + WS_GATE); int* BLKCNT = (int*)(ws + WS_BLKCNT);
    LAS float* lg = (LAS float*)(F.lds + F.wave * 4352);
    LAS int* hist = (LAS int*)(F.lds + LDSCTL_OFF + 1024);
    if (F.tid < 32) hist[F.tid] = 0;
    __syncthreads();
    const int rpb = (T_ALL + F.G - 1) / F.G, r0 = F.bid * rpb, r1 = (r0 + rpb < T_ALL) ? r0 + rpb : T_ALL;
    const float* rw = a.in[I_RTW] + (size_t)l * 1024 * 32;
    const int i = lane & 31, kk = lane >> 5;
    const f32x4* ng = (const f32x4*)(a.in[I_N2G] + l * D) + kk;
    for (int rb = r0 + F.wave * 32; rb < r1; rb += NWAVES * 32) {
        const int nrow = (r1 - rb) < 32 ? (r1 - rb) : 32; const bool live = i < nrow;
        const int row = live ? rb + i : r1 - 1; const int w = row < T_LAT ? (row >> 12) : 8;
        const f32x4* xr = (const f32x4*)(X + (size_t)row * D) + kk;
        float ss = 0.f;
#pragma unroll 8
        for (int q = 0; q < 128; ++q) { const f32x4 v = xr[2 * q]; ss += (v[0] * v[0] + v[1] * v[1]) + (v[2] * v[2] + v[3] * v[3]); }
        ss += __builtin_bit_cast(float, __builtin_amdgcn_ds_bpermute((lane ^ 32) << 2, __builtin_bit_cast(int, ss)));
        const float rstd = 1.0f / sqrtf(ss * (1.f / D) + 1e-6f);
        const f32x4* sh = (const f32x4*)(MOD + (size_t)(l * 9 + w) * 6144 + 3072) + kk; const f32x4* sc = (const f32x4*)(MOD + (size_t)(l * 9 + w) * 6144 + 4096) + kk;
        v2u* ho = (v2u*)(H + (size_t)row * D) + kk;
        f32x16r acc;
#pragma unroll
        for (int e = 0; e < 16; ++e) acc[e] = 0.f;
        const float* wp = rw + (size_t)(4 * kk) * 32 + i;
#pragma unroll 2
        for (int q = 0; q < 128; ++q) {
            const f32x4 xv = xr[2 * q]; const f32x4 h4 = xv * rstd * ng[2 * q] * (sc[2 * q] + 1.0f) + sh[2 * q];
            const float w0 = wp[(size_t)(8 * q) * 32], w1 = wp[(size_t)(8 * q + 1) * 32], w2 = wp[(size_t)(8 * q + 2) * 32], w3 = wp[(size_t)(8 * q + 3) * 32];
            if (live) { v2u o; o.x = pk2(h4[0], h4[1]); o.y = pk2(h4[2], h4[3]); ho[2 * q] = o; }
            acc = __builtin_amdgcn_mfma_f32_32x32x2f32(h4[0], w0, acc, 0, 0, 0);
            acc = __builtin_amdgcn_mfma_f32_32x32x2f32(h4[1], w1, acc, 0, 0, 0);
            acc = __builtin_amdgcn_mfma_f32_32x32x2f32(h4[2], w2, acc, 0, 0, 0);
            acc = __builtin_amdgcn_mfma_f32_32x32x2f32(h4[3], w3, acc, 0, 0, 0);
        }
        const float rbias = a.in[I_RTB][l * 32 + i];
#pragma unroll
        for (int r = 0; r < 16; ++r) { const int ri = (r & 3) + 8 * (r >> 2) + 4 * kk; lg[ri * 33 + i] = acc[r] + rbias; }
        LDS_WAIT(); asm volatile("" ::: "memory");
        if (lane < nrow) {
            LAS float* lr = lg + lane * 33; const int orow = rb + lane;
            float tv[4]; int ti[4];
#pragma unroll
            for (int r = 0; r < 4; ++r) { float bv = -INFINITY; int bi = 0;
#pragma unroll 8
                for (int e = 0; e < 32; ++e) { const float v = lr[e]; if (v > bv) { bv = v; bi = e; } }
                tv[r] = bv; ti[r] = bi; lr[bi] = -INFINITY; }
            const float e1 = expf(tv[1] - tv[0]), e2 = expf(tv[2] - tv[0]), e3 = expf(tv[3] - tv[0]); const float inv = 1.0f / (1.0f + e1 + e2 + e3);
            *(int4*)(EIDX + orow * 4) = make_int4(ti[0], ti[1], ti[2], ti[3]); *(f32x4*)(GATE + orow * 4) = (f32x4){inv, e1 * inv, e2 * inv, e3 * inv};
#pragma unroll
            for (int r = 0; r < 4; ++r) __hip_atomic_fetch_add(&hist[ti[r]], 1, __ATOMIC_RELAXED, __HIP_MEMORY_SCOPE_WORKGROUP);
        }
        LDS_WAIT(); asm volatile("" ::: "memory");
    }
    __syncthreads();
    if (F.tid < 32) BLKCNT[F.bid * 32 + F.tid] = hist[F.tid];
    __syncthreads();
}

__device__ __forceinline__ void stage_moe_scatter(const Ctx& F, int l) {
    const auto& a = *F.a; unsigned char* ws = a.ws; const int lane = F.lane;
    const bf16* H = (const bf16*)(ws + WS_H); bf16* XS = (bf16*)(ws + WS_XS);
    const int* EIDX = (const int*)(ws + WS_EIDX); int* POS = (int*)(ws + WS_POS); const int* BLKCNT = (const int*)(ws + WS_BLKCNT); int* META = (int*)(ws + WS_META);
    LAS int* tot = (LAS int*)F.lds; LAS int* off = tot + 32; LAS int* base = tot + 64; LAS int* posl = tot + 128; LAS int* eloc = tot + 4096;
    const int rpb = (T_ALL + F.G - 1) / F.G, r0 = F.bid * rpb, r1 = (r0 + rpb < T_ALL) ? r0 + rpb : T_ALL; const int na = (r1 > r0) ? (r1 - r0) * 4 : 0;
    for (int i = F.tid; i < na; i += NTHREADS) eloc[i] = EIDX[r0 * 4 + i];
    { LAS int* part = tot + 8192; const int e = F.tid & 31, pt = F.tid >> 5; int t = 0, o = 0;
      for (int b2 = pt; b2 < F.G; b2 += 16) { const int c = BLKCNT[b2 * 32 + e]; t += c; o += (b2 < F.bid) ? c : 0; }
      part[pt * 32 + e] = t; part[512 + pt * 32 + e] = o; }
    __syncthreads();
    if (F.tid < 32) { LAS int* part = tot + 8192; int t = 0, o = 0;
#pragma unroll
        for (int pt = 0; pt < 16; ++pt) { t += part[pt * 32 + F.tid]; o += part[512 + pt * 32 + F.tid]; }
        tot[F.tid] = t; off[F.tid] = o; }
    __syncthreads();
    if (F.tid == 0) { int acc = 0; for (int e = 0; e < 32; ++e) { base[e] = acc; acc += (tot[e] + 255) & ~255; } base[32] = acc; }
    __syncthreads();
    if (F.bid == 0 && F.tid < 33) META[F.tid] = base[F.tid];
    if (F.tid < 32) { int run = base[F.tid] + off[F.tid]; for (int i = 0; i < na; ++i) { if (eloc[i] == F.tid) { posl[i] = run; POS[r0 * 4 + i] = run; ++run; } } }
    __syncthreads();
    for (int i = F.wave; i < na; i += NWAVES) { const int row = r0 + (i >> 2); const int p = posl[i];
        const v4u* s = (const v4u*)(H + (size_t)row * D) + lane; v4u* dp = (v4u*)(XS + (size_t)p * D) + lane;
        dp[0] = s[0]; dp[64] = s[64]; }
    __syncthreads();
}
__device__ __forceinline__ LAS int* load_moe_base(const Ctx& F) {
    LAS int* base = (LAS int*)(F.lds + LDSCTL_OFF + 256);
    const int* META = (const int*)(F.a->ws + WS_META);
    if (F.tid < 33) base[F.tid] = META[F.tid];
    __syncthreads();
    return base;
}

constexpr int NSTAGE_L = 13, NSTAGES = 1 + DEPTH * NSTAGE_L + 1;
__global__ void __launch_bounds__(NTHREADS, 2) mk_fwd(Args args) {
    extern __shared__ __attribute__((aligned(16))) unsigned char lds_raw[];
    Ctx F; F.a = kargs(); F.lds = (LAS unsigned char*)lds_raw; F.tid = threadIdx.x; F.lane = F.tid & 63; F.wave = __builtin_amdgcn_readfirstlane(F.tid >> 6); F.bid = blockIdx.x; F.G = gridDim.x;
    volatile LAS unsigned* MISC = (volatile LAS unsigned*)(F.lds + LDSCTL_OFF);
    for (int u = F.tid; u < (LDS_BYTES - LDSCTL_OFF) / 4; u += NTHREADS) ((LAS unsigned*)(F.lds + LDSCTL_OFF))[u] = 0u;
    __syncthreads();
#if MK_PER_STAGE
#define GRID_BAR() do { } while (0)
#else
    (void)xcd_barrier_post((unsigned*)(F.a->ws + WS_CTL) + CW_BAR, MISC + 8);
#define GRID_BAR() do { XcdBarrier b_; b_.bar = (unsigned*)(kargs()->ws + WS_CTL) + CW_BAR; b_.x = xb_xcc_id(); b_.st = (volatile LAS unsigned*)((LAS unsigned char*)lds_raw + LDSCTL_OFF + opaque(32)); xcd_barrier(b_); } while (0)
#endif
#ifndef ONLY_S
#define ONLY_S -1
#endif
#define STG_SEL(k) (ONLY_S < 0 || ONLY_S == (((k) == 0) ? 0 : ((k) == NSTAGES - 1 ? 14 : (((k) - 1) % NSTAGE_L) + 1)))
#if MK_PER_STAGE
#define IN(k) (STG_SEL(k) && kargs()->ph_lo == (k))
#else
#define IN(k) STG_SEL(k)
#endif
#if MK_PER_STAGE
#define SEAM(k) do { } while (0)
#else
#define SEAM(k) do { if ((k) + 1 < NSTAGES) GRID_BAR(); } while (0)
#endif
#define STAGE(k) if (IN(k)) { F.a = kargs(); F.tid = opaque_v((int)threadIdx.x); F.lane = F.tid & 63; F.wave = __builtin_amdgcn_readfirstlane(F.tid >> 6); F.bid = opaque((int)blockIdx.x); F.G = opaque((int)gridDim.x); F.lds = (LAS unsigned char*)lds_raw + opaque(0); unsigned char* ws = F.a->ws; const int l = opaque(lq); unsigned char* wl = ws + WS_WTS + (size_t)l * WL_STRIDE; (void)wl; (void)ws;
#define STAGE_END(k) } SEAM(k);
    int lq = 0;
    STAGE(0) p0_prologue(F); STAGE_END(0)
    for (lq = 0; lq < DEPTH; ++lq) {
        const int sb = 1 + lq * NSTAGE_L;
        STAGE(sb + 0) stage_norm1(F, l); STAGE_END(sb + 0)
        STAGE(sb + 1) pg8::SchedStatic S; S.init(ws + WS_H, wl + WO_WIN, T_ALL, IN_COLS, 1024, F.G, F.bid); pg8::EpiBf16 E{(bf16*)(ws + WS_Z), IN_COLS, nullptr, 0};
            pg8::gemm_phase(F.lds, F.tid, 1024, S, E); STAGE_END(sb + 1)
        STAGE(sb + 2) for (int rep = 0; rep < REPN(1); ++rep) stage_rw_prep1(F, l); for (int rep = 0; rep < REPN(2); ++rep) stage_s5_scan<0>(F, l); for (int rep = 0; rep < REPN(3); ++rep) stage_hy_pre(F, l); STAGE_END(sb + 2)
        STAGE(sb + 3) { pg8::SchedStatic S; S.init(ws + WS_ARW, wl + WO_RWCAT, T_ALL, 2560, 256, F.G, F.bid); pg8::EpiBf16 E{(bf16*)(ws + WS_P), 2560, nullptr, 0}; PT(4); pg8::gemm_phase(F.lds, F.tid, 256, S, E); PT(5); }
            for (int rep = 0; rep < REPN(4); ++rep) stage_s5_scan<1>(F, l); STAGE_END(sb + 3)
        STAGE(sb + 4) for (int rep = 0; rep < REPN(5); ++rep) stage_rw_prep2(F, l); for (int rep = 0; rep < REPN(6); ++rep) stage_s5_prep(F, l); STAGE_END(sb + 4)
        STAGE(sb + 5) PT(10); stage_mixer(F, l); PT(11); STAGE_END(sb + 5) STAGE(sb + 5) PT(12); }
        STAGE(sb + 6) { pg8::SchedStatic S; S.init(ws + WS_AS5, wl + WO_GLU, T_ALL, 1024, 512, F.G, F.bid); pg8::EpiGlu<0> E{(bf16*)(ws + WS_YS5), 512, F.a->in[I_S5GLUB] + l * 1024, 0, 512}; PT(13); pg8::gemm_phase(F.lds, F.tid, 512, S, E); PT(14); }
            for (int rep = 0; rep < REPN(7); ++rep) stage_rw_readout(F, l); for (int rep = 0; rep < REPN(8); ++rep) stage_hy_post(F, l); STAGE_END(sb + 6)
        STAGE(sb + 7) pg8::SchedMerge S; S.A0 = (const char*)(ws + WS_YHY); S.A1 = (const char*)(ws + WS_YRW); S.A2 = (const char*)(ws + WS_YS5); S.Bt = (const char*)(wl + WO_WBR); S.tstep = (size_t)256 * 512 * 2; S.bstride = (size_t)1024 * 512 * 2;
            S.nM = T_ALL / 256; S.nN = 4; S.G = F.G; S.c = F.bid;
            pg8::EpiMerge E{(float*)(ws + WS_MTMP), (bf16*)(ws + WS_H), (const bf16*)(ws + WS_Z) + GATE_OFF}; pg8::gemm_phase(F.lds, F.tid, 512, S, E); STAGE_END(sb + 7)
        STAGE(sb + 8) pg8::SchedStatic S; S.init(ws + WS_H, wl + WO_WOUT, T_ALL, 1024, 1024, F.G, F.bid); pg8::EpiResid E{(float*)(ws + WS_X), (const float*)(ws + WS_MOD) + (size_t)l * 9 * 6144 + 2048};
            pg8::gemm_phase(F.lds, F.tid, 1024, S, E); STAGE_END(sb + 8)
        STAGE(sb + 9) PT(17); stage_norm2_router(F, l); PT(18); STAGE_END(sb + 9)
        STAGE(sb + 10) PT(19); stage_moe_scatter(F, l); PT(20); STAGE_END(sb + 10)
        STAGE(sb + 11) LAS int* base = load_moe_base(F);
            pg8::SchedMoe S; S.A = (const char*)(ws + WS_XS); S.Bt = (const char*)(wl + WO_W1); S.tstep = (size_t)256 * 1024 * 2; S.estride = (size_t)2048 * 1024 * 2; S.NPN = 8; S.G = F.G; S.c = F.bid; S.base = base;
            pg8::EpiGlu<1> E{(bf16*)(ws + WS_ACT), 1024, F.a->in[I_B1] + (size_t)l * 32 * 2048, 2048, 1024}; pg8::gemm_phase(F.lds, F.tid, 1024, S, E); STAGE_END(sb + 11)
        STAGE(sb + 12) LAS int* base = load_moe_base(F);
            pg8::SchedMoe S; S.A = (const char*)(ws + WS_ACT); S.Bt = (const char*)(wl + WO_W2); S.tstep = (size_t)256 * 1024 * 2; S.estride = (size_t)1024 * 1024 * 2; S.NPN = 4; S.G = F.G; S.c = F.bid; S.base = base;
            pg8::EpiBf16 E{(bf16*)(ws + WS_XS), 1024, F.a->in[I_B2] + (size_t)l * 32 * 1024, 1024}; pg8::gemm_phase(F.lds, F.tid, 1024, S, E); STAGE_END(sb + 12)
    }
    lq = DEPTH;
    STAGE(NSTAGES - 1)
#ifndef PROBE_T
        stage_norm1(F, l);
#endif
#ifdef PROBE_T
        { const unsigned long long* st = (const unsigned long long*)(F.a->ws + WS_CTL + CW_STAMP * 4); const float cval = (float)(long long)(st[PROBE_B] - st[PROBE_A]) * (1.0f / (100.0f * PROBE_DIV));
          __syncthreads(); for (size_t i = (size_t)F.bid * NTHREADS + F.tid; i < (size_t)T_LAT * D; i += (size_t)F.G * NTHREADS) F.a->out[i] = cval; }
#endif
    }
#undef IN
#undef SEAM
}

extern "C" void kernel_launch(void* const* d_in, const int* in_sizes, int n_in, void* d_out, int out_size, void* d_ws, size_t ws_size, hipStream_t stream) {
    static int grid = 0;
    if (grid == 0) {
        if (n_in != 51 || out_size != T_LAT * D || ws_size < WS_END) { fprintf(stderr, "kernel_launch: unexpected shapes (n_in %d out %d ws %zu, need %zu)\n", n_in, out_size, ws_size, (size_t)WS_END); grid = -1; return; }
        int dev = 0, cus = 0, per_cu = 0;
        if (hipGetDevice(&dev) != hipSuccess || hipDeviceGetAttribute(&cus, hipDeviceAttributeMultiprocessorCount, dev) != hipSuccess) { grid = -1; return; }
        if (hipFuncSetAttribute((const void*)mk_fwd, hipFuncAttributeMaxDynamicSharedMemorySize, LDS_BYTES) != hipSuccess) { fprintf(stderr, "kernel_launch: hipFuncSetAttribute failed\n"); grid = -1; return; }
        if (hipOccupancyMaxActiveBlocksPerMultiprocessor(&per_cu, (const void*)mk_fwd, NTHREADS, LDS_BYTES) != hipSuccess || per_cu < 1) fprintf(stderr, "kernel_launch: occupancy query says %d\n", per_cu);
        (void)hipGetLastError();
        grid = cus;
    }
    if (grid < 0) return;
    if (hipMemsetAsync((char*)d_ws + WS_CTL, 0, CTL_ZERO_BYTES, stream) != hipSuccess) return;
    Args a{};
    for (int i = 0; i < 51; ++i) a.in[i] = (const float*)d_in[i];
    a.out = (float*)d_out; a.ws = (unsigned char*)d_ws;
#if MK_PER_STAGE
    for (int s = 0; s < NSTAGES; ++s) { a.ph_lo = s; a.ph_hi = s + 1; int reps = 1;
#ifdef PROBE_SET
        { const int ls = (s == 0 || s == NSTAGES - 1) ? -1 : (s - 1) % NSTAGE_L;
          if (PROBE_SET >= 1 && PROBE_SET <= 13 && ls == PROBE_SET - 1 && ls != 5 && ls != 8 && !(ls == 0 && s > 1)) reps = 3;
          if (PROBE_SET == 14 && s == 0) reps = 3; }
#endif
        for (int r = 0; r < reps; ++r) hipLaunchKernelGGL(mk_fwd, dim3(grid), dim3(NTHREADS), LDS_BYTES, stream, a); }
#else
    a.ph_lo = 0; a.ph_hi = NSTAGES; hipLaunchKernelGGL(mk_fwd, dim3(grid), dim3(NTHREADS), LDS_BYTES, stream, a);
#endif
}
```

```cpp
#include <hip/hip_runtime.h>
#include <cstdio>
#include <cstdint>

#ifndef DUPK
#define DUPK 0
#endif
#define REPN(k) ((DUPK == (k)) ? 3 : 1)
#ifndef REP_GEMM
#define REP_GEMM 1
#endif
#ifndef REP_LIGHT
#define REP_LIGHT 1
#endif
#ifndef REP_PRO
#define REP_PRO 1
#endif
#ifndef MK_PER_STAGE
#define MK_PER_STAGE 0
#endif

#define GAS __attribute__((address_space(1)))
#define LAS __attribute__((address_space(3)))
typedef unsigned short bf16;
typedef unsigned v4u __attribute__((ext_vector_type(4)));
typedef unsigned v2u __attribute__((ext_vector_type(2)));
typedef float f32x4 __attribute__((ext_vector_type(4)));
typedef float f32x2 __attribute__((ext_vector_type(2)));
typedef short bf16x8 __attribute__((ext_vector_type(8)));

constexpr int D = 1024, BATCH = 8, SEQ = 4096, CTXL = 256, DEPTH = 2;
constexpr int T_LAT = BATCH * SEQ, T_CTX = BATCH * CTXL, T_ALL = T_LAT + T_CTX;
constexpr int IN_COLS = 6912, HY_OFF = 0, RW_OFF = 1536, S5_OFF = 3328, GATE_OFF = 3840;
constexpr int NE = 32, TOPK = 4;
constexpr int MAXSLOT = 147456;
constexpr int NWAVES = 8, NTHREADS = 512;
constexpr int HY_MARG = 128, HY_ROWB = 8720, HY_RLEN = 8272, HY_RLENC = 592;
constexpr int HY_R1_OFF = 8 * HY_ROWB, HY_R2_OFF = HY_R1_OFF + HY_RLEN * 2;

constexpr size_t MiB = 1ull << 20;
constexpr size_t WS_CTL = 0, CTL_ZERO_BYTES = 1 * MiB;
constexpr size_t WS_MOD = 1 * MiB;
constexpr size_t WS_BLKCNT = 2 * MiB;
constexpr size_t WS_META = 2 * MiB + 512 * 1024;
constexpr size_t WS_EIDX = 3 * MiB, WS_GATE = 4 * MiB, WS_POS = 5 * MiB;
constexpr size_t WS_WTS = 8 * MiB, WL_STRIDE = 214 * MiB;
constexpr size_t WO_WIN = 0, WO_RWCAT = 14 * MiB, WO_GLU = 16 * MiB, WO_WBR = 17 * MiB, WO_WOUT = 20 * MiB, WO_W1 = 22 * MiB, WO_W2 = 150 * MiB;
constexpr size_t WS_GF = 436 * MiB, GF_STRIDE = 20 * MiB, GF_CTX = 17 * MiB;
constexpr size_t WS_X = 504 * MiB;
constexpr size_t WS_H = 640 * MiB;
constexpr size_t WS_BIG = 708 * MiB;
constexpr size_t WS_Z = WS_BIG;
constexpr size_t WS_SCN = 1167 * MiB;
constexpr size_t WS_MTMP = WS_SCN;
constexpr size_t WS_P = 1473 * MiB;
constexpr size_t WS_ARW = 1643 * MiB;
constexpr size_t WS_YP = 1660 * MiB;
constexpr size_t WS_YDIR = WS_YP;
constexpr size_t WS_UT = 1796 * MiB;
constexpr size_t WS_AS5 = 2000 * MiB;
constexpr size_t WS_YHY = 1898 * MiB, WS_YRW = 1932 * MiB, WS_YS5 = 1966 * MiB;
constexpr size_t WS_XS = WS_BIG;
constexpr size_t WS_ACT = WS_BIG + 288 * MiB;
constexpr size_t WS_END = 2034 * MiB;
constexpr int CW_BAR = 4096;

constexpr int RING_BYTES = 131072;
constexpr int LDSCTL_OFF = RING_BYTES;
constexpr int LDS_BYTES = 163840;

typedef __bf16 bf16x2_t __attribute__((ext_vector_type(2)));
__device__ __forceinline__ unsigned pk2(float lo, float hi) { const bf16x2_t v = __builtin_convertvector((f32x2){lo, hi}, bf16x2_t); return __builtin_bit_cast(unsigned, v); }
__device__ __forceinline__ unsigned f2bf(float f) { return pk2(f, 0.f) & 0xffffu; }
__device__ __forceinline__ float bf2f(bf16 b) { return __builtin_bit_cast(float, ((unsigned)b) << 16); }
__device__ __forceinline__ float bflo(unsigned w) { return __builtin_bit_cast(float, w << 16); }
__device__ __forceinline__ float bfhi(unsigned w) { return __builtin_bit_cast(float, w & 0xffff0000u); }
__device__ __forceinline__ float sigm(float x) { return 1.f / (1.f + __expf(-x)); }
#define LDS_WAIT() asm volatile("s_waitcnt lgkmcnt(0)" ::: "memory")
__device__ __forceinline__ float dpp_f(float x, const int ctrl_sel) {
    const int v = __builtin_bit_cast(int, x);
    int r;
    if (ctrl_sel == 0) r = __builtin_amdgcn_update_dpp(0, v, 0xB1, 0xF, 0xF, true);
    else if (ctrl_sel == 1) r = __builtin_amdgcn_update_dpp(0, v, 0x4E, 0xF, 0xF, true);
    else r = __builtin_amdgcn_update_dpp(0, v, 0x141, 0xF, 0xF, true);
    return __builtin_bit_cast(float, r);
}
__device__ __forceinline__ float red32(float x) {
    x += dpp_f(x, 0); x += dpp_f(x, 1); x += dpp_f(x, 2);
    x += __builtin_bit_cast(float, __builtin_amdgcn_update_dpp(0, __builtin_bit_cast(int, x), 0x128, 0xF, 0xF, true));
    x += __builtin_bit_cast(float, __builtin_amdgcn_ds_swizzle(__builtin_bit_cast(int, x), 0x401F));
    return x;
}
__device__ __forceinline__ float wave_sum(float v) {
    v = red32(v);
    return __builtin_bit_cast(float, __builtin_amdgcn_readlane(__builtin_bit_cast(int, v), 0)) + __builtin_bit_cast(float, __builtin_amdgcn_readlane(__builtin_bit_cast(int, v), 32));
}
__device__ __forceinline__ int xch32(int v, const int step) {
    if (step == 0) return __builtin_amdgcn_update_dpp(0, v, 0xB1, 0xF, 0xF, true);
    if (step == 1) return __builtin_amdgcn_update_dpp(0, v, 0x4E, 0xF, 0xF, true);
    if (step == 2) return __builtin_amdgcn_update_dpp(0, v, 0x141, 0xF, 0xF, true);
    if (step == 3) return __builtin_amdgcn_update_dpp(0, v, 0x128, 0xF, 0xF, true);
    return __builtin_amdgcn_ds_swizzle(v, 0x401F);
}
__device__ __forceinline__ float red8(float x) { x += dpp_f(x, 0); x += dpp_f(x, 1); x += dpp_f(x, 2); return x; }

#define XB_TMO      128
#define XB_XCNT(j)  (256  + 64 * (j))
#define XB_XSUB(j)  (1280 + 64 * (j))
#define XB_XGEN(j)  (2304 + 64 * (j))
#define XB_TOP      3328
#define XB_TOPGEN   3392
#define XCD_BAR_WORDS 3456
#define XB_SPIN_CAP (1u << 22)
__device__ __forceinline__ unsigned xb_ld(unsigned* p)              { return __hip_atomic_load(p, __ATOMIC_RELAXED, __HIP_MEMORY_SCOPE_AGENT); }
__device__ __forceinline__ unsigned xb_add(unsigned* p, unsigned v) { return __hip_atomic_fetch_add(p, v, __ATOMIC_RELAXED, __HIP_MEMORY_SCOPE_AGENT); }
__device__ __forceinline__ unsigned xb_xcc_id() { return (unsigned)__builtin_amdgcn_s_getreg((3 << 11) | 20) & 0xFu; }
#define XB_SPIN(cond, bar) do { unsigned _sp = 0; while (cond) { __builtin_amdgcn_s_sleep(1); \
    if ((++_sp & 255u) == 0u) { if (xb_ld(&(bar)[XB_TMO])) break; if (_sp > XB_SPIN_CAP) { atomicAdd(&(bar)[XB_TMO], 1u); break; } } } } while (0)
struct XcdBarrier { unsigned* bar; unsigned x; volatile LAS unsigned* st; };
__device__ __forceinline__ XcdBarrier xcd_barrier_post(unsigned* bar, volatile LAS unsigned* st) {
    XcdBarrier b; b.bar = bar; b.x = xb_xcc_id(); b.st = st;
    if (threadIdx.x == 0) (void)xb_add(&bar[XB_XCNT(b.x)], 1u);
    return b;
}
__device__ __forceinline__ void xcd_barrier_complete(unsigned* bar, unsigned x, unsigned& nloc, unsigned& nx) {
    const unsigned G = gridDim.x * gridDim.y * gridDim.z;
    unsigned sum, cnt, mine, sp = 0u;
    for (;;) {
        sum = 0u; cnt = 0u; mine = 0u;
#pragma unroll
        for (unsigned j = 0; j < 16; ++j) { const unsigned c = xb_ld(&bar[XB_XCNT(j)]); sum += c; cnt += (c > 0u) ? 1u : 0u; mine = (j == x) ? c : mine; }
        if (sum == G) break;
        __builtin_amdgcn_s_sleep(1);
        if ((++sp & 255u) == 0u) { if (xb_ld(&bar[XB_TMO])) break; if (sp > XB_SPIN_CAP) { atomicAdd(&bar[XB_TMO], 1u); break; } }
    }
    nloc = mine > 0u ? mine : 1u; nx = cnt > 0u ? cnt : 1u;
}
__device__ __forceinline__ void xcd_barrier(const XcdBarrier& b) {
    asm volatile("s_waitcnt vmcnt(0)" ::: "memory");
    __syncthreads();
    if (threadIdx.x == 0) {
        unsigned* bar = b.bar;
        __builtin_amdgcn_s_waitcnt(0);
        unsigned nloc = b.st[0], nx = b.st[1];
        if (nloc == 0u) { xcd_barrier_complete(bar, b.x, nloc, nx); b.st[0] = nloc; b.st[1] = nx; }
        const unsigned old = xb_add(&bar[XB_XSUB(b.x)], 1u);
        const unsigned gen = old / nloc;
        if (old + 1u == (gen + 1u) * nloc) {
            __builtin_amdgcn_fence(__ATOMIC_RELEASE, "agent");
            asm volatile("s_waitcnt vmcnt(0)" ::: "memory");
            const unsigned og = xb_add(&bar[XB_TOP], 1u);
            const unsigned tg = og / nx;
            if (og + 1u == (tg + 1u) * nx) xb_add(&bar[XB_TOPGEN], 1u);
            else XB_SPIN(xb_ld(&bar[XB_TOPGEN]) == tg, bar);
            __builtin_amdgcn_fence(__ATOMIC_ACQUIRE, "agent");
            xb_add(&bar[XB_XGEN(b.x)], 1u);
            asm volatile("s_waitcnt vmcnt(0)" ::: "memory");
        } else {
            XB_SPIN(xb_ld(&bar[XB_XGEN(b.x)]) == gen, bar);
            __builtin_amdgcn_fence(__ATOMIC_ACQUIRE, "agent");
            asm volatile("s_waitcnt vmcnt(0)" ::: "memory");
        }
    }
    __syncthreads();
}

namespace pg8 {
constexpr int BM = 256, BK = 64, HALF = 128, HTB = HALF * BK * 2, STAGE_BYTES = 8 * HTB, NXCD = 8, WGM = 8;
__host__ __device__ __forceinline__ int lds_byte(int r, int c) { const int st = (r >> 4) * 2 + (c >> 5), rr = r & 15, cc = c & 31, ob = rr * 64 + cc * 2; return st * 1024 + (ob ^ (((ob >> 9) & 1) << 5)); }
__host__ __device__ __forceinline__ void stage_rc(int b, int& R, int& C) { const int st = b / 1024, sb = b % 1024, swz = sb ^ (((sb >> 9) & 1) << 5); R = (st >> 1) * 16 + swz / 64; C = (st & 1) * 32 + (swz % 64) / 2; }
__host__ __device__ __forceinline__ int perm32(int rho) { const int n = rho >> 4, i = rho & 15; return 8 * (i >> 2) + 4 * n + (i & 3); }
struct Unit { int pm, pn, e; };
__device__ __forceinline__ unsigned cvt_pk_bf16(float lo, float hi) { return pk2(lo, hi); }

__device__ __forceinline__ void tile_of(int L, int nM, int nN, int& pm, int& pn) {
    const int nwg = nM * nN; int wgid = L;
    { const int q = nwg / NXCD, r = nwg % NXCD, xcd = wgid % NXCD, off = wgid / NXCD; wgid = (xcd < r ? xcd * (q + 1) : r * (q + 1) + (xcd - r) * q) + off; }
    const int nig = WGM * nN, gid = wgid / nig, fm = gid * WGM, gsz = (nM - fm) < WGM ? (nM - fm) : WGM;
    pm = fm + ((wgid % nig) % gsz); pn = (wgid % nig) / gsz;
}
struct SchedStatic {
    const char* A; const char* Bt; size_t tstep; int nM, nN, G, c;
    __device__ __forceinline__ void init(const void* A_, const void* Bt_, int M, int N, int K, int G_, int c_) { A = (const char*)A_; Bt = (const char*)Bt_; tstep = (size_t)BM * K * 2; nM = M / BM; nN = N / BM; G = G_; c = c_; }
    __device__ __forceinline__ bool next(int i, Unit& u) const { const long L = (long)i * G + c; if (L >= (long)nM * nN) return false; tile_of((int)L, nM, nN, u.pm, u.pn); u.e = 0; return true; }
    __device__ __forceinline__ const char* aptr(const Unit& u) const { return A + (size_t)u.pm * tstep; }
    __device__ __forceinline__ const char* bptr(const Unit& u) const { return Bt + (size_t)u.pn * tstep; }
};
struct SchedMerge {
    const char* A0; const char* A1; const char* A2; const char* Bt; size_t tstep, bstride; int nM, nN, G, c;
    __device__ __forceinline__ bool next(int i, Unit& u) const { const int j = i / 3, br = i - 3 * j; const long L = (long)j * G + c; if (L >= (long)nM * nN) return false; tile_of((int)L, nM, nN, u.pm, u.pn); u.e = br; return true; }
    __device__ __forceinline__ const char* aptr(const Unit& u) const { return (u.e == 0 ? A0 : (u.e == 1 ? A1 : A2)) + (size_t)u.pm * tstep; }
    __device__ __forceinline__ const char* bptr(const Unit& u) const { return Bt + (size_t)u.e * bstride + (size_t)u.pn * tstep; }
};
struct SchedMoe {
    const char* A; const char* Bt; size_t tstep, estride; int NPN, G, c; const LAS int* base;
    __device__ __forceinline__ bool next(int i, Unit& u) const {
        const int ntiles = base[32] >> 8; const long L = (long)i * G + c; if (L >= (long)ntiles * NPN) return false;
        u.pm = (int)(L / NPN); u.pn = (int)(L % NPN); const int r0 = u.pm << 8; int e = 0;
#pragma unroll 1
        for (int k = 1; k < 32; ++k) e += (r0 >= base[k]) ? 1 : 0;
        u.e = e; return true;
    }
    __device__ __forceinline__ const char* aptr(const Unit& u) const { return A + (size_t)u.pm * tstep; }
    __device__ __forceinline__ const char* bptr(const Unit& u) const { return Bt + (size_t)u.e * estride + (size_t)u.pn * tstep; }
};

template <class Epi, class Sched>
__device__ __forceinline__ void gemm_phase(LAS unsigned char* lds, const int tid, const int K, const Sched& S, const Epi& E) {
    const int wid = __builtin_amdgcn_readfirstlane(tid >> 6), lane = tid & 63, wr = wid >> 2, wc = wid & 3, fr = lane & 15, fq = lane >> 4;
    const int nt = K / BK;
    unsigned voffA[2], voffB[2];
#pragma unroll
    for (int i = 0; i < 2; ++i) { int R, C; stage_rc(tid * 16 + i * 8192, R, C); const int Rb = Epi::PERM ? ((R & ~31) + perm32(R & 31)) : R;
        voffA[i] = (unsigned)(R * K + C) * 2u; voffB[i] = (unsigned)(Rb * K + C) * 2u; }
    const size_t kstep = (size_t)(BK * 2);
    const size_t hstep = (size_t)HALF * K * 2;
    const unsigned ldsw = (unsigned)wid * 1024u;
    const int aoff = lds_byte(wr * 64 + fr, fq * 8), boff = lds_byte(wc * 32 + fr, fq * 8);
#define PG8_SA(b, h) (((b) * 2 + (h)) * HTB)
#define PG8_SB(b, h) ((4 + (b) * 2 + (h)) * HTB)
#define PG8_STAGE(bufoff, gbase, voff) do { _Pragma("unroll") for (int _i = 0; _i < 2; ++_i) \
        __builtin_amdgcn_global_load_lds((const unsigned*)((const char*)(gbase) + (voff)[_i]), (LAS unsigned*)(lds + (bufoff) + ldsw + _i * 8192), 16, 0, 0); } while (0)
#define PG8_LDA(dst, b, h) do { _Pragma("unroll") for (int m = 0; m < 4; ++m) _Pragma("unroll") for (int k = 0; k < 2; ++k) dst[m][k] = *(const LAS bf16x8*)(lds + PG8_SA(b, h) + aoff + m * 2048 + k * 1024); } while (0)
#define PG8_LDB(dst, b, h) do { _Pragma("unroll") for (int n = 0; n < 2; ++n) _Pragma("unroll") for (int k = 0; k < 2; ++k) dst[n][k] = *(const LAS bf16x8*)(lds + PG8_SB(b, h) + boff + n * 2048 + k * 1024); } while (0)
#define PG8_MMA(ai, bj, At, Bt) do { __builtin_amdgcn_s_setprio(1); _Pragma("unroll") for (int m = 0; m < 4; ++m) _Pragma("unroll") for (int n = 0; n < 2; ++n) _Pragma("unroll") for (int k = 0; k < 2; ++k) \
        acc[ai][bj][m][n] = __builtin_amdgcn_mfma_f32_16x16x32_bf16(Bt[n][k], At[m][k], acc[ai][bj][m][n], 0, 0, 0); __builtin_amdgcn_s_setprio(0); } while (0)
#define PG8_WAIT_V(n) asm volatile("s_waitcnt vmcnt(" #n ")" ::: "memory")
#define PG8_WAIT_L(n) asm volatile("s_waitcnt lgkmcnt(" #n ")" ::: "memory")
#define PG8_BAR __builtin_amdgcn_s_barrier()
#define PG8_SCHED __builtin_amdgcn_sched_barrier(0)
    Unit cur, nxt; int ui = 0;
    if (!S.next(0, cur)) return;
    f32x4 acc[2][2][4][2];
#pragma unroll
    for (int a = 0; a < 2; ++a)
#pragma unroll
        for (int b = 0; b < 2; ++b)
#pragma unroll
            for (int m = 0; m < 4; ++m)
#pragma unroll
                for (int n = 0; n < 2; ++n) acc[a][b][m][n] = (f32x4){0.f, 0.f, 0.f, 0.f};
    bf16x8 At[4][2], B0[2][2], B1[2][2];
    const char* cA = S.aptr(cur); const char* cB = S.bptr(cur);
    PG8_STAGE(PG8_SB(0, 0), cB, voffB); PG8_STAGE(PG8_SB(0, 1), cB + hstep, voffB); PG8_STAGE(PG8_SA(0, 0), cA, voffA); PG8_STAGE(PG8_SA(0, 1), cA + hstep, voffA);
    if (wr == 1) PG8_BAR;
    PG8_WAIT_V(2); PG8_BAR;
    PG8_STAGE(PG8_SB(1, 0), cB + kstep, voffB); PG8_STAGE(PG8_SA(1, 0), cA + kstep, voffA); PG8_STAGE(PG8_SB(1, 1), cB + hstep + kstep, voffB);
    PG8_WAIT_V(6); PG8_BAR;
    for (;;) {
        const bool has_next = S.next(ui + 1, nxt);
        const char* nA = has_next ? S.aptr(nxt) : cA; const char* nB = has_next ? S.bptr(nxt) : cB;
        for (int t = 0; t < nt; t += 2) {
            const bool last = (t == nt - 2);
            const char* a1 = cA + (size_t)(t + 1) * kstep;
            const char* a2 = last ? nA : cA + (size_t)(t + 2) * kstep; const char* b2 = last ? nB : cB + (size_t)(t + 2) * kstep;
            const char* a3 = a2 + kstep; const char* b3 = b2 + kstep;
            PG8_LDB(B0, 0, 0); PG8_LDB(B1, 0, 1); PG8_SCHED; PG8_LDA(At, 0, 0); PG8_STAGE(PG8_SA(1, 1), a1 + hstep, voffA);
            PG8_WAIT_V(8); PG8_WAIT_L(0); PG8_BAR; PG8_MMA(0, 0, At, B0); PG8_MMA(0, 1, At, B1); PG8_BAR; PG8_SCHED;
            PG8_LDA(At, 0, 1); PG8_STAGE(PG8_SB(0, 0), b2, voffB); PG8_STAGE(PG8_SB(0, 1), b2 + hstep, voffB); PG8_STAGE(PG8_SA(0, 0), a2, voffA);
            PG8_WAIT_V(8); PG8_WAIT_L(0); PG8_BAR; PG8_MMA(1, 0, At, B0); PG8_MMA(1, 1, At, B1); PG8_BAR; PG8_SCHED;
            PG8_LDB(B0, 1, 0); PG8_LDB(B1, 1, 1); PG8_SCHED; PG8_LDA(At, 1, 0); PG8_STAGE(PG8_SA(0, 1), a2 + hstep, voffA);
            PG8_WAIT_V(8); PG8_WAIT_L(0); PG8_BAR; PG8_MMA(0, 0, At, B0); PG8_MMA(0, 1, At, B1); PG8_BAR; PG8_SCHED;
            PG8_LDA(At, 1, 1); PG8_STAGE(PG8_SB(1, 0), b3, voffB); PG8_STAGE(PG8_SB(1, 1), b3 + hstep, voffB); PG8_STAGE(PG8_SA(1, 0), a3, voffA);
            PG8_WAIT_V(8); PG8_WAIT_L(0); PG8_BAR; PG8_MMA(1, 0, At, B0); PG8_MMA(1, 1, At, B1); PG8_BAR; PG8_SCHED;
        }
        if (wr == 0) PG8_BAR;
        E(acc, cur, wr, wc, fr, fq);
        if (!has_next) break;
#pragma unroll
        for (int a = 0; a < 2; ++a)
#pragma unroll
            for (int b = 0; b < 2; ++b)
#pragma unroll
                for (int m = 0; m < 4; ++m)
#pragma unroll
                    for (int n = 0; n < 2; ++n) acc[a][b][m][n] = (f32x4){0.f, 0.f, 0.f, 0.f};
        cur = nxt; cA = nA; cB = nB; ++ui;
        if (wr == 1) PG8_BAR;
    }
    PG8_WAIT_V(0);
    PG8_BAR;
#undef PG8_SA
#undef PG8_SB
#undef PG8_STAGE
#undef PG8_LDA
#undef PG8_LDB
#undef PG8_MMA
#undef PG8_WAIT_V
#undef PG8_WAIT_L
#undef PG8_BAR
#undef PG8_SCHED
}

struct EpiBf16 {
    static constexpr bool PERM = true;
    bf16* O; int ldc; const float* bias; int bias_stride;
    __device__ __forceinline__ void operator()(const f32x4 (&acc)[2][2][4][2], const Unit& u, int wr, int wc, int fr, int fq) const {
        const int row0 = u.pm * BM + wr * 64 + fr, col0 = u.pn * BM + wc * 32 + 8 * fq;
        f32x4 bv[2][2];
#pragma unroll
        for (int bj = 0; bj < 2; ++bj)
#pragma unroll
            for (int n = 0; n < 2; ++n) bv[bj][n] = bias ? *(const f32x4*)(bias + (size_t)u.e * bias_stride + col0 + bj * HALF + 4 * n) : (f32x4){0.f, 0.f, 0.f, 0.f};
#pragma unroll
        for (int ai = 0; ai < 2; ++ai)
#pragma unroll
            for (int m = 0; m < 4; ++m) { bf16* rowp = O + (size_t)(row0 + ai * HALF + m * 16) * ldc + col0;
#pragma unroll
                for (int bj = 0; bj < 2; ++bj) { const f32x4 v0 = acc[ai][bj][m][0] + bv[bj][0], v1 = acc[ai][bj][m][1] + bv[bj][1];
                    v4u w; w.x = cvt_pk_bf16(v0[0], v0[1]); w.y = cvt_pk_bf16(v0[2], v0[3]); w.z = cvt_pk_bf16(v1[0], v1[1]); w.w = cvt_pk_bf16(v1[2], v1[3]);
                    *(v4u*)(rowp + bj * HALF) = w; } }
    }
};
template <int MODE> struct EpiGlu {
    static constexpr bool PERM = true;
    bf16* O; int ldc; const float* bias; int bias_stride, hs;
    __device__ __forceinline__ void operator()(const f32x4 (&acc)[2][2][4][2], const Unit& u, int wr, int wc, int fr, int fq) const {
        const int row0 = u.pm * BM + wr * 64 + fr, col0 = u.pn * HALF + wc * 32 + 8 * fq;
        const float* bp = bias + (size_t)u.e * bias_stride + col0;
        f32x4 ba[2], bb[2];
#pragma unroll
        for (int n = 0; n < 2; ++n) { ba[n] = *(const f32x4*)(bp + 4 * n); bb[n] = *(const f32x4*)(bp + hs + 4 * n); }
#pragma unroll
        for (int ai = 0; ai < 2; ++ai)
#pragma unroll
            for (int m = 0; m < 4; ++m) { bf16* rowp = O + (size_t)(row0 + ai * HALF + m * 16) * ldc + col0;
                float o[8];
#pragma unroll
                for (int n = 0; n < 2; ++n) { const f32x4 a = acc[ai][0][m][n] + ba[n], b = acc[ai][1][m][n] + bb[n];
#pragma unroll
                    for (int j = 0; j < 4; ++j) {
                        if (MODE == 0) o[4 * n + j] = a[j] * sigm(b[j]);
                        else { const float g = fminf(a[j], 7.f), up = fminf(fmaxf(b[j], -7.f), 7.f); o[4 * n + j] = (up + 1.f) * g * sigm(1.702f * g); } } }
                v4u w; w.x = cvt_pk_bf16(o[0], o[1]); w.y = cvt_pk_bf16(o[2], o[3]); w.z = cvt_pk_bf16(o[4], o[5]); w.w = cvt_pk_bf16(o[6], o[7]);
                *(v4u*)rowp = w; }
    }
};
struct EpiMerge {
    static constexpr bool PERM = true;
    float* mtmp; bf16* Mo; const bf16* zg;
    __device__ __forceinline__ void operator()(const f32x4 (&acc)[2][2][4][2], const Unit& u, int wr, int wc, int fr, int fq) const {
        const int row0 = u.pm * BM + wr * 64 + fr, col0 = u.pn * BM + wc * 32 + 8 * fq;
#pragma unroll
        for (int ai = 0; ai < 2; ++ai)
#pragma unroll
            for (int m = 0; m < 4; ++m) { const size_t r = (size_t)(row0 + ai * HALF + m * 16);
#pragma unroll
                for (int bj = 0; bj < 2; ++bj) { const int c = col0 + bj * HALF;
                    const v4u gz = *(const v4u*)(zg + r * IN_COLS + u.e * 1024 + c);
                    float g[8] = {bflo(gz.x), bfhi(gz.x), bflo(gz.y), bfhi(gz.y), bflo(gz.z), bfhi(gz.z), bflo(gz.w), bfhi(gz.w)};
                    f32x4 t0, t1; float* tp = mtmp + r * 1024 + c;
                    if (u.e == 0) { t0 = (f32x4){0.f, 0.f, 0.f, 0.f}; t1 = t0; } else { t0 = *(const f32x4*)tp; t1 = *(const f32x4*)(tp + 4); }
#pragma unroll
                    for (int j = 0; j < 4; ++j) { t0[j] += sigm(g[j]) * acc[ai][bj][m][0][j]; t1[j] += sigm(g[4 + j]) * acc[ai][bj][m][1][j]; }
                    if (u.e < 2) { *(f32x4*)tp = t0; *(f32x4*)(tp + 4) = t1; }
                    else { v4u w; w.x = cvt_pk_bf16(t0[0], t0[1]); w.y = cvt_pk_bf16(t0[2], t0[3]); w.z = cvt_pk_bf16(t1[0], t1[1]); w.w = cvt_pk_bf16(t1[2], t1[3]);
                        *(v4u*)(Mo + r * 1024 + c) = w; } } }
    }
};
struct EpiResid {
    static constexpr bool PERM = false;
    float* X; const float* gmod;
    __device__ __forceinline__ void operator()(const f32x4 (&acc)[2][2][4][2], const Unit& u, int wr, int wc, int fr, int fq) const {
        const int row0 = u.pm * BM + wr * 64 + fr, col0 = u.pn * BM + wc * 32 + 4 * fq;
        const int r00 = u.pm * BM; const int w = r00 < T_LAT ? (r00 >> 12) : 8;
        f32x4 gv[2][2];
#pragma unroll
        for (int bj = 0; bj < 2; ++bj)
#pragma unroll
            for (int n = 0; n < 2; ++n) gv[bj][n] = *(const f32x4*)(gmod + (size_t)w * 6144 + col0 + bj * HALF + n * 16);
#pragma unroll
        for (int ai = 0; ai < 2; ++ai)
#pragma unroll
            for (int m = 0; m < 4; ++m) { float* rowp = X + (size_t)(row0 + ai * HALF + m * 16) * 1024 + col0;
#pragma unroll
                for (int bj = 0; bj < 2; ++bj)
#pragma unroll
                    for (int n = 0; n < 2; ++n) { f32x4* p = (f32x4*)(rowp + bj * HALF + n * 16); *p = *p + gv[bj][n] * acc[ai][bj][m][n]; } }
    }
};
}

struct Args { const float* in[51]; float* out; unsigned char* ws; int ph_lo, ph_hi; };
enum { I_X = 0, I_C, I_CTX, I_CCTX, I_ADAW, I_ADAB, I_N1G, I_N2G, I_WIN, I_HYCW, I_HYCB, I_HYW1, I_HYB1, I_HYF1, I_HYW2, I_HYB2, I_HYF2, I_HYW3, I_HYB3, I_HYBIAS,
       I_RWCW, I_RWCB, I_RWWUP, I_RWW0, I_RWAUP, I_RWA0, I_RWGUP, I_RWKK, I_RWKA, I_RWRK, I_RWLNG, I_RWLNB, I_S5ARE, I_S5AIM, I_S5LDT, I_S5BRE, I_S5BIM, I_S5CRE, I_S5CIM, I_S5D,
       I_S5GLUW, I_S5GLUB, I_WBR, I_WOUT, I_RTW, I_RTB, I_W1, I_B1, I_W2, I_B2, I_FING };

typedef const __attribute__((address_space(4))) Args* CArgsP;
__device__ __forceinline__ CArgsP kargs() { CArgsP p = (CArgsP)__builtin_amdgcn_kernarg_segment_ptr(); asm volatile("" : "+s"(p)); return p; }
__device__ __forceinline__ int opaque(int v) { asm volatile("" : "+s"(v)); return v; }
__device__ __forceinline__ int opaque_v(int v) { asm volatile("" : "+v"(v)); return v; }
struct Ctx { CArgsP a; LAS unsigned char* lds; int tid, lane, wave, bid, G; };

__device__ __forceinline__ void row_seq(int row, int& base, int& pos, int& n) {
    if (row < T_LAT) { base = row & ~(SEQ - 1); pos = row & (SEQ - 1); n = SEQ; }
    else { const int r = row - T_LAT; base = T_LAT + (r & ~(CTXL - 1)); pos = r & (CTXL - 1); n = CTXL; }
}
__device__ __forceinline__ float conv3z(const bf16* zc, int pos, int n, float w0, float w1, float w2, float b) {
    const float zm = pos > 0 ? bf2f(zc[(size_t)(pos - 1) * IN_COLS]) : 0.f, z0 = bf2f(zc[(size_t)pos * IN_COLS]), zp = pos < n - 1 ? bf2f(zc[(size_t)(pos + 1) * IN_COLS]) : 0.f;
    return zm * w0 + z0 * w1 + zp * w2 + b;
}

template <int MODE>
__device__ __forceinline__ void transpose_item(const float* W, int K, int N, bf16* WT, int Hs, LAS float* scr, int item, int lane) {
    const int nblk = N / 32, kb = item / nblk, nb = item % nblk, k0 = 64 * kb, n0 = 32 * nb;
#pragma unroll 8
    for (int i = 0; i < 32; ++i) { const int kk = 2 * i + (lane >> 5); scr[kk * 33 + (lane & 31)] = W[(size_t)(k0 + kk) * N + n0 + (lane & 31)]; }
    LDS_WAIT(); asm volatile("" ::: "memory");
    const int c = lane & 7;
#pragma unroll
    for (int j = 0; j < 4; ++j) { const int n = (lane >> 3) + 8 * j; const LAS float* s = scr + (8 * c) * 33 + n;
        v4u o; o.x = pk2(s[0 * 33], s[1 * 33]); o.y = pk2(s[2 * 33], s[3 * 33]); o.z = pk2(s[4 * 33], s[5 * 33]); o.w = pk2(s[6 * 33], s[7 * 33]);
        int dr = n0 + n;
        if (MODE == 1) { const int nc = n0 + n; const int jx = nc < Hs ? nc : nc - Hs; dr = (jx >> 7) * 256 + (nc < Hs ? 0 : 128) + (jx & 127); }
        *(v4u*)(WT + (size_t)dr * K + k0 + 8 * c) = o; }
    LDS_WAIT(); asm volatile("" ::: "memory");
}

__device__ __forceinline__ void p0_prologue(const Ctx& F) {
    const auto& a = *F.a; unsigned char* ws = a.ws;
    const int gw = F.bid * NWAVES + F.wave, NGW = F.G * NWAVES, lane = F.lane;
    float* X = (float*)(ws + WS_X);
    for (int row = gw; row < T_ALL; row += NGW) {
        f32x4* xo = (f32x4*)(X + (size_t)row * D) + lane;
        if (row < T_LAT) {
            const f32x4* xi = (const f32x4*)(a.in[I_X] + (size_t)row * D) + lane;
            const int t = row & (SEQ - 1); const float pr = (float)(t >> 6), pc = (float)(t & 63);
#pragma unroll
            for (int j = 0; j < 4; ++j) { f32x4 v = xi[64 * j];
#pragma unroll
                for (int e = 0; e < 4; ++e) { const float om = 1.0f / powf(10000.0f, (float)(4 * lane + e) / 256.0f); const float ang = ((j < 2) ? pr : pc) * om; v[e] += (j & 1) ? cosf(ang) : sinf(ang); }
                xo[64 * j] = v; }
        } else {
            const f32x4* xi = (const f32x4*)(a.in[I_CTX] + (size_t)(row - T_LAT) * D) + lane;
#pragma unroll
            for (int j = 0; j < 4; ++j) xo[64 * j] = xi[64 * j];
        }
    }
    {
        LAS float* condl = (LAS float*)F.lds; LAS float* psum = (LAS float*)(F.lds + 40960);
        for (int i = F.tid; i < 9 * 1024; i += NTHREADS) { const int w = i >> 10, k = i & 1023; const float cv = (w < 8) ? a.in[I_C][w * 1024 + k] : a.in[I_CCTX][k]; condl[i] = cv / (1.f + expf(-cv)); }
        __syncthreads();
        float* MOD = (float*)(ws + WS_MOD);
        for (int it = F.bid; it < 2 * 96; it += F.G) {
            const int l = it / 96, cg = it % 96, col = cg * 64 + lane;
            float acc[9];
#pragma unroll
            for (int w = 0; w < 9; ++w) acc[w] = 0.f;
            const float* wp = a.in[I_ADAW] + ((size_t)l * 1024 + F.wave * 128) * 6144 + col;
            for (int k = 0; k < 128; ++k) { const float wv = wp[(size_t)k * 6144];
#pragma unroll
                for (int w = 0; w < 9; ++w) acc[w] += condl[w * 1024 + F.wave * 128 + k] * wv; }
#pragma unroll
            for (int w = 0; w < 9; ++w) psum[(F.wave * 9 + w) * 64 + lane] = acc[w];
            __syncthreads();
            if (F.wave == 0) {
#pragma unroll
                for (int w = 0; w < 9; ++w) { float s = 0.f;
#pragma unroll
                    for (int wv = 0; wv < 8; ++wv) s += psum[(wv * 9 + w) * 64 + lane];
                    MOD[(size_t)(l * 9 + w) * 6144 + col] = s + a.in[I_ADAB][l * 6144 + col]; }
            }
            __syncthreads();
        }
    }
    {
        LAS float* scr = (LAS float*)(F.lds + F.wave * 16384);
        constexpr int IT_W1 = 16 * 64, IT_W2 = 16 * 32, IT_WIN = 16 * 216, IT_GLU = 8 * 32, IT_WBR = 8 * 32, IT_WOUT = 16 * 32;
        constexpr int N_W1 = 64 * IT_W1, N_W2 = 64 * IT_W2, N_WIN = 2 * IT_WIN, N_GLU = 2 * IT_GLU, N_WBR = 6 * IT_WBR, N_WOUT = 2 * IT_WOUT;
        constexpr int NITEMS = N_W1 + N_W2 + N_WIN + N_GLU + N_WBR + N_WOUT;
        for (int it = gw; it < NITEMS; it += NGW) {
            int r = it;
            if (r < N_W1) { const int mtx = r / IT_W1, l = mtx >> 5, e = mtx & 31; transpose_item<1>(a.in[I_W1] + (size_t)mtx * 1024 * 2048, 1024, 2048, (bf16*)(ws + WS_WTS + l * WL_STRIDE + WO_W1) + (size_t)e * 2048 * 1024, 1024, scr, r % IT_W1, lane); continue; } r -= N_W1;
            if (r < N_W2) { const int mtx = r / IT_W2, l = mtx >> 5, e = mtx & 31; transpose_item<0>(a.in[I_W2] + (size_t)mtx * 1024 * 1024, 1024, 1024, (bf16*)(ws + WS_WTS + l * WL_STRIDE + WO_W2) + (size_t)e * 1024 * 1024, 0, scr, r % IT_W2, lane); continue; } r -= N_W2;
            if (r < N_WIN) { const int l = r / IT_WIN; transpose_item<0>(a.in[I_WIN] + (size_t)l * 1024 * IN_COLS, 1024, IN_COLS, (bf16*)(ws + WS_WTS + l * WL_STRIDE + WO_WIN), 0, scr, r % IT_WIN, lane); continue; } r -= N_WIN;
            if (r < N_GLU) { const int l = r / IT_GLU; transpose_item<1>(a.in[I_S5GLUW] + (size_t)l * 512 * 1024, 512, 1024, (bf16*)(ws + WS_WTS + l * WL_STRIDE + WO_GLU), 512, scr, r % IT_GLU, lane); continue; } r -= N_GLU;
            if (r < N_WBR) { const int mtx = r / IT_WBR, l = mtx / 3, br = mtx % 3; transpose_item<0>(a.in[I_WBR] + (size_t)mtx * 512 * 1024, 512, 1024, (bf16*)(ws + WS_WTS + l * WL_STRIDE + WO_WBR) + (size_t)br * 1024 * 512, 0, scr, r % IT_WBR, lane); continue; } r -= N_WBR;
            { const int l = r / IT_WOUT; transpose_item<0>(a.in[I_WOUT] + (size_t)l * 1024 * 1024, 1024, 1024, (bf16*)(ws + WS_WTS + l * WL_STRIDE + WO_WOUT), 0, scr, r % IT_WOUT, lane); }
        }
        for (int i = F.bid * NTHREADS + F.tid; i < 2 * 2560 * 256; i += F.G * NTHREADS) {
            const int l = i / (2560 * 256), r = i % (2560 * 256), n = r >> 8, k = r & 255; float v = 0.f;
            if (n < 1024) { if (k < 64) v = a.in[I_RWWUP][(((size_t)l * 2 + (n >> 9)) * 64 + k) * 512 + (n & 511)]; }
            else if (n < 2048) { if (k >= 64 && k < 128) v = a.in[I_RWAUP][(((size_t)l * 2 + ((n - 1024) >> 9)) * 64 + (k - 64)) * 512 + (n & 511)]; }
            else { if (k >= 128) v = a.in[I_RWGUP][((size_t)l * 128 + (k - 128)) * 512 + (n - 2048)]; }
            ((bf16*)(ws + WS_WTS + l * WL_STRIDE + WO_RWCAT))[r] = (bf16)f2bf(v);
        }
    }
    __syncthreads();
    {
        LAS float* feats = (LAS float*)F.lds; LAS float* h1 = feats + 8 * 33; LAS float* h2 = h1 + 8 * 64;
        constexpr int NIT = 2 * (512 + 32);
        for (int it = F.bid; it < NIT; it += F.G) {
            const int l = it / 544, r = it % 544, nsel = r >= 512, n = nsel ? CTXL : SEQ, p0 = (nsel ? r - 512 : r) * 8;
            if (F.tid < 8 * 33) { const int p = F.tid / 33, i = F.tid % 33, pos = p0 + p; float f;
                if (i == 0) f = (float)pos / (float)(n - 1);
                else { const int k = (i - 1) & 15; const float band = 1e-4f + (float)k * ((15.0f - 1e-4f) / 15.0f); const float ang = (6.283185307179586f * (float)pos / (float)n) * band; f = (i <= 16) ? cosf(ang) : -sinf(ang); }
                feats[p * 33 + i] = f; }
            __syncthreads();
            { const int p = F.tid >> 6, j = F.tid & 63; float s = a.in[I_HYB1][l * 64 + j];
                for (int i = 0; i < 33; ++i) s += feats[p * 33 + i] * a.in[I_HYW1][((size_t)l * 33 + i) * 64 + j];
                h1[p * 64 + j] = sinf(a.in[I_HYF1][l * 64 + j] * s); }
            __syncthreads();
            { const int p = F.tid >> 6, j = F.tid & 63; float s = a.in[I_HYB2][l * 64 + j];
                for (int i = 0; i < 64; ++i) s += h1[p * 64 + i] * a.in[I_HYW2][((size_t)l * 64 + i) * 64 + j];
                h2[p * 64 + j] = sinf(a.in[I_HYF2][l * 64 + j] * s); }
            __syncthreads();
            float acc[4][8];
#pragma unroll
            for (int q = 0; q < 4; ++q)
#pragma unroll
                for (int p = 0; p < 8; ++p) acc[q][p] = 0.f;
            const float* w3 = a.in[I_HYW3] + (size_t)l * 64 * 2048 + F.tid;
            for (int i = 0; i < 64; ++i) { float wv[4];
#pragma unroll
                for (int q = 0; q < 4; ++q) wv[q] = w3[(size_t)i * 2048 + q * 512];
#pragma unroll
                for (int p = 0; p < 8; ++p) { const float hv = h2[p * 64 + i];
#pragma unroll
                    for (int q = 0; q < 4; ++q) acc[q][p] += hv * wv[q]; } }
            const int c = F.tid; const float dstart = logf(0.01f) / 1.5f, dstop = logf(0.01f) / 0.3f; const float delta = fabsf(dstart + (float)c * ((dstop - dstart) / 511.0f));
            const int RL = nsel ? HY_RLENC : HY_RLEN, off = n + 47;
            bf16* Rb = (bf16*)(ws + WS_GF + l * GF_STRIDE + (nsel ? GF_CTX : 0));
#pragma unroll
            for (int q = 0; q < 4; ++q) { const int o = q >> 1, side = q & 1; const float b3 = a.in[I_HYB3][l * 2048 + q * 512 + c];
                bf16* Rc = Rb + ((size_t)o * 512 + c) * RL;
#pragma unroll
                for (int p = 0; p < 8; ++p) { const int pos = p0 + p; const float t = (float)pos / (float)(n - 1); const float val = (acc[q][p] + b3) * expf(-t * delta);
                    if (side == 0) Rc[off - pos] = (bf16)f2bf(val);
                    else if (pos >= 1) Rc[off + pos] = (bf16)f2bf(val); }
                if (p0 == 0 && side == 0) { for (int m = 0; m < 48; ++m) Rc[m] = 0; for (int m = off + n; m < RL; ++m) Rc[m] = 0; } }
            __syncthreads();
        }
    }
}

__device__ __forceinline__ void stage_norm1(const Ctx& F, int l) {
    const auto& a = *F.a; unsigned char* ws = a.ws; const int lane = F.lane;
    const int gw = F.bid * NWAVES + F.wave, NGW = F.G * NWAVES;
    float* X = (float*)(ws + WS_X); bf16* H = (bf16*)(ws + WS_H); const float* MOD = (const float*)(ws + WS_MOD);
    const bf16* YS = (const bf16*)(ws + WS_XS); const int* POS = (const int*)(ws + WS_POS); const float* GATE = (const float*)(ws + WS_GATE);
    const int nrows = (l == DEPTH) ? T_LAT : T_ALL;
    for (int row = gw; row < nrows; row += NGW) {
        const int w = row < T_LAT ? (row >> 12) : 8;
        f32x4* xr = (f32x4*)(X + (size_t)row * D) + lane;
        f32x4 v[4];
#pragma unroll
        for (int j = 0; j < 4; ++j) v[j] = xr[64 * j];
        if (l > 0) {
            f32x4 mo[4];
#pragma unroll
            for (int j = 0; j < 4; ++j) mo[j] = (f32x4){0.f, 0.f, 0.f, 0.f};
#pragma unroll
            for (int k = 0; k < TOPK; ++k) { const int p = POS[row * 4 + k]; const float g = GATE[row * 4 + k];
                const v2u* yr = (const v2u*)(YS + (size_t)p * D) + lane;
#pragma unroll
                for (int j = 0; j < 4; ++j) { const v2u y = yr[64 * j]; mo[j][0] += g * bflo(y.x); mo[j][1] += g * bfhi(y.x); mo[j][2] += g * bflo(y.y); mo[j][3] += g * bfhi(y.y); } }
            const f32x4* g2 = (const f32x4*)(MOD + (size_t)((l - 1) * 9 + w) * 6144 + 5120) + lane;
#pragma unroll
            for (int j = 0; j < 4; ++j) { v[j] = v[j] + g2[64 * j] * mo[j]; xr[64 * j] = v[j]; }
        }
        float ss = 0.f;
#pragma unroll
        for (int j = 0; j < 4; ++j) ss += (v[j][0] * v[j][0] + v[j][1] * v[j][1]) + (v[j][2] * v[j][2] + v[j][3] * v[j][3]);
        const float rstd = 1.0f / sqrtf(wave_sum(ss) * (1.f / D) + 1e-6f);
        if (l == DEPTH) {
            const f32x4* fg = (const f32x4*)a.in[I_FING] + lane; f32x4* o = (f32x4*)(a.out + (size_t)row * D) + lane;
#pragma unroll
            for (int j = 0; j < 4; ++j) o[64 * j] = v[j] * rstd * fg[64 * j];
        } else {
            const f32x4* ng = (const f32x4*)(a.in[I_N1G] + l * D) + lane;
            const f32x4* sh = (const f32x4*)(MOD + (size_t)(l * 9 + w) * 6144) + lane; const f32x4* sc = (const f32x4*)(MOD + (size_t)(l * 9 + w) * 6144 + 1024) + lane;
            v2u* ho = (v2u*)(H + (size_t)row * D) + lane;
#pragma unroll
            for (int j = 0; j < 4; ++j) { const f32x4 h = v[j] * rstd * ng[64 * j] * (sc[64 * j] + 1.0f) + sh[64 * j]; v2u o; o.x = pk2(h[0], h[1]); o.y = pk2(h[2], h[3]); ho[64 * j] = o; }
        }
    }
}

__device__ __forceinline__ void stage_rw_prep1(const Ctx& F, int l) {
    const auto& a = *F.a; unsigned char* ws = a.ws;
    const bf16* Z = (const bf16*)(ws + WS_Z); bf16* ARW = (bf16*)(ws + WS_ARW);
    const int j = F.tid & 255, col = 1536 + j;
    const float* cw = a.in[I_RWCW] + (size_t)l * 3 * 1792; const float w0 = cw[col], w1 = cw[1792 + col], w2 = cw[2 * 1792 + col], cb = a.in[I_RWCB][l * 1792 + col];
    for (int row = F.bid * 2 + (F.tid >> 8); row < T_ALL; row += F.G * 2) {
        int base, pos, n; row_seq(row, base, pos, n);
        float v = conv3z(Z + (size_t)base * IN_COLS + RW_OFF + col, pos, n, w0, w1, w2, cb);
        if (j < 64) v = tanhf(v); else if (j >= 128) v = sigm(v);
        ARW[(size_t)row * 256 + j] = (bf16)f2bf(v);
    }
}

__device__ __forceinline__ void stage_rw_prep2(const Ctx& F, int l) {
    const auto& a = *F.a; unsigned char* ws = a.ws; const int lane = F.lane;
    const bf16* Z = (const bf16*)(ws + WS_Z); const bf16* P = (const bf16*)(ws + WS_P); bf16* SCN = (bf16*)(ws + WS_SCN);
    const int gw = F.bid * NWAVES + F.wave, NGW = F.G * NWAVES;
    constexpr int TR = 17, NRT = T_ALL / TR;
    const float* cw = a.in[I_RWCW] + (size_t)l * 3 * 1792; const float* cbp = a.in[I_RWCB] + l * 1792;
    for (int tile = gw; tile < NRT * 4; tile += NGW) {
        const int rt = tile % NRT, hp = tile / NRT, row0 = rt * TR, c0 = hp * 128 + 2 * lane;
        f32x2 w[3][3], cb[3];
#pragma unroll
        for (int s = 0; s < 3; ++s) { cb[s] = *(const f32x2*)(cbp + s * 512 + c0);
#pragma unroll
            for (int j = 0; j < 3; ++j) w[s][j] = *(const f32x2*)(cw + j * 1792 + s * 512 + c0); }
        const f32x2 KKw = *(const f32x2*)(a.in[I_RWKK] + l * 512 + c0), KAw = *(const f32x2*)(a.in[I_RWKA] + l * 512 + c0);
        f32x2 W0[2], A0[2];
#pragma unroll
        for (int d = 0; d < 2; ++d) { W0[d] = *(const f32x2*)(a.in[I_RWW0] + (l * 2 + d) * 512 + c0); A0[d] = *(const f32x2*)(a.in[I_RWA0] + (l * 2 + d) * 512 + c0); }
        const unsigned* zb = (const unsigned*)(Z + RW_OFF + c0);
        unsigned zm[3], z0[3], zp[3];
#pragma unroll
        for (int s = 0; s < 3; ++s) { zm[s] = row0 > 0 ? zb[(size_t)(row0 - 1) * (IN_COLS / 2) + s * 256] : 0u; z0[s] = zb[(size_t)row0 * (IN_COLS / 2) + s * 256]; }
#pragma unroll 1
        for (int i = 0; i < TR; ++i) {
            const int row = row0 + i; int base, pos, n; row_seq(row, base, pos, n);
#pragma unroll
            for (int s = 0; s < 3; ++s) zp[s] = (row + 1 < T_ALL) ? zb[(size_t)(row + 1) * (IN_COLS / 2) + s * 256] : 0u;
            const float mlo = pos > 0 ? 1.f : 0.f, mhi = pos < n - 1 ? 1.f : 0.f;
            f32x2 u[3];
#pragma unroll
            for (int s = 0; s < 3; ++s) { u[s] = (f32x2){bflo(zm[s]), bfhi(zm[s])} * mlo * w[s][0] + (f32x2){bflo(z0[s]), bfhi(z0[s])} * w[s][1] + (f32x2){bflo(zp[s]), bfhi(zp[s])} * mhi * w[s][2] + cb[s]; zm[s] = z0[s]; z0[s] = zp[s]; }
            const f32x2 r = u[0], k = u[1], v = u[2];
            f32x2 kk = k * KKw;
            const float ss = red32(kk[0] * kk[0] + kk[1] * kk[1]);
            kk = kk * (1.0f / sqrtf(fmaxf(ss, 1e-24f)));
            const unsigned* pr = (const unsigned*)(P + (size_t)row * 2560 + c0);
            unsigned* o = (unsigned*)(SCN + (size_t)row * 9 * 512 + c0);
            o[0] = pk2(r[0], r[1]); o[256] = pk2(v[0], v[1]); o[2 * 256] = pk2(kk[0], kk[1]);
#pragma unroll
            for (int d = 0; d < 2; ++d) {
                const unsigned pw = pr[d * 256], pa = pr[512 + d * 256];
                float ld[2], kd[2], be[2];
#pragma unroll
                for (int e = 0; e < 2; ++e) {
                    const float uu = W0[d][e] + (e ? bfhi(pw) : bflo(pw));
                    ld[e] = -0.60653065971263342f * sigm(uu);
                    const float av = sigm(A0[d][e] + (e ? bfhi(pa) : bflo(pa)));
                    kd[e] = k[e] * (1.f + (av - 1.f) * KAw[e]); be[e] = kk[e] * av; }
                o[(3 + 3 * d) * 256] = pk2(ld[0], ld[1]); o[(4 + 3 * d) * 256] = pk2(kd[0], kd[1]); o[(5 + 3 * d) * 256] = pk2(be[0], be[1]);
            }
        }
    }
}

__device__ __forceinline__ int seq_row(int b, int d, int sidx) {
    if (sidx < CTXL) { const int t = d ? (CTXL - 1 - sidx) : sidx; return T_LAT + b * CTXL + t; }
    const int tl = sidx - CTXL; const int t = d ? (SEQ - 1 - tl) : tl; return b * SEQ + t;
}

constexpr int CW_WORK = 16384;
constexpr int CW_STAMP = 20480;
#ifdef PROBE_T
#ifndef PROBE_BID
#define PROBE_BID 0
#endif
#define PT(k) do { if (F.bid == PROBE_BID && F.tid == 0 && l == 0) ((unsigned long long*)(F.a->ws + WS_CTL + CW_STAMP * 4))[k] = __builtin_amdgcn_s_memrealtime(); } while (0)
#else
#define PT(k) do { } while (0)
#endif
__device__ __forceinline__ void rw_scan_item(const Ctx& F, int l, int it2) {
    const int it = it2 >> 1, half = it2 & 1;
    const auto& a = *F.a; unsigned char* ws = a.ws; const int tid = F.tid, lane = F.lane;
    const bf16* SCN = (const bf16*)(ws + WS_SCN); float* YD = (float*)(ws + WS_YDIR);
    LAS float* sbuf = (LAS float*)F.lds;
    LAS float* ybuf = (LAS float*)(F.lds + 49152);
    const bool comp = F.wave < 4;
    const int lt = tid & 255, ls = lt >> 4, lj = lt & 15;
    const int vl = lane >> 3, kq = lane & 7, vrow = half * 32 + (F.wave & 3) * 8 + vl;
    constexpr int NCH = (CTXL + SEQ) / 16;
    const int d = it & 1, h = (it >> 1) & 7, b = it >> 4;
    f32x2 S[4];
#pragma unroll
    for (int q = 0; q < 4; ++q) S[q] = (f32x2){0.f, 0.f};
    v2u ldr[6];
#define RW_ISSUE(c) do { const int row_ = seq_row(b, d, (c) * 16 + ls); const v2u* p_ = (const v2u*)(SCN + (size_t)row_ * 9 * 512 + h * 64) + lj; \
        ldr[0] = p_[2 * 128]; ldr[1] = p_[(3 + 3 * d) * 128]; ldr[2] = p_[(5 + 3 * d) * 128]; ldr[3] = p_[(4 + 3 * d) * 128]; ldr[4] = p_[0]; ldr[5] = p_[128]; } while (0)
#define RW_WRITE(bufi) do { LAS float* o_ = sbuf + (((bufi) * 16 + ls) * 6) * 64 + 4 * lj; \
        *(LAS f32x4*)(o_) = (f32x4){-bflo(ldr[0].x), -bfhi(ldr[0].x), -bflo(ldr[0].y), -bfhi(ldr[0].y)}; \
        *(LAS f32x4*)(o_ + 64) = (f32x4){__expf(bflo(ldr[1].x)), __expf(bfhi(ldr[1].x)), __expf(bflo(ldr[1].y)), __expf(bfhi(ldr[1].y))}; \
        *(LAS f32x4*)(o_ + 128) = (f32x4){bflo(ldr[2].x), bfhi(ldr[2].x), bflo(ldr[2].y), bfhi(ldr[2].y)}; *(LAS f32x4*)(o_ + 192) = (f32x4){bflo(ldr[3].x), bfhi(ldr[3].x), bflo(ldr[3].y), bfhi(ldr[3].y)}; \
        *(LAS f32x4*)(o_ + 256) = (f32x4){bflo(ldr[4].x), bfhi(ldr[4].x), bflo(ldr[4].y), bfhi(ldr[4].y)}; *(LAS f32x4*)(o_ + 320) = (f32x4){bflo(ldr[5].x), bfhi(ldr[5].x), bflo(ldr[5].y), bfhi(ldr[5].y)}; } while (0)
#define RW_FLUSH(c) do { const int row_ = seq_row(b, d, (c) * 16 + ls); \
        *(f32x2*)(YD + ((size_t)d * T_ALL + row_) * 512 + h * 64 + half * 32 + 2 * lj) = *(const LAS f32x2*)(ybuf + ((((c) & 1) * 16 + ls) * 64) + half * 32 + 2 * lj); } while (0)
    if (!comp) { RW_ISSUE(0); RW_WRITE(0); RW_ISSUE(1); }
    __syncthreads();
#pragma unroll 1
    for (int c = 0; c < NCH; ++c) {
        const int bi = c & 1;
        if (!comp) {
            if (c + 1 < NCH) RW_WRITE(bi ^ 1);
            if (c + 2 < NCH) RW_ISSUE(c + 2);
            if (c > 0) RW_FLUSH(c - 1);
        } else {
        float yv[16];
        f32x4 opA[10], opB[10]; float vvA, vvB;
#define RW_LD(op, vvx, s_) do { const LAS float* sp_ = sbuf + ((bi * 16 + (s_)) * 6) * 64 + 8 * kq; \
            _Pragma("unroll") for (int q_ = 0; q_ < 5; ++q_) { op[2 * q_] = *(const LAS f32x4*)(sp_ + 64 * q_); op[2 * q_ + 1] = *(const LAS f32x4*)(sp_ + 64 * q_ + 4); } \
            vvx = sbuf[((bi * 16 + (s_)) * 6 + 5) * 64 + vrow]; } while (0)
#define RW_COMP(op, vvx, s_) do { \
            const f32x4 a0 = op[0], a1 = op[1], w0 = op[2], w1 = op[3], b0 = op[4], b1 = op[5], k0 = op[6], k1 = op[7], r0 = op[8], r1 = op[9]; \
            const f32x2 vv2 = (f32x2){vvx, vvx}; \
            const f32x2 p0 = S[1] * (f32x2){a0[2], a0[3]} + S[0] * (f32x2){a0[0], a0[1]}; \
            const f32x2 p1 = S[3] * (f32x2){a1[2], a1[3]} + S[2] * (f32x2){a1[0], a1[1]}; \
            const f32x2 t0 = S[0] * (f32x2){w0[0], w0[1]} + vv2 * (f32x2){k0[0], k0[1]}; \
            const f32x2 t1 = S[1] * (f32x2){w0[2], w0[3]} + vv2 * (f32x2){k0[2], k0[3]}; \
            const f32x2 t2 = S[2] * (f32x2){w1[0], w1[1]} + vv2 * (f32x2){k1[0], k1[1]}; \
            const f32x2 t3 = S[3] * (f32x2){w1[2], w1[3]} + vv2 * (f32x2){k1[2], k1[3]}; \
            const f32x2 ac = p0 + p1; \
            const float sa = red8(ac[0] + ac[1]); \
            const f32x2 sa2 = (f32x2){sa, sa}; \
            S[0] = sa2 * (f32x2){b0[0], b0[1]} + t0; S[1] = sa2 * (f32x2){b0[2], b0[3]} + t1; \
            S[2] = sa2 * (f32x2){b1[0], b1[1]} + t2; S[3] = sa2 * (f32x2){b1[2], b1[3]} + t3; \
            const f32x2 q0 = S[1] * (f32x2){r0[2], r0[3]} + S[0] * (f32x2){r0[0], r0[1]}; \
            const f32x2 q1 = S[3] * (f32x2){r1[2], r1[3]} + S[2] * (f32x2){r1[0], r1[1]}; \
            const f32x2 yc = q0 + q1; \
            yv[s_] = red8(yc[0] + yc[1]); } while (0)
        RW_LD(opA, vvA, 0);
#pragma unroll
        for (int s = 0; s < 16; s += 2) {
            RW_LD(opB, vvB, s + 1);
            __builtin_amdgcn_sched_barrier(0);
            RW_COMP(opA, vvA, s);
            __builtin_amdgcn_sched_barrier(0);
            if (s + 2 < 16) RW_LD(opA, vvA, s + 2);
            __builtin_amdgcn_sched_barrier(0);
            RW_COMP(opB, vvB, s + 1);
            __builtin_amdgcn_sched_barrier(0);
        }
#undef RW_LD
#undef RW_COMP
#pragma unroll
        for (int s = 0; s < 16; ++s) if ((s & 7) == kq) ybuf[((bi * 16 + s) * 64) + vrow] = yv[s];
        }
        __syncthreads();
    }
    if (!comp) RW_FLUSH(NCH - 1);
    __syncthreads();
#undef RW_ISSUE
#undef RW_WRITE
#undef RW_FLUSH
}

constexpr size_t WS_RWSCR = WS_YHY;
constexpr int RWS_QY = 0, RWS_YV = 2048, RWS_PZ = 4096, RWS_ZV = 12288, RWS_SLOT = 20480;
typedef __bf16 bf16x8n __attribute__((ext_vector_type(8)));
__device__ __forceinline__ f32x4 mma16(const bf16x8 a, const bf16x8 b, const f32x4 c) { return __builtin_amdgcn_mfma_f32_16x16x32_bf16(a, b, c, 0, 0, 0); }
__device__ __forceinline__ float dpp_shr(float x, const int n) {
    const int v = __builtin_bit_cast(int, x); int r;
    if (n == 1) r = __builtin_amdgcn_update_dpp(0, v, 0x111, 0xF, 0xF, true); else if (n == 2) r = __builtin_amdgcn_update_dpp(0, v, 0x112, 0xF, 0xF, true);
    else if (n == 4) r = __builtin_amdgcn_update_dpp(0, v, 0x114, 0xF, 0xF, true); else r = __builtin_amdgcn_update_dpp(0, v, 0x118, 0xF, 0xF, true);
    return __builtin_bit_cast(float, r);
}
__device__ __forceinline__ v4u pack8(const float (&x)[8]) { v4u o; o.x = pk2(x[0], x[1]); o.y = pk2(x[2], x[3]); o.z = pk2(x[4], x[5]); o.w = pk2(x[6], x[7]); return o; }
__device__ __forceinline__ void unpack8(const v4u u, float (&x)[8]) { x[0] = bflo(u.x); x[1] = bfhi(u.x); x[2] = bflo(u.y); x[3] = bfhi(u.y); x[4] = bflo(u.z); x[5] = bfhi(u.z); x[6] = bflo(u.w); x[7] = bfhi(u.w); }
__device__ __forceinline__ bf16x8 frag16(const LAS bf16* m, int rowbase, int lane) {
    v4u v = (v4u){0u, 0u, 0u, 0u}; if ((lane >> 4) < 2) v = *(const LAS v4u*)(m + (rowbase + (lane & 15)) * 16 + 8 * (lane >> 4)); return __builtin_bit_cast(bf16x8, v); }
__device__ __forceinline__ void st_colmaj(LAS bf16* m, int colbase, const f32x4 d, int lane) {
    v2u o; o.x = pk2(d[0], d[1]); o.y = pk2(d[2], d[3]); *(LAS v2u*)(m + (colbase + (lane & 15)) * 16 + 4 * (lane >> 4)) = o; }
__device__ __forceinline__ void st_rowmaj(LAS bf16* m, const f32x4 d, int lane) {
#pragma unroll
    for (int r = 0; r < 4; ++r) m[(4 * (lane >> 4) + r) * 16 + (lane & 15)] = (bf16)f2bf(d[r]); }
template <int KS0, int KS1>
__device__ __forceinline__ void rw_chunk_load(const Ctx& F, int b, int h, int d, int cidx, v4u (&raw)[12]) {
    const int lane = opaque_v(F.lane), t = lane & 15, kg = lane >> 4;
    const bf16* base = (const bf16*)(F.a->ws + WS_SCN) + (size_t)seq_row(b, d, 16 * cidx + t) * 9 * 512 + h * 64;
#pragma unroll
    for (int ks = KS0; ks < KS1; ++ks) { const int off = 32 * ks + 8 * kg;
        raw[6 * ks + 0] = *(const v4u*)(base + (3 + 3 * d) * 512 + off); raw[6 * ks + 1] = *(const v4u*)(base + 2 * 512 + off); raw[6 * ks + 2] = *(const v4u*)(base + off);
        raw[6 * ks + 3] = *(const v4u*)(base + (5 + 3 * d) * 512 + off); raw[6 * ks + 4] = *(const v4u*)(base + (4 + 3 * d) * 512 + off); raw[6 * ks + 5] = *(const v4u*)(base + 512 + off); }
}
__device__ __forceinline__ void rw_chunk_task(const Ctx& F, const v4u (&raw)[12], LAS unsigned char* wl, unsigned char* slot) {
    const int lane = opaque_v(F.lane), t = lane & 15, kg = lane >> 4;
    LAS bf16* ATt = (LAS bf16*)(wl); LAS bf16* RBr = (LAS bf16*)(wl + 2048); LAS bf16* BHt = (LAS bf16*)(wl + 4096); LAS bf16* KHt = (LAS bf16*)(wl + 6144); LAS bf16* VTt = (LAS bf16*)(wl + 8192);
    LAS bf16* WAt = (LAS bf16*)(wl + 10240); LAS bf16* N_r = (LAS bf16*)(wl + 12288); LAS bf16* N_c = (LAS bf16*)(wl + 12800); LAS bf16* T_r = (LAS bf16*)(wl + 13312);
    LAS bf16* AK_r = (LAS bf16*)(wl + 13824); LAS bf16* RB2 = (LAS bf16*)(wl + 14336); LAS bf16* RK_r = (LAS bf16*)(wl + 14848); LAS float* GCl = (LAS float*)(wl + 15360);
    bf16x8 fAb[2], fRb[2], fBb[2], fKb[2];
#pragma unroll
    for (int ks = 0; ks < 2; ++ks) {
        const int off = 32 * ks + 8 * kg;
        float ea[8], er[8], eb[8], eh[8];
        { const v4u uld = raw[6 * ks + 0]; float ld[8]; unpack8(uld, ld);
#pragma unroll
          for (int j = 0; j < 8; ++j) { float c = ld[j]; c += dpp_shr(c, 1); c += dpp_shr(c, 2); c += dpp_shr(c, 4); c += dpp_shr(c, 8);
              const float tot = __builtin_bit_cast(float, __builtin_amdgcn_ds_bpermute((lane | 15) << 2, __builtin_bit_cast(int, c)));
              ea[j] = __expf(c - ld[j]); er[j] = __expf(c); eb[j] = __expf(-c); eh[j] = __expf(tot - c);
              if (t == 0) GCl[off + j] = __expf(tot); } }
        { const v4u u = raw[6 * ks + 1]; float x[8]; unpack8(u, x);
#pragma unroll
          for (int j = 0; j < 8; ++j) { x[j] = -x[j] * ea[j]; ATt[(off + j) * 16 + t] = (bf16)f2bf(x[j]); }
          const v4u p = pack8(x); fAb[ks] = __builtin_bit_cast(bf16x8, p); }
        { const v4u u = raw[6 * ks + 2]; float x[8]; unpack8(u, x);
#pragma unroll
          for (int j = 0; j < 8; ++j) x[j] = x[j] * er[j];
          const v4u p = pack8(x); fRb[ks] = __builtin_bit_cast(bf16x8, p); *(LAS v4u*)(RBr + t * 64 + off) = p; }
        { const v4u u = raw[6 * ks + 3]; float x[8], y[8]; unpack8(u, x);
#pragma unroll
          for (int j = 0; j < 8; ++j) { y[j] = x[j] * eb[j]; BHt[(off + j) * 16 + t] = (bf16)f2bf(x[j] * eh[j]); }
          const v4u p = pack8(y); fBb[ks] = __builtin_bit_cast(bf16x8, p); }
        { const v4u u = raw[6 * ks + 4]; float x[8], y[8]; unpack8(u, x);
#pragma unroll
          for (int j = 0; j < 8; ++j) { y[j] = x[j] * eb[j]; KHt[(off + j) * 16 + t] = (bf16)f2bf(x[j] * eh[j]); }
          const v4u p = pack8(y); fKb[ks] = __builtin_bit_cast(bf16x8, p); }
        { const v4u u = raw[6 * ks + 5];
          const bf16 e0 = (bf16)(u.x & 0xffff), e1 = (bf16)(u.x >> 16), e2 = (bf16)(u.y & 0xffff), e3 = (bf16)(u.y >> 16), e4 = (bf16)(u.z & 0xffff), e5 = (bf16)(u.z >> 16), e6 = (bf16)(u.w & 0xffff), e7 = (bf16)(u.w >> 16);
          VTt[(off + 0) * 16 + t] = e0; VTt[(off + 1) * 16 + t] = e1; VTt[(off + 2) * 16 + t] = e2; VTt[(off + 3) * 16 + t] = e3; VTt[(off + 4) * 16 + t] = e4; VTt[(off + 5) * 16 + t] = e5; VTt[(off + 6) * 16 + t] = e6; VTt[(off + 7) * 16 + t] = e7; }
        __builtin_amdgcn_sched_barrier(0);
    }
    asm volatile("" ::: "memory");
    const f32x4 z4 = (f32x4){0.f, 0.f, 0.f, 0.f};
    f32x4 n0 = mma16(fAb[1], fBb[1], mma16(fAb[0], fBb[0], z4)), aak = mma16(fAb[1], fKb[1], mma16(fAb[0], fKb[0], z4));
    f32x4 arb = mma16(fRb[1], fBb[1], mma16(fRb[0], fBb[0], z4)), ark = mma16(fRb[1], fKb[1], mma16(fRb[0], fKb[0], z4));
#pragma unroll
    for (int r = 0; r < 4; ++r) { const int tt = 4 * kg + r; if (!(t < tt)) { n0[r] = 0.f; aak[r] = 0.f; } if (!(t <= tt)) { arb[r] = 0.f; ark[r] = 0.f; } }
    st_rowmaj(AK_r, aak, lane); st_rowmaj(RB2, arb, lane); st_rowmaj(RK_r, ark, lane); asm volatile("" ::: "memory");
    f32x4 accT = n0;
#pragma unroll
    for (int r = 0; r < 4; ++r) accT[r] += (4 * kg + r == t) ? 1.f : 0.f;
    f32x4 nn = n0;
#pragma unroll
    for (int itn = 0; itn < 3; ++itn) {
        st_rowmaj(N_r, nn, lane); st_colmaj(N_c, 0, nn, lane); st_rowmaj(T_r, accT, lane); asm volatile("" ::: "memory");
        const bf16x8 fa = frag16(N_r, 0, lane), fb = frag16(N_c, 0, lane), ft = frag16(T_r, 0, lane);
        nn = mma16(fa, fb, z4); asm volatile("" ::: "memory");
        st_colmaj(N_c, 0, nn, lane); asm volatile("" ::: "memory");
        const bf16x8 fb2 = frag16(N_c, 0, lane);
        accT = mma16(ft, fb2, accT); asm volatile("" ::: "memory");
    }
    st_rowmaj(T_r, accT, lane); asm volatile("" ::: "memory");
    const bf16x8 fT = frag16(T_r, 0, lane), fAK = frag16(AK_r, 0, lane), fARB = frag16(RB2, 0, lane), fARK = frag16(RK_r, 0, lane);
#pragma unroll
    for (int kt = 0; kt < 4; ++kt) { const f32x4 dd = mma16(fT, frag16(ATt, 16 * kt, lane), z4); st_colmaj(WAt, 16 * kt, dd, lane); } asm volatile("" ::: "memory");
    { const bf16x8 fArbT = frag16(RB2, 0, lane);
#pragma unroll
      for (int kt = 0; kt < 4; ++kt) { const v2u ri = *(const LAS v2u*)(RBr + t * 64 + 16 * kt + 4 * kg);
          f32x4 c0 = (f32x4){bflo(ri.x), bfhi(ri.x), bflo(ri.y), bfhi(ri.y)};
          c0 = mma16(frag16(WAt, 16 * kt, lane), fArbT, c0);
          v2u o; o.x = pk2(c0[0], c0[1]); o.y = pk2(c0[2], c0[3]); *(v2u*)(slot + RWS_QY + (t * 64 + 16 * kt + 4 * kg) * 2) = o; } }
    asm volatile("" ::: "memory");
#pragma unroll
    for (int vt = 0; vt < 4; ++vt) { const f32x4 dd = mma16(fAK, frag16(VTt, 16 * vt, lane), z4); st_colmaj(ATt, 16 * vt, dd, lane); } asm volatile("" ::: "memory");
    asm volatile("" ::: "memory");
    LAS bf16* UVt = RBr;
#pragma unroll
    for (int vt = 0; vt < 4; ++vt) { const f32x4 dd = mma16(fT, frag16(ATt, 16 * vt, lane), z4); st_colmaj(UVt, 16 * vt, dd, lane); } asm volatile("" ::: "memory");
#pragma unroll
    for (int vt = 0; vt < 4; ++vt) { const f32x4 dd = mma16(fARK, frag16(VTt, 16 * vt, lane), mma16(fARB, frag16(UVt, 16 * vt, lane), z4));
        v2u o; o.x = pk2(dd[0], dd[1]); o.y = pk2(dd[2], dd[3]); *(v2u*)(slot + RWS_YV + ((16 * vt + t) * 16 + 4 * kg) * 2) = o; }
#pragma unroll
    for (int ktp = 0; ktp < 4; ++ktp) { const bf16x8 fBh = frag16(BHt, 16 * ktp, lane);
#pragma unroll
        for (int kt = 0; kt < 4; ++kt) { f32x4 dd = mma16(frag16(WAt, 16 * kt, lane), fBh, z4);
            if (kt == ktp) {
#pragma unroll
                for (int r = 0; r < 4; ++r) if (4 * kg + r == t) dd[r] += GCl[16 * kt + t]; }
            v2u o; o.x = pk2(dd[0], dd[1]); o.y = pk2(dd[2], dd[3]); *(v2u*)(slot + RWS_PZ + ((16 * ktp + t) * 64 + 16 * kt + 4 * kg) * 2) = o; } }
#pragma unroll
    for (int vt = 0; vt < 4; ++vt) { const bf16x8 fU = frag16(UVt, 16 * vt, lane), fV = frag16(VTt, 16 * vt, lane);
#pragma unroll
        for (int ktp = 0; ktp < 4; ++ktp) { const f32x4 dd = mma16(frag16(KHt, 16 * ktp, lane), fV, mma16(frag16(BHt, 16 * ktp, lane), fU, z4));
            v2u o; o.x = pk2(dd[0], dd[1]); o.y = pk2(dd[2], dd[3]); *(v2u*)(slot + RWS_ZV + ((16 * vt + t) * 64 + 16 * ktp + 4 * kg) * 2) = o; } }
}
__device__ __forceinline__ void rw_chunk_task2(const Ctx& F, const v4u (&raw)[12], LAS unsigned char* wl, f32x4 (&yv)[4], f32x4 (&zv)[4][4]) {
    const int lane = opaque_v(F.lane), t = lane & 15, kg = lane >> 4;
    LAS bf16* ATt = (LAS bf16*)(wl); LAS bf16* RBr = (LAS bf16*)(wl + 2048); LAS bf16* BHt = (LAS bf16*)(wl + 4096); LAS bf16* KHt = (LAS bf16*)(wl + 6144); LAS bf16* VTt = (LAS bf16*)(wl + 8192);
    LAS bf16* WAt = (LAS bf16*)(wl + 10240); LAS bf16* N_r = (LAS bf16*)(wl + 12288); LAS bf16* N_c = (LAS bf16*)(wl + 12800); LAS bf16* T_r = (LAS bf16*)(wl + 13312);
    LAS bf16* AK_r = (LAS bf16*)(wl + 13824); LAS bf16* RB2 = (LAS bf16*)(wl + 14336); LAS bf16* RK_r = (LAS bf16*)(wl + 14848); LAS float* GCl = (LAS float*)(wl + 15360);
    bf16x8 fAb[2], fRb[2], fBb[2], fKb[2];
#pragma unroll
    for (int ks = 0; ks < 2; ++ks) {
        const int off = 32 * ks + 8 * kg;
        float ea[8], er[8], eb[8], eh[8];
        { const v4u uld = raw[6 * ks + 0]; float ld[8]; unpack8(uld, ld);
#pragma unroll
          for (int j = 0; j < 8; ++j) { float c = ld[j]; c += dpp_shr(c, 1); c += dpp_shr(c, 2); c += dpp_shr(c, 4); c += dpp_shr(c, 8);
              const float tot = __builtin_bit_cast(float, __builtin_amdgcn_ds_bpermute((lane | 15) << 2, __builtin_bit_cast(int, c)));
              ea[j] = __expf(c - ld[j]); er[j] = __expf(c); eb[j] = __expf(-c); eh[j] = __expf(tot - c);
              if (t == 0) GCl[off + j] = __expf(tot); } }
        { const v4u u = raw[6 * ks + 1]; float x[8]; unpack8(u, x);
#pragma unroll
          for (int j = 0; j < 8; ++j) { x[j] = -x[j] * ea[j]; ATt[(off + j) * 16 + t] = (bf16)f2bf(x[j]); }
          const v4u p = pack8(x); fAb[ks] = __builtin_bit_cast(bf16x8, p); }
        { const v4u u = raw[6 * ks + 2]; float x[8]; unpack8(u, x);
#pragma unroll
          for (int j = 0; j < 8; ++j) x[j] = x[j] * er[j];
          const v4u p = pack8(x); fRb[ks] = __builtin_bit_cast(bf16x8, p); *(LAS v4u*)(RBr + t * 64 + off) = p; }
        { const v4u u = raw[6 * ks + 3]; float x[8], y[8]; unpack8(u, x);
#pragma unroll
          for (int j = 0; j < 8; ++j) { y[j] = x[j] * eb[j]; BHt[(off + j) * 16 + t] = (bf16)f2bf(x[j] * eh[j]); }
          const v4u p = pack8(y); fBb[ks] = __builtin_bit_cast(bf16x8, p); }
        { const v4u u = raw[6 * ks + 4]; float x[8], y[8]; unpack8(u, x);
#pragma unroll
          for (int j = 0; j < 8; ++j) { y[j] = x[j] * eb[j]; KHt[(off + j) * 16 + t] = (bf16)f2bf(x[j] * eh[j]); }
          const v4u p = pack8(y); fKb[ks] = __builtin_bit_cast(bf16x8, p); }
        { const v4u u = raw[6 * ks + 5];
          const bf16 e0 = (bf16)(u.x & 0xffff), e1 = (bf16)(u.x >> 16), e2 = (bf16)(u.y & 0xffff), e3 = (bf16)(u.y >> 16), e4 = (bf16)(u.z & 0xffff), e5 = (bf16)(u.z >> 16), e6 = (bf16)(u.w & 0xffff), e7 = (bf16)(u.w >> 16);
          VTt[(off + 0) * 16 + t] = e0; VTt[(off + 1) * 16 + t] = e1; VTt[(off + 2) * 16 + t] = e2; VTt[(off + 3) * 16 + t] = e3; VTt[(off + 4) * 16 + t] = e4; VTt[(off + 5) * 16 + t] = e5; VTt[(off + 6) * 16 + t] = e6; VTt[(off + 7) * 16 + t] = e7; }
        __builtin_amdgcn_sched_barrier(0);
    }
    asm volatile("" ::: "memory");
    const f32x4 z4 = (f32x4){0.f, 0.f, 0.f, 0.f};
    f32x4 n0 = mma16(fAb[1], fBb[1], mma16(fAb[0], fBb[0], z4)), aak = mma16(fAb[1], fKb[1], mma16(fAb[0], fKb[0], z4));
    f32x4 arb = mma16(fRb[1], fBb[1], mma16(fRb[0], fBb[0], z4)), ark = mma16(fRb[1], fKb[1], mma16(fRb[0], fKb[0], z4));
#pragma unroll
    for (int r = 0; r < 4; ++r) { const int tt = 4 * kg + r; if (!(t < tt)) { n0[r] = 0.f; aak[r] = 0.f; } if (!(t <= tt)) { arb[r] = 0.f; ark[r] = 0.f; } }
    st_rowmaj(AK_r, aak, lane); st_rowmaj(RB2, arb, lane); st_rowmaj(RK_r, ark, lane); asm volatile("" ::: "memory");
    f32x4 accT = n0;
#pragma unroll
    for (int r = 0; r < 4; ++r) accT[r] += (4 * kg + r == t) ? 1.f : 0.f;
    f32x4 nn = n0;
#pragma unroll
    for (int itn = 0; itn < 3; ++itn) {
        st_rowmaj(N_r, nn, lane); st_colmaj(N_c, 0, nn, lane); st_rowmaj(T_r, accT, lane); asm volatile("" ::: "memory");
        const bf16x8 fa = frag16(N_r, 0, lane), fb = frag16(N_c, 0, lane), ft = frag16(T_r, 0, lane);
        nn = mma16(fa, fb, z4); asm volatile("" ::: "memory");
        st_colmaj(N_c, 0, nn, lane); asm volatile("" ::: "memory");
        const bf16x8 fb2 = frag16(N_c, 0, lane);
        accT = mma16(ft, fb2, accT); asm volatile("" ::: "memory");
    }
    st_rowmaj(T_r, accT, lane); asm volatile("" ::: "memory");
    const bf16x8 fT = frag16(T_r, 0, lane), fAK = frag16(AK_r, 0, lane), fARB = frag16(RB2, 0, lane), fARK = frag16(RK_r, 0, lane);
#pragma unroll
    for (int kt = 0; kt < 4; ++kt) { const f32x4 dd = mma16(fT, frag16(ATt, 16 * kt, lane), z4); st_colmaj(WAt, 16 * kt, dd, lane); } asm volatile("" ::: "memory");
    f32x4 qy[4];
    { const bf16x8 fArbT = frag16(RB2, 0, lane);
#pragma unroll
      for (int kt = 0; kt < 4; ++kt) { const v2u ri = *(const LAS v2u*)(RBr + t * 64 + 16 * kt + 4 * kg);
          qy[kt] = mma16(frag16(WAt, 16 * kt, lane), fArbT, (f32x4){bflo(ri.x), bfhi(ri.x), bflo(ri.y), bfhi(ri.y)}); } }
    asm volatile("" ::: "memory");
#pragma unroll
    for (int vt = 0; vt < 4; ++vt) { const f32x4 dd = mma16(fAK, frag16(VTt, 16 * vt, lane), z4); st_colmaj(ATt, 16 * vt, dd, lane); } asm volatile("" ::: "memory");
    LAS bf16* UVt = RBr;
#pragma unroll
    for (int vt = 0; vt < 4; ++vt) { const f32x4 dd = mma16(fT, frag16(ATt, 16 * vt, lane), z4); st_colmaj(UVt, 16 * vt, dd, lane); } asm volatile("" ::: "memory");
#pragma unroll
    for (int vt = 0; vt < 4; ++vt) { const bf16x8 fU = frag16(UVt, 16 * vt, lane), fV = frag16(VTt, 16 * vt, lane);
        yv[vt] = mma16(fARK, fV, mma16(fARB, fU, z4));
#pragma unroll
        for (int ktp = 0; ktp < 4; ++ktp) zv[vt][ktp] = mma16(frag16(KHt, 16 * ktp, lane), fV, mma16(frag16(BHt, 16 * ktp, lane), fU, z4)); }
    f32x4 pz[4][4];
#pragma unroll
    for (int ktp = 0; ktp < 4; ++ktp) { const bf16x8 fBh = frag16(BHt, 16 * ktp, lane);
#pragma unroll
        for (int kt = 0; kt < 4; ++kt) { f32x4 dd = mma16(frag16(WAt, 16 * kt, lane), fBh, z4);
            if (kt == ktp) {
#pragma unroll
                for (int r = 0; r < 4; ++r) if (4 * kg + r == t) dd[r] += GCl[16 * kt + t]; }
            pz[ktp][kt] = dd; } }
    asm volatile("s_waitcnt lgkmcnt(0)" ::: "memory");
#pragma unroll
    for (int ktp = 0; ktp < 4; ++ktp) { LAS bf16* reg = (LAS bf16*)(wl + (ktp < 2 ? ktp * 2048 : (ktp + 1) * 2048));
#pragma unroll
        for (int kt = 0; kt < 4; ++kt) { v2u o; o.x = pk2(pz[ktp][kt][0], pz[ktp][kt][1]); o.y = pk2(pz[ktp][kt][2], pz[ktp][kt][3]); *(LAS v2u*)(reg + t * 64 + 16 * kt + 4 * kg) = o; } }
#pragma unroll
    for (int kt = 0; kt < 4; ++kt) { v2u o; o.x = pk2(qy[kt][0], qy[kt][1]); o.y = pk2(qy[kt][2], qy[kt][3]); *(LAS v2u*)(BHt + t * 64 + 16 * kt + 4 * kg) = o; }
    asm volatile("s_waitcnt lgkmcnt(0)" ::: "memory");
}
constexpr int RWZ_OFF = LDSCTL_OFF + 8192, RWF_OFF = LDSCTL_OFF + 2048;
__device__ __forceinline__ void rw_chunk_item2(const Ctx& F, int l, int it, size_t yoff = WS_YDIR) {
    const auto& a = *F.a; unsigned char* ws = a.ws; const int lane = opaque_v(F.lane), t = lane & 15, kg = lane >> 4;
    const int d = it & 1, h = (it >> 1) & 7, b = it >> 4;
    float* YD = (float*)(ws + yoff);
    LAS unsigned char* wl = F.lds + F.wave * 15616;
    LAS bf16* ZS = (LAS bf16*)(F.lds + RWZ_OFF);
    volatile LAS int* flag = (volatile LAS int*)(F.lds + RWF_OFF);
    for (int i = F.tid; i < 2048; i += NTHREADS) ((LAS unsigned*)ZS)[i] = 0u;
    if (F.tid == 0) *flag = 0;
    __syncthreads();
    constexpr int NCHK = (CTXL + SEQ) / 16;
#pragma unroll 1
    for (int c = F.wave; c < NCHK; c += NWAVES) {
        v4u raw[12]; f32x4 yv[4], zv[4][4];
        rw_chunk_load<0, 2>(F, b, h, d, c, raw);
        rw_chunk_task2(F, raw, wl, yv, zv);
        while (*flag < c) __builtin_amdgcn_s_sleep(1);
        asm volatile("" ::: "memory");
        const LAS bf16* Zc = ZS + (c & 1) * 4096; LAS bf16* Zn = ZS + ((c + 1) & 1) * 4096;
        bf16x8 zb[4][2];
#pragma unroll
        for (int vb = 0; vb < 4; ++vb)
#pragma unroll
            for (int ks = 0; ks < 2; ++ks) zb[vb][ks] = *(const LAS bf16x8*)(Zc + (16 * vb + t) * 64 + 32 * ks + 8 * kg);
        { const LAS bf16* Qr = (const LAS bf16*)(wl + 4096); const bf16x8 q0 = *(const LAS bf16x8*)(Qr + t * 64 + 8 * kg), q1 = *(const LAS bf16x8*)(Qr + t * 64 + 32 + 8 * kg);
#pragma unroll
          for (int vb = 0; vb < 4; ++vb) { const f32x4 y = mma16(q1, zb[vb][1], mma16(q0, zb[vb][0], yv[vb]));
#pragma unroll
              for (int r = 0; r < 4; ++r) { const int row = seq_row(b, d, c * 16 + 4 * kg + r); YD[((size_t)d * T_ALL + row) * 512 + h * 64 + 16 * vb + t] = y[r]; } } }
#pragma unroll
        for (int ktp = 0; ktp < 4; ++ktp) { const LAS bf16* Pr = (const LAS bf16*)(wl + (ktp < 2 ? ktp * 2048 : (ktp + 1) * 2048));
            const bf16x8 p0 = *(const LAS bf16x8*)(Pr + t * 64 + 8 * kg), p1 = *(const LAS bf16x8*)(Pr + t * 64 + 32 + 8 * kg);
#pragma unroll
            for (int vb = 0; vb < 4; ++vb) { const f32x4 z = mma16(p1, zb[vb][1], mma16(p0, zb[vb][0], zv[vb][ktp]));
                v2u o; o.x = pk2(z[0], z[1]); o.y = pk2(z[2], z[3]); *(LAS v2u*)(Zn + (16 * vb + t) * 64 + 16 * ktp + 4 * kg) = o; } }
        asm volatile("s_waitcnt lgkmcnt(0)" ::: "memory");
        if (lane == 0) *flag = c + 1;
        asm volatile("s_waitcnt lgkmcnt(0)" ::: "memory");
    }
    __syncthreads();
}
__device__ __forceinline__ v2u ld_sc1_8(const void* p) { const unsigned long long v = __hip_atomic_load((const unsigned long long*)p, __ATOMIC_RELAXED, __HIP_MEMORY_SCOPE_AGENT); v2u o; o.x = (unsigned)v; o.y = (unsigned)(v >> 32); return o; }
__device__ __forceinline__ v4u ld_sc1_16(const void* p) { const v2u a = ld_sc1_8(p), b = ld_sc1_8((const char*)p + 8); return (v4u){a.x, a.y, b.x, b.y}; }
__device__ __forceinline__ void rw_chunk_item(const Ctx& F, int l, int it) {
    const auto& a = *F.a; unsigned char* ws = a.ws; const int lane = F.lane, t = lane & 15, kg = lane >> 4;
    const int d = it & 1, h = (it >> 1) & 7, b = it >> 4;
    float* YD = (float*)(ws + WS_YDIR);
    unsigned char* scr = ws + WS_RWSCR + (size_t)F.bid * 16 * RWS_SLOT;
    LAS unsigned char* wl = F.lds + F.wave * 15616;
    LAS bf16* ZL = (LAS bf16*)(F.lds + LDSCTL_OFF + 4096 + (F.wave & 3) * 2048);
    if (F.wave < 4) { for (int i = lane; i < 512; i += 64) ((LAS unsigned*)ZL)[i] = 0u; }
    asm volatile("" ::: "memory");
    constexpr int NCHK = (CTXL + SEQ) / 16, NB = NCHK / 16;
#pragma unroll 1
    for (int bt = 0; bt < NB; ++bt) {
        { v4u cur[12];
#pragma unroll 1
          for (int jj = 0; jj < 2; ++jj) { rw_chunk_load<0, 2>(F, b, h, d, bt * 16 + F.wave + 8 * jj, cur); rw_chunk_task(F, cur, wl, scr + (size_t)(F.wave + 8 * jj) * RWS_SLOT); } }
        asm volatile("s_waitcnt vmcnt(0)" ::: "memory");
        __syncthreads();
        {
            const int t = opaque_v(lane & 15), kg = opaque_v(lane >> 4), vb = opaque(F.wave) & 3;
            const unsigned char* scrb = F.a->ws + WS_RWSCR + (size_t)opaque(F.bid) * 16 * RWS_SLOT;
            LAS unsigned char* sbuf = F.lds;
            const int lt = opaque_v(F.tid) & 255; const bool loader = F.wave >= 4;
            const int lw = opaque(F.wave) & 3;
#define RWB_ISSUE(j_) do { const unsigned char* gp_ = scrb + (size_t)(j_) * RWS_SLOT + (size_t)(lw * 5) * 1024 + lane * 16; LAS unsigned char* lp_ = sbuf + ((j_) % 6) * RWS_SLOT + (lw * 5) * 1024; \
                _Pragma("unroll") for (int q = 0; q < 5; ++q) __builtin_amdgcn_global_load_lds((const unsigned*)(gp_ + q * 1024), (LAS unsigned*)(lp_ + q * 1024), 16, 0, 16); } while (0)
#define RWB_COMP(bi_, j_) do { const LAS unsigned char* sl_ = sbuf + (bi_) * RWS_SLOT; bf16x8 zb[2], qf[2]; \
                _Pragma("unroll") for (int ks = 0; ks < 2; ++ks) { zb[ks] = *(const LAS bf16x8*)(ZL + t * 64 + 32 * ks + 8 * kg); qf[ks] = *(const LAS bf16x8*)(sl_ + RWS_QY + (t * 64 + 32 * ks + 8 * kg) * 2); } \
                const v2u y_ = *(const LAS v2u*)(sl_ + RWS_YV + ((16 * vb + t) * 16 + 4 * kg) * 2); \
                f32x4 yacc = (f32x4){bflo(y_.x), bfhi(y_.x), bflo(y_.y), bfhi(y_.y)}; \
                yacc = mma16(qf[1], zb[1], mma16(qf[0], zb[0], yacc)); \
                f32x4 zn[4]; \
                _Pragma("unroll") for (int ktp = 0; ktp < 4; ++ktp) { const v2u z_ = *(const LAS v2u*)(sl_ + RWS_ZV + ((16 * vb + t) * 64 + 16 * ktp + 4 * kg) * 2); \
                    f32x4 zc = (f32x4){bflo(z_.x), bfhi(z_.x), bflo(z_.y), bfhi(z_.y)}; \
                    _Pragma("unroll") for (int ks = 0; ks < 2; ++ks) zc = mma16(*(const LAS bf16x8*)(sl_ + RWS_PZ + ((16 * ktp + t) * 64 + 32 * ks + 8 * kg) * 2), zb[ks], zc); \
                    zn[ktp] = zc; } \
                _Pragma("unroll") for (int r = 0; r < 4; ++r) { const int row = seq_row(b, d, (bt * 16 + (j_)) * 16 + 4 * kg + r); YD[((size_t)d * T_ALL + row) * 512 + h * 64 + 16 * vb + t] = yacc[r]; } \
                asm volatile("s_waitcnt lgkmcnt(0)" ::: "memory"); \
                _Pragma("unroll") for (int ktp = 0; ktp < 4; ++ktp) { v2u o; o.x = pk2(zn[ktp][0], zn[ktp][1]); o.y = pk2(zn[ktp][2], zn[ktp][3]); *(LAS v2u*)(ZL + t * 64 + 16 * ktp + 4 * kg) = o; } \
                asm volatile("s_waitcnt lgkmcnt(0)" ::: "memory"); } while (0)
#define RWB_BAR() do { asm volatile("s_waitcnt lgkmcnt(0)" ::: "memory"); __builtin_amdgcn_s_barrier(); asm volatile("" ::: "memory"); } while (0)
            if (loader) { RWB_ISSUE(0); RWB_ISSUE(1); RWB_ISSUE(2); RWB_ISSUE(3); asm volatile("s_waitcnt vmcnt(15)" ::: "memory"); }
            RWB_BAR();
#pragma unroll 1
            for (int j = 0; j < 16; ++j) {
                if (loader) { if (j + 4 < 16) { RWB_ISSUE(j + 4); asm volatile("s_waitcnt vmcnt(15)" ::: "memory"); } else { asm volatile("s_waitcnt vmcnt(0)" ::: "memory"); } }
                else { RWB_COMP(j % 6, j); }
                RWB_BAR();
            }
#undef RWB_BAR
#undef RWB_ISSUE
#undef RWB_COMP
        }
        __syncthreads();
    }
}

__device__ __forceinline__ void stage_rw_readout(const Ctx& F, int l) {
    const auto& a = *F.a; unsigned char* ws = a.ws; const int lane = F.lane;
    const bf16* SCN = (const bf16*)(ws + WS_SCN); const bf16* P = (const bf16*)(ws + WS_P); const float* YD = (const float*)(ws + WS_YDIR); bf16* YRW = (bf16*)(ws + WS_YRW);
    const int gw = F.bid * NWAVES + F.wave, NGW = F.G * NWAVES;
    constexpr int TR = 17, NRT = T_ALL / TR;
    for (int tile = gw; tile < NRT * 4; tile += NGW) {
        const int rt = tile % NRT, hp = tile / NRT, row0 = rt * TR, c0 = hp * 128 + 2 * lane;
        const f32x2 rk = *(const f32x2*)(a.in[I_RWRK] + l * 512 + c0), lng = *(const f32x2*)(a.in[I_RWLNG] + l * 512 + c0), lnb = *(const f32x2*)(a.in[I_RWLNB] + l * 512 + c0);
#pragma unroll 4
        for (int i = 0; i < TR; ++i) {
            const int row = row0 + i;
            const unsigned* sp = (const unsigned*)(SCN + (size_t)row * 9 * 512 + c0);
            const unsigned ru = sp[0], vu = sp[256], k0u = sp[4 * 256], k1u = sp[7 * 256];
            const f32x2 y0 = *(const f32x2*)(YD + (size_t)row * 512 + c0), y1 = *(const f32x2*)(YD + ((size_t)T_ALL + row) * 512 + c0);
            const unsigned gu = *(const unsigned*)(P + (size_t)row * 2560 + 2048 + c0);
            const float bon = red32(bflo(ru) * (bflo(k0u) + bflo(k1u)) * rk[0] + bfhi(ru) * (bfhi(k0u) + bfhi(k1u)) * rk[1]);
            f32x2 y = y0 + y1 + (f32x2){bflo(vu), bfhi(vu)} * bon;
            const float mu = red32(y[0] + y[1]) * (1.f / 64.f);
            y = y - mu;
            const float var = red32(y[0] * y[0] + y[1] * y[1]) * (1.f / 64.f);
            const f32x2 yn = y * (1.0f / sqrtf(var + 64e-5f));
            const f32x2 ov = (yn * lng + lnb) * (f32x2){bflo(gu), bfhi(gu)};
            *(unsigned*)(YRW + (size_t)row * 512 + c0) = pk2(ov[0], ov[1]);
        }
    }
}

constexpr size_t WS_S5E = 6 * MiB;
constexpr int S5_NSEG = 4, S5_SEGLEN = (CTXL + SEQ) / S5_NSEG;
__device__ __forceinline__ void s5_disc(const float are, const float aim, const float dt, float& lbr, float& lbi, float& cr, float& ci) {
    const float mag = expf(are * dt); lbr = mag * cosf(aim * dt); lbi = mag * sinf(aim * dt);
    const float den = are * are + aim * aim, nr = lbr - 1.0f; cr = (nr * are + lbi * aim) / den; ci = (lbi * are - nr * aim) / den;
}
template <int PASS>
__device__ __forceinline__ void stage_s5_scan(const Ctx& F, int l) {
    const auto& a = *F.a; unsigned char* ws = a.ws; const int lane = F.lane;
    const bf16* Z = (const bf16*)(ws + WS_Z); float* YP = (float*)(ws + WS_YP); f32x2* S5E = (f32x2*)(ws + WS_S5E);
    LAS unsigned char* wl = F.lds + F.wave * 16384;
    LAS float* buL = (LAS float*)wl;
    LAS bf16* Hs = (LAS bf16*)(wl + 8704);
    const int fr = lane & 15, kg = lane >> 4;
    for (int itx = F.bid * NWAVES + F.wave; itx < BATCH * 32 * 2 * S5_NSEG; itx += NWAVES * F.G) {
        const int seg = itx & (S5_NSEG - 1), it = itx >> 2;
        const int d = it & 1, g = (it >> 1) & 31, b = it >> 6, p = lane;
        const float dt = expf(a.in[I_S5LDT][(l * 2 + d) * 32 + g]);
        const float* arep = a.in[I_S5ARE] + ((size_t)(l * 2 + d) * 32 + g) * 64; const float* aimp = a.in[I_S5AIM] + ((size_t)(l * 2 + d) * 32 + g) * 64;
        float lbr, lbi, cr_, ci_; s5_disc(arep[p], aimp[p], dt, lbr, lbi, cr_, ci_);
        bf16x8 afr[2][4];
#pragma unroll
        for (int tl = 0; tl < 4; ++tl) { const int pp = 16 * tl + fr; float r0_, r1_, cr, ci; s5_disc(arep[pp], aimp[pp], dt, r0_, r1_, cr, ci);
            v4u pr = (v4u){0u, 0u, 0u, 0u}, pi = (v4u){0u, 0u, 0u, 0u};
            if (kg < 2) { const float* br = a.in[I_S5BRE] + (((size_t)l * 32 + g) * 64 + pp) * 16 + 8 * kg; const float* bi = a.in[I_S5BIM] + (((size_t)l * 32 + g) * 64 + pp) * 16 + 8 * kg;
                const f32x4 x0 = *(const f32x4*)br, x1 = *(const f32x4*)(br + 4), y0 = *(const f32x4*)bi, y1 = *(const f32x4*)(bi + 4);
                pr.x = pk2(cr * x0[0] - ci * y0[0], cr * x0[1] - ci * y0[1]); pr.y = pk2(cr * x0[2] - ci * y0[2], cr * x0[3] - ci * y0[3]);
                pr.z = pk2(cr * x1[0] - ci * y1[0], cr * x1[1] - ci * y1[1]); pr.w = pk2(cr * x1[2] - ci * y1[2], cr * x1[3] - ci * y1[3]);
                pi.x = pk2(cr * y0[0] + ci * x0[0], cr * y0[1] + ci * x0[1]); pi.y = pk2(cr * y0[2] + ci * x0[2], cr * y0[3] + ci * x0[3]);
                pi.z = pk2(cr * y1[0] + ci * x1[0], cr * y1[1] + ci * x1[1]); pi.w = pk2(cr * y1[2] + ci * x1[2], cr * y1[3] + ci * x1[3]); }
            afr[0][tl] = __builtin_bit_cast(bf16x8, pr); afr[1][tl] = __builtin_bit_cast(bf16x8, pi); }
        bf16x8 cf[4];
        f32x2 hst = (f32x2){0.f, 0.f};
        if (PASS == 1) {
#pragma unroll
            for (int kk = 0; kk < 4; ++kk) { const int p0 = 16 * kk + 4 * kg;
                const f32x4 c0 = *(const f32x4*)(a.in[I_S5CRE] + (((size_t)l * 32 + g) * 16 + fr) * 64 + p0), c1 = *(const f32x4*)(a.in[I_S5CIM] + (((size_t)l * 32 + g) * 16 + fr) * 64 + p0);
                v4u pk; pk.x = pk2(c0[0], -c1[0]); pk.y = pk2(c0[1], -c1[1]); pk.z = pk2(c0[2], -c1[2]); pk.w = pk2(c0[3], -c1[3]);
                cf[kk] = __builtin_bit_cast(bf16x8, pk); }
            float pr_ = lbr, pi_ = lbi, l64r = 1.f, l64i = 0.f;
#pragma unroll 1
            for (int q = 0; q < 10; ++q) { const float nr2 = pr_ * pr_ - pi_ * pi_, ni2 = 2.f * pr_ * pi_; pr_ = nr2; pi_ = ni2; if (q == 5) { l64r = pr_; l64i = pi_; } }
            const float lLr = pr_ * l64r - pi_ * l64i, lLi = pr_ * l64i + pi_ * l64r;
#pragma unroll 1
            for (int sgi = 0; sgi < seg; ++sgi) { const f32x2 ev = S5E[((size_t)it * S5_NSEG + sgi) * 64 + p];
                hst = (f32x2){lLr * hst[0] - lLi * hst[1] + ev[0], lLr * hst[1] + lLi * hst[0] + ev[1]}; }
        }
        const f32x2 lbr2 = (f32x2){lbr, lbr}, lbi2 = (f32x2){lbi, lbi};
        const int sbeg = seg * S5_SEGLEN, send = sbeg + S5_SEGLEN;
        v4u un = (v4u){0u, 0u, 0u, 0u}, uc;
#define S5_LOADU(s0_) do { if (kg < 2) { const int row_ = seq_row(b, d, (s0_) + fr); un = *(const v4u*)(Z + (size_t)row_ * IN_COLS + S5_OFF + g * 16 + kg * 8); } } while (0)
        S5_LOADU(sbeg);
#pragma unroll 1
        for (int s0 = sbeg; s0 < send; s0 += 16) {
            uc = un;
            if (s0 + 16 < send) S5_LOADU(s0 + 16);
            const bf16x8 ufr = __builtin_bit_cast(bf16x8, uc);
#pragma unroll
            for (int c = 0; c < 2; ++c)
#pragma unroll
                for (int tl = 0; tl < 4; ++tl) { const f32x4 dd = __builtin_amdgcn_mfma_f32_16x16x32_bf16(afr[c][tl], ufr, (f32x4){0.f, 0.f, 0.f, 0.f}, 0, 0, 0);
                    *(LAS f32x4*)(buL + (c * 16 + fr) * 68 + 16 * tl + 4 * kg) = dd; }
            LDS_WAIT(); asm volatile("" ::: "memory");
            f32x2 bu[16];
#pragma unroll
            for (int s = 0; s < 16; ++s) bu[s] = (f32x2){buL[s * 68 + p], buL[(16 + s) * 68 + p]};
#pragma unroll
            for (int s = 0; s < 16; ++s) {
                const f32x2 sw = (f32x2){-hst[1], hst[0]};
                hst = lbr2 * hst + (lbi2 * sw + bu[s]);
                if (PASS == 1) *(LAS unsigned*)(Hs + s * 136 + 2 * p) = pg8::cvt_pk_bf16(hst[0], hst[1]);
            }
            if (PASS == 1) {
                LDS_WAIT(); asm volatile("" ::: "memory");
                f32x4 acc = (f32x4){0.f, 0.f, 0.f, 0.f};
#pragma unroll
                for (int kk = 0; kk < 4; ++kk) { const bf16x8 af = *(const LAS bf16x8*)(Hs + fr * 136 + 32 * kk + 8 * kg); acc = __builtin_amdgcn_mfma_f32_16x16x32_bf16(af, cf[kk], acc, 0, 0, 0); }
#pragma unroll
                for (int r = 0; r < 4; ++r) { const int row = seq_row(b, d, s0 + 4 * kg + r); YP[((size_t)d * T_ALL + row) * 512 + g * 16 + fr] = acc[r]; }
            }
            LDS_WAIT(); asm volatile("" ::: "memory");
        }
        if (PASS == 0) S5E[((size_t)it * S5_NSEG + seg) * 64 + p] = hst;
#undef S5_LOADU
    }
}

__device__ __forceinline__ void stage_s5_prep(const Ctx& F, int l) {
    const auto& a = *F.a; unsigned char* ws = a.ws;
    const bf16* Z = (const bf16*)(ws + WS_Z); const float* YP = (const float*)(ws + WS_YP); bf16* AS5 = (bf16*)(ws + WS_AS5);
    const float dsk = a.in[I_S5D][l * 512 + F.tid];
    for (int row = F.bid; row < T_ALL; row += F.G) {
        const int c = F.tid;
        const float u = bf2f(Z[(size_t)row * IN_COLS + S5_OFF + c]);
        const float y = YP[(size_t)row * 512 + c] + YP[((size_t)T_ALL + row) * 512 + c] + u * dsk;
        const float ge = 0.5f * y * (1.f + tanhf(0.7978845608028654f * (y + 0.044715f * y * y * y)));
        AS5[(size_t)row * 512 + c] = (bf16)f2bf(ge);
    }
}

__device__ __forceinline__ void stage_hy_pre(const Ctx& F, int l) {
    const auto& a = *F.a; unsigned char* ws = a.ws; const int lane = F.lane;
    const bf16* Z = (const bf16*)(ws + WS_Z); bf16* UT = (bf16*)(ws + WS_UT);
    LAS bf16* tl = (LAS bf16*)(F.lds + F.wave * 16384);
    const float* cw = a.in[I_HYCW] + (size_t)l * 3 * 1536; const float* cbp = a.in[I_HYCB] + l * 1536;
    const int gw = F.bid * NWAVES + F.wave, NGW = F.G * NWAVES;
    for (int tile = gw; tile < (T_ALL / 64) * 24; tile += NGW) {
        const int rt = tile / 24, ct = tile % 24, row0 = rt * 64, col = ct * 64 + lane;
        int base, pos0, n; row_seq(row0, base, pos0, n);
        const bf16* zc = Z + (size_t)base * IN_COLS + HY_OFF + col;
        const float w0 = cw[col], w1 = cw[1536 + col], w2 = cw[2 * 1536 + col], cb = cbp[col];
        float zm = pos0 > 0 ? bf2f(zc[(size_t)(pos0 - 1) * IN_COLS]) : 0.f, z0 = bf2f(zc[(size_t)pos0 * IN_COLS]);
#pragma unroll 8
        for (int r = 0; r < 64; ++r) { const float zp = (pos0 + r + 1 < n) ? bf2f(zc[(size_t)(pos0 + r + 1) * IN_COLS]) : 0.f;
            tl[lane * 66 + r] = (bf16)f2bf(w0 * zm + w1 * z0 + w2 * zp + cb); zm = z0; z0 = zp; }
        LDS_WAIT(); asm volatile("" ::: "memory");
        bf16* up = UT + (size_t)(ct * 64) * T_ALL + row0 + lane;
#pragma unroll 8
        for (int cc = 0; cc < 64; ++cc) up[(size_t)cc * T_ALL] = tl[cc * 66 + lane];
        LDS_WAIT(); asm volatile("" ::: "memory");
    }
}
__device__ __forceinline__ void stage_hy_post(const Ctx& F, int l) {
    const auto& a = *F.a; unsigned char* ws = a.ws; const int lane = F.lane;
    const bf16* YT = (const bf16*)(ws + WS_UT) + (size_t)1024 * T_ALL; bf16* YHY = (bf16*)(ws + WS_YHY);
    LAS bf16* tl = (LAS bf16*)(F.lds + F.wave * 8448);
    const int gw = F.bid * NWAVES + F.wave, NGW = F.G * NWAVES;
    for (int tile = gw; tile < (T_ALL / 64) * 8; tile += NGW) {
        const int rt = tile >> 3, ct = tile & 7, row0 = rt * 64, c0 = ct * 64;
        const bf16* yp = YT + (size_t)c0 * T_ALL + row0 + lane;
#pragma unroll 8
        for (int cc = 0; cc < 64; ++cc) tl[cc * 66 + lane] = yp[(size_t)cc * T_ALL];
        LDS_WAIT(); asm volatile("" ::: "memory");
        bf16* op = YHY + (size_t)row0 * 512 + c0 + lane;
#pragma unroll 8
        for (int r = 0; r < 64; ++r) op[(size_t)r * 512] = tl[lane * 66 + r];
        LDS_WAIT(); asm volatile("" ::: "memory");
    }
}
typedef float f32x16 __attribute__((ext_vector_type(16)));
__device__ __forceinline__ void hyena_item(const Ctx& F, int l, int c, int isctx) {
    const auto& a = *F.a; unsigned char* ws = a.ws; const int tid = F.tid, lane = F.lane;
    const int n = isctx ? CTXL : SEQ, rowbase = isctx ? T_LAT : 0, RL = isctx ? HY_RLENC : HY_RLEN, off = n + 47;
    const bf16* UT = (const bf16*)(ws + WS_UT);
    const bf16* x1g = UT + (size_t)c * T_ALL + rowbase; const bf16* x2g = UT + (size_t)(512 + c) * T_ALL + rowbase; bf16* vg = (bf16*)UT + (size_t)(1024 + c) * T_ALL + rowbase;
    const bf16* Rg = (const bf16*)(ws + WS_GF + l * GF_STRIDE + (isctx ? GF_CTX : 0)) + (size_t)c * RL;
    LAS unsigned char* XB = F.lds; LAS unsigned char* R1 = F.lds + HY_R1_OFF; LAS unsigned char* R2 = F.lds + HY_R2_OFF;
    { const int cpb = n / 8;
      for (int q = tid; q < 8 * cpb; q += NTHREADS) { const int b = q / cpb, ch = q % cpb; *(LAS v4u*)(XB + b * HY_ROWB + 2 * HY_MARG + 16 * ch) = *(const v4u*)(vg + (size_t)b * n + 8 * ch); }
      if (tid < 256) { const int b = tid >> 5, side = (tid >> 4) & 1, ch = tid & 15; *(LAS v4u*)(XB + b * HY_ROWB + (side ? 2 * (HY_MARG + n) : 0) + 16 * ch) = (v4u){0u, 0u, 0u, 0u}; }
      const int rch = RL / 8;
      for (int q = tid; q < rch; q += NTHREADS) { *(LAS v4u*)(R1 + 16 * q) = *(const v4u*)(Rg + 8 * q); *(LAS v4u*)(R2 + 16 * q) = *(const v4u*)(Rg + (size_t)512 * RL + 8 * q); } }
    __syncthreads();
    const int i = lane & 31, kg = lane >> 5, jb = lane & 3, bb = (lane & 31) >> 2;
    const int rsh = (off - i) & 7, rd = rsh >> 1; const bool s1 = rd & 1, s2 = rd & 2; const unsigned sh = (rsh & 1) ? 16u : 0u;
    const int aconst = 2 * (off - i + 8 * kg - rsh), bconst = bb * HY_ROWB + 2 * (HY_MARG + 32 * jb + 8 * kg);
    const int T0w = 512 * F.wave; const int ntile = (n - T0w) >= 512 ? 4 : ((n - T0w) > 0 ? (n - T0w) / 128 : 0);
    const float bias0 = a.in[I_HYBIAS][(l * 2 + 0) * 512 + c], bias1 = a.in[I_HYBIAS][(l * 2 + 1) * 512 + c];
    f32x16 acc[4];
    v2u y1p[4][4];
#define HY_AFRAG(wa, wb, afr) do { \
        const unsigned a0 = s1 ? wa.y : wa.x, a1 = s1 ? wa.z : wa.y, a2 = s1 ? wa.w : wa.z, a3 = s1 ? wb.x : wa.w, a4 = s1 ? wb.y : wb.x, a5 = s1 ? wb.z : wb.y, a6 = s1 ? wb.w : wb.z; \
        const unsigned b0 = s2 ? a2 : a0, b1 = s2 ? a3 : a1, b2 = s2 ? a4 : a2, b3 = s2 ? a5 : a3, b4 = s2 ? a6 : a4; \
        v4u af_; af_.x = __builtin_amdgcn_alignbit(b1, b0, sh); af_.y = __builtin_amdgcn_alignbit(b2, b1, sh); af_.z = __builtin_amdgcn_alignbit(b3, b2, sh); af_.w = __builtin_amdgcn_alignbit(b4, b3, sh); \
        afr = __builtin_bit_cast(bf16x8, af_); } while (0)
#define HY_STEP_COND(RB, d) do { \
        const v4u wa = *(const LAS v4u*)((RB) + aconst - 2 * (d)), wb = *(const LAS v4u*)((RB) + aconst - 2 * (d) + 16); bf16x8 afr; HY_AFRAG(wa, wb, afr); \
        _Pragma("unroll") for (int m = 0; m < 4; ++m) { const int T0 = T0w + 128 * m; \
            if (m < ntile && (d) >= T0 - n + 16 && (d) <= T0 + 96) { const bf16x8 bfr = *(const LAS bf16x8*)(XB + bconst + 2 * (T0 - (d))); \
                acc[m] = __builtin_amdgcn_mfma_f32_32x32x16_bf16(afr, bfr, acc[m], 0, 0, 0); } } } while (0)
#define HY_LOAD(RB, d, wa, wb, bq) do { wa = *(const LAS v4u*)((RB) + aconst - 2 * (d)); wb = *(const LAS v4u*)((RB) + aconst - 2 * (d) + 16); \
        _Pragma("unroll") for (int m = 0; m < 4; ++m) bq[m] = *(const LAS bf16x8*)(XB + bconst + 2 * (T0w + 128 * m - (d))); } while (0)
#define HY_MMA(wa, wb, bq) do { bf16x8 afr; HY_AFRAG(wa, wb, afr); \
        _Pragma("unroll") for (int m = 0; m < 4; ++m) acc[m] = __builtin_amdgcn_mfma_f32_32x32x16_bf16(afr, bq[m], acc[m], 0, 0, 0); } while (0)
#define HY_CONV(RB) do { \
        _Pragma("unroll") for (int m = 0; m < 4; ++m) _Pragma("unroll") for (int e = 0; e < 16; ++e) acc[m][e] = 0.f; \
        if (ntile == 4) { \
            const int dA = T0w - n + 16, dB = T0w + 384 - n + 16, dC = T0w + 96, dD = T0w + 384 + 96;     \
            _Pragma("unroll 1") for (int d = dA; d < dB; d += 16) HY_STEP_COND(RB, d); \
            { v4u waA, wbA, waB, wbB; bf16x8 bqA[4], bqB[4]; \
              HY_LOAD(RB, dB, waA, wbA, bqA); \
              _Pragma("unroll 1") for (int d = dB; d <= dC; d += 32) { \
                  if (d + 16 <= dC) HY_LOAD(RB, d + 16, waB, wbB, bqB); \
                  __builtin_amdgcn_sched_barrier(0); \
                  HY_MMA(waA, wbA, bqA); \
                  __builtin_amdgcn_sched_barrier(0); \
                  if (d + 32 <= dC) HY_LOAD(RB, d + 32, waA, wbA, bqA); \
                  __builtin_amdgcn_sched_barrier(0); \
                  if (d + 16 <= dC) HY_MMA(waB, wbB, bqB); \
                  __builtin_amdgcn_sched_barrier(0); } } \
            _Pragma("unroll 1") for (int d = dC + 16; d <= dD; d += 16) HY_STEP_COND(RB, d); \
        } else if (ntile > 0) { const int dhi = T0w + 128 * (ntile - 1) + 96; \
            _Pragma("unroll 1") for (int d = T0w - n + 16; d <= dhi; d += 16) HY_STEP_COND(RB, d); } } while (0)
    HY_CONV(R1);
#pragma unroll
    for (int m = 0; m < 4; ++m) if (m < ntile) {
#pragma unroll
        for (int rg = 0; rg < 4; ++rg) { const int t4 = T0w + 128 * m + 32 * jb + 8 * rg + 4 * kg;
            const v2u xv = *(const v2u*)(x1g + (size_t)bb * n + t4); const v2u vv = *(const LAS v2u*)(XB + bb * HY_ROWB + 2 * (HY_MARG + t4));
            const float y0 = bflo(xv.x) * (acc[m][4 * rg + 0] + bias0 * bflo(vv.x)), y1 = bfhi(xv.x) * (acc[m][4 * rg + 1] + bias0 * bfhi(vv.x));
            const float y2 = bflo(xv.y) * (acc[m][4 * rg + 2] + bias0 * bflo(vv.y)), y3 = bfhi(xv.y) * (acc[m][4 * rg + 3] + bias0 * bfhi(vv.y));
            y1p[m][rg].x = pk2(y0, y1); y1p[m][rg].y = pk2(y2, y3); } }
    __syncthreads();
#pragma unroll
    for (int m = 0; m < 4; ++m) if (m < ntile) {
#pragma unroll
        for (int rg = 0; rg < 4; ++rg) { const int t4 = T0w + 128 * m + 32 * jb + 8 * rg + 4 * kg; *(LAS v2u*)(XB + bb * HY_ROWB + 2 * (HY_MARG + t4)) = y1p[m][rg]; } }
    __syncthreads();
    HY_CONV(R2);
#pragma unroll
    for (int m = 0; m < 4; ++m) if (m < ntile) {
#pragma unroll
        for (int rg = 0; rg < 4; ++rg) { const int t4 = T0w + 128 * m + 32 * jb + 8 * rg + 4 * kg;
            const v2u xv = *(const v2u*)(x2g + (size_t)bb * n + t4); const v2u yv = y1p[m][rg];
            const float o0 = bflo(xv.x) * (acc[m][4 * rg + 0] + bias1 * bflo(yv.x)), o1 = bfhi(xv.x) * (acc[m][4 * rg + 1] + bias1 * bfhi(yv.x));
            const float o2 = bflo(xv.y) * (acc[m][4 * rg + 2] + bias1 * bflo(yv.y)), o3 = bfhi(xv.y) * (acc[m][4 * rg + 3] + bias1 * bfhi(yv.y));
            v2u ov; ov.x = pk2(o0, o1); ov.y = pk2(o2, o3); *(v2u*)(vg + (size_t)bb * n + t4) = ov; } }
    __syncthreads();
#undef HY_CONV
#undef HY_AFRAG
#undef HY_STEP_COND
#undef HY_LOAD
#undef HY_MMA
}
__device__ __forceinline__ void stage_mixer(const Ctx& F, int l) {
    unsigned* ctr = (unsigned*)(F.a->ws + WS_CTL) + CW_WORK + 64 * l;
    LAS int* itb = (LAS int*)(F.lds + LDSCTL_OFF + 512);
    const int nit = 128 + 512 + (l == 0 ? 512 : 0);
#ifdef PROBE_STATIC
    return;
#endif
    for (;;) {
        if (F.tid == 0) *itb = (int)__hip_atomic_fetch_add(ctr, 1u, __ATOMIC_RELAXED, __HIP_MEMORY_SCOPE_AGENT);
        __syncthreads();
        const int it = *itb;
        __syncthreads();
        if (it >= nit) break;
        Ctx Fi; Fi.a = kargs(); Fi.tid = opaque_v((int)threadIdx.x); Fi.lane = Fi.tid & 63; Fi.wave = __builtin_amdgcn_readfirstlane(Fi.tid >> 6); Fi.bid = opaque((int)blockIdx.x); Fi.G = opaque((int)gridDim.x);
        Fi.lds = (LAS unsigned char*)((LAS unsigned char*)0 + opaque(0)) + (F.lds - (LAS unsigned char*)0);
#ifdef PROBE_T
        if (l == 0 && F.tid == 0 && it == 5) ((unsigned long long*)(F.a->ws + WS_CTL + CW_STAMP * 4))[21] = __builtin_amdgcn_s_memrealtime();
        if (l == 0 && F.tid == 0 && it == 300) ((unsigned long long*)(F.a->ws + WS_CTL + CW_STAMP * 4))[23] = __builtin_amdgcn_s_memrealtime();
#endif
        if (it < 128) { for (int rep = 0; rep < ((DUPK == 9) ? 2 : 1); ++rep) rw_chunk_item2(Fi, opaque(l), it); }
        else if (it < 640) hyena_item(Fi, opaque(l), it - 128, 0);
        else hyena_item(Fi, opaque(l), it - 640, 1);
#ifdef PROBE_T
        if (l == 0 && F.tid == 0 && it == 5) ((unsigned long long*)(F.a->ws + WS_CTL + CW_STAMP * 4))[22] = __builtin_amdgcn_s_memrealtime();
        if (l == 0 && F.tid == 0 && it == 300) ((unsigned long long*)(F.a->ws + WS_CTL + CW_STAMP * 4))[24] = __builtin_amdgcn_s_memrealtime();
#endif
    }
}

typedef float f32x16r __attribute__((ext_vector_type(16)));
__device__ __forceinline__ void stage_norm2_router(const Ctx& F, int l) {
    const auto& a = *F.a; unsigned char* ws = a.ws; const int lane = F.lane;
    const float* X = (const float*)(ws + WS_X); bf16* H = (bf16*)(ws + WS_H); const float* MOD = (const float*)(ws + WS_MOD);
    int* EIDX = (int*)(ws + WS_EIDX); float* GATE = (float*)(ws + WS_GATE); int* BLKCNT = (int*)(ws + WS_BLKCNT);
    LAS float* lg = (LAS float*)(F.lds + F.wave * 4352);
    LAS int* hist = (LAS int*)(F.lds + LDSCTL_OFF + 1024);
    if (F.tid < 32) hist[F.tid] = 0;
    __syncthreads();
    const int rpb = (T_ALL + F.G - 1) / F.G, r0 = F.bid * rpb, r1 = (r0 + rpb < T_ALL) ? r0 + rpb : T_ALL;
    const float* rw = a.in[I_RTW] + (size_t)l * 1024 * 32;
    const int i = lane & 31, kk = lane >> 5;
    const f32x4* ng = (const f32x4*)(a.in[I_N2G] + l * D) + kk;
    for (int rb = r0 + F.wave * 32; rb < r1; rb += NWAVES * 32) {
        const int nrow = (r1 - rb) < 32 ? (r1 - rb) : 32; const bool live = i < nrow;
        const int row = live ? rb + i : r1 - 1; const int w = row < T_LAT ? (row >> 12) : 8;
        const f32x4* xr = (const f32x4*)(X + (size_t)row * D) + kk;
        float ss = 0.f;
#pragma unroll 8
        for (int q = 0; q < 128; ++q) { const f32x4 v = xr[2 * q]; ss += (v[0] * v[0] + v[1] * v[1]) + (v[2] * v[2] + v[3] * v[3]); }
        ss += __builtin_bit_cast(float, __builtin_amdgcn_ds_bpermute((lane ^ 32) << 2, __builtin_bit_cast(int, ss)));
        const float rstd = 1.0f / sqrtf(ss * (1.f / D) + 1e-6f);
        const f32x4* sh = (const f32x4*)(MOD + (size_t)(l * 9 + w) * 6144 + 3072) + kk; const f32x4* sc = (const f32x4*)(MOD + (size_t)(l * 9 + w) * 6144 + 4096) + kk;
        v2u* ho = (v2u*)(H + (size_t)row * D) + kk;
        f32x16r acc;
#pragma unroll
        for (int e = 0; e < 16; ++e) acc[e] = 0.f;
        const float* wp = rw + (size_t)(4 * kk) * 32 + i;
#pragma unroll 2
        for (int q = 0; q < 128; ++q) {
            const f32x4 xv = xr[2 * q]; const f32x4 h4 = xv * rstd * ng[2 * q] * (sc[2 * q] + 1.0f) + sh[2 * q];
            const float w0 = wp[(size_t)(8 * q) * 32], w1 = wp[(size_t)(8 * q + 1) * 32], w2 = wp[(size_t)(8 * q + 2) * 32], w3 = wp[(size_t)(8 * q + 3) * 32];
            if (live) { v2u o; o.x = pk2(h4[0], h4[1]); o.y = pk2(h4[2], h4[3]); ho[2 * q] = o; }
            acc = __builtin_amdgcn_mfma_f32_32x32x2f32(h4[0], w0, acc, 0, 0, 0);
            acc = __builtin_amdgcn_mfma_f32_32x32x2f32(h4[1], w1, acc, 0, 0, 0);
            acc = __builtin_amdgcn_mfma_f32_32x32x2f32(h4[2], w2, acc, 0, 0, 0);
            acc = __builtin_amdgcn_mfma_f32_32x32x2f32(h4[3], w3, acc, 0, 0, 0);
        }
        const float rbias = a.in[I_RTB][l * 32 + i];
#pragma unroll
        for (int r = 0; r < 16; ++r) { const int ri = (r & 3) + 8 * (r >> 2) + 4 * kk; lg[ri * 33 + i] = acc[r] + rbias; }
        LDS_WAIT(); asm volatile("" ::: "memory");
        if (lane < nrow) {
            LAS float* lr = lg + lane * 33; const int orow = rb + lane;
            float tv[4]; int ti[4];
#pragma unroll
            for (int r = 0; r < 4; ++r) { float bv = -INFINITY; int bi = 0;
#pragma unroll 8
                for (int e = 0; e < 32; ++e) { const float v = lr[e]; if (v > bv) { bv = v; bi = e; } }
                tv[r] = bv; ti[r] = bi; lr[bi] = -INFINITY; }
            const float e1 = expf(tv[1] - tv[0]), e2 = expf(tv[2] - tv[0]), e3 = expf(tv[3] - tv[0]); const float inv = 1.0f / (1.0f + e1 + e2 + e3);
            *(int4*)(EIDX + orow * 4) = make_int4(ti[0], ti[1], ti[2], ti[3]); *(f32x4*)(GATE + orow * 4) = (f32x4){inv, e1 * inv, e2 * inv, e3 * inv};
#pragma unroll
            for (int r = 0; r < 4; ++r) __hip_atomic_fetch_add(&hist[ti[r]], 1, __ATOMIC_RELAXED, __HIP_MEMORY_SCOPE_WORKGROUP);
        }
        LDS_WAIT(); asm volatile("" ::: "memory");
    }
    __syncthreads();
    if (F.tid < 32) BLKCNT[F.bid * 32 + F.tid] = hist[F.tid];
    __syncthreads();
}

__device__ __forceinline__ void stage_moe_scatter(const Ctx& F, int l) {
    const auto& a = *F.a; unsigned char* ws = a.ws; const int lane = F.lane;
    const bf16* H = (const bf16*)(ws + WS_H); bf16* XS = (bf16*)(ws + WS_XS);
    const int* EIDX = (const int*)(ws + WS_EIDX); int* POS = (int*)(ws + WS_POS); const int* BLKCNT = (const int*)(ws + WS_BLKCNT); int* META = (int*)(ws + WS_META);
    LAS int* tot = (LAS int*)F.lds; LAS int* off = tot + 32; LAS int* base = tot + 64; LAS int* posl = tot + 128; LAS int* eloc = tot + 4096;
    const int rpb = (T_ALL + F.G - 1) / F.G, r0 = F.bid * rpb, r1 = (r0 + rpb < T_ALL) ? r0 + rpb : T_ALL; const int na = (r1 > r0) ? (r1 - r0) * 4 : 0;
    for (int i = F.tid; i < na; i += NTHREADS) eloc[i] = EIDX[r0 * 4 + i];
    { LAS int* part = tot + 8192; const int e = F.tid & 31, pt = F.tid >> 5; int t = 0, o = 0;
      for (int b2 = pt; b2 < F.G; b2 += 16) { const int c = BLKCNT[b2 * 32 + e]; t += c; o += (b2 < F.bid) ? c : 0; }
      part[pt * 32 + e] = t; part[512 + pt * 32 + e] = o; }
    __syncthreads();
    if (F.tid < 32) { LAS int* part = tot + 8192; int t = 0, o = 0;
#pragma unroll
        for (int pt = 0; pt < 16; ++pt) { t += part[pt * 32 + F.tid]; o += part[512 + pt * 32 + F.tid]; }
        tot[F.tid] = t; off[F.tid] = o; }
    __syncthreads();
    if (F.tid == 0) { int acc = 0; for (int e = 0; e < 32; ++e) { base[e] = acc; acc += (tot[e] + 255) & ~255; } base[32] = acc; }
    __syncthreads();
    if (F.bid == 0 && F.tid < 33) META[F.tid] = base[F.tid];
    if (F.tid < 32) { int run = base[F.tid] + off[F.tid]; for (int i = 0; i < na; ++i) { if (eloc[i] == F.tid) { posl[i] = run; POS[r0 * 4 + i] = run; ++run; } } }
    __syncthreads();
    for (int i = F.wave; i < na; i += NWAVES) { const int row = r0 + (i >> 2); const int p = posl[i];
        const v4u* s = (const v4u*)(H + (size_t)row * D) + lane; v4u* dp = (v4u*)(XS + (size_t)p * D) + lane;
        dp[0] = s[0]; dp[64] = s[64]; }
    __syncthreads();
}
__device__ __forceinline__ LAS int* load_moe_base(const Ctx& F) {
    LAS int* base = (LAS int*)(F.lds + LDSCTL_OFF + 256);
    const int* META = (const int*)(F.a->ws + WS_META);
    if (F.tid < 33) base[F.tid] = META[F.tid];
    __syncthreads();
    return base;
}

constexpr int NSTAGE_L = 13, NSTAGES = 1 + DEPTH * NSTAGE_L + 1;
__global__ void __launch_bounds__(NTHREADS, 2) mk_fwd(Args args) {
    extern __shared__ __attribute__((aligned(16))) unsigned char lds_raw[];
    Ctx F; F.a = kargs(); F.lds = (LAS unsigned char*)lds_raw; F.tid = threadIdx.x; F.lane = F.tid & 63; F.wave = __builtin_amdgcn_readfirstlane(F.tid >> 6); F.bid = blockIdx.x; F.G = gridDim.x;
    volatile LAS unsigned* MISC = (volatile LAS unsigned*)(F.lds + LDSCTL_OFF);
    for (int u = F.tid; u < (LDS_BYTES - LDSCTL_OFF) / 4; u += NTHREADS) ((LAS unsigned*)(F.lds + LDSCTL_OFF))[u] = 0u;
    __syncthreads();
#if MK_PER_STAGE
#define GRID_BAR() do { } while (0)
#else
    (void)xcd_barrier_post((unsigned*)(F.a->ws + WS_CTL) + CW_BAR, MISC + 8);
#define GRID_BAR() do { XcdBarrier b_; b_.bar = (unsigned*)(kargs()->ws + WS_CTL) + CW_BAR; b_.x = xb_xcc_id(); b_.st = (volatile LAS unsigned*)((LAS unsigned char*)lds_raw + LDSCTL_OFF + opaque(32)); xcd_barrier(b_); } while (0)
#endif
#ifndef ONLY_S
#define ONLY_S -1
#endif
#define STG_SEL(k) (ONLY_S < 0 || ONLY_S == (((k) == 0) ? 0 : ((k) == NSTAGES - 1 ? 14 : (((k) - 1) % NSTAGE_L) + 1)))
#if MK_PER_STAGE
#define IN(k) (STG_SEL(k) && kargs()->ph_lo == (k))
#else
#define IN(k) STG_SEL(k)
#endif
#if MK_PER_STAGE
#define SEAM(k) do { } while (0)
#else
#define SEAM(k) do { if ((k) + 1 < NSTAGES) GRID_BAR(); } while (0)
#endif
#define STAGE(k) if (IN(k)) { F.a = kargs(); F.tid = opaque_v((int)threadIdx.x); F.lane = F.tid & 63; F.wave = __builtin_amdgcn_readfirstlane(F.tid >> 6); F.bid = opaque((int)blockIdx.x); F.G = opaque((int)gridDim.x); F.lds = (LAS unsigned char*)lds_raw + opaque(0); unsigned char* ws = F.a->ws; const int l = opaque(lq); unsigned char* wl = ws + WS_WTS + (size_t)l * WL_STRIDE; (void)wl; (void)ws;
#define STAGE_END(k) } SEAM(k);
    int lq = 0;
    STAGE(0) p0_prologue(F); STAGE_END(0)
    for (lq = 0; lq < DEPTH; ++lq) {
        const int sb = 1 + lq * NSTAGE_L;
        STAGE(sb + 0) stage_norm1(F, l); STAGE_END(sb + 0)
        STAGE(sb + 1) pg8::SchedStatic S; S.init(ws + WS_H, wl + WO_WIN, T_ALL, IN_COLS, 1024, F.G, F.bid); pg8::EpiBf16 E{(bf16*)(ws + WS_Z), IN_COLS, nullptr, 0};
            pg8::gemm_phase(F.lds, F.tid, 1024, S, E); STAGE_END(sb + 1)
        STAGE(sb + 2) for (int rep = 0; rep < REPN(1); ++rep) stage_rw_prep1(F, l); for (int rep = 0; rep < REPN(2); ++rep) stage_s5_scan<0>(F, l); for (int rep = 0; rep < REPN(3); ++rep) stage_hy_pre(F, l); STAGE_END(sb + 2)
        STAGE(sb + 3) { pg8::SchedStatic S; S.init(ws + WS_ARW, wl + WO_RWCAT, T_ALL, 2560, 256, F.G, F.bid); pg8::EpiBf16 E{(bf16*)(ws + WS_P), 2560, nullptr, 0}; PT(4); pg8::gemm_phase(F.lds, F.tid, 256, S, E); PT(5); }
            for (int rep = 0; rep < REPN(4); ++rep) stage_s5_scan<1>(F, l); STAGE_END(sb + 3)
        STAGE(sb + 4) for (int rep = 0; rep < REPN(5); ++rep) stage_rw_prep2(F, l); for (int rep = 0; rep < REPN(6); ++rep) stage_s5_prep(F, l); STAGE_END(sb + 4)
        STAGE(sb + 5) PT(10); stage_mixer(F, l); PT(11); STAGE_END(sb + 5) STAGE(sb + 5) PT(12); }
        STAGE(sb + 6) { pg8::SchedStatic S; S.init(ws + WS_AS5, wl + WO_GLU, T_ALL, 1024, 512, F.G, F.bid); pg8::EpiGlu<0> E{(bf16*)(ws + WS_YS5), 512, F.a->in[I_S5GLUB] + l * 1024, 0, 512}; PT(13); pg8::gemm_phase(F.lds, F.tid, 512, S, E); PT(14); }
            for (int rep = 0; rep < REPN(7); ++rep) stage_rw_readout(F, l); for (int rep = 0; rep < REPN(8); ++rep) stage_hy_post(F, l); STAGE_END(sb + 6)
        STAGE(sb + 7) pg8::SchedMerge S; S.A0 = (const char*)(ws + WS_YHY); S.A1 = (const char*)(ws + WS_YRW); S.A2 = (const char*)(ws + WS_YS5); S.Bt = (const char*)(wl + WO_WBR); S.tstep = (size_t)256 * 512 * 2; S.bstride = (size_t)1024 * 512 * 2;
            S.nM = T_ALL / 256; S.nN = 4; S.G = F.G; S.c = F.bid;
            pg8::EpiMerge E{(float*)(ws + WS_MTMP), (bf16*)(ws + WS_H), (const bf16*)(ws + WS_Z) + GATE_OFF}; pg8::gemm_phase(F.lds, F.tid, 512, S, E); STAGE_END(sb + 7)
        STAGE(sb + 8) pg8::SchedStatic S; S.init(ws + WS_H, wl + WO_WOUT, T_ALL, 1024, 1024, F.G, F.bid); pg8::EpiResid E{(float*)(ws + WS_X), (const float*)(ws + WS_MOD) + (size_t)l * 9 * 6144 + 2048};
            pg8::gemm_phase(F.lds, F.tid, 1024, S, E); STAGE_END(sb + 8)
        STAGE(sb + 9) PT(17); stage_norm2_router(F, l); PT(18); STAGE_END(sb + 9)
        STAGE(sb + 10) PT(19); stage_moe_scatter(F, l); PT(20); STAGE_END(sb + 10)
        STAGE(sb + 11) LAS int* base = load_moe_base(F);
            pg8::SchedMoe S; S.A = (const char*)(ws + WS_XS); S.Bt = (const char*)(wl + WO_W1); S.tstep = (size_t)256 * 1024 * 2; S.estride = (size_t)2048 * 1024 * 2; S.NPN = 8; S.G = F.G; S.c = F.bid; S.base = base;
            pg8::EpiGlu<1> E{(bf16*)(ws + WS_ACT), 1024, F.a->in[I_B1] + (size_t)l * 32 * 2048, 2048, 1024}; pg8::gemm_phase(F.lds, F.tid, 1024, S, E); STAGE_END(sb + 11)
        STAGE(sb + 12) LAS int* base = load_moe_base(F);
            pg8::SchedMoe S; S.A = (const char*)(ws + WS_ACT); S.Bt = (const char*)(wl + WO_W2); S.tstep = (size_t)256 * 1024 * 2; S.estride = (size_t)1024 * 1024 * 2; S.NPN = 4; S.G = F.G; S.c = F.bid; S.base = base;
            pg8::EpiBf16 E{(bf16*)(ws + WS_XS), 1024, F.a->in[I_B2] + (size_t)l * 32 * 1024, 1024}; pg8::gemm_phase(F.lds, F.tid, 1024, S, E); STAGE_END(sb + 12)
    }
    lq = DEPTH;
    STAGE(NSTAGES - 1)
#ifndef PROBE_T
        stage_norm1(F, l);
#endif
#ifdef PROBE_T
        { const unsigned long long* st = (const unsigned long long*)(F.a->ws + WS_CTL + CW_STAMP * 4); const float cval = (float)(long long)(st[PROBE_B] - st[PROBE_A]) * (1.0f / (100.0f * PROBE_DIV));
          __syncthreads(); for (size_t i = (size_t)F.bid * NTHREADS + F.tid; i < (size_t)T_LAT * D; i += (size_t)F.G * NTHREADS) F.a->out[i] = cval; }
#endif
    }
#undef IN
#undef SEAM
}

extern "C" void kernel_launch(void* const* d_in, const int* in_sizes, int n_in, void* d_out, int out_size, void* d_ws, size_t ws_size, hipStream_t stream) {
    static int grid = 0;
    if (grid == 0) {
        if (n_in != 51 || out_size != T_LAT * D || ws_size < WS_END) { fprintf(stderr, "kernel_launch: unexpected shapes (n_in %d out %d ws %zu, need %zu)\n", n_in, out_size, ws_size, (size_t)WS_END); grid = -1; return; }
        int dev = 0, cus = 0, per_cu = 0;
        if (hipGetDevice(&dev) != hipSuccess || hipDeviceGetAttribute(&cus, hipDeviceAttributeMultiprocessorCount, dev) != hipSuccess) { grid = -1; return; }
        if (hipFuncSetAttribute((const void*)mk_fwd, hipFuncAttributeMaxDynamicSharedMemorySize, LDS_BYTES) != hipSuccess) { fprintf(stderr, "kernel_launch: hipFuncSetAttribute failed\n"); grid = -1; return; }
        if (hipOccupancyMaxActiveBlocksPerMultiprocessor(&per_cu, (const void*)mk_fwd, NTHREADS, LDS_BYTES) != hipSuccess || per_cu < 1) fprintf(stderr, "kernel_launch: occupancy query says %d\n", per_cu);
        (void)hipGetLastError();
        grid = cus;
    }
    if (grid < 0) return;
    if (hipMemsetAsync((char*)d_ws + WS_CTL, 0, CTL_ZERO_BYTES, stream) != hipSuccess) return;
    Args a{};
    for (int i = 0; i < 51; ++i) a.in[i] = (const float*)d_in[i];
    a.out = (float*)d_out; a.ws = (unsigned char*)d_ws;
#if MK_PER_STAGE
    for (int s = 0; s < NSTAGES; ++s) { a.ph_lo = s; a.ph_hi = s + 1; int reps = 1;
#ifdef PROBE_SET
        { const int ls = (s == 0 || s == NSTAGES - 1) ? -1 : (s - 1) % NSTAGE_L;
          if (PROBE_SET >= 1 && PROBE_SET <= 13 && ls == PROBE_SET - 1 && ls != 5 && ls != 8 && !(ls == 0 && s > 1)) reps = 3;
          if (PROBE_SET == 14 && s == 0) reps = 3; }
#endif
        for (int r = 0; r < reps; ++r) hipLaunchKernelGGL(mk_fwd, dim3(grid), dim3(NTHREADS), LDS_BYTES, stream, a); }
#else
    a.ph_lo = 0; a.ph_hi = NSTAGES; hipLaunchKernelGGL(mk_fwd, dim3(grid), dim3(NTHREADS), LDS_BYTES, stream, a);
#endif
}
```

```cpp
#include <hip/hip_runtime.h>
#include <cstdio>
#include <cstdint>

#ifndef DUPK
#define DUPK 0
#endif
#define REPN(k) ((DUPK == (k)) ? 3 : 1)
#ifndef REP_GEMM
#define REP_GEMM 1
#endif
#ifndef REP_LIGHT
#define REP_LIGHT 1
#endif
#ifndef REP_PRO
#define REP_PRO 1
#endif
#ifndef MK_PER_STAGE
#define MK_PER_STAGE 0
#endif

#define GAS __attribute__((address_space(1)))
#define LAS __attribute__((address_space(3)))
typedef unsigned short bf16;
typedef unsigned v4u __attribute__((ext_vector_type(4)));
typedef unsigned v2u __attribute__((ext_vector_type(2)));
typedef float f32x4 __attribute__((ext_vector_type(4)));
typedef float f32x2 __attribute__((ext_vector_type(2)));
typedef short bf16x8 __attribute__((ext_vector_type(8)));

constexpr int D = 1024, BATCH = 8, SEQ = 4096, CTXL = 256, DEPTH = 2;
constexpr int T_LAT = BATCH * SEQ, T_CTX = BATCH * CTXL, T_ALL = T_LAT + T_CTX;
constexpr int IN_COLS = 6912, HY_OFF = 0, RW_OFF = 1536, S5_OFF = 3328, GATE_OFF = 3840;
constexpr int NE = 32, TOPK = 4;
constexpr int MAXSLOT = 147456;
constexpr int NWAVES = 8, NTHREADS = 512;
constexpr int HY_MARG = 128, HY_ROWB = 8720, HY_RLEN = 8272, HY_RLENC = 592;
constexpr int HY_R1_OFF = 8 * HY_ROWB, HY_R2_OFF = HY_R1_OFF + HY_RLEN * 2;

constexpr size_t MiB = 1ull << 20;
constexpr size_t WS_CTL = 0, CTL_ZERO_BYTES = 1 * MiB;
constexpr size_t WS_MOD = 1 * MiB;
constexpr size_t WS_BLKCNT = 2 * MiB;
constexpr size_t WS_META = 2 * MiB + 512 * 1024;
constexpr size_t WS_EIDX = 3 * MiB, WS_GATE = 4 * MiB, WS_POS = 5 * MiB;
constexpr size_t WS_WTS = 8 * MiB, WL_STRIDE = 214 * MiB;
constexpr size_t WO_WIN = 0, WO_RWCAT = 14 * MiB, WO_GLU = 16 * MiB, WO_WBR = 17 * MiB, WO_WOUT = 20 * MiB, WO_W1 = 22 * MiB, WO_W2 = 150 * MiB;
constexpr size_t WS_GF = 436 * MiB, GF_STRIDE = 20 * MiB, GF_CTX = 17 * MiB;
constexpr size_t WS_X = 504 * MiB;
constexpr size_t WS_H = 640 * MiB;
constexpr size_t WS_BIG = 708 * MiB;
constexpr size_t WS_Z = WS_BIG;
constexpr size_t WS_SCN = 1167 * MiB;
constexpr size_t WS_MTMP = WS_SCN;
constexpr size_t WS_P = 1473 * MiB;
constexpr size_t WS_ARW = 1643 * MiB;
constexpr size_t WS_YP = 1660 * MiB;
constexpr size_t WS_YDIR = WS_YP;
constexpr size_t WS_UT = 1796 * MiB;
constexpr size_t WS_AS5 = 2000 * MiB;
constexpr size_t WS_YHY = 1898 * MiB, WS_YRW = 1932 * MiB, WS_YS5 = 1966 * MiB;
constexpr size_t WS_XS = WS_BIG;
constexpr size_t WS_ACT = WS_BIG + 288 * MiB;
constexpr size_t WS_END = 2034 * MiB;
constexpr int CW_BAR = 4096;

constexpr int RING_BYTES = 131072;
constexpr int LDSCTL_OFF = RING_BYTES;
constexpr int LDS_BYTES = 163840;

typedef __bf16 bf16x2_t __attribute__((ext_vector_type(2)));
__device__ __forceinline__ unsigned pk2(float lo, float hi) { const bf16x2_t v = __builtin_convertvector((f32x2){lo, hi}, bf16x2_t); return __builtin_bit_cast(unsigned, v); }
__device__ __forceinline__ unsigned f2bf(float f) { return pk2(f, 0.f) & 0xffffu; }
__device__ __forceinline__ float bf2f(bf16 b) { return __builtin_bit_cast(float, ((unsigned)b) << 16); }
__device__ __forceinline__ float bflo(unsigned w) { return __builtin_bit_cast(float, w << 16); }
__device__ __forceinline__ float bfhi(unsigned w) { return __builtin_bit_cast(float, w & 0xffff0000u); }
__device__ __forceinline__ float sigm(float x) { return 1.f / (1.f + __expf(-x)); }
#define LDS_WAIT() asm volatile("s_waitcnt lgkmcnt(0)" ::: "memory")
__device__ __forceinline__ float dpp_f(float x, const int ctrl_sel) {
    const int v = __builtin_bit_cast(int, x);
    int r;
    if (ctrl_sel == 0) r = __builtin_amdgcn_update_dpp(0, v, 0xB1, 0xF, 0xF, true);
    else if (ctrl_sel == 1) r = __builtin_amdgcn_update_dpp(0, v, 0x4E, 0xF, 0xF, true);
    else r = __builtin_amdgcn_update_dpp(0, v, 0x141, 0xF, 0xF, true);
    return __builtin_bit_cast(float, r);
}
__device__ __forceinline__ float red32(float x) {
    x += dpp_f(x, 0); x += dpp_f(x, 1); x += dpp_f(x, 2);
    x += __builtin_bit_cast(float, __builtin_amdgcn_update_dpp(0, __builtin_bit_cast(int, x), 0x128, 0xF, 0xF, true));
    x += __builtin_bit_cast(float, __builtin_amdgcn_ds_swizzle(__builtin_bit_cast(int, x), 0x401F));
    return x;
}
__device__ __forceinline__ float wave_sum(float v) {
    v = red32(v);
    return __builtin_bit_cast(float, __builtin_amdgcn_readlane(__builtin_bit_cast(int, v), 0)) + __builtin_bit_cast(float, __builtin_amdgcn_readlane(__builtin_bit_cast(int, v), 32));
}
__device__ __forceinline__ int xch32(int v, const int step) {
    if (step == 0) return __builtin_amdgcn_update_dpp(0, v, 0xB1, 0xF, 0xF, true);
    if (step == 1) return __builtin_amdgcn_update_dpp(0, v, 0x4E, 0xF, 0xF, true);
    if (step == 2) return __builtin_amdgcn_update_dpp(0, v, 0x141, 0xF, 0xF, true);
    if (step == 3) return __builtin_amdgcn_update_dpp(0, v, 0x128, 0xF, 0xF, true);
    return __builtin_amdgcn_ds_swizzle(v, 0x401F);
}
__device__ __forceinline__ float red8(float x) { x += dpp_f(x, 0); x += dpp_f(x, 1); x += dpp_f(x, 2); return x; }

#define XB_TMO      128
#define XB_XCNT(j)  (256  + 64 * (j))
#define XB_XSUB(j)  (1280 + 64 * (j))
#define XB_XGEN(j)  (2304 + 64 * (j))
#define XB_TOP      3328
#define XB_TOPGEN   3392
#define XCD_BAR_WORDS 3456
#define XB_SPIN_CAP (1u << 22)
__device__ __forceinline__ unsigned xb_ld(unsigned* p)              { return __hip_atomic_load(p, __ATOMIC_RELAXED, __HIP_MEMORY_SCOPE_AGENT); }
__device__ __forceinline__ unsigned xb_add(unsigned* p, unsigned v) { return __hip_atomic_fetch_add(p, v, __ATOMIC_RELAXED, __HIP_MEMORY_SCOPE_AGENT); }
__device__ __forceinline__ unsigned xb_xcc_id() { return (unsigned)__builtin_amdgcn_s_getreg((3 << 11) | 20) & 0xFu; }
#define XB_SPIN(cond, bar) do { unsigned _sp = 0; while (cond) { __builtin_amdgcn_s_sleep(1); \
    if ((++_sp & 255u) == 0u) { if (xb_ld(&(bar)[XB_TMO])) break; if (_sp > XB_SPIN_CAP) { atomicAdd(&(bar)[XB_TMO], 1u); break; } } } } while (0)
struct XcdBarrier { unsigned* bar; unsigned x; volatile LAS unsigned* st; };
__device__ __forceinline__ XcdBarrier xcd_barrier_post(unsigned* bar, volatile LAS unsigned* st) {
    XcdBarrier b; b.bar = bar; b.x = xb_xcc_id(); b.st = st;
    if (threadIdx.x == 0) (void)xb_add(&bar[XB_XCNT(b.x)], 1u);
    return b;
}
__device__ __forceinline__ void xcd_barrier_complete(unsigned* bar, unsigned x, unsigned& nloc, unsigned& nx) {
    const unsigned G = gridDim.x * gridDim.y * gridDim.z;
    unsigned sum, cnt, mine, sp = 0u;
    for (;;) {
        sum = 0u; cnt = 0u; mine = 0u;
#pragma unroll
        for (unsigned j = 0; j < 16; ++j) { const unsigned c = xb_ld(&bar[XB_XCNT(j)]); sum += c; cnt += (c > 0u) ? 1u : 0u; mine = (j == x) ? c : mine; }
        if (sum == G) break;
        __builtin_amdgcn_s_sleep(1);
        if ((++sp & 255u) == 0u) { if (xb_ld(&bar[XB_TMO])) break; if (sp > XB_SPIN_CAP) { atomicAdd(&bar[XB_TMO], 1u); break; } }
    }
    nloc = mine > 0u ? mine : 1u; nx = cnt > 0u ? cnt : 1u;
}
__device__ __forceinline__ void xcd_barrier(const XcdBarrier& b) {
    asm volatile("s_waitcnt vmcnt(0)" ::: "memory");
    __syncthreads();
    if (threadIdx.x == 0) {
        unsigned* bar = b.bar;
        __builtin_amdgcn_s_waitcnt(0);
        unsigned nloc = b.st[0], nx = b.st[1];
        if (nloc == 0u) { xcd_barrier_complete(bar, b.x, nloc, nx); b.st[0] = nloc; b.st[1] = nx; }
        const unsigned old = xb_add(&bar[XB_XSUB(b.x)], 1u);
        const unsigned gen = old / nloc;
        if (old + 1u == (gen + 1u) * nloc) {
            __builtin_amdgcn_fence(__ATOMIC_RELEASE, "agent");
            asm volatile("s_waitcnt vmcnt(0)" ::: "memory");
            const unsigned og = xb_add(&bar[XB_TOP], 1u);
            const unsigned tg = og / nx;
            if (og + 1u == (tg + 1u) * nx) xb_add(&bar[XB_TOPGEN], 1u);
            else XB_SPIN(xb_ld(&bar[XB_TOPGEN]) == tg, bar);
            __builtin_amdgcn_fence(__ATOMIC_ACQUIRE, "agent");
            xb_add(&bar[XB_XGEN(b.x)], 1u);
            asm volatile("s_waitcnt vmcnt(0)" ::: "memory");
        } else {
            XB_SPIN(xb_ld(&bar[XB_XGEN(b.x)]) == gen, bar);
            __builtin_amdgcn_fence(__ATOMIC_ACQUIRE, "agent");
            asm volatile("s_waitcnt vmcnt(0)" ::: "memory");
        }
    }
    __syncthreads();
}

namespace pg8 {
constexpr int BM = 256, BK = 64, HALF = 128, HTB = HALF * BK * 2, STAGE_BYTES = 8 * HTB, NXCD = 8, WGM = 8;
__host__ __device__ __forceinline__ int lds_byte(int r, int c) { const int st = (r >> 4) * 2 + (c >> 5), rr = r & 15, cc = c & 31, ob = rr * 64 + cc * 2; return st * 1024 + (ob ^ (((ob >> 9) & 1) << 5)); }
__host__ __device__ __forceinline__ void stage_rc(int b, int& R, int& C) { const int st = b / 1024, sb = b % 1024, swz = sb ^ (((sb >> 9) & 1) << 5); R = (st >> 1) * 16 + swz / 64; C = (st & 1) * 32 + (swz % 64) / 2; }
__host__ __device__ __forceinline__ int perm32(int rho) { const int n = rho >> 4, i = rho & 15; return 8 * (i >> 2) + 4 * n + (i & 3); }
struct Unit { int pm, pn, e; };
__device__ __forceinline__ unsigned cvt_pk_bf16(float lo, float hi) { return pk2(lo, hi); }

__device__ __forceinline__ void tile_of(int L, int nM, int nN, int& pm, int& pn) {
    const int nwg = nM * nN; int wgid = L;
    { const int q = nwg / NXCD, r = nwg % NXCD, xcd = wgid % NXCD, off = wgid / NXCD; wgid = (xcd < r ? xcd * (q + 1) : r * (q + 1) + (xcd - r) * q) + off; }
    const int nig = WGM * nN, gid = wgid / nig, fm = gid * WGM, gsz = (nM - fm) < WGM ? (nM - fm) : WGM;
    pm = fm + ((wgid % nig) % gsz); pn = (wgid % nig) / gsz;
}
struct SchedStatic {
    const char* A; const char* Bt; size_t tstep; int nM, nN, G, c;
    __device__ __forceinline__ void init(const void* A_, const void* Bt_, int M, int N, int K, int G_, int c_) { A = (const char*)A_; Bt = (const char*)Bt_; tstep = (size_t)BM * K * 2; nM = M / BM; nN = N / BM; G = G_; c = c_; }
    __device__ __forceinline__ bool next(int i, Unit& u) const { const long L = (long)i * G + c; if (L >= (long)nM * nN) return false; tile_of((int)L, nM, nN, u.pm, u.pn); u.e = 0; return true; }
    __device__ __forceinline__ const char* aptr(const Unit& u) const { return A + (size_t)u.pm * tstep; }
    __device__ __forceinline__ const char* bptr(const Unit& u) const { return Bt + (size_t)u.pn * tstep; }
};
struct SchedMerge {
    const char* A0; const char* A1; const char* A2; const char* Bt; size_t tstep, bstride; int nM, nN, G, c;
    __device__ __forceinline__ bool next(int i, Unit& u) const { const int j = i / 3, br = i - 3 * j; const long L = (long)j * G + c; if (L >= (long)nM * nN) return false; tile_of((int)L, nM, nN, u.pm, u.pn); u.e = br; return true; }
    __device__ __forceinline__ const char* aptr(const Unit& u) const { return (u.e == 0 ? A0 : (u.e == 1 ? A1 : A2)) + (size_t)u.pm * tstep; }
    __device__ __forceinline__ const char* bptr(const Unit& u) const { return Bt + (size_t)u.e * bstride + (size_t)u.pn * tstep; }
};
struct SchedMoe {
    const char* A; const char* Bt; size_t tstep, estride; int NPN, G, c; const LAS int* base;
    __device__ __forceinline__ bool next(int i, Unit& u) const {
        const int ntiles = base[32] >> 8; const long L = (long)i * G + c; if (L >= (long)ntiles * NPN) return false;
        u.pm = (int)(L / NPN); u.pn = (int)(L % NPN); const int r0 = u.pm << 8; int e = 0;
#pragma unroll 1
        for (int k = 1; k < 32; ++k) e += (r0 >= base[k]) ? 1 : 0;
        u.e = e; return true;
    }
    __device__ __forceinline__ const char* aptr(const Unit& u) const { return A + (size_t)u.pm * tstep; }
    __device__ __forceinline__ const char* bptr(const Unit& u) const { return Bt + (size_t)u.e * estride + (size_t)u.pn * tstep; }
};

template <class Epi, class Sched>
__device__ __forceinline__ void gemm_phase(LAS unsigned char* lds, const int tid, const int K, const Sched& S, const Epi& E) {
    const int wid = __builtin_amdgcn_readfirstlane(tid >> 6), lane = tid & 63, wr = wid >> 2, wc = wid & 3, fr = lane & 15, fq = lane >> 4;
    const int nt = K / BK;
    unsigned voffA[2], voffB[2];
#pragma unroll
    for (int i = 0; i < 2; ++i) { int R, C; stage_rc(tid * 16 + i * 8192, R, C); const int Rb = Epi::PERM ? ((R & ~31) + perm32(R & 31)) : R;
        voffA[i] = (unsigned)(R * K + C) * 2u; voffB[i] = (unsigned)(Rb * K + C) * 2u; }
    const size_t kstep = (size_t)(BK * 2);
    const size_t hstep = (size_t)HALF * K * 2;
    const unsigned ldsw = (unsigned)wid * 1024u;
    const int aoff = lds_byte(wr * 64 + fr, fq * 8), boff = lds_byte(wc * 32 + fr, fq * 8);
#define PG8_SA(b, h) (((b) * 2 + (h)) * HTB)
#define PG8_SB(b, h) ((4 + (b) * 2 + (h)) * HTB)
#define PG8_STAGE(bufoff, gbase, voff) do { _Pragma("unroll") for (int _i = 0; _i < 2; ++_i) \
        __builtin_amdgcn_global_load_lds((const unsigned*)((const char*)(gbase) + (voff)[_i]), (LAS unsigned*)(lds + (bufoff) + ldsw + _i * 8192), 16, 0, 0); } while (0)
#define PG8_LDA(dst, b, h) do { _Pragma("unroll") for (int m = 0; m < 4; ++m) _Pragma("unroll") for (int k = 0; k < 2; ++k) dst[m][k] = *(const LAS bf16x8*)(lds + PG8_SA(b, h) + aoff + m * 2048 + k * 1024); } while (0)
#define PG8_LDB(dst, b, h) do { _Pragma("unroll") for (int n = 0; n < 2; ++n) _Pragma("unroll") for (int k = 0; k < 2; ++k) dst[n][k] = *(const LAS bf16x8*)(lds + PG8_SB(b, h) + boff + n * 2048 + k * 1024); } while (0)
#define PG8_MMA(ai, bj, At, Bt) do { __builtin_amdgcn_s_setprio(1); _Pragma("unroll") for (int m = 0; m < 4; ++m) _Pragma("unroll") for (int n = 0; n < 2; ++n) _Pragma("unroll") for (int k = 0; k < 2; ++k) \
        acc[ai][bj][m][n] = __builtin_amdgcn_mfma_f32_16x16x32_bf16(Bt[n][k], At[m][k], acc[ai][bj][m][n], 0, 0, 0); __builtin_amdgcn_s_setprio(0); } while (0)
#define PG8_WAIT_V(n) asm volatile("s_waitcnt vmcnt(" #n ")" ::: "memory")
#define PG8_WAIT_L(n) asm volatile("s_waitcnt lgkmcnt(" #n ")" ::: "memory")
#define PG8_BAR __builtin_amdgcn_s_barrier()
#define PG8_SCHED __builtin_amdgcn_sched_barrier(0)
    Unit cur, nxt; int ui = 0;
    if (!S.next(0, cur)) return;
    f32x4 acc[2][2][4][2];
#pragma unroll
    for (int a = 0; a < 2; ++a)
#pragma unroll
        for (int b = 0; b < 2; ++b)
#pragma unroll
            for (int m = 0; m < 4; ++m)
#pragma unroll
                for (int n = 0; n < 2; ++n) acc[a][b][m][n] = (f32x4){0.f, 0.f, 0.f, 0.f};
    bf16x8 At[4][2], B0[2][2], B1[2][2];
    const char* cA = S.aptr(cur); const char* cB = S.bptr(cur);
    PG8_STAGE(PG8_SB(0, 0), cB, voffB); PG8_STAGE(PG8_SB(0, 1), cB + hstep, voffB); PG8_STAGE(PG8_SA(0, 0), cA, voffA); PG8_STAGE(PG8_SA(0, 1), cA + hstep, voffA);
    if (wr == 1) PG8_BAR;
    PG8_WAIT_V(2); PG8_BAR;
    PG8_STAGE(PG8_SB(1, 0), cB + kstep, voffB); PG8_STAGE(PG8_SA(1, 0), cA + kstep, voffA); PG8_STAGE(PG8_SB(1, 1), cB + hstep + kstep, voffB);
    PG8_WAIT_V(6); PG8_BAR;
    for (;;) {
        const bool has_next = S.next(ui + 1, nxt);
        const char* nA = has_next ? S.aptr(nxt) : cA; const char* nB = has_next ? S.bptr(nxt) : cB;
        for (int t = 0; t < nt; t += 2) {
            const bool last = (t == nt - 2);
            const char* a1 = cA + (size_t)(t + 1) * kstep;
            const char* a2 = last ? nA : cA + (size_t)(t + 2) * kstep; const char* b2 = last ? nB : cB + (size_t)(t + 2) * kstep;
            const char* a3 = a2 + kstep; const char* b3 = b2 + kstep;
            PG8_LDB(B0, 0, 0); PG8_LDB(B1, 0, 1); PG8_SCHED; PG8_LDA(At, 0, 0); PG8_STAGE(PG8_SA(1, 1), a1 + hstep, voffA);
            PG8_WAIT_V(8); PG8_WAIT_L(0); PG8_BAR; PG8_MMA(0, 0, At, B0); PG8_MMA(0, 1, At, B1); PG8_BAR; PG8_SCHED;
            PG8_LDA(At, 0, 1); PG8_STAGE(PG8_SB(0, 0), b2, voffB); PG8_STAGE(PG8_SB(0, 1), b2 + hstep, voffB); PG8_STAGE(PG8_SA(0, 0), a2, voffA);
            PG8_WAIT_V(8); PG8_WAIT_L(0); PG8_BAR; PG8_MMA(1, 0, At, B0); PG8_MMA(1, 1, At, B1); PG8_BAR; PG8_SCHED;
            PG8_LDB(B0, 1, 0); PG8_LDB(B1, 1, 1); PG8_SCHED; PG8_LDA(At, 1, 0); PG8_STAGE(PG8_SA(0, 1), a2 + hstep, voffA);
            PG8_WAIT_V(8); PG8_WAIT_L(0); PG8_BAR; PG8_MMA(0, 0, At, B0); PG8_MMA(0, 1, At, B1); PG8_BAR; PG8_SCHED;
            PG8_LDA(At, 1, 1); PG8_STAGE(PG8_SB(1, 0), b3, voffB); PG8_STAGE(PG8_SB(1, 1), b3 + hstep, voffB); PG8_STAGE(PG8_SA(1, 0), a3, voffA);
            PG8_WAIT_V(8); PG8_WAIT_L(0); PG8_BAR; PG8_MMA(1, 0, At, B0); PG8_MMA(1, 1, At, B1); PG8_BAR; PG8_SCHED;
        }
        if (wr == 0) PG8_BAR;
        E(acc, cur, wr, wc, fr, fq);
        if (!has_next) break;
#pragma unroll
        for (int a = 0; a < 2; ++a)
#pragma unroll
            for (int b = 0; b < 2; ++b)
#pragma unroll
                for (int m = 0; m < 4; ++m)
#pragma unroll
                    for (int n = 0; n < 2; ++n) acc[a][b][m][n] = (f32x4){0.f, 0.f, 0.f, 0.f};
        cur = nxt; cA = nA; cB = nB; ++ui;
        if (wr == 1) PG8_BAR;
    }
    PG8_WAIT_V(0);
    PG8_BAR;
#undef PG8_SA
#undef PG8_SB
#undef PG8_STAGE
#undef PG8_LDA
#undef PG8_LDB
#undef PG8_MMA
#undef PG8_WAIT_V
#undef PG8_WAIT_L
#undef PG8_BAR
#undef PG8_SCHED
}

struct EpiBf16 {
    static constexpr bool PERM = true;
    bf16* O; int ldc; const float* bias; int bias_stride;
    __device__ __forceinline__ void operator()(const f32x4 (&acc)[2][2][4][2], const Unit& u, int wr, int wc, int fr, int fq) const {
        const int row0 = u.pm * BM + wr * 64 + fr, col0 = u.pn * BM + wc * 32 + 8 * fq;
        f32x4 bv[2][2];
#pragma unroll
        for (int bj = 0; bj < 2; ++bj)
#pragma unroll
            for (int n = 0; n < 2; ++n) bv[bj][n] = bias ? *(const f32x4*)(bias + (size_t)u.e * bias_stride + col0 + bj * HALF + 4 * n) : (f32x4){0.f, 0.f, 0.f, 0.f};
#pragma unroll
        for (int ai = 0; ai < 2; ++ai)
#pragma unroll
            for (int m = 0; m < 4; ++m) { bf16* rowp = O + (size_t)(row0 + ai * HALF + m * 16) * ldc + col0;
#pragma unroll
                for (int bj = 0; bj < 2; ++bj) { const f32x4 v0 = acc[ai][bj][m][0] + bv[bj][0], v1 = acc[ai][bj][m][1] + bv[bj][1];
                    v4u w; w.x = cvt_pk_bf16(v0[0], v0[1]); w.y = cvt_pk_bf16(v0[2], v0[3]); w.z = cvt_pk_bf16(v1[0], v1[1]); w.w = cvt_pk_bf16(v1[2], v1[3]);
                    *(v4u*)(rowp + bj * HALF) = w; } }
    }
};
template <int MODE> struct EpiGlu {
    static constexpr bool PERM = true;
    bf16* O; int ldc; const float* bias; int bias_stride, hs;
    __device__ __forceinline__ void operator()(const f32x4 (&acc)[2][2][4][2], const Unit& u, int wr, int wc, int fr, int fq) const {
        const int row0 = u.pm * BM + wr * 64 + fr, col0 = u.pn * HALF + wc * 32 + 8 * fq;
        const float* bp = bias + (size_t)u.e * bias_stride + col0;
        f32x4 ba[2], bb[2];
#pragma unroll
        for (int n = 0; n < 2; ++n) { ba[n] = *(const f32x4*)(bp + 4 * n); bb[n] = *(const f32x4*)(bp + hs + 4 * n); }
#pragma unroll
        for (int ai = 0; ai < 2; ++ai)
#pragma unroll
            for (int m = 0; m < 4; ++m) { bf16* rowp = O + (size_t)(row0 + ai * HALF + m * 16) * ldc + col0;
                float o[8];
#pragma unroll
                for (int n = 0; n < 2; ++n) { const f32x4 a = acc[ai][0][m][n] + ba[n], b = acc[ai][1][m][n] + bb[n];
#pragma unroll
                    for (int j = 0; j < 4; ++j) {
                        if (MODE == 0) o[4 * n + j] = a[j] * sigm(b[j]);
                        else { const float g = fminf(a[j], 7.f), up = fminf(fmaxf(b[j], -7.f), 7.f); o[4 * n + j] = (up + 1.f) * g * sigm(1.702f * g); } } }
                v4u w; w.x = cvt_pk_bf16(o[0], o[1]); w.y = cvt_pk_bf16(o[2], o[3]); w.z = cvt_pk_bf16(o[4], o[5]); w.w = cvt_pk_bf16(o[6], o[7]);
                *(v4u*)rowp = w; }
    }
};
struct EpiMerge {
    static constexpr bool PERM = true;
    float* mtmp; bf16* Mo; const bf16* zg;
    __device__ __forceinline__ void operator()(const f32x4 (&acc)[2][2][4][2], const Unit& u, int wr, int wc, int fr, int fq) const {
        const int row0 = u.pm * BM + wr * 64 + fr, col0 = u.pn * BM + wc * 32 + 8 * fq;
#pragma unroll
        for (int ai = 0; ai < 2; ++ai)
#pragma unroll
            for (int m = 0; m < 4; ++m) { const size_t r = (size_t)(row0 + ai * HALF + m * 16);
#pragma unroll
                for (int bj = 0; bj < 2; ++bj) { const int c = col0 + bj * HALF;
                    const v4u gz = *(const v4u*)(zg + r * IN_COLS + u.e * 1024 + c);
                    float g[8] = {bflo(gz.x), bfhi(gz.x), bflo(gz.y), bfhi(gz.y), bflo(gz.z), bfhi(gz.z), bflo(gz.w), bfhi(gz.w)};
                    f32x4 t0, t1; float* tp = mtmp + r * 1024 + c;
                    if (u.e == 0) { t0 = (f32x4){0.f, 0.f, 0.f, 0.f}; t1 = t0; } else { t0 = *(const f32x4*)tp; t1 = *(const f32x4*)(tp + 4); }
#pragma unroll
                    for (int j = 0; j < 4; ++j) { t0[j] += sigm(g[j]) * acc[ai][bj][m][0][j]; t1[j] += sigm(g[4 + j]) * acc[ai][bj][m][1][j]; }
                    if (u.e < 2) { *(f32x4*)tp = t0; *(f32x4*)(tp + 4) = t1; }
                    else { v4u w; w.x = cvt_pk_bf16(t0[0], t0[1]); w.y = cvt_pk_bf16(t0[2], t0[3]); w.z = cvt_pk_bf16(t1[0], t1[1]); w.w = cvt_pk_bf16(t1[2], t1[3]);
                        *(v4u*)(Mo + r * 1024 + c) = w; } } }
    }
};
struct EpiResid {
    static constexpr bool PERM = false;
    float* X; const float* gmod;
    __device__ __forceinline__ void operator()(const f32x4 (&acc)[2][2][4][2], const Unit& u, int wr, int wc, int fr, int fq) const {
        const int row0 = u.pm * BM + wr * 64 + fr, col0 = u.pn * BM + wc * 32 + 4 * fq;
        const int r00 = u.pm * BM; const int w = r00 < T_LAT ? (r00 >> 12) : 8;
        f32x4 gv[2][2];
#pragma unroll
        for (int bj = 0; bj < 2; ++bj)
#pragma unroll
            for (int n = 0; n < 2; ++n) gv[bj][n] = *(const f32x4*)(gmod + (size_t)w * 6144 + col0 + bj * HALF + n * 16);
#pragma unroll
        for (int ai = 0; ai < 2; ++ai)
#pragma unroll
            for (int m = 0; m < 4; ++m) { float* rowp = X + (size_t)(row0 + ai * HALF + m * 16) * 1024 + col0;
#pragma unroll
                for (int bj = 0; bj < 2; ++bj)
#pragma unroll
                    for (int n = 0; n < 2; ++n) { f32x4* p = (f32x4*)(rowp + bj * HALF + n * 16); *p = *p + gv[bj][n] * acc[ai][bj][m][n]; } }
    }
};
}

struct Args { const float* in[51]; float* out; unsigned char* ws; int ph_lo, ph_hi; };
enum { I_X = 0, I_C, I_CTX, I_CCTX, I_ADAW, I_ADAB, I_N1G, I_N2G, I_WIN, I_HYCW, I_HYCB, I_HYW1, I_HYB1, I_HYF1, I_HYW2, I_HYB2, I_HYF2, I_HYW3, I_HYB3, I_HYBIAS,
       I_RWCW, I_RWCB, I_RWWUP, I_RWW0, I_RWAUP, I_RWA0, I_RWGUP, I_RWKK, I_RWKA, I_RWRK, I_RWLNG, I_RWLNB, I_S5ARE, I_S5AIM, I_S5LDT, I_S5BRE, I_S5BIM, I_S5CRE, I_S5CIM, I_S5D,
       I_S5GLUW, I_S5GLUB, I_WBR, I_WOUT, I_RTW, I_RTB, I_W1, I_B1, I_W2, I_B2, I_FING };

typedef const __attribute__((address_space(4))) Args* CArgsP;
__device__ __forceinline__ CArgsP kargs() { CArgsP p = (CArgsP)__builtin_amdgcn_kernarg_segment_ptr(); asm volatile("" : "+s"(p)); return p; }
__device__ __forceinline__ int opaque(int v) { asm volatile("" : "+s"(v)); return v; }
__device__ __forceinline__ int opaque_v(int v) { asm volatile("" : "+v"(v)); return v; }
struct Ctx { CArgsP a; LAS unsigned char* lds; int tid, lane, wave, bid, G; };

__device__ __forceinline__ void row_seq(int row, int& base, int& pos, int& n) {
    if (row < T_LAT) { base = row & ~(SEQ - 1); pos = row & (SEQ - 1); n = SEQ; }
    else { const int r = row - T_LAT; base = T_LAT + (r & ~(CTXL - 1)); pos = r & (CTXL - 1); n = CTXL; }
}
__device__ __forceinline__ float conv3z(const bf16* zc, int pos, int n, float w0, float w1, float w2, float b) {
    const float zm = pos > 0 ? bf2f(zc[(size_t)(pos - 1) * IN_COLS]) : 0.f, z0 = bf2f(zc[(size_t)pos * IN_COLS]), zp = pos < n - 1 ? bf2f(zc[(size_t)(pos + 1) * IN_COLS]) : 0.f;
    return zm * w0 + z0 * w1 + zp * w2 + b;
}

template <int MODE>
__device__ __forceinline__ void transpose_item(const float* W, int K, int N, bf16* WT, int Hs, LAS float* scr, int item, int lane) {
    const int nblk = N / 32, kb = item / nblk, nb = item % nblk, k0 = 64 * kb, n0 = 32 * nb;
#pragma unroll 8
    for (int i = 0; i < 32; ++i) { const int kk = 2 * i + (lane >> 5); scr[kk * 33 + (lane & 31)] = W[(size_t)(k0 + kk) * N + n0 + (lane & 31)]; }
    LDS_WAIT(); asm volatile("" ::: "memory");
    const int c = lane & 7;
#pragma unroll
    for (int j = 0; j < 4; ++j) { const int n = (lane >> 3) + 8 * j; const LAS float* s = scr + (8 * c) * 33 + n;
        v4u o; o.x = pk2(s[0 * 33], s[1 * 33]); o.y = pk2(s[2 * 33], s[3 * 33]); o.z = pk2(s[4 * 33], s[5 * 33]); o.w = pk2(s[6 * 33], s[7 * 33]);
        int dr = n0 + n;
        if (MODE == 1) { const int nc = n0 + n; const int jx = nc < Hs ? nc : nc - Hs; dr = (jx >> 7) * 256 + (nc < Hs ? 0 : 128) + (jx & 127); }
        *(v4u*)(WT + (size_t)dr * K + k0 + 8 * c) = o; }
    LDS_WAIT(); asm volatile("" ::: "memory");
}

__device__ __forceinline__ void p0_prologue(const Ctx& F) {
    const auto& a = *F.a; unsigned char* ws = a.ws;
    const int gw = F.bid * NWAVES + F.wave, NGW = F.G * NWAVES, lane = F.lane;
    float* X = (float*)(ws + WS_X);
    for (int t = gw; t < SEQ; t += NGW) {
        const float pr = (float)(t >> 6), pc = (float)(t & 63);
        f32x4 pe[4];
#pragma unroll
        for (int j = 0; j < 4; ++j)
#pragma unroll
            for (int e = 0; e < 4; ++e) { const float om = 1.0f / powf(10000.0f, (float)(4 * lane + e) / 256.0f); const float ang = ((j < 2) ? pr : pc) * om; pe[j][e] = (j & 1) ? cosf(ang) : sinf(ang); }
#pragma unroll 2
        for (int bb = 0; bb < BATCH; ++bb) { const size_t row = (size_t)bb * SEQ + t;
            const f32x4* xi = (const f32x4*)(a.in[I_X] + row * D) + lane; f32x4* xo = (f32x4*)(X + row * D) + lane;
#pragma unroll
            for (int j = 0; j < 4; ++j) xo[64 * j] = xi[64 * j] + pe[j]; }
    }
    for (int row = T_LAT + gw; row < T_ALL; row += NGW) {
        const f32x4* xi = (const f32x4*)(a.in[I_CTX] + (size_t)(row - T_LAT) * D) + lane; f32x4* xo = (f32x4*)(X + (size_t)row * D) + lane;
#pragma unroll
        for (int j = 0; j < 4; ++j) xo[64 * j] = xi[64 * j];
    }
    {
        LAS float* condl = (LAS float*)F.lds; LAS float* psum = (LAS float*)(F.lds + 40960);
        for (int i = F.tid; i < 9 * 1024; i += NTHREADS) { const int w = i >> 10, k = i & 1023; const float cv = (w < 8) ? a.in[I_C][w * 1024 + k] : a.in[I_CCTX][k]; condl[i] = cv / (1.f + expf(-cv)); }
        __syncthreads();
        float* MOD = (float*)(ws + WS_MOD);
        for (int it = F.bid; it < 2 * 96; it += F.G) {
            const int l = it / 96, cg = it % 96, col = cg * 64 + lane;
            float acc[9];
#pragma unroll
            for (int w = 0; w < 9; ++w) acc[w] = 0.f;
            const float* wp = a.in[I_ADAW] + ((size_t)l * 1024 + F.wave * 128) * 6144 + col;
#pragma unroll 1
            for (int k0 = 0; k0 < 128; k0 += 16) { float wv[16];
#pragma unroll
                for (int k = 0; k < 16; ++k) wv[k] = wp[(size_t)(k0 + k) * 6144];
#pragma unroll
                for (int k = 0; k < 16; ++k)
#pragma unroll
                    for (int w = 0; w < 9; ++w) acc[w] += condl[w * 1024 + F.wave * 128 + k0 + k] * wv[k]; }
#pragma unroll
            for (int w = 0; w < 9; ++w) psum[(F.wave * 9 + w) * 64 + lane] = acc[w];
            __syncthreads();
            if (F.wave == 0) {
#pragma unroll
                for (int w = 0; w < 9; ++w) { float s = 0.f;
#pragma unroll
                    for (int wv = 0; wv < 8; ++wv) s += psum[(wv * 9 + w) * 64 + lane];
                    MOD[(size_t)(l * 9 + w) * 6144 + col] = s + a.in[I_ADAB][l * 6144 + col]; }
            }
            __syncthreads();
        }
    }
    {
        LAS float* scr = (LAS float*)(F.lds + F.wave * 16384);
        constexpr int IT_W1 = 16 * 64, IT_W2 = 16 * 32, IT_WIN = 16 * 216, IT_GLU = 8 * 32, IT_WBR = 8 * 32, IT_WOUT = 16 * 32;
        constexpr int N_W1 = 64 * IT_W1, N_W2 = 64 * IT_W2, N_WIN = 2 * IT_WIN, N_GLU = 2 * IT_GLU, N_WBR = 6 * IT_WBR, N_WOUT = 2 * IT_WOUT;
        constexpr int NITEMS = N_W1 + N_W2 + N_WIN + N_GLU + N_WBR + N_WOUT;
        for (int it = gw; it < NITEMS; it += NGW) {
            int r = it;
            if (r < N_W1) { const int mtx = r / IT_W1, l = mtx >> 5, e = mtx & 31; transpose_item<1>(a.in[I_W1] + (size_t)mtx * 1024 * 2048, 1024, 2048, (bf16*)(ws + WS_WTS + l * WL_STRIDE + WO_W1) + (size_t)e * 2048 * 1024, 1024, scr, r % IT_W1, lane); continue; } r -= N_W1;
            if (r < N_W2) { const int mtx = r / IT_W2, l = mtx >> 5, e = mtx & 31; transpose_item<0>(a.in[I_W2] + (size_t)mtx * 1024 * 1024, 1024, 1024, (bf16*)(ws + WS_WTS + l * WL_STRIDE + WO_W2) + (size_t)e * 1024 * 1024, 0, scr, r % IT_W2, lane); continue; } r -= N_W2;
            if (r < N_WIN) { const int l = r / IT_WIN; transpose_item<0>(a.in[I_WIN] + (size_t)l * 1024 * IN_COLS, 1024, IN_COLS, (bf16*)(ws + WS_WTS + l * WL_STRIDE + WO_WIN), 0, scr, r % IT_WIN, lane); continue; } r -= N_WIN;
            if (r < N_GLU) { const int l = r / IT_GLU; transpose_item<1>(a.in[I_S5GLUW] + (size_t)l * 512 * 1024, 512, 1024, (bf16*)(ws + WS_WTS + l * WL_STRIDE + WO_GLU), 512, scr, r % IT_GLU, lane); continue; } r -= N_GLU;
            if (r < N_WBR) { const int mtx = r / IT_WBR, l = mtx / 3, br = mtx % 3; transpose_item<0>(a.in[I_WBR] + (size_t)mtx * 512 * 1024, 512, 1024, (bf16*)(ws + WS_WTS + l * WL_STRIDE + WO_WBR) + (size_t)br * 1024 * 512, 0, scr, r % IT_WBR, lane); continue; } r -= N_WBR;
            { const int l = r / IT_WOUT; transpose_item<0>(a.in[I_WOUT] + (size_t)l * 1024 * 1024, 1024, 1024, (bf16*)(ws + WS_WTS + l * WL_STRIDE + WO_WOUT), 0, scr, r % IT_WOUT, lane); }
        }
        for (int i = F.bid * NTHREADS + F.tid; i < 2 * 2560 * 256; i += F.G * NTHREADS) {
            const int l = i / (2560 * 256), r = i % (2560 * 256), n = r >> 8, k = r & 255; float v = 0.f;
            if (n < 1024) { if (k < 64) v = a.in[I_RWWUP][(((size_t)l * 2 + (n >> 9)) * 64 + k) * 512 + (n & 511)]; }
            else if (n < 2048) { if (k >= 64 && k < 128) v = a.in[I_RWAUP][(((size_t)l * 2 + ((n - 1024) >> 9)) * 64 + (k - 64)) * 512 + (n & 511)]; }
            else { if (k >= 128) v = a.in[I_RWGUP][((size_t)l * 128 + (k - 128)) * 512 + (n - 2048)]; }
            ((bf16*)(ws + WS_WTS + l * WL_STRIDE + WO_RWCAT))[r] = (bf16)f2bf(v);
        }
    }
    __syncthreads();
    {
        LAS float* feats = (LAS float*)F.lds; LAS float* h1 = feats + 8 * 33; LAS float* h2 = h1 + 8 * 64;
        constexpr int NIT = 2 * (512 + 32);
        for (int it = F.bid; it < NIT; it += F.G) {
            const int l = it / 544, r = it % 544, nsel = r >= 512, n = nsel ? CTXL : SEQ, p0 = (nsel ? r - 512 : r) * 8;
            if (F.tid < 8 * 33) { const int p = F.tid / 33, i = F.tid % 33, pos = p0 + p; float f;
                if (i == 0) f = (float)pos / (float)(n - 1);
                else { const int k = (i - 1) & 15; const float band = 1e-4f + (float)k * ((15.0f - 1e-4f) / 15.0f); const float ang = (6.283185307179586f * (float)pos / (float)n) * band; f = (i <= 16) ? cosf(ang) : -sinf(ang); }
                feats[p * 33 + i] = f; }
            __syncthreads();
            { const int p = F.tid >> 6, j = F.tid & 63; float s = a.in[I_HYB1][l * 64 + j]; const float* w1p = a.in[I_HYW1] + (size_t)l * 33 * 64 + j;
#pragma unroll
                for (int i = 0; i < 33; ++i) s += feats[p * 33 + i] * w1p[i * 64];
                h1[p * 64 + j] = sinf(a.in[I_HYF1][l * 64 + j] * s); }
            __syncthreads();
            { const int p = F.tid >> 6, j = F.tid & 63; float s = a.in[I_HYB2][l * 64 + j];
                const float* w2p = a.in[I_HYW2] + (size_t)l * 64 * 64 + j;
#pragma unroll 16
                for (int i = 0; i < 64; ++i) s += h1[p * 64 + i] * w2p[i * 64];
                h2[p * 64 + j] = sinf(a.in[I_HYF2][l * 64 + j] * s); }
            __syncthreads();
            float acc[4][8];
#pragma unroll
            for (int q = 0; q < 4; ++q)
#pragma unroll
                for (int p = 0; p < 8; ++p) acc[q][p] = 0.f;
            const float* w3 = a.in[I_HYW3] + (size_t)l * 64 * 2048 + F.tid;
#pragma unroll 8
            for (int i = 0; i < 64; ++i) { float wv[4];
#pragma unroll
                for (int q = 0; q < 4; ++q) wv[q] = w3[(size_t)i * 2048 + q * 512];
#pragma unroll
                for (int p = 0; p < 8; ++p) { const float hv = h2[p * 64 + i];
#pragma unroll
                    for (int q = 0; q < 4; ++q) acc[q][p] += hv * wv[q]; } }
            const int c = F.tid; const float dstart = logf(0.01f) / 1.5f, dstop = logf(0.01f) / 0.3f; const float delta = fabsf(dstart + (float)c * ((dstop - dstart) / 511.0f));
            const int RL = nsel ? HY_RLENC : HY_RLEN, off = n + 47;
            bf16* Rb = (bf16*)(ws + WS_GF + l * GF_STRIDE + (nsel ? GF_CTX : 0));
#pragma unroll
            for (int q = 0; q < 4; ++q) { const int o = q >> 1, side = q & 1; const float b3 = a.in[I_HYB3][l * 2048 + q * 512 + c];
                bf16* Rc = Rb + ((size_t)o * 512 + c) * RL;
#pragma unroll
                for (int p = 0; p < 8; ++p) { const int pos = p0 + p; const float t = (float)pos / (float)(n - 1); const float val = (acc[q][p] + b3) * expf(-t * delta);
                    if (side == 0) Rc[off - pos] = (bf16)f2bf(val);
                    else if (pos >= 1) Rc[off + pos] = (bf16)f2bf(val); }
                if (p0 == 0 && side == 0) { for (int m = 0; m < 48; ++m) Rc[m] = 0; for (int m = off + n; m < RL; ++m) Rc[m] = 0; } }
            __syncthreads();
        }
    }
}

__device__ __forceinline__ void stage_norm1(const Ctx& F, int l) {
    const auto& a = *F.a; unsigned char* ws = a.ws; const int lane = F.lane;
    const int gw = F.bid * NWAVES + F.wave, NGW = F.G * NWAVES;
    float* X = (float*)(ws + WS_X); bf16* H = (bf16*)(ws + WS_H); const float* MOD = (const float*)(ws + WS_MOD);
    const bf16* YS = (const bf16*)(ws + WS_XS); const int* POS = (const int*)(ws + WS_POS); const float* GATE = (const float*)(ws + WS_GATE);
    const int nrows = (l == DEPTH) ? T_LAT : T_ALL;
    for (int row = gw; row < nrows; row += NGW) {
        const int w = row < T_LAT ? (row >> 12) : 8;
        f32x4* xr = (f32x4*)(X + (size_t)row * D) + lane;
        f32x4 v[4];
#pragma unroll
        for (int j = 0; j < 4; ++j) v[j] = xr[64 * j];
        if (l > 0) {
            f32x4 mo[4];
#pragma unroll
            for (int j = 0; j < 4; ++j) mo[j] = (f32x4){0.f, 0.f, 0.f, 0.f};
#pragma unroll
            for (int k = 0; k < TOPK; ++k) { const int p = POS[row * 4 + k]; const float g = GATE[row * 4 + k];
                const v2u* yr = (const v2u*)(YS + (size_t)p * D) + lane;
#pragma unroll
                for (int j = 0; j < 4; ++j) { const v2u y = yr[64 * j]; mo[j][0] += g * bflo(y.x); mo[j][1] += g * bfhi(y.x); mo[j][2] += g * bflo(y.y); mo[j][3] += g * bfhi(y.y); } }
            const f32x4* g2 = (const f32x4*)(MOD + (size_t)((l - 1) * 9 + w) * 6144 + 5120) + lane;
#pragma unroll
            for (int j = 0; j < 4; ++j) { v[j] = v[j] + g2[64 * j] * mo[j]; xr[64 * j] = v[j]; }
        }
        float ss = 0.f;
#pragma unroll
        for (int j = 0; j < 4; ++j) ss += (v[j][0] * v[j][0] + v[j][1] * v[j][1]) + (v[j][2] * v[j][2] + v[j][3] * v[j][3]);
        const float rstd = 1.0f / sqrtf(wave_sum(ss) * (1.f / D) + 1e-6f);
        if (l == DEPTH) {
            const f32x4* fg = (const f32x4*)a.in[I_FING] + lane; f32x4* o = (f32x4*)(a.out + (size_t)row * D) + lane;
#pragma unroll
            for (int j = 0; j < 4; ++j) o[64 * j] = v[j] * rstd * fg[64 * j];
        } else {
            const f32x4* ng = (const f32x4*)(a.in[I_N1G] + l * D) + lane;
            const f32x4* sh = (const f32x4*)(MOD + (size_t)(l * 9 + w) * 6144) + lane; const f32x4* sc = (const f32x4*)(MOD + (size_t)(l * 9 + w) * 6144 + 1024) + lane;
            v2u* ho = (v2u*)(H + (size_t)row * D) + lane;
#pragma unroll
            for (int j = 0; j < 4; ++j) { const f32x4 h = v[j] * rstd * ng[64 * j] * (sc[64 * j] + 1.0f) + sh[64 * j]; v2u o; o.x = pk2(h[0], h[1]); o.y = pk2(h[2], h[3]); ho[64 * j] = o; }
        }
    }
}

__device__ __forceinline__ void stage_rw_prep1(const Ctx& F, int l) {
    const auto& a = *F.a; unsigned char* ws = a.ws;
    const bf16* Z = (const bf16*)(ws + WS_Z); bf16* ARW = (bf16*)(ws + WS_ARW);
    const int j = F.tid & 255, col = 1536 + j;
    const float* cw = a.in[I_RWCW] + (size_t)l * 3 * 1792; const float w0 = cw[col], w1 = cw[1792 + col], w2 = cw[2 * 1792 + col], cb = a.in[I_RWCB][l * 1792 + col];
    for (int row = F.bid * 2 + (F.tid >> 8); row < T_ALL; row += F.G * 2) {
        int base, pos, n; row_seq(row, base, pos, n);
        float v = conv3z(Z + (size_t)base * IN_COLS + RW_OFF + col, pos, n, w0, w1, w2, cb);
        if (j < 64) v = tanhf(v); else if (j >= 128) v = sigm(v);
        ARW[(size_t)row * 256 + j] = (bf16)f2bf(v);
    }
}

__device__ __forceinline__ void stage_rw_prep2(const Ctx& F, int l) {
    const auto& a = *F.a; unsigned char* ws = a.ws; const int lane = F.lane;
    const bf16* Z = (const bf16*)(ws + WS_Z); const bf16* P = (const bf16*)(ws + WS_P); bf16* SCN = (bf16*)(ws + WS_SCN);
    const int gw = F.bid * NWAVES + F.wave, NGW = F.G * NWAVES;
    constexpr int TR = 17, NRT = T_ALL / TR;
    const float* cw = a.in[I_RWCW] + (size_t)l * 3 * 1792; const float* cbp = a.in[I_RWCB] + l * 1792;
    for (int tile = gw; tile < NRT * 4; tile += NGW) {
        const int rt = tile % NRT, hp = tile / NRT, row0 = rt * TR, c0 = hp * 128 + 2 * lane;
        f32x2 w[3][3], cb[3];
#pragma unroll
        for (int s = 0; s < 3; ++s) { cb[s] = *(const f32x2*)(cbp + s * 512 + c0);
#pragma unroll
            for (int j = 0; j < 3; ++j) w[s][j] = *(const f32x2*)(cw + j * 1792 + s * 512 + c0); }
        const f32x2 KKw = *(const f32x2*)(a.in[I_RWKK] + l * 512 + c0), KAw = *(const f32x2*)(a.in[I_RWKA] + l * 512 + c0);
        f32x2 W0[2], A0[2];
#pragma unroll
        for (int d = 0; d < 2; ++d) { W0[d] = *(const f32x2*)(a.in[I_RWW0] + (l * 2 + d) * 512 + c0); A0[d] = *(const f32x2*)(a.in[I_RWA0] + (l * 2 + d) * 512 + c0); }
        const unsigned* zb = (const unsigned*)(Z + RW_OFF + c0);
        unsigned zm[3], z0[3], zp[3];
#pragma unroll
        for (int s = 0; s < 3; ++s) { zm[s] = row0 > 0 ? zb[(size_t)(row0 - 1) * (IN_COLS / 2) + s * 256] : 0u; z0[s] = zb[(size_t)row0 * (IN_COLS / 2) + s * 256]; }
#pragma unroll 1
        for (int i = 0; i < TR; ++i) {
            const int row = row0 + i; int base, pos, n; row_seq(row, base, pos, n);
#pragma unroll
            for (int s = 0; s < 3; ++s) zp[s] = (row + 1 < T_ALL) ? zb[(size_t)(row + 1) * (IN_COLS / 2) + s * 256] : 0u;
            const float mlo = pos > 0 ? 1.f : 0.f, mhi = pos < n - 1 ? 1.f : 0.f;
            f32x2 u[3];
#pragma unroll
            for (int s = 0; s < 3; ++s) { u[s] = (f32x2){bflo(zm[s]), bfhi(zm[s])} * mlo * w[s][0] + (f32x2){bflo(z0[s]), bfhi(z0[s])} * w[s][1] + (f32x2){bflo(zp[s]), bfhi(zp[s])} * mhi * w[s][2] + cb[s]; zm[s] = z0[s]; z0[s] = zp[s]; }
            const f32x2 r = u[0], k = u[1], v = u[2];
            f32x2 kk = k * KKw;
            const float ss = red32(kk[0] * kk[0] + kk[1] * kk[1]);
            kk = kk * (1.0f / sqrtf(fmaxf(ss, 1e-24f)));
            const unsigned* pr = (const unsigned*)(P + (size_t)row * 2560 + c0);
            unsigned* o = (unsigned*)(SCN + (size_t)row * 9 * 512 + c0);
            o[0] = pk2(r[0], r[1]); o[256] = pk2(v[0], v[1]); o[2 * 256] = pk2(kk[0], kk[1]);
#pragma unroll
            for (int d = 0; d < 2; ++d) {
                const unsigned pw = pr[d * 256], pa = pr[512 + d * 256];
                float ld[2], kd[2], be[2];
#pragma unroll
                for (int e = 0; e < 2; ++e) {
                    const float uu = W0[d][e] + (e ? bfhi(pw) : bflo(pw));
                    ld[e] = -0.60653065971263342f * sigm(uu);
                    const float av = sigm(A0[d][e] + (e ? bfhi(pa) : bflo(pa)));
                    kd[e] = k[e] * (1.f + (av - 1.f) * KAw[e]); be[e] = kk[e] * av; }
                o[(3 + 3 * d) * 256] = pk2(ld[0], ld[1]); o[(4 + 3 * d) * 256] = pk2(kd[0], kd[1]); o[(5 + 3 * d) * 256] = pk2(be[0], be[1]);
            }
        }
    }
}

__device__ __forceinline__ int seq_row(int b, int d, int sidx) {
    if (sidx < CTXL) { const int t = d ? (CTXL - 1 - sidx) : sidx; return T_LAT + b * CTXL + t; }
    const int tl = sidx - CTXL; const int t = d ? (SEQ - 1 - tl) : tl; return b * SEQ + t;
}

constexpr int CW_WORK = 16384;
constexpr int CW_STAMP = 20480;
#ifdef PROBE_T
#ifndef PROBE_BID
#define PROBE_BID 0
#endif
#define PT(k) do { if (F.bid == PROBE_BID && F.tid == 0 && l == 0) ((unsigned long long*)(F.a->ws + WS_CTL + CW_STAMP * 4))[k] = __builtin_amdgcn_s_memrealtime(); } while (0)
#else
#define PT(k) do { } while (0)
#endif
__device__ __forceinline__ void rw_scan_item(const Ctx& F, int l, int it2) {
    const int it = it2 >> 1, half = it2 & 1;
    const auto& a = *F.a; unsigned char* ws = a.ws; const int tid = F.tid, lane = F.lane;
    const bf16* SCN = (const bf16*)(ws + WS_SCN); float* YD = (float*)(ws + WS_YDIR);
    LAS float* sbuf = (LAS float*)F.lds;
    LAS float* ybuf = (LAS float*)(F.lds + 49152);
    const bool comp = F.wave < 4;
    const int lt = tid & 255, ls = lt >> 4, lj = lt & 15;
    const int vl = lane >> 3, kq = lane & 7, vrow = half * 32 + (F.wave & 3) * 8 + vl;
    constexpr int NCH = (CTXL + SEQ) / 16;
    const int d = it & 1, h = (it >> 1) & 7, b = it >> 4;
    f32x2 S[4];
#pragma unroll
    for (int q = 0; q < 4; ++q) S[q] = (f32x2){0.f, 0.f};
    v2u ldr[6];
#define RW_ISSUE(c) do { const int row_ = seq_row(b, d, (c) * 16 + ls); const v2u* p_ = (const v2u*)(SCN + (size_t)row_ * 9 * 512 + h * 64) + lj; \
        ldr[0] = p_[2 * 128]; ldr[1] = p_[(3 + 3 * d) * 128]; ldr[2] = p_[(5 + 3 * d) * 128]; ldr[3] = p_[(4 + 3 * d) * 128]; ldr[4] = p_[0]; ldr[5] = p_[128]; } while (0)
#define RW_WRITE(bufi) do { LAS float* o_ = sbuf + (((bufi) * 16 + ls) * 6) * 64 + 4 * lj; \
        *(LAS f32x4*)(o_) = (f32x4){-bflo(ldr[0].x), -bfhi(ldr[0].x), -bflo(ldr[0].y), -bfhi(ldr[0].y)}; \
        *(LAS f32x4*)(o_ + 64) = (f32x4){__expf(bflo(ldr[1].x)), __expf(bfhi(ldr[1].x)), __expf(bflo(ldr[1].y)), __expf(bfhi(ldr[1].y))}; \
        *(LAS f32x4*)(o_ + 128) = (f32x4){bflo(ldr[2].x), bfhi(ldr[2].x), bflo(ldr[2].y), bfhi(ldr[2].y)}; *(LAS f32x4*)(o_ + 192) = (f32x4){bflo(ldr[3].x), bfhi(ldr[3].x), bflo(ldr[3].y), bfhi(ldr[3].y)}; \
        *(LAS f32x4*)(o_ + 256) = (f32x4){bflo(ldr[4].x), bfhi(ldr[4].x), bflo(ldr[4].y), bfhi(ldr[4].y)}; *(LAS f32x4*)(o_ + 320) = (f32x4){bflo(ldr[5].x), bfhi(ldr[5].x), bflo(ldr[5].y), bfhi(ldr[5].y)}; } while (0)
#define RW_FLUSH(c) do { const int row_ = seq_row(b, d, (c) * 16 + ls); \
        *(f32x2*)(YD + ((size_t)d * T_ALL + row_) * 512 + h * 64 + half * 32 + 2 * lj) = *(const LAS f32x2*)(ybuf + ((((c) & 1) * 16 + ls) * 64) + half * 32 + 2 * lj); } while (0)
    if (!comp) { RW_ISSUE(0); RW_WRITE(0); RW_ISSUE(1); }
    __syncthreads();
#pragma unroll 1
    for (int c = 0; c < NCH; ++c) {
        const int bi = c & 1;
        if (!comp) {
            if (c + 1 < NCH) RW_WRITE(bi ^ 1);
            if (c + 2 < NCH) RW_ISSUE(c + 2);
            if (c > 0) RW_FLUSH(c - 1);
        } else {
        float yv[16];
        f32x4 opA[10], opB[10]; float vvA, vvB;
#define RW_LD(op, vvx, s_) do { const LAS float* sp_ = sbuf + ((bi * 16 + (s_)) * 6) * 64 + 8 * kq; \
            _Pragma("unroll") for (int q_ = 0; q_ < 5; ++q_) { op[2 * q_] = *(const LAS f32x4*)(sp_ + 64 * q_); op[2 * q_ + 1] = *(const LAS f32x4*)(sp_ + 64 * q_ + 4); } \
            vvx = sbuf[((bi * 16 + (s_)) * 6 + 5) * 64 + vrow]; } while (0)
#define RW_COMP(op, vvx, s_) do { \
            const f32x4 a0 = op[0], a1 = op[1], w0 = op[2], w1 = op[3], b0 = op[4], b1 = op[5], k0 = op[6], k1 = op[7], r0 = op[8], r1 = op[9]; \
            const f32x2 vv2 = (f32x2){vvx, vvx}; \
            const f32x2 p0 = S[1] * (f32x2){a0[2], a0[3]} + S[0] * (f32x2){a0[0], a0[1]}; \
            const f32x2 p1 = S[3] * (f32x2){a1[2], a1[3]} + S[2] * (f32x2){a1[0], a1[1]}; \
            const f32x2 t0 = S[0] * (f32x2){w0[0], w0[1]} + vv2 * (f32x2){k0[0], k0[1]}; \
            const f32x2 t1 = S[1] * (f32x2){w0[2], w0[3]} + vv2 * (f32x2){k0[2], k0[3]}; \
            const f32x2 t2 = S[2] * (f32x2){w1[0], w1[1]} + vv2 * (f32x2){k1[0], k1[1]}; \
            const f32x2 t3 = S[3] * (f32x2){w1[2], w1[3]} + vv2 * (f32x2){k1[2], k1[3]}; \
            const f32x2 ac = p0 + p1; \
            const float sa = red8(ac[0] + ac[1]); \
            const f32x2 sa2 = (f32x2){sa, sa}; \
            S[0] = sa2 * (f32x2){b0[0], b0[1]} + t0; S[1] = sa2 * (f32x2){b0[2], b0[3]} + t1; \
            S[2] = sa2 * (f32x2){b1[0], b1[1]} + t2; S[3] = sa2 * (f32x2){b1[2], b1[3]} + t3; \
            const f32x2 q0 = S[1] * (f32x2){r0[2], r0[3]} + S[0] * (f32x2){r0[0], r0[1]}; \
            const f32x2 q1 = S[3] * (f32x2){r1[2], r1[3]} + S[2] * (f32x2){r1[0], r1[1]}; \
            const f32x2 yc = q0 + q1; \
            yv[s_] = red8(yc[0] + yc[1]); } while (0)
        RW_LD(opA, vvA, 0);
#pragma unroll
        for (int s = 0; s < 16; s += 2) {
            RW_LD(opB, vvB, s + 1);
            __builtin_amdgcn_sched_barrier(0);
            RW_COMP(opA, vvA, s);
            __builtin_amdgcn_sched_barrier(0);
            if (s + 2 < 16) RW_LD(opA, vvA, s + 2);
            __builtin_amdgcn_sched_barrier(0);
            RW_COMP(opB, vvB, s + 1);
            __builtin_amdgcn_sched_barrier(0);
        }
#undef RW_LD
#undef RW_COMP
#pragma unroll
        for (int s = 0; s < 16; ++s) if ((s & 7) == kq) ybuf[((bi * 16 + s) * 64) + vrow] = yv[s];
        }
        __syncthreads();
    }
    if (!comp) RW_FLUSH(NCH - 1);
    __syncthreads();
#undef RW_ISSUE
#undef RW_WRITE
#undef RW_FLUSH
}

constexpr size_t WS_RWSCR = WS_YHY;
constexpr int RWS_QY = 0, RWS_YV = 2048, RWS_PZ = 4096, RWS_ZV = 12288, RWS_SLOT = 20480;
typedef __bf16 bf16x8n __attribute__((ext_vector_type(8)));
__device__ __forceinline__ f32x4 mma16(const bf16x8 a, const bf16x8 b, const f32x4 c) { return __builtin_amdgcn_mfma_f32_16x16x32_bf16(a, b, c, 0, 0, 0); }
__device__ __forceinline__ float dpp_shr(float x, const int n) {
    const int v = __builtin_bit_cast(int, x); int r;
    if (n == 1) r = __builtin_amdgcn_update_dpp(0, v, 0x111, 0xF, 0xF, true); else if (n == 2) r = __builtin_amdgcn_update_dpp(0, v, 0x112, 0xF, 0xF, true);
    else if (n == 4) r = __builtin_amdgcn_update_dpp(0, v, 0x114, 0xF, 0xF, true); else r = __builtin_amdgcn_update_dpp(0, v, 0x118, 0xF, 0xF, true);
    return __builtin_bit_cast(float, r);
}
__device__ __forceinline__ v4u pack8(const float (&x)[8]) { v4u o; o.x = pk2(x[0], x[1]); o.y = pk2(x[2], x[3]); o.z = pk2(x[4], x[5]); o.w = pk2(x[6], x[7]); return o; }
__device__ __forceinline__ void unpack8(const v4u u, float (&x)[8]) { x[0] = bflo(u.x); x[1] = bfhi(u.x); x[2] = bflo(u.y); x[3] = bfhi(u.y); x[4] = bflo(u.z); x[5] = bfhi(u.z); x[6] = bflo(u.w); x[7] = bfhi(u.w); }
__device__ __forceinline__ bf16x8 frag16(const LAS bf16* m, int rowbase, int lane) {
    v4u v = (v4u){0u, 0u, 0u, 0u}; if ((lane >> 4) < 2) v = *(const LAS v4u*)(m + (rowbase + (lane & 15)) * 16 + 8 * (lane >> 4)); return __builtin_bit_cast(bf16x8, v); }
__device__ __forceinline__ void st_colmaj(LAS bf16* m, int colbase, const f32x4 d, int lane) {
    v2u o; o.x = pk2(d[0], d[1]); o.y = pk2(d[2], d[3]); *(LAS v2u*)(m + (colbase + (lane & 15)) * 16 + 4 * (lane >> 4)) = o; }
__device__ __forceinline__ void st_rowmaj(LAS bf16* m, const f32x4 d, int lane) {
#pragma unroll
    for (int r = 0; r < 4; ++r) m[(4 * (lane >> 4) + r) * 16 + (lane & 15)] = (bf16)f2bf(d[r]); }
template <int KS0, int KS1>
__device__ __forceinline__ void rw_chunk_load(const Ctx& F, int b, int h, int d, int cidx, v4u (&raw)[12]) {
    const int lane = opaque_v(F.lane), t = lane & 15, kg = lane >> 4;
    const bf16* base = (const bf16*)(F.a->ws + WS_SCN) + (size_t)seq_row(b, d, 16 * cidx + t) * 9 * 512 + h * 64;
#pragma unroll
    for (int ks = KS0; ks < KS1; ++ks) { const int off = 32 * ks + 8 * kg;
        raw[6 * ks + 0] = *(const v4u*)(base + (3 + 3 * d) * 512 + off); raw[6 * ks + 1] = *(const v4u*)(base + 2 * 512 + off); raw[6 * ks + 2] = *(const v4u*)(base + off);
        raw[6 * ks + 3] = *(const v4u*)(base + (5 + 3 * d) * 512 + off); raw[6 * ks + 4] = *(const v4u*)(base + (4 + 3 * d) * 512 + off); raw[6 * ks + 5] = *(const v4u*)(base + 512 + off); }
}
__device__ __forceinline__ void rw_chunk_task(const Ctx& F, const v4u (&raw)[12], LAS unsigned char* wl, unsigned char* slot) {
    const int lane = opaque_v(F.lane), t = lane & 15, kg = lane >> 4;
    LAS bf16* ATt = (LAS bf16*)(wl); LAS bf16* RBr = (LAS bf16*)(wl + 2048); LAS bf16* BHt = (LAS bf16*)(wl + 4096); LAS bf16* KHt = (LAS bf16*)(wl + 6144); LAS bf16* VTt = (LAS bf16*)(wl + 8192);
    LAS bf16* WAt = (LAS bf16*)(wl + 10240); LAS bf16* N_r = (LAS bf16*)(wl + 12288); LAS bf16* N_c = (LAS bf16*)(wl + 12800); LAS bf16* T_r = (LAS bf16*)(wl + 13312);
    LAS bf16* AK_r = (LAS bf16*)(wl + 13824); LAS bf16* RB2 = (LAS bf16*)(wl + 14336); LAS bf16* RK_r = (LAS bf16*)(wl + 14848); LAS float* GCl = (LAS float*)(wl + 15360);
    bf16x8 fAb[2], fRb[2], fBb[2], fKb[2];
#pragma unroll
    for (int ks = 0; ks < 2; ++ks) {
        const int off = 32 * ks + 8 * kg;
        float ea[8], er[8], eb[8], eh[8];
        { const v4u uld = raw[6 * ks + 0]; float ld[8]; unpack8(uld, ld);
#pragma unroll
          for (int j = 0; j < 8; ++j) { float c = ld[j]; c += dpp_shr(c, 1); c += dpp_shr(c, 2); c += dpp_shr(c, 4); c += dpp_shr(c, 8);
              const float tot = __builtin_bit_cast(float, __builtin_amdgcn_ds_bpermute((lane | 15) << 2, __builtin_bit_cast(int, c)));
              ea[j] = __expf(c - ld[j]); er[j] = __expf(c); eb[j] = __expf(-c); eh[j] = __expf(tot - c);
              if (t == 0) GCl[off + j] = __expf(tot); } }
        { const v4u u = raw[6 * ks + 1]; float x[8]; unpack8(u, x);
#pragma unroll
          for (int j = 0; j < 8; ++j) { x[j] = -x[j] * ea[j]; ATt[(off + j) * 16 + t] = (bf16)f2bf(x[j]); }
          const v4u p = pack8(x); fAb[ks] = __builtin_bit_cast(bf16x8, p); }
        { const v4u u = raw[6 * ks + 2]; float x[8]; unpack8(u, x);
#pragma unroll
          for (int j = 0; j < 8; ++j) x[j] = x[j] * er[j];
          const v4u p = pack8(x); fRb[ks] = __builtin_bit_cast(bf16x8, p); *(LAS v4u*)(RBr + t * 64 + off) = p; }
        { const v4u u = raw[6 * ks + 3]; float x[8], y[8]; unpack8(u, x);
#pragma unroll
          for (int j = 0; j < 8; ++j) { y[j] = x[j] * eb[j]; BHt[(off + j) * 16 + t] = (bf16)f2bf(x[j] * eh[j]); }
          const v4u p = pack8(y); fBb[ks] = __builtin_bit_cast(bf16x8, p); }
        { const v4u u = raw[6 * ks + 4]; float x[8], y[8]; unpack8(u, x);
#pragma unroll
          for (int j = 0; j < 8; ++j) { y[j] = x[j] * eb[j]; KHt[(off + j) * 16 + t] = (bf16)f2bf(x[j] * eh[j]); }
          const v4u p = pack8(y); fKb[ks] = __builtin_bit_cast(bf16x8, p); }
        { const v4u u = raw[6 * ks + 5];
          const bf16 e0 = (bf16)(u.x & 0xffff), e1 = (bf16)(u.x >> 16), e2 = (bf16)(u.y & 0xffff), e3 = (bf16)(u.y >> 16), e4 = (bf16)(u.z & 0xffff), e5 = (bf16)(u.z >> 16), e6 = (bf16)(u.w & 0xffff), e7 = (bf16)(u.w >> 16);
          VTt[(off + 0) * 16 + t] = e0; VTt[(off + 1) * 16 + t] = e1; VTt[(off + 2) * 16 + t] = e2; VTt[(off + 3) * 16 + t] = e3; VTt[(off + 4) * 16 + t] = e4; VTt[(off + 5) * 16 + t] = e5; VTt[(off + 6) * 16 + t] = e6; VTt[(off + 7) * 16 + t] = e7; }
        __builtin_amdgcn_sched_barrier(0);
    }
    asm volatile("" ::: "memory");
    const f32x4 z4 = (f32x4){0.f, 0.f, 0.f, 0.f};
    f32x4 n0 = mma16(fAb[1], fBb[1], mma16(fAb[0], fBb[0], z4)), aak = mma16(fAb[1], fKb[1], mma16(fAb[0], fKb[0], z4));
    f32x4 arb = mma16(fRb[1], fBb[1], mma16(fRb[0], fBb[0], z4)), ark = mma16(fRb[1], fKb[1], mma16(fRb[0], fKb[0], z4));
#pragma unroll
    for (int r = 0; r < 4; ++r) { const int tt = 4 * kg + r; if (!(t < tt)) { n0[r] = 0.f; aak[r] = 0.f; } if (!(t <= tt)) { arb[r] = 0.f; ark[r] = 0.f; } }
    st_rowmaj(AK_r, aak, lane); st_rowmaj(RB2, arb, lane); st_rowmaj(RK_r, ark, lane); asm volatile("" ::: "memory");
    f32x4 accT = n0;
#pragma unroll
    for (int r = 0; r < 4; ++r) accT[r] += (4 * kg + r == t) ? 1.f : 0.f;
    f32x4 nn = n0;
#pragma unroll
    for (int itn = 0; itn < 3; ++itn) {
        st_rowmaj(N_r, nn, lane); st_colmaj(N_c, 0, nn, lane); st_rowmaj(T_r, accT, lane); asm volatile("" ::: "memory");
        const bf16x8 fa = frag16(N_r, 0, lane), fb = frag16(N_c, 0, lane), ft = frag16(T_r, 0, lane);
        nn = mma16(fa, fb, z4); asm volatile("" ::: "memory");
        st_colmaj(N_c, 0, nn, lane); asm volatile("" ::: "memory");
        const bf16x8 fb2 = frag16(N_c, 0, lane);
        accT = mma16(ft, fb2, accT); asm volatile("" ::: "memory");
    }
    st_rowmaj(T_r, accT, lane); asm volatile("" ::: "memory");
    const bf16x8 fT = frag16(T_r, 0, lane), fAK = frag16(AK_r, 0, lane), fARB = frag16(RB2, 0, lane), fARK = frag16(RK_r, 0, lane);
#pragma unroll
    for (int kt = 0; kt < 4; ++kt) { const f32x4 dd = mma16(fT, frag16(ATt, 16 * kt, lane), z4); st_colmaj(WAt, 16 * kt, dd, lane); } asm volatile("" ::: "memory");
    { const bf16x8 fArbT = frag16(RB2, 0, lane);
#pragma unroll
      for (int kt = 0; kt < 4; ++kt) { const v2u ri = *(const LAS v2u*)(RBr + t * 64 + 16 * kt + 4 * kg);
          f32x4 c0 = (f32x4){bflo(ri.x), bfhi(ri.x), bflo(ri.y), bfhi(ri.y)};
          c0 = mma16(frag16(WAt, 16 * kt, lane), fArbT, c0);
          v2u o; o.x = pk2(c0[0], c0[1]); o.y = pk2(c0[2], c0[3]); *(v2u*)(slot + RWS_QY + (t * 64 + 16 * kt + 4 * kg) * 2) = o; } }
    asm volatile("" ::: "memory");
#pragma unroll
    for (int vt = 0; vt < 4; ++vt) { const f32x4 dd = mma16(fAK, frag16(VTt, 16 * vt, lane), z4); st_colmaj(ATt, 16 * vt, dd, lane); } asm volatile("" ::: "memory");
    asm volatile("" ::: "memory");
    LAS bf16* UVt = RBr;
#pragma unroll
    for (int vt = 0; vt < 4; ++vt) { const f32x4 dd = mma16(fT, frag16(ATt, 16 * vt, lane), z4); st_colmaj(UVt, 16 * vt, dd, lane); } asm volatile("" ::: "memory");
#pragma unroll
    for (int vt = 0; vt < 4; ++vt) { const f32x4 dd = mma16(fARK, frag16(VTt, 16 * vt, lane), mma16(fARB, frag16(UVt, 16 * vt, lane), z4));
        v2u o; o.x = pk2(dd[0], dd[1]); o.y = pk2(dd[2], dd[3]); *(v2u*)(slot + RWS_YV + ((16 * vt + t) * 16 + 4 * kg) * 2) = o; }
#pragma unroll
    for (int ktp = 0; ktp < 4; ++ktp) { const bf16x8 fBh = frag16(BHt, 16 * ktp, lane);
#pragma unroll
        for (int kt = 0; kt < 4; ++kt) { f32x4 dd = mma16(frag16(WAt, 16 * kt, lane), fBh, z4);
            if (kt == ktp) {
#pragma unroll
                for (int r = 0; r < 4; ++r) if (4 * kg + r == t) dd[r] += GCl[16 * kt + t]; }
            v2u o; o.x = pk2(dd[0], dd[1]); o.y = pk2(dd[2], dd[3]); *(v2u*)(slot + RWS_PZ + ((16 * ktp + t) * 64 + 16 * kt + 4 * kg) * 2) = o; } }
#pragma unroll
    for (int vt = 0; vt < 4; ++vt) { const bf16x8 fU = frag16(UVt, 16 * vt, lane), fV = frag16(VTt, 16 * vt, lane);
#pragma unroll
        for (int ktp = 0; ktp < 4; ++ktp) { const f32x4 dd = mma16(frag16(KHt, 16 * ktp, lane), fV, mma16(frag16(BHt, 16 * ktp, lane), fU, z4));
            v2u o; o.x = pk2(dd[0], dd[1]); o.y = pk2(dd[2], dd[3]); *(v2u*)(slot + RWS_ZV + ((16 * vt + t) * 64 + 16 * ktp + 4 * kg) * 2) = o; } }
}
__device__ __forceinline__ void rw_chunk_task2(const Ctx& F, const v4u (&raw)[12], LAS unsigned char* wl, f32x4 (&yv)[4], f32x4 (&zv)[4][4]) {
    const int lane = opaque_v(F.lane), t = lane & 15, kg = lane >> 4;
    LAS bf16* ATt = (LAS bf16*)(wl); LAS bf16* RBr = (LAS bf16*)(wl + 2048); LAS bf16* BHt = (LAS bf16*)(wl + 4096); LAS bf16* KHt = (LAS bf16*)(wl + 6144); LAS bf16* VTt = (LAS bf16*)(wl + 8192);
    LAS bf16* WAt = (LAS bf16*)(wl + 10240); LAS bf16* N_r = (LAS bf16*)(wl + 12288); LAS bf16* N_c = (LAS bf16*)(wl + 12800); LAS bf16* T_r = (LAS bf16*)(wl + 13312);
    LAS bf16* AK_r = (LAS bf16*)(wl + 13824); LAS bf16* RB2 = (LAS bf16*)(wl + 14336); LAS bf16* RK_r = (LAS bf16*)(wl + 14848); LAS float* GCl = (LAS float*)(wl + 15360);
    bf16x8 fAb[2], fRb[2], fBb[2], fKb[2];
#pragma unroll
    for (int ks = 0; ks < 2; ++ks) {
        const int off = 32 * ks + 8 * kg;
        float ea[8], er[8], eb[8], eh[8];
        { const v4u uld = raw[6 * ks + 0]; float ld[8]; unpack8(uld, ld);
#pragma unroll
          for (int j = 0; j < 8; ++j) { float c = ld[j]; c += dpp_shr(c, 1); c += dpp_shr(c, 2); c += dpp_shr(c, 4); c += dpp_shr(c, 8);
              const float tot = __builtin_bit_cast(float, __builtin_amdgcn_ds_bpermute((lane | 15) << 2, __builtin_bit_cast(int, c)));
              ea[j] = __expf(c - ld[j]); er[j] = __expf(c); eb[j] = __expf(-c); eh[j] = __expf(tot - c);
              if (t == 0) GCl[off + j] = __expf(tot); } }
        { const v4u u = raw[6 * ks + 1]; float x[8]; unpack8(u, x);
#pragma unroll
          for (int j = 0; j < 8; ++j) { x[j] = -x[j] * ea[j]; ATt[(off + j) * 16 + t] = (bf16)f2bf(x[j]); }
          const v4u p = pack8(x); fAb[ks] = __builtin_bit_cast(bf16x8, p); }
        { const v4u u = raw[6 * ks + 2]; float x[8]; unpack8(u, x);
#pragma unroll
          for (int j = 0; j < 8; ++j) x[j] = x[j] * er[j];
          const v4u p = pack8(x); fRb[ks] = __builtin_bit_cast(bf16x8, p); *(LAS v4u*)(RBr + t * 64 + off) = p; }
        { const v4u u = raw[6 * ks + 3]; float x[8], y[8]; unpack8(u, x);
#pragma unroll
          for (int j = 0; j < 8; ++j) { y[j] = x[j] * eb[j]; BHt[(off + j) * 16 + t] = (bf16)f2bf(x[j] * eh[j]); }
          const v4u p = pack8(y); fBb[ks] = __builtin_bit_cast(bf16x8, p); }
        { const v4u u = raw[6 * ks + 4]; float x[8], y[8]; unpack8(u, x);
#pragma unroll
          for (int j = 0; j < 8; ++j) { y[j] = x[j] * eb[j]; KHt[(off + j) * 16 + t] = (bf16)f2bf(x[j] * eh[j]); }
          const v4u p = pack8(y); fKb[ks] = __builtin_bit_cast(bf16x8, p); }
        { const v4u u = raw[6 * ks + 5];
          const bf16 e0 = (bf16)(u.x & 0xffff), e1 = (bf16)(u.x >> 16), e2 = (bf16)(u.y & 0xffff), e3 = (bf16)(u.y >> 16), e4 = (bf16)(u.z & 0xffff), e5 = (bf16)(u.z >> 16), e6 = (bf16)(u.w & 0xffff), e7 = (bf16)(u.w >> 16);
          VTt[(off + 0) * 16 + t] = e0; VTt[(off + 1) * 16 + t] = e1; VTt[(off + 2) * 16 + t] = e2; VTt[(off + 3) * 16 + t] = e3; VTt[(off + 4) * 16 + t] = e4; VTt[(off + 5) * 16 + t] = e5; VTt[(off + 6) * 16 + t] = e6; VTt[(off + 7) * 16 + t] = e7; }
        __builtin_amdgcn_sched_barrier(0);
    }
    asm volatile("" ::: "memory");
    const f32x4 z4 = (f32x4){0.f, 0.f, 0.f, 0.f};
    f32x4 n0 = mma16(fAb[1], fBb[1], mma16(fAb[0], fBb[0], z4)), aak = mma16(fAb[1], fKb[1], mma16(fAb[0], fKb[0], z4));
    f32x4 arb = mma16(fRb[1], fBb[1], mma16(fRb[0], fBb[0], z4)), ark = mma16(fRb[1], fKb[1], mma16(fRb[0], fKb[0], z4));
#pragma unroll
    for (int r = 0; r < 4; ++r) { const int tt = 4 * kg + r; if (!(t < tt)) { n0[r] = 0.f; aak[r] = 0.f; } if (!(t <= tt)) { arb[r] = 0.f; ark[r] = 0.f; } }
    st_rowmaj(AK_r, aak, lane); st_rowmaj(RB2, arb, lane); st_rowmaj(RK_r, ark, lane); asm volatile("" ::: "memory");
    f32x4 accT = n0;
#pragma unroll
    for (int r = 0; r < 4; ++r) accT[r] += (4 * kg + r == t) ? 1.f : 0.f;
    f32x4 nn = n0;
#pragma unroll
    for (int itn = 0; itn < 3; ++itn) {
        st_rowmaj(N_r, nn, lane); st_colmaj(N_c, 0, nn, lane); st_rowmaj(T_r, accT, lane); asm volatile("" ::: "memory");
        const bf16x8 fa = frag16(N_r, 0, lane), fb = frag16(N_c, 0, lane), ft = frag16(T_r, 0, lane);
        nn = mma16(fa, fb, z4); asm volatile("" ::: "memory");
        st_colmaj(N_c, 0, nn, lane); asm volatile("" ::: "memory");
        const bf16x8 fb2 = frag16(N_c, 0, lane);
        accT = mma16(ft, fb2, accT); asm volatile("" ::: "memory");
    }
    st_rowmaj(T_r, accT, lane); asm volatile("" ::: "memory");
    const bf16x8 fT = frag16(T_r, 0, lane), fAK = frag16(AK_r, 0, lane), fARB = frag16(RB2, 0, lane), fARK = frag16(RK_r, 0, lane);
#pragma unroll
    for (int kt = 0; kt < 4; ++kt) { const f32x4 dd = mma16(fT, frag16(ATt, 16 * kt, lane), z4); st_colmaj(WAt, 16 * kt, dd, lane); } asm volatile("" ::: "memory");
    f32x4 qy[4];
    { const bf16x8 fArbT = frag16(RB2, 0, lane);
#pragma unroll
      for (int kt = 0; kt < 4; ++kt) { const v2u ri = *(const LAS v2u*)(RBr + t * 64 + 16 * kt + 4 * kg);
          qy[kt] = mma16(frag16(WAt, 16 * kt, lane), fArbT, (f32x4){bflo(ri.x), bfhi(ri.x), bflo(ri.y), bfhi(ri.y)}); } }
    asm volatile("" ::: "memory");
#pragma unroll
    for (int vt = 0; vt < 4; ++vt) { const f32x4 dd = mma16(fAK, frag16(VTt, 16 * vt, lane), z4); st_colmaj(ATt, 16 * vt, dd, lane); } asm volatile("" ::: "memory");
    LAS bf16* UVt = RBr;
#pragma unroll
    for (int vt = 0; vt < 4; ++vt) { const f32x4 dd = mma16(fT, frag16(ATt, 16 * vt, lane), z4); st_colmaj(UVt, 16 * vt, dd, lane); } asm volatile("" ::: "memory");
#pragma unroll
    for (int vt = 0; vt < 4; ++vt) { const bf16x8 fU = frag16(UVt, 16 * vt, lane), fV = frag16(VTt, 16 * vt, lane);
        yv[vt] = mma16(fARK, fV, mma16(fARB, fU, z4));
#pragma unroll
        for (int ktp = 0; ktp < 4; ++ktp) zv[vt][ktp] = mma16(frag16(KHt, 16 * ktp, lane), fV, mma16(frag16(BHt, 16 * ktp, lane), fU, z4)); }
    f32x4 pz[4][4];
#pragma unroll
    for (int ktp = 0; ktp < 4; ++ktp) { const bf16x8 fBh = frag16(BHt, 16 * ktp, lane);
#pragma unroll
        for (int kt = 0; kt < 4; ++kt) { f32x4 dd = mma16(frag16(WAt, 16 * kt, lane), fBh, z4);
            if (kt == ktp) {
#pragma unroll
                for (int r = 0; r < 4; ++r) if (4 * kg + r == t) dd[r] += GCl[16 * kt + t]; }
            pz[ktp][kt] = dd; } }
    asm volatile("s_waitcnt lgkmcnt(0)" ::: "memory");
#pragma unroll
    for (int ktp = 0; ktp < 4; ++ktp) { LAS bf16* reg = (LAS bf16*)(wl + (ktp < 2 ? ktp * 2048 : (ktp + 1) * 2048));
#pragma unroll
        for (int kt = 0; kt < 4; ++kt) { v2u o; o.x = pk2(pz[ktp][kt][0], pz[ktp][kt][1]); o.y = pk2(pz[ktp][kt][2], pz[ktp][kt][3]); *(LAS v2u*)(reg + t * 64 + 16 * kt + 4 * kg) = o; } }
#pragma unroll
    for (int kt = 0; kt < 4; ++kt) { v2u o; o.x = pk2(qy[kt][0], qy[kt][1]); o.y = pk2(qy[kt][2], qy[kt][3]); *(LAS v2u*)(BHt + t * 64 + 16 * kt + 4 * kg) = o; }
    asm volatile("s_waitcnt lgkmcnt(0)" ::: "memory");
}
constexpr int RWZ_OFF = LDSCTL_OFF + 8192, RWF_OFF = LDSCTL_OFF + 2048;
__device__ __forceinline__ void rw_chunk_item2(const Ctx& F, int l, int it, size_t yoff = WS_YDIR) {
    const auto& a = *F.a; unsigned char* ws = a.ws; const int lane = opaque_v(F.lane), t = lane & 15, kg = lane >> 4;
    const int d = it & 1, h = (it >> 1) & 7, b = it >> 4;
    float* YD = (float*)(ws + yoff);
    LAS unsigned char* wl = F.lds + F.wave * 15616;
    LAS bf16* ZS = (LAS bf16*)(F.lds + RWZ_OFF);
    volatile LAS int* flag = (volatile LAS int*)(F.lds + RWF_OFF);
    for (int i = F.tid; i < 2048; i += NTHREADS) ((LAS unsigned*)ZS)[i] = 0u;
    if (F.tid == 0) *flag = 0;
    __syncthreads();
    constexpr int NCHK = (CTXL + SEQ) / 16;
#pragma unroll 1
    for (int c = F.wave; c < NCHK; c += NWAVES) {
        v4u raw[12]; f32x4 yv[4], zv[4][4];
        rw_chunk_load<0, 2>(F, b, h, d, c, raw);
        rw_chunk_task2(F, raw, wl, yv, zv);
        while (*flag < c) __builtin_amdgcn_s_sleep(1);
        asm volatile("" ::: "memory");
        const LAS bf16* Zc = ZS + (c & 1) * 4096; LAS bf16* Zn = ZS + ((c + 1) & 1) * 4096;
        bf16x8 zb[4][2];
#pragma unroll
        for (int vb = 0; vb < 4; ++vb)
#pragma unroll
            for (int ks = 0; ks < 2; ++ks) zb[vb][ks] = *(const LAS bf16x8*)(Zc + (16 * vb + t) * 64 + 32 * ks + 8 * kg);
        { const LAS bf16* Qr = (const LAS bf16*)(wl + 4096); const bf16x8 q0 = *(const LAS bf16x8*)(Qr + t * 64 + 8 * kg), q1 = *(const LAS bf16x8*)(Qr + t * 64 + 32 + 8 * kg);
#pragma unroll
          for (int vb = 0; vb < 4; ++vb) { const f32x4 y = mma16(q1, zb[vb][1], mma16(q0, zb[vb][0], yv[vb]));
#pragma unroll
              for (int r = 0; r < 4; ++r) { const int row = seq_row(b, d, c * 16 + 4 * kg + r); YD[((size_t)d * T_ALL + row) * 512 + h * 64 + 16 * vb + t] = y[r]; } } }
#pragma unroll
        for (int ktp = 0; ktp < 4; ++ktp) { const LAS bf16* Pr = (const LAS bf16*)(wl + (ktp < 2 ? ktp * 2048 : (ktp + 1) * 2048));
            const bf16x8 p0 = *(const LAS bf16x8*)(Pr + t * 64 + 8 * kg), p1 = *(const LAS bf16x8*)(Pr + t * 64 + 32 + 8 * kg);
#pragma unroll
            for (int vb = 0; vb < 4; ++vb) { const f32x4 z = mma16(p1, zb[vb][1], mma16(p0, zb[vb][0], zv[vb][ktp]));
                v2u o; o.x = pk2(z[0], z[1]); o.y = pk2(z[2], z[3]); *(LAS v2u*)(Zn + (16 * vb + t) * 64 + 16 * ktp + 4 * kg) = o; } }
        asm volatile("s_waitcnt lgkmcnt(0)" ::: "memory");
        if (lane == 0) *flag = c + 1;
        asm volatile("s_waitcnt lgkmcnt(0)" ::: "memory");
    }
    __syncthreads();
}
__device__ __forceinline__ v2u ld_sc1_8(const void* p) { const unsigned long long v = __hip_atomic_load((const unsigned long long*)p, __ATOMIC_RELAXED, __HIP_MEMORY_SCOPE_AGENT); v2u o; o.x = (unsigned)v; o.y = (unsigned)(v >> 32); return o; }
__device__ __forceinline__ v4u ld_sc1_16(const void* p) { const v2u a = ld_sc1_8(p), b = ld_sc1_8((const char*)p + 8); return (v4u){a.x, a.y, b.x, b.y}; }
__device__ __forceinline__ void rw_chunk_item(const Ctx& F, int l, int it) {
    const auto& a = *F.a; unsigned char* ws = a.ws; const int lane = F.lane, t = lane & 15, kg = lane >> 4;
    const int d = it & 1, h = (it >> 1) & 7, b = it >> 4;
    float* YD = (float*)(ws + WS_YDIR);
    unsigned char* scr = ws + WS_RWSCR + (size_t)F.bid * 16 * RWS_SLOT;
    LAS unsigned char* wl = F.lds + F.wave * 15616;
    LAS bf16* ZL = (LAS bf16*)(F.lds + LDSCTL_OFF + 4096 + (F.wave & 3) * 2048);
    if (F.wave < 4) { for (int i = lane; i < 512; i += 64) ((LAS unsigned*)ZL)[i] = 0u; }
    asm volatile("" ::: "memory");
    constexpr int NCHK = (CTXL + SEQ) / 16, NB = NCHK / 16;
#pragma unroll 1
    for (int bt = 0; bt < NB; ++bt) {
        { v4u cur[12];
#pragma unroll 1
          for (int jj = 0; jj < 2; ++jj) { rw_chunk_load<0, 2>(F, b, h, d, bt * 16 + F.wave + 8 * jj, cur); rw_chunk_task(F, cur, wl, scr + (size_t)(F.wave + 8 * jj) * RWS_SLOT); } }
        asm volatile("s_waitcnt vmcnt(0)" ::: "memory");
        __syncthreads();
        {
            const int t = opaque_v(lane & 15), kg = opaque_v(lane >> 4), vb = opaque(F.wave) & 3;
            const unsigned char* scrb = F.a->ws + WS_RWSCR + (size_t)opaque(F.bid) * 16 * RWS_SLOT;
            LAS unsigned char* sbuf = F.lds;
            const int lt = opaque_v(F.tid) & 255; const bool loader = F.wave >= 4;
            const int lw = opaque(F.wave) & 3;
#define RWB_ISSUE(j_) do { const unsigned char* gp_ = scrb + (size_t)(j_) * RWS_SLOT + (size_t)(lw * 5) * 1024 + lane * 16; LAS unsigned char* lp_ = sbuf + ((j_) % 6) * RWS_SLOT + (lw * 5) * 1024; \
                _Pragma("unroll") for (int q = 0; q < 5; ++q) __builtin_amdgcn_global_load_lds((const unsigned*)(gp_ + q * 1024), (LAS unsigned*)(lp_ + q * 1024), 16, 0, 16); } while (0)
#define RWB_COMP(bi_, j_) do { const LAS unsigned char* sl_ = sbuf + (bi_) * RWS_SLOT; bf16x8 zb[2], qf[2]; \
                _Pragma("unroll") for (int ks = 0; ks < 2; ++ks) { zb[ks] = *(const LAS bf16x8*)(ZL + t * 64 + 32 * ks + 8 * kg); qf[ks] = *(const LAS bf16x8*)(sl_ + RWS_QY + (t * 64 + 32 * ks + 8 * kg) * 2); } \
                const v2u y_ = *(const LAS v2u*)(sl_ + RWS_YV + ((16 * vb + t) * 16 + 4 * kg) * 2); \
                f32x4 yacc = (f32x4){bflo(y_.x), bfhi(y_.x), bflo(y_.y), bfhi(y_.y)}; \
                yacc = mma16(qf[1], zb[1], mma16(qf[0], zb[0], yacc)); \
                f32x4 zn[4]; \
                _Pragma("unroll") for (int ktp = 0; ktp < 4; ++ktp) { const v2u z_ = *(const LAS v2u*)(sl_ + RWS_ZV + ((16 * vb + t) * 64 + 16 * ktp + 4 * kg) * 2); \
                    f32x4 zc = (f32x4){bflo(z_.x), bfhi(z_.x), bflo(z_.y), bfhi(z_.y)}; \
                    _Pragma("unroll") for (int ks = 0; ks < 2; ++ks) zc = mma16(*(const LAS bf16x8*)(sl_ + RWS_PZ + ((16 * ktp + t) * 64 + 32 * ks + 8 * kg) * 2), zb[ks], zc); \
                    zn[ktp] = zc; } \
                _Pragma("unroll") for (int r = 0; r < 4; ++r) { const int row = seq_row(b, d, (bt * 16 + (j_)) * 16 + 4 * kg + r); YD[((size_t)d * T_ALL + row) * 512 + h * 64 + 16 * vb + t] = yacc[r]; } \
                asm volatile("s_waitcnt lgkmcnt(0)" ::: "memory"); \
                _Pragma("unroll") for (int ktp = 0; ktp < 4; ++ktp) { v2u o; o.x = pk2(zn[ktp][0], zn[ktp][1]); o.y = pk2(zn[ktp][2], zn[ktp][3]); *(LAS v2u*)(ZL + t * 64 + 16 * ktp + 4 * kg) = o; } \
                asm volatile("s_waitcnt lgkmcnt(0)" ::: "memory"); } while (0)
#define RWB_BAR() do { asm volatile("s_waitcnt lgkmcnt(0)" ::: "memory"); __builtin_amdgcn_s_barrier(); asm volatile("" ::: "memory"); } while (0)
            if (loader) { RWB_ISSUE(0); RWB_ISSUE(1); RWB_ISSUE(2); RWB_ISSUE(3); asm volatile("s_waitcnt vmcnt(15)" ::: "memory"); }
            RWB_BAR();
#pragma unroll 1
            for (int j = 0; j < 16; ++j) {
                if (loader) { if (j + 4 < 16) { RWB_ISSUE(j + 4); asm volatile("s_waitcnt vmcnt(15)" ::: "memory"); } else { asm volatile("s_waitcnt vmcnt(0)" ::: "memory"); } }
                else { RWB_COMP(j % 6, j); }
                RWB_BAR();
            }
#undef RWB_BAR
#undef RWB_ISSUE
#undef RWB_COMP
        }
        __syncthreads();
    }
}

__device__ __forceinline__ void stage_rw_readout(const Ctx& F, int l) {
    const auto& a = *F.a; unsigned char* ws = a.ws; const int lane = F.lane;
    const bf16* SCN = (const bf16*)(ws + WS_SCN); const bf16* P = (const bf16*)(ws + WS_P); const float* YD = (const float*)(ws + WS_YDIR); bf16* YRW = (bf16*)(ws + WS_YRW);
    const int gw = F.bid * NWAVES + F.wave, NGW = F.G * NWAVES;
    constexpr int TR = 17, NRT = T_ALL / TR;
    for (int tile = gw; tile < NRT * 4; tile += NGW) {
        const int rt = tile % NRT, hp = tile / NRT, row0 = rt * TR, c0 = hp * 128 + 2 * lane;
        const f32x2 rk = *(const f32x2*)(a.in[I_RWRK] + l * 512 + c0), lng = *(const f32x2*)(a.in[I_RWLNG] + l * 512 + c0), lnb = *(const f32x2*)(a.in[I_RWLNB] + l * 512 + c0);
#pragma unroll 4
        for (int i = 0; i < TR; ++i) {
            const int row = row0 + i;
            const unsigned* sp = (const unsigned*)(SCN + (size_t)row * 9 * 512 + c0);
            const unsigned ru = sp[0], vu = sp[256], k0u = sp[4 * 256], k1u = sp[7 * 256];
            const f32x2 y0 = *(const f32x2*)(YD + (size_t)row * 512 + c0), y1 = *(const f32x2*)(YD + ((size_t)T_ALL + row) * 512 + c0);
            const unsigned gu = *(const unsigned*)(P + (size_t)row * 2560 + 2048 + c0);
            const float bon = red32(bflo(ru) * (bflo(k0u) + bflo(k1u)) * rk[0] + bfhi(ru) * (bfhi(k0u) + bfhi(k1u)) * rk[1]);
            f32x2 y = y0 + y1 + (f32x2){bflo(vu), bfhi(vu)} * bon;
            const float mu = red32(y[0] + y[1]) * (1.f / 64.f);
            y = y - mu;
            const float var = red32(y[0] * y[0] + y[1] * y[1]) * (1.f / 64.f);
            const f32x2 yn = y * (1.0f / sqrtf(var + 64e-5f));
            const f32x2 ov = (yn * lng + lnb) * (f32x2){bflo(gu), bfhi(gu)};
            *(unsigned*)(YRW + (size_t)row * 512 + c0) = pk2(ov[0], ov[1]);
        }
    }
}

constexpr size_t WS_S5E = 6 * MiB;
constexpr int S5_NSEG = 4, S5_SEGLEN = (CTXL + SEQ) / S5_NSEG;
__device__ __forceinline__ void s5_disc(const float are, const float aim, const float dt, float& lbr, float& lbi, float& cr, float& ci) {
    const float mag = expf(are * dt); lbr = mag * cosf(aim * dt); lbi = mag * sinf(aim * dt);
    const float den = are * are + aim * aim, nr = lbr - 1.0f; cr = (nr * are + lbi * aim) / den; ci = (lbi * are - nr * aim) / den;
}
template <int PASS>
__device__ __forceinline__ void stage_s5_scan(const Ctx& F, int l) {
    const auto& a = *F.a; unsigned char* ws = a.ws; const int lane = F.lane;
    const bf16* Z = (const bf16*)(ws + WS_Z); float* YP = (float*)(ws + WS_YP); f32x2* S5E = (f32x2*)(ws + WS_S5E);
    LAS unsigned char* wl = F.lds + F.wave * 16384;
    LAS float* buL = (LAS float*)wl;
    LAS bf16* Hs = (LAS bf16*)(wl + 8704);
    const int fr = lane & 15, kg = lane >> 4;
    for (int itx = F.bid * NWAVES + F.wave; itx < BATCH * 32 * 2 * S5_NSEG; itx += NWAVES * F.G) {
        const int seg = itx & (S5_NSEG - 1), it = itx >> 2;
        const int d = it & 1, g = (it >> 1) & 31, b = it >> 6, p = lane;
        const float dt = expf(a.in[I_S5LDT][(l * 2 + d) * 32 + g]);
        const float* arep = a.in[I_S5ARE] + ((size_t)(l * 2 + d) * 32 + g) * 64; const float* aimp = a.in[I_S5AIM] + ((size_t)(l * 2 + d) * 32 + g) * 64;
        float lbr, lbi, cr_, ci_; s5_disc(arep[p], aimp[p], dt, lbr, lbi, cr_, ci_);
        bf16x8 afr[2][4];
#pragma unroll
        for (int tl = 0; tl < 4; ++tl) { const int pp = 16 * tl + fr; float r0_, r1_, cr, ci; s5_disc(arep[pp], aimp[pp], dt, r0_, r1_, cr, ci);
            v4u pr = (v4u){0u, 0u, 0u, 0u}, pi = (v4u){0u, 0u, 0u, 0u};
            if (kg < 2) { const float* br = a.in[I_S5BRE] + (((size_t)l * 32 + g) * 64 + pp) * 16 + 8 * kg; const float* bi = a.in[I_S5BIM] + (((size_t)l * 32 + g) * 64 + pp) * 16 + 8 * kg;
                const f32x4 x0 = *(const f32x4*)br, x1 = *(const f32x4*)(br + 4), y0 = *(const f32x4*)bi, y1 = *(const f32x4*)(bi + 4);
                pr.x = pk2(cr * x0[0] - ci * y0[0], cr * x0[1] - ci * y0[1]); pr.y = pk2(cr * x0[2] - ci * y0[2], cr * x0[3] - ci * y0[3]);
                pr.z = pk2(cr * x1[0] - ci * y1[0], cr * x1[1] - ci * y1[1]); pr.w = pk2(cr * x1[2] - ci * y1[2], cr * x1[3] - ci * y1[3]);
                pi.x = pk2(cr * y0[0] + ci * x0[0], cr * y0[1] + ci * x0[1]); pi.y = pk2(cr * y0[2] + ci * x0[2], cr * y0[3] + ci * x0[3]);
                pi.z = pk2(cr * y1[0] + ci * x1[0], cr * y1[1] + ci * x1[1]); pi.w = pk2(cr * y1[2] + ci * x1[2], cr * y1[3] + ci * x1[3]); }
            afr[0][tl] = __builtin_bit_cast(bf16x8, pr); afr[1][tl] = __builtin_bit_cast(bf16x8, pi); }
        bf16x8 cf[4];
        f32x2 hst = (f32x2){0.f, 0.f};
        if (PASS == 1) {
#pragma unroll
            for (int kk = 0; kk < 4; ++kk) { const int p0 = 16 * kk + 4 * kg;
                const f32x4 c0 = *(const f32x4*)(a.in[I_S5CRE] + (((size_t)l * 32 + g) * 16 + fr) * 64 + p0), c1 = *(const f32x4*)(a.in[I_S5CIM] + (((size_t)l * 32 + g) * 16 + fr) * 64 + p0);
                v4u pk; pk.x = pk2(c0[0], -c1[0]); pk.y = pk2(c0[1], -c1[1]); pk.z = pk2(c0[2], -c1[2]); pk.w = pk2(c0[3], -c1[3]);
                cf[kk] = __builtin_bit_cast(bf16x8, pk); }
            float pr_ = lbr, pi_ = lbi, l64r = 1.f, l64i = 0.f;
#pragma unroll 1
            for (int q = 0; q < 10; ++q) { const float nr2 = pr_ * pr_ - pi_ * pi_, ni2 = 2.f * pr_ * pi_; pr_ = nr2; pi_ = ni2; if (q == 5) { l64r = pr_; l64i = pi_; } }
            const float lLr = pr_ * l64r - pi_ * l64i, lLi = pr_ * l64i + pi_ * l64r;
#pragma unroll 1
            for (int sgi = 0; sgi < seg; ++sgi) { const f32x2 ev = S5E[((size_t)it * S5_NSEG + sgi) * 64 + p];
                hst = (f32x2){lLr * hst[0] - lLi * hst[1] + ev[0], lLr * hst[1] + lLi * hst[0] + ev[1]}; }
        }
        const f32x2 lbr2 = (f32x2){lbr, lbr}, lbi2 = (f32x2){lbi, lbi};
        const int sbeg = seg * S5_SEGLEN, send = sbeg + S5_SEGLEN;
        v4u un = (v4u){0u, 0u, 0u, 0u}, uc;
#define S5_LOADU(s0_) do { if (kg < 2) { const int row_ = seq_row(b, d, (s0_) + fr); un = *(const v4u*)(Z + (size_t)row_ * IN_COLS + S5_OFF + g * 16 + kg * 8); } } while (0)
        S5_LOADU(sbeg);
#pragma unroll 1
        for (int s0 = sbeg; s0 < send; s0 += 16) {
            uc = un;
            if (s0 + 16 < send) S5_LOADU(s0 + 16);
            const bf16x8 ufr = __builtin_bit_cast(bf16x8, uc);
#pragma unroll
            for (int c = 0; c < 2; ++c)
#pragma unroll
                for (int tl = 0; tl < 4; ++tl) { const f32x4 dd = __builtin_amdgcn_mfma_f32_16x16x32_bf16(afr[c][tl], ufr, (f32x4){0.f, 0.f, 0.f, 0.f}, 0, 0, 0);
                    *(LAS f32x4*)(buL + (c * 16 + fr) * 68 + 16 * tl + 4 * kg) = dd; }
            LDS_WAIT(); asm volatile("" ::: "memory");
            f32x2 bu[16];
#pragma unroll
            for (int s = 0; s < 16; ++s) bu[s] = (f32x2){buL[s * 68 + p], buL[(16 + s) * 68 + p]};
#pragma unroll
            for (int s = 0; s < 16; ++s) {
                const f32x2 sw = (f32x2){-hst[1], hst[0]};
                hst = lbr2 * hst + (lbi2 * sw + bu[s]);
                if (PASS == 1) *(LAS unsigned*)(Hs + s * 136 + 2 * p) = pg8::cvt_pk_bf16(hst[0], hst[1]);
            }
            if (PASS == 1) {
                LDS_WAIT(); asm volatile("" ::: "memory");
                f32x4 acc = (f32x4){0.f, 0.f, 0.f, 0.f};
#pragma unroll
                for (int kk = 0; kk < 4; ++kk) { const bf16x8 af = *(const LAS bf16x8*)(Hs + fr * 136 + 32 * kk + 8 * kg); acc = __builtin_amdgcn_mfma_f32_16x16x32_bf16(af, cf[kk], acc, 0, 0, 0); }
#pragma unroll
                for (int r = 0; r < 4; ++r) { const int row = seq_row(b, d, s0 + 4 * kg + r); YP[((size_t)d * T_ALL + row) * 512 + g * 16 + fr] = acc[r]; }
            }
            LDS_WAIT(); asm volatile("" ::: "memory");
        }
        if (PASS == 0) S5E[((size_t)it * S5_NSEG + seg) * 64 + p] = hst;
#undef S5_LOADU
    }
}

__device__ __forceinline__ void stage_s5_prep(const Ctx& F, int l, int nrows) {
    const auto& a = *F.a; unsigned char* ws = a.ws;
    const bf16* Z = (const bf16*)(ws + WS_Z); const float* YP = (const float*)(ws + WS_YP); bf16* AS5 = (bf16*)(ws + WS_AS5);
    const float dsk = a.in[I_S5D][l * 512 + F.tid];
    for (int row = F.bid; row < nrows; row += F.G) {
        const int c = F.tid;
        const float u = bf2f(Z[(size_t)row * IN_COLS + S5_OFF + c]);
        const float y = YP[(size_t)row * 512 + c] + YP[((size_t)T_ALL + row) * 512 + c] + u * dsk;
        const float ge = 0.5f * y * (1.f + tanhf(0.7978845608028654f * (y + 0.044715f * y * y * y)));
        AS5[(size_t)row * 512 + c] = (bf16)f2bf(ge);
    }
}

__device__ __forceinline__ void stage_hy_pre(const Ctx& F, int l, int nrows) {
    const auto& a = *F.a; unsigned char* ws = a.ws; const int lane = F.lane;
    const bf16* Z = (const bf16*)(ws + WS_Z); bf16* UT = (bf16*)(ws + WS_UT);
    LAS bf16* tl = (LAS bf16*)(F.lds + F.wave * 16384);
    const float* cw = a.in[I_HYCW] + (size_t)l * 3 * 1536; const float* cbp = a.in[I_HYCB] + l * 1536;
    const int gw = F.bid * NWAVES + F.wave, NGW = F.G * NWAVES;
    for (int tile = gw; tile < (nrows / 64) * 24; tile += NGW) {
        const int rt = tile / 24, ct = tile % 24, row0 = rt * 64, col = ct * 64 + lane;
        int base, pos0, n; row_seq(row0, base, pos0, n);
        const bf16* zc = Z + (size_t)base * IN_COLS + HY_OFF + col;
        const float w0 = cw[col], w1 = cw[1536 + col], w2 = cw[2 * 1536 + col], cb = cbp[col];
        float zm = pos0 > 0 ? bf2f(zc[(size_t)(pos0 - 1) * IN_COLS]) : 0.f, z0 = bf2f(zc[(size_t)pos0 * IN_COLS]);
#pragma unroll 8
        for (int r = 0; r < 64; ++r) { const float zp = (pos0 + r + 1 < n) ? bf2f(zc[(size_t)(pos0 + r + 1) * IN_COLS]) : 0.f;
            tl[lane * 66 + r] = (bf16)f2bf(w0 * zm + w1 * z0 + w2 * zp + cb); zm = z0; z0 = zp; }
        LDS_WAIT(); asm volatile("" ::: "memory");
        bf16* up = UT + (size_t)(ct * 64) * T_ALL + row0 + lane;
#pragma unroll 8
        for (int cc = 0; cc < 64; ++cc) up[(size_t)cc * T_ALL] = tl[cc * 66 + lane];
        LDS_WAIT(); asm volatile("" ::: "memory");
    }
}
__device__ __forceinline__ void stage_hy_post(const Ctx& F, int l, int nrows) {
    const auto& a = *F.a; unsigned char* ws = a.ws; const int lane = F.lane;
    const bf16* YT = (const bf16*)(ws + WS_UT) + (size_t)1024 * T_ALL; bf16* YHY = (bf16*)(ws + WS_YHY);
    LAS bf16* tl = (LAS bf16*)(F.lds + F.wave * 8448);
    const int gw = F.bid * NWAVES + F.wave, NGW = F.G * NWAVES;
    for (int tile = gw; tile < (nrows / 64) * 8; tile += NGW) {
        const int rt = tile >> 3, ct = tile & 7, row0 = rt * 64, c0 = ct * 64;
        const bf16* yp = YT + (size_t)c0 * T_ALL + row0 + lane;
#pragma unroll 8
        for (int cc = 0; cc < 64; ++cc) tl[cc * 66 + lane] = yp[(size_t)cc * T_ALL];
        LDS_WAIT(); asm volatile("" ::: "memory");
        bf16* op = YHY + (size_t)row0 * 512 + c0 + lane;
#pragma unroll 8
        for (int r = 0; r < 64; ++r) op[(size_t)r * 512] = tl[lane * 66 + r];
        LDS_WAIT(); asm volatile("" ::: "memory");
    }
}
typedef float f32x16 __attribute__((ext_vector_type(16)));
__device__ __forceinline__ void hyena_item(const Ctx& F, int l, int c, int isctx) {
    const auto& a = *F.a; unsigned char* ws = a.ws; const int tid = F.tid, lane = F.lane;
    const int n = isctx ? CTXL : SEQ, rowbase = isctx ? T_LAT : 0, RL = isctx ? HY_RLENC : HY_RLEN, off = n + 47;
    const bf16* UT = (const bf16*)(ws + WS_UT);
    const bf16* x1g = UT + (size_t)c * T_ALL + rowbase; const bf16* x2g = UT + (size_t)(512 + c) * T_ALL + rowbase; bf16* vg = (bf16*)UT + (size_t)(1024 + c) * T_ALL + rowbase;
    const bf16* Rg = (const bf16*)(ws + WS_GF + l * GF_STRIDE + (isctx ? GF_CTX : 0)) + (size_t)c * RL;
    LAS unsigned char* XB = F.lds; LAS unsigned char* R1 = F.lds + HY_R1_OFF; LAS unsigned char* R2 = F.lds + HY_R2_OFF;
    { const int cpb = n / 8;
      for (int q = tid; q < 8 * cpb; q += NTHREADS) { const int b = q / cpb, ch = q % cpb; *(LAS v4u*)(XB + b * HY_ROWB + 2 * HY_MARG + 16 * ch) = *(const v4u*)(vg + (size_t)b * n + 8 * ch); }
      if (tid < 256) { const int b = tid >> 5, side = (tid >> 4) & 1, ch = tid & 15; *(LAS v4u*)(XB + b * HY_ROWB + (side ? 2 * (HY_MARG + n) : 0) + 16 * ch) = (v4u){0u, 0u, 0u, 0u}; }
      const int rch = RL / 8;
      for (int q = tid; q < rch; q += NTHREADS) { *(LAS v4u*)(R1 + 16 * q) = *(const v4u*)(Rg + 8 * q); *(LAS v4u*)(R2 + 16 * q) = *(const v4u*)(Rg + (size_t)512 * RL + 8 * q); } }
    __syncthreads();
    const int i = lane & 31, kg = lane >> 5, jb = lane & 3, bb = (lane & 31) >> 2;
    const int rsh = (off - i) & 7, rd = rsh >> 1; const bool s1 = rd & 1, s2 = rd & 2; const unsigned sh = (rsh & 1) ? 16u : 0u;
    const int aconst = 2 * (off - i + 8 * kg - rsh), bconst = bb * HY_ROWB + 2 * (HY_MARG + 32 * jb + 8 * kg);
    const int T0w = 512 * F.wave; const int ntile = (n - T0w) >= 512 ? 4 : ((n - T0w) > 0 ? (n - T0w) / 128 : 0);
    const float bias0 = a.in[I_HYBIAS][(l * 2 + 0) * 512 + c], bias1 = a.in[I_HYBIAS][(l * 2 + 1) * 512 + c];
    f32x16 acc[4];
    v2u y1p[4][4];
#define HY_AFRAG(wa, wb, afr) do { \
        const unsigned a0 = s1 ? wa.y : wa.x, a1 = s1 ? wa.z : wa.y, a2 = s1 ? wa.w : wa.z, a3 = s1 ? wb.x : wa.w, a4 = s1 ? wb.y : wb.x, a5 = s1 ? wb.z : wb.y, a6 = s1 ? wb.w : wb.z; \
        const unsigned b0 = s2 ? a2 : a0, b1 = s2 ? a3 : a1, b2 = s2 ? a4 : a2, b3 = s2 ? a5 : a3, b4 = s2 ? a6 : a4; \
        v4u af_; af_.x = __builtin_amdgcn_alignbit(b1, b0, sh); af_.y = __builtin_amdgcn_alignbit(b2, b1, sh); af_.z = __builtin_amdgcn_alignbit(b3, b2, sh); af_.w = __builtin_amdgcn_alignbit(b4, b3, sh); \
        afr = __builtin_bit_cast(bf16x8, af_); } while (0)
#define HY_STEP_COND(RB, d) do { \
        const v4u wa = *(const LAS v4u*)((RB) + aconst - 2 * (d)), wb = *(const LAS v4u*)((RB) + aconst - 2 * (d) + 16); bf16x8 afr; HY_AFRAG(wa, wb, afr); \
        _Pragma("unroll") for (int m = 0; m < 4; ++m) { const int T0 = T0w + 128 * m; \
            if (m < ntile && (d) >= T0 - n + 16 && (d) <= T0 + 96) { const bf16x8 bfr = *(const LAS bf16x8*)(XB + bconst + 2 * (T0 - (d))); \
                acc[m] = __builtin_amdgcn_mfma_f32_32x32x16_bf16(afr, bfr, acc[m], 0, 0, 0); } } } while (0)
#define HY_LOAD(RB, d, wa, wb, bq) do { wa = *(const LAS v4u*)((RB) + aconst - 2 * (d)); wb = *(const LAS v4u*)((RB) + aconst - 2 * (d) + 16); \
        _Pragma("unroll") for (int m = 0; m < 4; ++m) bq[m] = *(const LAS bf16x8*)(XB + bconst + 2 * (T0w + 128 * m - (d))); } while (0)
#define HY_MMA(wa, wb, bq) do { bf16x8 afr; HY_AFRAG(wa, wb, afr); \
        _Pragma("unroll") for (int m = 0; m < 4; ++m) acc[m] = __builtin_amdgcn_mfma_f32_32x32x16_bf16(afr, bq[m], acc[m], 0, 0, 0); } while (0)
#define HY_CONV(RB) do { \
        _Pragma("unroll") for (int m = 0; m < 4; ++m) _Pragma("unroll") for (int e = 0; e < 16; ++e) acc[m][e] = 0.f; \
        if (ntile == 4) { \
            const int dA = T0w - n + 16, dB = T0w + 384 - n + 16, dC = T0w + 96, dD = T0w + 384 + 96;     \
            _Pragma("unroll 1") for (int d = dA; d < dB; d += 16) HY_STEP_COND(RB, d); \
            { v4u waA, wbA, waB, wbB; bf16x8 bqA[4], bqB[4]; \
              HY_LOAD(RB, dB, waA, wbA, bqA); \
              _Pragma("unroll 1") for (int d = dB; d <= dC; d += 32) { \
                  if (d + 16 <= dC) HY_LOAD(RB, d + 16, waB, wbB, bqB); \
                  __builtin_amdgcn_sched_barrier(0); \
                  HY_MMA(waA, wbA, bqA); \
                  __builtin_amdgcn_sched_barrier(0); \
                  if (d + 32 <= dC) HY_LOAD(RB, d + 32, waA, wbA, bqA); \
                  __builtin_amdgcn_sched_barrier(0); \
                  if (d + 16 <= dC) HY_MMA(waB, wbB, bqB); \
                  __builtin_amdgcn_sched_barrier(0); } } \
            _Pragma("unroll 1") for (int d = dC + 16; d <= dD; d += 16) HY_STEP_COND(RB, d); \
        } else if (ntile > 0) { const int dhi = T0w + 128 * (ntile - 1) + 96; \
            _Pragma("unroll 1") for (int d = T0w - n + 16; d <= dhi; d += 16) HY_STEP_COND(RB, d); } } while (0)
    HY_CONV(R1);
#pragma unroll
    for (int m = 0; m < 4; ++m) if (m < ntile) {
#pragma unroll
        for (int rg = 0; rg < 4; ++rg) { const int t4 = T0w + 128 * m + 32 * jb + 8 * rg + 4 * kg;
            const v2u xv = *(const v2u*)(x1g + (size_t)bb * n + t4); const v2u vv = *(const LAS v2u*)(XB + bb * HY_ROWB + 2 * (HY_MARG + t4));
            const float y0 = bflo(xv.x) * (acc[m][4 * rg + 0] + bias0 * bflo(vv.x)), y1 = bfhi(xv.x) * (acc[m][4 * rg + 1] + bias0 * bfhi(vv.x));
            const float y2 = bflo(xv.y) * (acc[m][4 * rg + 2] + bias0 * bflo(vv.y)), y3 = bfhi(xv.y) * (acc[m][4 * rg + 3] + bias0 * bfhi(vv.y));
            y1p[m][rg].x = pk2(y0, y1); y1p[m][rg].y = pk2(y2, y3); } }
    __syncthreads();
#pragma unroll
    for (int m = 0; m < 4; ++m) if (m < ntile) {
#pragma unroll
        for (int rg = 0; rg < 4; ++rg) { const int t4 = T0w + 128 * m + 32 * jb + 8 * rg + 4 * kg; *(LAS v2u*)(XB + bb * HY_ROWB + 2 * (HY_MARG + t4)) = y1p[m][rg]; } }
    __syncthreads();
    HY_CONV(R2);
#pragma unroll
    for (int m = 0; m < 4; ++m) if (m < ntile) {
#pragma unroll
        for (int rg = 0; rg < 4; ++rg) { const int t4 = T0w + 128 * m + 32 * jb + 8 * rg + 4 * kg;
            const v2u xv = *(const v2u*)(x2g + (size_t)bb * n + t4); const v2u yv = y1p[m][rg];
            const float o0 = bflo(xv.x) * (acc[m][4 * rg + 0] + bias1 * bflo(yv.x)), o1 = bfhi(xv.x) * (acc[m][4 * rg + 1] + bias1 * bfhi(yv.x));
            const float o2 = bflo(xv.y) * (acc[m][4 * rg + 2] + bias1 * bflo(yv.y)), o3 = bfhi(xv.y) * (acc[m][4 * rg + 3] + bias1 * bfhi(yv.y));
            v2u ov; ov.x = pk2(o0, o1); ov.y = pk2(o2, o3); *(v2u*)(vg + (size_t)bb * n + t4) = ov; } }
    __syncthreads();
#undef HY_CONV
#undef HY_AFRAG
#undef HY_STEP_COND
#undef HY_LOAD
#undef HY_MMA
}
__device__ __forceinline__ void stage_mixer(const Ctx& F, int l) {
    unsigned* ctr = (unsigned*)(F.a->ws + WS_CTL) + CW_WORK + 64 * l;
    LAS int* itb = (LAS int*)(F.lds + LDSCTL_OFF + 512);
    const int nit = 128 + 512 + (l == 0 ? 512 : 0);
#ifdef PROBE_STATIC
    return;
#endif
    for (;;) {
        if (F.tid == 0) *itb = (int)__hip_atomic_fetch_add(ctr, 1u, __ATOMIC_RELAXED, __HIP_MEMORY_SCOPE_AGENT);
        __syncthreads();
        const int it = *itb;
        __syncthreads();
        if (it >= nit) break;
        Ctx Fi; Fi.a = kargs(); Fi.tid = opaque_v((int)threadIdx.x); Fi.lane = Fi.tid & 63; Fi.wave = __builtin_amdgcn_readfirstlane(Fi.tid >> 6); Fi.bid = opaque((int)blockIdx.x); Fi.G = opaque((int)gridDim.x);
        Fi.lds = (LAS unsigned char*)((LAS unsigned char*)0 + opaque(0)) + (F.lds - (LAS unsigned char*)0);
#ifdef PROBE_T
        if (l == 0 && F.tid == 0 && it == 5) ((unsigned long long*)(F.a->ws + WS_CTL + CW_STAMP * 4))[21] = __builtin_amdgcn_s_memrealtime();
        if (l == 0 && F.tid == 0 && it == 300) ((unsigned long long*)(F.a->ws + WS_CTL + CW_STAMP * 4))[23] = __builtin_amdgcn_s_memrealtime();
#endif
        if (it < 128) { for (int rep = 0; rep < ((DUPK == 9) ? 2 : 1); ++rep) rw_chunk_item2(Fi, opaque(l), it); }
        else if (it < 640) hyena_item(Fi, opaque(l), it - 128, 0);
        else hyena_item(Fi, opaque(l), it - 640, 1);
#ifdef PROBE_T
        if (l == 0 && F.tid == 0 && it == 5) ((unsigned long long*)(F.a->ws + WS_CTL + CW_STAMP * 4))[22] = __builtin_amdgcn_s_memrealtime();
        if (l == 0 && F.tid == 0 && it == 300) ((unsigned long long*)(F.a->ws + WS_CTL + CW_STAMP * 4))[24] = __builtin_amdgcn_s_memrealtime();
#endif
    }
}

typedef float f32x16r __attribute__((ext_vector_type(16)));
__device__ __forceinline__ void stage_norm2_router(const Ctx& F, int l, int nrows) {
    const auto& a = *F.a; unsigned char* ws = a.ws; const int lane = F.lane;
    const float* X = (const float*)(ws + WS_X); bf16* H = (bf16*)(ws + WS_H); const float* MOD = (const float*)(ws + WS_MOD);
    int* EIDX = (int*)(ws + WS_EIDX); float* GATE = (float*)(ws + WS_GATE); int* BLKCNT = (int*)(ws + WS_BLKCNT);
    LAS float* lg = (LAS float*)(F.lds + F.wave * 4352);
    LAS int* hist = (LAS int*)(F.lds + LDSCTL_OFF + 1024);
    if (F.tid < 32) hist[F.tid] = 0;
    __syncthreads();
    const int rpb = (nrows + F.G - 1) / F.G, r0 = F.bid * rpb, r1 = (r0 + rpb < nrows) ? r0 + rpb : nrows;
    const float* rw = a.in[I_RTW] + (size_t)l * 1024 * 32;
    const int i = lane & 31, kk = lane >> 5;
    const f32x4* ng = (const f32x4*)(a.in[I_N2G] + l * D) + kk;
    for (int rb = r0 + F.wave * 32; rb < r1; rb += NWAVES * 32) {
        const int nrow = (r1 - rb) < 32 ? (r1 - rb) : 32; const bool live = i < nrow;
        const int row = live ? rb + i : r1 - 1; const int w = row < T_LAT ? (row >> 12) : 8;
        const f32x4* xr = (const f32x4*)(X + (size_t)row * D) + kk;
        float ss = 0.f;
#pragma unroll 8
        for (int q = 0; q < 128; ++q) { const f32x4 v = xr[2 * q]; ss += (v[0] * v[0] + v[1] * v[1]) + (v[2] * v[2] + v[3] * v[3]); }
        ss += __builtin_bit_cast(float, __builtin_amdgcn_ds_bpermute((lane ^ 32) << 2, __builtin_bit_cast(int, ss)));
        const float rstd = 1.0f / sqrtf(ss * (1.f / D) + 1e-6f);
        const f32x4* sh = (const f32x4*)(MOD + (size_t)(l * 9 + w) * 6144 + 3072) + kk; const f32x4* sc = (const f32x4*)(MOD + (size_t)(l * 9 + w) * 6144 + 4096) + kk;
        v2u* ho = (v2u*)(H + (size_t)row * D) + kk;
        f32x16r acc;
#pragma unroll
        for (int e = 0; e < 16; ++e) acc[e] = 0.f;
        const float* wp = rw + (size_t)(4 * kk) * 32 + i;
#pragma unroll 2
        for (int q = 0; q < 128; ++q) {
            const f32x4 xv = xr[2 * q]; const f32x4 h4 = xv * rstd * ng[2 * q] * (sc[2 * q] + 1.0f) + sh[2 * q];
            const float w0 = wp[(size_t)(8 * q) * 32], w1 = wp[(size_t)(8 * q + 1) * 32], w2 = wp[(size_t)(8 * q + 2) * 32], w3 = wp[(size_t)(8 * q + 3) * 32];
            if (live) { v2u o; o.x = pk2(h4[0], h4[1]); o.y = pk2(h4[2], h4[3]); ho[2 * q] = o; }
            acc = __builtin_amdgcn_mfma_f32_32x32x2f32(h4[0], w0, acc, 0, 0, 0);
            acc = __builtin_amdgcn_mfma_f32_32x32x2f32(h4[1], w1, acc, 0, 0, 0);
            acc = __builtin_amdgcn_mfma_f32_32x32x2f32(h4[2], w2, acc, 0, 0, 0);
            acc = __builtin_amdgcn_mfma_f32_32x32x2f32(h4[3], w3, acc, 0, 0, 0);
        }
        const float rbias = a.in[I_RTB][l * 32 + i];
#pragma unroll
        for (int r = 0; r < 16; ++r) { const int ri = (r & 3) + 8 * (r >> 2) + 4 * kk; lg[ri * 33 + i] = acc[r] + rbias; }
        LDS_WAIT(); asm volatile("" ::: "memory");
        if (lane < nrow) {
            LAS float* lr = lg + lane * 33; const int orow = rb + lane;
            float tv[4]; int ti[4];
#pragma unroll
            for (int r = 0; r < 4; ++r) { float bv = -INFINITY; int bi = 0;
#pragma unroll 8
                for (int e = 0; e < 32; ++e) { const float v = lr[e]; if (v > bv) { bv = v; bi = e; } }
                tv[r] = bv; ti[r] = bi; lr[bi] = -INFINITY; }
            const float e1 = expf(tv[1] - tv[0]), e2 = expf(tv[2] - tv[0]), e3 = expf(tv[3] - tv[0]); const float inv = 1.0f / (1.0f + e1 + e2 + e3);
            *(int4*)(EIDX + orow * 4) = make_int4(ti[0], ti[1], ti[2], ti[3]); *(f32x4*)(GATE + orow * 4) = (f32x4){inv, e1 * inv, e2 * inv, e3 * inv};
#pragma unroll
            for (int r = 0; r < 4; ++r) __hip_atomic_fetch_add(&hist[ti[r]], 1, __ATOMIC_RELAXED, __HIP_MEMORY_SCOPE_WORKGROUP);
        }
        LDS_WAIT(); asm volatile("" ::: "memory");
    }
    __syncthreads();
    if (F.tid < 32) BLKCNT[F.bid * 32 + F.tid] = hist[F.tid];
    __syncthreads();
}

__device__ __forceinline__ void stage_moe_scatter(const Ctx& F, int l, int nrows) {
    const auto& a = *F.a; unsigned char* ws = a.ws; const int lane = F.lane;
    const bf16* H = (const bf16*)(ws + WS_H); bf16* XS = (bf16*)(ws + WS_XS);
    const int* EIDX = (const int*)(ws + WS_EIDX); int* POS = (int*)(ws + WS_POS); const int* BLKCNT = (const int*)(ws + WS_BLKCNT); int* META = (int*)(ws + WS_META);
    LAS int* tot = (LAS int*)F.lds; LAS int* off = tot + 32; LAS int* base = tot + 64; LAS int* posl = tot + 128; LAS int* eloc = tot + 4096;
    const int rpb = (nrows + F.G - 1) / F.G, r0 = F.bid * rpb, r1 = (r0 + rpb < nrows) ? r0 + rpb : nrows; const int na = (r1 > r0) ? (r1 - r0) * 4 : 0;
    for (int i = F.tid; i < na; i += NTHREADS) eloc[i] = EIDX[r0 * 4 + i];
    { LAS int* part = tot + 8192; const int e = F.tid & 31, pt = F.tid >> 5; int t = 0, o = 0;
      for (int b2 = pt; b2 < F.G; b2 += 16) { const int c = BLKCNT[b2 * 32 + e]; t += c; o += (b2 < F.bid) ? c : 0; }
      part[pt * 32 + e] = t; part[512 + pt * 32 + e] = o; }
    __syncthreads();
    if (F.tid < 32) { LAS int* part = tot + 8192; int t = 0, o = 0;
#pragma unroll
        for (int pt = 0; pt < 16; ++pt) { t += part[pt * 32 + F.tid]; o += part[512 + pt * 32 + F.tid]; }
        tot[F.tid] = t; off[F.tid] = o; }
    __syncthreads();
    if (F.tid == 0) { int acc = 0; for (int e = 0; e < 32; ++e) { base[e] = acc; acc += (tot[e] + 255) & ~255; } base[32] = acc; }
    __syncthreads();
    if (F.bid == 0 && F.tid < 33) META[F.tid] = base[F.tid];
    if (F.tid < 32) { int run = base[F.tid] + off[F.tid]; for (int i = 0; i < na; ++i) { if (eloc[i] == F.tid) { posl[i] = run; POS[r0 * 4 + i] = run; ++run; } } }
    __syncthreads();
    for (int i = F.wave; i < na; i += NWAVES) { const int row = r0 + (i >> 2); const int p = posl[i];
        const v4u* s = (const v4u*)(H + (size_t)row * D) + lane; v4u* dp = (v4u*)(XS + (size_t)p * D) + lane;
        dp[0] = s[0]; dp[64] = s[64]; }
    __syncthreads();
}
__device__ __forceinline__ LAS int* load_moe_base(const Ctx& F) {
    LAS int* base = (LAS int*)(F.lds + LDSCTL_OFF + 256);
    const int* META = (const int*)(F.a->ws + WS_META);
    if (F.tid < 33) base[F.tid] = META[F.tid];
    __syncthreads();
    return base;
}

constexpr int NSTAGE_L = 13, NSTAGES = 1 + DEPTH * NSTAGE_L + 1;
__global__ void __launch_bounds__(NTHREADS, 2) mk_fwd(Args args) {
    extern __shared__ __attribute__((aligned(16))) unsigned char lds_raw[];
    Ctx F; F.a = kargs(); F.lds = (LAS unsigned char*)lds_raw; F.tid = threadIdx.x; F.lane = F.tid & 63; F.wave = __builtin_amdgcn_readfirstlane(F.tid >> 6); F.bid = blockIdx.x; F.G = gridDim.x;
    volatile LAS unsigned* MISC = (volatile LAS unsigned*)(F.lds + LDSCTL_OFF);
    for (int u = F.tid; u < (LDS_BYTES - LDSCTL_OFF) / 4; u += NTHREADS) ((LAS unsigned*)(F.lds + LDSCTL_OFF))[u] = 0u;
    __syncthreads();
#if MK_PER_STAGE
#define GRID_BAR() do { } while (0)
#else
    (void)xcd_barrier_post((unsigned*)(F.a->ws + WS_CTL) + CW_BAR, MISC + 8);
#define GRID_BAR() do { XcdBarrier b_; b_.bar = (unsigned*)(kargs()->ws + WS_CTL) + CW_BAR; b_.x = xb_xcc_id(); b_.st = (volatile LAS unsigned*)((LAS unsigned char*)lds_raw + LDSCTL_OFF + opaque(32)); xcd_barrier(b_); } while (0)
#endif
#ifndef ONLY_S
#define ONLY_S -1
#endif
#define STG_SEL(k) (ONLY_S < 0 || ONLY_S == (((k) == 0) ? 0 : ((k) == NSTAGES - 1 ? 14 : (((k) - 1) % NSTAGE_L) + 1)))
#if MK_PER_STAGE
#define IN(k) (STG_SEL(k) && kargs()->ph_lo == (k))
#else
#define IN(k) STG_SEL(k)
#endif
#if MK_PER_STAGE
#define SEAM(k) do { } while (0)
#else
#define SEAM(k) do { if ((k) + 1 < NSTAGES) GRID_BAR(); } while (0)
#endif
#define STAGE(k) if (IN(k)) { F.a = kargs(); F.tid = opaque_v((int)threadIdx.x); F.lane = F.tid & 63; F.wave = __builtin_amdgcn_readfirstlane(F.tid >> 6); F.bid = opaque((int)blockIdx.x); F.G = opaque((int)gridDim.x); F.lds = (LAS unsigned char*)lds_raw + opaque(0); unsigned char* ws = F.a->ws; const int l = opaque(lq); unsigned char* wl = ws + WS_WTS + (size_t)l * WL_STRIDE; (void)wl; (void)ws;
#define STAGE_END(k) } SEAM(k);
    int lq = 0;
    STAGE(0) p0_prologue(F); STAGE_END(0)
    for (lq = 0; lq < DEPTH; ++lq) {
        const int sb = 1 + lq * NSTAGE_L;
        const int nrl = opaque((lq == DEPTH - 1) ? T_LAT : T_ALL);
        STAGE(sb + 0) stage_norm1(F, l); STAGE_END(sb + 0)
        STAGE(sb + 1) pg8::SchedStatic S; S.init(ws + WS_H, wl + WO_WIN, T_ALL, IN_COLS, 1024, F.G, F.bid); pg8::EpiBf16 E{(bf16*)(ws + WS_Z), IN_COLS, nullptr, 0};
            pg8::gemm_phase(F.lds, F.tid, 1024, S, E); STAGE_END(sb + 1)
        STAGE(sb + 2) for (int rep = 0; rep < REPN(1); ++rep) stage_rw_prep1(F, l); for (int rep = 0; rep < REPN(2); ++rep) stage_s5_scan<0>(F, l); for (int rep = 0; rep < REPN(3); ++rep) stage_hy_pre(F, l, nrl); STAGE_END(sb + 2)
        STAGE(sb + 3) { pg8::SchedStatic S; S.init(ws + WS_ARW, wl + WO_RWCAT, T_ALL, 2560, 256, F.G, F.bid); pg8::EpiBf16 E{(bf16*)(ws + WS_P), 2560, nullptr, 0}; PT(4); pg8::gemm_phase(F.lds, F.tid, 256, S, E); PT(5); }
            for (int rep = 0; rep < REPN(4); ++rep) stage_s5_scan<1>(F, l); STAGE_END(sb + 3)
        STAGE(sb + 4) for (int rep = 0; rep < REPN(5); ++rep) stage_rw_prep2(F, l); for (int rep = 0; rep < REPN(6); ++rep) stage_s5_prep(F, l, nrl); STAGE_END(sb + 4)
        STAGE(sb + 5) PT(10); stage_mixer(F, l); PT(11); STAGE_END(sb + 5) STAGE(sb + 5) PT(12); }
        STAGE(sb + 6) { pg8::SchedStatic S; S.init(ws + WS_AS5, wl + WO_GLU, nrl, 1024, 512, F.G, F.bid); pg8::EpiGlu<0> E{(bf16*)(ws + WS_YS5), 512, F.a->in[I_S5GLUB] + l * 1024, 0, 512}; PT(13); pg8::gemm_phase(F.lds, F.tid, 512, S, E); PT(14); }
            for (int rep = 0; rep < REPN(7); ++rep) stage_rw_readout(F, l); for (int rep = 0; rep < REPN(8); ++rep) stage_hy_post(F, l, nrl); STAGE_END(sb + 6)
        STAGE(sb + 7) pg8::SchedMerge S; S.A0 = (const char*)(ws + WS_YHY); S.A1 = (const char*)(ws + WS_YRW); S.A2 = (const char*)(ws + WS_YS5); S.Bt = (const char*)(wl + WO_WBR); S.tstep = (size_t)256 * 512 * 2; S.bstride = (size_t)1024 * 512 * 2;
            S.nM = nrl / 256; S.nN = 4; S.G = F.G; S.c = F.bid;
            pg8::EpiMerge E{(float*)(ws + WS_MTMP), (bf16*)(ws + WS_H), (const bf16*)(ws + WS_Z) + GATE_OFF}; pg8::gemm_phase(F.lds, F.tid, 512, S, E); STAGE_END(sb + 7)
        STAGE(sb + 8) pg8::SchedStatic S; S.init(ws + WS_H, wl + WO_WOUT, nrl, 1024, 1024, F.G, F.bid); pg8::EpiResid E{(float*)(ws + WS_X), (const float*)(ws + WS_MOD) + (size_t)l * 9 * 6144 + 2048};
            pg8::gemm_phase(F.lds, F.tid, 1024, S, E); STAGE_END(sb + 8)
        STAGE(sb + 9) PT(17); stage_norm2_router(F, l, nrl); PT(18); STAGE_END(sb + 9)
        STAGE(sb + 10) PT(19); stage_moe_scatter(F, l, nrl); PT(20); STAGE_END(sb + 10)
        STAGE(sb + 11) LAS int* base = load_moe_base(F);
            pg8::SchedMoe S; S.A = (const char*)(ws + WS_XS); S.Bt = (const char*)(wl + WO_W1); S.tstep = (size_t)256 * 1024 * 2; S.estride = (size_t)2048 * 1024 * 2; S.NPN = 8; S.G = F.G; S.c = F.bid; S.base = base;
            pg8::EpiGlu<1> E{(bf16*)(ws + WS_ACT), 1024, F.a->in[I_B1] + (size_t)l * 32 * 2048, 2048, 1024}; pg8::gemm_phase(F.lds, F.tid, 1024, S, E); STAGE_END(sb + 11)
        STAGE(sb + 12) LAS int* base = load_moe_base(F);
            pg8::SchedMoe S; S.A = (const char*)(ws + WS_ACT); S.Bt = (const char*)(wl + WO_W2); S.tstep = (size_t)256 * 1024 * 2; S.estride = (size_t)1024 * 1024 * 2; S.NPN = 4; S.G = F.G; S.c = F.bid; S.base = base;
            pg8::EpiBf16 E{(bf16*)(ws + WS_XS), 1024, F.a->in[I_B2] + (size_t)l * 32 * 1024, 1024}; pg8::gemm_phase(F.lds, F.tid, 1024, S, E); STAGE_END(sb + 12)
    }
    lq = DEPTH;
    STAGE(NSTAGES - 1)
#ifndef PROBE_T
        stage_norm1(F, l);
#endif
#ifdef PROBE_T
        { const unsigned long long* st = (const unsigned long long*)(F.a->ws + WS_CTL + CW_STAMP * 4); const float cval = (float)(long long)(st[PROBE_B] - st[PROBE_A]) * (1.0f / (100.0f * PROBE_DIV));
          __syncthreads(); for (size_t i = (size_t)F.bid * NTHREADS + F.tid; i < (size_t)T_LAT * D; i += (size_t)F.G * NTHREADS) F.a->out[i] = cval; }
#endif
    }
#undef IN
#undef SEAM
}

extern "C" void kernel_launch(void* const* d_in, const int* in_sizes, int n_in, void* d_out, int out_size, void* d_ws, size_t ws_size, hipStream_t stream) {
    static int grid = 0;
    if (grid == 0) {
        if (n_in != 51 || out_size != T_LAT * D || ws_size < WS_END) { fprintf(stderr, "kernel_launch: unexpected shapes (n_in %d out %d ws %zu, need %zu)\n", n_in, out_size, ws_size, (size_t)WS_END); grid = -1; return; }
        int dev = 0, cus = 0, per_cu = 0;
        if (hipGetDevice(&dev) != hipSuccess || hipDeviceGetAttribute(&cus, hipDeviceAttributeMultiprocessorCount, dev) != hipSuccess) { grid = -1; return; }
        if (hipFuncSetAttribute((const void*)mk_fwd, hipFuncAttributeMaxDynamicSharedMemorySize, LDS_BYTES) != hipSuccess) { fprintf(stderr, "kernel_launch: hipFuncSetAttribute failed\n"); grid = -1; return; }
        if (hipOccupancyMaxActiveBlocksPerMultiprocessor(&per_cu, (const void*)mk_fwd, NTHREADS, LDS_BYTES) != hipSuccess || per_cu < 1) fprintf(stderr, "kernel_launch: occupancy query says %d\n", per_cu);
        (void)hipGetLastError();
        grid = cus;
    }
    if (grid < 0) return;
    if (hipMemsetAsync((char*)d_ws + WS_CTL, 0, CTL_ZERO_BYTES, stream) != hipSuccess) return;
    Args a{};
    for (int i = 0; i < 51; ++i) a.in[i] = (const float*)d_in[i];
    a.out = (float*)d_out; a.ws = (unsigned char*)d_ws;
#if MK_PER_STAGE
    for (int s = 0; s < NSTAGES; ++s) { a.ph_lo = s; a.ph_hi = s + 1; int reps = 1;
#ifdef PROBE_SET
        { const int ls = (s == 0 || s == NSTAGES - 1) ? -1 : (s - 1) % NSTAGE_L;
          if (PROBE_SET >= 1 && PROBE_SET <= 13 && ls == PROBE_SET - 1 && ls != 5 && ls != 8 && !(ls == 0 && s > 1)) reps = 3;
          if (PROBE_SET == 14 && s == 0) reps = 3; }
#endif
        for (int r = 0; r < reps; ++r) hipLaunchKernelGGL(mk_fwd, dim3(grid), dim3(NTHREADS), LDS_BYTES, stream, a); }
#else
    a.ph_lo = 0; a.ph_hi = NSTAGES; hipLaunchKernelGGL(mk_fwd, dim3(grid), dim3(NTHREADS), LDS_BYTES, stream, a);
#endif
}
```

```cpp
#include <hip/hip_runtime.h>
#include <cstdio>
#include <cstdint>

#ifndef DUPK
#define DUPK 0
#endif
#define REPN(k) ((DUPK == (k)) ? 3 : 1)
#ifndef REP_GEMM
#define REP_GEMM 1
#endif
#ifndef REP_LIGHT
#define REP_LIGHT 1
#endif
#ifndef REP_PRO
#define REP_PRO 1
#endif
#ifndef MK_PER_STAGE
#define MK_PER_STAGE 0
#endif

#define GAS __attribute__((address_space(1)))
#define LAS __attribute__((address_space(3)))
typedef unsigned short bf16;
typedef unsigned v4u __attribute__((ext_vector_type(4)));
typedef unsigned v2u __attribute__((ext_vector_type(2)));
typedef float f32x4 __attribute__((ext_vector_type(4)));
typedef float f32x2 __attribute__((ext_vector_type(2)));
typedef short bf16x8 __attribute__((ext_vector_type(8)));

constexpr int D = 1024, BATCH = 8, SEQ = 4096, CTXL = 256, DEPTH = 2;
constexpr int T_LAT = BATCH * SEQ, T_CTX = BATCH * CTXL, T_ALL = T_LAT + T_CTX;
constexpr int IN_COLS = 6912, HY_OFF = 0, RW_OFF = 1536, S5_OFF = 3328, GATE_OFF = 3840;
constexpr int NE = 32, TOPK = 4;
constexpr int MAXSLOT = 147456;
constexpr int NWAVES = 8, NTHREADS = 512;
constexpr int HY_MARG = 128, HY_ROWB = 8720, HY_RLEN = 8272, HY_RLENC = 592;
constexpr int HY_R1_OFF = 8 * HY_ROWB, HY_R2_OFF = HY_R1_OFF + HY_RLEN * 2;

constexpr size_t MiB = 1ull << 20;
constexpr size_t WS_CTL = 0, CTL_ZERO_BYTES = 1 * MiB;
constexpr size_t WS_MOD = 1 * MiB;
constexpr size_t WS_BLKCNT = 2 * MiB;
constexpr size_t WS_META = 2 * MiB + 512 * 1024;
constexpr size_t WS_ROWOF = 7 * MiB;
constexpr size_t WS_EIDX = 3 * MiB, WS_GATE = 4 * MiB, WS_POS = 5 * MiB;
constexpr size_t WS_WTS = 8 * MiB, WL_STRIDE = 214 * MiB;
constexpr size_t WO_WIN = 0, WO_RWCAT = 14 * MiB, WO_GLU = 16 * MiB, WO_WBR = 17 * MiB, WO_WOUT = 20 * MiB, WO_W1 = 22 * MiB, WO_W2 = 150 * MiB;
constexpr size_t WS_GF = 436 * MiB, GF_STRIDE = 20 * MiB, GF_CTX = 17 * MiB;
constexpr size_t WS_X = 504 * MiB;
constexpr size_t WS_H = 640 * MiB;
constexpr size_t WS_BIG = 708 * MiB;
constexpr size_t WS_Z = WS_BIG;
constexpr size_t WS_SCN = 1167 * MiB;
constexpr size_t WS_MTMP = WS_SCN;
constexpr size_t WS_P = 1473 * MiB;
constexpr size_t WS_ARW = 1643 * MiB;
constexpr size_t WS_YP = 1660 * MiB;
constexpr size_t WS_YDIR = WS_YP;
constexpr size_t WS_UT = 1796 * MiB;
constexpr size_t WS_AS5 = 2000 * MiB;
constexpr size_t WS_YHY = 1898 * MiB, WS_YRW = 1932 * MiB, WS_YS5 = 1966 * MiB;
constexpr size_t WS_XS = WS_BIG;
constexpr size_t WS_ACT = WS_BIG + 288 * MiB;
constexpr size_t WS_END = 2034 * MiB;
constexpr int CW_BAR = 4096;

constexpr int RING_BYTES = 131072;
constexpr int LDSCTL_OFF = RING_BYTES;
constexpr int LDS_BYTES = 163840;

typedef __bf16 bf16x2_t __attribute__((ext_vector_type(2)));
__device__ __forceinline__ unsigned pk2(float lo, float hi) { const bf16x2_t v = __builtin_convertvector((f32x2){lo, hi}, bf16x2_t); return __builtin_bit_cast(unsigned, v); }
__device__ __forceinline__ unsigned f2bf(float f) { return pk2(f, 0.f) & 0xffffu; }
__device__ __forceinline__ float bf2f(bf16 b) { return __builtin_bit_cast(float, ((unsigned)b) << 16); }
__device__ __forceinline__ float bflo(unsigned w) { return __builtin_bit_cast(float, w << 16); }
__device__ __forceinline__ float bfhi(unsigned w) { return __builtin_bit_cast(float, w & 0xffff0000u); }
__device__ __forceinline__ float sigm(float x) { return 1.f / (1.f + __expf(-x)); }
#define LDS_WAIT() asm volatile("s_waitcnt lgkmcnt(0)" ::: "memory")
__device__ __forceinline__ float dpp_f(float x, const int ctrl_sel) {
    const int v = __builtin_bit_cast(int, x);
    int r;
    if (ctrl_sel == 0) r = __builtin_amdgcn_update_dpp(0, v, 0xB1, 0xF, 0xF, true);
    else if (ctrl_sel == 1) r = __builtin_amdgcn_update_dpp(0, v, 0x4E, 0xF, 0xF, true);
    else r = __builtin_amdgcn_update_dpp(0, v, 0x141, 0xF, 0xF, true);
    return __builtin_bit_cast(float, r);
}
__device__ __forceinline__ float red32(float x) {
    x += dpp_f(x, 0); x += dpp_f(x, 1); x += dpp_f(x, 2);
    x += __builtin_bit_cast(float, __builtin_amdgcn_update_dpp(0, __builtin_bit_cast(int, x), 0x128, 0xF, 0xF, true));
    x += __builtin_bit_cast(float, __builtin_amdgcn_ds_swizzle(__builtin_bit_cast(int, x), 0x401F));
    return x;
}
__device__ __forceinline__ float wave_sum(float v) {
    v = red32(v);
    return __builtin_bit_cast(float, __builtin_amdgcn_readlane(__builtin_bit_cast(int, v), 0)) + __builtin_bit_cast(float, __builtin_amdgcn_readlane(__builtin_bit_cast(int, v), 32));
}
__device__ __forceinline__ int xch32(int v, const int step) {
    if (step == 0) return __builtin_amdgcn_update_dpp(0, v, 0xB1, 0xF, 0xF, true);
    if (step == 1) return __builtin_amdgcn_update_dpp(0, v, 0x4E, 0xF, 0xF, true);
    if (step == 2) return __builtin_amdgcn_update_dpp(0, v, 0x141, 0xF, 0xF, true);
    if (step == 3) return __builtin_amdgcn_update_dpp(0, v, 0x128, 0xF, 0xF, true);
    return __builtin_amdgcn_ds_swizzle(v, 0x401F);
}
__device__ __forceinline__ float red8(float x) { x += dpp_f(x, 0); x += dpp_f(x, 1); x += dpp_f(x, 2); return x; }

#define XB_TMO      128
#define XB_XCNT(j)  (256  + 64 * (j))
#define XB_XSUB(j)  (1280 + 64 * (j))
#define XB_XGEN(j)  (2304 + 64 * (j))
#define XB_TOP      3328
#define XB_TOPGEN   3392
#define XCD_BAR_WORDS 3456
#define XB_SPIN_CAP (1u << 22)
__device__ __forceinline__ unsigned xb_ld(unsigned* p)              { return __hip_atomic_load(p, __ATOMIC_RELAXED, __HIP_MEMORY_SCOPE_AGENT); }
__device__ __forceinline__ unsigned xb_add(unsigned* p, unsigned v) { return __hip_atomic_fetch_add(p, v, __ATOMIC_RELAXED, __HIP_MEMORY_SCOPE_AGENT); }
__device__ __forceinline__ unsigned xb_xcc_id() { return (unsigned)__builtin_amdgcn_s_getreg((3 << 11) | 20) & 0xFu; }
#define XB_SPIN(cond, bar) do { unsigned _sp = 0; while (cond) { __builtin_amdgcn_s_sleep(1); \
    if ((++_sp & 255u) == 0u) { if (xb_ld(&(bar)[XB_TMO])) break; if (_sp > XB_SPIN_CAP) { atomicAdd(&(bar)[XB_TMO], 1u); break; } } } } while (0)
struct XcdBarrier { unsigned* bar; unsigned x; volatile LAS unsigned* st; };
__device__ __forceinline__ XcdBarrier xcd_barrier_post(unsigned* bar, volatile LAS unsigned* st) {
    XcdBarrier b; b.bar = bar; b.x = xb_xcc_id(); b.st = st;
    if (threadIdx.x == 0) (void)xb_add(&bar[XB_XCNT(b.x)], 1u);
    return b;
}
__device__ __forceinline__ void xcd_barrier_complete(unsigned* bar, unsigned x, unsigned& nloc, unsigned& nx) {
    const unsigned G = gridDim.x * gridDim.y * gridDim.z;
    unsigned sum, cnt, mine, sp = 0u;
    for (;;) {
        sum = 0u; cnt = 0u; mine = 0u;
#pragma unroll
        for (unsigned j = 0; j < 16; ++j) { const unsigned c = xb_ld(&bar[XB_XCNT(j)]); sum += c; cnt += (c > 0u) ? 1u : 0u; mine = (j == x) ? c : mine; }
        if (sum == G) break;
        __builtin_amdgcn_s_sleep(1);
        if ((++sp & 255u) == 0u) { if (xb_ld(&bar[XB_TMO])) break; if (sp > XB_SPIN_CAP) { atomicAdd(&bar[XB_TMO], 1u); break; } }
    }
    nloc = mine > 0u ? mine : 1u; nx = cnt > 0u ? cnt : 1u;
}
__device__ __forceinline__ void xcd_barrier(const XcdBarrier& b) {
    asm volatile("s_waitcnt vmcnt(0)" ::: "memory");
    __syncthreads();
    if (threadIdx.x == 0) {
        unsigned* bar = b.bar;
        __builtin_amdgcn_s_waitcnt(0);
        unsigned nloc = b.st[0], nx = b.st[1];
        if (nloc == 0u) { xcd_barrier_complete(bar, b.x, nloc, nx); b.st[0] = nloc; b.st[1] = nx; }
        const unsigned old = xb_add(&bar[XB_XSUB(b.x)], 1u);
        const unsigned gen = old / nloc;
        if (old + 1u == (gen + 1u) * nloc) {
            __builtin_amdgcn_fence(__ATOMIC_RELEASE, "agent");
            asm volatile("s_waitcnt vmcnt(0)" ::: "memory");
            const unsigned og = xb_add(&bar[XB_TOP], 1u);
            const unsigned tg = og / nx;
            if (og + 1u == (tg + 1u) * nx) xb_add(&bar[XB_TOPGEN], 1u);
            else XB_SPIN(xb_ld(&bar[XB_TOPGEN]) == tg, bar);
            __builtin_amdgcn_fence(__ATOMIC_ACQUIRE, "agent");
            xb_add(&bar[XB_XGEN(b.x)], 1u);
            asm volatile("s_waitcnt vmcnt(0)" ::: "memory");
        } else {
            XB_SPIN(xb_ld(&bar[XB_XGEN(b.x)]) == gen, bar);
            __builtin_amdgcn_fence(__ATOMIC_ACQUIRE, "agent");
            asm volatile("s_waitcnt vmcnt(0)" ::: "memory");
        }
    }
    __syncthreads();
}

namespace pg8 {
constexpr int BM = 256, BK = 64, HALF = 128, HTB = HALF * BK * 2, STAGE_BYTES = 8 * HTB, NXCD = 8, WGM = 8, ROWTAB_OFF = 131072 + 4096;
__host__ __device__ __forceinline__ int lds_byte(int r, int c) { const int st = (r >> 4) * 2 + (c >> 5), rr = r & 15, cc = c & 31, ob = rr * 64 + cc * 2; return st * 1024 + (ob ^ (((ob >> 9) & 1) << 5)); }
__host__ __device__ __forceinline__ void stage_rc(int b, int& R, int& C) { const int st = b / 1024, sb = b % 1024, swz = sb ^ (((sb >> 9) & 1) << 5); R = (st >> 1) * 16 + swz / 64; C = (st & 1) * 32 + (swz % 64) / 2; }
__host__ __device__ __forceinline__ int perm32(int rho) { const int n = rho >> 4, i = rho & 15; return 8 * (i >> 2) + 4 * n + (i & 3); }
struct Unit { int pm, pn, e; };
__device__ __forceinline__ unsigned cvt_pk_bf16(float lo, float hi) { return pk2(lo, hi); }

__device__ __forceinline__ void tile_of(int L, int nM, int nN, int& pm, int& pn) {
    const int nwg = nM * nN; int wgid = L;
    { const int q = nwg / NXCD, r = nwg % NXCD, xcd = wgid % NXCD, off = wgid / NXCD; wgid = (xcd < r ? xcd * (q + 1) : r * (q + 1) + (xcd - r) * q) + off; }
    const int nig = WGM * nN, gid = wgid / nig, fm = gid * WGM, gsz = (nM - fm) < WGM ? (nM - fm) : WGM;
    pm = fm + ((wgid % nig) % gsz); pn = (wgid % nig) / gsz;
}
struct SchedStatic {
    static constexpr bool GATHER = false;
    const char* A; const char* Bt; size_t tstep; int nM, nN, G, c;
    __device__ __forceinline__ void init(const void* A_, const void* Bt_, int M, int N, int K, int G_, int c_) { A = (const char*)A_; Bt = (const char*)Bt_; tstep = (size_t)BM * K * 2; nM = M / BM; nN = N / BM; G = G_; c = c_; }
    __device__ __forceinline__ bool next(int i, Unit& u) const { const long L = (long)i * G + c; if (L >= (long)nM * nN) return false; tile_of((int)L, nM, nN, u.pm, u.pn); u.e = 0; return true; }
    __device__ __forceinline__ const char* aptr(const Unit& u) const { return A + (size_t)u.pm * tstep; }
    __device__ __forceinline__ const char* bptr(const Unit& u) const { return Bt + (size_t)u.pn * tstep; }
};
struct SchedMerge {
    static constexpr bool GATHER = false;
    const char* A0; const char* A1; const char* A2; const char* Bt; size_t tstep, bstride; int nM, nN, G, c;
    __device__ __forceinline__ bool next(int i, Unit& u) const { const int j = i / 3, br = i - 3 * j; const long L = (long)j * G + c; if (L >= (long)nM * nN) return false; tile_of((int)L, nM, nN, u.pm, u.pn); u.e = br; return true; }
    __device__ __forceinline__ const char* aptr(const Unit& u) const { return (u.e == 0 ? A0 : (u.e == 1 ? A1 : A2)) + (size_t)u.pm * tstep; }
    __device__ __forceinline__ const char* bptr(const Unit& u) const { return Bt + (size_t)u.e * bstride + (size_t)u.pn * tstep; }
};
struct SchedMoe {
    static constexpr bool GATHER = false;
    const char* A; const char* Bt; size_t tstep, estride; int NPN, G, c; const LAS int* base;
    __device__ __forceinline__ bool next(int i, Unit& u) const {
        const int ntiles = base[32] >> 8; const int per = G >> 3;
        const long L = (long)i * G + (((G & 7) == 0) ? (c & 7) * per + (c >> 3) : c);
        if (L >= (long)ntiles * NPN) return false;
        u.pm = (int)(L / NPN); u.pn = (int)(L % NPN); const int r0 = u.pm << 8; int e = 0;
#pragma unroll 1
        for (int k = 1; k < 32; ++k) e += (r0 >= base[k]) ? 1 : 0;
        u.e = e; return true;
    }
    __device__ __forceinline__ const char* aptr(const Unit& u) const { return A + (size_t)u.pm * tstep; }
    __device__ __forceinline__ const char* bptr(const Unit& u) const { return Bt + (size_t)u.e * estride + (size_t)u.pn * tstep; }
};
struct SchedMoeG : SchedMoe {
    static constexpr bool GATHER = true;
    const unsigned* rowof;
    __device__ __forceinline__ const char* aptr(const Unit&) const { return A; }
};

template <class Epi, class Sched>
__device__ __forceinline__ void gemm_phase(LAS unsigned char* lds, const int tid, const int K, const Sched& S, const Epi& E) {
    const int wid = __builtin_amdgcn_readfirstlane(tid >> 6), lane = tid & 63, wr = wid >> 2, wc = wid & 3, fr = lane & 15, fq = lane >> 4;
    const int nt = K / BK;
    unsigned voffA[2], voffB[2];
#pragma unroll
    for (int i = 0; i < 2; ++i) { int R, C; stage_rc(tid * 16 + i * 8192, R, C); const int Rb = Epi::PERM ? ((R & ~31) + perm32(R & 31)) : R;
        voffA[i] = (unsigned)(R * K + C) * 2u; voffB[i] = (unsigned)(Rb * K + C) * 2u; }
    const size_t kstep = (size_t)(BK * 2);
    const size_t hstep = (size_t)HALF * K * 2;
    const unsigned ldsw = (unsigned)wid * 1024u;
    const int aoff = lds_byte(wr * 64 + fr, fq * 8), boff = lds_byte(wc * 32 + fr, fq * 8);
#define PG8_SA(b, h) (((b) * 2 + (h)) * HTB)
#define PG8_SB(b, h) ((4 + (b) * 2 + (h)) * HTB)
#define PG8_STAGE(bufoff, gbase, voff) do { _Pragma("unroll") for (int _i = 0; _i < 2; ++_i) \
        __builtin_amdgcn_global_load_lds((const unsigned*)((const char*)(gbase) + (voff)[_i]), (LAS unsigned*)(lds + (bufoff) + ldsw + _i * 8192), 16, 0, 0); } while (0)
#define PG8_STAGEA(bufoff, kp, h) do { if constexpr (Sched::GATHER) { _Pragma("unroll") for (int _i = 0; _i < 2; ++_i) \
        __builtin_amdgcn_global_load_lds((const unsigned*)((const char*)(kp) + g[2 * (h) + _i]), (LAS unsigned*)(lds + (bufoff) + ldsw + _i * 8192), 16, 0, 0); } \
        else { PG8_STAGE(bufoff, (kp) + (h) * hstep, voffA); } } while (0)
#define PG8_GLOAD(buf) do { const LAS unsigned* rt_ = (const LAS unsigned*)(lds + ROWTAB_OFF + (buf) * 1024) + gR0; _Pragma("unroll") for (int _j = 0; _j < 4; ++_j) g[_j] = rt_[64 * _j] + gCb; } while (0)
#define PG8_GDMA(pm_, buf) do { if (wid == 0) __builtin_amdgcn_global_load_lds((const unsigned*)(S.rowof + (size_t)(pm_) * 256 + lane * 4), (LAS unsigned*)(lds + ROWTAB_OFF + (buf) * 1024), 16, 0, 0); } while (0)
#define PG8_LDA(dst, b, h) do { _Pragma("unroll") for (int m = 0; m < 4; ++m) _Pragma("unroll") for (int k = 0; k < 2; ++k) dst[m][k] = *(const LAS bf16x8*)(lds + PG8_SA(b, h) + aoff + m * 2048 + k * 1024); } while (0)
#define PG8_LDB(dst, b, h) do { _Pragma("unroll") for (int n = 0; n < 2; ++n) _Pragma("unroll") for (int k = 0; k < 2; ++k) dst[n][k] = *(const LAS bf16x8*)(lds + PG8_SB(b, h) + boff + n * 2048 + k * 1024); } while (0)
#define PG8_MMA(ai, bj, At, Bt) do { __builtin_amdgcn_s_setprio(1); _Pragma("unroll") for (int m = 0; m < 4; ++m) _Pragma("unroll") for (int n = 0; n < 2; ++n) _Pragma("unroll") for (int k = 0; k < 2; ++k) \
        acc[ai][bj][m][n] = __builtin_amdgcn_mfma_f32_16x16x32_bf16(Bt[n][k], At[m][k], acc[ai][bj][m][n], 0, 0, 0); __builtin_amdgcn_s_setprio(0); } while (0)
#define PG8_WAIT_V(n) asm volatile("s_waitcnt vmcnt(" #n ")" ::: "memory")
#define PG8_WAIT_L(n) asm volatile("s_waitcnt lgkmcnt(" #n ")" ::: "memory")
#define PG8_BAR __builtin_amdgcn_s_barrier()
#define PG8_SCHED __builtin_amdgcn_sched_barrier(0)
    Unit cur, nxt; int ui = 0;
    if (!S.next(0, cur)) return;
    f32x4 acc[2][2][4][2];
#pragma unroll
    for (int a = 0; a < 2; ++a)
#pragma unroll
        for (int b = 0; b < 2; ++b)
#pragma unroll
            for (int m = 0; m < 4; ++m)
#pragma unroll
                for (int n = 0; n < 2; ++n) acc[a][b][m][n] = (f32x4){0.f, 0.f, 0.f, 0.f};
    bf16x8 At[4][2], B0[2][2], B1[2][2];
    const char* cA = S.aptr(cur); const char* cB = S.bptr(cur);
    unsigned g[4] = {0u, 0u, 0u, 0u}; int gR0 = 0; unsigned gCb = 0u;
    if constexpr (Sched::GATHER) { int R, C; stage_rc(tid * 16, R, C); gR0 = R; gCb = (unsigned)C * 2u;
        PG8_GDMA(cur.pm, 0); PG8_WAIT_V(0); PG8_BAR; PG8_GLOAD(0); }
    PG8_STAGE(PG8_SB(0, 0), cB, voffB); PG8_STAGE(PG8_SB(0, 1), cB + hstep, voffB); PG8_STAGEA(PG8_SA(0, 0), cA, 0); PG8_STAGEA(PG8_SA(0, 1), cA, 1);
    if (wr == 1) PG8_BAR;
    PG8_WAIT_V(2); PG8_BAR;
    PG8_STAGE(PG8_SB(1, 0), cB + kstep, voffB); PG8_STAGEA(PG8_SA(1, 0), cA + kstep, 0); PG8_STAGE(PG8_SB(1, 1), cB + hstep + kstep, voffB);
    PG8_WAIT_V(6); PG8_BAR;
    for (;;) {
        const bool has_next = S.next(ui + 1, nxt);
        const char* nA = has_next ? S.aptr(nxt) : cA; const char* nB = has_next ? S.bptr(nxt) : cB;
        if constexpr (Sched::GATHER) { if (has_next) PG8_GDMA(nxt.pm, (ui + 1) & 1); }
        for (int t = 0; t < nt; t += 2) {
            const bool last = (t == nt - 2);
            const char* a1 = cA + (size_t)(t + 1) * kstep;
            const char* a2 = last ? nA : cA + (size_t)(t + 2) * kstep; const char* b2 = last ? nB : cB + (size_t)(t + 2) * kstep;
            const char* a3 = a2 + kstep; const char* b3 = b2 + kstep;
            PG8_LDB(B0, 0, 0); PG8_LDB(B1, 0, 1); PG8_SCHED; PG8_LDA(At, 0, 0); PG8_STAGEA(PG8_SA(1, 1), a1, 1);
            PG8_WAIT_V(8); PG8_WAIT_L(0); PG8_BAR; PG8_MMA(0, 0, At, B0); PG8_MMA(0, 1, At, B1); PG8_BAR; PG8_SCHED;
            if constexpr (Sched::GATHER) { if (last && has_next) PG8_GLOAD((ui + 1) & 1); PG8_SCHED; }
            PG8_LDA(At, 0, 1); PG8_STAGE(PG8_SB(0, 0), b2, voffB); PG8_STAGE(PG8_SB(0, 1), b2 + hstep, voffB); PG8_STAGEA(PG8_SA(0, 0), a2, 0);
            PG8_WAIT_V(8); PG8_WAIT_L(0); PG8_BAR; PG8_MMA(1, 0, At, B0); PG8_MMA(1, 1, At, B1); PG8_BAR; PG8_SCHED;
            PG8_LDB(B0, 1, 0); PG8_LDB(B1, 1, 1); PG8_SCHED; PG8_LDA(At, 1, 0); PG8_STAGEA(PG8_SA(0, 1), a2, 1);
            PG8_WAIT_V(8); PG8_WAIT_L(0); PG8_BAR; PG8_MMA(0, 0, At, B0); PG8_MMA(0, 1, At, B1); PG8_BAR; PG8_SCHED;
            PG8_LDA(At, 1, 1); PG8_STAGE(PG8_SB(1, 0), b3, voffB); PG8_STAGE(PG8_SB(1, 1), b3 + hstep, voffB); PG8_STAGEA(PG8_SA(1, 0), a3, 0);
            PG8_WAIT_V(8); PG8_WAIT_L(0); PG8_BAR; PG8_MMA(1, 0, At, B0); PG8_MMA(1, 1, At, B1); PG8_BAR; PG8_SCHED;
        }
        if (wr == 0) PG8_BAR;
        E(acc, cur, wr, wc, fr, fq);
        if (!has_next) break;
#pragma unroll
        for (int a = 0; a < 2; ++a)
#pragma unroll
            for (int b = 0; b < 2; ++b)
#pragma unroll
                for (int m = 0; m < 4; ++m)
#pragma unroll
                    for (int n = 0; n < 2; ++n) acc[a][b][m][n] = (f32x4){0.f, 0.f, 0.f, 0.f};
        cur = nxt; cA = nA; cB = nB; ++ui;
        if (wr == 1) PG8_BAR;
    }
    PG8_WAIT_V(0);
    PG8_BAR;
#undef PG8_SA
#undef PG8_SB
#undef PG8_STAGE
#undef PG8_STAGEA
#undef PG8_GLOAD
#undef PG8_GDMA
#undef PG8_LDA
#undef PG8_LDB
#undef PG8_MMA
#undef PG8_WAIT_V
#undef PG8_WAIT_L
#undef PG8_BAR
#undef PG8_SCHED
}

struct EpiBf16 {
    static constexpr bool PERM = true;
    bf16* O; int ldc; const float* bias; int bias_stride;
    __device__ __forceinline__ void operator()(const f32x4 (&acc)[2][2][4][2], const Unit& u, int wr, int wc, int fr, int fq) const {
        const int row0 = u.pm * BM + wr * 64 + fr, col0 = u.pn * BM + wc * 32 + 8 * fq;
        f32x4 bv[2][2];
#pragma unroll
        for (int bj = 0; bj < 2; ++bj)
#pragma unroll
            for (int n = 0; n < 2; ++n) bv[bj][n] = bias ? *(const f32x4*)(bias + (size_t)u.e * bias_stride + col0 + bj * HALF + 4 * n) : (f32x4){0.f, 0.f, 0.f, 0.f};
#pragma unroll
        for (int ai = 0; ai < 2; ++ai)
#pragma unroll
            for (int m = 0; m < 4; ++m) { bf16* rowp = O + (size_t)(row0 + ai * HALF + m * 16) * ldc + col0;
#pragma unroll
                for (int bj = 0; bj < 2; ++bj) { const f32x4 v0 = acc[ai][bj][m][0] + bv[bj][0], v1 = acc[ai][bj][m][1] + bv[bj][1];
                    v4u w; w.x = cvt_pk_bf16(v0[0], v0[1]); w.y = cvt_pk_bf16(v0[2], v0[3]); w.z = cvt_pk_bf16(v1[0], v1[1]); w.w = cvt_pk_bf16(v1[2], v1[3]);
                    *(v4u*)(rowp + bj * HALF) = w; } }
    }
};
template <int MODE> struct EpiGlu {
    static constexpr bool PERM = true;
    bf16* O; int ldc; const float* bias; int bias_stride, hs;
    __device__ __forceinline__ void operator()(const f32x4 (&acc)[2][2][4][2], const Unit& u, int wr, int wc, int fr, int fq) const {
        const int row0 = u.pm * BM + wr * 64 + fr, col0 = u.pn * HALF + wc * 32 + 8 * fq;
        const float* bp = bias + (size_t)u.e * bias_stride + col0;
        f32x4 ba[2], bb[2];
#pragma unroll
        for (int n = 0; n < 2; ++n) { ba[n] = *(const f32x4*)(bp + 4 * n); bb[n] = *(const f32x4*)(bp + hs + 4 * n); }
#pragma unroll
        for (int ai = 0; ai < 2; ++ai)
#pragma unroll
            for (int m = 0; m < 4; ++m) { bf16* rowp = O + (size_t)(row0 + ai * HALF + m * 16) * ldc + col0;
                float o[8];
#pragma unroll
                for (int n = 0; n < 2; ++n) { const f32x4 a = acc[ai][0][m][n] + ba[n], b = acc[ai][1][m][n] + bb[n];
#pragma unroll
                    for (int j = 0; j < 4; ++j) {
                        if (MODE == 0) o[4 * n + j] = a[j] * sigm(b[j]);
                        else { const float g = fminf(a[j], 7.f), up = fminf(fmaxf(b[j], -7.f), 7.f); o[4 * n + j] = (up + 1.f) * g * sigm(1.702f * g); } } }
                v4u w; w.x = cvt_pk_bf16(o[0], o[1]); w.y = cvt_pk_bf16(o[2], o[3]); w.z = cvt_pk_bf16(o[4], o[5]); w.w = cvt_pk_bf16(o[6], o[7]);
                *(v4u*)rowp = w; }
    }
};
struct EpiMerge {
    static constexpr bool PERM = true;
    float* mtmp; bf16* Mo; const bf16* zg;
    __device__ __forceinline__ void operator()(const f32x4 (&acc)[2][2][4][2], const Unit& u, int wr, int wc, int fr, int fq) const {
        const int row0 = u.pm * BM + wr * 64 + fr, col0 = u.pn * BM + wc * 32 + 8 * fq;
#pragma unroll
        for (int ai = 0; ai < 2; ++ai)
#pragma unroll
            for (int m = 0; m < 4; ++m) { const size_t r = (size_t)(row0 + ai * HALF + m * 16);
#pragma unroll
                for (int bj = 0; bj < 2; ++bj) { const int c = col0 + bj * HALF;
                    const v4u gz = *(const v4u*)(zg + r * IN_COLS + u.e * 1024 + c);
                    float g[8] = {bflo(gz.x), bfhi(gz.x), bflo(gz.y), bfhi(gz.y), bflo(gz.z), bfhi(gz.z), bflo(gz.w), bfhi(gz.w)};
                    f32x4 t0, t1; float* tp = mtmp + r * 1024 + c;
                    if (u.e == 0) { t0 = (f32x4){0.f, 0.f, 0.f, 0.f}; t1 = t0; } else { t0 = *(const f32x4*)tp; t1 = *(const f32x4*)(tp + 4); }
#pragma unroll
                    for (int j = 0; j < 4; ++j) { t0[j] += sigm(g[j]) * acc[ai][bj][m][0][j]; t1[j] += sigm(g[4 + j]) * acc[ai][bj][m][1][j]; }
                    if (u.e < 2) { *(f32x4*)tp = t0; *(f32x4*)(tp + 4) = t1; }
                    else { v4u w; w.x = cvt_pk_bf16(t0[0], t0[1]); w.y = cvt_pk_bf16(t0[2], t0[3]); w.z = cvt_pk_bf16(t1[0], t1[1]); w.w = cvt_pk_bf16(t1[2], t1[3]);
                        *(v4u*)(Mo + r * 1024 + c) = w; } } }
    }
};
struct EpiResid {
    static constexpr bool PERM = false;
    float* X; const float* gmod;
    __device__ __forceinline__ void operator()(const f32x4 (&acc)[2][2][4][2], const Unit& u, int wr, int wc, int fr, int fq) const {
        const int row0 = u.pm * BM + wr * 64 + fr, col0 = u.pn * BM + wc * 32 + 4 * fq;
        const int r00 = u.pm * BM; const int w = r00 < T_LAT ? (r00 >> 12) : 8;
        f32x4 gv[2][2];
#pragma unroll
        for (int bj = 0; bj < 2; ++bj)
#pragma unroll
            for (int n = 0; n < 2; ++n) gv[bj][n] = *(const f32x4*)(gmod + (size_t)w * 6144 + col0 + bj * HALF + n * 16);
#pragma unroll
        for (int ai = 0; ai < 2; ++ai)
#pragma unroll
            for (int m = 0; m < 4; ++m) { float* rowp = X + (size_t)(row0 + ai * HALF + m * 16) * 1024 + col0;
#pragma unroll
                for (int bj = 0; bj < 2; ++bj)
#pragma unroll
                    for (int n = 0; n < 2; ++n) { f32x4* p = (f32x4*)(rowp + bj * HALF + n * 16); *p = *p + gv[bj][n] * acc[ai][bj][m][n]; } }
    }
};
}

struct Args { const float* in[51]; float* out; unsigned char* ws; int ph_lo, ph_hi; };
enum { I_X = 0, I_C, I_CTX, I_CCTX, I_ADAW, I_ADAB, I_N1G, I_N2G, I_WIN, I_HYCW, I_HYCB, I_HYW1, I_HYB1, I_HYF1, I_HYW2, I_HYB2, I_HYF2, I_HYW3, I_HYB3, I_HYBIAS,
       I_RWCW, I_RWCB, I_RWWUP, I_RWW0, I_RWAUP, I_RWA0, I_RWGUP, I_RWKK, I_RWKA, I_RWRK, I_RWLNG, I_RWLNB, I_S5ARE, I_S5AIM, I_S5LDT, I_S5BRE, I_S5BIM, I_S5CRE, I_S5CIM, I_S5D,
       I_S5GLUW, I_S5GLUB, I_WBR, I_WOUT, I_RTW, I_RTB, I_W1, I_B1, I_W2, I_B2, I_FING };

typedef const __attribute__((address_space(4))) Args* CArgsP;
__device__ __forceinline__ CArgsP kargs() { CArgsP p = (CArgsP)__builtin_amdgcn_kernarg_segment_ptr(); asm volatile("" : "+s"(p)); return p; }
__device__ __forceinline__ int opaque(int v) { asm volatile("" : "+s"(v)); return v; }
__device__ __forceinline__ int opaque_v(int v) { asm volatile("" : "+v"(v)); return v; }
struct Ctx { CArgsP a; LAS unsigned char* lds; int tid, lane, wave, bid, G; };

__device__ __forceinline__ void row_seq(int row, int& base, int& pos, int& n) {
    if (row < T_LAT) { base = row & ~(SEQ - 1); pos = row & (SEQ - 1); n = SEQ; }
    else { const int r = row - T_LAT; base = T_LAT + (r & ~(CTXL - 1)); pos = r & (CTXL - 1); n = CTXL; }
}
__device__ __forceinline__ float conv3z(const bf16* zc, int pos, int n, float w0, float w1, float w2, float b) {
    const float zm = pos > 0 ? bf2f(zc[(size_t)(pos - 1) * IN_COLS]) : 0.f, z0 = bf2f(zc[(size_t)pos * IN_COLS]), zp = pos < n - 1 ? bf2f(zc[(size_t)(pos + 1) * IN_COLS]) : 0.f;
    return zm * w0 + z0 * w1 + zp * w2 + b;
}

template <int MODE>
__device__ __forceinline__ void transpose_item(const float* W, int K, int N, bf16* WT, int Hs, LAS float* scr, int item, int lane) {
    const int nblk = N / 32, kb = item / nblk, nb = item % nblk, k0 = 64 * kb, n0 = 32 * nb;
#pragma unroll 8
    for (int i = 0; i < 32; ++i) { const int kk = 2 * i + (lane >> 5); scr[kk * 33 + (lane & 31)] = W[(size_t)(k0 + kk) * N + n0 + (lane & 31)]; }
    LDS_WAIT(); asm volatile("" ::: "memory");
    const int c = lane & 7;
#pragma unroll
    for (int j = 0; j < 4; ++j) { const int n = (lane >> 3) + 8 * j; const LAS float* s = scr + (8 * c) * 33 + n;
        v4u o; o.x = pk2(s[0 * 33], s[1 * 33]); o.y = pk2(s[2 * 33], s[3 * 33]); o.z = pk2(s[4 * 33], s[5 * 33]); o.w = pk2(s[6 * 33], s[7 * 33]);
        int dr = n0 + n;
        if (MODE == 1) { const int nc = n0 + n; const int jx = nc < Hs ? nc : nc - Hs; dr = (jx >> 7) * 256 + (nc < Hs ? 0 : 128) + (jx & 127); }
        *(v4u*)(WT + (size_t)dr * K + k0 + 8 * c) = o; }
    LDS_WAIT(); asm volatile("" ::: "memory");
}

__device__ __forceinline__ void p0_prologue(const Ctx& F) {
    const auto& a = *F.a; unsigned char* ws = a.ws;
    const int gw = F.bid * NWAVES + F.wave, NGW = F.G * NWAVES, lane = F.lane;
    float* X = (float*)(ws + WS_X);
    for (int t = gw; t < SEQ; t += NGW) {
        const float pr = (float)(t >> 6), pc = (float)(t & 63);
        f32x4 pe[4];
#pragma unroll
        for (int j = 0; j < 4; ++j)
#pragma unroll
            for (int e = 0; e < 4; ++e) { const float om = 1.0f / powf(10000.0f, (float)(4 * lane + e) / 256.0f); const float ang = ((j < 2) ? pr : pc) * om; pe[j][e] = (j & 1) ? cosf(ang) : sinf(ang); }
#pragma unroll 2
        for (int bb = 0; bb < BATCH; ++bb) { const size_t row = (size_t)bb * SEQ + t;
            const f32x4* xi = (const f32x4*)(a.in[I_X] + row * D) + lane; f32x4* xo = (f32x4*)(X + row * D) + lane;
#pragma unroll
            for (int j = 0; j < 4; ++j) xo[64 * j] = xi[64 * j] + pe[j]; }
    }
    for (int row = T_LAT + gw; row < T_ALL; row += NGW) {
        const f32x4* xi = (const f32x4*)(a.in[I_CTX] + (size_t)(row - T_LAT) * D) + lane; f32x4* xo = (f32x4*)(X + (size_t)row * D) + lane;
#pragma unroll
        for (int j = 0; j < 4; ++j) xo[64 * j] = xi[64 * j];
    }
    {
        LAS float* condl = (LAS float*)F.lds; LAS float* psum = (LAS float*)(F.lds + 40960);
        for (int i = F.tid; i < 9 * 1024; i += NTHREADS) { const int w = i >> 10, k = i & 1023; const float cv = (w < 8) ? a.in[I_C][w * 1024 + k] : a.in[I_CCTX][k]; condl[i] = cv / (1.f + expf(-cv)); }
        __syncthreads();
        float* MOD = (float*)(ws + WS_MOD);
        for (int it = F.bid; it < 2 * 96; it += F.G) {
            const int l = it / 96, cg = it % 96, col = cg * 64 + lane;
            float acc[9];
#pragma unroll
            for (int w = 0; w < 9; ++w) acc[w] = 0.f;
            const float* wp = a.in[I_ADAW] + ((size_t)l * 1024 + F.wave * 128) * 6144 + col;
#pragma unroll 1
            for (int k0 = 0; k0 < 128; k0 += 16) { float wv[16];
#pragma unroll
                for (int k = 0; k < 16; ++k) wv[k] = wp[(size_t)(k0 + k) * 6144];
#pragma unroll
                for (int k = 0; k < 16; ++k)
#pragma unroll
                    for (int w = 0; w < 9; ++w) acc[w] += condl[w * 1024 + F.wave * 128 + k0 + k] * wv[k]; }
#pragma unroll
            for (int w = 0; w < 9; ++w) psum[(F.wave * 9 + w) * 64 + lane] = acc[w];
            __syncthreads();
            if (F.wave == 0) {
#pragma unroll
                for (int w = 0; w < 9; ++w) { float s = 0.f;
#pragma unroll
                    for (int wv = 0; wv < 8; ++wv) s += psum[(wv * 9 + w) * 64 + lane];
                    MOD[(size_t)(l * 9 + w) * 6144 + col] = s + a.in[I_ADAB][l * 6144 + col]; }
            }
            __syncthreads();
        }
    }
    {
        LAS float* scr = (LAS float*)(F.lds + F.wave * 16384);
        constexpr int IT_W1 = 16 * 64, IT_W2 = 16 * 32, IT_WIN = 16 * 216, IT_GLU = 8 * 32, IT_WBR = 8 * 32, IT_WOUT = 16 * 32;
        constexpr int N_W1 = 64 * IT_W1, N_W2 = 64 * IT_W2, N_WIN = 2 * IT_WIN, N_GLU = 2 * IT_GLU, N_WBR = 6 * IT_WBR, N_WOUT = 2 * IT_WOUT;
        constexpr int NITEMS = N_W1 + N_W2 + N_WIN + N_GLU + N_WBR + N_WOUT;
        for (int it = gw; it < NITEMS; it += NGW) {
            int r = it;
            if (r < N_W1) { const int mtx = r / IT_W1, l = mtx >> 5, e = mtx & 31; transpose_item<1>(a.in[I_W1] + (size_t)mtx * 1024 * 2048, 1024, 2048, (bf16*)(ws + WS_WTS + l * WL_STRIDE + WO_W1) + (size_t)e * 2048 * 1024, 1024, scr, r % IT_W1, lane); continue; } r -= N_W1;
            if (r < N_W2) { const int mtx = r / IT_W2, l = mtx >> 5, e = mtx & 31; transpose_item<0>(a.in[I_W2] + (size_t)mtx * 1024 * 1024, 1024, 1024, (bf16*)(ws + WS_WTS + l * WL_STRIDE + WO_W2) + (size_t)e * 1024 * 1024, 0, scr, r % IT_W2, lane); continue; } r -= N_W2;
            if (r < N_WIN) { const int l = r / IT_WIN; transpose_item<0>(a.in[I_WIN] + (size_t)l * 1024 * IN_COLS, 1024, IN_COLS, (bf16*)(ws + WS_WTS + l * WL_STRIDE + WO_WIN), 0, scr, r % IT_WIN, lane); continue; } r -= N_WIN;
            if (r < N_GLU) { const int l = r / IT_GLU; transpose_item<1>(a.in[I_S5GLUW] + (size_t)l * 512 * 1024, 512, 1024, (bf16*)(ws + WS_WTS + l * WL_STRIDE + WO_GLU), 512, scr, r % IT_GLU, lane); continue; } r -= N_GLU;
            if (r < N_WBR) { const int mtx = r / IT_WBR, l = mtx / 3, br = mtx % 3; transpose_item<0>(a.in[I_WBR] + (size_t)mtx * 512 * 1024, 512, 1024, (bf16*)(ws + WS_WTS + l * WL_STRIDE + WO_WBR) + (size_t)br * 1024 * 512, 0, scr, r % IT_WBR, lane); continue; } r -= N_WBR;
            { const int l = r / IT_WOUT; transpose_item<0>(a.in[I_WOUT] + (size_t)l * 1024 * 1024, 1024, 1024, (bf16*)(ws + WS_WTS + l * WL_STRIDE + WO_WOUT), 0, scr, r % IT_WOUT, lane); }
        }
        for (int i = F.bid * NTHREADS + F.tid; i < 2 * 2560 * 256; i += F.G * NTHREADS) {
            const int l = i / (2560 * 256), r = i % (2560 * 256), n = r >> 8, k = r & 255; float v = 0.f;
            if (n < 1024) { if (k < 64) v = a.in[I_RWWUP][(((size_t)l * 2 + (n >> 9)) * 64 + k) * 512 + (n & 511)]; }
            else if (n < 2048) { if (k >= 64 && k < 128) v = a.in[I_RWAUP][(((size_t)l * 2 + ((n - 1024) >> 9)) * 64 + (k - 64)) * 512 + (n & 511)]; }
            else { if (k >= 128) v = a.in[I_RWGUP][((size_t)l * 128 + (k - 128)) * 512 + (n - 2048)]; }
            ((bf16*)(ws + WS_WTS + l * WL_STRIDE + WO_RWCAT))[r] = (bf16)f2bf(v);
        }
    }
    __syncthreads();
    {
        LAS float* feats = (LAS float*)F.lds; LAS float* h1 = feats + 8 * 33; LAS float* h2 = h1 + 8 * 64;
        constexpr int NIT = 2 * (512 + 32);
        for (int it = F.bid; it < NIT; it += F.G) {
            const int l = it / 544, r = it % 544, nsel = r >= 512, n = nsel ? CTXL : SEQ, p0 = (nsel ? r - 512 : r) * 8;
            if (F.tid < 8 * 33) { const int p = F.tid / 33, i = F.tid % 33, pos = p0 + p; float f;
                if (i == 0) f = (float)pos / (float)(n - 1);
                else { const int k = (i - 1) & 15; const float band = 1e-4f + (float)k * ((15.0f - 1e-4f) / 15.0f); const float ang = (6.283185307179586f * (float)pos / (float)n) * band; f = (i <= 16) ? cosf(ang) : -sinf(ang); }
                feats[p * 33 + i] = f; }
            __syncthreads();
            { const int p = F.tid >> 6, j = F.tid & 63; float s = a.in[I_HYB1][l * 64 + j]; const float* w1p = a.in[I_HYW1] + (size_t)l * 33 * 64 + j;
#pragma unroll
                for (int i = 0; i < 33; ++i) s += feats[p * 33 + i] * w1p[i * 64];
                h1[p * 64 + j] = sinf(a.in[I_HYF1][l * 64 + j] * s); }
            __syncthreads();
            { const int p = F.tid >> 6, j = F.tid & 63; float s = a.in[I_HYB2][l * 64 + j];
                const float* w2p = a.in[I_HYW2] + (size_t)l * 64 * 64 + j;
#pragma unroll 16
                for (int i = 0; i < 64; ++i) s += h1[p * 64 + i] * w2p[i * 64];
                h2[p * 64 + j] = sinf(a.in[I_HYF2][l * 64 + j] * s); }
            __syncthreads();
            float acc[4][8];
#pragma unroll
            for (int q = 0; q < 4; ++q)
#pragma unroll
                for (int p = 0; p < 8; ++p) acc[q][p] = 0.f;
            const float* w3 = a.in[I_HYW3] + (size_t)l * 64 * 2048 + F.tid;
#pragma unroll 8
            for (int i = 0; i < 64; ++i) { float wv[4];
#pragma unroll
                for (int q = 0; q < 4; ++q) wv[q] = w3[(size_t)i * 2048 + q * 512];
#pragma unroll
                for (int p = 0; p < 8; ++p) { const float hv = h2[p * 64 + i];
#pragma unroll
                    for (int q = 0; q < 4; ++q) acc[q][p] += hv * wv[q]; } }
            const int c = F.tid; const float dstart = logf(0.01f) / 1.5f, dstop = logf(0.01f) / 0.3f; const float delta = fabsf(dstart + (float)c * ((dstop - dstart) / 511.0f));
            const int RL = nsel ? HY_RLENC : HY_RLEN, off = n + 47;
            bf16* Rb = (bf16*)(ws + WS_GF + l * GF_STRIDE + (nsel ? GF_CTX : 0));
#pragma unroll
            for (int q = 0; q < 4; ++q) { const int o = q >> 1, side = q & 1; const float b3 = a.in[I_HYB3][l * 2048 + q * 512 + c];
                bf16* Rc = Rb + ((size_t)o * 512 + c) * RL;
#pragma unroll
                for (int p = 0; p < 8; ++p) { const int pos = p0 + p; const float t = (float)pos / (float)(n - 1); const float val = (acc[q][p] + b3) * expf(-t * delta);
                    if (side == 0) Rc[off - pos] = (bf16)f2bf(val);
                    else if (pos >= 1) Rc[off + pos] = (bf16)f2bf(val); }
                if (p0 == 0 && side == 0) { for (int m = 0; m < 48; ++m) Rc[m] = 0; for (int m = off + n; m < RL; ++m) Rc[m] = 0; } }
            __syncthreads();
        }
    }
}

__device__ __forceinline__ void stage_norm1(const Ctx& F, int l) {
    const auto& a = *F.a; unsigned char* ws = a.ws; const int lane = F.lane;
    const int gw = F.bid * NWAVES + F.wave, NGW = F.G * NWAVES;
    float* X = (float*)(ws + WS_X); bf16* H = (bf16*)(ws + WS_H); const float* MOD = (const float*)(ws + WS_MOD);
    const bf16* YS = (const bf16*)(ws + WS_XS); const int* POS = (const int*)(ws + WS_POS); const float* GATE = (const float*)(ws + WS_GATE);
    const int nrows = (l == DEPTH) ? T_LAT : T_ALL;
    for (int row = gw; row < nrows; row += NGW) {
        const int w = row < T_LAT ? (row >> 12) : 8;
        f32x4* xr = (f32x4*)(X + (size_t)row * D) + lane;
        f32x4 v[4];
#pragma unroll
        for (int j = 0; j < 4; ++j) v[j] = xr[64 * j];
        if (l > 0) {
            f32x4 mo[4];
#pragma unroll
            for (int j = 0; j < 4; ++j) mo[j] = (f32x4){0.f, 0.f, 0.f, 0.f};
#pragma unroll
            for (int k = 0; k < TOPK; ++k) { const int p = POS[row * 4 + k]; const float g = GATE[row * 4 + k];
                const v2u* yr = (const v2u*)(YS + (size_t)p * D) + lane;
#pragma unroll
                for (int j = 0; j < 4; ++j) { const v2u y = yr[64 * j]; mo[j][0] += g * bflo(y.x); mo[j][1] += g * bfhi(y.x); mo[j][2] += g * bflo(y.y); mo[j][3] += g * bfhi(y.y); } }
            const f32x4* g2 = (const f32x4*)(MOD + (size_t)((l - 1) * 9 + w) * 6144 + 5120) + lane;
#pragma unroll
            for (int j = 0; j < 4; ++j) { v[j] = v[j] + g2[64 * j] * mo[j]; xr[64 * j] = v[j]; }
        }
        float ss = 0.f;
#pragma unroll
        for (int j = 0; j < 4; ++j) ss += (v[j][0] * v[j][0] + v[j][1] * v[j][1]) + (v[j][2] * v[j][2] + v[j][3] * v[j][3]);
        const float rstd = 1.0f / sqrtf(wave_sum(ss) * (1.f / D) + 1e-6f);
        if (l == DEPTH) {
            const f32x4* fg = (const f32x4*)a.in[I_FING] + lane; f32x4* o = (f32x4*)(a.out + (size_t)row * D) + lane;
#pragma unroll
            for (int j = 0; j < 4; ++j) o[64 * j] = v[j] * rstd * fg[64 * j];
        } else {
            const f32x4* ng = (const f32x4*)(a.in[I_N1G] + l * D) + lane;
            const f32x4* sh = (const f32x4*)(MOD + (size_t)(l * 9 + w) * 6144) + lane; const f32x4* sc = (const f32x4*)(MOD + (size_t)(l * 9 + w) * 6144 + 1024) + lane;
            v2u* ho = (v2u*)(H + (size_t)row * D) + lane;
#pragma unroll
            for (int j = 0; j < 4; ++j) { const f32x4 h = v[j] * rstd * ng[64 * j] * (sc[64 * j] + 1.0f) + sh[64 * j]; v2u o; o.x = pk2(h[0], h[1]); o.y = pk2(h[2], h[3]); ho[64 * j] = o; }
        }
    }
}

__device__ __forceinline__ void stage_rw_prep1(const Ctx& F, int l) {
    const auto& a = *F.a; unsigned char* ws = a.ws;
    const bf16* Z = (const bf16*)(ws + WS_Z); bf16* ARW = (bf16*)(ws + WS_ARW);
    const int j = F.tid & 255, col = 1536 + j;
    const float* cw = a.in[I_RWCW] + (size_t)l * 3 * 1792; const float w0 = cw[col], w1 = cw[1792 + col], w2 = cw[2 * 1792 + col], cb = a.in[I_RWCB][l * 1792 + col];
    for (int row = F.bid * 2 + (F.tid >> 8); row < T_ALL; row += F.G * 2) {
        int base, pos, n; row_seq(row, base, pos, n);
        float v = conv3z(Z + (size_t)base * IN_COLS + RW_OFF + col, pos, n, w0, w1, w2, cb);
        if (j < 64) v = tanhf(v); else if (j >= 128) v = sigm(v);
        ARW[(size_t)row * 256 + j] = (bf16)f2bf(v);
    }
}

__device__ __forceinline__ void stage_rw_prep2(const Ctx& F, int l) {
    const auto& a = *F.a; unsigned char* ws = a.ws; const int lane = F.lane;
    const bf16* Z = (const bf16*)(ws + WS_Z); const bf16* P = (const bf16*)(ws + WS_P); bf16* SCN = (bf16*)(ws + WS_SCN);
    const int gw = F.bid * NWAVES + F.wave, NGW = F.G * NWAVES;
    constexpr int TR = 17, NRT = T_ALL / TR;
    const float* cw = a.in[I_RWCW] + (size_t)l * 3 * 1792; const float* cbp = a.in[I_RWCB] + l * 1792;
    for (int tile = gw; tile < NRT * 4; tile += NGW) {
        const int rt = tile % NRT, hp = tile / NRT, row0 = rt * TR, c0 = hp * 128 + 2 * lane;
        f32x2 w[3][3], cb[3];
#pragma unroll
        for (int s = 0; s < 3; ++s) { cb[s] = *(const f32x2*)(cbp + s * 512 + c0);
#pragma unroll
            for (int j = 0; j < 3; ++j) w[s][j] = *(const f32x2*)(cw + j * 1792 + s * 512 + c0); }
        const f32x2 KKw = *(const f32x2*)(a.in[I_RWKK] + l * 512 + c0), KAw = *(const f32x2*)(a.in[I_RWKA] + l * 512 + c0);
        f32x2 W0[2], A0[2];
#pragma unroll
        for (int d = 0; d < 2; ++d) { W0[d] = *(const f32x2*)(a.in[I_RWW0] + (l * 2 + d) * 512 + c0); A0[d] = *(const f32x2*)(a.in[I_RWA0] + (l * 2 + d) * 512 + c0); }
        const unsigned* zb = (const unsigned*)(Z + RW_OFF + c0);
        unsigned zm[3], z0[3], zp[3];
#pragma unroll
        for (int s = 0; s < 3; ++s) { zm[s] = row0 > 0 ? zb[(size_t)(row0 - 1) * (IN_COLS / 2) + s * 256] : 0u; z0[s] = zb[(size_t)row0 * (IN_COLS / 2) + s * 256]; }
#pragma unroll 1
        for (int i = 0; i < TR; ++i) {
            const int row = row0 + i; int base, pos, n; row_seq(row, base, pos, n);
#pragma unroll
            for (int s = 0; s < 3; ++s) zp[s] = (row + 1 < T_ALL) ? zb[(size_t)(row + 1) * (IN_COLS / 2) + s * 256] : 0u;
            const float mlo = pos > 0 ? 1.f : 0.f, mhi = pos < n - 1 ? 1.f : 0.f;
            f32x2 u[3];
#pragma unroll
            for (int s = 0; s < 3; ++s) { u[s] = (f32x2){bflo(zm[s]), bfhi(zm[s])} * mlo * w[s][0] + (f32x2){bflo(z0[s]), bfhi(z0[s])} * w[s][1] + (f32x2){bflo(zp[s]), bfhi(zp[s])} * mhi * w[s][2] + cb[s]; zm[s] = z0[s]; z0[s] = zp[s]; }
            const f32x2 r = u[0], k = u[1], v = u[2];
            f32x2 kk = k * KKw;
            const float ss = red32(kk[0] * kk[0] + kk[1] * kk[1]);
            kk = kk * (1.0f / sqrtf(fmaxf(ss, 1e-24f)));
            const unsigned* pr = (const unsigned*)(P + (size_t)row * 2560 + c0);
            unsigned* o = (unsigned*)(SCN + (size_t)row * 9 * 512 + c0);
            o[0] = pk2(r[0], r[1]); o[256] = pk2(v[0], v[1]); o[2 * 256] = pk2(kk[0], kk[1]);
#pragma unroll
            for (int d = 0; d < 2; ++d) {
                const unsigned pw = pr[d * 256], pa = pr[512 + d * 256];
                float ld[2], kd[2], be[2];
#pragma unroll
                for (int e = 0; e < 2; ++e) {
                    const float uu = W0[d][e] + (e ? bfhi(pw) : bflo(pw));
                    ld[e] = -0.60653065971263342f * sigm(uu);
                    const float av = sigm(A0[d][e] + (e ? bfhi(pa) : bflo(pa)));
                    kd[e] = k[e] * (1.f + (av - 1.f) * KAw[e]); be[e] = kk[e] * av; }
                o[(3 + 3 * d) * 256] = pk2(ld[0], ld[1]); o[(4 + 3 * d) * 256] = pk2(kd[0], kd[1]); o[(5 + 3 * d) * 256] = pk2(be[0], be[1]);
            }
        }
    }
}

__device__ __forceinline__ int seq_row(int b, int d, int sidx) {
    if (sidx < CTXL) { const int t = d ? (CTXL - 1 - sidx) : sidx; return T_LAT + b * CTXL + t; }
    const int tl = sidx - CTXL; const int t = d ? (SEQ - 1 - tl) : tl; return b * SEQ + t;
}

constexpr int CW_WORK = 16384;
constexpr int CW_STAMP = 20480;
#ifdef PROBE_T
#ifndef PROBE_BID
#define PROBE_BID 0
#endif
#define PT(k) do { if (F.bid == PROBE_BID && F.tid == 0 && l == 0) ((unsigned long long*)(F.a->ws + WS_CTL + CW_STAMP * 4))[k] = __builtin_amdgcn_s_memrealtime(); } while (0)
#else
#define PT(k) do { } while (0)
#endif
__device__ __forceinline__ void rw_scan_item(const Ctx& F, int l, int it2) {
    const int it = it2 >> 1, half = it2 & 1;
    const auto& a = *F.a; unsigned char* ws = a.ws; const int tid = F.tid, lane = F.lane;
    const bf16* SCN = (const bf16*)(ws + WS_SCN); float* YD = (float*)(ws + WS_YDIR);
    LAS float* sbuf = (LAS float*)F.lds;
    LAS float* ybuf = (LAS float*)(F.lds + 49152);
    const bool comp = F.wave < 4;
    const int lt = tid & 255, ls = lt >> 4, lj = lt & 15;
    const int vl = lane >> 3, kq = lane & 7, vrow = half * 32 + (F.wave & 3) * 8 + vl;
    constexpr int NCH = (CTXL + SEQ) / 16;
    const int d = it & 1, h = (it >> 1) & 7, b = it >> 4;
    f32x2 S[4];
#pragma unroll
    for (int q = 0; q < 4; ++q) S[q] = (f32x2){0.f, 0.f};
    v2u ldr[6];
#define RW_ISSUE(c) do { const int row_ = seq_row(b, d, (c) * 16 + ls); const v2u* p_ = (const v2u*)(SCN + (size_t)row_ * 9 * 512 + h * 64) + lj; \
        ldr[0] = p_[2 * 128]; ldr[1] = p_[(3 + 3 * d) * 128]; ldr[2] = p_[(5 + 3 * d) * 128]; ldr[3] = p_[(4 + 3 * d) * 128]; ldr[4] = p_[0]; ldr[5] = p_[128]; } while (0)
#define RW_WRITE(bufi) do { LAS float* o_ = sbuf + (((bufi) * 16 + ls) * 6) * 64 + 4 * lj; \
        *(LAS f32x4*)(o_) = (f32x4){-bflo(ldr[0].x), -bfhi(ldr[0].x), -bflo(ldr[0].y), -bfhi(ldr[0].y)}; \
        *(LAS f32x4*)(o_ + 64) = (f32x4){__expf(bflo(ldr[1].x)), __expf(bfhi(ldr[1].x)), __expf(bflo(ldr[1].y)), __expf(bfhi(ldr[1].y))}; \
        *(LAS f32x4*)(o_ + 128) = (f32x4){bflo(ldr[2].x), bfhi(ldr[2].x), bflo(ldr[2].y), bfhi(ldr[2].y)}; *(LAS f32x4*)(o_ + 192) = (f32x4){bflo(ldr[3].x), bfhi(ldr[3].x), bflo(ldr[3].y), bfhi(ldr[3].y)}; \
        *(LAS f32x4*)(o_ + 256) = (f32x4){bflo(ldr[4].x), bfhi(ldr[4].x), bflo(ldr[4].y), bfhi(ldr[4].y)}; *(LAS f32x4*)(o_ + 320) = (f32x4){bflo(ldr[5].x), bfhi(ldr[5].x), bflo(ldr[5].y), bfhi(ldr[5].y)}; } while (0)
#define RW_FLUSH(c) do { const int row_ = seq_row(b, d, (c) * 16 + ls); \
        *(f32x2*)(YD + ((size_t)d * T_ALL + row_) * 512 + h * 64 + half * 32 + 2 * lj) = *(const LAS f32x2*)(ybuf + ((((c) & 1) * 16 + ls) * 64) + half * 32 + 2 * lj); } while (0)
    if (!comp) { RW_ISSUE(0); RW_WRITE(0); RW_ISSUE(1); }
    __syncthreads();
#pragma unroll 1
    for (int c = 0; c < NCH; ++c) {
        const int bi = c & 1;
        if (!comp) {
            if (c + 1 < NCH) RW_WRITE(bi ^ 1);
            if (c + 2 < NCH) RW_ISSUE(c + 2);
            if (c > 0) RW_FLUSH(c - 1);
        } else {
        float yv[16];
        f32x4 opA[10], opB[10]; float vvA, vvB;
#define RW_LD(op, vvx, s_) do { const LAS float* sp_ = sbuf + ((bi * 16 + (s_)) * 6) * 64 + 8 * kq; \
            _Pragma("unroll") for (int q_ = 0; q_ < 5; ++q_) { op[2 * q_] = *(const LAS f32x4*)(sp_ + 64 * q_); op[2 * q_ + 1] = *(const LAS f32x4*)(sp_ + 64 * q_ + 4); } \
            vvx = sbuf[((bi * 16 + (s_)) * 6 + 5) * 64 + vrow]; } while (0)
#define RW_COMP(op, vvx, s_) do { \
            const f32x4 a0 = op[0], a1 = op[1], w0 = op[2], w1 = op[3], b0 = op[4], b1 = op[5], k0 = op[6], k1 = op[7], r0 = op[8], r1 = op[9]; \
            const f32x2 vv2 = (f32x2){vvx, vvx}; \
            const f32x2 p0 = S[1] * (f32x2){a0[2], a0[3]} + S[0] * (f32x2){a0[0], a0[1]}; \
            const f32x2 p1 = S[3] * (f32x2){a1[2], a1[3]} + S[2] * (f32x2){a1[0], a1[1]}; \
            const f32x2 t0 = S[0] * (f32x2){w0[0], w0[1]} + vv2 * (f32x2){k0[0], k0[1]}; \
            const f32x2 t1 = S[1] * (f32x2){w0[2], w0[3]} + vv2 * (f32x2){k0[2], k0[3]}; \
            const f32x2 t2 = S[2] * (f32x2){w1[0], w1[1]} + vv2 * (f32x2){k1[0], k1[1]}; \
            const f32x2 t3 = S[3] * (f32x2){w1[2], w1[3]} + vv2 * (f32x2){k1[2], k1[3]}; \
            const f32x2 ac = p0 + p1; \
            const float sa = red8(ac[0] + ac[1]); \
            const f32x2 sa2 = (f32x2){sa, sa}; \
            S[0] = sa2 * (f32x2){b0[0], b0[1]} + t0; S[1] = sa2 * (f32x2){b0[2], b0[3]} + t1; \
            S[2] = sa2 * (f32x2){b1[0], b1[1]} + t2; S[3] = sa2 * (f32x2){b1[2], b1[3]} + t3; \
            const f32x2 q0 = S[1] * (f32x2){r0[2], r0[3]} + S[0] * (f32x2){r0[0], r0[1]}; \
            const f32x2 q1 = S[3] * (f32x2){r1[2], r1[3]} + S[2] * (f32x2){r1[0], r1[1]}; \
            const f32x2 yc = q0 + q1; \
            yv[s_] = red8(yc[0] + yc[1]); } while (0)
        RW_LD(opA, vvA, 0);
#pragma unroll
        for (int s = 0; s < 16; s += 2) {
            RW_LD(opB, vvB, s + 1);
            __builtin_amdgcn_sched_barrier(0);
            RW_COMP(opA, vvA, s);
            __builtin_amdgcn_sched_barrier(0);
            if (s + 2 < 16) RW_LD(opA, vvA, s + 2);
            __builtin_amdgcn_sched_barrier(0);
            RW_COMP(opB, vvB, s + 1);
            __builtin_amdgcn_sched_barrier(0);
        }
#undef RW_LD
#undef RW_COMP
#pragma unroll
        for (int s = 0; s < 16; ++s) if ((s & 7) == kq) ybuf[((bi * 16 + s) * 64) + vrow] = yv[s];
        }
        __syncthreads();
    }
    if (!comp) RW_FLUSH(NCH - 1);
    __syncthreads();
#undef RW_ISSUE
#undef RW_WRITE
#undef RW_FLUSH
}

constexpr size_t WS_RWSCR = WS_YHY;
constexpr int RWS_QY = 0, RWS_YV = 2048, RWS_PZ = 4096, RWS_ZV = 12288, RWS_SLOT = 20480;
typedef __bf16 bf16x8n __attribute__((ext_vector_type(8)));
__device__ __forceinline__ f32x4 mma16(const bf16x8 a, const bf16x8 b, const f32x4 c) { return __builtin_amdgcn_mfma_f32_16x16x32_bf16(a, b, c, 0, 0, 0); }
__device__ __forceinline__ float dpp_shr(float x, const int n) {
    const int v = __builtin_bit_cast(int, x); int r;
    if (n == 1) r = __builtin_amdgcn_update_dpp(0, v, 0x111, 0xF, 0xF, true); else if (n == 2) r = __builtin_amdgcn_update_dpp(0, v, 0x112, 0xF, 0xF, true);
    else if (n == 4) r = __builtin_amdgcn_update_dpp(0, v, 0x114, 0xF, 0xF, true); else r = __builtin_amdgcn_update_dpp(0, v, 0x118, 0xF, 0xF, true);
    return __builtin_bit_cast(float, r);
}
__device__ __forceinline__ v4u pack8(const float (&x)[8]) { v4u o; o.x = pk2(x[0], x[1]); o.y = pk2(x[2], x[3]); o.z = pk2(x[4], x[5]); o.w = pk2(x[6], x[7]); return o; }
__device__ __forceinline__ void unpack8(const v4u u, float (&x)[8]) { x[0] = bflo(u.x); x[1] = bfhi(u.x); x[2] = bflo(u.y); x[3] = bfhi(u.y); x[4] = bflo(u.z); x[5] = bfhi(u.z); x[6] = bflo(u.w); x[7] = bfhi(u.w); }
__device__ __forceinline__ bf16x8 frag16(const LAS bf16* m, int rowbase, int lane) {
    v4u v = (v4u){0u, 0u, 0u, 0u}; if ((lane >> 4) < 2) v = *(const LAS v4u*)(m + (rowbase + (lane & 15)) * 16 + 8 * (lane >> 4)); return __builtin_bit_cast(bf16x8, v); }
__device__ __forceinline__ void st_colmaj(LAS bf16* m, int colbase, const f32x4 d, int lane) {
    v2u o; o.x = pk2(d[0], d[1]); o.y = pk2(d[2], d[3]); *(LAS v2u*)(m + (colbase + (lane & 15)) * 16 + 4 * (lane >> 4)) = o; }
__device__ __forceinline__ void st_rowmaj(LAS bf16* m, const f32x4 d, int lane) {
#pragma unroll
    for (int r = 0; r < 4; ++r) m[(4 * (lane >> 4) + r) * 16 + (lane & 15)] = (bf16)f2bf(d[r]); }
template <int KS0, int KS1>
__device__ __forceinline__ void rw_chunk_load(const Ctx& F, int b, int h, int d, int cidx, v4u (&raw)[12]) {
    const int lane = opaque_v(F.lane), t = lane & 15, kg = lane >> 4;
    const bf16* base = (const bf16*)(F.a->ws + WS_SCN) + (size_t)seq_row(b, d, 16 * cidx + t) * 9 * 512 + h * 64;
#pragma unroll
    for (int ks = KS0; ks < KS1; ++ks) { const int off = 32 * ks + 8 * kg;
        raw[6 * ks + 0] = *(const v4u*)(base + (3 + 3 * d) * 512 + off); raw[6 * ks + 1] = *(const v4u*)(base + 2 * 512 + off); raw[6 * ks + 2] = *(const v4u*)(base + off);
        raw[6 * ks + 3] = *(const v4u*)(base + (5 + 3 * d) * 512 + off); raw[6 * ks + 4] = *(const v4u*)(base + (4 + 3 * d) * 512 + off); raw[6 * ks + 5] = *(const v4u*)(base + 512 + off); }
}
__device__ __forceinline__ void rw_chunk_task(const Ctx& F, const v4u (&raw)[12], LAS unsigned char* wl, unsigned char* slot) {
    const int lane = opaque_v(F.lane), t = lane & 15, kg = lane >> 4;
    LAS bf16* ATt = (LAS bf16*)(wl); LAS bf16* RBr = (LAS bf16*)(wl + 2048); LAS bf16* BHt = (LAS bf16*)(wl + 4096); LAS bf16* KHt = (LAS bf16*)(wl + 6144); LAS bf16* VTt = (LAS bf16*)(wl + 8192);
    LAS bf16* WAt = (LAS bf16*)(wl + 10240); LAS bf16* N_r = (LAS bf16*)(wl + 12288); LAS bf16* N_c = (LAS bf16*)(wl + 12800); LAS bf16* T_r = (LAS bf16*)(wl + 13312);
    LAS bf16* AK_r = (LAS bf16*)(wl + 13824); LAS bf16* RB2 = (LAS bf16*)(wl + 14336); LAS bf16* RK_r = (LAS bf16*)(wl + 14848); LAS float* GCl = (LAS float*)(wl + 15360);
    bf16x8 fAb[2], fRb[2], fBb[2], fKb[2];
#pragma unroll
    for (int ks = 0; ks < 2; ++ks) {
        const int off = 32 * ks + 8 * kg;
        float ea[8], er[8], eb[8], eh[8];
        { const v4u uld = raw[6 * ks + 0]; float ld[8]; unpack8(uld, ld);
#pragma unroll
          for (int j = 0; j < 8; ++j) { float c = ld[j]; c += dpp_shr(c, 1); c += dpp_shr(c, 2); c += dpp_shr(c, 4); c += dpp_shr(c, 8);
              const float tot = __builtin_bit_cast(float, __builtin_amdgcn_ds_bpermute((lane | 15) << 2, __builtin_bit_cast(int, c)));
              ea[j] = __expf(c - ld[j]); er[j] = __expf(c); eb[j] = __expf(-c); eh[j] = __expf(tot - c);
              if (t == 0) GCl[off + j] = __expf(tot); } }
        { const v4u u = raw[6 * ks + 1]; float x[8]; unpack8(u, x);
#pragma unroll
          for (int j = 0; j < 8; ++j) { x[j] = -x[j] * ea[j]; ATt[(off + j) * 16 + t] = (bf16)f2bf(x[j]); }
          const v4u p = pack8(x); fAb[ks] = __builtin_bit_cast(bf16x8, p); }
        { const v4u u = raw[6 * ks + 2]; float x[8]; unpack8(u, x);
#pragma unroll
          for (int j = 0; j < 8; ++j) x[j] = x[j] * er[j];
          const v4u p = pack8(x); fRb[ks] = __builtin_bit_cast(bf16x8, p); *(LAS v4u*)(RBr + t * 64 + off) = p; }
        { const v4u u = raw[6 * ks + 3]; float x[8], y[8]; unpack8(u, x);
#pragma unroll
          for (int j = 0; j < 8; ++j) { y[j] = x[j] * eb[j]; BHt[(off + j) * 16 + t] = (bf16)f2bf(x[j] * eh[j]); }
          const v4u p = pack8(y); fBb[ks] = __builtin_bit_cast(bf16x8, p); }
        { const v4u u = raw[6 * ks + 4]; float x[8], y[8]; unpack8(u, x);
#pragma unroll
          for (int j = 0; j < 8; ++j) { y[j] = x[j] * eb[j]; KHt[(off + j) * 16 + t] = (bf16)f2bf(x[j] * eh[j]); }
          const v4u p = pack8(y); fKb[ks] = __builtin_bit_cast(bf16x8, p); }
        { const v4u u = raw[6 * ks + 5];
          const bf16 e0 = (bf16)(u.x & 0xffff), e1 = (bf16)(u.x >> 16), e2 = (bf16)(u.y & 0xffff), e3 = (bf16)(u.y >> 16), e4 = (bf16)(u.z & 0xffff), e5 = (bf16)(u.z >> 16), e6 = (bf16)(u.w & 0xffff), e7 = (bf16)(u.w >> 16);
          VTt[(off + 0) * 16 + t] = e0; VTt[(off + 1) * 16 + t] = e1; VTt[(off + 2) * 16 + t] = e2; VTt[(off + 3) * 16 + t] = e3; VTt[(off + 4) * 16 + t] = e4; VTt[(off + 5) * 16 + t] = e5; VTt[(off + 6) * 16 + t] = e6; VTt[(off + 7) * 16 + t] = e7; }
        __builtin_amdgcn_sched_barrier(0);
    }
    asm volatile("" ::: "memory");
    const f32x4 z4 = (f32x4){0.f, 0.f, 0.f, 0.f};
    f32x4 n0 = mma16(fAb[1], fBb[1], mma16(fAb[0], fBb[0], z4)), aak = mma16(fAb[1], fKb[1], mma16(fAb[0], fKb[0], z4));
    f32x4 arb = mma16(fRb[1], fBb[1], mma16(fRb[0], fBb[0], z4)), ark = mma16(fRb[1], fKb[1], mma16(fRb[0], fKb[0], z4));
#pragma unroll
    for (int r = 0; r < 4; ++r) { const int tt = 4 * kg + r; if (!(t < tt)) { n0[r] = 0.f; aak[r] = 0.f; } if (!(t <= tt)) { arb[r] = 0.f; ark[r] = 0.f; } }
    st_rowmaj(AK_r, aak, lane); st_rowmaj(RB2, arb, lane); st_rowmaj(RK_r, ark, lane); asm volatile("" ::: "memory");
    f32x4 accT = n0;
#pragma unroll
    for (int r = 0; r < 4; ++r) accT[r] += (4 * kg + r == t) ? 1.f : 0.f;
    f32x4 nn = n0;
#pragma unroll
    for (int itn = 0; itn < 3; ++itn) {
        st_rowmaj(N_r, nn, lane); st_colmaj(N_c, 0, nn, lane); st_rowmaj(T_r, accT, lane); asm volatile("" ::: "memory");
        const bf16x8 fa = frag16(N_r, 0, lane), fb = frag16(N_c, 0, lane), ft = frag16(T_r, 0, lane);
        nn = mma16(fa, fb, z4); asm volatile("" ::: "memory");
        st_colmaj(N_c, 0, nn, lane); asm volatile("" ::: "memory");
        const bf16x8 fb2 = frag16(N_c, 0, lane);
        accT = mma16(ft, fb2, accT); asm volatile("" ::: "memory");
    }
    st_rowmaj(T_r, accT, lane); asm volatile("" ::: "memory");
    const bf16x8 fT = frag16(T_r, 0, lane), fAK = frag16(AK_r, 0, lane), fARB = frag16(RB2, 0, lane), fARK = frag16(RK_r, 0, lane);
#pragma unroll
    for (int kt = 0; kt < 4; ++kt) { const f32x4 dd = mma16(fT, frag16(ATt, 16 * kt, lane), z4); st_colmaj(WAt, 16 * kt, dd, lane); } asm volatile("" ::: "memory");
    { const bf16x8 fArbT = frag16(RB2, 0, lane);
#pragma unroll
      for (int kt = 0; kt < 4; ++kt) { const v2u ri = *(const LAS v2u*)(RBr + t * 64 + 16 * kt + 4 * kg);
          f32x4 c0 = (f32x4){bflo(ri.x), bfhi(ri.x), bflo(ri.y), bfhi(ri.y)};
          c0 = mma16(frag16(WAt, 16 * kt, lane), fArbT, c0);
          v2u o; o.x = pk2(c0[0], c0[1]); o.y = pk2(c0[2], c0[3]); *(v2u*)(slot + RWS_QY + (t * 64 + 16 * kt + 4 * kg) * 2) = o; } }
    asm volatile("" ::: "memory");
#pragma unroll
    for (int vt = 0; vt < 4; ++vt) { const f32x4 dd = mma16(fAK, frag16(VTt, 16 * vt, lane), z4); st_colmaj(ATt, 16 * vt, dd, lane); } asm volatile("" ::: "memory");
    asm volatile("" ::: "memory");
    LAS bf16* UVt = RBr;
#pragma unroll
    for (int vt = 0; vt < 4; ++vt) { const f32x4 dd = mma16(fT, frag16(ATt, 16 * vt, lane), z4); st_colmaj(UVt, 16 * vt, dd, lane); } asm volatile("" ::: "memory");
#pragma unroll
    for (int vt = 0; vt < 4; ++vt) { const f32x4 dd = mma16(fARK, frag16(VTt, 16 * vt, lane), mma16(fARB, frag16(UVt, 16 * vt, lane), z4));
        v2u o; o.x = pk2(dd[0], dd[1]); o.y = pk2(dd[2], dd[3]); *(v2u*)(slot + RWS_YV + ((16 * vt + t) * 16 + 4 * kg) * 2) = o; }
#pragma unroll
    for (int ktp = 0; ktp < 4; ++ktp) { const bf16x8 fBh = frag16(BHt, 16 * ktp, lane);
#pragma unroll
        for (int kt = 0; kt < 4; ++kt) { f32x4 dd = mma16(frag16(WAt, 16 * kt, lane), fBh, z4);
            if (kt == ktp) {
#pragma unroll
                for (int r = 0; r < 4; ++r) if (4 * kg + r == t) dd[r] += GCl[16 * kt + t]; }
            v2u o; o.x = pk2(dd[0], dd[1]); o.y = pk2(dd[2], dd[3]); *(v2u*)(slot + RWS_PZ + ((16 * ktp + t) * 64 + 16 * kt + 4 * kg) * 2) = o; } }
#pragma unroll
    for (int vt = 0; vt < 4; ++vt) { const bf16x8 fU = frag16(UVt, 16 * vt, lane), fV = frag16(VTt, 16 * vt, lane);
#pragma unroll
        for (int ktp = 0; ktp < 4; ++ktp) { const f32x4 dd = mma16(frag16(KHt, 16 * ktp, lane), fV, mma16(frag16(BHt, 16 * ktp, lane), fU, z4));
            v2u o; o.x = pk2(dd[0], dd[1]); o.y = pk2(dd[2], dd[3]); *(v2u*)(slot + RWS_ZV + ((16 * vt + t) * 64 + 16 * ktp + 4 * kg) * 2) = o; } }
}
__device__ __forceinline__ void rw_chunk_task2(const Ctx& F, const v4u (&raw)[12], LAS unsigned char* wl, f32x4 (&yv)[4], f32x4 (&zv)[4][4]) {
    const int lane = opaque_v(F.lane), t = lane & 15, kg = lane >> 4;
    LAS bf16* ATt = (LAS bf16*)(wl); LAS bf16* RBr = (LAS bf16*)(wl + 2048); LAS bf16* BHt = (LAS bf16*)(wl + 4096); LAS bf16* KHt = (LAS bf16*)(wl + 6144); LAS bf16* VTt = (LAS bf16*)(wl + 8192);
    LAS bf16* WAt = (LAS bf16*)(wl + 10240); LAS bf16* N_r = (LAS bf16*)(wl + 12288); LAS bf16* N_c = (LAS bf16*)(wl + 12800); LAS bf16* T_r = (LAS bf16*)(wl + 13312);
    LAS bf16* AK_r = (LAS bf16*)(wl + 13824); LAS bf16* RB2 = (LAS bf16*)(wl + 14336); LAS bf16* RK_r = (LAS bf16*)(wl + 14848); LAS float* GCl = (LAS float*)(wl + 15360);
    bf16x8 fAb[2], fRb[2], fBb[2], fKb[2];
#pragma unroll
    for (int ks = 0; ks < 2; ++ks) {
        const int off = 32 * ks + 8 * kg;
        float ea[8], er[8], eb[8], eh[8];
        { const v4u uld = raw[6 * ks + 0]; float ld[8]; unpack8(uld, ld);
#pragma unroll
          for (int j = 0; j < 8; ++j) { float c = ld[j]; c += dpp_shr(c, 1); c += dpp_shr(c, 2); c += dpp_shr(c, 4); c += dpp_shr(c, 8);
              const float tot = __builtin_bit_cast(float, __builtin_amdgcn_ds_bpermute((lane | 15) << 2, __builtin_bit_cast(int, c)));
              ea[j] = __expf(c - ld[j]); er[j] = __expf(c); eb[j] = __expf(-c); eh[j] = __expf(tot - c);
              if (t == 0) GCl[off + j] = __expf(tot); } }
        { const v4u u = raw[6 * ks + 1]; float x[8]; unpack8(u, x);
#pragma unroll
          for (int j = 0; j < 8; ++j) { x[j] = -x[j] * ea[j]; ATt[(off + j) * 16 + t] = (bf16)f2bf(x[j]); }
          const v4u p = pack8(x); fAb[ks] = __builtin_bit_cast(bf16x8, p); }
        { const v4u u = raw[6 * ks + 2]; float x[8]; unpack8(u, x);
#pragma unroll
          for (int j = 0; j < 8; ++j) x[j] = x[j] * er[j];
          const v4u p = pack8(x); fRb[ks] = __builtin_bit_cast(bf16x8, p); *(LAS v4u*)(RBr + t * 64 + off) = p; }
        { const v4u u = raw[6 * ks + 3]; float x[8], y[8]; unpack8(u, x);
#pragma unroll
          for (int j = 0; j < 8; ++j) { y[j] = x[j] * eb[j]; BHt[(off + j) * 16 + t] = (bf16)f2bf(x[j] * eh[j]); }
          const v4u p = pack8(y); fBb[ks] = __builtin_bit_cast(bf16x8, p); }
        { const v4u u = raw[6 * ks + 4]; float x[8], y[8]; unpack8(u, x);
#pragma unroll
          for (int j = 0; j < 8; ++j) { y[j] = x[j] * eb[j]; KHt[(off + j) * 16 + t] = (bf16)f2bf(x[j] * eh[j]); }
          const v4u p = pack8(y); fKb[ks] = __builtin_bit_cast(bf16x8, p); }
        { const v4u u = raw[6 * ks + 5];
          const bf16 e0 = (bf16)(u.x & 0xffff), e1 = (bf16)(u.x >> 16), e2 = (bf16)(u.y & 0xffff), e3 = (bf16)(u.y >> 16), e4 = (bf16)(u.z & 0xffff), e5 = (bf16)(u.z >> 16), e6 = (bf16)(u.w & 0xffff), e7 = (bf16)(u.w >> 16);
          VTt[(off + 0) * 16 + t] = e0; VTt[(off + 1) * 16 + t] = e1; VTt[(off + 2) * 16 + t] = e2; VTt[(off + 3) * 16 + t] = e3; VTt[(off + 4) * 16 + t] = e4; VTt[(off + 5) * 16 + t] = e5; VTt[(off + 6) * 16 + t] = e6; VTt[(off + 7) * 16 + t] = e7; }
        __builtin_amdgcn_sched_barrier(0);
    }
    asm volatile("" ::: "memory");
    const f32x4 z4 = (f32x4){0.f, 0.f, 0.f, 0.f};
    f32x4 n0 = mma16(fAb[1], fBb[1], mma16(fAb[0], fBb[0], z4)), aak = mma16(fAb[1], fKb[1], mma16(fAb[0], fKb[0], z4));
    f32x4 arb = mma16(fRb[1], fBb[1], mma16(fRb[0], fBb[0], z4)), ark = mma16(fRb[1], fKb[1], mma16(fRb[0], fKb[0], z4));
#pragma unroll
    for (int r = 0; r < 4; ++r) { const int tt = 4 * kg + r; if (!(t < tt)) { n0[r] = 0.f; aak[r] = 0.f; } if (!(t <= tt)) { arb[r] = 0.f; ark[r] = 0.f; } }
    st_rowmaj(AK_r, aak, lane); st_rowmaj(RB2, arb, lane); st_rowmaj(RK_r, ark, lane); asm volatile("" ::: "memory");
    f32x4 accT = n0;
#pragma unroll
    for (int r = 0; r < 4; ++r) accT[r] += (4 * kg + r == t) ? 1.f : 0.f;
    f32x4 nn = n0;
#pragma unroll
    for (int itn = 0; itn < 3; ++itn) {
        st_rowmaj(N_r, nn, lane); st_colmaj(N_c, 0, nn, lane); st_rowmaj(T_r, accT, lane); asm volatile("" ::: "memory");
        const bf16x8 fa = frag16(N_r, 0, lane), fb = frag16(N_c, 0, lane), ft = frag16(T_r, 0, lane);
        nn = mma16(fa, fb, z4); asm volatile("" ::: "memory");
        st_colmaj(N_c, 0, nn, lane); asm volatile("" ::: "memory");
        const bf16x8 fb2 = frag16(N_c, 0, lane);
        accT = mma16(ft, fb2, accT); asm volatile("" ::: "memory");
    }
    st_rowmaj(T_r, accT, lane); asm volatile("" ::: "memory");
    const bf16x8 fT = frag16(T_r, 0, lane), fAK = frag16(AK_r, 0, lane), fARB = frag16(RB2, 0, lane), fARK = frag16(RK_r, 0, lane);
#pragma unroll
    for (int kt = 0; kt < 4; ++kt) { const f32x4 dd = mma16(fT, frag16(ATt, 16 * kt, lane), z4); st_colmaj(WAt, 16 * kt, dd, lane); } asm volatile("" ::: "memory");
    f32x4 qy[4];
    { const bf16x8 fArbT = frag16(RB2, 0, lane);
#pragma unroll
      for (int kt = 0; kt < 4; ++kt) { const v2u ri = *(const LAS v2u*)(RBr + t * 64 + 16 * kt + 4 * kg);
          qy[kt] = mma16(frag16(WAt, 16 * kt, lane), fArbT, (f32x4){bflo(ri.x), bfhi(ri.x), bflo(ri.y), bfhi(ri.y)}); } }
    asm volatile("" ::: "memory");
#pragma unroll
    for (int vt = 0; vt < 4; ++vt) { const f32x4 dd = mma16(fAK, frag16(VTt, 16 * vt, lane), z4); st_colmaj(ATt, 16 * vt, dd, lane); } asm volatile("" ::: "memory");
    LAS bf16* UVt = RBr;
#pragma unroll
    for (int vt = 0; vt < 4; ++vt) { const f32x4 dd = mma16(fT, frag16(ATt, 16 * vt, lane), z4); st_colmaj(UVt, 16 * vt, dd, lane); } asm volatile("" ::: "memory");
#pragma unroll
    for (int vt = 0; vt < 4; ++vt) { const bf16x8 fU = frag16(UVt, 16 * vt, lane), fV = frag16(VTt, 16 * vt, lane);
        yv[vt] = mma16(fARK, fV, mma16(fARB, fU, z4));
#pragma unroll
        for (int ktp = 0; ktp < 4; ++ktp) zv[vt][ktp] = mma16(frag16(KHt, 16 * ktp, lane), fV, mma16(frag16(BHt, 16 * ktp, lane), fU, z4)); }
    f32x4 pz[4][4];
#pragma unroll
    for (int ktp = 0; ktp < 4; ++ktp) { const bf16x8 fBh = frag16(BHt, 16 * ktp, lane);
#pragma unroll
        for (int kt = 0; kt < 4; ++kt) { f32x4 dd = mma16(frag16(WAt, 16 * kt, lane), fBh, z4);
            if (kt == ktp) {
#pragma unroll
                for (int r = 0; r < 4; ++r) if (4 * kg + r == t) dd[r] += GCl[16 * kt + t]; }
            pz[ktp][kt] = dd; } }
    asm volatile("s_waitcnt lgkmcnt(0)" ::: "memory");
#pragma unroll
    for (int ktp = 0; ktp < 4; ++ktp) { LAS bf16* reg = (LAS bf16*)(wl + (ktp < 2 ? ktp * 2048 : (ktp + 1) * 2048));
#pragma unroll
        for (int kt = 0; kt < 4; ++kt) { v2u o; o.x = pk2(pz[ktp][kt][0], pz[ktp][kt][1]); o.y = pk2(pz[ktp][kt][2], pz[ktp][kt][3]); *(LAS v2u*)(reg + t * 64 + 16 * kt + 4 * kg) = o; } }
#pragma unroll
    for (int kt = 0; kt < 4; ++kt) { v2u o; o.x = pk2(qy[kt][0], qy[kt][1]); o.y = pk2(qy[kt][2], qy[kt][3]); *(LAS v2u*)(BHt + t * 64 + 16 * kt + 4 * kg) = o; }
    asm volatile("s_waitcnt lgkmcnt(0)" ::: "memory");
}
constexpr int RWZ_OFF = LDSCTL_OFF + 8192, RWF_OFF = LDSCTL_OFF + 2048;
__device__ __forceinline__ void rw_chunk_item2(const Ctx& F, int l, int it, size_t yoff = WS_YDIR) {
    const auto& a = *F.a; unsigned char* ws = a.ws; const int lane = opaque_v(F.lane), t = lane & 15, kg = lane >> 4;
    const int d = it & 1, h = (it >> 1) & 7, b = it >> 4;
    float* YD = (float*)(ws + yoff);
    LAS unsigned char* wl = F.lds + F.wave * 15616;
    LAS bf16* ZS = (LAS bf16*)(F.lds + RWZ_OFF);
    volatile LAS int* flag = (volatile LAS int*)(F.lds + RWF_OFF);
    for (int i = F.tid; i < 2048; i += NTHREADS) ((LAS unsigned*)ZS)[i] = 0u;
    if (F.tid == 0) *flag = 0;
    __syncthreads();
    constexpr int NCHK = (CTXL + SEQ) / 16;
#pragma unroll 1
    for (int c = F.wave; c < NCHK; c += NWAVES) {
        v4u raw[12]; f32x4 yv[4], zv[4][4];
        rw_chunk_load<0, 2>(F, b, h, d, c, raw);
        rw_chunk_task2(F, raw, wl, yv, zv);
        while (*flag < c) __builtin_amdgcn_s_sleep(1);
        asm volatile("" ::: "memory");
        const LAS bf16* Zc = ZS + (c & 1) * 4096; LAS bf16* Zn = ZS + ((c + 1) & 1) * 4096;
        bf16x8 zb[4][2];
#pragma unroll
        for (int vb = 0; vb < 4; ++vb)
#pragma unroll
            for (int ks = 0; ks < 2; ++ks) zb[vb][ks] = *(const LAS bf16x8*)(Zc + (16 * vb + t) * 64 + 32 * ks + 8 * kg);
        { const LAS bf16* Qr = (const LAS bf16*)(wl + 4096); const bf16x8 q0 = *(const LAS bf16x8*)(Qr + t * 64 + 8 * kg), q1 = *(const LAS bf16x8*)(Qr + t * 64 + 32 + 8 * kg);
#pragma unroll
          for (int vb = 0; vb < 4; ++vb) { const f32x4 y = mma16(q1, zb[vb][1], mma16(q0, zb[vb][0], yv[vb]));
#pragma unroll
              for (int r = 0; r < 4; ++r) { const int row = seq_row(b, d, c * 16 + 4 * kg + r); YD[((size_t)d * T_ALL + row) * 512 + h * 64 + 16 * vb + t] = y[r]; } } }
#pragma unroll
        for (int ktp = 0; ktp < 4; ++ktp) { const LAS bf16* Pr = (const LAS bf16*)(wl + (ktp < 2 ? ktp * 2048 : (ktp + 1) * 2048));
            const bf16x8 p0 = *(const LAS bf16x8*)(Pr + t * 64 + 8 * kg), p1 = *(const LAS bf16x8*)(Pr + t * 64 + 32 + 8 * kg);
#pragma unroll
            for (int vb = 0; vb < 4; ++vb) { const f32x4 z = mma16(p1, zb[vb][1], mma16(p0, zb[vb][0], zv[vb][ktp]));
                v2u o; o.x = pk2(z[0], z[1]); o.y = pk2(z[2], z[3]); *(LAS v2u*)(Zn + (16 * vb + t) * 64 + 16 * ktp + 4 * kg) = o; } }
        asm volatile("s_waitcnt lgkmcnt(0)" ::: "memory");
        if (lane == 0) *flag = c + 1;
        asm volatile("s_waitcnt lgkmcnt(0)" ::: "memory");
    }
    __syncthreads();
}
__device__ __forceinline__ v2u ld_sc1_8(const void* p) { const unsigned long long v = __hip_atomic_load((const unsigned long long*)p, __ATOMIC_RELAXED, __HIP_MEMORY_SCOPE_AGENT); v2u o; o.x = (unsigned)v; o.y = (unsigned)(v >> 32); return o; }
__device__ __forceinline__ v4u ld_sc1_16(const void* p) { const v2u a = ld_sc1_8(p), b = ld_sc1_8((const char*)p + 8); return (v4u){a.x, a.y, b.x, b.y}; }
__device__ __forceinline__ void rw_chunk_item(const Ctx& F, int l, int it) {
    const auto& a = *F.a; unsigned char* ws = a.ws; const int lane = F.lane, t = lane & 15, kg = lane >> 4;
    const int d = it & 1, h = (it >> 1) & 7, b = it >> 4;
    float* YD = (float*)(ws + WS_YDIR);
    unsigned char* scr = ws + WS_RWSCR + (size_t)F.bid * 16 * RWS_SLOT;
    LAS unsigned char* wl = F.lds + F.wave * 15616;
    LAS bf16* ZL = (LAS bf16*)(F.lds + LDSCTL_OFF + 4096 + (F.wave & 3) * 2048);
    if (F.wave < 4) { for (int i = lane; i < 512; i += 64) ((LAS unsigned*)ZL)[i] = 0u; }
    asm volatile("" ::: "memory");
    constexpr int NCHK = (CTXL + SEQ) / 16, NB = NCHK / 16;
#pragma unroll 1
    for (int bt = 0; bt < NB; ++bt) {
        { v4u cur[12];
#pragma unroll 1
          for (int jj = 0; jj < 2; ++jj) { rw_chunk_load<0, 2>(F, b, h, d, bt * 16 + F.wave + 8 * jj, cur); rw_chunk_task(F, cur, wl, scr + (size_t)(F.wave + 8 * jj) * RWS_SLOT); } }
        asm volatile("s_waitcnt vmcnt(0)" ::: "memory");
        __syncthreads();
        {
            const int t = opaque_v(lane & 15), kg = opaque_v(lane >> 4), vb = opaque(F.wave) & 3;
            const unsigned char* scrb = F.a->ws + WS_RWSCR + (size_t)opaque(F.bid) * 16 * RWS_SLOT;
            LAS unsigned char* sbuf = F.lds;
            const int lt = opaque_v(F.tid) & 255; const bool loader = F.wave >= 4;
            const int lw = opaque(F.wave) & 3;
#define RWB_ISSUE(j_) do { const unsigned char* gp_ = scrb + (size_t)(j_) * RWS_SLOT + (size_t)(lw * 5) * 1024 + lane * 16; LAS unsigned char* lp_ = sbuf + ((j_) % 6) * RWS_SLOT + (lw * 5) * 1024; \
                _Pragma("unroll") for (int q = 0; q < 5; ++q) __builtin_amdgcn_global_load_lds((const unsigned*)(gp_ + q * 1024), (LAS unsigned*)(lp_ + q * 1024), 16, 0, 16); } while (0)
#define RWB_COMP(bi_, j_) do { const LAS unsigned char* sl_ = sbuf + (bi_) * RWS_SLOT; bf16x8 zb[2], qf[2]; \
                _Pragma("unroll") for (int ks = 0; ks < 2; ++ks) { zb[ks] = *(const LAS bf16x8*)(ZL + t * 64 + 32 * ks + 8 * kg); qf[ks] = *(const LAS bf16x8*)(sl_ + RWS_QY + (t * 64 + 32 * ks + 8 * kg) * 2); } \
                const v2u y_ = *(const LAS v2u*)(sl_ + RWS_YV + ((16 * vb + t) * 16 + 4 * kg) * 2); \
                f32x4 yacc = (f32x4){bflo(y_.x), bfhi(y_.x), bflo(y_.y), bfhi(y_.y)}; \
                yacc = mma16(qf[1], zb[1], mma16(qf[0], zb[0], yacc)); \
                f32x4 zn[4]; \
                _Pragma("unroll") for (int ktp = 0; ktp < 4; ++ktp) { const v2u z_ = *(const LAS v2u*)(sl_ + RWS_ZV + ((16 * vb + t) * 64 + 16 * ktp + 4 * kg) * 2); \
                    f32x4 zc = (f32x4){bflo(z_.x), bfhi(z_.x), bflo(z_.y), bfhi(z_.y)}; \
                    _Pragma("unroll") for (int ks = 0; ks < 2; ++ks) zc = mma16(*(const LAS bf16x8*)(sl_ + RWS_PZ + ((16 * ktp + t) * 64 + 32 * ks + 8 * kg) * 2), zb[ks], zc); \
                    zn[ktp] = zc; } \
                _Pragma("unroll") for (int r = 0; r < 4; ++r) { const int row = seq_row(b, d, (bt * 16 + (j_)) * 16 + 4 * kg + r); YD[((size_t)d * T_ALL + row) * 512 + h * 64 + 16 * vb + t] = yacc[r]; } \
                asm volatile("s_waitcnt lgkmcnt(0)" ::: "memory"); \
                _Pragma("unroll") for (int ktp = 0; ktp < 4; ++ktp) { v2u o; o.x = pk2(zn[ktp][0], zn[ktp][1]); o.y = pk2(zn[ktp][2], zn[ktp][3]); *(LAS v2u*)(ZL + t * 64 + 16 * ktp + 4 * kg) = o; } \
                asm volatile("s_waitcnt lgkmcnt(0)" ::: "memory"); } while (0)
#define RWB_BAR() do { asm volatile("s_waitcnt lgkmcnt(0)" ::: "memory"); __builtin_amdgcn_s_barrier(); asm volatile("" ::: "memory"); } while (0)
            if (loader) { RWB_ISSUE(0); RWB_ISSUE(1); RWB_ISSUE(2); RWB_ISSUE(3); asm volatile("s_waitcnt vmcnt(15)" ::: "memory"); }
            RWB_BAR();
#pragma unroll 1
            for (int j = 0; j < 16; ++j) {
                if (loader) { if (j + 4 < 16) { RWB_ISSUE(j + 4); asm volatile("s_waitcnt vmcnt(15)" ::: "memory"); } else { asm volatile("s_waitcnt vmcnt(0)" ::: "memory"); } }
                else { RWB_COMP(j % 6, j); }
                RWB_BAR();
            }
#undef RWB_BAR
#undef RWB_ISSUE
#undef RWB_COMP
        }
        __syncthreads();
    }
}

__device__ __forceinline__ void stage_rw_readout(const Ctx& F, int l) {
    const auto& a = *F.a; unsigned char* ws = a.ws; const int lane = F.lane;
    const bf16* SCN = (const bf16*)(ws + WS_SCN); const bf16* P = (const bf16*)(ws + WS_P); const float* YD = (const float*)(ws + WS_YDIR); bf16* YRW = (bf16*)(ws + WS_YRW);
    const int gw = F.bid * NWAVES + F.wave, NGW = F.G * NWAVES;
    constexpr int TR = 17, NRT = T_ALL / TR;
    for (int tile = gw; tile < NRT * 4; tile += NGW) {
        const int rt = tile % NRT, hp = tile / NRT, row0 = rt * TR, c0 = hp * 128 + 2 * lane;
        const f32x2 rk = *(const f32x2*)(a.in[I_RWRK] + l * 512 + c0), lng = *(const f32x2*)(a.in[I_RWLNG] + l * 512 + c0), lnb = *(const f32x2*)(a.in[I_RWLNB] + l * 512 + c0);
#pragma unroll 4
        for (int i = 0; i < TR; ++i) {
            const int row = row0 + i;
            const unsigned* sp = (const unsigned*)(SCN + (size_t)row * 9 * 512 + c0);
            const unsigned ru = sp[0], vu = sp[256], k0u = sp[4 * 256], k1u = sp[7 * 256];
            const f32x2 y0 = *(const f32x2*)(YD + (size_t)row * 512 + c0), y1 = *(const f32x2*)(YD + ((size_t)T_ALL + row) * 512 + c0);
            const unsigned gu = *(const unsigned*)(P + (size_t)row * 2560 + 2048 + c0);
            const float bon = red32(bflo(ru) * (bflo(k0u) + bflo(k1u)) * rk[0] + bfhi(ru) * (bfhi(k0u) + bfhi(k1u)) * rk[1]);
            f32x2 y = y0 + y1 + (f32x2){bflo(vu), bfhi(vu)} * bon;
            const float mu = red32(y[0] + y[1]) * (1.f / 64.f);
            y = y - mu;
            const float var = red32(y[0] * y[0] + y[1] * y[1]) * (1.f / 64.f);
            const f32x2 yn = y * (1.0f / sqrtf(var + 64e-5f));
            const f32x2 ov = (yn * lng + lnb) * (f32x2){bflo(gu), bfhi(gu)};
            *(unsigned*)(YRW + (size_t)row * 512 + c0) = pk2(ov[0], ov[1]);
        }
    }
}

constexpr size_t WS_S5E = 6 * MiB;
constexpr int S5_NSEG = 4, S5_SEGLEN = (CTXL + SEQ) / S5_NSEG;
__device__ __forceinline__ void s5_disc(const float are, const float aim, const float dt, float& lbr, float& lbi, float& cr, float& ci) {
    const float mag = expf(are * dt); lbr = mag * cosf(aim * dt); lbi = mag * sinf(aim * dt);
    const float den = are * are + aim * aim, nr = lbr - 1.0f; cr = (nr * are + lbi * aim) / den; ci = (lbi * are - nr * aim) / den;
}
template <int PASS>
__device__ __forceinline__ void stage_s5_scan(const Ctx& F, int l) {
    const auto& a = *F.a; unsigned char* ws = a.ws; const int lane = F.lane;
    const bf16* Z = (const bf16*)(ws + WS_Z); float* YP = (float*)(ws + WS_YP); f32x2* S5E = (f32x2*)(ws + WS_S5E);
    LAS unsigned char* wl = F.lds + F.wave * 16384;
    LAS float* buL = (LAS float*)wl;
    LAS bf16* Hs = (LAS bf16*)(wl + 8704);
    const int fr = lane & 15, kg = lane >> 4;
    for (int itx = F.bid * NWAVES + F.wave; itx < BATCH * 32 * 2 * S5_NSEG; itx += NWAVES * F.G) {
        const int seg = itx & (S5_NSEG - 1), it = itx >> 2;
        const int d = it & 1, g = (it >> 1) & 31, b = it >> 6, p = lane;
        const float dt = expf(a.in[I_S5LDT][(l * 2 + d) * 32 + g]);
        const float* arep = a.in[I_S5ARE] + ((size_t)(l * 2 + d) * 32 + g) * 64; const float* aimp = a.in[I_S5AIM] + ((size_t)(l * 2 + d) * 32 + g) * 64;
        float lbr, lbi, cr_, ci_; s5_disc(arep[p], aimp[p], dt, lbr, lbi, cr_, ci_);
        bf16x8 afr[2][4];
#pragma unroll
        for (int tl = 0; tl < 4; ++tl) { const int pp = 16 * tl + fr; float r0_, r1_, cr, ci; s5_disc(arep[pp], aimp[pp], dt, r0_, r1_, cr, ci);
            v4u pr = (v4u){0u, 0u, 0u, 0u}, pi = (v4u){0u, 0u, 0u, 0u};
            if (kg < 2) { const float* br = a.in[I_S5BRE] + (((size_t)l * 32 + g) * 64 + pp) * 16 + 8 * kg; const float* bi = a.in[I_S5BIM] + (((size_t)l * 32 + g) * 64 + pp) * 16 + 8 * kg;
                const f32x4 x0 = *(const f32x4*)br, x1 = *(const f32x4*)(br + 4), y0 = *(const f32x4*)bi, y1 = *(const f32x4*)(bi + 4);
                pr.x = pk2(cr * x0[0] - ci * y0[0], cr * x0[1] - ci * y0[1]); pr.y = pk2(cr * x0[2] - ci * y0[2], cr * x0[3] - ci * y0[3]);
                pr.z = pk2(cr * x1[0] - ci * y1[0], cr * x1[1] - ci * y1[1]); pr.w = pk2(cr * x1[2] - ci * y1[2], cr * x1[3] - ci * y1[3]);
                pi.x = pk2(cr * y0[0] + ci * x0[0], cr * y0[1] + ci * x0[1]); pi.y = pk2(cr * y0[2] + ci * x0[2], cr * y0[3] + ci * x0[3]);
                pi.z = pk2(cr * y1[0] + ci * x1[0], cr * y1[1] + ci * x1[1]); pi.w = pk2(cr * y1[2] + ci * x1[2], cr * y1[3] + ci * x1[3]); }
            afr[0][tl] = __builtin_bit_cast(bf16x8, pr); afr[1][tl] = __builtin_bit_cast(bf16x8, pi); }
        bf16x8 cf[4];
        f32x2 hst = (f32x2){0.f, 0.f};
        if (PASS == 1) {
#pragma unroll
            for (int kk = 0; kk < 4; ++kk) { const int p0 = 16 * kk + 4 * kg;
                const f32x4 c0 = *(const f32x4*)(a.in[I_S5CRE] + (((size_t)l * 32 + g) * 16 + fr) * 64 + p0), c1 = *(const f32x4*)(a.in[I_S5CIM] + (((size_t)l * 32 + g) * 16 + fr) * 64 + p0);
                v4u pk; pk.x = pk2(c0[0], -c1[0]); pk.y = pk2(c0[1], -c1[1]); pk.z = pk2(c0[2], -c1[2]); pk.w = pk2(c0[3], -c1[3]);
                cf[kk] = __builtin_bit_cast(bf16x8, pk); }
            float pr_ = lbr, pi_ = lbi, l64r = 1.f, l64i = 0.f;
#pragma unroll 1
            for (int q = 0; q < 10; ++q) { const float nr2 = pr_ * pr_ - pi_ * pi_, ni2 = 2.f * pr_ * pi_; pr_ = nr2; pi_ = ni2; if (q == 5) { l64r = pr_; l64i = pi_; } }
            const float lLr = pr_ * l64r - pi_ * l64i, lLi = pr_ * l64i + pi_ * l64r;
#pragma unroll 1
            for (int sgi = 0; sgi < seg; ++sgi) { const f32x2 ev = S5E[((size_t)it * S5_NSEG + sgi) * 64 + p];
                hst = (f32x2){lLr * hst[0] - lLi * hst[1] + ev[0], lLr * hst[1] + lLi * hst[0] + ev[1]}; }
        }
        const f32x2 lbr2 = (f32x2){lbr, lbr}, lbi2 = (f32x2){lbi, lbi};
        const int sbeg = seg * S5_SEGLEN, send = sbeg + S5_SEGLEN;
        v4u un = (v4u){0u, 0u, 0u, 0u}, uc;
#define S5_LOADU(s0_) do { if (kg < 2) { const int row_ = seq_row(b, d, (s0_) + fr); un = *(const v4u*)(Z + (size_t)row_ * IN_COLS + S5_OFF + g * 16 + kg * 8); } } while (0)
        S5_LOADU(sbeg);
#pragma unroll 1
        for (int s0 = sbeg; s0 < send; s0 += 16) {
            uc = un;
            if (s0 + 16 < send) S5_LOADU(s0 + 16);
            const bf16x8 ufr = __builtin_bit_cast(bf16x8, uc);
#pragma unroll
            for (int c = 0; c < 2; ++c)
#pragma unroll
                for (int tl = 0; tl < 4; ++tl) { const f32x4 dd = __builtin_amdgcn_mfma_f32_16x16x32_bf16(afr[c][tl], ufr, (f32x4){0.f, 0.f, 0.f, 0.f}, 0, 0, 0);
                    *(LAS f32x4*)(buL + (c * 16 + fr) * 68 + 16 * tl + 4 * kg) = dd; }
            LDS_WAIT(); asm volatile("" ::: "memory");
            f32x2 bu[16];
#pragma unroll
            for (int s = 0; s < 16; ++s) bu[s] = (f32x2){buL[s * 68 + p], buL[(16 + s) * 68 + p]};
#pragma unroll
            for (int s = 0; s < 16; ++s) {
                const f32x2 sw = (f32x2){-hst[1], hst[0]};
                hst = lbr2 * hst + (lbi2 * sw + bu[s]);
                if (PASS == 1) *(LAS unsigned*)(Hs + s * 136 + 2 * p) = pg8::cvt_pk_bf16(hst[0], hst[1]);
            }
            if (PASS == 1) {
                LDS_WAIT(); asm volatile("" ::: "memory");
                f32x4 acc = (f32x4){0.f, 0.f, 0.f, 0.f};
#pragma unroll
                for (int kk = 0; kk < 4; ++kk) { const bf16x8 af = *(const LAS bf16x8*)(Hs + fr * 136 + 32 * kk + 8 * kg); acc = __builtin_amdgcn_mfma_f32_16x16x32_bf16(af, cf[kk], acc, 0, 0, 0); }
#pragma unroll
                for (int r = 0; r < 4; ++r) { const int row = seq_row(b, d, s0 + 4 * kg + r); YP[((size_t)d * T_ALL + row) * 512 + g * 16 + fr] = acc[r]; }
            }
            LDS_WAIT(); asm volatile("" ::: "memory");
        }
        if (PASS == 0) S5E[((size_t)it * S5_NSEG + seg) * 64 + p] = hst;
#undef S5_LOADU
    }
}

__device__ __forceinline__ void stage_s5_prep(const Ctx& F, int l, int nrows) {
    const auto& a = *F.a; unsigned char* ws = a.ws;
    const bf16* Z = (const bf16*)(ws + WS_Z); const float* YP = (const float*)(ws + WS_YP); bf16* AS5 = (bf16*)(ws + WS_AS5);
    const float dsk = a.in[I_S5D][l * 512 + F.tid];
    for (int row = F.bid; row < nrows; row += F.G) {
        const int c = F.tid;
        const float u = bf2f(Z[(size_t)row * IN_COLS + S5_OFF + c]);
        const float y = YP[(size_t)row * 512 + c] + YP[((size_t)T_ALL + row) * 512 + c] + u * dsk;
        const float ge = 0.5f * y * (1.f + tanhf(0.7978845608028654f * (y + 0.044715f * y * y * y)));
        AS5[(size_t)row * 512 + c] = (bf16)f2bf(ge);
    }
}

__device__ __forceinline__ void stage_hy_pre(const Ctx& F, int l, int nrows) {
    const auto& a = *F.a; unsigned char* ws = a.ws; const int lane = F.lane;
    const bf16* Z = (const bf16*)(ws + WS_Z); bf16* UT = (bf16*)(ws + WS_UT);
    LAS bf16* tl = (LAS bf16*)(F.lds + F.wave * 16384);
    const float* cw = a.in[I_HYCW] + (size_t)l * 3 * 1536; const float* cbp = a.in[I_HYCB] + l * 1536;
    const int gw = F.bid * NWAVES + F.wave, NGW = F.G * NWAVES;
    for (int tile = gw; tile < (nrows / 64) * 24; tile += NGW) {
        const int rt = tile / 24, ct = tile % 24, row0 = rt * 64, col = ct * 64 + lane;
        int base, pos0, n; row_seq(row0, base, pos0, n);
        const bf16* zc = Z + (size_t)base * IN_COLS + HY_OFF + col;
        const float w0 = cw[col], w1 = cw[1536 + col], w2 = cw[2 * 1536 + col], cb = cbp[col];
        float zm = pos0 > 0 ? bf2f(zc[(size_t)(pos0 - 1) * IN_COLS]) : 0.f, z0 = bf2f(zc[(size_t)pos0 * IN_COLS]);
#pragma unroll 8
        for (int r = 0; r < 64; ++r) { const float zp = (pos0 + r + 1 < n) ? bf2f(zc[(size_t)(pos0 + r + 1) * IN_COLS]) : 0.f;
            tl[lane * 66 + r] = (bf16)f2bf(w0 * zm + w1 * z0 + w2 * zp + cb); zm = z0; z0 = zp; }
        LDS_WAIT(); asm volatile("" ::: "memory");
        bf16* up = UT + (size_t)(ct * 64) * T_ALL + row0 + lane;
#pragma unroll 8
        for (int cc = 0; cc < 64; ++cc) up[(size_t)cc * T_ALL] = tl[cc * 66 + lane];
        LDS_WAIT(); asm volatile("" ::: "memory");
    }
}
__device__ __forceinline__ void stage_hy_post(const Ctx& F, int l, int nrows) {
    const auto& a = *F.a; unsigned char* ws = a.ws; const int lane = F.lane;
    const bf16* YT = (const bf16*)(ws + WS_UT) + (size_t)1024 * T_ALL; bf16* YHY = (bf16*)(ws + WS_YHY);
    LAS bf16* tl = (LAS bf16*)(F.lds + F.wave * 8448);
    const int gw = F.bid * NWAVES + F.wave, NGW = F.G * NWAVES;
    for (int tile = gw; tile < (nrows / 64) * 8; tile += NGW) {
        const int rt = tile >> 3, ct = tile & 7, row0 = rt * 64, c0 = ct * 64;
        const bf16* yp = YT + (size_t)c0 * T_ALL + row0 + lane;
#pragma unroll 8
        for (int cc = 0; cc < 64; ++cc) tl[cc * 66 + lane] = yp[(size_t)cc * T_ALL];
        LDS_WAIT(); asm volatile("" ::: "memory");
        bf16* op = YHY + (size_t)row0 * 512 + c0 + lane;
#pragma unroll 8
        for (int r = 0; r < 64; ++r) op[(size_t)r * 512] = tl[lane * 66 + r];
        LDS_WAIT(); asm volatile("" ::: "memory");
    }
}
typedef float f32x16 __attribute__((ext_vector_type(16)));
__device__ __forceinline__ void hyena_item(const Ctx& F, int l, int c, int isctx) {
    const auto& a = *F.a; unsigned char* ws = a.ws; const int tid = F.tid, lane = F.lane;
    const int n = isctx ? CTXL : SEQ, rowbase = isctx ? T_LAT : 0, RL = isctx ? HY_RLENC : HY_RLEN, off = n + 47;
    const bf16* UT = (const bf16*)(ws + WS_UT);
    const bf16* x1g = UT + (size_t)c * T_ALL + rowbase; const bf16* x2g = UT + (size_t)(512 + c) * T_ALL + rowbase; bf16* vg = (bf16*)UT + (size_t)(1024 + c) * T_ALL + rowbase;
    const bf16* Rg = (const bf16*)(ws + WS_GF + l * GF_STRIDE + (isctx ? GF_CTX : 0)) + (size_t)c * RL;
    LAS unsigned char* XB = F.lds; LAS unsigned char* R1 = F.lds + HY_R1_OFF; LAS unsigned char* R2 = F.lds + HY_R2_OFF;
    { const int cpb = n / 8;
      for (int q = tid; q < 8 * cpb; q += NTHREADS) { const int b = q / cpb, ch = q % cpb; *(LAS v4u*)(XB + b * HY_ROWB + 2 * HY_MARG + 16 * ch) = *(const v4u*)(vg + (size_t)b * n + 8 * ch); }
      if (tid < 256) { const int b = tid >> 5, side = (tid >> 4) & 1, ch = tid & 15; const unsigned zz = (unsigned)opaque_v(0); *(LAS v4u*)(XB + b * HY_ROWB + (side ? 2 * (HY_MARG + n) : 0) + 16 * ch) = (v4u){zz, zz, zz, zz}; }
      const int rch = RL / 8;
      for (int q = tid; q < rch; q += NTHREADS) { *(LAS v4u*)(R1 + 16 * q) = *(const v4u*)(Rg + 8 * q); *(LAS v4u*)(R2 + 16 * q) = *(const v4u*)(Rg + (size_t)512 * RL + 8 * q); } }
    __syncthreads();
    const int i = lane & 31, kg = lane >> 5, jb = lane & 3, bb = (lane & 31) >> 2;
    const int rsh = (off - i) & 7, rd = rsh >> 1; const bool s1 = rd & 1, s2 = rd & 2; const unsigned sh = (rsh & 1) ? 16u : 0u;
    const int aconst = 2 * (off - i + 8 * kg - rsh), bconst = bb * HY_ROWB + 2 * (HY_MARG + 32 * jb + 8 * kg);
    const int T0w = 512 * F.wave; const int ntile = (n - T0w) >= 512 ? 4 : ((n - T0w) > 0 ? (n - T0w) / 128 : 0);
    const float bias0 = a.in[I_HYBIAS][(l * 2 + 0) * 512 + c], bias1 = a.in[I_HYBIAS][(l * 2 + 1) * 512 + c];
    f32x16 acc[4];
    v2u y1p[4][4];
#define HY_AFRAG(wa, wb, afr) do { \
        const unsigned a0 = s1 ? wa.y : wa.x, a1 = s1 ? wa.z : wa.y, a2 = s1 ? wa.w : wa.z, a3 = s1 ? wb.x : wa.w, a4 = s1 ? wb.y : wb.x, a5 = s1 ? wb.z : wb.y, a6 = s1 ? wb.w : wb.z; \
        const unsigned b0 = s2 ? a2 : a0, b1 = s2 ? a3 : a1, b2 = s2 ? a4 : a2, b3 = s2 ? a5 : a3, b4 = s2 ? a6 : a4; \
        v4u af_; af_.x = __builtin_amdgcn_alignbit(b1, b0, sh); af_.y = __builtin_amdgcn_alignbit(b2, b1, sh); af_.z = __builtin_amdgcn_alignbit(b3, b2, sh); af_.w = __builtin_amdgcn_alignbit(b4, b3, sh); \
        afr = __builtin_bit_cast(bf16x8, af_); } while (0)
#define HY_STEP_COND(RB, d) do { \
        const v4u wa = *(const LAS v4u*)((RB) + aconst - 2 * (d)), wb = *(const LAS v4u*)((RB) + aconst - 2 * (d) + 16); bf16x8 afr; HY_AFRAG(wa, wb, afr); \
        _Pragma("unroll") for (int m = 0; m < 4; ++m) { const int T0 = T0w + 128 * m; \
            if (m < ntile && (d) >= T0 - n + 16 && (d) <= T0 + 96) { const bf16x8 bfr = *(const LAS bf16x8*)(XB + bconst + 2 * (T0 - (d))); \
                acc[m] = __builtin_amdgcn_mfma_f32_32x32x16_bf16(afr, bfr, acc[m], 0, 0, 0); } } } while (0)
#define HY_LOAD(RB, d, wa, wb, bq) do { wa = *(const LAS v4u*)((RB) + aconst - 2 * (d)); wb = *(const LAS v4u*)((RB) + aconst - 2 * (d) + 16); \
        _Pragma("unroll") for (int m = 0; m < 4; ++m) bq[m] = *(const LAS bf16x8*)(XB + bconst + 2 * (T0w + 128 * m - (d))); } while (0)
#define HY_MMA(wa, wb, bq) do { bf16x8 afr; HY_AFRAG(wa, wb, afr); \
        _Pragma("unroll") for (int m = 0; m < 4; ++m) acc[m] = __builtin_amdgcn_mfma_f32_32x32x16_bf16(afr, bq[m], acc[m], 0, 0, 0); } while (0)
#define HY_CONV(RB) do { \
        _Pragma("unroll") for (int m = 0; m < 4; ++m) _Pragma("unroll") for (int e = 0; e < 16; ++e) acc[m][e] = 0.f; \
        if (ntile == 4) { \
            const int dA = T0w - n + 16, dB = T0w + 384 - n + 16, dC = T0w + 96, dD = T0w + 384 + 96;     \
            _Pragma("unroll 1") for (int d = dA; d < dB; d += 16) HY_STEP_COND(RB, d); \
            { v4u waA, wbA, waB, wbB; bf16x8 bqA[4], bqB[4]; \
              HY_LOAD(RB, dB, waA, wbA, bqA); \
              _Pragma("unroll 1") for (int d = dB; d <= dC; d += 32) { \
                  if (d + 16 <= dC) HY_LOAD(RB, d + 16, waB, wbB, bqB); \
                  __builtin_amdgcn_sched_barrier(0); \
                  HY_MMA(waA, wbA, bqA); \
                  __builtin_amdgcn_sched_barrier(0); \
                  if (d + 32 <= dC) HY_LOAD(RB, d + 32, waA, wbA, bqA); \
                  __builtin_amdgcn_sched_barrier(0); \
                  if (d + 16 <= dC) HY_MMA(waB, wbB, bqB); \
                  __builtin_amdgcn_sched_barrier(0); } } \
            _Pragma("unroll 1") for (int d = dC + 16; d <= dD; d += 16) HY_STEP_COND(RB, d); \
        } else if (ntile > 0) { const int dhi = T0w + 128 * (ntile - 1) + 96; \
            _Pragma("unroll 1") for (int d = T0w - n + 16; d <= dhi; d += 16) HY_STEP_COND(RB, d); } } while (0)
    HY_CONV(R1);
#pragma unroll
    for (int m = 0; m < 4; ++m) if (m < ntile) {
#pragma unroll
        for (int rg = 0; rg < 4; ++rg) { const int t4 = T0w + 128 * m + 32 * jb + 8 * rg + 4 * kg;
            const v2u xv = *(const v2u*)(x1g + (size_t)bb * n + t4); const v2u vv = *(const LAS v2u*)(XB + bb * HY_ROWB + 2 * (HY_MARG + t4));
            const float y0 = bflo(xv.x) * (acc[m][4 * rg + 0] + bias0 * bflo(vv.x)), y1 = bfhi(xv.x) * (acc[m][4 * rg + 1] + bias0 * bfhi(vv.x));
            const float y2 = bflo(xv.y) * (acc[m][4 * rg + 2] + bias0 * bflo(vv.y)), y3 = bfhi(xv.y) * (acc[m][4 * rg + 3] + bias0 * bfhi(vv.y));
            y1p[m][rg].x = pk2(y0, y1); y1p[m][rg].y = pk2(y2, y3); } }
    __syncthreads();
#pragma unroll
    for (int m = 0; m < 4; ++m) if (m < ntile) {
#pragma unroll
        for (int rg = 0; rg < 4; ++rg) { const int t4 = T0w + 128 * m + 32 * jb + 8 * rg + 4 * kg; *(LAS v2u*)(XB + bb * HY_ROWB + 2 * (HY_MARG + t4)) = y1p[m][rg]; } }
    __syncthreads();
    HY_CONV(R2);
#pragma unroll
    for (int m = 0; m < 4; ++m) if (m < ntile) {
#pragma unroll
        for (int rg = 0; rg < 4; ++rg) { const int t4 = T0w + 128 * m + 32 * jb + 8 * rg + 4 * kg;
            const v2u xv = *(const v2u*)(x2g + (size_t)bb * n + t4); const v2u yv = y1p[m][rg];
            const float o0 = bflo(xv.x) * (acc[m][4 * rg + 0] + bias1 * bflo(yv.x)), o1 = bfhi(xv.x) * (acc[m][4 * rg + 1] + bias1 * bfhi(yv.x));
            const float o2 = bflo(xv.y) * (acc[m][4 * rg + 2] + bias1 * bflo(yv.y)), o3 = bfhi(xv.y) * (acc[m][4 * rg + 3] + bias1 * bfhi(yv.y));
            v2u ov; ov.x = pk2(o0, o1); ov.y = pk2(o2, o3); *(v2u*)(vg + (size_t)bb * n + t4) = ov; } }
    __syncthreads();
#undef HY_CONV
#undef HY_AFRAG
#undef HY_STEP_COND
#undef HY_LOAD
#undef HY_MMA
}
__device__ __forceinline__ void stage_mixer(const Ctx& F, int l) {
    unsigned* ctr = (unsigned*)(F.a->ws + WS_CTL) + CW_WORK + 64 * l;
    LAS int* itb = (LAS int*)(F.lds + LDSCTL_OFF + 512);
    const int nit = 128 + 512 + (l == 0 ? 512 : 0);
#ifdef PROBE_STATIC
    return;
#endif
    for (;;) {
        if (F.tid == 0) *itb = (int)__hip_atomic_fetch_add(ctr, 1u, __ATOMIC_RELAXED, __HIP_MEMORY_SCOPE_AGENT);
        __syncthreads();
        const int it = *itb;
        __syncthreads();
        if (it >= nit) break;
        Ctx Fi; Fi.a = kargs(); Fi.tid = opaque_v((int)threadIdx.x); Fi.lane = Fi.tid & 63; Fi.wave = __builtin_amdgcn_readfirstlane(Fi.tid >> 6); Fi.bid = opaque((int)blockIdx.x); Fi.G = opaque((int)gridDim.x);
        Fi.lds = (LAS unsigned char*)((LAS unsigned char*)0 + opaque(0)) + (F.lds - (LAS unsigned char*)0);
#ifdef PROBE_T
        if (l == 0 && F.tid == 0 && it == 5) ((unsigned long long*)(F.a->ws + WS_CTL + CW_STAMP * 4))[21] = __builtin_amdgcn_s_memrealtime();
        if (l == 0 && F.tid == 0 && it == 300) ((unsigned long long*)(F.a->ws + WS_CTL + CW_STAMP * 4))[23] = __builtin_amdgcn_s_memrealtime();
#endif
        if (it < 128) { for (int rep = 0; rep < ((DUPK == 9) ? 2 : 1); ++rep) rw_chunk_item2(Fi, opaque(l), it); }
        else if (it < 640) hyena_item(Fi, opaque(l), it - 128, 0);
        else hyena_item(Fi, opaque(l), it - 640, 1);
#ifdef PROBE_T
        if (l == 0 && F.tid == 0 && it == 5) ((unsigned long long*)(F.a->ws + WS_CTL + CW_STAMP * 4))[22] = __builtin_amdgcn_s_memrealtime();
        if (l == 0 && F.tid == 0 && it == 300) ((unsigned long long*)(F.a->ws + WS_CTL + CW_STAMP * 4))[24] = __builtin_amdgcn_s_memrealtime();
#endif
    }
}

typedef float f32x16r __attribute__((ext_vector_type(16)));
__device__ __forceinline__ void stage_norm2_router(const Ctx& F, int l, int nrows) {
    const auto& a = *F.a; unsigned char* ws = a.ws; const int lane = F.lane;
    const float* X = (const float*)(ws + WS_X); bf16* H = (bf16*)(ws + WS_H); const float* MOD = (const float*)(ws + WS_MOD);
    int* EIDX = (int*)(ws + WS_EIDX); float* GATE = (float*)(ws + WS_GATE); int* BLKCNT = (int*)(ws + WS_BLKCNT);
    LAS float* lg = (LAS float*)(F.lds + F.wave * 4352);
    LAS int* hist = (LAS int*)(F.lds + LDSCTL_OFF + 1024);
    if (F.tid < 32) hist[F.tid] = 0;
    __syncthreads();
    const int rpb = (nrows + F.G - 1) / F.G, r0 = F.bid * rpb, r1 = (r0 + rpb < nrows) ? r0 + rpb : nrows;
    const float* rw = a.in[I_RTW] + (size_t)l * 1024 * 32;
    const int i = lane & 31, kk = lane >> 5;
    const f32x4* ng = (const f32x4*)(a.in[I_N2G] + l * D) + kk;
    for (int rb = r0 + F.wave * 32; rb < r1; rb += NWAVES * 32) {
        const int nrow = (r1 - rb) < 32 ? (r1 - rb) : 32; const bool live = i < nrow;
        const int row = live ? rb + i : r1 - 1; const int w = row < T_LAT ? (row >> 12) : 8;
        const f32x4* xr = (const f32x4*)(X + (size_t)row * D) + kk;
        float ss = 0.f;
#pragma unroll 8
        for (int q = 0; q < 128; ++q) { const f32x4 v = xr[2 * q]; ss += (v[0] * v[0] + v[1] * v[1]) + (v[2] * v[2] + v[3] * v[3]); }
        ss += __builtin_bit_cast(float, __builtin_amdgcn_ds_bpermute((lane ^ 32) << 2, __builtin_bit_cast(int, ss)));
        const float rstd = 1.0f / sqrtf(ss * (1.f / D) + 1e-6f);
        const f32x4* sh = (const f32x4*)(MOD + (size_t)(l * 9 + w) * 6144 + 3072) + kk; const f32x4* sc = (const f32x4*)(MOD + (size_t)(l * 9 + w) * 6144 + 4096) + kk;
        v2u* ho = (v2u*)(H + (size_t)row * D) + kk;
        f32x16r acc;
#pragma unroll
        for (int e = 0; e < 16; ++e) acc[e] = 0.f;
        const float* wp = rw + (size_t)(4 * kk) * 32 + i;
#pragma unroll 2
        for (int q = 0; q < 128; ++q) {
            const f32x4 xv = xr[2 * q]; const f32x4 h4 = xv * rstd * ng[2 * q] * (sc[2 * q] + 1.0f) + sh[2 * q];
            const float w0 = wp[(size_t)(8 * q) * 32], w1 = wp[(size_t)(8 * q + 1) * 32], w2 = wp[(size_t)(8 * q + 2) * 32], w3 = wp[(size_t)(8 * q + 3) * 32];
            if (live) { v2u o; o.x = pk2(h4[0], h4[1]); o.y = pk2(h4[2], h4[3]); ho[2 * q] = o; }
            acc = __builtin_amdgcn_mfma_f32_32x32x2f32(h4[0], w0, acc, 0, 0, 0);
            acc = __builtin_amdgcn_mfma_f32_32x32x2f32(h4[1], w1, acc, 0, 0, 0);
            acc = __builtin_amdgcn_mfma_f32_32x32x2f32(h4[2], w2, acc, 0, 0, 0);
            acc = __builtin_amdgcn_mfma_f32_32x32x2f32(h4[3], w3, acc, 0, 0, 0);
        }
        const float rbias = a.in[I_RTB][l * 32 + i];
#pragma unroll
        for (int r = 0; r < 16; ++r) { const int ri = (r & 3) + 8 * (r >> 2) + 4 * kk; lg[ri * 33 + i] = acc[r] + rbias; }
        LDS_WAIT(); asm volatile("" ::: "memory");
        if (lane < nrow) {
            LAS float* lr = lg + lane * 33; const int orow = rb + lane;
            float tv[4]; int ti[4];
#pragma unroll
            for (int r = 0; r < 4; ++r) { float bv = -INFINITY; int bi = 0;
#pragma unroll 8
                for (int e = 0; e < 32; ++e) { const float v = lr[e]; if (v > bv) { bv = v; bi = e; } }
                tv[r] = bv; ti[r] = bi; lr[bi] = -INFINITY; }
            const float e1 = expf(tv[1] - tv[0]), e2 = expf(tv[2] - tv[0]), e3 = expf(tv[3] - tv[0]); const float inv = 1.0f / (1.0f + e1 + e2 + e3);
            *(int4*)(EIDX + orow * 4) = make_int4(ti[0], ti[1], ti[2], ti[3]); *(f32x4*)(GATE + orow * 4) = (f32x4){inv, e1 * inv, e2 * inv, e3 * inv};
#pragma unroll
            for (int r = 0; r < 4; ++r) __hip_atomic_fetch_add(&hist[ti[r]], 1, __ATOMIC_RELAXED, __HIP_MEMORY_SCOPE_WORKGROUP);
        }
        LDS_WAIT(); asm volatile("" ::: "memory");
    }
    __syncthreads();
    if (F.tid < 32) BLKCNT[F.bid * 32 + F.tid] = hist[F.tid];
    __syncthreads();
}

__device__ __forceinline__ void stage_moe_scatter(const Ctx& F, int l, int nrows) {
    const auto& a = *F.a; unsigned char* ws = a.ws; const int lane = F.lane;
    const bf16* H = (const bf16*)(ws + WS_H); bf16* XS = (bf16*)(ws + WS_XS);
    const int* EIDX = (const int*)(ws + WS_EIDX); int* POS = (int*)(ws + WS_POS); const int* BLKCNT = (const int*)(ws + WS_BLKCNT); int* META = (int*)(ws + WS_META);
    LAS int* tot = (LAS int*)F.lds; LAS int* off = tot + 32; LAS int* base = tot + 64; LAS int* posl = tot + 128; LAS int* eloc = tot + 4096;
    const int rpb = (nrows + F.G - 1) / F.G, r0 = F.bid * rpb, r1 = (r0 + rpb < nrows) ? r0 + rpb : nrows; const int na = (r1 > r0) ? (r1 - r0) * 4 : 0;
    for (int i = F.tid; i < na; i += NTHREADS) eloc[i] = EIDX[r0 * 4 + i];
    { LAS int* part = tot + 8192; const int e = F.tid & 31, pt = F.tid >> 5; int t = 0, o = 0;
      for (int b2 = pt; b2 < F.G; b2 += 16) { const int c = BLKCNT[b2 * 32 + e]; t += c; o += (b2 < F.bid) ? c : 0; }
      part[pt * 32 + e] = t; part[512 + pt * 32 + e] = o; }
    __syncthreads();
    if (F.tid < 32) { LAS int* part = tot + 8192; int t = 0, o = 0;
#pragma unroll
        for (int pt = 0; pt < 16; ++pt) { t += part[pt * 32 + F.tid]; o += part[512 + pt * 32 + F.tid]; }
        tot[F.tid] = t; off[F.tid] = o; }
    __syncthreads();
    if (F.tid == 0) { int acc = 0; for (int e = 0; e < 32; ++e) { base[e] = acc; acc += (tot[e] + 255) & ~255; } base[32] = acc; }
    __syncthreads();
    if (F.bid == 0 && F.tid < 33) META[F.tid] = base[F.tid];
    unsigned* ROWOF = (unsigned*)(ws + WS_ROWOF);
    if (F.tid < 32) { int run = base[F.tid] + off[F.tid]; for (int i = 0; i < na; ++i) { if (eloc[i] == F.tid) { POS[r0 * 4 + i] = run; ROWOF[run] = (unsigned)(r0 + (i >> 2)) * (unsigned)(D * 2); ++run; } } }
    for (int e = F.bid; e < 32; e += F.G) for (int i = base[e] + tot[e] + F.tid; i < base[e + 1]; i += NTHREADS) ROWOF[i] = 0u;
    __syncthreads();
}
__device__ __forceinline__ LAS int* load_moe_base(const Ctx& F) {
    LAS int* base = (LAS int*)(F.lds + LDSCTL_OFF + 256);
    const int* META = (const int*)(F.a->ws + WS_META);
    if (F.tid < 33) base[F.tid] = META[F.tid];
    __syncthreads();
    return base;
}

constexpr int NSTAGE_L = 13, NSTAGES = 1 + DEPTH * NSTAGE_L + 1;
__global__ void __launch_bounds__(NTHREADS, 2) mk_fwd(Args args) {
    extern __shared__ __attribute__((aligned(16))) unsigned char lds_raw[];
    Ctx F; F.a = kargs(); F.lds = (LAS unsigned char*)lds_raw; F.tid = threadIdx.x; F.lane = F.tid & 63; F.wave = __builtin_amdgcn_readfirstlane(F.tid >> 6); F.bid = blockIdx.x; F.G = gridDim.x;
    volatile LAS unsigned* MISC = (volatile LAS unsigned*)(F.lds + LDSCTL_OFF);
    for (int u = F.tid; u < (LDS_BYTES - LDSCTL_OFF) / 4; u += NTHREADS) ((LAS unsigned*)(F.lds + LDSCTL_OFF))[u] = 0u;
    __syncthreads();
#if MK_PER_STAGE
#define GRID_BAR() do { } while (0)
#else
    (void)xcd_barrier_post((unsigned*)(F.a->ws + WS_CTL) + CW_BAR, MISC + 8);
#define GRID_BAR() do { XcdBarrier b_; b_.bar = (unsigned*)(kargs()->ws + WS_CTL) + CW_BAR; b_.x = xb_xcc_id(); b_.st = (volatile LAS unsigned*)((LAS unsigned char*)lds_raw + LDSCTL_OFF + opaque(32)); xcd_barrier(b_); } while (0)
#endif
#ifndef ONLY_S
#define ONLY_S -1
#endif
#define STG_SEL(k) (ONLY_S < 0 || ONLY_S == (((k) == 0) ? 0 : ((k) == NSTAGES - 1 ? 14 : (((k) - 1) % NSTAGE_L) + 1)))
#if MK_PER_STAGE
#define IN(k) (STG_SEL(k) && kargs()->ph_lo == (k))
#else
#define IN(k) STG_SEL(k)
#endif
#if MK_PER_STAGE
#define SEAM(k) do { } while (0)
#else
#define SEAM(k) do { if ((k) + 1 < NSTAGES) GRID_BAR(); } while (0)
#endif
#define STAGE(k) if (IN(k)) { F.a = kargs(); F.tid = opaque_v((int)threadIdx.x); F.lane = F.tid & 63; F.wave = __builtin_amdgcn_readfirstlane(F.tid >> 6); F.bid = opaque((int)blockIdx.x); F.G = opaque((int)gridDim.x); F.lds = (LAS unsigned char*)lds_raw + opaque(0); unsigned char* ws = F.a->ws; const int l = opaque(lq); unsigned char* wl = ws + WS_WTS + (size_t)l * WL_STRIDE; (void)wl; (void)ws;
#define STAGE_END(k) } SEAM(k);
    int lq = 0;
    STAGE(0) p0_prologue(F); STAGE_END(0)
    for (lq = 0; lq < DEPTH; ++lq) {
        const int sb = 1 + lq * NSTAGE_L;
        const int nrl = opaque((lq == DEPTH - 1) ? T_LAT : T_ALL);
        STAGE(sb + 0) stage_norm1(F, l); STAGE_END(sb + 0)
        STAGE(sb + 1) pg8::SchedStatic S; S.init(ws + WS_H, wl + WO_WIN, T_ALL, IN_COLS, 1024, F.G, F.bid); pg8::EpiBf16 E{(bf16*)(ws + WS_Z), IN_COLS, nullptr, 0};
            pg8::gemm_phase(F.lds, F.tid, 1024, S, E); STAGE_END(sb + 1)
        STAGE(sb + 2) for (int rep = 0; rep < REPN(1); ++rep) stage_rw_prep1(F, l); for (int rep = 0; rep < REPN(2); ++rep) stage_s5_scan<0>(F, l); for (int rep = 0; rep < REPN(3); ++rep) stage_hy_pre(F, l, nrl); STAGE_END(sb + 2)
        STAGE(sb + 3) { pg8::SchedStatic S; S.init(ws + WS_ARW, wl + WO_RWCAT, T_ALL, 2560, 256, F.G, F.bid); pg8::EpiBf16 E{(bf16*)(ws + WS_P), 2560, nullptr, 0}; PT(4); pg8::gemm_phase(F.lds, F.tid, 256, S, E); PT(5); }
            for (int rep = 0; rep < REPN(4); ++rep) stage_s5_scan<1>(F, l); STAGE_END(sb + 3)
        STAGE(sb + 4) for (int rep = 0; rep < REPN(5); ++rep) stage_rw_prep2(F, l); for (int rep = 0; rep < REPN(6); ++rep) stage_s5_prep(F, l, nrl); STAGE_END(sb + 4)
        STAGE(sb + 5) PT(10); stage_mixer(F, l); PT(11); STAGE_END(sb + 5) STAGE(sb + 5) PT(12); }
        STAGE(sb + 6) { pg8::SchedStatic S; S.init(ws + WS_AS5, wl + WO_GLU, nrl, 1024, 512, F.G, F.bid); pg8::EpiGlu<0> E{(bf16*)(ws + WS_YS5), 512, F.a->in[I_S5GLUB] + l * 1024, 0, 512}; PT(13); pg8::gemm_phase(F.lds, F.tid, 512, S, E); PT(14); }
            for (int rep = 0; rep < REPN(7); ++rep) stage_rw_readout(F, l); for (int rep = 0; rep < REPN(8); ++rep) stage_hy_post(F, l, nrl); STAGE_END(sb + 6)
        STAGE(sb + 7) pg8::SchedMerge S; S.A0 = (const char*)(ws + WS_YHY); S.A1 = (const char*)(ws + WS_YRW); S.A2 = (const char*)(ws + WS_YS5); S.Bt = (const char*)(wl + WO_WBR); S.tstep = (size_t)256 * 512 * 2; S.bstride = (size_t)1024 * 512 * 2;
            S.nM = nrl / 256; S.nN = 4; S.G = F.G; S.c = F.bid;
            pg8::EpiMerge E{(float*)(ws + WS_MTMP), (bf16*)(ws + WS_H), (const bf16*)(ws + WS_Z) + GATE_OFF}; pg8::gemm_phase(F.lds, F.tid, 512, S, E); STAGE_END(sb + 7)
        STAGE(sb + 8) pg8::SchedStatic S; S.init(ws + WS_H, wl + WO_WOUT, nrl, 1024, 1024, F.G, F.bid); pg8::EpiResid E{(float*)(ws + WS_X), (const float*)(ws + WS_MOD) + (size_t)l * 9 * 6144 + 2048};
            pg8::gemm_phase(F.lds, F.tid, 1024, S, E); STAGE_END(sb + 8)
        STAGE(sb + 9) PT(17); stage_norm2_router(F, l, nrl); PT(18); STAGE_END(sb + 9)
        STAGE(sb + 10) PT(19); stage_moe_scatter(F, l, nrl); PT(20); STAGE_END(sb + 10)
        STAGE(sb + 11) LAS int* base = load_moe_base(F);
            pg8::SchedMoeG S; S.A = (const char*)(ws + WS_H); S.rowof = (const unsigned*)(ws + WS_ROWOF); S.Bt = (const char*)(wl + WO_W1); S.tstep = (size_t)256 * 1024 * 2; S.estride = (size_t)2048 * 1024 * 2; S.NPN = 8; S.G = F.G; S.c = F.bid; S.base = base;
            pg8::EpiGlu<1> E{(bf16*)(ws + WS_ACT), 1024, F.a->in[I_B1] + (size_t)l * 32 * 2048, 2048, 1024}; pg8::gemm_phase(F.lds, F.tid, 1024, S, E); STAGE_END(sb + 11)
        STAGE(sb + 12) LAS int* base = load_moe_base(F);
            pg8::SchedMoe S; S.A = (const char*)(ws + WS_ACT); S.Bt = (const char*)(wl + WO_W2); S.tstep = (size_t)256 * 1024 * 2; S.estride = (size_t)1024 * 1024 * 2; S.NPN = 4; S.G = F.G; S.c = F.bid; S.base = base;
            pg8::EpiBf16 E{(bf16*)(ws + WS_XS), 1024, F.a->in[I_B2] + (size_t)l * 32 * 1024, 1024}; pg8::gemm_phase(F.lds, F.tid, 1024, S, E); STAGE_END(sb + 12)
    }
    lq = DEPTH;
    STAGE(NSTAGES - 1)
#ifndef PROBE_T
        stage_norm1(F, l);
#endif
#ifdef PROBE_T
        { const unsigned long long* st = (const unsigned long long*)(F.a->ws + WS_CTL + CW_STAMP * 4); const float cval = (float)(long long)(st[PROBE_B] - st[PROBE_A]) * (1.0f / (100.0f * PROBE_DIV));
          __syncthreads(); for (size_t i = (size_t)F.bid * NTHREADS + F.tid; i < (size_t)T_LAT * D; i += (size_t)F.G * NTHREADS) F.a->out[i] = cval; }
#endif
    }
#undef IN
#undef SEAM
}

extern "C" void kernel_launch(void* const* d_in, const int* in_sizes, int n_in, void* d_out, int out_size, void* d_ws, size_t ws_size, hipStream_t stream) {
    static int grid = 0;
    if (grid == 0) {
        if (n_in != 51 || out_size != T_LAT * D || ws_size < WS_END) { fprintf(stderr, "kernel_launch: unexpected shapes (n_in %d out %d ws %zu, need %zu)\n", n_in, out_size, ws_size, (size_t)WS_END); grid = -1; return; }
        int dev = 0, cus = 0, per_cu = 0;
        if (hipGetDevice(&dev) != hipSuccess || hipDeviceGetAttribute(&cus, hipDeviceAttributeMultiprocessorCount, dev) != hipSuccess) { grid = -1; return; }
        if (hipFuncSetAttribute((const void*)mk_fwd, hipFuncAttributeMaxDynamicSharedMemorySize, LDS_BYTES) != hipSuccess) { fprintf(stderr, "kernel_launch: hipFuncSetAttribute failed\n"); grid = -1; return; }
        if (hipOccupancyMaxActiveBlocksPerMultiprocessor(&per_cu, (const void*)mk_fwd, NTHREADS, LDS_BYTES) != hipSuccess || per_cu < 1) fprintf(stderr, "kernel_launch: occupancy query says %d\n", per_cu);
        (void)hipGetLastError();
        grid = cus;
    }
    if (grid < 0) return;
    if (hipMemsetAsync((char*)d_ws + WS_CTL, 0, CTL_ZERO_BYTES, stream) != hipSuccess) return;
    Args a{};
    for (int i = 0; i < 51; ++i) a.in[i] = (const float*)d_in[i];
    a.out = (float*)d_out; a.ws = (unsigned char*)d_ws;
#if MK_PER_STAGE
    for (int s = 0; s < NSTAGES; ++s) { a.ph_lo = s; a.ph_hi = s + 1; int reps = 1;
#ifdef PROBE_SET
        { const int ls = (s == 0 || s == NSTAGES - 1) ? -1 : (s - 1) % NSTAGE_L;
          if (PROBE_SET >= 1 && PROBE_SET <= 13 && ls == PROBE_SET - 1 && ls != 5 && ls != 8 && !(ls == 0 && s > 1)) reps = 3;
          if (PROBE_SET == 14 && s == 0) reps = 3; }
#endif
        for (int r = 0; r < reps; ++r) hipLaunchKernelGGL(mk_fwd, dim3(grid), dim3(NTHREADS), LDS_BYTES, stream, a); }
#else
    a.ph_lo = 0; a.ph_hi = NSTAGES; hipLaunchKernelGGL(mk_fwd, dim3(grid), dim3(NTHREADS), LDS_BYTES, stream, a);
#endif
}
```

```cpp
#include <hip/hip_runtime.h>
#include <cstdio>
#include <cstdint>

#ifndef DUPK
#define DUPK 0
#endif
#define REPN(k) ((DUPK == (k)) ? 3 : 1)
#ifndef REP_GEMM
#define REP_GEMM 1
#endif
#ifndef REP_LIGHT
#define REP_LIGHT 1
#endif
#ifndef REP_PRO
#define REP_PRO 1
#endif
#ifndef MK_PER_STAGE
#define MK_PER_STAGE 0
#endif

#define GAS __attribute__((address_space(1)))
#define LAS __attribute__((address_space(3)))
typedef unsigned short bf16;
typedef unsigned v4u __attribute__((ext_vector_type(4)));
typedef unsigned v2u __attribute__((ext_vector_type(2)));
typedef float f32x4 __attribute__((ext_vector_type(4)));
typedef float f32x2 __attribute__((ext_vector_type(2)));
typedef short bf16x8 __attribute__((ext_vector_type(8)));

constexpr int D = 1024, BATCH = 8, SEQ = 4096, CTXL = 256, DEPTH = 2;
constexpr int T_LAT = BATCH * SEQ, T_CTX = BATCH * CTXL, T_ALL = T_LAT + T_CTX;
constexpr int IN_COLS = 6912, HY_OFF = 0, RW_OFF = 1536, S5_OFF = 3328, GATE_OFF = 3840;
constexpr int NE = 32, TOPK = 4;
constexpr int MAXSLOT = 147456;
constexpr int NWAVES = 8, NTHREADS = 512;
constexpr int HY_MARG = 128, HY_ROWB = 8720, HY_RLEN = 8272, HY_RLENC = 592;
constexpr int HY_R1_OFF = 8 * HY_ROWB, HY_R2_OFF = HY_R1_OFF + HY_RLEN * 2;

constexpr size_t MiB = 1ull << 20;
constexpr size_t WS_CTL = 0, CTL_ZERO_BYTES = 1 * MiB;
constexpr size_t WS_MOD = 1 * MiB;
constexpr size_t WS_BLKCNT = 2 * MiB;
constexpr size_t WS_META = 2 * MiB + 512 * 1024;
constexpr size_t WS_ROWOF = 7 * MiB;
constexpr size_t WS_EIDX = 3 * MiB, WS_GATE = 4 * MiB, WS_POS = 5 * MiB;
constexpr size_t WS_WTS = 8 * MiB, WL_STRIDE = 214 * MiB;
constexpr size_t WO_WIN = 0, WO_RWCAT = 14 * MiB, WO_GLU = 16 * MiB, WO_WBR = 17 * MiB, WO_WOUT = 20 * MiB, WO_W1 = 22 * MiB, WO_W2 = 150 * MiB;
constexpr size_t WS_GF = 436 * MiB, GF_STRIDE = 20 * MiB, GF_CTX = 17 * MiB;
constexpr size_t WS_X = 504 * MiB;
constexpr size_t WS_H = 640 * MiB;
constexpr size_t WS_BIG = 708 * MiB;
constexpr size_t WS_Z = WS_BIG;
constexpr size_t WS_SCN = 1167 * MiB;
constexpr size_t WS_MTMP = WS_SCN;
constexpr size_t WS_P = 1473 * MiB;
constexpr size_t WS_ARW = 1643 * MiB;
constexpr size_t WS_YP = 1660 * MiB;
constexpr size_t WS_YDIR = WS_YP;
constexpr size_t WS_UT = 1796 * MiB;
constexpr size_t WS_AS5 = 2000 * MiB;
constexpr size_t WS_YHY = 1898 * MiB, WS_YRW = 1932 * MiB, WS_YS5 = 1966 * MiB;
constexpr size_t WS_XS = WS_BIG;
constexpr size_t WS_ACT = WS_BIG + 288 * MiB;
constexpr size_t WS_END = 2034 * MiB;
constexpr int CW_BAR = 4096;

constexpr int RING_BYTES = 131072;
constexpr int LDSCTL_OFF = RING_BYTES;
constexpr int LDS_BYTES = 163840;

typedef __bf16 bf16x2_t __attribute__((ext_vector_type(2)));
__device__ __forceinline__ unsigned pk2(float lo, float hi) { const bf16x2_t v = __builtin_convertvector((f32x2){lo, hi}, bf16x2_t); return __builtin_bit_cast(unsigned, v); }
__device__ __forceinline__ unsigned f2bf(float f) { return pk2(f, 0.f) & 0xffffu; }
__device__ __forceinline__ float bf2f(bf16 b) { return __builtin_bit_cast(float, ((unsigned)b) << 16); }
__device__ __forceinline__ float bflo(unsigned w) { return __builtin_bit_cast(float, w << 16); }
__device__ __forceinline__ float bfhi(unsigned w) { return __builtin_bit_cast(float, w & 0xffff0000u); }
__device__ __forceinline__ float sigm(float x) { return 1.f / (1.f + __expf(-x)); }
#define LDS_WAIT() asm volatile("s_waitcnt lgkmcnt(0)" ::: "memory")
__device__ __forceinline__ float dpp_f(float x, const int ctrl_sel) {
    const int v = __builtin_bit_cast(int, x);
    int r;
    if (ctrl_sel == 0) r = __builtin_amdgcn_update_dpp(0, v, 0xB1, 0xF, 0xF, true);
    else if (ctrl_sel == 1) r = __builtin_amdgcn_update_dpp(0, v, 0x4E, 0xF, 0xF, true);
    else r = __builtin_amdgcn_update_dpp(0, v, 0x141, 0xF, 0xF, true);
    return __builtin_bit_cast(float, r);
}
__device__ __forceinline__ float red32(float x) {
    x += dpp_f(x, 0); x += dpp_f(x, 1); x += dpp_f(x, 2);
    x += __builtin_bit_cast(float, __builtin_amdgcn_update_dpp(0, __builtin_bit_cast(int, x), 0x128, 0xF, 0xF, true));
    x += __builtin_bit_cast(float, __builtin_amdgcn_ds_swizzle(__builtin_bit_cast(int, x), 0x401F));
    return x;
}
__device__ __forceinline__ float wave_sum(float v) {
    v = red32(v);
    return __builtin_bit_cast(float, __builtin_amdgcn_readlane(__builtin_bit_cast(int, v), 0)) + __builtin_bit_cast(float, __builtin_amdgcn_readlane(__builtin_bit_cast(int, v), 32));
}
__device__ __forceinline__ int xch32(int v, const int step) {
    if (step == 0) return __builtin_amdgcn_update_dpp(0, v, 0xB1, 0xF, 0xF, true);
    if (step == 1) return __builtin_amdgcn_update_dpp(0, v, 0x4E, 0xF, 0xF, true);
    if (step == 2) return __builtin_amdgcn_update_dpp(0, v, 0x141, 0xF, 0xF, true);
    if (step == 3) return __builtin_amdgcn_update_dpp(0, v, 0x128, 0xF, 0xF, true);
    return __builtin_amdgcn_ds_swizzle(v, 0x401F);
}
__device__ __forceinline__ float red8(float x) { x += dpp_f(x, 0); x += dpp_f(x, 1); x += dpp_f(x, 2); return x; }

#define XB_TMO      128
#define XB_XCNT(j)  (256  + 64 * (j))
#define XB_XSUB(j)  (1280 + 64 * (j))
#define XB_XGEN(j)  (2304 + 64 * (j))
#define XB_TOP      3328
#define XB_TOPGEN   3392
#define XCD_BAR_WORDS 3456
#define XB_SPIN_CAP (1u << 22)
__device__ __forceinline__ unsigned xb_ld(unsigned* p)              { return __hip_atomic_load(p, __ATOMIC_RELAXED, __HIP_MEMORY_SCOPE_AGENT); }
__device__ __forceinline__ unsigned xb_add(unsigned* p, unsigned v) { return __hip_atomic_fetch_add(p, v, __ATOMIC_RELAXED, __HIP_MEMORY_SCOPE_AGENT); }
__device__ __forceinline__ unsigned xb_xcc_id() { return (unsigned)__builtin_amdgcn_s_getreg((3 << 11) | 20) & 0xFu; }
#define XB_SPIN(cond, bar) do { unsigned _sp = 0; while (cond) { __builtin_amdgcn_s_sleep(1); \
    if ((++_sp & 255u) == 0u) { if (xb_ld(&(bar)[XB_TMO])) break; if (_sp > XB_SPIN_CAP) { atomicAdd(&(bar)[XB_TMO], 1u); break; } } } } while (0)
struct XcdBarrier { unsigned* bar; unsigned x; volatile LAS unsigned* st; };
__device__ __forceinline__ XcdBarrier xcd_barrier_post(unsigned* bar, volatile LAS unsigned* st) {
    XcdBarrier b; b.bar = bar; b.x = xb_xcc_id(); b.st = st;
    if (threadIdx.x == 0) (void)xb_add(&bar[XB_XCNT(b.x)], 1u);
    return b;
}
__device__ __forceinline__ void xcd_barrier_complete(unsigned* bar, unsigned x, unsigned& nloc, unsigned& nx) {
    const unsigned G = gridDim.x * gridDim.y * gridDim.z;
    unsigned sum, cnt, mine, sp = 0u;
    for (;;) {
        sum = 0u; cnt = 0u; mine = 0u;
#pragma unroll
        for (unsigned j = 0; j < 16; ++j) { const unsigned c = xb_ld(&bar[XB_XCNT(j)]); sum += c; cnt += (c > 0u) ? 1u : 0u; mine = (j == x) ? c : mine; }
        if (sum == G) break;
        __builtin_amdgcn_s_sleep(1);
        if ((++sp & 255u) == 0u) { if (xb_ld(&bar[XB_TMO])) break; if (sp > XB_SPIN_CAP) { atomicAdd(&bar[XB_TMO], 1u); break; } }
    }
    nloc = mine > 0u ? mine : 1u; nx = cnt > 0u ? cnt : 1u;
}
__device__ __forceinline__ void xcd_barrier(const XcdBarrier& b) {
    asm volatile("s_waitcnt vmcnt(0)" ::: "memory");
    __syncthreads();
    if (threadIdx.x == 0) {
        unsigned* bar = b.bar;
        __builtin_amdgcn_s_waitcnt(0);
        unsigned nloc = b.st[0], nx = b.st[1];
        if (nloc == 0u) { xcd_barrier_complete(bar, b.x, nloc, nx); b.st[0] = nloc; b.st[1] = nx; }
        const unsigned old = xb_add(&bar[XB_XSUB(b.x)], 1u);
        const unsigned gen = old / nloc;
        if (old + 1u == (gen + 1u) * nloc) {
            __builtin_amdgcn_fence(__ATOMIC_RELEASE, "agent");
            asm volatile("s_waitcnt vmcnt(0)" ::: "memory");
            const unsigned og = xb_add(&bar[XB_TOP], 1u);
            const unsigned tg = og / nx;
            if (og + 1u == (tg + 1u) * nx) xb_add(&bar[XB_TOPGEN], 1u);
            else XB_SPIN(xb_ld(&bar[XB_TOPGEN]) == tg, bar);
            __builtin_amdgcn_fence(__ATOMIC_ACQUIRE, "agent");
            xb_add(&bar[XB_XGEN(b.x)], 1u);
            asm volatile("s_waitcnt vmcnt(0)" ::: "memory");
        } else {
            XB_SPIN(xb_ld(&bar[XB_XGEN(b.x)]) == gen, bar);
            __builtin_amdgcn_fence(__ATOMIC_ACQUIRE, "agent");
            asm volatile("s_waitcnt vmcnt(0)" ::: "memory");
        }
    }
    __syncthreads();
}

namespace pg8 {
constexpr int BM = 256, BK = 64, HALF = 128, HTB = HALF * BK * 2, STAGE_BYTES = 8 * HTB, NXCD = 8, WGM = 8, ROWTAB_OFF = 131072 + 4096;
__host__ __device__ __forceinline__ int lds_byte(int r, int c) { const int st = (r >> 4) * 2 + (c >> 5), rr = r & 15, cc = c & 31, ob = rr * 64 + cc * 2; return st * 1024 + (ob ^ (((ob >> 9) & 1) << 5)); }
__host__ __device__ __forceinline__ void stage_rc(int b, int& R, int& C) { const int st = b / 1024, sb = b % 1024, swz = sb ^ (((sb >> 9) & 1) << 5); R = (st >> 1) * 16 + swz / 64; C = (st & 1) * 32 + (swz % 64) / 2; }
__host__ __device__ __forceinline__ int perm32(int rho) { const int n = rho >> 4, i = rho & 15; return 8 * (i >> 2) + 4 * n + (i & 3); }
struct Unit { int pm, pn, e; };
__device__ __forceinline__ unsigned cvt_pk_bf16(float lo, float hi) { return pk2(lo, hi); }

__device__ __forceinline__ void tile_of(int L, int nM, int nN, int& pm, int& pn) {
    const int nwg = nM * nN; int wgid = L;
    { const int q = nwg / NXCD, r = nwg % NXCD, xcd = wgid % NXCD, off = wgid / NXCD; wgid = (xcd < r ? xcd * (q + 1) : r * (q + 1) + (xcd - r) * q) + off; }
    const int nig = WGM * nN, gid = wgid / nig, fm = gid * WGM, gsz = (nM - fm) < WGM ? (nM - fm) : WGM;
    pm = fm + ((wgid % nig) % gsz); pn = (wgid % nig) / gsz;
}
struct SchedStatic {
    static constexpr bool GATHER = false;
    const char* A; const char* Bt; size_t tstep; int nM, nN, G, c;
    __device__ __forceinline__ void init(const void* A_, const void* Bt_, int M, int N, int K, int G_, int c_) { A = (const char*)A_; Bt = (const char*)Bt_; tstep = (size_t)BM * K * 2; nM = M / BM; nN = N / BM; G = G_; c = c_; }
    __device__ __forceinline__ bool next(int i, Unit& u) const { const long L = (long)i * G + c; if (L >= (long)nM * nN) return false; tile_of((int)L, nM, nN, u.pm, u.pn); u.e = 0; return true; }
    __device__ __forceinline__ const char* aptr(const Unit& u) const { return A + (size_t)u.pm * tstep; }
    __device__ __forceinline__ const char* bptr(const Unit& u) const { return Bt + (size_t)u.pn * tstep; }
};
struct SchedMerge {
    static constexpr bool GATHER = false;
    const char* A0; const char* A1; const char* A2; const char* Bt; size_t tstep, bstride; int nM, nN, G, c;
    __device__ __forceinline__ bool next(int i, Unit& u) const { const int j = i / 3, br = i - 3 * j; const long L = (long)j * G + c; if (L >= (long)nM * nN) return false; tile_of((int)L, nM, nN, u.pm, u.pn); u.e = br; return true; }
    __device__ __forceinline__ const char* aptr(const Unit& u) const { return (u.e == 0 ? A0 : (u.e == 1 ? A1 : A2)) + (size_t)u.pm * tstep; }
    __device__ __forceinline__ const char* bptr(const Unit& u) const { return Bt + (size_t)u.e * bstride + (size_t)u.pn * tstep; }
};
struct SchedMoe {
    static constexpr bool GATHER = false;
    const char* A; const char* Bt; size_t tstep, estride; int NPN, G, c; const LAS int* base;
    __device__ __forceinline__ bool next(int i, Unit& u) const {
        const int ntiles = base[32] >> 8; const int per = G >> 3;
        const long L = (long)i * G + (((G & 7) == 0) ? (c & 7) * per + (c >> 3) : c);
        if (L >= (long)ntiles * NPN) return false;
        u.pm = (int)(L / NPN); u.pn = (int)(L % NPN); const int r0 = u.pm << 8; int e = 0;
#pragma unroll 1
        for (int k = 1; k < 32; ++k) e += (r0 >= base[k]) ? 1 : 0;
        u.e = e; return true;
    }
    __device__ __forceinline__ const char* aptr(const Unit& u) const { return A + (size_t)u.pm * tstep; }
    __device__ __forceinline__ const char* bptr(const Unit& u) const { return Bt + (size_t)u.e * estride + (size_t)u.pn * tstep; }
};
struct SchedMoeG : SchedMoe {
    static constexpr bool GATHER = true;
    const unsigned* rowof;
    __device__ __forceinline__ const char* aptr(const Unit&) const { return A; }
};

template <class Epi, class Sched>
__device__ __forceinline__ void gemm_phase(LAS unsigned char* lds, const int tid, const int K, const Sched& S, const Epi& E) {
    const int wid = __builtin_amdgcn_readfirstlane(tid >> 6), lane = tid & 63, wr = wid >> 2, wc = wid & 3, fr = lane & 15, fq = lane >> 4;
    const int nt = K / BK;
    unsigned voffA[2], voffB[2];
#pragma unroll
    for (int i = 0; i < 2; ++i) { int R, C; stage_rc(tid * 16 + i * 8192, R, C); const int Rb = Epi::PERM ? ((R & ~31) + perm32(R & 31)) : R;
        voffA[i] = (unsigned)(R * K + C) * 2u; voffB[i] = (unsigned)(Rb * K + C) * 2u; }
    const size_t kstep = (size_t)(BK * 2);
    const size_t hstep = (size_t)HALF * K * 2;
    const unsigned ldsw = (unsigned)wid * 1024u;
    const int aoff = lds_byte(wr * 64 + fr, fq * 8), boff = lds_byte(wc * 32 + fr, fq * 8);
#define PG8_SA(b, h) (((b) * 2 + (h)) * HTB)
#define PG8_SB(b, h) ((4 + (b) * 2 + (h)) * HTB)
#define PG8_STAGE(bufoff, gbase, voff) do { _Pragma("unroll") for (int _i = 0; _i < 2; ++_i) \
        __builtin_amdgcn_global_load_lds((const unsigned*)((const char*)(gbase) + (voff)[_i]), (LAS unsigned*)(lds + (bufoff) + ldsw + _i * 8192), 16, 0, 0); } while (0)
#define PG8_STAGEA(bufoff, kp, h) do { if constexpr (Sched::GATHER) { _Pragma("unroll") for (int _i = 0; _i < 2; ++_i) \
        __builtin_amdgcn_global_load_lds((const unsigned*)((const char*)(kp) + g[2 * (h) + _i]), (LAS unsigned*)(lds + (bufoff) + ldsw + _i * 8192), 16, 0, 0); } \
        else { PG8_STAGE(bufoff, (kp) + (h) * hstep, voffA); } } while (0)
#define PG8_GLOAD(buf) do { const LAS unsigned* rt_ = (const LAS unsigned*)(lds + ROWTAB_OFF + (buf) * 1024) + gR0; _Pragma("unroll") for (int _j = 0; _j < 4; ++_j) g[_j] = rt_[64 * _j] + gCb; } while (0)
#define PG8_GDMA(pm_, buf) do { if (wid == 0) __builtin_amdgcn_global_load_lds((const unsigned*)(S.rowof + (size_t)(pm_) * 256 + lane * 4), (LAS unsigned*)(lds + ROWTAB_OFF + (buf) * 1024), 16, 0, 0); } while (0)
#define PG8_LDA(dst, b, h) do { _Pragma("unroll") for (int m = 0; m < 4; ++m) _Pragma("unroll") for (int k = 0; k < 2; ++k) dst[m][k] = *(const LAS bf16x8*)(lds + PG8_SA(b, h) + aoff + m * 2048 + k * 1024); } while (0)
#define PG8_LDB(dst, b, h) do { _Pragma("unroll") for (int n = 0; n < 2; ++n) _Pragma("unroll") for (int k = 0; k < 2; ++k) dst[n][k] = *(const LAS bf16x8*)(lds + PG8_SB(b, h) + boff + n * 2048 + k * 1024); } while (0)
#define PG8_MMA(ai, bj, At, Bt) do { __builtin_amdgcn_s_setprio(1); _Pragma("unroll") for (int m = 0; m < 4; ++m) _Pragma("unroll") for (int n = 0; n < 2; ++n) _Pragma("unroll") for (int k = 0; k < 2; ++k) \
        acc[ai][bj][m][n] = __builtin_amdgcn_mfma_f32_16x16x32_bf16(Bt[n][k], At[m][k], acc[ai][bj][m][n], 0, 0, 0); __builtin_amdgcn_s_setprio(0); } while (0)
#define PG8_WAIT_V(n) asm volatile("s_waitcnt vmcnt(" #n ")" ::: "memory")
#define PG8_WAIT_L(n) asm volatile("s_waitcnt lgkmcnt(" #n ")" ::: "memory")
#define PG8_BAR __builtin_amdgcn_s_barrier()
#define PG8_SCHED __builtin_amdgcn_sched_barrier(0)
    Unit cur, nxt; int ui = 0;
    if (!S.next(0, cur)) return;
    f32x4 acc[2][2][4][2];
#pragma unroll
    for (int a = 0; a < 2; ++a)
#pragma unroll
        for (int b = 0; b < 2; ++b)
#pragma unroll
            for (int m = 0; m < 4; ++m)
#pragma unroll
                for (int n = 0; n < 2; ++n) acc[a][b][m][n] = (f32x4){0.f, 0.f, 0.f, 0.f};
    bf16x8 At[4][2], B0[2][2], B1[2][2];
    const char* cA = S.aptr(cur); const char* cB = S.bptr(cur);
    unsigned g[4] = {0u, 0u, 0u, 0u}; int gR0 = 0; unsigned gCb = 0u;
    if constexpr (Sched::GATHER) { int R, C; stage_rc(tid * 16, R, C); gR0 = R; gCb = (unsigned)C * 2u;
        PG8_GDMA(cur.pm, 0); PG8_WAIT_V(0); PG8_BAR; PG8_GLOAD(0); }
    PG8_STAGE(PG8_SB(0, 0), cB, voffB); PG8_STAGE(PG8_SB(0, 1), cB + hstep, voffB); PG8_STAGEA(PG8_SA(0, 0), cA, 0); PG8_STAGEA(PG8_SA(0, 1), cA, 1);
    if (wr == 1) PG8_BAR;
    PG8_WAIT_V(2); PG8_BAR;
    PG8_STAGE(PG8_SB(1, 0), cB + kstep, voffB); PG8_STAGEA(PG8_SA(1, 0), cA + kstep, 0); PG8_STAGE(PG8_SB(1, 1), cB + hstep + kstep, voffB);
    PG8_WAIT_V(6); PG8_BAR;
    for (;;) {
        const bool has_next = S.next(ui + 1, nxt);
        const char* nA = has_next ? S.aptr(nxt) : cA; const char* nB = has_next ? S.bptr(nxt) : cB;
        if constexpr (Sched::GATHER) { if (has_next) PG8_GDMA(nxt.pm, (ui + 1) & 1); }
        for (int t = 0; t < nt; t += 2) {
            const bool last = (t == nt - 2);
            const char* a1 = cA + (size_t)(t + 1) * kstep;
            const char* a2 = last ? nA : cA + (size_t)(t + 2) * kstep; const char* b2 = last ? nB : cB + (size_t)(t + 2) * kstep;
            const char* a3 = a2 + kstep; const char* b3 = b2 + kstep;
            PG8_LDB(B0, 0, 0); PG8_LDB(B1, 0, 1); PG8_SCHED; PG8_LDA(At, 0, 0); PG8_STAGEA(PG8_SA(1, 1), a1, 1);
            PG8_WAIT_V(8); PG8_WAIT_L(0); PG8_BAR; PG8_MMA(0, 0, At, B0); PG8_MMA(0, 1, At, B1); PG8_BAR; PG8_SCHED;
            if constexpr (Sched::GATHER) { if (last && has_next) PG8_GLOAD((ui + 1) & 1); PG8_SCHED; }
            PG8_LDA(At, 0, 1); PG8_STAGE(PG8_SB(0, 0), b2, voffB); PG8_STAGE(PG8_SB(0, 1), b2 + hstep, voffB); PG8_STAGEA(PG8_SA(0, 0), a2, 0);
            PG8_WAIT_V(8); PG8_WAIT_L(0); PG8_BAR; PG8_MMA(1, 0, At, B0); PG8_MMA(1, 1, At, B1); PG8_BAR; PG8_SCHED;
            PG8_LDB(B0, 1, 0); PG8_LDB(B1, 1, 1); PG8_SCHED; PG8_LDA(At, 1, 0); PG8_STAGEA(PG8_SA(0, 1), a2, 1);
            PG8_WAIT_V(8); PG8_WAIT_L(0); PG8_BAR; PG8_MMA(0, 0, At, B0); PG8_MMA(0, 1, At, B1); PG8_BAR; PG8_SCHED;
            PG8_LDA(At, 1, 1); PG8_STAGE(PG8_SB(1, 0), b3, voffB); PG8_STAGE(PG8_SB(1, 1), b3 + hstep, voffB); PG8_STAGEA(PG8_SA(1, 0), a3, 0);
            PG8_WAIT_V(8); PG8_WAIT_L(0); PG8_BAR; PG8_MMA(1, 0, At, B0); PG8_MMA(1, 1, At, B1); PG8_BAR; PG8_SCHED;
        }
        if (wr == 0) PG8_BAR;
        E(acc, cur, wr, wc, fr, fq);
        if (!has_next) break;
#pragma unroll
        for (int a = 0; a < 2; ++a)
#pragma unroll
            for (int b = 0; b < 2; ++b)
#pragma unroll
                for (int m = 0; m < 4; ++m)
#pragma unroll
                    for (int n = 0; n < 2; ++n) acc[a][b][m][n] = (f32x4){0.f, 0.f, 0.f, 0.f};
        cur = nxt; cA = nA; cB = nB; ++ui;
        if (wr == 1) PG8_BAR;
    }
    PG8_WAIT_V(0);
    PG8_BAR;
#undef PG8_SA
#undef PG8_SB
#undef PG8_STAGE
#undef PG8_STAGEA
#undef PG8_GLOAD
#undef PG8_GDMA
#undef PG8_LDA
#undef PG8_LDB
#undef PG8_MMA
#undef PG8_WAIT_V
#undef PG8_WAIT_L
#undef PG8_BAR
#undef PG8_SCHED
}

struct EpiBf16 {
    static constexpr bool PERM = true;
    bf16* O; int ldc; const float* bias; int bias_stride;
    __device__ __forceinline__ void operator()(const f32x4 (&acc)[2][2][4][2], const Unit& u, int wr, int wc, int fr, int fq) const {
        const int row0 = u.pm * BM + wr * 64 + fr, col0 = u.pn * BM + wc * 32 + 8 * fq;
        f32x4 bv[2][2];
#pragma unroll
        for (int bj = 0; bj < 2; ++bj)
#pragma unroll
            for (int n = 0; n < 2; ++n) bv[bj][n] = bias ? *(const f32x4*)(bias + (size_t)u.e * bias_stride + col0 + bj * HALF + 4 * n) : (f32x4){0.f, 0.f, 0.f, 0.f};
#pragma unroll
        for (int ai = 0; ai < 2; ++ai)
#pragma unroll
            for (int m = 0; m < 4; ++m) { bf16* rowp = O + (size_t)(row0 + ai * HALF + m * 16) * ldc + col0;
#pragma unroll
                for (int bj = 0; bj < 2; ++bj) { const f32x4 v0 = acc[ai][bj][m][0] + bv[bj][0], v1 = acc[ai][bj][m][1] + bv[bj][1];
                    v4u w; w.x = cvt_pk_bf16(v0[0], v0[1]); w.y = cvt_pk_bf16(v0[2], v0[3]); w.z = cvt_pk_bf16(v1[0], v1[1]); w.w = cvt_pk_bf16(v1[2], v1[3]);
                    *(v4u*)(rowp + bj * HALF) = w; } }
    }
};
template <int MODE> struct EpiGlu {
    static constexpr bool PERM = true;
    bf16* O; int ldc; const float* bias; int bias_stride, hs;
    __device__ __forceinline__ void operator()(const f32x4 (&acc)[2][2][4][2], const Unit& u, int wr, int wc, int fr, int fq) const {
        const int row0 = u.pm * BM + wr * 64 + fr, col0 = u.pn * HALF + wc * 32 + 8 * fq;
        const float* bp = bias + (size_t)u.e * bias_stride + col0;
        f32x4 ba[2], bb[2];
#pragma unroll
        for (int n = 0; n < 2; ++n) { ba[n] = *(const f32x4*)(bp + 4 * n); bb[n] = *(const f32x4*)(bp + hs + 4 * n); }
#pragma unroll
        for (int ai = 0; ai < 2; ++ai)
#pragma unroll
            for (int m = 0; m < 4; ++m) { bf16* rowp = O + (size_t)(row0 + ai * HALF + m * 16) * ldc + col0;
                float o[8];
#pragma unroll
                for (int n = 0; n < 2; ++n) { const f32x4 a = acc[ai][0][m][n] + ba[n], b = acc[ai][1][m][n] + bb[n];
#pragma unroll
                    for (int j = 0; j < 4; ++j) {
                        if (MODE == 0) o[4 * n + j] = a[j] * sigm(b[j]);
                        else { const float g = fminf(a[j], 7.f), up = fminf(fmaxf(b[j], -7.f), 7.f); o[4 * n + j] = (up + 1.f) * g * sigm(1.702f * g); } } }
                v4u w; w.x = cvt_pk_bf16(o[0], o[1]); w.y = cvt_pk_bf16(o[2], o[3]); w.z = cvt_pk_bf16(o[4], o[5]); w.w = cvt_pk_bf16(o[6], o[7]);
                *(v4u*)rowp = w; }
    }
};
struct EpiMerge {
    static constexpr bool PERM = true;
    float* mtmp; bf16* Mo; const bf16* zg;
    __device__ __forceinline__ void operator()(const f32x4 (&acc)[2][2][4][2], const Unit& u, int wr, int wc, int fr, int fq) const {
        const int row0 = u.pm * BM + wr * 64 + fr, col0 = u.pn * BM + wc * 32 + 8 * fq;
#pragma unroll
        for (int ai = 0; ai < 2; ++ai)
#pragma unroll
            for (int m = 0; m < 4; ++m) { const size_t r = (size_t)(row0 + ai * HALF + m * 16);
#pragma unroll
                for (int bj = 0; bj < 2; ++bj) { const int c = col0 + bj * HALF;
                    const v4u gz = *(const v4u*)(zg + r * IN_COLS + u.e * 1024 + c);
                    float g[8] = {bflo(gz.x), bfhi(gz.x), bflo(gz.y), bfhi(gz.y), bflo(gz.z), bfhi(gz.z), bflo(gz.w), bfhi(gz.w)};
                    f32x4 t0, t1; float* tp = mtmp + r * 1024 + c;
                    if (u.e == 0) { t0 = (f32x4){0.f, 0.f, 0.f, 0.f}; t1 = t0; } else { t0 = *(const f32x4*)tp; t1 = *(const f32x4*)(tp + 4); }
#pragma unroll
                    for (int j = 0; j < 4; ++j) { t0[j] += sigm(g[j]) * acc[ai][bj][m][0][j]; t1[j] += sigm(g[4 + j]) * acc[ai][bj][m][1][j]; }
                    if (u.e < 2) { *(f32x4*)tp = t0; *(f32x4*)(tp + 4) = t1; }
                    else { v4u w; w.x = cvt_pk_bf16(t0[0], t0[1]); w.y = cvt_pk_bf16(t0[2], t0[3]); w.z = cvt_pk_bf16(t1[0], t1[1]); w.w = cvt_pk_bf16(t1[2], t1[3]);
                        *(v4u*)(Mo + r * 1024 + c) = w; } } }
    }
};
struct EpiResid {
    static constexpr bool PERM = false;
    float* X; const float* gmod;
    __device__ __forceinline__ void operator()(const f32x4 (&acc)[2][2][4][2], const Unit& u, int wr, int wc, int fr, int fq) const {
        const int row0 = u.pm * BM + wr * 64 + fr, col0 = u.pn * BM + wc * 32 + 4 * fq;
        const int r00 = u.pm * BM; const int w = r00 < T_LAT ? (r00 >> 12) : 8;
        f32x4 gv[2][2];
#pragma unroll
        for (int bj = 0; bj < 2; ++bj)
#pragma unroll
            for (int n = 0; n < 2; ++n) gv[bj][n] = *(const f32x4*)(gmod + (size_t)w * 6144 + col0 + bj * HALF + n * 16);
#pragma unroll
        for (int ai = 0; ai < 2; ++ai)
#pragma unroll
            for (int m = 0; m < 4; ++m) { float* rowp = X + (size_t)(row0 + ai * HALF + m * 16) * 1024 + col0;
#pragma unroll
                for (int bj = 0; bj < 2; ++bj)
#pragma unroll
                    for (int n = 0; n < 2; ++n) { f32x4* p = (f32x4*)(rowp + bj * HALF + n * 16); *p = *p + gv[bj][n] * acc[ai][bj][m][n]; } }
    }
};
}

struct Args { const float* in[51]; float* out; unsigned char* ws; int ph_lo, ph_hi; };
enum { I_X = 0, I_C, I_CTX, I_CCTX, I_ADAW, I_ADAB, I_N1G, I_N2G, I_WIN, I_HYCW, I_HYCB, I_HYW1, I_HYB1, I_HYF1, I_HYW2, I_HYB2, I_HYF2, I_HYW3, I_HYB3, I_HYBIAS,
       I_RWCW, I_RWCB, I_RWWUP, I_RWW0, I_RWAUP, I_RWA0, I_RWGUP, I_RWKK, I_RWKA, I_RWRK, I_RWLNG, I_RWLNB, I_S5ARE, I_S5AIM, I_S5LDT, I_S5BRE, I_S5BIM, I_S5CRE, I_S5CIM, I_S5D,
       I_S5GLUW, I_S5GLUB, I_WBR, I_WOUT, I_RTW, I_RTB, I_W1, I_B1, I_W2, I_B2, I_FING };

typedef const __attribute__((address_space(4))) Args* CArgsP;
__device__ __forceinline__ CArgsP kargs() { CArgsP p = (CArgsP)__builtin_amdgcn_kernarg_segment_ptr(); asm volatile("" : "+s"(p)); return p; }
__device__ __forceinline__ int opaque(int v) { asm volatile("" : "+s"(v)); return v; }
__device__ __forceinline__ int opaque_v(int v) { asm volatile("" : "+v"(v)); return v; }
struct Ctx { CArgsP a; LAS unsigned char* lds; int tid, lane, wave, bid, G; };

__device__ __forceinline__ void row_seq(int row, int& base, int& pos, int& n) {
    if (row < T_LAT) { base = row & ~(SEQ - 1); pos = row & (SEQ - 1); n = SEQ; }
    else { const int r = row - T_LAT; base = T_LAT + (r & ~(CTXL - 1)); pos = r & (CTXL - 1); n = CTXL; }
}
__device__ __forceinline__ float conv3z(const bf16* zc, int pos, int n, float w0, float w1, float w2, float b) {
    const float zm = pos > 0 ? bf2f(zc[(size_t)(pos - 1) * IN_COLS]) : 0.f, z0 = bf2f(zc[(size_t)pos * IN_COLS]), zp = pos < n - 1 ? bf2f(zc[(size_t)(pos + 1) * IN_COLS]) : 0.f;
    return zm * w0 + z0 * w1 + zp * w2 + b;
}

template <int MODE>
__device__ __forceinline__ void transpose_item(const float* W, int K, int N, bf16* WT, int Hs, LAS float* scr, int item, int lane) {
    const int nblk = N / 32, kb = item / nblk, nb = item % nblk, k0 = 64 * kb, n0 = 32 * nb;
#pragma unroll 8
    for (int i = 0; i < 32; ++i) { const int kk = 2 * i + (lane >> 5); scr[kk * 33 + (lane & 31)] = W[(size_t)(k0 + kk) * N + n0 + (lane & 31)]; }
    LDS_WAIT(); asm volatile("" ::: "memory");
    const int c = lane & 7;
#pragma unroll
    for (int j = 0; j < 4; ++j) { const int n = (lane >> 3) + 8 * j; const LAS float* s = scr + (8 * c) * 33 + n;
        v4u o; o.x = pk2(s[0 * 33], s[1 * 33]); o.y = pk2(s[2 * 33], s[3 * 33]); o.z = pk2(s[4 * 33], s[5 * 33]); o.w = pk2(s[6 * 33], s[7 * 33]);
        int dr = n0 + n;
        if (MODE == 1) { const int nc = n0 + n; const int jx = nc < Hs ? nc : nc - Hs; dr = (jx >> 7) * 256 + (nc < Hs ? 0 : 128) + (jx & 127); }
        *(v4u*)(WT + (size_t)dr * K + k0 + 8 * c) = o; }
    LDS_WAIT(); asm volatile("" ::: "memory");
}

__device__ __forceinline__ void p0_prologue(const Ctx& F) {
    const auto& a = *F.a; unsigned char* ws = a.ws;
    const int gw = F.bid * NWAVES + F.wave, NGW = F.G * NWAVES, lane = F.lane;
    float* X = (float*)(ws + WS_X);
    for (int t = gw; t < SEQ; t += NGW) {
        const float pr = (float)(t >> 6), pc = (float)(t & 63);
        f32x4 pe[4];
#pragma unroll
        for (int j = 0; j < 4; ++j)
#pragma unroll
            for (int e = 0; e < 4; ++e) { const float om = 1.0f / powf(10000.0f, (float)(4 * lane + e) / 256.0f); const float ang = ((j < 2) ? pr : pc) * om; pe[j][e] = (j & 1) ? cosf(ang) : sinf(ang); }
#pragma unroll 2
        for (int bb = 0; bb < BATCH; ++bb) { const size_t row = (size_t)bb * SEQ + t;
            const f32x4* xi = (const f32x4*)(a.in[I_X] + row * D) + lane; f32x4* xo = (f32x4*)(X + row * D) + lane;
#pragma unroll
            for (int j = 0; j < 4; ++j) xo[64 * j] = xi[64 * j] + pe[j]; }
    }
    for (int row = T_LAT + gw; row < T_ALL; row += NGW) {
        const f32x4* xi = (const f32x4*)(a.in[I_CTX] + (size_t)(row - T_LAT) * D) + lane; f32x4* xo = (f32x4*)(X + (size_t)row * D) + lane;
#pragma unroll
        for (int j = 0; j < 4; ++j) xo[64 * j] = xi[64 * j];
    }
    {
        LAS float* condl = (LAS float*)F.lds; LAS float* psum = (LAS float*)(F.lds + 40960);
        for (int i = F.tid; i < 9 * 1024; i += NTHREADS) { const int w = i >> 10, k = i & 1023; const float cv = (w < 8) ? a.in[I_C][w * 1024 + k] : a.in[I_CCTX][k]; condl[i] = cv / (1.f + expf(-cv)); }
        __syncthreads();
        float* MOD = (float*)(ws + WS_MOD);
        for (int it = F.bid; it < 2 * 96; it += F.G) {
            const int l = it / 96, cg = it % 96, col = cg * 64 + lane;
            float acc[9];
#pragma unroll
            for (int w = 0; w < 9; ++w) acc[w] = 0.f;
            const float* wp = a.in[I_ADAW] + ((size_t)l * 1024 + F.wave * 128) * 6144 + col;
#pragma unroll 1
            for (int k0 = 0; k0 < 128; k0 += 16) { float wv[16];
#pragma unroll
                for (int k = 0; k < 16; ++k) wv[k] = wp[(size_t)(k0 + k) * 6144];
#pragma unroll
                for (int k = 0; k < 16; ++k)
#pragma unroll
                    for (int w = 0; w < 9; ++w) acc[w] += condl[w * 1024 + F.wave * 128 + k0 + k] * wv[k]; }
#pragma unroll
            for (int w = 0; w < 9; ++w) psum[(F.wave * 9 + w) * 64 + lane] = acc[w];
            __syncthreads();
            if (F.wave == 0) {
#pragma unroll
                for (int w = 0; w < 9; ++w) { float s = 0.f;
#pragma unroll
                    for (int wv = 0; wv < 8; ++wv) s += psum[(wv * 9 + w) * 64 + lane];
                    MOD[(size_t)(l * 9 + w) * 6144 + col] = s + a.in[I_ADAB][l * 6144 + col]; }
            }
            __syncthreads();
        }
    }
    {
        LAS float* scr = (LAS float*)(F.lds + F.wave * 16384);
        constexpr int IT_W1 = 16 * 64, IT_W2 = 16 * 32, IT_WIN = 16 * 216, IT_GLU = 8 * 32, IT_WBR = 8 * 32, IT_WOUT = 16 * 32;
        constexpr int N_W1 = 64 * IT_W1, N_W2 = 64 * IT_W2, N_WIN = 2 * IT_WIN, N_GLU = 2 * IT_GLU, N_WBR = 6 * IT_WBR, N_WOUT = 2 * IT_WOUT;
        constexpr int NITEMS = N_W1 + N_W2 + N_WIN + N_GLU + N_WBR + N_WOUT;
        for (int it = gw; it < NITEMS; it += NGW) {
            int r = it;
            if (r < N_W1) { const int mtx = r / IT_W1, l = mtx >> 5, e = mtx & 31; transpose_item<1>(a.in[I_W1] + (size_t)mtx * 1024 * 2048, 1024, 2048, (bf16*)(ws + WS_WTS + l * WL_STRIDE + WO_W1) + (size_t)e * 2048 * 1024, 1024, scr, r % IT_W1, lane); continue; } r -= N_W1;
            if (r < N_W2) { const int mtx = r / IT_W2, l = mtx >> 5, e = mtx & 31; transpose_item<0>(a.in[I_W2] + (size_t)mtx * 1024 * 1024, 1024, 1024, (bf16*)(ws + WS_WTS + l * WL_STRIDE + WO_W2) + (size_t)e * 1024 * 1024, 0, scr, r % IT_W2, lane); continue; } r -= N_W2;
            if (r < N_WIN) { const int l = r / IT_WIN; transpose_item<0>(a.in[I_WIN] + (size_t)l * 1024 * IN_COLS, 1024, IN_COLS, (bf16*)(ws + WS_WTS + l * WL_STRIDE + WO_WIN), 0, scr, r % IT_WIN, lane); continue; } r -= N_WIN;
            if (r < N_GLU) { const int l = r / IT_GLU; transpose_item<1>(a.in[I_S5GLUW] + (size_t)l * 512 * 1024, 512, 1024, (bf16*)(ws + WS_WTS + l * WL_STRIDE + WO_GLU), 512, scr, r % IT_GLU, lane); continue; } r -= N_GLU;
            if (r < N_WBR) { const int mtx = r / IT_WBR, l = mtx / 3, br = mtx % 3; transpose_item<0>(a.in[I_WBR] + (size_t)mtx * 512 * 1024, 512, 1024, (bf16*)(ws + WS_WTS + l * WL_STRIDE + WO_WBR) + (size_t)br * 1024 * 512, 0, scr, r % IT_WBR, lane); continue; } r -= N_WBR;
            { const int l = r / IT_WOUT; transpose_item<0>(a.in[I_WOUT] + (size_t)l * 1024 * 1024, 1024, 1024, (bf16*)(ws + WS_WTS + l * WL_STRIDE + WO_WOUT), 0, scr, r % IT_WOUT, lane); }
        }
        for (int i = F.bid * NTHREADS + F.tid; i < 2 * 2560 * 256; i += F.G * NTHREADS) {
            const int l = i / (2560 * 256), r = i % (2560 * 256), n = r >> 8, k = r & 255; float v = 0.f;
            if (n < 1024) { if (k < 64) v = a.in[I_RWWUP][(((size_t)l * 2 + (n >> 9)) * 64 + k) * 512 + (n & 511)]; }
            else if (n < 2048) { if (k >= 64 && k < 128) v = a.in[I_RWAUP][(((size_t)l * 2 + ((n - 1024) >> 9)) * 64 + (k - 64)) * 512 + (n & 511)]; }
            else { if (k >= 128) v = a.in[I_RWGUP][((size_t)l * 128 + (k - 128)) * 512 + (n - 2048)]; }
            ((bf16*)(ws + WS_WTS + l * WL_STRIDE + WO_RWCAT))[r] = (bf16)f2bf(v);
        }
    }
    __syncthreads();
    {
        LAS float* feats = (LAS float*)F.lds; LAS float* h1 = feats + 8 * 33; LAS float* h2 = h1 + 8 * 64;
        constexpr int NIT = 2 * (512 + 32);
        for (int it = F.bid; it < NIT; it += F.G) {
            const int l = it / 544, r = it % 544, nsel = r >= 512, n = nsel ? CTXL : SEQ, p0 = (nsel ? r - 512 : r) * 8;
            if (F.tid < 8 * 33) { const int p = F.tid / 33, i = F.tid % 33, pos = p0 + p; float f;
                if (i == 0) f = (float)pos / (float)(n - 1);
                else { const int k = (i - 1) & 15; const float band = 1e-4f + (float)k * ((15.0f - 1e-4f) / 15.0f); const float ang = (6.283185307179586f * (float)pos / (float)n) * band; f = (i <= 16) ? cosf(ang) : -sinf(ang); }
                feats[p * 33 + i] = f; }
            __syncthreads();
            { const int p = F.tid >> 6, j = F.tid & 63; float s = a.in[I_HYB1][l * 64 + j]; const float* w1p = a.in[I_HYW1] + (size_t)l * 33 * 64 + j;
#pragma unroll
                for (int i = 0; i < 33; ++i) s += feats[p * 33 + i] * w1p[i * 64];
                h1[p * 64 + j] = sinf(a.in[I_HYF1][l * 64 + j] * s); }
            __syncthreads();
            { const int p = F.tid >> 6, j = F.tid & 63; float s = a.in[I_HYB2][l * 64 + j];
                const float* w2p = a.in[I_HYW2] + (size_t)l * 64 * 64 + j;
#pragma unroll 16
                for (int i = 0; i < 64; ++i) s += h1[p * 64 + i] * w2p[i * 64];
                h2[p * 64 + j] = sinf(a.in[I_HYF2][l * 64 + j] * s); }
            __syncthreads();
            float acc[4][8];
#pragma unroll
            for (int q = 0; q < 4; ++q)
#pragma unroll
                for (int p = 0; p < 8; ++p) acc[q][p] = 0.f;
            const float* w3 = a.in[I_HYW3] + (size_t)l * 64 * 2048 + F.tid;
#pragma unroll 8
            for (int i = 0; i < 64; ++i) { float wv[4];
#pragma unroll
                for (int q = 0; q < 4; ++q) wv[q] = w3[(size_t)i * 2048 + q * 512];
#pragma unroll
                for (int p = 0; p < 8; ++p) { const float hv = h2[p * 64 + i];
#pragma unroll
                    for (int q = 0; q < 4; ++q) acc[q][p] += hv * wv[q]; } }
            const int c = F.tid; const float dstart = logf(0.01f) / 1.5f, dstop = logf(0.01f) / 0.3f; const float delta = fabsf(dstart + (float)c * ((dstop - dstart) / 511.0f));
            const int RL = nsel ? HY_RLENC : HY_RLEN, off = n + 47;
            bf16* Rb = (bf16*)(ws + WS_GF + l * GF_STRIDE + (nsel ? GF_CTX : 0));
#pragma unroll
            for (int q = 0; q < 4; ++q) { const int o = q >> 1, side = q & 1; const float b3 = a.in[I_HYB3][l * 2048 + q * 512 + c];
                bf16* Rc = Rb + ((size_t)o * 512 + c) * RL;
#pragma unroll
                for (int p = 0; p < 8; ++p) { const int pos = p0 + p; const float t = (float)pos / (float)(n - 1); const float val = (acc[q][p] + b3) * expf(-t * delta);
                    if (side == 0) Rc[off - pos] = (bf16)f2bf(val);
                    else if (pos >= 1) Rc[off + pos] = (bf16)f2bf(val); }
                if (p0 == 0 && side == 0) { for (int m = 0; m < 48; ++m) Rc[m] = 0; for (int m = off + n; m < RL; ++m) Rc[m] = 0; } }
            __syncthreads();
        }
    }
}

__device__ __forceinline__ void stage_norm1(const Ctx& F, int l) {
    const auto& a = *F.a; unsigned char* ws = a.ws; const int lane = F.lane;
    const int gw = F.bid * NWAVES + F.wave, NGW = F.G * NWAVES;
    float* X = (float*)(ws + WS_X); bf16* H = (bf16*)(ws + WS_H); const float* MOD = (const float*)(ws + WS_MOD);
    const bf16* YS = (const bf16*)(ws + WS_XS); const int* POS = (const int*)(ws + WS_POS); const float* GATE = (const float*)(ws + WS_GATE);
    const int nrows = (l == DEPTH) ? T_LAT : T_ALL;
    for (int row = gw; row < nrows; row += NGW) {
        const int w = row < T_LAT ? (row >> 12) : 8;
        f32x4* xr = (f32x4*)(X + (size_t)row * D) + lane;
        f32x4 v[4];
#pragma unroll
        for (int j = 0; j < 4; ++j) v[j] = xr[64 * j];
        if (l > 0) {
            f32x4 mo[4];
#pragma unroll
            for (int j = 0; j < 4; ++j) mo[j] = (f32x4){0.f, 0.f, 0.f, 0.f};
#pragma unroll
            for (int k = 0; k < TOPK; ++k) { const int p = POS[row * 4 + k]; const float g = GATE[row * 4 + k];
                const v2u* yr = (const v2u*)(YS + (size_t)p * D) + lane;
#pragma unroll
                for (int j = 0; j < 4; ++j) { const v2u y = yr[64 * j]; mo[j][0] += g * bflo(y.x); mo[j][1] += g * bfhi(y.x); mo[j][2] += g * bflo(y.y); mo[j][3] += g * bfhi(y.y); } }
            const f32x4* g2 = (const f32x4*)(MOD + (size_t)((l - 1) * 9 + w) * 6144 + 5120) + lane;
#pragma unroll
            for (int j = 0; j < 4; ++j) { v[j] = v[j] + g2[64 * j] * mo[j]; xr[64 * j] = v[j]; }
        }
        float ss = 0.f;
#pragma unroll
        for (int j = 0; j < 4; ++j) ss += (v[j][0] * v[j][0] + v[j][1] * v[j][1]) + (v[j][2] * v[j][2] + v[j][3] * v[j][3]);
        const float rstd = 1.0f / sqrtf(wave_sum(ss) * (1.f / D) + 1e-6f);
        if (l == DEPTH) {
            const f32x4* fg = (const f32x4*)a.in[I_FING] + lane; f32x4* o = (f32x4*)(a.out + (size_t)row * D) + lane;
#pragma unroll
            for (int j = 0; j < 4; ++j) o[64 * j] = v[j] * rstd * fg[64 * j];
        } else {
            const f32x4* ng = (const f32x4*)(a.in[I_N1G] + l * D) + lane;
            const f32x4* sh = (const f32x4*)(MOD + (size_t)(l * 9 + w) * 6144) + lane; const f32x4* sc = (const f32x4*)(MOD + (size_t)(l * 9 + w) * 6144 + 1024) + lane;
            v2u* ho = (v2u*)(H + (size_t)row * D) + lane;
#pragma unroll
            for (int j = 0; j < 4; ++j) { const f32x4 h = v[j] * rstd * ng[64 * j] * (sc[64 * j] + 1.0f) + sh[64 * j]; v2u o; o.x = pk2(h[0], h[1]); o.y = pk2(h[2], h[3]); ho[64 * j] = o; }
        }
    }
}

__device__ __forceinline__ void stage_rw_prep1(const Ctx& F, int l) {
    const auto& a = *F.a; unsigned char* ws = a.ws;
    const bf16* Z = (const bf16*)(ws + WS_Z); bf16* ARW = (bf16*)(ws + WS_ARW);
    const int j = F.tid & 255, col = 1536 + j;
    const float* cw = a.in[I_RWCW] + (size_t)l * 3 * 1792; const float w0 = cw[col], w1 = cw[1792 + col], w2 = cw[2 * 1792 + col], cb = a.in[I_RWCB][l * 1792 + col];
    for (int row = F.bid * 2 + (F.tid >> 8); row < T_ALL; row += F.G * 2) {
        int base, pos, n; row_seq(row, base, pos, n);
        float v = conv3z(Z + (size_t)base * IN_COLS + RW_OFF + col, pos, n, w0, w1, w2, cb);
        if (j < 64) v = tanhf(v); else if (j >= 128) v = sigm(v);
        ARW[(size_t)row * 256 + j] = (bf16)f2bf(v);
    }
}

__device__ __forceinline__ void stage_rw_prep2(const Ctx& F, int l) {
    const auto& a = *F.a; unsigned char* ws = a.ws; const int lane = F.lane;
    const bf16* Z = (const bf16*)(ws + WS_Z); const bf16* P = (const bf16*)(ws + WS_P); bf16* SCN = (bf16*)(ws + WS_SCN);
    const int gw = F.bid * NWAVES + F.wave, NGW = F.G * NWAVES;
    constexpr int TR = 17, NRT = T_ALL / TR;
    const float* cw = a.in[I_RWCW] + (size_t)l * 3 * 1792; const float* cbp = a.in[I_RWCB] + l * 1792;
    for (int tile = gw; tile < NRT * 4; tile += NGW) {
        const int rt = tile % NRT, hp = tile / NRT, row0 = rt * TR, c0 = hp * 128 + 2 * lane;
        f32x2 w[3][3], cb[3];
#pragma unroll
        for (int s = 0; s < 3; ++s) { cb[s] = *(const f32x2*)(cbp + s * 512 + c0);
#pragma unroll
            for (int j = 0; j < 3; ++j) w[s][j] = *(const f32x2*)(cw + j * 1792 + s * 512 + c0); }
        const f32x2 KKw = *(const f32x2*)(a.in[I_RWKK] + l * 512 + c0), KAw = *(const f32x2*)(a.in[I_RWKA] + l * 512 + c0);
        f32x2 W0[2], A0[2];
#pragma unroll
        for (int d = 0; d < 2; ++d) { W0[d] = *(const f32x2*)(a.in[I_RWW0] + (l * 2 + d) * 512 + c0); A0[d] = *(const f32x2*)(a.in[I_RWA0] + (l * 2 + d) * 512 + c0); }
        const unsigned* zb = (const unsigned*)(Z + RW_OFF + c0);
        unsigned zm[3], z0[3], zp[3];
#pragma unroll
        for (int s = 0; s < 3; ++s) { zm[s] = row0 > 0 ? zb[(size_t)(row0 - 1) * (IN_COLS / 2) + s * 256] : 0u; z0[s] = zb[(size_t)row0 * (IN_COLS / 2) + s * 256]; }
#pragma unroll 1
        for (int i = 0; i < TR; ++i) {
            const int row = row0 + i; int base, pos, n; row_seq(row, base, pos, n);
#pragma unroll
            for (int s = 0; s < 3; ++s) zp[s] = (row + 1 < T_ALL) ? zb[(size_t)(row + 1) * (IN_COLS / 2) + s * 256] : 0u;
            const float mlo = pos > 0 ? 1.f : 0.f, mhi = pos < n - 1 ? 1.f : 0.f;
            f32x2 u[3];
#pragma unroll
            for (int s = 0; s < 3; ++s) { u[s] = (f32x2){bflo(zm[s]), bfhi(zm[s])} * mlo * w[s][0] + (f32x2){bflo(z0[s]), bfhi(z0[s])} * w[s][1] + (f32x2){bflo(zp[s]), bfhi(zp[s])} * mhi * w[s][2] + cb[s]; zm[s] = z0[s]; z0[s] = zp[s]; }
            const f32x2 r = u[0], k = u[1], v = u[2];
            f32x2 kk = k * KKw;
            const float ss = red32(kk[0] * kk[0] + kk[1] * kk[1]);
            kk = kk * (1.0f / sqrtf(fmaxf(ss, 1e-24f)));
            const unsigned* pr = (const unsigned*)(P + (size_t)row * 2560 + c0);
            unsigned* o = (unsigned*)(SCN + (size_t)row * 9 * 512 + c0);
            o[0] = pk2(r[0], r[1]); o[256] = pk2(v[0], v[1]); o[2 * 256] = pk2(kk[0], kk[1]);
#pragma unroll
            for (int d = 0; d < 2; ++d) {
                const unsigned pw = pr[d * 256], pa = pr[512 + d * 256];
                float ld[2], kd[2], be[2];
#pragma unroll
                for (int e = 0; e < 2; ++e) {
                    const float uu = W0[d][e] + (e ? bfhi(pw) : bflo(pw));
                    ld[e] = -0.60653065971263342f * sigm(uu);
                    const float av = sigm(A0[d][e] + (e ? bfhi(pa) : bflo(pa)));
                    kd[e] = k[e] * (1.f + (av - 1.f) * KAw[e]); be[e] = kk[e] * av; }
                o[(3 + 3 * d) * 256] = pk2(ld[0], ld[1]); o[(4 + 3 * d) * 256] = pk2(kd[0], kd[1]); o[(5 + 3 * d) * 256] = pk2(be[0], be[1]);
            }
        }
    }
}

__device__ __forceinline__ int seq_row(int b, int d, int sidx) {
    if (sidx < CTXL) { const int t = d ? (CTXL - 1 - sidx) : sidx; return T_LAT + b * CTXL + t; }
    const int tl = sidx - CTXL; const int t = d ? (SEQ - 1 - tl) : tl; return b * SEQ + t;
}

constexpr int CW_WORK = 16384;
constexpr int CW_STAMP = 20480;
#ifdef PROBE_T
#ifndef PROBE_BID
#define PROBE_BID 0
#endif
#define PT(k) do { if (F.bid == PROBE_BID && F.tid == 0 && l == 0) ((unsigned long long*)(F.a->ws + WS_CTL + CW_STAMP * 4))[k] = __builtin_amdgcn_s_memrealtime(); } while (0)
#else
#define PT(k) do { } while (0)
#endif
__device__ __forceinline__ void rw_scan_item(const Ctx& F, int l, int it2) {
    const int it = it2 >> 1, half = it2 & 1;
    const auto& a = *F.a; unsigned char* ws = a.ws; const int tid = F.tid, lane = F.lane;
    const bf16* SCN = (const bf16*)(ws + WS_SCN); float* YD = (float*)(ws + WS_YDIR);
    LAS float* sbuf = (LAS float*)F.lds;
    LAS float* ybuf = (LAS float*)(F.lds + 49152);
    const bool comp = F.wave < 4;
    const int lt = tid & 255, ls = lt >> 4, lj = lt & 15;
    const int vl = lane >> 3, kq = lane & 7, vrow = half * 32 + (F.wave & 3) * 8 + vl;
    constexpr int NCH = (CTXL + SEQ) / 16;
    const int d = it & 1, h = (it >> 1) & 7, b = it >> 4;
    f32x2 S[4];
#pragma unroll
    for (int q = 0; q < 4; ++q) S[q] = (f32x2){0.f, 0.f};
    v2u ldr[6];
#define RW_ISSUE(c) do { const int row_ = seq_row(b, d, (c) * 16 + ls); const v2u* p_ = (const v2u*)(SCN + (size_t)row_ * 9 * 512 + h * 64) + lj; \
        ldr[0] = p_[2 * 128]; ldr[1] = p_[(3 + 3 * d) * 128]; ldr[2] = p_[(5 + 3 * d) * 128]; ldr[3] = p_[(4 + 3 * d) * 128]; ldr[4] = p_[0]; ldr[5] = p_[128]; } while (0)
#define RW_WRITE(bufi) do { LAS float* o_ = sbuf + (((bufi) * 16 + ls) * 6) * 64 + 4 * lj; \
        *(LAS f32x4*)(o_) = (f32x4){-bflo(ldr[0].x), -bfhi(ldr[0].x), -bflo(ldr[0].y), -bfhi(ldr[0].y)}; \
        *(LAS f32x4*)(o_ + 64) = (f32x4){__expf(bflo(ldr[1].x)), __expf(bfhi(ldr[1].x)), __expf(bflo(ldr[1].y)), __expf(bfhi(ldr[1].y))}; \
        *(LAS f32x4*)(o_ + 128) = (f32x4){bflo(ldr[2].x), bfhi(ldr[2].x), bflo(ldr[2].y), bfhi(ldr[2].y)}; *(LAS f32x4*)(o_ + 192) = (f32x4){bflo(ldr[3].x), bfhi(ldr[3].x), bflo(ldr[3].y), bfhi(ldr[3].y)}; \
        *(LAS f32x4*)(o_ + 256) = (f32x4){bflo(ldr[4].x), bfhi(ldr[4].x), bflo(ldr[4].y), bfhi(ldr[4].y)}; *(LAS f32x4*)(o_ + 320) = (f32x4){bflo(ldr[5].x), bfhi(ldr[5].x), bflo(ldr[5].y), bfhi(ldr[5].y)}; } while (0)
#define RW_FLUSH(c) do { const int row_ = seq_row(b, d, (c) * 16 + ls); \
        *(f32x2*)(YD + ((size_t)d * T_ALL + row_) * 512 + h * 64 + half * 32 + 2 * lj) = *(const LAS f32x2*)(ybuf + ((((c) & 1) * 16 + ls) * 64) + half * 32 + 2 * lj); } while (0)
    if (!comp) { RW_ISSUE(0); RW_WRITE(0); RW_ISSUE(1); }
    __syncthreads();
#pragma unroll 1
    for (int c = 0; c < NCH; ++c) {
        const int bi = c & 1;
        if (!comp) {
            if (c + 1 < NCH) RW_WRITE(bi ^ 1);
            if (c + 2 < NCH) RW_ISSUE(c + 2);
            if (c > 0) RW_FLUSH(c - 1);
        } else {
        float yv[16];
        f32x4 opA[10], opB[10]; float vvA, vvB;
#define RW_LD(op, vvx, s_) do { const LAS float* sp_ = sbuf + ((bi * 16 + (s_)) * 6) * 64 + 8 * kq; \
            _Pragma("unroll") for (int q_ = 0; q_ < 5; ++q_) { op[2 * q_] = *(const LAS f32x4*)(sp_ + 64 * q_); op[2 * q_ + 1] = *(const LAS f32x4*)(sp_ + 64 * q_ + 4); } \
            vvx = sbuf[((bi * 16 + (s_)) * 6 + 5) * 64 + vrow]; } while (0)
#define RW_COMP(op, vvx, s_) do { \
            const f32x4 a0 = op[0], a1 = op[1], w0 = op[2], w1 = op[3], b0 = op[4], b1 = op[5], k0 = op[6], k1 = op[7], r0 = op[8], r1 = op[9]; \
            const f32x2 vv2 = (f32x2){vvx, vvx}; \
            const f32x2 p0 = S[1] * (f32x2){a0[2], a0[3]} + S[0] * (f32x2){a0[0], a0[1]}; \
            const f32x2 p1 = S[3] * (f32x2){a1[2], a1[3]} + S[2] * (f32x2){a1[0], a1[1]}; \
            const f32x2 t0 = S[0] * (f32x2){w0[0], w0[1]} + vv2 * (f32x2){k0[0], k0[1]}; \
            const f32x2 t1 = S[1] * (f32x2){w0[2], w0[3]} + vv2 * (f32x2){k0[2], k0[3]}; \
            const f32x2 t2 = S[2] * (f32x2){w1[0], w1[1]} + vv2 * (f32x2){k1[0], k1[1]}; \
            const f32x2 t3 = S[3] * (f32x2){w1[2], w1[3]} + vv2 * (f32x2){k1[2], k1[3]}; \
            const f32x2 ac = p0 + p1; \
            const float sa = red8(ac[0] + ac[1]); \
            const f32x2 sa2 = (f32x2){sa, sa}; \
            S[0] = sa2 * (f32x2){b0[0], b0[1]} + t0; S[1] = sa2 * (f32x2){b0[2], b0[3]} + t1; \
            S[2] = sa2 * (f32x2){b1[0], b1[1]} + t2; S[3] = sa2 * (f32x2){b1[2], b1[3]} + t3; \
            const f32x2 q0 = S[1] * (f32x2){r0[2], r0[3]} + S[0] * (f32x2){r0[0], r0[1]}; \
            const f32x2 q1 = S[3] * (f32x2){r1[2], r1[3]} + S[2] * (f32x2){r1[0], r1[1]}; \
            const f32x2 yc = q0 + q1; \
            yv[s_] = red8(yc[0] + yc[1]); } while (0)
        RW_LD(opA, vvA, 0);
#pragma unroll
        for (int s = 0; s < 16; s += 2) {
            RW_LD(opB, vvB, s + 1);
            __builtin_amdgcn_sched_barrier(0);
            RW_COMP(opA, vvA, s);
            __builtin_amdgcn_sched_barrier(0);
            if (s + 2 < 16) RW_LD(opA, vvA, s + 2);
            __builtin_amdgcn_sched_barrier(0);
            RW_COMP(opB, vvB, s + 1);
            __builtin_amdgcn_sched_barrier(0);
        }
#undef RW_LD
#undef RW_COMP
#pragma unroll
        for (int s = 0; s < 16; ++s) if ((s & 7) == kq) ybuf[((bi * 16 + s) * 64) + vrow] = yv[s];
        }
        __syncthreads();
    }
    if (!comp) RW_FLUSH(NCH - 1);
    __syncthreads();
#undef RW_ISSUE
#undef RW_WRITE
#undef RW_FLUSH
}

constexpr size_t WS_RWSCR = WS_YHY;
constexpr int RWS_QY = 0, RWS_YV = 2048, RWS_PZ = 4096, RWS_ZV = 12288, RWS_SLOT = 20480;
typedef __bf16 bf16x8n __attribute__((ext_vector_type(8)));
__device__ __forceinline__ f32x4 mma16(const bf16x8 a, const bf16x8 b, const f32x4 c) { return __builtin_amdgcn_mfma_f32_16x16x32_bf16(a, b, c, 0, 0, 0); }
__device__ __forceinline__ float dpp_shr(float x, const int n) {
    const int v = __builtin_bit_cast(int, x); int r;
    if (n == 1) r = __builtin_amdgcn_update_dpp(0, v, 0x111, 0xF, 0xF, true); else if (n == 2) r = __builtin_amdgcn_update_dpp(0, v, 0x112, 0xF, 0xF, true);
    else if (n == 4) r = __builtin_amdgcn_update_dpp(0, v, 0x114, 0xF, 0xF, true); else r = __builtin_amdgcn_update_dpp(0, v, 0x118, 0xF, 0xF, true);
    return __builtin_bit_cast(float, r);
}
__device__ __forceinline__ v4u pack8(const float (&x)[8]) { v4u o; o.x = pk2(x[0], x[1]); o.y = pk2(x[2], x[3]); o.z = pk2(x[4], x[5]); o.w = pk2(x[6], x[7]); return o; }
__device__ __forceinline__ void unpack8(const v4u u, float (&x)[8]) { x[0] = bflo(u.x); x[1] = bfhi(u.x); x[2] = bflo(u.y); x[3] = bfhi(u.y); x[4] = bflo(u.z); x[5] = bfhi(u.z); x[6] = bflo(u.w); x[7] = bfhi(u.w); }
__device__ __forceinline__ bf16x8 frag16(const LAS bf16* m, int rowbase, int lane) {
    v4u v = (v4u){0u, 0u, 0u, 0u}; if ((lane >> 4) < 2) v = *(const LAS v4u*)(m + (rowbase + (lane & 15)) * 16 + 8 * (lane >> 4)); return __builtin_bit_cast(bf16x8, v); }
__device__ __forceinline__ void st_colmaj(LAS bf16* m, int colbase, const f32x4 d, int lane) {
    v2u o; o.x = pk2(d[0], d[1]); o.y = pk2(d[2], d[3]); *(LAS v2u*)(m + (colbase + (lane & 15)) * 16 + 4 * (lane >> 4)) = o; }
__device__ __forceinline__ void st_rowmaj(LAS bf16* m, const f32x4 d, int lane) {
#pragma unroll
    for (int r = 0; r < 4; ++r) m[(4 * (lane >> 4) + r) * 16 + (lane & 15)] = (bf16)f2bf(d[r]); }
template <int KS0, int KS1>
__device__ __forceinline__ void rw_chunk_load(const Ctx& F, int b, int h, int d, int cidx, v4u (&raw)[12]) {
    const int lane = opaque_v(F.lane), t = lane & 15, kg = lane >> 4;
    const bf16* base = (const bf16*)(F.a->ws + WS_SCN) + (size_t)seq_row(b, d, 16 * cidx + t) * 9 * 512 + h * 64;
#pragma unroll
    for (int ks = KS0; ks < KS1; ++ks) { const int off = 32 * ks + 8 * kg;
        raw[6 * ks + 0] = *(const v4u*)(base + (3 + 3 * d) * 512 + off); raw[6 * ks + 1] = *(const v4u*)(base + 2 * 512 + off); raw[6 * ks + 2] = *(const v4u*)(base + off);
        raw[6 * ks + 3] = *(const v4u*)(base + (5 + 3 * d) * 512 + off); raw[6 * ks + 4] = *(const v4u*)(base + (4 + 3 * d) * 512 + off); raw[6 * ks + 5] = *(const v4u*)(base + 512 + off); }
}
__device__ __forceinline__ void rw_chunk_task(const Ctx& F, const v4u (&raw)[12], LAS unsigned char* wl, unsigned char* slot) {
    const int lane = opaque_v(F.lane), t = lane & 15, kg = lane >> 4;
    LAS bf16* ATt = (LAS bf16*)(wl); LAS bf16* RBr = (LAS bf16*)(wl + 2048); LAS bf16* BHt = (LAS bf16*)(wl + 4096); LAS bf16* KHt = (LAS bf16*)(wl + 6144); LAS bf16* VTt = (LAS bf16*)(wl + 8192);
    LAS bf16* WAt = (LAS bf16*)(wl + 10240); LAS bf16* N_r = (LAS bf16*)(wl + 12288); LAS bf16* N_c = (LAS bf16*)(wl + 12800); LAS bf16* T_r = (LAS bf16*)(wl + 13312);
    LAS bf16* AK_r = (LAS bf16*)(wl + 13824); LAS bf16* RB2 = (LAS bf16*)(wl + 14336); LAS bf16* RK_r = (LAS bf16*)(wl + 14848); LAS float* GCl = (LAS float*)(wl + 15360);
    bf16x8 fAb[2], fRb[2], fBb[2], fKb[2];
#pragma unroll
    for (int ks = 0; ks < 2; ++ks) {
        const int off = 32 * ks + 8 * kg;
        float ea[8], er[8], eb[8], eh[8];
        { const v4u uld = raw[6 * ks + 0]; float ld[8]; unpack8(uld, ld);
#pragma unroll
          for (int j = 0; j < 8; ++j) { float c = ld[j]; c += dpp_shr(c, 1); c += dpp_shr(c, 2); c += dpp_shr(c, 4); c += dpp_shr(c, 8);
              const float tot = __builtin_bit_cast(float, __builtin_amdgcn_ds_bpermute((lane | 15) << 2, __builtin_bit_cast(int, c)));
              ea[j] = __expf(c - ld[j]); er[j] = __expf(c); eb[j] = __expf(-c); eh[j] = __expf(tot - c);
              if (t == 0) GCl[off + j] = __expf(tot); } }
        { const v4u u = raw[6 * ks + 1]; float x[8]; unpack8(u, x);
#pragma unroll
          for (int j = 0; j < 8; ++j) { x[j] = -x[j] * ea[j]; ATt[(off + j) * 16 + t] = (bf16)f2bf(x[j]); }
          const v4u p = pack8(x); fAb[ks] = __builtin_bit_cast(bf16x8, p); }
        { const v4u u = raw[6 * ks + 2]; float x[8]; unpack8(u, x);
#pragma unroll
          for (int j = 0; j < 8; ++j) x[j] = x[j] * er[j];
          const v4u p = pack8(x); fRb[ks] = __builtin_bit_cast(bf16x8, p); *(LAS v4u*)(RBr + t * 64 + off) = p; }
        { const v4u u = raw[6 * ks + 3]; float x[8], y[8]; unpack8(u, x);
#pragma unroll
          for (int j = 0; j < 8; ++j) { y[j] = x[j] * eb[j]; BHt[(off + j) * 16 + t] = (bf16)f2bf(x[j] * eh[j]); }
          const v4u p = pack8(y); fBb[ks] = __builtin_bit_cast(bf16x8, p); }
        { const v4u u = raw[6 * ks + 4]; float x[8], y[8]; unpack8(u, x);
#pragma unroll
          for (int j = 0; j < 8; ++j) { y[j] = x[j] * eb[j]; KHt[(off + j) * 16 + t] = (bf16)f2bf(x[j] * eh[j]); }
          const v4u p = pack8(y); fKb[ks] = __builtin_bit_cast(bf16x8, p); }
        { const v4u u = raw[6 * ks + 5];
          const bf16 e0 = (bf16)(u.x & 0xffff), e1 = (bf16)(u.x >> 16), e2 = (bf16)(u.y & 0xffff), e3 = (bf16)(u.y >> 16), e4 = (bf16)(u.z & 0xffff), e5 = (bf16)(u.z >> 16), e6 = (bf16)(u.w & 0xffff), e7 = (bf16)(u.w >> 16);
          VTt[(off + 0) * 16 + t] = e0; VTt[(off + 1) * 16 + t] = e1; VTt[(off + 2) * 16 + t] = e2; VTt[(off + 3) * 16 + t] = e3; VTt[(off + 4) * 16 + t] = e4; VTt[(off + 5) * 16 + t] = e5; VTt[(off + 6) * 16 + t] = e6; VTt[(off + 7) * 16 + t] = e7; }
        __builtin_amdgcn_sched_barrier(0);
    }
    asm volatile("" ::: "memory");
    const f32x4 z4 = (f32x4){0.f, 0.f, 0.f, 0.f};
    f32x4 n0 = mma16(fAb[1], fBb[1], mma16(fAb[0], fBb[0], z4)), aak = mma16(fAb[1], fKb[1], mma16(fAb[0], fKb[0], z4));
    f32x4 arb = mma16(fRb[1], fBb[1], mma16(fRb[0], fBb[0], z4)), ark = mma16(fRb[1], fKb[1], mma16(fRb[0], fKb[0], z4));
#pragma unroll
    for (int r = 0; r < 4; ++r) { const int tt = 4 * kg + r; if (!(t < tt)) { n0[r] = 0.f; aak[r] = 0.f; } if (!(t <= tt)) { arb[r] = 0.f; ark[r] = 0.f; } }
    st_rowmaj(AK_r, aak, lane); st_rowmaj(RB2, arb, lane); st_rowmaj(RK_r, ark, lane); asm volatile("" ::: "memory");
    f32x4 accT = n0;
#pragma unroll
    for (int r = 0; r < 4; ++r) accT[r] += (4 * kg + r == t) ? 1.f : 0.f;
    f32x4 nn = n0;
#pragma unroll
    for (int itn = 0; itn < 3; ++itn) {
        st_rowmaj(N_r, nn, lane); st_colmaj(N_c, 0, nn, lane); st_rowmaj(T_r, accT, lane); asm volatile("" ::: "memory");
        const bf16x8 fa = frag16(N_r, 0, lane), fb = frag16(N_c, 0, lane), ft = frag16(T_r, 0, lane);
        nn = mma16(fa, fb, z4); asm volatile("" ::: "memory");
        st_colmaj(N_c, 0, nn, lane); asm volatile("" ::: "memory");
        const bf16x8 fb2 = frag16(N_c, 0, lane);
        accT = mma16(ft, fb2, accT); asm volatile("" ::: "memory");
    }
    st_rowmaj(T_r, accT, lane); asm volatile("" ::: "memory");
    const bf16x8 fT = frag16(T_r, 0, lane), fAK = frag16(AK_r, 0, lane), fARB = frag16(RB2, 0, lane), fARK = frag16(RK_r, 0, lane);
#pragma unroll
    for (int kt = 0; kt < 4; ++kt) { const f32x4 dd = mma16(fT, frag16(ATt, 16 * kt, lane), z4); st_colmaj(WAt, 16 * kt, dd, lane); } asm volatile("" ::: "memory");
    { const bf16x8 fArbT = frag16(RB2, 0, lane);
#pragma unroll
      for (int kt = 0; kt < 4; ++kt) { const v2u ri = *(const LAS v2u*)(RBr + t * 64 + 16 * kt + 4 * kg);
          f32x4 c0 = (f32x4){bflo(ri.x), bfhi(ri.x), bflo(ri.y), bfhi(ri.y)};
          c0 = mma16(frag16(WAt, 16 * kt, lane), fArbT, c0);
          v2u o; o.x = pk2(c0[0], c0[1]); o.y = pk2(c0[2], c0[3]); *(v2u*)(slot + RWS_QY + (t * 64 + 16 * kt + 4 * kg) * 2) = o; } }
    asm volatile("" ::: "memory");
#pragma unroll
    for (int vt = 0; vt < 4; ++vt) { const f32x4 dd = mma16(fAK, frag16(VTt, 16 * vt, lane), z4); st_colmaj(ATt, 16 * vt, dd, lane); } asm volatile("" ::: "memory");
    asm volatile("" ::: "memory");
    LAS bf16* UVt = RBr;
#pragma unroll
    for (int vt = 0; vt < 4; ++vt) { const f32x4 dd = mma16(fT, frag16(ATt, 16 * vt, lane), z4); st_colmaj(UVt, 16 * vt, dd, lane); } asm volatile("" ::: "memory");
#pragma unroll
    for (int vt = 0; vt < 4; ++vt) { const f32x4 dd = mma16(fARK, frag16(VTt, 16 * vt, lane), mma16(fARB, frag16(UVt, 16 * vt, lane), z4));
        v2u o; o.x = pk2(dd[0], dd[1]); o.y = pk2(dd[2], dd[3]); *(v2u*)(slot + RWS_YV + ((16 * vt + t) * 16 + 4 * kg) * 2) = o; }
#pragma unroll
    for (int ktp = 0; ktp < 4; ++ktp) { const bf16x8 fBh = frag16(BHt, 16 * ktp, lane);
#pragma unroll
        for (int kt = 0; kt < 4; ++kt) { f32x4 dd = mma16(frag16(WAt, 16 * kt, lane), fBh, z4);
            if (kt == ktp) {
#pragma unroll
                for (int r = 0; r < 4; ++r) if (4 * kg + r == t) dd[r] += GCl[16 * kt + t]; }
            v2u o; o.x = pk2(dd[0], dd[1]); o.y = pk2(dd[2], dd[3]); *(v2u*)(slot + RWS_PZ + ((16 * ktp + t) * 64 + 16 * kt + 4 * kg) * 2) = o; } }
#pragma unroll
    for (int vt = 0; vt < 4; ++vt) { const bf16x8 fU = frag16(UVt, 16 * vt, lane), fV = frag16(VTt, 16 * vt, lane);
#pragma unroll
        for (int ktp = 0; ktp < 4; ++ktp) { const f32x4 dd = mma16(frag16(KHt, 16 * ktp, lane), fV, mma16(frag16(BHt, 16 * ktp, lane), fU, z4));
            v2u o; o.x = pk2(dd[0], dd[1]); o.y = pk2(dd[2], dd[3]); *(v2u*)(slot + RWS_ZV + ((16 * vt + t) * 64 + 16 * ktp + 4 * kg) * 2) = o; } }
}
__device__ __forceinline__ void rw_chunk_task2(const Ctx& F, const v4u (&raw)[12], LAS unsigned char* wl, f32x4 (&yv)[4], f32x4 (&zv)[4][4]) {
    const int lane = opaque_v(F.lane), t = lane & 15, kg = lane >> 4;
    LAS bf16* ATt = (LAS bf16*)(wl); LAS bf16* RBr = (LAS bf16*)(wl + 2048); LAS bf16* BHt = (LAS bf16*)(wl + 4096); LAS bf16* KHt = (LAS bf16*)(wl + 6144); LAS bf16* VTt = (LAS bf16*)(wl + 8192);
    LAS bf16* WAt = (LAS bf16*)(wl + 10240); LAS bf16* N_r = (LAS bf16*)(wl + 12288); LAS bf16* N_c = (LAS bf16*)(wl + 12800); LAS bf16* T_r = (LAS bf16*)(wl + 13312);
    LAS bf16* AK_r = (LAS bf16*)(wl + 13824); LAS bf16* RB2 = (LAS bf16*)(wl + 14336); LAS bf16* RK_r = (LAS bf16*)(wl + 14848); LAS float* GCl = (LAS float*)(wl + 15360);
    bf16x8 fAb[2], fRb[2], fBb[2], fKb[2];
#pragma unroll
    for (int ks = 0; ks < 2; ++ks) {
        const int off = 32 * ks + 8 * kg;
        float ea[8], er[8], eb[8], eh[8];
        { const v4u uld = raw[6 * ks + 0]; float ld[8]; unpack8(uld, ld);
#pragma unroll
          for (int j = 0; j < 8; ++j) { float c = ld[j]; c += dpp_shr(c, 1); c += dpp_shr(c, 2); c += dpp_shr(c, 4); c += dpp_shr(c, 8);
              const float tot = __builtin_bit_cast(float, __builtin_amdgcn_ds_bpermute((lane | 15) << 2, __builtin_bit_cast(int, c)));
              ea[j] = __expf(c - ld[j]); er[j] = __expf(c); eb[j] = __expf(-c); eh[j] = __expf(tot - c);
              if (t == 0) GCl[off + j] = __expf(tot); } }
        { const v4u u = raw[6 * ks + 1]; float x[8]; unpack8(u, x);
#pragma unroll
          for (int j = 0; j < 8; ++j) { x[j] = -x[j] * ea[j]; ATt[(off + j) * 16 + t] = (bf16)f2bf(x[j]); }
          const v4u p = pack8(x); fAb[ks] = __builtin_bit_cast(bf16x8, p); }
        { const v4u u = raw[6 * ks + 2]; float x[8]; unpack8(u, x);
#pragma unroll
          for (int j = 0; j < 8; ++j) x[j] = x[j] * er[j];
          const v4u p = pack8(x); fRb[ks] = __builtin_bit_cast(bf16x8, p); *(LAS v4u*)(RBr + t * 64 + off) = p; }
        { const v4u u = raw[6 * ks + 3]; float x[8], y[8]; unpack8(u, x);
#pragma unroll
          for (int j = 0; j < 8; ++j) { y[j] = x[j] * eb[j]; BHt[(off + j) * 16 + t] = (bf16)f2bf(x[j] * eh[j]); }
          const v4u p = pack8(y); fBb[ks] = __builtin_bit_cast(bf16x8, p); }
        { const v4u u = raw[6 * ks + 4]; float x[8], y[8]; unpack8(u, x);
#pragma unroll
          for (int j = 0; j < 8; ++j) { y[j] = x[j] * eb[j]; KHt[(off + j) * 16 + t] = (bf16)f2bf(x[j] * eh[j]); }
          const v4u p = pack8(y); fKb[ks] = __builtin_bit_cast(bf16x8, p); }
        { const v4u u = raw[6 * ks + 5];
          const bf16 e0 = (bf16)(u.x & 0xffff), e1 = (bf16)(u.x >> 16), e2 = (bf16)(u.y & 0xffff), e3 = (bf16)(u.y >> 16), e4 = (bf16)(u.z & 0xffff), e5 = (bf16)(u.z >> 16), e6 = (bf16)(u.w & 0xffff), e7 = (bf16)(u.w >> 16);
          VTt[(off + 0) * 16 + t] = e0; VTt[(off + 1) * 16 + t] = e1; VTt[(off + 2) * 16 + t] = e2; VTt[(off + 3) * 16 + t] = e3; VTt[(off + 4) * 16 + t] = e4; VTt[(off + 5) * 16 + t] = e5; VTt[(off + 6) * 16 + t] = e6; VTt[(off + 7) * 16 + t] = e7; }
        __builtin_amdgcn_sched_barrier(0);
    }
    asm volatile("" ::: "memory");
    const f32x4 z4 = (f32x4){0.f, 0.f, 0.f, 0.f};
    f32x4 n0 = mma16(fAb[1], fBb[1], mma16(fAb[0], fBb[0], z4)), aak = mma16(fAb[1], fKb[1], mma16(fAb[0], fKb[0], z4));
    f32x4 arb = mma16(fRb[1], fBb[1], mma16(fRb[0], fBb[0], z4)), ark = mma16(fRb[1], fKb[1], mma16(fRb[0], fKb[0], z4));
#pragma unroll
    for (int r = 0; r < 4; ++r) { const int tt = 4 * kg + r; if (!(t < tt)) { n0[r] = 0.f; aak[r] = 0.f; } if (!(t <= tt)) { arb[r] = 0.f; ark[r] = 0.f; } }
    st_rowmaj(AK_r, aak, lane); st_rowmaj(RB2, arb, lane); st_rowmaj(RK_r, ark, lane); asm volatile("" ::: "memory");
    f32x4 accT = n0;
#pragma unroll
    for (int r = 0; r < 4; ++r) accT[r] += (4 * kg + r == t) ? 1.f : 0.f;
    f32x4 nn = n0;
#pragma unroll
    for (int itn = 0; itn < 3; ++itn) {
        st_rowmaj(N_r, nn, lane); st_colmaj(N_c, 0, nn, lane); st_rowmaj(T_r, accT, lane); asm volatile("" ::: "memory");
        const bf16x8 fa = frag16(N_r, 0, lane), fb = frag16(N_c, 0, lane), ft = frag16(T_r, 0, lane);
        nn = mma16(fa, fb, z4); asm volatile("" ::: "memory");
        st_colmaj(N_c, 0, nn, lane); asm volatile("" ::: "memory");
        const bf16x8 fb2 = frag16(N_c, 0, lane);
        accT = mma16(ft, fb2, accT); asm volatile("" ::: "memory");
    }
    st_rowmaj(T_r, accT, lane); asm volatile("" ::: "memory");
    const bf16x8 fT = frag16(T_r, 0, lane), fAK = frag16(AK_r, 0, lane), fARB = frag16(RB2, 0, lane), fARK = frag16(RK_r, 0, lane);
#pragma unroll
    for (int kt = 0; kt < 4; ++kt) { const f32x4 dd = mma16(fT, frag16(ATt, 16 * kt, lane), z4); st_colmaj(WAt, 16 * kt, dd, lane); } asm volatile("" ::: "memory");
    f32x4 qy[4];
    { const bf16x8 fArbT = frag16(RB2, 0, lane);
#pragma unroll
      for (int kt = 0; kt < 4; ++kt) { const v2u ri = *(const LAS v2u*)(RBr + t * 64 + 16 * kt + 4 * kg);
          qy[kt] = mma16(frag16(WAt, 16 * kt, lane), fArbT, (f32x4){bflo(ri.x), bfhi(ri.x), bflo(ri.y), bfhi(ri.y)}); } }
    asm volatile("" ::: "memory");
#pragma unroll
    for (int vt = 0; vt < 4; ++vt) { const f32x4 dd = mma16(fAK, frag16(VTt, 16 * vt, lane), z4); st_colmaj(ATt, 16 * vt, dd, lane); } asm volatile("" ::: "memory");
    LAS bf16* UVt = RBr;
#pragma unroll
    for (int vt = 0; vt < 4; ++vt) { const f32x4 dd = mma16(fT, frag16(ATt, 16 * vt, lane), z4); st_colmaj(UVt, 16 * vt, dd, lane); } asm volatile("" ::: "memory");
#pragma unroll
    for (int vt = 0; vt < 4; ++vt) { const bf16x8 fU = frag16(UVt, 16 * vt, lane), fV = frag16(VTt, 16 * vt, lane);
        yv[vt] = mma16(fARK, fV, mma16(fARB, fU, z4));
#pragma unroll
        for (int ktp = 0; ktp < 4; ++ktp) zv[vt][ktp] = mma16(frag16(KHt, 16 * ktp, lane), fV, mma16(frag16(BHt, 16 * ktp, lane), fU, z4)); }
    f32x4 pz[4][4];
#pragma unroll
    for (int ktp = 0; ktp < 4; ++ktp) { const bf16x8 fBh = frag16(BHt, 16 * ktp, lane);
#pragma unroll
        for (int kt = 0; kt < 4; ++kt) { f32x4 dd = mma16(frag16(WAt, 16 * kt, lane), fBh, z4);
            if (kt == ktp) {
#pragma unroll
                for (int r = 0; r < 4; ++r) if (4 * kg + r == t) dd[r] += GCl[16 * kt + t]; }
            pz[ktp][kt] = dd; } }
    asm volatile("s_waitcnt lgkmcnt(0)" ::: "memory");
#pragma unroll
    for (int ktp = 0; ktp < 4; ++ktp) { LAS bf16* reg = (LAS bf16*)(wl + (ktp < 2 ? ktp * 2048 : (ktp + 1) * 2048));
#pragma unroll
        for (int kt = 0; kt < 4; ++kt) { v2u o; o.x = pk2(pz[ktp][kt][0], pz[ktp][kt][1]); o.y = pk2(pz[ktp][kt][2], pz[ktp][kt][3]); *(LAS v2u*)(reg + t * 64 + 16 * kt + 4 * kg) = o; } }
#pragma unroll
    for (int kt = 0; kt < 4; ++kt) { v2u o; o.x = pk2(qy[kt][0], qy[kt][1]); o.y = pk2(qy[kt][2], qy[kt][3]); *(LAS v2u*)(BHt + t * 64 + 16 * kt + 4 * kg) = o; }
    asm volatile("s_waitcnt lgkmcnt(0)" ::: "memory");
}
constexpr int RWZ_OFF = LDSCTL_OFF + 8192, RWF_OFF = LDSCTL_OFF + 2048;
__device__ __forceinline__ void rw_chunk_item2(const Ctx& F, int l, int it, size_t yoff = WS_YDIR) {
    const auto& a = *F.a; unsigned char* ws = a.ws; const int lane = opaque_v(F.lane), t = lane & 15, kg = lane >> 4;
    const int d = it & 1, h = (it >> 1) & 7, b = it >> 4;
    float* YD = (float*)(ws + yoff);
    LAS unsigned char* wl = F.lds + F.wave * 15616;
    LAS bf16* ZS = (LAS bf16*)(F.lds + RWZ_OFF);
    volatile LAS int* flag = (volatile LAS int*)(F.lds + RWF_OFF);
    for (int i = F.tid; i < 2048; i += NTHREADS) ((LAS unsigned*)ZS)[i] = 0u;
    if (F.tid == 0) *flag = 0;
    __syncthreads();
    constexpr int NCHK = (CTXL + SEQ) / 16;
#pragma unroll 1
    for (int c = F.wave; c < NCHK; c += NWAVES) {
        v4u raw[12]; f32x4 yv[4], zv[4][4];
        rw_chunk_load<0, 2>(F, b, h, d, c, raw);
        rw_chunk_task2(F, raw, wl, yv, zv);
        while (*flag < c) __builtin_amdgcn_s_sleep(1);
        asm volatile("" ::: "memory");
        const LAS bf16* Zc = ZS + (c & 1) * 4096; LAS bf16* Zn = ZS + ((c + 1) & 1) * 4096;
        bf16x8 zb[4][2];
#pragma unroll
        for (int vb = 0; vb < 4; ++vb)
#pragma unroll
            for (int ks = 0; ks < 2; ++ks) zb[vb][ks] = *(const LAS bf16x8*)(Zc + (16 * vb + t) * 64 + 32 * ks + 8 * kg);
        { const LAS bf16* Qr = (const LAS bf16*)(wl + 4096); const bf16x8 q0 = *(const LAS bf16x8*)(Qr + t * 64 + 8 * kg), q1 = *(const LAS bf16x8*)(Qr + t * 64 + 32 + 8 * kg);
#pragma unroll
          for (int vb = 0; vb < 4; ++vb) { const f32x4 y = mma16(q1, zb[vb][1], mma16(q0, zb[vb][0], yv[vb]));
#pragma unroll
              for (int r = 0; r < 4; ++r) { const int row = seq_row(b, d, c * 16 + 4 * kg + r); YD[((size_t)d * T_ALL + row) * 512 + h * 64 + 16 * vb + t] = y[r]; } } }
#pragma unroll
        for (int ktp = 0; ktp < 4; ++ktp) { const LAS bf16* Pr = (const LAS bf16*)(wl + (ktp < 2 ? ktp * 2048 : (ktp + 1) * 2048));
            const bf16x8 p0 = *(const LAS bf16x8*)(Pr + t * 64 + 8 * kg), p1 = *(const LAS bf16x8*)(Pr + t * 64 + 32 + 8 * kg);
#pragma unroll
            for (int vb = 0; vb < 4; ++vb) { const f32x4 z = mma16(p1, zb[vb][1], mma16(p0, zb[vb][0], zv[vb][ktp]));
                v2u o; o.x = pk2(z[0], z[1]); o.y = pk2(z[2], z[3]); *(LAS v2u*)(Zn + (16 * vb + t) * 64 + 16 * ktp + 4 * kg) = o; } }
        asm volatile("s_waitcnt lgkmcnt(0)" ::: "memory");
        if (lane == 0) *flag = c + 1;
        asm volatile("s_waitcnt lgkmcnt(0)" ::: "memory");
    }
    __syncthreads();
}
__device__ __forceinline__ v2u ld_sc1_8(const void* p) { const unsigned long long v = __hip_atomic_load((const unsigned long long*)p, __ATOMIC_RELAXED, __HIP_MEMORY_SCOPE_AGENT); v2u o; o.x = (unsigned)v; o.y = (unsigned)(v >> 32); return o; }
__device__ __forceinline__ v4u ld_sc1_16(const void* p) { const v2u a = ld_sc1_8(p), b = ld_sc1_8((const char*)p + 8); return (v4u){a.x, a.y, b.x, b.y}; }
__device__ __forceinline__ void rw_chunk_item(const Ctx& F, int l, int it) {
    const auto& a = *F.a; unsigned char* ws = a.ws; const int lane = F.lane, t = lane & 15, kg = lane >> 4;
    const int d = it & 1, h = (it >> 1) & 7, b = it >> 4;
    float* YD = (float*)(ws + WS_YDIR);
    unsigned char* scr = ws + WS_RWSCR + (size_t)F.bid * 16 * RWS_SLOT;
    LAS unsigned char* wl = F.lds + F.wave * 15616;
    LAS bf16* ZL = (LAS bf16*)(F.lds + LDSCTL_OFF + 4096 + (F.wave & 3) * 2048);
    if (F.wave < 4) { for (int i = lane; i < 512; i += 64) ((LAS unsigned*)ZL)[i] = 0u; }
    asm volatile("" ::: "memory");
    constexpr int NCHK = (CTXL + SEQ) / 16, NB = NCHK / 16;
#pragma unroll 1
    for (int bt = 0; bt < NB; ++bt) {
        { v4u cur[12];
#pragma unroll 1
          for (int jj = 0; jj < 2; ++jj) { rw_chunk_load<0, 2>(F, b, h, d, bt * 16 + F.wave + 8 * jj, cur); rw_chunk_task(F, cur, wl, scr + (size_t)(F.wave + 8 * jj) * RWS_SLOT); } }
        asm volatile("s_waitcnt vmcnt(0)" ::: "memory");
        __syncthreads();
        {
            const int t = opaque_v(lane & 15), kg = opaque_v(lane >> 4), vb = opaque(F.wave) & 3;
            const unsigned char* scrb = F.a->ws + WS_RWSCR + (size_t)opaque(F.bid) * 16 * RWS_SLOT;
            LAS unsigned char* sbuf = F.lds;
            const int lt = opaque_v(F.tid) & 255; const bool loader = F.wave >= 4;
            const int lw = opaque(F.wave) & 3;
#define RWB_ISSUE(j_) do { const unsigned char* gp_ = scrb + (size_t)(j_) * RWS_SLOT + (size_t)(lw * 5) * 1024 + lane * 16; LAS unsigned char* lp_ = sbuf + ((j_) % 6) * RWS_SLOT + (lw * 5) * 1024; \
                _Pragma("unroll") for (int q = 0; q < 5; ++q) __builtin_amdgcn_global_load_lds((const unsigned*)(gp_ + q * 1024), (LAS unsigned*)(lp_ + q * 1024), 16, 0, 16); } while (0)
#define RWB_COMP(bi_, j_) do { const LAS unsigned char* sl_ = sbuf + (bi_) * RWS_SLOT; bf16x8 zb[2], qf[2]; \
                _Pragma("unroll") for (int ks = 0; ks < 2; ++ks) { zb[ks] = *(const LAS bf16x8*)(ZL + t * 64 + 32 * ks + 8 * kg); qf[ks] = *(const LAS bf16x8*)(sl_ + RWS_QY + (t * 64 + 32 * ks + 8 * kg) * 2); } \
                const v2u y_ = *(const LAS v2u*)(sl_ + RWS_YV + ((16 * vb + t) * 16 + 4 * kg) * 2); \
                f32x4 yacc = (f32x4){bflo(y_.x), bfhi(y_.x), bflo(y_.y), bfhi(y_.y)}; \
                yacc = mma16(qf[1], zb[1], mma16(qf[0], zb[0], yacc)); \
                f32x4 zn[4]; \
                _Pragma("unroll") for (int ktp = 0; ktp < 4; ++ktp) { const v2u z_ = *(const LAS v2u*)(sl_ + RWS_ZV + ((16 * vb + t) * 64 + 16 * ktp + 4 * kg) * 2); \
                    f32x4 zc = (f32x4){bflo(z_.x), bfhi(z_.x), bflo(z_.y), bfhi(z_.y)}; \
                    _Pragma("unroll") for (int ks = 0; ks < 2; ++ks) zc = mma16(*(const LAS bf16x8*)(sl_ + RWS_PZ + ((16 * ktp + t) * 64 + 32 * ks + 8 * kg) * 2), zb[ks], zc); \
                    zn[ktp] = zc; } \
                _Pragma("unroll") for (int r = 0; r < 4; ++r) { const int row = seq_row(b, d, (bt * 16 + (j_)) * 16 + 4 * kg + r); YD[((size_t)d * T_ALL + row) * 512 + h * 64 + 16 * vb + t] = yacc[r]; } \
                asm volatile("s_waitcnt lgkmcnt(0)" ::: "memory"); \
                _Pragma("unroll") for (int ktp = 0; ktp < 4; ++ktp) { v2u o; o.x = pk2(zn[ktp][0], zn[ktp][1]); o.y = pk2(zn[ktp][2], zn[ktp][3]); *(LAS v2u*)(ZL + t * 64 + 16 * ktp + 4 * kg) = o; } \
                asm volatile("s_waitcnt lgkmcnt(0)" ::: "memory"); } while (0)
#define RWB_BAR() do { asm volatile("s_waitcnt lgkmcnt(0)" ::: "memory"); __builtin_amdgcn_s_barrier(); asm volatile("" ::: "memory"); } while (0)
            if (loader) { RWB_ISSUE(0); RWB_ISSUE(1); RWB_ISSUE(2); RWB_ISSUE(3); asm volatile("s_waitcnt vmcnt(15)" ::: "memory"); }
            RWB_BAR();
#pragma unroll 1
            for (int j = 0; j < 16; ++j) {
                if (loader) { if (j + 4 < 16) { RWB_ISSUE(j + 4); asm volatile("s_waitcnt vmcnt(15)" ::: "memory"); } else { asm volatile("s_waitcnt vmcnt(0)" ::: "memory"); } }
                else { RWB_COMP(j % 6, j); }
                RWB_BAR();
            }
#undef RWB_BAR
#undef RWB_ISSUE
#undef RWB_COMP
        }
        __syncthreads();
    }
}

__device__ __forceinline__ void stage_rw_readout(const Ctx& F, int l) {
    const auto& a = *F.a; unsigned char* ws = a.ws; const int lane = F.lane;
    const bf16* SCN = (const bf16*)(ws + WS_SCN); const bf16* P = (const bf16*)(ws + WS_P); const float* YD = (const float*)(ws + WS_YDIR); bf16* YRW = (bf16*)(ws + WS_YRW);
    const int gw = F.bid * NWAVES + F.wave, NGW = F.G * NWAVES;
    constexpr int TR = 17, NRT = T_ALL / TR;
    for (int tile = gw; tile < NRT * 4; tile += NGW) {
        const int rt = tile % NRT, hp = tile / NRT, row0 = rt * TR, c0 = hp * 128 + 2 * lane;
        const f32x2 rk = *(const f32x2*)(a.in[I_RWRK] + l * 512 + c0), lng = *(const f32x2*)(a.in[I_RWLNG] + l * 512 + c0), lnb = *(const f32x2*)(a.in[I_RWLNB] + l * 512 + c0);
#pragma unroll 4
        for (int i = 0; i < TR; ++i) {
            const int row = row0 + i;
            const unsigned* sp = (const unsigned*)(SCN + (size_t)row * 9 * 512 + c0);
            const unsigned ru = sp[0], vu = sp[256], k0u = sp[4 * 256], k1u = sp[7 * 256];
            const f32x2 y0 = *(const f32x2*)(YD + (size_t)row * 512 + c0), y1 = *(const f32x2*)(YD + ((size_t)T_ALL + row) * 512 + c0);
            const unsigned gu = *(const unsigned*)(P + (size_t)row * 2560 + 2048 + c0);
            const float bon = red32(bflo(ru) * (bflo(k0u) + bflo(k1u)) * rk[0] + bfhi(ru) * (bfhi(k0u) + bfhi(k1u)) * rk[1]);
            f32x2 y = y0 + y1 + (f32x2){bflo(vu), bfhi(vu)} * bon;
            const float mu = red32(y[0] + y[1]) * (1.f / 64.f);
            y = y - mu;
            const float var = red32(y[0] * y[0] + y[1] * y[1]) * (1.f / 64.f);
            const f32x2 yn = y * (1.0f / sqrtf(var + 64e-5f));
            const f32x2 ov = (yn * lng + lnb) * (f32x2){bflo(gu), bfhi(gu)};
            *(unsigned*)(YRW + (size_t)row * 512 + c0) = pk2(ov[0], ov[1]);
        }
    }
}

constexpr size_t WS_S5E = 6 * MiB;
constexpr int S5_NSEG = 4, S5_SEGLEN = (CTXL + SEQ) / S5_NSEG;
__device__ __forceinline__ void s5_disc(const float are, const float aim, const float dt, float& lbr, float& lbi, float& cr, float& ci) {
    const float mag = expf(are * dt); lbr = mag * cosf(aim * dt); lbi = mag * sinf(aim * dt);
    const float den = are * are + aim * aim, nr = lbr - 1.0f; cr = (nr * are + lbi * aim) / den; ci = (lbi * are - nr * aim) / den;
}
template <int PASS>
__device__ __forceinline__ void stage_s5_scan(const Ctx& F, int l) {
    const auto& a = *F.a; unsigned char* ws = a.ws; const int lane = F.lane;
    const bf16* Z = (const bf16*)(ws + WS_Z); float* YP = (float*)(ws + WS_YP); f32x2* S5E = (f32x2*)(ws + WS_S5E);
    LAS unsigned char* wl = F.lds + F.wave * 16384;
    LAS float* buL = (LAS float*)wl;
    LAS bf16* Hs = (LAS bf16*)(wl + 8704);
    const int fr = lane & 15, kg = lane >> 4;
    for (int itx = F.bid * NWAVES + F.wave; itx < BATCH * 32 * 2 * S5_NSEG; itx += NWAVES * F.G) {
        const int seg = itx & (S5_NSEG - 1), it = itx >> 2;
        const int d = it & 1, g = (it >> 1) & 31, b = it >> 6, p = lane;
        const float dt = expf(a.in[I_S5LDT][(l * 2 + d) * 32 + g]);
        const float* arep = a.in[I_S5ARE] + ((size_t)(l * 2 + d) * 32 + g) * 64; const float* aimp = a.in[I_S5AIM] + ((size_t)(l * 2 + d) * 32 + g) * 64;
        float lbr, lbi, cr_, ci_; s5_disc(arep[p], aimp[p], dt, lbr, lbi, cr_, ci_);
        bf16x8 afr[2][4];
#pragma unroll
        for (int tl = 0; tl < 4; ++tl) { const int pp = 16 * tl + fr; float r0_, r1_, cr, ci; s5_disc(arep[pp], aimp[pp], dt, r0_, r1_, cr, ci);
            v4u pr = (v4u){0u, 0u, 0u, 0u}, pi = (v4u){0u, 0u, 0u, 0u};
            if (kg < 2) { const float* br = a.in[I_S5BRE] + (((size_t)l * 32 + g) * 64 + pp) * 16 + 8 * kg; const float* bi = a.in[I_S5BIM] + (((size_t)l * 32 + g) * 64 + pp) * 16 + 8 * kg;
                const f32x4 x0 = *(const f32x4*)br, x1 = *(const f32x4*)(br + 4), y0 = *(const f32x4*)bi, y1 = *(const f32x4*)(bi + 4);
                pr.x = pk2(cr * x0[0] - ci * y0[0], cr * x0[1] - ci * y0[1]); pr.y = pk2(cr * x0[2] - ci * y0[2], cr * x0[3] - ci * y0[3]);
                pr.z = pk2(cr * x1[0] - ci * y1[0], cr * x1[1] - ci * y1[1]); pr.w = pk2(cr * x1[2] - ci * y1[2], cr * x1[3] - ci * y1[3]);
                pi.x = pk2(cr * y0[0] + ci * x0[0], cr * y0[1] + ci * x0[1]); pi.y = pk2(cr * y0[2] + ci * x0[2], cr * y0[3] + ci * x0[3]);
                pi.z = pk2(cr * y1[0] + ci * x1[0], cr * y1[1] + ci * x1[1]); pi.w = pk2(cr * y1[2] + ci * x1[2], cr * y1[3] + ci * x1[3]); }
            afr[0][tl] = __builtin_bit_cast(bf16x8, pr); afr[1][tl] = __builtin_bit_cast(bf16x8, pi); }
        bf16x8 cf[4];
        f32x2 hst = (f32x2){0.f, 0.f};
        if (PASS == 1) {
#pragma unroll
            for (int kk = 0; kk < 4; ++kk) { const int p0 = 16 * kk + 4 * kg;
                const f32x4 c0 = *(const f32x4*)(a.in[I_S5CRE] + (((size_t)l * 32 + g) * 16 + fr) * 64 + p0), c1 = *(const f32x4*)(a.in[I_S5CIM] + (((size_t)l * 32 + g) * 16 + fr) * 64 + p0);
                v4u pk; pk.x = pk2(c0[0], -c1[0]); pk.y = pk2(c0[1], -c1[1]); pk.z = pk2(c0[2], -c1[2]); pk.w = pk2(c0[3], -c1[3]);
                cf[kk] = __builtin_bit_cast(bf16x8, pk); }
            float pr_ = lbr, pi_ = lbi, l64r = 1.f, l64i = 0.f;
#pragma unroll 1
            for (int q = 0; q < 10; ++q) { const float nr2 = pr_ * pr_ - pi_ * pi_, ni2 = 2.f * pr_ * pi_; pr_ = nr2; pi_ = ni2; if (q == 5) { l64r = pr_; l64i = pi_; } }
            const float lLr = pr_ * l64r - pi_ * l64i, lLi = pr_ * l64i + pi_ * l64r;
#pragma unroll 1
            for (int sgi = 0; sgi < seg; ++sgi) { const f32x2 ev = S5E[((size_t)it * S5_NSEG + sgi) * 64 + p];
                hst = (f32x2){lLr * hst[0] - lLi * hst[1] + ev[0], lLr * hst[1] + lLi * hst[0] + ev[1]}; }
        }
        const f32x2 lbr2 = (f32x2){lbr, lbr}, lbi2 = (f32x2){lbi, lbi};
        const int sbeg = seg * S5_SEGLEN, send = sbeg + S5_SEGLEN;
        v4u un = (v4u){0u, 0u, 0u, 0u}, uc;
#define S5_LOADU(s0_) do { if (kg < 2) { const int row_ = seq_row(b, d, (s0_) + fr); un = *(const v4u*)(Z + (size_t)row_ * IN_COLS + S5_OFF + g * 16 + kg * 8); } } while (0)
        S5_LOADU(sbeg);
#pragma unroll 1
        for (int s0 = sbeg; s0 < send; s0 += 16) {
            uc = un;
            if (s0 + 16 < send) S5_LOADU(s0 + 16);
            const bf16x8 ufr = __builtin_bit_cast(bf16x8, uc);
#pragma unroll
            for (int c = 0; c < 2; ++c)
#pragma unroll
                for (int tl = 0; tl < 4; ++tl) { const f32x4 dd = __builtin_amdgcn_mfma_f32_16x16x32_bf16(afr[c][tl], ufr, (f32x4){0.f, 0.f, 0.f, 0.f}, 0, 0, 0);
                    *(LAS f32x4*)(buL + (c * 16 + fr) * 68 + 16 * tl + 4 * kg) = dd; }
            LDS_WAIT(); asm volatile("" ::: "memory");
            f32x2 bu[16];
#pragma unroll
            for (int s = 0; s < 16; ++s) bu[s] = (f32x2){buL[s * 68 + p], buL[(16 + s) * 68 + p]};
#pragma unroll
            for (int s = 0; s < 16; ++s) {
                const f32x2 sw = (f32x2){-hst[1], hst[0]};
                hst = lbr2 * hst + (lbi2 * sw + bu[s]);
                if (PASS == 1) *(LAS unsigned*)(Hs + s * 136 + 2 * p) = pg8::cvt_pk_bf16(hst[0], hst[1]);
            }
            if (PASS == 1) {
                LDS_WAIT(); asm volatile("" ::: "memory");
                f32x4 acc = (f32x4){0.f, 0.f, 0.f, 0.f};
#pragma unroll
                for (int kk = 0; kk < 4; ++kk) { const bf16x8 af = *(const LAS bf16x8*)(Hs + fr * 136 + 32 * kk + 8 * kg); acc = __builtin_amdgcn_mfma_f32_16x16x32_bf16(af, cf[kk], acc, 0, 0, 0); }
#pragma unroll
                for (int r = 0; r < 4; ++r) { const int row = seq_row(b, d, s0 + 4 * kg + r); YP[((size_t)d * T_ALL + row) * 512 + g * 16 + fr] = acc[r]; }
            }
            LDS_WAIT(); asm volatile("" ::: "memory");
        }
        if (PASS == 0) S5E[((size_t)it * S5_NSEG + seg) * 64 + p] = hst;
#undef S5_LOADU
    }
}

__device__ __forceinline__ void stage_s5_prep(const Ctx& F, int l, int nrows) {
    const auto& a = *F.a; unsigned char* ws = a.ws;
    const bf16* Z = (const bf16*)(ws + WS_Z); const float* YP = (const float*)(ws + WS_YP); bf16* AS5 = (bf16*)(ws + WS_AS5);
    const float dsk = a.in[I_S5D][l * 512 + F.tid];
    for (int row = F.bid; row < nrows; row += F.G) {
        const int c = F.tid;
        const float u = bf2f(Z[(size_t)row * IN_COLS + S5_OFF + c]);
        const float y = YP[(size_t)row * 512 + c] + YP[((size_t)T_ALL + row) * 512 + c] + u * dsk;
        const float ge = 0.5f * y * (1.f + tanhf(0.7978845608028654f * (y + 0.044715f * y * y * y)));
        AS5[(size_t)row * 512 + c] = (bf16)f2bf(ge);
    }
}

__device__ __forceinline__ void stage_hy_pre(const Ctx& F, int l, int nrows) {
    const auto& a = *F.a; unsigned char* ws = a.ws; const int lane = F.lane;
    const bf16* Z = (const bf16*)(ws + WS_Z); bf16* UT = (bf16*)(ws + WS_UT);
    LAS unsigned char* tl = F.lds + F.wave * 16384;
    const float* cw = a.in[I_HYCW] + (size_t)l * 3 * 1536; const float* cbp = a.in[I_HYCB] + l * 1536;
    const int gw = F.bid * NWAVES + F.wave, NGW = F.G * NWAVES;
    const int q = lane >> 3, k = lane & 7;
    for (int tile = gw; tile < (nrows / 64) * 24; tile += NGW) {
        const int rt = tile / 24, ct = tile % 24, row0 = rt * 64, c0 = ct * 64;
        int base, pos0, n; row_seq(row0, base, pos0, n);
        const bf16* zt = Z + (size_t)row0 * IN_COLS + HY_OFF + c0 + 8 * k;
        v4u v[8], hv = (v4u){0u, 0u, 0u, 0u};
#pragma unroll
        for (int i = 0; i < 8; ++i) v[i] = *(const v4u*)(zt + (size_t)(8 * i + q) * IN_COLS);
        if (q == 0 && pos0 > 0) hv = *(const v4u*)(zt - (size_t)IN_COLS);
        if (q == 1 && pos0 + 64 < n) hv = *(const v4u*)(zt + (size_t)64 * IN_COLS);
#pragma unroll
        for (int i = 0; i < 8; ++i) { LAS unsigned* p = (LAS unsigned*)(tl + (1 + 8 * i + q) * 132 + 16 * k); p[0] = v[i].x; p[1] = v[i].y; p[2] = v[i].z; p[3] = v[i].w; }
        if (q < 2) { LAS unsigned* p = (LAS unsigned*)(tl + (q ? 65 : 0) * 132 + 16 * k); p[0] = hv.x; p[1] = hv.y; p[2] = hv.z; p[3] = hv.w; }
        LDS_WAIT(); asm volatile("" ::: "memory");
#pragma unroll 2
        for (int i = 0; i < 8; ++i) {
            const int ch = 8 * i + q, col = c0 + ch;
            const float w0 = cw[col], w1 = cw[1536 + col], w2 = cw[2 * 1536 + col], cb = cbp[col];
            const LAS unsigned short* s = (const LAS unsigned short*)(tl + (8 * k) * 132 + ch * 2);
            float z[10];
#pragma unroll
            for (int t = 0; t < 10; ++t) z[t] = __builtin_bit_cast(float, (unsigned)s[t * 66] << 16);
            float o[8];
#pragma unroll
            for (int t = 0; t < 8; ++t) o[t] = w0 * z[t] + w1 * z[t + 1] + w2 * z[t + 2] + cb;
            v4u w; w.x = pk2(o[0], o[1]); w.y = pk2(o[2], o[3]); w.z = pk2(o[4], o[5]); w.w = pk2(o[6], o[7]);
            *(v4u*)(UT + (size_t)col * T_ALL + row0 + 8 * k) = w;
        }
        LDS_WAIT(); asm volatile("" ::: "memory");
    }
}
__device__ __forceinline__ void stage_hy_post(const Ctx& F, int l, int nrows) {
    const auto& a = *F.a; unsigned char* ws = a.ws; const int lane = F.lane;
    const bf16* YT = (const bf16*)(ws + WS_UT) + (size_t)1024 * T_ALL; bf16* YHY = (bf16*)(ws + WS_YHY);
    LAS unsigned char* tl = F.lds + F.wave * 16384;
    const int gw = F.bid * NWAVES + F.wave, NGW = F.G * NWAVES;
    const int q = lane >> 3, k = lane & 7;
    for (int tile = gw; tile < (nrows / 64) * 8; tile += NGW) {
        const int rt = tile >> 3, ct = tile & 7, row0 = rt * 64, c0 = ct * 64;
        const bf16* yp = YT + (size_t)(c0 + q) * T_ALL + row0 + 8 * k;
        v4u v[8];
#pragma unroll
        for (int i = 0; i < 8; ++i) v[i] = *(const v4u*)(yp + (size_t)(8 * i) * T_ALL);
#pragma unroll
        for (int i = 0; i < 8; ++i) { LAS unsigned* p = (LAS unsigned*)(tl + (8 * i + q) * 132 + 16 * k); p[0] = v[i].x; p[1] = v[i].y; p[2] = v[i].z; p[3] = v[i].w; }
        LDS_WAIT(); asm volatile("" ::: "memory");
#pragma unroll
        for (int i = 0; i < 8; ++i) { const int r = 8 * i + q;
            const LAS unsigned short* s = (const LAS unsigned short*)(tl + (8 * k) * 132 + r * 2);
            unsigned e[8];
#pragma unroll
            for (int j = 0; j < 8; ++j) e[j] = s[j * 66];
            v4u w; w.x = e[0] | (e[1] << 16); w.y = e[2] | (e[3] << 16); w.z = e[4] | (e[5] << 16); w.w = e[6] | (e[7] << 16);
            *(v4u*)(YHY + (size_t)(row0 + r) * 512 + c0 + 8 * k) = w; }
        LDS_WAIT(); asm volatile("" ::: "memory");
    }
}
typedef float f32x16 __attribute__((ext_vector_type(16)));
__device__ __forceinline__ void hyena_item(const Ctx& F, int l, int c, int isctx) {
    const auto& a = *F.a; unsigned char* ws = a.ws; const int tid = F.tid, lane = F.lane;
    const int n = isctx ? CTXL : SEQ, rowbase = isctx ? T_LAT : 0, RL = isctx ? HY_RLENC : HY_RLEN, off = n + 47;
    const bf16* UT = (const bf16*)(ws + WS_UT);
    const bf16* x1g = UT + (size_t)c * T_ALL + rowbase; const bf16* x2g = UT + (size_t)(512 + c) * T_ALL + rowbase; bf16* vg = (bf16*)UT + (size_t)(1024 + c) * T_ALL + rowbase;
    const bf16* Rg = (const bf16*)(ws + WS_GF + l * GF_STRIDE + (isctx ? GF_CTX : 0)) + (size_t)c * RL;
    LAS unsigned char* XB = F.lds; LAS unsigned char* R1 = F.lds + HY_R1_OFF; LAS unsigned char* R2 = F.lds + HY_R2_OFF;
    { const int cpb = n / 8;
      for (int q = tid; q < 8 * cpb; q += NTHREADS) { const int b = q / cpb, ch = q % cpb; *(LAS v4u*)(XB + b * HY_ROWB + 2 * HY_MARG + 16 * ch) = *(const v4u*)(vg + (size_t)b * n + 8 * ch); }
      if (tid < 256) { const int b = tid >> 5, side = (tid >> 4) & 1, ch = tid & 15; const unsigned zz = (unsigned)opaque_v(0); *(LAS v4u*)(XB + b * HY_ROWB + (side ? 2 * (HY_MARG + n) : 0) + 16 * ch) = (v4u){zz, zz, zz, zz}; }
      const int rch = RL / 8;
      for (int q = tid; q < rch; q += NTHREADS) { *(LAS v4u*)(R1 + 16 * q) = *(const v4u*)(Rg + 8 * q); *(LAS v4u*)(R2 + 16 * q) = *(const v4u*)(Rg + (size_t)512 * RL + 8 * q); } }
    __syncthreads();
    const int i = lane & 31, kg = lane >> 5, jb = lane & 3, bb = (lane & 31) >> 2;
    const int rsh = (off - i) & 7, rd = rsh >> 1; const bool s1 = rd & 1, s2 = rd & 2; const unsigned sh = (rsh & 1) ? 16u : 0u;
    const int aconst = 2 * (off - i + 8 * kg - rsh), bconst = bb * HY_ROWB + 2 * (HY_MARG + 32 * jb + 8 * kg);
    const int T0w = 512 * F.wave; const int ntile = (n - T0w) >= 512 ? 4 : ((n - T0w) > 0 ? (n - T0w) / 128 : 0);
    const float bias0 = a.in[I_HYBIAS][(l * 2 + 0) * 512 + c], bias1 = a.in[I_HYBIAS][(l * 2 + 1) * 512 + c];
    f32x16 acc[4];
    v2u y1p[4][4];
#define HY_AFRAG(wa, wb, afr) do { \
        const unsigned a0 = s1 ? wa.y : wa.x, a1 = s1 ? wa.z : wa.y, a2 = s1 ? wa.w : wa.z, a3 = s1 ? wb.x : wa.w, a4 = s1 ? wb.y : wb.x, a5 = s1 ? wb.z : wb.y, a6 = s1 ? wb.w : wb.z; \
        const unsigned b0 = s2 ? a2 : a0, b1 = s2 ? a3 : a1, b2 = s2 ? a4 : a2, b3 = s2 ? a5 : a3, b4 = s2 ? a6 : a4; \
        v4u af_; af_.x = __builtin_amdgcn_alignbit(b1, b0, sh); af_.y = __builtin_amdgcn_alignbit(b2, b1, sh); af_.z = __builtin_amdgcn_alignbit(b3, b2, sh); af_.w = __builtin_amdgcn_alignbit(b4, b3, sh); \
        afr = __builtin_bit_cast(bf16x8, af_); } while (0)
#define HY_STEP_COND(RB, d) do { \
        const v4u wa = *(const LAS v4u*)((RB) + aconst - 2 * (d)), wb = *(const LAS v4u*)((RB) + aconst - 2 * (d) + 16); bf16x8 afr; HY_AFRAG(wa, wb, afr); \
        _Pragma("unroll") for (int m = 0; m < 4; ++m) { const int T0 = T0w + 128 * m; \
            if (m < ntile && (d) >= T0 - n + 16 && (d) <= T0 + 96) { const bf16x8 bfr = *(const LAS bf16x8*)(XB + bconst + 2 * (T0 - (d))); \
                acc[m] = __builtin_amdgcn_mfma_f32_32x32x16_bf16(afr, bfr, acc[m], 0, 0, 0); } } } while (0)
#define HY_LOAD(RB, d, wa, wb, bq) do { wa = *(const LAS v4u*)((RB) + aconst - 2 * (d)); wb = *(const LAS v4u*)((RB) + aconst - 2 * (d) + 16); \
        _Pragma("unroll") for (int m = 0; m < 4; ++m) bq[m] = *(const LAS bf16x8*)(XB + bconst + 2 * (T0w + 128 * m - (d))); } while (0)
#define HY_MMA(wa, wb, bq) do { bf16x8 afr; HY_AFRAG(wa, wb, afr); \
        _Pragma("unroll") for (int m = 0; m < 4; ++m) acc[m] = __builtin_amdgcn_mfma_f32_32x32x16_bf16(afr, bq[m], acc[m], 0, 0, 0); } while (0)
#define HY_CONV(RB) do { \
        _Pragma("unroll") for (int m = 0; m < 4; ++m) _Pragma("unroll") for (int e = 0; e < 16; ++e) acc[m][e] = 0.f; \
        if (ntile == 4) { \
            const int dA = T0w - n + 16, dB = T0w + 384 - n + 16, dC = T0w + 96, dD = T0w + 384 + 96;     \
            _Pragma("unroll 1") for (int d = dA; d < dB; d += 16) HY_STEP_COND(RB, d); \
            { v4u waA, wbA, waB, wbB; bf16x8 bqA[4], bqB[4]; \
              HY_LOAD(RB, dB, waA, wbA, bqA); \
              _Pragma("unroll 1") for (int d = dB; d <= dC; d += 32) { \
                  if (d + 16 <= dC) HY_LOAD(RB, d + 16, waB, wbB, bqB); \
                  __builtin_amdgcn_sched_barrier(0); \
                  HY_MMA(waA, wbA, bqA); \
                  __builtin_amdgcn_sched_barrier(0); \
                  if (d + 32 <= dC) HY_LOAD(RB, d + 32, waA, wbA, bqA); \
                  __builtin_amdgcn_sched_barrier(0); \
                  if (d + 16 <= dC) HY_MMA(waB, wbB, bqB); \
                  __builtin_amdgcn_sched_barrier(0); } } \
            _Pragma("unroll 1") for (int d = dC + 16; d <= dD; d += 16) HY_STEP_COND(RB, d); \
        } else if (ntile > 0) { const int dhi = T0w + 128 * (ntile - 1) + 96; \
            _Pragma("unroll 1") for (int d = T0w - n + 16; d <= dhi; d += 16) HY_STEP_COND(RB, d); } } while (0)
    HY_CONV(R1);
#pragma unroll
    for (int m = 0; m < 4; ++m) if (m < ntile) {
#pragma unroll
        for (int rg = 0; rg < 4; ++rg) { const int t4 = T0w + 128 * m + 32 * jb + 8 * rg + 4 * kg;
            const v2u xv = *(const v2u*)(x1g + (size_t)bb * n + t4); const v2u vv = *(const LAS v2u*)(XB + bb * HY_ROWB + 2 * (HY_MARG + t4));
            const float y0 = bflo(xv.x) * (acc[m][4 * rg + 0] + bias0 * bflo(vv.x)), y1 = bfhi(xv.x) * (acc[m][4 * rg + 1] + bias0 * bfhi(vv.x));
            const float y2 = bflo(xv.y) * (acc[m][4 * rg + 2] + bias0 * bflo(vv.y)), y3 = bfhi(xv.y) * (acc[m][4 * rg + 3] + bias0 * bfhi(vv.y));
            y1p[m][rg].x = pk2(y0, y1); y1p[m][rg].y = pk2(y2, y3); } }
    __syncthreads();
#pragma unroll
    for (int m = 0; m < 4; ++m) if (m < ntile) {
#pragma unroll
        for (int rg = 0; rg < 4; ++rg) { const int t4 = T0w + 128 * m + 32 * jb + 8 * rg + 4 * kg; *(LAS v2u*)(XB + bb * HY_ROWB + 2 * (HY_MARG + t4)) = y1p[m][rg]; } }
    __syncthreads();
    HY_CONV(R2);
#pragma unroll
    for (int m = 0; m < 4; ++m) if (m < ntile) {
#pragma unroll
        for (int rg = 0; rg < 4; ++rg) { const int t4 = T0w + 128 * m + 32 * jb + 8 * rg + 4 * kg;
            const v2u xv = *(const v2u*)(x2g + (size_t)bb * n + t4); const v2u yv = y1p[m][rg];
            const float o0 = bflo(xv.x) * (acc[m][4 * rg + 0] + bias1 * bflo(yv.x)), o1 = bfhi(xv.x) * (acc[m][4 * rg + 1] + bias1 * bfhi(yv.x));
            const float o2 = bflo(xv.y) * (acc[m][4 * rg + 2] + bias1 * bflo(yv.y)), o3 = bfhi(xv.y) * (acc[m][4 * rg + 3] + bias1 * bfhi(yv.y));
            v2u ov; ov.x = pk2(o0, o1); ov.y = pk2(o2, o3); *(v2u*)(vg + (size_t)bb * n + t4) = ov; } }
    __syncthreads();
#undef HY_CONV
#undef HY_AFRAG
#undef HY_STEP_COND
#undef HY_LOAD
#undef HY_MMA
}
__device__ __forceinline__ void stage_mixer(const Ctx& F, int l) {
    unsigned* ctr = (unsigned*)(F.a->ws + WS_CTL) + CW_WORK + 64 * l;
    LAS int* itb = (LAS int*)(F.lds + LDSCTL_OFF + 512);
    const int nit = 128 + 512 + (l == 0 ? 512 : 0);
#ifdef PROBE_STATIC
    return;
#endif
    for (;;) {
        if (F.tid == 0) *itb = (int)__hip_atomic_fetch_add(ctr, 1u, __ATOMIC_RELAXED, __HIP_MEMORY_SCOPE_AGENT);
        __syncthreads();
        const int it = *itb;
        __syncthreads();
        if (it >= nit) break;
        Ctx Fi; Fi.a = kargs(); Fi.tid = opaque_v((int)threadIdx.x); Fi.lane = Fi.tid & 63; Fi.wave = __builtin_amdgcn_readfirstlane(Fi.tid >> 6); Fi.bid = opaque((int)blockIdx.x); Fi.G = opaque((int)gridDim.x);
        Fi.lds = (LAS unsigned char*)((LAS unsigned char*)0 + opaque(0)) + (F.lds - (LAS unsigned char*)0);
#ifdef PROBE_T
        if (l == 0 && F.tid == 0 && it == 5) ((unsigned long long*)(F.a->ws + WS_CTL + CW_STAMP * 4))[21] = __builtin_amdgcn_s_memrealtime();
        if (l == 0 && F.tid == 0 && it == 300) ((unsigned long long*)(F.a->ws + WS_CTL + CW_STAMP * 4))[23] = __builtin_amdgcn_s_memrealtime();
#endif
        if (it < 128) { for (int rep = 0; rep < ((DUPK == 9) ? 2 : 1); ++rep) rw_chunk_item2(Fi, opaque(l), it); }
        else if (it < 640) hyena_item(Fi, opaque(l), it - 128, 0);
        else hyena_item(Fi, opaque(l), it - 640, 1);
#ifdef PROBE_T
        if (l == 0 && F.tid == 0 && it == 5) ((unsigned long long*)(F.a->ws + WS_CTL + CW_STAMP * 4))[22] = __builtin_amdgcn_s_memrealtime();
        if (l == 0 && F.tid == 0 && it == 300) ((unsigned long long*)(F.a->ws + WS_CTL + CW_STAMP * 4))[24] = __builtin_amdgcn_s_memrealtime();
#endif
    }
}

typedef float f32x16r __attribute__((ext_vector_type(16)));
__device__ __forceinline__ void stage_norm2_router(const Ctx& F, int l, int nrows) {
    const auto& a = *F.a; unsigned char* ws = a.ws; const int lane = F.lane;
    const float* X = (const float*)(ws + WS_X); bf16* H = (bf16*)(ws + WS_H); const float* MOD = (const float*)(ws + WS_MOD);
    int* EIDX = (int*)(ws + WS_EIDX); float* GATE = (float*)(ws + WS_GATE); int* BLKCNT = (int*)(ws + WS_BLKCNT);
    LAS float* lg = (LAS float*)(F.lds + F.wave * 4352);
    LAS int* hist = (LAS int*)(F.lds + LDSCTL_OFF + 1024);
    if (F.tid < 32) hist[F.tid] = 0;
    __syncthreads();
    const int rpb = (nrows + F.G - 1) / F.G, r0 = F.bid * rpb, r1 = (r0 + rpb < nrows) ? r0 + rpb : nrows;
    const float* rw = a.in[I_RTW] + (size_t)l * 1024 * 32;
    const int i = lane & 31, kk = lane >> 5;
    const f32x4* ng = (const f32x4*)(a.in[I_N2G] + l * D) + kk;
    for (int rb = r0 + F.wave * 32; rb < r1; rb += NWAVES * 32) {
        const int nrow = (r1 - rb) < 32 ? (r1 - rb) : 32; const bool live = i < nrow;
        const int row = live ? rb + i : r1 - 1; const int w = row < T_LAT ? (row >> 12) : 8;
        const f32x4* xr = (const f32x4*)(X + (size_t)row * D) + kk;
        float ss = 0.f;
#pragma unroll 8
        for (int q = 0; q < 128; ++q) { const f32x4 v = xr[2 * q]; ss += (v[0] * v[0] + v[1] * v[1]) + (v[2] * v[2] + v[3] * v[3]); }
        ss += __builtin_bit_cast(float, __builtin_amdgcn_ds_bpermute((lane ^ 32) << 2, __builtin_bit_cast(int, ss)));
        const float rstd = 1.0f / sqrtf(ss * (1.f / D) + 1e-6f);
        const f32x4* sh = (const f32x4*)(MOD + (size_t)(l * 9 + w) * 6144 + 3072) + kk; const f32x4* sc = (const f32x4*)(MOD + (size_t)(l * 9 + w) * 6144 + 4096) + kk;
        v2u* ho = (v2u*)(H + (size_t)row * D) + kk;
        f32x16r acc;
#pragma unroll
        for (int e = 0; e < 16; ++e) acc[e] = 0.f;
        const float* wp = rw + (size_t)(4 * kk) * 32 + i;
#pragma unroll 2
        for (int q = 0; q < 128; ++q) {
            const f32x4 xv = xr[2 * q]; const f32x4 h4 = xv * rstd * ng[2 * q] * (sc[2 * q] + 1.0f) + sh[2 * q];
            const float w0 = wp[(size_t)(8 * q) * 32], w1 = wp[(size_t)(8 * q + 1) * 32], w2 = wp[(size_t)(8 * q + 2) * 32], w3 = wp[(size_t)(8 * q + 3) * 32];
            if (live) { v2u o; o.x = pk2(h4[0], h4[1]); o.y = pk2(h4[2], h4[3]); ho[2 * q] = o; }
            acc = __builtin_amdgcn_mfma_f32_32x32x2f32(h4[0], w0, acc, 0, 0, 0);
            acc = __builtin_amdgcn_mfma_f32_32x32x2f32(h4[1], w1, acc, 0, 0, 0);
            acc = __builtin_amdgcn_mfma_f32_32x32x2f32(h4[2], w2, acc, 0, 0, 0);
            acc = __builtin_amdgcn_mfma_f32_32x32x2f32(h4[3], w3, acc, 0, 0, 0);
        }
        const float rbias = a.in[I_RTB][l * 32 + i];
#pragma unroll
        for (int r = 0; r < 16; ++r) { const int ri = (r & 3) + 8 * (r >> 2) + 4 * kk; lg[ri * 33 + i] = acc[r] + rbias; }
        LDS_WAIT(); asm volatile("" ::: "memory");
        if (lane < nrow) {
            LAS float* lr = lg + lane * 33; const int orow = rb + lane;
            float tv[4]; int ti[4];
#pragma unroll
            for (int r = 0; r < 4; ++r) { float bv = -INFINITY; int bi = 0;
#pragma unroll 8
                for (int e = 0; e < 32; ++e) { const float v = lr[e]; if (v > bv) { bv = v; bi = e; } }
                tv[r] = bv; ti[r] = bi; lr[bi] = -INFINITY; }
            const float e1 = expf(tv[1] - tv[0]), e2 = expf(tv[2] - tv[0]), e3 = expf(tv[3] - tv[0]); const float inv = 1.0f / (1.0f + e1 + e2 + e3);
            *(int4*)(EIDX + orow * 4) = make_int4(ti[0], ti[1], ti[2], ti[3]); *(f32x4*)(GATE + orow * 4) = (f32x4){inv, e1 * inv, e2 * inv, e3 * inv};
#pragma unroll
            for (int r = 0; r < 4; ++r) __hip_atomic_fetch_add(&hist[ti[r]], 1, __ATOMIC_RELAXED, __HIP_MEMORY_SCOPE_WORKGROUP);
        }
        LDS_WAIT(); asm volatile("" ::: "memory");
    }
    __syncthreads();
    if (F.tid < 32) BLKCNT[F.bid * 32 + F.tid] = hist[F.tid];
    __syncthreads();
}

__device__ __forceinline__ void stage_moe_scatter(const Ctx& F, int l, int nrows) {
    const auto& a = *F.a; unsigned char* ws = a.ws; const int lane = F.lane;
    const bf16* H = (const bf16*)(ws + WS_H); bf16* XS = (bf16*)(ws + WS_XS);
    const int* EIDX = (const int*)(ws + WS_EIDX); int* POS = (int*)(ws + WS_POS); const int* BLKCNT = (const int*)(ws + WS_BLKCNT); int* META = (int*)(ws + WS_META);
    LAS int* tot = (LAS int*)F.lds; LAS int* off = tot + 32; LAS int* base = tot + 64; LAS int* posl = tot + 128; LAS int* eloc = tot + 4096;
    const int rpb = (nrows + F.G - 1) / F.G, r0 = F.bid * rpb, r1 = (r0 + rpb < nrows) ? r0 + rpb : nrows; const int na = (r1 > r0) ? (r1 - r0) * 4 : 0;
    for (int i = F.tid; i < na; i += NTHREADS) eloc[i] = EIDX[r0 * 4 + i];
    { LAS int* part = tot + 8192; const int e = F.tid & 31, pt = F.tid >> 5; int t = 0, o = 0;
      for (int b2 = pt; b2 < F.G; b2 += 16) { const int c = BLKCNT[b2 * 32 + e]; t += c; o += (b2 < F.bid) ? c : 0; }
      part[pt * 32 + e] = t; part[512 + pt * 32 + e] = o; }
    __syncthreads();
    if (F.tid < 32) { LAS int* part = tot + 8192; int t = 0, o = 0;
#pragma unroll
        for (int pt = 0; pt < 16; ++pt) { t += part[pt * 32 + F.tid]; o += part[512 + pt * 32 + F.tid]; }
        tot[F.tid] = t; off[F.tid] = o; }
    __syncthreads();
    if (F.tid == 0) { int acc = 0; for (int e = 0; e < 32; ++e) { base[e] = acc; acc += (tot[e] + 255) & ~255; } base[32] = acc; }
    __syncthreads();
    if (F.bid == 0 && F.tid < 33) META[F.tid] = base[F.tid];
    unsigned* ROWOF = (unsigned*)(ws + WS_ROWOF);
    if (F.tid < 32) { int run = base[F.tid] + off[F.tid]; for (int i = 0; i < na; ++i) { if (eloc[i] == F.tid) { POS[r0 * 4 + i] = run; ROWOF[run] = (unsigned)(r0 + (i >> 2)) * (unsigned)(D * 2); ++run; } } }
    for (int e = F.bid; e < 32; e += F.G) for (int i = base[e] + tot[e] + F.tid; i < base[e + 1]; i += NTHREADS) ROWOF[i] = 0u;
    __syncthreads();
}
__device__ __forceinline__ LAS int* load_moe_base(const Ctx& F) {
    LAS int* base = (LAS int*)(F.lds + LDSCTL_OFF + 256);
    const int* META = (const int*)(F.a->ws + WS_META);
    if (F.tid < 33) base[F.tid] = META[F.tid];
    __syncthreads();
    return base;
}

constexpr int NSTAGE_L = 13, NSTAGES = 1 + DEPTH * NSTAGE_L + 1;
__global__ void __launch_bounds__(NTHREADS, 2) mk_fwd(Args args) {
    extern __shared__ __attribute__((aligned(16))) unsigned char lds_raw[];
    Ctx F; F.a = kargs(); F.lds = (LAS unsigned char*)lds_raw; F.tid = threadIdx.x; F.lane = F.tid & 63; F.wave = __builtin_amdgcn_readfirstlane(F.tid >> 6); F.bid = blockIdx.x; F.G = gridDim.x;
    volatile LAS unsigned* MISC = (volatile LAS unsigned*)(F.lds + LDSCTL_OFF);
    for (int u = F.tid; u < (LDS_BYTES - LDSCTL_OFF) / 4; u += NTHREADS) ((LAS unsigned*)(F.lds + LDSCTL_OFF))[u] = 0u;
    __syncthreads();
#if MK_PER_STAGE
#define GRID_BAR() do { } while (0)
#else
    (void)xcd_barrier_post((unsigned*)(F.a->ws + WS_CTL) + CW_BAR, MISC + 8);
#define GRID_BAR() do { XcdBarrier b_; b_.bar = (unsigned*)(kargs()->ws + WS_CTL) + CW_BAR; b_.x = xb_xcc_id(); b_.st = (volatile LAS unsigned*)((LAS unsigned char*)lds_raw + LDSCTL_OFF + opaque(32)); xcd_barrier(b_); } while (0)
#endif
#ifndef ONLY_S
#define ONLY_S -1
#endif
#define STG_SEL(k) (ONLY_S < 0 || ONLY_S == (((k) == 0) ? 0 : ((k) == NSTAGES - 1 ? 14 : (((k) - 1) % NSTAGE_L) + 1)))
#if MK_PER_STAGE
#define IN(k) (STG_SEL(k) && kargs()->ph_lo == (k))
#else
#define IN(k) STG_SEL(k)
#endif
#if MK_PER_STAGE
#define SEAM(k) do { } while (0)
#else
#define SEAM(k) do { if ((k) + 1 < NSTAGES) GRID_BAR(); } while (0)
#endif
#define STAGE(k) if (IN(k)) { F.a = kargs(); F.tid = opaque_v((int)threadIdx.x); F.lane = F.tid & 63; F.wave = __builtin_amdgcn_readfirstlane(F.tid >> 6); F.bid = opaque((int)blockIdx.x); F.G = opaque((int)gridDim.x); F.lds = (LAS unsigned char*)lds_raw + opaque(0); unsigned char* ws = F.a->ws; const int l = opaque(lq); unsigned char* wl = ws + WS_WTS + (size_t)l * WL_STRIDE; (void)wl; (void)ws;
#define STAGE_END(k) } SEAM(k);
    int lq = 0;
    STAGE(0) p0_prologue(F); STAGE_END(0)
    for (lq = 0; lq < DEPTH; ++lq) {
        const int sb = 1 + lq * NSTAGE_L;
        const int nrl = opaque((lq == DEPTH - 1) ? T_LAT : T_ALL);
        STAGE(sb + 0) stage_norm1(F, l); STAGE_END(sb + 0)
        STAGE(sb + 1) pg8::SchedStatic S; S.init(ws + WS_H, wl + WO_WIN, T_ALL, IN_COLS, 1024, F.G, F.bid); pg8::EpiBf16 E{(bf16*)(ws + WS_Z), IN_COLS, nullptr, 0};
            pg8::gemm_phase(F.lds, F.tid, 1024, S, E); STAGE_END(sb + 1)
        STAGE(sb + 2) for (int rep = 0; rep < REPN(1); ++rep) stage_rw_prep1(F, l); for (int rep = 0; rep < REPN(2); ++rep) stage_s5_scan<0>(F, l); for (int rep = 0; rep < REPN(3); ++rep) stage_hy_pre(F, l, nrl); STAGE_END(sb + 2)
        STAGE(sb + 3) { pg8::SchedStatic S; S.init(ws + WS_ARW, wl + WO_RWCAT, T_ALL, 2560, 256, F.G, F.bid); pg8::EpiBf16 E{(bf16*)(ws + WS_P), 2560, nullptr, 0}; PT(4); pg8::gemm_phase(F.lds, F.tid, 256, S, E); PT(5); }
            for (int rep = 0; rep < REPN(4); ++rep) stage_s5_scan<1>(F, l); STAGE_END(sb + 3)
        STAGE(sb + 4) for (int rep = 0; rep < REPN(5); ++rep) stage_rw_prep2(F, l); for (int rep = 0; rep < REPN(6); ++rep) stage_s5_prep(F, l, nrl); STAGE_END(sb + 4)
        STAGE(sb + 5) PT(10); stage_mixer(F, l); PT(11); STAGE_END(sb + 5) STAGE(sb + 5) PT(12); }
        STAGE(sb + 6) { pg8::SchedStatic S; S.init(ws + WS_AS5, wl + WO_GLU, nrl, 1024, 512, F.G, F.bid); pg8::EpiGlu<0> E{(bf16*)(ws + WS_YS5), 512, F.a->in[I_S5GLUB] + l * 1024, 0, 512}; PT(13); pg8::gemm_phase(F.lds, F.tid, 512, S, E); PT(14); }
            for (int rep = 0; rep < REPN(7); ++rep) stage_rw_readout(F, l); for (int rep = 0; rep < REPN(8); ++rep) stage_hy_post(F, l, nrl); STAGE_END(sb + 6)
        STAGE(sb + 7) pg8::SchedMerge S; S.A0 = (const char*)(ws + WS_YHY); S.A1 = (const char*)(ws + WS_YRW); S.A2 = (const char*)(ws + WS_YS5); S.Bt = (const char*)(wl + WO_WBR); S.tstep = (size_t)256 * 512 * 2; S.bstride = (size_t)1024 * 512 * 2;
            S.nM = nrl / 256; S.nN = 4; S.G = F.G; S.c = F.bid;
            pg8::EpiMerge E{(float*)(ws + WS_MTMP), (bf16*)(ws + WS_H), (const bf16*)(ws + WS_Z) + GATE_OFF}; pg8::gemm_phase(F.lds, F.tid, 512, S, E); STAGE_END(sb + 7)
        STAGE(sb + 8) pg8::SchedStatic S; S.init(ws + WS_H, wl + WO_WOUT, nrl, 1024, 1024, F.G, F.bid); pg8::EpiResid E{(float*)(ws + WS_X), (const float*)(ws + WS_MOD) + (size_t)l * 9 * 6144 + 2048};
            pg8::gemm_phase(F.lds, F.tid, 1024, S, E); STAGE_END(sb + 8)
        STAGE(sb + 9) PT(17); stage_norm2_router(F, l, nrl); PT(18); STAGE_END(sb + 9)
        STAGE(sb + 10) PT(19); stage_moe_scatter(F, l, nrl); PT(20); STAGE_END(sb + 10)
        STAGE(sb + 11) LAS int* base = load_moe_base(F);
            pg8::SchedMoeG S; S.A = (const char*)(ws + WS_H); S.rowof = (const unsigned*)(ws + WS_ROWOF); S.Bt = (const char*)(wl + WO_W1); S.tstep = (size_t)256 * 1024 * 2; S.estride = (size_t)2048 * 1024 * 2; S.NPN = 8; S.G = F.G; S.c = F.bid; S.base = base;
            pg8::EpiGlu<1> E{(bf16*)(ws + WS_ACT), 1024, F.a->in[I_B1] + (size_t)l * 32 * 2048, 2048, 1024}; pg8::gemm_phase(F.lds, F.tid, 1024, S, E); STAGE_END(sb + 11)
        STAGE(sb + 12) LAS int* base = load_moe_base(F);
            pg8::SchedMoe S; S.A = (const char*)(ws + WS_ACT); S.Bt = (const char*)(wl + WO_W2); S.tstep = (size_t)256 * 1024 * 2; S.estride = (size_t)1024 * 1024 * 2; S.NPN = 4; S.G = F.G; S.c = F.bid; S.base = base;
            pg8::EpiBf16 E{(bf16*)(ws + WS_XS), 1024, F.a->in[I_B2] + (size_t)l * 32 * 1024, 1024}; pg8::gemm_phase(F.lds, F.tid, 1024, S, E); STAGE_END(sb + 12)
    }
    lq = DEPTH;
    STAGE(NSTAGES - 1)
#ifndef PROBE_T
        stage_norm1(F, l);
#endif
#ifdef PROBE_T
        { const unsigned long long* st = (const unsigned long long*)(F.a->ws + WS_CTL + CW_STAMP * 4); const float cval = (float)(long long)(st[PROBE_B] - st[PROBE_A]) * (1.0f / (100.0f * PROBE_DIV));
          __syncthreads(); for (size_t i = (size_t)F.bid * NTHREADS + F.tid; i < (size_t)T_LAT * D; i += (size_t)F.G * NTHREADS) F.a->out[i] = cval; }
#endif
    }
#undef IN
#undef SEAM
}

extern "C" void kernel_launch(void* const* d_in, const int* in_sizes, int n_in, void* d_out, int out_size, void* d_ws, size_t ws_size, hipStream_t stream) {
    static int grid = 0;
    if (grid == 0) {
        if (n_in != 51 || out_size != T_LAT * D || ws_size < WS_END) { fprintf(stderr, "kernel_launch: unexpected shapes (n_in %d out %d ws %zu, need %zu)\n", n_in, out_size, ws_size, (size_t)WS_END); grid = -1; return; }
        int dev = 0, cus = 0, per_cu = 0;
        if (hipGetDevice(&dev) != hipSuccess || hipDeviceGetAttribute(&cus, hipDeviceAttributeMultiprocessorCount, dev) != hipSuccess) { grid = -1; return; }
        if (hipFuncSetAttribute((const void*)mk_fwd, hipFuncAttributeMaxDynamicSharedMemorySize, LDS_BYTES) != hipSuccess) { fprintf(stderr, "kernel_launch: hipFuncSetAttribute failed\n"); grid = -1; return; }
        if (hipOccupancyMaxActiveBlocksPerMultiprocessor(&per_cu, (const void*)mk_fwd, NTHREADS, LDS_BYTES) != hipSuccess || per_cu < 1) fprintf(stderr, "kernel_launch: occupancy query says %d\n", per_cu);
        (void)hipGetLastError();
        grid = cus;
    }
    if (grid < 0) return;
    if (hipMemsetAsync((char*)d_ws + WS_CTL, 0, CTL_ZERO_BYTES, stream) != hipSuccess) return;
    Args a{};
    for (int i = 0; i < 51; ++i) a.in[i] = (const float*)d_in[i];
    a.out = (float*)d_out; a.ws = (unsigned char*)d_ws;
#if MK_PER_STAGE
    for (int s = 0; s < NSTAGES; ++s) { a.ph_lo = s; a.ph_hi = s + 1; int reps = 1;
#ifdef PROBE_SET
        { const int ls = (s == 0 || s == NSTAGES - 1) ? -1 : (s - 1) % NSTAGE_L;
          if (PROBE_SET >= 1 && PROBE_SET <= 13 && ls == PROBE_SET - 1 && ls != 5 && ls != 8 && !(ls == 0 && s > 1)) reps = 3;
          if (PROBE_SET == 14 && s == 0) reps = 3; }
#endif
        for (int r = 0; r < reps; ++r) hipLaunchKernelGGL(mk_fwd, dim3(grid), dim3(NTHREADS), LDS_BYTES, stream, a); }
#else
    a.ph_lo = 0; a.ph_hi = NSTAGES; hipLaunchKernelGGL(mk_fwd, dim3(grid), dim3(NTHREADS), LDS_BYTES, stream, a);
#endif
}
```

```cpp
#include <hip/hip_runtime.h>
#include <cstdio>
#include <cstdint>

#ifndef DUPK
#define DUPK 0
#endif
#define REPN(k) ((DUPK == (k)) ? 3 : 1)
#ifndef REP_GEMM
#define REP_GEMM 1
#endif
#ifndef REP_LIGHT
#define REP_LIGHT 1
#endif
#ifndef REP_PRO
#define REP_PRO 1
#endif
#ifndef MK_PER_STAGE
#define MK_PER_STAGE 0
#endif

#define GAS __attribute__((address_space(1)))
#define LAS __attribute__((address_space(3)))
typedef unsigned short bf16;
typedef unsigned v4u __attribute__((ext_vector_type(4)));
typedef unsigned v2u __attribute__((ext_vector_type(2)));
typedef float f32x4 __attribute__((ext_vector_type(4)));
typedef float f32x2 __attribute__((ext_vector_type(2)));
typedef short bf16x8 __attribute__((ext_vector_type(8)));

constexpr int D = 1024, BATCH = 8, SEQ = 4096, CTXL = 256, DEPTH = 2;
constexpr int T_LAT = BATCH * SEQ, T_CTX = BATCH * CTXL, T_ALL = T_LAT + T_CTX;
constexpr int IN_COLS = 6912, HY_OFF = 0, RW_OFF = 1536, S5_OFF = 3328, GATE_OFF = 3840;
constexpr int NE = 32, TOPK = 4;
constexpr int MAXSLOT = 147456;
constexpr int NWAVES = 8, NTHREADS = 512;
constexpr int HY_MARG = 128, HY_ROWB = 8720, HY_RLEN = 8272, HY_RLENC = 592;
constexpr int HY_R1_OFF = 8 * HY_ROWB, HY_R2_OFF = HY_R1_OFF + HY_RLEN * 2;

constexpr size_t MiB = 1ull << 20;
constexpr size_t WS_CTL = 0, CTL_ZERO_BYTES = 1 * MiB;
constexpr size_t WS_MOD = 1 * MiB;
constexpr size_t WS_BLKCNT = 2 * MiB;
constexpr size_t WS_META = 2 * MiB + 512 * 1024;
constexpr size_t WS_ROWOF = 7 * MiB;
constexpr size_t WS_EIDX = 3 * MiB, WS_GATE = 4 * MiB, WS_POS = 5 * MiB;
constexpr size_t WS_WTS = 8 * MiB, WL_STRIDE = 214 * MiB;
constexpr size_t WO_WIN = 0, WO_RWCAT = 14 * MiB, WO_GLU = 16 * MiB, WO_WBR = 17 * MiB, WO_WOUT = 20 * MiB, WO_W1 = 22 * MiB, WO_W2 = 150 * MiB;
constexpr size_t WS_GF = 436 * MiB, GF_STRIDE = 20 * MiB, GF_CTX = 17 * MiB;
constexpr size_t WS_X = 504 * MiB;
constexpr size_t WS_H = 640 * MiB;
constexpr size_t WS_BIG = 708 * MiB;
constexpr size_t WS_Z = WS_BIG;
constexpr size_t WS_SCN = 1167 * MiB;
constexpr size_t WS_MTMP = WS_SCN;
constexpr size_t WS_P = 1473 * MiB;
constexpr size_t WS_ARW = 1643 * MiB;
constexpr size_t WS_YP = 1660 * MiB;
constexpr size_t WS_YDIR = WS_YP;
constexpr size_t WS_UT = 1796 * MiB;
constexpr size_t WS_AS5 = 2000 * MiB;
constexpr size_t WS_YHY = 1898 * MiB, WS_YRW = 1932 * MiB, WS_YS5 = 1966 * MiB;
constexpr size_t WS_XS = WS_BIG;
constexpr size_t WS_ACT = WS_BIG + 288 * MiB;
constexpr size_t WS_END = 2034 * MiB;
constexpr int CW_BAR = 4096;

constexpr int RING_BYTES = 131072;
constexpr int LDSCTL_OFF = RING_BYTES;
constexpr int LDS_BYTES = 163840;

typedef __bf16 bf16x2_t __attribute__((ext_vector_type(2)));
__device__ __forceinline__ unsigned pk2(float lo, float hi) { const bf16x2_t v = __builtin_convertvector((f32x2){lo, hi}, bf16x2_t); return __builtin_bit_cast(unsigned, v); }
__device__ __forceinline__ unsigned f2bf(float f) { return pk2(f, 0.f) & 0xffffu; }
__device__ __forceinline__ float bf2f(bf16 b) { return __builtin_bit_cast(float, ((unsigned)b) << 16); }
__device__ __forceinline__ float bflo(unsigned w) { return __builtin_bit_cast(float, w << 16); }
__device__ __forceinline__ float bfhi(unsigned w) { return __builtin_bit_cast(float, w & 0xffff0000u); }
__device__ __forceinline__ float sigm(float x) { return 1.f / (1.f + __expf(-x)); }
__device__ __forceinline__ float tanh_fast(float x) { const float e = __expf(2.f * x); return 1.f - 2.f / (e + 1.f); }
#define LDS_WAIT() asm volatile("s_waitcnt lgkmcnt(0)" ::: "memory")
__device__ __forceinline__ float dpp_f(float x, const int ctrl_sel) {
    const int v = __builtin_bit_cast(int, x);
    int r;
    if (ctrl_sel == 0) r = __builtin_amdgcn_update_dpp(0, v, 0xB1, 0xF, 0xF, true);
    else if (ctrl_sel == 1) r = __builtin_amdgcn_update_dpp(0, v, 0x4E, 0xF, 0xF, true);
    else r = __builtin_amdgcn_update_dpp(0, v, 0x141, 0xF, 0xF, true);
    return __builtin_bit_cast(float, r);
}
__device__ __forceinline__ float red32(float x) {
    x += dpp_f(x, 0); x += dpp_f(x, 1); x += dpp_f(x, 2);
    x += __builtin_bit_cast(float, __builtin_amdgcn_update_dpp(0, __builtin_bit_cast(int, x), 0x128, 0xF, 0xF, true));
    x += __builtin_bit_cast(float, __builtin_amdgcn_ds_swizzle(__builtin_bit_cast(int, x), 0x401F));
    return x;
}
__device__ __forceinline__ float wave_sum(float v) {
    v = red32(v);
    return __builtin_bit_cast(float, __builtin_amdgcn_readlane(__builtin_bit_cast(int, v), 0)) + __builtin_bit_cast(float, __builtin_amdgcn_readlane(__builtin_bit_cast(int, v), 32));
}
__device__ __forceinline__ int xch32(int v, const int step) {
    if (step == 0) return __builtin_amdgcn_update_dpp(0, v, 0xB1, 0xF, 0xF, true);
    if (step == 1) return __builtin_amdgcn_update_dpp(0, v, 0x4E, 0xF, 0xF, true);
    if (step == 2) return __builtin_amdgcn_update_dpp(0, v, 0x141, 0xF, 0xF, true);
    if (step == 3) return __builtin_amdgcn_update_dpp(0, v, 0x128, 0xF, 0xF, true);
    return __builtin_amdgcn_ds_swizzle(v, 0x401F);
}
__device__ __forceinline__ float red8(float x) { x += dpp_f(x, 0); x += dpp_f(x, 1); x += dpp_f(x, 2); return x; }

#define XB_TMO      128
#define XB_XCNT(j)  (256  + 64 * (j))
#define XB_XSUB(j)  (1280 + 64 * (j))
#define XB_XGEN(j)  (2304 + 64 * (j))
#define XB_TOP      3328
#define XB_TOPGEN   3392
#define XCD_BAR_WORDS 3456
#define XB_SPIN_CAP (1u << 22)
__device__ __forceinline__ unsigned xb_ld(unsigned* p)              { return __hip_atomic_load(p, __ATOMIC_RELAXED, __HIP_MEMORY_SCOPE_AGENT); }
__device__ __forceinline__ unsigned xb_add(unsigned* p, unsigned v) { return __hip_atomic_fetch_add(p, v, __ATOMIC_RELAXED, __HIP_MEMORY_SCOPE_AGENT); }
__device__ __forceinline__ unsigned xb_xcc_id() { return (unsigned)__builtin_amdgcn_s_getreg((3 << 11) | 20) & 0xFu; }
#define XB_SPIN(cond, bar) do { unsigned _sp = 0; while (cond) { __builtin_amdgcn_s_sleep(1); \
    if ((++_sp & 255u) == 0u) { if (xb_ld(&(bar)[XB_TMO])) break; if (_sp > XB_SPIN_CAP) { atomicAdd(&(bar)[XB_TMO], 1u); break; } } } } while (0)
struct XcdBarrier { unsigned* bar; unsigned x; volatile LAS unsigned* st; };
__device__ __forceinline__ XcdBarrier xcd_barrier_post(unsigned* bar, volatile LAS unsigned* st) {
    XcdBarrier b; b.bar = bar; b.x = xb_xcc_id(); b.st = st;
    if (threadIdx.x == 0) (void)xb_add(&bar[XB_XCNT(b.x)], 1u);
    return b;
}
__device__ __forceinline__ void xcd_barrier_complete(unsigned* bar, unsigned x, unsigned& nloc, unsigned& nx) {
    const unsigned G = gridDim.x * gridDim.y * gridDim.z;
    unsigned sum, cnt, mine, sp = 0u;
    for (;;) {
        sum = 0u; cnt = 0u; mine = 0u;
#pragma unroll
        for (unsigned j = 0; j < 16; ++j) { const unsigned c = xb_ld(&bar[XB_XCNT(j)]); sum += c; cnt += (c > 0u) ? 1u : 0u; mine = (j == x) ? c : mine; }
        if (sum == G) break;
        __builtin_amdgcn_s_sleep(1);
        if ((++sp & 255u) == 0u) { if (xb_ld(&bar[XB_TMO])) break; if (sp > XB_SPIN_CAP) { atomicAdd(&bar[XB_TMO], 1u); break; } }
    }
    nloc = mine > 0u ? mine : 1u; nx = cnt > 0u ? cnt : 1u;
}
__device__ __forceinline__ void xcd_barrier(const XcdBarrier& b) {
    asm volatile("s_waitcnt vmcnt(0)" ::: "memory");
    __syncthreads();
    if (threadIdx.x == 0) {
        unsigned* bar = b.bar;
        __builtin_amdgcn_s_waitcnt(0);
        unsigned nloc = b.st[0], nx = b.st[1];
        if (nloc == 0u) { xcd_barrier_complete(bar, b.x, nloc, nx); b.st[0] = nloc; b.st[1] = nx; }
        const unsigned old = xb_add(&bar[XB_XSUB(b.x)], 1u);
        const unsigned gen = old / nloc;
        if (old + 1u == (gen + 1u) * nloc) {
            __builtin_amdgcn_fence(__ATOMIC_RELEASE, "agent");
            asm volatile("s_waitcnt vmcnt(0)" ::: "memory");
            const unsigned og = xb_add(&bar[XB_TOP], 1u);
            const unsigned tg = og / nx;
            if (og + 1u == (tg + 1u) * nx) xb_add(&bar[XB_TOPGEN], 1u);
            else XB_SPIN(xb_ld(&bar[XB_TOPGEN]) == tg, bar);
            __builtin_amdgcn_fence(__ATOMIC_ACQUIRE, "agent");
            xb_add(&bar[XB_XGEN(b.x)], 1u);
            asm volatile("s_waitcnt vmcnt(0)" ::: "memory");
        } else {
            XB_SPIN(xb_ld(&bar[XB_XGEN(b.x)]) == gen, bar);
            __builtin_amdgcn_fence(__ATOMIC_ACQUIRE, "agent");
            asm volatile("s_waitcnt vmcnt(0)" ::: "memory");
        }
    }
    __syncthreads();
}

namespace pg8 {
constexpr int BM = 256, BK = 64, HALF = 128, HTB = HALF * BK * 2, STAGE_BYTES = 8 * HTB, NXCD = 8, WGM = 8, ROWTAB_OFF = 131072 + 4096;
__host__ __device__ __forceinline__ int lds_byte(int r, int c) { const int st = (r >> 4) * 2 + (c >> 5), rr = r & 15, cc = c & 31, ob = rr * 64 + cc * 2; return st * 1024 + (ob ^ (((ob >> 9) & 1) << 5)); }
__host__ __device__ __forceinline__ void stage_rc(int b, int& R, int& C) { const int st = b / 1024, sb = b % 1024, swz = sb ^ (((sb >> 9) & 1) << 5); R = (st >> 1) * 16 + swz / 64; C = (st & 1) * 32 + (swz % 64) / 2; }
__host__ __device__ __forceinline__ int perm32(int rho) { const int n = rho >> 4, i = rho & 15; return 8 * (i >> 2) + 4 * n + (i & 3); }
struct Unit { int pm, pn, e; };
__device__ __forceinline__ unsigned cvt_pk_bf16(float lo, float hi) { return pk2(lo, hi); }

__device__ __forceinline__ void tile_of(int L, int nM, int nN, int& pm, int& pn) {
    const int nwg = nM * nN; int wgid = L;
    { const int q = nwg / NXCD, r = nwg % NXCD, xcd = wgid % NXCD, off = wgid / NXCD; wgid = (xcd < r ? xcd * (q + 1) : r * (q + 1) + (xcd - r) * q) + off; }
    const int nig = WGM * nN, gid = wgid / nig, fm = gid * WGM, gsz = (nM - fm) < WGM ? (nM - fm) : WGM;
    pm = fm + ((wgid % nig) % gsz); pn = (wgid % nig) / gsz;
}
struct SchedStatic {
    static constexpr bool GATHER = false;
    const char* A; const char* Bt; size_t tstep; int nM, nN, G, c;
    __device__ __forceinline__ void init(const void* A_, const void* Bt_, int M, int N, int K, int G_, int c_) { A = (const char*)A_; Bt = (const char*)Bt_; tstep = (size_t)BM * K * 2; nM = M / BM; nN = N / BM; G = G_; c = c_; }
    __device__ __forceinline__ bool next(int i, Unit& u) const { const long L = (long)i * G + c; if (L >= (long)nM * nN) return false; tile_of((int)L, nM, nN, u.pm, u.pn); u.e = 0; return true; }
    __device__ __forceinline__ const char* aptr(const Unit& u) const { return A + (size_t)u.pm * tstep; }
    __device__ __forceinline__ const char* bptr(const Unit& u) const { return Bt + (size_t)u.pn * tstep; }
};
struct SchedWin {
    static constexpr bool GATHER = false;
    const char* A; const char* Bt; size_t tstep; int G, c, part;
    __device__ __forceinline__ bool next(int i, Unit& u) const {
        const int L = i * G + c, nmf = part ? 128 : 136, nfull = nmf * 27; u.e = 0;
        if (L < nfull) { tile_of(L, nmf, 27, u.pm, u.pn); return true; }
        const int L2 = L - nfull; if (!part || L2 >= 8 * 9) return false;
        u.pm = 128 + L2 / 9; u.pn = 6 + L2 % 9; return true; }
    __device__ __forceinline__ const char* aptr(const Unit& u) const { return A + (size_t)u.pm * tstep; }
    __device__ __forceinline__ const char* bptr(const Unit& u) const { return Bt + (size_t)u.pn * tstep; }
};
struct SchedMerge {
    static constexpr bool GATHER = false;
    const char* A0; const char* A1; const char* A2; const char* Bt; size_t tstep, bstride; int nM, nN, G, c;
    __device__ __forceinline__ bool next(int i, Unit& u) const { const int j = i / 3, br = i - 3 * j; const long L = (long)j * G + c; if (L >= (long)nM * nN) return false; tile_of((int)L, nM, nN, u.pm, u.pn); u.e = br; return true; }
    __device__ __forceinline__ const char* aptr(const Unit& u) const { return (u.e == 0 ? A0 : (u.e == 1 ? A1 : A2)) + (size_t)u.pm * tstep; }
    __device__ __forceinline__ const char* bptr(const Unit& u) const { return Bt + (size_t)u.e * bstride + (size_t)u.pn * tstep; }
};
struct SchedMoe {
    static constexpr bool GATHER = false;
    const char* A; const char* Bt; size_t tstep, estride; int NPN, G, c; const LAS int* base;
    __device__ __forceinline__ bool next(int i, Unit& u) const {
        const int ntiles = base[32] >> 8; const int per = G >> 3;
        const long L = (long)i * G + (((G & 7) == 0) ? (c & 7) * per + (c >> 3) : c);
        if (L >= (long)ntiles * NPN) return false;
        u.pm = (int)(L / NPN); u.pn = (int)(L % NPN); const int r0 = u.pm << 8; int e = 0;
#pragma unroll 1
        for (int k = 1; k < 32; ++k) e += (r0 >= base[k]) ? 1 : 0;
        u.e = e; return true;
    }
    __device__ __forceinline__ const char* aptr(const Unit& u) const { return A + (size_t)u.pm * tstep; }
    __device__ __forceinline__ const char* bptr(const Unit& u) const { return Bt + (size_t)u.e * estride + (size_t)u.pn * tstep; }
};
struct SchedMoeG : SchedMoe {
    static constexpr bool GATHER = true;
    const unsigned* rowof;
    __device__ __forceinline__ const char* aptr(const Unit&) const { return A; }
};

template <class Epi, class Sched>
__device__ __forceinline__ void gemm_phase(LAS unsigned char* lds, const int tid, const int K, const Sched& S, const Epi& E) {
    const int wid = __builtin_amdgcn_readfirstlane(tid >> 6), lane = tid & 63, wr = wid >> 2, wc = wid & 3, fr = lane & 15, fq = lane >> 4;
    const int nt = K / BK;
    unsigned voffA[2], voffB[2];
#pragma unroll
    for (int i = 0; i < 2; ++i) { int R, C; stage_rc(tid * 16 + i * 8192, R, C); const int Rb = Epi::PERM ? ((R & ~31) + perm32(R & 31)) : R;
        voffA[i] = (unsigned)(R * K + C) * 2u; voffB[i] = (unsigned)(Rb * K + C) * 2u; }
    const size_t kstep = (size_t)(BK * 2);
    const size_t hstep = (size_t)HALF * K * 2;
    const unsigned ldsw = (unsigned)wid * 1024u;
    const int aoff = lds_byte(wr * 64 + fr, fq * 8), boff = lds_byte(wc * 32 + fr, fq * 8);
#define PG8_SA(b, h) (((b) * 2 + (h)) * HTB)
#define PG8_SB(b, h) ((4 + (b) * 2 + (h)) * HTB)
#define PG8_STAGE(bufoff, gbase, voff) do { _Pragma("unroll") for (int _i = 0; _i < 2; ++_i) \
        __builtin_amdgcn_global_load_lds((const unsigned*)((const char*)(gbase) + (voff)[_i]), (LAS unsigned*)(lds + (bufoff) + ldsw + _i * 8192), 16, 0, 0); } while (0)
#define PG8_STAGEA(bufoff, kp, h) do { if constexpr (Sched::GATHER) { _Pragma("unroll") for (int _i = 0; _i < 2; ++_i) \
        __builtin_amdgcn_global_load_lds((const unsigned*)((const char*)(kp) + g[2 * (h) + _i]), (LAS unsigned*)(lds + (bufoff) + ldsw + _i * 8192), 16, 0, 0); } \
        else { PG8_STAGE(bufoff, (kp) + (h) * hstep, voffA); } } while (0)
#define PG8_GLOAD(buf) do { const LAS unsigned* rt_ = (const LAS unsigned*)(lds + ROWTAB_OFF + (buf) * 1024) + gR0; _Pragma("unroll") for (int _j = 0; _j < 4; ++_j) g[_j] = rt_[64 * _j] + gCb; } while (0)
#define PG8_GDMA(pm_, buf) do { if (wid == 0) __builtin_amdgcn_global_load_lds((const unsigned*)(S.rowof + (size_t)(pm_) * 256 + lane * 4), (LAS unsigned*)(lds + ROWTAB_OFF + (buf) * 1024), 16, 0, 0); } while (0)
#define PG8_LDA(dst, b, h) do { _Pragma("unroll") for (int m = 0; m < 4; ++m) _Pragma("unroll") for (int k = 0; k < 2; ++k) dst[m][k] = *(const LAS bf16x8*)(lds + PG8_SA(b, h) + aoff + m * 2048 + k * 1024); } while (0)
#define PG8_LDB(dst, b, h) do { _Pragma("unroll") for (int n = 0; n < 2; ++n) _Pragma("unroll") for (int k = 0; k < 2; ++k) dst[n][k] = *(const LAS bf16x8*)(lds + PG8_SB(b, h) + boff + n * 2048 + k * 1024); } while (0)
#define PG8_MMA(ai, bj, At, Bt) do { __builtin_amdgcn_s_setprio(1); _Pragma("unroll") for (int m = 0; m < 4; ++m) _Pragma("unroll") for (int n = 0; n < 2; ++n) _Pragma("unroll") for (int k = 0; k < 2; ++k) \
        acc[ai][bj][m][n] = __builtin_amdgcn_mfma_f32_16x16x32_bf16(Bt[n][k], At[m][k], acc[ai][bj][m][n], 0, 0, 0); __builtin_amdgcn_s_setprio(0); } while (0)
#define PG8_WAIT_V(n) asm volatile("s_waitcnt vmcnt(" #n ")" ::: "memory")
#define PG8_WAIT_L(n) asm volatile("s_waitcnt lgkmcnt(" #n ")" ::: "memory")
#define PG8_BAR __builtin_amdgcn_s_barrier()
#define PG8_SCHED __builtin_amdgcn_sched_barrier(0)
    Unit cur, nxt; int ui = 0;
    if (!S.next(0, cur)) return;
    f32x4 acc[2][2][4][2];
#pragma unroll
    for (int a = 0; a < 2; ++a)
#pragma unroll
        for (int b = 0; b < 2; ++b)
#pragma unroll
            for (int m = 0; m < 4; ++m)
#pragma unroll
                for (int n = 0; n < 2; ++n) acc[a][b][m][n] = (f32x4){0.f, 0.f, 0.f, 0.f};
    bf16x8 At[4][2], B0[2][2], B1[2][2];
    const char* cA = S.aptr(cur); const char* cB = S.bptr(cur);
    unsigned g[4] = {0u, 0u, 0u, 0u}; int gR0 = 0; unsigned gCb = 0u;
    if constexpr (Sched::GATHER) { int R, C; stage_rc(tid * 16, R, C); gR0 = R; gCb = (unsigned)C * 2u;
        PG8_GDMA(cur.pm, 0); PG8_WAIT_V(0); PG8_BAR; PG8_GLOAD(0); }
    PG8_STAGE(PG8_SB(0, 0), cB, voffB); PG8_STAGE(PG8_SB(0, 1), cB + hstep, voffB); PG8_STAGEA(PG8_SA(0, 0), cA, 0); PG8_STAGEA(PG8_SA(0, 1), cA, 1);
    if (wr == 1) PG8_BAR;
    PG8_WAIT_V(2); PG8_BAR;
    PG8_STAGE(PG8_SB(1, 0), cB + kstep, voffB); PG8_STAGEA(PG8_SA(1, 0), cA + kstep, 0); PG8_STAGE(PG8_SB(1, 1), cB + hstep + kstep, voffB);
    PG8_WAIT_V(6); PG8_BAR;
    for (;;) {
        const bool has_next = S.next(ui + 1, nxt);
        const char* nA = has_next ? S.aptr(nxt) : cA; const char* nB = has_next ? S.bptr(nxt) : cB;
        if constexpr (Sched::GATHER) { if (has_next) PG8_GDMA(nxt.pm, (ui + 1) & 1); }
        for (int t = 0; t < nt; t += 2) {
            const bool last = (t == nt - 2);
            const char* a1 = cA + (size_t)(t + 1) * kstep;
            const char* a2 = last ? nA : cA + (size_t)(t + 2) * kstep; const char* b2 = last ? nB : cB + (size_t)(t + 2) * kstep;
            const char* a3 = a2 + kstep; const char* b3 = b2 + kstep;
            PG8_LDB(B0, 0, 0); PG8_LDB(B1, 0, 1); PG8_SCHED; PG8_LDA(At, 0, 0); PG8_STAGEA(PG8_SA(1, 1), a1, 1);
            PG8_WAIT_V(8); PG8_WAIT_L(0); PG8_BAR; PG8_MMA(0, 0, At, B0); PG8_MMA(0, 1, At, B1); PG8_BAR; PG8_SCHED;
            if constexpr (Sched::GATHER) { if (last && has_next) PG8_GLOAD((ui + 1) & 1); PG8_SCHED; }
            PG8_LDA(At, 0, 1); PG8_STAGE(PG8_SB(0, 0), b2, voffB); PG8_STAGE(PG8_SB(0, 1), b2 + hstep, voffB); PG8_STAGEA(PG8_SA(0, 0), a2, 0);
            PG8_WAIT_V(8); PG8_WAIT_L(0); PG8_BAR; PG8_MMA(1, 0, At, B0); PG8_MMA(1, 1, At, B1); PG8_BAR; PG8_SCHED;
            PG8_LDB(B0, 1, 0); PG8_LDB(B1, 1, 1); PG8_SCHED; PG8_LDA(At, 1, 0); PG8_STAGEA(PG8_SA(0, 1), a2, 1);
            PG8_WAIT_V(8); PG8_WAIT_L(0); PG8_BAR; PG8_MMA(0, 0, At, B0); PG8_MMA(0, 1, At, B1); PG8_BAR; PG8_SCHED;
            PG8_LDA(At, 1, 1); PG8_STAGE(PG8_SB(1, 0), b3, voffB); PG8_STAGE(PG8_SB(1, 1), b3 + hstep, voffB); PG8_STAGEA(PG8_SA(1, 0), a3, 0);
            PG8_WAIT_V(8); PG8_WAIT_L(0); PG8_BAR; PG8_MMA(1, 0, At, B0); PG8_MMA(1, 1, At, B1); PG8_BAR; PG8_SCHED;
        }
        if (wr == 0) PG8_BAR;
        { int t2_ = (int)threadIdx.x; asm volatile("" : "+v"(t2_)); E(acc, cur, wr, wc, t2_ & 15, (t2_ >> 4) & 3); }
        if (!has_next) break;
#pragma unroll
        for (int a = 0; a < 2; ++a)
#pragma unroll
            for (int b = 0; b < 2; ++b)
#pragma unroll
                for (int m = 0; m < 4; ++m)
#pragma unroll
                    for (int n = 0; n < 2; ++n) acc[a][b][m][n] = (f32x4){0.f, 0.f, 0.f, 0.f};
        cur = nxt; cA = nA; cB = nB; ++ui;
        if (wr == 1) PG8_BAR;
    }
    PG8_WAIT_V(0);
    PG8_BAR;
#undef PG8_SA
#undef PG8_SB
#undef PG8_STAGE
#undef PG8_STAGEA
#undef PG8_GLOAD
#undef PG8_GDMA
#undef PG8_LDA
#undef PG8_LDB
#undef PG8_MMA
#undef PG8_WAIT_V
#undef PG8_WAIT_L
#undef PG8_BAR
#undef PG8_SCHED
}

struct EpiBf16 {
    static constexpr bool PERM = true;
    bf16* O; int ldc; const float* bias; int bias_stride;
    __device__ __forceinline__ void operator()(const f32x4 (&acc)[2][2][4][2], const Unit& u, int wr, int wc, int fr, int fq) const {
        const int row0 = u.pm * BM + wr * 64 + fr, col0 = u.pn * BM + wc * 32 + 8 * fq;
        f32x4 bv[2][2];
#pragma unroll
        for (int bj = 0; bj < 2; ++bj)
#pragma unroll
            for (int n = 0; n < 2; ++n) bv[bj][n] = bias ? *(const f32x4*)(bias + (size_t)u.e * bias_stride + col0 + bj * HALF + 4 * n) : (f32x4){0.f, 0.f, 0.f, 0.f};
#pragma unroll
        for (int ai = 0; ai < 2; ++ai)
#pragma unroll
            for (int m = 0; m < 4; ++m) { bf16* rowp = O + (size_t)(row0 + ai * HALF + m * 16) * ldc + col0;
#pragma unroll
                for (int bj = 0; bj < 2; ++bj) { const f32x4 v0 = acc[ai][bj][m][0] + bv[bj][0], v1 = acc[ai][bj][m][1] + bv[bj][1];
                    v4u w; w.x = cvt_pk_bf16(v0[0], v0[1]); w.y = cvt_pk_bf16(v0[2], v0[3]); w.z = cvt_pk_bf16(v1[0], v1[1]); w.w = cvt_pk_bf16(v1[2], v1[3]);
                    *(v4u*)(rowp + bj * HALF) = w; } }
    }
};
template <int MODE> struct EpiGlu {
    static constexpr bool PERM = true;
    bf16* O; int ldc; const float* bias; int bias_stride, hs;
    __device__ __forceinline__ void operator()(const f32x4 (&acc)[2][2][4][2], const Unit& u, int wr, int wc, int fr, int fq) const {
        const int row0 = u.pm * BM + wr * 64 + fr, col0 = u.pn * HALF + wc * 32 + 8 * fq;
        const float* bp = bias + (size_t)u.e * bias_stride + col0;
        f32x4 ba[2], bb[2];
#pragma unroll
        for (int n = 0; n < 2; ++n) { ba[n] = *(const f32x4*)(bp + 4 * n); bb[n] = *(const f32x4*)(bp + hs + 4 * n); }
#pragma unroll
        for (int ai = 0; ai < 2; ++ai)
#pragma unroll
            for (int m = 0; m < 4; ++m) { bf16* rowp = O + (size_t)(row0 + ai * HALF + m * 16) * ldc + col0;
                float o[8];
#pragma unroll
                for (int n = 0; n < 2; ++n) { const f32x4 a = acc[ai][0][m][n] + ba[n], b = acc[ai][1][m][n] + bb[n];
#pragma unroll
                    for (int j = 0; j < 4; ++j) {
                        if (MODE == 0) o[4 * n + j] = a[j] * sigm(b[j]);
                        else { const float g = fminf(a[j], 7.f), up = fminf(fmaxf(b[j], -7.f), 7.f); o[4 * n + j] = (up + 1.f) * g * sigm(1.702f * g); } } }
                v4u w; w.x = cvt_pk_bf16(o[0], o[1]); w.y = cvt_pk_bf16(o[2], o[3]); w.z = cvt_pk_bf16(o[4], o[5]); w.w = cvt_pk_bf16(o[6], o[7]);
                *(v4u*)rowp = w; }
    }
};
struct EpiMerge {
    static constexpr bool PERM = true;
    bf16* mtmp; bf16* Mo; const bf16* zg;
    __device__ __forceinline__ void operator()(const f32x4 (&acc)[2][2][4][2], const Unit& u, int wr, int wc, int fr, int fq) const {
        const int row0 = u.pm * BM + wr * 64 + fr, col0 = u.pn * BM + wc * 32 + 8 * fq;
#pragma unroll
        for (int ai = 0; ai < 2; ++ai)
#pragma unroll
            for (int m = 0; m < 4; ++m) { const size_t r = (size_t)(row0 + ai * HALF + m * 16);
#pragma unroll
                for (int bj = 0; bj < 2; ++bj) { const int c = col0 + bj * HALF;
                    const v4u gz = *(const v4u*)(zg + r * IN_COLS + u.e * 1024 + c);
                    float g[8] = {bflo(gz.x), bfhi(gz.x), bflo(gz.y), bfhi(gz.y), bflo(gz.z), bfhi(gz.z), bflo(gz.w), bfhi(gz.w)};
                    f32x4 t0, t1; bf16* tp = mtmp + r * 1024 + c;
                    if (u.e == 0) { t0 = (f32x4){0.f, 0.f, 0.f, 0.f}; t1 = t0; } else { const v4u pv = *(const v4u*)tp; t0 = (f32x4){bflo(pv.x), bfhi(pv.x), bflo(pv.y), bfhi(pv.y)}; t1 = (f32x4){bflo(pv.z), bfhi(pv.z), bflo(pv.w), bfhi(pv.w)}; }
#pragma unroll
                    for (int j = 0; j < 4; ++j) { t0[j] += sigm(g[j]) * acc[ai][bj][m][0][j]; t1[j] += sigm(g[4 + j]) * acc[ai][bj][m][1][j]; }
                    if (u.e < 2) { v4u w; w.x = cvt_pk_bf16(t0[0], t0[1]); w.y = cvt_pk_bf16(t0[2], t0[3]); w.z = cvt_pk_bf16(t1[0], t1[1]); w.w = cvt_pk_bf16(t1[2], t1[3]); *(v4u*)tp = w; }
                    else { v4u w; w.x = cvt_pk_bf16(t0[0], t0[1]); w.y = cvt_pk_bf16(t0[2], t0[3]); w.z = cvt_pk_bf16(t1[0], t1[1]); w.w = cvt_pk_bf16(t1[2], t1[3]);
                        *(v4u*)(Mo + r * 1024 + c) = w; } } }
    }
};
struct EpiResid {
    static constexpr bool PERM = false;
    float* X; const float* gmod;
    __device__ __forceinline__ void operator()(const f32x4 (&acc)[2][2][4][2], const Unit& u, int wr, int wc, int fr, int fq) const {
        const int row0 = u.pm * BM + wr * 64 + fr, col0 = u.pn * BM + wc * 32 + 4 * fq;
        const int r00 = u.pm * BM; const int w = r00 < T_LAT ? (r00 >> 12) : 8;
        f32x4 gv[2][2];
#pragma unroll
        for (int bj = 0; bj < 2; ++bj)
#pragma unroll
            for (int n = 0; n < 2; ++n) gv[bj][n] = *(const f32x4*)(gmod + (size_t)w * 6144 + col0 + bj * HALF + n * 16);
#pragma unroll
        for (int ai = 0; ai < 2; ++ai)
#pragma unroll
            for (int m = 0; m < 4; ++m) { float* rowp = X + (size_t)(row0 + ai * HALF + m * 16) * 1024 + col0;
#pragma unroll
                for (int bj = 0; bj < 2; ++bj)
#pragma unroll
                    for (int n = 0; n < 2; ++n) { f32x4* p = (f32x4*)(rowp + bj * HALF + n * 16); *p = *p + gv[bj][n] * acc[ai][bj][m][n]; } }
    }
};
}

struct Args { const float* in[51]; float* out; unsigned char* ws; int ph_lo, ph_hi; };
enum { I_X = 0, I_C, I_CTX, I_CCTX, I_ADAW, I_ADAB, I_N1G, I_N2G, I_WIN, I_HYCW, I_HYCB, I_HYW1, I_HYB1, I_HYF1, I_HYW2, I_HYB2, I_HYF2, I_HYW3, I_HYB3, I_HYBIAS,
       I_RWCW, I_RWCB, I_RWWUP, I_RWW0, I_RWAUP, I_RWA0, I_RWGUP, I_RWKK, I_RWKA, I_RWRK, I_RWLNG, I_RWLNB, I_S5ARE, I_S5AIM, I_S5LDT, I_S5BRE, I_S5BIM, I_S5CRE, I_S5CIM, I_S5D,
       I_S5GLUW, I_S5GLUB, I_WBR, I_WOUT, I_RTW, I_RTB, I_W1, I_B1, I_W2, I_B2, I_FING };

typedef const __attribute__((address_space(4))) Args* CArgsP;
__device__ __forceinline__ CArgsP kargs() { CArgsP p = (CArgsP)__builtin_amdgcn_kernarg_segment_ptr(); asm volatile("" : "+s"(p)); return p; }
__device__ __forceinline__ int opaque(int v) { asm volatile("" : "+s"(v)); return v; }
__device__ __forceinline__ int opaque_v(int v) { asm volatile("" : "+v"(v)); return v; }
struct Ctx { CArgsP a; LAS unsigned char* lds; int tid, lane, wave, bid, G; };

__device__ __forceinline__ void row_seq(int row, int& base, int& pos, int& n) {
    if (row < T_LAT) { base = row & ~(SEQ - 1); pos = row & (SEQ - 1); n = SEQ; }
    else { const int r = row - T_LAT; base = T_LAT + (r & ~(CTXL - 1)); pos = r & (CTXL - 1); n = CTXL; }
}
__device__ __forceinline__ float conv3z(const bf16* zc, int pos, int n, float w0, float w1, float w2, float b) {
    const float zm = pos > 0 ? bf2f(zc[(size_t)(pos - 1) * IN_COLS]) : 0.f, z0 = bf2f(zc[(size_t)pos * IN_COLS]), zp = pos < n - 1 ? bf2f(zc[(size_t)(pos + 1) * IN_COLS]) : 0.f;
    return zm * w0 + z0 * w1 + zp * w2 + b;
}

template <int MODE>
__device__ __forceinline__ void transpose_item(const float* W, int K, int N, bf16* WT, int Hs, LAS float* scr, int item, int lane) {
    const int nblk = N / 32, kb = item / nblk, nb = item % nblk, k0 = 64 * kb, n0 = 32 * nb;
#pragma unroll 8
    for (int i = 0; i < 32; ++i) { const int kk = 2 * i + (lane >> 5); scr[kk * 33 + (lane & 31)] = W[(size_t)(k0 + kk) * N + n0 + (lane & 31)]; }
    LDS_WAIT(); asm volatile("" ::: "memory");
    const int c = lane & 7;
#pragma unroll
    for (int j = 0; j < 4; ++j) { const int n = (lane >> 3) + 8 * j; const LAS float* s = scr + (8 * c) * 33 + n;
        v4u o; o.x = pk2(s[0 * 33], s[1 * 33]); o.y = pk2(s[2 * 33], s[3 * 33]); o.z = pk2(s[4 * 33], s[5 * 33]); o.w = pk2(s[6 * 33], s[7 * 33]);
        int dr = n0 + n;
        if (MODE == 1) { const int nc = n0 + n; const int jx = nc < Hs ? nc : nc - Hs; dr = (jx >> 7) * 256 + (nc < Hs ? 0 : 128) + (jx & 127); }
        *(v4u*)(WT + (size_t)dr * K + k0 + 8 * c) = o; }
    LDS_WAIT(); asm volatile("" ::: "memory");
}

__device__ __forceinline__ void p0_prologue(const Ctx& F) {
    const auto& a = *F.a; unsigned char* ws = a.ws;
    const int gw = F.bid * NWAVES + F.wave, NGW = F.G * NWAVES, lane = F.lane;
    float* X = (float*)(ws + WS_X);
    for (int t = gw; t < SEQ; t += NGW) {
        const float pr = (float)(t >> 6), pc = (float)(t & 63);
        f32x4 pe[4];
#pragma unroll
        for (int j = 0; j < 4; ++j)
#pragma unroll
            for (int e = 0; e < 4; ++e) { const float om = 1.0f / powf(10000.0f, (float)(4 * lane + e) / 256.0f); const float ang = ((j < 2) ? pr : pc) * om; pe[j][e] = (j & 1) ? cosf(ang) : sinf(ang); }
#pragma unroll 2
        for (int bb = 0; bb < BATCH; ++bb) { const size_t row = (size_t)bb * SEQ + t;
            const f32x4* xi = (const f32x4*)(a.in[I_X] + row * D) + lane; f32x4* xo = (f32x4*)(X + row * D) + lane;
#pragma unroll
            for (int j = 0; j < 4; ++j) xo[64 * j] = xi[64 * j] + pe[j]; }
    }
    for (int row = T_LAT + gw; row < T_ALL; row += NGW) {
        const f32x4* xi = (const f32x4*)(a.in[I_CTX] + (size_t)(row - T_LAT) * D) + lane; f32x4* xo = (f32x4*)(X + (size_t)row * D) + lane;
#pragma unroll
        for (int j = 0; j < 4; ++j) xo[64 * j] = xi[64 * j];
    }
    {
        LAS float* condl = (LAS float*)F.lds; LAS float* psum = (LAS float*)(F.lds + 40960);
        for (int i = F.tid; i < 9 * 1024; i += NTHREADS) { const int w = i >> 10, k = i & 1023; const float cv = (w < 8) ? a.in[I_C][w * 1024 + k] : a.in[I_CCTX][k]; condl[i] = cv / (1.f + expf(-cv)); }
        __syncthreads();
        float* MOD = (float*)(ws + WS_MOD);
        for (int it = F.bid; it < 2 * 96; it += F.G) {
            const int l = it / 96, cg = it % 96, col = cg * 64 + lane;
            float acc[9];
#pragma unroll
            for (int w = 0; w < 9; ++w) acc[w] = 0.f;
            const float* wp = a.in[I_ADAW] + ((size_t)l * 1024 + F.wave * 128) * 6144 + col;
#pragma unroll 1
            for (int k0 = 0; k0 < 128; k0 += 16) { float wv[16];
#pragma unroll
                for (int k = 0; k < 16; ++k) wv[k] = wp[(size_t)(k0 + k) * 6144];
#pragma unroll
                for (int k = 0; k < 16; ++k)
#pragma unroll
                    for (int w = 0; w < 9; ++w) acc[w] += condl[w * 1024 + F.wave * 128 + k0 + k] * wv[k]; }
#pragma unroll
            for (int w = 0; w < 9; ++w) psum[(F.wave * 9 + w) * 64 + lane] = acc[w];
            __syncthreads();
            if (F.wave == 0) {
#pragma unroll
                for (int w = 0; w < 9; ++w) { float s = 0.f;
#pragma unroll
                    for (int wv = 0; wv < 8; ++wv) s += psum[(wv * 9 + w) * 64 + lane];
                    MOD[(size_t)(l * 9 + w) * 6144 + col] = s + a.in[I_ADAB][l * 6144 + col]; }
            }
            __syncthreads();
        }
    }
    {
        LAS float* scr = (LAS float*)(F.lds + F.wave * 16384);
        constexpr int IT_W1 = 16 * 64, IT_W2 = 16 * 32, IT_WIN = 16 * 216, IT_GLU = 8 * 32, IT_WBR = 8 * 32, IT_WOUT = 16 * 32;
        constexpr int N_W1 = 64 * IT_W1, N_W2 = 64 * IT_W2, N_WIN = 2 * IT_WIN, N_GLU = 2 * IT_GLU, N_WBR = 6 * IT_WBR, N_WOUT = 2 * IT_WOUT;
        constexpr int NITEMS = N_W1 + N_W2 + N_WIN + N_GLU + N_WBR + N_WOUT;
        for (int it = gw; it < NITEMS; it += NGW) {
            int r = it;
            if (r < N_W1) { const int mtx = r / IT_W1, l = mtx >> 5, e = mtx & 31; transpose_item<1>(a.in[I_W1] + (size_t)mtx * 1024 * 2048, 1024, 2048, (bf16*)(ws + WS_WTS + l * WL_STRIDE + WO_W1) + (size_t)e * 2048 * 1024, 1024, scr, r % IT_W1, lane); continue; } r -= N_W1;
            if (r < N_W2) { const int mtx = r / IT_W2, l = mtx >> 5, e = mtx & 31; transpose_item<0>(a.in[I_W2] + (size_t)mtx * 1024 * 1024, 1024, 1024, (bf16*)(ws + WS_WTS + l * WL_STRIDE + WO_W2) + (size_t)e * 1024 * 1024, 0, scr, r % IT_W2, lane); continue; } r -= N_W2;
            if (r < N_WIN) { const int l = r / IT_WIN; transpose_item<0>(a.in[I_WIN] + (size_t)l * 1024 * IN_COLS, 1024, IN_COLS, (bf16*)(ws + WS_WTS + l * WL_STRIDE + WO_WIN), 0, scr, r % IT_WIN, lane); continue; } r -= N_WIN;
            if (r < N_GLU) { const int l = r / IT_GLU; transpose_item<1>(a.in[I_S5GLUW] + (size_t)l * 512 * 1024, 512, 1024, (bf16*)(ws + WS_WTS + l * WL_STRIDE + WO_GLU), 512, scr, r % IT_GLU, lane); continue; } r -= N_GLU;
            if (r < N_WBR) { const int mtx = r / IT_WBR, l = mtx / 3, br = mtx % 3; transpose_item<0>(a.in[I_WBR] + (size_t)mtx * 512 * 1024, 512, 1024, (bf16*)(ws + WS_WTS + l * WL_STRIDE + WO_WBR) + (size_t)br * 1024 * 512, 0, scr, r % IT_WBR, lane); continue; } r -= N_WBR;
            { const int l = r / IT_WOUT; transpose_item<0>(a.in[I_WOUT] + (size_t)l * 1024 * 1024, 1024, 1024, (bf16*)(ws + WS_WTS + l * WL_STRIDE + WO_WOUT), 0, scr, r % IT_WOUT, lane); }
        }
        for (int i = F.bid * NTHREADS + F.tid; i < 2 * 2560 * 256; i += F.G * NTHREADS) {
            const int l = i / (2560 * 256), r = i % (2560 * 256), n = r >> 8, k = r & 255; float v = 0.f;
            if (n < 1024) { if (k < 64) v = a.in[I_RWWUP][(((size_t)l * 2 + (n >> 9)) * 64 + k) * 512 + (n & 511)]; }
            else if (n < 2048) { if (k >= 64 && k < 128) v = a.in[I_RWAUP][(((size_t)l * 2 + ((n - 1024) >> 9)) * 64 + (k - 64)) * 512 + (n & 511)]; }
            else { if (k >= 128) v = a.in[I_RWGUP][((size_t)l * 128 + (k - 128)) * 512 + (n - 2048)]; }
            ((bf16*)(ws + WS_WTS + l * WL_STRIDE + WO_RWCAT))[r] = (bf16)f2bf(v);
        }
    }
    __syncthreads();
    {
        LAS float* feats = (LAS float*)F.lds; LAS float* h1 = feats + 8 * 33; LAS float* h2 = h1 + 8 * 64;
        constexpr int NIT = 2 * (512 + 32);
        for (int it = F.bid; it < NIT; it += F.G) {
            const int l = it / 544, r = it % 544, nsel = r >= 512, n = nsel ? CTXL : SEQ, p0 = (nsel ? r - 512 : r) * 8;
            if (F.tid < 8 * 33) { const int p = F.tid / 33, i = F.tid % 33, pos = p0 + p; float f;
                if (i == 0) f = (float)pos / (float)(n - 1);
                else { const int k = (i - 1) & 15; const float band = 1e-4f + (float)k * ((15.0f - 1e-4f) / 15.0f); const float ang = (6.283185307179586f * (float)pos / (float)n) * band; f = (i <= 16) ? cosf(ang) : -sinf(ang); }
                feats[p * 33 + i] = f; }
            __syncthreads();
            { const int p = F.tid >> 6, j = F.tid & 63; float s = a.in[I_HYB1][l * 64 + j]; const float* w1p = a.in[I_HYW1] + (size_t)l * 33 * 64 + j;
#pragma unroll
                for (int i = 0; i < 33; ++i) s += feats[p * 33 + i] * w1p[i * 64];
                h1[p * 64 + j] = sinf(a.in[I_HYF1][l * 64 + j] * s); }
            __syncthreads();
            { const int p = F.tid >> 6, j = F.tid & 63; float s = a.in[I_HYB2][l * 64 + j];
                const float* w2p = a.in[I_HYW2] + (size_t)l * 64 * 64 + j;
#pragma unroll 16
                for (int i = 0; i < 64; ++i) s += h1[p * 64 + i] * w2p[i * 64];
                h2[p * 64 + j] = sinf(a.in[I_HYF2][l * 64 + j] * s); }
            __syncthreads();
            float acc[4][8];
#pragma unroll
            for (int q = 0; q < 4; ++q)
#pragma unroll
                for (int p = 0; p < 8; ++p) acc[q][p] = 0.f;
            const float* w3 = a.in[I_HYW3] + (size_t)l * 64 * 2048 + F.tid;
#pragma unroll 8
            for (int i = 0; i < 64; ++i) { float wv[4];
#pragma unroll
                for (int q = 0; q < 4; ++q) wv[q] = w3[(size_t)i * 2048 + q * 512];
#pragma unroll
                for (int p = 0; p < 8; ++p) { const float hv = h2[p * 64 + i];
#pragma unroll
                    for (int q = 0; q < 4; ++q) acc[q][p] += hv * wv[q]; } }
            const int c = F.tid; const float dstart = logf(0.01f) / 1.5f, dstop = logf(0.01f) / 0.3f; const float delta = fabsf(dstart + (float)c * ((dstop - dstart) / 511.0f));
            const int RL = nsel ? HY_RLENC : HY_RLEN, off = n + 47;
            bf16* Rb = (bf16*)(ws + WS_GF + l * GF_STRIDE + (nsel ? GF_CTX : 0));
#pragma unroll
            for (int q = 0; q < 4; ++q) { const int o = q >> 1, side = q & 1; const float b3 = a.in[I_HYB3][l * 2048 + q * 512 + c];
                bf16* Rc = Rb + ((size_t)o * 512 + c) * RL;
#pragma unroll
                for (int p = 0; p < 8; ++p) { const int pos = p0 + p; const float t = (float)pos / (float)(n - 1); const float val = (acc[q][p] + b3) * expf(-t * delta);
                    if (side == 0) Rc[off - pos] = (bf16)f2bf(val);
                    else if (pos >= 1) Rc[off + pos] = (bf16)f2bf(val); }
                if (p0 == 0 && side == 0) { for (int m = 0; m < 48; ++m) Rc[m] = 0; for (int m = off + n; m < RL; ++m) Rc[m] = 0; } }
            __syncthreads();
        }
    }
}

__device__ __forceinline__ void stage_norm1(const Ctx& F, int l) {
    const auto& a = *F.a; unsigned char* ws = a.ws; const int lane = F.lane;
    const int gw = F.bid * NWAVES + F.wave, NGW = F.G * NWAVES;
    float* X = (float*)(ws + WS_X); bf16* H = (bf16*)(ws + WS_H); const float* MOD = (const float*)(ws + WS_MOD);
    const bf16* YS = (const bf16*)(ws + WS_XS); const int* POS = (const int*)(ws + WS_POS); const float* GATE = (const float*)(ws + WS_GATE);
    const int nrows = (l == DEPTH) ? T_LAT : T_ALL;
    for (int row = gw; row < nrows; row += NGW) {
        const int w = row < T_LAT ? (row >> 12) : 8;
        f32x4* xr = (f32x4*)(X + (size_t)row * D) + lane;
        f32x4 v[4];
#pragma unroll
        for (int j = 0; j < 4; ++j) v[j] = xr[64 * j];
        if (l > 0) {
            f32x4 mo[4];
#pragma unroll
            for (int j = 0; j < 4; ++j) mo[j] = (f32x4){0.f, 0.f, 0.f, 0.f};
#pragma unroll
            for (int k = 0; k < TOPK; ++k) { const int p = POS[row * 4 + k]; const float g = GATE[row * 4 + k];
                const v2u* yr = (const v2u*)(YS + (size_t)p * D) + lane;
#pragma unroll
                for (int j = 0; j < 4; ++j) { const v2u y = yr[64 * j]; mo[j][0] += g * bflo(y.x); mo[j][1] += g * bfhi(y.x); mo[j][2] += g * bflo(y.y); mo[j][3] += g * bfhi(y.y); } }
            const f32x4* g2 = (const f32x4*)(MOD + (size_t)((l - 1) * 9 + w) * 6144 + 5120) + lane;
#pragma unroll
            for (int j = 0; j < 4; ++j) { v[j] = v[j] + g2[64 * j] * mo[j]; xr[64 * j] = v[j]; }
        }
        float ss = 0.f;
#pragma unroll
        for (int j = 0; j < 4; ++j) ss += (v[j][0] * v[j][0] + v[j][1] * v[j][1]) + (v[j][2] * v[j][2] + v[j][3] * v[j][3]);
        const float rstd = 1.0f / sqrtf(wave_sum(ss) * (1.f / D) + 1e-6f);
        if (l == DEPTH) {
            const f32x4* fg = (const f32x4*)a.in[I_FING] + lane; f32x4* o = (f32x4*)(a.out + (size_t)row * D) + lane;
#pragma unroll
            for (int j = 0; j < 4; ++j) o[64 * j] = v[j] * rstd * fg[64 * j];
        } else {
            const f32x4* ng = (const f32x4*)(a.in[I_N1G] + l * D) + lane;
            const f32x4* sh = (const f32x4*)(MOD + (size_t)(l * 9 + w) * 6144) + lane; const f32x4* sc = (const f32x4*)(MOD + (size_t)(l * 9 + w) * 6144 + 1024) + lane;
            v2u* ho = (v2u*)(H + (size_t)row * D) + lane;
#pragma unroll
            for (int j = 0; j < 4; ++j) { const f32x4 h = v[j] * rstd * ng[64 * j] * (sc[64 * j] + 1.0f) + sh[64 * j]; v2u o; o.x = pk2(h[0], h[1]); o.y = pk2(h[2], h[3]); ho[64 * j] = o; }
        }
    }
}

__device__ __forceinline__ void stage_rw_prep1(const Ctx& F, int l) {
    const auto& a = *F.a; unsigned char* ws = a.ws;
    const bf16* Z = (const bf16*)(ws + WS_Z); bf16* ARW = (bf16*)(ws + WS_ARW);
    const int j = 4 * (F.tid & 63), col = 1536 + j, rq = F.tid >> 6;
    const float* cw = a.in[I_RWCW] + (size_t)l * 3 * 1792;
    const f32x4 w0 = *(const f32x4*)(cw + col), w1 = *(const f32x4*)(cw + 1792 + col), w2 = *(const f32x4*)(cw + 2 * 1792 + col), cb = *(const f32x4*)(a.in[I_RWCB] + l * 1792 + col);
#pragma unroll 2
    for (int row = F.bid * 8 + rq; row < T_ALL; row += F.G * 8) {
        int base, pos, n; row_seq(row, base, pos, n);
        const bf16* zc = Z + (size_t)row * IN_COLS + RW_OFF + col;
        const v2u z0 = *(const v2u*)zc;
        v2u zm = (v2u){0u, 0u}, zp = (v2u){0u, 0u};
        if (pos > 0) zm = *(const v2u*)(zc - IN_COLS);
        if (pos < n - 1) zp = *(const v2u*)(zc + IN_COLS);
        f32x4 v = (f32x4){bflo(zm.x), bfhi(zm.x), bflo(zm.y), bfhi(zm.y)} * w0 + (f32x4){bflo(z0.x), bfhi(z0.x), bflo(z0.y), bfhi(z0.y)} * w1 + (f32x4){bflo(zp.x), bfhi(zp.x), bflo(zp.y), bfhi(zp.y)} * w2 + cb;
#pragma unroll
        for (int e2 = 0; e2 < 4; ++e2) { if (j < 64) v[e2] = tanh_fast(v[e2]); else if (j >= 128) v[e2] = sigm(v[e2]); }
        v2u o; o.x = pk2(v[0], v[1]); o.y = pk2(v[2], v[3]);
        *(v2u*)(ARW + (size_t)row * 256 + j) = o;
    }
}

__device__ __forceinline__ void stage_rw_prep2(const Ctx& F, int l) {
    const auto& a = *F.a; unsigned char* ws = a.ws; const int lane = F.lane;
    const bf16* Z = (const bf16*)(ws + WS_Z); const bf16* P = (const bf16*)(ws + WS_P); bf16* SCN = (bf16*)(ws + WS_SCN);
    const int gw = F.bid * NWAVES + F.wave, NGW = F.G * NWAVES;
    constexpr int TR = 17, NRT = T_ALL / TR;
    const float* cw = a.in[I_RWCW] + (size_t)l * 3 * 1792; const float* cbp = a.in[I_RWCB] + l * 1792;
    for (int tile = gw; tile < NRT * 4; tile += NGW) {
        const int rt = tile % NRT, hp = tile / NRT, row0 = rt * TR, c0 = hp * 128 + 2 * lane;
        f32x2 w[3][3], cb[3];
#pragma unroll
        for (int s = 0; s < 3; ++s) { cb[s] = *(const f32x2*)(cbp + s * 512 + c0);
#pragma unroll
            for (int j = 0; j < 3; ++j) w[s][j] = *(const f32x2*)(cw + j * 1792 + s * 512 + c0); }
        const f32x2 KKw = *(const f32x2*)(a.in[I_RWKK] + l * 512 + c0), KAw = *(const f32x2*)(a.in[I_RWKA] + l * 512 + c0);
        f32x2 W0[2], A0[2];
#pragma unroll
        for (int d = 0; d < 2; ++d) { W0[d] = *(const f32x2*)(a.in[I_RWW0] + (l * 2 + d) * 512 + c0); A0[d] = *(const f32x2*)(a.in[I_RWA0] + (l * 2 + d) * 512 + c0); }
        const unsigned* zb = (const unsigned*)(Z + RW_OFF + c0);
        unsigned zm[3], z0[3], zp[3];
#pragma unroll
        for (int s = 0; s < 3; ++s) { zm[s] = row0 > 0 ? zb[(size_t)(row0 - 1) * (IN_COLS / 2) + s * 256] : 0u; z0[s] = zb[(size_t)row0 * (IN_COLS / 2) + s * 256]; }
#pragma unroll 1
        for (int i = 0; i < TR; ++i) {
            const int row = row0 + i; int base, pos, n; row_seq(row, base, pos, n);
#pragma unroll
            for (int s = 0; s < 3; ++s) zp[s] = (row + 1 < T_ALL) ? zb[(size_t)(row + 1) * (IN_COLS / 2) + s * 256] : 0u;
            const float mlo = pos > 0 ? 1.f : 0.f, mhi = pos < n - 1 ? 1.f : 0.f;
            f32x2 u[3];
#pragma unroll
            for (int s = 0; s < 3; ++s) { u[s] = (f32x2){bflo(zm[s]), bfhi(zm[s])} * mlo * w[s][0] + (f32x2){bflo(z0[s]), bfhi(z0[s])} * w[s][1] + (f32x2){bflo(zp[s]), bfhi(zp[s])} * mhi * w[s][2] + cb[s]; zm[s] = z0[s]; z0[s] = zp[s]; }
            const f32x2 r = u[0], k = u[1], v = u[2];
            f32x2 kk = k * KKw;
            const float ss = red32(kk[0] * kk[0] + kk[1] * kk[1]);
            kk = kk * (1.0f / sqrtf(fmaxf(ss, 1e-24f)));
            const unsigned* pr = (const unsigned*)(P + (size_t)row * 2560 + c0);
            unsigned* o = (unsigned*)(SCN + (size_t)row * 9 * 512 + c0);
            o[0] = pk2(r[0], r[1]); o[256] = pk2(v[0], v[1]); o[2 * 256] = pk2(kk[0], kk[1]);
#pragma unroll
            for (int d = 0; d < 2; ++d) {
                const unsigned pw = pr[d * 256], pa = pr[512 + d * 256];
                float ld[2], kd[2], be[2];
#pragma unroll
                for (int e = 0; e < 2; ++e) {
                    const float uu = W0[d][e] + (e ? bfhi(pw) : bflo(pw));
                    ld[e] = -0.60653065971263342f * sigm(uu);
                    const float av = sigm(A0[d][e] + (e ? bfhi(pa) : bflo(pa)));
                    kd[e] = k[e] * (1.f + (av - 1.f) * KAw[e]); be[e] = kk[e] * av; }
                o[(3 + 3 * d) * 256] = pk2(ld[0], ld[1]); o[(4 + 3 * d) * 256] = pk2(kd[0], kd[1]); o[(5 + 3 * d) * 256] = pk2(be[0], be[1]);
            }
        }
    }
}

__device__ __forceinline__ int seq_row(int b, int d, int sidx) {
    if (sidx < CTXL) { const int t = d ? (CTXL - 1 - sidx) : sidx; return T_LAT + b * CTXL + t; }
    const int tl = sidx - CTXL; const int t = d ? (SEQ - 1 - tl) : tl; return b * SEQ + t;
}

constexpr int CW_WORK = 16384;
constexpr int CW_STAMP = 20480;
#ifdef PROBE_T
#ifndef PROBE_BID
#define PROBE_BID 0
#endif
#define PT(k) do { if (F.bid == PROBE_BID && F.tid == 0 && l == 0) ((unsigned long long*)(F.a->ws + WS_CTL + CW_STAMP * 4))[k] = __builtin_amdgcn_s_memrealtime(); } while (0)
#else
#define PT(k) do { } while (0)
#endif
__device__ __forceinline__ void rw_scan_item(const Ctx& F, int l, int it2) {
    const int it = it2 >> 1, half = it2 & 1;
    const auto& a = *F.a; unsigned char* ws = a.ws; const int tid = F.tid, lane = F.lane;
    const bf16* SCN = (const bf16*)(ws + WS_SCN); float* YD = (float*)(ws + WS_YDIR);
    LAS float* sbuf = (LAS float*)F.lds;
    LAS float* ybuf = (LAS float*)(F.lds + 49152);
    const bool comp = F.wave < 4;
    const int lt = tid & 255, ls = lt >> 4, lj = lt & 15;
    const int vl = lane >> 3, kq = lane & 7, vrow = half * 32 + (F.wave & 3) * 8 + vl;
    constexpr int NCH = (CTXL + SEQ) / 16;
    const int d = it & 1, h = (it >> 1) & 7, b = it >> 4;
    f32x2 S[4];
#pragma unroll
    for (int q = 0; q < 4; ++q) S[q] = (f32x2){0.f, 0.f};
    v2u ldr[6];
#define RW_ISSUE(c) do { const int row_ = seq_row(b, d, (c) * 16 + ls); const v2u* p_ = (const v2u*)(SCN + (size_t)row_ * 9 * 512 + h * 64) + lj; \
        ldr[0] = p_[2 * 128]; ldr[1] = p_[(3 + 3 * d) * 128]; ldr[2] = p_[(5 + 3 * d) * 128]; ldr[3] = p_[(4 + 3 * d) * 128]; ldr[4] = p_[0]; ldr[5] = p_[128]; } while (0)
#define RW_WRITE(bufi) do { LAS float* o_ = sbuf + (((bufi) * 16 + ls) * 6) * 64 + 4 * lj; \
        *(LAS f32x4*)(o_) = (f32x4){-bflo(ldr[0].x), -bfhi(ldr[0].x), -bflo(ldr[0].y), -bfhi(ldr[0].y)}; \
        *(LAS f32x4*)(o_ + 64) = (f32x4){__expf(bflo(ldr[1].x)), __expf(bfhi(ldr[1].x)), __expf(bflo(ldr[1].y)), __expf(bfhi(ldr[1].y))}; \
        *(LAS f32x4*)(o_ + 128) = (f32x4){bflo(ldr[2].x), bfhi(ldr[2].x), bflo(ldr[2].y), bfhi(ldr[2].y)}; *(LAS f32x4*)(o_ + 192) = (f32x4){bflo(ldr[3].x), bfhi(ldr[3].x), bflo(ldr[3].y), bfhi(ldr[3].y)}; \
        *(LAS f32x4*)(o_ + 256) = (f32x4){bflo(ldr[4].x), bfhi(ldr[4].x), bflo(ldr[4].y), bfhi(ldr[4].y)}; *(LAS f32x4*)(o_ + 320) = (f32x4){bflo(ldr[5].x), bfhi(ldr[5].x), bflo(ldr[5].y), bfhi(ldr[5].y)}; } while (0)
#define RW_FLUSH(c) do { const int row_ = seq_row(b, d, (c) * 16 + ls); \
        *(f32x2*)(YD + ((size_t)d * T_ALL + row_) * 512 + h * 64 + half * 32 + 2 * lj) = *(const LAS f32x2*)(ybuf + ((((c) & 1) * 16 + ls) * 64) + half * 32 + 2 * lj); } while (0)
    if (!comp) { RW_ISSUE(0); RW_WRITE(0); RW_ISSUE(1); }
    __syncthreads();
#pragma unroll 1
    for (int c = 0; c < NCH; ++c) {
        const int bi = c & 1;
        if (!comp) {
            if (c + 1 < NCH) RW_WRITE(bi ^ 1);
            if (c + 2 < NCH) RW_ISSUE(c + 2);
            if (c > 0) RW_FLUSH(c - 1);
        } else {
        float yv[16];
        f32x4 opA[10], opB[10]; float vvA, vvB;
#define RW_LD(op, vvx, s_) do { const LAS float* sp_ = sbuf + ((bi * 16 + (s_)) * 6) * 64 + 8 * kq; \
            _Pragma("unroll") for (int q_ = 0; q_ < 5; ++q_) { op[2 * q_] = *(const LAS f32x4*)(sp_ + 64 * q_); op[2 * q_ + 1] = *(const LAS f32x4*)(sp_ + 64 * q_ + 4); } \
            vvx = sbuf[((bi * 16 + (s_)) * 6 + 5) * 64 + vrow]; } while (0)
#define RW_COMP(op, vvx, s_) do { \
            const f32x4 a0 = op[0], a1 = op[1], w0 = op[2], w1 = op[3], b0 = op[4], b1 = op[5], k0 = op[6], k1 = op[7], r0 = op[8], r1 = op[9]; \
            const f32x2 vv2 = (f32x2){vvx, vvx}; \
            const f32x2 p0 = S[1] * (f32x2){a0[2], a0[3]} + S[0] * (f32x2){a0[0], a0[1]}; \
            const f32x2 p1 = S[3] * (f32x2){a1[2], a1[3]} + S[2] * (f32x2){a1[0], a1[1]}; \
            const f32x2 t0 = S[0] * (f32x2){w0[0], w0[1]} + vv2 * (f32x2){k0[0], k0[1]}; \
            const f32x2 t1 = S[1] * (f32x2){w0[2], w0[3]} + vv2 * (f32x2){k0[2], k0[3]}; \
            const f32x2 t2 = S[2] * (f32x2){w1[0], w1[1]} + vv2 * (f32x2){k1[0], k1[1]}; \
            const f32x2 t3 = S[3] * (f32x2){w1[2], w1[3]} + vv2 * (f32x2){k1[2], k1[3]}; \
            const f32x2 ac = p0 + p1; \
            const float sa = red8(ac[0] + ac[1]); \
            const f32x2 sa2 = (f32x2){sa, sa}; \
            S[0] = sa2 * (f32x2){b0[0], b0[1]} + t0; S[1] = sa2 * (f32x2){b0[2], b0[3]} + t1; \
            S[2] = sa2 * (f32x2){b1[0], b1[1]} + t2; S[3] = sa2 * (f32x2){b1[2], b1[3]} + t3; \
            const f32x2 q0 = S[1] * (f32x2){r0[2], r0[3]} + S[0] * (f32x2){r0[0], r0[1]}; \
            const f32x2 q1 = S[3] * (f32x2){r1[2], r1[3]} + S[2] * (f32x2){r1[0], r1[1]}; \
            const f32x2 yc = q0 + q1; \
            yv[s_] = red8(yc[0] + yc[1]); } while (0)
        RW_LD(opA, vvA, 0);
#pragma unroll
        for (int s = 0; s < 16; s += 2) {
            RW_LD(opB, vvB, s + 1);
            __builtin_amdgcn_sched_barrier(0);
            RW_COMP(opA, vvA, s);
            __builtin_amdgcn_sched_barrier(0);
            if (s + 2 < 16) RW_LD(opA, vvA, s + 2);
            __builtin_amdgcn_sched_barrier(0);
            RW_COMP(opB, vvB, s + 1);
            __builtin_amdgcn_sched_barrier(0);
        }
#undef RW_LD
#undef RW_COMP
#pragma unroll
        for (int s = 0; s < 16; ++s) if ((s & 7) == kq) ybuf[((bi * 16 + s) * 64) + vrow] = yv[s];
        }
        __syncthreads();
    }
    if (!comp) RW_FLUSH(NCH - 1);
    __syncthreads();
#undef RW_ISSUE
#undef RW_WRITE
#undef RW_FLUSH
}

constexpr size_t WS_RWSCR = WS_YHY;
constexpr int RWS_QY = 0, RWS_YV = 2048, RWS_PZ = 4096, RWS_ZV = 12288, RWS_SLOT = 20480;
typedef __bf16 bf16x8n __attribute__((ext_vector_type(8)));
__device__ __forceinline__ f32x4 mma16(const bf16x8 a, const bf16x8 b, const f32x4 c) { return __builtin_amdgcn_mfma_f32_16x16x32_bf16(a, b, c, 0, 0, 0); }
__device__ __forceinline__ float dpp_shr(float x, const int n) {
    const int v = __builtin_bit_cast(int, x); int r;
    if (n == 1) r = __builtin_amdgcn_update_dpp(0, v, 0x111, 0xF, 0xF, true); else if (n == 2) r = __builtin_amdgcn_update_dpp(0, v, 0x112, 0xF, 0xF, true);
    else if (n == 4) r = __builtin_amdgcn_update_dpp(0, v, 0x114, 0xF, 0xF, true); else r = __builtin_amdgcn_update_dpp(0, v, 0x118, 0xF, 0xF, true);
    return __builtin_bit_cast(float, r);
}
__device__ __forceinline__ v4u pack8(const float (&x)[8]) { v4u o; o.x = pk2(x[0], x[1]); o.y = pk2(x[2], x[3]); o.z = pk2(x[4], x[5]); o.w = pk2(x[6], x[7]); return o; }
__device__ __forceinline__ void unpack8(const v4u u, float (&x)[8]) { x[0] = bflo(u.x); x[1] = bfhi(u.x); x[2] = bflo(u.y); x[3] = bfhi(u.y); x[4] = bflo(u.z); x[5] = bfhi(u.z); x[6] = bflo(u.w); x[7] = bfhi(u.w); }
constexpr int LDS_ZERO16 = 131072 + 3072;
__device__ __forceinline__ bf16x8 frag16z(const LAS bf16* m, int rowbase, int lane, const LAS v4u* z) {
    const LAS v4u* p = (const LAS v4u*)(m + (rowbase + (lane & 15)) * 16 + 8 * (lane >> 4));
    const v4u v = *(((lane >> 4) < 2) ? p : z); return __builtin_bit_cast(bf16x8, v); }
#define frag16(m_, rb_, ln_) frag16z(m_, rb_, ln_, zp16)
__device__ __forceinline__ void st_colmaj(LAS bf16* m, int colbase, const f32x4 d, int lane) {
    v2u o; o.x = pk2(d[0], d[1]); o.y = pk2(d[2], d[3]); *(LAS v2u*)(m + (colbase + (lane & 15)) * 16 + 4 * (lane >> 4)) = o; }
__device__ __forceinline__ void st_rowmaj(LAS bf16* m, const f32x4 d, int lane) {
#pragma unroll
    for (int r = 0; r < 4; ++r) m[(4 * (lane >> 4) + r) * 16 + (lane & 15)] = (bf16)f2bf(d[r]); }
template <int KS0, int KS1>
__device__ __forceinline__ void rw_chunk_load(const Ctx& F, int b, int h, int d, int cidx, v4u (&raw)[12]) {
    const int lane = opaque_v(F.lane), t = lane & 15, kg = lane >> 4;
    const bf16* base = (const bf16*)(F.a->ws + WS_SCN) + (size_t)seq_row(b, d, 16 * cidx + t) * 9 * 512 + h * 64;
#pragma unroll
    for (int ks = KS0; ks < KS1; ++ks) { const int off = 32 * ks + 8 * kg;
        raw[6 * ks + 0] = *(const v4u*)(base + (3 + 3 * d) * 512 + off); raw[6 * ks + 1] = *(const v4u*)(base + 2 * 512 + off); raw[6 * ks + 2] = *(const v4u*)(base + off);
        raw[6 * ks + 3] = *(const v4u*)(base + (5 + 3 * d) * 512 + off); raw[6 * ks + 4] = *(const v4u*)(base + (4 + 3 * d) * 512 + off); raw[6 * ks + 5] = *(const v4u*)(base + 512 + off); }
}
__device__ __forceinline__ void rw_chunk_task(const Ctx& F, const v4u (&raw)[12], LAS unsigned char* wl, unsigned char* slot) {
    const LAS v4u* zp16 = (const LAS v4u*)(F.lds + LDS_ZERO16);
    const int lane = opaque_v(F.lane), t = lane & 15, kg = lane >> 4;
    LAS bf16* ATt = (LAS bf16*)(wl); LAS bf16* RBr = (LAS bf16*)(wl + 2048); LAS bf16* BHt = (LAS bf16*)(wl + 4096); LAS bf16* KHt = (LAS bf16*)(wl + 6144); LAS bf16* VTt = (LAS bf16*)(wl + 8192);
    LAS bf16* WAt = (LAS bf16*)(wl + 10240); LAS bf16* N_r = (LAS bf16*)(wl + 12288); LAS bf16* N_c = (LAS bf16*)(wl + 12800); LAS bf16* T_r = (LAS bf16*)(wl + 13312);
    LAS bf16* AK_r = (LAS bf16*)(wl + 13824); LAS bf16* RB2 = (LAS bf16*)(wl + 14336); LAS bf16* RK_r = (LAS bf16*)(wl + 14848); LAS float* GCl = (LAS float*)(wl + 15360);
    bf16x8 fAb[2], fRb[2], fBb[2], fKb[2];
#pragma unroll
    for (int ks = 0; ks < 2; ++ks) {
        const int off = 32 * ks + 8 * kg;
        float ea[8], er[8], eb[8], eh[8];
        { const v4u uld = raw[6 * ks + 0]; float ld[8]; unpack8(uld, ld);
#pragma unroll
          for (int j = 0; j < 8; ++j) { float c = ld[j]; c += dpp_shr(c, 1); c += dpp_shr(c, 2); c += dpp_shr(c, 4); c += dpp_shr(c, 8);
              const float tot = __builtin_bit_cast(float, __builtin_amdgcn_ds_bpermute((lane | 15) << 2, __builtin_bit_cast(int, c)));
              ea[j] = __expf(c - ld[j]); er[j] = __expf(c); eb[j] = __expf(-c); eh[j] = __expf(tot - c);
              if (t == 0) GCl[off + j] = __expf(tot); } }
        { const v4u u = raw[6 * ks + 1]; float x[8]; unpack8(u, x);
#pragma unroll
          for (int j = 0; j < 8; ++j) { x[j] = -x[j] * ea[j]; ATt[(off + j) * 16 + t] = (bf16)f2bf(x[j]); }
          const v4u p = pack8(x); fAb[ks] = __builtin_bit_cast(bf16x8, p); }
        { const v4u u = raw[6 * ks + 2]; float x[8]; unpack8(u, x);
#pragma unroll
          for (int j = 0; j < 8; ++j) x[j] = x[j] * er[j];
          const v4u p = pack8(x); fRb[ks] = __builtin_bit_cast(bf16x8, p); *(LAS v4u*)(RBr + t * 64 + off) = p; }
        { const v4u u = raw[6 * ks + 3]; float x[8], y[8]; unpack8(u, x);
#pragma unroll
          for (int j = 0; j < 8; ++j) { y[j] = x[j] * eb[j]; BHt[(off + j) * 16 + t] = (bf16)f2bf(x[j] * eh[j]); }
          const v4u p = pack8(y); fBb[ks] = __builtin_bit_cast(bf16x8, p); }
        { const v4u u = raw[6 * ks + 4]; float x[8], y[8]; unpack8(u, x);
#pragma unroll
          for (int j = 0; j < 8; ++j) { y[j] = x[j] * eb[j]; KHt[(off + j) * 16 + t] = (bf16)f2bf(x[j] * eh[j]); }
          const v4u p = pack8(y); fKb[ks] = __builtin_bit_cast(bf16x8, p); }
        { const v4u u = raw[6 * ks + 5];
          const bf16 e0 = (bf16)(u.x & 0xffff), e1 = (bf16)(u.x >> 16), e2 = (bf16)(u.y & 0xffff), e3 = (bf16)(u.y >> 16), e4 = (bf16)(u.z & 0xffff), e5 = (bf16)(u.z >> 16), e6 = (bf16)(u.w & 0xffff), e7 = (bf16)(u.w >> 16);
          VTt[(off + 0) * 16 + t] = e0; VTt[(off + 1) * 16 + t] = e1; VTt[(off + 2) * 16 + t] = e2; VTt[(off + 3) * 16 + t] = e3; VTt[(off + 4) * 16 + t] = e4; VTt[(off + 5) * 16 + t] = e5; VTt[(off + 6) * 16 + t] = e6; VTt[(off + 7) * 16 + t] = e7; }
        __builtin_amdgcn_sched_barrier(0);
    }
    asm volatile("" ::: "memory");
    const f32x4 z4 = (f32x4){0.f, 0.f, 0.f, 0.f};
    f32x4 n0 = mma16(fAb[1], fBb[1], mma16(fAb[0], fBb[0], z4)), aak = mma16(fAb[1], fKb[1], mma16(fAb[0], fKb[0], z4));
    f32x4 arb = mma16(fRb[1], fBb[1], mma16(fRb[0], fBb[0], z4)), ark = mma16(fRb[1], fKb[1], mma16(fRb[0], fKb[0], z4));
#pragma unroll
    for (int r = 0; r < 4; ++r) { const int tt = 4 * kg + r; if (!(t < tt)) { n0[r] = 0.f; aak[r] = 0.f; } if (!(t <= tt)) { arb[r] = 0.f; ark[r] = 0.f; } }
    st_rowmaj(AK_r, aak, lane); st_rowmaj(RB2, arb, lane); st_rowmaj(RK_r, ark, lane); asm volatile("" ::: "memory");
    f32x4 accT = n0;
#pragma unroll
    for (int r = 0; r < 4; ++r) accT[r] += (4 * kg + r == t) ? 1.f : 0.f;
    f32x4 nn = n0;
#pragma unroll
    for (int itn = 0; itn < 3; ++itn) {
        st_rowmaj(N_r, nn, lane); st_colmaj(N_c, 0, nn, lane); st_rowmaj(T_r, accT, lane); asm volatile("" ::: "memory");
        const bf16x8 fa = frag16(N_r, 0, lane), fb = frag16(N_c, 0, lane), ft = frag16(T_r, 0, lane);
        nn = mma16(fa, fb, z4); asm volatile("" ::: "memory");
        st_colmaj(N_c, 0, nn, lane); asm volatile("" ::: "memory");
        const bf16x8 fb2 = frag16(N_c, 0, lane);
        accT = mma16(ft, fb2, accT); asm volatile("" ::: "memory");
    }
    st_rowmaj(T_r, accT, lane); asm volatile("" ::: "memory");
    const bf16x8 fT = frag16(T_r, 0, lane), fAK = frag16(AK_r, 0, lane), fARB = frag16(RB2, 0, lane), fARK = frag16(RK_r, 0, lane);
#pragma unroll
    for (int kt = 0; kt < 4; ++kt) { const f32x4 dd = mma16(fT, frag16(ATt, 16 * kt, lane), z4); st_colmaj(WAt, 16 * kt, dd, lane); } asm volatile("" ::: "memory");
    { const bf16x8 fArbT = frag16(RB2, 0, lane);
#pragma unroll
      for (int kt = 0; kt < 4; ++kt) { const v2u ri = *(const LAS v2u*)(RBr + t * 64 + 16 * kt + 4 * kg);
          f32x4 c0 = (f32x4){bflo(ri.x), bfhi(ri.x), bflo(ri.y), bfhi(ri.y)};
          c0 = mma16(frag16(WAt, 16 * kt, lane), fArbT, c0);
          v2u o; o.x = pk2(c0[0], c0[1]); o.y = pk2(c0[2], c0[3]); *(v2u*)(slot + RWS_QY + (t * 64 + 16 * kt + 4 * kg) * 2) = o; } }
    asm volatile("" ::: "memory");
#pragma unroll
    for (int vt = 0; vt < 4; ++vt) { const f32x4 dd = mma16(fAK, frag16(VTt, 16 * vt, lane), z4); st_colmaj(ATt, 16 * vt, dd, lane); } asm volatile("" ::: "memory");
    asm volatile("" ::: "memory");
    LAS bf16* UVt = RBr;
#pragma unroll
    for (int vt = 0; vt < 4; ++vt) { const f32x4 dd = mma16(fT, frag16(ATt, 16 * vt, lane), z4); st_colmaj(UVt, 16 * vt, dd, lane); } asm volatile("" ::: "memory");
#pragma unroll
    for (int vt = 0; vt < 4; ++vt) { const f32x4 dd = mma16(fARK, frag16(VTt, 16 * vt, lane), mma16(fARB, frag16(UVt, 16 * vt, lane), z4));
        v2u o; o.x = pk2(dd[0], dd[1]); o.y = pk2(dd[2], dd[3]); *(v2u*)(slot + RWS_YV + ((16 * vt + t) * 16 + 4 * kg) * 2) = o; }
#pragma unroll
    for (int ktp = 0; ktp < 4; ++ktp) { const bf16x8 fBh = frag16(BHt, 16 * ktp, lane);
#pragma unroll
        for (int kt = 0; kt < 4; ++kt) { f32x4 dd = mma16(frag16(WAt, 16 * kt, lane), fBh, z4);
            if (kt == ktp) {
#pragma unroll
                for (int r = 0; r < 4; ++r) if (4 * kg + r == t) dd[r] += GCl[16 * kt + t]; }
            v2u o; o.x = pk2(dd[0], dd[1]); o.y = pk2(dd[2], dd[3]); *(v2u*)(slot + RWS_PZ + ((16 * ktp + t) * 64 + 16 * kt + 4 * kg) * 2) = o; } }
#pragma unroll
    for (int vt = 0; vt < 4; ++vt) { const bf16x8 fU = frag16(UVt, 16 * vt, lane), fV = frag16(VTt, 16 * vt, lane);
#pragma unroll
        for (int ktp = 0; ktp < 4; ++ktp) { const f32x4 dd = mma16(frag16(KHt, 16 * ktp, lane), fV, mma16(frag16(BHt, 16 * ktp, lane), fU, z4));
            v2u o; o.x = pk2(dd[0], dd[1]); o.y = pk2(dd[2], dd[3]); *(v2u*)(slot + RWS_ZV + ((16 * vt + t) * 64 + 16 * ktp + 4 * kg) * 2) = o; } }
}
__device__ __forceinline__ void rw_chunk_task2(const Ctx& F, const v4u (&raw)[12], LAS unsigned char* wl, f32x4 (&yv)[4], f32x4 (&zv)[4][4]) {
    const LAS v4u* zp16 = (const LAS v4u*)(F.lds + LDS_ZERO16);
    const int lane = opaque_v(F.lane), t = lane & 15, kg = lane >> 4;
    LAS bf16* ATt = (LAS bf16*)(wl); LAS bf16* RBr = (LAS bf16*)(wl + 2048); LAS bf16* BHt = (LAS bf16*)(wl + 4096); LAS bf16* KHt = (LAS bf16*)(wl + 6144); LAS bf16* VTt = (LAS bf16*)(wl + 8192);
    LAS bf16* WAt = (LAS bf16*)(wl + 10240); LAS bf16* N_r = (LAS bf16*)(wl + 12288); LAS bf16* N_c = (LAS bf16*)(wl + 12800); LAS bf16* T_r = (LAS bf16*)(wl + 13312);
    LAS bf16* AK_r = (LAS bf16*)(wl + 13824); LAS bf16* RB2 = (LAS bf16*)(wl + 14336); LAS bf16* RK_r = (LAS bf16*)(wl + 14848); LAS float* GCl = (LAS float*)(wl + 15360);
    bf16x8 fAb[2], fRb[2], fBb[2], fKb[2];
#pragma unroll
    for (int ks = 0; ks < 2; ++ks) {
        const int off = 32 * ks + 8 * kg;
        float ea[8], er[8], eb[8], eh[8];
        { const v4u uld = raw[6 * ks + 0]; float ld[8]; unpack8(uld, ld);
#pragma unroll
          for (int j = 0; j < 8; ++j) { float c = ld[j]; c += dpp_shr(c, 1); c += dpp_shr(c, 2); c += dpp_shr(c, 4); c += dpp_shr(c, 8);
              const float tot = __builtin_bit_cast(float, __builtin_amdgcn_ds_bpermute((lane | 15) << 2, __builtin_bit_cast(int, c)));
              ea[j] = __expf(c - ld[j]); er[j] = __expf(c); eb[j] = __expf(-c); eh[j] = __expf(tot - c);
              if (t == 0) GCl[off + j] = __expf(tot); } }
        { const v4u u = raw[6 * ks + 1]; float x[8]; unpack8(u, x);
#pragma unroll
          for (int j = 0; j < 8; ++j) { x[j] = -x[j] * ea[j]; ATt[(off + j) * 16 + t] = (bf16)f2bf(x[j]); }
          const v4u p = pack8(x); fAb[ks] = __builtin_bit_cast(bf16x8, p); }
        { const v4u u = raw[6 * ks + 2]; float x[8]; unpack8(u, x);
#pragma unroll
          for (int j = 0; j < 8; ++j) x[j] = x[j] * er[j];
          const v4u p = pack8(x); fRb[ks] = __builtin_bit_cast(bf16x8, p); *(LAS v4u*)(RBr + t * 64 + off) = p; }
        { const v4u u = raw[6 * ks + 3]; float x[8], y[8]; unpack8(u, x);
#pragma unroll
          for (int j = 0; j < 8; ++j) { y[j] = x[j] * eb[j]; BHt[(off + j) * 16 + t] = (bf16)f2bf(x[j] * eh[j]); }
          const v4u p = pack8(y); fBb[ks] = __builtin_bit_cast(bf16x8, p); }
        { const v4u u = raw[6 * ks + 4]; float x[8], y[8]; unpack8(u, x);
#pragma unroll
          for (int j = 0; j < 8; ++j) { y[j] = x[j] * eb[j]; KHt[(off + j) * 16 + t] = (bf16)f2bf(x[j] * eh[j]); }
          const v4u p = pack8(y); fKb[ks] = __builtin_bit_cast(bf16x8, p); }
        { const v4u u = raw[6 * ks + 5];
          const bf16 e0 = (bf16)(u.x & 0xffff), e1 = (bf16)(u.x >> 16), e2 = (bf16)(u.y & 0xffff), e3 = (bf16)(u.y >> 16), e4 = (bf16)(u.z & 0xffff), e5 = (bf16)(u.z >> 16), e6 = (bf16)(u.w & 0xffff), e7 = (bf16)(u.w >> 16);
          VTt[(off + 0) * 16 + t] = e0; VTt[(off + 1) * 16 + t] = e1; VTt[(off + 2) * 16 + t] = e2; VTt[(off + 3) * 16 + t] = e3; VTt[(off + 4) * 16 + t] = e4; VTt[(off + 5) * 16 + t] = e5; VTt[(off + 6) * 16 + t] = e6; VTt[(off + 7) * 16 + t] = e7; }
        __builtin_amdgcn_sched_barrier(0);
    }
    asm volatile("" ::: "memory");
    const f32x4 z4 = (f32x4){0.f, 0.f, 0.f, 0.f};
    f32x4 n0 = mma16(fAb[1], fBb[1], mma16(fAb[0], fBb[0], z4)), aak = mma16(fAb[1], fKb[1], mma16(fAb[0], fKb[0], z4));
    f32x4 arb = mma16(fRb[1], fBb[1], mma16(fRb[0], fBb[0], z4)), ark = mma16(fRb[1], fKb[1], mma16(fRb[0], fKb[0], z4));
#pragma unroll
    for (int r = 0; r < 4; ++r) { const int tt = 4 * kg + r; if (!(t < tt)) { n0[r] = 0.f; aak[r] = 0.f; } if (!(t <= tt)) { arb[r] = 0.f; ark[r] = 0.f; } }
    st_rowmaj(AK_r, aak, lane); st_rowmaj(RB2, arb, lane); st_rowmaj(RK_r, ark, lane); asm volatile("" ::: "memory");
    f32x4 accT = n0;
#pragma unroll
    for (int r = 0; r < 4; ++r) accT[r] += (4 * kg + r == t) ? 1.f : 0.f;
    f32x4 nn = n0;
#pragma unroll
    for (int itn = 0; itn < 3; ++itn) {
        st_rowmaj(N_r, nn, lane); st_colmaj(N_c, 0, nn, lane); st_rowmaj(T_r, accT, lane); asm volatile("" ::: "memory");
        const bf16x8 fa = frag16(N_r, 0, lane), fb = frag16(N_c, 0, lane), ft = frag16(T_r, 0, lane);
        nn = mma16(fa, fb, z4); asm volatile("" ::: "memory");
        st_colmaj(N_c, 0, nn, lane); asm volatile("" ::: "memory");
        const bf16x8 fb2 = frag16(N_c, 0, lane);
        accT = mma16(ft, fb2, accT); asm volatile("" ::: "memory");
    }
    st_rowmaj(T_r, accT, lane); asm volatile("" ::: "memory");
    const bf16x8 fT = frag16(T_r, 0, lane), fAK = frag16(AK_r, 0, lane), fARB = frag16(RB2, 0, lane), fARK = frag16(RK_r, 0, lane);
#pragma unroll
    for (int kt = 0; kt < 4; ++kt) { const f32x4 dd = mma16(fT, frag16(ATt, 16 * kt, lane), z4); st_colmaj(WAt, 16 * kt, dd, lane); } asm volatile("" ::: "memory");
    f32x4 qy[4];
    { const bf16x8 fArbT = frag16(RB2, 0, lane);
#pragma unroll
      for (int kt = 0; kt < 4; ++kt) { const v2u ri = *(const LAS v2u*)(RBr + t * 64 + 16 * kt + 4 * kg);
          qy[kt] = mma16(frag16(WAt, 16 * kt, lane), fArbT, (f32x4){bflo(ri.x), bfhi(ri.x), bflo(ri.y), bfhi(ri.y)}); } }
    asm volatile("" ::: "memory");
#pragma unroll
    for (int vt = 0; vt < 4; ++vt) { const f32x4 dd = mma16(fAK, frag16(VTt, 16 * vt, lane), z4); st_colmaj(ATt, 16 * vt, dd, lane); } asm volatile("" ::: "memory");
    LAS bf16* UVt = RBr;
#pragma unroll
    for (int vt = 0; vt < 4; ++vt) { const f32x4 dd = mma16(fT, frag16(ATt, 16 * vt, lane), z4); st_colmaj(UVt, 16 * vt, dd, lane); } asm volatile("" ::: "memory");
#pragma unroll
    for (int vt = 0; vt < 4; ++vt) { const bf16x8 fU = frag16(UVt, 16 * vt, lane), fV = frag16(VTt, 16 * vt, lane);
        yv[vt] = mma16(fARK, fV, mma16(fARB, fU, z4));
#pragma unroll
        for (int ktp = 0; ktp < 4; ++ktp) zv[vt][ktp] = mma16(frag16(KHt, 16 * ktp, lane), fV, mma16(frag16(BHt, 16 * ktp, lane), fU, z4)); }
    f32x4 pz[4][4];
#pragma unroll
    for (int ktp = 0; ktp < 4; ++ktp) { const bf16x8 fBh = frag16(BHt, 16 * ktp, lane);
#pragma unroll
        for (int kt = 0; kt < 4; ++kt) { f32x4 dd = mma16(frag16(WAt, 16 * kt, lane), fBh, z4);
            if (kt == ktp) {
#pragma unroll
                for (int r = 0; r < 4; ++r) if (4 * kg + r == t) dd[r] += GCl[16 * kt + t]; }
            pz[ktp][kt] = dd; } }
    asm volatile("s_waitcnt lgkmcnt(0)" ::: "memory");
#pragma unroll
    for (int ktp = 0; ktp < 4; ++ktp) { LAS bf16* reg = (LAS bf16*)(wl + (ktp < 2 ? ktp * 2048 : (ktp + 1) * 2048));
#pragma unroll
        for (int kt = 0; kt < 4; ++kt) { v2u o; o.x = pk2(pz[ktp][kt][0], pz[ktp][kt][1]); o.y = pk2(pz[ktp][kt][2], pz[ktp][kt][3]); *(LAS v2u*)(reg + t * 64 + 16 * kt + 4 * kg) = o; } }
#pragma unroll
    for (int kt = 0; kt < 4; ++kt) { v2u o; o.x = pk2(qy[kt][0], qy[kt][1]); o.y = pk2(qy[kt][2], qy[kt][3]); *(LAS v2u*)(BHt + t * 64 + 16 * kt + 4 * kg) = o; }
    asm volatile("s_waitcnt lgkmcnt(0)" ::: "memory");
}
constexpr int RWZ_OFF = LDSCTL_OFF + 8192, RWF_OFF = LDSCTL_OFF + 2048;
__device__ __forceinline__ void rw_chunk_item2(const Ctx& F, int l, int it, size_t yoff = WS_YDIR) {
    const auto& a = *F.a; unsigned char* ws = a.ws; const int lane = opaque_v(F.lane), t = lane & 15, kg = lane >> 4;
    const int d = it & 1, h = (it >> 1) & 7, b = it >> 4;
    float* YD = (float*)(ws + yoff);
    LAS unsigned char* wl = F.lds + F.wave * 15616;
    LAS bf16* ZS = (LAS bf16*)(F.lds + RWZ_OFF);
    volatile LAS int* flag = (volatile LAS int*)(F.lds + RWF_OFF);
    for (int i = F.tid; i < 2048; i += NTHREADS) ((LAS unsigned*)ZS)[i] = 0u;
    if (F.tid == 0) *flag = 0;
    __syncthreads();
    constexpr int NCHK = (CTXL + SEQ) / 16;
    v4u raw[12];
    rw_chunk_load<0, 2>(F, b, h, d, F.wave, raw);
#pragma unroll 1
    for (int c = F.wave; c < NCHK; c += NWAVES) {
        f32x4 yv[4], zv[4][4];
        rw_chunk_task2(F, raw, wl, yv, zv);
        if (c + NWAVES < NCHK) rw_chunk_load<0, 2>(F, b, h, d, c + NWAVES, raw);
        while (*flag < c) __builtin_amdgcn_s_sleep(1);
        asm volatile("" ::: "memory");
        const LAS bf16* Zc = ZS + (c & 1) * 4096; LAS bf16* Zn = ZS + ((c + 1) & 1) * 4096;
        bf16x8 zb[4][2];
#pragma unroll
        for (int vb = 0; vb < 4; ++vb)
#pragma unroll
            for (int ks = 0; ks < 2; ++ks) zb[vb][ks] = *(const LAS bf16x8*)(Zc + (16 * vb + t) * 64 + 32 * ks + 8 * kg);
        { const LAS bf16* Qr = (const LAS bf16*)(wl + 4096); const bf16x8 q0 = *(const LAS bf16x8*)(Qr + t * 64 + 8 * kg), q1 = *(const LAS bf16x8*)(Qr + t * 64 + 32 + 8 * kg);
#pragma unroll
          for (int vb = 0; vb < 4; ++vb) { const f32x4 y = mma16(q1, zb[vb][1], mma16(q0, zb[vb][0], yv[vb]));
#pragma unroll
              for (int r = 0; r < 4; ++r) { const int row = seq_row(b, d, c * 16 + 4 * kg + r); YD[((size_t)d * T_ALL + row) * 512 + h * 64 + 16 * vb + t] = y[r]; } } }
#pragma unroll
        for (int ktp = 0; ktp < 4; ++ktp) { const LAS bf16* Pr = (const LAS bf16*)(wl + (ktp < 2 ? ktp * 2048 : (ktp + 1) * 2048));
            const bf16x8 p0 = *(const LAS bf16x8*)(Pr + t * 64 + 8 * kg), p1 = *(const LAS bf16x8*)(Pr + t * 64 + 32 + 8 * kg);
#pragma unroll
            for (int vb = 0; vb < 4; ++vb) { const f32x4 z = mma16(p1, zb[vb][1], mma16(p0, zb[vb][0], zv[vb][ktp]));
                v2u o; o.x = pk2(z[0], z[1]); o.y = pk2(z[2], z[3]); *(LAS v2u*)(Zn + (16 * vb + t) * 64 + 16 * ktp + 4 * kg) = o; } }
        asm volatile("s_waitcnt lgkmcnt(0)" ::: "memory");
        if (lane == 0) *flag = c + 1;
        asm volatile("s_waitcnt lgkmcnt(0)" ::: "memory");
    }
    __syncthreads();
}
__device__ __forceinline__ v2u ld_sc1_8(const void* p) { const unsigned long long v = __hip_atomic_load((const unsigned long long*)p, __ATOMIC_RELAXED, __HIP_MEMORY_SCOPE_AGENT); v2u o; o.x = (unsigned)v; o.y = (unsigned)(v >> 32); return o; }
__device__ __forceinline__ v4u ld_sc1_16(const void* p) { const v2u a = ld_sc1_8(p), b = ld_sc1_8((const char*)p + 8); return (v4u){a.x, a.y, b.x, b.y}; }
__device__ __forceinline__ void rw_chunk_item(const Ctx& F, int l, int it) {
    const auto& a = *F.a; unsigned char* ws = a.ws; const int lane = F.lane, t = lane & 15, kg = lane >> 4;
    const int d = it & 1, h = (it >> 1) & 7, b = it >> 4;
    float* YD = (float*)(ws + WS_YDIR);
    unsigned char* scr = ws + WS_RWSCR + (size_t)F.bid * 16 * RWS_SLOT;
    LAS unsigned char* wl = F.lds + F.wave * 15616;
    LAS bf16* ZL = (LAS bf16*)(F.lds + LDSCTL_OFF + 4096 + (F.wave & 3) * 2048);
    if (F.wave < 4) { for (int i = lane; i < 512; i += 64) ((LAS unsigned*)ZL)[i] = 0u; }
    asm volatile("" ::: "memory");
    constexpr int NCHK = (CTXL + SEQ) / 16, NB = NCHK / 16;
#pragma unroll 1
    for (int bt = 0; bt < NB; ++bt) {
        { v4u cur[12];
#pragma unroll 1
          for (int jj = 0; jj < 2; ++jj) { rw_chunk_load<0, 2>(F, b, h, d, bt * 16 + F.wave + 8 * jj, cur); rw_chunk_task(F, cur, wl, scr + (size_t)(F.wave + 8 * jj) * RWS_SLOT); } }
        asm volatile("s_waitcnt vmcnt(0)" ::: "memory");
        __syncthreads();
        {
            const int t = opaque_v(lane & 15), kg = opaque_v(lane >> 4), vb = opaque(F.wave) & 3;
            const unsigned char* scrb = F.a->ws + WS_RWSCR + (size_t)opaque(F.bid) * 16 * RWS_SLOT;
            LAS unsigned char* sbuf = F.lds;
            const int lt = opaque_v(F.tid) & 255; const bool loader = F.wave >= 4;
            const int lw = opaque(F.wave) & 3;
#define RWB_ISSUE(j_) do { const unsigned char* gp_ = scrb + (size_t)(j_) * RWS_SLOT + (size_t)(lw * 5) * 1024 + lane * 16; LAS unsigned char* lp_ = sbuf + ((j_) % 6) * RWS_SLOT + (lw * 5) * 1024; \
                _Pragma("unroll") for (int q = 0; q < 5; ++q) __builtin_amdgcn_global_load_lds((const unsigned*)(gp_ + q * 1024), (LAS unsigned*)(lp_ + q * 1024), 16, 0, 16); } while (0)
#define RWB_COMP(bi_, j_) do { const LAS unsigned char* sl_ = sbuf + (bi_) * RWS_SLOT; bf16x8 zb[2], qf[2]; \
                _Pragma("unroll") for (int ks = 0; ks < 2; ++ks) { zb[ks] = *(const LAS bf16x8*)(ZL + t * 64 + 32 * ks + 8 * kg); qf[ks] = *(const LAS bf16x8*)(sl_ + RWS_QY + (t * 64 + 32 * ks + 8 * kg) * 2); } \
                const v2u y_ = *(const LAS v2u*)(sl_ + RWS_YV + ((16 * vb + t) * 16 + 4 * kg) * 2); \
                f32x4 yacc = (f32x4){bflo(y_.x), bfhi(y_.x), bflo(y_.y), bfhi(y_.y)}; \
                yacc = mma16(qf[1], zb[1], mma16(qf[0], zb[0], yacc)); \
                f32x4 zn[4]; \
                _Pragma("unroll") for (int ktp = 0; ktp < 4; ++ktp) { const v2u z_ = *(const LAS v2u*)(sl_ + RWS_ZV + ((16 * vb + t) * 64 + 16 * ktp + 4 * kg) * 2); \
                    f32x4 zc = (f32x4){bflo(z_.x), bfhi(z_.x), bflo(z_.y), bfhi(z_.y)}; \
                    _Pragma("unroll") for (int ks = 0; ks < 2; ++ks) zc = mma16(*(const LAS bf16x8*)(sl_ + RWS_PZ + ((16 * ktp + t) * 64 + 32 * ks + 8 * kg) * 2), zb[ks], zc); \
                    zn[ktp] = zc; } \
                _Pragma("unroll") for (int r = 0; r < 4; ++r) { const int row = seq_row(b, d, (bt * 16 + (j_)) * 16 + 4 * kg + r); YD[((size_t)d * T_ALL + row) * 512 + h * 64 + 16 * vb + t] = yacc[r]; } \
                asm volatile("s_waitcnt lgkmcnt(0)" ::: "memory"); \
                _Pragma("unroll") for (int ktp = 0; ktp < 4; ++ktp) { v2u o; o.x = pk2(zn[ktp][0], zn[ktp][1]); o.y = pk2(zn[ktp][2], zn[ktp][3]); *(LAS v2u*)(ZL + t * 64 + 16 * ktp + 4 * kg) = o; } \
                asm volatile("s_waitcnt lgkmcnt(0)" ::: "memory"); } while (0)
#define RWB_BAR() do { asm volatile("s_waitcnt lgkmcnt(0)" ::: "memory"); __builtin_amdgcn_s_barrier(); asm volatile("" ::: "memory"); } while (0)
            if (loader) { RWB_ISSUE(0); RWB_ISSUE(1); RWB_ISSUE(2); RWB_ISSUE(3); asm volatile("s_waitcnt vmcnt(15)" ::: "memory"); }
            RWB_BAR();
#pragma unroll 1
            for (int j = 0; j < 16; ++j) {
                if (loader) { if (j + 4 < 16) { RWB_ISSUE(j + 4); asm volatile("s_waitcnt vmcnt(15)" ::: "memory"); } else { asm volatile("s_waitcnt vmcnt(0)" ::: "memory"); } }
                else { RWB_COMP(j % 6, j); }
                RWB_BAR();
            }
#undef RWB_BAR
#undef RWB_ISSUE
#undef RWB_COMP
        }
        __syncthreads();
    }
}

__device__ __forceinline__ void stage_rw_readout(const Ctx& F, int l) {
    const auto& a = *F.a; unsigned char* ws = a.ws; const int lane = F.lane;
    const bf16* SCN = (const bf16*)(ws + WS_SCN); const bf16* P = (const bf16*)(ws + WS_P); const float* YD = (const float*)(ws + WS_YDIR); bf16* YRW = (bf16*)(ws + WS_YRW);
    const int gw = F.bid * NWAVES + F.wave, NGW = F.G * NWAVES;
    constexpr int TR = 17, NRT = T_ALL / TR;
    for (int tile = gw; tile < NRT * 4; tile += NGW) {
        const int rt = tile % NRT, hp = tile / NRT, row0 = rt * TR, c0 = hp * 128 + 2 * lane;
        const f32x2 rk = *(const f32x2*)(a.in[I_RWRK] + l * 512 + c0), lng = *(const f32x2*)(a.in[I_RWLNG] + l * 512 + c0), lnb = *(const f32x2*)(a.in[I_RWLNB] + l * 512 + c0);
#pragma unroll 4
        for (int i = 0; i < TR; ++i) {
            const int row = row0 + i;
            const unsigned* sp = (const unsigned*)(SCN + (size_t)row * 9 * 512 + c0);
            const unsigned ru = sp[0], vu = sp[256], k0u = sp[4 * 256], k1u = sp[7 * 256];
            const f32x2 y0 = *(const f32x2*)(YD + (size_t)row * 512 + c0), y1 = *(const f32x2*)(YD + ((size_t)T_ALL + row) * 512 + c0);
            const unsigned gu = *(const unsigned*)(P + (size_t)row * 2560 + 2048 + c0);
            const float bon = red32(bflo(ru) * (bflo(k0u) + bflo(k1u)) * rk[0] + bfhi(ru) * (bfhi(k0u) + bfhi(k1u)) * rk[1]);
            f32x2 y = y0 + y1 + (f32x2){bflo(vu), bfhi(vu)} * bon;
            const float mu = red32(y[0] + y[1]) * (1.f / 64.f);
            y = y - mu;
            const float var = red32(y[0] * y[0] + y[1] * y[1]) * (1.f / 64.f);
            const f32x2 yn = y * (1.0f / sqrtf(var + 64e-5f));
            const f32x2 ov = (yn * lng + lnb) * (f32x2){bflo(gu), bfhi(gu)};
            *(unsigned*)(YRW + (size_t)row * 512 + c0) = pk2(ov[0], ov[1]);
        }
    }
}

constexpr size_t WS_S5E = 6 * MiB;
constexpr int S5_NSEG = 4, S5_SEGLEN = (CTXL + SEQ) / S5_NSEG;
__device__ __forceinline__ void s5_disc(const float are, const float aim, const float dt, float& lbr, float& lbi, float& cr, float& ci) {
    const float mag = expf(are * dt); lbr = mag * cosf(aim * dt); lbi = mag * sinf(aim * dt);
    const float den = are * are + aim * aim, nr = lbr - 1.0f; cr = (nr * are + lbi * aim) / den; ci = (lbi * are - nr * aim) / den;
}
template <int PASS>
__device__ __forceinline__ void stage_s5_scan(const Ctx& F, int l) {
    const auto& a = *F.a; unsigned char* ws = a.ws; const int lane = F.lane;
    const bf16* Z = (const bf16*)(ws + WS_Z); float* YP = (float*)(ws + WS_YP); f32x2* S5E = (f32x2*)(ws + WS_S5E);
    LAS unsigned char* wl = F.lds + F.wave * 16384;
    LAS float* buL = (LAS float*)wl;
    LAS bf16* Hs = (LAS bf16*)(wl + 8704);
    const int fr = lane & 15, kg = lane >> 4;
    for (int itx = F.bid * NWAVES + F.wave; itx < BATCH * 32 * 2 * S5_NSEG; itx += NWAVES * F.G) {
        const int seg = itx & (S5_NSEG - 1), it = itx >> 2;
        const int d = it & 1, g = (it >> 1) & 31, b = it >> 6, p = lane;
        const float dt = expf(a.in[I_S5LDT][(l * 2 + d) * 32 + g]);
        const float* arep = a.in[I_S5ARE] + ((size_t)(l * 2 + d) * 32 + g) * 64; const float* aimp = a.in[I_S5AIM] + ((size_t)(l * 2 + d) * 32 + g) * 64;
        float lbr, lbi, cr_, ci_; s5_disc(arep[p], aimp[p], dt, lbr, lbi, cr_, ci_);
        bf16x8 afr[2][4];
#pragma unroll
        for (int tl = 0; tl < 4; ++tl) { const int pp = 16 * tl + fr; float r0_, r1_, cr, ci; s5_disc(arep[pp], aimp[pp], dt, r0_, r1_, cr, ci);
            v4u pr = (v4u){0u, 0u, 0u, 0u}, pi = (v4u){0u, 0u, 0u, 0u};
            if (kg < 2) { const float* br = a.in[I_S5BRE] + (((size_t)l * 32 + g) * 64 + pp) * 16 + 8 * kg; const float* bi = a.in[I_S5BIM] + (((size_t)l * 32 + g) * 64 + pp) * 16 + 8 * kg;
                const f32x4 x0 = *(const f32x4*)br, x1 = *(const f32x4*)(br + 4), y0 = *(const f32x4*)bi, y1 = *(const f32x4*)(bi + 4);
                pr.x = pk2(cr * x0[0] - ci * y0[0], cr * x0[1] - ci * y0[1]); pr.y = pk2(cr * x0[2] - ci * y0[2], cr * x0[3] - ci * y0[3]);
                pr.z = pk2(cr * x1[0] - ci * y1[0], cr * x1[1] - ci * y1[1]); pr.w = pk2(cr * x1[2] - ci * y1[2], cr * x1[3] - ci * y1[3]);
                pi.x = pk2(cr * y0[0] + ci * x0[0], cr * y0[1] + ci * x0[1]); pi.y = pk2(cr * y0[2] + ci * x0[2], cr * y0[3] + ci * x0[3]);
                pi.z = pk2(cr * y1[0] + ci * x1[0], cr * y1[1] + ci * x1[1]); pi.w = pk2(cr * y1[2] + ci * x1[2], cr * y1[3] + ci * x1[3]); }
            afr[0][tl] = __builtin_bit_cast(bf16x8, pr); afr[1][tl] = __builtin_bit_cast(bf16x8, pi); }
        bf16x8 cf[4];
        f32x2 hst = (f32x2){0.f, 0.f};
        if (PASS == 1) {
#pragma unroll
            for (int kk = 0; kk < 4; ++kk) { const int p0 = 16 * kk + 4 * kg;
                const f32x4 c0 = *(const f32x4*)(a.in[I_S5CRE] + (((size_t)l * 32 + g) * 16 + fr) * 64 + p0), c1 = *(const f32x4*)(a.in[I_S5CIM] + (((size_t)l * 32 + g) * 16 + fr) * 64 + p0);
                v4u pk; pk.x = pk2(c0[0], -c1[0]); pk.y = pk2(c0[1], -c1[1]); pk.z = pk2(c0[2], -c1[2]); pk.w = pk2(c0[3], -c1[3]);
                cf[kk] = __builtin_bit_cast(bf16x8, pk); }
            float pr_ = lbr, pi_ = lbi, l64r = 1.f, l64i = 0.f;
#pragma unroll 1
            for (int q = 0; q < 10; ++q) { const float nr2 = pr_ * pr_ - pi_ * pi_, ni2 = 2.f * pr_ * pi_; pr_ = nr2; pi_ = ni2; if (q == 5) { l64r = pr_; l64i = pi_; } }
            const float lLr = pr_ * l64r - pi_ * l64i, lLi = pr_ * l64i + pi_ * l64r;
#pragma unroll 1
            for (int sgi = 0; sgi < seg; ++sgi) { const f32x2 ev = S5E[((size_t)it * S5_NSEG + sgi) * 64 + p];
                hst = (f32x2){lLr * hst[0] - lLi * hst[1] + ev[0], lLr * hst[1] + lLi * hst[0] + ev[1]}; }
        }
        const f32x2 lbr2 = (f32x2){lbr, lbr}, lbi2 = (f32x2){lbi, lbi};
        const int sbeg = seg * S5_SEGLEN, send = sbeg + S5_SEGLEN;
        v4u un = (v4u){0u, 0u, 0u, 0u}, un2 = un, un3 = un, uc;
#define S5_LOADU(dst_, s0_) do { if (kg < 2) { const int row_ = seq_row(b, d, (s0_) + fr); dst_ = *(const v4u*)(Z + (size_t)row_ * IN_COLS + S5_OFF + g * 16 + kg * 8); } } while (0)
        S5_LOADU(un, sbeg); S5_LOADU(un2, sbeg + 16); S5_LOADU(un3, sbeg + 32);
#pragma unroll 1
        for (int s0 = sbeg; s0 < send; s0 += 16) {
            uc = un; un = un2; un2 = un3;
            if (s0 + 48 < send) S5_LOADU(un3, s0 + 48);
            const bf16x8 ufr = __builtin_bit_cast(bf16x8, uc);
#pragma unroll
            for (int c = 0; c < 2; ++c)
#pragma unroll
                for (int tl = 0; tl < 4; ++tl) { const f32x4 dd = __builtin_amdgcn_mfma_f32_16x16x32_bf16(afr[c][tl], ufr, (f32x4){0.f, 0.f, 0.f, 0.f}, 0, 0, 0);
                    *(LAS f32x4*)(buL + (c * 16 + fr) * 68 + 16 * tl + 4 * kg) = dd; }
            LDS_WAIT(); asm volatile("" ::: "memory");
            f32x2 bu[16];
#pragma unroll
            for (int s = 0; s < 16; ++s) bu[s] = (f32x2){buL[s * 68 + p], buL[(16 + s) * 68 + p]};
#pragma unroll
            for (int s = 0; s < 16; ++s) {
                const f32x2 sw = (f32x2){-hst[1], hst[0]};
                hst = lbr2 * hst + (lbi2 * sw + bu[s]);
                if (PASS == 1) *(LAS unsigned*)(Hs + s * 136 + 2 * p) = pg8::cvt_pk_bf16(hst[0], hst[1]);
            }
            if (PASS == 1) {
                LDS_WAIT(); asm volatile("" ::: "memory");
                f32x4 acc = (f32x4){0.f, 0.f, 0.f, 0.f};
#pragma unroll
                for (int kk = 0; kk < 4; ++kk) { const bf16x8 af = *(const LAS bf16x8*)(Hs + fr * 136 + 32 * kk + 8 * kg); acc = __builtin_amdgcn_mfma_f32_16x16x32_bf16(af, cf[kk], acc, 0, 0, 0); }
#pragma unroll
                for (int r = 0; r < 4; ++r) { const int row = seq_row(b, d, s0 + 4 * kg + r); YP[((size_t)d * T_ALL + row) * 512 + g * 16 + fr] = acc[r]; }
            }
            LDS_WAIT(); asm volatile("" ::: "memory");
        }
        if (PASS == 0) S5E[((size_t)it * S5_NSEG + seg) * 64 + p] = hst;
#undef S5_LOADU
    }
}

__device__ __forceinline__ void stage_s5_prep(const Ctx& F, int l, int nrows) {
    const auto& a = *F.a; unsigned char* ws = a.ws;
    const bf16* Z = (const bf16*)(ws + WS_Z); const float* YP = (const float*)(ws + WS_YP); bf16* AS5 = (bf16*)(ws + WS_AS5);
    const int c = 4 * (F.tid & 127), rq = F.tid >> 7;
    const f32x4 dsk = *(const f32x4*)(a.in[I_S5D] + l * 512 + c);
#pragma unroll 2
    for (int row = F.bid * 4 + rq; row < nrows; row += F.G * 4) {
        const v2u uz = *(const v2u*)(Z + (size_t)row * IN_COLS + S5_OFF + c);
        const f32x4 y0 = *(const f32x4*)(YP + (size_t)row * 512 + c), y1 = *(const f32x4*)(YP + ((size_t)T_ALL + row) * 512 + c);
        const f32x4 u = (f32x4){bflo(uz.x), bfhi(uz.x), bflo(uz.y), bfhi(uz.y)};
        const f32x4 y = y0 + y1 + u * dsk;
        float ge[4];
#pragma unroll
        for (int j = 0; j < 4; ++j) ge[j] = 0.5f * y[j] * (1.f + tanh_fast(0.7978845608028654f * (y[j] + 0.044715f * y[j] * y[j] * y[j])));
        v2u o; o.x = pk2(ge[0], ge[1]); o.y = pk2(ge[2], ge[3]);
        *(v2u*)(AS5 + (size_t)row * 512 + c) = o;
    }
}

__device__ __forceinline__ void stage_hy_pre(const Ctx& F, int l, int nrows) {
    const auto& a = *F.a; unsigned char* ws = a.ws; const int lane = F.lane;
    const bf16* Z = (const bf16*)(ws + WS_Z); bf16* UT = (bf16*)(ws + WS_UT);
    LAS unsigned char* tl = F.lds + F.wave * 16384;
    const float* cw = a.in[I_HYCW] + (size_t)l * 3 * 1536; const float* cbp = a.in[I_HYCB] + l * 1536;
    const int gw = F.bid * NWAVES + F.wave, NGW = F.G * NWAVES;
    const int q = lane >> 3, k = lane & 7;
    for (int tile = gw; tile < (nrows / 64) * 24; tile += NGW) {
        const int rt = tile / 24, ct = tile % 24, row0 = rt * 64, c0 = ct * 64;
        int base, pos0, n; row_seq(row0, base, pos0, n);
        const bf16* zt = Z + (size_t)row0 * IN_COLS + HY_OFF + c0 + 8 * k;
        v4u v[8], hv = (v4u){0u, 0u, 0u, 0u};
#pragma unroll
        for (int i = 0; i < 8; ++i) v[i] = *(const v4u*)(zt + (size_t)(8 * i + q) * IN_COLS);
        if (q == 0 && pos0 > 0) hv = *(const v4u*)(zt - (size_t)IN_COLS);
        if (q == 1 && pos0 + 64 < n) hv = *(const v4u*)(zt + (size_t)64 * IN_COLS);
#pragma unroll
        for (int i = 0; i < 8; ++i) { LAS unsigned* p = (LAS unsigned*)(tl + (1 + 8 * i + q) * 132 + 16 * k); p[0] = v[i].x; p[1] = v[i].y; p[2] = v[i].z; p[3] = v[i].w; }
        if (q < 2) { LAS unsigned* p = (LAS unsigned*)(tl + (q ? 65 : 0) * 132 + 16 * k); p[0] = hv.x; p[1] = hv.y; p[2] = hv.z; p[3] = hv.w; }
        LDS_WAIT(); asm volatile("" ::: "memory");
#pragma unroll 2
        for (int i = 0; i < 8; ++i) {
            const int ch = 8 * i + q, col = c0 + ch;
            const float w0 = cw[col], w1 = cw[1536 + col], w2 = cw[2 * 1536 + col], cb = cbp[col];
            const LAS unsigned short* s = (const LAS unsigned short*)(tl + (8 * k) * 132 + ch * 2);
            float z[10];
#pragma unroll
            for (int t = 0; t < 10; ++t) z[t] = __builtin_bit_cast(float, (unsigned)s[t * 66] << 16);
            float o[8];
#pragma unroll
            for (int t = 0; t < 8; ++t) o[t] = w0 * z[t] + w1 * z[t + 1] + w2 * z[t + 2] + cb;
            v4u w; w.x = pk2(o[0], o[1]); w.y = pk2(o[2], o[3]); w.z = pk2(o[4], o[5]); w.w = pk2(o[6], o[7]);
            *(v4u*)(UT + (size_t)col * T_ALL + row0 + 8 * k) = w;
        }
        LDS_WAIT(); asm volatile("" ::: "memory");
    }
}
__device__ __forceinline__ void stage_hy_post(const Ctx& F, int l, int nrows) {
    const auto& a = *F.a; unsigned char* ws = a.ws; const int lane = F.lane;
    const bf16* YT = (const bf16*)(ws + WS_UT) + (size_t)1024 * T_ALL; bf16* YHY = (bf16*)(ws + WS_YHY);
    LAS unsigned char* tl = F.lds + F.wave * 16384;
    const int gw = F.bid * NWAVES + F.wave, NGW = F.G * NWAVES;
    const int q = lane >> 3, k = lane & 7;
    for (int tile = gw; tile < (nrows / 64) * 8; tile += NGW) {
        const int rt = tile >> 3, ct = tile & 7, row0 = rt * 64, c0 = ct * 64;
        const bf16* yp = YT + (size_t)(c0 + q) * T_ALL + row0 + 8 * k;
        v4u v[8];
#pragma unroll
        for (int i = 0; i < 8; ++i) v[i] = *(const v4u*)(yp + (size_t)(8 * i) * T_ALL);
#pragma unroll
        for (int i = 0; i < 8; ++i) { LAS unsigned* p = (LAS unsigned*)(tl + (8 * i + q) * 132 + 16 * k); p[0] = v[i].x; p[1] = v[i].y; p[2] = v[i].z; p[3] = v[i].w; }
        LDS_WAIT(); asm volatile("" ::: "memory");
#pragma unroll
        for (int i = 0; i < 8; ++i) { const int r = 8 * i + q;
            const LAS unsigned short* s = (const LAS unsigned short*)(tl + (8 * k) * 132 + r * 2);
            unsigned e[8];
#pragma unroll
            for (int j = 0; j < 8; ++j) e[j] = s[j * 66];
            v4u w; w.x = e[0] | (e[1] << 16); w.y = e[2] | (e[3] << 16); w.z = e[4] | (e[5] << 16); w.w = e[6] | (e[7] << 16);
            *(v4u*)(YHY + (size_t)(row0 + r) * 512 + c0 + 8 * k) = w; }
        LDS_WAIT(); asm volatile("" ::: "memory");
    }
}
typedef float f32x16 __attribute__((ext_vector_type(16)));
__device__ __forceinline__ void hyena_item(const Ctx& F, int l, int c, int isctx) {
    const auto& a = *F.a; unsigned char* ws = a.ws; const int tid = F.tid, lane = F.lane;
    const int n = isctx ? CTXL : SEQ, rowbase = isctx ? T_LAT : 0, RL = isctx ? HY_RLENC : HY_RLEN, off = n + 47;
    const bf16* UT = (const bf16*)(ws + WS_UT);
    const bf16* x1g = UT + (size_t)c * T_ALL + rowbase; const bf16* x2g = UT + (size_t)(512 + c) * T_ALL + rowbase; bf16* vg = (bf16*)UT + (size_t)(1024 + c) * T_ALL + rowbase;
    const bf16* Rg = (const bf16*)(ws + WS_GF + l * GF_STRIDE + (isctx ? GF_CTX : 0)) + (size_t)c * RL;
    LAS unsigned char* XB = F.lds; LAS unsigned char* R1 = F.lds + HY_R1_OFF; LAS unsigned char* R2 = F.lds + HY_R2_OFF;
    { const int cpb = n / 8;
      for (int q = tid; q < 8 * cpb; q += NTHREADS) { const int b = q / cpb, ch = q % cpb; *(LAS v4u*)(XB + b * HY_ROWB + 2 * HY_MARG + 16 * ch) = *(const v4u*)(vg + (size_t)b * n + 8 * ch); }
      if (tid < 256) { const int b = tid >> 5, side = (tid >> 4) & 1, ch = tid & 15; const unsigned zz = (unsigned)opaque_v(0); *(LAS v4u*)(XB + b * HY_ROWB + (side ? 2 * (HY_MARG + n) : 0) + 16 * ch) = (v4u){zz, zz, zz, zz}; }
      const int rch = RL / 8;
      for (int q = tid; q < rch; q += NTHREADS) { *(LAS v4u*)(R1 + 16 * q) = *(const v4u*)(Rg + 8 * q); *(LAS v4u*)(R2 + 16 * q) = *(const v4u*)(Rg + (size_t)512 * RL + 8 * q); } }
    __syncthreads();
    const int i = lane & 31, kg = lane >> 5, jb = lane & 3, bb = (lane & 31) >> 2;
    const int rsh = (off - i) & 7, rd = rsh >> 1; const bool s1 = rd & 1, s2 = rd & 2; const unsigned sh = (rsh & 1) ? 16u : 0u;
    const int aconst = 2 * (off - i + 8 * kg - rsh), bconst = bb * HY_ROWB + 2 * (HY_MARG + 32 * jb + 8 * kg);
    const int T0w = 512 * F.wave; const int ntile = (n - T0w) >= 512 ? 4 : ((n - T0w) > 0 ? (n - T0w) / 128 : 0);
    const float bias0 = a.in[I_HYBIAS][(l * 2 + 0) * 512 + c], bias1 = a.in[I_HYBIAS][(l * 2 + 1) * 512 + c];
    f32x16 acc[4];
    v2u y1p[4][4];
#define HY_AFRAG(wa, wb, afr) do { \
        const unsigned a0 = s1 ? wa.y : wa.x, a1 = s1 ? wa.z : wa.y, a2 = s1 ? wa.w : wa.z, a3 = s1 ? wb.x : wa.w, a4 = s1 ? wb.y : wb.x, a5 = s1 ? wb.z : wb.y, a6 = s1 ? wb.w : wb.z; \
        const unsigned b0 = s2 ? a2 : a0, b1 = s2 ? a3 : a1, b2 = s2 ? a4 : a2, b3 = s2 ? a5 : a3, b4 = s2 ? a6 : a4; \
        v4u af_; af_.x = __builtin_amdgcn_alignbit(b1, b0, sh); af_.y = __builtin_amdgcn_alignbit(b2, b1, sh); af_.z = __builtin_amdgcn_alignbit(b3, b2, sh); af_.w = __builtin_amdgcn_alignbit(b4, b3, sh); \
        afr = __builtin_bit_cast(bf16x8, af_); } while (0)
#define HY_STEP_COND(RB, d) do { \
        const v4u wa = *(const LAS v4u*)((RB) + aconst - 2 * (d)), wb = *(const LAS v4u*)((RB) + aconst - 2 * (d) + 16); bf16x8 afr; HY_AFRAG(wa, wb, afr); \
        _Pragma("unroll") for (int m = 0; m < 4; ++m) { const int T0 = T0w + 128 * m; \
            if (m < ntile && (d) >= T0 - n + 16 && (d) <= T0 + 96) { const bf16x8 bfr = *(const LAS bf16x8*)(XB + bconst + 2 * (T0 - (d))); \
                acc[m] = __builtin_amdgcn_mfma_f32_32x32x16_bf16(afr, bfr, acc[m], 0, 0, 0); } } } while (0)
#define HY_LOAD(RB, d, wa, wb, bq) do { wa = *(const LAS v4u*)((RB) + aconst - 2 * (d)); wb = *(const LAS v4u*)((RB) + aconst - 2 * (d) + 16); \
        _Pragma("unroll") for (int m = 0; m < 4; ++m) bq[m] = *(const LAS bf16x8*)(XB + bconst + 2 * (T0w + 128 * m - (d))); } while (0)
#define HY_MMA(wa, wb, bq) do { bf16x8 afr; HY_AFRAG(wa, wb, afr); \
        _Pragma("unroll") for (int m = 0; m < 4; ++m) acc[m] = __builtin_amdgcn_mfma_f32_32x32x16_bf16(afr, bq[m], acc[m], 0, 0, 0); } while (0)
#define HY_CONV(RB) do { \
        _Pragma("unroll") for (int m = 0; m < 4; ++m) _Pragma("unroll") for (int e = 0; e < 16; ++e) acc[m][e] = 0.f; \
        if (ntile == 4) { \
            const int dA = T0w - n + 16, dB = T0w + 384 - n + 16, dC = T0w + 96, dD = T0w + 384 + 96;     \
            _Pragma("unroll 1") for (int d = dA; d < dB; d += 16) HY_STEP_COND(RB, d); \
            { v4u waA, wbA, waB, wbB; bf16x8 bqA[4], bqB[4]; \
              HY_LOAD(RB, dB, waA, wbA, bqA); \
              _Pragma("unroll 1") for (int d = dB; d <= dC; d += 32) { \
                  if (d + 16 <= dC) HY_LOAD(RB, d + 16, waB, wbB, bqB); \
                  __builtin_amdgcn_sched_barrier(0); \
                  HY_MMA(waA, wbA, bqA); \
                  __builtin_amdgcn_sched_barrier(0); \
                  if (d + 32 <= dC) HY_LOAD(RB, d + 32, waA, wbA, bqA); \
                  __builtin_amdgcn_sched_barrier(0); \
                  if (d + 16 <= dC) HY_MMA(waB, wbB, bqB); \
                  __builtin_amdgcn_sched_barrier(0); } } \
            _Pragma("unroll 1") for (int d = dC + 16; d <= dD; d += 16) HY_STEP_COND(RB, d); \
        } else if (ntile > 0) { const int dhi = T0w + 128 * (ntile - 1) + 96; \
            _Pragma("unroll 1") for (int d = T0w - n + 16; d <= dhi; d += 16) HY_STEP_COND(RB, d); } } while (0)
    HY_CONV(R1);
#pragma unroll
    for (int m = 0; m < 4; ++m) if (m < ntile) {
#pragma unroll
        for (int rg = 0; rg < 4; ++rg) { const int t4 = T0w + 128 * m + 32 * jb + 8 * rg + 4 * kg;
            const v2u xv = *(const v2u*)(x1g + (size_t)bb * n + t4); const v2u vv = *(const LAS v2u*)(XB + bb * HY_ROWB + 2 * (HY_MARG + t4));
            const float y0 = bflo(xv.x) * (acc[m][4 * rg + 0] + bias0 * bflo(vv.x)), y1 = bfhi(xv.x) * (acc[m][4 * rg + 1] + bias0 * bfhi(vv.x));
            const float y2 = bflo(xv.y) * (acc[m][4 * rg + 2] + bias0 * bflo(vv.y)), y3 = bfhi(xv.y) * (acc[m][4 * rg + 3] + bias0 * bfhi(vv.y));
            y1p[m][rg].x = pk2(y0, y1); y1p[m][rg].y = pk2(y2, y3); } }
    __syncthreads();
#pragma unroll
    for (int m = 0; m < 4; ++m) if (m < ntile) {
#pragma unroll
        for (int rg = 0; rg < 4; ++rg) { const int t4 = T0w + 128 * m + 32 * jb + 8 * rg + 4 * kg; *(LAS v2u*)(XB + bb * HY_ROWB + 2 * (HY_MARG + t4)) = y1p[m][rg]; } }
    __syncthreads();
    HY_CONV(R2);
#pragma unroll
    for (int m = 0; m < 4; ++m) if (m < ntile) {
#pragma unroll
        for (int rg = 0; rg < 4; ++rg) { const int t4 = T0w + 128 * m + 32 * jb + 8 * rg + 4 * kg;
            const v2u xv = *(const v2u*)(x2g + (size_t)bb * n + t4); const v2u yv = y1p[m][rg];
            const float o0 = bflo(xv.x) * (acc[m][4 * rg + 0] + bias1 * bflo(yv.x)), o1 = bfhi(xv.x) * (acc[m][4 * rg + 1] + bias1 * bfhi(yv.x));
            const float o2 = bflo(xv.y) * (acc[m][4 * rg + 2] + bias1 * bflo(yv.y)), o3 = bfhi(xv.y) * (acc[m][4 * rg + 3] + bias1 * bfhi(yv.y));
            v2u ov; ov.x = pk2(o0, o1); ov.y = pk2(o2, o3); *(v2u*)(vg + (size_t)bb * n + t4) = ov; } }
    __syncthreads();
#undef HY_CONV
#undef HY_AFRAG
#undef HY_STEP_COND
#undef HY_LOAD
#undef HY_MMA
}
__device__ __forceinline__ void stage_mixer(const Ctx& F, int l) {
    unsigned* ctr = (unsigned*)(F.a->ws + WS_CTL) + CW_WORK + 64 * l;
    LAS int* itb = (LAS int*)(F.lds + LDSCTL_OFF + 512);
    const int nit = 128 + 512 + (l == 0 ? 512 : 0);
#ifdef PROBE_STATIC
    return;
#endif
    for (;;) {
        if (F.tid == 0) *itb = (int)__hip_atomic_fetch_add(ctr, 1u, __ATOMIC_RELAXED, __HIP_MEMORY_SCOPE_AGENT);
        __syncthreads();
        const int it = *itb;
        __syncthreads();
        if (it >= nit) break;
        Ctx Fi; Fi.a = kargs(); Fi.tid = opaque_v((int)threadIdx.x); Fi.lane = Fi.tid & 63; Fi.wave = __builtin_amdgcn_readfirstlane(Fi.tid >> 6); Fi.bid = opaque((int)blockIdx.x); Fi.G = opaque((int)gridDim.x);
        Fi.lds = (LAS unsigned char*)((LAS unsigned char*)0 + opaque(0)) + (F.lds - (LAS unsigned char*)0);
#ifdef PROBE_T
        if (l == 0 && F.tid == 0 && it == 5) ((unsigned long long*)(F.a->ws + WS_CTL + CW_STAMP * 4))[21] = __builtin_amdgcn_s_memrealtime();
        if (l == 0 && F.tid == 0 && it == 300) ((unsigned long long*)(F.a->ws + WS_CTL + CW_STAMP * 4))[23] = __builtin_amdgcn_s_memrealtime();
#endif
        if (it < 128) { for (int rep = 0; rep < ((DUPK == 9) ? 2 : 1); ++rep) rw_chunk_item2(Fi, opaque(l), it); }
        else if (it < 640) hyena_item(Fi, opaque(l), it - 128, 0);
        else hyena_item(Fi, opaque(l), it - 640, 1);
#ifdef PROBE_T
        if (l == 0 && F.tid == 0 && it == 5) ((unsigned long long*)(F.a->ws + WS_CTL + CW_STAMP * 4))[22] = __builtin_amdgcn_s_memrealtime();
        if (l == 0 && F.tid == 0 && it == 300) ((unsigned long long*)(F.a->ws + WS_CTL + CW_STAMP * 4))[24] = __builtin_amdgcn_s_memrealtime();
#endif
    }
}

typedef float f32x16r __attribute__((ext_vector_type(16)));
__device__ __forceinline__ void stage_norm2_router(const Ctx& F, int l, int nrows) {
    const auto& a = *F.a; unsigned char* ws = a.ws; const int lane = F.lane;
    const float* X = (const float*)(ws + WS_X); bf16* H = (bf16*)(ws + WS_H); const float* MOD = (const float*)(ws + WS_MOD);
    int* EIDX = (int*)(ws + WS_EIDX); float* GATE = (float*)(ws + WS_GATE); int* BLKCNT = (int*)(ws + WS_BLKCNT);
    LAS float* lg = (LAS float*)(F.lds + F.wave * 4352);
    LAS int* hist = (LAS int*)(F.lds + LDSCTL_OFF + 1024);
    if (F.tid < 32) hist[F.tid] = 0;
    __syncthreads();
    const int rpb = (nrows + F.G - 1) / F.G, r0 = F.bid * rpb, r1 = (r0 + rpb < nrows) ? r0 + rpb : nrows;
    const float* rw = a.in[I_RTW] + (size_t)l * 1024 * 32;
    const int i = lane & 31, kk = lane >> 5;
    const f32x4* ng = (const f32x4*)(a.in[I_N2G] + l * D) + kk;
    for (int rb = r0 + F.wave * 32; rb < r1; rb += NWAVES * 32) {
        const int nrow = (r1 - rb) < 32 ? (r1 - rb) : 32; const bool live = i < nrow;
        const int row = live ? rb + i : r1 - 1; const int w = row < T_LAT ? (row >> 12) : 8;
        const f32x4* xr = (const f32x4*)(X + (size_t)row * D) + kk;
        float ss = 0.f;
#pragma unroll 8
        for (int q = 0; q < 128; ++q) { const f32x4 v = xr[2 * q]; ss += (v[0] * v[0] + v[1] * v[1]) + (v[2] * v[2] + v[3] * v[3]); }
        ss += __builtin_bit_cast(float, __builtin_amdgcn_ds_bpermute((lane ^ 32) << 2, __builtin_bit_cast(int, ss)));
        const float rstd = 1.0f / sqrtf(ss * (1.f / D) + 1e-6f);
        const f32x4* sh = (const f32x4*)(MOD + (size_t)(l * 9 + w) * 6144 + 3072) + kk; const f32x4* sc = (const f32x4*)(MOD + (size_t)(l * 9 + w) * 6144 + 4096) + kk;
        v2u* ho = (v2u*)(H + (size_t)row * D) + kk;
        f32x16r acc;
#pragma unroll
        for (int e = 0; e < 16; ++e) acc[e] = 0.f;
        const float* wp = rw + (size_t)(4 * kk) * 32 + i;
#pragma unroll 2
        for (int q = 0; q < 128; ++q) {
            const f32x4 xv = xr[2 * q]; const f32x4 h4 = xv * rstd * ng[2 * q] * (sc[2 * q] + 1.0f) + sh[2 * q];
            const float w0 = wp[(size_t)(8 * q) * 32], w1 = wp[(size_t)(8 * q + 1) * 32], w2 = wp[(size_t)(8 * q + 2) * 32], w3 = wp[(size_t)(8 * q + 3) * 32];
            if (live) { v2u o; o.x = pk2(h4[0], h4[1]); o.y = pk2(h4[2], h4[3]); ho[2 * q] = o; }
            acc = __builtin_amdgcn_mfma_f32_32x32x2f32(h4[0], w0, acc, 0, 0, 0);
            acc = __builtin_amdgcn_mfma_f32_32x32x2f32(h4[1], w1, acc, 0, 0, 0);
            acc = __builtin_amdgcn_mfma_f32_32x32x2f32(h4[2], w2, acc, 0, 0, 0);
            acc = __builtin_amdgcn_mfma_f32_32x32x2f32(h4[3], w3, acc, 0, 0, 0);
        }
        const float rbias = a.in[I_RTB][l * 32 + i];
#pragma unroll
        for (int r = 0; r < 16; ++r) { const int ri = (r & 3) + 8 * (r >> 2) + 4 * kk; lg[ri * 33 + i] = acc[r] + rbias; }
        LDS_WAIT(); asm volatile("" ::: "memory");
        if (lane < nrow) {
            LAS float* lr = lg + lane * 33; const int orow = rb + lane;
            float tv[4]; int ti[4];
#pragma unroll
            for (int r = 0; r < 4; ++r) { float bv = -INFINITY; int bi = 0;
#pragma unroll 8
                for (int e = 0; e < 32; ++e) { const float v = lr[e]; if (v > bv) { bv = v; bi = e; } }
                tv[r] = bv; ti[r] = bi; lr[bi] = -INFINITY; }
            const float e1 = expf(tv[1] - tv[0]), e2 = expf(tv[2] - tv[0]), e3 = expf(tv[3] - tv[0]); const float inv = 1.0f / (1.0f + e1 + e2 + e3);
            *(int4*)(EIDX + orow * 4) = make_int4(ti[0], ti[1], ti[2], ti[3]); *(f32x4*)(GATE + orow * 4) = (f32x4){inv, e1 * inv, e2 * inv, e3 * inv};
#pragma unroll
            for (int r = 0; r < 4; ++r) __hip_atomic_fetch_add(&hist[ti[r]], 1, __ATOMIC_RELAXED, __HIP_MEMORY_SCOPE_WORKGROUP);
        }
        LDS_WAIT(); asm volatile("" ::: "memory");
    }
    __syncthreads();
    if (F.tid < 32) BLKCNT[F.bid * 32 + F.tid] = hist[F.tid];
    __syncthreads();
}

__device__ __forceinline__ void stage_moe_scatter(const Ctx& F, int l, int nrows) {
    const auto& a = *F.a; unsigned char* ws = a.ws; const int lane = F.lane;
    const bf16* H = (const bf16*)(ws + WS_H); bf16* XS = (bf16*)(ws + WS_XS);
    const int* EIDX = (const int*)(ws + WS_EIDX); int* POS = (int*)(ws + WS_POS); const int* BLKCNT = (const int*)(ws + WS_BLKCNT); int* META = (int*)(ws + WS_META);
    LAS int* tot = (LAS int*)F.lds; LAS int* off = tot + 32; LAS int* base = tot + 64; LAS int* posl = tot + 128; LAS int* eloc = tot + 4096;
    const int rpb = (nrows + F.G - 1) / F.G, r0 = F.bid * rpb, r1 = (r0 + rpb < nrows) ? r0 + rpb : nrows; const int na = (r1 > r0) ? (r1 - r0) * 4 : 0;
    for (int i = F.tid; i < na; i += NTHREADS) eloc[i] = EIDX[r0 * 4 + i];
    { LAS int* part = tot + 8192; const int e = F.tid & 31, pt = F.tid >> 5; int t = 0, o = 0;
      for (int b2 = pt; b2 < F.G; b2 += 16) { const int c = BLKCNT[b2 * 32 + e]; t += c; o += (b2 < F.bid) ? c : 0; }
      part[pt * 32 + e] = t; part[512 + pt * 32 + e] = o; }
    __syncthreads();
    if (F.tid < 32) { LAS int* part = tot + 8192; int t = 0, o = 0;
#pragma unroll
        for (int pt = 0; pt < 16; ++pt) { t += part[pt * 32 + F.tid]; o += part[512 + pt * 32 + F.tid]; }
        tot[F.tid] = t; off[F.tid] = o; }
    __syncthreads();
    if (F.tid == 0) { int acc = 0; for (int e = 0; e < 32; ++e) { base[e] = acc; acc += (tot[e] + 255) & ~255; } base[32] = acc; }
    __syncthreads();
    if (F.bid == 0 && F.tid < 33) META[F.tid] = base[F.tid];
    unsigned* ROWOF = (unsigned*)(ws + WS_ROWOF);
    if (F.tid < 32) { int run = base[F.tid] + off[F.tid]; for (int i = 0; i < na; ++i) { if (eloc[i] == F.tid) { POS[r0 * 4 + i] = run; ROWOF[run] = (unsigned)(r0 + (i >> 2)) * (unsigned)(D * 2); ++run; } } }
    for (int e = F.bid; e < 32; e += F.G) for (int i = base[e] + tot[e] + F.tid; i < base[e + 1]; i += NTHREADS) ROWOF[i] = 0u;
    __syncthreads();
}
__device__ __forceinline__ LAS int* load_moe_base(const Ctx& F) {
    LAS int* base = (LAS int*)(F.lds + LDSCTL_OFF + 256);
    const int* META = (const int*)(F.a->ws + WS_META);
    if (F.tid < 33) base[F.tid] = META[F.tid];
    __syncthreads();
    return base;
}

constexpr int NSTAGE_L = 13, NSTAGES = 1 + DEPTH * NSTAGE_L + 1;
__global__ void __launch_bounds__(NTHREADS, 2) mk_fwd(Args args) {
    extern __shared__ __attribute__((aligned(16))) unsigned char lds_raw[];
    Ctx F; F.a = kargs(); F.lds = (LAS unsigned char*)lds_raw; F.tid = threadIdx.x; F.lane = F.tid & 63; F.wave = __builtin_amdgcn_readfirstlane(F.tid >> 6); F.bid = blockIdx.x; F.G = gridDim.x;
    volatile LAS unsigned* MISC = (volatile LAS unsigned*)(F.lds + LDSCTL_OFF);
    for (int u = F.tid; u < (LDS_BYTES - LDSCTL_OFF) / 4; u += NTHREADS) ((LAS unsigned*)(F.lds + LDSCTL_OFF))[u] = 0u;
    __syncthreads();
#if MK_PER_STAGE
#define GRID_BAR() do { } while (0)
#else
    (void)xcd_barrier_post((unsigned*)(F.a->ws + WS_CTL) + CW_BAR, MISC + 8);
#define GRID_BAR() do { XcdBarrier b_; b_.bar = (unsigned*)(kargs()->ws + WS_CTL) + CW_BAR; b_.x = xb_xcc_id(); b_.st = (volatile LAS unsigned*)((LAS unsigned char*)lds_raw + LDSCTL_OFF + opaque(32)); xcd_barrier(b_); } while (0)
#endif
#ifndef ONLY_S
#define ONLY_S -1
#endif
#define STG_SEL(k) (ONLY_S < 0 || ONLY_S == (((k) == 0) ? 0 : ((k) == NSTAGES - 1 ? 14 : (((k) - 1) % NSTAGE_L) + 1)))
#if MK_PER_STAGE
#define IN(k) (STG_SEL(k) && kargs()->ph_lo == (k))
#else
#define IN(k) STG_SEL(k)
#endif
#if MK_PER_STAGE
#define SEAM(k) do { } while (0)
#else
#define SEAM(k) do { if ((k) + 1 < NSTAGES) GRID_BAR(); } while (0)
#endif
#define STAGE(k) if (IN(k)) { F.a = kargs(); F.tid = opaque_v((int)threadIdx.x); F.lane = F.tid & 63; F.wave = __builtin_amdgcn_readfirstlane(F.tid >> 6); F.bid = opaque((int)blockIdx.x); F.G = opaque((int)gridDim.x); F.lds = (LAS unsigned char*)lds_raw + opaque(0); unsigned char* ws = F.a->ws; const int l = opaque(lq); unsigned char* wl = ws + WS_WTS + (size_t)l * WL_STRIDE; (void)wl; (void)ws;
#define STAGE_END(k) } SEAM(k);
    int lq = 0;
    STAGE(0) p0_prologue(F); STAGE_END(0)
    for (lq = 0; lq < DEPTH; ++lq) {
        const int sb = 1 + lq * NSTAGE_L;
        const int nrl = opaque((lq == DEPTH - 1) ? T_LAT : T_ALL);
        STAGE(sb + 0) stage_norm1(F, l); STAGE_END(sb + 0)
        STAGE(sb + 1) pg8::SchedWin S; S.A = (const char*)(ws + WS_H); S.Bt = (const char*)(wl + WO_WIN); S.tstep = (size_t)256 * 1024 * 2; S.G = F.G; S.c = F.bid; S.part = (nrl != T_ALL); pg8::EpiBf16 E{(bf16*)(ws + WS_Z), IN_COLS, nullptr, 0};
            pg8::gemm_phase(F.lds, F.tid, 1024, S, E); STAGE_END(sb + 1)
        STAGE(sb + 2) for (int rep = 0; rep < REPN(1); ++rep) stage_rw_prep1(F, l); for (int rep = 0; rep < REPN(2); ++rep) stage_s5_scan<0>(F, l); for (int rep = 0; rep < REPN(3); ++rep) stage_hy_pre(F, l, nrl); STAGE_END(sb + 2)
        STAGE(sb + 3) { pg8::SchedStatic S; S.init(ws + WS_ARW, wl + WO_RWCAT, T_ALL, 2560, 256, F.G, F.bid); pg8::EpiBf16 E{(bf16*)(ws + WS_P), 2560, nullptr, 0}; PT(4); pg8::gemm_phase(F.lds, F.tid, 256, S, E); PT(5); }
            F.tid = opaque_v((int)threadIdx.x); F.lane = F.tid & 63;
            for (int rep = 0; rep < REPN(4); ++rep) stage_s5_scan<1>(F, l); STAGE_END(sb + 3)
        STAGE(sb + 4) for (int rep = 0; rep < REPN(5); ++rep) stage_rw_prep2(F, l); for (int rep = 0; rep < REPN(6); ++rep) stage_s5_prep(F, l, nrl); STAGE_END(sb + 4)
        STAGE(sb + 5) PT(10); stage_mixer(F, l); PT(11); STAGE_END(sb + 5) STAGE(sb + 5) PT(12); }
        STAGE(sb + 6) { pg8::SchedStatic S; S.init(ws + WS_AS5, wl + WO_GLU, nrl, 1024, 512, F.G, F.bid); pg8::EpiGlu<0> E{(bf16*)(ws + WS_YS5), 512, F.a->in[I_S5GLUB] + l * 1024, 0, 512}; PT(13); pg8::gemm_phase(F.lds, F.tid, 512, S, E); PT(14); }
            for (int rep = 0; rep < REPN(7); ++rep) stage_rw_readout(F, l); for (int rep = 0; rep < REPN(8); ++rep) stage_hy_post(F, l, nrl); STAGE_END(sb + 6)
        STAGE(sb + 7) pg8::SchedMerge S; S.A0 = (const char*)(ws + WS_YHY); S.A1 = (const char*)(ws + WS_YRW); S.A2 = (const char*)(ws + WS_YS5); S.Bt = (const char*)(wl + WO_WBR); S.tstep = (size_t)256 * 512 * 2; S.bstride = (size_t)1024 * 512 * 2;
            S.nM = nrl / 256; S.nN = 4; S.G = F.G; S.c = F.bid;
            pg8::EpiMerge E{(bf16*)(ws + WS_MTMP), (bf16*)(ws + WS_H), (const bf16*)(ws + WS_Z) + GATE_OFF}; pg8::gemm_phase(F.lds, F.tid, 512, S, E); STAGE_END(sb + 7)
        STAGE(sb + 8) pg8::SchedStatic S; S.init(ws + WS_H, wl + WO_WOUT, nrl, 1024, 1024, F.G, F.bid); pg8::EpiResid E{(float*)(ws + WS_X), (const float*)(ws + WS_MOD) + (size_t)l * 9 * 6144 + 2048};
            pg8::gemm_phase(F.lds, F.tid, 1024, S, E); STAGE_END(sb + 8)
        STAGE(sb + 9) PT(17); stage_norm2_router(F, l, nrl); PT(18); STAGE_END(sb + 9)
        STAGE(sb + 10) PT(19); stage_moe_scatter(F, l, nrl); PT(20); STAGE_END(sb + 10)
        STAGE(sb + 11) LAS int* base = load_moe_base(F);
            pg8::SchedMoeG S; S.A = (const char*)(ws + WS_H); S.rowof = (const unsigned*)(ws + WS_ROWOF); S.Bt = (const char*)(wl + WO_W1); S.tstep = (size_t)256 * 1024 * 2; S.estride = (size_t)2048 * 1024 * 2; S.NPN = 8; S.G = F.G; S.c = F.bid; S.base = base;
            pg8::EpiGlu<1> E{(bf16*)(ws + WS_ACT), 1024, F.a->in[I_B1] + (size_t)l * 32 * 2048, 2048, 1024}; pg8::gemm_phase(F.lds, F.tid, 1024, S, E); STAGE_END(sb + 11)
        STAGE(sb + 12) LAS int* base = load_moe_base(F);
            pg8::SchedMoe S; S.A = (const char*)(ws + WS_ACT); S.Bt = (const char*)(wl + WO_W2); S.tstep = (size_t)256 * 1024 * 2; S.estride = (size_t)1024 * 1024 * 2; S.NPN = 4; S.G = F.G; S.c = F.bid; S.base = base;
            pg8::EpiBf16 E{(bf16*)(ws + WS_XS), 1024, F.a->in[I_B2] + (size_t)l * 32 * 1024, 1024}; pg8::gemm_phase(F.lds, F.tid, 1024, S, E); STAGE_END(sb + 12)
    }
    lq = DEPTH;
    STAGE(NSTAGES - 1)
#ifndef PROBE_T
        stage_norm1(F, l);
#endif
#ifdef PROBE_T
        { const unsigned long long* st = (const unsigned long long*)(F.a->ws + WS_CTL + CW_STAMP * 4); const float cval = (float)(long long)(st[PROBE_B] - st[PROBE_A]) * (1.0f / (100.0f * PROBE_DIV));
          __syncthreads(); for (size_t i = (size_t)F.bid * NTHREADS + F.tid; i < (size_t)T_LAT * D; i += (size_t)F.G * NTHREADS) F.a->out[i] = cval; }
#endif
    }
#undef IN
#undef SEAM
}

extern "C" void kernel_launch(void* const* d_in, const int* in_sizes, int n_in, void* d_out, int out_size, void* d_ws, size_t ws_size, hipStream_t stream) {
    static int grid = 0;
    if (grid == 0) {
        if (n_in != 51 || out_size != T_LAT * D || ws_size < WS_END) { fprintf(stderr, "kernel_launch: unexpected shapes (n_in %d out %d ws %zu, need %zu)\n", n_in, out_size, ws_size, (size_t)WS_END); grid = -1; return; }
        int dev = 0, cus = 0, per_cu = 0;
        if (hipGetDevice(&dev) != hipSuccess || hipDeviceGetAttribute(&cus, hipDeviceAttributeMultiprocessorCount, dev) != hipSuccess) { grid = -1; return; }
        if (hipFuncSetAttribute((const void*)mk_fwd, hipFuncAttributeMaxDynamicSharedMemorySize, LDS_BYTES) != hipSuccess) { fprintf(stderr, "kernel_launch: hipFuncSetAttribute failed\n"); grid = -1; return; }
        if (hipOccupancyMaxActiveBlocksPerMultiprocessor(&per_cu, (const void*)mk_fwd, NTHREADS, LDS_BYTES) != hipSuccess || per_cu < 1) fprintf(stderr, "kernel_launch: occupancy query says %d\n", per_cu);
        (void)hipGetLastError();
        grid = cus;
    }
    if (grid < 0) return;
    if (hipMemsetAsync((char*)d_ws + WS_CTL, 0, CTL_ZERO_BYTES, stream) != hipSuccess) return;
    Args a{};
    for (int i = 0; i < 51; ++i) a.in[i] = (const float*)d_in[i];
    a.out = (float*)d_out; a.ws = (unsigned char*)d_ws;
#if MK_PER_STAGE
    for (int s = 0; s < NSTAGES; ++s) { a.ph_lo = s; a.ph_hi = s + 1; int reps = 1;
#ifdef PROBE_SET
        { const int ls = (s == 0 || s == NSTAGES - 1) ? -1 : (s - 1) % NSTAGE_L;
          if (PROBE_SET >= 1 && PROBE_SET <= 13 && ls == PROBE_SET - 1 && ls != 5 && ls != 8 && !(ls == 0 && s > 1)) reps = 3;
          if (PROBE_SET == 14 && s == 0) reps = 3; }
#endif
        for (int r = 0; r < reps; ++r) hipLaunchKernelGGL(mk_fwd, dim3(grid), dim3(NTHREADS), LDS_BYTES, stream, a); }
#else
    a.ph_lo = 0; a.ph_hi = NSTAGES; hipLaunchKernelGGL(mk_fwd, dim3(grid), dim3(NTHREADS), LDS_BYTES, stream, a);
#endif
}
```

```cpp
#include <hip/hip_runtime.h>
#include <cstdio>
#include <cstdint>

#ifndef DUPK
#define DUPK 0
#endif
#define REPN(k) ((DUPK == (k)) ? 3 : 1)
#ifndef REP_GEMM
#define REP_GEMM 1
#endif
#ifndef REP_LIGHT
#define REP_LIGHT 1
#endif
#ifndef REP_PRO
#define REP_PRO 1
#endif
#ifndef MK_PER_STAGE
#define MK_PER_STAGE 0
#endif

#define GAS __attribute__((address_space(1)))
#define LAS __attribute__((address_space(3)))
typedef unsigned short bf16;
typedef unsigned v4u __attribute__((ext_vector_type(4)));
typedef unsigned v2u __attribute__((ext_vector_type(2)));
typedef float f32x4 __attribute__((ext_vector_type(4)));
typedef float f32x2 __attribute__((ext_vector_type(2)));
typedef short bf16x8 __attribute__((ext_vector_type(8)));

constexpr int D = 1024, BATCH = 8, SEQ = 4096, CTXL = 256, DEPTH = 2;
constexpr int T_LAT = BATCH * SEQ, T_CTX = BATCH * CTXL, T_ALL = T_LAT + T_CTX;
constexpr int IN_COLS = 6912, HY_OFF = 0, RW_OFF = 1536, S5_OFF = 3328, GATE_OFF = 3840;
constexpr int NE = 32, TOPK = 4;
constexpr int MAXSLOT = 147456;
constexpr int NWAVES = 8, NTHREADS = 512;
constexpr int HY_MARG = 128, HY_ROWB = 8720, HY_RLEN = 8272, HY_RLENC = 592;
constexpr int HY_R1_OFF = 8 * HY_ROWB, HY_R2_OFF = HY_R1_OFF + HY_RLEN * 2;

constexpr size_t MiB = 1ull << 20;
constexpr size_t WS_CTL = 0, CTL_ZERO_BYTES = 1 * MiB;
constexpr size_t WS_MOD = 1 * MiB;
constexpr size_t WS_BLKCNT = 2 * MiB;
constexpr size_t WS_META = 2 * MiB + 512 * 1024;
constexpr size_t WS_ROWOF = 7 * MiB;
constexpr size_t WS_EIDX = 3 * MiB, WS_GATE = 4 * MiB, WS_POS = 5 * MiB;
constexpr size_t WS_WTS = 8 * MiB, WL_STRIDE = 214 * MiB;
constexpr size_t WO_WIN = 0, WO_RWCAT = 14 * MiB, WO_GLU = 16 * MiB, WO_WBR = 17 * MiB, WO_WOUT = 20 * MiB, WO_W1 = 22 * MiB, WO_W2 = 150 * MiB;
constexpr size_t WS_GF = 436 * MiB, GF_STRIDE = 20 * MiB, GF_CTX = 17 * MiB;
constexpr size_t WS_X = 504 * MiB;
constexpr size_t WS_H = 640 * MiB;
constexpr size_t WS_BIG = 708 * MiB;
constexpr size_t WS_Z = WS_BIG;
constexpr size_t WS_SCN = 1167 * MiB;
constexpr size_t WS_MTMP = WS_SCN;
constexpr size_t WS_P = 1473 * MiB;
constexpr size_t WS_ARW = 1643 * MiB;
constexpr size_t WS_YP = 1660 * MiB;
constexpr size_t WS_YDIR = WS_YP;
constexpr size_t WS_UT = 1796 * MiB;
constexpr size_t WS_AS5 = 2000 * MiB;
constexpr size_t WS_YHY = 1898 * MiB, WS_YRW = 1932 * MiB, WS_YS5 = 1966 * MiB;
constexpr size_t WS_XS = WS_BIG;
constexpr size_t WS_ACT = WS_BIG + 288 * MiB;
constexpr size_t WS_END = 2034 * MiB;
constexpr int CW_BAR = 4096;

constexpr int RING_BYTES = 131072;
constexpr int LDSCTL_OFF = RING_BYTES;
constexpr int LDS_BYTES = 163840;

typedef __bf16 bf16x2_t __attribute__((ext_vector_type(2)));
__device__ __forceinline__ unsigned pk2(float lo, float hi) { const bf16x2_t v = __builtin_convertvector((f32x2){lo, hi}, bf16x2_t); return __builtin_bit_cast(unsigned, v); }
__device__ __forceinline__ unsigned f2bf(float f) { return pk2(f, 0.f) & 0xffffu; }
__device__ __forceinline__ float bf2f(bf16 b) { return __builtin_bit_cast(float, ((unsigned)b) << 16); }
__device__ __forceinline__ float bflo(unsigned w) { return __builtin_bit_cast(float, w << 16); }
__device__ __forceinline__ float bfhi(unsigned w) { return __builtin_bit_cast(float, w & 0xffff0000u); }
__device__ __forceinline__ float sigm(float x) { return 1.f / (1.f + __expf(-x)); }
__device__ __forceinline__ float tanh_fast(float x) { const float e = __expf(2.f * x); return 1.f - 2.f / (e + 1.f); }
#define LDS_WAIT() asm volatile("s_waitcnt lgkmcnt(0)" ::: "memory")
__device__ __forceinline__ float dpp_f(float x, const int ctrl_sel) {
    const int v = __builtin_bit_cast(int, x);
    int r;
    if (ctrl_sel == 0) r = __builtin_amdgcn_update_dpp(0, v, 0xB1, 0xF, 0xF, true);
    else if (ctrl_sel == 1) r = __builtin_amdgcn_update_dpp(0, v, 0x4E, 0xF, 0xF, true);
    else r = __builtin_amdgcn_update_dpp(0, v, 0x141, 0xF, 0xF, true);
    return __builtin_bit_cast(float, r);
}
__device__ __forceinline__ float red32(float x) {
    x += dpp_f(x, 0); x += dpp_f(x, 1); x += dpp_f(x, 2);
    x += __builtin_bit_cast(float, __builtin_amdgcn_update_dpp(0, __builtin_bit_cast(int, x), 0x128, 0xF, 0xF, true));
    x += __builtin_bit_cast(float, __builtin_amdgcn_ds_swizzle(__builtin_bit_cast(int, x), 0x401F));
    return x;
}
__device__ __forceinline__ float wave_sum(float v) {
    v = red32(v);
    return __builtin_bit_cast(float, __builtin_amdgcn_readlane(__builtin_bit_cast(int, v), 0)) + __builtin_bit_cast(float, __builtin_amdgcn_readlane(__builtin_bit_cast(int, v), 32));
}
__device__ __forceinline__ int xch32(int v, const int step) {
    if (step == 0) return __builtin_amdgcn_update_dpp(0, v, 0xB1, 0xF, 0xF, true);
    if (step == 1) return __builtin_amdgcn_update_dpp(0, v, 0x4E, 0xF, 0xF, true);
    if (step == 2) return __builtin_amdgcn_update_dpp(0, v, 0x141, 0xF, 0xF, true);
    if (step == 3) return __builtin_amdgcn_update_dpp(0, v, 0x128, 0xF, 0xF, true);
    return __builtin_amdgcn_ds_swizzle(v, 0x401F);
}
__device__ __forceinline__ float red8(float x) { x += dpp_f(x, 0); x += dpp_f(x, 1); x += dpp_f(x, 2); return x; }

#define XB_TMO      128
#define XB_XCNT(j)  (256  + 64 * (j))
#define XB_XSUB(j)  (1280 + 64 * (j))
#define XB_XGEN(j)  (2304 + 64 * (j))
#define XB_TOP      3328
#define XB_TOPGEN   3392
#define XCD_BAR_WORDS 3456
#define XB_SPIN_CAP (1u << 22)
__device__ __forceinline__ unsigned xb_ld(unsigned* p)              { return __hip_atomic_load(p, __ATOMIC_RELAXED, __HIP_MEMORY_SCOPE_AGENT); }
__device__ __forceinline__ unsigned xb_add(unsigned* p, unsigned v) { return __hip_atomic_fetch_add(p, v, __ATOMIC_RELAXED, __HIP_MEMORY_SCOPE_AGENT); }
__device__ __forceinline__ unsigned xb_xcc_id() { return (unsigned)__builtin_amdgcn_s_getreg((3 << 11) | 20) & 0xFu; }
#define XB_SPIN(cond, bar) do { unsigned _sp = 0; while (cond) { __builtin_amdgcn_s_sleep(1); \
    if ((++_sp & 255u) == 0u) { if (xb_ld(&(bar)[XB_TMO])) break; if (_sp > XB_SPIN_CAP) { atomicAdd(&(bar)[XB_TMO], 1u); break; } } } } while (0)
struct XcdBarrier { unsigned* bar; unsigned x; volatile LAS unsigned* st; };
__device__ __forceinline__ XcdBarrier xcd_barrier_post(unsigned* bar, volatile LAS unsigned* st) {
    XcdBarrier b; b.bar = bar; b.x = xb_xcc_id(); b.st = st;
    if (threadIdx.x == 0) (void)xb_add(&bar[XB_XCNT(b.x)], 1u);
    return b;
}
__device__ __forceinline__ void xcd_barrier_complete(unsigned* bar, unsigned x, unsigned& nloc, unsigned& nx) {
    const unsigned G = gridDim.x * gridDim.y * gridDim.z;
    unsigned sum, cnt, mine, sp = 0u;
    for (;;) {
        sum = 0u; cnt = 0u; mine = 0u;
#pragma unroll
        for (unsigned j = 0; j < 16; ++j) { const unsigned c = xb_ld(&bar[XB_XCNT(j)]); sum += c; cnt += (c > 0u) ? 1u : 0u; mine = (j == x) ? c : mine; }
        if (sum == G) break;
        __builtin_amdgcn_s_sleep(1);
        if ((++sp & 255u) == 0u) { if (xb_ld(&bar[XB_TMO])) break; if (sp > XB_SPIN_CAP) { atomicAdd(&bar[XB_TMO], 1u); break; } }
    }
    nloc = mine > 0u ? mine : 1u; nx = cnt > 0u ? cnt : 1u;
}
__device__ __forceinline__ void xcd_barrier(const XcdBarrier& b) {
    asm volatile("s_waitcnt vmcnt(0)" ::: "memory");
    __syncthreads();
    if (threadIdx.x == 0) {
        unsigned* bar = b.bar;
        __builtin_amdgcn_s_waitcnt(0);
        unsigned nloc = b.st[0], nx = b.st[1];
        if (nloc == 0u) { xcd_barrier_complete(bar, b.x, nloc, nx); b.st[0] = nloc; b.st[1] = nx; }
        const unsigned old = xb_add(&bar[XB_XSUB(b.x)], 1u);
        const unsigned gen = old / nloc;
        if (old + 1u == (gen + 1u) * nloc) {
            __builtin_amdgcn_fence(__ATOMIC_RELEASE, "agent");
            asm volatile("s_waitcnt vmcnt(0)" ::: "memory");
            const unsigned og = xb_add(&bar[XB_TOP], 1u);
            const unsigned tg = og / nx;
            if (og + 1u == (tg + 1u) * nx) xb_add(&bar[XB_TOPGEN], 1u);
            else XB_SPIN(xb_ld(&bar[XB_TOPGEN]) == tg, bar);
            __builtin_amdgcn_fence(__ATOMIC_ACQUIRE, "agent");
            xb_add(&bar[XB_XGEN(b.x)], 1u);
            asm volatile("s_waitcnt vmcnt(0)" ::: "memory");
        } else {
            XB_SPIN(xb_ld(&bar[XB_XGEN(b.x)]) == gen, bar);
            __builtin_amdgcn_fence(__ATOMIC_ACQUIRE, "agent");
            asm volatile("s_waitcnt vmcnt(0)" ::: "memory");
        }
    }
    __syncthreads();
}

namespace pg8 {
constexpr int BM = 256, BK = 64, HALF = 128, HTB = HALF * BK * 2, STAGE_BYTES = 8 * HTB, NXCD = 8, WGM = 8, ROWTAB_OFF = 131072 + 4096;
__host__ __device__ __forceinline__ int lds_byte(int r, int c) { const int st = (r >> 4) * 2 + (c >> 5), rr = r & 15, cc = c & 31, ob = rr * 64 + cc * 2; return st * 1024 + (ob ^ (((ob >> 9) & 1) << 5)); }
__host__ __device__ __forceinline__ void stage_rc(int b, int& R, int& C) { const int st = b / 1024, sb = b % 1024, swz = sb ^ (((sb >> 9) & 1) << 5); R = (st >> 1) * 16 + swz / 64; C = (st & 1) * 32 + (swz % 64) / 2; }
__host__ __device__ __forceinline__ int perm32(int rho) { const int n = rho >> 4, i = rho & 15; return 8 * (i >> 2) + 4 * n + (i & 3); }
struct Unit { int pm, pn, e; };
__device__ __forceinline__ unsigned cvt_pk_bf16(float lo, float hi) { return pk2(lo, hi); }

__device__ __forceinline__ void tile_of(int L, int nM, int nN, int& pm, int& pn) {
    const int nwg = nM * nN; int wgid = L;
    { const int q = nwg / NXCD, r = nwg % NXCD, xcd = wgid % NXCD, off = wgid / NXCD; wgid = (xcd < r ? xcd * (q + 1) : r * (q + 1) + (xcd - r) * q) + off; }
    const int nig = WGM * nN, gid = wgid / nig, fm = gid * WGM, gsz = (nM - fm) < WGM ? (nM - fm) : WGM;
    pm = fm + ((wgid % nig) % gsz); pn = (wgid % nig) / gsz;
}
struct SchedStatic {
    static constexpr bool GATHER = false;
    const char* A; const char* Bt; size_t tstep; int nM, nN, G, c;
    __device__ __forceinline__ void init(const void* A_, const void* Bt_, int M, int N, int K, int G_, int c_) { A = (const char*)A_; Bt = (const char*)Bt_; tstep = (size_t)BM * K * 2; nM = M / BM; nN = N / BM; G = G_; c = c_; }
    __device__ __forceinline__ bool next(int i, Unit& u) const { const long L = (long)i * G + c; if (L >= (long)nM * nN) return false; tile_of((int)L, nM, nN, u.pm, u.pn); u.e = 0; return true; }
    __device__ __forceinline__ const char* aptr(const Unit& u) const { return A + (size_t)u.pm * tstep; }
    __device__ __forceinline__ const char* bptr(const Unit& u) const { return Bt + (size_t)u.pn * tstep; }
};
struct SchedWin {
    static constexpr bool GATHER = false;
    const char* A; const char* Bt; size_t tstep; int G, c, part;
    __device__ __forceinline__ bool next(int i, Unit& u) const {
        const int L = i * G + c, nmf = part ? 128 : 136, nfull = nmf * 27; u.e = 0;
        if (L < nfull) { tile_of(L, nmf, 27, u.pm, u.pn); return true; }
        const int L2 = L - nfull; if (!part || L2 >= 8 * 9) return false;
        u.pm = 128 + L2 / 9; u.pn = 6 + L2 % 9; return true; }
    __device__ __forceinline__ const char* aptr(const Unit& u) const { return A + (size_t)u.pm * tstep; }
    __device__ __forceinline__ const char* bptr(const Unit& u) const { return Bt + (size_t)u.pn * tstep; }
};
struct SchedMerge {
    static constexpr bool GATHER = false;
    const char* A0; const char* A1; const char* A2; const char* Bt; size_t tstep, bstride; int nM, nN, G, c;
    __device__ __forceinline__ bool next(int i, Unit& u) const { const int j = i / 3, br = i - 3 * j; const long L = (long)j * G + c; if (L >= (long)nM * nN) return false; tile_of((int)L, nM, nN, u.pm, u.pn); u.e = br; return true; }
    __device__ __forceinline__ const char* aptr(const Unit& u) const { return (u.e == 0 ? A0 : (u.e == 1 ? A1 : A2)) + (size_t)u.pm * tstep; }
    __device__ __forceinline__ const char* bptr(const Unit& u) const { return Bt + (size_t)u.e * bstride + (size_t)u.pn * tstep; }
};
struct SchedMoe {
    static constexpr bool GATHER = false;
    const char* A; const char* Bt; size_t tstep, estride; int NPN, G, c; const LAS int* base;
    __device__ __forceinline__ bool next(int i, Unit& u) const {
        const int ntiles = base[32] >> 8; const int per = G >> 3;
        const long L = (long)i * G + (((G & 7) == 0) ? (c & 7) * per + (c >> 3) : c);
        if (L >= (long)ntiles * NPN) return false;
        u.pm = (int)(L / NPN); u.pn = (int)(L % NPN); const int r0 = u.pm << 8; int e = 0;
#pragma unroll 1
        for (int k = 1; k < 32; ++k) e += (r0 >= base[k]) ? 1 : 0;
        u.e = e; return true;
    }
    __device__ __forceinline__ const char* aptr(const Unit& u) const { return A + (size_t)u.pm * tstep; }
    __device__ __forceinline__ const char* bptr(const Unit& u) const { return Bt + (size_t)u.e * estride + (size_t)u.pn * tstep; }
};
struct SchedMoeG : SchedMoe {
    static constexpr bool GATHER = true;
    const unsigned* rowof;
    __device__ __forceinline__ const char* aptr(const Unit&) const { return A; }
};

template <class Epi, class Sched>
__device__ __forceinline__ void gemm_phase(LAS unsigned char* lds, const int tid, const int K, const Sched& S, const Epi& E) {
    const int wid = __builtin_amdgcn_readfirstlane(tid >> 6), lane = tid & 63, wr = wid >> 2, wc = wid & 3, fr = lane & 15, fq = lane >> 4;
    const int nt = K / BK;
    unsigned voffA[2], voffB[2];
#pragma unroll
    for (int i = 0; i < 2; ++i) { int R, C; stage_rc(tid * 16 + i * 8192, R, C); const int Rb = Epi::PERM ? ((R & ~31) + perm32(R & 31)) : R;
        voffA[i] = (unsigned)(R * K + C) * 2u; voffB[i] = (unsigned)(Rb * K + C) * 2u; }
    const size_t kstep = (size_t)(BK * 2);
    const size_t hstep = (size_t)HALF * K * 2;
    const unsigned ldsw = (unsigned)wid * 1024u;
    const int aoff = lds_byte(wr * 64 + fr, fq * 8), boff = lds_byte(wc * 32 + fr, fq * 8);
#define PG8_SA(b, h) (((b) * 2 + (h)) * HTB)
#define PG8_SB(b, h) ((4 + (b) * 2 + (h)) * HTB)
#define PG8_STAGE(bufoff, gbase, voff) do { _Pragma("unroll") for (int _i = 0; _i < 2; ++_i) \
        __builtin_amdgcn_global_load_lds((const unsigned*)((const char*)(gbase) + (voff)[_i]), (LAS unsigned*)(lds + (bufoff) + ldsw + _i * 8192), 16, 0, 0); } while (0)
#define PG8_STAGEA(bufoff, kp, h) do { if constexpr (Sched::GATHER) { _Pragma("unroll") for (int _i = 0; _i < 2; ++_i) \
        __builtin_amdgcn_global_load_lds((const unsigned*)((const char*)(kp) + g[2 * (h) + _i]), (LAS unsigned*)(lds + (bufoff) + ldsw + _i * 8192), 16, 0, 0); } \
        else { PG8_STAGE(bufoff, (kp) + (h) * hstep, voffA); } } while (0)
#define PG8_GLOAD(buf) do { const LAS unsigned* rt_ = (const LAS unsigned*)(lds + ROWTAB_OFF + (buf) * 1024) + gR0; _Pragma("unroll") for (int _j = 0; _j < 4; ++_j) g[_j] = rt_[64 * _j] + gCb; } while (0)
#define PG8_GDMA(pm_, buf) do { if (wid == 0) __builtin_amdgcn_global_load_lds((const unsigned*)(S.rowof + (size_t)(pm_) * 256 + lane * 4), (LAS unsigned*)(lds + ROWTAB_OFF + (buf) * 1024), 16, 0, 0); } while (0)
#define PG8_LDA(dst, b, h) do { _Pragma("unroll") for (int m = 0; m < 4; ++m) _Pragma("unroll") for (int k = 0; k < 2; ++k) dst[m][k] = *(const LAS bf16x8*)(lds + PG8_SA(b, h) + aoff + m * 2048 + k * 1024); } while (0)
#define PG8_LDB(dst, b, h) do { _Pragma("unroll") for (int n = 0; n < 2; ++n) _Pragma("unroll") for (int k = 0; k < 2; ++k) dst[n][k] = *(const LAS bf16x8*)(lds + PG8_SB(b, h) + boff + n * 2048 + k * 1024); } while (0)
#define PG8_MMA(ai, bj, At, Bt) do { __builtin_amdgcn_s_setprio(1); _Pragma("unroll") for (int m = 0; m < 4; ++m) _Pragma("unroll") for (int n = 0; n < 2; ++n) _Pragma("unroll") for (int k = 0; k < 2; ++k) \
        acc[ai][bj][m][n] = __builtin_amdgcn_mfma_f32_16x16x32_bf16(Bt[n][k], At[m][k], acc[ai][bj][m][n], 0, 0, 0); __builtin_amdgcn_s_setprio(0); } while (0)
#define PG8_WAIT_V(n) asm volatile("s_waitcnt vmcnt(" #n ")" ::: "memory")
#define PG8_WAIT_L(n) asm volatile("s_waitcnt lgkmcnt(" #n ")" ::: "memory")
#define PG8_BAR __builtin_amdgcn_s_barrier()
#define PG8_SCHED __builtin_amdgcn_sched_barrier(0)
    Unit cur, nxt; int ui = 0;
    if (!S.next(0, cur)) return;
    f32x4 acc[2][2][4][2];
#pragma unroll
    for (int a = 0; a < 2; ++a)
#pragma unroll
        for (int b = 0; b < 2; ++b)
#pragma unroll
            for (int m = 0; m < 4; ++m)
#pragma unroll
                for (int n = 0; n < 2; ++n) acc[a][b][m][n] = (f32x4){0.f, 0.f, 0.f, 0.f};
    bf16x8 At[4][2], B0[2][2], B1[2][2];
    const char* cA = S.aptr(cur); const char* cB = S.bptr(cur);
    unsigned g[4] = {0u, 0u, 0u, 0u}; int gR0 = 0; unsigned gCb = 0u;
    if constexpr (Sched::GATHER) { int R, C; stage_rc(tid * 16, R, C); gR0 = R; gCb = (unsigned)C * 2u;
        PG8_GDMA(cur.pm, 0); PG8_WAIT_V(0); PG8_BAR; PG8_GLOAD(0); }
    PG8_STAGE(PG8_SB(0, 0), cB, voffB); PG8_STAGE(PG8_SB(0, 1), cB + hstep, voffB); PG8_STAGEA(PG8_SA(0, 0), cA, 0); PG8_STAGEA(PG8_SA(0, 1), cA, 1);
    if (wr == 1) PG8_BAR;
    PG8_WAIT_V(2); PG8_BAR;
    PG8_STAGE(PG8_SB(1, 0), cB + kstep, voffB); PG8_STAGEA(PG8_SA(1, 0), cA + kstep, 0); PG8_STAGE(PG8_SB(1, 1), cB + hstep + kstep, voffB);
    PG8_WAIT_V(6); PG8_BAR;
    for (;;) {
        const bool has_next = S.next(ui + 1, nxt);
        const char* nA = has_next ? S.aptr(nxt) : cA; const char* nB = has_next ? S.bptr(nxt) : cB;
        if constexpr (Sched::GATHER) { if (has_next) PG8_GDMA(nxt.pm, (ui + 1) & 1); }
        for (int t = 0; t < nt; t += 2) {
            const bool last = (t == nt - 2);
            const char* a1 = cA + (size_t)(t + 1) * kstep;
            const char* a2 = last ? nA : cA + (size_t)(t + 2) * kstep; const char* b2 = last ? nB : cB + (size_t)(t + 2) * kstep;
            const char* a3 = a2 + kstep; const char* b3 = b2 + kstep;
            PG8_LDB(B0, 0, 0); PG8_LDB(B1, 0, 1); PG8_SCHED; PG8_LDA(At, 0, 0); PG8_STAGEA(PG8_SA(1, 1), a1, 1);
            PG8_WAIT_V(8); PG8_WAIT_L(0); PG8_BAR; PG8_MMA(0, 0, At, B0); PG8_MMA(0, 1, At, B1); PG8_BAR; PG8_SCHED;
            if constexpr (Sched::GATHER) { if (last && has_next) PG8_GLOAD((ui + 1) & 1); PG8_SCHED; }
            PG8_LDA(At, 0, 1); PG8_STAGE(PG8_SB(0, 0), b2, voffB); PG8_STAGE(PG8_SB(0, 1), b2 + hstep, voffB); PG8_STAGEA(PG8_SA(0, 0), a2, 0);
            PG8_WAIT_V(8); PG8_WAIT_L(0); PG8_BAR; PG8_MMA(1, 0, At, B0); PG8_MMA(1, 1, At, B1); PG8_BAR; PG8_SCHED;
            PG8_LDB(B0, 1, 0); PG8_LDB(B1, 1, 1); PG8_SCHED; PG8_LDA(At, 1, 0); PG8_STAGEA(PG8_SA(0, 1), a2, 1);
            PG8_WAIT_V(8); PG8_WAIT_L(0); PG8_BAR; PG8_MMA(0, 0, At, B0); PG8_MMA(0, 1, At, B1); PG8_BAR; PG8_SCHED;
            PG8_LDA(At, 1, 1); PG8_STAGE(PG8_SB(1, 0), b3, voffB); PG8_STAGE(PG8_SB(1, 1), b3 + hstep, voffB); PG8_STAGEA(PG8_SA(1, 0), a3, 0);
            PG8_WAIT_V(8); PG8_WAIT_L(0); PG8_BAR; PG8_MMA(1, 0, At, B0); PG8_MMA(1, 1, At, B1); PG8_BAR; PG8_SCHED;
        }
        if (wr == 0) PG8_BAR;
        { int t2_ = (int)threadIdx.x; asm volatile("" : "+v"(t2_)); E(acc, cur, wr, wc, t2_ & 15, (t2_ >> 4) & 3); }
        if (!has_next) break;
#pragma unroll
        for (int a = 0; a < 2; ++a)
#pragma unroll
            for (int b = 0; b < 2; ++b)
#pragma unroll
                for (int m = 0; m < 4; ++m)
#pragma unroll
                    for (int n = 0; n < 2; ++n) acc[a][b][m][n] = (f32x4){0.f, 0.f, 0.f, 0.f};
        cur = nxt; cA = nA; cB = nB; ++ui;
        if (wr == 1) PG8_BAR;
    }
    PG8_WAIT_V(0);
    PG8_BAR;
#undef PG8_SA
#undef PG8_SB
#undef PG8_STAGE
#undef PG8_STAGEA
#undef PG8_GLOAD
#undef PG8_GDMA
#undef PG8_LDA
#undef PG8_LDB
#undef PG8_MMA
#undef PG8_WAIT_V
#undef PG8_WAIT_L
#undef PG8_BAR
#undef PG8_SCHED
}

struct EpiBf16 {
    static constexpr bool PERM = true;
    bf16* O; int ldc; const float* bias; int bias_stride;
    __device__ __forceinline__ void operator()(const f32x4 (&acc)[2][2][4][2], const Unit& u, int wr, int wc, int fr, int fq) const {
        const int row0 = u.pm * BM + wr * 64 + fr, col0 = u.pn * BM + wc * 32 + 8 * fq;
        f32x4 bv[2][2];
#pragma unroll
        for (int bj = 0; bj < 2; ++bj)
#pragma unroll
            for (int n = 0; n < 2; ++n) bv[bj][n] = bias ? *(const f32x4*)(bias + (size_t)u.e * bias_stride + col0 + bj * HALF + 4 * n) : (f32x4){0.f, 0.f, 0.f, 0.f};
#pragma unroll
        for (int ai = 0; ai < 2; ++ai)
#pragma unroll
            for (int m = 0; m < 4; ++m) { bf16* rowp = O + (size_t)(row0 + ai * HALF + m * 16) * ldc + col0;
#pragma unroll
                for (int bj = 0; bj < 2; ++bj) { const f32x4 v0 = acc[ai][bj][m][0] + bv[bj][0], v1 = acc[ai][bj][m][1] + bv[bj][1];
                    v4u w; w.x = cvt_pk_bf16(v0[0], v0[1]); w.y = cvt_pk_bf16(v0[2], v0[3]); w.z = cvt_pk_bf16(v1[0], v1[1]); w.w = cvt_pk_bf16(v1[2], v1[3]);
                    *(v4u*)(rowp + bj * HALF) = w; } }
    }
};
template <int MODE> struct EpiGlu {
    static constexpr bool PERM = true;
    bf16* O; int ldc; const float* bias; int bias_stride, hs;
    __device__ __forceinline__ void operator()(const f32x4 (&acc)[2][2][4][2], const Unit& u, int wr, int wc, int fr, int fq) const {
        const int row0 = u.pm * BM + wr * 64 + fr, col0 = u.pn * HALF + wc * 32 + 8 * fq;
        const float* bp = bias + (size_t)u.e * bias_stride + col0;
        f32x4 ba[2], bb[2];
#pragma unroll
        for (int n = 0; n < 2; ++n) { ba[n] = *(const f32x4*)(bp + 4 * n); bb[n] = *(const f32x4*)(bp + hs + 4 * n); }
#pragma unroll
        for (int ai = 0; ai < 2; ++ai)
#pragma unroll
            for (int m = 0; m < 4; ++m) { bf16* rowp = O + (size_t)(row0 + ai * HALF + m * 16) * ldc + col0;
                float o[8];
#pragma unroll
                for (int n = 0; n < 2; ++n) { const f32x4 a = acc[ai][0][m][n] + ba[n], b = acc[ai][1][m][n] + bb[n];
#pragma unroll
                    for (int j = 0; j < 4; ++j) {
                        if (MODE == 0) o[4 * n + j] = a[j] * sigm(b[j]);
                        else { const float g = fminf(a[j], 7.f), up = fminf(fmaxf(b[j], -7.f), 7.f); o[4 * n + j] = (up + 1.f) * g * sigm(1.702f * g); } } }
                v4u w; w.x = cvt_pk_bf16(o[0], o[1]); w.y = cvt_pk_bf16(o[2], o[3]); w.z = cvt_pk_bf16(o[4], o[5]); w.w = cvt_pk_bf16(o[6], o[7]);
                *(v4u*)rowp = w; }
    }
};
struct EpiMerge {
    static constexpr bool PERM = true;
    bf16* mtmp; bf16* Mo; const bf16* zg;
    __device__ __forceinline__ void operator()(const f32x4 (&acc)[2][2][4][2], const Unit& u, int wr, int wc, int fr, int fq) const {
        const int row0 = u.pm * BM + wr * 64 + fr, col0 = u.pn * BM + wc * 32 + 8 * fq;
#pragma unroll
        for (int ai = 0; ai < 2; ++ai)
#pragma unroll
            for (int m = 0; m < 4; ++m) { const size_t r = (size_t)(row0 + ai * HALF + m * 16);
#pragma unroll
                for (int bj = 0; bj < 2; ++bj) { const int c = col0 + bj * HALF;
                    const v4u gz = *(const v4u*)(zg + r * IN_COLS + u.e * 1024 + c);
                    float g[8] = {bflo(gz.x), bfhi(gz.x), bflo(gz.y), bfhi(gz.y), bflo(gz.z), bfhi(gz.z), bflo(gz.w), bfhi(gz.w)};
                    f32x4 t0, t1; bf16* tp = mtmp + r * 1024 + c;
                    if (u.e == 0) { t0 = (f32x4){0.f, 0.f, 0.f, 0.f}; t1 = t0; } else { const v4u pv = *(const v4u*)tp; t0 = (f32x4){bflo(pv.x), bfhi(pv.x), bflo(pv.y), bfhi(pv.y)}; t1 = (f32x4){bflo(pv.z), bfhi(pv.z), bflo(pv.w), bfhi(pv.w)}; }
#pragma unroll
                    for (int j = 0; j < 4; ++j) { t0[j] += sigm(g[j]) * acc[ai][bj][m][0][j]; t1[j] += sigm(g[4 + j]) * acc[ai][bj][m][1][j]; }
                    if (u.e < 2) { v4u w; w.x = cvt_pk_bf16(t0[0], t0[1]); w.y = cvt_pk_bf16(t0[2], t0[3]); w.z = cvt_pk_bf16(t1[0], t1[1]); w.w = cvt_pk_bf16(t1[2], t1[3]); *(v4u*)tp = w; }
                    else { v4u w; w.x = cvt_pk_bf16(t0[0], t0[1]); w.y = cvt_pk_bf16(t0[2], t0[3]); w.z = cvt_pk_bf16(t1[0], t1[1]); w.w = cvt_pk_bf16(t1[2], t1[3]);
                        *(v4u*)(Mo + r * 1024 + c) = w; } } }
    }
};
struct EpiResid {
    static constexpr bool PERM = false;
    float* X; const float* gmod;
    __device__ __forceinline__ void operator()(const f32x4 (&acc)[2][2][4][2], const Unit& u, int wr, int wc, int fr, int fq) const {
        const int row0 = u.pm * BM + wr * 64 + fr, col0 = u.pn * BM + wc * 32 + 4 * fq;
        const int r00 = u.pm * BM; const int w = r00 < T_LAT ? (r00 >> 12) : 8;
        f32x4 gv[2][2];
#pragma unroll
        for (int bj = 0; bj < 2; ++bj)
#pragma unroll
            for (int n = 0; n < 2; ++n) gv[bj][n] = *(const f32x4*)(gmod + (size_t)w * 6144 + col0 + bj * HALF + n * 16);
#pragma unroll
        for (int ai = 0; ai < 2; ++ai)
#pragma unroll
            for (int m = 0; m < 4; ++m) { float* rowp = X + (size_t)(row0 + ai * HALF + m * 16) * 1024 + col0;
#pragma unroll
                for (int bj = 0; bj < 2; ++bj)
#pragma unroll
                    for (int n = 0; n < 2; ++n) { f32x4* p = (f32x4*)(rowp + bj * HALF + n * 16); *p = *p + gv[bj][n] * acc[ai][bj][m][n]; } }
    }
};
}

struct Args { const float* in[51]; float* out; unsigned char* ws; int ph_lo, ph_hi; };
enum { I_X = 0, I_C, I_CTX, I_CCTX, I_ADAW, I_ADAB, I_N1G, I_N2G, I_WIN, I_HYCW, I_HYCB, I_HYW1, I_HYB1, I_HYF1, I_HYW2, I_HYB2, I_HYF2, I_HYW3, I_HYB3, I_HYBIAS,
       I_RWCW, I_RWCB, I_RWWUP, I_RWW0, I_RWAUP, I_RWA0, I_RWGUP, I_RWKK, I_RWKA, I_RWRK, I_RWLNG, I_RWLNB, I_S5ARE, I_S5AIM, I_S5LDT, I_S5BRE, I_S5BIM, I_S5CRE, I_S5CIM, I_S5D,
       I_S5GLUW, I_S5GLUB, I_WBR, I_WOUT, I_RTW, I_RTB, I_W1, I_B1, I_W2, I_B2, I_FING };

typedef const __attribute__((address_space(4))) Args* CArgsP;
__device__ __forceinline__ CArgsP kargs() { CArgsP p = (CArgsP)__builtin_amdgcn_kernarg_segment_ptr(); asm volatile("" : "+s"(p)); return p; }
__device__ __forceinline__ int opaque(int v) { asm volatile("" : "+s"(v)); return v; }
__device__ __forceinline__ int opaque_v(int v) { asm volatile("" : "+v"(v)); return v; }
struct Ctx { CArgsP a; LAS unsigned char* lds; int tid, lane, wave, bid, G; };

__device__ __forceinline__ void row_seq(int row, int& base, int& pos, int& n) {
    if (row < T_LAT) { base = row & ~(SEQ - 1); pos = row & (SEQ - 1); n = SEQ; }
    else { const int r = row - T_LAT; base = T_LAT + (r & ~(CTXL - 1)); pos = r & (CTXL - 1); n = CTXL; }
}
__device__ __forceinline__ float conv3z(const bf16* zc, int pos, int n, float w0, float w1, float w2, float b) {
    const float zm = pos > 0 ? bf2f(zc[(size_t)(pos - 1) * IN_COLS]) : 0.f, z0 = bf2f(zc[(size_t)pos * IN_COLS]), zp = pos < n - 1 ? bf2f(zc[(size_t)(pos + 1) * IN_COLS]) : 0.f;
    return zm * w0 + z0 * w1 + zp * w2 + b;
}

template <int MODE>
__device__ __forceinline__ void transpose_item(const float* W, int K, int N, bf16* WT, int Hs, LAS float* scr, int item, int lane) {
    const int nblk = N / 32, kb = item / nblk, nb = item % nblk, k0 = 64 * kb, n0 = 32 * nb;
#pragma unroll 8
    for (int i = 0; i < 32; ++i) { const int kk = 2 * i + (lane >> 5); scr[kk * 33 + (lane & 31)] = W[(size_t)(k0 + kk) * N + n0 + (lane & 31)]; }
    LDS_WAIT(); asm volatile("" ::: "memory");
    const int c = lane & 7;
#pragma unroll
    for (int j = 0; j < 4; ++j) { const int n = (lane >> 3) + 8 * j; const LAS float* s = scr + (8 * c) * 33 + n;
        v4u o; o.x = pk2(s[0 * 33], s[1 * 33]); o.y = pk2(s[2 * 33], s[3 * 33]); o.z = pk2(s[4 * 33], s[5 * 33]); o.w = pk2(s[6 * 33], s[7 * 33]);
        int dr = n0 + n;
        if (MODE == 1) { const int nc = n0 + n; const int jx = nc < Hs ? nc : nc - Hs; dr = (jx >> 7) * 256 + (nc < Hs ? 0 : 128) + (jx & 127); }
        *(v4u*)(WT + (size_t)dr * K + k0 + 8 * c) = o; }
    LDS_WAIT(); asm volatile("" ::: "memory");
}

__device__ __forceinline__ void p0_prologue(const Ctx& F) {
    const auto& a = *F.a; unsigned char* ws = a.ws;
    const int gw = F.bid * NWAVES + F.wave, NGW = F.G * NWAVES, lane = F.lane;
    float* X = (float*)(ws + WS_X);
    for (int t = gw; t < SEQ; t += NGW) {
        const float pr = (float)(t >> 6), pc = (float)(t & 63);
        f32x4 pe[4];
#pragma unroll
        for (int j = 0; j < 4; ++j)
#pragma unroll
            for (int e = 0; e < 4; ++e) { const float om = 1.0f / powf(10000.0f, (float)(4 * lane + e) / 256.0f); const float ang = ((j < 2) ? pr : pc) * om; pe[j][e] = (j & 1) ? cosf(ang) : sinf(ang); }
#pragma unroll 2
        for (int bb = 0; bb < BATCH; ++bb) { const size_t row = (size_t)bb * SEQ + t;
            const f32x4* xi = (const f32x4*)(a.in[I_X] + row * D) + lane; f32x4* xo = (f32x4*)(X + row * D) + lane;
#pragma unroll
            for (int j = 0; j < 4; ++j) xo[64 * j] = xi[64 * j] + pe[j]; }
    }
    for (int row = T_LAT + gw; row < T_ALL; row += NGW) {
        const f32x4* xi = (const f32x4*)(a.in[I_CTX] + (size_t)(row - T_LAT) * D) + lane; f32x4* xo = (f32x4*)(X + (size_t)row * D) + lane;
#pragma unroll
        for (int j = 0; j < 4; ++j) xo[64 * j] = xi[64 * j];
    }
    {
        LAS float* condl = (LAS float*)F.lds; LAS float* psum = (LAS float*)(F.lds + 40960);
        for (int i = F.tid; i < 9 * 1024; i += NTHREADS) { const int w = i >> 10, k = i & 1023; const float cv = (w < 8) ? a.in[I_C][w * 1024 + k] : a.in[I_CCTX][k]; condl[i] = cv / (1.f + expf(-cv)); }
        __syncthreads();
        float* MOD = (float*)(ws + WS_MOD);
        for (int it = F.bid; it < 2 * 96; it += F.G) {
            const int l = it / 96, cg = it % 96, col = cg * 64 + lane;
            float acc[9];
#pragma unroll
            for (int w = 0; w < 9; ++w) acc[w] = 0.f;
            const float* wp = a.in[I_ADAW] + ((size_t)l * 1024 + F.wave * 128) * 6144 + col;
#pragma unroll 1
            for (int k0 = 0; k0 < 128; k0 += 16) { float wv[16];
#pragma unroll
                for (int k = 0; k < 16; ++k) wv[k] = wp[(size_t)(k0 + k) * 6144];
#pragma unroll
                for (int k = 0; k < 16; ++k)
#pragma unroll
                    for (int w = 0; w < 9; ++w) acc[w] += condl[w * 1024 + F.wave * 128 + k0 + k] * wv[k]; }
#pragma unroll
            for (int w = 0; w < 9; ++w) psum[(F.wave * 9 + w) * 64 + lane] = acc[w];
            __syncthreads();
            if (F.wave == 0) {
#pragma unroll
                for (int w = 0; w < 9; ++w) { float s = 0.f;
#pragma unroll
                    for (int wv = 0; wv < 8; ++wv) s += psum[(wv * 9 + w) * 64 + lane];
                    MOD[(size_t)(l * 9 + w) * 6144 + col] = s + a.in[I_ADAB][l * 6144 + col]; }
            }
            __syncthreads();
        }
    }
    {
        LAS float* scr = (LAS float*)(F.lds + F.wave * 16384);
        constexpr int IT_W1 = 16 * 64, IT_W2 = 16 * 32, IT_WIN = 16 * 216, IT_GLU = 8 * 32, IT_WBR = 8 * 32, IT_WOUT = 16 * 32;
        constexpr int N_W1 = 64 * IT_W1, N_W2 = 64 * IT_W2, N_WIN = 2 * IT_WIN, N_GLU = 2 * IT_GLU, N_WBR = 6 * IT_WBR, N_WOUT = 2 * IT_WOUT;
        constexpr int NITEMS = N_W1 + N_W2 + N_WIN + N_GLU + N_WBR + N_WOUT;
        for (int it = gw; it < NITEMS; it += NGW) {
            int r = it;
            if (r < N_W1) { const int mtx = r / IT_W1, l = mtx >> 5, e = mtx & 31; transpose_item<1>(a.in[I_W1] + (size_t)mtx * 1024 * 2048, 1024, 2048, (bf16*)(ws + WS_WTS + l * WL_STRIDE + WO_W1) + (size_t)e * 2048 * 1024, 1024, scr, r % IT_W1, lane); continue; } r -= N_W1;
            if (r < N_W2) { const int mtx = r / IT_W2, l = mtx >> 5, e = mtx & 31; transpose_item<0>(a.in[I_W2] + (size_t)mtx * 1024 * 1024, 1024, 1024, (bf16*)(ws + WS_WTS + l * WL_STRIDE + WO_W2) + (size_t)e * 1024 * 1024, 0, scr, r % IT_W2, lane); continue; } r -= N_W2;
            if (r < N_WIN) { const int l = r / IT_WIN; transpose_item<0>(a.in[I_WIN] + (size_t)l * 1024 * IN_COLS, 1024, IN_COLS, (bf16*)(ws + WS_WTS + l * WL_STRIDE + WO_WIN), 0, scr, r % IT_WIN, lane); continue; } r -= N_WIN;
            if (r < N_GLU) { const int l = r / IT_GLU; transpose_item<1>(a.in[I_S5GLUW] + (size_t)l * 512 * 1024, 512, 1024, (bf16*)(ws + WS_WTS + l * WL_STRIDE + WO_GLU), 512, scr, r % IT_GLU, lane); continue; } r -= N_GLU;
            if (r < N_WBR) { const int mtx = r / IT_WBR, l = mtx / 3, br = mtx % 3; transpose_item<0>(a.in[I_WBR] + (size_t)mtx * 512 * 1024, 512, 1024, (bf16*)(ws + WS_WTS + l * WL_STRIDE + WO_WBR) + (size_t)br * 1024 * 512, 0, scr, r % IT_WBR, lane); continue; } r -= N_WBR;
            { const int l = r / IT_WOUT; transpose_item<0>(a.in[I_WOUT] + (size_t)l * 1024 * 1024, 1024, 1024, (bf16*)(ws + WS_WTS + l * WL_STRIDE + WO_WOUT), 0, scr, r % IT_WOUT, lane); }
        }
        for (int i = F.bid * NTHREADS + F.tid; i < 2 * 2560 * 256; i += F.G * NTHREADS) {
            const int l = i / (2560 * 256), r = i % (2560 * 256), n = r >> 8, k = r & 255; float v = 0.f;
            if (n < 1024) { if (k < 64) v = a.in[I_RWWUP][(((size_t)l * 2 + (n >> 9)) * 64 + k) * 512 + (n & 511)]; }
            else if (n < 2048) { if (k >= 64 && k < 128) v = a.in[I_RWAUP][(((size_t)l * 2 + ((n - 1024) >> 9)) * 64 + (k - 64)) * 512 + (n & 511)]; }
            else { if (k >= 128) v = a.in[I_RWGUP][((size_t)l * 128 + (k - 128)) * 512 + (n - 2048)]; }
            ((bf16*)(ws + WS_WTS + l * WL_STRIDE + WO_RWCAT))[r] = (bf16)f2bf(v);
        }
    }
    __syncthreads();
    {
        LAS float* feats = (LAS float*)F.lds; LAS float* h1 = feats + 8 * 33; LAS float* h2 = h1 + 8 * 64;
        constexpr int NIT = 2 * (512 + 32);
        for (int it = F.bid; it < NIT; it += F.G) {
            const int l = it / 544, r = it % 544, nsel = r >= 512, n = nsel ? CTXL : SEQ, p0 = (nsel ? r - 512 : r) * 8;
            if (F.tid < 8 * 33) { const int p = F.tid / 33, i = F.tid % 33, pos = p0 + p; float f;
                if (i == 0) f = (float)pos / (float)(n - 1);
                else { const int k = (i - 1) & 15; const float band = 1e-4f + (float)k * ((15.0f - 1e-4f) / 15.0f); const float ang = (6.283185307179586f * (float)pos / (float)n) * band; f = (i <= 16) ? cosf(ang) : -sinf(ang); }
                feats[p * 33 + i] = f; }
            __syncthreads();
            { const int p = F.tid >> 6, j = F.tid & 63; float s = a.in[I_HYB1][l * 64 + j]; const float* w1p = a.in[I_HYW1] + (size_t)l * 33 * 64 + j;
#pragma unroll
                for (int i = 0; i < 33; ++i) s += feats[p * 33 + i] * w1p[i * 64];
                h1[p * 64 + j] = sinf(a.in[I_HYF1][l * 64 + j] * s); }
            __syncthreads();
            { const int p = F.tid >> 6, j = F.tid & 63; float s = a.in[I_HYB2][l * 64 + j];
                const float* w2p = a.in[I_HYW2] + (size_t)l * 64 * 64 + j;
#pragma unroll 16
                for (int i = 0; i < 64; ++i) s += h1[p * 64 + i] * w2p[i * 64];
                h2[p * 64 + j] = sinf(a.in[I_HYF2][l * 64 + j] * s); }
            __syncthreads();
            float acc[4][8];
#pragma unroll
            for (int q = 0; q < 4; ++q)
#pragma unroll
                for (int p = 0; p < 8; ++p) acc[q][p] = 0.f;
            const float* w3 = a.in[I_HYW3] + (size_t)l * 64 * 2048 + F.tid;
#pragma unroll 8
            for (int i = 0; i < 64; ++i) { float wv[4];
#pragma unroll
                for (int q = 0; q < 4; ++q) wv[q] = w3[(size_t)i * 2048 + q * 512];
#pragma unroll
                for (int p = 0; p < 8; ++p) { const float hv = h2[p * 64 + i];
#pragma unroll
                    for (int q = 0; q < 4; ++q) acc[q][p] += hv * wv[q]; } }
            const int c = F.tid; const float dstart = logf(0.01f) / 1.5f, dstop = logf(0.01f) / 0.3f; const float delta = fabsf(dstart + (float)c * ((dstop - dstart) / 511.0f));
            const int RL = nsel ? HY_RLENC : HY_RLEN, off = n + 47;
            bf16* Rb = (bf16*)(ws + WS_GF + l * GF_STRIDE + (nsel ? GF_CTX : 0));
#pragma unroll
            for (int q = 0; q < 4; ++q) { const int o = q >> 1, side = q & 1; const float b3 = a.in[I_HYB3][l * 2048 + q * 512 + c];
                bf16* Rc = Rb + ((size_t)o * 512 + c) * RL;
#pragma unroll
                for (int p = 0; p < 8; ++p) { const int pos = p0 + p; const float t = (float)pos / (float)(n - 1); const float val = (acc[q][p] + b3) * expf(-t * delta);
                    if (side == 0) Rc[off - pos] = (bf16)f2bf(val);
                    else if (pos >= 1) Rc[off + pos] = (bf16)f2bf(val); }
                if (p0 == 0 && side == 0) { for (int m = 0; m < 48; ++m) Rc[m] = 0; for (int m = off + n; m < RL; ++m) Rc[m] = 0; } }
            __syncthreads();
        }
    }
}

__device__ __forceinline__ void stage_norm1(const Ctx& F, int l) {
    const auto& a = *F.a; unsigned char* ws = a.ws; const int lane = F.lane;
    const int gw = F.bid * NWAVES + F.wave, NGW = F.G * NWAVES;
    float* X = (float*)(ws + WS_X); bf16* H = (bf16*)(ws + WS_H); const float* MOD = (const float*)(ws + WS_MOD);
    const bf16* YS = (const bf16*)(ws + WS_XS); const int* POS = (const int*)(ws + WS_POS); const float* GATE = (const float*)(ws + WS_GATE);
    const int nrows = (l == DEPTH) ? T_LAT : T_ALL;
    f32x4 vn[4]; int4 pn = make_int4(0, 0, 0, 0); f32x4 gn = (f32x4){0.f, 0.f, 0.f, 0.f};
    if (gw < nrows) {
#pragma unroll
        for (int j = 0; j < 4; ++j) vn[j] = ((const f32x4*)(X + (size_t)gw * D) + lane)[64 * j];
        if (l > 0) { pn = *(const int4*)(POS + gw * 4); gn = *(const f32x4*)(GATE + gw * 4); } }
#pragma unroll 1
    for (int row = gw; row < nrows; row += NGW) {
        const int w = row < T_LAT ? (row >> 12) : 8;
        f32x4* xr = (f32x4*)(X + (size_t)row * D) + lane;
        f32x4 v[4];
#pragma unroll
        for (int j = 0; j < 4; ++j) v[j] = vn[j];
        const int4 pc = pn; const f32x4 gc = gn;
        if (row + NGW < nrows) { const int rn = row + NGW;
#pragma unroll
            for (int j = 0; j < 4; ++j) vn[j] = ((const f32x4*)(X + (size_t)rn * D) + lane)[64 * j];
            if (l > 0) { pn = *(const int4*)(POS + rn * 4); gn = *(const f32x4*)(GATE + rn * 4); } }
        if (l > 0) {
            f32x4 mo[4];
#pragma unroll
            for (int j = 0; j < 4; ++j) mo[j] = (f32x4){0.f, 0.f, 0.f, 0.f};
            const int pk_[4] = {pc.x, pc.y, pc.z, pc.w};
#pragma unroll
            for (int k = 0; k < TOPK; ++k) { const int p = pk_[k]; const float g = gc[k];
                const v2u* yr = (const v2u*)(YS + (size_t)p * D) + lane;
#pragma unroll
                for (int j = 0; j < 4; ++j) { const v2u y = yr[64 * j]; mo[j][0] += g * bflo(y.x); mo[j][1] += g * bfhi(y.x); mo[j][2] += g * bflo(y.y); mo[j][3] += g * bfhi(y.y); } }
            const f32x4* g2 = (const f32x4*)(MOD + (size_t)((l - 1) * 9 + w) * 6144 + 5120) + lane;
#pragma unroll
            for (int j = 0; j < 4; ++j) { v[j] = v[j] + g2[64 * j] * mo[j]; xr[64 * j] = v[j]; }
        }
        float ss = 0.f;
#pragma unroll
        for (int j = 0; j < 4; ++j) ss += (v[j][0] * v[j][0] + v[j][1] * v[j][1]) + (v[j][2] * v[j][2] + v[j][3] * v[j][3]);
        const float rstd = 1.0f / sqrtf(wave_sum(ss) * (1.f / D) + 1e-6f);
        if (l == DEPTH) {
            const f32x4* fg = (const f32x4*)a.in[I_FING] + lane; f32x4* o = (f32x4*)(a.out + (size_t)row * D) + lane;
#pragma unroll
            for (int j = 0; j < 4; ++j) o[64 * j] = v[j] * rstd * fg[64 * j];
        } else {
            const f32x4* ng = (const f32x4*)(a.in[I_N1G] + l * D) + lane;
            const f32x4* sh = (const f32x4*)(MOD + (size_t)(l * 9 + w) * 6144) + lane; const f32x4* sc = (const f32x4*)(MOD + (size_t)(l * 9 + w) * 6144 + 1024) + lane;
            v2u* ho = (v2u*)(H + (size_t)row * D) + lane;
#pragma unroll
            for (int j = 0; j < 4; ++j) { const f32x4 h = v[j] * rstd * ng[64 * j] * (sc[64 * j] + 1.0f) + sh[64 * j]; v2u o; o.x = pk2(h[0], h[1]); o.y = pk2(h[2], h[3]); ho[64 * j] = o; }
        }
    }
}

__device__ __forceinline__ void stage_rw_prep1(const Ctx& F, int l) {
    const auto& a = *F.a; unsigned char* ws = a.ws;
    const bf16* Z = (const bf16*)(ws + WS_Z); bf16* ARW = (bf16*)(ws + WS_ARW);
    const int j = 4 * (F.tid & 63), col = 1536 + j, rq = F.tid >> 6;
    const float* cw = a.in[I_RWCW] + (size_t)l * 3 * 1792;
    const f32x4 w0 = *(const f32x4*)(cw + col), w1 = *(const f32x4*)(cw + 1792 + col), w2 = *(const f32x4*)(cw + 2 * 1792 + col), cb = *(const f32x4*)(a.in[I_RWCB] + l * 1792 + col);
#pragma unroll 2
    for (int row = F.bid * 8 + rq; row < T_ALL; row += F.G * 8) {
        int base, pos, n; row_seq(row, base, pos, n);
        const bf16* zc = Z + (size_t)row * IN_COLS + RW_OFF + col;
        const v2u z0 = *(const v2u*)zc;
        v2u zm = (v2u){0u, 0u}, zp = (v2u){0u, 0u};
        if (pos > 0) zm = *(const v2u*)(zc - IN_COLS);
        if (pos < n - 1) zp = *(const v2u*)(zc + IN_COLS);
        f32x4 v = (f32x4){bflo(zm.x), bfhi(zm.x), bflo(zm.y), bfhi(zm.y)} * w0 + (f32x4){bflo(z0.x), bfhi(z0.x), bflo(z0.y), bfhi(z0.y)} * w1 + (f32x4){bflo(zp.x), bfhi(zp.x), bflo(zp.y), bfhi(zp.y)} * w2 + cb;
#pragma unroll
        for (int e2 = 0; e2 < 4; ++e2) { if (j < 64) v[e2] = tanh_fast(v[e2]); else if (j >= 128) v[e2] = sigm(v[e2]); }
        v2u o; o.x = pk2(v[0], v[1]); o.y = pk2(v[2], v[3]);
        *(v2u*)(ARW + (size_t)row * 256 + j) = o;
    }
}

__device__ __forceinline__ void stage_rw_prep2(const Ctx& F, int l) {
    const auto& a = *F.a; unsigned char* ws = a.ws; const int lane = F.lane;
    const bf16* Z = (const bf16*)(ws + WS_Z); const bf16* P = (const bf16*)(ws + WS_P); bf16* SCN = (bf16*)(ws + WS_SCN);
    const int gw = F.bid * NWAVES + F.wave, NGW = F.G * NWAVES;
    constexpr int TR = 17, NRT = T_ALL / TR;
    const float* cw = a.in[I_RWCW] + (size_t)l * 3 * 1792; const float* cbp = a.in[I_RWCB] + l * 1792;
    for (int tile = gw; tile < NRT * 4; tile += NGW) {
        const int rt = tile % NRT, hp = tile / NRT, row0 = rt * TR, c0 = hp * 128 + 2 * lane;
        f32x2 w[3][3], cb[3];
#pragma unroll
        for (int s = 0; s < 3; ++s) { cb[s] = *(const f32x2*)(cbp + s * 512 + c0);
#pragma unroll
            for (int j = 0; j < 3; ++j) w[s][j] = *(const f32x2*)(cw + j * 1792 + s * 512 + c0); }
        const f32x2 KKw = *(const f32x2*)(a.in[I_RWKK] + l * 512 + c0), KAw = *(const f32x2*)(a.in[I_RWKA] + l * 512 + c0);
        f32x2 W0[2], A0[2];
#pragma unroll
        for (int d = 0; d < 2; ++d) { W0[d] = *(const f32x2*)(a.in[I_RWW0] + (l * 2 + d) * 512 + c0); A0[d] = *(const f32x2*)(a.in[I_RWA0] + (l * 2 + d) * 512 + c0); }
        const unsigned* zb = (const unsigned*)(Z + RW_OFF + c0);
        unsigned zm[3], z0[3], zp[3];
#pragma unroll
        for (int s = 0; s < 3; ++s) { zm[s] = row0 > 0 ? zb[(size_t)(row0 - 1) * (IN_COLS / 2) + s * 256] : 0u; z0[s] = zb[(size_t)row0 * (IN_COLS / 2) + s * 256]; }
        unsigned pn_[4], pc_[4];
        { const unsigned* pr0 = (const unsigned*)(P + (size_t)row0 * 2560 + c0); pn_[0] = pr0[0]; pn_[1] = pr0[512]; pn_[2] = pr0[256]; pn_[3] = pr0[768]; }
#pragma unroll 1
        for (int i = 0; i < TR; ++i) {
            const int row = row0 + i; int base, pos, n; row_seq(row, base, pos, n);
#pragma unroll
            for (int e = 0; e < 4; ++e) pc_[e] = pn_[e];
            if (i + 1 < TR) { const unsigned* pr1 = (const unsigned*)(P + (size_t)(row + 1) * 2560 + c0); pn_[0] = pr1[0]; pn_[1] = pr1[512]; pn_[2] = pr1[256]; pn_[3] = pr1[768]; }
#pragma unroll
            for (int s = 0; s < 3; ++s) zp[s] = (row + 1 < T_ALL) ? zb[(size_t)(row + 1) * (IN_COLS / 2) + s * 256] : 0u;
            const float mlo = pos > 0 ? 1.f : 0.f, mhi = pos < n - 1 ? 1.f : 0.f;
            f32x2 u[3];
#pragma unroll
            for (int s = 0; s < 3; ++s) { u[s] = (f32x2){bflo(zm[s]), bfhi(zm[s])} * mlo * w[s][0] + (f32x2){bflo(z0[s]), bfhi(z0[s])} * w[s][1] + (f32x2){bflo(zp[s]), bfhi(zp[s])} * mhi * w[s][2] + cb[s]; zm[s] = z0[s]; z0[s] = zp[s]; }
            const f32x2 r = u[0], k = u[1], v = u[2];
            f32x2 kk = k * KKw;
            const float ss = red32(kk[0] * kk[0] + kk[1] * kk[1]);
            kk = kk * (1.0f / sqrtf(fmaxf(ss, 1e-24f)));
            unsigned* o = (unsigned*)(SCN + (size_t)row * 9 * 512 + c0);
            o[0] = pk2(r[0], r[1]); o[256] = pk2(v[0], v[1]); o[2 * 256] = pk2(kk[0], kk[1]);
#pragma unroll
            for (int d = 0; d < 2; ++d) {
                const unsigned pw = pc_[2 * d], pa = pc_[2 * d + 1];
                float ld[2], kd[2], be[2];
#pragma unroll
                for (int e = 0; e < 2; ++e) {
                    const float uu = W0[d][e] + (e ? bfhi(pw) : bflo(pw));
                    ld[e] = -0.60653065971263342f * sigm(uu);
                    const float av = sigm(A0[d][e] + (e ? bfhi(pa) : bflo(pa)));
                    kd[e] = k[e] * (1.f + (av - 1.f) * KAw[e]); be[e] = kk[e] * av; }
                o[(3 + 3 * d) * 256] = pk2(ld[0], ld[1]); o[(4 + 3 * d) * 256] = pk2(kd[0], kd[1]); o[(5 + 3 * d) * 256] = pk2(be[0], be[1]);
            }
        }
    }
}

__device__ __forceinline__ int seq_row(int b, int d, int sidx) {
    if (sidx < CTXL) { const int t = d ? (CTXL - 1 - sidx) : sidx; return T_LAT + b * CTXL + t; }
    const int tl = sidx - CTXL; const int t = d ? (SEQ - 1 - tl) : tl; return b * SEQ + t;
}

constexpr int CW_WORK = 16384;
constexpr int CW_STAMP = 20480;
#ifdef PROBE_T
#ifndef PROBE_BID
#define PROBE_BID 0
#endif
#define PT(k) do { if (F.bid == PROBE_BID && F.tid == 0 && l == 0) ((unsigned long long*)(F.a->ws + WS_CTL + CW_STAMP * 4))[k] = __builtin_amdgcn_s_memrealtime(); } while (0)
#else
#define PT(k) do { } while (0)
#endif
__device__ __forceinline__ void rw_scan_item(const Ctx& F, int l, int it2) {
    const int it = it2 >> 1, half = it2 & 1;
    const auto& a = *F.a; unsigned char* ws = a.ws; const int tid = F.tid, lane = F.lane;
    const bf16* SCN = (const bf16*)(ws + WS_SCN); float* YD = (float*)(ws + WS_YDIR);
    LAS float* sbuf = (LAS float*)F.lds;
    LAS float* ybuf = (LAS float*)(F.lds + 49152);
    const bool comp = F.wave < 4;
    const int lt = tid & 255, ls = lt >> 4, lj = lt & 15;
    const int vl = lane >> 3, kq = lane & 7, vrow = half * 32 + (F.wave & 3) * 8 + vl;
    constexpr int NCH = (CTXL + SEQ) / 16;
    const int d = it & 1, h = (it >> 1) & 7, b = it >> 4;
    f32x2 S[4];
#pragma unroll
    for (int q = 0; q < 4; ++q) S[q] = (f32x2){0.f, 0.f};
    v2u ldr[6];
#define RW_ISSUE(c) do { const int row_ = seq_row(b, d, (c) * 16 + ls); const v2u* p_ = (const v2u*)(SCN + (size_t)row_ * 9 * 512 + h * 64) + lj; \
        ldr[0] = p_[2 * 128]; ldr[1] = p_[(3 + 3 * d) * 128]; ldr[2] = p_[(5 + 3 * d) * 128]; ldr[3] = p_[(4 + 3 * d) * 128]; ldr[4] = p_[0]; ldr[5] = p_[128]; } while (0)
#define RW_WRITE(bufi) do { LAS float* o_ = sbuf + (((bufi) * 16 + ls) * 6) * 64 + 4 * lj; \
        *(LAS f32x4*)(o_) = (f32x4){-bflo(ldr[0].x), -bfhi(ldr[0].x), -bflo(ldr[0].y), -bfhi(ldr[0].y)}; \
        *(LAS f32x4*)(o_ + 64) = (f32x4){__expf(bflo(ldr[1].x)), __expf(bfhi(ldr[1].x)), __expf(bflo(ldr[1].y)), __expf(bfhi(ldr[1].y))}; \
        *(LAS f32x4*)(o_ + 128) = (f32x4){bflo(ldr[2].x), bfhi(ldr[2].x), bflo(ldr[2].y), bfhi(ldr[2].y)}; *(LAS f32x4*)(o_ + 192) = (f32x4){bflo(ldr[3].x), bfhi(ldr[3].x), bflo(ldr[3].y), bfhi(ldr[3].y)}; \
        *(LAS f32x4*)(o_ + 256) = (f32x4){bflo(ldr[4].x), bfhi(ldr[4].x), bflo(ldr[4].y), bfhi(ldr[4].y)}; *(LAS f32x4*)(o_ + 320) = (f32x4){bflo(ldr[5].x), bfhi(ldr[5].x), bflo(ldr[5].y), bfhi(ldr[5].y)}; } while (0)
#define RW_FLUSH(c) do { const int row_ = seq_row(b, d, (c) * 16 + ls); \
        *(f32x2*)(YD + ((size_t)d * T_ALL + row_) * 512 + h * 64 + half * 32 + 2 * lj) = *(const LAS f32x2*)(ybuf + ((((c) & 1) * 16 + ls) * 64) + half * 32 + 2 * lj); } while (0)
    if (!comp) { RW_ISSUE(0); RW_WRITE(0); RW_ISSUE(1); }
    __syncthreads();
#pragma unroll 1
    for (int c = 0; c < NCH; ++c) {
        const int bi = c & 1;
        if (!comp) {
            if (c + 1 < NCH) RW_WRITE(bi ^ 1);
            if (c + 2 < NCH) RW_ISSUE(c + 2);
            if (c > 0) RW_FLUSH(c - 1);
        } else {
        float yv[16];
        f32x4 opA[10], opB[10]; float vvA, vvB;
#define RW_LD(op, vvx, s_) do { const LAS float* sp_ = sbuf + ((bi * 16 + (s_)) * 6) * 64 + 8 * kq; \
            _Pragma("unroll") for (int q_ = 0; q_ < 5; ++q_) { op[2 * q_] = *(const LAS f32x4*)(sp_ + 64 * q_); op[2 * q_ + 1] = *(const LAS f32x4*)(sp_ + 64 * q_ + 4); } \
            vvx = sbuf[((bi * 16 + (s_)) * 6 + 5) * 64 + vrow]; } while (0)
#define RW_COMP(op, vvx, s_) do { \
            const f32x4 a0 = op[0], a1 = op[1], w0 = op[2], w1 = op[3], b0 = op[4], b1 = op[5], k0 = op[6], k1 = op[7], r0 = op[8], r1 = op[9]; \
            const f32x2 vv2 = (f32x2){vvx, vvx}; \
            const f32x2 p0 = S[1] * (f32x2){a0[2], a0[3]} + S[0] * (f32x2){a0[0], a0[1]}; \
            const f32x2 p1 = S[3] * (f32x2){a1[2], a1[3]} + S[2] * (f32x2){a1[0], a1[1]}; \
            const f32x2 t0 = S[0] * (f32x2){w0[0], w0[1]} + vv2 * (f32x2){k0[0], k0[1]}; \
            const f32x2 t1 = S[1] * (f32x2){w0[2], w0[3]} + vv2 * (f32x2){k0[2], k0[3]}; \
            const f32x2 t2 = S[2] * (f32x2){w1[0], w1[1]} + vv2 * (f32x2){k1[0], k1[1]}; \
            const f32x2 t3 = S[3] * (f32x2){w1[2], w1[3]} + vv2 * (f32x2){k1[2], k1[3]}; \
            const f32x2 ac = p0 + p1; \
            const float sa = red8(ac[0] + ac[1]); \
            const f32x2 sa2 = (f32x2){sa, sa}; \
            S[0] = sa2 * (f32x2){b0[0], b0[1]} + t0; S[1] = sa2 * (f32x2){b0[2], b0[3]} + t1; \
            S[2] = sa2 * (f32x2){b1[0], b1[1]} + t2; S[3] = sa2 * (f32x2){b1[2], b1[3]} + t3; \
            const f32x2 q0 = S[1] * (f32x2){r0[2], r0[3]} + S[0] * (f32x2){r0[0], r0[1]}; \
            const f32x2 q1 = S[3] * (f32x2){r1[2], r1[3]} + S[2] * (f32x2){r1[0], r1[1]}; \
            const f32x2 yc = q0 + q1; \
            yv[s_] = red8(yc[0] + yc[1]); } while (0)
        RW_LD(opA, vvA, 0);
#pragma unroll
        for (int s = 0; s < 16; s += 2) {
            RW_LD(opB, vvB, s + 1);
            __builtin_amdgcn_sched_barrier(0);
            RW_COMP(opA, vvA, s);
            __builtin_amdgcn_sched_barrier(0);
            if (s + 2 < 16) RW_LD(opA, vvA, s + 2);
            __builtin_amdgcn_sched_barrier(0);
            RW_COMP(opB, vvB, s + 1);
            __builtin_amdgcn_sched_barrier(0);
        }
#undef RW_LD
#undef RW_COMP
#pragma unroll
        for (int s = 0; s < 16; ++s) if ((s & 7) == kq) ybuf[((bi * 16 + s) * 64) + vrow] = yv[s];
        }
        __syncthreads();
    }
    if (!comp) RW_FLUSH(NCH - 1);
    __syncthreads();
#undef RW_ISSUE
#undef RW_WRITE
#undef RW_FLUSH
}

constexpr size_t WS_RWSCR = WS_YHY;
constexpr int RWS_QY = 0, RWS_YV = 2048, RWS_PZ = 4096, RWS_ZV = 12288, RWS_SLOT = 20480;
typedef __bf16 bf16x8n __attribute__((ext_vector_type(8)));
__device__ __forceinline__ f32x4 mma16(const bf16x8 a, const bf16x8 b, const f32x4 c) { return __builtin_amdgcn_mfma_f32_16x16x32_bf16(a, b, c, 0, 0, 0); }
__device__ __forceinline__ float dpp_shr(float x, const int n) {
    const int v = __builtin_bit_cast(int, x); int r;
    if (n == 1) r = __builtin_amdgcn_update_dpp(0, v, 0x111, 0xF, 0xF, true); else if (n == 2) r = __builtin_amdgcn_update_dpp(0, v, 0x112, 0xF, 0xF, true);
    else if (n == 4) r = __builtin_amdgcn_update_dpp(0, v, 0x114, 0xF, 0xF, true); else r = __builtin_amdgcn_update_dpp(0, v, 0x118, 0xF, 0xF, true);
    return __builtin_bit_cast(float, r);
}
__device__ __forceinline__ v4u pack8(const float (&x)[8]) { v4u o; o.x = pk2(x[0], x[1]); o.y = pk2(x[2], x[3]); o.z = pk2(x[4], x[5]); o.w = pk2(x[6], x[7]); return o; }
__device__ __forceinline__ void unpack8(const v4u u, float (&x)[8]) { x[0] = bflo(u.x); x[1] = bfhi(u.x); x[2] = bflo(u.y); x[3] = bfhi(u.y); x[4] = bflo(u.z); x[5] = bfhi(u.z); x[6] = bflo(u.w); x[7] = bfhi(u.w); }
constexpr int LDS_ZERO16 = 131072 + 3072;
__device__ __forceinline__ bf16x8 frag16z(const LAS bf16* m, int rowbase, int lane, const LAS v4u* z) {
    const LAS v4u* p = (const LAS v4u*)(m + (rowbase + (lane & 15)) * 16 + 8 * (lane >> 4));
    const v4u v = *(((lane >> 4) < 2) ? p : z); return __builtin_bit_cast(bf16x8, v); }
#define frag16(m_, rb_, ln_) frag16z(m_, rb_, ln_, zp16)
__device__ __forceinline__ void st_colmaj(LAS bf16* m, int colbase, const f32x4 d, int lane) {
    v2u o; o.x = pk2(d[0], d[1]); o.y = pk2(d[2], d[3]); *(LAS v2u*)(m + (colbase + (lane & 15)) * 16 + 4 * (lane >> 4)) = o; }
__device__ __forceinline__ void st_rowmaj(LAS bf16* m, const f32x4 d, int lane) {
#pragma unroll
    for (int r = 0; r < 4; ++r) m[(4 * (lane >> 4) + r) * 16 + (lane & 15)] = (bf16)f2bf(d[r]); }
template <int KS0, int KS1>
__device__ __forceinline__ void rw_chunk_load(const Ctx& F, int b, int h, int d, int cidx, v4u (&raw)[12]) {
    const int lane = opaque_v(F.lane), t = lane & 15, kg = lane >> 4;
    const bf16* base = (const bf16*)(F.a->ws + WS_SCN) + (size_t)seq_row(b, d, 16 * cidx + t) * 9 * 512 + h * 64;
#pragma unroll
    for (int ks = KS0; ks < KS1; ++ks) { const int off = 32 * ks + 8 * kg;
        raw[6 * ks + 0] = *(const v4u*)(base + (3 + 3 * d) * 512 + off); raw[6 * ks + 1] = *(const v4u*)(base + 2 * 512 + off); raw[6 * ks + 2] = *(const v4u*)(base + off);
        raw[6 * ks + 3] = *(const v4u*)(base + (5 + 3 * d) * 512 + off); raw[6 * ks + 4] = *(const v4u*)(base + (4 + 3 * d) * 512 + off); raw[6 * ks + 5] = *(const v4u*)(base + 512 + off); }
}
__device__ __forceinline__ void rw_chunk_task(const Ctx& F, const v4u (&raw)[12], LAS unsigned char* wl, unsigned char* slot) {
    const LAS v4u* zp16 = (const LAS v4u*)(F.lds + LDS_ZERO16);
    const int lane = opaque_v(F.lane), t = lane & 15, kg = lane >> 4;
    LAS bf16* ATt = (LAS bf16*)(wl); LAS bf16* RBr = (LAS bf16*)(wl + 2048); LAS bf16* BHt = (LAS bf16*)(wl + 4096); LAS bf16* KHt = (LAS bf16*)(wl + 6144); LAS bf16* VTt = (LAS bf16*)(wl + 8192);
    LAS bf16* WAt = (LAS bf16*)(wl + 10240); LAS bf16* N_r = (LAS bf16*)(wl + 12288); LAS bf16* N_c = (LAS bf16*)(wl + 12800); LAS bf16* T_r = (LAS bf16*)(wl + 13312);
    LAS bf16* AK_r = (LAS bf16*)(wl + 13824); LAS bf16* RB2 = (LAS bf16*)(wl + 14336); LAS bf16* RK_r = (LAS bf16*)(wl + 14848); LAS float* GCl = (LAS float*)(wl + 15360);
    bf16x8 fAb[2], fRb[2], fBb[2], fKb[2];
#pragma unroll
    for (int ks = 0; ks < 2; ++ks) {
        const int off = 32 * ks + 8 * kg;
        float ea[8], er[8], eb[8], eh[8];
        { const v4u uld = raw[6 * ks + 0]; float ld[8]; unpack8(uld, ld);
#pragma unroll
          for (int j = 0; j < 8; ++j) { float c = ld[j]; c += dpp_shr(c, 1); c += dpp_shr(c, 2); c += dpp_shr(c, 4); c += dpp_shr(c, 8);
              const float tot = __builtin_bit_cast(float, __builtin_amdgcn_ds_bpermute((lane | 15) << 2, __builtin_bit_cast(int, c)));
              ea[j] = __expf(c - ld[j]); er[j] = __expf(c); eb[j] = __expf(-c); eh[j] = __expf(tot - c);
              if (t == 0) GCl[off + j] = __expf(tot); } }
        { const v4u u = raw[6 * ks + 1]; float x[8]; unpack8(u, x);
#pragma unroll
          for (int j = 0; j < 8; ++j) { x[j] = -x[j] * ea[j]; ATt[(off + j) * 16 + t] = (bf16)f2bf(x[j]); }
          const v4u p = pack8(x); fAb[ks] = __builtin_bit_cast(bf16x8, p); }
        { const v4u u = raw[6 * ks + 2]; float x[8]; unpack8(u, x);
#pragma unroll
          for (int j = 0; j < 8; ++j) x[j] = x[j] * er[j];
          const v4u p = pack8(x); fRb[ks] = __builtin_bit_cast(bf16x8, p); *(LAS v4u*)(RBr + t * 64 + off) = p; }
        { const v4u u = raw[6 * ks + 3]; float x[8], y[8]; unpack8(u, x);
#pragma unroll
          for (int j = 0; j < 8; ++j) { y[j] = x[j] * eb[j]; BHt[(off + j) * 16 + t] = (bf16)f2bf(x[j] * eh[j]); }
          const v4u p = pack8(y); fBb[ks] = __builtin_bit_cast(bf16x8, p); }
        { const v4u u = raw[6 * ks + 4]; float x[8], y[8]; unpack8(u, x);
#pragma unroll
          for (int j = 0; j < 8; ++j) { y[j] = x[j] * eb[j]; KHt[(off + j) * 16 + t] = (bf16)f2bf(x[j] * eh[j]); }
          const v4u p = pack8(y); fKb[ks] = __builtin_bit_cast(bf16x8, p); }
        { const v4u u = raw[6 * ks + 5];
          const bf16 e0 = (bf16)(u.x & 0xffff), e1 = (bf16)(u.x >> 16), e2 = (bf16)(u.y & 0xffff), e3 = (bf16)(u.y >> 16), e4 = (bf16)(u.z & 0xffff), e5 = (bf16)(u.z >> 16), e6 = (bf16)(u.w & 0xffff), e7 = (bf16)(u.w >> 16);
          VTt[(off + 0) * 16 + t] = e0; VTt[(off + 1) * 16 + t] = e1; VTt[(off + 2) * 16 + t] = e2; VTt[(off + 3) * 16 + t] = e3; VTt[(off + 4) * 16 + t] = e4; VTt[(off + 5) * 16 + t] = e5; VTt[(off + 6) * 16 + t] = e6; VTt[(off + 7) * 16 + t] = e7; }
        __builtin_amdgcn_sched_barrier(0);
    }
    asm volatile("" ::: "memory");
    const f32x4 z4 = (f32x4){0.f, 0.f, 0.f, 0.f};
    f32x4 n0 = mma16(fAb[1], fBb[1], mma16(fAb[0], fBb[0], z4)), aak = mma16(fAb[1], fKb[1], mma16(fAb[0], fKb[0], z4));
    f32x4 arb = mma16(fRb[1], fBb[1], mma16(fRb[0], fBb[0], z4)), ark = mma16(fRb[1], fKb[1], mma16(fRb[0], fKb[0], z4));
#pragma unroll
    for (int r = 0; r < 4; ++r) { const int tt = 4 * kg + r; if (!(t < tt)) { n0[r] = 0.f; aak[r] = 0.f; } if (!(t <= tt)) { arb[r] = 0.f; ark[r] = 0.f; } }
    st_rowmaj(AK_r, aak, lane); st_rowmaj(RB2, arb, lane); st_rowmaj(RK_r, ark, lane); asm volatile("" ::: "memory");
    f32x4 accT = n0;
#pragma unroll
    for (int r = 0; r < 4; ++r) accT[r] += (4 * kg + r == t) ? 1.f : 0.f;
    f32x4 nn = n0;
#pragma unroll
    for (int itn = 0; itn < 3; ++itn) {
        st_rowmaj(N_r, nn, lane); st_colmaj(N_c, 0, nn, lane); st_rowmaj(T_r, accT, lane); asm volatile("" ::: "memory");
        const bf16x8 fa = frag16(N_r, 0, lane), fb = frag16(N_c, 0, lane), ft = frag16(T_r, 0, lane);
        nn = mma16(fa, fb, z4); asm volatile("" ::: "memory");
        st_colmaj(N_c, 0, nn, lane); asm volatile("" ::: "memory");
        const bf16x8 fb2 = frag16(N_c, 0, lane);
        accT = mma16(ft, fb2, accT); asm volatile("" ::: "memory");
    }
    st_rowmaj(T_r, accT, lane); asm volatile("" ::: "memory");
    const bf16x8 fT = frag16(T_r, 0, lane), fAK = frag16(AK_r, 0, lane), fARB = frag16(RB2, 0, lane), fARK = frag16(RK_r, 0, lane);
#pragma unroll
    for (int kt = 0; kt < 4; ++kt) { const f32x4 dd = mma16(fT, frag16(ATt, 16 * kt, lane), z4); st_colmaj(WAt, 16 * kt, dd, lane); } asm volatile("" ::: "memory");
    { const bf16x8 fArbT = frag16(RB2, 0, lane);
#pragma unroll
      for (int kt = 0; kt < 4; ++kt) { const v2u ri = *(const LAS v2u*)(RBr + t * 64 + 16 * kt + 4 * kg);
          f32x4 c0 = (f32x4){bflo(ri.x), bfhi(ri.x), bflo(ri.y), bfhi(ri.y)};
          c0 = mma16(frag16(WAt, 16 * kt, lane), fArbT, c0);
          v2u o; o.x = pk2(c0[0], c0[1]); o.y = pk2(c0[2], c0[3]); *(v2u*)(slot + RWS_QY + (t * 64 + 16 * kt + 4 * kg) * 2) = o; } }
    asm volatile("" ::: "memory");
#pragma unroll
    for (int vt = 0; vt < 4; ++vt) { const f32x4 dd = mma16(fAK, frag16(VTt, 16 * vt, lane), z4); st_colmaj(ATt, 16 * vt, dd, lane); } asm volatile("" ::: "memory");
    asm volatile("" ::: "memory");
    LAS bf16* UVt = RBr;
#pragma unroll
    for (int vt = 0; vt < 4; ++vt) { const f32x4 dd = mma16(fT, frag16(ATt, 16 * vt, lane), z4); st_colmaj(UVt, 16 * vt, dd, lane); } asm volatile("" ::: "memory");
#pragma unroll
    for (int vt = 0; vt < 4; ++vt) { const f32x4 dd = mma16(fARK, frag16(VTt, 16 * vt, lane), mma16(fARB, frag16(UVt, 16 * vt, lane), z4));
        v2u o; o.x = pk2(dd[0], dd[1]); o.y = pk2(dd[2], dd[3]); *(v2u*)(slot + RWS_YV + ((16 * vt + t) * 16 + 4 * kg) * 2) = o; }
#pragma unroll
    for (int ktp = 0; ktp < 4; ++ktp) { const bf16x8 fBh = frag16(BHt, 16 * ktp, lane);
#pragma unroll
        for (int kt = 0; kt < 4; ++kt) { f32x4 dd = mma16(frag16(WAt, 16 * kt, lane), fBh, z4);
            if (kt == ktp) {
#pragma unroll
                for (int r = 0; r < 4; ++r) if (4 * kg + r == t) dd[r] += GCl[16 * kt + t]; }
            v2u o; o.x = pk2(dd[0], dd[1]); o.y = pk2(dd[2], dd[3]); *(v2u*)(slot + RWS_PZ + ((16 * ktp + t) * 64 + 16 * kt + 4 * kg) * 2) = o; } }
#pragma unroll
    for (int vt = 0; vt < 4; ++vt) { const bf16x8 fU = frag16(UVt, 16 * vt, lane), fV = frag16(VTt, 16 * vt, lane);
#pragma unroll
        for (int ktp = 0; ktp < 4; ++ktp) { const f32x4 dd = mma16(frag16(KHt, 16 * ktp, lane), fV, mma16(frag16(BHt, 16 * ktp, lane), fU, z4));
            v2u o; o.x = pk2(dd[0], dd[1]); o.y = pk2(dd[2], dd[3]); *(v2u*)(slot + RWS_ZV + ((16 * vt + t) * 64 + 16 * ktp + 4 * kg) * 2) = o; } }
}
__device__ __forceinline__ void rw_chunk_task2(const Ctx& F, const v4u (&raw)[12], LAS unsigned char* wl, f32x4 (&yv)[4], f32x4 (&zv)[4][4]) {
    const LAS v4u* zp16 = (const LAS v4u*)(F.lds + LDS_ZERO16);
    const int lane = opaque_v(F.lane), t = lane & 15, kg = lane >> 4;
    LAS bf16* ATt = (LAS bf16*)(wl); LAS bf16* RBr = (LAS bf16*)(wl + 2048); LAS bf16* BHt = (LAS bf16*)(wl + 4096); LAS bf16* KHt = (LAS bf16*)(wl + 6144); LAS bf16* VTt = (LAS bf16*)(wl + 8192);
    LAS bf16* WAt = (LAS bf16*)(wl + 10240); LAS bf16* N_r = (LAS bf16*)(wl + 12288); LAS bf16* N_c = (LAS bf16*)(wl + 12800); LAS bf16* T_r = (LAS bf16*)(wl + 13312);
    LAS bf16* AK_r = (LAS bf16*)(wl + 13824); LAS bf16* RB2 = (LAS bf16*)(wl + 14336); LAS bf16* RK_r = (LAS bf16*)(wl + 14848); LAS float* GCl = (LAS float*)(wl + 15360);
    bf16x8 fAb[2], fRb[2], fBb[2], fKb[2];
#pragma unroll
    for (int ks = 0; ks < 2; ++ks) {
        const int off = 32 * ks + 8 * kg;
        float ea[8], er[8], eb[8], eh[8];
        { const v4u uld = raw[6 * ks + 0]; float ld[8]; unpack8(uld, ld);
#pragma unroll
          for (int j = 0; j < 8; ++j) { float c = ld[j]; c += dpp_shr(c, 1); c += dpp_shr(c, 2); c += dpp_shr(c, 4); c += dpp_shr(c, 8);
              const float tot = __builtin_bit_cast(float, __builtin_amdgcn_ds_bpermute((lane | 15) << 2, __builtin_bit_cast(int, c)));
              ea[j] = __expf(c - ld[j]); er[j] = __expf(c); eb[j] = __expf(-c); eh[j] = __expf(tot - c);
              if (t == 0) GCl[off + j] = __expf(tot); } }
        { const v4u u = raw[6 * ks + 1]; float x[8]; unpack8(u, x);
#pragma unroll
          for (int j = 0; j < 8; ++j) { x[j] = -x[j] * ea[j]; ATt[(off + j) * 16 + t] = (bf16)f2bf(x[j]); }
          const v4u p = pack8(x); fAb[ks] = __builtin_bit_cast(bf16x8, p); }
        { const v4u u = raw[6 * ks + 2]; float x[8]; unpack8(u, x);
#pragma unroll
          for (int j = 0; j < 8; ++j) x[j] = x[j] * er[j];
          const v4u p = pack8(x); fRb[ks] = __builtin_bit_cast(bf16x8, p); *(LAS v4u*)(RBr + t * 64 + off) = p; }
        { const v4u u = raw[6 * ks + 3]; float x[8], y[8]; unpack8(u, x);
#pragma unroll
          for (int j = 0; j < 8; ++j) { y[j] = x[j] * eb[j]; BHt[(off + j) * 16 + t] = (bf16)f2bf(x[j] * eh[j]); }
          const v4u p = pack8(y); fBb[ks] = __builtin_bit_cast(bf16x8, p); }
        { const v4u u = raw[6 * ks + 4]; float x[8], y[8]; unpack8(u, x);
#pragma unroll
          for (int j = 0; j < 8; ++j) { y[j] = x[j] * eb[j]; KHt[(off + j) * 16 + t] = (bf16)f2bf(x[j] * eh[j]); }
          const v4u p = pack8(y); fKb[ks] = __builtin_bit_cast(bf16x8, p); }
        { const v4u u = raw[6 * ks + 5];
          const bf16 e0 = (bf16)(u.x & 0xffff), e1 = (bf16)(u.x >> 16), e2 = (bf16)(u.y & 0xffff), e3 = (bf16)(u.y >> 16), e4 = (bf16)(u.z & 0xffff), e5 = (bf16)(u.z >> 16), e6 = (bf16)(u.w & 0xffff), e7 = (bf16)(u.w >> 16);
          VTt[(off + 0) * 16 + t] = e0; VTt[(off + 1) * 16 + t] = e1; VTt[(off + 2) * 16 + t] = e2; VTt[(off + 3) * 16 + t] = e3; VTt[(off + 4) * 16 + t] = e4; VTt[(off + 5) * 16 + t] = e5; VTt[(off + 6) * 16 + t] = e6; VTt[(off + 7) * 16 + t] = e7; }
        __builtin_amdgcn_sched_barrier(0);
    }
    asm volatile("" ::: "memory");
    const f32x4 z4 = (f32x4){0.f, 0.f, 0.f, 0.f};
    f32x4 n0 = mma16(fAb[1], fBb[1], mma16(fAb[0], fBb[0], z4)), aak = mma16(fAb[1], fKb[1], mma16(fAb[0], fKb[0], z4));
    f32x4 arb = mma16(fRb[1], fBb[1], mma16(fRb[0], fBb[0], z4)), ark = mma16(fRb[1], fKb[1], mma16(fRb[0], fKb[0], z4));
#pragma unroll
    for (int r = 0; r < 4; ++r) { const int tt = 4 * kg + r; if (!(t < tt)) { n0[r] = 0.f; aak[r] = 0.f; } if (!(t <= tt)) { arb[r] = 0.f; ark[r] = 0.f; } }
    st_rowmaj(AK_r, aak, lane); st_rowmaj(RB2, arb, lane); st_rowmaj(RK_r, ark, lane); asm volatile("" ::: "memory");
    f32x4 accT = n0;
#pragma unroll
    for (int r = 0; r < 4; ++r) accT[r] += (4 * kg + r == t) ? 1.f : 0.f;
    f32x4 nn = n0;
#pragma unroll
    for (int itn = 0; itn < 3; ++itn) {
        st_rowmaj(N_r, nn, lane); st_colmaj(N_c, 0, nn, lane); st_rowmaj(T_r, accT, lane); asm volatile("" ::: "memory");
        const bf16x8 fa = frag16(N_r, 0, lane), fb = frag16(N_c, 0, lane), ft = frag16(T_r, 0, lane);
        nn = mma16(fa, fb, z4); asm volatile("" ::: "memory");
        st_colmaj(N_c, 0, nn, lane); asm volatile("" ::: "memory");
        const bf16x8 fb2 = frag16(N_c, 0, lane);
        accT = mma16(ft, fb2, accT); asm volatile("" ::: "memory");
    }
    st_rowmaj(T_r, accT, lane); asm volatile("" ::: "memory");
    const bf16x8 fT = frag16(T_r, 0, lane), fAK = frag16(AK_r, 0, lane), fARB = frag16(RB2, 0, lane), fARK = frag16(RK_r, 0, lane);
#pragma unroll
    for (int kt = 0; kt < 4; ++kt) { const f32x4 dd = mma16(fT, frag16(ATt, 16 * kt, lane), z4); st_colmaj(WAt, 16 * kt, dd, lane); } asm volatile("" ::: "memory");
    f32x4 qy[4];
    { const bf16x8 fArbT = frag16(RB2, 0, lane);
#pragma unroll
      for (int kt = 0; kt < 4; ++kt) { const v2u ri = *(const LAS v2u*)(RBr + t * 64 + 16 * kt + 4 * kg);
          qy[kt] = mma16(frag16(WAt, 16 * kt, lane), fArbT, (f32x4){bflo(ri.x), bfhi(ri.x), bflo(ri.y), bfhi(ri.y)}); } }
    asm volatile("" ::: "memory");
#pragma unroll
    for (int vt = 0; vt < 4; ++vt) { const f32x4 dd = mma16(fAK, frag16(VTt, 16 * vt, lane), z4); st_colmaj(ATt, 16 * vt, dd, lane); } asm volatile("" ::: "memory");
    LAS bf16* UVt = RBr;
#pragma unroll
    for (int vt = 0; vt < 4; ++vt) { const f32x4 dd = mma16(fT, frag16(ATt, 16 * vt, lane), z4); st_colmaj(UVt, 16 * vt, dd, lane); } asm volatile("" ::: "memory");
#pragma unroll
    for (int vt = 0; vt < 4; ++vt) { const bf16x8 fU = frag16(UVt, 16 * vt, lane), fV = frag16(VTt, 16 * vt, lane);
        yv[vt] = mma16(fARK, fV, mma16(fARB, fU, z4));
#pragma unroll
        for (int ktp = 0; ktp < 4; ++ktp) zv[vt][ktp] = mma16(frag16(KHt, 16 * ktp, lane), fV, mma16(frag16(BHt, 16 * ktp, lane), fU, z4)); }
    f32x4 pz[4][4];
#pragma unroll
    for (int ktp = 0; ktp < 4; ++ktp) { const bf16x8 fBh = frag16(BHt, 16 * ktp, lane);
#pragma unroll
        for (int kt = 0; kt < 4; ++kt) { f32x4 dd = mma16(frag16(WAt, 16 * kt, lane), fBh, z4);
            if (kt == ktp) {
#pragma unroll
                for (int r = 0; r < 4; ++r) if (4 * kg + r == t) dd[r] += GCl[16 * kt + t]; }
            pz[ktp][kt] = dd; } }
    asm volatile("s_waitcnt lgkmcnt(0)" ::: "memory");
#pragma unroll
    for (int ktp = 0; ktp < 4; ++ktp) { LAS bf16* reg = (LAS bf16*)(wl + (ktp < 2 ? ktp * 2048 : (ktp + 1) * 2048));
#pragma unroll
        for (int kt = 0; kt < 4; ++kt) { v2u o; o.x = pk2(pz[ktp][kt][0], pz[ktp][kt][1]); o.y = pk2(pz[ktp][kt][2], pz[ktp][kt][3]); *(LAS v2u*)(reg + t * 64 + 16 * kt + 4 * kg) = o; } }
#pragma unroll
    for (int kt = 0; kt < 4; ++kt) { v2u o; o.x = pk2(qy[kt][0], qy[kt][1]); o.y = pk2(qy[kt][2], qy[kt][3]); *(LAS v2u*)(BHt + t * 64 + 16 * kt + 4 * kg) = o; }
    asm volatile("s_waitcnt lgkmcnt(0)" ::: "memory");
}
constexpr int RWZ_OFF = LDSCTL_OFF + 8192, RWF_OFF = LDSCTL_OFF + 2048;
__device__ __forceinline__ void rw_chunk_item2(const Ctx& F, int l, int it, size_t yoff = WS_YDIR) {
    const auto& a = *F.a; unsigned char* ws = a.ws; const int lane = opaque_v(F.lane), t = lane & 15, kg = lane >> 4;
    const int d = it & 1, h = (it >> 1) & 7, b = it >> 4;
    float* YD = (float*)(ws + yoff);
    LAS unsigned char* wl = F.lds + F.wave * 15616;
    LAS bf16* ZS = (LAS bf16*)(F.lds + RWZ_OFF);
    volatile LAS int* flag = (volatile LAS int*)(F.lds + RWF_OFF);
    for (int i = F.tid; i < 2048; i += NTHREADS) ((LAS unsigned*)ZS)[i] = 0u;
    if (F.tid == 0) *flag = 0;
    __syncthreads();
    constexpr int NCHK = (CTXL + SEQ) / 16;
    v4u raw[12];
    rw_chunk_load<0, 2>(F, b, h, d, F.wave, raw);
#pragma unroll 1
    for (int c = F.wave; c < NCHK; c += NWAVES) {
        f32x4 yv[4], zv[4][4];
        rw_chunk_task2(F, raw, wl, yv, zv);
        if (c + NWAVES < NCHK) rw_chunk_load<0, 2>(F, b, h, d, c + NWAVES, raw);
        while (*flag < c) __builtin_amdgcn_s_sleep(1);
        asm volatile("" ::: "memory");
        const LAS bf16* Zc = ZS + (c & 1) * 4096; LAS bf16* Zn = ZS + ((c + 1) & 1) * 4096;
        bf16x8 zb[4][2];
#pragma unroll
        for (int vb = 0; vb < 4; ++vb)
#pragma unroll
            for (int ks = 0; ks < 2; ++ks) zb[vb][ks] = *(const LAS bf16x8*)(Zc + (16 * vb + t) * 64 + 32 * ks + 8 * kg);
        { const LAS bf16* Qr = (const LAS bf16*)(wl + 4096); const bf16x8 q0 = *(const LAS bf16x8*)(Qr + t * 64 + 8 * kg), q1 = *(const LAS bf16x8*)(Qr + t * 64 + 32 + 8 * kg);
#pragma unroll
          for (int vb = 0; vb < 4; ++vb) { const f32x4 y = mma16(q1, zb[vb][1], mma16(q0, zb[vb][0], yv[vb]));
#pragma unroll
              for (int r = 0; r < 4; ++r) { const int row = seq_row(b, d, c * 16 + 4 * kg + r); YD[((size_t)d * T_ALL + row) * 512 + h * 64 + 16 * vb + t] = y[r]; } } }
#pragma unroll
        for (int ktp = 0; ktp < 4; ++ktp) { const LAS bf16* Pr = (const LAS bf16*)(wl + (ktp < 2 ? ktp * 2048 : (ktp + 1) * 2048));
            const bf16x8 p0 = *(const LAS bf16x8*)(Pr + t * 64 + 8 * kg), p1 = *(const LAS bf16x8*)(Pr + t * 64 + 32 + 8 * kg);
#pragma unroll
            for (int vb = 0; vb < 4; ++vb) { const f32x4 z = mma16(p1, zb[vb][1], mma16(p0, zb[vb][0], zv[vb][ktp]));
                v2u o; o.x = pk2(z[0], z[1]); o.y = pk2(z[2], z[3]); *(LAS v2u*)(Zn + (16 * vb + t) * 64 + 16 * ktp + 4 * kg) = o; } }
        asm volatile("s_waitcnt lgkmcnt(0)" ::: "memory");
        if (lane == 0) *flag = c + 1;
        asm volatile("s_waitcnt lgkmcnt(0)" ::: "memory");
    }
    __syncthreads();
}
__device__ __forceinline__ v2u ld_sc1_8(const void* p) { const unsigned long long v = __hip_atomic_load((const unsigned long long*)p, __ATOMIC_RELAXED, __HIP_MEMORY_SCOPE_AGENT); v2u o; o.x = (unsigned)v; o.y = (unsigned)(v >> 32); return o; }
__device__ __forceinline__ v4u ld_sc1_16(const void* p) { const v2u a = ld_sc1_8(p), b = ld_sc1_8((const char*)p + 8); return (v4u){a.x, a.y, b.x, b.y}; }
__device__ __forceinline__ void rw_chunk_item(const Ctx& F, int l, int it) {
    const auto& a = *F.a; unsigned char* ws = a.ws; const int lane = F.lane, t = lane & 15, kg = lane >> 4;
    const int d = it & 1, h = (it >> 1) & 7, b = it >> 4;
    float* YD = (float*)(ws + WS_YDIR);
    unsigned char* scr = ws + WS_RWSCR + (size_t)F.bid * 16 * RWS_SLOT;
    LAS unsigned char* wl = F.lds + F.wave * 15616;
    LAS bf16* ZL = (LAS bf16*)(F.lds + LDSCTL_OFF + 4096 + (F.wave & 3) * 2048);
    if (F.wave < 4) { for (int i = lane; i < 512; i += 64) ((LAS unsigned*)ZL)[i] = 0u; }
    asm volatile("" ::: "memory");
    constexpr int NCHK = (CTXL + SEQ) / 16, NB = NCHK / 16;
#pragma unroll 1
    for (int bt = 0; bt < NB; ++bt) {
        { v4u cur[12];
#pragma unroll 1
          for (int jj = 0; jj < 2; ++jj) { rw_chunk_load<0, 2>(F, b, h, d, bt * 16 + F.wave + 8 * jj, cur); rw_chunk_task(F, cur, wl, scr + (size_t)(F.wave + 8 * jj) * RWS_SLOT); } }
        asm volatile("s_waitcnt vmcnt(0)" ::: "memory");
        __syncthreads();
        {
            const int t = opaque_v(lane & 15), kg = opaque_v(lane >> 4), vb = opaque(F.wave) & 3;
            const unsigned char* scrb = F.a->ws + WS_RWSCR + (size_t)opaque(F.bid) * 16 * RWS_SLOT;
            LAS unsigned char* sbuf = F.lds;
            const int lt = opaque_v(F.tid) & 255; const bool loader = F.wave >= 4;
            const int lw = opaque(F.wave) & 3;
#define RWB_ISSUE(j_) do { const unsigned char* gp_ = scrb + (size_t)(j_) * RWS_SLOT + (size_t)(lw * 5) * 1024 + lane * 16; LAS unsigned char* lp_ = sbuf + ((j_) % 6) * RWS_SLOT + (lw * 5) * 1024; \
                _Pragma("unroll") for (int q = 0; q < 5; ++q) __builtin_amdgcn_global_load_lds((const unsigned*)(gp_ + q * 1024), (LAS unsigned*)(lp_ + q * 1024), 16, 0, 16); } while (0)
#define RWB_COMP(bi_, j_) do { const LAS unsigned char* sl_ = sbuf + (bi_) * RWS_SLOT; bf16x8 zb[2], qf[2]; \
                _Pragma("unroll") for (int ks = 0; ks < 2; ++ks) { zb[ks] = *(const LAS bf16x8*)(ZL + t * 64 + 32 * ks + 8 * kg); qf[ks] = *(const LAS bf16x8*)(sl_ + RWS_QY + (t * 64 + 32 * ks + 8 * kg) * 2); } \
                const v2u y_ = *(const LAS v2u*)(sl_ + RWS_YV + ((16 * vb + t) * 16 + 4 * kg) * 2); \
                f32x4 yacc = (f32x4){bflo(y_.x), bfhi(y_.x), bflo(y_.y), bfhi(y_.y)}; \
                yacc = mma16(qf[1], zb[1], mma16(qf[0], zb[0], yacc)); \
                f32x4 zn[4]; \
                _Pragma("unroll") for (int ktp = 0; ktp < 4; ++ktp) { const v2u z_ = *(const LAS v2u*)(sl_ + RWS_ZV + ((16 * vb + t) * 64 + 16 * ktp + 4 * kg) * 2); \
                    f32x4 zc = (f32x4){bflo(z_.x), bfhi(z_.x), bflo(z_.y), bfhi(z_.y)}; \
                    _Pragma("unroll") for (int ks = 0; ks < 2; ++ks) zc = mma16(*(const LAS bf16x8*)(sl_ + RWS_PZ + ((16 * ktp + t) * 64 + 32 * ks + 8 * kg) * 2), zb[ks], zc); \
                    zn[ktp] = zc; } \
                _Pragma("unroll") for (int r = 0; r < 4; ++r) { const int row = seq_row(b, d, (bt * 16 + (j_)) * 16 + 4 * kg + r); YD[((size_t)d * T_ALL + row) * 512 + h * 64 + 16 * vb + t] = yacc[r]; } \
                asm volatile("s_waitcnt lgkmcnt(0)" ::: "memory"); \
                _Pragma("unroll") for (int ktp = 0; ktp < 4; ++ktp) { v2u o; o.x = pk2(zn[ktp][0], zn[ktp][1]); o.y = pk2(zn[ktp][2], zn[ktp][3]); *(LAS v2u*)(ZL + t * 64 + 16 * ktp + 4 * kg) = o; } \
                asm volatile("s_waitcnt lgkmcnt(0)" ::: "memory"); } while (0)
#define RWB_BAR() do { asm volatile("s_waitcnt lgkmcnt(0)" ::: "memory"); __builtin_amdgcn_s_barrier(); asm volatile("" ::: "memory"); } while (0)
            if (loader) { RWB_ISSUE(0); RWB_ISSUE(1); RWB_ISSUE(2); RWB_ISSUE(3); asm volatile("s_waitcnt vmcnt(15)" ::: "memory"); }
            RWB_BAR();
#pragma unroll 1
            for (int j = 0; j < 16; ++j) {
                if (loader) { if (j + 4 < 16) { RWB_ISSUE(j + 4); asm volatile("s_waitcnt vmcnt(15)" ::: "memory"); } else { asm volatile("s_waitcnt vmcnt(0)" ::: "memory"); } }
                else { RWB_COMP(j % 6, j); }
                RWB_BAR();
            }
#undef RWB_BAR
#undef RWB_ISSUE
#undef RWB_COMP
        }
        __syncthreads();
    }
}

__device__ __forceinline__ void stage_rw_readout(const Ctx& F, int l) {
    const auto& a = *F.a; unsigned char* ws = a.ws; const int lane = F.lane;
    const bf16* SCN = (const bf16*)(ws + WS_SCN); const bf16* P = (const bf16*)(ws + WS_P); const float* YD = (const float*)(ws + WS_YDIR); bf16* YRW = (bf16*)(ws + WS_YRW);
    const int gw = F.bid * NWAVES + F.wave, NGW = F.G * NWAVES;
    constexpr int TR = 17, NRT = T_ALL / TR;
    for (int tile = gw; tile < NRT * 4; tile += NGW) {
        const int rt = tile % NRT, hp = tile / NRT, row0 = rt * TR, c0 = hp * 128 + 2 * lane;
        const f32x2 rk = *(const f32x2*)(a.in[I_RWRK] + l * 512 + c0), lng = *(const f32x2*)(a.in[I_RWLNG] + l * 512 + c0), lnb = *(const f32x2*)(a.in[I_RWLNB] + l * 512 + c0);
#pragma unroll 4
        for (int i = 0; i < TR; ++i) {
            const int row = row0 + i;
            const unsigned* sp = (const unsigned*)(SCN + (size_t)row * 9 * 512 + c0);
            const unsigned ru = sp[0], vu = sp[256], k0u = sp[4 * 256], k1u = sp[7 * 256];
            const f32x2 y0 = *(const f32x2*)(YD + (size_t)row * 512 + c0), y1 = *(const f32x2*)(YD + ((size_t)T_ALL + row) * 512 + c0);
            const unsigned gu = *(const unsigned*)(P + (size_t)row * 2560 + 2048 + c0);
            const float bon = red32(bflo(ru) * (bflo(k0u) + bflo(k1u)) * rk[0] + bfhi(ru) * (bfhi(k0u) + bfhi(k1u)) * rk[1]);
            f32x2 y = y0 + y1 + (f32x2){bflo(vu), bfhi(vu)} * bon;
            const float mu = red32(y[0] + y[1]) * (1.f / 64.f);
            y = y - mu;
            const float var = red32(y[0] * y[0] + y[1] * y[1]) * (1.f / 64.f);
            const f32x2 yn = y * (1.0f / sqrtf(var + 64e-5f));
            const f32x2 ov = (yn * lng + lnb) * (f32x2){bflo(gu), bfhi(gu)};
            *(unsigned*)(YRW + (size_t)row * 512 + c0) = pk2(ov[0], ov[1]);
        }
    }
}

constexpr size_t WS_S5E = 6 * MiB;
constexpr int S5_NSEG = 4, S5_SEGLEN = (CTXL + SEQ) / S5_NSEG;
__device__ __forceinline__ void s5_disc(const float are, const float aim, const float dt, float& lbr, float& lbi, float& cr, float& ci) {
    const float mag = expf(are * dt); lbr = mag * cosf(aim * dt); lbi = mag * sinf(aim * dt);
    const float den = are * are + aim * aim, nr = lbr - 1.0f; cr = (nr * are + lbi * aim) / den; ci = (lbi * are - nr * aim) / den;
}
template <int PASS>
__device__ __forceinline__ void stage_s5_scan(const Ctx& F, int l) {
    const auto& a = *F.a; unsigned char* ws = a.ws; const int lane = F.lane;
    const bf16* Z = (const bf16*)(ws + WS_Z); float* YP = (float*)(ws + WS_YP); f32x2* S5E = (f32x2*)(ws + WS_S5E);
    LAS unsigned char* wl = F.lds + F.wave * 16384;
    LAS float* buL = (LAS float*)wl;
    LAS bf16* Hs = (LAS bf16*)(wl + 8704);
    const int fr = lane & 15, kg = lane >> 4;
    for (int itx = F.bid * NWAVES + F.wave; itx < BATCH * 32 * 2 * S5_NSEG; itx += NWAVES * F.G) {
        const int seg = itx & (S5_NSEG - 1), it = itx >> 2;
        const int d = it & 1, g = (it >> 1) & 31, b = it >> 6, p = lane;
        const float dt = expf(a.in[I_S5LDT][(l * 2 + d) * 32 + g]);
        const float* arep = a.in[I_S5ARE] + ((size_t)(l * 2 + d) * 32 + g) * 64; const float* aimp = a.in[I_S5AIM] + ((size_t)(l * 2 + d) * 32 + g) * 64;
        float lbr, lbi, cr_, ci_; s5_disc(arep[p], aimp[p], dt, lbr, lbi, cr_, ci_);
        bf16x8 afr[2][4];
#pragma unroll
        for (int tl = 0; tl < 4; ++tl) { const int pp = 16 * tl + fr; float r0_, r1_, cr, ci; s5_disc(arep[pp], aimp[pp], dt, r0_, r1_, cr, ci);
            v4u pr = (v4u){0u, 0u, 0u, 0u}, pi = (v4u){0u, 0u, 0u, 0u};
            if (kg < 2) { const float* br = a.in[I_S5BRE] + (((size_t)l * 32 + g) * 64 + pp) * 16 + 8 * kg; const float* bi = a.in[I_S5BIM] + (((size_t)l * 32 + g) * 64 + pp) * 16 + 8 * kg;
                const f32x4 x0 = *(const f32x4*)br, x1 = *(const f32x4*)(br + 4), y0 = *(const f32x4*)bi, y1 = *(const f32x4*)(bi + 4);
                pr.x = pk2(cr * x0[0] - ci * y0[0], cr * x0[1] - ci * y0[1]); pr.y = pk2(cr * x0[2] - ci * y0[2], cr * x0[3] - ci * y0[3]);
                pr.z = pk2(cr * x1[0] - ci * y1[0], cr * x1[1] - ci * y1[1]); pr.w = pk2(cr * x1[2] - ci * y1[2], cr * x1[3] - ci * y1[3]);
                pi.x = pk2(cr * y0[0] + ci * x0[0], cr * y0[1] + ci * x0[1]); pi.y = pk2(cr * y0[2] + ci * x0[2], cr * y0[3] + ci * x0[3]);
                pi.z = pk2(cr * y1[0] + ci * x1[0], cr * y1[1] + ci * x1[1]); pi.w = pk2(cr * y1[2] + ci * x1[2], cr * y1[3] + ci * x1[3]); }
            afr[0][tl] = __builtin_bit_cast(bf16x8, pr); afr[1][tl] = __builtin_bit_cast(bf16x8, pi); }
        bf16x8 cf[4];
        f32x2 hst = (f32x2){0.f, 0.f};
        if (PASS == 1) {
#pragma unroll
            for (int kk = 0; kk < 4; ++kk) { const int p0 = 16 * kk + 4 * kg;
                const f32x4 c0 = *(const f32x4*)(a.in[I_S5CRE] + (((size_t)l * 32 + g) * 16 + fr) * 64 + p0), c1 = *(const f32x4*)(a.in[I_S5CIM] + (((size_t)l * 32 + g) * 16 + fr) * 64 + p0);
                v4u pk; pk.x = pk2(c0[0], -c1[0]); pk.y = pk2(c0[1], -c1[1]); pk.z = pk2(c0[2], -c1[2]); pk.w = pk2(c0[3], -c1[3]);
                cf[kk] = __builtin_bit_cast(bf16x8, pk); }
            float pr_ = lbr, pi_ = lbi, l64r = 1.f, l64i = 0.f;
#pragma unroll 1
            for (int q = 0; q < 10; ++q) { const float nr2 = pr_ * pr_ - pi_ * pi_, ni2 = 2.f * pr_ * pi_; pr_ = nr2; pi_ = ni2; if (q == 5) { l64r = pr_; l64i = pi_; } }
            const float lLr = pr_ * l64r - pi_ * l64i, lLi = pr_ * l64i + pi_ * l64r;
#pragma unroll 1
            for (int sgi = 0; sgi < seg; ++sgi) { const f32x2 ev = S5E[((size_t)it * S5_NSEG + sgi) * 64 + p];
                hst = (f32x2){lLr * hst[0] - lLi * hst[1] + ev[0], lLr * hst[1] + lLi * hst[0] + ev[1]}; }
        }
        const f32x2 lbr2 = (f32x2){lbr, lbr}, lbi2 = (f32x2){lbi, lbi};
        const int sbeg = seg * S5_SEGLEN, send = sbeg + S5_SEGLEN;
        v4u un = (v4u){0u, 0u, 0u, 0u}, un2 = un, un3 = un, uc;
#define S5_LOADU(dst_, s0_) do { if (kg < 2) { const int row_ = seq_row(b, d, (s0_) + fr); dst_ = *(const v4u*)(Z + (size_t)row_ * IN_COLS + S5_OFF + g * 16 + kg * 8); } } while (0)
        S5_LOADU(un, sbeg); S5_LOADU(un2, sbeg + 16); S5_LOADU(un3, sbeg + 32);
#pragma unroll 1
        for (int s0 = sbeg; s0 < send; s0 += 16) {
            uc = un; un = un2; un2 = un3;
            if (s0 + 48 < send) S5_LOADU(un3, s0 + 48);
            const bf16x8 ufr = __builtin_bit_cast(bf16x8, uc);
#pragma unroll
            for (int c = 0; c < 2; ++c)
#pragma unroll
                for (int tl = 0; tl < 4; ++tl) { const f32x4 dd = __builtin_amdgcn_mfma_f32_16x16x32_bf16(afr[c][tl], ufr, (f32x4){0.f, 0.f, 0.f, 0.f}, 0, 0, 0);
                    *(LAS f32x4*)(buL + (c * 16 + fr) * 68 + 16 * tl + 4 * kg) = dd; }
            LDS_WAIT(); asm volatile("" ::: "memory");
            f32x2 bu[16];
#pragma unroll
            for (int s = 0; s < 16; ++s) bu[s] = (f32x2){buL[s * 68 + p], buL[(16 + s) * 68 + p]};
#pragma unroll
            for (int s = 0; s < 16; ++s) {
                const f32x2 sw = (f32x2){-hst[1], hst[0]};
                hst = lbr2 * hst + (lbi2 * sw + bu[s]);
                if (PASS == 1) *(LAS unsigned*)(Hs + s * 136 + 2 * p) = pg8::cvt_pk_bf16(hst[0], hst[1]);
            }
            if (PASS == 1) {
                LDS_WAIT(); asm volatile("" ::: "memory");
                f32x4 acc = (f32x4){0.f, 0.f, 0.f, 0.f};
#pragma unroll
                for (int kk = 0; kk < 4; ++kk) { const bf16x8 af = *(const LAS bf16x8*)(Hs + fr * 136 + 32 * kk + 8 * kg); acc = __builtin_amdgcn_mfma_f32_16x16x32_bf16(af, cf[kk], acc, 0, 0, 0); }
#pragma unroll
                for (int r = 0; r < 4; ++r) { const int row = seq_row(b, d, s0 + 4 * kg + r); YP[((size_t)d * T_ALL + row) * 512 + g * 16 + fr] = acc[r]; }
            }
            LDS_WAIT(); asm volatile("" ::: "memory");
        }
        if (PASS == 0) S5E[((size_t)it * S5_NSEG + seg) * 64 + p] = hst;
#undef S5_LOADU
    }
}

__device__ __forceinline__ void stage_s5_prep(const Ctx& F, int l, int nrows) {
    const auto& a = *F.a; unsigned char* ws = a.ws;
    const bf16* Z = (const bf16*)(ws + WS_Z); const float* YP = (const float*)(ws + WS_YP); bf16* AS5 = (bf16*)(ws + WS_AS5);
    const int c = 4 * (F.tid & 127), rq = F.tid >> 7;
    const f32x4 dsk = *(const f32x4*)(a.in[I_S5D] + l * 512 + c);
#pragma unroll 4
    for (int row = F.bid * 4 + rq; row < nrows; row += F.G * 4) {
        const v2u uz = *(const v2u*)(Z + (size_t)row * IN_COLS + S5_OFF + c);
        const f32x4 y0 = *(const f32x4*)(YP + (size_t)row * 512 + c), y1 = *(const f32x4*)(YP + ((size_t)T_ALL + row) * 512 + c);
        const f32x4 u = (f32x4){bflo(uz.x), bfhi(uz.x), bflo(uz.y), bfhi(uz.y)};
        const f32x4 y = y0 + y1 + u * dsk;
        float ge[4];
#pragma unroll
        for (int j = 0; j < 4; ++j) ge[j] = 0.5f * y[j] * (1.f + tanh_fast(0.7978845608028654f * (y[j] + 0.044715f * y[j] * y[j] * y[j])));
        v2u o; o.x = pk2(ge[0], ge[1]); o.y = pk2(ge[2], ge[3]);
        *(v2u*)(AS5 + (size_t)row * 512 + c) = o;
    }
}

__device__ __forceinline__ void stage_hy_pre(const Ctx& F, int l, int nrows) {
    const auto& a = *F.a; unsigned char* ws = a.ws; const int lane = F.lane;
    const bf16* Z = (const bf16*)(ws + WS_Z); bf16* UT = (bf16*)(ws + WS_UT);
    LAS unsigned char* tl = F.lds + F.wave * 16384;
    const float* cw = a.in[I_HYCW] + (size_t)l * 3 * 1536; const float* cbp = a.in[I_HYCB] + l * 1536;
    const int gw = F.bid * NWAVES + F.wave, NGW = F.G * NWAVES;
    const int q = lane >> 3, k = lane & 7, ntile = (nrows / 64) * 24;
    v4u v[8], hv;
#define HYPRE_LOAD(tile_) do { const int rt_ = (tile_) / 24, ct_ = (tile_) % 24, row0_ = rt_ * 64; int base_, pos0_, n_; row_seq(row0_, base_, pos0_, n_); \
        const bf16* zt_ = Z + (size_t)row0_ * IN_COLS + HY_OFF + ct_ * 64 + 8 * k; hv = (v4u){0u, 0u, 0u, 0u}; \
        _Pragma("unroll") for (int i = 0; i < 8; ++i) v[i] = *(const v4u*)(zt_ + (size_t)(8 * i + q) * IN_COLS); \
        if (q == 0 && pos0_ > 0) hv = *(const v4u*)(zt_ - (size_t)IN_COLS); \
        if (q == 1 && pos0_ + 64 < n_) hv = *(const v4u*)(zt_ + (size_t)64 * IN_COLS); } while (0)
    if (gw < ntile) HYPRE_LOAD(gw);
#pragma unroll 1
    for (int tile = gw; tile < ntile; tile += NGW) {
        const int rt = tile / 24, ct = tile % 24, row0 = rt * 64, c0 = ct * 64;
        f32x4 wv[8];
#pragma unroll
        for (int i = 0; i < 8; ++i) { const int col = c0 + 8 * i + q; wv[i] = (f32x4){cw[col], cw[1536 + col], cw[2 * 1536 + col], cbp[col]}; }
#pragma unroll
        for (int i = 0; i < 8; ++i) { LAS unsigned* p = (LAS unsigned*)(tl + (1 + 8 * i + q) * 132 + 16 * k); p[0] = v[i].x; p[1] = v[i].y; p[2] = v[i].z; p[3] = v[i].w; }
        if (q < 2) { LAS unsigned* p = (LAS unsigned*)(tl + (q ? 65 : 0) * 132 + 16 * k); p[0] = hv.x; p[1] = hv.y; p[2] = hv.z; p[3] = hv.w; }
        if (tile + NGW < ntile) HYPRE_LOAD(tile + NGW);
        LDS_WAIT(); asm volatile("" ::: "memory");
#pragma unroll 2
        for (int i = 0; i < 8; ++i) {
            const int ch = 8 * i + q, col = c0 + ch;
            const LAS unsigned short* s = (const LAS unsigned short*)(tl + (8 * k) * 132 + ch * 2);
            float z[10];
#pragma unroll
            for (int t = 0; t < 10; ++t) z[t] = __builtin_bit_cast(float, (unsigned)s[t * 66] << 16);
            float o[8];
#pragma unroll
            for (int t = 0; t < 8; ++t) o[t] = wv[i][0] * z[t] + wv[i][1] * z[t + 1] + wv[i][2] * z[t + 2] + wv[i][3];
            v4u w; w.x = pk2(o[0], o[1]); w.y = pk2(o[2], o[3]); w.z = pk2(o[4], o[5]); w.w = pk2(o[6], o[7]);
            *(v4u*)(UT + (size_t)col * T_ALL + row0 + 8 * k) = w;
        }
        LDS_WAIT(); asm volatile("" ::: "memory");
    }
#undef HYPRE_LOAD
}
__device__ __forceinline__ void stage_hy_post(const Ctx& F, int l, int nrows) {
    const auto& a = *F.a; unsigned char* ws = a.ws; const int lane = F.lane;
    const bf16* YT = (const bf16*)(ws + WS_UT) + (size_t)1024 * T_ALL; bf16* YHY = (bf16*)(ws + WS_YHY);
    LAS unsigned char* tl = F.lds + F.wave * 16384;
    const int gw = F.bid * NWAVES + F.wave, NGW = F.G * NWAVES;
    const int q = lane >> 3, k = lane & 7, ntile = (nrows / 64) * 8;
    v4u v[8];
#define HYPOST_LOAD(tile_) do { const bf16* yp_ = YT + (size_t)(((tile_) & 7) * 64 + q) * T_ALL + ((tile_) >> 3) * 64 + 8 * k; \
        _Pragma("unroll") for (int i = 0; i < 8; ++i) v[i] = *(const v4u*)(yp_ + (size_t)(8 * i) * T_ALL); } while (0)
    if (gw < ntile) HYPOST_LOAD(gw);
#pragma unroll 1
    for (int tile = gw; tile < ntile; tile += NGW) {
        const int rt = tile >> 3, ct = tile & 7, row0 = rt * 64, c0 = ct * 64;
#pragma unroll
        for (int i = 0; i < 8; ++i) { LAS unsigned* p = (LAS unsigned*)(tl + (8 * i + q) * 132 + 16 * k); p[0] = v[i].x; p[1] = v[i].y; p[2] = v[i].z; p[3] = v[i].w; }
        if (tile + NGW < ntile) HYPOST_LOAD(tile + NGW);
        LDS_WAIT(); asm volatile("" ::: "memory");
#pragma unroll
        for (int i = 0; i < 8; ++i) { const int r = 8 * i + q;
            const LAS unsigned short* s = (const LAS unsigned short*)(tl + (8 * k) * 132 + r * 2);
            unsigned e[8];
#pragma unroll
            for (int j = 0; j < 8; ++j) e[j] = s[j * 66];
            v4u w; w.x = e[0] | (e[1] << 16); w.y = e[2] | (e[3] << 16); w.z = e[4] | (e[5] << 16); w.w = e[6] | (e[7] << 16);
            *(v4u*)(YHY + (size_t)(row0 + r) * 512 + c0 + 8 * k) = w; }
        LDS_WAIT(); asm volatile("" ::: "memory");
    }
#undef HYPOST_LOAD
}
typedef float f32x16 __attribute__((ext_vector_type(16)));
__device__ __forceinline__ void hyena_item(const Ctx& F, int l, int c, int isctx) {
    const auto& a = *F.a; unsigned char* ws = a.ws; const int tid = F.tid, lane = F.lane;
    const int n = isctx ? CTXL : SEQ, rowbase = isctx ? T_LAT : 0, RL = isctx ? HY_RLENC : HY_RLEN, off = n + 47;
    const bf16* UT = (const bf16*)(ws + WS_UT);
    const bf16* x1g = UT + (size_t)c * T_ALL + rowbase; const bf16* x2g = UT + (size_t)(512 + c) * T_ALL + rowbase; bf16* vg = (bf16*)UT + (size_t)(1024 + c) * T_ALL + rowbase;
    const bf16* Rg = (const bf16*)(ws + WS_GF + l * GF_STRIDE + (isctx ? GF_CTX : 0)) + (size_t)c * RL;
    LAS unsigned char* XB = F.lds; LAS unsigned char* R1 = F.lds + HY_R1_OFF; LAS unsigned char* R2 = F.lds + HY_R2_OFF;
    { const int cpb = n / 8;
      for (int q = tid; q < 8 * cpb; q += NTHREADS) { const int b = q / cpb, ch = q % cpb; *(LAS v4u*)(XB + b * HY_ROWB + 2 * HY_MARG + 16 * ch) = *(const v4u*)(vg + (size_t)b * n + 8 * ch); }
      if (tid < 256) { const int b = tid >> 5, side = (tid >> 4) & 1, ch = tid & 15; const unsigned zz = (unsigned)opaque_v(0); *(LAS v4u*)(XB + b * HY_ROWB + (side ? 2 * (HY_MARG + n) : 0) + 16 * ch) = (v4u){zz, zz, zz, zz}; }
      const int rch = RL / 8;
      for (int q = tid; q < rch; q += NTHREADS) { *(LAS v4u*)(R1 + 16 * q) = *(const v4u*)(Rg + 8 * q); *(LAS v4u*)(R2 + 16 * q) = *(const v4u*)(Rg + (size_t)512 * RL + 8 * q); } }
    __syncthreads();
    const int i = lane & 31, kg = lane >> 5, jb = lane & 3, bb = (lane & 31) >> 2;
    const int rsh = (off - i) & 7, rd = rsh >> 1; const bool s1 = rd & 1, s2 = rd & 2; const unsigned sh = (rsh & 1) ? 16u : 0u;
    const int aconst = 2 * (off - i + 8 * kg - rsh), bconst = bb * HY_ROWB + 2 * (HY_MARG + 32 * jb + 8 * kg);
    const int T0w = 512 * F.wave; const int ntile = (n - T0w) >= 512 ? 4 : ((n - T0w) > 0 ? (n - T0w) / 128 : 0);
    const float bias0 = a.in[I_HYBIAS][(l * 2 + 0) * 512 + c], bias1 = a.in[I_HYBIAS][(l * 2 + 1) * 512 + c];
    f32x16 acc[4];
    v2u y1p[4][4];
#define HY_AFRAG(wa, wb, afr) do { \
        const unsigned a0 = s1 ? wa.y : wa.x, a1 = s1 ? wa.z : wa.y, a2 = s1 ? wa.w : wa.z, a3 = s1 ? wb.x : wa.w, a4 = s1 ? wb.y : wb.x, a5 = s1 ? wb.z : wb.y, a6 = s1 ? wb.w : wb.z; \
        const unsigned b0 = s2 ? a2 : a0, b1 = s2 ? a3 : a1, b2 = s2 ? a4 : a2, b3 = s2 ? a5 : a3, b4 = s2 ? a6 : a4; \
        v4u af_; af_.x = __builtin_amdgcn_alignbit(b1, b0, sh); af_.y = __builtin_amdgcn_alignbit(b2, b1, sh); af_.z = __builtin_amdgcn_alignbit(b3, b2, sh); af_.w = __builtin_amdgcn_alignbit(b4, b3, sh); \
        afr = __builtin_bit_cast(bf16x8, af_); } while (0)
#define HY_STEP_COND(RB, d) do { \
        const v4u wa = *(const LAS v4u*)((RB) + aconst - 2 * (d)), wb = *(const LAS v4u*)((RB) + aconst - 2 * (d) + 16); bf16x8 afr; HY_AFRAG(wa, wb, afr); \
        _Pragma("unroll") for (int m = 0; m < 4; ++m) { const int T0 = T0w + 128 * m; \
            if (m < ntile && (d) >= T0 - n + 16 && (d) <= T0 + 96) { const bf16x8 bfr = *(const LAS bf16x8*)(XB + bconst + 2 * (T0 - (d))); \
                acc[m] = __builtin_amdgcn_mfma_f32_32x32x16_bf16(afr, bfr, acc[m], 0, 0, 0); } } } while (0)
#define HY_LOAD(RB, d, wa, wb, bq) do { wa = *(const LAS v4u*)((RB) + aconst - 2 * (d)); wb = *(const LAS v4u*)((RB) + aconst - 2 * (d) + 16); \
        _Pragma("unroll") for (int m = 0; m < 4; ++m) bq[m] = *(const LAS bf16x8*)(XB + bconst + 2 * (T0w + 128 * m - (d))); } while (0)
#define HY_MMA(wa, wb, bq) do { bf16x8 afr; HY_AFRAG(wa, wb, afr); \
        _Pragma("unroll") for (int m = 0; m < 4; ++m) acc[m] = __builtin_amdgcn_mfma_f32_32x32x16_bf16(afr, bq[m], acc[m], 0, 0, 0); } while (0)
#define HY_CONV(RB) do { \
        _Pragma("unroll") for (int m = 0; m < 4; ++m) _Pragma("unroll") for (int e = 0; e < 16; ++e) acc[m][e] = 0.f; \
        if (ntile == 4) { \
            const int dA = T0w - n + 16, dB = T0w + 384 - n + 16, dC = T0w + 96, dD = T0w + 384 + 96;     \
            _Pragma("unroll 1") for (int d = dA; d < dB; d += 16) HY_STEP_COND(RB, d); \
            { v4u waA, wbA, waB, wbB; bf16x8 bqA[4], bqB[4]; \
              HY_LOAD(RB, dB, waA, wbA, bqA); \
              _Pragma("unroll 1") for (int d = dB; d <= dC; d += 32) { \
                  if (d + 16 <= dC) HY_LOAD(RB, d + 16, waB, wbB, bqB); \
                  __builtin_amdgcn_sched_barrier(0); \
                  HY_MMA(waA, wbA, bqA); \
                  __builtin_amdgcn_sched_barrier(0); \
                  if (d + 32 <= dC) HY_LOAD(RB, d + 32, waA, wbA, bqA); \
                  __builtin_amdgcn_sched_barrier(0); \
                  if (d + 16 <= dC) HY_MMA(waB, wbB, bqB); \
                  __builtin_amdgcn_sched_barrier(0); } } \
            _Pragma("unroll 1") for (int d = dC + 16; d <= dD; d += 16) HY_STEP_COND(RB, d); \
        } else if (ntile > 0) { const int dhi = T0w + 128 * (ntile - 1) + 96; \
            _Pragma("unroll 1") for (int d = T0w - n + 16; d <= dhi; d += 16) HY_STEP_COND(RB, d); } } while (0)
    HY_CONV(R1);
#pragma unroll
    for (int m = 0; m < 4; ++m) if (m < ntile) {
#pragma unroll
        for (int rg = 0; rg < 4; ++rg) { const int t4 = T0w + 128 * m + 32 * jb + 8 * rg + 4 * kg;
            const v2u xv = *(const v2u*)(x1g + (size_t)bb * n + t4); const v2u vv = *(const LAS v2u*)(XB + bb * HY_ROWB + 2 * (HY_MARG + t4));
            const float y0 = bflo(xv.x) * (acc[m][4 * rg + 0] + bias0 * bflo(vv.x)), y1 = bfhi(xv.x) * (acc[m][4 * rg + 1] + bias0 * bfhi(vv.x));
            const float y2 = bflo(xv.y) * (acc[m][4 * rg + 2] + bias0 * bflo(vv.y)), y3 = bfhi(xv.y) * (acc[m][4 * rg + 3] + bias0 * bfhi(vv.y));
            y1p[m][rg].x = pk2(y0, y1); y1p[m][rg].y = pk2(y2, y3); } }
    __syncthreads();
#pragma unroll
    for (int m = 0; m < 4; ++m) if (m < ntile) {
#pragma unroll
        for (int rg = 0; rg < 4; ++rg) { const int t4 = T0w + 128 * m + 32 * jb + 8 * rg + 4 * kg; *(LAS v2u*)(XB + bb * HY_ROWB + 2 * (HY_MARG + t4)) = y1p[m][rg]; } }
    __syncthreads();
    HY_CONV(R2);
#pragma unroll
    for (int m = 0; m < 4; ++m) if (m < ntile) {
#pragma unroll
        for (int rg = 0; rg < 4; ++rg) { const int t4 = T0w + 128 * m + 32 * jb + 8 * rg + 4 * kg;
            const v2u xv = *(const v2u*)(x2g + (size_t)bb * n + t4); const v2u yv = y1p[m][rg];
            const float o0 = bflo(xv.x) * (acc[m][4 * rg + 0] + bias1 * bflo(yv.x)), o1 = bfhi(xv.x) * (acc[m][4 * rg + 1] + bias1 * bfhi(yv.x));
            const float o2 = bflo(xv.y) * (acc[m][4 * rg + 2] + bias1 * bflo(yv.y)), o3 = bfhi(xv.y) * (acc[m][4 * rg + 3] + bias1 * bfhi(yv.y));
            v2u ov; ov.x = pk2(o0, o1); ov.y = pk2(o2, o3); *(v2u*)(vg + (size_t)bb * n + t4) = ov; } }
    __syncthreads();
#undef HY_CONV
#undef HY_AFRAG
#undef HY_STEP_COND
#undef HY_LOAD
#undef HY_MMA
}
__device__ __forceinline__ void stage_mixer(const Ctx& F, int l) {
    unsigned* ctr = (unsigned*)(F.a->ws + WS_CTL) + CW_WORK + 64 * l;
    LAS int* itb = (LAS int*)(F.lds + LDSCTL_OFF + 512);
    const int nit = 128 + 512 + (l == 0 ? 512 : 0);
#ifdef PROBE_STATIC
    return;
#endif
    for (;;) {
        if (F.tid == 0) *itb = (int)__hip_atomic_fetch_add(ctr, 1u, __ATOMIC_RELAXED, __HIP_MEMORY_SCOPE_AGENT);
        __syncthreads();
        const int it = *itb;
        __syncthreads();
        if (it >= nit) break;
        Ctx Fi; Fi.a = kargs(); Fi.tid = opaque_v((int)threadIdx.x); Fi.lane = Fi.tid & 63; Fi.wave = __builtin_amdgcn_readfirstlane(Fi.tid >> 6); Fi.bid = opaque((int)blockIdx.x); Fi.G = opaque((int)gridDim.x);
        Fi.lds = (LAS unsigned char*)((LAS unsigned char*)0 + opaque(0)) + (F.lds - (LAS unsigned char*)0);
#ifdef PROBE_T
        if (l == 0 && F.tid == 0 && it == 5) ((unsigned long long*)(F.a->ws + WS_CTL + CW_STAMP * 4))[21] = __builtin_amdgcn_s_memrealtime();
        if (l == 0 && F.tid == 0 && it == 300) ((unsigned long long*)(F.a->ws + WS_CTL + CW_STAMP * 4))[23] = __builtin_amdgcn_s_memrealtime();
#endif
        if (it < 128) { for (int rep = 0; rep < ((DUPK == 9) ? 2 : 1); ++rep) rw_chunk_item2(Fi, opaque(l), it); }
        else if (it < 640) hyena_item(Fi, opaque(l), it - 128, 0);
        else hyena_item(Fi, opaque(l), it - 640, 1);
#ifdef PROBE_T
        if (l == 0 && F.tid == 0 && it == 5) ((unsigned long long*)(F.a->ws + WS_CTL + CW_STAMP * 4))[22] = __builtin_amdgcn_s_memrealtime();
        if (l == 0 && F.tid == 0 && it == 300) ((unsigned long long*)(F.a->ws + WS_CTL + CW_STAMP * 4))[24] = __builtin_amdgcn_s_memrealtime();
#endif
    }
}

typedef float f32x16r __attribute__((ext_vector_type(16)));
__device__ __forceinline__ void stage_norm2_router(const Ctx& F, int l, int nrows) {
    const auto& a = *F.a; unsigned char* ws = a.ws; const int lane = F.lane;
    const float* X = (const float*)(ws + WS_X); bf16* H = (bf16*)(ws + WS_H); const float* MOD = (const float*)(ws + WS_MOD);
    int* EIDX = (int*)(ws + WS_EIDX); float* GATE = (float*)(ws + WS_GATE); int* BLKCNT = (int*)(ws + WS_BLKCNT);
    LAS float* lg = (LAS float*)(F.lds + F.wave * 4352);
    LAS int* hist = (LAS int*)(F.lds + LDSCTL_OFF + 1024);
    if (F.tid < 32) hist[F.tid] = 0;
    __syncthreads();
    const int rpb = (nrows + F.G - 1) / F.G, r0 = F.bid * rpb, r1 = (r0 + rpb < nrows) ? r0 + rpb : nrows;
    const float* rw = a.in[I_RTW] + (size_t)l * 1024 * 32;
    const int i = lane & 31, kk = lane >> 5;
    const f32x4* ng = (const f32x4*)(a.in[I_N2G] + l * D) + kk;
    for (int rb = r0 + F.wave * 32; rb < r1; rb += NWAVES * 32) {
        const int nrow = (r1 - rb) < 32 ? (r1 - rb) : 32; const bool live = i < nrow;
        const int row = live ? rb + i : r1 - 1; const int w = row < T_LAT ? (row >> 12) : 8;
        const f32x4* xr = (const f32x4*)(X + (size_t)row * D) + kk;
        float ss = 0.f;
#pragma unroll 8
        for (int q = 0; q < 128; ++q) { const f32x4 v = xr[2 * q]; ss += (v[0] * v[0] + v[1] * v[1]) + (v[2] * v[2] + v[3] * v[3]); }
        ss += __builtin_bit_cast(float, __builtin_amdgcn_ds_bpermute((lane ^ 32) << 2, __builtin_bit_cast(int, ss)));
        const float rstd = 1.0f / sqrtf(ss * (1.f / D) + 1e-6f);
        const f32x4* sh = (const f32x4*)(MOD + (size_t)(l * 9 + w) * 6144 + 3072) + kk; const f32x4* sc = (const f32x4*)(MOD + (size_t)(l * 9 + w) * 6144 + 4096) + kk;
        v2u* ho = (v2u*)(H + (size_t)row * D) + kk;
        f32x16r acc;
#pragma unroll
        for (int e = 0; e < 16; ++e) acc[e] = 0.f;
        const float* wp = rw + (size_t)(4 * kk) * 32 + i;
#pragma unroll 2
        for (int q = 0; q < 128; ++q) {
            const f32x4 xv = xr[2 * q]; const f32x4 h4 = xv * rstd * ng[2 * q] * (sc[2 * q] + 1.0f) + sh[2 * q];
            const float w0 = wp[(size_t)(8 * q) * 32], w1 = wp[(size_t)(8 * q + 1) * 32], w2 = wp[(size_t)(8 * q + 2) * 32], w3 = wp[(size_t)(8 * q + 3) * 32];
            if (live) { v2u o; o.x = pk2(h4[0], h4[1]); o.y = pk2(h4[2], h4[3]); ho[2 * q] = o; }
            acc = __builtin_amdgcn_mfma_f32_32x32x2f32(h4[0], w0, acc, 0, 0, 0);
            acc = __builtin_amdgcn_mfma_f32_32x32x2f32(h4[1], w1, acc, 0, 0, 0);
            acc = __builtin_amdgcn_mfma_f32_32x32x2f32(h4[2], w2, acc, 0, 0, 0);
            acc = __builtin_amdgcn_mfma_f32_32x32x2f32(h4[3], w3, acc, 0, 0, 0);
        }
        const float rbias = a.in[I_RTB][l * 32 + i];
#pragma unroll
        for (int r = 0; r < 16; ++r) { const int ri = (r & 3) + 8 * (r >> 2) + 4 * kk; lg[ri * 33 + i] = acc[r] + rbias; }
        LDS_WAIT(); asm volatile("" ::: "memory");
        if (lane < nrow) {
            LAS float* lr = lg + lane * 33; const int orow = rb + lane;
            float tv[4]; int ti[4];
#pragma unroll
            for (int r = 0; r < 4; ++r) { float bv = -INFINITY; int bi = 0;
#pragma unroll 8
                for (int e = 0; e < 32; ++e) { const float v = lr[e]; if (v > bv) { bv = v; bi = e; } }
                tv[r] = bv; ti[r] = bi; lr[bi] = -INFINITY; }
            const float e1 = expf(tv[1] - tv[0]), e2 = expf(tv[2] - tv[0]), e3 = expf(tv[3] - tv[0]); const float inv = 1.0f / (1.0f + e1 + e2 + e3);
            *(int4*)(EIDX + orow * 4) = make_int4(ti[0], ti[1], ti[2], ti[3]); *(f32x4*)(GATE + orow * 4) = (f32x4){inv, e1 * inv, e2 * inv, e3 * inv};
#pragma unroll
            for (int r = 0; r < 4; ++r) __hip_atomic_fetch_add(&hist[ti[r]], 1, __ATOMIC_RELAXED, __HIP_MEMORY_SCOPE_WORKGROUP);
        }
        LDS_WAIT(); asm volatile("" ::: "memory");
    }
    __syncthreads();
    if (F.tid < 32) BLKCNT[F.bid * 32 + F.tid] = hist[F.tid];
    __syncthreads();
}

__device__ __forceinline__ void stage_moe_scatter(const Ctx& F, int l, int nrows) {
    const auto& a = *F.a; unsigned char* ws = a.ws; const int lane = F.lane;
    const bf16* H = (const bf16*)(ws + WS_H); bf16* XS = (bf16*)(ws + WS_XS);
    const int* EIDX = (const int*)(ws + WS_EIDX); int* POS = (int*)(ws + WS_POS); const int* BLKCNT = (const int*)(ws + WS_BLKCNT); int* META = (int*)(ws + WS_META);
    LAS int* tot = (LAS int*)F.lds; LAS int* off = tot + 32; LAS int* base = tot + 64; LAS int* posl = tot + 128; LAS int* eloc = tot + 4096;
    const int rpb = (nrows + F.G - 1) / F.G, r0 = F.bid * rpb, r1 = (r0 + rpb < nrows) ? r0 + rpb : nrows; const int na = (r1 > r0) ? (r1 - r0) * 4 : 0;
    for (int i = F.tid; i < na; i += NTHREADS) eloc[i] = EIDX[r0 * 4 + i];
    { LAS int* part = tot + 8192; const int e = F.tid & 31, pt = F.tid >> 5; int t = 0, o = 0;
      for (int b2 = pt; b2 < F.G; b2 += 16) { const int c = BLKCNT[b2 * 32 + e]; t += c; o += (b2 < F.bid) ? c : 0; }
      part[pt * 32 + e] = t; part[512 + pt * 32 + e] = o; }
    __syncthreads();
    if (F.tid < 32) { LAS int* part = tot + 8192; int t = 0, o = 0;
#pragma unroll
        for (int pt = 0; pt < 16; ++pt) { t += part[pt * 32 + F.tid]; o += part[512 + pt * 32 + F.tid]; }
        tot[F.tid] = t; off[F.tid] = o; }
    __syncthreads();
    if (F.tid == 0) { int acc = 0; for (int e = 0; e < 32; ++e) { base[e] = acc; acc += (tot[e] + 255) & ~255; } base[32] = acc; }
    __syncthreads();
    if (F.bid == 0 && F.tid < 33) META[F.tid] = base[F.tid];
    unsigned* ROWOF = (unsigned*)(ws + WS_ROWOF);
    if (F.tid < 32) { int run = base[F.tid] + off[F.tid]; for (int i = 0; i < na; ++i) { if (eloc[i] == F.tid) { POS[r0 * 4 + i] = run; ROWOF[run] = (unsigned)(r0 + (i >> 2)) * (unsigned)(D * 2); ++run; } } }
    for (int e = F.bid; e < 32; e += F.G) for (int i = base[e] + tot[e] + F.tid; i < base[e + 1]; i += NTHREADS) ROWOF[i] = 0u;
    __syncthreads();
}
__device__ __forceinline__ LAS int* load_moe_base(const Ctx& F) {
    LAS int* base = (LAS int*)(F.lds + LDSCTL_OFF + 256);
    const int* META = (const int*)(F.a->ws + WS_META);
    if (F.tid < 33) base[F.tid] = META[F.tid];
    __syncthreads();
    return base;
}

constexpr int NSTAGE_L = 13, NSTAGES = 1 + DEPTH * NSTAGE_L + 1;
__global__ void __launch_bounds__(NTHREADS, 2) mk_fwd(Args args) {
    extern __shared__ __attribute__((aligned(16))) unsigned char lds_raw[];
    Ctx F; F.a = kargs(); F.lds = (LAS unsigned char*)lds_raw; F.tid = threadIdx.x; F.lane = F.tid & 63; F.wave = __builtin_amdgcn_readfirstlane(F.tid >> 6); F.bid = blockIdx.x; F.G = gridDim.x;
    volatile LAS unsigned* MISC = (volatile LAS unsigned*)(F.lds + LDSCTL_OFF);
    for (int u = F.tid; u < (LDS_BYTES - LDSCTL_OFF) / 4; u += NTHREADS) ((LAS unsigned*)(F.lds + LDSCTL_OFF))[u] = 0u;
    __syncthreads();
#if MK_PER_STAGE
#define GRID_BAR() do { } while (0)
#else
    (void)xcd_barrier_post((unsigned*)(F.a->ws + WS_CTL) + CW_BAR, MISC + 8);
#define GRID_BAR() do { XcdBarrier b_; b_.bar = (unsigned*)(kargs()->ws + WS_CTL) + CW_BAR; b_.x = xb_xcc_id(); b_.st = (volatile LAS unsigned*)((LAS unsigned char*)lds_raw + LDSCTL_OFF + opaque(32)); xcd_barrier(b_); } while (0)
#endif
#ifndef ONLY_S
#define ONLY_S -1
#endif
#define STG_SEL(k) (ONLY_S < 0 || ONLY_S == (((k) == 0) ? 0 : ((k) == NSTAGES - 1 ? 14 : (((k) - 1) % NSTAGE_L) + 1)))
#if MK_PER_STAGE
#define IN(k) (STG_SEL(k) && kargs()->ph_lo == (k))
#else
#define IN(k) STG_SEL(k)
#endif
#if MK_PER_STAGE
#define SEAM(k) do { } while (0)
#else
#define SEAM(k) do { if ((k) + 1 < NSTAGES) GRID_BAR(); } while (0)
#endif
#define STAGE(k) if (IN(k)) { F.a = kargs(); F.tid = opaque_v((int)threadIdx.x); F.lane = F.tid & 63; F.wave = __builtin_amdgcn_readfirstlane(F.tid >> 6); F.bid = opaque((int)blockIdx.x); F.G = opaque((int)gridDim.x); F.lds = (LAS unsigned char*)lds_raw + opaque(0); unsigned char* ws = F.a->ws; const int l = opaque(lq); unsigned char* wl = ws + WS_WTS + (size_t)l * WL_STRIDE; (void)wl; (void)ws;
#define STAGE_END(k) } SEAM(k);
    int lq = 0;
    STAGE(0) p0_prologue(F); STAGE_END(0)
    for (lq = 0; lq < DEPTH; ++lq) {
        const int sb = 1 + lq * NSTAGE_L;
        const int nrl = opaque((lq == DEPTH - 1) ? T_LAT : T_ALL);
        STAGE(sb + 0) stage_norm1(F, l); STAGE_END(sb + 0)
        STAGE(sb + 1) pg8::SchedWin S; S.A = (const char*)(ws + WS_H); S.Bt = (const char*)(wl + WO_WIN); S.tstep = (size_t)256 * 1024 * 2; S.G = F.G; S.c = F.bid; S.part = (nrl != T_ALL); pg8::EpiBf16 E{(bf16*)(ws + WS_Z), IN_COLS, nullptr, 0};
            pg8::gemm_phase(F.lds, F.tid, 1024, S, E); STAGE_END(sb + 1)
        STAGE(sb + 2) for (int rep = 0; rep < REPN(1); ++rep) stage_rw_prep1(F, l); for (int rep = 0; rep < REPN(2); ++rep) stage_s5_scan<0>(F, l); for (int rep = 0; rep < REPN(3); ++rep) stage_hy_pre(F, l, nrl); STAGE_END(sb + 2)
        STAGE(sb + 3) { pg8::SchedStatic S; S.init(ws + WS_ARW, wl + WO_RWCAT, T_ALL, 2560, 256, F.G, F.bid); pg8::EpiBf16 E{(bf16*)(ws + WS_P), 2560, nullptr, 0}; PT(4); pg8::gemm_phase(F.lds, F.tid, 256, S, E); PT(5); }
            F.tid = opaque_v((int)threadIdx.x); F.lane = F.tid & 63;
            for (int rep = 0; rep < REPN(4); ++rep) stage_s5_scan<1>(F, l); STAGE_END(sb + 3)
        STAGE(sb + 4) for (int rep = 0; rep < REPN(5); ++rep) stage_rw_prep2(F, l); for (int rep = 0; rep < REPN(6); ++rep) stage_s5_prep(F, l, nrl); STAGE_END(sb + 4)
        STAGE(sb + 5) PT(10); stage_mixer(F, l); PT(11); STAGE_END(sb + 5) STAGE(sb + 5) PT(12); }
        STAGE(sb + 6) { pg8::SchedStatic S; S.init(ws + WS_AS5, wl + WO_GLU, nrl, 1024, 512, F.G, F.bid); pg8::EpiGlu<0> E{(bf16*)(ws + WS_YS5), 512, F.a->in[I_S5GLUB] + l * 1024, 0, 512}; PT(13); pg8::gemm_phase(F.lds, F.tid, 512, S, E); PT(14); }
            for (int rep = 0; rep < REPN(7); ++rep) stage_rw_readout(F, l); for (int rep = 0; rep < REPN(8); ++rep) stage_hy_post(F, l, nrl); STAGE_END(sb + 6)
        STAGE(sb + 7) pg8::SchedMerge S; S.A0 = (const char*)(ws + WS_YHY); S.A1 = (const char*)(ws + WS_YRW); S.A2 = (const char*)(ws + WS_YS5); S.Bt = (const char*)(wl + WO_WBR); S.tstep = (size_t)256 * 512 * 2; S.bstride = (size_t)1024 * 512 * 2;
            S.nM = nrl / 256; S.nN = 4; S.G = F.G; S.c = F.bid;
            pg8::EpiMerge E{(bf16*)(ws + WS_MTMP), (bf16*)(ws + WS_H), (const bf16*)(ws + WS_Z) + GATE_OFF}; pg8::gemm_phase(F.lds, F.tid, 512, S, E); STAGE_END(sb + 7)
        STAGE(sb + 8) pg8::SchedStatic S; S.init(ws + WS_H, wl + WO_WOUT, nrl, 1024, 1024, F.G, F.bid); pg8::EpiResid E{(float*)(ws + WS_X), (const float*)(ws + WS_MOD) + (size_t)l * 9 * 6144 + 2048};
            pg8::gemm_phase(F.lds, F.tid, 1024, S, E); STAGE_END(sb + 8)
        STAGE(sb + 9) PT(17); stage_norm2_router(F, l, nrl); PT(18); STAGE_END(sb + 9)
        STAGE(sb + 10) PT(19); stage_moe_scatter(F, l, nrl); PT(20); STAGE_END(sb + 10)
        STAGE(sb + 11) LAS int* base = load_moe_base(F);
            pg8::SchedMoeG S; S.A = (const char*)(ws + WS_H); S.rowof = (const unsigned*)(ws + WS_ROWOF); S.Bt = (const char*)(wl + WO_W1); S.tstep = (size_t)256 * 1024 * 2; S.estride = (size_t)2048 * 1024 * 2; S.NPN = 8; S.G = F.G; S.c = F.bid; S.base = base;
            pg8::EpiGlu<1> E{(bf16*)(ws + WS_ACT), 1024, F.a->in[I_B1] + (size_t)l * 32 * 2048, 2048, 1024}; pg8::gemm_phase(F.lds, F.tid, 1024, S, E); STAGE_END(sb + 11)
        STAGE(sb + 12) LAS int* base = load_moe_base(F);
            pg8::SchedMoe S; S.A = (const char*)(ws + WS_ACT); S.Bt = (const char*)(wl + WO_W2); S.tstep = (size_t)256 * 1024 * 2; S.estride = (size_t)1024 * 1024 * 2; S.NPN = 4; S.G = F.G; S.c = F.bid; S.base = base;
            pg8::EpiBf16 E{(bf16*)(ws + WS_XS), 1024, F.a->in[I_B2] + (size_t)l * 32 * 1024, 1024}; pg8::gemm_phase(F.lds, F.tid, 1024, S, E); STAGE_END(sb + 12)
    }
    lq = DEPTH;
    STAGE(NSTAGES - 1)
#ifndef PROBE_T
        stage_norm1(F, l);
#endif
#ifdef PROBE_T
        { const unsigned long long* st = (const unsigned long long*)(F.a->ws + WS_CTL + CW_STAMP * 4); const float cval = (float)(long long)(st[PROBE_B] - st[PROBE_A]) * (1.0f / (100.0f * PROBE_DIV));
          __syncthreads(); for (size_t i = (size_t)F.bid * NTHREADS + F.tid; i < (size_t)T_LAT * D; i += (size_t)F.G * NTHREADS) F.a->out[i] = cval; }
#endif
    }
#undef IN
#undef SEAM
}

extern "C" void kernel_launch(void* const* d_in, const int* in_sizes, int n_in, void* d_out, int out_size, void* d_ws, size_t ws_size, hipStream_t stream) {
    static int grid = 0;
    if (grid == 0) {
        if (n_in != 51 || out_size != T_LAT * D || ws_size < WS_END) { fprintf(stderr, "kernel_launch: unexpected shapes (n_in %d out %d ws %zu, need %zu)\n", n_in, out_size, ws_size, (size_t)WS_END); grid = -1; return; }
        int dev = 0, cus = 0, per_cu = 0;
        if (hipGetDevice(&dev) != hipSuccess || hipDeviceGetAttribute(&cus, hipDeviceAttributeMultiprocessorCount, dev) != hipSuccess) { grid = -1; return; }
        if (hipFuncSetAttribute((const void*)mk_fwd, hipFuncAttributeMaxDynamicSharedMemorySize, LDS_BYTES) != hipSuccess) { fprintf(stderr, "kernel_launch: hipFuncSetAttribute failed\n"); grid = -1; return; }
        if (hipOccupancyMaxActiveBlocksPerMultiprocessor(&per_cu, (const void*)mk_fwd, NTHREADS, LDS_BYTES) != hipSuccess || per_cu < 1) fprintf(stderr, "kernel_launch: occupancy query says %d\n", per_cu);
        (void)hipGetLastError();
        grid = cus;
    }
    if (grid < 0) return;
    if (hipMemsetAsync((char*)d_ws + WS_CTL, 0, CTL_ZERO_BYTES, stream) != hipSuccess) return;
    Args a{};
    for (int i = 0; i < 51; ++i) a.in[i] = (const float*)d_in[i];
    a.out = (float*)d_out; a.ws = (unsigned char*)d_ws;
#if MK_PER_STAGE
    for (int s = 0; s < NSTAGES; ++s) { a.ph_lo = s; a.ph_hi = s + 1; int reps = 1;
#ifdef PROBE_SET
        { const int ls = (s == 0 || s == NSTAGES - 1) ? -1 : (s - 1) % NSTAGE_L;
          if (PROBE_SET >= 1 && PROBE_SET <= 13 && ls == PROBE_SET - 1 && ls != 5 && ls != 8 && !(ls == 0 && s > 1)) reps = 3;
          if (PROBE_SET == 14 && s == 0) reps = 3; }
#endif
        for (int r = 0; r < reps; ++r) hipLaunchKernelGGL(mk_fwd, dim3(grid), dim3(NTHREADS), LDS_BYTES, stream, a); }
#else
    a.ph_lo = 0; a.ph_hi = NSTAGES; hipLaunchKernelGGL(mk_fwd, dim3(grid), dim3(NTHREADS), LDS_BYTES, stream, a);
#endif
}
```

```cpp
#include <hip/hip_runtime.h>
#include <cstdio>
#include <cstdint>

#ifndef DUPK
#define DUPK 0
#endif
#define REPN(k) ((DUPK == (k)) ? 3 : 1)
#ifndef REP_GEMM
#define REP_GEMM 1
#endif
#ifndef REP_LIGHT
#define REP_LIGHT 1
#endif
#ifndef REP_PRO
#define REP_PRO 1
#endif
#ifndef MK_PER_STAGE
#define MK_PER_STAGE 0
#endif

#define GAS __attribute__((address_space(1)))
#define LAS __attribute__((address_space(3)))
typedef unsigned short bf16;
typedef unsigned v4u __attribute__((ext_vector_type(4)));
typedef unsigned v2u __attribute__((ext_vector_type(2)));
typedef float f32x4 __attribute__((ext_vector_type(4)));
typedef float f32x2 __attribute__((ext_vector_type(2)));
typedef short bf16x8 __attribute__((ext_vector_type(8)));

constexpr int D = 1024, BATCH = 8, SEQ = 4096, CTXL = 256, DEPTH = 2;
constexpr int T_LAT = BATCH * SEQ, T_CTX = BATCH * CTXL, T_ALL = T_LAT + T_CTX;
constexpr int IN_COLS = 6912, HY_OFF = 0, RW_OFF = 1536, S5_OFF = 3328, GATE_OFF = 3840;
constexpr int NE = 32, TOPK = 4;
constexpr int MAXSLOT = 147456;
constexpr int NWAVES = 8, NTHREADS = 512;
constexpr int HY_MARG = 128, HY_ROWB = 8720, HY_RLEN = 8272, HY_RLENC = 592;
constexpr int HY_R1_OFF = 8 * HY_ROWB, HY_R2_OFF = HY_R1_OFF + HY_RLEN * 2;

constexpr size_t MiB = 1ull << 20;
constexpr size_t WS_CTL = 0, CTL_ZERO_BYTES = 1 * MiB;
constexpr size_t WS_MOD = 1 * MiB;
constexpr size_t WS_BLKCNT = 2 * MiB;
constexpr size_t WS_META = 2 * MiB + 512 * 1024;
constexpr size_t WS_ROWOF = 7 * MiB;
constexpr size_t WS_EIDX = 3 * MiB, WS_GATE = 4 * MiB, WS_POS = 5 * MiB;
constexpr size_t WS_WTS = 8 * MiB, WL_STRIDE = 214 * MiB;
constexpr size_t WO_WIN = 0, WO_RWCAT = 14 * MiB, WO_GLU = 16 * MiB, WO_WBR = 17 * MiB, WO_WOUT = 20 * MiB, WO_W1 = 22 * MiB, WO_W2 = 150 * MiB;
constexpr size_t WS_GF = 436 * MiB, GF_STRIDE = 20 * MiB, GF_CTX = 17 * MiB;
constexpr size_t WS_X = 504 * MiB;
constexpr size_t WS_H = 640 * MiB;
constexpr size_t WS_BIG = 708 * MiB;
constexpr size_t WS_Z = WS_BIG;
constexpr size_t WS_SCN = 1167 * MiB;
constexpr size_t WS_MTMP = WS_SCN;
constexpr size_t WS_P = 1473 * MiB;
constexpr size_t WS_ARW = 1643 * MiB;
constexpr size_t WS_YP = 1660 * MiB;
constexpr size_t WS_YDIR = WS_YP;
constexpr size_t WS_UT = 1796 * MiB;
constexpr size_t WS_AS5 = 2000 * MiB;
constexpr size_t WS_YHY = 1898 * MiB, WS_YRW = 1932 * MiB, WS_YS5 = 1966 * MiB;
constexpr size_t WS_XS = WS_BIG;
constexpr size_t WS_ACT = WS_BIG + 288 * MiB;
constexpr size_t WS_END = 2034 * MiB;
constexpr int CW_BAR = 4096;

constexpr int RING_BYTES = 131072;
constexpr int LDSCTL_OFF = RING_BYTES;
constexpr int LDS_BYTES = 163840;

typedef __bf16 bf16x2_t __attribute__((ext_vector_type(2)));
__device__ __forceinline__ unsigned pk2(float lo, float hi) { const bf16x2_t v = __builtin_convertvector((f32x2){lo, hi}, bf16x2_t); return __builtin_bit_cast(unsigned, v); }
__device__ __forceinline__ unsigned f2bf(float f) { return pk2(f, 0.f) & 0xffffu; }
__device__ __forceinline__ float bf2f(bf16 b) { return __builtin_bit_cast(float, ((unsigned)b) << 16); }
__device__ __forceinline__ float bflo(unsigned w) { return __builtin_bit_cast(float, w << 16); }
__device__ __forceinline__ float bfhi(unsigned w) { return __builtin_bit_cast(float, w & 0xffff0000u); }
__device__ __forceinline__ float sigm(float x) { return __builtin_amdgcn_rcpf(1.f + __expf(-x)); }
__device__ __forceinline__ float tanh_fast(float x) { const float e = __expf(2.f * x); return 1.f - 2.f * __builtin_amdgcn_rcpf(e + 1.f); }
#define LDS_WAIT() asm volatile("s_waitcnt lgkmcnt(0)" ::: "memory")
__device__ __forceinline__ float dpp_f(float x, const int ctrl_sel) {
    const int v = __builtin_bit_cast(int, x);
    int r;
    if (ctrl_sel == 0) r = __builtin_amdgcn_update_dpp(0, v, 0xB1, 0xF, 0xF, true);
    else if (ctrl_sel == 1) r = __builtin_amdgcn_update_dpp(0, v, 0x4E, 0xF, 0xF, true);
    else r = __builtin_amdgcn_update_dpp(0, v, 0x141, 0xF, 0xF, true);
    return __builtin_bit_cast(float, r);
}
__device__ __forceinline__ float red32(float x) {
    x += dpp_f(x, 0); x += dpp_f(x, 1); x += dpp_f(x, 2);
    x += __builtin_bit_cast(float, __builtin_amdgcn_update_dpp(0, __builtin_bit_cast(int, x), 0x128, 0xF, 0xF, true));
    x += __builtin_bit_cast(float, __builtin_amdgcn_ds_swizzle(__builtin_bit_cast(int, x), 0x401F));
    return x;
}
__device__ __forceinline__ float wave_sum(float v) {
    v = red32(v);
    return __builtin_bit_cast(float, __builtin_amdgcn_readlane(__builtin_bit_cast(int, v), 0)) + __builtin_bit_cast(float, __builtin_amdgcn_readlane(__builtin_bit_cast(int, v), 32));
}
__device__ __forceinline__ int xch32(int v, const int step) {
    if (step == 0) return __builtin_amdgcn_update_dpp(0, v, 0xB1, 0xF, 0xF, true);
    if (step == 1) return __builtin_amdgcn_update_dpp(0, v, 0x4E, 0xF, 0xF, true);
    if (step == 2) return __builtin_amdgcn_update_dpp(0, v, 0x141, 0xF, 0xF, true);
    if (step == 3) return __builtin_amdgcn_update_dpp(0, v, 0x128, 0xF, 0xF, true);
    return __builtin_amdgcn_ds_swizzle(v, 0x401F);
}
__device__ __forceinline__ float red8(float x) { x += dpp_f(x, 0); x += dpp_f(x, 1); x += dpp_f(x, 2); return x; }

#define XB_TMO      128
#define XB_XCNT(j)  (256  + 64 * (j))
#define XB_XSUB(j)  (1280 + 64 * (j))
#define XB_XGEN(j)  (2304 + 64 * (j))
#define XB_TOP      3328
#define XB_TOPGEN   3392
#define XCD_BAR_WORDS 3456
#define XB_SPIN_CAP (1u << 22)
__device__ __forceinline__ unsigned xb_ld(unsigned* p)              { return __hip_atomic_load(p, __ATOMIC_RELAXED, __HIP_MEMORY_SCOPE_AGENT); }
__device__ __forceinline__ unsigned xb_add(unsigned* p, unsigned v) { return __hip_atomic_fetch_add(p, v, __ATOMIC_RELAXED, __HIP_MEMORY_SCOPE_AGENT); }
__device__ __forceinline__ unsigned xb_xcc_id() { return (unsigned)__builtin_amdgcn_s_getreg((3 << 11) | 20) & 0xFu; }
#define XB_SPIN(cond, bar) do { unsigned _sp = 0; while (cond) { __builtin_amdgcn_s_sleep(1); \
    if ((++_sp & 255u) == 0u) { if (xb_ld(&(bar)[XB_TMO])) break; if (_sp > XB_SPIN_CAP) { atomicAdd(&(bar)[XB_TMO], 1u); break; } } } } while (0)
struct XcdBarrier { unsigned* bar; unsigned x; volatile LAS unsigned* st; };
__device__ __forceinline__ XcdBarrier xcd_barrier_post(unsigned* bar, volatile LAS unsigned* st) {
    XcdBarrier b; b.bar = bar; b.x = xb_xcc_id(); b.st = st;
    if (threadIdx.x == 0) (void)xb_add(&bar[XB_XCNT(b.x)], 1u);
    return b;
}
__device__ __forceinline__ void xcd_barrier_complete(unsigned* bar, unsigned x, unsigned& nloc, unsigned& nx) {
    const unsigned G = gridDim.x * gridDim.y * gridDim.z;
    unsigned sum, cnt, mine, sp = 0u;
    for (;;) {
        sum = 0u; cnt = 0u; mine = 0u;
#pragma unroll
        for (unsigned j = 0; j < 16; ++j) { const unsigned c = xb_ld(&bar[XB_XCNT(j)]); sum += c; cnt += (c > 0u) ? 1u : 0u; mine = (j == x) ? c : mine; }
        if (sum == G) break;
        __builtin_amdgcn_s_sleep(1);
        if ((++sp & 255u) == 0u) { if (xb_ld(&bar[XB_TMO])) break; if (sp > XB_SPIN_CAP) { atomicAdd(&bar[XB_TMO], 1u); break; } }
    }
    nloc = mine > 0u ? mine : 1u; nx = cnt > 0u ? cnt : 1u;
}
__device__ __forceinline__ void xcd_barrier(const XcdBarrier& b) {
    asm volatile("s_waitcnt vmcnt(0)" ::: "memory");
    __syncthreads();
    if (threadIdx.x == 0) {
        unsigned* bar = b.bar;
        __builtin_amdgcn_s_waitcnt(0);
        unsigned nloc = b.st[0], nx = b.st[1];
        if (nloc == 0u) { xcd_barrier_complete(bar, b.x, nloc, nx); b.st[0] = nloc; b.st[1] = nx; }
        const unsigned old = xb_add(&bar[XB_XSUB(b.x)], 1u);
        const unsigned gen = old / nloc;
        if (old + 1u == (gen + 1u) * nloc) {
            __builtin_amdgcn_fence(__ATOMIC_RELEASE, "agent");
            asm volatile("s_waitcnt vmcnt(0)" ::: "memory");
            const unsigned og = xb_add(&bar[XB_TOP], 1u);
            const unsigned tg = og / nx;
            if (og + 1u == (tg + 1u) * nx) xb_add(&bar[XB_TOPGEN], 1u);
            else XB_SPIN(xb_ld(&bar[XB_TOPGEN]) == tg, bar);
            __builtin_amdgcn_fence(__ATOMIC_ACQUIRE, "agent");
            xb_add(&bar[XB_XGEN(b.x)], 1u);
            asm volatile("s_waitcnt vmcnt(0)" ::: "memory");
        } else {
            XB_SPIN(xb_ld(&bar[XB_XGEN(b.x)]) == gen, bar);
            __builtin_amdgcn_fence(__ATOMIC_ACQUIRE, "agent");
            asm volatile("s_waitcnt vmcnt(0)" ::: "memory");
        }
    }
    __syncthreads();
}

namespace pg8 {
constexpr int BM = 256, BK = 64, HALF = 128, HTB = HALF * BK * 2, STAGE_BYTES = 8 * HTB, NXCD = 8, WGM = 8, ROWTAB_OFF = 131072 + 4096;
__host__ __device__ __forceinline__ int lds_byte(int r, int c) { const int st = (r >> 4) * 2 + (c >> 5), rr = r & 15, cc = c & 31, ob = rr * 64 + cc * 2; return st * 1024 + (ob ^ (((ob >> 9) & 1) << 5)); }
__host__ __device__ __forceinline__ void stage_rc(int b, int& R, int& C) { const int st = b / 1024, sb = b % 1024, swz = sb ^ (((sb >> 9) & 1) << 5); R = (st >> 1) * 16 + swz / 64; C = (st & 1) * 32 + (swz % 64) / 2; }
__host__ __device__ __forceinline__ int perm32(int rho) { const int n = rho >> 4, i = rho & 15; return 8 * (i >> 2) + 4 * n + (i & 3); }
struct Unit { int pm, pn, e; };
__device__ __forceinline__ unsigned cvt_pk_bf16(float lo, float hi) { return pk2(lo, hi); }

__device__ __forceinline__ void tile_of(int L, int nM, int nN, int& pm, int& pn) {
    const int nwg = nM * nN; int wgid = L;
    { const int q = nwg / NXCD, r = nwg % NXCD, xcd = wgid % NXCD, off = wgid / NXCD; wgid = (xcd < r ? xcd * (q + 1) : r * (q + 1) + (xcd - r) * q) + off; }
    const int nig = WGM * nN, gid = wgid / nig, fm = gid * WGM, gsz = (nM - fm) < WGM ? (nM - fm) : WGM;
    pm = fm + ((wgid % nig) % gsz); pn = (wgid % nig) / gsz;
}
struct SchedStatic {
    static constexpr bool GATHER = false;
    const char* A; const char* Bt; size_t tstep; int nM, nN, G, c;
    __device__ __forceinline__ void init(const void* A_, const void* Bt_, int M, int N, int K, int G_, int c_) { A = (const char*)A_; Bt = (const char*)Bt_; tstep = (size_t)BM * K * 2; nM = M / BM; nN = N / BM; G = G_; c = c_; }
    __device__ __forceinline__ bool next(int i, Unit& u) const { const long L = (long)i * G + c; if (L >= (long)nM * nN) return false; tile_of((int)L, nM, nN, u.pm, u.pn); u.e = 0; return true; }
    __device__ __forceinline__ const char* aptr(const Unit& u) const { return A + (size_t)u.pm * tstep; }
    __device__ __forceinline__ const char* bptr(const Unit& u) const { return Bt + (size_t)u.pn * tstep; }
};
struct SchedWin {
    static constexpr bool GATHER = false;
    const char* A; const char* Bt; size_t tstep; int G, c, part;
    __device__ __forceinline__ bool next(int i, Unit& u) const {
        const int L = i * G + c, nmf = part ? 128 : 136, nfull = nmf * 27; u.e = 0;
        if (L < nfull) { tile_of(L, nmf, 27, u.pm, u.pn); return true; }
        const int L2 = L - nfull; if (!part || L2 >= 8 * 9) return false;
        u.pm = 128 + L2 / 9; u.pn = 6 + L2 % 9; return true; }
    __device__ __forceinline__ const char* aptr(const Unit& u) const { return A + (size_t)u.pm * tstep; }
    __device__ __forceinline__ const char* bptr(const Unit& u) const { return Bt + (size_t)u.pn * tstep; }
};
struct SchedMerge {
    static constexpr bool GATHER = false;
    const char* A0; const char* A1; const char* A2; const char* Bt; size_t tstep, bstride; int nM, nN, G, c;
    __device__ __forceinline__ bool next(int i, Unit& u) const { const int j = i / 3, br = i - 3 * j; const long L = (long)j * G + c; if (L >= (long)nM * nN) return false; tile_of((int)L, nM, nN, u.pm, u.pn); u.e = br; return true; }
    __device__ __forceinline__ const char* aptr(const Unit& u) const { return (u.e == 0 ? A0 : (u.e == 1 ? A1 : A2)) + (size_t)u.pm * tstep; }
    __device__ __forceinline__ const char* bptr(const Unit& u) const { return Bt + (size_t)u.e * bstride + (size_t)u.pn * tstep; }
};
struct SchedMoe {
    static constexpr bool GATHER = false;
    const char* A; const char* Bt; size_t tstep, estride; int NPN, G, c; const LAS int* base;
    __device__ __forceinline__ bool next(int i, Unit& u) const {
        const int ntiles = base[32] >> 8; const int per = G >> 3;
        const long L = (long)i * G + (((G & 7) == 0) ? (c & 7) * per + (c >> 3) : c);
        if (L >= (long)ntiles * NPN) return false;
        u.pm = (int)(L / NPN); u.pn = (int)(L % NPN); const int r0 = u.pm << 8; int e = 0;
#pragma unroll 1
        for (int k = 1; k < 32; ++k) e += (r0 >= base[k]) ? 1 : 0;
        u.e = e; return true;
    }
    __device__ __forceinline__ const char* aptr(const Unit& u) const { return A + (size_t)u.pm * tstep; }
    __device__ __forceinline__ const char* bptr(const Unit& u) const { return Bt + (size_t)u.e * estride + (size_t)u.pn * tstep; }
};
struct SchedMoeG : SchedMoe {
    static constexpr bool GATHER = true;
    const unsigned* rowof;
    __device__ __forceinline__ const char* aptr(const Unit&) const { return A; }
};

template <class Epi, class Sched>
__device__ __forceinline__ void gemm_phase(LAS unsigned char* lds, const int tid, const int K, const Sched& S, const Epi& E) {
    const int wid = __builtin_amdgcn_readfirstlane(tid >> 6), lane = tid & 63, wr = wid >> 2, wc = wid & 3, fr = lane & 15, fq = lane >> 4;
    const int nt = K / BK;
    unsigned voffA[2], voffB[2];
#pragma unroll
    for (int i = 0; i < 2; ++i) { int R, C; stage_rc(tid * 16 + i * 8192, R, C); const int Rb = Epi::PERM ? ((R & ~31) + perm32(R & 31)) : R;
        voffA[i] = (unsigned)(R * K + C) * 2u; voffB[i] = (unsigned)(Rb * K + C) * 2u; }
    const size_t kstep = (size_t)(BK * 2);
    const size_t hstep = (size_t)HALF * K * 2;
    const unsigned ldsw = (unsigned)wid * 1024u;
    const int aoff = lds_byte(wr * 64 + fr, fq * 8), boff = lds_byte(wc * 32 + fr, fq * 8);
#define PG8_SA(b, h) (((b) * 2 + (h)) * HTB)
#define PG8_SB(b, h) ((4 + (b) * 2 + (h)) * HTB)
#define PG8_STAGE(bufoff, gbase, voff) do { _Pragma("unroll") for (int _i = 0; _i < 2; ++_i) \
        __builtin_amdgcn_global_load_lds((const unsigned*)((const char*)(gbase) + (voff)[_i]), (LAS unsigned*)(lds + (bufoff) + ldsw + _i * 8192), 16, 0, 0); } while (0)
#define PG8_STAGEA(bufoff, kp, h) do { if constexpr (Sched::GATHER) { _Pragma("unroll") for (int _i = 0; _i < 2; ++_i) \
        __builtin_amdgcn_global_load_lds((const unsigned*)((const char*)(kp) + g[2 * (h) + _i]), (LAS unsigned*)(lds + (bufoff) + ldsw + _i * 8192), 16, 0, 0); } \
        else { PG8_STAGE(bufoff, (kp) + (h) * hstep, voffA); } } while (0)
#define PG8_GLOAD(buf) do { const LAS unsigned* rt_ = (const LAS unsigned*)(lds + ROWTAB_OFF + (buf) * 1024) + gR0; _Pragma("unroll") for (int _j = 0; _j < 4; ++_j) g[_j] = rt_[64 * _j] + gCb; } while (0)
#define PG8_GDMA(pm_, buf) do { if (wid == 0) __builtin_amdgcn_global_load_lds((const unsigned*)(S.rowof + (size_t)(pm_) * 256 + lane * 4), (LAS unsigned*)(lds + ROWTAB_OFF + (buf) * 1024), 16, 0, 0); } while (0)
#define PG8_LDA(dst, b, h) do { _Pragma("unroll") for (int m = 0; m < 4; ++m) _Pragma("unroll") for (int k = 0; k < 2; ++k) dst[m][k] = *(const LAS bf16x8*)(lds + PG8_SA(b, h) + aoff + m * 2048 + k * 1024); } while (0)
#define PG8_LDB(dst, b, h) do { _Pragma("unroll") for (int n = 0; n < 2; ++n) _Pragma("unroll") for (int k = 0; k < 2; ++k) dst[n][k] = *(const LAS bf16x8*)(lds + PG8_SB(b, h) + boff + n * 2048 + k * 1024); } while (0)
#define PG8_MMA(ai, bj, At, Bt) do { __builtin_amdgcn_s_setprio(1); _Pragma("unroll") for (int m = 0; m < 4; ++m) _Pragma("unroll") for (int n = 0; n < 2; ++n) _Pragma("unroll") for (int k = 0; k < 2; ++k) \
        acc[ai][bj][m][n] = __builtin_amdgcn_mfma_f32_16x16x32_bf16(Bt[n][k], At[m][k], acc[ai][bj][m][n], 0, 0, 0); __builtin_amdgcn_s_setprio(0); } while (0)
#define PG8_WAIT_V(n) asm volatile("s_waitcnt vmcnt(" #n ")" ::: "memory")
#define PG8_WAIT_L(n) asm volatile("s_waitcnt lgkmcnt(" #n ")" ::: "memory")
#define PG8_BAR __builtin_amdgcn_s_barrier()
#define PG8_SCHED __builtin_amdgcn_sched_barrier(0)
    Unit cur, nxt; int ui = 0;
    if (!S.next(0, cur)) return;
    f32x4 acc[2][2][4][2];
#pragma unroll
    for (int a = 0; a < 2; ++a)
#pragma unroll
        for (int b = 0; b < 2; ++b)
#pragma unroll
            for (int m = 0; m < 4; ++m)
#pragma unroll
                for (int n = 0; n < 2; ++n) acc[a][b][m][n] = (f32x4){0.f, 0.f, 0.f, 0.f};
    bf16x8 At[4][2], B0[2][2], B1[2][2];
    const char* cA = S.aptr(cur); const char* cB = S.bptr(cur);
    unsigned g[4] = {0u, 0u, 0u, 0u}; int gR0 = 0; unsigned gCb = 0u;
    if constexpr (Sched::GATHER) { int R, C; stage_rc(tid * 16, R, C); gR0 = R; gCb = (unsigned)C * 2u;
        PG8_GDMA(cur.pm, 0); PG8_WAIT_V(0); PG8_BAR; PG8_GLOAD(0); }
    PG8_STAGE(PG8_SB(0, 0), cB, voffB); PG8_STAGE(PG8_SB(0, 1), cB + hstep, voffB); PG8_STAGEA(PG8_SA(0, 0), cA, 0); PG8_STAGEA(PG8_SA(0, 1), cA, 1);
    if (wr == 1) PG8_BAR;
    PG8_WAIT_V(2); PG8_BAR;
    PG8_STAGE(PG8_SB(1, 0), cB + kstep, voffB); PG8_STAGEA(PG8_SA(1, 0), cA + kstep, 0); PG8_STAGE(PG8_SB(1, 1), cB + hstep + kstep, voffB);
    PG8_WAIT_V(6); PG8_BAR;
    for (;;) {
        const bool has_next = S.next(ui + 1, nxt);
        const char* nA = has_next ? S.aptr(nxt) : cA; const char* nB = has_next ? S.bptr(nxt) : cB;
        if constexpr (Sched::GATHER) { if (has_next) PG8_GDMA(nxt.pm, (ui + 1) & 1); }
        for (int t = 0; t < nt; t += 2) {
            const bool last = (t == nt - 2);
            const char* a1 = cA + (size_t)(t + 1) * kstep;
            const char* a2 = last ? nA : cA + (size_t)(t + 2) * kstep; const char* b2 = last ? nB : cB + (size_t)(t + 2) * kstep;
            const char* a3 = a2 + kstep; const char* b3 = b2 + kstep;
            PG8_LDB(B0, 0, 0); PG8_LDB(B1, 0, 1); PG8_SCHED; PG8_LDA(At, 0, 0); PG8_STAGEA(PG8_SA(1, 1), a1, 1);
            PG8_WAIT_V(8); PG8_WAIT_L(0); PG8_BAR; PG8_MMA(0, 0, At, B0); PG8_MMA(0, 1, At, B1); PG8_BAR; PG8_SCHED;
            if constexpr (Sched::GATHER) { if (last && has_next) PG8_GLOAD((ui + 1) & 1); PG8_SCHED; }
            PG8_LDA(At, 0, 1); PG8_STAGE(PG8_SB(0, 0), b2, voffB); PG8_STAGE(PG8_SB(0, 1), b2 + hstep, voffB); PG8_STAGEA(PG8_SA(0, 0), a2, 0);
            PG8_WAIT_V(8); PG8_WAIT_L(0); PG8_BAR; PG8_MMA(1, 0, At, B0); PG8_MMA(1, 1, At, B1); PG8_BAR; PG8_SCHED;
            PG8_LDB(B0, 1, 0); PG8_LDB(B1, 1, 1); PG8_SCHED; PG8_LDA(At, 1, 0); PG8_STAGEA(PG8_SA(0, 1), a2, 1);
            PG8_WAIT_V(8); PG8_WAIT_L(0); PG8_BAR; PG8_MMA(0, 0, At, B0); PG8_MMA(0, 1, At, B1); PG8_BAR; PG8_SCHED;
            PG8_LDA(At, 1, 1); PG8_STAGE(PG8_SB(1, 0), b3, voffB); PG8_STAGE(PG8_SB(1, 1), b3 + hstep, voffB); PG8_STAGEA(PG8_SA(1, 0), a3, 0);
            PG8_WAIT_V(8); PG8_WAIT_L(0); PG8_BAR; PG8_MMA(1, 0, At, B0); PG8_MMA(1, 1, At, B1); PG8_BAR; PG8_SCHED;
        }
        if (wr == 0) PG8_BAR;
        { int t2_ = (int)threadIdx.x; asm volatile("" : "+v"(t2_)); E(acc, cur, wr, wc, t2_ & 15, (t2_ >> 4) & 3); }
        if (!has_next) break;
#pragma unroll
        for (int a = 0; a < 2; ++a)
#pragma unroll
            for (int b = 0; b < 2; ++b)
#pragma unroll
                for (int m = 0; m < 4; ++m)
#pragma unroll
                    for (int n = 0; n < 2; ++n) acc[a][b][m][n] = (f32x4){0.f, 0.f, 0.f, 0.f};
        cur = nxt; cA = nA; cB = nB; ++ui;
        if (wr == 1) PG8_BAR;
    }
    PG8_WAIT_V(0);
    PG8_BAR;
#undef PG8_SA
#undef PG8_SB
#undef PG8_STAGE
#undef PG8_STAGEA
#undef PG8_GLOAD
#undef PG8_GDMA
#undef PG8_LDA
#undef PG8_LDB
#undef PG8_MMA
#undef PG8_WAIT_V
#undef PG8_WAIT_L
#undef PG8_BAR
#undef PG8_SCHED
}

struct EpiBf16 {
    static constexpr bool PERM = true;
    bf16* O; int ldc; const float* bias; int bias_stride;
    __device__ __forceinline__ void operator()(const f32x4 (&acc)[2][2][4][2], const Unit& u, int wr, int wc, int fr, int fq) const {
        const int row0 = u.pm * BM + wr * 64 + fr, col0 = u.pn * BM + wc * 32 + 8 * fq;
        f32x4 bv[2][2];
#pragma unroll
        for (int bj = 0; bj < 2; ++bj)
#pragma unroll
            for (int n = 0; n < 2; ++n) bv[bj][n] = bias ? *(const f32x4*)(bias + (size_t)u.e * bias_stride + col0 + bj * HALF + 4 * n) : (f32x4){0.f, 0.f, 0.f, 0.f};
#pragma unroll
        for (int ai = 0; ai < 2; ++ai)
#pragma unroll
            for (int m = 0; m < 4; ++m) { bf16* rowp = O + (size_t)(row0 + ai * HALF + m * 16) * ldc + col0;
#pragma unroll
                for (int bj = 0; bj < 2; ++bj) { const f32x4 v0 = acc[ai][bj][m][0] + bv[bj][0], v1 = acc[ai][bj][m][1] + bv[bj][1];
                    v4u w; w.x = cvt_pk_bf16(v0[0], v0[1]); w.y = cvt_pk_bf16(v0[2], v0[3]); w.z = cvt_pk_bf16(v1[0], v1[1]); w.w = cvt_pk_bf16(v1[2], v1[3]);
                    *(v4u*)(rowp + bj * HALF) = w; } }
    }
};
template <int MODE> struct EpiGlu {
    static constexpr bool PERM = true;
    bf16* O; int ldc; const float* bias; int bias_stride, hs;
    __device__ __forceinline__ void operator()(const f32x4 (&acc)[2][2][4][2], const Unit& u, int wr, int wc, int fr, int fq) const {
        const int row0 = u.pm * BM + wr * 64 + fr, col0 = u.pn * HALF + wc * 32 + 8 * fq;
        const float* bp = bias + (size_t)u.e * bias_stride + col0;
        f32x4 ba[2], bb[2];
#pragma unroll
        for (int n = 0; n < 2; ++n) { ba[n] = *(const f32x4*)(bp + 4 * n); bb[n] = *(const f32x4*)(bp + hs + 4 * n); }
#pragma unroll
        for (int ai = 0; ai < 2; ++ai)
#pragma unroll
            for (int m = 0; m < 4; ++m) { bf16* rowp = O + (size_t)(row0 + ai * HALF + m * 16) * ldc + col0;
                float o[8];
#pragma unroll
                for (int n = 0; n < 2; ++n) { const f32x4 a = acc[ai][0][m][n] + ba[n], b = acc[ai][1][m][n] + bb[n];
#pragma unroll
                    for (int j = 0; j < 4; ++j) {
                        if (MODE == 0) o[4 * n + j] = a[j] * sigm(b[j]);
                        else { const float g = fminf(a[j], 7.f), up = fminf(fmaxf(b[j], -7.f), 7.f); o[4 * n + j] = (up + 1.f) * g * sigm(1.702f * g); } } }
                v4u w; w.x = cvt_pk_bf16(o[0], o[1]); w.y = cvt_pk_bf16(o[2], o[3]); w.z = cvt_pk_bf16(o[4], o[5]); w.w = cvt_pk_bf16(o[6], o[7]);
                *(v4u*)rowp = w; }
    }
};
struct EpiMerge {
    static constexpr bool PERM = true;
    bf16* mtmp; bf16* Mo; const bf16* zg;
    __device__ __forceinline__ void operator()(const f32x4 (&acc)[2][2][4][2], const Unit& u, int wr, int wc, int fr, int fq) const {
        const int row0 = u.pm * BM + wr * 64 + fr, col0 = u.pn * BM + wc * 32 + 8 * fq;
#pragma unroll
        for (int ai = 0; ai < 2; ++ai)
#pragma unroll
            for (int m = 0; m < 4; ++m) { const size_t r = (size_t)(row0 + ai * HALF + m * 16);
#pragma unroll
                for (int bj = 0; bj < 2; ++bj) { const int c = col0 + bj * HALF;
                    const v4u gz = *(const v4u*)(zg + r * IN_COLS + u.e * 1024 + c);
                    float g[8] = {bflo(gz.x), bfhi(gz.x), bflo(gz.y), bfhi(gz.y), bflo(gz.z), bfhi(gz.z), bflo(gz.w), bfhi(gz.w)};
                    f32x4 t0, t1; bf16* tp = mtmp + r * 1024 + c;
                    if (u.e == 0) { t0 = (f32x4){0.f, 0.f, 0.f, 0.f}; t1 = t0; } else { const v4u pv = *(const v4u*)tp; t0 = (f32x4){bflo(pv.x), bfhi(pv.x), bflo(pv.y), bfhi(pv.y)}; t1 = (f32x4){bflo(pv.z), bfhi(pv.z), bflo(pv.w), bfhi(pv.w)}; }
#pragma unroll
                    for (int j = 0; j < 4; ++j) { t0[j] += sigm(g[j]) * acc[ai][bj][m][0][j]; t1[j] += sigm(g[4 + j]) * acc[ai][bj][m][1][j]; }
                    if (u.e < 2) { v4u w; w.x = cvt_pk_bf16(t0[0], t0[1]); w.y = cvt_pk_bf16(t0[2], t0[3]); w.z = cvt_pk_bf16(t1[0], t1[1]); w.w = cvt_pk_bf16(t1[2], t1[3]); *(v4u*)tp = w; }
                    else { v4u w; w.x = cvt_pk_bf16(t0[0], t0[1]); w.y = cvt_pk_bf16(t0[2], t0[3]); w.z = cvt_pk_bf16(t1[0], t1[1]); w.w = cvt_pk_bf16(t1[2], t1[3]);
                        *(v4u*)(Mo + r * 1024 + c) = w; } } }
    }
};
struct EpiResid {
    static constexpr bool PERM = false;
    float* X; const float* gmod;
    __device__ __forceinline__ void operator()(const f32x4 (&acc)[2][2][4][2], const Unit& u, int wr, int wc, int fr, int fq) const {
        const int row0 = u.pm * BM + wr * 64 + fr, col0 = u.pn * BM + wc * 32 + 4 * fq;
        const int r00 = u.pm * BM; const int w = r00 < T_LAT ? (r00 >> 12) : 8;
        f32x4 gv[2][2];
#pragma unroll
        for (int bj = 0; bj < 2; ++bj)
#pragma unroll
            for (int n = 0; n < 2; ++n) gv[bj][n] = *(const f32x4*)(gmod + (size_t)w * 6144 + col0 + bj * HALF + n * 16);
#pragma unroll
        for (int ai = 0; ai < 2; ++ai)
#pragma unroll
            for (int m = 0; m < 4; ++m) { float* rowp = X + (size_t)(row0 + ai * HALF + m * 16) * 1024 + col0;
#pragma unroll
                for (int bj = 0; bj < 2; ++bj)
#pragma unroll
                    for (int n = 0; n < 2; ++n) { f32x4* p = (f32x4*)(rowp + bj * HALF + n * 16); *p = *p + gv[bj][n] * acc[ai][bj][m][n]; } }
    }
};
}

struct Args { const float* in[51]; float* out; unsigned char* ws; int ph_lo, ph_hi; };
enum { I_X = 0, I_C, I_CTX, I_CCTX, I_ADAW, I_ADAB, I_N1G, I_N2G, I_WIN, I_HYCW, I_HYCB, I_HYW1, I_HYB1, I_HYF1, I_HYW2, I_HYB2, I_HYF2, I_HYW3, I_HYB3, I_HYBIAS,
       I_RWCW, I_RWCB, I_RWWUP, I_RWW0, I_RWAUP, I_RWA0, I_RWGUP, I_RWKK, I_RWKA, I_RWRK, I_RWLNG, I_RWLNB, I_S5ARE, I_S5AIM, I_S5LDT, I_S5BRE, I_S5BIM, I_S5CRE, I_S5CIM, I_S5D,
       I_S5GLUW, I_S5GLUB, I_WBR, I_WOUT, I_RTW, I_RTB, I_W1, I_B1, I_W2, I_B2, I_FING };

typedef const __attribute__((address_space(4))) Args* CArgsP;
__device__ __forceinline__ CArgsP kargs() { CArgsP p = (CArgsP)__builtin_amdgcn_kernarg_segment_ptr(); asm volatile("" : "+s"(p)); return p; }
__device__ __forceinline__ int opaque(int v) { asm volatile("" : "+s"(v)); return v; }
__device__ __forceinline__ int opaque_v(int v) { asm volatile("" : "+v"(v)); return v; }
struct Ctx { CArgsP a; LAS unsigned char* lds; int tid, lane, wave, bid, G; };

__device__ __forceinline__ void row_seq(int row, int& base, int& pos, int& n) {
    if (row < T_LAT) { base = row & ~(SEQ - 1); pos = row & (SEQ - 1); n = SEQ; }
    else { const int r = row - T_LAT; base = T_LAT + (r & ~(CTXL - 1)); pos = r & (CTXL - 1); n = CTXL; }
}
__device__ __forceinline__ float conv3z(const bf16* zc, int pos, int n, float w0, float w1, float w2, float b) {
    const float zm = pos > 0 ? bf2f(zc[(size_t)(pos - 1) * IN_COLS]) : 0.f, z0 = bf2f(zc[(size_t)pos * IN_COLS]), zp = pos < n - 1 ? bf2f(zc[(size_t)(pos + 1) * IN_COLS]) : 0.f;
    return zm * w0 + z0 * w1 + zp * w2 + b;
}

template <int MODE>
__device__ __forceinline__ void transpose_item(const float* W, int K, int N, bf16* WT, int Hs, LAS float* scr, int item, int lane) {
    const int nblk = N / 32, kb = item / nblk, nb = item % nblk, k0 = 64 * kb, n0 = 32 * nb;
#pragma unroll 8
    for (int i = 0; i < 32; ++i) { const int kk = 2 * i + (lane >> 5); scr[kk * 33 + (lane & 31)] = W[(size_t)(k0 + kk) * N + n0 + (lane & 31)]; }
    LDS_WAIT(); asm volatile("" ::: "memory");
    const int c = lane & 7;
#pragma unroll
    for (int j = 0; j < 4; ++j) { const int n = (lane >> 3) + 8 * j; const LAS float* s = scr + (8 * c) * 33 + n;
        v4u o; o.x = pk2(s[0 * 33], s[1 * 33]); o.y = pk2(s[2 * 33], s[3 * 33]); o.z = pk2(s[4 * 33], s[5 * 33]); o.w = pk2(s[6 * 33], s[7 * 33]);
        int dr = n0 + n;
        if (MODE == 1) { const int nc = n0 + n; const int jx = nc < Hs ? nc : nc - Hs; dr = (jx >> 7) * 256 + (nc < Hs ? 0 : 128) + (jx & 127); }
        *(v4u*)(WT + (size_t)dr * K + k0 + 8 * c) = o; }
    LDS_WAIT(); asm volatile("" ::: "memory");
}

__device__ __forceinline__ void p0_prologue(const Ctx& F) {
    const auto& a = *F.a; unsigned char* ws = a.ws;
    const int gw = F.bid * NWAVES + F.wave, NGW = F.G * NWAVES, lane = F.lane;
    float* X = (float*)(ws + WS_X);
    for (int t = gw; t < SEQ; t += NGW) {
        const float pr = (float)(t >> 6), pc = (float)(t & 63);
        f32x4 pe[4];
#pragma unroll
        for (int j = 0; j < 4; ++j)
#pragma unroll
            for (int e = 0; e < 4; ++e) { const float om = 1.0f / powf(10000.0f, (float)(4 * lane + e) / 256.0f); const float ang = ((j < 2) ? pr : pc) * om; pe[j][e] = (j & 1) ? cosf(ang) : sinf(ang); }
#pragma unroll 2
        for (int bb = 0; bb < BATCH; ++bb) { const size_t row = (size_t)bb * SEQ + t;
            const f32x4* xi = (const f32x4*)(a.in[I_X] + row * D) + lane; f32x4* xo = (f32x4*)(X + row * D) + lane;
#pragma unroll
            for (int j = 0; j < 4; ++j) xo[64 * j] = xi[64 * j] + pe[j]; }
    }
    for (int row = T_LAT + gw; row < T_ALL; row += NGW) {
        const f32x4* xi = (const f32x4*)(a.in[I_CTX] + (size_t)(row - T_LAT) * D) + lane; f32x4* xo = (f32x4*)(X + (size_t)row * D) + lane;
#pragma unroll
        for (int j = 0; j < 4; ++j) xo[64 * j] = xi[64 * j];
    }
    {
        LAS float* condl = (LAS float*)F.lds; LAS float* psum = (LAS float*)(F.lds + 40960);
        for (int i = F.tid; i < 9 * 1024; i += NTHREADS) { const int w = i >> 10, k = i & 1023; const float cv = (w < 8) ? a.in[I_C][w * 1024 + k] : a.in[I_CCTX][k]; condl[i] = cv / (1.f + expf(-cv)); }
        __syncthreads();
        float* MOD = (float*)(ws + WS_MOD);
        for (int it = F.bid; it < 2 * 96; it += F.G) {
            const int l = it / 96, cg = it % 96, col = cg * 64 + lane;
            float acc[9];
#pragma unroll
            for (int w = 0; w < 9; ++w) acc[w] = 0.f;
            const float* wp = a.in[I_ADAW] + ((size_t)l * 1024 + F.wave * 128) * 6144 + col;
#pragma unroll 1
            for (int k0 = 0; k0 < 128; k0 += 16) { float wv[16];
#pragma unroll
                for (int k = 0; k < 16; ++k) wv[k] = wp[(size_t)(k0 + k) * 6144];
#pragma unroll
                for (int k = 0; k < 16; ++k)
#pragma unroll
                    for (int w = 0; w < 9; ++w) acc[w] += condl[w * 1024 + F.wave * 128 + k0 + k] * wv[k]; }
#pragma unroll
            for (int w = 0; w < 9; ++w) psum[(F.wave * 9 + w) * 64 + lane] = acc[w];
            __syncthreads();
            if (F.wave == 0) {
#pragma unroll
                for (int w = 0; w < 9; ++w) { float s = 0.f;
#pragma unroll
                    for (int wv = 0; wv < 8; ++wv) s += psum[(wv * 9 + w) * 64 + lane];
                    MOD[(size_t)(l * 9 + w) * 6144 + col] = s + a.in[I_ADAB][l * 6144 + col]; }
            }
            __syncthreads();
        }
    }
    {
        LAS float* scr = (LAS float*)(F.lds + F.wave * 16384);
        constexpr int IT_W1 = 16 * 64, IT_W2 = 16 * 32, IT_WIN = 16 * 216, IT_GLU = 8 * 32, IT_WBR = 8 * 32, IT_WOUT = 16 * 32;
        constexpr int N_W1 = 64 * IT_W1, N_W2 = 64 * IT_W2, N_WIN = 2 * IT_WIN, N_GLU = 2 * IT_GLU, N_WBR = 6 * IT_WBR, N_WOUT = 2 * IT_WOUT;
        constexpr int NITEMS = N_W1 + N_W2 + N_WIN + N_GLU + N_WBR + N_WOUT;
        for (int it = gw; it < NITEMS; it += NGW) {
            int r = it;
            if (r < N_W1) { const int mtx = r / IT_W1, l = mtx >> 5, e = mtx & 31; transpose_item<1>(a.in[I_W1] + (size_t)mtx * 1024 * 2048, 1024, 2048, (bf16*)(ws + WS_WTS + l * WL_STRIDE + WO_W1) + (size_t)e * 2048 * 1024, 1024, scr, r % IT_W1, lane); continue; } r -= N_W1;
            if (r < N_W2) { const int mtx = r / IT_W2, l = mtx >> 5, e = mtx & 31; transpose_item<0>(a.in[I_W2] + (size_t)mtx * 1024 * 1024, 1024, 1024, (bf16*)(ws + WS_WTS + l * WL_STRIDE + WO_W2) + (size_t)e * 1024 * 1024, 0, scr, r % IT_W2, lane); continue; } r -= N_W2;
            if (r < N_WIN) { const int l = r / IT_WIN; transpose_item<0>(a.in[I_WIN] + (size_t)l * 1024 * IN_COLS, 1024, IN_COLS, (bf16*)(ws + WS_WTS + l * WL_STRIDE + WO_WIN), 0, scr, r % IT_WIN, lane); continue; } r -= N_WIN;
            if (r < N_GLU) { const int l = r / IT_GLU; transpose_item<1>(a.in[I_S5GLUW] + (size_t)l * 512 * 1024, 512, 1024, (bf16*)(ws + WS_WTS + l * WL_STRIDE + WO_GLU), 512, scr, r % IT_GLU, lane); continue; } r -= N_GLU;
            if (r < N_WBR) { const int mtx = r / IT_WBR, l = mtx / 3, br = mtx % 3; transpose_item<0>(a.in[I_WBR] + (size_t)mtx * 512 * 1024, 512, 1024, (bf16*)(ws + WS_WTS + l * WL_STRIDE + WO_WBR) + (size_t)br * 1024 * 512, 0, scr, r % IT_WBR, lane); continue; } r -= N_WBR;
            { const int l = r / IT_WOUT; transpose_item<0>(a.in[I_WOUT] + (size_t)l * 1024 * 1024, 1024, 1024, (bf16*)(ws + WS_WTS + l * WL_STRIDE + WO_WOUT), 0, scr, r % IT_WOUT, lane); }
        }
        for (int i = F.bid * NTHREADS + F.tid; i < 2 * 2560 * 256; i += F.G * NTHREADS) {
            const int l = i / (2560 * 256), r = i % (2560 * 256), n = r >> 8, k = r & 255; float v = 0.f;
            if (n < 1024) { if (k < 64) v = a.in[I_RWWUP][(((size_t)l * 2 + (n >> 9)) * 64 + k) * 512 + (n & 511)]; }
            else if (n < 2048) { if (k >= 64 && k < 128) v = a.in[I_RWAUP][(((size_t)l * 2 + ((n - 1024) >> 9)) * 64 + (k - 64)) * 512 + (n & 511)]; }
            else { if (k >= 128) v = a.in[I_RWGUP][((size_t)l * 128 + (k - 128)) * 512 + (n - 2048)]; }
            ((bf16*)(ws + WS_WTS + l * WL_STRIDE + WO_RWCAT))[r] = (bf16)f2bf(v);
        }
    }
    __syncthreads();
    {
        LAS float* feats = (LAS float*)F.lds; LAS float* h1 = feats + 8 * 33; LAS float* h2 = h1 + 8 * 64;
        constexpr int NIT = 2 * (512 + 32);
        for (int it = F.bid; it < NIT; it += F.G) {
            const int l = it / 544, r = it % 544, nsel = r >= 512, n = nsel ? CTXL : SEQ, p0 = (nsel ? r - 512 : r) * 8;
            if (F.tid < 8 * 33) { const int p = F.tid / 33, i = F.tid % 33, pos = p0 + p; float f;
                if (i == 0) f = (float)pos / (float)(n - 1);
                else { const int k = (i - 1) & 15; const float band = 1e-4f + (float)k * ((15.0f - 1e-4f) / 15.0f); const float ang = (6.283185307179586f * (float)pos / (float)n) * band; f = (i <= 16) ? cosf(ang) : -sinf(ang); }
                feats[p * 33 + i] = f; }
            __syncthreads();
            { const int p = F.tid >> 6, j = F.tid & 63; float s = a.in[I_HYB1][l * 64 + j]; const float* w1p = a.in[I_HYW1] + (size_t)l * 33 * 64 + j;
#pragma unroll
                for (int i = 0; i < 33; ++i) s += feats[p * 33 + i] * w1p[i * 64];
                h1[p * 64 + j] = sinf(a.in[I_HYF1][l * 64 + j] * s); }
            __syncthreads();
            { const int p = F.tid >> 6, j = F.tid & 63; float s = a.in[I_HYB2][l * 64 + j];
                const float* w2p = a.in[I_HYW2] + (size_t)l * 64 * 64 + j;
#pragma unroll 16
                for (int i = 0; i < 64; ++i) s += h1[p * 64 + i] * w2p[i * 64];
                h2[p * 64 + j] = sinf(a.in[I_HYF2][l * 64 + j] * s); }
            __syncthreads();
            float acc[4][8];
#pragma unroll
            for (int q = 0; q < 4; ++q)
#pragma unroll
                for (int p = 0; p < 8; ++p) acc[q][p] = 0.f;
            const float* w3 = a.in[I_HYW3] + (size_t)l * 64 * 2048 + F.tid;
#pragma unroll 8
            for (int i = 0; i < 64; ++i) { float wv[4];
#pragma unroll
                for (int q = 0; q < 4; ++q) wv[q] = w3[(size_t)i * 2048 + q * 512];
#pragma unroll
                for (int p = 0; p < 8; ++p) { const float hv = h2[p * 64 + i];
#pragma unroll
                    for (int q = 0; q < 4; ++q) acc[q][p] += hv * wv[q]; } }
            const int c = F.tid; const float dstart = logf(0.01f) / 1.5f, dstop = logf(0.01f) / 0.3f; const float delta = fabsf(dstart + (float)c * ((dstop - dstart) / 511.0f));
            const int RL = nsel ? HY_RLENC : HY_RLEN, off = n + 47;
            bf16* Rb = (bf16*)(ws + WS_GF + l * GF_STRIDE + (nsel ? GF_CTX : 0));
#pragma unroll
            for (int q = 0; q < 4; ++q) { const int o = q >> 1, side = q & 1; const float b3 = a.in[I_HYB3][l * 2048 + q * 512 + c];
                bf16* Rc = Rb + ((size_t)o * 512 + c) * RL;
#pragma unroll
                for (int p = 0; p < 8; ++p) { const int pos = p0 + p; const float t = (float)pos / (float)(n - 1); const float val = (acc[q][p] + b3) * expf(-t * delta);
                    if (side == 0) Rc[off - pos] = (bf16)f2bf(val);
                    else if (pos >= 1) Rc[off + pos] = (bf16)f2bf(val); }
                if (p0 == 0 && side == 0) { for (int m = 0; m < 48; ++m) Rc[m] = 0; for (int m = off + n; m < RL; ++m) Rc[m] = 0; } }
            __syncthreads();
        }
    }
}

__device__ __forceinline__ void stage_norm1(const Ctx& F, int l) {
    const auto& a = *F.a; unsigned char* ws = a.ws; const int lane = F.lane;
    const int gw = F.bid * NWAVES + F.wave, NGW = F.G * NWAVES;
    float* X = (float*)(ws + WS_X); bf16* H = (bf16*)(ws + WS_H); const float* MOD = (const float*)(ws + WS_MOD);
    const bf16* YS = (const bf16*)(ws + WS_XS); const int* POS = (const int*)(ws + WS_POS); const float* GATE = (const float*)(ws + WS_GATE);
    const int nrows = (l == DEPTH) ? T_LAT : T_ALL;
    f32x4 vn[4]; int4 pn = make_int4(0, 0, 0, 0); f32x4 gn = (f32x4){0.f, 0.f, 0.f, 0.f};
    if (gw < nrows) {
#pragma unroll
        for (int j = 0; j < 4; ++j) vn[j] = ((const f32x4*)(X + (size_t)gw * D) + lane)[64 * j];
        if (l > 0) { pn = *(const int4*)(POS + gw * 4); gn = *(const f32x4*)(GATE + gw * 4); } }
#pragma unroll 1
    for (int row = gw; row < nrows; row += NGW) {
        const int w = row < T_LAT ? (row >> 12) : 8;
        f32x4* xr = (f32x4*)(X + (size_t)row * D) + lane;
        f32x4 v[4];
#pragma unroll
        for (int j = 0; j < 4; ++j) v[j] = vn[j];
        const int4 pc = pn; const f32x4 gc = gn;
        if (row + NGW < nrows) { const int rn = row + NGW;
#pragma unroll
            for (int j = 0; j < 4; ++j) vn[j] = ((const f32x4*)(X + (size_t)rn * D) + lane)[64 * j];
            if (l > 0) { pn = *(const int4*)(POS + rn * 4); gn = *(const f32x4*)(GATE + rn * 4); } }
        if (l > 0) {
            f32x4 mo[4];
#pragma unroll
            for (int j = 0; j < 4; ++j) mo[j] = (f32x4){0.f, 0.f, 0.f, 0.f};
            const int pk_[4] = {pc.x, pc.y, pc.z, pc.w};
#pragma unroll
            for (int k = 0; k < TOPK; ++k) { const int p = pk_[k]; const float g = gc[k];
                const v2u* yr = (const v2u*)(YS + (size_t)p * D) + lane;
#pragma unroll
                for (int j = 0; j < 4; ++j) { const v2u y = yr[64 * j]; mo[j][0] += g * bflo(y.x); mo[j][1] += g * bfhi(y.x); mo[j][2] += g * bflo(y.y); mo[j][3] += g * bfhi(y.y); } }
            const f32x4* g2 = (const f32x4*)(MOD + (size_t)((l - 1) * 9 + w) * 6144 + 5120) + lane;
#pragma unroll
            for (int j = 0; j < 4; ++j) { v[j] = v[j] + g2[64 * j] * mo[j]; xr[64 * j] = v[j]; }
        }
        float ss = 0.f;
#pragma unroll
        for (int j = 0; j < 4; ++j) ss += (v[j][0] * v[j][0] + v[j][1] * v[j][1]) + (v[j][2] * v[j][2] + v[j][3] * v[j][3]);
        const float rstd = __builtin_amdgcn_rsqf(wave_sum(ss) * (1.f / D) + 1e-6f);
        if (l == DEPTH) {
            const f32x4* fg = (const f32x4*)a.in[I_FING] + lane; f32x4* o = (f32x4*)(a.out + (size_t)row * D) + lane;
#pragma unroll
            for (int j = 0; j < 4; ++j) o[64 * j] = v[j] * rstd * fg[64 * j];
        } else {
            const f32x4* ng = (const f32x4*)(a.in[I_N1G] + l * D) + lane;
            const f32x4* sh = (const f32x4*)(MOD + (size_t)(l * 9 + w) * 6144) + lane; const f32x4* sc = (const f32x4*)(MOD + (size_t)(l * 9 + w) * 6144 + 1024) + lane;
            v2u* ho = (v2u*)(H + (size_t)row * D) + lane;
#pragma unroll
            for (int j = 0; j < 4; ++j) { const f32x4 h = v[j] * rstd * ng[64 * j] * (sc[64 * j] + 1.0f) + sh[64 * j]; v2u o; o.x = pk2(h[0], h[1]); o.y = pk2(h[2], h[3]); ho[64 * j] = o; }
        }
    }
}

__device__ __forceinline__ void stage_rw_prep1(const Ctx& F, int l) {
    const auto& a = *F.a; unsigned char* ws = a.ws;
    const bf16* Z = (const bf16*)(ws + WS_Z); bf16* ARW = (bf16*)(ws + WS_ARW);
    const int j = 4 * (F.tid & 63), col = 1536 + j, rq = F.tid >> 6;
    const float* cw = a.in[I_RWCW] + (size_t)l * 3 * 1792;
    const f32x4 w0 = *(const f32x4*)(cw + col), w1 = *(const f32x4*)(cw + 1792 + col), w2 = *(const f32x4*)(cw + 2 * 1792 + col), cb = *(const f32x4*)(a.in[I_RWCB] + l * 1792 + col);
#pragma unroll 2
    for (int row = F.bid * 8 + rq; row < T_ALL; row += F.G * 8) {
        int base, pos, n; row_seq(row, base, pos, n);
        const bf16* zc = Z + (size_t)row * IN_COLS + RW_OFF + col;
        const v2u z0 = *(const v2u*)zc;
        v2u zm = (v2u){0u, 0u}, zp = (v2u){0u, 0u};
        if (pos > 0) zm = *(const v2u*)(zc - IN_COLS);
        if (pos < n - 1) zp = *(const v2u*)(zc + IN_COLS);
        f32x4 v = (f32x4){bflo(zm.x), bfhi(zm.x), bflo(zm.y), bfhi(zm.y)} * w0 + (f32x4){bflo(z0.x), bfhi(z0.x), bflo(z0.y), bfhi(z0.y)} * w1 + (f32x4){bflo(zp.x), bfhi(zp.x), bflo(zp.y), bfhi(zp.y)} * w2 + cb;
#pragma unroll
        for (int e2 = 0; e2 < 4; ++e2) { if (j < 64) v[e2] = tanh_fast(v[e2]); else if (j >= 128) v[e2] = sigm(v[e2]); }
        v2u o; o.x = pk2(v[0], v[1]); o.y = pk2(v[2], v[3]);
        *(v2u*)(ARW + (size_t)row * 256 + j) = o;
    }
}

__device__ __forceinline__ void stage_rw_prep2(const Ctx& F, int l) {
    const auto& a = *F.a; unsigned char* ws = a.ws; const int lane = F.lane;
    const bf16* Z = (const bf16*)(ws + WS_Z); const bf16* P = (const bf16*)(ws + WS_P); bf16* SCN = (bf16*)(ws + WS_SCN);
    const int gw = F.bid * NWAVES + F.wave, NGW = F.G * NWAVES;
    constexpr int TR = 17, NRT = T_ALL / TR;
    const float* cw = a.in[I_RWCW] + (size_t)l * 3 * 1792; const float* cbp = a.in[I_RWCB] + l * 1792;
    for (int tile = gw; tile < NRT * 4; tile += NGW) {
        const int rt = tile % NRT, hp = tile / NRT, row0 = rt * TR, c0 = hp * 128 + 2 * lane;
        f32x2 w[3][3], cb[3];
#pragma unroll
        for (int s = 0; s < 3; ++s) { cb[s] = *(const f32x2*)(cbp + s * 512 + c0);
#pragma unroll
            for (int j = 0; j < 3; ++j) w[s][j] = *(const f32x2*)(cw + j * 1792 + s * 512 + c0); }
        const f32x2 KKw = *(const f32x2*)(a.in[I_RWKK] + l * 512 + c0), KAw = *(const f32x2*)(a.in[I_RWKA] + l * 512 + c0);
        f32x2 W0[2], A0[2];
#pragma unroll
        for (int d = 0; d < 2; ++d) { W0[d] = *(const f32x2*)(a.in[I_RWW0] + (l * 2 + d) * 512 + c0); A0[d] = *(const f32x2*)(a.in[I_RWA0] + (l * 2 + d) * 512 + c0); }
        const unsigned* zb = (const unsigned*)(Z + RW_OFF + c0);
        unsigned zm[3], z0[3], zp[3];
#pragma unroll
        for (int s = 0; s < 3; ++s) { zm[s] = row0 > 0 ? zb[(size_t)(row0 - 1) * (IN_COLS / 2) + s * 256] : 0u; z0[s] = zb[(size_t)row0 * (IN_COLS / 2) + s * 256]; }
        unsigned pn_[4], pc_[4];
        { const unsigned* pr0 = (const unsigned*)(P + (size_t)row0 * 2560 + c0); pn_[0] = pr0[0]; pn_[1] = pr0[512]; pn_[2] = pr0[256]; pn_[3] = pr0[768]; }
#pragma unroll 1
        for (int i = 0; i < TR; ++i) {
            const int row = row0 + i; int base, pos, n; row_seq(row, base, pos, n);
#pragma unroll
            for (int e = 0; e < 4; ++e) pc_[e] = pn_[e];
            if (i + 1 < TR) { const unsigned* pr1 = (const unsigned*)(P + (size_t)(row + 1) * 2560 + c0); pn_[0] = pr1[0]; pn_[1] = pr1[512]; pn_[2] = pr1[256]; pn_[3] = pr1[768]; }
#pragma unroll
            for (int s = 0; s < 3; ++s) zp[s] = (row + 1 < T_ALL) ? zb[(size_t)(row + 1) * (IN_COLS / 2) + s * 256] : 0u;
            const float mlo = pos > 0 ? 1.f : 0.f, mhi = pos < n - 1 ? 1.f : 0.f;
            f32x2 u[3];
#pragma unroll
            for (int s = 0; s < 3; ++s) { u[s] = (f32x2){bflo(zm[s]), bfhi(zm[s])} * mlo * w[s][0] + (f32x2){bflo(z0[s]), bfhi(z0[s])} * w[s][1] + (f32x2){bflo(zp[s]), bfhi(zp[s])} * mhi * w[s][2] + cb[s]; zm[s] = z0[s]; z0[s] = zp[s]; }
            const f32x2 r = u[0], k = u[1], v = u[2];
            f32x2 kk = k * KKw;
            const float ss = red32(kk[0] * kk[0] + kk[1] * kk[1]);
            kk = kk * (__builtin_amdgcn_rsqf(fmaxf(ss, 1e-24f)));
            unsigned* o = (unsigned*)(SCN + (size_t)row * 9 * 512 + c0);
            o[0] = pk2(r[0], r[1]); o[256] = pk2(v[0], v[1]); o[2 * 256] = pk2(kk[0], kk[1]);
#pragma unroll
            for (int d = 0; d < 2; ++d) {
                const unsigned pw = pc_[2 * d], pa = pc_[2 * d + 1];
                float ld[2], kd[2], be[2];
#pragma unroll
                for (int e = 0; e < 2; ++e) {
                    const float uu = W0[d][e] + (e ? bfhi(pw) : bflo(pw));
                    ld[e] = -0.60653065971263342f * sigm(uu);
                    const float av = sigm(A0[d][e] + (e ? bfhi(pa) : bflo(pa)));
                    kd[e] = k[e] * (1.f + (av - 1.f) * KAw[e]); be[e] = kk[e] * av; }
                o[(3 + 3 * d) * 256] = pk2(ld[0], ld[1]); o[(4 + 3 * d) * 256] = pk2(kd[0], kd[1]); o[(5 + 3 * d) * 256] = pk2(be[0], be[1]);
            }
        }
    }
}

__device__ __forceinline__ int seq_row(int b, int d, int sidx) {
    if (sidx < CTXL) { const int t = d ? (CTXL - 1 - sidx) : sidx; return T_LAT + b * CTXL + t; }
    const int tl = sidx - CTXL; const int t = d ? (SEQ - 1 - tl) : tl; return b * SEQ + t;
}

constexpr int CW_WORK = 16384;
constexpr int CW_STAMP = 20480;
#ifdef PROBE_T
#ifndef PROBE_BID
#define PROBE_BID 0
#endif
#define PT(k) do { if (F.bid == PROBE_BID && F.tid == 0 && l == 0) ((unsigned long long*)(F.a->ws + WS_CTL + CW_STAMP * 4))[k] = __builtin_amdgcn_s_memrealtime(); } while (0)
#else
#define PT(k) do { } while (0)
#endif
__device__ __forceinline__ void rw_scan_item(const Ctx& F, int l, int it2) {
    const int it = it2 >> 1, half = it2 & 1;
    const auto& a = *F.a; unsigned char* ws = a.ws; const int tid = F.tid, lane = F.lane;
    const bf16* SCN = (const bf16*)(ws + WS_SCN); float* YD = (float*)(ws + WS_YDIR);
    LAS float* sbuf = (LAS float*)F.lds;
    LAS float* ybuf = (LAS float*)(F.lds + 49152);
    const bool comp = F.wave < 4;
    const int lt = tid & 255, ls = lt >> 4, lj = lt & 15;
    const int vl = lane >> 3, kq = lane & 7, vrow = half * 32 + (F.wave & 3) * 8 + vl;
    constexpr int NCH = (CTXL + SEQ) / 16;
    const int d = it & 1, h = (it >> 1) & 7, b = it >> 4;
    f32x2 S[4];
#pragma unroll
    for (int q = 0; q < 4; ++q) S[q] = (f32x2){0.f, 0.f};
    v2u ldr[6];
#define RW_ISSUE(c) do { const int row_ = seq_row(b, d, (c) * 16 + ls); const v2u* p_ = (const v2u*)(SCN + (size_t)row_ * 9 * 512 + h * 64) + lj; \
        ldr[0] = p_[2 * 128]; ldr[1] = p_[(3 + 3 * d) * 128]; ldr[2] = p_[(5 + 3 * d) * 128]; ldr[3] = p_[(4 + 3 * d) * 128]; ldr[4] = p_[0]; ldr[5] = p_[128]; } while (0)
#define RW_WRITE(bufi) do { LAS float* o_ = sbuf + (((bufi) * 16 + ls) * 6) * 64 + 4 * lj; \
        *(LAS f32x4*)(o_) = (f32x4){-bflo(ldr[0].x), -bfhi(ldr[0].x), -bflo(ldr[0].y), -bfhi(ldr[0].y)}; \
        *(LAS f32x4*)(o_ + 64) = (f32x4){__expf(bflo(ldr[1].x)), __expf(bfhi(ldr[1].x)), __expf(bflo(ldr[1].y)), __expf(bfhi(ldr[1].y))}; \
        *(LAS f32x4*)(o_ + 128) = (f32x4){bflo(ldr[2].x), bfhi(ldr[2].x), bflo(ldr[2].y), bfhi(ldr[2].y)}; *(LAS f32x4*)(o_ + 192) = (f32x4){bflo(ldr[3].x), bfhi(ldr[3].x), bflo(ldr[3].y), bfhi(ldr[3].y)}; \
        *(LAS f32x4*)(o_ + 256) = (f32x4){bflo(ldr[4].x), bfhi(ldr[4].x), bflo(ldr[4].y), bfhi(ldr[4].y)}; *(LAS f32x4*)(o_ + 320) = (f32x4){bflo(ldr[5].x), bfhi(ldr[5].x), bflo(ldr[5].y), bfhi(ldr[5].y)}; } while (0)
#define RW_FLUSH(c) do { const int row_ = seq_row(b, d, (c) * 16 + ls); \
        *(f32x2*)(YD + ((size_t)d * T_ALL + row_) * 512 + h * 64 + half * 32 + 2 * lj) = *(const LAS f32x2*)(ybuf + ((((c) & 1) * 16 + ls) * 64) + half * 32 + 2 * lj); } while (0)
    if (!comp) { RW_ISSUE(0); RW_WRITE(0); RW_ISSUE(1); }
    __syncthreads();
#pragma unroll 1
    for (int c = 0; c < NCH; ++c) {
        const int bi = c & 1;
        if (!comp) {
            if (c + 1 < NCH) RW_WRITE(bi ^ 1);
            if (c + 2 < NCH) RW_ISSUE(c + 2);
            if (c > 0) RW_FLUSH(c - 1);
        } else {
        float yv[16];
        f32x4 opA[10], opB[10]; float vvA, vvB;
#define RW_LD(op, vvx, s_) do { const LAS float* sp_ = sbuf + ((bi * 16 + (s_)) * 6) * 64 + 8 * kq; \
            _Pragma("unroll") for (int q_ = 0; q_ < 5; ++q_) { op[2 * q_] = *(const LAS f32x4*)(sp_ + 64 * q_); op[2 * q_ + 1] = *(const LAS f32x4*)(sp_ + 64 * q_ + 4); } \
            vvx = sbuf[((bi * 16 + (s_)) * 6 + 5) * 64 + vrow]; } while (0)
#define RW_COMP(op, vvx, s_) do { \
            const f32x4 a0 = op[0], a1 = op[1], w0 = op[2], w1 = op[3], b0 = op[4], b1 = op[5], k0 = op[6], k1 = op[7], r0 = op[8], r1 = op[9]; \
            const f32x2 vv2 = (f32x2){vvx, vvx}; \
            const f32x2 p0 = S[1] * (f32x2){a0[2], a0[3]} + S[0] * (f32x2){a0[0], a0[1]}; \
            const f32x2 p1 = S[3] * (f32x2){a1[2], a1[3]} + S[2] * (f32x2){a1[0], a1[1]}; \
            const f32x2 t0 = S[0] * (f32x2){w0[0], w0[1]} + vv2 * (f32x2){k0[0], k0[1]}; \
            const f32x2 t1 = S[1] * (f32x2){w0[2], w0[3]} + vv2 * (f32x2){k0[2], k0[3]}; \
            const f32x2 t2 = S[2] * (f32x2){w1[0], w1[1]} + vv2 * (f32x2){k1[0], k1[1]}; \
            const f32x2 t3 = S[3] * (f32x2){w1[2], w1[3]} + vv2 * (f32x2){k1[2], k1[3]}; \
            const f32x2 ac = p0 + p1; \
            const float sa = red8(ac[0] + ac[1]); \
            const f32x2 sa2 = (f32x2){sa, sa}; \
            S[0] = sa2 * (f32x2){b0[0], b0[1]} + t0; S[1] = sa2 * (f32x2){b0[2], b0[3]} + t1; \
            S[2] = sa2 * (f32x2){b1[0], b1[1]} + t2; S[3] = sa2 * (f32x2){b1[2], b1[3]} + t3; \
            const f32x2 q0 = S[1] * (f32x2){r0[2], r0[3]} + S[0] * (f32x2){r0[0], r0[1]}; \
            const f32x2 q1 = S[3] * (f32x2){r1[2], r1[3]} + S[2] * (f32x2){r1[0], r1[1]}; \
            const f32x2 yc = q0 + q1; \
            yv[s_] = red8(yc[0] + yc[1]); } while (0)
        RW_LD(opA, vvA, 0);
#pragma unroll
        for (int s = 0; s < 16; s += 2) {
            RW_LD(opB, vvB, s + 1);
            __builtin_amdgcn_sched_barrier(0);
            RW_COMP(opA, vvA, s);
            __builtin_amdgcn_sched_barrier(0);
            if (s + 2 < 16) RW_LD(opA, vvA, s + 2);
            __builtin_amdgcn_sched_barrier(0);
            RW_COMP(opB, vvB, s + 1);
            __builtin_amdgcn_sched_barrier(0);
        }
#undef RW_LD
#undef RW_COMP
#pragma unroll
        for (int s = 0; s < 16; ++s) if ((s & 7) == kq) ybuf[((bi * 16 + s) * 64) + vrow] = yv[s];
        }
        __syncthreads();
    }
    if (!comp) RW_FLUSH(NCH - 1);
    __syncthreads();
#undef RW_ISSUE
#undef RW_WRITE
#undef RW_FLUSH
}

constexpr size_t WS_RWSCR = WS_YHY;
constexpr int RWS_QY = 0, RWS_YV = 2048, RWS_PZ = 4096, RWS_ZV = 12288, RWS_SLOT = 20480;
typedef __bf16 bf16x8n __attribute__((ext_vector_type(8)));
__device__ __forceinline__ f32x4 mma16(const bf16x8 a, const bf16x8 b, const f32x4 c) { return __builtin_amdgcn_mfma_f32_16x16x32_bf16(a, b, c, 0, 0, 0); }
__device__ __forceinline__ float dpp_shr(float x, const int n) {
    const int v = __builtin_bit_cast(int, x); int r;
    if (n == 1) r = __builtin_amdgcn_update_dpp(0, v, 0x111, 0xF, 0xF, true); else if (n == 2) r = __builtin_amdgcn_update_dpp(0, v, 0x112, 0xF, 0xF, true);
    else if (n == 4) r = __builtin_amdgcn_update_dpp(0, v, 0x114, 0xF, 0xF, true); else r = __builtin_amdgcn_update_dpp(0, v, 0x118, 0xF, 0xF, true);
    return __builtin_bit_cast(float, r);
}
__device__ __forceinline__ v4u pack8(const float (&x)[8]) { v4u o; o.x = pk2(x[0], x[1]); o.y = pk2(x[2], x[3]); o.z = pk2(x[4], x[5]); o.w = pk2(x[6], x[7]); return o; }
__device__ __forceinline__ void unpack8(const v4u u, float (&x)[8]) { x[0] = bflo(u.x); x[1] = bfhi(u.x); x[2] = bflo(u.y); x[3] = bfhi(u.y); x[4] = bflo(u.z); x[5] = bfhi(u.z); x[6] = bflo(u.w); x[7] = bfhi(u.w); }
constexpr int LDS_ZERO16 = 131072 + 3072;
__device__ __forceinline__ bf16x8 frag16z(const LAS bf16* m, int rowbase, int lane, const LAS v4u* z) {
    const LAS v4u* p = (const LAS v4u*)(m + (rowbase + (lane & 15)) * 16 + 8 * (lane >> 4));
    const v4u v = *(((lane >> 4) < 2) ? p : z); return __builtin_bit_cast(bf16x8, v); }
#define frag16(m_, rb_, ln_) frag16z(m_, rb_, ln_, zp16)
__device__ __forceinline__ void st_colmaj(LAS bf16* m, int colbase, const f32x4 d, int lane) {
    v2u o; o.x = pk2(d[0], d[1]); o.y = pk2(d[2], d[3]); *(LAS v2u*)(m + (colbase + (lane & 15)) * 16 + 4 * (lane >> 4)) = o; }
__device__ __forceinline__ void st_rowmaj(LAS bf16* m, const f32x4 d, int lane) {
#pragma unroll
    for (int r = 0; r < 4; ++r) m[(4 * (lane >> 4) + r) * 16 + (lane & 15)] = (bf16)f2bf(d[r]); }
template <int KS0, int KS1>
__device__ __forceinline__ void rw_chunk_load(const Ctx& F, int b, int h, int d, int cidx, v4u (&raw)[12]) {
    const int lane = opaque_v(F.lane), t = lane & 15, kg = lane >> 4;
    const bf16* base = (const bf16*)(F.a->ws + WS_SCN) + (size_t)seq_row(b, d, 16 * cidx + t) * 9 * 512 + h * 64;
#pragma unroll
    for (int ks = KS0; ks < KS1; ++ks) { const int off = 32 * ks + 8 * kg;
        raw[6 * ks + 0] = *(const v4u*)(base + (3 + 3 * d) * 512 + off); raw[6 * ks + 1] = *(const v4u*)(base + 2 * 512 + off); raw[6 * ks + 2] = *(const v4u*)(base + off);
        raw[6 * ks + 3] = *(const v4u*)(base + (5 + 3 * d) * 512 + off); raw[6 * ks + 4] = *(const v4u*)(base + (4 + 3 * d) * 512 + off); raw[6 * ks + 5] = *(const v4u*)(base + 512 + off); }
}
__device__ __forceinline__ void rw_chunk_task(const Ctx& F, const v4u (&raw)[12], LAS unsigned char* wl, unsigned char* slot) {
    const LAS v4u* zp16 = (const LAS v4u*)(F.lds + LDS_ZERO16);
    const int lane = opaque_v(F.lane), t = lane & 15, kg = lane >> 4;
    LAS bf16* ATt = (LAS bf16*)(wl); LAS bf16* RBr = (LAS bf16*)(wl + 2048); LAS bf16* BHt = (LAS bf16*)(wl + 4096); LAS bf16* KHt = (LAS bf16*)(wl + 6144); LAS bf16* VTt = (LAS bf16*)(wl + 8192);
    LAS bf16* WAt = (LAS bf16*)(wl + 10240); LAS bf16* N_r = (LAS bf16*)(wl + 12288); LAS bf16* N_c = (LAS bf16*)(wl + 12800); LAS bf16* T_r = (LAS bf16*)(wl + 13312);
    LAS bf16* AK_r = (LAS bf16*)(wl + 13824); LAS bf16* RB2 = (LAS bf16*)(wl + 14336); LAS bf16* RK_r = (LAS bf16*)(wl + 14848); LAS float* GCl = (LAS float*)(wl + 15360);
    bf16x8 fAb[2], fRb[2], fBb[2], fKb[2];
#pragma unroll
    for (int ks = 0; ks < 2; ++ks) {
        const int off = 32 * ks + 8 * kg;
        float ea[8], er[8], eb[8], eh[8];
        { const v4u uld = raw[6 * ks + 0]; float ld[8]; unpack8(uld, ld);
#pragma unroll
          for (int j = 0; j < 8; ++j) { float c = ld[j]; c += dpp_shr(c, 1); c += dpp_shr(c, 2); c += dpp_shr(c, 4); c += dpp_shr(c, 8);
              const float tot = __builtin_bit_cast(float, __builtin_amdgcn_ds_bpermute((lane | 15) << 2, __builtin_bit_cast(int, c)));
              ea[j] = __expf(c - ld[j]); er[j] = __expf(c); eb[j] = __expf(-c); eh[j] = __expf(tot - c);
              if (t == 0) GCl[off + j] = __expf(tot); } }
        { const v4u u = raw[6 * ks + 1]; float x[8]; unpack8(u, x);
#pragma unroll
          for (int j = 0; j < 8; ++j) { x[j] = -x[j] * ea[j]; ATt[(off + j) * 16 + t] = (bf16)f2bf(x[j]); }
          const v4u p = pack8(x); fAb[ks] = __builtin_bit_cast(bf16x8, p); }
        { const v4u u = raw[6 * ks + 2]; float x[8]; unpack8(u, x);
#pragma unroll
          for (int j = 0; j < 8; ++j) x[j] = x[j] * er[j];
          const v4u p = pack8(x); fRb[ks] = __builtin_bit_cast(bf16x8, p); *(LAS v4u*)(RBr + t * 64 + off) = p; }
        { const v4u u = raw[6 * ks + 3]; float x[8], y[8]; unpack8(u, x);
#pragma unroll
          for (int j = 0; j < 8; ++j) { y[j] = x[j] * eb[j]; BHt[(off + j) * 16 + t] = (bf16)f2bf(x[j] * eh[j]); }
          const v4u p = pack8(y); fBb[ks] = __builtin_bit_cast(bf16x8, p); }
        { const v4u u = raw[6 * ks + 4]; float x[8], y[8]; unpack8(u, x);
#pragma unroll
          for (int j = 0; j < 8; ++j) { y[j] = x[j] * eb[j]; KHt[(off + j) * 16 + t] = (bf16)f2bf(x[j] * eh[j]); }
          const v4u p = pack8(y); fKb[ks] = __builtin_bit_cast(bf16x8, p); }
        { const v4u u = raw[6 * ks + 5];
          const bf16 e0 = (bf16)(u.x & 0xffff), e1 = (bf16)(u.x >> 16), e2 = (bf16)(u.y & 0xffff), e3 = (bf16)(u.y >> 16), e4 = (bf16)(u.z & 0xffff), e5 = (bf16)(u.z >> 16), e6 = (bf16)(u.w & 0xffff), e7 = (bf16)(u.w >> 16);
          VTt[(off + 0) * 16 + t] = e0; VTt[(off + 1) * 16 + t] = e1; VTt[(off + 2) * 16 + t] = e2; VTt[(off + 3) * 16 + t] = e3; VTt[(off + 4) * 16 + t] = e4; VTt[(off + 5) * 16 + t] = e5; VTt[(off + 6) * 16 + t] = e6; VTt[(off + 7) * 16 + t] = e7; }
        __builtin_amdgcn_sched_barrier(0);
    }
    asm volatile("" ::: "memory");
    const f32x4 z4 = (f32x4){0.f, 0.f, 0.f, 0.f};
    f32x4 n0 = mma16(fAb[1], fBb[1], mma16(fAb[0], fBb[0], z4)), aak = mma16(fAb[1], fKb[1], mma16(fAb[0], fKb[0], z4));
    f32x4 arb = mma16(fRb[1], fBb[1], mma16(fRb[0], fBb[0], z4)), ark = mma16(fRb[1], fKb[1], mma16(fRb[0], fKb[0], z4));
#pragma unroll
    for (int r = 0; r < 4; ++r) { const int tt = 4 * kg + r; if (!(t < tt)) { n0[r] = 0.f; aak[r] = 0.f; } if (!(t <= tt)) { arb[r] = 0.f; ark[r] = 0.f; } }
    st_rowmaj(AK_r, aak, lane); st_rowmaj(RB2, arb, lane); st_rowmaj(RK_r, ark, lane); asm volatile("" ::: "memory");
    f32x4 accT = n0;
#pragma unroll
    for (int r = 0; r < 4; ++r) accT[r] += (4 * kg + r == t) ? 1.f : 0.f;
    f32x4 nn = n0;
#pragma unroll
    for (int itn = 0; itn < 3; ++itn) {
        st_rowmaj(N_r, nn, lane); st_colmaj(N_c, 0, nn, lane); st_rowmaj(T_r, accT, lane); asm volatile("" ::: "memory");
        const bf16x8 fa = frag16(N_r, 0, lane), fb = frag16(N_c, 0, lane), ft = frag16(T_r, 0, lane);
        nn = mma16(fa, fb, z4); asm volatile("" ::: "memory");
        st_colmaj(N_c, 0, nn, lane); asm volatile("" ::: "memory");
        const bf16x8 fb2 = frag16(N_c, 0, lane);
        accT = mma16(ft, fb2, accT); asm volatile("" ::: "memory");
    }
    st_rowmaj(T_r, accT, lane); asm volatile("" ::: "memory");
    const bf16x8 fT = frag16(T_r, 0, lane), fAK = frag16(AK_r, 0, lane), fARB = frag16(RB2, 0, lane), fARK = frag16(RK_r, 0, lane);
#pragma unroll
    for (int kt = 0; kt < 4; ++kt) { const f32x4 dd = mma16(fT, frag16(ATt, 16 * kt, lane), z4); st_colmaj(WAt, 16 * kt, dd, lane); } asm volatile("" ::: "memory");
    { const bf16x8 fArbT = frag16(RB2, 0, lane);
#pragma unroll
      for (int kt = 0; kt < 4; ++kt) { const v2u ri = *(const LAS v2u*)(RBr + t * 64 + 16 * kt + 4 * kg);
          f32x4 c0 = (f32x4){bflo(ri.x), bfhi(ri.x), bflo(ri.y), bfhi(ri.y)};
          c0 = mma16(frag16(WAt, 16 * kt, lane), fArbT, c0);
          v2u o; o.x = pk2(c0[0], c0[1]); o.y = pk2(c0[2], c0[3]); *(v2u*)(slot + RWS_QY + (t * 64 + 16 * kt + 4 * kg) * 2) = o; } }
    asm volatile("" ::: "memory");
#pragma unroll
    for (int vt = 0; vt < 4; ++vt) { const f32x4 dd = mma16(fAK, frag16(VTt, 16 * vt, lane), z4); st_colmaj(ATt, 16 * vt, dd, lane); } asm volatile("" ::: "memory");
    asm volatile("" ::: "memory");
    LAS bf16* UVt = RBr;
#pragma unroll
    for (int vt = 0; vt < 4; ++vt) { const f32x4 dd = mma16(fT, frag16(ATt, 16 * vt, lane), z4); st_colmaj(UVt, 16 * vt, dd, lane); } asm volatile("" ::: "memory");
#pragma unroll
    for (int vt = 0; vt < 4; ++vt) { const f32x4 dd = mma16(fARK, frag16(VTt, 16 * vt, lane), mma16(fARB, frag16(UVt, 16 * vt, lane), z4));
        v2u o; o.x = pk2(dd[0], dd[1]); o.y = pk2(dd[2], dd[3]); *(v2u*)(slot + RWS_YV + ((16 * vt + t) * 16 + 4 * kg) * 2) = o; }
#pragma unroll
    for (int ktp = 0; ktp < 4; ++ktp) { const bf16x8 fBh = frag16(BHt, 16 * ktp, lane);
#pragma unroll
        for (int kt = 0; kt < 4; ++kt) { f32x4 dd = mma16(frag16(WAt, 16 * kt, lane), fBh, z4);
            if (kt == ktp) {
#pragma unroll
                for (int r = 0; r < 4; ++r) if (4 * kg + r == t) dd[r] += GCl[16 * kt + t]; }
            v2u o; o.x = pk2(dd[0], dd[1]); o.y = pk2(dd[2], dd[3]); *(v2u*)(slot + RWS_PZ + ((16 * ktp + t) * 64 + 16 * kt + 4 * kg) * 2) = o; } }
#pragma unroll
    for (int vt = 0; vt < 4; ++vt) { const bf16x8 fU = frag16(UVt, 16 * vt, lane), fV = frag16(VTt, 16 * vt, lane);
#pragma unroll
        for (int ktp = 0; ktp < 4; ++ktp) { const f32x4 dd = mma16(frag16(KHt, 16 * ktp, lane), fV, mma16(frag16(BHt, 16 * ktp, lane), fU, z4));
            v2u o; o.x = pk2(dd[0], dd[1]); o.y = pk2(dd[2], dd[3]); *(v2u*)(slot + RWS_ZV + ((16 * vt + t) * 64 + 16 * ktp + 4 * kg) * 2) = o; } }
}
__device__ __forceinline__ void rw_chunk_task2(const Ctx& F, const v4u (&raw)[12], LAS unsigned char* wl, f32x4 (&yv)[4], f32x4 (&zv)[4][4]) {
    const LAS v4u* zp16 = (const LAS v4u*)(F.lds + LDS_ZERO16);
    const int lane = opaque_v(F.lane), t = lane & 15, kg = lane >> 4;
    LAS bf16* ATt = (LAS bf16*)(wl); LAS bf16* RBr = (LAS bf16*)(wl + 2048); LAS bf16* BHt = (LAS bf16*)(wl + 4096); LAS bf16* KHt = (LAS bf16*)(wl + 6144); LAS bf16* VTt = (LAS bf16*)(wl + 8192);
    LAS bf16* WAt = (LAS bf16*)(wl + 10240); LAS bf16* N_r = (LAS bf16*)(wl + 12288); LAS bf16* N_c = (LAS bf16*)(wl + 12800); LAS bf16* T_r = (LAS bf16*)(wl + 13312);
    LAS bf16* AK_r = (LAS bf16*)(wl + 13824); LAS bf16* RB2 = (LAS bf16*)(wl + 14336); LAS bf16* RK_r = (LAS bf16*)(wl + 14848); LAS float* GCl = (LAS float*)(wl + 15360);
    bf16x8 fAb[2], fRb[2], fBb[2], fKb[2];
#pragma unroll
    for (int ks = 0; ks < 2; ++ks) {
        const int off = 32 * ks + 8 * kg;
        float ea[8], er[8], eb[8], eh[8];
        { const v4u uld = raw[6 * ks + 0]; float ld[8]; unpack8(uld, ld);
#pragma unroll
          for (int j = 0; j < 8; ++j) { float c = ld[j]; c += dpp_shr(c, 1); c += dpp_shr(c, 2); c += dpp_shr(c, 4); c += dpp_shr(c, 8);
              const float tot = __builtin_bit_cast(float, __builtin_amdgcn_ds_bpermute((lane | 15) << 2, __builtin_bit_cast(int, c)));
              ea[j] = __expf(c - ld[j]); er[j] = __expf(c); eb[j] = __expf(-c); eh[j] = __expf(tot - c);
              if (t == 0) GCl[off + j] = __expf(tot); } }
        { const v4u u = raw[6 * ks + 1]; float x[8]; unpack8(u, x);
#pragma unroll
          for (int j = 0; j < 8; ++j) { x[j] = -x[j] * ea[j]; ATt[(off + j) * 16 + t] = (bf16)f2bf(x[j]); }
          const v4u p = pack8(x); fAb[ks] = __builtin_bit_cast(bf16x8, p); }
        { const v4u u = raw[6 * ks + 2]; float x[8]; unpack8(u, x);
#pragma unroll
          for (int j = 0; j < 8; ++j) x[j] = x[j] * er[j];
          const v4u p = pack8(x); fRb[ks] = __builtin_bit_cast(bf16x8, p); *(LAS v4u*)(RBr + t * 64 + off) = p; }
        { const v4u u = raw[6 * ks + 3]; float x[8], y[8]; unpack8(u, x);
#pragma unroll
          for (int j = 0; j < 8; ++j) { y[j] = x[j] * eb[j]; BHt[(off + j) * 16 + t] = (bf16)f2bf(x[j] * eh[j]); }
          const v4u p = pack8(y); fBb[ks] = __builtin_bit_cast(bf16x8, p); }
        { const v4u u = raw[6 * ks + 4]; float x[8], y[8]; unpack8(u, x);
#pragma unroll
          for (int j = 0; j < 8; ++j) { y[j] = x[j] * eb[j]; KHt[(off + j) * 16 + t] = (bf16)f2bf(x[j] * eh[j]); }
          const v4u p = pack8(y); fKb[ks] = __builtin_bit_cast(bf16x8, p); }
        { const v4u u = raw[6 * ks + 5];
          const bf16 e0 = (bf16)(u.x & 0xffff), e1 = (bf16)(u.x >> 16), e2 = (bf16)(u.y & 0xffff), e3 = (bf16)(u.y >> 16), e4 = (bf16)(u.z & 0xffff), e5 = (bf16)(u.z >> 16), e6 = (bf16)(u.w & 0xffff), e7 = (bf16)(u.w >> 16);
          VTt[(off + 0) * 16 + t] = e0; VTt[(off + 1) * 16 + t] = e1; VTt[(off + 2) * 16 + t] = e2; VTt[(off + 3) * 16 + t] = e3; VTt[(off + 4) * 16 + t] = e4; VTt[(off + 5) * 16 + t] = e5; VTt[(off + 6) * 16 + t] = e6; VTt[(off + 7) * 16 + t] = e7; }
        __builtin_amdgcn_sched_barrier(0);
    }
    asm volatile("" ::: "memory");
    const f32x4 z4 = (f32x4){0.f, 0.f, 0.f, 0.f};
    f32x4 n0 = mma16(fAb[1], fBb[1], mma16(fAb[0], fBb[0], z4)), aak = mma16(fAb[1], fKb[1], mma16(fAb[0], fKb[0], z4));
    f32x4 arb = mma16(fRb[1], fBb[1], mma16(fRb[0], fBb[0], z4)), ark = mma16(fRb[1], fKb[1], mma16(fRb[0], fKb[0], z4));
#pragma unroll
    for (int r = 0; r < 4; ++r) { const int tt = 4 * kg + r; if (!(t < tt)) { n0[r] = 0.f; aak[r] = 0.f; } if (!(t <= tt)) { arb[r] = 0.f; ark[r] = 0.f; } }
    st_rowmaj(AK_r, aak, lane); st_rowmaj(RB2, arb, lane); st_rowmaj(RK_r, ark, lane); asm volatile("" ::: "memory");
    f32x4 accT = n0;
#pragma unroll
    for (int r = 0; r < 4; ++r) accT[r] += (4 * kg + r == t) ? 1.f : 0.f;
    f32x4 nn = n0;
#pragma unroll
    for (int itn = 0; itn < 3; ++itn) {
        st_rowmaj(N_r, nn, lane); st_colmaj(N_c, 0, nn, lane); st_rowmaj(T_r, accT, lane); asm volatile("" ::: "memory");
        const bf16x8 fa = frag16(N_r, 0, lane), fb = frag16(N_c, 0, lane), ft = frag16(T_r, 0, lane);
        nn = mma16(fa, fb, z4); asm volatile("" ::: "memory");
        st_colmaj(N_c, 0, nn, lane); asm volatile("" ::: "memory");
        const bf16x8 fb2 = frag16(N_c, 0, lane);
        accT = mma16(ft, fb2, accT); asm volatile("" ::: "memory");
    }
    st_rowmaj(T_r, accT, lane); asm volatile("" ::: "memory");
    const bf16x8 fT = frag16(T_r, 0, lane), fAK = frag16(AK_r, 0, lane), fARB = frag16(RB2, 0, lane), fARK = frag16(RK_r, 0, lane);
#pragma unroll
    for (int kt = 0; kt < 4; ++kt) { const f32x4 dd = mma16(fT, frag16(ATt, 16 * kt, lane), z4); st_colmaj(WAt, 16 * kt, dd, lane); } asm volatile("" ::: "memory");
    f32x4 qy[4];
    { const bf16x8 fArbT = frag16(RB2, 0, lane);
#pragma unroll
      for (int kt = 0; kt < 4; ++kt) { const v2u ri = *(const LAS v2u*)(RBr + t * 64 + 16 * kt + 4 * kg);
          qy[kt] = mma16(frag16(WAt, 16 * kt, lane), fArbT, (f32x4){bflo(ri.x), bfhi(ri.x), bflo(ri.y), bfhi(ri.y)}); } }
    asm volatile("" ::: "memory");
#pragma unroll
    for (int vt = 0; vt < 4; ++vt) { const f32x4 dd = mma16(fAK, frag16(VTt, 16 * vt, lane), z4); st_colmaj(ATt, 16 * vt, dd, lane); } asm volatile("" ::: "memory");
    LAS bf16* UVt = RBr;
#pragma unroll
    for (int vt = 0; vt < 4; ++vt) { const f32x4 dd = mma16(fT, frag16(ATt, 16 * vt, lane), z4); st_colmaj(UVt, 16 * vt, dd, lane); } asm volatile("" ::: "memory");
#pragma unroll
    for (int vt = 0; vt < 4; ++vt) { const bf16x8 fU = frag16(UVt, 16 * vt, lane), fV = frag16(VTt, 16 * vt, lane);
        yv[vt] = mma16(fARK, fV, mma16(fARB, fU, z4));
#pragma unroll
        for (int ktp = 0; ktp < 4; ++ktp) zv[vt][ktp] = mma16(frag16(KHt, 16 * ktp, lane), fV, mma16(frag16(BHt, 16 * ktp, lane), fU, z4)); }
    f32x4 pz[4][4];
#pragma unroll
    for (int ktp = 0; ktp < 4; ++ktp) { const bf16x8 fBh = frag16(BHt, 16 * ktp, lane);
#pragma unroll
        for (int kt = 0; kt < 4; ++kt) { f32x4 dd = mma16(frag16(WAt, 16 * kt, lane), fBh, z4);
            if (kt == ktp) {
#pragma unroll
                for (int r = 0; r < 4; ++r) if (4 * kg + r == t) dd[r] += GCl[16 * kt + t]; }
            pz[ktp][kt] = dd; } }
    asm volatile("s_waitcnt lgkmcnt(0)" ::: "memory");
#pragma unroll
    for (int ktp = 0; ktp < 4; ++ktp) { LAS bf16* reg = (LAS bf16*)(wl + (ktp < 2 ? ktp * 2048 : (ktp + 1) * 2048));
#pragma unroll
        for (int kt = 0; kt < 4; ++kt) { v2u o; o.x = pk2(pz[ktp][kt][0], pz[ktp][kt][1]); o.y = pk2(pz[ktp][kt][2], pz[ktp][kt][3]); *(LAS v2u*)(reg + t * 64 + 16 * kt + 4 * kg) = o; } }
#pragma unroll
    for (int kt = 0; kt < 4; ++kt) { v2u o; o.x = pk2(qy[kt][0], qy[kt][1]); o.y = pk2(qy[kt][2], qy[kt][3]); *(LAS v2u*)(BHt + t * 64 + 16 * kt + 4 * kg) = o; }
    asm volatile("s_waitcnt lgkmcnt(0)" ::: "memory");
}
constexpr int RWZ_OFF = LDSCTL_OFF + 8192, RWF_OFF = LDSCTL_OFF + 2048;
__device__ __forceinline__ void rw_chunk_item2(const Ctx& F, int l, int it, size_t yoff = WS_YDIR) {
    const auto& a = *F.a; unsigned char* ws = a.ws; const int lane = opaque_v(F.lane), t = lane & 15, kg = lane >> 4;
    const int d = it & 1, h = (it >> 1) & 7, b = it >> 4;
    float* YD = (float*)(ws + yoff);
    LAS unsigned char* wl = F.lds + F.wave * 15616;
    LAS bf16* ZS = (LAS bf16*)(F.lds + RWZ_OFF);
    volatile LAS int* flag = (volatile LAS int*)(F.lds + RWF_OFF);
    for (int i = F.tid; i < 2048; i += NTHREADS) ((LAS unsigned*)ZS)[i] = 0u;
    if (F.tid == 0) *flag = 0;
    __syncthreads();
    constexpr int NCHK = (CTXL + SEQ) / 16;
    v4u raw[12];
    rw_chunk_load<0, 2>(F, b, h, d, F.wave, raw);
#pragma unroll 1
    for (int c = F.wave; c < NCHK; c += NWAVES) {
        f32x4 yv[4], zv[4][4];
        rw_chunk_task2(F, raw, wl, yv, zv);
        if (c + NWAVES < NCHK) rw_chunk_load<0, 2>(F, b, h, d, c + NWAVES, raw);
        while (*flag < c) __builtin_amdgcn_s_sleep(1);
        asm volatile("" ::: "memory");
        const LAS bf16* Zc = ZS + (c & 1) * 4096; LAS bf16* Zn = ZS + ((c + 1) & 1) * 4096;
        bf16x8 zb[4][2];
#pragma unroll
        for (int vb = 0; vb < 4; ++vb)
#pragma unroll
            for (int ks = 0; ks < 2; ++ks) zb[vb][ks] = *(const LAS bf16x8*)(Zc + (16 * vb + t) * 64 + 32 * ks + 8 * kg);
        { const LAS bf16* Qr = (const LAS bf16*)(wl + 4096); const bf16x8 q0 = *(const LAS bf16x8*)(Qr + t * 64 + 8 * kg), q1 = *(const LAS bf16x8*)(Qr + t * 64 + 32 + 8 * kg);
#pragma unroll
          for (int vb = 0; vb < 4; ++vb) { const f32x4 y = mma16(q1, zb[vb][1], mma16(q0, zb[vb][0], yv[vb]));
#pragma unroll
              for (int r = 0; r < 4; ++r) { const int row = seq_row(b, d, c * 16 + 4 * kg + r); YD[((size_t)d * T_ALL + row) * 512 + h * 64 + 16 * vb + t] = y[r]; } } }
#pragma unroll
        for (int ktp = 0; ktp < 4; ++ktp) { const LAS bf16* Pr = (const LAS bf16*)(wl + (ktp < 2 ? ktp * 2048 : (ktp + 1) * 2048));
            const bf16x8 p0 = *(const LAS bf16x8*)(Pr + t * 64 + 8 * kg), p1 = *(const LAS bf16x8*)(Pr + t * 64 + 32 + 8 * kg);
#pragma unroll
            for (int vb = 0; vb < 4; ++vb) { const f32x4 z = mma16(p1, zb[vb][1], mma16(p0, zb[vb][0], zv[vb][ktp]));
                v2u o; o.x = pk2(z[0], z[1]); o.y = pk2(z[2], z[3]); *(LAS v2u*)(Zn + (16 * vb + t) * 64 + 16 * ktp + 4 * kg) = o; } }
        asm volatile("s_waitcnt lgkmcnt(0)" ::: "memory");
        if (lane == 0) *flag = c + 1;
        asm volatile("s_waitcnt lgkmcnt(0)" ::: "memory");
    }
    __syncthreads();
}
__device__ __forceinline__ v2u ld_sc1_8(const void* p) { const unsigned long long v = __hip_atomic_load((const unsigned long long*)p, __ATOMIC_RELAXED, __HIP_MEMORY_SCOPE_AGENT); v2u o; o.x = (unsigned)v; o.y = (unsigned)(v >> 32); return o; }
__device__ __forceinline__ v4u ld_sc1_16(const void* p) { const v2u a = ld_sc1_8(p), b = ld_sc1_8((const char*)p + 8); return (v4u){a.x, a.y, b.x, b.y}; }
__device__ __forceinline__ void rw_chunk_item(const Ctx& F, int l, int it) {
    const auto& a = *F.a; unsigned char* ws = a.ws; const int lane = F.lane, t = lane & 15, kg = lane >> 4;
    const int d = it & 1, h = (it >> 1) & 7, b = it >> 4;
    float* YD = (float*)(ws + WS_YDIR);
    unsigned char* scr = ws + WS_RWSCR + (size_t)F.bid * 16 * RWS_SLOT;
    LAS unsigned char* wl = F.lds + F.wave * 15616;
    LAS bf16* ZL = (LAS bf16*)(F.lds + LDSCTL_OFF + 4096 + (F.wave & 3) * 2048);
    if (F.wave < 4) { for (int i = lane; i < 512; i += 64) ((LAS unsigned*)ZL)[i] = 0u; }
    asm volatile("" ::: "memory");
    constexpr int NCHK = (CTXL + SEQ) / 16, NB = NCHK / 16;
#pragma unroll 1
    for (int bt = 0; bt < NB; ++bt) {
        { v4u cur[12];
#pragma unroll 1
          for (int jj = 0; jj < 2; ++jj) { rw_chunk_load<0, 2>(F, b, h, d, bt * 16 + F.wave + 8 * jj, cur); rw_chunk_task(F, cur, wl, scr + (size_t)(F.wave + 8 * jj) * RWS_SLOT); } }
        asm volatile("s_waitcnt vmcnt(0)" ::: "memory");
        __syncthreads();
        {
            const int t = opaque_v(lane & 15), kg = opaque_v(lane >> 4), vb = opaque(F.wave) & 3;
            const unsigned char* scrb = F.a->ws + WS_RWSCR + (size_t)opaque(F.bid) * 16 * RWS_SLOT;
            LAS unsigned char* sbuf = F.lds;
            const int lt = opaque_v(F.tid) & 255; const bool loader = F.wave >= 4;
            const int lw = opaque(F.wave) & 3;
#define RWB_ISSUE(j_) do { const unsigned char* gp_ = scrb + (size_t)(j_) * RWS_SLOT + (size_t)(lw * 5) * 1024 + lane * 16; LAS unsigned char* lp_ = sbuf + ((j_) % 6) * RWS_SLOT + (lw * 5) * 1024; \
                _Pragma("unroll") for (int q = 0; q < 5; ++q) __builtin_amdgcn_global_load_lds((const unsigned*)(gp_ + q * 1024), (LAS unsigned*)(lp_ + q * 1024), 16, 0, 16); } while (0)
#define RWB_COMP(bi_, j_) do { const LAS unsigned char* sl_ = sbuf + (bi_) * RWS_SLOT; bf16x8 zb[2], qf[2]; \
                _Pragma("unroll") for (int ks = 0; ks < 2; ++ks) { zb[ks] = *(const LAS bf16x8*)(ZL + t * 64 + 32 * ks + 8 * kg); qf[ks] = *(const LAS bf16x8*)(sl_ + RWS_QY + (t * 64 + 32 * ks + 8 * kg) * 2); } \
                const v2u y_ = *(const LAS v2u*)(sl_ + RWS_YV + ((16 * vb + t) * 16 + 4 * kg) * 2); \
                f32x4 yacc = (f32x4){bflo(y_.x), bfhi(y_.x), bflo(y_.y), bfhi(y_.y)}; \
                yacc = mma16(qf[1], zb[1], mma16(qf[0], zb[0], yacc)); \
                f32x4 zn[4]; \
                _Pragma("unroll") for (int ktp = 0; ktp < 4; ++ktp) { const v2u z_ = *(const LAS v2u*)(sl_ + RWS_ZV + ((16 * vb + t) * 64 + 16 * ktp + 4 * kg) * 2); \
                    f32x4 zc = (f32x4){bflo(z_.x), bfhi(z_.x), bflo(z_.y), bfhi(z_.y)}; \
                    _Pragma("unroll") for (int ks = 0; ks < 2; ++ks) zc = mma16(*(const LAS bf16x8*)(sl_ + RWS_PZ + ((16 * ktp + t) * 64 + 32 * ks + 8 * kg) * 2), zb[ks], zc); \
                    zn[ktp] = zc; } \
                _Pragma("unroll") for (int r = 0; r < 4; ++r) { const int row = seq_row(b, d, (bt * 16 + (j_)) * 16 + 4 * kg + r); YD[((size_t)d * T_ALL + row) * 512 + h * 64 + 16 * vb + t] = yacc[r]; } \
                asm volatile("s_waitcnt lgkmcnt(0)" ::: "memory"); \
                _Pragma("unroll") for (int ktp = 0; ktp < 4; ++ktp) { v2u o; o.x = pk2(zn[ktp][0], zn[ktp][1]); o.y = pk2(zn[ktp][2], zn[ktp][3]); *(LAS v2u*)(ZL + t * 64 + 16 * ktp + 4 * kg) = o; } \
                asm volatile("s_waitcnt lgkmcnt(0)" ::: "memory"); } while (0)
#define RWB_BAR() do { asm volatile("s_waitcnt lgkmcnt(0)" ::: "memory"); __builtin_amdgcn_s_barrier(); asm volatile("" ::: "memory"); } while (0)
            if (loader) { RWB_ISSUE(0); RWB_ISSUE(1); RWB_ISSUE(2); RWB_ISSUE(3); asm volatile("s_waitcnt vmcnt(15)" ::: "memory"); }
            RWB_BAR();
#pragma unroll 1
            for (int j = 0; j < 16; ++j) {
                if (loader) { if (j + 4 < 16) { RWB_ISSUE(j + 4); asm volatile("s_waitcnt vmcnt(15)" ::: "memory"); } else { asm volatile("s_waitcnt vmcnt(0)" ::: "memory"); } }
                else { RWB_COMP(j % 6, j); }
                RWB_BAR();
            }
#undef RWB_BAR
#undef RWB_ISSUE
#undef RWB_COMP
        }
        __syncthreads();
    }
}

__device__ __forceinline__ void stage_rw_readout(const Ctx& F, int l) {
    const auto& a = *F.a; unsigned char* ws = a.ws; const int lane = F.lane;
    const bf16* SCN = (const bf16*)(ws + WS_SCN); const bf16* P = (const bf16*)(ws + WS_P); const float* YD = (const float*)(ws + WS_YDIR); bf16* YRW = (bf16*)(ws + WS_YRW);
    const int gw = F.bid * NWAVES + F.wave, NGW = F.G * NWAVES;
    constexpr int TR = 17, NRT = T_ALL / TR;
    for (int tile = gw; tile < NRT * 4; tile += NGW) {
        const int rt = tile % NRT, hp = tile / NRT, row0 = rt * TR, c0 = hp * 128 + 2 * lane;
        const f32x2 rk = *(const f32x2*)(a.in[I_RWRK] + l * 512 + c0), lng = *(const f32x2*)(a.in[I_RWLNG] + l * 512 + c0), lnb = *(const f32x2*)(a.in[I_RWLNB] + l * 512 + c0);
#pragma unroll 4
        for (int i = 0; i < TR; ++i) {
            const int row = row0 + i;
            const unsigned* sp = (const unsigned*)(SCN + (size_t)row * 9 * 512 + c0);
            const unsigned ru = sp[0], vu = sp[256], k0u = sp[4 * 256], k1u = sp[7 * 256];
            const f32x2 y0 = *(const f32x2*)(YD + (size_t)row * 512 + c0), y1 = *(const f32x2*)(YD + ((size_t)T_ALL + row) * 512 + c0);
            const unsigned gu = *(const unsigned*)(P + (size_t)row * 2560 + 2048 + c0);
            const float bon = red32(bflo(ru) * (bflo(k0u) + bflo(k1u)) * rk[0] + bfhi(ru) * (bfhi(k0u) + bfhi(k1u)) * rk[1]);
            f32x2 y = y0 + y1 + (f32x2){bflo(vu), bfhi(vu)} * bon;
            const float mu = red32(y[0] + y[1]) * (1.f / 64.f);
            y = y - mu;
            const float var = red32(y[0] * y[0] + y[1] * y[1]) * (1.f / 64.f);
            const f32x2 yn = y * (__builtin_amdgcn_rsqf(var + 64e-5f));
            const f32x2 ov = (yn * lng + lnb) * (f32x2){bflo(gu), bfhi(gu)};
            *(unsigned*)(YRW + (size_t)row * 512 + c0) = pk2(ov[0], ov[1]);
        }
    }
}

constexpr size_t WS_S5E = 6 * MiB;
constexpr int S5_NSEG = 4, S5_SEGLEN = (CTXL + SEQ) / S5_NSEG;
__device__ __forceinline__ void s5_disc(const float are, const float aim, const float dt, float& lbr, float& lbi, float& cr, float& ci) {
    const float mag = expf(are * dt); lbr = mag * cosf(aim * dt); lbi = mag * sinf(aim * dt);
    const float den = are * are + aim * aim, nr = lbr - 1.0f; cr = (nr * are + lbi * aim) / den; ci = (lbi * are - nr * aim) / den;
}
template <int PASS>
__device__ __forceinline__ void stage_s5_scan(const Ctx& F, int l) {
    const auto& a = *F.a; unsigned char* ws = a.ws; const int lane = F.lane;
    const bf16* Z = (const bf16*)(ws + WS_Z); float* YP = (float*)(ws + WS_YP); f32x2* S5E = (f32x2*)(ws + WS_S5E);
    LAS unsigned char* wl = F.lds + F.wave * 16384;
    LAS float* buL = (LAS float*)wl;
    LAS bf16* Hs = (LAS bf16*)(wl + 8704);
    const int fr = lane & 15, kg = lane >> 4;
    for (int itx = F.bid * NWAVES + F.wave; itx < BATCH * 32 * 2 * S5_NSEG; itx += NWAVES * F.G) {
        const int seg = itx & (S5_NSEG - 1), it = itx >> 2;
        const int d = it & 1, g = (it >> 1) & 31, b = it >> 6, p = lane;
        const float dt = expf(a.in[I_S5LDT][(l * 2 + d) * 32 + g]);
        const float* arep = a.in[I_S5ARE] + ((size_t)(l * 2 + d) * 32 + g) * 64; const float* aimp = a.in[I_S5AIM] + ((size_t)(l * 2 + d) * 32 + g) * 64;
        float lbr, lbi, cr_, ci_; s5_disc(arep[p], aimp[p], dt, lbr, lbi, cr_, ci_);
        bf16x8 afr[2][4];
#pragma unroll
        for (int tl = 0; tl < 4; ++tl) { const int pp = 16 * tl + fr; float r0_, r1_, cr, ci; s5_disc(arep[pp], aimp[pp], dt, r0_, r1_, cr, ci);
            v4u pr = (v4u){0u, 0u, 0u, 0u}, pi = (v4u){0u, 0u, 0u, 0u};
            if (kg < 2) { const float* br = a.in[I_S5BRE] + (((size_t)l * 32 + g) * 64 + pp) * 16 + 8 * kg; const float* bi = a.in[I_S5BIM] + (((size_t)l * 32 + g) * 64 + pp) * 16 + 8 * kg;
                const f32x4 x0 = *(const f32x4*)br, x1 = *(const f32x4*)(br + 4), y0 = *(const f32x4*)bi, y1 = *(const f32x4*)(bi + 4);
                pr.x = pk2(cr * x0[0] - ci * y0[0], cr * x0[1] - ci * y0[1]); pr.y = pk2(cr * x0[2] - ci * y0[2], cr * x0[3] - ci * y0[3]);
                pr.z = pk2(cr * x1[0] - ci * y1[0], cr * x1[1] - ci * y1[1]); pr.w = pk2(cr * x1[2] - ci * y1[2], cr * x1[3] - ci * y1[3]);
                pi.x = pk2(cr * y0[0] + ci * x0[0], cr * y0[1] + ci * x0[1]); pi.y = pk2(cr * y0[2] + ci * x0[2], cr * y0[3] + ci * x0[3]);
                pi.z = pk2(cr * y1[0] + ci * x1[0], cr * y1[1] + ci * x1[1]); pi.w = pk2(cr * y1[2] + ci * x1[2], cr * y1[3] + ci * x1[3]); }
            afr[0][tl] = __builtin_bit_cast(bf16x8, pr); afr[1][tl] = __builtin_bit_cast(bf16x8, pi); }
        bf16x8 cf[4];
        f32x2 hst = (f32x2){0.f, 0.f};
        if (PASS == 1) {
#pragma unroll
            for (int kk = 0; kk < 4; ++kk) { const int p0 = 16 * kk + 4 * kg;
                const f32x4 c0 = *(const f32x4*)(a.in[I_S5CRE] + (((size_t)l * 32 + g) * 16 + fr) * 64 + p0), c1 = *(const f32x4*)(a.in[I_S5CIM] + (((size_t)l * 32 + g) * 16 + fr) * 64 + p0);
                v4u pk; pk.x = pk2(c0[0], -c1[0]); pk.y = pk2(c0[1], -c1[1]); pk.z = pk2(c0[2], -c1[2]); pk.w = pk2(c0[3], -c1[3]);
                cf[kk] = __builtin_bit_cast(bf16x8, pk); }
            float pr_ = lbr, pi_ = lbi, l64r = 1.f, l64i = 0.f;
#pragma unroll 1
            for (int q = 0; q < 10; ++q) { const float nr2 = pr_ * pr_ - pi_ * pi_, ni2 = 2.f * pr_ * pi_; pr_ = nr2; pi_ = ni2; if (q == 5) { l64r = pr_; l64i = pi_; } }
            const float lLr = pr_ * l64r - pi_ * l64i, lLi = pr_ * l64i + pi_ * l64r;
#pragma unroll 1
            for (int sgi = 0; sgi < seg; ++sgi) { const f32x2 ev = S5E[((size_t)it * S5_NSEG + sgi) * 64 + p];
                hst = (f32x2){lLr * hst[0] - lLi * hst[1] + ev[0], lLr * hst[1] + lLi * hst[0] + ev[1]}; }
        }
        const f32x2 lbr2 = (f32x2){lbr, lbr}, lbi2 = (f32x2){lbi, lbi};
        const int sbeg = seg * S5_SEGLEN, send = sbeg + S5_SEGLEN;
        v4u un = (v4u){0u, 0u, 0u, 0u}, un2 = un, un3 = un, uc;
#define S5_LOADU(dst_, s0_) do { if (kg < 2) { const int row_ = seq_row(b, d, (s0_) + fr); dst_ = *(const v4u*)(Z + (size_t)row_ * IN_COLS + S5_OFF + g * 16 + kg * 8); } } while (0)
        S5_LOADU(un, sbeg); S5_LOADU(un2, sbeg + 16); S5_LOADU(un3, sbeg + 32);
#pragma unroll 1
        for (int s0 = sbeg; s0 < send; s0 += 16) {
            uc = un; un = un2; un2 = un3;
            if (s0 + 48 < send) S5_LOADU(un3, s0 + 48);
            const bf16x8 ufr = __builtin_bit_cast(bf16x8, uc);
#pragma unroll
            for (int c = 0; c < 2; ++c)
#pragma unroll
                for (int tl = 0; tl < 4; ++tl) { const f32x4 dd = __builtin_amdgcn_mfma_f32_16x16x32_bf16(afr[c][tl], ufr, (f32x4){0.f, 0.f, 0.f, 0.f}, 0, 0, 0);
                    *(LAS f32x4*)(buL + (c * 16 + fr) * 68 + 16 * tl + 4 * kg) = dd; }
            LDS_WAIT(); asm volatile("" ::: "memory");
            f32x2 bu[16];
#pragma unroll
            for (int s = 0; s < 16; ++s) bu[s] = (f32x2){buL[s * 68 + p], buL[(16 + s) * 68 + p]};
#pragma unroll
            for (int s = 0; s < 16; ++s) {
                const f32x2 sw = (f32x2){-hst[1], hst[0]};
                hst = lbr2 * hst + (lbi2 * sw + bu[s]);
                if (PASS == 1) *(LAS unsigned*)(Hs + s * 136 + 2 * p) = pg8::cvt_pk_bf16(hst[0], hst[1]);
            }
            if (PASS == 1) {
                LDS_WAIT(); asm volatile("" ::: "memory");
                f32x4 acc = (f32x4){0.f, 0.f, 0.f, 0.f};
#pragma unroll
                for (int kk = 0; kk < 4; ++kk) { const bf16x8 af = *(const LAS bf16x8*)(Hs + fr * 136 + 32 * kk + 8 * kg); acc = __builtin_amdgcn_mfma_f32_16x16x32_bf16(af, cf[kk], acc, 0, 0, 0); }
#pragma unroll
                for (int r = 0; r < 4; ++r) { const int row = seq_row(b, d, s0 + 4 * kg + r); YP[((size_t)d * T_ALL + row) * 512 + g * 16 + fr] = acc[r]; }
            }
            LDS_WAIT(); asm volatile("" ::: "memory");
        }
        if (PASS == 0) S5E[((size_t)it * S5_NSEG + seg) * 64 + p] = hst;
#undef S5_LOADU
    }
}

__device__ __forceinline__ void stage_s5_prep(const Ctx& F, int l, int nrows) {
    const auto& a = *F.a; unsigned char* ws = a.ws;
    const bf16* Z = (const bf16*)(ws + WS_Z); const float* YP = (const float*)(ws + WS_YP); bf16* AS5 = (bf16*)(ws + WS_AS5);
    const int c = 4 * (F.tid & 127), rq = F.tid >> 7;
    const f32x4 dsk = *(const f32x4*)(a.in[I_S5D] + l * 512 + c);
#pragma unroll 4
    for (int row = F.bid * 4 + rq; row < nrows; row += F.G * 4) {
        const v2u uz = *(const v2u*)(Z + (size_t)row * IN_COLS + S5_OFF + c);
        const f32x4 y0 = *(const f32x4*)(YP + (size_t)row * 512 + c), y1 = *(const f32x4*)(YP + ((size_t)T_ALL + row) * 512 + c);
        const f32x4 u = (f32x4){bflo(uz.x), bfhi(uz.x), bflo(uz.y), bfhi(uz.y)};
        const f32x4 y = y0 + y1 + u * dsk;
        float ge[4];
#pragma unroll
        for (int j = 0; j < 4; ++j) ge[j] = 0.5f * y[j] * (1.f + tanh_fast(0.7978845608028654f * (y[j] + 0.044715f * y[j] * y[j] * y[j])));
        v2u o; o.x = pk2(ge[0], ge[1]); o.y = pk2(ge[2], ge[3]);
        *(v2u*)(AS5 + (size_t)row * 512 + c) = o;
    }
}

__device__ __forceinline__ void stage_hy_pre(const Ctx& F, int l, int nrows) {
    const auto& a = *F.a; unsigned char* ws = a.ws; const int lane = F.lane;
    const bf16* Z = (const bf16*)(ws + WS_Z); bf16* UT = (bf16*)(ws + WS_UT);
    LAS unsigned char* tl = F.lds + F.wave * 16384;
    const float* cw = a.in[I_HYCW] + (size_t)l * 3 * 1536; const float* cbp = a.in[I_HYCB] + l * 1536;
    const int gw = F.bid * NWAVES + F.wave, NGW = F.G * NWAVES;
    const int q = lane >> 3, k = lane & 7, ntile = (nrows / 64) * 24;
    v4u v[8], hv;
#define HYPRE_LOAD(tile_) do { const int rt_ = (tile_) / 24, ct_ = (tile_) % 24, row0_ = rt_ * 64; int base_, pos0_, n_; row_seq(row0_, base_, pos0_, n_); \
        const bf16* zt_ = Z + (size_t)row0_ * IN_COLS + HY_OFF + ct_ * 64 + 8 * k; hv = (v4u){0u, 0u, 0u, 0u}; \
        _Pragma("unroll") for (int i = 0; i < 8; ++i) v[i] = *(const v4u*)(zt_ + (size_t)(8 * i + q) * IN_COLS); \
        if (q == 0 && pos0_ > 0) hv = *(const v4u*)(zt_ - (size_t)IN_COLS); \
        if (q == 1 && pos0_ + 64 < n_) hv = *(const v4u*)(zt_ + (size_t)64 * IN_COLS); } while (0)
    if (gw < ntile) HYPRE_LOAD(gw);
#pragma unroll 1
    for (int tile = gw; tile < ntile; tile += NGW) {
        const int rt = tile / 24, ct = tile % 24, row0 = rt * 64, c0 = ct * 64;
        f32x4 wv[8];
#pragma unroll
        for (int i = 0; i < 8; ++i) { const int col = c0 + 8 * i + q; wv[i] = (f32x4){cw[col], cw[1536 + col], cw[2 * 1536 + col], cbp[col]}; }
#pragma unroll
        for (int i = 0; i < 8; ++i) { LAS unsigned* p = (LAS unsigned*)(tl + (1 + 8 * i + q) * 132 + 16 * k); p[0] = v[i].x; p[1] = v[i].y; p[2] = v[i].z; p[3] = v[i].w; }
        if (q < 2) { LAS unsigned* p = (LAS unsigned*)(tl + (q ? 65 : 0) * 132 + 16 * k); p[0] = hv.x; p[1] = hv.y; p[2] = hv.z; p[3] = hv.w; }
        if (tile + NGW < ntile) HYPRE_LOAD(tile + NGW);
        LDS_WAIT(); asm volatile("" ::: "memory");
#pragma unroll 2
        for (int i = 0; i < 8; ++i) {
            const int ch = 8 * i + q, col = c0 + ch;
            const LAS unsigned short* s = (const LAS unsigned short*)(tl + (8 * k) * 132 + ch * 2);
            float z[10];
#pragma unroll
            for (int t = 0; t < 10; ++t) z[t] = __builtin_bit_cast(float, (unsigned)s[t * 66] << 16);
            float o[8];
#pragma unroll
            for (int t = 0; t < 8; ++t) o[t] = wv[i][0] * z[t] + wv[i][1] * z[t + 1] + wv[i][2] * z[t + 2] + wv[i][3];
            v4u w; w.x = pk2(o[0], o[1]); w.y = pk2(o[2], o[3]); w.z = pk2(o[4], o[5]); w.w = pk2(o[6], o[7]);
            *(v4u*)(UT + (size_t)col * T_ALL + row0 + 8 * k) = w;
        }
        LDS_WAIT(); asm volatile("" ::: "memory");
    }
#undef HYPRE_LOAD
}
__device__ __forceinline__ void stage_hy_post(const Ctx& F, int l, int nrows) {
    const auto& a = *F.a; unsigned char* ws = a.ws; const int lane = F.lane;
    const bf16* YT = (const bf16*)(ws + WS_UT) + (size_t)1024 * T_ALL; bf16* YHY = (bf16*)(ws + WS_YHY);
    LAS unsigned char* tl = F.lds + F.wave * 16384;
    const int gw = F.bid * NWAVES + F.wave, NGW = F.G * NWAVES;
    const int q = lane >> 3, k = lane & 7, ntile = (nrows / 64) * 8;
    v4u v[8];
#define HYPOST_LOAD(tile_) do { const bf16* yp_ = YT + (size_t)(((tile_) & 7) * 64 + q) * T_ALL + ((tile_) >> 3) * 64 + 8 * k; \
        _Pragma("unroll") for (int i = 0; i < 8; ++i) v[i] = *(const v4u*)(yp_ + (size_t)(8 * i) * T_ALL); } while (0)
    if (gw < ntile) HYPOST_LOAD(gw);
#pragma unroll 1
    for (int tile = gw; tile < ntile; tile += NGW) {
        const int rt = tile >> 3, ct = tile & 7, row0 = rt * 64, c0 = ct * 64;
#pragma unroll
        for (int i = 0; i < 8; ++i) { LAS unsigned* p = (LAS unsigned*)(tl + (8 * i + q) * 132 + 16 * k); p[0] = v[i].x; p[1] = v[i].y; p[2] = v[i].z; p[3] = v[i].w; }
        if (tile + NGW < ntile) HYPOST_LOAD(tile + NGW);
        LDS_WAIT(); asm volatile("" ::: "memory");
#pragma unroll
        for (int i = 0; i < 8; ++i) { const int r = 8 * i + q;
            const LAS unsigned short* s = (const LAS unsigned short*)(tl + (8 * k) * 132 + r * 2);
            unsigned e[8];
#pragma unroll
            for (int j = 0; j < 8; ++j) e[j] = s[j * 66];
            v4u w; w.x = e[0] | (e[1] << 16); w.y = e[2] | (e[3] << 16); w.z = e[4] | (e[5] << 16); w.w = e[6] | (e[7] << 16);
            *(v4u*)(YHY + (size_t)(row0 + r) * 512 + c0 + 8 * k) = w; }
        LDS_WAIT(); asm volatile("" ::: "memory");
    }
#undef HYPOST_LOAD
}
typedef float f32x16 __attribute__((ext_vector_type(16)));
__device__ __forceinline__ void hyena_item(const Ctx& F, int l, int c, int isctx) {
    const auto& a = *F.a; unsigned char* ws = a.ws; const int tid = F.tid, lane = F.lane;
    const int n = isctx ? CTXL : SEQ, rowbase = isctx ? T_LAT : 0, RL = isctx ? HY_RLENC : HY_RLEN, off = n + 47;
    const bf16* UT = (const bf16*)(ws + WS_UT);
    const bf16* x1g = UT + (size_t)c * T_ALL + rowbase; const bf16* x2g = UT + (size_t)(512 + c) * T_ALL + rowbase; bf16* vg = (bf16*)UT + (size_t)(1024 + c) * T_ALL + rowbase;
    const bf16* Rg = (const bf16*)(ws + WS_GF + l * GF_STRIDE + (isctx ? GF_CTX : 0)) + (size_t)c * RL;
    LAS unsigned char* XB = F.lds; LAS unsigned char* R1 = F.lds + HY_R1_OFF; LAS unsigned char* R2 = F.lds + HY_R2_OFF;
    { const int cpb = n / 8;
      for (int q = tid; q < 8 * cpb; q += NTHREADS) { const int b = q / cpb, ch = q % cpb; *(LAS v4u*)(XB + b * HY_ROWB + 2 * HY_MARG + 16 * ch) = *(const v4u*)(vg + (size_t)b * n + 8 * ch); }
      if (tid < 256) { const int b = tid >> 5, side = (tid >> 4) & 1, ch = tid & 15; const unsigned zz = (unsigned)opaque_v(0); *(LAS v4u*)(XB + b * HY_ROWB + (side ? 2 * (HY_MARG + n) : 0) + 16 * ch) = (v4u){zz, zz, zz, zz}; }
      const int rch = RL / 8;
      for (int q = tid; q < rch; q += NTHREADS) { *(LAS v4u*)(R1 + 16 * q) = *(const v4u*)(Rg + 8 * q); *(LAS v4u*)(R2 + 16 * q) = *(const v4u*)(Rg + (size_t)512 * RL + 8 * q); } }
    __syncthreads();
    const int i = lane & 31, kg = lane >> 5, jb = lane & 3, bb = (lane & 31) >> 2;
    const int rsh = (off - i) & 7, rd = rsh >> 1; const bool s1 = rd & 1, s2 = rd & 2; const unsigned sh = (rsh & 1) ? 16u : 0u;
    const int aconst = 2 * (off - i + 8 * kg - rsh), bconst = bb * HY_ROWB + 2 * (HY_MARG + 32 * jb + 8 * kg);
    const int T0w = 512 * F.wave; const int ntile = (n - T0w) >= 512 ? 4 : ((n - T0w) > 0 ? (n - T0w) / 128 : 0);
    const float bias0 = a.in[I_HYBIAS][(l * 2 + 0) * 512 + c], bias1 = a.in[I_HYBIAS][(l * 2 + 1) * 512 + c];
    f32x16 acc[4];
    v2u y1p[4][4];
#define HY_AFRAG(wa, wb, afr) do { \
        const unsigned a0 = s1 ? wa.y : wa.x, a1 = s1 ? wa.z : wa.y, a2 = s1 ? wa.w : wa.z, a3 = s1 ? wb.x : wa.w, a4 = s1 ? wb.y : wb.x, a5 = s1 ? wb.z : wb.y, a6 = s1 ? wb.w : wb.z; \
        const unsigned b0 = s2 ? a2 : a0, b1 = s2 ? a3 : a1, b2 = s2 ? a4 : a2, b3 = s2 ? a5 : a3, b4 = s2 ? a6 : a4; \
        v4u af_; af_.x = __builtin_amdgcn_alignbit(b1, b0, sh); af_.y = __builtin_amdgcn_alignbit(b2, b1, sh); af_.z = __builtin_amdgcn_alignbit(b3, b2, sh); af_.w = __builtin_amdgcn_alignbit(b4, b3, sh); \
        afr = __builtin_bit_cast(bf16x8, af_); } while (0)
#define HY_STEP_COND(RB, d) do { \
        const v4u wa = *(const LAS v4u*)((RB) + aconst - 2 * (d)), wb = *(const LAS v4u*)((RB) + aconst - 2 * (d) + 16); bf16x8 afr; HY_AFRAG(wa, wb, afr); \
        _Pragma("unroll") for (int m = 0; m < 4; ++m) { const int T0 = T0w + 128 * m; \
            if (m < ntile && (d) >= T0 - n + 16 && (d) <= T0 + 96) { const bf16x8 bfr = *(const LAS bf16x8*)(XB + bconst + 2 * (T0 - (d))); \
                acc[m] = __builtin_amdgcn_mfma_f32_32x32x16_bf16(afr, bfr, acc[m], 0, 0, 0); } } } while (0)
#define HY_LOAD(RB, d, wa, wb, bq) do { wa = *(const LAS v4u*)((RB) + aconst - 2 * (d)); wb = *(const LAS v4u*)((RB) + aconst - 2 * (d) + 16); \
        _Pragma("unroll") for (int m = 0; m < 4; ++m) bq[m] = *(const LAS bf16x8*)(XB + bconst + 2 * (T0w + 128 * m - (d))); } while (0)
#define HY_MMA(wa, wb, bq) do { bf16x8 afr; HY_AFRAG(wa, wb, afr); \
        _Pragma("unroll") for (int m = 0; m < 4; ++m) acc[m] = __builtin_amdgcn_mfma_f32_32x32x16_bf16(afr, bq[m], acc[m], 0, 0, 0); } while (0)
#define HY_CONV(RB) do { \
        _Pragma("unroll") for (int m = 0; m < 4; ++m) _Pragma("unroll") for (int e = 0; e < 16; ++e) acc[m][e] = 0.f; \
        if (ntile == 4) { \
            const int dA = T0w - n + 16, dB = T0w + 384 - n + 16, dC = T0w + 96, dD = T0w + 384 + 96;     \
            _Pragma("unroll 1") for (int d = dA; d < dB; d += 16) HY_STEP_COND(RB, d); \
            { v4u waA, wbA, waB, wbB; bf16x8 bqA[4], bqB[4]; \
              HY_LOAD(RB, dB, waA, wbA, bqA); \
              _Pragma("unroll 1") for (int d = dB; d <= dC; d += 32) { \
                  if (d + 16 <= dC) HY_LOAD(RB, d + 16, waB, wbB, bqB); \
                  __builtin_amdgcn_sched_barrier(0); \
                  HY_MMA(waA, wbA, bqA); \
                  __builtin_amdgcn_sched_barrier(0); \
                  if (d + 32 <= dC) HY_LOAD(RB, d + 32, waA, wbA, bqA); \
                  __builtin_amdgcn_sched_barrier(0); \
                  if (d + 16 <= dC) HY_MMA(waB, wbB, bqB); \
                  __builtin_amdgcn_sched_barrier(0); } } \
            _Pragma("unroll 1") for (int d = dC + 16; d <= dD; d += 16) HY_STEP_COND(RB, d); \
        } else if (ntile > 0) { const int dhi = T0w + 128 * (ntile - 1) + 96; \
            _Pragma("unroll 1") for (int d = T0w - n + 16; d <= dhi; d += 16) HY_STEP_COND(RB, d); } } while (0)
    HY_CONV(R1);
#pragma unroll
    for (int m = 0; m < 4; ++m) if (m < ntile) {
#pragma unroll
        for (int rg = 0; rg < 4; ++rg) { const int t4 = T0w + 128 * m + 32 * jb + 8 * rg + 4 * kg;
            const v2u xv = *(const v2u*)(x1g + (size_t)bb * n + t4); const v2u vv = *(const LAS v2u*)(XB + bb * HY_ROWB + 2 * (HY_MARG + t4));
            const float y0 = bflo(xv.x) * (acc[m][4 * rg + 0] + bias0 * bflo(vv.x)), y1 = bfhi(xv.x) * (acc[m][4 * rg + 1] + bias0 * bfhi(vv.x));
            const float y2 = bflo(xv.y) * (acc[m][4 * rg + 2] + bias0 * bflo(vv.y)), y3 = bfhi(xv.y) * (acc[m][4 * rg + 3] + bias0 * bfhi(vv.y));
            y1p[m][rg].x = pk2(y0, y1); y1p[m][rg].y = pk2(y2, y3); } }
    __syncthreads();
#pragma unroll
    for (int m = 0; m < 4; ++m) if (m < ntile) {
#pragma unroll
        for (int rg = 0; rg < 4; ++rg) { const int t4 = T0w + 128 * m + 32 * jb + 8 * rg + 4 * kg; *(LAS v2u*)(XB + bb * HY_ROWB + 2 * (HY_MARG + t4)) = y1p[m][rg]; } }
    __syncthreads();
    HY_CONV(R2);
#pragma unroll
    for (int m = 0; m < 4; ++m) if (m < ntile) {
#pragma unroll
        for (int rg = 0; rg < 4; ++rg) { const int t4 = T0w + 128 * m + 32 * jb + 8 * rg + 4 * kg;
            const v2u xv = *(const v2u*)(x2g + (size_t)bb * n + t4); const v2u yv = y1p[m][rg];
            const float o0 = bflo(xv.x) * (acc[m][4 * rg + 0] + bias1 * bflo(yv.x)), o1 = bfhi(xv.x) * (acc[m][4 * rg + 1] + bias1 * bfhi(yv.x));
            const float o2 = bflo(xv.y) * (acc[m][4 * rg + 2] + bias1 * bflo(yv.y)), o3 = bfhi(xv.y) * (acc[m][4 * rg + 3] + bias1 * bfhi(yv.y));
            v2u ov; ov.x = pk2(o0, o1); ov.y = pk2(o2, o3); *(v2u*)(vg + (size_t)bb * n + t4) = ov; } }
    __syncthreads();
#undef HY_CONV
#undef HY_AFRAG
#undef HY_STEP_COND
#undef HY_LOAD
#undef HY_MMA
}
__device__ __forceinline__ void stage_mixer(const Ctx& F, int l) {
    unsigned* ctr = (unsigned*)(F.a->ws + WS_CTL) + CW_WORK + 64 * l;
    LAS int* itb = (LAS int*)(F.lds + LDSCTL_OFF + 512);
    const int nit = 128 + 512 + (l == 0 ? 512 : 0);
#ifdef PROBE_STATIC
    return;
#endif
    for (;;) {
        if (F.tid == 0) *itb = (int)__hip_atomic_fetch_add(ctr, 1u, __ATOMIC_RELAXED, __HIP_MEMORY_SCOPE_AGENT);
        __syncthreads();
        const int it = *itb;
        __syncthreads();
        if (it >= nit) break;
        Ctx Fi; Fi.a = kargs(); Fi.tid = opaque_v((int)threadIdx.x); Fi.lane = Fi.tid & 63; Fi.wave = __builtin_amdgcn_readfirstlane(Fi.tid >> 6); Fi.bid = opaque((int)blockIdx.x); Fi.G = opaque((int)gridDim.x);
        Fi.lds = (LAS unsigned char*)((LAS unsigned char*)0 + opaque(0)) + (F.lds - (LAS unsigned char*)0);
#ifdef PROBE_T
        if (l == 0 && F.tid == 0 && it == 5) ((unsigned long long*)(F.a->ws + WS_CTL + CW_STAMP * 4))[21] = __builtin_amdgcn_s_memrealtime();
        if (l == 0 && F.tid == 0 && it == 300) ((unsigned long long*)(F.a->ws + WS_CTL + CW_STAMP * 4))[23] = __builtin_amdgcn_s_memrealtime();
#endif
        if (it < 128) { for (int rep = 0; rep < ((DUPK == 9) ? 2 : 1); ++rep) rw_chunk_item2(Fi, opaque(l), it); }
        else if (it < 640) hyena_item(Fi, opaque(l), it - 128, 0);
        else hyena_item(Fi, opaque(l), it - 640, 1);
#ifdef PROBE_T
        if (l == 0 && F.tid == 0 && it == 5) ((unsigned long long*)(F.a->ws + WS_CTL + CW_STAMP * 4))[22] = __builtin_amdgcn_s_memrealtime();
        if (l == 0 && F.tid == 0 && it == 300) ((unsigned long long*)(F.a->ws + WS_CTL + CW_STAMP * 4))[24] = __builtin_amdgcn_s_memrealtime();
#endif
    }
}

typedef float f32x16r __attribute__((ext_vector_type(16)));
__device__ __forceinline__ void stage_norm2_router(const Ctx& F, int l, int nrows) {
    const auto& a = *F.a; unsigned char* ws = a.ws; const int lane = F.lane;
    const float* X = (const float*)(ws + WS_X); bf16* H = (bf16*)(ws + WS_H); const float* MOD = (const float*)(ws + WS_MOD);
    int* EIDX = (int*)(ws + WS_EIDX); float* GATE = (float*)(ws + WS_GATE); int* BLKCNT = (int*)(ws + WS_BLKCNT);
    LAS float* lg = (LAS float*)(F.lds + F.wave * 4352);
    LAS int* hist = (LAS int*)(F.lds + LDSCTL_OFF + 1024);
    if (F.tid < 32) hist[F.tid] = 0;
    __syncthreads();
    const int rpb = (nrows + F.G - 1) / F.G, r0 = F.bid * rpb, r1 = (r0 + rpb < nrows) ? r0 + rpb : nrows;
    const float* rw = a.in[I_RTW] + (size_t)l * 1024 * 32;
    const int i = lane & 31, kk = lane >> 5;
    const f32x4* ng = (const f32x4*)(a.in[I_N2G] + l * D) + kk;
    for (int rb = r0 + F.wave * 32; rb < r1; rb += NWAVES * 32) {
        const int nrow = (r1 - rb) < 32 ? (r1 - rb) : 32; const bool live = i < nrow;
        const int row = live ? rb + i : r1 - 1; const int w = row < T_LAT ? (row >> 12) : 8;
        const f32x4* xr = (const f32x4*)(X + (size_t)row * D) + kk;
        float ss = 0.f;
#pragma unroll 8
        for (int q = 0; q < 128; ++q) { const f32x4 v = xr[2 * q]; ss += (v[0] * v[0] + v[1] * v[1]) + (v[2] * v[2] + v[3] * v[3]); }
        ss += __builtin_bit_cast(float, __builtin_amdgcn_ds_bpermute((lane ^ 32) << 2, __builtin_bit_cast(int, ss)));
        const float rstd = __builtin_amdgcn_rsqf(ss * (1.f / D) + 1e-6f);
        const f32x4* sh = (const f32x4*)(MOD + (size_t)(l * 9 + w) * 6144 + 3072) + kk; const f32x4* sc = (const f32x4*)(MOD + (size_t)(l * 9 + w) * 6144 + 4096) + kk;
        v2u* ho = (v2u*)(H + (size_t)row * D) + kk;
        f32x16r acc;
#pragma unroll
        for (int e = 0; e < 16; ++e) acc[e] = 0.f;
        const float* wp = rw + (size_t)(4 * kk) * 32 + i;
#pragma unroll 2
        for (int q = 0; q < 128; ++q) {
            const f32x4 xv = xr[2 * q]; const f32x4 h4 = xv * rstd * ng[2 * q] * (sc[2 * q] + 1.0f) + sh[2 * q];
            const float w0 = wp[(size_t)(8 * q) * 32], w1 = wp[(size_t)(8 * q + 1) * 32], w2 = wp[(size_t)(8 * q + 2) * 32], w3 = wp[(size_t)(8 * q + 3) * 32];
            if (live) { v2u o; o.x = pk2(h4[0], h4[1]); o.y = pk2(h4[2], h4[3]); ho[2 * q] = o; }
            acc = __builtin_amdgcn_mfma_f32_32x32x2f32(h4[0], w0, acc, 0, 0, 0);
            acc = __builtin_amdgcn_mfma_f32_32x32x2f32(h4[1], w1, acc, 0, 0, 0);
            acc = __builtin_amdgcn_mfma_f32_32x32x2f32(h4[2], w2, acc, 0, 0, 0);
            acc = __builtin_amdgcn_mfma_f32_32x32x2f32(h4[3], w3, acc, 0, 0, 0);
        }
        const float rbias = a.in[I_RTB][l * 32 + i];
#pragma unroll
        for (int r = 0; r < 16; ++r) { const int ri = (r & 3) + 8 * (r >> 2) + 4 * kk; lg[ri * 33 + i] = acc[r] + rbias; }
        LDS_WAIT(); asm volatile("" ::: "memory");
        if (lane < nrow) {
            LAS float* lr = lg + lane * 33; const int orow = rb + lane;
            float tv[4]; int ti[4];
#pragma unroll
            for (int r = 0; r < 4; ++r) { float bv = -INFINITY; int bi = 0;
#pragma unroll 8
                for (int e = 0; e < 32; ++e) { const float v = lr[e]; if (v > bv) { bv = v; bi = e; } }
                tv[r] = bv; ti[r] = bi; lr[bi] = -INFINITY; }
            const float e1 = expf(tv[1] - tv[0]), e2 = expf(tv[2] - tv[0]), e3 = expf(tv[3] - tv[0]); const float inv = 1.0f / (1.0f + e1 + e2 + e3);
            *(int4*)(EIDX + orow * 4) = make_int4(ti[0], ti[1], ti[2], ti[3]); *(f32x4*)(GATE + orow * 4) = (f32x4){inv, e1 * inv, e2 * inv, e3 * inv};
#pragma unroll
            for (int r = 0; r < 4; ++r) __hip_atomic_fetch_add(&hist[ti[r]], 1, __ATOMIC_RELAXED, __HIP_MEMORY_SCOPE_WORKGROUP);
        }
        LDS_WAIT(); asm volatile("" ::: "memory");
    }
    __syncthreads();
    if (F.tid < 32) BLKCNT[F.bid * 32 + F.tid] = hist[F.tid];
    __syncthreads();
}

__device__ __forceinline__ void stage_moe_scatter(const Ctx& F, int l, int nrows) {
    const auto& a = *F.a; unsigned char* ws = a.ws; const int lane = F.lane;
    const bf16* H = (const bf16*)(ws + WS_H); bf16* XS = (bf16*)(ws + WS_XS);
    const int* EIDX = (const int*)(ws + WS_EIDX); int* POS = (int*)(ws + WS_POS); const int* BLKCNT = (const int*)(ws + WS_BLKCNT); int* META = (int*)(ws + WS_META);
    LAS int* tot = (LAS int*)F.lds; LAS int* off = tot + 32; LAS int* base = tot + 64; LAS int* posl = tot + 128; LAS int* eloc = tot + 4096;
    const int rpb = (nrows + F.G - 1) / F.G, r0 = F.bid * rpb, r1 = (r0 + rpb < nrows) ? r0 + rpb : nrows; const int na = (r1 > r0) ? (r1 - r0) * 4 : 0;
    for (int i = F.tid; i < na; i += NTHREADS) eloc[i] = EIDX[r0 * 4 + i];
    { LAS int* part = tot + 8192; const int e = F.tid & 31, pt = F.tid >> 5; int t = 0, o = 0;
      for (int b2 = pt; b2 < F.G; b2 += 16) { const int c = BLKCNT[b2 * 32 + e]; t += c; o += (b2 < F.bid) ? c : 0; }
      part[pt * 32 + e] = t; part[512 + pt * 32 + e] = o; }
    __syncthreads();
    if (F.tid < 32) { LAS int* part = tot + 8192; int t = 0, o = 0;
#pragma unroll
        for (int pt = 0; pt < 16; ++pt) { t += part[pt * 32 + F.tid]; o += part[512 + pt * 32 + F.tid]; }
        tot[F.tid] = t; off[F.tid] = o; }
    __syncthreads();
    if (F.tid == 0) { int acc = 0; for (int e = 0; e < 32; ++e) { base[e] = acc; acc += (tot[e] + 255) & ~255; } base[32] = acc; }
    __syncthreads();
    if (F.bid == 0 && F.tid < 33) META[F.tid] = base[F.tid];
    unsigned* ROWOF = (unsigned*)(ws + WS_ROWOF);
    if (F.tid < 32) { int run = base[F.tid] + off[F.tid]; for (int i = 0; i < na; ++i) { if (eloc[i] == F.tid) { POS[r0 * 4 + i] = run; ROWOF[run] = (unsigned)(r0 + (i >> 2)) * (unsigned)(D * 2); ++run; } } }
    for (int e = F.bid; e < 32; e += F.G) for (int i = base[e] + tot[e] + F.tid; i < base[e + 1]; i += NTHREADS) ROWOF[i] = 0u;
    __syncthreads();
}
__device__ __forceinline__ LAS int* load_moe_base(const Ctx& F) {
    LAS int* base = (LAS int*)(F.lds + LDSCTL_OFF + 256);
    const int* META = (const int*)(F.a->ws + WS_META);
    if (F.tid < 33) base[F.tid] = META[F.tid];
    __syncthreads();
    return base;
}

constexpr int NSTAGE_L = 13, NSTAGES = 1 + DEPTH * NSTAGE_L + 1;
__global__ void __launch_bounds__(NTHREADS, 2) mk_fwd(Args args) {
    extern __shared__ __attribute__((aligned(16))) unsigned char lds_raw[];
    Ctx F; F.a = kargs(); F.lds = (LAS unsigned char*)lds_raw; F.tid = threadIdx.x; F.lane = F.tid & 63; F.wave = __builtin_amdgcn_readfirstlane(F.tid >> 6); F.bid = blockIdx.x; F.G = gridDim.x;
    volatile LAS unsigned* MISC = (volatile LAS unsigned*)(F.lds + LDSCTL_OFF);
    for (int u = F.tid; u < (LDS_BYTES - LDSCTL_OFF) / 4; u += NTHREADS) ((LAS unsigned*)(F.lds + LDSCTL_OFF))[u] = 0u;
    __syncthreads();
#if MK_PER_STAGE
#define GRID_BAR() do { } while (0)
#else
    (void)xcd_barrier_post((unsigned*)(F.a->ws + WS_CTL) + CW_BAR, MISC + 8);
#define GRID_BAR() do { XcdBarrier b_; b_.bar = (unsigned*)(kargs()->ws + WS_CTL) + CW_BAR; b_.x = xb_xcc_id(); b_.st = (volatile LAS unsigned*)((LAS unsigned char*)lds_raw + LDSCTL_OFF + opaque(32)); xcd_barrier(b_); } while (0)
#endif
#ifndef ONLY_S
#define ONLY_S -1
#endif
#define STG_SEL(k) (ONLY_S < 0 || ONLY_S == (((k) == 0) ? 0 : ((k) == NSTAGES - 1 ? 14 : (((k) - 1) % NSTAGE_L) + 1)))
#if MK_PER_STAGE
#define IN(k) (STG_SEL(k) && kargs()->ph_lo == (k))
#else
#define IN(k) STG_SEL(k)
#endif
#if MK_PER_STAGE
#define SEAM(k) do { } while (0)
#else
#define SEAM(k) do { if ((k) + 1 < NSTAGES) GRID_BAR(); } while (0)
#endif
#define STAGE(k) if (IN(k)) { F.a = kargs(); F.tid = opaque_v((int)threadIdx.x); F.lane = F.tid & 63; F.wave = __builtin_amdgcn_readfirstlane(F.tid >> 6); F.bid = opaque((int)blockIdx.x); F.G = opaque((int)gridDim.x); F.lds = (LAS unsigned char*)lds_raw + opaque(0); unsigned char* ws = F.a->ws; const int l = opaque(lq); unsigned char* wl = ws + WS_WTS + (size_t)l * WL_STRIDE; (void)wl; (void)ws;
#define STAGE_END(k) } SEAM(k);
    int lq = 0;
    STAGE(0) p0_prologue(F); STAGE_END(0)
    for (lq = 0; lq < DEPTH; ++lq) {
        const int sb = 1 + lq * NSTAGE_L;
        const int nrl = opaque((lq == DEPTH - 1) ? T_LAT : T_ALL);
        STAGE(sb + 0) stage_norm1(F, l); STAGE_END(sb + 0)
        STAGE(sb + 1) pg8::SchedWin S; S.A = (const char*)(ws + WS_H); S.Bt = (const char*)(wl + WO_WIN); S.tstep = (size_t)256 * 1024 * 2; S.G = F.G; S.c = F.bid; S.part = (nrl != T_ALL); pg8::EpiBf16 E{(bf16*)(ws + WS_Z), IN_COLS, nullptr, 0};
            pg8::gemm_phase(F.lds, F.tid, 1024, S, E); STAGE_END(sb + 1)
        STAGE(sb + 2) for (int rep = 0; rep < REPN(1); ++rep) stage_rw_prep1(F, l); for (int rep = 0; rep < REPN(2); ++rep) stage_s5_scan<0>(F, l); for (int rep = 0; rep < REPN(3); ++rep) stage_hy_pre(F, l, nrl); STAGE_END(sb + 2)
        STAGE(sb + 3) { pg8::SchedStatic S; S.init(ws + WS_ARW, wl + WO_RWCAT, T_ALL, 2560, 256, F.G, F.bid); pg8::EpiBf16 E{(bf16*)(ws + WS_P), 2560, nullptr, 0}; PT(4); pg8::gemm_phase(F.lds, F.tid, 256, S, E); PT(5); }
            F.tid = opaque_v((int)threadIdx.x); F.lane = F.tid & 63;
            for (int rep = 0; rep < REPN(4); ++rep) stage_s5_scan<1>(F, l); STAGE_END(sb + 3)
        STAGE(sb + 4) for (int rep = 0; rep < REPN(5); ++rep) stage_rw_prep2(F, l); for (int rep = 0; rep < REPN(6); ++rep) stage_s5_prep(F, l, nrl); STAGE_END(sb + 4)
        STAGE(sb + 5) PT(10); stage_mixer(F, l); PT(11); STAGE_END(sb + 5) STAGE(sb + 5) PT(12); }
        STAGE(sb + 6) { pg8::SchedStatic S; S.init(ws + WS_AS5, wl + WO_GLU, nrl, 1024, 512, F.G, F.bid); pg8::EpiGlu<0> E{(bf16*)(ws + WS_YS5), 512, F.a->in[I_S5GLUB] + l * 1024, 0, 512}; PT(13); pg8::gemm_phase(F.lds, F.tid, 512, S, E); PT(14); }
            for (int rep = 0; rep < REPN(7); ++rep) stage_rw_readout(F, l); for (int rep = 0; rep < REPN(8); ++rep) stage_hy_post(F, l, nrl); STAGE_END(sb + 6)
        STAGE(sb + 7) pg8::SchedMerge S; S.A0 = (const char*)(ws + WS_YHY); S.A1 = (const char*)(ws + WS_YRW); S.A2 = (const char*)(ws + WS_YS5); S.Bt = (const char*)(wl + WO_WBR); S.tstep = (size_t)256 * 512 * 2; S.bstride = (size_t)1024 * 512 * 2;
            S.nM = nrl / 256; S.nN = 4; S.G = F.G; S.c = F.bid;
            pg8::EpiMerge E{(bf16*)(ws + WS_MTMP), (bf16*)(ws + WS_H), (const bf16*)(ws + WS_Z) + GATE_OFF}; pg8::gemm_phase(F.lds, F.tid, 512, S, E); STAGE_END(sb + 7)
        STAGE(sb + 8) pg8::SchedStatic S; S.init(ws + WS_H, wl + WO_WOUT, nrl, 1024, 1024, F.G, F.bid); pg8::EpiResid E{(float*)(ws + WS_X), (const float*)(ws + WS_MOD) + (size_t)l * 9 * 6144 + 2048};
            pg8::gemm_phase(F.lds, F.tid, 1024, S, E); STAGE_END(sb + 8)
        STAGE(sb + 9) PT(17); stage_norm2_router(F, l, nrl); PT(18); STAGE_END(sb + 9)
        STAGE(sb + 10) PT(19); stage_moe_scatter(F, l, nrl); PT(20); STAGE_END(sb + 10)
        STAGE(sb + 11) LAS int* base = load_moe_base(F);
            pg8::SchedMoeG S; S.A = (const char*)(ws + WS_H); S.rowof = (const unsigned*)(ws + WS_ROWOF); S.Bt = (const char*)(wl + WO_W1); S.tstep = (size_t)256 * 1024 * 2; S.estride = (size_t)2048 * 1024 * 2; S.NPN = 8; S.G = F.G; S.c = F.bid; S.base = base;
            pg8::EpiGlu<1> E{(bf16*)(ws + WS_ACT), 1024, F.a->in[I_B1] + (size_t)l * 32 * 2048, 2048, 1024}; pg8::gemm_phase(F.lds, F.tid, 1024, S, E); STAGE_END(sb + 11)
        STAGE(sb + 12) LAS int* base = load_moe_base(F);
            pg8::SchedMoe S; S.A = (const char*)(ws + WS_ACT); S.Bt = (const char*)(wl + WO_W2); S.tstep = (size_t)256 * 1024 * 2; S.estride = (size_t)1024 * 1024 * 2; S.NPN = 4; S.G = F.G; S.c = F.bid; S.base = base;
            pg8::EpiBf16 E{(bf16*)(ws + WS_XS), 1024, F.a->in[I_B2] + (size_t)l * 32 * 1024, 1024}; pg8::gemm_phase(F.lds, F.tid, 1024, S, E); STAGE_END(sb + 12)
    }
    lq = DEPTH;
    STAGE(NSTAGES - 1)
#ifndef PROBE_T
        stage_norm1(F, l);
#endif
#ifdef PROBE_T
        { const unsigned long long* st = (const unsigned long long*)(F.a->ws + WS_CTL + CW_STAMP * 4); const float cval = (float)(long long)(st[PROBE_B] - st[PROBE_A]) * (1.0f / (100.0f * PROBE_DIV));
          __syncthreads(); for (size_t i = (size_t)F.bid * NTHREADS + F.tid; i < (size_t)T_LAT * D; i += (size_t)F.G * NTHREADS) F.a->out[i] = cval; }
#endif
    }
#undef IN
#undef SEAM
}

extern "C" void kernel_launch(void* const* d_in, const int* in_sizes, int n_in, void* d_out, int out_size, void* d_ws, size_t ws_size, hipStream_t stream) {
    static int grid = 0;
    if (grid == 0) {
        if (n_in != 51 || out_size != T_LAT * D || ws_size < WS_END) { fprintf(stderr, "kernel_launch: unexpected shapes (n_in %d out %d ws %zu, need %zu)\n", n_in, out_size, ws_size, (size_t)WS_END); grid = -1; return; }
        int dev = 0, cus = 0, per_cu = 0;
        if (hipGetDevice(&dev) != hipSuccess || hipDeviceGetAttribute(&cus, hipDeviceAttributeMultiprocessorCount, dev) != hipSuccess) { grid = -1; return; }
        if (hipFuncSetAttribute((const void*)mk_fwd, hipFuncAttributeMaxDynamicSharedMemorySize, LDS_BYTES) != hipSuccess) { fprintf(stderr, "kernel_launch: hipFuncSetAttribute failed\n"); grid = -1; return; }
        if (hipOccupancyMaxActiveBlocksPerMultiprocessor(&per_cu, (const void*)mk_fwd, NTHREADS, LDS_BYTES) != hipSuccess || per_cu < 1) fprintf(stderr, "kernel_launch: occupancy query says %d\n", per_cu);
        (void)hipGetLastError();
        grid = cus;
    }
    if (grid < 0) return;
    if (hipMemsetAsync((char*)d_ws + WS_CTL, 0, CTL_ZERO_BYTES, stream) != hipSuccess) return;
    Args a{};
    for (int i = 0; i < 51; ++i) a.in[i] = (const float*)d_in[i];
    a.out = (float*)d_out; a.ws = (unsigned char*)d_ws;
#if MK_PER_STAGE
    for (int s = 0; s < NSTAGES; ++s) { a.ph_lo = s; a.ph_hi = s + 1; int reps = 1;
#ifdef PROBE_SET
        { const int ls = (s == 0 || s == NSTAGES - 1) ? -1 : (s - 1) % NSTAGE_L;
          if (PROBE_SET >= 1 && PROBE_SET <= 13 && ls == PROBE_SET - 1 && ls != 5 && ls != 8 && !(ls == 0 && s > 1)) reps = 3;
          if (PROBE_SET == 14 && s == 0) reps = 3; }
#endif
        for (int r = 0; r < reps; ++r) hipLaunchKernelGGL(mk_fwd, dim3(grid), dim3(NTHREADS), LDS_BYTES, stream, a); }
#else
    a.ph_lo = 0; a.ph_hi = NSTAGES; hipLaunchKernelGGL(mk_fwd, dim3(grid), dim3(NTHREADS), LDS_BYTES, stream, a);
#endif
}
```

```cpp
#include <hip/hip_runtime.h>
#include <cstdio>
#include <cstdint>

#ifndef DUPK
#define DUPK 0
#endif
#define REPN(k) ((DUPK == (k)) ? 3 : 1)
#ifndef REP_GEMM
#define REP_GEMM 1
#endif
#ifndef REP_LIGHT
#define REP_LIGHT 1
#endif
#ifndef REP_PRO
#define REP_PRO 1
#endif
#ifndef MK_PER_STAGE
#define MK_PER_STAGE 0
#endif

#define GAS __attribute__((address_space(1)))
#define LAS __attribute__((address_space(3)))
typedef unsigned short bf16;
typedef unsigned v4u __attribute__((ext_vector_type(4)));
typedef unsigned v2u __attribute__((ext_vector_type(2)));
typedef float f32x4 __attribute__((ext_vector_type(4)));
typedef float f32x2 __attribute__((ext_vector_type(2)));
typedef short bf16x8 __attribute__((ext_vector_type(8)));

constexpr int D = 1024, BATCH = 8, SEQ = 4096, CTXL = 256, DEPTH = 2;
constexpr int T_LAT = BATCH * SEQ, T_CTX = BATCH * CTXL, T_ALL = T_LAT + T_CTX;
constexpr int IN_COLS = 6912, HY_OFF = 0, RW_OFF = 1536, S5_OFF = 3328, GATE_OFF = 3840;
constexpr int NE = 32, TOPK = 4;
constexpr int MAXSLOT = 147456;
constexpr int NWAVES = 8, NTHREADS = 512;
constexpr int HY_MARG = 128, HY_ROWB = 8720, HY_RLEN = 8272, HY_RLENC = 592;
constexpr int HY_R1_OFF = 8 * HY_ROWB, HY_R2_OFF = HY_R1_OFF + HY_RLEN * 2;

constexpr size_t MiB = 1ull << 20;
constexpr size_t WS_CTL = 0, CTL_ZERO_BYTES = 1 * MiB;
constexpr size_t WS_MOD = 1 * MiB;
constexpr size_t WS_BLKCNT = 2 * MiB;
constexpr size_t WS_META = 2 * MiB + 512 * 1024;
constexpr size_t WS_ROWOF = 7 * MiB;
constexpr size_t WS_EIDX = 3 * MiB, WS_GATE = 4 * MiB, WS_POS = 5 * MiB;
constexpr size_t WS_WTS = 8 * MiB, WL_STRIDE = 214 * MiB;
constexpr size_t WO_WIN = 0, WO_RWCAT = 14 * MiB, WO_GLU = 16 * MiB, WO_WBR = 17 * MiB, WO_WOUT = 20 * MiB, WO_W1 = 22 * MiB, WO_W2 = 150 * MiB;
constexpr size_t WS_GF = 436 * MiB, GF_STRIDE = 20 * MiB, GF_CTX = 17 * MiB;
constexpr size_t WS_X = 504 * MiB;
constexpr size_t WS_H = 640 * MiB;
constexpr size_t WS_BIG = 708 * MiB;
constexpr size_t WS_Z = WS_BIG;
constexpr size_t WS_SCN = 1167 * MiB;
constexpr size_t WS_MTMP = WS_SCN;
constexpr size_t WS_P = 1473 * MiB;
constexpr size_t WS_ARW = 1643 * MiB;
constexpr size_t WS_YP = 1660 * MiB;
constexpr size_t WS_YDIR = WS_YP;
constexpr size_t WS_UT = 1796 * MiB;
constexpr size_t WS_AS5 = 2000 * MiB;
constexpr size_t WS_YHY = 1898 * MiB, WS_YRW = 1932 * MiB, WS_YS5 = 1966 * MiB;
constexpr size_t WS_XS = WS_BIG;
constexpr size_t WS_ACT = WS_BIG + 288 * MiB;
constexpr size_t WS_END = 2034 * MiB;
constexpr int CW_BAR = 4096;

constexpr int RING_BYTES = 131072;
constexpr int LDSCTL_OFF = RING_BYTES;
constexpr int LDS_BYTES = 163840;

typedef __bf16 bf16x2_t __attribute__((ext_vector_type(2)));
__device__ __forceinline__ unsigned pk2(float lo, float hi) { const bf16x2_t v = __builtin_convertvector((f32x2){lo, hi}, bf16x2_t); return __builtin_bit_cast(unsigned, v); }
__device__ __forceinline__ unsigned f2bf(float f) { return pk2(f, 0.f) & 0xffffu; }
__device__ __forceinline__ float bf2f(bf16 b) { return __builtin_bit_cast(float, ((unsigned)b) << 16); }
__device__ __forceinline__ float bflo(unsigned w) { return __builtin_bit_cast(float, w << 16); }
__device__ __forceinline__ float bfhi(unsigned w) { return __builtin_bit_cast(float, w & 0xffff0000u); }
__device__ __forceinline__ float sigm(float x) { return __builtin_amdgcn_rcpf(1.f + __expf(-x)); }
__device__ __forceinline__ float tanh_fast(float x) { const float e = __expf(2.f * x); return 1.f - 2.f * __builtin_amdgcn_rcpf(e + 1.f); }
#define LDS_WAIT() asm volatile("s_waitcnt lgkmcnt(0)" ::: "memory")
__device__ __forceinline__ float dpp_f(float x, const int ctrl_sel) {
    const int v = __builtin_bit_cast(int, x);
    int r;
    if (ctrl_sel == 0) r = __builtin_amdgcn_update_dpp(0, v, 0xB1, 0xF, 0xF, true);
    else if (ctrl_sel == 1) r = __builtin_amdgcn_update_dpp(0, v, 0x4E, 0xF, 0xF, true);
    else r = __builtin_amdgcn_update_dpp(0, v, 0x141, 0xF, 0xF, true);
    return __builtin_bit_cast(float, r);
}
__device__ __forceinline__ float red32(float x) {
    x += dpp_f(x, 0); x += dpp_f(x, 1); x += dpp_f(x, 2);
    x += __builtin_bit_cast(float, __builtin_amdgcn_update_dpp(0, __builtin_bit_cast(int, x), 0x128, 0xF, 0xF, true));
    x += __builtin_bit_cast(float, __builtin_amdgcn_ds_swizzle(__builtin_bit_cast(int, x), 0x401F));
    return x;
}
__device__ __forceinline__ float wave_sum(float v) {
    v = red32(v);
    return __builtin_bit_cast(float, __builtin_amdgcn_readlane(__builtin_bit_cast(int, v), 0)) + __builtin_bit_cast(float, __builtin_amdgcn_readlane(__builtin_bit_cast(int, v), 32));
}
__device__ __forceinline__ int xch32(int v, const int step) {
    if (step == 0) return __builtin_amdgcn_update_dpp(0, v, 0xB1, 0xF, 0xF, true);
    if (step == 1) return __builtin_amdgcn_update_dpp(0, v, 0x4E, 0xF, 0xF, true);
    if (step == 2) return __builtin_amdgcn_update_dpp(0, v, 0x141, 0xF, 0xF, true);
    if (step == 3) return __builtin_amdgcn_update_dpp(0, v, 0x128, 0xF, 0xF, true);
    return __builtin_amdgcn_ds_swizzle(v, 0x401F);
}
__device__ __forceinline__ float red8(float x) { x += dpp_f(x, 0); x += dpp_f(x, 1); x += dpp_f(x, 2); return x; }

#define XB_TMO      128
#define XB_XCNT(j)  (256  + 64 * (j))
#define XB_XSUB(j)  (1280 + 64 * (j))
#define XB_XGEN(j)  (2304 + 64 * (j))
#define XB_TOP      3328
#define XB_TOPGEN   3392
#define XCD_BAR_WORDS 3456
#define XB_SPIN_CAP (1u << 22)
__device__ __forceinline__ unsigned xb_ld(unsigned* p)              { return __hip_atomic_load(p, __ATOMIC_RELAXED, __HIP_MEMORY_SCOPE_AGENT); }
__device__ __forceinline__ unsigned xb_add(unsigned* p, unsigned v) { return __hip_atomic_fetch_add(p, v, __ATOMIC_RELAXED, __HIP_MEMORY_SCOPE_AGENT); }
__device__ __forceinline__ unsigned xb_xcc_id() { return (unsigned)__builtin_amdgcn_s_getreg((3 << 11) | 20) & 0xFu; }
#define XB_SPIN(cond, bar) do { unsigned _sp = 0; while (cond) { __builtin_amdgcn_s_sleep(1); \
    if ((++_sp & 255u) == 0u) { if (xb_ld(&(bar)[XB_TMO])) break; if (_sp > XB_SPIN_CAP) { atomicAdd(&(bar)[XB_TMO], 1u); break; } } } } while (0)
struct XcdBarrier { unsigned* bar; unsigned x; volatile LAS unsigned* st; };
__device__ __forceinline__ XcdBarrier xcd_barrier_post(unsigned* bar, volatile LAS unsigned* st) {
    XcdBarrier b; b.bar = bar; b.x = xb_xcc_id(); b.st = st;
    if (threadIdx.x == 0) (void)xb_add(&bar[XB_XCNT(b.x)], 1u);
    return b;
}
__device__ __forceinline__ void xcd_barrier_complete(unsigned* bar, unsigned x, unsigned& nloc, unsigned& nx) {
    const unsigned G = gridDim.x * gridDim.y * gridDim.z;
    unsigned sum, cnt, mine, sp = 0u;
    for (;;) {
        sum = 0u; cnt = 0u; mine = 0u;
#pragma unroll
        for (unsigned j = 0; j < 16; ++j) { const unsigned c = xb_ld(&bar[XB_XCNT(j)]); sum += c; cnt += (c > 0u) ? 1u : 0u; mine = (j == x) ? c : mine; }
        if (sum == G) break;
        __builtin_amdgcn_s_sleep(1);
        if ((++sp & 255u) == 0u) { if (xb_ld(&bar[XB_TMO])) break; if (sp > XB_SPIN_CAP) { atomicAdd(&bar[XB_TMO], 1u); break; } }
    }
    nloc = mine > 0u ? mine : 1u; nx = cnt > 0u ? cnt : 1u;
}
__device__ __forceinline__ void xcd_barrier(const XcdBarrier& b) {
    asm volatile("s_waitcnt vmcnt(0)" ::: "memory");
    __syncthreads();
    if (threadIdx.x == 0) {
        unsigned* bar = b.bar;
        __builtin_amdgcn_s_waitcnt(0);
        unsigned nloc = b.st[0], nx = b.st[1];
        if (nloc == 0u) { xcd_barrier_complete(bar, b.x, nloc, nx); b.st[0] = nloc; b.st[1] = nx; }
        const unsigned old = xb_add(&bar[XB_XSUB(b.x)], 1u);
        const unsigned gen = old / nloc;
        if (old + 1u == (gen + 1u) * nloc) {
            __builtin_amdgcn_fence(__ATOMIC_RELEASE, "agent");
            asm volatile("s_waitcnt vmcnt(0)" ::: "memory");
            const unsigned og = xb_add(&bar[XB_TOP], 1u);
            const unsigned tg = og / nx;
            if (og + 1u == (tg + 1u) * nx) xb_add(&bar[XB_TOPGEN], 1u);
            else XB_SPIN(xb_ld(&bar[XB_TOPGEN]) == tg, bar);
            __builtin_amdgcn_fence(__ATOMIC_ACQUIRE, "agent");
            xb_add(&bar[XB_XGEN(b.x)], 1u);
            asm volatile("s_waitcnt vmcnt(0)" ::: "memory");
        } else {
            XB_SPIN(xb_ld(&bar[XB_XGEN(b.x)]) == gen, bar);
            __builtin_amdgcn_fence(__ATOMIC_ACQUIRE, "agent");
            asm volatile("s_waitcnt vmcnt(0)" ::: "memory");
        }
    }
    __syncthreads();
}

namespace pg8 {
constexpr int BM = 256, BK = 64, HALF = 128, HTB = HALF * BK * 2, STAGE_BYTES = 8 * HTB, NXCD = 8, WGM = 8, ROWTAB_OFF = 131072 + 4096;
__host__ __device__ __forceinline__ int lds_byte(int r, int c) { const int st = (r >> 4) * 2 + (c >> 5), rr = r & 15, cc = c & 31, ob = rr * 64 + cc * 2; return st * 1024 + (ob ^ (((ob >> 9) & 1) << 5)); }
__host__ __device__ __forceinline__ void stage_rc(int b, int& R, int& C) { const int st = b / 1024, sb = b % 1024, swz = sb ^ (((sb >> 9) & 1) << 5); R = (st >> 1) * 16 + swz / 64; C = (st & 1) * 32 + (swz % 64) / 2; }
__host__ __device__ __forceinline__ int perm32(int rho) { const int n = rho >> 4, i = rho & 15; return 8 * (i >> 2) + 4 * n + (i & 3); }
struct Unit { int pm, pn, e; };
__device__ __forceinline__ unsigned cvt_pk_bf16(float lo, float hi) { return pk2(lo, hi); }

__device__ __forceinline__ void tile_of(int L, int nM, int nN, int& pm, int& pn) {
    const int nwg = nM * nN; int wgid = L;
    { const int q = nwg / NXCD, r = nwg % NXCD, xcd = wgid % NXCD, off = wgid / NXCD; wgid = (xcd < r ? xcd * (q + 1) : r * (q + 1) + (xcd - r) * q) + off; }
    const int nig = WGM * nN, gid = wgid / nig, fm = gid * WGM, gsz = (nM - fm) < WGM ? (nM - fm) : WGM;
    pm = fm + ((wgid % nig) % gsz); pn = (wgid % nig) / gsz;
}
struct SchedStatic {
    static constexpr bool GATHER = false;
    const char* A; const char* Bt; size_t tstep; int nM, nN, G, c;
    __device__ __forceinline__ void init(const void* A_, const void* Bt_, int M, int N, int K, int G_, int c_) { A = (const char*)A_; Bt = (const char*)Bt_; tstep = (size_t)BM * K * 2; nM = M / BM; nN = N / BM; G = G_; c = c_; }
    __device__ __forceinline__ bool next(int i, Unit& u) const { const long L = (long)i * G + c; if (L >= (long)nM * nN) return false; tile_of((int)L, nM, nN, u.pm, u.pn); u.e = 0; return true; }
    __device__ __forceinline__ const char* aptr(const Unit& u) const { return A + (size_t)u.pm * tstep; }
    __device__ __forceinline__ const char* bptr(const Unit& u) const { return Bt + (size_t)u.pn * tstep; }
};
struct SchedWin {
    static constexpr bool GATHER = false;
    const char* A; const char* Bt; size_t tstep; int G, c, part;
    __device__ __forceinline__ bool next(int i, Unit& u) const {
        const int L = i * G + c, nmf = part ? 128 : 136, nfull = nmf * 27; u.e = 0;
        if (L < nfull) { tile_of(L, nmf, 27, u.pm, u.pn); return true; }
        const int L2 = L - nfull; if (!part || L2 >= 8 * 9) return false;
        u.pm = 128 + L2 / 9; u.pn = 6 + L2 % 9; return true; }
    __device__ __forceinline__ const char* aptr(const Unit& u) const { return A + (size_t)u.pm * tstep; }
    __device__ __forceinline__ const char* bptr(const Unit& u) const { return Bt + (size_t)u.pn * tstep; }
};
struct SchedMerge {
    static constexpr bool GATHER = false;
    const char* A0; const char* A1; const char* A2; const char* Bt; size_t tstep, bstride; int nM, nN, G, c;
    __device__ __forceinline__ bool next(int i, Unit& u) const { const int j = i / 3, br = i - 3 * j; const long L = (long)j * G + c; if (L >= (long)nM * nN) return false; tile_of((int)L, nM, nN, u.pm, u.pn); u.e = br; return true; }
    __device__ __forceinline__ const char* aptr(const Unit& u) const { return (u.e == 0 ? A0 : (u.e == 1 ? A1 : A2)) + (size_t)u.pm * tstep; }
    __device__ __forceinline__ const char* bptr(const Unit& u) const { return Bt + (size_t)u.e * bstride + (size_t)u.pn * tstep; }
};
struct SchedMoe {
    static constexpr bool GATHER = false;
    const char* A; const char* Bt; size_t tstep, estride; int NPN, G, c; const LAS int* base;
    __device__ __forceinline__ bool next(int i, Unit& u) const {
        const int ntiles = base[32] >> 8; const int per = G >> 3;
        const long L = (long)i * G + (((G & 7) == 0) ? (c & 7) * per + (c >> 3) : c);
        if (L >= (long)ntiles * NPN) return false;
        u.pm = (int)(L / NPN); u.pn = (int)(L % NPN); const int r0 = u.pm << 8; int e = 0;
#pragma unroll 1
        for (int k = 1; k < 32; ++k) e += (r0 >= base[k]) ? 1 : 0;
        u.e = e; return true;
    }
    __device__ __forceinline__ const char* aptr(const Unit& u) const { return A + (size_t)u.pm * tstep; }
    __device__ __forceinline__ const char* bptr(const Unit& u) const { return Bt + (size_t)u.e * estride + (size_t)u.pn * tstep; }
};
struct SchedMoeG : SchedMoe {
    static constexpr bool GATHER = true;
    const unsigned* rowof;
    __device__ __forceinline__ const char* aptr(const Unit&) const { return A; }
};

template <class Epi, class Sched>
__device__ __forceinline__ void gemm_phase(LAS unsigned char* lds, const int tid, const int K, const Sched& S, const Epi& E) {
    const int wid = __builtin_amdgcn_readfirstlane(tid >> 6), lane = tid & 63, wr = wid >> 2, wc = wid & 3, fr = lane & 15, fq = lane >> 4;
    const int nt = K / BK;
    unsigned voffA[2], voffB[2];
#pragma unroll
    for (int i = 0; i < 2; ++i) { int R, C; stage_rc(tid * 16 + i * 8192, R, C); const int Rb = Epi::PERM ? ((R & ~31) + perm32(R & 31)) : R;
        voffA[i] = (unsigned)(R * K + C) * 2u; voffB[i] = (unsigned)(Rb * K + C) * 2u; }
    const size_t kstep = (size_t)(BK * 2);
    const size_t hstep = (size_t)HALF * K * 2;
    const unsigned ldsw = (unsigned)wid * 1024u;
    const int aoff = lds_byte(wr * 64 + fr, fq * 8), boff = lds_byte(wc * 32 + fr, fq * 8);
#define PG8_SA(b, h) (((b) * 2 + (h)) * HTB)
#define PG8_SB(b, h) ((4 + (b) * 2 + (h)) * HTB)
#define PG8_STAGE(bufoff, gbase, voff) do { _Pragma("unroll") for (int _i = 0; _i < 2; ++_i) \
        __builtin_amdgcn_global_load_lds((const unsigned*)((const char*)(gbase) + (voff)[_i]), (LAS unsigned*)(lds + (bufoff) + ldsw + _i * 8192), 16, 0, 0); } while (0)
#define PG8_STAGEA(bufoff, kp, h) do { if constexpr (Sched::GATHER) { _Pragma("unroll") for (int _i = 0; _i < 2; ++_i) \
        __builtin_amdgcn_global_load_lds((const unsigned*)((const char*)(kp) + g[2 * (h) + _i]), (LAS unsigned*)(lds + (bufoff) + ldsw + _i * 8192), 16, 0, 0); } \
        else { PG8_STAGE(bufoff, (kp) + (h) * hstep, voffA); } } while (0)
#define PG8_GLOAD(buf) do { const LAS unsigned* rt_ = (const LAS unsigned*)(lds + ROWTAB_OFF + (buf) * 1024) + gR0; _Pragma("unroll") for (int _j = 0; _j < 4; ++_j) g[_j] = rt_[64 * _j] + gCb; } while (0)
#define PG8_GDMA(pm_, buf) do { if (wid == 0) __builtin_amdgcn_global_load_lds((const unsigned*)(S.rowof + (size_t)(pm_) * 256 + lane * 4), (LAS unsigned*)(lds + ROWTAB_OFF + (buf) * 1024), 16, 0, 0); } while (0)
#define PG8_LDA(dst, b, h) do { _Pragma("unroll") for (int m = 0; m < 4; ++m) _Pragma("unroll") for (int k = 0; k < 2; ++k) dst[m][k] = *(const LAS bf16x8*)(lds + PG8_SA(b, h) + aoff + m * 2048 + k * 1024); } while (0)
#define PG8_LDB(dst, b, h) do { _Pragma("unroll") for (int n = 0; n < 2; ++n) _Pragma("unroll") for (int k = 0; k < 2; ++k) dst[n][k] = *(const LAS bf16x8*)(lds + PG8_SB(b, h) + boff + n * 2048 + k * 1024); } while (0)
#define PG8_MMA(ai, bj, At, Bt) do { __builtin_amdgcn_s_setprio(1); _Pragma("unroll") for (int m = 0; m < 4; ++m) _Pragma("unroll") for (int n = 0; n < 2; ++n) _Pragma("unroll") for (int k = 0; k < 2; ++k) \
        acc[ai][bj][m][n] = __builtin_amdgcn_mfma_f32_16x16x32_bf16(Bt[n][k], At[m][k], acc[ai][bj][m][n], 0, 0, 0); __builtin_amdgcn_s_setprio(0); } while (0)
#define PG8_WAIT_V(n) asm volatile("s_waitcnt vmcnt(" #n ")" ::: "memory")
#define PG8_WAIT_L(n) asm volatile("s_waitcnt lgkmcnt(" #n ")" ::: "memory")
#define PG8_BAR __builtin_amdgcn_s_barrier()
#define PG8_SCHED __builtin_amdgcn_sched_barrier(0)
    Unit cur, nxt; int ui = 0;
    if (!S.next(0, cur)) return;
    f32x4 acc[2][2][4][2];
#pragma unroll
    for (int a = 0; a < 2; ++a)
#pragma unroll
        for (int b = 0; b < 2; ++b)
#pragma unroll
            for (int m = 0; m < 4; ++m)
#pragma unroll
                for (int n = 0; n < 2; ++n) acc[a][b][m][n] = (f32x4){0.f, 0.f, 0.f, 0.f};
    bf16x8 At[4][2], B0[2][2], B1[2][2];
    const char* cA = S.aptr(cur); const char* cB = S.bptr(cur);
    unsigned g[4] = {0u, 0u, 0u, 0u}; int gR0 = 0; unsigned gCb = 0u;
    if constexpr (Sched::GATHER) { int R, C; stage_rc(tid * 16, R, C); gR0 = R; gCb = (unsigned)C * 2u;
        PG8_GDMA(cur.pm, 0); PG8_WAIT_V(0); PG8_BAR; PG8_GLOAD(0); }
    PG8_STAGE(PG8_SB(0, 0), cB, voffB); PG8_STAGE(PG8_SB(0, 1), cB + hstep, voffB); PG8_STAGEA(PG8_SA(0, 0), cA, 0); PG8_STAGEA(PG8_SA(0, 1), cA, 1);
    if (wr == 1) PG8_BAR;
    PG8_WAIT_V(2); PG8_BAR;
    PG8_STAGE(PG8_SB(1, 0), cB + kstep, voffB); PG8_STAGEA(PG8_SA(1, 0), cA + kstep, 0); PG8_STAGE(PG8_SB(1, 1), cB + hstep + kstep, voffB);
    PG8_WAIT_V(6); PG8_BAR;
    for (;;) {
        const bool has_next = S.next(ui + 1, nxt);
        const char* nA = has_next ? S.aptr(nxt) : cA; const char* nB = has_next ? S.bptr(nxt) : cB;
        if constexpr (Sched::GATHER) { if (has_next) PG8_GDMA(nxt.pm, (ui + 1) & 1); }
        for (int t = 0; t < nt; t += 2) {
            const bool last = (t == nt - 2);
            const char* a1 = cA + (size_t)(t + 1) * kstep;
            const char* a2 = last ? nA : cA + (size_t)(t + 2) * kstep; const char* b2 = last ? nB : cB + (size_t)(t + 2) * kstep;
            const char* a3 = a2 + kstep; const char* b3 = b2 + kstep;
            PG8_LDB(B0, 0, 0); PG8_LDB(B1, 0, 1); PG8_SCHED; PG8_LDA(At, 0, 0); PG8_STAGEA(PG8_SA(1, 1), a1, 1);
            PG8_WAIT_V(8); PG8_WAIT_L(0); PG8_BAR; PG8_MMA(0, 0, At, B0); PG8_MMA(0, 1, At, B1); PG8_BAR; PG8_SCHED;
            if constexpr (Sched::GATHER) { if (last && has_next) PG8_GLOAD((ui + 1) & 1); PG8_SCHED; }
            PG8_LDA(At, 0, 1); PG8_STAGE(PG8_SB(0, 0), b2, voffB); PG8_STAGE(PG8_SB(0, 1), b2 + hstep, voffB); PG8_STAGEA(PG8_SA(0, 0), a2, 0);
            PG8_WAIT_V(8); PG8_WAIT_L(0); PG8_BAR; PG8_MMA(1, 0, At, B0); PG8_MMA(1, 1, At, B1); PG8_BAR; PG8_SCHED;
            PG8_LDB(B0, 1, 0); PG8_LDB(B1, 1, 1); PG8_SCHED; PG8_LDA(At, 1, 0); PG8_STAGEA(PG8_SA(0, 1), a2, 1);
            PG8_WAIT_V(8); PG8_WAIT_L(0); PG8_BAR; PG8_MMA(0, 0, At, B0); PG8_MMA(0, 1, At, B1); PG8_BAR; PG8_SCHED;
            PG8_LDA(At, 1, 1); PG8_STAGE(PG8_SB(1, 0), b3, voffB); PG8_STAGE(PG8_SB(1, 1), b3 + hstep, voffB); PG8_STAGEA(PG8_SA(1, 0), a3, 0);
            PG8_WAIT_V(8); PG8_WAIT_L(0); PG8_BAR; PG8_MMA(1, 0, At, B0); PG8_MMA(1, 1, At, B1); PG8_BAR; PG8_SCHED;
        }
        if (wr == 0) PG8_BAR;
        { int t2_ = (int)threadIdx.x; asm volatile("" : "+v"(t2_)); E(acc, cur, wr, wc, t2_ & 15, (t2_ >> 4) & 3); }
        if (!has_next) break;
#pragma unroll
        for (int a = 0; a < 2; ++a)
#pragma unroll
            for (int b = 0; b < 2; ++b)
#pragma unroll
                for (int m = 0; m < 4; ++m)
#pragma unroll
                    for (int n = 0; n < 2; ++n) acc[a][b][m][n] = (f32x4){0.f, 0.f, 0.f, 0.f};
        cur = nxt; cA = nA; cB = nB; ++ui;
        if (wr == 1) PG8_BAR;
    }
    PG8_WAIT_V(0);
    PG8_BAR;
#undef PG8_SA
#undef PG8_SB
#undef PG8_STAGE
#undef PG8_STAGEA
#undef PG8_GLOAD
#undef PG8_GDMA
#undef PG8_LDA
#undef PG8_LDB
#undef PG8_MMA
#undef PG8_WAIT_V
#undef PG8_WAIT_L
#undef PG8_BAR
#undef PG8_SCHED
}

struct EpiBf16 {
    static constexpr bool PERM = true;
    bf16* O; int ldc; const float* bias; int bias_stride;
    __device__ __forceinline__ void operator()(const f32x4 (&acc)[2][2][4][2], const Unit& u, int wr, int wc, int fr, int fq) const {
        const int row0 = u.pm * BM + wr * 64 + fr, col0 = u.pn * BM + wc * 32 + 8 * fq;
        f32x4 bv[2][2];
#pragma unroll
        for (int bj = 0; bj < 2; ++bj)
#pragma unroll
            for (int n = 0; n < 2; ++n) bv[bj][n] = bias ? *(const f32x4*)(bias + (size_t)u.e * bias_stride + col0 + bj * HALF + 4 * n) : (f32x4){0.f, 0.f, 0.f, 0.f};
#pragma unroll
        for (int ai = 0; ai < 2; ++ai)
#pragma unroll
            for (int m = 0; m < 4; ++m) { bf16* rowp = O + (size_t)(row0 + ai * HALF + m * 16) * ldc + col0;
#pragma unroll
                for (int bj = 0; bj < 2; ++bj) { const f32x4 v0 = acc[ai][bj][m][0] + bv[bj][0], v1 = acc[ai][bj][m][1] + bv[bj][1];
                    v4u w; w.x = cvt_pk_bf16(v0[0], v0[1]); w.y = cvt_pk_bf16(v0[2], v0[3]); w.z = cvt_pk_bf16(v1[0], v1[1]); w.w = cvt_pk_bf16(v1[2], v1[3]);
                    *(v4u*)(rowp + bj * HALF) = w; } }
    }
};
template <int MODE> struct EpiGlu {
    static constexpr bool PERM = true;
    bf16* O; int ldc; const float* bias; int bias_stride, hs;
    __device__ __forceinline__ void operator()(const f32x4 (&acc)[2][2][4][2], const Unit& u, int wr, int wc, int fr, int fq) const {
        const int row0 = u.pm * BM + wr * 64 + fr, col0 = u.pn * HALF + wc * 32 + 8 * fq;
        const float* bp = bias + (size_t)u.e * bias_stride + col0;
        f32x4 ba[2], bb[2];
#pragma unroll
        for (int n = 0; n < 2; ++n) { ba[n] = *(const f32x4*)(bp + 4 * n); bb[n] = *(const f32x4*)(bp + hs + 4 * n); }
#pragma unroll
        for (int ai = 0; ai < 2; ++ai)
#pragma unroll
            for (int m = 0; m < 4; ++m) { bf16* rowp = O + (size_t)(row0 + ai * HALF + m * 16) * ldc + col0;
                float o[8];
#pragma unroll
                for (int n = 0; n < 2; ++n) { const f32x4 a = acc[ai][0][m][n] + ba[n], b = acc[ai][1][m][n] + bb[n];
#pragma unroll
                    for (int j = 0; j < 4; ++j) {
                        if (MODE == 0) o[4 * n + j] = a[j] * sigm(b[j]);
                        else { const float g = fminf(a[j], 7.f), up = fminf(fmaxf(b[j], -7.f), 7.f); o[4 * n + j] = (up + 1.f) * g * sigm(1.702f * g); } } }
                v4u w; w.x = cvt_pk_bf16(o[0], o[1]); w.y = cvt_pk_bf16(o[2], o[3]); w.z = cvt_pk_bf16(o[4], o[5]); w.w = cvt_pk_bf16(o[6], o[7]);
                *(v4u*)rowp = w; }
    }
};
struct EpiMerge {
    static constexpr bool PERM = true;
    bf16* mtmp; bf16* Mo; const bf16* zg;
    __device__ __forceinline__ void operator()(const f32x4 (&acc)[2][2][4][2], const Unit& u, int wr, int wc, int fr, int fq) const {
        const int row0 = u.pm * BM + wr * 64 + fr, col0 = u.pn * BM + wc * 32 + 8 * fq;
#pragma unroll
        for (int ai = 0; ai < 2; ++ai)
#pragma unroll
            for (int m = 0; m < 4; ++m) { const size_t r = (size_t)(row0 + ai * HALF + m * 16);
#pragma unroll
                for (int bj = 0; bj < 2; ++bj) { const int c = col0 + bj * HALF;
                    const v4u gz = *(const v4u*)(zg + r * IN_COLS + u.e * 1024 + c);
                    float g[8] = {bflo(gz.x), bfhi(gz.x), bflo(gz.y), bfhi(gz.y), bflo(gz.z), bfhi(gz.z), bflo(gz.w), bfhi(gz.w)};
                    f32x4 t0, t1; bf16* tp = mtmp + r * 1024 + c;
                    if (u.e == 0) { t0 = (f32x4){0.f, 0.f, 0.f, 0.f}; t1 = t0; } else { const v4u pv = *(const v4u*)tp; t0 = (f32x4){bflo(pv.x), bfhi(pv.x), bflo(pv.y), bfhi(pv.y)}; t1 = (f32x4){bflo(pv.z), bfhi(pv.z), bflo(pv.w), bfhi(pv.w)}; }
#pragma unroll
                    for (int j = 0; j < 4; ++j) { t0[j] += sigm(g[j]) * acc[ai][bj][m][0][j]; t1[j] += sigm(g[4 + j]) * acc[ai][bj][m][1][j]; }
                    if (u.e < 2) { v4u w; w.x = cvt_pk_bf16(t0[0], t0[1]); w.y = cvt_pk_bf16(t0[2], t0[3]); w.z = cvt_pk_bf16(t1[0], t1[1]); w.w = cvt_pk_bf16(t1[2], t1[3]); *(v4u*)tp = w; }
                    else { v4u w; w.x = cvt_pk_bf16(t0[0], t0[1]); w.y = cvt_pk_bf16(t0[2], t0[3]); w.z = cvt_pk_bf16(t1[0], t1[1]); w.w = cvt_pk_bf16(t1[2], t1[3]);
                        *(v4u*)(Mo + r * 1024 + c) = w; } } }
    }
};
struct EpiResid {
    static constexpr bool PERM = false;
    float* X; const float* gmod;
    __device__ __forceinline__ void operator()(const f32x4 (&acc)[2][2][4][2], const Unit& u, int wr, int wc, int fr, int fq) const {
        const int row0 = u.pm * BM + wr * 64 + fr, col0 = u.pn * BM + wc * 32 + 4 * fq;
        const int r00 = u.pm * BM; const int w = r00 < T_LAT ? (r00 >> 12) : 8;
        f32x4 gv[2][2];
#pragma unroll
        for (int bj = 0; bj < 2; ++bj)
#pragma unroll
            for (int n = 0; n < 2; ++n) gv[bj][n] = *(const f32x4*)(gmod + (size_t)w * 6144 + col0 + bj * HALF + n * 16);
#pragma unroll
        for (int ai = 0; ai < 2; ++ai)
#pragma unroll
            for (int m = 0; m < 4; ++m) { float* rowp = X + (size_t)(row0 + ai * HALF + m * 16) * 1024 + col0;
#pragma unroll
                for (int bj = 0; bj < 2; ++bj)
#pragma unroll
                    for (int n = 0; n < 2; ++n) { f32x4* p = (f32x4*)(rowp + bj * HALF + n * 16); *p = *p + gv[bj][n] * acc[ai][bj][m][n]; } }
    }
};
}

struct Args { const float* in[51]; float* out; unsigned char* ws; int ph_lo, ph_hi; };
enum { I_X = 0, I_C, I_CTX, I_CCTX, I_ADAW, I_ADAB, I_N1G, I_N2G, I_WIN, I_HYCW, I_HYCB, I_HYW1, I_HYB1, I_HYF1, I_HYW2, I_HYB2, I_HYF2, I_HYW3, I_HYB3, I_HYBIAS,
       I_RWCW, I_RWCB, I_RWWUP, I_RWW0, I_RWAUP, I_RWA0, I_RWGUP, I_RWKK, I_RWKA, I_RWRK, I_RWLNG, I_RWLNB, I_S5ARE, I_S5AIM, I_S5LDT, I_S5BRE, I_S5BIM, I_S5CRE, I_S5CIM, I_S5D,
       I_S5GLUW, I_S5GLUB, I_WBR, I_WOUT, I_RTW, I_RTB, I_W1, I_B1, I_W2, I_B2, I_FING };

typedef const __attribute__((address_space(4))) Args* CArgsP;
__device__ __forceinline__ CArgsP kargs() { CArgsP p = (CArgsP)__builtin_amdgcn_kernarg_segment_ptr(); asm volatile("" : "+s"(p)); return p; }
__device__ __forceinline__ int opaque(int v) { asm volatile("" : "+s"(v)); return v; }
__device__ __forceinline__ int opaque_v(int v) { asm volatile("" : "+v"(v)); return v; }
struct Ctx { CArgsP a; LAS unsigned char* lds; int tid, lane, wave, bid, G; };

__device__ __forceinline__ void row_seq(int row, int& base, int& pos, int& n) {
    if (row < T_LAT) { base = row & ~(SEQ - 1); pos = row & (SEQ - 1); n = SEQ; }
    else { const int r = row - T_LAT; base = T_LAT + (r & ~(CTXL - 1)); pos = r & (CTXL - 1); n = CTXL; }
}
__device__ __forceinline__ float conv3z(const bf16* zc, int pos, int n, float w0, float w1, float w2, float b) {
    const float zm = pos > 0 ? bf2f(zc[(size_t)(pos - 1) * IN_COLS]) : 0.f, z0 = bf2f(zc[(size_t)pos * IN_COLS]), zp = pos < n - 1 ? bf2f(zc[(size_t)(pos + 1) * IN_COLS]) : 0.f;
    return zm * w0 + z0 * w1 + zp * w2 + b;
}

template <int MODE>
__device__ __forceinline__ void transpose_item(const float* W, int K, int N, bf16* WT, int Hs, LAS float* scr, int item, int lane) {
    const int nblk = N / 32, kb = item / nblk, nb = item % nblk, k0 = 64 * kb, n0 = 32 * nb;
#pragma unroll 8
    for (int i = 0; i < 32; ++i) { const int kk = 2 * i + (lane >> 5); scr[kk * 33 + (lane & 31)] = W[(size_t)(k0 + kk) * N + n0 + (lane & 31)]; }
    LDS_WAIT(); asm volatile("" ::: "memory");
    const int c = lane & 7;
#pragma unroll
    for (int j = 0; j < 4; ++j) { const int n = (lane >> 3) + 8 * j; const LAS float* s = scr + (8 * c) * 33 + n;
        v4u o; o.x = pk2(s[0 * 33], s[1 * 33]); o.y = pk2(s[2 * 33], s[3 * 33]); o.z = pk2(s[4 * 33], s[5 * 33]); o.w = pk2(s[6 * 33], s[7 * 33]);
        int dr = n0 + n;
        if (MODE == 1) { const int nc = n0 + n; const int jx = nc < Hs ? nc : nc - Hs; dr = (jx >> 7) * 256 + (nc < Hs ? 0 : 128) + (jx & 127); }
        *(v4u*)(WT + (size_t)dr * K + k0 + 8 * c) = o; }
    LDS_WAIT(); asm volatile("" ::: "memory");
}

__device__ __forceinline__ void p0_prologue(const Ctx& F) {
    const auto& a = *F.a; unsigned char* ws = a.ws;
    const int gw = F.bid * NWAVES + F.wave, NGW = F.G * NWAVES, lane = F.lane;
    float* X = (float*)(ws + WS_X);
    for (int t = gw; t < SEQ; t += NGW) {
        const float pr = (float)(t >> 6), pc = (float)(t & 63);
        f32x4 pe[4];
#pragma unroll
        for (int j = 0; j < 4; ++j)
#pragma unroll
            for (int e = 0; e < 4; ++e) { const float om = 1.0f / powf(10000.0f, (float)(4 * lane + e) / 256.0f); const float ang = ((j < 2) ? pr : pc) * om; pe[j][e] = (j & 1) ? cosf(ang) : sinf(ang); }
#pragma unroll 2
        for (int bb = 0; bb < BATCH; ++bb) { const size_t row = (size_t)bb * SEQ + t;
            const f32x4* xi = (const f32x4*)(a.in[I_X] + row * D) + lane; f32x4* xo = (f32x4*)(X + row * D) + lane;
#pragma unroll
            for (int j = 0; j < 4; ++j) xo[64 * j] = xi[64 * j] + pe[j]; }
    }
    for (int row = T_LAT + gw; row < T_ALL; row += NGW) {
        const f32x4* xi = (const f32x4*)(a.in[I_CTX] + (size_t)(row - T_LAT) * D) + lane; f32x4* xo = (f32x4*)(X + (size_t)row * D) + lane;
#pragma unroll
        for (int j = 0; j < 4; ++j) xo[64 * j] = xi[64 * j];
    }
    {
        LAS float* condl = (LAS float*)F.lds; LAS float* psum = (LAS float*)(F.lds + 40960);
        for (int i = F.tid; i < 9 * 1024; i += NTHREADS) { const int w = i >> 10, k = i & 1023; const float cv = (w < 8) ? a.in[I_C][w * 1024 + k] : a.in[I_CCTX][k]; condl[i] = cv / (1.f + expf(-cv)); }
        __syncthreads();
        float* MOD = (float*)(ws + WS_MOD);
        for (int it = F.bid; it < 2 * 96; it += F.G) {
            const int l = it / 96, cg = it % 96, col = cg * 64 + lane;
            float acc[9];
#pragma unroll
            for (int w = 0; w < 9; ++w) acc[w] = 0.f;
            const float* wp = a.in[I_ADAW] + ((size_t)l * 1024 + F.wave * 128) * 6144 + col;
#pragma unroll 1
            for (int k0 = 0; k0 < 128; k0 += 16) { float wv[16];
#pragma unroll
                for (int k = 0; k < 16; ++k) wv[k] = wp[(size_t)(k0 + k) * 6144];
#pragma unroll
                for (int k = 0; k < 16; ++k)
#pragma unroll
                    for (int w = 0; w < 9; ++w) acc[w] += condl[w * 1024 + F.wave * 128 + k0 + k] * wv[k]; }
#pragma unroll
            for (int w = 0; w < 9; ++w) psum[(F.wave * 9 + w) * 64 + lane] = acc[w];
            __syncthreads();
            if (F.wave == 0) {
#pragma unroll
                for (int w = 0; w < 9; ++w) { float s = 0.f;
#pragma unroll
                    for (int wv = 0; wv < 8; ++wv) s += psum[(wv * 9 + w) * 64 + lane];
                    MOD[(size_t)(l * 9 + w) * 6144 + col] = s + a.in[I_ADAB][l * 6144 + col]; }
            }
            __syncthreads();
        }
    }
    {
        LAS float* scr = (LAS float*)(F.lds + F.wave * 16384);
        constexpr int IT_W1 = 16 * 64, IT_W2 = 16 * 32, IT_WIN = 16 * 216, IT_GLU = 8 * 32, IT_WBR = 8 * 32, IT_WOUT = 16 * 32;
        constexpr int N_W1 = 64 * IT_W1, N_W2 = 64 * IT_W2, N_WIN = 2 * IT_WIN, N_GLU = 2 * IT_GLU, N_WBR = 6 * IT_WBR, N_WOUT = 2 * IT_WOUT;
        constexpr int NITEMS = N_W1 + N_W2 + N_WIN + N_GLU + N_WBR + N_WOUT;
        for (int it = gw; it < NITEMS; it += NGW) {
            int r = it;
            if (r < N_W1) { const int mtx = r / IT_W1, l = mtx >> 5, e = mtx & 31; transpose_item<1>(a.in[I_W1] + (size_t)mtx * 1024 * 2048, 1024, 2048, (bf16*)(ws + WS_WTS + l * WL_STRIDE + WO_W1) + (size_t)e * 2048 * 1024, 1024, scr, r % IT_W1, lane); continue; } r -= N_W1;
            if (r < N_W2) { const int mtx = r / IT_W2, l = mtx >> 5, e = mtx & 31; transpose_item<0>(a.in[I_W2] + (size_t)mtx * 1024 * 1024, 1024, 1024, (bf16*)(ws + WS_WTS + l * WL_STRIDE + WO_W2) + (size_t)e * 1024 * 1024, 0, scr, r % IT_W2, lane); continue; } r -= N_W2;
            if (r < N_WIN) { const int l = r / IT_WIN; transpose_item<0>(a.in[I_WIN] + (size_t)l * 1024 * IN_COLS, 1024, IN_COLS, (bf16*)(ws + WS_WTS + l * WL_STRIDE + WO_WIN), 0, scr, r % IT_WIN, lane); continue; } r -= N_WIN;
            if (r < N_GLU) { const int l = r / IT_GLU; transpose_item<1>(a.in[I_S5GLUW] + (size_t)l * 512 * 1024, 512, 1024, (bf16*)(ws + WS_WTS + l * WL_STRIDE + WO_GLU), 512, scr, r % IT_GLU, lane); continue; } r -= N_GLU;
            if (r < N_WBR) { const int mtx = r / IT_WBR, l = mtx / 3, br = mtx % 3; transpose_item<0>(a.in[I_WBR] + (size_t)mtx * 512 * 1024, 512, 1024, (bf16*)(ws + WS_WTS + l * WL_STRIDE + WO_WBR) + (size_t)br * 1024 * 512, 0, scr, r % IT_WBR, lane); continue; } r -= N_WBR;
            { const int l = r / IT_WOUT; transpose_item<0>(a.in[I_WOUT] + (size_t)l * 1024 * 1024, 1024, 1024, (bf16*)(ws + WS_WTS + l * WL_STRIDE + WO_WOUT), 0, scr, r % IT_WOUT, lane); }
        }
        for (int i = F.bid * NTHREADS + F.tid; i < 2 * 2560 * 256; i += F.G * NTHREADS) {
            const int l = i / (2560 * 256), r = i % (2560 * 256), n = r >> 8, k = r & 255; float v = 0.f;
            if (n < 1024) { if (k < 64) v = a.in[I_RWWUP][(((size_t)l * 2 + (n >> 9)) * 64 + k) * 512 + (n & 511)]; }
            else if (n < 2048) { if (k >= 64 && k < 128) v = a.in[I_RWAUP][(((size_t)l * 2 + ((n - 1024) >> 9)) * 64 + (k - 64)) * 512 + (n & 511)]; }
            else { if (k >= 128) v = a.in[I_RWGUP][((size_t)l * 128 + (k - 128)) * 512 + (n - 2048)]; }
            ((bf16*)(ws + WS_WTS + l * WL_STRIDE + WO_RWCAT))[r] = (bf16)f2bf(v);
        }
    }
    __syncthreads();
    {
        LAS float* feats = (LAS float*)F.lds; LAS float* h1 = feats + 8 * 33; LAS float* h2 = h1 + 8 * 64;
        constexpr int NIT = 2 * (512 + 32);
        for (int it = F.bid; it < NIT; it += F.G) {
            const int l = it / 544, r = it % 544, nsel = r >= 512, n = nsel ? CTXL : SEQ, p0 = (nsel ? r - 512 : r) * 8;
            if (F.tid < 8 * 33) { const int p = F.tid / 33, i = F.tid % 33, pos = p0 + p; float f;
                if (i == 0) f = (float)pos / (float)(n - 1);
                else { const int k = (i - 1) & 15; const float band = 1e-4f + (float)k * ((15.0f - 1e-4f) / 15.0f); const float ang = (6.283185307179586f * (float)pos / (float)n) * band; f = (i <= 16) ? cosf(ang) : -sinf(ang); }
                feats[p * 33 + i] = f; }
            __syncthreads();
            { const int p = F.tid >> 6, j = F.tid & 63; float s = a.in[I_HYB1][l * 64 + j]; const float* w1p = a.in[I_HYW1] + (size_t)l * 33 * 64 + j;
#pragma unroll
                for (int i = 0; i < 33; ++i) s += feats[p * 33 + i] * w1p[i * 64];
                h1[p * 64 + j] = sinf(a.in[I_HYF1][l * 64 + j] * s); }
            __syncthreads();
            { const int p = F.tid >> 6, j = F.tid & 63; float s = a.in[I_HYB2][l * 64 + j];
                const float* w2p = a.in[I_HYW2] + (size_t)l * 64 * 64 + j;
#pragma unroll 16
                for (int i = 0; i < 64; ++i) s += h1[p * 64 + i] * w2p[i * 64];
                h2[p * 64 + j] = sinf(a.in[I_HYF2][l * 64 + j] * s); }
            __syncthreads();
            float acc[4][8];
#pragma unroll
            for (int q = 0; q < 4; ++q)
#pragma unroll
                for (int p = 0; p < 8; ++p) acc[q][p] = 0.f;
            const float* w3 = a.in[I_HYW3] + (size_t)l * 64 * 2048 + F.tid;
#pragma unroll 8
            for (int i = 0; i < 64; ++i) { float wv[4];
#pragma unroll
                for (int q = 0; q < 4; ++q) wv[q] = w3[(size_t)i * 2048 + q * 512];
#pragma unroll
                for (int p = 0; p < 8; ++p) { const float hv = h2[p * 64 + i];
#pragma unroll
                    for (int q = 0; q < 4; ++q) acc[q][p] += hv * wv[q]; } }
            const int c = F.tid; const float dstart = logf(0.01f) / 1.5f, dstop = logf(0.01f) / 0.3f; const float delta = fabsf(dstart + (float)c * ((dstop - dstart) / 511.0f));
            const int RL = nsel ? HY_RLENC : HY_RLEN, off = n + 47;
            bf16* Rb = (bf16*)(ws + WS_GF + l * GF_STRIDE + (nsel ? GF_CTX : 0));
#pragma unroll
            for (int q = 0; q < 4; ++q) { const int o = q >> 1, side = q & 1; const float b3 = a.in[I_HYB3][l * 2048 + q * 512 + c];
                bf16* Rc = Rb + ((size_t)o * 512 + c) * RL;
#pragma unroll
                for (int p = 0; p < 8; ++p) { const int pos = p0 + p; const float t = (float)pos / (float)(n - 1); const float val = (acc[q][p] + b3) * expf(-t * delta);
                    if (side == 0) Rc[off - pos] = (bf16)f2bf(val);
                    else if (pos >= 1) Rc[off + pos] = (bf16)f2bf(val); }
                if (p0 == 0 && side == 0) { for (int m = 0; m < 48; ++m) Rc[m] = 0; for (int m = off + n; m < RL; ++m) Rc[m] = 0; } }
            __syncthreads();
        }
    }
}

__device__ __forceinline__ void stage_norm1(const Ctx& F, int l) {
    const auto& a = *F.a; unsigned char* ws = a.ws; const int lane = F.lane;
    const int gw = F.bid * NWAVES + F.wave, NGW = F.G * NWAVES;
    float* X = (float*)(ws + WS_X); bf16* H = (bf16*)(ws + WS_H); const float* MOD = (const float*)(ws + WS_MOD);
    const bf16* YS = (const bf16*)(ws + WS_XS); const int* POS = (const int*)(ws + WS_POS); const float* GATE = (const float*)(ws + WS_GATE);
    const int nrows = (l == DEPTH) ? T_LAT : T_ALL;
    f32x4 ngv[4];
    { const f32x4* ngp = (l == DEPTH) ? (const f32x4*)a.in[I_FING] + lane : (const f32x4*)(a.in[I_N1G] + l * D) + lane;
#pragma unroll
      for (int j = 0; j < 4; ++j) ngv[j] = ngp[64 * j]; }
    f32x4 vn[4]; v2u ysn[4][4]; int4 pnn = make_int4(0, 0, 0, 0); f32x4 gn = (f32x4){0.f, 0.f, 0.f, 0.f}, gnn = gn;
#pragma unroll
    for (int k = 0; k < 4; ++k)
#pragma unroll
        for (int j = 0; j < 4; ++j) ysn[k][j] = (v2u){0u, 0u};
#define N1_LDYS(p4_) do { const int pk_[4] = {(p4_).x, (p4_).y, (p4_).z, (p4_).w}; _Pragma("unroll") for (int k = 0; k < 4; ++k) { const v2u* yr_ = (const v2u*)(YS + (size_t)pk_[k] * D) + lane; \
        _Pragma("unroll") for (int j = 0; j < 4; ++j) ysn[k][j] = yr_[64 * j]; } } while (0)
    if (gw < nrows) {
#pragma unroll
        for (int j = 0; j < 4; ++j) vn[j] = ((const f32x4*)(X + (size_t)gw * D) + lane)[64 * j];
        if (l > 0) { const int4 p0 = *(const int4*)(POS + gw * 4); gn = *(const f32x4*)(GATE + gw * 4);
            if (gw + NGW < nrows) { pnn = *(const int4*)(POS + (gw + NGW) * 4); gnn = *(const f32x4*)(GATE + (gw + NGW) * 4); }
            N1_LDYS(p0); } }
#pragma unroll 1
    for (int row = gw; row < nrows; row += NGW) {
        const int w = row < T_LAT ? (row >> 12) : 8;
        f32x4* xr = (f32x4*)(X + (size_t)row * D) + lane;
        f32x4 v[4]; v2u ysc[4][4];
#pragma unroll
        for (int j = 0; j < 4; ++j) v[j] = vn[j];
#pragma unroll
        for (int k = 0; k < 4; ++k)
#pragma unroll
            for (int j = 0; j < 4; ++j) ysc[k][j] = ysn[k][j];
        const f32x4 gc = gn; const int4 pnx = pnn; gn = gnn;
        const int rn = row + NGW, rnn = row + 2 * NGW;
        if (rn < nrows) {
#pragma unroll
            for (int j = 0; j < 4; ++j) vn[j] = ((const f32x4*)(X + (size_t)rn * D) + lane)[64 * j];
            if (l > 0) N1_LDYS(pnx); }
        if (l > 0 && rnn < nrows) { pnn = *(const int4*)(POS + rnn * 4); gnn = *(const f32x4*)(GATE + rnn * 4); }
        f32x4 m0[4], m1[4], m2[4];
        if (l < DEPTH) {
#pragma unroll
            for (int j = 0; j < 4; ++j) { m0[j] = ((const f32x4*)(MOD + (size_t)(l * 9 + w) * 6144) + lane)[64 * j]; m1[j] = ((const f32x4*)(MOD + (size_t)(l * 9 + w) * 6144 + 1024) + lane)[64 * j]; } }
        if (l > 0) {
#pragma unroll
            for (int j = 0; j < 4; ++j) m2[j] = ((const f32x4*)(MOD + (size_t)((l - 1) * 9 + w) * 6144 + 5120) + lane)[64 * j];
            f32x4 mo[4];
#pragma unroll
            for (int j = 0; j < 4; ++j) mo[j] = (f32x4){0.f, 0.f, 0.f, 0.f};
#pragma unroll
            for (int k = 0; k < TOPK; ++k) { const float g = gc[k];
#pragma unroll
                for (int j = 0; j < 4; ++j) { const v2u y = ysc[k][j]; mo[j][0] += g * bflo(y.x); mo[j][1] += g * bfhi(y.x); mo[j][2] += g * bflo(y.y); mo[j][3] += g * bfhi(y.y); } }
#pragma unroll
            for (int j = 0; j < 4; ++j) { v[j] = v[j] + m2[j] * mo[j]; xr[64 * j] = v[j]; }
        }
        float ss = 0.f;
#pragma unroll
        for (int j = 0; j < 4; ++j) ss += (v[j][0] * v[j][0] + v[j][1] * v[j][1]) + (v[j][2] * v[j][2] + v[j][3] * v[j][3]);
        const float rstd = __builtin_amdgcn_rsqf(wave_sum(ss) * (1.f / D) + 1e-6f);
        if (l == DEPTH) {
            f32x4* o = (f32x4*)(a.out + (size_t)row * D) + lane;
#pragma unroll
            for (int j = 0; j < 4; ++j) o[64 * j] = v[j] * rstd * ngv[j];
        } else {
            v2u* ho = (v2u*)(H + (size_t)row * D) + lane;
#pragma unroll
            for (int j = 0; j < 4; ++j) { const f32x4 h = v[j] * rstd * ngv[j] * (m1[j] + 1.0f) + m0[j]; v2u o; o.x = pk2(h[0], h[1]); o.y = pk2(h[2], h[3]); ho[64 * j] = o; }
        }
    }
#undef N1_LDYS
}

__device__ __forceinline__ void stage_rw_prep1(const Ctx& F, int l) {
    const auto& a = *F.a; unsigned char* ws = a.ws;
    const bf16* __restrict__ Z = (const bf16*)(ws + WS_Z); bf16* __restrict__ ARW = (bf16*)(ws + WS_ARW);
    const int j = 4 * (F.tid & 63), col = 1536 + j, rq = F.tid >> 6;
    const float* cw = a.in[I_RWCW] + (size_t)l * 3 * 1792;
    const f32x4 w0 = *(const f32x4*)(cw + col), w1 = *(const f32x4*)(cw + 1792 + col), w2 = *(const f32x4*)(cw + 2 * 1792 + col), cb = *(const f32x4*)(a.in[I_RWCB] + l * 1792 + col);
#pragma unroll 4
    for (int row = F.bid * 8 + rq; row < T_ALL; row += F.G * 8) {
        int base, pos, n; row_seq(row, base, pos, n);
        const bf16* zc = Z + (size_t)row * IN_COLS + RW_OFF + col;
        const v2u z0 = *(const v2u*)zc;
        v2u zm = (v2u){0u, 0u}, zp = (v2u){0u, 0u};
        if (pos > 0) zm = *(const v2u*)(zc - IN_COLS);
        if (pos < n - 1) zp = *(const v2u*)(zc + IN_COLS);
        f32x4 v = (f32x4){bflo(zm.x), bfhi(zm.x), bflo(zm.y), bfhi(zm.y)} * w0 + (f32x4){bflo(z0.x), bfhi(z0.x), bflo(z0.y), bfhi(z0.y)} * w1 + (f32x4){bflo(zp.x), bfhi(zp.x), bflo(zp.y), bfhi(zp.y)} * w2 + cb;
#pragma unroll
        for (int e2 = 0; e2 < 4; ++e2) { if (j < 64) v[e2] = tanh_fast(v[e2]); else if (j >= 128) v[e2] = sigm(v[e2]); }
        v2u o; o.x = pk2(v[0], v[1]); o.y = pk2(v[2], v[3]);
        *(v2u*)(ARW + (size_t)row * 256 + j) = o;
    }
}

__device__ __forceinline__ void stage_rw_prep2(const Ctx& F, int l) {
    const auto& a = *F.a; unsigned char* ws = a.ws; const int lane = F.lane;
    const bf16* Z = (const bf16*)(ws + WS_Z); const bf16* P = (const bf16*)(ws + WS_P); bf16* SCN = (bf16*)(ws + WS_SCN);
    const int gw = F.bid * NWAVES + F.wave, NGW = F.G * NWAVES;
    constexpr int TR = 17, NRT = T_ALL / TR;
    const float* cw = a.in[I_RWCW] + (size_t)l * 3 * 1792; const float* cbp = a.in[I_RWCB] + l * 1792;
    for (int tile = gw; tile < NRT * 4; tile += NGW) {
        const int rt = tile % NRT, hp = tile / NRT, row0 = rt * TR, c0 = hp * 128 + 2 * lane;
        f32x2 w[3][3], cb[3];
#pragma unroll
        for (int s = 0; s < 3; ++s) { cb[s] = *(const f32x2*)(cbp + s * 512 + c0);
#pragma unroll
            for (int j = 0; j < 3; ++j) w[s][j] = *(const f32x2*)(cw + j * 1792 + s * 512 + c0); }
        const f32x2 KKw = *(const f32x2*)(a.in[I_RWKK] + l * 512 + c0), KAw = *(const f32x2*)(a.in[I_RWKA] + l * 512 + c0);
        f32x2 W0[2], A0[2];
#pragma unroll
        for (int d = 0; d < 2; ++d) { W0[d] = *(const f32x2*)(a.in[I_RWW0] + (l * 2 + d) * 512 + c0); A0[d] = *(const f32x2*)(a.in[I_RWA0] + (l * 2 + d) * 512 + c0); }
        const unsigned* zb = (const unsigned*)(Z + RW_OFF + c0);
        unsigned zw[8][3], pw_[8][4];
#define P2_LDZ(j_) do { const int rr_ = row0 + (j_); if (rr_ >= 0 && rr_ < T_ALL) { _Pragma("unroll") for (int s = 0; s < 3; ++s) zw[((j_) + 1) & 7][s] = zb[(size_t)rr_ * (IN_COLS / 2) + s * 256]; } \
        else { _Pragma("unroll") for (int s = 0; s < 3; ++s) zw[((j_) + 1) & 7][s] = 0u; } } while (0)
#define P2_LDP(j_) do { const unsigned* pr_ = (const unsigned*)(P + (size_t)(row0 + (j_)) * 2560 + c0); pw_[(j_) & 7][0] = pr_[0]; pw_[(j_) & 7][1] = pr_[512]; pw_[(j_) & 7][2] = pr_[256]; pw_[(j_) & 7][3] = pr_[768]; } while (0)
        P2_LDZ(-1); P2_LDZ(0); P2_LDZ(1); P2_LDZ(2); P2_LDZ(3); P2_LDP(0); P2_LDP(1); P2_LDP(2);
#pragma unroll
        for (int i = 0; i < TR; ++i) {
            const int row = row0 + i; int base, pos, n; row_seq(row, base, pos, n);
            if (i + 4 <= TR) P2_LDZ(i + 4);
            if (i + 3 < TR) P2_LDP(i + 3);
            unsigned zm[3], z0[3], zp[3], pc_[4];
#pragma unroll
            for (int s = 0; s < 3; ++s) { zm[s] = zw[i & 7][s]; z0[s] = zw[(i + 1) & 7][s]; zp[s] = zw[(i + 2) & 7][s]; }
#pragma unroll
            for (int e = 0; e < 4; ++e) pc_[e] = pw_[i & 7][e];
            const float mlo = pos > 0 ? 1.f : 0.f, mhi = pos < n - 1 ? 1.f : 0.f;
            f32x2 u[3];
#pragma unroll
            for (int s = 0; s < 3; ++s) u[s] = (f32x2){bflo(zm[s]), bfhi(zm[s])} * mlo * w[s][0] + (f32x2){bflo(z0[s]), bfhi(z0[s])} * w[s][1] + (f32x2){bflo(zp[s]), bfhi(zp[s])} * mhi * w[s][2] + cb[s];
            const f32x2 r = u[0], k = u[1], v = u[2];
            f32x2 kk = k * KKw;
            const float ss = red32(kk[0] * kk[0] + kk[1] * kk[1]);
            kk = kk * (__builtin_amdgcn_rsqf(fmaxf(ss, 1e-24f)));
            unsigned* o = (unsigned*)(SCN + (size_t)row * 9 * 512 + c0);
            o[0] = pk2(r[0], r[1]); o[256] = pk2(v[0], v[1]); o[2 * 256] = pk2(kk[0], kk[1]);
#pragma unroll
            for (int d = 0; d < 2; ++d) {
                const unsigned pw = pc_[2 * d], pa = pc_[2 * d + 1];
                float ld[2], kd[2], be[2];
#pragma unroll
                for (int e = 0; e < 2; ++e) {
                    const float uu = W0[d][e] + (e ? bfhi(pw) : bflo(pw));
                    ld[e] = -0.60653065971263342f * sigm(uu);
                    const float av = sigm(A0[d][e] + (e ? bfhi(pa) : bflo(pa)));
                    kd[e] = k[e] * (1.f + (av - 1.f) * KAw[e]); be[e] = kk[e] * av; }
                o[(3 + 3 * d) * 256] = pk2(ld[0], ld[1]); o[(4 + 3 * d) * 256] = pk2(kd[0], kd[1]); o[(5 + 3 * d) * 256] = pk2(be[0], be[1]);
            }
        }
    }
}
#undef P2_LDZ
#undef P2_LDP

__device__ __forceinline__ int seq_row(int b, int d, int sidx) {
    if (sidx < CTXL) { const int t = d ? (CTXL - 1 - sidx) : sidx; return T_LAT + b * CTXL + t; }
    const int tl = sidx - CTXL; const int t = d ? (SEQ - 1 - tl) : tl; return b * SEQ + t;
}

constexpr int CW_WORK = 16384;
constexpr int CW_STAMP = 20480;
#ifdef PROBE_T
#ifndef PROBE_BID
#define PROBE_BID 0
#endif
#define PT(k) do { if (F.bid == PROBE_BID && F.tid == 0 && l == 0) ((unsigned long long*)(F.a->ws + WS_CTL + CW_STAMP * 4))[k] = __builtin_amdgcn_s_memrealtime(); } while (0)
#else
#define PT(k) do { } while (0)
#endif
__device__ __forceinline__ void rw_scan_item(const Ctx& F, int l, int it2) {
    const int it = it2 >> 1, half = it2 & 1;
    const auto& a = *F.a; unsigned char* ws = a.ws; const int tid = F.tid, lane = F.lane;
    const bf16* SCN = (const bf16*)(ws + WS_SCN); float* YD = (float*)(ws + WS_YDIR);
    LAS float* sbuf = (LAS float*)F.lds;
    LAS float* ybuf = (LAS float*)(F.lds + 49152);
    const bool comp = F.wave < 4;
    const int lt = tid & 255, ls = lt >> 4, lj = lt & 15;
    const int vl = lane >> 3, kq = lane & 7, vrow = half * 32 + (F.wave & 3) * 8 + vl;
    constexpr int NCH = (CTXL + SEQ) / 16;
    const int d = it & 1, h = (it >> 1) & 7, b = it >> 4;
    f32x2 S[4];
#pragma unroll
    for (int q = 0; q < 4; ++q) S[q] = (f32x2){0.f, 0.f};
    v2u ldr[6];
#define RW_ISSUE(c) do { const int row_ = seq_row(b, d, (c) * 16 + ls); const v2u* p_ = (const v2u*)(SCN + (size_t)row_ * 9 * 512 + h * 64) + lj; \
        ldr[0] = p_[2 * 128]; ldr[1] = p_[(3 + 3 * d) * 128]; ldr[2] = p_[(5 + 3 * d) * 128]; ldr[3] = p_[(4 + 3 * d) * 128]; ldr[4] = p_[0]; ldr[5] = p_[128]; } while (0)
#define RW_WRITE(bufi) do { LAS float* o_ = sbuf + (((bufi) * 16 + ls) * 6) * 64 + 4 * lj; \
        *(LAS f32x4*)(o_) = (f32x4){-bflo(ldr[0].x), -bfhi(ldr[0].x), -bflo(ldr[0].y), -bfhi(ldr[0].y)}; \
        *(LAS f32x4*)(o_ + 64) = (f32x4){__expf(bflo(ldr[1].x)), __expf(bfhi(ldr[1].x)), __expf(bflo(ldr[1].y)), __expf(bfhi(ldr[1].y))}; \
        *(LAS f32x4*)(o_ + 128) = (f32x4){bflo(ldr[2].x), bfhi(ldr[2].x), bflo(ldr[2].y), bfhi(ldr[2].y)}; *(LAS f32x4*)(o_ + 192) = (f32x4){bflo(ldr[3].x), bfhi(ldr[3].x), bflo(ldr[3].y), bfhi(ldr[3].y)}; \
        *(LAS f32x4*)(o_ + 256) = (f32x4){bflo(ldr[4].x), bfhi(ldr[4].x), bflo(ldr[4].y), bfhi(ldr[4].y)}; *(LAS f32x4*)(o_ + 320) = (f32x4){bflo(ldr[5].x), bfhi(ldr[5].x), bflo(ldr[5].y), bfhi(ldr[5].y)}; } while (0)
#define RW_FLUSH(c) do { const int row_ = seq_row(b, d, (c) * 16 + ls); \
        *(f32x2*)(YD + ((size_t)d * T_ALL + row_) * 512 + h * 64 + half * 32 + 2 * lj) = *(const LAS f32x2*)(ybuf + ((((c) & 1) * 16 + ls) * 64) + half * 32 + 2 * lj); } while (0)
    if (!comp) { RW_ISSUE(0); RW_WRITE(0); RW_ISSUE(1); }
    __syncthreads();
#pragma unroll 1
    for (int c = 0; c < NCH; ++c) {
        const int bi = c & 1;
        if (!comp) {
            if (c + 1 < NCH) RW_WRITE(bi ^ 1);
            if (c + 2 < NCH) RW_ISSUE(c + 2);
            if (c > 0) RW_FLUSH(c - 1);
        } else {
        float yv[16];
        f32x4 opA[10], opB[10]; float vvA, vvB;
#define RW_LD(op, vvx, s_) do { const LAS float* sp_ = sbuf + ((bi * 16 + (s_)) * 6) * 64 + 8 * kq; \
            _Pragma("unroll") for (int q_ = 0; q_ < 5; ++q_) { op[2 * q_] = *(const LAS f32x4*)(sp_ + 64 * q_); op[2 * q_ + 1] = *(const LAS f32x4*)(sp_ + 64 * q_ + 4); } \
            vvx = sbuf[((bi * 16 + (s_)) * 6 + 5) * 64 + vrow]; } while (0)
#define RW_COMP(op, vvx, s_) do { \
            const f32x4 a0 = op[0], a1 = op[1], w0 = op[2], w1 = op[3], b0 = op[4], b1 = op[5], k0 = op[6], k1 = op[7], r0 = op[8], r1 = op[9]; \
            const f32x2 vv2 = (f32x2){vvx, vvx}; \
            const f32x2 p0 = S[1] * (f32x2){a0[2], a0[3]} + S[0] * (f32x2){a0[0], a0[1]}; \
            const f32x2 p1 = S[3] * (f32x2){a1[2], a1[3]} + S[2] * (f32x2){a1[0], a1[1]}; \
            const f32x2 t0 = S[0] * (f32x2){w0[0], w0[1]} + vv2 * (f32x2){k0[0], k0[1]}; \
            const f32x2 t1 = S[1] * (f32x2){w0[2], w0[3]} + vv2 * (f32x2){k0[2], k0[3]}; \
            const f32x2 t2 = S[2] * (f32x2){w1[0], w1[1]} + vv2 * (f32x2){k1[0], k1[1]}; \
            const f32x2 t3 = S[3] * (f32x2){w1[2], w1[3]} + vv2 * (f32x2){k1[2], k1[3]}; \
            const f32x2 ac = p0 + p1; \
            const float sa = red8(ac[0] + ac[1]); \
            const f32x2 sa2 = (f32x2){sa, sa}; \
            S[0] = sa2 * (f32x2){b0[0], b0[1]} + t0; S[1] = sa2 * (f32x2){b0[2], b0[3]} + t1; \
            S[2] = sa2 * (f32x2){b1[0], b1[1]} + t2; S[3] = sa2 * (f32x2){b1[2], b1[3]} + t3; \
            const f32x2 q0 = S[1] * (f32x2){r0[2], r0[3]} + S[0] * (f32x2){r0[0], r0[1]}; \
            const f32x2 q1 = S[3] * (f32x2){r1[2], r1[3]} + S[2] * (f32x2){r1[0], r1[1]}; \
            const f32x2 yc = q0 + q1; \
            yv[s_] = red8(yc[0] + yc[1]); } while (0)
        RW_LD(opA, vvA, 0);
#pragma unroll
        for (int s = 0; s < 16; s += 2) {
            RW_LD(opB, vvB, s + 1);
            __builtin_amdgcn_sched_barrier(0);
            RW_COMP(opA, vvA, s);
            __builtin_amdgcn_sched_barrier(0);
            if (s + 2 < 16) RW_LD(opA, vvA, s + 2);
            __builtin_amdgcn_sched_barrier(0);
            RW_COMP(opB, vvB, s + 1);
            __builtin_amdgcn_sched_barrier(0);
        }
#undef RW_LD
#undef RW_COMP
#pragma unroll
        for (int s = 0; s < 16; ++s) if ((s & 7) == kq) ybuf[((bi * 16 + s) * 64) + vrow] = yv[s];
        }
        __syncthreads();
    }
    if (!comp) RW_FLUSH(NCH - 1);
    __syncthreads();
#undef RW_ISSUE
#undef RW_WRITE
#undef RW_FLUSH
}

constexpr size_t WS_RWSCR = WS_YHY;
constexpr int RWS_QY = 0, RWS_YV = 2048, RWS_PZ = 4096, RWS_ZV = 12288, RWS_SLOT = 20480;
typedef __bf16 bf16x8n __attribute__((ext_vector_type(8)));
__device__ __forceinline__ f32x4 mma16(const bf16x8 a, const bf16x8 b, const f32x4 c) { return __builtin_amdgcn_mfma_f32_16x16x32_bf16(a, b, c, 0, 0, 0); }
__device__ __forceinline__ float dpp_shr(float x, const int n) {
    const int v = __builtin_bit_cast(int, x); int r;
    if (n == 1) r = __builtin_amdgcn_update_dpp(0, v, 0x111, 0xF, 0xF, true); else if (n == 2) r = __builtin_amdgcn_update_dpp(0, v, 0x112, 0xF, 0xF, true);
    else if (n == 4) r = __builtin_amdgcn_update_dpp(0, v, 0x114, 0xF, 0xF, true); else r = __builtin_amdgcn_update_dpp(0, v, 0x118, 0xF, 0xF, true);
    return __builtin_bit_cast(float, r);
}
__device__ __forceinline__ v4u pack8(const float (&x)[8]) { v4u o; o.x = pk2(x[0], x[1]); o.y = pk2(x[2], x[3]); o.z = pk2(x[4], x[5]); o.w = pk2(x[6], x[7]); return o; }
__device__ __forceinline__ void unpack8(const v4u u, float (&x)[8]) { x[0] = bflo(u.x); x[1] = bfhi(u.x); x[2] = bflo(u.y); x[3] = bfhi(u.y); x[4] = bflo(u.z); x[5] = bfhi(u.z); x[6] = bflo(u.w); x[7] = bfhi(u.w); }
constexpr int LDS_ZERO16 = 131072 + 3072;
__device__ __forceinline__ bf16x8 frag16z(const LAS bf16* m, int rowbase, int lane, const LAS v4u* z) {
    const LAS v4u* p = (const LAS v4u*)(m + (rowbase + (lane & 15)) * 16 + 8 * (lane >> 4));
    const v4u v = *(((lane >> 4) < 2) ? p : z); return __builtin_bit_cast(bf16x8, v); }
#define frag16(m_, rb_, ln_) frag16z(m_, rb_, ln_, zp16)
__device__ __forceinline__ void st_colmaj(LAS bf16* m, int colbase, const f32x4 d, int lane) {
    v2u o; o.x = pk2(d[0], d[1]); o.y = pk2(d[2], d[3]); *(LAS v2u*)(m + (colbase + (lane & 15)) * 16 + 4 * (lane >> 4)) = o; }
__device__ __forceinline__ void st_rowmaj(LAS bf16* m, const f32x4 d, int lane) {
#pragma unroll
    for (int r = 0; r < 4; ++r) m[(4 * (lane >> 4) + r) * 16 + (lane & 15)] = (bf16)f2bf(d[r]); }
template <int KS0, int KS1>
__device__ __forceinline__ void rw_chunk_load(const Ctx& F, int b, int h, int d, int cidx, v4u (&raw)[12]) {
    const int lane = opaque_v(F.lane), t = lane & 15, kg = lane >> 4;
    const bf16* base = (const bf16*)(F.a->ws + WS_SCN) + (size_t)seq_row(b, d, 16 * cidx + t) * 9 * 512 + h * 64;
#pragma unroll
    for (int ks = KS0; ks < KS1; ++ks) { const int off = 32 * ks + 8 * kg;
        raw[6 * ks + 0] = *(const v4u*)(base + (3 + 3 * d) * 512 + off); raw[6 * ks + 1] = *(const v4u*)(base + 2 * 512 + off); raw[6 * ks + 2] = *(const v4u*)(base + off);
        raw[6 * ks + 3] = *(const v4u*)(base + (5 + 3 * d) * 512 + off); raw[6 * ks + 4] = *(const v4u*)(base + (4 + 3 * d) * 512 + off); raw[6 * ks + 5] = *(const v4u*)(base + 512 + off); }
}
__device__ __forceinline__ void rw_chunk_task(const Ctx& F, const v4u (&raw)[12], LAS unsigned char* wl, unsigned char* slot) {
    const LAS v4u* zp16 = (const LAS v4u*)(F.lds + LDS_ZERO16);
    const int lane = opaque_v(F.lane), t = lane & 15, kg = lane >> 4;
    LAS bf16* ATt = (LAS bf16*)(wl); LAS bf16* RBr = (LAS bf16*)(wl + 2048); LAS bf16* BHt = (LAS bf16*)(wl + 4096); LAS bf16* KHt = (LAS bf16*)(wl + 6144); LAS bf16* VTt = (LAS bf16*)(wl + 8192);
    LAS bf16* WAt = (LAS bf16*)(wl + 10240); LAS bf16* N_r = (LAS bf16*)(wl + 12288); LAS bf16* N_c = (LAS bf16*)(wl + 12800); LAS bf16* T_r = (LAS bf16*)(wl + 13312);
    LAS bf16* AK_r = (LAS bf16*)(wl + 13824); LAS bf16* RB2 = (LAS bf16*)(wl + 14336); LAS bf16* RK_r = (LAS bf16*)(wl + 14848); LAS float* GCl = (LAS float*)(wl + 15360);
    bf16x8 fAb[2], fRb[2], fBb[2], fKb[2];
#pragma unroll
    for (int ks = 0; ks < 2; ++ks) {
        const int off = 32 * ks + 8 * kg;
        float ea[8], er[8], eb[8], eh[8];
        { const v4u uld = raw[6 * ks + 0]; float ld[8]; unpack8(uld, ld);
#pragma unroll
          for (int j = 0; j < 8; ++j) { float c = ld[j]; c += dpp_shr(c, 1); c += dpp_shr(c, 2); c += dpp_shr(c, 4); c += dpp_shr(c, 8);
              const float tot = __builtin_bit_cast(float, __builtin_amdgcn_ds_bpermute((lane | 15) << 2, __builtin_bit_cast(int, c)));
              ea[j] = __expf(c - ld[j]); er[j] = __expf(c); eb[j] = __expf(-c); eh[j] = __expf(tot - c);
              if (t == 0) GCl[off + j] = __expf(tot); } }
        { const v4u u = raw[6 * ks + 1]; float x[8]; unpack8(u, x);
#pragma unroll
          for (int j = 0; j < 8; ++j) { x[j] = -x[j] * ea[j]; ATt[(off + j) * 16 + t] = (bf16)f2bf(x[j]); }
          const v4u p = pack8(x); fAb[ks] = __builtin_bit_cast(bf16x8, p); }
        { const v4u u = raw[6 * ks + 2]; float x[8]; unpack8(u, x);
#pragma unroll
          for (int j = 0; j < 8; ++j) x[j] = x[j] * er[j];
          const v4u p = pack8(x); fRb[ks] = __builtin_bit_cast(bf16x8, p); *(LAS v4u*)(RBr + t * 64 + off) = p; }
        { const v4u u = raw[6 * ks + 3]; float x[8], y[8]; unpack8(u, x);
#pragma unroll
          for (int j = 0; j < 8; ++j) { y[j] = x[j] * eb[j]; BHt[(off + j) * 16 + t] = (bf16)f2bf(x[j] * eh[j]); }
          const v4u p = pack8(y); fBb[ks] = __builtin_bit_cast(bf16x8, p); }
        { const v4u u = raw[6 * ks + 4]; float x[8], y[8]; unpack8(u, x);
#pragma unroll
          for (int j = 0; j < 8; ++j) { y[j] = x[j] * eb[j]; KHt[(off + j) * 16 + t] = (bf16)f2bf(x[j] * eh[j]); }
          const v4u p = pack8(y); fKb[ks] = __builtin_bit_cast(bf16x8, p); }
        { const v4u u = raw[6 * ks + 5];
          const bf16 e0 = (bf16)(u.x & 0xffff), e1 = (bf16)(u.x >> 16), e2 = (bf16)(u.y & 0xffff), e3 = (bf16)(u.y >> 16), e4 = (bf16)(u.z & 0xffff), e5 = (bf16)(u.z >> 16), e6 = (bf16)(u.w & 0xffff), e7 = (bf16)(u.w >> 16);
          VTt[(off + 0) * 16 + t] = e0; VTt[(off + 1) * 16 + t] = e1; VTt[(off + 2) * 16 + t] = e2; VTt[(off + 3) * 16 + t] = e3; VTt[(off + 4) * 16 + t] = e4; VTt[(off + 5) * 16 + t] = e5; VTt[(off + 6) * 16 + t] = e6; VTt[(off + 7) * 16 + t] = e7; }
        __builtin_amdgcn_sched_barrier(0);
    }
    asm volatile("" ::: "memory");
    const f32x4 z4 = (f32x4){0.f, 0.f, 0.f, 0.f};
    f32x4 n0 = mma16(fAb[1], fBb[1], mma16(fAb[0], fBb[0], z4)), aak = mma16(fAb[1], fKb[1], mma16(fAb[0], fKb[0], z4));
    f32x4 arb = mma16(fRb[1], fBb[1], mma16(fRb[0], fBb[0], z4)), ark = mma16(fRb[1], fKb[1], mma16(fRb[0], fKb[0], z4));
#pragma unroll
    for (int r = 0; r < 4; ++r) { const int tt = 4 * kg + r; if (!(t < tt)) { n0[r] = 0.f; aak[r] = 0.f; } if (!(t <= tt)) { arb[r] = 0.f; ark[r] = 0.f; } }
    st_rowmaj(AK_r, aak, lane); st_rowmaj(RB2, arb, lane); st_rowmaj(RK_r, ark, lane); asm volatile("" ::: "memory");
    f32x4 accT = n0;
#pragma unroll
    for (int r = 0; r < 4; ++r) accT[r] += (4 * kg + r == t) ? 1.f : 0.f;
    f32x4 nn = n0;
#pragma unroll
    for (int itn = 0; itn < 3; ++itn) {
        st_rowmaj(N_r, nn, lane); st_colmaj(N_c, 0, nn, lane); st_rowmaj(T_r, accT, lane); asm volatile("" ::: "memory");
        const bf16x8 fa = frag16(N_r, 0, lane), fb = frag16(N_c, 0, lane), ft = frag16(T_r, 0, lane);
        nn = mma16(fa, fb, z4); asm volatile("" ::: "memory");
        st_colmaj(N_c, 0, nn, lane); asm volatile("" ::: "memory");
        const bf16x8 fb2 = frag16(N_c, 0, lane);
        accT = mma16(ft, fb2, accT); asm volatile("" ::: "memory");
    }
    st_rowmaj(T_r, accT, lane); asm volatile("" ::: "memory");
    const bf16x8 fT = frag16(T_r, 0, lane), fAK = frag16(AK_r, 0, lane), fARB = frag16(RB2, 0, lane), fARK = frag16(RK_r, 0, lane);
#pragma unroll
    for (int kt = 0; kt < 4; ++kt) { const f32x4 dd = mma16(fT, frag16(ATt, 16 * kt, lane), z4); st_colmaj(WAt, 16 * kt, dd, lane); } asm volatile("" ::: "memory");
    { const bf16x8 fArbT = frag16(RB2, 0, lane);
#pragma unroll
      for (int kt = 0; kt < 4; ++kt) { const v2u ri = *(const LAS v2u*)(RBr + t * 64 + 16 * kt + 4 * kg);
          f32x4 c0 = (f32x4){bflo(ri.x), bfhi(ri.x), bflo(ri.y), bfhi(ri.y)};
          c0 = mma16(frag16(WAt, 16 * kt, lane), fArbT, c0);
          v2u o; o.x = pk2(c0[0], c0[1]); o.y = pk2(c0[2], c0[3]); *(v2u*)(slot + RWS_QY + (t * 64 + 16 * kt + 4 * kg) * 2) = o; } }
    asm volatile("" ::: "memory");
#pragma unroll
    for (int vt = 0; vt < 4; ++vt) { const f32x4 dd = mma16(fAK, frag16(VTt, 16 * vt, lane), z4); st_colmaj(ATt, 16 * vt, dd, lane); } asm volatile("" ::: "memory");
    asm volatile("" ::: "memory");
    LAS bf16* UVt = RBr;
#pragma unroll
    for (int vt = 0; vt < 4; ++vt) { const f32x4 dd = mma16(fT, frag16(ATt, 16 * vt, lane), z4); st_colmaj(UVt, 16 * vt, dd, lane); } asm volatile("" ::: "memory");
#pragma unroll
    for (int vt = 0; vt < 4; ++vt) { const f32x4 dd = mma16(fARK, frag16(VTt, 16 * vt, lane), mma16(fARB, frag16(UVt, 16 * vt, lane), z4));
        v2u o; o.x = pk2(dd[0], dd[1]); o.y = pk2(dd[2], dd[3]); *(v2u*)(slot + RWS_YV + ((16 * vt + t) * 16 + 4 * kg) * 2) = o; }
#pragma unroll
    for (int ktp = 0; ktp < 4; ++ktp) { const bf16x8 fBh = frag16(BHt, 16 * ktp, lane);
#pragma unroll
        for (int kt = 0; kt < 4; ++kt) { f32x4 dd = mma16(frag16(WAt, 16 * kt, lane), fBh, z4);
            if (kt == ktp) {
#pragma unroll
                for (int r = 0; r < 4; ++r) if (4 * kg + r == t) dd[r] += GCl[16 * kt + t]; }
            v2u o; o.x = pk2(dd[0], dd[1]); o.y = pk2(dd[2], dd[3]); *(v2u*)(slot + RWS_PZ + ((16 * ktp + t) * 64 + 16 * kt + 4 * kg) * 2) = o; } }
#pragma unroll
    for (int vt = 0; vt < 4; ++vt) { const bf16x8 fU = frag16(UVt, 16 * vt, lane), fV = frag16(VTt, 16 * vt, lane);
#pragma unroll
        for (int ktp = 0; ktp < 4; ++ktp) { const f32x4 dd = mma16(frag16(KHt, 16 * ktp, lane), fV, mma16(frag16(BHt, 16 * ktp, lane), fU, z4));
            v2u o; o.x = pk2(dd[0], dd[1]); o.y = pk2(dd[2], dd[3]); *(v2u*)(slot + RWS_ZV + ((16 * vt + t) * 64 + 16 * ktp + 4 * kg) * 2) = o; } }
}
__device__ __forceinline__ void rw_chunk_task2(const Ctx& F, const v4u (&raw)[12], LAS unsigned char* wl, f32x4 (&yv)[4], f32x4 (&zv)[4][4]) {
    const LAS v4u* zp16 = (const LAS v4u*)(F.lds + LDS_ZERO16);
    const int lane = opaque_v(F.lane), t = lane & 15, kg = lane >> 4;
    LAS bf16* ATt = (LAS bf16*)(wl); LAS bf16* RBr = (LAS bf16*)(wl + 2048); LAS bf16* BHt = (LAS bf16*)(wl + 4096); LAS bf16* KHt = (LAS bf16*)(wl + 6144); LAS bf16* VTt = (LAS bf16*)(wl + 8192);
    LAS bf16* WAt = (LAS bf16*)(wl + 10240); LAS bf16* N_r = (LAS bf16*)(wl + 12288); LAS bf16* N_c = (LAS bf16*)(wl + 12800); LAS bf16* T_r = (LAS bf16*)(wl + 13312);
    LAS bf16* AK_r = (LAS bf16*)(wl + 13824); LAS bf16* RB2 = (LAS bf16*)(wl + 14336); LAS bf16* RK_r = (LAS bf16*)(wl + 14848); LAS float* GCl = (LAS float*)(wl + 15360);
    bf16x8 fAb[2], fRb[2], fBb[2], fKb[2];
#pragma unroll
    for (int ks = 0; ks < 2; ++ks) {
        const int off = 32 * ks + 8 * kg;
        float ea[8], er[8], eb[8], eh[8];
        { const v4u uld = raw[6 * ks + 0]; float ld[8]; unpack8(uld, ld);
#pragma unroll
          for (int j = 0; j < 8; ++j) { float c = ld[j]; c += dpp_shr(c, 1); c += dpp_shr(c, 2); c += dpp_shr(c, 4); c += dpp_shr(c, 8);
              const float tot = __builtin_bit_cast(float, __builtin_amdgcn_ds_bpermute((lane | 15) << 2, __builtin_bit_cast(int, c)));
              ea[j] = __expf(c - ld[j]); er[j] = __expf(c); eb[j] = __expf(-c); eh[j] = __expf(tot - c);
              if (t == 0) GCl[off + j] = __expf(tot); } }
        { const v4u u = raw[6 * ks + 1]; float x[8]; unpack8(u, x);
#pragma unroll
          for (int j = 0; j < 8; ++j) { x[j] = -x[j] * ea[j]; ATt[(off + j) * 16 + t] = (bf16)f2bf(x[j]); }
          const v4u p = pack8(x); fAb[ks] = __builtin_bit_cast(bf16x8, p); }
        { const v4u u = raw[6 * ks + 2]; float x[8]; unpack8(u, x);
#pragma unroll
          for (int j = 0; j < 8; ++j) x[j] = x[j] * er[j];
          const v4u p = pack8(x); fRb[ks] = __builtin_bit_cast(bf16x8, p); *(LAS v4u*)(RBr + t * 64 + off) = p; }
        { const v4u u = raw[6 * ks + 3]; float x[8], y[8]; unpack8(u, x);
#pragma unroll
          for (int j = 0; j < 8; ++j) { y[j] = x[j] * eb[j]; BHt[(off + j) * 16 + t] = (bf16)f2bf(x[j] * eh[j]); }
          const v4u p = pack8(y); fBb[ks] = __builtin_bit_cast(bf16x8, p); }
        { const v4u u = raw[6 * ks + 4]; float x[8], y[8]; unpack8(u, x);
#pragma unroll
          for (int j = 0; j < 8; ++j) { y[j] = x[j] * eb[j]; KHt[(off + j) * 16 + t] = (bf16)f2bf(x[j] * eh[j]); }
          const v4u p = pack8(y); fKb[ks] = __builtin_bit_cast(bf16x8, p); }
        { const v4u u = raw[6 * ks + 5];
          const bf16 e0 = (bf16)(u.x & 0xffff), e1 = (bf16)(u.x >> 16), e2 = (bf16)(u.y & 0xffff), e3 = (bf16)(u.y >> 16), e4 = (bf16)(u.z & 0xffff), e5 = (bf16)(u.z >> 16), e6 = (bf16)(u.w & 0xffff), e7 = (bf16)(u.w >> 16);
          VTt[(off + 0) * 16 + t] = e0; VTt[(off + 1) * 16 + t] = e1; VTt[(off + 2) * 16 + t] = e2; VTt[(off + 3) * 16 + t] = e3; VTt[(off + 4) * 16 + t] = e4; VTt[(off + 5) * 16 + t] = e5; VTt[(off + 6) * 16 + t] = e6; VTt[(off + 7) * 16 + t] = e7; }
        __builtin_amdgcn_sched_barrier(0);
    }
    asm volatile("" ::: "memory");
    const f32x4 z4 = (f32x4){0.f, 0.f, 0.f, 0.f};
    f32x4 n0 = mma16(fAb[1], fBb[1], mma16(fAb[0], fBb[0], z4)), aak = mma16(fAb[1], fKb[1], mma16(fAb[0], fKb[0], z4));
    f32x4 arb = mma16(fRb[1], fBb[1], mma16(fRb[0], fBb[0], z4)), ark = mma16(fRb[1], fKb[1], mma16(fRb[0], fKb[0], z4));
#pragma unroll
    for (int r = 0; r < 4; ++r) { const int tt = 4 * kg + r; if (!(t < tt)) { n0[r] = 0.f; aak[r] = 0.f; } if (!(t <= tt)) { arb[r] = 0.f; ark[r] = 0.f; } }
    st_rowmaj(AK_r, aak, lane); st_rowmaj(RB2, arb, lane); st_rowmaj(RK_r, ark, lane); asm volatile("" ::: "memory");
    f32x4 accT = n0;
#pragma unroll
    for (int r = 0; r < 4; ++r) accT[r] += (4 * kg + r == t) ? 1.f : 0.f;
    f32x4 nn = n0;
#pragma unroll
    for (int itn = 0; itn < 3; ++itn) {
        st_rowmaj(N_r, nn, lane); st_colmaj(N_c, 0, nn, lane); st_rowmaj(T_r, accT, lane); asm volatile("" ::: "memory");
        const bf16x8 fa = frag16(N_r, 0, lane), fb = frag16(N_c, 0, lane), ft = frag16(T_r, 0, lane);
        nn = mma16(fa, fb, z4); asm volatile("" ::: "memory");
        st_colmaj(N_c, 0, nn, lane); asm volatile("" ::: "memory");
        const bf16x8 fb2 = frag16(N_c, 0, lane);
        accT = mma16(ft, fb2, accT); asm volatile("" ::: "memory");
    }
    st_rowmaj(T_r, accT, lane); asm volatile("" ::: "memory");
    const bf16x8 fT = frag16(T_r, 0, lane), fAK = frag16(AK_r, 0, lane), fARB = frag16(RB2, 0, lane), fARK = frag16(RK_r, 0, lane);
#pragma unroll
    for (int kt = 0; kt < 4; ++kt) { const f32x4 dd = mma16(fT, frag16(ATt, 16 * kt, lane), z4); st_colmaj(WAt, 16 * kt, dd, lane); } asm volatile("" ::: "memory");
    f32x4 qy[4];
    { const bf16x8 fArbT = frag16(RB2, 0, lane);
#pragma unroll
      for (int kt = 0; kt < 4; ++kt) { const v2u ri = *(const LAS v2u*)(RBr + t * 64 + 16 * kt + 4 * kg);
          qy[kt] = mma16(frag16(WAt, 16 * kt, lane), fArbT, (f32x4){bflo(ri.x), bfhi(ri.x), bflo(ri.y), bfhi(ri.y)}); } }
    asm volatile("" ::: "memory");
#pragma unroll
    for (int vt = 0; vt < 4; ++vt) { const f32x4 dd = mma16(fAK, frag16(VTt, 16 * vt, lane), z4); st_colmaj(ATt, 16 * vt, dd, lane); } asm volatile("" ::: "memory");
    LAS bf16* UVt = RBr;
#pragma unroll
    for (int vt = 0; vt < 4; ++vt) { const f32x4 dd = mma16(fT, frag16(ATt, 16 * vt, lane), z4); st_colmaj(UVt, 16 * vt, dd, lane); } asm volatile("" ::: "memory");
#pragma unroll
    for (int vt = 0; vt < 4; ++vt) { const bf16x8 fU = frag16(UVt, 16 * vt, lane), fV = frag16(VTt, 16 * vt, lane);
        yv[vt] = mma16(fARK, fV, mma16(fARB, fU, z4));
#pragma unroll
        for (int ktp = 0; ktp < 4; ++ktp) zv[vt][ktp] = mma16(frag16(KHt, 16 * ktp, lane), fV, mma16(frag16(BHt, 16 * ktp, lane), fU, z4)); }
    f32x4 pz[4][4];
#pragma unroll
    for (int ktp = 0; ktp < 4; ++ktp) { const bf16x8 fBh = frag16(BHt, 16 * ktp, lane);
#pragma unroll
        for (int kt = 0; kt < 4; ++kt) { f32x4 dd = mma16(frag16(WAt, 16 * kt, lane), fBh, z4);
            if (kt == ktp) {
#pragma unroll
                for (int r = 0; r < 4; ++r) if (4 * kg + r == t) dd[r] += GCl[16 * kt + t]; }
            pz[ktp][kt] = dd; } }
    asm volatile("s_waitcnt lgkmcnt(0)" ::: "memory");
#pragma unroll
    for (int ktp = 0; ktp < 4; ++ktp) { LAS bf16* reg = (LAS bf16*)(wl + (ktp < 2 ? ktp * 2048 : (ktp + 1) * 2048));
#pragma unroll
        for (int kt = 0; kt < 4; ++kt) { v2u o; o.x = pk2(pz[ktp][kt][0], pz[ktp][kt][1]); o.y = pk2(pz[ktp][kt][2], pz[ktp][kt][3]); *(LAS v2u*)(reg + t * 64 + 16 * kt + 4 * kg) = o; } }
#pragma unroll
    for (int kt = 0; kt < 4; ++kt) { v2u o; o.x = pk2(qy[kt][0], qy[kt][1]); o.y = pk2(qy[kt][2], qy[kt][3]); *(LAS v2u*)(BHt + t * 64 + 16 * kt + 4 * kg) = o; }
    asm volatile("s_waitcnt lgkmcnt(0)" ::: "memory");
}
constexpr int RWZ_OFF = LDSCTL_OFF + 8192, RWF_OFF = LDSCTL_OFF + 2048;
__device__ __forceinline__ void rw_chunk_item2(const Ctx& F, int l, int it, size_t yoff = WS_YDIR) {
    const auto& a = *F.a; unsigned char* ws = a.ws; const int lane = opaque_v(F.lane), t = lane & 15, kg = lane >> 4;
    const int d = it & 1, h = (it >> 1) & 7, b = it >> 4;
    float* YD = (float*)(ws + yoff);
    LAS unsigned char* wl = F.lds + F.wave * 15616;
    LAS bf16* ZS = (LAS bf16*)(F.lds + RWZ_OFF);
    volatile LAS int* flag = (volatile LAS int*)(F.lds + RWF_OFF);
    for (int i = F.tid; i < 2048; i += NTHREADS) ((LAS unsigned*)ZS)[i] = 0u;
    if (F.tid == 0) *flag = 0;
    __syncthreads();
    constexpr int NCHK = (CTXL + SEQ) / 16;
    v4u raw[12];
    rw_chunk_load<0, 2>(F, b, h, d, F.wave, raw);
#pragma unroll 1
    for (int c = F.wave; c < NCHK; c += NWAVES) {
        f32x4 yv[4], zv[4][4];
        rw_chunk_task2(F, raw, wl, yv, zv);
        if (c + NWAVES < NCHK) rw_chunk_load<0, 2>(F, b, h, d, c + NWAVES, raw);
        while (*flag < c) __builtin_amdgcn_s_sleep(1);
        asm volatile("" ::: "memory");
        const LAS bf16* Zc = ZS + (c & 1) * 4096; LAS bf16* Zn = ZS + ((c + 1) & 1) * 4096;
        bf16x8 zb[4][2];
#pragma unroll
        for (int vb = 0; vb < 4; ++vb)
#pragma unroll
            for (int ks = 0; ks < 2; ++ks) zb[vb][ks] = *(const LAS bf16x8*)(Zc + (16 * vb + t) * 64 + 32 * ks + 8 * kg);
        { const LAS bf16* Qr = (const LAS bf16*)(wl + 4096); const bf16x8 q0 = *(const LAS bf16x8*)(Qr + t * 64 + 8 * kg), q1 = *(const LAS bf16x8*)(Qr + t * 64 + 32 + 8 * kg);
#pragma unroll
          for (int vb = 0; vb < 4; ++vb) { const f32x4 y = mma16(q1, zb[vb][1], mma16(q0, zb[vb][0], yv[vb]));
#pragma unroll
              for (int r = 0; r < 4; ++r) { const int row = seq_row(b, d, c * 16 + 4 * kg + r); YD[((size_t)d * T_ALL + row) * 512 + h * 64 + 16 * vb + t] = y[r]; } } }
#pragma unroll
        for (int ktp = 0; ktp < 4; ++ktp) { const LAS bf16* Pr = (const LAS bf16*)(wl + (ktp < 2 ? ktp * 2048 : (ktp + 1) * 2048));
            const bf16x8 p0 = *(const LAS bf16x8*)(Pr + t * 64 + 8 * kg), p1 = *(const LAS bf16x8*)(Pr + t * 64 + 32 + 8 * kg);
#pragma unroll
            for (int vb = 0; vb < 4; ++vb) { const f32x4 z = mma16(p1, zb[vb][1], mma16(p0, zb[vb][0], zv[vb][ktp]));
                v2u o; o.x = pk2(z[0], z[1]); o.y = pk2(z[2], z[3]); *(LAS v2u*)(Zn + (16 * vb + t) * 64 + 16 * ktp + 4 * kg) = o; } }
        asm volatile("s_waitcnt lgkmcnt(0)" ::: "memory");
        if (lane == 0) *flag = c + 1;
        asm volatile("s_waitcnt lgkmcnt(0)" ::: "memory");
    }
    __syncthreads();
}
__device__ __forceinline__ v2u ld_sc1_8(const void* p) { const unsigned long long v = __hip_atomic_load((const unsigned long long*)p, __ATOMIC_RELAXED, __HIP_MEMORY_SCOPE_AGENT); v2u o; o.x = (unsigned)v; o.y = (unsigned)(v >> 32); return o; }
__device__ __forceinline__ v4u ld_sc1_16(const void* p) { const v2u a = ld_sc1_8(p), b = ld_sc1_8((const char*)p + 8); return (v4u){a.x, a.y, b.x, b.y}; }
__device__ __forceinline__ void rw_chunk_item(const Ctx& F, int l, int it) {
    const auto& a = *F.a; unsigned char* ws = a.ws; const int lane = F.lane, t = lane & 15, kg = lane >> 4;
    const int d = it & 1, h = (it >> 1) & 7, b = it >> 4;
    float* YD = (float*)(ws + WS_YDIR);
    unsigned char* scr = ws + WS_RWSCR + (size_t)F.bid * 16 * RWS_SLOT;
    LAS unsigned char* wl = F.lds + F.wave * 15616;
    LAS bf16* ZL = (LAS bf16*)(F.lds + LDSCTL_OFF + 4096 + (F.wave & 3) * 2048);
    if (F.wave < 4) { for (int i = lane; i < 512; i += 64) ((LAS unsigned*)ZL)[i] = 0u; }
    asm volatile("" ::: "memory");
    constexpr int NCHK = (CTXL + SEQ) / 16, NB = NCHK / 16;
#pragma unroll 1
    for (int bt = 0; bt < NB; ++bt) {
        { v4u cur[12];
#pragma unroll 1
          for (int jj = 0; jj < 2; ++jj) { rw_chunk_load<0, 2>(F, b, h, d, bt * 16 + F.wave + 8 * jj, cur); rw_chunk_task(F, cur, wl, scr + (size_t)(F.wave + 8 * jj) * RWS_SLOT); } }
        asm volatile("s_waitcnt vmcnt(0)" ::: "memory");
        __syncthreads();
        {
            const int t = opaque_v(lane & 15), kg = opaque_v(lane >> 4), vb = opaque(F.wave) & 3;
            const unsigned char* scrb = F.a->ws + WS_RWSCR + (size_t)opaque(F.bid) * 16 * RWS_SLOT;
            LAS unsigned char* sbuf = F.lds;
            const int lt = opaque_v(F.tid) & 255; const bool loader = F.wave >= 4;
            const int lw = opaque(F.wave) & 3;
#define RWB_ISSUE(j_) do { const unsigned char* gp_ = scrb + (size_t)(j_) * RWS_SLOT + (size_t)(lw * 5) * 1024 + lane * 16; LAS unsigned char* lp_ = sbuf + ((j_) % 6) * RWS_SLOT + (lw * 5) * 1024; \
                _Pragma("unroll") for (int q = 0; q < 5; ++q) __builtin_amdgcn_global_load_lds((const unsigned*)(gp_ + q * 1024), (LAS unsigned*)(lp_ + q * 1024), 16, 0, 16); } while (0)
#define RWB_COMP(bi_, j_) do { const LAS unsigned char* sl_ = sbuf + (bi_) * RWS_SLOT; bf16x8 zb[2], qf[2]; \
                _Pragma("unroll") for (int ks = 0; ks < 2; ++ks) { zb[ks] = *(const LAS bf16x8*)(ZL + t * 64 + 32 * ks + 8 * kg); qf[ks] = *(const LAS bf16x8*)(sl_ + RWS_QY + (t * 64 + 32 * ks + 8 * kg) * 2); } \
                const v2u y_ = *(const LAS v2u*)(sl_ + RWS_YV + ((16 * vb + t) * 16 + 4 * kg) * 2); \
                f32x4 yacc = (f32x4){bflo(y_.x), bfhi(y_.x), bflo(y_.y), bfhi(y_.y)}; \
                yacc = mma16(qf[1], zb[1], mma16(qf[0], zb[0], yacc)); \
                f32x4 zn[4]; \
                _Pragma("unroll") for (int ktp = 0; ktp < 4; ++ktp) { const v2u z_ = *(const LAS v2u*)(sl_ + RWS_ZV + ((16 * vb + t) * 64 + 16 * ktp + 4 * kg) * 2); \
                    f32x4 zc = (f32x4){bflo(z_.x), bfhi(z_.x), bflo(z_.y), bfhi(z_.y)}; \
                    _Pragma("unroll") for (int ks = 0; ks < 2; ++ks) zc = mma16(*(const LAS bf16x8*)(sl_ + RWS_PZ + ((16 * ktp + t) * 64 + 32 * ks + 8 * kg) * 2), zb[ks], zc); \
                    zn[ktp] = zc; } \
                _Pragma("unroll") for (int r = 0; r < 4; ++r) { const int row = seq_row(b, d, (bt * 16 + (j_)) * 16 + 4 * kg + r); YD[((size_t)d * T_ALL + row) * 512 + h * 64 + 16 * vb + t] = yacc[r]; } \
                asm volatile("s_waitcnt lgkmcnt(0)" ::: "memory"); \
                _Pragma("unroll") for (int ktp = 0; ktp < 4; ++ktp) { v2u o; o.x = pk2(zn[ktp][0], zn[ktp][1]); o.y = pk2(zn[ktp][2], zn[ktp][3]); *(LAS v2u*)(ZL + t * 64 + 16 * ktp + 4 * kg) = o; } \
                asm volatile("s_waitcnt lgkmcnt(0)" ::: "memory"); } while (0)
#define RWB_BAR() do { asm volatile("s_waitcnt lgkmcnt(0)" ::: "memory"); __builtin_amdgcn_s_barrier(); asm volatile("" ::: "memory"); } while (0)
            if (loader) { RWB_ISSUE(0); RWB_ISSUE(1); RWB_ISSUE(2); RWB_ISSUE(3); asm volatile("s_waitcnt vmcnt(15)" ::: "memory"); }
            RWB_BAR();
#pragma unroll 1
            for (int j = 0; j < 16; ++j) {
                if (loader) { if (j + 4 < 16) { RWB_ISSUE(j + 4); asm volatile("s_waitcnt vmcnt(15)" ::: "memory"); } else { asm volatile("s_waitcnt vmcnt(0)" ::: "memory"); } }
                else { RWB_COMP(j % 6, j); }
                RWB_BAR();
            }
#undef RWB_BAR
#undef RWB_ISSUE
#undef RWB_COMP
        }
        __syncthreads();
    }
}

__device__ __forceinline__ void stage_rw_readout(const Ctx& F, int l) {
    const auto& a = *F.a; unsigned char* ws = a.ws; const int lane = F.lane;
    const bf16* SCN = (const bf16*)(ws + WS_SCN); const bf16* P = (const bf16*)(ws + WS_P); const float* YD = (const float*)(ws + WS_YDIR); bf16* YRW = (bf16*)(ws + WS_YRW);
    const int gw = F.bid * NWAVES + F.wave, NGW = F.G * NWAVES;
    constexpr int TR = 17, NRT = T_ALL / TR;
    for (int tile = gw; tile < NRT * 4; tile += NGW) {
        const int rt = tile % NRT, hp = tile / NRT, row0 = rt * TR, c0 = hp * 128 + 2 * lane;
        const f32x2 rk = *(const f32x2*)(a.in[I_RWRK] + l * 512 + c0), lng = *(const f32x2*)(a.in[I_RWLNG] + l * 512 + c0), lnb = *(const f32x2*)(a.in[I_RWLNB] + l * 512 + c0);
        unsigned sw_[8][5]; f32x2 yw_[8][2];
#define RO_LD(j_) do { const int rr_ = row0 + (j_); const unsigned* sp_ = (const unsigned*)(SCN + (size_t)rr_ * 9 * 512 + c0); \
        sw_[(j_) & 7][0] = sp_[0]; sw_[(j_) & 7][1] = sp_[256]; sw_[(j_) & 7][2] = sp_[4 * 256]; sw_[(j_) & 7][3] = sp_[7 * 256]; sw_[(j_) & 7][4] = *(const unsigned*)(P + (size_t)rr_ * 2560 + 2048 + c0); \
        yw_[(j_) & 7][0] = *(const f32x2*)(YD + (size_t)rr_ * 512 + c0); yw_[(j_) & 7][1] = *(const f32x2*)(YD + ((size_t)T_ALL + rr_) * 512 + c0); } while (0)
        RO_LD(0); RO_LD(1); RO_LD(2);
#pragma unroll
        for (int i = 0; i < TR; ++i) {
            const int row = row0 + i;
            if (i + 3 < TR) RO_LD(i + 3);
            const unsigned ru = sw_[i & 7][0], vu = sw_[i & 7][1], k0u = sw_[i & 7][2], k1u = sw_[i & 7][3], gu = sw_[i & 7][4];
            const f32x2 y0 = yw_[i & 7][0], y1 = yw_[i & 7][1];
            const float bon = red32(bflo(ru) * (bflo(k0u) + bflo(k1u)) * rk[0] + bfhi(ru) * (bfhi(k0u) + bfhi(k1u)) * rk[1]);
            f32x2 y = y0 + y1 + (f32x2){bflo(vu), bfhi(vu)} * bon;
            const float mu = red32(y[0] + y[1]) * (1.f / 64.f);
            y = y - mu;
            const float var = red32(y[0] * y[0] + y[1] * y[1]) * (1.f / 64.f);
            const f32x2 yn = y * (__builtin_amdgcn_rsqf(var + 64e-5f));
            const f32x2 ov = (yn * lng + lnb) * (f32x2){bflo(gu), bfhi(gu)};
            *(unsigned*)(YRW + (size_t)row * 512 + c0) = pk2(ov[0], ov[1]);
        }
    }
}
#undef RO_LD

constexpr size_t WS_S5E = 6 * MiB;
constexpr int S5_NSEG = 4, S5_SEGLEN = (CTXL + SEQ) / S5_NSEG;
__device__ __forceinline__ void s5_disc(const float are, const float aim, const float dt, float& lbr, float& lbi, float& cr, float& ci) {
    const float mag = expf(are * dt); lbr = mag * cosf(aim * dt); lbi = mag * sinf(aim * dt);
    const float den = are * are + aim * aim, nr = lbr - 1.0f; cr = (nr * are + lbi * aim) / den; ci = (lbi * are - nr * aim) / den;
}
template <int PASS>
__device__ __forceinline__ void stage_s5_scan(const Ctx& F, int l) {
    const auto& a = *F.a; unsigned char* ws = a.ws; const int lane = F.lane;
    const bf16* Z = (const bf16*)(ws + WS_Z); float* YP = (float*)(ws + WS_YP); f32x2* S5E = (f32x2*)(ws + WS_S5E);
    LAS unsigned char* wl = F.lds + F.wave * 16384;
    LAS float* buL = (LAS float*)wl;
    LAS bf16* Hs = (LAS bf16*)(wl + 8704);
    const int fr = lane & 15, kg = lane >> 4;
    for (int itx = F.bid * NWAVES + F.wave; itx < BATCH * 32 * 2 * S5_NSEG; itx += NWAVES * F.G) {
        const int seg = itx & (S5_NSEG - 1), it = itx >> 2;
        const int d = it & 1, g = (it >> 1) & 31, b = it >> 6, p = lane;
        const float dt = expf(a.in[I_S5LDT][(l * 2 + d) * 32 + g]);
        const float* arep = a.in[I_S5ARE] + ((size_t)(l * 2 + d) * 32 + g) * 64; const float* aimp = a.in[I_S5AIM] + ((size_t)(l * 2 + d) * 32 + g) * 64;
        float lbr, lbi, cr_, ci_; s5_disc(arep[p], aimp[p], dt, lbr, lbi, cr_, ci_);
        bf16x8 afr[2][4];
#pragma unroll
        for (int tl = 0; tl < 4; ++tl) { const int pp = 16 * tl + fr; float r0_, r1_, cr, ci; s5_disc(arep[pp], aimp[pp], dt, r0_, r1_, cr, ci);
            v4u pr = (v4u){0u, 0u, 0u, 0u}, pi = (v4u){0u, 0u, 0u, 0u};
            if (kg < 2) { const float* br = a.in[I_S5BRE] + (((size_t)l * 32 + g) * 64 + pp) * 16 + 8 * kg; const float* bi = a.in[I_S5BIM] + (((size_t)l * 32 + g) * 64 + pp) * 16 + 8 * kg;
                const f32x4 x0 = *(const f32x4*)br, x1 = *(const f32x4*)(br + 4), y0 = *(const f32x4*)bi, y1 = *(const f32x4*)(bi + 4);
                pr.x = pk2(cr * x0[0] - ci * y0[0], cr * x0[1] - ci * y0[1]); pr.y = pk2(cr * x0[2] - ci * y0[2], cr * x0[3] - ci * y0[3]);
                pr.z = pk2(cr * x1[0] - ci * y1[0], cr * x1[1] - ci * y1[1]); pr.w = pk2(cr * x1[2] - ci * y1[2], cr * x1[3] - ci * y1[3]);
                pi.x = pk2(cr * y0[0] + ci * x0[0], cr * y0[1] + ci * x0[1]); pi.y = pk2(cr * y0[2] + ci * x0[2], cr * y0[3] + ci * x0[3]);
                pi.z = pk2(cr * y1[0] + ci * x1[0], cr * y1[1] + ci * x1[1]); pi.w = pk2(cr * y1[2] + ci * x1[2], cr * y1[3] + ci * x1[3]); }
            afr[0][tl] = __builtin_bit_cast(bf16x8, pr); afr[1][tl] = __builtin_bit_cast(bf16x8, pi); }
        bf16x8 cf[4];
        f32x2 hst = (f32x2){0.f, 0.f};
        if (PASS == 1) {
#pragma unroll
            for (int kk = 0; kk < 4; ++kk) { const int p0 = 16 * kk + 4 * kg;
                const f32x4 c0 = *(const f32x4*)(a.in[I_S5CRE] + (((size_t)l * 32 + g) * 16 + fr) * 64 + p0), c1 = *(const f32x4*)(a.in[I_S5CIM] + (((size_t)l * 32 + g) * 16 + fr) * 64 + p0);
                v4u pk; pk.x = pk2(c0[0], -c1[0]); pk.y = pk2(c0[1], -c1[1]); pk.z = pk2(c0[2], -c1[2]); pk.w = pk2(c0[3], -c1[3]);
                cf[kk] = __builtin_bit_cast(bf16x8, pk); }
            float pr_ = lbr, pi_ = lbi, l64r = 1.f, l64i = 0.f;
#pragma unroll 1
            for (int q = 0; q < 10; ++q) { const float nr2 = pr_ * pr_ - pi_ * pi_, ni2 = 2.f * pr_ * pi_; pr_ = nr2; pi_ = ni2; if (q == 5) { l64r = pr_; l64i = pi_; } }
            const float lLr = pr_ * l64r - pi_ * l64i, lLi = pr_ * l64i + pi_ * l64r;
#pragma unroll 1
            for (int sgi = 0; sgi < seg; ++sgi) { const f32x2 ev = S5E[((size_t)it * S5_NSEG + sgi) * 64 + p];
                hst = (f32x2){lLr * hst[0] - lLi * hst[1] + ev[0], lLr * hst[1] + lLi * hst[0] + ev[1]}; }
        }
        const f32x2 lbr2 = (f32x2){lbr, lbr}, lbi2 = (f32x2){lbi, lbi};
        const int sbeg = seg * S5_SEGLEN, send = sbeg + S5_SEGLEN;
        v4u un = (v4u){0u, 0u, 0u, 0u}, un2 = un, un3 = un, uc;
#define S5_LOADU(dst_, s0_) do { if (kg < 2) { const int row_ = seq_row(b, d, (s0_) + fr); dst_ = *(const v4u*)(Z + (size_t)row_ * IN_COLS + S5_OFF + g * 16 + kg * 8); } } while (0)
        S5_LOADU(un, sbeg); S5_LOADU(un2, sbeg + 16); S5_LOADU(un3, sbeg + 32);
#pragma unroll 1
        for (int s0 = sbeg; s0 < send; s0 += 16) {
            uc = un; un = un2; un2 = un3;
            if (s0 + 48 < send) S5_LOADU(un3, s0 + 48);
            const bf16x8 ufr = __builtin_bit_cast(bf16x8, uc);
#pragma unroll
            for (int c = 0; c < 2; ++c)
#pragma unroll
                for (int tl = 0; tl < 4; ++tl) { const f32x4 dd = __builtin_amdgcn_mfma_f32_16x16x32_bf16(afr[c][tl], ufr, (f32x4){0.f, 0.f, 0.f, 0.f}, 0, 0, 0);
                    *(LAS f32x4*)(buL + (c * 16 + fr) * 68 + 16 * tl + 4 * kg) = dd; }
            LDS_WAIT(); asm volatile("" ::: "memory");
            f32x2 bu[16];
#pragma unroll
            for (int s = 0; s < 16; ++s) bu[s] = (f32x2){buL[s * 68 + p], buL[(16 + s) * 68 + p]};
#pragma unroll
            for (int s = 0; s < 16; ++s) {
                const f32x2 sw = (f32x2){-hst[1], hst[0]};
                hst = lbr2 * hst + (lbi2 * sw + bu[s]);
                if (PASS == 1) *(LAS unsigned*)(Hs + s * 136 + 2 * p) = pg8::cvt_pk_bf16(hst[0], hst[1]);
            }
            if (PASS == 1) {
                LDS_WAIT(); asm volatile("" ::: "memory");
                f32x4 acc = (f32x4){0.f, 0.f, 0.f, 0.f};
#pragma unroll
                for (int kk = 0; kk < 4; ++kk) { const bf16x8 af = *(const LAS bf16x8*)(Hs + fr * 136 + 32 * kk + 8 * kg); acc = __builtin_amdgcn_mfma_f32_16x16x32_bf16(af, cf[kk], acc, 0, 0, 0); }
#pragma unroll
                for (int r = 0; r < 4; ++r) { const int row = seq_row(b, d, s0 + 4 * kg + r); YP[((size_t)d * T_ALL + row) * 512 + g * 16 + fr] = acc[r]; }
            }
            LDS_WAIT(); asm volatile("" ::: "memory");
        }
        if (PASS == 0) S5E[((size_t)it * S5_NSEG + seg) * 64 + p] = hst;
#undef S5_LOADU
    }
}

__device__ __forceinline__ void stage_s5_prep(const Ctx& F, int l, int nrows) {
    const auto& a = *F.a; unsigned char* ws = a.ws;
    const bf16* __restrict__ Z = (const bf16*)(ws + WS_Z); const float* __restrict__ YP = (const float*)(ws + WS_YP); bf16* __restrict__ AS5 = (bf16*)(ws + WS_AS5);
    const int c = 4 * (F.tid & 127), rq = F.tid >> 7;
    const f32x4 dsk = *(const f32x4*)(a.in[I_S5D] + l * 512 + c);
#pragma unroll 4
    for (int row = F.bid * 4 + rq; row < nrows; row += F.G * 4) {
        const v2u uz = *(const v2u*)(Z + (size_t)row * IN_COLS + S5_OFF + c);
        const f32x4 y0 = *(const f32x4*)(YP + (size_t)row * 512 + c), y1 = *(const f32x4*)(YP + ((size_t)T_ALL + row) * 512 + c);
        const f32x4 u = (f32x4){bflo(uz.x), bfhi(uz.x), bflo(uz.y), bfhi(uz.y)};
        const f32x4 y = y0 + y1 + u * dsk;
        float ge[4];
#pragma unroll
        for (int j = 0; j < 4; ++j) ge[j] = 0.5f * y[j] * (1.f + tanh_fast(0.7978845608028654f * (y[j] + 0.044715f * y[j] * y[j] * y[j])));
        v2u o; o.x = pk2(ge[0], ge[1]); o.y = pk2(ge[2], ge[3]);
        *(v2u*)(AS5 + (size_t)row * 512 + c) = o;
    }
}

__device__ __forceinline__ void stage_hy_pre(const Ctx& F, int l, int nrows) {
    const auto& a = *F.a; unsigned char* ws = a.ws; const int lane = F.lane;
    const bf16* Z = (const bf16*)(ws + WS_Z); bf16* UT = (bf16*)(ws + WS_UT);
    LAS unsigned char* tl = F.lds + F.wave * 16384;
    const float* cw = a.in[I_HYCW] + (size_t)l * 3 * 1536; const float* cbp = a.in[I_HYCB] + l * 1536;
    const int gw = F.bid * NWAVES + F.wave, NGW = F.G * NWAVES;
    const int q = lane >> 3, k = lane & 7, ntile = (nrows / 64) * 24;
    v4u v[8], hv;
#define HYPRE_LOAD(tile_) do { const int rt_ = (tile_) / 24, ct_ = (tile_) % 24, row0_ = rt_ * 64; int base_, pos0_, n_; row_seq(row0_, base_, pos0_, n_); \
        const bf16* zt_ = Z + (size_t)row0_ * IN_COLS + HY_OFF + ct_ * 64 + 8 * k; hv = (v4u){0u, 0u, 0u, 0u}; \
        _Pragma("unroll") for (int i = 0; i < 8; ++i) v[i] = *(const v4u*)(zt_ + (size_t)(8 * i + q) * IN_COLS); \
        if (q == 0 && pos0_ > 0) hv = *(const v4u*)(zt_ - (size_t)IN_COLS); \
        if (q == 1 && pos0_ + 64 < n_) hv = *(const v4u*)(zt_ + (size_t)64 * IN_COLS); } while (0)
    if (gw < ntile) HYPRE_LOAD(gw);
#pragma unroll 1
    for (int tile = gw; tile < ntile; tile += NGW) {
        const int rt = tile / 24, ct = tile % 24, row0 = rt * 64, c0 = ct * 64;
        f32x4 wv[8];
#pragma unroll
        for (int i = 0; i < 8; ++i) { const int col = c0 + 8 * i + q; wv[i] = (f32x4){cw[col], cw[1536 + col], cw[2 * 1536 + col], cbp[col]}; }
#pragma unroll
        for (int i = 0; i < 8; ++i) { LAS unsigned* p = (LAS unsigned*)(tl + (1 + 8 * i + q) * 132 + 16 * k); p[0] = v[i].x; p[1] = v[i].y; p[2] = v[i].z; p[3] = v[i].w; }
        if (q < 2) { LAS unsigned* p = (LAS unsigned*)(tl + (q ? 65 : 0) * 132 + 16 * k); p[0] = hv.x; p[1] = hv.y; p[2] = hv.z; p[3] = hv.w; }
        if (tile + NGW < ntile) HYPRE_LOAD(tile + NGW);
        LDS_WAIT(); asm volatile("" ::: "memory");
#pragma unroll 2
        for (int i = 0; i < 8; ++i) {
            const int ch = 8 * i + q, col = c0 + ch;
            const LAS unsigned short* s = (const LAS unsigned short*)(tl + (8 * k) * 132 + ch * 2);
            float z[10];
#pragma unroll
            for (int t = 0; t < 10; ++t) z[t] = __builtin_bit_cast(float, (unsigned)s[t * 66] << 16);
            float o[8];
#pragma unroll
            for (int t = 0; t < 8; ++t) o[t] = wv[i][0] * z[t] + wv[i][1] * z[t + 1] + wv[i][2] * z[t + 2] + wv[i][3];
            v4u w; w.x = pk2(o[0], o[1]); w.y = pk2(o[2], o[3]); w.z = pk2(o[4], o[5]); w.w = pk2(o[6], o[7]);
            *(v4u*)(UT + (size_t)col * T_ALL + row0 + 8 * k) = w;
        }
        LDS_WAIT(); asm volatile("" ::: "memory");
    }
#undef HYPRE_LOAD
}
__device__ __forceinline__ void stage_hy_post(const Ctx& F, int l, int nrows) {
    const auto& a = *F.a; unsigned char* ws = a.ws; const int lane = F.lane;
    const bf16* YT = (const bf16*)(ws + WS_UT) + (size_t)1024 * T_ALL; bf16* YHY = (bf16*)(ws + WS_YHY);
    LAS unsigned char* tl = F.lds + F.wave * 16384;
    const int gw = F.bid * NWAVES + F.wave, NGW = F.G * NWAVES;
    const int q = lane >> 3, k = lane & 7, ntile = (nrows / 64) * 8;
    v4u v[8];
#define HYPOST_LOAD(tile_) do { const bf16* yp_ = YT + (size_t)(((tile_) & 7) * 64 + q) * T_ALL + ((tile_) >> 3) * 64 + 8 * k; \
        _Pragma("unroll") for (int i = 0; i < 8; ++i) v[i] = *(const v4u*)(yp_ + (size_t)(8 * i) * T_ALL); } while (0)
    if (gw < ntile) HYPOST_LOAD(gw);
#pragma unroll 1
    for (int tile = gw; tile < ntile; tile += NGW) {
        const int rt = tile >> 3, ct = tile & 7, row0 = rt * 64, c0 = ct * 64;
#pragma unroll
        for (int i = 0; i < 8; ++i) { LAS unsigned* p = (LAS unsigned*)(tl + (8 * i + q) * 132 + 16 * k); p[0] = v[i].x; p[1] = v[i].y; p[2] = v[i].z; p[3] = v[i].w; }
        if (tile + NGW < ntile) HYPOST_LOAD(tile + NGW);
        LDS_WAIT(); asm volatile("" ::: "memory");
#pragma unroll
        for (int i = 0; i < 8; ++i) { const int r = 8 * i + q;
            const LAS unsigned short* s = (const LAS unsigned short*)(tl + (8 * k) * 132 + r * 2);
            unsigned e[8];
#pragma unroll
            for (int j = 0; j < 8; ++j) e[j] = s[j * 66];
            v4u w; w.x = e[0] | (e[1] << 16); w.y = e[2] | (e[3] << 16); w.z = e[4] | (e[5] << 16); w.w = e[6] | (e[7] << 16);
            *(v4u*)(YHY + (size_t)(row0 + r) * 512 + c0 + 8 * k) = w; }
        LDS_WAIT(); asm volatile("" ::: "memory");
    }
#undef HYPOST_LOAD
}
typedef float f32x16 __attribute__((ext_vector_type(16)));
__device__ __forceinline__ void hyena_item(const Ctx& F, int l, int c, int isctx) {
    const auto& a = *F.a; unsigned char* ws = a.ws; const int tid = F.tid, lane = F.lane;
    const int n = isctx ? CTXL : SEQ, rowbase = isctx ? T_LAT : 0, RL = isctx ? HY_RLENC : HY_RLEN, off = n + 47;
    const bf16* UT = (const bf16*)(ws + WS_UT);
    const bf16* x1g = UT + (size_t)c * T_ALL + rowbase; const bf16* x2g = UT + (size_t)(512 + c) * T_ALL + rowbase; bf16* vg = (bf16*)UT + (size_t)(1024 + c) * T_ALL + rowbase;
    const bf16* Rg = (const bf16*)(ws + WS_GF + l * GF_STRIDE + (isctx ? GF_CTX : 0)) + (size_t)c * RL;
    LAS unsigned char* XB = F.lds; LAS unsigned char* R1 = F.lds + HY_R1_OFF; LAS unsigned char* R2 = F.lds + HY_R2_OFF;
    { const int cpb = n / 8;
      for (int q = tid; q < 8 * cpb; q += NTHREADS) { const int b = q / cpb, ch = q % cpb; *(LAS v4u*)(XB + b * HY_ROWB + 2 * HY_MARG + 16 * ch) = *(const v4u*)(vg + (size_t)b * n + 8 * ch); }
      if (tid < 256) { const int b = tid >> 5, side = (tid >> 4) & 1, ch = tid & 15; const unsigned zz = (unsigned)opaque_v(0); *(LAS v4u*)(XB + b * HY_ROWB + (side ? 2 * (HY_MARG + n) : 0) + 16 * ch) = (v4u){zz, zz, zz, zz}; }
      const int rch = RL / 8;
      for (int q = tid; q < rch; q += NTHREADS) { *(LAS v4u*)(R1 + 16 * q) = *(const v4u*)(Rg + 8 * q); *(LAS v4u*)(R2 + 16 * q) = *(const v4u*)(Rg + (size_t)512 * RL + 8 * q); } }
    __syncthreads();
    const int i = lane & 31, kg = lane >> 5, jb = lane & 3, bb = (lane & 31) >> 2;
    const int rsh = (off - i) & 7, rd = rsh >> 1; const bool s1 = rd & 1, s2 = rd & 2; const unsigned sh = (rsh & 1) ? 16u : 0u;
    const int aconst = 2 * (off - i + 8 * kg - rsh), bconst = bb * HY_ROWB + 2 * (HY_MARG + 32 * jb + 8 * kg);
    const int T0w = 512 * F.wave; const int ntile = (n - T0w) >= 512 ? 4 : ((n - T0w) > 0 ? (n - T0w) / 128 : 0);
    const float bias0 = a.in[I_HYBIAS][(l * 2 + 0) * 512 + c], bias1 = a.in[I_HYBIAS][(l * 2 + 1) * 512 + c];
    f32x16 acc[4];
    v2u y1p[4][4];
#define HY_AFRAG(wa, wb, afr) do { \
        const unsigned a0 = s1 ? wa.y : wa.x, a1 = s1 ? wa.z : wa.y, a2 = s1 ? wa.w : wa.z, a3 = s1 ? wb.x : wa.w, a4 = s1 ? wb.y : wb.x, a5 = s1 ? wb.z : wb.y, a6 = s1 ? wb.w : wb.z; \
        const unsigned b0 = s2 ? a2 : a0, b1 = s2 ? a3 : a1, b2 = s2 ? a4 : a2, b3 = s2 ? a5 : a3, b4 = s2 ? a6 : a4; \
        v4u af_; af_.x = __builtin_amdgcn_alignbit(b1, b0, sh); af_.y = __builtin_amdgcn_alignbit(b2, b1, sh); af_.z = __builtin_amdgcn_alignbit(b3, b2, sh); af_.w = __builtin_amdgcn_alignbit(b4, b3, sh); \
        afr = __builtin_bit_cast(bf16x8, af_); } while (0)
#define HY_STEP_COND(RB, d) do { \
        const v4u wa = *(const LAS v4u*)((RB) + aconst - 2 * (d)), wb = *(const LAS v4u*)((RB) + aconst - 2 * (d) + 16); bf16x8 afr; HY_AFRAG(wa, wb, afr); \
        _Pragma("unroll") for (int m = 0; m < 4; ++m) { const int T0 = T0w + 128 * m; \
            if (m < ntile && (d) >= T0 - n + 16 && (d) <= T0 + 96) { const bf16x8 bfr = *(const LAS bf16x8*)(XB + bconst + 2 * (T0 - (d))); \
                acc[m] = __builtin_amdgcn_mfma_f32_32x32x16_bf16(afr, bfr, acc[m], 0, 0, 0); } } } while (0)
#define HY_LOAD(RB, d, wa, wb, bq) do { wa = *(const LAS v4u*)((RB) + aconst - 2 * (d)); wb = *(const LAS v4u*)((RB) + aconst - 2 * (d) + 16); \
        _Pragma("unroll") for (int m = 0; m < 4; ++m) bq[m] = *(const LAS bf16x8*)(XB + bconst + 2 * (T0w + 128 * m - (d))); } while (0)
#define HY_MMA(wa, wb, bq) do { bf16x8 afr; HY_AFRAG(wa, wb, afr); \
        _Pragma("unroll") for (int m = 0; m < 4; ++m) acc[m] = __builtin_amdgcn_mfma_f32_32x32x16_bf16(afr, bq[m], acc[m], 0, 0, 0); } while (0)
#define HY_CONV(RB) do { \
        _Pragma("unroll") for (int m = 0; m < 4; ++m) _Pragma("unroll") for (int e = 0; e < 16; ++e) acc[m][e] = 0.f; \
        if (ntile == 4) { \
            const int dA = T0w - n + 16, dB = T0w + 384 - n + 16, dC = T0w + 96, dD = T0w + 384 + 96;     \
            _Pragma("unroll 1") for (int d = dA; d < dB; d += 16) HY_STEP_COND(RB, d); \
            { v4u waA, wbA, waB, wbB; bf16x8 bqA[4], bqB[4]; \
              HY_LOAD(RB, dB, waA, wbA, bqA); \
              _Pragma("unroll 1") for (int d = dB; d <= dC; d += 32) { \
                  if (d + 16 <= dC) HY_LOAD(RB, d + 16, waB, wbB, bqB); \
                  __builtin_amdgcn_sched_barrier(0); \
                  HY_MMA(waA, wbA, bqA); \
                  __builtin_amdgcn_sched_barrier(0); \
                  if (d + 32 <= dC) HY_LOAD(RB, d + 32, waA, wbA, bqA); \
                  __builtin_amdgcn_sched_barrier(0); \
                  if (d + 16 <= dC) HY_MMA(waB, wbB, bqB); \
                  __builtin_amdgcn_sched_barrier(0); } } \
            _Pragma("unroll 1") for (int d = dC + 16; d <= dD; d += 16) HY_STEP_COND(RB, d); \
        } else if (ntile > 0) { const int dhi = T0w + 128 * (ntile - 1) + 96; \
            _Pragma("unroll 1") for (int d = T0w - n + 16; d <= dhi; d += 16) HY_STEP_COND(RB, d); } } while (0)
    HY_CONV(R1);
#pragma unroll
    for (int m = 0; m < 4; ++m) if (m < ntile) {
#pragma unroll
        for (int rg = 0; rg < 4; ++rg) { const int t4 = T0w + 128 * m + 32 * jb + 8 * rg + 4 * kg;
            const v2u xv = *(const v2u*)(x1g + (size_t)bb * n + t4); const v2u vv = *(const LAS v2u*)(XB + bb * HY_ROWB + 2 * (HY_MARG + t4));
            const float y0 = bflo(xv.x) * (acc[m][4 * rg + 0] + bias0 * bflo(vv.x)), y1 = bfhi(xv.x) * (acc[m][4 * rg + 1] + bias0 * bfhi(vv.x));
            const float y2 = bflo(xv.y) * (acc[m][4 * rg + 2] + bias0 * bflo(vv.y)), y3 = bfhi(xv.y) * (acc[m][4 * rg + 3] + bias0 * bfhi(vv.y));
            y1p[m][rg].x = pk2(y0, y1); y1p[m][rg].y = pk2(y2, y3); } }
    __syncthreads();
#pragma unroll
    for (int m = 0; m < 4; ++m) if (m < ntile) {
#pragma unroll
        for (int rg = 0; rg < 4; ++rg) { const int t4 = T0w + 128 * m + 32 * jb + 8 * rg + 4 * kg; *(LAS v2u*)(XB + bb * HY_ROWB + 2 * (HY_MARG + t4)) = y1p[m][rg]; } }
    __syncthreads();
    HY_CONV(R2);
#pragma unroll
    for (int m = 0; m < 4; ++m) if (m < ntile) {
#pragma unroll
        for (int rg = 0; rg < 4; ++rg) { const int t4 = T0w + 128 * m + 32 * jb + 8 * rg + 4 * kg;
            const v2u xv = *(const v2u*)(x2g + (size_t)bb * n + t4); const v2u yv = y1p[m][rg];
            const float o0 = bflo(xv.x) * (acc[m][4 * rg + 0] + bias1 * bflo(yv.x)), o1 = bfhi(xv.x) * (acc[m][4 * rg + 1] + bias1 * bfhi(yv.x));
            const float o2 = bflo(xv.y) * (acc[m][4 * rg + 2] + bias1 * bflo(yv.y)), o3 = bfhi(xv.y) * (acc[m][4 * rg + 3] + bias1 * bfhi(yv.y));
            v2u ov; ov.x = pk2(o0, o1); ov.y = pk2(o2, o3); *(v2u*)(vg + (size_t)bb * n + t4) = ov; } }
    __syncthreads();
#undef HY_CONV
#undef HY_AFRAG
#undef HY_STEP_COND
#undef HY_LOAD
#undef HY_MMA
}
__device__ __forceinline__ void stage_mixer(const Ctx& F, int l) {
    unsigned* ctr = (unsigned*)(F.a->ws + WS_CTL) + CW_WORK + 64 * l;
    LAS int* itb = (LAS int*)(F.lds + LDSCTL_OFF + 512);
    const int nit = 128 + 512 + (l == 0 ? 512 : 0);
#ifdef PROBE_STATIC
    return;
#endif
    for (;;) {
        if (F.tid == 0) *itb = (int)__hip_atomic_fetch_add(ctr, 1u, __ATOMIC_RELAXED, __HIP_MEMORY_SCOPE_AGENT);
        __syncthreads();
        const int it = *itb;
        __syncthreads();
        if (it >= nit) break;
        Ctx Fi; Fi.a = kargs(); Fi.tid = opaque_v((int)threadIdx.x); Fi.lane = Fi.tid & 63; Fi.wave = __builtin_amdgcn_readfirstlane(Fi.tid >> 6); Fi.bid = opaque((int)blockIdx.x); Fi.G = opaque((int)gridDim.x);
        Fi.lds = (LAS unsigned char*)((LAS unsigned char*)0 + opaque(0)) + (F.lds - (LAS unsigned char*)0);
#ifdef PROBE_T
        if (l == 0 && F.tid == 0 && it == 5) ((unsigned long long*)(F.a->ws + WS_CTL + CW_STAMP * 4))[21] = __builtin_amdgcn_s_memrealtime();
        if (l == 0 && F.tid == 0 && it == 300) ((unsigned long long*)(F.a->ws + WS_CTL + CW_STAMP * 4))[23] = __builtin_amdgcn_s_memrealtime();
#endif
        if (it < 128) { for (int rep = 0; rep < ((DUPK == 9) ? 2 : 1); ++rep) rw_chunk_item2(Fi, opaque(l), it); }
        else if (it < 640) hyena_item(Fi, opaque(l), it - 128, 0);
        else hyena_item(Fi, opaque(l), it - 640, 1);
#ifdef PROBE_T
        if (l == 0 && F.tid == 0 && it == 5) ((unsigned long long*)(F.a->ws + WS_CTL + CW_STAMP * 4))[22] = __builtin_amdgcn_s_memrealtime();
        if (l == 0 && F.tid == 0 && it == 300) ((unsigned long long*)(F.a->ws + WS_CTL + CW_STAMP * 4))[24] = __builtin_amdgcn_s_memrealtime();
#endif
    }
}

typedef float f32x16r __attribute__((ext_vector_type(16)));
__device__ __forceinline__ void stage_norm2_router(const Ctx& F, int l, int nrows) {
    const auto& a = *F.a; unsigned char* ws = a.ws; const int lane = F.lane;
    const float* X = (const float*)(ws + WS_X); bf16* H = (bf16*)(ws + WS_H); const float* MOD = (const float*)(ws + WS_MOD);
    int* EIDX = (int*)(ws + WS_EIDX); float* GATE = (float*)(ws + WS_GATE); int* BLKCNT = (int*)(ws + WS_BLKCNT);
    LAS float* lg = (LAS float*)(F.lds + F.wave * 4352);
    LAS int* hist = (LAS int*)(F.lds + LDSCTL_OFF + 1024);
    if (F.tid < 32) hist[F.tid] = 0;
    __syncthreads();
    const int rpb = (nrows + F.G - 1) / F.G, r0 = F.bid * rpb, r1 = (r0 + rpb < nrows) ? r0 + rpb : nrows;
    const float* rw = a.in[I_RTW] + (size_t)l * 1024 * 32;
    const int i = lane & 31, kk = lane >> 5;
    const f32x4* ng = (const f32x4*)(a.in[I_N2G] + l * D) + kk;
    for (int rb = r0 + F.wave * 32; rb < r1; rb += NWAVES * 32) {
        const int nrow = (r1 - rb) < 32 ? (r1 - rb) : 32; const bool live = i < nrow;
        const int row = live ? rb + i : r1 - 1; const int w = row < T_LAT ? (row >> 12) : 8;
        const f32x4* xr = (const f32x4*)(X + (size_t)row * D) + kk;
        float ss = 0.f;
#pragma unroll 16
        for (int q = 0; q < 128; ++q) { const f32x4 v = xr[2 * q]; ss += (v[0] * v[0] + v[1] * v[1]) + (v[2] * v[2] + v[3] * v[3]); }
        ss += __builtin_bit_cast(float, __builtin_amdgcn_ds_bpermute((lane ^ 32) << 2, __builtin_bit_cast(int, ss)));
        const float rstd = __builtin_amdgcn_rsqf(ss * (1.f / D) + 1e-6f);
        const f32x4* sh = (const f32x4*)(MOD + (size_t)(l * 9 + w) * 6144 + 3072) + kk; const f32x4* sc = (const f32x4*)(MOD + (size_t)(l * 9 + w) * 6144 + 4096) + kk;
        v2u* ho = (v2u*)(H + (size_t)row * D) + kk;
        f32x16r acc;
#pragma unroll
        for (int e = 0; e < 16; ++e) acc[e] = 0.f;
        const float* wp = rw + (size_t)(4 * kk) * 32 + i;
        f32x4 xn[4], gn_[4], cn_[4], sn_[4], wn_[4];
#define RT_LOAD(q0_) do { _Pragma("unroll") for (int u_ = 0; u_ < 4; ++u_) { const int q_ = (q0_) + u_; xn[u_] = xr[2 * q_]; gn_[u_] = ng[2 * q_]; cn_[u_] = sc[2 * q_]; sn_[u_] = sh[2 * q_]; \
            wn_[u_] = (f32x4){wp[(size_t)(8 * q_) * 32], wp[(size_t)(8 * q_ + 1) * 32], wp[(size_t)(8 * q_ + 2) * 32], wp[(size_t)(8 * q_ + 3) * 32]}; } } while (0)
        RT_LOAD(0);
#pragma unroll 1
        for (int q0 = 0; q0 < 128; q0 += 4) {
            f32x4 xc[4], gc_[4], cc_[4], sc_[4], wc_[4];
#pragma unroll
            for (int u = 0; u < 4; ++u) { xc[u] = xn[u]; gc_[u] = gn_[u]; cc_[u] = cn_[u]; sc_[u] = sn_[u]; wc_[u] = wn_[u]; }
            if (q0 + 4 < 128) RT_LOAD(q0 + 4);
#pragma unroll
            for (int u = 0; u < 4; ++u) { const int q = q0 + u;
                const f32x4 h4 = xc[u] * rstd * gc_[u] * (cc_[u] + 1.0f) + sc_[u];
                if (live) { v2u o; o.x = pk2(h4[0], h4[1]); o.y = pk2(h4[2], h4[3]); ho[2 * q] = o; }
                acc = __builtin_amdgcn_mfma_f32_32x32x2f32(h4[0], wc_[u][0], acc, 0, 0, 0);
                acc = __builtin_amdgcn_mfma_f32_32x32x2f32(h4[1], wc_[u][1], acc, 0, 0, 0);
                acc = __builtin_amdgcn_mfma_f32_32x32x2f32(h4[2], wc_[u][2], acc, 0, 0, 0);
                acc = __builtin_amdgcn_mfma_f32_32x32x2f32(h4[3], wc_[u][3], acc, 0, 0, 0); }
        }
#undef RT_LOAD
        const float rbias = a.in[I_RTB][l * 32 + i];
#pragma unroll
        for (int r = 0; r < 16; ++r) { const int ri = (r & 3) + 8 * (r >> 2) + 4 * kk; lg[ri * 33 + i] = acc[r] + rbias; }
        LDS_WAIT(); asm volatile("" ::: "memory");
        if (lane < nrow) {
            LAS float* lr = lg + lane * 33; const int orow = rb + lane;
            float tv[4]; int ti[4];
#pragma unroll
            for (int r = 0; r < 4; ++r) { float bv = -INFINITY; int bi = 0;
#pragma unroll 8
                for (int e = 0; e < 32; ++e) { const float v = lr[e]; if (v > bv) { bv = v; bi = e; } }
                tv[r] = bv; ti[r] = bi; lr[bi] = -INFINITY; }
            const float e1 = expf(tv[1] - tv[0]), e2 = expf(tv[2] - tv[0]), e3 = expf(tv[3] - tv[0]); const float inv = 1.0f / (1.0f + e1 + e2 + e3);
            *(int4*)(EIDX + orow * 4) = make_int4(ti[0], ti[1], ti[2], ti[3]); *(f32x4*)(GATE + orow * 4) = (f32x4){inv, e1 * inv, e2 * inv, e3 * inv};
#pragma unroll
            for (int r = 0; r < 4; ++r) __hip_atomic_fetch_add(&hist[ti[r]], 1, __ATOMIC_RELAXED, __HIP_MEMORY_SCOPE_WORKGROUP);
        }
        LDS_WAIT(); asm volatile("" ::: "memory");
    }
    __syncthreads();
    if (F.tid < 32) BLKCNT[F.bid * 32 + F.tid] = hist[F.tid];
    __syncthreads();
}

__device__ __forceinline__ void stage_moe_scatter(const Ctx& F, int l, int nrows) {
    const auto& a = *F.a; unsigned char* ws = a.ws; const int lane = F.lane;
    const bf16* H = (const bf16*)(ws + WS_H); bf16* XS = (bf16*)(ws + WS_XS);
    const int* EIDX = (const int*)(ws + WS_EIDX); int* POS = (int*)(ws + WS_POS); const int* BLKCNT = (const int*)(ws + WS_BLKCNT); int* META = (int*)(ws + WS_META);
    LAS int* tot = (LAS int*)F.lds; LAS int* off = tot + 32; LAS int* base = tot + 64; LAS int* posl = tot + 128; LAS int* eloc = tot + 4096;
    const int rpb = (nrows + F.G - 1) / F.G, r0 = F.bid * rpb, r1 = (r0 + rpb < nrows) ? r0 + rpb : nrows; const int na = (r1 > r0) ? (r1 - r0) * 4 : 0;
    for (int i = F.tid; i < na; i += NTHREADS) eloc[i] = EIDX[r0 * 4 + i];
    { LAS int* part = tot + 8192; const int e = F.tid & 31, pt = F.tid >> 5; int t = 0, o = 0;
      for (int b2 = pt; b2 < F.G; b2 += 16) { const int c = BLKCNT[b2 * 32 + e]; t += c; o += (b2 < F.bid) ? c : 0; }
      part[pt * 32 + e] = t; part[512 + pt * 32 + e] = o; }
    __syncthreads();
    if (F.tid < 32) { LAS int* part = tot + 8192; int t = 0, o = 0;
#pragma unroll
        for (int pt = 0; pt < 16; ++pt) { t += part[pt * 32 + F.tid]; o += part[512 + pt * 32 + F.tid]; }
        tot[F.tid] = t; off[F.tid] = o; }
    __syncthreads();
    if (F.tid == 0) { int acc = 0; for (int e = 0; e < 32; ++e) { base[e] = acc; acc += (tot[e] + 255) & ~255; } base[32] = acc; }
    __syncthreads();
    if (F.bid == 0 && F.tid < 33) META[F.tid] = base[F.tid];
    unsigned* ROWOF = (unsigned*)(ws + WS_ROWOF);
    if (F.tid < 32) { int run = base[F.tid] + off[F.tid]; for (int i = 0; i < na; ++i) { if (eloc[i] == F.tid) { POS[r0 * 4 + i] = run; ROWOF[run] = (unsigned)(r0 + (i >> 2)) * (unsigned)(D * 2); ++run; } } }
    for (int e = F.bid; e < 32; e += F.G) for (int i = base[e] + tot[e] + F.tid; i < base[e + 1]; i += NTHREADS) ROWOF[i] = 0u;
    __syncthreads();
}
__device__ __forceinline__ LAS int* load_moe_base(const Ctx& F) {
    LAS int* base = (LAS int*)(F.lds + LDSCTL_OFF + 256);
    const int* META = (const int*)(F.a->ws + WS_META);
    if (F.tid < 33) base[F.tid] = META[F.tid];
    __syncthreads();
    return base;
}

constexpr int NSTAGE_L = 13, NSTAGES = 1 + DEPTH * NSTAGE_L + 1;
__global__ void __launch_bounds__(NTHREADS, 2) mk_fwd(Args args) {
    extern __shared__ __attribute__((aligned(16))) unsigned char lds_raw[];
    Ctx F; F.a = kargs(); F.lds = (LAS unsigned char*)lds_raw; F.tid = threadIdx.x; F.lane = F.tid & 63; F.wave = __builtin_amdgcn_readfirstlane(F.tid >> 6); F.bid = blockIdx.x; F.G = gridDim.x;
    volatile LAS unsigned* MISC = (volatile LAS unsigned*)(F.lds + LDSCTL_OFF);
    for (int u = F.tid; u < (LDS_BYTES - LDSCTL_OFF) / 4; u += NTHREADS) ((LAS unsigned*)(F.lds + LDSCTL_OFF))[u] = 0u;
    __syncthreads();
#if MK_PER_STAGE
#define GRID_BAR() do { } while (0)
#else
    (void)xcd_barrier_post((unsigned*)(F.a->ws + WS_CTL) + CW_BAR, MISC + 8);
#define GRID_BAR() do { XcdBarrier b_; b_.bar = (unsigned*)(kargs()->ws + WS_CTL) + CW_BAR; b_.x = xb_xcc_id(); b_.st = (volatile LAS unsigned*)((LAS unsigned char*)lds_raw + LDSCTL_OFF + opaque(32)); xcd_barrier(b_); } while (0)
#endif
#ifndef ONLY_S
#define ONLY_S -1
#endif
#define STG_SEL(k) (ONLY_S < 0 || ONLY_S == (((k) == 0) ? 0 : ((k) == NSTAGES - 1 ? 14 : (((k) - 1) % NSTAGE_L) + 1)))
#if MK_PER_STAGE
#define IN(k) (STG_SEL(k) && kargs()->ph_lo == (k))
#else
#define IN(k) STG_SEL(k)
#endif
#if MK_PER_STAGE
#define SEAM(k) do { } while (0)
#else
#define SEAM(k) do { if ((k) + 1 < NSTAGES) GRID_BAR(); } while (0)
#endif
#define STAGE(k) if (IN(k)) { F.a = kargs(); F.tid = opaque_v((int)threadIdx.x); F.lane = F.tid & 63; F.wave = __builtin_amdgcn_readfirstlane(F.tid >> 6); F.bid = opaque((int)blockIdx.x); F.G = opaque((int)gridDim.x); F.lds = (LAS unsigned char*)lds_raw + opaque(0); unsigned char* ws = F.a->ws; const int l = opaque(lq); unsigned char* wl = ws + WS_WTS + (size_t)l * WL_STRIDE; (void)wl; (void)ws;
#define STAGE_END(k) } SEAM(k);
    int lq = 0;
    STAGE(0) p0_prologue(F); STAGE_END(0)
    for (lq = 0; lq < DEPTH; ++lq) {
        const int sb = 1 + lq * NSTAGE_L;
        const int nrl = opaque((lq == DEPTH - 1) ? T_LAT : T_ALL);
        STAGE(sb + 0) stage_norm1(F, l); STAGE_END(sb + 0)
        STAGE(sb + 1) pg8::SchedWin S; S.A = (const char*)(ws + WS_H); S.Bt = (const char*)(wl + WO_WIN); S.tstep = (size_t)256 * 1024 * 2; S.G = F.G; S.c = F.bid; S.part = (nrl != T_ALL); pg8::EpiBf16 E{(bf16*)(ws + WS_Z), IN_COLS, nullptr, 0};
            pg8::gemm_phase(F.lds, F.tid, 1024, S, E); STAGE_END(sb + 1)
        STAGE(sb + 2) for (int rep = 0; rep < REPN(1); ++rep) stage_rw_prep1(F, l); for (int rep = 0; rep < REPN(2); ++rep) stage_s5_scan<0>(F, l); for (int rep = 0; rep < REPN(3); ++rep) stage_hy_pre(F, l, nrl); STAGE_END(sb + 2)
        STAGE(sb + 3) { pg8::SchedStatic S; S.init(ws + WS_ARW, wl + WO_RWCAT, T_ALL, 2560, 256, F.G, F.bid); pg8::EpiBf16 E{(bf16*)(ws + WS_P), 2560, nullptr, 0}; PT(4); pg8::gemm_phase(F.lds, F.tid, 256, S, E); PT(5); }
            F.tid = opaque_v((int)threadIdx.x); F.lane = F.tid & 63;
            for (int rep = 0; rep < REPN(4); ++rep) stage_s5_scan<1>(F, l); STAGE_END(sb + 3)
        STAGE(sb + 4) for (int rep = 0; rep < REPN(5); ++rep) stage_rw_prep2(F, l); for (int rep = 0; rep < REPN(6); ++rep) stage_s5_prep(F, l, nrl); STAGE_END(sb + 4)
        STAGE(sb + 5) PT(10); stage_mixer(F, l); PT(11); STAGE_END(sb + 5) STAGE(sb + 5) PT(12); }
        STAGE(sb + 6) { pg8::SchedStatic S; S.init(ws + WS_AS5, wl + WO_GLU, nrl, 1024, 512, F.G, F.bid); pg8::EpiGlu<0> E{(bf16*)(ws + WS_YS5), 512, F.a->in[I_S5GLUB] + l * 1024, 0, 512}; PT(13); pg8::gemm_phase(F.lds, F.tid, 512, S, E); PT(14); }
            for (int rep = 0; rep < REPN(7); ++rep) stage_rw_readout(F, l); for (int rep = 0; rep < REPN(8); ++rep) stage_hy_post(F, l, nrl); STAGE_END(sb + 6)
        STAGE(sb + 7) pg8::SchedMerge S; S.A0 = (const char*)(ws + WS_YHY); S.A1 = (const char*)(ws + WS_YRW); S.A2 = (const char*)(ws + WS_YS5); S.Bt = (const char*)(wl + WO_WBR); S.tstep = (size_t)256 * 512 * 2; S.bstride = (size_t)1024 * 512 * 2;
            S.nM = nrl / 256; S.nN = 4; S.G = F.G; S.c = F.bid;
            pg8::EpiMerge E{(bf16*)(ws + WS_MTMP), (bf16*)(ws + WS_H), (const bf16*)(ws + WS_Z) + GATE_OFF}; pg8::gemm_phase(F.lds, F.tid, 512, S, E); STAGE_END(sb + 7)
        STAGE(sb + 8) pg8::SchedStatic S; S.init(ws + WS_H, wl + WO_WOUT, nrl, 1024, 1024, F.G, F.bid); pg8::EpiResid E{(float*)(ws + WS_X), (const float*)(ws + WS_MOD) + (size_t)l * 9 * 6144 + 2048};
            pg8::gemm_phase(F.lds, F.tid, 1024, S, E); STAGE_END(sb + 8)
        STAGE(sb + 9) PT(17); stage_norm2_router(F, l, nrl); PT(18); STAGE_END(sb + 9)
        STAGE(sb + 10) PT(19); stage_moe_scatter(F, l, nrl); PT(20); STAGE_END(sb + 10)
        STAGE(sb + 11) LAS int* base = load_moe_base(F);
            pg8::SchedMoeG S; S.A = (const char*)(ws + WS_H); S.rowof = (const unsigned*)(ws + WS_ROWOF); S.Bt = (const char*)(wl + WO_W1); S.tstep = (size_t)256 * 1024 * 2; S.estride = (size_t)2048 * 1024 * 2; S.NPN = 8; S.G = F.G; S.c = F.bid; S.base = base;
            pg8::EpiGlu<1> E{(bf16*)(ws + WS_ACT), 1024, F.a->in[I_B1] + (size_t)l * 32 * 2048, 2048, 1024}; pg8::gemm_phase(F.lds, F.tid, 1024, S, E); STAGE_END(sb + 11)
        STAGE(sb + 12) LAS int* base = load_moe_base(F);
            pg8::SchedMoe S; S.A = (const char*)(ws + WS_ACT); S.Bt = (const char*)(wl + WO_W2); S.tstep = (size_t)256 * 1024 * 2; S.estride = (size_t)1024 * 1024 * 2; S.NPN = 4; S.G = F.G; S.c = F.bid; S.base = base;
            pg8::EpiBf16 E{(bf16*)(ws + WS_XS), 1024, F.a->in[I_B2] + (size_t)l * 32 * 1024, 1024}; pg8::gemm_phase(F.lds, F.tid, 1024, S, E); STAGE_END(sb + 12)
    }
    lq = DEPTH;
    STAGE(NSTAGES - 1)
#ifndef PROBE_T
        stage_norm1(F, l);
#endif
#ifdef PROBE_T
        { const unsigned long long* st = (const unsigned long long*)(F.a->ws + WS_CTL + CW_STAMP * 4); const float cval = (float)(long long)(st[PROBE_B] - st[PROBE_A]) * (1.0f / (100.0f * PROBE_DIV));
          __syncthreads(); for (size_t i = (size_t)F.bid * NTHREADS + F.tid; i < (size_t)T_LAT * D; i += (size_t)F.G * NTHREADS) F.a->out[i] = cval; }
#endif
    }
#undef IN
#undef SEAM
}

extern "C" void kernel_launch(void* const* d_in, const int* in_sizes, int n_in, void* d_out, int out_size, void* d_ws, size_t ws_size, hipStream_t stream) {
    static int grid = 0;
    if (grid == 0) {
        if (n_in != 51 || out_size != T_LAT * D || ws_size < WS_END) { fprintf(stderr, "kernel_launch: unexpected shapes (n_in %d out %d ws %zu, need %zu)\n", n_in, out_size, ws_size, (size_t)WS_END); grid = -1; return; }
        int dev = 0, cus = 0, per_cu = 0;
        if (hipGetDevice(&dev) != hipSuccess || hipDeviceGetAttribute(&cus, hipDeviceAttributeMultiprocessorCount, dev) != hipSuccess) { grid = -1; return; }
        if (hipFuncSetAttribute((const void*)mk_fwd, hipFuncAttributeMaxDynamicSharedMemorySize, LDS_BYTES) != hipSuccess) { fprintf(stderr, "kernel_launch: hipFuncSetAttribute failed\n"); grid = -1; return; }
        if (hipOccupancyMaxActiveBlocksPerMultiprocessor(&per_cu, (const void*)mk_fwd, NTHREADS, LDS_BYTES) != hipSuccess || per_cu < 1) fprintf(stderr, "kernel_launch: occupancy query says %d\n", per_cu);
        (void)hipGetLastError();
        grid = cus;
    }
    if (grid < 0) return;
    if (hipMemsetAsync((char*)d_ws + WS_CTL, 0, CTL_ZERO_BYTES, stream) != hipSuccess) return;
    Args a{};
    for (int i = 0; i < 51; ++i) a.in[i] = (const float*)d_in[i];
    a.out = (float*)d_out; a.ws = (unsigned char*)d_ws;
#if MK_PER_STAGE
    for (int s = 0; s < NSTAGES; ++s) { a.ph_lo = s; a.ph_hi = s + 1; int reps = 1;
#ifdef PROBE_SET
        { const int ls = (s == 0 || s == NSTAGES - 1) ? -1 : (s - 1) % NSTAGE_L;
          if (PROBE_SET >= 1 && PROBE_SET <= 13 && ls == PROBE_SET - 1 && ls != 5 && ls != 8 && !(ls == 0 && s > 1)) reps = 3;
          if (PROBE_SET == 14 && s == 0) reps = 3; }
#endif
        for (int r = 0; r < reps; ++r) hipLaunchKernelGGL(mk_fwd, dim3(grid), dim3(NTHREADS), LDS_BYTES, stream, a); }
#else
    a.ph_lo = 0; a.ph_hi = NSTAGES; hipLaunchKernelGGL(mk_fwd, dim3(grid), dim3(NTHREADS), LDS_BYTES, stream, a);
#endif
}
```

```cpp
#include <hip/hip_runtime.h>
#include <cstdio>
#include <cstdint>

#ifndef DUPK
#define DUPK 0
#endif
#define REPN(k) ((DUPK == (k)) ? 3 : 1)
#ifndef REP_GEMM
#define REP_GEMM 1
#endif
#ifndef REP_LIGHT
#define REP_LIGHT 1
#endif
#ifndef REP_PRO
#define REP_PRO 1
#endif
#ifndef MK_PER_STAGE
#define MK_PER_STAGE 0
#endif

#define GAS __attribute__((address_space(1)))
#define LAS __attribute__((address_space(3)))
typedef unsigned short bf16;
typedef unsigned v4u __attribute__((ext_vector_type(4)));
typedef unsigned v2u __attribute__((ext_vector_type(2)));
typedef float f32x4 __attribute__((ext_vector_type(4)));
typedef float f32x2 __attribute__((ext_vector_type(2)));
typedef short bf16x8 __attribute__((ext_vector_type(8)));

constexpr int D = 1024, BATCH = 8, SEQ = 4096, CTXL = 256, DEPTH = 2;
constexpr int T_LAT = BATCH * SEQ, T_CTX = BATCH * CTXL, T_ALL = T_LAT + T_CTX;
constexpr int IN_COLS = 6912, HY_OFF = 0, RW_OFF = 1536, S5_OFF = 3328, GATE_OFF = 3840;
constexpr int NE = 32, TOPK = 4;
constexpr int MAXSLOT = 147456;
constexpr int NWAVES = 8, NTHREADS = 512;
constexpr int HY_MARG = 128, HY_ROWB = 8720, HY_RLEN = 8272, HY_RLENC = 592;
constexpr int HY_R1_OFF = 8 * HY_ROWB, HY_R2_OFF = HY_R1_OFF + HY_RLEN * 2;

constexpr size_t MiB = 1ull << 20;
constexpr size_t WS_CTL = 0, CTL_ZERO_BYTES = 1 * MiB;
constexpr size_t WS_MOD = 1 * MiB;
constexpr size_t WS_BLKCNT = 2 * MiB;
constexpr size_t WS_META = 2 * MiB + 512 * 1024;
constexpr size_t WS_ROWOF = 480 * MiB;
constexpr int CW_CNT = 24576;
constexpr size_t WS_EIDX = 3 * MiB, WS_GATE = 4 * MiB, WS_POS = 5 * MiB;
constexpr size_t WS_WTS = 8 * MiB, WL_STRIDE = 214 * MiB;
constexpr size_t WO_WIN = 0, WO_RWCAT = 14 * MiB, WO_GLU = 16 * MiB, WO_WBR = 17 * MiB, WO_WOUT = 20 * MiB, WO_W1 = 22 * MiB, WO_W2 = 150 * MiB;
constexpr size_t WS_GF = 436 * MiB, GF_STRIDE = 20 * MiB, GF_CTX = 17 * MiB;
constexpr size_t WS_X = 504 * MiB;
constexpr size_t WS_H = 640 * MiB;
constexpr size_t WS_BIG = 708 * MiB;
constexpr size_t WS_Z = WS_BIG;
constexpr size_t WS_SCN = 1167 * MiB;
constexpr size_t WS_MTMP = WS_SCN;
constexpr size_t WS_P = 1473 * MiB;
constexpr size_t WS_ARW = 1643 * MiB;
constexpr size_t WS_YP = 1660 * MiB;
constexpr size_t WS_YDIR = WS_YP;
constexpr size_t WS_UT = 1796 * MiB;
constexpr size_t WS_AS5 = 2000 * MiB;
constexpr size_t WS_YHY = 1898 * MiB, WS_YRW = 1932 * MiB, WS_YS5 = 1966 * MiB;
constexpr size_t WS_XS = WS_BIG;
constexpr size_t WS_ACT = WS_BIG + 288 * MiB;
constexpr size_t WS_END = 2034 * MiB;
constexpr int CW_BAR = 4096;

constexpr int RING_BYTES = 131072;
constexpr int LDSCTL_OFF = RING_BYTES;
constexpr int LDS_BYTES = 163840;

typedef __bf16 bf16x2_t __attribute__((ext_vector_type(2)));
__device__ __forceinline__ unsigned pk2(float lo, float hi) { const bf16x2_t v = __builtin_convertvector((f32x2){lo, hi}, bf16x2_t); return __builtin_bit_cast(unsigned, v); }
__device__ __forceinline__ unsigned f2bf(float f) { return pk2(f, 0.f) & 0xffffu; }
__device__ __forceinline__ float bf2f(bf16 b) { return __builtin_bit_cast(float, ((unsigned)b) << 16); }
__device__ __forceinline__ float bflo(unsigned w) { return __builtin_bit_cast(float, w << 16); }
__device__ __forceinline__ float bfhi(unsigned w) { return __builtin_bit_cast(float, w & 0xffff0000u); }
__device__ __forceinline__ float sigm(float x) { return __builtin_amdgcn_rcpf(1.f + __expf(-x)); }
__device__ __forceinline__ float tanh_fast(float x) { const float e = __expf(2.f * x); return 1.f - 2.f * __builtin_amdgcn_rcpf(e + 1.f); }
#define LDS_WAIT() asm volatile("s_waitcnt lgkmcnt(0)" ::: "memory")
__device__ __forceinline__ float dpp_f(float x, const int ctrl_sel) {
    const int v = __builtin_bit_cast(int, x);
    int r;
    if (ctrl_sel == 0) r = __builtin_amdgcn_update_dpp(0, v, 0xB1, 0xF, 0xF, true);
    else if (ctrl_sel == 1) r = __builtin_amdgcn_update_dpp(0, v, 0x4E, 0xF, 0xF, true);
    else r = __builtin_amdgcn_update_dpp(0, v, 0x141, 0xF, 0xF, true);
    return __builtin_bit_cast(float, r);
}
__device__ __forceinline__ float red32(float x) {
    x += dpp_f(x, 0); x += dpp_f(x, 1); x += dpp_f(x, 2);
    x += __builtin_bit_cast(float, __builtin_amdgcn_update_dpp(0, __builtin_bit_cast(int, x), 0x128, 0xF, 0xF, true));
    x += __builtin_bit_cast(float, __builtin_amdgcn_ds_swizzle(__builtin_bit_cast(int, x), 0x401F));
    return x;
}
__device__ __forceinline__ float wave_sum(float v) {
    v = red32(v);
    return __builtin_bit_cast(float, __builtin_amdgcn_readlane(__builtin_bit_cast(int, v), 0)) + __builtin_bit_cast(float, __builtin_amdgcn_readlane(__builtin_bit_cast(int, v), 32));
}
__device__ __forceinline__ int xch32(int v, const int step) {
    if (step == 0) return __builtin_amdgcn_update_dpp(0, v, 0xB1, 0xF, 0xF, true);
    if (step == 1) return __builtin_amdgcn_update_dpp(0, v, 0x4E, 0xF, 0xF, true);
    if (step == 2) return __builtin_amdgcn_update_dpp(0, v, 0x141, 0xF, 0xF, true);
    if (step == 3) return __builtin_amdgcn_update_dpp(0, v, 0x128, 0xF, 0xF, true);
    return __builtin_amdgcn_ds_swizzle(v, 0x401F);
}
__device__ __forceinline__ float red8(float x) { x += dpp_f(x, 0); x += dpp_f(x, 1); x += dpp_f(x, 2); return x; }

#define XB_TMO      128
#define XB_XCNT(j)  (256  + 64 * (j))
#define XB_XSUB(j)  (1280 + 64 * (j))
#define XB_XGEN(j)  (2304 + 64 * (j))
#define XB_TOP      3328
#define XB_TOPGEN   3392
#define XCD_BAR_WORDS 3456
#define XB_SPIN_CAP (1u << 22)
__device__ __forceinline__ unsigned xb_ld(unsigned* p)              { return __hip_atomic_load(p, __ATOMIC_RELAXED, __HIP_MEMORY_SCOPE_AGENT); }
__device__ __forceinline__ unsigned xb_add(unsigned* p, unsigned v) { return __hip_atomic_fetch_add(p, v, __ATOMIC_RELAXED, __HIP_MEMORY_SCOPE_AGENT); }
__device__ __forceinline__ unsigned xb_xcc_id() { return (unsigned)__builtin_amdgcn_s_getreg((3 << 11) | 20) & 0xFu; }
#define XB_SPIN(cond, bar) do { unsigned _sp = 0; while (cond) { __builtin_amdgcn_s_sleep(1); \
    if ((++_sp & 255u) == 0u) { if (xb_ld(&(bar)[XB_TMO])) break; if (_sp > XB_SPIN_CAP) { atomicAdd(&(bar)[XB_TMO], 1u); break; } } } } while (0)
struct XcdBarrier { unsigned* bar; unsigned x; volatile LAS unsigned* st; };
__device__ __forceinline__ XcdBarrier xcd_barrier_post(unsigned* bar, volatile LAS unsigned* st) {
    XcdBarrier b; b.bar = bar; b.x = xb_xcc_id(); b.st = st;
    if (threadIdx.x == 0) (void)xb_add(&bar[XB_XCNT(b.x)], 1u);
    return b;
}
__device__ __forceinline__ void xcd_barrier_complete(unsigned* bar, unsigned x, unsigned& nloc, unsigned& nx) {
    const unsigned G = gridDim.x * gridDim.y * gridDim.z;
    unsigned sum, cnt, mine, sp = 0u;
    for (;;) {
        sum = 0u; cnt = 0u; mine = 0u;
#pragma unroll
        for (unsigned j = 0; j < 16; ++j) { const unsigned c = xb_ld(&bar[XB_XCNT(j)]); sum += c; cnt += (c > 0u) ? 1u : 0u; mine = (j == x) ? c : mine; }
        if (sum == G) break;
        __builtin_amdgcn_s_sleep(1);
        if ((++sp & 255u) == 0u) { if (xb_ld(&bar[XB_TMO])) break; if (sp > XB_SPIN_CAP) { atomicAdd(&bar[XB_TMO], 1u); break; } }
    }
    nloc = mine > 0u ? mine : 1u; nx = cnt > 0u ? cnt : 1u;
}
__device__ __forceinline__ void xcd_barrier(const XcdBarrier& b) {
    asm volatile("s_waitcnt vmcnt(0)" ::: "memory");
    __syncthreads();
    if (threadIdx.x == 0) {
        unsigned* bar = b.bar;
        __builtin_amdgcn_s_waitcnt(0);
        unsigned nloc = b.st[0], nx = b.st[1];
        if (nloc == 0u) { xcd_barrier_complete(bar, b.x, nloc, nx); b.st[0] = nloc; b.st[1] = nx; }
        const unsigned old = xb_add(&bar[XB_XSUB(b.x)], 1u);
        const unsigned gen = old / nloc;
        if (old + 1u == (gen + 1u) * nloc) {
            __builtin_amdgcn_fence(__ATOMIC_RELEASE, "agent");
            asm volatile("s_waitcnt vmcnt(0)" ::: "memory");
            const unsigned og = xb_add(&bar[XB_TOP], 1u);
            const unsigned tg = og / nx;
            if (og + 1u == (tg + 1u) * nx) xb_add(&bar[XB_TOPGEN], 1u);
            else XB_SPIN(xb_ld(&bar[XB_TOPGEN]) == tg, bar);
            __builtin_amdgcn_fence(__ATOMIC_ACQUIRE, "agent");
            xb_add(&bar[XB_XGEN(b.x)], 1u);
            asm volatile("s_waitcnt vmcnt(0)" ::: "memory");
        } else {
            XB_SPIN(xb_ld(&bar[XB_XGEN(b.x)]) == gen, bar);
            __builtin_amdgcn_fence(__ATOMIC_ACQUIRE, "agent");
            asm volatile("s_waitcnt vmcnt(0)" ::: "memory");
        }
    }
    __syncthreads();
}

namespace pg8 {
constexpr int MOE_CAP = 34816;
constexpr int BM = 256, BK = 64, HALF = 128, HTB = HALF * BK * 2, STAGE_BYTES = 8 * HTB, NXCD = 8, WGM = 8, ROWTAB_OFF = 131072 + 4096;
__host__ __device__ __forceinline__ int lds_byte(int r, int c) { const int st = (r >> 4) * 2 + (c >> 5), rr = r & 15, cc = c & 31, ob = rr * 64 + cc * 2; return st * 1024 + (ob ^ (((ob >> 9) & 1) << 5)); }
__host__ __device__ __forceinline__ void stage_rc(int b, int& R, int& C) { const int st = b / 1024, sb = b % 1024, swz = sb ^ (((sb >> 9) & 1) << 5); R = (st >> 1) * 16 + swz / 64; C = (st & 1) * 32 + (swz % 64) / 2; }
__host__ __device__ __forceinline__ int perm32(int rho) { const int n = rho >> 4, i = rho & 15; return 8 * (i >> 2) + 4 * n + (i & 3); }
struct Unit { int pm, pn, e; };
__device__ __forceinline__ unsigned cvt_pk_bf16(float lo, float hi) { return pk2(lo, hi); }

__device__ __forceinline__ void tile_of(int L, int nM, int nN, int& pm, int& pn) {
    const int nwg = nM * nN; int wgid = L;
    { const int q = nwg / NXCD, r = nwg % NXCD, xcd = wgid % NXCD, off = wgid / NXCD; wgid = (xcd < r ? xcd * (q + 1) : r * (q + 1) + (xcd - r) * q) + off; }
    const int nig = WGM * nN, gid = wgid / nig, fm = gid * WGM, gsz = (nM - fm) < WGM ? (nM - fm) : WGM;
    pm = fm + ((wgid % nig) % gsz); pn = (wgid % nig) / gsz;
}
struct SchedStatic {
    static constexpr bool GATHER = false;
    const char* A; const char* Bt; size_t tstep; int nM, nN, G, c;
    __device__ __forceinline__ void init(const void* A_, const void* Bt_, int M, int N, int K, int G_, int c_) { A = (const char*)A_; Bt = (const char*)Bt_; tstep = (size_t)BM * K * 2; nM = M / BM; nN = N / BM; G = G_; c = c_; }
    __device__ __forceinline__ bool next(int i, Unit& u) const { const long L = (long)i * G + c; if (L >= (long)nM * nN) return false; tile_of((int)L, nM, nN, u.pm, u.pn); u.e = 0; return true; }
    __device__ __forceinline__ const char* aptr(const Unit& u) const { return A + (size_t)u.pm * tstep; }
    __device__ __forceinline__ const char* bptr(const Unit& u) const { return Bt + (size_t)u.pn * tstep; }
};
struct SchedWin {
    static constexpr bool GATHER = false;
    const char* A; const char* Bt; size_t tstep; int G, c, part;
    __device__ __forceinline__ bool next(int i, Unit& u) const {
        const int L = i * G + c, nmf = part ? 128 : 136, nfull = nmf * 27; u.e = 0;
        if (L < nfull) { tile_of(L, nmf, 27, u.pm, u.pn); return true; }
        const int L2 = L - nfull; if (!part || L2 >= 8 * 9) return false;
        u.pm = 128 + L2 / 9; u.pn = 6 + L2 % 9; return true; }
    __device__ __forceinline__ const char* aptr(const Unit& u) const { return A + (size_t)u.pm * tstep; }
    __device__ __forceinline__ const char* bptr(const Unit& u) const { return Bt + (size_t)u.pn * tstep; }
};
struct SchedMerge {
    static constexpr bool GATHER = false;
    const char* A0; const char* A1; const char* A2; const char* Bt; size_t tstep, bstride; int nM, nN, G, c;
    __device__ __forceinline__ bool next(int i, Unit& u) const { const int j = i / 3, br = i - 3 * j; const long L = (long)j * G + c; if (L >= (long)nM * nN) return false; tile_of((int)L, nM, nN, u.pm, u.pn); u.e = br; return true; }
    __device__ __forceinline__ const char* aptr(const Unit& u) const { return (u.e == 0 ? A0 : (u.e == 1 ? A1 : A2)) + (size_t)u.pm * tstep; }
    __device__ __forceinline__ const char* bptr(const Unit& u) const { return Bt + (size_t)u.e * bstride + (size_t)u.pn * tstep; }
};
struct SchedMoe {
    static constexpr bool GATHER = false;
    const char* A; const char* Bt; size_t tstep, estride; int NPN, G, c; const LAS int* base;
    __device__ __forceinline__ bool next(int i, Unit& u) const {
        const int ntiles = base[32] >> 8; const int per = G >> 3;
        const long L = (long)i * G + (((G & 7) == 0) ? (c & 7) * per + (c >> 3) : c);
        if (L >= (long)ntiles * NPN) return false;
        u.pm = (int)(L / NPN); u.pn = (int)(L % NPN); const int r0 = u.pm << 8; int e = 0;
#pragma unroll 1
        for (int k = 1; k < 32; ++k) e += (r0 >= base[k]) ? 1 : 0;
        u.e = e; return true;
    }
    __device__ __forceinline__ const char* aptr(const Unit& u) const { return A + (size_t)u.pm * tstep; }
    __device__ __forceinline__ const char* bptr(const Unit& u) const { return Bt + (size_t)u.e * estride + (size_t)u.pn * tstep; }
};
struct SchedMoeG : SchedMoe {
    static constexpr bool GATHER = true;
    const unsigned* rowof;
    __device__ __forceinline__ const char* aptr(const Unit&) const { return A; }
    __device__ __forceinline__ const unsigned* rowptr(const Unit& u) const { return rowof + (size_t)u.e * MOE_CAP + ((u.pm << 8) - base[u.e]); }
    __device__ __forceinline__ int valid(const Unit& u) const { return base[64 + u.e] - ((u.pm << 8) - base[u.e]); }
};

template <class Epi, class Sched>
__device__ __forceinline__ void gemm_phase(LAS unsigned char* lds, const int tid, const int K, const Sched& S, const Epi& E) {
    const int wid = __builtin_amdgcn_readfirstlane(tid >> 6), lane = tid & 63, wr = wid >> 2, wc = wid & 3, fr = lane & 15, fq = lane >> 4;
    const int nt = K / BK;
    unsigned voffA[2], voffB[2];
#pragma unroll
    for (int i = 0; i < 2; ++i) { int R, C; stage_rc(tid * 16 + i * 8192, R, C); const int Rb = Epi::PERM ? ((R & ~31) + perm32(R & 31)) : R;
        voffA[i] = (unsigned)(R * K + C) * 2u; voffB[i] = (unsigned)(Rb * K + C) * 2u; }
    const size_t kstep = (size_t)(BK * 2);
    const size_t hstep = (size_t)HALF * K * 2;
    const unsigned ldsw = (unsigned)wid * 1024u;
    const int aoff = lds_byte(wr * 64 + fr, fq * 8), boff = lds_byte(wc * 32 + fr, fq * 8);
#define PG8_SA(b, h) (((b) * 2 + (h)) * HTB)
#define PG8_SB(b, h) ((4 + (b) * 2 + (h)) * HTB)
#define PG8_STAGE(bufoff, gbase, voff) do { _Pragma("unroll") for (int _i = 0; _i < 2; ++_i) \
        __builtin_amdgcn_global_load_lds((const unsigned*)((const char*)(gbase) + (voff)[_i]), (LAS unsigned*)(lds + (bufoff) + ldsw + _i * 8192), 16, 0, 0); } while (0)
#define PG8_STAGEA(bufoff, kp, h) do { if constexpr (Sched::GATHER) { _Pragma("unroll") for (int _i = 0; _i < 2; ++_i) \
        __builtin_amdgcn_global_load_lds((const unsigned*)((const char*)(kp) + g[2 * (h) + _i]), (LAS unsigned*)(lds + (bufoff) + ldsw + _i * 8192), 16, 0, 0); } \
        else { PG8_STAGE(bufoff, (kp) + (h) * hstep, voffA); } } while (0)
#define PG8_GLOAD(un_, buf) do { const LAS unsigned* rt_ = (const LAS unsigned*)(lds + ROWTAB_OFF + (buf) * 1024) + gR0; const int nv_ = S.valid(un_); \
        _Pragma("unroll") for (int _j = 0; _j < 4; ++_j) g[_j] = ((gR0 + 64 * _j < nv_) ? rt_[64 * _j] : 0u) + gCb; } while (0)
#define PG8_GDMA(un_, buf) do { if (wid == 0) { unsigned lo_ = (unsigned)threadIdx.x; asm volatile("" : "+v"(lo_)); lo_ = (lo_ & 63u) * 16u; \
        __builtin_amdgcn_global_load_lds((const unsigned*)((const char*)S.rowptr(un_) + lo_), (LAS unsigned*)(lds + ROWTAB_OFF + (buf) * 1024), 16, 0, 0); } } while (0)
#define PG8_LDA(dst, b, h) do { _Pragma("unroll") for (int m = 0; m < 4; ++m) _Pragma("unroll") for (int k = 0; k < 2; ++k) dst[m][k] = *(const LAS bf16x8*)(lds + PG8_SA(b, h) + aoff + m * 2048 + k * 1024); } while (0)
#define PG8_LDB(dst, b, h) do { _Pragma("unroll") for (int n = 0; n < 2; ++n) _Pragma("unroll") for (int k = 0; k < 2; ++k) dst[n][k] = *(const LAS bf16x8*)(lds + PG8_SB(b, h) + boff + n * 2048 + k * 1024); } while (0)
#define PG8_MMA(ai, bj, At, Bt) do { __builtin_amdgcn_s_setprio(1); _Pragma("unroll") for (int m = 0; m < 4; ++m) _Pragma("unroll") for (int n = 0; n < 2; ++n) _Pragma("unroll") for (int k = 0; k < 2; ++k) \
        acc[ai][bj][m][n] = __builtin_amdgcn_mfma_f32_16x16x32_bf16(Bt[n][k], At[m][k], acc[ai][bj][m][n], 0, 0, 0); __builtin_amdgcn_s_setprio(0); } while (0)
#define PG8_WAIT_V(n) asm volatile("s_waitcnt vmcnt(" #n ")" ::: "memory")
#define PG8_WAIT_L(n) asm volatile("s_waitcnt lgkmcnt(" #n ")" ::: "memory")
#define PG8_BAR __builtin_amdgcn_s_barrier()
#define PG8_SCHED __builtin_amdgcn_sched_barrier(0)
    Unit cur, nxt; int ui = 0;
    if (!S.next(0, cur)) return;
    f32x4 acc[2][2][4][2];
#pragma unroll
    for (int a = 0; a < 2; ++a)
#pragma unroll
        for (int b = 0; b < 2; ++b)
#pragma unroll
            for (int m = 0; m < 4; ++m)
#pragma unroll
                for (int n = 0; n < 2; ++n) acc[a][b][m][n] = (f32x4){0.f, 0.f, 0.f, 0.f};
    bf16x8 At[4][2], B0[2][2], B1[2][2];
    const char* cA = S.aptr(cur); const char* cB = S.bptr(cur);
    unsigned g[4] = {0u, 0u, 0u, 0u}; int gR0 = 0; unsigned gCb = 0u;
    if constexpr (Sched::GATHER) { int R, C; stage_rc(tid * 16, R, C); gR0 = R; gCb = (unsigned)C * 2u;
        PG8_GDMA(cur, 0); PG8_WAIT_V(0); PG8_BAR; PG8_GLOAD(cur, 0); }
    PG8_STAGE(PG8_SB(0, 0), cB, voffB); PG8_STAGE(PG8_SB(0, 1), cB + hstep, voffB); PG8_STAGEA(PG8_SA(0, 0), cA, 0); PG8_STAGEA(PG8_SA(0, 1), cA, 1);
    if (wr == 1) PG8_BAR;
    PG8_WAIT_V(2); PG8_BAR;
    PG8_STAGE(PG8_SB(1, 0), cB + kstep, voffB); PG8_STAGEA(PG8_SA(1, 0), cA + kstep, 0); PG8_STAGE(PG8_SB(1, 1), cB + hstep + kstep, voffB);
    PG8_WAIT_V(6); PG8_BAR;
    for (;;) {
        const bool has_next = S.next(ui + 1, nxt);
        const char* nA = has_next ? S.aptr(nxt) : cA; const char* nB = has_next ? S.bptr(nxt) : cB;
        if constexpr (Sched::GATHER) { if (has_next) PG8_GDMA(nxt, (ui + 1) & 1); }
        for (int t = 0; t < nt; t += 2) {
            const bool last = (t == nt - 2);
            const char* a1 = cA + (size_t)(t + 1) * kstep;
            const char* a2 = last ? nA : cA + (size_t)(t + 2) * kstep; const char* b2 = last ? nB : cB + (size_t)(t + 2) * kstep;
            const char* a3 = a2 + kstep; const char* b3 = b2 + kstep;
            PG8_LDB(B0, 0, 0); PG8_LDB(B1, 0, 1); PG8_SCHED; PG8_LDA(At, 0, 0); PG8_STAGEA(PG8_SA(1, 1), a1, 1);
            PG8_WAIT_V(8); PG8_WAIT_L(0); PG8_BAR; PG8_MMA(0, 0, At, B0); PG8_MMA(0, 1, At, B1); PG8_BAR; PG8_SCHED;
            if constexpr (Sched::GATHER) { if (last && has_next) PG8_GLOAD(nxt, (ui + 1) & 1); PG8_SCHED; }
            PG8_LDA(At, 0, 1); PG8_STAGE(PG8_SB(0, 0), b2, voffB); PG8_STAGE(PG8_SB(0, 1), b2 + hstep, voffB); PG8_STAGEA(PG8_SA(0, 0), a2, 0);
            PG8_WAIT_V(8); PG8_WAIT_L(0); PG8_BAR; PG8_MMA(1, 0, At, B0); PG8_MMA(1, 1, At, B1); PG8_BAR; PG8_SCHED;
            PG8_LDB(B0, 1, 0); PG8_LDB(B1, 1, 1); PG8_SCHED; PG8_LDA(At, 1, 0); PG8_STAGEA(PG8_SA(0, 1), a2, 1);
            PG8_WAIT_V(8); PG8_WAIT_L(0); PG8_BAR; PG8_MMA(0, 0, At, B0); PG8_MMA(0, 1, At, B1); PG8_BAR; PG8_SCHED;
            PG8_LDA(At, 1, 1); PG8_STAGE(PG8_SB(1, 0), b3, voffB); PG8_STAGE(PG8_SB(1, 1), b3 + hstep, voffB); PG8_STAGEA(PG8_SA(1, 0), a3, 0);
            PG8_WAIT_V(8); PG8_WAIT_L(0); PG8_BAR; PG8_MMA(1, 0, At, B0); PG8_MMA(1, 1, At, B1); PG8_BAR; PG8_SCHED;
        }
        if (wr == 0) PG8_BAR;
        { int t2_ = (int)threadIdx.x; asm volatile("" : "+v"(t2_)); E(acc, cur, wr, wc, t2_ & 15, (t2_ >> 4) & 3); }
        if (!has_next) break;
#pragma unroll
        for (int a = 0; a < 2; ++a)
#pragma unroll
            for (int b = 0; b < 2; ++b)
#pragma unroll
                for (int m = 0; m < 4; ++m)
#pragma unroll
                    for (int n = 0; n < 2; ++n) acc[a][b][m][n] = (f32x4){0.f, 0.f, 0.f, 0.f};
        cur = nxt; cA = nA; cB = nB; ++ui;
        if (wr == 1) PG8_BAR;
    }
    PG8_WAIT_V(0);
    PG8_BAR;
#undef PG8_SA
#undef PG8_SB
#undef PG8_STAGE
#undef PG8_STAGEA
#undef PG8_GLOAD
#undef PG8_GDMA
#undef PG8_LDA
#undef PG8_LDB
#undef PG8_MMA
#undef PG8_WAIT_V
#undef PG8_WAIT_L
#undef PG8_BAR
#undef PG8_SCHED
}

struct EpiBf16 {
    static constexpr bool PERM = true;
    bf16* O; int ldc; const float* bias; int bias_stride;
    __device__ __forceinline__ void operator()(const f32x4 (&acc)[2][2][4][2], const Unit& u, int wr, int wc, int fr, int fq) const {
        const int row0 = u.pm * BM + wr * 64 + fr, col0 = u.pn * BM + wc * 32 + 8 * fq;
        f32x4 bv[2][2];
#pragma unroll
        for (int bj = 0; bj < 2; ++bj)
#pragma unroll
            for (int n = 0; n < 2; ++n) bv[bj][n] = bias ? *(const f32x4*)(bias + (size_t)u.e * bias_stride + col0 + bj * HALF + 4 * n) : (f32x4){0.f, 0.f, 0.f, 0.f};
#pragma unroll
        for (int ai = 0; ai < 2; ++ai)
#pragma unroll
            for (int m = 0; m < 4; ++m) { bf16* rowp = O + (size_t)(row0 + ai * HALF + m * 16) * ldc + col0;
#pragma unroll
                for (int bj = 0; bj < 2; ++bj) { const f32x4 v0 = acc[ai][bj][m][0] + bv[bj][0], v1 = acc[ai][bj][m][1] + bv[bj][1];
                    v4u w; w.x = cvt_pk_bf16(v0[0], v0[1]); w.y = cvt_pk_bf16(v0[2], v0[3]); w.z = cvt_pk_bf16(v1[0], v1[1]); w.w = cvt_pk_bf16(v1[2], v1[3]);
                    *(v4u*)(rowp + bj * HALF) = w; } }
    }
};
template <int MODE> struct EpiGlu {
    static constexpr bool PERM = true;
    bf16* O; int ldc; const float* bias; int bias_stride, hs;
    __device__ __forceinline__ void operator()(const f32x4 (&acc)[2][2][4][2], const Unit& u, int wr, int wc, int fr, int fq) const {
        const int row0 = u.pm * BM + wr * 64 + fr, col0 = u.pn * HALF + wc * 32 + 8 * fq;
        const float* bp = bias + (size_t)u.e * bias_stride + col0;
        f32x4 ba[2], bb[2];
#pragma unroll
        for (int n = 0; n < 2; ++n) { ba[n] = *(const f32x4*)(bp + 4 * n); bb[n] = *(const f32x4*)(bp + hs + 4 * n); }
#pragma unroll
        for (int ai = 0; ai < 2; ++ai)
#pragma unroll
            for (int m = 0; m < 4; ++m) { bf16* rowp = O + (size_t)(row0 + ai * HALF + m * 16) * ldc + col0;
                float o[8];
#pragma unroll
                for (int n = 0; n < 2; ++n) { const f32x4 a = acc[ai][0][m][n] + ba[n], b = acc[ai][1][m][n] + bb[n];
#pragma unroll
                    for (int j = 0; j < 4; ++j) {
                        if (MODE == 0) o[4 * n + j] = a[j] * sigm(b[j]);
                        else { const float g = fminf(a[j], 7.f), up = fminf(fmaxf(b[j], -7.f), 7.f); o[4 * n + j] = (up + 1.f) * g * sigm(1.702f * g); } } }
                v4u w; w.x = cvt_pk_bf16(o[0], o[1]); w.y = cvt_pk_bf16(o[2], o[3]); w.z = cvt_pk_bf16(o[4], o[5]); w.w = cvt_pk_bf16(o[6], o[7]);
                *(v4u*)rowp = w; }
    }
};
struct EpiMerge {
    static constexpr bool PERM = true;
    bf16* mtmp; bf16* Mo; const bf16* zg;
    __device__ __forceinline__ void operator()(const f32x4 (&acc)[2][2][4][2], const Unit& u, int wr, int wc, int fr, int fq) const {
        const int row0 = u.pm * BM + wr * 64 + fr, col0 = u.pn * BM + wc * 32 + 8 * fq;
#pragma unroll
        for (int ai = 0; ai < 2; ++ai)
#pragma unroll
            for (int m = 0; m < 4; ++m) { const size_t r = (size_t)(row0 + ai * HALF + m * 16);
#pragma unroll
                for (int bj = 0; bj < 2; ++bj) { const int c = col0 + bj * HALF;
                    const v4u gz = *(const v4u*)(zg + r * IN_COLS + u.e * 1024 + c);
                    float g[8] = {bflo(gz.x), bfhi(gz.x), bflo(gz.y), bfhi(gz.y), bflo(gz.z), bfhi(gz.z), bflo(gz.w), bfhi(gz.w)};
                    f32x4 t0, t1; bf16* tp = mtmp + r * 1024 + c;
                    if (u.e == 0) { t0 = (f32x4){0.f, 0.f, 0.f, 0.f}; t1 = t0; } else { const v4u pv = *(const v4u*)tp; t0 = (f32x4){bflo(pv.x), bfhi(pv.x), bflo(pv.y), bfhi(pv.y)}; t1 = (f32x4){bflo(pv.z), bfhi(pv.z), bflo(pv.w), bfhi(pv.w)}; }
#pragma unroll
                    for (int j = 0; j < 4; ++j) { t0[j] += sigm(g[j]) * acc[ai][bj][m][0][j]; t1[j] += sigm(g[4 + j]) * acc[ai][bj][m][1][j]; }
                    if (u.e < 2) { v4u w; w.x = cvt_pk_bf16(t0[0], t0[1]); w.y = cvt_pk_bf16(t0[2], t0[3]); w.z = cvt_pk_bf16(t1[0], t1[1]); w.w = cvt_pk_bf16(t1[2], t1[3]); *(v4u*)tp = w; }
                    else { v4u w; w.x = cvt_pk_bf16(t0[0], t0[1]); w.y = cvt_pk_bf16(t0[2], t0[3]); w.z = cvt_pk_bf16(t1[0], t1[1]); w.w = cvt_pk_bf16(t1[2], t1[3]);
                        *(v4u*)(Mo + r * 1024 + c) = w; } } }
    }
};
struct EpiResid {
    static constexpr bool PERM = false;
    float* X; const float* gmod;
    __device__ __forceinline__ void operator()(const f32x4 (&acc)[2][2][4][2], const Unit& u, int wr, int wc, int fr, int fq) const {
        const int row0 = u.pm * BM + wr * 64 + fr, col0 = u.pn * BM + wc * 32 + 4 * fq;
        const int r00 = u.pm * BM; const int w = r00 < T_LAT ? (r00 >> 12) : 8;
        f32x4 gv[2][2];
#pragma unroll
        for (int bj = 0; bj < 2; ++bj)
#pragma unroll
            for (int n = 0; n < 2; ++n) gv[bj][n] = *(const f32x4*)(gmod + (size_t)w * 6144 + col0 + bj * HALF + n * 16);
#pragma unroll
        for (int ai = 0; ai < 2; ++ai)
#pragma unroll
            for (int m = 0; m < 4; ++m) { float* rowp = X + (size_t)(row0 + ai * HALF + m * 16) * 1024 + col0;
#pragma unroll
                for (int bj = 0; bj < 2; ++bj)
#pragma unroll
                    for (int n = 0; n < 2; ++n) { f32x4* p = (f32x4*)(rowp + bj * HALF + n * 16); *p = *p + gv[bj][n] * acc[ai][bj][m][n]; } }
    }
};
}

struct Args { const float* in[51]; float* out; unsigned char* ws; int ph_lo, ph_hi; };
enum { I_X = 0, I_C, I_CTX, I_CCTX, I_ADAW, I_ADAB, I_N1G, I_N2G, I_WIN, I_HYCW, I_HYCB, I_HYW1, I_HYB1, I_HYF1, I_HYW2, I_HYB2, I_HYF2, I_HYW3, I_HYB3, I_HYBIAS,
       I_RWCW, I_RWCB, I_RWWUP, I_RWW0, I_RWAUP, I_RWA0, I_RWGUP, I_RWKK, I_RWKA, I_RWRK, I_RWLNG, I_RWLNB, I_S5ARE, I_S5AIM, I_S5LDT, I_S5BRE, I_S5BIM, I_S5CRE, I_S5CIM, I_S5D,
       I_S5GLUW, I_S5GLUB, I_WBR, I_WOUT, I_RTW, I_RTB, I_W1, I_B1, I_W2, I_B2, I_FING };

typedef const __attribute__((address_space(4))) Args* CArgsP;
__device__ __forceinline__ CArgsP kargs() { CArgsP p = (CArgsP)__builtin_amdgcn_kernarg_segment_ptr(); asm volatile("" : "+s"(p)); return p; }
__device__ __forceinline__ int opaque(int v) { asm volatile("" : "+s"(v)); return v; }
__device__ __forceinline__ int opaque_v(int v) { asm volatile("" : "+v"(v)); return v; }
struct Ctx { CArgsP a; LAS unsigned char* lds; int tid, lane, wave, bid, G; };

__device__ __forceinline__ void row_seq(int row, int& base, int& pos, int& n) {
    if (row < T_LAT) { base = row & ~(SEQ - 1); pos = row & (SEQ - 1); n = SEQ; }
    else { const int r = row - T_LAT; base = T_LAT + (r & ~(CTXL - 1)); pos = r & (CTXL - 1); n = CTXL; }
}
__device__ __forceinline__ float conv3z(const bf16* zc, int pos, int n, float w0, float w1, float w2, float b) {
    const float zm = pos > 0 ? bf2f(zc[(size_t)(pos - 1) * IN_COLS]) : 0.f, z0 = bf2f(zc[(size_t)pos * IN_COLS]), zp = pos < n - 1 ? bf2f(zc[(size_t)(pos + 1) * IN_COLS]) : 0.f;
    return zm * w0 + z0 * w1 + zp * w2 + b;
}

template <int MODE>
__device__ __forceinline__ void transpose_item(const float* W, int K, int N, bf16* WT, int Hs, LAS float* scr, int item, int lane) {
    const int nblk = N / 32, kb = item / nblk, nb = item % nblk, k0 = 64 * kb, n0 = 32 * nb;
#pragma unroll 8
    for (int i = 0; i < 32; ++i) { const int kk = 2 * i + (lane >> 5); scr[kk * 33 + (lane & 31)] = W[(size_t)(k0 + kk) * N + n0 + (lane & 31)]; }
    LDS_WAIT(); asm volatile("" ::: "memory");
    const int c = lane & 7;
#pragma unroll
    for (int j = 0; j < 4; ++j) { const int n = (lane >> 3) + 8 * j; const LAS float* s = scr + (8 * c) * 33 + n;
        v4u o; o.x = pk2(s[0 * 33], s[1 * 33]); o.y = pk2(s[2 * 33], s[3 * 33]); o.z = pk2(s[4 * 33], s[5 * 33]); o.w = pk2(s[6 * 33], s[7 * 33]);
        int dr = n0 + n;
        if (MODE == 1) { const int nc = n0 + n; const int jx = nc < Hs ? nc : nc - Hs; dr = (jx >> 7) * 256 + (nc < Hs ? 0 : 128) + (jx & 127); }
        *(v4u*)(WT + (size_t)dr * K + k0 + 8 * c) = o; }
    LDS_WAIT(); asm volatile("" ::: "memory");
}

__device__ __forceinline__ void p0_prologue(const Ctx& F) {
    const auto& a = *F.a; unsigned char* ws = a.ws;
    const int gw = F.bid * NWAVES + F.wave, NGW = F.G * NWAVES, lane = F.lane;
    float* X = (float*)(ws + WS_X);
    for (int t = gw; t < SEQ; t += NGW) {
        const float pr = (float)(t >> 6), pc = (float)(t & 63);
        f32x4 pe[4];
#pragma unroll
        for (int j = 0; j < 4; ++j)
#pragma unroll
            for (int e = 0; e < 4; ++e) { const float om = 1.0f / powf(10000.0f, (float)(4 * lane + e) / 256.0f); const float ang = ((j < 2) ? pr : pc) * om; pe[j][e] = (j & 1) ? cosf(ang) : sinf(ang); }
#pragma unroll 2
        for (int bb = 0; bb < BATCH; ++bb) { const size_t row = (size_t)bb * SEQ + t;
            const f32x4* xi = (const f32x4*)(a.in[I_X] + row * D) + lane; f32x4* xo = (f32x4*)(X + row * D) + lane;
#pragma unroll
            for (int j = 0; j < 4; ++j) xo[64 * j] = xi[64 * j] + pe[j]; }
    }
    for (int row = T_LAT + gw; row < T_ALL; row += NGW) {
        const f32x4* xi = (const f32x4*)(a.in[I_CTX] + (size_t)(row - T_LAT) * D) + lane; f32x4* xo = (f32x4*)(X + (size_t)row * D) + lane;
#pragma unroll
        for (int j = 0; j < 4; ++j) xo[64 * j] = xi[64 * j];
    }
    {
        LAS float* condl = (LAS float*)F.lds; LAS float* psum = (LAS float*)(F.lds + 40960);
        for (int i = F.tid; i < 9 * 1024; i += NTHREADS) { const int w = i >> 10, k = i & 1023; const float cv = (w < 8) ? a.in[I_C][w * 1024 + k] : a.in[I_CCTX][k]; condl[i] = cv / (1.f + expf(-cv)); }
        __syncthreads();
        float* MOD = (float*)(ws + WS_MOD);
        for (int it = F.bid; it < 2 * 96; it += F.G) {
            const int l = it / 96, cg = it % 96, col = cg * 64 + lane;
            float acc[9];
#pragma unroll
            for (int w = 0; w < 9; ++w) acc[w] = 0.f;
            const float* wp = a.in[I_ADAW] + ((size_t)l * 1024 + F.wave * 128) * 6144 + col;
#pragma unroll 1
            for (int k0 = 0; k0 < 128; k0 += 16) { float wv[16];
#pragma unroll
                for (int k = 0; k < 16; ++k) wv[k] = wp[(size_t)(k0 + k) * 6144];
#pragma unroll
                for (int k = 0; k < 16; ++k)
#pragma unroll
                    for (int w = 0; w < 9; ++w) acc[w] += condl[w * 1024 + F.wave * 128 + k0 + k] * wv[k]; }
#pragma unroll
            for (int w = 0; w < 9; ++w) psum[(F.wave * 9 + w) * 64 + lane] = acc[w];
            __syncthreads();
            if (F.wave == 0) {
#pragma unroll
                for (int w = 0; w < 9; ++w) { float s = 0.f;
#pragma unroll
                    for (int wv = 0; wv < 8; ++wv) s += psum[(wv * 9 + w) * 64 + lane];
                    MOD[(size_t)(l * 9 + w) * 6144 + col] = s + a.in[I_ADAB][l * 6144 + col]; }
            }
            __syncthreads();
        }
    }
    {
        LAS float* scr = (LAS float*)(F.lds + F.wave * 16384);
        constexpr int IT_W1 = 16 * 64, IT_W2 = 16 * 32, IT_WIN = 16 * 216, IT_GLU = 8 * 32, IT_WBR = 8 * 32, IT_WOUT = 16 * 32;
        constexpr int N_W1 = 64 * IT_W1, N_W2 = 64 * IT_W2, N_WIN = 2 * IT_WIN, N_GLU = 2 * IT_GLU, N_WBR = 6 * IT_WBR, N_WOUT = 2 * IT_WOUT;
        constexpr int NITEMS = N_W1 + N_W2 + N_WIN + N_GLU + N_WBR + N_WOUT;
        for (int it = gw; it < NITEMS; it += NGW) {
            int r = it;
            if (r < N_W1) { const int mtx = r / IT_W1, l = mtx >> 5, e = mtx & 31; transpose_item<1>(a.in[I_W1] + (size_t)mtx * 1024 * 2048, 1024, 2048, (bf16*)(ws + WS_WTS + l * WL_STRIDE + WO_W1) + (size_t)e * 2048 * 1024, 1024, scr, r % IT_W1, lane); continue; } r -= N_W1;
            if (r < N_W2) { const int mtx = r / IT_W2, l = mtx >> 5, e = mtx & 31; transpose_item<0>(a.in[I_W2] + (size_t)mtx * 1024 * 1024, 1024, 1024, (bf16*)(ws + WS_WTS + l * WL_STRIDE + WO_W2) + (size_t)e * 1024 * 1024, 0, scr, r % IT_W2, lane); continue; } r -= N_W2;
            if (r < N_WIN) { const int l = r / IT_WIN; transpose_item<0>(a.in[I_WIN] + (size_t)l * 1024 * IN_COLS, 1024, IN_COLS, (bf16*)(ws + WS_WTS + l * WL_STRIDE + WO_WIN), 0, scr, r % IT_WIN, lane); continue; } r -= N_WIN;
            if (r < N_GLU) { const int l = r / IT_GLU; transpose_item<1>(a.in[I_S5GLUW] + (size_t)l * 512 * 1024, 512, 1024, (bf16*)(ws + WS_WTS + l * WL_STRIDE + WO_GLU), 512, scr, r % IT_GLU, lane); continue; } r -= N_GLU;
            if (r < N_WBR) { const int mtx = r / IT_WBR, l = mtx / 3, br = mtx % 3; transpose_item<0>(a.in[I_WBR] + (size_t)mtx * 512 * 1024, 512, 1024, (bf16*)(ws + WS_WTS + l * WL_STRIDE + WO_WBR) + (size_t)br * 1024 * 512, 0, scr, r % IT_WBR, lane); continue; } r -= N_WBR;
            { const int l = r / IT_WOUT; transpose_item<0>(a.in[I_WOUT] + (size_t)l * 1024 * 1024, 1024, 1024, (bf16*)(ws + WS_WTS + l * WL_STRIDE + WO_WOUT), 0, scr, r % IT_WOUT, lane); }
        }
        for (int i = F.bid * NTHREADS + F.tid; i < 2 * 2560 * 256; i += F.G * NTHREADS) {
            const int l = i / (2560 * 256), r = i % (2560 * 256), n = r >> 8, k = r & 255; float v = 0.f;
            if (n < 1024) { if (k < 64) v = a.in[I_RWWUP][(((size_t)l * 2 + (n >> 9)) * 64 + k) * 512 + (n & 511)]; }
            else if (n < 2048) { if (k >= 64 && k < 128) v = a.in[I_RWAUP][(((size_t)l * 2 + ((n - 1024) >> 9)) * 64 + (k - 64)) * 512 + (n & 511)]; }
            else { if (k >= 128) v = a.in[I_RWGUP][((size_t)l * 128 + (k - 128)) * 512 + (n - 2048)]; }
            ((bf16*)(ws + WS_WTS + l * WL_STRIDE + WO_RWCAT))[r] = (bf16)f2bf(v);
        }
    }
    __syncthreads();
    {
        LAS float* feats = (LAS float*)F.lds; LAS float* h1 = feats + 8 * 33; LAS float* h2 = h1 + 8 * 64;
        constexpr int NIT = 2 * (512 + 32);
        for (int it = F.bid; it < NIT; it += F.G) {
            const int l = it / 544, r = it % 544, nsel = r >= 512, n = nsel ? CTXL : SEQ, p0 = (nsel ? r - 512 : r) * 8;
            if (F.tid < 8 * 33) { const int p = F.tid / 33, i = F.tid % 33, pos = p0 + p; float f;
                if (i == 0) f = (float)pos / (float)(n - 1);
                else { const int k = (i - 1) & 15; const float band = 1e-4f + (float)k * ((15.0f - 1e-4f) / 15.0f); const float ang = (6.283185307179586f * (float)pos / (float)n) * band; f = (i <= 16) ? cosf(ang) : -sinf(ang); }
                feats[p * 33 + i] = f; }
            __syncthreads();
            { const int p = F.tid >> 6, j = F.tid & 63; float s = a.in[I_HYB1][l * 64 + j]; const float* w1p = a.in[I_HYW1] + (size_t)l * 33 * 64 + j;
#pragma unroll
                for (int i = 0; i < 33; ++i) s += feats[p * 33 + i] * w1p[i * 64];
                h1[p * 64 + j] = sinf(a.in[I_HYF1][l * 64 + j] * s); }
            __syncthreads();
            { const int p = F.tid >> 6, j = F.tid & 63; float s = a.in[I_HYB2][l * 64 + j];
                const float* w2p = a.in[I_HYW2] + (size_t)l * 64 * 64 + j;
#pragma unroll 16
                for (int i = 0; i < 64; ++i) s += h1[p * 64 + i] * w2p[i * 64];
                h2[p * 64 + j] = sinf(a.in[I_HYF2][l * 64 + j] * s); }
            __syncthreads();
            float acc[4][8];
#pragma unroll
            for (int q = 0; q < 4; ++q)
#pragma unroll
                for (int p = 0; p < 8; ++p) acc[q][p] = 0.f;
            const float* w3 = a.in[I_HYW3] + (size_t)l * 64 * 2048 + F.tid;
#pragma unroll 8
            for (int i = 0; i < 64; ++i) { float wv[4];
#pragma unroll
                for (int q = 0; q < 4; ++q) wv[q] = w3[(size_t)i * 2048 + q * 512];
#pragma unroll
                for (int p = 0; p < 8; ++p) { const float hv = h2[p * 64 + i];
#pragma unroll
                    for (int q = 0; q < 4; ++q) acc[q][p] += hv * wv[q]; } }
            const int c = F.tid; const float dstart = logf(0.01f) / 1.5f, dstop = logf(0.01f) / 0.3f; const float delta = fabsf(dstart + (float)c * ((dstop - dstart) / 511.0f));
            const int RL = nsel ? HY_RLENC : HY_RLEN, off = n + 47;
            bf16* Rb = (bf16*)(ws + WS_GF + l * GF_STRIDE + (nsel ? GF_CTX : 0));
#pragma unroll
            for (int q = 0; q < 4; ++q) { const int o = q >> 1, side = q & 1; const float b3 = a.in[I_HYB3][l * 2048 + q * 512 + c];
                bf16* Rc = Rb + ((size_t)o * 512 + c) * RL;
#pragma unroll
                for (int p = 0; p < 8; ++p) { const int pos = p0 + p; const float t = (float)pos / (float)(n - 1); const float val = (acc[q][p] + b3) * expf(-t * delta);
                    if (side == 0) Rc[off - pos] = (bf16)f2bf(val);
                    else if (pos >= 1) Rc[off + pos] = (bf16)f2bf(val); }
                if (p0 == 0 && side == 0) { for (int m = 0; m < 48; ++m) Rc[m] = 0; for (int m = off + n; m < RL; ++m) Rc[m] = 0; } }
            __syncthreads();
        }
    }
}

__device__ __forceinline__ void stage_norm1(const Ctx& F, int l) {
    const auto& a = *F.a; unsigned char* ws = a.ws; const int lane = F.lane;
    const int gw = F.bid * NWAVES + F.wave, NGW = F.G * NWAVES;
    float* X = (float*)(ws + WS_X); bf16* H = (bf16*)(ws + WS_H); const float* MOD = (const float*)(ws + WS_MOD);
    const bf16* YS = (const bf16*)(ws + WS_XS); const int* POS = (const int*)(ws + WS_POS); const float* GATE = (const float*)(ws + WS_GATE);
    const int nrows = (l == DEPTH) ? T_LAT : T_ALL;
    f32x4 ngv[4];
    { const f32x4* ngp = (l == DEPTH) ? (const f32x4*)a.in[I_FING] + lane : (const f32x4*)(a.in[I_N1G] + l * D) + lane;
#pragma unroll
      for (int j = 0; j < 4; ++j) ngv[j] = ngp[64 * j]; }
    f32x4 vn[4]; v2u ysn[4][4]; int4 pnn = make_int4(0, 0, 0, 0); f32x4 gn = (f32x4){0.f, 0.f, 0.f, 0.f}, gnn = gn;
#pragma unroll
    for (int k = 0; k < 4; ++k)
#pragma unroll
        for (int j = 0; j < 4; ++j) ysn[k][j] = (v2u){0u, 0u};
#define N1_LDYS(p4_) do { const int pk_[4] = {(p4_).x, (p4_).y, (p4_).z, (p4_).w}; _Pragma("unroll") for (int k = 0; k < 4; ++k) { const v2u* yr_ = (const v2u*)(YS + (size_t)pk_[k] * D) + lane; \
        _Pragma("unroll") for (int j = 0; j < 4; ++j) ysn[k][j] = yr_[64 * j]; } } while (0)
    if (gw < nrows) {
#pragma unroll
        for (int j = 0; j < 4; ++j) vn[j] = ((const f32x4*)(X + (size_t)gw * D) + lane)[64 * j];
        if (l > 0) { const int4 p0 = *(const int4*)(POS + gw * 4); gn = *(const f32x4*)(GATE + gw * 4);
            if (gw + NGW < nrows) { pnn = *(const int4*)(POS + (gw + NGW) * 4); gnn = *(const f32x4*)(GATE + (gw + NGW) * 4); }
            N1_LDYS(p0); } }
#pragma unroll 1
    for (int row = gw; row < nrows; row += NGW) {
        const int w = row < T_LAT ? (row >> 12) : 8;
        f32x4* xr = (f32x4*)(X + (size_t)row * D) + lane;
        f32x4 v[4]; v2u ysc[4][4];
#pragma unroll
        for (int j = 0; j < 4; ++j) v[j] = vn[j];
#pragma unroll
        for (int k = 0; k < 4; ++k)
#pragma unroll
            for (int j = 0; j < 4; ++j) ysc[k][j] = ysn[k][j];
        const f32x4 gc = gn; const int4 pnx = pnn; gn = gnn;
        const int rn = row + NGW, rnn = row + 2 * NGW;
        if (rn < nrows) {
#pragma unroll
            for (int j = 0; j < 4; ++j) vn[j] = ((const f32x4*)(X + (size_t)rn * D) + lane)[64 * j];
            if (l > 0) N1_LDYS(pnx); }
        if (l > 0 && rnn < nrows) { pnn = *(const int4*)(POS + rnn * 4); gnn = *(const f32x4*)(GATE + rnn * 4); }
        f32x4 m0[4], m1[4], m2[4];
        if (l < DEPTH) {
#pragma unroll
            for (int j = 0; j < 4; ++j) { m0[j] = ((const f32x4*)(MOD + (size_t)(l * 9 + w) * 6144) + lane)[64 * j]; m1[j] = ((const f32x4*)(MOD + (size_t)(l * 9 + w) * 6144 + 1024) + lane)[64 * j]; } }
        if (l > 0) {
#pragma unroll
            for (int j = 0; j < 4; ++j) m2[j] = ((const f32x4*)(MOD + (size_t)((l - 1) * 9 + w) * 6144 + 5120) + lane)[64 * j];
            f32x4 mo[4];
#pragma unroll
            for (int j = 0; j < 4; ++j) mo[j] = (f32x4){0.f, 0.f, 0.f, 0.f};
#pragma unroll
            for (int k = 0; k < TOPK; ++k) { const float g = gc[k];
#pragma unroll
                for (int j = 0; j < 4; ++j) { const v2u y = ysc[k][j]; mo[j][0] += g * bflo(y.x); mo[j][1] += g * bfhi(y.x); mo[j][2] += g * bflo(y.y); mo[j][3] += g * bfhi(y.y); } }
#pragma unroll
            for (int j = 0; j < 4; ++j) { v[j] = v[j] + m2[j] * mo[j]; xr[64 * j] = v[j]; }
        }
        float ss = 0.f;
#pragma unroll
        for (int j = 0; j < 4; ++j) ss += (v[j][0] * v[j][0] + v[j][1] * v[j][1]) + (v[j][2] * v[j][2] + v[j][3] * v[j][3]);
        const float rstd = __builtin_amdgcn_rsqf(wave_sum(ss) * (1.f / D) + 1e-6f);
        if (l == DEPTH) {
            f32x4* o = (f32x4*)(a.out + (size_t)row * D) + lane;
#pragma unroll
            for (int j = 0; j < 4; ++j) o[64 * j] = v[j] * rstd * ngv[j];
        } else {
            v2u* ho = (v2u*)(H + (size_t)row * D) + lane;
#pragma unroll
            for (int j = 0; j < 4; ++j) { const f32x4 h = v[j] * rstd * ngv[j] * (m1[j] + 1.0f) + m0[j]; v2u o; o.x = pk2(h[0], h[1]); o.y = pk2(h[2], h[3]); ho[64 * j] = o; }
        }
    }
#undef N1_LDYS
}

__device__ __forceinline__ void stage_rw_prep1(const Ctx& F, int l) {
    const auto& a = *F.a; unsigned char* ws = a.ws;
    const bf16* __restrict__ Z = (const bf16*)(ws + WS_Z); bf16* __restrict__ ARW = (bf16*)(ws + WS_ARW);
    const int j = 4 * (F.tid & 63), col = 1536 + j, rq = F.tid >> 6;
    const float* cw = a.in[I_RWCW] + (size_t)l * 3 * 1792;
    const f32x4 w0 = *(const f32x4*)(cw + col), w1 = *(const f32x4*)(cw + 1792 + col), w2 = *(const f32x4*)(cw + 2 * 1792 + col), cb = *(const f32x4*)(a.in[I_RWCB] + l * 1792 + col);
#pragma unroll 4
    for (int row = F.bid * 8 + rq; row < T_ALL; row += F.G * 8) {
        int base, pos, n; row_seq(row, base, pos, n);
        const bf16* zc = Z + (size_t)row * IN_COLS + RW_OFF + col;
        const v2u z0 = *(const v2u*)zc;
        v2u zm = (v2u){0u, 0u}, zp = (v2u){0u, 0u};
        if (pos > 0) zm = *(const v2u*)(zc - IN_COLS);
        if (pos < n - 1) zp = *(const v2u*)(zc + IN_COLS);
        f32x4 v = (f32x4){bflo(zm.x), bfhi(zm.x), bflo(zm.y), bfhi(zm.y)} * w0 + (f32x4){bflo(z0.x), bfhi(z0.x), bflo(z0.y), bfhi(z0.y)} * w1 + (f32x4){bflo(zp.x), bfhi(zp.x), bflo(zp.y), bfhi(zp.y)} * w2 + cb;
#pragma unroll
        for (int e2 = 0; e2 < 4; ++e2) { if (j < 64) v[e2] = tanh_fast(v[e2]); else if (j >= 128) v[e2] = sigm(v[e2]); }
        v2u o; o.x = pk2(v[0], v[1]); o.y = pk2(v[2], v[3]);
        *(v2u*)(ARW + (size_t)row * 256 + j) = o;
    }
}

__device__ __forceinline__ void stage_rw_prep2(const Ctx& F, int l) {
    const auto& a = *F.a; unsigned char* ws = a.ws; const int lane = F.lane;
    const bf16* Z = (const bf16*)(ws + WS_Z); const bf16* P = (const bf16*)(ws + WS_P); bf16* SCN = (bf16*)(ws + WS_SCN);
    const int gw = F.bid * NWAVES + F.wave, NGW = F.G * NWAVES;
    constexpr int TR = 17, NRT = T_ALL / TR;
    const float* cw = a.in[I_RWCW] + (size_t)l * 3 * 1792; const float* cbp = a.in[I_RWCB] + l * 1792;
    for (int tile = gw; tile < NRT * 4; tile += NGW) {
        const int rt = tile % NRT, hp = tile / NRT, row0 = rt * TR, c0 = hp * 128 + 2 * lane;
        f32x2 w[3][3], cb[3];
#pragma unroll
        for (int s = 0; s < 3; ++s) { cb[s] = *(const f32x2*)(cbp + s * 512 + c0);
#pragma unroll
            for (int j = 0; j < 3; ++j) w[s][j] = *(const f32x2*)(cw + j * 1792 + s * 512 + c0); }
        const f32x2 KKw = *(const f32x2*)(a.in[I_RWKK] + l * 512 + c0), KAw = *(const f32x2*)(a.in[I_RWKA] + l * 512 + c0);
        f32x2 W0[2], A0[2];
#pragma unroll
        for (int d = 0; d < 2; ++d) { W0[d] = *(const f32x2*)(a.in[I_RWW0] + (l * 2 + d) * 512 + c0); A0[d] = *(const f32x2*)(a.in[I_RWA0] + (l * 2 + d) * 512 + c0); }
        const unsigned* zb = (const unsigned*)(Z + RW_OFF + c0);
        unsigned zw[8][3], pw_[8][4];
#define P2_LDZ(j_) do { const int rr_ = row0 + (j_); if (rr_ >= 0 && rr_ < T_ALL) { _Pragma("unroll") for (int s = 0; s < 3; ++s) zw[((j_) + 1) & 7][s] = zb[(size_t)rr_ * (IN_COLS / 2) + s * 256]; } \
        else { _Pragma("unroll") for (int s = 0; s < 3; ++s) zw[((j_) + 1) & 7][s] = 0u; } } while (0)
#define P2_LDP(j_) do { const unsigned* pr_ = (const unsigned*)(P + (size_t)(row0 + (j_)) * 2560 + c0); pw_[(j_) & 7][0] = pr_[0]; pw_[(j_) & 7][1] = pr_[512]; pw_[(j_) & 7][2] = pr_[256]; pw_[(j_) & 7][3] = pr_[768]; } while (0)
        P2_LDZ(-1); P2_LDZ(0); P2_LDZ(1); P2_LDZ(2); P2_LDZ(3); P2_LDP(0); P2_LDP(1); P2_LDP(2);
#pragma unroll
        for (int i = 0; i < TR; ++i) {
            const int row = row0 + i; int base, pos, n; row_seq(row, base, pos, n);
            if (i + 4 <= TR) P2_LDZ(i + 4);
            if (i + 3 < TR) P2_LDP(i + 3);
            unsigned zm[3], z0[3], zp[3], pc_[4];
#pragma unroll
            for (int s = 0; s < 3; ++s) { zm[s] = zw[i & 7][s]; z0[s] = zw[(i + 1) & 7][s]; zp[s] = zw[(i + 2) & 7][s]; }
#pragma unroll
            for (int e = 0; e < 4; ++e) pc_[e] = pw_[i & 7][e];
            const float mlo = pos > 0 ? 1.f : 0.f, mhi = pos < n - 1 ? 1.f : 0.f;
            f32x2 u[3];
#pragma unroll
            for (int s = 0; s < 3; ++s) u[s] = (f32x2){bflo(zm[s]), bfhi(zm[s])} * mlo * w[s][0] + (f32x2){bflo(z0[s]), bfhi(z0[s])} * w[s][1] + (f32x2){bflo(zp[s]), bfhi(zp[s])} * mhi * w[s][2] + cb[s];
            const f32x2 r = u[0], k = u[1], v = u[2];
            f32x2 kk = k * KKw;
            const float ss = red32(kk[0] * kk[0] + kk[1] * kk[1]);
            kk = kk * (__builtin_amdgcn_rsqf(fmaxf(ss, 1e-24f)));
            unsigned* o = (unsigned*)(SCN + (size_t)row * 9 * 512 + c0);
            o[0] = pk2(r[0], r[1]); o[256] = pk2(v[0], v[1]); o[2 * 256] = pk2(kk[0], kk[1]);
#pragma unroll
            for (int d = 0; d < 2; ++d) {
                const unsigned pw = pc_[2 * d], pa = pc_[2 * d + 1];
                float ld[2], kd[2], be[2];
#pragma unroll
                for (int e = 0; e < 2; ++e) {
                    const float uu = W0[d][e] + (e ? bfhi(pw) : bflo(pw));
                    ld[e] = -0.60653065971263342f * sigm(uu);
                    const float av = sigm(A0[d][e] + (e ? bfhi(pa) : bflo(pa)));
                    kd[e] = k[e] * (1.f + (av - 1.f) * KAw[e]); be[e] = kk[e] * av; }
                o[(3 + 3 * d) * 256] = pk2(ld[0], ld[1]); o[(4 + 3 * d) * 256] = pk2(kd[0], kd[1]); o[(5 + 3 * d) * 256] = pk2(be[0], be[1]);
            }
        }
    }
}
#undef P2_LDZ
#undef P2_LDP

__device__ __forceinline__ int seq_row(int b, int d, int sidx) {
    if (sidx < CTXL) { const int t = d ? (CTXL - 1 - sidx) : sidx; return T_LAT + b * CTXL + t; }
    const int tl = sidx - CTXL; const int t = d ? (SEQ - 1 - tl) : tl; return b * SEQ + t;
}

constexpr int CW_WORK = 16384;
constexpr int CW_STAMP = 20480;
#ifdef PROBE_T
#ifndef PROBE_BID
#define PROBE_BID 0
#endif
#define PT(k) do { if (F.bid == PROBE_BID && F.tid == 0 && l == 0) ((unsigned long long*)(F.a->ws + WS_CTL + CW_STAMP * 4))[k] = __builtin_amdgcn_s_memrealtime(); } while (0)
#else
#define PT(k) do { } while (0)
#endif
__device__ __forceinline__ void rw_scan_item(const Ctx& F, int l, int it2) {
    const int it = it2 >> 1, half = it2 & 1;
    const auto& a = *F.a; unsigned char* ws = a.ws; const int tid = F.tid, lane = F.lane;
    const bf16* SCN = (const bf16*)(ws + WS_SCN); float* YD = (float*)(ws + WS_YDIR);
    LAS float* sbuf = (LAS float*)F.lds;
    LAS float* ybuf = (LAS float*)(F.lds + 49152);
    const bool comp = F.wave < 4;
    const int lt = tid & 255, ls = lt >> 4, lj = lt & 15;
    const int vl = lane >> 3, kq = lane & 7, vrow = half * 32 + (F.wave & 3) * 8 + vl;
    constexpr int NCH = (CTXL + SEQ) / 16;
    const int d = it & 1, h = (it >> 1) & 7, b = it >> 4;
    f32x2 S[4];
#pragma unroll
    for (int q = 0; q < 4; ++q) S[q] = (f32x2){0.f, 0.f};
    v2u ldr[6];
#define RW_ISSUE(c) do { const int row_ = seq_row(b, d, (c) * 16 + ls); const v2u* p_ = (const v2u*)(SCN + (size_t)row_ * 9 * 512 + h * 64) + lj; \
        ldr[0] = p_[2 * 128]; ldr[1] = p_[(3 + 3 * d) * 128]; ldr[2] = p_[(5 + 3 * d) * 128]; ldr[3] = p_[(4 + 3 * d) * 128]; ldr[4] = p_[0]; ldr[5] = p_[128]; } while (0)
#define RW_WRITE(bufi) do { LAS float* o_ = sbuf + (((bufi) * 16 + ls) * 6) * 64 + 4 * lj; \
        *(LAS f32x4*)(o_) = (f32x4){-bflo(ldr[0].x), -bfhi(ldr[0].x), -bflo(ldr[0].y), -bfhi(ldr[0].y)}; \
        *(LAS f32x4*)(o_ + 64) = (f32x4){__expf(bflo(ldr[1].x)), __expf(bfhi(ldr[1].x)), __expf(bflo(ldr[1].y)), __expf(bfhi(ldr[1].y))}; \
        *(LAS f32x4*)(o_ + 128) = (f32x4){bflo(ldr[2].x), bfhi(ldr[2].x), bflo(ldr[2].y), bfhi(ldr[2].y)}; *(LAS f32x4*)(o_ + 192) = (f32x4){bflo(ldr[3].x), bfhi(ldr[3].x), bflo(ldr[3].y), bfhi(ldr[3].y)}; \
        *(LAS f32x4*)(o_ + 256) = (f32x4){bflo(ldr[4].x), bfhi(ldr[4].x), bflo(ldr[4].y), bfhi(ldr[4].y)}; *(LAS f32x4*)(o_ + 320) = (f32x4){bflo(ldr[5].x), bfhi(ldr[5].x), bflo(ldr[5].y), bfhi(ldr[5].y)}; } while (0)
#define RW_FLUSH(c) do { const int row_ = seq_row(b, d, (c) * 16 + ls); \
        *(f32x2*)(YD + ((size_t)d * T_ALL + row_) * 512 + h * 64 + half * 32 + 2 * lj) = *(const LAS f32x2*)(ybuf + ((((c) & 1) * 16 + ls) * 64) + half * 32 + 2 * lj); } while (0)
    if (!comp) { RW_ISSUE(0); RW_WRITE(0); RW_ISSUE(1); }
    __syncthreads();
#pragma unroll 1
    for (int c = 0; c < NCH; ++c) {
        const int bi = c & 1;
        if (!comp) {
            if (c + 1 < NCH) RW_WRITE(bi ^ 1);
            if (c + 2 < NCH) RW_ISSUE(c + 2);
            if (c > 0) RW_FLUSH(c - 1);
        } else {
        float yv[16];
        f32x4 opA[10], opB[10]; float vvA, vvB;
#define RW_LD(op, vvx, s_) do { const LAS float* sp_ = sbuf + ((bi * 16 + (s_)) * 6) * 64 + 8 * kq; \
            _Pragma("unroll") for (int q_ = 0; q_ < 5; ++q_) { op[2 * q_] = *(const LAS f32x4*)(sp_ + 64 * q_); op[2 * q_ + 1] = *(const LAS f32x4*)(sp_ + 64 * q_ + 4); } \
            vvx = sbuf[((bi * 16 + (s_)) * 6 + 5) * 64 + vrow]; } while (0)
#define RW_COMP(op, vvx, s_) do { \
            const f32x4 a0 = op[0], a1 = op[1], w0 = op[2], w1 = op[3], b0 = op[4], b1 = op[5], k0 = op[6], k1 = op[7], r0 = op[8], r1 = op[9]; \
            const f32x2 vv2 = (f32x2){vvx, vvx}; \
            const f32x2 p0 = S[1] * (f32x2){a0[2], a0[3]} + S[0] * (f32x2){a0[0], a0[1]}; \
            const f32x2 p1 = S[3] * (f32x2){a1[2], a1[3]} + S[2] * (f32x2){a1[0], a1[1]}; \
            const f32x2 t0 = S[0] * (f32x2){w0[0], w0[1]} + vv2 * (f32x2){k0[0], k0[1]}; \
            const f32x2 t1 = S[1] * (f32x2){w0[2], w0[3]} + vv2 * (f32x2){k0[2], k0[3]}; \
            const f32x2 t2 = S[2] * (f32x2){w1[0], w1[1]} + vv2 * (f32x2){k1[0], k1[1]}; \
            const f32x2 t3 = S[3] * (f32x2){w1[2], w1[3]} + vv2 * (f32x2){k1[2], k1[3]}; \
            const f32x2 ac = p0 + p1; \
            const float sa = red8(ac[0] + ac[1]); \
            const f32x2 sa2 = (f32x2){sa, sa}; \
            S[0] = sa2 * (f32x2){b0[0], b0[1]} + t0; S[1] = sa2 * (f32x2){b0[2], b0[3]} + t1; \
            S[2] = sa2 * (f32x2){b1[0], b1[1]} + t2; S[3] = sa2 * (f32x2){b1[2], b1[3]} + t3; \
            const f32x2 q0 = S[1] * (f32x2){r0[2], r0[3]} + S[0] * (f32x2){r0[0], r0[1]}; \
            const f32x2 q1 = S[3] * (f32x2){r1[2], r1[3]} + S[2] * (f32x2){r1[0], r1[1]}; \
            const f32x2 yc = q0 + q1; \
            yv[s_] = red8(yc[0] + yc[1]); } while (0)
        RW_LD(opA, vvA, 0);
#pragma unroll
        for (int s = 0; s < 16; s += 2) {
            RW_LD(opB, vvB, s + 1);
            __builtin_amdgcn_sched_barrier(0);
            RW_COMP(opA, vvA, s);
            __builtin_amdgcn_sched_barrier(0);
            if (s + 2 < 16) RW_LD(opA, vvA, s + 2);
            __builtin_amdgcn_sched_barrier(0);
            RW_COMP(opB, vvB, s + 1);
            __builtin_amdgcn_sched_barrier(0);
        }
#undef RW_LD
#undef RW_COMP
#pragma unroll
        for (int s = 0; s < 16; ++s) if ((s & 7) == kq) ybuf[((bi * 16 + s) * 64) + vrow] = yv[s];
        }
        __syncthreads();
    }
    if (!comp) RW_FLUSH(NCH - 1);
    __syncthreads();
#undef RW_ISSUE
#undef RW_WRITE
#undef RW_FLUSH
}

constexpr size_t WS_RWSCR = WS_YHY;
constexpr int RWS_QY = 0, RWS_YV = 2048, RWS_PZ = 4096, RWS_ZV = 12288, RWS_SLOT = 20480;
typedef __bf16 bf16x8n __attribute__((ext_vector_type(8)));
__device__ __forceinline__ f32x4 mma16(const bf16x8 a, const bf16x8 b, const f32x4 c) { return __builtin_amdgcn_mfma_f32_16x16x32_bf16(a, b, c, 0, 0, 0); }
__device__ __forceinline__ float dpp_shr(float x, const int n) {
    const int v = __builtin_bit_cast(int, x); int r;
    if (n == 1) r = __builtin_amdgcn_update_dpp(0, v, 0x111, 0xF, 0xF, true); else if (n == 2) r = __builtin_amdgcn_update_dpp(0, v, 0x112, 0xF, 0xF, true);
    else if (n == 4) r = __builtin_amdgcn_update_dpp(0, v, 0x114, 0xF, 0xF, true); else r = __builtin_amdgcn_update_dpp(0, v, 0x118, 0xF, 0xF, true);
    return __builtin_bit_cast(float, r);
}
__device__ __forceinline__ v4u pack8(const float (&x)[8]) { v4u o; o.x = pk2(x[0], x[1]); o.y = pk2(x[2], x[3]); o.z = pk2(x[4], x[5]); o.w = pk2(x[6], x[7]); return o; }
__device__ __forceinline__ void unpack8(const v4u u, float (&x)[8]) { x[0] = bflo(u.x); x[1] = bfhi(u.x); x[2] = bflo(u.y); x[3] = bfhi(u.y); x[4] = bflo(u.z); x[5] = bfhi(u.z); x[6] = bflo(u.w); x[7] = bfhi(u.w); }
constexpr int LDS_ZERO16 = 131072 + 3072;
__device__ __forceinline__ bf16x8 frag16z(const LAS bf16* m, int rowbase, int lane, const LAS v4u* z) {
    const LAS v4u* p = (const LAS v4u*)(m + (rowbase + (lane & 15)) * 16 + 8 * (lane >> 4));
    const v4u v = *(((lane >> 4) < 2) ? p : z); return __builtin_bit_cast(bf16x8, v); }
#define frag16(m_, rb_, ln_) frag16z(m_, rb_, ln_, zp16)
__device__ __forceinline__ void st_colmaj(LAS bf16* m, int colbase, const f32x4 d, int lane) {
    v2u o; o.x = pk2(d[0], d[1]); o.y = pk2(d[2], d[3]); *(LAS v2u*)(m + (colbase + (lane & 15)) * 16 + 4 * (lane >> 4)) = o; }
__device__ __forceinline__ void st_rowmaj(LAS bf16* m, const f32x4 d, int lane) {
#pragma unroll
    for (int r = 0; r < 4; ++r) m[(4 * (lane >> 4) + r) * 16 + (lane & 15)] = (bf16)f2bf(d[r]); }
template <int KS0, int KS1>
__device__ __forceinline__ void rw_chunk_load(const Ctx& F, int b, int h, int d, int cidx, v4u (&raw)[12]) {
    const int lane = opaque_v(F.lane), t = lane & 15, kg = lane >> 4;
    const bf16* base = (const bf16*)(F.a->ws + WS_SCN) + (size_t)seq_row(b, d, 16 * cidx + t) * 9 * 512 + h * 64;
#pragma unroll
    for (int ks = KS0; ks < KS1; ++ks) { const int off = 32 * ks + 8 * kg;
        raw[6 * ks + 0] = *(const v4u*)(base + (3 + 3 * d) * 512 + off); raw[6 * ks + 1] = *(const v4u*)(base + 2 * 512 + off); raw[6 * ks + 2] = *(const v4u*)(base + off);
        raw[6 * ks + 3] = *(const v4u*)(base + (5 + 3 * d) * 512 + off); raw[6 * ks + 4] = *(const v4u*)(base + (4 + 3 * d) * 512 + off); raw[6 * ks + 5] = *(const v4u*)(base + 512 + off); }
}
__device__ __forceinline__ void rw_chunk_task(const Ctx& F, const v4u (&raw)[12], LAS unsigned char* wl, unsigned char* slot) {
    const LAS v4u* zp16 = (const LAS v4u*)(F.lds + LDS_ZERO16);
    const int lane = opaque_v(F.lane), t = lane & 15, kg = lane >> 4;
    LAS bf16* ATt = (LAS bf16*)(wl); LAS bf16* RBr = (LAS bf16*)(wl + 2048); LAS bf16* BHt = (LAS bf16*)(wl + 4096); LAS bf16* KHt = (LAS bf16*)(wl + 6144); LAS bf16* VTt = (LAS bf16*)(wl + 8192);
    LAS bf16* WAt = (LAS bf16*)(wl + 10240); LAS bf16* N_r = (LAS bf16*)(wl + 12288); LAS bf16* N_c = (LAS bf16*)(wl + 12800); LAS bf16* T_r = (LAS bf16*)(wl + 13312);
    LAS bf16* AK_r = (LAS bf16*)(wl + 13824); LAS bf16* RB2 = (LAS bf16*)(wl + 14336); LAS bf16* RK_r = (LAS bf16*)(wl + 14848); LAS float* GCl = (LAS float*)(wl + 15360);
    bf16x8 fAb[2], fRb[2], fBb[2], fKb[2];
#pragma unroll
    for (int ks = 0; ks < 2; ++ks) {
        const int off = 32 * ks + 8 * kg;
        float ea[8], er[8], eb[8], eh[8];
        { const v4u uld = raw[6 * ks + 0]; float ld[8]; unpack8(uld, ld);
#pragma unroll
          for (int j = 0; j < 8; ++j) { float c = ld[j]; c += dpp_shr(c, 1); c += dpp_shr(c, 2); c += dpp_shr(c, 4); c += dpp_shr(c, 8);
              const float tot = __builtin_bit_cast(float, __builtin_amdgcn_ds_bpermute((lane | 15) << 2, __builtin_bit_cast(int, c)));
              ea[j] = __expf(c - ld[j]); er[j] = __expf(c); eb[j] = __expf(-c); eh[j] = __expf(tot - c);
              if (t == 0) GCl[off + j] = __expf(tot); } }
        { const v4u u = raw[6 * ks + 1]; float x[8]; unpack8(u, x);
#pragma unroll
          for (int j = 0; j < 8; ++j) { x[j] = -x[j] * ea[j]; ATt[(off + j) * 16 + t] = (bf16)f2bf(x[j]); }
          const v4u p = pack8(x); fAb[ks] = __builtin_bit_cast(bf16x8, p); }
        { const v4u u = raw[6 * ks + 2]; float x[8]; unpack8(u, x);
#pragma unroll
          for (int j = 0; j < 8; ++j) x[j] = x[j] * er[j];
          const v4u p = pack8(x); fRb[ks] = __builtin_bit_cast(bf16x8, p); *(LAS v4u*)(RBr + t * 64 + off) = p; }
        { const v4u u = raw[6 * ks + 3]; float x[8], y[8]; unpack8(u, x);
#pragma unroll
          for (int j = 0; j < 8; ++j) { y[j] = x[j] * eb[j]; BHt[(off + j) * 16 + t] = (bf16)f2bf(x[j] * eh[j]); }
          const v4u p = pack8(y); fBb[ks] = __builtin_bit_cast(bf16x8, p); }
        { const v4u u = raw[6 * ks + 4]; float x[8], y[8]; unpack8(u, x);
#pragma unroll
          for (int j = 0; j < 8; ++j) { y[j] = x[j] * eb[j]; KHt[(off + j) * 16 + t] = (bf16)f2bf(x[j] * eh[j]); }
          const v4u p = pack8(y); fKb[ks] = __builtin_bit_cast(bf16x8, p); }
        { const v4u u = raw[6 * ks + 5];
          const bf16 e0 = (bf16)(u.x & 0xffff), e1 = (bf16)(u.x >> 16), e2 = (bf16)(u.y & 0xffff), e3 = (bf16)(u.y >> 16), e4 = (bf16)(u.z & 0xffff), e5 = (bf16)(u.z >> 16), e6 = (bf16)(u.w & 0xffff), e7 = (bf16)(u.w >> 16);
          VTt[(off + 0) * 16 + t] = e0; VTt[(off + 1) * 16 + t] = e1; VTt[(off + 2) * 16 + t] = e2; VTt[(off + 3) * 16 + t] = e3; VTt[(off + 4) * 16 + t] = e4; VTt[(off + 5) * 16 + t] = e5; VTt[(off + 6) * 16 + t] = e6; VTt[(off + 7) * 16 + t] = e7; }
        __builtin_amdgcn_sched_barrier(0);
    }
    asm volatile("" ::: "memory");
    const f32x4 z4 = (f32x4){0.f, 0.f, 0.f, 0.f};
    f32x4 n0 = mma16(fAb[1], fBb[1], mma16(fAb[0], fBb[0], z4)), aak = mma16(fAb[1], fKb[1], mma16(fAb[0], fKb[0], z4));
    f32x4 arb = mma16(fRb[1], fBb[1], mma16(fRb[0], fBb[0], z4)), ark = mma16(fRb[1], fKb[1], mma16(fRb[0], fKb[0], z4));
#pragma unroll
    for (int r = 0; r < 4; ++r) { const int tt = 4 * kg + r; if (!(t < tt)) { n0[r] = 0.f; aak[r] = 0.f; } if (!(t <= tt)) { arb[r] = 0.f; ark[r] = 0.f; } }
    st_rowmaj(AK_r, aak, lane); st_rowmaj(RB2, arb, lane); st_rowmaj(RK_r, ark, lane); asm volatile("" ::: "memory");
    f32x4 accT = n0;
#pragma unroll
    for (int r = 0; r < 4; ++r) accT[r] += (4 * kg + r == t) ? 1.f : 0.f;
    f32x4 nn = n0;
#pragma unroll
    for (int itn = 0; itn < 3; ++itn) {
        st_rowmaj(N_r, nn, lane); st_colmaj(N_c, 0, nn, lane); st_rowmaj(T_r, accT, lane); asm volatile("" ::: "memory");
        const bf16x8 fa = frag16(N_r, 0, lane), fb = frag16(N_c, 0, lane), ft = frag16(T_r, 0, lane);
        nn = mma16(fa, fb, z4); asm volatile("" ::: "memory");
        st_colmaj(N_c, 0, nn, lane); asm volatile("" ::: "memory");
        const bf16x8 fb2 = frag16(N_c, 0, lane);
        accT = mma16(ft, fb2, accT); asm volatile("" ::: "memory");
    }
    st_rowmaj(T_r, accT, lane); asm volatile("" ::: "memory");
    const bf16x8 fT = frag16(T_r, 0, lane), fAK = frag16(AK_r, 0, lane), fARB = frag16(RB2, 0, lane), fARK = frag16(RK_r, 0, lane);
#pragma unroll
    for (int kt = 0; kt < 4; ++kt) { const f32x4 dd = mma16(fT, frag16(ATt, 16 * kt, lane), z4); st_colmaj(WAt, 16 * kt, dd, lane); } asm volatile("" ::: "memory");
    { const bf16x8 fArbT = frag16(RB2, 0, lane);
#pragma unroll
      for (int kt = 0; kt < 4; ++kt) { const v2u ri = *(const LAS v2u*)(RBr + t * 64 + 16 * kt + 4 * kg);
          f32x4 c0 = (f32x4){bflo(ri.x), bfhi(ri.x), bflo(ri.y), bfhi(ri.y)};
          c0 = mma16(frag16(WAt, 16 * kt, lane), fArbT, c0);
          v2u o; o.x = pk2(c0[0], c0[1]); o.y = pk2(c0[2], c0[3]); *(v2u*)(slot + RWS_QY + (t * 64 + 16 * kt + 4 * kg) * 2) = o; } }
    asm volatile("" ::: "memory");
#pragma unroll
    for (int vt = 0; vt < 4; ++vt) { const f32x4 dd = mma16(fAK, frag16(VTt, 16 * vt, lane), z4); st_colmaj(ATt, 16 * vt, dd, lane); } asm volatile("" ::: "memory");
    asm volatile("" ::: "memory");
    LAS bf16* UVt = RBr;
#pragma unroll
    for (int vt = 0; vt < 4; ++vt) { const f32x4 dd = mma16(fT, frag16(ATt, 16 * vt, lane), z4); st_colmaj(UVt, 16 * vt, dd, lane); } asm volatile("" ::: "memory");
#pragma unroll
    for (int vt = 0; vt < 4; ++vt) { const f32x4 dd = mma16(fARK, frag16(VTt, 16 * vt, lane), mma16(fARB, frag16(UVt, 16 * vt, lane), z4));
        v2u o; o.x = pk2(dd[0], dd[1]); o.y = pk2(dd[2], dd[3]); *(v2u*)(slot + RWS_YV + ((16 * vt + t) * 16 + 4 * kg) * 2) = o; }
#pragma unroll
    for (int ktp = 0; ktp < 4; ++ktp) { const bf16x8 fBh = frag16(BHt, 16 * ktp, lane);
#pragma unroll
        for (int kt = 0; kt < 4; ++kt) { f32x4 dd = mma16(frag16(WAt, 16 * kt, lane), fBh, z4);
            if (kt == ktp) {
#pragma unroll
                for (int r = 0; r < 4; ++r) if (4 * kg + r == t) dd[r] += GCl[16 * kt + t]; }
            v2u o; o.x = pk2(dd[0], dd[1]); o.y = pk2(dd[2], dd[3]); *(v2u*)(slot + RWS_PZ + ((16 * ktp + t) * 64 + 16 * kt + 4 * kg) * 2) = o; } }
#pragma unroll
    for (int vt = 0; vt < 4; ++vt) { const bf16x8 fU = frag16(UVt, 16 * vt, lane), fV = frag16(VTt, 16 * vt, lane);
#pragma unroll
        for (int ktp = 0; ktp < 4; ++ktp) { const f32x4 dd = mma16(frag16(KHt, 16 * ktp, lane), fV, mma16(frag16(BHt, 16 * ktp, lane), fU, z4));
            v2u o; o.x = pk2(dd[0], dd[1]); o.y = pk2(dd[2], dd[3]); *(v2u*)(slot + RWS_ZV + ((16 * vt + t) * 64 + 16 * ktp + 4 * kg) * 2) = o; } }
}
__device__ __forceinline__ void rw_chunk_task2(const Ctx& F, const v4u (&raw)[12], LAS unsigned char* wl, f32x4 (&yv)[4], f32x4 (&zv)[4][4]) {
    const LAS v4u* zp16 = (const LAS v4u*)(F.lds + LDS_ZERO16);
    const int lane = opaque_v(F.lane), t = lane & 15, kg = lane >> 4;
    LAS bf16* ATt = (LAS bf16*)(wl); LAS bf16* RBr = (LAS bf16*)(wl + 2048); LAS bf16* BHt = (LAS bf16*)(wl + 4096); LAS bf16* KHt = (LAS bf16*)(wl + 6144); LAS bf16* VTt = (LAS bf16*)(wl + 8192);
    LAS bf16* WAt = (LAS bf16*)(wl + 10240); LAS bf16* N_r = (LAS bf16*)(wl + 12288); LAS bf16* N_c = (LAS bf16*)(wl + 12800); LAS bf16* T_r = (LAS bf16*)(wl + 13312);
    LAS bf16* AK_r = (LAS bf16*)(wl + 13824); LAS bf16* RB2 = (LAS bf16*)(wl + 14336); LAS bf16* RK_r = (LAS bf16*)(wl + 14848); LAS float* GCl = (LAS float*)(wl + 15360);
    bf16x8 fAb[2], fRb[2], fBb[2], fKb[2];
#pragma unroll
    for (int ks = 0; ks < 2; ++ks) {
        const int off = 32 * ks + 8 * kg;
        float ea[8], er[8], eb[8], eh[8];
        { const v4u uld = raw[6 * ks + 0]; float ld[8]; unpack8(uld, ld);
#pragma unroll
          for (int j = 0; j < 8; ++j) { float c = ld[j]; c += dpp_shr(c, 1); c += dpp_shr(c, 2); c += dpp_shr(c, 4); c += dpp_shr(c, 8);
              const float tot = __builtin_bit_cast(float, __builtin_amdgcn_ds_bpermute((lane | 15) << 2, __builtin_bit_cast(int, c)));
              ea[j] = __expf(c - ld[j]); er[j] = __expf(c); eb[j] = __expf(-c); eh[j] = __expf(tot - c);
              if (t == 0) GCl[off + j] = __expf(tot); } }
        { const v4u u = raw[6 * ks + 1]; float x[8]; unpack8(u, x);
#pragma unroll
          for (int j = 0; j < 8; ++j) { x[j] = -x[j] * ea[j]; ATt[(off + j) * 16 + t] = (bf16)f2bf(x[j]); }
          const v4u p = pack8(x); fAb[ks] = __builtin_bit_cast(bf16x8, p); }
        { const v4u u = raw[6 * ks + 2]; float x[8]; unpack8(u, x);
#pragma unroll
          for (int j = 0; j < 8; ++j) x[j] = x[j] * er[j];
          const v4u p = pack8(x); fRb[ks] = __builtin_bit_cast(bf16x8, p); *(LAS v4u*)(RBr + t * 64 + off) = p; }
        { const v4u u = raw[6 * ks + 3]; float x[8], y[8]; unpack8(u, x);
#pragma unroll
          for (int j = 0; j < 8; ++j) { y[j] = x[j] * eb[j]; BHt[(off + j) * 16 + t] = (bf16)f2bf(x[j] * eh[j]); }
          const v4u p = pack8(y); fBb[ks] = __builtin_bit_cast(bf16x8, p); }
        { const v4u u = raw[6 * ks + 4]; float x[8], y[8]; unpack8(u, x);
#pragma unroll
          for (int j = 0; j < 8; ++j) { y[j] = x[j] * eb[j]; KHt[(off + j) * 16 + t] = (bf16)f2bf(x[j] * eh[j]); }
          const v4u p = pack8(y); fKb[ks] = __builtin_bit_cast(bf16x8, p); }
        { const v4u u = raw[6 * ks + 5];
          const bf16 e0 = (bf16)(u.x & 0xffff), e1 = (bf16)(u.x >> 16), e2 = (bf16)(u.y & 0xffff), e3 = (bf16)(u.y >> 16), e4 = (bf16)(u.z & 0xffff), e5 = (bf16)(u.z >> 16), e6 = (bf16)(u.w & 0xffff), e7 = (bf16)(u.w >> 16);
          VTt[(off + 0) * 16 + t] = e0; VTt[(off + 1) * 16 + t] = e1; VTt[(off + 2) * 16 + t] = e2; VTt[(off + 3) * 16 + t] = e3; VTt[(off + 4) * 16 + t] = e4; VTt[(off + 5) * 16 + t] = e5; VTt[(off + 6) * 16 + t] = e6; VTt[(off + 7) * 16 + t] = e7; }
        __builtin_amdgcn_sched_barrier(0);
    }
    asm volatile("" ::: "memory");
    const f32x4 z4 = (f32x4){0.f, 0.f, 0.f, 0.f};
    f32x4 n0 = mma16(fAb[1], fBb[1], mma16(fAb[0], fBb[0], z4)), aak = mma16(fAb[1], fKb[1], mma16(fAb[0], fKb[0], z4));
    f32x4 arb = mma16(fRb[1], fBb[1], mma16(fRb[0], fBb[0], z4)), ark = mma16(fRb[1], fKb[1], mma16(fRb[0], fKb[0], z4));
#pragma unroll
    for (int r = 0; r < 4; ++r) { const int tt = 4 * kg + r; if (!(t < tt)) { n0[r] = 0.f; aak[r] = 0.f; } if (!(t <= tt)) { arb[r] = 0.f; ark[r] = 0.f; } }
    st_rowmaj(AK_r, aak, lane); st_rowmaj(RB2, arb, lane); st_rowmaj(RK_r, ark, lane); asm volatile("" ::: "memory");
    f32x4 accT = n0;
#pragma unroll
    for (int r = 0; r < 4; ++r) accT[r] += (4 * kg + r == t) ? 1.f : 0.f;
    f32x4 nn = n0;
#pragma unroll
    for (int itn = 0; itn < 3; ++itn) {
        st_rowmaj(N_r, nn, lane); st_colmaj(N_c, 0, nn, lane); st_rowmaj(T_r, accT, lane); asm volatile("" ::: "memory");
        const bf16x8 fa = frag16(N_r, 0, lane), fb = frag16(N_c, 0, lane), ft = frag16(T_r, 0, lane);
        nn = mma16(fa, fb, z4); asm volatile("" ::: "memory");
        st_colmaj(N_c, 0, nn, lane); asm volatile("" ::: "memory");
        const bf16x8 fb2 = frag16(N_c, 0, lane);
        accT = mma16(ft, fb2, accT); asm volatile("" ::: "memory");
    }
    st_rowmaj(T_r, accT, lane); asm volatile("" ::: "memory");
    const bf16x8 fT = frag16(T_r, 0, lane), fAK = frag16(AK_r, 0, lane), fARB = frag16(RB2, 0, lane), fARK = frag16(RK_r, 0, lane);
#pragma unroll
    for (int kt = 0; kt < 4; ++kt) { const f32x4 dd = mma16(fT, frag16(ATt, 16 * kt, lane), z4); st_colmaj(WAt, 16 * kt, dd, lane); } asm volatile("" ::: "memory");
    f32x4 qy[4];
    { const bf16x8 fArbT = frag16(RB2, 0, lane);
#pragma unroll
      for (int kt = 0; kt < 4; ++kt) { const v2u ri = *(const LAS v2u*)(RBr + t * 64 + 16 * kt + 4 * kg);
          qy[kt] = mma16(frag16(WAt, 16 * kt, lane), fArbT, (f32x4){bflo(ri.x), bfhi(ri.x), bflo(ri.y), bfhi(ri.y)}); } }
    asm volatile("" ::: "memory");
#pragma unroll
    for (int vt = 0; vt < 4; ++vt) { const f32x4 dd = mma16(fAK, frag16(VTt, 16 * vt, lane), z4); st_colmaj(ATt, 16 * vt, dd, lane); } asm volatile("" ::: "memory");
    LAS bf16* UVt = RBr;
#pragma unroll
    for (int vt = 0; vt < 4; ++vt) { const f32x4 dd = mma16(fT, frag16(ATt, 16 * vt, lane), z4); st_colmaj(UVt, 16 * vt, dd, lane); } asm volatile("" ::: "memory");
#pragma unroll
    for (int vt = 0; vt < 4; ++vt) { const bf16x8 fU = frag16(UVt, 16 * vt, lane), fV = frag16(VTt, 16 * vt, lane);
        yv[vt] = mma16(fARK, fV, mma16(fARB, fU, z4));
#pragma unroll
        for (int ktp = 0; ktp < 4; ++ktp) zv[vt][ktp] = mma16(frag16(KHt, 16 * ktp, lane), fV, mma16(frag16(BHt, 16 * ktp, lane), fU, z4)); }
    f32x4 pz[4][4];
#pragma unroll
    for (int ktp = 0; ktp < 4; ++ktp) { const bf16x8 fBh = frag16(BHt, 16 * ktp, lane);
#pragma unroll
        for (int kt = 0; kt < 4; ++kt) { f32x4 dd = mma16(frag16(WAt, 16 * kt, lane), fBh, z4);
            if (kt == ktp) {
#pragma unroll
                for (int r = 0; r < 4; ++r) if (4 * kg + r == t) dd[r] += GCl[16 * kt + t]; }
            pz[ktp][kt] = dd; } }
    asm volatile("s_waitcnt lgkmcnt(0)" ::: "memory");
#pragma unroll
    for (int ktp = 0; ktp < 4; ++ktp) { LAS bf16* reg = (LAS bf16*)(wl + (ktp < 2 ? ktp * 2048 : (ktp + 1) * 2048));
#pragma unroll
        for (int kt = 0; kt < 4; ++kt) { v2u o; o.x = pk2(pz[ktp][kt][0], pz[ktp][kt][1]); o.y = pk2(pz[ktp][kt][2], pz[ktp][kt][3]); *(LAS v2u*)(reg + t * 64 + 16 * kt + 4 * kg) = o; } }
#pragma unroll
    for (int kt = 0; kt < 4; ++kt) { v2u o; o.x = pk2(qy[kt][0], qy[kt][1]); o.y = pk2(qy[kt][2], qy[kt][3]); *(LAS v2u*)(BHt + t * 64 + 16 * kt + 4 * kg) = o; }
    asm volatile("s_waitcnt lgkmcnt(0)" ::: "memory");
}
constexpr int RWZ_OFF = LDSCTL_OFF + 8192, RWF_OFF = LDSCTL_OFF + 2048;
__device__ __forceinline__ void rw_chunk_item2(const Ctx& F, int l, int it, size_t yoff = WS_YDIR) {
    const auto& a = *F.a; unsigned char* ws = a.ws; const int lane = opaque_v(F.lane), t = lane & 15, kg = lane >> 4;
    const int d = it & 1, h = (it >> 1) & 7, b = it >> 4;
    float* YD = (float*)(ws + yoff);
    LAS unsigned char* wl = F.lds + F.wave * 15616;
    LAS bf16* ZS = (LAS bf16*)(F.lds + RWZ_OFF);
    volatile LAS int* flag = (volatile LAS int*)(F.lds + RWF_OFF);
    for (int i = F.tid; i < 2048; i += NTHREADS) ((LAS unsigned*)ZS)[i] = 0u;
    if (F.tid == 0) *flag = 0;
    __syncthreads();
    constexpr int NCHK = (CTXL + SEQ) / 16;
    v4u raw[12];
    rw_chunk_load<0, 2>(F, b, h, d, F.wave, raw);
#pragma unroll 1
    for (int c = F.wave; c < NCHK; c += NWAVES) {
        f32x4 yv[4], zv[4][4];
        rw_chunk_task2(F, raw, wl, yv, zv);
        if (c + NWAVES < NCHK) rw_chunk_load<0, 2>(F, b, h, d, c + NWAVES, raw);
        while (*flag < c) __builtin_amdgcn_s_sleep(1);
        asm volatile("" ::: "memory");
        const LAS bf16* Zc = ZS + (c & 1) * 4096; LAS bf16* Zn = ZS + ((c + 1) & 1) * 4096;
        bf16x8 zb[4][2];
#pragma unroll
        for (int vb = 0; vb < 4; ++vb)
#pragma unroll
            for (int ks = 0; ks < 2; ++ks) zb[vb][ks] = *(const LAS bf16x8*)(Zc + (16 * vb + t) * 64 + 32 * ks + 8 * kg);
        { const LAS bf16* Qr = (const LAS bf16*)(wl + 4096); const bf16x8 q0 = *(const LAS bf16x8*)(Qr + t * 64 + 8 * kg), q1 = *(const LAS bf16x8*)(Qr + t * 64 + 32 + 8 * kg);
#pragma unroll
          for (int vb = 0; vb < 4; ++vb) { const f32x4 y = mma16(q1, zb[vb][1], mma16(q0, zb[vb][0], yv[vb]));
#pragma unroll
              for (int r = 0; r < 4; ++r) { const int row = seq_row(b, d, c * 16 + 4 * kg + r); YD[((size_t)d * T_ALL + row) * 512 + h * 64 + 16 * vb + t] = y[r]; } } }
#pragma unroll
        for (int ktp = 0; ktp < 4; ++ktp) { const LAS bf16* Pr = (const LAS bf16*)(wl + (ktp < 2 ? ktp * 2048 : (ktp + 1) * 2048));
            const bf16x8 p0 = *(const LAS bf16x8*)(Pr + t * 64 + 8 * kg), p1 = *(const LAS bf16x8*)(Pr + t * 64 + 32 + 8 * kg);
#pragma unroll
            for (int vb = 0; vb < 4; ++vb) { const f32x4 z = mma16(p1, zb[vb][1], mma16(p0, zb[vb][0], zv[vb][ktp]));
                v2u o; o.x = pk2(z[0], z[1]); o.y = pk2(z[2], z[3]); *(LAS v2u*)(Zn + (16 * vb + t) * 64 + 16 * ktp + 4 * kg) = o; } }
        asm volatile("s_waitcnt lgkmcnt(0)" ::: "memory");
        if (lane == 0) *flag = c + 1;
        asm volatile("s_waitcnt lgkmcnt(0)" ::: "memory");
    }
    __syncthreads();
}
__device__ __forceinline__ v2u ld_sc1_8(const void* p) { const unsigned long long v = __hip_atomic_load((const unsigned long long*)p, __ATOMIC_RELAXED, __HIP_MEMORY_SCOPE_AGENT); v2u o; o.x = (unsigned)v; o.y = (unsigned)(v >> 32); return o; }
__device__ __forceinline__ v4u ld_sc1_16(const void* p) { const v2u a = ld_sc1_8(p), b = ld_sc1_8((const char*)p + 8); return (v4u){a.x, a.y, b.x, b.y}; }
__device__ __forceinline__ void rw_chunk_item(const Ctx& F, int l, int it) {
    const auto& a = *F.a; unsigned char* ws = a.ws; const int lane = F.lane, t = lane & 15, kg = lane >> 4;
    const int d = it & 1, h = (it >> 1) & 7, b = it >> 4;
    float* YD = (float*)(ws + WS_YDIR);
    unsigned char* scr = ws + WS_RWSCR + (size_t)F.bid * 16 * RWS_SLOT;
    LAS unsigned char* wl = F.lds + F.wave * 15616;
    LAS bf16* ZL = (LAS bf16*)(F.lds + LDSCTL_OFF + 4096 + (F.wave & 3) * 2048);
    if (F.wave < 4) { for (int i = lane; i < 512; i += 64) ((LAS unsigned*)ZL)[i] = 0u; }
    asm volatile("" ::: "memory");
    constexpr int NCHK = (CTXL + SEQ) / 16, NB = NCHK / 16;
#pragma unroll 1
    for (int bt = 0; bt < NB; ++bt) {
        { v4u cur[12];
#pragma unroll 1
          for (int jj = 0; jj < 2; ++jj) { rw_chunk_load<0, 2>(F, b, h, d, bt * 16 + F.wave + 8 * jj, cur); rw_chunk_task(F, cur, wl, scr + (size_t)(F.wave + 8 * jj) * RWS_SLOT); } }
        asm volatile("s_waitcnt vmcnt(0)" ::: "memory");
        __syncthreads();
        {
            const int t = opaque_v(lane & 15), kg = opaque_v(lane >> 4), vb = opaque(F.wave) & 3;
            const unsigned char* scrb = F.a->ws + WS_RWSCR + (size_t)opaque(F.bid) * 16 * RWS_SLOT;
            LAS unsigned char* sbuf = F.lds;
            const int lt = opaque_v(F.tid) & 255; const bool loader = F.wave >= 4;
            const int lw = opaque(F.wave) & 3;
#define RWB_ISSUE(j_) do { const unsigned char* gp_ = scrb + (size_t)(j_) * RWS_SLOT + (size_t)(lw * 5) * 1024 + lane * 16; LAS unsigned char* lp_ = sbuf + ((j_) % 6) * RWS_SLOT + (lw * 5) * 1024; \
                _Pragma("unroll") for (int q = 0; q < 5; ++q) __builtin_amdgcn_global_load_lds((const unsigned*)(gp_ + q * 1024), (LAS unsigned*)(lp_ + q * 1024), 16, 0, 16); } while (0)
#define RWB_COMP(bi_, j_) do { const LAS unsigned char* sl_ = sbuf + (bi_) * RWS_SLOT; bf16x8 zb[2], qf[2]; \
                _Pragma("unroll") for (int ks = 0; ks < 2; ++ks) { zb[ks] = *(const LAS bf16x8*)(ZL + t * 64 + 32 * ks + 8 * kg); qf[ks] = *(const LAS bf16x8*)(sl_ + RWS_QY + (t * 64 + 32 * ks + 8 * kg) * 2); } \
                const v2u y_ = *(const LAS v2u*)(sl_ + RWS_YV + ((16 * vb + t) * 16 + 4 * kg) * 2); \
                f32x4 yacc = (f32x4){bflo(y_.x), bfhi(y_.x), bflo(y_.y), bfhi(y_.y)}; \
                yacc = mma16(qf[1], zb[1], mma16(qf[0], zb[0], yacc)); \
                f32x4 zn[4]; \
                _Pragma("unroll") for (int ktp = 0; ktp < 4; ++ktp) { const v2u z_ = *(const LAS v2u*)(sl_ + RWS_ZV + ((16 * vb + t) * 64 + 16 * ktp + 4 * kg) * 2); \
                    f32x4 zc = (f32x4){bflo(z_.x), bfhi(z_.x), bflo(z_.y), bfhi(z_.y)}; \
                    _Pragma("unroll") for (int ks = 0; ks < 2; ++ks) zc = mma16(*(const LAS bf16x8*)(sl_ + RWS_PZ + ((16 * ktp + t) * 64 + 32 * ks + 8 * kg) * 2), zb[ks], zc); \
                    zn[ktp] = zc; } \
                _Pragma("unroll") for (int r = 0; r < 4; ++r) { const int row = seq_row(b, d, (bt * 16 + (j_)) * 16 + 4 * kg + r); YD[((size_t)d * T_ALL + row) * 512 + h * 64 + 16 * vb + t] = yacc[r]; } \
                asm volatile("s_waitcnt lgkmcnt(0)" ::: "memory"); \
                _Pragma("unroll") for (int ktp = 0; ktp < 4; ++ktp) { v2u o; o.x = pk2(zn[ktp][0], zn[ktp][1]); o.y = pk2(zn[ktp][2], zn[ktp][3]); *(LAS v2u*)(ZL + t * 64 + 16 * ktp + 4 * kg) = o; } \
                asm volatile("s_waitcnt lgkmcnt(0)" ::: "memory"); } while (0)
#define RWB_BAR() do { asm volatile("s_waitcnt lgkmcnt(0)" ::: "memory"); __builtin_amdgcn_s_barrier(); asm volatile("" ::: "memory"); } while (0)
            if (loader) { RWB_ISSUE(0); RWB_ISSUE(1); RWB_ISSUE(2); RWB_ISSUE(3); asm volatile("s_waitcnt vmcnt(15)" ::: "memory"); }
            RWB_BAR();
#pragma unroll 1
            for (int j = 0; j < 16; ++j) {
                if (loader) { if (j + 4 < 16) { RWB_ISSUE(j + 4); asm volatile("s_waitcnt vmcnt(15)" ::: "memory"); } else { asm volatile("s_waitcnt vmcnt(0)" ::: "memory"); } }
                else { RWB_COMP(j % 6, j); }
                RWB_BAR();
            }
#undef RWB_BAR
#undef RWB_ISSUE
#undef RWB_COMP
        }
        __syncthreads();
    }
}

__device__ __forceinline__ void stage_rw_readout(const Ctx& F, int l) {
    const auto& a = *F.a; unsigned char* ws = a.ws; const int lane = F.lane;
    const bf16* SCN = (const bf16*)(ws + WS_SCN); const bf16* P = (const bf16*)(ws + WS_P); const float* YD = (const float*)(ws + WS_YDIR); bf16* YRW = (bf16*)(ws + WS_YRW);
    const int gw = F.bid * NWAVES + F.wave, NGW = F.G * NWAVES;
    constexpr int TR = 17, NRT = T_ALL / TR;
    for (int tile = gw; tile < NRT * 4; tile += NGW) {
        const int rt = tile % NRT, hp = tile / NRT, row0 = rt * TR, c0 = hp * 128 + 2 * lane;
        const f32x2 rk = *(const f32x2*)(a.in[I_RWRK] + l * 512 + c0), lng = *(const f32x2*)(a.in[I_RWLNG] + l * 512 + c0), lnb = *(const f32x2*)(a.in[I_RWLNB] + l * 512 + c0);
        unsigned sw_[8][5]; f32x2 yw_[8][2];
#define RO_LD(j_) do { const int rr_ = row0 + (j_); const unsigned* sp_ = (const unsigned*)(SCN + (size_t)rr_ * 9 * 512 + c0); \
        sw_[(j_) & 7][0] = sp_[0]; sw_[(j_) & 7][1] = sp_[256]; sw_[(j_) & 7][2] = sp_[4 * 256]; sw_[(j_) & 7][3] = sp_[7 * 256]; sw_[(j_) & 7][4] = *(const unsigned*)(P + (size_t)rr_ * 2560 + 2048 + c0); \
        yw_[(j_) & 7][0] = *(const f32x2*)(YD + (size_t)rr_ * 512 + c0); yw_[(j_) & 7][1] = *(const f32x2*)(YD + ((size_t)T_ALL + rr_) * 512 + c0); } while (0)
        RO_LD(0); RO_LD(1); RO_LD(2);
#pragma unroll
        for (int i = 0; i < TR; ++i) {
            const int row = row0 + i;
            if (i + 3 < TR) RO_LD(i + 3);
            const unsigned ru = sw_[i & 7][0], vu = sw_[i & 7][1], k0u = sw_[i & 7][2], k1u = sw_[i & 7][3], gu = sw_[i & 7][4];
            const f32x2 y0 = yw_[i & 7][0], y1 = yw_[i & 7][1];
            const float bon = red32(bflo(ru) * (bflo(k0u) + bflo(k1u)) * rk[0] + bfhi(ru) * (bfhi(k0u) + bfhi(k1u)) * rk[1]);
            f32x2 y = y0 + y1 + (f32x2){bflo(vu), bfhi(vu)} * bon;
            const float mu = red32(y[0] + y[1]) * (1.f / 64.f);
            y = y - mu;
            const float var = red32(y[0] * y[0] + y[1] * y[1]) * (1.f / 64.f);
            const f32x2 yn = y * (__builtin_amdgcn_rsqf(var + 64e-5f));
            const f32x2 ov = (yn * lng + lnb) * (f32x2){bflo(gu), bfhi(gu)};
            *(unsigned*)(YRW + (size_t)row * 512 + c0) = pk2(ov[0], ov[1]);
        }
    }
}
#undef RO_LD

constexpr size_t WS_S5E = 6 * MiB;
constexpr int S5_NSEG = 4, S5_SEGLEN = (CTXL + SEQ) / S5_NSEG;
__device__ __forceinline__ void s5_disc(const float are, const float aim, const float dt, float& lbr, float& lbi, float& cr, float& ci) {
    const float mag = expf(are * dt); lbr = mag * cosf(aim * dt); lbi = mag * sinf(aim * dt);
    const float den = are * are + aim * aim, nr = lbr - 1.0f; cr = (nr * are + lbi * aim) / den; ci = (lbi * are - nr * aim) / den;
}
template <int PASS>
__device__ __forceinline__ void stage_s5_scan(const Ctx& F, int l) {
    const auto& a = *F.a; unsigned char* ws = a.ws; const int lane = F.lane;
    const bf16* Z = (const bf16*)(ws + WS_Z); float* YP = (float*)(ws + WS_YP); f32x2* S5E = (f32x2*)(ws + WS_S5E);
    LAS unsigned char* wl = F.lds + F.wave * 16384;
    LAS float* buL = (LAS float*)wl;
    LAS bf16* Hs = (LAS bf16*)(wl + 8704);
    const int fr = lane & 15, kg = lane >> 4;
    for (int itx = F.bid * NWAVES + F.wave; itx < BATCH * 32 * 2 * S5_NSEG; itx += NWAVES * F.G) {
        const int seg = itx & (S5_NSEG - 1), it = itx >> 2;
        const int d = it & 1, g = (it >> 1) & 31, b = it >> 6, p = lane;
        const float dt = expf(a.in[I_S5LDT][(l * 2 + d) * 32 + g]);
        const float* arep = a.in[I_S5ARE] + ((size_t)(l * 2 + d) * 32 + g) * 64; const float* aimp = a.in[I_S5AIM] + ((size_t)(l * 2 + d) * 32 + g) * 64;
        float lbr, lbi, cr_, ci_; s5_disc(arep[p], aimp[p], dt, lbr, lbi, cr_, ci_);
        bf16x8 afr[2][4];
#pragma unroll
        for (int tl = 0; tl < 4; ++tl) { const int pp = 16 * tl + fr; float r0_, r1_, cr, ci; s5_disc(arep[pp], aimp[pp], dt, r0_, r1_, cr, ci);
            v4u pr = (v4u){0u, 0u, 0u, 0u}, pi = (v4u){0u, 0u, 0u, 0u};
            if (kg < 2) { const float* br = a.in[I_S5BRE] + (((size_t)l * 32 + g) * 64 + pp) * 16 + 8 * kg; const float* bi = a.in[I_S5BIM] + (((size_t)l * 32 + g) * 64 + pp) * 16 + 8 * kg;
                const f32x4 x0 = *(const f32x4*)br, x1 = *(const f32x4*)(br + 4), y0 = *(const f32x4*)bi, y1 = *(const f32x4*)(bi + 4);
                pr.x = pk2(cr * x0[0] - ci * y0[0], cr * x0[1] - ci * y0[1]); pr.y = pk2(cr * x0[2] - ci * y0[2], cr * x0[3] - ci * y0[3]);
                pr.z = pk2(cr * x1[0] - ci * y1[0], cr * x1[1] - ci * y1[1]); pr.w = pk2(cr * x1[2] - ci * y1[2], cr * x1[3] - ci * y1[3]);
                pi.x = pk2(cr * y0[0] + ci * x0[0], cr * y0[1] + ci * x0[1]); pi.y = pk2(cr * y0[2] + ci * x0[2], cr * y0[3] + ci * x0[3]);
                pi.z = pk2(cr * y1[0] + ci * x1[0], cr * y1[1] + ci * x1[1]); pi.w = pk2(cr * y1[2] + ci * x1[2], cr * y1[3] + ci * x1[3]); }
            afr[0][tl] = __builtin_bit_cast(bf16x8, pr); afr[1][tl] = __builtin_bit_cast(bf16x8, pi); }
        bf16x8 cf[4];
        f32x2 hst = (f32x2){0.f, 0.f};
        if (PASS == 1) {
#pragma unroll
            for (int kk = 0; kk < 4; ++kk) { const int p0 = 16 * kk + 4 * kg;
                const f32x4 c0 = *(const f32x4*)(a.in[I_S5CRE] + (((size_t)l * 32 + g) * 16 + fr) * 64 + p0), c1 = *(const f32x4*)(a.in[I_S5CIM] + (((size_t)l * 32 + g) * 16 + fr) * 64 + p0);
                v4u pk; pk.x = pk2(c0[0], -c1[0]); pk.y = pk2(c0[1], -c1[1]); pk.z = pk2(c0[2], -c1[2]); pk.w = pk2(c0[3], -c1[3]);
                cf[kk] = __builtin_bit_cast(bf16x8, pk); }
            float pr_ = lbr, pi_ = lbi, l64r = 1.f, l64i = 0.f;
#pragma unroll 1
            for (int q = 0; q < 10; ++q) { const float nr2 = pr_ * pr_ - pi_ * pi_, ni2 = 2.f * pr_ * pi_; pr_ = nr2; pi_ = ni2; if (q == 5) { l64r = pr_; l64i = pi_; } }
            const float lLr = pr_ * l64r - pi_ * l64i, lLi = pr_ * l64i + pi_ * l64r;
#pragma unroll 1
            for (int sgi = 0; sgi < seg; ++sgi) { const f32x2 ev = S5E[((size_t)it * S5_NSEG + sgi) * 64 + p];
                hst = (f32x2){lLr * hst[0] - lLi * hst[1] + ev[0], lLr * hst[1] + lLi * hst[0] + ev[1]}; }
        }
        const f32x2 lbr2 = (f32x2){lbr, lbr}, lbi2 = (f32x2){lbi, lbi};
        const int sbeg = seg * S5_SEGLEN, send = sbeg + S5_SEGLEN;
        v4u u0 = (v4u){0u, 0u, 0u, 0u}, u1 = u0, u2 = u0, u3 = u0;
#define S5_LOADU(dst_, s0_) do { const int sx_ = ((s0_) < send) ? (s0_) : (send - 16); const int row_ = seq_row(b, d, sx_ + fr); dst_ = *(const v4u*)(Z + (size_t)row_ * IN_COLS + S5_OFF + g * 16 + (kg & 1) * 8); } while (0)
#define S5_CHUNK(ux_, sc_) do { \
            { const v4u um_ = (kg < 2) ? ux_ : (v4u){0u, 0u, 0u, 0u}; const bf16x8 ufr = __builtin_bit_cast(bf16x8, um_); \
              _Pragma("unroll") for (int c = 0; c < 2; ++c) _Pragma("unroll") for (int tl = 0; tl < 4; ++tl) { \
                const f32x4 dd = __builtin_amdgcn_mfma_f32_16x16x32_bf16(afr[c][tl], ufr, (f32x4){0.f, 0.f, 0.f, 0.f}, 0, 0, 0); *(LAS f32x4*)(buL + (c * 16 + fr) * 68 + 16 * tl + 4 * kg) = dd; } } \
            S5_LOADU(ux_, (sc_) + 64); \
            LDS_WAIT(); asm volatile("" ::: "memory"); \
            f32x2 bu[16]; \
            _Pragma("unroll") for (int s = 0; s < 16; ++s) bu[s] = (f32x2){buL[s * 68 + p], buL[(16 + s) * 68 + p]}; \
            _Pragma("unroll") for (int s = 0; s < 16; ++s) { const float tr_ = __builtin_fmaf(-lbi, hst[1], bu[s][0]), ti_ = __builtin_fmaf(lbi, hst[0], bu[s][1]); \
                hst = (f32x2){__builtin_fmaf(lbr, hst[0], tr_), __builtin_fmaf(lbr, hst[1], ti_)}; \
                if (PASS == 1) *(LAS unsigned*)(Hs + s * 136 + 2 * p) = pg8::cvt_pk_bf16(hst[0], hst[1]); } \
            if (PASS == 1) { LDS_WAIT(); asm volatile("" ::: "memory"); \
                f32x4 acc = (f32x4){0.f, 0.f, 0.f, 0.f}; \
                _Pragma("unroll") for (int kk = 0; kk < 4; ++kk) { const bf16x8 af = *(const LAS bf16x8*)(Hs + fr * 136 + 32 * kk + 8 * kg); acc = __builtin_amdgcn_mfma_f32_16x16x32_bf16(af, cf[kk], acc, 0, 0, 0); } \
                _Pragma("unroll") for (int r = 0; r < 4; ++r) { const int row = seq_row(b, d, (sc_) + 4 * kg + r); YP[((size_t)d * T_ALL + row) * 512 + g * 16 + fr] = acc[r]; } } \
            LDS_WAIT(); asm volatile("" ::: "memory"); } while (0)
        S5_LOADU(u0, sbeg); S5_LOADU(u1, sbeg + 16); S5_LOADU(u2, sbeg + 32); S5_LOADU(u3, sbeg + 48);
#pragma unroll 1
        for (int s0 = sbeg; s0 < send; s0 += 64) { S5_CHUNK(u0, s0); S5_CHUNK(u1, s0 + 16); S5_CHUNK(u2, s0 + 32); S5_CHUNK(u3, s0 + 48); }
#undef S5_CHUNK
        if (PASS == 0) S5E[((size_t)it * S5_NSEG + seg) * 64 + p] = hst;
#undef S5_LOADU
    }
}

__device__ __forceinline__ void stage_s5_prep(const Ctx& F, int l, int nrows) {
    const auto& a = *F.a; unsigned char* ws = a.ws;
    const bf16* __restrict__ Z = (const bf16*)(ws + WS_Z); const float* __restrict__ YP = (const float*)(ws + WS_YP); bf16* __restrict__ AS5 = (bf16*)(ws + WS_AS5);
    const int c = 4 * (F.tid & 127), rq = F.tid >> 7;
    const f32x4 dsk = *(const f32x4*)(a.in[I_S5D] + l * 512 + c);
#pragma unroll 4
    for (int row = F.bid * 4 + rq; row < nrows; row += F.G * 4) {
        const v2u uz = *(const v2u*)(Z + (size_t)row * IN_COLS + S5_OFF + c);
        const f32x4 y0 = *(const f32x4*)(YP + (size_t)row * 512 + c), y1 = *(const f32x4*)(YP + ((size_t)T_ALL + row) * 512 + c);
        const f32x4 u = (f32x4){bflo(uz.x), bfhi(uz.x), bflo(uz.y), bfhi(uz.y)};
        const f32x4 y = y0 + y1 + u * dsk;
        float ge[4];
#pragma unroll
        for (int j = 0; j < 4; ++j) ge[j] = 0.5f * y[j] * (1.f + tanh_fast(0.7978845608028654f * (y[j] + 0.044715f * y[j] * y[j] * y[j])));
        v2u o; o.x = pk2(ge[0], ge[1]); o.y = pk2(ge[2], ge[3]);
        *(v2u*)(AS5 + (size_t)row * 512 + c) = o;
    }
}

__device__ __forceinline__ void stage_hy_pre(const Ctx& F, int l, int nrows) {
    const auto& a = *F.a; unsigned char* ws = a.ws; const int lane = F.lane;
    const bf16* Z = (const bf16*)(ws + WS_Z); bf16* UT = (bf16*)(ws + WS_UT);
    LAS unsigned char* tl = F.lds + F.wave * 16384;
    const float* cw = a.in[I_HYCW] + (size_t)l * 3 * 1536; const float* cbp = a.in[I_HYCB] + l * 1536;
    const int gw = F.bid * NWAVES + F.wave, NGW = F.G * NWAVES;
    const int q = lane >> 3, k = lane & 7, ntile = (nrows / 64) * 24;
    v4u v[8], hv;
#define HYPRE_LOAD(tile_) do { const int rt_ = (tile_) / 24, ct_ = (tile_) % 24, row0_ = rt_ * 64; int base_, pos0_, n_; row_seq(row0_, base_, pos0_, n_); \
        const bf16* zt_ = Z + (size_t)row0_ * IN_COLS + HY_OFF + ct_ * 64 + 8 * k; hv = (v4u){0u, 0u, 0u, 0u}; \
        _Pragma("unroll") for (int i = 0; i < 8; ++i) v[i] = *(const v4u*)(zt_ + (size_t)(8 * i + q) * IN_COLS); \
        if (q == 0 && pos0_ > 0) hv = *(const v4u*)(zt_ - (size_t)IN_COLS); \
        if (q == 1 && pos0_ + 64 < n_) hv = *(const v4u*)(zt_ + (size_t)64 * IN_COLS); } while (0)
    if (gw < ntile) HYPRE_LOAD(gw);
#pragma unroll 1
    for (int tile = gw; tile < ntile; tile += NGW) {
        const int rt = tile / 24, ct = tile % 24, row0 = rt * 64, c0 = ct * 64;
        f32x4 wv[8];
#pragma unroll
        for (int i = 0; i < 8; ++i) { const int col = c0 + 8 * i + q; wv[i] = (f32x4){cw[col], cw[1536 + col], cw[2 * 1536 + col], cbp[col]}; }
#pragma unroll
        for (int i = 0; i < 8; ++i) { LAS unsigned* p = (LAS unsigned*)(tl + (1 + 8 * i + q) * 132 + 16 * k); p[0] = v[i].x; p[1] = v[i].y; p[2] = v[i].z; p[3] = v[i].w; }
        if (q < 2) { LAS unsigned* p = (LAS unsigned*)(tl + (q ? 65 : 0) * 132 + 16 * k); p[0] = hv.x; p[1] = hv.y; p[2] = hv.z; p[3] = hv.w; }
        if (tile + NGW < ntile) HYPRE_LOAD(tile + NGW);
        LDS_WAIT(); asm volatile("" ::: "memory");
#pragma unroll 2
        for (int i = 0; i < 8; ++i) {
            const int ch = 8 * i + q, col = c0 + ch;
            const LAS unsigned short* s = (const LAS unsigned short*)(tl + (8 * k) * 132 + ch * 2);
            float z[10];
#pragma unroll
            for (int t = 0; t < 10; ++t) z[t] = __builtin_bit_cast(float, (unsigned)s[t * 66] << 16);
            float o[8];
#pragma unroll
            for (int t = 0; t < 8; ++t) o[t] = wv[i][0] * z[t] + wv[i][1] * z[t + 1] + wv[i][2] * z[t + 2] + wv[i][3];
            v4u w; w.x = pk2(o[0], o[1]); w.y = pk2(o[2], o[3]); w.z = pk2(o[4], o[5]); w.w = pk2(o[6], o[7]);
            *(v4u*)(UT + (size_t)col * T_ALL + row0 + 8 * k) = w;
        }
        LDS_WAIT(); asm volatile("" ::: "memory");
    }
#undef HYPRE_LOAD
}
__device__ __forceinline__ void stage_hy_post(const Ctx& F, int l, int nrows) {
    const auto& a = *F.a; unsigned char* ws = a.ws; const int lane = F.lane;
    const bf16* YT = (const bf16*)(ws + WS_UT) + (size_t)1024 * T_ALL; bf16* YHY = (bf16*)(ws + WS_YHY);
    LAS unsigned char* tl = F.lds + F.wave * 16384;
    const int gw = F.bid * NWAVES + F.wave, NGW = F.G * NWAVES;
    const int q = lane >> 3, k = lane & 7, ntile = (nrows / 64) * 8;
    v4u v[8];
#define HYPOST_LOAD(tile_) do { const bf16* yp_ = YT + (size_t)(((tile_) & 7) * 64 + q) * T_ALL + ((tile_) >> 3) * 64 + 8 * k; \
        _Pragma("unroll") for (int i = 0; i < 8; ++i) v[i] = *(const v4u*)(yp_ + (size_t)(8 * i) * T_ALL); } while (0)
    if (gw < ntile) HYPOST_LOAD(gw);
#pragma unroll 1
    for (int tile = gw; tile < ntile; tile += NGW) {
        const int rt = tile >> 3, ct = tile & 7, row0 = rt * 64, c0 = ct * 64;
#pragma unroll
        for (int i = 0; i < 8; ++i) { LAS unsigned* p = (LAS unsigned*)(tl + (8 * i + q) * 132 + 16 * k); p[0] = v[i].x; p[1] = v[i].y; p[2] = v[i].z; p[3] = v[i].w; }
        if (tile + NGW < ntile) HYPOST_LOAD(tile + NGW);
        LDS_WAIT(); asm volatile("" ::: "memory");
#pragma unroll
        for (int i = 0; i < 8; ++i) { const int r = 8 * i + q;
            const LAS unsigned short* s = (const LAS unsigned short*)(tl + (8 * k) * 132 + r * 2);
            unsigned e[8];
#pragma unroll
            for (int j = 0; j < 8; ++j) e[j] = s[j * 66];
            v4u w; w.x = e[0] | (e[1] << 16); w.y = e[2] | (e[3] << 16); w.z = e[4] | (e[5] << 16); w.w = e[6] | (e[7] << 16);
            *(v4u*)(YHY + (size_t)(row0 + r) * 512 + c0 + 8 * k) = w; }
        LDS_WAIT(); asm volatile("" ::: "memory");
    }
#undef HYPOST_LOAD
}
typedef float f32x16 __attribute__((ext_vector_type(16)));
__device__ __forceinline__ void hyena_item(const Ctx& F, int l, int c, int isctx) {
    const auto& a = *F.a; unsigned char* ws = a.ws; const int tid = F.tid, lane = F.lane;
    const int n = isctx ? CTXL : SEQ, rowbase = isctx ? T_LAT : 0, RL = isctx ? HY_RLENC : HY_RLEN, off = n + 47;
    const bf16* UT = (const bf16*)(ws + WS_UT);
    const bf16* x1g = UT + (size_t)c * T_ALL + rowbase; const bf16* x2g = UT + (size_t)(512 + c) * T_ALL + rowbase; bf16* vg = (bf16*)UT + (size_t)(1024 + c) * T_ALL + rowbase;
    const bf16* Rg = (const bf16*)(ws + WS_GF + l * GF_STRIDE + (isctx ? GF_CTX : 0)) + (size_t)c * RL;
    LAS unsigned char* XB = F.lds; LAS unsigned char* R1 = F.lds + HY_R1_OFF; LAS unsigned char* R2 = F.lds + HY_R2_OFF;
    { const int cpb = n / 8;
      for (int q = tid; q < 8 * cpb; q += NTHREADS) { const int b = q / cpb, ch = q % cpb; *(LAS v4u*)(XB + b * HY_ROWB + 2 * HY_MARG + 16 * ch) = *(const v4u*)(vg + (size_t)b * n + 8 * ch); }
      if (tid < 256) { const int b = tid >> 5, side = (tid >> 4) & 1, ch = tid & 15; const unsigned zz = (unsigned)opaque_v(0); *(LAS v4u*)(XB + b * HY_ROWB + (side ? 2 * (HY_MARG + n) : 0) + 16 * ch) = (v4u){zz, zz, zz, zz}; }
      const int rch = RL / 8;
      for (int q = tid; q < rch; q += NTHREADS) { *(LAS v4u*)(R1 + 16 * q) = *(const v4u*)(Rg + 8 * q); *(LAS v4u*)(R2 + 16 * q) = *(const v4u*)(Rg + (size_t)512 * RL + 8 * q); } }
    __syncthreads();
    const int i = lane & 31, kg = lane >> 5, jb = lane & 3, bb = (lane & 31) >> 2;
    const int rsh = (off - i) & 7, rd = rsh >> 1; const bool s1 = rd & 1, s2 = rd & 2; const unsigned sh = (rsh & 1) ? 16u : 0u;
    const int aconst = 2 * (off - i + 8 * kg - rsh), bconst = bb * HY_ROWB + 2 * (HY_MARG + 32 * jb + 8 * kg);
    const int T0w = 512 * F.wave; const int ntile = (n - T0w) >= 512 ? 4 : ((n - T0w) > 0 ? (n - T0w) / 128 : 0);
    const float bias0 = a.in[I_HYBIAS][(l * 2 + 0) * 512 + c], bias1 = a.in[I_HYBIAS][(l * 2 + 1) * 512 + c];
    f32x16 acc[4];
    v2u y1p[4][4];
#define HY_AFRAG(wa, wb, afr) do { \
        const unsigned a0 = s1 ? wa.y : wa.x, a1 = s1 ? wa.z : wa.y, a2 = s1 ? wa.w : wa.z, a3 = s1 ? wb.x : wa.w, a4 = s1 ? wb.y : wb.x, a5 = s1 ? wb.z : wb.y, a6 = s1 ? wb.w : wb.z; \
        const unsigned b0 = s2 ? a2 : a0, b1 = s2 ? a3 : a1, b2 = s2 ? a4 : a2, b3 = s2 ? a5 : a3, b4 = s2 ? a6 : a4; \
        v4u af_; af_.x = __builtin_amdgcn_alignbit(b1, b0, sh); af_.y = __builtin_amdgcn_alignbit(b2, b1, sh); af_.z = __builtin_amdgcn_alignbit(b3, b2, sh); af_.w = __builtin_amdgcn_alignbit(b4, b3, sh); \
        afr = __builtin_bit_cast(bf16x8, af_); } while (0)
#define HY_STEP_COND(RB, d) do { \
        const v4u wa = *(const LAS v4u*)((RB) + aconst - 2 * (d)), wb = *(const LAS v4u*)((RB) + aconst - 2 * (d) + 16); bf16x8 afr; HY_AFRAG(wa, wb, afr); \
        _Pragma("unroll") for (int m = 0; m < 4; ++m) { const int T0 = T0w + 128 * m; \
            if (m < ntile && (d) >= T0 - n + 16 && (d) <= T0 + 96) { const bf16x8 bfr = *(const LAS bf16x8*)(XB + bconst + 2 * (T0 - (d))); \
                acc[m] = __builtin_amdgcn_mfma_f32_32x32x16_bf16(afr, bfr, acc[m], 0, 0, 0); } } } while (0)
#define HY_LOAD(RB, d, wa, wb, bq) do { wa = *(const LAS v4u*)((RB) + aconst - 2 * (d)); wb = *(const LAS v4u*)((RB) + aconst - 2 * (d) + 16); \
        _Pragma("unroll") for (int m = 0; m < 4; ++m) bq[m] = *(const LAS bf16x8*)(XB + bconst + 2 * (T0w + 128 * m - (d))); } while (0)
#define HY_MMA(wa, wb, bq) do { bf16x8 afr; HY_AFRAG(wa, wb, afr); \
        _Pragma("unroll") for (int m = 0; m < 4; ++m) acc[m] = __builtin_amdgcn_mfma_f32_32x32x16_bf16(afr, bq[m], acc[m], 0, 0, 0); } while (0)
#define HY_CONV(RB) do { \
        _Pragma("unroll") for (int m = 0; m < 4; ++m) _Pragma("unroll") for (int e = 0; e < 16; ++e) acc[m][e] = 0.f; \
        if (ntile == 4) { \
            const int dA = T0w - n + 16, dB = T0w + 384 - n + 16, dC = T0w + 96, dD = T0w + 384 + 96;     \
            _Pragma("unroll 1") for (int d = dA; d < dB; d += 16) HY_STEP_COND(RB, d); \
            { v4u waA, wbA, waB, wbB; bf16x8 bqA[4], bqB[4]; \
              HY_LOAD(RB, dB, waA, wbA, bqA); \
              _Pragma("unroll 1") for (int d = dB; d <= dC; d += 32) { \
                  if (d + 16 <= dC) HY_LOAD(RB, d + 16, waB, wbB, bqB); \
                  __builtin_amdgcn_sched_barrier(0); \
                  HY_MMA(waA, wbA, bqA); \
                  __builtin_amdgcn_sched_barrier(0); \
                  if (d + 32 <= dC) HY_LOAD(RB, d + 32, waA, wbA, bqA); \
                  __builtin_amdgcn_sched_barrier(0); \
                  if (d + 16 <= dC) HY_MMA(waB, wbB, bqB); \
                  __builtin_amdgcn_sched_barrier(0); } } \
            _Pragma("unroll 1") for (int d = dC + 16; d <= dD; d += 16) HY_STEP_COND(RB, d); \
        } else if (ntile > 0) { const int dhi = T0w + 128 * (ntile - 1) + 96; \
            _Pragma("unroll 1") for (int d = T0w - n + 16; d <= dhi; d += 16) HY_STEP_COND(RB, d); } } while (0)
    HY_CONV(R1);
#pragma unroll
    for (int m = 0; m < 4; ++m) if (m < ntile) {
#pragma unroll
        for (int rg = 0; rg < 4; ++rg) { const int t4 = T0w + 128 * m + 32 * jb + 8 * rg + 4 * kg;
            const v2u xv = *(const v2u*)(x1g + (size_t)bb * n + t4); const v2u vv = *(const LAS v2u*)(XB + bb * HY_ROWB + 2 * (HY_MARG + t4));
            const float y0 = bflo(xv.x) * (acc[m][4 * rg + 0] + bias0 * bflo(vv.x)), y1 = bfhi(xv.x) * (acc[m][4 * rg + 1] + bias0 * bfhi(vv.x));
            const float y2 = bflo(xv.y) * (acc[m][4 * rg + 2] + bias0 * bflo(vv.y)), y3 = bfhi(xv.y) * (acc[m][4 * rg + 3] + bias0 * bfhi(vv.y));
            y1p[m][rg].x = pk2(y0, y1); y1p[m][rg].y = pk2(y2, y3); } }
    __syncthreads();
#pragma unroll
    for (int m = 0; m < 4; ++m) if (m < ntile) {
#pragma unroll
        for (int rg = 0; rg < 4; ++rg) { const int t4 = T0w + 128 * m + 32 * jb + 8 * rg + 4 * kg; *(LAS v2u*)(XB + bb * HY_ROWB + 2 * (HY_MARG + t4)) = y1p[m][rg]; } }
    __syncthreads();
    HY_CONV(R2);
#pragma unroll
    for (int m = 0; m < 4; ++m) if (m < ntile) {
#pragma unroll
        for (int rg = 0; rg < 4; ++rg) { const int t4 = T0w + 128 * m + 32 * jb + 8 * rg + 4 * kg;
            const v2u xv = *(const v2u*)(x2g + (size_t)bb * n + t4); const v2u yv = y1p[m][rg];
            const float o0 = bflo(xv.x) * (acc[m][4 * rg + 0] + bias1 * bflo(yv.x)), o1 = bfhi(xv.x) * (acc[m][4 * rg + 1] + bias1 * bfhi(yv.x));
            const float o2 = bflo(xv.y) * (acc[m][4 * rg + 2] + bias1 * bflo(yv.y)), o3 = bfhi(xv.y) * (acc[m][4 * rg + 3] + bias1 * bfhi(yv.y));
            v2u ov; ov.x = pk2(o0, o1); ov.y = pk2(o2, o3); *(v2u*)(vg + (size_t)bb * n + t4) = ov; } }
    __syncthreads();
#undef HY_CONV
#undef HY_AFRAG
#undef HY_STEP_COND
#undef HY_LOAD
#undef HY_MMA
}
__device__ __forceinline__ void stage_mixer(const Ctx& F, int l) {
    unsigned* ctr = (unsigned*)(F.a->ws + WS_CTL) + CW_WORK + 64 * l;
    LAS int* itb = (LAS int*)(F.lds + LDSCTL_OFF + 512);
    const int nit = 128 + 512 + (l == 0 ? 512 : 0);
#ifdef PROBE_STATIC
    return;
#endif
    for (;;) {
        if (F.tid == 0) *itb = (int)__hip_atomic_fetch_add(ctr, 1u, __ATOMIC_RELAXED, __HIP_MEMORY_SCOPE_AGENT);
        __syncthreads();
        const int it = *itb;
        __syncthreads();
        if (it >= nit) break;
        Ctx Fi; Fi.a = kargs(); Fi.tid = opaque_v((int)threadIdx.x); Fi.lane = Fi.tid & 63; Fi.wave = __builtin_amdgcn_readfirstlane(Fi.tid >> 6); Fi.bid = opaque((int)blockIdx.x); Fi.G = opaque((int)gridDim.x);
        Fi.lds = (LAS unsigned char*)((LAS unsigned char*)0 + opaque(0)) + (F.lds - (LAS unsigned char*)0);
#ifdef PROBE_T
        if (l == 0 && F.tid == 0 && it == 5) ((unsigned long long*)(F.a->ws + WS_CTL + CW_STAMP * 4))[21] = __builtin_amdgcn_s_memrealtime();
        if (l == 0 && F.tid == 0 && it == 300) ((unsigned long long*)(F.a->ws + WS_CTL + CW_STAMP * 4))[23] = __builtin_amdgcn_s_memrealtime();
#endif
        if (it < 128) { for (int rep = 0; rep < ((DUPK == 9) ? 2 : 1); ++rep) rw_chunk_item2(Fi, opaque(l), it); }
        else if (it < 640) hyena_item(Fi, opaque(l), it - 128, 0);
        else hyena_item(Fi, opaque(l), it - 640, 1);
#ifdef PROBE_T
        if (l == 0 && F.tid == 0 && it == 5) ((unsigned long long*)(F.a->ws + WS_CTL + CW_STAMP * 4))[22] = __builtin_amdgcn_s_memrealtime();
        if (l == 0 && F.tid == 0 && it == 300) ((unsigned long long*)(F.a->ws + WS_CTL + CW_STAMP * 4))[24] = __builtin_amdgcn_s_memrealtime();
#endif
    }
}

typedef float f32x16r __attribute__((ext_vector_type(16)));
__device__ __forceinline__ void stage_norm2_router(const Ctx& F, int l, int nrows) {
    const auto& a = *F.a; unsigned char* ws = a.ws; const int lane = F.lane;
    const float* X = (const float*)(ws + WS_X); bf16* H = (bf16*)(ws + WS_H); const float* MOD = (const float*)(ws + WS_MOD);
    int* EIDX = (int*)(ws + WS_EIDX); float* GATE = (float*)(ws + WS_GATE); int* POS = (int*)(ws + WS_POS); unsigned* ROWOF = (unsigned*)(ws + WS_ROWOF);
    LAS int* lex = (LAS int*)(F.lds + 40960); LAS int* lrk = lex + 1024; LAS int* offl = lrk + 1024;
    LAS float* lg = (LAS float*)(F.lds + F.wave * 4352);
    LAS int* hist = (LAS int*)(F.lds + LDSCTL_OFF + 1024);
    if (F.tid < 32) hist[F.tid] = 0;
    __syncthreads();
    const int rpb = (nrows + F.G - 1) / F.G, r0 = F.bid * rpb, r1 = (r0 + rpb < nrows) ? r0 + rpb : nrows;
    const float* rw = a.in[I_RTW] + (size_t)l * 1024 * 32;
    const int i = lane & 31, kk = lane >> 5;
    const f32x4* ng = (const f32x4*)(a.in[I_N2G] + l * D) + kk;
    for (int rb = r0 + F.wave * 32; rb < r1; rb += NWAVES * 32) {
        const int nrow = (r1 - rb) < 32 ? (r1 - rb) : 32; const bool live = i < nrow;
        const int row = live ? rb + i : r1 - 1; const int w = row < T_LAT ? (row >> 12) : 8;
        const f32x4* xr = (const f32x4*)(X + (size_t)row * D) + kk;
        float ss = 0.f;
#pragma unroll 16
        for (int q = 0; q < 128; ++q) { const f32x4 v = xr[2 * q]; ss += (v[0] * v[0] + v[1] * v[1]) + (v[2] * v[2] + v[3] * v[3]); }
        ss += __builtin_bit_cast(float, __builtin_amdgcn_ds_bpermute((lane ^ 32) << 2, __builtin_bit_cast(int, ss)));
        const float rstd = __builtin_amdgcn_rsqf(ss * (1.f / D) + 1e-6f);
        const f32x4* sh = (const f32x4*)(MOD + (size_t)(l * 9 + w) * 6144 + 3072) + kk; const f32x4* sc = (const f32x4*)(MOD + (size_t)(l * 9 + w) * 6144 + 4096) + kk;
        v2u* ho = (v2u*)(H + (size_t)row * D) + kk;
        f32x16r acc;
#pragma unroll
        for (int e = 0; e < 16; ++e) acc[e] = 0.f;
        const float* wp = rw + (size_t)(4 * kk) * 32 + i;
        f32x4 xn[4], gn_[4], cn_[4], sn_[4], wn_[4];
#define RT_LOAD(q0_) do { _Pragma("unroll") for (int u_ = 0; u_ < 4; ++u_) { const int q_ = (q0_) + u_; xn[u_] = xr[2 * q_]; gn_[u_] = ng[2 * q_]; cn_[u_] = sc[2 * q_]; sn_[u_] = sh[2 * q_]; \
            wn_[u_] = (f32x4){wp[(size_t)(8 * q_) * 32], wp[(size_t)(8 * q_ + 1) * 32], wp[(size_t)(8 * q_ + 2) * 32], wp[(size_t)(8 * q_ + 3) * 32]}; } } while (0)
        RT_LOAD(0);
#pragma unroll 1
        for (int q0 = 0; q0 < 128; q0 += 4) {
            f32x4 xc[4], gc_[4], cc_[4], sc_[4], wc_[4];
#pragma unroll
            for (int u = 0; u < 4; ++u) { xc[u] = xn[u]; gc_[u] = gn_[u]; cc_[u] = cn_[u]; sc_[u] = sn_[u]; wc_[u] = wn_[u]; }
            if (q0 + 4 < 128) RT_LOAD(q0 + 4);
#pragma unroll
            for (int u = 0; u < 4; ++u) { const int q = q0 + u;
                const f32x4 h4 = xc[u] * rstd * gc_[u] * (cc_[u] + 1.0f) + sc_[u];
                if (live) { v2u o; o.x = pk2(h4[0], h4[1]); o.y = pk2(h4[2], h4[3]); ho[2 * q] = o; }
                acc = __builtin_amdgcn_mfma_f32_32x32x2f32(h4[0], wc_[u][0], acc, 0, 0, 0);
                acc = __builtin_amdgcn_mfma_f32_32x32x2f32(h4[1], wc_[u][1], acc, 0, 0, 0);
                acc = __builtin_amdgcn_mfma_f32_32x32x2f32(h4[2], wc_[u][2], acc, 0, 0, 0);
                acc = __builtin_amdgcn_mfma_f32_32x32x2f32(h4[3], wc_[u][3], acc, 0, 0, 0); }
        }
#undef RT_LOAD
        const float rbias = a.in[I_RTB][l * 32 + i];
#pragma unroll
        for (int r = 0; r < 16; ++r) { const int ri = (r & 3) + 8 * (r >> 2) + 4 * kk; lg[ri * 33 + i] = acc[r] + rbias; }
        LDS_WAIT(); asm volatile("" ::: "memory");
        if (lane < nrow) {
            LAS float* lr = lg + lane * 33; const int orow = rb + lane;
            float tv[4]; int ti[4];
#pragma unroll
            for (int r = 0; r < 4; ++r) { float bv = -INFINITY; int bi = 0;
#pragma unroll 8
                for (int e = 0; e < 32; ++e) { const float v = lr[e]; if (v > bv) { bv = v; bi = e; } }
                tv[r] = bv; ti[r] = bi; lr[bi] = -INFINITY; }
            const float e1 = expf(tv[1] - tv[0]), e2 = expf(tv[2] - tv[0]), e3 = expf(tv[3] - tv[0]); const float inv = 1.0f / (1.0f + e1 + e2 + e3);
            *(int4*)(EIDX + orow * 4) = make_int4(ti[0], ti[1], ti[2], ti[3]); *(f32x4*)(GATE + orow * 4) = (f32x4){inv, e1 * inv, e2 * inv, e3 * inv};
#pragma unroll
            for (int r = 0; r < 4; ++r) { const int rk = __hip_atomic_fetch_add(&hist[ti[r]], 1, __ATOMIC_RELAXED, __HIP_MEMORY_SCOPE_WORKGROUP); lex[(orow - r0) * 4 + r] = ti[r]; lrk[(orow - r0) * 4 + r] = rk; }
        }
        LDS_WAIT(); asm volatile("" ::: "memory");
    }
    __syncthreads();
    if (F.tid < 32) { const int c = hist[F.tid]; offl[F.tid] = c ? (int)__hip_atomic_fetch_add((unsigned*)(ws + WS_CTL) + CW_CNT + 64 * l + F.tid, (unsigned)c, __ATOMIC_RELAXED, __HIP_MEMORY_SCOPE_AGENT) : 0; }
    __syncthreads();
    for (int i = F.tid; i < (r1 > r0 ? (r1 - r0) * 4 : 0); i += NTHREADS) { const int e = lex[i], pos = offl[e] + lrk[i];
        POS[r0 * 4 + i] = pos; ROWOF[(size_t)e * pg8::MOE_CAP + pos] = (unsigned)(r0 + (i >> 2)) * (unsigned)(D * 2); }
    __syncthreads();
}

__device__ __forceinline__ LAS int* load_moe_base(const Ctx& F, int l) {
    LAS int* base = (LAS int*)(F.lds + LDSCTL_OFF + 256);
    if (F.tid < 32) base[64 + F.tid] = (int)__hip_atomic_load((unsigned*)(F.a->ws + WS_CTL) + CW_CNT + 64 * l + F.tid, __ATOMIC_RELAXED, __HIP_MEMORY_SCOPE_AGENT);
    __syncthreads();
    if (F.tid == 0) { int acc = 0; for (int e = 0; e < 32; ++e) { base[e] = acc; acc += (base[64 + e] + 255) & ~255; } base[32] = acc; }
    __syncthreads();
    return base;
}
__device__ __forceinline__ void moe_fix_pos(const Ctx& F, int nrows, const LAS int* base) {
    unsigned char* ws = F.a->ws; const int* EIDX = (const int*)(ws + WS_EIDX); int* POS = (int*)(ws + WS_POS);
    const int rpb = (nrows + F.G - 1) / F.G, r0 = F.bid * rpb, r1 = (r0 + rpb < nrows) ? r0 + rpb : nrows;
    for (int i = F.tid; i < (r1 > r0 ? (r1 - r0) * 4 : 0); i += NTHREADS) POS[r0 * 4 + i] += base[EIDX[r0 * 4 + i]];
}

constexpr int NSTAGE_L = 12, NSTAGES = 1 + DEPTH * NSTAGE_L + 1;
__global__ void __launch_bounds__(NTHREADS, 2) mk_fwd(Args args) {
    extern __shared__ __attribute__((aligned(16))) unsigned char lds_raw[];
    Ctx F; F.a = kargs(); F.lds = (LAS unsigned char*)lds_raw; F.tid = threadIdx.x; F.lane = F.tid & 63; F.wave = __builtin_amdgcn_readfirstlane(F.tid >> 6); F.bid = blockIdx.x; F.G = gridDim.x;
    volatile LAS unsigned* MISC = (volatile LAS unsigned*)(F.lds + LDSCTL_OFF);
    for (int u = F.tid; u < (LDS_BYTES - LDSCTL_OFF) / 4; u += NTHREADS) ((LAS unsigned*)(F.lds + LDSCTL_OFF))[u] = 0u;
    __syncthreads();
#if MK_PER_STAGE
#define GRID_BAR() do { } while (0)
#else
    (void)xcd_barrier_post((unsigned*)(F.a->ws + WS_CTL) + CW_BAR, MISC + 8);
#define GRID_BAR() do { XcdBarrier b_; b_.bar = (unsigned*)(kargs()->ws + WS_CTL) + CW_BAR; b_.x = xb_xcc_id(); b_.st = (volatile LAS unsigned*)((LAS unsigned char*)lds_raw + LDSCTL_OFF + opaque(32)); xcd_barrier(b_); } while (0)
#endif
#ifndef ONLY_S
#define ONLY_S -1
#endif
#define STG_SEL(k) (ONLY_S < 0 || ONLY_S == (((k) == 0) ? 0 : ((k) == NSTAGES - 1 ? 14 : (((k) - 1) % NSTAGE_L) + 1)))
#if MK_PER_STAGE
#define IN(k) (STG_SEL(k) && kargs()->ph_lo == (k))
#else
#define IN(k) STG_SEL(k)
#endif
#if MK_PER_STAGE
#define SEAM(k) do { } while (0)
#else
#define SEAM(k) do { if ((k) + 1 < NSTAGES) GRID_BAR(); } while (0)
#endif
#define STAGE(k) if (IN(k)) { F.a = kargs(); F.tid = opaque_v((int)threadIdx.x); F.lane = F.tid & 63; F.wave = __builtin_amdgcn_readfirstlane(F.tid >> 6); F.bid = opaque((int)blockIdx.x); F.G = opaque((int)gridDim.x); F.lds = (LAS unsigned char*)lds_raw + opaque(0); unsigned char* ws = F.a->ws; const int l = opaque(lq); unsigned char* wl = ws + WS_WTS + (size_t)l * WL_STRIDE; (void)wl; (void)ws;
#define STAGE_END(k) } SEAM(k);
    int lq = 0;
    STAGE(0) p0_prologue(F); STAGE_END(0)
    for (lq = 0; lq < DEPTH; ++lq) {
        const int sb = 1 + lq * NSTAGE_L;
        const int nrl = opaque((lq == DEPTH - 1) ? T_LAT : T_ALL);
        STAGE(sb + 0) stage_norm1(F, l); STAGE_END(sb + 0)
        STAGE(sb + 1) pg8::SchedWin S; S.A = (const char*)(ws + WS_H); S.Bt = (const char*)(wl + WO_WIN); S.tstep = (size_t)256 * 1024 * 2; S.G = F.G; S.c = F.bid; S.part = (nrl != T_ALL); pg8::EpiBf16 E{(bf16*)(ws + WS_Z), IN_COLS, nullptr, 0};
            pg8::gemm_phase(F.lds, F.tid, 1024, S, E); STAGE_END(sb + 1)
        STAGE(sb + 2) for (int rep = 0; rep < REPN(1); ++rep) stage_rw_prep1(F, l); for (int rep = 0; rep < REPN(2); ++rep) stage_s5_scan<0>(F, l); for (int rep = 0; rep < REPN(3); ++rep) stage_hy_pre(F, l, nrl); STAGE_END(sb + 2)
        STAGE(sb + 3) { pg8::SchedStatic S; S.init(ws + WS_ARW, wl + WO_RWCAT, T_ALL, 2560, 256, F.G, F.bid); pg8::EpiBf16 E{(bf16*)(ws + WS_P), 2560, nullptr, 0}; PT(4); pg8::gemm_phase(F.lds, F.tid, 256, S, E); PT(5); }
            F.tid = opaque_v((int)threadIdx.x); F.lane = F.tid & 63;
            for (int rep = 0; rep < REPN(4); ++rep) stage_s5_scan<1>(F, l); STAGE_END(sb + 3)
        STAGE(sb + 4) for (int rep = 0; rep < REPN(5); ++rep) stage_rw_prep2(F, l); for (int rep = 0; rep < REPN(6); ++rep) stage_s5_prep(F, l, nrl); STAGE_END(sb + 4)
        STAGE(sb + 5) PT(10); stage_mixer(F, l); PT(11); STAGE_END(sb + 5) STAGE(sb + 5) PT(12); }
        STAGE(sb + 6) { pg8::SchedStatic S; S.init(ws + WS_AS5, wl + WO_GLU, nrl, 1024, 512, F.G, F.bid); pg8::EpiGlu<0> E{(bf16*)(ws + WS_YS5), 512, F.a->in[I_S5GLUB] + l * 1024, 0, 512}; PT(13); pg8::gemm_phase(F.lds, F.tid, 512, S, E); PT(14); }
            for (int rep = 0; rep < REPN(7); ++rep) stage_rw_readout(F, l); for (int rep = 0; rep < REPN(8); ++rep) stage_hy_post(F, l, nrl); STAGE_END(sb + 6)
        STAGE(sb + 7) pg8::SchedMerge S; S.A0 = (const char*)(ws + WS_YHY); S.A1 = (const char*)(ws + WS_YRW); S.A2 = (const char*)(ws + WS_YS5); S.Bt = (const char*)(wl + WO_WBR); S.tstep = (size_t)256 * 512 * 2; S.bstride = (size_t)1024 * 512 * 2;
            S.nM = nrl / 256; S.nN = 4; S.G = F.G; S.c = F.bid;
            pg8::EpiMerge E{(bf16*)(ws + WS_MTMP), (bf16*)(ws + WS_H), (const bf16*)(ws + WS_Z) + GATE_OFF}; pg8::gemm_phase(F.lds, F.tid, 512, S, E); STAGE_END(sb + 7)
        STAGE(sb + 8) pg8::SchedStatic S; S.init(ws + WS_H, wl + WO_WOUT, nrl, 1024, 1024, F.G, F.bid); pg8::EpiResid E{(float*)(ws + WS_X), (const float*)(ws + WS_MOD) + (size_t)l * 9 * 6144 + 2048};
            pg8::gemm_phase(F.lds, F.tid, 1024, S, E); STAGE_END(sb + 8)
        STAGE(sb + 9) PT(17); stage_norm2_router(F, l, nrl); PT(18); STAGE_END(sb + 9)
        STAGE(sb + 10) LAS int* base = load_moe_base(F, l); moe_fix_pos(F, nrl, base);
            pg8::SchedMoeG S; S.A = (const char*)(ws + WS_H); S.rowof = (const unsigned*)(ws + WS_ROWOF); S.Bt = (const char*)(wl + WO_W1); S.tstep = (size_t)256 * 1024 * 2; S.estride = (size_t)2048 * 1024 * 2; S.NPN = 8; S.G = F.G; S.c = F.bid; S.base = base;
            pg8::EpiGlu<1> E{(bf16*)(ws + WS_ACT), 1024, F.a->in[I_B1] + (size_t)l * 32 * 2048, 2048, 1024}; pg8::gemm_phase(F.lds, F.tid, 1024, S, E); STAGE_END(sb + 10)
        STAGE(sb + 11) LAS int* base = load_moe_base(F, l);
            pg8::SchedMoe S; S.A = (const char*)(ws + WS_ACT); S.Bt = (const char*)(wl + WO_W2); S.tstep = (size_t)256 * 1024 * 2; S.estride = (size_t)1024 * 1024 * 2; S.NPN = 4; S.G = F.G; S.c = F.bid; S.base = base;
            pg8::EpiBf16 E{(bf16*)(ws + WS_XS), 1024, F.a->in[I_B2] + (size_t)l * 32 * 1024, 1024}; pg8::gemm_phase(F.lds, F.tid, 1024, S, E); STAGE_END(sb + 11)
    }
    lq = DEPTH;
    STAGE(NSTAGES - 1)
#ifndef PROBE_T
        stage_norm1(F, l);
#endif
#ifdef PROBE_T
        { const unsigned long long* st = (const unsigned long long*)(F.a->ws + WS_CTL + CW_STAMP * 4); const float cval = (float)(long long)(st[PROBE_B] - st[PROBE_A]) * (1.0f / (100.0f * PROBE_DIV));
          __syncthreads(); for (size_t i = (size_t)F.bid * NTHREADS + F.tid; i < (size_t)T_LAT * D; i += (size_t)F.G * NTHREADS) F.a->out[i] = cval; }
#endif
    }
#undef IN
#undef SEAM
}

extern "C" void kernel_launch(void* const* d_in, const int* in_sizes, int n_in, void* d_out, int out_size, void* d_ws, size_t ws_size, hipStream_t stream) {
    static int grid = 0;
    if (grid == 0) {
        if (n_in != 51 || out_size != T_LAT * D || ws_size < WS_END) { fprintf(stderr, "kernel_launch: unexpected shapes (n_in %d out %d ws %zu, need %zu)\n", n_in, out_size, ws_size, (size_t)WS_END); grid = -1; return; }
        int dev = 0, cus = 0, per_cu = 0;
        if (hipGetDevice(&dev) != hipSuccess || hipDeviceGetAttribute(&cus, hipDeviceAttributeMultiprocessorCount, dev) != hipSuccess) { grid = -1; return; }
        if (hipFuncSetAttribute((const void*)mk_fwd, hipFuncAttributeMaxDynamicSharedMemorySize, LDS_BYTES) != hipSuccess) { fprintf(stderr, "kernel_launch: hipFuncSetAttribute failed\n"); grid = -1; return; }
        if (hipOccupancyMaxActiveBlocksPerMultiprocessor(&per_cu, (const void*)mk_fwd, NTHREADS, LDS_BYTES) != hipSuccess || per_cu < 1) fprintf(stderr, "kernel_launch: occupancy query says %d\n", per_cu);
        (void)hipGetLastError();
        grid = cus;
    }
    if (grid < 0) return;
    if (hipMemsetAsync((char*)d_ws + WS_CTL, 0, CTL_ZERO_BYTES, stream) != hipSuccess) return;
    Args a{};
    for (int i = 0; i < 51; ++i) a.in[i] = (const float*)d_in[i];
    a.out = (float*)d_out; a.ws = (unsigned char*)d_ws;
#if MK_PER_STAGE
    for (int s = 0; s < NSTAGES; ++s) { a.ph_lo = s; a.ph_hi = s + 1; int reps = 1;
#ifdef PROBE_SET
        { const int ls = (s == 0 || s == NSTAGES - 1) ? -1 : (s - 1) % NSTAGE_L;
          if (PROBE_SET >= 1 && PROBE_SET <= 13 && ls == PROBE_SET - 1 && ls != 5 && ls != 8 && !(ls == 0 && s > 1)) reps = 3;
          if (PROBE_SET == 14 && s == 0) reps = 3; }
#endif
        for (int r = 0; r < reps; ++r) hipLaunchKernelGGL(mk_fwd, dim3(grid), dim3(NTHREADS), LDS_BYTES, stream, a); }
#else
    a.ph_lo = 0; a.ph_hi = NSTAGES; hipLaunchKernelGGL(mk_fwd, dim3(grid), dim3(NTHREADS), LDS_BYTES, stream, a);
#endif
}
```

```cpp
#include <hip/hip_runtime.h>
#include <cstdio>
#include <cstdint>

#ifndef DUPK
#define DUPK 0
#endif
#define REPN(k) ((DUPK == (k)) ? 3 : 1)
#ifndef REP_GEMM
#define REP_GEMM 1
#endif
#ifndef REP_LIGHT
#define REP_LIGHT 1
#endif
#ifndef REP_PRO
#define REP_PRO 1
#endif
#ifndef MK_PER_STAGE
#define MK_PER_STAGE 0
#endif

#define GAS __attribute__((address_space(1)))
#define LAS __attribute__((address_space(3)))
typedef unsigned short bf16;
typedef unsigned v4u __attribute__((ext_vector_type(4)));
typedef unsigned v2u __attribute__((ext_vector_type(2)));
typedef float f32x4 __attribute__((ext_vector_type(4)));
typedef float f32x2 __attribute__((ext_vector_type(2)));
typedef short bf16x8 __attribute__((ext_vector_type(8)));

constexpr int D = 1024, BATCH = 8, SEQ = 4096, CTXL = 256, DEPTH = 2;
constexpr int T_LAT = BATCH * SEQ, T_CTX = BATCH * CTXL, T_ALL = T_LAT + T_CTX;
constexpr int IN_COLS = 6912, HY_OFF = 0, RW_OFF = 1536, S5_OFF = 3328, GATE_OFF = 3840;
constexpr int NE = 32, TOPK = 4;
constexpr int MAXSLOT = 147456;
constexpr int NWAVES = 8, NTHREADS = 512;
constexpr int HY_MARG = 128, HY_ROWB = 8720, HY_RLEN = 8272, HY_RLENC = 592;
constexpr int HY_R1_OFF = 8 * HY_ROWB, HY_R2_OFF = HY_R1_OFF + HY_RLEN * 2;

constexpr size_t MiB = 1ull << 20;
constexpr size_t WS_CTL = 0, CTL_ZERO_BYTES = 1 * MiB;
constexpr size_t WS_MOD = 1 * MiB;
constexpr size_t WS_BLKCNT = 2 * MiB;
constexpr size_t WS_META = 2 * MiB + 512 * 1024;
constexpr size_t WS_ROWOF = 480 * MiB;
constexpr int CW_CNT = 24576;
constexpr size_t WS_EIDX = 3 * MiB, WS_GATE = 4 * MiB, WS_POS = 5 * MiB;
constexpr size_t WS_WTS = 8 * MiB, WL_STRIDE = 214 * MiB;
constexpr size_t WO_WIN = 0, WO_RWCAT = 14 * MiB, WO_GLU = 16 * MiB, WO_WBR = 17 * MiB, WO_WOUT = 20 * MiB, WO_W1 = 22 * MiB, WO_W2 = 150 * MiB;
constexpr size_t WS_GF = 436 * MiB, GF_STRIDE = 20 * MiB, GF_CTX = 17 * MiB;
constexpr size_t WS_X = 504 * MiB;
constexpr size_t WS_H = 640 * MiB;
constexpr size_t WS_BIG = 708 * MiB;
constexpr size_t WS_Z = WS_BIG;
constexpr size_t WS_SCN = 1167 * MiB;
constexpr size_t WS_MTMP = WS_SCN;
constexpr size_t WS_P = 1473 * MiB;
constexpr size_t WS_ARW = 1643 * MiB;
constexpr size_t WS_YP = 1660 * MiB;
constexpr size_t WS_YDIR = WS_YP;
constexpr size_t WS_UT = 1796 * MiB;
constexpr size_t WS_AS5 = 2000 * MiB;
constexpr size_t WS_YHY = 1898 * MiB, WS_YRW = 1932 * MiB, WS_YS5 = 1966 * MiB;
constexpr size_t WS_XS = WS_BIG;
constexpr size_t WS_ACT = WS_BIG + 288 * MiB;
constexpr size_t WS_END = 2034 * MiB;
constexpr int CW_BAR = 4096;

constexpr int RING_BYTES = 131072;
constexpr int LDSCTL_OFF = RING_BYTES;
constexpr int LDS_BYTES = 163840;

typedef __bf16 bf16x2_t __attribute__((ext_vector_type(2)));
__device__ __forceinline__ unsigned pk2(float lo, float hi) { const bf16x2_t v = __builtin_convertvector((f32x2){lo, hi}, bf16x2_t); return __builtin_bit_cast(unsigned, v); }
__device__ __forceinline__ unsigned f2bf(float f) { return pk2(f, 0.f) & 0xffffu; }
__device__ __forceinline__ float bf2f(bf16 b) { return __builtin_bit_cast(float, ((unsigned)b) << 16); }
__device__ __forceinline__ float bflo(unsigned w) { return __builtin_bit_cast(float, w << 16); }
__device__ __forceinline__ float bfhi(unsigned w) { return __builtin_bit_cast(float, w & 0xffff0000u); }
__device__ __forceinline__ float sigm(float x) { return __builtin_amdgcn_rcpf(1.f + __expf(-x)); }
__device__ __forceinline__ float tanh_fast(float x) { const float e = __expf(2.f * x); return 1.f - 2.f * __builtin_amdgcn_rcpf(e + 1.f); }
#define LDS_WAIT() asm volatile("s_waitcnt lgkmcnt(0)" ::: "memory")
__device__ __forceinline__ float dpp_f(float x, const int ctrl_sel) {
    const int v = __builtin_bit_cast(int, x);
    int r;
    if (ctrl_sel == 0) r = __builtin_amdgcn_update_dpp(0, v, 0xB1, 0xF, 0xF, true);
    else if (ctrl_sel == 1) r = __builtin_amdgcn_update_dpp(0, v, 0x4E, 0xF, 0xF, true);
    else r = __builtin_amdgcn_update_dpp(0, v, 0x141, 0xF, 0xF, true);
    return __builtin_bit_cast(float, r);
}
__device__ __forceinline__ float red32(float x) {
    x += dpp_f(x, 0); x += dpp_f(x, 1); x += dpp_f(x, 2);
    x += __builtin_bit_cast(float, __builtin_amdgcn_update_dpp(0, __builtin_bit_cast(int, x), 0x128, 0xF, 0xF, true));
    x += __builtin_bit_cast(float, __builtin_amdgcn_ds_swizzle(__builtin_bit_cast(int, x), 0x401F));
    return x;
}
__device__ __forceinline__ float wave_sum(float v) {
    v = red32(v);
    return __builtin_bit_cast(float, __builtin_amdgcn_readlane(__builtin_bit_cast(int, v), 0)) + __builtin_bit_cast(float, __builtin_amdgcn_readlane(__builtin_bit_cast(int, v), 32));
}
__device__ __forceinline__ int xch32(int v, const int step) {
    if (step == 0) return __builtin_amdgcn_update_dpp(0, v, 0xB1, 0xF, 0xF, true);
    if (step == 1) return __builtin_amdgcn_update_dpp(0, v, 0x4E, 0xF, 0xF, true);
    if (step == 2) return __builtin_amdgcn_update_dpp(0, v, 0x141, 0xF, 0xF, true);
    if (step == 3) return __builtin_amdgcn_update_dpp(0, v, 0x128, 0xF, 0xF, true);
    return __builtin_amdgcn_ds_swizzle(v, 0x401F);
}
__device__ __forceinline__ float red8(float x) { x += dpp_f(x, 0); x += dpp_f(x, 1); x += dpp_f(x, 2); return x; }

#define XB_TMO      128
#define XB_XCNT(j)  (256  + 64 * (j))
#define XB_XSUB(j)  (1280 + 64 * (j))
#define XB_XGEN(j)  (2304 + 64 * (j))
#define XB_TOP      3328
#define XB_TOPGEN   3392
#define XCD_BAR_WORDS 3456
#define XB_SPIN_CAP (1u << 22)
__device__ __forceinline__ unsigned xb_ld(unsigned* p)              { return __hip_atomic_load(p, __ATOMIC_RELAXED, __HIP_MEMORY_SCOPE_AGENT); }
__device__ __forceinline__ unsigned xb_add(unsigned* p, unsigned v) { return __hip_atomic_fetch_add(p, v, __ATOMIC_RELAXED, __HIP_MEMORY_SCOPE_AGENT); }
__device__ __forceinline__ unsigned xb_xcc_id() { return (unsigned)__builtin_amdgcn_s_getreg((3 << 11) | 20) & 0xFu; }
#define XB_SPIN(cond, bar) do { unsigned _sp = 0; while (cond) { __builtin_amdgcn_s_sleep(1); \
    if ((++_sp & 255u) == 0u) { if (xb_ld(&(bar)[XB_TMO])) break; if (_sp > XB_SPIN_CAP) { atomicAdd(&(bar)[XB_TMO], 1u); break; } } } } while (0)
struct XcdBarrier { unsigned* bar; unsigned x; volatile LAS unsigned* st; };
__device__ __forceinline__ XcdBarrier xcd_barrier_post(unsigned* bar, volatile LAS unsigned* st) {
    XcdBarrier b; b.bar = bar; b.x = xb_xcc_id(); b.st = st;
    if (threadIdx.x == 0) (void)xb_add(&bar[XB_XCNT(b.x)], 1u);
    return b;
}
__device__ __forceinline__ void xcd_barrier_complete(unsigned* bar, unsigned x, unsigned& nloc, unsigned& nx) {
    const unsigned G = gridDim.x * gridDim.y * gridDim.z;
    unsigned sum, cnt, mine, sp = 0u;
    for (;;) {
        sum = 0u; cnt = 0u; mine = 0u;
#pragma unroll
        for (unsigned j = 0; j < 16; ++j) { const unsigned c = xb_ld(&bar[XB_XCNT(j)]); sum += c; cnt += (c > 0u) ? 1u : 0u; mine = (j == x) ? c : mine; }
        if (sum == G) break;
        __builtin_amdgcn_s_sleep(1);
        if ((++sp & 255u) == 0u) { if (xb_ld(&bar[XB_TMO])) break; if (sp > XB_SPIN_CAP) { atomicAdd(&bar[XB_TMO], 1u); break; } }
    }
    nloc = mine > 0u ? mine : 1u; nx = cnt > 0u ? cnt : 1u;
}
__device__ __forceinline__ void xcd_barrier(const XcdBarrier& b) {
    asm volatile("s_waitcnt vmcnt(0)" ::: "memory");
    __syncthreads();
    if (threadIdx.x == 0) {
        unsigned* bar = b.bar;
        __builtin_amdgcn_s_waitcnt(0);
        unsigned nloc = b.st[0], nx = b.st[1];
        if (nloc == 0u) { xcd_barrier_complete(bar, b.x, nloc, nx); b.st[0] = nloc; b.st[1] = nx; }
        const unsigned old = xb_add(&bar[XB_XSUB(b.x)], 1u);
        const unsigned gen = old / nloc;
        if (old + 1u == (gen + 1u) * nloc) {
            __builtin_amdgcn_fence(__ATOMIC_RELEASE, "agent");
            asm volatile("s_waitcnt vmcnt(0)" ::: "memory");
            const unsigned og = xb_add(&bar[XB_TOP], 1u);
            const unsigned tg = og / nx;
            if (og + 1u == (tg + 1u) * nx) xb_add(&bar[XB_TOPGEN], 1u);
            else XB_SPIN(xb_ld(&bar[XB_TOPGEN]) == tg, bar);
            __builtin_amdgcn_fence(__ATOMIC_ACQUIRE, "agent");
            xb_add(&bar[XB_XGEN(b.x)], 1u);
            asm volatile("s_waitcnt vmcnt(0)" ::: "memory");
        } else {
            XB_SPIN(xb_ld(&bar[XB_XGEN(b.x)]) == gen, bar);
            __builtin_amdgcn_fence(__ATOMIC_ACQUIRE, "agent");
            asm volatile("s_waitcnt vmcnt(0)" ::: "memory");
        }
    }
    __syncthreads();
}

namespace pg8 {
constexpr int MOE_CAP = 34816;
constexpr int BM = 256, BK = 64, HALF = 128, HTB = HALF * BK * 2, STAGE_BYTES = 8 * HTB, NXCD = 8, WGM = 8, ROWTAB_OFF = 131072 + 4096;
__host__ __device__ __forceinline__ int lds_byte(int r, int c) { const int st = (r >> 4) * 2 + (c >> 5), rr = r & 15, cc = c & 31, ob = rr * 64 + cc * 2; return st * 1024 + (ob ^ (((ob >> 9) & 1) << 5)); }
__host__ __device__ __forceinline__ void stage_rc(int b, int& R, int& C) { const int st = b / 1024, sb = b % 1024, swz = sb ^ (((sb >> 9) & 1) << 5); R = (st >> 1) * 16 + swz / 64; C = (st & 1) * 32 + (swz % 64) / 2; }
__host__ __device__ __forceinline__ int perm32(int rho) { const int n = rho >> 4, i = rho & 15; return 8 * (i >> 2) + 4 * n + (i & 3); }
struct Unit { int pm, pn, e; };
__device__ __forceinline__ unsigned cvt_pk_bf16(float lo, float hi) { return pk2(lo, hi); }

__device__ __forceinline__ void tile_of(int L, int nM, int nN, int& pm, int& pn) {
    const int nwg = nM * nN; int wgid = L;
    { const int q = nwg / NXCD, r = nwg % NXCD, xcd = wgid % NXCD, off = wgid / NXCD; wgid = (xcd < r ? xcd * (q + 1) : r * (q + 1) + (xcd - r) * q) + off; }
    const int nig = WGM * nN, gid = wgid / nig, fm = gid * WGM, gsz = (nM - fm) < WGM ? (nM - fm) : WGM;
    pm = fm + ((wgid % nig) % gsz); pn = (wgid % nig) / gsz;
}
struct SchedStatic {
    static constexpr bool GATHER = false;
    const char* A; const char* Bt; size_t tstep; int nM, nN, G, c;
    __device__ __forceinline__ void init(const void* A_, const void* Bt_, int M, int N, int K, int G_, int c_) { A = (const char*)A_; Bt = (const char*)Bt_; tstep = (size_t)BM * K * 2; nM = M / BM; nN = N / BM; G = G_; c = c_; }
    __device__ __forceinline__ bool next(int i, Unit& u) const { const long L = (long)i * G + c; if (L >= (long)nM * nN) return false; tile_of((int)L, nM, nN, u.pm, u.pn); u.e = 0; return true; }
    __device__ __forceinline__ const char* aptr(const Unit& u) const { return A + (size_t)u.pm * tstep; }
    __device__ __forceinline__ const char* bptr(const Unit& u) const { return Bt + (size_t)u.pn * tstep; }
};
struct SchedWin {
    static constexpr bool GATHER = false;
    const char* A; const char* Bt; size_t tstep; int G, c, part;
    __device__ __forceinline__ bool next(int i, Unit& u) const {
        const int L = i * G + c, nmf = part ? 128 : 136, nfull = nmf * 27; u.e = 0;
        if (L < nfull) { tile_of(L, nmf, 27, u.pm, u.pn); return true; }
        const int L2 = L - nfull; if (!part || L2 >= 8 * 9) return false;
        u.pm = 128 + L2 / 9; u.pn = 6 + L2 % 9; return true; }
    __device__ __forceinline__ const char* aptr(const Unit& u) const { return A + (size_t)u.pm * tstep; }
    __device__ __forceinline__ const char* bptr(const Unit& u) const { return Bt + (size_t)u.pn * tstep; }
};
struct SchedMerge {
    static constexpr bool GATHER = false;
    const char* A0; const char* A1; const char* A2; const char* Bt; size_t tstep, bstride; int nM, nN, G, c;
    __device__ __forceinline__ bool next(int i, Unit& u) const { const int j = i / 3, br = i - 3 * j; const long L = (long)j * G + c; if (L >= (long)nM * nN) return false; tile_of((int)L, nM, nN, u.pm, u.pn); u.e = br; return true; }
    __device__ __forceinline__ const char* aptr(const Unit& u) const { return (u.e == 0 ? A0 : (u.e == 1 ? A1 : A2)) + (size_t)u.pm * tstep; }
    __device__ __forceinline__ const char* bptr(const Unit& u) const { return Bt + (size_t)u.e * bstride + (size_t)u.pn * tstep; }
};
struct SchedMoe {
    static constexpr bool GATHER = false;
    const char* A; const char* Bt; size_t tstep, estride; int NPN, G, c; const LAS int* base;
    __device__ __forceinline__ bool next(int i, Unit& u) const {
        const int ntiles = base[32] >> 8; const int per = G >> 3;
        const long L = (long)i * G + (((G & 7) == 0) ? (c & 7) * per + (c >> 3) : c);
        if (L >= (long)ntiles * NPN) return false;
        u.pm = (int)(L / NPN); u.pn = (int)(L % NPN); const int r0 = u.pm << 8; int e = 0;
#pragma unroll 1
        for (int k = 1; k < 32; ++k) e += (r0 >= base[k]) ? 1 : 0;
        u.e = e; return true;
    }
    __device__ __forceinline__ const char* aptr(const Unit& u) const { return A + (size_t)u.pm * tstep; }
    __device__ __forceinline__ const char* bptr(const Unit& u) const { return Bt + (size_t)u.e * estride + (size_t)u.pn * tstep; }
};
struct SchedMoeG : SchedMoe {
    static constexpr bool GATHER = true;
    const unsigned* rowof;
    __device__ __forceinline__ const char* aptr(const Unit&) const { return A; }
    __device__ __forceinline__ const unsigned* rowptr(const Unit& u) const { return rowof + (size_t)u.e * MOE_CAP + ((u.pm << 8) - base[u.e]); }
    __device__ __forceinline__ int valid(const Unit& u) const { return base[64 + u.e] - ((u.pm << 8) - base[u.e]); }
};

template <class Epi, class Sched>
__device__ __forceinline__ void gemm_phase(LAS unsigned char* lds, const int tid, const int K, const Sched& S, const Epi& E) {
    const int wid = __builtin_amdgcn_readfirstlane(tid >> 6), lane = tid & 63, wr = wid >> 2, wc = wid & 3, fr = lane & 15, fq = lane >> 4;
    const int nt = K / BK;
    unsigned voffA[2], voffB[2];
#pragma unroll
    for (int i = 0; i < 2; ++i) { int R, C; stage_rc(tid * 16 + i * 8192, R, C); const int Rb = Epi::PERM ? ((R & ~31) + perm32(R & 31)) : R;
        voffA[i] = (unsigned)(R * K + C) * 2u; voffB[i] = (unsigned)(Rb * K + C) * 2u; }
    const size_t kstep = (size_t)(BK * 2);
    const size_t hstep = (size_t)HALF * K * 2;
    const unsigned ldsw = (unsigned)wid * 1024u;
    const int aoff = lds_byte(wr * 64 + fr, fq * 8), boff = lds_byte(wc * 32 + fr, fq * 8);
#define PG8_SA(b, h) (((b) * 2 + (h)) * HTB)
#define PG8_SB(b, h) ((4 + (b) * 2 + (h)) * HTB)
#define PG8_STAGE(bufoff, gbase, voff) do { _Pragma("unroll") for (int _i = 0; _i < 2; ++_i) \
        __builtin_amdgcn_global_load_lds((const unsigned*)((const char*)(gbase) + (voff)[_i]), (LAS unsigned*)(lds + (bufoff) + ldsw + _i * 8192), 16, 0, 0); } while (0)
#define PG8_STAGEA(bufoff, kp, h) do { if constexpr (Sched::GATHER) { _Pragma("unroll") for (int _i = 0; _i < 2; ++_i) \
        __builtin_amdgcn_global_load_lds((const unsigned*)((const char*)(kp) + g[2 * (h) + _i]), (LAS unsigned*)(lds + (bufoff) + ldsw + _i * 8192), 16, 0, 0); } \
        else { PG8_STAGE(bufoff, (kp) + (h) * hstep, voffA); } } while (0)
#define PG8_GLOAD(un_, buf) do { const LAS unsigned* rt_ = (const LAS unsigned*)(lds + ROWTAB_OFF + (buf) * 1024) + gR0; const int nv_ = S.valid(un_); \
        _Pragma("unroll") for (int _j = 0; _j < 4; ++_j) g[_j] = ((gR0 + 64 * _j < nv_) ? rt_[64 * _j] : 0u) + gCb; } while (0)
#define PG8_GDMA(un_, buf) do { if (wid == 0) { unsigned lo_ = (unsigned)threadIdx.x; asm volatile("" : "+v"(lo_)); lo_ = (lo_ & 63u) * 16u; \
        __builtin_amdgcn_global_load_lds((const unsigned*)((const char*)S.rowptr(un_) + lo_), (LAS unsigned*)(lds + ROWTAB_OFF + (buf) * 1024), 16, 0, 0); } } while (0)
#define PG8_LDA(dst, b, h) do { _Pragma("unroll") for (int m = 0; m < 4; ++m) _Pragma("unroll") for (int k = 0; k < 2; ++k) dst[m][k] = *(const LAS bf16x8*)(lds + PG8_SA(b, h) + aoff + m * 2048 + k * 1024); } while (0)
#define PG8_LDB(dst, b, h) do { _Pragma("unroll") for (int n = 0; n < 2; ++n) _Pragma("unroll") for (int k = 0; k < 2; ++k) dst[n][k] = *(const LAS bf16x8*)(lds + PG8_SB(b, h) + boff + n * 2048 + k * 1024); } while (0)
#define PG8_MMA(ai, bj, At, Bt) do { __builtin_amdgcn_s_setprio(1); _Pragma("unroll") for (int m = 0; m < 4; ++m) _Pragma("unroll") for (int n = 0; n < 2; ++n) _Pragma("unroll") for (int k = 0; k < 2; ++k) \
        acc[ai][bj][m][n] = __builtin_amdgcn_mfma_f32_16x16x32_bf16(Bt[n][k], At[m][k], acc[ai][bj][m][n], 0, 0, 0); __builtin_amdgcn_s_setprio(0); } while (0)
#define PG8_WAIT_V(n) asm volatile("s_waitcnt vmcnt(" #n ")" ::: "memory")
#define PG8_WAIT_L(n) asm volatile("s_waitcnt lgkmcnt(" #n ")" ::: "memory")
#define PG8_BAR __builtin_amdgcn_s_barrier()
#define PG8_SCHED __builtin_amdgcn_sched_barrier(0)
    Unit cur, nxt; int ui = 0;
    if (!S.next(0, cur)) return;
    f32x4 acc[2][2][4][2];
#pragma unroll
    for (int a = 0; a < 2; ++a)
#pragma unroll
        for (int b = 0; b < 2; ++b)
#pragma unroll
            for (int m = 0; m < 4; ++m)
#pragma unroll
                for (int n = 0; n < 2; ++n) acc[a][b][m][n] = (f32x4){0.f, 0.f, 0.f, 0.f};
    bf16x8 At[4][2], B0[2][2], B1[2][2];
    const char* cA = S.aptr(cur); const char* cB = S.bptr(cur);
    unsigned g[4] = {0u, 0u, 0u, 0u}; int gR0 = 0; unsigned gCb = 0u;
    if constexpr (Sched::GATHER) { int R, C; stage_rc(tid * 16, R, C); gR0 = R; gCb = (unsigned)C * 2u;
        PG8_GDMA(cur, 0); PG8_WAIT_V(0); PG8_BAR; PG8_GLOAD(cur, 0); }
    PG8_STAGE(PG8_SB(0, 0), cB, voffB); PG8_STAGE(PG8_SB(0, 1), cB + hstep, voffB); PG8_STAGEA(PG8_SA(0, 0), cA, 0); PG8_STAGEA(PG8_SA(0, 1), cA, 1);
    if (wr == 1) PG8_BAR;
    PG8_WAIT_V(2); PG8_BAR;
    PG8_STAGE(PG8_SB(1, 0), cB + kstep, voffB); PG8_STAGEA(PG8_SA(1, 0), cA + kstep, 0); PG8_STAGE(PG8_SB(1, 1), cB + hstep + kstep, voffB);
    PG8_WAIT_V(6); PG8_BAR;
    for (;;) {
        const bool has_next = S.next(ui + 1, nxt);
        const char* nA = has_next ? S.aptr(nxt) : cA; const char* nB = has_next ? S.bptr(nxt) : cB;
        if constexpr (Sched::GATHER) { if (has_next) PG8_GDMA(nxt, (ui + 1) & 1); }
        for (int t = 0; t < nt; t += 2) {
            const bool last = (t == nt - 2);
            const char* a1 = cA + (size_t)(t + 1) * kstep;
            const char* a2 = last ? nA : cA + (size_t)(t + 2) * kstep; const char* b2 = last ? nB : cB + (size_t)(t + 2) * kstep;
            const char* a3 = a2 + kstep; const char* b3 = b2 + kstep;
            PG8_LDB(B0, 0, 0); PG8_LDB(B1, 0, 1); PG8_SCHED; PG8_LDA(At, 0, 0); PG8_STAGEA(PG8_SA(1, 1), a1, 1);
            PG8_WAIT_V(8); PG8_WAIT_L(0); PG8_BAR; PG8_MMA(0, 0, At, B0); PG8_MMA(0, 1, At, B1); PG8_BAR; PG8_SCHED;
            if constexpr (Sched::GATHER) { if (last && has_next) PG8_GLOAD(nxt, (ui + 1) & 1); PG8_SCHED; }
            PG8_LDA(At, 0, 1); PG8_STAGE(PG8_SB(0, 0), b2, voffB); PG8_STAGE(PG8_SB(0, 1), b2 + hstep, voffB); PG8_STAGEA(PG8_SA(0, 0), a2, 0);
            PG8_WAIT_V(8); PG8_WAIT_L(0); PG8_BAR; PG8_MMA(1, 0, At, B0); PG8_MMA(1, 1, At, B1); PG8_BAR; PG8_SCHED;
            PG8_LDB(B0, 1, 0); PG8_LDB(B1, 1, 1); PG8_SCHED; PG8_LDA(At, 1, 0); PG8_STAGEA(PG8_SA(0, 1), a2, 1);
            PG8_WAIT_V(8); PG8_WAIT_L(0); PG8_BAR; PG8_MMA(0, 0, At, B0); PG8_MMA(0, 1, At, B1); PG8_BAR; PG8_SCHED;
            PG8_LDA(At, 1, 1); PG8_STAGE(PG8_SB(1, 0), b3, voffB); PG8_STAGE(PG8_SB(1, 1), b3 + hstep, voffB); PG8_STAGEA(PG8_SA(1, 0), a3, 0);
            PG8_WAIT_V(8); PG8_WAIT_L(0); PG8_BAR; PG8_MMA(1, 0, At, B0); PG8_MMA(1, 1, At, B1); PG8_BAR; PG8_SCHED;
        }
        if (wr == 0) PG8_BAR;
        { int t2_ = (int)threadIdx.x; asm volatile("" : "+v"(t2_)); E(acc, cur, wr, wc, t2_ & 15, (t2_ >> 4) & 3); }
        if (!has_next) break;
#pragma unroll
        for (int a = 0; a < 2; ++a)
#pragma unroll
            for (int b = 0; b < 2; ++b)
#pragma unroll
                for (int m = 0; m < 4; ++m)
#pragma unroll
                    for (int n = 0; n < 2; ++n) acc[a][b][m][n] = (f32x4){0.f, 0.f, 0.f, 0.f};
        cur = nxt; cA = nA; cB = nB; ++ui;
        if (wr == 1) PG8_BAR;
    }
    PG8_WAIT_V(0);
    PG8_BAR;
#undef PG8_SA
#undef PG8_SB
#undef PG8_STAGE
#undef PG8_STAGEA
#undef PG8_GLOAD
#undef PG8_GDMA
#undef PG8_LDA
#undef PG8_LDB
#undef PG8_MMA
#undef PG8_WAIT_V
#undef PG8_WAIT_L
#undef PG8_BAR
#undef PG8_SCHED
}

struct EpiBf16 {
    static constexpr bool PERM = true;
    bf16* O; int ldc; const float* bias; int bias_stride;
    __device__ __forceinline__ void operator()(const f32x4 (&acc)[2][2][4][2], const Unit& u, int wr, int wc, int fr, int fq) const {
        const int row0 = u.pm * BM + wr * 64 + fr, col0 = u.pn * BM + wc * 32 + 8 * fq;
        f32x4 bv[2][2];
#pragma unroll
        for (int bj = 0; bj < 2; ++bj)
#pragma unroll
            for (int n = 0; n < 2; ++n) bv[bj][n] = bias ? *(const f32x4*)(bias + (size_t)u.e * bias_stride + col0 + bj * HALF + 4 * n) : (f32x4){0.f, 0.f, 0.f, 0.f};
#pragma unroll
        for (int ai = 0; ai < 2; ++ai)
#pragma unroll
            for (int m = 0; m < 4; ++m) { bf16* rowp = O + (size_t)(row0 + ai * HALF + m * 16) * ldc + col0;
#pragma unroll
                for (int bj = 0; bj < 2; ++bj) { const f32x4 v0 = acc[ai][bj][m][0] + bv[bj][0], v1 = acc[ai][bj][m][1] + bv[bj][1];
                    v4u w; w.x = cvt_pk_bf16(v0[0], v0[1]); w.y = cvt_pk_bf16(v0[2], v0[3]); w.z = cvt_pk_bf16(v1[0], v1[1]); w.w = cvt_pk_bf16(v1[2], v1[3]);
                    *(v4u*)(rowp + bj * HALF) = w; } }
    }
};
template <int MODE> struct EpiGlu {
    static constexpr bool PERM = true;
    bf16* O; int ldc; const float* bias; int bias_stride, hs;
    __device__ __forceinline__ void operator()(const f32x4 (&acc)[2][2][4][2], const Unit& u, int wr, int wc, int fr, int fq) const {
        const int row0 = u.pm * BM + wr * 64 + fr, col0 = u.pn * HALF + wc * 32 + 8 * fq;
        const float* bp = bias + (size_t)u.e * bias_stride + col0;
        f32x4 ba[2], bb[2];
#pragma unroll
        for (int n = 0; n < 2; ++n) { ba[n] = *(const f32x4*)(bp + 4 * n); bb[n] = *(const f32x4*)(bp + hs + 4 * n); }
#pragma unroll
        for (int ai = 0; ai < 2; ++ai)
#pragma unroll
            for (int m = 0; m < 4; ++m) { bf16* rowp = O + (size_t)(row0 + ai * HALF + m * 16) * ldc + col0;
                float o[8];
#pragma unroll
                for (int n = 0; n < 2; ++n) { const f32x4 a = acc[ai][0][m][n] + ba[n], b = acc[ai][1][m][n] + bb[n];
#pragma unroll
                    for (int j = 0; j < 4; ++j) {
                        if (MODE == 0) o[4 * n + j] = a[j] * sigm(b[j]);
                        else { const float g = fminf(a[j], 7.f), up = fminf(fmaxf(b[j], -7.f), 7.f); o[4 * n + j] = (up + 1.f) * g * sigm(1.702f * g); } } }
                v4u w; w.x = cvt_pk_bf16(o[0], o[1]); w.y = cvt_pk_bf16(o[2], o[3]); w.z = cvt_pk_bf16(o[4], o[5]); w.w = cvt_pk_bf16(o[6], o[7]);
                *(v4u*)rowp = w; }
    }
};
struct EpiMerge {
    static constexpr bool PERM = true;
    bf16* mtmp; bf16* Mo; const bf16* zg;
    __device__ __forceinline__ void operator()(const f32x4 (&acc)[2][2][4][2], const Unit& u, int wr, int wc, int fr, int fq) const {
        const int row0 = u.pm * BM + wr * 64 + fr, col0 = u.pn * BM + wc * 32 + 8 * fq;
#pragma unroll
        for (int ai = 0; ai < 2; ++ai)
#pragma unroll
            for (int m = 0; m < 4; ++m) { const size_t r = (size_t)(row0 + ai * HALF + m * 16);
#pragma unroll
                for (int bj = 0; bj < 2; ++bj) { const int c = col0 + bj * HALF;
                    const v4u gz = *(const v4u*)(zg + r * IN_COLS + u.e * 1024 + c);
                    float g[8] = {bflo(gz.x), bfhi(gz.x), bflo(gz.y), bfhi(gz.y), bflo(gz.z), bfhi(gz.z), bflo(gz.w), bfhi(gz.w)};
                    f32x4 t0, t1; bf16* tp = mtmp + r * 1024 + c;
                    if (u.e == 0) { t0 = (f32x4){0.f, 0.f, 0.f, 0.f}; t1 = t0; } else { const v4u pv = *(const v4u*)tp; t0 = (f32x4){bflo(pv.x), bfhi(pv.x), bflo(pv.y), bfhi(pv.y)}; t1 = (f32x4){bflo(pv.z), bfhi(pv.z), bflo(pv.w), bfhi(pv.w)}; }
#pragma unroll
                    for (int j = 0; j < 4; ++j) { t0[j] += sigm(g[j]) * acc[ai][bj][m][0][j]; t1[j] += sigm(g[4 + j]) * acc[ai][bj][m][1][j]; }
                    if (u.e < 2) { v4u w; w.x = cvt_pk_bf16(t0[0], t0[1]); w.y = cvt_pk_bf16(t0[2], t0[3]); w.z = cvt_pk_bf16(t1[0], t1[1]); w.w = cvt_pk_bf16(t1[2], t1[3]); *(v4u*)tp = w; }
                    else { v4u w; w.x = cvt_pk_bf16(t0[0], t0[1]); w.y = cvt_pk_bf16(t0[2], t0[3]); w.z = cvt_pk_bf16(t1[0], t1[1]); w.w = cvt_pk_bf16(t1[2], t1[3]);
                        *(v4u*)(Mo + r * 1024 + c) = w; } } }
    }
};
struct EpiResid {
    static constexpr bool PERM = false;
    float* X; const float* gmod;
    __device__ __forceinline__ void operator()(const f32x4 (&acc)[2][2][4][2], const Unit& u, int wr, int wc, int fr, int fq) const {
        const int row0 = u.pm * BM + wr * 64 + fr, col0 = u.pn * BM + wc * 32 + 4 * fq;
        const int r00 = u.pm * BM; const int w = r00 < T_LAT ? (r00 >> 12) : 8;
        f32x4 gv[2][2];
#pragma unroll
        for (int bj = 0; bj < 2; ++bj)
#pragma unroll
            for (int n = 0; n < 2; ++n) gv[bj][n] = *(const f32x4*)(gmod + (size_t)w * 6144 + col0 + bj * HALF + n * 16);
#pragma unroll
        for (int ai = 0; ai < 2; ++ai)
#pragma unroll
            for (int m = 0; m < 4; ++m) { float* rowp = X + (size_t)(row0 + ai * HALF + m * 16) * 1024 + col0;
#pragma unroll
                for (int bj = 0; bj < 2; ++bj)
#pragma unroll
                    for (int n = 0; n < 2; ++n) { f32x4* p = (f32x4*)(rowp + bj * HALF + n * 16); *p = *p + gv[bj][n] * acc[ai][bj][m][n]; } }
    }
};
}

struct Args { const float* in[51]; float* out; unsigned char* ws; int ph_lo, ph_hi; };
enum { I_X = 0, I_C, I_CTX, I_CCTX, I_ADAW, I_ADAB, I_N1G, I_N2G, I_WIN, I_HYCW, I_HYCB, I_HYW1, I_HYB1, I_HYF1, I_HYW2, I_HYB2, I_HYF2, I_HYW3, I_HYB3, I_HYBIAS,
       I_RWCW, I_RWCB, I_RWWUP, I_RWW0, I_RWAUP, I_RWA0, I_RWGUP, I_RWKK, I_RWKA, I_RWRK, I_RWLNG, I_RWLNB, I_S5ARE, I_S5AIM, I_S5LDT, I_S5BRE, I_S5BIM, I_S5CRE, I_S5CIM, I_S5D,
       I_S5GLUW, I_S5GLUB, I_WBR, I_WOUT, I_RTW, I_RTB, I_W1, I_B1, I_W2, I_B2, I_FING };

typedef const __attribute__((address_space(4))) Args* CArgsP;
__device__ __forceinline__ CArgsP kargs() { CArgsP p = (CArgsP)__builtin_amdgcn_kernarg_segment_ptr(); asm volatile("" : "+s"(p)); return p; }
__device__ __forceinline__ int opaque(int v) { asm volatile("" : "+s"(v)); return v; }
__device__ __forceinline__ int opaque_v(int v) { asm volatile("" : "+v"(v)); return v; }
struct Ctx { CArgsP a; LAS unsigned char* lds; int tid, lane, wave, bid, G; };

__device__ __forceinline__ void row_seq(int row, int& base, int& pos, int& n) {
    if (row < T_LAT) { base = row & ~(SEQ - 1); pos = row & (SEQ - 1); n = SEQ; }
    else { const int r = row - T_LAT; base = T_LAT + (r & ~(CTXL - 1)); pos = r & (CTXL - 1); n = CTXL; }
}
__device__ __forceinline__ float conv3z(const bf16* zc, int pos, int n, float w0, float w1, float w2, float b) {
    const float zm = pos > 0 ? bf2f(zc[(size_t)(pos - 1) * IN_COLS]) : 0.f, z0 = bf2f(zc[(size_t)pos * IN_COLS]), zp = pos < n - 1 ? bf2f(zc[(size_t)(pos + 1) * IN_COLS]) : 0.f;
    return zm * w0 + z0 * w1 + zp * w2 + b;
}

template <int MODE>
__device__ __forceinline__ void transpose_item(const float* W, int K, int N, bf16* WT, int Hs, LAS float* scr, int item, int lane) {
    const int nblk = N / 32, kb = item / nblk, nb = item % nblk, k0 = 64 * kb, n0 = 32 * nb;
#pragma unroll 8
    for (int i = 0; i < 32; ++i) { const int kk = 2 * i + (lane >> 5); scr[kk * 33 + (lane & 31)] = W[(size_t)(k0 + kk) * N + n0 + (lane & 31)]; }
    LDS_WAIT(); asm volatile("" ::: "memory");
    const int c = lane & 7;
#pragma unroll
    for (int j = 0; j < 4; ++j) { const int n = (lane >> 3) + 8 * j; const LAS float* s = scr + (8 * c) * 33 + n;
        v4u o; o.x = pk2(s[0 * 33], s[1 * 33]); o.y = pk2(s[2 * 33], s[3 * 33]); o.z = pk2(s[4 * 33], s[5 * 33]); o.w = pk2(s[6 * 33], s[7 * 33]);
        int dr = n0 + n;
        if (MODE == 1) { const int nc = n0 + n; const int jx = nc < Hs ? nc : nc - Hs; dr = (jx >> 7) * 256 + (nc < Hs ? 0 : 128) + (jx & 127); }
        *(v4u*)(WT + (size_t)dr * K + k0 + 8 * c) = o; }
    LDS_WAIT(); asm volatile("" ::: "memory");
}

__device__ __forceinline__ void p0_prologue(const Ctx& F) {
    const auto& a = *F.a; unsigned char* ws = a.ws;
    const int gw = F.bid * NWAVES + F.wave, NGW = F.G * NWAVES, lane = F.lane;
    float* X = (float*)(ws + WS_X);
    for (int t = gw; t < SEQ; t += NGW) {
        const float pr = (float)(t >> 6), pc = (float)(t & 63);
        f32x4 pe[4];
#pragma unroll
        for (int j = 0; j < 4; ++j)
#pragma unroll
            for (int e = 0; e < 4; ++e) { const float om = __builtin_amdgcn_exp2f((float)(4 * lane + e) * (-13.287712379549449f / 256.0f)); const float ang = ((j < 2) ? pr : pc) * om; pe[j][e] = (j & 1) ? __cosf(ang) : __sinf(ang); }
#pragma unroll 2
        for (int bb = 0; bb < BATCH; ++bb) { const size_t row = (size_t)bb * SEQ + t;
            const f32x4* xi = (const f32x4*)(a.in[I_X] + row * D) + lane; f32x4* xo = (f32x4*)(X + row * D) + lane;
#pragma unroll
            for (int j = 0; j < 4; ++j) xo[64 * j] = xi[64 * j] + pe[j]; }
    }
    for (int row = T_LAT + gw; row < T_ALL; row += NGW) {
        const f32x4* xi = (const f32x4*)(a.in[I_CTX] + (size_t)(row - T_LAT) * D) + lane; f32x4* xo = (f32x4*)(X + (size_t)row * D) + lane;
#pragma unroll
        for (int j = 0; j < 4; ++j) xo[64 * j] = xi[64 * j];
    }
    {
        LAS float* condl = (LAS float*)F.lds; LAS float* psum = (LAS float*)(F.lds + 40960);
        for (int i = F.tid; i < 9 * 1024; i += NTHREADS) { const int w = i >> 10, k = i & 1023; const float cv = (w < 8) ? a.in[I_C][w * 1024 + k] : a.in[I_CCTX][k]; condl[i] = cv / (1.f + expf(-cv)); }
        __syncthreads();
        float* MOD = (float*)(ws + WS_MOD);
        for (int it = F.bid; it < 2 * 96; it += F.G) {
            const int l = it / 96, cg = it % 96, col = cg * 64 + lane;
            float acc[9];
#pragma unroll
            for (int w = 0; w < 9; ++w) acc[w] = 0.f;
            const float* wp = a.in[I_ADAW] + ((size_t)l * 1024 + F.wave * 128) * 6144 + col;
#pragma unroll 1
            for (int k0 = 0; k0 < 128; k0 += 16) { float wv[16];
#pragma unroll
                for (int k = 0; k < 16; ++k) wv[k] = wp[(size_t)(k0 + k) * 6144];
#pragma unroll
                for (int k = 0; k < 16; ++k)
#pragma unroll
                    for (int w = 0; w < 9; ++w) acc[w] += condl[w * 1024 + F.wave * 128 + k0 + k] * wv[k]; }
#pragma unroll
            for (int w = 0; w < 9; ++w) psum[(F.wave * 9 + w) * 64 + lane] = acc[w];
            __syncthreads();
            if (F.wave == 0) {
#pragma unroll
                for (int w = 0; w < 9; ++w) { float s = 0.f;
#pragma unroll
                    for (int wv = 0; wv < 8; ++wv) s += psum[(wv * 9 + w) * 64 + lane];
                    MOD[(size_t)(l * 9 + w) * 6144 + col] = s + a.in[I_ADAB][l * 6144 + col]; }
            }
            __syncthreads();
        }
    }
    {
        LAS float* scr = (LAS float*)(F.lds + F.wave * 16384);
        constexpr int IT_W1 = 16 * 64, IT_W2 = 16 * 32, IT_WIN = 16 * 216, IT_GLU = 8 * 32, IT_WBR = 8 * 32, IT_WOUT = 16 * 32;
        constexpr int N_W1 = 64 * IT_W1, N_W2 = 64 * IT_W2, N_WIN = 2 * IT_WIN, N_GLU = 2 * IT_GLU, N_WBR = 6 * IT_WBR, N_WOUT = 2 * IT_WOUT;
        constexpr int NITEMS = N_W1 + N_W2 + N_WIN + N_GLU + N_WBR + N_WOUT;
        for (int it = gw; it < NITEMS; it += NGW) {
            int r = it;
            if (r < N_W1) { const int mtx = r / IT_W1, l = mtx >> 5, e = mtx & 31; transpose_item<1>(a.in[I_W1] + (size_t)mtx * 1024 * 2048, 1024, 2048, (bf16*)(ws + WS_WTS + l * WL_STRIDE + WO_W1) + (size_t)e * 2048 * 1024, 1024, scr, r % IT_W1, lane); continue; } r -= N_W1;
            if (r < N_W2) { const int mtx = r / IT_W2, l = mtx >> 5, e = mtx & 31; transpose_item<0>(a.in[I_W2] + (size_t)mtx * 1024 * 1024, 1024, 1024, (bf16*)(ws + WS_WTS + l * WL_STRIDE + WO_W2) + (size_t)e * 1024 * 1024, 0, scr, r % IT_W2, lane); continue; } r -= N_W2;
            if (r < N_WIN) { const int l = r / IT_WIN; transpose_item<0>(a.in[I_WIN] + (size_t)l * 1024 * IN_COLS, 1024, IN_COLS, (bf16*)(ws + WS_WTS + l * WL_STRIDE + WO_WIN), 0, scr, r % IT_WIN, lane); continue; } r -= N_WIN;
            if (r < N_GLU) { const int l = r / IT_GLU; transpose_item<1>(a.in[I_S5GLUW] + (size_t)l * 512 * 1024, 512, 1024, (bf16*)(ws + WS_WTS + l * WL_STRIDE + WO_GLU), 512, scr, r % IT_GLU, lane); continue; } r -= N_GLU;
            if (r < N_WBR) { const int mtx = r / IT_WBR, l = mtx / 3, br = mtx % 3; transpose_item<0>(a.in[I_WBR] + (size_t)mtx * 512 * 1024, 512, 1024, (bf16*)(ws + WS_WTS + l * WL_STRIDE + WO_WBR) + (size_t)br * 1024 * 512, 0, scr, r % IT_WBR, lane); continue; } r -= N_WBR;
            { const int l = r / IT_WOUT; transpose_item<0>(a.in[I_WOUT] + (size_t)l * 1024 * 1024, 1024, 1024, (bf16*)(ws + WS_WTS + l * WL_STRIDE + WO_WOUT), 0, scr, r % IT_WOUT, lane); }
        }
        for (int i = F.bid * NTHREADS + F.tid; i < 2 * 2560 * 256; i += F.G * NTHREADS) {
            const int l = i / (2560 * 256), r = i % (2560 * 256), n = r >> 8, k = r & 255; float v = 0.f;
            if (n < 1024) { if (k < 64) v = a.in[I_RWWUP][(((size_t)l * 2 + (n >> 9)) * 64 + k) * 512 + (n & 511)]; }
            else if (n < 2048) { if (k >= 64 && k < 128) v = a.in[I_RWAUP][(((size_t)l * 2 + ((n - 1024) >> 9)) * 64 + (k - 64)) * 512 + (n & 511)]; }
            else { if (k >= 128) v = a.in[I_RWGUP][((size_t)l * 128 + (k - 128)) * 512 + (n - 2048)]; }
            ((bf16*)(ws + WS_WTS + l * WL_STRIDE + WO_RWCAT))[r] = (bf16)f2bf(v);
        }
    }
    __syncthreads();
    {
        LAS float* feats = (LAS float*)F.lds; LAS float* h1 = feats + 8 * 33; LAS float* h2 = h1 + 8 * 64;
        constexpr int NIT = 2 * (512 + 32);
        for (int it = F.bid; it < NIT; it += F.G) {
            const int l = it / 544, r = it % 544, nsel = r >= 512, n = nsel ? CTXL : SEQ, p0 = (nsel ? r - 512 : r) * 8;
            if (F.tid < 8 * 33) { const int p = F.tid / 33, i = F.tid % 33, pos = p0 + p; float f;
                if (i == 0) f = (float)pos / (float)(n - 1);
                else { const int k = (i - 1) & 15; const float band = 1e-4f + (float)k * ((15.0f - 1e-4f) / 15.0f); const float ang = (6.283185307179586f * (float)pos / (float)n) * band; f = (i <= 16) ? cosf(ang) : -sinf(ang); }
                feats[p * 33 + i] = f; }
            __syncthreads();
            { const int p = F.tid >> 6, j = F.tid & 63; float s = a.in[I_HYB1][l * 64 + j]; const float* w1p = a.in[I_HYW1] + (size_t)l * 33 * 64 + j;
#pragma unroll
                for (int i = 0; i < 33; ++i) s += feats[p * 33 + i] * w1p[i * 64];
                h1[p * 64 + j] = sinf(a.in[I_HYF1][l * 64 + j] * s); }
            __syncthreads();
            { const int p = F.tid >> 6, j = F.tid & 63; float s = a.in[I_HYB2][l * 64 + j];
                const float* w2p = a.in[I_HYW2] + (size_t)l * 64 * 64 + j;
#pragma unroll 16
                for (int i = 0; i < 64; ++i) s += h1[p * 64 + i] * w2p[i * 64];
                h2[p * 64 + j] = sinf(a.in[I_HYF2][l * 64 + j] * s); }
            __syncthreads();
            float acc[4][8];
#pragma unroll
            for (int q = 0; q < 4; ++q)
#pragma unroll
                for (int p = 0; p < 8; ++p) acc[q][p] = 0.f;
            const float* w3 = a.in[I_HYW3] + (size_t)l * 64 * 2048 + F.tid;
#pragma unroll 8
            for (int i = 0; i < 64; ++i) { float wv[4];
#pragma unroll
                for (int q = 0; q < 4; ++q) wv[q] = w3[(size_t)i * 2048 + q * 512];
#pragma unroll
                for (int p = 0; p < 8; ++p) { const float hv = h2[p * 64 + i];
#pragma unroll
                    for (int q = 0; q < 4; ++q) acc[q][p] += hv * wv[q]; } }
            const int c = F.tid; const float dstart = logf(0.01f) / 1.5f, dstop = logf(0.01f) / 0.3f; const float delta = fabsf(dstart + (float)c * ((dstop - dstart) / 511.0f));
            const int RL = nsel ? HY_RLENC : HY_RLEN, off = n + 47; const float rn1 = 1.0f / (float)(n - 1);
            bf16* Rb = (bf16*)(ws + WS_GF + l * GF_STRIDE + (nsel ? GF_CTX : 0));
#pragma unroll
            for (int q = 0; q < 4; ++q) { const int o = q >> 1, side = q & 1; const float b3 = a.in[I_HYB3][l * 2048 + q * 512 + c];
                bf16* Rc = Rb + ((size_t)o * 512 + c) * RL;
#pragma unroll
                for (int p = 0; p < 8; ++p) { const int pos = p0 + p; const float t = (float)pos * rn1; const float val = (acc[q][p] + b3) * __expf(-t * delta);
                    if (side == 0) Rc[off - pos] = (bf16)f2bf(val);
                    else if (pos >= 1) Rc[off + pos] = (bf16)f2bf(val); }
                if (p0 == 0 && side == 0) { for (int m = 0; m < 48; ++m) Rc[m] = 0; for (int m = off + n; m < RL; ++m) Rc[m] = 0; } }
            __syncthreads();
        }
    }
}

__device__ __forceinline__ void stage_norm1(const Ctx& F, int l) {
    const auto& a = *F.a; unsigned char* ws = a.ws; const int lane = F.lane;
    const int gw = F.bid * NWAVES + F.wave, NGW = F.G * NWAVES;
    float* X = (float*)(ws + WS_X); bf16* H = (bf16*)(ws + WS_H); const float* MOD = (const float*)(ws + WS_MOD);
    const bf16* YS = (const bf16*)(ws + WS_XS); const int* POS = (const int*)(ws + WS_POS); const float* GATE = (const float*)(ws + WS_GATE);
    const int nrows = (l == DEPTH) ? T_LAT : T_ALL;
    f32x4 ngv[4];
    { const f32x4* ngp = (l == DEPTH) ? (const f32x4*)a.in[I_FING] + lane : (const f32x4*)(a.in[I_N1G] + l * D) + lane;
#pragma unroll
      for (int j = 0; j < 4; ++j) ngv[j] = ngp[64 * j]; }
    f32x4 vn[4]; v2u ysn[4][4]; int4 pnn = make_int4(0, 0, 0, 0); f32x4 gn = (f32x4){0.f, 0.f, 0.f, 0.f}, gnn = gn;
#pragma unroll
    for (int k = 0; k < 4; ++k)
#pragma unroll
        for (int j = 0; j < 4; ++j) ysn[k][j] = (v2u){0u, 0u};
#define N1_LDYS(p4_) do { const int pk_[4] = {(p4_).x, (p4_).y, (p4_).z, (p4_).w}; _Pragma("unroll") for (int k = 0; k < 4; ++k) { const v2u* yr_ = (const v2u*)(YS + (size_t)pk_[k] * D) + lane; \
        _Pragma("unroll") for (int j = 0; j < 4; ++j) ysn[k][j] = yr_[64 * j]; } } while (0)
    if (gw < nrows) {
#pragma unroll
        for (int j = 0; j < 4; ++j) vn[j] = ((const f32x4*)(X + (size_t)gw * D) + lane)[64 * j];
        if (l > 0) { const int4 p0 = *(const int4*)(POS + gw * 4); gn = *(const f32x4*)(GATE + gw * 4);
            if (gw + NGW < nrows) { pnn = *(const int4*)(POS + (gw + NGW) * 4); gnn = *(const f32x4*)(GATE + (gw + NGW) * 4); }
            N1_LDYS(p0); } }
#pragma unroll 1
    for (int row = gw; row < nrows; row += NGW) {
        const int w = row < T_LAT ? (row >> 12) : 8;
        f32x4* xr = (f32x4*)(X + (size_t)row * D) + lane;
        f32x4 v[4]; v2u ysc[4][4];
#pragma unroll
        for (int j = 0; j < 4; ++j) v[j] = vn[j];
#pragma unroll
        for (int k = 0; k < 4; ++k)
#pragma unroll
            for (int j = 0; j < 4; ++j) ysc[k][j] = ysn[k][j];
        const f32x4 gc = gn; const int4 pnx = pnn; gn = gnn;
        const int rn = row + NGW, rnn = row + 2 * NGW;
        if (rn < nrows) {
#pragma unroll
            for (int j = 0; j < 4; ++j) vn[j] = ((const f32x4*)(X + (size_t)rn * D) + lane)[64 * j];
            if (l > 0) N1_LDYS(pnx); }
        if (l > 0 && rnn < nrows) { pnn = *(const int4*)(POS + rnn * 4); gnn = *(const f32x4*)(GATE + rnn * 4); }
        f32x4 m0[4], m1[4], m2[4];
        if (l < DEPTH) {
#pragma unroll
            for (int j = 0; j < 4; ++j) { m0[j] = ((const f32x4*)(MOD + (size_t)(l * 9 + w) * 6144) + lane)[64 * j]; m1[j] = ((const f32x4*)(MOD + (size_t)(l * 9 + w) * 6144 + 1024) + lane)[64 * j]; } }
        if (l > 0) {
#pragma unroll
            for (int j = 0; j < 4; ++j) m2[j] = ((const f32x4*)(MOD + (size_t)((l - 1) * 9 + w) * 6144 + 5120) + lane)[64 * j];
            f32x4 mo[4];
#pragma unroll
            for (int j = 0; j < 4; ++j) mo[j] = (f32x4){0.f, 0.f, 0.f, 0.f};
#pragma unroll
            for (int k = 0; k < TOPK; ++k) { const float g = gc[k];
#pragma unroll
                for (int j = 0; j < 4; ++j) { const v2u y = ysc[k][j]; mo[j][0] += g * bflo(y.x); mo[j][1] += g * bfhi(y.x); mo[j][2] += g * bflo(y.y); mo[j][3] += g * bfhi(y.y); } }
#pragma unroll
            for (int j = 0; j < 4; ++j) { v[j] = v[j] + m2[j] * mo[j]; xr[64 * j] = v[j]; }
        }
        float ss = 0.f;
#pragma unroll
        for (int j = 0; j < 4; ++j) ss += (v[j][0] * v[j][0] + v[j][1] * v[j][1]) + (v[j][2] * v[j][2] + v[j][3] * v[j][3]);
        const float rstd = __builtin_amdgcn_rsqf(wave_sum(ss) * (1.f / D) + 1e-6f);
        if (l == DEPTH) {
            f32x4* o = (f32x4*)(a.out + (size_t)row * D) + lane;
#pragma unroll
            for (int j = 0; j < 4; ++j) o[64 * j] = v[j] * rstd * ngv[j];
        } else {
            v2u* ho = (v2u*)(H + (size_t)row * D) + lane;
#pragma unroll
            for (int j = 0; j < 4; ++j) { const f32x4 h = v[j] * rstd * ngv[j] * (m1[j] + 1.0f) + m0[j]; v2u o; o.x = pk2(h[0], h[1]); o.y = pk2(h[2], h[3]); ho[64 * j] = o; }
        }
    }
#undef N1_LDYS
}

__device__ __forceinline__ void stage_rw_prep1(const Ctx& F, int l) {
    const auto& a = *F.a; unsigned char* ws = a.ws;
    const bf16* __restrict__ Z = (const bf16*)(ws + WS_Z); bf16* __restrict__ ARW = (bf16*)(ws + WS_ARW);
    const int j = 4 * (F.tid & 63), col = 1536 + j, rq = F.tid >> 6;
    const float* cw = a.in[I_RWCW] + (size_t)l * 3 * 1792;
    const f32x4 w0 = *(const f32x4*)(cw + col), w1 = *(const f32x4*)(cw + 1792 + col), w2 = *(const f32x4*)(cw + 2 * 1792 + col), cb = *(const f32x4*)(a.in[I_RWCB] + l * 1792 + col);
#pragma unroll 4
    for (int row = F.bid * 8 + rq; row < T_ALL; row += F.G * 8) {
        int base, pos, n; row_seq(row, base, pos, n);
        const bf16* zc = Z + (size_t)row * IN_COLS + RW_OFF + col;
        const v2u z0 = *(const v2u*)zc;
        v2u zm = (v2u){0u, 0u}, zp = (v2u){0u, 0u};
        if (pos > 0) zm = *(const v2u*)(zc - IN_COLS);
        if (pos < n - 1) zp = *(const v2u*)(zc + IN_COLS);
        f32x4 v = (f32x4){bflo(zm.x), bfhi(zm.x), bflo(zm.y), bfhi(zm.y)} * w0 + (f32x4){bflo(z0.x), bfhi(z0.x), bflo(z0.y), bfhi(z0.y)} * w1 + (f32x4){bflo(zp.x), bfhi(zp.x), bflo(zp.y), bfhi(zp.y)} * w2 + cb;
#pragma unroll
        for (int e2 = 0; e2 < 4; ++e2) { if (j < 64) v[e2] = tanh_fast(v[e2]); else if (j >= 128) v[e2] = sigm(v[e2]); }
        v2u o; o.x = pk2(v[0], v[1]); o.y = pk2(v[2], v[3]);
        *(v2u*)(ARW + (size_t)row * 256 + j) = o;
    }
}

__device__ __forceinline__ void stage_rw_prep2(const Ctx& F, int l) {
    const auto& a = *F.a; unsigned char* ws = a.ws; const int lane = F.lane;
    const bf16* Z = (const bf16*)(ws + WS_Z); const bf16* P = (const bf16*)(ws + WS_P); bf16* SCN = (bf16*)(ws + WS_SCN);
    const int gw = F.bid * NWAVES + F.wave, NGW = F.G * NWAVES;
    constexpr int TR = 17, NRT = T_ALL / TR;
    const float* cw = a.in[I_RWCW] + (size_t)l * 3 * 1792; const float* cbp = a.in[I_RWCB] + l * 1792;
    for (int tile = gw; tile < NRT * 4; tile += NGW) {
        const int rt = tile % NRT, hp = tile / NRT, row0 = rt * TR, c0 = hp * 128 + 2 * lane;
        f32x2 w[3][3], cb[3];
#pragma unroll
        for (int s = 0; s < 3; ++s) { cb[s] = *(const f32x2*)(cbp + s * 512 + c0);
#pragma unroll
            for (int j = 0; j < 3; ++j) w[s][j] = *(const f32x2*)(cw + j * 1792 + s * 512 + c0); }
        const f32x2 KKw = *(const f32x2*)(a.in[I_RWKK] + l * 512 + c0), KAw = *(const f32x2*)(a.in[I_RWKA] + l * 512 + c0);
        f32x2 W0[2], A0[2];
#pragma unroll
        for (int d = 0; d < 2; ++d) { W0[d] = *(const f32x2*)(a.in[I_RWW0] + (l * 2 + d) * 512 + c0); A0[d] = *(const f32x2*)(a.in[I_RWA0] + (l * 2 + d) * 512 + c0); }
        const unsigned* zb = (const unsigned*)(Z + RW_OFF + c0);
        unsigned zw[8][3], pw_[8][4];
#define P2_LDZ(j_) do { const int rr_ = row0 + (j_); if (rr_ >= 0 && rr_ < T_ALL) { _Pragma("unroll") for (int s = 0; s < 3; ++s) zw[((j_) + 1) & 7][s] = zb[(size_t)rr_ * (IN_COLS / 2) + s * 256]; } \
        else { _Pragma("unroll") for (int s = 0; s < 3; ++s) zw[((j_) + 1) & 7][s] = 0u; } } while (0)
#define P2_LDP(j_) do { const unsigned* pr_ = (const unsigned*)(P + (size_t)(row0 + (j_)) * 2560 + c0); pw_[(j_) & 7][0] = pr_[0]; pw_[(j_) & 7][1] = pr_[512]; pw_[(j_) & 7][2] = pr_[256]; pw_[(j_) & 7][3] = pr_[768]; } while (0)
        P2_LDZ(-1); P2_LDZ(0); P2_LDZ(1); P2_LDZ(2); P2_LDZ(3); P2_LDP(0); P2_LDP(1); P2_LDP(2);
#pragma unroll
        for (int i = 0; i < TR; ++i) {
            const int row = row0 + i; int base, pos, n; row_seq(row, base, pos, n);
            if (i + 4 <= TR) P2_LDZ(i + 4);
            if (i + 3 < TR) P2_LDP(i + 3);
            unsigned zm[3], z0[3], zp[3], pc_[4];
#pragma unroll
            for (int s = 0; s < 3; ++s) { zm[s] = zw[i & 7][s]; z0[s] = zw[(i + 1) & 7][s]; zp[s] = zw[(i + 2) & 7][s]; }
#pragma unroll
            for (int e = 0; e < 4; ++e) pc_[e] = pw_[i & 7][e];
            const float mlo = pos > 0 ? 1.f : 0.f, mhi = pos < n - 1 ? 1.f : 0.f;
            f32x2 u[3];
#pragma unroll
            for (int s = 0; s < 3; ++s) u[s] = (f32x2){bflo(zm[s]), bfhi(zm[s])} * mlo * w[s][0] + (f32x2){bflo(z0[s]), bfhi(z0[s])} * w[s][1] + (f32x2){bflo(zp[s]), bfhi(zp[s])} * mhi * w[s][2] + cb[s];
            const f32x2 r = u[0], k = u[1], v = u[2];
            f32x2 kk = k * KKw;
            const float ss = red32(kk[0] * kk[0] + kk[1] * kk[1]);
            kk = kk * (__builtin_amdgcn_rsqf(fmaxf(ss, 1e-24f)));
            unsigned* o = (unsigned*)(SCN + (size_t)row * 9 * 512 + c0);
            o[0] = pk2(r[0], r[1]); o[256] = pk2(v[0], v[1]); o[2 * 256] = pk2(kk[0], kk[1]);
#pragma unroll
            for (int d = 0; d < 2; ++d) {
                const unsigned pw = pc_[2 * d], pa = pc_[2 * d + 1];
                float ld[2], kd[2], be[2];
#pragma unroll
                for (int e = 0; e < 2; ++e) {
                    const float uu = W0[d][e] + (e ? bfhi(pw) : bflo(pw));
                    ld[e] = -0.60653065971263342f * sigm(uu);
                    const float av = sigm(A0[d][e] + (e ? bfhi(pa) : bflo(pa)));
                    kd[e] = k[e] * (1.f + (av - 1.f) * KAw[e]); be[e] = kk[e] * av; }
                o[(3 + 3 * d) * 256] = pk2(ld[0], ld[1]); o[(4 + 3 * d) * 256] = pk2(kd[0], kd[1]); o[(5 + 3 * d) * 256] = pk2(be[0], be[1]);
            }
        }
    }
}
#undef P2_LDZ
#undef P2_LDP

__device__ __forceinline__ int seq_row(int b, int d, int sidx) {
    if (sidx < CTXL) { const int t = d ? (CTXL - 1 - sidx) : sidx; return T_LAT + b * CTXL + t; }
    const int tl = sidx - CTXL; const int t = d ? (SEQ - 1 - tl) : tl; return b * SEQ + t;
}

constexpr int CW_WORK = 16384;
constexpr int CW_STAMP = 20480;
#ifdef PROBE_T
#ifndef PROBE_BID
#define PROBE_BID 0
#endif
#define PT(k) do { if (F.bid == PROBE_BID && F.tid == 0 && l == 0) ((unsigned long long*)(F.a->ws + WS_CTL + CW_STAMP * 4))[k] = __builtin_amdgcn_s_memrealtime(); } while (0)
#else
#define PT(k) do { } while (0)
#endif
__device__ __forceinline__ void rw_scan_item(const Ctx& F, int l, int it2) {
    const int it = it2 >> 1, half = it2 & 1;
    const auto& a = *F.a; unsigned char* ws = a.ws; const int tid = F.tid, lane = F.lane;
    const bf16* SCN = (const bf16*)(ws + WS_SCN); float* YD = (float*)(ws + WS_YDIR);
    LAS float* sbuf = (LAS float*)F.lds;
    LAS float* ybuf = (LAS float*)(F.lds + 49152);
    const bool comp = F.wave < 4;
    const int lt = tid & 255, ls = lt >> 4, lj = lt & 15;
    const int vl = lane >> 3, kq = lane & 7, vrow = half * 32 + (F.wave & 3) * 8 + vl;
    constexpr int NCH = (CTXL + SEQ) / 16;
    const int d = it & 1, h = (it >> 1) & 7, b = it >> 4;
    f32x2 S[4];
#pragma unroll
    for (int q = 0; q < 4; ++q) S[q] = (f32x2){0.f, 0.f};
    v2u ldr[6];
#define RW_ISSUE(c) do { const int row_ = seq_row(b, d, (c) * 16 + ls); const v2u* p_ = (const v2u*)(SCN + (size_t)row_ * 9 * 512 + h * 64) + lj; \
        ldr[0] = p_[2 * 128]; ldr[1] = p_[(3 + 3 * d) * 128]; ldr[2] = p_[(5 + 3 * d) * 128]; ldr[3] = p_[(4 + 3 * d) * 128]; ldr[4] = p_[0]; ldr[5] = p_[128]; } while (0)
#define RW_WRITE(bufi) do { LAS float* o_ = sbuf + (((bufi) * 16 + ls) * 6) * 64 + 4 * lj; \
        *(LAS f32x4*)(o_) = (f32x4){-bflo(ldr[0].x), -bfhi(ldr[0].x), -bflo(ldr[0].y), -bfhi(ldr[0].y)}; \
        *(LAS f32x4*)(o_ + 64) = (f32x4){__expf(bflo(ldr[1].x)), __expf(bfhi(ldr[1].x)), __expf(bflo(ldr[1].y)), __expf(bfhi(ldr[1].y))}; \
        *(LAS f32x4*)(o_ + 128) = (f32x4){bflo(ldr[2].x), bfhi(ldr[2].x), bflo(ldr[2].y), bfhi(ldr[2].y)}; *(LAS f32x4*)(o_ + 192) = (f32x4){bflo(ldr[3].x), bfhi(ldr[3].x), bflo(ldr[3].y), bfhi(ldr[3].y)}; \
        *(LAS f32x4*)(o_ + 256) = (f32x4){bflo(ldr[4].x), bfhi(ldr[4].x), bflo(ldr[4].y), bfhi(ldr[4].y)}; *(LAS f32x4*)(o_ + 320) = (f32x4){bflo(ldr[5].x), bfhi(ldr[5].x), bflo(ldr[5].y), bfhi(ldr[5].y)}; } while (0)
#define RW_FLUSH(c) do { const int row_ = seq_row(b, d, (c) * 16 + ls); \
        *(f32x2*)(YD + ((size_t)d * T_ALL + row_) * 512 + h * 64 + half * 32 + 2 * lj) = *(const LAS f32x2*)(ybuf + ((((c) & 1) * 16 + ls) * 64) + half * 32 + 2 * lj); } while (0)
    if (!comp) { RW_ISSUE(0); RW_WRITE(0); RW_ISSUE(1); }
    __syncthreads();
#pragma unroll 1
    for (int c = 0; c < NCH; ++c) {
        const int bi = c & 1;
        if (!comp) {
            if (c + 1 < NCH) RW_WRITE(bi ^ 1);
            if (c + 2 < NCH) RW_ISSUE(c + 2);
            if (c > 0) RW_FLUSH(c - 1);
        } else {
        float yv[16];
        f32x4 opA[10], opB[10]; float vvA, vvB;
#define RW_LD(op, vvx, s_) do { const LAS float* sp_ = sbuf + ((bi * 16 + (s_)) * 6) * 64 + 8 * kq; \
            _Pragma("unroll") for (int q_ = 0; q_ < 5; ++q_) { op[2 * q_] = *(const LAS f32x4*)(sp_ + 64 * q_); op[2 * q_ + 1] = *(const LAS f32x4*)(sp_ + 64 * q_ + 4); } \
            vvx = sbuf[((bi * 16 + (s_)) * 6 + 5) * 64 + vrow]; } while (0)
#define RW_COMP(op, vvx, s_) do { \
            const f32x4 a0 = op[0], a1 = op[1], w0 = op[2], w1 = op[3], b0 = op[4], b1 = op[5], k0 = op[6], k1 = op[7], r0 = op[8], r1 = op[9]; \
            const f32x2 vv2 = (f32x2){vvx, vvx}; \
            const f32x2 p0 = S[1] * (f32x2){a0[2], a0[3]} + S[0] * (f32x2){a0[0], a0[1]}; \
            const f32x2 p1 = S[3] * (f32x2){a1[2], a1[3]} + S[2] * (f32x2){a1[0], a1[1]}; \
            const f32x2 t0 = S[0] * (f32x2){w0[0], w0[1]} + vv2 * (f32x2){k0[0], k0[1]}; \
            const f32x2 t1 = S[1] * (f32x2){w0[2], w0[3]} + vv2 * (f32x2){k0[2], k0[3]}; \
            const f32x2 t2 = S[2] * (f32x2){w1[0], w1[1]} + vv2 * (f32x2){k1[0], k1[1]}; \
            const f32x2 t3 = S[3] * (f32x2){w1[2], w1[3]} + vv2 * (f32x2){k1[2], k1[3]}; \
            const f32x2 ac = p0 + p1; \
            const float sa = red8(ac[0] + ac[1]); \
            const f32x2 sa2 = (f32x2){sa, sa}; \
            S[0] = sa2 * (f32x2){b0[0], b0[1]} + t0; S[1] = sa2 * (f32x2){b0[2], b0[3]} + t1; \
            S[2] = sa2 * (f32x2){b1[0], b1[1]} + t2; S[3] = sa2 * (f32x2){b1[2], b1[3]} + t3; \
            const f32x2 q0 = S[1] * (f32x2){r0[2], r0[3]} + S[0] * (f32x2){r0[0], r0[1]}; \
            const f32x2 q1 = S[3] * (f32x2){r1[2], r1[3]} + S[2] * (f32x2){r1[0], r1[1]}; \
            const f32x2 yc = q0 + q1; \
            yv[s_] = red8(yc[0] + yc[1]); } while (0)
        RW_LD(opA, vvA, 0);
#pragma unroll
        for (int s = 0; s < 16; s += 2) {
            RW_LD(opB, vvB, s + 1);
            __builtin_amdgcn_sched_barrier(0);
            RW_COMP(opA, vvA, s);
            __builtin_amdgcn_sched_barrier(0);
            if (s + 2 < 16) RW_LD(opA, vvA, s + 2);
            __builtin_amdgcn_sched_barrier(0);
            RW_COMP(opB, vvB, s + 1);
            __builtin_amdgcn_sched_barrier(0);
        }
#undef RW_LD
#undef RW_COMP
#pragma unroll
        for (int s = 0; s < 16; ++s) if ((s & 7) == kq) ybuf[((bi * 16 + s) * 64) + vrow] = yv[s];
        }
        __syncthreads();
    }
    if (!comp) RW_FLUSH(NCH - 1);
    __syncthreads();
#undef RW_ISSUE
#undef RW_WRITE
#undef RW_FLUSH
}

constexpr size_t WS_RWSCR = WS_YHY;
constexpr int RWS_QY = 0, RWS_YV = 2048, RWS_PZ = 4096, RWS_ZV = 12288, RWS_SLOT = 20480;
typedef __bf16 bf16x8n __attribute__((ext_vector_type(8)));
__device__ __forceinline__ f32x4 mma16(const bf16x8 a, const bf16x8 b, const f32x4 c) { return __builtin_amdgcn_mfma_f32_16x16x32_bf16(a, b, c, 0, 0, 0); }
__device__ __forceinline__ float dpp_shr(float x, const int n) {
    const int v = __builtin_bit_cast(int, x); int r;
    if (n == 1) r = __builtin_amdgcn_update_dpp(0, v, 0x111, 0xF, 0xF, true); else if (n == 2) r = __builtin_amdgcn_update_dpp(0, v, 0x112, 0xF, 0xF, true);
    else if (n == 4) r = __builtin_amdgcn_update_dpp(0, v, 0x114, 0xF, 0xF, true); else r = __builtin_amdgcn_update_dpp(0, v, 0x118, 0xF, 0xF, true);
    return __builtin_bit_cast(float, r);
}
__device__ __forceinline__ v4u pack8(const float (&x)[8]) { v4u o; o.x = pk2(x[0], x[1]); o.y = pk2(x[2], x[3]); o.z = pk2(x[4], x[5]); o.w = pk2(x[6], x[7]); return o; }
__device__ __forceinline__ void unpack8(const v4u u, float (&x)[8]) { x[0] = bflo(u.x); x[1] = bfhi(u.x); x[2] = bflo(u.y); x[3] = bfhi(u.y); x[4] = bflo(u.z); x[5] = bfhi(u.z); x[6] = bflo(u.w); x[7] = bfhi(u.w); }
constexpr int LDS_ZERO16 = 131072 + 3072;
__device__ __forceinline__ bf16x8 frag16z(const LAS bf16* m, int rowbase, int lane, const LAS v4u* z) {
    const LAS v4u* p = (const LAS v4u*)(m + (rowbase + (lane & 15)) * 16 + 8 * (lane >> 4));
    const v4u v = *(((lane >> 4) < 2) ? p : z); return __builtin_bit_cast(bf16x8, v); }
#define frag16(m_, rb_, ln_) frag16z(m_, rb_, ln_, zp16)
__device__ __forceinline__ void st_colmaj(LAS bf16* m, int colbase, const f32x4 d, int lane) {
    v2u o; o.x = pk2(d[0], d[1]); o.y = pk2(d[2], d[3]); *(LAS v2u*)(m + (colbase + (lane & 15)) * 16 + 4 * (lane >> 4)) = o; }
__device__ __forceinline__ void st_rowmaj(LAS bf16* m, const f32x4 d, int lane) {
#pragma unroll
    for (int r = 0; r < 4; ++r) m[(4 * (lane >> 4) + r) * 16 + (lane & 15)] = (bf16)f2bf(d[r]); }
template <int KS0, int KS1>
__device__ __forceinline__ void rw_chunk_load(const Ctx& F, int b, int h, int d, int cidx, v4u (&raw)[12]) {
    const int lane = opaque_v(F.lane), t = lane & 15, kg = lane >> 4;
    const bf16* base = (const bf16*)(F.a->ws + WS_SCN) + (size_t)seq_row(b, d, 16 * cidx + t) * 9 * 512 + h * 64;
#pragma unroll
    for (int ks = KS0; ks < KS1; ++ks) { const int off = 32 * ks + 8 * kg;
        raw[6 * ks + 0] = *(const v4u*)(base + (3 + 3 * d) * 512 + off); raw[6 * ks + 1] = *(const v4u*)(base + 2 * 512 + off); raw[6 * ks + 2] = *(const v4u*)(base + off);
        raw[6 * ks + 3] = *(const v4u*)(base + (5 + 3 * d) * 512 + off); raw[6 * ks + 4] = *(const v4u*)(base + (4 + 3 * d) * 512 + off); raw[6 * ks + 5] = *(const v4u*)(base + 512 + off); }
}
__device__ __forceinline__ void rw_chunk_task(const Ctx& F, const v4u (&raw)[12], LAS unsigned char* wl, unsigned char* slot) {
    const LAS v4u* zp16 = (const LAS v4u*)(F.lds + LDS_ZERO16);
    const int lane = opaque_v(F.lane), t = lane & 15, kg = lane >> 4;
    LAS bf16* ATt = (LAS bf16*)(wl); LAS bf16* RBr = (LAS bf16*)(wl + 2048); LAS bf16* BHt = (LAS bf16*)(wl + 4096); LAS bf16* KHt = (LAS bf16*)(wl + 6144); LAS bf16* VTt = (LAS bf16*)(wl + 8192);
    LAS bf16* WAt = (LAS bf16*)(wl + 10240); LAS bf16* N_r = (LAS bf16*)(wl + 12288); LAS bf16* N_c = (LAS bf16*)(wl + 12800); LAS bf16* T_r = (LAS bf16*)(wl + 13312);
    LAS bf16* AK_r = (LAS bf16*)(wl + 13824); LAS bf16* RB2 = (LAS bf16*)(wl + 14336); LAS bf16* RK_r = (LAS bf16*)(wl + 14848); LAS float* GCl = (LAS float*)(wl + 15360);
    bf16x8 fAb[2], fRb[2], fBb[2], fKb[2];
#pragma unroll
    for (int ks = 0; ks < 2; ++ks) {
        const int off = 32 * ks + 8 * kg;
        float ea[8], er[8], eb[8], eh[8];
        { const v4u uld = raw[6 * ks + 0]; float ld[8]; unpack8(uld, ld);
#pragma unroll
          for (int j = 0; j < 8; ++j) { float c = ld[j]; c += dpp_shr(c, 1); c += dpp_shr(c, 2); c += dpp_shr(c, 4); c += dpp_shr(c, 8);
              const float tot = __builtin_bit_cast(float, __builtin_amdgcn_ds_bpermute((lane | 15) << 2, __builtin_bit_cast(int, c)));
              ea[j] = __expf(c - ld[j]); er[j] = __expf(c); eb[j] = __expf(-c); eh[j] = __expf(tot - c);
              if (t == 0) GCl[off + j] = __expf(tot); } }
        { const v4u u = raw[6 * ks + 1]; float x[8]; unpack8(u, x);
#pragma unroll
          for (int j = 0; j < 8; ++j) { x[j] = -x[j] * ea[j]; ATt[(off + j) * 16 + t] = (bf16)f2bf(x[j]); }
          const v4u p = pack8(x); fAb[ks] = __builtin_bit_cast(bf16x8, p); }
        { const v4u u = raw[6 * ks + 2]; float x[8]; unpack8(u, x);
#pragma unroll
          for (int j = 0; j < 8; ++j) x[j] = x[j] * er[j];
          const v4u p = pack8(x); fRb[ks] = __builtin_bit_cast(bf16x8, p); *(LAS v4u*)(RBr + t * 64 + off) = p; }
        { const v4u u = raw[6 * ks + 3]; float x[8], y[8]; unpack8(u, x);
#pragma unroll
          for (int j = 0; j < 8; ++j) { y[j] = x[j] * eb[j]; BHt[(off + j) * 16 + t] = (bf16)f2bf(x[j] * eh[j]); }
          const v4u p = pack8(y); fBb[ks] = __builtin_bit_cast(bf16x8, p); }
        { const v4u u = raw[6 * ks + 4]; float x[8], y[8]; unpack8(u, x);
#pragma unroll
          for (int j = 0; j < 8; ++j) { y[j] = x[j] * eb[j]; KHt[(off + j) * 16 + t] = (bf16)f2bf(x[j] * eh[j]); }
          const v4u p = pack8(y); fKb[ks] = __builtin_bit_cast(bf16x8, p); }
        { const v4u u = raw[6 * ks + 5];
          const bf16 e0 = (bf16)(u.x & 0xffff), e1 = (bf16)(u.x >> 16), e2 = (bf16)(u.y & 0xffff), e3 = (bf16)(u.y >> 16), e4 = (bf16)(u.z & 0xffff), e5 = (bf16)(u.z >> 16), e6 = (bf16)(u.w & 0xffff), e7 = (bf16)(u.w >> 16);
          VTt[(off + 0) * 16 + t] = e0; VTt[(off + 1) * 16 + t] = e1; VTt[(off + 2) * 16 + t] = e2; VTt[(off + 3) * 16 + t] = e3; VTt[(off + 4) * 16 + t] = e4; VTt[(off + 5) * 16 + t] = e5; VTt[(off + 6) * 16 + t] = e6; VTt[(off + 7) * 16 + t] = e7; }
        __builtin_amdgcn_sched_barrier(0);
    }
    asm volatile("" ::: "memory");
    const f32x4 z4 = (f32x4){0.f, 0.f, 0.f, 0.f};
    f32x4 n0 = mma16(fAb[1], fBb[1], mma16(fAb[0], fBb[0], z4)), aak = mma16(fAb[1], fKb[1], mma16(fAb[0], fKb[0], z4));
    f32x4 arb = mma16(fRb[1], fBb[1], mma16(fRb[0], fBb[0], z4)), ark = mma16(fRb[1], fKb[1], mma16(fRb[0], fKb[0], z4));
#pragma unroll
    for (int r = 0; r < 4; ++r) { const int tt = 4 * kg + r; if (!(t < tt)) { n0[r] = 0.f; aak[r] = 0.f; } if (!(t <= tt)) { arb[r] = 0.f; ark[r] = 0.f; } }
    st_rowmaj(AK_r, aak, lane); st_rowmaj(RB2, arb, lane); st_rowmaj(RK_r, ark, lane); asm volatile("" ::: "memory");
    f32x4 accT = n0;
#pragma unroll
    for (int r = 0; r < 4; ++r) accT[r] += (4 * kg + r == t) ? 1.f : 0.f;
    f32x4 nn = n0;
#pragma unroll
    for (int itn = 0; itn < 3; ++itn) {
        st_rowmaj(N_r, nn, lane); st_colmaj(N_c, 0, nn, lane); st_rowmaj(T_r, accT, lane); asm volatile("" ::: "memory");
        const bf16x8 fa = frag16(N_r, 0, lane), fb = frag16(N_c, 0, lane), ft = frag16(T_r, 0, lane);
        nn = mma16(fa, fb, z4); asm volatile("" ::: "memory");
        st_colmaj(N_c, 0, nn, lane); asm volatile("" ::: "memory");
        const bf16x8 fb2 = frag16(N_c, 0, lane);
        accT = mma16(ft, fb2, accT); asm volatile("" ::: "memory");
    }
    st_rowmaj(T_r, accT, lane); asm volatile("" ::: "memory");
    const bf16x8 fT = frag16(T_r, 0, lane), fAK = frag16(AK_r, 0, lane), fARB = frag16(RB2, 0, lane), fARK = frag16(RK_r, 0, lane);
#pragma unroll
    for (int kt = 0; kt < 4; ++kt) { const f32x4 dd = mma16(fT, frag16(ATt, 16 * kt, lane), z4); st_colmaj(WAt, 16 * kt, dd, lane); } asm volatile("" ::: "memory");
    { const bf16x8 fArbT = frag16(RB2, 0, lane);
#pragma unroll
      for (int kt = 0; kt < 4; ++kt) { const v2u ri = *(const LAS v2u*)(RBr + t * 64 + 16 * kt + 4 * kg);
          f32x4 c0 = (f32x4){bflo(ri.x), bfhi(ri.x), bflo(ri.y), bfhi(ri.y)};
          c0 = mma16(frag16(WAt, 16 * kt, lane), fArbT, c0);
          v2u o; o.x = pk2(c0[0], c0[1]); o.y = pk2(c0[2], c0[3]); *(v2u*)(slot + RWS_QY + (t * 64 + 16 * kt + 4 * kg) * 2) = o; } }
    asm volatile("" ::: "memory");
#pragma unroll
    for (int vt = 0; vt < 4; ++vt) { const f32x4 dd = mma16(fAK, frag16(VTt, 16 * vt, lane), z4); st_colmaj(ATt, 16 * vt, dd, lane); } asm volatile("" ::: "memory");
    asm volatile("" ::: "memory");
    LAS bf16* UVt = RBr;
#pragma unroll
    for (int vt = 0; vt < 4; ++vt) { const f32x4 dd = mma16(fT, frag16(ATt, 16 * vt, lane), z4); st_colmaj(UVt, 16 * vt, dd, lane); } asm volatile("" ::: "memory");
#pragma unroll
    for (int vt = 0; vt < 4; ++vt) { const f32x4 dd = mma16(fARK, frag16(VTt, 16 * vt, lane), mma16(fARB, frag16(UVt, 16 * vt, lane), z4));
        v2u o; o.x = pk2(dd[0], dd[1]); o.y = pk2(dd[2], dd[3]); *(v2u*)(slot + RWS_YV + ((16 * vt + t) * 16 + 4 * kg) * 2) = o; }
#pragma unroll
    for (int ktp = 0; ktp < 4; ++ktp) { const bf16x8 fBh = frag16(BHt, 16 * ktp, lane);
#pragma unroll
        for (int kt = 0; kt < 4; ++kt) { f32x4 dd = mma16(frag16(WAt, 16 * kt, lane), fBh, z4);
            if (kt == ktp) {
#pragma unroll
                for (int r = 0; r < 4; ++r) if (4 * kg + r == t) dd[r] += GCl[16 * kt + t]; }
            v2u o; o.x = pk2(dd[0], dd[1]); o.y = pk2(dd[2], dd[3]); *(v2u*)(slot + RWS_PZ + ((16 * ktp + t) * 64 + 16 * kt + 4 * kg) * 2) = o; } }
#pragma unroll
    for (int vt = 0; vt < 4; ++vt) { const bf16x8 fU = frag16(UVt, 16 * vt, lane), fV = frag16(VTt, 16 * vt, lane);
#pragma unroll
        for (int ktp = 0; ktp < 4; ++ktp) { const f32x4 dd = mma16(frag16(KHt, 16 * ktp, lane), fV, mma16(frag16(BHt, 16 * ktp, lane), fU, z4));
            v2u o; o.x = pk2(dd[0], dd[1]); o.y = pk2(dd[2], dd[3]); *(v2u*)(slot + RWS_ZV + ((16 * vt + t) * 64 + 16 * ktp + 4 * kg) * 2) = o; } }
}
__device__ __forceinline__ void rw_chunk_task2(const Ctx& F, const v4u (&raw)[12], LAS unsigned char* wl, f32x4 (&yv)[4], f32x4 (&zv)[4][4]) {
    const LAS v4u* zp16 = (const LAS v4u*)(F.lds + LDS_ZERO16);
    const int lane = opaque_v(F.lane), t = lane & 15, kg = lane >> 4;
    LAS bf16* ATt = (LAS bf16*)(wl); LAS bf16* RBr = (LAS bf16*)(wl + 2048); LAS bf16* BHt = (LAS bf16*)(wl + 4096); LAS bf16* KHt = (LAS bf16*)(wl + 6144); LAS bf16* VTt = (LAS bf16*)(wl + 8192);
    LAS bf16* WAt = (LAS bf16*)(wl + 10240); LAS bf16* N_r = (LAS bf16*)(wl + 12288); LAS bf16* N_c = (LAS bf16*)(wl + 12800); LAS bf16* T_r = (LAS bf16*)(wl + 13312);
    LAS bf16* AK_r = (LAS bf16*)(wl + 13824); LAS bf16* RB2 = (LAS bf16*)(wl + 14336); LAS bf16* RK_r = (LAS bf16*)(wl + 14848); LAS float* GCl = (LAS float*)(wl + 15360);
    bf16x8 fAb[2], fRb[2], fBb[2], fKb[2];
#pragma unroll
    for (int ks = 0; ks < 2; ++ks) {
        const int off = 32 * ks + 8 * kg;
        float ea[8], er[8], eb[8], eh[8];
        { const v4u uld = raw[6 * ks + 0]; float ld[8]; unpack8(uld, ld);
#pragma unroll
          for (int j = 0; j < 8; ++j) { float c = ld[j]; c += dpp_shr(c, 1); c += dpp_shr(c, 2); c += dpp_shr(c, 4); c += dpp_shr(c, 8);
              const float tot = __builtin_bit_cast(float, __builtin_amdgcn_ds_bpermute((lane | 15) << 2, __builtin_bit_cast(int, c)));
              ea[j] = __expf(c - ld[j]); er[j] = __expf(c); eb[j] = __expf(-c); eh[j] = __expf(tot - c);
              if (t == 0) GCl[off + j] = __expf(tot); } }
        { const v4u u = raw[6 * ks + 1]; float x[8]; unpack8(u, x);
#pragma unroll
          for (int j = 0; j < 8; ++j) { x[j] = -x[j] * ea[j]; ATt[(off + j) * 16 + t] = (bf16)f2bf(x[j]); }
          const v4u p = pack8(x); fAb[ks] = __builtin_bit_cast(bf16x8, p); }
        { const v4u u = raw[6 * ks + 2]; float x[8]; unpack8(u, x);
#pragma unroll
          for (int j = 0; j < 8; ++j) x[j] = x[j] * er[j];
          const v4u p = pack8(x); fRb[ks] = __builtin_bit_cast(bf16x8, p); *(LAS v4u*)(RBr + t * 64 + off) = p; }
        { const v4u u = raw[6 * ks + 3]; float x[8], y[8]; unpack8(u, x);
#pragma unroll
          for (int j = 0; j < 8; ++j) { y[j] = x[j] * eb[j]; BHt[(off + j) * 16 + t] = (bf16)f2bf(x[j] * eh[j]); }
          const v4u p = pack8(y); fBb[ks] = __builtin_bit_cast(bf16x8, p); }
        { const v4u u = raw[6 * ks + 4]; float x[8], y[8]; unpack8(u, x);
#pragma unroll
          for (int j = 0; j < 8; ++j) { y[j] = x[j] * eb[j]; KHt[(off + j) * 16 + t] = (bf16)f2bf(x[j] * eh[j]); }
          const v4u p = pack8(y); fKb[ks] = __builtin_bit_cast(bf16x8, p); }
        { const v4u u = raw[6 * ks + 5];
          const bf16 e0 = (bf16)(u.x & 0xffff), e1 = (bf16)(u.x >> 16), e2 = (bf16)(u.y & 0xffff), e3 = (bf16)(u.y >> 16), e4 = (bf16)(u.z & 0xffff), e5 = (bf16)(u.z >> 16), e6 = (bf16)(u.w & 0xffff), e7 = (bf16)(u.w >> 16);
          VTt[(off + 0) * 16 + t] = e0; VTt[(off + 1) * 16 + t] = e1; VTt[(off + 2) * 16 + t] = e2; VTt[(off + 3) * 16 + t] = e3; VTt[(off + 4) * 16 + t] = e4; VTt[(off + 5) * 16 + t] = e5; VTt[(off + 6) * 16 + t] = e6; VTt[(off + 7) * 16 + t] = e7; }
        __builtin_amdgcn_sched_barrier(0);
    }
    asm volatile("" ::: "memory");
    const f32x4 z4 = (f32x4){0.f, 0.f, 0.f, 0.f};
    f32x4 n0 = mma16(fAb[1], fBb[1], mma16(fAb[0], fBb[0], z4)), aak = mma16(fAb[1], fKb[1], mma16(fAb[0], fKb[0], z4));
    f32x4 arb = mma16(fRb[1], fBb[1], mma16(fRb[0], fBb[0], z4)), ark = mma16(fRb[1], fKb[1], mma16(fRb[0], fKb[0], z4));
#pragma unroll
    for (int r = 0; r < 4; ++r) { const int tt = 4 * kg + r; if (!(t < tt)) { n0[r] = 0.f; aak[r] = 0.f; } if (!(t <= tt)) { arb[r] = 0.f; ark[r] = 0.f; } }
    st_rowmaj(AK_r, aak, lane); st_rowmaj(RB2, arb, lane); st_rowmaj(RK_r, ark, lane); asm volatile("" ::: "memory");
    f32x4 accT = n0;
#pragma unroll
    for (int r = 0; r < 4; ++r) accT[r] += (4 * kg + r == t) ? 1.f : 0.f;
    f32x4 nn = n0;
#pragma unroll
    for (int itn = 0; itn < 3; ++itn) {
        st_rowmaj(N_r, nn, lane); st_colmaj(N_c, 0, nn, lane); st_rowmaj(T_r, accT, lane); asm volatile("" ::: "memory");
        const bf16x8 fa = frag16(N_r, 0, lane), fb = frag16(N_c, 0, lane), ft = frag16(T_r, 0, lane);
        nn = mma16(fa, fb, z4); asm volatile("" ::: "memory");
        st_colmaj(N_c, 0, nn, lane); asm volatile("" ::: "memory");
        const bf16x8 fb2 = frag16(N_c, 0, lane);
        accT = mma16(ft, fb2, accT); asm volatile("" ::: "memory");
    }
    st_rowmaj(T_r, accT, lane); asm volatile("" ::: "memory");
    const bf16x8 fT = frag16(T_r, 0, lane), fAK = frag16(AK_r, 0, lane), fARB = frag16(RB2, 0, lane), fARK = frag16(RK_r, 0, lane);
#pragma unroll
    for (int kt = 0; kt < 4; ++kt) { const f32x4 dd = mma16(fT, frag16(ATt, 16 * kt, lane), z4); st_colmaj(WAt, 16 * kt, dd, lane); } asm volatile("" ::: "memory");
    f32x4 qy[4];
    { const bf16x8 fArbT = frag16(RB2, 0, lane);
#pragma unroll
      for (int kt = 0; kt < 4; ++kt) { const v2u ri = *(const LAS v2u*)(RBr + t * 64 + 16 * kt + 4 * kg);
          qy[kt] = mma16(frag16(WAt, 16 * kt, lane), fArbT, (f32x4){bflo(ri.x), bfhi(ri.x), bflo(ri.y), bfhi(ri.y)}); } }
    asm volatile("" ::: "memory");
#pragma unroll
    for (int vt = 0; vt < 4; ++vt) { const f32x4 dd = mma16(fAK, frag16(VTt, 16 * vt, lane), z4); st_colmaj(ATt, 16 * vt, dd, lane); } asm volatile("" ::: "memory");
    LAS bf16* UVt = RBr;
#pragma unroll
    for (int vt = 0; vt < 4; ++vt) { const f32x4 dd = mma16(fT, frag16(ATt, 16 * vt, lane), z4); st_colmaj(UVt, 16 * vt, dd, lane); } asm volatile("" ::: "memory");
#pragma unroll
    for (int vt = 0; vt < 4; ++vt) { const bf16x8 fU = frag16(UVt, 16 * vt, lane), fV = frag16(VTt, 16 * vt, lane);
        yv[vt] = mma16(fARK, fV, mma16(fARB, fU, z4));
#pragma unroll
        for (int ktp = 0; ktp < 4; ++ktp) zv[vt][ktp] = mma16(frag16(KHt, 16 * ktp, lane), fV, mma16(frag16(BHt, 16 * ktp, lane), fU, z4)); }
    f32x4 pz[4][4];
#pragma unroll
    for (int ktp = 0; ktp < 4; ++ktp) { const bf16x8 fBh = frag16(BHt, 16 * ktp, lane);
#pragma unroll
        for (int kt = 0; kt < 4; ++kt) { f32x4 dd = mma16(frag16(WAt, 16 * kt, lane), fBh, z4);
            if (kt == ktp) {
#pragma unroll
                for (int r = 0; r < 4; ++r) if (4 * kg + r == t) dd[r] += GCl[16 * kt + t]; }
            pz[ktp][kt] = dd; } }
    asm volatile("s_waitcnt lgkmcnt(0)" ::: "memory");
#pragma unroll
    for (int ktp = 0; ktp < 4; ++ktp) { LAS bf16* reg = (LAS bf16*)(wl + (ktp < 2 ? ktp * 2048 : (ktp + 1) * 2048));
#pragma unroll
        for (int kt = 0; kt < 4; ++kt) { v2u o; o.x = pk2(pz[ktp][kt][0], pz[ktp][kt][1]); o.y = pk2(pz[ktp][kt][2], pz[ktp][kt][3]); *(LAS v2u*)(reg + t * 64 + 16 * kt + 4 * kg) = o; } }
#pragma unroll
    for (int kt = 0; kt < 4; ++kt) { v2u o; o.x = pk2(qy[kt][0], qy[kt][1]); o.y = pk2(qy[kt][2], qy[kt][3]); *(LAS v2u*)(BHt + t * 64 + 16 * kt + 4 * kg) = o; }
    asm volatile("s_waitcnt lgkmcnt(0)" ::: "memory");
}
constexpr int RWZ_OFF = LDSCTL_OFF + 8192, RWF_OFF = LDSCTL_OFF + 2048;
__device__ __forceinline__ void rw_chunk_item2(const Ctx& F, int l, int it, size_t yoff = WS_YDIR) {
    const auto& a = *F.a; unsigned char* ws = a.ws; const int lane = opaque_v(F.lane), t = lane & 15, kg = lane >> 4;
    const int d = it & 1, h = (it >> 1) & 7, b = it >> 4;
    float* YD = (float*)(ws + yoff);
    LAS unsigned char* wl = F.lds + F.wave * 15616;
    LAS bf16* ZS = (LAS bf16*)(F.lds + RWZ_OFF);
    volatile LAS int* flag = (volatile LAS int*)(F.lds + RWF_OFF);
    for (int i = F.tid; i < 2048; i += NTHREADS) ((LAS unsigned*)ZS)[i] = 0u;
    if (F.tid == 0) *flag = 0;
    __syncthreads();
    constexpr int NCHK = (CTXL + SEQ) / 16;
    v4u raw[12];
    rw_chunk_load<0, 2>(F, b, h, d, F.wave, raw);
#pragma unroll 1
    for (int c = F.wave; c < NCHK; c += NWAVES) {
        f32x4 yv[4], zv[4][4];
        rw_chunk_task2(F, raw, wl, yv, zv);
        if (c + NWAVES < NCHK) rw_chunk_load<0, 2>(F, b, h, d, c + NWAVES, raw);
        while (*flag < c) __builtin_amdgcn_s_sleep(1);
        asm volatile("" ::: "memory");
        const LAS bf16* Zc = ZS + (c & 1) * 4096; LAS bf16* Zn = ZS + ((c + 1) & 1) * 4096;
        bf16x8 zb[4][2];
#pragma unroll
        for (int vb = 0; vb < 4; ++vb)
#pragma unroll
            for (int ks = 0; ks < 2; ++ks) zb[vb][ks] = *(const LAS bf16x8*)(Zc + (16 * vb + t) * 64 + 32 * ks + 8 * kg);
        { const LAS bf16* Qr = (const LAS bf16*)(wl + 4096); const bf16x8 q0 = *(const LAS bf16x8*)(Qr + t * 64 + 8 * kg), q1 = *(const LAS bf16x8*)(Qr + t * 64 + 32 + 8 * kg);
#pragma unroll
          for (int vb = 0; vb < 4; ++vb) { const f32x4 y = mma16(q1, zb[vb][1], mma16(q0, zb[vb][0], yv[vb]));
#pragma unroll
              for (int r = 0; r < 4; ++r) { const int row = seq_row(b, d, c * 16 + 4 * kg + r); YD[((size_t)d * T_ALL + row) * 512 + h * 64 + 16 * vb + t] = y[r]; } } }
#pragma unroll
        for (int ktp = 0; ktp < 4; ++ktp) { const LAS bf16* Pr = (const LAS bf16*)(wl + (ktp < 2 ? ktp * 2048 : (ktp + 1) * 2048));
            const bf16x8 p0 = *(const LAS bf16x8*)(Pr + t * 64 + 8 * kg), p1 = *(const LAS bf16x8*)(Pr + t * 64 + 32 + 8 * kg);
#pragma unroll
            for (int vb = 0; vb < 4; ++vb) { const f32x4 z = mma16(p1, zb[vb][1], mma16(p0, zb[vb][0], zv[vb][ktp]));
                v2u o; o.x = pk2(z[0], z[1]); o.y = pk2(z[2], z[3]); *(LAS v2u*)(Zn + (16 * vb + t) * 64 + 16 * ktp + 4 * kg) = o; } }
        asm volatile("s_waitcnt lgkmcnt(0)" ::: "memory");
        if (lane == 0) *flag = c + 1;
        asm volatile("s_waitcnt lgkmcnt(0)" ::: "memory");
    }
    __syncthreads();
}
__device__ __forceinline__ v2u ld_sc1_8(const void* p) { const unsigned long long v = __hip_atomic_load((const unsigned long long*)p, __ATOMIC_RELAXED, __HIP_MEMORY_SCOPE_AGENT); v2u o; o.x = (unsigned)v; o.y = (unsigned)(v >> 32); return o; }
__device__ __forceinline__ v4u ld_sc1_16(const void* p) { const v2u a = ld_sc1_8(p), b = ld_sc1_8((const char*)p + 8); return (v4u){a.x, a.y, b.x, b.y}; }
__device__ __forceinline__ void rw_chunk_item(const Ctx& F, int l, int it) {
    const auto& a = *F.a; unsigned char* ws = a.ws; const int lane = F.lane, t = lane & 15, kg = lane >> 4;
    const int d = it & 1, h = (it >> 1) & 7, b = it >> 4;
    float* YD = (float*)(ws + WS_YDIR);
    unsigned char* scr = ws + WS_RWSCR + (size_t)F.bid * 16 * RWS_SLOT;
    LAS unsigned char* wl = F.lds + F.wave * 15616;
    LAS bf16* ZL = (LAS bf16*)(F.lds + LDSCTL_OFF + 4096 + (F.wave & 3) * 2048);
    if (F.wave < 4) { for (int i = lane; i < 512; i += 64) ((LAS unsigned*)ZL)[i] = 0u; }
    asm volatile("" ::: "memory");
    constexpr int NCHK = (CTXL + SEQ) / 16, NB = NCHK / 16;
#pragma unroll 1
    for (int bt = 0; bt < NB; ++bt) {
        { v4u cur[12];
#pragma unroll 1
          for (int jj = 0; jj < 2; ++jj) { rw_chunk_load<0, 2>(F, b, h, d, bt * 16 + F.wave + 8 * jj, cur); rw_chunk_task(F, cur, wl, scr + (size_t)(F.wave + 8 * jj) * RWS_SLOT); } }
        asm volatile("s_waitcnt vmcnt(0)" ::: "memory");
        __syncthreads();
        {
            const int t = opaque_v(lane & 15), kg = opaque_v(lane >> 4), vb = opaque(F.wave) & 3;
            const unsigned char* scrb = F.a->ws + WS_RWSCR + (size_t)opaque(F.bid) * 16 * RWS_SLOT;
            LAS unsigned char* sbuf = F.lds;
            const int lt = opaque_v(F.tid) & 255; const bool loader = F.wave >= 4;
            const int lw = opaque(F.wave) & 3;
#define RWB_ISSUE(j_) do { const unsigned char* gp_ = scrb + (size_t)(j_) * RWS_SLOT + (size_t)(lw * 5) * 1024 + lane * 16; LAS unsigned char* lp_ = sbuf + ((j_) % 6) * RWS_SLOT + (lw * 5) * 1024; \
                _Pragma("unroll") for (int q = 0; q < 5; ++q) __builtin_amdgcn_global_load_lds((const unsigned*)(gp_ + q * 1024), (LAS unsigned*)(lp_ + q * 1024), 16, 0, 16); } while (0)
#define RWB_COMP(bi_, j_) do { const LAS unsigned char* sl_ = sbuf + (bi_) * RWS_SLOT; bf16x8 zb[2], qf[2]; \
                _Pragma("unroll") for (int ks = 0; ks < 2; ++ks) { zb[ks] = *(const LAS bf16x8*)(ZL + t * 64 + 32 * ks + 8 * kg); qf[ks] = *(const LAS bf16x8*)(sl_ + RWS_QY + (t * 64 + 32 * ks + 8 * kg) * 2); } \
                const v2u y_ = *(const LAS v2u*)(sl_ + RWS_YV + ((16 * vb + t) * 16 + 4 * kg) * 2); \
                f32x4 yacc = (f32x4){bflo(y_.x), bfhi(y_.x), bflo(y_.y), bfhi(y_.y)}; \
                yacc = mma16(qf[1], zb[1], mma16(qf[0], zb[0], yacc)); \
                f32x4 zn[4]; \
                _Pragma("unroll") for (int ktp = 0; ktp < 4; ++ktp) { const v2u z_ = *(const LAS v2u*)(sl_ + RWS_ZV + ((16 * vb + t) * 64 + 16 * ktp + 4 * kg) * 2); \
                    f32x4 zc = (f32x4){bflo(z_.x), bfhi(z_.x), bflo(z_.y), bfhi(z_.y)}; \
                    _Pragma("unroll") for (int ks = 0; ks < 2; ++ks) zc = mma16(*(const LAS bf16x8*)(sl_ + RWS_PZ + ((16 * ktp + t) * 64 + 32 * ks + 8 * kg) * 2), zb[ks], zc); \
                    zn[ktp] = zc; } \
                _Pragma("unroll") for (int r = 0; r < 4; ++r) { const int row = seq_row(b, d, (bt * 16 + (j_)) * 16 + 4 * kg + r); YD[((size_t)d * T_ALL + row) * 512 + h * 64 + 16 * vb + t] = yacc[r]; } \
                asm volatile("s_waitcnt lgkmcnt(0)" ::: "memory"); \
                _Pragma("unroll") for (int ktp = 0; ktp < 4; ++ktp) { v2u o; o.x = pk2(zn[ktp][0], zn[ktp][1]); o.y = pk2(zn[ktp][2], zn[ktp][3]); *(LAS v2u*)(ZL + t * 64 + 16 * ktp + 4 * kg) = o; } \
                asm volatile("s_waitcnt lgkmcnt(0)" ::: "memory"); } while (0)
#define RWB_BAR() do { asm volatile("s_waitcnt lgkmcnt(0)" ::: "memory"); __builtin_amdgcn_s_barrier(); asm volatile("" ::: "memory"); } while (0)
            if (loader) { RWB_ISSUE(0); RWB_ISSUE(1); RWB_ISSUE(2); RWB_ISSUE(3); asm volatile("s_waitcnt vmcnt(15)" ::: "memory"); }
            RWB_BAR();
#pragma unroll 1
            for (int j = 0; j < 16; ++j) {
                if (loader) { if (j + 4 < 16) { RWB_ISSUE(j + 4); asm volatile("s_waitcnt vmcnt(15)" ::: "memory"); } else { asm volatile("s_waitcnt vmcnt(0)" ::: "memory"); } }
                else { RWB_COMP(j % 6, j); }
                RWB_BAR();
            }
#undef RWB_BAR
#undef RWB_ISSUE
#undef RWB_COMP
        }
        __syncthreads();
    }
}

__device__ __forceinline__ void stage_rw_readout(const Ctx& F, int l) {
    const auto& a = *F.a; unsigned char* ws = a.ws; const int lane = F.lane;
    const bf16* SCN = (const bf16*)(ws + WS_SCN); const bf16* P = (const bf16*)(ws + WS_P); const float* YD = (const float*)(ws + WS_YDIR); bf16* YRW = (bf16*)(ws + WS_YRW);
    const int gw = F.bid * NWAVES + F.wave, NGW = F.G * NWAVES;
    constexpr int TR = 17, NRT = T_ALL / TR;
    for (int tile = gw; tile < NRT * 4; tile += NGW) {
        const int rt = tile % NRT, hp = tile / NRT, row0 = rt * TR, c0 = hp * 128 + 2 * lane;
        const f32x2 rk = *(const f32x2*)(a.in[I_RWRK] + l * 512 + c0), lng = *(const f32x2*)(a.in[I_RWLNG] + l * 512 + c0), lnb = *(const f32x2*)(a.in[I_RWLNB] + l * 512 + c0);
        unsigned sw_[8][5]; f32x2 yw_[8][2];
#define RO_LD(j_) do { const int rr_ = row0 + (j_); const unsigned* sp_ = (const unsigned*)(SCN + (size_t)rr_ * 9 * 512 + c0); \
        sw_[(j_) & 7][0] = sp_[0]; sw_[(j_) & 7][1] = sp_[256]; sw_[(j_) & 7][2] = sp_[4 * 256]; sw_[(j_) & 7][3] = sp_[7 * 256]; sw_[(j_) & 7][4] = *(const unsigned*)(P + (size_t)rr_ * 2560 + 2048 + c0); \
        yw_[(j_) & 7][0] = *(const f32x2*)(YD + (size_t)rr_ * 512 + c0); yw_[(j_) & 7][1] = *(const f32x2*)(YD + ((size_t)T_ALL + rr_) * 512 + c0); } while (0)
        RO_LD(0); RO_LD(1); RO_LD(2);
#pragma unroll
        for (int i = 0; i < TR; ++i) {
            const int row = row0 + i;
            if (i + 3 < TR) RO_LD(i + 3);
            const unsigned ru = sw_[i & 7][0], vu = sw_[i & 7][1], k0u = sw_[i & 7][2], k1u = sw_[i & 7][3], gu = sw_[i & 7][4];
            const f32x2 y0 = yw_[i & 7][0], y1 = yw_[i & 7][1];
            const float bon = red32(bflo(ru) * (bflo(k0u) + bflo(k1u)) * rk[0] + bfhi(ru) * (bfhi(k0u) + bfhi(k1u)) * rk[1]);
            f32x2 y = y0 + y1 + (f32x2){bflo(vu), bfhi(vu)} * bon;
            const float mu = red32(y[0] + y[1]) * (1.f / 64.f);
            y = y - mu;
            const float var = red32(y[0] * y[0] + y[1] * y[1]) * (1.f / 64.f);
            const f32x2 yn = y * (__builtin_amdgcn_rsqf(var + 64e-5f));
            const f32x2 ov = (yn * lng + lnb) * (f32x2){bflo(gu), bfhi(gu)};
            *(unsigned*)(YRW + (size_t)row * 512 + c0) = pk2(ov[0], ov[1]);
        }
    }
}
#undef RO_LD

constexpr size_t WS_S5E = 6 * MiB;
constexpr int S5_NSEG = 4, S5_SEGLEN = (CTXL + SEQ) / S5_NSEG;
__device__ __forceinline__ void s5_disc(const float are, const float aim, const float dt, float& lbr, float& lbi, float& cr, float& ci) {
    const float mag = expf(are * dt); lbr = mag * cosf(aim * dt); lbi = mag * sinf(aim * dt);
    const float den = are * are + aim * aim, nr = lbr - 1.0f; cr = (nr * are + lbi * aim) / den; ci = (lbi * are - nr * aim) / den;
}
template <int PASS>
__device__ __forceinline__ void stage_s5_scan(const Ctx& F, int l) {
    const auto& a = *F.a; unsigned char* ws = a.ws; const int lane = F.lane;
    const bf16* Z = (const bf16*)(ws + WS_Z); float* YP = (float*)(ws + WS_YP); f32x2* S5E = (f32x2*)(ws + WS_S5E);
    LAS unsigned char* wl = F.lds + F.wave * 16384;
    LAS float* buL = (LAS float*)wl;
    LAS bf16* Hs = (LAS bf16*)(wl + 8704);
    const int fr = lane & 15, kg = lane >> 4;
    for (int itx = F.bid * NWAVES + F.wave; itx < BATCH * 32 * 2 * S5_NSEG; itx += NWAVES * F.G) {
        const int seg = itx & (S5_NSEG - 1), it = itx >> 2;
        const int d = it & 1, g = (it >> 1) & 31, b = it >> 6, p = lane;
        const float dt = expf(a.in[I_S5LDT][(l * 2 + d) * 32 + g]);
        const float* arep = a.in[I_S5ARE] + ((size_t)(l * 2 + d) * 32 + g) * 64; const float* aimp = a.in[I_S5AIM] + ((size_t)(l * 2 + d) * 32 + g) * 64;
        float lbr, lbi, cr_, ci_; s5_disc(arep[p], aimp[p], dt, lbr, lbi, cr_, ci_);
        bf16x8 afr[2][4];
#pragma unroll
        for (int tl = 0; tl < 4; ++tl) { const int pp = 16 * tl + fr; float r0_, r1_, cr, ci; s5_disc(arep[pp], aimp[pp], dt, r0_, r1_, cr, ci);
            v4u pr = (v4u){0u, 0u, 0u, 0u}, pi = (v4u){0u, 0u, 0u, 0u};
            if (kg < 2) { const float* br = a.in[I_S5BRE] + (((size_t)l * 32 + g) * 64 + pp) * 16 + 8 * kg; const float* bi = a.in[I_S5BIM] + (((size_t)l * 32 + g) * 64 + pp) * 16 + 8 * kg;
                const f32x4 x0 = *(const f32x4*)br, x1 = *(const f32x4*)(br + 4), y0 = *(const f32x4*)bi, y1 = *(const f32x4*)(bi + 4);
                pr.x = pk2(cr * x0[0] - ci * y0[0], cr * x0[1] - ci * y0[1]); pr.y = pk2(cr * x0[2] - ci * y0[2], cr * x0[3] - ci * y0[3]);
                pr.z = pk2(cr * x1[0] - ci * y1[0], cr * x1[1] - ci * y1[1]); pr.w = pk2(cr * x1[2] - ci * y1[2], cr * x1[3] - ci * y1[3]);
                pi.x = pk2(cr * y0[0] + ci * x0[0], cr * y0[1] + ci * x0[1]); pi.y = pk2(cr * y0[2] + ci * x0[2], cr * y0[3] + ci * x0[3]);
                pi.z = pk2(cr * y1[0] + ci * x1[0], cr * y1[1] + ci * x1[1]); pi.w = pk2(cr * y1[2] + ci * x1[2], cr * y1[3] + ci * x1[3]); }
            afr[0][tl] = __builtin_bit_cast(bf16x8, pr); afr[1][tl] = __builtin_bit_cast(bf16x8, pi); }
        bf16x8 cf[4];
        f32x2 hst = (f32x2){0.f, 0.f};
        if (PASS == 1) {
#pragma unroll
            for (int kk = 0; kk < 4; ++kk) { const int p0 = 16 * kk + 4 * kg;
                const f32x4 c0 = *(const f32x4*)(a.in[I_S5CRE] + (((size_t)l * 32 + g) * 16 + fr) * 64 + p0), c1 = *(const f32x4*)(a.in[I_S5CIM] + (((size_t)l * 32 + g) * 16 + fr) * 64 + p0);
                v4u pk; pk.x = pk2(c0[0], -c1[0]); pk.y = pk2(c0[1], -c1[1]); pk.z = pk2(c0[2], -c1[2]); pk.w = pk2(c0[3], -c1[3]);
                cf[kk] = __builtin_bit_cast(bf16x8, pk); }
            float pr_ = lbr, pi_ = lbi, l64r = 1.f, l64i = 0.f;
#pragma unroll 1
            for (int q = 0; q < 10; ++q) { const float nr2 = pr_ * pr_ - pi_ * pi_, ni2 = 2.f * pr_ * pi_; pr_ = nr2; pi_ = ni2; if (q == 5) { l64r = pr_; l64i = pi_; } }
            const float lLr = pr_ * l64r - pi_ * l64i, lLi = pr_ * l64i + pi_ * l64r;
#pragma unroll 1
            for (int sgi = 0; sgi < seg; ++sgi) { const f32x2 ev = S5E[((size_t)it * S5_NSEG + sgi) * 64 + p];
                hst = (f32x2){lLr * hst[0] - lLi * hst[1] + ev[0], lLr * hst[1] + lLi * hst[0] + ev[1]}; }
        }
        const f32x2 lbr2 = (f32x2){lbr, lbr}, lbi2 = (f32x2){lbi, lbi};
        const int sbeg = seg * S5_SEGLEN, send = sbeg + S5_SEGLEN;
        v4u u0 = (v4u){0u, 0u, 0u, 0u}, u1 = u0, u2 = u0, u3 = u0;
#define S5_LOADU(dst_, s0_) do { const int sx_ = ((s0_) < send) ? (s0_) : (send - 16); const int row_ = seq_row(b, d, sx_ + fr); dst_ = *(const v4u*)(Z + (size_t)row_ * IN_COLS + S5_OFF + g * 16 + (kg & 1) * 8); } while (0)
#define S5_CHUNK(ux_, sc_) do { \
            { const v4u um_ = (kg < 2) ? ux_ : (v4u){0u, 0u, 0u, 0u}; const bf16x8 ufr = __builtin_bit_cast(bf16x8, um_); \
              _Pragma("unroll") for (int c = 0; c < 2; ++c) _Pragma("unroll") for (int tl = 0; tl < 4; ++tl) { \
                const f32x4 dd = __builtin_amdgcn_mfma_f32_16x16x32_bf16(afr[c][tl], ufr, (f32x4){0.f, 0.f, 0.f, 0.f}, 0, 0, 0); *(LAS f32x4*)(buL + (c * 16 + fr) * 68 + 16 * tl + 4 * kg) = dd; } } \
            S5_LOADU(ux_, (sc_) + 64); \
            LDS_WAIT(); asm volatile("" ::: "memory"); \
            f32x2 bu[16]; \
            _Pragma("unroll") for (int s = 0; s < 16; ++s) bu[s] = (f32x2){buL[s * 68 + p], buL[(16 + s) * 68 + p]}; \
            _Pragma("unroll") for (int s = 0; s < 16; ++s) { const float tr_ = __builtin_fmaf(-lbi, hst[1], bu[s][0]), ti_ = __builtin_fmaf(lbi, hst[0], bu[s][1]); \
                hst = (f32x2){__builtin_fmaf(lbr, hst[0], tr_), __builtin_fmaf(lbr, hst[1], ti_)}; \
                if (PASS == 1) *(LAS unsigned*)(Hs + s * 136 + 2 * p) = pg8::cvt_pk_bf16(hst[0], hst[1]); } \
            if (PASS == 1) { LDS_WAIT(); asm volatile("" ::: "memory"); \
                f32x4 acc = (f32x4){0.f, 0.f, 0.f, 0.f}; \
                _Pragma("unroll") for (int kk = 0; kk < 4; ++kk) { const bf16x8 af = *(const LAS bf16x8*)(Hs + fr * 136 + 32 * kk + 8 * kg); acc = __builtin_amdgcn_mfma_f32_16x16x32_bf16(af, cf[kk], acc, 0, 0, 0); } \
                _Pragma("unroll") for (int r = 0; r < 4; ++r) { const int row = seq_row(b, d, (sc_) + 4 * kg + r); YP[((size_t)d * T_ALL + row) * 512 + g * 16 + fr] = acc[r]; } } \
            LDS_WAIT(); asm volatile("" ::: "memory"); } while (0)
        S5_LOADU(u0, sbeg); S5_LOADU(u1, sbeg + 16); S5_LOADU(u2, sbeg + 32); S5_LOADU(u3, sbeg + 48);
#pragma unroll 1
        for (int s0 = sbeg; s0 < send; s0 += 64) { S5_CHUNK(u0, s0); S5_CHUNK(u1, s0 + 16); S5_CHUNK(u2, s0 + 32); S5_CHUNK(u3, s0 + 48); }
#undef S5_CHUNK
        if (PASS == 0) S5E[((size_t)it * S5_NSEG + seg) * 64 + p] = hst;
#undef S5_LOADU
    }
}

__device__ __forceinline__ void stage_s5_prep(const Ctx& F, int l, int nrows) {
    const auto& a = *F.a; unsigned char* ws = a.ws;
    const bf16* __restrict__ Z = (const bf16*)(ws + WS_Z); const float* __restrict__ YP = (const float*)(ws + WS_YP); bf16* __restrict__ AS5 = (bf16*)(ws + WS_AS5);
    const int c = 4 * (F.tid & 127), rq = F.tid >> 7;
    const f32x4 dsk = *(const f32x4*)(a.in[I_S5D] + l * 512 + c);
#pragma unroll 4
    for (int row = F.bid * 4 + rq; row < nrows; row += F.G * 4) {
        const v2u uz = *(const v2u*)(Z + (size_t)row * IN_COLS + S5_OFF + c);
        const f32x4 y0 = *(const f32x4*)(YP + (size_t)row * 512 + c), y1 = *(const f32x4*)(YP + ((size_t)T_ALL + row) * 512 + c);
        const f32x4 u = (f32x4){bflo(uz.x), bfhi(uz.x), bflo(uz.y), bfhi(uz.y)};
        const f32x4 y = y0 + y1 + u * dsk;
        float ge[4];
#pragma unroll
        for (int j = 0; j < 4; ++j) ge[j] = 0.5f * y[j] * (1.f + tanh_fast(0.7978845608028654f * (y[j] + 0.044715f * y[j] * y[j] * y[j])));
        v2u o; o.x = pk2(ge[0], ge[1]); o.y = pk2(ge[2], ge[3]);
        *(v2u*)(AS5 + (size_t)row * 512 + c) = o;
    }
}

__device__ __forceinline__ void stage_hy_pre(const Ctx& F, int l, int nrows) {
    const auto& a = *F.a; unsigned char* ws = a.ws; const int lane = F.lane;
    const bf16* Z = (const bf16*)(ws + WS_Z); bf16* UT = (bf16*)(ws + WS_UT);
    LAS unsigned char* tl = F.lds + F.wave * 16384;
    const float* cw = a.in[I_HYCW] + (size_t)l * 3 * 1536; const float* cbp = a.in[I_HYCB] + l * 1536;
    const int gw = F.bid * NWAVES + F.wave, NGW = F.G * NWAVES;
    const int q = lane >> 3, k = lane & 7, ntile = (nrows / 64) * 24;
    v4u v[8], hv;
#define HYPRE_LOAD(tile_) do { const int rt_ = (tile_) / 24, ct_ = (tile_) % 24, row0_ = rt_ * 64; int base_, pos0_, n_; row_seq(row0_, base_, pos0_, n_); \
        const bf16* zt_ = Z + (size_t)row0_ * IN_COLS + HY_OFF + ct_ * 64 + 8 * k; hv = (v4u){0u, 0u, 0u, 0u}; \
        _Pragma("unroll") for (int i = 0; i < 8; ++i) v[i] = *(const v4u*)(zt_ + (size_t)(8 * i + q) * IN_COLS); \
        if (q == 0 && pos0_ > 0) hv = *(const v4u*)(zt_ - (size_t)IN_COLS); \
        if (q == 1 && pos0_ + 64 < n_) hv = *(const v4u*)(zt_ + (size_t)64 * IN_COLS); } while (0)
    if (gw < ntile) HYPRE_LOAD(gw);
#pragma unroll 1
    for (int tile = gw; tile < ntile; tile += NGW) {
        const int rt = tile / 24, ct = tile % 24, row0 = rt * 64, c0 = ct * 64;
        f32x4 wv[8];
#pragma unroll
        for (int i = 0; i < 8; ++i) { const int col = c0 + 8 * i + q; wv[i] = (f32x4){cw[col], cw[1536 + col], cw[2 * 1536 + col], cbp[col]}; }
#pragma unroll
        for (int i = 0; i < 8; ++i) { LAS unsigned* p = (LAS unsigned*)(tl + (1 + 8 * i + q) * 132 + 16 * k); p[0] = v[i].x; p[1] = v[i].y; p[2] = v[i].z; p[3] = v[i].w; }
        if (q < 2) { LAS unsigned* p = (LAS unsigned*)(tl + (q ? 65 : 0) * 132 + 16 * k); p[0] = hv.x; p[1] = hv.y; p[2] = hv.z; p[3] = hv.w; }
        if (tile + NGW < ntile) HYPRE_LOAD(tile + NGW);
        LDS_WAIT(); asm volatile("" ::: "memory");
#pragma unroll 2
        for (int i = 0; i < 8; ++i) {
            const int ch = 8 * i + q, col = c0 + ch;
            const LAS unsigned short* s = (const LAS unsigned short*)(tl + (8 * k) * 132 + ch * 2);
            float z[10];
#pragma unroll
            for (int t = 0; t < 10; ++t) z[t] = __builtin_bit_cast(float, (unsigned)s[t * 66] << 16);
            float o[8];
#pragma unroll
            for (int t = 0; t < 8; ++t) o[t] = wv[i][0] * z[t] + wv[i][1] * z[t + 1] + wv[i][2] * z[t + 2] + wv[i][3];
            v4u w; w.x = pk2(o[0], o[1]); w.y = pk2(o[2], o[3]); w.z = pk2(o[4], o[5]); w.w = pk2(o[6], o[7]);
            *(v4u*)(UT + (size_t)col * T_ALL + row0 + 8 * k) = w;
        }
        LDS_WAIT(); asm volatile("" ::: "memory");
    }
#undef HYPRE_LOAD
}
__device__ __forceinline__ void stage_hy_post(const Ctx& F, int l, int nrows) {
    const auto& a = *F.a; unsigned char* ws = a.ws; const int lane = F.lane;
    const bf16* YT = (const bf16*)(ws + WS_UT) + (size_t)1024 * T_ALL; bf16* YHY = (bf16*)(ws + WS_YHY);
    LAS unsigned char* tl = F.lds + F.wave * 16384;
    const int gw = F.bid * NWAVES + F.wave, NGW = F.G * NWAVES;
    const int q = lane >> 3, k = lane & 7, ntile = (nrows / 64) * 8;
    v4u v[8];
#define HYPOST_LOAD(tile_) do { const bf16* yp_ = YT + (size_t)(((tile_) & 7) * 64 + q) * T_ALL + ((tile_) >> 3) * 64 + 8 * k; \
        _Pragma("unroll") for (int i = 0; i < 8; ++i) v[i] = *(const v4u*)(yp_ + (size_t)(8 * i) * T_ALL); } while (0)
    if (gw < ntile) HYPOST_LOAD(gw);
#pragma unroll 1
    for (int tile = gw; tile < ntile; tile += NGW) {
        const int rt = tile >> 3, ct = tile & 7, row0 = rt * 64, c0 = ct * 64;
#pragma unroll
        for (int i = 0; i < 8; ++i) { LAS unsigned* p = (LAS unsigned*)(tl + (8 * i + q) * 132 + 16 * k); p[0] = v[i].x; p[1] = v[i].y; p[2] = v[i].z; p[3] = v[i].w; }
        if (tile + NGW < ntile) HYPOST_LOAD(tile + NGW);
        LDS_WAIT(); asm volatile("" ::: "memory");
#pragma unroll
        for (int i = 0; i < 8; ++i) { const int r = 8 * i + q;
            const LAS unsigned short* s = (const LAS unsigned short*)(tl + (8 * k) * 132 + r * 2);
            unsigned e[8];
#pragma unroll
            for (int j = 0; j < 8; ++j) e[j] = s[j * 66];
            v4u w; w.x = e[0] | (e[1] << 16); w.y = e[2] | (e[3] << 16); w.z = e[4] | (e[5] << 16); w.w = e[6] | (e[7] << 16);
            *(v4u*)(YHY + (size_t)(row0 + r) * 512 + c0 + 8 * k) = w; }
        LDS_WAIT(); asm volatile("" ::: "memory");
    }
#undef HYPOST_LOAD
}
typedef float f32x16 __attribute__((ext_vector_type(16)));
__device__ __forceinline__ void hyena_item(const Ctx& F, int l, int c, int isctx) {
    const auto& a = *F.a; unsigned char* ws = a.ws; const int tid = F.tid, lane = F.lane;
    const int n = isctx ? CTXL : SEQ, rowbase = isctx ? T_LAT : 0, RL = isctx ? HY_RLENC : HY_RLEN, off = n + 47;
    const bf16* UT = (const bf16*)(ws + WS_UT);
    const bf16* x1g = UT + (size_t)c * T_ALL + rowbase; const bf16* x2g = UT + (size_t)(512 + c) * T_ALL + rowbase; bf16* vg = (bf16*)UT + (size_t)(1024 + c) * T_ALL + rowbase;
    const bf16* Rg = (const bf16*)(ws + WS_GF + l * GF_STRIDE + (isctx ? GF_CTX : 0)) + (size_t)c * RL;
    LAS unsigned char* XB = F.lds; LAS unsigned char* R1 = F.lds + HY_R1_OFF; LAS unsigned char* R2 = F.lds + HY_R2_OFF;
    { const int cpb = n / 8;
      for (int q = tid; q < 8 * cpb; q += NTHREADS) { const int b = q / cpb, ch = q % cpb; *(LAS v4u*)(XB + b * HY_ROWB + 2 * HY_MARG + 16 * ch) = *(const v4u*)(vg + (size_t)b * n + 8 * ch); }
      if (tid < 256) { const int b = tid >> 5, side = (tid >> 4) & 1, ch = tid & 15; const unsigned zz = (unsigned)opaque_v(0); *(LAS v4u*)(XB + b * HY_ROWB + (side ? 2 * (HY_MARG + n) : 0) + 16 * ch) = (v4u){zz, zz, zz, zz}; }
      const int rch = RL / 8;
      for (int q = tid; q < rch; q += NTHREADS) { *(LAS v4u*)(R1 + 16 * q) = *(const v4u*)(Rg + 8 * q); *(LAS v4u*)(R2 + 16 * q) = *(const v4u*)(Rg + (size_t)512 * RL + 8 * q); } }
    __syncthreads();
    const int i = lane & 31, kg = lane >> 5, jb = lane & 3, bb = (lane & 31) >> 2;
    const int rsh = (off - i) & 7, rd = rsh >> 1; const bool s1 = rd & 1, s2 = rd & 2; const unsigned sh = (rsh & 1) ? 16u : 0u;
    const int aconst = 2 * (off - i + 8 * kg - rsh), bconst = bb * HY_ROWB + 2 * (HY_MARG + 32 * jb + 8 * kg);
    const int T0w = 512 * F.wave; const int ntile = (n - T0w) >= 512 ? 4 : ((n - T0w) > 0 ? (n - T0w) / 128 : 0);
    const float bias0 = a.in[I_HYBIAS][(l * 2 + 0) * 512 + c], bias1 = a.in[I_HYBIAS][(l * 2 + 1) * 512 + c];
    f32x16 acc[4];
    v2u y1p[4][4];
#define HY_AFRAG(wa, wb, afr) do { \
        const unsigned a0 = s1 ? wa.y : wa.x, a1 = s1 ? wa.z : wa.y, a2 = s1 ? wa.w : wa.z, a3 = s1 ? wb.x : wa.w, a4 = s1 ? wb.y : wb.x, a5 = s1 ? wb.z : wb.y, a6 = s1 ? wb.w : wb.z; \
        const unsigned b0 = s2 ? a2 : a0, b1 = s2 ? a3 : a1, b2 = s2 ? a4 : a2, b3 = s2 ? a5 : a3, b4 = s2 ? a6 : a4; \
        v4u af_; af_.x = __builtin_amdgcn_alignbit(b1, b0, sh); af_.y = __builtin_amdgcn_alignbit(b2, b1, sh); af_.z = __builtin_amdgcn_alignbit(b3, b2, sh); af_.w = __builtin_amdgcn_alignbit(b4, b3, sh); \
        afr = __builtin_bit_cast(bf16x8, af_); } while (0)
#define HY_STEP_COND(RB, d) do { \
        const v4u wa = *(const LAS v4u*)((RB) + aconst - 2 * (d)), wb = *(const LAS v4u*)((RB) + aconst - 2 * (d) + 16); bf16x8 afr; HY_AFRAG(wa, wb, afr); \
        _Pragma("unroll") for (int m = 0; m < 4; ++m) { const int T0 = T0w + 128 * m; \
            if (m < ntile && (d) >= T0 - n + 16 && (d) <= T0 + 96) { const bf16x8 bfr = *(const LAS bf16x8*)(XB + bconst + 2 * (T0 - (d))); \
                acc[m] = __builtin_amdgcn_mfma_f32_32x32x16_bf16(afr, bfr, acc[m], 0, 0, 0); } } } while (0)
#define HY_LOAD(RB, d, wa, wb, bq) do { wa = *(const LAS v4u*)((RB) + aconst - 2 * (d)); wb = *(const LAS v4u*)((RB) + aconst - 2 * (d) + 16); \
        _Pragma("unroll") for (int m = 0; m < 4; ++m) bq[m] = *(const LAS bf16x8*)(XB + bconst + 2 * (T0w + 128 * m - (d))); } while (0)
#define HY_MMA(wa, wb, bq) do { bf16x8 afr; HY_AFRAG(wa, wb, afr); \
        _Pragma("unroll") for (int m = 0; m < 4; ++m) acc[m] = __builtin_amdgcn_mfma_f32_32x32x16_bf16(afr, bq[m], acc[m], 0, 0, 0); } while (0)
#define HY_CONV(RB) do { \
        _Pragma("unroll") for (int m = 0; m < 4; ++m) _Pragma("unroll") for (int e = 0; e < 16; ++e) acc[m][e] = 0.f; \
        if (ntile == 4) { \
            const int dA = T0w - n + 16, dB = T0w + 384 - n + 16, dC = T0w + 96, dD = T0w + 384 + 96;     \
            _Pragma("unroll 1") for (int d = dA; d < dB; d += 16) HY_STEP_COND(RB, d); \
            { v4u waA, wbA, waB, wbB; bf16x8 bqA[4], bqB[4]; \
              HY_LOAD(RB, dB, waA, wbA, bqA); \
              _Pragma("unroll 1") for (int d = dB; d <= dC; d += 32) { \
                  if (d + 16 <= dC) HY_LOAD(RB, d + 16, waB, wbB, bqB); \
                  __builtin_amdgcn_sched_barrier(0); \
                  HY_MMA(waA, wbA, bqA); \
                  __builtin_amdgcn_sched_barrier(0); \
                  if (d + 32 <= dC) HY_LOAD(RB, d + 32, waA, wbA, bqA); \
                  __builtin_amdgcn_sched_barrier(0); \
                  if (d + 16 <= dC) HY_MMA(waB, wbB, bqB); \
                  __builtin_amdgcn_sched_barrier(0); } } \
            _Pragma("unroll 1") for (int d = dC + 16; d <= dD; d += 16) HY_STEP_COND(RB, d); \
        } else if (ntile > 0) { const int dhi = T0w + 128 * (ntile - 1) + 96; \
            _Pragma("unroll 1") for (int d = T0w - n + 16; d <= dhi; d += 16) HY_STEP_COND(RB, d); } } while (0)
    HY_CONV(R1);
#pragma unroll
    for (int m = 0; m < 4; ++m) if (m < ntile) {
#pragma unroll
        for (int rg = 0; rg < 4; ++rg) { const int t4 = T0w + 128 * m + 32 * jb + 8 * rg + 4 * kg;
            const v2u xv = *(const v2u*)(x1g + (size_t)bb * n + t4); const v2u vv = *(const LAS v2u*)(XB + bb * HY_ROWB + 2 * (HY_MARG + t4));
            const float y0 = bflo(xv.x) * (acc[m][4 * rg + 0] + bias0 * bflo(vv.x)), y1 = bfhi(xv.x) * (acc[m][4 * rg + 1] + bias0 * bfhi(vv.x));
            const float y2 = bflo(xv.y) * (acc[m][4 * rg + 2] + bias0 * bflo(vv.y)), y3 = bfhi(xv.y) * (acc[m][4 * rg + 3] + bias0 * bfhi(vv.y));
            y1p[m][rg].x = pk2(y0, y1); y1p[m][rg].y = pk2(y2, y3); } }
    __syncthreads();
#pragma unroll
    for (int m = 0; m < 4; ++m) if (m < ntile) {
#pragma unroll
        for (int rg = 0; rg < 4; ++rg) { const int t4 = T0w + 128 * m + 32 * jb + 8 * rg + 4 * kg; *(LAS v2u*)(XB + bb * HY_ROWB + 2 * (HY_MARG + t4)) = y1p[m][rg]; } }
    __syncthreads();
    HY_CONV(R2);
#pragma unroll
    for (int m = 0; m < 4; ++m) if (m < ntile) {
#pragma unroll
        for (int rg = 0; rg < 4; ++rg) { const int t4 = T0w + 128 * m + 32 * jb + 8 * rg + 4 * kg;
            const v2u xv = *(const v2u*)(x2g + (size_t)bb * n + t4); const v2u yv = y1p[m][rg];
            const float o0 = bflo(xv.x) * (acc[m][4 * rg + 0] + bias1 * bflo(yv.x)), o1 = bfhi(xv.x) * (acc[m][4 * rg + 1] + bias1 * bfhi(yv.x));
            const float o2 = bflo(xv.y) * (acc[m][4 * rg + 2] + bias1 * bflo(yv.y)), o3 = bfhi(xv.y) * (acc[m][4 * rg + 3] + bias1 * bfhi(yv.y));
            v2u ov; ov.x = pk2(o0, o1); ov.y = pk2(o2, o3); *(v2u*)(vg + (size_t)bb * n + t4) = ov; } }
    __syncthreads();
#undef HY_CONV
#undef HY_AFRAG
#undef HY_STEP_COND
#undef HY_LOAD
#undef HY_MMA
}
__device__ __forceinline__ void stage_mixer(const Ctx& F, int l) {
    unsigned* ctr = (unsigned*)(F.a->ws + WS_CTL) + CW_WORK + 64 * l;
    LAS int* itb = (LAS int*)(F.lds + LDSCTL_OFF + 512);
    const int nit = 128 + 512 + (l == 0 ? 512 : 0);
#ifdef PROBE_STATIC
    return;
#endif
    for (;;) {
        if (F.tid == 0) *itb = (int)__hip_atomic_fetch_add(ctr, 1u, __ATOMIC_RELAXED, __HIP_MEMORY_SCOPE_AGENT);
        __syncthreads();
        const int it = *itb;
        __syncthreads();
        if (it >= nit) break;
        Ctx Fi; Fi.a = kargs(); Fi.tid = opaque_v((int)threadIdx.x); Fi.lane = Fi.tid & 63; Fi.wave = __builtin_amdgcn_readfirstlane(Fi.tid >> 6); Fi.bid = opaque((int)blockIdx.x); Fi.G = opaque((int)gridDim.x);
        Fi.lds = (LAS unsigned char*)((LAS unsigned char*)0 + opaque(0)) + (F.lds - (LAS unsigned char*)0);
#ifdef PROBE_T
        if (l == 0 && F.tid == 0 && it == 5) ((unsigned long long*)(F.a->ws + WS_CTL + CW_STAMP * 4))[21] = __builtin_amdgcn_s_memrealtime();
        if (l == 0 && F.tid == 0 && it == 300) ((unsigned long long*)(F.a->ws + WS_CTL + CW_STAMP * 4))[23] = __builtin_amdgcn_s_memrealtime();
#endif
        if (it < 128) { for (int rep = 0; rep < ((DUPK == 9) ? 2 : 1); ++rep) rw_chunk_item2(Fi, opaque(l), it); }
        else if (it < 640) hyena_item(Fi, opaque(l), it - 128, 0);
        else hyena_item(Fi, opaque(l), it - 640, 1);
#ifdef PROBE_T
        if (l == 0 && F.tid == 0 && it == 5) ((unsigned long long*)(F.a->ws + WS_CTL + CW_STAMP * 4))[22] = __builtin_amdgcn_s_memrealtime();
        if (l == 0 && F.tid == 0 && it == 300) ((unsigned long long*)(F.a->ws + WS_CTL + CW_STAMP * 4))[24] = __builtin_amdgcn_s_memrealtime();
#endif
    }
}

typedef float f32x16r __attribute__((ext_vector_type(16)));
__device__ __forceinline__ void stage_norm2_router(const Ctx& F, int l, int nrows) {
    const auto& a = *F.a; unsigned char* ws = a.ws; const int lane = F.lane;
    const float* X = (const float*)(ws + WS_X); bf16* H = (bf16*)(ws + WS_H); const float* MOD = (const float*)(ws + WS_MOD);
    int* EIDX = (int*)(ws + WS_EIDX); float* GATE = (float*)(ws + WS_GATE); int* POS = (int*)(ws + WS_POS); unsigned* ROWOF = (unsigned*)(ws + WS_ROWOF);
    LAS int* lex = (LAS int*)(F.lds + 40960); LAS int* lrk = lex + 2048; LAS int* offl = lrk + 2048;
    LAS float* lg = (LAS float*)(F.lds + F.wave * 4352);
    LAS int* hist = (LAS int*)(F.lds + LDSCTL_OFF + 1024);
    if (F.tid < 32) hist[F.tid] = 0;
    __syncthreads();
    const int rpb = (nrows + F.G - 1) / F.G, r0 = F.bid * rpb, r1 = (r0 + rpb < nrows) ? r0 + rpb : nrows;
    const float* rw = a.in[I_RTW] + (size_t)l * 1024 * 32;
    const int i = lane & 31, kk = lane >> 5;
    const f32x4* ng = (const f32x4*)(a.in[I_N2G] + l * D) + kk;
    for (int rb = r0 + F.wave * 32; rb < r1; rb += NWAVES * 32) {
        const int nrow = (r1 - rb) < 32 ? (r1 - rb) : 32; const bool live = i < nrow;
        const int row = live ? rb + i : r1 - 1; const int w = row < T_LAT ? (row >> 12) : 8;
        const f32x4* xr = (const f32x4*)(X + (size_t)row * D) + kk;
        float ss = 0.f;
#pragma unroll 16
        for (int q = 0; q < 128; ++q) { const f32x4 v = xr[2 * q]; ss += (v[0] * v[0] + v[1] * v[1]) + (v[2] * v[2] + v[3] * v[3]); }
        ss += __builtin_bit_cast(float, __builtin_amdgcn_ds_bpermute((lane ^ 32) << 2, __builtin_bit_cast(int, ss)));
        const float rstd = __builtin_amdgcn_rsqf(ss * (1.f / D) + 1e-6f);
        const f32x4* sh = (const f32x4*)(MOD + (size_t)(l * 9 + w) * 6144 + 3072) + kk; const f32x4* sc = (const f32x4*)(MOD + (size_t)(l * 9 + w) * 6144 + 4096) + kk;
        v2u* ho = (v2u*)(H + (size_t)row * D) + kk;
        f32x16r acc;
#pragma unroll
        for (int e = 0; e < 16; ++e) acc[e] = 0.f;
        const float* wp = rw + (size_t)(4 * kk) * 32 + i;
        f32x4 xn[4], gn_[4], cn_[4], sn_[4], wn_[4];
#define RT_LOAD(q0_) do { _Pragma("unroll") for (int u_ = 0; u_ < 4; ++u_) { const int q_ = (q0_) + u_; xn[u_] = xr[2 * q_]; gn_[u_] = ng[2 * q_]; cn_[u_] = sc[2 * q_]; sn_[u_] = sh[2 * q_]; \
            wn_[u_] = (f32x4){wp[(size_t)(8 * q_) * 32], wp[(size_t)(8 * q_ + 1) * 32], wp[(size_t)(8 * q_ + 2) * 32], wp[(size_t)(8 * q_ + 3) * 32]}; } } while (0)
        RT_LOAD(0);
#pragma unroll 1
        for (int q0 = 0; q0 < 128; q0 += 4) {
            f32x4 xc[4], gc_[4], cc_[4], sc_[4], wc_[4];
#pragma unroll
            for (int u = 0; u < 4; ++u) { xc[u] = xn[u]; gc_[u] = gn_[u]; cc_[u] = cn_[u]; sc_[u] = sn_[u]; wc_[u] = wn_[u]; }
            if (q0 + 4 < 128) RT_LOAD(q0 + 4);
#pragma unroll
            for (int u = 0; u < 4; ++u) { const int q = q0 + u;
                const f32x4 h4 = xc[u] * rstd * gc_[u] * (cc_[u] + 1.0f) + sc_[u];
                if (live) { v2u o; o.x = pk2(h4[0], h4[1]); o.y = pk2(h4[2], h4[3]); ho[2 * q] = o; }
                acc = __builtin_amdgcn_mfma_f32_32x32x2f32(h4[0], wc_[u][0], acc, 0, 0, 0);
                acc = __builtin_amdgcn_mfma_f32_32x32x2f32(h4[1], wc_[u][1], acc, 0, 0, 0);
                acc = __builtin_amdgcn_mfma_f32_32x32x2f32(h4[2], wc_[u][2], acc, 0, 0, 0);
                acc = __builtin_amdgcn_mfma_f32_32x32x2f32(h4[3], wc_[u][3], acc, 0, 0, 0); }
        }
#undef RT_LOAD
        const float rbias = a.in[I_RTB][l * 32 + i];
#pragma unroll
        for (int r = 0; r < 16; ++r) { const int ri = (r & 3) + 8 * (r >> 2) + 4 * kk; lg[ri * 33 + i] = acc[r] + rbias; }
        LDS_WAIT(); asm volatile("" ::: "memory");
        if (lane < nrow) {
            LAS float* lr = lg + lane * 33; const int orow = rb + lane;
            float tv[4]; int ti[4];
#pragma unroll
            for (int r = 0; r < 4; ++r) { float bv = -INFINITY; int bi = 0;
#pragma unroll 8
                for (int e = 0; e < 32; ++e) { const float v = lr[e]; if (v > bv) { bv = v; bi = e; } }
                tv[r] = bv; ti[r] = bi; lr[bi] = -INFINITY; }
            const float e1 = expf(tv[1] - tv[0]), e2 = expf(tv[2] - tv[0]), e3 = expf(tv[3] - tv[0]); const float inv = 1.0f / (1.0f + e1 + e2 + e3);
            *(int4*)(EIDX + orow * 4) = make_int4(ti[0], ti[1], ti[2], ti[3]); *(f32x4*)(GATE + orow * 4) = (f32x4){inv, e1 * inv, e2 * inv, e3 * inv};
#pragma unroll
            for (int r = 0; r < 4; ++r) { const int rk = __hip_atomic_fetch_add(&hist[ti[r]], 1, __ATOMIC_RELAXED, __HIP_MEMORY_SCOPE_WORKGROUP); lex[(orow - r0) * 4 + r] = ti[r]; lrk[(orow - r0) * 4 + r] = rk; }
        }
        LDS_WAIT(); asm volatile("" ::: "memory");
    }
    __syncthreads();
    if (F.tid < 32) { const int c = hist[F.tid]; offl[F.tid] = c ? (int)__hip_atomic_fetch_add((unsigned*)(ws + WS_CTL) + CW_CNT + 64 * l + F.tid, (unsigned)c, __ATOMIC_RELAXED, __HIP_MEMORY_SCOPE_AGENT) : 0; }
    __syncthreads();
    for (int i = F.tid; i < (r1 > r0 ? (r1 - r0) * 4 : 0); i += NTHREADS) { const int e = lex[i], pos = offl[e] + lrk[i];
        POS[r0 * 4 + i] = pos; ROWOF[(size_t)e * pg8::MOE_CAP + pos] = (unsigned)(r0 + (i >> 2)) * (unsigned)(D * 2); }
    __syncthreads();
}

__device__ __forceinline__ LAS int* load_moe_base(const Ctx& F, int l) {
    LAS int* base = (LAS int*)(F.lds + LDSCTL_OFF + 256);
    if (F.tid < 32) base[64 + F.tid] = (int)__hip_atomic_load((unsigned*)(F.a->ws + WS_CTL) + CW_CNT + 64 * l + F.tid, __ATOMIC_RELAXED, __HIP_MEMORY_SCOPE_AGENT);
    __syncthreads();
    if (F.tid == 0) { int acc = 0; for (int e = 0; e < 32; ++e) { base[e] = acc; acc += (base[64 + e] + 255) & ~255; } base[32] = acc; }
    __syncthreads();
    return base;
}
__device__ __forceinline__ void moe_fix_pos(const Ctx& F, int nrows, const LAS int* base) {
    unsigned char* ws = F.a->ws; const int* EIDX = (const int*)(ws + WS_EIDX); int* POS = (int*)(ws + WS_POS);
    const int rpb = (nrows + F.G - 1) / F.G, r0 = F.bid * rpb, r1 = (r0 + rpb < nrows) ? r0 + rpb : nrows;
    for (int i = F.tid; i < (r1 > r0 ? (r1 - r0) * 4 : 0); i += NTHREADS) POS[r0 * 4 + i] += base[EIDX[r0 * 4 + i]];
}

constexpr int NSTAGE_L = 12, NSTAGES = 1 + DEPTH * NSTAGE_L + 1;
__global__ void __launch_bounds__(NTHREADS, 2) mk_fwd(Args args) {
    extern __shared__ __attribute__((aligned(16))) unsigned char lds_raw[];
    Ctx F; F.a = kargs(); F.lds = (LAS unsigned char*)lds_raw; F.tid = threadIdx.x; F.lane = F.tid & 63; F.wave = __builtin_amdgcn_readfirstlane(F.tid >> 6); F.bid = blockIdx.x; F.G = gridDim.x;
    volatile LAS unsigned* MISC = (volatile LAS unsigned*)(F.lds + LDSCTL_OFF);
    for (int u = F.tid; u < (LDS_BYTES - LDSCTL_OFF) / 4; u += NTHREADS) ((LAS unsigned*)(F.lds + LDSCTL_OFF))[u] = 0u;
    __syncthreads();
#if MK_PER_STAGE
#define GRID_BAR() do { } while (0)
#else
    (void)xcd_barrier_post((unsigned*)(F.a->ws + WS_CTL) + CW_BAR, MISC + 8);
#define GRID_BAR() do { XcdBarrier b_; b_.bar = (unsigned*)(kargs()->ws + WS_CTL) + CW_BAR; b_.x = xb_xcc_id(); b_.st = (volatile LAS unsigned*)((LAS unsigned char*)lds_raw + LDSCTL_OFF + opaque(32)); xcd_barrier(b_); } while (0)
#endif
#ifndef ONLY_S
#define ONLY_S -1
#endif
#define STG_SEL(k) (ONLY_S < 0 || ONLY_S == (((k) == 0) ? 0 : ((k) == NSTAGES - 1 ? 14 : (((k) - 1) % NSTAGE_L) + 1)))
#if MK_PER_STAGE
#define IN(k) (STG_SEL(k) && kargs()->ph_lo == (k))
#else
#define IN(k) STG_SEL(k)
#endif
#if MK_PER_STAGE
#define SEAM(k) do { } while (0)
#else
#define SEAM(k) do { if ((k) + 1 < NSTAGES) GRID_BAR(); } while (0)
#endif
#define STAGE(k) if (IN(k)) { F.a = kargs(); F.tid = opaque_v((int)threadIdx.x); F.lane = F.tid & 63; F.wave = __builtin_amdgcn_readfirstlane(F.tid >> 6); F.bid = opaque((int)blockIdx.x); F.G = opaque((int)gridDim.x); F.lds = (LAS unsigned char*)lds_raw + opaque(0); unsigned char* ws = F.a->ws; const int l = opaque(lq); unsigned char* wl = ws + WS_WTS + (size_t)l * WL_STRIDE; (void)wl; (void)ws;
#define STAGE_END(k) } SEAM(k);
    int lq = 0;
    STAGE(0) p0_prologue(F); STAGE_END(0)
    for (lq = 0; lq < DEPTH; ++lq) {
        const int sb = 1 + lq * NSTAGE_L;
        const int nrl = opaque((lq == DEPTH - 1) ? T_LAT : T_ALL);
        STAGE(sb + 0) stage_norm1(F, l); STAGE_END(sb + 0)
        STAGE(sb + 1) pg8::SchedWin S; S.A = (const char*)(ws + WS_H); S.Bt = (const char*)(wl + WO_WIN); S.tstep = (size_t)256 * 1024 * 2; S.G = F.G; S.c = F.bid; S.part = (nrl != T_ALL); pg8::EpiBf16 E{(bf16*)(ws + WS_Z), IN_COLS, nullptr, 0};
            pg8::gemm_phase(F.lds, F.tid, 1024, S, E); STAGE_END(sb + 1)
        STAGE(sb + 2) for (int rep = 0; rep < REPN(1); ++rep) stage_rw_prep1(F, l); for (int rep = 0; rep < REPN(2); ++rep) stage_s5_scan<0>(F, l); for (int rep = 0; rep < REPN(3); ++rep) stage_hy_pre(F, l, nrl); STAGE_END(sb + 2)
        STAGE(sb + 3) { pg8::SchedStatic S; S.init(ws + WS_ARW, wl + WO_RWCAT, T_ALL, 2560, 256, F.G, F.bid); pg8::EpiBf16 E{(bf16*)(ws + WS_P), 2560, nullptr, 0}; PT(4); pg8::gemm_phase(F.lds, F.tid, 256, S, E); PT(5); }
            F.tid = opaque_v((int)threadIdx.x); F.lane = F.tid & 63;
            for (int rep = 0; rep < REPN(4); ++rep) stage_s5_scan<1>(F, l); STAGE_END(sb + 3)
        STAGE(sb + 4) for (int rep = 0; rep < REPN(5); ++rep) stage_rw_prep2(F, l); for (int rep = 0; rep < REPN(6); ++rep) stage_s5_prep(F, l, nrl); STAGE_END(sb + 4)
        STAGE(sb + 5) PT(10); stage_mixer(F, l); PT(11); STAGE_END(sb + 5) STAGE(sb + 5) PT(12); }
        STAGE(sb + 6) { pg8::SchedStatic S; S.init(ws + WS_AS5, wl + WO_GLU, nrl, 1024, 512, F.G, F.bid); pg8::EpiGlu<0> E{(bf16*)(ws + WS_YS5), 512, F.a->in[I_S5GLUB] + l * 1024, 0, 512}; PT(13); pg8::gemm_phase(F.lds, F.tid, 512, S, E); PT(14); }
            for (int rep = 0; rep < REPN(7); ++rep) stage_rw_readout(F, l); for (int rep = 0; rep < REPN(8); ++rep) stage_hy_post(F, l, nrl); STAGE_END(sb + 6)
        STAGE(sb + 7) pg8::SchedMerge S; S.A0 = (const char*)(ws + WS_YHY); S.A1 = (const char*)(ws + WS_YRW); S.A2 = (const char*)(ws + WS_YS5); S.Bt = (const char*)(wl + WO_WBR); S.tstep = (size_t)256 * 512 * 2; S.bstride = (size_t)1024 * 512 * 2;
            S.nM = nrl / 256; S.nN = 4; S.G = F.G; S.c = F.bid;
            pg8::EpiMerge E{(bf16*)(ws + WS_MTMP), (bf16*)(ws + WS_H), (const bf16*)(ws + WS_Z) + GATE_OFF}; pg8::gemm_phase(F.lds, F.tid, 512, S, E); STAGE_END(sb + 7)
        STAGE(sb + 8) pg8::SchedStatic S; S.init(ws + WS_H, wl + WO_WOUT, nrl, 1024, 1024, F.G, F.bid); pg8::EpiResid E{(float*)(ws + WS_X), (const float*)(ws + WS_MOD) + (size_t)l * 9 * 6144 + 2048};
            pg8::gemm_phase(F.lds, F.tid, 1024, S, E); STAGE_END(sb + 8)
        STAGE(sb + 9) PT(17); stage_norm2_router(F, l, nrl); PT(18); STAGE_END(sb + 9)
        STAGE(sb + 10) LAS int* base = load_moe_base(F, l); moe_fix_pos(F, nrl, base);
            pg8::SchedMoeG S; S.A = (const char*)(ws + WS_H); S.rowof = (const unsigned*)(ws + WS_ROWOF); S.Bt = (const char*)(wl + WO_W1); S.tstep = (size_t)256 * 1024 * 2; S.estride = (size_t)2048 * 1024 * 2; S.NPN = 8; S.G = F.G; S.c = F.bid; S.base = base;
            pg8::EpiGlu<1> E{(bf16*)(ws + WS_ACT), 1024, F.a->in[I_B1] + (size_t)l * 32 * 2048, 2048, 1024}; pg8::gemm_phase(F.lds, F.tid, 1024, S, E); STAGE_END(sb + 10)
        STAGE(sb + 11) LAS int* base = load_moe_base(F, l);
            pg8::SchedMoe S; S.A = (const char*)(ws + WS_ACT); S.Bt = (const char*)(wl + WO_W2); S.tstep = (size_t)256 * 1024 * 2; S.estride = (size_t)1024 * 1024 * 2; S.NPN = 4; S.G = F.G; S.c = F.bid; S.base = base;
            pg8::EpiBf16 E{(bf16*)(ws + WS_XS), 1024, F.a->in[I_B2] + (size_t)l * 32 * 1024, 1024}; pg8::gemm_phase(F.lds, F.tid, 1024, S, E); STAGE_END(sb + 11)
    }
    lq = DEPTH;
    STAGE(NSTAGES - 1)
#ifndef PROBE_T
        stage_norm1(F, l);
#endif
#ifdef PROBE_T
        { const unsigned long long* st = (const unsigned long long*)(F.a->ws + WS_CTL + CW_STAMP * 4); const float cval = (float)(long long)(st[PROBE_B] - st[PROBE_A]) * (1.0f / (100.0f * PROBE_DIV));
          __syncthreads(); for (size_t i = (size_t)F.bid * NTHREADS + F.tid; i < (size_t)T_LAT * D; i += (size_t)F.G * NTHREADS) F.a->out[i] = cval; }
#endif
    }
#undef IN
#undef SEAM
}

extern "C" void kernel_launch(void* const* d_in, const int* in_sizes, int n_in, void* d_out, int out_size, void* d_ws, size_t ws_size, hipStream_t stream) {
    static int grid = 0;
    if (grid == 0) {
        if (n_in != 51 || out_size != T_LAT * D || ws_size < WS_END) { fprintf(stderr, "kernel_launch: unexpected shapes (n_in %d out %d ws %zu, need %zu)\n", n_in, out_size, ws_size, (size_t)WS_END); grid = -1; return; }
        int dev = 0, cus = 0, per_cu = 0;
        if (hipGetDevice(&dev) != hipSuccess || hipDeviceGetAttribute(&cus, hipDeviceAttributeMultiprocessorCount, dev) != hipSuccess) { grid = -1; return; }
        if (hipFuncSetAttribute((const void*)mk_fwd, hipFuncAttributeMaxDynamicSharedMemorySize, LDS_BYTES) != hipSuccess) { fprintf(stderr, "kernel_launch: hipFuncSetAttribute failed\n"); grid = -1; return; }
        if (hipOccupancyMaxActiveBlocksPerMultiprocessor(&per_cu, (const void*)mk_fwd, NTHREADS, LDS_BYTES) != hipSuccess || per_cu < 1) fprintf(stderr, "kernel_launch: occupancy query says %d\n", per_cu);
        (void)hipGetLastError();
        grid = cus;
    }
    if (grid < 0) return;
    if (hipMemsetAsync((char*)d_ws + WS_CTL, 0, CTL_ZERO_BYTES, stream) != hipSuccess) return;
    Args a{};
    for (int i = 0; i < 51; ++i) a.in[i] = (const float*)d_in[i];
    a.out = (float*)d_out; a.ws = (unsigned char*)d_ws;
#if MK_PER_STAGE
    for (int s = 0; s < NSTAGES; ++s) { a.ph_lo = s; a.ph_hi = s + 1; int reps = 1;
#ifdef PROBE_SET
        { const int ls = (s == 0 || s == NSTAGES - 1) ? -1 : (s - 1) % NSTAGE_L;
          if (PROBE_SET >= 1 && PROBE_SET <= 13 && ls == PROBE_SET - 1 && ls != 5 && ls != 8 && !(ls == 0 && s > 1)) reps = 3;
          if (PROBE_SET == 14 && s == 0) reps = 3; }
#endif
        for (int r = 0; r < reps; ++r) hipLaunchKernelGGL(mk_fwd, dim3(grid), dim3(NTHREADS), LDS_BYTES, stream, a); }
#else
    a.ph_lo = 0; a.ph_hi = NSTAGES; hipLaunchKernelGGL(mk_fwd, dim3(grid), dim3(NTHREADS), LDS_BYTES, stream, a);
#endif
}
```

```cpp
#include <hip/hip_runtime.h>
#include <cstdio>
#include <cstdint>

#ifndef DUPK
#define DUPK 0
#endif
#define REPN(k) ((DUPK == (k)) ? 3 : 1)
#ifndef REP_GEMM
#define REP_GEMM 1
#endif
#ifndef REP_LIGHT
#define REP_LIGHT 1
#endif
#ifndef REP_PRO
#define REP_PRO 1
#endif
#ifndef MK_PER_STAGE
#define MK_PER_STAGE 0
#endif

#define GAS __attribute__((address_space(1)))
#define LAS __attribute__((address_space(3)))
typedef unsigned short bf16;
typedef unsigned v4u __attribute__((ext_vector_type(4)));
typedef unsigned v2u __attribute__((ext_vector_type(2)));
typedef float f32x4 __attribute__((ext_vector_type(4)));
typedef float f32x2 __attribute__((ext_vector_type(2)));
typedef short bf16x8 __attribute__((ext_vector_type(8)));

constexpr int D = 1024, BATCH = 8, SEQ = 4096, CTXL = 256, DEPTH = 2;
constexpr int T_LAT = BATCH * SEQ, T_CTX = BATCH * CTXL, T_ALL = T_LAT + T_CTX;
constexpr int IN_COLS = 6912, HY_OFF = 0, RW_OFF = 1536, S5_OFF = 3328, GATE_OFF = 3840;
constexpr int NE = 32, TOPK = 4;
constexpr int MAXSLOT = 147456;
constexpr int NWAVES = 8, NTHREADS = 512;
constexpr int HY_MARG = 128, HY_ROWB = 8720, HY_RLEN = 8272, HY_RLENC = 592;
constexpr int HY_R1_OFF = 8 * HY_ROWB, HY_R2_OFF = HY_R1_OFF + HY_RLEN * 2;

constexpr size_t MiB = 1ull << 20;
constexpr size_t WS_CTL = 0, CTL_ZERO_BYTES = 1 * MiB;
constexpr size_t WS_MOD = 1 * MiB;
constexpr size_t WS_BLKCNT = 2 * MiB;
constexpr size_t WS_META = 2 * MiB + 512 * 1024;
constexpr size_t WS_ROWOF = 480 * MiB;
constexpr int CW_CNT = 24576;
constexpr size_t WS_EIDX = 3 * MiB, WS_GATE = 4 * MiB, WS_POS = 5 * MiB;
constexpr size_t WS_WTS = 8 * MiB, WL_STRIDE = 214 * MiB;
constexpr size_t WO_WIN = 0, WO_RWCAT = 14 * MiB, WO_GLU = 16 * MiB, WO_WBR = 17 * MiB, WO_WOUT = 20 * MiB, WO_W1 = 22 * MiB, WO_W2 = 150 * MiB;
constexpr size_t WS_GF = 436 * MiB, GF_STRIDE = 20 * MiB, GF_CTX = 17 * MiB;
constexpr size_t WS_X = 504 * MiB;
constexpr size_t WS_H = 640 * MiB;
constexpr size_t WS_BIG = 708 * MiB;
constexpr size_t WS_Z = WS_BIG;
constexpr size_t WS_SCN = 1167 * MiB;
constexpr size_t WS_MTMP = WS_SCN;
constexpr size_t WS_P = 1473 * MiB;
constexpr size_t WS_ARW = 1643 * MiB;
constexpr size_t WS_YP = 1660 * MiB;
constexpr size_t WS_YDIR = WS_YP;
constexpr size_t WS_UT = 1796 * MiB;
constexpr size_t WS_AS5 = 2000 * MiB;
constexpr size_t WS_YHY = 1898 * MiB, WS_YRW = 1932 * MiB, WS_YS5 = 1966 * MiB;
constexpr size_t WS_XS = WS_BIG;
constexpr size_t WS_ACT = WS_BIG + 288 * MiB;
constexpr size_t WS_END = 2034 * MiB;
constexpr int CW_BAR = 4096;

constexpr int RING_BYTES = 131072;
constexpr int LDSCTL_OFF = RING_BYTES;
constexpr int LDS_BYTES = 163840;

typedef __bf16 bf16x2_t __attribute__((ext_vector_type(2)));
__device__ __forceinline__ unsigned pk2(float lo, float hi) { const bf16x2_t v = __builtin_convertvector((f32x2){lo, hi}, bf16x2_t); return __builtin_bit_cast(unsigned, v); }
__device__ __forceinline__ unsigned f2bf(float f) { return pk2(f, 0.f) & 0xffffu; }
__device__ __forceinline__ float bf2f(bf16 b) { return __builtin_bit_cast(float, ((unsigned)b) << 16); }
__device__ __forceinline__ float bflo(unsigned w) { return __builtin_bit_cast(float, w << 16); }
__device__ __forceinline__ float bfhi(unsigned w) { return __builtin_bit_cast(float, w & 0xffff0000u); }
__device__ __forceinline__ float sigm(float x) { return __builtin_amdgcn_rcpf(1.f + __expf(-x)); }
__device__ __forceinline__ float tanh_fast(float x) { const float e = __expf(2.f * x); return 1.f - 2.f * __builtin_amdgcn_rcpf(e + 1.f); }
#define LDS_WAIT() asm volatile("s_waitcnt lgkmcnt(0)" ::: "memory")
__device__ __forceinline__ float dpp_f(float x, const int ctrl_sel) {
    const int v = __builtin_bit_cast(int, x);
    int r;
    if (ctrl_sel == 0) r = __builtin_amdgcn_update_dpp(0, v, 0xB1, 0xF, 0xF, true);
    else if (ctrl_sel == 1) r = __builtin_amdgcn_update_dpp(0, v, 0x4E, 0xF, 0xF, true);
    else r = __builtin_amdgcn_update_dpp(0, v, 0x141, 0xF, 0xF, true);
    return __builtin_bit_cast(float, r);
}
__device__ __forceinline__ float red32(float x) {
    x += dpp_f(x, 0); x += dpp_f(x, 1); x += dpp_f(x, 2);
    x += __builtin_bit_cast(float, __builtin_amdgcn_update_dpp(0, __builtin_bit_cast(int, x), 0x128, 0xF, 0xF, true));
    x += __builtin_bit_cast(float, __builtin_amdgcn_ds_swizzle(__builtin_bit_cast(int, x), 0x401F));
    return x;
}
__device__ __forceinline__ float wave_sum(float v) {
    v = red32(v);
    return __builtin_bit_cast(float, __builtin_amdgcn_readlane(__builtin_bit_cast(int, v), 0)) + __builtin_bit_cast(float, __builtin_amdgcn_readlane(__builtin_bit_cast(int, v), 32));
}
__device__ __forceinline__ int xch32(int v, const int step) {
    if (step == 0) return __builtin_amdgcn_update_dpp(0, v, 0xB1, 0xF, 0xF, true);
    if (step == 1) return __builtin_amdgcn_update_dpp(0, v, 0x4E, 0xF, 0xF, true);
    if (step == 2) return __builtin_amdgcn_update_dpp(0, v, 0x141, 0xF, 0xF, true);
    if (step == 3) return __builtin_amdgcn_update_dpp(0, v, 0x128, 0xF, 0xF, true);
    return __builtin_amdgcn_ds_swizzle(v, 0x401F);
}
__device__ __forceinline__ float red8(float x) { x += dpp_f(x, 0); x += dpp_f(x, 1); x += dpp_f(x, 2); return x; }

#define XB_TMO      128
#define XB_XCNT(j)  (256  + 64 * (j))
#define XB_XSUB(j)  (1280 + 64 * (j))
#define XB_XGEN(j)  (2304 + 64 * (j))
#define XB_TOP      3328
#define XB_TOPGEN   3392
#define XCD_BAR_WORDS 3456
#define XB_SPIN_CAP (1u << 22)
__device__ __forceinline__ unsigned xb_ld(unsigned* p)              { return __hip_atomic_load(p, __ATOMIC_RELAXED, __HIP_MEMORY_SCOPE_AGENT); }
__device__ __forceinline__ unsigned xb_add(unsigned* p, unsigned v) { return __hip_atomic_fetch_add(p, v, __ATOMIC_RELAXED, __HIP_MEMORY_SCOPE_AGENT); }
__device__ __forceinline__ unsigned xb_xcc_id() { return (unsigned)__builtin_amdgcn_s_getreg((3 << 11) | 20) & 0xFu; }
#define XB_SPIN(cond, bar) do { unsigned _sp = 0; while (cond) { __builtin_amdgcn_s_sleep(1); \
    if ((++_sp & 255u) == 0u) { if (xb_ld(&(bar)[XB_TMO])) break; if (_sp > XB_SPIN_CAP) { atomicAdd(&(bar)[XB_TMO], 1u); break; } } } } while (0)
struct XcdBarrier { unsigned* bar; unsigned x; volatile LAS unsigned* st; };
__device__ __forceinline__ XcdBarrier xcd_barrier_post(unsigned* bar, volatile LAS unsigned* st) {
    XcdBarrier b; b.bar = bar; b.x = xb_xcc_id(); b.st = st;
    if (threadIdx.x == 0) (void)xb_add(&bar[XB_XCNT(b.x)], 1u);
    return b;
}
__device__ __forceinline__ void xcd_barrier_complete(unsigned* bar, unsigned x, unsigned& nloc, unsigned& nx) {
    const unsigned G = gridDim.x * gridDim.y * gridDim.z;
    unsigned sum, cnt, mine, sp = 0u;
    for (;;) {
        sum = 0u; cnt = 0u; mine = 0u;
#pragma unroll
        for (unsigned j = 0; j < 16; ++j) { const unsigned c = xb_ld(&bar[XB_XCNT(j)]); sum += c; cnt += (c > 0u) ? 1u : 0u; mine = (j == x) ? c : mine; }
        if (sum == G) break;
        __builtin_amdgcn_s_sleep(1);
        if ((++sp & 255u) == 0u) { if (xb_ld(&bar[XB_TMO])) break; if (sp > XB_SPIN_CAP) { atomicAdd(&bar[XB_TMO], 1u); break; } }
    }
    nloc = mine > 0u ? mine : 1u; nx = cnt > 0u ? cnt : 1u;
}
__device__ __forceinline__ void xcd_barrier(const XcdBarrier& b) {
    asm volatile("s_waitcnt vmcnt(0)" ::: "memory");
    __syncthreads();
    if (threadIdx.x == 0) {
        unsigned* bar = b.bar;
        __builtin_amdgcn_s_waitcnt(0);
        unsigned nloc = b.st[0], nx = b.st[1];
        if (nloc == 0u) { xcd_barrier_complete(bar, b.x, nloc, nx); b.st[0] = nloc; b.st[1] = nx; }
        const unsigned old = xb_add(&bar[XB_XSUB(b.x)], 1u);
        const unsigned gen = old / nloc;
        if (old + 1u == (gen + 1u) * nloc) {
            __builtin_amdgcn_fence(__ATOMIC_RELEASE, "agent");
            asm volatile("s_waitcnt vmcnt(0)" ::: "memory");
            const unsigned og = xb_add(&bar[XB_TOP], 1u);
            const unsigned tg = og / nx;
            if (og + 1u == (tg + 1u) * nx) xb_add(&bar[XB_TOPGEN], 1u);
            else XB_SPIN(xb_ld(&bar[XB_TOPGEN]) == tg, bar);
            __builtin_amdgcn_fence(__ATOMIC_ACQUIRE, "agent");
            xb_add(&bar[XB_XGEN(b.x)], 1u);
            asm volatile("s_waitcnt vmcnt(0)" ::: "memory");
        } else {
            XB_SPIN(xb_ld(&bar[XB_XGEN(b.x)]) == gen, bar);
            __builtin_amdgcn_fence(__ATOMIC_ACQUIRE, "agent");
            asm volatile("s_waitcnt vmcnt(0)" ::: "memory");
        }
    }
    __syncthreads();
}

namespace pg8 {
constexpr int MOE_CAP = 34816;
constexpr int BM = 256, BK = 64, HALF = 128, HTB = HALF * BK * 2, STAGE_BYTES = 8 * HTB, NXCD = 8, WGM = 8, ROWTAB_OFF = 131072 + 4096;
__host__ __device__ __forceinline__ int lds_byte(int r, int c) { const int st = (r >> 4) * 2 + (c >> 5), rr = r & 15, cc = c & 31, ob = rr * 64 + cc * 2; return st * 1024 + (ob ^ (((ob >> 9) & 1) << 5)); }
__host__ __device__ __forceinline__ void stage_rc(int b, int& R, int& C) { const int st = b / 1024, sb = b % 1024, swz = sb ^ (((sb >> 9) & 1) << 5); R = (st >> 1) * 16 + swz / 64; C = (st & 1) * 32 + (swz % 64) / 2; }
__host__ __device__ __forceinline__ int perm32(int rho) { const int n = rho >> 4, i = rho & 15; return 8 * (i >> 2) + 4 * n + (i & 3); }
struct Unit { int pm, pn, e; };
__device__ __forceinline__ unsigned cvt_pk_bf16(float lo, float hi) { return pk2(lo, hi); }

__device__ __forceinline__ void tile_of(int L, int nM, int nN, int& pm, int& pn) {
    const int nwg = nM * nN; int wgid = L;
    { const int q = nwg / NXCD, r = nwg % NXCD, xcd = wgid % NXCD, off = wgid / NXCD; wgid = (xcd < r ? xcd * (q + 1) : r * (q + 1) + (xcd - r) * q) + off; }
    const int nig = WGM * nN, gid = wgid / nig, fm = gid * WGM, gsz = (nM - fm) < WGM ? (nM - fm) : WGM;
    pm = fm + ((wgid % nig) % gsz); pn = (wgid % nig) / gsz;
}
struct SchedStatic {
    static constexpr bool GATHER = false;
    const char* A; const char* Bt; size_t tstep; int nM, nN, G, c;
    __device__ __forceinline__ void init(const void* A_, const void* Bt_, int M, int N, int K, int G_, int c_) { A = (const char*)A_; Bt = (const char*)Bt_; tstep = (size_t)BM * K * 2; nM = M / BM; nN = N / BM; G = G_; c = c_; }
    __device__ __forceinline__ bool next(int i, Unit& u) const { const long L = (long)i * G + c; if (L >= (long)nM * nN) return false; tile_of((int)L, nM, nN, u.pm, u.pn); u.e = 0; return true; }
    __device__ __forceinline__ const char* aptr(const Unit& u) const { return A + (size_t)u.pm * tstep; }
    __device__ __forceinline__ const char* bptr(const Unit& u) const { return Bt + (size_t)u.pn * tstep; }
};
struct SchedWin {
    static constexpr bool GATHER = false;
    const char* A; const char* Bt; size_t tstep; int G, c, part;
    __device__ __forceinline__ bool next(int i, Unit& u) const {
        const int L = i * G + c, nmf = part ? 128 : 136, nfull = nmf * 27; u.e = 0;
        if (L < nfull) { tile_of(L, nmf, 27, u.pm, u.pn); return true; }
        const int L2 = L - nfull; if (!part || L2 >= 8 * 9) return false;
        u.pm = 128 + L2 / 9; u.pn = 6 + L2 % 9; return true; }
    __device__ __forceinline__ const char* aptr(const Unit& u) const { return A + (size_t)u.pm * tstep; }
    __device__ __forceinline__ const char* bptr(const Unit& u) const { return Bt + (size_t)u.pn * tstep; }
};
struct SchedMerge {
    static constexpr bool GATHER = false;
    const char* A0; const char* A1; const char* A2; const char* Bt; size_t tstep, bstride; int nM, nN, G, c;
    __device__ __forceinline__ bool next(int i, Unit& u) const { const int j = i / 3, br = i - 3 * j; const long L = (long)j * G + c; if (L >= (long)nM * nN) return false; tile_of((int)L, nM, nN, u.pm, u.pn); u.e = br; return true; }
    __device__ __forceinline__ const char* aptr(const Unit& u) const { return (u.e == 0 ? A0 : (u.e == 1 ? A1 : A2)) + (size_t)u.pm * tstep; }
    __device__ __forceinline__ const char* bptr(const Unit& u) const { return Bt + (size_t)u.e * bstride + (size_t)u.pn * tstep; }
};
struct SchedMoe {
    static constexpr bool GATHER = false;
    const char* A; const char* Bt; size_t tstep, estride; int NPN, G, c; const LAS int* base;
    __device__ __forceinline__ bool next(int i, Unit& u) const {
        const int ntiles = base[32] >> 8; const int per = G >> 3;
        const long L = (long)i * G + (((G & 7) == 0) ? (c & 7) * per + (c >> 3) : c);
        if (L >= (long)ntiles * NPN) return false;
        u.pm = (int)(L / NPN); u.pn = (int)(L % NPN); const int r0 = u.pm << 8; int e = 0;
#pragma unroll 1
        for (int k = 1; k < 32; ++k) e += (r0 >= base[k]) ? 1 : 0;
        u.e = e; return true;
    }
    __device__ __forceinline__ const char* aptr(const Unit& u) const { return A + (size_t)u.pm * tstep; }
    __device__ __forceinline__ const char* bptr(const Unit& u) const { return Bt + (size_t)u.e * estride + (size_t)u.pn * tstep; }
};
struct SchedMoeG : SchedMoe {
    static constexpr bool GATHER = true;
    const unsigned* rowof;
    __device__ __forceinline__ const char* aptr(const Unit&) const { return A; }
    __device__ __forceinline__ const unsigned* rowptr(const Unit& u) const { return rowof + (size_t)u.e * MOE_CAP + ((u.pm << 8) - base[u.e]); }
    __device__ __forceinline__ int valid(const Unit& u) const { return base[64 + u.e] - ((u.pm << 8) - base[u.e]); }
};

template <class Epi, class Sched>
__device__ __forceinline__ void gemm_phase(LAS unsigned char* lds, const int tid, const int K, const Sched& S, const Epi& E) {
    const int wid = __builtin_amdgcn_readfirstlane(tid >> 6), lane = tid & 63, wr = wid >> 2, wc = wid & 3, fr = lane & 15, fq = lane >> 4;
    const int nt = K / BK;
    unsigned voffA[2], voffB[2];
#pragma unroll
    for (int i = 0; i < 2; ++i) { int R, C; stage_rc(tid * 16 + i * 8192, R, C); const int Rb = Epi::PERM ? ((R & ~31) + perm32(R & 31)) : R;
        voffA[i] = (unsigned)(R * K + C) * 2u; voffB[i] = (unsigned)(Rb * K + C) * 2u; }
    const size_t kstep = (size_t)(BK * 2);
    const size_t hstep = (size_t)HALF * K * 2;
    const unsigned ldsw = (unsigned)wid * 1024u;
    const int aoff = lds_byte(wr * 64 + fr, fq * 8), boff = lds_byte(wc * 32 + fr, fq * 8);
#define PG8_SA(b, h) (((b) * 2 + (h)) * HTB)
#define PG8_SB(b, h) ((4 + (b) * 2 + (h)) * HTB)
#define PG8_STAGE(bufoff, gbase, voff) do { _Pragma("unroll") for (int _i = 0; _i < 2; ++_i) \
        __builtin_amdgcn_global_load_lds((const unsigned*)((const char*)(gbase) + (voff)[_i]), (LAS unsigned*)(lds + (bufoff) + ldsw + _i * 8192), 16, 0, 0); } while (0)
#define PG8_STAGEA(bufoff, kp, h) do { if constexpr (Sched::GATHER) { _Pragma("unroll") for (int _i = 0; _i < 2; ++_i) \
        __builtin_amdgcn_global_load_lds((const unsigned*)((const char*)(kp) + g[2 * (h) + _i]), (LAS unsigned*)(lds + (bufoff) + ldsw + _i * 8192), 16, 0, 0); } \
        else { PG8_STAGE(bufoff, (kp) + (h) * hstep, voffA); } } while (0)
#define PG8_GLOAD(un_, buf) do { const LAS unsigned* rt_ = (const LAS unsigned*)(lds + ROWTAB_OFF + (buf) * 1024) + gR0; const int nv_ = S.valid(un_); \
        _Pragma("unroll") for (int _j = 0; _j < 4; ++_j) g[_j] = ((gR0 + 64 * _j < nv_) ? rt_[64 * _j] : 0u) + gCb; } while (0)
#define PG8_GDMA(un_, buf) do { if (wid == 0) { unsigned lo_ = (unsigned)threadIdx.x; asm volatile("" : "+v"(lo_)); lo_ = (lo_ & 63u) * 16u; \
        __builtin_amdgcn_global_load_lds((const unsigned*)((const char*)S.rowptr(un_) + lo_), (LAS unsigned*)(lds + ROWTAB_OFF + (buf) * 1024), 16, 0, 0); } } while (0)
#define PG8_LDA(dst, b, h) do { _Pragma("unroll") for (int m = 0; m < 4; ++m) _Pragma("unroll") for (int k = 0; k < 2; ++k) dst[m][k] = *(const LAS bf16x8*)(lds + PG8_SA(b, h) + aoff + m * 2048 + k * 1024); } while (0)
#define PG8_LDB(dst, b, h) do { _Pragma("unroll") for (int n = 0; n < 2; ++n) _Pragma("unroll") for (int k = 0; k < 2; ++k) dst[n][k] = *(const LAS bf16x8*)(lds + PG8_SB(b, h) + boff + n * 2048 + k * 1024); } while (0)
#define PG8_MMA(ai, bj, At, Bt) do { __builtin_amdgcn_s_setprio(1); _Pragma("unroll") for (int m = 0; m < 4; ++m) _Pragma("unroll") for (int n = 0; n < 2; ++n) _Pragma("unroll") for (int k = 0; k < 2; ++k) \
        acc[ai][bj][m][n] = __builtin_amdgcn_mfma_f32_16x16x32_bf16(Bt[n][k], At[m][k], acc[ai][bj][m][n], 0, 0, 0); __builtin_amdgcn_s_setprio(0); } while (0)
#define PG8_WAIT_V(n) asm volatile("s_waitcnt vmcnt(" #n ")" ::: "memory")
#define PG8_WAIT_L(n) asm volatile("s_waitcnt lgkmcnt(" #n ")" ::: "memory")
#define PG8_BAR __builtin_amdgcn_s_barrier()
#define PG8_SCHED __builtin_amdgcn_sched_barrier(0)
    Unit cur, nxt; int ui = 0;
    if (!S.next(0, cur)) return;
    f32x4 acc[2][2][4][2];
#pragma unroll
    for (int a = 0; a < 2; ++a)
#pragma unroll
        for (int b = 0; b < 2; ++b)
#pragma unroll
            for (int m = 0; m < 4; ++m)
#pragma unroll
                for (int n = 0; n < 2; ++n) acc[a][b][m][n] = (f32x4){0.f, 0.f, 0.f, 0.f};
    bf16x8 At[4][2], B0[2][2], B1[2][2];
    const char* cA = S.aptr(cur); const char* cB = S.bptr(cur);
    unsigned g[4] = {0u, 0u, 0u, 0u}; int gR0 = 0; unsigned gCb = 0u;
    if constexpr (Sched::GATHER) { int R, C; stage_rc(tid * 16, R, C); gR0 = R; gCb = (unsigned)C * 2u;
        PG8_GDMA(cur, 0); PG8_WAIT_V(0); PG8_BAR; PG8_GLOAD(cur, 0); }
    PG8_STAGE(PG8_SB(0, 0), cB, voffB); PG8_STAGE(PG8_SB(0, 1), cB + hstep, voffB); PG8_STAGEA(PG8_SA(0, 0), cA, 0); PG8_STAGEA(PG8_SA(0, 1), cA, 1);
    if (wr == 1) PG8_BAR;
    PG8_WAIT_V(2); PG8_BAR;
    PG8_STAGE(PG8_SB(1, 0), cB + kstep, voffB); PG8_STAGEA(PG8_SA(1, 0), cA + kstep, 0); PG8_STAGE(PG8_SB(1, 1), cB + hstep + kstep, voffB);
    PG8_WAIT_V(6); PG8_BAR;
    for (;;) {
        const bool has_next = S.next(ui + 1, nxt);
        const char* nA = has_next ? S.aptr(nxt) : cA; const char* nB = has_next ? S.bptr(nxt) : cB;
        if constexpr (Sched::GATHER) { if (has_next) PG8_GDMA(nxt, (ui + 1) & 1); }
        for (int t = 0; t < nt; t += 2) {
            const bool last = (t == nt - 2);
            const char* a1 = cA + (size_t)(t + 1) * kstep;
            const char* a2 = last ? nA : cA + (size_t)(t + 2) * kstep; const char* b2 = last ? nB : cB + (size_t)(t + 2) * kstep;
            const char* a3 = a2 + kstep; const char* b3 = b2 + kstep;
            PG8_LDB(B0, 0, 0); PG8_LDB(B1, 0, 1); PG8_SCHED; PG8_LDA(At, 0, 0); PG8_STAGEA(PG8_SA(1, 1), a1, 1);
            PG8_WAIT_V(8); PG8_WAIT_L(0); PG8_BAR; PG8_MMA(0, 0, At, B0); PG8_MMA(0, 1, At, B1); PG8_BAR; PG8_SCHED;
            if constexpr (Sched::GATHER) { if (last && has_next) PG8_GLOAD(nxt, (ui + 1) & 1); PG8_SCHED; }
            PG8_LDA(At, 0, 1); PG8_STAGE(PG8_SB(0, 0), b2, voffB); PG8_STAGE(PG8_SB(0, 1), b2 + hstep, voffB); PG8_STAGEA(PG8_SA(0, 0), a2, 0);
            PG8_WAIT_V(8); PG8_WAIT_L(0); PG8_BAR; PG8_MMA(1, 0, At, B0); PG8_MMA(1, 1, At, B1); PG8_BAR; PG8_SCHED;
            PG8_LDB(B0, 1, 0); PG8_LDB(B1, 1, 1); PG8_SCHED; PG8_LDA(At, 1, 0); PG8_STAGEA(PG8_SA(0, 1), a2, 1);
            PG8_WAIT_V(8); PG8_WAIT_L(0); PG8_BAR; PG8_MMA(0, 0, At, B0); PG8_MMA(0, 1, At, B1); PG8_BAR; PG8_SCHED;
            PG8_LDA(At, 1, 1); PG8_STAGE(PG8_SB(1, 0), b3, voffB); PG8_STAGE(PG8_SB(1, 1), b3 + hstep, voffB); PG8_STAGEA(PG8_SA(1, 0), a3, 0);
            PG8_WAIT_V(8); PG8_WAIT_L(0); PG8_BAR; PG8_MMA(1, 0, At, B0); PG8_MMA(1, 1, At, B1); PG8_BAR; PG8_SCHED;
        }
        if (wr == 0) PG8_BAR;
        { int t2_ = (int)threadIdx.x; asm volatile("" : "+v"(t2_)); E(acc, cur, wr, wc, t2_ & 15, (t2_ >> 4) & 3); }
        if (!has_next) break;
#pragma unroll
        for (int a = 0; a < 2; ++a)
#pragma unroll
            for (int b = 0; b < 2; ++b)
#pragma unroll
                for (int m = 0; m < 4; ++m)
#pragma unroll
                    for (int n = 0; n < 2; ++n) acc[a][b][m][n] = (f32x4){0.f, 0.f, 0.f, 0.f};
        cur = nxt; cA = nA; cB = nB; ++ui;
        if (wr == 1) PG8_BAR;
    }
    PG8_WAIT_V(0);
    PG8_BAR;
#undef PG8_SA
#undef PG8_SB
#undef PG8_STAGE
#undef PG8_STAGEA
#undef PG8_GLOAD
#undef PG8_GDMA
#undef PG8_LDA
#undef PG8_LDB
#undef PG8_MMA
#undef PG8_WAIT_V
#undef PG8_WAIT_L
#undef PG8_BAR
#undef PG8_SCHED
}

struct EpiBf16 {
    static constexpr bool PERM = true;
    bf16* O; int ldc; const float* bias; int bias_stride;
    __device__ __forceinline__ void operator()(const f32x4 (&acc)[2][2][4][2], const Unit& u, int wr, int wc, int fr, int fq) const {
        const int row0 = u.pm * BM + wr * 64 + fr, col0 = u.pn * BM + wc * 32 + 8 * fq;
        f32x4 bv[2][2];
#pragma unroll
        for (int bj = 0; bj < 2; ++bj)
#pragma unroll
            for (int n = 0; n < 2; ++n) bv[bj][n] = bias ? *(const f32x4*)(bias + (size_t)u.e * bias_stride + col0 + bj * HALF + 4 * n) : (f32x4){0.f, 0.f, 0.f, 0.f};
#pragma unroll
        for (int ai = 0; ai < 2; ++ai)
#pragma unroll
            for (int m = 0; m < 4; ++m) { bf16* rowp = O + (size_t)(row0 + ai * HALF + m * 16) * ldc + col0;
#pragma unroll
                for (int bj = 0; bj < 2; ++bj) { const f32x4 v0 = acc[ai][bj][m][0] + bv[bj][0], v1 = acc[ai][bj][m][1] + bv[bj][1];
                    v4u w; w.x = cvt_pk_bf16(v0[0], v0[1]); w.y = cvt_pk_bf16(v0[2], v0[3]); w.z = cvt_pk_bf16(v1[0], v1[1]); w.w = cvt_pk_bf16(v1[2], v1[3]);
                    *(v4u*)(rowp + bj * HALF) = w; } }
    }
};
template <int MODE> struct EpiGlu {
    static constexpr bool PERM = true;
    bf16* O; int ldc; const float* bias; int bias_stride, hs;
    __device__ __forceinline__ void operator()(const f32x4 (&acc)[2][2][4][2], const Unit& u, int wr, int wc, int fr, int fq) const {
        const int row0 = u.pm * BM + wr * 64 + fr, col0 = u.pn * HALF + wc * 32 + 8 * fq;
        const float* bp = bias + (size_t)u.e * bias_stride + col0;
        f32x4 ba[2], bb[2];
#pragma unroll
        for (int n = 0; n < 2; ++n) { ba[n] = *(const f32x4*)(bp + 4 * n); bb[n] = *(const f32x4*)(bp + hs + 4 * n); }
#pragma unroll
        for (int ai = 0; ai < 2; ++ai)
#pragma unroll
            for (int m = 0; m < 4; ++m) { bf16* rowp = O + (size_t)(row0 + ai * HALF + m * 16) * ldc + col0;
                float o[8];
#pragma unroll
                for (int n = 0; n < 2; ++n) { const f32x4 a = acc[ai][0][m][n] + ba[n], b = acc[ai][1][m][n] + bb[n];
#pragma unroll
                    for (int j = 0; j < 4; ++j) {
                        if (MODE == 0) o[4 * n + j] = a[j] * sigm(b[j]);
                        else { const float g = fminf(a[j], 7.f), up = fminf(fmaxf(b[j], -7.f), 7.f); o[4 * n + j] = (up + 1.f) * g * sigm(1.702f * g); } } }
                v4u w; w.x = cvt_pk_bf16(o[0], o[1]); w.y = cvt_pk_bf16(o[2], o[3]); w.z = cvt_pk_bf16(o[4], o[5]); w.w = cvt_pk_bf16(o[6], o[7]);
                *(v4u*)rowp = w; }
    }
};
struct EpiMerge {
    static constexpr bool PERM = true;
    bf16* mtmp; bf16* Mo; const bf16* zg;
    __device__ __forceinline__ void operator()(const f32x4 (&acc)[2][2][4][2], const Unit& u, int wr, int wc, int fr, int fq) const {
        const int row0 = u.pm * BM + wr * 64 + fr, col0 = u.pn * BM + wc * 32 + 8 * fq;
#pragma unroll
        for (int ai = 0; ai < 2; ++ai)
#pragma unroll
            for (int m = 0; m < 4; ++m) { const size_t r = (size_t)(row0 + ai * HALF + m * 16);
#pragma unroll
                for (int bj = 0; bj < 2; ++bj) { const int c = col0 + bj * HALF;
                    const v4u gz = *(const v4u*)(zg + r * IN_COLS + u.e * 1024 + c);
                    float g[8] = {bflo(gz.x), bfhi(gz.x), bflo(gz.y), bfhi(gz.y), bflo(gz.z), bfhi(gz.z), bflo(gz.w), bfhi(gz.w)};
                    f32x4 t0, t1; bf16* tp = mtmp + r * 1024 + c;
                    if (u.e == 0) { t0 = (f32x4){0.f, 0.f, 0.f, 0.f}; t1 = t0; } else { const v4u pv = *(const v4u*)tp; t0 = (f32x4){bflo(pv.x), bfhi(pv.x), bflo(pv.y), bfhi(pv.y)}; t1 = (f32x4){bflo(pv.z), bfhi(pv.z), bflo(pv.w), bfhi(pv.w)}; }
#pragma unroll
                    for (int j = 0; j < 4; ++j) { t0[j] += sigm(g[j]) * acc[ai][bj][m][0][j]; t1[j] += sigm(g[4 + j]) * acc[ai][bj][m][1][j]; }
                    if (u.e < 2) { v4u w; w.x = cvt_pk_bf16(t0[0], t0[1]); w.y = cvt_pk_bf16(t0[2], t0[3]); w.z = cvt_pk_bf16(t1[0], t1[1]); w.w = cvt_pk_bf16(t1[2], t1[3]); *(v4u*)tp = w; }
                    else { v4u w; w.x = cvt_pk_bf16(t0[0], t0[1]); w.y = cvt_pk_bf16(t0[2], t0[3]); w.z = cvt_pk_bf16(t1[0], t1[1]); w.w = cvt_pk_bf16(t1[2], t1[3]);
                        *(v4u*)(Mo + r * 1024 + c) = w; } } }
    }
};
struct EpiResid {
    static constexpr bool PERM = false;
    float* X; const float* gmod;
    __device__ __forceinline__ void operator()(const f32x4 (&acc)[2][2][4][2], const Unit& u, int wr, int wc, int fr, int fq) const {
        const int row0 = u.pm * BM + wr * 64 + fr, col0 = u.pn * BM + wc * 32 + 4 * fq;
        const int r00 = u.pm * BM; const int w = r00 < T_LAT ? (r00 >> 12) : 8;
        f32x4 gv[2][2];
#pragma unroll
        for (int bj = 0; bj < 2; ++bj)
#pragma unroll
            for (int n = 0; n < 2; ++n) gv[bj][n] = *(const f32x4*)(gmod + (size_t)w * 6144 + col0 + bj * HALF + n * 16);
#pragma unroll
        for (int ai = 0; ai < 2; ++ai)
#pragma unroll
            for (int m = 0; m < 4; ++m) { float* rowp = X + (size_t)(row0 + ai * HALF + m * 16) * 1024 + col0;
#pragma unroll
                for (int bj = 0; bj < 2; ++bj)
#pragma unroll
                    for (int n = 0; n < 2; ++n) { f32x4* p = (f32x4*)(rowp + bj * HALF + n * 16); *p = *p + gv[bj][n] * acc[ai][bj][m][n]; } }
    }
};
}

struct Args { const float* in[51]; float* out; unsigned char* ws; int ph_lo, ph_hi; };
enum { I_X = 0, I_C, I_CTX, I_CCTX, I_ADAW, I_ADAB, I_N1G, I_N2G, I_WIN, I_HYCW, I_HYCB, I_HYW1, I_HYB1, I_HYF1, I_HYW2, I_HYB2, I_HYF2, I_HYW3, I_HYB3, I_HYBIAS,
       I_RWCW, I_RWCB, I_RWWUP, I_RWW0, I_RWAUP, I_RWA0, I_RWGUP, I_RWKK, I_RWKA, I_RWRK, I_RWLNG, I_RWLNB, I_S5ARE, I_S5AIM, I_S5LDT, I_S5BRE, I_S5BIM, I_S5CRE, I_S5CIM, I_S5D,
       I_S5GLUW, I_S5GLUB, I_WBR, I_WOUT, I_RTW, I_RTB, I_W1, I_B1, I_W2, I_B2, I_FING };

typedef const __attribute__((address_space(4))) Args* CArgsP;
__device__ __forceinline__ CArgsP kargs() { CArgsP p = (CArgsP)__builtin_amdgcn_kernarg_segment_ptr(); asm volatile("" : "+s"(p)); return p; }
__device__ __forceinline__ int opaque(int v) { asm volatile("" : "+s"(v)); return v; }
__device__ __forceinline__ int opaque_v(int v) { asm volatile("" : "+v"(v)); return v; }
struct Ctx { CArgsP a; LAS unsigned char* lds; int tid, lane, wave, bid, G; };

__device__ __forceinline__ void row_seq(int row, int& base, int& pos, int& n) {
    if (row < T_LAT) { base = row & ~(SEQ - 1); pos = row & (SEQ - 1); n = SEQ; }
    else { const int r = row - T_LAT; base = T_LAT + (r & ~(CTXL - 1)); pos = r & (CTXL - 1); n = CTXL; }
}
__device__ __forceinline__ float conv3z(const bf16* zc, int pos, int n, float w0, float w1, float w2, float b) {
    const float zm = pos > 0 ? bf2f(zc[(size_t)(pos - 1) * IN_COLS]) : 0.f, z0 = bf2f(zc[(size_t)pos * IN_COLS]), zp = pos < n - 1 ? bf2f(zc[(size_t)(pos + 1) * IN_COLS]) : 0.f;
    return zm * w0 + z0 * w1 + zp * w2 + b;
}

template <int MODE>
__device__ __forceinline__ void transpose_item(const float* W, int K, int N, bf16* WT, int Hs, LAS float* scr, int item, int lane) {
    const int nblk = N / 32, kb = item / nblk, nb = item % nblk, k0 = 64 * kb, n0 = 32 * nb;
#pragma unroll 8
    for (int i = 0; i < 32; ++i) { const int kk = 2 * i + (lane >> 5); scr[kk * 33 + (lane & 31)] = W[(size_t)(k0 + kk) * N + n0 + (lane & 31)]; }
    LDS_WAIT(); asm volatile("" ::: "memory");
    const int c = lane & 7;
#pragma unroll
    for (int j = 0; j < 4; ++j) { const int n = (lane >> 3) + 8 * j; const LAS float* s = scr + (8 * c) * 33 + n;
        v4u o; o.x = pk2(s[0 * 33], s[1 * 33]); o.y = pk2(s[2 * 33], s[3 * 33]); o.z = pk2(s[4 * 33], s[5 * 33]); o.w = pk2(s[6 * 33], s[7 * 33]);
        int dr = n0 + n;
        if (MODE == 1) { const int nc = n0 + n; const int jx = nc < Hs ? nc : nc - Hs; dr = (jx >> 7) * 256 + (nc < Hs ? 0 : 128) + (jx & 127); }
        *(v4u*)(WT + (size_t)dr * K + k0 + 8 * c) = o; }
    LDS_WAIT(); asm volatile("" ::: "memory");
}

__device__ __forceinline__ void p0_prologue(const Ctx& F) {
    const auto& a = *F.a; unsigned char* ws = a.ws;
    const int gw = F.bid * NWAVES + F.wave, NGW = F.G * NWAVES, lane = F.lane;
    float* X = (float*)(ws + WS_X);
    for (int t = gw; t < SEQ; t += NGW) {
        const float pr = (float)(t >> 6), pc = (float)(t & 63);
        f32x4 pe[4];
#pragma unroll
        for (int j = 0; j < 4; ++j)
#pragma unroll
            for (int e = 0; e < 4; ++e) { const float om = __builtin_amdgcn_exp2f((float)(4 * lane + e) * (-13.287712379549449f / 256.0f)); const float ang = ((j < 2) ? pr : pc) * om; pe[j][e] = (j & 1) ? __cosf(ang) : __sinf(ang); }
#pragma unroll 2
        for (int bb = 0; bb < BATCH; ++bb) { const size_t row = (size_t)bb * SEQ + t;
            const f32x4* xi = (const f32x4*)(a.in[I_X] + row * D) + lane; f32x4* xo = (f32x4*)(X + row * D) + lane;
#pragma unroll
            for (int j = 0; j < 4; ++j) xo[64 * j] = xi[64 * j] + pe[j]; }
    }
    for (int row = T_LAT + gw; row < T_ALL; row += NGW) {
        const f32x4* xi = (const f32x4*)(a.in[I_CTX] + (size_t)(row - T_LAT) * D) + lane; f32x4* xo = (f32x4*)(X + (size_t)row * D) + lane;
#pragma unroll
        for (int j = 0; j < 4; ++j) xo[64 * j] = xi[64 * j];
    }
    {
        LAS float* condl = (LAS float*)F.lds; LAS float* psum = (LAS float*)(F.lds + 40960);
        for (int i = F.tid; i < 9 * 1024; i += NTHREADS) { const int w = i >> 10, k = i & 1023; const float cv = (w < 8) ? a.in[I_C][w * 1024 + k] : a.in[I_CCTX][k]; condl[i] = cv / (1.f + expf(-cv)); }
        __syncthreads();
        float* MOD = (float*)(ws + WS_MOD);
        for (int it = F.bid; it < 2 * 96; it += F.G) {
            const int l = it / 96, cg = it % 96, col = cg * 64 + lane;
            float acc[9];
#pragma unroll
            for (int w = 0; w < 9; ++w) acc[w] = 0.f;
            const float* wp = a.in[I_ADAW] + ((size_t)l * 1024 + F.wave * 128) * 6144 + col;
#pragma unroll 1
            for (int k0 = 0; k0 < 128; k0 += 16) { float wv[16];
#pragma unroll
                for (int k = 0; k < 16; ++k) wv[k] = wp[(size_t)(k0 + k) * 6144];
#pragma unroll
                for (int k = 0; k < 16; ++k)
#pragma unroll
                    for (int w = 0; w < 9; ++w) acc[w] += condl[w * 1024 + F.wave * 128 + k0 + k] * wv[k]; }
#pragma unroll
            for (int w = 0; w < 9; ++w) psum[(F.wave * 9 + w) * 64 + lane] = acc[w];
            __syncthreads();
            if (F.wave == 0) {
#pragma unroll
                for (int w = 0; w < 9; ++w) { float s = 0.f;
#pragma unroll
                    for (int wv = 0; wv < 8; ++wv) s += psum[(wv * 9 + w) * 64 + lane];
                    MOD[(size_t)(l * 9 + w) * 6144 + col] = s + a.in[I_ADAB][l * 6144 + col]; }
            }
            __syncthreads();
        }
    }
    {
        LAS float* scr = (LAS float*)(F.lds + F.wave * 16384);
        constexpr int IT_W1 = 16 * 64, IT_W2 = 16 * 32, IT_WIN = 16 * 216, IT_GLU = 8 * 32, IT_WBR = 8 * 32, IT_WOUT = 16 * 32;
        constexpr int N_W1 = 64 * IT_W1, N_W2 = 64 * IT_W2, N_WIN = 2 * IT_WIN, N_GLU = 2 * IT_GLU, N_WBR = 6 * IT_WBR, N_WOUT = 2 * IT_WOUT;
        constexpr int NITEMS = N_W1 + N_W2 + N_WIN + N_GLU + N_WBR + N_WOUT;
        for (int it = gw; it < NITEMS; it += NGW) {
            int r = it;
            if (r < N_W1) { const int mtx = r / IT_W1, l = mtx >> 5, e = mtx & 31; transpose_item<1>(a.in[I_W1] + (size_t)mtx * 1024 * 2048, 1024, 2048, (bf16*)(ws + WS_WTS + l * WL_STRIDE + WO_W1) + (size_t)e * 2048 * 1024, 1024, scr, r % IT_W1, lane); continue; } r -= N_W1;
            if (r < N_W2) { const int mtx = r / IT_W2, l = mtx >> 5, e = mtx & 31; transpose_item<0>(a.in[I_W2] + (size_t)mtx * 1024 * 1024, 1024, 1024, (bf16*)(ws + WS_WTS + l * WL_STRIDE + WO_W2) + (size_t)e * 1024 * 1024, 0, scr, r % IT_W2, lane); continue; } r -= N_W2;
            if (r < N_WIN) { const int l = r / IT_WIN; transpose_item<0>(a.in[I_WIN] + (size_t)l * 1024 * IN_COLS, 1024, IN_COLS, (bf16*)(ws + WS_WTS + l * WL_STRIDE + WO_WIN), 0, scr, r % IT_WIN, lane); continue; } r -= N_WIN;
            if (r < N_GLU) { const int l = r / IT_GLU; transpose_item<1>(a.in[I_S5GLUW] + (size_t)l * 512 * 1024, 512, 1024, (bf16*)(ws + WS_WTS + l * WL_STRIDE + WO_GLU), 512, scr, r % IT_GLU, lane); continue; } r -= N_GLU;
            if (r < N_WBR) { const int mtx = r / IT_WBR, l = mtx / 3, br = mtx % 3; transpose_item<0>(a.in[I_WBR] + (size_t)mtx * 512 * 1024, 512, 1024, (bf16*)(ws + WS_WTS + l * WL_STRIDE + WO_WBR) + (size_t)br * 1024 * 512, 0, scr, r % IT_WBR, lane); continue; } r -= N_WBR;
            { const int l = r / IT_WOUT; transpose_item<0>(a.in[I_WOUT] + (size_t)l * 1024 * 1024, 1024, 1024, (bf16*)(ws + WS_WTS + l * WL_STRIDE + WO_WOUT), 0, scr, r % IT_WOUT, lane); }
        }
        for (int i = F.bid * NTHREADS + F.tid; i < 2 * 2560 * 256; i += F.G * NTHREADS) {
            const int l = i / (2560 * 256), r = i % (2560 * 256), n = r >> 8, k = r & 255; float v = 0.f;
            if (n < 1024) { if (k < 64) v = a.in[I_RWWUP][(((size_t)l * 2 + (n >> 9)) * 64 + k) * 512 + (n & 511)]; }
            else if (n < 2048) { if (k >= 64 && k < 128) v = a.in[I_RWAUP][(((size_t)l * 2 + ((n - 1024) >> 9)) * 64 + (k - 64)) * 512 + (n & 511)]; }
            else { if (k >= 128) v = a.in[I_RWGUP][((size_t)l * 128 + (k - 128)) * 512 + (n - 2048)]; }
            ((bf16*)(ws + WS_WTS + l * WL_STRIDE + WO_RWCAT))[r] = (bf16)f2bf(v);
        }
    }
    __syncthreads();
    {
        LAS float* feats = (LAS float*)F.lds; LAS float* h1 = feats + 8 * 33; LAS float* h2 = h1 + 8 * 64;
        constexpr int NIT = 2 * (512 + 32);
        for (int it = F.bid; it < NIT; it += F.G) {
            const int l = it / 544, r = it % 544, nsel = r >= 512, n = nsel ? CTXL : SEQ, p0 = (nsel ? r - 512 : r) * 8;
            if (F.tid < 8 * 33) { const int p = F.tid / 33, i = F.tid % 33, pos = p0 + p; float f;
                if (i == 0) f = (float)pos / (float)(n - 1);
                else { const int k = (i - 1) & 15; const float band = 1e-4f + (float)k * ((15.0f - 1e-4f) / 15.0f); const float ang = (6.283185307179586f * (float)pos / (float)n) * band; f = (i <= 16) ? cosf(ang) : -sinf(ang); }
                feats[p * 33 + i] = f; }
            __syncthreads();
            { const int p = F.tid >> 6, j = F.tid & 63; float s = a.in[I_HYB1][l * 64 + j]; const float* w1p = a.in[I_HYW1] + (size_t)l * 33 * 64 + j;
#pragma unroll
                for (int i = 0; i < 33; ++i) s += feats[p * 33 + i] * w1p[i * 64];
                h1[p * 64 + j] = sinf(a.in[I_HYF1][l * 64 + j] * s); }
            __syncthreads();
            { const int p = F.tid >> 6, j = F.tid & 63; float s = a.in[I_HYB2][l * 64 + j];
                const float* w2p = a.in[I_HYW2] + (size_t)l * 64 * 64 + j;
#pragma unroll 16
                for (int i = 0; i < 64; ++i) s += h1[p * 64 + i] * w2p[i * 64];
                h2[p * 64 + j] = sinf(a.in[I_HYF2][l * 64 + j] * s); }
            __syncthreads();
            float acc[4][8];
#pragma unroll
            for (int q = 0; q < 4; ++q)
#pragma unroll
                for (int p = 0; p < 8; ++p) acc[q][p] = 0.f;
            const float* w3 = a.in[I_HYW3] + (size_t)l * 64 * 2048 + F.tid;
#pragma unroll 8
            for (int i = 0; i < 64; ++i) { float wv[4];
#pragma unroll
                for (int q = 0; q < 4; ++q) wv[q] = w3[(size_t)i * 2048 + q * 512];
#pragma unroll
                for (int p = 0; p < 8; ++p) { const float hv = h2[p * 64 + i];
#pragma unroll
                    for (int q = 0; q < 4; ++q) acc[q][p] += hv * wv[q]; } }
            const int c = F.tid; const float dstart = logf(0.01f) / 1.5f, dstop = logf(0.01f) / 0.3f; const float delta = fabsf(dstart + (float)c * ((dstop - dstart) / 511.0f));
            const int RL = nsel ? HY_RLENC : HY_RLEN, off = n + 47; const float rn1 = 1.0f / (float)(n - 1);
            bf16* Rb = (bf16*)(ws + WS_GF + l * GF_STRIDE + (nsel ? GF_CTX : 0));
#pragma unroll
            for (int q = 0; q < 4; ++q) { const int o = q >> 1, side = q & 1; const float b3 = a.in[I_HYB3][l * 2048 + q * 512 + c];
                bf16* Rc = Rb + ((size_t)o * 512 + c) * RL;
#pragma unroll
                for (int p = 0; p < 8; ++p) { const int pos = p0 + p; const float t = (float)pos * rn1; const float val = (acc[q][p] + b3) * __expf(-t * delta);
                    if (side == 0) Rc[off - pos] = (bf16)f2bf(val);
                    else if (pos >= 1) Rc[off + pos] = (bf16)f2bf(val); }
                if (p0 == 0 && side == 0) { for (int m = 0; m < 48; ++m) Rc[m] = 0; for (int m = off + n; m < RL; ++m) Rc[m] = 0; } }
            __syncthreads();
        }
    }
}

__device__ __forceinline__ void stage_norm1(const Ctx& F, int l) {
    const auto& a = *F.a; unsigned char* ws = a.ws; const int lane = F.lane;
    const int gw = F.bid * NWAVES + F.wave, NGW = F.G * NWAVES;
    float* X = (float*)(ws + WS_X); bf16* H = (bf16*)(ws + WS_H); const float* MOD = (const float*)(ws + WS_MOD);
    const bf16* YS = (const bf16*)(ws + WS_XS); const int* POS = (const int*)(ws + WS_POS); const float* GATE = (const float*)(ws + WS_GATE);
    const int nrows = (l == DEPTH) ? T_LAT : T_ALL;
    f32x4 ngv[4];
    { const f32x4* ngp = (l == DEPTH) ? (const f32x4*)a.in[I_FING] + lane : (const f32x4*)(a.in[I_N1G] + l * D) + lane;
#pragma unroll
      for (int j = 0; j < 4; ++j) ngv[j] = ngp[64 * j]; }
    f32x4 vn[4]; v2u ysn[4][4]; int4 pnn = make_int4(0, 0, 0, 0); f32x4 gn = (f32x4){0.f, 0.f, 0.f, 0.f}, gnn = gn;
#pragma unroll
    for (int k = 0; k < 4; ++k)
#pragma unroll
        for (int j = 0; j < 4; ++j) ysn[k][j] = (v2u){0u, 0u};
#define N1_LDYS(p4_) do { const int pk_[4] = {(p4_).x, (p4_).y, (p4_).z, (p4_).w}; _Pragma("unroll") for (int k = 0; k < 4; ++k) { const v2u* yr_ = (const v2u*)(YS + (size_t)pk_[k] * D) + lane; \
        _Pragma("unroll") for (int j = 0; j < 4; ++j) ysn[k][j] = yr_[64 * j]; } } while (0)
    if (gw < nrows) {
#pragma unroll
        for (int j = 0; j < 4; ++j) vn[j] = ((const f32x4*)(X + (size_t)gw * D) + lane)[64 * j];
        if (l > 0) { const int4 p0 = *(const int4*)(POS + gw * 4); gn = *(const f32x4*)(GATE + gw * 4);
            if (gw + NGW < nrows) { pnn = *(const int4*)(POS + (gw + NGW) * 4); gnn = *(const f32x4*)(GATE + (gw + NGW) * 4); }
            N1_LDYS(p0); } }
#pragma unroll 1
    for (int row = gw; row < nrows; row += NGW) {
        const int w = row < T_LAT ? (row >> 12) : 8;
        f32x4* xr = (f32x4*)(X + (size_t)row * D) + lane;
        f32x4 v[4]; v2u ysc[4][4];
#pragma unroll
        for (int j = 0; j < 4; ++j) v[j] = vn[j];
#pragma unroll
        for (int k = 0; k < 4; ++k)
#pragma unroll
            for (int j = 0; j < 4; ++j) ysc[k][j] = ysn[k][j];
        const f32x4 gc = gn; const int4 pnx = pnn; gn = gnn;
        const int rn = row + NGW, rnn = row + 2 * NGW;
        if (rn < nrows) {
#pragma unroll
            for (int j = 0; j < 4; ++j) vn[j] = ((const f32x4*)(X + (size_t)rn * D) + lane)[64 * j];
            if (l > 0) N1_LDYS(pnx); }
        if (l > 0 && rnn < nrows) { pnn = *(const int4*)(POS + rnn * 4); gnn = *(const f32x4*)(GATE + rnn * 4); }
        f32x4 m0[4], m1[4], m2[4];
        if (l < DEPTH) {
#pragma unroll
            for (int j = 0; j < 4; ++j) { m0[j] = ((const f32x4*)(MOD + (size_t)(l * 9 + w) * 6144) + lane)[64 * j]; m1[j] = ((const f32x4*)(MOD + (size_t)(l * 9 + w) * 6144 + 1024) + lane)[64 * j]; } }
        if (l > 0) {
#pragma unroll
            for (int j = 0; j < 4; ++j) m2[j] = ((const f32x4*)(MOD + (size_t)((l - 1) * 9 + w) * 6144 + 5120) + lane)[64 * j];
            f32x4 mo[4];
#pragma unroll
            for (int j = 0; j < 4; ++j) mo[j] = (f32x4){0.f, 0.f, 0.f, 0.f};
#pragma unroll
            for (int k = 0; k < TOPK; ++k) { const float g = gc[k];
#pragma unroll
                for (int j = 0; j < 4; ++j) { const v2u y = ysc[k][j]; mo[j][0] += g * bflo(y.x); mo[j][1] += g * bfhi(y.x); mo[j][2] += g * bflo(y.y); mo[j][3] += g * bfhi(y.y); } }
#pragma unroll
            for (int j = 0; j < 4; ++j) { v[j] = v[j] + m2[j] * mo[j]; xr[64 * j] = v[j]; }
        }
        float ss = 0.f;
#pragma unroll
        for (int j = 0; j < 4; ++j) ss += (v[j][0] * v[j][0] + v[j][1] * v[j][1]) + (v[j][2] * v[j][2] + v[j][3] * v[j][3]);
        const float rstd = __builtin_amdgcn_rsqf(wave_sum(ss) * (1.f / D) + 1e-6f);
        if (l == DEPTH) {
            f32x4* o = (f32x4*)(a.out + (size_t)row * D) + lane;
#pragma unroll
            for (int j = 0; j < 4; ++j) o[64 * j] = v[j] * rstd * ngv[j];
        } else {
            v2u* ho = (v2u*)(H + (size_t)row * D) + lane;
#pragma unroll
            for (int j = 0; j < 4; ++j) { const f32x4 h = v[j] * rstd * ngv[j] * (m1[j] + 1.0f) + m0[j]; v2u o; o.x = pk2(h[0], h[1]); o.y = pk2(h[2], h[3]); ho[64 * j] = o; }
        }
    }
#undef N1_LDYS
}

__device__ __forceinline__ void stage_rw_prep1(const Ctx& F, int l) {
    const auto& a = *F.a; unsigned char* ws = a.ws;
    const bf16* __restrict__ Z = (const bf16*)(ws + WS_Z); bf16* __restrict__ ARW = (bf16*)(ws + WS_ARW);
    const int j = 4 * (F.tid & 63), col = 1536 + j, rq = F.tid >> 6;
    const float* cw = a.in[I_RWCW] + (size_t)l * 3 * 1792;
    const f32x4 w0 = *(const f32x4*)(cw + col), w1 = *(const f32x4*)(cw + 1792 + col), w2 = *(const f32x4*)(cw + 2 * 1792 + col), cb = *(const f32x4*)(a.in[I_RWCB] + l * 1792 + col);
#pragma unroll 4
    for (int row = F.bid * 8 + rq; row < T_ALL; row += F.G * 8) {
        int base, pos, n; row_seq(row, base, pos, n);
        const bf16* zc = Z + (size_t)row * IN_COLS + RW_OFF + col;
        const v2u z0 = *(const v2u*)zc;
        v2u zm = (v2u){0u, 0u}, zp = (v2u){0u, 0u};
        if (pos > 0) zm = *(const v2u*)(zc - IN_COLS);
        if (pos < n - 1) zp = *(const v2u*)(zc + IN_COLS);
        f32x4 v = (f32x4){bflo(zm.x), bfhi(zm.x), bflo(zm.y), bfhi(zm.y)} * w0 + (f32x4){bflo(z0.x), bfhi(z0.x), bflo(z0.y), bfhi(z0.y)} * w1 + (f32x4){bflo(zp.x), bfhi(zp.x), bflo(zp.y), bfhi(zp.y)} * w2 + cb;
#pragma unroll
        for (int e2 = 0; e2 < 4; ++e2) { if (j < 64) v[e2] = tanh_fast(v[e2]); else if (j >= 128) v[e2] = sigm(v[e2]); }
        v2u o; o.x = pk2(v[0], v[1]); o.y = pk2(v[2], v[3]);
        *(v2u*)(ARW + (size_t)row * 256 + j) = o;
    }
}

__device__ __forceinline__ void stage_rw_prep2(const Ctx& F, int l) {
    const auto& a = *F.a; unsigned char* ws = a.ws; const int lane = F.lane;
    const bf16* Z = (const bf16*)(ws + WS_Z); const bf16* P = (const bf16*)(ws + WS_P); bf16* SCN = (bf16*)(ws + WS_SCN);
    const int gw = F.bid * NWAVES + F.wave, NGW = F.G * NWAVES;
    constexpr int TR = 17, NRT = T_ALL / TR;
    const float* cw = a.in[I_RWCW] + (size_t)l * 3 * 1792; const float* cbp = a.in[I_RWCB] + l * 1792;
    for (int tile = gw; tile < NRT * 4; tile += NGW) {
        const int rt = tile % NRT, hp = tile / NRT, row0 = rt * TR, c0 = hp * 128 + 2 * lane;
        f32x2 w[3][3], cb[3];
#pragma unroll
        for (int s = 0; s < 3; ++s) { cb[s] = *(const f32x2*)(cbp + s * 512 + c0);
#pragma unroll
            for (int j = 0; j < 3; ++j) w[s][j] = *(const f32x2*)(cw + j * 1792 + s * 512 + c0); }
        const f32x2 KKw = *(const f32x2*)(a.in[I_RWKK] + l * 512 + c0), KAw = *(const f32x2*)(a.in[I_RWKA] + l * 512 + c0);
        f32x2 W0[2], A0[2];
#pragma unroll
        for (int d = 0; d < 2; ++d) { W0[d] = *(const f32x2*)(a.in[I_RWW0] + (l * 2 + d) * 512 + c0); A0[d] = *(const f32x2*)(a.in[I_RWA0] + (l * 2 + d) * 512 + c0); }
        const unsigned* zb = (const unsigned*)(Z + RW_OFF + c0);
        unsigned zw[8][3], pw_[8][4];
#define P2_LDZ(j_) do { const int rr_ = row0 + (j_); if (rr_ >= 0 && rr_ < T_ALL) { _Pragma("unroll") for (int s = 0; s < 3; ++s) zw[((j_) + 1) & 7][s] = zb[(size_t)rr_ * (IN_COLS / 2) + s * 256]; } \
        else { _Pragma("unroll") for (int s = 0; s < 3; ++s) zw[((j_) + 1) & 7][s] = 0u; } } while (0)
#define P2_LDP(j_) do { const unsigned* pr_ = (const unsigned*)(P + (size_t)(row0 + (j_)) * 2560 + c0); pw_[(j_) & 7][0] = pr_[0]; pw_[(j_) & 7][1] = pr_[512]; pw_[(j_) & 7][2] = pr_[256]; pw_[(j_) & 7][3] = pr_[768]; } while (0)
        P2_LDZ(-1); P2_LDZ(0); P2_LDZ(1); P2_LDZ(2); P2_LDZ(3); P2_LDP(0); P2_LDP(1); P2_LDP(2);
#pragma unroll
        for (int i = 0; i < TR; ++i) {
            const int row = row0 + i; int base, pos, n; row_seq(row, base, pos, n);
            if (i + 4 <= TR) P2_LDZ(i + 4);
            if (i + 3 < TR) P2_LDP(i + 3);
            unsigned zm[3], z0[3], zp[3], pc_[4];
#pragma unroll
            for (int s = 0; s < 3; ++s) { zm[s] = zw[i & 7][s]; z0[s] = zw[(i + 1) & 7][s]; zp[s] = zw[(i + 2) & 7][s]; }
#pragma unroll
            for (int e = 0; e < 4; ++e) pc_[e] = pw_[i & 7][e];
            const float mlo = pos > 0 ? 1.f : 0.f, mhi = pos < n - 1 ? 1.f : 0.f;
            f32x2 u[3];
#pragma unroll
            for (int s = 0; s < 3; ++s) u[s] = (f32x2){bflo(zm[s]), bfhi(zm[s])} * mlo * w[s][0] + (f32x2){bflo(z0[s]), bfhi(z0[s])} * w[s][1] + (f32x2){bflo(zp[s]), bfhi(zp[s])} * mhi * w[s][2] + cb[s];
            const f32x2 r = u[0], k = u[1], v = u[2];
            f32x2 kk = k * KKw;
            const float ss = red32(kk[0] * kk[0] + kk[1] * kk[1]);
            kk = kk * (__builtin_amdgcn_rsqf(fmaxf(ss, 1e-24f)));
            unsigned* o = (unsigned*)(SCN + (size_t)row * 9 * 512 + c0);
            o[0] = pk2(r[0], r[1]); o[256] = pk2(v[0], v[1]); o[2 * 256] = pk2(kk[0], kk[1]);
#pragma unroll
            for (int d = 0; d < 2; ++d) {
                const unsigned pw = pc_[2 * d], pa = pc_[2 * d + 1];
                float ld[2], kd[2], be[2];
#pragma unroll
                for (int e = 0; e < 2; ++e) {
                    const float uu = W0[d][e] + (e ? bfhi(pw) : bflo(pw));
                    ld[e] = -0.60653065971263342f * sigm(uu);
                    const float av = sigm(A0[d][e] + (e ? bfhi(pa) : bflo(pa)));
                    kd[e] = k[e] * (1.f + (av - 1.f) * KAw[e]); be[e] = kk[e] * av; }
                o[(3 + 3 * d) * 256] = pk2(ld[0], ld[1]); o[(4 + 3 * d) * 256] = pk2(kd[0], kd[1]); o[(5 + 3 * d) * 256] = pk2(be[0], be[1]);
            }
        }
    }
}
#undef P2_LDZ
#undef P2_LDP

__device__ __forceinline__ int seq_row(int b, int d, int sidx) {
    if (sidx < CTXL) { const int t = d ? (CTXL - 1 - sidx) : sidx; return T_LAT + b * CTXL + t; }
    const int tl = sidx - CTXL; const int t = d ? (SEQ - 1 - tl) : tl; return b * SEQ + t;
}

constexpr int CW_WORK = 16384;
constexpr int CW_STAMP = 20480;
#ifdef PROBE_T
#ifndef PROBE_BID
#define PROBE_BID 0
#endif
#define PT(k) do { if (F.bid == PROBE_BID && F.tid == 0 && l == 0) ((unsigned long long*)(F.a->ws + WS_CTL + CW_STAMP * 4))[k] = __builtin_amdgcn_s_memrealtime(); } while (0)
#else
#define PT(k) do { } while (0)
#endif
__device__ __forceinline__ void rw_scan_item(const Ctx& F, int l, int it2) {
    const int it = it2 >> 1, half = it2 & 1;
    const auto& a = *F.a; unsigned char* ws = a.ws; const int tid = F.tid, lane = F.lane;
    const bf16* SCN = (const bf16*)(ws + WS_SCN); float* YD = (float*)(ws + WS_YDIR);
    LAS float* sbuf = (LAS float*)F.lds;
    LAS float* ybuf = (LAS float*)(F.lds + 49152);
    const bool comp = F.wave < 4;
    const int lt = tid & 255, ls = lt >> 4, lj = lt & 15;
    const int vl = lane >> 3, kq = lane & 7, vrow = half * 32 + (F.wave & 3) * 8 + vl;
    constexpr int NCH = (CTXL + SEQ) / 16;
    const int d = it & 1, h = (it >> 1) & 7, b = it >> 4;
    f32x2 S[4];
#pragma unroll
    for (int q = 0; q < 4; ++q) S[q] = (f32x2){0.f, 0.f};
    v2u ldr[6];
#define RW_ISSUE(c) do { const int row_ = seq_row(b, d, (c) * 16 + ls); const v2u* p_ = (const v2u*)(SCN + (size_t)row_ * 9 * 512 + h * 64) + lj; \
        ldr[0] = p_[2 * 128]; ldr[1] = p_[(3 + 3 * d) * 128]; ldr[2] = p_[(5 + 3 * d) * 128]; ldr[3] = p_[(4 + 3 * d) * 128]; ldr[4] = p_[0]; ldr[5] = p_[128]; } while (0)
#define RW_WRITE(bufi) do { LAS float* o_ = sbuf + (((bufi) * 16 + ls) * 6) * 64 + 4 * lj; \
        *(LAS f32x4*)(o_) = (f32x4){-bflo(ldr[0].x), -bfhi(ldr[0].x), -bflo(ldr[0].y), -bfhi(ldr[0].y)}; \
        *(LAS f32x4*)(o_ + 64) = (f32x4){__expf(bflo(ldr[1].x)), __expf(bfhi(ldr[1].x)), __expf(bflo(ldr[1].y)), __expf(bfhi(ldr[1].y))}; \
        *(LAS f32x4*)(o_ + 128) = (f32x4){bflo(ldr[2].x), bfhi(ldr[2].x), bflo(ldr[2].y), bfhi(ldr[2].y)}; *(LAS f32x4*)(o_ + 192) = (f32x4){bflo(ldr[3].x), bfhi(ldr[3].x), bflo(ldr[3].y), bfhi(ldr[3].y)}; \
        *(LAS f32x4*)(o_ + 256) = (f32x4){bflo(ldr[4].x), bfhi(ldr[4].x), bflo(ldr[4].y), bfhi(ldr[4].y)}; *(LAS f32x4*)(o_ + 320) = (f32x4){bflo(ldr[5].x), bfhi(ldr[5].x), bflo(ldr[5].y), bfhi(ldr[5].y)}; } while (0)
#define RW_FLUSH(c) do { const int row_ = seq_row(b, d, (c) * 16 + ls); \
        *(f32x2*)(YD + ((size_t)d * T_ALL + row_) * 512 + h * 64 + half * 32 + 2 * lj) = *(const LAS f32x2*)(ybuf + ((((c) & 1) * 16 + ls) * 64) + half * 32 + 2 * lj); } while (0)
    if (!comp) { RW_ISSUE(0); RW_WRITE(0); RW_ISSUE(1); }
    __syncthreads();
#pragma unroll 1
    for (int c = 0; c < NCH; ++c) {
        const int bi = c & 1;
        if (!comp) {
            if (c + 1 < NCH) RW_WRITE(bi ^ 1);
            if (c + 2 < NCH) RW_ISSUE(c + 2);
            if (c > 0) RW_FLUSH(c - 1);
        } else {
        float yv[16];
        f32x4 opA[10], opB[10]; float vvA, vvB;
#define RW_LD(op, vvx, s_) do { const LAS float* sp_ = sbuf + ((bi * 16 + (s_)) * 6) * 64 + 8 * kq; \
            _Pragma("unroll") for (int q_ = 0; q_ < 5; ++q_) { op[2 * q_] = *(const LAS f32x4*)(sp_ + 64 * q_); op[2 * q_ + 1] = *(const LAS f32x4*)(sp_ + 64 * q_ + 4); } \
            vvx = sbuf[((bi * 16 + (s_)) * 6 + 5) * 64 + vrow]; } while (0)
#define RW_COMP(op, vvx, s_) do { \
            const f32x4 a0 = op[0], a1 = op[1], w0 = op[2], w1 = op[3], b0 = op[4], b1 = op[5], k0 = op[6], k1 = op[7], r0 = op[8], r1 = op[9]; \
            const f32x2 vv2 = (f32x2){vvx, vvx}; \
            const f32x2 p0 = S[1] * (f32x2){a0[2], a0[3]} + S[0] * (f32x2){a0[0], a0[1]}; \
            const f32x2 p1 = S[3] * (f32x2){a1[2], a1[3]} + S[2] * (f32x2){a1[0], a1[1]}; \
            const f32x2 t0 = S[0] * (f32x2){w0[0], w0[1]} + vv2 * (f32x2){k0[0], k0[1]}; \
            const f32x2 t1 = S[1] * (f32x2){w0[2], w0[3]} + vv2 * (f32x2){k0[2], k0[3]}; \
            const f32x2 t2 = S[2] * (f32x2){w1[0], w1[1]} + vv2 * (f32x2){k1[0], k1[1]}; \
            const f32x2 t3 = S[3] * (f32x2){w1[2], w1[3]} + vv2 * (f32x2){k1[2], k1[3]}; \
            const f32x2 ac = p0 + p1; \
            const float sa = red8(ac[0] + ac[1]); \
            const f32x2 sa2 = (f32x2){sa, sa}; \
            S[0] = sa2 * (f32x2){b0[0], b0[1]} + t0; S[1] = sa2 * (f32x2){b0[2], b0[3]} + t1; \
            S[2] = sa2 * (f32x2){b1[0], b1[1]} + t2; S[3] = sa2 * (f32x2){b1[2], b1[3]} + t3; \
            const f32x2 q0 = S[1] * (f32x2){r0[2], r0[3]} + S[0] * (f32x2){r0[0], r0[1]}; \
            const f32x2 q1 = S[3] * (f32x2){r1[2], r1[3]} + S[2] * (f32x2){r1[0], r1[1]}; \
            const f32x2 yc = q0 + q1; \
            yv[s_] = red8(yc[0] + yc[1]); } while (0)
        RW_LD(opA, vvA, 0);
#pragma unroll
        for (int s = 0; s < 16; s += 2) {
            RW_LD(opB, vvB, s + 1);
            __builtin_amdgcn_sched_barrier(0);
            RW_COMP(opA, vvA, s);
            __builtin_amdgcn_sched_barrier(0);
            if (s + 2 < 16) RW_LD(opA, vvA, s + 2);
            __builtin_amdgcn_sched_barrier(0);
            RW_COMP(opB, vvB, s + 1);
            __builtin_amdgcn_sched_barrier(0);
        }
#undef RW_LD
#undef RW_COMP
#pragma unroll
        for (int s = 0; s < 16; ++s) if ((s & 7) == kq) ybuf[((bi * 16 + s) * 64) + vrow] = yv[s];
        }
        __syncthreads();
    }
    if (!comp) RW_FLUSH(NCH - 1);
    __syncthreads();
#undef RW_ISSUE
#undef RW_WRITE
#undef RW_FLUSH
}

constexpr size_t WS_RWSCR = WS_YHY;
constexpr int RWS_QY = 0, RWS_YV = 2048, RWS_PZ = 4096, RWS_ZV = 12288, RWS_SLOT = 20480;
typedef __bf16 bf16x8n __attribute__((ext_vector_type(8)));
__device__ __forceinline__ f32x4 mma16(const bf16x8 a, const bf16x8 b, const f32x4 c) { return __builtin_amdgcn_mfma_f32_16x16x32_bf16(a, b, c, 0, 0, 0); }
__device__ __forceinline__ float dpp_shr(float x, const int n) {
    const int v = __builtin_bit_cast(int, x); int r;
    if (n == 1) r = __builtin_amdgcn_update_dpp(0, v, 0x111, 0xF, 0xF, true); else if (n == 2) r = __builtin_amdgcn_update_dpp(0, v, 0x112, 0xF, 0xF, true);
    else if (n == 4) r = __builtin_amdgcn_update_dpp(0, v, 0x114, 0xF, 0xF, true); else r = __builtin_amdgcn_update_dpp(0, v, 0x118, 0xF, 0xF, true);
    return __builtin_bit_cast(float, r);
}
__device__ __forceinline__ v4u pack8(const float (&x)[8]) { v4u o; o.x = pk2(x[0], x[1]); o.y = pk2(x[2], x[3]); o.z = pk2(x[4], x[5]); o.w = pk2(x[6], x[7]); return o; }
__device__ __forceinline__ void unpack8(const v4u u, float (&x)[8]) { x[0] = bflo(u.x); x[1] = bfhi(u.x); x[2] = bflo(u.y); x[3] = bfhi(u.y); x[4] = bflo(u.z); x[5] = bfhi(u.z); x[6] = bflo(u.w); x[7] = bfhi(u.w); }
constexpr int LDS_ZERO16 = 131072 + 3072;
__device__ __forceinline__ bf16x8 frag16z(const LAS bf16* m, int rowbase, int lane, const LAS v4u* z) {
    const LAS v4u* p = (const LAS v4u*)(m + (rowbase + (lane & 15)) * 16 + 8 * (lane >> 4));
    const v4u v = *(((lane >> 4) < 2) ? p : z); return __builtin_bit_cast(bf16x8, v); }
#define frag16(m_, rb_, ln_) frag16z(m_, rb_, ln_, zp16)
__device__ __forceinline__ void st_colmaj(LAS bf16* m, int colbase, const f32x4 d, int lane) {
    v2u o; o.x = pk2(d[0], d[1]); o.y = pk2(d[2], d[3]); *(LAS v2u*)(m + (colbase + (lane & 15)) * 16 + 4 * (lane >> 4)) = o; }
__device__ __forceinline__ void st_rowmaj(LAS bf16* m, const f32x4 d, int lane) {
#pragma unroll
    for (int r = 0; r < 4; ++r) m[(4 * (lane >> 4) + r) * 16 + (lane & 15)] = (bf16)f2bf(d[r]); }
template <int KS0, int KS1>
__device__ __forceinline__ void rw_chunk_load(const Ctx& F, int b, int h, int d, int cidx, v4u (&raw)[12]) {
    const int lane = opaque_v(F.lane), t = lane & 15, kg = lane >> 4;
    const bf16* base = (const bf16*)(F.a->ws + WS_SCN) + (size_t)seq_row(b, d, 16 * cidx + t) * 9 * 512 + h * 64;
#pragma unroll
    for (int ks = KS0; ks < KS1; ++ks) { const int off = 32 * ks + 8 * kg;
        raw[6 * ks + 0] = *(const v4u*)(base + (3 + 3 * d) * 512 + off); raw[6 * ks + 1] = *(const v4u*)(base + 2 * 512 + off); raw[6 * ks + 2] = *(const v4u*)(base + off);
        raw[6 * ks + 3] = *(const v4u*)(base + (5 + 3 * d) * 512 + off); raw[6 * ks + 4] = *(const v4u*)(base + (4 + 3 * d) * 512 + off); raw[6 * ks + 5] = *(const v4u*)(base + 512 + off); }
}
__device__ __forceinline__ void rw_chunk_task(const Ctx& F, const v4u (&raw)[12], LAS unsigned char* wl, unsigned char* slot) {
    const LAS v4u* zp16 = (const LAS v4u*)(F.lds + LDS_ZERO16);
    const int lane = opaque_v(F.lane), t = lane & 15, kg = lane >> 4;
    LAS bf16* ATt = (LAS bf16*)(wl); LAS bf16* RBr = (LAS bf16*)(wl + 2048); LAS bf16* BHt = (LAS bf16*)(wl + 4096); LAS bf16* KHt = (LAS bf16*)(wl + 6144); LAS bf16* VTt = (LAS bf16*)(wl + 8192);
    LAS bf16* WAt = (LAS bf16*)(wl + 10240); LAS bf16* N_r = (LAS bf16*)(wl + 12288); LAS bf16* N_c = (LAS bf16*)(wl + 12800); LAS bf16* T_r = (LAS bf16*)(wl + 13312);
    LAS bf16* AK_r = (LAS bf16*)(wl + 13824); LAS bf16* RB2 = (LAS bf16*)(wl + 14336); LAS bf16* RK_r = (LAS bf16*)(wl + 14848); LAS float* GCl = (LAS float*)(wl + 15360);
    bf16x8 fAb[2], fRb[2], fBb[2], fKb[2];
#pragma unroll
    for (int ks = 0; ks < 2; ++ks) {
        const int off = 32 * ks + 8 * kg;
        float ea[8], er[8], eb[8], eh[8];
        { const v4u uld = raw[6 * ks + 0]; float ld[8]; unpack8(uld, ld);
#pragma unroll
          for (int j = 0; j < 8; ++j) { float c = ld[j]; c += dpp_shr(c, 1); c += dpp_shr(c, 2); c += dpp_shr(c, 4); c += dpp_shr(c, 8);
              const float tot = __builtin_bit_cast(float, __builtin_amdgcn_ds_bpermute((lane | 15) << 2, __builtin_bit_cast(int, c)));
              ea[j] = __expf(c - ld[j]); er[j] = __expf(c); eb[j] = __expf(-c); eh[j] = __expf(tot - c);
              if (t == 0) GCl[off + j] = __expf(tot); } }
        { const v4u u = raw[6 * ks + 1]; float x[8]; unpack8(u, x);
#pragma unroll
          for (int j = 0; j < 8; ++j) { x[j] = -x[j] * ea[j]; ATt[(off + j) * 16 + t] = (bf16)f2bf(x[j]); }
          const v4u p = pack8(x); fAb[ks] = __builtin_bit_cast(bf16x8, p); }
        { const v4u u = raw[6 * ks + 2]; float x[8]; unpack8(u, x);
#pragma unroll
          for (int j = 0; j < 8; ++j) x[j] = x[j] * er[j];
          const v4u p = pack8(x); fRb[ks] = __builtin_bit_cast(bf16x8, p); *(LAS v4u*)(RBr + t * 64 + off) = p; }
        { const v4u u = raw[6 * ks + 3]; float x[8], y[8]; unpack8(u, x);
#pragma unroll
          for (int j = 0; j < 8; ++j) { y[j] = x[j] * eb[j]; BHt[(off + j) * 16 + t] = (bf16)f2bf(x[j] * eh[j]); }
          const v4u p = pack8(y); fBb[ks] = __builtin_bit_cast(bf16x8, p); }
        { const v4u u = raw[6 * ks + 4]; float x[8], y[8]; unpack8(u, x);
#pragma unroll
          for (int j = 0; j < 8; ++j) { y[j] = x[j] * eb[j]; KHt[(off + j) * 16 + t] = (bf16)f2bf(x[j] * eh[j]); }
          const v4u p = pack8(y); fKb[ks] = __builtin_bit_cast(bf16x8, p); }
        { const v4u u = raw[6 * ks + 5];
          const bf16 e0 = (bf16)(u.x & 0xffff), e1 = (bf16)(u.x >> 16), e2 = (bf16)(u.y & 0xffff), e3 = (bf16)(u.y >> 16), e4 = (bf16)(u.z & 0xffff), e5 = (bf16)(u.z >> 16), e6 = (bf16)(u.w & 0xffff), e7 = (bf16)(u.w >> 16);
          VTt[(off + 0) * 16 + t] = e0; VTt[(off + 1) * 16 + t] = e1; VTt[(off + 2) * 16 + t] = e2; VTt[(off + 3) * 16 + t] = e3; VTt[(off + 4) * 16 + t] = e4; VTt[(off + 5) * 16 + t] = e5; VTt[(off + 6) * 16 + t] = e6; VTt[(off + 7) * 16 + t] = e7; }
        __builtin_amdgcn_sched_barrier(0);
    }
    asm volatile("" ::: "memory");
    const f32x4 z4 = (f32x4){0.f, 0.f, 0.f, 0.f};
    f32x4 n0 = mma16(fAb[1], fBb[1], mma16(fAb[0], fBb[0], z4)), aak = mma16(fAb[1], fKb[1], mma16(fAb[0], fKb[0], z4));
    f32x4 arb = mma16(fRb[1], fBb[1], mma16(fRb[0], fBb[0], z4)), ark = mma16(fRb[1], fKb[1], mma16(fRb[0], fKb[0], z4));
#pragma unroll
    for (int r = 0; r < 4; ++r) { const int tt = 4 * kg + r; if (!(t < tt)) { n0[r] = 0.f; aak[r] = 0.f; } if (!(t <= tt)) { arb[r] = 0.f; ark[r] = 0.f; } }
    st_rowmaj(AK_r, aak, lane); st_rowmaj(RB2, arb, lane); st_rowmaj(RK_r, ark, lane); asm volatile("" ::: "memory");
    f32x4 accT = n0;
#pragma unroll
    for (int r = 0; r < 4; ++r) accT[r] += (4 * kg + r == t) ? 1.f : 0.f;
    f32x4 nn = n0;
#pragma unroll
    for (int itn = 0; itn < 3; ++itn) {
        st_rowmaj(N_r, nn, lane); st_colmaj(N_c, 0, nn, lane); st_rowmaj(T_r, accT, lane); asm volatile("" ::: "memory");
        const bf16x8 fa = frag16(N_r, 0, lane), fb = frag16(N_c, 0, lane), ft = frag16(T_r, 0, lane);
        nn = mma16(fa, fb, z4); asm volatile("" ::: "memory");
        st_colmaj(N_c, 0, nn, lane); asm volatile("" ::: "memory");
        const bf16x8 fb2 = frag16(N_c, 0, lane);
        accT = mma16(ft, fb2, accT); asm volatile("" ::: "memory");
    }
    st_rowmaj(T_r, accT, lane); asm volatile("" ::: "memory");
    const bf16x8 fT = frag16(T_r, 0, lane), fAK = frag16(AK_r, 0, lane), fARB = frag16(RB2, 0, lane), fARK = frag16(RK_r, 0, lane);
#pragma unroll
    for (int kt = 0; kt < 4; ++kt) { const f32x4 dd = mma16(fT, frag16(ATt, 16 * kt, lane), z4); st_colmaj(WAt, 16 * kt, dd, lane); } asm volatile("" ::: "memory");
    { const bf16x8 fArbT = frag16(RB2, 0, lane);
#pragma unroll
      for (int kt = 0; kt < 4; ++kt) { const v2u ri = *(const LAS v2u*)(RBr + t * 64 + 16 * kt + 4 * kg);
          f32x4 c0 = (f32x4){bflo(ri.x), bfhi(ri.x), bflo(ri.y), bfhi(ri.y)};
          c0 = mma16(frag16(WAt, 16 * kt, lane), fArbT, c0);
          v2u o; o.x = pk2(c0[0], c0[1]); o.y = pk2(c0[2], c0[3]); *(v2u*)(slot + RWS_QY + (t * 64 + 16 * kt + 4 * kg) * 2) = o; } }
    asm volatile("" ::: "memory");
#pragma unroll
    for (int vt = 0; vt < 4; ++vt) { const f32x4 dd = mma16(fAK, frag16(VTt, 16 * vt, lane), z4); st_colmaj(ATt, 16 * vt, dd, lane); } asm volatile("" ::: "memory");
    asm volatile("" ::: "memory");
    LAS bf16* UVt = RBr;
#pragma unroll
    for (int vt = 0; vt < 4; ++vt) { const f32x4 dd = mma16(fT, frag16(ATt, 16 * vt, lane), z4); st_colmaj(UVt, 16 * vt, dd, lane); } asm volatile("" ::: "memory");
#pragma unroll
    for (int vt = 0; vt < 4; ++vt) { const f32x4 dd = mma16(fARK, frag16(VTt, 16 * vt, lane), mma16(fARB, frag16(UVt, 16 * vt, lane), z4));
        v2u o; o.x = pk2(dd[0], dd[1]); o.y = pk2(dd[2], dd[3]); *(v2u*)(slot + RWS_YV + ((16 * vt + t) * 16 + 4 * kg) * 2) = o; }
#pragma unroll
    for (int ktp = 0; ktp < 4; ++ktp) { const bf16x8 fBh = frag16(BHt, 16 * ktp, lane);
#pragma unroll
        for (int kt = 0; kt < 4; ++kt) { f32x4 dd = mma16(frag16(WAt, 16 * kt, lane), fBh, z4);
            if (kt == ktp) {
#pragma unroll
                for (int r = 0; r < 4; ++r) if (4 * kg + r == t) dd[r] += GCl[16 * kt + t]; }
            v2u o; o.x = pk2(dd[0], dd[1]); o.y = pk2(dd[2], dd[3]); *(v2u*)(slot + RWS_PZ + ((16 * ktp + t) * 64 + 16 * kt + 4 * kg) * 2) = o; } }
#pragma unroll
    for (int vt = 0; vt < 4; ++vt) { const bf16x8 fU = frag16(UVt, 16 * vt, lane), fV = frag16(VTt, 16 * vt, lane);
#pragma unroll
        for (int ktp = 0; ktp < 4; ++ktp) { const f32x4 dd = mma16(frag16(KHt, 16 * ktp, lane), fV, mma16(frag16(BHt, 16 * ktp, lane), fU, z4));
            v2u o; o.x = pk2(dd[0], dd[1]); o.y = pk2(dd[2], dd[3]); *(v2u*)(slot + RWS_ZV + ((16 * vt + t) * 64 + 16 * ktp + 4 * kg) * 2) = o; } }
}
__device__ __forceinline__ void rw_chunk_task2(const Ctx& F, const v4u (&raw)[12], LAS unsigned char* wl, f32x4 (&yv)[4], f32x4 (&zv)[4][4]) {
    const LAS v4u* zp16 = (const LAS v4u*)(F.lds + LDS_ZERO16);
    const int lane = opaque_v(F.lane), t = lane & 15, kg = lane >> 4;
    LAS bf16* ATt = (LAS bf16*)(wl); LAS bf16* RBr = (LAS bf16*)(wl + 2048); LAS bf16* BHt = (LAS bf16*)(wl + 4096); LAS bf16* KHt = (LAS bf16*)(wl + 6144); LAS bf16* VTt = (LAS bf16*)(wl + 8192);
    LAS bf16* WAt = (LAS bf16*)(wl + 10240); LAS bf16* N_r = (LAS bf16*)(wl + 12288); LAS bf16* N_c = (LAS bf16*)(wl + 12800); LAS bf16* T_r = (LAS bf16*)(wl + 13312);
    LAS bf16* AK_r = (LAS bf16*)(wl + 13824); LAS bf16* RB2 = (LAS bf16*)(wl + 14336); LAS bf16* RK_r = (LAS bf16*)(wl + 14848); LAS float* GCl = (LAS float*)(wl + 15360);
    bf16x8 fAb[2], fRb[2], fBb[2], fKb[2];
#pragma unroll
    for (int ks = 0; ks < 2; ++ks) {
        const int off = 32 * ks + 8 * kg;
        float ea[8], er[8], eb[8], eh[8];
        { const v4u uld = raw[6 * ks + 0]; float ld[8]; unpack8(uld, ld);
#pragma unroll
          for (int j = 0; j < 8; ++j) { float c = ld[j]; c += dpp_shr(c, 1); c += dpp_shr(c, 2); c += dpp_shr(c, 4); c += dpp_shr(c, 8);
              const float tot = __builtin_bit_cast(float, __builtin_amdgcn_ds_bpermute((lane | 15) << 2, __builtin_bit_cast(int, c)));
              ea[j] = __expf(c - ld[j]); er[j] = __expf(c); eb[j] = __expf(-c); eh[j] = __expf(tot - c);
              if (t == 0) GCl[off + j] = __expf(tot); } }
        { const v4u u = raw[6 * ks + 1]; float x[8]; unpack8(u, x);
#pragma unroll
          for (int j = 0; j < 8; ++j) { x[j] = -x[j] * ea[j]; ATt[(off + j) * 16 + t] = (bf16)f2bf(x[j]); }
          const v4u p = pack8(x); fAb[ks] = __builtin_bit_cast(bf16x8, p); }
        { const v4u u = raw[6 * ks + 2]; float x[8]; unpack8(u, x);
#pragma unroll
          for (int j = 0; j < 8; ++j) x[j] = x[j] * er[j];
          const v4u p = pack8(x); fRb[ks] = __builtin_bit_cast(bf16x8, p); *(LAS v4u*)(RBr + t * 64 + off) = p; }
        { const v4u u = raw[6 * ks + 3]; float x[8], y[8]; unpack8(u, x);
#pragma unroll
          for (int j = 0; j < 8; ++j) { y[j] = x[j] * eb[j]; BHt[(off + j) * 16 + t] = (bf16)f2bf(x[j] * eh[j]); }
          const v4u p = pack8(y); fBb[ks] = __builtin_bit_cast(bf16x8, p); }
        { const v4u u = raw[6 * ks + 4]; float x[8], y[8]; unpack8(u, x);
#pragma unroll
          for (int j = 0; j < 8; ++j) { y[j] = x[j] * eb[j]; KHt[(off + j) * 16 + t] = (bf16)f2bf(x[j] * eh[j]); }
          const v4u p = pack8(y); fKb[ks] = __builtin_bit_cast(bf16x8, p); }
        { const v4u u = raw[6 * ks + 5];
          const bf16 e0 = (bf16)(u.x & 0xffff), e1 = (bf16)(u.x >> 16), e2 = (bf16)(u.y & 0xffff), e3 = (bf16)(u.y >> 16), e4 = (bf16)(u.z & 0xffff), e5 = (bf16)(u.z >> 16), e6 = (bf16)(u.w & 0xffff), e7 = (bf16)(u.w >> 16);
          VTt[(off + 0) * 16 + t] = e0; VTt[(off + 1) * 16 + t] = e1; VTt[(off + 2) * 16 + t] = e2; VTt[(off + 3) * 16 + t] = e3; VTt[(off + 4) * 16 + t] = e4; VTt[(off + 5) * 16 + t] = e5; VTt[(off + 6) * 16 + t] = e6; VTt[(off + 7) * 16 + t] = e7; }
        __builtin_amdgcn_sched_barrier(0);
    }
    asm volatile("" ::: "memory");
    const f32x4 z4 = (f32x4){0.f, 0.f, 0.f, 0.f};
    f32x4 n0 = mma16(fAb[1], fBb[1], mma16(fAb[0], fBb[0], z4)), aak = mma16(fAb[1], fKb[1], mma16(fAb[0], fKb[0], z4));
    f32x4 arb = mma16(fRb[1], fBb[1], mma16(fRb[0], fBb[0], z4)), ark = mma16(fRb[1], fKb[1], mma16(fRb[0], fKb[0], z4));
#pragma unroll
    for (int r = 0; r < 4; ++r) { const int tt = 4 * kg + r; if (!(t < tt)) { n0[r] = 0.f; aak[r] = 0.f; } if (!(t <= tt)) { arb[r] = 0.f; ark[r] = 0.f; } }
    st_rowmaj(AK_r, aak, lane); st_rowmaj(RB2, arb, lane); st_rowmaj(RK_r, ark, lane); asm volatile("" ::: "memory");
    f32x4 accT = n0;
#pragma unroll
    for (int r = 0; r < 4; ++r) accT[r] += (4 * kg + r == t) ? 1.f : 0.f;
    f32x4 nn = n0;
#pragma unroll
    for (int itn = 0; itn < 3; ++itn) {
        st_rowmaj(N_r, nn, lane); st_colmaj(N_c, 0, nn, lane); st_rowmaj(T_r, accT, lane); asm volatile("" ::: "memory");
        const bf16x8 fa = frag16(N_r, 0, lane), fb = frag16(N_c, 0, lane), ft = frag16(T_r, 0, lane);
        nn = mma16(fa, fb, z4); asm volatile("" ::: "memory");
        st_colmaj(N_c, 0, nn, lane); asm volatile("" ::: "memory");
        const bf16x8 fb2 = frag16(N_c, 0, lane);
        accT = mma16(ft, fb2, accT); asm volatile("" ::: "memory");
    }
    st_rowmaj(T_r, accT, lane); asm volatile("" ::: "memory");
    const bf16x8 fT = frag16(T_r, 0, lane), fAK = frag16(AK_r, 0, lane), fARB = frag16(RB2, 0, lane), fARK = frag16(RK_r, 0, lane);
#pragma unroll
    for (int kt = 0; kt < 4; ++kt) { const f32x4 dd = mma16(fT, frag16(ATt, 16 * kt, lane), z4); st_colmaj(WAt, 16 * kt, dd, lane); } asm volatile("" ::: "memory");
    f32x4 qy[4];
    { const bf16x8 fArbT = frag16(RB2, 0, lane);
#pragma unroll
      for (int kt = 0; kt < 4; ++kt) { const v2u ri = *(const LAS v2u*)(RBr + t * 64 + 16 * kt + 4 * kg);
          qy[kt] = mma16(frag16(WAt, 16 * kt, lane), fArbT, (f32x4){bflo(ri.x), bfhi(ri.x), bflo(ri.y), bfhi(ri.y)}); } }
    asm volatile("" ::: "memory");
#pragma unroll
    for (int vt = 0; vt < 4; ++vt) { const f32x4 dd = mma16(fAK, frag16(VTt, 16 * vt, lane), z4); st_colmaj(ATt, 16 * vt, dd, lane); } asm volatile("" ::: "memory");
    LAS bf16* UVt = RBr;
#pragma unroll
    for (int vt = 0; vt < 4; ++vt) { const f32x4 dd = mma16(fT, frag16(ATt, 16 * vt, lane), z4); st_colmaj(UVt, 16 * vt, dd, lane); } asm volatile("" ::: "memory");
#pragma unroll
    for (int vt = 0; vt < 4; ++vt) { const bf16x8 fU = frag16(UVt, 16 * vt, lane), fV = frag16(VTt, 16 * vt, lane);
        yv[vt] = mma16(fARK, fV, mma16(fARB, fU, z4));
#pragma unroll
        for (int ktp = 0; ktp < 4; ++ktp) zv[vt][ktp] = mma16(frag16(KHt, 16 * ktp, lane), fV, mma16(frag16(BHt, 16 * ktp, lane), fU, z4)); }
    f32x4 pz[4][4];
#pragma unroll
    for (int ktp = 0; ktp < 4; ++ktp) { const bf16x8 fBh = frag16(BHt, 16 * ktp, lane);
#pragma unroll
        for (int kt = 0; kt < 4; ++kt) { f32x4 dd = mma16(frag16(WAt, 16 * kt, lane), fBh, z4);
            if (kt == ktp) {
#pragma unroll
                for (int r = 0; r < 4; ++r) if (4 * kg + r == t) dd[r] += GCl[16 * kt + t]; }
            pz[ktp][kt] = dd; } }
    asm volatile("s_waitcnt lgkmcnt(0)" ::: "memory");
#pragma unroll
    for (int ktp = 0; ktp < 4; ++ktp) { LAS bf16* reg = (LAS bf16*)(wl + (ktp < 2 ? ktp * 2048 : (ktp + 1) * 2048));
#pragma unroll
        for (int kt = 0; kt < 4; ++kt) { v2u o; o.x = pk2(pz[ktp][kt][0], pz[ktp][kt][1]); o.y = pk2(pz[ktp][kt][2], pz[ktp][kt][3]); *(LAS v2u*)(reg + t * 64 + 16 * kt + 4 * kg) = o; } }
#pragma unroll
    for (int kt = 0; kt < 4; ++kt) { v2u o; o.x = pk2(qy[kt][0], qy[kt][1]); o.y = pk2(qy[kt][2], qy[kt][3]); *(LAS v2u*)(BHt + t * 64 + 16 * kt + 4 * kg) = o; }
    asm volatile("s_waitcnt lgkmcnt(0)" ::: "memory");
}
constexpr int RWZ_OFF = LDSCTL_OFF + 8192, RWF_OFF = LDSCTL_OFF + 2048;
__device__ __forceinline__ void rw_chunk_item2(const Ctx& F, int l, int it, size_t yoff = WS_YDIR) {
    const auto& a = *F.a; unsigned char* ws = a.ws; const int lane = opaque_v(F.lane), t = lane & 15, kg = lane >> 4;
    const int d = it & 1, h = (it >> 1) & 7, b = it >> 4;
    float* YD = (float*)(ws + yoff);
    LAS unsigned char* wl = F.lds + F.wave * 15616;
    LAS bf16* ZS = (LAS bf16*)(F.lds + RWZ_OFF);
    volatile LAS int* flag = (volatile LAS int*)(F.lds + RWF_OFF);
    for (int i = F.tid; i < 2048; i += NTHREADS) ((LAS unsigned*)ZS)[i] = 0u;
    if (F.tid == 0) *flag = 0;
    __syncthreads();
    constexpr int NCHK = (CTXL + SEQ) / 16;
    v4u raw[12];
    rw_chunk_load<0, 2>(F, b, h, d, F.wave, raw);
#pragma unroll 1
    for (int c = F.wave; c < NCHK; c += NWAVES) {
        f32x4 yv[4], zv[4][4];
        rw_chunk_task2(F, raw, wl, yv, zv);
        if (c + NWAVES < NCHK) rw_chunk_load<0, 2>(F, b, h, d, c + NWAVES, raw);
        while (*flag < c) __builtin_amdgcn_s_sleep(1);
        asm volatile("" ::: "memory");
        const LAS bf16* Zc = ZS + (c & 1) * 4096; LAS bf16* Zn = ZS + ((c + 1) & 1) * 4096;
        bf16x8 zb[4][2];
#pragma unroll
        for (int vb = 0; vb < 4; ++vb)
#pragma unroll
            for (int ks = 0; ks < 2; ++ks) zb[vb][ks] = *(const LAS bf16x8*)(Zc + (16 * vb + t) * 64 + 32 * ks + 8 * kg);
        { const LAS bf16* Qr = (const LAS bf16*)(wl + 4096); const bf16x8 q0 = *(const LAS bf16x8*)(Qr + t * 64 + 8 * kg), q1 = *(const LAS bf16x8*)(Qr + t * 64 + 32 + 8 * kg);
#pragma unroll
          for (int vb = 0; vb < 4; ++vb) { const f32x4 y = mma16(q1, zb[vb][1], mma16(q0, zb[vb][0], yv[vb]));
#pragma unroll
              for (int r = 0; r < 4; ++r) { const int row = seq_row(b, d, c * 16 + 4 * kg + r); YD[((size_t)d * T_ALL + row) * 512 + h * 64 + 16 * vb + t] = y[r]; } } }
#pragma unroll
        for (int ktp = 0; ktp < 4; ++ktp) { const LAS bf16* Pr = (const LAS bf16*)(wl + (ktp < 2 ? ktp * 2048 : (ktp + 1) * 2048));
            const bf16x8 p0 = *(const LAS bf16x8*)(Pr + t * 64 + 8 * kg), p1 = *(const LAS bf16x8*)(Pr + t * 64 + 32 + 8 * kg);
#pragma unroll
            for (int vb = 0; vb < 4; ++vb) { const f32x4 z = mma16(p1, zb[vb][1], mma16(p0, zb[vb][0], zv[vb][ktp]));
                v2u o; o.x = pk2(z[0], z[1]); o.y = pk2(z[2], z[3]); *(LAS v2u*)(Zn + (16 * vb + t) * 64 + 16 * ktp + 4 * kg) = o; } }
        asm volatile("s_waitcnt lgkmcnt(0)" ::: "memory");
        if (lane == 0) *flag = c + 1;
        asm volatile("s_waitcnt lgkmcnt(0)" ::: "memory");
    }
    __syncthreads();
}
__device__ __forceinline__ v2u ld_sc1_8(const void* p) { const unsigned long long v = __hip_atomic_load((const unsigned long long*)p, __ATOMIC_RELAXED, __HIP_MEMORY_SCOPE_AGENT); v2u o; o.x = (unsigned)v; o.y = (unsigned)(v >> 32); return o; }
__device__ __forceinline__ v4u ld_sc1_16(const void* p) { const v2u a = ld_sc1_8(p), b = ld_sc1_8((const char*)p + 8); return (v4u){a.x, a.y, b.x, b.y}; }
__device__ __forceinline__ void rw_chunk_item(const Ctx& F, int l, int it) {
    const auto& a = *F.a; unsigned char* ws = a.ws; const int lane = F.lane, t = lane & 15, kg = lane >> 4;
    const int d = it & 1, h = (it >> 1) & 7, b = it >> 4;
    float* YD = (float*)(ws + WS_YDIR);
    unsigned char* scr = ws + WS_RWSCR + (size_t)F.bid * 16 * RWS_SLOT;
    LAS unsigned char* wl = F.lds + F.wave * 15616;
    LAS bf16* ZL = (LAS bf16*)(F.lds + LDSCTL_OFF + 4096 + (F.wave & 3) * 2048);
    if (F.wave < 4) { for (int i = lane; i < 512; i += 64) ((LAS unsigned*)ZL)[i] = 0u; }
    asm volatile("" ::: "memory");
    constexpr int NCHK = (CTXL + SEQ) / 16, NB = NCHK / 16;
#pragma unroll 1
    for (int bt = 0; bt < NB; ++bt) {
        { v4u cur[12];
#pragma unroll 1
          for (int jj = 0; jj < 2; ++jj) { rw_chunk_load<0, 2>(F, b, h, d, bt * 16 + F.wave + 8 * jj, cur); rw_chunk_task(F, cur, wl, scr + (size_t)(F.wave + 8 * jj) * RWS_SLOT); } }
        asm volatile("s_waitcnt vmcnt(0)" ::: "memory");
        __syncthreads();
        {
            const int t = opaque_v(lane & 15), kg = opaque_v(lane >> 4), vb = opaque(F.wave) & 3;
            const unsigned char* scrb = F.a->ws + WS_RWSCR + (size_t)opaque(F.bid) * 16 * RWS_SLOT;
            LAS unsigned char* sbuf = F.lds;
            const int lt = opaque_v(F.tid) & 255; const bool loader = F.wave >= 4;
            const int lw = opaque(F.wave) & 3;
#define RWB_ISSUE(j_) do { const unsigned char* gp_ = scrb + (size_t)(j_) * RWS_SLOT + (size_t)(lw * 5) * 1024 + lane * 16; LAS unsigned char* lp_ = sbuf + ((j_) % 6) * RWS_SLOT + (lw * 5) * 1024; \
                _Pragma("unroll") for (int q = 0; q < 5; ++q) __builtin_amdgcn_global_load_lds((const unsigned*)(gp_ + q * 1024), (LAS unsigned*)(lp_ + q * 1024), 16, 0, 16); } while (0)
#define RWB_COMP(bi_, j_) do { const LAS unsigned char* sl_ = sbuf + (bi_) * RWS_SLOT; bf16x8 zb[2], qf[2]; \
                _Pragma("unroll") for (int ks = 0; ks < 2; ++ks) { zb[ks] = *(const LAS bf16x8*)(ZL + t * 64 + 32 * ks + 8 * kg); qf[ks] = *(const LAS bf16x8*)(sl_ + RWS_QY + (t * 64 + 32 * ks + 8 * kg) * 2); } \
                const v2u y_ = *(const LAS v2u*)(sl_ + RWS_YV + ((16 * vb + t) * 16 + 4 * kg) * 2); \
                f32x4 yacc = (f32x4){bflo(y_.x), bfhi(y_.x), bflo(y_.y), bfhi(y_.y)}; \
                yacc = mma16(qf[1], zb[1], mma16(qf[0], zb[0], yacc)); \
                f32x4 zn[4]; \
                _Pragma("unroll") for (int ktp = 0; ktp < 4; ++ktp) { const v2u z_ = *(const LAS v2u*)(sl_ + RWS_ZV + ((16 * vb + t) * 64 + 16 * ktp + 4 * kg) * 2); \
                    f32x4 zc = (f32x4){bflo(z_.x), bfhi(z_.x), bflo(z_.y), bfhi(z_.y)}; \
                    _Pragma("unroll") for (int ks = 0; ks < 2; ++ks) zc = mma16(*(const LAS bf16x8*)(sl_ + RWS_PZ + ((16 * ktp + t) * 64 + 32 * ks + 8 * kg) * 2), zb[ks], zc); \
                    zn[ktp] = zc; } \
                _Pragma("unroll") for (int r = 0; r < 4; ++r) { const int row = seq_row(b, d, (bt * 16 + (j_)) * 16 + 4 * kg + r); YD[((size_t)d * T_ALL + row) * 512 + h * 64 + 16 * vb + t] = yacc[r]; } \
                asm volatile("s_waitcnt lgkmcnt(0)" ::: "memory"); \
                _Pragma("unroll") for (int ktp = 0; ktp < 4; ++ktp) { v2u o; o.x = pk2(zn[ktp][0], zn[ktp][1]); o.y = pk2(zn[ktp][2], zn[ktp][3]); *(LAS v2u*)(ZL + t * 64 + 16 * ktp + 4 * kg) = o; } \
                asm volatile("s_waitcnt lgkmcnt(0)" ::: "memory"); } while (0)
#define RWB_BAR() do { asm volatile("s_waitcnt lgkmcnt(0)" ::: "memory"); __builtin_amdgcn_s_barrier(); asm volatile("" ::: "memory"); } while (0)
            if (loader) { RWB_ISSUE(0); RWB_ISSUE(1); RWB_ISSUE(2); RWB_ISSUE(3); asm volatile("s_waitcnt vmcnt(15)" ::: "memory"); }
            RWB_BAR();
#pragma unroll 1
            for (int j = 0; j < 16; ++j) {
                if (loader) { if (j + 4 < 16) { RWB_ISSUE(j + 4); asm volatile("s_waitcnt vmcnt(15)" ::: "memory"); } else { asm volatile("s_waitcnt vmcnt(0)" ::: "memory"); } }
                else { RWB_COMP(j % 6, j); }
                RWB_BAR();
            }
#undef RWB_BAR
#undef RWB_ISSUE
#undef RWB_COMP
        }
        __syncthreads();
    }
}

__device__ __forceinline__ void stage_rw_readout(const Ctx& F, int l) {
    const auto& a = *F.a; unsigned char* ws = a.ws; const int lane = F.lane;
    const bf16* SCN = (const bf16*)(ws + WS_SCN); const bf16* P = (const bf16*)(ws + WS_P); const float* YD = (const float*)(ws + WS_YDIR); bf16* YRW = (bf16*)(ws + WS_YRW);
    const int gw = F.bid * NWAVES + F.wave, NGW = F.G * NWAVES;
    constexpr int TR = 17, NRT = T_ALL / TR;
    for (int tile = gw; tile < NRT * 4; tile += NGW) {
        const int rt = tile % NRT, hp = tile / NRT, row0 = rt * TR, c0 = hp * 128 + 2 * lane;
        const f32x2 rk = *(const f32x2*)(a.in[I_RWRK] + l * 512 + c0), lng = *(const f32x2*)(a.in[I_RWLNG] + l * 512 + c0), lnb = *(const f32x2*)(a.in[I_RWLNB] + l * 512 + c0);
        unsigned sw_[8][5]; f32x2 yw_[8][2];
#define RO_LD(j_) do { const int rr_ = row0 + (j_); const unsigned* sp_ = (const unsigned*)(SCN + (size_t)rr_ * 9 * 512 + c0); \
        sw_[(j_) & 7][0] = sp_[0]; sw_[(j_) & 7][1] = sp_[256]; sw_[(j_) & 7][2] = sp_[4 * 256]; sw_[(j_) & 7][3] = sp_[7 * 256]; sw_[(j_) & 7][4] = *(const unsigned*)(P + (size_t)rr_ * 2560 + 2048 + c0); \
        yw_[(j_) & 7][0] = *(const f32x2*)(YD + (size_t)rr_ * 512 + c0); yw_[(j_) & 7][1] = *(const f32x2*)(YD + ((size_t)T_ALL + rr_) * 512 + c0); } while (0)
        RO_LD(0); RO_LD(1); RO_LD(2);
#pragma unroll
        for (int i = 0; i < TR; ++i) {
            const int row = row0 + i;
            if (i + 3 < TR) RO_LD(i + 3);
            const unsigned ru = sw_[i & 7][0], vu = sw_[i & 7][1], k0u = sw_[i & 7][2], k1u = sw_[i & 7][3], gu = sw_[i & 7][4];
            const f32x2 y0 = yw_[i & 7][0], y1 = yw_[i & 7][1];
            const float bon = red32(bflo(ru) * (bflo(k0u) + bflo(k1u)) * rk[0] + bfhi(ru) * (bfhi(k0u) + bfhi(k1u)) * rk[1]);
            f32x2 y = y0 + y1 + (f32x2){bflo(vu), bfhi(vu)} * bon;
            const float mu = red32(y[0] + y[1]) * (1.f / 64.f);
            y = y - mu;
            const float var = red32(y[0] * y[0] + y[1] * y[1]) * (1.f / 64.f);
            const f32x2 yn = y * (__builtin_amdgcn_rsqf(var + 64e-5f));
            const f32x2 ov = (yn * lng + lnb) * (f32x2){bflo(gu), bfhi(gu)};
            *(unsigned*)(YRW + (size_t)row * 512 + c0) = pk2(ov[0], ov[1]);
        }
    }
}
#undef RO_LD

constexpr size_t WS_S5E = 6 * MiB;
constexpr int S5_NSEG = 4, S5_SEGLEN = (CTXL + SEQ) / S5_NSEG;
__device__ __forceinline__ void s5_disc(const float are, const float aim, const float dt, float& lbr, float& lbi, float& cr, float& ci) {
    const float mag = expf(are * dt); lbr = mag * cosf(aim * dt); lbi = mag * sinf(aim * dt);
    const float den = are * are + aim * aim, nr = lbr - 1.0f; cr = (nr * are + lbi * aim) / den; ci = (lbi * are - nr * aim) / den;
}
template <int PASS>
__device__ __forceinline__ void stage_s5_scan(const Ctx& F, int l) {
    const auto& a = *F.a; unsigned char* ws = a.ws; const int lane = F.lane;
    const bf16* Z = (const bf16*)(ws + WS_Z); bf16* YP = (bf16*)(ws + WS_YP); f32x2* S5E = (f32x2*)(ws + WS_S5E);
    LAS unsigned char* wl = F.lds + F.wave * 16384;
    LAS float* buL = (LAS float*)wl;
    LAS bf16* Hs = (LAS bf16*)(wl + 8704);
    const int fr = lane & 15, kg = lane >> 4;
    for (int itx = F.bid * NWAVES + F.wave; itx < BATCH * 32 * 2 * S5_NSEG; itx += NWAVES * F.G) {
        const int seg = itx & (S5_NSEG - 1), it = itx >> 2;
        const int d = it & 1, g = (it >> 1) & 31, b = it >> 6, p = lane;
        const float dt = expf(a.in[I_S5LDT][(l * 2 + d) * 32 + g]);
        const float* arep = a.in[I_S5ARE] + ((size_t)(l * 2 + d) * 32 + g) * 64; const float* aimp = a.in[I_S5AIM] + ((size_t)(l * 2 + d) * 32 + g) * 64;
        float lbr, lbi, cr_, ci_; s5_disc(arep[p], aimp[p], dt, lbr, lbi, cr_, ci_);
        bf16x8 afr[2][4];
#pragma unroll
        for (int tl = 0; tl < 4; ++tl) { const int pp = 16 * tl + fr; float r0_, r1_, cr, ci; s5_disc(arep[pp], aimp[pp], dt, r0_, r1_, cr, ci);
            v4u pr = (v4u){0u, 0u, 0u, 0u}, pi = (v4u){0u, 0u, 0u, 0u};
            if (kg < 2) { const float* br = a.in[I_S5BRE] + (((size_t)l * 32 + g) * 64 + pp) * 16 + 8 * kg; const float* bi = a.in[I_S5BIM] + (((size_t)l * 32 + g) * 64 + pp) * 16 + 8 * kg;
                const f32x4 x0 = *(const f32x4*)br, x1 = *(const f32x4*)(br + 4), y0 = *(const f32x4*)bi, y1 = *(const f32x4*)(bi + 4);
                pr.x = pk2(cr * x0[0] - ci * y0[0], cr * x0[1] - ci * y0[1]); pr.y = pk2(cr * x0[2] - ci * y0[2], cr * x0[3] - ci * y0[3]);
                pr.z = pk2(cr * x1[0] - ci * y1[0], cr * x1[1] - ci * y1[1]); pr.w = pk2(cr * x1[2] - ci * y1[2], cr * x1[3] - ci * y1[3]);
                pi.x = pk2(cr * y0[0] + ci * x0[0], cr * y0[1] + ci * x0[1]); pi.y = pk2(cr * y0[2] + ci * x0[2], cr * y0[3] + ci * x0[3]);
                pi.z = pk2(cr * y1[0] + ci * x1[0], cr * y1[1] + ci * x1[1]); pi.w = pk2(cr * y1[2] + ci * x1[2], cr * y1[3] + ci * x1[3]); }
            afr[0][tl] = __builtin_bit_cast(bf16x8, pr); afr[1][tl] = __builtin_bit_cast(bf16x8, pi); }
        bf16x8 cf[4];
        f32x2 hst = (f32x2){0.f, 0.f};
        if (PASS == 1) {
#pragma unroll
            for (int kk = 0; kk < 4; ++kk) { const int p0 = 16 * kk + 4 * kg;
                const f32x4 c0 = *(const f32x4*)(a.in[I_S5CRE] + (((size_t)l * 32 + g) * 16 + fr) * 64 + p0), c1 = *(const f32x4*)(a.in[I_S5CIM] + (((size_t)l * 32 + g) * 16 + fr) * 64 + p0);
                v4u pk; pk.x = pk2(c0[0], -c1[0]); pk.y = pk2(c0[1], -c1[1]); pk.z = pk2(c0[2], -c1[2]); pk.w = pk2(c0[3], -c1[3]);
                cf[kk] = __builtin_bit_cast(bf16x8, pk); }
            float pr_ = lbr, pi_ = lbi, l64r = 1.f, l64i = 0.f;
#pragma unroll 1
            for (int q = 0; q < 10; ++q) { const float nr2 = pr_ * pr_ - pi_ * pi_, ni2 = 2.f * pr_ * pi_; pr_ = nr2; pi_ = ni2; if (q == 5) { l64r = pr_; l64i = pi_; } }
            const float lLr = pr_ * l64r - pi_ * l64i, lLi = pr_ * l64i + pi_ * l64r;
#pragma unroll 1
            for (int sgi = 0; sgi < seg; ++sgi) { const f32x2 ev = S5E[((size_t)it * S5_NSEG + sgi) * 64 + p];
                hst = (f32x2){lLr * hst[0] - lLi * hst[1] + ev[0], lLr * hst[1] + lLi * hst[0] + ev[1]}; }
        }
        const f32x2 lbr2 = (f32x2){lbr, lbr}, lbi2 = (f32x2){lbi, lbi};
        const int sbeg = seg * S5_SEGLEN, send = sbeg + S5_SEGLEN;
        v4u u0 = (v4u){0u, 0u, 0u, 0u}, u1 = u0, u2 = u0, u3 = u0;
#define S5_LOADU(dst_, s0_) do { const int sx_ = ((s0_) < send) ? (s0_) : (send - 16); const int row_ = seq_row(b, d, sx_ + fr); dst_ = *(const v4u*)(Z + (size_t)row_ * IN_COLS + S5_OFF + g * 16 + (kg & 1) * 8); } while (0)
#define S5_CHUNK(ux_, sc_) do { \
            { const v4u um_ = (kg < 2) ? ux_ : (v4u){0u, 0u, 0u, 0u}; const bf16x8 ufr = __builtin_bit_cast(bf16x8, um_); \
              _Pragma("unroll") for (int c = 0; c < 2; ++c) _Pragma("unroll") for (int tl = 0; tl < 4; ++tl) { \
                const f32x4 dd = __builtin_amdgcn_mfma_f32_16x16x32_bf16(afr[c][tl], ufr, (f32x4){0.f, 0.f, 0.f, 0.f}, 0, 0, 0); *(LAS f32x4*)(buL + (c * 16 + fr) * 68 + 16 * tl + 4 * kg) = dd; } } \
            S5_LOADU(ux_, (sc_) + 64); \
            LDS_WAIT(); asm volatile("" ::: "memory"); \
            f32x2 bu[16]; \
            _Pragma("unroll") for (int s = 0; s < 16; ++s) bu[s] = (f32x2){buL[s * 68 + p], buL[(16 + s) * 68 + p]}; \
            _Pragma("unroll") for (int s = 0; s < 16; ++s) { const float tr_ = __builtin_fmaf(-lbi, hst[1], bu[s][0]), ti_ = __builtin_fmaf(lbi, hst[0], bu[s][1]); \
                hst = (f32x2){__builtin_fmaf(lbr, hst[0], tr_), __builtin_fmaf(lbr, hst[1], ti_)}; \
                if (PASS == 1) *(LAS unsigned*)(Hs + s * 136 + 2 * p) = pg8::cvt_pk_bf16(hst[0], hst[1]); } \
            if (PASS == 1) { LDS_WAIT(); asm volatile("" ::: "memory"); \
                f32x4 acc = (f32x4){0.f, 0.f, 0.f, 0.f}; \
                _Pragma("unroll") for (int kk = 0; kk < 4; ++kk) { const bf16x8 af = *(const LAS bf16x8*)(Hs + fr * 136 + 32 * kk + 8 * kg); acc = __builtin_amdgcn_mfma_f32_16x16x32_bf16(af, cf[kk], acc, 0, 0, 0); } \
                _Pragma("unroll") for (int r = 0; r < 4; ++r) { const int row = seq_row(b, d, (sc_) + 4 * kg + r); YP[((size_t)d * T_ALL + row) * 512 + g * 16 + fr] = (bf16)f2bf(acc[r]); } } \
            LDS_WAIT(); asm volatile("" ::: "memory"); } while (0)
        S5_LOADU(u0, sbeg); S5_LOADU(u1, sbeg + 16); S5_LOADU(u2, sbeg + 32); S5_LOADU(u3, sbeg + 48);
#pragma unroll 1
        for (int s0 = sbeg; s0 < send; s0 += 64) { S5_CHUNK(u0, s0); S5_CHUNK(u1, s0 + 16); S5_CHUNK(u2, s0 + 32); S5_CHUNK(u3, s0 + 48); }
#undef S5_CHUNK
        if (PASS == 0) S5E[((size_t)it * S5_NSEG + seg) * 64 + p] = hst;
#undef S5_LOADU
    }
}

__device__ __forceinline__ void stage_s5_prep(const Ctx& F, int l, int nrows) {
    const auto& a = *F.a; unsigned char* ws = a.ws;
    const bf16* __restrict__ Z = (const bf16*)(ws + WS_Z); const bf16* __restrict__ YP = (const bf16*)(ws + WS_YP); bf16* __restrict__ AS5 = (bf16*)(ws + WS_AS5);
    const int c = 4 * (F.tid & 127), rq = F.tid >> 7;
    const f32x4 dsk = *(const f32x4*)(a.in[I_S5D] + l * 512 + c);
#pragma unroll 4
    for (int row = F.bid * 4 + rq; row < nrows; row += F.G * 4) {
        const v2u uz = *(const v2u*)(Z + (size_t)row * IN_COLS + S5_OFF + c);
        const v2u q0 = *(const v2u*)(YP + (size_t)row * 512 + c), q1 = *(const v2u*)(YP + ((size_t)T_ALL + row) * 512 + c);
        const f32x4 y0 = (f32x4){bflo(q0.x), bfhi(q0.x), bflo(q0.y), bfhi(q0.y)}, y1 = (f32x4){bflo(q1.x), bfhi(q1.x), bflo(q1.y), bfhi(q1.y)};
        const f32x4 u = (f32x4){bflo(uz.x), bfhi(uz.x), bflo(uz.y), bfhi(uz.y)};
        const f32x4 y = y0 + y1 + u * dsk;
        float ge[4];
#pragma unroll
        for (int j = 0; j < 4; ++j) ge[j] = 0.5f * y[j] * (1.f + tanh_fast(0.7978845608028654f * (y[j] + 0.044715f * y[j] * y[j] * y[j])));
        v2u o; o.x = pk2(ge[0], ge[1]); o.y = pk2(ge[2], ge[3]);
        *(v2u*)(AS5 + (size_t)row * 512 + c) = o;
    }
}

__device__ __forceinline__ void stage_hy_pre(const Ctx& F, int l, int nrows) {
    const auto& a = *F.a; unsigned char* ws = a.ws; const int lane = F.lane;
    const bf16* Z = (const bf16*)(ws + WS_Z); bf16* UT = (bf16*)(ws + WS_UT);
    LAS unsigned char* tl = F.lds + F.wave * 16384;
    const float* cw = a.in[I_HYCW] + (size_t)l * 3 * 1536; const float* cbp = a.in[I_HYCB] + l * 1536;
    const int gw = F.bid * NWAVES + F.wave, NGW = F.G * NWAVES;
    const int q = lane >> 3, k = lane & 7, ntile = (nrows / 64) * 24;
    v4u v[8], hv;
#define HYPRE_LOAD(tile_) do { const int rt_ = (tile_) / 24, ct_ = (tile_) % 24, row0_ = rt_ * 64; int base_, pos0_, n_; row_seq(row0_, base_, pos0_, n_); \
        const bf16* zt_ = Z + (size_t)row0_ * IN_COLS + HY_OFF + ct_ * 64 + 8 * k; hv = (v4u){0u, 0u, 0u, 0u}; \
        _Pragma("unroll") for (int i = 0; i < 8; ++i) v[i] = *(const v4u*)(zt_ + (size_t)(8 * i + q) * IN_COLS); \
        if (q == 0 && pos0_ > 0) hv = *(const v4u*)(zt_ - (size_t)IN_COLS); \
        if (q == 1 && pos0_ + 64 < n_) hv = *(const v4u*)(zt_ + (size_t)64 * IN_COLS); } while (0)
    if (gw < ntile) HYPRE_LOAD(gw);
#pragma unroll 1
    for (int tile = gw; tile < ntile; tile += NGW) {
        const int rt = tile / 24, ct = tile % 24, row0 = rt * 64, c0 = ct * 64;
        f32x4 wv[8];
#pragma unroll
        for (int i = 0; i < 8; ++i) { const int col = c0 + 8 * i + q; wv[i] = (f32x4){cw[col], cw[1536 + col], cw[2 * 1536 + col], cbp[col]}; }
#pragma unroll
        for (int i = 0; i < 8; ++i) { LAS unsigned* p = (LAS unsigned*)(tl + (1 + 8 * i + q) * 132 + 16 * k); p[0] = v[i].x; p[1] = v[i].y; p[2] = v[i].z; p[3] = v[i].w; }
        if (q < 2) { LAS unsigned* p = (LAS unsigned*)(tl + (q ? 65 : 0) * 132 + 16 * k); p[0] = hv.x; p[1] = hv.y; p[2] = hv.z; p[3] = hv.w; }
        if (tile + NGW < ntile) HYPRE_LOAD(tile + NGW);
        LDS_WAIT(); asm volatile("" ::: "memory");
#pragma unroll 2
        for (int i = 0; i < 8; ++i) {
            const int ch = 8 * i + q, col = c0 + ch;
            const LAS unsigned short* s = (const LAS unsigned short*)(tl + (8 * k) * 132 + ch * 2);
            float z[10];
#pragma unroll
            for (int t = 0; t < 10; ++t) z[t] = __builtin_bit_cast(float, (unsigned)s[t * 66] << 16);
            float o[8];
#pragma unroll
            for (int t = 0; t < 8; ++t) o[t] = wv[i][0] * z[t] + wv[i][1] * z[t + 1] + wv[i][2] * z[t + 2] + wv[i][3];
            v4u w; w.x = pk2(o[0], o[1]); w.y = pk2(o[2], o[3]); w.z = pk2(o[4], o[5]); w.w = pk2(o[6], o[7]);
            *(v4u*)(UT + (size_t)col * T_ALL + row0 + 8 * k) = w;
        }
        LDS_WAIT(); asm volatile("" ::: "memory");
    }
#undef HYPRE_LOAD
}
__device__ __forceinline__ void stage_hy_post(const Ctx& F, int l, int nrows) {
    const auto& a = *F.a; unsigned char* ws = a.ws; const int lane = F.lane;
    const bf16* YT = (const bf16*)(ws + WS_UT) + (size_t)1024 * T_ALL; bf16* YHY = (bf16*)(ws + WS_YHY);
    LAS unsigned char* tl = F.lds + F.wave * 16384;
    const int gw = F.bid * NWAVES + F.wave, NGW = F.G * NWAVES;
    const int q = lane >> 3, k = lane & 7, ntile = (nrows / 64) * 8;
    v4u v[8];
#define HYPOST_LOAD(tile_) do { const bf16* yp_ = YT + (size_t)(((tile_) & 7) * 64 + q) * T_ALL + ((tile_) >> 3) * 64 + 8 * k; \
        _Pragma("unroll") for (int i = 0; i < 8; ++i) v[i] = *(const v4u*)(yp_ + (size_t)(8 * i) * T_ALL); } while (0)
    if (gw < ntile) HYPOST_LOAD(gw);
#pragma unroll 1
    for (int tile = gw; tile < ntile; tile += NGW) {
        const int rt = tile >> 3, ct = tile & 7, row0 = rt * 64, c0 = ct * 64;
#pragma unroll
        for (int i = 0; i < 8; ++i) { LAS unsigned* p = (LAS unsigned*)(tl + (8 * i + q) * 132 + 16 * k); p[0] = v[i].x; p[1] = v[i].y; p[2] = v[i].z; p[3] = v[i].w; }
        if (tile + NGW < ntile) HYPOST_LOAD(tile + NGW);
        LDS_WAIT(); asm volatile("" ::: "memory");
#pragma unroll
        for (int i = 0; i < 8; ++i) { const int r = 8 * i + q;
            const LAS unsigned short* s = (const LAS unsigned short*)(tl + (8 * k) * 132 + r * 2);
            unsigned e[8];
#pragma unroll
            for (int j = 0; j < 8; ++j) e[j] = s[j * 66];
            v4u w; w.x = e[0] | (e[1] << 16); w.y = e[2] | (e[3] << 16); w.z = e[4] | (e[5] << 16); w.w = e[6] | (e[7] << 16);
            *(v4u*)(YHY + (size_t)(row0 + r) * 512 + c0 + 8 * k) = w; }
        LDS_WAIT(); asm volatile("" ::: "memory");
    }
#undef HYPOST_LOAD
}
typedef float f32x16 __attribute__((ext_vector_type(16)));
__device__ __forceinline__ void hyena_item(const Ctx& F, int l, int c, int isctx) {
    const auto& a = *F.a; unsigned char* ws = a.ws; const int tid = F.tid, lane = F.lane;
    const int n = isctx ? CTXL : SEQ, rowbase = isctx ? T_LAT : 0, RL = isctx ? HY_RLENC : HY_RLEN, off = n + 47;
    const bf16* UT = (const bf16*)(ws + WS_UT);
    const bf16* x1g = UT + (size_t)c * T_ALL + rowbase; const bf16* x2g = UT + (size_t)(512 + c) * T_ALL + rowbase; bf16* vg = (bf16*)UT + (size_t)(1024 + c) * T_ALL + rowbase;
    const bf16* Rg = (const bf16*)(ws + WS_GF + l * GF_STRIDE + (isctx ? GF_CTX : 0)) + (size_t)c * RL;
    LAS unsigned char* XB = F.lds; LAS unsigned char* R1 = F.lds + HY_R1_OFF; LAS unsigned char* R2 = F.lds + HY_R2_OFF;
    { const int cpb = n / 8;
      for (int q = tid; q < 8 * cpb; q += NTHREADS) { const int b = q / cpb, ch = q % cpb; *(LAS v4u*)(XB + b * HY_ROWB + 2 * HY_MARG + 16 * ch) = *(const v4u*)(vg + (size_t)b * n + 8 * ch); }
      if (tid < 256) { const int b = tid >> 5, side = (tid >> 4) & 1, ch = tid & 15; const unsigned zz = (unsigned)opaque_v(0); *(LAS v4u*)(XB + b * HY_ROWB + (side ? 2 * (HY_MARG + n) : 0) + 16 * ch) = (v4u){zz, zz, zz, zz}; }
      const int rch = RL / 8;
      for (int q = tid; q < rch; q += NTHREADS) { *(LAS v4u*)(R1 + 16 * q) = *(const v4u*)(Rg + 8 * q); *(LAS v4u*)(R2 + 16 * q) = *(const v4u*)(Rg + (size_t)512 * RL + 8 * q); } }
    __syncthreads();
    const int i = lane & 31, kg = lane >> 5, jb = lane & 3, bb = (lane & 31) >> 2;
    const int rsh = (off - i) & 7, rd = rsh >> 1; const bool s1 = rd & 1, s2 = rd & 2; const unsigned sh = (rsh & 1) ? 16u : 0u;
    const int aconst = 2 * (off - i + 8 * kg - rsh), bconst = bb * HY_ROWB + 2 * (HY_MARG + 32 * jb + 8 * kg);
    const int T0w = 512 * F.wave; const int ntile = (n - T0w) >= 512 ? 4 : ((n - T0w) > 0 ? (n - T0w) / 128 : 0);
    const float bias0 = a.in[I_HYBIAS][(l * 2 + 0) * 512 + c], bias1 = a.in[I_HYBIAS][(l * 2 + 1) * 512 + c];
    f32x16 acc[4];
    v2u y1p[4][4];
#define HY_AFRAG(wa, wb, afr) do { \
        const unsigned a0 = s1 ? wa.y : wa.x, a1 = s1 ? wa.z : wa.y, a2 = s1 ? wa.w : wa.z, a3 = s1 ? wb.x : wa.w, a4 = s1 ? wb.y : wb.x, a5 = s1 ? wb.z : wb.y, a6 = s1 ? wb.w : wb.z; \
        const unsigned b0 = s2 ? a2 : a0, b1 = s2 ? a3 : a1, b2 = s2 ? a4 : a2, b3 = s2 ? a5 : a3, b4 = s2 ? a6 : a4; \
        v4u af_; af_.x = __builtin_amdgcn_alignbit(b1, b0, sh); af_.y = __builtin_amdgcn_alignbit(b2, b1, sh); af_.z = __builtin_amdgcn_alignbit(b3, b2, sh); af_.w = __builtin_amdgcn_alignbit(b4, b3, sh); \
        afr = __builtin_bit_cast(bf16x8, af_); } while (0)
#define HY_STEP_COND(RB, d) do { \
        const v4u wa = *(const LAS v4u*)((RB) + aconst - 2 * (d)), wb = *(const LAS v4u*)((RB) + aconst - 2 * (d) + 16); bf16x8 afr; HY_AFRAG(wa, wb, afr); \
        _Pragma("unroll") for (int m = 0; m < 4; ++m) { const int T0 = T0w + 128 * m; \
            if (m < ntile && (d) >= T0 - n + 16 && (d) <= T0 + 96) { const bf16x8 bfr = *(const LAS bf16x8*)(XB + bconst + 2 * (T0 - (d))); \
                acc[m] = __builtin_amdgcn_mfma_f32_32x32x16_bf16(afr, bfr, acc[m], 0, 0, 0); } } } while (0)
#define HY_LOAD(RB, d, wa, wb, bq) do { wa = *(const LAS v4u*)((RB) + aconst - 2 * (d)); wb = *(const LAS v4u*)((RB) + aconst - 2 * (d) + 16); \
        _Pragma("unroll") for (int m = 0; m < 4; ++m) bq[m] = *(const LAS bf16x8*)(XB + bconst + 2 * (T0w + 128 * m - (d))); } while (0)
#define HY_MMA(wa, wb, bq) do { bf16x8 afr; HY_AFRAG(wa, wb, afr); \
        _Pragma("unroll") for (int m = 0; m < 4; ++m) acc[m] = __builtin_amdgcn_mfma_f32_32x32x16_bf16(afr, bq[m], acc[m], 0, 0, 0); } while (0)
#define HY_CONV(RB) do { \
        _Pragma("unroll") for (int m = 0; m < 4; ++m) _Pragma("unroll") for (int e = 0; e < 16; ++e) acc[m][e] = 0.f; \
        if (ntile == 4) { \
            const int dA = T0w - n + 16, dB = T0w + 384 - n + 16, dC = T0w + 96, dD = T0w + 384 + 96;     \
            _Pragma("unroll 1") for (int d = dA; d < dB; d += 16) HY_STEP_COND(RB, d); \
            { v4u waA, wbA, waB, wbB; bf16x8 bqA[4], bqB[4]; \
              HY_LOAD(RB, dB, waA, wbA, bqA); \
              _Pragma("unroll 1") for (int d = dB; d <= dC; d += 32) { \
                  if (d + 16 <= dC) HY_LOAD(RB, d + 16, waB, wbB, bqB); \
                  __builtin_amdgcn_sched_barrier(0); \
                  HY_MMA(waA, wbA, bqA); \
                  __builtin_amdgcn_sched_barrier(0); \
                  if (d + 32 <= dC) HY_LOAD(RB, d + 32, waA, wbA, bqA); \
                  __builtin_amdgcn_sched_barrier(0); \
                  if (d + 16 <= dC) HY_MMA(waB, wbB, bqB); \
                  __builtin_amdgcn_sched_barrier(0); } } \
            _Pragma("unroll 1") for (int d = dC + 16; d <= dD; d += 16) HY_STEP_COND(RB, d); \
        } else if (ntile > 0) { const int dhi = T0w + 128 * (ntile - 1) + 96; \
            _Pragma("unroll 1") for (int d = T0w - n + 16; d <= dhi; d += 16) HY_STEP_COND(RB, d); } } while (0)
    HY_CONV(R1);
#pragma unroll
    for (int m = 0; m < 4; ++m) if (m < ntile) {
#pragma unroll
        for (int rg = 0; rg < 4; ++rg) { const int t4 = T0w + 128 * m + 32 * jb + 8 * rg + 4 * kg;
            const v2u xv = *(const v2u*)(x1g + (size_t)bb * n + t4); const v2u vv = *(const LAS v2u*)(XB + bb * HY_ROWB + 2 * (HY_MARG + t4));
            const float y0 = bflo(xv.x) * (acc[m][4 * rg + 0] + bias0 * bflo(vv.x)), y1 = bfhi(xv.x) * (acc[m][4 * rg + 1] + bias0 * bfhi(vv.x));
            const float y2 = bflo(xv.y) * (acc[m][4 * rg + 2] + bias0 * bflo(vv.y)), y3 = bfhi(xv.y) * (acc[m][4 * rg + 3] + bias0 * bfhi(vv.y));
            y1p[m][rg].x = pk2(y0, y1); y1p[m][rg].y = pk2(y2, y3); } }
    __syncthreads();
#pragma unroll
    for (int m = 0; m < 4; ++m) if (m < ntile) {
#pragma unroll
        for (int rg = 0; rg < 4; ++rg) { const int t4 = T0w + 128 * m + 32 * jb + 8 * rg + 4 * kg; *(LAS v2u*)(XB + bb * HY_ROWB + 2 * (HY_MARG + t4)) = y1p[m][rg]; } }
    __syncthreads();
    HY_CONV(R2);
#pragma unroll
    for (int m = 0; m < 4; ++m) if (m < ntile) {
#pragma unroll
        for (int rg = 0; rg < 4; ++rg) { const int t4 = T0w + 128 * m + 32 * jb + 8 * rg + 4 * kg;
            const v2u xv = *(const v2u*)(x2g + (size_t)bb * n + t4); const v2u yv = y1p[m][rg];
            const float o0 = bflo(xv.x) * (acc[m][4 * rg + 0] + bias1 * bflo(yv.x)), o1 = bfhi(xv.x) * (acc[m][4 * rg + 1] + bias1 * bfhi(yv.x));
            const float o2 = bflo(xv.y) * (acc[m][4 * rg + 2] + bias1 * bflo(yv.y)), o3 = bfhi(xv.y) * (acc[m][4 * rg + 3] + bias1 * bfhi(yv.y));
            v2u ov; ov.x = pk2(o0, o1); ov.y = pk2(o2, o3); *(v2u*)(vg + (size_t)bb * n + t4) = ov; } }
    __syncthreads();
#undef HY_CONV
#undef HY_AFRAG
#undef HY_STEP_COND
#undef HY_LOAD
#undef HY_MMA
}
__device__ __forceinline__ void stage_mixer(const Ctx& F, int l) {
    unsigned* ctr = (unsigned*)(F.a->ws + WS_CTL) + CW_WORK + 64 * l;
    LAS int* itb = (LAS int*)(F.lds + LDSCTL_OFF + 512);
    const int nit = 128 + 512 + (l == 0 ? 512 : 0);
#ifdef PROBE_STATIC
    return;
#endif
    for (;;) {
        if (F.tid == 0) *itb = (int)__hip_atomic_fetch_add(ctr, 1u, __ATOMIC_RELAXED, __HIP_MEMORY_SCOPE_AGENT);
        __syncthreads();
        const int it = *itb;
        __syncthreads();
        if (it >= nit) break;
        Ctx Fi; Fi.a = kargs(); Fi.tid = opaque_v((int)threadIdx.x); Fi.lane = Fi.tid & 63; Fi.wave = __builtin_amdgcn_readfirstlane(Fi.tid >> 6); Fi.bid = opaque((int)blockIdx.x); Fi.G = opaque((int)gridDim.x);
        Fi.lds = (LAS unsigned char*)((LAS unsigned char*)0 + opaque(0)) + (F.lds - (LAS unsigned char*)0);
#ifdef PROBE_T
        if (l == 0 && F.tid == 0 && it == 5) ((unsigned long long*)(F.a->ws + WS_CTL + CW_STAMP * 4))[21] = __builtin_amdgcn_s_memrealtime();
        if (l == 0 && F.tid == 0 && it == 300) ((unsigned long long*)(F.a->ws + WS_CTL + CW_STAMP * 4))[23] = __builtin_amdgcn_s_memrealtime();
#endif
        if (it < 128) { for (int rep = 0; rep < ((DUPK == 9) ? 2 : 1); ++rep) rw_chunk_item2(Fi, opaque(l), it); }
        else if (it < 640) hyena_item(Fi, opaque(l), it - 128, 0);
        else hyena_item(Fi, opaque(l), it - 640, 1);
#ifdef PROBE_T
        if (l == 0 && F.tid == 0 && it == 5) ((unsigned long long*)(F.a->ws + WS_CTL + CW_STAMP * 4))[22] = __builtin_amdgcn_s_memrealtime();
        if (l == 0 && F.tid == 0 && it == 300) ((unsigned long long*)(F.a->ws + WS_CTL + CW_STAMP * 4))[24] = __builtin_amdgcn_s_memrealtime();
#endif
    }
}

typedef float f32x16r __attribute__((ext_vector_type(16)));
__device__ __forceinline__ void stage_norm2_router(const Ctx& F, int l, int nrows) {
    const auto& a = *F.a; unsigned char* ws = a.ws; const int lane = F.lane;
    const float* X = (const float*)(ws + WS_X); bf16* H = (bf16*)(ws + WS_H); const float* MOD = (const float*)(ws + WS_MOD);
    int* EIDX = (int*)(ws + WS_EIDX); float* GATE = (float*)(ws + WS_GATE); int* POS = (int*)(ws + WS_POS); unsigned* ROWOF = (unsigned*)(ws + WS_ROWOF);
    LAS int* lex = (LAS int*)(F.lds + 40960); LAS int* lrk = lex + 2048; LAS int* offl = lrk + 2048;
    LAS float* lg = (LAS float*)(F.lds + F.wave * 4352);
    LAS int* hist = (LAS int*)(F.lds + LDSCTL_OFF + 1024);
    if (F.tid < 32) hist[F.tid] = 0;
    __syncthreads();
    const int rpb = (nrows + F.G - 1) / F.G, r0 = F.bid * rpb, r1 = (r0 + rpb < nrows) ? r0 + rpb : nrows;
    const float* rw = a.in[I_RTW] + (size_t)l * 1024 * 32;
    const int i = lane & 31, kk = lane >> 5;
    const f32x4* ng = (const f32x4*)(a.in[I_N2G] + l * D) + kk;
    for (int rb = r0 + F.wave * 32; rb < r1; rb += NWAVES * 32) {
        const int nrow = (r1 - rb) < 32 ? (r1 - rb) : 32; const bool live = i < nrow;
        const int row = live ? rb + i : r1 - 1; const int w = row < T_LAT ? (row >> 12) : 8;
        const f32x4* xr = (const f32x4*)(X + (size_t)row * D) + kk;
        float ss = 0.f;
#pragma unroll 16
        for (int q = 0; q < 128; ++q) { const f32x4 v = xr[2 * q]; ss += (v[0] * v[0] + v[1] * v[1]) + (v[2] * v[2] + v[3] * v[3]); }
        ss += __builtin_bit_cast(float, __builtin_amdgcn_ds_bpermute((lane ^ 32) << 2, __builtin_bit_cast(int, ss)));
        const float rstd = __builtin_amdgcn_rsqf(ss * (1.f / D) + 1e-6f);
        const f32x4* sh = (const f32x4*)(MOD + (size_t)(l * 9 + w) * 6144 + 3072) + kk; const f32x4* sc = (const f32x4*)(MOD + (size_t)(l * 9 + w) * 6144 + 4096) + kk;
        v2u* ho = (v2u*)(H + (size_t)row * D) + kk;
        f32x16r acc;
#pragma unroll
        for (int e = 0; e < 16; ++e) acc[e] = 0.f;
        const float* wp = rw + (size_t)(4 * kk) * 32 + i;
        f32x4 xn[4], gn_[4], cn_[4], sn_[4], wn_[4];
#define RT_LOAD(q0_) do { _Pragma("unroll") for (int u_ = 0; u_ < 4; ++u_) { const int q_ = (q0_) + u_; xn[u_] = xr[2 * q_]; gn_[u_] = ng[2 * q_]; cn_[u_] = sc[2 * q_]; sn_[u_] = sh[2 * q_]; \
            wn_[u_] = (f32x4){wp[(size_t)(8 * q_) * 32], wp[(size_t)(8 * q_ + 1) * 32], wp[(size_t)(8 * q_ + 2) * 32], wp[(size_t)(8 * q_ + 3) * 32]}; } } while (0)
        RT_LOAD(0);
#pragma unroll 1
        for (int q0 = 0; q0 < 128; q0 += 4) {
            f32x4 xc[4], gc_[4], cc_[4], sc_[4], wc_[4];
#pragma unroll
            for (int u = 0; u < 4; ++u) { xc[u] = xn[u]; gc_[u] = gn_[u]; cc_[u] = cn_[u]; sc_[u] = sn_[u]; wc_[u] = wn_[u]; }
            if (q0 + 4 < 128) RT_LOAD(q0 + 4);
#pragma unroll
            for (int u = 0; u < 4; ++u) { const int q = q0 + u;
                const f32x4 h4 = xc[u] * rstd * gc_[u] * (cc_[u] + 1.0f) + sc_[u];
                if (live) { v2u o; o.x = pk2(h4[0], h4[1]); o.y = pk2(h4[2], h4[3]); ho[2 * q] = o; }
                acc = __builtin_amdgcn_mfma_f32_32x32x2f32(h4[0], wc_[u][0], acc, 0, 0, 0);
                acc = __builtin_amdgcn_mfma_f32_32x32x2f32(h4[1], wc_[u][1], acc, 0, 0, 0);
                acc = __builtin_amdgcn_mfma_f32_32x32x2f32(h4[2], wc_[u][2], acc, 0, 0, 0);
                acc = __builtin_amdgcn_mfma_f32_32x32x2f32(h4[3], wc_[u][3], acc, 0, 0, 0); }
        }
#undef RT_LOAD
        const float rbias = a.in[I_RTB][l * 32 + i];
#pragma unroll
        for (int r = 0; r < 16; ++r) { const int ri = (r & 3) + 8 * (r >> 2) + 4 * kk; lg[ri * 33 + i] = acc[r] + rbias; }
        LDS_WAIT(); asm volatile("" ::: "memory");
        if (lane < nrow) {
            LAS float* lr = lg + lane * 33; const int orow = rb + lane;
            float tv[4]; int ti[4];
#pragma unroll
            for (int r = 0; r < 4; ++r) { float bv = -INFINITY; int bi = 0;
#pragma unroll 8
                for (int e = 0; e < 32; ++e) { const float v = lr[e]; if (v > bv) { bv = v; bi = e; } }
                tv[r] = bv; ti[r] = bi; lr[bi] = -INFINITY; }
            const float e1 = expf(tv[1] - tv[0]), e2 = expf(tv[2] - tv[0]), e3 = expf(tv[3] - tv[0]); const float inv = 1.0f / (1.0f + e1 + e2 + e3);
            *(int4*)(EIDX + orow * 4) = make_int4(ti[0], ti[1], ti[2], ti[3]); *(f32x4*)(GATE + orow * 4) = (f32x4){inv, e1 * inv, e2 * inv, e3 * inv};
#pragma unroll
            for (int r = 0; r < 4; ++r) { const int rk = __hip_atomic_fetch_add(&hist[ti[r]], 1, __ATOMIC_RELAXED, __HIP_MEMORY_SCOPE_WORKGROUP); lex[(orow - r0) * 4 + r] = ti[r]; lrk[(orow - r0) * 4 + r] = rk; }
        }
        LDS_WAIT(); asm volatile("" ::: "memory");
    }
    __syncthreads();
    if (F.tid < 32) { const int c = hist[F.tid]; offl[F.tid] = c ? (int)__hip_atomic_fetch_add((unsigned*)(ws + WS_CTL) + CW_CNT + 64 * l + F.tid, (unsigned)c, __ATOMIC_RELAXED, __HIP_MEMORY_SCOPE_AGENT) : 0; }
    __syncthreads();
    for (int i = F.tid; i < (r1 > r0 ? (r1 - r0) * 4 : 0); i += NTHREADS) { const int e = lex[i], pos = offl[e] + lrk[i];
        POS[r0 * 4 + i] = pos; ROWOF[(size_t)e * pg8::MOE_CAP + pos] = (unsigned)(r0 + (i >> 2)) * (unsigned)(D * 2); }
    __syncthreads();
}

__device__ __forceinline__ LAS int* load_moe_base(const Ctx& F, int l) {
    LAS int* base = (LAS int*)(F.lds + LDSCTL_OFF + 256);
    if (F.tid < 32) base[64 + F.tid] = (int)__hip_atomic_load((unsigned*)(F.a->ws + WS_CTL) + CW_CNT + 64 * l + F.tid, __ATOMIC_RELAXED, __HIP_MEMORY_SCOPE_AGENT);
    __syncthreads();
    if (F.tid == 0) { int acc = 0; for (int e = 0; e < 32; ++e) { base[e] = acc; acc += (base[64 + e] + 255) & ~255; } base[32] = acc; }
    __syncthreads();
    return base;
}
__device__ __forceinline__ void moe_fix_pos(const Ctx& F, int nrows, const LAS int* base) {
    unsigned char* ws = F.a->ws; const int* EIDX = (const int*)(ws + WS_EIDX); int* POS = (int*)(ws + WS_POS);
    const int rpb = (nrows + F.G - 1) / F.G, r0 = F.bid * rpb, r1 = (r0 + rpb < nrows) ? r0 + rpb : nrows;
    for (int i = F.tid; i < (r1 > r0 ? (r1 - r0) * 4 : 0); i += NTHREADS) POS[r0 * 4 + i] += base[EIDX[r0 * 4 + i]];
}

constexpr int NSTAGE_L = 12, NSTAGES = 1 + DEPTH * NSTAGE_L + 1;
__global__ void __launch_bounds__(NTHREADS, 2) mk_fwd(Args args) {
    extern __shared__ __attribute__((aligned(16))) unsigned char lds_raw[];
    Ctx F; F.a = kargs(); F.lds = (LAS unsigned char*)lds_raw; F.tid = threadIdx.x; F.lane = F.tid & 63; F.wave = __builtin_amdgcn_readfirstlane(F.tid >> 6); F.bid = blockIdx.x; F.G = gridDim.x;
    volatile LAS unsigned* MISC = (volatile LAS unsigned*)(F.lds + LDSCTL_OFF);
    for (int u = F.tid; u < (LDS_BYTES - LDSCTL_OFF) / 4; u += NTHREADS) ((LAS unsigned*)(F.lds + LDSCTL_OFF))[u] = 0u;
    __syncthreads();
#if MK_PER_STAGE
#define GRID_BAR() do { } while (0)
#else
    (void)xcd_barrier_post((unsigned*)(F.a->ws + WS_CTL) + CW_BAR, MISC + 8);
#define GRID_BAR() do { XcdBarrier b_; b_.bar = (unsigned*)(kargs()->ws + WS_CTL) + CW_BAR; b_.x = xb_xcc_id(); b_.st = (volatile LAS unsigned*)((LAS unsigned char*)lds_raw + LDSCTL_OFF + opaque(32)); xcd_barrier(b_); } while (0)
#endif
#ifndef ONLY_S
#define ONLY_S -1
#endif
#define STG_SEL(k) (ONLY_S < 0 || ONLY_S == (((k) == 0) ? 0 : ((k) == NSTAGES - 1 ? 14 : (((k) - 1) % NSTAGE_L) + 1)))
#if MK_PER_STAGE
#define IN(k) (STG_SEL(k) && kargs()->ph_lo == (k))
#else
#define IN(k) STG_SEL(k)
#endif
#if MK_PER_STAGE
#define SEAM(k) do { } while (0)
#else
#define SEAM(k) do { if ((k) + 1 < NSTAGES) GRID_BAR(); } while (0)
#endif
#define STAGE(k) if (IN(k)) { F.a = kargs(); F.tid = opaque_v((int)threadIdx.x); F.lane = F.tid & 63; F.wave = __builtin_amdgcn_readfirstlane(F.tid >> 6); F.bid = opaque((int)blockIdx.x); F.G = opaque((int)gridDim.x); F.lds = (LAS unsigned char*)lds_raw + opaque(0); unsigned char* ws = F.a->ws; const int l = opaque(lq); unsigned char* wl = ws + WS_WTS + (size_t)l * WL_STRIDE; (void)wl; (void)ws;
#define STAGE_END(k) } SEAM(k);
    int lq = 0;
    STAGE(0) p0_prologue(F); STAGE_END(0)
    for (lq = 0; lq < DEPTH; ++lq) {
        const int sb = 1 + lq * NSTAGE_L;
        const int nrl = opaque((lq == DEPTH - 1) ? T_LAT : T_ALL);
        STAGE(sb + 0) stage_norm1(F, l); STAGE_END(sb + 0)
        STAGE(sb + 1) pg8::SchedWin S; S.A = (const char*)(ws + WS_H); S.Bt = (const char*)(wl + WO_WIN); S.tstep = (size_t)256 * 1024 * 2; S.G = F.G; S.c = F.bid; S.part = (nrl != T_ALL); pg8::EpiBf16 E{(bf16*)(ws + WS_Z), IN_COLS, nullptr, 0};
            pg8::gemm_phase(F.lds, F.tid, 1024, S, E); STAGE_END(sb + 1)
        STAGE(sb + 2) for (int rep = 0; rep < REPN(1); ++rep) stage_rw_prep1(F, l); for (int rep = 0; rep < REPN(2); ++rep) stage_s5_scan<0>(F, l); for (int rep = 0; rep < REPN(3); ++rep) stage_hy_pre(F, l, nrl); STAGE_END(sb + 2)
        STAGE(sb + 3) { pg8::SchedStatic S; S.init(ws + WS_ARW, wl + WO_RWCAT, T_ALL, 2560, 256, F.G, F.bid); pg8::EpiBf16 E{(bf16*)(ws + WS_P), 2560, nullptr, 0}; PT(4); pg8::gemm_phase(F.lds, F.tid, 256, S, E); PT(5); }
            F.tid = opaque_v((int)threadIdx.x); F.lane = F.tid & 63;
            for (int rep = 0; rep < REPN(4); ++rep) stage_s5_scan<1>(F, l); STAGE_END(sb + 3)
        STAGE(sb + 4) for (int rep = 0; rep < REPN(5); ++rep) stage_rw_prep2(F, l); for (int rep = 0; rep < REPN(6); ++rep) stage_s5_prep(F, l, nrl); STAGE_END(sb + 4)
        STAGE(sb + 5) PT(10); stage_mixer(F, l); PT(11); STAGE_END(sb + 5) STAGE(sb + 5) PT(12); }
        STAGE(sb + 6) { pg8::SchedStatic S; S.init(ws + WS_AS5, wl + WO_GLU, nrl, 1024, 512, F.G, F.bid); pg8::EpiGlu<0> E{(bf16*)(ws + WS_YS5), 512, F.a->in[I_S5GLUB] + l * 1024, 0, 512}; PT(13); pg8::gemm_phase(F.lds, F.tid, 512, S, E); PT(14); }
            for (int rep = 0; rep < REPN(7); ++rep) stage_rw_readout(F, l); for (int rep = 0; rep < REPN(8); ++rep) stage_hy_post(F, l, nrl); STAGE_END(sb + 6)
        STAGE(sb + 7) pg8::SchedMerge S; S.A0 = (const char*)(ws + WS_YHY); S.A1 = (const char*)(ws + WS_YRW); S.A2 = (const char*)(ws + WS_YS5); S.Bt = (const char*)(wl + WO_WBR); S.tstep = (size_t)256 * 512 * 2; S.bstride = (size_t)1024 * 512 * 2;
            S.nM = nrl / 256; S.nN = 4; S.G = F.G; S.c = F.bid;
            pg8::EpiMerge E{(bf16*)(ws + WS_MTMP), (bf16*)(ws + WS_H), (const bf16*)(ws + WS_Z) + GATE_OFF}; pg8::gemm_phase(F.lds, F.tid, 512, S, E); STAGE_END(sb + 7)
        STAGE(sb + 8) pg8::SchedStatic S; S.init(ws + WS_H, wl + WO_WOUT, nrl, 1024, 1024, F.G, F.bid); pg8::EpiResid E{(float*)(ws + WS_X), (const float*)(ws + WS_MOD) + (size_t)l * 9 * 6144 + 2048};
            pg8::gemm_phase(F.lds, F.tid, 1024, S, E); STAGE_END(sb + 8)
        STAGE(sb + 9) PT(17); stage_norm2_router(F, l, nrl); PT(18); STAGE_END(sb + 9)
        STAGE(sb + 10) LAS int* base = load_moe_base(F, l); moe_fix_pos(F, nrl, base);
            pg8::SchedMoeG S; S.A = (const char*)(ws + WS_H); S.rowof = (const unsigned*)(ws + WS_ROWOF); S.Bt = (const char*)(wl + WO_W1); S.tstep = (size_t)256 * 1024 * 2; S.estride = (size_t)2048 * 1024 * 2; S.NPN = 8; S.G = F.G; S.c = F.bid; S.base = base;
            pg8::EpiGlu<1> E{(bf16*)(ws + WS_ACT), 1024, F.a->in[I_B1] + (size_t)l * 32 * 2048, 2048, 1024}; pg8::gemm_phase(F.lds, F.tid, 1024, S, E); STAGE_END(sb + 10)
        STAGE(sb + 11) LAS int* base = load_moe_base(F, l);
            pg8::SchedMoe S; S.A = (const char*)(ws + WS_ACT); S.Bt = (const char*)(wl + WO_W2); S.tstep = (size_t)256 * 1024 * 2; S.estride = (size_t)1024 * 1024 * 2; S.NPN = 4; S.G = F.G; S.c = F.bid; S.base = base;
            pg8::EpiBf16 E{(bf16*)(ws + WS_XS), 1024, F.a->in[I_B2] + (size_t)l * 32 * 1024, 1024}; pg8::gemm_phase(F.lds, F.tid, 1024, S, E); STAGE_END(sb + 11)
    }
    lq = DEPTH;
    STAGE(NSTAGES - 1)
#ifndef PROBE_T
        stage_norm1(F, l);
#endif
#ifdef PROBE_T
        { const unsigned long long* st = (const unsigned long long*)(F.a->ws + WS_CTL + CW_STAMP * 4); const float cval = (float)(long long)(st[PROBE_B] - st[PROBE_A]) * (1.0f / (100.0f * PROBE_DIV));
          __syncthreads(); for (size_t i = (size_t)F.bid * NTHREADS + F.tid; i < (size_t)T_LAT * D; i += (size_t)F.G * NTHREADS) F.a->out[i] = cval; }
#endif
    }
#undef IN
#undef SEAM
}

extern "C" void kernel_launch(void* const* d_in, const int* in_sizes, int n_in, void* d_out, int out_size, void* d_ws, size_t ws_size, hipStream_t stream) {
    static int grid = 0;
    if (grid == 0) {
        if (n_in != 51 || out_size != T_LAT * D || ws_size < WS_END) { fprintf(stderr, "kernel_launch: unexpected shapes (n_in %d out %d ws %zu, need %zu)\n", n_in, out_size, ws_size, (size_t)WS_END); grid = -1; return; }
        int dev = 0, cus = 0, per_cu = 0;
        if (hipGetDevice(&dev) != hipSuccess || hipDeviceGetAttribute(&cus, hipDeviceAttributeMultiprocessorCount, dev) != hipSuccess) { grid = -1; return; }
        if (hipFuncSetAttribute((const void*)mk_fwd, hipFuncAttributeMaxDynamicSharedMemorySize, LDS_BYTES) != hipSuccess) { fprintf(stderr, "kernel_launch: hipFuncSetAttribute failed\n"); grid = -1; return; }
        if (hipOccupancyMaxActiveBlocksPerMultiprocessor(&per_cu, (const void*)mk_fwd, NTHREADS, LDS_BYTES) != hipSuccess || per_cu < 1) fprintf(stderr, "kernel_launch: occupancy query says %d\n", per_cu);
        (void)hipGetLastError();
        grid = cus;
    }
    if (grid < 0) return;
    if (hipMemsetAsync((char*)d_ws + WS_CTL, 0, CTL_ZERO_BYTES, stream) != hipSuccess) return;
    Args a{};
    for (int i = 0; i < 51; ++i) a.in[i] = (const float*)d_in[i];
    a.out = (float*)d_out; a.ws = (unsigned char*)d_ws;
#if MK_PER_STAGE
    for (int s = 0; s < NSTAGES; ++s) { a.ph_lo = s; a.ph_hi = s + 1; int reps = 1;
#ifdef PROBE_SET
        { const int ls = (s == 0 || s == NSTAGES - 1) ? -1 : (s - 1) % NSTAGE_L;
          if (PROBE_SET >= 1 && PROBE_SET <= 13 && ls == PROBE_SET - 1 && ls != 5 && ls != 8 && !(ls == 0 && s > 1)) reps = 3;
          if (PROBE_SET == 14 && s == 0) reps = 3; }
#endif
        for (int r = 0; r < reps; ++r) hipLaunchKernelGGL(mk_fwd, dim3(grid), dim3(NTHREADS), LDS_BYTES, stream, a); }
#else
    a.ph_lo = 0; a.ph_hi = NSTAGES; hipLaunchKernelGGL(mk_fwd, dim3(grid), dim3(NTHREADS), LDS_BYTES, stream, a);
#endif
}
```

```cpp
#include <hip/hip_runtime.h>
#include <cstdio>
#include <cstdint>

#ifndef DUPK
#define DUPK 0
#endif
#define REPN(k) ((DUPK == (k)) ? 3 : 1)
#ifndef REP_GEMM
#define REP_GEMM 1
#endif
#ifndef REP_LIGHT
#define REP_LIGHT 1
#endif
#ifndef REP_PRO
#define REP_PRO 1
#endif
#ifndef MK_PER_STAGE
#define MK_PER_STAGE 0
#endif

#define GAS __attribute__((address_space(1)))
#define LAS __attribute__((address_space(3)))
typedef unsigned short bf16;
typedef unsigned v4u __attribute__((ext_vector_type(4)));
typedef unsigned v2u __attribute__((ext_vector_type(2)));
typedef float f32x4 __attribute__((ext_vector_type(4)));
typedef float f32x2 __attribute__((ext_vector_type(2)));
typedef short bf16x8 __attribute__((ext_vector_type(8)));

constexpr int D = 1024, BATCH = 8, SEQ = 4096, CTXL = 256, DEPTH = 2;
constexpr int T_LAT = BATCH * SEQ, T_CTX = BATCH * CTXL, T_ALL = T_LAT + T_CTX;
constexpr int IN_COLS = 6912, HY_OFF = 0, RW_OFF = 1536, S5_OFF = 3328, GATE_OFF = 3840;
constexpr int NE = 32, TOPK = 4;
constexpr int MAXSLOT = 147456;
constexpr int NWAVES = 8, NTHREADS = 512;
constexpr int HY_MARG = 128, HY_ROWB = 8720, HY_RLEN = 8272, HY_RLENC = 592;
constexpr int HY_R1_OFF = 8 * HY_ROWB, HY_R2_OFF = HY_R1_OFF + HY_RLEN * 2;

constexpr size_t MiB = 1ull << 20;
constexpr size_t WS_CTL = 0, CTL_ZERO_BYTES = 1 * MiB;
constexpr size_t WS_MOD = 1 * MiB;
constexpr size_t WS_BLKCNT = 2 * MiB;
constexpr size_t WS_META = 2 * MiB + 512 * 1024;
constexpr size_t WS_ROWOF = 480 * MiB;
constexpr int CW_CNT = 24576;
constexpr size_t WS_EIDX = 3 * MiB, WS_GATE = 4 * MiB, WS_POS = 5 * MiB;
constexpr size_t WS_WTS = 8 * MiB, WL_STRIDE = 214 * MiB;
constexpr size_t WO_WIN = 0, WO_RWCAT = 14 * MiB, WO_GLU = 16 * MiB, WO_WBR = 17 * MiB, WO_WOUT = 20 * MiB, WO_W1 = 22 * MiB, WO_W2 = 150 * MiB;
constexpr size_t WS_GF = 436 * MiB, GF_STRIDE = 20 * MiB, GF_CTX = 17 * MiB;
constexpr size_t WS_X = 504 * MiB;
constexpr size_t WS_H = 640 * MiB;
constexpr size_t WS_BIG = 708 * MiB;
constexpr size_t WS_Z = WS_BIG;
constexpr size_t WS_SCN = 1167 * MiB;
constexpr size_t WS_MTMP = WS_SCN;
constexpr size_t WS_P = 1473 * MiB;
constexpr size_t WS_ARW = 1643 * MiB;
constexpr size_t WS_YP = 1660 * MiB;
constexpr size_t WS_YDIR = WS_YP;
constexpr size_t WS_UT = 1796 * MiB;
constexpr size_t WS_AS5 = 2000 * MiB;
constexpr size_t WS_YHY = 1898 * MiB, WS_YRW = 1932 * MiB, WS_YS5 = 1966 * MiB;
constexpr size_t WS_XS = WS_BIG;
constexpr size_t WS_ACT = WS_BIG + 288 * MiB;
constexpr size_t WS_END = 2034 * MiB;
constexpr int CW_BAR = 4096;

constexpr int RING_BYTES = 131072;
constexpr int LDSCTL_OFF = RING_BYTES;
constexpr int LDS_BYTES = 163840;

typedef __bf16 bf16x2_t __attribute__((ext_vector_type(2)));
__device__ __forceinline__ unsigned pk2(float lo, float hi) { const bf16x2_t v = __builtin_convertvector((f32x2){lo, hi}, bf16x2_t); return __builtin_bit_cast(unsigned, v); }
__device__ __forceinline__ unsigned f2bf(float f) { return pk2(f, 0.f) & 0xffffu; }
__device__ __forceinline__ float bf2f(bf16 b) { return __builtin_bit_cast(float, ((unsigned)b) << 16); }
__device__ __forceinline__ float bflo(unsigned w) { return __builtin_bit_cast(float, w << 16); }
__device__ __forceinline__ float bfhi(unsigned w) { return __builtin_bit_cast(float, w & 0xffff0000u); }
__device__ __forceinline__ float sigm(float x) { return __builtin_amdgcn_rcpf(1.f + __expf(-x)); }
__device__ __forceinline__ float tanh_fast(float x) { const float e = __expf(2.f * x); return 1.f - 2.f * __builtin_amdgcn_rcpf(e + 1.f); }
#define LDS_WAIT() asm volatile("s_waitcnt lgkmcnt(0)" ::: "memory")
__device__ __forceinline__ float dpp_f(float x, const int ctrl_sel) {
    const int v = __builtin_bit_cast(int, x);
    int r;
    if (ctrl_sel == 0) r = __builtin_amdgcn_update_dpp(0, v, 0xB1, 0xF, 0xF, true);
    else if (ctrl_sel == 1) r = __builtin_amdgcn_update_dpp(0, v, 0x4E, 0xF, 0xF, true);
    else r = __builtin_amdgcn_update_dpp(0, v, 0x141, 0xF, 0xF, true);
    return __builtin_bit_cast(float, r);
}
__device__ __forceinline__ float red32(float x) {
    x += dpp_f(x, 0); x += dpp_f(x, 1); x += dpp_f(x, 2);
    x += __builtin_bit_cast(float, __builtin_amdgcn_update_dpp(0, __builtin_bit_cast(int, x), 0x128, 0xF, 0xF, true));
    x += __builtin_bit_cast(float, __builtin_amdgcn_ds_swizzle(__builtin_bit_cast(int, x), 0x401F));
    return x;
}
__device__ __forceinline__ float wave_sum(float v) {
    v = red32(v);
    return __builtin_bit_cast(float, __builtin_amdgcn_readlane(__builtin_bit_cast(int, v), 0)) + __builtin_bit_cast(float, __builtin_amdgcn_readlane(__builtin_bit_cast(int, v), 32));
}
__device__ __forceinline__ int xch32(int v, const int step) {
    if (step == 0) return __builtin_amdgcn_update_dpp(0, v, 0xB1, 0xF, 0xF, true);
    if (step == 1) return __builtin_amdgcn_update_dpp(0, v, 0x4E, 0xF, 0xF, true);
    if (step == 2) return __builtin_amdgcn_update_dpp(0, v, 0x141, 0xF, 0xF, true);
    if (step == 3) return __builtin_amdgcn_update_dpp(0, v, 0x128, 0xF, 0xF, true);
    return __builtin_amdgcn_ds_swizzle(v, 0x401F);
}
__device__ __forceinline__ float red8(float x) { x += dpp_f(x, 0); x += dpp_f(x, 1); x += dpp_f(x, 2); return x; }

#define XB_TMO      128
#define XB_XCNT(j)  (256  + 64 * (j))
#define XB_XSUB(j)  (1280 + 64 * (j))
#define XB_XGEN(j)  (2304 + 64 * (j))
#define XB_TOP      3328
#define XB_TOPGEN   3392
#define XCD_BAR_WORDS 3456
#define XB_SPIN_CAP (1u << 22)
__device__ __forceinline__ unsigned xb_ld(unsigned* p)              { return __hip_atomic_load(p, __ATOMIC_RELAXED, __HIP_MEMORY_SCOPE_AGENT); }
__device__ __forceinline__ unsigned xb_add(unsigned* p, unsigned v) { return __hip_atomic_fetch_add(p, v, __ATOMIC_RELAXED, __HIP_MEMORY_SCOPE_AGENT); }
__device__ __forceinline__ unsigned xb_xcc_id() { return (unsigned)__builtin_amdgcn_s_getreg((3 << 11) | 20) & 0xFu; }
#define XB_SPIN(cond, bar) do { unsigned _sp = 0; while (cond) { __builtin_amdgcn_s_sleep(1); \
    if ((++_sp & 255u) == 0u) { if (xb_ld(&(bar)[XB_TMO])) break; if (_sp > XB_SPIN_CAP) { atomicAdd(&(bar)[XB_TMO], 1u); break; } } } } while (0)
struct XcdBarrier { unsigned* bar; unsigned x; volatile LAS unsigned* st; };
__device__ __forceinline__ XcdBarrier xcd_barrier_post(unsigned* bar, volatile LAS unsigned* st) {
    XcdBarrier b; b.bar = bar; b.x = xb_xcc_id(); b.st = st;
    if (threadIdx.x == 0) (void)xb_add(&bar[XB_XCNT(b.x)], 1u);
    return b;
}
__device__ __forceinline__ void xcd_barrier_complete(unsigned* bar, unsigned x, unsigned& nloc, unsigned& nx) {
    const unsigned G = gridDim.x * gridDim.y * gridDim.z;
    unsigned sum, cnt, mine, sp = 0u;
    for (;;) {
        sum = 0u; cnt = 0u; mine = 0u;
#pragma unroll
        for (unsigned j = 0; j < 16; ++j) { const unsigned c = xb_ld(&bar[XB_XCNT(j)]); sum += c; cnt += (c > 0u) ? 1u : 0u; mine = (j == x) ? c : mine; }
        if (sum == G) break;
        __builtin_amdgcn_s_sleep(1);
        if ((++sp & 255u) == 0u) { if (xb_ld(&bar[XB_TMO])) break; if (sp > XB_SPIN_CAP) { atomicAdd(&bar[XB_TMO], 1u); break; } }
    }
    nloc = mine > 0u ? mine : 1u; nx = cnt > 0u ? cnt : 1u;
}
__device__ __forceinline__ void xcd_barrier(const XcdBarrier& b) {
    asm volatile("s_waitcnt vmcnt(0)" ::: "memory");
    __syncthreads();
    if (threadIdx.x == 0) {
        unsigned* bar = b.bar;
        __builtin_amdgcn_s_waitcnt(0);
        unsigned nloc = b.st[0], nx = b.st[1];
        if (nloc == 0u) { xcd_barrier_complete(bar, b.x, nloc, nx); b.st[0] = nloc; b.st[1] = nx; }
        const unsigned old = xb_add(&bar[XB_XSUB(b.x)], 1u);
        const unsigned gen = old / nloc;
        if (old + 1u == (gen + 1u) * nloc) {
            __builtin_amdgcn_fence(__ATOMIC_RELEASE, "agent");
            asm volatile("s_waitcnt vmcnt(0)" ::: "memory");
            const unsigned og = xb_add(&bar[XB_TOP], 1u);
            const unsigned tg = og / nx;
            if (og + 1u == (tg + 1u) * nx) xb_add(&bar[XB_TOPGEN], 1u);
            else XB_SPIN(xb_ld(&bar[XB_TOPGEN]) == tg, bar);
            __builtin_amdgcn_fence(__ATOMIC_ACQUIRE, "agent");
            xb_add(&bar[XB_XGEN(b.x)], 1u);
            asm volatile("s_waitcnt vmcnt(0)" ::: "memory");
        } else {
            XB_SPIN(xb_ld(&bar[XB_XGEN(b.x)]) == gen, bar);
            __builtin_amdgcn_fence(__ATOMIC_ACQUIRE, "agent");
            asm volatile("s_waitcnt vmcnt(0)" ::: "memory");
        }
    }
    __syncthreads();
}

namespace pg8 {
constexpr int MOE_CAP = 34816;
constexpr int BM = 256, BK = 64, HALF = 128, HTB = HALF * BK * 2, STAGE_BYTES = 8 * HTB, NXCD = 8, WGM = 8, ROWTAB_OFF = 131072 + 4096;
__host__ __device__ __forceinline__ int lds_byte(int r, int c) { const int st = (r >> 4) * 2 + (c >> 5), rr = r & 15, cc = c & 31, ob = rr * 64 + cc * 2; return st * 1024 + (ob ^ (((ob >> 9) & 1) << 5)); }
__host__ __device__ __forceinline__ void stage_rc(int b, int& R, int& C) { const int st = b / 1024, sb = b % 1024, swz = sb ^ (((sb >> 9) & 1) << 5); R = (st >> 1) * 16 + swz / 64; C = (st & 1) * 32 + (swz % 64) / 2; }
__host__ __device__ __forceinline__ int perm32(int rho) { const int n = rho >> 4, i = rho & 15; return 8 * (i >> 2) + 4 * n + (i & 3); }
struct Unit { int pm, pn, e; };
__device__ __forceinline__ unsigned cvt_pk_bf16(float lo, float hi) { return pk2(lo, hi); }

__device__ __forceinline__ void tile_of(int L, int nM, int nN, int& pm, int& pn) {
    const int nwg = nM * nN; int wgid = L;
    { const int q = nwg / NXCD, r = nwg % NXCD, xcd = wgid % NXCD, off = wgid / NXCD; wgid = (xcd < r ? xcd * (q + 1) : r * (q + 1) + (xcd - r) * q) + off; }
    const int nig = WGM * nN, gid = wgid / nig, fm = gid * WGM, gsz = (nM - fm) < WGM ? (nM - fm) : WGM;
    pm = fm + ((wgid % nig) % gsz); pn = (wgid % nig) / gsz;
}
struct SchedStatic {
    static constexpr bool GATHER = false;
    const char* A; const char* Bt; size_t tstep; int nM, nN, G, c;
    __device__ __forceinline__ void init(const void* A_, const void* Bt_, int M, int N, int K, int G_, int c_) { A = (const char*)A_; Bt = (const char*)Bt_; tstep = (size_t)BM * K * 2; nM = M / BM; nN = N / BM; G = G_; c = c_; }
    __device__ __forceinline__ bool next(int i, Unit& u) const { const long L = (long)i * G + c; if (L >= (long)nM * nN) return false; tile_of((int)L, nM, nN, u.pm, u.pn); u.e = 0; return true; }
    __device__ __forceinline__ const char* aptr(const Unit& u) const { return A + (size_t)u.pm * tstep; }
    __device__ __forceinline__ const char* bptr(const Unit& u) const { return Bt + (size_t)u.pn * tstep; }
};
struct SchedWin {
    static constexpr bool GATHER = false;
    const char* A; const char* Bt; size_t tstep; int G, c, part;
    __device__ __forceinline__ bool next(int i, Unit& u) const {
        const int L = i * G + c, nmf = part ? 128 : 136, nfull = nmf * 27; u.e = 0;
        if (L < nfull) { tile_of(L, nmf, 27, u.pm, u.pn); return true; }
        const int L2 = L - nfull; if (!part || L2 >= 8 * 9) return false;
        u.pm = 128 + L2 / 9; u.pn = 6 + L2 % 9; return true; }
    __device__ __forceinline__ const char* aptr(const Unit& u) const { return A + (size_t)u.pm * tstep; }
    __device__ __forceinline__ const char* bptr(const Unit& u) const { return Bt + (size_t)u.pn * tstep; }
};
struct SchedMerge {
    static constexpr bool GATHER = false;
    const char* A0; const char* A1; const char* A2; const char* Bt; size_t tstep, bstride; int nM, nN, G, c;
    __device__ __forceinline__ bool next(int i, Unit& u) const { const int j = i / 3, br = i - 3 * j; const long L = (long)j * G + c; if (L >= (long)nM * nN) return false; tile_of((int)L, nM, nN, u.pm, u.pn); u.e = br; return true; }
    __device__ __forceinline__ const char* aptr(const Unit& u) const { return (u.e == 0 ? A0 : (u.e == 1 ? A1 : A2)) + (size_t)u.pm * tstep; }
    __device__ __forceinline__ const char* bptr(const Unit& u) const { return Bt + (size_t)u.e * bstride + (size_t)u.pn * tstep; }
};
struct SchedMoe {
    static constexpr bool GATHER = false;
    const char* A; const char* Bt; size_t tstep, estride; int NPN, G, c; const LAS int* base;
    __device__ __forceinline__ bool next(int i, Unit& u) const {
        const int ntiles = base[32] >> 8; const int per = G >> 3;
        const long L = (long)i * G + (((G & 7) == 0) ? (c & 7) * per + (c >> 3) : c);
        if (L >= (long)ntiles * NPN) return false;
        u.pm = (int)(L / NPN); u.pn = (int)(L % NPN); const int r0 = u.pm << 8; int e = 0;
#pragma unroll 1
        for (int k = 1; k < 32; ++k) e += (r0 >= base[k]) ? 1 : 0;
        u.e = e; return true;
    }
    __device__ __forceinline__ const char* aptr(const Unit& u) const { return A + (size_t)u.pm * tstep; }
    __device__ __forceinline__ const char* bptr(const Unit& u) const { return Bt + (size_t)u.e * estride + (size_t)u.pn * tstep; }
};
struct SchedMoeG : SchedMoe {
    static constexpr bool GATHER = true;
    const unsigned* rowof;
    __device__ __forceinline__ const char* aptr(const Unit&) const { return A; }
    __device__ __forceinline__ const unsigned* rowptr(const Unit& u) const { return rowof + (size_t)u.e * MOE_CAP + ((u.pm << 8) - base[u.e]); }
    __device__ __forceinline__ int valid(const Unit& u) const { return base[64 + u.e] - ((u.pm << 8) - base[u.e]); }
};

template <class Epi, class Sched>
__device__ __forceinline__ void gemm_phase(LAS unsigned char* lds, const int tid, const int K, const Sched& S, const Epi& E) {
    const int wid = __builtin_amdgcn_readfirstlane(tid >> 6), lane = tid & 63, wr = wid >> 2, wc = wid & 3, fr = lane & 15, fq = lane >> 4;
    const int nt = K / BK;
    unsigned voffA[2], voffB[2];
#pragma unroll
    for (int i = 0; i < 2; ++i) { int R, C; stage_rc(tid * 16 + i * 8192, R, C); const int Rb = Epi::PERM ? ((R & ~31) + perm32(R & 31)) : R;
        voffA[i] = (unsigned)(R * K + C) * 2u; voffB[i] = (unsigned)(Rb * K + C) * 2u; }
    const size_t kstep = (size_t)(BK * 2);
    const size_t hstep = (size_t)HALF * K * 2;
    const unsigned ldsw = (unsigned)wid * 1024u;
    const int aoff = lds_byte(wr * 64 + fr, fq * 8), boff = lds_byte(wc * 32 + fr, fq * 8);
#define PG8_SA(b, h) (((b) * 2 + (h)) * HTB)
#define PG8_SB(b, h) ((4 + (b) * 2 + (h)) * HTB)
#define PG8_STAGE(bufoff, gbase, voff) do { _Pragma("unroll") for (int _i = 0; _i < 2; ++_i) \
        __builtin_amdgcn_global_load_lds((const unsigned*)((const char*)(gbase) + (voff)[_i]), (LAS unsigned*)(lds + (bufoff) + ldsw + _i * 8192), 16, 0, 0); } while (0)
#define PG8_STAGEA(bufoff, kp, h) do { if constexpr (Sched::GATHER) { _Pragma("unroll") for (int _i = 0; _i < 2; ++_i) \
        __builtin_amdgcn_global_load_lds((const unsigned*)((const char*)(kp) + g[2 * (h) + _i]), (LAS unsigned*)(lds + (bufoff) + ldsw + _i * 8192), 16, 0, 0); } \
        else { PG8_STAGE(bufoff, (kp) + (h) * hstep, voffA); } } while (0)
#define PG8_GLOAD(un_, buf) do { const LAS unsigned* rt_ = (const LAS unsigned*)(lds + ROWTAB_OFF + (buf) * 1024) + gR0; const int nv_ = S.valid(un_); \
        _Pragma("unroll") for (int _j = 0; _j < 4; ++_j) g[_j] = ((gR0 + 64 * _j < nv_) ? rt_[64 * _j] : 0u) + gCb; } while (0)
#define PG8_GDMA(un_, buf) do { if (wid == 0) { unsigned lo_ = (unsigned)threadIdx.x; asm volatile("" : "+v"(lo_)); lo_ = (lo_ & 63u) * 16u; \
        __builtin_amdgcn_global_load_lds((const unsigned*)((const char*)S.rowptr(un_) + lo_), (LAS unsigned*)(lds + ROWTAB_OFF + (buf) * 1024), 16, 0, 0); } } while (0)
#define PG8_LDA(dst, b, h) do { _Pragma("unroll") for (int m = 0; m < 4; ++m) _Pragma("unroll") for (int k = 0; k < 2; ++k) dst[m][k] = *(const LAS bf16x8*)(lds + PG8_SA(b, h) + aoff + m * 2048 + k * 1024); } while (0)
#define PG8_LDB(dst, b, h) do { _Pragma("unroll") for (int n = 0; n < 2; ++n) _Pragma("unroll") for (int k = 0; k < 2; ++k) dst[n][k] = *(const LAS bf16x8*)(lds + PG8_SB(b, h) + boff + n * 2048 + k * 1024); } while (0)
#define PG8_MMA(ai, bj, At, Bt) do { __builtin_amdgcn_s_setprio(1); _Pragma("unroll") for (int m = 0; m < 4; ++m) _Pragma("unroll") for (int n = 0; n < 2; ++n) _Pragma("unroll") for (int k = 0; k < 2; ++k) \
        acc[ai][bj][m][n] = __builtin_amdgcn_mfma_f32_16x16x32_bf16(Bt[n][k], At[m][k], acc[ai][bj][m][n], 0, 0, 0); __builtin_amdgcn_s_setprio(0); } while (0)
#define PG8_WAIT_V(n) asm volatile("s_waitcnt vmcnt(" #n ")" ::: "memory")
#define PG8_WAIT_L(n) asm volatile("s_waitcnt lgkmcnt(" #n ")" ::: "memory")
#define PG8_BAR __builtin_amdgcn_s_barrier()
#define PG8_SCHED __builtin_amdgcn_sched_barrier(0)
    Unit cur, nxt; int ui = 0;
    if (!S.next(0, cur)) return;
    f32x4 acc[2][2][4][2];
#pragma unroll
    for (int a = 0; a < 2; ++a)
#pragma unroll
        for (int b = 0; b < 2; ++b)
#pragma unroll
            for (int m = 0; m < 4; ++m)
#pragma unroll
                for (int n = 0; n < 2; ++n) acc[a][b][m][n] = (f32x4){0.f, 0.f, 0.f, 0.f};
    bf16x8 At[4][2], B0[2][2], B1[2][2];
    const char* cA = S.aptr(cur); const char* cB = S.bptr(cur);
    unsigned g[4] = {0u, 0u, 0u, 0u}; int gR0 = 0; unsigned gCb = 0u;
    if constexpr (Sched::GATHER) { int R, C; stage_rc(tid * 16, R, C); gR0 = R; gCb = (unsigned)C * 2u;
        PG8_GDMA(cur, 0); PG8_WAIT_V(0); PG8_BAR; PG8_GLOAD(cur, 0); }
    PG8_STAGE(PG8_SB(0, 0), cB, voffB); PG8_STAGE(PG8_SB(0, 1), cB + hstep, voffB); PG8_STAGEA(PG8_SA(0, 0), cA, 0); PG8_STAGEA(PG8_SA(0, 1), cA, 1);
    if (wr == 1) PG8_BAR;
    PG8_WAIT_V(2); PG8_BAR;
    PG8_STAGE(PG8_SB(1, 0), cB + kstep, voffB); PG8_STAGEA(PG8_SA(1, 0), cA + kstep, 0); PG8_STAGE(PG8_SB(1, 1), cB + hstep + kstep, voffB);
    PG8_WAIT_V(6); PG8_BAR;
    for (;;) {
        const bool has_next = S.next(ui + 1, nxt);
        const char* nA = has_next ? S.aptr(nxt) : cA; const char* nB = has_next ? S.bptr(nxt) : cB;
        if constexpr (Sched::GATHER) { if (has_next) PG8_GDMA(nxt, (ui + 1) & 1); }
        for (int t = 0; t < nt; t += 2) {
            const bool last = (t == nt - 2);
            const char* a1 = cA + (size_t)(t + 1) * kstep;
            const char* a2 = last ? nA : cA + (size_t)(t + 2) * kstep; const char* b2 = last ? nB : cB + (size_t)(t + 2) * kstep;
            const char* a3 = a2 + kstep; const char* b3 = b2 + kstep;
            PG8_LDB(B0, 0, 0); PG8_LDB(B1, 0, 1); PG8_SCHED; PG8_LDA(At, 0, 0); PG8_STAGEA(PG8_SA(1, 1), a1, 1);
            PG8_WAIT_V(8); PG8_WAIT_L(0); PG8_BAR; PG8_MMA(0, 0, At, B0); PG8_MMA(0, 1, At, B1); PG8_BAR; PG8_SCHED;
            if constexpr (Sched::GATHER) { if (last && has_next) PG8_GLOAD(nxt, (ui + 1) & 1); PG8_SCHED; }
            PG8_LDA(At, 0, 1); PG8_STAGE(PG8_SB(0, 0), b2, voffB); PG8_STAGE(PG8_SB(0, 1), b2 + hstep, voffB); PG8_STAGEA(PG8_SA(0, 0), a2, 0);
            PG8_WAIT_V(8); PG8_WAIT_L(0); PG8_BAR; PG8_MMA(1, 0, At, B0); PG8_MMA(1, 1, At, B1); PG8_BAR; PG8_SCHED;
            PG8_LDB(B0, 1, 0); PG8_LDB(B1, 1, 1); PG8_SCHED; PG8_LDA(At, 1, 0); PG8_STAGEA(PG8_SA(0, 1), a2, 1);
            PG8_WAIT_V(8); PG8_WAIT_L(0); PG8_BAR; PG8_MMA(0, 0, At, B0); PG8_MMA(0, 1, At, B1); PG8_BAR; PG8_SCHED;
            PG8_LDA(At, 1, 1); PG8_STAGE(PG8_SB(1, 0), b3, voffB); PG8_STAGE(PG8_SB(1, 1), b3 + hstep, voffB); PG8_STAGEA(PG8_SA(1, 0), a3, 0);
            PG8_WAIT_V(8); PG8_WAIT_L(0); PG8_BAR; PG8_MMA(1, 0, At, B0); PG8_MMA(1, 1, At, B1); PG8_BAR; PG8_SCHED;
        }
        if (wr == 0) PG8_BAR;
        { int t2_ = (int)threadIdx.x; asm volatile("" : "+v"(t2_)); E(acc, cur, wr, wc, t2_ & 15, (t2_ >> 4) & 3); }
        if (!has_next) break;
#pragma unroll
        for (int a = 0; a < 2; ++a)
#pragma unroll
            for (int b = 0; b < 2; ++b)
#pragma unroll
                for (int m = 0; m < 4; ++m)
#pragma unroll
                    for (int n = 0; n < 2; ++n) acc[a][b][m][n] = (f32x4){0.f, 0.f, 0.f, 0.f};
        cur = nxt; cA = nA; cB = nB; ++ui;
        if (wr == 1) PG8_BAR;
    }
    PG8_WAIT_V(0);
    PG8_BAR;
#undef PG8_SA
#undef PG8_SB
#undef PG8_STAGE
#undef PG8_STAGEA
#undef PG8_GLOAD
#undef PG8_GDMA
#undef PG8_LDA
#undef PG8_LDB
#undef PG8_MMA
#undef PG8_WAIT_V
#undef PG8_WAIT_L
#undef PG8_BAR
#undef PG8_SCHED
}

struct EpiBf16 {
    static constexpr bool PERM = true;
    bf16* O; int ldc; const float* bias; int bias_stride;
    __device__ __forceinline__ void operator()(const f32x4 (&acc)[2][2][4][2], const Unit& u, int wr, int wc, int fr, int fq) const {
        const int row0 = u.pm * BM + wr * 64 + fr, col0 = u.pn * BM + wc * 32 + 8 * fq;
        f32x4 bv[2][2];
#pragma unroll
        for (int bj = 0; bj < 2; ++bj)
#pragma unroll
            for (int n = 0; n < 2; ++n) bv[bj][n] = bias ? *(const f32x4*)(bias + (size_t)u.e * bias_stride + col0 + bj * HALF + 4 * n) : (f32x4){0.f, 0.f, 0.f, 0.f};
#pragma unroll
        for (int ai = 0; ai < 2; ++ai)
#pragma unroll
            for (int m = 0; m < 4; ++m) { bf16* rowp = O + (size_t)(row0 + ai * HALF + m * 16) * ldc + col0;
#pragma unroll
                for (int bj = 0; bj < 2; ++bj) { const f32x4 v0 = acc[ai][bj][m][0] + bv[bj][0], v1 = acc[ai][bj][m][1] + bv[bj][1];
                    v4u w; w.x = cvt_pk_bf16(v0[0], v0[1]); w.y = cvt_pk_bf16(v0[2], v0[3]); w.z = cvt_pk_bf16(v1[0], v1[1]); w.w = cvt_pk_bf16(v1[2], v1[3]);
                    *(v4u*)(rowp + bj * HALF) = w; } }
    }
};
template <int MODE> struct EpiGlu {
    static constexpr bool PERM = true;
    bf16* O; int ldc; const float* bias; int bias_stride, hs;
    __device__ __forceinline__ void operator()(const f32x4 (&acc)[2][2][4][2], const Unit& u, int wr, int wc, int fr, int fq) const {
        const int row0 = u.pm * BM + wr * 64 + fr, col0 = u.pn * HALF + wc * 32 + 8 * fq;
        const float* bp = bias + (size_t)u.e * bias_stride + col0;
        f32x4 ba[2], bb[2];
#pragma unroll
        for (int n = 0; n < 2; ++n) { ba[n] = *(const f32x4*)(bp + 4 * n); bb[n] = *(const f32x4*)(bp + hs + 4 * n); }
#pragma unroll
        for (int ai = 0; ai < 2; ++ai)
#pragma unroll
            for (int m = 0; m < 4; ++m) { bf16* rowp = O + (size_t)(row0 + ai * HALF + m * 16) * ldc + col0;
                float o[8];
#pragma unroll
                for (int n = 0; n < 2; ++n) { const f32x4 a = acc[ai][0][m][n] + ba[n], b = acc[ai][1][m][n] + bb[n];
#pragma unroll
                    for (int j = 0; j < 4; ++j) {
                        if (MODE == 0) o[4 * n + j] = a[j] * sigm(b[j]);
                        else { const float g = fminf(a[j], 7.f), up = fminf(fmaxf(b[j], -7.f), 7.f); o[4 * n + j] = (up + 1.f) * g * sigm(1.702f * g); } } }
                v4u w; w.x = cvt_pk_bf16(o[0], o[1]); w.y = cvt_pk_bf16(o[2], o[3]); w.z = cvt_pk_bf16(o[4], o[5]); w.w = cvt_pk_bf16(o[6], o[7]);
                *(v4u*)rowp = w; }
    }
};
struct EpiMerge {
    static constexpr bool PERM = true;
    bf16* mtmp; bf16* Mo; const bf16* zg;
    __device__ __forceinline__ void operator()(const f32x4 (&acc)[2][2][4][2], const Unit& u, int wr, int wc, int fr, int fq) const {
        const int row0 = u.pm * BM + wr * 64 + fr, col0 = u.pn * BM + wc * 32 + 8 * fq;
#pragma unroll
        for (int ai = 0; ai < 2; ++ai)
#pragma unroll
            for (int m = 0; m < 4; ++m) { const size_t r = (size_t)(row0 + ai * HALF + m * 16);
#pragma unroll
                for (int bj = 0; bj < 2; ++bj) { const int c = col0 + bj * HALF;
                    const v4u gz = *(const v4u*)(zg + r * IN_COLS + u.e * 1024 + c);
                    float g[8] = {bflo(gz.x), bfhi(gz.x), bflo(gz.y), bfhi(gz.y), bflo(gz.z), bfhi(gz.z), bflo(gz.w), bfhi(gz.w)};
                    f32x4 t0, t1; bf16* tp = mtmp + r * 1024 + c;
                    if (u.e == 0) { t0 = (f32x4){0.f, 0.f, 0.f, 0.f}; t1 = t0; } else { const v4u pv = *(const v4u*)tp; t0 = (f32x4){bflo(pv.x), bfhi(pv.x), bflo(pv.y), bfhi(pv.y)}; t1 = (f32x4){bflo(pv.z), bfhi(pv.z), bflo(pv.w), bfhi(pv.w)}; }
#pragma unroll
                    for (int j = 0; j < 4; ++j) { t0[j] += sigm(g[j]) * acc[ai][bj][m][0][j]; t1[j] += sigm(g[4 + j]) * acc[ai][bj][m][1][j]; }
                    if (u.e < 2) { v4u w; w.x = cvt_pk_bf16(t0[0], t0[1]); w.y = cvt_pk_bf16(t0[2], t0[3]); w.z = cvt_pk_bf16(t1[0], t1[1]); w.w = cvt_pk_bf16(t1[2], t1[3]); *(v4u*)tp = w; }
                    else { v4u w; w.x = cvt_pk_bf16(t0[0], t0[1]); w.y = cvt_pk_bf16(t0[2], t0[3]); w.z = cvt_pk_bf16(t1[0], t1[1]); w.w = cvt_pk_bf16(t1[2], t1[3]);
                        *(v4u*)(Mo + r * 1024 + c) = w; } } }
    }
};
struct EpiResid {
    static constexpr bool PERM = false;
    float* X; const float* gmod;
    __device__ __forceinline__ void operator()(const f32x4 (&acc)[2][2][4][2], const Unit& u, int wr, int wc, int fr, int fq) const {
        const int row0 = u.pm * BM + wr * 64 + fr, col0 = u.pn * BM + wc * 32 + 4 * fq;
        const int r00 = u.pm * BM; const int w = r00 < T_LAT ? (r00 >> 12) : 8;
        f32x4 gv[2][2];
#pragma unroll
        for (int bj = 0; bj < 2; ++bj)
#pragma unroll
            for (int n = 0; n < 2; ++n) gv[bj][n] = *(const f32x4*)(gmod + (size_t)w * 6144 + col0 + bj * HALF + n * 16);
#pragma unroll
        for (int ai = 0; ai < 2; ++ai)
#pragma unroll
            for (int m = 0; m < 4; ++m) { float* rowp = X + (size_t)(row0 + ai * HALF + m * 16) * 1024 + col0;
#pragma unroll
                for (int bj = 0; bj < 2; ++bj)
#pragma unroll
                    for (int n = 0; n < 2; ++n) { f32x4* p = (f32x4*)(rowp + bj * HALF + n * 16); *p = *p + gv[bj][n] * acc[ai][bj][m][n]; } }
    }
};
}

struct Args { const float* in[51]; float* out; unsigned char* ws; int ph_lo, ph_hi; };
enum { I_X = 0, I_C, I_CTX, I_CCTX, I_ADAW, I_ADAB, I_N1G, I_N2G, I_WIN, I_HYCW, I_HYCB, I_HYW1, I_HYB1, I_HYF1, I_HYW2, I_HYB2, I_HYF2, I_HYW3, I_HYB3, I_HYBIAS,
       I_RWCW, I_RWCB, I_RWWUP, I_RWW0, I_RWAUP, I_RWA0, I_RWGUP, I_RWKK, I_RWKA, I_RWRK, I_RWLNG, I_RWLNB, I_S5ARE, I_S5AIM, I_S5LDT, I_S5BRE, I_S5BIM, I_S5CRE, I_S5CIM, I_S5D,
       I_S5GLUW, I_S5GLUB, I_WBR, I_WOUT, I_RTW, I_RTB, I_W1, I_B1, I_W2, I_B2, I_FING };

typedef const __attribute__((address_space(4))) Args* CArgsP;
__device__ __forceinline__ CArgsP kargs() { CArgsP p = (CArgsP)__builtin_amdgcn_kernarg_segment_ptr(); asm volatile("" : "+s"(p)); return p; }
__device__ __forceinline__ int opaque(int v) { asm volatile("" : "+s"(v)); return v; }
__device__ __forceinline__ int opaque_v(int v) { asm volatile("" : "+v"(v)); return v; }
struct Ctx { CArgsP a; LAS unsigned char* lds; int tid, lane, wave, bid, G; };

__device__ __forceinline__ void row_seq(int row, int& base, int& pos, int& n) {
    if (row < T_LAT) { base = row & ~(SEQ - 1); pos = row & (SEQ - 1); n = SEQ; }
    else { const int r = row - T_LAT; base = T_LAT + (r & ~(CTXL - 1)); pos = r & (CTXL - 1); n = CTXL; }
}
__device__ __forceinline__ float conv3z(const bf16* zc, int pos, int n, float w0, float w1, float w2, float b) {
    const float zm = pos > 0 ? bf2f(zc[(size_t)(pos - 1) * IN_COLS]) : 0.f, z0 = bf2f(zc[(size_t)pos * IN_COLS]), zp = pos < n - 1 ? bf2f(zc[(size_t)(pos + 1) * IN_COLS]) : 0.f;
    return zm * w0 + z0 * w1 + zp * w2 + b;
}

template <int MODE>
__device__ __forceinline__ void transpose_item(const float* W, int K, int N, bf16* WT, int Hs, LAS float* scr, int item, int lane) {
    const int nblk = N / 32, kb = item / nblk, nb = item % nblk, k0 = 64 * kb, n0 = 32 * nb;
#pragma unroll 8
    for (int i = 0; i < 32; ++i) { const int kk = 2 * i + (lane >> 5); scr[kk * 33 + (lane & 31)] = W[(size_t)(k0 + kk) * N + n0 + (lane & 31)]; }
    LDS_WAIT(); asm volatile("" ::: "memory");
    const int c = lane & 7;
#pragma unroll
    for (int j = 0; j < 4; ++j) { const int n = (lane >> 3) + 8 * j; const LAS float* s = scr + (8 * c) * 33 + n;
        v4u o; o.x = pk2(s[0 * 33], s[1 * 33]); o.y = pk2(s[2 * 33], s[3 * 33]); o.z = pk2(s[4 * 33], s[5 * 33]); o.w = pk2(s[6 * 33], s[7 * 33]);
        int dr = n0 + n;
        if (MODE == 1) { const int nc = n0 + n; const int jx = nc < Hs ? nc : nc - Hs; dr = (jx >> 7) * 256 + (nc < Hs ? 0 : 128) + (jx & 127); }
        *(v4u*)(WT + (size_t)dr * K + k0 + 8 * c) = o; }
    LDS_WAIT(); asm volatile("" ::: "memory");
}

__device__ __forceinline__ void p0_prologue(const Ctx& F) {
    const auto& a = *F.a; unsigned char* ws = a.ws;
    const int gw = F.bid * NWAVES + F.wave, NGW = F.G * NWAVES, lane = F.lane;
    float* X = (float*)(ws + WS_X);
    for (int t = gw; t < SEQ; t += NGW) {
        const float pr = (float)(t >> 6), pc = (float)(t & 63);
        f32x4 pe[4];
#pragma unroll
        for (int j = 0; j < 4; ++j)
#pragma unroll
            for (int e = 0; e < 4; ++e) { const float om = __builtin_amdgcn_exp2f((float)(4 * lane + e) * (-13.287712379549449f / 256.0f)); const float ang = ((j < 2) ? pr : pc) * om; pe[j][e] = (j & 1) ? __cosf(ang) : __sinf(ang); }
#pragma unroll 2
        for (int bb = 0; bb < BATCH; ++bb) { const size_t row = (size_t)bb * SEQ + t;
            const f32x4* xi = (const f32x4*)(a.in[I_X] + row * D) + lane; f32x4* xo = (f32x4*)(X + row * D) + lane;
#pragma unroll
            for (int j = 0; j < 4; ++j) xo[64 * j] = xi[64 * j] + pe[j]; }
    }
    for (int row = T_LAT + gw; row < T_ALL; row += NGW) {
        const f32x4* xi = (const f32x4*)(a.in[I_CTX] + (size_t)(row - T_LAT) * D) + lane; f32x4* xo = (f32x4*)(X + (size_t)row * D) + lane;
#pragma unroll
        for (int j = 0; j < 4; ++j) xo[64 * j] = xi[64 * j];
    }
    {
        LAS float* condl = (LAS float*)F.lds; LAS float* psum = (LAS float*)(F.lds + 40960);
        for (int i = F.tid; i < 9 * 1024; i += NTHREADS) { const int w = i >> 10, k = i & 1023; const float cv = (w < 8) ? a.in[I_C][w * 1024 + k] : a.in[I_CCTX][k]; condl[i] = cv / (1.f + expf(-cv)); }
        __syncthreads();
        float* MOD = (float*)(ws + WS_MOD);
        for (int it = F.bid; it < 2 * 96; it += F.G) {
            const int l = it / 96, cg = it % 96, col = cg * 64 + lane;
            float acc[9];
#pragma unroll
            for (int w = 0; w < 9; ++w) acc[w] = 0.f;
            const float* wp = a.in[I_ADAW] + ((size_t)l * 1024 + F.wave * 128) * 6144 + col;
#pragma unroll 1
            for (int k0 = 0; k0 < 128; k0 += 16) { float wv[16];
#pragma unroll
                for (int k = 0; k < 16; ++k) wv[k] = wp[(size_t)(k0 + k) * 6144];
#pragma unroll
                for (int k = 0; k < 16; ++k)
#pragma unroll
                    for (int w = 0; w < 9; ++w) acc[w] += condl[w * 1024 + F.wave * 128 + k0 + k] * wv[k]; }
#pragma unroll
            for (int w = 0; w < 9; ++w) psum[(F.wave * 9 + w) * 64 + lane] = acc[w];
            __syncthreads();
            if (F.wave == 0) {
#pragma unroll
                for (int w = 0; w < 9; ++w) { float s = 0.f;
#pragma unroll
                    for (int wv = 0; wv < 8; ++wv) s += psum[(wv * 9 + w) * 64 + lane];
                    MOD[(size_t)(l * 9 + w) * 6144 + col] = s + a.in[I_ADAB][l * 6144 + col]; }
            }
            __syncthreads();
        }
    }
    {
        LAS float* scr = (LAS float*)(F.lds + F.wave * 16384);
        constexpr int IT_W1 = 16 * 64, IT_W2 = 16 * 32, IT_WIN = 16 * 216, IT_GLU = 8 * 32, IT_WBR = 8 * 32, IT_WOUT = 16 * 32;
        constexpr int N_W1 = 64 * IT_W1, N_W2 = 64 * IT_W2, N_WIN = 2 * IT_WIN, N_GLU = 2 * IT_GLU, N_WBR = 6 * IT_WBR, N_WOUT = 2 * IT_WOUT;
        constexpr int NITEMS = N_W1 + N_W2 + N_WIN + N_GLU + N_WBR + N_WOUT;
        for (int it = gw; it < NITEMS; it += NGW) {
            int r = it;
            if (r < N_W1) { const int mtx = r / IT_W1, l = mtx >> 5, e = mtx & 31; transpose_item<1>(a.in[I_W1] + (size_t)mtx * 1024 * 2048, 1024, 2048, (bf16*)(ws + WS_WTS + l * WL_STRIDE + WO_W1) + (size_t)e * 2048 * 1024, 1024, scr, r % IT_W1, lane); continue; } r -= N_W1;
            if (r < N_W2) { const int mtx = r / IT_W2, l = mtx >> 5, e = mtx & 31; transpose_item<0>(a.in[I_W2] + (size_t)mtx * 1024 * 1024, 1024, 1024, (bf16*)(ws + WS_WTS + l * WL_STRIDE + WO_W2) + (size_t)e * 1024 * 1024, 0, scr, r % IT_W2, lane); continue; } r -= N_W2;
            if (r < N_WIN) { const int l = r / IT_WIN; transpose_item<0>(a.in[I_WIN] + (size_t)l * 1024 * IN_COLS, 1024, IN_COLS, (bf16*)(ws + WS_WTS + l * WL_STRIDE + WO_WIN), 0, scr, r % IT_WIN, lane); continue; } r -= N_WIN;
            if (r < N_GLU) { const int l = r / IT_GLU; transpose_item<1>(a.in[I_S5GLUW] + (size_t)l * 512 * 1024, 512, 1024, (bf16*)(ws + WS_WTS + l * WL_STRIDE + WO_GLU), 512, scr, r % IT_GLU, lane); continue; } r -= N_GLU;
            if (r < N_WBR) { const int mtx = r / IT_WBR, l = mtx / 3, br = mtx % 3; transpose_item<0>(a.in[I_WBR] + (size_t)mtx * 512 * 1024, 512, 1024, (bf16*)(ws + WS_WTS + l * WL_STRIDE + WO_WBR) + (size_t)br * 1024 * 512, 0, scr, r % IT_WBR, lane); continue; } r -= N_WBR;
            { const int l = r / IT_WOUT; transpose_item<0>(a.in[I_WOUT] + (size_t)l * 1024 * 1024, 1024, 1024, (bf16*)(ws + WS_WTS + l * WL_STRIDE + WO_WOUT), 0, scr, r % IT_WOUT, lane); }
        }
        for (int i = F.bid * NTHREADS + F.tid; i < 2 * 2560 * 256; i += F.G * NTHREADS) {
            const int l = i / (2560 * 256), r = i % (2560 * 256), n = r >> 8, k = r & 255; float v = 0.f;
            if (n < 1024) { if (k < 64) v = a.in[I_RWWUP][(((size_t)l * 2 + (n >> 9)) * 64 + k) * 512 + (n & 511)]; }
            else if (n < 2048) { if (k >= 64 && k < 128) v = a.in[I_RWAUP][(((size_t)l * 2 + ((n - 1024) >> 9)) * 64 + (k - 64)) * 512 + (n & 511)]; }
            else { if (k >= 128) v = a.in[I_RWGUP][((size_t)l * 128 + (k - 128)) * 512 + (n - 2048)]; }
            ((bf16*)(ws + WS_WTS + l * WL_STRIDE + WO_RWCAT))[r] = (bf16)f2bf(v);
        }
    }
    __syncthreads();
    {
        LAS float* feats = (LAS float*)F.lds; LAS float* h1 = feats + 8 * 33; LAS float* h2 = h1 + 8 * 64;
        constexpr int NIT = 2 * (512 + 32);
        for (int it = F.bid; it < NIT; it += F.G) {
            const int l = it / 544, r = it % 544, nsel = r >= 512, n = nsel ? CTXL : SEQ, p0 = (nsel ? r - 512 : r) * 8;
            if (F.tid < 8 * 33) { const int p = F.tid / 33, i = F.tid % 33, pos = p0 + p; float f;
                if (i == 0) f = (float)pos / (float)(n - 1);
                else { const int k = (i - 1) & 15; const float band = 1e-4f + (float)k * ((15.0f - 1e-4f) / 15.0f); const float ang = (6.283185307179586f * (float)pos / (float)n) * band; f = (i <= 16) ? cosf(ang) : -sinf(ang); }
                feats[p * 33 + i] = f; }
            __syncthreads();
            { const int p = F.tid >> 6, j = F.tid & 63; float s = a.in[I_HYB1][l * 64 + j]; const float* w1p = a.in[I_HYW1] + (size_t)l * 33 * 64 + j;
#pragma unroll
                for (int i = 0; i < 33; ++i) s += feats[p * 33 + i] * w1p[i * 64];
                h1[p * 64 + j] = sinf(a.in[I_HYF1][l * 64 + j] * s); }
            __syncthreads();
            { const int p = F.tid >> 6, j = F.tid & 63; float s = a.in[I_HYB2][l * 64 + j];
                const float* w2p = a.in[I_HYW2] + (size_t)l * 64 * 64 + j;
#pragma unroll 16
                for (int i = 0; i < 64; ++i) s += h1[p * 64 + i] * w2p[i * 64];
                h2[p * 64 + j] = sinf(a.in[I_HYF2][l * 64 + j] * s); }
            __syncthreads();
            float acc[4][8];
#pragma unroll
            for (int q = 0; q < 4; ++q)
#pragma unroll
                for (int p = 0; p < 8; ++p) acc[q][p] = 0.f;
            const float* w3 = a.in[I_HYW3] + (size_t)l * 64 * 2048 + F.tid;
#pragma unroll 8
            for (int i = 0; i < 64; ++i) { float wv[4];
#pragma unroll
                for (int q = 0; q < 4; ++q) wv[q] = w3[(size_t)i * 2048 + q * 512];
#pragma unroll
                for (int p = 0; p < 8; ++p) { const float hv = h2[p * 64 + i];
#pragma unroll
                    for (int q = 0; q < 4; ++q) acc[q][p] += hv * wv[q]; } }
            const int c = F.tid; const float dstart = logf(0.01f) / 1.5f, dstop = logf(0.01f) / 0.3f; const float delta = fabsf(dstart + (float)c * ((dstop - dstart) / 511.0f));
            const int RL = nsel ? HY_RLENC : HY_RLEN, off = n + 47; const float rn1 = 1.0f / (float)(n - 1);
            bf16* Rb = (bf16*)(ws + WS_GF + l * GF_STRIDE + (nsel ? GF_CTX : 0));
#pragma unroll
            for (int q = 0; q < 4; ++q) { const int o = q >> 1, side = q & 1; const float b3 = a.in[I_HYB3][l * 2048 + q * 512 + c];
                bf16* Rc = Rb + ((size_t)o * 512 + c) * RL;
#pragma unroll
                for (int p = 0; p < 8; ++p) { const int pos = p0 + p; const float t = (float)pos * rn1; const float val = (acc[q][p] + b3) * __expf(-t * delta);
                    if (side == 0) Rc[off - pos] = (bf16)f2bf(val);
                    else if (pos >= 1) Rc[off + pos] = (bf16)f2bf(val); }
                if (p0 == 0 && side == 0) { for (int m = 0; m < 48; ++m) Rc[m] = 0; for (int m = off + n; m < RL; ++m) Rc[m] = 0; } }
            __syncthreads();
        }
    }
}

__device__ __forceinline__ void stage_norm1(const Ctx& F, int l) {
    const auto& a = *F.a; unsigned char* ws = a.ws; const int lane = F.lane;
    const int gw = F.bid * NWAVES + F.wave, NGW = F.G * NWAVES;
    float* X = (float*)(ws + WS_X); bf16* H = (bf16*)(ws + WS_H); const float* MOD = (const float*)(ws + WS_MOD);
    const bf16* YS = (const bf16*)(ws + WS_XS); const int* POS = (const int*)(ws + WS_POS); const float* GATE = (const float*)(ws + WS_GATE);
    const int nrows = (l == DEPTH) ? T_LAT : T_ALL;
    f32x4 ngv[4];
    { const f32x4* ngp = (l == DEPTH) ? (const f32x4*)a.in[I_FING] + lane : (const f32x4*)(a.in[I_N1G] + l * D) + lane;
#pragma unroll
      for (int j = 0; j < 4; ++j) ngv[j] = ngp[64 * j]; }
    f32x4 vn[4]; v2u ysn[4][4]; int4 pnn = make_int4(0, 0, 0, 0); f32x4 gn = (f32x4){0.f, 0.f, 0.f, 0.f}, gnn = gn;
#pragma unroll
    for (int k = 0; k < 4; ++k)
#pragma unroll
        for (int j = 0; j < 4; ++j) ysn[k][j] = (v2u){0u, 0u};
#define N1_LDYS(p4_) do { const int pk_[4] = {(p4_).x, (p4_).y, (p4_).z, (p4_).w}; _Pragma("unroll") for (int k = 0; k < 4; ++k) { const v2u* yr_ = (const v2u*)(YS + (size_t)pk_[k] * D) + lane; \
        _Pragma("unroll") for (int j = 0; j < 4; ++j) ysn[k][j] = yr_[64 * j]; } } while (0)
    if (gw < nrows) {
#pragma unroll
        for (int j = 0; j < 4; ++j) vn[j] = ((const f32x4*)(X + (size_t)gw * D) + lane)[64 * j];
        if (l > 0) { const int4 p0 = *(const int4*)(POS + gw * 4); gn = *(const f32x4*)(GATE + gw * 4);
            if (gw + NGW < nrows) { pnn = *(const int4*)(POS + (gw + NGW) * 4); gnn = *(const f32x4*)(GATE + (gw + NGW) * 4); }
            N1_LDYS(p0); } }
#pragma unroll 1
    for (int row = gw; row < nrows; row += NGW) {
        const int w = row < T_LAT ? (row >> 12) : 8;
        f32x4* xr = (f32x4*)(X + (size_t)row * D) + lane;
        f32x4 v[4]; v2u ysc[4][4];
#pragma unroll
        for (int j = 0; j < 4; ++j) v[j] = vn[j];
#pragma unroll
        for (int k = 0; k < 4; ++k)
#pragma unroll
            for (int j = 0; j < 4; ++j) ysc[k][j] = ysn[k][j];
        const f32x4 gc = gn; const int4 pnx = pnn; gn = gnn;
        const int rn = row + NGW, rnn = row + 2 * NGW;
        if (rn < nrows) {
#pragma unroll
            for (int j = 0; j < 4; ++j) vn[j] = ((const f32x4*)(X + (size_t)rn * D) + lane)[64 * j];
            if (l > 0) N1_LDYS(pnx); }
        if (l > 0 && rnn < nrows) { pnn = *(const int4*)(POS + rnn * 4); gnn = *(const f32x4*)(GATE + rnn * 4); }
        f32x4 m0[4], m1[4], m2[4];
        if (l < DEPTH) {
#pragma unroll
            for (int j = 0; j < 4; ++j) { m0[j] = ((const f32x4*)(MOD + (size_t)(l * 9 + w) * 6144) + lane)[64 * j]; m1[j] = ((const f32x4*)(MOD + (size_t)(l * 9 + w) * 6144 + 1024) + lane)[64 * j]; } }
        if (l > 0) {
#pragma unroll
            for (int j = 0; j < 4; ++j) m2[j] = ((const f32x4*)(MOD + (size_t)((l - 1) * 9 + w) * 6144 + 5120) + lane)[64 * j];
            f32x4 mo[4];
#pragma unroll
            for (int j = 0; j < 4; ++j) mo[j] = (f32x4){0.f, 0.f, 0.f, 0.f};
#pragma unroll
            for (int k = 0; k < TOPK; ++k) { const float g = gc[k];
#pragma unroll
                for (int j = 0; j < 4; ++j) { const v2u y = ysc[k][j]; mo[j][0] += g * bflo(y.x); mo[j][1] += g * bfhi(y.x); mo[j][2] += g * bflo(y.y); mo[j][3] += g * bfhi(y.y); } }
#pragma unroll
            for (int j = 0; j < 4; ++j) { v[j] = v[j] + m2[j] * mo[j]; xr[64 * j] = v[j]; }
        }
        float ss = 0.f;
#pragma unroll
        for (int j = 0; j < 4; ++j) ss += (v[j][0] * v[j][0] + v[j][1] * v[j][1]) + (v[j][2] * v[j][2] + v[j][3] * v[j][3]);
        const float rstd = __builtin_amdgcn_rsqf(wave_sum(ss) * (1.f / D) + 1e-6f);
        if (l == DEPTH) {
            f32x4* o = (f32x4*)(a.out + (size_t)row * D) + lane;
#pragma unroll
            for (int j = 0; j < 4; ++j) o[64 * j] = v[j] * rstd * ngv[j];
        } else {
            v2u* ho = (v2u*)(H + (size_t)row * D) + lane;
#pragma unroll
            for (int j = 0; j < 4; ++j) { const f32x4 h = v[j] * rstd * ngv[j] * (m1[j] + 1.0f) + m0[j]; v2u o; o.x = pk2(h[0], h[1]); o.y = pk2(h[2], h[3]); ho[64 * j] = o; }
        }
    }
#undef N1_LDYS
}

__device__ __forceinline__ void stage_rw_prep1(const Ctx& F, int l) {
    const auto& a = *F.a; unsigned char* ws = a.ws;
    const bf16* __restrict__ Z = (const bf16*)(ws + WS_Z); bf16* __restrict__ ARW = (bf16*)(ws + WS_ARW);
    const int j = 4 * (F.tid & 63), col = 1536 + j, rq = F.tid >> 6;
    const float* cw = a.in[I_RWCW] + (size_t)l * 3 * 1792;
    const f32x4 w0 = *(const f32x4*)(cw + col), w1 = *(const f32x4*)(cw + 1792 + col), w2 = *(const f32x4*)(cw + 2 * 1792 + col), cb = *(const f32x4*)(a.in[I_RWCB] + l * 1792 + col);
#pragma unroll 4
    for (int row = F.bid * 8 + rq; row < T_ALL; row += F.G * 8) {
        int base, pos, n; row_seq(row, base, pos, n);
        const bf16* zc = Z + (size_t)row * IN_COLS + RW_OFF + col;
        const v2u z0 = *(const v2u*)zc;
        v2u zm = (v2u){0u, 0u}, zp = (v2u){0u, 0u};
        if (pos > 0) zm = *(const v2u*)(zc - IN_COLS);
        if (pos < n - 1) zp = *(const v2u*)(zc + IN_COLS);
        f32x4 v = (f32x4){bflo(zm.x), bfhi(zm.x), bflo(zm.y), bfhi(zm.y)} * w0 + (f32x4){bflo(z0.x), bfhi(z0.x), bflo(z0.y), bfhi(z0.y)} * w1 + (f32x4){bflo(zp.x), bfhi(zp.x), bflo(zp.y), bfhi(zp.y)} * w2 + cb;
#pragma unroll
        for (int e2 = 0; e2 < 4; ++e2) { if (j < 64) v[e2] = tanh_fast(v[e2]); else if (j >= 128) v[e2] = sigm(v[e2]); }
        v2u o; o.x = pk2(v[0], v[1]); o.y = pk2(v[2], v[3]);
        *(v2u*)(ARW + (size_t)row * 256 + j) = o;
    }
}

__device__ __forceinline__ void stage_rw_prep2(const Ctx& F, int l) {
    const auto& a = *F.a; unsigned char* ws = a.ws; const int lane = F.lane;
    const bf16* Z = (const bf16*)(ws + WS_Z); const bf16* P = (const bf16*)(ws + WS_P); bf16* SCN = (bf16*)(ws + WS_SCN);
    const int gw = F.bid * NWAVES + F.wave, NGW = F.G * NWAVES;
    constexpr int TR = 17, NRT = T_ALL / TR;
    const float* cw = a.in[I_RWCW] + (size_t)l * 3 * 1792; const float* cbp = a.in[I_RWCB] + l * 1792;
    for (int tile = gw; tile < NRT * 4; tile += NGW) {
        const int rt = tile % NRT, hp = tile / NRT, row0 = rt * TR, c0 = hp * 128 + 2 * lane;
        f32x2 w[3][3], cb[3];
#pragma unroll
        for (int s = 0; s < 3; ++s) { cb[s] = *(const f32x2*)(cbp + s * 512 + c0);
#pragma unroll
            for (int j = 0; j < 3; ++j) w[s][j] = *(const f32x2*)(cw + j * 1792 + s * 512 + c0); }
        const f32x2 KKw = *(const f32x2*)(a.in[I_RWKK] + l * 512 + c0), KAw = *(const f32x2*)(a.in[I_RWKA] + l * 512 + c0);
        f32x2 W0[2], A0[2];
#pragma unroll
        for (int d = 0; d < 2; ++d) { W0[d] = *(const f32x2*)(a.in[I_RWW0] + (l * 2 + d) * 512 + c0); A0[d] = *(const f32x2*)(a.in[I_RWA0] + (l * 2 + d) * 512 + c0); }
        const unsigned* zb = (const unsigned*)(Z + RW_OFF + c0);
        unsigned zw[8][3], pw_[8][4];
#define P2_LDZ(j_) do { const int rr_ = row0 + (j_); if (rr_ >= 0 && rr_ < T_ALL) { _Pragma("unroll") for (int s = 0; s < 3; ++s) zw[((j_) + 1) & 7][s] = zb[(size_t)rr_ * (IN_COLS / 2) + s * 256]; } \
        else { _Pragma("unroll") for (int s = 0; s < 3; ++s) zw[((j_) + 1) & 7][s] = 0u; } } while (0)
#define P2_LDP(j_) do { const unsigned* pr_ = (const unsigned*)(P + (size_t)(row0 + (j_)) * 2560 + c0); pw_[(j_) & 7][0] = pr_[0]; pw_[(j_) & 7][1] = pr_[512]; pw_[(j_) & 7][2] = pr_[256]; pw_[(j_) & 7][3] = pr_[768]; } while (0)
        P2_LDZ(-1); P2_LDZ(0); P2_LDZ(1); P2_LDZ(2); P2_LDZ(3); P2_LDP(0); P2_LDP(1); P2_LDP(2);
#pragma unroll
        for (int i = 0; i < TR; ++i) {
            const int row = row0 + i; int base, pos, n; row_seq(row, base, pos, n);
            if (i + 4 <= TR) P2_LDZ(i + 4);
            if (i + 3 < TR) P2_LDP(i + 3);
            unsigned zm[3], z0[3], zp[3], pc_[4];
#pragma unroll
            for (int s = 0; s < 3; ++s) { zm[s] = zw[i & 7][s]; z0[s] = zw[(i + 1) & 7][s]; zp[s] = zw[(i + 2) & 7][s]; }
#pragma unroll
            for (int e = 0; e < 4; ++e) pc_[e] = pw_[i & 7][e];
            const float mlo = pos > 0 ? 1.f : 0.f, mhi = pos < n - 1 ? 1.f : 0.f;
            f32x2 u[3];
#pragma unroll
            for (int s = 0; s < 3; ++s) u[s] = (f32x2){bflo(zm[s]), bfhi(zm[s])} * mlo * w[s][0] + (f32x2){bflo(z0[s]), bfhi(z0[s])} * w[s][1] + (f32x2){bflo(zp[s]), bfhi(zp[s])} * mhi * w[s][2] + cb[s];
            const f32x2 r = u[0], k = u[1], v = u[2];
            f32x2 kk = k * KKw;
            const float ss = red32(kk[0] * kk[0] + kk[1] * kk[1]);
            kk = kk * (__builtin_amdgcn_rsqf(fmaxf(ss, 1e-24f)));
            unsigned* o = (unsigned*)(SCN + (size_t)row * 9 * 512 + c0);
            o[0] = pk2(r[0], r[1]); o[256] = pk2(v[0], v[1]); o[2 * 256] = pk2(kk[0], kk[1]);
#pragma unroll
            for (int d = 0; d < 2; ++d) {
                const unsigned pw = pc_[2 * d], pa = pc_[2 * d + 1];
                float ld[2], kd[2], be[2];
#pragma unroll
                for (int e = 0; e < 2; ++e) {
                    const float uu = W0[d][e] + (e ? bfhi(pw) : bflo(pw));
                    ld[e] = -0.60653065971263342f * sigm(uu);
                    const float av = sigm(A0[d][e] + (e ? bfhi(pa) : bflo(pa)));
                    kd[e] = k[e] * (1.f + (av - 1.f) * KAw[e]); be[e] = kk[e] * av; }
                o[(3 + 3 * d) * 256] = pk2(ld[0], ld[1]); o[(4 + 3 * d) * 256] = pk2(kd[0], kd[1]); o[(5 + 3 * d) * 256] = pk2(be[0], be[1]);
            }
        }
    }
}
#undef P2_LDZ
#undef P2_LDP

__device__ __forceinline__ int seq_row(int b, int d, int sidx) {
    if (sidx < CTXL) { const int t = d ? (CTXL - 1 - sidx) : sidx; return T_LAT + b * CTXL + t; }
    const int tl = sidx - CTXL; const int t = d ? (SEQ - 1 - tl) : tl; return b * SEQ + t;
}

constexpr int CW_WORK = 16384;
constexpr int CW_STAMP = 20480;
#ifdef PROBE_T
#ifndef PROBE_BID
#define PROBE_BID 0
#endif
#define PT(k) do { if (F.bid == PROBE_BID && F.tid == 0 && l == 0) ((unsigned long long*)(F.a->ws + WS_CTL + CW_STAMP * 4))[k] = __builtin_amdgcn_s_memrealtime(); } while (0)
#else
#define PT(k) do { } while (0)
#endif
__device__ __forceinline__ void rw_scan_item(const Ctx& F, int l, int it2) {
    const int it = it2 >> 1, half = it2 & 1;
    const auto& a = *F.a; unsigned char* ws = a.ws; const int tid = F.tid, lane = F.lane;
    const bf16* SCN = (const bf16*)(ws + WS_SCN); float* YD = (float*)(ws + WS_YDIR);
    LAS float* sbuf = (LAS float*)F.lds;
    LAS float* ybuf = (LAS float*)(F.lds + 49152);
    const bool comp = F.wave < 4;
    const int lt = tid & 255, ls = lt >> 4, lj = lt & 15;
    const int vl = lane >> 3, kq = lane & 7, vrow = half * 32 + (F.wave & 3) * 8 + vl;
    constexpr int NCH = (CTXL + SEQ) / 16;
    const int d = it & 1, h = (it >> 1) & 7, b = it >> 4;
    f32x2 S[4];
#pragma unroll
    for (int q = 0; q < 4; ++q) S[q] = (f32x2){0.f, 0.f};
    v2u ldr[6];
#define RW_ISSUE(c) do { const int row_ = seq_row(b, d, (c) * 16 + ls); const v2u* p_ = (const v2u*)(SCN + (size_t)row_ * 9 * 512 + h * 64) + lj; \
        ldr[0] = p_[2 * 128]; ldr[1] = p_[(3 + 3 * d) * 128]; ldr[2] = p_[(5 + 3 * d) * 128]; ldr[3] = p_[(4 + 3 * d) * 128]; ldr[4] = p_[0]; ldr[5] = p_[128]; } while (0)
#define RW_WRITE(bufi) do { LAS float* o_ = sbuf + (((bufi) * 16 + ls) * 6) * 64 + 4 * lj; \
        *(LAS f32x4*)(o_) = (f32x4){-bflo(ldr[0].x), -bfhi(ldr[0].x), -bflo(ldr[0].y), -bfhi(ldr[0].y)}; \
        *(LAS f32x4*)(o_ + 64) = (f32x4){__expf(bflo(ldr[1].x)), __expf(bfhi(ldr[1].x)), __expf(bflo(ldr[1].y)), __expf(bfhi(ldr[1].y))}; \
        *(LAS f32x4*)(o_ + 128) = (f32x4){bflo(ldr[2].x), bfhi(ldr[2].x), bflo(ldr[2].y), bfhi(ldr[2].y)}; *(LAS f32x4*)(o_ + 192) = (f32x4){bflo(ldr[3].x), bfhi(ldr[3].x), bflo(ldr[3].y), bfhi(ldr[3].y)}; \
        *(LAS f32x4*)(o_ + 256) = (f32x4){bflo(ldr[4].x), bfhi(ldr[4].x), bflo(ldr[4].y), bfhi(ldr[4].y)}; *(LAS f32x4*)(o_ + 320) = (f32x4){bflo(ldr[5].x), bfhi(ldr[5].x), bflo(ldr[5].y), bfhi(ldr[5].y)}; } while (0)
#define RW_FLUSH(c) do { const int row_ = seq_row(b, d, (c) * 16 + ls); \
        *(f32x2*)(YD + ((size_t)d * T_ALL + row_) * 512 + h * 64 + half * 32 + 2 * lj) = *(const LAS f32x2*)(ybuf + ((((c) & 1) * 16 + ls) * 64) + half * 32 + 2 * lj); } while (0)
    if (!comp) { RW_ISSUE(0); RW_WRITE(0); RW_ISSUE(1); }
    __syncthreads();
#pragma unroll 1
    for (int c = 0; c < NCH; ++c) {
        const int bi = c & 1;
        if (!comp) {
            if (c + 1 < NCH) RW_WRITE(bi ^ 1);
            if (c + 2 < NCH) RW_ISSUE(c + 2);
            if (c > 0) RW_FLUSH(c - 1);
        } else {
        float yv[16];
        f32x4 opA[10], opB[10]; float vvA, vvB;
#define RW_LD(op, vvx, s_) do { const LAS float* sp_ = sbuf + ((bi * 16 + (s_)) * 6) * 64 + 8 * kq; \
            _Pragma("unroll") for (int q_ = 0; q_ < 5; ++q_) { op[2 * q_] = *(const LAS f32x4*)(sp_ + 64 * q_); op[2 * q_ + 1] = *(const LAS f32x4*)(sp_ + 64 * q_ + 4); } \
            vvx = sbuf[((bi * 16 + (s_)) * 6 + 5) * 64 + vrow]; } while (0)
#define RW_COMP(op, vvx, s_) do { \
            const f32x4 a0 = op[0], a1 = op[1], w0 = op[2], w1 = op[3], b0 = op[4], b1 = op[5], k0 = op[6], k1 = op[7], r0 = op[8], r1 = op[9]; \
            const f32x2 vv2 = (f32x2){vvx, vvx}; \
            const f32x2 p0 = S[1] * (f32x2){a0[2], a0[3]} + S[0] * (f32x2){a0[0], a0[1]}; \
            const f32x2 p1 = S[3] * (f32x2){a1[2], a1[3]} + S[2] * (f32x2){a1[0], a1[1]}; \
            const f32x2 t0 = S[0] * (f32x2){w0[0], w0[1]} + vv2 * (f32x2){k0[0], k0[1]}; \
            const f32x2 t1 = S[1] * (f32x2){w0[2], w0[3]} + vv2 * (f32x2){k0[2], k0[3]}; \
            const f32x2 t2 = S[2] * (f32x2){w1[0], w1[1]} + vv2 * (f32x2){k1[0], k1[1]}; \
            const f32x2 t3 = S[3] * (f32x2){w1[2], w1[3]} + vv2 * (f32x2){k1[2], k1[3]}; \
            const f32x2 ac = p0 + p1; \
            const float sa = red8(ac[0] + ac[1]); \
            const f32x2 sa2 = (f32x2){sa, sa}; \
            S[0] = sa2 * (f32x2){b0[0], b0[1]} + t0; S[1] = sa2 * (f32x2){b0[2], b0[3]} + t1; \
            S[2] = sa2 * (f32x2){b1[0], b1[1]} + t2; S[3] = sa2 * (f32x2){b1[2], b1[3]} + t3; \
            const f32x2 q0 = S[1] * (f32x2){r0[2], r0[3]} + S[0] * (f32x2){r0[0], r0[1]}; \
            const f32x2 q1 = S[3] * (f32x2){r1[2], r1[3]} + S[2] * (f32x2){r1[0], r1[1]}; \
            const f32x2 yc = q0 + q1; \
            yv[s_] = red8(yc[0] + yc[1]); } while (0)
        RW_LD(opA, vvA, 0);
#pragma unroll
        for (int s = 0; s < 16; s += 2) {
            RW_LD(opB, vvB, s + 1);
            __builtin_amdgcn_sched_barrier(0);
            RW_COMP(opA, vvA, s);
            __builtin_amdgcn_sched_barrier(0);
            if (s + 2 < 16) RW_LD(opA, vvA, s + 2);
            __builtin_amdgcn_sched_barrier(0);
            RW_COMP(opB, vvB, s + 1);
            __builtin_amdgcn_sched_barrier(0);
        }
#undef RW_LD
#undef RW_COMP
#pragma unroll
        for (int s = 0; s < 16; ++s) if ((s & 7) == kq) ybuf[((bi * 16 + s) * 64) + vrow] = yv[s];
        }
        __syncthreads();
    }
    if (!comp) RW_FLUSH(NCH - 1);
    __syncthreads();
#undef RW_ISSUE
#undef RW_WRITE
#undef RW_FLUSH
}

constexpr size_t WS_RWSCR = WS_YHY;
constexpr int RWS_QY = 0, RWS_YV = 2048, RWS_PZ = 4096, RWS_ZV = 12288, RWS_SLOT = 20480;
typedef __bf16 bf16x8n __attribute__((ext_vector_type(8)));
__device__ __forceinline__ f32x4 mma16(const bf16x8 a, const bf16x8 b, const f32x4 c) { return __builtin_amdgcn_mfma_f32_16x16x32_bf16(a, b, c, 0, 0, 0); }
__device__ __forceinline__ float dpp_shr(float x, const int n) {
    const int v = __builtin_bit_cast(int, x); int r;
    if (n == 1) r = __builtin_amdgcn_update_dpp(0, v, 0x111, 0xF, 0xF, true); else if (n == 2) r = __builtin_amdgcn_update_dpp(0, v, 0x112, 0xF, 0xF, true);
    else if (n == 4) r = __builtin_amdgcn_update_dpp(0, v, 0x114, 0xF, 0xF, true); else r = __builtin_amdgcn_update_dpp(0, v, 0x118, 0xF, 0xF, true);
    return __builtin_bit_cast(float, r);
}
__device__ __forceinline__ v4u pack8(const float (&x)[8]) { v4u o; o.x = pk2(x[0], x[1]); o.y = pk2(x[2], x[3]); o.z = pk2(x[4], x[5]); o.w = pk2(x[6], x[7]); return o; }
__device__ __forceinline__ void unpack8(const v4u u, float (&x)[8]) { x[0] = bflo(u.x); x[1] = bfhi(u.x); x[2] = bflo(u.y); x[3] = bfhi(u.y); x[4] = bflo(u.z); x[5] = bfhi(u.z); x[6] = bflo(u.w); x[7] = bfhi(u.w); }
constexpr int LDS_ZERO16 = 131072 + 3072;
__device__ __forceinline__ bf16x8 frag16z(const LAS bf16* m, int rowbase, int lane, const LAS v4u* z) {
    const LAS v4u* p = (const LAS v4u*)(m + (rowbase + (lane & 15)) * 16 + 8 * (lane >> 4));
    const v4u v = *(((lane >> 4) < 2) ? p : z); return __builtin_bit_cast(bf16x8, v); }
#define frag16(m_, rb_, ln_) frag16z(m_, rb_, ln_, zp16)
__device__ __forceinline__ void st_colmaj(LAS bf16* m, int colbase, const f32x4 d, int lane) {
    v2u o; o.x = pk2(d[0], d[1]); o.y = pk2(d[2], d[3]); *(LAS v2u*)(m + (colbase + (lane & 15)) * 16 + 4 * (lane >> 4)) = o; }
__device__ __forceinline__ void st_rowmaj(LAS bf16* m, const f32x4 d, int lane) {
#pragma unroll
    for (int r = 0; r < 4; ++r) m[(4 * (lane >> 4) + r) * 16 + (lane & 15)] = (bf16)f2bf(d[r]); }
template <int KS0, int KS1>
__device__ __forceinline__ void rw_chunk_load(const Ctx& F, int b, int h, int d, int cidx, v4u (&raw)[12]) {
    const int lane = opaque_v(F.lane), t = lane & 15, kg = lane >> 4;
    const bf16* base = (const bf16*)(F.a->ws + WS_SCN) + (size_t)seq_row(b, d, 16 * cidx + t) * 9 * 512 + h * 64;
#pragma unroll
    for (int ks = KS0; ks < KS1; ++ks) { const int off = 32 * ks + 8 * kg;
        raw[6 * ks + 0] = *(const v4u*)(base + (3 + 3 * d) * 512 + off); raw[6 * ks + 1] = *(const v4u*)(base + 2 * 512 + off); raw[6 * ks + 2] = *(const v4u*)(base + off);
        raw[6 * ks + 3] = *(const v4u*)(base + (5 + 3 * d) * 512 + off); raw[6 * ks + 4] = *(const v4u*)(base + (4 + 3 * d) * 512 + off); raw[6 * ks + 5] = *(const v4u*)(base + 512 + off); }
}
__device__ __forceinline__ void rw_chunk_task(const Ctx& F, const v4u (&raw)[12], LAS unsigned char* wl, unsigned char* slot) {
    const LAS v4u* zp16 = (const LAS v4u*)(F.lds + LDS_ZERO16);
    const int lane = opaque_v(F.lane), t = lane & 15, kg = lane >> 4;
    LAS bf16* ATt = (LAS bf16*)(wl); LAS bf16* RBr = (LAS bf16*)(wl + 2048); LAS bf16* BHt = (LAS bf16*)(wl + 4096); LAS bf16* KHt = (LAS bf16*)(wl + 6144); LAS bf16* VTt = (LAS bf16*)(wl + 8192);
    LAS bf16* WAt = (LAS bf16*)(wl + 10240); LAS bf16* N_r = (LAS bf16*)(wl + 12288); LAS bf16* N_c = (LAS bf16*)(wl + 12800); LAS bf16* T_r = (LAS bf16*)(wl + 13312);
    LAS bf16* AK_r = (LAS bf16*)(wl + 13824); LAS bf16* RB2 = (LAS bf16*)(wl + 14336); LAS bf16* RK_r = (LAS bf16*)(wl + 14848); LAS float* GCl = (LAS float*)(wl + 15360);
    bf16x8 fAb[2], fRb[2], fBb[2], fKb[2];
#pragma unroll
    for (int ks = 0; ks < 2; ++ks) {
        const int off = 32 * ks + 8 * kg;
        float ea[8], er[8], eb[8], eh[8];
        { const v4u uld = raw[6 * ks + 0]; float ld[8]; unpack8(uld, ld);
#pragma unroll
          for (int j = 0; j < 8; ++j) { float c = ld[j]; c += dpp_shr(c, 1); c += dpp_shr(c, 2); c += dpp_shr(c, 4); c += dpp_shr(c, 8);
              const float tot = __builtin_bit_cast(float, __builtin_amdgcn_ds_bpermute((lane | 15) << 2, __builtin_bit_cast(int, c)));
              ea[j] = __expf(c - ld[j]); er[j] = __expf(c); eb[j] = __expf(-c); eh[j] = __expf(tot - c);
              if (t == 0) GCl[off + j] = __expf(tot); } }
        { const v4u u = raw[6 * ks + 1]; float x[8]; unpack8(u, x);
#pragma unroll
          for (int j = 0; j < 8; ++j) { x[j] = -x[j] * ea[j]; ATt[(off + j) * 16 + t] = (bf16)f2bf(x[j]); }
          const v4u p = pack8(x); fAb[ks] = __builtin_bit_cast(bf16x8, p); }
        { const v4u u = raw[6 * ks + 2]; float x[8]; unpack8(u, x);
#pragma unroll
          for (int j = 0; j < 8; ++j) x[j] = x[j] * er[j];
          const v4u p = pack8(x); fRb[ks] = __builtin_bit_cast(bf16x8, p); *(LAS v4u*)(RBr + t * 64 + off) = p; }
        { const v4u u = raw[6 * ks + 3]; float x[8], y[8]; unpack8(u, x);
#pragma unroll
          for (int j = 0; j < 8; ++j) { y[j] = x[j] * eb[j]; BHt[(off + j) * 16 + t] = (bf16)f2bf(x[j] * eh[j]); }
          const v4u p = pack8(y); fBb[ks] = __builtin_bit_cast(bf16x8, p); }
        { const v4u u = raw[6 * ks + 4]; float x[8], y[8]; unpack8(u, x);
#pragma unroll
          for (int j = 0; j < 8; ++j) { y[j] = x[j] * eb[j]; KHt[(off + j) * 16 + t] = (bf16)f2bf(x[j] * eh[j]); }
          const v4u p = pack8(y); fKb[ks] = __builtin_bit_cast(bf16x8, p); }
        { const v4u u = raw[6 * ks + 5];
          const bf16 e0 = (bf16)(u.x & 0xffff), e1 = (bf16)(u.x >> 16), e2 = (bf16)(u.y & 0xffff), e3 = (bf16)(u.y >> 16), e4 = (bf16)(u.z & 0xffff), e5 = (bf16)(u.z >> 16), e6 = (bf16)(u.w & 0xffff), e7 = (bf16)(u.w >> 16);
          VTt[(off + 0) * 16 + t] = e0; VTt[(off + 1) * 16 + t] = e1; VTt[(off + 2) * 16 + t] = e2; VTt[(off + 3) * 16 + t] = e3; VTt[(off + 4) * 16 + t] = e4; VTt[(off + 5) * 16 + t] = e5; VTt[(off + 6) * 16 + t] = e6; VTt[(off + 7) * 16 + t] = e7; }
        __builtin_amdgcn_sched_barrier(0);
    }
    asm volatile("" ::: "memory");
    const f32x4 z4 = (f32x4){0.f, 0.f, 0.f, 0.f};
    f32x4 n0 = mma16(fAb[1], fBb[1], mma16(fAb[0], fBb[0], z4)), aak = mma16(fAb[1], fKb[1], mma16(fAb[0], fKb[0], z4));
    f32x4 arb = mma16(fRb[1], fBb[1], mma16(fRb[0], fBb[0], z4)), ark = mma16(fRb[1], fKb[1], mma16(fRb[0], fKb[0], z4));
#pragma unroll
    for (int r = 0; r < 4; ++r) { const int tt = 4 * kg + r; if (!(t < tt)) { n0[r] = 0.f; aak[r] = 0.f; } if (!(t <= tt)) { arb[r] = 0.f; ark[r] = 0.f; } }
    st_rowmaj(AK_r, aak, lane); st_rowmaj(RB2, arb, lane); st_rowmaj(RK_r, ark, lane); asm volatile("" ::: "memory");
    f32x4 accT = n0;
#pragma unroll
    for (int r = 0; r < 4; ++r) accT[r] += (4 * kg + r == t) ? 1.f : 0.f;
    f32x4 nn = n0;
#pragma unroll
    for (int itn = 0; itn < 3; ++itn) {
        st_rowmaj(N_r, nn, lane); st_colmaj(N_c, 0, nn, lane); st_rowmaj(T_r, accT, lane); asm volatile("" ::: "memory");
        const bf16x8 fa = frag16(N_r, 0, lane), fb = frag16(N_c, 0, lane), ft = frag16(T_r, 0, lane);
        nn = mma16(fa, fb, z4); asm volatile("" ::: "memory");
        st_colmaj(N_c, 0, nn, lane); asm volatile("" ::: "memory");
        const bf16x8 fb2 = frag16(N_c, 0, lane);
        accT = mma16(ft, fb2, accT); asm volatile("" ::: "memory");
    }
    st_rowmaj(T_r, accT, lane); asm volatile("" ::: "memory");
    const bf16x8 fT = frag16(T_r, 0, lane), fAK = frag16(AK_r, 0, lane), fARB = frag16(RB2, 0, lane), fARK = frag16(RK_r, 0, lane);
#pragma unroll
    for (int kt = 0; kt < 4; ++kt) { const f32x4 dd = mma16(fT, frag16(ATt, 16 * kt, lane), z4); st_colmaj(WAt, 16 * kt, dd, lane); } asm volatile("" ::: "memory");
    { const bf16x8 fArbT = frag16(RB2, 0, lane);
#pragma unroll
      for (int kt = 0; kt < 4; ++kt) { const v2u ri = *(const LAS v2u*)(RBr + t * 64 + 16 * kt + 4 * kg);
          f32x4 c0 = (f32x4){bflo(ri.x), bfhi(ri.x), bflo(ri.y), bfhi(ri.y)};
          c0 = mma16(frag16(WAt, 16 * kt, lane), fArbT, c0);
          v2u o; o.x = pk2(c0[0], c0[1]); o.y = pk2(c0[2], c0[3]); *(v2u*)(slot + RWS_QY + (t * 64 + 16 * kt + 4 * kg) * 2) = o; } }
    asm volatile("" ::: "memory");
#pragma unroll
    for (int vt = 0; vt < 4; ++vt) { const f32x4 dd = mma16(fAK, frag16(VTt, 16 * vt, lane), z4); st_colmaj(ATt, 16 * vt, dd, lane); } asm volatile("" ::: "memory");
    asm volatile("" ::: "memory");
    LAS bf16* UVt = RBr;
#pragma unroll
    for (int vt = 0; vt < 4; ++vt) { const f32x4 dd = mma16(fT, frag16(ATt, 16 * vt, lane), z4); st_colmaj(UVt, 16 * vt, dd, lane); } asm volatile("" ::: "memory");
#pragma unroll
    for (int vt = 0; vt < 4; ++vt) { const f32x4 dd = mma16(fARK, frag16(VTt, 16 * vt, lane), mma16(fARB, frag16(UVt, 16 * vt, lane), z4));
        v2u o; o.x = pk2(dd[0], dd[1]); o.y = pk2(dd[2], dd[3]); *(v2u*)(slot + RWS_YV + ((16 * vt + t) * 16 + 4 * kg) * 2) = o; }
#pragma unroll
    for (int ktp = 0; ktp < 4; ++ktp) { const bf16x8 fBh = frag16(BHt, 16 * ktp, lane);
#pragma unroll
        for (int kt = 0; kt < 4; ++kt) { f32x4 dd = mma16(frag16(WAt, 16 * kt, lane), fBh, z4);
            if (kt == ktp) {
#pragma unroll
                for (int r = 0; r < 4; ++r) if (4 * kg + r == t) dd[r] += GCl[16 * kt + t]; }
            v2u o; o.x = pk2(dd[0], dd[1]); o.y = pk2(dd[2], dd[3]); *(v2u*)(slot + RWS_PZ + ((16 * ktp + t) * 64 + 16 * kt + 4 * kg) * 2) = o; } }
#pragma unroll
    for (int vt = 0; vt < 4; ++vt) { const bf16x8 fU = frag16(UVt, 16 * vt, lane), fV = frag16(VTt, 16 * vt, lane);
#pragma unroll
        for (int ktp = 0; ktp < 4; ++ktp) { const f32x4 dd = mma16(frag16(KHt, 16 * ktp, lane), fV, mma16(frag16(BHt, 16 * ktp, lane), fU, z4));
            v2u o; o.x = pk2(dd[0], dd[1]); o.y = pk2(dd[2], dd[3]); *(v2u*)(slot + RWS_ZV + ((16 * vt + t) * 64 + 16 * ktp + 4 * kg) * 2) = o; } }
}
__device__ __forceinline__ void rw_chunk_task2(const Ctx& F, const v4u (&raw)[12], LAS unsigned char* wl, f32x4 (&yv)[4], f32x4 (&zv)[4][4]) {
    const LAS v4u* zp16 = (const LAS v4u*)(F.lds + LDS_ZERO16);
    const int lane = opaque_v(F.lane), t = lane & 15, kg = lane >> 4;
    LAS bf16* ATt = (LAS bf16*)(wl); LAS bf16* RBr = (LAS bf16*)(wl + 2048); LAS bf16* BHt = (LAS bf16*)(wl + 4096); LAS bf16* KHt = (LAS bf16*)(wl + 6144); LAS bf16* VTt = (LAS bf16*)(wl + 8192);
    LAS bf16* WAt = (LAS bf16*)(wl + 10240); LAS bf16* N_r = (LAS bf16*)(wl + 12288); LAS bf16* N_c = (LAS bf16*)(wl + 12800); LAS bf16* T_r = (LAS bf16*)(wl + 13312);
    LAS bf16* AK_r = (LAS bf16*)(wl + 13824); LAS bf16* RB2 = (LAS bf16*)(wl + 14336); LAS bf16* RK_r = (LAS bf16*)(wl + 14848); LAS float* GCl = (LAS float*)(wl + 15360);
    bf16x8 fAb[2], fRb[2], fBb[2], fKb[2];
#pragma unroll
    for (int ks = 0; ks < 2; ++ks) {
        const int off = 32 * ks + 8 * kg;
        float ea[8], er[8], eb[8], eh[8];
        { const v4u uld = raw[6 * ks + 0]; float ld[8]; unpack8(uld, ld);
#pragma unroll
          for (int j = 0; j < 8; ++j) { float c = ld[j]; c += dpp_shr(c, 1); c += dpp_shr(c, 2); c += dpp_shr(c, 4); c += dpp_shr(c, 8);
              const float tot = __builtin_bit_cast(float, __builtin_amdgcn_ds_bpermute((lane | 15) << 2, __builtin_bit_cast(int, c)));
              ea[j] = __expf(c - ld[j]); er[j] = __expf(c); eb[j] = __expf(-c); const float et_ = __expf(tot); eh[j] = et_ * eb[j];
              if (t == 0) GCl[off + j] = et_; } }
        { const v4u u = raw[6 * ks + 1]; float x[8]; unpack8(u, x);
#pragma unroll
          for (int j = 0; j < 8; ++j) { x[j] = -x[j] * ea[j]; ATt[(off + j) * 16 + t] = (bf16)f2bf(x[j]); }
          const v4u p = pack8(x); fAb[ks] = __builtin_bit_cast(bf16x8, p); }
        { const v4u u = raw[6 * ks + 2]; float x[8]; unpack8(u, x);
#pragma unroll
          for (int j = 0; j < 8; ++j) x[j] = x[j] * er[j];
          const v4u p = pack8(x); fRb[ks] = __builtin_bit_cast(bf16x8, p); *(LAS v4u*)(RBr + t * 64 + off) = p; }
        { const v4u u = raw[6 * ks + 3]; float x[8], y[8]; unpack8(u, x);
#pragma unroll
          for (int j = 0; j < 8; ++j) { y[j] = x[j] * eb[j]; BHt[(off + j) * 16 + t] = (bf16)f2bf(x[j] * eh[j]); }
          const v4u p = pack8(y); fBb[ks] = __builtin_bit_cast(bf16x8, p); }
        { const v4u u = raw[6 * ks + 4]; float x[8], y[8]; unpack8(u, x);
#pragma unroll
          for (int j = 0; j < 8; ++j) { y[j] = x[j] * eb[j]; KHt[(off + j) * 16 + t] = (bf16)f2bf(x[j] * eh[j]); }
          const v4u p = pack8(y); fKb[ks] = __builtin_bit_cast(bf16x8, p); }
        { const v4u u = raw[6 * ks + 5];
          const bf16 e0 = (bf16)(u.x & 0xffff), e1 = (bf16)(u.x >> 16), e2 = (bf16)(u.y & 0xffff), e3 = (bf16)(u.y >> 16), e4 = (bf16)(u.z & 0xffff), e5 = (bf16)(u.z >> 16), e6 = (bf16)(u.w & 0xffff), e7 = (bf16)(u.w >> 16);
          VTt[(off + 0) * 16 + t] = e0; VTt[(off + 1) * 16 + t] = e1; VTt[(off + 2) * 16 + t] = e2; VTt[(off + 3) * 16 + t] = e3; VTt[(off + 4) * 16 + t] = e4; VTt[(off + 5) * 16 + t] = e5; VTt[(off + 6) * 16 + t] = e6; VTt[(off + 7) * 16 + t] = e7; }
        __builtin_amdgcn_sched_barrier(0);
    }
    asm volatile("" ::: "memory");
    const f32x4 z4 = (f32x4){0.f, 0.f, 0.f, 0.f};
    f32x4 n0 = mma16(fAb[1], fBb[1], mma16(fAb[0], fBb[0], z4)), aak = mma16(fAb[1], fKb[1], mma16(fAb[0], fKb[0], z4));
    f32x4 arb = mma16(fRb[1], fBb[1], mma16(fRb[0], fBb[0], z4)), ark = mma16(fRb[1], fKb[1], mma16(fRb[0], fKb[0], z4));
#pragma unroll
    for (int r = 0; r < 4; ++r) { const int tt = 4 * kg + r; if (!(t < tt)) { n0[r] = 0.f; aak[r] = 0.f; } if (!(t <= tt)) { arb[r] = 0.f; ark[r] = 0.f; } }
    st_rowmaj(AK_r, aak, lane); st_rowmaj(RB2, arb, lane); st_rowmaj(RK_r, ark, lane); asm volatile("" ::: "memory");
    f32x4 accT = n0;
#pragma unroll
    for (int r = 0; r < 4; ++r) accT[r] += (4 * kg + r == t) ? 1.f : 0.f;
    f32x4 nn = n0;
#pragma unroll
    for (int itn = 0; itn < 3; ++itn) {
        st_rowmaj(N_r, nn, lane); st_colmaj(N_c, 0, nn, lane); st_rowmaj(T_r, accT, lane); asm volatile("" ::: "memory");
        const bf16x8 fa = frag16(N_r, 0, lane), fb = frag16(N_c, 0, lane), ft = frag16(T_r, 0, lane);
        nn = mma16(fa, fb, z4); asm volatile("" ::: "memory");
        st_colmaj(N_c, 0, nn, lane); asm volatile("" ::: "memory");
        const bf16x8 fb2 = frag16(N_c, 0, lane);
        accT = mma16(ft, fb2, accT); asm volatile("" ::: "memory");
    }
    st_rowmaj(T_r, accT, lane); asm volatile("" ::: "memory");
    const bf16x8 fT = frag16(T_r, 0, lane), fAK = frag16(AK_r, 0, lane), fARB = frag16(RB2, 0, lane), fARK = frag16(RK_r, 0, lane);
#pragma unroll
    for (int kt = 0; kt < 4; ++kt) { const f32x4 dd = mma16(fT, frag16(ATt, 16 * kt, lane), z4); st_colmaj(WAt, 16 * kt, dd, lane); } asm volatile("" ::: "memory");
    f32x4 qy[4];
    { const bf16x8 fArbT = frag16(RB2, 0, lane);
#pragma unroll
      for (int kt = 0; kt < 4; ++kt) { const v2u ri = *(const LAS v2u*)(RBr + t * 64 + 16 * kt + 4 * kg);
          qy[kt] = mma16(frag16(WAt, 16 * kt, lane), fArbT, (f32x4){bflo(ri.x), bfhi(ri.x), bflo(ri.y), bfhi(ri.y)}); } }
    asm volatile("" ::: "memory");
#pragma unroll
    for (int vt = 0; vt < 4; ++vt) { const f32x4 dd = mma16(fAK, frag16(VTt, 16 * vt, lane), z4); st_colmaj(ATt, 16 * vt, dd, lane); } asm volatile("" ::: "memory");
    LAS bf16* UVt = RBr;
#pragma unroll
    for (int vt = 0; vt < 4; ++vt) { const f32x4 dd = mma16(fT, frag16(ATt, 16 * vt, lane), z4); st_colmaj(UVt, 16 * vt, dd, lane); } asm volatile("" ::: "memory");
#pragma unroll
    for (int vt = 0; vt < 4; ++vt) { const bf16x8 fU = frag16(UVt, 16 * vt, lane), fV = frag16(VTt, 16 * vt, lane);
        yv[vt] = mma16(fARK, fV, mma16(fARB, fU, z4));
#pragma unroll
        for (int ktp = 0; ktp < 4; ++ktp) zv[vt][ktp] = mma16(frag16(KHt, 16 * ktp, lane), fV, mma16(frag16(BHt, 16 * ktp, lane), fU, z4)); }
    f32x4 pz[4][4];
#pragma unroll
    for (int ktp = 0; ktp < 4; ++ktp) { const bf16x8 fBh = frag16(BHt, 16 * ktp, lane);
#pragma unroll
        for (int kt = 0; kt < 4; ++kt) { f32x4 dd = mma16(frag16(WAt, 16 * kt, lane), fBh, z4);
            if (kt == ktp) {
#pragma unroll
                for (int r = 0; r < 4; ++r) if (4 * kg + r == t) dd[r] += GCl[16 * kt + t]; }
            pz[ktp][kt] = dd; } }
    asm volatile("s_waitcnt lgkmcnt(0)" ::: "memory");
#pragma unroll
    for (int ktp = 0; ktp < 4; ++ktp) { LAS bf16* reg = (LAS bf16*)(wl + (ktp < 2 ? ktp * 2048 : (ktp + 1) * 2048));
#pragma unroll
        for (int kt = 0; kt < 4; ++kt) { v2u o; o.x = pk2(pz[ktp][kt][0], pz[ktp][kt][1]); o.y = pk2(pz[ktp][kt][2], pz[ktp][kt][3]); *(LAS v2u*)(reg + t * 64 + 16 * kt + 4 * kg) = o; } }
#pragma unroll
    for (int kt = 0; kt < 4; ++kt) { v2u o; o.x = pk2(qy[kt][0], qy[kt][1]); o.y = pk2(qy[kt][2], qy[kt][3]); *(LAS v2u*)(BHt + t * 64 + 16 * kt + 4 * kg) = o; }
    asm volatile("s_waitcnt lgkmcnt(0)" ::: "memory");
}
constexpr int RWZ_OFF = LDSCTL_OFF + 8192, RWF_OFF = LDSCTL_OFF + 2048;
__device__ __forceinline__ void rw_chunk_item2(const Ctx& F, int l, int it, size_t yoff = WS_YDIR) {
    const auto& a = *F.a; unsigned char* ws = a.ws; const int lane = opaque_v(F.lane), t = lane & 15, kg = lane >> 4;
    const int d = it & 1, h = (it >> 1) & 7, b = it >> 4;
    float* YD = (float*)(ws + yoff);
    LAS unsigned char* wl = F.lds + F.wave * 15616;
    LAS bf16* ZS = (LAS bf16*)(F.lds + RWZ_OFF);
    volatile LAS int* flag = (volatile LAS int*)(F.lds + RWF_OFF);
    for (int i = F.tid; i < 2048; i += NTHREADS) ((LAS unsigned*)ZS)[i] = 0u;
    if (F.tid == 0) *flag = 0;
    __syncthreads();
    constexpr int NCHK = (CTXL + SEQ) / 16;
    v4u raw[12];
    rw_chunk_load<0, 2>(F, b, h, d, F.wave, raw);
#pragma unroll 1
    for (int c = F.wave; c < NCHK; c += NWAVES) {
        f32x4 yv[4], zv[4][4];
        rw_chunk_task2(F, raw, wl, yv, zv);
        if (c + NWAVES < NCHK) rw_chunk_load<0, 2>(F, b, h, d, c + NWAVES, raw);
        while (*flag < c) __builtin_amdgcn_s_sleep(1);
        asm volatile("" ::: "memory");
        const LAS bf16* Zc = ZS + (c & 1) * 4096; LAS bf16* Zn = ZS + ((c + 1) & 1) * 4096;
        bf16x8 zb[4][2];
#pragma unroll
        for (int vb = 0; vb < 4; ++vb)
#pragma unroll
            for (int ks = 0; ks < 2; ++ks) zb[vb][ks] = *(const LAS bf16x8*)(Zc + (16 * vb + t) * 64 + 32 * ks + 8 * kg);
        { const LAS bf16* Qr = (const LAS bf16*)(wl + 4096); const bf16x8 q0 = *(const LAS bf16x8*)(Qr + t * 64 + 8 * kg), q1 = *(const LAS bf16x8*)(Qr + t * 64 + 32 + 8 * kg);
#pragma unroll
          for (int vb = 0; vb < 4; ++vb) { const f32x4 y = mma16(q1, zb[vb][1], mma16(q0, zb[vb][0], yv[vb]));
#pragma unroll
              for (int r = 0; r < 4; ++r) { const int row = seq_row(b, d, c * 16 + 4 * kg + r); YD[((size_t)d * T_ALL + row) * 512 + h * 64 + 16 * vb + t] = y[r]; } } }
#pragma unroll
        for (int ktp = 0; ktp < 4; ++ktp) { const LAS bf16* Pr = (const LAS bf16*)(wl + (ktp < 2 ? ktp * 2048 : (ktp + 1) * 2048));
            const bf16x8 p0 = *(const LAS bf16x8*)(Pr + t * 64 + 8 * kg), p1 = *(const LAS bf16x8*)(Pr + t * 64 + 32 + 8 * kg);
#pragma unroll
            for (int vb = 0; vb < 4; ++vb) { const f32x4 z = mma16(p1, zb[vb][1], mma16(p0, zb[vb][0], zv[vb][ktp]));
                v2u o; o.x = pk2(z[0], z[1]); o.y = pk2(z[2], z[3]); *(LAS v2u*)(Zn + (16 * vb + t) * 64 + 16 * ktp + 4 * kg) = o; } }
        asm volatile("s_waitcnt lgkmcnt(0)" ::: "memory");
        if (lane == 0) *flag = c + 1;
        asm volatile("s_waitcnt lgkmcnt(0)" ::: "memory");
    }
    __syncthreads();
}
__device__ __forceinline__ v2u ld_sc1_8(const void* p) { const unsigned long long v = __hip_atomic_load((const unsigned long long*)p, __ATOMIC_RELAXED, __HIP_MEMORY_SCOPE_AGENT); v2u o; o.x = (unsigned)v; o.y = (unsigned)(v >> 32); return o; }
__device__ __forceinline__ v4u ld_sc1_16(const void* p) { const v2u a = ld_sc1_8(p), b = ld_sc1_8((const char*)p + 8); return (v4u){a.x, a.y, b.x, b.y}; }
__device__ __forceinline__ void rw_chunk_item(const Ctx& F, int l, int it) {
    const auto& a = *F.a; unsigned char* ws = a.ws; const int lane = F.lane, t = lane & 15, kg = lane >> 4;
    const int d = it & 1, h = (it >> 1) & 7, b = it >> 4;
    float* YD = (float*)(ws + WS_YDIR);
    unsigned char* scr = ws + WS_RWSCR + (size_t)F.bid * 16 * RWS_SLOT;
    LAS unsigned char* wl = F.lds + F.wave * 15616;
    LAS bf16* ZL = (LAS bf16*)(F.lds + LDSCTL_OFF + 4096 + (F.wave & 3) * 2048);
    if (F.wave < 4) { for (int i = lane; i < 512; i += 64) ((LAS unsigned*)ZL)[i] = 0u; }
    asm volatile("" ::: "memory");
    constexpr int NCHK = (CTXL + SEQ) / 16, NB = NCHK / 16;
#pragma unroll 1
    for (int bt = 0; bt < NB; ++bt) {
        { v4u cur[12];
#pragma unroll 1
          for (int jj = 0; jj < 2; ++jj) { rw_chunk_load<0, 2>(F, b, h, d, bt * 16 + F.wave + 8 * jj, cur); rw_chunk_task(F, cur, wl, scr + (size_t)(F.wave + 8 * jj) * RWS_SLOT); } }
        asm volatile("s_waitcnt vmcnt(0)" ::: "memory");
        __syncthreads();
        {
            const int t = opaque_v(lane & 15), kg = opaque_v(lane >> 4), vb = opaque(F.wave) & 3;
            const unsigned char* scrb = F.a->ws + WS_RWSCR + (size_t)opaque(F.bid) * 16 * RWS_SLOT;
            LAS unsigned char* sbuf = F.lds;
            const int lt = opaque_v(F.tid) & 255; const bool loader = F.wave >= 4;
            const int lw = opaque(F.wave) & 3;
#define RWB_ISSUE(j_) do { const unsigned char* gp_ = scrb + (size_t)(j_) * RWS_SLOT + (size_t)(lw * 5) * 1024 + lane * 16; LAS unsigned char* lp_ = sbuf + ((j_) % 6) * RWS_SLOT + (lw * 5) * 1024; \
                _Pragma("unroll") for (int q = 0; q < 5; ++q) __builtin_amdgcn_global_load_lds((const unsigned*)(gp_ + q * 1024), (LAS unsigned*)(lp_ + q * 1024), 16, 0, 16); } while (0)
#define RWB_COMP(bi_, j_) do { const LAS unsigned char* sl_ = sbuf + (bi_) * RWS_SLOT; bf16x8 zb[2], qf[2]; \
                _Pragma("unroll") for (int ks = 0; ks < 2; ++ks) { zb[ks] = *(const LAS bf16x8*)(ZL + t * 64 + 32 * ks + 8 * kg); qf[ks] = *(const LAS bf16x8*)(sl_ + RWS_QY + (t * 64 + 32 * ks + 8 * kg) * 2); } \
                const v2u y_ = *(const LAS v2u*)(sl_ + RWS_YV + ((16 * vb + t) * 16 + 4 * kg) * 2); \
                f32x4 yacc = (f32x4){bflo(y_.x), bfhi(y_.x), bflo(y_.y), bfhi(y_.y)}; \
                yacc = mma16(qf[1], zb[1], mma16(qf[0], zb[0], yacc)); \
                f32x4 zn[4]; \
                _Pragma("unroll") for (int ktp = 0; ktp < 4; ++ktp) { const v2u z_ = *(const LAS v2u*)(sl_ + RWS_ZV + ((16 * vb + t) * 64 + 16 * ktp + 4 * kg) * 2); \
                    f32x4 zc = (f32x4){bflo(z_.x), bfhi(z_.x), bflo(z_.y), bfhi(z_.y)}; \
                    _Pragma("unroll") for (int ks = 0; ks < 2; ++ks) zc = mma16(*(const LAS bf16x8*)(sl_ + RWS_PZ + ((16 * ktp + t) * 64 + 32 * ks + 8 * kg) * 2), zb[ks], zc); \
                    zn[ktp] = zc; } \
                _Pragma("unroll") for (int r = 0; r < 4; ++r) { const int row = seq_row(b, d, (bt * 16 + (j_)) * 16 + 4 * kg + r); YD[((size_t)d * T_ALL + row) * 512 + h * 64 + 16 * vb + t] = yacc[r]; } \
                asm volatile("s_waitcnt lgkmcnt(0)" ::: "memory"); \
                _Pragma("unroll") for (int ktp = 0; ktp < 4; ++ktp) { v2u o; o.x = pk2(zn[ktp][0], zn[ktp][1]); o.y = pk2(zn[ktp][2], zn[ktp][3]); *(LAS v2u*)(ZL + t * 64 + 16 * ktp + 4 * kg) = o; } \
                asm volatile("s_waitcnt lgkmcnt(0)" ::: "memory"); } while (0)
#define RWB_BAR() do { asm volatile("s_waitcnt lgkmcnt(0)" ::: "memory"); __builtin_amdgcn_s_barrier(); asm volatile("" ::: "memory"); } while (0)
            if (loader) { RWB_ISSUE(0); RWB_ISSUE(1); RWB_ISSUE(2); RWB_ISSUE(3); asm volatile("s_waitcnt vmcnt(15)" ::: "memory"); }
            RWB_BAR();
#pragma unroll 1
            for (int j = 0; j < 16; ++j) {
                if (loader) { if (j + 4 < 16) { RWB_ISSUE(j + 4); asm volatile("s_waitcnt vmcnt(15)" ::: "memory"); } else { asm volatile("s_waitcnt vmcnt(0)" ::: "memory"); } }
                else { RWB_COMP(j % 6, j); }
                RWB_BAR();
            }
#undef RWB_BAR
#undef RWB_ISSUE
#undef RWB_COMP
        }
        __syncthreads();
    }
}

__device__ __forceinline__ void stage_rw_readout(const Ctx& F, int l) {
    const auto& a = *F.a; unsigned char* ws = a.ws; const int lane = F.lane;
    const bf16* SCN = (const bf16*)(ws + WS_SCN); const bf16* P = (const bf16*)(ws + WS_P); const float* YD = (const float*)(ws + WS_YDIR); bf16* YRW = (bf16*)(ws + WS_YRW);
    const int gw = F.bid * NWAVES + F.wave, NGW = F.G * NWAVES;
    constexpr int TR = 17, NRT = T_ALL / TR;
    for (int tile = gw; tile < NRT * 4; tile += NGW) {
        const int rt = tile % NRT, hp = tile / NRT, row0 = rt * TR, c0 = hp * 128 + 2 * lane;
        const f32x2 rk = *(const f32x2*)(a.in[I_RWRK] + l * 512 + c0), lng = *(const f32x2*)(a.in[I_RWLNG] + l * 512 + c0), lnb = *(const f32x2*)(a.in[I_RWLNB] + l * 512 + c0);
        unsigned sw_[8][5]; f32x2 yw_[8][2];
#define RO_LD(j_) do { const int rr_ = row0 + (j_); const unsigned* sp_ = (const unsigned*)(SCN + (size_t)rr_ * 9 * 512 + c0); \
        sw_[(j_) & 7][0] = sp_[0]; sw_[(j_) & 7][1] = sp_[256]; sw_[(j_) & 7][2] = sp_[4 * 256]; sw_[(j_) & 7][3] = sp_[7 * 256]; sw_[(j_) & 7][4] = *(const unsigned*)(P + (size_t)rr_ * 2560 + 2048 + c0); \
        yw_[(j_) & 7][0] = *(const f32x2*)(YD + (size_t)rr_ * 512 + c0); yw_[(j_) & 7][1] = *(const f32x2*)(YD + ((size_t)T_ALL + rr_) * 512 + c0); } while (0)
        RO_LD(0); RO_LD(1); RO_LD(2);
#pragma unroll
        for (int i = 0; i < TR; ++i) {
            const int row = row0 + i;
            if (i + 3 < TR) RO_LD(i + 3);
            const unsigned ru = sw_[i & 7][0], vu = sw_[i & 7][1], k0u = sw_[i & 7][2], k1u = sw_[i & 7][3], gu = sw_[i & 7][4];
            const f32x2 y0 = yw_[i & 7][0], y1 = yw_[i & 7][1];
            const float bon = red32(bflo(ru) * (bflo(k0u) + bflo(k1u)) * rk[0] + bfhi(ru) * (bfhi(k0u) + bfhi(k1u)) * rk[1]);
            f32x2 y = y0 + y1 + (f32x2){bflo(vu), bfhi(vu)} * bon;
            const float mu = red32(y[0] + y[1]) * (1.f / 64.f);
            y = y - mu;
            const float var = red32(y[0] * y[0] + y[1] * y[1]) * (1.f / 64.f);
            const f32x2 yn = y * (__builtin_amdgcn_rsqf(var + 64e-5f));
            const f32x2 ov = (yn * lng + lnb) * (f32x2){bflo(gu), bfhi(gu)};
            *(unsigned*)(YRW + (size_t)row * 512 + c0) = pk2(ov[0], ov[1]);
        }
    }
}
#undef RO_LD

constexpr size_t WS_S5E = 6 * MiB;
constexpr int S5_NSEG = 4, S5_SEGLEN = (CTXL + SEQ) / S5_NSEG;
__device__ __forceinline__ void s5_disc(const float are, const float aim, const float dt, float& lbr, float& lbi, float& cr, float& ci) {
    const float mag = expf(are * dt); lbr = mag * cosf(aim * dt); lbi = mag * sinf(aim * dt);
    const float den = are * are + aim * aim, nr = lbr - 1.0f; cr = (nr * are + lbi * aim) / den; ci = (lbi * are - nr * aim) / den;
}
template <int PASS>
__device__ __forceinline__ void stage_s5_scan(const Ctx& F, int l) {
    const auto& a = *F.a; unsigned char* ws = a.ws; const int lane = F.lane;
    const bf16* Z = (const bf16*)(ws + WS_Z); bf16* YP = (bf16*)(ws + WS_YP); f32x2* S5E = (f32x2*)(ws + WS_S5E);
    LAS unsigned char* wl = F.lds + F.wave * 16384;
    LAS float* buL = (LAS float*)wl;
    LAS bf16* Hs = (LAS bf16*)(wl + 8704);
    const int fr = lane & 15, kg = lane >> 4;
    for (int itx = F.bid * NWAVES + F.wave; itx < BATCH * 32 * 2 * S5_NSEG; itx += NWAVES * F.G) {
        const int seg = itx & (S5_NSEG - 1), it = itx >> 2;
        const int d = it & 1, g = (it >> 1) & 31, b = it >> 6, p = lane;
        const float dt = expf(a.in[I_S5LDT][(l * 2 + d) * 32 + g]);
        const float* arep = a.in[I_S5ARE] + ((size_t)(l * 2 + d) * 32 + g) * 64; const float* aimp = a.in[I_S5AIM] + ((size_t)(l * 2 + d) * 32 + g) * 64;
        float lbr, lbi, cr_, ci_; s5_disc(arep[p], aimp[p], dt, lbr, lbi, cr_, ci_);
        bf16x8 afr[2][4];
#pragma unroll
        for (int tl = 0; tl < 4; ++tl) { const int pp = 16 * tl + fr; float r0_, r1_, cr, ci; s5_disc(arep[pp], aimp[pp], dt, r0_, r1_, cr, ci);
            v4u pr = (v4u){0u, 0u, 0u, 0u}, pi = (v4u){0u, 0u, 0u, 0u};
            if (kg < 2) { const float* br = a.in[I_S5BRE] + (((size_t)l * 32 + g) * 64 + pp) * 16 + 8 * kg; const float* bi = a.in[I_S5BIM] + (((size_t)l * 32 + g) * 64 + pp) * 16 + 8 * kg;
                const f32x4 x0 = *(const f32x4*)br, x1 = *(const f32x4*)(br + 4), y0 = *(const f32x4*)bi, y1 = *(const f32x4*)(bi + 4);
                pr.x = pk2(cr * x0[0] - ci * y0[0], cr * x0[1] - ci * y0[1]); pr.y = pk2(cr * x0[2] - ci * y0[2], cr * x0[3] - ci * y0[3]);
                pr.z = pk2(cr * x1[0] - ci * y1[0], cr * x1[1] - ci * y1[1]); pr.w = pk2(cr * x1[2] - ci * y1[2], cr * x1[3] - ci * y1[3]);
                pi.x = pk2(cr * y0[0] + ci * x0[0], cr * y0[1] + ci * x0[1]); pi.y = pk2(cr * y0[2] + ci * x0[2], cr * y0[3] + ci * x0[3]);
                pi.z = pk2(cr * y1[0] + ci * x1[0], cr * y1[1] + ci * x1[1]); pi.w = pk2(cr * y1[2] + ci * x1[2], cr * y1[3] + ci * x1[3]); }
            afr[0][tl] = __builtin_bit_cast(bf16x8, pr); afr[1][tl] = __builtin_bit_cast(bf16x8, pi); }
        bf16x8 cf[4];
        f32x2 hst = (f32x2){0.f, 0.f};
        if (PASS == 1) {
#pragma unroll
            for (int kk = 0; kk < 4; ++kk) { const int p0 = 16 * kk + 4 * kg;
                const f32x4 c0 = *(const f32x4*)(a.in[I_S5CRE] + (((size_t)l * 32 + g) * 16 + fr) * 64 + p0), c1 = *(const f32x4*)(a.in[I_S5CIM] + (((size_t)l * 32 + g) * 16 + fr) * 64 + p0);
                v4u pk; pk.x = pk2(c0[0], -c1[0]); pk.y = pk2(c0[1], -c1[1]); pk.z = pk2(c0[2], -c1[2]); pk.w = pk2(c0[3], -c1[3]);
                cf[kk] = __builtin_bit_cast(bf16x8, pk); }
            float pr_ = lbr, pi_ = lbi, l64r = 1.f, l64i = 0.f;
#pragma unroll 1
            for (int q = 0; q < 10; ++q) { const float nr2 = pr_ * pr_ - pi_ * pi_, ni2 = 2.f * pr_ * pi_; pr_ = nr2; pi_ = ni2; if (q == 5) { l64r = pr_; l64i = pi_; } }
            const float lLr = pr_ * l64r - pi_ * l64i, lLi = pr_ * l64i + pi_ * l64r;
#pragma unroll 1
            for (int sgi = 0; sgi < seg; ++sgi) { const f32x2 ev = S5E[((size_t)it * S5_NSEG + sgi) * 64 + p];
                hst = (f32x2){lLr * hst[0] - lLi * hst[1] + ev[0], lLr * hst[1] + lLi * hst[0] + ev[1]}; }
        }
        const f32x2 lbr2 = (f32x2){lbr, lbr}, lbi2 = (f32x2){lbi, lbi};
        const int sbeg = seg * S5_SEGLEN, send = sbeg + S5_SEGLEN;
        v4u u0 = (v4u){0u, 0u, 0u, 0u}, u1 = u0, u2 = u0, u3 = u0;
#define S5_LOADU(dst_, s0_) do { const int sx_ = ((s0_) < send) ? (s0_) : (send - 16); const int row_ = seq_row(b, d, sx_ + fr); dst_ = *(const v4u*)(Z + (size_t)row_ * IN_COLS + S5_OFF + g * 16 + (kg & 1) * 8); } while (0)
#define S5_CHUNK(ux_, sc_) do { \
            { const v4u um_ = (kg < 2) ? ux_ : (v4u){0u, 0u, 0u, 0u}; const bf16x8 ufr = __builtin_bit_cast(bf16x8, um_); \
              _Pragma("unroll") for (int c = 0; c < 2; ++c) _Pragma("unroll") for (int tl = 0; tl < 4; ++tl) { \
                const f32x4 dd = __builtin_amdgcn_mfma_f32_16x16x32_bf16(afr[c][tl], ufr, (f32x4){0.f, 0.f, 0.f, 0.f}, 0, 0, 0); *(LAS f32x4*)(buL + (c * 16 + fr) * 68 + 16 * tl + 4 * kg) = dd; } } \
            S5_LOADU(ux_, (sc_) + 64); \
            LDS_WAIT(); asm volatile("" ::: "memory"); \
            f32x2 bu[16]; \
            _Pragma("unroll") for (int s = 0; s < 16; ++s) bu[s] = (f32x2){buL[s * 68 + p], buL[(16 + s) * 68 + p]}; \
            _Pragma("unroll") for (int s = 0; s < 16; ++s) { const float tr_ = __builtin_fmaf(-lbi, hst[1], bu[s][0]), ti_ = __builtin_fmaf(lbi, hst[0], bu[s][1]); \
                hst = (f32x2){__builtin_fmaf(lbr, hst[0], tr_), __builtin_fmaf(lbr, hst[1], ti_)}; \
                if (PASS == 1) *(LAS unsigned*)(Hs + s * 136 + 2 * p) = pg8::cvt_pk_bf16(hst[0], hst[1]); } \
            if (PASS == 1) { LDS_WAIT(); asm volatile("" ::: "memory"); \
                f32x4 acc = (f32x4){0.f, 0.f, 0.f, 0.f}; \
                _Pragma("unroll") for (int kk = 0; kk < 4; ++kk) { const bf16x8 af = *(const LAS bf16x8*)(Hs + fr * 136 + 32 * kk + 8 * kg); acc = __builtin_amdgcn_mfma_f32_16x16x32_bf16(af, cf[kk], acc, 0, 0, 0); } \
                { const int rowq_ = seq_row(b, d, (sc_) + 4 * kg); bf16* yq_ = YP + ((size_t)d * T_ALL + rowq_) * 512 + g * 16 + fr; const int st_ = d ? -512 : 512; \
                  _Pragma("unroll") for (int r = 0; r < 4; ++r) yq_[r * st_] = (bf16)f2bf(acc[r]); } } \
            LDS_WAIT(); asm volatile("" ::: "memory"); } while (0)
        S5_LOADU(u0, sbeg); S5_LOADU(u1, sbeg + 16); S5_LOADU(u2, sbeg + 32); S5_LOADU(u3, sbeg + 48);
#pragma unroll 1
        for (int s0 = sbeg; s0 < send; s0 += 64) { S5_CHUNK(u0, s0); S5_CHUNK(u1, s0 + 16); S5_CHUNK(u2, s0 + 32); S5_CHUNK(u3, s0 + 48); }
#undef S5_CHUNK
        if (PASS == 0) S5E[((size_t)it * S5_NSEG + seg) * 64 + p] = hst;
#undef S5_LOADU
    }
}

__device__ __forceinline__ void stage_s5_prep(const Ctx& F, int l, int nrows) {
    const auto& a = *F.a; unsigned char* ws = a.ws;
    const bf16* __restrict__ Z = (const bf16*)(ws + WS_Z); const bf16* __restrict__ YP = (const bf16*)(ws + WS_YP); bf16* __restrict__ AS5 = (bf16*)(ws + WS_AS5);
    const int c = 4 * (F.tid & 127), rq = F.tid >> 7;
    const f32x4 dsk = *(const f32x4*)(a.in[I_S5D] + l * 512 + c);
#pragma unroll 4
    for (int row = F.bid * 4 + rq; row < nrows; row += F.G * 4) {
        const v2u uz = *(const v2u*)(Z + (size_t)row * IN_COLS + S5_OFF + c);
        const v2u q0 = *(const v2u*)(YP + (size_t)row * 512 + c), q1 = *(const v2u*)(YP + ((size_t)T_ALL + row) * 512 + c);
        const f32x4 y0 = (f32x4){bflo(q0.x), bfhi(q0.x), bflo(q0.y), bfhi(q0.y)}, y1 = (f32x4){bflo(q1.x), bfhi(q1.x), bflo(q1.y), bfhi(q1.y)};
        const f32x4 u = (f32x4){bflo(uz.x), bfhi(uz.x), bflo(uz.y), bfhi(uz.y)};
        const f32x4 y = y0 + y1 + u * dsk;
        float ge[4];
#pragma unroll
        for (int j = 0; j < 4; ++j) ge[j] = 0.5f * y[j] * (1.f + tanh_fast(0.7978845608028654f * (y[j] + 0.044715f * y[j] * y[j] * y[j])));
        v2u o; o.x = pk2(ge[0], ge[1]); o.y = pk2(ge[2], ge[3]);
        *(v2u*)(AS5 + (size_t)row * 512 + c) = o;
    }
}

__device__ __forceinline__ void stage_hy_pre(const Ctx& F, int l, int nrows) {
    const auto& a = *F.a; unsigned char* ws = a.ws; const int lane = F.lane;
    const bf16* Z = (const bf16*)(ws + WS_Z); bf16* UT = (bf16*)(ws + WS_UT);
    LAS unsigned char* tl = F.lds + F.wave * 16384;
    const float* cw = a.in[I_HYCW] + (size_t)l * 3 * 1536; const float* cbp = a.in[I_HYCB] + l * 1536;
    const int gw = F.bid * NWAVES + F.wave, NGW = F.G * NWAVES;
    const int q = lane >> 3, k = lane & 7, ntile = (nrows / 64) * 24;
    v4u v[8], hv;
#define HYPRE_LOAD(tile_) do { const int rt_ = (tile_) / 24, ct_ = (tile_) % 24, row0_ = rt_ * 64; int base_, pos0_, n_; row_seq(row0_, base_, pos0_, n_); \
        const bf16* zt_ = Z + (size_t)row0_ * IN_COLS + HY_OFF + ct_ * 64 + 8 * k; hv = (v4u){0u, 0u, 0u, 0u}; \
        _Pragma("unroll") for (int i = 0; i < 8; ++i) v[i] = *(const v4u*)(zt_ + (size_t)(8 * i + q) * IN_COLS); \
        if (q == 0 && pos0_ > 0) hv = *(const v4u*)(zt_ - (size_t)IN_COLS); \
        if (q == 1 && pos0_ + 64 < n_) hv = *(const v4u*)(zt_ + (size_t)64 * IN_COLS); } while (0)
    if (gw < ntile) HYPRE_LOAD(gw);
#pragma unroll 1
    for (int tile = gw; tile < ntile; tile += NGW) {
        const int rt = tile / 24, ct = tile % 24, row0 = rt * 64, c0 = ct * 64;
        f32x4 wv[8];
#pragma unroll
        for (int i = 0; i < 8; ++i) { const int col = c0 + 8 * i + q; wv[i] = (f32x4){cw[col], cw[1536 + col], cw[2 * 1536 + col], cbp[col]}; }
#pragma unroll
        for (int i = 0; i < 8; ++i) { LAS unsigned* p = (LAS unsigned*)(tl + (1 + 8 * i + q) * 132 + 16 * k); p[0] = v[i].x; p[1] = v[i].y; p[2] = v[i].z; p[3] = v[i].w; }
        if (q < 2) { LAS unsigned* p = (LAS unsigned*)(tl + (q ? 65 : 0) * 132 + 16 * k); p[0] = hv.x; p[1] = hv.y; p[2] = hv.z; p[3] = hv.w; }
        if (tile + NGW < ntile) HYPRE_LOAD(tile + NGW);
        LDS_WAIT(); asm volatile("" ::: "memory");
#pragma unroll 2
        for (int i = 0; i < 8; ++i) {
            const int ch = 8 * i + q, col = c0 + ch;
            const LAS unsigned short* s = (const LAS unsigned short*)(tl + (8 * k) * 132 + ch * 2);
            float z[10];
#pragma unroll
            for (int t = 0; t < 10; ++t) z[t] = __builtin_bit_cast(float, (unsigned)s[t * 66] << 16);
            float o[8];
#pragma unroll
            for (int t = 0; t < 8; ++t) o[t] = wv[i][0] * z[t] + wv[i][1] * z[t + 1] + wv[i][2] * z[t + 2] + wv[i][3];
            v4u w; w.x = pk2(o[0], o[1]); w.y = pk2(o[2], o[3]); w.z = pk2(o[4], o[5]); w.w = pk2(o[6], o[7]);
            *(v4u*)(UT + (size_t)col * T_ALL + row0 + 8 * k) = w;
        }
        LDS_WAIT(); asm volatile("" ::: "memory");
    }
#undef HYPRE_LOAD
}
__device__ __forceinline__ void stage_hy_post(const Ctx& F, int l, int nrows) {
    const auto& a = *F.a; unsigned char* ws = a.ws; const int lane = F.lane;
    const bf16* YT = (const bf16*)(ws + WS_UT) + (size_t)1024 * T_ALL; bf16* YHY = (bf16*)(ws + WS_YHY);
    LAS unsigned char* tl = F.lds + F.wave * 16384;
    const int gw = F.bid * NWAVES + F.wave, NGW = F.G * NWAVES;
    const int q = lane >> 3, k = lane & 7, ntile = (nrows / 64) * 8;
    v4u v[8];
#define HYPOST_LOAD(tile_) do { const bf16* yp_ = YT + (size_t)(((tile_) & 7) * 64 + q) * T_ALL + ((tile_) >> 3) * 64 + 8 * k; \
        _Pragma("unroll") for (int i = 0; i < 8; ++i) v[i] = *(const v4u*)(yp_ + (size_t)(8 * i) * T_ALL); } while (0)
    if (gw < ntile) HYPOST_LOAD(gw);
#pragma unroll 1
    for (int tile = gw; tile < ntile; tile += NGW) {
        const int rt = tile >> 3, ct = tile & 7, row0 = rt * 64, c0 = ct * 64;
#pragma unroll
        for (int i = 0; i < 8; ++i) { LAS unsigned* p = (LAS unsigned*)(tl + (8 * i + q) * 132 + 16 * k); p[0] = v[i].x; p[1] = v[i].y; p[2] = v[i].z; p[3] = v[i].w; }
        if (tile + NGW < ntile) HYPOST_LOAD(tile + NGW);
        LDS_WAIT(); asm volatile("" ::: "memory");
#pragma unroll
        for (int i = 0; i < 8; ++i) { const int r = 8 * i + q;
            const LAS unsigned short* s = (const LAS unsigned short*)(tl + (8 * k) * 132 + r * 2);
            unsigned e[8];
#pragma unroll
            for (int j = 0; j < 8; ++j) e[j] = s[j * 66];
            v4u w; w.x = e[0] | (e[1] << 16); w.y = e[2] | (e[3] << 16); w.z = e[4] | (e[5] << 16); w.w = e[6] | (e[7] << 16);
            *(v4u*)(YHY + (size_t)(row0 + r) * 512 + c0 + 8 * k) = w; }
        LDS_WAIT(); asm volatile("" ::: "memory");
    }
#undef HYPOST_LOAD
}
typedef float f32x16 __attribute__((ext_vector_type(16)));
__device__ __forceinline__ void hyena_item(const Ctx& F, int l, int c, int isctx) {
    const auto& a = *F.a; unsigned char* ws = a.ws; const int tid = F.tid, lane = F.lane;
    const int n = isctx ? CTXL : SEQ, rowbase = isctx ? T_LAT : 0, RL = isctx ? HY_RLENC : HY_RLEN, off = n + 47;
    const bf16* UT = (const bf16*)(ws + WS_UT);
    const bf16* x1g = UT + (size_t)c * T_ALL + rowbase; const bf16* x2g = UT + (size_t)(512 + c) * T_ALL + rowbase; bf16* vg = (bf16*)UT + (size_t)(1024 + c) * T_ALL + rowbase;
    const bf16* Rg = (const bf16*)(ws + WS_GF + l * GF_STRIDE + (isctx ? GF_CTX : 0)) + (size_t)c * RL;
    LAS unsigned char* XB = F.lds; LAS unsigned char* R1 = F.lds + HY_R1_OFF; LAS unsigned char* R2 = F.lds + HY_R2_OFF;
    { const int cpb = n / 8;
      for (int q = tid; q < 8 * cpb; q += NTHREADS) { const int b = q / cpb, ch = q % cpb; *(LAS v4u*)(XB + b * HY_ROWB + 2 * HY_MARG + 16 * ch) = *(const v4u*)(vg + (size_t)b * n + 8 * ch); }
      if (tid < 256) { const int b = tid >> 5, side = (tid >> 4) & 1, ch = tid & 15; const unsigned zz = (unsigned)opaque_v(0); *(LAS v4u*)(XB + b * HY_ROWB + (side ? 2 * (HY_MARG + n) : 0) + 16 * ch) = (v4u){zz, zz, zz, zz}; }
      const int rch = RL / 8;
      for (int q = tid; q < rch; q += NTHREADS) { *(LAS v4u*)(R1 + 16 * q) = *(const v4u*)(Rg + 8 * q); *(LAS v4u*)(R2 + 16 * q) = *(const v4u*)(Rg + (size_t)512 * RL + 8 * q); } }
    __syncthreads();
    const int i = lane & 31, kg = lane >> 5, jb = lane & 3, bb = (lane & 31) >> 2;
    const int rsh = (off - i) & 7, rd = rsh >> 1; const bool s1 = rd & 1, s2 = rd & 2; const unsigned sh = (rsh & 1) ? 16u : 0u;
    const int aconst = 2 * (off - i + 8 * kg - rsh), bconst = bb * HY_ROWB + 2 * (HY_MARG + 32 * jb + 8 * kg);
    const int T0w = 512 * F.wave; const int ntile = (n - T0w) >= 512 ? 4 : ((n - T0w) > 0 ? (n - T0w) / 128 : 0);
    const float bias0 = a.in[I_HYBIAS][(l * 2 + 0) * 512 + c], bias1 = a.in[I_HYBIAS][(l * 2 + 1) * 512 + c];
    f32x16 acc[4];
    v2u y1p[4][4];
#define HY_AFRAG(wa, wb, afr) do { \
        const unsigned a0 = s1 ? wa.y : wa.x, a1 = s1 ? wa.z : wa.y, a2 = s1 ? wa.w : wa.z, a3 = s1 ? wb.x : wa.w, a4 = s1 ? wb.y : wb.x, a5 = s1 ? wb.z : wb.y, a6 = s1 ? wb.w : wb.z; \
        const unsigned b0 = s2 ? a2 : a0, b1 = s2 ? a3 : a1, b2 = s2 ? a4 : a2, b3 = s2 ? a5 : a3, b4 = s2 ? a6 : a4; \
        v4u af_; af_.x = __builtin_amdgcn_alignbit(b1, b0, sh); af_.y = __builtin_amdgcn_alignbit(b2, b1, sh); af_.z = __builtin_amdgcn_alignbit(b3, b2, sh); af_.w = __builtin_amdgcn_alignbit(b4, b3, sh); \
        afr = __builtin_bit_cast(bf16x8, af_); } while (0)
#define HY_STEP_COND(RB, d) do { \
        const v4u wa = *(const LAS v4u*)((RB) + aconst - 2 * (d)), wb = *(const LAS v4u*)((RB) + aconst - 2 * (d) + 16); bf16x8 afr; HY_AFRAG(wa, wb, afr); \
        _Pragma("unroll") for (int m = 0; m < 4; ++m) { const int T0 = T0w + 128 * m; \
            if (m < ntile && (d) >= T0 - n + 16 && (d) <= T0 + 96) { const bf16x8 bfr = *(const LAS bf16x8*)(XB + bconst + 2 * (T0 - (d))); \
                acc[m] = __builtin_amdgcn_mfma_f32_32x32x16_bf16(afr, bfr, acc[m], 0, 0, 0); } } } while (0)
#define HY_LOAD(RB, d, wa, wb, bq) do { wa = *(const LAS v4u*)((RB) + aconst - 2 * (d)); wb = *(const LAS v4u*)((RB) + aconst - 2 * (d) + 16); \
        _Pragma("unroll") for (int m = 0; m < 4; ++m) bq[m] = *(const LAS bf16x8*)(XB + bconst + 2 * (T0w + 128 * m - (d))); } while (0)
#define HY_MMA(wa, wb, bq) do { bf16x8 afr; HY_AFRAG(wa, wb, afr); \
        _Pragma("unroll") for (int m = 0; m < 4; ++m) acc[m] = __builtin_amdgcn_mfma_f32_32x32x16_bf16(afr, bq[m], acc[m], 0, 0, 0); } while (0)
#define HY_CONV(RB) do { \
        _Pragma("unroll") for (int m = 0; m < 4; ++m) _Pragma("unroll") for (int e = 0; e < 16; ++e) acc[m][e] = 0.f; \
        if (ntile == 4) { \
            const int dA = T0w - n + 16, dB = T0w + 384 - n + 16, dC = T0w + 96, dD = T0w + 384 + 96;     \
            _Pragma("unroll 1") for (int d = dA; d < dB; d += 16) HY_STEP_COND(RB, d); \
            { v4u waA, wbA, waB, wbB; bf16x8 bqA[4], bqB[4]; \
              HY_LOAD(RB, dB, waA, wbA, bqA); \
              _Pragma("unroll 1") for (int d = dB; d <= dC; d += 32) { \
                  if (d + 16 <= dC) HY_LOAD(RB, d + 16, waB, wbB, bqB); \
                  __builtin_amdgcn_sched_barrier(0); \
                  HY_MMA(waA, wbA, bqA); \
                  __builtin_amdgcn_sched_barrier(0); \
                  if (d + 32 <= dC) HY_LOAD(RB, d + 32, waA, wbA, bqA); \
                  __builtin_amdgcn_sched_barrier(0); \
                  if (d + 16 <= dC) HY_MMA(waB, wbB, bqB); \
                  __builtin_amdgcn_sched_barrier(0); } } \
            _Pragma("unroll 1") for (int d = dC + 16; d <= dD; d += 16) HY_STEP_COND(RB, d); \
        } else if (ntile > 0) { const int dhi = T0w + 128 * (ntile - 1) + 96; \
            _Pragma("unroll 1") for (int d = T0w - n + 16; d <= dhi; d += 16) HY_STEP_COND(RB, d); } } while (0)
    HY_CONV(R1);
#pragma unroll
    for (int m = 0; m < 4; ++m) if (m < ntile) {
#pragma unroll
        for (int rg = 0; rg < 4; ++rg) { const int t4 = T0w + 128 * m + 32 * jb + 8 * rg + 4 * kg;
            const v2u xv = *(const v2u*)(x1g + (size_t)bb * n + t4); const v2u vv = *(const LAS v2u*)(XB + bb * HY_ROWB + 2 * (HY_MARG + t4));
            const float y0 = bflo(xv.x) * (acc[m][4 * rg + 0] + bias0 * bflo(vv.x)), y1 = bfhi(xv.x) * (acc[m][4 * rg + 1] + bias0 * bfhi(vv.x));
            const float y2 = bflo(xv.y) * (acc[m][4 * rg + 2] + bias0 * bflo(vv.y)), y3 = bfhi(xv.y) * (acc[m][4 * rg + 3] + bias0 * bfhi(vv.y));
            y1p[m][rg].x = pk2(y0, y1); y1p[m][rg].y = pk2(y2, y3); } }
    __syncthreads();
#pragma unroll
    for (int m = 0; m < 4; ++m) if (m < ntile) {
#pragma unroll
        for (int rg = 0; rg < 4; ++rg) { const int t4 = T0w + 128 * m + 32 * jb + 8 * rg + 4 * kg; *(LAS v2u*)(XB + bb * HY_ROWB + 2 * (HY_MARG + t4)) = y1p[m][rg]; } }
    __syncthreads();
    HY_CONV(R2);
#pragma unroll
    for (int m = 0; m < 4; ++m) if (m < ntile) {
#pragma unroll
        for (int rg = 0; rg < 4; ++rg) { const int t4 = T0w + 128 * m + 32 * jb + 8 * rg + 4 * kg;
            const v2u xv = *(const v2u*)(x2g + (size_t)bb * n + t4); const v2u yv = y1p[m][rg];
            const float o0 = bflo(xv.x) * (acc[m][4 * rg + 0] + bias1 * bflo(yv.x)), o1 = bfhi(xv.x) * (acc[m][4 * rg + 1] + bias1 * bfhi(yv.x));
            const float o2 = bflo(xv.y) * (acc[m][4 * rg + 2] + bias1 * bflo(yv.y)), o3 = bfhi(xv.y) * (acc[m][4 * rg + 3] + bias1 * bfhi(yv.y));
            v2u ov; ov.x = pk2(o0, o1); ov.y = pk2(o2, o3); *(v2u*)(vg + (size_t)bb * n + t4) = ov; } }
    __syncthreads();
#undef HY_CONV
#undef HY_AFRAG
#undef HY_STEP_COND
#undef HY_LOAD
#undef HY_MMA
}
__device__ __forceinline__ void stage_mixer(const Ctx& F, int l) {
    unsigned* ctr = (unsigned*)(F.a->ws + WS_CTL) + CW_WORK + 64 * l;
    LAS int* itb = (LAS int*)(F.lds + LDSCTL_OFF + 512);
    const int nit = 128 + 512 + (l == 0 ? 512 : 0);
#ifdef PROBE_STATIC
    return;
#endif
    for (;;) {
        if (F.tid == 0) *itb = (int)__hip_atomic_fetch_add(ctr, 1u, __ATOMIC_RELAXED, __HIP_MEMORY_SCOPE_AGENT);
        __syncthreads();
        const int it = *itb;
        __syncthreads();
        if (it >= nit) break;
        Ctx Fi; Fi.a = kargs(); Fi.tid = opaque_v((int)threadIdx.x); Fi.lane = Fi.tid & 63; Fi.wave = __builtin_amdgcn_readfirstlane(Fi.tid >> 6); Fi.bid = opaque((int)blockIdx.x); Fi.G = opaque((int)gridDim.x);
        Fi.lds = (LAS unsigned char*)((LAS unsigned char*)0 + opaque(0)) + (F.lds - (LAS unsigned char*)0);
#ifdef PROBE_T
        if (l == 0 && F.tid == 0 && it == 5) ((unsigned long long*)(F.a->ws + WS_CTL + CW_STAMP * 4))[21] = __builtin_amdgcn_s_memrealtime();
        if (l == 0 && F.tid == 0 && it == 300) ((unsigned long long*)(F.a->ws + WS_CTL + CW_STAMP * 4))[23] = __builtin_amdgcn_s_memrealtime();
#endif
        if (it < 128) { for (int rep = 0; rep < ((DUPK == 9) ? 2 : 1); ++rep) rw_chunk_item2(Fi, opaque(l), it); }
        else if (it < 640) hyena_item(Fi, opaque(l), it - 128, 0);
        else hyena_item(Fi, opaque(l), it - 640, 1);
#ifdef PROBE_T
        if (l == 0 && F.tid == 0 && it == 5) ((unsigned long long*)(F.a->ws + WS_CTL + CW_STAMP * 4))[22] = __builtin_amdgcn_s_memrealtime();
        if (l == 0 && F.tid == 0 && it == 300) ((unsigned long long*)(F.a->ws + WS_CTL + CW_STAMP * 4))[24] = __builtin_amdgcn_s_memrealtime();
#endif
    }
}

typedef float f32x16r __attribute__((ext_vector_type(16)));
__device__ __forceinline__ void stage_norm2_router(const Ctx& F, int l, int nrows) {
    const auto& a = *F.a; unsigned char* ws = a.ws; const int lane = F.lane;
    const float* X = (const float*)(ws + WS_X); bf16* H = (bf16*)(ws + WS_H); const float* MOD = (const float*)(ws + WS_MOD);
    int* EIDX = (int*)(ws + WS_EIDX); float* GATE = (float*)(ws + WS_GATE); int* POS = (int*)(ws + WS_POS); unsigned* ROWOF = (unsigned*)(ws + WS_ROWOF);
    LAS int* lex = (LAS int*)(F.lds + 40960); LAS int* lrk = lex + 2048; LAS int* offl = lrk + 2048;
    LAS float* lg = (LAS float*)(F.lds + F.wave * 4352);
    LAS int* hist = (LAS int*)(F.lds + LDSCTL_OFF + 1024);
    if (F.tid < 32) hist[F.tid] = 0;
    __syncthreads();
    const int rpb = (nrows + F.G - 1) / F.G, r0 = F.bid * rpb, r1 = (r0 + rpb < nrows) ? r0 + rpb : nrows;
    const float* rw = a.in[I_RTW] + (size_t)l * 1024 * 32;
    const int i = lane & 31, kk = lane >> 5;
    const f32x4* ng = (const f32x4*)(a.in[I_N2G] + l * D) + kk;
    for (int rb = r0 + F.wave * 32; rb < r1; rb += NWAVES * 32) {
        const int nrow = (r1 - rb) < 32 ? (r1 - rb) : 32; const bool live = i < nrow;
        const int row = live ? rb + i : r1 - 1; const int w = row < T_LAT ? (row >> 12) : 8;
        const f32x4* xr = (const f32x4*)(X + (size_t)row * D) + kk;
        float ss = 0.f;
#pragma unroll 16
        for (int q = 0; q < 128; ++q) { const f32x4 v = xr[2 * q]; ss += (v[0] * v[0] + v[1] * v[1]) + (v[2] * v[2] + v[3] * v[3]); }
        ss += __builtin_bit_cast(float, __builtin_amdgcn_ds_bpermute((lane ^ 32) << 2, __builtin_bit_cast(int, ss)));
        const float rstd = __builtin_amdgcn_rsqf(ss * (1.f / D) + 1e-6f);
        const f32x4* sh = (const f32x4*)(MOD + (size_t)(l * 9 + w) * 6144 + 3072) + kk; const f32x4* sc = (const f32x4*)(MOD + (size_t)(l * 9 + w) * 6144 + 4096) + kk;
        v2u* ho = (v2u*)(H + (size_t)row * D) + kk;
        f32x16r acc;
#pragma unroll
        for (int e = 0; e < 16; ++e) acc[e] = 0.f;
        const float* wp = rw + (size_t)(4 * kk) * 32 + i;
        f32x4 xn[4], gn_[4], cn_[4], sn_[4], wn_[4];
#define RT_LOAD(q0_) do { _Pragma("unroll") for (int u_ = 0; u_ < 4; ++u_) { const int q_ = (q0_) + u_; xn[u_] = xr[2 * q_]; gn_[u_] = ng[2 * q_]; cn_[u_] = sc[2 * q_]; sn_[u_] = sh[2 * q_]; \
            wn_[u_] = (f32x4){wp[(size_t)(8 * q_) * 32], wp[(size_t)(8 * q_ + 1) * 32], wp[(size_t)(8 * q_ + 2) * 32], wp[(size_t)(8 * q_ + 3) * 32]}; } } while (0)
        RT_LOAD(0);
#pragma unroll 1
        for (int q0 = 0; q0 < 128; q0 += 4) {
            f32x4 xc[4], gc_[4], cc_[4], sc_[4], wc_[4];
#pragma unroll
            for (int u = 0; u < 4; ++u) { xc[u] = xn[u]; gc_[u] = gn_[u]; cc_[u] = cn_[u]; sc_[u] = sn_[u]; wc_[u] = wn_[u]; }
            if (q0 + 4 < 128) RT_LOAD(q0 + 4);
#pragma unroll
            for (int u = 0; u < 4; ++u) { const int q = q0 + u;
                const f32x4 h4 = xc[u] * rstd * gc_[u] * (cc_[u] + 1.0f) + sc_[u];
                if (live) { v2u o; o.x = pk2(h4[0], h4[1]); o.y = pk2(h4[2], h4[3]); ho[2 * q] = o; }
                acc = __builtin_amdgcn_mfma_f32_32x32x2f32(h4[0], wc_[u][0], acc, 0, 0, 0);
                acc = __builtin_amdgcn_mfma_f32_32x32x2f32(h4[1], wc_[u][1], acc, 0, 0, 0);
                acc = __builtin_amdgcn_mfma_f32_32x32x2f32(h4[2], wc_[u][2], acc, 0, 0, 0);
                acc = __builtin_amdgcn_mfma_f32_32x32x2f32(h4[3], wc_[u][3], acc, 0, 0, 0); }
        }
#undef RT_LOAD
        const float rbias = a.in[I_RTB][l * 32 + i];
#pragma unroll
        for (int r = 0; r < 16; ++r) { const int ri = (r & 3) + 8 * (r >> 2) + 4 * kk; lg[ri * 33 + i] = acc[r] + rbias; }
        LDS_WAIT(); asm volatile("" ::: "memory");
        if (lane < nrow) {
            LAS float* lr = lg + lane * 33; const int orow = rb + lane;
            float tv[4]; int ti[4];
#pragma unroll
            for (int r = 0; r < 4; ++r) { float bv = -INFINITY; int bi = 0;
#pragma unroll 8
                for (int e = 0; e < 32; ++e) { const float v = lr[e]; if (v > bv) { bv = v; bi = e; } }
                tv[r] = bv; ti[r] = bi; lr[bi] = -INFINITY; }
            const float e1 = expf(tv[1] - tv[0]), e2 = expf(tv[2] - tv[0]), e3 = expf(tv[3] - tv[0]); const float inv = 1.0f / (1.0f + e1 + e2 + e3);
            *(int4*)(EIDX + orow * 4) = make_int4(ti[0], ti[1], ti[2], ti[3]); *(f32x4*)(GATE + orow * 4) = (f32x4){inv, e1 * inv, e2 * inv, e3 * inv};
#pragma unroll
            for (int r = 0; r < 4; ++r) { const int rk = __hip_atomic_fetch_add(&hist[ti[r]], 1, __ATOMIC_RELAXED, __HIP_MEMORY_SCOPE_WORKGROUP); lex[(orow - r0) * 4 + r] = ti[r]; lrk[(orow - r0) * 4 + r] = rk; }
        }
        LDS_WAIT(); asm volatile("" ::: "memory");
    }
    __syncthreads();
    if (F.tid < 32) { const int c = hist[F.tid]; offl[F.tid] = c ? (int)__hip_atomic_fetch_add((unsigned*)(ws + WS_CTL) + CW_CNT + 64 * l + F.tid, (unsigned)c, __ATOMIC_RELAXED, __HIP_MEMORY_SCOPE_AGENT) : 0; }
    __syncthreads();
    for (int i = F.tid; i < (r1 > r0 ? (r1 - r0) * 4 : 0); i += NTHREADS) { const int e = lex[i], pos = offl[e] + lrk[i];
        POS[r0 * 4 + i] = pos; ROWOF[(size_t)e * pg8::MOE_CAP + pos] = (unsigned)(r0 + (i >> 2)) * (unsigned)(D * 2); }
    __syncthreads();
}

__device__ __forceinline__ LAS int* load_moe_base(const Ctx& F, int l) {
    LAS int* base = (LAS int*)(F.lds + LDSCTL_OFF + 256);
    if (F.tid < 32) base[64 + F.tid] = (int)__hip_atomic_load((unsigned*)(F.a->ws + WS_CTL) + CW_CNT + 64 * l + F.tid, __ATOMIC_RELAXED, __HIP_MEMORY_SCOPE_AGENT);
    __syncthreads();
    if (F.tid == 0) { int acc = 0; for (int e = 0; e < 32; ++e) { base[e] = acc; acc += (base[64 + e] + 255) & ~255; } base[32] = acc; }
    __syncthreads();
    return base;
}
__device__ __forceinline__ void moe_fix_pos(const Ctx& F, int nrows, const LAS int* base) {
    unsigned char* ws = F.a->ws; const int* EIDX = (const int*)(ws + WS_EIDX); int* POS = (int*)(ws + WS_POS);
    const int rpb = (nrows + F.G - 1) / F.G, r0 = F.bid * rpb, r1 = (r0 + rpb < nrows) ? r0 + rpb : nrows;
    for (int i = F.tid; i < (r1 > r0 ? (r1 - r0) * 4 : 0); i += NTHREADS) POS[r0 * 4 + i] += base[EIDX[r0 * 4 + i]];
}

constexpr int NSTAGE_L = 12, NSTAGES = 1 + DEPTH * NSTAGE_L + 1;
__global__ void __launch_bounds__(NTHREADS, 2) mk_fwd(Args args) {
    extern __shared__ __attribute__((aligned(16))) unsigned char lds_raw[];
    Ctx F; F.a = kargs(); F.lds = (LAS unsigned char*)lds_raw; F.tid = threadIdx.x; F.lane = F.tid & 63; F.wave = __builtin_amdgcn_readfirstlane(F.tid >> 6); F.bid = blockIdx.x; F.G = gridDim.x;
    volatile LAS unsigned* MISC = (volatile LAS unsigned*)(F.lds + LDSCTL_OFF);
    for (int u = F.tid; u < (LDS_BYTES - LDSCTL_OFF) / 4; u += NTHREADS) ((LAS unsigned*)(F.lds + LDSCTL_OFF))[u] = 0u;
    __syncthreads();
#if MK_PER_STAGE
#define GRID_BAR() do { } while (0)
#else
    (void)xcd_barrier_post((unsigned*)(F.a->ws + WS_CTL) + CW_BAR, MISC + 8);
#define GRID_BAR() do { XcdBarrier b_; b_.bar = (unsigned*)(kargs()->ws + WS_CTL) + CW_BAR; b_.x = xb_xcc_id(); b_.st = (volatile LAS unsigned*)((LAS unsigned char*)lds_raw + LDSCTL_OFF + opaque(32)); xcd_barrier(b_); } while (0)
#endif
#ifndef ONLY_S
#define ONLY_S -1
#endif
#define STG_SEL(k) (ONLY_S < 0 || ONLY_S == (((k) == 0) ? 0 : ((k) == NSTAGES - 1 ? 14 : (((k) - 1) % NSTAGE_L) + 1)))
#if MK_PER_STAGE
#define IN(k) (STG_SEL(k) && kargs()->ph_lo == (k))
#else
#define IN(k) STG_SEL(k)
#endif
#if MK_PER_STAGE
#define SEAM(k) do { } while (0)
#else
#define SEAM(k) do { if ((k) + 1 < NSTAGES) GRID_BAR(); } while (0)
#endif
#define STAGE(k) if (IN(k)) { F.a = kargs(); F.tid = opaque_v((int)threadIdx.x); F.lane = F.tid & 63; F.wave = __builtin_amdgcn_readfirstlane(F.tid >> 6); F.bid = opaque((int)blockIdx.x); F.G = opaque((int)gridDim.x); F.lds = (LAS unsigned char*)lds_raw + opaque(0); unsigned char* ws = F.a->ws; const int l = opaque(lq); unsigned char* wl = ws + WS_WTS + (size_t)l * WL_STRIDE; (void)wl; (void)ws;
#define STAGE_END(k) } SEAM(k);
    int lq = 0;
    STAGE(0) p0_prologue(F); STAGE_END(0)
    for (lq = 0; lq < DEPTH; ++lq) {
        const int sb = 1 + lq * NSTAGE_L;
        const int nrl = opaque((lq == DEPTH - 1) ? T_LAT : T_ALL);
        STAGE(sb + 0) stage_norm1(F, l); STAGE_END(sb + 0)
        STAGE(sb + 1) pg8::SchedWin S; S.A = (const char*)(ws + WS_H); S.Bt = (const char*)(wl + WO_WIN); S.tstep = (size_t)256 * 1024 * 2; S.G = F.G; S.c = F.bid; S.part = (nrl != T_ALL); pg8::EpiBf16 E{(bf16*)(ws + WS_Z), IN_COLS, nullptr, 0};
            pg8::gemm_phase(F.lds, F.tid, 1024, S, E); STAGE_END(sb + 1)
        STAGE(sb + 2) for (int rep = 0; rep < REPN(1); ++rep) stage_rw_prep1(F, l); for (int rep = 0; rep < REPN(2); ++rep) stage_s5_scan<0>(F, l); for (int rep = 0; rep < REPN(3); ++rep) stage_hy_pre(F, l, nrl); STAGE_END(sb + 2)
        STAGE(sb + 3) { pg8::SchedStatic S; S.init(ws + WS_ARW, wl + WO_RWCAT, T_ALL, 2560, 256, F.G, F.bid); pg8::EpiBf16 E{(bf16*)(ws + WS_P), 2560, nullptr, 0}; PT(4); pg8::gemm_phase(F.lds, F.tid, 256, S, E); PT(5); }
            F.tid = opaque_v((int)threadIdx.x); F.lane = F.tid & 63;
            for (int rep = 0; rep < REPN(4); ++rep) stage_s5_scan<1>(F, l); STAGE_END(sb + 3)
        STAGE(sb + 4) for (int rep = 0; rep < REPN(5); ++rep) stage_rw_prep2(F, l); for (int rep = 0; rep < REPN(6); ++rep) stage_s5_prep(F, l, nrl); STAGE_END(sb + 4)
        STAGE(sb + 5) PT(10); stage_mixer(F, l); PT(11); STAGE_END(sb + 5) STAGE(sb + 5) PT(12); }
        STAGE(sb + 6) { pg8::SchedStatic S; S.init(ws + WS_AS5, wl + WO_GLU, nrl, 1024, 512, F.G, F.bid); pg8::EpiGlu<0> E{(bf16*)(ws + WS_YS5), 512, F.a->in[I_S5GLUB] + l * 1024, 0, 512}; PT(13); pg8::gemm_phase(F.lds, F.tid, 512, S, E); PT(14); }
            for (int rep = 0; rep < REPN(7); ++rep) stage_rw_readout(F, l); for (int rep = 0; rep < REPN(8); ++rep) stage_hy_post(F, l, nrl); STAGE_END(sb + 6)
        STAGE(sb + 7) pg8::SchedMerge S; S.A0 = (const char*)(ws + WS_YHY); S.A1 = (const char*)(ws + WS_YRW); S.A2 = (const char*)(ws + WS_YS5); S.Bt = (const char*)(wl + WO_WBR); S.tstep = (size_t)256 * 512 * 2; S.bstride = (size_t)1024 * 512 * 2;
            S.nM = nrl / 256; S.nN = 4; S.G = F.G; S.c = F.bid;
            pg8::EpiMerge E{(bf16*)(ws + WS_MTMP), (bf16*)(ws + WS_H), (const bf16*)(ws + WS_Z) + GATE_OFF}; pg8::gemm_phase(F.lds, F.tid, 512, S, E); STAGE_END(sb + 7)
        STAGE(sb + 8) pg8::SchedStatic S; S.init(ws + WS_H, wl + WO_WOUT, nrl, 1024, 1024, F.G, F.bid); pg8::EpiResid E{(float*)(ws + WS_X), (const float*)(ws + WS_MOD) + (size_t)l * 9 * 6144 + 2048};
            pg8::gemm_phase(F.lds, F.tid, 1024, S, E); STAGE_END(sb + 8)
        STAGE(sb + 9) PT(17); stage_norm2_router(F, l, nrl); PT(18); STAGE_END(sb + 9)
        STAGE(sb + 10) LAS int* base = load_moe_base(F, l); moe_fix_pos(F, nrl, base);
            pg8::SchedMoeG S; S.A = (const char*)(ws + WS_H); S.rowof = (const unsigned*)(ws + WS_ROWOF); S.Bt = (const char*)(wl + WO_W1); S.tstep = (size_t)256 * 1024 * 2; S.estride = (size_t)2048 * 1024 * 2; S.NPN = 8; S.G = F.G; S.c = F.bid; S.base = base;
            pg8::EpiGlu<1> E{(bf16*)(ws + WS_ACT), 1024, F.a->in[I_B1] + (size_t)l * 32 * 2048, 2048, 1024}; pg8::gemm_phase(F.lds, F.tid, 1024, S, E); STAGE_END(sb + 10)
        STAGE(sb + 11) LAS int* base = load_moe_base(F, l);
            pg8::SchedMoe S; S.A = (const char*)(ws + WS_ACT); S.Bt = (const char*)(wl + WO_W2); S.tstep = (size_t)256 * 1024 * 2; S.estride = (size_t)1024 * 1024 * 2; S.NPN = 4; S.G = F.G; S.c = F.bid; S.base = base;
            pg8::EpiBf16 E{(bf16*)(ws + WS_XS), 1024, F.a->in[I_B2] + (size_t)l * 32 * 1024, 1024}; pg8::gemm_phase(F.lds, F.tid, 1024, S, E); STAGE_END(sb + 11)
    }
    lq = DEPTH;
    STAGE(NSTAGES - 1)
#ifndef PROBE_T
        stage_norm1(F, l);
#endif
#ifdef PROBE_T
        { const unsigned long long* st = (const unsigned long long*)(F.a->ws + WS_CTL + CW_STAMP * 4); const float cval = (float)(long long)(st[PROBE_B] - st[PROBE_A]) * (1.0f / (100.0f * PROBE_DIV));
          __syncthreads(); for (size_t i = (size_t)F.bid * NTHREADS + F.tid; i < (size_t)T_LAT * D; i += (size_t)F.G * NTHREADS) F.a->out[i] = cval; }
#endif
    }
#undef IN
#undef SEAM
}

extern "C" void kernel_launch(void* const* d_in, const int* in_sizes, int n_in, void* d_out, int out_size, void* d_ws, size_t ws_size, hipStream_t stream) {
    static int grid = 0;
    if (grid == 0) {
        if (n_in != 51 || out_size != T_LAT * D || ws_size < WS_END) { fprintf(stderr, "kernel_launch: unexpected shapes (n_in %d out %d ws %zu, need %zu)\n", n_in, out_size, ws_size, (size_t)WS_END); grid = -1; return; }
        int dev = 0, cus = 0, per_cu = 0;
        if (hipGetDevice(&dev) != hipSuccess || hipDeviceGetAttribute(&cus, hipDeviceAttributeMultiprocessorCount, dev) != hipSuccess) { grid = -1; return; }
        if (hipFuncSetAttribute((const void*)mk_fwd, hipFuncAttributeMaxDynamicSharedMemorySize, LDS_BYTES) != hipSuccess) { fprintf(stderr, "kernel_launch: hipFuncSetAttribute failed\n"); grid = -1; return; }
        if (hipOccupancyMaxActiveBlocksPerMultiprocessor(&per_cu, (const void*)mk_fwd, NTHREADS, LDS_BYTES) != hipSuccess || per_cu < 1) fprintf(stderr, "kernel_launch: occupancy query says %d\n", per_cu);
        (void)hipGetLastError();
        grid = cus;
    }
    if (grid < 0) return;
    if (hipMemsetAsync((char*)d_ws + WS_CTL, 0, CTL_ZERO_BYTES, stream) != hipSuccess) return;
    Args a{};
    for (int i = 0; i < 51; ++i) a.in[i] = (const float*)d_in[i];
    a.out = (float*)d_out; a.ws = (unsigned char*)d_ws;
#if MK_PER_STAGE
    for (int s = 0; s < NSTAGES; ++s) { a.ph_lo = s; a.ph_hi = s + 1; int reps = 1;
#ifdef PROBE_SET
        { const int ls = (s == 0 || s == NSTAGES - 1) ? -1 : (s - 1) % NSTAGE_L;
          if (PROBE_SET >= 1 && PROBE_SET <= 13 && ls == PROBE_SET - 1 && ls != 5 && ls != 8 && !(ls == 0 && s > 1)) reps = 3;
          if (PROBE_SET == 14 && s == 0) reps = 3; }
#endif
        for (int r = 0; r < reps; ++r) hipLaunchKernelGGL(mk_fwd, dim3(grid), dim3(NTHREADS), LDS_BYTES, stream, a); }
#else
    a.ph_lo = 0; a.ph_hi = NSTAGES; hipLaunchKernelGGL(mk_fwd, dim3(grid), dim3(NTHREADS), LDS_BYTES, stream, a);
#endif
}
```

```cpp
#include <hip/hip_runtime.h>
#include <cstdio>
#include <cstdint>

#ifndef DUPK
#define DUPK 0
#endif
#define REPN(k) ((DUPK == (k)) ? 3 : 1)
#ifndef REP_GEMM
#define REP_GEMM 1
#endif
#ifndef REP_LIGHT
#define REP_LIGHT 1
#endif
#ifndef REP_PRO
#define REP_PRO 1
#endif
#ifndef MK_PER_STAGE
#define MK_PER_STAGE 0
#endif

#define GAS __attribute__((address_space(1)))
#define LAS __attribute__((address_space(3)))
typedef unsigned short bf16;
typedef unsigned v4u __attribute__((ext_vector_type(4)));
typedef unsigned v2u __attribute__((ext_vector_type(2)));
typedef float f32x4 __attribute__((ext_vector_type(4)));
typedef float f32x2 __attribute__((ext_vector_type(2)));
typedef short bf16x8 __attribute__((ext_vector_type(8)));

constexpr int D = 1024, BATCH = 8, SEQ = 4096, CTXL = 256, DEPTH = 2;
constexpr int T_LAT = BATCH * SEQ, T_CTX = BATCH * CTXL, T_ALL = T_LAT + T_CTX;
constexpr int IN_COLS = 6912, HY_OFF = 0, RW_OFF = 1536, S5_OFF = 3328, GATE_OFF = 3840;
constexpr int NE = 32, TOPK = 4;
constexpr int MAXSLOT = 147456;
constexpr int NWAVES = 8, NTHREADS = 512;
constexpr int HY_MARG = 128, HY_ROWB = 8720, HY_RLEN = 8272, HY_RLENC = 592;
constexpr int HY_R1_OFF = 8 * HY_ROWB, HY_R2_OFF = HY_R1_OFF + HY_RLEN * 2;

constexpr size_t MiB = 1ull << 20;
constexpr size_t WS_CTL = 0, CTL_ZERO_BYTES = 1 * MiB;
constexpr size_t WS_MOD = 1 * MiB;
constexpr size_t WS_BLKCNT = 2 * MiB;
constexpr size_t WS_META = 2 * MiB + 512 * 1024;
constexpr size_t WS_ROWOF = 480 * MiB;
constexpr int CW_CNT = 24576;
constexpr size_t WS_EIDX = 3 * MiB, WS_GATE = 4 * MiB, WS_POS = 5 * MiB;
constexpr size_t WS_WTS = 8 * MiB, WL_STRIDE = 214 * MiB;
constexpr size_t WO_WIN = 0, WO_RWCAT = 14 * MiB, WO_GLU = 16 * MiB, WO_WBR = 17 * MiB, WO_WOUT = 20 * MiB, WO_W1 = 22 * MiB, WO_W2 = 150 * MiB;
constexpr size_t WS_GF = 436 * MiB, GF_STRIDE = 20 * MiB, GF_CTX = 17 * MiB;
constexpr size_t WS_X = 504 * MiB;
constexpr size_t WS_H = 640 * MiB;
constexpr size_t WS_BIG = 708 * MiB;
constexpr size_t WS_Z = WS_BIG;
constexpr size_t WS_SCN = 1167 * MiB;
constexpr size_t WS_MTMP = WS_SCN;
constexpr size_t WS_P = 1473 * MiB;
constexpr size_t WS_ARW = 1643 * MiB;
constexpr size_t WS_YDIR = 1660 * MiB;
constexpr size_t WS_YP = 1898 * MiB;
constexpr size_t WS_UT = 1796 * MiB;
constexpr size_t WS_AS5 = 2000 * MiB;
constexpr size_t WS_YHY = 1898 * MiB, WS_YRW = 1932 * MiB, WS_YS5 = 1966 * MiB;
constexpr size_t WS_XS = WS_BIG;
constexpr size_t WS_ACT = WS_BIG + 288 * MiB;
constexpr size_t WS_END = 2034 * MiB;
constexpr int CW_BAR = 4096;

constexpr int RING_BYTES = 131072;
constexpr int LDSCTL_OFF = RING_BYTES;
constexpr int LDS_BYTES = 163840;

typedef __bf16 bf16x2_t __attribute__((ext_vector_type(2)));
__device__ __forceinline__ unsigned pk2(float lo, float hi) { const bf16x2_t v = __builtin_convertvector((f32x2){lo, hi}, bf16x2_t); return __builtin_bit_cast(unsigned, v); }
__device__ __forceinline__ unsigned f2bf(float f) { return pk2(f, 0.f) & 0xffffu; }
__device__ __forceinline__ float bf2f(bf16 b) { return __builtin_bit_cast(float, ((unsigned)b) << 16); }
__device__ __forceinline__ float bflo(unsigned w) { return __builtin_bit_cast(float, w << 16); }
__device__ __forceinline__ float bfhi(unsigned w) { return __builtin_bit_cast(float, w & 0xffff0000u); }
__device__ __forceinline__ float sigm(float x) { return __builtin_amdgcn_rcpf(1.f + __expf(-x)); }
__device__ __forceinline__ float tanh_fast(float x) { const float e = __expf(2.f * x); return 1.f - 2.f * __builtin_amdgcn_rcpf(e + 1.f); }
#define LDS_WAIT() asm volatile("s_waitcnt lgkmcnt(0)" ::: "memory")
__device__ __forceinline__ float dpp_f(float x, const int ctrl_sel) {
    const int v = __builtin_bit_cast(int, x);
    int r;
    if (ctrl_sel == 0) r = __builtin_amdgcn_update_dpp(0, v, 0xB1, 0xF, 0xF, true);
    else if (ctrl_sel == 1) r = __builtin_amdgcn_update_dpp(0, v, 0x4E, 0xF, 0xF, true);
    else r = __builtin_amdgcn_update_dpp(0, v, 0x141, 0xF, 0xF, true);
    return __builtin_bit_cast(float, r);
}
__device__ __forceinline__ float red32(float x) {
    x += dpp_f(x, 0); x += dpp_f(x, 1); x += dpp_f(x, 2);
    x += __builtin_bit_cast(float, __builtin_amdgcn_update_dpp(0, __builtin_bit_cast(int, x), 0x128, 0xF, 0xF, true));
    x += __builtin_bit_cast(float, __builtin_amdgcn_ds_swizzle(__builtin_bit_cast(int, x), 0x401F));
    return x;
}
__device__ __forceinline__ float wave_sum(float v) {
    v = red32(v);
    return __builtin_bit_cast(float, __builtin_amdgcn_readlane(__builtin_bit_cast(int, v), 0)) + __builtin_bit_cast(float, __builtin_amdgcn_readlane(__builtin_bit_cast(int, v), 32));
}
__device__ __forceinline__ int xch32(int v, const int step) {
    if (step == 0) return __builtin_amdgcn_update_dpp(0, v, 0xB1, 0xF, 0xF, true);
    if (step == 1) return __builtin_amdgcn_update_dpp(0, v, 0x4E, 0xF, 0xF, true);
    if (step == 2) return __builtin_amdgcn_update_dpp(0, v, 0x141, 0xF, 0xF, true);
    if (step == 3) return __builtin_amdgcn_update_dpp(0, v, 0x128, 0xF, 0xF, true);
    return __builtin_amdgcn_ds_swizzle(v, 0x401F);
}
__device__ __forceinline__ float red8(float x) { x += dpp_f(x, 0); x += dpp_f(x, 1); x += dpp_f(x, 2); return x; }

#define XB_TMO      128
#define XB_XCNT(j)  (256  + 64 * (j))
#define XB_XSUB(j)  (1280 + 64 * (j))
#define XB_XGEN(j)  (2304 + 64 * (j))
#define XB_TOP      3328
#define XB_TOPGEN   3392
#define XCD_BAR_WORDS 3456
#define XB_SPIN_CAP (1u << 22)
__device__ __forceinline__ unsigned xb_ld(unsigned* p)              { return __hip_atomic_load(p, __ATOMIC_RELAXED, __HIP_MEMORY_SCOPE_AGENT); }
__device__ __forceinline__ unsigned xb_add(unsigned* p, unsigned v) { return __hip_atomic_fetch_add(p, v, __ATOMIC_RELAXED, __HIP_MEMORY_SCOPE_AGENT); }
__device__ __forceinline__ unsigned xb_xcc_id() { return (unsigned)__builtin_amdgcn_s_getreg((3 << 11) | 20) & 0xFu; }
#define XB_SPIN(cond, bar) do { unsigned _sp = 0; while (cond) { __builtin_amdgcn_s_sleep(1); \
    if ((++_sp & 255u) == 0u) { if (xb_ld(&(bar)[XB_TMO])) break; if (_sp > XB_SPIN_CAP) { atomicAdd(&(bar)[XB_TMO], 1u); break; } } } } while (0)
struct XcdBarrier { unsigned* bar; unsigned x; volatile LAS unsigned* st; };
__device__ __forceinline__ XcdBarrier xcd_barrier_post(unsigned* bar, volatile LAS unsigned* st) {
    XcdBarrier b; b.bar = bar; b.x = xb_xcc_id(); b.st = st;
    if (threadIdx.x == 0) (void)xb_add(&bar[XB_XCNT(b.x)], 1u);
    return b;
}
__device__ __forceinline__ void xcd_barrier_complete(unsigned* bar, unsigned x, unsigned& nloc, unsigned& nx) {
    const unsigned G = gridDim.x * gridDim.y * gridDim.z;
    unsigned sum, cnt, mine, sp = 0u;
    for (;;) {
        sum = 0u; cnt = 0u; mine = 0u;
#pragma unroll
        for (unsigned j = 0; j < 16; ++j) { const unsigned c = xb_ld(&bar[XB_XCNT(j)]); sum += c; cnt += (c > 0u) ? 1u : 0u; mine = (j == x) ? c : mine; }
        if (sum == G) break;
        __builtin_amdgcn_s_sleep(1);
        if ((++sp & 255u) == 0u) { if (xb_ld(&bar[XB_TMO])) break; if (sp > XB_SPIN_CAP) { atomicAdd(&bar[XB_TMO], 1u); break; } }
    }
    nloc = mine > 0u ? mine : 1u; nx = cnt > 0u ? cnt : 1u;
}
__device__ __forceinline__ void xcd_barrier(const XcdBarrier& b) {
    asm volatile("s_waitcnt vmcnt(0)" ::: "memory");
    __syncthreads();
    if (threadIdx.x == 0) {
        unsigned* bar = b.bar;
        __builtin_amdgcn_s_waitcnt(0);
        unsigned nloc = b.st[0], nx = b.st[1];
        if (nloc == 0u) { xcd_barrier_complete(bar, b.x, nloc, nx); b.st[0] = nloc; b.st[1] = nx; }
        const unsigned old = xb_add(&bar[XB_XSUB(b.x)], 1u);
        const unsigned gen = old / nloc;
        if (old + 1u == (gen + 1u) * nloc) {
            __builtin_amdgcn_fence(__ATOMIC_RELEASE, "agent");
            asm volatile("s_waitcnt vmcnt(0)" ::: "memory");
            const unsigned og = xb_add(&bar[XB_TOP], 1u);
            const unsigned tg = og / nx;
            if (og + 1u == (tg + 1u) * nx) xb_add(&bar[XB_TOPGEN], 1u);
            else XB_SPIN(xb_ld(&bar[XB_TOPGEN]) == tg, bar);
            __builtin_amdgcn_fence(__ATOMIC_ACQUIRE, "agent");
            xb_add(&bar[XB_XGEN(b.x)], 1u);
            asm volatile("s_waitcnt vmcnt(0)" ::: "memory");
        } else {
            XB_SPIN(xb_ld(&bar[XB_XGEN(b.x)]) == gen, bar);
            __builtin_amdgcn_fence(__ATOMIC_ACQUIRE, "agent");
            asm volatile("s_waitcnt vmcnt(0)" ::: "memory");
        }
    }
    __syncthreads();
}

namespace pg8 {
constexpr int MOE_CAP = 34816;
constexpr int BM = 256, BK = 64, HALF = 128, HTB = HALF * BK * 2, STAGE_BYTES = 8 * HTB, NXCD = 8, WGM = 8, ROWTAB_OFF = 131072 + 4096;
__host__ __device__ __forceinline__ int lds_byte(int r, int c) { const int st = (r >> 4) * 2 + (c >> 5), rr = r & 15, cc = c & 31, ob = rr * 64 + cc * 2; return st * 1024 + (ob ^ (((ob >> 9) & 1) << 5)); }
__host__ __device__ __forceinline__ void stage_rc(int b, int& R, int& C) { const int st = b / 1024, sb = b % 1024, swz = sb ^ (((sb >> 9) & 1) << 5); R = (st >> 1) * 16 + swz / 64; C = (st & 1) * 32 + (swz % 64) / 2; }
__host__ __device__ __forceinline__ int perm32(int rho) { const int n = rho >> 4, i = rho & 15; return 8 * (i >> 2) + 4 * n + (i & 3); }
struct Unit { int pm, pn, e; };
__device__ __forceinline__ unsigned cvt_pk_bf16(float lo, float hi) { return pk2(lo, hi); }

__device__ __forceinline__ void tile_of(int L, int nM, int nN, int& pm, int& pn) {
    const int nwg = nM * nN; int wgid = L;
    { const int q = nwg / NXCD, r = nwg % NXCD, xcd = wgid % NXCD, off = wgid / NXCD; wgid = (xcd < r ? xcd * (q + 1) : r * (q + 1) + (xcd - r) * q) + off; }
    const int nig = WGM * nN, gid = wgid / nig, fm = gid * WGM, gsz = (nM - fm) < WGM ? (nM - fm) : WGM;
    pm = fm + ((wgid % nig) % gsz); pn = (wgid % nig) / gsz;
}
struct SchedStatic {
    static constexpr bool GATHER = false;
    const char* A; const char* Bt; size_t tstep; int nM, nN, G, c;
    __device__ __forceinline__ void init(const void* A_, const void* Bt_, int M, int N, int K, int G_, int c_) { A = (const char*)A_; Bt = (const char*)Bt_; tstep = (size_t)BM * K * 2; nM = M / BM; nN = N / BM; G = G_; c = c_; }
    __device__ __forceinline__ bool next(int i, Unit& u) const { const long L = (long)i * G + c; if (L >= (long)nM * nN) return false; tile_of((int)L, nM, nN, u.pm, u.pn); u.e = 0; return true; }
    __device__ __forceinline__ const char* aptr(const Unit& u) const { return A + (size_t)u.pm * tstep; }
    __device__ __forceinline__ const char* bptr(const Unit& u) const { return Bt + (size_t)u.pn * tstep; }
};
struct SchedWin {
    static constexpr bool GATHER = false;
    const char* A; const char* Bt; size_t tstep; int G, c, part;
    __device__ __forceinline__ bool next(int i, Unit& u) const {
        const int L = i * G + c, nmf = part ? 128 : 136, nfull = nmf * 27; u.e = 0;
        if (L < nfull) { tile_of(L, nmf, 27, u.pm, u.pn); return true; }
        const int L2 = L - nfull; if (!part || L2 >= 8 * 9) return false;
        u.pm = 128 + L2 / 9; u.pn = 6 + L2 % 9; return true; }
    __device__ __forceinline__ const char* aptr(const Unit& u) const { return A + (size_t)u.pm * tstep; }
    __device__ __forceinline__ const char* bptr(const Unit& u) const { return Bt + (size_t)u.pn * tstep; }
};
struct SchedMerge {
    static constexpr bool GATHER = false;
    const char* A0; const char* A1; const char* A2; const char* Bt; size_t tstep, bstride; int nM, nN, G, c;
    __device__ __forceinline__ bool next(int i, Unit& u) const { const int j = i / 3, br = i - 3 * j; const long L = (long)j * G + c; if (L >= (long)nM * nN) return false; tile_of((int)L, nM, nN, u.pm, u.pn); u.e = br; return true; }
    __device__ __forceinline__ const char* aptr(const Unit& u) const { return (u.e == 0 ? A0 : (u.e == 1 ? A1 : A2)) + (size_t)u.pm * tstep; }
    __device__ __forceinline__ const char* bptr(const Unit& u) const { return Bt + (size_t)u.e * bstride + (size_t)u.pn * tstep; }
};
struct SchedMoe {
    static constexpr bool GATHER = false;
    const char* A; const char* Bt; size_t tstep, estride; int NPN, G, c; const LAS int* base;
    __device__ __forceinline__ bool next(int i, Unit& u) const {
        const int ntiles = base[32] >> 8; const int per = G >> 3;
        const long L = (long)i * G + (((G & 7) == 0) ? (c & 7) * per + (c >> 3) : c);
        if (L >= (long)ntiles * NPN) return false;
        u.pm = (int)(L / NPN); u.pn = (int)(L % NPN); const int r0 = u.pm << 8; int e = 0;
#pragma unroll 1
        for (int k = 1; k < 32; ++k) e += (r0 >= base[k]) ? 1 : 0;
        u.e = e; return true;
    }
    __device__ __forceinline__ const char* aptr(const Unit& u) const { return A + (size_t)u.pm * tstep; }
    __device__ __forceinline__ const char* bptr(const Unit& u) const { return Bt + (size_t)u.e * estride + (size_t)u.pn * tstep; }
};
struct SchedMoeG : SchedMoe {
    static constexpr bool GATHER = true;
    const unsigned* rowof;
    __device__ __forceinline__ const char* aptr(const Unit&) const { return A; }
    __device__ __forceinline__ const unsigned* rowptr(const Unit& u) const { return rowof + (size_t)u.e * MOE_CAP + ((u.pm << 8) - base[u.e]); }
    __device__ __forceinline__ int valid(const Unit& u) const { return base[64 + u.e] - ((u.pm << 8) - base[u.e]); }
};

template <class Epi, class Sched>
__device__ __forceinline__ void gemm_phase(LAS unsigned char* lds, const int tid, const int K, const Sched& S, const Epi& E) {
    const int wid = __builtin_amdgcn_readfirstlane(tid >> 6), lane = tid & 63, wr = wid >> 2, wc = wid & 3, fr = lane & 15, fq = lane >> 4;
    const int nt = K / BK;
    unsigned voffA[2], voffB[2];
#pragma unroll
    for (int i = 0; i < 2; ++i) { int R, C; stage_rc(tid * 16 + i * 8192, R, C); const int Rb = Epi::PERM ? ((R & ~31) + perm32(R & 31)) : R;
        voffA[i] = (unsigned)(R * K + C) * 2u; voffB[i] = (unsigned)(Rb * K + C) * 2u; }
    const size_t kstep = (size_t)(BK * 2);
    const size_t hstep = (size_t)HALF * K * 2;
    const unsigned ldsw = (unsigned)wid * 1024u;
    const int aoff = lds_byte(wr * 64 + fr, fq * 8), boff = lds_byte(wc * 32 + fr, fq * 8);
#define PG8_SA(b, h) (((b) * 2 + (h)) * HTB)
#define PG8_SB(b, h) ((4 + (b) * 2 + (h)) * HTB)
#define PG8_STAGE(bufoff, gbase, voff) do { _Pragma("unroll") for (int _i = 0; _i < 2; ++_i) \
        __builtin_amdgcn_global_load_lds((const unsigned*)((const char*)(gbase) + (voff)[_i]), (LAS unsigned*)(lds + (bufoff) + ldsw + _i * 8192), 16, 0, 0); } while (0)
#define PG8_STAGEA(bufoff, kp, h) do { if constexpr (Sched::GATHER) { _Pragma("unroll") for (int _i = 0; _i < 2; ++_i) \
        __builtin_amdgcn_global_load_lds((const unsigned*)((const char*)(kp) + g[2 * (h) + _i]), (LAS unsigned*)(lds + (bufoff) + ldsw + _i * 8192), 16, 0, 0); } \
        else { PG8_STAGE(bufoff, (kp) + (h) * hstep, voffA); } } while (0)
#define PG8_GLOAD(un_, buf) do { const LAS unsigned* rt_ = (const LAS unsigned*)(lds + ROWTAB_OFF + (buf) * 1024) + gR0; const int nv_ = S.valid(un_); \
        _Pragma("unroll") for (int _j = 0; _j < 4; ++_j) g[_j] = ((gR0 + 64 * _j < nv_) ? rt_[64 * _j] : 0u) + gCb; } while (0)
#define PG8_GDMA(un_, buf) do { if (wid == 0) { unsigned lo_ = (unsigned)threadIdx.x; asm volatile("" : "+v"(lo_)); lo_ = (lo_ & 63u) * 16u; \
        __builtin_amdgcn_global_load_lds((const unsigned*)((const char*)S.rowptr(un_) + lo_), (LAS unsigned*)(lds + ROWTAB_OFF + (buf) * 1024), 16, 0, 0); } } while (0)
#define PG8_LDA(dst, b, h) do { _Pragma("unroll") for (int m = 0; m < 4; ++m) _Pragma("unroll") for (int k = 0; k < 2; ++k) dst[m][k] = *(const LAS bf16x8*)(lds + PG8_SA(b, h) + aoff + m * 2048 + k * 1024); } while (0)
#define PG8_LDB(dst, b, h) do { _Pragma("unroll") for (int n = 0; n < 2; ++n) _Pragma("unroll") for (int k = 0; k < 2; ++k) dst[n][k] = *(const LAS bf16x8*)(lds + PG8_SB(b, h) + boff + n * 2048 + k * 1024); } while (0)
#define PG8_MMA(ai, bj, At, Bt) do { __builtin_amdgcn_s_setprio(1); _Pragma("unroll") for (int m = 0; m < 4; ++m) _Pragma("unroll") for (int n = 0; n < 2; ++n) _Pragma("unroll") for (int k = 0; k < 2; ++k) \
        acc[ai][bj][m][n] = __builtin_amdgcn_mfma_f32_16x16x32_bf16(Bt[n][k], At[m][k], acc[ai][bj][m][n], 0, 0, 0); __builtin_amdgcn_s_setprio(0); } while (0)
#define PG8_WAIT_V(n) asm volatile("s_waitcnt vmcnt(" #n ")" ::: "memory")
#define PG8_WAIT_L(n) asm volatile("s_waitcnt lgkmcnt(" #n ")" ::: "memory")
#define PG8_BAR __builtin_amdgcn_s_barrier()
#define PG8_SCHED __builtin_amdgcn_sched_barrier(0)
    Unit cur, nxt; int ui = 0;
    if (!S.next(0, cur)) return;
    f32x4 acc[2][2][4][2];
#pragma unroll
    for (int a = 0; a < 2; ++a)
#pragma unroll
        for (int b = 0; b < 2; ++b)
#pragma unroll
            for (int m = 0; m < 4; ++m)
#pragma unroll
                for (int n = 0; n < 2; ++n) acc[a][b][m][n] = (f32x4){0.f, 0.f, 0.f, 0.f};
    bf16x8 At[4][2], B0[2][2], B1[2][2];
    const char* cA = S.aptr(cur); const char* cB = S.bptr(cur);
    unsigned g[4] = {0u, 0u, 0u, 0u}; int gR0 = 0; unsigned gCb = 0u;
    if constexpr (Sched::GATHER) { int R, C; stage_rc(tid * 16, R, C); gR0 = R; gCb = (unsigned)C * 2u;
        PG8_GDMA(cur, 0); PG8_WAIT_V(0); PG8_BAR; PG8_GLOAD(cur, 0); }
    PG8_STAGE(PG8_SB(0, 0), cB, voffB); PG8_STAGE(PG8_SB(0, 1), cB + hstep, voffB); PG8_STAGEA(PG8_SA(0, 0), cA, 0); PG8_STAGEA(PG8_SA(0, 1), cA, 1);
    if (wr == 1) PG8_BAR;
    PG8_WAIT_V(2); PG8_BAR;
    PG8_STAGE(PG8_SB(1, 0), cB + kstep, voffB); PG8_STAGEA(PG8_SA(1, 0), cA + kstep, 0); PG8_STAGE(PG8_SB(1, 1), cB + hstep + kstep, voffB);
    PG8_WAIT_V(6); PG8_BAR;
    for (;;) {
        const bool has_next = S.next(ui + 1, nxt);
        const char* nA = has_next ? S.aptr(nxt) : cA; const char* nB = has_next ? S.bptr(nxt) : cB;
        if constexpr (Sched::GATHER) { if (has_next) PG8_GDMA(nxt, (ui + 1) & 1); }
        for (int t = 0; t < nt; t += 2) {
            const bool last = (t == nt - 2);
            const char* a1 = cA + (size_t)(t + 1) * kstep;
            const char* a2 = last ? nA : cA + (size_t)(t + 2) * kstep; const char* b2 = last ? nB : cB + (size_t)(t + 2) * kstep;
            const char* a3 = a2 + kstep; const char* b3 = b2 + kstep;
            PG8_LDB(B0, 0, 0); PG8_LDB(B1, 0, 1); PG8_SCHED; PG8_LDA(At, 0, 0); PG8_STAGEA(PG8_SA(1, 1), a1, 1);
            PG8_WAIT_V(8); PG8_WAIT_L(0); PG8_BAR; PG8_MMA(0, 0, At, B0); PG8_MMA(0, 1, At, B1); PG8_BAR; PG8_SCHED;
            if constexpr (Sched::GATHER) { if (last && has_next) PG8_GLOAD(nxt, (ui + 1) & 1); PG8_SCHED; }
            PG8_LDA(At, 0, 1); PG8_STAGE(PG8_SB(0, 0), b2, voffB); PG8_STAGE(PG8_SB(0, 1), b2 + hstep, voffB); PG8_STAGEA(PG8_SA(0, 0), a2, 0);
            PG8_WAIT_V(8); PG8_WAIT_L(0); PG8_BAR; PG8_MMA(1, 0, At, B0); PG8_MMA(1, 1, At, B1); PG8_BAR; PG8_SCHED;
            PG8_LDB(B0, 1, 0); PG8_LDB(B1, 1, 1); PG8_SCHED; PG8_LDA(At, 1, 0); PG8_STAGEA(PG8_SA(0, 1), a2, 1);
            PG8_WAIT_V(8); PG8_WAIT_L(0); PG8_BAR; PG8_MMA(0, 0, At, B0); PG8_MMA(0, 1, At, B1); PG8_BAR; PG8_SCHED;
            PG8_LDA(At, 1, 1); PG8_STAGE(PG8_SB(1, 0), b3, voffB); PG8_STAGE(PG8_SB(1, 1), b3 + hstep, voffB); PG8_STAGEA(PG8_SA(1, 0), a3, 0);
            PG8_WAIT_V(8); PG8_WAIT_L(0); PG8_BAR; PG8_MMA(1, 0, At, B0); PG8_MMA(1, 1, At, B1); PG8_BAR; PG8_SCHED;
        }
        if (wr == 0) PG8_BAR;
        { int t2_ = (int)threadIdx.x; asm volatile("" : "+v"(t2_)); E(acc, cur, wr, wc, t2_ & 15, (t2_ >> 4) & 3); }
        if (!has_next) break;
#pragma unroll
        for (int a = 0; a < 2; ++a)
#pragma unroll
            for (int b = 0; b < 2; ++b)
#pragma unroll
                for (int m = 0; m < 4; ++m)
#pragma unroll
                    for (int n = 0; n < 2; ++n) acc[a][b][m][n] = (f32x4){0.f, 0.f, 0.f, 0.f};
        cur = nxt; cA = nA; cB = nB; ++ui;
        if (wr == 1) PG8_BAR;
    }
    PG8_WAIT_V(0);
    PG8_BAR;
#undef PG8_SA
#undef PG8_SB
#undef PG8_STAGE
#undef PG8_STAGEA
#undef PG8_GLOAD
#undef PG8_GDMA
#undef PG8_LDA
#undef PG8_LDB
#undef PG8_MMA
#undef PG8_WAIT_V
#undef PG8_WAIT_L
#undef PG8_BAR
#undef PG8_SCHED
}

struct EpiBf16 {
    static constexpr bool PERM = true;
    bf16* O; int ldc; const float* bias; int bias_stride;
    __device__ __forceinline__ void operator()(const f32x4 (&acc)[2][2][4][2], const Unit& u, int wr, int wc, int fr, int fq) const {
        const int row0 = u.pm * BM + wr * 64 + fr, col0 = u.pn * BM + wc * 32 + 8 * fq;
        f32x4 bv[2][2];
#pragma unroll
        for (int bj = 0; bj < 2; ++bj)
#pragma unroll
            for (int n = 0; n < 2; ++n) bv[bj][n] = bias ? *(const f32x4*)(bias + (size_t)u.e * bias_stride + col0 + bj * HALF + 4 * n) : (f32x4){0.f, 0.f, 0.f, 0.f};
#pragma unroll
        for (int ai = 0; ai < 2; ++ai)
#pragma unroll
            for (int m = 0; m < 4; ++m) { bf16* rowp = O + (size_t)(row0 + ai * HALF + m * 16) * ldc + col0;
#pragma unroll
                for (int bj = 0; bj < 2; ++bj) { const f32x4 v0 = acc[ai][bj][m][0] + bv[bj][0], v1 = acc[ai][bj][m][1] + bv[bj][1];
                    v4u w; w.x = cvt_pk_bf16(v0[0], v0[1]); w.y = cvt_pk_bf16(v0[2], v0[3]); w.z = cvt_pk_bf16(v1[0], v1[1]); w.w = cvt_pk_bf16(v1[2], v1[3]);
                    *(v4u*)(rowp + bj * HALF) = w; } }
    }
};
template <int MODE> struct EpiGlu {
    static constexpr bool PERM = true;
    bf16* O; int ldc; const float* bias; int bias_stride, hs;
    __device__ __forceinline__ void operator()(const f32x4 (&acc)[2][2][4][2], const Unit& u, int wr, int wc, int fr, int fq) const {
        const int row0 = u.pm * BM + wr * 64 + fr, col0 = u.pn * HALF + wc * 32 + 8 * fq;
        const float* bp = bias + (size_t)u.e * bias_stride + col0;
        f32x4 ba[2], bb[2];
#pragma unroll
        for (int n = 0; n < 2; ++n) { ba[n] = *(const f32x4*)(bp + 4 * n); bb[n] = *(const f32x4*)(bp + hs + 4 * n); }
#pragma unroll
        for (int ai = 0; ai < 2; ++ai)
#pragma unroll
            for (int m = 0; m < 4; ++m) { bf16* rowp = O + (size_t)(row0 + ai * HALF + m * 16) * ldc + col0;
                float o[8];
#pragma unroll
                for (int n = 0; n < 2; ++n) { const f32x4 a = acc[ai][0][m][n] + ba[n], b = acc[ai][1][m][n] + bb[n];
#pragma unroll
                    for (int j = 0; j < 4; ++j) {
                        if (MODE == 0) o[4 * n + j] = a[j] * sigm(b[j]);
                        else { const float g = fminf(a[j], 7.f), up = fminf(fmaxf(b[j], -7.f), 7.f); o[4 * n + j] = (up + 1.f) * g * sigm(1.702f * g); } } }
                v4u w; w.x = cvt_pk_bf16(o[0], o[1]); w.y = cvt_pk_bf16(o[2], o[3]); w.z = cvt_pk_bf16(o[4], o[5]); w.w = cvt_pk_bf16(o[6], o[7]);
                *(v4u*)rowp = w; }
    }
};
struct EpiMerge {
    static constexpr bool PERM = true;
    bf16* mtmp; bf16* Mo; const bf16* zg;
    __device__ __forceinline__ void operator()(const f32x4 (&acc)[2][2][4][2], const Unit& u, int wr, int wc, int fr, int fq) const {
        const int row0 = u.pm * BM + wr * 64 + fr, col0 = u.pn * BM + wc * 32 + 8 * fq;
#pragma unroll
        for (int ai = 0; ai < 2; ++ai)
#pragma unroll
            for (int m = 0; m < 4; ++m) { const size_t r = (size_t)(row0 + ai * HALF + m * 16);
#pragma unroll
                for (int bj = 0; bj < 2; ++bj) { const int c = col0 + bj * HALF;
                    const v4u gz = *(const v4u*)(zg + r * IN_COLS + u.e * 1024 + c);
                    float g[8] = {bflo(gz.x), bfhi(gz.x), bflo(gz.y), bfhi(gz.y), bflo(gz.z), bfhi(gz.z), bflo(gz.w), bfhi(gz.w)};
                    f32x4 t0, t1; bf16* tp = mtmp + r * 1024 + c;
                    if (u.e == 0) { t0 = (f32x4){0.f, 0.f, 0.f, 0.f}; t1 = t0; } else { const v4u pv = *(const v4u*)tp; t0 = (f32x4){bflo(pv.x), bfhi(pv.x), bflo(pv.y), bfhi(pv.y)}; t1 = (f32x4){bflo(pv.z), bfhi(pv.z), bflo(pv.w), bfhi(pv.w)}; }
#pragma unroll
                    for (int j = 0; j < 4; ++j) { t0[j] += sigm(g[j]) * acc[ai][bj][m][0][j]; t1[j] += sigm(g[4 + j]) * acc[ai][bj][m][1][j]; }
                    if (u.e < 2) { v4u w; w.x = cvt_pk_bf16(t0[0], t0[1]); w.y = cvt_pk_bf16(t0[2], t0[3]); w.z = cvt_pk_bf16(t1[0], t1[1]); w.w = cvt_pk_bf16(t1[2], t1[3]); *(v4u*)tp = w; }
                    else { v4u w; w.x = cvt_pk_bf16(t0[0], t0[1]); w.y = cvt_pk_bf16(t0[2], t0[3]); w.z = cvt_pk_bf16(t1[0], t1[1]); w.w = cvt_pk_bf16(t1[2], t1[3]);
                        *(v4u*)(Mo + r * 1024 + c) = w; } } }
    }
};
struct EpiResid {
    static constexpr bool PERM = false;
    float* X; const float* gmod;
    __device__ __forceinline__ void operator()(const f32x4 (&acc)[2][2][4][2], const Unit& u, int wr, int wc, int fr, int fq) const {
        const int row0 = u.pm * BM + wr * 64 + fr, col0 = u.pn * BM + wc * 32 + 4 * fq;
        const int r00 = u.pm * BM; const int w = r00 < T_LAT ? (r00 >> 12) : 8;
        f32x4 gv[2][2];
#pragma unroll
        for (int bj = 0; bj < 2; ++bj)
#pragma unroll
            for (int n = 0; n < 2; ++n) gv[bj][n] = *(const f32x4*)(gmod + (size_t)w * 6144 + col0 + bj * HALF + n * 16);
#pragma unroll
        for (int ai = 0; ai < 2; ++ai)
#pragma unroll
            for (int m = 0; m < 4; ++m) { float* rowp = X + (size_t)(row0 + ai * HALF + m * 16) * 1024 + col0;
#pragma unroll
                for (int bj = 0; bj < 2; ++bj)
#pragma unroll
                    for (int n = 0; n < 2; ++n) { f32x4* p = (f32x4*)(rowp + bj * HALF + n * 16); *p = *p + gv[bj][n] * acc[ai][bj][m][n]; } }
    }
};
}

struct Args { const float* in[51]; float* out; unsigned char* ws; int ph_lo, ph_hi; };
enum { I_X = 0, I_C, I_CTX, I_CCTX, I_ADAW, I_ADAB, I_N1G, I_N2G, I_WIN, I_HYCW, I_HYCB, I_HYW1, I_HYB1, I_HYF1, I_HYW2, I_HYB2, I_HYF2, I_HYW3, I_HYB3, I_HYBIAS,
       I_RWCW, I_RWCB, I_RWWUP, I_RWW0, I_RWAUP, I_RWA0, I_RWGUP, I_RWKK, I_RWKA, I_RWRK, I_RWLNG, I_RWLNB, I_S5ARE, I_S5AIM, I_S5LDT, I_S5BRE, I_S5BIM, I_S5CRE, I_S5CIM, I_S5D,
       I_S5GLUW, I_S5GLUB, I_WBR, I_WOUT, I_RTW, I_RTB, I_W1, I_B1, I_W2, I_B2, I_FING };

typedef const __attribute__((address_space(4))) Args* CArgsP;
__device__ __forceinline__ CArgsP kargs() { CArgsP p = (CArgsP)__builtin_amdgcn_kernarg_segment_ptr(); asm volatile("" : "+s"(p)); return p; }
__device__ __forceinline__ int opaque(int v) { asm volatile("" : "+s"(v)); return v; }
__device__ __forceinline__ int opaque_v(int v) { asm volatile("" : "+v"(v)); return v; }
struct Ctx { CArgsP a; LAS unsigned char* lds; int tid, lane, wave, bid, G; };

__device__ __forceinline__ void row_seq(int row, int& base, int& pos, int& n) {
    if (row < T_LAT) { base = row & ~(SEQ - 1); pos = row & (SEQ - 1); n = SEQ; }
    else { const int r = row - T_LAT; base = T_LAT + (r & ~(CTXL - 1)); pos = r & (CTXL - 1); n = CTXL; }
}
__device__ __forceinline__ float conv3z(const bf16* zc, int pos, int n, float w0, float w1, float w2, float b) {
    const float zm = pos > 0 ? bf2f(zc[(size_t)(pos - 1) * IN_COLS]) : 0.f, z0 = bf2f(zc[(size_t)pos * IN_COLS]), zp = pos < n - 1 ? bf2f(zc[(size_t)(pos + 1) * IN_COLS]) : 0.f;
    return zm * w0 + z0 * w1 + zp * w2 + b;
}

template <int MODE>
__device__ __forceinline__ void transpose_item(const float* W, int K, int N, bf16* WT, int Hs, LAS float* scr, int item, int lane) {
    const int nblk = N / 32, kb = item / nblk, nb = item % nblk, k0 = 64 * kb, n0 = 32 * nb;
#pragma unroll 8
    for (int i = 0; i < 32; ++i) { const int kk = 2 * i + (lane >> 5); scr[kk * 33 + (lane & 31)] = W[(size_t)(k0 + kk) * N + n0 + (lane & 31)]; }
    LDS_WAIT(); asm volatile("" ::: "memory");
    const int c = lane & 7;
#pragma unroll
    for (int j = 0; j < 4; ++j) { const int n = (lane >> 3) + 8 * j; const LAS float* s = scr + (8 * c) * 33 + n;
        v4u o; o.x = pk2(s[0 * 33], s[1 * 33]); o.y = pk2(s[2 * 33], s[3 * 33]); o.z = pk2(s[4 * 33], s[5 * 33]); o.w = pk2(s[6 * 33], s[7 * 33]);
        int dr = n0 + n;
        if (MODE == 1) { const int nc = n0 + n; const int jx = nc < Hs ? nc : nc - Hs; dr = (jx >> 7) * 256 + (nc < Hs ? 0 : 128) + (jx & 127); }
        *(v4u*)(WT + (size_t)dr * K + k0 + 8 * c) = o; }
    LDS_WAIT(); asm volatile("" ::: "memory");
}

__device__ __forceinline__ void p0_prologue(const Ctx& F) {
    const auto& a = *F.a; unsigned char* ws = a.ws;
    const int gw = F.bid * NWAVES + F.wave, NGW = F.G * NWAVES, lane = F.lane;
    float* X = (float*)(ws + WS_X);
    for (int t = gw; t < SEQ; t += NGW) {
        const float pr = (float)(t >> 6), pc = (float)(t & 63);
        f32x4 pe[4];
#pragma unroll
        for (int j = 0; j < 4; ++j)
#pragma unroll
            for (int e = 0; e < 4; ++e) { const float om = __builtin_amdgcn_exp2f((float)(4 * lane + e) * (-13.287712379549449f / 256.0f)); const float ang = ((j < 2) ? pr : pc) * om; pe[j][e] = (j & 1) ? __cosf(ang) : __sinf(ang); }
#pragma unroll 2
        for (int bb = 0; bb < BATCH; ++bb) { const size_t row = (size_t)bb * SEQ + t;
            const f32x4* xi = (const f32x4*)(a.in[I_X] + row * D) + lane; f32x4* xo = (f32x4*)(X + row * D) + lane;
#pragma unroll
            for (int j = 0; j < 4; ++j) xo[64 * j] = xi[64 * j] + pe[j]; }
    }
    for (int row = T_LAT + gw; row < T_ALL; row += NGW) {
        const f32x4* xi = (const f32x4*)(a.in[I_CTX] + (size_t)(row - T_LAT) * D) + lane; f32x4* xo = (f32x4*)(X + (size_t)row * D) + lane;
#pragma unroll
        for (int j = 0; j < 4; ++j) xo[64 * j] = xi[64 * j];
    }
    {
        LAS float* condl = (LAS float*)F.lds; LAS float* psum = (LAS float*)(F.lds + 40960);
        for (int i = F.tid; i < 9 * 1024; i += NTHREADS) { const int w = i >> 10, k = i & 1023; const float cv = (w < 8) ? a.in[I_C][w * 1024 + k] : a.in[I_CCTX][k]; condl[i] = cv / (1.f + expf(-cv)); }
        __syncthreads();
        float* MOD = (float*)(ws + WS_MOD);
        for (int it = F.bid; it < 2 * 96; it += F.G) {
            const int l = it / 96, cg = it % 96, col = cg * 64 + lane;
            float acc[9];
#pragma unroll
            for (int w = 0; w < 9; ++w) acc[w] = 0.f;
            const float* wp = a.in[I_ADAW] + ((size_t)l * 1024 + F.wave * 128) * 6144 + col;
#pragma unroll 1
            for (int k0 = 0; k0 < 128; k0 += 16) { float wv[16];
#pragma unroll
                for (int k = 0; k < 16; ++k) wv[k] = wp[(size_t)(k0 + k) * 6144];
#pragma unroll
                for (int k = 0; k < 16; ++k)
#pragma unroll
                    for (int w = 0; w < 9; ++w) acc[w] += condl[w * 1024 + F.wave * 128 + k0 + k] * wv[k]; }
#pragma unroll
            for (int w = 0; w < 9; ++w) psum[(F.wave * 9 + w) * 64 + lane] = acc[w];
            __syncthreads();
            if (F.wave == 0) {
#pragma unroll
                for (int w = 0; w < 9; ++w) { float s = 0.f;
#pragma unroll
                    for (int wv = 0; wv < 8; ++wv) s += psum[(wv * 9 + w) * 64 + lane];
                    MOD[(size_t)(l * 9 + w) * 6144 + col] = s + a.in[I_ADAB][l * 6144 + col]; }
            }
            __syncthreads();
        }
    }
    {
        LAS float* scr = (LAS float*)(F.lds + F.wave * 16384);
        constexpr int IT_W1 = 16 * 64, IT_W2 = 16 * 32, IT_WIN = 16 * 216, IT_GLU = 8 * 32, IT_WBR = 8 * 32, IT_WOUT = 16 * 32;
        constexpr int N_W1 = 64 * IT_W1, N_W2 = 64 * IT_W2, N_WIN = 2 * IT_WIN, N_GLU = 2 * IT_GLU, N_WBR = 6 * IT_WBR, N_WOUT = 2 * IT_WOUT;
        constexpr int NITEMS = N_W1 + N_W2 + N_WIN + N_GLU + N_WBR + N_WOUT;
        for (int it = gw; it < NITEMS; it += NGW) {
            int r = it;
            if (r < N_W1) { const int mtx = r / IT_W1, l = mtx >> 5, e = mtx & 31; transpose_item<1>(a.in[I_W1] + (size_t)mtx * 1024 * 2048, 1024, 2048, (bf16*)(ws + WS_WTS + l * WL_STRIDE + WO_W1) + (size_t)e * 2048 * 1024, 1024, scr, r % IT_W1, lane); continue; } r -= N_W1;
            if (r < N_W2) { const int mtx = r / IT_W2, l = mtx >> 5, e = mtx & 31; transpose_item<0>(a.in[I_W2] + (size_t)mtx * 1024 * 1024, 1024, 1024, (bf16*)(ws + WS_WTS + l * WL_STRIDE + WO_W2) + (size_t)e * 1024 * 1024, 0, scr, r % IT_W2, lane); continue; } r -= N_W2;
            if (r < N_WIN) { const int l = r / IT_WIN; transpose_item<0>(a.in[I_WIN] + (size_t)l * 1024 * IN_COLS, 1024, IN_COLS, (bf16*)(ws + WS_WTS + l * WL_STRIDE + WO_WIN), 0, scr, r % IT_WIN, lane); continue; } r -= N_WIN;
            if (r < N_GLU) { const int l = r / IT_GLU; transpose_item<1>(a.in[I_S5GLUW] + (size_t)l * 512 * 1024, 512, 1024, (bf16*)(ws + WS_WTS + l * WL_STRIDE + WO_GLU), 512, scr, r % IT_GLU, lane); continue; } r -= N_GLU;
            if (r < N_WBR) { const int mtx = r / IT_WBR, l = mtx / 3, br = mtx % 3; transpose_item<0>(a.in[I_WBR] + (size_t)mtx * 512 * 1024, 512, 1024, (bf16*)(ws + WS_WTS + l * WL_STRIDE + WO_WBR) + (size_t)br * 1024 * 512, 0, scr, r % IT_WBR, lane); continue; } r -= N_WBR;
            { const int l = r / IT_WOUT; transpose_item<0>(a.in[I_WOUT] + (size_t)l * 1024 * 1024, 1024, 1024, (bf16*)(ws + WS_WTS + l * WL_STRIDE + WO_WOUT), 0, scr, r % IT_WOUT, lane); }
        }
        for (int i = F.bid * NTHREADS + F.tid; i < 2 * 2560 * 256; i += F.G * NTHREADS) {
            const int l = i / (2560 * 256), r = i % (2560 * 256), n = r >> 8, k = r & 255; float v = 0.f;
            if (n < 1024) { if (k < 64) v = a.in[I_RWWUP][(((size_t)l * 2 + (n >> 9)) * 64 + k) * 512 + (n & 511)]; }
            else if (n < 2048) { if (k >= 64 && k < 128) v = a.in[I_RWAUP][(((size_t)l * 2 + ((n - 1024) >> 9)) * 64 + (k - 64)) * 512 + (n & 511)]; }
            else { if (k >= 128) v = a.in[I_RWGUP][((size_t)l * 128 + (k - 128)) * 512 + (n - 2048)]; }
            ((bf16*)(ws + WS_WTS + l * WL_STRIDE + WO_RWCAT))[r] = (bf16)f2bf(v);
        }
    }
    __syncthreads();
    {
        LAS float* feats = (LAS float*)F.lds; LAS float* h1 = feats + 8 * 33; LAS float* h2 = h1 + 8 * 64;
        constexpr int NIT = 2 * (512 + 32);
        for (int it = F.bid; it < NIT; it += F.G) {
            const int l = it / 544, r = it % 544, nsel = r >= 512, n = nsel ? CTXL : SEQ, p0 = (nsel ? r - 512 : r) * 8;
            if (F.tid < 8 * 33) { const int p = F.tid / 33, i = F.tid % 33, pos = p0 + p; float f;
                if (i == 0) f = (float)pos / (float)(n - 1);
                else { const int k = (i - 1) & 15; const float band = 1e-4f + (float)k * ((15.0f - 1e-4f) / 15.0f); const float ang = (6.283185307179586f * (float)pos / (float)n) * band; f = (i <= 16) ? cosf(ang) : -sinf(ang); }
                feats[p * 33 + i] = f; }
            __syncthreads();
            { const int p = F.tid >> 6, j = F.tid & 63; float s = a.in[I_HYB1][l * 64 + j]; const float* w1p = a.in[I_HYW1] + (size_t)l * 33 * 64 + j;
#pragma unroll
                for (int i = 0; i < 33; ++i) s += feats[p * 33 + i] * w1p[i * 64];
                h1[p * 64 + j] = sinf(a.in[I_HYF1][l * 64 + j] * s); }
            __syncthreads();
            { const int p = F.tid >> 6, j = F.tid & 63; float s = a.in[I_HYB2][l * 64 + j];
                const float* w2p = a.in[I_HYW2] + (size_t)l * 64 * 64 + j;
#pragma unroll 16
                for (int i = 0; i < 64; ++i) s += h1[p * 64 + i] * w2p[i * 64];
                h2[p * 64 + j] = sinf(a.in[I_HYF2][l * 64 + j] * s); }
            __syncthreads();
            float acc[4][8];
#pragma unroll
            for (int q = 0; q < 4; ++q)
#pragma unroll
                for (int p = 0; p < 8; ++p) acc[q][p] = 0.f;
            const float* w3 = a.in[I_HYW3] + (size_t)l * 64 * 2048 + F.tid;
#pragma unroll 8
            for (int i = 0; i < 64; ++i) { float wv[4];
#pragma unroll
                for (int q = 0; q < 4; ++q) wv[q] = w3[(size_t)i * 2048 + q * 512];
#pragma unroll
                for (int p = 0; p < 8; ++p) { const float hv = h2[p * 64 + i];
#pragma unroll
                    for (int q = 0; q < 4; ++q) acc[q][p] += hv * wv[q]; } }
            const int c = F.tid; const float dstart = logf(0.01f) / 1.5f, dstop = logf(0.01f) / 0.3f; const float delta = fabsf(dstart + (float)c * ((dstop - dstart) / 511.0f));
            const int RL = nsel ? HY_RLENC : HY_RLEN, off = n + 47; const float rn1 = 1.0f / (float)(n - 1);
            bf16* Rb = (bf16*)(ws + WS_GF + l * GF_STRIDE + (nsel ? GF_CTX : 0));
#pragma unroll
            for (int q = 0; q < 4; ++q) { const int o = q >> 1, side = q & 1; const float b3 = a.in[I_HYB3][l * 2048 + q * 512 + c];
                bf16* Rc = Rb + ((size_t)o * 512 + c) * RL;
#pragma unroll
                for (int p = 0; p < 8; ++p) { const int pos = p0 + p; const float t = (float)pos * rn1; const float val = (acc[q][p] + b3) * __expf(-t * delta);
                    if (side == 0) Rc[off - pos] = (bf16)f2bf(val);
                    else if (pos >= 1) Rc[off + pos] = (bf16)f2bf(val); }
                if (p0 == 0 && side == 0) { for (int m = 0; m < 48; ++m) Rc[m] = 0; for (int m = off + n; m < RL; ++m) Rc[m] = 0; } }
            __syncthreads();
        }
    }
}

__device__ __forceinline__ void stage_norm1(const Ctx& F, int l) {
    const auto& a = *F.a; unsigned char* ws = a.ws; const int lane = F.lane;
    const int gw = F.bid * NWAVES + F.wave, NGW = F.G * NWAVES;
    float* X = (float*)(ws + WS_X); bf16* H = (bf16*)(ws + WS_H); const float* MOD = (const float*)(ws + WS_MOD);
    const bf16* YS = (const bf16*)(ws + WS_XS); const int* POS = (const int*)(ws + WS_POS); const float* GATE = (const float*)(ws + WS_GATE);
    const int nrows = (l == DEPTH) ? T_LAT : T_ALL;
    f32x4 ngv[4];
    { const f32x4* ngp = (l == DEPTH) ? (const f32x4*)a.in[I_FING] + lane : (const f32x4*)(a.in[I_N1G] + l * D) + lane;
#pragma unroll
      for (int j = 0; j < 4; ++j) ngv[j] = ngp[64 * j]; }
    f32x4 vn[4]; v2u ysn[4][4]; int4 pnn = make_int4(0, 0, 0, 0); f32x4 gn = (f32x4){0.f, 0.f, 0.f, 0.f}, gnn = gn;
#pragma unroll
    for (int k = 0; k < 4; ++k)
#pragma unroll
        for (int j = 0; j < 4; ++j) ysn[k][j] = (v2u){0u, 0u};
#define N1_LDYS(p4_) do { const int pk_[4] = {(p4_).x, (p4_).y, (p4_).z, (p4_).w}; _Pragma("unroll") for (int k = 0; k < 4; ++k) { const v2u* yr_ = (const v2u*)(YS + (size_t)pk_[k] * D) + lane; \
        _Pragma("unroll") for (int j = 0; j < 4; ++j) ysn[k][j] = yr_[64 * j]; } } while (0)
    if (gw < nrows) {
#pragma unroll
        for (int j = 0; j < 4; ++j) vn[j] = ((const f32x4*)(X + (size_t)gw * D) + lane)[64 * j];
        if (l > 0) { const int4 p0 = *(const int4*)(POS + gw * 4); gn = *(const f32x4*)(GATE + gw * 4);
            if (gw + NGW < nrows) { pnn = *(const int4*)(POS + (gw + NGW) * 4); gnn = *(const f32x4*)(GATE + (gw + NGW) * 4); }
            N1_LDYS(p0); } }
#pragma unroll 1
    for (int row = gw; row < nrows; row += NGW) {
        const int w = row < T_LAT ? (row >> 12) : 8;
        f32x4* xr = (f32x4*)(X + (size_t)row * D) + lane;
        f32x4 v[4]; v2u ysc[4][4];
#pragma unroll
        for (int j = 0; j < 4; ++j) v[j] = vn[j];
#pragma unroll
        for (int k = 0; k < 4; ++k)
#pragma unroll
            for (int j = 0; j < 4; ++j) ysc[k][j] = ysn[k][j];
        const f32x4 gc = gn; const int4 pnx = pnn; gn = gnn;
        const int rn = row + NGW, rnn = row + 2 * NGW;
        if (rn < nrows) {
#pragma unroll
            for (int j = 0; j < 4; ++j) vn[j] = ((const f32x4*)(X + (size_t)rn * D) + lane)[64 * j];
            if (l > 0) N1_LDYS(pnx); }
        if (l > 0 && rnn < nrows) { pnn = *(const int4*)(POS + rnn * 4); gnn = *(const f32x4*)(GATE + rnn * 4); }
        f32x4 m0[4], m1[4], m2[4];
        if (l < DEPTH) {
#pragma unroll
            for (int j = 0; j < 4; ++j) { m0[j] = ((const f32x4*)(MOD + (size_t)(l * 9 + w) * 6144) + lane)[64 * j]; m1[j] = ((const f32x4*)(MOD + (size_t)(l * 9 + w) * 6144 + 1024) + lane)[64 * j]; } }
        if (l > 0) {
#pragma unroll
            for (int j = 0; j < 4; ++j) m2[j] = ((const f32x4*)(MOD + (size_t)((l - 1) * 9 + w) * 6144 + 5120) + lane)[64 * j];
            f32x4 mo[4];
#pragma unroll
            for (int j = 0; j < 4; ++j) mo[j] = (f32x4){0.f, 0.f, 0.f, 0.f};
#pragma unroll
            for (int k = 0; k < TOPK; ++k) { const float g = gc[k];
#pragma unroll
                for (int j = 0; j < 4; ++j) { const v2u y = ysc[k][j]; mo[j][0] += g * bflo(y.x); mo[j][1] += g * bfhi(y.x); mo[j][2] += g * bflo(y.y); mo[j][3] += g * bfhi(y.y); } }
#pragma unroll
            for (int j = 0; j < 4; ++j) { v[j] = v[j] + m2[j] * mo[j]; xr[64 * j] = v[j]; }
        }
        float ss = 0.f;
#pragma unroll
        for (int j = 0; j < 4; ++j) ss += (v[j][0] * v[j][0] + v[j][1] * v[j][1]) + (v[j][2] * v[j][2] + v[j][3] * v[j][3]);
        const float rstd = __builtin_amdgcn_rsqf(wave_sum(ss) * (1.f / D) + 1e-6f);
        if (l == DEPTH) {
            f32x4* o = (f32x4*)(a.out + (size_t)row * D) + lane;
#pragma unroll
            for (int j = 0; j < 4; ++j) o[64 * j] = v[j] * rstd * ngv[j];
        } else {
            v2u* ho = (v2u*)(H + (size_t)row * D) + lane;
#pragma unroll
            for (int j = 0; j < 4; ++j) { const f32x4 h = v[j] * rstd * ngv[j] * (m1[j] + 1.0f) + m0[j]; v2u o; o.x = pk2(h[0], h[1]); o.y = pk2(h[2], h[3]); ho[64 * j] = o; }
        }
    }
#undef N1_LDYS
}

__device__ __forceinline__ void stage_rw_prep1(const Ctx& F, int l) {
    const auto& a = *F.a; unsigned char* ws = a.ws;
    const bf16* __restrict__ Z = (const bf16*)(ws + WS_Z); bf16* __restrict__ ARW = (bf16*)(ws + WS_ARW);
    const int j = 4 * (F.tid & 63), col = 1536 + j, rq = F.tid >> 6;
    const float* cw = a.in[I_RWCW] + (size_t)l * 3 * 1792;
    const f32x4 w0 = *(const f32x4*)(cw + col), w1 = *(const f32x4*)(cw + 1792 + col), w2 = *(const f32x4*)(cw + 2 * 1792 + col), cb = *(const f32x4*)(a.in[I_RWCB] + l * 1792 + col);
#pragma unroll 4
    for (int row = F.bid * 8 + rq; row < T_ALL; row += F.G * 8) {
        int base, pos, n; row_seq(row, base, pos, n);
        const bf16* zc = Z + (size_t)row * IN_COLS + RW_OFF + col;
        const v2u z0 = *(const v2u*)zc;
        v2u zm = (v2u){0u, 0u}, zp = (v2u){0u, 0u};
        if (pos > 0) zm = *(const v2u*)(zc - IN_COLS);
        if (pos < n - 1) zp = *(const v2u*)(zc + IN_COLS);
        f32x4 v = (f32x4){bflo(zm.x), bfhi(zm.x), bflo(zm.y), bfhi(zm.y)} * w0 + (f32x4){bflo(z0.x), bfhi(z0.x), bflo(z0.y), bfhi(z0.y)} * w1 + (f32x4){bflo(zp.x), bfhi(zp.x), bflo(zp.y), bfhi(zp.y)} * w2 + cb;
#pragma unroll
        for (int e2 = 0; e2 < 4; ++e2) { if (j < 64) v[e2] = tanh_fast(v[e2]); else if (j >= 128) v[e2] = sigm(v[e2]); }
        v2u o; o.x = pk2(v[0], v[1]); o.y = pk2(v[2], v[3]);
        *(v2u*)(ARW + (size_t)row * 256 + j) = o;
    }
}

__device__ __forceinline__ void stage_rw_prep2(const Ctx& F, int l) {
    const auto& a = *F.a; unsigned char* ws = a.ws; const int lane = F.lane;
    const bf16* Z = (const bf16*)(ws + WS_Z); const bf16* P = (const bf16*)(ws + WS_P); bf16* SCN = (bf16*)(ws + WS_SCN);
    const int gw = F.bid * NWAVES + F.wave, NGW = F.G * NWAVES;
    constexpr int TR = 17, NRT = T_ALL / TR;
    const float* cw = a.in[I_RWCW] + (size_t)l * 3 * 1792; const float* cbp = a.in[I_RWCB] + l * 1792;
    for (int tile = gw; tile < NRT * 4; tile += NGW) {
        const int rt = tile % NRT, hp = tile / NRT, row0 = rt * TR, c0 = hp * 128 + 2 * lane;
        f32x2 w[3][3], cb[3];
#pragma unroll
        for (int s = 0; s < 3; ++s) { cb[s] = *(const f32x2*)(cbp + s * 512 + c0);
#pragma unroll
            for (int j = 0; j < 3; ++j) w[s][j] = *(const f32x2*)(cw + j * 1792 + s * 512 + c0); }
        const f32x2 KKw = *(const f32x2*)(a.in[I_RWKK] + l * 512 + c0), KAw = *(const f32x2*)(a.in[I_RWKA] + l * 512 + c0);
        f32x2 W0[2], A0[2];
#pragma unroll
        for (int d = 0; d < 2; ++d) { W0[d] = *(const f32x2*)(a.in[I_RWW0] + (l * 2 + d) * 512 + c0); A0[d] = *(const f32x2*)(a.in[I_RWA0] + (l * 2 + d) * 512 + c0); }
        const unsigned* zb = (const unsigned*)(Z + RW_OFF + c0);
        unsigned zw[8][3], pw_[8][4];
#define P2_LDZ(j_) do { const int rr_ = row0 + (j_); if (rr_ >= 0 && rr_ < T_ALL) { _Pragma("unroll") for (int s = 0; s < 3; ++s) zw[((j_) + 1) & 7][s] = zb[(size_t)rr_ * (IN_COLS / 2) + s * 256]; } \
        else { _Pragma("unroll") for (int s = 0; s < 3; ++s) zw[((j_) + 1) & 7][s] = 0u; } } while (0)
#define P2_LDP(j_) do { const unsigned* pr_ = (const unsigned*)(P + (size_t)(row0 + (j_)) * 2560 + c0); pw_[(j_) & 7][0] = pr_[0]; pw_[(j_) & 7][1] = pr_[512]; pw_[(j_) & 7][2] = pr_[256]; pw_[(j_) & 7][3] = pr_[768]; } while (0)
        P2_LDZ(-1); P2_LDZ(0); P2_LDZ(1); P2_LDZ(2); P2_LDZ(3); P2_LDP(0); P2_LDP(1); P2_LDP(2);
#pragma unroll
        for (int i = 0; i < TR; ++i) {
            const int row = row0 + i; int base, pos, n; row_seq(row, base, pos, n);
            if (i + 4 <= TR) P2_LDZ(i + 4);
            if (i + 3 < TR) P2_LDP(i + 3);
            unsigned zm[3], z0[3], zp[3], pc_[4];
#pragma unroll
            for (int s = 0; s < 3; ++s) { zm[s] = zw[i & 7][s]; z0[s] = zw[(i + 1) & 7][s]; zp[s] = zw[(i + 2) & 7][s]; }
#pragma unroll
            for (int e = 0; e < 4; ++e) pc_[e] = pw_[i & 7][e];
            const float mlo = pos > 0 ? 1.f : 0.f, mhi = pos < n - 1 ? 1.f : 0.f;
            f32x2 u[3];
#pragma unroll
            for (int s = 0; s < 3; ++s) u[s] = (f32x2){bflo(zm[s]), bfhi(zm[s])} * mlo * w[s][0] + (f32x2){bflo(z0[s]), bfhi(z0[s])} * w[s][1] + (f32x2){bflo(zp[s]), bfhi(zp[s])} * mhi * w[s][2] + cb[s];
            const f32x2 r = u[0], k = u[1], v = u[2];
            f32x2 kk = k * KKw;
            const float ss = red32(kk[0] * kk[0] + kk[1] * kk[1]);
            kk = kk * (__builtin_amdgcn_rsqf(fmaxf(ss, 1e-24f)));
            unsigned* o = (unsigned*)(SCN + (size_t)row * 9 * 512 + c0);
            o[0] = pk2(r[0], r[1]); o[256] = pk2(v[0], v[1]); o[2 * 256] = pk2(kk[0], kk[1]);
#pragma unroll
            for (int d = 0; d < 2; ++d) {
                const unsigned pw = pc_[2 * d], pa = pc_[2 * d + 1];
                float ld[2], kd[2], be[2];
#pragma unroll
                for (int e = 0; e < 2; ++e) {
                    const float uu = W0[d][e] + (e ? bfhi(pw) : bflo(pw));
                    ld[e] = -0.60653065971263342f * sigm(uu);
                    const float av = sigm(A0[d][e] + (e ? bfhi(pa) : bflo(pa)));
                    kd[e] = k[e] * (1.f + (av - 1.f) * KAw[e]); be[e] = kk[e] * av; }
                o[(3 + 3 * d) * 256] = pk2(ld[0], ld[1]); o[(4 + 3 * d) * 256] = pk2(kd[0], kd[1]); o[(5 + 3 * d) * 256] = pk2(be[0], be[1]);
            }
        }
    }
}
#undef P2_LDZ
#undef P2_LDP

__device__ __forceinline__ int seq_row(int b, int d, int sidx) {
    if (sidx < CTXL) { const int t = d ? (CTXL - 1 - sidx) : sidx; return T_LAT + b * CTXL + t; }
    const int tl = sidx - CTXL; const int t = d ? (SEQ - 1 - tl) : tl; return b * SEQ + t;
}

constexpr int CW_WORK = 16384;
constexpr int CW_STAMP = 20480;
#ifdef PROBE_T
#ifndef PROBE_BID
#define PROBE_BID 0
#endif
#define PT(k) do { if (F.bid == PROBE_BID && F.tid == 0 && l == 0) ((unsigned long long*)(F.a->ws + WS_CTL + CW_STAMP * 4))[k] = __builtin_amdgcn_s_memrealtime(); } while (0)
#else
#define PT(k) do { } while (0)
#endif
__device__ __forceinline__ void rw_scan_item(const Ctx& F, int l, int it2) {
    const int it = it2 >> 1, half = it2 & 1;
    const auto& a = *F.a; unsigned char* ws = a.ws; const int tid = F.tid, lane = F.lane;
    const bf16* SCN = (const bf16*)(ws + WS_SCN); float* YD = (float*)(ws + WS_YDIR);
    LAS float* sbuf = (LAS float*)F.lds;
    LAS float* ybuf = (LAS float*)(F.lds + 49152);
    const bool comp = F.wave < 4;
    const int lt = tid & 255, ls = lt >> 4, lj = lt & 15;
    const int vl = lane >> 3, kq = lane & 7, vrow = half * 32 + (F.wave & 3) * 8 + vl;
    constexpr int NCH = (CTXL + SEQ) / 16;
    const int d = it & 1, h = (it >> 1) & 7, b = it >> 4;
    f32x2 S[4];
#pragma unroll
    for (int q = 0; q < 4; ++q) S[q] = (f32x2){0.f, 0.f};
    v2u ldr[6];
#define RW_ISSUE(c) do { const int row_ = seq_row(b, d, (c) * 16 + ls); const v2u* p_ = (const v2u*)(SCN + (size_t)row_ * 9 * 512 + h * 64) + lj; \
        ldr[0] = p_[2 * 128]; ldr[1] = p_[(3 + 3 * d) * 128]; ldr[2] = p_[(5 + 3 * d) * 128]; ldr[3] = p_[(4 + 3 * d) * 128]; ldr[4] = p_[0]; ldr[5] = p_[128]; } while (0)
#define RW_WRITE(bufi) do { LAS float* o_ = sbuf + (((bufi) * 16 + ls) * 6) * 64 + 4 * lj; \
        *(LAS f32x4*)(o_) = (f32x4){-bflo(ldr[0].x), -bfhi(ldr[0].x), -bflo(ldr[0].y), -bfhi(ldr[0].y)}; \
        *(LAS f32x4*)(o_ + 64) = (f32x4){__expf(bflo(ldr[1].x)), __expf(bfhi(ldr[1].x)), __expf(bflo(ldr[1].y)), __expf(bfhi(ldr[1].y))}; \
        *(LAS f32x4*)(o_ + 128) = (f32x4){bflo(ldr[2].x), bfhi(ldr[2].x), bflo(ldr[2].y), bfhi(ldr[2].y)}; *(LAS f32x4*)(o_ + 192) = (f32x4){bflo(ldr[3].x), bfhi(ldr[3].x), bflo(ldr[3].y), bfhi(ldr[3].y)}; \
        *(LAS f32x4*)(o_ + 256) = (f32x4){bflo(ldr[4].x), bfhi(ldr[4].x), bflo(ldr[4].y), bfhi(ldr[4].y)}; *(LAS f32x4*)(o_ + 320) = (f32x4){bflo(ldr[5].x), bfhi(ldr[5].x), bflo(ldr[5].y), bfhi(ldr[5].y)}; } while (0)
#define RW_FLUSH(c) do { const int row_ = seq_row(b, d, (c) * 16 + ls); \
        *(f32x2*)(YD + ((size_t)d * T_ALL + row_) * 512 + h * 64 + half * 32 + 2 * lj) = *(const LAS f32x2*)(ybuf + ((((c) & 1) * 16 + ls) * 64) + half * 32 + 2 * lj); } while (0)
    if (!comp) { RW_ISSUE(0); RW_WRITE(0); RW_ISSUE(1); }
    __syncthreads();
#pragma unroll 1
    for (int c = 0; c < NCH; ++c) {
        const int bi = c & 1;
        if (!comp) {
            if (c + 1 < NCH) RW_WRITE(bi ^ 1);
            if (c + 2 < NCH) RW_ISSUE(c + 2);
            if (c > 0) RW_FLUSH(c - 1);
        } else {
        float yv[16];
        f32x4 opA[10], opB[10]; float vvA, vvB;
#define RW_LD(op, vvx, s_) do { const LAS float* sp_ = sbuf + ((bi * 16 + (s_)) * 6) * 64 + 8 * kq; \
            _Pragma("unroll") for (int q_ = 0; q_ < 5; ++q_) { op[2 * q_] = *(const LAS f32x4*)(sp_ + 64 * q_); op[2 * q_ + 1] = *(const LAS f32x4*)(sp_ + 64 * q_ + 4); } \
            vvx = sbuf[((bi * 16 + (s_)) * 6 + 5) * 64 + vrow]; } while (0)
#define RW_COMP(op, vvx, s_) do { \
            const f32x4 a0 = op[0], a1 = op[1], w0 = op[2], w1 = op[3], b0 = op[4], b1 = op[5], k0 = op[6], k1 = op[7], r0 = op[8], r1 = op[9]; \
            const f32x2 vv2 = (f32x2){vvx, vvx}; \
            const f32x2 p0 = S[1] * (f32x2){a0[2], a0[3]} + S[0] * (f32x2){a0[0], a0[1]}; \
            const f32x2 p1 = S[3] * (f32x2){a1[2], a1[3]} + S[2] * (f32x2){a1[0], a1[1]}; \
            const f32x2 t0 = S[0] * (f32x2){w0[0], w0[1]} + vv2 * (f32x2){k0[0], k0[1]}; \
            const f32x2 t1 = S[1] * (f32x2){w0[2], w0[3]} + vv2 * (f32x2){k0[2], k0[3]}; \
            const f32x2 t2 = S[2] * (f32x2){w1[0], w1[1]} + vv2 * (f32x2){k1[0], k1[1]}; \
            const f32x2 t3 = S[3] * (f32x2){w1[2], w1[3]} + vv2 * (f32x2){k1[2], k1[3]}; \
            const f32x2 ac = p0 + p1; \
            const float sa = red8(ac[0] + ac[1]); \
            const f32x2 sa2 = (f32x2){sa, sa}; \
            S[0] = sa2 * (f32x2){b0[0], b0[1]} + t0; S[1] = sa2 * (f32x2){b0[2], b0[3]} + t1; \
            S[2] = sa2 * (f32x2){b1[0], b1[1]} + t2; S[3] = sa2 * (f32x2){b1[2], b1[3]} + t3; \
            const f32x2 q0 = S[1] * (f32x2){r0[2], r0[3]} + S[0] * (f32x2){r0[0], r0[1]}; \
            const f32x2 q1 = S[3] * (f32x2){r1[2], r1[3]} + S[2] * (f32x2){r1[0], r1[1]}; \
            const f32x2 yc = q0 + q1; \
            yv[s_] = red8(yc[0] + yc[1]); } while (0)
        RW_LD(opA, vvA, 0);
#pragma unroll
        for (int s = 0; s < 16; s += 2) {
            RW_LD(opB, vvB, s + 1);
            __builtin_amdgcn_sched_barrier(0);
            RW_COMP(opA, vvA, s);
            __builtin_amdgcn_sched_barrier(0);
            if (s + 2 < 16) RW_LD(opA, vvA, s + 2);
            __builtin_amdgcn_sched_barrier(0);
            RW_COMP(opB, vvB, s + 1);
            __builtin_amdgcn_sched_barrier(0);
        }
#undef RW_LD
#undef RW_COMP
#pragma unroll
        for (int s = 0; s < 16; ++s) if ((s & 7) == kq) ybuf[((bi * 16 + s) * 64) + vrow] = yv[s];
        }
        __syncthreads();
    }
    if (!comp) RW_FLUSH(NCH - 1);
    __syncthreads();
#undef RW_ISSUE
#undef RW_WRITE
#undef RW_FLUSH
}

constexpr size_t WS_RWSCR = WS_YHY;
constexpr int RWS_QY = 0, RWS_YV = 2048, RWS_PZ = 4096, RWS_ZV = 12288, RWS_SLOT = 20480;
typedef __bf16 bf16x8n __attribute__((ext_vector_type(8)));
__device__ __forceinline__ f32x4 mma16(const bf16x8 a, const bf16x8 b, const f32x4 c) { return __builtin_amdgcn_mfma_f32_16x16x32_bf16(a, b, c, 0, 0, 0); }
__device__ __forceinline__ float dpp_shr(float x, const int n) {
    const int v = __builtin_bit_cast(int, x); int r;
    if (n == 1) r = __builtin_amdgcn_update_dpp(0, v, 0x111, 0xF, 0xF, true); else if (n == 2) r = __builtin_amdgcn_update_dpp(0, v, 0x112, 0xF, 0xF, true);
    else if (n == 4) r = __builtin_amdgcn_update_dpp(0, v, 0x114, 0xF, 0xF, true); else r = __builtin_amdgcn_update_dpp(0, v, 0x118, 0xF, 0xF, true);
    return __builtin_bit_cast(float, r);
}
__device__ __forceinline__ v4u pack8(const float (&x)[8]) { v4u o; o.x = pk2(x[0], x[1]); o.y = pk2(x[2], x[3]); o.z = pk2(x[4], x[5]); o.w = pk2(x[6], x[7]); return o; }
__device__ __forceinline__ void unpack8(const v4u u, float (&x)[8]) { x[0] = bflo(u.x); x[1] = bfhi(u.x); x[2] = bflo(u.y); x[3] = bfhi(u.y); x[4] = bflo(u.z); x[5] = bfhi(u.z); x[6] = bflo(u.w); x[7] = bfhi(u.w); }
constexpr int LDS_ZERO16 = 131072 + 3072;
__device__ __forceinline__ bf16x8 frag16z(const LAS bf16* m, int rowbase, int lane, const LAS v4u* z) {
    const LAS v4u* p = (const LAS v4u*)(m + (rowbase + (lane & 15)) * 16 + 8 * (lane >> 4));
    const v4u v = *(((lane >> 4) < 2) ? p : z); return __builtin_bit_cast(bf16x8, v); }
#define frag16(m_, rb_, ln_) frag16z(m_, rb_, ln_, zp16)
__device__ __forceinline__ void st_colmaj(LAS bf16* m, int colbase, const f32x4 d, int lane) {
    v2u o; o.x = pk2(d[0], d[1]); o.y = pk2(d[2], d[3]); *(LAS v2u*)(m + (colbase + (lane & 15)) * 16 + 4 * (lane >> 4)) = o; }
__device__ __forceinline__ void st_rowmaj(LAS bf16* m, const f32x4 d, int lane) {
#pragma unroll
    for (int r = 0; r < 4; ++r) m[(4 * (lane >> 4) + r) * 16 + (lane & 15)] = (bf16)f2bf(d[r]); }
template <int KS0, int KS1>
__device__ __forceinline__ void rw_chunk_load(const Ctx& F, int b, int h, int d, int cidx, v4u (&raw)[12]) {
    const int lane = opaque_v(F.lane), t = lane & 15, kg = lane >> 4;
    const bf16* base = (const bf16*)(F.a->ws + WS_SCN) + (size_t)seq_row(b, d, 16 * cidx + t) * 9 * 512 + h * 64;
#pragma unroll
    for (int ks = KS0; ks < KS1; ++ks) { const int off = 32 * ks + 8 * kg;
        raw[6 * ks + 0] = *(const v4u*)(base + (3 + 3 * d) * 512 + off); raw[6 * ks + 1] = *(const v4u*)(base + 2 * 512 + off); raw[6 * ks + 2] = *(const v4u*)(base + off);
        raw[6 * ks + 3] = *(const v4u*)(base + (5 + 3 * d) * 512 + off); raw[6 * ks + 4] = *(const v4u*)(base + (4 + 3 * d) * 512 + off); raw[6 * ks + 5] = *(const v4u*)(base + 512 + off); }
}
__device__ __forceinline__ void rw_chunk_task(const Ctx& F, const v4u (&raw)[12], LAS unsigned char* wl, unsigned char* slot) {
    const LAS v4u* zp16 = (const LAS v4u*)(F.lds + LDS_ZERO16);
    const int lane = opaque_v(F.lane), t = lane & 15, kg = lane >> 4;
    LAS bf16* ATt = (LAS bf16*)(wl); LAS bf16* RBr = (LAS bf16*)(wl + 2048); LAS bf16* BHt = (LAS bf16*)(wl + 4096); LAS bf16* KHt = (LAS bf16*)(wl + 6144); LAS bf16* VTt = (LAS bf16*)(wl + 8192);
    LAS bf16* WAt = (LAS bf16*)(wl + 10240); LAS bf16* N_r = (LAS bf16*)(wl + 12288); LAS bf16* N_c = (LAS bf16*)(wl + 12800); LAS bf16* T_r = (LAS bf16*)(wl + 13312);
    LAS bf16* AK_r = (LAS bf16*)(wl + 13824); LAS bf16* RB2 = (LAS bf16*)(wl + 14336); LAS bf16* RK_r = (LAS bf16*)(wl + 14848); LAS float* GCl = (LAS float*)(wl + 15360);
    bf16x8 fAb[2], fRb[2], fBb[2], fKb[2];
#pragma unroll
    for (int ks = 0; ks < 2; ++ks) {
        const int off = 32 * ks + 8 * kg;
        float ea[8], er[8], eb[8], eh[8];
        { const v4u uld = raw[6 * ks + 0]; float ld[8]; unpack8(uld, ld);
#pragma unroll
          for (int j = 0; j < 8; ++j) { float c = ld[j]; c += dpp_shr(c, 1); c += dpp_shr(c, 2); c += dpp_shr(c, 4); c += dpp_shr(c, 8);
              const float tot = __builtin_bit_cast(float, __builtin_amdgcn_ds_bpermute((lane | 15) << 2, __builtin_bit_cast(int, c)));
              ea[j] = __expf(c - ld[j]); er[j] = __expf(c); eb[j] = __expf(-c); eh[j] = __expf(tot - c);
              if (t == 0) GCl[off + j] = __expf(tot); } }
        { const v4u u = raw[6 * ks + 1]; float x[8]; unpack8(u, x);
#pragma unroll
          for (int j = 0; j < 8; ++j) { x[j] = -x[j] * ea[j]; ATt[(off + j) * 16 + t] = (bf16)f2bf(x[j]); }
          const v4u p = pack8(x); fAb[ks] = __builtin_bit_cast(bf16x8, p); }
        { const v4u u = raw[6 * ks + 2]; float x[8]; unpack8(u, x);
#pragma unroll
          for (int j = 0; j < 8; ++j) x[j] = x[j] * er[j];
          const v4u p = pack8(x); fRb[ks] = __builtin_bit_cast(bf16x8, p); *(LAS v4u*)(RBr + t * 64 + off) = p; }
        { const v4u u = raw[6 * ks + 3]; float x[8], y[8]; unpack8(u, x);
#pragma unroll
          for (int j = 0; j < 8; ++j) { y[j] = x[j] * eb[j]; BHt[(off + j) * 16 + t] = (bf16)f2bf(x[j] * eh[j]); }
          const v4u p = pack8(y); fBb[ks] = __builtin_bit_cast(bf16x8, p); }
        { const v4u u = raw[6 * ks + 4]; float x[8], y[8]; unpack8(u, x);
#pragma unroll
          for (int j = 0; j < 8; ++j) { y[j] = x[j] * eb[j]; KHt[(off + j) * 16 + t] = (bf16)f2bf(x[j] * eh[j]); }
          const v4u p = pack8(y); fKb[ks] = __builtin_bit_cast(bf16x8, p); }
        { const v4u u = raw[6 * ks + 5];
          const bf16 e0 = (bf16)(u.x & 0xffff), e1 = (bf16)(u.x >> 16), e2 = (bf16)(u.y & 0xffff), e3 = (bf16)(u.y >> 16), e4 = (bf16)(u.z & 0xffff), e5 = (bf16)(u.z >> 16), e6 = (bf16)(u.w & 0xffff), e7 = (bf16)(u.w >> 16);
          VTt[(off + 0) * 16 + t] = e0; VTt[(off + 1) * 16 + t] = e1; VTt[(off + 2) * 16 + t] = e2; VTt[(off + 3) * 16 + t] = e3; VTt[(off + 4) * 16 + t] = e4; VTt[(off + 5) * 16 + t] = e5; VTt[(off + 6) * 16 + t] = e6; VTt[(off + 7) * 16 + t] = e7; }
        __builtin_amdgcn_sched_barrier(0);
    }
    asm volatile("" ::: "memory");
    const f32x4 z4 = (f32x4){0.f, 0.f, 0.f, 0.f};
    f32x4 n0 = mma16(fAb[1], fBb[1], mma16(fAb[0], fBb[0], z4)), aak = mma16(fAb[1], fKb[1], mma16(fAb[0], fKb[0], z4));
    f32x4 arb = mma16(fRb[1], fBb[1], mma16(fRb[0], fBb[0], z4)), ark = mma16(fRb[1], fKb[1], mma16(fRb[0], fKb[0], z4));
#pragma unroll
    for (int r = 0; r < 4; ++r) { const int tt = 4 * kg + r; if (!(t < tt)) { n0[r] = 0.f; aak[r] = 0.f; } if (!(t <= tt)) { arb[r] = 0.f; ark[r] = 0.f; } }
    st_rowmaj(AK_r, aak, lane); st_rowmaj(RB2, arb, lane); st_rowmaj(RK_r, ark, lane); asm volatile("" ::: "memory");
    f32x4 accT = n0;
#pragma unroll
    for (int r = 0; r < 4; ++r) accT[r] += (4 * kg + r == t) ? 1.f : 0.f;
    f32x4 nn = n0;
#pragma unroll
    for (int itn = 0; itn < 3; ++itn) {
        st_rowmaj(N_r, nn, lane); st_colmaj(N_c, 0, nn, lane); st_rowmaj(T_r, accT, lane); asm volatile("" ::: "memory");
        const bf16x8 fa = frag16(N_r, 0, lane), fb = frag16(N_c, 0, lane), ft = frag16(T_r, 0, lane);
        nn = mma16(fa, fb, z4); asm volatile("" ::: "memory");
        st_colmaj(N_c, 0, nn, lane); asm volatile("" ::: "memory");
        const bf16x8 fb2 = frag16(N_c, 0, lane);
        accT = mma16(ft, fb2, accT); asm volatile("" ::: "memory");
    }
    st_rowmaj(T_r, accT, lane); asm volatile("" ::: "memory");
    const bf16x8 fT = frag16(T_r, 0, lane), fAK = frag16(AK_r, 0, lane), fARB = frag16(RB2, 0, lane), fARK = frag16(RK_r, 0, lane);
#pragma unroll
    for (int kt = 0; kt < 4; ++kt) { const f32x4 dd = mma16(fT, frag16(ATt, 16 * kt, lane), z4); st_colmaj(WAt, 16 * kt, dd, lane); } asm volatile("" ::: "memory");
    { const bf16x8 fArbT = frag16(RB2, 0, lane);
#pragma unroll
      for (int kt = 0; kt < 4; ++kt) { const v2u ri = *(const LAS v2u*)(RBr + t * 64 + 16 * kt + 4 * kg);
          f32x4 c0 = (f32x4){bflo(ri.x), bfhi(ri.x), bflo(ri.y), bfhi(ri.y)};
          c0 = mma16(frag16(WAt, 16 * kt, lane), fArbT, c0);
          v2u o; o.x = pk2(c0[0], c0[1]); o.y = pk2(c0[2], c0[3]); *(v2u*)(slot + RWS_QY + (t * 64 + 16 * kt + 4 * kg) * 2) = o; } }
    asm volatile("" ::: "memory");
#pragma unroll
    for (int vt = 0; vt < 4; ++vt) { const f32x4 dd = mma16(fAK, frag16(VTt, 16 * vt, lane), z4); st_colmaj(ATt, 16 * vt, dd, lane); } asm volatile("" ::: "memory");
    asm volatile("" ::: "memory");
    LAS bf16* UVt = RBr;
#pragma unroll
    for (int vt = 0; vt < 4; ++vt) { const f32x4 dd = mma16(fT, frag16(ATt, 16 * vt, lane), z4); st_colmaj(UVt, 16 * vt, dd, lane); } asm volatile("" ::: "memory");
#pragma unroll
    for (int vt = 0; vt < 4; ++vt) { const f32x4 dd = mma16(fARK, frag16(VTt, 16 * vt, lane), mma16(fARB, frag16(UVt, 16 * vt, lane), z4));
        v2u o; o.x = pk2(dd[0], dd[1]); o.y = pk2(dd[2], dd[3]); *(v2u*)(slot + RWS_YV + ((16 * vt + t) * 16 + 4 * kg) * 2) = o; }
#pragma unroll
    for (int ktp = 0; ktp < 4; ++ktp) { const bf16x8 fBh = frag16(BHt, 16 * ktp, lane);
#pragma unroll
        for (int kt = 0; kt < 4; ++kt) { f32x4 dd = mma16(frag16(WAt, 16 * kt, lane), fBh, z4);
            if (kt == ktp) {
#pragma unroll
                for (int r = 0; r < 4; ++r) if (4 * kg + r == t) dd[r] += GCl[16 * kt + t]; }
            v2u o; o.x = pk2(dd[0], dd[1]); o.y = pk2(dd[2], dd[3]); *(v2u*)(slot + RWS_PZ + ((16 * ktp + t) * 64 + 16 * kt + 4 * kg) * 2) = o; } }
#pragma unroll
    for (int vt = 0; vt < 4; ++vt) { const bf16x8 fU = frag16(UVt, 16 * vt, lane), fV = frag16(VTt, 16 * vt, lane);
#pragma unroll
        for (int ktp = 0; ktp < 4; ++ktp) { const f32x4 dd = mma16(frag16(KHt, 16 * ktp, lane), fV, mma16(frag16(BHt, 16 * ktp, lane), fU, z4));
            v2u o; o.x = pk2(dd[0], dd[1]); o.y = pk2(dd[2], dd[3]); *(v2u*)(slot + RWS_ZV + ((16 * vt + t) * 64 + 16 * ktp + 4 * kg) * 2) = o; } }
}
__device__ __forceinline__ void rw_chunk_task2(const Ctx& F, const v4u (&raw)[12], LAS unsigned char* wl, f32x4 (&yv)[4], f32x4 (&zv)[4][4]) {
    const LAS v4u* zp16 = (const LAS v4u*)(F.lds + LDS_ZERO16);
    const int lane = opaque_v(F.lane), t = lane & 15, kg = lane >> 4;
    LAS bf16* ATt = (LAS bf16*)(wl); LAS bf16* RBr = (LAS bf16*)(wl + 2048); LAS bf16* BHt = (LAS bf16*)(wl + 4096); LAS bf16* KHt = (LAS bf16*)(wl + 6144); LAS bf16* VTt = (LAS bf16*)(wl + 8192);
    LAS bf16* WAt = (LAS bf16*)(wl + 10240); LAS bf16* N_r = (LAS bf16*)(wl + 12288); LAS bf16* N_c = (LAS bf16*)(wl + 12800); LAS bf16* T_r = (LAS bf16*)(wl + 13312);
    LAS bf16* AK_r = (LAS bf16*)(wl + 13824); LAS bf16* RB2 = (LAS bf16*)(wl + 14336); LAS bf16* RK_r = (LAS bf16*)(wl + 14848); LAS float* GCl = (LAS float*)(wl + 15360);
    bf16x8 fAb[2], fRb[2], fBb[2], fKb[2];
#pragma unroll
    for (int ks = 0; ks < 2; ++ks) {
        const int off = 32 * ks + 8 * kg;
        float ea[8], er[8], eb[8], eh[8];
        { const v4u uld = raw[6 * ks + 0]; float ld[8]; unpack8(uld, ld);
#pragma unroll
          for (int j = 0; j < 8; ++j) { float c = ld[j]; c += dpp_shr(c, 1); c += dpp_shr(c, 2); c += dpp_shr(c, 4); c += dpp_shr(c, 8);
              const float tot = __builtin_bit_cast(float, __builtin_amdgcn_ds_bpermute((lane | 15) << 2, __builtin_bit_cast(int, c)));
              ea[j] = __expf(c - ld[j]); er[j] = __expf(c); eb[j] = __expf(-c); const float et_ = __expf(tot); eh[j] = et_ * eb[j];
              if (t == 0) GCl[off + j] = et_; } }
        { const v4u u = raw[6 * ks + 1]; float x[8]; unpack8(u, x);
#pragma unroll
          for (int j = 0; j < 8; ++j) { x[j] = -x[j] * ea[j]; ATt[(off + j) * 16 + t] = (bf16)f2bf(x[j]); }
          const v4u p = pack8(x); fAb[ks] = __builtin_bit_cast(bf16x8, p); }
        { const v4u u = raw[6 * ks + 2]; float x[8]; unpack8(u, x);
#pragma unroll
          for (int j = 0; j < 8; ++j) x[j] = x[j] * er[j];
          const v4u p = pack8(x); fRb[ks] = __builtin_bit_cast(bf16x8, p); *(LAS v4u*)(RBr + t * 64 + off) = p; }
        { const v4u u = raw[6 * ks + 3]; float x[8], y[8]; unpack8(u, x);
#pragma unroll
          for (int j = 0; j < 8; ++j) { y[j] = x[j] * eb[j]; BHt[(off + j) * 16 + t] = (bf16)f2bf(x[j] * eh[j]); }
          const v4u p = pack8(y); fBb[ks] = __builtin_bit_cast(bf16x8, p); }
        { const v4u u = raw[6 * ks + 4]; float x[8], y[8]; unpack8(u, x);
#pragma unroll
          for (int j = 0; j < 8; ++j) { y[j] = x[j] * eb[j]; KHt[(off + j) * 16 + t] = (bf16)f2bf(x[j] * eh[j]); }
          const v4u p = pack8(y); fKb[ks] = __builtin_bit_cast(bf16x8, p); }
        { const v4u u = raw[6 * ks + 5];
          const bf16 e0 = (bf16)(u.x & 0xffff), e1 = (bf16)(u.x >> 16), e2 = (bf16)(u.y & 0xffff), e3 = (bf16)(u.y >> 16), e4 = (bf16)(u.z & 0xffff), e5 = (bf16)(u.z >> 16), e6 = (bf16)(u.w & 0xffff), e7 = (bf16)(u.w >> 16);
          VTt[(off + 0) * 16 + t] = e0; VTt[(off + 1) * 16 + t] = e1; VTt[(off + 2) * 16 + t] = e2; VTt[(off + 3) * 16 + t] = e3; VTt[(off + 4) * 16 + t] = e4; VTt[(off + 5) * 16 + t] = e5; VTt[(off + 6) * 16 + t] = e6; VTt[(off + 7) * 16 + t] = e7; }
        __builtin_amdgcn_sched_barrier(0);
    }
    asm volatile("" ::: "memory");
    const f32x4 z4 = (f32x4){0.f, 0.f, 0.f, 0.f};
    f32x4 n0 = mma16(fAb[1], fBb[1], mma16(fAb[0], fBb[0], z4)), aak = mma16(fAb[1], fKb[1], mma16(fAb[0], fKb[0], z4));
    f32x4 arb = mma16(fRb[1], fBb[1], mma16(fRb[0], fBb[0], z4)), ark = mma16(fRb[1], fKb[1], mma16(fRb[0], fKb[0], z4));
#pragma unroll
    for (int r = 0; r < 4; ++r) { const int tt = 4 * kg + r; if (!(t < tt)) { n0[r] = 0.f; aak[r] = 0.f; } if (!(t <= tt)) { arb[r] = 0.f; ark[r] = 0.f; } }
    st_rowmaj(AK_r, aak, lane); st_rowmaj(RB2, arb, lane); st_rowmaj(RK_r, ark, lane); asm volatile("" ::: "memory");
    f32x4 accT = n0;
#pragma unroll
    for (int r = 0; r < 4; ++r) accT[r] += (4 * kg + r == t) ? 1.f : 0.f;
    f32x4 nn = n0;
#pragma unroll
    for (int itn = 0; itn < 3; ++itn) {
        st_rowmaj(N_r, nn, lane); st_colmaj(N_c, 0, nn, lane); st_rowmaj(T_r, accT, lane); asm volatile("" ::: "memory");
        const bf16x8 fa = frag16(N_r, 0, lane), fb = frag16(N_c, 0, lane), ft = frag16(T_r, 0, lane);
        nn = mma16(fa, fb, z4); asm volatile("" ::: "memory");
        st_colmaj(N_c, 0, nn, lane); asm volatile("" ::: "memory");
        const bf16x8 fb2 = frag16(N_c, 0, lane);
        accT = mma16(ft, fb2, accT); asm volatile("" ::: "memory");
    }
    st_rowmaj(T_r, accT, lane); asm volatile("" ::: "memory");
    const bf16x8 fT = frag16(T_r, 0, lane), fAK = frag16(AK_r, 0, lane), fARB = frag16(RB2, 0, lane), fARK = frag16(RK_r, 0, lane);
#pragma unroll
    for (int kt = 0; kt < 4; ++kt) { const f32x4 dd = mma16(fT, frag16(ATt, 16 * kt, lane), z4); st_colmaj(WAt, 16 * kt, dd, lane); } asm volatile("" ::: "memory");
    f32x4 qy[4];
    { const bf16x8 fArbT = frag16(RB2, 0, lane);
#pragma unroll
      for (int kt = 0; kt < 4; ++kt) { const v2u ri = *(const LAS v2u*)(RBr + t * 64 + 16 * kt + 4 * kg);
          qy[kt] = mma16(frag16(WAt, 16 * kt, lane), fArbT, (f32x4){bflo(ri.x), bfhi(ri.x), bflo(ri.y), bfhi(ri.y)}); } }
    asm volatile("" ::: "memory");
#pragma unroll
    for (int vt = 0; vt < 4; ++vt) { const f32x4 dd = mma16(fAK, frag16(VTt, 16 * vt, lane), z4); st_colmaj(ATt, 16 * vt, dd, lane); } asm volatile("" ::: "memory");
    LAS bf16* UVt = RBr;
#pragma unroll
    for (int vt = 0; vt < 4; ++vt) { const f32x4 dd = mma16(fT, frag16(ATt, 16 * vt, lane), z4); st_colmaj(UVt, 16 * vt, dd, lane); } asm volatile("" ::: "memory");
#pragma unroll
    for (int vt = 0; vt < 4; ++vt) { const bf16x8 fU = frag16(UVt, 16 * vt, lane), fV = frag16(VTt, 16 * vt, lane);
        yv[vt] = mma16(fARK, fV, mma16(fARB, fU, z4));
#pragma unroll
        for (int ktp = 0; ktp < 4; ++ktp) zv[vt][ktp] = mma16(frag16(KHt, 16 * ktp, lane), fV, mma16(frag16(BHt, 16 * ktp, lane), fU, z4)); }
    f32x4 pz[4][4];
#pragma unroll
    for (int ktp = 0; ktp < 4; ++ktp) { const bf16x8 fBh = frag16(BHt, 16 * ktp, lane);
#pragma unroll
        for (int kt = 0; kt < 4; ++kt) { f32x4 dd = mma16(frag16(WAt, 16 * kt, lane), fBh, z4);
            if (kt == ktp) {
#pragma unroll
                for (int r = 0; r < 4; ++r) if (4 * kg + r == t) dd[r] += GCl[16 * kt + t]; }
            pz[ktp][kt] = dd; } }
    asm volatile("s_waitcnt lgkmcnt(0)" ::: "memory");
#pragma unroll
    for (int ktp = 0; ktp < 4; ++ktp) { LAS bf16* reg = (LAS bf16*)(wl + (ktp < 2 ? ktp * 2048 : (ktp + 1) * 2048));
#pragma unroll
        for (int kt = 0; kt < 4; ++kt) { v2u o; o.x = pk2(pz[ktp][kt][0], pz[ktp][kt][1]); o.y = pk2(pz[ktp][kt][2], pz[ktp][kt][3]); *(LAS v2u*)(reg + t * 64 + 16 * kt + 4 * kg) = o; } }
#pragma unroll
    for (int kt = 0; kt < 4; ++kt) { v2u o; o.x = pk2(qy[kt][0], qy[kt][1]); o.y = pk2(qy[kt][2], qy[kt][3]); *(LAS v2u*)(BHt + t * 64 + 16 * kt + 4 * kg) = o; }
    asm volatile("s_waitcnt lgkmcnt(0)" ::: "memory");
}
constexpr int RWZ_OFF = LDSCTL_OFF + 8192, RWF_OFF = LDSCTL_OFF + 2048;
__device__ __forceinline__ void rw_chunk_item2(const Ctx& F, int l, int it, size_t yoff = WS_YDIR) {
    const auto& a = *F.a; unsigned char* ws = a.ws; const int lane = opaque_v(F.lane), t = lane & 15, kg = lane >> 4;
    const int d = it & 1, h = (it >> 1) & 7, b = it >> 4;
    float* YD = (float*)(ws + yoff);
    LAS unsigned char* wl = F.lds + F.wave * 15616;
    LAS bf16* ZS = (LAS bf16*)(F.lds + RWZ_OFF);
    volatile LAS int* flag = (volatile LAS int*)(F.lds + RWF_OFF);
    for (int i = F.tid; i < 2048; i += NTHREADS) ((LAS unsigned*)ZS)[i] = 0u;
    if (F.tid == 0) *flag = 0;
    __syncthreads();
    constexpr int NCHK = (CTXL + SEQ) / 16;
    v4u raw[12];
    rw_chunk_load<0, 2>(F, b, h, d, F.wave, raw);
#pragma unroll 1
    for (int c = F.wave; c < NCHK; c += NWAVES) {
        f32x4 yv[4], zv[4][4];
        rw_chunk_task2(F, raw, wl, yv, zv);
        if (c + NWAVES < NCHK) rw_chunk_load<0, 2>(F, b, h, d, c + NWAVES, raw);
        while (*flag < c) __builtin_amdgcn_s_sleep(1);
        asm volatile("" ::: "memory");
        const LAS bf16* Zc = ZS + (c & 1) * 4096; LAS bf16* Zn = ZS + ((c + 1) & 1) * 4096;
        bf16x8 zb[4][2];
#pragma unroll
        for (int vb = 0; vb < 4; ++vb)
#pragma unroll
            for (int ks = 0; ks < 2; ++ks) zb[vb][ks] = *(const LAS bf16x8*)(Zc + (16 * vb + t) * 64 + 32 * ks + 8 * kg);
        { const LAS bf16* Qr = (const LAS bf16*)(wl + 4096); const bf16x8 q0 = *(const LAS bf16x8*)(Qr + t * 64 + 8 * kg), q1 = *(const LAS bf16x8*)(Qr + t * 64 + 32 + 8 * kg);
#pragma unroll
          for (int vb = 0; vb < 4; ++vb) { const f32x4 y = mma16(q1, zb[vb][1], mma16(q0, zb[vb][0], yv[vb]));
#pragma unroll
              for (int r = 0; r < 4; ++r) { const int row = seq_row(b, d, c * 16 + 4 * kg + r); YD[((size_t)d * T_ALL + row) * 512 + h * 64 + 16 * vb + t] = y[r]; } } }
#pragma unroll
        for (int ktp = 0; ktp < 4; ++ktp) { const LAS bf16* Pr = (const LAS bf16*)(wl + (ktp < 2 ? ktp * 2048 : (ktp + 1) * 2048));
            const bf16x8 p0 = *(const LAS bf16x8*)(Pr + t * 64 + 8 * kg), p1 = *(const LAS bf16x8*)(Pr + t * 64 + 32 + 8 * kg);
#pragma unroll
            for (int vb = 0; vb < 4; ++vb) { const f32x4 z = mma16(p1, zb[vb][1], mma16(p0, zb[vb][0], zv[vb][ktp]));
                v2u o; o.x = pk2(z[0], z[1]); o.y = pk2(z[2], z[3]); *(LAS v2u*)(Zn + (16 * vb + t) * 64 + 16 * ktp + 4 * kg) = o; } }
        asm volatile("s_waitcnt lgkmcnt(0)" ::: "memory");
        if (lane == 0) *flag = c + 1;
        asm volatile("s_waitcnt lgkmcnt(0)" ::: "memory");
    }
    __syncthreads();
}
__device__ __forceinline__ v2u ld_sc1_8(const void* p) { const unsigned long long v = __hip_atomic_load((const unsigned long long*)p, __ATOMIC_RELAXED, __HIP_MEMORY_SCOPE_AGENT); v2u o; o.x = (unsigned)v; o.y = (unsigned)(v >> 32); return o; }
__device__ __forceinline__ v4u ld_sc1_16(const void* p) { const v2u a = ld_sc1_8(p), b = ld_sc1_8((const char*)p + 8); return (v4u){a.x, a.y, b.x, b.y}; }
__device__ __forceinline__ void rw_chunk_item(const Ctx& F, int l, int it) {
    const auto& a = *F.a; unsigned char* ws = a.ws; const int lane = F.lane, t = lane & 15, kg = lane >> 4;
    const int d = it & 1, h = (it >> 1) & 7, b = it >> 4;
    float* YD = (float*)(ws + WS_YDIR);
    unsigned char* scr = ws + WS_RWSCR + (size_t)F.bid * 16 * RWS_SLOT;
    LAS unsigned char* wl = F.lds + F.wave * 15616;
    LAS bf16* ZL = (LAS bf16*)(F.lds + LDSCTL_OFF + 4096 + (F.wave & 3) * 2048);
    if (F.wave < 4) { for (int i = lane; i < 512; i += 64) ((LAS unsigned*)ZL)[i] = 0u; }
    asm volatile("" ::: "memory");
    constexpr int NCHK = (CTXL + SEQ) / 16, NB = NCHK / 16;
#pragma unroll 1
    for (int bt = 0; bt < NB; ++bt) {
        { v4u cur[12];
#pragma unroll 1
          for (int jj = 0; jj < 2; ++jj) { rw_chunk_load<0, 2>(F, b, h, d, bt * 16 + F.wave + 8 * jj, cur); rw_chunk_task(F, cur, wl, scr + (size_t)(F.wave + 8 * jj) * RWS_SLOT); } }
        asm volatile("s_waitcnt vmcnt(0)" ::: "memory");
        __syncthreads();
        {
            const int t = opaque_v(lane & 15), kg = opaque_v(lane >> 4), vb = opaque(F.wave) & 3;
            const unsigned char* scrb = F.a->ws + WS_RWSCR + (size_t)opaque(F.bid) * 16 * RWS_SLOT;
            LAS unsigned char* sbuf = F.lds;
            const int lt = opaque_v(F.tid) & 255; const bool loader = F.wave >= 4;
            const int lw = opaque(F.wave) & 3;
#define RWB_ISSUE(j_) do { const unsigned char* gp_ = scrb + (size_t)(j_) * RWS_SLOT + (size_t)(lw * 5) * 1024 + lane * 16; LAS unsigned char* lp_ = sbuf + ((j_) % 6) * RWS_SLOT + (lw * 5) * 1024; \
                _Pragma("unroll") for (int q = 0; q < 5; ++q) __builtin_amdgcn_global_load_lds((const unsigned*)(gp_ + q * 1024), (LAS unsigned*)(lp_ + q * 1024), 16, 0, 16); } while (0)
#define RWB_COMP(bi_, j_) do { const LAS unsigned char* sl_ = sbuf + (bi_) * RWS_SLOT; bf16x8 zb[2], qf[2]; \
                _Pragma("unroll") for (int ks = 0; ks < 2; ++ks) { zb[ks] = *(const LAS bf16x8*)(ZL + t * 64 + 32 * ks + 8 * kg); qf[ks] = *(const LAS bf16x8*)(sl_ + RWS_QY + (t * 64 + 32 * ks + 8 * kg) * 2); } \
                const v2u y_ = *(const LAS v2u*)(sl_ + RWS_YV + ((16 * vb + t) * 16 + 4 * kg) * 2); \
                f32x4 yacc = (f32x4){bflo(y_.x), bfhi(y_.x), bflo(y_.y), bfhi(y_.y)}; \
                yacc = mma16(qf[1], zb[1], mma16(qf[0], zb[0], yacc)); \
                f32x4 zn[4]; \
                _Pragma("unroll") for (int ktp = 0; ktp < 4; ++ktp) { const v2u z_ = *(const LAS v2u*)(sl_ + RWS_ZV + ((16 * vb + t) * 64 + 16 * ktp + 4 * kg) * 2); \
                    f32x4 zc = (f32x4){bflo(z_.x), bfhi(z_.x), bflo(z_.y), bfhi(z_.y)}; \
                    _Pragma("unroll") for (int ks = 0; ks < 2; ++ks) zc = mma16(*(const LAS bf16x8*)(sl_ + RWS_PZ + ((16 * ktp + t) * 64 + 32 * ks + 8 * kg) * 2), zb[ks], zc); \
                    zn[ktp] = zc; } \
                _Pragma("unroll") for (int r = 0; r < 4; ++r) { const int row = seq_row(b, d, (bt * 16 + (j_)) * 16 + 4 * kg + r); YD[((size_t)d * T_ALL + row) * 512 + h * 64 + 16 * vb + t] = yacc[r]; } \
                asm volatile("s_waitcnt lgkmcnt(0)" ::: "memory"); \
                _Pragma("unroll") for (int ktp = 0; ktp < 4; ++ktp) { v2u o; o.x = pk2(zn[ktp][0], zn[ktp][1]); o.y = pk2(zn[ktp][2], zn[ktp][3]); *(LAS v2u*)(ZL + t * 64 + 16 * ktp + 4 * kg) = o; } \
                asm volatile("s_waitcnt lgkmcnt(0)" ::: "memory"); } while (0)
#define RWB_BAR() do { asm volatile("s_waitcnt lgkmcnt(0)" ::: "memory"); __builtin_amdgcn_s_barrier(); asm volatile("" ::: "memory"); } while (0)
            if (loader) { RWB_ISSUE(0); RWB_ISSUE(1); RWB_ISSUE(2); RWB_ISSUE(3); asm volatile("s_waitcnt vmcnt(15)" ::: "memory"); }
            RWB_BAR();
#pragma unroll 1
            for (int j = 0; j < 16; ++j) {
                if (loader) { if (j + 4 < 16) { RWB_ISSUE(j + 4); asm volatile("s_waitcnt vmcnt(15)" ::: "memory"); } else { asm volatile("s_waitcnt vmcnt(0)" ::: "memory"); } }
                else { RWB_COMP(j % 6, j); }
                RWB_BAR();
            }
#undef RWB_BAR
#undef RWB_ISSUE
#undef RWB_COMP
        }
        __syncthreads();
    }
}

__device__ __forceinline__ void stage_rw_readout(const Ctx& F, int l) {
    const auto& a = *F.a; unsigned char* ws = a.ws; const int lane = F.lane;
    const bf16* SCN = (const bf16*)(ws + WS_SCN); const bf16* P = (const bf16*)(ws + WS_P); const float* YD = (const float*)(ws + WS_YDIR); bf16* YRW = (bf16*)(ws + WS_YRW);
    const int gw = F.bid * NWAVES + F.wave, NGW = F.G * NWAVES;
    constexpr int TR = 17, NRT = T_ALL / TR;
    for (int tile = gw; tile < NRT * 4; tile += NGW) {
        const int rt = tile % NRT, hp = tile / NRT, row0 = rt * TR, c0 = hp * 128 + 2 * lane;
        const f32x2 rk = *(const f32x2*)(a.in[I_RWRK] + l * 512 + c0), lng = *(const f32x2*)(a.in[I_RWLNG] + l * 512 + c0), lnb = *(const f32x2*)(a.in[I_RWLNB] + l * 512 + c0);
        unsigned sw_[8][5]; f32x2 yw_[8][2];
#define RO_LD(j_) do { const int rr_ = row0 + (j_); const unsigned* sp_ = (const unsigned*)(SCN + (size_t)rr_ * 9 * 512 + c0); \
        sw_[(j_) & 7][0] = sp_[0]; sw_[(j_) & 7][1] = sp_[256]; sw_[(j_) & 7][2] = sp_[4 * 256]; sw_[(j_) & 7][3] = sp_[7 * 256]; sw_[(j_) & 7][4] = *(const unsigned*)(P + (size_t)rr_ * 2560 + 2048 + c0); \
        yw_[(j_) & 7][0] = *(const f32x2*)(YD + (size_t)rr_ * 512 + c0); yw_[(j_) & 7][1] = *(const f32x2*)(YD + ((size_t)T_ALL + rr_) * 512 + c0); } while (0)
        RO_LD(0); RO_LD(1); RO_LD(2);
#pragma unroll
        for (int i = 0; i < TR; ++i) {
            const int row = row0 + i;
            if (i + 3 < TR) RO_LD(i + 3);
            const unsigned ru = sw_[i & 7][0], vu = sw_[i & 7][1], k0u = sw_[i & 7][2], k1u = sw_[i & 7][3], gu = sw_[i & 7][4];
            const f32x2 y0 = yw_[i & 7][0], y1 = yw_[i & 7][1];
            const float bon = red32(bflo(ru) * (bflo(k0u) + bflo(k1u)) * rk[0] + bfhi(ru) * (bfhi(k0u) + bfhi(k1u)) * rk[1]);
            f32x2 y = y0 + y1 + (f32x2){bflo(vu), bfhi(vu)} * bon;
            const float mu = red32(y[0] + y[1]) * (1.f / 64.f);
            y = y - mu;
            const float var = red32(y[0] * y[0] + y[1] * y[1]) * (1.f / 64.f);
            const f32x2 yn = y * (__builtin_amdgcn_rsqf(var + 64e-5f));
            const f32x2 ov = (yn * lng + lnb) * (f32x2){bflo(gu), bfhi(gu)};
            *(unsigned*)(YRW + (size_t)row * 512 + c0) = pk2(ov[0], ov[1]);
        }
    }
}
#undef RO_LD

constexpr size_t WS_S5E = 6 * MiB;
constexpr int S5_NSEG = 4, S5_SEGLEN = (CTXL + SEQ) / S5_NSEG;
__device__ __forceinline__ void s5_disc(const float are, const float aim, const float dt, float& lbr, float& lbi, float& cr, float& ci) {
    const float mag = expf(are * dt); lbr = mag * cosf(aim * dt); lbi = mag * sinf(aim * dt);
    const float den = are * are + aim * aim, nr = lbr - 1.0f; cr = (nr * are + lbi * aim) / den; ci = (lbi * are - nr * aim) / den;
}
template <int PASS>
__device__ __forceinline__ void stage_s5_scan(const Ctx& F, int l, int item = -1) {
    const auto& a = *F.a; unsigned char* ws = a.ws; const int lane = F.lane;
    const bf16* Z = (const bf16*)(ws + WS_Z); bf16* YP = (bf16*)(ws + WS_YP); f32x2* S5E = (f32x2*)(ws + WS_S5E);
    LAS unsigned char* wl = F.lds + F.wave * 16384;
    LAS float* buL = (LAS float*)wl;
    LAS bf16* Hs = (LAS bf16*)(wl + 8704);
    const int fr = lane & 15, kg = lane >> 4;
    for (int itx = (item < 0 ? F.bid : item) * NWAVES + F.wave; itx < BATCH * 32 * 2 * S5_NSEG; itx += (item < 0 ? NWAVES * F.G : BATCH * 32 * 2 * S5_NSEG)) {
        const int seg = itx & (S5_NSEG - 1), it = itx >> 2;
        const int d = it & 1, g = (it >> 1) & 31, b = it >> 6, p = lane;
        const float dt = expf(a.in[I_S5LDT][(l * 2 + d) * 32 + g]);
        const float* arep = a.in[I_S5ARE] + ((size_t)(l * 2 + d) * 32 + g) * 64; const float* aimp = a.in[I_S5AIM] + ((size_t)(l * 2 + d) * 32 + g) * 64;
        float lbr, lbi, cr_, ci_; s5_disc(arep[p], aimp[p], dt, lbr, lbi, cr_, ci_);
        bf16x8 afr[2][4];
#pragma unroll
        for (int tl = 0; tl < 4; ++tl) { const int pp = 16 * tl + fr; float r0_, r1_, cr, ci; s5_disc(arep[pp], aimp[pp], dt, r0_, r1_, cr, ci);
            v4u pr = (v4u){0u, 0u, 0u, 0u}, pi = (v4u){0u, 0u, 0u, 0u};
            if (kg < 2) { const float* br = a.in[I_S5BRE] + (((size_t)l * 32 + g) * 64 + pp) * 16 + 8 * kg; const float* bi = a.in[I_S5BIM] + (((size_t)l * 32 + g) * 64 + pp) * 16 + 8 * kg;
                const f32x4 x0 = *(const f32x4*)br, x1 = *(const f32x4*)(br + 4), y0 = *(const f32x4*)bi, y1 = *(const f32x4*)(bi + 4);
                pr.x = pk2(cr * x0[0] - ci * y0[0], cr * x0[1] - ci * y0[1]); pr.y = pk2(cr * x0[2] - ci * y0[2], cr * x0[3] - ci * y0[3]);
                pr.z = pk2(cr * x1[0] - ci * y1[0], cr * x1[1] - ci * y1[1]); pr.w = pk2(cr * x1[2] - ci * y1[2], cr * x1[3] - ci * y1[3]);
                pi.x = pk2(cr * y0[0] + ci * x0[0], cr * y0[1] + ci * x0[1]); pi.y = pk2(cr * y0[2] + ci * x0[2], cr * y0[3] + ci * x0[3]);
                pi.z = pk2(cr * y1[0] + ci * x1[0], cr * y1[1] + ci * x1[1]); pi.w = pk2(cr * y1[2] + ci * x1[2], cr * y1[3] + ci * x1[3]); }
            afr[0][tl] = __builtin_bit_cast(bf16x8, pr); afr[1][tl] = __builtin_bit_cast(bf16x8, pi); }
        bf16x8 cf[4];
        f32x2 hst = (f32x2){0.f, 0.f};
        if (PASS == 1) {
#pragma unroll
            for (int kk = 0; kk < 4; ++kk) { const int p0 = 16 * kk + 4 * kg;
                const f32x4 c0 = *(const f32x4*)(a.in[I_S5CRE] + (((size_t)l * 32 + g) * 16 + fr) * 64 + p0), c1 = *(const f32x4*)(a.in[I_S5CIM] + (((size_t)l * 32 + g) * 16 + fr) * 64 + p0);
                v4u pk; pk.x = pk2(c0[0], -c1[0]); pk.y = pk2(c0[1], -c1[1]); pk.z = pk2(c0[2], -c1[2]); pk.w = pk2(c0[3], -c1[3]);
                cf[kk] = __builtin_bit_cast(bf16x8, pk); }
            float pr_ = lbr, pi_ = lbi, l64r = 1.f, l64i = 0.f;
#pragma unroll 1
            for (int q = 0; q < 10; ++q) { const float nr2 = pr_ * pr_ - pi_ * pi_, ni2 = 2.f * pr_ * pi_; pr_ = nr2; pi_ = ni2; if (q == 5) { l64r = pr_; l64i = pi_; } }
            const float lLr = pr_ * l64r - pi_ * l64i, lLi = pr_ * l64i + pi_ * l64r;
#pragma unroll 1
            for (int sgi = 0; sgi < seg; ++sgi) { const f32x2 ev = S5E[((size_t)it * S5_NSEG + sgi) * 64 + p];
                hst = (f32x2){lLr * hst[0] - lLi * hst[1] + ev[0], lLr * hst[1] + lLi * hst[0] + ev[1]}; }
        }
        const f32x2 lbr2 = (f32x2){lbr, lbr}, lbi2 = (f32x2){lbi, lbi};
        const int sbeg = seg * S5_SEGLEN, send = sbeg + S5_SEGLEN;
        v4u u0 = (v4u){0u, 0u, 0u, 0u}, u1 = u0, u2 = u0, u3 = u0;
#define S5_LOADU(dst_, s0_) do { const int sx_ = ((s0_) < send) ? (s0_) : (send - 16); const int row_ = seq_row(b, d, sx_ + fr); dst_ = *(const v4u*)(Z + (size_t)row_ * IN_COLS + S5_OFF + g * 16 + (kg & 1) * 8); } while (0)
#define S5_CHUNK(ux_, sc_) do { \
            { const v4u um_ = (kg < 2) ? ux_ : (v4u){0u, 0u, 0u, 0u}; const bf16x8 ufr = __builtin_bit_cast(bf16x8, um_); \
              _Pragma("unroll") for (int c = 0; c < 2; ++c) _Pragma("unroll") for (int tl = 0; tl < 4; ++tl) { \
                const f32x4 dd = __builtin_amdgcn_mfma_f32_16x16x32_bf16(afr[c][tl], ufr, (f32x4){0.f, 0.f, 0.f, 0.f}, 0, 0, 0); *(LAS f32x4*)(buL + (c * 16 + fr) * 68 + 16 * tl + 4 * kg) = dd; } } \
            S5_LOADU(ux_, (sc_) + 64); \
            LDS_WAIT(); asm volatile("" ::: "memory"); \
            f32x2 bu[16]; \
            _Pragma("unroll") for (int s = 0; s < 16; ++s) bu[s] = (f32x2){buL[s * 68 + p], buL[(16 + s) * 68 + p]}; \
            _Pragma("unroll") for (int s = 0; s < 16; ++s) { const float tr_ = __builtin_fmaf(-lbi, hst[1], bu[s][0]), ti_ = __builtin_fmaf(lbi, hst[0], bu[s][1]); \
                hst = (f32x2){__builtin_fmaf(lbr, hst[0], tr_), __builtin_fmaf(lbr, hst[1], ti_)}; \
                if (PASS == 1) *(LAS unsigned*)(Hs + s * 136 + 2 * p) = pg8::cvt_pk_bf16(hst[0], hst[1]); } \
            if (PASS == 1) { LDS_WAIT(); asm volatile("" ::: "memory"); \
                f32x4 acc = (f32x4){0.f, 0.f, 0.f, 0.f}; \
                _Pragma("unroll") for (int kk = 0; kk < 4; ++kk) { const bf16x8 af = *(const LAS bf16x8*)(Hs + fr * 136 + 32 * kk + 8 * kg); acc = __builtin_amdgcn_mfma_f32_16x16x32_bf16(af, cf[kk], acc, 0, 0, 0); } \
                { const int rowq_ = seq_row(b, d, (sc_) + 4 * kg); bf16* yq_ = YP + ((size_t)d * T_ALL + rowq_) * 512 + g * 16 + fr; const int st_ = d ? -512 : 512; \
                  _Pragma("unroll") for (int r = 0; r < 4; ++r) yq_[r * st_] = (bf16)f2bf(acc[r]); } } \
            LDS_WAIT(); asm volatile("" ::: "memory"); } while (0)
        S5_LOADU(u0, sbeg); S5_LOADU(u1, sbeg + 16); S5_LOADU(u2, sbeg + 32); S5_LOADU(u3, sbeg + 48);
#pragma unroll 1
        for (int s0 = sbeg; s0 < send; s0 += 64) { S5_CHUNK(u0, s0); S5_CHUNK(u1, s0 + 16); S5_CHUNK(u2, s0 + 32); S5_CHUNK(u3, s0 + 48); }
#undef S5_CHUNK
        if (PASS == 0) S5E[((size_t)it * S5_NSEG + seg) * 64 + p] = hst;
#undef S5_LOADU
    }
}

__device__ __forceinline__ void stage_s5_prep(const Ctx& F, int l, int nrows) {
    const auto& a = *F.a; unsigned char* ws = a.ws;
    const bf16* __restrict__ Z = (const bf16*)(ws + WS_Z); const bf16* __restrict__ YP = (const bf16*)(ws + WS_YP); bf16* __restrict__ AS5 = (bf16*)(ws + WS_AS5);
    const int c = 4 * (F.tid & 127), rq = F.tid >> 7;
    const f32x4 dsk = *(const f32x4*)(a.in[I_S5D] + l * 512 + c);
#pragma unroll 4
    for (int row = F.bid * 4 + rq; row < nrows; row += F.G * 4) {
        const v2u uz = *(const v2u*)(Z + (size_t)row * IN_COLS + S5_OFF + c);
        const v2u q0 = *(const v2u*)(YP + (size_t)row * 512 + c), q1 = *(const v2u*)(YP + ((size_t)T_ALL + row) * 512 + c);
        const f32x4 y0 = (f32x4){bflo(q0.x), bfhi(q0.x), bflo(q0.y), bfhi(q0.y)}, y1 = (f32x4){bflo(q1.x), bfhi(q1.x), bflo(q1.y), bfhi(q1.y)};
        const f32x4 u = (f32x4){bflo(uz.x), bfhi(uz.x), bflo(uz.y), bfhi(uz.y)};
        const f32x4 y = y0 + y1 + u * dsk;
        float ge[4];
#pragma unroll
        for (int j = 0; j < 4; ++j) ge[j] = 0.5f * y[j] * (1.f + tanh_fast(0.7978845608028654f * (y[j] + 0.044715f * y[j] * y[j] * y[j])));
        v2u o; o.x = pk2(ge[0], ge[1]); o.y = pk2(ge[2], ge[3]);
        *(v2u*)(AS5 + (size_t)row * 512 + c) = o;
    }
}

__device__ __forceinline__ void stage_hy_pre(const Ctx& F, int l, int nrows) {
    const auto& a = *F.a; unsigned char* ws = a.ws; const int lane = F.lane;
    const bf16* Z = (const bf16*)(ws + WS_Z); bf16* UT = (bf16*)(ws + WS_UT);
    LAS unsigned char* tl = F.lds + F.wave * 16384;
    const float* cw = a.in[I_HYCW] + (size_t)l * 3 * 1536; const float* cbp = a.in[I_HYCB] + l * 1536;
    const int gw = F.bid * NWAVES + F.wave, NGW = F.G * NWAVES;
    const int q = lane >> 3, k = lane & 7, ntile = (nrows / 64) * 24;
    v4u v[8], hv;
#define HYPRE_LOAD(tile_) do { const int rt_ = (tile_) / 24, ct_ = (tile_) % 24, row0_ = rt_ * 64; int base_, pos0_, n_; row_seq(row0_, base_, pos0_, n_); \
        const bf16* zt_ = Z + (size_t)row0_ * IN_COLS + HY_OFF + ct_ * 64 + 8 * k; hv = (v4u){0u, 0u, 0u, 0u}; \
        _Pragma("unroll") for (int i = 0; i < 8; ++i) v[i] = *(const v4u*)(zt_ + (size_t)(8 * i + q) * IN_COLS); \
        if (q == 0 && pos0_ > 0) hv = *(const v4u*)(zt_ - (size_t)IN_COLS); \
        if (q == 1 && pos0_ + 64 < n_) hv = *(const v4u*)(zt_ + (size_t)64 * IN_COLS); } while (0)
    if (gw < ntile) HYPRE_LOAD(gw);
#pragma unroll 1
    for (int tile = gw; tile < ntile; tile += NGW) {
        const int rt = tile / 24, ct = tile % 24, row0 = rt * 64, c0 = ct * 64;
        f32x4 wv[8];
#pragma unroll
        for (int i = 0; i < 8; ++i) { const int col = c0 + 8 * i + q; wv[i] = (f32x4){cw[col], cw[1536 + col], cw[2 * 1536 + col], cbp[col]}; }
#pragma unroll
        for (int i = 0; i < 8; ++i) { LAS unsigned* p = (LAS unsigned*)(tl + (1 + 8 * i + q) * 132 + 16 * k); p[0] = v[i].x; p[1] = v[i].y; p[2] = v[i].z; p[3] = v[i].w; }
        if (q < 2) { LAS unsigned* p = (LAS unsigned*)(tl + (q ? 65 : 0) * 132 + 16 * k); p[0] = hv.x; p[1] = hv.y; p[2] = hv.z; p[3] = hv.w; }
        if (tile + NGW < ntile) HYPRE_LOAD(tile + NGW);
        LDS_WAIT(); asm volatile("" ::: "memory");
#pragma unroll 2
        for (int i = 0; i < 8; ++i) {
            const int ch = 8 * i + q, col = c0 + ch;
            const LAS unsigned short* s = (const LAS unsigned short*)(tl + (8 * k) * 132 + ch * 2);
            float z[10];
#pragma unroll
            for (int t = 0; t < 10; ++t) z[t] = __builtin_bit_cast(float, (unsigned)s[t * 66] << 16);
            float o[8];
#pragma unroll
            for (int t = 0; t < 8; ++t) o[t] = wv[i][0] * z[t] + wv[i][1] * z[t + 1] + wv[i][2] * z[t + 2] + wv[i][3];
            v4u w; w.x = pk2(o[0], o[1]); w.y = pk2(o[2], o[3]); w.z = pk2(o[4], o[5]); w.w = pk2(o[6], o[7]);
            *(v4u*)(UT + (size_t)col * T_ALL + row0 + 8 * k) = w;
        }
        LDS_WAIT(); asm volatile("" ::: "memory");
    }
#undef HYPRE_LOAD
}
__device__ __forceinline__ void stage_hy_post(const Ctx& F, int l, int nrows) {
    const auto& a = *F.a; unsigned char* ws = a.ws; const int lane = F.lane;
    const bf16* YT = (const bf16*)(ws + WS_UT) + (size_t)1024 * T_ALL; bf16* YHY = (bf16*)(ws + WS_YHY);
    LAS unsigned char* tl = F.lds + F.wave * 16384;
    const int gw = F.bid * NWAVES + F.wave, NGW = F.G * NWAVES;
    const int q = lane >> 3, k = lane & 7, ntile = (nrows / 64) * 8;
    v4u v[8];
#define HYPOST_LOAD(tile_) do { const bf16* yp_ = YT + (size_t)(((tile_) & 7) * 64 + q) * T_ALL + ((tile_) >> 3) * 64 + 8 * k; \
        _Pragma("unroll") for (int i = 0; i < 8; ++i) v[i] = *(const v4u*)(yp_ + (size_t)(8 * i) * T_ALL); } while (0)
    if (gw < ntile) HYPOST_LOAD(gw);
#pragma unroll 1
    for (int tile = gw; tile < ntile; tile += NGW) {
        const int rt = tile >> 3, ct = tile & 7, row0 = rt * 64, c0 = ct * 64;
#pragma unroll
        for (int i = 0; i < 8; ++i) { LAS unsigned* p = (LAS unsigned*)(tl + (8 * i + q) * 132 + 16 * k); p[0] = v[i].x; p[1] = v[i].y; p[2] = v[i].z; p[3] = v[i].w; }
        if (tile + NGW < ntile) HYPOST_LOAD(tile + NGW);
        LDS_WAIT(); asm volatile("" ::: "memory");
#pragma unroll
        for (int i = 0; i < 8; ++i) { const int r = 8 * i + q;
            const LAS unsigned short* s = (const LAS unsigned short*)(tl + (8 * k) * 132 + r * 2);
            unsigned e[8];
#pragma unroll
            for (int j = 0; j < 8; ++j) e[j] = s[j * 66];
            v4u w; w.x = e[0] | (e[1] << 16); w.y = e[2] | (e[3] << 16); w.z = e[4] | (e[5] << 16); w.w = e[6] | (e[7] << 16);
            *(v4u*)(YHY + (size_t)(row0 + r) * 512 + c0 + 8 * k) = w; }
        LDS_WAIT(); asm volatile("" ::: "memory");
    }
#undef HYPOST_LOAD
}
typedef float f32x16 __attribute__((ext_vector_type(16)));
__device__ __forceinline__ void hyena_item(const Ctx& F, int l, int c, int isctx) {
    const auto& a = *F.a; unsigned char* ws = a.ws; const int tid = F.tid, lane = F.lane;
    const int n = isctx ? CTXL : SEQ, rowbase = isctx ? T_LAT : 0, RL = isctx ? HY_RLENC : HY_RLEN, off = n + 47;
    const bf16* UT = (const bf16*)(ws + WS_UT);
    const bf16* x1g = UT + (size_t)c * T_ALL + rowbase; const bf16* x2g = UT + (size_t)(512 + c) * T_ALL + rowbase; bf16* vg = (bf16*)UT + (size_t)(1024 + c) * T_ALL + rowbase;
    const bf16* Rg = (const bf16*)(ws + WS_GF + l * GF_STRIDE + (isctx ? GF_CTX : 0)) + (size_t)c * RL;
    LAS unsigned char* XB = F.lds; LAS unsigned char* R1 = F.lds + HY_R1_OFF; LAS unsigned char* R2 = F.lds + HY_R2_OFF;
    { const int cpb = n / 8;
      for (int q = tid; q < 8 * cpb; q += NTHREADS) { const int b = q / cpb, ch = q % cpb; *(LAS v4u*)(XB + b * HY_ROWB + 2 * HY_MARG + 16 * ch) = *(const v4u*)(vg + (size_t)b * n + 8 * ch); }
      if (tid < 256) { const int b = tid >> 5, side = (tid >> 4) & 1, ch = tid & 15; const unsigned zz = (unsigned)opaque_v(0); *(LAS v4u*)(XB + b * HY_ROWB + (side ? 2 * (HY_MARG + n) : 0) + 16 * ch) = (v4u){zz, zz, zz, zz}; }
      const int rch = RL / 8;
      for (int q = tid; q < rch; q += NTHREADS) { *(LAS v4u*)(R1 + 16 * q) = *(const v4u*)(Rg + 8 * q); *(LAS v4u*)(R2 + 16 * q) = *(const v4u*)(Rg + (size_t)512 * RL + 8 * q); } }
    __syncthreads();
    const int i = lane & 31, kg = lane >> 5, jb = lane & 3, bb = (lane & 31) >> 2;
    const int rsh = (off - i) & 7, rd = rsh >> 1; const bool s1 = rd & 1, s2 = rd & 2; const unsigned sh = (rsh & 1) ? 16u : 0u;
    const int aconst = 2 * (off - i + 8 * kg - rsh), bconst = bb * HY_ROWB + 2 * (HY_MARG + 32 * jb + 8 * kg);
    const int T0w = 512 * F.wave; const int ntile = (n - T0w) >= 512 ? 4 : ((n - T0w) > 0 ? (n - T0w) / 128 : 0);
    const float bias0 = a.in[I_HYBIAS][(l * 2 + 0) * 512 + c], bias1 = a.in[I_HYBIAS][(l * 2 + 1) * 512 + c];
    f32x16 acc[4];
    v2u y1p[4][4];
#define HY_AFRAG(wa, wb, afr) do { \
        const unsigned a0 = s1 ? wa.y : wa.x, a1 = s1 ? wa.z : wa.y, a2 = s1 ? wa.w : wa.z, a3 = s1 ? wb.x : wa.w, a4 = s1 ? wb.y : wb.x, a5 = s1 ? wb.z : wb.y, a6 = s1 ? wb.w : wb.z; \
        const unsigned b0 = s2 ? a2 : a0, b1 = s2 ? a3 : a1, b2 = s2 ? a4 : a2, b3 = s2 ? a5 : a3, b4 = s2 ? a6 : a4; \
        v4u af_; af_.x = __builtin_amdgcn_alignbit(b1, b0, sh); af_.y = __builtin_amdgcn_alignbit(b2, b1, sh); af_.z = __builtin_amdgcn_alignbit(b3, b2, sh); af_.w = __builtin_amdgcn_alignbit(b4, b3, sh); \
        afr = __builtin_bit_cast(bf16x8, af_); } while (0)
#define HY_STEP_COND(RB, d) do { \
        const v4u wa = *(const LAS v4u*)((RB) + aconst - 2 * (d)), wb = *(const LAS v4u*)((RB) + aconst - 2 * (d) + 16); bf16x8 afr; HY_AFRAG(wa, wb, afr); \
        _Pragma("unroll") for (int m = 0; m < 4; ++m) { const int T0 = T0w + 128 * m; \
            if (m < ntile && (d) >= T0 - n + 16 && (d) <= T0 + 96) { const bf16x8 bfr = *(const LAS bf16x8*)(XB + bconst + 2 * (T0 - (d))); \
                acc[m] = __builtin_amdgcn_mfma_f32_32x32x16_bf16(afr, bfr, acc[m], 0, 0, 0); } } } while (0)
#define HY_LOAD(RB, d, wa, wb, bq) do { wa = *(const LAS v4u*)((RB) + aconst - 2 * (d)); wb = *(const LAS v4u*)((RB) + aconst - 2 * (d) + 16); \
        _Pragma("unroll") for (int m = 0; m < 4; ++m) bq[m] = *(const LAS bf16x8*)(XB + bconst + 2 * (T0w + 128 * m - (d))); } while (0)
#define HY_MMA(wa, wb, bq) do { bf16x8 afr; HY_AFRAG(wa, wb, afr); \
        _Pragma("unroll") for (int m = 0; m < 4; ++m) acc[m] = __builtin_amdgcn_mfma_f32_32x32x16_bf16(afr, bq[m], acc[m], 0, 0, 0); } while (0)
#define HY_CONV(RB) do { \
        _Pragma("unroll") for (int m = 0; m < 4; ++m) _Pragma("unroll") for (int e = 0; e < 16; ++e) acc[m][e] = 0.f; \
        if (ntile == 4) { \
            const int dA = T0w - n + 16, dB = T0w + 384 - n + 16, dC = T0w + 96, dD = T0w + 384 + 96;     \
            _Pragma("unroll 1") for (int d = dA; d < dB; d += 16) HY_STEP_COND(RB, d); \
            { v4u waA, wbA, waB, wbB; bf16x8 bqA[4], bqB[4]; \
              HY_LOAD(RB, dB, waA, wbA, bqA); \
              _Pragma("unroll 1") for (int d = dB; d <= dC; d += 32) { \
                  if (d + 16 <= dC) HY_LOAD(RB, d + 16, waB, wbB, bqB); \
                  __builtin_amdgcn_sched_barrier(0); \
                  HY_MMA(waA, wbA, bqA); \
                  __builtin_amdgcn_sched_barrier(0); \
                  if (d + 32 <= dC) HY_LOAD(RB, d + 32, waA, wbA, bqA); \
                  __builtin_amdgcn_sched_barrier(0); \
                  if (d + 16 <= dC) HY_MMA(waB, wbB, bqB); \
                  __builtin_amdgcn_sched_barrier(0); } } \
            _Pragma("unroll 1") for (int d = dC + 16; d <= dD; d += 16) HY_STEP_COND(RB, d); \
        } else if (ntile > 0) { const int dhi = T0w + 128 * (ntile - 1) + 96; \
            _Pragma("unroll 1") for (int d = T0w - n + 16; d <= dhi; d += 16) HY_STEP_COND(RB, d); } } while (0)
    HY_CONV(R1);
#pragma unroll
    for (int m = 0; m < 4; ++m) if (m < ntile) {
#pragma unroll
        for (int rg = 0; rg < 4; ++rg) { const int t4 = T0w + 128 * m + 32 * jb + 8 * rg + 4 * kg;
            const v2u xv = *(const v2u*)(x1g + (size_t)bb * n + t4); const v2u vv = *(const LAS v2u*)(XB + bb * HY_ROWB + 2 * (HY_MARG + t4));
            const float y0 = bflo(xv.x) * (acc[m][4 * rg + 0] + bias0 * bflo(vv.x)), y1 = bfhi(xv.x) * (acc[m][4 * rg + 1] + bias0 * bfhi(vv.x));
            const float y2 = bflo(xv.y) * (acc[m][4 * rg + 2] + bias0 * bflo(vv.y)), y3 = bfhi(xv.y) * (acc[m][4 * rg + 3] + bias0 * bfhi(vv.y));
            y1p[m][rg].x = pk2(y0, y1); y1p[m][rg].y = pk2(y2, y3); } }
    __syncthreads();
#pragma unroll
    for (int m = 0; m < 4; ++m) if (m < ntile) {
#pragma unroll
        for (int rg = 0; rg < 4; ++rg) { const int t4 = T0w + 128 * m + 32 * jb + 8 * rg + 4 * kg; *(LAS v2u*)(XB + bb * HY_ROWB + 2 * (HY_MARG + t4)) = y1p[m][rg]; } }
    __syncthreads();
    HY_CONV(R2);
#pragma unroll
    for (int m = 0; m < 4; ++m) if (m < ntile) {
#pragma unroll
        for (int rg = 0; rg < 4; ++rg) { const int t4 = T0w + 128 * m + 32 * jb + 8 * rg + 4 * kg;
            const v2u xv = *(const v2u*)(x2g + (size_t)bb * n + t4); const v2u yv = y1p[m][rg];
            const float o0 = bflo(xv.x) * (acc[m][4 * rg + 0] + bias1 * bflo(yv.x)), o1 = bfhi(xv.x) * (acc[m][4 * rg + 1] + bias1 * bfhi(yv.x));
            const float o2 = bflo(xv.y) * (acc[m][4 * rg + 2] + bias1 * bflo(yv.y)), o3 = bfhi(xv.y) * (acc[m][4 * rg + 3] + bias1 * bfhi(yv.y));
            v2u ov; ov.x = pk2(o0, o1); ov.y = pk2(o2, o3); *(v2u*)(vg + (size_t)bb * n + t4) = ov; } }
    __syncthreads();
#undef HY_CONV
#undef HY_AFRAG
#undef HY_STEP_COND
#undef HY_LOAD
#undef HY_MMA
}
__device__ __forceinline__ void stage_mixer(const Ctx& F, int l) {
    unsigned* ctr = (unsigned*)(F.a->ws + WS_CTL) + CW_WORK + 64 * l;
    LAS int* itb = (LAS int*)(F.lds + LDSCTL_OFF + 512);
    constexpr int NS5 = BATCH * 32 * 2 * S5_NSEG / NWAVES;
    const int nit = 128 + NS5 + 512 + (l == 0 ? 512 : 0);
#ifdef PROBE_STATIC
    return;
#endif
    for (;;) {
        if (F.tid == 0) *itb = (int)__hip_atomic_fetch_add(ctr, 1u, __ATOMIC_RELAXED, __HIP_MEMORY_SCOPE_AGENT);
        __syncthreads();
        const int it = *itb;
        __syncthreads();
        if (it >= nit) break;
        Ctx Fi; Fi.a = kargs(); Fi.tid = opaque_v((int)threadIdx.x); Fi.lane = Fi.tid & 63; Fi.wave = __builtin_amdgcn_readfirstlane(Fi.tid >> 6); Fi.bid = opaque((int)blockIdx.x); Fi.G = opaque((int)gridDim.x);
        Fi.lds = (LAS unsigned char*)((LAS unsigned char*)0 + opaque(0)) + (F.lds - (LAS unsigned char*)0);
#ifdef PROBE_T
        if (l == 0 && F.tid == 0 && it == 5) ((unsigned long long*)(F.a->ws + WS_CTL + CW_STAMP * 4))[21] = __builtin_amdgcn_s_memrealtime();
        if (l == 0 && F.tid == 0 && it == 300) ((unsigned long long*)(F.a->ws + WS_CTL + CW_STAMP * 4))[23] = __builtin_amdgcn_s_memrealtime();
#endif
        if (it < 128) { for (int rep = 0; rep < ((DUPK == 9) ? 2 : 1); ++rep) rw_chunk_item2(Fi, opaque(l), it); }
        else if (it < 128 + NS5) stage_s5_scan<1>(Fi, opaque(l), it - 128);
        else if (it < 640 + NS5) hyena_item(Fi, opaque(l), it - 128 - NS5, 0);
        else hyena_item(Fi, opaque(l), it - 640 - NS5, 1);
#ifdef PROBE_T
        if (l == 0 && F.tid == 0 && it == 5) ((unsigned long long*)(F.a->ws + WS_CTL + CW_STAMP * 4))[22] = __builtin_amdgcn_s_memrealtime();
        if (l == 0 && F.tid == 0 && it == 300) ((unsigned long long*)(F.a->ws + WS_CTL + CW_STAMP * 4))[24] = __builtin_amdgcn_s_memrealtime();
#endif
    }
}

typedef float f32x16r __attribute__((ext_vector_type(16)));
__device__ __forceinline__ void stage_norm2_router(const Ctx& F, int l, int nrows) {
    const auto& a = *F.a; unsigned char* ws = a.ws; const int lane = F.lane;
    const float* X = (const float*)(ws + WS_X); bf16* H = (bf16*)(ws + WS_H); const float* MOD = (const float*)(ws + WS_MOD);
    int* EIDX = (int*)(ws + WS_EIDX); float* GATE = (float*)(ws + WS_GATE); int* POS = (int*)(ws + WS_POS); unsigned* ROWOF = (unsigned*)(ws + WS_ROWOF);
    LAS int* lex = (LAS int*)(F.lds + 40960); LAS int* lrk = lex + 2048; LAS int* offl = lrk + 2048;
    LAS float* lg = (LAS float*)(F.lds + F.wave * 4352);
    LAS int* hist = (LAS int*)(F.lds + LDSCTL_OFF + 1024);
    if (F.tid < 32) hist[F.tid] = 0;
    __syncthreads();
    const int rpb = (nrows + F.G - 1) / F.G, r0 = F.bid * rpb, r1 = (r0 + rpb < nrows) ? r0 + rpb : nrows;
    const float* rw = a.in[I_RTW] + (size_t)l * 1024 * 32;
    const int i = lane & 31, kk = lane >> 5;
    const f32x4* ng = (const f32x4*)(a.in[I_N2G] + l * D) + kk;
    for (int rb = r0 + F.wave * 32; rb < r1; rb += NWAVES * 32) {
        const int nrow = (r1 - rb) < 32 ? (r1 - rb) : 32; const bool live = i < nrow;
        const int row = live ? rb + i : r1 - 1; const int w = row < T_LAT ? (row >> 12) : 8;
        const f32x4* xr = (const f32x4*)(X + (size_t)row * D) + kk;
        float ss = 0.f;
#pragma unroll 16
        for (int q = 0; q < 128; ++q) { const f32x4 v = xr[2 * q]; ss += (v[0] * v[0] + v[1] * v[1]) + (v[2] * v[2] + v[3] * v[3]); }
        ss += __builtin_bit_cast(float, __builtin_amdgcn_ds_bpermute((lane ^ 32) << 2, __builtin_bit_cast(int, ss)));
        const float rstd = __builtin_amdgcn_rsqf(ss * (1.f / D) + 1e-6f);
        const f32x4* sh = (const f32x4*)(MOD + (size_t)(l * 9 + w) * 6144 + 3072) + kk; const f32x4* sc = (const f32x4*)(MOD + (size_t)(l * 9 + w) * 6144 + 4096) + kk;
        v2u* ho = (v2u*)(H + (size_t)row * D) + kk;
        f32x16r acc;
#pragma unroll
        for (int e = 0; e < 16; ++e) acc[e] = 0.f;
        const float* wp = rw + (size_t)(4 * kk) * 32 + i;
        f32x4 xn[4], gn_[4], cn_[4], sn_[4], wn_[4];
#define RT_LOAD(q0_) do { _Pragma("unroll") for (int u_ = 0; u_ < 4; ++u_) { const int q_ = (q0_) + u_; xn[u_] = xr[2 * q_]; gn_[u_] = ng[2 * q_]; cn_[u_] = sc[2 * q_]; sn_[u_] = sh[2 * q_]; \
            wn_[u_] = (f32x4){wp[(size_t)(8 * q_) * 32], wp[(size_t)(8 * q_ + 1) * 32], wp[(size_t)(8 * q_ + 2) * 32], wp[(size_t)(8 * q_ + 3) * 32]}; } } while (0)
        RT_LOAD(0);
#pragma unroll 1
        for (int q0 = 0; q0 < 128; q0 += 4) {
            f32x4 xc[4], gc_[4], cc_[4], sc_[4], wc_[4];
#pragma unroll
            for (int u = 0; u < 4; ++u) { xc[u] = xn[u]; gc_[u] = gn_[u]; cc_[u] = cn_[u]; sc_[u] = sn_[u]; wc_[u] = wn_[u]; }
            if (q0 + 4 < 128) RT_LOAD(q0 + 4);
#pragma unroll
            for (int u = 0; u < 4; ++u) { const int q = q0 + u;
                const f32x4 h4 = xc[u] * rstd * gc_[u] * (cc_[u] + 1.0f) + sc_[u];
                if (live) { v2u o; o.x = pk2(h4[0], h4[1]); o.y = pk2(h4[2], h4[3]); ho[2 * q] = o; }
                acc = __builtin_amdgcn_mfma_f32_32x32x2f32(h4[0], wc_[u][0], acc, 0, 0, 0);
                acc = __builtin_amdgcn_mfma_f32_32x32x2f32(h4[1], wc_[u][1], acc, 0, 0, 0);
                acc = __builtin_amdgcn_mfma_f32_32x32x2f32(h4[2], wc_[u][2], acc, 0, 0, 0);
                acc = __builtin_amdgcn_mfma_f32_32x32x2f32(h4[3], wc_[u][3], acc, 0, 0, 0); }
        }
#undef RT_LOAD
        const float rbias = a.in[I_RTB][l * 32 + i];
#pragma unroll
        for (int r = 0; r < 16; ++r) { const int ri = (r & 3) + 8 * (r >> 2) + 4 * kk; lg[ri * 33 + i] = acc[r] + rbias; }
        LDS_WAIT(); asm volatile("" ::: "memory");
        if (lane < nrow) {
            LAS float* lr = lg + lane * 33; const int orow = rb + lane;
            float tv[4]; int ti[4];
#pragma unroll
            for (int r = 0; r < 4; ++r) { float bv = -INFINITY; int bi = 0;
#pragma unroll 8
                for (int e = 0; e < 32; ++e) { const float v = lr[e]; if (v > bv) { bv = v; bi = e; } }
                tv[r] = bv; ti[r] = bi; lr[bi] = -INFINITY; }
            const float e1 = expf(tv[1] - tv[0]), e2 = expf(tv[2] - tv[0]), e3 = expf(tv[3] - tv[0]); const float inv = 1.0f / (1.0f + e1 + e2 + e3);
            *(int4*)(EIDX + orow * 4) = make_int4(ti[0], ti[1], ti[2], ti[3]); *(f32x4*)(GATE + orow * 4) = (f32x4){inv, e1 * inv, e2 * inv, e3 * inv};
#pragma unroll
            for (int r = 0; r < 4; ++r) { const int rk = __hip_atomic_fetch_add(&hist[ti[r]], 1, __ATOMIC_RELAXED, __HIP_MEMORY_SCOPE_WORKGROUP); lex[(orow - r0) * 4 + r] = ti[r]; lrk[(orow - r0) * 4 + r] = rk; }
        }
        LDS_WAIT(); asm volatile("" ::: "memory");
    }
    __syncthreads();
    if (F.tid < 32) { const int c = hist[F.tid]; offl[F.tid] = c ? (int)__hip_atomic_fetch_add((unsigned*)(ws + WS_CTL) + CW_CNT + 64 * l + F.tid, (unsigned)c, __ATOMIC_RELAXED, __HIP_MEMORY_SCOPE_AGENT) : 0; }
    __syncthreads();
    for (int i = F.tid; i < (r1 > r0 ? (r1 - r0) * 4 : 0); i += NTHREADS) { const int e = lex[i], pos = offl[e] + lrk[i];
        POS[r0 * 4 + i] = pos; ROWOF[(size_t)e * pg8::MOE_CAP + pos] = (unsigned)(r0 + (i >> 2)) * (unsigned)(D * 2); }
    __syncthreads();
}

__device__ __forceinline__ LAS int* load_moe_base(const Ctx& F, int l) {
    LAS int* base = (LAS int*)(F.lds + LDSCTL_OFF + 256);
    if (F.tid < 32) base[64 + F.tid] = (int)__hip_atomic_load((unsigned*)(F.a->ws + WS_CTL) + CW_CNT + 64 * l + F.tid, __ATOMIC_RELAXED, __HIP_MEMORY_SCOPE_AGENT);
    __syncthreads();
    if (F.tid == 0) { int acc = 0; for (int e = 0; e < 32; ++e) { base[e] = acc; acc += (base[64 + e] + 255) & ~255; } base[32] = acc; }
    __syncthreads();
    return base;
}
__device__ __forceinline__ void moe_fix_pos(const Ctx& F, int nrows, const LAS int* base) {
    unsigned char* ws = F.a->ws; const int* EIDX = (const int*)(ws + WS_EIDX); int* POS = (int*)(ws + WS_POS);
    const int rpb = (nrows + F.G - 1) / F.G, r0 = F.bid * rpb, r1 = (r0 + rpb < nrows) ? r0 + rpb : nrows;
    for (int i = F.tid; i < (r1 > r0 ? (r1 - r0) * 4 : 0); i += NTHREADS) POS[r0 * 4 + i] += base[EIDX[r0 * 4 + i]];
}

constexpr int NSTAGE_L = 13, NSTAGES = 1 + DEPTH * NSTAGE_L + 1;
__global__ void __launch_bounds__(NTHREADS, 2) mk_fwd(Args args) {
    extern __shared__ __attribute__((aligned(16))) unsigned char lds_raw[];
    Ctx F; F.a = kargs(); F.lds = (LAS unsigned char*)lds_raw; F.tid = threadIdx.x; F.lane = F.tid & 63; F.wave = __builtin_amdgcn_readfirstlane(F.tid >> 6); F.bid = blockIdx.x; F.G = gridDim.x;
    volatile LAS unsigned* MISC = (volatile LAS unsigned*)(F.lds + LDSCTL_OFF);
    for (int u = F.tid; u < (LDS_BYTES - LDSCTL_OFF) / 4; u += NTHREADS) ((LAS unsigned*)(F.lds + LDSCTL_OFF))[u] = 0u;
    __syncthreads();
#if MK_PER_STAGE
#define GRID_BAR() do { } while (0)
#else
    (void)xcd_barrier_post((unsigned*)(F.a->ws + WS_CTL) + CW_BAR, MISC + 8);
#define GRID_BAR() do { XcdBarrier b_; b_.bar = (unsigned*)(kargs()->ws + WS_CTL) + CW_BAR; b_.x = xb_xcc_id(); b_.st = (volatile LAS unsigned*)((LAS unsigned char*)lds_raw + LDSCTL_OFF + opaque(32)); xcd_barrier(b_); } while (0)
#endif
#ifndef ONLY_S
#define ONLY_S -1
#endif
#define STG_SEL(k) (ONLY_S < 0 || ONLY_S == (((k) == 0) ? 0 : ((k) == NSTAGES - 1 ? 14 : (((k) - 1) % NSTAGE_L) + 1)))
#if MK_PER_STAGE
#define IN(k) (STG_SEL(k) && kargs()->ph_lo == (k))
#else
#define IN(k) STG_SEL(k)
#endif
#if MK_PER_STAGE
#define SEAM(k) do { } while (0)
#else
#define SEAM(k) do { if ((k) + 1 < NSTAGES) GRID_BAR(); } while (0)
#endif
#define STAGE(k) if (IN(k)) { F.a = kargs(); F.tid = opaque_v((int)threadIdx.x); F.lane = F.tid & 63; F.wave = __builtin_amdgcn_readfirstlane(F.tid >> 6); F.bid = opaque((int)blockIdx.x); F.G = opaque((int)gridDim.x); F.lds = (LAS unsigned char*)lds_raw + opaque(0); unsigned char* ws = F.a->ws; const int l = opaque(lq); unsigned char* wl = ws + WS_WTS + (size_t)l * WL_STRIDE; (void)wl; (void)ws;
#define STAGE_END(k) } SEAM(k);
    int lq = 0;
    STAGE(0) p0_prologue(F); STAGE_END(0)
    for (lq = 0; lq < DEPTH; ++lq) {
        const int sb = 1 + lq * NSTAGE_L;
        const int nrl = opaque((lq == DEPTH - 1) ? T_LAT : T_ALL);
        STAGE(sb + 0) stage_norm1(F, l); STAGE_END(sb + 0)
        STAGE(sb + 1) pg8::SchedWin S; S.A = (const char*)(ws + WS_H); S.Bt = (const char*)(wl + WO_WIN); S.tstep = (size_t)256 * 1024 * 2; S.G = F.G; S.c = F.bid; S.part = (nrl != T_ALL); pg8::EpiBf16 E{(bf16*)(ws + WS_Z), IN_COLS, nullptr, 0};
            pg8::gemm_phase(F.lds, F.tid, 1024, S, E); STAGE_END(sb + 1)
        STAGE(sb + 2) for (int rep = 0; rep < REPN(1); ++rep) stage_rw_prep1(F, l); for (int rep = 0; rep < REPN(2); ++rep) stage_s5_scan<0>(F, l); for (int rep = 0; rep < REPN(3); ++rep) stage_hy_pre(F, l, nrl); STAGE_END(sb + 2)
        STAGE(sb + 3) { pg8::SchedStatic S; S.init(ws + WS_ARW, wl + WO_RWCAT, T_ALL, 2560, 256, F.G, F.bid); pg8::EpiBf16 E{(bf16*)(ws + WS_P), 2560, nullptr, 0}; PT(4); pg8::gemm_phase(F.lds, F.tid, 256, S, E); PT(5); }
            F.tid = opaque_v((int)threadIdx.x); F.lane = F.tid & 63;
            STAGE_END(sb + 3)
        STAGE(sb + 4) for (int rep = 0; rep < REPN(5); ++rep) stage_rw_prep2(F, l); STAGE_END(sb + 4)
        STAGE(sb + 5) PT(10); stage_mixer(F, l); PT(11); STAGE_END(sb + 5) STAGE(sb + 5) PT(12); }
        STAGE(sb + 6) stage_s5_prep(F, l, nrl); STAGE_END(sb + 6)
        STAGE(sb + 7) { pg8::SchedStatic S; S.init(ws + WS_AS5, wl + WO_GLU, nrl, 1024, 512, F.G, F.bid); pg8::EpiGlu<0> E{(bf16*)(ws + WS_YS5), 512, F.a->in[I_S5GLUB] + l * 1024, 0, 512}; PT(13); pg8::gemm_phase(F.lds, F.tid, 512, S, E); PT(14); }
            for (int rep = 0; rep < REPN(7); ++rep) stage_rw_readout(F, l); for (int rep = 0; rep < REPN(8); ++rep) stage_hy_post(F, l, nrl); STAGE_END(sb + 7)
        STAGE(sb + 8) pg8::SchedMerge S; S.A0 = (const char*)(ws + WS_YHY); S.A1 = (const char*)(ws + WS_YRW); S.A2 = (const char*)(ws + WS_YS5); S.Bt = (const char*)(wl + WO_WBR); S.tstep = (size_t)256 * 512 * 2; S.bstride = (size_t)1024 * 512 * 2;
            S.nM = nrl / 256; S.nN = 4; S.G = F.G; S.c = F.bid;
            pg8::EpiMerge E{(bf16*)(ws + WS_MTMP), (bf16*)(ws + WS_H), (const bf16*)(ws + WS_Z) + GATE_OFF}; pg8::gemm_phase(F.lds, F.tid, 512, S, E); STAGE_END(sb + 8)
        STAGE(sb + 9) pg8::SchedStatic S; S.init(ws + WS_H, wl + WO_WOUT, nrl, 1024, 1024, F.G, F.bid); pg8::EpiResid E{(float*)(ws + WS_X), (const float*)(ws + WS_MOD) + (size_t)l * 9 * 6144 + 2048};
            pg8::gemm_phase(F.lds, F.tid, 1024, S, E); STAGE_END(sb + 9)
        STAGE(sb + 10) PT(17); stage_norm2_router(F, l, nrl); PT(18); STAGE_END(sb + 10)
        STAGE(sb + 11) LAS int* base = load_moe_base(F, l); moe_fix_pos(F, nrl, base);
            pg8::SchedMoeG S; S.A = (const char*)(ws + WS_H); S.rowof = (const unsigned*)(ws + WS_ROWOF); S.Bt = (const char*)(wl + WO_W1); S.tstep = (size_t)256 * 1024 * 2; S.estride = (size_t)2048 * 1024 * 2; S.NPN = 8; S.G = F.G; S.c = F.bid; S.base = base;
            pg8::EpiGlu<1> E{(bf16*)(ws + WS_ACT), 1024, F.a->in[I_B1] + (size_t)l * 32 * 2048, 2048, 1024}; pg8::gemm_phase(F.lds, F.tid, 1024, S, E); STAGE_END(sb + 11)
        STAGE(sb + 12) LAS int* base = load_moe_base(F, l);
            pg8::SchedMoe S; S.A = (const char*)(ws + WS_ACT); S.Bt = (const char*)(wl + WO_W2); S.tstep = (size_t)256 * 1024 * 2; S.estride = (size_t)1024 * 1024 * 2; S.NPN = 4; S.G = F.G; S.c = F.bid; S.base = base;
            pg8::EpiBf16 E{(bf16*)(ws + WS_XS), 1024, F.a->in[I_B2] + (size_t)l * 32 * 1024, 1024}; pg8::gemm_phase(F.lds, F.tid, 1024, S, E); STAGE_END(sb + 12)
    }
    lq = DEPTH;
    STAGE(NSTAGES - 1)
#ifndef PROBE_T
        stage_norm1(F, l);
#endif
#ifdef PROBE_T
        { const unsigned long long* st = (const unsigned long long*)(F.a->ws + WS_CTL + CW_STAMP * 4); const float cval = (float)(long long)(st[PROBE_B] - st[PROBE_A]) * (1.0f / (100.0f * PROBE_DIV));
          __syncthreads(); for (size_t i = (size_t)F.bid * NTHREADS + F.tid; i < (size_t)T_LAT * D; i += (size_t)F.G * NTHREADS) F.a->out[i] = cval; }
#endif
    }
#undef IN
#undef SEAM
}

extern "C" void kernel_launch(void* const* d_in, const int* in_sizes, int n_in, void* d_out, int out_size, void* d_ws, size_t ws_size, hipStream_t stream) {
    static int grid = 0;
    if (grid == 0) {
        if (n_in != 51 || out_size != T_LAT * D || ws_size < WS_END) { fprintf(stderr, "kernel_launch: unexpected shapes (n_in %d out %d ws %zu, need %zu)\n", n_in, out_size, ws_size, (size_t)WS_END); grid = -1; return; }
        int dev = 0, cus = 0, per_cu = 0;
        if (hipGetDevice(&dev) != hipSuccess || hipDeviceGetAttribute(&cus, hipDeviceAttributeMultiprocessorCount, dev) != hipSuccess) { grid = -1; return; }
        if (hipFuncSetAttribute((const void*)mk_fwd, hipFuncAttributeMaxDynamicSharedMemorySize, LDS_BYTES) != hipSuccess) { fprintf(stderr, "kernel_launch: hipFuncSetAttribute failed\n"); grid = -1; return; }
        if (hipOccupancyMaxActiveBlocksPerMultiprocessor(&per_cu, (const void*)mk_fwd, NTHREADS, LDS_BYTES) != hipSuccess || per_cu < 1) fprintf(stderr, "kernel_launch: occupancy query says %d\n", per_cu);
        (void)hipGetLastError();
        grid = cus;
    }
    if (grid < 0) return;
    if (hipMemsetAsync((char*)d_ws + WS_CTL, 0, CTL_ZERO_BYTES, stream) != hipSuccess) return;
    Args a{};
    for (int i = 0; i < 51; ++i) a.in[i] = (const float*)d_in[i];
    a.out = (float*)d_out; a.ws = (unsigned char*)d_ws;
#if MK_PER_STAGE
    for (int s = 0; s < NSTAGES; ++s) { a.ph_lo = s; a.ph_hi = s + 1; int reps = 1;
#ifdef PROBE_SET
        { const int ls = (s == 0 || s == NSTAGES - 1) ? -1 : (s - 1) % NSTAGE_L;
          if (PROBE_SET >= 1 && PROBE_SET <= 13 && ls == PROBE_SET - 1 && ls != 5 && ls != 8 && !(ls == 0 && s > 1)) reps = 3;
          if (PROBE_SET == 14 && s == 0) reps = 3; }
#endif
        for (int r = 0; r < reps; ++r) hipLaunchKernelGGL(mk_fwd, dim3(grid), dim3(NTHREADS), LDS_BYTES, stream, a); }
#else
    a.ph_lo = 0; a.ph_hi = NSTAGES; hipLaunchKernelGGL(mk_fwd, dim3(grid), dim3(NTHREADS), LDS_BYTES, stream, a);
#endif
}
```

```cpp
#include <hip/hip_runtime.h>
#include <cstdio>
#include <cstdint>

#ifndef DUPK
#define DUPK 0
#endif
#define REPN(k) ((DUPK == (k)) ? 3 : 1)
#ifndef REP_GEMM
#define REP_GEMM 1
#endif
#ifndef REP_LIGHT
#define REP_LIGHT 1
#endif
#ifndef REP_PRO
#define REP_PRO 1
#endif
#ifndef MK_PER_STAGE
#define MK_PER_STAGE 0
#endif

#define GAS __attribute__((address_space(1)))
#define LAS __attribute__((address_space(3)))
typedef unsigned short bf16;
typedef unsigned v4u __attribute__((ext_vector_type(4)));
typedef unsigned v2u __attribute__((ext_vector_type(2)));
typedef float f32x4 __attribute__((ext_vector_type(4)));
typedef float f32x2 __attribute__((ext_vector_type(2)));
typedef short bf16x8 __attribute__((ext_vector_type(8)));

constexpr int D = 1024, BATCH = 8, SEQ = 4096, CTXL = 256, DEPTH = 2;
constexpr int T_LAT = BATCH * SEQ, T_CTX = BATCH * CTXL, T_ALL = T_LAT + T_CTX;
constexpr int IN_COLS = 6912, HY_OFF = 0, RW_OFF = 1536, S5_OFF = 3328, GATE_OFF = 3840;
constexpr int NE = 32, TOPK = 4;
constexpr int MAXSLOT = 147456;
constexpr int NWAVES = 8, NTHREADS = 512;
constexpr int HY_MARG = 128, HY_ROWB = 8720, HY_RLEN = 8272, HY_RLENC = 592;
constexpr int HY_R1_OFF = 8 * HY_ROWB, HY_R2_OFF = HY_R1_OFF + HY_RLEN * 2;

constexpr size_t MiB = 1ull << 20;
constexpr size_t WS_CTL = 0, CTL_ZERO_BYTES = 1 * MiB;
constexpr size_t WS_MOD = 1 * MiB;
constexpr size_t WS_BLKCNT = 2 * MiB;
constexpr size_t WS_META = 2 * MiB + 512 * 1024;
constexpr size_t WS_ROWOF = 480 * MiB;
constexpr int CW_CNT = 24576;
constexpr size_t WS_EIDX = 3 * MiB, WS_GATE = 4 * MiB, WS_POS = 5 * MiB;
constexpr size_t WS_WTS = 8 * MiB, WL_STRIDE = 214 * MiB;
constexpr size_t WO_WIN = 0, WO_RWCAT = 14 * MiB, WO_GLU = 16 * MiB, WO_WBR = 17 * MiB, WO_WOUT = 20 * MiB, WO_W1 = 22 * MiB, WO_W2 = 150 * MiB;
constexpr size_t WS_GF = 436 * MiB, GF_STRIDE = 20 * MiB, GF_CTX = 17 * MiB;
constexpr size_t WS_X = 504 * MiB;
constexpr size_t WS_H = 640 * MiB;
constexpr size_t WS_BIG = 708 * MiB;
constexpr size_t WS_Z = WS_BIG;
constexpr size_t WS_SCN = 1167 * MiB;
constexpr size_t WS_MTMP = WS_SCN;
constexpr size_t WS_P = 1473 * MiB;
constexpr size_t WS_ARW = 1643 * MiB;
constexpr size_t WS_YDIR = 1660 * MiB;
constexpr size_t WS_YP = 1898 * MiB;
constexpr size_t WS_UT = 1796 * MiB;
constexpr size_t WS_AS5 = 2000 * MiB;
constexpr size_t WS_YHY = 1898 * MiB, WS_YRW = 1932 * MiB, WS_YS5 = 1966 * MiB;
constexpr size_t WS_XS = WS_BIG;
constexpr size_t WS_ACT = WS_BIG + 288 * MiB;
constexpr size_t WS_END = 2034 * MiB;
constexpr int CW_BAR = 4096;

constexpr int RING_BYTES = 131072;
constexpr int LDSCTL_OFF = RING_BYTES;
constexpr int LDS_BYTES = 163840;

typedef __bf16 bf16x2_t __attribute__((ext_vector_type(2)));
__device__ __forceinline__ unsigned pk2(float lo, float hi) { const bf16x2_t v = __builtin_convertvector((f32x2){lo, hi}, bf16x2_t); return __builtin_bit_cast(unsigned, v); }
__device__ __forceinline__ unsigned f2bf(float f) { return pk2(f, 0.f) & 0xffffu; }
__device__ __forceinline__ float bf2f(bf16 b) { return __builtin_bit_cast(float, ((unsigned)b) << 16); }
__device__ __forceinline__ float bflo(unsigned w) { return __builtin_bit_cast(float, w << 16); }
__device__ __forceinline__ float bfhi(unsigned w) { return __builtin_bit_cast(float, w & 0xffff0000u); }
__device__ __forceinline__ float sigm(float x) { return __builtin_amdgcn_rcpf(1.f + __expf(-x)); }
__device__ __forceinline__ float tanh_fast(float x) { const float e = __expf(2.f * x); return 1.f - 2.f * __builtin_amdgcn_rcpf(e + 1.f); }
#define LDS_WAIT() asm volatile("s_waitcnt lgkmcnt(0)" ::: "memory")
__device__ __forceinline__ float dpp_f(float x, const int ctrl_sel) {
    const int v = __builtin_bit_cast(int, x);
    int r;
    if (ctrl_sel == 0) r = __builtin_amdgcn_update_dpp(0, v, 0xB1, 0xF, 0xF, true);
    else if (ctrl_sel == 1) r = __builtin_amdgcn_update_dpp(0, v, 0x4E, 0xF, 0xF, true);
    else r = __builtin_amdgcn_update_dpp(0, v, 0x141, 0xF, 0xF, true);
    return __builtin_bit_cast(float, r);
}
__device__ __forceinline__ float red32(float x) {
    x += dpp_f(x, 0); x += dpp_f(x, 1); x += dpp_f(x, 2);
    x += __builtin_bit_cast(float, __builtin_amdgcn_update_dpp(0, __builtin_bit_cast(int, x), 0x128, 0xF, 0xF, true));
    x += __builtin_bit_cast(float, __builtin_amdgcn_ds_swizzle(__builtin_bit_cast(int, x), 0x401F));
    return x;
}
__device__ __forceinline__ float wave_sum(float v) {
    v = red32(v);
    return __builtin_bit_cast(float, __builtin_amdgcn_readlane(__builtin_bit_cast(int, v), 0)) + __builtin_bit_cast(float, __builtin_amdgcn_readlane(__builtin_bit_cast(int, v), 32));
}
__device__ __forceinline__ int xch32(int v, const int step) {
    if (step == 0) return __builtin_amdgcn_update_dpp(0, v, 0xB1, 0xF, 0xF, true);
    if (step == 1) return __builtin_amdgcn_update_dpp(0, v, 0x4E, 0xF, 0xF, true);
    if (step == 2) return __builtin_amdgcn_update_dpp(0, v, 0x141, 0xF, 0xF, true);
    if (step == 3) return __builtin_amdgcn_update_dpp(0, v, 0x128, 0xF, 0xF, true);
    return __builtin_amdgcn_ds_swizzle(v, 0x401F);
}
__device__ __forceinline__ float red8(float x) { x += dpp_f(x, 0); x += dpp_f(x, 1); x += dpp_f(x, 2); return x; }

#define XB_TMO      128
#define XB_XCNT(j)  (256  + 64 * (j))
#define XB_XSUB(j)  (1280 + 64 * (j))
#define XB_XGEN(j)  (2304 + 64 * (j))
#define XB_TOP      3328
#define XB_TOPGEN   3392
#define XCD_BAR_WORDS 3456
#define XB_SPIN_CAP (1u << 22)
__device__ __forceinline__ unsigned xb_ld(unsigned* p)              { return __hip_atomic_load(p, __ATOMIC_RELAXED, __HIP_MEMORY_SCOPE_AGENT); }
__device__ __forceinline__ unsigned xb_add(unsigned* p, unsigned v) { return __hip_atomic_fetch_add(p, v, __ATOMIC_RELAXED, __HIP_MEMORY_SCOPE_AGENT); }
__device__ __forceinline__ unsigned xb_xcc_id() { return (unsigned)__builtin_amdgcn_s_getreg((3 << 11) | 20) & 0xFu; }
#define XB_SPIN(cond, bar) do { unsigned _sp = 0; while (cond) { __builtin_amdgcn_s_sleep(1); \
    if ((++_sp & 255u) == 0u) { if (xb_ld(&(bar)[XB_TMO])) break; if (_sp > XB_SPIN_CAP) { atomicAdd(&(bar)[XB_TMO], 1u); break; } } } } while (0)
struct XcdBarrier { unsigned* bar; unsigned x; volatile LAS unsigned* st; };
__device__ __forceinline__ XcdBarrier xcd_barrier_post(unsigned* bar, volatile LAS unsigned* st) {
    XcdBarrier b; b.bar = bar; b.x = xb_xcc_id(); b.st = st;
    if (threadIdx.x == 0) (void)xb_add(&bar[XB_XCNT(b.x)], 1u);
    return b;
}
__device__ __forceinline__ void xcd_barrier_complete(unsigned* bar, unsigned x, unsigned& nloc, unsigned& nx) {
    const unsigned G = gridDim.x * gridDim.y * gridDim.z;
    unsigned sum, cnt, mine, sp = 0u;
    for (;;) {
        sum = 0u; cnt = 0u; mine = 0u;
#pragma unroll
        for (unsigned j = 0; j < 16; ++j) { const unsigned c = xb_ld(&bar[XB_XCNT(j)]); sum += c; cnt += (c > 0u) ? 1u : 0u; mine = (j == x) ? c : mine; }
        if (sum == G) break;
        __builtin_amdgcn_s_sleep(1);
        if ((++sp & 255u) == 0u) { if (xb_ld(&bar[XB_TMO])) break; if (sp > XB_SPIN_CAP) { atomicAdd(&bar[XB_TMO], 1u); break; } }
    }
    nloc = mine > 0u ? mine : 1u; nx = cnt > 0u ? cnt : 1u;
}
__device__ __forceinline__ void xcd_barrier(const XcdBarrier& b) {
    asm volatile("s_waitcnt vmcnt(0)" ::: "memory");
    __syncthreads();
    if (threadIdx.x == 0) {
        unsigned* bar = b.bar;
        __builtin_amdgcn_s_waitcnt(0);
        unsigned nloc = b.st[0], nx = b.st[1];
        if (nloc == 0u) { xcd_barrier_complete(bar, b.x, nloc, nx); b.st[0] = nloc; b.st[1] = nx; }
        const unsigned old = xb_add(&bar[XB_XSUB(b.x)], 1u);
        const unsigned gen = old / nloc;
        if (old + 1u == (gen + 1u) * nloc) {
            __builtin_amdgcn_fence(__ATOMIC_RELEASE, "agent");
            asm volatile("s_waitcnt vmcnt(0)" ::: "memory");
            const unsigned og = xb_add(&bar[XB_TOP], 1u);
            const unsigned tg = og / nx;
            if (og + 1u == (tg + 1u) * nx) xb_add(&bar[XB_TOPGEN], 1u);
            else XB_SPIN(xb_ld(&bar[XB_TOPGEN]) == tg, bar);
            __builtin_amdgcn_fence(__ATOMIC_ACQUIRE, "agent");
            xb_add(&bar[XB_XGEN(b.x)], 1u);
            asm volatile("s_waitcnt vmcnt(0)" ::: "memory");
        } else {
            XB_SPIN(xb_ld(&bar[XB_XGEN(b.x)]) == gen, bar);
            __builtin_amdgcn_fence(__ATOMIC_ACQUIRE, "agent");
            asm volatile("s_waitcnt vmcnt(0)" ::: "memory");
        }
    }
    __syncthreads();
}

namespace pg8 {
constexpr int MOE_CAP = 34816;
constexpr int BM = 256, BK = 64, HALF = 128, HTB = HALF * BK * 2, STAGE_BYTES = 8 * HTB, NXCD = 8, WGM = 8, ROWTAB_OFF = 131072 + 4096;
__host__ __device__ __forceinline__ int lds_byte(int r, int c) { const int st = (r >> 4) * 2 + (c >> 5), rr = r & 15, cc = c & 31, ob = rr * 64 + cc * 2; return st * 1024 + (ob ^ (((ob >> 9) & 1) << 5)); }
__host__ __device__ __forceinline__ void stage_rc(int b, int& R, int& C) { const int st = b / 1024, sb = b % 1024, swz = sb ^ (((sb >> 9) & 1) << 5); R = (st >> 1) * 16 + swz / 64; C = (st & 1) * 32 + (swz % 64) / 2; }
__host__ __device__ __forceinline__ int perm32(int rho) { const int n = rho >> 4, i = rho & 15; return 8 * (i >> 2) + 4 * n + (i & 3); }
struct Unit { int pm, pn, e; };
__device__ __forceinline__ unsigned cvt_pk_bf16(float lo, float hi) { return pk2(lo, hi); }

__device__ __forceinline__ void tile_of(int L, int nM, int nN, int& pm, int& pn) {
    const int nwg = nM * nN; int wgid = L;
    { const int q = nwg / NXCD, r = nwg % NXCD, xcd = wgid % NXCD, off = wgid / NXCD; wgid = (xcd < r ? xcd * (q + 1) : r * (q + 1) + (xcd - r) * q) + off; }
    const int nig = WGM * nN, gid = wgid / nig, fm = gid * WGM, gsz = (nM - fm) < WGM ? (nM - fm) : WGM;
    pm = fm + ((wgid % nig) % gsz); pn = (wgid % nig) / gsz;
}
struct SchedStatic {
    static constexpr bool GATHER = false;
    const char* A; const char* Bt; size_t tstep; int nM, nN, G, c;
    __device__ __forceinline__ void init(const void* A_, const void* Bt_, int M, int N, int K, int G_, int c_) { A = (const char*)A_; Bt = (const char*)Bt_; tstep = (size_t)BM * K * 2; nM = M / BM; nN = N / BM; G = G_; c = c_; }
    __device__ __forceinline__ bool next(int i, Unit& u) const { const long L = (long)i * G + c; if (L >= (long)nM * nN) return false; tile_of((int)L, nM, nN, u.pm, u.pn); u.e = 0; return true; }
    __device__ __forceinline__ const char* aptr(const Unit& u) const { return A + (size_t)u.pm * tstep; }
    __device__ __forceinline__ const char* bptr(const Unit& u) const { return Bt + (size_t)u.pn * tstep; }
};
struct SchedWin {
    static constexpr bool GATHER = false;
    const char* A; const char* Bt; size_t tstep; int G, c, part;
    __device__ __forceinline__ bool next(int i, Unit& u) const {
        const int L = i * G + c, nmf = part ? 128 : 136, nfull = nmf * 27; u.e = 0;
        if (L < nfull) { tile_of(L, nmf, 27, u.pm, u.pn); return true; }
        const int L2 = L - nfull; if (!part || L2 >= 8 * 9) return false;
        u.pm = 128 + L2 / 9; u.pn = 6 + L2 % 9; return true; }
    __device__ __forceinline__ const char* aptr(const Unit& u) const { return A + (size_t)u.pm * tstep; }
    __device__ __forceinline__ const char* bptr(const Unit& u) const { return Bt + (size_t)u.pn * tstep; }
};
struct SchedMerge {
    static constexpr bool GATHER = false;
    const char* A0; const char* A1; const char* A2; const char* Bt; size_t tstep, bstride; int nM, nN, G, c;
    __device__ __forceinline__ bool next(int i, Unit& u) const { const int j = i / 3, br = i - 3 * j; const long L = (long)j * G + c; if (L >= (long)nM * nN) return false; tile_of((int)L, nM, nN, u.pm, u.pn); u.e = br; return true; }
    __device__ __forceinline__ const char* aptr(const Unit& u) const { return (u.e == 0 ? A0 : (u.e == 1 ? A1 : A2)) + (size_t)u.pm * tstep; }
    __device__ __forceinline__ const char* bptr(const Unit& u) const { return Bt + (size_t)u.e * bstride + (size_t)u.pn * tstep; }
};
struct SchedMoe {
    static constexpr bool GATHER = false;
    const char* A; const char* Bt; size_t tstep, estride; int NPN, G, c; const LAS int* base;
    __device__ __forceinline__ bool next(int i, Unit& u) const {
        const int ntiles = base[32] >> 8; const int per = G >> 3;
        const long L = (long)i * G + (((G & 7) == 0) ? (c & 7) * per + (c >> 3) : c);
        if (L >= (long)ntiles * NPN) return false;
        u.pm = (int)(L / NPN); u.pn = (int)(L % NPN); const int r0 = u.pm << 8; int e = 0;
#pragma unroll 1
        for (int k = 1; k < 32; ++k) e += (r0 >= base[k]) ? 1 : 0;
        u.e = e; return true;
    }
    __device__ __forceinline__ const char* aptr(const Unit& u) const { return A + (size_t)u.pm * tstep; }
    __device__ __forceinline__ const char* bptr(const Unit& u) const { return Bt + (size_t)u.e * estride + (size_t)u.pn * tstep; }
};
struct SchedMoeG : SchedMoe {
    static constexpr bool GATHER = true;
    const unsigned* rowof;
    __device__ __forceinline__ const char* aptr(const Unit&) const { return A; }
    __device__ __forceinline__ const unsigned* rowptr(const Unit& u) const { return rowof + (size_t)u.e * MOE_CAP + ((u.pm << 8) - base[u.e]); }
    __device__ __forceinline__ int valid(const Unit& u) const { return base[64 + u.e] - ((u.pm << 8) - base[u.e]); }
};

template <class Epi, class Sched>
__device__ __forceinline__ void gemm_phase(LAS unsigned char* lds, const int tid, const int K, const Sched& S, const Epi& E) {
    const int wid = __builtin_amdgcn_readfirstlane(tid >> 6), lane = tid & 63, wr = wid >> 2, wc = wid & 3, fr = lane & 15, fq = lane >> 4;
    const int nt = K / BK;
    unsigned voffA[2], voffB[2];
#pragma unroll
    for (int i = 0; i < 2; ++i) { int R, C; stage_rc(tid * 16 + i * 8192, R, C); const int Rb = Epi::PERM ? ((R & ~31) + perm32(R & 31)) : R;
        voffA[i] = (unsigned)(R * K + C) * 2u; voffB[i] = (unsigned)(Rb * K + C) * 2u; }
    const size_t kstep = (size_t)(BK * 2);
    const size_t hstep = (size_t)HALF * K * 2;
    const unsigned ldsw = (unsigned)wid * 1024u;
    const int aoff = lds_byte(wr * 64 + fr, fq * 8), boff = lds_byte(wc * 32 + fr, fq * 8);
#define PG8_SA(b, h) (((b) * 2 + (h)) * HTB)
#define PG8_SB(b, h) ((4 + (b) * 2 + (h)) * HTB)
#define PG8_STAGE(bufoff, gbase, voff) do { _Pragma("unroll") for (int _i = 0; _i < 2; ++_i) \
        __builtin_amdgcn_global_load_lds((const unsigned*)((const char*)(gbase) + (voff)[_i]), (LAS unsigned*)(lds + (bufoff) + ldsw + _i * 8192), 16, 0, 0); } while (0)
#define PG8_STAGEA(bufoff, kp, h) do { if constexpr (Sched::GATHER) { _Pragma("unroll") for (int _i = 0; _i < 2; ++_i) \
        __builtin_amdgcn_global_load_lds((const unsigned*)((const char*)(kp) + g[2 * (h) + _i]), (LAS unsigned*)(lds + (bufoff) + ldsw + _i * 8192), 16, 0, 0); } \
        else { PG8_STAGE(bufoff, (kp) + (h) * hstep, voffA); } } while (0)
#define PG8_GLOAD(un_, buf) do { const LAS unsigned* rt_ = (const LAS unsigned*)(lds + ROWTAB_OFF + (buf) * 1024) + gR0; const int nv_ = S.valid(un_); \
        _Pragma("unroll") for (int _j = 0; _j < 4; ++_j) g[_j] = ((gR0 + 64 * _j < nv_) ? rt_[64 * _j] : 0u) + gCb; } while (0)
#define PG8_GDMA(un_, buf) do { if (wid == 0) { unsigned lo_ = (unsigned)threadIdx.x; asm volatile("" : "+v"(lo_)); lo_ = (lo_ & 63u) * 16u; \
        __builtin_amdgcn_global_load_lds((const unsigned*)((const char*)S.rowptr(un_) + lo_), (LAS unsigned*)(lds + ROWTAB_OFF + (buf) * 1024), 16, 0, 0); } } while (0)
#define PG8_LDA(dst, b, h) do { _Pragma("unroll") for (int m = 0; m < 4; ++m) _Pragma("unroll") for (int k = 0; k < 2; ++k) dst[m][k] = *(const LAS bf16x8*)(lds + PG8_SA(b, h) + aoff + m * 2048 + k * 1024); } while (0)
#define PG8_LDB(dst, b, h) do { _Pragma("unroll") for (int n = 0; n < 2; ++n) _Pragma("unroll") for (int k = 0; k < 2; ++k) dst[n][k] = *(const LAS bf16x8*)(lds + PG8_SB(b, h) + boff + n * 2048 + k * 1024); } while (0)
#define PG8_MMA(ai, bj, At, Bt) do { __builtin_amdgcn_s_setprio(1); _Pragma("unroll") for (int m = 0; m < 4; ++m) _Pragma("unroll") for (int n = 0; n < 2; ++n) _Pragma("unroll") for (int k = 0; k < 2; ++k) \
        acc[ai][bj][m][n] = __builtin_amdgcn_mfma_f32_16x16x32_bf16(Bt[n][k], At[m][k], acc[ai][bj][m][n], 0, 0, 0); __builtin_amdgcn_s_setprio(0); } while (0)
#define PG8_WAIT_V(n) asm volatile("s_waitcnt vmcnt(" #n ")" ::: "memory")
#define PG8_WAIT_L(n) asm volatile("s_waitcnt lgkmcnt(" #n ")" ::: "memory")
#define PG8_BAR __builtin_amdgcn_s_barrier()
#define PG8_SCHED __builtin_amdgcn_sched_barrier(0)
    Unit cur, nxt; int ui = 0;
    if (!S.next(0, cur)) return;
    f32x4 acc[2][2][4][2];
#pragma unroll
    for (int a = 0; a < 2; ++a)
#pragma unroll
        for (int b = 0; b < 2; ++b)
#pragma unroll
            for (int m = 0; m < 4; ++m)
#pragma unroll
                for (int n = 0; n < 2; ++n) acc[a][b][m][n] = (f32x4){0.f, 0.f, 0.f, 0.f};
    bf16x8 At[4][2], B0[2][2], B1[2][2];
    const char* cA = S.aptr(cur); const char* cB = S.bptr(cur);
    unsigned g[4] = {0u, 0u, 0u, 0u}; int gR0 = 0; unsigned gCb = 0u;
    if constexpr (Sched::GATHER) { int R, C; stage_rc(tid * 16, R, C); gR0 = R; gCb = (unsigned)C * 2u;
        PG8_GDMA(cur, 0); PG8_WAIT_V(0); PG8_BAR; PG8_GLOAD(cur, 0); }
    PG8_STAGE(PG8_SB(0, 0), cB, voffB); PG8_STAGE(PG8_SB(0, 1), cB + hstep, voffB); PG8_STAGEA(PG8_SA(0, 0), cA, 0); PG8_STAGEA(PG8_SA(0, 1), cA, 1);
    if (wr == 1) PG8_BAR;
    PG8_WAIT_V(2); PG8_BAR;
    PG8_STAGE(PG8_SB(1, 0), cB + kstep, voffB); PG8_STAGEA(PG8_SA(1, 0), cA + kstep, 0); PG8_STAGE(PG8_SB(1, 1), cB + hstep + kstep, voffB);
    PG8_WAIT_V(6); PG8_BAR;
    for (;;) {
        const bool has_next = S.next(ui + 1, nxt);
        const char* nA = has_next ? S.aptr(nxt) : cA; const char* nB = has_next ? S.bptr(nxt) : cB;
        if constexpr (Sched::GATHER) { if (has_next) PG8_GDMA(nxt, (ui + 1) & 1); }
        for (int t = 0; t < nt; t += 2) {
            const bool last = (t == nt - 2);
            const char* a1 = cA + (size_t)(t + 1) * kstep;
            const char* a2 = last ? nA : cA + (size_t)(t + 2) * kstep; const char* b2 = last ? nB : cB + (size_t)(t + 2) * kstep;
            const char* a3 = a2 + kstep; const char* b3 = b2 + kstep;
            PG8_LDB(B0, 0, 0); PG8_LDB(B1, 0, 1); PG8_SCHED; PG8_LDA(At, 0, 0); PG8_STAGEA(PG8_SA(1, 1), a1, 1);
            PG8_WAIT_V(8); PG8_WAIT_L(0); PG8_BAR; PG8_MMA(0, 0, At, B0); PG8_MMA(0, 1, At, B1); PG8_BAR; PG8_SCHED;
            if constexpr (Sched::GATHER) { if (last && has_next) PG8_GLOAD(nxt, (ui + 1) & 1); PG8_SCHED; }
            PG8_LDA(At, 0, 1); PG8_STAGE(PG8_SB(0, 0), b2, voffB); PG8_STAGE(PG8_SB(0, 1), b2 + hstep, voffB); PG8_STAGEA(PG8_SA(0, 0), a2, 0);
            PG8_WAIT_V(8); PG8_WAIT_L(0); PG8_BAR; PG8_MMA(1, 0, At, B0); PG8_MMA(1, 1, At, B1); PG8_BAR; PG8_SCHED;
            PG8_LDB(B0, 1, 0); PG8_LDB(B1, 1, 1); PG8_SCHED; PG8_LDA(At, 1, 0); PG8_STAGEA(PG8_SA(0, 1), a2, 1);
            PG8_WAIT_V(8); PG8_WAIT_L(0); PG8_BAR; PG8_MMA(0, 0, At, B0); PG8_MMA(0, 1, At, B1); PG8_BAR; PG8_SCHED;
            PG8_LDA(At, 1, 1); PG8_STAGE(PG8_SB(1, 0), b3, voffB); PG8_STAGE(PG8_SB(1, 1), b3 + hstep, voffB); PG8_STAGEA(PG8_SA(1, 0), a3, 0);
            PG8_WAIT_V(8); PG8_WAIT_L(0); PG8_BAR; PG8_MMA(1, 0, At, B0); PG8_MMA(1, 1, At, B1); PG8_BAR; PG8_SCHED;
        }
        if (wr == 0) PG8_BAR;
        { int t2_ = (int)threadIdx.x; asm volatile("" : "+v"(t2_)); E(acc, cur, wr, wc, t2_ & 15, (t2_ >> 4) & 3); }
        if (!has_next) break;
#pragma unroll
        for (int a = 0; a < 2; ++a)
#pragma unroll
            for (int b = 0; b < 2; ++b)
#pragma unroll
                for (int m = 0; m < 4; ++m)
#pragma unroll
                    for (int n = 0; n < 2; ++n) acc[a][b][m][n] = (f32x4){0.f, 0.f, 0.f, 0.f};
        cur = nxt; cA = nA; cB = nB; ++ui;
        if (wr == 1) PG8_BAR;
    }
    PG8_WAIT_V(0);
    PG8_BAR;
#undef PG8_SA
#undef PG8_SB
#undef PG8_STAGE
#undef PG8_STAGEA
#undef PG8_GLOAD
#undef PG8_GDMA
#undef PG8_LDA
#undef PG8_LDB
#undef PG8_MMA
#undef PG8_WAIT_V
#undef PG8_WAIT_L
#undef PG8_BAR
#undef PG8_SCHED
}

struct EpiBf16 {
    static constexpr bool PERM = true;
    bf16* O; int ldc; const float* bias; int bias_stride;
    __device__ __forceinline__ void operator()(const f32x4 (&acc)[2][2][4][2], const Unit& u, int wr, int wc, int fr, int fq) const {
        const int row0 = u.pm * BM + wr * 64 + fr, col0 = u.pn * BM + wc * 32 + 8 * fq;
        f32x4 bv[2][2];
#pragma unroll
        for (int bj = 0; bj < 2; ++bj)
#pragma unroll
            for (int n = 0; n < 2; ++n) bv[bj][n] = bias ? *(const f32x4*)(bias + (size_t)u.e * bias_stride + col0 + bj * HALF + 4 * n) : (f32x4){0.f, 0.f, 0.f, 0.f};
#pragma unroll
        for (int ai = 0; ai < 2; ++ai)
#pragma unroll
            for (int m = 0; m < 4; ++m) { bf16* rowp = O + (size_t)(row0 + ai * HALF + m * 16) * ldc + col0;
#pragma unroll
                for (int bj = 0; bj < 2; ++bj) { const f32x4 v0 = acc[ai][bj][m][0] + bv[bj][0], v1 = acc[ai][bj][m][1] + bv[bj][1];
                    v4u w; w.x = cvt_pk_bf16(v0[0], v0[1]); w.y = cvt_pk_bf16(v0[2], v0[3]); w.z = cvt_pk_bf16(v1[0], v1[1]); w.w = cvt_pk_bf16(v1[2], v1[3]);
                    *(v4u*)(rowp + bj * HALF) = w; } }
    }
};
template <int MODE> struct EpiGlu {
    static constexpr bool PERM = true;
    bf16* O; int ldc; const float* bias; int bias_stride, hs;
    __device__ __forceinline__ void operator()(const f32x4 (&acc)[2][2][4][2], const Unit& u, int wr, int wc, int fr, int fq) const {
        const int row0 = u.pm * BM + wr * 64 + fr, col0 = u.pn * HALF + wc * 32 + 8 * fq;
        const float* bp = bias + (size_t)u.e * bias_stride + col0;
        f32x4 ba[2], bb[2];
#pragma unroll
        for (int n = 0; n < 2; ++n) { ba[n] = *(const f32x4*)(bp + 4 * n); bb[n] = *(const f32x4*)(bp + hs + 4 * n); }
#pragma unroll
        for (int ai = 0; ai < 2; ++ai)
#pragma unroll
            for (int m = 0; m < 4; ++m) { bf16* rowp = O + (size_t)(row0 + ai * HALF + m * 16) * ldc + col0;
                float o[8];
#pragma unroll
                for (int n = 0; n < 2; ++n) { const f32x4 a = acc[ai][0][m][n] + ba[n], b = acc[ai][1][m][n] + bb[n];
#pragma unroll
                    for (int j = 0; j < 4; ++j) {
                        if (MODE == 0) o[4 * n + j] = a[j] * sigm(b[j]);
                        else { const float g = fminf(a[j], 7.f), up = fminf(fmaxf(b[j], -7.f), 7.f); o[4 * n + j] = (up + 1.f) * g * sigm(1.702f * g); } } }
                v4u w; w.x = cvt_pk_bf16(o[0], o[1]); w.y = cvt_pk_bf16(o[2], o[3]); w.z = cvt_pk_bf16(o[4], o[5]); w.w = cvt_pk_bf16(o[6], o[7]);
                *(v4u*)rowp = w; }
    }
};
struct EpiMerge {
    static constexpr bool PERM = true;
    bf16* mtmp; bf16* Mo; const bf16* zg;
    __device__ __forceinline__ void operator()(const f32x4 (&acc)[2][2][4][2], const Unit& u, int wr, int wc, int fr, int fq) const {
        const int row0 = u.pm * BM + wr * 64 + fr, col0 = u.pn * BM + wc * 32 + 8 * fq;
#pragma unroll
        for (int ai = 0; ai < 2; ++ai)
#pragma unroll
            for (int m = 0; m < 4; ++m) { const size_t r = (size_t)(row0 + ai * HALF + m * 16);
#pragma unroll
                for (int bj = 0; bj < 2; ++bj) { const int c = col0 + bj * HALF;
                    const v4u gz = *(const v4u*)(zg + r * IN_COLS + u.e * 1024 + c);
                    float g[8] = {bflo(gz.x), bfhi(gz.x), bflo(gz.y), bfhi(gz.y), bflo(gz.z), bfhi(gz.z), bflo(gz.w), bfhi(gz.w)};
                    f32x4 t0, t1; bf16* tp = mtmp + r * 1024 + c;
                    if (u.e == 0) { t0 = (f32x4){0.f, 0.f, 0.f, 0.f}; t1 = t0; } else { const v4u pv = *(const v4u*)tp; t0 = (f32x4){bflo(pv.x), bfhi(pv.x), bflo(pv.y), bfhi(pv.y)}; t1 = (f32x4){bflo(pv.z), bfhi(pv.z), bflo(pv.w), bfhi(pv.w)}; }
#pragma unroll
                    for (int j = 0; j < 4; ++j) { t0[j] += sigm(g[j]) * acc[ai][bj][m][0][j]; t1[j] += sigm(g[4 + j]) * acc[ai][bj][m][1][j]; }
                    if (u.e < 2) { v4u w; w.x = cvt_pk_bf16(t0[0], t0[1]); w.y = cvt_pk_bf16(t0[2], t0[3]); w.z = cvt_pk_bf16(t1[0], t1[1]); w.w = cvt_pk_bf16(t1[2], t1[3]); *(v4u*)tp = w; }
                    else { v4u w; w.x = cvt_pk_bf16(t0[0], t0[1]); w.y = cvt_pk_bf16(t0[2], t0[3]); w.z = cvt_pk_bf16(t1[0], t1[1]); w.w = cvt_pk_bf16(t1[2], t1[3]);
                        *(v4u*)(Mo + r * 1024 + c) = w; } } }
    }
};
struct EpiResid {
    static constexpr bool PERM = false;
    float* X; const float* gmod;
    __device__ __forceinline__ void operator()(const f32x4 (&acc)[2][2][4][2], const Unit& u, int wr, int wc, int fr, int fq) const {
        const int row0 = u.pm * BM + wr * 64 + fr, col0 = u.pn * BM + wc * 32 + 4 * fq;
        const int r00 = u.pm * BM; const int w = r00 < T_LAT ? (r00 >> 12) : 8;
        f32x4 gv[2][2];
#pragma unroll
        for (int bj = 0; bj < 2; ++bj)
#pragma unroll
            for (int n = 0; n < 2; ++n) gv[bj][n] = *(const f32x4*)(gmod + (size_t)w * 6144 + col0 + bj * HALF + n * 16);
#pragma unroll
        for (int ai = 0; ai < 2; ++ai)
#pragma unroll
            for (int m = 0; m < 4; ++m) { float* rowp = X + (size_t)(row0 + ai * HALF + m * 16) * 1024 + col0;
#pragma unroll
                for (int bj = 0; bj < 2; ++bj)
#pragma unroll
                    for (int n = 0; n < 2; ++n) { f32x4* p = (f32x4*)(rowp + bj * HALF + n * 16); *p = *p + gv[bj][n] * acc[ai][bj][m][n]; } }
    }
};
}

struct Args { const float* in[51]; float* out; unsigned char* ws; int ph_lo, ph_hi; };
enum { I_X = 0, I_C, I_CTX, I_CCTX, I_ADAW, I_ADAB, I_N1G, I_N2G, I_WIN, I_HYCW, I_HYCB, I_HYW1, I_HYB1, I_HYF1, I_HYW2, I_HYB2, I_HYF2, I_HYW3, I_HYB3, I_HYBIAS,
       I_RWCW, I_RWCB, I_RWWUP, I_RWW0, I_RWAUP, I_RWA0, I_RWGUP, I_RWKK, I_RWKA, I_RWRK, I_RWLNG, I_RWLNB, I_S5ARE, I_S5AIM, I_S5LDT, I_S5BRE, I_S5BIM, I_S5CRE, I_S5CIM, I_S5D,
       I_S5GLUW, I_S5GLUB, I_WBR, I_WOUT, I_RTW, I_RTB, I_W1, I_B1, I_W2, I_B2, I_FING };

typedef const __attribute__((address_space(4))) Args* CArgsP;
__device__ __forceinline__ CArgsP kargs() { CArgsP p = (CArgsP)__builtin_amdgcn_kernarg_segment_ptr(); asm volatile("" : "+s"(p)); return p; }
__device__ __forceinline__ int opaque(int v) { asm volatile("" : "+s"(v)); return v; }
__device__ __forceinline__ int opaque_v(int v) { asm volatile("" : "+v"(v)); return v; }
struct Ctx { CArgsP a; LAS unsigned char* lds; int tid, lane, wave, bid, G; };

__device__ __forceinline__ void row_seq(int row, int& base, int& pos, int& n) {
    if (row < T_LAT) { base = row & ~(SEQ - 1); pos = row & (SEQ - 1); n = SEQ; }
    else { const int r = row - T_LAT; base = T_LAT + (r & ~(CTXL - 1)); pos = r & (CTXL - 1); n = CTXL; }
}
__device__ __forceinline__ float conv3z(const bf16* zc, int pos, int n, float w0, float w1, float w2, float b) {
    const float zm = pos > 0 ? bf2f(zc[(size_t)(pos - 1) * IN_COLS]) : 0.f, z0 = bf2f(zc[(size_t)pos * IN_COLS]), zp = pos < n - 1 ? bf2f(zc[(size_t)(pos + 1) * IN_COLS]) : 0.f;
    return zm * w0 + z0 * w1 + zp * w2 + b;
}

template <int MODE>
__device__ __forceinline__ void transpose_item(const float* W, int K, int N, bf16* WT, int Hs, LAS float* scr, int item, int lane) {
    const int nblk = N / 32, kb = item / nblk, nb = item % nblk, k0 = 64 * kb, n0 = 32 * nb;
#pragma unroll 8
    for (int i = 0; i < 32; ++i) { const int kk = 2 * i + (lane >> 5); scr[kk * 33 + (lane & 31)] = W[(size_t)(k0 + kk) * N + n0 + (lane & 31)]; }
    LDS_WAIT(); asm volatile("" ::: "memory");
    const int c = lane & 7;
#pragma unroll
    for (int j = 0; j < 4; ++j) { const int n = (lane >> 3) + 8 * j; const LAS float* s = scr + (8 * c) * 33 + n;
        v4u o; o.x = pk2(s[0 * 33], s[1 * 33]); o.y = pk2(s[2 * 33], s[3 * 33]); o.z = pk2(s[4 * 33], s[5 * 33]); o.w = pk2(s[6 * 33], s[7 * 33]);
        int dr = n0 + n;
        if (MODE == 1) { const int nc = n0 + n; const int jx = nc < Hs ? nc : nc - Hs; dr = (jx >> 7) * 256 + (nc < Hs ? 0 : 128) + (jx & 127); }
        *(v4u*)(WT + (size_t)dr * K + k0 + 8 * c) = o; }
    LDS_WAIT(); asm volatile("" ::: "memory");
}

__device__ __forceinline__ void p0_prologue(const Ctx& F) {
    const auto& a = *F.a; unsigned char* ws = a.ws;
    const int gw = F.bid * NWAVES + F.wave, NGW = F.G * NWAVES, lane = F.lane;
    float* X = (float*)(ws + WS_X);
    for (int t = gw; t < SEQ; t += NGW) {
        const float pr = (float)(t >> 6), pc = (float)(t & 63);
        f32x4 pe[4];
#pragma unroll
        for (int j = 0; j < 4; ++j)
#pragma unroll
            for (int e = 0; e < 4; ++e) { const float om = __builtin_amdgcn_exp2f((float)(4 * lane + e) * (-13.287712379549449f / 256.0f)); const float ang = ((j < 2) ? pr : pc) * om; pe[j][e] = (j & 1) ? __cosf(ang) : __sinf(ang); }
#pragma unroll 2
        for (int bb = 0; bb < BATCH; ++bb) { const size_t row = (size_t)bb * SEQ + t;
            const f32x4* xi = (const f32x4*)(a.in[I_X] + row * D) + lane; f32x4* xo = (f32x4*)(X + row * D) + lane;
#pragma unroll
            for (int j = 0; j < 4; ++j) xo[64 * j] = xi[64 * j] + pe[j]; }
    }
    for (int row = T_LAT + gw; row < T_ALL; row += NGW) {
        const f32x4* xi = (const f32x4*)(a.in[I_CTX] + (size_t)(row - T_LAT) * D) + lane; f32x4* xo = (f32x4*)(X + (size_t)row * D) + lane;
#pragma unroll
        for (int j = 0; j < 4; ++j) xo[64 * j] = xi[64 * j];
    }
    {
        LAS float* condl = (LAS float*)F.lds; LAS float* psum = (LAS float*)(F.lds + 40960);
        for (int i = F.tid; i < 9 * 1024; i += NTHREADS) { const int w = i >> 10, k = i & 1023; const float cv = (w < 8) ? a.in[I_C][w * 1024 + k] : a.in[I_CCTX][k]; condl[i] = cv / (1.f + expf(-cv)); }
        __syncthreads();
        float* MOD = (float*)(ws + WS_MOD);
        for (int it = F.bid; it < 2 * 96; it += F.G) {
            const int l = it / 96, cg = it % 96, col = cg * 64 + lane;
            float acc[9];
#pragma unroll
            for (int w = 0; w < 9; ++w) acc[w] = 0.f;
            const float* wp = a.in[I_ADAW] + ((size_t)l * 1024 + F.wave * 128) * 6144 + col;
#pragma unroll 1
            for (int k0 = 0; k0 < 128; k0 += 16) { float wv[16];
#pragma unroll
                for (int k = 0; k < 16; ++k) wv[k] = wp[(size_t)(k0 + k) * 6144];
#pragma unroll
                for (int k = 0; k < 16; ++k)
#pragma unroll
                    for (int w = 0; w < 9; ++w) acc[w] += condl[w * 1024 + F.wave * 128 + k0 + k] * wv[k]; }
#pragma unroll
            for (int w = 0; w < 9; ++w) psum[(F.wave * 9 + w) * 64 + lane] = acc[w];
            __syncthreads();
            if (F.wave == 0) {
#pragma unroll
                for (int w = 0; w < 9; ++w) { float s = 0.f;
#pragma unroll
                    for (int wv = 0; wv < 8; ++wv) s += psum[(wv * 9 + w) * 64 + lane];
                    MOD[(size_t)(l * 9 + w) * 6144 + col] = s + a.in[I_ADAB][l * 6144 + col]; }
            }
            __syncthreads();
        }
    }
    {
        LAS float* scr = (LAS float*)(F.lds + F.wave * 16384);
        constexpr int IT_W1 = 16 * 64, IT_W2 = 16 * 32, IT_WIN = 16 * 216, IT_GLU = 8 * 32, IT_WBR = 8 * 32, IT_WOUT = 16 * 32;
        constexpr int N_W1 = 64 * IT_W1, N_W2 = 64 * IT_W2, N_WIN = 2 * IT_WIN, N_GLU = 2 * IT_GLU, N_WBR = 6 * IT_WBR, N_WOUT = 2 * IT_WOUT;
        constexpr int NITEMS = N_W1 + N_W2 + N_WIN + N_GLU + N_WBR + N_WOUT;
        for (int it = gw; it < NITEMS; it += NGW) {
            int r = it;
            if (r < N_W1) { const int mtx = r / IT_W1, l = mtx >> 5, e = mtx & 31; transpose_item<1>(a.in[I_W1] + (size_t)mtx * 1024 * 2048, 1024, 2048, (bf16*)(ws + WS_WTS + l * WL_STRIDE + WO_W1) + (size_t)e * 2048 * 1024, 1024, scr, r % IT_W1, lane); continue; } r -= N_W1;
            if (r < N_W2) { const int mtx = r / IT_W2, l = mtx >> 5, e = mtx & 31; transpose_item<0>(a.in[I_W2] + (size_t)mtx * 1024 * 1024, 1024, 1024, (bf16*)(ws + WS_WTS + l * WL_STRIDE + WO_W2) + (size_t)e * 1024 * 1024, 0, scr, r % IT_W2, lane); continue; } r -= N_W2;
            if (r < N_WIN) { const int l = r / IT_WIN; transpose_item<0>(a.in[I_WIN] + (size_t)l * 1024 * IN_COLS, 1024, IN_COLS, (bf16*)(ws + WS_WTS + l * WL_STRIDE + WO_WIN), 0, scr, r % IT_WIN, lane); continue; } r -= N_WIN;
            if (r < N_GLU) { const int l = r / IT_GLU; transpose_item<1>(a.in[I_S5GLUW] + (size_t)l * 512 * 1024, 512, 1024, (bf16*)(ws + WS_WTS + l * WL_STRIDE + WO_GLU), 512, scr, r % IT_GLU, lane); continue; } r -= N_GLU;
            if (r < N_WBR) { const int mtx = r / IT_WBR, l = mtx / 3, br = mtx % 3; transpose_item<0>(a.in[I_WBR] + (size_t)mtx * 512 * 1024, 512, 1024, (bf16*)(ws + WS_WTS + l * WL_STRIDE + WO_WBR) + (size_t)br * 1024 * 512, 0, scr, r % IT_WBR, lane); continue; } r -= N_WBR;
            { const int l = r / IT_WOUT; transpose_item<0>(a.in[I_WOUT] + (size_t)l * 1024 * 1024, 1024, 1024, (bf16*)(ws + WS_WTS + l * WL_STRIDE + WO_WOUT), 0, scr, r % IT_WOUT, lane); }
        }
        for (int i = F.bid * NTHREADS + F.tid; i < 2 * 2560 * 256; i += F.G * NTHREADS) {
            const int l = i / (2560 * 256), r = i % (2560 * 256), n = r >> 8, k = r & 255; float v = 0.f;
            if (n < 1024) { if (k < 64) v = a.in[I_RWWUP][(((size_t)l * 2 + (n >> 9)) * 64 + k) * 512 + (n & 511)]; }
            else if (n < 2048) { if (k >= 64 && k < 128) v = a.in[I_RWAUP][(((size_t)l * 2 + ((n - 1024) >> 9)) * 64 + (k - 64)) * 512 + (n & 511)]; }
            else { if (k >= 128) v = a.in[I_RWGUP][((size_t)l * 128 + (k - 128)) * 512 + (n - 2048)]; }
            ((bf16*)(ws + WS_WTS + l * WL_STRIDE + WO_RWCAT))[r] = (bf16)f2bf(v);
        }
    }
    __syncthreads();
    {
        LAS float* feats = (LAS float*)F.lds; LAS float* h1 = feats + 8 * 33; LAS float* h2 = h1 + 8 * 64;
        constexpr int NIT = 2 * (512 + 32);
        for (int it = F.bid; it < NIT; it += F.G) {
            const int l = it / 544, r = it % 544, nsel = r >= 512, n = nsel ? CTXL : SEQ, p0 = (nsel ? r - 512 : r) * 8;
            if (F.tid < 8 * 33) { const int p = F.tid / 33, i = F.tid % 33, pos = p0 + p; float f;
                if (i == 0) f = (float)pos / (float)(n - 1);
                else { const int k = (i - 1) & 15; const float band = 1e-4f + (float)k * ((15.0f - 1e-4f) / 15.0f); const float ang = (6.283185307179586f * (float)pos / (float)n) * band; f = (i <= 16) ? cosf(ang) : -sinf(ang); }
                feats[p * 33 + i] = f; }
            __syncthreads();
            { const int p = F.tid >> 6, j = F.tid & 63; float s = a.in[I_HYB1][l * 64 + j]; const float* w1p = a.in[I_HYW1] + (size_t)l * 33 * 64 + j;
#pragma unroll
                for (int i = 0; i < 33; ++i) s += feats[p * 33 + i] * w1p[i * 64];
                h1[p * 64 + j] = sinf(a.in[I_HYF1][l * 64 + j] * s); }
            __syncthreads();
            { const int p = F.tid >> 6, j = F.tid & 63; float s = a.in[I_HYB2][l * 64 + j];
                const float* w2p = a.in[I_HYW2] + (size_t)l * 64 * 64 + j;
#pragma unroll 16
                for (int i = 0; i < 64; ++i) s += h1[p * 64 + i] * w2p[i * 64];
                h2[p * 64 + j] = sinf(a.in[I_HYF2][l * 64 + j] * s); }
            __syncthreads();
            float acc[4][8];
#pragma unroll
            for (int q = 0; q < 4; ++q)
#pragma unroll
                for (int p = 0; p < 8; ++p) acc[q][p] = 0.f;
            const float* w3 = a.in[I_HYW3] + (size_t)l * 64 * 2048 + F.tid;
#pragma unroll 8
            for (int i = 0; i < 64; ++i) { float wv[4];
#pragma unroll
                for (int q = 0; q < 4; ++q) wv[q] = w3[(size_t)i * 2048 + q * 512];
#pragma unroll
                for (int p = 0; p < 8; ++p) { const float hv = h2[p * 64 + i];
#pragma unroll
                    for (int q = 0; q < 4; ++q) acc[q][p] += hv * wv[q]; } }
            const int c = F.tid; const float dstart = logf(0.01f) / 1.5f, dstop = logf(0.01f) / 0.3f; const float delta = fabsf(dstart + (float)c * ((dstop - dstart) / 511.0f));
            const int RL = nsel ? HY_RLENC : HY_RLEN, off = n + 47; const float rn1 = 1.0f / (float)(n - 1);
            bf16* Rb = (bf16*)(ws + WS_GF + l * GF_STRIDE + (nsel ? GF_CTX : 0));
#pragma unroll
            for (int q = 0; q < 4; ++q) { const int o = q >> 1, side = q & 1; const float b3 = a.in[I_HYB3][l * 2048 + q * 512 + c];
                bf16* Rc = Rb + ((size_t)o * 512 + c) * RL;
#pragma unroll
                for (int p = 0; p < 8; ++p) { const int pos = p0 + p; const float t = (float)pos * rn1; const float val = (acc[q][p] + b3) * __expf(-t * delta);
                    if (side == 0) Rc[off - pos] = (bf16)f2bf(val);
                    else if (pos >= 1) Rc[off + pos] = (bf16)f2bf(val); }
                if (p0 == 0 && side == 0) { for (int m = 0; m < 48; ++m) Rc[m] = 0; for (int m = off + n; m < RL; ++m) Rc[m] = 0; } }
            __syncthreads();
        }
    }
}

__device__ __forceinline__ void stage_norm1(const Ctx& F, int l) {
    const auto& a = *F.a; unsigned char* ws = a.ws; const int lane = F.lane;
    const int gw = F.bid * NWAVES + F.wave, NGW = F.G * NWAVES;
    float* X = (float*)(ws + WS_X); bf16* H = (bf16*)(ws + WS_H); const float* MOD = (const float*)(ws + WS_MOD);
    const bf16* YS = (const bf16*)(ws + WS_XS); const int* POS = (const int*)(ws + WS_POS); const float* GATE = (const float*)(ws + WS_GATE);
    const int nrows = (l == DEPTH) ? T_LAT : T_ALL;
    f32x4 ngv[4];
    { const f32x4* ngp = (l == DEPTH) ? (const f32x4*)a.in[I_FING] + lane : (const f32x4*)(a.in[I_N1G] + l * D) + lane;
#pragma unroll
      for (int j = 0; j < 4; ++j) ngv[j] = ngp[64 * j]; }
    f32x4 vn[4]; v2u ysn[4][4]; int4 pnn = make_int4(0, 0, 0, 0); f32x4 gn = (f32x4){0.f, 0.f, 0.f, 0.f}, gnn = gn;
#pragma unroll
    for (int k = 0; k < 4; ++k)
#pragma unroll
        for (int j = 0; j < 4; ++j) ysn[k][j] = (v2u){0u, 0u};
#define N1_LDYS(p4_) do { const int pk_[4] = {(p4_).x, (p4_).y, (p4_).z, (p4_).w}; _Pragma("unroll") for (int k = 0; k < 4; ++k) { const v2u* yr_ = (const v2u*)(YS + (size_t)pk_[k] * D) + lane; \
        _Pragma("unroll") for (int j = 0; j < 4; ++j) ysn[k][j] = yr_[64 * j]; } } while (0)
    if (gw < nrows) {
#pragma unroll
        for (int j = 0; j < 4; ++j) vn[j] = ((const f32x4*)(X + (size_t)gw * D) + lane)[64 * j];
        if (l > 0) { const int4 p0 = *(const int4*)(POS + gw * 4); gn = *(const f32x4*)(GATE + gw * 4);
            if (gw + NGW < nrows) { pnn = *(const int4*)(POS + (gw + NGW) * 4); gnn = *(const f32x4*)(GATE + (gw + NGW) * 4); }
            N1_LDYS(p0); } }
#pragma unroll 1
    for (int row = gw; row < nrows; row += NGW) {
        const int w = row < T_LAT ? (row >> 12) : 8;
        f32x4* xr = (f32x4*)(X + (size_t)row * D) + lane;
        f32x4 v[4]; v2u ysc[4][4];
#pragma unroll
        for (int j = 0; j < 4; ++j) v[j] = vn[j];
#pragma unroll
        for (int k = 0; k < 4; ++k)
#pragma unroll
            for (int j = 0; j < 4; ++j) ysc[k][j] = ysn[k][j];
        const f32x4 gc = gn; const int4 pnx = pnn; gn = gnn;
        const int rn = row + NGW, rnn = row + 2 * NGW;
        if (rn < nrows) {
#pragma unroll
            for (int j = 0; j < 4; ++j) vn[j] = ((const f32x4*)(X + (size_t)rn * D) + lane)[64 * j];
            if (l > 0) N1_LDYS(pnx); }
        if (l > 0 && rnn < nrows) { pnn = *(const int4*)(POS + rnn * 4); gnn = *(const f32x4*)(GATE + rnn * 4); }
        f32x4 m0[4], m1[4], m2[4];
        if (l < DEPTH) {
#pragma unroll
            for (int j = 0; j < 4; ++j) { m0[j] = ((const f32x4*)(MOD + (size_t)(l * 9 + w) * 6144) + lane)[64 * j]; m1[j] = ((const f32x4*)(MOD + (size_t)(l * 9 + w) * 6144 + 1024) + lane)[64 * j]; } }
        if (l > 0) {
#pragma unroll
            for (int j = 0; j < 4; ++j) m2[j] = ((const f32x4*)(MOD + (size_t)((l - 1) * 9 + w) * 6144 + 5120) + lane)[64 * j];
            f32x4 mo[4];
#pragma unroll
            for (int j = 0; j < 4; ++j) mo[j] = (f32x4){0.f, 0.f, 0.f, 0.f};
#pragma unroll
            for (int k = 0; k < TOPK; ++k) { const float g = gc[k];
#pragma unroll
                for (int j = 0; j < 4; ++j) { const v2u y = ysc[k][j]; mo[j][0] += g * bflo(y.x); mo[j][1] += g * bfhi(y.x); mo[j][2] += g * bflo(y.y); mo[j][3] += g * bfhi(y.y); } }
#pragma unroll
            for (int j = 0; j < 4; ++j) { v[j] = v[j] + m2[j] * mo[j]; xr[64 * j] = v[j]; }
        }
        float ss = 0.f;
#pragma unroll
        for (int j = 0; j < 4; ++j) ss += (v[j][0] * v[j][0] + v[j][1] * v[j][1]) + (v[j][2] * v[j][2] + v[j][3] * v[j][3]);
        const float rstd = __builtin_amdgcn_rsqf(wave_sum(ss) * (1.f / D) + 1e-6f);
        if (l == DEPTH) {
            f32x4* o = (f32x4*)(a.out + (size_t)row * D) + lane;
#pragma unroll
            for (int j = 0; j < 4; ++j) o[64 * j] = v[j] * rstd * ngv[j];
        } else {
            v2u* ho = (v2u*)(H + (size_t)row * D) + lane;
#pragma unroll
            for (int j = 0; j < 4; ++j) { const f32x4 h = v[j] * rstd * ngv[j] * (m1[j] + 1.0f) + m0[j]; v2u o; o.x = pk2(h[0], h[1]); o.y = pk2(h[2], h[3]); ho[64 * j] = o; }
        }
    }
#undef N1_LDYS
}

__device__ __forceinline__ void stage_rw_prep1(const Ctx& F, int l) {
    const auto& a = *F.a; unsigned char* ws = a.ws;
    const bf16* __restrict__ Z = (const bf16*)(ws + WS_Z); bf16* __restrict__ ARW = (bf16*)(ws + WS_ARW);
    const int j = 4 * (F.tid & 63), col = 1536 + j, rq = F.tid >> 6;
    const float* cw = a.in[I_RWCW] + (size_t)l * 3 * 1792;
    const f32x4 w0 = *(const f32x4*)(cw + col), w1 = *(const f32x4*)(cw + 1792 + col), w2 = *(const f32x4*)(cw + 2 * 1792 + col), cb = *(const f32x4*)(a.in[I_RWCB] + l * 1792 + col);
#pragma unroll 4
    for (int row = F.bid * 8 + rq; row < T_ALL; row += F.G * 8) {
        int base, pos, n; row_seq(row, base, pos, n);
        const bf16* zc = Z + (size_t)row * IN_COLS + RW_OFF + col;
        const v2u z0 = *(const v2u*)zc;
        v2u zm = (v2u){0u, 0u}, zp = (v2u){0u, 0u};
        if (pos > 0) zm = *(const v2u*)(zc - IN_COLS);
        if (pos < n - 1) zp = *(const v2u*)(zc + IN_COLS);
        f32x4 v = (f32x4){bflo(zm.x), bfhi(zm.x), bflo(zm.y), bfhi(zm.y)} * w0 + (f32x4){bflo(z0.x), bfhi(z0.x), bflo(z0.y), bfhi(z0.y)} * w1 + (f32x4){bflo(zp.x), bfhi(zp.x), bflo(zp.y), bfhi(zp.y)} * w2 + cb;
#pragma unroll
        for (int e2 = 0; e2 < 4; ++e2) { if (j < 64) v[e2] = tanh_fast(v[e2]); else if (j >= 128) v[e2] = sigm(v[e2]); }
        v2u o; o.x = pk2(v[0], v[1]); o.y = pk2(v[2], v[3]);
        *(v2u*)(ARW + (size_t)row * 256 + j) = o;
    }
}

__device__ __forceinline__ void stage_rw_prep2(const Ctx& F, int l) {
    const auto& a = *F.a; unsigned char* ws = a.ws; const int lane = F.lane;
    const bf16* Z = (const bf16*)(ws + WS_Z); const bf16* P = (const bf16*)(ws + WS_P); bf16* SCN = (bf16*)(ws + WS_SCN);
    const int gw = F.bid * NWAVES + F.wave, NGW = F.G * NWAVES;
    constexpr int TR = 17, NRT = T_ALL / TR;
    const float* cw = a.in[I_RWCW] + (size_t)l * 3 * 1792; const float* cbp = a.in[I_RWCB] + l * 1792;
    for (int tile = gw; tile < NRT * 4; tile += NGW) {
        const int rt = tile % NRT, hp = tile / NRT, row0 = rt * TR, c0 = hp * 128 + 2 * lane;
        f32x2 w[3][3], cb[3];
#pragma unroll
        for (int s = 0; s < 3; ++s) { cb[s] = *(const f32x2*)(cbp + s * 512 + c0);
#pragma unroll
            for (int j = 0; j < 3; ++j) w[s][j] = *(const f32x2*)(cw + j * 1792 + s * 512 + c0); }
        const f32x2 KKw = *(const f32x2*)(a.in[I_RWKK] + l * 512 + c0), KAw = *(const f32x2*)(a.in[I_RWKA] + l * 512 + c0);
        f32x2 W0[2], A0[2];
#pragma unroll
        for (int d = 0; d < 2; ++d) { W0[d] = *(const f32x2*)(a.in[I_RWW0] + (l * 2 + d) * 512 + c0); A0[d] = *(const f32x2*)(a.in[I_RWA0] + (l * 2 + d) * 512 + c0); }
        const unsigned* zb = (const unsigned*)(Z + RW_OFF + c0);
        unsigned zw[8][3], pw_[8][4];
#define P2_LDZ(j_) do { const int rr_ = row0 + (j_); if (rr_ >= 0 && rr_ < T_ALL) { _Pragma("unroll") for (int s = 0; s < 3; ++s) zw[((j_) + 1) & 7][s] = zb[(size_t)rr_ * (IN_COLS / 2) + s * 256]; } \
        else { _Pragma("unroll") for (int s = 0; s < 3; ++s) zw[((j_) + 1) & 7][s] = 0u; } } while (0)
#define P2_LDP(j_) do { const unsigned* pr_ = (const unsigned*)(P + (size_t)(row0 + (j_)) * 2560 + c0); pw_[(j_) & 7][0] = pr_[0]; pw_[(j_) & 7][1] = pr_[512]; pw_[(j_) & 7][2] = pr_[256]; pw_[(j_) & 7][3] = pr_[768]; } while (0)
        P2_LDZ(-1); P2_LDZ(0); P2_LDZ(1); P2_LDZ(2); P2_LDZ(3); P2_LDP(0); P2_LDP(1); P2_LDP(2);
#pragma unroll
        for (int i = 0; i < TR; ++i) {
            const int row = row0 + i; int base, pos, n; row_seq(row, base, pos, n);
            if (i + 4 <= TR) P2_LDZ(i + 4);
            if (i + 3 < TR) P2_LDP(i + 3);
            unsigned zm[3], z0[3], zp[3], pc_[4];
#pragma unroll
            for (int s = 0; s < 3; ++s) { zm[s] = zw[i & 7][s]; z0[s] = zw[(i + 1) & 7][s]; zp[s] = zw[(i + 2) & 7][s]; }
#pragma unroll
            for (int e = 0; e < 4; ++e) pc_[e] = pw_[i & 7][e];
            const float mlo = pos > 0 ? 1.f : 0.f, mhi = pos < n - 1 ? 1.f : 0.f;
            f32x2 u[3];
#pragma unroll
            for (int s = 0; s < 3; ++s) u[s] = (f32x2){bflo(zm[s]), bfhi(zm[s])} * mlo * w[s][0] + (f32x2){bflo(z0[s]), bfhi(z0[s])} * w[s][1] + (f32x2){bflo(zp[s]), bfhi(zp[s])} * mhi * w[s][2] + cb[s];
            const f32x2 r = u[0], k = u[1], v = u[2];
            f32x2 kk = k * KKw;
            const float ss = red32(kk[0] * kk[0] + kk[1] * kk[1]);
            kk = kk * (__builtin_amdgcn_rsqf(fmaxf(ss, 1e-24f)));
            unsigned* o = (unsigned*)(SCN + (size_t)row * 9 * 512 + c0);
            o[0] = pk2(r[0], r[1]); o[256] = pk2(v[0], v[1]); o[2 * 256] = pk2(kk[0], kk[1]);
#pragma unroll
            for (int d = 0; d < 2; ++d) {
                const unsigned pw = pc_[2 * d], pa = pc_[2 * d + 1];
                float ld[2], kd[2], be[2];
#pragma unroll
                for (int e = 0; e < 2; ++e) {
                    const float uu = W0[d][e] + (e ? bfhi(pw) : bflo(pw));
                    ld[e] = -0.60653065971263342f * sigm(uu);
                    const float av = sigm(A0[d][e] + (e ? bfhi(pa) : bflo(pa)));
                    kd[e] = k[e] * (1.f + (av - 1.f) * KAw[e]); be[e] = kk[e] * av; }
                o[(3 + 3 * d) * 256] = pk2(ld[0], ld[1]); o[(4 + 3 * d) * 256] = pk2(kd[0], kd[1]); o[(5 + 3 * d) * 256] = pk2(be[0], be[1]);
            }
        }
    }
}
#undef P2_LDZ
#undef P2_LDP

__device__ __forceinline__ int seq_row(int b, int d, int sidx) {
    if (sidx < CTXL) { const int t = d ? (CTXL - 1 - sidx) : sidx; return T_LAT + b * CTXL + t; }
    const int tl = sidx - CTXL; const int t = d ? (SEQ - 1 - tl) : tl; return b * SEQ + t;
}

constexpr int CW_WORK = 16384;
constexpr int CW_STAMP = 20480;
#ifdef PROBE_T
#ifndef PROBE_BID
#define PROBE_BID 0
#endif
#define PT(k) do { if (F.bid == PROBE_BID && F.tid == 0 && l == 0) ((unsigned long long*)(F.a->ws + WS_CTL + CW_STAMP * 4))[k] = __builtin_amdgcn_s_memrealtime(); } while (0)
#else
#define PT(k) do { } while (0)
#endif
__device__ __forceinline__ void rw_scan_item(const Ctx& F, int l, int it2) {
    const int it = it2 >> 1, half = it2 & 1;
    const auto& a = *F.a; unsigned char* ws = a.ws; const int tid = F.tid, lane = F.lane;
    const bf16* SCN = (const bf16*)(ws + WS_SCN); float* YD = (float*)(ws + WS_YDIR);
    LAS float* sbuf = (LAS float*)F.lds;
    LAS float* ybuf = (LAS float*)(F.lds + 49152);
    const bool comp = F.wave < 4;
    const int lt = tid & 255, ls = lt >> 4, lj = lt & 15;
    const int vl = lane >> 3, kq = lane & 7, vrow = half * 32 + (F.wave & 3) * 8 + vl;
    constexpr int NCH = (CTXL + SEQ) / 16;
    const int d = it & 1, h = (it >> 1) & 7, b = it >> 4;
    f32x2 S[4];
#pragma unroll
    for (int q = 0; q < 4; ++q) S[q] = (f32x2){0.f, 0.f};
    v2u ldr[6];
#define RW_ISSUE(c) do { const int row_ = seq_row(b, d, (c) * 16 + ls); const v2u* p_ = (const v2u*)(SCN + (size_t)row_ * 9 * 512 + h * 64) + lj; \
        ldr[0] = p_[2 * 128]; ldr[1] = p_[(3 + 3 * d) * 128]; ldr[2] = p_[(5 + 3 * d) * 128]; ldr[3] = p_[(4 + 3 * d) * 128]; ldr[4] = p_[0]; ldr[5] = p_[128]; } while (0)
#define RW_WRITE(bufi) do { LAS float* o_ = sbuf + (((bufi) * 16 + ls) * 6) * 64 + 4 * lj; \
        *(LAS f32x4*)(o_) = (f32x4){-bflo(ldr[0].x), -bfhi(ldr[0].x), -bflo(ldr[0].y), -bfhi(ldr[0].y)}; \
        *(LAS f32x4*)(o_ + 64) = (f32x4){__expf(bflo(ldr[1].x)), __expf(bfhi(ldr[1].x)), __expf(bflo(ldr[1].y)), __expf(bfhi(ldr[1].y))}; \
        *(LAS f32x4*)(o_ + 128) = (f32x4){bflo(ldr[2].x), bfhi(ldr[2].x), bflo(ldr[2].y), bfhi(ldr[2].y)}; *(LAS f32x4*)(o_ + 192) = (f32x4){bflo(ldr[3].x), bfhi(ldr[3].x), bflo(ldr[3].y), bfhi(ldr[3].y)}; \
        *(LAS f32x4*)(o_ + 256) = (f32x4){bflo(ldr[4].x), bfhi(ldr[4].x), bflo(ldr[4].y), bfhi(ldr[4].y)}; *(LAS f32x4*)(o_ + 320) = (f32x4){bflo(ldr[5].x), bfhi(ldr[5].x), bflo(ldr[5].y), bfhi(ldr[5].y)}; } while (0)
#define RW_FLUSH(c) do { const int row_ = seq_row(b, d, (c) * 16 + ls); \
        *(f32x2*)(YD + ((size_t)d * T_ALL + row_) * 512 + h * 64 + half * 32 + 2 * lj) = *(const LAS f32x2*)(ybuf + ((((c) & 1) * 16 + ls) * 64) + half * 32 + 2 * lj); } while (0)
    if (!comp) { RW_ISSUE(0); RW_WRITE(0); RW_ISSUE(1); }
    __syncthreads();
#pragma unroll 1
    for (int c = 0; c < NCH; ++c) {
        const int bi = c & 1;
        if (!comp) {
            if (c + 1 < NCH) RW_WRITE(bi ^ 1);
            if (c + 2 < NCH) RW_ISSUE(c + 2);
            if (c > 0) RW_FLUSH(c - 1);
        } else {
        float yv[16];
        f32x4 opA[10], opB[10]; float vvA, vvB;
#define RW_LD(op, vvx, s_) do { const LAS float* sp_ = sbuf + ((bi * 16 + (s_)) * 6) * 64 + 8 * kq; \
            _Pragma("unroll") for (int q_ = 0; q_ < 5; ++q_) { op[2 * q_] = *(const LAS f32x4*)(sp_ + 64 * q_); op[2 * q_ + 1] = *(const LAS f32x4*)(sp_ + 64 * q_ + 4); } \
            vvx = sbuf[((bi * 16 + (s_)) * 6 + 5) * 64 + vrow]; } while (0)
#define RW_COMP(op, vvx, s_) do { \
            const f32x4 a0 = op[0], a1 = op[1], w0 = op[2], w1 = op[3], b0 = op[4], b1 = op[5], k0 = op[6], k1 = op[7], r0 = op[8], r1 = op[9]; \
            const f32x2 vv2 = (f32x2){vvx, vvx}; \
            const f32x2 p0 = S[1] * (f32x2){a0[2], a0[3]} + S[0] * (f32x2){a0[0], a0[1]}; \
            const f32x2 p1 = S[3] * (f32x2){a1[2], a1[3]} + S[2] * (f32x2){a1[0], a1[1]}; \
            const f32x2 t0 = S[0] * (f32x2){w0[0], w0[1]} + vv2 * (f32x2){k0[0], k0[1]}; \
            const f32x2 t1 = S[1] * (f32x2){w0[2], w0[3]} + vv2 * (f32x2){k0[2], k0[3]}; \
            const f32x2 t2 = S[2] * (f32x2){w1[0], w1[1]} + vv2 * (f32x2){k1[0], k1[1]}; \
            const f32x2 t3 = S[3] * (f32x2){w1[2], w1[3]} + vv2 * (f32x2){k1[2], k1[3]}; \
            const f32x2 ac = p0 + p1; \
            const float sa = red8(ac[0] + ac[1]); \
            const f32x2 sa2 = (f32x2){sa, sa}; \
            S[0] = sa2 * (f32x2){b0[0], b0[1]} + t0; S[1] = sa2 * (f32x2){b0[2], b0[3]} + t1; \
            S[2] = sa2 * (f32x2){b1[0], b1[1]} + t2; S[3] = sa2 * (f32x2){b1[2], b1[3]} + t3; \
            const f32x2 q0 = S[1] * (f32x2){r0[2], r0[3]} + S[0] * (f32x2){r0[0], r0[1]}; \
            const f32x2 q1 = S[3] * (f32x2){r1[2], r1[3]} + S[2] * (f32x2){r1[0], r1[1]}; \
            const f32x2 yc = q0 + q1; \
            yv[s_] = red8(yc[0] + yc[1]); } while (0)
        RW_LD(opA, vvA, 0);
#pragma unroll
        for (int s = 0; s < 16; s += 2) {
            RW_LD(opB, vvB, s + 1);
            __builtin_amdgcn_sched_barrier(0);
            RW_COMP(opA, vvA, s);
            __builtin_amdgcn_sched_barrier(0);
            if (s + 2 < 16) RW_LD(opA, vvA, s + 2);
            __builtin_amdgcn_sched_barrier(0);
            RW_COMP(opB, vvB, s + 1);
            __builtin_amdgcn_sched_barrier(0);
        }
#undef RW_LD
#undef RW_COMP
#pragma unroll
        for (int s = 0; s < 16; ++s) if ((s & 7) == kq) ybuf[((bi * 16 + s) * 64) + vrow] = yv[s];
        }
        __syncthreads();
    }
    if (!comp) RW_FLUSH(NCH - 1);
    __syncthreads();
#undef RW_ISSUE
#undef RW_WRITE
#undef RW_FLUSH
}

constexpr size_t WS_RWSCR = WS_YHY;
constexpr int RWS_QY = 0, RWS_YV = 2048, RWS_PZ = 4096, RWS_ZV = 12288, RWS_SLOT = 20480;
typedef __bf16 bf16x8n __attribute__((ext_vector_type(8)));
__device__ __forceinline__ f32x4 mma16(const bf16x8 a, const bf16x8 b, const f32x4 c) { return __builtin_amdgcn_mfma_f32_16x16x32_bf16(a, b, c, 0, 0, 0); }
__device__ __forceinline__ float dpp_shr(float x, const int n) {
    const int v = __builtin_bit_cast(int, x); int r;
    if (n == 1) r = __builtin_amdgcn_update_dpp(0, v, 0x111, 0xF, 0xF, true); else if (n == 2) r = __builtin_amdgcn_update_dpp(0, v, 0x112, 0xF, 0xF, true);
    else if (n == 4) r = __builtin_amdgcn_update_dpp(0, v, 0x114, 0xF, 0xF, true); else r = __builtin_amdgcn_update_dpp(0, v, 0x118, 0xF, 0xF, true);
    return __builtin_bit_cast(float, r);
}
__device__ __forceinline__ v4u pack8(const float (&x)[8]) { v4u o; o.x = pk2(x[0], x[1]); o.y = pk2(x[2], x[3]); o.z = pk2(x[4], x[5]); o.w = pk2(x[6], x[7]); return o; }
__device__ __forceinline__ void unpack8(const v4u u, float (&x)[8]) { x[0] = bflo(u.x); x[1] = bfhi(u.x); x[2] = bflo(u.y); x[3] = bfhi(u.y); x[4] = bflo(u.z); x[5] = bfhi(u.z); x[6] = bflo(u.w); x[7] = bfhi(u.w); }
constexpr int LDS_ZERO16 = 131072 + 3072;
typedef short bf16x4s __attribute__((ext_vector_type(4)));
__device__ __forceinline__ bf16x4s frag16k(const LAS bf16* m, int rowbase, int lane) { return __builtin_bit_cast(bf16x4s, *(const LAS v2u*)(m + (rowbase + (lane & 15)) * 16 + 4 * (lane >> 4))); }
__device__ __forceinline__ f32x4 mma16(const bf16x4s a, const bf16x4s b, const f32x4 c) { return __builtin_amdgcn_mfma_f32_16x16x16bf16_1k(a, b, c, 0, 0, 0); }
#define frag16(m_, rb_, ln_) frag16k(m_, rb_, ln_)
__device__ __forceinline__ void st_colmaj(LAS bf16* m, int colbase, const f32x4 d, int lane) {
    v2u o; o.x = pk2(d[0], d[1]); o.y = pk2(d[2], d[3]); *(LAS v2u*)(m + (colbase + (lane & 15)) * 16 + 4 * (lane >> 4)) = o; }
__device__ __forceinline__ void st_rowmaj(LAS bf16* m, const f32x4 d, int lane) {
#pragma unroll
    for (int r = 0; r < 4; ++r) m[(4 * (lane >> 4) + r) * 16 + (lane & 15)] = (bf16)f2bf(d[r]); }
template <int KS0, int KS1>
__device__ __forceinline__ void rw_chunk_load(const Ctx& F, int b, int h, int d, int cidx, v4u (&raw)[12]) {
    const int lane = opaque_v(F.lane), t = lane & 15, kg = lane >> 4;
    const bf16* base = (const bf16*)(F.a->ws + WS_SCN) + (size_t)seq_row(b, d, 16 * cidx + t) * 9 * 512 + h * 64;
#pragma unroll
    for (int ks = KS0; ks < KS1; ++ks) { const int off = 32 * ks + 8 * kg;
        raw[6 * ks + 0] = *(const v4u*)(base + (3 + 3 * d) * 512 + off); raw[6 * ks + 1] = *(const v4u*)(base + 2 * 512 + off); raw[6 * ks + 2] = *(const v4u*)(base + off);
        raw[6 * ks + 3] = *(const v4u*)(base + (5 + 3 * d) * 512 + off); raw[6 * ks + 4] = *(const v4u*)(base + (4 + 3 * d) * 512 + off); raw[6 * ks + 5] = *(const v4u*)(base + 512 + off); }
}
__device__ __forceinline__ void rw_chunk_task2(const Ctx& F, const v4u (&raw)[12], LAS unsigned char* wl, f32x4 (&yv)[4], f32x4 (&zv)[4][4]) {
    const int lane = opaque_v(F.lane), t = lane & 15, kg = lane >> 4;
    LAS bf16* ATt = (LAS bf16*)(wl); LAS bf16* RBr = (LAS bf16*)(wl + 2048); LAS bf16* BHt = (LAS bf16*)(wl + 4096); LAS bf16* KHt = (LAS bf16*)(wl + 6144); LAS bf16* VTt = (LAS bf16*)(wl + 8192);
    LAS bf16* WAt = (LAS bf16*)(wl + 10240); LAS bf16* N_r = (LAS bf16*)(wl + 12288); LAS bf16* N_c = (LAS bf16*)(wl + 12800); LAS bf16* T_r = (LAS bf16*)(wl + 13312);
    LAS bf16* AK_r = (LAS bf16*)(wl + 13824); LAS bf16* RB2 = (LAS bf16*)(wl + 14336); LAS bf16* RK_r = (LAS bf16*)(wl + 14848); LAS float* GCl = (LAS float*)(wl + 15360);
    bf16x8 fAb[2], fRb[2], fBb[2], fKb[2];
#pragma unroll
    for (int ks = 0; ks < 2; ++ks) {
        const int off = 32 * ks + 8 * kg;
        float ea[8], er[8], eb[8], eh[8];
        { const v4u uld = raw[6 * ks + 0]; float ld[8]; unpack8(uld, ld);
#pragma unroll
          for (int j = 0; j < 8; ++j) { float c = ld[j]; c += dpp_shr(c, 1); c += dpp_shr(c, 2); c += dpp_shr(c, 4); c += dpp_shr(c, 8);
              const float tot = __builtin_bit_cast(float, __builtin_amdgcn_ds_bpermute((lane | 15) << 2, __builtin_bit_cast(int, c)));
              ea[j] = __expf(c - ld[j]); er[j] = __expf(c); eb[j] = __expf(-c); const float et_ = __expf(tot); eh[j] = et_ * eb[j];
              if (t == 0) GCl[off + j] = et_; } }
        { const v4u u = raw[6 * ks + 1]; float x[8]; unpack8(u, x);
#pragma unroll
          for (int j = 0; j < 8; ++j) { x[j] = -x[j] * ea[j]; ATt[(off + j) * 16 + t] = (bf16)f2bf(x[j]); }
          const v4u p = pack8(x); fAb[ks] = __builtin_bit_cast(bf16x8, p); }
        { const v4u u = raw[6 * ks + 2]; float x[8]; unpack8(u, x);
#pragma unroll
          for (int j = 0; j < 8; ++j) x[j] = x[j] * er[j];
          const v4u p = pack8(x); fRb[ks] = __builtin_bit_cast(bf16x8, p); *(LAS v4u*)(RBr + t * 64 + off) = p; }
        { const v4u u = raw[6 * ks + 3]; float x[8], y[8]; unpack8(u, x);
#pragma unroll
          for (int j = 0; j < 8; ++j) { y[j] = x[j] * eb[j]; BHt[(off + j) * 16 + t] = (bf16)f2bf(x[j] * eh[j]); }
          const v4u p = pack8(y); fBb[ks] = __builtin_bit_cast(bf16x8, p); }
        { const v4u u = raw[6 * ks + 4]; float x[8], y[8]; unpack8(u, x);
#pragma unroll
          for (int j = 0; j < 8; ++j) { y[j] = x[j] * eb[j]; KHt[(off + j) * 16 + t] = (bf16)f2bf(x[j] * eh[j]); }
          const v4u p = pack8(y); fKb[ks] = __builtin_bit_cast(bf16x8, p); }
        { const v4u u = raw[6 * ks + 5];
          const bf16 e0 = (bf16)(u.x & 0xffff), e1 = (bf16)(u.x >> 16), e2 = (bf16)(u.y & 0xffff), e3 = (bf16)(u.y >> 16), e4 = (bf16)(u.z & 0xffff), e5 = (bf16)(u.z >> 16), e6 = (bf16)(u.w & 0xffff), e7 = (bf16)(u.w >> 16);
          VTt[(off + 0) * 16 + t] = e0; VTt[(off + 1) * 16 + t] = e1; VTt[(off + 2) * 16 + t] = e2; VTt[(off + 3) * 16 + t] = e3; VTt[(off + 4) * 16 + t] = e4; VTt[(off + 5) * 16 + t] = e5; VTt[(off + 6) * 16 + t] = e6; VTt[(off + 7) * 16 + t] = e7; }
        __builtin_amdgcn_sched_barrier(0);
    }
    asm volatile("" ::: "memory");
    const f32x4 z4 = (f32x4){0.f, 0.f, 0.f, 0.f};
    f32x4 n0 = mma16(fAb[1], fBb[1], mma16(fAb[0], fBb[0], z4)), aak = mma16(fAb[1], fKb[1], mma16(fAb[0], fKb[0], z4));
    f32x4 arb = mma16(fRb[1], fBb[1], mma16(fRb[0], fBb[0], z4)), ark = mma16(fRb[1], fKb[1], mma16(fRb[0], fKb[0], z4));
#pragma unroll
    for (int r = 0; r < 4; ++r) { const int tt = 4 * kg + r; if (!(t < tt)) { n0[r] = 0.f; aak[r] = 0.f; } if (!(t <= tt)) { arb[r] = 0.f; ark[r] = 0.f; } }
    st_rowmaj(AK_r, aak, lane); st_rowmaj(RB2, arb, lane); st_rowmaj(RK_r, ark, lane); asm volatile("" ::: "memory");
    f32x4 accT = n0;
#pragma unroll
    for (int r = 0; r < 4; ++r) accT[r] += (4 * kg + r == t) ? 1.f : 0.f;
    f32x4 nn = n0;
#pragma unroll
    for (int itn = 0; itn < 3; ++itn) {
        st_rowmaj(N_r, nn, lane); st_colmaj(N_c, 0, nn, lane); st_rowmaj(T_r, accT, lane); asm volatile("" ::: "memory");
        const auto fa = frag16(N_r, 0, lane), fb = frag16(N_c, 0, lane), ft = frag16(T_r, 0, lane);
        nn = mma16(fa, fb, z4); asm volatile("" ::: "memory");
        st_colmaj(N_c, 0, nn, lane); asm volatile("" ::: "memory");
        const auto fb2 = frag16(N_c, 0, lane);
        accT = mma16(ft, fb2, accT); asm volatile("" ::: "memory");
    }
    st_rowmaj(T_r, accT, lane); asm volatile("" ::: "memory");
    const auto fT = frag16(T_r, 0, lane), fAK = frag16(AK_r, 0, lane), fARB = frag16(RB2, 0, lane), fARK = frag16(RK_r, 0, lane);
#pragma unroll
    for (int kt = 0; kt < 4; ++kt) { const f32x4 dd = mma16(fT, frag16(ATt, 16 * kt, lane), z4); st_colmaj(WAt, 16 * kt, dd, lane); } asm volatile("" ::: "memory");
    f32x4 qy[4];
    { const auto fArbT = frag16(RB2, 0, lane);
#pragma unroll
      for (int kt = 0; kt < 4; ++kt) { const v2u ri = *(const LAS v2u*)(RBr + t * 64 + 16 * kt + 4 * kg);
          qy[kt] = mma16(frag16(WAt, 16 * kt, lane), fArbT, (f32x4){bflo(ri.x), bfhi(ri.x), bflo(ri.y), bfhi(ri.y)}); } }
    asm volatile("" ::: "memory");
#pragma unroll
    for (int vt = 0; vt < 4; ++vt) { const f32x4 dd = mma16(fAK, frag16(VTt, 16 * vt, lane), z4); st_colmaj(ATt, 16 * vt, dd, lane); } asm volatile("" ::: "memory");
    LAS bf16* UVt = RBr;
#pragma unroll
    for (int vt = 0; vt < 4; ++vt) { const f32x4 dd = mma16(fT, frag16(ATt, 16 * vt, lane), z4); st_colmaj(UVt, 16 * vt, dd, lane); } asm volatile("" ::: "memory");
#pragma unroll
    for (int vt = 0; vt < 4; ++vt) { const auto fU = frag16(UVt, 16 * vt, lane), fV = frag16(VTt, 16 * vt, lane);
        yv[vt] = mma16(fARK, fV, mma16(fARB, fU, z4));
#pragma unroll
        for (int ktp = 0; ktp < 4; ++ktp) zv[vt][ktp] = mma16(frag16(KHt, 16 * ktp, lane), fV, mma16(frag16(BHt, 16 * ktp, lane), fU, z4)); }
    f32x4 pz[4][4];
#pragma unroll
    for (int ktp = 0; ktp < 4; ++ktp) { const auto fBh = frag16(BHt, 16 * ktp, lane);
#pragma unroll
        for (int kt = 0; kt < 4; ++kt) { f32x4 dd = mma16(frag16(WAt, 16 * kt, lane), fBh, z4);
            if (kt == ktp) {
#pragma unroll
                for (int r = 0; r < 4; ++r) if (4 * kg + r == t) dd[r] += GCl[16 * kt + t]; }
            pz[ktp][kt] = dd; } }
    asm volatile("s_waitcnt lgkmcnt(0)" ::: "memory");
#pragma unroll
    for (int ktp = 0; ktp < 4; ++ktp) { LAS bf16* reg = (LAS bf16*)(wl + (ktp < 2 ? ktp * 2048 : (ktp + 1) * 2048));
#pragma unroll
        for (int kt = 0; kt < 4; ++kt) { v2u o; o.x = pk2(pz[ktp][kt][0], pz[ktp][kt][1]); o.y = pk2(pz[ktp][kt][2], pz[ktp][kt][3]); *(LAS v2u*)(reg + t * 64 + 16 * kt + 4 * kg) = o; } }
#pragma unroll
    for (int kt = 0; kt < 4; ++kt) { v2u o; o.x = pk2(qy[kt][0], qy[kt][1]); o.y = pk2(qy[kt][2], qy[kt][3]); *(LAS v2u*)(BHt + t * 64 + 16 * kt + 4 * kg) = o; }
    asm volatile("s_waitcnt lgkmcnt(0)" ::: "memory");
}
constexpr int RWZ_OFF = LDSCTL_OFF + 8192, RWF_OFF = LDSCTL_OFF + 2048;
__device__ __forceinline__ void rw_chunk_item2(const Ctx& F, int l, int it, size_t yoff = WS_YDIR) {
    const auto& a = *F.a; unsigned char* ws = a.ws; const int lane = opaque_v(F.lane), t = lane & 15, kg = lane >> 4;
    const int d = it & 1, h = (it >> 1) & 7, b = it >> 4;
    float* YD = (float*)(ws + yoff);
    LAS unsigned char* wl = F.lds + F.wave * 15616;
    LAS bf16* ZS = (LAS bf16*)(F.lds + RWZ_OFF);
    volatile LAS int* flag = (volatile LAS int*)(F.lds + RWF_OFF);
    for (int i = F.tid; i < 2048; i += NTHREADS) ((LAS unsigned*)ZS)[i] = 0u;
    if (F.tid == 0) *flag = 0;
    __syncthreads();
    constexpr int NCHK = (CTXL + SEQ) / 16;
    v4u raw[12];
    rw_chunk_load<0, 2>(F, b, h, d, F.wave, raw);
#pragma unroll 1
    for (int c = F.wave; c < NCHK; c += NWAVES) {
        f32x4 yv[4], zv[4][4];
        rw_chunk_task2(F, raw, wl, yv, zv);
        if (c + NWAVES < NCHK) rw_chunk_load<0, 2>(F, b, h, d, c + NWAVES, raw);
        while (*flag < c) __builtin_amdgcn_s_sleep(1);
        asm volatile("" ::: "memory");
        const LAS bf16* Zc = ZS + (c & 1) * 4096; LAS bf16* Zn = ZS + ((c + 1) & 1) * 4096;
        bf16x8 zb[4][2];
#pragma unroll
        for (int vb = 0; vb < 4; ++vb)
#pragma unroll
            for (int ks = 0; ks < 2; ++ks) zb[vb][ks] = *(const LAS bf16x8*)(Zc + (16 * vb + t) * 64 + 32 * ks + 8 * kg);
        { const LAS bf16* Qr = (const LAS bf16*)(wl + 4096); const bf16x8 q0 = *(const LAS bf16x8*)(Qr + t * 64 + 8 * kg), q1 = *(const LAS bf16x8*)(Qr + t * 64 + 32 + 8 * kg);
#pragma unroll
          for (int vb = 0; vb < 4; ++vb) { const f32x4 y = mma16(q1, zb[vb][1], mma16(q0, zb[vb][0], yv[vb]));
#pragma unroll
              for (int r = 0; r < 4; ++r) { const int row = seq_row(b, d, c * 16 + 4 * kg + r); YD[((size_t)d * T_ALL + row) * 512 + h * 64 + 16 * vb + t] = y[r]; } } }
#pragma unroll
        for (int ktp = 0; ktp < 4; ++ktp) { const LAS bf16* Pr = (const LAS bf16*)(wl + (ktp < 2 ? ktp * 2048 : (ktp + 1) * 2048));
            const bf16x8 p0 = *(const LAS bf16x8*)(Pr + t * 64 + 8 * kg), p1 = *(const LAS bf16x8*)(Pr + t * 64 + 32 + 8 * kg);
#pragma unroll
            for (int vb = 0; vb < 4; ++vb) { const f32x4 z = mma16(p1, zb[vb][1], mma16(p0, zb[vb][0], zv[vb][ktp]));
                v2u o; o.x = pk2(z[0], z[1]); o.y = pk2(z[2], z[3]); *(LAS v2u*)(Zn + (16 * vb + t) * 64 + 16 * ktp + 4 * kg) = o; } }
        asm volatile("s_waitcnt lgkmcnt(0)" ::: "memory");
        if (lane == 0) *flag = c + 1;
        asm volatile("s_waitcnt lgkmcnt(0)" ::: "memory");
    }
    __syncthreads();
}

__device__ __forceinline__ void stage_rw_readout(const Ctx& F, int l) {
    const auto& a = *F.a; unsigned char* ws = a.ws; const int lane = F.lane;
    const bf16* SCN = (const bf16*)(ws + WS_SCN); const bf16* P = (const bf16*)(ws + WS_P); const float* YD = (const float*)(ws + WS_YDIR); bf16* YRW = (bf16*)(ws + WS_YRW);
    const int gw = F.bid * NWAVES + F.wave, NGW = F.G * NWAVES;
    constexpr int TR = 17, NRT = T_ALL / TR;
    for (int tile = gw; tile < NRT * 4; tile += NGW) {
        const int rt = tile % NRT, hp = tile / NRT, row0 = rt * TR, c0 = hp * 128 + 2 * lane;
        const f32x2 rk = *(const f32x2*)(a.in[I_RWRK] + l * 512 + c0), lng = *(const f32x2*)(a.in[I_RWLNG] + l * 512 + c0), lnb = *(const f32x2*)(a.in[I_RWLNB] + l * 512 + c0);
        unsigned sw_[8][5]; f32x2 yw_[8][2];
#define RO_LD(j_) do { const int rr_ = row0 + (j_); const unsigned* sp_ = (const unsigned*)(SCN + (size_t)rr_ * 9 * 512 + c0); \
        sw_[(j_) & 7][0] = sp_[0]; sw_[(j_) & 7][1] = sp_[256]; sw_[(j_) & 7][2] = sp_[4 * 256]; sw_[(j_) & 7][3] = sp_[7 * 256]; sw_[(j_) & 7][4] = *(const unsigned*)(P + (size_t)rr_ * 2560 + 2048 + c0); \
        yw_[(j_) & 7][0] = *(const f32x2*)(YD + (size_t)rr_ * 512 + c0); yw_[(j_) & 7][1] = *(const f32x2*)(YD + ((size_t)T_ALL + rr_) * 512 + c0); } while (0)
        RO_LD(0); RO_LD(1); RO_LD(2);
#pragma unroll
        for (int i = 0; i < TR; ++i) {
            const int row = row0 + i;
            if (i + 3 < TR) RO_LD(i + 3);
            const unsigned ru = sw_[i & 7][0], vu = sw_[i & 7][1], k0u = sw_[i & 7][2], k1u = sw_[i & 7][3], gu = sw_[i & 7][4];
            const f32x2 y0 = yw_[i & 7][0], y1 = yw_[i & 7][1];
            const float bon = red32(bflo(ru) * (bflo(k0u) + bflo(k1u)) * rk[0] + bfhi(ru) * (bfhi(k0u) + bfhi(k1u)) * rk[1]);
            f32x2 y = y0 + y1 + (f32x2){bflo(vu), bfhi(vu)} * bon;
            const float mu = red32(y[0] + y[1]) * (1.f / 64.f);
            y = y - mu;
            const float var = red32(y[0] * y[0] + y[1] * y[1]) * (1.f / 64.f);
            const f32x2 yn = y * (__builtin_amdgcn_rsqf(var + 64e-5f));
            const f32x2 ov = (yn * lng + lnb) * (f32x2){bflo(gu), bfhi(gu)};
            *(unsigned*)(YRW + (size_t)row * 512 + c0) = pk2(ov[0], ov[1]);
        }
    }
}
#undef RO_LD

constexpr size_t WS_S5E = 6 * MiB;
constexpr int S5_NSEG = 4, S5_SEGLEN = (CTXL + SEQ) / S5_NSEG;
__device__ __forceinline__ void s5_disc(const float are, const float aim, const float dt, float& lbr, float& lbi, float& cr, float& ci) {
    const float mag = expf(are * dt); lbr = mag * cosf(aim * dt); lbi = mag * sinf(aim * dt);
    const float den = are * are + aim * aim, nr = lbr - 1.0f; cr = (nr * are + lbi * aim) / den; ci = (lbi * are - nr * aim) / den;
}
template <int PASS>
__device__ __forceinline__ void stage_s5_scan(const Ctx& F, int l, int item = -1) {
    const auto& a = *F.a; unsigned char* ws = a.ws; const int lane = F.lane;
    const bf16* Z = (const bf16*)(ws + WS_Z); bf16* YP = (bf16*)(ws + WS_YP); f32x2* S5E = (f32x2*)(ws + WS_S5E);
    LAS unsigned char* wl = F.lds + F.wave * 16384;
    LAS float* buL = (LAS float*)wl;
    LAS bf16* Hs = (LAS bf16*)(wl + 8704);
    const int fr = lane & 15, kg = lane >> 4;
    for (int itx = (item < 0 ? F.bid : item) * NWAVES + F.wave; itx < BATCH * 32 * 2 * S5_NSEG; itx += (item < 0 ? NWAVES * F.G : BATCH * 32 * 2 * S5_NSEG)) {
        const int seg = itx & (S5_NSEG - 1), it = itx >> 2;
        const int d = it & 1, g = (it >> 1) & 31, b = it >> 6, p = lane;
        const float dt = expf(a.in[I_S5LDT][(l * 2 + d) * 32 + g]);
        const float* arep = a.in[I_S5ARE] + ((size_t)(l * 2 + d) * 32 + g) * 64; const float* aimp = a.in[I_S5AIM] + ((size_t)(l * 2 + d) * 32 + g) * 64;
        float lbr, lbi, cr_, ci_; s5_disc(arep[p], aimp[p], dt, lbr, lbi, cr_, ci_);
        bf16x8 afr[2][4];
#pragma unroll
        for (int tl = 0; tl < 4; ++tl) { const int pp = 16 * tl + fr; float r0_, r1_, cr, ci; s5_disc(arep[pp], aimp[pp], dt, r0_, r1_, cr, ci);
            v4u pr = (v4u){0u, 0u, 0u, 0u}, pi = (v4u){0u, 0u, 0u, 0u};
            if (kg < 2) { const float* br = a.in[I_S5BRE] + (((size_t)l * 32 + g) * 64 + pp) * 16 + 8 * kg; const float* bi = a.in[I_S5BIM] + (((size_t)l * 32 + g) * 64 + pp) * 16 + 8 * kg;
                const f32x4 x0 = *(const f32x4*)br, x1 = *(const f32x4*)(br + 4), y0 = *(const f32x4*)bi, y1 = *(const f32x4*)(bi + 4);
                pr.x = pk2(cr * x0[0] - ci * y0[0], cr * x0[1] - ci * y0[1]); pr.y = pk2(cr * x0[2] - ci * y0[2], cr * x0[3] - ci * y0[3]);
                pr.z = pk2(cr * x1[0] - ci * y1[0], cr * x1[1] - ci * y1[1]); pr.w = pk2(cr * x1[2] - ci * y1[2], cr * x1[3] - ci * y1[3]);
                pi.x = pk2(cr * y0[0] + ci * x0[0], cr * y0[1] + ci * x0[1]); pi.y = pk2(cr * y0[2] + ci * x0[2], cr * y0[3] + ci * x0[3]);
                pi.z = pk2(cr * y1[0] + ci * x1[0], cr * y1[1] + ci * x1[1]); pi.w = pk2(cr * y1[2] + ci * x1[2], cr * y1[3] + ci * x1[3]); }
            afr[0][tl] = __builtin_bit_cast(bf16x8, pr); afr[1][tl] = __builtin_bit_cast(bf16x8, pi); }
        bf16x8 cf[4];
        f32x2 hst = (f32x2){0.f, 0.f};
        if (PASS == 1) {
#pragma unroll
            for (int kk = 0; kk < 4; ++kk) { const int p0 = 16 * kk + 4 * kg;
                const f32x4 c0 = *(const f32x4*)(a.in[I_S5CRE] + (((size_t)l * 32 + g) * 16 + fr) * 64 + p0), c1 = *(const f32x4*)(a.in[I_S5CIM] + (((size_t)l * 32 + g) * 16 + fr) * 64 + p0);
                v4u pk; pk.x = pk2(c0[0], -c1[0]); pk.y = pk2(c0[1], -c1[1]); pk.z = pk2(c0[2], -c1[2]); pk.w = pk2(c0[3], -c1[3]);
                cf[kk] = __builtin_bit_cast(bf16x8, pk); }
            float pr_ = lbr, pi_ = lbi, l64r = 1.f, l64i = 0.f;
#pragma unroll 1
            for (int q = 0; q < 10; ++q) { const float nr2 = pr_ * pr_ - pi_ * pi_, ni2 = 2.f * pr_ * pi_; pr_ = nr2; pi_ = ni2; if (q == 5) { l64r = pr_; l64i = pi_; } }
            const float lLr = pr_ * l64r - pi_ * l64i, lLi = pr_ * l64i + pi_ * l64r;
#pragma unroll 1
            for (int sgi = 0; sgi < seg; ++sgi) { const f32x2 ev = S5E[((size_t)it * S5_NSEG + sgi) * 64 + p];
                hst = (f32x2){lLr * hst[0] - lLi * hst[1] + ev[0], lLr * hst[1] + lLi * hst[0] + ev[1]}; }
        }
        const f32x2 lbr2 = (f32x2){lbr, lbr}, lbi2 = (f32x2){lbi, lbi};
        const int sbeg = seg * S5_SEGLEN, send = sbeg + S5_SEGLEN;
        v4u u0 = (v4u){0u, 0u, 0u, 0u}, u1 = u0, u2 = u0, u3 = u0;
#define S5_LOADU(dst_, s0_) do { const int sx_ = ((s0_) < send) ? (s0_) : (send - 16); const int row_ = seq_row(b, d, sx_ + fr); dst_ = *(const v4u*)(Z + (size_t)row_ * IN_COLS + S5_OFF + g * 16 + (kg & 1) * 8); } while (0)
#define S5_CHUNK(ux_, sc_) do { \
            { const v4u um_ = (kg < 2) ? ux_ : (v4u){0u, 0u, 0u, 0u}; const bf16x8 ufr = __builtin_bit_cast(bf16x8, um_); \
              _Pragma("unroll") for (int c = 0; c < 2; ++c) _Pragma("unroll") for (int tl = 0; tl < 4; ++tl) { \
                const f32x4 dd = __builtin_amdgcn_mfma_f32_16x16x32_bf16(afr[c][tl], ufr, (f32x4){0.f, 0.f, 0.f, 0.f}, 0, 0, 0); *(LAS f32x4*)(buL + (c * 16 + fr) * 68 + 16 * tl + 4 * kg) = dd; } } \
            S5_LOADU(ux_, (sc_) + 64); \
            LDS_WAIT(); asm volatile("" ::: "memory"); \
            f32x2 bu[16]; \
            _Pragma("unroll") for (int s = 0; s < 16; ++s) bu[s] = (f32x2){buL[s * 68 + p], buL[(16 + s) * 68 + p]}; \
            _Pragma("unroll") for (int s = 0; s < 16; ++s) { const float tr_ = __builtin_fmaf(-lbi, hst[1], bu[s][0]), ti_ = __builtin_fmaf(lbi, hst[0], bu[s][1]); \
                hst = (f32x2){__builtin_fmaf(lbr, hst[0], tr_), __builtin_fmaf(lbr, hst[1], ti_)}; \
                if (PASS == 1) *(LAS unsigned*)(Hs + s * 136 + 2 * p) = pg8::cvt_pk_bf16(hst[0], hst[1]); } \
            if (PASS == 1) { LDS_WAIT(); asm volatile("" ::: "memory"); \
                f32x4 acc = (f32x4){0.f, 0.f, 0.f, 0.f}; \
                _Pragma("unroll") for (int kk = 0; kk < 4; ++kk) { const bf16x8 af = *(const LAS bf16x8*)(Hs + fr * 136 + 32 * kk + 8 * kg); acc = __builtin_amdgcn_mfma_f32_16x16x32_bf16(af, cf[kk], acc, 0, 0, 0); } \
                { const int rowq_ = seq_row(b, d, (sc_) + 4 * kg); bf16* yq_ = YP + ((size_t)d * T_ALL + rowq_) * 512 + g * 16 + fr; const int st_ = d ? -512 : 512; \
                  _Pragma("unroll") for (int r = 0; r < 4; ++r) yq_[r * st_] = (bf16)f2bf(acc[r]); } } \
            LDS_WAIT(); asm volatile("" ::: "memory"); } while (0)
        S5_LOADU(u0, sbeg); S5_LOADU(u1, sbeg + 16); S5_LOADU(u2, sbeg + 32); S5_LOADU(u3, sbeg + 48);
#pragma unroll 1
        for (int s0 = sbeg; s0 < send; s0 += 64) { S5_CHUNK(u0, s0); S5_CHUNK(u1, s0 + 16); S5_CHUNK(u2, s0 + 32); S5_CHUNK(u3, s0 + 48); }
#undef S5_CHUNK
        if (PASS == 0) S5E[((size_t)it * S5_NSEG + seg) * 64 + p] = hst;
#undef S5_LOADU
    }
}

__device__ __forceinline__ void stage_s5_prep(const Ctx& F, int l, int nrows) {
    const auto& a = *F.a; unsigned char* ws = a.ws;
    const bf16* __restrict__ Z = (const bf16*)(ws + WS_Z); const bf16* __restrict__ YP = (const bf16*)(ws + WS_YP); bf16* __restrict__ AS5 = (bf16*)(ws + WS_AS5);
    const int c = 4 * (F.tid & 127), rq = F.tid >> 7;
    const f32x4 dsk = *(const f32x4*)(a.in[I_S5D] + l * 512 + c);
#pragma unroll 4
    for (int row = F.bid * 4 + rq; row < nrows; row += F.G * 4) {
        const v2u uz = *(const v2u*)(Z + (size_t)row * IN_COLS + S5_OFF + c);
        const v2u q0 = *(const v2u*)(YP + (size_t)row * 512 + c), q1 = *(const v2u*)(YP + ((size_t)T_ALL + row) * 512 + c);
        const f32x4 y0 = (f32x4){bflo(q0.x), bfhi(q0.x), bflo(q0.y), bfhi(q0.y)}, y1 = (f32x4){bflo(q1.x), bfhi(q1.x), bflo(q1.y), bfhi(q1.y)};
        const f32x4 u = (f32x4){bflo(uz.x), bfhi(uz.x), bflo(uz.y), bfhi(uz.y)};
        const f32x4 y = y0 + y1 + u * dsk;
        float ge[4];
#pragma unroll
        for (int j = 0; j < 4; ++j) ge[j] = 0.5f * y[j] * (1.f + tanh_fast(0.7978845608028654f * (y[j] + 0.044715f * y[j] * y[j] * y[j])));
        v2u o; o.x = pk2(ge[0], ge[1]); o.y = pk2(ge[2], ge[3]);
        *(v2u*)(AS5 + (size_t)row * 512 + c) = o;
    }
}

__device__ __forceinline__ void stage_hy_pre(const Ctx& F, int l, int nrows) {
    const auto& a = *F.a; unsigned char* ws = a.ws; const int lane = F.lane;
    const bf16* Z = (const bf16*)(ws + WS_Z); bf16* UT = (bf16*)(ws + WS_UT);
    LAS unsigned char* tl = F.lds + F.wave * 16384;
    const float* cw = a.in[I_HYCW] + (size_t)l * 3 * 1536; const float* cbp = a.in[I_HYCB] + l * 1536;
    const int gw = F.bid * NWAVES + F.wave, NGW = F.G * NWAVES;
    const int q = lane >> 3, k = lane & 7, ntile = (nrows / 64) * 24;
    v4u v[8], hv;
#define HYPRE_LOAD(tile_) do { const int rt_ = (tile_) / 24, ct_ = (tile_) % 24, row0_ = rt_ * 64; int base_, pos0_, n_; row_seq(row0_, base_, pos0_, n_); \
        const bf16* zt_ = Z + (size_t)row0_ * IN_COLS + HY_OFF + ct_ * 64 + 8 * k; hv = (v4u){0u, 0u, 0u, 0u}; \
        _Pragma("unroll") for (int i = 0; i < 8; ++i) v[i] = *(const v4u*)(zt_ + (size_t)(8 * i + q) * IN_COLS); \
        if (q == 0 && pos0_ > 0) hv = *(const v4u*)(zt_ - (size_t)IN_COLS); \
        if (q == 1 && pos0_ + 64 < n_) hv = *(const v4u*)(zt_ + (size_t)64 * IN_COLS); } while (0)
    if (gw < ntile) HYPRE_LOAD(gw);
#pragma unroll 1
    for (int tile = gw; tile < ntile; tile += NGW) {
        const int rt = tile / 24, ct = tile % 24, row0 = rt * 64, c0 = ct * 64;
        f32x4 wv[8];
#pragma unroll
        for (int i = 0; i < 8; ++i) { const int col = c0 + 8 * i + q; wv[i] = (f32x4){cw[col], cw[1536 + col], cw[2 * 1536 + col], cbp[col]}; }
#pragma unroll
        for (int i = 0; i < 8; ++i) { LAS unsigned* p = (LAS unsigned*)(tl + (1 + 8 * i + q) * 132 + 16 * k); p[0] = v[i].x; p[1] = v[i].y; p[2] = v[i].z; p[3] = v[i].w; }
        if (q < 2) { LAS unsigned* p = (LAS unsigned*)(tl + (q ? 65 : 0) * 132 + 16 * k); p[0] = hv.x; p[1] = hv.y; p[2] = hv.z; p[3] = hv.w; }
        if (tile + NGW < ntile) HYPRE_LOAD(tile + NGW);
        LDS_WAIT(); asm volatile("" ::: "memory");
#pragma unroll 2
        for (int i = 0; i < 8; ++i) {
            const int ch = 8 * i + q, col = c0 + ch;
            const LAS unsigned short* s = (const LAS unsigned short*)(tl + (8 * k) * 132 + ch * 2);
            float z[10];
#pragma unroll
            for (int t = 0; t < 10; ++t) z[t] = __builtin_bit_cast(float, (unsigned)s[t * 66] << 16);
            float o[8];
#pragma unroll
            for (int t = 0; t < 8; ++t) o[t] = wv[i][0] * z[t] + wv[i][1] * z[t + 1] + wv[i][2] * z[t + 2] + wv[i][3];
            v4u w; w.x = pk2(o[0], o[1]); w.y = pk2(o[2], o[3]); w.z = pk2(o[4], o[5]); w.w = pk2(o[6], o[7]);
            *(v4u*)(UT + (size_t)col * T_ALL + row0 + 8 * k) = w;
        }
        LDS_WAIT(); asm volatile("" ::: "memory");
    }
#undef HYPRE_LOAD
}
__device__ __forceinline__ void stage_hy_post(const Ctx& F, int l, int nrows) {
    const auto& a = *F.a; unsigned char* ws = a.ws; const int lane = F.lane;
    const bf16* YT = (const bf16*)(ws + WS_UT) + (size_t)1024 * T_ALL; bf16* YHY = (bf16*)(ws + WS_YHY);
    LAS unsigned char* tl = F.lds + F.wave * 16384;
    const int gw = F.bid * NWAVES + F.wave, NGW = F.G * NWAVES;
    const int q = lane >> 3, k = lane & 7, ntile = (nrows / 64) * 8;
    v4u v[8];
#define HYPOST_LOAD(tile_) do { const bf16* yp_ = YT + (size_t)(((tile_) & 7) * 64 + q) * T_ALL + ((tile_) >> 3) * 64 + 8 * k; \
        _Pragma("unroll") for (int i = 0; i < 8; ++i) v[i] = *(const v4u*)(yp_ + (size_t)(8 * i) * T_ALL); } while (0)
    if (gw < ntile) HYPOST_LOAD(gw);
#pragma unroll 1
    for (int tile = gw; tile < ntile; tile += NGW) {
        const int rt = tile >> 3, ct = tile & 7, row0 = rt * 64, c0 = ct * 64;
#pragma unroll
        for (int i = 0; i < 8; ++i) { LAS unsigned* p = (LAS unsigned*)(tl + (8 * i + q) * 132 + 16 * k); p[0] = v[i].x; p[1] = v[i].y; p[2] = v[i].z; p[3] = v[i].w; }
        if (tile + NGW < ntile) HYPOST_LOAD(tile + NGW);
        LDS_WAIT(); asm volatile("" ::: "memory");
#pragma unroll
        for (int i = 0; i < 8; ++i) { const int r = 8 * i + q;
            const LAS unsigned short* s = (const LAS unsigned short*)(tl + (8 * k) * 132 + r * 2);
            unsigned e[8];
#pragma unroll
            for (int j = 0; j < 8; ++j) e[j] = s[j * 66];
            v4u w; w.x = e[0] | (e[1] << 16); w.y = e[2] | (e[3] << 16); w.z = e[4] | (e[5] << 16); w.w = e[6] | (e[7] << 16);
            *(v4u*)(YHY + (size_t)(row0 + r) * 512 + c0 + 8 * k) = w; }
        LDS_WAIT(); asm volatile("" ::: "memory");
    }
#undef HYPOST_LOAD
}
typedef float f32x16 __attribute__((ext_vector_type(16)));
__device__ __forceinline__ void hyena_item(const Ctx& F, int l, int c, int isctx) {
    const auto& a = *F.a; unsigned char* ws = a.ws; const int tid = F.tid, lane = F.lane;
    const int n = isctx ? CTXL : SEQ, rowbase = isctx ? T_LAT : 0, RL = isctx ? HY_RLENC : HY_RLEN, off = n + 47;
    const bf16* UT = (const bf16*)(ws + WS_UT);
    const bf16* x1g = UT + (size_t)c * T_ALL + rowbase; const bf16* x2g = UT + (size_t)(512 + c) * T_ALL + rowbase; bf16* vg = (bf16*)UT + (size_t)(1024 + c) * T_ALL + rowbase;
    const bf16* Rg = (const bf16*)(ws + WS_GF + l * GF_STRIDE + (isctx ? GF_CTX : 0)) + (size_t)c * RL;
    LAS unsigned char* XB = F.lds; LAS unsigned char* R1 = F.lds + HY_R1_OFF; LAS unsigned char* R2 = F.lds + HY_R2_OFF;
    { const int cpb = n / 8;
      for (int q = tid; q < 8 * cpb; q += NTHREADS) { const int b = q / cpb, ch = q % cpb; *(LAS v4u*)(XB + b * HY_ROWB + 2 * HY_MARG + 16 * ch) = *(const v4u*)(vg + (size_t)b * n + 8 * ch); }
      if (tid < 256) { const int b = tid >> 5, side = (tid >> 4) & 1, ch = tid & 15; const unsigned zz = (unsigned)opaque_v(0); *(LAS v4u*)(XB + b * HY_ROWB + (side ? 2 * (HY_MARG + n) : 0) + 16 * ch) = (v4u){zz, zz, zz, zz}; }
      const int rch = RL / 8;
      for (int q = tid; q < rch; q += NTHREADS) { *(LAS v4u*)(R1 + 16 * q) = *(const v4u*)(Rg + 8 * q); *(LAS v4u*)(R2 + 16 * q) = *(const v4u*)(Rg + (size_t)512 * RL + 8 * q); } }
    __syncthreads();
    const int i = lane & 31, kg = lane >> 5, jb = lane & 3, bb = (lane & 31) >> 2;
    const int rsh = (off - i) & 7, rd = rsh >> 1; const bool s1 = rd & 1, s2 = rd & 2; const unsigned sh = (rsh & 1) ? 16u : 0u;
    const int aconst = 2 * (off - i + 8 * kg - rsh), bconst = bb * HY_ROWB + 2 * (HY_MARG + 32 * jb + 8 * kg);
    const int T0w = 512 * F.wave; const int ntile = (n - T0w) >= 512 ? 4 : ((n - T0w) > 0 ? (n - T0w) / 128 : 0);
    const float bias0 = a.in[I_HYBIAS][(l * 2 + 0) * 512 + c], bias1 = a.in[I_HYBIAS][(l * 2 + 1) * 512 + c];
    f32x16 acc[4];
    v2u y1p[4][4];
#define HY_AFRAG(wa, wb, afr) do { \
        const unsigned a0 = s1 ? wa.y : wa.x, a1 = s1 ? wa.z : wa.y, a2 = s1 ? wa.w : wa.z, a3 = s1 ? wb.x : wa.w, a4 = s1 ? wb.y : wb.x, a5 = s1 ? wb.z : wb.y, a6 = s1 ? wb.w : wb.z; \
        const unsigned b0 = s2 ? a2 : a0, b1 = s2 ? a3 : a1, b2 = s2 ? a4 : a2, b3 = s2 ? a5 : a3, b4 = s2 ? a6 : a4; \
        v4u af_; af_.x = __builtin_amdgcn_alignbit(b1, b0, sh); af_.y = __builtin_amdgcn_alignbit(b2, b1, sh); af_.z = __builtin_amdgcn_alignbit(b3, b2, sh); af_.w = __builtin_amdgcn_alignbit(b4, b3, sh); \
        afr = __builtin_bit_cast(bf16x8, af_); } while (0)
#define HY_STEP_COND(RB, d) do { \
        const v4u wa = *(const LAS v4u*)((RB) + aconst - 2 * (d)), wb = *(const LAS v4u*)((RB) + aconst - 2 * (d) + 16); bf16x8 afr; HY_AFRAG(wa, wb, afr); \
        _Pragma("unroll") for (int m = 0; m < 4; ++m) { const int T0 = T0w + 128 * m; \
            if (m < ntile && (d) >= T0 - n + 16 && (d) <= T0 + 96) { const bf16x8 bfr = *(const LAS bf16x8*)(XB + bconst + 2 * (T0 - (d))); \
                acc[m] = __builtin_amdgcn_mfma_f32_32x32x16_bf16(afr, bfr, acc[m], 0, 0, 0); } } } while (0)
#define HY_LOAD(RB, d, wa, wb, bq) do { wa = *(const LAS v4u*)((RB) + aconst - 2 * (d)); wb = *(const LAS v4u*)((RB) + aconst - 2 * (d) + 16); \
        _Pragma("unroll") for (int m = 0; m < 4; ++m) bq[m] = *(const LAS bf16x8*)(XB + bconst + 2 * (T0w + 128 * m - (d))); } while (0)
#define HY_MMA(wa, wb, bq) do { bf16x8 afr; HY_AFRAG(wa, wb, afr); \
        _Pragma("unroll") for (int m = 0; m < 4; ++m) acc[m] = __builtin_amdgcn_mfma_f32_32x32x16_bf16(afr, bq[m], acc[m], 0, 0, 0); } while (0)
#define HY_CONV(RB) do { \
        _Pragma("unroll") for (int m = 0; m < 4; ++m) _Pragma("unroll") for (int e = 0; e < 16; ++e) acc[m][e] = 0.f; \
        if (ntile == 4) { \
            const int dA = T0w - n + 16, dB = T0w + 384 - n + 16, dC = T0w + 96, dD = T0w + 384 + 96;     \
            _Pragma("unroll 1") for (int d = dA; d < dB; d += 16) HY_STEP_COND(RB, d); \
            { v4u waA, wbA, waB, wbB; bf16x8 bqA[4], bqB[4]; \
              HY_LOAD(RB, dB, waA, wbA, bqA); \
              _Pragma("unroll 1") for (int d = dB; d <= dC; d += 32) { \
                  if (d + 16 <= dC) HY_LOAD(RB, d + 16, waB, wbB, bqB); \
                  __builtin_amdgcn_sched_barrier(0); \
                  HY_MMA(waA, wbA, bqA); \
                  __builtin_amdgcn_sched_barrier(0); \
                  if (d + 32 <= dC) HY_LOAD(RB, d + 32, waA, wbA, bqA); \
                  __builtin_amdgcn_sched_barrier(0); \
                  if (d + 16 <= dC) HY_MMA(waB, wbB, bqB); \
                  __builtin_amdgcn_sched_barrier(0); } } \
            _Pragma("unroll 1") for (int d = dC + 16; d <= dD; d += 16) HY_STEP_COND(RB, d); \
        } else if (ntile > 0) { const int dhi = T0w + 128 * (ntile - 1) + 96; \
            _Pragma("unroll 1") for (int d = T0w - n + 16; d <= dhi; d += 16) HY_STEP_COND(RB, d); } } while (0)
    HY_CONV(R1);
#pragma unroll
    for (int m = 0; m < 4; ++m) if (m < ntile) {
#pragma unroll
        for (int rg = 0; rg < 4; ++rg) { const int t4 = T0w + 128 * m + 32 * jb + 8 * rg + 4 * kg;
            const v2u xv = *(const v2u*)(x1g + (size_t)bb * n + t4); const v2u vv = *(const LAS v2u*)(XB + bb * HY_ROWB + 2 * (HY_MARG + t4));
            const float y0 = bflo(xv.x) * (acc[m][4 * rg + 0] + bias0 * bflo(vv.x)), y1 = bfhi(xv.x) * (acc[m][4 * rg + 1] + bias0 * bfhi(vv.x));
            const float y2 = bflo(xv.y) * (acc[m][4 * rg + 2] + bias0 * bflo(vv.y)), y3 = bfhi(xv.y) * (acc[m][4 * rg + 3] + bias0 * bfhi(vv.y));
            y1p[m][rg].x = pk2(y0, y1); y1p[m][rg].y = pk2(y2, y3); } }
    __syncthreads();
#pragma unroll
    for (int m = 0; m < 4; ++m) if (m < ntile) {
#pragma unroll
        for (int rg = 0; rg < 4; ++rg) { const int t4 = T0w + 128 * m + 32 * jb + 8 * rg + 4 * kg; *(LAS v2u*)(XB + bb * HY_ROWB + 2 * (HY_MARG + t4)) = y1p[m][rg]; } }
    __syncthreads();
    HY_CONV(R2);
#pragma unroll
    for (int m = 0; m < 4; ++m) if (m < ntile) {
#pragma unroll
        for (int rg = 0; rg < 4; ++rg) { const int t4 = T0w + 128 * m + 32 * jb + 8 * rg + 4 * kg;
            const v2u xv = *(const v2u*)(x2g + (size_t)bb * n + t4); const v2u yv = y1p[m][rg];
            const float o0 = bflo(xv.x) * (acc[m][4 * rg + 0] + bias1 * bflo(yv.x)), o1 = bfhi(xv.x) * (acc[m][4 * rg + 1] + bias1 * bfhi(yv.x));
            const float o2 = bflo(xv.y) * (acc[m][4 * rg + 2] + bias1 * bflo(yv.y)), o3 = bfhi(xv.y) * (acc[m][4 * rg + 3] + bias1 * bfhi(yv.y));
            v2u ov; ov.x = pk2(o0, o1); ov.y = pk2(o2, o3); *(v2u*)(vg + (size_t)bb * n + t4) = ov; } }
    __syncthreads();
#undef HY_CONV
#undef HY_AFRAG
#undef HY_STEP_COND
#undef HY_LOAD
#undef HY_MMA
}
__device__ __forceinline__ void stage_mixer(const Ctx& F, int l) {
    unsigned* ctr = (unsigned*)(F.a->ws + WS_CTL) + CW_WORK + 64 * l;
    LAS int* itb = (LAS int*)(F.lds + LDSCTL_OFF + 512);
    constexpr int NS5 = BATCH * 32 * 2 * S5_NSEG / NWAVES;
    const int nit = 128 + NS5 + 512 + (l == 0 ? 512 : 0);
#ifdef PROBE_STATIC
    return;
#endif
    for (;;) {
        if (F.tid == 0) *itb = (int)__hip_atomic_fetch_add(ctr, 1u, __ATOMIC_RELAXED, __HIP_MEMORY_SCOPE_AGENT);
        __syncthreads();
        const int it = *itb;
        __syncthreads();
        if (it >= nit) break;
        Ctx Fi; Fi.a = kargs(); Fi.tid = opaque_v((int)threadIdx.x); Fi.lane = Fi.tid & 63; Fi.wave = __builtin_amdgcn_readfirstlane(Fi.tid >> 6); Fi.bid = opaque((int)blockIdx.x); Fi.G = opaque((int)gridDim.x);
        Fi.lds = (LAS unsigned char*)((LAS unsigned char*)0 + opaque(0)) + (F.lds - (LAS unsigned char*)0);
#ifdef PROBE_T
        if (l == 0 && F.tid == 0 && it == 5) ((unsigned long long*)(F.a->ws + WS_CTL + CW_STAMP * 4))[21] = __builtin_amdgcn_s_memrealtime();
        if (l == 0 && F.tid == 0 && it == 300) ((unsigned long long*)(F.a->ws + WS_CTL + CW_STAMP * 4))[23] = __builtin_amdgcn_s_memrealtime();
#endif
        if (it < 128) { for (int rep = 0; rep < ((DUPK == 9) ? 2 : 1); ++rep) rw_chunk_item2(Fi, opaque(l), it); }
        else if (it < 128 + NS5) stage_s5_scan<1>(Fi, opaque(l), it - 128);
        else if (it < 640 + NS5) hyena_item(Fi, opaque(l), it - 128 - NS5, 0);
        else hyena_item(Fi, opaque(l), it - 640 - NS5, 1);
#ifdef PROBE_T
        if (l == 0 && F.tid == 0 && it == 5) ((unsigned long long*)(F.a->ws + WS_CTL + CW_STAMP * 4))[22] = __builtin_amdgcn_s_memrealtime();
        if (l == 0 && F.tid == 0 && it == 300) ((unsigned long long*)(F.a->ws + WS_CTL + CW_STAMP * 4))[24] = __builtin_amdgcn_s_memrealtime();
#endif
    }
}

typedef float f32x16r __attribute__((ext_vector_type(16)));
__device__ __forceinline__ void stage_norm2_router(const Ctx& F, int l, int nrows) {
    const auto& a = *F.a; unsigned char* ws = a.ws; const int lane = F.lane;
    const float* X = (const float*)(ws + WS_X); bf16* H = (bf16*)(ws + WS_H); const float* MOD = (const float*)(ws + WS_MOD);
    int* EIDX = (int*)(ws + WS_EIDX); float* GATE = (float*)(ws + WS_GATE); int* POS = (int*)(ws + WS_POS); unsigned* ROWOF = (unsigned*)(ws + WS_ROWOF);
    LAS int* lex = (LAS int*)(F.lds + 40960); LAS int* lrk = lex + 2048; LAS int* offl = lrk + 2048;
    LAS float* lg = (LAS float*)(F.lds + F.wave * 4352);
    LAS int* hist = (LAS int*)(F.lds + LDSCTL_OFF + 1024);
    if (F.tid < 32) hist[F.tid] = 0;
    __syncthreads();
    const int rpb = (nrows + F.G - 1) / F.G, r0 = F.bid * rpb, r1 = (r0 + rpb < nrows) ? r0 + rpb : nrows;
    const float* rw = a.in[I_RTW] + (size_t)l * 1024 * 32;
    const int i = lane & 31, kk = lane >> 5;
    const f32x4* ng = (const f32x4*)(a.in[I_N2G] + l * D) + kk;
    for (int rb = r0 + F.wave * 32; rb < r1; rb += NWAVES * 32) {
        const int nrow = (r1 - rb) < 32 ? (r1 - rb) : 32; const bool live = i < nrow;
        const int row = live ? rb + i : r1 - 1; const int w = row < T_LAT ? (row >> 12) : 8;
        const f32x4* xr = (const f32x4*)(X + (size_t)row * D) + kk;
        float ss = 0.f;
#pragma unroll 16
        for (int q = 0; q < 128; ++q) { const f32x4 v = xr[2 * q]; ss += (v[0] * v[0] + v[1] * v[1]) + (v[2] * v[2] + v[3] * v[3]); }
        ss += __builtin_bit_cast(float, __builtin_amdgcn_ds_bpermute((lane ^ 32) << 2, __builtin_bit_cast(int, ss)));
        const float rstd = __builtin_amdgcn_rsqf(ss * (1.f / D) + 1e-6f);
        const f32x4* sh = (const f32x4*)(MOD + (size_t)(l * 9 + w) * 6144 + 3072) + kk; const f32x4* sc = (const f32x4*)(MOD + (size_t)(l * 9 + w) * 6144 + 4096) + kk;
        v2u* ho = (v2u*)(H + (size_t)row * D) + kk;
        f32x16r acc;
#pragma unroll
        for (int e = 0; e < 16; ++e) acc[e] = 0.f;
        const float* wp = rw + (size_t)(4 * kk) * 32 + i;
        f32x4 xn[4], gn_[4], cn_[4], sn_[4], wn_[4];
#define RT_LOAD(q0_) do { _Pragma("unroll") for (int u_ = 0; u_ < 4; ++u_) { const int q_ = (q0_) + u_; xn[u_] = xr[2 * q_]; gn_[u_] = ng[2 * q_]; cn_[u_] = sc[2 * q_]; sn_[u_] = sh[2 * q_]; \
            wn_[u_] = (f32x4){wp[(size_t)(8 * q_) * 32], wp[(size_t)(8 * q_ + 1) * 32], wp[(size_t)(8 * q_ + 2) * 32], wp[(size_t)(8 * q_ + 3) * 32]}; } } while (0)
        RT_LOAD(0);
#pragma unroll 1
        for (int q0 = 0; q0 < 128; q0 += 4) {
            f32x4 xc[4], gc_[4], cc_[4], sc_[4], wc_[4];
#pragma unroll
            for (int u = 0; u < 4; ++u) { xc[u] = xn[u]; gc_[u] = gn_[u]; cc_[u] = cn_[u]; sc_[u] = sn_[u]; wc_[u] = wn_[u]; }
            if (q0 + 4 < 128) RT_LOAD(q0 + 4);
#pragma unroll
            for (int u = 0; u < 4; ++u) { const int q = q0 + u;
                const f32x4 h4 = xc[u] * rstd * gc_[u] * (cc_[u] + 1.0f) + sc_[u];
                if (live) { v2u o; o.x = pk2(h4[0], h4[1]); o.y = pk2(h4[2], h4[3]); ho[2 * q] = o; }
                acc = __builtin_amdgcn_mfma_f32_32x32x2f32(h4[0], wc_[u][0], acc, 0, 0, 0);
                acc = __builtin_amdgcn_mfma_f32_32x32x2f32(h4[1], wc_[u][1], acc, 0, 0, 0);
                acc = __builtin_amdgcn_mfma_f32_32x32x2f32(h4[2], wc_[u][2], acc, 0, 0, 0);
                acc = __builtin_amdgcn_mfma_f32_32x32x2f32(h4[3], wc_[u][3], acc, 0, 0, 0); }
        }
#undef RT_LOAD
        const float rbias = a.in[I_RTB][l * 32 + i];
#pragma unroll
        for (int r = 0; r < 16; ++r) { const int ri = (r & 3) + 8 * (r >> 2) + 4 * kk; lg[ri * 33 + i] = acc[r] + rbias; }
        LDS_WAIT(); asm volatile("" ::: "memory");
        if (lane < nrow) {
            LAS float* lr = lg + lane * 33; const int orow = rb + lane;
            float tv[4]; int ti[4];
#pragma unroll
            for (int r = 0; r < 4; ++r) { float bv = -INFINITY; int bi = 0;
#pragma unroll 8
                for (int e = 0; e < 32; ++e) { const float v = lr[e]; if (v > bv) { bv = v; bi = e; } }
                tv[r] = bv; ti[r] = bi; lr[bi] = -INFINITY; }
            const float e1 = expf(tv[1] - tv[0]), e2 = expf(tv[2] - tv[0]), e3 = expf(tv[3] - tv[0]); const float inv = 1.0f / (1.0f + e1 + e2 + e3);
            *(int4*)(EIDX + orow * 4) = make_int4(ti[0], ti[1], ti[2], ti[3]); *(f32x4*)(GATE + orow * 4) = (f32x4){inv, e1 * inv, e2 * inv, e3 * inv};
#pragma unroll
            for (int r = 0; r < 4; ++r) { const int rk = __hip_atomic_fetch_add(&hist[ti[r]], 1, __ATOMIC_RELAXED, __HIP_MEMORY_SCOPE_WORKGROUP); lex[(orow - r0) * 4 + r] = ti[r]; lrk[(orow - r0) * 4 + r] = rk; }
        }
        LDS_WAIT(); asm volatile("" ::: "memory");
    }
    __syncthreads();
    if (F.tid < 32) { const int c = hist[F.tid]; offl[F.tid] = c ? (int)__hip_atomic_fetch_add((unsigned*)(ws + WS_CTL) + CW_CNT + 64 * l + F.tid, (unsigned)c, __ATOMIC_RELAXED, __HIP_MEMORY_SCOPE_AGENT) : 0; }
    __syncthreads();
    for (int i = F.tid; i < (r1 > r0 ? (r1 - r0) * 4 : 0); i += NTHREADS) { const int e = lex[i], pos = offl[e] + lrk[i];
        POS[r0 * 4 + i] = pos; ROWOF[(size_t)e * pg8::MOE_CAP + pos] = (unsigned)(r0 + (i >> 2)) * (unsigned)(D * 2); }
    __syncthreads();
}

__device__ __forceinline__ LAS int* load_moe_base(const Ctx& F, int l) {
    LAS int* base = (LAS int*)(F.lds + LDSCTL_OFF + 256);
    if (F.tid < 32) base[64 + F.tid] = (int)__hip_atomic_load((unsigned*)(F.a->ws + WS_CTL) + CW_CNT + 64 * l + F.tid, __ATOMIC_RELAXED, __HIP_MEMORY_SCOPE_AGENT);
    __syncthreads();
    if (F.tid == 0) { int acc = 0; for (int e = 0; e < 32; ++e) { base[e] = acc; acc += (base[64 + e] + 255) & ~255; } base[32] = acc; }
    __syncthreads();
    return base;
}
__device__ __forceinline__ void moe_fix_pos(const Ctx& F, int nrows, const LAS int* base) {
    unsigned char* ws = F.a->ws; const int* EIDX = (const int*)(ws + WS_EIDX); int* POS = (int*)(ws + WS_POS);
    const int rpb = (nrows + F.G - 1) / F.G, r0 = F.bid * rpb, r1 = (r0 + rpb < nrows) ? r0 + rpb : nrows;
    for (int i = F.tid; i < (r1 > r0 ? (r1 - r0) * 4 : 0); i += NTHREADS) POS[r0 * 4 + i] += base[EIDX[r0 * 4 + i]];
}

constexpr int NSTAGE_L = 13, NSTAGES = 1 + DEPTH * NSTAGE_L + 1;
__global__ void __launch_bounds__(NTHREADS, 2) mk_fwd(Args args) {
    extern __shared__ __attribute__((aligned(16))) unsigned char lds_raw[];
    Ctx F; F.a = kargs(); F.lds = (LAS unsigned char*)lds_raw; F.tid = threadIdx.x; F.lane = F.tid & 63; F.wave = __builtin_amdgcn_readfirstlane(F.tid >> 6); F.bid = blockIdx.x; F.G = gridDim.x;
    volatile LAS unsigned* MISC = (volatile LAS unsigned*)(F.lds + LDSCTL_OFF);
    for (int u = F.tid; u < (LDS_BYTES - LDSCTL_OFF) / 4; u += NTHREADS) ((LAS unsigned*)(F.lds + LDSCTL_OFF))[u] = 0u;
    __syncthreads();
#if MK_PER_STAGE
#define GRID_BAR() do { } while (0)
#else
    (void)xcd_barrier_post((unsigned*)(F.a->ws + WS_CTL) + CW_BAR, MISC + 8);
#define GRID_BAR() do { XcdBarrier b_; b_.bar = (unsigned*)(kargs()->ws + WS_CTL) + CW_BAR; b_.x = xb_xcc_id(); b_.st = (volatile LAS unsigned*)((LAS unsigned char*)lds_raw + LDSCTL_OFF + opaque(32)); xcd_barrier(b_); } while (0)
#endif
#ifndef ONLY_S
#define ONLY_S -1
#endif
#define STG_SEL(k) (ONLY_S < 0 || ONLY_S == (((k) == 0) ? 0 : ((k) == NSTAGES - 1 ? 14 : (((k) - 1) % NSTAGE_L) + 1)))
#if MK_PER_STAGE
#define IN(k) (STG_SEL(k) && kargs()->ph_lo == (k))
#else
#define IN(k) STG_SEL(k)
#endif
#if MK_PER_STAGE
#define SEAM(k) do { } while (0)
#else
#define SEAM(k) do { if ((k) + 1 < NSTAGES) GRID_BAR(); } while (0)
#endif
#define STAGE(k) if (IN(k)) { F.a = kargs(); F.tid = opaque_v((int)threadIdx.x); F.lane = F.tid & 63; F.wave = __builtin_amdgcn_readfirstlane(F.tid >> 6); F.bid = opaque((int)blockIdx.x); F.G = opaque((int)gridDim.x); F.lds = (LAS unsigned char*)lds_raw + opaque(0); unsigned char* ws = F.a->ws; const int l = opaque(lq); unsigned char* wl = ws + WS_WTS + (size_t)l * WL_STRIDE; (void)wl; (void)ws;
#define STAGE_END(k) } SEAM(k);
    int lq = 0;
    STAGE(0) p0_prologue(F); STAGE_END(0)
    for (lq = 0; lq < DEPTH; ++lq) {
        const int sb = 1 + lq * NSTAGE_L;
        const int nrl = opaque((lq == DEPTH - 1) ? T_LAT : T_ALL);
        STAGE(sb + 0) stage_norm1(F, l); STAGE_END(sb + 0)
        STAGE(sb + 1) pg8::SchedWin S; S.A = (const char*)(ws + WS_H); S.Bt = (const char*)(wl + WO_WIN); S.tstep = (size_t)256 * 1024 * 2; S.G = F.G; S.c = F.bid; S.part = (nrl != T_ALL); pg8::EpiBf16 E{(bf16*)(ws + WS_Z), IN_COLS, nullptr, 0};
            pg8::gemm_phase(F.lds, F.tid, 1024, S, E); STAGE_END(sb + 1)
        STAGE(sb + 2) for (int rep = 0; rep < REPN(1); ++rep) stage_rw_prep1(F, l); for (int rep = 0; rep < REPN(2); ++rep) stage_s5_scan<0>(F, l); for (int rep = 0; rep < REPN(3); ++rep) stage_hy_pre(F, l, nrl); STAGE_END(sb + 2)
        STAGE(sb + 3) { pg8::SchedStatic S; S.init(ws + WS_ARW, wl + WO_RWCAT, T_ALL, 2560, 256, F.G, F.bid); pg8::EpiBf16 E{(bf16*)(ws + WS_P), 2560, nullptr, 0}; PT(4); pg8::gemm_phase(F.lds, F.tid, 256, S, E); PT(5); }
            F.tid = opaque_v((int)threadIdx.x); F.lane = F.tid & 63;
            STAGE_END(sb + 3)
        STAGE(sb + 4) for (int rep = 0; rep < REPN(5); ++rep) stage_rw_prep2(F, l); STAGE_END(sb + 4)
        STAGE(sb + 5) PT(10); stage_mixer(F, l); PT(11); STAGE_END(sb + 5) STAGE(sb + 5) PT(12); }
        STAGE(sb + 6) stage_s5_prep(F, l, nrl); STAGE_END(sb + 6)
        STAGE(sb + 7) { pg8::SchedStatic S; S.init(ws + WS_AS5, wl + WO_GLU, nrl, 1024, 512, F.G, F.bid); pg8::EpiGlu<0> E{(bf16*)(ws + WS_YS5), 512, F.a->in[I_S5GLUB] + l * 1024, 0, 512}; PT(13); pg8::gemm_phase(F.lds, F.tid, 512, S, E); PT(14); }
            for (int rep = 0; rep < REPN(7); ++rep) stage_rw_readout(F, l); for (int rep = 0; rep < REPN(8); ++rep) stage_hy_post(F, l, nrl); STAGE_END(sb + 7)
        STAGE(sb + 8) pg8::SchedMerge S; S.A0 = (const char*)(ws + WS_YHY); S.A1 = (const char*)(ws + WS_YRW); S.A2 = (const char*)(ws + WS_YS5); S.Bt = (const char*)(wl + WO_WBR); S.tstep = (size_t)256 * 512 * 2; S.bstride = (size_t)1024 * 512 * 2;
            S.nM = nrl / 256; S.nN = 4; S.G = F.G; S.c = F.bid;
            pg8::EpiMerge E{(bf16*)(ws + WS_MTMP), (bf16*)(ws + WS_H), (const bf16*)(ws + WS_Z) + GATE_OFF}; pg8::gemm_phase(F.lds, F.tid, 512, S, E); STAGE_END(sb + 8)
        STAGE(sb + 9) pg8::SchedStatic S; S.init(ws + WS_H, wl + WO_WOUT, nrl, 1024, 1024, F.G, F.bid); pg8::EpiResid E{(float*)(ws + WS_X), (const float*)(ws + WS_MOD) + (size_t)l * 9 * 6144 + 2048};
            pg8::gemm_phase(F.lds, F.tid, 1024, S, E); STAGE_END(sb + 9)
        STAGE(sb + 10) PT(17); stage_norm2_router(F, l, nrl); PT(18); STAGE_END(sb + 10)
        STAGE(sb + 11) LAS int* base = load_moe_base(F, l); moe_fix_pos(F, nrl, base);
            pg8::SchedMoeG S; S.A = (const char*)(ws + WS_H); S.rowof = (const unsigned*)(ws + WS_ROWOF); S.Bt = (const char*)(wl + WO_W1); S.tstep = (size_t)256 * 1024 * 2; S.estride = (size_t)2048 * 1024 * 2; S.NPN = 8; S.G = F.G; S.c = F.bid; S.base = base;
            pg8::EpiGlu<1> E{(bf16*)(ws + WS_ACT), 1024, F.a->in[I_B1] + (size_t)l * 32 * 2048, 2048, 1024}; pg8::gemm_phase(F.lds, F.tid, 1024, S, E); STAGE_END(sb + 11)
        STAGE(sb + 12) LAS int* base = load_moe_base(F, l);
            pg8::SchedMoe S; S.A = (const char*)(ws + WS_ACT); S.Bt = (const char*)(wl + WO_W2); S.tstep = (size_t)256 * 1024 * 2; S.estride = (size_t)1024 * 1024 * 2; S.NPN = 4; S.G = F.G; S.c = F.bid; S.base = base;
            pg8::EpiBf16 E{(bf16*)(ws + WS_XS), 1024, F.a->in[I_B2] + (size_t)l * 32 * 1024, 1024}; pg8::gemm_phase(F.lds, F.tid, 1024, S, E); STAGE_END(sb + 12)
    }
    lq = DEPTH;
    STAGE(NSTAGES - 1)
#ifndef PROBE_T
        stage_norm1(F, l);
#endif
#ifdef PROBE_T
        { const unsigned long long* st = (const unsigned long long*)(F.a->ws + WS_CTL + CW_STAMP * 4); const float cval = (float)(long long)(st[PROBE_B] - st[PROBE_A]) * (1.0f / (100.0f * PROBE_DIV));
          __syncthreads(); for (size_t i = (size_t)F.bid * NTHREADS + F.tid; i < (size_t)T_LAT * D; i += (size_t)F.G * NTHREADS) F.a->out[i] = cval; }
#endif
    }
#undef IN
#undef SEAM
}

extern "C" void kernel_launch(void* const* d_in, const int* in_sizes, int n_in, void* d_out, int out_size, void* d_ws, size_t ws_size, hipStream_t stream) {
    static int grid = 0;
    if (grid == 0) {
        if (n_in != 51 || out_size != T_LAT * D || ws_size < WS_END) { fprintf(stderr, "kernel_launch: unexpected shapes (n_in %d out %d ws %zu, need %zu)\n", n_in, out_size, ws_size, (size_t)WS_END); grid = -1; return; }
        int dev = 0, cus = 0, per_cu = 0;
        if (hipGetDevice(&dev) != hipSuccess || hipDeviceGetAttribute(&cus, hipDeviceAttributeMultiprocessorCount, dev) != hipSuccess) { grid = -1; return; }
        if (hipFuncSetAttribute((const void*)mk_fwd, hipFuncAttributeMaxDynamicSharedMemorySize, LDS_BYTES) != hipSuccess) { fprintf(stderr, "kernel_launch: hipFuncSetAttribute failed\n"); grid = -1; return; }
        if (hipOccupancyMaxActiveBlocksPerMultiprocessor(&per_cu, (const void*)mk_fwd, NTHREADS, LDS_BYTES) != hipSuccess || per_cu < 1) fprintf(stderr, "kernel_launch: occupancy query says %d\n", per_cu);
        (void)hipGetLastError();
        grid = cus;
    }
    if (grid < 0) return;
    if (hipMemsetAsync((char*)d_ws + WS_CTL, 0, CTL_ZERO_BYTES, stream) != hipSuccess) return;
    Args a{};
    for (int i = 0; i < 51; ++i) a.in[i] = (const float*)d_in[i];
    a.out = (float*)d_out; a.ws = (unsigned char*)d_ws;
#if MK_PER_STAGE
    for (int s = 0; s < NSTAGES; ++s) { a.ph_lo = s; a.ph_hi = s + 1; int reps = 1;
#ifdef PROBE_SET
        { const int ls = (s == 0 || s == NSTAGES - 1) ? -1 : (s - 1) % NSTAGE_L;
          if (PROBE_SET >= 1 && PROBE_SET <= 13 && ls == PROBE_SET - 1 && ls != 5 && ls != 8 && !(ls == 0 && s > 1)) reps = 3;
          if (PROBE_SET == 14 && s == 0) reps = 3; }
#endif
        for (int r = 0; r < reps; ++r) hipLaunchKernelGGL(mk_fwd, dim3(grid), dim3(NTHREADS), LDS_BYTES, stream, a); }
#else
    a.ph_lo = 0; a.ph_hi = NSTAGES; hipLaunchKernelGGL(mk_fwd, dim3(grid), dim3(NTHREADS), LDS_BYTES, stream, a);
#endif
}
```

```cpp
#include <hip/hip_runtime.h>
#include <cstdio>
#include <cstdint>

#ifndef DUPK
#define DUPK 0
#endif
#define REPN(k) ((DUPK == (k)) ? 3 : 1)
#ifndef REP_GEMM
#define REP_GEMM 1
#endif
#ifndef REP_LIGHT
#define REP_LIGHT 1
#endif
#ifndef REP_PRO
#define REP_PRO 1
#endif
#ifndef MK_PER_STAGE
#define MK_PER_STAGE 0
#endif

#define GAS __attribute__((address_space(1)))
#define LAS __attribute__((address_space(3)))
typedef unsigned short bf16;
typedef unsigned v4u __attribute__((ext_vector_type(4)));
typedef unsigned v2u __attribute__((ext_vector_type(2)));
typedef float f32x4 __attribute__((ext_vector_type(4)));
typedef float f32x2 __attribute__((ext_vector_type(2)));
typedef short bf16x8 __attribute__((ext_vector_type(8)));

constexpr int D = 1024, BATCH = 8, SEQ = 4096, CTXL = 256, DEPTH = 2;
constexpr int T_LAT = BATCH * SEQ, T_CTX = BATCH * CTXL, T_ALL = T_LAT + T_CTX;
constexpr int IN_COLS = 6912, HY_OFF = 0, RW_OFF = 1536, S5_OFF = 3328, GATE_OFF = 3840;
constexpr int NE = 32, TOPK = 4;
constexpr int MAXSLOT = 147456;
constexpr int NWAVES = 8, NTHREADS = 512;
constexpr int HY_MARG = 128, HY_ROWB = 8720, HY_RLEN = 8272, HY_RLENC = 592;
constexpr int HY_R1_OFF = 8 * HY_ROWB, HY_R2_OFF = HY_R1_OFF + HY_RLEN * 2;

constexpr size_t MiB = 1ull << 20;
constexpr size_t WS_CTL = 0, CTL_ZERO_BYTES = 1 * MiB;
constexpr size_t WS_MOD = 1 * MiB;
constexpr size_t WS_BLKCNT = 2 * MiB;
constexpr size_t WS_META = 2 * MiB + 512 * 1024;
constexpr size_t WS_ROWOF = 480 * MiB;
constexpr int CW_CNT = 24576;
constexpr size_t WS_EIDX = 3 * MiB, WS_GATE = 4 * MiB, WS_POS = 5 * MiB;
constexpr size_t WS_WTS = 8 * MiB, WL_STRIDE = 214 * MiB;
constexpr size_t WO_WIN = 0, WO_RWCAT = 14 * MiB, WO_GLU = 16 * MiB, WO_WBR = 17 * MiB, WO_WOUT = 20 * MiB, WO_W1 = 22 * MiB, WO_W2 = 150 * MiB;
constexpr size_t WS_GF = 436 * MiB, GF_STRIDE = 20 * MiB, GF_CTX = 17 * MiB;
constexpr size_t WS_X = 504 * MiB;
constexpr size_t WS_H = 640 * MiB;
constexpr size_t WS_BIG = 708 * MiB;
constexpr size_t WS_Z = WS_BIG;
constexpr size_t WS_SCN = 1167 * MiB;
constexpr size_t WS_MTMP = WS_SCN;
constexpr size_t WS_P = 1473 * MiB;
constexpr size_t WS_ARW = 1643 * MiB;
constexpr size_t WS_YDIR = 1660 * MiB;
constexpr size_t WS_YP = 1898 * MiB;
constexpr size_t WS_UT = 1796 * MiB;
constexpr size_t WS_AS5 = 2000 * MiB;
constexpr size_t WS_YHY = 1898 * MiB, WS_YRW = 1932 * MiB, WS_YS5 = 1966 * MiB;
constexpr size_t WS_XS = WS_BIG;
constexpr size_t WS_ACT = WS_BIG + 288 * MiB;
constexpr size_t WS_END = 2034 * MiB;
constexpr int CW_BAR = 4096;

constexpr int RING_BYTES = 131072;
constexpr int LDSCTL_OFF = RING_BYTES;
constexpr int LDS_BYTES = 163840;

typedef __bf16 bf16x2_t __attribute__((ext_vector_type(2)));
__device__ __forceinline__ unsigned pk2(float lo, float hi) { const bf16x2_t v = __builtin_convertvector((f32x2){lo, hi}, bf16x2_t); return __builtin_bit_cast(unsigned, v); }
__device__ __forceinline__ unsigned f2bf(float f) { return pk2(f, 0.f) & 0xffffu; }
__device__ __forceinline__ float bf2f(bf16 b) { return __builtin_bit_cast(float, ((unsigned)b) << 16); }
__device__ __forceinline__ float bflo(unsigned w) { return __builtin_bit_cast(float, w << 16); }
__device__ __forceinline__ float bfhi(unsigned w) { return __builtin_bit_cast(float, w & 0xffff0000u); }
__device__ __forceinline__ float sigm(float x) { return __builtin_amdgcn_rcpf(1.f + __expf(-x)); }
__device__ __forceinline__ float tanh_fast(float x) { const float e = __expf(2.f * x); return 1.f - 2.f * __builtin_amdgcn_rcpf(e + 1.f); }
#define LDS_WAIT() asm volatile("s_waitcnt lgkmcnt(0)" ::: "memory")
__device__ __forceinline__ float dpp_f(float x, const int ctrl_sel) {
    const int v = __builtin_bit_cast(int, x);
    int r;
    if (ctrl_sel == 0) r = __builtin_amdgcn_update_dpp(0, v, 0xB1, 0xF, 0xF, true);
    else if (ctrl_sel == 1) r = __builtin_amdgcn_update_dpp(0, v, 0x4E, 0xF, 0xF, true);
    else r = __builtin_amdgcn_update_dpp(0, v, 0x141, 0xF, 0xF, true);
    return __builtin_bit_cast(float, r);
}
__device__ __forceinline__ float red32(float x) {
    x += dpp_f(x, 0); x += dpp_f(x, 1); x += dpp_f(x, 2);
    x += __builtin_bit_cast(float, __builtin_amdgcn_update_dpp(0, __builtin_bit_cast(int, x), 0x128, 0xF, 0xF, true));
    x += __builtin_bit_cast(float, __builtin_amdgcn_ds_swizzle(__builtin_bit_cast(int, x), 0x401F));
    return x;
}
__device__ __forceinline__ float wave_sum(float v) {
    v = red32(v);
    return __builtin_bit_cast(float, __builtin_amdgcn_readlane(__builtin_bit_cast(int, v), 0)) + __builtin_bit_cast(float, __builtin_amdgcn_readlane(__builtin_bit_cast(int, v), 32));
}
__device__ __forceinline__ int xch32(int v, const int step) {
    if (step == 0) return __builtin_amdgcn_update_dpp(0, v, 0xB1, 0xF, 0xF, true);
    if (step == 1) return __builtin_amdgcn_update_dpp(0, v, 0x4E, 0xF, 0xF, true);
    if (step == 2) return __builtin_amdgcn_update_dpp(0, v, 0x141, 0xF, 0xF, true);
    if (step == 3) return __builtin_amdgcn_update_dpp(0, v, 0x128, 0xF, 0xF, true);
    return __builtin_amdgcn_ds_swizzle(v, 0x401F);
}
__device__ __forceinline__ float red8(float x) { x += dpp_f(x, 0); x += dpp_f(x, 1); x += dpp_f(x, 2); return x; }

#define XB_TMO      128
#define XB_XCNT(j)  (256  + 64 * (j))
#define XB_XSUB(j)  (1280 + 64 * (j))
#define XB_XGEN(j)  (2304 + 64 * (j))
#define XB_TOP      3328
#define XB_TOPGEN   3392
#define XCD_BAR_WORDS 3456
#define XB_SPIN_CAP (1u << 22)
__device__ __forceinline__ unsigned xb_ld(unsigned* p)              { return __hip_atomic_load(p, __ATOMIC_RELAXED, __HIP_MEMORY_SCOPE_AGENT); }
__device__ __forceinline__ unsigned xb_add(unsigned* p, unsigned v) { return __hip_atomic_fetch_add(p, v, __ATOMIC_RELAXED, __HIP_MEMORY_SCOPE_AGENT); }
__device__ __forceinline__ unsigned xb_xcc_id() { return (unsigned)__builtin_amdgcn_s_getreg((3 << 11) | 20) & 0xFu; }
#define XB_SPIN(cond, bar) do { unsigned _sp = 0; while (cond) { __builtin_amdgcn_s_sleep(1); \
    if ((++_sp & 255u) == 0u) { if (xb_ld(&(bar)[XB_TMO])) break; if (_sp > XB_SPIN_CAP) { atomicAdd(&(bar)[XB_TMO], 1u); break; } } } } while (0)
struct XcdBarrier { unsigned* bar; unsigned x; volatile LAS unsigned* st; };
__device__ __forceinline__ XcdBarrier xcd_barrier_post(unsigned* bar, volatile LAS unsigned* st) {
    XcdBarrier b; b.bar = bar; b.x = xb_xcc_id(); b.st = st;
    if (threadIdx.x == 0) (void)xb_add(&bar[XB_XCNT(b.x)], 1u);
    return b;
}
__device__ __forceinline__ void xcd_barrier_complete(unsigned* bar, unsigned x, unsigned& nloc, unsigned& nx) {
    const unsigned G = gridDim.x * gridDim.y * gridDim.z;
    unsigned sum, cnt, mine, sp = 0u;
    for (;;) {
        sum = 0u; cnt = 0u; mine = 0u;
#pragma unroll
        for (unsigned j = 0; j < 16; ++j) { const unsigned c = xb_ld(&bar[XB_XCNT(j)]); sum += c; cnt += (c > 0u) ? 1u : 0u; mine = (j == x) ? c : mine; }
        if (sum == G) break;
        __builtin_amdgcn_s_sleep(1);
        if ((++sp & 255u) == 0u) { if (xb_ld(&bar[XB_TMO])) break; if (sp > XB_SPIN_CAP) { atomicAdd(&bar[XB_TMO], 1u); break; } }
    }
    nloc = mine > 0u ? mine : 1u; nx = cnt > 0u ? cnt : 1u;
}
__device__ __forceinline__ void xcd_barrier(const XcdBarrier& b) {
    asm volatile("s_waitcnt vmcnt(0)" ::: "memory");
    __syncthreads();
    if (threadIdx.x == 0) {
        unsigned* bar = b.bar;
        __builtin_amdgcn_s_waitcnt(0);
        unsigned nloc = b.st[0], nx = b.st[1];
        if (nloc == 0u) { xcd_barrier_complete(bar, b.x, nloc, nx); b.st[0] = nloc; b.st[1] = nx; }
        const unsigned old = xb_add(&bar[XB_XSUB(b.x)], 1u);
        const unsigned gen = old / nloc;
        if (old + 1u == (gen + 1u) * nloc) {
            __builtin_amdgcn_fence(__ATOMIC_RELEASE, "agent");
            asm volatile("s_waitcnt vmcnt(0)" ::: "memory");
            const unsigned og = xb_add(&bar[XB_TOP], 1u);
            const unsigned tg = og / nx;
            if (og + 1u == (tg + 1u) * nx) xb_add(&bar[XB_TOPGEN], 1u);
            else XB_SPIN(xb_ld(&bar[XB_TOPGEN]) == tg, bar);
            __builtin_amdgcn_fence(__ATOMIC_ACQUIRE, "agent");
            xb_add(&bar[XB_XGEN(b.x)], 1u);
            asm volatile("s_waitcnt vmcnt(0)" ::: "memory");
        } else {
            XB_SPIN(xb_ld(&bar[XB_XGEN(b.x)]) == gen, bar);
            __builtin_amdgcn_fence(__ATOMIC_ACQUIRE, "agent");
            asm volatile("s_waitcnt vmcnt(0)" ::: "memory");
        }
    }
    __syncthreads();
}

namespace pg8 {
constexpr int MOE_CAP = 34816;
constexpr int BM = 256, BK = 64, HALF = 128, HTB = HALF * BK * 2, STAGE_BYTES = 8 * HTB, NXCD = 8, WGM = 8, ROWTAB_OFF = 131072 + 4096;
__host__ __device__ __forceinline__ int lds_byte(int r, int c) { const int st = (r >> 4) * 2 + (c >> 5), rr = r & 15, cc = c & 31, ob = rr * 64 + cc * 2; return st * 1024 + (ob ^ (((ob >> 9) & 1) << 5)); }
__host__ __device__ __forceinline__ void stage_rc(int b, int& R, int& C) { const int st = b / 1024, sb = b % 1024, swz = sb ^ (((sb >> 9) & 1) << 5); R = (st >> 1) * 16 + swz / 64; C = (st & 1) * 32 + (swz % 64) / 2; }
__host__ __device__ __forceinline__ int perm32(int rho) { const int n = rho >> 4, i = rho & 15; return 8 * (i >> 2) + 4 * n + (i & 3); }
struct Unit { int pm, pn, e; };
__device__ __forceinline__ unsigned cvt_pk_bf16(float lo, float hi) { return pk2(lo, hi); }

__device__ __forceinline__ void tile_of(int L, int nM, int nN, int& pm, int& pn) {
    const int nwg = nM * nN; int wgid = L;
    { const int q = nwg / NXCD, r = nwg % NXCD, xcd = wgid % NXCD, off = wgid / NXCD; wgid = (xcd < r ? xcd * (q + 1) : r * (q + 1) + (xcd - r) * q) + off; }
    const int nig = WGM * nN, gid = wgid / nig, fm = gid * WGM, gsz = (nM - fm) < WGM ? (nM - fm) : WGM;
    pm = fm + ((wgid % nig) % gsz); pn = (wgid % nig) / gsz;
}
struct SchedStatic {
    static constexpr bool GATHER = false;
    const char* A; const char* Bt; size_t tstep; int nM, nN, G, c;
    __device__ __forceinline__ void init(const void* A_, const void* Bt_, int M, int N, int K, int G_, int c_) { A = (const char*)A_; Bt = (const char*)Bt_; tstep = (size_t)BM * K * 2; nM = M / BM; nN = N / BM; G = G_; c = c_; }
    __device__ __forceinline__ bool next(int i, Unit& u) const { const long L = (long)i * G + c; if (L >= (long)nM * nN) return false; tile_of((int)L, nM, nN, u.pm, u.pn); u.e = 0; return true; }
    __device__ __forceinline__ const char* aptr(const Unit& u) const { return A + (size_t)u.pm * tstep; }
    __device__ __forceinline__ const char* bptr(const Unit& u) const { return Bt + (size_t)u.pn * tstep; }
};
struct SchedWin {
    static constexpr bool GATHER = false;
    const char* A; const char* Bt; size_t tstep; int G, c, part;
    __device__ __forceinline__ bool next(int i, Unit& u) const {
        const int L = i * G + c, nmf = part ? 128 : 136, nfull = nmf * 27; u.e = 0;
        if (L < nfull) { tile_of(L, nmf, 27, u.pm, u.pn); return true; }
        const int L2 = L - nfull; if (!part || L2 >= 8 * 9) return false;
        u.pm = 128 + L2 / 9; u.pn = 6 + L2 % 9; return true; }
    __device__ __forceinline__ const char* aptr(const Unit& u) const { return A + (size_t)u.pm * tstep; }
    __device__ __forceinline__ const char* bptr(const Unit& u) const { return Bt + (size_t)u.pn * tstep; }
};
struct SchedMerge {
    static constexpr bool GATHER = false;
    const char* A0; const char* A1; const char* A2; const char* Bt; size_t tstep, bstride; int nM, nN, G, c;
    __device__ __forceinline__ bool next(int i, Unit& u) const { const int j = i / 3, br = i - 3 * j; const long L = (long)j * G + c; if (L >= (long)nM * nN) return false; tile_of((int)L, nM, nN, u.pm, u.pn); u.e = br; return true; }
    __device__ __forceinline__ const char* aptr(const Unit& u) const { return (u.e == 0 ? A0 : (u.e == 1 ? A1 : A2)) + (size_t)u.pm * tstep; }
    __device__ __forceinline__ const char* bptr(const Unit& u) const { return Bt + (size_t)u.e * bstride + (size_t)u.pn * tstep; }
};
struct SchedMoe {
    static constexpr bool GATHER = false;
    const char* A; const char* Bt; size_t tstep, estride; int NPN, G, c; const LAS int* base;
    __device__ __forceinline__ bool next(int i, Unit& u) const {
        const int ntiles = base[32] >> 8; const int per = G >> 3;
        const long L = (long)i * G + (((G & 7) == 0) ? (c & 7) * per + (c >> 3) : c);
        if (L >= (long)ntiles * NPN) return false;
        u.pm = (int)(L / NPN); u.pn = (int)(L % NPN); const int r0 = u.pm << 8; int e = 0;
#pragma unroll 1
        for (int k = 1; k < 32; ++k) e += (r0 >= base[k]) ? 1 : 0;
        u.e = e; return true;
    }
    __device__ __forceinline__ const char* aptr(const Unit& u) const { return A + (size_t)u.pm * tstep; }
    __device__ __forceinline__ const char* bptr(const Unit& u) const { return Bt + (size_t)u.e * estride + (size_t)u.pn * tstep; }
};
struct SchedMoeG : SchedMoe {
    static constexpr bool GATHER = true;
    const unsigned* rowof;
    __device__ __forceinline__ const char* aptr(const Unit&) const { return A; }
    __device__ __forceinline__ const unsigned* rowptr(const Unit& u) const { return rowof + (size_t)u.e * MOE_CAP + ((u.pm << 8) - base[u.e]); }
    __device__ __forceinline__ int valid(const Unit& u) const { return base[64 + u.e] - ((u.pm << 8) - base[u.e]); }
};

template <class Epi, class Sched>
__device__ __forceinline__ void gemm_phase(LAS unsigned char* lds, const int tid, const int K, const Sched& S, const Epi& E) {
    const int wid = __builtin_amdgcn_readfirstlane(tid >> 6), lane = tid & 63, wr = wid >> 2, wc = wid & 3, fr = lane & 15, fq = lane >> 4;
    const int nt = K / BK;
    unsigned voffA[2], voffB[2];
#pragma unroll
    for (int i = 0; i < 2; ++i) { int R, C; stage_rc(tid * 16 + i * 8192, R, C); const int Rb = Epi::PERM ? ((R & ~31) + perm32(R & 31)) : R;
        voffA[i] = (unsigned)(R * K + C) * 2u; voffB[i] = (unsigned)(Rb * K + C) * 2u; }
    const size_t kstep = (size_t)(BK * 2);
    const size_t hstep = (size_t)HALF * K * 2;
    const unsigned ldsw = (unsigned)wid * 1024u;
    const int aoff = lds_byte(wr * 64 + fr, fq * 8), boff = lds_byte(wc * 32 + fr, fq * 8);
#define PG8_SA(b, h) (((b) * 2 + (h)) * HTB)
#define PG8_SB(b, h) ((4 + (b) * 2 + (h)) * HTB)
#define PG8_STAGE(bufoff, gbase, voff) do { _Pragma("unroll") for (int _i = 0; _i < 2; ++_i) \
        __builtin_amdgcn_global_load_lds((const unsigned*)((const char*)(gbase) + (voff)[_i]), (LAS unsigned*)(lds + (bufoff) + ldsw + _i * 8192), 16, 0, 0); } while (0)
#define PG8_STAGEA(bufoff, kp, h) do { if constexpr (Sched::GATHER) { _Pragma("unroll") for (int _i = 0; _i < 2; ++_i) \
        __builtin_amdgcn_global_load_lds((const unsigned*)((const char*)(kp) + g[2 * (h) + _i]), (LAS unsigned*)(lds + (bufoff) + ldsw + _i * 8192), 16, 0, 0); } \
        else { PG8_STAGE(bufoff, (kp) + (h) * hstep, voffA); } } while (0)
#define PG8_GLOAD(un_, buf) do { const LAS unsigned* rt_ = (const LAS unsigned*)(lds + ROWTAB_OFF + (buf) * 1024) + gR0; const int nv_ = S.valid(un_); \
        _Pragma("unroll") for (int _j = 0; _j < 4; ++_j) g[_j] = ((gR0 + 64 * _j < nv_) ? rt_[64 * _j] : 0u) + gCb; } while (0)
#define PG8_GDMA(un_, buf) do { if (wid == 0) { unsigned lo_ = (unsigned)threadIdx.x; asm volatile("" : "+v"(lo_)); lo_ = (lo_ & 63u) * 16u; \
        __builtin_amdgcn_global_load_lds((const unsigned*)((const char*)S.rowptr(un_) + lo_), (LAS unsigned*)(lds + ROWTAB_OFF + (buf) * 1024), 16, 0, 0); } } while (0)
#define PG8_LDA(dst, b, h) do { _Pragma("unroll") for (int m = 0; m < 4; ++m) _Pragma("unroll") for (int k = 0; k < 2; ++k) dst[m][k] = *(const LAS bf16x8*)(lds + PG8_SA(b, h) + aoff + m * 2048 + k * 1024); } while (0)
#define PG8_LDB(dst, b, h) do { _Pragma("unroll") for (int n = 0; n < 2; ++n) _Pragma("unroll") for (int k = 0; k < 2; ++k) dst[n][k] = *(const LAS bf16x8*)(lds + PG8_SB(b, h) + boff + n * 2048 + k * 1024); } while (0)
#define PG8_MMA(ai, bj, At, Bt) do { __builtin_amdgcn_s_setprio(1); _Pragma("unroll") for (int m = 0; m < 4; ++m) _Pragma("unroll") for (int n = 0; n < 2; ++n) _Pragma("unroll") for (int k = 0; k < 2; ++k) \
        acc[ai][bj][m][n] = __builtin_amdgcn_mfma_f32_16x16x32_bf16(Bt[n][k], At[m][k], acc[ai][bj][m][n], 0, 0, 0); __builtin_amdgcn_s_setprio(0); } while (0)
#define PG8_WAIT_V(n) asm volatile("s_waitcnt vmcnt(" #n ")" ::: "memory")
#define PG8_WAIT_L(n) asm volatile("s_waitcnt lgkmcnt(" #n ")" ::: "memory")
#define PG8_BAR __builtin_amdgcn_s_barrier()
#define PG8_SCHED __builtin_amdgcn_sched_barrier(0)
    Unit cur, nxt; int ui = 0;
    if (!S.next(0, cur)) return;
    f32x4 acc[2][2][4][2];
#pragma unroll
    for (int a = 0; a < 2; ++a)
#pragma unroll
        for (int b = 0; b < 2; ++b)
#pragma unroll
            for (int m = 0; m < 4; ++m)
#pragma unroll
                for (int n = 0; n < 2; ++n) acc[a][b][m][n] = (f32x4){0.f, 0.f, 0.f, 0.f};
    bf16x8 At[4][2], B0[2][2], B1[2][2];
    const char* cA = S.aptr(cur); const char* cB = S.bptr(cur);
    unsigned g[4] = {0u, 0u, 0u, 0u}; int gR0 = 0; unsigned gCb = 0u;
    if constexpr (Sched::GATHER) { int R, C; stage_rc(tid * 16, R, C); gR0 = R; gCb = (unsigned)C * 2u;
        PG8_GDMA(cur, 0); PG8_WAIT_V(0); PG8_BAR; PG8_GLOAD(cur, 0); }
    PG8_STAGE(PG8_SB(0, 0), cB, voffB); PG8_STAGE(PG8_SB(0, 1), cB + hstep, voffB); PG8_STAGEA(PG8_SA(0, 0), cA, 0); PG8_STAGEA(PG8_SA(0, 1), cA, 1);
    if (wr == 1) PG8_BAR;
    PG8_WAIT_V(2); PG8_BAR;
    PG8_STAGE(PG8_SB(1, 0), cB + kstep, voffB); PG8_STAGEA(PG8_SA(1, 0), cA + kstep, 0); PG8_STAGE(PG8_SB(1, 1), cB + hstep + kstep, voffB);
    PG8_WAIT_V(6); PG8_BAR;
    for (;;) {
        const bool has_next = S.next(ui + 1, nxt);
        const char* nA = has_next ? S.aptr(nxt) : cA; const char* nB = has_next ? S.bptr(nxt) : cB;
        if constexpr (Sched::GATHER) { if (has_next) PG8_GDMA(nxt, (ui + 1) & 1); }
        for (int t = 0; t < nt; t += 2) {
            const bool last = (t == nt - 2);
            const char* a1 = cA + (size_t)(t + 1) * kstep;
            const char* a2 = last ? nA : cA + (size_t)(t + 2) * kstep; const char* b2 = last ? nB : cB + (size_t)(t + 2) * kstep;
            const char* a3 = a2 + kstep; const char* b3 = b2 + kstep;
            PG8_LDB(B0, 0, 0); PG8_LDB(B1, 0, 1); PG8_SCHED; PG8_LDA(At, 0, 0); PG8_STAGEA(PG8_SA(1, 1), a1, 1);
            PG8_WAIT_V(8); PG8_WAIT_L(0); PG8_BAR; PG8_MMA(0, 0, At, B0); PG8_MMA(0, 1, At, B1); PG8_BAR; PG8_SCHED;
            if constexpr (Sched::GATHER) { if (last && has_next) PG8_GLOAD(nxt, (ui + 1) & 1); PG8_SCHED; }
            PG8_LDA(At, 0, 1); PG8_STAGE(PG8_SB(0, 0), b2, voffB); PG8_STAGE(PG8_SB(0, 1), b2 + hstep, voffB); PG8_STAGEA(PG8_SA(0, 0), a2, 0);
            PG8_WAIT_V(8); PG8_WAIT_L(0); PG8_BAR; PG8_MMA(1, 0, At, B0); PG8_MMA(1, 1, At, B1); PG8_BAR; PG8_SCHED;
            PG8_LDB(B0, 1, 0); PG8_LDB(B1, 1, 1); PG8_SCHED; PG8_LDA(At, 1, 0); PG8_STAGEA(PG8_SA(0, 1), a2, 1);
            PG8_WAIT_V(8); PG8_WAIT_L(0); PG8_BAR; PG8_MMA(0, 0, At, B0); PG8_MMA(0, 1, At, B1); PG8_BAR; PG8_SCHED;
            PG8_LDA(At, 1, 1); PG8_STAGE(PG8_SB(1, 0), b3, voffB); PG8_STAGE(PG8_SB(1, 1), b3 + hstep, voffB); PG8_STAGEA(PG8_SA(1, 0), a3, 0);
            PG8_WAIT_V(8); PG8_WAIT_L(0); PG8_BAR; PG8_MMA(1, 0, At, B0); PG8_MMA(1, 1, At, B1); PG8_BAR; PG8_SCHED;
        }
        if (wr == 0) PG8_BAR;
        { int t2_ = (int)threadIdx.x; asm volatile("" : "+v"(t2_)); E(acc, cur, wr, wc, t2_ & 15, (t2_ >> 4) & 3); }
        if (!has_next) break;
#pragma unroll
        for (int a = 0; a < 2; ++a)
#pragma unroll
            for (int b = 0; b < 2; ++b)
#pragma unroll
                for (int m = 0; m < 4; ++m)
#pragma unroll
                    for (int n = 0; n < 2; ++n) acc[a][b][m][n] = (f32x4){0.f, 0.f, 0.f, 0.f};
        cur = nxt; cA = nA; cB = nB; ++ui;
        if (wr == 1) PG8_BAR;
    }
    PG8_WAIT_V(0);
    PG8_BAR;
#undef PG8_SA
#undef PG8_SB
#undef PG8_STAGE
#undef PG8_STAGEA
#undef PG8_GLOAD
#undef PG8_GDMA
#undef PG8_LDA
#undef PG8_LDB
#undef PG8_MMA
#undef PG8_WAIT_V
#undef PG8_WAIT_L
#undef PG8_BAR
#undef PG8_SCHED
}

struct EpiBf16 {
    static constexpr bool PERM = true;
    bf16* O; int ldc; const float* bias; int bias_stride;
    __device__ __forceinline__ void operator()(const f32x4 (&acc)[2][2][4][2], const Unit& u, int wr, int wc, int fr, int fq) const {
        const int row0 = u.pm * BM + wr * 64 + fr, col0 = u.pn * BM + wc * 32 + 8 * fq;
        f32x4 bv[2][2];
#pragma unroll
        for (int bj = 0; bj < 2; ++bj)
#pragma unroll
            for (int n = 0; n < 2; ++n) bv[bj][n] = bias ? *(const f32x4*)(bias + (size_t)u.e * bias_stride + col0 + bj * HALF + 4 * n) : (f32x4){0.f, 0.f, 0.f, 0.f};
#pragma unroll
        for (int ai = 0; ai < 2; ++ai)
#pragma unroll
            for (int m = 0; m < 4; ++m) { bf16* rowp = O + (size_t)(row0 + ai * HALF + m * 16) * ldc + col0;
#pragma unroll
                for (int bj = 0; bj < 2; ++bj) { const f32x4 v0 = acc[ai][bj][m][0] + bv[bj][0], v1 = acc[ai][bj][m][1] + bv[bj][1];
                    v4u w; w.x = cvt_pk_bf16(v0[0], v0[1]); w.y = cvt_pk_bf16(v0[2], v0[3]); w.z = cvt_pk_bf16(v1[0], v1[1]); w.w = cvt_pk_bf16(v1[2], v1[3]);
                    *(v4u*)(rowp + bj * HALF) = w; } }
    }
};
template <int MODE> struct EpiGlu {
    static constexpr bool PERM = true;
    bf16* O; int ldc; const float* bias; int bias_stride, hs;
    __device__ __forceinline__ void operator()(const f32x4 (&acc)[2][2][4][2], const Unit& u, int wr, int wc, int fr, int fq) const {
        const int row0 = u.pm * BM + wr * 64 + fr, col0 = u.pn * HALF + wc * 32 + 8 * fq;
        const float* bp = bias + (size_t)u.e * bias_stride + col0;
        f32x4 ba[2], bb[2];
#pragma unroll
        for (int n = 0; n < 2; ++n) { ba[n] = *(const f32x4*)(bp + 4 * n); bb[n] = *(const f32x4*)(bp + hs + 4 * n); }
#pragma unroll
        for (int ai = 0; ai < 2; ++ai)
#pragma unroll
            for (int m = 0; m < 4; ++m) { bf16* rowp = O + (size_t)(row0 + ai * HALF + m * 16) * ldc + col0;
                float o[8];
#pragma unroll
                for (int n = 0; n < 2; ++n) { const f32x4 a = acc[ai][0][m][n] + ba[n], b = acc[ai][1][m][n] + bb[n];
#pragma unroll
                    for (int j = 0; j < 4; ++j) {
                        if (MODE == 0) o[4 * n + j] = a[j] * sigm(b[j]);
                        else { const float g = fminf(a[j], 7.f), up = fminf(fmaxf(b[j], -7.f), 7.f); o[4 * n + j] = (up + 1.f) * g * sigm(1.702f * g); } } }
                v4u w; w.x = cvt_pk_bf16(o[0], o[1]); w.y = cvt_pk_bf16(o[2], o[3]); w.z = cvt_pk_bf16(o[4], o[5]); w.w = cvt_pk_bf16(o[6], o[7]);
                *(v4u*)rowp = w; }
    }
};
struct EpiMerge {
    static constexpr bool PERM = true;
    bf16* mtmp; bf16* Mo; const bf16* zg;
    __device__ __forceinline__ void operator()(const f32x4 (&acc)[2][2][4][2], const Unit& u, int wr, int wc, int fr, int fq) const {
        const int row0 = u.pm * BM + wr * 64 + fr, col0 = u.pn * BM + wc * 32 + 8 * fq;
#pragma unroll
        for (int ai = 0; ai < 2; ++ai)
#pragma unroll
            for (int m = 0; m < 4; ++m) { const size_t r = (size_t)(row0 + ai * HALF + m * 16);
#pragma unroll
                for (int bj = 0; bj < 2; ++bj) { const int c = col0 + bj * HALF;
                    const v4u gz = *(const v4u*)(zg + r * IN_COLS + u.e * 1024 + c);
                    float g[8] = {bflo(gz.x), bfhi(gz.x), bflo(gz.y), bfhi(gz.y), bflo(gz.z), bfhi(gz.z), bflo(gz.w), bfhi(gz.w)};
                    f32x4 t0, t1; bf16* tp = mtmp + r * 1024 + c;
                    if (u.e == 0) { t0 = (f32x4){0.f, 0.f, 0.f, 0.f}; t1 = t0; } else { const v4u pv = *(const v4u*)tp; t0 = (f32x4){bflo(pv.x), bfhi(pv.x), bflo(pv.y), bfhi(pv.y)}; t1 = (f32x4){bflo(pv.z), bfhi(pv.z), bflo(pv.w), bfhi(pv.w)}; }
#pragma unroll
                    for (int j = 0; j < 4; ++j) { t0[j] += sigm(g[j]) * acc[ai][bj][m][0][j]; t1[j] += sigm(g[4 + j]) * acc[ai][bj][m][1][j]; }
                    if (u.e < 2) { v4u w; w.x = cvt_pk_bf16(t0[0], t0[1]); w.y = cvt_pk_bf16(t0[2], t0[3]); w.z = cvt_pk_bf16(t1[0], t1[1]); w.w = cvt_pk_bf16(t1[2], t1[3]); *(v4u*)tp = w; }
                    else { v4u w; w.x = cvt_pk_bf16(t0[0], t0[1]); w.y = cvt_pk_bf16(t0[2], t0[3]); w.z = cvt_pk_bf16(t1[0], t1[1]); w.w = cvt_pk_bf16(t1[2], t1[3]);
                        *(v4u*)(Mo + r * 1024 + c) = w; } } }
    }
};
struct EpiResid {
    static constexpr bool PERM = false;
    float* X; const float* gmod;
    __device__ __forceinline__ void operator()(const f32x4 (&acc)[2][2][4][2], const Unit& u, int wr, int wc, int fr, int fq) const {
        const int row0 = u.pm * BM + wr * 64 + fr, col0 = u.pn * BM + wc * 32 + 4 * fq;
        const int r00 = u.pm * BM; const int w = r00 < T_LAT ? (r00 >> 12) : 8;
        f32x4 gv[2][2];
#pragma unroll
        for (int bj = 0; bj < 2; ++bj)
#pragma unroll
            for (int n = 0; n < 2; ++n) gv[bj][n] = *(const f32x4*)(gmod + (size_t)w * 6144 + col0 + bj * HALF + n * 16);
#pragma unroll
        for (int ai = 0; ai < 2; ++ai)
#pragma unroll
            for (int m = 0; m < 4; ++m) { float* rowp = X + (size_t)(row0 + ai * HALF + m * 16) * 1024 + col0;
#pragma unroll
                for (int bj = 0; bj < 2; ++bj)
#pragma unroll
                    for (int n = 0; n < 2; ++n) { f32x4* p = (f32x4*)(rowp + bj * HALF + n * 16); *p = *p + gv[bj][n] * acc[ai][bj][m][n]; } }
    }
};
}

struct Args { const float* in[51]; float* out; unsigned char* ws; int ph_lo, ph_hi; };
enum { I_X = 0, I_C, I_CTX, I_CCTX, I_ADAW, I_ADAB, I_N1G, I_N2G, I_WIN, I_HYCW, I_HYCB, I_HYW1, I_HYB1, I_HYF1, I_HYW2, I_HYB2, I_HYF2, I_HYW3, I_HYB3, I_HYBIAS,
       I_RWCW, I_RWCB, I_RWWUP, I_RWW0, I_RWAUP, I_RWA0, I_RWGUP, I_RWKK, I_RWKA, I_RWRK, I_RWLNG, I_RWLNB, I_S5ARE, I_S5AIM, I_S5LDT, I_S5BRE, I_S5BIM, I_S5CRE, I_S5CIM, I_S5D,
       I_S5GLUW, I_S5GLUB, I_WBR, I_WOUT, I_RTW, I_RTB, I_W1, I_B1, I_W2, I_B2, I_FING };

typedef const __attribute__((address_space(4))) Args* CArgsP;
__device__ __forceinline__ CArgsP kargs() { CArgsP p = (CArgsP)__builtin_amdgcn_kernarg_segment_ptr(); asm volatile("" : "+s"(p)); return p; }
__device__ __forceinline__ int opaque(int v) { asm volatile("" : "+s"(v)); return v; }
__device__ __forceinline__ int opaque_v(int v) { asm volatile("" : "+v"(v)); return v; }
struct Ctx { CArgsP a; LAS unsigned char* lds; int tid, lane, wave, bid, G; };

__device__ __forceinline__ void row_seq(int row, int& base, int& pos, int& n) {
    if (row < T_LAT) { base = row & ~(SEQ - 1); pos = row & (SEQ - 1); n = SEQ; }
    else { const int r = row - T_LAT; base = T_LAT + (r & ~(CTXL - 1)); pos = r & (CTXL - 1); n = CTXL; }
}
__device__ __forceinline__ float conv3z(const bf16* zc, int pos, int n, float w0, float w1, float w2, float b) {
    const float zm = pos > 0 ? bf2f(zc[(size_t)(pos - 1) * IN_COLS]) : 0.f, z0 = bf2f(zc[(size_t)pos * IN_COLS]), zp = pos < n - 1 ? bf2f(zc[(size_t)(pos + 1) * IN_COLS]) : 0.f;
    return zm * w0 + z0 * w1 + zp * w2 + b;
}

template <int MODE>
__device__ __forceinline__ void transpose_item(const float* W, int K, int N, bf16* WT, int Hs, LAS float* scr, int item, int lane) {
    const int nblk = N / 32, kb = item / nblk, nb = item % nblk, k0 = 64 * kb, n0 = 32 * nb;
#pragma unroll 8
    for (int i = 0; i < 32; ++i) { const int kk = 2 * i + (lane >> 5); scr[kk * 33 + (lane & 31)] = W[(size_t)(k0 + kk) * N + n0 + (lane & 31)]; }
    LDS_WAIT(); asm volatile("" ::: "memory");
    const int c = lane & 7;
#pragma unroll
    for (int j = 0; j < 4; ++j) { const int n = (lane >> 3) + 8 * j; const LAS float* s = scr + (8 * c) * 33 + n;
        v4u o; o.x = pk2(s[0 * 33], s[1 * 33]); o.y = pk2(s[2 * 33], s[3 * 33]); o.z = pk2(s[4 * 33], s[5 * 33]); o.w = pk2(s[6 * 33], s[7 * 33]);
        int dr = n0 + n;
        if (MODE == 1) { const int nc = n0 + n; const int jx = nc < Hs ? nc : nc - Hs; dr = (jx >> 7) * 256 + (nc < Hs ? 0 : 128) + (jx & 127); }
        *(v4u*)(WT + (size_t)dr * K + k0 + 8 * c) = o; }
    LDS_WAIT(); asm volatile("" ::: "memory");
}

__device__ __forceinline__ void p0_prologue(const Ctx& F) {
    const auto& a = *F.a; unsigned char* ws = a.ws;
    const int gw = F.bid * NWAVES + F.wave, NGW = F.G * NWAVES, lane = F.lane;
    float* X = (float*)(ws + WS_X);
    for (int t = gw; t < SEQ; t += NGW) {
        const float pr = (float)(t >> 6), pc = (float)(t & 63);
        f32x4 pe[4];
#pragma unroll
        for (int j = 0; j < 4; ++j)
#pragma unroll
            for (int e = 0; e < 4; ++e) { const float om = __builtin_amdgcn_exp2f((float)(4 * lane + e) * (-13.287712379549449f / 256.0f)); const float ang = ((j < 2) ? pr : pc) * om; pe[j][e] = (j & 1) ? __cosf(ang) : __sinf(ang); }
#pragma unroll 2
        for (int bb = 0; bb < BATCH; ++bb) { const size_t row = (size_t)bb * SEQ + t;
            const f32x4* xi = (const f32x4*)(a.in[I_X] + row * D) + lane; f32x4* xo = (f32x4*)(X + row * D) + lane;
#pragma unroll
            for (int j = 0; j < 4; ++j) xo[64 * j] = xi[64 * j] + pe[j]; }
    }
    for (int row = T_LAT + gw; row < T_ALL; row += NGW) {
        const f32x4* xi = (const f32x4*)(a.in[I_CTX] + (size_t)(row - T_LAT) * D) + lane; f32x4* xo = (f32x4*)(X + (size_t)row * D) + lane;
#pragma unroll
        for (int j = 0; j < 4; ++j) xo[64 * j] = xi[64 * j];
    }
    {
        LAS float* condl = (LAS float*)F.lds; LAS float* psum = (LAS float*)(F.lds + 40960);
        for (int i = F.tid; i < 9 * 1024; i += NTHREADS) { const int w = i >> 10, k = i & 1023; const float cv = (w < 8) ? a.in[I_C][w * 1024 + k] : a.in[I_CCTX][k]; condl[i] = cv / (1.f + expf(-cv)); }
        __syncthreads();
        float* MOD = (float*)(ws + WS_MOD);
        for (int it = F.bid; it < 2 * 96; it += F.G) {
            const int l = it / 96, cg = it % 96, col = cg * 64 + lane;
            float acc[9];
#pragma unroll
            for (int w = 0; w < 9; ++w) acc[w] = 0.f;
            const float* wp = a.in[I_ADAW] + ((size_t)l * 1024 + F.wave * 128) * 6144 + col;
#pragma unroll 1
            for (int k0 = 0; k0 < 128; k0 += 16) { float wv[16];
#pragma unroll
                for (int k = 0; k < 16; ++k) wv[k] = wp[(size_t)(k0 + k) * 6144];
#pragma unroll
                for (int k = 0; k < 16; ++k)
#pragma unroll
                    for (int w = 0; w < 9; ++w) acc[w] += condl[w * 1024 + F.wave * 128 + k0 + k] * wv[k]; }
#pragma unroll
            for (int w = 0; w < 9; ++w) psum[(F.wave * 9 + w) * 64 + lane] = acc[w];
            __syncthreads();
            if (F.wave == 0) {
#pragma unroll
                for (int w = 0; w < 9; ++w) { float s = 0.f;
#pragma unroll
                    for (int wv = 0; wv < 8; ++wv) s += psum[(wv * 9 + w) * 64 + lane];
                    MOD[(size_t)(l * 9 + w) * 6144 + col] = s + a.in[I_ADAB][l * 6144 + col]; }
            }
            __syncthreads();
        }
    }
    {
        LAS float* scr = (LAS float*)(F.lds + F.wave * 16384);
        constexpr int IT_W1 = 16 * 64, IT_W2 = 16 * 32, IT_WIN = 16 * 216, IT_GLU = 8 * 32, IT_WBR = 8 * 32, IT_WOUT = 16 * 32;
        constexpr int N_W1 = 64 * IT_W1, N_W2 = 64 * IT_W2, N_WIN = 2 * IT_WIN, N_GLU = 2 * IT_GLU, N_WBR = 6 * IT_WBR, N_WOUT = 2 * IT_WOUT;
        constexpr int NITEMS = N_W1 + N_W2 + N_WIN + N_GLU + N_WBR + N_WOUT;
        for (int it = gw; it < NITEMS; it += NGW) {
            int r = it;
            if (r < N_W1) { const int mtx = r / IT_W1, l = mtx >> 5, e = mtx & 31; transpose_item<1>(a.in[I_W1] + (size_t)mtx * 1024 * 2048, 1024, 2048, (bf16*)(ws + WS_WTS + l * WL_STRIDE + WO_W1) + (size_t)e * 2048 * 1024, 1024, scr, r % IT_W1, lane); continue; } r -= N_W1;
            if (r < N_W2) { const int mtx = r / IT_W2, l = mtx >> 5, e = mtx & 31; transpose_item<0>(a.in[I_W2] + (size_t)mtx * 1024 * 1024, 1024, 1024, (bf16*)(ws + WS_WTS + l * WL_STRIDE + WO_W2) + (size_t)e * 1024 * 1024, 0, scr, r % IT_W2, lane); continue; } r -= N_W2;
            if (r < N_WIN) { const int l = r / IT_WIN; transpose_item<0>(a.in[I_WIN] + (size_t)l * 1024 * IN_COLS, 1024, IN_COLS, (bf16*)(ws + WS_WTS + l * WL_STRIDE + WO_WIN), 0, scr, r % IT_WIN, lane); continue; } r -= N_WIN;
            if (r < N_GLU) { const int l = r / IT_GLU; transpose_item<1>(a.in[I_S5GLUW] + (size_t)l * 512 * 1024, 512, 1024, (bf16*)(ws + WS_WTS + l * WL_STRIDE + WO_GLU), 512, scr, r % IT_GLU, lane); continue; } r -= N_GLU;
            if (r < N_WBR) { const int mtx = r / IT_WBR, l = mtx / 3, br = mtx % 3; transpose_item<0>(a.in[I_WBR] + (size_t)mtx * 512 * 1024, 512, 1024, (bf16*)(ws + WS_WTS + l * WL_STRIDE + WO_WBR) + (size_t)br * 1024 * 512, 0, scr, r % IT_WBR, lane); continue; } r -= N_WBR;
            { const int l = r / IT_WOUT; transpose_item<0>(a.in[I_WOUT] + (size_t)l * 1024 * 1024, 1024, 1024, (bf16*)(ws + WS_WTS + l * WL_STRIDE + WO_WOUT), 0, scr, r % IT_WOUT, lane); }
        }
        for (int i = F.bid * NTHREADS + F.tid; i < 2 * 2560 * 256; i += F.G * NTHREADS) {
            const int l = i / (2560 * 256), r = i % (2560 * 256), n = r >> 8, k = r & 255; float v = 0.f;
            if (n < 1024) { if (k < 64) v = a.in[I_RWWUP][(((size_t)l * 2 + (n >> 9)) * 64 + k) * 512 + (n & 511)]; }
            else if (n < 2048) { if (k >= 64 && k < 128) v = a.in[I_RWAUP][(((size_t)l * 2 + ((n - 1024) >> 9)) * 64 + (k - 64)) * 512 + (n & 511)]; }
            else { if (k >= 128) v = a.in[I_RWGUP][((size_t)l * 128 + (k - 128)) * 512 + (n - 2048)]; }
            ((bf16*)(ws + WS_WTS + l * WL_STRIDE + WO_RWCAT))[r] = (bf16)f2bf(v);
        }
    }
    __syncthreads();
    {
        LAS float* feats = (LAS float*)F.lds; LAS float* h1 = feats + 8 * 33; LAS float* h2 = h1 + 8 * 64;
        constexpr int NIT = 2 * (512 + 32);
        for (int it = F.bid; it < NIT; it += F.G) {
            const int l = it / 544, r = it % 544, nsel = r >= 512, n = nsel ? CTXL : SEQ, p0 = (nsel ? r - 512 : r) * 8;
            if (l == DEPTH - 1 && nsel) continue;
            if (F.tid < 8 * 33) { const int p = F.tid / 33, i = F.tid % 33, pos = p0 + p; float f;
                if (i == 0) f = (float)pos / (float)(n - 1);
                else { const int k = (i - 1) & 15; const float band = 1e-4f + (float)k * ((15.0f - 1e-4f) / 15.0f); const float ang = (6.283185307179586f * (float)pos / (float)n) * band; f = (i <= 16) ? cosf(ang) : -sinf(ang); }
                feats[p * 33 + i] = f; }
            __syncthreads();
            { const int p = F.tid >> 6, j = F.tid & 63; float s = a.in[I_HYB1][l * 64 + j]; const float* w1p = a.in[I_HYW1] + (size_t)l * 33 * 64 + j;
#pragma unroll
                for (int i = 0; i < 33; ++i) s += feats[p * 33 + i] * w1p[i * 64];
                h1[p * 64 + j] = sinf(a.in[I_HYF1][l * 64 + j] * s); }
            __syncthreads();
            { const int p = F.tid >> 6, j = F.tid & 63; float s = a.in[I_HYB2][l * 64 + j];
                const float* w2p = a.in[I_HYW2] + (size_t)l * 64 * 64 + j;
#pragma unroll 16
                for (int i = 0; i < 64; ++i) s += h1[p * 64 + i] * w2p[i * 64];
                h2[p * 64 + j] = sinf(a.in[I_HYF2][l * 64 + j] * s); }
            __syncthreads();
            float acc[4][8];
#pragma unroll
            for (int q = 0; q < 4; ++q)
#pragma unroll
                for (int p = 0; p < 8; ++p) acc[q][p] = 0.f;
            const float* w3 = a.in[I_HYW3] + (size_t)l * 64 * 2048 + F.tid;
#pragma unroll 8
            for (int i = 0; i < 64; ++i) { float wv[4];
#pragma unroll
                for (int q = 0; q < 4; ++q) wv[q] = w3[(size_t)i * 2048 + q * 512];
#pragma unroll
                for (int p = 0; p < 8; ++p) { const float hv = h2[p * 64 + i];
#pragma unroll
                    for (int q = 0; q < 4; ++q) acc[q][p] += hv * wv[q]; } }
            const int c = F.tid; const float dstart = logf(0.01f) / 1.5f, dstop = logf(0.01f) / 0.3f; const float delta = fabsf(dstart + (float)c * ((dstop - dstart) / 511.0f));
            const int RL = nsel ? HY_RLENC : HY_RLEN, off = n + 47; const float rn1 = 1.0f / (float)(n - 1);
            bf16* Rb = (bf16*)(ws + WS_GF + l * GF_STRIDE + (nsel ? GF_CTX : 0));
#pragma unroll
            for (int q = 0; q < 4; ++q) { const int o = q >> 1, side = q & 1; const float b3 = a.in[I_HYB3][l * 2048 + q * 512 + c];
                bf16* Rc = Rb + ((size_t)o * 512 + c) * RL;
#pragma unroll
                for (int p = 0; p < 8; ++p) { const int pos = p0 + p; const float t = (float)pos * rn1; const float val = (acc[q][p] + b3) * __expf(-t * delta);
                    if (side == 0) Rc[off - pos] = (bf16)f2bf(val);
                    else if (pos >= 1) Rc[off + pos] = (bf16)f2bf(val); }
                if (p0 == 0 && side == 0) { for (int m = 0; m < 48; ++m) Rc[m] = 0; for (int m = off + n; m < RL; ++m) Rc[m] = 0; } }
            __syncthreads();
        }
    }
}

__device__ __forceinline__ void stage_norm1(const Ctx& F, int l) {
    const auto& a = *F.a; unsigned char* ws = a.ws; const int lane = F.lane;
    const int gw = F.bid * NWAVES + F.wave, NGW = F.G * NWAVES;
    float* X = (float*)(ws + WS_X); bf16* H = (bf16*)(ws + WS_H); const float* MOD = (const float*)(ws + WS_MOD);
    const bf16* YS = (const bf16*)(ws + WS_XS); const int* POS = (const int*)(ws + WS_POS); const float* GATE = (const float*)(ws + WS_GATE);
    const int nrows = (l == DEPTH) ? T_LAT : T_ALL;
    f32x4 ngv[4];
    { const f32x4* ngp = (l == DEPTH) ? (const f32x4*)a.in[I_FING] + lane : (const f32x4*)(a.in[I_N1G] + l * D) + lane;
#pragma unroll
      for (int j = 0; j < 4; ++j) ngv[j] = ngp[64 * j]; }
    f32x4 vn[4]; v2u ysn[4][4]; int4 pnn = make_int4(0, 0, 0, 0); f32x4 gn = (f32x4){0.f, 0.f, 0.f, 0.f}, gnn = gn;
#pragma unroll
    for (int k = 0; k < 4; ++k)
#pragma unroll
        for (int j = 0; j < 4; ++j) ysn[k][j] = (v2u){0u, 0u};
#define N1_LDYS(p4_) do { const int pk_[4] = {(p4_).x, (p4_).y, (p4_).z, (p4_).w}; _Pragma("unroll") for (int k = 0; k < 4; ++k) { const v2u* yr_ = (const v2u*)(YS + (size_t)pk_[k] * D) + lane; \
        _Pragma("unroll") for (int j = 0; j < 4; ++j) ysn[k][j] = yr_[64 * j]; } } while (0)
    if (gw < nrows) {
#pragma unroll
        for (int j = 0; j < 4; ++j) vn[j] = ((const f32x4*)(X + (size_t)gw * D) + lane)[64 * j];
        if (l > 0) { const int4 p0 = *(const int4*)(POS + gw * 4); gn = *(const f32x4*)(GATE + gw * 4);
            if (gw + NGW < nrows) { pnn = *(const int4*)(POS + (gw + NGW) * 4); gnn = *(const f32x4*)(GATE + (gw + NGW) * 4); }
            N1_LDYS(p0); } }
#pragma unroll 1
    for (int row = gw; row < nrows; row += NGW) {
        const int w = row < T_LAT ? (row >> 12) : 8;
        f32x4* xr = (f32x4*)(X + (size_t)row * D) + lane;
        f32x4 v[4]; v2u ysc[4][4];
#pragma unroll
        for (int j = 0; j < 4; ++j) v[j] = vn[j];
#pragma unroll
        for (int k = 0; k < 4; ++k)
#pragma unroll
            for (int j = 0; j < 4; ++j) ysc[k][j] = ysn[k][j];
        const f32x4 gc = gn; const int4 pnx = pnn; gn = gnn;
        const int rn = row + NGW, rnn = row + 2 * NGW;
        if (rn < nrows) {
#pragma unroll
            for (int j = 0; j < 4; ++j) vn[j] = ((const f32x4*)(X + (size_t)rn * D) + lane)[64 * j];
            if (l > 0) N1_LDYS(pnx); }
        if (l > 0 && rnn < nrows) { pnn = *(const int4*)(POS + rnn * 4); gnn = *(const f32x4*)(GATE + rnn * 4); }
        f32x4 m0[4], m1[4], m2[4];
        if (l < DEPTH) {
#pragma unroll
            for (int j = 0; j < 4; ++j) { m0[j] = ((const f32x4*)(MOD + (size_t)(l * 9 + w) * 6144) + lane)[64 * j]; m1[j] = ((const f32x4*)(MOD + (size_t)(l * 9 + w) * 6144 + 1024) + lane)[64 * j]; } }
        if (l > 0) {
#pragma unroll
            for (int j = 0; j < 4; ++j) m2[j] = ((const f32x4*)(MOD + (size_t)((l - 1) * 9 + w) * 6144 + 5120) + lane)[64 * j];
            f32x4 mo[4];
#pragma unroll
            for (int j = 0; j < 4; ++j) mo[j] = (f32x4){0.f, 0.f, 0.f, 0.f};
#pragma unroll
            for (int k = 0; k < TOPK; ++k) { const float g = gc[k];
#pragma unroll
                for (int j = 0; j < 4; ++j) { const v2u y = ysc[k][j]; mo[j][0] += g * bflo(y.x); mo[j][1] += g * bfhi(y.x); mo[j][2] += g * bflo(y.y); mo[j][3] += g * bfhi(y.y); } }
#pragma unroll
            for (int j = 0; j < 4; ++j) { v[j] = v[j] + m2[j] * mo[j]; if (l < DEPTH) xr[64 * j] = v[j]; }
        }
        float ss = 0.f;
#pragma unroll
        for (int j = 0; j < 4; ++j) ss += (v[j][0] * v[j][0] + v[j][1] * v[j][1]) + (v[j][2] * v[j][2] + v[j][3] * v[j][3]);
        const float rstd = __builtin_amdgcn_rsqf(wave_sum(ss) * (1.f / D) + 1e-6f);
        if (l == DEPTH) {
            f32x4* o = (f32x4*)(a.out + (size_t)row * D) + lane;
#pragma unroll
            for (int j = 0; j < 4; ++j) o[64 * j] = v[j] * rstd * ngv[j];
        } else {
            v2u* ho = (v2u*)(H + (size_t)row * D) + lane;
#pragma unroll
            for (int j = 0; j < 4; ++j) { const f32x4 h = v[j] * rstd * ngv[j] * (m1[j] + 1.0f) + m0[j]; v2u o; o.x = pk2(h[0], h[1]); o.y = pk2(h[2], h[3]); ho[64 * j] = o; }
        }
    }
#undef N1_LDYS
}

__device__ __forceinline__ void stage_rw_prep1(const Ctx& F, int l) {
    const auto& a = *F.a; unsigned char* ws = a.ws;
    const bf16* __restrict__ Z = (const bf16*)(ws + WS_Z); bf16* __restrict__ ARW = (bf16*)(ws + WS_ARW);
    const int j = 4 * (F.tid & 63), col = 1536 + j, rq = F.tid >> 6;
    const float* cw = a.in[I_RWCW] + (size_t)l * 3 * 1792;
    const f32x4 w0 = *(const f32x4*)(cw + col), w1 = *(const f32x4*)(cw + 1792 + col), w2 = *(const f32x4*)(cw + 2 * 1792 + col), cb = *(const f32x4*)(a.in[I_RWCB] + l * 1792 + col);
#pragma unroll 4
    for (int row = F.bid * 8 + rq; row < T_ALL; row += F.G * 8) {
        int base, pos, n; row_seq(row, base, pos, n);
        const bf16* zc = Z + (size_t)row * IN_COLS + RW_OFF + col;
        const v2u z0 = *(const v2u*)zc;
        v2u zm = (v2u){0u, 0u}, zp = (v2u){0u, 0u};
        if (pos > 0) zm = *(const v2u*)(zc - IN_COLS);
        if (pos < n - 1) zp = *(const v2u*)(zc + IN_COLS);
        f32x4 v = (f32x4){bflo(zm.x), bfhi(zm.x), bflo(zm.y), bfhi(zm.y)} * w0 + (f32x4){bflo(z0.x), bfhi(z0.x), bflo(z0.y), bfhi(z0.y)} * w1 + (f32x4){bflo(zp.x), bfhi(zp.x), bflo(zp.y), bfhi(zp.y)} * w2 + cb;
#pragma unroll
        for (int e2 = 0; e2 < 4; ++e2) { if (j < 64) v[e2] = tanh_fast(v[e2]); else if (j >= 128) v[e2] = sigm(v[e2]); }
        v2u o; o.x = pk2(v[0], v[1]); o.y = pk2(v[2], v[3]);
        *(v2u*)(ARW + (size_t)row * 256 + j) = o;
    }
}

__device__ __forceinline__ void stage_rw_prep2(const Ctx& F, int l) {
    const auto& a = *F.a; unsigned char* ws = a.ws; const int lane = F.lane;
    const bf16* Z = (const bf16*)(ws + WS_Z); const bf16* P = (const bf16*)(ws + WS_P); bf16* SCN = (bf16*)(ws + WS_SCN);
    const int gw = F.bid * NWAVES + F.wave, NGW = F.G * NWAVES;
    constexpr int TR = 17, NRT = T_ALL / TR;
    const float* cw = a.in[I_RWCW] + (size_t)l * 3 * 1792; const float* cbp = a.in[I_RWCB] + l * 1792;
    for (int tile = gw; tile < NRT * 4; tile += NGW) {
        const int rt = tile % NRT, hp = tile / NRT, row0 = rt * TR, c0 = hp * 128 + 2 * lane;
        f32x2 w[3][3], cb[3];
#pragma unroll
        for (int s = 0; s < 3; ++s) { cb[s] = *(const f32x2*)(cbp + s * 512 + c0);
#pragma unroll
            for (int j = 0; j < 3; ++j) w[s][j] = *(const f32x2*)(cw + j * 1792 + s * 512 + c0); }
        const f32x2 KKw = *(const f32x2*)(a.in[I_RWKK] + l * 512 + c0), KAw = *(const f32x2*)(a.in[I_RWKA] + l * 512 + c0);
        f32x2 W0[2], A0[2];
#pragma unroll
        for (int d = 0; d < 2; ++d) { W0[d] = *(const f32x2*)(a.in[I_RWW0] + (l * 2 + d) * 512 + c0); A0[d] = *(const f32x2*)(a.in[I_RWA0] + (l * 2 + d) * 512 + c0); }
        const unsigned* zb = (const unsigned*)(Z + RW_OFF + c0);
        unsigned zw[8][3], pw_[8][4];
#define P2_LDZ(j_) do { const int rr_ = row0 + (j_); if (rr_ >= 0 && rr_ < T_ALL) { _Pragma("unroll") for (int s = 0; s < 3; ++s) zw[((j_) + 1) & 7][s] = zb[(size_t)rr_ * (IN_COLS / 2) + s * 256]; } \
        else { _Pragma("unroll") for (int s = 0; s < 3; ++s) zw[((j_) + 1) & 7][s] = 0u; } } while (0)
#define P2_LDP(j_) do { const unsigned* pr_ = (const unsigned*)(P + (size_t)(row0 + (j_)) * 2560 + c0); pw_[(j_) & 7][0] = pr_[0]; pw_[(j_) & 7][1] = pr_[512]; pw_[(j_) & 7][2] = pr_[256]; pw_[(j_) & 7][3] = pr_[768]; } while (0)
        P2_LDZ(-1); P2_LDZ(0); P2_LDZ(1); P2_LDZ(2); P2_LDZ(3); P2_LDP(0); P2_LDP(1); P2_LDP(2);
#pragma unroll
        for (int i = 0; i < TR; ++i) {
            const int row = row0 + i; int base, pos, n; row_seq(row, base, pos, n);
            if (i + 4 <= TR) P2_LDZ(i + 4);
            if (i + 3 < TR) P2_LDP(i + 3);
            unsigned zm[3], z0[3], zp[3], pc_[4];
#pragma unroll
            for (int s = 0; s < 3; ++s) { zm[s] = zw[i & 7][s]; z0[s] = zw[(i + 1) & 7][s]; zp[s] = zw[(i + 2) & 7][s]; }
#pragma unroll
            for (int e = 0; e < 4; ++e) pc_[e] = pw_[i & 7][e];
            const float mlo = pos > 0 ? 1.f : 0.f, mhi = pos < n - 1 ? 1.f : 0.f;
            f32x2 u[3];
#pragma unroll
            for (int s = 0; s < 3; ++s) u[s] = (f32x2){bflo(zm[s]), bfhi(zm[s])} * mlo * w[s][0] + (f32x2){bflo(z0[s]), bfhi(z0[s])} * w[s][1] + (f32x2){bflo(zp[s]), bfhi(zp[s])} * mhi * w[s][2] + cb[s];
            const f32x2 r = u[0], k = u[1], v = u[2];
            f32x2 kk = k * KKw;
            const float ss = red32(kk[0] * kk[0] + kk[1] * kk[1]);
            kk = kk * (__builtin_amdgcn_rsqf(fmaxf(ss, 1e-24f)));
            unsigned* o = (unsigned*)(SCN + (size_t)row * 9 * 512 + c0);
            o[0] = pk2(r[0], r[1]); o[256] = pk2(v[0], v[1]); o[2 * 256] = pk2(kk[0], kk[1]);
#pragma unroll
            for (int d = 0; d < 2; ++d) {
                const unsigned pw = pc_[2 * d], pa = pc_[2 * d + 1];
                float ld[2], kd[2], be[2];
#pragma unroll
                for (int e = 0; e < 2; ++e) {
                    const float uu = W0[d][e] + (e ? bfhi(pw) : bflo(pw));
                    ld[e] = -0.60653065971263342f * sigm(uu);
                    const float av = sigm(A0[d][e] + (e ? bfhi(pa) : bflo(pa)));
                    kd[e] = k[e] * (1.f + (av - 1.f) * KAw[e]); be[e] = kk[e] * av; }
                o[(3 + 3 * d) * 256] = pk2(ld[0], ld[1]); o[(4 + 3 * d) * 256] = pk2(kd[0], kd[1]); o[(5 + 3 * d) * 256] = pk2(be[0], be[1]);
            }
        }
    }
}
#undef P2_LDZ
#undef P2_LDP

__device__ __forceinline__ int seq_row(int b, int d, int sidx) {
    if (sidx < CTXL) { const int t = d ? (CTXL - 1 - sidx) : sidx; return T_LAT + b * CTXL + t; }
    const int tl = sidx - CTXL; const int t = d ? (SEQ - 1 - tl) : tl; return b * SEQ + t;
}

constexpr int CW_WORK = 16384;
constexpr int CW_STAMP = 20480;
#ifdef PROBE_T
#ifndef PROBE_BID
#define PROBE_BID 0
#endif
#define PT(k) do { if (F.bid == PROBE_BID && F.tid == 0 && l == 0) ((unsigned long long*)(F.a->ws + WS_CTL + CW_STAMP * 4))[k] = __builtin_amdgcn_s_memrealtime(); } while (0)
#else
#define PT(k) do { } while (0)
#endif
__device__ __forceinline__ void rw_scan_item(const Ctx& F, int l, int it2) {
    const int it = it2 >> 1, half = it2 & 1;
    const auto& a = *F.a; unsigned char* ws = a.ws; const int tid = F.tid, lane = F.lane;
    const bf16* SCN = (const bf16*)(ws + WS_SCN); float* YD = (float*)(ws + WS_YDIR);
    LAS float* sbuf = (LAS float*)F.lds;
    LAS float* ybuf = (LAS float*)(F.lds + 49152);
    const bool comp = F.wave < 4;
    const int lt = tid & 255, ls = lt >> 4, lj = lt & 15;
    const int vl = lane >> 3, kq = lane & 7, vrow = half * 32 + (F.wave & 3) * 8 + vl;
    constexpr int NCH = (CTXL + SEQ) / 16;
    const int d = it & 1, h = (it >> 1) & 7, b = it >> 4;
    f32x2 S[4];
#pragma unroll
    for (int q = 0; q < 4; ++q) S[q] = (f32x2){0.f, 0.f};
    v2u ldr[6];
#define RW_ISSUE(c) do { const int row_ = seq_row(b, d, (c) * 16 + ls); const v2u* p_ = (const v2u*)(SCN + (size_t)row_ * 9 * 512 + h * 64) + lj; \
        ldr[0] = p_[2 * 128]; ldr[1] = p_[(3 + 3 * d) * 128]; ldr[2] = p_[(5 + 3 * d) * 128]; ldr[3] = p_[(4 + 3 * d) * 128]; ldr[4] = p_[0]; ldr[5] = p_[128]; } while (0)
#define RW_WRITE(bufi) do { LAS float* o_ = sbuf + (((bufi) * 16 + ls) * 6) * 64 + 4 * lj; \
        *(LAS f32x4*)(o_) = (f32x4){-bflo(ldr[0].x), -bfhi(ldr[0].x), -bflo(ldr[0].y), -bfhi(ldr[0].y)}; \
        *(LAS f32x4*)(o_ + 64) = (f32x4){__expf(bflo(ldr[1].x)), __expf(bfhi(ldr[1].x)), __expf(bflo(ldr[1].y)), __expf(bfhi(ldr[1].y))}; \
        *(LAS f32x4*)(o_ + 128) = (f32x4){bflo(ldr[2].x), bfhi(ldr[2].x), bflo(ldr[2].y), bfhi(ldr[2].y)}; *(LAS f32x4*)(o_ + 192) = (f32x4){bflo(ldr[3].x), bfhi(ldr[3].x), bflo(ldr[3].y), bfhi(ldr[3].y)}; \
        *(LAS f32x4*)(o_ + 256) = (f32x4){bflo(ldr[4].x), bfhi(ldr[4].x), bflo(ldr[4].y), bfhi(ldr[4].y)}; *(LAS f32x4*)(o_ + 320) = (f32x4){bflo(ldr[5].x), bfhi(ldr[5].x), bflo(ldr[5].y), bfhi(ldr[5].y)}; } while (0)
#define RW_FLUSH(c) do { const int row_ = seq_row(b, d, (c) * 16 + ls); \
        *(f32x2*)(YD + ((size_t)d * T_ALL + row_) * 512 + h * 64 + half * 32 + 2 * lj) = *(const LAS f32x2*)(ybuf + ((((c) & 1) * 16 + ls) * 64) + half * 32 + 2 * lj); } while (0)
    if (!comp) { RW_ISSUE(0); RW_WRITE(0); RW_ISSUE(1); }
    __syncthreads();
#pragma unroll 1
    for (int c = 0; c < NCH; ++c) {
        const int bi = c & 1;
        if (!comp) {
            if (c + 1 < NCH) RW_WRITE(bi ^ 1);
            if (c + 2 < NCH) RW_ISSUE(c + 2);
            if (c > 0) RW_FLUSH(c - 1);
        } else {
        float yv[16];
        f32x4 opA[10], opB[10]; float vvA, vvB;
#define RW_LD(op, vvx, s_) do { const LAS float* sp_ = sbuf + ((bi * 16 + (s_)) * 6) * 64 + 8 * kq; \
            _Pragma("unroll") for (int q_ = 0; q_ < 5; ++q_) { op[2 * q_] = *(const LAS f32x4*)(sp_ + 64 * q_); op[2 * q_ + 1] = *(const LAS f32x4*)(sp_ + 64 * q_ + 4); } \
            vvx = sbuf[((bi * 16 + (s_)) * 6 + 5) * 64 + vrow]; } while (0)
#define RW_COMP(op, vvx, s_) do { \
            const f32x4 a0 = op[0], a1 = op[1], w0 = op[2], w1 = op[3], b0 = op[4], b1 = op[5], k0 = op[6], k1 = op[7], r0 = op[8], r1 = op[9]; \
            const f32x2 vv2 = (f32x2){vvx, vvx}; \
            const f32x2 p0 = S[1] * (f32x2){a0[2], a0[3]} + S[0] * (f32x2){a0[0], a0[1]}; \
            const f32x2 p1 = S[3] * (f32x2){a1[2], a1[3]} + S[2] * (f32x2){a1[0], a1[1]}; \
            const f32x2 t0 = S[0] * (f32x2){w0[0], w0[1]} + vv2 * (f32x2){k0[0], k0[1]}; \
            const f32x2 t1 = S[1] * (f32x2){w0[2], w0[3]} + vv2 * (f32x2){k0[2], k0[3]}; \
            const f32x2 t2 = S[2] * (f32x2){w1[0], w1[1]} + vv2 * (f32x2){k1[0], k1[1]}; \
            const f32x2 t3 = S[3] * (f32x2){w1[2], w1[3]} + vv2 * (f32x2){k1[2], k1[3]}; \
            const f32x2 ac = p0 + p1; \
            const float sa = red8(ac[0] + ac[1]); \
            const f32x2 sa2 = (f32x2){sa, sa}; \
            S[0] = sa2 * (f32x2){b0[0], b0[1]} + t0; S[1] = sa2 * (f32x2){b0[2], b0[3]} + t1; \
            S[2] = sa2 * (f32x2){b1[0], b1[1]} + t2; S[3] = sa2 * (f32x2){b1[2], b1[3]} + t3; \
            const f32x2 q0 = S[1] * (f32x2){r0[2], r0[3]} + S[0] * (f32x2){r0[0], r0[1]}; \
            const f32x2 q1 = S[3] * (f32x2){r1[2], r1[3]} + S[2] * (f32x2){r1[0], r1[1]}; \
            const f32x2 yc = q0 + q1; \
            yv[s_] = red8(yc[0] + yc[1]); } while (0)
        RW_LD(opA, vvA, 0);
#pragma unroll
        for (int s = 0; s < 16; s += 2) {
            RW_LD(opB, vvB, s + 1);
            __builtin_amdgcn_sched_barrier(0);
            RW_COMP(opA, vvA, s);
            __builtin_amdgcn_sched_barrier(0);
            if (s + 2 < 16) RW_LD(opA, vvA, s + 2);
            __builtin_amdgcn_sched_barrier(0);
            RW_COMP(opB, vvB, s + 1);
            __builtin_amdgcn_sched_barrier(0);
        }
#undef RW_LD
#undef RW_COMP
#pragma unroll
        for (int s = 0; s < 16; ++s) if ((s & 7) == kq) ybuf[((bi * 16 + s) * 64) + vrow] = yv[s];
        }
        __syncthreads();
    }
    if (!comp) RW_FLUSH(NCH - 1);
    __syncthreads();
#undef RW_ISSUE
#undef RW_WRITE
#undef RW_FLUSH
}

constexpr size_t WS_RWSCR = WS_YHY;
constexpr int RWS_QY = 0, RWS_YV = 2048, RWS_PZ = 4096, RWS_ZV = 12288, RWS_SLOT = 20480;
typedef __bf16 bf16x8n __attribute__((ext_vector_type(8)));
__device__ __forceinline__ f32x4 mma16(const bf16x8 a, const bf16x8 b, const f32x4 c) { return __builtin_amdgcn_mfma_f32_16x16x32_bf16(a, b, c, 0, 0, 0); }
__device__ __forceinline__ float dpp_shr(float x, const int n) {
    const int v = __builtin_bit_cast(int, x); int r;
    if (n == 1) r = __builtin_amdgcn_update_dpp(0, v, 0x111, 0xF, 0xF, true); else if (n == 2) r = __builtin_amdgcn_update_dpp(0, v, 0x112, 0xF, 0xF, true);
    else if (n == 4) r = __builtin_amdgcn_update_dpp(0, v, 0x114, 0xF, 0xF, true); else r = __builtin_amdgcn_update_dpp(0, v, 0x118, 0xF, 0xF, true);
    return __builtin_bit_cast(float, r);
}
__device__ __forceinline__ v4u pack8(const float (&x)[8]) { v4u o; o.x = pk2(x[0], x[1]); o.y = pk2(x[2], x[3]); o.z = pk2(x[4], x[5]); o.w = pk2(x[6], x[7]); return o; }
__device__ __forceinline__ void unpack8(const v4u u, float (&x)[8]) { x[0] = bflo(u.x); x[1] = bfhi(u.x); x[2] = bflo(u.y); x[3] = bfhi(u.y); x[4] = bflo(u.z); x[5] = bfhi(u.z); x[6] = bflo(u.w); x[7] = bfhi(u.w); }
constexpr int LDS_ZERO16 = 131072 + 3072;
typedef short bf16x4s __attribute__((ext_vector_type(4)));
__device__ __forceinline__ bf16x4s frag16k(const LAS bf16* m, int rowbase, int lane) { return __builtin_bit_cast(bf16x4s, *(const LAS v2u*)(m + (rowbase + (lane & 15)) * 16 + 4 * (lane >> 4))); }
__device__ __forceinline__ f32x4 mma16(const bf16x4s a, const bf16x4s b, const f32x4 c) { return __builtin_amdgcn_mfma_f32_16x16x16bf16_1k(a, b, c, 0, 0, 0); }
#define frag16(m_, rb_, ln_) frag16k(m_, rb_, ln_)
__device__ __forceinline__ void st_colmaj(LAS bf16* m, int colbase, const f32x4 d, int lane) {
    v2u o; o.x = pk2(d[0], d[1]); o.y = pk2(d[2], d[3]); *(LAS v2u*)(m + (colbase + (lane & 15)) * 16 + 4 * (lane >> 4)) = o; }
__device__ __forceinline__ void st_rowmaj(LAS bf16* m, const f32x4 d, int lane) {
#pragma unroll
    for (int r = 0; r < 4; ++r) m[(4 * (lane >> 4) + r) * 16 + (lane & 15)] = (bf16)f2bf(d[r]); }
template <int KS0, int KS1>
__device__ __forceinline__ void rw_chunk_load(const Ctx& F, int b, int h, int d, int cidx, v4u (&raw)[12]) {
    const int lane = opaque_v(F.lane), t = lane & 15, kg = lane >> 4;
    const bf16* base = (const bf16*)(F.a->ws + WS_SCN) + (size_t)seq_row(b, d, 16 * cidx + t) * 9 * 512 + h * 64;
#pragma unroll
    for (int ks = KS0; ks < KS1; ++ks) { const int off = 32 * ks + 8 * kg;
        raw[6 * ks + 0] = *(const v4u*)(base + (3 + 3 * d) * 512 + off); raw[6 * ks + 1] = *(const v4u*)(base + 2 * 512 + off); raw[6 * ks + 2] = *(const v4u*)(base + off);
        raw[6 * ks + 3] = *(const v4u*)(base + (5 + 3 * d) * 512 + off); raw[6 * ks + 4] = *(const v4u*)(base + (4 + 3 * d) * 512 + off); raw[6 * ks + 5] = *(const v4u*)(base + 512 + off); }
}
__device__ __forceinline__ void rw_chunk_task2(const Ctx& F, const v4u (&raw)[12], LAS unsigned char* wl, f32x4 (&yv)[4], f32x4 (&zv)[4][4]) {
    const int lane = opaque_v(F.lane), t = lane & 15, kg = lane >> 4;
    LAS bf16* ATt = (LAS bf16*)(wl); LAS bf16* RBr = (LAS bf16*)(wl + 2048); LAS bf16* BHt = (LAS bf16*)(wl + 4096); LAS bf16* KHt = (LAS bf16*)(wl + 6144); LAS bf16* VTt = (LAS bf16*)(wl + 8192);
    LAS bf16* WAt = (LAS bf16*)(wl + 10240); LAS bf16* N_r = (LAS bf16*)(wl + 12288); LAS bf16* N_c = (LAS bf16*)(wl + 12800); LAS bf16* T_r = (LAS bf16*)(wl + 13312);
    LAS bf16* AK_r = (LAS bf16*)(wl + 13824); LAS bf16* RB2 = (LAS bf16*)(wl + 14336); LAS bf16* RK_r = (LAS bf16*)(wl + 14848); LAS float* GCl = (LAS float*)(wl + 15360);
    bf16x8 fAb[2], fRb[2], fBb[2], fKb[2];
#pragma unroll
    for (int ks = 0; ks < 2; ++ks) {
        const int off = 32 * ks + 8 * kg;
        float ea[8], er[8], eb[8], eh[8];
        { const v4u uld = raw[6 * ks + 0]; float ld[8]; unpack8(uld, ld);
#pragma unroll
          for (int j = 0; j < 8; ++j) { float c = ld[j]; c += dpp_shr(c, 1); c += dpp_shr(c, 2); c += dpp_shr(c, 4); c += dpp_shr(c, 8);
              const float tot = __builtin_bit_cast(float, __builtin_amdgcn_ds_bpermute((lane | 15) << 2, __builtin_bit_cast(int, c)));
              ea[j] = __expf(c - ld[j]); er[j] = __expf(c); eb[j] = __expf(-c); const float et_ = __expf(tot); eh[j] = et_ * eb[j];
              if (t == 0) GCl[off + j] = et_; } }
        { const v4u u = raw[6 * ks + 1]; float x[8]; unpack8(u, x);
#pragma unroll
          for (int j = 0; j < 8; ++j) { x[j] = -x[j] * ea[j]; ATt[(off + j) * 16 + t] = (bf16)f2bf(x[j]); }
          const v4u p = pack8(x); fAb[ks] = __builtin_bit_cast(bf16x8, p); }
        { const v4u u = raw[6 * ks + 2]; float x[8]; unpack8(u, x);
#pragma unroll
          for (int j = 0; j < 8; ++j) x[j] = x[j] * er[j];
          const v4u p = pack8(x); fRb[ks] = __builtin_bit_cast(bf16x8, p); *(LAS v4u*)(RBr + t * 64 + off) = p; }
        { const v4u u = raw[6 * ks + 3]; float x[8], y[8]; unpack8(u, x);
#pragma unroll
          for (int j = 0; j < 8; ++j) { y[j] = x[j] * eb[j]; BHt[(off + j) * 16 + t] = (bf16)f2bf(x[j] * eh[j]); }
          const v4u p = pack8(y); fBb[ks] = __builtin_bit_cast(bf16x8, p); }
        { const v4u u = raw[6 * ks + 4]; float x[8], y[8]; unpack8(u, x);
#pragma unroll
          for (int j = 0; j < 8; ++j) { y[j] = x[j] * eb[j]; KHt[(off + j) * 16 + t] = (bf16)f2bf(x[j] * eh[j]); }
          const v4u p = pack8(y); fKb[ks] = __builtin_bit_cast(bf16x8, p); }
        { const v4u u = raw[6 * ks + 5];
          const bf16 e0 = (bf16)(u.x & 0xffff), e1 = (bf16)(u.x >> 16), e2 = (bf16)(u.y & 0xffff), e3 = (bf16)(u.y >> 16), e4 = (bf16)(u.z & 0xffff), e5 = (bf16)(u.z >> 16), e6 = (bf16)(u.w & 0xffff), e7 = (bf16)(u.w >> 16);
          VTt[(off + 0) * 16 + t] = e0; VTt[(off + 1) * 16 + t] = e1; VTt[(off + 2) * 16 + t] = e2; VTt[(off + 3) * 16 + t] = e3; VTt[(off + 4) * 16 + t] = e4; VTt[(off + 5) * 16 + t] = e5; VTt[(off + 6) * 16 + t] = e6; VTt[(off + 7) * 16 + t] = e7; }
        __builtin_amdgcn_sched_barrier(0);
    }
    asm volatile("" ::: "memory");
    const f32x4 z4 = (f32x4){0.f, 0.f, 0.f, 0.f};
    f32x4 n0 = mma16(fAb[1], fBb[1], mma16(fAb[0], fBb[0], z4)), aak = mma16(fAb[1], fKb[1], mma16(fAb[0], fKb[0], z4));
    f32x4 arb = mma16(fRb[1], fBb[1], mma16(fRb[0], fBb[0], z4)), ark = mma16(fRb[1], fKb[1], mma16(fRb[0], fKb[0], z4));
#pragma unroll
    for (int r = 0; r < 4; ++r) { const int tt = 4 * kg + r; if (!(t < tt)) { n0[r] = 0.f; aak[r] = 0.f; } if (!(t <= tt)) { arb[r] = 0.f; ark[r] = 0.f; } }
    st_rowmaj(AK_r, aak, lane); st_rowmaj(RB2, arb, lane); st_rowmaj(RK_r, ark, lane); asm volatile("" ::: "memory");
    f32x4 accT = n0;
#pragma unroll
    for (int r = 0; r < 4; ++r) accT[r] += (4 * kg + r == t) ? 1.f : 0.f;
    f32x4 nn = n0;
#pragma unroll
    for (int itn = 0; itn < 3; ++itn) {
        st_rowmaj(N_r, nn, lane); st_colmaj(N_c, 0, nn, lane); st_rowmaj(T_r, accT, lane); asm volatile("" ::: "memory");
        const auto fa = frag16(N_r, 0, lane), fb = frag16(N_c, 0, lane), ft = frag16(T_r, 0, lane);
        nn = mma16(fa, fb, z4); asm volatile("" ::: "memory");
        st_colmaj(N_c, 0, nn, lane); asm volatile("" ::: "memory");
        const auto fb2 = frag16(N_c, 0, lane);
        accT = mma16(ft, fb2, accT); asm volatile("" ::: "memory");
    }
    st_rowmaj(T_r, accT, lane); asm volatile("" ::: "memory");
    const auto fT = frag16(T_r, 0, lane), fAK = frag16(AK_r, 0, lane), fARB = frag16(RB2, 0, lane), fARK = frag16(RK_r, 0, lane);
#pragma unroll
    for (int kt = 0; kt < 4; ++kt) { const f32x4 dd = mma16(fT, frag16(ATt, 16 * kt, lane), z4); st_colmaj(WAt, 16 * kt, dd, lane); } asm volatile("" ::: "memory");
    f32x4 qy[4];
    { const auto fArbT = frag16(RB2, 0, lane);
#pragma unroll
      for (int kt = 0; kt < 4; ++kt) { const v2u ri = *(const LAS v2u*)(RBr + t * 64 + 16 * kt + 4 * kg);
          qy[kt] = mma16(frag16(WAt, 16 * kt, lane), fArbT, (f32x4){bflo(ri.x), bfhi(ri.x), bflo(ri.y), bfhi(ri.y)}); } }
    asm volatile("" ::: "memory");
#pragma unroll
    for (int vt = 0; vt < 4; ++vt) { const f32x4 dd = mma16(fAK, frag16(VTt, 16 * vt, lane), z4); st_colmaj(ATt, 16 * vt, dd, lane); } asm volatile("" ::: "memory");
    LAS bf16* UVt = RBr;
#pragma unroll
    for (int vt = 0; vt < 4; ++vt) { const f32x4 dd = mma16(fT, frag16(ATt, 16 * vt, lane), z4); st_colmaj(UVt, 16 * vt, dd, lane); } asm volatile("" ::: "memory");
#pragma unroll
    for (int vt = 0; vt < 4; ++vt) { const auto fU = frag16(UVt, 16 * vt, lane), fV = frag16(VTt, 16 * vt, lane);
        yv[vt] = mma16(fARK, fV, mma16(fARB, fU, z4));
#pragma unroll
        for (int ktp = 0; ktp < 4; ++ktp) zv[vt][ktp] = mma16(frag16(KHt, 16 * ktp, lane), fV, mma16(frag16(BHt, 16 * ktp, lane), fU, z4)); }
    f32x4 pz[4][4];
#pragma unroll
    for (int ktp = 0; ktp < 4; ++ktp) { const auto fBh = frag16(BHt, 16 * ktp, lane);
#pragma unroll
        for (int kt = 0; kt < 4; ++kt) { f32x4 dd = mma16(frag16(WAt, 16 * kt, lane), fBh, z4);
            if (kt == ktp) {
#pragma unroll
                for (int r = 0; r < 4; ++r) if (4 * kg + r == t) dd[r] += GCl[16 * kt + t]; }
            pz[ktp][kt] = dd; } }
    asm volatile("s_waitcnt lgkmcnt(0)" ::: "memory");
#pragma unroll
    for (int ktp = 0; ktp < 4; ++ktp) { LAS bf16* reg = (LAS bf16*)(wl + (ktp < 2 ? ktp * 2048 : (ktp + 1) * 2048));
#pragma unroll
        for (int kt = 0; kt < 4; ++kt) { v2u o; o.x = pk2(pz[ktp][kt][0], pz[ktp][kt][1]); o.y = pk2(pz[ktp][kt][2], pz[ktp][kt][3]); *(LAS v2u*)(reg + t * 64 + 16 * kt + 4 * kg) = o; } }
#pragma unroll
    for (int kt = 0; kt < 4; ++kt) { v2u o; o.x = pk2(qy[kt][0], qy[kt][1]); o.y = pk2(qy[kt][2], qy[kt][3]); *(LAS v2u*)(BHt + t * 64 + 16 * kt + 4 * kg) = o; }
    asm volatile("s_waitcnt lgkmcnt(0)" ::: "memory");
}
constexpr int RWZ_OFF = LDSCTL_OFF + 8192, RWF_OFF = LDSCTL_OFF + 2048;
__device__ __forceinline__ void rw_chunk_item2(const Ctx& F, int l, int it, size_t yoff = WS_YDIR) {
    const auto& a = *F.a; unsigned char* ws = a.ws; const int lane = opaque_v(F.lane), t = lane & 15, kg = lane >> 4;
    const int d = it & 1, h = (it >> 1) & 7, b = it >> 4;
    float* YD = (float*)(ws + yoff);
    LAS unsigned char* wl = F.lds + F.wave * 15616;
    LAS bf16* ZS = (LAS bf16*)(F.lds + RWZ_OFF);
    volatile LAS int* flag = (volatile LAS int*)(F.lds + RWF_OFF);
    for (int i = F.tid; i < 2048; i += NTHREADS) ((LAS unsigned*)ZS)[i] = 0u;
    if (F.tid == 0) *flag = 0;
    __syncthreads();
    constexpr int NCHK = (CTXL + SEQ) / 16;
    v4u raw[12];
    rw_chunk_load<0, 2>(F, b, h, d, F.wave, raw);
#pragma unroll 1
    for (int c = F.wave; c < NCHK; c += NWAVES) {
        f32x4 yv[4], zv[4][4];
        rw_chunk_task2(F, raw, wl, yv, zv);
        if (c + NWAVES < NCHK) rw_chunk_load<0, 2>(F, b, h, d, c + NWAVES, raw);
        while (*flag < c) __builtin_amdgcn_s_sleep(1);
        asm volatile("" ::: "memory");
        const LAS bf16* Zc = ZS + (c & 1) * 4096; LAS bf16* Zn = ZS + ((c + 1) & 1) * 4096;
        bf16x8 zb[4][2];
#pragma unroll
        for (int vb = 0; vb < 4; ++vb)
#pragma unroll
            for (int ks = 0; ks < 2; ++ks) zb[vb][ks] = *(const LAS bf16x8*)(Zc + (16 * vb + t) * 64 + 32 * ks + 8 * kg);
        { const LAS bf16* Qr = (const LAS bf16*)(wl + 4096); const bf16x8 q0 = *(const LAS bf16x8*)(Qr + t * 64 + 8 * kg), q1 = *(const LAS bf16x8*)(Qr + t * 64 + 32 + 8 * kg);
#pragma unroll
          for (int vb = 0; vb < 4; ++vb) { const f32x4 y = mma16(q1, zb[vb][1], mma16(q0, zb[vb][0], yv[vb]));
#pragma unroll
              for (int r = 0; r < 4; ++r) { const int row = seq_row(b, d, c * 16 + 4 * kg + r); YD[((size_t)d * T_ALL + row) * 512 + h * 64 + 16 * vb + t] = y[r]; } } }
#pragma unroll
        for (int ktp = 0; ktp < 4; ++ktp) { const LAS bf16* Pr = (const LAS bf16*)(wl + (ktp < 2 ? ktp * 2048 : (ktp + 1) * 2048));
            const bf16x8 p0 = *(const LAS bf16x8*)(Pr + t * 64 + 8 * kg), p1 = *(const LAS bf16x8*)(Pr + t * 64 + 32 + 8 * kg);
#pragma unroll
            for (int vb = 0; vb < 4; ++vb) { const f32x4 z = mma16(p1, zb[vb][1], mma16(p0, zb[vb][0], zv[vb][ktp]));
                v2u o; o.x = pk2(z[0], z[1]); o.y = pk2(z[2], z[3]); *(LAS v2u*)(Zn + (16 * vb + t) * 64 + 16 * ktp + 4 * kg) = o; } }
        asm volatile("s_waitcnt lgkmcnt(0)" ::: "memory");
        if (lane == 0) *flag = c + 1;
        asm volatile("s_waitcnt lgkmcnt(0)" ::: "memory");
    }
    __syncthreads();
}

__device__ __forceinline__ void stage_rw_readout(const Ctx& F, int l) {
    const auto& a = *F.a; unsigned char* ws = a.ws; const int lane = F.lane;
    const bf16* SCN = (const bf16*)(ws + WS_SCN); const bf16* P = (const bf16*)(ws + WS_P); const float* YD = (const float*)(ws + WS_YDIR); bf16* YRW = (bf16*)(ws + WS_YRW);
    const int gw = F.bid * NWAVES + F.wave, NGW = F.G * NWAVES;
    constexpr int TR = 17, NRT = T_ALL / TR;
    for (int tile = gw; tile < NRT * 4; tile += NGW) {
        const int rt = tile % NRT, hp = tile / NRT, row0 = rt * TR, c0 = hp * 128 + 2 * lane;
        const f32x2 rk = *(const f32x2*)(a.in[I_RWRK] + l * 512 + c0), lng = *(const f32x2*)(a.in[I_RWLNG] + l * 512 + c0), lnb = *(const f32x2*)(a.in[I_RWLNB] + l * 512 + c0);
        unsigned sw_[8][5]; f32x2 yw_[8][2];
#define RO_LD(j_) do { const int rr_ = row0 + (j_); const unsigned* sp_ = (const unsigned*)(SCN + (size_t)rr_ * 9 * 512 + c0); \
        sw_[(j_) & 7][0] = sp_[0]; sw_[(j_) & 7][1] = sp_[256]; sw_[(j_) & 7][2] = sp_[4 * 256]; sw_[(j_) & 7][3] = sp_[7 * 256]; sw_[(j_) & 7][4] = *(const unsigned*)(P + (size_t)rr_ * 2560 + 2048 + c0); \
        yw_[(j_) & 7][0] = *(const f32x2*)(YD + (size_t)rr_ * 512 + c0); yw_[(j_) & 7][1] = *(const f32x2*)(YD + ((size_t)T_ALL + rr_) * 512 + c0); } while (0)
        RO_LD(0); RO_LD(1); RO_LD(2);
#pragma unroll
        for (int i = 0; i < TR; ++i) {
            const int row = row0 + i;
            if (i + 3 < TR) RO_LD(i + 3);
            const unsigned ru = sw_[i & 7][0], vu = sw_[i & 7][1], k0u = sw_[i & 7][2], k1u = sw_[i & 7][3], gu = sw_[i & 7][4];
            const f32x2 y0 = yw_[i & 7][0], y1 = yw_[i & 7][1];
            const float bon = red32(bflo(ru) * (bflo(k0u) + bflo(k1u)) * rk[0] + bfhi(ru) * (bfhi(k0u) + bfhi(k1u)) * rk[1]);
            f32x2 y = y0 + y1 + (f32x2){bflo(vu), bfhi(vu)} * bon;
            const float mu = red32(y[0] + y[1]) * (1.f / 64.f);
            y = y - mu;
            const float var = red32(y[0] * y[0] + y[1] * y[1]) * (1.f / 64.f);
            const f32x2 yn = y * (__builtin_amdgcn_rsqf(var + 64e-5f));
            const f32x2 ov = (yn * lng + lnb) * (f32x2){bflo(gu), bfhi(gu)};
            *(unsigned*)(YRW + (size_t)row * 512 + c0) = pk2(ov[0], ov[1]);
        }
    }
}
#undef RO_LD

constexpr size_t WS_S5E = 6 * MiB;
constexpr int S5_NSEG = 4, S5_SEGLEN = (CTXL + SEQ) / S5_NSEG;
__device__ __forceinline__ void s5_disc(const float are, const float aim, const float dt, float& lbr, float& lbi, float& cr, float& ci) {
    const float mag = expf(are * dt); lbr = mag * cosf(aim * dt); lbi = mag * sinf(aim * dt);
    const float den = are * are + aim * aim, nr = lbr - 1.0f; cr = (nr * are + lbi * aim) / den; ci = (lbi * are - nr * aim) / den;
}
template <int PASS>
__device__ __forceinline__ void stage_s5_scan(const Ctx& F, int l, int item = -1) {
    const auto& a = *F.a; unsigned char* ws = a.ws; const int lane = F.lane;
    const bf16* Z = (const bf16*)(ws + WS_Z); bf16* YP = (bf16*)(ws + WS_YP); f32x2* S5E = (f32x2*)(ws + WS_S5E);
    LAS unsigned char* wl = F.lds + F.wave * 16384;
    LAS float* buL = (LAS float*)wl;
    LAS bf16* Hs = (LAS bf16*)(wl + 8704);
    const int fr = lane & 15, kg = lane >> 4;
    for (int itx = (item < 0 ? F.bid : item) * NWAVES + F.wave; itx < BATCH * 32 * 2 * S5_NSEG; itx += (item < 0 ? NWAVES * F.G : BATCH * 32 * 2 * S5_NSEG)) {
        const int seg = itx & (S5_NSEG - 1), it = itx >> 2;
        const int d = it & 1, g = (it >> 1) & 31, b = it >> 6, p = lane;
        const float dt = expf(a.in[I_S5LDT][(l * 2 + d) * 32 + g]);
        const float* arep = a.in[I_S5ARE] + ((size_t)(l * 2 + d) * 32 + g) * 64; const float* aimp = a.in[I_S5AIM] + ((size_t)(l * 2 + d) * 32 + g) * 64;
        float lbr, lbi, cr_, ci_; s5_disc(arep[p], aimp[p], dt, lbr, lbi, cr_, ci_);
        bf16x8 afr[2][4];
#pragma unroll
        for (int tl = 0; tl < 4; ++tl) { const int pp = 16 * tl + fr; float r0_, r1_, cr, ci; s5_disc(arep[pp], aimp[pp], dt, r0_, r1_, cr, ci);
            v4u pr = (v4u){0u, 0u, 0u, 0u}, pi = (v4u){0u, 0u, 0u, 0u};
            if (kg < 2) { const float* br = a.in[I_S5BRE] + (((size_t)l * 32 + g) * 64 + pp) * 16 + 8 * kg; const float* bi = a.in[I_S5BIM] + (((size_t)l * 32 + g) * 64 + pp) * 16 + 8 * kg;
                const f32x4 x0 = *(const f32x4*)br, x1 = *(const f32x4*)(br + 4), y0 = *(const f32x4*)bi, y1 = *(const f32x4*)(bi + 4);
                pr.x = pk2(cr * x0[0] - ci * y0[0], cr * x0[1] - ci * y0[1]); pr.y = pk2(cr * x0[2] - ci * y0[2], cr * x0[3] - ci * y0[3]);
                pr.z = pk2(cr * x1[0] - ci * y1[0], cr * x1[1] - ci * y1[1]); pr.w = pk2(cr * x1[2] - ci * y1[2], cr * x1[3] - ci * y1[3]);
                pi.x = pk2(cr * y0[0] + ci * x0[0], cr * y0[1] + ci * x0[1]); pi.y = pk2(cr * y0[2] + ci * x0[2], cr * y0[3] + ci * x0[3]);
                pi.z = pk2(cr * y1[0] + ci * x1[0], cr * y1[1] + ci * x1[1]); pi.w = pk2(cr * y1[2] + ci * x1[2], cr * y1[3] + ci * x1[3]); }
            afr[0][tl] = __builtin_bit_cast(bf16x8, pr); afr[1][tl] = __builtin_bit_cast(bf16x8, pi); }
        bf16x8 cf[4];
        f32x2 hst = (f32x2){0.f, 0.f};
        if (PASS == 1) {
#pragma unroll
            for (int kk = 0; kk < 4; ++kk) { const int p0 = 16 * kk + 4 * kg;
                const f32x4 c0 = *(const f32x4*)(a.in[I_S5CRE] + (((size_t)l * 32 + g) * 16 + fr) * 64 + p0), c1 = *(const f32x4*)(a.in[I_S5CIM] + (((size_t)l * 32 + g) * 16 + fr) * 64 + p0);
                v4u pk; pk.x = pk2(c0[0], -c1[0]); pk.y = pk2(c0[1], -c1[1]); pk.z = pk2(c0[2], -c1[2]); pk.w = pk2(c0[3], -c1[3]);
                cf[kk] = __builtin_bit_cast(bf16x8, pk); }
            float pr_ = lbr, pi_ = lbi, l64r = 1.f, l64i = 0.f;
#pragma unroll 1
            for (int q = 0; q < 10; ++q) { const float nr2 = pr_ * pr_ - pi_ * pi_, ni2 = 2.f * pr_ * pi_; pr_ = nr2; pi_ = ni2; if (q == 5) { l64r = pr_; l64i = pi_; } }
            const float lLr = pr_ * l64r - pi_ * l64i, lLi = pr_ * l64i + pi_ * l64r;
#pragma unroll 1
            for (int sgi = 0; sgi < seg; ++sgi) { const f32x2 ev = S5E[((size_t)it * S5_NSEG + sgi) * 64 + p];
                hst = (f32x2){lLr * hst[0] - lLi * hst[1] + ev[0], lLr * hst[1] + lLi * hst[0] + ev[1]}; }
        }
        const f32x2 lbr2 = (f32x2){lbr, lbr}, lbi2 = (f32x2){lbi, lbi};
        const int sbeg = seg * S5_SEGLEN, send = sbeg + S5_SEGLEN;
        v4u u0 = (v4u){0u, 0u, 0u, 0u}, u1 = u0, u2 = u0, u3 = u0;
#define S5_LOADU(dst_, s0_) do { const int sx_ = ((s0_) < send) ? (s0_) : (send - 16); const int row_ = seq_row(b, d, sx_ + fr); dst_ = *(const v4u*)(Z + (size_t)row_ * IN_COLS + S5_OFF + g * 16 + (kg & 1) * 8); } while (0)
#define S5_CHUNK(ux_, sc_) do { \
            { const v4u um_ = (kg < 2) ? ux_ : (v4u){0u, 0u, 0u, 0u}; const bf16x8 ufr = __builtin_bit_cast(bf16x8, um_); \
              _Pragma("unroll") for (int c = 0; c < 2; ++c) _Pragma("unroll") for (int tl = 0; tl < 4; ++tl) { \
                const f32x4 dd = __builtin_amdgcn_mfma_f32_16x16x32_bf16(afr[c][tl], ufr, (f32x4){0.f, 0.f, 0.f, 0.f}, 0, 0, 0); *(LAS f32x4*)(buL + (c * 16 + fr) * 68 + 16 * tl + 4 * kg) = dd; } } \
            S5_LOADU(ux_, (sc_) + 64); \
            LDS_WAIT(); asm volatile("" ::: "memory"); \
            f32x2 bu[16]; \
            _Pragma("unroll") for (int s = 0; s < 16; ++s) bu[s] = (f32x2){buL[s * 68 + p], buL[(16 + s) * 68 + p]}; \
            _Pragma("unroll") for (int s = 0; s < 16; ++s) { const float tr_ = __builtin_fmaf(-lbi, hst[1], bu[s][0]), ti_ = __builtin_fmaf(lbi, hst[0], bu[s][1]); \
                hst = (f32x2){__builtin_fmaf(lbr, hst[0], tr_), __builtin_fmaf(lbr, hst[1], ti_)}; \
                if (PASS == 1) *(LAS unsigned*)(Hs + s * 136 + 2 * p) = pg8::cvt_pk_bf16(hst[0], hst[1]); } \
            if (PASS == 1) { LDS_WAIT(); asm volatile("" ::: "memory"); \
                f32x4 acc = (f32x4){0.f, 0.f, 0.f, 0.f}; \
                _Pragma("unroll") for (int kk = 0; kk < 4; ++kk) { const bf16x8 af = *(const LAS bf16x8*)(Hs + fr * 136 + 32 * kk + 8 * kg); acc = __builtin_amdgcn_mfma_f32_16x16x32_bf16(af, cf[kk], acc, 0, 0, 0); } \
                { const int rowq_ = seq_row(b, d, (sc_) + 4 * kg); bf16* yq_ = YP + ((size_t)d * T_ALL + rowq_) * 512 + g * 16 + fr; const int st_ = d ? -512 : 512; \
                  _Pragma("unroll") for (int r = 0; r < 4; ++r) yq_[r * st_] = (bf16)f2bf(acc[r]); } } \
            LDS_WAIT(); asm volatile("" ::: "memory"); } while (0)
        S5_LOADU(u0, sbeg); S5_LOADU(u1, sbeg + 16); S5_LOADU(u2, sbeg + 32); S5_LOADU(u3, sbeg + 48);
#pragma unroll 1
        for (int s0 = sbeg; s0 < send; s0 += 64) { S5_CHUNK(u0, s0); S5_CHUNK(u1, s0 + 16); S5_CHUNK(u2, s0 + 32); S5_CHUNK(u3, s0 + 48); }
#undef S5_CHUNK
        if (PASS == 0) S5E[((size_t)it * S5_NSEG + seg) * 64 + p] = hst;
#undef S5_LOADU
    }
}

__device__ __forceinline__ void stage_s5_prep(const Ctx& F, int l, int nrows) {
    const auto& a = *F.a; unsigned char* ws = a.ws;
    const bf16* __restrict__ Z = (const bf16*)(ws + WS_Z); const bf16* __restrict__ YP = (const bf16*)(ws + WS_YP); bf16* __restrict__ AS5 = (bf16*)(ws + WS_AS5);
    const int c = 4 * (F.tid & 127), rq = F.tid >> 7;
    const f32x4 dsk = *(const f32x4*)(a.in[I_S5D] + l * 512 + c);
#pragma unroll 4
    for (int row = F.bid * 4 + rq; row < nrows; row += F.G * 4) {
        const v2u uz = *(const v2u*)(Z + (size_t)row * IN_COLS + S5_OFF + c);
        const v2u q0 = *(const v2u*)(YP + (size_t)row * 512 + c), q1 = *(const v2u*)(YP + ((size_t)T_ALL + row) * 512 + c);
        const f32x4 y0 = (f32x4){bflo(q0.x), bfhi(q0.x), bflo(q0.y), bfhi(q0.y)}, y1 = (f32x4){bflo(q1.x), bfhi(q1.x), bflo(q1.y), bfhi(q1.y)};
        const f32x4 u = (f32x4){bflo(uz.x), bfhi(uz.x), bflo(uz.y), bfhi(uz.y)};
        const f32x4 y = y0 + y1 + u * dsk;
        float ge[4];
#pragma unroll
        for (int j = 0; j < 4; ++j) ge[j] = 0.5f * y[j] * (1.f + tanh_fast(0.7978845608028654f * (y[j] + 0.044715f * y[j] * y[j] * y[j])));
        v2u o; o.x = pk2(ge[0], ge[1]); o.y = pk2(ge[2], ge[3]);
        *(v2u*)(AS5 + (size_t)row * 512 + c) = o;
    }
}

__device__ __forceinline__ void stage_hy_pre(const Ctx& F, int l, int nrows) {
    const auto& a = *F.a; unsigned char* ws = a.ws; const int lane = F.lane;
    const bf16* Z = (const bf16*)(ws + WS_Z); bf16* UT = (bf16*)(ws + WS_UT);
    LAS unsigned char* tl = F.lds + F.wave * 16384;
    const float* cw = a.in[I_HYCW] + (size_t)l * 3 * 1536; const float* cbp = a.in[I_HYCB] + l * 1536;
    const int gw = F.bid * NWAVES + F.wave, NGW = F.G * NWAVES;
    const int q = lane >> 3, k = lane & 7, ntile = (nrows / 64) * 24;
    v4u v[8], hv;
#define HYPRE_LOAD(tile_) do { const int rt_ = (tile_) / 24, ct_ = (tile_) % 24, row0_ = rt_ * 64; int base_, pos0_, n_; row_seq(row0_, base_, pos0_, n_); \
        const bf16* zt_ = Z + (size_t)row0_ * IN_COLS + HY_OFF + ct_ * 64 + 8 * k; hv = (v4u){0u, 0u, 0u, 0u}; \
        _Pragma("unroll") for (int i = 0; i < 8; ++i) v[i] = *(const v4u*)(zt_ + (size_t)(8 * i + q) * IN_COLS); \
        if (q == 0 && pos0_ > 0) hv = *(const v4u*)(zt_ - (size_t)IN_COLS); \
        if (q == 1 && pos0_ + 64 < n_) hv = *(const v4u*)(zt_ + (size_t)64 * IN_COLS); } while (0)
    if (gw < ntile) HYPRE_LOAD(gw);
#pragma unroll 1
    for (int tile = gw; tile < ntile; tile += NGW) {
        const int rt = tile / 24, ct = tile % 24, row0 = rt * 64, c0 = ct * 64;
        f32x4 wv[8];
#pragma unroll
        for (int i = 0; i < 8; ++i) { const int col = c0 + 8 * i + q; wv[i] = (f32x4){cw[col], cw[1536 + col], cw[2 * 1536 + col], cbp[col]}; }
#pragma unroll
        for (int i = 0; i < 8; ++i) { LAS unsigned* p = (LAS unsigned*)(tl + (1 + 8 * i + q) * 132 + 16 * k); p[0] = v[i].x; p[1] = v[i].y; p[2] = v[i].z; p[3] = v[i].w; }
        if (q < 2) { LAS unsigned* p = (LAS unsigned*)(tl + (q ? 65 : 0) * 132 + 16 * k); p[0] = hv.x; p[1] = hv.y; p[2] = hv.z; p[3] = hv.w; }
        if (tile + NGW < ntile) HYPRE_LOAD(tile + NGW);
        LDS_WAIT(); asm volatile("" ::: "memory");
#pragma unroll 2
        for (int i = 0; i < 8; ++i) {
            const int ch = 8 * i + q, col = c0 + ch;
            const LAS unsigned short* s = (const LAS unsigned short*)(tl + (8 * k) * 132 + ch * 2);
            float z[10];
#pragma unroll
            for (int t = 0; t < 10; ++t) z[t] = __builtin_bit_cast(float, (unsigned)s[t * 66] << 16);
            float o[8];
#pragma unroll
            for (int t = 0; t < 8; ++t) o[t] = wv[i][0] * z[t] + wv[i][1] * z[t + 1] + wv[i][2] * z[t + 2] + wv[i][3];
            v4u w; w.x = pk2(o[0], o[1]); w.y = pk2(o[2], o[3]); w.z = pk2(o[4], o[5]); w.w = pk2(o[6], o[7]);
            *(v4u*)(UT + (size_t)col * T_ALL + row0 + 8 * k) = w;
        }
        LDS_WAIT(); asm volatile("" ::: "memory");
    }
#undef HYPRE_LOAD
}
__device__ __forceinline__ void stage_hy_post(const Ctx& F, int l, int nrows) {
    const auto& a = *F.a; unsigned char* ws = a.ws; const int lane = F.lane;
    const bf16* YT = (const bf16*)(ws + WS_UT) + (size_t)1024 * T_ALL; bf16* YHY = (bf16*)(ws + WS_YHY);
    LAS unsigned char* tl = F.lds + F.wave * 16384;
    const int gw = F.bid * NWAVES + F.wave, NGW = F.G * NWAVES;
    const int q = lane >> 3, k = lane & 7, ntile = (nrows / 64) * 8;
    v4u v[8];
#define HYPOST_LOAD(tile_) do { const bf16* yp_ = YT + (size_t)(((tile_) & 7) * 64 + q) * T_ALL + ((tile_) >> 3) * 64 + 8 * k; \
        _Pragma("unroll") for (int i = 0; i < 8; ++i) v[i] = *(const v4u*)(yp_ + (size_t)(8 * i) * T_ALL); } while (0)
    if (gw < ntile) HYPOST_LOAD(gw);
#pragma unroll 1
    for (int tile = gw; tile < ntile; tile += NGW) {
        const int rt = tile >> 3, ct = tile & 7, row0 = rt * 64, c0 = ct * 64;
#pragma unroll
        for (int i = 0; i < 8; ++i) { LAS unsigned* p = (LAS unsigned*)(tl + (8 * i + q) * 132 + 16 * k); p[0] = v[i].x; p[1] = v[i].y; p[2] = v[i].z; p[3] = v[i].w; }
        if (tile + NGW < ntile) HYPOST_LOAD(tile + NGW);
        LDS_WAIT(); asm volatile("" ::: "memory");
#pragma unroll
        for (int i = 0; i < 8; ++i) { const int r = 8 * i + q;
            const LAS unsigned short* s = (const LAS unsigned short*)(tl + (8 * k) * 132 + r * 2);
            unsigned e[8];
#pragma unroll
            for (int j = 0; j < 8; ++j) e[j] = s[j * 66];
            v4u w; w.x = e[0] | (e[1] << 16); w.y = e[2] | (e[3] << 16); w.z = e[4] | (e[5] << 16); w.w = e[6] | (e[7] << 16);
            *(v4u*)(YHY + (size_t)(row0 + r) * 512 + c0 + 8 * k) = w; }
        LDS_WAIT(); asm volatile("" ::: "memory");
    }
#undef HYPOST_LOAD
}
typedef float f32x16 __attribute__((ext_vector_type(16)));
__device__ __forceinline__ void hyena_item(const Ctx& F, int l, int c, int isctx) {
    const auto& a = *F.a; unsigned char* ws = a.ws; const int tid = F.tid, lane = F.lane;
    const int n = isctx ? CTXL : SEQ, rowbase = isctx ? T_LAT : 0, RL = isctx ? HY_RLENC : HY_RLEN, off = n + 47;
    const bf16* UT = (const bf16*)(ws + WS_UT);
    const bf16* x1g = UT + (size_t)c * T_ALL + rowbase; const bf16* x2g = UT + (size_t)(512 + c) * T_ALL + rowbase; bf16* vg = (bf16*)UT + (size_t)(1024 + c) * T_ALL + rowbase;
    const bf16* Rg = (const bf16*)(ws + WS_GF + l * GF_STRIDE + (isctx ? GF_CTX : 0)) + (size_t)c * RL;
    LAS unsigned char* XB = F.lds; LAS unsigned char* R1 = F.lds + HY_R1_OFF; LAS unsigned char* R2 = F.lds + HY_R2_OFF;
    { const int cpb = n / 8;
      for (int q = tid; q < 8 * cpb; q += NTHREADS) { const int b = q / cpb, ch = q % cpb; *(LAS v4u*)(XB + b * HY_ROWB + 2 * HY_MARG + 16 * ch) = *(const v4u*)(vg + (size_t)b * n + 8 * ch); }
      if (tid < 256) { const int b = tid >> 5, side = (tid >> 4) & 1, ch = tid & 15; const unsigned zz = (unsigned)opaque_v(0); *(LAS v4u*)(XB + b * HY_ROWB + (side ? 2 * (HY_MARG + n) : 0) + 16 * ch) = (v4u){zz, zz, zz, zz}; }
      const int rch = RL / 8;
      for (int q = tid; q < rch; q += NTHREADS) { *(LAS v4u*)(R1 + 16 * q) = *(const v4u*)(Rg + 8 * q); *(LAS v4u*)(R2 + 16 * q) = *(const v4u*)(Rg + (size_t)512 * RL + 8 * q); } }
    __syncthreads();
    const int i = lane & 31, kg = lane >> 5, jb = lane & 3, bb = (lane & 31) >> 2;
    const int rsh = (off - i) & 7, rd = rsh >> 1; const bool s1 = rd & 1, s2 = rd & 2; const unsigned sh = (rsh & 1) ? 16u : 0u;
    const int aconst = 2 * (off - i + 8 * kg - rsh), bconst = bb * HY_ROWB + 2 * (HY_MARG + 32 * jb + 8 * kg);
    const int T0w = 512 * F.wave; const int ntile = (n - T0w) >= 512 ? 4 : ((n - T0w) > 0 ? (n - T0w) / 128 : 0);
    const float bias0 = a.in[I_HYBIAS][(l * 2 + 0) * 512 + c], bias1 = a.in[I_HYBIAS][(l * 2 + 1) * 512 + c];
    f32x16 acc[4];
    v2u y1p[4][4];
#define HY_AFRAG(wa, wb, afr) do { \
        const unsigned a0 = s1 ? wa.y : wa.x, a1 = s1 ? wa.z : wa.y, a2 = s1 ? wa.w : wa.z, a3 = s1 ? wb.x : wa.w, a4 = s1 ? wb.y : wb.x, a5 = s1 ? wb.z : wb.y, a6 = s1 ? wb.w : wb.z; \
        const unsigned b0 = s2 ? a2 : a0, b1 = s2 ? a3 : a1, b2 = s2 ? a4 : a2, b3 = s2 ? a5 : a3, b4 = s2 ? a6 : a4; \
        v4u af_; af_.x = __builtin_amdgcn_alignbit(b1, b0, sh); af_.y = __builtin_amdgcn_alignbit(b2, b1, sh); af_.z = __builtin_amdgcn_alignbit(b3, b2, sh); af_.w = __builtin_amdgcn_alignbit(b4, b3, sh); \
        afr = __builtin_bit_cast(bf16x8, af_); } while (0)
#define HY_STEP_COND(RB, d) do { \
        const v4u wa = *(const LAS v4u*)((RB) + aconst - 2 * (d)), wb = *(const LAS v4u*)((RB) + aconst - 2 * (d) + 16); bf16x8 afr; HY_AFRAG(wa, wb, afr); \
        _Pragma("unroll") for (int m = 0; m < 4; ++m) { const int T0 = T0w + 128 * m; \
            if (m < ntile && (d) >= T0 - n + 16 && (d) <= T0 + 96) { const bf16x8 bfr = *(const LAS bf16x8*)(XB + bconst + 2 * (T0 - (d))); \
                acc[m] = __builtin_amdgcn_mfma_f32_32x32x16_bf16(afr, bfr, acc[m], 0, 0, 0); } } } while (0)
#define HY_LOAD(RB, d, wa, wb, bq) do { wa = *(const LAS v4u*)((RB) + aconst - 2 * (d)); wb = *(const LAS v4u*)((RB) + aconst - 2 * (d) + 16); \
        _Pragma("unroll") for (int m = 0; m < 4; ++m) bq[m] = *(const LAS bf16x8*)(XB + bconst + 2 * (T0w + 128 * m - (d))); } while (0)
#define HY_MMA(wa, wb, bq) do { bf16x8 afr; HY_AFRAG(wa, wb, afr); \
        _Pragma("unroll") for (int m = 0; m < 4; ++m) acc[m] = __builtin_amdgcn_mfma_f32_32x32x16_bf16(afr, bq[m], acc[m], 0, 0, 0); } while (0)
#define HY_CONV(RB) do { \
        _Pragma("unroll") for (int m = 0; m < 4; ++m) _Pragma("unroll") for (int e = 0; e < 16; ++e) acc[m][e] = 0.f; \
        if (ntile == 4) { \
            const int dA = T0w - n + 16, dB = T0w + 384 - n + 16, dC = T0w + 96, dD = T0w + 384 + 96;     \
            _Pragma("unroll 1") for (int d = dA; d < dB; d += 16) HY_STEP_COND(RB, d); \
            { v4u waA, wbA, waB, wbB; bf16x8 bqA[4], bqB[4]; \
              HY_LOAD(RB, dB, waA, wbA, bqA); \
              _Pragma("unroll 1") for (int d = dB; d <= dC; d += 32) { \
                  if (d + 16 <= dC) HY_LOAD(RB, d + 16, waB, wbB, bqB); \
                  __builtin_amdgcn_sched_barrier(0); \
                  HY_MMA(waA, wbA, bqA); \
                  __builtin_amdgcn_sched_barrier(0); \
                  if (d + 32 <= dC) HY_LOAD(RB, d + 32, waA, wbA, bqA); \
                  __builtin_amdgcn_sched_barrier(0); \
                  if (d + 16 <= dC) HY_MMA(waB, wbB, bqB); \
                  __builtin_amdgcn_sched_barrier(0); } } \
            _Pragma("unroll 1") for (int d = dC + 16; d <= dD; d += 16) HY_STEP_COND(RB, d); \
        } else if (ntile > 0) { const int dhi = T0w + 128 * (ntile - 1) + 96; \
            _Pragma("unroll 1") for (int d = T0w - n + 16; d <= dhi; d += 16) HY_STEP_COND(RB, d); } } while (0)
    HY_CONV(R1);
#pragma unroll
    for (int m = 0; m < 4; ++m) if (m < ntile) {
#pragma unroll
        for (int rg = 0; rg < 4; ++rg) { const int t4 = T0w + 128 * m + 32 * jb + 8 * rg + 4 * kg;
            const v2u xv = *(const v2u*)(x1g + (size_t)bb * n + t4); const v2u vv = *(const LAS v2u*)(XB + bb * HY_ROWB + 2 * (HY_MARG + t4));
            const float y0 = bflo(xv.x) * (acc[m][4 * rg + 0] + bias0 * bflo(vv.x)), y1 = bfhi(xv.x) * (acc[m][4 * rg + 1] + bias0 * bfhi(vv.x));
            const float y2 = bflo(xv.y) * (acc[m][4 * rg + 2] + bias0 * bflo(vv.y)), y3 = bfhi(xv.y) * (acc[m][4 * rg + 3] + bias0 * bfhi(vv.y));
            y1p[m][rg].x = pk2(y0, y1); y1p[m][rg].y = pk2(y2, y3); } }
    __syncthreads();
#pragma unroll
    for (int m = 0; m < 4; ++m) if (m < ntile) {
#pragma unroll
        for (int rg = 0; rg < 4; ++rg) { const int t4 = T0w + 128 * m + 32 * jb + 8 * rg + 4 * kg; *(LAS v2u*)(XB + bb * HY_ROWB + 2 * (HY_MARG + t4)) = y1p[m][rg]; } }
    __syncthreads();
    HY_CONV(R2);
#pragma unroll
    for (int m = 0; m < 4; ++m) if (m < ntile) {
#pragma unroll
        for (int rg = 0; rg < 4; ++rg) { const int t4 = T0w + 128 * m + 32 * jb + 8 * rg + 4 * kg;
            const v2u xv = *(const v2u*)(x2g + (size_t)bb * n + t4); const v2u yv = y1p[m][rg];
            const float o0 = bflo(xv.x) * (acc[m][4 * rg + 0] + bias1 * bflo(yv.x)), o1 = bfhi(xv.x) * (acc[m][4 * rg + 1] + bias1 * bfhi(yv.x));
            const float o2 = bflo(xv.y) * (acc[m][4 * rg + 2] + bias1 * bflo(yv.y)), o3 = bfhi(xv.y) * (acc[m][4 * rg + 3] + bias1 * bfhi(yv.y));
            v2u ov; ov.x = pk2(o0, o1); ov.y = pk2(o2, o3); *(v2u*)(vg + (size_t)bb * n + t4) = ov; } }
    __syncthreads();
#undef HY_CONV
#undef HY_AFRAG
#undef HY_STEP_COND
#undef HY_LOAD
#undef HY_MMA
}
__device__ __forceinline__ void stage_mixer(const Ctx& F, int l) {
    unsigned* ctr = (unsigned*)(F.a->ws + WS_CTL) + CW_WORK + 64 * l;
    LAS int* itb = (LAS int*)(F.lds + LDSCTL_OFF + 512);
    constexpr int NS5 = BATCH * 32 * 2 * S5_NSEG / NWAVES;
    const int nit = 128 + NS5 + 512 + (l == 0 ? 512 : 0);
#ifdef PROBE_STATIC
    return;
#endif
    for (;;) {
        if (F.tid == 0) *itb = (int)__hip_atomic_fetch_add(ctr, 1u, __ATOMIC_RELAXED, __HIP_MEMORY_SCOPE_AGENT);
        __syncthreads();
        const int it = *itb;
        __syncthreads();
        if (it >= nit) break;
        Ctx Fi; Fi.a = kargs(); Fi.tid = opaque_v((int)threadIdx.x); Fi.lane = Fi.tid & 63; Fi.wave = __builtin_amdgcn_readfirstlane(Fi.tid >> 6); Fi.bid = opaque((int)blockIdx.x); Fi.G = opaque((int)gridDim.x);
        Fi.lds = (LAS unsigned char*)((LAS unsigned char*)0 + opaque(0)) + (F.lds - (LAS unsigned char*)0);
#ifdef PROBE_T
        if (l == 0 && F.tid == 0 && it == 5) ((unsigned long long*)(F.a->ws + WS_CTL + CW_STAMP * 4))[21] = __builtin_amdgcn_s_memrealtime();
        if (l == 0 && F.tid == 0 && it == 300) ((unsigned long long*)(F.a->ws + WS_CTL + CW_STAMP * 4))[23] = __builtin_amdgcn_s_memrealtime();
#endif
        if (it < 128) { for (int rep = 0; rep < ((DUPK == 9) ? 2 : 1); ++rep) rw_chunk_item2(Fi, opaque(l), it); }
        else if (it < 128 + NS5) stage_s5_scan<1>(Fi, opaque(l), it - 128);
        else if (it < 640 + NS5) hyena_item(Fi, opaque(l), it - 128 - NS5, 0);
        else hyena_item(Fi, opaque(l), it - 640 - NS5, 1);
#ifdef PROBE_T
        if (l == 0 && F.tid == 0 && it == 5) ((unsigned long long*)(F.a->ws + WS_CTL + CW_STAMP * 4))[22] = __builtin_amdgcn_s_memrealtime();
        if (l == 0 && F.tid == 0 && it == 300) ((unsigned long long*)(F.a->ws + WS_CTL + CW_STAMP * 4))[24] = __builtin_amdgcn_s_memrealtime();
#endif
    }
}

typedef float f32x16r __attribute__((ext_vector_type(16)));
__device__ __forceinline__ void stage_norm2_router(const Ctx& F, int l, int nrows) {
    const auto& a = *F.a; unsigned char* ws = a.ws; const int lane = F.lane;
    const float* X = (const float*)(ws + WS_X); bf16* H = (bf16*)(ws + WS_H); const float* MOD = (const float*)(ws + WS_MOD);
    int* EIDX = (int*)(ws + WS_EIDX); float* GATE = (float*)(ws + WS_GATE); int* POS = (int*)(ws + WS_POS); unsigned* ROWOF = (unsigned*)(ws + WS_ROWOF);
    LAS int* lex = (LAS int*)(F.lds + 40960); LAS int* lrk = lex + 2048; LAS int* offl = lrk + 2048;
    LAS float* lg = (LAS float*)(F.lds + F.wave * 4352);
    LAS int* hist = (LAS int*)(F.lds + LDSCTL_OFF + 1024);
    if (F.tid < 32) hist[F.tid] = 0;
    __syncthreads();
    const int rpb = (nrows + F.G - 1) / F.G, r0 = F.bid * rpb, r1 = (r0 + rpb < nrows) ? r0 + rpb : nrows;
    const float* rw = a.in[I_RTW] + (size_t)l * 1024 * 32;
    const int i = lane & 31, kk = lane >> 5;
    const f32x4* ng = (const f32x4*)(a.in[I_N2G] + l * D) + kk;
    for (int rb = r0 + F.wave * 32; rb < r1; rb += NWAVES * 32) {
        const int nrow = (r1 - rb) < 32 ? (r1 - rb) : 32; const bool live = i < nrow;
        const int row = live ? rb + i : r1 - 1; const int w = row < T_LAT ? (row >> 12) : 8;
        const f32x4* xr = (const f32x4*)(X + (size_t)row * D) + kk;
        float ss = 0.f;
#pragma unroll 16
        for (int q = 0; q < 128; ++q) { const f32x4 v = xr[2 * q]; ss += (v[0] * v[0] + v[1] * v[1]) + (v[2] * v[2] + v[3] * v[3]); }
        ss += __builtin_bit_cast(float, __builtin_amdgcn_ds_bpermute((lane ^ 32) << 2, __builtin_bit_cast(int, ss)));
        const float rstd = __builtin_amdgcn_rsqf(ss * (1.f / D) + 1e-6f);
        const f32x4* sh = (const f32x4*)(MOD + (size_t)(l * 9 + w) * 6144 + 3072) + kk; const f32x4* sc = (const f32x4*)(MOD + (size_t)(l * 9 + w) * 6144 + 4096) + kk;
        v2u* ho = (v2u*)(H + (size_t)row * D) + kk;
        f32x16r acc;
#pragma unroll
        for (int e = 0; e < 16; ++e) acc[e] = 0.f;
        const float* wp = rw + (size_t)(4 * kk) * 32 + i;
        f32x4 xn[4], gn_[4], cn_[4], sn_[4], wn_[4];
#define RT_LOAD(q0_) do { _Pragma("unroll") for (int u_ = 0; u_ < 4; ++u_) { const int q_ = (q0_) + u_; xn[u_] = xr[2 * q_]; gn_[u_] = ng[2 * q_]; cn_[u_] = sc[2 * q_]; sn_[u_] = sh[2 * q_]; \
            wn_[u_] = (f32x4){wp[(size_t)(8 * q_) * 32], wp[(size_t)(8 * q_ + 1) * 32], wp[(size_t)(8 * q_ + 2) * 32], wp[(size_t)(8 * q_ + 3) * 32]}; } } while (0)
        RT_LOAD(0);
#pragma unroll 1
        for (int q0 = 0; q0 < 128; q0 += 4) {
            f32x4 xc[4], gc_[4], cc_[4], sc_[4], wc_[4];
#pragma unroll
            for (int u = 0; u < 4; ++u) { xc[u] = xn[u]; gc_[u] = gn_[u]; cc_[u] = cn_[u]; sc_[u] = sn_[u]; wc_[u] = wn_[u]; }
            if (q0 + 4 < 128) RT_LOAD(q0 + 4);
#pragma unroll
            for (int u = 0; u < 4; ++u) { const int q = q0 + u;
                const f32x4 h4 = xc[u] * rstd * gc_[u] * (cc_[u] + 1.0f) + sc_[u];
                if (live) { v2u o; o.x = pk2(h4[0], h4[1]); o.y = pk2(h4[2], h4[3]); ho[2 * q] = o; }
                acc = __builtin_amdgcn_mfma_f32_32x32x2f32(h4[0], wc_[u][0], acc, 0, 0, 0);
                acc = __builtin_amdgcn_mfma_f32_32x32x2f32(h4[1], wc_[u][1], acc, 0, 0, 0);
                acc = __builtin_amdgcn_mfma_f32_32x32x2f32(h4[2], wc_[u][2], acc, 0, 0, 0);
                acc = __builtin_amdgcn_mfma_f32_32x32x2f32(h4[3], wc_[u][3], acc, 0, 0, 0); }
        }
#undef RT_LOAD
        const float rbias = a.in[I_RTB][l * 32 + i];
#pragma unroll
        for (int r = 0; r < 16; ++r) { const int ri = (r & 3) + 8 * (r >> 2) + 4 * kk; lg[ri * 33 + i] = acc[r] + rbias; }
        LDS_WAIT(); asm volatile("" ::: "memory");
        if (lane < nrow) {
            LAS float* lr = lg + lane * 33; const int orow = rb + lane;
            float tv[4]; int ti[4];
#pragma unroll
            for (int r = 0; r < 4; ++r) { float bv = -INFINITY; int bi = 0;
#pragma unroll 8
                for (int e = 0; e < 32; ++e) { const float v = lr[e]; if (v > bv) { bv = v; bi = e; } }
                tv[r] = bv; ti[r] = bi; lr[bi] = -INFINITY; }
            const float e1 = expf(tv[1] - tv[0]), e2 = expf(tv[2] - tv[0]), e3 = expf(tv[3] - tv[0]); const float inv = 1.0f / (1.0f + e1 + e2 + e3);
            *(int4*)(EIDX + orow * 4) = make_int4(ti[0], ti[1], ti[2], ti[3]); *(f32x4*)(GATE + orow * 4) = (f32x4){inv, e1 * inv, e2 * inv, e3 * inv};
#pragma unroll
            for (int r = 0; r < 4; ++r) { const int rk = __hip_atomic_fetch_add(&hist[ti[r]], 1, __ATOMIC_RELAXED, __HIP_MEMORY_SCOPE_WORKGROUP); lex[(orow - r0) * 4 + r] = ti[r]; lrk[(orow - r0) * 4 + r] = rk; }
        }
        LDS_WAIT(); asm volatile("" ::: "memory");
    }
    __syncthreads();
    if (F.tid < 32) { const int c = hist[F.tid]; offl[F.tid] = c ? (int)__hip_atomic_fetch_add((unsigned*)(ws + WS_CTL) + CW_CNT + 64 * l + F.tid, (unsigned)c, __ATOMIC_RELAXED, __HIP_MEMORY_SCOPE_AGENT) : 0; }
    __syncthreads();
    for (int i = F.tid; i < (r1 > r0 ? (r1 - r0) * 4 : 0); i += NTHREADS) { const int e = lex[i], pos = offl[e] + lrk[i];
        POS[r0 * 4 + i] = pos; ROWOF[(size_t)e * pg8::MOE_CAP + pos] = (unsigned)(r0 + (i >> 2)) * (unsigned)(D * 2); }
    __syncthreads();
}

__device__ __forceinline__ LAS int* load_moe_base(const Ctx& F, int l) {
    LAS int* base = (LAS int*)(F.lds + LDSCTL_OFF + 256);
    if (F.tid < 32) base[64 + F.tid] = (int)__hip_atomic_load((unsigned*)(F.a->ws + WS_CTL) + CW_CNT + 64 * l + F.tid, __ATOMIC_RELAXED, __HIP_MEMORY_SCOPE_AGENT);
    __syncthreads();
    if (F.tid == 0) { int acc = 0; for (int e = 0; e < 32; ++e) { base[e] = acc; acc += (base[64 + e] + 255) & ~255; } base[32] = acc; }
    __syncthreads();
    return base;
}
__device__ __forceinline__ void moe_fix_pos(const Ctx& F, int nrows, const LAS int* base) {
    unsigned char* ws = F.a->ws; const int* EIDX = (const int*)(ws + WS_EIDX); int* POS = (int*)(ws + WS_POS);
    const int rpb = (nrows + F.G - 1) / F.G, r0 = F.bid * rpb, r1 = (r0 + rpb < nrows) ? r0 + rpb : nrows;
    for (int i = F.tid; i < (r1 > r0 ? (r1 - r0) * 4 : 0); i += NTHREADS) POS[r0 * 4 + i] += base[EIDX[r0 * 4 + i]];
}

constexpr int NSTAGE_L = 13, NSTAGES = 1 + DEPTH * NSTAGE_L + 1;
__global__ void __launch_bounds__(NTHREADS, 2) mk_fwd(Args args) {
    extern __shared__ __attribute__((aligned(16))) unsigned char lds_raw[];
    Ctx F; F.a = kargs(); F.lds = (LAS unsigned char*)lds_raw; F.tid = threadIdx.x; F.lane = F.tid & 63; F.wave = __builtin_amdgcn_readfirstlane(F.tid >> 6); F.bid = blockIdx.x; F.G = gridDim.x;
    volatile LAS unsigned* MISC = (volatile LAS unsigned*)(F.lds + LDSCTL_OFF);
    for (int u = F.tid; u < (LDS_BYTES - LDSCTL_OFF) / 4; u += NTHREADS) ((LAS unsigned*)(F.lds + LDSCTL_OFF))[u] = 0u;
    __syncthreads();
#if MK_PER_STAGE
#define GRID_BAR() do { } while (0)
#else
    (void)xcd_barrier_post((unsigned*)(F.a->ws + WS_CTL) + CW_BAR, MISC + 8);
#define GRID_BAR() do { XcdBarrier b_; b_.bar = (unsigned*)(kargs()->ws + WS_CTL) + CW_BAR; b_.x = xb_xcc_id(); b_.st = (volatile LAS unsigned*)((LAS unsigned char*)lds_raw + LDSCTL_OFF + opaque(32)); xcd_barrier(b_); } while (0)
#endif
#ifndef ONLY_S
#define ONLY_S -1
#endif
#define STG_SEL(k) (ONLY_S < 0 || ONLY_S == (((k) == 0) ? 0 : ((k) == NSTAGES - 1 ? 14 : (((k) - 1) % NSTAGE_L) + 1)))
#if MK_PER_STAGE
#define IN(k) (STG_SEL(k) && kargs()->ph_lo == (k))
#else
#define IN(k) STG_SEL(k)
#endif
#if MK_PER_STAGE
#define SEAM(k) do { } while (0)
#else
#define SEAM(k) do { if ((k) + 1 < NSTAGES) GRID_BAR(); } while (0)
#endif
#define STAGE(k) if (IN(k)) { F.a = kargs(); F.tid = opaque_v((int)threadIdx.x); F.lane = F.tid & 63; F.wave = __builtin_amdgcn_readfirstlane(F.tid >> 6); F.bid = opaque((int)blockIdx.x); F.G = opaque((int)gridDim.x); F.lds = (LAS unsigned char*)lds_raw + opaque(0); unsigned char* ws = F.a->ws; const int l = opaque(lq); unsigned char* wl = ws + WS_WTS + (size_t)l * WL_STRIDE; (void)wl; (void)ws;
#define STAGE_END(k) } SEAM(k);
    int lq = 0;
    STAGE(0) p0_prologue(F); STAGE_END(0)
    for (lq = 0; lq < DEPTH; ++lq) {
        const int sb = 1 + lq * NSTAGE_L;
        const int nrl = opaque((lq == DEPTH - 1) ? T_LAT : T_ALL);
        STAGE(sb + 0) stage_norm1(F, l); STAGE_END(sb + 0)
        STAGE(sb + 1) pg8::SchedWin S; S.A = (const char*)(ws + WS_H); S.Bt = (const char*)(wl + WO_WIN); S.tstep = (size_t)256 * 1024 * 2; S.G = F.G; S.c = F.bid; S.part = (nrl != T_ALL); pg8::EpiBf16 E{(bf16*)(ws + WS_Z), IN_COLS, nullptr, 0};
            pg8::gemm_phase(F.lds, F.tid, 1024, S, E); STAGE_END(sb + 1)
        STAGE(sb + 2) for (int rep = 0; rep < REPN(1); ++rep) stage_rw_prep1(F, l); for (int rep = 0; rep < REPN(2); ++rep) stage_s5_scan<0>(F, l); for (int rep = 0; rep < REPN(3); ++rep) stage_hy_pre(F, l, nrl); STAGE_END(sb + 2)
        STAGE(sb + 3) { pg8::SchedStatic S; S.init(ws + WS_ARW, wl + WO_RWCAT, T_ALL, 2560, 256, F.G, F.bid); pg8::EpiBf16 E{(bf16*)(ws + WS_P), 2560, nullptr, 0}; PT(4); pg8::gemm_phase(F.lds, F.tid, 256, S, E); PT(5); }
            F.tid = opaque_v((int)threadIdx.x); F.lane = F.tid & 63;
            STAGE_END(sb + 3)
        STAGE(sb + 4) for (int rep = 0; rep < REPN(5); ++rep) stage_rw_prep2(F, l); STAGE_END(sb + 4)
        STAGE(sb + 5) PT(10); stage_mixer(F, l); PT(11); STAGE_END(sb + 5) STAGE(sb + 5) PT(12); }
        STAGE(sb + 6) stage_s5_prep(F, l, nrl); STAGE_END(sb + 6)
        STAGE(sb + 7) { pg8::SchedStatic S; S.init(ws + WS_AS5, wl + WO_GLU, nrl, 1024, 512, F.G, F.bid); pg8::EpiGlu<0> E{(bf16*)(ws + WS_YS5), 512, F.a->in[I_S5GLUB] + l * 1024, 0, 512}; PT(13); pg8::gemm_phase(F.lds, F.tid, 512, S, E); PT(14); }
            for (int rep = 0; rep < REPN(7); ++rep) stage_rw_readout(F, l); for (int rep = 0; rep < REPN(8); ++rep) stage_hy_post(F, l, nrl); STAGE_END(sb + 7)
        STAGE(sb + 8) pg8::SchedMerge S; S.A0 = (const char*)(ws + WS_YHY); S.A1 = (const char*)(ws + WS_YRW); S.A2 = (const char*)(ws + WS_YS5); S.Bt = (const char*)(wl + WO_WBR); S.tstep = (size_t)256 * 512 * 2; S.bstride = (size_t)1024 * 512 * 2;
            S.nM = nrl / 256; S.nN = 4; S.G = F.G; S.c = F.bid;
            pg8::EpiMerge E{(bf16*)(ws + WS_MTMP), (bf16*)(ws + WS_H), (const bf16*)(ws + WS_Z) + GATE_OFF}; pg8::gemm_phase(F.lds, F.tid, 512, S, E); STAGE_END(sb + 8)
        STAGE(sb + 9) pg8::SchedStatic S; S.init(ws + WS_H, wl + WO_WOUT, nrl, 1024, 1024, F.G, F.bid); pg8::EpiResid E{(float*)(ws + WS_X), (const float*)(ws + WS_MOD) + (size_t)l * 9 * 6144 + 2048};
            pg8::gemm_phase(F.lds, F.tid, 1024, S, E); STAGE_END(sb + 9)
        STAGE(sb + 10) PT(17); stage_norm2_router(F, l, nrl); PT(18); STAGE_END(sb + 10)
        STAGE(sb + 11) LAS int* base = load_moe_base(F, l); moe_fix_pos(F, nrl, base);
            pg8::SchedMoeG S; S.A = (const char*)(ws + WS_H); S.rowof = (const unsigned*)(ws + WS_ROWOF); S.Bt = (const char*)(wl + WO_W1); S.tstep = (size_t)256 * 1024 * 2; S.estride = (size_t)2048 * 1024 * 2; S.NPN = 8; S.G = F.G; S.c = F.bid; S.base = base;
            pg8::EpiGlu<1> E{(bf16*)(ws + WS_ACT), 1024, F.a->in[I_B1] + (size_t)l * 32 * 2048, 2048, 1024}; pg8::gemm_phase(F.lds, F.tid, 1024, S, E); STAGE_END(sb + 11)
        STAGE(sb + 12) LAS int* base = load_moe_base(F, l);
            pg8::SchedMoe S; S.A = (const char*)(ws + WS_ACT); S.Bt = (const char*)(wl + WO_W2); S.tstep = (size_t)256 * 1024 * 2; S.estride = (size_t)1024 * 1024 * 2; S.NPN = 4; S.G = F.G; S.c = F.bid; S.base = base;
            pg8::EpiBf16 E{(bf16*)(ws + WS_XS), 1024, F.a->in[I_B2] + (size_t)l * 32 * 1024, 1024}; pg8::gemm_phase(F.lds, F.tid, 1024, S, E); STAGE_END(sb + 12)
    }
    lq = DEPTH;
    STAGE(NSTAGES - 1)
#ifndef PROBE_T
        stage_norm1(F, l);
#endif
#ifdef PROBE_T
        { const unsigned long long* st = (const unsigned long long*)(F.a->ws + WS_CTL + CW_STAMP * 4); const float cval = (float)(long long)(st[PROBE_B] - st[PROBE_A]) * (1.0f / (100.0f * PROBE_DIV));
          __syncthreads(); for (size_t i = (size_t)F.bid * NTHREADS + F.tid; i < (size_t)T_LAT * D; i += (size_t)F.G * NTHREADS) F.a->out[i] = cval; }
#endif
    }
#undef IN
#undef SEAM
}

extern "C" void kernel_launch(void* const* d_in, const int* in_sizes, int n_in, void* d_out, int out_size, void* d_ws, size_t ws_size, hipStream_t stream) {
    static int grid = 0;
    if (grid == 0) {
        if (n_in != 51 || out_size != T_LAT * D || ws_size < WS_END) { fprintf(stderr, "kernel_launch: unexpected shapes (n_in %d out %d ws %zu, need %zu)\n", n_in, out_size, ws_size, (size_t)WS_END); grid = -1; return; }
        int dev = 0, cus = 0, per_cu = 0;
        if (hipGetDevice(&dev) != hipSuccess || hipDeviceGetAttribute(&cus, hipDeviceAttributeMultiprocessorCount, dev) != hipSuccess) { grid = -1; return; }
        if (hipFuncSetAttribute((const void*)mk_fwd, hipFuncAttributeMaxDynamicSharedMemorySize, LDS_BYTES) != hipSuccess) { fprintf(stderr, "kernel_launch: hipFuncSetAttribute failed\n"); grid = -1; return; }
        if (hipOccupancyMaxActiveBlocksPerMultiprocessor(&per_cu, (const void*)mk_fwd, NTHREADS, LDS_BYTES) != hipSuccess || per_cu < 1) fprintf(stderr, "kernel_launch: occupancy query says %d\n", per_cu);
        (void)hipGetLastError();
        grid = cus;
    }
    if (grid < 0) return;
    if (hipMemsetAsync((char*)d_ws + WS_CTL, 0, CTL_ZERO_BYTES, stream) != hipSuccess) return;
    Args a{};
    for (int i = 0; i < 51; ++i) a.in[i] = (const float*)d_in[i];
    a.out = (float*)d_out; a.ws = (unsigned char*)d_ws;
#if MK_PER_STAGE
    for (int s = 0; s < NSTAGES; ++s) { a.ph_lo = s; a.ph_hi = s + 1; int reps = 1;
#ifdef PROBE_SET
        { const int ls = (s == 0 || s == NSTAGES - 1) ? -1 : (s - 1) % NSTAGE_L;
          if (PROBE_SET >= 1 && PROBE_SET <= 13 && ls == PROBE_SET - 1 && ls != 5 && ls != 8 && !(ls == 0 && s > 1)) reps = 3;
          if (PROBE_SET == 14 && s == 0) reps = 3; }
#endif
        for (int r = 0; r < reps; ++r) hipLaunchKernelGGL(mk_fwd, dim3(grid), dim3(NTHREADS), LDS_BYTES, stream, a); }
#else
    a.ph_lo = 0; a.ph_hi = NSTAGES; hipLaunchKernelGGL(mk_fwd, dim3(grid), dim3(NTHREADS), LDS_BYTES, stream, a);
#endif
}
```

```cpp
#include <hip/hip_runtime.h>
#include <cstdio>
#include <cstdint>

#ifndef DUPK
#define DUPK 0
#endif
#define REPN(k) ((DUPK == (k)) ? 3 : 1)
#ifndef REP_GEMM
#define REP_GEMM 1
#endif
#ifndef REP_LIGHT
#define REP_LIGHT 1
#endif
#ifndef REP_PRO
#define REP_PRO 1
#endif
#ifndef MK_PER_STAGE
#define MK_PER_STAGE 0
#endif

#define GAS __attribute__((address_space(1)))
#define LAS __attribute__((address_space(3)))
typedef unsigned short bf16;
typedef unsigned v4u __attribute__((ext_vector_type(4)));
typedef unsigned v2u __attribute__((ext_vector_type(2)));
typedef float f32x4 __attribute__((ext_vector_type(4)));
typedef float f32x2 __attribute__((ext_vector_type(2)));
typedef short bf16x8 __attribute__((ext_vector_type(8)));

constexpr int D = 1024, BATCH = 8, SEQ = 4096, CTXL = 256, DEPTH = 2;
constexpr int T_LAT = BATCH * SEQ, T_CTX = BATCH * CTXL, T_ALL = T_LAT + T_CTX;
constexpr int IN_COLS = 6912, HY_OFF = 0, RW_OFF = 1536, S5_OFF = 3328, GATE_OFF = 3840;
constexpr int NE = 32, TOPK = 4;
constexpr int MAXSLOT = 147456;
constexpr int NWAVES = 8, NTHREADS = 512;
constexpr int HY_MARG = 128, HY_ROWB = 8720, HY_RLEN = 8272, HY_RLENC = 592;
constexpr int HY_R1_OFF = 8 * HY_ROWB, HY_R2_OFF = HY_R1_OFF + HY_RLEN * 2;

constexpr size_t MiB = 1ull << 20;
constexpr size_t WS_CTL = 0, CTL_ZERO_BYTES = 1 * MiB;
constexpr size_t WS_MOD = 1 * MiB;
constexpr size_t WS_BLKCNT = 2 * MiB;
constexpr size_t WS_META = 2 * MiB + 512 * 1024;
constexpr size_t WS_ROWOF = 480 * MiB;
constexpr int CW_CNT = 24576;
constexpr size_t WS_EIDX = 3 * MiB, WS_GATE = 4 * MiB, WS_POS = 5 * MiB;
constexpr size_t WS_WTS = 8 * MiB, WL_STRIDE = 214 * MiB;
constexpr size_t WO_WIN = 0, WO_RWCAT = 14 * MiB, WO_GLU = 16 * MiB, WO_WBR = 17 * MiB, WO_WOUT = 20 * MiB, WO_W1 = 22 * MiB, WO_W2 = 150 * MiB;
constexpr size_t WS_GF = 436 * MiB, GF_STRIDE = 20 * MiB, GF_CTX = 17 * MiB;
constexpr size_t WS_X = 504 * MiB;
constexpr size_t WS_H = 640 * MiB;
constexpr size_t WS_BIG = 708 * MiB;
constexpr size_t WS_Z = WS_BIG;
constexpr size_t WS_SCN = 1167 * MiB;
constexpr size_t WS_MTMP = WS_SCN;
constexpr size_t WS_P = 1473 * MiB;
constexpr size_t WS_ARW = 1643 * MiB;
constexpr size_t WS_YDIR = 1660 * MiB;
constexpr size_t WS_YP = 1898 * MiB;
constexpr size_t WS_UT = 1796 * MiB;
constexpr size_t WS_AS5 = 2000 * MiB;
constexpr size_t WS_YHY = 1898 * MiB, WS_YRW = 1932 * MiB, WS_YS5 = 1966 * MiB;
constexpr size_t WS_XS = WS_BIG;
constexpr size_t WS_ACT = WS_BIG + 288 * MiB;
constexpr size_t WS_END = 2034 * MiB;
constexpr int CW_BAR = 4096;

constexpr int RING_BYTES = 131072;
constexpr int LDSCTL_OFF = RING_BYTES;
constexpr int LDS_BYTES = 163840;

typedef __bf16 bf16x2_t __attribute__((ext_vector_type(2)));
__device__ __forceinline__ unsigned pk2(float lo, float hi) { const bf16x2_t v = __builtin_convertvector((f32x2){lo, hi}, bf16x2_t); return __builtin_bit_cast(unsigned, v); }
__device__ __forceinline__ unsigned f2bf(float f) { return pk2(f, 0.f) & 0xffffu; }
__device__ __forceinline__ float bf2f(bf16 b) { return __builtin_bit_cast(float, ((unsigned)b) << 16); }
__device__ __forceinline__ float bflo(unsigned w) { return __builtin_bit_cast(float, w << 16); }
__device__ __forceinline__ float bfhi(unsigned w) { return __builtin_bit_cast(float, w & 0xffff0000u); }
__device__ __forceinline__ float sigm(float x) { return __builtin_amdgcn_rcpf(1.f + __expf(-x)); }
__device__ __forceinline__ float tanh_fast(float x) { const float e = __expf(2.f * x); return 1.f - 2.f * __builtin_amdgcn_rcpf(e + 1.f); }
#define LDS_WAIT() asm volatile("s_waitcnt lgkmcnt(0)" ::: "memory")
__device__ __forceinline__ float dpp_f(float x, const int ctrl_sel) {
    const int v = __builtin_bit_cast(int, x);
    int r;
    if (ctrl_sel == 0) r = __builtin_amdgcn_update_dpp(0, v, 0xB1, 0xF, 0xF, true);
    else if (ctrl_sel == 1) r = __builtin_amdgcn_update_dpp(0, v, 0x4E, 0xF, 0xF, true);
    else r = __builtin_amdgcn_update_dpp(0, v, 0x141, 0xF, 0xF, true);
    return __builtin_bit_cast(float, r);
}
__device__ __forceinline__ float red32(float x) {
    x += dpp_f(x, 0); x += dpp_f(x, 1); x += dpp_f(x, 2);
    x += __builtin_bit_cast(float, __builtin_amdgcn_update_dpp(0, __builtin_bit_cast(int, x), 0x128, 0xF, 0xF, true));
    x += __builtin_bit_cast(float, __builtin_amdgcn_ds_swizzle(__builtin_bit_cast(int, x), 0x401F));
    return x;
}
__device__ __forceinline__ float wave_sum(float v) {
    v = red32(v);
    return __builtin_bit_cast(float, __builtin_amdgcn_readlane(__builtin_bit_cast(int, v), 0)) + __builtin_bit_cast(float, __builtin_amdgcn_readlane(__builtin_bit_cast(int, v), 32));
}
__device__ __forceinline__ int xch32(int v, const int step) {
    if (step == 0) return __builtin_amdgcn_update_dpp(0, v, 0xB1, 0xF, 0xF, true);
    if (step == 1) return __builtin_amdgcn_update_dpp(0, v, 0x4E, 0xF, 0xF, true);
    if (step == 2) return __builtin_amdgcn_update_dpp(0, v, 0x141, 0xF, 0xF, true);
    if (step == 3) return __builtin_amdgcn_update_dpp(0, v, 0x128, 0xF, 0xF, true);
    return __builtin_amdgcn_ds_swizzle(v, 0x401F);
}
__device__ __forceinline__ float red8(float x) { x += dpp_f(x, 0); x += dpp_f(x, 1); x += dpp_f(x, 2); return x; }

#define XB_TMO      128
#define XB_XCNT(j)  (256  + 64 * (j))
#define XB_XSUB(j)  (1280 + 64 * (j))
#define XB_XGEN(j)  (2304 + 64 * (j))
#define XB_TOP      3328
#define XB_TOPGEN   3392
#define XCD_BAR_WORDS 3456
#define XB_SPIN_CAP (1u << 22)
__device__ __forceinline__ unsigned xb_ld(unsigned* p)              { return __hip_atomic_load(p, __ATOMIC_RELAXED, __HIP_MEMORY_SCOPE_AGENT); }
__device__ __forceinline__ unsigned xb_add(unsigned* p, unsigned v) { return __hip_atomic_fetch_add(p, v, __ATOMIC_RELAXED, __HIP_MEMORY_SCOPE_AGENT); }
__device__ __forceinline__ unsigned xb_xcc_id() { return (unsigned)__builtin_amdgcn_s_getreg((3 << 11) | 20) & 0xFu; }
#define XB_SPIN(cond, bar) do { unsigned _sp = 0; while (cond) { __builtin_amdgcn_s_sleep(1); \
    if ((++_sp & 255u) == 0u) { if (xb_ld(&(bar)[XB_TMO])) break; if (_sp > XB_SPIN_CAP) { atomicAdd(&(bar)[XB_TMO], 1u); break; } } } } while (0)
struct XcdBarrier { unsigned* bar; unsigned x; volatile LAS unsigned* st; };
__device__ __forceinline__ XcdBarrier xcd_barrier_post(unsigned* bar, volatile LAS unsigned* st) {
    XcdBarrier b; b.bar = bar; b.x = xb_xcc_id(); b.st = st;
    if (threadIdx.x == 0) (void)xb_add(&bar[XB_XCNT(b.x)], 1u);
    return b;
}
__device__ __forceinline__ void xcd_barrier_complete(unsigned* bar, unsigned x, unsigned& nloc, unsigned& nx) {
    const unsigned G = gridDim.x * gridDim.y * gridDim.z;
    unsigned sum, cnt, mine, sp = 0u;
    for (;;) {
        sum = 0u; cnt = 0u; mine = 0u;
#pragma unroll
        for (unsigned j = 0; j < 16; ++j) { const unsigned c = xb_ld(&bar[XB_XCNT(j)]); sum += c; cnt += (c > 0u) ? 1u : 0u; mine = (j == x) ? c : mine; }
        if (sum == G) break;
        __builtin_amdgcn_s_sleep(1);
        if ((++sp & 255u) == 0u) { if (xb_ld(&bar[XB_TMO])) break; if (sp > XB_SPIN_CAP) { atomicAdd(&bar[XB_TMO], 1u); break; } }
    }
    nloc = mine > 0u ? mine : 1u; nx = cnt > 0u ? cnt : 1u;
}
__device__ __forceinline__ void xcd_barrier(const XcdBarrier& b) {
    asm volatile("s_waitcnt vmcnt(0)" ::: "memory");
    __syncthreads();
    if (threadIdx.x == 0) {
        unsigned* bar = b.bar;
        __builtin_amdgcn_s_waitcnt(0);
        unsigned nloc = b.st[0], nx = b.st[1];
        if (nloc == 0u) { xcd_barrier_complete(bar, b.x, nloc, nx); b.st[0] = nloc; b.st[1] = nx; }
        const unsigned old = xb_add(&bar[XB_XSUB(b.x)], 1u);
        const unsigned gen = old / nloc;
        if (old + 1u == (gen + 1u) * nloc) {
            __builtin_amdgcn_fence(__ATOMIC_RELEASE, "agent");
            asm volatile("s_waitcnt vmcnt(0)" ::: "memory");
            const unsigned og = xb_add(&bar[XB_TOP], 1u);
            const unsigned tg = og / nx;
            if (og + 1u == (tg + 1u) * nx) xb_add(&bar[XB_TOPGEN], 1u);
            else XB_SPIN(xb_ld(&bar[XB_TOPGEN]) == tg, bar);
            __builtin_amdgcn_fence(__ATOMIC_ACQUIRE, "agent");
            xb_add(&bar[XB_XGEN(b.x)], 1u);
            asm volatile("s_waitcnt vmcnt(0)" ::: "memory");
        } else {
            XB_SPIN(xb_ld(&bar[XB_XGEN(b.x)]) == gen, bar);
            __builtin_amdgcn_fence(__ATOMIC_ACQUIRE, "agent");
            asm volatile("s_waitcnt vmcnt(0)" ::: "memory");
        }
    }
    __syncthreads();
}

namespace pg8 {
constexpr int MOE_CAP = 34816;
constexpr int BM = 256, BK = 64, HALF = 128, HTB = HALF * BK * 2, STAGE_BYTES = 8 * HTB, NXCD = 8, WGM = 8, ROWTAB_OFF = 131072 + 4096;
__host__ __device__ __forceinline__ int lds_byte(int r, int c) { const int st = (r >> 4) * 2 + (c >> 5), rr = r & 15, cc = c & 31, ob = rr * 64 + cc * 2; return st * 1024 + (ob ^ (((ob >> 9) & 1) << 5)); }
__host__ __device__ __forceinline__ void stage_rc(int b, int& R, int& C) { const int st = b / 1024, sb = b % 1024, swz = sb ^ (((sb >> 9) & 1) << 5); R = (st >> 1) * 16 + swz / 64; C = (st & 1) * 32 + (swz % 64) / 2; }
__host__ __device__ __forceinline__ int perm32(int rho) { const int n = rho >> 4, i = rho & 15; return 8 * (i >> 2) + 4 * n + (i & 3); }
struct Unit { int pm, pn, e; };
__device__ __forceinline__ unsigned cvt_pk_bf16(float lo, float hi) { return pk2(lo, hi); }

__device__ __forceinline__ void tile_of(int L, int nM, int nN, int& pm, int& pn) {
    const int nwg = nM * nN; int wgid = L;
    { const int q = nwg / NXCD, r = nwg % NXCD, xcd = wgid % NXCD, off = wgid / NXCD; wgid = (xcd < r ? xcd * (q + 1) : r * (q + 1) + (xcd - r) * q) + off; }
    const int nig = WGM * nN, gid = wgid / nig, fm = gid * WGM, gsz = (nM - fm) < WGM ? (nM - fm) : WGM;
    pm = fm + ((wgid % nig) % gsz); pn = (wgid % nig) / gsz;
}
struct SchedStatic {
    static constexpr bool GATHER = false;
    const char* A; const char* Bt; size_t tstep; int nM, nN, G, c;
    __device__ __forceinline__ void init(const void* A_, const void* Bt_, int M, int N, int K, int G_, int c_) { A = (const char*)A_; Bt = (const char*)Bt_; tstep = (size_t)BM * K * 2; nM = M / BM; nN = N / BM; G = G_; c = c_; }
    __device__ __forceinline__ bool next(int i, Unit& u) const { const long L = (long)i * G + c; if (L >= (long)nM * nN) return false; tile_of((int)L, nM, nN, u.pm, u.pn); u.e = 0; return true; }
    __device__ __forceinline__ const char* aptr(const Unit& u) const { return A + (size_t)u.pm * tstep; }
    __device__ __forceinline__ const char* bptr(const Unit& u) const { return Bt + (size_t)u.pn * tstep; }
};
struct SchedWin {
    static constexpr bool GATHER = false;
    const char* A; const char* Bt; size_t tstep; int G, c, part;
    __device__ __forceinline__ bool next(int i, Unit& u) const {
        const int L = i * G + c, nmf = part ? 128 : 136, nfull = nmf * 27; u.e = 0;
        if (L < nfull) { tile_of(L, nmf, 27, u.pm, u.pn); return true; }
        const int L2 = L - nfull; if (!part || L2 >= 8 * 9) return false;
        u.pm = 128 + L2 / 9; u.pn = 6 + L2 % 9; return true; }
    __device__ __forceinline__ const char* aptr(const Unit& u) const { return A + (size_t)u.pm * tstep; }
    __device__ __forceinline__ const char* bptr(const Unit& u) const { return Bt + (size_t)u.pn * tstep; }
};
struct SchedP {
    static constexpr bool GATHER = false;
    const char* A; const char* Bt; size_t tstep; int nM, G, c;
    __device__ __forceinline__ bool next(int i, Unit& u) const { const long L = (long)i * G + c; if (L >= (long)nM * 10) return false; tile_of((int)L, nM, 10, u.pm, u.pn); u.e = 0; return true; }
    __device__ __forceinline__ const char* aptr(const Unit& u) const { return A + (size_t)u.pm * tstep + (u.pn < 8 ? 0 : 256); }
    __device__ __forceinline__ const char* bptr(const Unit& u) const { return Bt + (size_t)u.pn * tstep + (u.pn < 8 ? 0 : 256); }
};
struct SchedMerge {
    static constexpr bool GATHER = false;
    const char* A0; const char* A1; const char* A2; const char* Bt; size_t tstep, bstride; int nM, nN, G, c;
    __device__ __forceinline__ bool next(int i, Unit& u) const { const int j = i / 3, br = i - 3 * j; const long L = (long)j * G + c; if (L >= (long)nM * nN) return false; tile_of((int)L, nM, nN, u.pm, u.pn); u.e = br; return true; }
    __device__ __forceinline__ const char* aptr(const Unit& u) const { return (u.e == 0 ? A0 : (u.e == 1 ? A1 : A2)) + (size_t)u.pm * tstep; }
    __device__ __forceinline__ const char* bptr(const Unit& u) const { return Bt + (size_t)u.e * bstride + (size_t)u.pn * tstep; }
};
struct SchedMoe {
    static constexpr bool GATHER = false;
    const char* A; const char* Bt; size_t tstep, estride; int NPN, G, c; const LAS int* base;
    __device__ __forceinline__ bool next(int i, Unit& u) const {
        const int ntiles = base[32] >> 8; const int per = G >> 3;
        const long L = (long)i * G + (((G & 7) == 0) ? (c & 7) * per + (c >> 3) : c);
        if (L >= (long)ntiles * NPN) return false;
        u.pm = (int)(L / NPN); u.pn = (int)(L % NPN); const int r0 = u.pm << 8; int e = 0;
#pragma unroll 1
        for (int k = 1; k < 32; ++k) e += (r0 >= base[k]) ? 1 : 0;
        u.e = e; return true;
    }
    __device__ __forceinline__ const char* aptr(const Unit& u) const { return A + (size_t)u.pm * tstep; }
    __device__ __forceinline__ const char* bptr(const Unit& u) const { return Bt + (size_t)u.e * estride + (size_t)u.pn * tstep; }
};
struct SchedMoeG : SchedMoe {
    static constexpr bool GATHER = true;
    const unsigned* rowof;
    __device__ __forceinline__ const char* aptr(const Unit&) const { return A; }
    __device__ __forceinline__ const unsigned* rowptr(const Unit& u) const { return rowof + (size_t)u.e * MOE_CAP + ((u.pm << 8) - base[u.e]); }
    __device__ __forceinline__ int valid(const Unit& u) const { return base[64 + u.e] - ((u.pm << 8) - base[u.e]); }
};

template <class Epi, class Sched>
__device__ __forceinline__ void gemm_phase(LAS unsigned char* lds, const int tid, const int K, const Sched& S, const Epi& E, const int ntk = 0) {
    const int wid = __builtin_amdgcn_readfirstlane(tid >> 6), lane = tid & 63, wr = wid >> 2, wc = wid & 3, fr = lane & 15, fq = lane >> 4;
    const int nt = ntk ? ntk : K / BK;
    unsigned voffA[2], voffB[2];
#pragma unroll
    for (int i = 0; i < 2; ++i) { int R, C; stage_rc(tid * 16 + i * 8192, R, C); const int Rb = Epi::PERM ? ((R & ~31) + perm32(R & 31)) : R;
        voffA[i] = (unsigned)(R * K + C) * 2u; voffB[i] = (unsigned)(Rb * K + C) * 2u; }
    const size_t kstep = (size_t)(BK * 2);
    const size_t hstep = (size_t)HALF * K * 2;
    const unsigned ldsw = (unsigned)wid * 1024u;
    const int aoff = lds_byte(wr * 64 + fr, fq * 8), boff = lds_byte(wc * 32 + fr, fq * 8);
#define PG8_SA(b, h) (((b) * 2 + (h)) * HTB)
#define PG8_SB(b, h) ((4 + (b) * 2 + (h)) * HTB)
#define PG8_STAGE(bufoff, gbase, voff) do { _Pragma("unroll") for (int _i = 0; _i < 2; ++_i) \
        __builtin_amdgcn_global_load_lds((const unsigned*)((const char*)(gbase) + (voff)[_i]), (LAS unsigned*)(lds + (bufoff) + ldsw + _i * 8192), 16, 0, 0); } while (0)
#define PG8_STAGEA(bufoff, kp, h) do { if constexpr (Sched::GATHER) { _Pragma("unroll") for (int _i = 0; _i < 2; ++_i) \
        __builtin_amdgcn_global_load_lds((const unsigned*)((const char*)(kp) + g[2 * (h) + _i]), (LAS unsigned*)(lds + (bufoff) + ldsw + _i * 8192), 16, 0, 0); } \
        else { PG8_STAGE(bufoff, (kp) + (h) * hstep, voffA); } } while (0)
#define PG8_GLOAD(un_, buf) do { const LAS unsigned* rt_ = (const LAS unsigned*)(lds + ROWTAB_OFF + (buf) * 1024) + gR0; const int nv_ = S.valid(un_); \
        _Pragma("unroll") for (int _j = 0; _j < 4; ++_j) g[_j] = ((gR0 + 64 * _j < nv_) ? rt_[64 * _j] : 0u) + gCb; } while (0)
#define PG8_GDMA(un_, buf) do { if (wid == 0) { unsigned lo_ = (unsigned)threadIdx.x; asm volatile("" : "+v"(lo_)); lo_ = (lo_ & 63u) * 16u; \
        __builtin_amdgcn_global_load_lds((const unsigned*)((const char*)S.rowptr(un_) + lo_), (LAS unsigned*)(lds + ROWTAB_OFF + (buf) * 1024), 16, 0, 0); } } while (0)
#define PG8_LDA(dst, b, h) do { _Pragma("unroll") for (int m = 0; m < 4; ++m) _Pragma("unroll") for (int k = 0; k < 2; ++k) dst[m][k] = *(const LAS bf16x8*)(lds + PG8_SA(b, h) + aoff + m * 2048 + k * 1024); } while (0)
#define PG8_LDB(dst, b, h) do { _Pragma("unroll") for (int n = 0; n < 2; ++n) _Pragma("unroll") for (int k = 0; k < 2; ++k) dst[n][k] = *(const LAS bf16x8*)(lds + PG8_SB(b, h) + boff + n * 2048 + k * 1024); } while (0)
#define PG8_MMA(ai, bj, At, Bt) do { __builtin_amdgcn_s_setprio(1); _Pragma("unroll") for (int m = 0; m < 4; ++m) _Pragma("unroll") for (int n = 0; n < 2; ++n) _Pragma("unroll") for (int k = 0; k < 2; ++k) \
        acc[ai][bj][m][n] = __builtin_amdgcn_mfma_f32_16x16x32_bf16(Bt[n][k], At[m][k], acc[ai][bj][m][n], 0, 0, 0); __builtin_amdgcn_s_setprio(0); } while (0)
#define PG8_WAIT_V(n) asm volatile("s_waitcnt vmcnt(" #n ")" ::: "memory")
#define PG8_WAIT_L(n) asm volatile("s_waitcnt lgkmcnt(" #n ")" ::: "memory")
#define PG8_BAR __builtin_amdgcn_s_barrier()
#define PG8_SCHED __builtin_amdgcn_sched_barrier(0)
    Unit cur, nxt; int ui = 0;
    if (!S.next(0, cur)) return;
    f32x4 acc[2][2][4][2];
#pragma unroll
    for (int a = 0; a < 2; ++a)
#pragma unroll
        for (int b = 0; b < 2; ++b)
#pragma unroll
            for (int m = 0; m < 4; ++m)
#pragma unroll
                for (int n = 0; n < 2; ++n) acc[a][b][m][n] = (f32x4){0.f, 0.f, 0.f, 0.f};
    bf16x8 At[4][2], B0[2][2], B1[2][2];
    const char* cA = S.aptr(cur); const char* cB = S.bptr(cur);
    unsigned g[4] = {0u, 0u, 0u, 0u}; int gR0 = 0; unsigned gCb = 0u;
    if constexpr (Sched::GATHER) { int R, C; stage_rc(tid * 16, R, C); gR0 = R; gCb = (unsigned)C * 2u;
        PG8_GDMA(cur, 0); PG8_WAIT_V(0); PG8_BAR; PG8_GLOAD(cur, 0); }
    PG8_STAGE(PG8_SB(0, 0), cB, voffB); PG8_STAGE(PG8_SB(0, 1), cB + hstep, voffB); PG8_STAGEA(PG8_SA(0, 0), cA, 0); PG8_STAGEA(PG8_SA(0, 1), cA, 1);
    if (wr == 1) PG8_BAR;
    PG8_WAIT_V(2); PG8_BAR;
    PG8_STAGE(PG8_SB(1, 0), cB + kstep, voffB); PG8_STAGEA(PG8_SA(1, 0), cA + kstep, 0); PG8_STAGE(PG8_SB(1, 1), cB + hstep + kstep, voffB);
    PG8_WAIT_V(6); PG8_BAR;
    for (;;) {
        const bool has_next = S.next(ui + 1, nxt);
        const char* nA = has_next ? S.aptr(nxt) : cA; const char* nB = has_next ? S.bptr(nxt) : cB;
        if constexpr (Sched::GATHER) { if (has_next) PG8_GDMA(nxt, (ui + 1) & 1); }
        for (int t = 0; t < nt; t += 2) {
            const bool last = (t == nt - 2);
            const char* a1 = cA + (size_t)(t + 1) * kstep;
            const char* a2 = last ? nA : cA + (size_t)(t + 2) * kstep; const char* b2 = last ? nB : cB + (size_t)(t + 2) * kstep;
            const char* a3 = a2 + kstep; const char* b3 = b2 + kstep;
            PG8_LDB(B0, 0, 0); PG8_LDB(B1, 0, 1); PG8_SCHED; PG8_LDA(At, 0, 0); PG8_STAGEA(PG8_SA(1, 1), a1, 1);
            PG8_WAIT_V(8); PG8_WAIT_L(0); PG8_BAR; PG8_MMA(0, 0, At, B0); PG8_MMA(0, 1, At, B1); PG8_BAR; PG8_SCHED;
            if constexpr (Sched::GATHER) { if (last && has_next) PG8_GLOAD(nxt, (ui + 1) & 1); PG8_SCHED; }
            PG8_LDA(At, 0, 1); PG8_STAGE(PG8_SB(0, 0), b2, voffB); PG8_STAGE(PG8_SB(0, 1), b2 + hstep, voffB); PG8_STAGEA(PG8_SA(0, 0), a2, 0);
            PG8_WAIT_V(8); PG8_WAIT_L(0); PG8_BAR; PG8_MMA(1, 0, At, B0); PG8_MMA(1, 1, At, B1); PG8_BAR; PG8_SCHED;
            PG8_LDB(B0, 1, 0); PG8_LDB(B1, 1, 1); PG8_SCHED; PG8_LDA(At, 1, 0); PG8_STAGEA(PG8_SA(0, 1), a2, 1);
            PG8_WAIT_V(8); PG8_WAIT_L(0); PG8_BAR; PG8_MMA(0, 0, At, B0); PG8_MMA(0, 1, At, B1); PG8_BAR; PG8_SCHED;
            PG8_LDA(At, 1, 1); PG8_STAGE(PG8_SB(1, 0), b3, voffB); PG8_STAGE(PG8_SB(1, 1), b3 + hstep, voffB); PG8_STAGEA(PG8_SA(1, 0), a3, 0);
            PG8_WAIT_V(8); PG8_WAIT_L(0); PG8_BAR; PG8_MMA(1, 0, At, B0); PG8_MMA(1, 1, At, B1); PG8_BAR; PG8_SCHED;
        }
        if (wr == 0) PG8_BAR;
        { int t2_ = (int)threadIdx.x; asm volatile("" : "+v"(t2_)); E(acc, cur, wr, wc, t2_ & 15, (t2_ >> 4) & 3); }
        if (!has_next) break;
#pragma unroll
        for (int a = 0; a < 2; ++a)
#pragma unroll
            for (int b = 0; b < 2; ++b)
#pragma unroll
                for (int m = 0; m < 4; ++m)
#pragma unroll
                    for (int n = 0; n < 2; ++n) acc[a][b][m][n] = (f32x4){0.f, 0.f, 0.f, 0.f};
        cur = nxt; cA = nA; cB = nB; ++ui;
        if (wr == 1) PG8_BAR;
    }
    PG8_WAIT_V(0);
    PG8_BAR;
#undef PG8_SA
#undef PG8_SB
#undef PG8_STAGE
#undef PG8_STAGEA
#undef PG8_GLOAD
#undef PG8_GDMA
#undef PG8_LDA
#undef PG8_LDB
#undef PG8_MMA
#undef PG8_WAIT_V
#undef PG8_WAIT_L
#undef PG8_BAR
#undef PG8_SCHED
}

struct EpiBf16 {
    static constexpr bool PERM = true;
    bf16* O; int ldc; const float* bias; int bias_stride;
    __device__ __forceinline__ void operator()(const f32x4 (&acc)[2][2][4][2], const Unit& u, int wr, int wc, int fr, int fq) const {
        const int row0 = u.pm * BM + wr * 64 + fr, col0 = u.pn * BM + wc * 32 + 8 * fq;
        f32x4 bv[2][2];
#pragma unroll
        for (int bj = 0; bj < 2; ++bj)
#pragma unroll
            for (int n = 0; n < 2; ++n) bv[bj][n] = bias ? *(const f32x4*)(bias + (size_t)u.e * bias_stride + col0 + bj * HALF + 4 * n) : (f32x4){0.f, 0.f, 0.f, 0.f};
#pragma unroll
        for (int ai = 0; ai < 2; ++ai)
#pragma unroll
            for (int m = 0; m < 4; ++m) { bf16* rowp = O + (size_t)(row0 + ai * HALF + m * 16) * ldc + col0;
#pragma unroll
                for (int bj = 0; bj < 2; ++bj) { const f32x4 v0 = acc[ai][bj][m][0] + bv[bj][0], v1 = acc[ai][bj][m][1] + bv[bj][1];
                    v4u w; w.x = cvt_pk_bf16(v0[0], v0[1]); w.y = cvt_pk_bf16(v0[2], v0[3]); w.z = cvt_pk_bf16(v1[0], v1[1]); w.w = cvt_pk_bf16(v1[2], v1[3]);
                    *(v4u*)(rowp + bj * HALF) = w; } }
    }
};
template <int MODE> struct EpiGlu {
    static constexpr bool PERM = true;
    bf16* O; int ldc; const float* bias; int bias_stride, hs;
    __device__ __forceinline__ void operator()(const f32x4 (&acc)[2][2][4][2], const Unit& u, int wr, int wc, int fr, int fq) const {
        const int row0 = u.pm * BM + wr * 64 + fr, col0 = u.pn * HALF + wc * 32 + 8 * fq;
        const float* bp = bias + (size_t)u.e * bias_stride + col0;
        f32x4 ba[2], bb[2];
#pragma unroll
        for (int n = 0; n < 2; ++n) { ba[n] = *(const f32x4*)(bp + 4 * n); bb[n] = *(const f32x4*)(bp + hs + 4 * n); }
#pragma unroll
        for (int ai = 0; ai < 2; ++ai)
#pragma unroll
            for (int m = 0; m < 4; ++m) { bf16* rowp = O + (size_t)(row0 + ai * HALF + m * 16) * ldc + col0;
                float o[8];
#pragma unroll
                for (int n = 0; n < 2; ++n) { const f32x4 a = acc[ai][0][m][n] + ba[n], b = acc[ai][1][m][n] + bb[n];
#pragma unroll
                    for (int j = 0; j < 4; ++j) {
                        if (MODE == 0) o[4 * n + j] = a[j] * sigm(b[j]);
                        else { const float g = fminf(a[j], 7.f), up = fminf(fmaxf(b[j], -7.f), 7.f); o[4 * n + j] = (up + 1.f) * g * sigm(1.702f * g); } } }
                v4u w; w.x = cvt_pk_bf16(o[0], o[1]); w.y = cvt_pk_bf16(o[2], o[3]); w.z = cvt_pk_bf16(o[4], o[5]); w.w = cvt_pk_bf16(o[6], o[7]);
                *(v4u*)rowp = w; }
    }
};
struct EpiMerge {
    static constexpr bool PERM = true;
    bf16* mtmp; bf16* Mo; const bf16* zg;
    __device__ __forceinline__ void operator()(const f32x4 (&acc)[2][2][4][2], const Unit& u, int wr, int wc, int fr, int fq) const {
        const int row0 = u.pm * BM + wr * 64 + fr, col0 = u.pn * BM + wc * 32 + 8 * fq;
#pragma unroll
        for (int ai = 0; ai < 2; ++ai)
#pragma unroll
            for (int m = 0; m < 4; ++m) { const size_t r = (size_t)(row0 + ai * HALF + m * 16);
#pragma unroll
                for (int bj = 0; bj < 2; ++bj) { const int c = col0 + bj * HALF;
                    const v4u gz = *(const v4u*)(zg + r * IN_COLS + u.e * 1024 + c);
                    float g[8] = {bflo(gz.x), bfhi(gz.x), bflo(gz.y), bfhi(gz.y), bflo(gz.z), bfhi(gz.z), bflo(gz.w), bfhi(gz.w)};
                    f32x4 t0, t1; bf16* tp = mtmp + r * 1024 + c;
                    if (u.e == 0) { t0 = (f32x4){0.f, 0.f, 0.f, 0.f}; t1 = t0; } else { const v4u pv = *(const v4u*)tp; t0 = (f32x4){bflo(pv.x), bfhi(pv.x), bflo(pv.y), bfhi(pv.y)}; t1 = (f32x4){bflo(pv.z), bfhi(pv.z), bflo(pv.w), bfhi(pv.w)}; }
#pragma unroll
                    for (int j = 0; j < 4; ++j) { t0[j] += sigm(g[j]) * acc[ai][bj][m][0][j]; t1[j] += sigm(g[4 + j]) * acc[ai][bj][m][1][j]; }
                    if (u.e < 2) { v4u w; w.x = cvt_pk_bf16(t0[0], t0[1]); w.y = cvt_pk_bf16(t0[2], t0[3]); w.z = cvt_pk_bf16(t1[0], t1[1]); w.w = cvt_pk_bf16(t1[2], t1[3]); *(v4u*)tp = w; }
                    else { v4u w; w.x = cvt_pk_bf16(t0[0], t0[1]); w.y = cvt_pk_bf16(t0[2], t0[3]); w.z = cvt_pk_bf16(t1[0], t1[1]); w.w = cvt_pk_bf16(t1[2], t1[3]);
                        *(v4u*)(Mo + r * 1024 + c) = w; } } }
    }
};
struct EpiResid {
    static constexpr bool PERM = false;
    float* X; const float* gmod;
    __device__ __forceinline__ void operator()(const f32x4 (&acc)[2][2][4][2], const Unit& u, int wr, int wc, int fr, int fq) const {
        const int row0 = u.pm * BM + wr * 64 + fr, col0 = u.pn * BM + wc * 32 + 4 * fq;
        const int r00 = u.pm * BM; const int w = r00 < T_LAT ? (r00 >> 12) : 8;
        f32x4 gv[2][2];
#pragma unroll
        for (int bj = 0; bj < 2; ++bj)
#pragma unroll
            for (int n = 0; n < 2; ++n) gv[bj][n] = *(const f32x4*)(gmod + (size_t)w * 6144 + col0 + bj * HALF + n * 16);
#pragma unroll
        for (int ai = 0; ai < 2; ++ai)
#pragma unroll
            for (int m = 0; m < 4; ++m) { float* rowp = X + (size_t)(row0 + ai * HALF + m * 16) * 1024 + col0;
#pragma unroll
                for (int bj = 0; bj < 2; ++bj)
#pragma unroll
                    for (int n = 0; n < 2; ++n) { f32x4* p = (f32x4*)(rowp + bj * HALF + n * 16); *p = *p + gv[bj][n] * acc[ai][bj][m][n]; } }
    }
};
}

struct Args { const float* in[51]; float* out; unsigned char* ws; int ph_lo, ph_hi; };
enum { I_X = 0, I_C, I_CTX, I_CCTX, I_ADAW, I_ADAB, I_N1G, I_N2G, I_WIN, I_HYCW, I_HYCB, I_HYW1, I_HYB1, I_HYF1, I_HYW2, I_HYB2, I_HYF2, I_HYW3, I_HYB3, I_HYBIAS,
       I_RWCW, I_RWCB, I_RWWUP, I_RWW0, I_RWAUP, I_RWA0, I_RWGUP, I_RWKK, I_RWKA, I_RWRK, I_RWLNG, I_RWLNB, I_S5ARE, I_S5AIM, I_S5LDT, I_S5BRE, I_S5BIM, I_S5CRE, I_S5CIM, I_S5D,
       I_S5GLUW, I_S5GLUB, I_WBR, I_WOUT, I_RTW, I_RTB, I_W1, I_B1, I_W2, I_B2, I_FING };

typedef const __attribute__((address_space(4))) Args* CArgsP;
__device__ __forceinline__ CArgsP kargs() { CArgsP p = (CArgsP)__builtin_amdgcn_kernarg_segment_ptr(); asm volatile("" : "+s"(p)); return p; }
__device__ __forceinline__ int opaque(int v) { asm volatile("" : "+s"(v)); return v; }
__device__ __forceinline__ int opaque_v(int v) { asm volatile("" : "+v"(v)); return v; }
struct Ctx { CArgsP a; LAS unsigned char* lds; int tid, lane, wave, bid, G; };

__device__ __forceinline__ void row_seq(int row, int& base, int& pos, int& n) {
    if (row < T_LAT) { base = row & ~(SEQ - 1); pos = row & (SEQ - 1); n = SEQ; }
    else { const int r = row - T_LAT; base = T_LAT + (r & ~(CTXL - 1)); pos = r & (CTXL - 1); n = CTXL; }
}
__device__ __forceinline__ float conv3z(const bf16* zc, int pos, int n, float w0, float w1, float w2, float b) {
    const float zm = pos > 0 ? bf2f(zc[(size_t)(pos - 1) * IN_COLS]) : 0.f, z0 = bf2f(zc[(size_t)pos * IN_COLS]), zp = pos < n - 1 ? bf2f(zc[(size_t)(pos + 1) * IN_COLS]) : 0.f;
    return zm * w0 + z0 * w1 + zp * w2 + b;
}

template <int MODE>
__device__ __forceinline__ void transpose_item(const float* W, int K, int N, bf16* WT, int Hs, LAS float* scr, int item, int lane) {
    const int nblk = N / 32, kb = item / nblk, nb = item % nblk, k0 = 64 * kb, n0 = 32 * nb;
#pragma unroll 8
    for (int i = 0; i < 32; ++i) { const int kk = 2 * i + (lane >> 5); scr[kk * 33 + (lane & 31)] = W[(size_t)(k0 + kk) * N + n0 + (lane & 31)]; }
    LDS_WAIT(); asm volatile("" ::: "memory");
    const int c = lane & 7;
#pragma unroll
    for (int j = 0; j < 4; ++j) { const int n = (lane >> 3) + 8 * j; const LAS float* s = scr + (8 * c) * 33 + n;
        v4u o; o.x = pk2(s[0 * 33], s[1 * 33]); o.y = pk2(s[2 * 33], s[3 * 33]); o.z = pk2(s[4 * 33], s[5 * 33]); o.w = pk2(s[6 * 33], s[7 * 33]);
        int dr = n0 + n;
        if (MODE == 1) { const int nc = n0 + n; const int jx = nc < Hs ? nc : nc - Hs; dr = (jx >> 7) * 256 + (nc < Hs ? 0 : 128) + (jx & 127); }
        *(v4u*)(WT + (size_t)dr * K + k0 + 8 * c) = o; }
    LDS_WAIT(); asm volatile("" ::: "memory");
}

__device__ __forceinline__ void p0_prologue(const Ctx& F) {
    const auto& a = *F.a; unsigned char* ws = a.ws;
    const int gw = F.bid * NWAVES + F.wave, NGW = F.G * NWAVES, lane = F.lane;
    float* X = (float*)(ws + WS_X);
    for (int t = gw; t < SEQ; t += NGW) {
        const float pr = (float)(t >> 6), pc = (float)(t & 63);
        f32x4 pe[4];
#pragma unroll
        for (int j = 0; j < 4; ++j)
#pragma unroll
            for (int e = 0; e < 4; ++e) { const float om = __builtin_amdgcn_exp2f((float)(4 * lane + e) * (-13.287712379549449f / 256.0f)); const float ang = ((j < 2) ? pr : pc) * om; pe[j][e] = (j & 1) ? __cosf(ang) : __sinf(ang); }
#pragma unroll 2
        for (int bb = 0; bb < BATCH; ++bb) { const size_t row = (size_t)bb * SEQ + t;
            const f32x4* xi = (const f32x4*)(a.in[I_X] + row * D) + lane; f32x4* xo = (f32x4*)(X + row * D) + lane;
#pragma unroll
            for (int j = 0; j < 4; ++j) xo[64 * j] = xi[64 * j] + pe[j]; }
    }
    for (int row = T_LAT + gw; row < T_ALL; row += NGW) {
        const f32x4* xi = (const f32x4*)(a.in[I_CTX] + (size_t)(row - T_LAT) * D) + lane; f32x4* xo = (f32x4*)(X + (size_t)row * D) + lane;
#pragma unroll
        for (int j = 0; j < 4; ++j) xo[64 * j] = xi[64 * j];
    }
    {
        LAS float* condl = (LAS float*)F.lds; LAS float* psum = (LAS float*)(F.lds + 40960);
        for (int i = F.tid; i < 9 * 1024; i += NTHREADS) { const int w = i >> 10, k = i & 1023; const float cv = (w < 8) ? a.in[I_C][w * 1024 + k] : a.in[I_CCTX][k]; condl[i] = cv / (1.f + expf(-cv)); }
        __syncthreads();
        float* MOD = (float*)(ws + WS_MOD);
        for (int it = F.bid; it < 2 * 96; it += F.G) {
            const int l = it / 96, cg = it % 96, col = cg * 64 + lane;
            float acc[9];
#pragma unroll
            for (int w = 0; w < 9; ++w) acc[w] = 0.f;
            const float* wp = a.in[I_ADAW] + ((size_t)l * 1024 + F.wave * 128) * 6144 + col;
#pragma unroll 1
            for (int k0 = 0; k0 < 128; k0 += 16) { float wv[16];
#pragma unroll
                for (int k = 0; k < 16; ++k) wv[k] = wp[(size_t)(k0 + k) * 6144];
#pragma unroll
                for (int k = 0; k < 16; ++k)
#pragma unroll
                    for (int w = 0; w < 9; ++w) acc[w] += condl[w * 1024 + F.wave * 128 + k0 + k] * wv[k]; }
#pragma unroll
            for (int w = 0; w < 9; ++w) psum[(F.wave * 9 + w) * 64 + lane] = acc[w];
            __syncthreads();
            if (F.wave == 0) {
#pragma unroll
                for (int w = 0; w < 9; ++w) { float s = 0.f;
#pragma unroll
                    for (int wv = 0; wv < 8; ++wv) s += psum[(wv * 9 + w) * 64 + lane];
                    MOD[(size_t)(l * 9 + w) * 6144 + col] = s + a.in[I_ADAB][l * 6144 + col]; }
            }
            __syncthreads();
        }
    }
    {
        LAS float* scr = (LAS float*)(F.lds + F.wave * 16384);
        constexpr int IT_W1 = 16 * 64, IT_W2 = 16 * 32, IT_WIN = 16 * 216, IT_GLU = 8 * 32, IT_WBR = 8 * 32, IT_WOUT = 16 * 32;
        constexpr int N_W1 = 64 * IT_W1, N_W2 = 64 * IT_W2, N_WIN = 2 * IT_WIN, N_GLU = 2 * IT_GLU, N_WBR = 6 * IT_WBR, N_WOUT = 2 * IT_WOUT;
        constexpr int NITEMS = N_W1 + N_W2 + N_WIN + N_GLU + N_WBR + N_WOUT;
        for (int it = gw; it < NITEMS; it += NGW) {
            int r = it;
            if (r < N_W1) { const int mtx = r / IT_W1, l = mtx >> 5, e = mtx & 31; transpose_item<1>(a.in[I_W1] + (size_t)mtx * 1024 * 2048, 1024, 2048, (bf16*)(ws + WS_WTS + l * WL_STRIDE + WO_W1) + (size_t)e * 2048 * 1024, 1024, scr, r % IT_W1, lane); continue; } r -= N_W1;
            if (r < N_W2) { const int mtx = r / IT_W2, l = mtx >> 5, e = mtx & 31; transpose_item<0>(a.in[I_W2] + (size_t)mtx * 1024 * 1024, 1024, 1024, (bf16*)(ws + WS_WTS + l * WL_STRIDE + WO_W2) + (size_t)e * 1024 * 1024, 0, scr, r % IT_W2, lane); continue; } r -= N_W2;
            if (r < N_WIN) { const int l = r / IT_WIN; transpose_item<0>(a.in[I_WIN] + (size_t)l * 1024 * IN_COLS, 1024, IN_COLS, (bf16*)(ws + WS_WTS + l * WL_STRIDE + WO_WIN), 0, scr, r % IT_WIN, lane); continue; } r -= N_WIN;
            if (r < N_GLU) { const int l = r / IT_GLU; transpose_item<1>(a.in[I_S5GLUW] + (size_t)l * 512 * 1024, 512, 1024, (bf16*)(ws + WS_WTS + l * WL_STRIDE + WO_GLU), 512, scr, r % IT_GLU, lane); continue; } r -= N_GLU;
            if (r < N_WBR) { const int mtx = r / IT_WBR, l = mtx / 3, br = mtx % 3; transpose_item<0>(a.in[I_WBR] + (size_t)mtx * 512 * 1024, 512, 1024, (bf16*)(ws + WS_WTS + l * WL_STRIDE + WO_WBR) + (size_t)br * 1024 * 512, 0, scr, r % IT_WBR, lane); continue; } r -= N_WBR;
            { const int l = r / IT_WOUT; transpose_item<0>(a.in[I_WOUT] + (size_t)l * 1024 * 1024, 1024, 1024, (bf16*)(ws + WS_WTS + l * WL_STRIDE + WO_WOUT), 0, scr, r % IT_WOUT, lane); }
        }
        for (int i = F.bid * NTHREADS + F.tid; i < 2 * 2560 * 256; i += F.G * NTHREADS) {
            const int l = i / (2560 * 256), r = i % (2560 * 256), n = r >> 8, k = r & 255; float v = 0.f;
            if (n < 1024) { if (k < 64) v = a.in[I_RWWUP][(((size_t)l * 2 + (n >> 9)) * 64 + k) * 512 + (n & 511)]; }
            else if (n < 2048) { if (k >= 64 && k < 128) v = a.in[I_RWAUP][(((size_t)l * 2 + ((n - 1024) >> 9)) * 64 + (k - 64)) * 512 + (n & 511)]; }
            else { if (k >= 128) v = a.in[I_RWGUP][((size_t)l * 128 + (k - 128)) * 512 + (n - 2048)]; }
            ((bf16*)(ws + WS_WTS + l * WL_STRIDE + WO_RWCAT))[r] = (bf16)f2bf(v);
        }
    }
    __syncthreads();
    {
        LAS float* feats = (LAS float*)F.lds; LAS float* h1 = feats + 8 * 33; LAS float* h2 = h1 + 8 * 64;
        constexpr int NIT = 2 * (512 + 32);
        for (int it = F.bid; it < NIT; it += F.G) {
            const int l = it / 544, r = it % 544, nsel = r >= 512, n = nsel ? CTXL : SEQ, p0 = (nsel ? r - 512 : r) * 8;
            if (l == DEPTH - 1 && nsel) continue;
            if (F.tid < 8 * 33) { const int p = F.tid / 33, i = F.tid % 33, pos = p0 + p; float f;
                if (i == 0) f = (float)pos / (float)(n - 1);
                else { const int k = (i - 1) & 15; const float band = 1e-4f + (float)k * ((15.0f - 1e-4f) / 15.0f); const float ang = (6.283185307179586f * (float)pos / (float)n) * band; f = (i <= 16) ? cosf(ang) : -sinf(ang); }
                feats[p * 33 + i] = f; }
            __syncthreads();
            { const int p = F.tid >> 6, j = F.tid & 63; float s = a.in[I_HYB1][l * 64 + j]; const float* w1p = a.in[I_HYW1] + (size_t)l * 33 * 64 + j;
#pragma unroll
                for (int i = 0; i < 33; ++i) s += feats[p * 33 + i] * w1p[i * 64];
                h1[p * 64 + j] = sinf(a.in[I_HYF1][l * 64 + j] * s); }
            __syncthreads();
            { const int p = F.tid >> 6, j = F.tid & 63; float s = a.in[I_HYB2][l * 64 + j];
                const float* w2p = a.in[I_HYW2] + (size_t)l * 64 * 64 + j;
#pragma unroll 16
                for (int i = 0; i < 64; ++i) s += h1[p * 64 + i] * w2p[i * 64];
                h2[p * 64 + j] = sinf(a.in[I_HYF2][l * 64 + j] * s); }
            __syncthreads();
            float acc[4][8];
#pragma unroll
            for (int q = 0; q < 4; ++q)
#pragma unroll
                for (int p = 0; p < 8; ++p) acc[q][p] = 0.f;
            const float* w3 = a.in[I_HYW3] + (size_t)l * 64 * 2048 + F.tid;
#pragma unroll 8
            for (int i = 0; i < 64; ++i) { float wv[4];
#pragma unroll
                for (int q = 0; q < 4; ++q) wv[q] = w3[(size_t)i * 2048 + q * 512];
#pragma unroll
                for (int p = 0; p < 8; ++p) { const float hv = h2[p * 64 + i];
#pragma unroll
                    for (int q = 0; q < 4; ++q) acc[q][p] += hv * wv[q]; } }
            const int c = F.tid; const float dstart = logf(0.01f) / 1.5f, dstop = logf(0.01f) / 0.3f; const float delta = fabsf(dstart + (float)c * ((dstop - dstart) / 511.0f));
            const int RL = nsel ? HY_RLENC : HY_RLEN, off = n + 47; const float rn1 = 1.0f / (float)(n - 1);
            bf16* Rb = (bf16*)(ws + WS_GF + l * GF_STRIDE + (nsel ? GF_CTX : 0));
#pragma unroll
            for (int q = 0; q < 4; ++q) { const int o = q >> 1, side = q & 1; const float b3 = a.in[I_HYB3][l * 2048 + q * 512 + c];
                bf16* Rc = Rb + ((size_t)o * 512 + c) * RL;
#pragma unroll
                for (int p = 0; p < 8; ++p) { const int pos = p0 + p; const float t = (float)pos * rn1; const float val = (acc[q][p] + b3) * __expf(-t * delta);
                    if (side == 0) Rc[off - pos] = (bf16)f2bf(val);
                    else if (pos >= 1) Rc[off + pos] = (bf16)f2bf(val); }
                if (p0 == 0 && side == 0) { for (int m = 0; m < 48; ++m) Rc[m] = 0; for (int m = off + n; m < RL; ++m) Rc[m] = 0; } }
            __syncthreads();
        }
    }
}

__device__ __forceinline__ void stage_norm1(const Ctx& F, int l) {
    const auto& a = *F.a; unsigned char* ws = a.ws; const int lane = F.lane;
    const int gw = F.bid * NWAVES + F.wave, NGW = F.G * NWAVES;
    float* X = (float*)(ws + WS_X); bf16* H = (bf16*)(ws + WS_H); const float* MOD = (const float*)(ws + WS_MOD);
    const bf16* YS = (const bf16*)(ws + WS_XS); const int* POS = (const int*)(ws + WS_POS); const float* GATE = (const float*)(ws + WS_GATE);
    const int nrows = (l == DEPTH) ? T_LAT : T_ALL;
    f32x4 ngv[4];
    { const f32x4* ngp = (l == DEPTH) ? (const f32x4*)a.in[I_FING] + lane : (const f32x4*)(a.in[I_N1G] + l * D) + lane;
#pragma unroll
      for (int j = 0; j < 4; ++j) ngv[j] = ngp[64 * j]; }
    f32x4 vn[4]; v2u ysn[4][4]; int4 pnn = make_int4(0, 0, 0, 0); f32x4 gn = (f32x4){0.f, 0.f, 0.f, 0.f}, gnn = gn;
#pragma unroll
    for (int k = 0; k < 4; ++k)
#pragma unroll
        for (int j = 0; j < 4; ++j) ysn[k][j] = (v2u){0u, 0u};
#define N1_LDYS(p4_) do { const int pk_[4] = {(p4_).x, (p4_).y, (p4_).z, (p4_).w}; _Pragma("unroll") for (int k = 0; k < 4; ++k) { const v2u* yr_ = (const v2u*)(YS + (size_t)pk_[k] * D) + lane; \
        _Pragma("unroll") for (int j = 0; j < 4; ++j) ysn[k][j] = yr_[64 * j]; } } while (0)
    if (gw < nrows) {
#pragma unroll
        for (int j = 0; j < 4; ++j) vn[j] = ((const f32x4*)(X + (size_t)gw * D) + lane)[64 * j];
        if (l > 0) { const int4 p0 = *(const int4*)(POS + gw * 4); gn = *(const f32x4*)(GATE + gw * 4);
            if (gw + NGW < nrows) { pnn = *(const int4*)(POS + (gw + NGW) * 4); gnn = *(const f32x4*)(GATE + (gw + NGW) * 4); }
            N1_LDYS(p0); } }
#pragma unroll 1
    for (int row = gw; row < nrows; row += NGW) {
        const int w = row < T_LAT ? (row >> 12) : 8;
        f32x4* xr = (f32x4*)(X + (size_t)row * D) + lane;
        f32x4 v[4]; v2u ysc[4][4];
#pragma unroll
        for (int j = 0; j < 4; ++j) v[j] = vn[j];
#pragma unroll
        for (int k = 0; k < 4; ++k)
#pragma unroll
            for (int j = 0; j < 4; ++j) ysc[k][j] = ysn[k][j];
        const f32x4 gc = gn; const int4 pnx = pnn; gn = gnn;
        const int rn = row + NGW, rnn = row + 2 * NGW;
        if (rn < nrows) {
#pragma unroll
            for (int j = 0; j < 4; ++j) vn[j] = ((const f32x4*)(X + (size_t)rn * D) + lane)[64 * j];
            if (l > 0) N1_LDYS(pnx); }
        if (l > 0 && rnn < nrows) { pnn = *(const int4*)(POS + rnn * 4); gnn = *(const f32x4*)(GATE + rnn * 4); }
        f32x4 m0[4], m1[4], m2[4];
        if (l < DEPTH) {
#pragma unroll
            for (int j = 0; j < 4; ++j) { m0[j] = ((const f32x4*)(MOD + (size_t)(l * 9 + w) * 6144) + lane)[64 * j]; m1[j] = ((const f32x4*)(MOD + (size_t)(l * 9 + w) * 6144 + 1024) + lane)[64 * j]; } }
        if (l > 0) {
#pragma unroll
            for (int j = 0; j < 4; ++j) m2[j] = ((const f32x4*)(MOD + (size_t)((l - 1) * 9 + w) * 6144 + 5120) + lane)[64 * j];
            f32x4 mo[4];
#pragma unroll
            for (int j = 0; j < 4; ++j) mo[j] = (f32x4){0.f, 0.f, 0.f, 0.f};
#pragma unroll
            for (int k = 0; k < TOPK; ++k) { const float g = gc[k];
#pragma unroll
                for (int j = 0; j < 4; ++j) { const v2u y = ysc[k][j]; mo[j][0] += g * bflo(y.x); mo[j][1] += g * bfhi(y.x); mo[j][2] += g * bflo(y.y); mo[j][3] += g * bfhi(y.y); } }
#pragma unroll
            for (int j = 0; j < 4; ++j) { v[j] = v[j] + m2[j] * mo[j]; if (l < DEPTH) xr[64 * j] = v[j]; }
        }
        float ss = 0.f;
#pragma unroll
        for (int j = 0; j < 4; ++j) ss += (v[j][0] * v[j][0] + v[j][1] * v[j][1]) + (v[j][2] * v[j][2] + v[j][3] * v[j][3]);
        const float rstd = __builtin_amdgcn_rsqf(wave_sum(ss) * (1.f / D) + 1e-6f);
        if (l == DEPTH) {
            f32x4* o = (f32x4*)(a.out + (size_t)row * D) + lane;
#pragma unroll
            for (int j = 0; j < 4; ++j) o[64 * j] = v[j] * rstd * ngv[j];
        } else {
            v2u* ho = (v2u*)(H + (size_t)row * D) + lane;
#pragma unroll
            for (int j = 0; j < 4; ++j) { const f32x4 h = v[j] * rstd * ngv[j] * (m1[j] + 1.0f) + m0[j]; v2u o; o.x = pk2(h[0], h[1]); o.y = pk2(h[2], h[3]); ho[64 * j] = o; }
        }
    }
#undef N1_LDYS
}

__device__ __forceinline__ void stage_rw_prep1(const Ctx& F, int l) {
    const auto& a = *F.a; unsigned char* ws = a.ws;
    const bf16* __restrict__ Z = (const bf16*)(ws + WS_Z); bf16* __restrict__ ARW = (bf16*)(ws + WS_ARW);
    const int j = 4 * (F.tid & 63), col = 1536 + j, rq = F.tid >> 6;
    const float* cw = a.in[I_RWCW] + (size_t)l * 3 * 1792;
    const f32x4 w0 = *(const f32x4*)(cw + col), w1 = *(const f32x4*)(cw + 1792 + col), w2 = *(const f32x4*)(cw + 2 * 1792 + col), cb = *(const f32x4*)(a.in[I_RWCB] + l * 1792 + col);
#pragma unroll 4
    for (int row = F.bid * 8 + rq; row < T_ALL; row += F.G * 8) {
        int base, pos, n; row_seq(row, base, pos, n);
        const bf16* zc = Z + (size_t)row * IN_COLS + RW_OFF + col;
        const v2u z0 = *(const v2u*)zc;
        v2u zm = (v2u){0u, 0u}, zp = (v2u){0u, 0u};
        if (pos > 0) zm = *(const v2u*)(zc - IN_COLS);
        if (pos < n - 1) zp = *(const v2u*)(zc + IN_COLS);
        f32x4 v = (f32x4){bflo(zm.x), bfhi(zm.x), bflo(zm.y), bfhi(zm.y)} * w0 + (f32x4){bflo(z0.x), bfhi(z0.x), bflo(z0.y), bfhi(z0.y)} * w1 + (f32x4){bflo(zp.x), bfhi(zp.x), bflo(zp.y), bfhi(zp.y)} * w2 + cb;
#pragma unroll
        for (int e2 = 0; e2 < 4; ++e2) { if (j < 64) v[e2] = tanh_fast(v[e2]); else if (j >= 128) v[e2] = sigm(v[e2]); }
        v2u o; o.x = pk2(v[0], v[1]); o.y = pk2(v[2], v[3]);
        *(v2u*)(ARW + (size_t)row * 256 + j) = o;
    }
}

__device__ __forceinline__ void stage_rw_prep2(const Ctx& F, int l) {
    const auto& a = *F.a; unsigned char* ws = a.ws; const int lane = F.lane;
    const bf16* Z = (const bf16*)(ws + WS_Z); const bf16* P = (const bf16*)(ws + WS_P); bf16* SCN = (bf16*)(ws + WS_SCN);
    const int gw = F.bid * NWAVES + F.wave, NGW = F.G * NWAVES;
    constexpr int TR = 17, NRT = T_ALL / TR;
    const float* cw = a.in[I_RWCW] + (size_t)l * 3 * 1792; const float* cbp = a.in[I_RWCB] + l * 1792;
    for (int tile = gw; tile < NRT * 4; tile += NGW) {
        const int rt = tile % NRT, hp = tile / NRT, row0 = rt * TR, c0 = hp * 128 + 2 * lane;
        f32x2 w[3][3], cb[3];
#pragma unroll
        for (int s = 0; s < 3; ++s) { cb[s] = *(const f32x2*)(cbp + s * 512 + c0);
#pragma unroll
            for (int j = 0; j < 3; ++j) w[s][j] = *(const f32x2*)(cw + j * 1792 + s * 512 + c0); }
        const f32x2 KKw = *(const f32x2*)(a.in[I_RWKK] + l * 512 + c0), KAw = *(const f32x2*)(a.in[I_RWKA] + l * 512 + c0);
        f32x2 W0[2], A0[2];
#pragma unroll
        for (int d = 0; d < 2; ++d) { W0[d] = *(const f32x2*)(a.in[I_RWW0] + (l * 2 + d) * 512 + c0); A0[d] = *(const f32x2*)(a.in[I_RWA0] + (l * 2 + d) * 512 + c0); }
        const unsigned* zb = (const unsigned*)(Z + RW_OFF + c0);
        unsigned zw[8][3], pw_[8][4];
#define P2_LDZ(j_) do { const int rr_ = row0 + (j_); if (rr_ >= 0 && rr_ < T_ALL) { _Pragma("unroll") for (int s = 0; s < 3; ++s) zw[((j_) + 1) & 7][s] = zb[(size_t)rr_ * (IN_COLS / 2) + s * 256]; } \
        else { _Pragma("unroll") for (int s = 0; s < 3; ++s) zw[((j_) + 1) & 7][s] = 0u; } } while (0)
#define P2_LDP(j_) do { const unsigned* pr_ = (const unsigned*)(P + (size_t)(row0 + (j_)) * 2560 + c0); pw_[(j_) & 7][0] = pr_[0]; pw_[(j_) & 7][1] = pr_[512]; pw_[(j_) & 7][2] = pr_[256]; pw_[(j_) & 7][3] = pr_[768]; } while (0)
        P2_LDZ(-1); P2_LDZ(0); P2_LDZ(1); P2_LDZ(2); P2_LDZ(3); P2_LDP(0); P2_LDP(1); P2_LDP(2);
#pragma unroll
        for (int i = 0; i < TR; ++i) {
            const int row = row0 + i; int base, pos, n; row_seq(row, base, pos, n);
            if (i + 4 <= TR) P2_LDZ(i + 4);
            if (i + 3 < TR) P2_LDP(i + 3);
            unsigned zm[3], z0[3], zp[3], pc_[4];
#pragma unroll
            for (int s = 0; s < 3; ++s) { zm[s] = zw[i & 7][s]; z0[s] = zw[(i + 1) & 7][s]; zp[s] = zw[(i + 2) & 7][s]; }
#pragma unroll
            for (int e = 0; e < 4; ++e) pc_[e] = pw_[i & 7][e];
            const float mlo = pos > 0 ? 1.f : 0.f, mhi = pos < n - 1 ? 1.f : 0.f;
            f32x2 u[3];
#pragma unroll
            for (int s = 0; s < 3; ++s) u[s] = (f32x2){bflo(zm[s]), bfhi(zm[s])} * mlo * w[s][0] + (f32x2){bflo(z0[s]), bfhi(z0[s])} * w[s][1] + (f32x2){bflo(zp[s]), bfhi(zp[s])} * mhi * w[s][2] + cb[s];
            const f32x2 r = u[0], k = u[1], v = u[2];
            f32x2 kk = k * KKw;
            const float ss = red32(kk[0] * kk[0] + kk[1] * kk[1]);
            kk = kk * (__builtin_amdgcn_rsqf(fmaxf(ss, 1e-24f)));
            unsigned* o = (unsigned*)(SCN + (size_t)row * 9 * 512 + c0);
            o[0] = pk2(r[0], r[1]); o[256] = pk2(v[0], v[1]); o[2 * 256] = pk2(kk[0], kk[1]);
#pragma unroll
            for (int d = 0; d < 2; ++d) {
                const unsigned pw = pc_[2 * d], pa = pc_[2 * d + 1];
                float ld[2], kd[2], be[2];
#pragma unroll
                for (int e = 0; e < 2; ++e) {
                    const float uu = W0[d][e] + (e ? bfhi(pw) : bflo(pw));
                    ld[e] = -0.60653065971263342f * sigm(uu);
                    const float av = sigm(A0[d][e] + (e ? bfhi(pa) : bflo(pa)));
                    kd[e] = k[e] * (1.f + (av - 1.f) * KAw[e]); be[e] = kk[e] * av; }
                o[(3 + 3 * d) * 256] = pk2(ld[0], ld[1]); o[(4 + 3 * d) * 256] = pk2(kd[0], kd[1]); o[(5 + 3 * d) * 256] = pk2(be[0], be[1]);
            }
        }
    }
}
#undef P2_LDZ
#undef P2_LDP

__device__ __forceinline__ int seq_row(int b, int d, int sidx) {
    if (sidx < CTXL) { const int t = d ? (CTXL - 1 - sidx) : sidx; return T_LAT + b * CTXL + t; }
    const int tl = sidx - CTXL; const int t = d ? (SEQ - 1 - tl) : tl; return b * SEQ + t;
}

constexpr int CW_WORK = 16384;
constexpr int CW_STAMP = 20480;
#ifdef PROBE_T
#ifndef PROBE_BID
#define PROBE_BID 0
#endif
#define PT(k) do { if (F.bid == PROBE_BID && F.tid == 0 && l == 0) ((unsigned long long*)(F.a->ws + WS_CTL + CW_STAMP * 4))[k] = __builtin_amdgcn_s_memrealtime(); } while (0)
#else
#define PT(k) do { } while (0)
#endif
__device__ __forceinline__ void rw_scan_item(const Ctx& F, int l, int it2) {
    const int it = it2 >> 1, half = it2 & 1;
    const auto& a = *F.a; unsigned char* ws = a.ws; const int tid = F.tid, lane = F.lane;
    const bf16* SCN = (const bf16*)(ws + WS_SCN); float* YD = (float*)(ws + WS_YDIR);
    LAS float* sbuf = (LAS float*)F.lds;
    LAS float* ybuf = (LAS float*)(F.lds + 49152);
    const bool comp = F.wave < 4;
    const int lt = tid & 255, ls = lt >> 4, lj = lt & 15;
    const int vl = lane >> 3, kq = lane & 7, vrow = half * 32 + (F.wave & 3) * 8 + vl;
    constexpr int NCH = (CTXL + SEQ) / 16;
    const int d = it & 1, h = (it >> 1) & 7, b = it >> 4;
    f32x2 S[4];
#pragma unroll
    for (int q = 0; q < 4; ++q) S[q] = (f32x2){0.f, 0.f};
    v2u ldr[6];
#define RW_ISSUE(c) do { const int row_ = seq_row(b, d, (c) * 16 + ls); const v2u* p_ = (const v2u*)(SCN + (size_t)row_ * 9 * 512 + h * 64) + lj; \
        ldr[0] = p_[2 * 128]; ldr[1] = p_[(3 + 3 * d) * 128]; ldr[2] = p_[(5 + 3 * d) * 128]; ldr[3] = p_[(4 + 3 * d) * 128]; ldr[4] = p_[0]; ldr[5] = p_[128]; } while (0)
#define RW_WRITE(bufi) do { LAS float* o_ = sbuf + (((bufi) * 16 + ls) * 6) * 64 + 4 * lj; \
        *(LAS f32x4*)(o_) = (f32x4){-bflo(ldr[0].x), -bfhi(ldr[0].x), -bflo(ldr[0].y), -bfhi(ldr[0].y)}; \
        *(LAS f32x4*)(o_ + 64) = (f32x4){__expf(bflo(ldr[1].x)), __expf(bfhi(ldr[1].x)), __expf(bflo(ldr[1].y)), __expf(bfhi(ldr[1].y))}; \
        *(LAS f32x4*)(o_ + 128) = (f32x4){bflo(ldr[2].x), bfhi(ldr[2].x), bflo(ldr[2].y), bfhi(ldr[2].y)}; *(LAS f32x4*)(o_ + 192) = (f32x4){bflo(ldr[3].x), bfhi(ldr[3].x), bflo(ldr[3].y), bfhi(ldr[3].y)}; \
        *(LAS f32x4*)(o_ + 256) = (f32x4){bflo(ldr[4].x), bfhi(ldr[4].x), bflo(ldr[4].y), bfhi(ldr[4].y)}; *(LAS f32x4*)(o_ + 320) = (f32x4){bflo(ldr[5].x), bfhi(ldr[5].x), bflo(ldr[5].y), bfhi(ldr[5].y)}; } while (0)
#define RW_FLUSH(c) do { const int row_ = seq_row(b, d, (c) * 16 + ls); \
        *(f32x2*)(YD + ((size_t)d * T_ALL + row_) * 512 + h * 64 + half * 32 + 2 * lj) = *(const LAS f32x2*)(ybuf + ((((c) & 1) * 16 + ls) * 64) + half * 32 + 2 * lj); } while (0)
    if (!comp) { RW_ISSUE(0); RW_WRITE(0); RW_ISSUE(1); }
    __syncthreads();
#pragma unroll 1
    for (int c = 0; c < NCH; ++c) {
        const int bi = c & 1;
        if (!comp) {
            if (c + 1 < NCH) RW_WRITE(bi ^ 1);
            if (c + 2 < NCH) RW_ISSUE(c + 2);
            if (c > 0) RW_FLUSH(c - 1);
        } else {
        float yv[16];
        f32x4 opA[10], opB[10]; float vvA, vvB;
#define RW_LD(op, vvx, s_) do { const LAS float* sp_ = sbuf + ((bi * 16 + (s_)) * 6) * 64 + 8 * kq; \
            _Pragma("unroll") for (int q_ = 0; q_ < 5; ++q_) { op[2 * q_] = *(const LAS f32x4*)(sp_ + 64 * q_); op[2 * q_ + 1] = *(const LAS f32x4*)(sp_ + 64 * q_ + 4); } \
            vvx = sbuf[((bi * 16 + (s_)) * 6 + 5) * 64 + vrow]; } while (0)
#define RW_COMP(op, vvx, s_) do { \
            const f32x4 a0 = op[0], a1 = op[1], w0 = op[2], w1 = op[3], b0 = op[4], b1 = op[5], k0 = op[6], k1 = op[7], r0 = op[8], r1 = op[9]; \
            const f32x2 vv2 = (f32x2){vvx, vvx}; \
            const f32x2 p0 = S[1] * (f32x2){a0[2], a0[3]} + S[0] * (f32x2){a0[0], a0[1]}; \
            const f32x2 p1 = S[3] * (f32x2){a1[2], a1[3]} + S[2] * (f32x2){a1[0], a1[1]}; \
            const f32x2 t0 = S[0] * (f32x2){w0[0], w0[1]} + vv2 * (f32x2){k0[0], k0[1]}; \
            const f32x2 t1 = S[1] * (f32x2){w0[2], w0[3]} + vv2 * (f32x2){k0[2], k0[3]}; \
            const f32x2 t2 = S[2] * (f32x2){w1[0], w1[1]} + vv2 * (f32x2){k1[0], k1[1]}; \
            const f32x2 t3 = S[3] * (f32x2){w1[2], w1[3]} + vv2 * (f32x2){k1[2], k1[3]}; \
            const f32x2 ac = p0 + p1; \
            const float sa = red8(ac[0] + ac[1]); \
            const f32x2 sa2 = (f32x2){sa, sa}; \
            S[0] = sa2 * (f32x2){b0[0], b0[1]} + t0; S[1] = sa2 * (f32x2){b0[2], b0[3]} + t1; \
            S[2] = sa2 * (f32x2){b1[0], b1[1]} + t2; S[3] = sa2 * (f32x2){b1[2], b1[3]} + t3; \
            const f32x2 q0 = S[1] * (f32x2){r0[2], r0[3]} + S[0] * (f32x2){r0[0], r0[1]}; \
            const f32x2 q1 = S[3] * (f32x2){r1[2], r1[3]} + S[2] * (f32x2){r1[0], r1[1]}; \
            const f32x2 yc = q0 + q1; \
            yv[s_] = red8(yc[0] + yc[1]); } while (0)
        RW_LD(opA, vvA, 0);
#pragma unroll
        for (int s = 0; s < 16; s += 2) {
            RW_LD(opB, vvB, s + 1);
            __builtin_amdgcn_sched_barrier(0);
            RW_COMP(opA, vvA, s);
            __builtin_amdgcn_sched_barrier(0);
            if (s + 2 < 16) RW_LD(opA, vvA, s + 2);
            __builtin_amdgcn_sched_barrier(0);
            RW_COMP(opB, vvB, s + 1);
            __builtin_amdgcn_sched_barrier(0);
        }
#undef RW_LD
#undef RW_COMP
#pragma unroll
        for (int s = 0; s < 16; ++s) if ((s & 7) == kq) ybuf[((bi * 16 + s) * 64) + vrow] = yv[s];
        }
        __syncthreads();
    }
    if (!comp) RW_FLUSH(NCH - 1);
    __syncthreads();
#undef RW_ISSUE
#undef RW_WRITE
#undef RW_FLUSH
}

constexpr size_t WS_RWSCR = WS_YHY;
constexpr int RWS_QY = 0, RWS_YV = 2048, RWS_PZ = 4096, RWS_ZV = 12288, RWS_SLOT = 20480;
typedef __bf16 bf16x8n __attribute__((ext_vector_type(8)));
__device__ __forceinline__ f32x4 mma16(const bf16x8 a, const bf16x8 b, const f32x4 c) { return __builtin_amdgcn_mfma_f32_16x16x32_bf16(a, b, c, 0, 0, 0); }
__device__ __forceinline__ float dpp_shr(float x, const int n) {
    const int v = __builtin_bit_cast(int, x); int r;
    if (n == 1) r = __builtin_amdgcn_update_dpp(0, v, 0x111, 0xF, 0xF, true); else if (n == 2) r = __builtin_amdgcn_update_dpp(0, v, 0x112, 0xF, 0xF, true);
    else if (n == 4) r = __builtin_amdgcn_update_dpp(0, v, 0x114, 0xF, 0xF, true); else r = __builtin_amdgcn_update_dpp(0, v, 0x118, 0xF, 0xF, true);
    return __builtin_bit_cast(float, r);
}
__device__ __forceinline__ v4u pack8(const float (&x)[8]) { v4u o; o.x = pk2(x[0], x[1]); o.y = pk2(x[2], x[3]); o.z = pk2(x[4], x[5]); o.w = pk2(x[6], x[7]); return o; }
__device__ __forceinline__ void unpack8(const v4u u, float (&x)[8]) { x[0] = bflo(u.x); x[1] = bfhi(u.x); x[2] = bflo(u.y); x[3] = bfhi(u.y); x[4] = bflo(u.z); x[5] = bfhi(u.z); x[6] = bflo(u.w); x[7] = bfhi(u.w); }
constexpr int LDS_ZERO16 = 131072 + 3072;
typedef short bf16x4s __attribute__((ext_vector_type(4)));
__device__ __forceinline__ bf16x4s frag16k(const LAS bf16* m, int rowbase, int lane) { return __builtin_bit_cast(bf16x4s, *(const LAS v2u*)(m + (rowbase + (lane & 15)) * 16 + 4 * (lane >> 4))); }
__device__ __forceinline__ f32x4 mma16(const bf16x4s a, const bf16x4s b, const f32x4 c) { return __builtin_amdgcn_mfma_f32_16x16x16bf16_1k(a, b, c, 0, 0, 0); }
#define frag16(m_, rb_, ln_) frag16k(m_, rb_, ln_)
__device__ __forceinline__ void st_colmaj(LAS bf16* m, int colbase, const f32x4 d, int lane) {
    v2u o; o.x = pk2(d[0], d[1]); o.y = pk2(d[2], d[3]); *(LAS v2u*)(m + (colbase + (lane & 15)) * 16 + 4 * (lane >> 4)) = o; }
__device__ __forceinline__ void st_rowmaj(LAS bf16* m, const f32x4 d, int lane) {
#pragma unroll
    for (int r = 0; r < 4; ++r) m[(4 * (lane >> 4) + r) * 16 + (lane & 15)] = (bf16)f2bf(d[r]); }
template <int KS0, int KS1>
__device__ __forceinline__ void rw_chunk_load(const Ctx& F, int b, int h, int d, int cidx, v4u (&raw)[12]) {
    const int lane = opaque_v(F.lane), t = lane & 15, kg = lane >> 4;
    const bf16* base = (const bf16*)(F.a->ws + WS_SCN) + (size_t)seq_row(b, d, 16 * cidx + t) * 9 * 512 + h * 64;
#pragma unroll
    for (int ks = KS0; ks < KS1; ++ks) { const int off = 32 * ks + 8 * kg;
        raw[6 * ks + 0] = *(const v4u*)(base + (3 + 3 * d) * 512 + off); raw[6 * ks + 1] = *(const v4u*)(base + 2 * 512 + off); raw[6 * ks + 2] = *(const v4u*)(base + off);
        raw[6 * ks + 3] = *(const v4u*)(base + (5 + 3 * d) * 512 + off); raw[6 * ks + 4] = *(const v4u*)(base + (4 + 3 * d) * 512 + off); raw[6 * ks + 5] = *(const v4u*)(base + 512 + off); }
}
__device__ __forceinline__ void rw_chunk_task2(const Ctx& F, const v4u (&raw)[12], LAS unsigned char* wl, f32x4 (&yv)[4], f32x4 (&zv)[4][4]) {
    const int lane = opaque_v(F.lane), t = lane & 15, kg = lane >> 4;
    LAS bf16* ATt = (LAS bf16*)(wl); LAS bf16* RBr = (LAS bf16*)(wl + 2048); LAS bf16* BHt = (LAS bf16*)(wl + 4096); LAS bf16* KHt = (LAS bf16*)(wl + 6144); LAS bf16* VTt = (LAS bf16*)(wl + 8192);
    LAS bf16* WAt = (LAS bf16*)(wl + 10240); LAS bf16* N_r = (LAS bf16*)(wl + 12288); LAS bf16* N_c = (LAS bf16*)(wl + 12800); LAS bf16* T_r = (LAS bf16*)(wl + 13312);
    LAS bf16* AK_r = (LAS bf16*)(wl + 13824); LAS bf16* RB2 = (LAS bf16*)(wl + 14336); LAS bf16* RK_r = (LAS bf16*)(wl + 14848); LAS float* GCl = (LAS float*)(wl + 15360);
    bf16x8 fAb[2], fRb[2], fBb[2], fKb[2];
#pragma unroll
    for (int ks = 0; ks < 2; ++ks) {
        const int off = 32 * ks + 8 * kg;
        float ea[8], er[8], eb[8], eh[8];
        { const v4u uld = raw[6 * ks + 0]; float ld[8]; unpack8(uld, ld);
#pragma unroll
          for (int j = 0; j < 8; ++j) { float c = ld[j]; c += dpp_shr(c, 1); c += dpp_shr(c, 2); c += dpp_shr(c, 4); c += dpp_shr(c, 8);
              const float tot = __builtin_bit_cast(float, __builtin_amdgcn_ds_bpermute((lane | 15) << 2, __builtin_bit_cast(int, c)));
              ea[j] = __expf(c - ld[j]); er[j] = __expf(c); eb[j] = __expf(-c); const float et_ = __expf(tot); eh[j] = et_ * eb[j];
              if (t == 0) GCl[off + j] = et_; } }
        { const v4u u = raw[6 * ks + 1]; float x[8]; unpack8(u, x);
#pragma unroll
          for (int j = 0; j < 8; ++j) { x[j] = -x[j] * ea[j]; ATt[(off + j) * 16 + t] = (bf16)f2bf(x[j]); }
          const v4u p = pack8(x); fAb[ks] = __builtin_bit_cast(bf16x8, p); }
        { const v4u u = raw[6 * ks + 2]; float x[8]; unpack8(u, x);
#pragma unroll
          for (int j = 0; j < 8; ++j) x[j] = x[j] * er[j];
          const v4u p = pack8(x); fRb[ks] = __builtin_bit_cast(bf16x8, p); *(LAS v4u*)(RBr + t * 64 + off) = p; }
        { const v4u u = raw[6 * ks + 3]; float x[8], y[8]; unpack8(u, x);
#pragma unroll
          for (int j = 0; j < 8; ++j) { y[j] = x[j] * eb[j]; BHt[(off + j) * 16 + t] = (bf16)f2bf(x[j] * eh[j]); }
          const v4u p = pack8(y); fBb[ks] = __builtin_bit_cast(bf16x8, p); }
        { const v4u u = raw[6 * ks + 4]; float x[8], y[8]; unpack8(u, x);
#pragma unroll
          for (int j = 0; j < 8; ++j) { y[j] = x[j] * eb[j]; KHt[(off + j) * 16 + t] = (bf16)f2bf(x[j] * eh[j]); }
          const v4u p = pack8(y); fKb[ks] = __builtin_bit_cast(bf16x8, p); }
        { const v4u u = raw[6 * ks + 5];
          const bf16 e0 = (bf16)(u.x & 0xffff), e1 = (bf16)(u.x >> 16), e2 = (bf16)(u.y & 0xffff), e3 = (bf16)(u.y >> 16), e4 = (bf16)(u.z & 0xffff), e5 = (bf16)(u.z >> 16), e6 = (bf16)(u.w & 0xffff), e7 = (bf16)(u.w >> 16);
          VTt[(off + 0) * 16 + t] = e0; VTt[(off + 1) * 16 + t] = e1; VTt[(off + 2) * 16 + t] = e2; VTt[(off + 3) * 16 + t] = e3; VTt[(off + 4) * 16 + t] = e4; VTt[(off + 5) * 16 + t] = e5; VTt[(off + 6) * 16 + t] = e6; VTt[(off + 7) * 16 + t] = e7; }
        __builtin_amdgcn_sched_barrier(0);
    }
    asm volatile("" ::: "memory");
    const f32x4 z4 = (f32x4){0.f, 0.f, 0.f, 0.f};
    f32x4 n0 = mma16(fAb[1], fBb[1], mma16(fAb[0], fBb[0], z4)), aak = mma16(fAb[1], fKb[1], mma16(fAb[0], fKb[0], z4));
    f32x4 arb = mma16(fRb[1], fBb[1], mma16(fRb[0], fBb[0], z4)), ark = mma16(fRb[1], fKb[1], mma16(fRb[0], fKb[0], z4));
#pragma unroll
    for (int r = 0; r < 4; ++r) { const int tt = 4 * kg + r; if (!(t < tt)) { n0[r] = 0.f; aak[r] = 0.f; } if (!(t <= tt)) { arb[r] = 0.f; ark[r] = 0.f; } }
    st_rowmaj(AK_r, aak, lane); st_rowmaj(RB2, arb, lane); st_rowmaj(RK_r, ark, lane); asm volatile("" ::: "memory");
    f32x4 accT = n0;
#pragma unroll
    for (int r = 0; r < 4; ++r) accT[r] += (4 * kg + r == t) ? 1.f : 0.f;
    f32x4 nn = n0;
#pragma unroll
    for (int itn = 0; itn < 3; ++itn) {
        st_rowmaj(N_r, nn, lane); st_colmaj(N_c, 0, nn, lane); st_rowmaj(T_r, accT, lane); asm volatile("" ::: "memory");
        const auto fa = frag16(N_r, 0, lane), fb = frag16(N_c, 0, lane), ft = frag16(T_r, 0, lane);
        nn = mma16(fa, fb, z4); asm volatile("" ::: "memory");
        st_colmaj(N_c, 0, nn, lane); asm volatile("" ::: "memory");
        const auto fb2 = frag16(N_c, 0, lane);
        accT = mma16(ft, fb2, accT); asm volatile("" ::: "memory");
    }
    st_rowmaj(T_r, accT, lane); asm volatile("" ::: "memory");
    const auto fT = frag16(T_r, 0, lane), fAK = frag16(AK_r, 0, lane), fARB = frag16(RB2, 0, lane), fARK = frag16(RK_r, 0, lane);
#pragma unroll
    for (int kt = 0; kt < 4; ++kt) { const f32x4 dd = mma16(fT, frag16(ATt, 16 * kt, lane), z4); st_colmaj(WAt, 16 * kt, dd, lane); } asm volatile("" ::: "memory");
    f32x4 qy[4];
    { const auto fArbT = frag16(RB2, 0, lane);
#pragma unroll
      for (int kt = 0; kt < 4; ++kt) { const v2u ri = *(const LAS v2u*)(RBr + t * 64 + 16 * kt + 4 * kg);
          qy[kt] = mma16(frag16(WAt, 16 * kt, lane), fArbT, (f32x4){bflo(ri.x), bfhi(ri.x), bflo(ri.y), bfhi(ri.y)}); } }
    asm volatile("" ::: "memory");
#pragma unroll
    for (int vt = 0; vt < 4; ++vt) { const f32x4 dd = mma16(fAK, frag16(VTt, 16 * vt, lane), z4); st_colmaj(ATt, 16 * vt, dd, lane); } asm volatile("" ::: "memory");
    LAS bf16* UVt = RBr;
#pragma unroll
    for (int vt = 0; vt < 4; ++vt) { const f32x4 dd = mma16(fT, frag16(ATt, 16 * vt, lane), z4); st_colmaj(UVt, 16 * vt, dd, lane); } asm volatile("" ::: "memory");
#pragma unroll
    for (int vt = 0; vt < 4; ++vt) { const auto fU = frag16(UVt, 16 * vt, lane), fV = frag16(VTt, 16 * vt, lane);
        yv[vt] = mma16(fARK, fV, mma16(fARB, fU, z4));
#pragma unroll
        for (int ktp = 0; ktp < 4; ++ktp) zv[vt][ktp] = mma16(frag16(KHt, 16 * ktp, lane), fV, mma16(frag16(BHt, 16 * ktp, lane), fU, z4)); }
    f32x4 pz[4][4];
#pragma unroll
    for (int ktp = 0; ktp < 4; ++ktp) { const auto fBh = frag16(BHt, 16 * ktp, lane);
#pragma unroll
        for (int kt = 0; kt < 4; ++kt) { f32x4 dd = mma16(frag16(WAt, 16 * kt, lane), fBh, z4);
            if (kt == ktp) {
#pragma unroll
                for (int r = 0; r < 4; ++r) if (4 * kg + r == t) dd[r] += GCl[16 * kt + t]; }
            pz[ktp][kt] = dd; } }
    asm volatile("s_waitcnt lgkmcnt(0)" ::: "memory");
#pragma unroll
    for (int ktp = 0; ktp < 4; ++ktp) { LAS bf16* reg = (LAS bf16*)(wl + (ktp < 2 ? ktp * 2048 : (ktp + 1) * 2048));
#pragma unroll
        for (int kt = 0; kt < 4; ++kt) { v2u o; o.x = pk2(pz[ktp][kt][0], pz[ktp][kt][1]); o.y = pk2(pz[ktp][kt][2], pz[ktp][kt][3]); *(LAS v2u*)(reg + t * 64 + 16 * kt + 4 * kg) = o; } }
#pragma unroll
    for (int kt = 0; kt < 4; ++kt) { v2u o; o.x = pk2(qy[kt][0], qy[kt][1]); o.y = pk2(qy[kt][2], qy[kt][3]); *(LAS v2u*)(BHt + t * 64 + 16 * kt + 4 * kg) = o; }
    asm volatile("s_waitcnt lgkmcnt(0)" ::: "memory");
}
constexpr int RWZ_OFF = LDSCTL_OFF + 8192, RWF_OFF = LDSCTL_OFF + 2048;
__device__ __forceinline__ void rw_chunk_item2(const Ctx& F, int l, int it, size_t yoff = WS_YDIR) {
    const auto& a = *F.a; unsigned char* ws = a.ws; const int lane = opaque_v(F.lane), t = lane & 15, kg = lane >> 4;
    const int d = it & 1, h = (it >> 1) & 7, b = it >> 4;
    float* YD = (float*)(ws + yoff);
    LAS unsigned char* wl = F.lds + F.wave * 15616;
    LAS bf16* ZS = (LAS bf16*)(F.lds + RWZ_OFF);
    volatile LAS int* flag = (volatile LAS int*)(F.lds + RWF_OFF);
    for (int i = F.tid; i < 2048; i += NTHREADS) ((LAS unsigned*)ZS)[i] = 0u;
    if (F.tid == 0) *flag = 0;
    __syncthreads();
    constexpr int NCHK = (CTXL + SEQ) / 16;
    v4u raw[12];
    rw_chunk_load<0, 2>(F, b, h, d, F.wave, raw);
#pragma unroll 1
    for (int c = F.wave; c < NCHK; c += NWAVES) {
        f32x4 yv[4], zv[4][4];
        rw_chunk_task2(F, raw, wl, yv, zv);
        if (c + NWAVES < NCHK) rw_chunk_load<0, 2>(F, b, h, d, c + NWAVES, raw);
        while (*flag < c) __builtin_amdgcn_s_sleep(1);
        asm volatile("" ::: "memory");
        const LAS bf16* Zc = ZS + (c & 1) * 4096; LAS bf16* Zn = ZS + ((c + 1) & 1) * 4096;
        bf16x8 zb[4][2];
#pragma unroll
        for (int vb = 0; vb < 4; ++vb)
#pragma unroll
            for (int ks = 0; ks < 2; ++ks) zb[vb][ks] = *(const LAS bf16x8*)(Zc + (16 * vb + t) * 64 + 32 * ks + 8 * kg);
        { const LAS bf16* Qr = (const LAS bf16*)(wl + 4096); const bf16x8 q0 = *(const LAS bf16x8*)(Qr + t * 64 + 8 * kg), q1 = *(const LAS bf16x8*)(Qr + t * 64 + 32 + 8 * kg);
#pragma unroll
          for (int vb = 0; vb < 4; ++vb) { const f32x4 y = mma16(q1, zb[vb][1], mma16(q0, zb[vb][0], yv[vb]));
#pragma unroll
              for (int r = 0; r < 4; ++r) { const int row = seq_row(b, d, c * 16 + 4 * kg + r); YD[((size_t)d * T_ALL + row) * 512 + h * 64 + 16 * vb + t] = y[r]; } } }
#pragma unroll
        for (int ktp = 0; ktp < 4; ++ktp) { const LAS bf16* Pr = (const LAS bf16*)(wl + (ktp < 2 ? ktp * 2048 : (ktp + 1) * 2048));
            const bf16x8 p0 = *(const LAS bf16x8*)(Pr + t * 64 + 8 * kg), p1 = *(const LAS bf16x8*)(Pr + t * 64 + 32 + 8 * kg);
#pragma unroll
            for (int vb = 0; vb < 4; ++vb) { const f32x4 z = mma16(p1, zb[vb][1], mma16(p0, zb[vb][0], zv[vb][ktp]));
                v2u o; o.x = pk2(z[0], z[1]); o.y = pk2(z[2], z[3]); *(LAS v2u*)(Zn + (16 * vb + t) * 64 + 16 * ktp + 4 * kg) = o; } }
        asm volatile("s_waitcnt lgkmcnt(0)" ::: "memory");
        if (lane == 0) *flag = c + 1;
        asm volatile("s_waitcnt lgkmcnt(0)" ::: "memory");
    }
    __syncthreads();
}

__device__ __forceinline__ void stage_rw_readout(const Ctx& F, int l) {
    const auto& a = *F.a; unsigned char* ws = a.ws; const int lane = F.lane;
    const bf16* SCN = (const bf16*)(ws + WS_SCN); const bf16* P = (const bf16*)(ws + WS_P); const float* YD = (const float*)(ws + WS_YDIR); bf16* YRW = (bf16*)(ws + WS_YRW);
    const int gw = F.bid * NWAVES + F.wave, NGW = F.G * NWAVES;
    constexpr int TR = 17, NRT = T_ALL / TR;
    for (int tile = gw; tile < NRT * 4; tile += NGW) {
        const int rt = tile % NRT, hp = tile / NRT, row0 = rt * TR, c0 = hp * 128 + 2 * lane;
        const f32x2 rk = *(const f32x2*)(a.in[I_RWRK] + l * 512 + c0), lng = *(const f32x2*)(a.in[I_RWLNG] + l * 512 + c0), lnb = *(const f32x2*)(a.in[I_RWLNB] + l * 512 + c0);
        unsigned sw_[8][5]; f32x2 yw_[8][2];
#define RO_LD(j_) do { const int rr_ = row0 + (j_); const unsigned* sp_ = (const unsigned*)(SCN + (size_t)rr_ * 9 * 512 + c0); \
        sw_[(j_) & 7][0] = sp_[0]; sw_[(j_) & 7][1] = sp_[256]; sw_[(j_) & 7][2] = sp_[4 * 256]; sw_[(j_) & 7][3] = sp_[7 * 256]; sw_[(j_) & 7][4] = *(const unsigned*)(P + (size_t)rr_ * 2560 + 2048 + c0); \
        yw_[(j_) & 7][0] = *(const f32x2*)(YD + (size_t)rr_ * 512 + c0); yw_[(j_) & 7][1] = *(const f32x2*)(YD + ((size_t)T_ALL + rr_) * 512 + c0); } while (0)
        RO_LD(0); RO_LD(1); RO_LD(2);
#pragma unroll
        for (int i = 0; i < TR; ++i) {
            const int row = row0 + i;
            if (i + 3 < TR) RO_LD(i + 3);
            const unsigned ru = sw_[i & 7][0], vu = sw_[i & 7][1], k0u = sw_[i & 7][2], k1u = sw_[i & 7][3], gu = sw_[i & 7][4];
            const f32x2 y0 = yw_[i & 7][0], y1 = yw_[i & 7][1];
            const float bon = red32(bflo(ru) * (bflo(k0u) + bflo(k1u)) * rk[0] + bfhi(ru) * (bfhi(k0u) + bfhi(k1u)) * rk[1]);
            f32x2 y = y0 + y1 + (f32x2){bflo(vu), bfhi(vu)} * bon;
            const float mu = red32(y[0] + y[1]) * (1.f / 64.f);
            y = y - mu;
            const float var = red32(y[0] * y[0] + y[1] * y[1]) * (1.f / 64.f);
            const f32x2 yn = y * (__builtin_amdgcn_rsqf(var + 64e-5f));
            const f32x2 ov = (yn * lng + lnb) * (f32x2){bflo(gu), bfhi(gu)};
            *(unsigned*)(YRW + (size_t)row * 512 + c0) = pk2(ov[0], ov[1]);
        }
    }
}
#undef RO_LD

constexpr size_t WS_S5E = 6 * MiB;
constexpr int S5_NSEG = 4, S5_SEGLEN = (CTXL + SEQ) / S5_NSEG;
__device__ __forceinline__ void s5_disc(const float are, const float aim, const float dt, float& lbr, float& lbi, float& cr, float& ci) {
    const float mag = expf(are * dt); lbr = mag * cosf(aim * dt); lbi = mag * sinf(aim * dt);
    const float den = are * are + aim * aim, nr = lbr - 1.0f; cr = (nr * are + lbi * aim) / den; ci = (lbi * are - nr * aim) / den;
}
template <int PASS>
__device__ __forceinline__ void stage_s5_scan(const Ctx& F, int l, int item = -1) {
    const auto& a = *F.a; unsigned char* ws = a.ws; const int lane = F.lane;
    const bf16* Z = (const bf16*)(ws + WS_Z); bf16* YP = (bf16*)(ws + WS_YP); f32x2* S5E = (f32x2*)(ws + WS_S5E);
    LAS unsigned char* wl = F.lds + F.wave * 16384;
    LAS float* buL = (LAS float*)wl;
    LAS bf16* Hs = (LAS bf16*)(wl + 8704);
    const int fr = lane & 15, kg = lane >> 4;
    for (int itx = (item < 0 ? F.bid : item) * NWAVES + F.wave; itx < BATCH * 32 * 2 * S5_NSEG; itx += (item < 0 ? NWAVES * F.G : BATCH * 32 * 2 * S5_NSEG)) {
        const int seg = itx & (S5_NSEG - 1), it = itx >> 2;
        const int d = it & 1, g = (it >> 1) & 31, b = it >> 6, p = lane;
        const float dt = expf(a.in[I_S5LDT][(l * 2 + d) * 32 + g]);
        const float* arep = a.in[I_S5ARE] + ((size_t)(l * 2 + d) * 32 + g) * 64; const float* aimp = a.in[I_S5AIM] + ((size_t)(l * 2 + d) * 32 + g) * 64;
        float lbr, lbi, cr_, ci_; s5_disc(arep[p], aimp[p], dt, lbr, lbi, cr_, ci_);
        bf16x8 afr[2][4];
#pragma unroll
        for (int tl = 0; tl < 4; ++tl) { const int pp = 16 * tl + fr; float r0_, r1_, cr, ci; s5_disc(arep[pp], aimp[pp], dt, r0_, r1_, cr, ci);
            v4u pr = (v4u){0u, 0u, 0u, 0u}, pi = (v4u){0u, 0u, 0u, 0u};
            if (kg < 2) { const float* br = a.in[I_S5BRE] + (((size_t)l * 32 + g) * 64 + pp) * 16 + 8 * kg; const float* bi = a.in[I_S5BIM] + (((size_t)l * 32 + g) * 64 + pp) * 16 + 8 * kg;
                const f32x4 x0 = *(const f32x4*)br, x1 = *(const f32x4*)(br + 4), y0 = *(const f32x4*)bi, y1 = *(const f32x4*)(bi + 4);
                pr.x = pk2(cr * x0[0] - ci * y0[0], cr * x0[1] - ci * y0[1]); pr.y = pk2(cr * x0[2] - ci * y0[2], cr * x0[3] - ci * y0[3]);
                pr.z = pk2(cr * x1[0] - ci * y1[0], cr * x1[1] - ci * y1[1]); pr.w = pk2(cr * x1[2] - ci * y1[2], cr * x1[3] - ci * y1[3]);
                pi.x = pk2(cr * y0[0] + ci * x0[0], cr * y0[1] + ci * x0[1]); pi.y = pk2(cr * y0[2] + ci * x0[2], cr * y0[3] + ci * x0[3]);
                pi.z = pk2(cr * y1[0] + ci * x1[0], cr * y1[1] + ci * x1[1]); pi.w = pk2(cr * y1[2] + ci * x1[2], cr * y1[3] + ci * x1[3]); }
            afr[0][tl] = __builtin_bit_cast(bf16x8, pr); afr[1][tl] = __builtin_bit_cast(bf16x8, pi); }
        bf16x8 cf[4];
        f32x2 hst = (f32x2){0.f, 0.f};
        if (PASS == 1) {
#pragma unroll
            for (int kk = 0; kk < 4; ++kk) { const int p0 = 16 * kk + 4 * kg;
                const f32x4 c0 = *(const f32x4*)(a.in[I_S5CRE] + (((size_t)l * 32 + g) * 16 + fr) * 64 + p0), c1 = *(const f32x4*)(a.in[I_S5CIM] + (((size_t)l * 32 + g) * 16 + fr) * 64 + p0);
                v4u pk; pk.x = pk2(c0[0], -c1[0]); pk.y = pk2(c0[1], -c1[1]); pk.z = pk2(c0[2], -c1[2]); pk.w = pk2(c0[3], -c1[3]);
                cf[kk] = __builtin_bit_cast(bf16x8, pk); }
            float pr_ = lbr, pi_ = lbi, l64r = 1.f, l64i = 0.f;
#pragma unroll 1
            for (int q = 0; q < 10; ++q) { const float nr2 = pr_ * pr_ - pi_ * pi_, ni2 = 2.f * pr_ * pi_; pr_ = nr2; pi_ = ni2; if (q == 5) { l64r = pr_; l64i = pi_; } }
            const float lLr = pr_ * l64r - pi_ * l64i, lLi = pr_ * l64i + pi_ * l64r;
#pragma unroll 1
            for (int sgi = 0; sgi < seg; ++sgi) { const f32x2 ev = S5E[((size_t)it * S5_NSEG + sgi) * 64 + p];
                hst = (f32x2){lLr * hst[0] - lLi * hst[1] + ev[0], lLr * hst[1] + lLi * hst[0] + ev[1]}; }
        }
        const f32x2 lbr2 = (f32x2){lbr, lbr}, lbi2 = (f32x2){lbi, lbi};
        const int sbeg = seg * S5_SEGLEN, send = sbeg + S5_SEGLEN;
        v4u u0 = (v4u){0u, 0u, 0u, 0u}, u1 = u0, u2 = u0, u3 = u0;
#define S5_LOADU(dst_, s0_) do { const int sx_ = ((s0_) < send) ? (s0_) : (send - 16); const int row_ = seq_row(b, d, sx_ + fr); dst_ = *(const v4u*)(Z + (size_t)row_ * IN_COLS + S5_OFF + g * 16 + (kg & 1) * 8); } while (0)
#define S5_CHUNK(ux_, sc_) do { \
            { const v4u um_ = (kg < 2) ? ux_ : (v4u){0u, 0u, 0u, 0u}; const bf16x8 ufr = __builtin_bit_cast(bf16x8, um_); \
              _Pragma("unroll") for (int c = 0; c < 2; ++c) _Pragma("unroll") for (int tl = 0; tl < 4; ++tl) { \
                const f32x4 dd = __builtin_amdgcn_mfma_f32_16x16x32_bf16(afr[c][tl], ufr, (f32x4){0.f, 0.f, 0.f, 0.f}, 0, 0, 0); *(LAS f32x4*)(buL + (c * 16 + fr) * 68 + 16 * tl + 4 * kg) = dd; } } \
            S5_LOADU(ux_, (sc_) + 64); \
            LDS_WAIT(); asm volatile("" ::: "memory"); \
            f32x2 bu[16]; \
            _Pragma("unroll") for (int s = 0; s < 16; ++s) bu[s] = (f32x2){buL[s * 68 + p], buL[(16 + s) * 68 + p]}; \
            _Pragma("unroll") for (int s = 0; s < 16; ++s) { const float tr_ = __builtin_fmaf(-lbi, hst[1], bu[s][0]), ti_ = __builtin_fmaf(lbi, hst[0], bu[s][1]); \
                hst = (f32x2){__builtin_fmaf(lbr, hst[0], tr_), __builtin_fmaf(lbr, hst[1], ti_)}; \
                if (PASS == 1) *(LAS unsigned*)(Hs + s * 136 + 2 * p) = pg8::cvt_pk_bf16(hst[0], hst[1]); } \
            if (PASS == 1) { LDS_WAIT(); asm volatile("" ::: "memory"); \
                f32x4 acc = (f32x4){0.f, 0.f, 0.f, 0.f}; \
                _Pragma("unroll") for (int kk = 0; kk < 4; ++kk) { const bf16x8 af = *(const LAS bf16x8*)(Hs + fr * 136 + 32 * kk + 8 * kg); acc = __builtin_amdgcn_mfma_f32_16x16x32_bf16(af, cf[kk], acc, 0, 0, 0); } \
                { const int rowq_ = seq_row(b, d, (sc_) + 4 * kg); bf16* yq_ = YP + ((size_t)d * T_ALL + rowq_) * 512 + g * 16 + fr; const int st_ = d ? -512 : 512; \
                  _Pragma("unroll") for (int r = 0; r < 4; ++r) yq_[r * st_] = (bf16)f2bf(acc[r]); } } \
            LDS_WAIT(); asm volatile("" ::: "memory"); } while (0)
        S5_LOADU(u0, sbeg); S5_LOADU(u1, sbeg + 16); S5_LOADU(u2, sbeg + 32); S5_LOADU(u3, sbeg + 48);
#pragma unroll 1
        for (int s0 = sbeg; s0 < send; s0 += 64) { S5_CHUNK(u0, s0); S5_CHUNK(u1, s0 + 16); S5_CHUNK(u2, s0 + 32); S5_CHUNK(u3, s0 + 48); }
#undef S5_CHUNK
        if (PASS == 0) S5E[((size_t)it * S5_NSEG + seg) * 64 + p] = hst;
#undef S5_LOADU
    }
}

__device__ __forceinline__ void stage_s5_prep(const Ctx& F, int l, int nrows) {
    const auto& a = *F.a; unsigned char* ws = a.ws;
    const bf16* __restrict__ Z = (const bf16*)(ws + WS_Z); const bf16* __restrict__ YP = (const bf16*)(ws + WS_YP); bf16* __restrict__ AS5 = (bf16*)(ws + WS_AS5);
    const int c = 4 * (F.tid & 127), rq = F.tid >> 7;
    const f32x4 dsk = *(const f32x4*)(a.in[I_S5D] + l * 512 + c);
#pragma unroll 4
    for (int row = F.bid * 4 + rq; row < nrows; row += F.G * 4) {
        const v2u uz = *(const v2u*)(Z + (size_t)row * IN_COLS + S5_OFF + c);
        const v2u q0 = *(const v2u*)(YP + (size_t)row * 512 + c), q1 = *(const v2u*)(YP + ((size_t)T_ALL + row) * 512 + c);
        const f32x4 y0 = (f32x4){bflo(q0.x), bfhi(q0.x), bflo(q0.y), bfhi(q0.y)}, y1 = (f32x4){bflo(q1.x), bfhi(q1.x), bflo(q1.y), bfhi(q1.y)};
        const f32x4 u = (f32x4){bflo(uz.x), bfhi(uz.x), bflo(uz.y), bfhi(uz.y)};
        const f32x4 y = y0 + y1 + u * dsk;
        float ge[4];
#pragma unroll
        for (int j = 0; j < 4; ++j) ge[j] = 0.5f * y[j] * (1.f + tanh_fast(0.7978845608028654f * (y[j] + 0.044715f * y[j] * y[j] * y[j])));
        v2u o; o.x = pk2(ge[0], ge[1]); o.y = pk2(ge[2], ge[3]);
        *(v2u*)(AS5 + (size_t)row * 512 + c) = o;
    }
}

__device__ __forceinline__ void stage_hy_pre(const Ctx& F, int l, int nrows) {
    const auto& a = *F.a; unsigned char* ws = a.ws; const int lane = F.lane;
    const bf16* Z = (const bf16*)(ws + WS_Z); bf16* UT = (bf16*)(ws + WS_UT);
    LAS unsigned char* tl = F.lds + F.wave * 16384;
    const float* cw = a.in[I_HYCW] + (size_t)l * 3 * 1536; const float* cbp = a.in[I_HYCB] + l * 1536;
    const int gw = F.bid * NWAVES + F.wave, NGW = F.G * NWAVES;
    const int q = lane >> 3, k = lane & 7, ntile = (nrows / 64) * 24;
    v4u v[8], hv;
#define HYPRE_LOAD(tile_) do { const int rt_ = (tile_) / 24, ct_ = (tile_) % 24, row0_ = rt_ * 64; int base_, pos0_, n_; row_seq(row0_, base_, pos0_, n_); \
        const bf16* zt_ = Z + (size_t)row0_ * IN_COLS + HY_OFF + ct_ * 64 + 8 * k; hv = (v4u){0u, 0u, 0u, 0u}; \
        _Pragma("unroll") for (int i = 0; i < 8; ++i) v[i] = *(const v4u*)(zt_ + (size_t)(8 * i + q) * IN_COLS); \
        if (q == 0 && pos0_ > 0) hv = *(const v4u*)(zt_ - (size_t)IN_COLS); \
        if (q == 1 && pos0_ + 64 < n_) hv = *(const v4u*)(zt_ + (size_t)64 * IN_COLS); } while (0)
    if (gw < ntile) HYPRE_LOAD(gw);
#pragma unroll 1
    for (int tile = gw; tile < ntile; tile += NGW) {
        const int rt = tile / 24, ct = tile % 24, row0 = rt * 64, c0 = ct * 64;
        f32x4 wv[8];
#pragma unroll
        for (int i = 0; i < 8; ++i) { const int col = c0 + 8 * i + q; wv[i] = (f32x4){cw[col], cw[1536 + col], cw[2 * 1536 + col], cbp[col]}; }
#pragma unroll
        for (int i = 0; i < 8; ++i) { LAS unsigned* p = (LAS unsigned*)(tl + (1 + 8 * i + q) * 132 + 16 * k); p[0] = v[i].x; p[1] = v[i].y; p[2] = v[i].z; p[3] = v[i].w; }
        if (q < 2) { LAS unsigned* p = (LAS unsigned*)(tl + (q ? 65 : 0) * 132 + 16 * k); p[0] = hv.x; p[1] = hv.y; p[2] = hv.z; p[3] = hv.w; }
        if (tile + NGW < ntile) HYPRE_LOAD(tile + NGW);
        LDS_WAIT(); asm volatile("" ::: "memory");
#pragma unroll 2
        for (int i = 0; i < 8; ++i) {
            const int ch = 8 * i + q, col = c0 + ch;
            const LAS unsigned short* s = (const LAS unsigned short*)(tl + (8 * k) * 132 + ch * 2);
            float z[10];
#pragma unroll
            for (int t = 0; t < 10; ++t) z[t] = __builtin_bit_cast(float, (unsigned)s[t * 66] << 16);
            float o[8];
#pragma unroll
            for (int t = 0; t < 8; ++t) o[t] = wv[i][0] * z[t] + wv[i][1] * z[t + 1] + wv[i][2] * z[t + 2] + wv[i][3];
            v4u w; w.x = pk2(o[0], o[1]); w.y = pk2(o[2], o[3]); w.z = pk2(o[4], o[5]); w.w = pk2(o[6], o[7]);
            *(v4u*)(UT + (size_t)col * T_ALL + row0 + 8 * k) = w;
        }
        LDS_WAIT(); asm volatile("" ::: "memory");
    }
#undef HYPRE_LOAD
}
__device__ __forceinline__ void stage_hy_post(const Ctx& F, int l, int nrows) {
    const auto& a = *F.a; unsigned char* ws = a.ws; const int lane = F.lane;
    const bf16* YT = (const bf16*)(ws + WS_UT) + (size_t)1024 * T_ALL; bf16* YHY = (bf16*)(ws + WS_YHY);
    LAS unsigned char* tl = F.lds + F.wave * 16384;
    const int gw = F.bid * NWAVES + F.wave, NGW = F.G * NWAVES;
    const int q = lane >> 3, k = lane & 7, ntile = (nrows / 64) * 8;
    v4u v[8];
#define HYPOST_LOAD(tile_) do { const bf16* yp_ = YT + (size_t)(((tile_) & 7) * 64 + q) * T_ALL + ((tile_) >> 3) * 64 + 8 * k; \
        _Pragma("unroll") for (int i = 0; i < 8; ++i) v[i] = *(const v4u*)(yp_ + (size_t)(8 * i) * T_ALL); } while (0)
    if (gw < ntile) HYPOST_LOAD(gw);
#pragma unroll 1
    for (int tile = gw; tile < ntile; tile += NGW) {
        const int rt = tile >> 3, ct = tile & 7, row0 = rt * 64, c0 = ct * 64;
#pragma unroll
        for (int i = 0; i < 8; ++i) { LAS unsigned* p = (LAS unsigned*)(tl + (8 * i + q) * 132 + 16 * k); p[0] = v[i].x; p[1] = v[i].y; p[2] = v[i].z; p[3] = v[i].w; }
        if (tile + NGW < ntile) HYPOST_LOAD(tile + NGW);
        LDS_WAIT(); asm volatile("" ::: "memory");
#pragma unroll
        for (int i = 0; i < 8; ++i) { const int r = 8 * i + q;
            const LAS unsigned short* s = (const LAS unsigned short*)(tl + (8 * k) * 132 + r * 2);
            unsigned e[8];
#pragma unroll
            for (int j = 0; j < 8; ++j) e[j] = s[j * 66];
            v4u w; w.x = e[0] | (e[1] << 16); w.y = e[2] | (e[3] << 16); w.z = e[4] | (e[5] << 16); w.w = e[6] | (e[7] << 16);
            *(v4u*)(YHY + (size_t)(row0 + r) * 512 + c0 + 8 * k) = w; }
        LDS_WAIT(); asm volatile("" ::: "memory");
    }
#undef HYPOST_LOAD
}
typedef float f32x16 __attribute__((ext_vector_type(16)));
__device__ __forceinline__ void hyena_item(const Ctx& F, int l, int c, int isctx) {
    const auto& a = *F.a; unsigned char* ws = a.ws; const int tid = F.tid, lane = F.lane;
    const int n = isctx ? CTXL : SEQ, rowbase = isctx ? T_LAT : 0, RL = isctx ? HY_RLENC : HY_RLEN, off = n + 47;
    const bf16* UT = (const bf16*)(ws + WS_UT);
    const bf16* x1g = UT + (size_t)c * T_ALL + rowbase; const bf16* x2g = UT + (size_t)(512 + c) * T_ALL + rowbase; bf16* vg = (bf16*)UT + (size_t)(1024 + c) * T_ALL + rowbase;
    const bf16* Rg = (const bf16*)(ws + WS_GF + l * GF_STRIDE + (isctx ? GF_CTX : 0)) + (size_t)c * RL;
    LAS unsigned char* XB = F.lds; LAS unsigned char* R1 = F.lds + HY_R1_OFF; LAS unsigned char* R2 = F.lds + HY_R2_OFF;
    { const int cpb = n / 8;
      for (int q = tid; q < 8 * cpb; q += NTHREADS) { const int b = q / cpb, ch = q % cpb; *(LAS v4u*)(XB + b * HY_ROWB + 2 * HY_MARG + 16 * ch) = *(const v4u*)(vg + (size_t)b * n + 8 * ch); }
      if (tid < 256) { const int b = tid >> 5, side = (tid >> 4) & 1, ch = tid & 15; const unsigned zz = (unsigned)opaque_v(0); *(LAS v4u*)(XB + b * HY_ROWB + (side ? 2 * (HY_MARG + n) : 0) + 16 * ch) = (v4u){zz, zz, zz, zz}; }
      const int rch = RL / 8;
      for (int q = tid; q < rch; q += NTHREADS) { *(LAS v4u*)(R1 + 16 * q) = *(const v4u*)(Rg + 8 * q); *(LAS v4u*)(R2 + 16 * q) = *(const v4u*)(Rg + (size_t)512 * RL + 8 * q); } }
    __syncthreads();
    const int i = lane & 31, kg = lane >> 5, jb = lane & 3, bb = (lane & 31) >> 2;
    const int rsh = (off - i) & 7, rd = rsh >> 1; const bool s1 = rd & 1, s2 = rd & 2; const unsigned sh = (rsh & 1) ? 16u : 0u;
    const int aconst = 2 * (off - i + 8 * kg - rsh), bconst = bb * HY_ROWB + 2 * (HY_MARG + 32 * jb + 8 * kg);
    const int T0w = 512 * F.wave; const int ntile = (n - T0w) >= 512 ? 4 : ((n - T0w) > 0 ? (n - T0w) / 128 : 0);
    const float bias0 = a.in[I_HYBIAS][(l * 2 + 0) * 512 + c], bias1 = a.in[I_HYBIAS][(l * 2 + 1) * 512 + c];
    f32x16 acc[4];
    v2u y1p[4][4];
#define HY_AFRAG(wa, wb, afr) do { \
        const unsigned a0 = s1 ? wa.y : wa.x, a1 = s1 ? wa.z : wa.y, a2 = s1 ? wa.w : wa.z, a3 = s1 ? wb.x : wa.w, a4 = s1 ? wb.y : wb.x, a5 = s1 ? wb.z : wb.y, a6 = s1 ? wb.w : wb.z; \
        const unsigned b0 = s2 ? a2 : a0, b1 = s2 ? a3 : a1, b2 = s2 ? a4 : a2, b3 = s2 ? a5 : a3, b4 = s2 ? a6 : a4; \
        v4u af_; af_.x = __builtin_amdgcn_alignbit(b1, b0, sh); af_.y = __builtin_amdgcn_alignbit(b2, b1, sh); af_.z = __builtin_amdgcn_alignbit(b3, b2, sh); af_.w = __builtin_amdgcn_alignbit(b4, b3, sh); \
        afr = __builtin_bit_cast(bf16x8, af_); } while (0)
#define HY_STEP_COND(RB, d) do { \
        const v4u wa = *(const LAS v4u*)((RB) + aconst - 2 * (d)), wb = *(const LAS v4u*)((RB) + aconst - 2 * (d) + 16); bf16x8 afr; HY_AFRAG(wa, wb, afr); \
        _Pragma("unroll") for (int m = 0; m < 4; ++m) { const int T0 = T0w + 128 * m; \
            if (m < ntile && (d) >= T0 - n + 16 && (d) <= T0 + 96) { const bf16x8 bfr = *(const LAS bf16x8*)(XB + bconst + 2 * (T0 - (d))); \
                acc[m] = __builtin_amdgcn_mfma_f32_32x32x16_bf16(afr, bfr, acc[m], 0, 0, 0); } } } while (0)
#define HY_LOAD(RB, d, wa, wb, bq) do { wa = *(const LAS v4u*)((RB) + aconst - 2 * (d)); wb = *(const LAS v4u*)((RB) + aconst - 2 * (d) + 16); \
        _Pragma("unroll") for (int m = 0; m < 4; ++m) bq[m] = *(const LAS bf16x8*)(XB + bconst + 2 * (T0w + 128 * m - (d))); } while (0)
#define HY_MMA(wa, wb, bq) do { bf16x8 afr; HY_AFRAG(wa, wb, afr); \
        _Pragma("unroll") for (int m = 0; m < 4; ++m) acc[m] = __builtin_amdgcn_mfma_f32_32x32x16_bf16(afr, bq[m], acc[m], 0, 0, 0); } while (0)
#define HY_LOAD2(RB, d, wa, wb, f0, f2) do { wa = *(const LAS v4u*)((RB) + aconst - 2 * (d)); wb = *(const LAS v4u*)((RB) + aconst - 2 * (d) + 16); \
        f0 = *(const LAS bf16x8*)(XB + bconst + 2 * (T0w - (d))); f2 = *(const LAS bf16x8*)(XB + bconst + 2 * (T0w + 256 - (d))); } while (0)
#define HY_MMA2(wa, wb, b0, b1, b2, b3) do { bf16x8 afr; HY_AFRAG(wa, wb, afr); \
        acc[0] = __builtin_amdgcn_mfma_f32_32x32x16_bf16(afr, b0, acc[0], 0, 0, 0); acc[1] = __builtin_amdgcn_mfma_f32_32x32x16_bf16(afr, b1, acc[1], 0, 0, 0); \
        acc[2] = __builtin_amdgcn_mfma_f32_32x32x16_bf16(afr, b2, acc[2], 0, 0, 0); acc[3] = __builtin_amdgcn_mfma_f32_32x32x16_bf16(afr, b3, acc[3], 0, 0, 0); } while (0)
#define HY_CONV(RB) do { \
        _Pragma("unroll") for (int m = 0; m < 4; ++m) _Pragma("unroll") for (int e = 0; e < 16; ++e) acc[m][e] = 0.f; \
        if (ntile == 4) { \
            const int dA = T0w - n + 16, dB = T0w + 384 - n + 16, dC = T0w + 96, dD = T0w + 384 + 96;     \
            _Pragma("unroll 1") for (int d = dA; d < dB; d += 16) HY_STEP_COND(RB, d); \
              \
              \
            const int nst_ = (dC - dB) / 16 + 1, nblk_ = nst_ >> 3; \
            { bf16x8 q0[8], q2[8]; v4u waA, wbA, waB, wbB; bf16x8 f0A, f2A, f0B, f2B; \
              _Pragma("unroll") for (int k = 0; k < 8; ++k) { q0[k] = *(const LAS bf16x8*)(XB + bconst + 2 * (T0w + 128 - (dB + 16 * k))); q2[k] = *(const LAS bf16x8*)(XB + bconst + 2 * (T0w + 384 - (dB + 16 * k))); } \
              HY_LOAD2(RB, dB, waA, wbA, f0A, f2A); \
              _Pragma("unroll 1") for (int blk = 0; blk < nblk_; ++blk) { const int d0 = dB + 128 * blk; \
                  _Pragma("unroll") for (int k = 0; k < 8; k += 2) { \
                      HY_LOAD2(RB, d0 + 16 * (k + 1), waB, wbB, f0B, f2B); \
                      __builtin_amdgcn_sched_barrier(0); \
                      HY_MMA2(waA, wbA, f0A, q0[k], f2A, q2[k]); q0[k] = f0A; q2[k] = f2A; \
                      __builtin_amdgcn_sched_barrier(0); \
                      HY_LOAD2(RB, d0 + 16 * (k + 2), waA, wbA, f0A, f2A); \
                      __builtin_amdgcn_sched_barrier(0); \
                      HY_MMA2(waB, wbB, f0B, q0[k + 1], f2B, q2[k + 1]); q0[k + 1] = f0B; q2[k + 1] = f2B; \
                      __builtin_amdgcn_sched_barrier(0); } } } \
            _Pragma("unroll 1") for (int d = dB + 128 * nblk_; d <= dC; d += 16) HY_STEP_COND(RB, d); \
            _Pragma("unroll 1") for (int d = dC + 16; d <= dD; d += 16) HY_STEP_COND(RB, d); \
        } else if (ntile > 0) { const int dhi = T0w + 128 * (ntile - 1) + 96; \
            _Pragma("unroll 1") for (int d = T0w - n + 16; d <= dhi; d += 16) HY_STEP_COND(RB, d); } } while (0)
    HY_CONV(R1);
#pragma unroll
    for (int m = 0; m < 4; ++m) if (m < ntile) {
#pragma unroll
        for (int rg = 0; rg < 4; ++rg) { const int t4 = T0w + 128 * m + 32 * jb + 8 * rg + 4 * kg;
            const v2u xv = *(const v2u*)(x1g + (size_t)bb * n + t4); const v2u vv = *(const LAS v2u*)(XB + bb * HY_ROWB + 2 * (HY_MARG + t4));
            const float y0 = bflo(xv.x) * (acc[m][4 * rg + 0] + bias0 * bflo(vv.x)), y1 = bfhi(xv.x) * (acc[m][4 * rg + 1] + bias0 * bfhi(vv.x));
            const float y2 = bflo(xv.y) * (acc[m][4 * rg + 2] + bias0 * bflo(vv.y)), y3 = bfhi(xv.y) * (acc[m][4 * rg + 3] + bias0 * bfhi(vv.y));
            y1p[m][rg].x = pk2(y0, y1); y1p[m][rg].y = pk2(y2, y3); } }
    __syncthreads();
#pragma unroll
    for (int m = 0; m < 4; ++m) if (m < ntile) {
#pragma unroll
        for (int rg = 0; rg < 4; ++rg) { const int t4 = T0w + 128 * m + 32 * jb + 8 * rg + 4 * kg; *(LAS v2u*)(XB + bb * HY_ROWB + 2 * (HY_MARG + t4)) = y1p[m][rg]; } }
    __syncthreads();
    HY_CONV(R2);
#pragma unroll
    for (int m = 0; m < 4; ++m) if (m < ntile) {
#pragma unroll
        for (int rg = 0; rg < 4; ++rg) { const int t4 = T0w + 128 * m + 32 * jb + 8 * rg + 4 * kg;
            const v2u xv = *(const v2u*)(x2g + (size_t)bb * n + t4); const v2u yv = y1p[m][rg];
            const float o0 = bflo(xv.x) * (acc[m][4 * rg + 0] + bias1 * bflo(yv.x)), o1 = bfhi(xv.x) * (acc[m][4 * rg + 1] + bias1 * bfhi(yv.x));
            const float o2 = bflo(xv.y) * (acc[m][4 * rg + 2] + bias1 * bflo(yv.y)), o3 = bfhi(xv.y) * (acc[m][4 * rg + 3] + bias1 * bfhi(yv.y));
            v2u ov; ov.x = pk2(o0, o1); ov.y = pk2(o2, o3); *(v2u*)(vg + (size_t)bb * n + t4) = ov; } }
    __syncthreads();
#undef HY_CONV
#undef HY_AFRAG
#undef HY_STEP_COND
#undef HY_LOAD
#undef HY_LOAD2
#undef HY_MMA2
#undef HY_MMA
}
__device__ __forceinline__ void stage_mixer(const Ctx& F, int l) {
    unsigned* ctr = (unsigned*)(F.a->ws + WS_CTL) + CW_WORK + 64 * l;
    LAS int* itb = (LAS int*)(F.lds + LDSCTL_OFF + 512);
    constexpr int NS5 = BATCH * 32 * 2 * S5_NSEG / NWAVES;
    const int nit = 128 + NS5 + 512 + (l == 0 ? 512 : 0);
#ifdef PROBE_STATIC
    return;
#endif
    for (;;) {
        if (F.tid == 0) *itb = (int)__hip_atomic_fetch_add(ctr, 1u, __ATOMIC_RELAXED, __HIP_MEMORY_SCOPE_AGENT);
        __syncthreads();
        const int it = *itb;
        __syncthreads();
        if (it >= nit) break;
        Ctx Fi; Fi.a = kargs(); Fi.tid = opaque_v((int)threadIdx.x); Fi.lane = Fi.tid & 63; Fi.wave = __builtin_amdgcn_readfirstlane(Fi.tid >> 6); Fi.bid = opaque((int)blockIdx.x); Fi.G = opaque((int)gridDim.x);
        Fi.lds = (LAS unsigned char*)((LAS unsigned char*)0 + opaque(0)) + (F.lds - (LAS unsigned char*)0);
#ifdef PROBE_T
        if (l == 0 && F.tid == 0 && it == 5) ((unsigned long long*)(F.a->ws + WS_CTL + CW_STAMP * 4))[21] = __builtin_amdgcn_s_memrealtime();
        if (l == 0 && F.tid == 0 && it == 300) ((unsigned long long*)(F.a->ws + WS_CTL + CW_STAMP * 4))[23] = __builtin_amdgcn_s_memrealtime();
#endif
        if (it < 128) { for (int rep = 0; rep < ((DUPK == 9) ? 2 : 1); ++rep) rw_chunk_item2(Fi, opaque(l), it); }
        else if (it < 128 + NS5) stage_s5_scan<1>(Fi, opaque(l), it - 128);
        else if (it < 640 + NS5) hyena_item(Fi, opaque(l), it - 128 - NS5, 0);
        else hyena_item(Fi, opaque(l), it - 640 - NS5, 1);
#ifdef PROBE_T
        if (l == 0 && F.tid == 0 && it == 5) ((unsigned long long*)(F.a->ws + WS_CTL + CW_STAMP * 4))[22] = __builtin_amdgcn_s_memrealtime();
        if (l == 0 && F.tid == 0 && it == 300) ((unsigned long long*)(F.a->ws + WS_CTL + CW_STAMP * 4))[24] = __builtin_amdgcn_s_memrealtime();
#endif
    }
}

typedef float f32x16r __attribute__((ext_vector_type(16)));
__device__ __forceinline__ void stage_norm2_router(const Ctx& F, int l, int nrows) {
    const auto& a = *F.a; unsigned char* ws = a.ws; const int lane = F.lane;
    const float* X = (const float*)(ws + WS_X); bf16* H = (bf16*)(ws + WS_H); const float* MOD = (const float*)(ws + WS_MOD);
    int* EIDX = (int*)(ws + WS_EIDX); float* GATE = (float*)(ws + WS_GATE); int* POS = (int*)(ws + WS_POS); unsigned* ROWOF = (unsigned*)(ws + WS_ROWOF);
    LAS int* lex = (LAS int*)(F.lds + 40960); LAS int* lrk = lex + 2048; LAS int* offl = lrk + 2048;
    LAS float* lg = (LAS float*)(F.lds + F.wave * 4352);
    LAS int* hist = (LAS int*)(F.lds + LDSCTL_OFF + 1024);
    if (F.tid < 32) hist[F.tid] = 0;
    __syncthreads();
    const int rpb = (nrows + F.G - 1) / F.G, r0 = F.bid * rpb, r1 = (r0 + rpb < nrows) ? r0 + rpb : nrows;
    const float* rw = a.in[I_RTW] + (size_t)l * 1024 * 32;
    const int i = lane & 31, kk = lane >> 5;
    const f32x4* ng = (const f32x4*)(a.in[I_N2G] + l * D) + kk;
    for (int rb = r0 + F.wave * 32; rb < r1; rb += NWAVES * 32) {
        const int nrow = (r1 - rb) < 32 ? (r1 - rb) : 32; const bool live = i < nrow;
        const int row = live ? rb + i : r1 - 1; const int w = row < T_LAT ? (row >> 12) : 8;
        const f32x4* xr = (const f32x4*)(X + (size_t)row * D) + kk;
        float ss = 0.f;
#pragma unroll 16
        for (int q = 0; q < 128; ++q) { const f32x4 v = xr[2 * q]; ss += (v[0] * v[0] + v[1] * v[1]) + (v[2] * v[2] + v[3] * v[3]); }
        ss += __builtin_bit_cast(float, __builtin_amdgcn_ds_bpermute((lane ^ 32) << 2, __builtin_bit_cast(int, ss)));
        const float rstd = __builtin_amdgcn_rsqf(ss * (1.f / D) + 1e-6f);
        const f32x4* sh = (const f32x4*)(MOD + (size_t)(l * 9 + w) * 6144 + 3072) + kk; const f32x4* sc = (const f32x4*)(MOD + (size_t)(l * 9 + w) * 6144 + 4096) + kk;
        v2u* ho = (v2u*)(H + (size_t)row * D) + kk;
        f32x16r acc;
#pragma unroll
        for (int e = 0; e < 16; ++e) acc[e] = 0.f;
        const float* wp = rw + (size_t)(4 * kk) * 32 + i;
        f32x4 xn[4], gn_[4], cn_[4], sn_[4], wn_[4];
#define RT_LOAD(q0_) do { _Pragma("unroll") for (int u_ = 0; u_ < 4; ++u_) { const int q_ = (q0_) + u_; xn[u_] = xr[2 * q_]; gn_[u_] = ng[2 * q_]; cn_[u_] = sc[2 * q_]; sn_[u_] = sh[2 * q_]; \
            wn_[u_] = (f32x4){wp[(size_t)(8 * q_) * 32], wp[(size_t)(8 * q_ + 1) * 32], wp[(size_t)(8 * q_ + 2) * 32], wp[(size_t)(8 * q_ + 3) * 32]}; } } while (0)
        RT_LOAD(0);
#pragma unroll 1
        for (int q0 = 0; q0 < 128; q0 += 4) {
            f32x4 xc[4], gc_[4], cc_[4], sc_[4], wc_[4];
#pragma unroll
            for (int u = 0; u < 4; ++u) { xc[u] = xn[u]; gc_[u] = gn_[u]; cc_[u] = cn_[u]; sc_[u] = sn_[u]; wc_[u] = wn_[u]; }
            if (q0 + 4 < 128) RT_LOAD(q0 + 4);
#pragma unroll
            for (int u = 0; u < 4; ++u) { const int q = q0 + u;
                const f32x4 h4 = xc[u] * rstd * gc_[u] * (cc_[u] + 1.0f) + sc_[u];
                if (live) { v2u o; o.x = pk2(h4[0], h4[1]); o.y = pk2(h4[2], h4[3]); ho[2 * q] = o; }
                acc = __builtin_amdgcn_mfma_f32_32x32x2f32(h4[0], wc_[u][0], acc, 0, 0, 0);
                acc = __builtin_amdgcn_mfma_f32_32x32x2f32(h4[1], wc_[u][1], acc, 0, 0, 0);
                acc = __builtin_amdgcn_mfma_f32_32x32x2f32(h4[2], wc_[u][2], acc, 0, 0, 0);
                acc = __builtin_amdgcn_mfma_f32_32x32x2f32(h4[3], wc_[u][3], acc, 0, 0, 0); }
        }
#undef RT_LOAD
        const float rbias = a.in[I_RTB][l * 32 + i];
#pragma unroll
        for (int r = 0; r < 16; ++r) { const int ri = (r & 3) + 8 * (r >> 2) + 4 * kk; lg[ri * 33 + i] = acc[r] + rbias; }
        LDS_WAIT(); asm volatile("" ::: "memory");
        if (lane < nrow) {
            LAS float* lr = lg + lane * 33; const int orow = rb + lane;
            float tv[4]; int ti[4];
#pragma unroll
            for (int r = 0; r < 4; ++r) { float bv = -INFINITY; int bi = 0;
#pragma unroll 8
                for (int e = 0; e < 32; ++e) { const float v = lr[e]; if (v > bv) { bv = v; bi = e; } }
                tv[r] = bv; ti[r] = bi; lr[bi] = -INFINITY; }
            const float e1 = expf(tv[1] - tv[0]), e2 = expf(tv[2] - tv[0]), e3 = expf(tv[3] - tv[0]); const float inv = 1.0f / (1.0f + e1 + e2 + e3);
            *(int4*)(EIDX + orow * 4) = make_int4(ti[0], ti[1], ti[2], ti[3]); *(f32x4*)(GATE + orow * 4) = (f32x4){inv, e1 * inv, e2 * inv, e3 * inv};
#pragma unroll
            for (int r = 0; r < 4; ++r) { const int rk = __hip_atomic_fetch_add(&hist[ti[r]], 1, __ATOMIC_RELAXED, __HIP_MEMORY_SCOPE_WORKGROUP); lex[(orow - r0) * 4 + r] = ti[r]; lrk[(orow - r0) * 4 + r] = rk; }
        }
        LDS_WAIT(); asm volatile("" ::: "memory");
    }
    __syncthreads();
    if (F.tid < 32) { const int c = hist[F.tid]; offl[F.tid] = c ? (int)__hip_atomic_fetch_add((unsigned*)(ws + WS_CTL) + CW_CNT + 64 * l + F.tid, (unsigned)c, __ATOMIC_RELAXED, __HIP_MEMORY_SCOPE_AGENT) : 0; }
    __syncthreads();
    for (int i = F.tid; i < (r1 > r0 ? (r1 - r0) * 4 : 0); i += NTHREADS) { const int e = lex[i], pos = offl[e] + lrk[i];
        POS[r0 * 4 + i] = pos; ROWOF[(size_t)e * pg8::MOE_CAP + pos] = (unsigned)(r0 + (i >> 2)) * (unsigned)(D * 2); }
    __syncthreads();
}

__device__ __forceinline__ LAS int* load_moe_base(const Ctx& F, int l) {
    LAS int* base = (LAS int*)(F.lds + LDSCTL_OFF + 256);
    if (F.tid < 32) base[64 + F.tid] = (int)__hip_atomic_load((unsigned*)(F.a->ws + WS_CTL) + CW_CNT + 64 * l + F.tid, __ATOMIC_RELAXED, __HIP_MEMORY_SCOPE_AGENT);
    __syncthreads();
    if (F.tid == 0) { int acc = 0; for (int e = 0; e < 32; ++e) { base[e] = acc; acc += (base[64 + e] + 255) & ~255; } base[32] = acc; }
    __syncthreads();
    return base;
}
__device__ __forceinline__ void moe_fix_pos(const Ctx& F, int nrows, const LAS int* base) {
    unsigned char* ws = F.a->ws; const int* EIDX = (const int*)(ws + WS_EIDX); int* POS = (int*)(ws + WS_POS);
    const int rpb = (nrows + F.G - 1) / F.G, r0 = F.bid * rpb, r1 = (r0 + rpb < nrows) ? r0 + rpb : nrows;
    for (int i = F.tid; i < (r1 > r0 ? (r1 - r0) * 4 : 0); i += NTHREADS) POS[r0 * 4 + i] += base[EIDX[r0 * 4 + i]];
}

constexpr int NSTAGE_L = 13, NSTAGES = 1 + DEPTH * NSTAGE_L + 1;
__global__ void __launch_bounds__(NTHREADS, 2) mk_fwd(Args args) {
    extern __shared__ __attribute__((aligned(16))) unsigned char lds_raw[];
    Ctx F; F.a = kargs(); F.lds = (LAS unsigned char*)lds_raw; F.tid = threadIdx.x; F.lane = F.tid & 63; F.wave = __builtin_amdgcn_readfirstlane(F.tid >> 6); F.bid = blockIdx.x; F.G = gridDim.x;
    volatile LAS unsigned* MISC = (volatile LAS unsigned*)(F.lds + LDSCTL_OFF);
    for (int u = F.tid; u < (LDS_BYTES - LDSCTL_OFF) / 4; u += NTHREADS) ((LAS unsigned*)(F.lds + LDSCTL_OFF))[u] = 0u;
    __syncthreads();
#if MK_PER_STAGE
#define GRID_BAR() do { } while (0)
#else
    (void)xcd_barrier_post((unsigned*)(F.a->ws + WS_CTL) + CW_BAR, MISC + 8);
#define GRID_BAR() do { XcdBarrier b_; b_.bar = (unsigned*)(kargs()->ws + WS_CTL) + CW_BAR; b_.x = xb_xcc_id(); b_.st = (volatile LAS unsigned*)((LAS unsigned char*)lds_raw + LDSCTL_OFF + opaque(32)); xcd_barrier(b_); } while (0)
#endif
#ifndef ONLY_S
#define ONLY_S -1
#endif
#define STG_SEL(k) (ONLY_S < 0 || ONLY_S == (((k) == 0) ? 0 : ((k) == NSTAGES - 1 ? 14 : (((k) - 1) % NSTAGE_L) + 1)))
#if MK_PER_STAGE
#define IN(k) (STG_SEL(k) && kargs()->ph_lo == (k))
#else
#define IN(k) STG_SEL(k)
#endif
#if MK_PER_STAGE
#define SEAM(k) do { } while (0)
#else
#define SEAM(k) do { if ((k) + 1 < NSTAGES) GRID_BAR(); } while (0)
#endif
#define STAGE(k) if (IN(k)) { F.a = kargs(); F.tid = opaque_v((int)threadIdx.x); F.lane = F.tid & 63; F.wave = __builtin_amdgcn_readfirstlane(F.tid >> 6); F.bid = opaque((int)blockIdx.x); F.G = opaque((int)gridDim.x); F.lds = (LAS unsigned char*)lds_raw + opaque(0); unsigned char* ws = F.a->ws; const int l = opaque(lq); unsigned char* wl = ws + WS_WTS + (size_t)l * WL_STRIDE; (void)wl; (void)ws;
#define STAGE_END(k) } SEAM(k);
    int lq = 0;
    STAGE(0) p0_prologue(F); STAGE_END(0)
    for (lq = 0; lq < DEPTH; ++lq) {
        const int sb = 1 + lq * NSTAGE_L;
        const int nrl = opaque((lq == DEPTH - 1) ? T_LAT : T_ALL);
        STAGE(sb + 0) stage_norm1(F, l); STAGE_END(sb + 0)
        STAGE(sb + 1) pg8::SchedWin S; S.A = (const char*)(ws + WS_H); S.Bt = (const char*)(wl + WO_WIN); S.tstep = (size_t)256 * 1024 * 2; S.G = F.G; S.c = F.bid; S.part = (nrl != T_ALL); pg8::EpiBf16 E{(bf16*)(ws + WS_Z), IN_COLS, nullptr, 0};
            pg8::gemm_phase(F.lds, F.tid, 1024, S, E); STAGE_END(sb + 1)
        STAGE(sb + 2) for (int rep = 0; rep < REPN(1); ++rep) stage_rw_prep1(F, l); for (int rep = 0; rep < REPN(2); ++rep) stage_s5_scan<0>(F, l); for (int rep = 0; rep < REPN(3); ++rep) stage_hy_pre(F, l, nrl); STAGE_END(sb + 2)
        STAGE(sb + 3) { pg8::SchedP S; S.A = (const char*)(ws + WS_ARW); S.Bt = (const char*)(wl + WO_RWCAT); S.tstep = (size_t)256 * 256 * 2; S.nM = T_ALL / 256; S.G = F.G; S.c = F.bid; pg8::EpiBf16 E{(bf16*)(ws + WS_P), 2560, nullptr, 0}; pg8::gemm_phase(F.lds, F.tid, 256, S, E, 2); }
            F.tid = opaque_v((int)threadIdx.x); F.lane = F.tid & 63;
            STAGE_END(sb + 3)
        STAGE(sb + 4) for (int rep = 0; rep < REPN(5); ++rep) stage_rw_prep2(F, l); STAGE_END(sb + 4)
        STAGE(sb + 5) PT(10); stage_mixer(F, l); PT(11); STAGE_END(sb + 5) STAGE(sb + 5) PT(12); }
        STAGE(sb + 6) stage_s5_prep(F, l, nrl); STAGE_END(sb + 6)
        STAGE(sb + 7) { pg8::SchedStatic S; S.init(ws + WS_AS5, wl + WO_GLU, nrl, 1024, 512, F.G, F.bid); pg8::EpiGlu<0> E{(bf16*)(ws + WS_YS5), 512, F.a->in[I_S5GLUB] + l * 1024, 0, 512}; PT(13); pg8::gemm_phase(F.lds, F.tid, 512, S, E); PT(14); }
            for (int rep = 0; rep < REPN(7); ++rep) stage_rw_readout(F, l); for (int rep = 0; rep < REPN(8); ++rep) stage_hy_post(F, l, nrl); STAGE_END(sb + 7)
        STAGE(sb + 8) pg8::SchedMerge S; S.A0 = (const char*)(ws + WS_YHY); S.A1 = (const char*)(ws + WS_YRW); S.A2 = (const char*)(ws + WS_YS5); S.Bt = (const char*)(wl + WO_WBR); S.tstep = (size_t)256 * 512 * 2; S.bstride = (size_t)1024 * 512 * 2;
            S.nM = nrl / 256; S.nN = 4; S.G = F.G; S.c = F.bid;
            pg8::EpiMerge E{(bf16*)(ws + WS_MTMP), (bf16*)(ws + WS_H), (const bf16*)(ws + WS_Z) + GATE_OFF}; pg8::gemm_phase(F.lds, F.tid, 512, S, E); STAGE_END(sb + 8)
        STAGE(sb + 9) pg8::SchedStatic S; S.init(ws + WS_H, wl + WO_WOUT, nrl, 1024, 1024, F.G, F.bid); pg8::EpiResid E{(float*)(ws + WS_X), (const float*)(ws + WS_MOD) + (size_t)l * 9 * 6144 + 2048};
            pg8::gemm_phase(F.lds, F.tid, 1024, S, E); STAGE_END(sb + 9)
        STAGE(sb + 10) PT(17); stage_norm2_router(F, l, nrl); PT(18); STAGE_END(sb + 10)
        STAGE(sb + 11) LAS int* base = load_moe_base(F, l); moe_fix_pos(F, nrl, base);
            pg8::SchedMoeG S; S.A = (const char*)(ws + WS_H); S.rowof = (const unsigned*)(ws + WS_ROWOF); S.Bt = (const char*)(wl + WO_W1); S.tstep = (size_t)256 * 1024 * 2; S.estride = (size_t)2048 * 1024 * 2; S.NPN = 8; S.G = F.G; S.c = F.bid; S.base = base;
            pg8::EpiGlu<1> E{(bf16*)(ws + WS_ACT), 1024, F.a->in[I_B1] + (size_t)l * 32 * 2048, 2048, 1024}; pg8::gemm_phase(F.lds, F.tid, 1024, S, E); STAGE_END(sb + 11)
        STAGE(sb + 12) LAS int* base = load_moe_base(F, l);
            pg8::SchedMoe S; S.A = (const char*)(ws + WS_ACT); S.Bt = (const char*)(wl + WO_W2); S.tstep = (size_t)256 * 1024 * 2; S.estride = (size_t)1024 * 1024 * 2; S.NPN = 4; S.G = F.G; S.c = F.bid; S.base = base;
            pg8::EpiBf16 E{(bf16*)(ws + WS_XS), 1024, F.a->in[I_B2] + (size_t)l * 32 * 1024, 1024}; pg8::gemm_phase(F.lds, F.tid, 1024, S, E); STAGE_END(sb + 12)
    }
    lq = DEPTH;
    STAGE(NSTAGES - 1)
#ifndef PROBE_T
        stage_norm1(F, l);
#endif
#ifdef PROBE_T
        { const unsigned long long* st = (const unsigned long long*)(F.a->ws + WS_CTL + CW_STAMP * 4); const float cval = (float)(long long)(st[PROBE_B] - st[PROBE_A]) * (1.0f / (100.0f * PROBE_DIV));
          __syncthreads(); for (size_t i = (size_t)F.bid * NTHREADS + F.tid; i < (size_t)T_LAT * D; i += (size_t)F.G * NTHREADS) F.a->out[i] = cval; }
#endif
    }
#undef IN
#undef SEAM
}

extern "C" void kernel_launch(void* const* d_in, const int* in_sizes, int n_in, void* d_out, int out_size, void* d_ws, size_t ws_size, hipStream_t stream) {
    static int grid = 0;
    if (grid == 0) {
        if (n_in != 51 || out_size != T_LAT * D || ws_size < WS_END) { fprintf(stderr, "kernel_launch: unexpected shapes (n_in %d out %d ws %zu, need %zu)\n", n_in, out_size, ws_size, (size_t)WS_END); grid = -1; return; }
        int dev = 0, cus = 0, per_cu = 0;
        if (hipGetDevice(&dev) != hipSuccess || hipDeviceGetAttribute(&cus, hipDeviceAttributeMultiprocessorCount, dev) != hipSuccess) { grid = -1; return; }
        if (hipFuncSetAttribute((const void*)mk_fwd, hipFuncAttributeMaxDynamicSharedMemorySize, LDS_BYTES) != hipSuccess) { fprintf(stderr, "kernel_launch: hipFuncSetAttribute failed\n"); grid = -1; return; }
        if (hipOccupancyMaxActiveBlocksPerMultiprocessor(&per_cu, (const void*)mk_fwd, NTHREADS, LDS_BYTES) != hipSuccess || per_cu < 1) fprintf(stderr, "kernel_launch: occupancy query says %d\n", per_cu);
        (void)hipGetLastError();
        grid = cus;
    }
    if (grid < 0) return;
    if (hipMemsetAsync((char*)d_ws + WS_CTL, 0, CTL_ZERO_BYTES, stream) != hipSuccess) return;
    Args a{};
    for (int i = 0; i < 51; ++i) a.in[i] = (const float*)d_in[i];
    a.out = (float*)d_out; a.ws = (unsigned char*)d_ws;
#if MK_PER_STAGE
    for (int s = 0; s < NSTAGES; ++s) { a.ph_lo = s; a.ph_hi = s + 1; int reps = 1;
#ifdef PROBE_SET
        { const int ls = (s == 0 || s == NSTAGES - 1) ? -1 : (s - 1) % NSTAGE_L;
          if (PROBE_SET >= 1 && PROBE_SET <= 13 && ls == PROBE_SET - 1 && ls != 5 && ls != 8 && !(ls == 0 && s > 1)) reps = 3;
          if (PROBE_SET == 14 && s == 0) reps = 3; }
#endif
        for (int r = 0; r < reps; ++r) hipLaunchKernelGGL(mk_fwd, dim3(grid), dim3(NTHREADS), LDS_BYTES, stream, a); }
#else
    a.ph_lo = 0; a.ph_hi = NSTAGES; hipLaunchKernelGGL(mk_fwd, dim3(grid), dim3(NTHREADS), LDS_BYTES, stream, a);
#endif
}
```

```cpp
#include <hip/hip_runtime.h>
#include <cstdio>
#include <cstdint>

#ifndef DUPK
#define DUPK 0
#endif
#define REPN(k) ((DUPK == (k)) ? 3 : 1)
#ifndef REP_GEMM
#define REP_GEMM 1
#endif
#ifndef REP_LIGHT
#define REP_LIGHT 1
#endif
#ifndef REP_PRO
#define REP_PRO 1
#endif
#ifndef MK_PER_STAGE
#define MK_PER_STAGE 0
#endif

#define GAS __attribute__((address_space(1)))
#define LAS __attribute__((address_space(3)))
typedef unsigned short bf16;
typedef unsigned v4u __attribute__((ext_vector_type(4)));
typedef unsigned v2u __attribute__((ext_vector_type(2)));
typedef float f32x4 __attribute__((ext_vector_type(4)));
typedef float f32x2 __attribute__((ext_vector_type(2)));
typedef short bf16x8 __attribute__((ext_vector_type(8)));

constexpr int D = 1024, BATCH = 8, SEQ = 4096, CTXL = 256, DEPTH = 2;
constexpr int T_LAT = BATCH * SEQ, T_CTX = BATCH * CTXL, T_ALL = T_LAT + T_CTX;
constexpr int IN_COLS = 6912, HY_OFF = 0, RW_OFF = 1536, S5_OFF = 3328, GATE_OFF = 3840;
constexpr int NE = 32, TOPK = 4;
constexpr int MAXSLOT = 147456;
constexpr int NWAVES = 8, NTHREADS = 512;
constexpr int HY_MARG = 128, HY_ROWB = 8720, HY_RLEN = 8272, HY_RLENC = 592;
constexpr int HY_R1_OFF = 8 * HY_ROWB, HY_R2_OFF = HY_R1_OFF + HY_RLEN * 2;

constexpr size_t MiB = 1ull << 20;
constexpr size_t WS_CTL = 0, CTL_ZERO_BYTES = 1 * MiB;
constexpr size_t WS_MOD = 1 * MiB;
constexpr size_t WS_BLKCNT = 2 * MiB;
constexpr size_t WS_META = 2 * MiB + 512 * 1024;
constexpr size_t WS_ROWOF = 480 * MiB;
constexpr int CW_CNT = 24576;
constexpr size_t WS_EIDX = 3 * MiB, WS_GATE = 4 * MiB, WS_POS = 5 * MiB;
constexpr size_t WS_WTS = 8 * MiB, WL_STRIDE = 214 * MiB;
constexpr size_t WO_WIN = 0, WO_RWCAT = 14 * MiB, WO_GLU = 16 * MiB, WO_WBR = 17 * MiB, WO_WOUT = 20 * MiB, WO_W1 = 22 * MiB, WO_W2 = 150 * MiB;
constexpr size_t WS_GF = 436 * MiB, GF_STRIDE = 20 * MiB, GF_CTX = 17 * MiB;
constexpr size_t WS_X = 504 * MiB;
constexpr size_t WS_H = 640 * MiB;
constexpr size_t WS_BIG = 708 * MiB;
constexpr size_t WS_Z = WS_BIG;
constexpr size_t WS_SCN = 1167 * MiB;
constexpr size_t WS_MTMP = WS_SCN;
constexpr size_t WS_P = 1473 * MiB;
constexpr size_t WS_ARW = 1643 * MiB;
constexpr size_t WS_YDIR = 1660 * MiB;
constexpr size_t WS_YP = 1898 * MiB;
constexpr size_t WS_UT = 1796 * MiB;
constexpr size_t WS_AS5 = 2000 * MiB;
constexpr size_t WS_YHY = 1898 * MiB, WS_YRW = 1932 * MiB, WS_YS5 = 1966 * MiB;
constexpr size_t WS_XS = WS_BIG;
constexpr size_t WS_ACT = WS_BIG + 288 * MiB;
constexpr size_t WS_END = 2034 * MiB;
constexpr int CW_BAR = 4096;

constexpr int RING_BYTES = 131072;
constexpr int LDSCTL_OFF = RING_BYTES;
constexpr int LDS_BYTES = 163840;

typedef __bf16 bf16x2_t __attribute__((ext_vector_type(2)));
__device__ __forceinline__ unsigned pk2(float lo, float hi) { const bf16x2_t v = __builtin_convertvector((f32x2){lo, hi}, bf16x2_t); return __builtin_bit_cast(unsigned, v); }
__device__ __forceinline__ unsigned f2bf(float f) { return pk2(f, 0.f) & 0xffffu; }
__device__ __forceinline__ float bf2f(bf16 b) { return __builtin_bit_cast(float, ((unsigned)b) << 16); }
__device__ __forceinline__ float bflo(unsigned w) { return __builtin_bit_cast(float, w << 16); }
__device__ __forceinline__ float bfhi(unsigned w) { return __builtin_bit_cast(float, w & 0xffff0000u); }
__device__ __forceinline__ float sigm(float x) { return __builtin_amdgcn_rcpf(1.f + __expf(-x)); }
__device__ __forceinline__ float tanh_fast(float x) { const float e = __expf(2.f * x); return 1.f - 2.f * __builtin_amdgcn_rcpf(e + 1.f); }
#define LDS_WAIT() asm volatile("s_waitcnt lgkmcnt(0)" ::: "memory")
__device__ __forceinline__ float dpp_f(float x, const int ctrl_sel) {
    const int v = __builtin_bit_cast(int, x);
    int r;
    if (ctrl_sel == 0) r = __builtin_amdgcn_update_dpp(0, v, 0xB1, 0xF, 0xF, true);
    else if (ctrl_sel == 1) r = __builtin_amdgcn_update_dpp(0, v, 0x4E, 0xF, 0xF, true);
    else r = __builtin_amdgcn_update_dpp(0, v, 0x141, 0xF, 0xF, true);
    return __builtin_bit_cast(float, r);
}
__device__ __forceinline__ float red32(float x) {
    x += dpp_f(x, 0); x += dpp_f(x, 1); x += dpp_f(x, 2);
    x += __builtin_bit_cast(float, __builtin_amdgcn_update_dpp(0, __builtin_bit_cast(int, x), 0x128, 0xF, 0xF, true));
    x += __builtin_bit_cast(float, __builtin_amdgcn_ds_swizzle(__builtin_bit_cast(int, x), 0x401F));
    return x;
}
__device__ __forceinline__ float wave_sum(float v) {
    v = red32(v);
    return __builtin_bit_cast(float, __builtin_amdgcn_readlane(__builtin_bit_cast(int, v), 0)) + __builtin_bit_cast(float, __builtin_amdgcn_readlane(__builtin_bit_cast(int, v), 32));
}
__device__ __forceinline__ int xch32(int v, const int step) {
    if (step == 0) return __builtin_amdgcn_update_dpp(0, v, 0xB1, 0xF, 0xF, true);
    if (step == 1) return __builtin_amdgcn_update_dpp(0, v, 0x4E, 0xF, 0xF, true);
    if (step == 2) return __builtin_amdgcn_update_dpp(0, v, 0x141, 0xF, 0xF, true);
    if (step == 3) return __builtin_amdgcn_update_dpp(0, v, 0x128, 0xF, 0xF, true);
    return __builtin_amdgcn_ds_swizzle(v, 0x401F);
}
__device__ __forceinline__ float red8(float x) { x += dpp_f(x, 0); x += dpp_f(x, 1); x += dpp_f(x, 2); return x; }

#define XB_TMO      128
#define XB_XCNT(j)  (256  + 64 * (j))
#define XB_XSUB(j)  (1280 + 64 * (j))
#define XB_XGEN(j)  (2304 + 64 * (j))
#define XB_TOP      3328
#define XB_TOPGEN   3392
#define XCD_BAR_WORDS 3456
#define XB_SPIN_CAP (1u << 22)
__device__ __forceinline__ unsigned xb_ld(unsigned* p)              { return __hip_atomic_load(p, __ATOMIC_RELAXED, __HIP_MEMORY_SCOPE_AGENT); }
__device__ __forceinline__ unsigned xb_add(unsigned* p, unsigned v) { return __hip_atomic_fetch_add(p, v, __ATOMIC_RELAXED, __HIP_MEMORY_SCOPE_AGENT); }
__device__ __forceinline__ unsigned xb_xcc_id() { return (unsigned)__builtin_amdgcn_s_getreg((3 << 11) | 20) & 0xFu; }
#define XB_SPIN(cond, bar) do { unsigned _sp = 0; while (cond) { __builtin_amdgcn_s_sleep(1); \
    if ((++_sp & 255u) == 0u) { if (xb_ld(&(bar)[XB_TMO])) break; if (_sp > XB_SPIN_CAP) { atomicAdd(&(bar)[XB_TMO], 1u); break; } } } } while (0)
struct XcdBarrier { unsigned* bar; unsigned x; volatile LAS unsigned* st; };
__device__ __forceinline__ XcdBarrier xcd_barrier_post(unsigned* bar, volatile LAS unsigned* st) {
    XcdBarrier b; b.bar = bar; b.x = xb_xcc_id(); b.st = st;
    if (threadIdx.x == 0) (void)xb_add(&bar[XB_XCNT(b.x)], 1u);
    return b;
}
__device__ __forceinline__ void xcd_barrier_complete(unsigned* bar, unsigned x, unsigned& nloc, unsigned& nx) {
    const unsigned G = gridDim.x * gridDim.y * gridDim.z;
    unsigned sum, cnt, mine, sp = 0u;
    for (;;) {
        sum = 0u; cnt = 0u; mine = 0u;
#pragma unroll
        for (unsigned j = 0; j < 16; ++j) { const unsigned c = xb_ld(&bar[XB_XCNT(j)]); sum += c; cnt += (c > 0u) ? 1u : 0u; mine = (j == x) ? c : mine; }
        if (sum == G) break;
        __builtin_amdgcn_s_sleep(1);
        if ((++sp & 255u) == 0u) { if (xb_ld(&bar[XB_TMO])) break; if (sp > XB_SPIN_CAP) { atomicAdd(&bar[XB_TMO], 1u); break; } }
    }
    nloc = mine > 0u ? mine : 1u; nx = cnt > 0u ? cnt : 1u;
}
__device__ __forceinline__ void xcd_barrier(const XcdBarrier& b) {
    asm volatile("s_waitcnt vmcnt(0)" ::: "memory");
    __syncthreads();
    if (threadIdx.x == 0) {
        unsigned* bar = b.bar;
        __builtin_amdgcn_s_waitcnt(0);
        unsigned nloc = b.st[0], nx = b.st[1];
        if (nloc == 0u) { xcd_barrier_complete(bar, b.x, nloc, nx); b.st[0] = nloc; b.st[1] = nx; }
        const unsigned old = xb_add(&bar[XB_XSUB(b.x)], 1u);
        const unsigned gen = old / nloc;
        if (old + 1u == (gen + 1u) * nloc) {
            __builtin_amdgcn_fence(__ATOMIC_RELEASE, "agent");
            asm volatile("s_waitcnt vmcnt(0)" ::: "memory");
            const unsigned og = xb_add(&bar[XB_TOP], 1u);
            const unsigned tg = og / nx;
            if (og + 1u == (tg + 1u) * nx) xb_add(&bar[XB_TOPGEN], 1u);
            else XB_SPIN(xb_ld(&bar[XB_TOPGEN]) == tg, bar);
            __builtin_amdgcn_fence(__ATOMIC_ACQUIRE, "agent");
            xb_add(&bar[XB_XGEN(b.x)], 1u);
            asm volatile("s_waitcnt vmcnt(0)" ::: "memory");
        } else {
            XB_SPIN(xb_ld(&bar[XB_XGEN(b.x)]) == gen, bar);
            __builtin_amdgcn_fence(__ATOMIC_ACQUIRE, "agent");
            asm volatile("s_waitcnt vmcnt(0)" ::: "memory");
        }
    }
    __syncthreads();
}

namespace pg8 {
constexpr int MOE_CAP = 34816;
constexpr int BM = 256, BK = 64, HALF = 128, HTB = HALF * BK * 2, STAGE_BYTES = 8 * HTB, NXCD = 8, WGM = 8, ROWTAB_OFF = 131072 + 4096;
__host__ __device__ __forceinline__ int lds_byte(int r, int c) { const int st = (r >> 4) * 2 + (c >> 5), rr = r & 15, cc = c & 31, ob = rr * 64 + cc * 2; return st * 1024 + (ob ^ (((ob >> 9) & 1) << 5)); }
__host__ __device__ __forceinline__ void stage_rc(int b, int& R, int& C) { const int st = b / 1024, sb = b % 1024, swz = sb ^ (((sb >> 9) & 1) << 5); R = (st >> 1) * 16 + swz / 64; C = (st & 1) * 32 + (swz % 64) / 2; }
__host__ __device__ __forceinline__ int perm32(int rho) { const int n = rho >> 4, i = rho & 15; return 8 * (i >> 2) + 4 * n + (i & 3); }
struct Unit { int pm, pn, e; };
__device__ __forceinline__ unsigned cvt_pk_bf16(float lo, float hi) { return pk2(lo, hi); }

__device__ __forceinline__ void tile_of(int L, int nM, int nN, int& pm, int& pn) {
    const int nwg = nM * nN; int wgid = L;
    { const int q = nwg / NXCD, r = nwg % NXCD, xcd = wgid % NXCD, off = wgid / NXCD; wgid = (xcd < r ? xcd * (q + 1) : r * (q + 1) + (xcd - r) * q) + off; }
    const int nig = WGM * nN, gid = wgid / nig, fm = gid * WGM, gsz = (nM - fm) < WGM ? (nM - fm) : WGM;
    pm = fm + ((wgid % nig) % gsz); pn = (wgid % nig) / gsz;
}
struct SchedStatic {
    static constexpr bool GATHER = false;
    const char* A; const char* Bt; size_t tstep; int nM, nN, G, c;
    __device__ __forceinline__ void init(const void* A_, const void* Bt_, int M, int N, int K, int G_, int c_) { A = (const char*)A_; Bt = (const char*)Bt_; tstep = (size_t)BM * K * 2; nM = M / BM; nN = N / BM; G = G_; c = c_; }
    __device__ __forceinline__ bool next(int i, Unit& u) const { const long L = (long)i * G + c; if (L >= (long)nM * nN) return false; tile_of((int)L, nM, nN, u.pm, u.pn); u.e = 0; return true; }
    __device__ __forceinline__ const char* aptr(const Unit& u) const { return A + (size_t)u.pm * tstep; }
    __device__ __forceinline__ const char* bptr(const Unit& u) const { return Bt + (size_t)u.pn * tstep; }
};
struct SchedWin {
    static constexpr bool GATHER = false;
    const char* A; const char* Bt; size_t tstep; int G, c, part;
    __device__ __forceinline__ bool next(int i, Unit& u) const {
        const int L = i * G + c, nmf = part ? 128 : 136, nfull = nmf * 27; u.e = 0;
        if (L < nfull) { tile_of(L, nmf, 27, u.pm, u.pn); return true; }
        const int L2 = L - nfull; if (!part || L2 >= 8 * 9) return false;
        u.pm = 128 + L2 / 9; u.pn = 6 + L2 % 9; return true; }
    __device__ __forceinline__ const char* aptr(const Unit& u) const { return A + (size_t)u.pm * tstep; }
    __device__ __forceinline__ const char* bptr(const Unit& u) const { return Bt + (size_t)u.pn * tstep; }
};
struct SchedP {
    static constexpr bool GATHER = false;
    const char* A; const char* Bt; size_t tstep; int nM, G, c;
    __device__ __forceinline__ bool next(int i, Unit& u) const { const long L = (long)i * G + c; if (L >= (long)nM * 10) return false; tile_of((int)L, nM, 10, u.pm, u.pn); u.e = 0; return true; }
    __device__ __forceinline__ const char* aptr(const Unit& u) const { return A + (size_t)u.pm * tstep + (u.pn < 8 ? 0 : 256); }
    __device__ __forceinline__ const char* bptr(const Unit& u) const { return Bt + (size_t)u.pn * tstep + (u.pn < 8 ? 0 : 256); }
};
struct SchedMerge {
    static constexpr bool GATHER = false;
    const char* A0; const char* A1; const char* A2; const char* Bt; size_t tstep, bstride; int nM, nN, G, c;
    __device__ __forceinline__ bool next(int i, Unit& u) const { const int j = i / 3, br = i - 3 * j; const long L = (long)j * G + c; if (L >= (long)nM * nN) return false; tile_of((int)L, nM, nN, u.pm, u.pn); u.e = br; return true; }
    __device__ __forceinline__ const char* aptr(const Unit& u) const { return (u.e == 0 ? A0 : (u.e == 1 ? A1 : A2)) + (size_t)u.pm * tstep; }
    __device__ __forceinline__ const char* bptr(const Unit& u) const { return Bt + (size_t)u.e * bstride + (size_t)u.pn * tstep; }
};
struct SchedMoe {
    static constexpr bool GATHER = false;
    const char* A; const char* Bt; size_t tstep, estride; int NPN, G, c; const LAS int* base;
    __device__ __forceinline__ bool next(int i, Unit& u) const {
        const int ntiles = base[32] >> 8; const int per = G >> 3;
        const long L = (long)i * G + (((G & 7) == 0) ? (c & 7) * per + (c >> 3) : c);
        if (L >= (long)ntiles * NPN) return false;
        u.pm = (int)(L / NPN); u.pn = (int)(L % NPN); const int r0 = u.pm << 8; int e = 0;
#pragma unroll 1
        for (int k = 1; k < 32; ++k) e += (r0 >= base[k]) ? 1 : 0;
        u.e = e; return true;
    }
    __device__ __forceinline__ const char* aptr(const Unit& u) const { return A + (size_t)u.pm * tstep; }
    __device__ __forceinline__ const char* bptr(const Unit& u) const { return Bt + (size_t)u.e * estride + (size_t)u.pn * tstep; }
};
struct SchedMoeG : SchedMoe {
    static constexpr bool GATHER = true;
    const unsigned* rowof;
    __device__ __forceinline__ const char* aptr(const Unit&) const { return A; }
    __device__ __forceinline__ const unsigned* rowptr(const Unit& u) const { return rowof + (size_t)u.e * MOE_CAP + ((u.pm << 8) - base[u.e]); }
    __device__ __forceinline__ int valid(const Unit& u) const { return base[64 + u.e] - ((u.pm << 8) - base[u.e]); }
};

template <class Epi, class Sched>
__device__ __forceinline__ void gemm_phase(LAS unsigned char* lds, const int tid, const int K, const Sched& S, const Epi& E, const int ntk = 0) {
    const int wid = __builtin_amdgcn_readfirstlane(tid >> 6), lane = tid & 63, wr = wid >> 2, wc = wid & 3, fr = lane & 15, fq = lane >> 4;
    const int nt = ntk ? ntk : K / BK;
    unsigned voffA[2], voffB[2];
#pragma unroll
    for (int i = 0; i < 2; ++i) { int R, C; stage_rc(tid * 16 + i * 8192, R, C); const int Rb = Epi::PERM ? ((R & ~31) + perm32(R & 31)) : R;
        voffA[i] = (unsigned)(R * K + C) * 2u; voffB[i] = (unsigned)(Rb * K + C) * 2u; }
    const size_t kstep = (size_t)(BK * 2);
    const size_t hstep = (size_t)HALF * K * 2;
    const unsigned ldsw = (unsigned)wid * 1024u;
    const int aoff = lds_byte(wr * 64 + fr, fq * 8), boff = lds_byte(wc * 32 + fr, fq * 8);
#define PG8_SA(b, h) (((b) * 2 + (h)) * HTB)
#define PG8_SB(b, h) ((4 + (b) * 2 + (h)) * HTB)
#define PG8_STAGE(bufoff, gbase, voff) do { _Pragma("unroll") for (int _i = 0; _i < 2; ++_i) \
        __builtin_amdgcn_global_load_lds((const unsigned*)((const char*)(gbase) + (voff)[_i]), (LAS unsigned*)(lds + (bufoff) + ldsw + _i * 8192), 16, 0, 0); } while (0)
#define PG8_STAGEA(bufoff, kp, h) do { if constexpr (Sched::GATHER) { _Pragma("unroll") for (int _i = 0; _i < 2; ++_i) \
        __builtin_amdgcn_global_load_lds((const unsigned*)((const char*)(kp) + g[2 * (h) + _i]), (LAS unsigned*)(lds + (bufoff) + ldsw + _i * 8192), 16, 0, 0); } \
        else { PG8_STAGE(bufoff, (kp) + (h) * hstep, voffA); } } while (0)
#define PG8_GLOAD(un_, buf) do { const LAS unsigned* rt_ = (const LAS unsigned*)(lds + ROWTAB_OFF + (buf) * 1024) + gR0; const int nv_ = S.valid(un_); \
        _Pragma("unroll") for (int _j = 0; _j < 4; ++_j) g[_j] = ((gR0 + 64 * _j < nv_) ? rt_[64 * _j] : 0u) + gCb; } while (0)
#define PG8_GDMA(un_, buf) do { if (wid == 0) { unsigned lo_ = (unsigned)threadIdx.x; asm volatile("" : "+v"(lo_)); lo_ = (lo_ & 63u) * 16u; \
        __builtin_amdgcn_global_load_lds((const unsigned*)((const char*)S.rowptr(un_) + lo_), (LAS unsigned*)(lds + ROWTAB_OFF + (buf) * 1024), 16, 0, 0); } } while (0)
#define PG8_LDA(dst, b, h) do { _Pragma("unroll") for (int m = 0; m < 4; ++m) _Pragma("unroll") for (int k = 0; k < 2; ++k) dst[m][k] = *(const LAS bf16x8*)(lds + PG8_SA(b, h) + aoff + m * 2048 + k * 1024); } while (0)
#define PG8_LDB(dst, b, h) do { _Pragma("unroll") for (int n = 0; n < 2; ++n) _Pragma("unroll") for (int k = 0; k < 2; ++k) dst[n][k] = *(const LAS bf16x8*)(lds + PG8_SB(b, h) + boff + n * 2048 + k * 1024); } while (0)
#define PG8_MMA(ai, bj, At, Bt) do { __builtin_amdgcn_s_setprio(1); _Pragma("unroll") for (int m = 0; m < 4; ++m) _Pragma("unroll") for (int n = 0; n < 2; ++n) _Pragma("unroll") for (int k = 0; k < 2; ++k) \
        acc[ai][bj][m][n] = __builtin_amdgcn_mfma_f32_16x16x32_bf16(Bt[n][k], At[m][k], acc[ai][bj][m][n], 0, 0, 0); __builtin_amdgcn_s_setprio(0); } while (0)
#define PG8_WAIT_V(n) asm volatile("s_waitcnt vmcnt(" #n ")" ::: "memory")
#define PG8_WAIT_L(n) asm volatile("s_waitcnt lgkmcnt(" #n ")" ::: "memory")
#define PG8_BAR __builtin_amdgcn_s_barrier()
#define PG8_SCHED __builtin_amdgcn_sched_barrier(0)
    Unit cur, nxt; int ui = 0;
    if (!S.next(0, cur)) return;
    f32x4 acc[2][2][4][2];
#pragma unroll
    for (int a = 0; a < 2; ++a)
#pragma unroll
        for (int b = 0; b < 2; ++b)
#pragma unroll
            for (int m = 0; m < 4; ++m)
#pragma unroll
                for (int n = 0; n < 2; ++n) acc[a][b][m][n] = (f32x4){0.f, 0.f, 0.f, 0.f};
    bf16x8 At[4][2], B0[2][2], B1[2][2];
    const char* cA = S.aptr(cur); const char* cB = S.bptr(cur);
    unsigned g[4] = {0u, 0u, 0u, 0u}; int gR0 = 0; unsigned gCb = 0u;
    if constexpr (Sched::GATHER) { int R, C; stage_rc(tid * 16, R, C); gR0 = R; gCb = (unsigned)C * 2u;
        PG8_GDMA(cur, 0); PG8_WAIT_V(0); PG8_BAR; PG8_GLOAD(cur, 0); }
    PG8_STAGE(PG8_SB(0, 0), cB, voffB); PG8_STAGE(PG8_SB(0, 1), cB + hstep, voffB); PG8_STAGEA(PG8_SA(0, 0), cA, 0); PG8_STAGEA(PG8_SA(0, 1), cA, 1);
    if (wr == 1) PG8_BAR;
    PG8_WAIT_V(2); PG8_BAR;
    PG8_STAGE(PG8_SB(1, 0), cB + kstep, voffB); PG8_STAGEA(PG8_SA(1, 0), cA + kstep, 0); PG8_STAGE(PG8_SB(1, 1), cB + hstep + kstep, voffB);
    PG8_WAIT_V(6); PG8_BAR;
    for (;;) {
        const bool has_next = S.next(ui + 1, nxt);
        const char* nA = has_next ? S.aptr(nxt) : cA; const char* nB = has_next ? S.bptr(nxt) : cB;
        if constexpr (Sched::GATHER) { if (has_next) PG8_GDMA(nxt, (ui + 1) & 1); }
        for (int t = 0; t < nt; t += 2) {
            const bool last = (t == nt - 2);
            const char* a1 = cA + (size_t)(t + 1) * kstep;
            const char* a2 = last ? nA : cA + (size_t)(t + 2) * kstep; const char* b2 = last ? nB : cB + (size_t)(t + 2) * kstep;
            const char* a3 = a2 + kstep; const char* b3 = b2 + kstep;
            PG8_LDB(B0, 0, 0); PG8_LDB(B1, 0, 1); PG8_SCHED; PG8_LDA(At, 0, 0); PG8_STAGEA(PG8_SA(1, 1), a1, 1);
            PG8_WAIT_V(8); PG8_WAIT_L(0); PG8_BAR; PG8_MMA(0, 0, At, B0); PG8_MMA(0, 1, At, B1); PG8_BAR; PG8_SCHED;
            if constexpr (Sched::GATHER) { if (last && has_next) PG8_GLOAD(nxt, (ui + 1) & 1); PG8_SCHED; }
            PG8_LDA(At, 0, 1); PG8_STAGE(PG8_SB(0, 0), b2, voffB); PG8_STAGE(PG8_SB(0, 1), b2 + hstep, voffB); PG8_STAGEA(PG8_SA(0, 0), a2, 0);
            PG8_WAIT_V(8); PG8_WAIT_L(0); PG8_BAR; PG8_MMA(1, 0, At, B0); PG8_MMA(1, 1, At, B1); PG8_BAR; PG8_SCHED;
            PG8_LDB(B0, 1, 0); PG8_LDB(B1, 1, 1); PG8_SCHED; PG8_LDA(At, 1, 0); PG8_STAGEA(PG8_SA(0, 1), a2, 1);
            PG8_WAIT_V(8); PG8_WAIT_L(0); PG8_BAR; PG8_MMA(0, 0, At, B0); PG8_MMA(0, 1, At, B1); PG8_BAR; PG8_SCHED;
            PG8_LDA(At, 1, 1); PG8_STAGE(PG8_SB(1, 0), b3, voffB); PG8_STAGE(PG8_SB(1, 1), b3 + hstep, voffB); PG8_STAGEA(PG8_SA(1, 0), a3, 0);
            PG8_WAIT_V(8); PG8_WAIT_L(0); PG8_BAR; PG8_MMA(1, 0, At, B0); PG8_MMA(1, 1, At, B1); PG8_BAR; PG8_SCHED;
        }
        if (wr == 0) PG8_BAR;
        { int t2_ = (int)threadIdx.x; asm volatile("" : "+v"(t2_)); E(acc, cur, wr, wc, t2_ & 15, (t2_ >> 4) & 3); }
        if (!has_next) break;
#pragma unroll
        for (int a = 0; a < 2; ++a)
#pragma unroll
            for (int b = 0; b < 2; ++b)
#pragma unroll
                for (int m = 0; m < 4; ++m)
#pragma unroll
                    for (int n = 0; n < 2; ++n) acc[a][b][m][n] = (f32x4){0.f, 0.f, 0.f, 0.f};
        cur = nxt; cA = nA; cB = nB; ++ui;
        if (wr == 1) PG8_BAR;
    }
    PG8_WAIT_V(0);
    PG8_BAR;
#undef PG8_SA
#undef PG8_SB
#undef PG8_STAGE
#undef PG8_STAGEA
#undef PG8_GLOAD
#undef PG8_GDMA
#undef PG8_LDA
#undef PG8_LDB
#undef PG8_MMA
#undef PG8_WAIT_V
#undef PG8_WAIT_L
#undef PG8_BAR
#undef PG8_SCHED
}

struct EpiBf16 {
    static constexpr bool PERM = true;
    bf16* O; int ldc; const float* bias; int bias_stride;
    __device__ __forceinline__ void operator()(const f32x4 (&acc)[2][2][4][2], const Unit& u, int wr, int wc, int fr, int fq) const {
        const int row0 = u.pm * BM + wr * 64 + fr, col0 = u.pn * BM + wc * 32 + 8 * fq;
        f32x4 bv[2][2];
#pragma unroll
        for (int bj = 0; bj < 2; ++bj)
#pragma unroll
            for (int n = 0; n < 2; ++n) bv[bj][n] = bias ? *(const f32x4*)(bias + (size_t)u.e * bias_stride + col0 + bj * HALF + 4 * n) : (f32x4){0.f, 0.f, 0.f, 0.f};
#pragma unroll
        for (int ai = 0; ai < 2; ++ai)
#pragma unroll
            for (int m = 0; m < 4; ++m) { bf16* rowp = O + (size_t)(row0 + ai * HALF + m * 16) * ldc + col0;
#pragma unroll
                for (int bj = 0; bj < 2; ++bj) { const f32x4 v0 = acc[ai][bj][m][0] + bv[bj][0], v1 = acc[ai][bj][m][1] + bv[bj][1];
                    v4u w; w.x = cvt_pk_bf16(v0[0], v0[1]); w.y = cvt_pk_bf16(v0[2], v0[3]); w.z = cvt_pk_bf16(v1[0], v1[1]); w.w = cvt_pk_bf16(v1[2], v1[3]);
                    *(v4u*)(rowp + bj * HALF) = w; } }
    }
};
template <int MODE> struct EpiGlu {
    static constexpr bool PERM = true;
    bf16* O; int ldc; const float* bias; int bias_stride, hs;
    __device__ __forceinline__ void operator()(const f32x4 (&acc)[2][2][4][2], const Unit& u, int wr, int wc, int fr, int fq) const {
        const int row0 = u.pm * BM + wr * 64 + fr, col0 = u.pn * HALF + wc * 32 + 8 * fq;
        const float* bp = bias + (size_t)u.e * bias_stride + col0;
        f32x4 ba[2], bb[2];
#pragma unroll
        for (int n = 0; n < 2; ++n) { ba[n] = *(const f32x4*)(bp + 4 * n); bb[n] = *(const f32x4*)(bp + hs + 4 * n); }
#pragma unroll
        for (int ai = 0; ai < 2; ++ai)
#pragma unroll
            for (int m = 0; m < 4; ++m) { bf16* rowp = O + (size_t)(row0 + ai * HALF + m * 16) * ldc + col0;
                float o[8];
#pragma unroll
                for (int n = 0; n < 2; ++n) { const f32x4 a = acc[ai][0][m][n] + ba[n], b = acc[ai][1][m][n] + bb[n];
#pragma unroll
                    for (int j = 0; j < 4; ++j) {
                        if (MODE == 0) o[4 * n + j] = a[j] * sigm(b[j]);
                        else { const float g = fminf(a[j], 7.f), up = fminf(fmaxf(b[j], -7.f), 7.f); o[4 * n + j] = (up + 1.f) * g * sigm(1.702f * g); } } }
                v4u w; w.x = cvt_pk_bf16(o[0], o[1]); w.y = cvt_pk_bf16(o[2], o[3]); w.z = cvt_pk_bf16(o[4], o[5]); w.w = cvt_pk_bf16(o[6], o[7]);
                *(v4u*)rowp = w; }
    }
};
struct EpiMerge {
    static constexpr bool PERM = true;
    bf16* mtmp; bf16* Mo; const bf16* zg;
    __device__ __forceinline__ void operator()(const f32x4 (&acc)[2][2][4][2], const Unit& u, int wr, int wc, int fr, int fq) const {
        const int row0 = u.pm * BM + wr * 64 + fr, col0 = u.pn * BM + wc * 32 + 8 * fq;
#pragma unroll
        for (int ai = 0; ai < 2; ++ai)
#pragma unroll
            for (int m = 0; m < 4; ++m) { const size_t r = (size_t)(row0 + ai * HALF + m * 16);
#pragma unroll
                for (int bj = 0; bj < 2; ++bj) { const int c = col0 + bj * HALF;
                    const v4u gz = *(const v4u*)(zg + r * IN_COLS + u.e * 1024 + c);
                    float g[8] = {bflo(gz.x), bfhi(gz.x), bflo(gz.y), bfhi(gz.y), bflo(gz.z), bfhi(gz.z), bflo(gz.w), bfhi(gz.w)};
                    f32x4 t0, t1; bf16* tp = mtmp + r * 1024 + c;
                    if (u.e == 0) { t0 = (f32x4){0.f, 0.f, 0.f, 0.f}; t1 = t0; } else { const v4u pv = *(const v4u*)tp; t0 = (f32x4){bflo(pv.x), bfhi(pv.x), bflo(pv.y), bfhi(pv.y)}; t1 = (f32x4){bflo(pv.z), bfhi(pv.z), bflo(pv.w), bfhi(pv.w)}; }
#pragma unroll
                    for (int j = 0; j < 4; ++j) { t0[j] += sigm(g[j]) * acc[ai][bj][m][0][j]; t1[j] += sigm(g[4 + j]) * acc[ai][bj][m][1][j]; }
                    if (u.e < 2) { v4u w; w.x = cvt_pk_bf16(t0[0], t0[1]); w.y = cvt_pk_bf16(t0[2], t0[3]); w.z = cvt_pk_bf16(t1[0], t1[1]); w.w = cvt_pk_bf16(t1[2], t1[3]); *(v4u*)tp = w; }
                    else { v4u w; w.x = cvt_pk_bf16(t0[0], t0[1]); w.y = cvt_pk_bf16(t0[2], t0[3]); w.z = cvt_pk_bf16(t1[0], t1[1]); w.w = cvt_pk_bf16(t1[2], t1[3]);
                        *(v4u*)(Mo + r * 1024 + c) = w; } } }
    }
};
struct EpiResid {
    static constexpr bool PERM = false;
    float* X; const float* gmod;
    __device__ __forceinline__ void operator()(const f32x4 (&acc)[2][2][4][2], const Unit& u, int wr, int wc, int fr, int fq) const {
        const int row0 = u.pm * BM + wr * 64 + fr, col0 = u.pn * BM + wc * 32 + 4 * fq;
        const int r00 = u.pm * BM; const int w = r00 < T_LAT ? (r00 >> 12) : 8;
        f32x4 gv[2][2];
#pragma unroll
        for (int bj = 0; bj < 2; ++bj)
#pragma unroll
            for (int n = 0; n < 2; ++n) gv[bj][n] = *(const f32x4*)(gmod + (size_t)w * 6144 + col0 + bj * HALF + n * 16);
#pragma unroll
        for (int ai = 0; ai < 2; ++ai)
#pragma unroll
            for (int m = 0; m < 4; ++m) { float* rowp = X + (size_t)(row0 + ai * HALF + m * 16) * 1024 + col0;
#pragma unroll
                for (int bj = 0; bj < 2; ++bj)
#pragma unroll
                    for (int n = 0; n < 2; ++n) { f32x4* p = (f32x4*)(rowp + bj * HALF + n * 16); *p = *p + gv[bj][n] * acc[ai][bj][m][n]; } }
    }
};
}

struct Args { const float* in[51]; float* out; unsigned char* ws; int ph_lo, ph_hi; };
enum { I_X = 0, I_C, I_CTX, I_CCTX, I_ADAW, I_ADAB, I_N1G, I_N2G, I_WIN, I_HYCW, I_HYCB, I_HYW1, I_HYB1, I_HYF1, I_HYW2, I_HYB2, I_HYF2, I_HYW3, I_HYB3, I_HYBIAS,
       I_RWCW, I_RWCB, I_RWWUP, I_RWW0, I_RWAUP, I_RWA0, I_RWGUP, I_RWKK, I_RWKA, I_RWRK, I_RWLNG, I_RWLNB, I_S5ARE, I_S5AIM, I_S5LDT, I_S5BRE, I_S5BIM, I_S5CRE, I_S5CIM, I_S5D,
       I_S5GLUW, I_S5GLUB, I_WBR, I_WOUT, I_RTW, I_RTB, I_W1, I_B1, I_W2, I_B2, I_FING };

typedef const __attribute__((address_space(4))) Args* CArgsP;
__device__ __forceinline__ CArgsP kargs() { CArgsP p = (CArgsP)__builtin_amdgcn_kernarg_segment_ptr(); asm volatile("" : "+s"(p)); return p; }
__device__ __forceinline__ int opaque(int v) { asm volatile("" : "+s"(v)); return v; }
__device__ __forceinline__ int opaque_v(int v) { asm volatile("" : "+v"(v)); return v; }
struct Ctx { CArgsP a; LAS unsigned char* lds; int tid, lane, wave, bid, G; };

__device__ __forceinline__ void row_seq(int row, int& base, int& pos, int& n) {
    if (row < T_LAT) { base = row & ~(SEQ - 1); pos = row & (SEQ - 1); n = SEQ; }
    else { const int r = row - T_LAT; base = T_LAT + (r & ~(CTXL - 1)); pos = r & (CTXL - 1); n = CTXL; }
}
__device__ __forceinline__ float conv3z(const bf16* zc, int pos, int n, float w0, float w1, float w2, float b) {
    const float zm = pos > 0 ? bf2f(zc[(size_t)(pos - 1) * IN_COLS]) : 0.f, z0 = bf2f(zc[(size_t)pos * IN_COLS]), zp = pos < n - 1 ? bf2f(zc[(size_t)(pos + 1) * IN_COLS]) : 0.f;
    return zm * w0 + z0 * w1 + zp * w2 + b;
}

template <int MODE>
__device__ __forceinline__ void transpose_item(const float* W, int K, int N, bf16* WT, int Hs, LAS float* scr, int item, int lane) {
    const int nblk = N / 32, kb = item / nblk, nb = item % nblk, k0 = 64 * kb, n0 = 32 * nb;
    { f32x4 wv[8];
#pragma unroll
      for (int i = 0; i < 8; ++i) wv[i] = *(const f32x4*)(W + (size_t)(k0 + 8 * i + (lane >> 3)) * N + n0 + 4 * (lane & 7));
#pragma unroll
      for (int i = 0; i < 8; ++i) { LAS float* sp = scr + (8 * i + (lane >> 3)) * 33 + 4 * (lane & 7); sp[0] = wv[i][0]; sp[1] = wv[i][1]; sp[2] = wv[i][2]; sp[3] = wv[i][3]; } }
    LDS_WAIT(); asm volatile("" ::: "memory");
    const int c = lane & 7;
#pragma unroll
    for (int j = 0; j < 4; ++j) { const int n = (lane >> 3) + 8 * j; const LAS float* s = scr + (8 * c) * 33 + n;
        v4u o; o.x = pk2(s[0 * 33], s[1 * 33]); o.y = pk2(s[2 * 33], s[3 * 33]); o.z = pk2(s[4 * 33], s[5 * 33]); o.w = pk2(s[6 * 33], s[7 * 33]);
        int dr = n0 + n;
        if (MODE == 1) { const int nc = n0 + n; const int jx = nc < Hs ? nc : nc - Hs; dr = (jx >> 7) * 256 + (nc < Hs ? 0 : 128) + (jx & 127); }
        *(v4u*)(WT + (size_t)dr * K + k0 + 8 * c) = o; }
    LDS_WAIT(); asm volatile("" ::: "memory");
}

__device__ __forceinline__ void p0_prologue(const Ctx& F) {
    const auto& a = *F.a; unsigned char* ws = a.ws;
    const int gw = F.bid * NWAVES + F.wave, NGW = F.G * NWAVES, lane = F.lane;
    float* X = (float*)(ws + WS_X);
    for (int t = gw; t < SEQ; t += NGW) {
        const float pr = (float)(t >> 6), pc = (float)(t & 63);
        f32x4 pe[4];
#pragma unroll
        for (int j = 0; j < 4; ++j)
#pragma unroll
            for (int e = 0; e < 4; ++e) { const float om = __builtin_amdgcn_exp2f((float)(4 * lane + e) * (-13.287712379549449f / 256.0f)); const float ang = ((j < 2) ? pr : pc) * om; pe[j][e] = (j & 1) ? __cosf(ang) : __sinf(ang); }
#pragma unroll 2
        for (int bb = 0; bb < BATCH; ++bb) { const size_t row = (size_t)bb * SEQ + t;
            const f32x4* xi = (const f32x4*)(a.in[I_X] + row * D) + lane; f32x4* xo = (f32x4*)(X + row * D) + lane;
#pragma unroll
            for (int j = 0; j < 4; ++j) xo[64 * j] = xi[64 * j] + pe[j]; }
    }
    for (int row = T_LAT + gw; row < T_ALL; row += NGW) {
        const f32x4* xi = (const f32x4*)(a.in[I_CTX] + (size_t)(row - T_LAT) * D) + lane; f32x4* xo = (f32x4*)(X + (size_t)row * D) + lane;
#pragma unroll
        for (int j = 0; j < 4; ++j) xo[64 * j] = xi[64 * j];
    }
    {
        LAS float* condl = (LAS float*)F.lds; LAS float* psum = (LAS float*)(F.lds + 40960);
        for (int i = F.tid; i < 9 * 1024; i += NTHREADS) { const int w = i >> 10, k = i & 1023; const float cv = (w < 8) ? a.in[I_C][w * 1024 + k] : a.in[I_CCTX][k]; condl[i] = cv / (1.f + expf(-cv)); }
        __syncthreads();
        float* MOD = (float*)(ws + WS_MOD);
        for (int it = F.bid; it < 2 * 96; it += F.G) {
            const int l = it / 96, cg = it % 96, col = cg * 64 + lane;
            float acc[9];
#pragma unroll
            for (int w = 0; w < 9; ++w) acc[w] = 0.f;
            const float* wp = a.in[I_ADAW] + ((size_t)l * 1024 + F.wave * 128) * 6144 + col;
#pragma unroll 1
            for (int k0 = 0; k0 < 128; k0 += 16) { float wv[16];
#pragma unroll
                for (int k = 0; k < 16; ++k) wv[k] = wp[(size_t)(k0 + k) * 6144];
#pragma unroll
                for (int k = 0; k < 16; ++k)
#pragma unroll
                    for (int w = 0; w < 9; ++w) acc[w] += condl[w * 1024 + F.wave * 128 + k0 + k] * wv[k]; }
#pragma unroll
            for (int w = 0; w < 9; ++w) psum[(F.wave * 9 + w) * 64 + lane] = acc[w];
            __syncthreads();
            if (F.wave == 0) {
#pragma unroll
                for (int w = 0; w < 9; ++w) { float s = 0.f;
#pragma unroll
                    for (int wv = 0; wv < 8; ++wv) s += psum[(wv * 9 + w) * 64 + lane];
                    MOD[(size_t)(l * 9 + w) * 6144 + col] = s + a.in[I_ADAB][l * 6144 + col]; }
            }
            __syncthreads();
        }
    }
    {
        LAS float* scr = (LAS float*)(F.lds + F.wave * 16384);
        constexpr int IT_W1 = 16 * 64, IT_W2 = 16 * 32, IT_WIN = 16 * 216, IT_GLU = 8 * 32, IT_WBR = 8 * 32, IT_WOUT = 16 * 32;
        constexpr int N_W1 = 64 * IT_W1, N_W2 = 64 * IT_W2, N_WIN = 2 * IT_WIN, N_GLU = 2 * IT_GLU, N_WBR = 6 * IT_WBR, N_WOUT = 2 * IT_WOUT;
        constexpr int NITEMS = N_W1 + N_W2 + N_WIN + N_GLU + N_WBR + N_WOUT;
        for (int it = gw; it < NITEMS; it += NGW) {
            int r = it;
            if (r < N_W1) { const int mtx = r / IT_W1, l = mtx >> 5, e = mtx & 31; transpose_item<1>(a.in[I_W1] + (size_t)mtx * 1024 * 2048, 1024, 2048, (bf16*)(ws + WS_WTS + l * WL_STRIDE + WO_W1) + (size_t)e * 2048 * 1024, 1024, scr, r % IT_W1, lane); continue; } r -= N_W1;
            if (r < N_W2) { const int mtx = r / IT_W2, l = mtx >> 5, e = mtx & 31; transpose_item<0>(a.in[I_W2] + (size_t)mtx * 1024 * 1024, 1024, 1024, (bf16*)(ws + WS_WTS + l * WL_STRIDE + WO_W2) + (size_t)e * 1024 * 1024, 0, scr, r % IT_W2, lane); continue; } r -= N_W2;
            if (r < N_WIN) { const int l = r / IT_WIN; transpose_item<0>(a.in[I_WIN] + (size_t)l * 1024 * IN_COLS, 1024, IN_COLS, (bf16*)(ws + WS_WTS + l * WL_STRIDE + WO_WIN), 0, scr, r % IT_WIN, lane); continue; } r -= N_WIN;
            if (r < N_GLU) { const int l = r / IT_GLU; transpose_item<1>(a.in[I_S5GLUW] + (size_t)l * 512 * 1024, 512, 1024, (bf16*)(ws + WS_WTS + l * WL_STRIDE + WO_GLU), 512, scr, r % IT_GLU, lane); continue; } r -= N_GLU;
            if (r < N_WBR) { const int mtx = r / IT_WBR, l = mtx / 3, br = mtx % 3; transpose_item<0>(a.in[I_WBR] + (size_t)mtx * 512 * 1024, 512, 1024, (bf16*)(ws + WS_WTS + l * WL_STRIDE + WO_WBR) + (size_t)br * 1024 * 512, 0, scr, r % IT_WBR, lane); continue; } r -= N_WBR;
            { const int l = r / IT_WOUT; transpose_item<0>(a.in[I_WOUT] + (size_t)l * 1024 * 1024, 1024, 1024, (bf16*)(ws + WS_WTS + l * WL_STRIDE + WO_WOUT), 0, scr, r % IT_WOUT, lane); }
        }
        for (int i = F.bid * NTHREADS + F.tid; i < 2 * 2560 * 256; i += F.G * NTHREADS) {
            const int l = i / (2560 * 256), r = i % (2560 * 256), n = r >> 8, k = r & 255; float v = 0.f;
            if (n < 1024) { if (k < 64) v = a.in[I_RWWUP][(((size_t)l * 2 + (n >> 9)) * 64 + k) * 512 + (n & 511)]; }
            else if (n < 2048) { if (k >= 64 && k < 128) v = a.in[I_RWAUP][(((size_t)l * 2 + ((n - 1024) >> 9)) * 64 + (k - 64)) * 512 + (n & 511)]; }
            else { if (k >= 128) v = a.in[I_RWGUP][((size_t)l * 128 + (k - 128)) * 512 + (n - 2048)]; }
            ((bf16*)(ws + WS_WTS + l * WL_STRIDE + WO_RWCAT))[r] = (bf16)f2bf(v);
        }
    }
    __syncthreads();
    {
        LAS float* feats = (LAS float*)F.lds; LAS float* h1 = feats + 8 * 33; LAS float* h2 = h1 + 8 * 64;
        constexpr int NIT = 2 * (512 + 32);
        for (int it = F.bid; it < NIT; it += F.G) {
            const int l = it / 544, r = it % 544, nsel = r >= 512, n = nsel ? CTXL : SEQ, p0 = (nsel ? r - 512 : r) * 8;
            if (l == DEPTH - 1 && nsel) continue;
            if (F.tid < 8 * 33) { const int p = F.tid / 33, i = F.tid % 33, pos = p0 + p; float f;
                if (i == 0) f = (float)pos / (float)(n - 1);
                else { const int k = (i - 1) & 15; const float band = 1e-4f + (float)k * ((15.0f - 1e-4f) / 15.0f); const float ang = (6.283185307179586f * (float)pos / (float)n) * band; f = (i <= 16) ? cosf(ang) : -sinf(ang); }
                feats[p * 33 + i] = f; }
            __syncthreads();
            { const int p = F.tid >> 6, j = F.tid & 63; float s = a.in[I_HYB1][l * 64 + j]; const float* w1p = a.in[I_HYW1] + (size_t)l * 33 * 64 + j;
#pragma unroll
                for (int i = 0; i < 33; ++i) s += feats[p * 33 + i] * w1p[i * 64];
                h1[p * 64 + j] = sinf(a.in[I_HYF1][l * 64 + j] * s); }
            __syncthreads();
            { const int p = F.tid >> 6, j = F.tid & 63; float s = a.in[I_HYB2][l * 64 + j];
                const float* w2p = a.in[I_HYW2] + (size_t)l * 64 * 64 + j;
#pragma unroll 16
                for (int i = 0; i < 64; ++i) s += h1[p * 64 + i] * w2p[i * 64];
                h2[p * 64 + j] = sinf(a.in[I_HYF2][l * 64 + j] * s); }
            __syncthreads();
            float acc[4][8];
#pragma unroll
            for (int q = 0; q < 4; ++q)
#pragma unroll
                for (int p = 0; p < 8; ++p) acc[q][p] = 0.f;
            const float* w3 = a.in[I_HYW3] + (size_t)l * 64 * 2048 + F.tid;
#pragma unroll 8
            for (int i = 0; i < 64; ++i) { float wv[4];
#pragma unroll
                for (int q = 0; q < 4; ++q) wv[q] = w3[(size_t)i * 2048 + q * 512];
#pragma unroll
                for (int p = 0; p < 8; ++p) { const float hv = h2[p * 64 + i];
#pragma unroll
                    for (int q = 0; q < 4; ++q) acc[q][p] += hv * wv[q]; } }
            const int c = F.tid; const float dstart = logf(0.01f) / 1.5f, dstop = logf(0.01f) / 0.3f; const float delta = fabsf(dstart + (float)c * ((dstop - dstart) / 511.0f));
            const int RL = nsel ? HY_RLENC : HY_RLEN, off = n + 47; const float rn1 = 1.0f / (float)(n - 1);
            bf16* Rb = (bf16*)(ws + WS_GF + l * GF_STRIDE + (nsel ? GF_CTX : 0));
#pragma unroll
            for (int q = 0; q < 4; ++q) { const int o = q >> 1, side = q & 1; const float b3 = a.in[I_HYB3][l * 2048 + q * 512 + c];
                bf16* Rc = Rb + ((size_t)o * 512 + c) * RL;
#pragma unroll
                for (int p = 0; p < 8; ++p) { const int pos = p0 + p; const float t = (float)pos * rn1; const float val = (acc[q][p] + b3) * __expf(-t * delta);
                    if (side == 0) Rc[off - pos] = (bf16)f2bf(val);
                    else if (pos >= 1) Rc[off + pos] = (bf16)f2bf(val); }
                if (p0 == 0 && side == 0) { for (int m = 0; m < 48; ++m) Rc[m] = 0; for (int m = off + n; m < RL; ++m) Rc[m] = 0; } }
            __syncthreads();
        }
    }
}

__device__ __forceinline__ void stage_norm1(const Ctx& F, int l) {
    const auto& a = *F.a; unsigned char* ws = a.ws; const int lane = F.lane;
    const int gw = F.bid * NWAVES + F.wave, NGW = F.G * NWAVES;
    float* X = (float*)(ws + WS_X); bf16* H = (bf16*)(ws + WS_H); const float* MOD = (const float*)(ws + WS_MOD);
    const bf16* YS = (const bf16*)(ws + WS_XS); const int* POS = (const int*)(ws + WS_POS); const float* GATE = (const float*)(ws + WS_GATE);
    const int nrows = (l == DEPTH) ? T_LAT : T_ALL;
    f32x4 ngv[4];
    { const f32x4* ngp = (l == DEPTH) ? (const f32x4*)a.in[I_FING] + lane : (const f32x4*)(a.in[I_N1G] + l * D) + lane;
#pragma unroll
      for (int j = 0; j < 4; ++j) ngv[j] = ngp[64 * j]; }
    f32x4 vn[4]; v2u ysn[4][4]; int4 pnn = make_int4(0, 0, 0, 0); f32x4 gn = (f32x4){0.f, 0.f, 0.f, 0.f}, gnn = gn;
#pragma unroll
    for (int k = 0; k < 4; ++k)
#pragma unroll
        for (int j = 0; j < 4; ++j) ysn[k][j] = (v2u){0u, 0u};
#define N1_LDYS(p4_) do { const int pk_[4] = {(p4_).x, (p4_).y, (p4_).z, (p4_).w}; _Pragma("unroll") for (int k = 0; k < 4; ++k) { const v2u* yr_ = (const v2u*)(YS + (size_t)pk_[k] * D) + lane; \
        _Pragma("unroll") for (int j = 0; j < 4; ++j) ysn[k][j] = yr_[64 * j]; } } while (0)
    if (gw < nrows) {
#pragma unroll
        for (int j = 0; j < 4; ++j) vn[j] = ((const f32x4*)(X + (size_t)gw * D) + lane)[64 * j];
        if (l > 0) { const int4 p0 = *(const int4*)(POS + gw * 4); gn = *(const f32x4*)(GATE + gw * 4);
            if (gw + NGW < nrows) { pnn = *(const int4*)(POS + (gw + NGW) * 4); gnn = *(const f32x4*)(GATE + (gw + NGW) * 4); }
            N1_LDYS(p0); } }
#pragma unroll 1
    for (int row = gw; row < nrows; row += NGW) {
        const int w = row < T_LAT ? (row >> 12) : 8;
        f32x4* xr = (f32x4*)(X + (size_t)row * D) + lane;
        f32x4 v[4]; v2u ysc[4][4];
#pragma unroll
        for (int j = 0; j < 4; ++j) v[j] = vn[j];
#pragma unroll
        for (int k = 0; k < 4; ++k)
#pragma unroll
            for (int j = 0; j < 4; ++j) ysc[k][j] = ysn[k][j];
        const f32x4 gc = gn; const int4 pnx = pnn; gn = gnn;
        const int rn = row + NGW, rnn = row + 2 * NGW;
        if (rn < nrows) {
#pragma unroll
            for (int j = 0; j < 4; ++j) vn[j] = ((const f32x4*)(X + (size_t)rn * D) + lane)[64 * j];
            if (l > 0) N1_LDYS(pnx); }
        if (l > 0 && rnn < nrows) { pnn = *(const int4*)(POS + rnn * 4); gnn = *(const f32x4*)(GATE + rnn * 4); }
        f32x4 m0[4], m1[4], m2[4];
        if (l < DEPTH) {
#pragma unroll
            for (int j = 0; j < 4; ++j) { m0[j] = ((const f32x4*)(MOD + (size_t)(l * 9 + w) * 6144) + lane)[64 * j]; m1[j] = ((const f32x4*)(MOD + (size_t)(l * 9 + w) * 6144 + 1024) + lane)[64 * j]; } }
        if (l > 0) {
#pragma unroll
            for (int j = 0; j < 4; ++j) m2[j] = ((const f32x4*)(MOD + (size_t)((l - 1) * 9 + w) * 6144 + 5120) + lane)[64 * j];
            f32x4 mo[4];
#pragma unroll
            for (int j = 0; j < 4; ++j) mo[j] = (f32x4){0.f, 0.f, 0.f, 0.f};
#pragma unroll
            for (int k = 0; k < TOPK; ++k) { const float g = gc[k];
#pragma unroll
                for (int j = 0; j < 4; ++j) { const v2u y = ysc[k][j]; mo[j][0] += g * bflo(y.x); mo[j][1] += g * bfhi(y.x); mo[j][2] += g * bflo(y.y); mo[j][3] += g * bfhi(y.y); } }
#pragma unroll
            for (int j = 0; j < 4; ++j) { v[j] = v[j] + m2[j] * mo[j]; if (l < DEPTH) xr[64 * j] = v[j]; }
        }
        float ss = 0.f;
#pragma unroll
        for (int j = 0; j < 4; ++j) ss += (v[j][0] * v[j][0] + v[j][1] * v[j][1]) + (v[j][2] * v[j][2] + v[j][3] * v[j][3]);
        const float rstd = __builtin_amdgcn_rsqf(wave_sum(ss) * (1.f / D) + 1e-6f);
        if (l == DEPTH) {
            f32x4* o = (f32x4*)(a.out + (size_t)row * D) + lane;
#pragma unroll
            for (int j = 0; j < 4; ++j) o[64 * j] = v[j] * rstd * ngv[j];
        } else {
            v2u* ho = (v2u*)(H + (size_t)row * D) + lane;
#pragma unroll
            for (int j = 0; j < 4; ++j) { const f32x4 h = v[j] * rstd * ngv[j] * (m1[j] + 1.0f) + m0[j]; v2u o; o.x = pk2(h[0], h[1]); o.y = pk2(h[2], h[3]); ho[64 * j] = o; }
        }
    }
#undef N1_LDYS
}

__device__ __forceinline__ void stage_rw_prep1(const Ctx& F, int l) {
    const auto& a = *F.a; unsigned char* ws = a.ws;
    const bf16* __restrict__ Z = (const bf16*)(ws + WS_Z); bf16* __restrict__ ARW = (bf16*)(ws + WS_ARW);
    const int j = 4 * (F.tid & 63), col = 1536 + j, rq = F.tid >> 6;
    const float* cw = a.in[I_RWCW] + (size_t)l * 3 * 1792;
    const f32x4 w0 = *(const f32x4*)(cw + col), w1 = *(const f32x4*)(cw + 1792 + col), w2 = *(const f32x4*)(cw + 2 * 1792 + col), cb = *(const f32x4*)(a.in[I_RWCB] + l * 1792 + col);
#pragma unroll 4
    for (int row = F.bid * 8 + rq; row < T_ALL; row += F.G * 8) {
        int base, pos, n; row_seq(row, base, pos, n);
        const bf16* zc = Z + (size_t)row * IN_COLS + RW_OFF + col;
        const v2u z0 = *(const v2u*)zc;
        v2u zm = (v2u){0u, 0u}, zp = (v2u){0u, 0u};
        if (pos > 0) zm = *(const v2u*)(zc - IN_COLS);
        if (pos < n - 1) zp = *(const v2u*)(zc + IN_COLS);
        f32x4 v = (f32x4){bflo(zm.x), bfhi(zm.x), bflo(zm.y), bfhi(zm.y)} * w0 + (f32x4){bflo(z0.x), bfhi(z0.x), bflo(z0.y), bfhi(z0.y)} * w1 + (f32x4){bflo(zp.x), bfhi(zp.x), bflo(zp.y), bfhi(zp.y)} * w2 + cb;
#pragma unroll
        for (int e2 = 0; e2 < 4; ++e2) { if (j < 64) v[e2] = tanh_fast(v[e2]); else if (j >= 128) v[e2] = sigm(v[e2]); }
        v2u o; o.x = pk2(v[0], v[1]); o.y = pk2(v[2], v[3]);
        *(v2u*)(ARW + (size_t)row * 256 + j) = o;
    }
}

__device__ __forceinline__ void stage_rw_prep2(const Ctx& F, int l) {
    const auto& a = *F.a; unsigned char* ws = a.ws; const int lane = F.lane;
    const bf16* Z = (const bf16*)(ws + WS_Z); const bf16* P = (const bf16*)(ws + WS_P); bf16* SCN = (bf16*)(ws + WS_SCN);
    const int gw = F.bid * NWAVES + F.wave, NGW = F.G * NWAVES;
    constexpr int TR = 17, NRT = T_ALL / TR;
    const float* cw = a.in[I_RWCW] + (size_t)l * 3 * 1792; const float* cbp = a.in[I_RWCB] + l * 1792;
    for (int tile = gw; tile < NRT * 4; tile += NGW) {
        const int rt = tile % NRT, hp = tile / NRT, row0 = rt * TR, c0 = hp * 128 + 2 * lane;
        f32x2 w[3][3], cb[3];
#pragma unroll
        for (int s = 0; s < 3; ++s) { cb[s] = *(const f32x2*)(cbp + s * 512 + c0);
#pragma unroll
            for (int j = 0; j < 3; ++j) w[s][j] = *(const f32x2*)(cw + j * 1792 + s * 512 + c0); }
        const f32x2 KKw = *(const f32x2*)(a.in[I_RWKK] + l * 512 + c0), KAw = *(const f32x2*)(a.in[I_RWKA] + l * 512 + c0);
        f32x2 W0[2], A0[2];
#pragma unroll
        for (int d = 0; d < 2; ++d) { W0[d] = *(const f32x2*)(a.in[I_RWW0] + (l * 2 + d) * 512 + c0); A0[d] = *(const f32x2*)(a.in[I_RWA0] + (l * 2 + d) * 512 + c0); }
        const unsigned* zb = (const unsigned*)(Z + RW_OFF + c0);
        unsigned zw[8][3], pw_[8][4];
#define P2_LDZ(j_) do { const int rr_ = row0 + (j_); if (rr_ >= 0 && rr_ < T_ALL) { _Pragma("unroll") for (int s = 0; s < 3; ++s) zw[((j_) + 1) & 7][s] = zb[(size_t)rr_ * (IN_COLS / 2) + s * 256]; } \
        else { _Pragma("unroll") for (int s = 0; s < 3; ++s) zw[((j_) + 1) & 7][s] = 0u; } } while (0)
#define P2_LDP(j_) do { const unsigned* pr_ = (const unsigned*)(P + (size_t)(row0 + (j_)) * 2560 + c0); pw_[(j_) & 7][0] = pr_[0]; pw_[(j_) & 7][1] = pr_[512]; pw_[(j_) & 7][2] = pr_[256]; pw_[(j_) & 7][3] = pr_[768]; } while (0)
        P2_LDZ(-1); P2_LDZ(0); P2_LDZ(1); P2_LDZ(2); P2_LDZ(3); P2_LDP(0); P2_LDP(1); P2_LDP(2);
#pragma unroll
        for (int i = 0; i < TR; ++i) {
            const int row = row0 + i; int base, pos, n; row_seq(row, base, pos, n);
            if (i + 4 <= TR) P2_LDZ(i + 4);
            if (i + 3 < TR) P2_LDP(i + 3);
            unsigned zm[3], z0[3], zp[3], pc_[4];
#pragma unroll
            for (int s = 0; s < 3; ++s) { zm[s] = zw[i & 7][s]; z0[s] = zw[(i + 1) & 7][s]; zp[s] = zw[(i + 2) & 7][s]; }
#pragma unroll
            for (int e = 0; e < 4; ++e) pc_[e] = pw_[i & 7][e];
            const float mlo = pos > 0 ? 1.f : 0.f, mhi = pos < n - 1 ? 1.f : 0.f;
            f32x2 u[3];
#pragma unroll
            for (int s = 0; s < 3; ++s) u[s] = (f32x2){bflo(zm[s]), bfhi(zm[s])} * mlo * w[s][0] + (f32x2){bflo(z0[s]), bfhi(z0[s])} * w[s][1] + (f32x2){bflo(zp[s]), bfhi(zp[s])} * mhi * w[s][2] + cb[s];
            const f32x2 r = u[0], k = u[1], v = u[2];
            f32x2 kk = k * KKw;
            const float ss = red32(kk[0] * kk[0] + kk[1] * kk[1]);
            kk = kk * (__builtin_amdgcn_rsqf(fmaxf(ss, 1e-24f)));
            unsigned* o = (unsigned*)(SCN + (size_t)row * 9 * 512 + c0);
            o[0] = pk2(r[0], r[1]); o[256] = pk2(v[0], v[1]); o[2 * 256] = pk2(kk[0], kk[1]);
#pragma unroll
            for (int d = 0; d < 2; ++d) {
                const unsigned pw = pc_[2 * d], pa = pc_[2 * d + 1];
                float ld[2], kd[2], be[2];
#pragma unroll
                for (int e = 0; e < 2; ++e) {
                    const float uu = W0[d][e] + (e ? bfhi(pw) : bflo(pw));
                    ld[e] = -0.60653065971263342f * sigm(uu);
                    const float av = sigm(A0[d][e] + (e ? bfhi(pa) : bflo(pa)));
                    kd[e] = k[e] * (1.f + (av - 1.f) * KAw[e]); be[e] = kk[e] * av; }
                o[(3 + 3 * d) * 256] = pk2(ld[0], ld[1]); o[(4 + 3 * d) * 256] = pk2(kd[0], kd[1]); o[(5 + 3 * d) * 256] = pk2(be[0], be[1]);
            }
        }
    }
}
#undef P2_LDZ
#undef P2_LDP

__device__ __forceinline__ int seq_row(int b, int d, int sidx) {
    if (sidx < CTXL) { const int t = d ? (CTXL - 1 - sidx) : sidx; return T_LAT + b * CTXL + t; }
    const int tl = sidx - CTXL; const int t = d ? (SEQ - 1 - tl) : tl; return b * SEQ + t;
}

constexpr int CW_WORK = 16384;
constexpr int CW_STAMP = 20480;
#ifdef PROBE_T
#ifndef PROBE_BID
#define PROBE_BID 0
#endif
#define PT(k) do { if (F.bid == PROBE_BID && F.tid == 0 && l == 0) ((unsigned long long*)(F.a->ws + WS_CTL + CW_STAMP * 4))[k] = __builtin_amdgcn_s_memrealtime(); } while (0)
#else
#define PT(k) do { } while (0)
#endif
__device__ __forceinline__ void rw_scan_item(const Ctx& F, int l, int it2) {
    const int it = it2 >> 1, half = it2 & 1;
    const auto& a = *F.a; unsigned char* ws = a.ws; const int tid = F.tid, lane = F.lane;
    const bf16* SCN = (const bf16*)(ws + WS_SCN); float* YD = (float*)(ws + WS_YDIR);
    LAS float* sbuf = (LAS float*)F.lds;
    LAS float* ybuf = (LAS float*)(F.lds + 49152);
    const bool comp = F.wave < 4;
    const int lt = tid & 255, ls = lt >> 4, lj = lt & 15;
    const int vl = lane >> 3, kq = lane & 7, vrow = half * 32 + (F.wave & 3) * 8 + vl;
    constexpr int NCH = (CTXL + SEQ) / 16;
    const int d = it & 1, h = (it >> 1) & 7, b = it >> 4;
    f32x2 S[4];
#pragma unroll
    for (int q = 0; q < 4; ++q) S[q] = (f32x2){0.f, 0.f};
    v2u ldr[6];
#define RW_ISSUE(c) do { const int row_ = seq_row(b, d, (c) * 16 + ls); const v2u* p_ = (const v2u*)(SCN + (size_t)row_ * 9 * 512 + h * 64) + lj; \
        ldr[0] = p_[2 * 128]; ldr[1] = p_[(3 + 3 * d) * 128]; ldr[2] = p_[(5 + 3 * d) * 128]; ldr[3] = p_[(4 + 3 * d) * 128]; ldr[4] = p_[0]; ldr[5] = p_[128]; } while (0)
#define RW_WRITE(bufi) do { LAS float* o_ = sbuf + (((bufi) * 16 + ls) * 6) * 64 + 4 * lj; \
        *(LAS f32x4*)(o_) = (f32x4){-bflo(ldr[0].x), -bfhi(ldr[0].x), -bflo(ldr[0].y), -bfhi(ldr[0].y)}; \
        *(LAS f32x4*)(o_ + 64) = (f32x4){__expf(bflo(ldr[1].x)), __expf(bfhi(ldr[1].x)), __expf(bflo(ldr[1].y)), __expf(bfhi(ldr[1].y))}; \
        *(LAS f32x4*)(o_ + 128) = (f32x4){bflo(ldr[2].x), bfhi(ldr[2].x), bflo(ldr[2].y), bfhi(ldr[2].y)}; *(LAS f32x4*)(o_ + 192) = (f32x4){bflo(ldr[3].x), bfhi(ldr[3].x), bflo(ldr[3].y), bfhi(ldr[3].y)}; \
        *(LAS f32x4*)(o_ + 256) = (f32x4){bflo(ldr[4].x), bfhi(ldr[4].x), bflo(ldr[4].y), bfhi(ldr[4].y)}; *(LAS f32x4*)(o_ + 320) = (f32x4){bflo(ldr[5].x), bfhi(ldr[5].x), bflo(ldr[5].y), bfhi(ldr[5].y)}; } while (0)
#define RW_FLUSH(c) do { const int row_ = seq_row(b, d, (c) * 16 + ls); \
        *(f32x2*)(YD + ((size_t)d * T_ALL + row_) * 512 + h * 64 + half * 32 + 2 * lj) = *(const LAS f32x2*)(ybuf + ((((c) & 1) * 16 + ls) * 64) + half * 32 + 2 * lj); } while (0)
    if (!comp) { RW_ISSUE(0); RW_WRITE(0); RW_ISSUE(1); }
    __syncthreads();
#pragma unroll 1
    for (int c = 0; c < NCH; ++c) {
        const int bi = c & 1;
        if (!comp) {
            if (c + 1 < NCH) RW_WRITE(bi ^ 1);
            if (c + 2 < NCH) RW_ISSUE(c + 2);
            if (c > 0) RW_FLUSH(c - 1);
        } else {
        float yv[16];
        f32x4 opA[10], opB[10]; float vvA, vvB;
#define RW_LD(op, vvx, s_) do { const LAS float* sp_ = sbuf + ((bi * 16 + (s_)) * 6) * 64 + 8 * kq; \
            _Pragma("unroll") for (int q_ = 0; q_ < 5; ++q_) { op[2 * q_] = *(const LAS f32x4*)(sp_ + 64 * q_); op[2 * q_ + 1] = *(const LAS f32x4*)(sp_ + 64 * q_ + 4); } \
            vvx = sbuf[((bi * 16 + (s_)) * 6 + 5) * 64 + vrow]; } while (0)
#define RW_COMP(op, vvx, s_) do { \
            const f32x4 a0 = op[0], a1 = op[1], w0 = op[2], w1 = op[3], b0 = op[4], b1 = op[5], k0 = op[6], k1 = op[7], r0 = op[8], r1 = op[9]; \
            const f32x2 vv2 = (f32x2){vvx, vvx}; \
            const f32x2 p0 = S[1] * (f32x2){a0[2], a0[3]} + S[0] * (f32x2){a0[0], a0[1]}; \
            const f32x2 p1 = S[3] * (f32x2){a1[2], a1[3]} + S[2] * (f32x2){a1[0], a1[1]}; \
            const f32x2 t0 = S[0] * (f32x2){w0[0], w0[1]} + vv2 * (f32x2){k0[0], k0[1]}; \
            const f32x2 t1 = S[1] * (f32x2){w0[2], w0[3]} + vv2 * (f32x2){k0[2], k0[3]}; \
            const f32x2 t2 = S[2] * (f32x2){w1[0], w1[1]} + vv2 * (f32x2){k1[0], k1[1]}; \
            const f32x2 t3 = S[3] * (f32x2){w1[2], w1[3]} + vv2 * (f32x2){k1[2], k1[3]}; \
            const f32x2 ac = p0 + p1; \
            const float sa = red8(ac[0] + ac[1]); \
            const f32x2 sa2 = (f32x2){sa, sa}; \
            S[0] = sa2 * (f32x2){b0[0], b0[1]} + t0; S[1] = sa2 * (f32x2){b0[2], b0[3]} + t1; \
            S[2] = sa2 * (f32x2){b1[0], b1[1]} + t2; S[3] = sa2 * (f32x2){b1[2], b1[3]} + t3; \
            const f32x2 q0 = S[1] * (f32x2){r0[2], r0[3]} + S[0] * (f32x2){r0[0], r0[1]}; \
            const f32x2 q1 = S[3] * (f32x2){r1[2], r1[3]} + S[2] * (f32x2){r1[0], r1[1]}; \
            const f32x2 yc = q0 + q1; \
            yv[s_] = red8(yc[0] + yc[1]); } while (0)
        RW_LD(opA, vvA, 0);
#pragma unroll
        for (int s = 0; s < 16; s += 2) {
            RW_LD(opB, vvB, s + 1);
            __builtin_amdgcn_sched_barrier(0);
            RW_COMP(opA, vvA, s);
            __builtin_amdgcn_sched_barrier(0);
            if (s + 2 < 16) RW_LD(opA, vvA, s + 2);
            __builtin_amdgcn_sched_barrier(0);
            RW_COMP(opB, vvB, s + 1);
            __builtin_amdgcn_sched_barrier(0);
        }
#undef RW_LD
#undef RW_COMP
#pragma unroll
        for (int s = 0; s < 16; ++s) if ((s & 7) == kq) ybuf[((bi * 16 + s) * 64) + vrow] = yv[s];
        }
        __syncthreads();
    }
    if (!comp) RW_FLUSH(NCH - 1);
    __syncthreads();
#undef RW_ISSUE
#undef RW_WRITE
#undef RW_FLUSH
}

constexpr size_t WS_RWSCR = WS_YHY;
constexpr int RWS_QY = 0, RWS_YV = 2048, RWS_PZ = 4096, RWS_ZV = 12288, RWS_SLOT = 20480;
typedef __bf16 bf16x8n __attribute__((ext_vector_type(8)));
__device__ __forceinline__ f32x4 mma16(const bf16x8 a, const bf16x8 b, const f32x4 c) { return __builtin_amdgcn_mfma_f32_16x16x32_bf16(a, b, c, 0, 0, 0); }
__device__ __forceinline__ float dpp_shr(float x, const int n) {
    const int v = __builtin_bit_cast(int, x); int r;
    if (n == 1) r = __builtin_amdgcn_update_dpp(0, v, 0x111, 0xF, 0xF, true); else if (n == 2) r = __builtin_amdgcn_update_dpp(0, v, 0x112, 0xF, 0xF, true);
    else if (n == 4) r = __builtin_amdgcn_update_dpp(0, v, 0x114, 0xF, 0xF, true); else r = __builtin_amdgcn_update_dpp(0, v, 0x118, 0xF, 0xF, true);
    return __builtin_bit_cast(float, r);
}
__device__ __forceinline__ v4u pack8(const float (&x)[8]) { v4u o; o.x = pk2(x[0], x[1]); o.y = pk2(x[2], x[3]); o.z = pk2(x[4], x[5]); o.w = pk2(x[6], x[7]); return o; }
__device__ __forceinline__ void unpack8(const v4u u, float (&x)[8]) { x[0] = bflo(u.x); x[1] = bfhi(u.x); x[2] = bflo(u.y); x[3] = bfhi(u.y); x[4] = bflo(u.z); x[5] = bfhi(u.z); x[6] = bflo(u.w); x[7] = bfhi(u.w); }
constexpr int LDS_ZERO16 = 131072 + 3072;
typedef short bf16x4s __attribute__((ext_vector_type(4)));
__device__ __forceinline__ bf16x4s frag16k(const LAS bf16* m, int rowbase, int lane) { return __builtin_bit_cast(bf16x4s, *(const LAS v2u*)(m + (rowbase + (lane & 15)) * 16 + 4 * (lane >> 4))); }
__device__ __forceinline__ f32x4 mma16(const bf16x4s a, const bf16x4s b, const f32x4 c) { return __builtin_amdgcn_mfma_f32_16x16x16bf16_1k(a, b, c, 0, 0, 0); }
#define frag16(m_, rb_, ln_) frag16k(m_, rb_, ln_)
__device__ __forceinline__ void st_colmaj(LAS bf16* m, int colbase, const f32x4 d, int lane) {
    v2u o; o.x = pk2(d[0], d[1]); o.y = pk2(d[2], d[3]); *(LAS v2u*)(m + (colbase + (lane & 15)) * 16 + 4 * (lane >> 4)) = o; }
__device__ __forceinline__ void st_rowmaj(LAS bf16* m, const f32x4 d, int lane) {
#pragma unroll
    for (int r = 0; r < 4; ++r) m[(4 * (lane >> 4) + r) * 16 + (lane & 15)] = (bf16)f2bf(d[r]); }
template <int KS0, int KS1>
__device__ __forceinline__ void rw_chunk_load(const Ctx& F, int b, int h, int d, int cidx, v4u (&raw)[12]) {
    const int lane = opaque_v(F.lane), t = lane & 15, kg = lane >> 4;
    const bf16* base = (const bf16*)(F.a->ws + WS_SCN) + (size_t)seq_row(b, d, 16 * cidx + t) * 9 * 512 + h * 64;
#pragma unroll
    for (int ks = KS0; ks < KS1; ++ks) { const int off = 32 * ks + 8 * kg;
        raw[6 * ks + 0] = *(const v4u*)(base + (3 + 3 * d) * 512 + off); raw[6 * ks + 1] = *(const v4u*)(base + 2 * 512 + off); raw[6 * ks + 2] = *(const v4u*)(base + off);
        raw[6 * ks + 3] = *(const v4u*)(base + (5 + 3 * d) * 512 + off); raw[6 * ks + 4] = *(const v4u*)(base + (4 + 3 * d) * 512 + off); raw[6 * ks + 5] = *(const v4u*)(base + 512 + off); }
}
__device__ __forceinline__ void rw_chunk_task2(const Ctx& F, const v4u (&raw)[12], LAS unsigned char* wl, f32x4 (&yv)[4], f32x4 (&zv)[4][4]) {
    const int lane = opaque_v(F.lane), t = lane & 15, kg = lane >> 4;
    LAS bf16* ATt = (LAS bf16*)(wl); LAS bf16* RBr = (LAS bf16*)(wl + 2048); LAS bf16* BHt = (LAS bf16*)(wl + 4096); LAS bf16* KHt = (LAS bf16*)(wl + 6144); LAS bf16* VTt = (LAS bf16*)(wl + 8192);
    LAS bf16* WAt = (LAS bf16*)(wl + 10240); LAS bf16* N_r = (LAS bf16*)(wl + 12288); LAS bf16* N_c = (LAS bf16*)(wl + 12800); LAS bf16* T_r = (LAS bf16*)(wl + 13312);
    LAS bf16* AK_r = (LAS bf16*)(wl + 13824); LAS bf16* RB2 = (LAS bf16*)(wl + 14336); LAS bf16* RK_r = (LAS bf16*)(wl + 14848); LAS float* GCl = (LAS float*)(wl + 15360);
    bf16x8 fAb[2], fRb[2], fBb[2], fKb[2];
#pragma unroll
    for (int ks = 0; ks < 2; ++ks) {
        const int off = 32 * ks + 8 * kg;
        float ea[8], er[8], eb[8], eh[8];
        { const v4u uld = raw[6 * ks + 0]; float ld[8]; unpack8(uld, ld);
#pragma unroll
          for (int j = 0; j < 8; ++j) { float c = ld[j]; c += dpp_shr(c, 1); c += dpp_shr(c, 2); c += dpp_shr(c, 4); c += dpp_shr(c, 8);
              const float tot = __builtin_bit_cast(float, __builtin_amdgcn_ds_bpermute((lane | 15) << 2, __builtin_bit_cast(int, c)));
              ea[j] = __expf(c - ld[j]); er[j] = __expf(c); eb[j] = __expf(-c); const float et_ = __expf(tot); eh[j] = et_ * eb[j];
              if (t == 0) GCl[off + j] = et_; } }
        { const v4u u = raw[6 * ks + 1]; float x[8]; unpack8(u, x);
#pragma unroll
          for (int j = 0; j < 8; ++j) { x[j] = -x[j] * ea[j]; ATt[(off + j) * 16 + t] = (bf16)f2bf(x[j]); }
          const v4u p = pack8(x); fAb[ks] = __builtin_bit_cast(bf16x8, p); }
        { const v4u u = raw[6 * ks + 2]; float x[8]; unpack8(u, x);
#pragma unroll
          for (int j = 0; j < 8; ++j) x[j] = x[j] * er[j];
          const v4u p = pack8(x); fRb[ks] = __builtin_bit_cast(bf16x8, p); *(LAS v4u*)(RBr + t * 64 + off) = p; }
        { const v4u u = raw[6 * ks + 3]; float x[8], y[8]; unpack8(u, x);
#pragma unroll
          for (int j = 0; j < 8; ++j) { y[j] = x[j] * eb[j]; BHt[(off + j) * 16 + t] = (bf16)f2bf(x[j] * eh[j]); }
          const v4u p = pack8(y); fBb[ks] = __builtin_bit_cast(bf16x8, p); }
        { const v4u u = raw[6 * ks + 4]; float x[8], y[8]; unpack8(u, x);
#pragma unroll
          for (int j = 0; j < 8; ++j) { y[j] = x[j] * eb[j]; KHt[(off + j) * 16 + t] = (bf16)f2bf(x[j] * eh[j]); }
          const v4u p = pack8(y); fKb[ks] = __builtin_bit_cast(bf16x8, p); }
        { const v4u u = raw[6 * ks + 5];
          const bf16 e0 = (bf16)(u.x & 0xffff), e1 = (bf16)(u.x >> 16), e2 = (bf16)(u.y & 0xffff), e3 = (bf16)(u.y >> 16), e4 = (bf16)(u.z & 0xffff), e5 = (bf16)(u.z >> 16), e6 = (bf16)(u.w & 0xffff), e7 = (bf16)(u.w >> 16);
          VTt[(off + 0) * 16 + t] = e0; VTt[(off + 1) * 16 + t] = e1; VTt[(off + 2) * 16 + t] = e2; VTt[(off + 3) * 16 + t] = e3; VTt[(off + 4) * 16 + t] = e4; VTt[(off + 5) * 16 + t] = e5; VTt[(off + 6) * 16 + t] = e6; VTt[(off + 7) * 16 + t] = e7; }
        __builtin_amdgcn_sched_barrier(0);
    }
    asm volatile("" ::: "memory");
    const f32x4 z4 = (f32x4){0.f, 0.f, 0.f, 0.f};
    f32x4 n0 = mma16(fAb[1], fBb[1], mma16(fAb[0], fBb[0], z4)), aak = mma16(fAb[1], fKb[1], mma16(fAb[0], fKb[0], z4));
    f32x4 arb = mma16(fRb[1], fBb[1], mma16(fRb[0], fBb[0], z4)), ark = mma16(fRb[1], fKb[1], mma16(fRb[0], fKb[0], z4));
#pragma unroll
    for (int r = 0; r < 4; ++r) { const int tt = 4 * kg + r; if (!(t < tt)) { n0[r] = 0.f; aak[r] = 0.f; } if (!(t <= tt)) { arb[r] = 0.f; ark[r] = 0.f; } }
    st_rowmaj(AK_r, aak, lane); st_rowmaj(RB2, arb, lane); st_rowmaj(RK_r, ark, lane); asm volatile("" ::: "memory");
    f32x4 accT = n0;
#pragma unroll
    for (int r = 0; r < 4; ++r) accT[r] += (4 * kg + r == t) ? 1.f : 0.f;
    f32x4 nn = n0;
#pragma unroll
    for (int itn = 0; itn < 3; ++itn) {
        st_rowmaj(N_r, nn, lane); st_colmaj(N_c, 0, nn, lane); st_rowmaj(T_r, accT, lane); asm volatile("" ::: "memory");
        const auto fa = frag16(N_r, 0, lane), fb = frag16(N_c, 0, lane), ft = frag16(T_r, 0, lane);
        nn = mma16(fa, fb, z4); asm volatile("" ::: "memory");
        st_colmaj(N_c, 0, nn, lane); asm volatile("" ::: "memory");
        const auto fb2 = frag16(N_c, 0, lane);
        accT = mma16(ft, fb2, accT); asm volatile("" ::: "memory");
    }
    st_rowmaj(T_r, accT, lane); asm volatile("" ::: "memory");
    const auto fT = frag16(T_r, 0, lane), fAK = frag16(AK_r, 0, lane), fARB = frag16(RB2, 0, lane), fARK = frag16(RK_r, 0, lane);
#pragma unroll
    for (int kt = 0; kt < 4; ++kt) { const f32x4 dd = mma16(fT, frag16(ATt, 16 * kt, lane), z4); st_colmaj(WAt, 16 * kt, dd, lane); } asm volatile("" ::: "memory");
    f32x4 qy[4];
    { const auto fArbT = frag16(RB2, 0, lane);
#pragma unroll
      for (int kt = 0; kt < 4; ++kt) { const v2u ri = *(const LAS v2u*)(RBr + t * 64 + 16 * kt + 4 * kg);
          qy[kt] = mma16(frag16(WAt, 16 * kt, lane), fArbT, (f32x4){bflo(ri.x), bfhi(ri.x), bflo(ri.y), bfhi(ri.y)}); } }
    asm volatile("" ::: "memory");
#pragma unroll
    for (int vt = 0; vt < 4; ++vt) { const f32x4 dd = mma16(fAK, frag16(VTt, 16 * vt, lane), z4); st_colmaj(ATt, 16 * vt, dd, lane); } asm volatile("" ::: "memory");
    LAS bf16* UVt = RBr;
#pragma unroll
    for (int vt = 0; vt < 4; ++vt) { const f32x4 dd = mma16(fT, frag16(ATt, 16 * vt, lane), z4); st_colmaj(UVt, 16 * vt, dd, lane); } asm volatile("" ::: "memory");
#pragma unroll
    for (int vt = 0; vt < 4; ++vt) { const auto fU = frag16(UVt, 16 * vt, lane), fV = frag16(VTt, 16 * vt, lane);
        yv[vt] = mma16(fARK, fV, mma16(fARB, fU, z4));
#pragma unroll
        for (int ktp = 0; ktp < 4; ++ktp) zv[vt][ktp] = mma16(frag16(KHt, 16 * ktp, lane), fV, mma16(frag16(BHt, 16 * ktp, lane), fU, z4)); }
    f32x4 pz[4][4];
#pragma unroll
    for (int ktp = 0; ktp < 4; ++ktp) { const auto fBh = frag16(BHt, 16 * ktp, lane);
#pragma unroll
        for (int kt = 0; kt < 4; ++kt) { f32x4 dd = mma16(frag16(WAt, 16 * kt, lane), fBh, z4);
            if (kt == ktp) {
#pragma unroll
                for (int r = 0; r < 4; ++r) if (4 * kg + r == t) dd[r] += GCl[16 * kt + t]; }
            pz[ktp][kt] = dd; } }
    asm volatile("s_waitcnt lgkmcnt(0)" ::: "memory");
#pragma unroll
    for (int ktp = 0; ktp < 4; ++ktp) { LAS bf16* reg = (LAS bf16*)(wl + (ktp < 2 ? ktp * 2048 : (ktp + 1) * 2048));
#pragma unroll
        for (int kt = 0; kt < 4; ++kt) { v2u o; o.x = pk2(pz[ktp][kt][0], pz[ktp][kt][1]); o.y = pk2(pz[ktp][kt][2], pz[ktp][kt][3]); *(LAS v2u*)(reg + t * 64 + 16 * kt + 4 * kg) = o; } }
#pragma unroll
    for (int kt = 0; kt < 4; ++kt) { v2u o; o.x = pk2(qy[kt][0], qy[kt][1]); o.y = pk2(qy[kt][2], qy[kt][3]); *(LAS v2u*)(BHt + t * 64 + 16 * kt + 4 * kg) = o; }
    asm volatile("s_waitcnt lgkmcnt(0)" ::: "memory");
}
constexpr int RWZ_OFF = LDSCTL_OFF + 8192, RWF_OFF = LDSCTL_OFF + 2048;
__device__ __forceinline__ void rw_chunk_item2(const Ctx& F, int l, int it, size_t yoff = WS_YDIR) {
    const auto& a = *F.a; unsigned char* ws = a.ws; const int lane = opaque_v(F.lane), t = lane & 15, kg = lane >> 4;
    const int d = it & 1, h = (it >> 1) & 7, b = it >> 4;
    float* YD = (float*)(ws + yoff);
    LAS unsigned char* wl = F.lds + F.wave * 15616;
    LAS bf16* ZS = (LAS bf16*)(F.lds + RWZ_OFF);
    volatile LAS int* flag = (volatile LAS int*)(F.lds + RWF_OFF);
    for (int i = F.tid; i < 2048; i += NTHREADS) ((LAS unsigned*)ZS)[i] = 0u;
    if (F.tid == 0) *flag = 0;
    __syncthreads();
    constexpr int NCHK = (CTXL + SEQ) / 16;
    v4u raw[12];
    rw_chunk_load<0, 2>(F, b, h, d, F.wave, raw);
#pragma unroll 1
    for (int c = F.wave; c < NCHK; c += NWAVES) {
        f32x4 yv[4], zv[4][4];
        rw_chunk_task2(F, raw, wl, yv, zv);
        if (c + NWAVES < NCHK) rw_chunk_load<0, 2>(F, b, h, d, c + NWAVES, raw);
        while (*flag < c) __builtin_amdgcn_s_sleep(1);
        asm volatile("" ::: "memory");
        const LAS bf16* Zc = ZS + (c & 1) * 4096; LAS bf16* Zn = ZS + ((c + 1) & 1) * 4096;
        bf16x8 zb[4][2];
#pragma unroll
        for (int vb = 0; vb < 4; ++vb)
#pragma unroll
            for (int ks = 0; ks < 2; ++ks) zb[vb][ks] = *(const LAS bf16x8*)(Zc + (16 * vb + t) * 64 + 32 * ks + 8 * kg);
        { const LAS bf16* Qr = (const LAS bf16*)(wl + 4096); const bf16x8 q0 = *(const LAS bf16x8*)(Qr + t * 64 + 8 * kg), q1 = *(const LAS bf16x8*)(Qr + t * 64 + 32 + 8 * kg);
#pragma unroll
          for (int vb = 0; vb < 4; ++vb) { const f32x4 y = mma16(q1, zb[vb][1], mma16(q0, zb[vb][0], yv[vb]));
#pragma unroll
              for (int r = 0; r < 4; ++r) { const int row = seq_row(b, d, c * 16 + 4 * kg + r); YD[((size_t)d * T_ALL + row) * 512 + h * 64 + 16 * vb + t] = y[r]; } } }
#pragma unroll
        for (int ktp = 0; ktp < 4; ++ktp) { const LAS bf16* Pr = (const LAS bf16*)(wl + (ktp < 2 ? ktp * 2048 : (ktp + 1) * 2048));
            const bf16x8 p0 = *(const LAS bf16x8*)(Pr + t * 64 + 8 * kg), p1 = *(const LAS bf16x8*)(Pr + t * 64 + 32 + 8 * kg);
#pragma unroll
            for (int vb = 0; vb < 4; ++vb) { const f32x4 z = mma16(p1, zb[vb][1], mma16(p0, zb[vb][0], zv[vb][ktp]));
                v2u o; o.x = pk2(z[0], z[1]); o.y = pk2(z[2], z[3]); *(LAS v2u*)(Zn + (16 * vb + t) * 64 + 16 * ktp + 4 * kg) = o; } }
        asm volatile("s_waitcnt lgkmcnt(0)" ::: "memory");
        if (lane == 0) *flag = c + 1;
        asm volatile("s_waitcnt lgkmcnt(0)" ::: "memory");
    }
    __syncthreads();
}

__device__ __forceinline__ void stage_rw_readout(const Ctx& F, int l) {
    const auto& a = *F.a; unsigned char* ws = a.ws; const int lane = F.lane;
    const bf16* SCN = (const bf16*)(ws + WS_SCN); const bf16* P = (const bf16*)(ws + WS_P); const float* YD = (const float*)(ws + WS_YDIR); bf16* YRW = (bf16*)(ws + WS_YRW);
    const int gw = F.bid * NWAVES + F.wave, NGW = F.G * NWAVES;
    constexpr int TR = 17, NRT = T_ALL / TR;
    for (int tile = gw; tile < NRT * 4; tile += NGW) {
        const int rt = tile % NRT, hp = tile / NRT, row0 = rt * TR, c0 = hp * 128 + 2 * lane;
        const f32x2 rk = *(const f32x2*)(a.in[I_RWRK] + l * 512 + c0), lng = *(const f32x2*)(a.in[I_RWLNG] + l * 512 + c0), lnb = *(const f32x2*)(a.in[I_RWLNB] + l * 512 + c0);
        unsigned sw_[8][5]; f32x2 yw_[8][2];
#define RO_LD(j_) do { const int rr_ = row0 + (j_); const unsigned* sp_ = (const unsigned*)(SCN + (size_t)rr_ * 9 * 512 + c0); \
        sw_[(j_) & 7][0] = sp_[0]; sw_[(j_) & 7][1] = sp_[256]; sw_[(j_) & 7][2] = sp_[4 * 256]; sw_[(j_) & 7][3] = sp_[7 * 256]; sw_[(j_) & 7][4] = *(const unsigned*)(P + (size_t)rr_ * 2560 + 2048 + c0); \
        yw_[(j_) & 7][0] = *(const f32x2*)(YD + (size_t)rr_ * 512 + c0); yw_[(j_) & 7][1] = *(const f32x2*)(YD + ((size_t)T_ALL + rr_) * 512 + c0); } while (0)
        RO_LD(0); RO_LD(1); RO_LD(2);
#pragma unroll
        for (int i = 0; i < TR; ++i) {
            const int row = row0 + i;
            if (i + 3 < TR) RO_LD(i + 3);
            const unsigned ru = sw_[i & 7][0], vu = sw_[i & 7][1], k0u = sw_[i & 7][2], k1u = sw_[i & 7][3], gu = sw_[i & 7][4];
            const f32x2 y0 = yw_[i & 7][0], y1 = yw_[i & 7][1];
            const float bon = red32(bflo(ru) * (bflo(k0u) + bflo(k1u)) * rk[0] + bfhi(ru) * (bfhi(k0u) + bfhi(k1u)) * rk[1]);
            f32x2 y = y0 + y1 + (f32x2){bflo(vu), bfhi(vu)} * bon;
            const float mu = red32(y[0] + y[1]) * (1.f / 64.f);
            y = y - mu;
            const float var = red32(y[0] * y[0] + y[1] * y[1]) * (1.f / 64.f);
            const f32x2 yn = y * (__builtin_amdgcn_rsqf(var + 64e-5f));
            const f32x2 ov = (yn * lng + lnb) * (f32x2){bflo(gu), bfhi(gu)};
            *(unsigned*)(YRW + (size_t)row * 512 + c0) = pk2(ov[0], ov[1]);
        }
    }
}
#undef RO_LD

constexpr size_t WS_S5E = 6 * MiB;
constexpr int S5_NSEG = 4, S5_SEGLEN = (CTXL + SEQ) / S5_NSEG;
__device__ __forceinline__ void s5_disc(const float are, const float aim, const float dt, float& lbr, float& lbi, float& cr, float& ci) {
    const float mag = expf(are * dt); lbr = mag * cosf(aim * dt); lbi = mag * sinf(aim * dt);
    const float den = are * are + aim * aim, nr = lbr - 1.0f; cr = (nr * are + lbi * aim) / den; ci = (lbi * are - nr * aim) / den;
}
template <int PASS>
__device__ __forceinline__ void stage_s5_scan(const Ctx& F, int l, int item = -1) {
    const auto& a = *F.a; unsigned char* ws = a.ws; const int lane = F.lane;
    const bf16* Z = (const bf16*)(ws + WS_Z); bf16* YP = (bf16*)(ws + WS_YP); f32x2* S5E = (f32x2*)(ws + WS_S5E);
    LAS unsigned char* wl = F.lds + F.wave * 16384;
    LAS float* buL = (LAS float*)wl;
    LAS bf16* Hs = (LAS bf16*)(wl + 8704);
    const int fr = lane & 15, kg = lane >> 4;
    for (int itx = (item < 0 ? F.bid : item) * NWAVES + F.wave; itx < BATCH * 32 * 2 * S5_NSEG; itx += (item < 0 ? NWAVES * F.G : BATCH * 32 * 2 * S5_NSEG)) {
        const int seg = itx & (S5_NSEG - 1), it = itx >> 2;
        const int d = it & 1, g = (it >> 1) & 31, b = it >> 6, p = lane;
        const float dt = expf(a.in[I_S5LDT][(l * 2 + d) * 32 + g]);
        const float* arep = a.in[I_S5ARE] + ((size_t)(l * 2 + d) * 32 + g) * 64; const float* aimp = a.in[I_S5AIM] + ((size_t)(l * 2 + d) * 32 + g) * 64;
        float lbr, lbi, cr_, ci_; s5_disc(arep[p], aimp[p], dt, lbr, lbi, cr_, ci_);
        bf16x8 afr[2][4];
#pragma unroll
        for (int tl = 0; tl < 4; ++tl) { const int pp = 16 * tl + fr; float r0_, r1_, cr, ci; s5_disc(arep[pp], aimp[pp], dt, r0_, r1_, cr, ci);
            v4u pr = (v4u){0u, 0u, 0u, 0u}, pi = (v4u){0u, 0u, 0u, 0u};
            if (kg < 2) { const float* br = a.in[I_S5BRE] + (((size_t)l * 32 + g) * 64 + pp) * 16 + 8 * kg; const float* bi = a.in[I_S5BIM] + (((size_t)l * 32 + g) * 64 + pp) * 16 + 8 * kg;
                const f32x4 x0 = *(const f32x4*)br, x1 = *(const f32x4*)(br + 4), y0 = *(const f32x4*)bi, y1 = *(const f32x4*)(bi + 4);
                pr.x = pk2(cr * x0[0] - ci * y0[0], cr * x0[1] - ci * y0[1]); pr.y = pk2(cr * x0[2] - ci * y0[2], cr * x0[3] - ci * y0[3]);
                pr.z = pk2(cr * x1[0] - ci * y1[0], cr * x1[1] - ci * y1[1]); pr.w = pk2(cr * x1[2] - ci * y1[2], cr * x1[3] - ci * y1[3]);
                pi.x = pk2(cr * y0[0] + ci * x0[0], cr * y0[1] + ci * x0[1]); pi.y = pk2(cr * y0[2] + ci * x0[2], cr * y0[3] + ci * x0[3]);
                pi.z = pk2(cr * y1[0] + ci * x1[0], cr * y1[1] + ci * x1[1]); pi.w = pk2(cr * y1[2] + ci * x1[2], cr * y1[3] + ci * x1[3]); }
            afr[0][tl] = __builtin_bit_cast(bf16x8, pr); afr[1][tl] = __builtin_bit_cast(bf16x8, pi); }
        bf16x8 cf[4];
        f32x2 hst = (f32x2){0.f, 0.f};
        if (PASS == 1) {
#pragma unroll
            for (int kk = 0; kk < 4; ++kk) { const int p0 = 16 * kk + 4 * kg;
                const f32x4 c0 = *(const f32x4*)(a.in[I_S5CRE] + (((size_t)l * 32 + g) * 16 + fr) * 64 + p0), c1 = *(const f32x4*)(a.in[I_S5CIM] + (((size_t)l * 32 + g) * 16 + fr) * 64 + p0);
                v4u pk; pk.x = pk2(c0[0], -c1[0]); pk.y = pk2(c0[1], -c1[1]); pk.z = pk2(c0[2], -c1[2]); pk.w = pk2(c0[3], -c1[3]);
                cf[kk] = __builtin_bit_cast(bf16x8, pk); }
            float pr_ = lbr, pi_ = lbi, l64r = 1.f, l64i = 0.f;
#pragma unroll 1
            for (int q = 0; q < 10; ++q) { const float nr2 = pr_ * pr_ - pi_ * pi_, ni2 = 2.f * pr_ * pi_; pr_ = nr2; pi_ = ni2; if (q == 5) { l64r = pr_; l64i = pi_; } }
            const float lLr = pr_ * l64r - pi_ * l64i, lLi = pr_ * l64i + pi_ * l64r;
#pragma unroll 1
            for (int sgi = 0; sgi < seg; ++sgi) { const f32x2 ev = S5E[((size_t)it * S5_NSEG + sgi) * 64 + p];
                hst = (f32x2){lLr * hst[0] - lLi * hst[1] + ev[0], lLr * hst[1] + lLi * hst[0] + ev[1]}; }
        }
        const f32x2 lbr2 = (f32x2){lbr, lbr}, lbi2 = (f32x2){lbi, lbi};
        const int sbeg = seg * S5_SEGLEN, send = sbeg + S5_SEGLEN;
        v4u u0 = (v4u){0u, 0u, 0u, 0u}, u1 = u0, u2 = u0, u3 = u0;
#define S5_LOADU(dst_, s0_) do { const int sx_ = ((s0_) < send) ? (s0_) : (send - 16); const int row_ = seq_row(b, d, sx_ + fr); dst_ = *(const v4u*)(Z + (size_t)row_ * IN_COLS + S5_OFF + g * 16 + (kg & 1) * 8); } while (0)
#define S5_CHUNK(ux_, sc_) do { \
            { const v4u um_ = (kg < 2) ? ux_ : (v4u){0u, 0u, 0u, 0u}; const bf16x8 ufr = __builtin_bit_cast(bf16x8, um_); \
              _Pragma("unroll") for (int c = 0; c < 2; ++c) _Pragma("unroll") for (int tl = 0; tl < 4; ++tl) { \
                const f32x4 dd = __builtin_amdgcn_mfma_f32_16x16x32_bf16(afr[c][tl], ufr, (f32x4){0.f, 0.f, 0.f, 0.f}, 0, 0, 0); *(LAS f32x4*)(buL + (c * 16 + fr) * 68 + 16 * tl + 4 * kg) = dd; } } \
            S5_LOADU(ux_, (sc_) + 64); \
            LDS_WAIT(); asm volatile("" ::: "memory"); \
            f32x2 bu[16]; \
            _Pragma("unroll") for (int s = 0; s < 16; ++s) bu[s] = (f32x2){buL[s * 68 + p], buL[(16 + s) * 68 + p]}; \
            _Pragma("unroll") for (int s = 0; s < 16; ++s) { const float tr_ = __builtin_fmaf(-lbi, hst[1], bu[s][0]), ti_ = __builtin_fmaf(lbi, hst[0], bu[s][1]); \
                hst = (f32x2){__builtin_fmaf(lbr, hst[0], tr_), __builtin_fmaf(lbr, hst[1], ti_)}; \
                if (PASS == 1) *(LAS unsigned*)(Hs + s * 136 + 2 * p) = pg8::cvt_pk_bf16(hst[0], hst[1]); } \
            if (PASS == 1) { LDS_WAIT(); asm volatile("" ::: "memory"); \
                f32x4 acc = (f32x4){0.f, 0.f, 0.f, 0.f}; \
                _Pragma("unroll") for (int kk = 0; kk < 4; ++kk) { const bf16x8 af = *(const LAS bf16x8*)(Hs + fr * 136 + 32 * kk + 8 * kg); acc = __builtin_amdgcn_mfma_f32_16x16x32_bf16(af, cf[kk], acc, 0, 0, 0); } \
                { const int rowq_ = seq_row(b, d, (sc_) + 4 * kg); bf16* yq_ = YP + ((size_t)d * T_ALL + rowq_) * 512 + g * 16 + fr; const int st_ = d ? -512 : 512; \
                  _Pragma("unroll") for (int r = 0; r < 4; ++r) yq_[r * st_] = (bf16)f2bf(acc[r]); } } \
            LDS_WAIT(); asm volatile("" ::: "memory"); } while (0)
        S5_LOADU(u0, sbeg); S5_LOADU(u1, sbeg + 16); S5_LOADU(u2, sbeg + 32); S5_LOADU(u3, sbeg + 48);
#pragma unroll 1
        for (int s0 = sbeg; s0 < send; s0 += 64) { S5_CHUNK(u0, s0); S5_CHUNK(u1, s0 + 16); S5_CHUNK(u2, s0 + 32); S5_CHUNK(u3, s0 + 48); }
#undef S5_CHUNK
        if (PASS == 0) S5E[((size_t)it * S5_NSEG + seg) * 64 + p] = hst;
#undef S5_LOADU
    }
}

__device__ __forceinline__ void stage_s5_prep(const Ctx& F, int l, int nrows) {
    const auto& a = *F.a; unsigned char* ws = a.ws;
    const bf16* __restrict__ Z = (const bf16*)(ws + WS_Z); const bf16* __restrict__ YP = (const bf16*)(ws + WS_YP); bf16* __restrict__ AS5 = (bf16*)(ws + WS_AS5);
    const int c = 4 * (F.tid & 127), rq = F.tid >> 7;
    const f32x4 dsk = *(const f32x4*)(a.in[I_S5D] + l * 512 + c);
#pragma unroll 4
    for (int row = F.bid * 4 + rq; row < nrows; row += F.G * 4) {
        const v2u uz = *(const v2u*)(Z + (size_t)row * IN_COLS + S5_OFF + c);
        const v2u q0 = *(const v2u*)(YP + (size_t)row * 512 + c), q1 = *(const v2u*)(YP + ((size_t)T_ALL + row) * 512 + c);
        const f32x4 y0 = (f32x4){bflo(q0.x), bfhi(q0.x), bflo(q0.y), bfhi(q0.y)}, y1 = (f32x4){bflo(q1.x), bfhi(q1.x), bflo(q1.y), bfhi(q1.y)};
        const f32x4 u = (f32x4){bflo(uz.x), bfhi(uz.x), bflo(uz.y), bfhi(uz.y)};
        const f32x4 y = y0 + y1 + u * dsk;
        float ge[4];
#pragma unroll
        for (int j = 0; j < 4; ++j) ge[j] = 0.5f * y[j] * (1.f + tanh_fast(0.7978845608028654f * (y[j] + 0.044715f * y[j] * y[j] * y[j])));
        v2u o; o.x = pk2(ge[0], ge[1]); o.y = pk2(ge[2], ge[3]);
        *(v2u*)(AS5 + (size_t)row * 512 + c) = o;
    }
}

__device__ __forceinline__ void stage_hy_pre(const Ctx& F, int l, int nrows) {
    const auto& a = *F.a; unsigned char* ws = a.ws; const int lane = F.lane;
    const bf16* Z = (const bf16*)(ws + WS_Z); bf16* UT = (bf16*)(ws + WS_UT);
    LAS unsigned char* tl = F.lds + F.wave * 16384;
    const float* cw = a.in[I_HYCW] + (size_t)l * 3 * 1536; const float* cbp = a.in[I_HYCB] + l * 1536;
    const int gw = F.bid * NWAVES + F.wave, NGW = F.G * NWAVES;
    const int q = lane >> 3, k = lane & 7, ntile = (nrows / 64) * 24;
    v4u v[8], hv;
#define HYPRE_LOAD(tile_) do { const int rt_ = (tile_) / 24, ct_ = (tile_) % 24, row0_ = rt_ * 64; int base_, pos0_, n_; row_seq(row0_, base_, pos0_, n_); \
        const bf16* zt_ = Z + (size_t)row0_ * IN_COLS + HY_OFF + ct_ * 64 + 8 * k; hv = (v4u){0u, 0u, 0u, 0u}; \
        _Pragma("unroll") for (int i = 0; i < 8; ++i) v[i] = *(const v4u*)(zt_ + (size_t)(8 * i + q) * IN_COLS); \
        if (q == 0 && pos0_ > 0) hv = *(const v4u*)(zt_ - (size_t)IN_COLS); \
        if (q == 1 && pos0_ + 64 < n_) hv = *(const v4u*)(zt_ + (size_t)64 * IN_COLS); } while (0)
    if (gw < ntile) HYPRE_LOAD(gw);
#pragma unroll 1
    for (int tile = gw; tile < ntile; tile += NGW) {
        const int rt = tile / 24, ct = tile % 24, row0 = rt * 64, c0 = ct * 64;
        f32x4 wv[8];
#pragma unroll
        for (int i = 0; i < 8; ++i) { const int col = c0 + 8 * i + q; wv[i] = (f32x4){cw[col], cw[1536 + col], cw[2 * 1536 + col], cbp[col]}; }
#pragma unroll
        for (int i = 0; i < 8; ++i) { LAS unsigned* p = (LAS unsigned*)(tl + (1 + 8 * i + q) * 132 + 16 * k); p[0] = v[i].x; p[1] = v[i].y; p[2] = v[i].z; p[3] = v[i].w; }
        if (q < 2) { LAS unsigned* p = (LAS unsigned*)(tl + (q ? 65 : 0) * 132 + 16 * k); p[0] = hv.x; p[1] = hv.y; p[2] = hv.z; p[3] = hv.w; }
        if (tile + NGW < ntile) HYPRE_LOAD(tile + NGW);
        LDS_WAIT(); asm volatile("" ::: "memory");
#pragma unroll 2
        for (int i = 0; i < 8; ++i) {
            const int ch = 8 * i + q, col = c0 + ch;
            const LAS unsigned short* s = (const LAS unsigned short*)(tl + (8 * k) * 132 + ch * 2);
            float z[10];
#pragma unroll
            for (int t = 0; t < 10; ++t) z[t] = __builtin_bit_cast(float, (unsigned)s[t * 66] << 16);
            float o[8];
#pragma unroll
            for (int t = 0; t < 8; ++t) o[t] = wv[i][0] * z[t] + wv[i][1] * z[t + 1] + wv[i][2] * z[t + 2] + wv[i][3];
            v4u w; w.x = pk2(o[0], o[1]); w.y = pk2(o[2], o[3]); w.z = pk2(o[4], o[5]); w.w = pk2(o[6], o[7]);
            *(v4u*)(UT + (size_t)col * T_ALL + row0 + 8 * k) = w;
        }
        LDS_WAIT(); asm volatile("" ::: "memory");
    }
#undef HYPRE_LOAD
}
__device__ __forceinline__ void stage_hy_post(const Ctx& F, int l, int nrows) {
    const auto& a = *F.a; unsigned char* ws = a.ws; const int lane = F.lane;
    const bf16* YT = (const bf16*)(ws + WS_UT) + (size_t)1024 * T_ALL; bf16* YHY = (bf16*)(ws + WS_YHY);
    LAS unsigned char* tl = F.lds + F.wave * 16384;
    const int gw = F.bid * NWAVES + F.wave, NGW = F.G * NWAVES;
    const int q = lane >> 3, k = lane & 7, ntile = (nrows / 64) * 8;
    v4u v[8];
#define HYPOST_LOAD(tile_) do { const bf16* yp_ = YT + (size_t)(((tile_) & 7) * 64 + q) * T_ALL + ((tile_) >> 3) * 64 + 8 * k; \
        _Pragma("unroll") for (int i = 0; i < 8; ++i) v[i] = *(const v4u*)(yp_ + (size_t)(8 * i) * T_ALL); } while (0)
    if (gw < ntile) HYPOST_LOAD(gw);
#pragma unroll 1
    for (int tile = gw; tile < ntile; tile += NGW) {
        const int rt = tile >> 3, ct = tile & 7, row0 = rt * 64, c0 = ct * 64;
#pragma unroll
        for (int i = 0; i < 8; ++i) { LAS unsigned* p = (LAS unsigned*)(tl + (8 * i + q) * 132 + 16 * k); p[0] = v[i].x; p[1] = v[i].y; p[2] = v[i].z; p[3] = v[i].w; }
        if (tile + NGW < ntile) HYPOST_LOAD(tile + NGW);
        LDS_WAIT(); asm volatile("" ::: "memory");
#pragma unroll
        for (int i = 0; i < 8; ++i) { const int r = 8 * i + q;
            const LAS unsigned short* s = (const LAS unsigned short*)(tl + (8 * k) * 132 + r * 2);
            unsigned e[8];
#pragma unroll
            for (int j = 0; j < 8; ++j) e[j] = s[j * 66];
            v4u w; w.x = e[0] | (e[1] << 16); w.y = e[2] | (e[3] << 16); w.z = e[4] | (e[5] << 16); w.w = e[6] | (e[7] << 16);
            *(v4u*)(YHY + (size_t)(row0 + r) * 512 + c0 + 8 * k) = w; }
        LDS_WAIT(); asm volatile("" ::: "memory");
    }
#undef HYPOST_LOAD
}
typedef float f32x16 __attribute__((ext_vector_type(16)));
__device__ __forceinline__ void hyena_item(const Ctx& F, int l, int c, int isctx) {
    const auto& a = *F.a; unsigned char* ws = a.ws; const int tid = F.tid, lane = F.lane;
    const int n = isctx ? CTXL : SEQ, rowbase = isctx ? T_LAT : 0, RL = isctx ? HY_RLENC : HY_RLEN, off = n + 47;
    const bf16* UT = (const bf16*)(ws + WS_UT);
    const bf16* x1g = UT + (size_t)c * T_ALL + rowbase; const bf16* x2g = UT + (size_t)(512 + c) * T_ALL + rowbase; bf16* vg = (bf16*)UT + (size_t)(1024 + c) * T_ALL + rowbase;
    const bf16* Rg = (const bf16*)(ws + WS_GF + l * GF_STRIDE + (isctx ? GF_CTX : 0)) + (size_t)c * RL;
    LAS unsigned char* XB = F.lds; LAS unsigned char* R1 = F.lds + HY_R1_OFF; LAS unsigned char* R2 = F.lds + HY_R2_OFF;
    { const int cpb = n / 8;
      for (int q = tid; q < 8 * cpb; q += NTHREADS) { const int b = q / cpb, ch = q % cpb; *(LAS v4u*)(XB + b * HY_ROWB + 2 * HY_MARG + 16 * ch) = *(const v4u*)(vg + (size_t)b * n + 8 * ch); }
      if (tid < 256) { const int b = tid >> 5, side = (tid >> 4) & 1, ch = tid & 15; const unsigned zz = (unsigned)opaque_v(0); *(LAS v4u*)(XB + b * HY_ROWB + (side ? 2 * (HY_MARG + n) : 0) + 16 * ch) = (v4u){zz, zz, zz, zz}; }
      const int rch = RL / 8;
      for (int q = tid; q < rch; q += NTHREADS) { *(LAS v4u*)(R1 + 16 * q) = *(const v4u*)(Rg + 8 * q); *(LAS v4u*)(R2 + 16 * q) = *(const v4u*)(Rg + (size_t)512 * RL + 8 * q); } }
    __syncthreads();
    const int i = lane & 31, kg = lane >> 5, jb = lane & 3, bb = (lane & 31) >> 2;
    const int rsh = (off - i) & 7, rd = rsh >> 1; const bool s1 = rd & 1, s2 = rd & 2; const unsigned sh = (rsh & 1) ? 16u : 0u;
    const int aconst = 2 * (off - i + 8 * kg - rsh), bconst = bb * HY_ROWB + 2 * (HY_MARG + 32 * jb + 8 * kg);
    const int T0w = 512 * F.wave; const int ntile = (n - T0w) >= 512 ? 4 : ((n - T0w) > 0 ? (n - T0w) / 128 : 0);
    const float bias0 = a.in[I_HYBIAS][(l * 2 + 0) * 512 + c], bias1 = a.in[I_HYBIAS][(l * 2 + 1) * 512 + c];
    f32x16 acc[4];
    v2u y1p[4][4];
#define HY_AFRAG(wa, wb, afr) do { \
        const unsigned a0 = s1 ? wa.y : wa.x, a1 = s1 ? wa.z : wa.y, a2 = s1 ? wa.w : wa.z, a3 = s1 ? wb.x : wa.w, a4 = s1 ? wb.y : wb.x, a5 = s1 ? wb.z : wb.y, a6 = s1 ? wb.w : wb.z; \
        const unsigned b0 = s2 ? a2 : a0, b1 = s2 ? a3 : a1, b2 = s2 ? a4 : a2, b3 = s2 ? a5 : a3, b4 = s2 ? a6 : a4; \
        v4u af_; af_.x = __builtin_amdgcn_alignbit(b1, b0, sh); af_.y = __builtin_amdgcn_alignbit(b2, b1, sh); af_.z = __builtin_amdgcn_alignbit(b3, b2, sh); af_.w = __builtin_amdgcn_alignbit(b4, b3, sh); \
        afr = __builtin_bit_cast(bf16x8, af_); } while (0)
#define HY_STEP_COND(RB, d) do { \
        const v4u wa = *(const LAS v4u*)((RB) + aconst - 2 * (d)), wb = *(const LAS v4u*)((RB) + aconst - 2 * (d) + 16); bf16x8 afr; HY_AFRAG(wa, wb, afr); \
        _Pragma("unroll") for (int m = 0; m < 4; ++m) { const int T0 = T0w + 128 * m; \
            if (m < ntile && (d) >= T0 - n + 16 && (d) <= T0 + 96) { const bf16x8 bfr = *(const LAS bf16x8*)(XB + bconst + 2 * (T0 - (d))); \
                acc[m] = __builtin_amdgcn_mfma_f32_32x32x16_bf16(afr, bfr, acc[m], 0, 0, 0); } } } while (0)
#define HY_LOAD(RB, d, wa, wb, bq) do { wa = *(const LAS v4u*)((RB) + aconst - 2 * (d)); wb = *(const LAS v4u*)((RB) + aconst - 2 * (d) + 16); \
        _Pragma("unroll") for (int m = 0; m < 4; ++m) bq[m] = *(const LAS bf16x8*)(XB + bconst + 2 * (T0w + 128 * m - (d))); } while (0)
#define HY_MMA(wa, wb, bq) do { bf16x8 afr; HY_AFRAG(wa, wb, afr); \
        _Pragma("unroll") for (int m = 0; m < 4; ++m) acc[m] = __builtin_amdgcn_mfma_f32_32x32x16_bf16(afr, bq[m], acc[m], 0, 0, 0); } while (0)
#define HY_CONV(RB) do { \
        _Pragma("unroll") for (int m = 0; m < 4; ++m) _Pragma("unroll") for (int e = 0; e < 16; ++e) acc[m][e] = 0.f; \
        if (ntile == 4) { \
            const int dA = T0w - n + 16, dB = T0w + 384 - n + 16, dC = T0w + 96, dD = T0w + 384 + 96;     \
            _Pragma("unroll 1") for (int d = dA; d < dB; d += 16) HY_STEP_COND(RB, d); \
            { v4u waA, wbA, waB, wbB; bf16x8 bqA[4], bqB[4]; \
              HY_LOAD(RB, dB, waA, wbA, bqA); \
              _Pragma("unroll 1") for (int d = dB; d <= dC; d += 32) { \
                  if (d + 16 <= dC) HY_LOAD(RB, d + 16, waB, wbB, bqB); \
                  __builtin_amdgcn_sched_barrier(0); \
                  HY_MMA(waA, wbA, bqA); \
                  __builtin_amdgcn_sched_barrier(0); \
                  if (d + 32 <= dC) HY_LOAD(RB, d + 32, waA, wbA, bqA); \
                  __builtin_amdgcn_sched_barrier(0); \
                  if (d + 16 <= dC) HY_MMA(waB, wbB, bqB); \
                  __builtin_amdgcn_sched_barrier(0); } } \
            _Pragma("unroll 1") for (int d = dC + 16; d <= dD; d += 16) HY_STEP_COND(RB, d); \
        } else if (ntile > 0) { const int dhi = T0w + 128 * (ntile - 1) + 96; \
            _Pragma("unroll 1") for (int d = T0w - n + 16; d <= dhi; d += 16) HY_STEP_COND(RB, d); } } while (0)
    HY_CONV(R1);
#pragma unroll
    for (int m = 0; m < 4; ++m) if (m < ntile) {
#pragma unroll
        for (int rg = 0; rg < 4; ++rg) { const int t4 = T0w + 128 * m + 32 * jb + 8 * rg + 4 * kg;
            const v2u xv = *(const v2u*)(x1g + (size_t)bb * n + t4); const v2u vv = *(const LAS v2u*)(XB + bb * HY_ROWB + 2 * (HY_MARG + t4));
            const float y0 = bflo(xv.x) * (acc[m][4 * rg + 0] + bias0 * bflo(vv.x)), y1 = bfhi(xv.x) * (acc[m][4 * rg + 1] + bias0 * bfhi(vv.x));
            const float y2 = bflo(xv.y) * (acc[m][4 * rg + 2] + bias0 * bflo(vv.y)), y3 = bfhi(xv.y) * (acc[m][4 * rg + 3] + bias0 * bfhi(vv.y));
            y1p[m][rg].x = pk2(y0, y1); y1p[m][rg].y = pk2(y2, y3); } }
    __syncthreads();
#pragma unroll
    for (int m = 0; m < 4; ++m) if (m < ntile) {
#pragma unroll
        for (int rg = 0; rg < 4; ++rg) { const int t4 = T0w + 128 * m + 32 * jb + 8 * rg + 4 * kg; *(LAS v2u*)(XB + bb * HY_ROWB + 2 * (HY_MARG + t4)) = y1p[m][rg]; } }
    __syncthreads();
    HY_CONV(R2);
#pragma unroll
    for (int m = 0; m < 4; ++m) if (m < ntile) {
#pragma unroll
        for (int rg = 0; rg < 4; ++rg) { const int t4 = T0w + 128 * m + 32 * jb + 8 * rg + 4 * kg;
            const v2u xv = *(const v2u*)(x2g + (size_t)bb * n + t4); const v2u yv = y1p[m][rg];
            const float o0 = bflo(xv.x) * (acc[m][4 * rg + 0] + bias1 * bflo(yv.x)), o1 = bfhi(xv.x) * (acc[m][4 * rg + 1] + bias1 * bfhi(yv.x));
            const float o2 = bflo(xv.y) * (acc[m][4 * rg + 2] + bias1 * bflo(yv.y)), o3 = bfhi(xv.y) * (acc[m][4 * rg + 3] + bias1 * bfhi(yv.y));
            v2u ov; ov.x = pk2(o0, o1); ov.y = pk2(o2, o3); *(v2u*)(vg + (size_t)bb * n + t4) = ov; } }
    __syncthreads();
#undef HY_CONV
#undef HY_AFRAG
#undef HY_STEP_COND
#undef HY_LOAD
#undef HY_MMA
}
__device__ __forceinline__ void stage_mixer(const Ctx& F, int l) {
    unsigned* ctr = (unsigned*)(F.a->ws + WS_CTL) + CW_WORK + 64 * l;
    LAS int* itb = (LAS int*)(F.lds + LDSCTL_OFF + 512);
    constexpr int NS5 = BATCH * 32 * 2 * S5_NSEG / NWAVES;
    const int nit = 128 + NS5 + 512 + (l == 0 ? 512 : 0);
#ifdef PROBE_STATIC
    return;
#endif
    for (;;) {
        if (F.tid == 0) *itb = (int)__hip_atomic_fetch_add(ctr, 1u, __ATOMIC_RELAXED, __HIP_MEMORY_SCOPE_AGENT);
        __syncthreads();
        const int it = *itb;
        __syncthreads();
        if (it >= nit) break;
        Ctx Fi; Fi.a = kargs(); Fi.tid = opaque_v((int)threadIdx.x); Fi.lane = Fi.tid & 63; Fi.wave = __builtin_amdgcn_readfirstlane(Fi.tid >> 6); Fi.bid = opaque((int)blockIdx.x); Fi.G = opaque((int)gridDim.x);
        Fi.lds = (LAS unsigned char*)((LAS unsigned char*)0 + opaque(0)) + (F.lds - (LAS unsigned char*)0);
#ifdef PROBE_T
        if (l == 0 && F.tid == 0 && it == 5) ((unsigned long long*)(F.a->ws + WS_CTL + CW_STAMP * 4))[21] = __builtin_amdgcn_s_memrealtime();
        if (l == 0 && F.tid == 0 && it == 300) ((unsigned long long*)(F.a->ws + WS_CTL + CW_STAMP * 4))[23] = __builtin_amdgcn_s_memrealtime();
#endif
        if (it < 128) { for (int rep = 0; rep < ((DUPK == 9) ? 2 : 1); ++rep) rw_chunk_item2(Fi, opaque(l), it); }
        else if (it < 128 + NS5) stage_s5_scan<1>(Fi, opaque(l), it - 128);
        else if (it < 640 + NS5) hyena_item(Fi, opaque(l), it - 128 - NS5, 0);
        else hyena_item(Fi, opaque(l), it - 640 - NS5, 1);
#ifdef PROBE_T
        if (l == 0 && F.tid == 0 && it == 5) ((unsigned long long*)(F.a->ws + WS_CTL + CW_STAMP * 4))[22] = __builtin_amdgcn_s_memrealtime();
        if (l == 0 && F.tid == 0 && it == 300) ((unsigned long long*)(F.a->ws + WS_CTL + CW_STAMP * 4))[24] = __builtin_amdgcn_s_memrealtime();
#endif
    }
}

typedef float f32x16r __attribute__((ext_vector_type(16)));
__device__ __forceinline__ void stage_norm2_router(const Ctx& F, int l, int nrows) {
    const auto& a = *F.a; unsigned char* ws = a.ws; const int lane = F.lane;
    const float* X = (const float*)(ws + WS_X); bf16* H = (bf16*)(ws + WS_H); const float* MOD = (const float*)(ws + WS_MOD);
    int* EIDX = (int*)(ws + WS_EIDX); float* GATE = (float*)(ws + WS_GATE); int* POS = (int*)(ws + WS_POS); unsigned* ROWOF = (unsigned*)(ws + WS_ROWOF);
    LAS int* lex = (LAS int*)(F.lds + 40960); LAS int* lrk = lex + 2048; LAS int* offl = lrk + 2048;
    LAS float* lg = (LAS float*)(F.lds + F.wave * 4352);
    LAS int* hist = (LAS int*)(F.lds + LDSCTL_OFF + 1024);
    if (F.tid < 32) hist[F.tid] = 0;
    __syncthreads();
    const int rpb = (nrows + F.G - 1) / F.G, r0 = F.bid * rpb, r1 = (r0 + rpb < nrows) ? r0 + rpb : nrows;
    const float* rw = a.in[I_RTW] + (size_t)l * 1024 * 32;
    const int i = lane & 31, kk = lane >> 5;
    const f32x4* ng = (const f32x4*)(a.in[I_N2G] + l * D) + kk;
    for (int rb = r0 + F.wave * 32; rb < r1; rb += NWAVES * 32) {
        const int nrow = (r1 - rb) < 32 ? (r1 - rb) : 32; const bool live = i < nrow;
        const int row = live ? rb + i : r1 - 1; const int w = row < T_LAT ? (row >> 12) : 8;
        const f32x4* xr = (const f32x4*)(X + (size_t)row * D) + kk;
        float ss = 0.f;
#pragma unroll 16
        for (int q = 0; q < 128; ++q) { const f32x4 v = xr[2 * q]; ss += (v[0] * v[0] + v[1] * v[1]) + (v[2] * v[2] + v[3] * v[3]); }
        ss += __builtin_bit_cast(float, __builtin_amdgcn_ds_bpermute((lane ^ 32) << 2, __builtin_bit_cast(int, ss)));
        const float rstd = __builtin_amdgcn_rsqf(ss * (1.f / D) + 1e-6f);
        const f32x4* sh = (const f32x4*)(MOD + (size_t)(l * 9 + w) * 6144 + 3072) + kk; const f32x4* sc = (const f32x4*)(MOD + (size_t)(l * 9 + w) * 6144 + 4096) + kk;
        v2u* ho = (v2u*)(H + (size_t)row * D) + kk;
        f32x16r acc;
#pragma unroll
        for (int e = 0; e < 16; ++e) acc[e] = 0.f;
        const float* wp = rw + (size_t)(4 * kk) * 32 + i;
        f32x4 xn[4], gn_[4], cn_[4], sn_[4], wn_[4];
#define RT_LOAD(q0_) do { _Pragma("unroll") for (int u_ = 0; u_ < 4; ++u_) { const int q_ = (q0_) + u_; xn[u_] = xr[2 * q_]; gn_[u_] = ng[2 * q_]; cn_[u_] = sc[2 * q_]; sn_[u_] = sh[2 * q_]; \
            wn_[u_] = (f32x4){wp[(size_t)(8 * q_) * 32], wp[(size_t)(8 * q_ + 1) * 32], wp[(size_t)(8 * q_ + 2) * 32], wp[(size_t)(8 * q_ + 3) * 32]}; } } while (0)
        RT_LOAD(0);
#pragma unroll 1
        for (int q0 = 0; q0 < 128; q0 += 4) {
            f32x4 xc[4], gc_[4], cc_[4], sc_[4], wc_[4];
#pragma unroll
            for (int u = 0; u < 4; ++u) { xc[u] = xn[u]; gc_[u] = gn_[u]; cc_[u] = cn_[u]; sc_[u] = sn_[u]; wc_[u] = wn_[u]; }
            if (q0 + 4 < 128) RT_LOAD(q0 + 4);
#pragma unroll
            for (int u = 0; u < 4; ++u) { const int q = q0 + u;
                const f32x4 h4 = xc[u] * rstd * gc_[u] * (cc_[u] + 1.0f) + sc_[u];
                if (live) { v2u o; o.x = pk2(h4[0], h4[1]); o.y = pk2(h4[2], h4[3]); ho[2 * q] = o; }
                acc = __builtin_amdgcn_mfma_f32_32x32x2f32(h4[0], wc_[u][0], acc, 0, 0, 0);
                acc = __builtin_amdgcn_mfma_f32_32x32x2f32(h4[1], wc_[u][1], acc, 0, 0, 0);
                acc = __builtin_amdgcn_mfma_f32_32x32x2f32(h4[2], wc_[u][2], acc, 0, 0, 0);
                acc = __builtin_amdgcn_mfma_f32_32x32x2f32(h4[3], wc_[u][3], acc, 0, 0, 0); }
        }
#undef RT_LOAD
        const float rbias = a.in[I_RTB][l * 32 + i];
#pragma unroll
        for (int r = 0; r < 16; ++r) { const int ri = (r & 3) + 8 * (r >> 2) + 4 * kk; lg[ri * 33 + i] = acc[r] + rbias; }
        LDS_WAIT(); asm volatile("" ::: "memory");
        if (lane < nrow) {
            LAS float* lr = lg + lane * 33; const int orow = rb + lane;
            float tv[4]; int ti[4];
#pragma unroll
            for (int r = 0; r < 4; ++r) { float bv = -INFINITY; int bi = 0;
#pragma unroll 8
                for (int e = 0; e < 32; ++e) { const float v = lr[e]; if (v > bv) { bv = v; bi = e; } }
                tv[r] = bv; ti[r] = bi; lr[bi] = -INFINITY; }
            const float e1 = expf(tv[1] - tv[0]), e2 = expf(tv[2] - tv[0]), e3 = expf(tv[3] - tv[0]); const float inv = 1.0f / (1.0f + e1 + e2 + e3);
            *(int4*)(EIDX + orow * 4) = make_int4(ti[0], ti[1], ti[2], ti[3]); *(f32x4*)(GATE + orow * 4) = (f32x4){inv, e1 * inv, e2 * inv, e3 * inv};
#pragma unroll
            for (int r = 0; r < 4; ++r) { const int rk = __hip_atomic_fetch_add(&hist[ti[r]], 1, __ATOMIC_RELAXED, __HIP_MEMORY_SCOPE_WORKGROUP); lex[(orow - r0) * 4 + r] = ti[r]; lrk[(orow - r0) * 4 + r] = rk; }
        }
        LDS_WAIT(); asm volatile("" ::: "memory");
    }
    __syncthreads();
    if (F.tid < 32) { const int c = hist[F.tid]; offl[F.tid] = c ? (int)__hip_atomic_fetch_add((unsigned*)(ws + WS_CTL) + CW_CNT + 64 * l + F.tid, (unsigned)c, __ATOMIC_RELAXED, __HIP_MEMORY_SCOPE_AGENT) : 0; }
    __syncthreads();
    for (int i = F.tid; i < (r1 > r0 ? (r1 - r0) * 4 : 0); i += NTHREADS) { const int e = lex[i], pos = offl[e] + lrk[i];
        POS[r0 * 4 + i] = pos; ROWOF[(size_t)e * pg8::MOE_CAP + pos] = (unsigned)(r0 + (i >> 2)) * (unsigned)(D * 2); }
    __syncthreads();
}

__device__ __forceinline__ LAS int* load_moe_base(const Ctx& F, int l) {
    LAS int* base = (LAS int*)(F.lds + LDSCTL_OFF + 256);
    if (F.tid < 32) base[64 + F.tid] = (int)__hip_atomic_load((unsigned*)(F.a->ws + WS_CTL) + CW_CNT + 64 * l + F.tid, __ATOMIC_RELAXED, __HIP_MEMORY_SCOPE_AGENT);
    __syncthreads();
    if (F.tid == 0) { int acc = 0; for (int e = 0; e < 32; ++e) { base[e] = acc; acc += (base[64 + e] + 255) & ~255; } base[32] = acc; }
    __syncthreads();
    return base;
}
__device__ __forceinline__ void moe_fix_pos(const Ctx& F, int nrows, const LAS int* base) {
    unsigned char* ws = F.a->ws; const int* EIDX = (const int*)(ws + WS_EIDX); int* POS = (int*)(ws + WS_POS);
    const int rpb = (nrows + F.G - 1) / F.G, r0 = F.bid * rpb, r1 = (r0 + rpb < nrows) ? r0 + rpb : nrows;
    for (int i = F.tid; i < (r1 > r0 ? (r1 - r0) * 4 : 0); i += NTHREADS) POS[r0 * 4 + i] += base[EIDX[r0 * 4 + i]];
}

constexpr int NSTAGE_L = 13, NSTAGES = 1 + DEPTH * NSTAGE_L + 1;
__global__ void __launch_bounds__(NTHREADS, 2) mk_fwd(Args args) {
    extern __shared__ __attribute__((aligned(16))) unsigned char lds_raw[];
    Ctx F; F.a = kargs(); F.lds = (LAS unsigned char*)lds_raw; F.tid = threadIdx.x; F.lane = F.tid & 63; F.wave = __builtin_amdgcn_readfirstlane(F.tid >> 6); F.bid = blockIdx.x; F.G = gridDim.x;
    volatile LAS unsigned* MISC = (volatile LAS unsigned*)(F.lds + LDSCTL_OFF);
    for (int u = F.tid; u < (LDS_BYTES - LDSCTL_OFF) / 4; u += NTHREADS) ((LAS unsigned*)(F.lds + LDSCTL_OFF))[u] = 0u;
    __syncthreads();
#if MK_PER_STAGE
#define GRID_BAR() do { } while (0)
#else
    (void)xcd_barrier_post((unsigned*)(F.a->ws + WS_CTL) + CW_BAR, MISC + 8);
#define GRID_BAR() do { XcdBarrier b_; b_.bar = (unsigned*)(kargs()->ws + WS_CTL) + CW_BAR; b_.x = xb_xcc_id(); b_.st = (volatile LAS unsigned*)((LAS unsigned char*)lds_raw + LDSCTL_OFF + opaque(32)); xcd_barrier(b_); } while (0)
#endif
#ifndef ONLY_S
#define ONLY_S -1
#endif
#define STG_SEL(k) (ONLY_S < 0 || ONLY_S == (((k) == 0) ? 0 : ((k) == NSTAGES - 1 ? 14 : (((k) - 1) % NSTAGE_L) + 1)))
#if MK_PER_STAGE
#define IN(k) (STG_SEL(k) && kargs()->ph_lo == (k))
#else
#define IN(k) STG_SEL(k)
#endif
#if MK_PER_STAGE
#define SEAM(k) do { } while (0)
#else
#define SEAM(k) do { if ((k) + 1 < NSTAGES) GRID_BAR(); } while (0)
#endif
#define STAGE(k) if (IN(k)) { F.a = kargs(); F.tid = opaque_v((int)threadIdx.x); F.lane = F.tid & 63; F.wave = __builtin_amdgcn_readfirstlane(F.tid >> 6); F.bid = opaque((int)blockIdx.x); F.G = opaque((int)gridDim.x); F.lds = (LAS unsigned char*)lds_raw + opaque(0); unsigned char* ws = F.a->ws; const int l = opaque(lq); unsigned char* wl = ws + WS_WTS + (size_t)l * WL_STRIDE; (void)wl; (void)ws;
#define STAGE_END(k) } SEAM(k);
    int lq = 0;
    STAGE(0) p0_prologue(F); STAGE_END(0)
    for (lq = 0; lq < DEPTH; ++lq) {
        const int sb = 1 + lq * NSTAGE_L;
        const int nrl = opaque((lq == DEPTH - 1) ? T_LAT : T_ALL);
        STAGE(sb + 0) stage_norm1(F, l); STAGE_END(sb + 0)
        STAGE(sb + 1) pg8::SchedWin S; S.A = (const char*)(ws + WS_H); S.Bt = (const char*)(wl + WO_WIN); S.tstep = (size_t)256 * 1024 * 2; S.G = F.G; S.c = F.bid; S.part = (nrl != T_ALL); pg8::EpiBf16 E{(bf16*)(ws + WS_Z), IN_COLS, nullptr, 0};
            pg8::gemm_phase(F.lds, F.tid, 1024, S, E); STAGE_END(sb + 1)
        STAGE(sb + 2) for (int rep = 0; rep < REPN(1); ++rep) stage_rw_prep1(F, l); for (int rep = 0; rep < REPN(2); ++rep) stage_s5_scan<0>(F, l); for (int rep = 0; rep < REPN(3); ++rep) stage_hy_pre(F, l, nrl); STAGE_END(sb + 2)
        STAGE(sb + 3) { pg8::SchedP S; S.A = (const char*)(ws + WS_ARW); S.Bt = (const char*)(wl + WO_RWCAT); S.tstep = (size_t)256 * 256 * 2; S.nM = T_ALL / 256; S.G = F.G; S.c = F.bid; pg8::EpiBf16 E{(bf16*)(ws + WS_P), 2560, nullptr, 0}; pg8::gemm_phase(F.lds, F.tid, 256, S, E, 2); }
            F.tid = opaque_v((int)threadIdx.x); F.lane = F.tid & 63;
            STAGE_END(sb + 3)
        STAGE(sb + 4) for (int rep = 0; rep < REPN(5); ++rep) stage_rw_prep2(F, l); STAGE_END(sb + 4)
        STAGE(sb + 5) PT(10); stage_mixer(F, l); PT(11); STAGE_END(sb + 5) STAGE(sb + 5) PT(12); }
        STAGE(sb + 6) stage_s5_prep(F, l, nrl); STAGE_END(sb + 6)
        STAGE(sb + 7) { pg8::SchedStatic S; S.init(ws + WS_AS5, wl + WO_GLU, nrl, 1024, 512, F.G, F.bid); pg8::EpiGlu<0> E{(bf16*)(ws + WS_YS5), 512, F.a->in[I_S5GLUB] + l * 1024, 0, 512}; PT(13); pg8::gemm_phase(F.lds, F.tid, 512, S, E); PT(14); }
            for (int rep = 0; rep < REPN(7); ++rep) stage_rw_readout(F, l); for (int rep = 0; rep < REPN(8); ++rep) stage_hy_post(F, l, nrl); STAGE_END(sb + 7)
        STAGE(sb + 8) pg8::SchedMerge S; S.A0 = (const char*)(ws + WS_YHY); S.A1 = (const char*)(ws + WS_YRW); S.A2 = (const char*)(ws + WS_YS5); S.Bt = (const char*)(wl + WO_WBR); S.tstep = (size_t)256 * 512 * 2; S.bstride = (size_t)1024 * 512 * 2;
            S.nM = nrl / 256; S.nN = 4; S.G = F.G; S.c = F.bid;
            pg8::EpiMerge E{(bf16*)(ws + WS_MTMP), (bf16*)(ws + WS_H), (const bf16*)(ws + WS_Z) + GATE_OFF}; pg8::gemm_phase(F.lds, F.tid, 512, S, E); STAGE_END(sb + 8)
        STAGE(sb + 9) pg8::SchedStatic S; S.init(ws + WS_H, wl + WO_WOUT, nrl, 1024, 1024, F.G, F.bid); pg8::EpiResid E{(float*)(ws + WS_X), (const float*)(ws + WS_MOD) + (size_t)l * 9 * 6144 + 2048};
            pg8::gemm_phase(F.lds, F.tid, 1024, S, E); STAGE_END(sb + 9)
        STAGE(sb + 10) PT(17); stage_norm2_router(F, l, nrl); PT(18); STAGE_END(sb + 10)
        STAGE(sb + 11) LAS int* base = load_moe_base(F, l); moe_fix_pos(F, nrl, base);
            pg8::SchedMoeG S; S.A = (const char*)(ws + WS_H); S.rowof = (const unsigned*)(ws + WS_ROWOF); S.Bt = (const char*)(wl + WO_W1); S.tstep = (size_t)256 * 1024 * 2; S.estride = (size_t)2048 * 1024 * 2; S.NPN = 8; S.G = F.G; S.c = F.bid; S.base = base;
            pg8::EpiGlu<1> E{(bf16*)(ws + WS_ACT), 1024, F.a->in[I_B1] + (size_t)l * 32 * 2048, 2048, 1024}; pg8::gemm_phase(F.lds, F.tid, 1024, S, E); STAGE_END(sb + 11)
        STAGE(sb + 12) LAS int* base = load_moe_base(F, l);
            pg8::SchedMoe S; S.A = (const char*)(ws + WS_ACT); S.Bt = (const char*)(wl + WO_W2); S.tstep = (size_t)256 * 1024 * 2; S.estride = (size_t)1024 * 1024 * 2; S.NPN = 4; S.G = F.G; S.c = F.bid; S.base = base;
            pg8::EpiBf16 E{(bf16*)(ws + WS_XS), 1024, F.a->in[I_B2] + (size_t)l * 32 * 1024, 1024}; pg8::gemm_phase(F.lds, F.tid, 1024, S, E); STAGE_END(sb + 12)
    }
    lq = DEPTH;
    STAGE(NSTAGES - 1)
#ifndef PROBE_T
        stage_norm1(F, l);
#endif
#ifdef PROBE_T
        { const unsigned long long* st = (const unsigned long long*)(F.a->ws + WS_CTL + CW_STAMP * 4); const float cval = (float)(long long)(st[PROBE_B] - st[PROBE_A]) * (1.0f / (100.0f * PROBE_DIV));
          __syncthreads(); for (size_t i = (size_t)F.bid * NTHREADS + F.tid; i < (size_t)T_LAT * D; i += (size_t)F.G * NTHREADS) F.a->out[i] = cval; }
#endif
    }
#undef IN
#undef SEAM
}

extern "C" void kernel_launch(void* const* d_in, const int* in_sizes, int n_in, void* d_out, int out_size, void* d_ws, size_t ws_size, hipStream_t stream) {
    static int grid = 0;
    if (grid == 0) {
        if (n_in != 51 || out_size != T_LAT * D || ws_size < WS_END) { fprintf(stderr, "kernel_launch: unexpected shapes (n_in %d out %d ws %zu, need %zu)\n", n_in, out_size, ws_size, (size_t)WS_END); grid = -1; return; }
        int dev = 0, cus = 0, per_cu = 0;
        if (hipGetDevice(&dev) != hipSuccess || hipDeviceGetAttribute(&cus, hipDeviceAttributeMultiprocessorCount, dev) != hipSuccess) { grid = -1; return; }
        if (hipFuncSetAttribute((const void*)mk_fwd, hipFuncAttributeMaxDynamicSharedMemorySize, LDS_BYTES) != hipSuccess) { fprintf(stderr, "kernel_launch: hipFuncSetAttribute failed\n"); grid = -1; return; }
        if (hipOccupancyMaxActiveBlocksPerMultiprocessor(&per_cu, (const void*)mk_fwd, NTHREADS, LDS_BYTES) != hipSuccess || per_cu < 1) fprintf(stderr, "kernel_launch: occupancy query says %d\n", per_cu);
        (void)hipGetLastError();
        grid = cus;
    }
    if (grid < 0) return;
    if (hipMemsetAsync((char*)d_ws + WS_CTL, 0, CTL_ZERO_BYTES, stream) != hipSuccess) return;
    Args a{};
    for (int i = 0; i < 51; ++i) a.in[i] = (const float*)d_in[i];
    a.out = (float*)d_out; a.ws = (unsigned char*)d_ws;
#if MK_PER_STAGE
    for (int s = 0; s < NSTAGES; ++s) { a.ph_lo = s; a.ph_hi = s + 1; int reps = 1;
#ifdef PROBE_SET
        { const int ls = (s == 0 || s == NSTAGES - 1) ? -1 : (s - 1) % NSTAGE_L;
          if (PROBE_SET >= 1 && PROBE_SET <= 13 && ls == PROBE_SET - 1 && ls != 5 && ls != 8 && !(ls == 0 && s > 1)) reps = 3;
          if (PROBE_SET == 14 && s == 0) reps = 3; }
#endif
        for (int r = 0; r < reps; ++r) hipLaunchKernelGGL(mk_fwd, dim3(grid), dim3(NTHREADS), LDS_BYTES, stream, a); }
#else
    a.ph_lo = 0; a.ph_hi = NSTAGES; hipLaunchKernelGGL(mk_fwd, dim3(grid), dim3(NTHREADS), LDS_BYTES, stream, a);
#endif
}
```

```cpp
#include <hip/hip_runtime.h>
#include <cstdio>
#include <cstdint>

#ifndef DUPK
#define DUPK 0
#endif
#define REPN(k) ((DUPK == (k)) ? 3 : 1)
#ifndef REP_GEMM
#define REP_GEMM 1
#endif
#ifndef REP_LIGHT
#define REP_LIGHT 1
#endif
#ifndef REP_PRO
#define REP_PRO 1
#endif
#ifndef MK_PER_STAGE
#define MK_PER_STAGE 0
#endif

#define GAS __attribute__((address_space(1)))
#define LAS __attribute__((address_space(3)))
typedef unsigned short bf16;
typedef unsigned v4u __attribute__((ext_vector_type(4)));
typedef unsigned v2u __attribute__((ext_vector_type(2)));
typedef float f32x4 __attribute__((ext_vector_type(4)));
typedef float f32x2 __attribute__((ext_vector_type(2)));
typedef short bf16x8 __attribute__((ext_vector_type(8)));

constexpr int D = 1024, BATCH = 8, SEQ = 4096, CTXL = 256, DEPTH = 2;
constexpr int T_LAT = BATCH * SEQ, T_CTX = BATCH * CTXL, T_ALL = T_LAT + T_CTX;
constexpr int IN_COLS = 6912, HY_OFF = 0, RW_OFF = 1536, S5_OFF = 3328, GATE_OFF = 3840;
constexpr int NE = 32, TOPK = 4;
constexpr int MAXSLOT = 147456;
constexpr int NWAVES = 8, NTHREADS = 512;
constexpr int HY_MARG = 128, HY_ROWB = 8720, HY_RLEN = 8272, HY_RLENC = 592;
constexpr int HY_R1_OFF = 8 * HY_ROWB, HY_R2_OFF = HY_R1_OFF + HY_RLEN * 2;

constexpr size_t MiB = 1ull << 20;
constexpr size_t WS_CTL = 0, CTL_ZERO_BYTES = 1 * MiB;
constexpr size_t WS_MOD = 1 * MiB;
constexpr size_t WS_BLKCNT = 2 * MiB;
constexpr size_t WS_META = 2 * MiB + 512 * 1024;
constexpr size_t WS_ROWOF = 480 * MiB;
constexpr int CW_CNT = 24576;
constexpr size_t WS_EIDX = 3 * MiB, WS_GATE = 4 * MiB, WS_POS = 5 * MiB;
constexpr size_t WS_WTS = 8 * MiB, WL_STRIDE = 214 * MiB;
constexpr size_t WO_WIN = 0, WO_RWCAT = 14 * MiB, WO_GLU = 16 * MiB, WO_WBR = 17 * MiB, WO_WOUT = 20 * MiB, WO_W1 = 22 * MiB, WO_W2 = 150 * MiB;
constexpr size_t WS_GF = 436 * MiB, GF_STRIDE = 20 * MiB, GF_CTX = 17 * MiB;
constexpr size_t WS_X = 504 * MiB;
constexpr size_t WS_H = 640 * MiB;
constexpr size_t WS_BIG = 708 * MiB;
constexpr size_t WS_Z = WS_BIG;
constexpr size_t WS_SCN = 1167 * MiB;
constexpr size_t WS_MTMP = WS_SCN;
constexpr size_t WS_P = 1473 * MiB;
constexpr size_t WS_ARW = 1643 * MiB;
constexpr size_t WS_YDIR = 1660 * MiB;
constexpr size_t WS_YP = 1898 * MiB;
constexpr size_t WS_UT = 1796 * MiB;
constexpr size_t WS_AS5 = 2000 * MiB;
constexpr size_t WS_YHY = 1898 * MiB, WS_YRW = 1932 * MiB, WS_YS5 = 1966 * MiB;
constexpr size_t WS_XS = WS_BIG;
constexpr size_t WS_ACT = WS_BIG + 288 * MiB;
constexpr size_t WS_END = 2034 * MiB;
constexpr int CW_BAR = 4096;

constexpr int RING_BYTES = 131072;
constexpr int LDSCTL_OFF = RING_BYTES;
constexpr int LDS_BYTES = 163840;

typedef __bf16 bf16x2_t __attribute__((ext_vector_type(2)));
__device__ __forceinline__ unsigned pk2(float lo, float hi) { const bf16x2_t v = __builtin_convertvector((f32x2){lo, hi}, bf16x2_t); return __builtin_bit_cast(unsigned, v); }
__device__ __forceinline__ unsigned f2bf(float f) { return pk2(f, 0.f) & 0xffffu; }
__device__ __forceinline__ float bf2f(bf16 b) { return __builtin_bit_cast(float, ((unsigned)b) << 16); }
__device__ __forceinline__ float bflo(unsigned w) { return __builtin_bit_cast(float, w << 16); }
__device__ __forceinline__ float bfhi(unsigned w) { return __builtin_bit_cast(float, w & 0xffff0000u); }
__device__ __forceinline__ float sigm(float x) { return __builtin_amdgcn_rcpf(1.f + __expf(-x)); }
__device__ __forceinline__ float tanh_fast(float x) { const float e = __expf(2.f * x); return 1.f - 2.f * __builtin_amdgcn_rcpf(e + 1.f); }
#define LDS_WAIT() asm volatile("s_waitcnt lgkmcnt(0)" ::: "memory")
__device__ __forceinline__ float dpp_f(float x, const int ctrl_sel) {
    const int v = __builtin_bit_cast(int, x);
    int r;
    if (ctrl_sel == 0) r = __builtin_amdgcn_update_dpp(0, v, 0xB1, 0xF, 0xF, true);
    else if (ctrl_sel == 1) r = __builtin_amdgcn_update_dpp(0, v, 0x4E, 0xF, 0xF, true);
    else r = __builtin_amdgcn_update_dpp(0, v, 0x141, 0xF, 0xF, true);
    return __builtin_bit_cast(float, r);
}
__device__ __forceinline__ float red32(float x) {
    x += dpp_f(x, 0); x += dpp_f(x, 1); x += dpp_f(x, 2);
    x += __builtin_bit_cast(float, __builtin_amdgcn_update_dpp(0, __builtin_bit_cast(int, x), 0x128, 0xF, 0xF, true));
    x += __builtin_bit_cast(float, __builtin_amdgcn_ds_swizzle(__builtin_bit_cast(int, x), 0x401F));
    return x;
}
__device__ __forceinline__ float wave_sum(float v) {
    v = red32(v);
    return __builtin_bit_cast(float, __builtin_amdgcn_readlane(__builtin_bit_cast(int, v), 0)) + __builtin_bit_cast(float, __builtin_amdgcn_readlane(__builtin_bit_cast(int, v), 32));
}
__device__ __forceinline__ int xch32(int v, const int step) {
    if (step == 0) return __builtin_amdgcn_update_dpp(0, v, 0xB1, 0xF, 0xF, true);
    if (step == 1) return __builtin_amdgcn_update_dpp(0, v, 0x4E, 0xF, 0xF, true);
    if (step == 2) return __builtin_amdgcn_update_dpp(0, v, 0x141, 0xF, 0xF, true);
    if (step == 3) return __builtin_amdgcn_update_dpp(0, v, 0x128, 0xF, 0xF, true);
    return __builtin_amdgcn_ds_swizzle(v, 0x401F);
}
__device__ __forceinline__ float red8(float x) { x += dpp_f(x, 0); x += dpp_f(x, 1); x += dpp_f(x, 2); return x; }

#define XB_TMO      128
#define XB_XCNT(j)  (256  + 64 * (j))
#define XB_XSUB(j)  (1280 + 64 * (j))
#define XB_XGEN(j)  (2304 + 64 * (j))
#define XB_TOP      3328
#define XB_TOPGEN   3392
#define XCD_BAR_WORDS 3456
#define XB_SPIN_CAP (1u << 22)
__device__ __forceinline__ unsigned xb_ld(unsigned* p)              { return __hip_atomic_load(p, __ATOMIC_RELAXED, __HIP_MEMORY_SCOPE_AGENT); }
__device__ __forceinline__ unsigned xb_add(unsigned* p, unsigned v) { return __hip_atomic_fetch_add(p, v, __ATOMIC_RELAXED, __HIP_MEMORY_SCOPE_AGENT); }
__device__ __forceinline__ unsigned xb_xcc_id() { return (unsigned)__builtin_amdgcn_s_getreg((3 << 11) | 20) & 0xFu; }
#define XB_SPIN(cond, bar) do { unsigned _sp = 0; while (cond) { __builtin_amdgcn_s_sleep(1); \
    if ((++_sp & 255u) == 0u) { if (xb_ld(&(bar)[XB_TMO])) break; if (_sp > XB_SPIN_CAP) { atomicAdd(&(bar)[XB_TMO], 1u); break; } } } } while (0)
struct XcdBarrier { unsigned* bar; unsigned x; volatile LAS unsigned* st; };
__device__ __forceinline__ XcdBarrier xcd_barrier_post(unsigned* bar, volatile LAS unsigned* st) {
    XcdBarrier b; b.bar = bar; b.x = xb_xcc_id(); b.st = st;
    if (threadIdx.x == 0) (void)xb_add(&bar[XB_XCNT(b.x)], 1u);
    return b;
}
__device__ __forceinline__ void xcd_barrier_complete(unsigned* bar, unsigned x, unsigned& nloc, unsigned& nx) {
    const unsigned G = gridDim.x * gridDim.y * gridDim.z;
    unsigned sum, cnt, mine, sp = 0u;
    for (;;) {
        sum = 0u; cnt = 0u; mine = 0u;
#pragma unroll
        for (unsigned j = 0; j < 16; ++j) { const unsigned c = xb_ld(&bar[XB_XCNT(j)]); sum += c; cnt += (c > 0u) ? 1u : 0u; mine = (j == x) ? c : mine; }
        if (sum == G) break;
        __builtin_amdgcn_s_sleep(1);
        if ((++sp & 255u) == 0u) { if (xb_ld(&bar[XB_TMO])) break; if (sp > XB_SPIN_CAP) { atomicAdd(&bar[XB_TMO], 1u); break; } }
    }
    nloc = mine > 0u ? mine : 1u; nx = cnt > 0u ? cnt : 1u;
}
__device__ __forceinline__ void xcd_barrier(const XcdBarrier& b) {
    asm volatile("s_waitcnt vmcnt(0)" ::: "memory");
    __syncthreads();
    if (threadIdx.x == 0) {
        unsigned* bar = b.bar;
        __builtin_amdgcn_s_waitcnt(0);
        unsigned nloc = b.st[0], nx = b.st[1];
        if (nloc == 0u) { xcd_barrier_complete(bar, b.x, nloc, nx); b.st[0] = nloc; b.st[1] = nx; }
        const unsigned old = xb_add(&bar[XB_XSUB(b.x)], 1u);
        const unsigned gen = old / nloc;
        if (old + 1u == (gen + 1u) * nloc) {
            __builtin_amdgcn_fence(__ATOMIC_RELEASE, "agent");
            asm volatile("s_waitcnt vmcnt(0)" ::: "memory");
            const unsigned og = xb_add(&bar[XB_TOP], 1u);
            const unsigned tg = og / nx;
            if (og + 1u == (tg + 1u) * nx) xb_add(&bar[XB_TOPGEN], 1u);
            else XB_SPIN(xb_ld(&bar[XB_TOPGEN]) == tg, bar);
            __builtin_amdgcn_fence(__ATOMIC_ACQUIRE, "agent");
            xb_add(&bar[XB_XGEN(b.x)], 1u);
            asm volatile("s_waitcnt vmcnt(0)" ::: "memory");
        } else {
            XB_SPIN(xb_ld(&bar[XB_XGEN(b.x)]) == gen, bar);
            __builtin_amdgcn_fence(__ATOMIC_ACQUIRE, "agent");
            asm volatile("s_waitcnt vmcnt(0)" ::: "memory");
        }
    }
    __syncthreads();
}

namespace pg8 {
constexpr int MOE_CAP = 34816;
constexpr int BM = 256, BK = 64, HALF = 128, HTB = HALF * BK * 2, STAGE_BYTES = 8 * HTB, NXCD = 8, WGM = 8, ROWTAB_OFF = 131072 + 4096;
__host__ __device__ __forceinline__ int lds_byte(int r, int c) { const int st = (r >> 4) * 2 + (c >> 5), rr = r & 15, cc = c & 31, ob = rr * 64 + cc * 2; return st * 1024 + (ob ^ (((ob >> 9) & 1) << 5)); }
__host__ __device__ __forceinline__ void stage_rc(int b, int& R, int& C) { const int st = b / 1024, sb = b % 1024, swz = sb ^ (((sb >> 9) & 1) << 5); R = (st >> 1) * 16 + swz / 64; C = (st & 1) * 32 + (swz % 64) / 2; }
__host__ __device__ __forceinline__ int perm32(int rho) { const int n = rho >> 4, i = rho & 15; return 8 * (i >> 2) + 4 * n + (i & 3); }
struct Unit { int pm, pn, e; };
__device__ __forceinline__ unsigned cvt_pk_bf16(float lo, float hi) { return pk2(lo, hi); }

__device__ __forceinline__ void tile_of(int L, int nM, int nN, int& pm, int& pn) {
    const int nwg = nM * nN; int wgid = L;
    { const int q = nwg / NXCD, r = nwg % NXCD, xcd = wgid % NXCD, off = wgid / NXCD; wgid = (xcd < r ? xcd * (q + 1) : r * (q + 1) + (xcd - r) * q) + off; }
    const int nig = WGM * nN, gid = wgid / nig, fm = gid * WGM, gsz = (nM - fm) < WGM ? (nM - fm) : WGM;
    pm = fm + ((wgid % nig) % gsz); pn = (wgid % nig) / gsz;
}
struct SchedStatic {
    static constexpr bool GATHER = false;
    const char* A; const char* Bt; size_t tstep; int nM, nN, G, c;
    __device__ __forceinline__ void init(const void* A_, const void* Bt_, int M, int N, int K, int G_, int c_) { A = (const char*)A_; Bt = (const char*)Bt_; tstep = (size_t)BM * K * 2; nM = M / BM; nN = N / BM; G = G_; c = c_; }
    __device__ __forceinline__ bool next(int i, Unit& u) const { const long L = (long)i * G + c; if (L >= (long)nM * nN) return false; tile_of((int)L, nM, nN, u.pm, u.pn); u.e = 0; return true; }
    __device__ __forceinline__ const char* aptr(const Unit& u) const { return A + (size_t)u.pm * tstep; }
    __device__ __forceinline__ const char* bptr(const Unit& u) const { return Bt + (size_t)u.pn * tstep; }
};
struct SchedWin {
    static constexpr bool GATHER = false;
    const char* A; const char* Bt; size_t tstep; int G, c, part;
    __device__ __forceinline__ bool next(int i, Unit& u) const {
        const int L = i * G + c, nmf = part ? 128 : 136, nfull = nmf * 27; u.e = 0;
        if (L < nfull) { tile_of(L, nmf, 27, u.pm, u.pn); return true; }
        const int L2 = L - nfull; if (!part || L2 >= 8 * 9) return false;
        u.pm = 128 + L2 / 9; u.pn = 6 + L2 % 9; return true; }
    __device__ __forceinline__ const char* aptr(const Unit& u) const { return A + (size_t)u.pm * tstep; }
    __device__ __forceinline__ const char* bptr(const Unit& u) const { return Bt + (size_t)u.pn * tstep; }
};
struct SchedP {
    static constexpr bool GATHER = false;
    const char* A; const char* Bt; size_t tstep; int nM, G, c;
    __device__ __forceinline__ bool next(int i, Unit& u) const { const long L = (long)i * G + c; if (L >= (long)nM * 10) return false; tile_of((int)L, nM, 10, u.pm, u.pn); u.e = 0; return true; }
    __device__ __forceinline__ const char* aptr(const Unit& u) const { return A + (size_t)u.pm * tstep + (u.pn < 8 ? 0 : 256); }
    __device__ __forceinline__ const char* bptr(const Unit& u) const { return Bt + (size_t)u.pn * tstep + (u.pn < 8 ? 0 : 256); }
};
struct SchedMerge {
    static constexpr bool GATHER = false;
    const char* A0; const char* A1; const char* A2; const char* Bt; size_t tstep, bstride; int nM, nN, G, c;
    __device__ __forceinline__ bool next(int i, Unit& u) const { const int j = i / 3, br = i - 3 * j; const long L = (long)j * G + c; if (L >= (long)nM * nN) return false; tile_of((int)L, nM, nN, u.pm, u.pn); u.e = br; return true; }
    __device__ __forceinline__ const char* aptr(const Unit& u) const { return (u.e == 0 ? A0 : (u.e == 1 ? A1 : A2)) + (size_t)u.pm * tstep; }
    __device__ __forceinline__ const char* bptr(const Unit& u) const { return Bt + (size_t)u.e * bstride + (size_t)u.pn * tstep; }
};
struct SchedMoe {
    static constexpr bool GATHER = false;
    const char* A; const char* Bt; size_t tstep, estride; int NPN, G, c; const LAS int* base;
    __device__ __forceinline__ bool next(int i, Unit& u) const {
        const int ntiles = base[32] >> 8; const int per = G >> 3;
        const long L = (long)i * G + (((G & 7) == 0) ? (c & 7) * per + (c >> 3) : c);
        if (L >= (long)ntiles * NPN) return false;
        u.pm = (int)(L / NPN); u.pn = (int)(L % NPN); const int r0 = u.pm << 8; int e = 0;
#pragma unroll 1
        for (int k = 1; k < 32; ++k) e += (r0 >= base[k]) ? 1 : 0;
        u.e = e; return true;
    }
    __device__ __forceinline__ const char* aptr(const Unit& u) const { return A + (size_t)u.pm * tstep; }
    __device__ __forceinline__ const char* bptr(const Unit& u) const { return Bt + (size_t)u.e * estride + (size_t)u.pn * tstep; }
};
struct SchedMoeG : SchedMoe {
    static constexpr bool GATHER = true;
    const unsigned* rowof;
    __device__ __forceinline__ const char* aptr(const Unit&) const { return A; }
    __device__ __forceinline__ const unsigned* rowptr(const Unit& u) const { return rowof + (size_t)u.e * MOE_CAP + ((u.pm << 8) - base[u.e]); }
    __device__ __forceinline__ int valid(const Unit& u) const { return base[64 + u.e] - ((u.pm << 8) - base[u.e]); }
};

template <class Epi, class Sched>
__device__ __forceinline__ void gemm_phase(LAS unsigned char* lds, const int tid, const int K, const Sched& S, const Epi& E, const int ntk = 0) {
    const int wid = __builtin_amdgcn_readfirstlane(tid >> 6), lane = tid & 63, wr = wid >> 2, wc = wid & 3, fr = lane & 15, fq = lane >> 4;
    const int nt = ntk ? ntk : K / BK;
    unsigned voffA[2], voffB[2];
#pragma unroll
    for (int i = 0; i < 2; ++i) { int R, C; stage_rc(tid * 16 + i * 8192, R, C); const int Rb = Epi::PERM ? ((R & ~31) + perm32(R & 31)) : R;
        voffA[i] = (unsigned)(R * K + C) * 2u; voffB[i] = (unsigned)(Rb * K + C) * 2u; }
    const size_t kstep = (size_t)(BK * 2);
    const size_t hstep = (size_t)HALF * K * 2;
    const unsigned ldsw = (unsigned)wid * 1024u;
    const int aoff = lds_byte(wr * 64 + fr, fq * 8), boff = lds_byte(wc * 32 + fr, fq * 8);
#define PG8_SA(b, h) (((b) * 2 + (h)) * HTB)
#define PG8_SB(b, h) ((4 + (b) * 2 + (h)) * HTB)
#define PG8_STAGE(bufoff, gbase, voff) do { _Pragma("unroll") for (int _i = 0; _i < 2; ++_i) \
        __builtin_amdgcn_global_load_lds((const unsigned*)((const char*)(gbase) + (voff)[_i]), (LAS unsigned*)(lds + (bufoff) + ldsw + _i * 8192), 16, 0, 0); } while (0)
#define PG8_STAGEA(bufoff, kp, h) do { if constexpr (Sched::GATHER) { _Pragma("unroll") for (int _i = 0; _i < 2; ++_i) \
        __builtin_amdgcn_global_load_lds((const unsigned*)((const char*)(kp) + g[2 * (h) + _i]), (LAS unsigned*)(lds + (bufoff) + ldsw + _i * 8192), 16, 0, 0); } \
        else { PG8_STAGE(bufoff, (kp) + (h) * hstep, voffA); } } while (0)
#define PG8_GLOAD(un_, buf) do { const LAS unsigned* rt_ = (const LAS unsigned*)(lds + ROWTAB_OFF + (buf) * 1024) + gR0; const int nv_ = S.valid(un_); \
        _Pragma("unroll") for (int _j = 0; _j < 4; ++_j) g[_j] = ((gR0 + 64 * _j < nv_) ? rt_[64 * _j] : 0u) + gCb; } while (0)
#define PG8_GDMA(un_, buf) do { if (wid == 0) { unsigned lo_ = (unsigned)threadIdx.x; asm volatile("" : "+v"(lo_)); lo_ = (lo_ & 63u) * 16u; \
        __builtin_amdgcn_global_load_lds((const unsigned*)((const char*)S.rowptr(un_) + lo_), (LAS unsigned*)(lds + ROWTAB_OFF + (buf) * 1024), 16, 0, 0); } } while (0)
#define PG8_LDA(dst, b, h) do { _Pragma("unroll") for (int m = 0; m < 4; ++m) _Pragma("unroll") for (int k = 0; k < 2; ++k) dst[m][k] = *(const LAS bf16x8*)(lds + PG8_SA(b, h) + aoff + m * 2048 + k * 1024); } while (0)
#define PG8_LDB(dst, b, h) do { _Pragma("unroll") for (int n = 0; n < 2; ++n) _Pragma("unroll") for (int k = 0; k < 2; ++k) dst[n][k] = *(const LAS bf16x8*)(lds + PG8_SB(b, h) + boff + n * 2048 + k * 1024); } while (0)
#define PG8_MMA(ai, bj, At, Bt) do { __builtin_amdgcn_s_setprio(1); _Pragma("unroll") for (int m = 0; m < 4; ++m) _Pragma("unroll") for (int n = 0; n < 2; ++n) _Pragma("unroll") for (int k = 0; k < 2; ++k) \
        acc[ai][bj][m][n] = __builtin_amdgcn_mfma_f32_16x16x32_bf16(Bt[n][k], At[m][k], acc[ai][bj][m][n], 0, 0, 0); __builtin_amdgcn_s_setprio(0); } while (0)
#define PG8_WAIT_V(n) asm volatile("s_waitcnt vmcnt(" #n ")" ::: "memory")
#define PG8_WAIT_L(n) asm volatile("s_waitcnt lgkmcnt(" #n ")" ::: "memory")
#define PG8_BAR __builtin_amdgcn_s_barrier()
#define PG8_SCHED __builtin_amdgcn_sched_barrier(0)
    Unit cur, nxt; int ui = 0;
    if (!S.next(0, cur)) return;
    f32x4 acc[2][2][4][2];
#pragma unroll
    for (int a = 0; a < 2; ++a)
#pragma unroll
        for (int b = 0; b < 2; ++b)
#pragma unroll
            for (int m = 0; m < 4; ++m)
#pragma unroll
                for (int n = 0; n < 2; ++n) acc[a][b][m][n] = (f32x4){0.f, 0.f, 0.f, 0.f};
    bf16x8 At[4][2], B0[2][2], B1[2][2];
    const char* cA = S.aptr(cur); const char* cB = S.bptr(cur);
    unsigned g[4] = {0u, 0u, 0u, 0u}; int gR0 = 0; unsigned gCb = 0u;
    if constexpr (Sched::GATHER) { int R, C; stage_rc(tid * 16, R, C); gR0 = R; gCb = (unsigned)C * 2u;
        PG8_GDMA(cur, 0); PG8_WAIT_V(0); PG8_BAR; PG8_GLOAD(cur, 0); }
    PG8_STAGE(PG8_SB(0, 0), cB, voffB); PG8_STAGE(PG8_SB(0, 1), cB + hstep, voffB); PG8_STAGEA(PG8_SA(0, 0), cA, 0); PG8_STAGEA(PG8_SA(0, 1), cA, 1);
    if (wr == 1) PG8_BAR;
    PG8_WAIT_V(2); PG8_BAR;
    PG8_STAGE(PG8_SB(1, 0), cB + kstep, voffB); PG8_STAGEA(PG8_SA(1, 0), cA + kstep, 0); PG8_STAGE(PG8_SB(1, 1), cB + hstep + kstep, voffB);
    PG8_WAIT_V(6); PG8_BAR;
    for (;;) {
        const bool has_next = S.next(ui + 1, nxt);
        const char* nA = has_next ? S.aptr(nxt) : cA; const char* nB = has_next ? S.bptr(nxt) : cB;
        if constexpr (Sched::GATHER) { if (has_next) PG8_GDMA(nxt, (ui + 1) & 1); }
        for (int t = 0; t < nt; t += 2) {
            const bool last = (t == nt - 2);
            const char* a1 = cA + (size_t)(t + 1) * kstep;
            const char* a2 = last ? nA : cA + (size_t)(t + 2) * kstep; const char* b2 = last ? nB : cB + (size_t)(t + 2) * kstep;
            const char* a3 = a2 + kstep; const char* b3 = b2 + kstep;
            PG8_LDB(B0, 0, 0); PG8_LDB(B1, 0, 1); PG8_SCHED; PG8_LDA(At, 0, 0); PG8_STAGEA(PG8_SA(1, 1), a1, 1);
            PG8_WAIT_V(8); PG8_WAIT_L(0); PG8_BAR; PG8_MMA(0, 0, At, B0); PG8_MMA(0, 1, At, B1); PG8_BAR; PG8_SCHED;
            if constexpr (Sched::GATHER) { if (last && has_next) PG8_GLOAD(nxt, (ui + 1) & 1); PG8_SCHED; }
            PG8_LDA(At, 0, 1); PG8_STAGE(PG8_SB(0, 0), b2, voffB); PG8_STAGE(PG8_SB(0, 1), b2 + hstep, voffB); PG8_STAGEA(PG8_SA(0, 0), a2, 0);
            PG8_WAIT_V(8); PG8_WAIT_L(0); PG8_BAR; PG8_MMA(1, 0, At, B0); PG8_MMA(1, 1, At, B1); PG8_BAR; PG8_SCHED;
            PG8_LDB(B0, 1, 0); PG8_LDB(B1, 1, 1); PG8_SCHED; PG8_LDA(At, 1, 0); PG8_STAGEA(PG8_SA(0, 1), a2, 1);
            PG8_WAIT_V(8); PG8_WAIT_L(0); PG8_BAR; PG8_MMA(0, 0, At, B0); PG8_MMA(0, 1, At, B1); PG8_BAR; PG8_SCHED;
            PG8_LDA(At, 1, 1); PG8_STAGE(PG8_SB(1, 0), b3, voffB); PG8_STAGE(PG8_SB(1, 1), b3 + hstep, voffB); PG8_STAGEA(PG8_SA(1, 0), a3, 0);
            PG8_WAIT_V(8); PG8_WAIT_L(0); PG8_BAR; PG8_MMA(1, 0, At, B0); PG8_MMA(1, 1, At, B1); PG8_BAR; PG8_SCHED;
        }
        if (wr == 0) PG8_BAR;
        { int t2_ = (int)threadIdx.x; asm volatile("" : "+v"(t2_)); E(acc, cur, wr, wc, t2_ & 15, (t2_ >> 4) & 3); }
        if (!has_next) break;
#pragma unroll
        for (int a = 0; a < 2; ++a)
#pragma unroll
            for (int b = 0; b < 2; ++b)
#pragma unroll
                for (int m = 0; m < 4; ++m)
#pragma unroll
                    for (int n = 0; n < 2; ++n) acc[a][b][m][n] = (f32x4){0.f, 0.f, 0.f, 0.f};
        cur = nxt; cA = nA; cB = nB; ++ui;
        if (wr == 1) PG8_BAR;
    }
    PG8_WAIT_V(0);
    PG8_BAR;
#undef PG8_SA
#undef PG8_SB
#undef PG8_STAGE
#undef PG8_STAGEA
#undef PG8_GLOAD
#undef PG8_GDMA
#undef PG8_LDA
#undef PG8_LDB
#undef PG8_MMA
#undef PG8_WAIT_V
#undef PG8_WAIT_L
#undef PG8_BAR
#undef PG8_SCHED
}

struct EpiBf16 {
    static constexpr bool PERM = true;
    bf16* O; int ldc; const float* bias; int bias_stride;
    __device__ __forceinline__ void operator()(const f32x4 (&acc)[2][2][4][2], const Unit& u, int wr, int wc, int fr, int fq) const {
        const int row0 = u.pm * BM + wr * 64 + fr, col0 = u.pn * BM + wc * 32 + 8 * fq;
        f32x4 bv[2][2];
#pragma unroll
        for (int bj = 0; bj < 2; ++bj)
#pragma unroll
            for (int n = 0; n < 2; ++n) bv[bj][n] = bias ? *(const f32x4*)(bias + (size_t)u.e * bias_stride + col0 + bj * HALF + 4 * n) : (f32x4){0.f, 0.f, 0.f, 0.f};
#pragma unroll
        for (int ai = 0; ai < 2; ++ai)
#pragma unroll
            for (int m = 0; m < 4; ++m) { bf16* rowp = O + (size_t)(row0 + ai * HALF + m * 16) * ldc + col0;
#pragma unroll
                for (int bj = 0; bj < 2; ++bj) { const f32x4 v0 = acc[ai][bj][m][0] + bv[bj][0], v1 = acc[ai][bj][m][1] + bv[bj][1];
                    v4u w; w.x = cvt_pk_bf16(v0[0], v0[1]); w.y = cvt_pk_bf16(v0[2], v0[3]); w.z = cvt_pk_bf16(v1[0], v1[1]); w.w = cvt_pk_bf16(v1[2], v1[3]);
                    *(v4u*)(rowp + bj * HALF) = w; } }
    }
};
template <int MODE> struct EpiGlu {
    static constexpr bool PERM = true;
    bf16* O; int ldc; const float* bias; int bias_stride, hs;
    __device__ __forceinline__ void operator()(const f32x4 (&acc)[2][2][4][2], const Unit& u, int wr, int wc, int fr, int fq) const {
        const int row0 = u.pm * BM + wr * 64 + fr, col0 = u.pn * HALF + wc * 32 + 8 * fq;
        const float* bp = bias + (size_t)u.e * bias_stride + col0;
        f32x4 ba[2], bb[2];
#pragma unroll
        for (int n = 0; n < 2; ++n) { ba[n] = *(const f32x4*)(bp + 4 * n); bb[n] = *(const f32x4*)(bp + hs + 4 * n); }
#pragma unroll
        for (int ai = 0; ai < 2; ++ai)
#pragma unroll
            for (int m = 0; m < 4; ++m) { bf16* rowp = O + (size_t)(row0 + ai * HALF + m * 16) * ldc + col0;
                float o[8];
#pragma unroll
                for (int n = 0; n < 2; ++n) { const f32x4 a = acc[ai][0][m][n] + ba[n], b = acc[ai][1][m][n] + bb[n];
#pragma unroll
                    for (int j = 0; j < 4; ++j) {
                        if (MODE == 0) o[4 * n + j] = a[j] * sigm(b[j]);
                        else { const float g = fminf(a[j], 7.f), up = fminf(fmaxf(b[j], -7.f), 7.f); o[4 * n + j] = (up + 1.f) * g * sigm(1.702f * g); } } }
                v4u w; w.x = cvt_pk_bf16(o[0], o[1]); w.y = cvt_pk_bf16(o[2], o[3]); w.z = cvt_pk_bf16(o[4], o[5]); w.w = cvt_pk_bf16(o[6], o[7]);
                *(v4u*)rowp = w; }
    }
};
struct EpiMerge {
    static constexpr bool PERM = true;
    bf16* mtmp; bf16* Mo; const bf16* zg;
    __device__ __forceinline__ void operator()(const f32x4 (&acc)[2][2][4][2], const Unit& u, int wr, int wc, int fr, int fq) const {
        const int row0 = u.pm * BM + wr * 64 + fr, col0 = u.pn * BM + wc * 32 + 8 * fq;
#pragma unroll
        for (int ai = 0; ai < 2; ++ai)
#pragma unroll
            for (int m = 0; m < 4; ++m) { const size_t r = (size_t)(row0 + ai * HALF + m * 16);
#pragma unroll
                for (int bj = 0; bj < 2; ++bj) { const int c = col0 + bj * HALF;
                    const v4u gz = *(const v4u*)(zg + r * IN_COLS + u.e * 1024 + c);
                    float g[8] = {bflo(gz.x), bfhi(gz.x), bflo(gz.y), bfhi(gz.y), bflo(gz.z), bfhi(gz.z), bflo(gz.w), bfhi(gz.w)};
                    f32x4 t0, t1; bf16* tp = mtmp + r * 1024 + c;
                    if (u.e == 0) { t0 = (f32x4){0.f, 0.f, 0.f, 0.f}; t1 = t0; } else { const v4u pv = *(const v4u*)tp; t0 = (f32x4){bflo(pv.x), bfhi(pv.x), bflo(pv.y), bfhi(pv.y)}; t1 = (f32x4){bflo(pv.z), bfhi(pv.z), bflo(pv.w), bfhi(pv.w)}; }
#pragma unroll
                    for (int j = 0; j < 4; ++j) { t0[j] += sigm(g[j]) * acc[ai][bj][m][0][j]; t1[j] += sigm(g[4 + j]) * acc[ai][bj][m][1][j]; }
                    if (u.e < 2) { v4u w; w.x = cvt_pk_bf16(t0[0], t0[1]); w.y = cvt_pk_bf16(t0[2], t0[3]); w.z = cvt_pk_bf16(t1[0], t1[1]); w.w = cvt_pk_bf16(t1[2], t1[3]); *(v4u*)tp = w; }
                    else { v4u w; w.x = cvt_pk_bf16(t0[0], t0[1]); w.y = cvt_pk_bf16(t0[2], t0[3]); w.z = cvt_pk_bf16(t1[0], t1[1]); w.w = cvt_pk_bf16(t1[2], t1[3]);
                        *(v4u*)(Mo + r * 1024 + c) = w; } } }
    }
};
struct EpiResid {
    static constexpr bool PERM = false;
    float* X; const float* gmod;
    __device__ __forceinline__ void operator()(const f32x4 (&acc)[2][2][4][2], const Unit& u, int wr, int wc, int fr, int fq) const {
        const int row0 = u.pm * BM + wr * 64 + fr, col0 = u.pn * BM + wc * 32 + 4 * fq;
        const int r00 = u.pm * BM; const int w = r00 < T_LAT ? (r00 >> 12) : 8;
        f32x4 gv[2][2];
#pragma unroll
        for (int bj = 0; bj < 2; ++bj)
#pragma unroll
            for (int n = 0; n < 2; ++n) gv[bj][n] = *(const f32x4*)(gmod + (size_t)w * 6144 + col0 + bj * HALF + n * 16);
#pragma unroll
        for (int ai = 0; ai < 2; ++ai)
#pragma unroll
            for (int m = 0; m < 4; ++m) { float* rowp = X + (size_t)(row0 + ai * HALF + m * 16) * 1024 + col0;
#pragma unroll
                for (int bj = 0; bj < 2; ++bj)
#pragma unroll
                    for (int n = 0; n < 2; ++n) { f32x4* p = (f32x4*)(rowp + bj * HALF + n * 16); *p = *p + gv[bj][n] * acc[ai][bj][m][n]; } }
    }
};
}

struct Args { const float* in[51]; float* out; unsigned char* ws; int ph_lo, ph_hi; };
enum { I_X = 0, I_C, I_CTX, I_CCTX, I_ADAW, I_ADAB, I_N1G, I_N2G, I_WIN, I_HYCW, I_HYCB, I_HYW1, I_HYB1, I_HYF1, I_HYW2, I_HYB2, I_HYF2, I_HYW3, I_HYB3, I_HYBIAS,
       I_RWCW, I_RWCB, I_RWWUP, I_RWW0, I_RWAUP, I_RWA0, I_RWGUP, I_RWKK, I_RWKA, I_RWRK, I_RWLNG, I_RWLNB, I_S5ARE, I_S5AIM, I_S5LDT, I_S5BRE, I_S5BIM, I_S5CRE, I_S5CIM, I_S5D,
       I_S5GLUW, I_S5GLUB, I_WBR, I_WOUT, I_RTW, I_RTB, I_W1, I_B1, I_W2, I_B2, I_FING };

typedef const __attribute__((address_space(4))) Args* CArgsP;
__device__ __forceinline__ CArgsP kargs() { CArgsP p = (CArgsP)__builtin_amdgcn_kernarg_segment_ptr(); asm volatile("" : "+s"(p)); return p; }
__device__ __forceinline__ int opaque(int v) { asm volatile("" : "+s"(v)); return v; }
__device__ __forceinline__ int opaque_v(int v) { asm volatile("" : "+v"(v)); return v; }
struct Ctx { CArgsP a; LAS unsigned char* lds; int tid, lane, wave, bid, G; };

__device__ __forceinline__ void row_seq(int row, int& base, int& pos, int& n) {
    if (row < T_LAT) { base = row & ~(SEQ - 1); pos = row & (SEQ - 1); n = SEQ; }
    else { const int r = row - T_LAT; base = T_LAT + (r & ~(CTXL - 1)); pos = r & (CTXL - 1); n = CTXL; }
}
__device__ __forceinline__ float conv3z(const bf16* zc, int pos, int n, float w0, float w1, float w2, float b) {
    const float zm = pos > 0 ? bf2f(zc[(size_t)(pos - 1) * IN_COLS]) : 0.f, z0 = bf2f(zc[(size_t)pos * IN_COLS]), zp = pos < n - 1 ? bf2f(zc[(size_t)(pos + 1) * IN_COLS]) : 0.f;
    return zm * w0 + z0 * w1 + zp * w2 + b;
}

template <int MODE>
__device__ __forceinline__ void transpose_item(const float* W, int K, int N, bf16* WT, int Hs, LAS float* scr, int item, int lane) {
    const int nblk = N / 32, kb = item / nblk, nb = item % nblk, k0 = 64 * kb, n0 = 32 * nb;
#pragma unroll 8
    for (int i = 0; i < 32; ++i) { const int kk = 2 * i + (lane >> 5); scr[kk * 33 + (lane & 31)] = W[(size_t)(k0 + kk) * N + n0 + (lane & 31)]; }
    LDS_WAIT(); asm volatile("" ::: "memory");
    const int c = lane & 7;
#pragma unroll
    for (int j = 0; j < 4; ++j) { const int n = (lane >> 3) + 8 * j; const LAS float* s = scr + (8 * c) * 33 + n;
        v4u o; o.x = pk2(s[0 * 33], s[1 * 33]); o.y = pk2(s[2 * 33], s[3 * 33]); o.z = pk2(s[4 * 33], s[5 * 33]); o.w = pk2(s[6 * 33], s[7 * 33]);
        int dr = n0 + n;
        if (MODE == 1) { const int nc = n0 + n; const int jx = nc < Hs ? nc : nc - Hs; dr = (jx >> 7) * 256 + (nc < Hs ? 0 : 128) + (jx & 127); }
        *(v4u*)(WT + (size_t)dr * K + k0 + 8 * c) = o; }
    LDS_WAIT(); asm volatile("" ::: "memory");
}

__device__ __forceinline__ void p0_prologue(const Ctx& F) {
    const auto& a = *F.a; unsigned char* ws = a.ws;
    const int gw = F.bid * NWAVES + F.wave, NGW = F.G * NWAVES, lane = F.lane;
    {
        LAS float* condl = (LAS float*)F.lds; LAS float* psum = (LAS float*)(F.lds + 40960);
        for (int i = F.tid; i < 9 * 1024; i += NTHREADS) { const int w = i >> 10, k = i & 1023; const float cv = (w < 8) ? a.in[I_C][w * 1024 + k] : a.in[I_CCTX][k]; condl[i] = cv / (1.f + expf(-cv)); }
        __syncthreads();
        float* MOD = (float*)(ws + WS_MOD);
        for (int it = F.bid; it < 2 * 96; it += F.G) {
            const int l = it / 96, cg = it % 96, col = cg * 64 + lane;
            float acc[9];
#pragma unroll
            for (int w = 0; w < 9; ++w) acc[w] = 0.f;
            const float* wp = a.in[I_ADAW] + ((size_t)l * 1024 + F.wave * 128) * 6144 + col;
#pragma unroll 1
            for (int k0 = 0; k0 < 128; k0 += 16) { float wv[16];
#pragma unroll
                for (int k = 0; k < 16; ++k) wv[k] = wp[(size_t)(k0 + k) * 6144];
#pragma unroll
                for (int k = 0; k < 16; ++k)
#pragma unroll
                    for (int w = 0; w < 9; ++w) acc[w] += condl[w * 1024 + F.wave * 128 + k0 + k] * wv[k]; }
#pragma unroll
            for (int w = 0; w < 9; ++w) psum[(F.wave * 9 + w) * 64 + lane] = acc[w];
            __syncthreads();
            if (F.wave == 0) {
#pragma unroll
                for (int w = 0; w < 9; ++w) { float s = 0.f;
#pragma unroll
                    for (int wv = 0; wv < 8; ++wv) s += psum[(wv * 9 + w) * 64 + lane];
                    MOD[(size_t)(l * 9 + w) * 6144 + col] = s + a.in[I_ADAB][l * 6144 + col]; }
            }
            __syncthreads();
        }
    }
    {
        LAS float* scr = (LAS float*)(F.lds + F.wave * 16384);
        constexpr int IT_W1 = 16 * 64, IT_W2 = 16 * 32, IT_WIN = 16 * 216, IT_GLU = 8 * 32, IT_WBR = 8 * 32, IT_WOUT = 16 * 32;
        constexpr int N_W1 = 64 * IT_W1, N_W2 = 64 * IT_W2, N_WIN = 2 * IT_WIN, N_GLU = 2 * IT_GLU, N_WBR = 6 * IT_WBR, N_WOUT = 2 * IT_WOUT;
        constexpr int NITEMS = N_W1 + N_W2 + N_WIN + N_GLU + N_WBR + N_WOUT;
        for (int it = gw; it < NITEMS; it += NGW) {
            int r = it;
            if (r < N_W1) { const int mtx = r / IT_W1, l = mtx >> 5, e = mtx & 31; transpose_item<1>(a.in[I_W1] + (size_t)mtx * 1024 * 2048, 1024, 2048, (bf16*)(ws + WS_WTS + l * WL_STRIDE + WO_W1) + (size_t)e * 2048 * 1024, 1024, scr, r % IT_W1, lane); continue; } r -= N_W1;
            if (r < N_W2) { const int mtx = r / IT_W2, l = mtx >> 5, e = mtx & 31; transpose_item<0>(a.in[I_W2] + (size_t)mtx * 1024 * 1024, 1024, 1024, (bf16*)(ws + WS_WTS + l * WL_STRIDE + WO_W2) + (size_t)e * 1024 * 1024, 0, scr, r % IT_W2, lane); continue; } r -= N_W2;
            if (r < N_WIN) { const int l = r / IT_WIN; transpose_item<0>(a.in[I_WIN] + (size_t)l * 1024 * IN_COLS, 1024, IN_COLS, (bf16*)(ws + WS_WTS + l * WL_STRIDE + WO_WIN), 0, scr, r % IT_WIN, lane); continue; } r -= N_WIN;
            if (r < N_GLU) { const int l = r / IT_GLU; transpose_item<1>(a.in[I_S5GLUW] + (size_t)l * 512 * 1024, 512, 1024, (bf16*)(ws + WS_WTS + l * WL_STRIDE + WO_GLU), 512, scr, r % IT_GLU, lane); continue; } r -= N_GLU;
            if (r < N_WBR) { const int mtx = r / IT_WBR, l = mtx / 3, br = mtx % 3; transpose_item<0>(a.in[I_WBR] + (size_t)mtx * 512 * 1024, 512, 1024, (bf16*)(ws + WS_WTS + l * WL_STRIDE + WO_WBR) + (size_t)br * 1024 * 512, 0, scr, r % IT_WBR, lane); continue; } r -= N_WBR;
            { const int l = r / IT_WOUT; transpose_item<0>(a.in[I_WOUT] + (size_t)l * 1024 * 1024, 1024, 1024, (bf16*)(ws + WS_WTS + l * WL_STRIDE + WO_WOUT), 0, scr, r % IT_WOUT, lane); }
        }
        for (int i = F.bid * NTHREADS + F.tid; i < 2 * 2560 * 256; i += F.G * NTHREADS) {
            const int l = i / (2560 * 256), r = i % (2560 * 256), n = r >> 8, k = r & 255; float v = 0.f;
            if (n < 1024) { if (k < 64) v = a.in[I_RWWUP][(((size_t)l * 2 + (n >> 9)) * 64 + k) * 512 + (n & 511)]; }
            else if (n < 2048) { if (k >= 64 && k < 128) v = a.in[I_RWAUP][(((size_t)l * 2 + ((n - 1024) >> 9)) * 64 + (k - 64)) * 512 + (n & 511)]; }
            else { if (k >= 128) v = a.in[I_RWGUP][((size_t)l * 128 + (k - 128)) * 512 + (n - 2048)]; }
            ((bf16*)(ws + WS_WTS + l * WL_STRIDE + WO_RWCAT))[r] = (bf16)f2bf(v);
        }
    }
    __syncthreads();
    {
        LAS float* feats = (LAS float*)F.lds; LAS float* h1 = feats + 8 * 33; LAS float* h2 = h1 + 8 * 64;
        constexpr int NIT = 2 * (512 + 32);
        for (int it = F.bid; it < NIT; it += F.G) {
            const int l = it / 544, r = it % 544, nsel = r >= 512, n = nsel ? CTXL : SEQ, p0 = (nsel ? r - 512 : r) * 8;
            if (l == DEPTH - 1 && nsel) continue;
            if (F.tid < 8 * 33) { const int p = F.tid / 33, i = F.tid % 33, pos = p0 + p; float f;
                if (i == 0) f = (float)pos / (float)(n - 1);
                else { const int k = (i - 1) & 15; const float band = 1e-4f + (float)k * ((15.0f - 1e-4f) / 15.0f); const float ang = (6.283185307179586f * (float)pos / (float)n) * band; f = (i <= 16) ? cosf(ang) : -sinf(ang); }
                feats[p * 33 + i] = f; }
            __syncthreads();
            { const int p = F.tid >> 6, j = F.tid & 63; float s = a.in[I_HYB1][l * 64 + j]; const float* w1p = a.in[I_HYW1] + (size_t)l * 33 * 64 + j;
#pragma unroll
                for (int i = 0; i < 33; ++i) s += feats[p * 33 + i] * w1p[i * 64];
                h1[p * 64 + j] = sinf(a.in[I_HYF1][l * 64 + j] * s); }
            __syncthreads();
            { const int p = F.tid >> 6, j = F.tid & 63; float s = a.in[I_HYB2][l * 64 + j];
                const float* w2p = a.in[I_HYW2] + (size_t)l * 64 * 64 + j;
#pragma unroll 16
                for (int i = 0; i < 64; ++i) s += h1[p * 64 + i] * w2p[i * 64];
                h2[p * 64 + j] = sinf(a.in[I_HYF2][l * 64 + j] * s); }
            __syncthreads();
            float acc[4][8];
#pragma unroll
            for (int q = 0; q < 4; ++q)
#pragma unroll
                for (int p = 0; p < 8; ++p) acc[q][p] = 0.f;
            const float* w3 = a.in[I_HYW3] + (size_t)l * 64 * 2048 + F.tid;
#pragma unroll 8
            for (int i = 0; i < 64; ++i) { float wv[4];
#pragma unroll
                for (int q = 0; q < 4; ++q) wv[q] = w3[(size_t)i * 2048 + q * 512];
#pragma unroll
                for (int p = 0; p < 8; ++p) { const float hv = h2[p * 64 + i];
#pragma unroll
                    for (int q = 0; q < 4; ++q) acc[q][p] += hv * wv[q]; } }
            const int c = F.tid; const float dstart = logf(0.01f) / 1.5f, dstop = logf(0.01f) / 0.3f; const float delta = fabsf(dstart + (float)c * ((dstop - dstart) / 511.0f));
            const int RL = nsel ? HY_RLENC : HY_RLEN, off = n + 47; const float rn1 = 1.0f / (float)(n - 1);
            bf16* Rb = (bf16*)(ws + WS_GF + l * GF_STRIDE + (nsel ? GF_CTX : 0));
#pragma unroll
            for (int q = 0; q < 4; ++q) { const int o = q >> 1, side = q & 1; const float b3 = a.in[I_HYB3][l * 2048 + q * 512 + c];
                bf16* Rc = Rb + ((size_t)o * 512 + c) * RL;
#pragma unroll
                for (int p = 0; p < 8; ++p) { const int pos = p0 + p; const float t = (float)pos * rn1; const float val = (acc[q][p] + b3) * __expf(-t * delta);
                    if (side == 0) Rc[off - pos] = (bf16)f2bf(val);
                    else if (pos >= 1) Rc[off + pos] = (bf16)f2bf(val); }
                if (p0 == 0 && side == 0) { for (int m = 0; m < 48; ++m) Rc[m] = 0; for (int m = off + n; m < RL; ++m) Rc[m] = 0; } }
            __syncthreads();
        }
    }
}

__device__ __forceinline__ void stage_xinit_norm1(const Ctx& F) {
    const auto& a = *F.a; unsigned char* ws = a.ws; const int lane = F.lane;
    const int gw = F.bid * NWAVES + F.wave, NGW = F.G * NWAVES;
    float* X = (float*)(ws + WS_X); bf16* H = (bf16*)(ws + WS_H); const float* MOD = (const float*)(ws + WS_MOD);
    f32x4 ngv[4];
#pragma unroll
    for (int j = 0; j < 4; ++j) ngv[j] = ((const f32x4*)a.in[I_N1G] + lane)[64 * j];
    const int nt = (SEQ - gw + NGW - 1) / NGW > 0 ? (SEQ - gw + NGW - 1) / NGW : 0;
    const int nc = (T_CTX - gw + NGW - 1) / NGW > 0 ? (T_CTX - gw + NGW - 1) / NGW : 0;
    const int nrow = nt * BATCH + nc;
    f32x4 xn[4], shn[4], scn[4];
#define XN_LOAD(k_) do { const int k2_ = (k_); int row_, w_; const float* src_; \
        if (k2_ < nt * BATCH) { const int t_ = gw + (k2_ >> 3) * NGW, b_ = k2_ & 7; row_ = b_ * SEQ + t_; w_ = b_; src_ = a.in[I_X] + (size_t)row_ * D; } \
        else { const int r_ = gw + (k2_ - nt * BATCH) * NGW; row_ = T_LAT + r_; w_ = 8; src_ = a.in[I_CTX] + (size_t)r_ * D; } \
        _Pragma("unroll") for (int j = 0; j < 4; ++j) { xn[j] = ((const f32x4*)src_ + lane)[64 * j]; shn[j] = ((const f32x4*)(MOD + (size_t)w_ * 6144) + lane)[64 * j]; scn[j] = ((const f32x4*)(MOD + (size_t)w_ * 6144 + 1024) + lane)[64 * j]; } } while (0)
    if (nrow > 0) XN_LOAD(0);
    f32x4 pe[4];
#pragma unroll
    for (int j = 0; j < 4; ++j) pe[j] = (f32x4){0.f, 0.f, 0.f, 0.f};
#pragma unroll 1
    for (int k = 0; k < nrow; ++k) {
        const bool lat = k < nt * BATCH;
        int row;
        if (lat) { const int t = gw + (k >> 3) * NGW, b = k & 7; row = b * SEQ + t;
            if (b == 0) { const float pr = (float)(t >> 6), pc = (float)(t & 63);
#pragma unroll
                for (int j = 0; j < 4; ++j)
#pragma unroll
                    for (int e = 0; e < 4; ++e) { const float om = __builtin_amdgcn_exp2f((float)(4 * lane + e) * (-13.287712379549449f / 256.0f)); const float ang = ((j < 2) ? pr : pc) * om; pe[j][e] = (j & 1) ? __cosf(ang) : __sinf(ang); } } }
        else row = T_LAT + gw + (k - nt * BATCH) * NGW;
        f32x4 v[4], sh[4], sc[4];
#pragma unroll
        for (int j = 0; j < 4; ++j) { v[j] = lat ? xn[j] + pe[j] : xn[j]; sh[j] = shn[j]; sc[j] = scn[j]; }
        if (k + 1 < nrow) XN_LOAD(k + 1);
        f32x4* xo = (f32x4*)(X + (size_t)row * D) + lane;
        float ss = 0.f;
#pragma unroll
        for (int j = 0; j < 4; ++j) { xo[64 * j] = v[j]; ss += (v[j][0] * v[j][0] + v[j][1] * v[j][1]) + (v[j][2] * v[j][2] + v[j][3] * v[j][3]); }
        const float rstd = __builtin_amdgcn_rsqf(wave_sum(ss) * (1.f / D) + 1e-6f);
        v2u* ho = (v2u*)(H + (size_t)row * D) + lane;
#pragma unroll
        for (int j = 0; j < 4; ++j) { const f32x4 h = v[j] * rstd * ngv[j] * (sc[j] + 1.0f) + sh[j]; v2u o; o.x = pk2(h[0], h[1]); o.y = pk2(h[2], h[3]); ho[64 * j] = o; }
    }
#undef XN_LOAD
}

__device__ __forceinline__ void stage_norm1(const Ctx& F, int l) {
    const auto& a = *F.a; unsigned char* ws = a.ws; const int lane = F.lane;
    const int gw = F.bid * NWAVES + F.wave, NGW = F.G * NWAVES;
    float* X = (float*)(ws + WS_X); bf16* H = (bf16*)(ws + WS_H); const float* MOD = (const float*)(ws + WS_MOD);
    const bf16* YS = (const bf16*)(ws + WS_XS); const int* POS = (const int*)(ws + WS_POS); const float* GATE = (const float*)(ws + WS_GATE);
    const int nrows = (l == DEPTH) ? T_LAT : T_ALL;
    f32x4 ngv[4];
    { const f32x4* ngp = (l == DEPTH) ? (const f32x4*)a.in[I_FING] + lane : (const f32x4*)(a.in[I_N1G] + l * D) + lane;
#pragma unroll
      for (int j = 0; j < 4; ++j) ngv[j] = ngp[64 * j]; }
    f32x4 vn[4]; v2u ysn[4][4]; int4 pnn = make_int4(0, 0, 0, 0); f32x4 gn = (f32x4){0.f, 0.f, 0.f, 0.f}, gnn = gn;
#pragma unroll
    for (int k = 0; k < 4; ++k)
#pragma unroll
        for (int j = 0; j < 4; ++j) ysn[k][j] = (v2u){0u, 0u};
#define N1_LDYS(p4_) do { const int pk_[4] = {(p4_).x, (p4_).y, (p4_).z, (p4_).w}; _Pragma("unroll") for (int k = 0; k < 4; ++k) { const v2u* yr_ = (const v2u*)(YS + (size_t)pk_[k] * D) + lane; \
        _Pragma("unroll") for (int j = 0; j < 4; ++j) ysn[k][j] = yr_[64 * j]; } } while (0)
    if (gw < nrows) {
#pragma unroll
        for (int j = 0; j < 4; ++j) vn[j] = ((const f32x4*)(X + (size_t)gw * D) + lane)[64 * j];
        if (l > 0) { const int4 p0 = *(const int4*)(POS + gw * 4); gn = *(const f32x4*)(GATE + gw * 4);
            if (gw + NGW < nrows) { pnn = *(const int4*)(POS + (gw + NGW) * 4); gnn = *(const f32x4*)(GATE + (gw + NGW) * 4); }
            N1_LDYS(p0); } }
#pragma unroll 1
    for (int row = gw; row < nrows; row += NGW) {
        const int w = row < T_LAT ? (row >> 12) : 8;
        f32x4* xr = (f32x4*)(X + (size_t)row * D) + lane;
        f32x4 v[4]; v2u ysc[4][4];
#pragma unroll
        for (int j = 0; j < 4; ++j) v[j] = vn[j];
#pragma unroll
        for (int k = 0; k < 4; ++k)
#pragma unroll
            for (int j = 0; j < 4; ++j) ysc[k][j] = ysn[k][j];
        const f32x4 gc = gn; const int4 pnx = pnn; gn = gnn;
        const int rn = row + NGW, rnn = row + 2 * NGW;
        if (rn < nrows) {
#pragma unroll
            for (int j = 0; j < 4; ++j) vn[j] = ((const f32x4*)(X + (size_t)rn * D) + lane)[64 * j];
            if (l > 0) N1_LDYS(pnx); }
        if (l > 0 && rnn < nrows) { pnn = *(const int4*)(POS + rnn * 4); gnn = *(const f32x4*)(GATE + rnn * 4); }
        f32x4 m0[4], m1[4], m2[4];
        if (l < DEPTH) {
#pragma unroll
            for (int j = 0; j < 4; ++j) { m0[j] = ((const f32x4*)(MOD + (size_t)(l * 9 + w) * 6144) + lane)[64 * j]; m1[j] = ((const f32x4*)(MOD + (size_t)(l * 9 + w) * 6144 + 1024) + lane)[64 * j]; } }
        if (l > 0) {
#pragma unroll
            for (int j = 0; j < 4; ++j) m2[j] = ((const f32x4*)(MOD + (size_t)((l - 1) * 9 + w) * 6144 + 5120) + lane)[64 * j];
            f32x4 mo[4];
#pragma unroll
            for (int j = 0; j < 4; ++j) mo[j] = (f32x4){0.f, 0.f, 0.f, 0.f};
#pragma unroll
            for (int k = 0; k < TOPK; ++k) { const float g = gc[k];
#pragma unroll
                for (int j = 0; j < 4; ++j) { const v2u y = ysc[k][j]; mo[j][0] += g * bflo(y.x); mo[j][1] += g * bfhi(y.x); mo[j][2] += g * bflo(y.y); mo[j][3] += g * bfhi(y.y); } }
#pragma unroll
            for (int j = 0; j < 4; ++j) { v[j] = v[j] + m2[j] * mo[j]; if (l < DEPTH) xr[64 * j] = v[j]; }
        }
        float ss = 0.f;
#pragma unroll
        for (int j = 0; j < 4; ++j) ss += (v[j][0] * v[j][0] + v[j][1] * v[j][1]) + (v[j][2] * v[j][2] + v[j][3] * v[j][3]);
        const float rstd = __builtin_amdgcn_rsqf(wave_sum(ss) * (1.f / D) + 1e-6f);
        if (l == DEPTH) {
            f32x4* o = (f32x4*)(a.out + (size_t)row * D) + lane;
#pragma unroll
            for (int j = 0; j < 4; ++j) o[64 * j] = v[j] * rstd * ngv[j];
        } else {
            v2u* ho = (v2u*)(H + (size_t)row * D) + lane;
#pragma unroll
            for (int j = 0; j < 4; ++j) { const f32x4 h = v[j] * rstd * ngv[j] * (m1[j] + 1.0f) + m0[j]; v2u o; o.x = pk2(h[0], h[1]); o.y = pk2(h[2], h[3]); ho[64 * j] = o; }
        }
    }
#undef N1_LDYS
}

__device__ __forceinline__ void stage_rw_prep1(const Ctx& F, int l) {
    const auto& a = *F.a; unsigned char* ws = a.ws;
    const bf16* __restrict__ Z = (const bf16*)(ws + WS_Z); bf16* __restrict__ ARW = (bf16*)(ws + WS_ARW);
    const int j = 4 * (F.tid & 63), col = 1536 + j, rq = F.tid >> 6;
    const float* cw = a.in[I_RWCW] + (size_t)l * 3 * 1792;
    const f32x4 w0 = *(const f32x4*)(cw + col), w1 = *(const f32x4*)(cw + 1792 + col), w2 = *(const f32x4*)(cw + 2 * 1792 + col), cb = *(const f32x4*)(a.in[I_RWCB] + l * 1792 + col);
#pragma unroll 4
    for (int row = F.bid * 8 + rq; row < T_ALL; row += F.G * 8) {
        int base, pos, n; row_seq(row, base, pos, n);
        const bf16* zc = Z + (size_t)row * IN_COLS + RW_OFF + col;
        const v2u z0 = *(const v2u*)zc;
        v2u zm = (v2u){0u, 0u}, zp = (v2u){0u, 0u};
        if (pos > 0) zm = *(const v2u*)(zc - IN_COLS);
        if (pos < n - 1) zp = *(const v2u*)(zc + IN_COLS);
        f32x4 v = (f32x4){bflo(zm.x), bfhi(zm.x), bflo(zm.y), bfhi(zm.y)} * w0 + (f32x4){bflo(z0.x), bfhi(z0.x), bflo(z0.y), bfhi(z0.y)} * w1 + (f32x4){bflo(zp.x), bfhi(zp.x), bflo(zp.y), bfhi(zp.y)} * w2 + cb;
#pragma unroll
        for (int e2 = 0; e2 < 4; ++e2) { if (j < 64) v[e2] = tanh_fast(v[e2]); else if (j >= 128) v[e2] = sigm(v[e2]); }
        v2u o; o.x = pk2(v[0], v[1]); o.y = pk2(v[2], v[3]);
        *(v2u*)(ARW + (size_t)row * 256 + j) = o;
    }
}

__device__ __forceinline__ void stage_rw_prep2(const Ctx& F, int l) {
    const auto& a = *F.a; unsigned char* ws = a.ws; const int lane = F.lane;
    const bf16* Z = (const bf16*)(ws + WS_Z); const bf16* P = (const bf16*)(ws + WS_P); bf16* SCN = (bf16*)(ws + WS_SCN);
    const int gw = F.bid * NWAVES + F.wave, NGW = F.G * NWAVES;
    constexpr int TR = 17, NRT = T_ALL / TR;
    const float* cw = a.in[I_RWCW] + (size_t)l * 3 * 1792; const float* cbp = a.in[I_RWCB] + l * 1792;
    for (int tile = gw; tile < NRT * 4; tile += NGW) {
        const int rt = tile % NRT, hp = tile / NRT, row0 = rt * TR, c0 = hp * 128 + 2 * lane;
        f32x2 w[3][3], cb[3];
#pragma unroll
        for (int s = 0; s < 3; ++s) { cb[s] = *(const f32x2*)(cbp + s * 512 + c0);
#pragma unroll
            for (int j = 0; j < 3; ++j) w[s][j] = *(const f32x2*)(cw + j * 1792 + s * 512 + c0); }
        const f32x2 KKw = *(const f32x2*)(a.in[I_RWKK] + l * 512 + c0), KAw = *(const f32x2*)(a.in[I_RWKA] + l * 512 + c0);
        f32x2 W0[2], A0[2];
#pragma unroll
        for (int d = 0; d < 2; ++d) { W0[d] = *(const f32x2*)(a.in[I_RWW0] + (l * 2 + d) * 512 + c0); A0[d] = *(const f32x2*)(a.in[I_RWA0] + (l * 2 + d) * 512 + c0); }
        const unsigned* zb = (const unsigned*)(Z + RW_OFF + c0);
        unsigned zw[8][3], pw_[8][4];
#define P2_LDZ(j_) do { const int rr_ = row0 + (j_); if (rr_ >= 0 && rr_ < T_ALL) { _Pragma("unroll") for (int s = 0; s < 3; ++s) zw[((j_) + 1) & 7][s] = zb[(size_t)rr_ * (IN_COLS / 2) + s * 256]; } \
        else { _Pragma("unroll") for (int s = 0; s < 3; ++s) zw[((j_) + 1) & 7][s] = 0u; } } while (0)
#define P2_LDP(j_) do { const unsigned* pr_ = (const unsigned*)(P + (size_t)(row0 + (j_)) * 2560 + c0); pw_[(j_) & 7][0] = pr_[0]; pw_[(j_) & 7][1] = pr_[512]; pw_[(j_) & 7][2] = pr_[256]; pw_[(j_) & 7][3] = pr_[768]; } while (0)
        P2_LDZ(-1); P2_LDZ(0); P2_LDZ(1); P2_LDZ(2); P2_LDZ(3); P2_LDP(0); P2_LDP(1); P2_LDP(2);
#pragma unroll
        for (int i = 0; i < TR; ++i) {
            const int row = row0 + i; int base, pos, n; row_seq(row, base, pos, n);
            if (i + 4 <= TR) P2_LDZ(i + 4);
            if (i + 3 < TR) P2_LDP(i + 3);
            unsigned zm[3], z0[3], zp[3], pc_[4];
#pragma unroll
            for (int s = 0; s < 3; ++s) { zm[s] = zw[i & 7][s]; z0[s] = zw[(i + 1) & 7][s]; zp[s] = zw[(i + 2) & 7][s]; }
#pragma unroll
            for (int e = 0; e < 4; ++e) pc_[e] = pw_[i & 7][e];
            const float mlo = pos > 0 ? 1.f : 0.f, mhi = pos < n - 1 ? 1.f : 0.f;
            f32x2 u[3];
#pragma unroll
            for (int s = 0; s < 3; ++s) u[s] = (f32x2){bflo(zm[s]), bfhi(zm[s])} * mlo * w[s][0] + (f32x2){bflo(z0[s]), bfhi(z0[s])} * w[s][1] + (f32x2){bflo(zp[s]), bfhi(zp[s])} * mhi * w[s][2] + cb[s];
            const f32x2 r = u[0], k = u[1], v = u[2];
            f32x2 kk = k * KKw;
            const float ss = red32(kk[0] * kk[0] + kk[1] * kk[1]);
            kk = kk * (__builtin_amdgcn_rsqf(fmaxf(ss, 1e-24f)));
            unsigned* o = (unsigned*)(SCN + (size_t)row * 9 * 512 + c0);
            o[0] = pk2(r[0], r[1]); o[256] = pk2(v[0], v[1]); o[2 * 256] = pk2(kk[0], kk[1]);
#pragma unroll
            for (int d = 0; d < 2; ++d) {
                const unsigned pw = pc_[2 * d], pa = pc_[2 * d + 1];
                float ld[2], kd[2], be[2];
#pragma unroll
                for (int e = 0; e < 2; ++e) {
                    const float uu = W0[d][e] + (e ? bfhi(pw) : bflo(pw));
                    ld[e] = -0.60653065971263342f * sigm(uu);
                    const float av = sigm(A0[d][e] + (e ? bfhi(pa) : bflo(pa)));
                    kd[e] = k[e] * (1.f + (av - 1.f) * KAw[e]); be[e] = kk[e] * av; }
                o[(3 + 3 * d) * 256] = pk2(ld[0], ld[1]); o[(4 + 3 * d) * 256] = pk2(kd[0], kd[1]); o[(5 + 3 * d) * 256] = pk2(be[0], be[1]);
            }
        }
    }
}
#undef P2_LDZ
#undef P2_LDP

__device__ __forceinline__ int seq_row(int b, int d, int sidx) {
    if (sidx < CTXL) { const int t = d ? (CTXL - 1 - sidx) : sidx; return T_LAT + b * CTXL + t; }
    const int tl = sidx - CTXL; const int t = d ? (SEQ - 1 - tl) : tl; return b * SEQ + t;
}

constexpr int CW_WORK = 16384;
constexpr int CW_STAMP = 20480;
#ifdef PROBE_T
#ifndef PROBE_BID
#define PROBE_BID 0
#endif
#define PT(k) do { if (F.bid == PROBE_BID && F.tid == 0 && l == 0) ((unsigned long long*)(F.a->ws + WS_CTL + CW_STAMP * 4))[k] = __builtin_amdgcn_s_memrealtime(); } while (0)
#else
#define PT(k) do { } while (0)
#endif
__device__ __forceinline__ void rw_scan_item(const Ctx& F, int l, int it2) {
    const int it = it2 >> 1, half = it2 & 1;
    const auto& a = *F.a; unsigned char* ws = a.ws; const int tid = F.tid, lane = F.lane;
    const bf16* SCN = (const bf16*)(ws + WS_SCN); float* YD = (float*)(ws + WS_YDIR);
    LAS float* sbuf = (LAS float*)F.lds;
    LAS float* ybuf = (LAS float*)(F.lds + 49152);
    const bool comp = F.wave < 4;
    const int lt = tid & 255, ls = lt >> 4, lj = lt & 15;
    const int vl = lane >> 3, kq = lane & 7, vrow = half * 32 + (F.wave & 3) * 8 + vl;
    constexpr int NCH = (CTXL + SEQ) / 16;
    const int d = it & 1, h = (it >> 1) & 7, b = it >> 4;
    f32x2 S[4];
#pragma unroll
    for (int q = 0; q < 4; ++q) S[q] = (f32x2){0.f, 0.f};
    v2u ldr[6];
#define RW_ISSUE(c) do { const int row_ = seq_row(b, d, (c) * 16 + ls); const v2u* p_ = (const v2u*)(SCN + (size_t)row_ * 9 * 512 + h * 64) + lj; \
        ldr[0] = p_[2 * 128]; ldr[1] = p_[(3 + 3 * d) * 128]; ldr[2] = p_[(5 + 3 * d) * 128]; ldr[3] = p_[(4 + 3 * d) * 128]; ldr[4] = p_[0]; ldr[5] = p_[128]; } while (0)
#define RW_WRITE(bufi) do { LAS float* o_ = sbuf + (((bufi) * 16 + ls) * 6) * 64 + 4 * lj; \
        *(LAS f32x4*)(o_) = (f32x4){-bflo(ldr[0].x), -bfhi(ldr[0].x), -bflo(ldr[0].y), -bfhi(ldr[0].y)}; \
        *(LAS f32x4*)(o_ + 64) = (f32x4){__expf(bflo(ldr[1].x)), __expf(bfhi(ldr[1].x)), __expf(bflo(ldr[1].y)), __expf(bfhi(ldr[1].y))}; \
        *(LAS f32x4*)(o_ + 128) = (f32x4){bflo(ldr[2].x), bfhi(ldr[2].x), bflo(ldr[2].y), bfhi(ldr[2].y)}; *(LAS f32x4*)(o_ + 192) = (f32x4){bflo(ldr[3].x), bfhi(ldr[3].x), bflo(ldr[3].y), bfhi(ldr[3].y)}; \
        *(LAS f32x4*)(o_ + 256) = (f32x4){bflo(ldr[4].x), bfhi(ldr[4].x), bflo(ldr[4].y), bfhi(ldr[4].y)}; *(LAS f32x4*)(o_ + 320) = (f32x4){bflo(ldr[5].x), bfhi(ldr[5].x), bflo(ldr[5].y), bfhi(ldr[5].y)}; } while (0)
#define RW_FLUSH(c) do { const int row_ = seq_row(b, d, (c) * 16 + ls); \
        *(f32x2*)(YD + ((size_t)d * T_ALL + row_) * 512 + h * 64 + half * 32 + 2 * lj) = *(const LAS f32x2*)(ybuf + ((((c) & 1) * 16 + ls) * 64) + half * 32 + 2 * lj); } while (0)
    if (!comp) { RW_ISSUE(0); RW_WRITE(0); RW_ISSUE(1); }
    __syncthreads();
#pragma unroll 1
    for (int c = 0; c < NCH; ++c) {
        const int bi = c & 1;
        if (!comp) {
            if (c + 1 < NCH) RW_WRITE(bi ^ 1);
            if (c + 2 < NCH) RW_ISSUE(c + 2);
            if (c > 0) RW_FLUSH(c - 1);
        } else {
        float yv[16];
        f32x4 opA[10], opB[10]; float vvA, vvB;
#define RW_LD(op, vvx, s_) do { const LAS float* sp_ = sbuf + ((bi * 16 + (s_)) * 6) * 64 + 8 * kq; \
            _Pragma("unroll") for (int q_ = 0; q_ < 5; ++q_) { op[2 * q_] = *(const LAS f32x4*)(sp_ + 64 * q_); op[2 * q_ + 1] = *(const LAS f32x4*)(sp_ + 64 * q_ + 4); } \
            vvx = sbuf[((bi * 16 + (s_)) * 6 + 5) * 64 + vrow]; } while (0)
#define RW_COMP(op, vvx, s_) do { \
            const f32x4 a0 = op[0], a1 = op[1], w0 = op[2], w1 = op[3], b0 = op[4], b1 = op[5], k0 = op[6], k1 = op[7], r0 = op[8], r1 = op[9]; \
            const f32x2 vv2 = (f32x2){vvx, vvx}; \
            const f32x2 p0 = S[1] * (f32x2){a0[2], a0[3]} + S[0] * (f32x2){a0[0], a0[1]}; \
            const f32x2 p1 = S[3] * (f32x2){a1[2], a1[3]} + S[2] * (f32x2){a1[0], a1[1]}; \
            const f32x2 t0 = S[0] * (f32x2){w0[0], w0[1]} + vv2 * (f32x2){k0[0], k0[1]}; \
            const f32x2 t1 = S[1] * (f32x2){w0[2], w0[3]} + vv2 * (f32x2){k0[2], k0[3]}; \
            const f32x2 t2 = S[2] * (f32x2){w1[0], w1[1]} + vv2 * (f32x2){k1[0], k1[1]}; \
            const f32x2 t3 = S[3] * (f32x2){w1[2], w1[3]} + vv2 * (f32x2){k1[2], k1[3]}; \
            const f32x2 ac = p0 + p1; \
            const float sa = red8(ac[0] + ac[1]); \
            const f32x2 sa2 = (f32x2){sa, sa}; \
            S[0] = sa2 * (f32x2){b0[0], b0[1]} + t0; S[1] = sa2 * (f32x2){b0[2], b0[3]} + t1; \
            S[2] = sa2 * (f32x2){b1[0], b1[1]} + t2; S[3] = sa2 * (f32x2){b1[2], b1[3]} + t3; \
            const f32x2 q0 = S[1] * (f32x2){r0[2], r0[3]} + S[0] * (f32x2){r0[0], r0[1]}; \
            const f32x2 q1 = S[3] * (f32x2){r1[2], r1[3]} + S[2] * (f32x2){r1[0], r1[1]}; \
            const f32x2 yc = q0 + q1; \
            yv[s_] = red8(yc[0] + yc[1]); } while (0)
        RW_LD(opA, vvA, 0);
#pragma unroll
        for (int s = 0; s < 16; s += 2) {
            RW_LD(opB, vvB, s + 1);
            __builtin_amdgcn_sched_barrier(0);
            RW_COMP(opA, vvA, s);
            __builtin_amdgcn_sched_barrier(0);
            if (s + 2 < 16) RW_LD(opA, vvA, s + 2);
            __builtin_amdgcn_sched_barrier(0);
            RW_COMP(opB, vvB, s + 1);
            __builtin_amdgcn_sched_barrier(0);
        }
#undef RW_LD
#undef RW_COMP
#pragma unroll
        for (int s = 0; s < 16; ++s) if ((s & 7) == kq) ybuf[((bi * 16 + s) * 64) + vrow] = yv[s];
        }
        __syncthreads();
    }
    if (!comp) RW_FLUSH(NCH - 1);
    __syncthreads();
#undef RW_ISSUE
#undef RW_WRITE
#undef RW_FLUSH
}

constexpr size_t WS_RWSCR = WS_YHY;
constexpr int RWS_QY = 0, RWS_YV = 2048, RWS_PZ = 4096, RWS_ZV = 12288, RWS_SLOT = 20480;
typedef __bf16 bf16x8n __attribute__((ext_vector_type(8)));
__device__ __forceinline__ f32x4 mma16(const bf16x8 a, const bf16x8 b, const f32x4 c) { return __builtin_amdgcn_mfma_f32_16x16x32_bf16(a, b, c, 0, 0, 0); }
__device__ __forceinline__ float dpp_shr(float x, const int n) {
    const int v = __builtin_bit_cast(int, x); int r;
    if (n == 1) r = __builtin_amdgcn_update_dpp(0, v, 0x111, 0xF, 0xF, true); else if (n == 2) r = __builtin_amdgcn_update_dpp(0, v, 0x112, 0xF, 0xF, true);
    else if (n == 4) r = __builtin_amdgcn_update_dpp(0, v, 0x114, 0xF, 0xF, true); else r = __builtin_amdgcn_update_dpp(0, v, 0x118, 0xF, 0xF, true);
    return __builtin_bit_cast(float, r);
}
__device__ __forceinline__ v4u pack8(const float (&x)[8]) { v4u o; o.x = pk2(x[0], x[1]); o.y = pk2(x[2], x[3]); o.z = pk2(x[4], x[5]); o.w = pk2(x[6], x[7]); return o; }
__device__ __forceinline__ void unpack8(const v4u u, float (&x)[8]) { x[0] = bflo(u.x); x[1] = bfhi(u.x); x[2] = bflo(u.y); x[3] = bfhi(u.y); x[4] = bflo(u.z); x[5] = bfhi(u.z); x[6] = bflo(u.w); x[7] = bfhi(u.w); }
constexpr int LDS_ZERO16 = 131072 + 3072;
typedef short bf16x4s __attribute__((ext_vector_type(4)));
__device__ __forceinline__ bf16x4s frag16k(const LAS bf16* m, int rowbase, int lane) { return __builtin_bit_cast(bf16x4s, *(const LAS v2u*)(m + (rowbase + (lane & 15)) * 16 + 4 * (lane >> 4))); }
__device__ __forceinline__ f32x4 mma16(const bf16x4s a, const bf16x4s b, const f32x4 c) { return __builtin_amdgcn_mfma_f32_16x16x16bf16_1k(a, b, c, 0, 0, 0); }
#define frag16(m_, rb_, ln_) frag16k(m_, rb_, ln_)
__device__ __forceinline__ void st_colmaj(LAS bf16* m, int colbase, const f32x4 d, int lane) {
    v2u o; o.x = pk2(d[0], d[1]); o.y = pk2(d[2], d[3]); *(LAS v2u*)(m + (colbase + (lane & 15)) * 16 + 4 * (lane >> 4)) = o; }
__device__ __forceinline__ void st_rowmaj(LAS bf16* m, const f32x4 d, int lane) {
#pragma unroll
    for (int r = 0; r < 4; ++r) m[(4 * (lane >> 4) + r) * 16 + (lane & 15)] = (bf16)f2bf(d[r]); }
template <int KS0, int KS1>
__device__ __forceinline__ void rw_chunk_load(const Ctx& F, int b, int h, int d, int cidx, v4u (&raw)[12]) {
    const int lane = opaque_v(F.lane), t = lane & 15, kg = lane >> 4;
    const bf16* base = (const bf16*)(F.a->ws + WS_SCN) + (size_t)seq_row(b, d, 16 * cidx + t) * 9 * 512 + h * 64;
#pragma unroll
    for (int ks = KS0; ks < KS1; ++ks) { const int off = 32 * ks + 8 * kg;
        raw[6 * ks + 0] = *(const v4u*)(base + (3 + 3 * d) * 512 + off); raw[6 * ks + 1] = *(const v4u*)(base + 2 * 512 + off); raw[6 * ks + 2] = *(const v4u*)(base + off);
        raw[6 * ks + 3] = *(const v4u*)(base + (5 + 3 * d) * 512 + off); raw[6 * ks + 4] = *(const v4u*)(base + (4 + 3 * d) * 512 + off); raw[6 * ks + 5] = *(const v4u*)(base + 512 + off); }
}
__device__ __forceinline__ void rw_chunk_task2(const Ctx& F, const v4u (&raw)[12], LAS unsigned char* wl, f32x4 (&yv)[4], f32x4 (&zv)[4][4]) {
    const int lane = opaque_v(F.lane), t = lane & 15, kg = lane >> 4;
    LAS bf16* ATt = (LAS bf16*)(wl); LAS bf16* RBr = (LAS bf16*)(wl + 2048); LAS bf16* BHt = (LAS bf16*)(wl + 4096); LAS bf16* KHt = (LAS bf16*)(wl + 6144); LAS bf16* VTt = (LAS bf16*)(wl + 8192);
    LAS bf16* WAt = (LAS bf16*)(wl + 10240); LAS bf16* N_r = (LAS bf16*)(wl + 12288); LAS bf16* N_c = (LAS bf16*)(wl + 12800); LAS bf16* T_r = (LAS bf16*)(wl + 13312);
    LAS bf16* AK_r = (LAS bf16*)(wl + 13824); LAS bf16* RB2 = (LAS bf16*)(wl + 14336); LAS bf16* RK_r = (LAS bf16*)(wl + 14848); LAS float* GCl = (LAS float*)(wl + 15360);
    bf16x8 fAb[2], fRb[2], fBb[2], fKb[2];
#pragma unroll
    for (int ks = 0; ks < 2; ++ks) {
        const int off = 32 * ks + 8 * kg;
        float ea[8], er[8], eb[8], eh[8];
        { const v4u uld = raw[6 * ks + 0]; float ld[8]; unpack8(uld, ld);
#pragma unroll
          for (int j = 0; j < 8; ++j) { float c = ld[j]; c += dpp_shr(c, 1); c += dpp_shr(c, 2); c += dpp_shr(c, 4); c += dpp_shr(c, 8);
              const float tot = __builtin_bit_cast(float, __builtin_amdgcn_ds_bpermute((lane | 15) << 2, __builtin_bit_cast(int, c)));
              ea[j] = __expf(c - ld[j]); er[j] = __expf(c); eb[j] = __expf(-c); const float et_ = __expf(tot); eh[j] = et_ * eb[j];
              if (t == 0) GCl[off + j] = et_; } }
        { const v4u u = raw[6 * ks + 1]; float x[8]; unpack8(u, x);
#pragma unroll
          for (int j = 0; j < 8; ++j) { x[j] = -x[j] * ea[j]; ATt[(off + j) * 16 + t] = (bf16)f2bf(x[j]); }
          const v4u p = pack8(x); fAb[ks] = __builtin_bit_cast(bf16x8, p); }
        { const v4u u = raw[6 * ks + 2]; float x[8]; unpack8(u, x);
#pragma unroll
          for (int j = 0; j < 8; ++j) x[j] = x[j] * er[j];
          const v4u p = pack8(x); fRb[ks] = __builtin_bit_cast(bf16x8, p); *(LAS v4u*)(RBr + t * 64 + off) = p; }
        { const v4u u = raw[6 * ks + 3]; float x[8], y[8]; unpack8(u, x);
#pragma unroll
          for (int j = 0; j < 8; ++j) { y[j] = x[j] * eb[j]; BHt[(off + j) * 16 + t] = (bf16)f2bf(x[j] * eh[j]); }
          const v4u p = pack8(y); fBb[ks] = __builtin_bit_cast(bf16x8, p); }
        { const v4u u = raw[6 * ks + 4]; float x[8], y[8]; unpack8(u, x);
#pragma unroll
          for (int j = 0; j < 8; ++j) { y[j] = x[j] * eb[j]; KHt[(off + j) * 16 + t] = (bf16)f2bf(x[j] * eh[j]); }
          const v4u p = pack8(y); fKb[ks] = __builtin_bit_cast(bf16x8, p); }
        { const v4u u = raw[6 * ks + 5];
          const bf16 e0 = (bf16)(u.x & 0xffff), e1 = (bf16)(u.x >> 16), e2 = (bf16)(u.y & 0xffff), e3 = (bf16)(u.y >> 16), e4 = (bf16)(u.z & 0xffff), e5 = (bf16)(u.z >> 16), e6 = (bf16)(u.w & 0xffff), e7 = (bf16)(u.w >> 16);
          VTt[(off + 0) * 16 + t] = e0; VTt[(off + 1) * 16 + t] = e1; VTt[(off + 2) * 16 + t] = e2; VTt[(off + 3) * 16 + t] = e3; VTt[(off + 4) * 16 + t] = e4; VTt[(off + 5) * 16 + t] = e5; VTt[(off + 6) * 16 + t] = e6; VTt[(off + 7) * 16 + t] = e7; }
        __builtin_amdgcn_sched_barrier(0);
    }
    asm volatile("" ::: "memory");
    const f32x4 z4 = (f32x4){0.f, 0.f, 0.f, 0.f};
    f32x4 n0 = mma16(fAb[1], fBb[1], mma16(fAb[0], fBb[0], z4)), aak = mma16(fAb[1], fKb[1], mma16(fAb[0], fKb[0], z4));
    f32x4 arb = mma16(fRb[1], fBb[1], mma16(fRb[0], fBb[0], z4)), ark = mma16(fRb[1], fKb[1], mma16(fRb[0], fKb[0], z4));
#pragma unroll
    for (int r = 0; r < 4; ++r) { const int tt = 4 * kg + r; if (!(t < tt)) { n0[r] = 0.f; aak[r] = 0.f; } if (!(t <= tt)) { arb[r] = 0.f; ark[r] = 0.f; } }
    st_rowmaj(AK_r, aak, lane); st_rowmaj(RB2, arb, lane); st_rowmaj(RK_r, ark, lane); asm volatile("" ::: "memory");
    f32x4 accT = n0;
#pragma unroll
    for (int r = 0; r < 4; ++r) accT[r] += (4 * kg + r == t) ? 1.f : 0.f;
    f32x4 nn = n0;
#pragma unroll
    for (int itn = 0; itn < 3; ++itn) {
        st_rowmaj(N_r, nn, lane); st_colmaj(N_c, 0, nn, lane); st_rowmaj(T_r, accT, lane); asm volatile("" ::: "memory");
        const auto fa = frag16(N_r, 0, lane), fb = frag16(N_c, 0, lane), ft = frag16(T_r, 0, lane);
        nn = mma16(fa, fb, z4); asm volatile("" ::: "memory");
        st_colmaj(N_c, 0, nn, lane); asm volatile("" ::: "memory");
        const auto fb2 = frag16(N_c, 0, lane);
        accT = mma16(ft, fb2, accT); asm volatile("" ::: "memory");
    }
    st_rowmaj(T_r, accT, lane); asm volatile("" ::: "memory");
    const auto fT = frag16(T_r, 0, lane), fAK = frag16(AK_r, 0, lane), fARB = frag16(RB2, 0, lane), fARK = frag16(RK_r, 0, lane);
#pragma unroll
    for (int kt = 0; kt < 4; ++kt) { const f32x4 dd = mma16(fT, frag16(ATt, 16 * kt, lane), z4); st_colmaj(WAt, 16 * kt, dd, lane); } asm volatile("" ::: "memory");
    f32x4 qy[4];
    { const auto fArbT = frag16(RB2, 0, lane);
#pragma unroll
      for (int kt = 0; kt < 4; ++kt) { const v2u ri = *(const LAS v2u*)(RBr + t * 64 + 16 * kt + 4 * kg);
          qy[kt] = mma16(frag16(WAt, 16 * kt, lane), fArbT, (f32x4){bflo(ri.x), bfhi(ri.x), bflo(ri.y), bfhi(ri.y)}); } }
    asm volatile("" ::: "memory");
#pragma unroll
    for (int vt = 0; vt < 4; ++vt) { const f32x4 dd = mma16(fAK, frag16(VTt, 16 * vt, lane), z4); st_colmaj(ATt, 16 * vt, dd, lane); } asm volatile("" ::: "memory");
    LAS bf16* UVt = RBr;
#pragma unroll
    for (int vt = 0; vt < 4; ++vt) { const f32x4 dd = mma16(fT, frag16(ATt, 16 * vt, lane), z4); st_colmaj(UVt, 16 * vt, dd, lane); } asm volatile("" ::: "memory");
#pragma unroll
    for (int vt = 0; vt < 4; ++vt) { const auto fU = frag16(UVt, 16 * vt, lane), fV = frag16(VTt, 16 * vt, lane);
        yv[vt] = mma16(fARK, fV, mma16(fARB, fU, z4));
#pragma unroll
        for (int ktp = 0; ktp < 4; ++ktp) zv[vt][ktp] = mma16(frag16(KHt, 16 * ktp, lane), fV, mma16(frag16(BHt, 16 * ktp, lane), fU, z4)); }
    f32x4 pz[4][4];
#pragma unroll
    for (int ktp = 0; ktp < 4; ++ktp) { const auto fBh = frag16(BHt, 16 * ktp, lane);
#pragma unroll
        for (int kt = 0; kt < 4; ++kt) { f32x4 dd = mma16(frag16(WAt, 16 * kt, lane), fBh, z4);
            if (kt == ktp) {
#pragma unroll
                for (int r = 0; r < 4; ++r) if (4 * kg + r == t) dd[r] += GCl[16 * kt + t]; }
            pz[ktp][kt] = dd; } }
    asm volatile("s_waitcnt lgkmcnt(0)" ::: "memory");
#pragma unroll
    for (int ktp = 0; ktp < 4; ++ktp) { LAS bf16* reg = (LAS bf16*)(wl + (ktp < 2 ? ktp * 2048 : (ktp + 1) * 2048));
#pragma unroll
        for (int kt = 0; kt < 4; ++kt) { v2u o; o.x = pk2(pz[ktp][kt][0], pz[ktp][kt][1]); o.y = pk2(pz[ktp][kt][2], pz[ktp][kt][3]); *(LAS v2u*)(reg + t * 64 + 16 * kt + 4 * kg) = o; } }
#pragma unroll
    for (int kt = 0; kt < 4; ++kt) { v2u o; o.x = pk2(qy[kt][0], qy[kt][1]); o.y = pk2(qy[kt][2], qy[kt][3]); *(LAS v2u*)(BHt + t * 64 + 16 * kt + 4 * kg) = o; }
    asm volatile("s_waitcnt lgkmcnt(0)" ::: "memory");
}
constexpr int RWZ_OFF = LDSCTL_OFF + 8192, RWF_OFF = LDSCTL_OFF + 2048;
__device__ __forceinline__ void rw_chunk_item2(const Ctx& F, int l, int it, size_t yoff = WS_YDIR) {
    const auto& a = *F.a; unsigned char* ws = a.ws; const int lane = opaque_v(F.lane), t = lane & 15, kg = lane >> 4;
    const int d = it & 1, h = (it >> 1) & 7, b = it >> 4;
    float* YD = (float*)(ws + yoff);
    LAS unsigned char* wl = F.lds + F.wave * 15616;
    LAS bf16* ZS = (LAS bf16*)(F.lds + RWZ_OFF);
    volatile LAS int* flag = (volatile LAS int*)(F.lds + RWF_OFF);
    for (int i = F.tid; i < 2048; i += NTHREADS) ((LAS unsigned*)ZS)[i] = 0u;
    if (F.tid == 0) *flag = 0;
    __syncthreads();
    constexpr int NCHK = (CTXL + SEQ) / 16;
    v4u raw[12];
    rw_chunk_load<0, 2>(F, b, h, d, F.wave, raw);
#pragma unroll 1
    for (int c = F.wave; c < NCHK; c += NWAVES) {
        f32x4 yv[4], zv[4][4];
        rw_chunk_task2(F, raw, wl, yv, zv);
        if (c + NWAVES < NCHK) rw_chunk_load<0, 2>(F, b, h, d, c + NWAVES, raw);
        while (*flag < c) __builtin_amdgcn_s_sleep(1);
        asm volatile("" ::: "memory");
        const LAS bf16* Zc = ZS + (c & 1) * 4096; LAS bf16* Zn = ZS + ((c + 1) & 1) * 4096;
        bf16x8 zb[4][2];
#pragma unroll
        for (int vb = 0; vb < 4; ++vb)
#pragma unroll
            for (int ks = 0; ks < 2; ++ks) zb[vb][ks] = *(const LAS bf16x8*)(Zc + (16 * vb + t) * 64 + 32 * ks + 8 * kg);
        { const LAS bf16* Qr = (const LAS bf16*)(wl + 4096); const bf16x8 q0 = *(const LAS bf16x8*)(Qr + t * 64 + 8 * kg), q1 = *(const LAS bf16x8*)(Qr + t * 64 + 32 + 8 * kg);
#pragma unroll
          for (int vb = 0; vb < 4; ++vb) { const f32x4 y = mma16(q1, zb[vb][1], mma16(q0, zb[vb][0], yv[vb]));
#pragma unroll
              for (int r = 0; r < 4; ++r) { const int row = seq_row(b, d, c * 16 + 4 * kg + r); YD[((size_t)d * T_ALL + row) * 512 + h * 64 + 16 * vb + t] = y[r]; } } }
#pragma unroll
        for (int ktp = 0; ktp < 4; ++ktp) { const LAS bf16* Pr = (const LAS bf16*)(wl + (ktp < 2 ? ktp * 2048 : (ktp + 1) * 2048));
            const bf16x8 p0 = *(const LAS bf16x8*)(Pr + t * 64 + 8 * kg), p1 = *(const LAS bf16x8*)(Pr + t * 64 + 32 + 8 * kg);
#pragma unroll
            for (int vb = 0; vb < 4; ++vb) { const f32x4 z = mma16(p1, zb[vb][1], mma16(p0, zb[vb][0], zv[vb][ktp]));
                v2u o; o.x = pk2(z[0], z[1]); o.y = pk2(z[2], z[3]); *(LAS v2u*)(Zn + (16 * vb + t) * 64 + 16 * ktp + 4 * kg) = o; } }
        asm volatile("s_waitcnt lgkmcnt(0)" ::: "memory");
        if (lane == 0) *flag = c + 1;
        asm volatile("s_waitcnt lgkmcnt(0)" ::: "memory");
    }
    __syncthreads();
}

__device__ __forceinline__ void stage_rw_readout(const Ctx& F, int l) {
    const auto& a = *F.a; unsigned char* ws = a.ws; const int lane = F.lane;
    const bf16* SCN = (const bf16*)(ws + WS_SCN); const bf16* P = (const bf16*)(ws + WS_P); const float* YD = (const float*)(ws + WS_YDIR); bf16* YRW = (bf16*)(ws + WS_YRW);
    const int gw = F.bid * NWAVES + F.wave, NGW = F.G * NWAVES;
    constexpr int TR = 17, NRT = T_ALL / TR;
    for (int tile = gw; tile < NRT * 4; tile += NGW) {
        const int rt = tile % NRT, hp = tile / NRT, row0 = rt * TR, c0 = hp * 128 + 2 * lane;
        const f32x2 rk = *(const f32x2*)(a.in[I_RWRK] + l * 512 + c0), lng = *(const f32x2*)(a.in[I_RWLNG] + l * 512 + c0), lnb = *(const f32x2*)(a.in[I_RWLNB] + l * 512 + c0);
        unsigned sw_[8][5]; f32x2 yw_[8][2];
#define RO_LD(j_) do { const int rr_ = row0 + (j_); const unsigned* sp_ = (const unsigned*)(SCN + (size_t)rr_ * 9 * 512 + c0); \
        sw_[(j_) & 7][0] = sp_[0]; sw_[(j_) & 7][1] = sp_[256]; sw_[(j_) & 7][2] = sp_[4 * 256]; sw_[(j_) & 7][3] = sp_[7 * 256]; sw_[(j_) & 7][4] = *(const unsigned*)(P + (size_t)rr_ * 2560 + 2048 + c0); \
        yw_[(j_) & 7][0] = *(const f32x2*)(YD + (size_t)rr_ * 512 + c0); yw_[(j_) & 7][1] = *(const f32x2*)(YD + ((size_t)T_ALL + rr_) * 512 + c0); } while (0)
        RO_LD(0); RO_LD(1); RO_LD(2);
#pragma unroll
        for (int i = 0; i < TR; ++i) {
            const int row = row0 + i;
            if (i + 3 < TR) RO_LD(i + 3);
            const unsigned ru = sw_[i & 7][0], vu = sw_[i & 7][1], k0u = sw_[i & 7][2], k1u = sw_[i & 7][3], gu = sw_[i & 7][4];
            const f32x2 y0 = yw_[i & 7][0], y1 = yw_[i & 7][1];
            const float bon = red32(bflo(ru) * (bflo(k0u) + bflo(k1u)) * rk[0] + bfhi(ru) * (bfhi(k0u) + bfhi(k1u)) * rk[1]);
            f32x2 y = y0 + y1 + (f32x2){bflo(vu), bfhi(vu)} * bon;
            const float mu = red32(y[0] + y[1]) * (1.f / 64.f);
            y = y - mu;
            const float var = red32(y[0] * y[0] + y[1] * y[1]) * (1.f / 64.f);
            const f32x2 yn = y * (__builtin_amdgcn_rsqf(var + 64e-5f));
            const f32x2 ov = (yn * lng + lnb) * (f32x2){bflo(gu), bfhi(gu)};
            *(unsigned*)(YRW + (size_t)row * 512 + c0) = pk2(ov[0], ov[1]);
        }
    }
}
#undef RO_LD

constexpr size_t WS_S5E = 6 * MiB;
constexpr int S5_NSEG = 4, S5_SEGLEN = (CTXL + SEQ) / S5_NSEG;
__device__ __forceinline__ void s5_disc(const float are, const float aim, const float dt, float& lbr, float& lbi, float& cr, float& ci) {
    const float mag = expf(are * dt); lbr = mag * cosf(aim * dt); lbi = mag * sinf(aim * dt);
    const float den = are * are + aim * aim, nr = lbr - 1.0f; cr = (nr * are + lbi * aim) / den; ci = (lbi * are - nr * aim) / den;
}
template <int PASS>
__device__ __forceinline__ void stage_s5_scan(const Ctx& F, int l, int item = -1) {
    const auto& a = *F.a; unsigned char* ws = a.ws; const int lane = F.lane;
    const bf16* Z = (const bf16*)(ws + WS_Z); bf16* YP = (bf16*)(ws + WS_YP); f32x2* S5E = (f32x2*)(ws + WS_S5E);
    LAS unsigned char* wl = F.lds + F.wave * 16384;
    LAS float* buL = (LAS float*)wl;
    LAS bf16* Hs = (LAS bf16*)(wl + 8704);
    const int fr = lane & 15, kg = lane >> 4;
    for (int itx = (item < 0 ? F.bid : item) * NWAVES + F.wave; itx < BATCH * 32 * 2 * S5_NSEG; itx += (item < 0 ? NWAVES * F.G : BATCH * 32 * 2 * S5_NSEG)) {
        const int seg = itx & (S5_NSEG - 1), it = itx >> 2;
        const int d = it & 1, g = (it >> 1) & 31, b = it >> 6, p = lane;
        const float dt = expf(a.in[I_S5LDT][(l * 2 + d) * 32 + g]);
        const float* arep = a.in[I_S5ARE] + ((size_t)(l * 2 + d) * 32 + g) * 64; const float* aimp = a.in[I_S5AIM] + ((size_t)(l * 2 + d) * 32 + g) * 64;
        float lbr, lbi, cr_, ci_; s5_disc(arep[p], aimp[p], dt, lbr, lbi, cr_, ci_);
        bf16x8 afr[2][4];
#pragma unroll
        for (int tl = 0; tl < 4; ++tl) { const int pp = 16 * tl + fr; float r0_, r1_, cr, ci; s5_disc(arep[pp], aimp[pp], dt, r0_, r1_, cr, ci);
            v4u pr = (v4u){0u, 0u, 0u, 0u}, pi = (v4u){0u, 0u, 0u, 0u};
            if (kg < 2) { const float* br = a.in[I_S5BRE] + (((size_t)l * 32 + g) * 64 + pp) * 16 + 8 * kg; const float* bi = a.in[I_S5BIM] + (((size_t)l * 32 + g) * 64 + pp) * 16 + 8 * kg;
                const f32x4 x0 = *(const f32x4*)br, x1 = *(const f32x4*)(br + 4), y0 = *(const f32x4*)bi, y1 = *(const f32x4*)(bi + 4);
                pr.x = pk2(cr * x0[0] - ci * y0[0], cr * x0[1] - ci * y0[1]); pr.y = pk2(cr * x0[2] - ci * y0[2], cr * x0[3] - ci * y0[3]);
                pr.z = pk2(cr * x1[0] - ci * y1[0], cr * x1[1] - ci * y1[1]); pr.w = pk2(cr * x1[2] - ci * y1[2], cr * x1[3] - ci * y1[3]);
                pi.x = pk2(cr * y0[0] + ci * x0[0], cr * y0[1] + ci * x0[1]); pi.y = pk2(cr * y0[2] + ci * x0[2], cr * y0[3] + ci * x0[3]);
                pi.z = pk2(cr * y1[0] + ci * x1[0], cr * y1[1] + ci * x1[1]); pi.w = pk2(cr * y1[2] + ci * x1[2], cr * y1[3] + ci * x1[3]); }
            afr[0][tl] = __builtin_bit_cast(bf16x8, pr); afr[1][tl] = __builtin_bit_cast(bf16x8, pi); }
        bf16x8 cf[4];
        f32x2 hst = (f32x2){0.f, 0.f};
        if (PASS == 1) {
#pragma unroll
            for (int kk = 0; kk < 4; ++kk) { const int p0 = 16 * kk + 4 * kg;
                const f32x4 c0 = *(const f32x4*)(a.in[I_S5CRE] + (((size_t)l * 32 + g) * 16 + fr) * 64 + p0), c1 = *(const f32x4*)(a.in[I_S5CIM] + (((size_t)l * 32 + g) * 16 + fr) * 64 + p0);
                v4u pk; pk.x = pk2(c0[0], -c1[0]); pk.y = pk2(c0[1], -c1[1]); pk.z = pk2(c0[2], -c1[2]); pk.w = pk2(c0[3], -c1[3]);
                cf[kk] = __builtin_bit_cast(bf16x8, pk); }
            float pr_ = lbr, pi_ = lbi, l64r = 1.f, l64i = 0.f;
#pragma unroll 1
            for (int q = 0; q < 10; ++q) { const float nr2 = pr_ * pr_ - pi_ * pi_, ni2 = 2.f * pr_ * pi_; pr_ = nr2; pi_ = ni2; if (q == 5) { l64r = pr_; l64i = pi_; } }
            const float lLr = pr_ * l64r - pi_ * l64i, lLi = pr_ * l64i + pi_ * l64r;
#pragma unroll 1
            for (int sgi = 0; sgi < seg; ++sgi) { const f32x2 ev = S5E[((size_t)it * S5_NSEG + sgi) * 64 + p];
                hst = (f32x2){lLr * hst[0] - lLi * hst[1] + ev[0], lLr * hst[1] + lLi * hst[0] + ev[1]}; }
        }
        const f32x2 lbr2 = (f32x2){lbr, lbr}, lbi2 = (f32x2){lbi, lbi};
        const int sbeg = seg * S5_SEGLEN, send = sbeg + S5_SEGLEN;
        v4u u0 = (v4u){0u, 0u, 0u, 0u}, u1 = u0, u2 = u0, u3 = u0;
#define S5_LOADU(dst_, s0_) do { const int sx_ = ((s0_) < send) ? (s0_) : (send - 16); const int row_ = seq_row(b, d, sx_ + fr); dst_ = *(const v4u*)(Z + (size_t)row_ * IN_COLS + S5_OFF + g * 16 + (kg & 1) * 8); } while (0)
#define S5_CHUNK(ux_, sc_) do { \
            { const v4u um_ = (kg < 2) ? ux_ : (v4u){0u, 0u, 0u, 0u}; const bf16x8 ufr = __builtin_bit_cast(bf16x8, um_); \
              _Pragma("unroll") for (int c = 0; c < 2; ++c) _Pragma("unroll") for (int tl = 0; tl < 4; ++tl) { \
                const f32x4 dd = __builtin_amdgcn_mfma_f32_16x16x32_bf16(afr[c][tl], ufr, (f32x4){0.f, 0.f, 0.f, 0.f}, 0, 0, 0); *(LAS f32x4*)(buL + (c * 16 + fr) * 68 + 16 * tl + 4 * kg) = dd; } } \
            S5_LOADU(ux_, (sc_) + 64); \
            LDS_WAIT(); asm volatile("" ::: "memory"); \
            f32x2 bu[16]; \
            _Pragma("unroll") for (int s = 0; s < 16; ++s) bu[s] = (f32x2){buL[s * 68 + p], buL[(16 + s) * 68 + p]}; \
            _Pragma("unroll") for (int s = 0; s < 16; ++s) { const float tr_ = __builtin_fmaf(-lbi, hst[1], bu[s][0]), ti_ = __builtin_fmaf(lbi, hst[0], bu[s][1]); \
                hst = (f32x2){__builtin_fmaf(lbr, hst[0], tr_), __builtin_fmaf(lbr, hst[1], ti_)}; \
                if (PASS == 1) *(LAS unsigned*)(Hs + s * 136 + 2 * p) = pg8::cvt_pk_bf16(hst[0], hst[1]); } \
            if (PASS == 1) { LDS_WAIT(); asm volatile("" ::: "memory"); \
                f32x4 acc = (f32x4){0.f, 0.f, 0.f, 0.f}; \
                _Pragma("unroll") for (int kk = 0; kk < 4; ++kk) { const bf16x8 af = *(const LAS bf16x8*)(Hs + fr * 136 + 32 * kk + 8 * kg); acc = __builtin_amdgcn_mfma_f32_16x16x32_bf16(af, cf[kk], acc, 0, 0, 0); } \
                { const int rowq_ = seq_row(b, d, (sc_) + 4 * kg); bf16* yq_ = YP + ((size_t)d * T_ALL + rowq_) * 512 + g * 16 + fr; const int st_ = d ? -512 : 512; \
                  _Pragma("unroll") for (int r = 0; r < 4; ++r) yq_[r * st_] = (bf16)f2bf(acc[r]); } } \
            LDS_WAIT(); asm volatile("" ::: "memory"); } while (0)
        S5_LOADU(u0, sbeg); S5_LOADU(u1, sbeg + 16); S5_LOADU(u2, sbeg + 32); S5_LOADU(u3, sbeg + 48);
#pragma unroll 1
        for (int s0 = sbeg; s0 < send; s0 += 64) { S5_CHUNK(u0, s0); S5_CHUNK(u1, s0 + 16); S5_CHUNK(u2, s0 + 32); S5_CHUNK(u3, s0 + 48); }
#undef S5_CHUNK
        if (PASS == 0) S5E[((size_t)it * S5_NSEG + seg) * 64 + p] = hst;
#undef S5_LOADU
    }
}

__device__ __forceinline__ void stage_s5_prep(const Ctx& F, int l, int nrows) {
    const auto& a = *F.a; unsigned char* ws = a.ws;
    const bf16* __restrict__ Z = (const bf16*)(ws + WS_Z); const bf16* __restrict__ YP = (const bf16*)(ws + WS_YP); bf16* __restrict__ AS5 = (bf16*)(ws + WS_AS5);
    const int c = 4 * (F.tid & 127), rq = F.tid >> 7;
    const f32x4 dsk = *(const f32x4*)(a.in[I_S5D] + l * 512 + c);
#pragma unroll 4
    for (int row = F.bid * 4 + rq; row < nrows; row += F.G * 4) {
        const v2u uz = *(const v2u*)(Z + (size_t)row * IN_COLS + S5_OFF + c);
        const v2u q0 = *(const v2u*)(YP + (size_t)row * 512 + c), q1 = *(const v2u*)(YP + ((size_t)T_ALL + row) * 512 + c);
        const f32x4 y0 = (f32x4){bflo(q0.x), bfhi(q0.x), bflo(q0.y), bfhi(q0.y)}, y1 = (f32x4){bflo(q1.x), bfhi(q1.x), bflo(q1.y), bfhi(q1.y)};
        const f32x4 u = (f32x4){bflo(uz.x), bfhi(uz.x), bflo(uz.y), bfhi(uz.y)};
        const f32x4 y = y0 + y1 + u * dsk;
        float ge[4];
#pragma unroll
        for (int j = 0; j < 4; ++j) ge[j] = 0.5f * y[j] * (1.f + tanh_fast(0.7978845608028654f * (y[j] + 0.044715f * y[j] * y[j] * y[j])));
        v2u o; o.x = pk2(ge[0], ge[1]); o.y = pk2(ge[2], ge[3]);
        *(v2u*)(AS5 + (size_t)row * 512 + c) = o;
    }
}

__device__ __forceinline__ void stage_hy_pre(const Ctx& F, int l, int nrows) {
    const auto& a = *F.a; unsigned char* ws = a.ws; const int lane = F.lane;
    const bf16* Z = (const bf16*)(ws + WS_Z); bf16* UT = (bf16*)(ws + WS_UT);
    LAS unsigned char* tl = F.lds + F.wave * 16384;
    const float* cw = a.in[I_HYCW] + (size_t)l * 3 * 1536; const float* cbp = a.in[I_HYCB] + l * 1536;
    const int gw = F.bid * NWAVES + F.wave, NGW = F.G * NWAVES;
    const int q = lane >> 3, k = lane & 7, ntile = (nrows / 64) * 24;
    v4u v[8], hv;
#define HYPRE_LOAD(tile_) do { const int rt_ = (tile_) / 24, ct_ = (tile_) % 24, row0_ = rt_ * 64; int base_, pos0_, n_; row_seq(row0_, base_, pos0_, n_); \
        const bf16* zt_ = Z + (size_t)row0_ * IN_COLS + HY_OFF + ct_ * 64 + 8 * k; hv = (v4u){0u, 0u, 0u, 0u}; \
        _Pragma("unroll") for (int i = 0; i < 8; ++i) v[i] = *(const v4u*)(zt_ + (size_t)(8 * i + q) * IN_COLS); \
        if (q == 0 && pos0_ > 0) hv = *(const v4u*)(zt_ - (size_t)IN_COLS); \
        if (q == 1 && pos0_ + 64 < n_) hv = *(const v4u*)(zt_ + (size_t)64 * IN_COLS); } while (0)
    if (gw < ntile) HYPRE_LOAD(gw);
#pragma unroll 1
    for (int tile = gw; tile < ntile; tile += NGW) {
        const int rt = tile / 24, ct = tile % 24, row0 = rt * 64, c0 = ct * 64;
        f32x4 wv[8];
#pragma unroll
        for (int i = 0; i < 8; ++i) { const int col = c0 + 8 * i + q; wv[i] = (f32x4){cw[col], cw[1536 + col], cw[2 * 1536 + col], cbp[col]}; }
#pragma unroll
        for (int i = 0; i < 8; ++i) { LAS unsigned* p = (LAS unsigned*)(tl + (1 + 8 * i + q) * 132 + 16 * k); p[0] = v[i].x; p[1] = v[i].y; p[2] = v[i].z; p[3] = v[i].w; }
        if (q < 2) { LAS unsigned* p = (LAS unsigned*)(tl + (q ? 65 : 0) * 132 + 16 * k); p[0] = hv.x; p[1] = hv.y; p[2] = hv.z; p[3] = hv.w; }
        if (tile + NGW < ntile) HYPRE_LOAD(tile + NGW);
        LDS_WAIT(); asm volatile("" ::: "memory");
#pragma unroll 2
        for (int i = 0; i < 8; ++i) {
            const int ch = 8 * i + q, col = c0 + ch;
            const LAS unsigned short* s = (const LAS unsigned short*)(tl + (8 * k) * 132 + ch * 2);
            float z[10];
#pragma unroll
            for (int t = 0; t < 10; ++t) z[t] = __builtin_bit_cast(float, (unsigned)s[t * 66] << 16);
            float o[8];
#pragma unroll
            for (int t = 0; t < 8; ++t) o[t] = wv[i][0] * z[t] + wv[i][1] * z[t + 1] + wv[i][2] * z[t + 2] + wv[i][3];
            v4u w; w.x = pk2(o[0], o[1]); w.y = pk2(o[2], o[3]); w.z = pk2(o[4], o[5]); w.w = pk2(o[6], o[7]);
            *(v4u*)(UT + (size_t)col * T_ALL + row0 + 8 * k) = w;
        }
        LDS_WAIT(); asm volatile("" ::: "memory");
    }
#undef HYPRE_LOAD
}
__device__ __forceinline__ void stage_hy_post(const Ctx& F, int l, int nrows) {
    const auto& a = *F.a; unsigned char* ws = a.ws; const int lane = F.lane;
    const bf16* YT = (const bf16*)(ws + WS_UT) + (size_t)1024 * T_ALL; bf16* YHY = (bf16*)(ws + WS_YHY);
    LAS unsigned char* tl = F.lds + F.wave * 16384;
    const int gw = F.bid * NWAVES + F.wave, NGW = F.G * NWAVES;
    const int q = lane >> 3, k = lane & 7, ntile = (nrows / 64) * 8;
    v4u v[8];
#define HYPOST_LOAD(tile_) do { const bf16* yp_ = YT + (size_t)(((tile_) & 7) * 64 + q) * T_ALL + ((tile_) >> 3) * 64 + 8 * k; \
        _Pragma("unroll") for (int i = 0; i < 8; ++i) v[i] = *(const v4u*)(yp_ + (size_t)(8 * i) * T_ALL); } while (0)
    if (gw < ntile) HYPOST_LOAD(gw);
#pragma unroll 1
    for (int tile = gw; tile < ntile; tile += NGW) {
        const int rt = tile >> 3, ct = tile & 7, row0 = rt * 64, c0 = ct * 64;
#pragma unroll
        for (int i = 0; i < 8; ++i) { LAS unsigned* p = (LAS unsigned*)(tl + (8 * i + q) * 132 + 16 * k); p[0] = v[i].x; p[1] = v[i].y; p[2] = v[i].z; p[3] = v[i].w; }
        if (tile + NGW < ntile) HYPOST_LOAD(tile + NGW);
        LDS_WAIT(); asm volatile("" ::: "memory");
#pragma unroll
        for (int i = 0; i < 8; ++i) { const int r = 8 * i + q;
            const LAS unsigned short* s = (const LAS unsigned short*)(tl + (8 * k) * 132 + r * 2);
            unsigned e[8];
#pragma unroll
            for (int j = 0; j < 8; ++j) e[j] = s[j * 66];
            v4u w; w.x = e[0] | (e[1] << 16); w.y = e[2] | (e[3] << 16); w.z = e[4] | (e[5] << 16); w.w = e[6] | (e[7] << 16);
            *(v4u*)(YHY + (size_t)(row0 + r) * 512 + c0 + 8 * k) = w; }
        LDS_WAIT(); asm volatile("" ::: "memory");
    }
#undef HYPOST_LOAD
}
typedef float f32x16 __attribute__((ext_vector_type(16)));
__device__ __forceinline__ void hyena_item(const Ctx& F, int l, int c, int isctx) {
    const auto& a = *F.a; unsigned char* ws = a.ws; const int tid = F.tid, lane = F.lane;
    const int n = isctx ? CTXL : SEQ, rowbase = isctx ? T_LAT : 0, RL = isctx ? HY_RLENC : HY_RLEN, off = n + 47;
    const bf16* UT = (const bf16*)(ws + WS_UT);
    const bf16* x1g = UT + (size_t)c * T_ALL + rowbase; const bf16* x2g = UT + (size_t)(512 + c) * T_ALL + rowbase; bf16* vg = (bf16*)UT + (size_t)(1024 + c) * T_ALL + rowbase;
    const bf16* Rg = (const bf16*)(ws + WS_GF + l * GF_STRIDE + (isctx ? GF_CTX : 0)) + (size_t)c * RL;
    LAS unsigned char* XB = F.lds; LAS unsigned char* R1 = F.lds + HY_R1_OFF; LAS unsigned char* R2 = F.lds + HY_R2_OFF;
    { const int cpb = n / 8;
      for (int q = tid; q < 8 * cpb; q += NTHREADS) { const int b = q / cpb, ch = q % cpb; *(LAS v4u*)(XB + b * HY_ROWB + 2 * HY_MARG + 16 * ch) = *(const v4u*)(vg + (size_t)b * n + 8 * ch); }
      if (tid < 256) { const int b = tid >> 5, side = (tid >> 4) & 1, ch = tid & 15; const unsigned zz = (unsigned)opaque_v(0); *(LAS v4u*)(XB + b * HY_ROWB + (side ? 2 * (HY_MARG + n) : 0) + 16 * ch) = (v4u){zz, zz, zz, zz}; }
      const int rch = RL / 8;
      for (int q = tid; q < rch; q += NTHREADS) { *(LAS v4u*)(R1 + 16 * q) = *(const v4u*)(Rg + 8 * q); *(LAS v4u*)(R2 + 16 * q) = *(const v4u*)(Rg + (size_t)512 * RL + 8 * q); } }
    __syncthreads();
    const int i = lane & 31, kg = lane >> 5, jb = lane & 3, bb = (lane & 31) >> 2;
    const int rsh = (off - i) & 7, rd = rsh >> 1; const bool s1 = rd & 1, s2 = rd & 2; const unsigned sh = (rsh & 1) ? 16u : 0u;
    const int aconst = 2 * (off - i + 8 * kg - rsh), bconst = bb * HY_ROWB + 2 * (HY_MARG + 32 * jb + 8 * kg);
    const int T0w = 512 * F.wave; const int ntile = (n - T0w) >= 512 ? 4 : ((n - T0w) > 0 ? (n - T0w) / 128 : 0);
    const float bias0 = a.in[I_HYBIAS][(l * 2 + 0) * 512 + c], bias1 = a.in[I_HYBIAS][(l * 2 + 1) * 512 + c];
    f32x16 acc[4];
    v2u y1p[4][4];
#define HY_AFRAG(wa, wb, afr) do { \
        const unsigned a0 = s1 ? wa.y : wa.x, a1 = s1 ? wa.z : wa.y, a2 = s1 ? wa.w : wa.z, a3 = s1 ? wb.x : wa.w, a4 = s1 ? wb.y : wb.x, a5 = s1 ? wb.z : wb.y, a6 = s1 ? wb.w : wb.z; \
        const unsigned b0 = s2 ? a2 : a0, b1 = s2 ? a3 : a1, b2 = s2 ? a4 : a2, b3 = s2 ? a5 : a3, b4 = s2 ? a6 : a4; \
        v4u af_; af_.x = __builtin_amdgcn_alignbit(b1, b0, sh); af_.y = __builtin_amdgcn_alignbit(b2, b1, sh); af_.z = __builtin_amdgcn_alignbit(b3, b2, sh); af_.w = __builtin_amdgcn_alignbit(b4, b3, sh); \
        afr = __builtin_bit_cast(bf16x8, af_); } while (0)
#define HY_STEP_COND(RB, d) do { \
        const v4u wa = *(const LAS v4u*)((RB) + aconst - 2 * (d)), wb = *(const LAS v4u*)((RB) + aconst - 2 * (d) + 16); bf16x8 afr; HY_AFRAG(wa, wb, afr); \
        _Pragma("unroll") for (int m = 0; m < 4; ++m) { const int T0 = T0w + 128 * m; \
            if (m < ntile && (d) >= T0 - n + 16 && (d) <= T0 + 96) { const bf16x8 bfr = *(const LAS bf16x8*)(XB + bconst + 2 * (T0 - (d))); \
                acc[m] = __builtin_amdgcn_mfma_f32_32x32x16_bf16(afr, bfr, acc[m], 0, 0, 0); } } } while (0)
#define HY_LOAD(RB, d, wa, wb, bq) do { wa = *(const LAS v4u*)((RB) + aconst - 2 * (d)); wb = *(const LAS v4u*)((RB) + aconst - 2 * (d) + 16); \
        _Pragma("unroll") for (int m = 0; m < 4; ++m) bq[m] = *(const LAS bf16x8*)(XB + bconst + 2 * (T0w + 128 * m - (d))); } while (0)
#define HY_MMA(wa, wb, bq) do { bf16x8 afr; HY_AFRAG(wa, wb, afr); \
        _Pragma("unroll") for (int m = 0; m < 4; ++m) acc[m] = __builtin_amdgcn_mfma_f32_32x32x16_bf16(afr, bq[m], acc[m], 0, 0, 0); } while (0)
#define HY_CONV(RB) do { \
        _Pragma("unroll") for (int m = 0; m < 4; ++m) _Pragma("unroll") for (int e = 0; e < 16; ++e) acc[m][e] = 0.f; \
        if (ntile == 4) { \
            const int dA = T0w - n + 16, dB = T0w + 384 - n + 16, dC = T0w + 96, dD = T0w + 384 + 96;     \
            _Pragma("unroll 1") for (int d = dA; d < dB; d += 16) HY_STEP_COND(RB, d); \
            { v4u waA, wbA, waB, wbB; bf16x8 bqA[4], bqB[4]; \
              HY_LOAD(RB, dB, waA, wbA, bqA); \
              _Pragma("unroll 1") for (int d = dB; d <= dC; d += 32) { \
                  if (d + 16 <= dC) HY_LOAD(RB, d + 16, waB, wbB, bqB); \
                  __builtin_amdgcn_sched_barrier(0); \
                  HY_MMA(waA, wbA, bqA); \
                  __builtin_amdgcn_sched_barrier(0); \
                  if (d + 32 <= dC) HY_LOAD(RB, d + 32, waA, wbA, bqA); \
                  __builtin_amdgcn_sched_barrier(0); \
                  if (d + 16 <= dC) HY_MMA(waB, wbB, bqB); \
                  __builtin_amdgcn_sched_barrier(0); } } \
            _Pragma("unroll 1") for (int d = dC + 16; d <= dD; d += 16) HY_STEP_COND(RB, d); \
        } else if (ntile > 0) { const int dhi = T0w + 128 * (ntile - 1) + 96; \
            _Pragma("unroll 1") for (int d = T0w - n + 16; d <= dhi; d += 16) HY_STEP_COND(RB, d); } } while (0)
    HY_CONV(R1);
#pragma unroll
    for (int m = 0; m < 4; ++m) if (m < ntile) {
#pragma unroll
        for (int rg = 0; rg < 4; ++rg) { const int t4 = T0w + 128 * m + 32 * jb + 8 * rg + 4 * kg;
            const v2u xv = *(const v2u*)(x1g + (size_t)bb * n + t4); const v2u vv = *(const LAS v2u*)(XB + bb * HY_ROWB + 2 * (HY_MARG + t4));
            const float y0 = bflo(xv.x) * (acc[m][4 * rg + 0] + bias0 * bflo(vv.x)), y1 = bfhi(xv.x) * (acc[m][4 * rg + 1] + bias0 * bfhi(vv.x));
            const float y2 = bflo(xv.y) * (acc[m][4 * rg + 2] + bias0 * bflo(vv.y)), y3 = bfhi(xv.y) * (acc[m][4 * rg + 3] + bias0 * bfhi(vv.y));
            y1p[m][rg].x = pk2(y0, y1); y1p[m][rg].y = pk2(y2, y3); } }
    __syncthreads();
#pragma unroll
    for (int m = 0; m < 4; ++m) if (m < ntile) {
#pragma unroll
        for (int rg = 0; rg < 4; ++rg) { const int t4 = T0w + 128 * m + 32 * jb + 8 * rg + 4 * kg; *(LAS v2u*)(XB + bb * HY_ROWB + 2 * (HY_MARG + t4)) = y1p[m][rg]; } }
    __syncthreads();
    HY_CONV(R2);
#pragma unroll
    for (int m = 0; m < 4; ++m) if (m < ntile) {
#pragma unroll
        for (int rg = 0; rg < 4; ++rg) { const int t4 = T0w + 128 * m + 32 * jb + 8 * rg + 4 * kg;
            const v2u xv = *(const v2u*)(x2g + (size_t)bb * n + t4); const v2u yv = y1p[m][rg];
            const float o0 = bflo(xv.x) * (acc[m][4 * rg + 0] + bias1 * bflo(yv.x)), o1 = bfhi(xv.x) * (acc[m][4 * rg + 1] + bias1 * bfhi(yv.x));
            const float o2 = bflo(xv.y) * (acc[m][4 * rg + 2] + bias1 * bflo(yv.y)), o3 = bfhi(xv.y) * (acc[m][4 * rg + 3] + bias1 * bfhi(yv.y));
            v2u ov; ov.x = pk2(o0, o1); ov.y = pk2(o2, o3); *(v2u*)(vg + (size_t)bb * n + t4) = ov; } }
    __syncthreads();
#undef HY_CONV
#undef HY_AFRAG
#undef HY_STEP_COND
#undef HY_LOAD
#undef HY_MMA
}
__device__ __forceinline__ void stage_mixer(const Ctx& F, int l) {
    unsigned* ctr = (unsigned*)(F.a->ws + WS_CTL) + CW_WORK + 64 * l;
    LAS int* itb = (LAS int*)(F.lds + LDSCTL_OFF + 512);
    constexpr int NS5 = BATCH * 32 * 2 * S5_NSEG / NWAVES;
    const int nit = 128 + NS5 + 512 + (l == 0 ? 512 : 0);
#ifdef PROBE_STATIC
    return;
#endif
    for (;;) {
        if (F.tid == 0) *itb = (int)__hip_atomic_fetch_add(ctr, 1u, __ATOMIC_RELAXED, __HIP_MEMORY_SCOPE_AGENT);
        __syncthreads();
        const int it = *itb;
        __syncthreads();
        if (it >= nit) break;
        Ctx Fi; Fi.a = kargs(); Fi.tid = opaque_v((int)threadIdx.x); Fi.lane = Fi.tid & 63; Fi.wave = __builtin_amdgcn_readfirstlane(Fi.tid >> 6); Fi.bid = opaque((int)blockIdx.x); Fi.G = opaque((int)gridDim.x);
        Fi.lds = (LAS unsigned char*)((LAS unsigned char*)0 + opaque(0)) + (F.lds - (LAS unsigned char*)0);
#ifdef PROBE_T
        if (l == 0 && F.tid == 0 && it == 5) ((unsigned long long*)(F.a->ws + WS_CTL + CW_STAMP * 4))[21] = __builtin_amdgcn_s_memrealtime();
        if (l == 0 && F.tid == 0 && it == 300) ((unsigned long long*)(F.a->ws + WS_CTL + CW_STAMP * 4))[23] = __builtin_amdgcn_s_memrealtime();
#endif
        if (it < 128) { for (int rep = 0; rep < ((DUPK == 9) ? 2 : 1); ++rep) rw_chunk_item2(Fi, opaque(l), it); }
        else if (it < 128 + NS5) stage_s5_scan<1>(Fi, opaque(l), it - 128);
        else if (it < 640 + NS5) hyena_item(Fi, opaque(l), it - 128 - NS5, 0);
        else hyena_item(Fi, opaque(l), it - 640 - NS5, 1);
#ifdef PROBE_T
        if (l == 0 && F.tid == 0 && it == 5) ((unsigned long long*)(F.a->ws + WS_CTL + CW_STAMP * 4))[22] = __builtin_amdgcn_s_memrealtime();
        if (l == 0 && F.tid == 0 && it == 300) ((unsigned long long*)(F.a->ws + WS_CTL + CW_STAMP * 4))[24] = __builtin_amdgcn_s_memrealtime();
#endif
    }
}

typedef float f32x16r __attribute__((ext_vector_type(16)));
__device__ __forceinline__ void stage_norm2_router(const Ctx& F, int l, int nrows) {
    const auto& a = *F.a; unsigned char* ws = a.ws; const int lane = F.lane;
    const float* X = (const float*)(ws + WS_X); bf16* H = (bf16*)(ws + WS_H); const float* MOD = (const float*)(ws + WS_MOD);
    int* EIDX = (int*)(ws + WS_EIDX); float* GATE = (float*)(ws + WS_GATE); int* POS = (int*)(ws + WS_POS); unsigned* ROWOF = (unsigned*)(ws + WS_ROWOF);
    LAS int* lex = (LAS int*)(F.lds + 40960); LAS int* lrk = lex + 2048; LAS int* offl = lrk + 2048;
    LAS float* lg = (LAS float*)(F.lds + F.wave * 4352);
    LAS int* hist = (LAS int*)(F.lds + LDSCTL_OFF + 1024);
    if (F.tid < 32) hist[F.tid] = 0;
    __syncthreads();
    const int rpb = (nrows + F.G - 1) / F.G, r0 = F.bid * rpb, r1 = (r0 + rpb < nrows) ? r0 + rpb : nrows;
    const float* rw = a.in[I_RTW] + (size_t)l * 1024 * 32;
    const int i = lane & 31, kk = lane >> 5;
    const f32x4* ng = (const f32x4*)(a.in[I_N2G] + l * D) + kk;
    for (int rb = r0 + F.wave * 32; rb < r1; rb += NWAVES * 32) {
        const int nrow = (r1 - rb) < 32 ? (r1 - rb) : 32; const bool live = i < nrow;
        const int row = live ? rb + i : r1 - 1; const int w = row < T_LAT ? (row >> 12) : 8;
        const f32x4* xr = (const f32x4*)(X + (size_t)row * D) + kk;
        float ss = 0.f;
#pragma unroll 16
        for (int q = 0; q < 128; ++q) { const f32x4 v = xr[2 * q]; ss += (v[0] * v[0] + v[1] * v[1]) + (v[2] * v[2] + v[3] * v[3]); }
        ss += __builtin_bit_cast(float, __builtin_amdgcn_ds_bpermute((lane ^ 32) << 2, __builtin_bit_cast(int, ss)));
        const float rstd = __builtin_amdgcn_rsqf(ss * (1.f / D) + 1e-6f);
        const f32x4* sh = (const f32x4*)(MOD + (size_t)(l * 9 + w) * 6144 + 3072) + kk; const f32x4* sc = (const f32x4*)(MOD + (size_t)(l * 9 + w) * 6144 + 4096) + kk;
        v2u* ho = (v2u*)(H + (size_t)row * D) + kk;
        f32x16r acc;
#pragma unroll
        for (int e = 0; e < 16; ++e) acc[e] = 0.f;
        const float* wp = rw + (size_t)(4 * kk) * 32 + i;
        f32x4 xn[4], gn_[4], cn_[4], sn_[4], wn_[4];
#define RT_LOAD(q0_) do { _Pragma("unroll") for (int u_ = 0; u_ < 4; ++u_) { const int q_ = (q0_) + u_; xn[u_] = xr[2 * q_]; gn_[u_] = ng[2 * q_]; cn_[u_] = sc[2 * q_]; sn_[u_] = sh[2 * q_]; \
            wn_[u_] = (f32x4){wp[(size_t)(8 * q_) * 32], wp[(size_t)(8 * q_ + 1) * 32], wp[(size_t)(8 * q_ + 2) * 32], wp[(size_t)(8 * q_ + 3) * 32]}; } } while (0)
        RT_LOAD(0);
#pragma unroll 1
        for (int q0 = 0; q0 < 128; q0 += 4) {
            f32x4 xc[4], gc_[4], cc_[4], sc_[4], wc_[4];
#pragma unroll
            for (int u = 0; u < 4; ++u) { xc[u] = xn[u]; gc_[u] = gn_[u]; cc_[u] = cn_[u]; sc_[u] = sn_[u]; wc_[u] = wn_[u]; }
            if (q0 + 4 < 128) RT_LOAD(q0 + 4);
#pragma unroll
            for (int u = 0; u < 4; ++u) { const int q = q0 + u;
                const f32x4 h4 = xc[u] * rstd * gc_[u] * (cc_[u] + 1.0f) + sc_[u];
                if (live) { v2u o; o.x = pk2(h4[0], h4[1]); o.y = pk2(h4[2], h4[3]); ho[2 * q] = o; }
                acc = __builtin_amdgcn_mfma_f32_32x32x2f32(h4[0], wc_[u][0], acc, 0, 0, 0);
                acc = __builtin_amdgcn_mfma_f32_32x32x2f32(h4[1], wc_[u][1], acc, 0, 0, 0);
                acc = __builtin_amdgcn_mfma_f32_32x32x2f32(h4[2], wc_[u][2], acc, 0, 0, 0);
                acc = __builtin_amdgcn_mfma_f32_32x32x2f32(h4[3], wc_[u][3], acc, 0, 0, 0); }
        }
#undef RT_LOAD
        const float rbias = a.in[I_RTB][l * 32 + i];
#pragma unroll
        for (int r = 0; r < 16; ++r) { const int ri = (r & 3) + 8 * (r >> 2) + 4 * kk; lg[ri * 33 + i] = acc[r] + rbias; }
        LDS_WAIT(); asm volatile("" ::: "memory");
        if (lane < nrow) {
            LAS float* lr = lg + lane * 33; const int orow = rb + lane;
            float tv[4]; int ti[4];
#pragma unroll
            for (int r = 0; r < 4; ++r) { float bv = -INFINITY; int bi = 0;
#pragma unroll 8
                for (int e = 0; e < 32; ++e) { const float v = lr[e]; if (v > bv) { bv = v; bi = e; } }
                tv[r] = bv; ti[r] = bi; lr[bi] = -INFINITY; }
            const float e1 = expf(tv[1] - tv[0]), e2 = expf(tv[2] - tv[0]), e3 = expf(tv[3] - tv[0]); const float inv = 1.0f / (1.0f + e1 + e2 + e3);
            *(int4*)(EIDX + orow * 4) = make_int4(ti[0], ti[1], ti[2], ti[3]); *(f32x4*)(GATE + orow * 4) = (f32x4){inv, e1 * inv, e2 * inv, e3 * inv};
#pragma unroll
            for (int r = 0; r < 4; ++r) { const int rk = __hip_atomic_fetch_add(&hist[ti[r]], 1, __ATOMIC_RELAXED, __HIP_MEMORY_SCOPE_WORKGROUP); lex[(orow - r0) * 4 + r] = ti[r]; lrk[(orow - r0) * 4 + r] = rk; }
        }
        LDS_WAIT(); asm volatile("" ::: "memory");
    }
    __syncthreads();
    if (F.tid < 32) { const int c = hist[F.tid]; offl[F.tid] = c ? (int)__hip_atomic_fetch_add((unsigned*)(ws + WS_CTL) + CW_CNT + 64 * l + F.tid, (unsigned)c, __ATOMIC_RELAXED, __HIP_MEMORY_SCOPE_AGENT) : 0; }
    __syncthreads();
    for (int i = F.tid; i < (r1 > r0 ? (r1 - r0) * 4 : 0); i += NTHREADS) { const int e = lex[i], pos = offl[e] + lrk[i];
        POS[r0 * 4 + i] = pos; ROWOF[(size_t)e * pg8::MOE_CAP + pos] = (unsigned)(r0 + (i >> 2)) * (unsigned)(D * 2); }
    __syncthreads();
}

__device__ __forceinline__ LAS int* load_moe_base(const Ctx& F, int l) {
    LAS int* base = (LAS int*)(F.lds + LDSCTL_OFF + 256);
    if (F.tid < 32) base[64 + F.tid] = (int)__hip_atomic_load((unsigned*)(F.a->ws + WS_CTL) + CW_CNT + 64 * l + F.tid, __ATOMIC_RELAXED, __HIP_MEMORY_SCOPE_AGENT);
    __syncthreads();
    if (F.tid == 0) { int acc = 0; for (int e = 0; e < 32; ++e) { base[e] = acc; acc += (base[64 + e] + 255) & ~255; } base[32] = acc; }
    __syncthreads();
    return base;
}
__device__ __forceinline__ void moe_fix_pos(const Ctx& F, int nrows, const LAS int* base) {
    unsigned char* ws = F.a->ws; const int* EIDX = (const int*)(ws + WS_EIDX); int* POS = (int*)(ws + WS_POS);
    const int rpb = (nrows + F.G - 1) / F.G, r0 = F.bid * rpb, r1 = (r0 + rpb < nrows) ? r0 + rpb : nrows;
    for (int i = F.tid; i < (r1 > r0 ? (r1 - r0) * 4 : 0); i += NTHREADS) POS[r0 * 4 + i] += base[EIDX[r0 * 4 + i]];
}

constexpr int NSTAGE_L = 13, NSTAGES = 1 + DEPTH * NSTAGE_L + 1;
__global__ void __launch_bounds__(NTHREADS, 2) mk_fwd(Args args) {
    extern __shared__ __attribute__((aligned(16))) unsigned char lds_raw[];
    Ctx F; F.a = kargs(); F.lds = (LAS unsigned char*)lds_raw; F.tid = threadIdx.x; F.lane = F.tid & 63; F.wave = __builtin_amdgcn_readfirstlane(F.tid >> 6); F.bid = blockIdx.x; F.G = gridDim.x;
    volatile LAS unsigned* MISC = (volatile LAS unsigned*)(F.lds + LDSCTL_OFF);
    for (int u = F.tid; u < (LDS_BYTES - LDSCTL_OFF) / 4; u += NTHREADS) ((LAS unsigned*)(F.lds + LDSCTL_OFF))[u] = 0u;
    __syncthreads();
#if MK_PER_STAGE
#define GRID_BAR() do { } while (0)
#else
    (void)xcd_barrier_post((unsigned*)(F.a->ws + WS_CTL) + CW_BAR, MISC + 8);
#define GRID_BAR() do { XcdBarrier b_; b_.bar = (unsigned*)(kargs()->ws + WS_CTL) + CW_BAR; b_.x = xb_xcc_id(); b_.st = (volatile LAS unsigned*)((LAS unsigned char*)lds_raw + LDSCTL_OFF + opaque(32)); xcd_barrier(b_); } while (0)
#endif
#ifndef ONLY_S
#define ONLY_S -1
#endif
#define STG_SEL(k) (ONLY_S < 0 || ONLY_S == (((k) == 0) ? 0 : ((k) == NSTAGES - 1 ? 14 : (((k) - 1) % NSTAGE_L) + 1)))
#if MK_PER_STAGE
#define IN(k) (STG_SEL(k) && kargs()->ph_lo == (k))
#else
#define IN(k) STG_SEL(k)
#endif
#if MK_PER_STAGE
#define SEAM(k) do { } while (0)
#else
#define SEAM(k) do { if ((k) + 1 < NSTAGES) GRID_BAR(); } while (0)
#endif
#define STAGE(k) if (IN(k)) { F.a = kargs(); F.tid = opaque_v((int)threadIdx.x); F.lane = F.tid & 63; F.wave = __builtin_amdgcn_readfirstlane(F.tid >> 6); F.bid = opaque((int)blockIdx.x); F.G = opaque((int)gridDim.x); F.lds = (LAS unsigned char*)lds_raw + opaque(0); unsigned char* ws = F.a->ws; const int l = opaque(lq); unsigned char* wl = ws + WS_WTS + (size_t)l * WL_STRIDE; (void)wl; (void)ws;
#define STAGE_END(k) } SEAM(k);
    int lq = 0;
    STAGE(0) p0_prologue(F); STAGE_END(0)
    for (lq = 0; lq < DEPTH; ++lq) {
        const int sb = 1 + lq * NSTAGE_L;
        const int nrl = opaque((lq == DEPTH - 1) ? T_LAT : T_ALL);
        STAGE(sb + 0) if (l == 0) stage_xinit_norm1(F); else stage_norm1(F, l); STAGE_END(sb + 0)
        STAGE(sb + 1) pg8::SchedWin S; S.A = (const char*)(ws + WS_H); S.Bt = (const char*)(wl + WO_WIN); S.tstep = (size_t)256 * 1024 * 2; S.G = F.G; S.c = F.bid; S.part = (nrl != T_ALL); pg8::EpiBf16 E{(bf16*)(ws + WS_Z), IN_COLS, nullptr, 0};
            pg8::gemm_phase(F.lds, F.tid, 1024, S, E); STAGE_END(sb + 1)
        STAGE(sb + 2) for (int rep = 0; rep < REPN(1); ++rep) stage_rw_prep1(F, l); for (int rep = 0; rep < REPN(2); ++rep) stage_s5_scan<0>(F, l); for (int rep = 0; rep < REPN(3); ++rep) stage_hy_pre(F, l, nrl); STAGE_END(sb + 2)
        STAGE(sb + 3) { pg8::SchedP S; S.A = (const char*)(ws + WS_ARW); S.Bt = (const char*)(wl + WO_RWCAT); S.tstep = (size_t)256 * 256 * 2; S.nM = T_ALL / 256; S.G = F.G; S.c = F.bid; pg8::EpiBf16 E{(bf16*)(ws + WS_P), 2560, nullptr, 0}; pg8::gemm_phase(F.lds, F.tid, 256, S, E, 2); }
            F.tid = opaque_v((int)threadIdx.x); F.lane = F.tid & 63;
            STAGE_END(sb + 3)
        STAGE(sb + 4) for (int rep = 0; rep < REPN(5); ++rep) stage_rw_prep2(F, l); STAGE_END(sb + 4)
        STAGE(sb + 5) PT(10); stage_mixer(F, l); PT(11); STAGE_END(sb + 5) STAGE(sb + 5) PT(12); }
        STAGE(sb + 6) stage_s5_prep(F, l, nrl); STAGE_END(sb + 6)
        STAGE(sb + 7) { pg8::SchedStatic S; S.init(ws + WS_AS5, wl + WO_GLU, nrl, 1024, 512, F.G, F.bid); pg8::EpiGlu<0> E{(bf16*)(ws + WS_YS5), 512, F.a->in[I_S5GLUB] + l * 1024, 0, 512}; PT(13); pg8::gemm_phase(F.lds, F.tid, 512, S, E); PT(14); }
            for (int rep = 0; rep < REPN(7); ++rep) stage_rw_readout(F, l); for (int rep = 0; rep < REPN(8); ++rep) stage_hy_post(F, l, nrl); STAGE_END(sb + 7)
        STAGE(sb + 8) pg8::SchedMerge S; S.A0 = (const char*)(ws + WS_YHY); S.A1 = (const char*)(ws + WS_YRW); S.A2 = (const char*)(ws + WS_YS5); S.Bt = (const char*)(wl + WO_WBR); S.tstep = (size_t)256 * 512 * 2; S.bstride = (size_t)1024 * 512 * 2;
            S.nM = nrl / 256; S.nN = 4; S.G = F.G; S.c = F.bid;
            pg8::EpiMerge E{(bf16*)(ws + WS_MTMP), (bf16*)(ws + WS_H), (const bf16*)(ws + WS_Z) + GATE_OFF}; pg8::gemm_phase(F.lds, F.tid, 512, S, E); STAGE_END(sb + 8)
        STAGE(sb + 9) pg8::SchedStatic S; S.init(ws + WS_H, wl + WO_WOUT, nrl, 1024, 1024, F.G, F.bid); pg8::EpiResid E{(float*)(ws + WS_X), (const float*)(ws + WS_MOD) + (size_t)l * 9 * 6144 + 2048};
            pg8::gemm_phase(F.lds, F.tid, 1024, S, E); STAGE_END(sb + 9)
        STAGE(sb + 10) PT(17); stage_norm2_router(F, l, nrl); PT(18); STAGE_END(sb + 10)
        STAGE(sb + 11) LAS int* base = load_moe_base(F, l); moe_fix_pos(F, nrl, base);
            pg8::SchedMoeG S; S.A = (const char*)(ws + WS_H); S.rowof = (const unsigned*)(ws + WS_ROWOF); S.Bt = (const char*)(wl + WO_W1); S.tstep = (size_t)256 * 1024 * 2; S.estride = (size_t)2048 * 1024 * 2; S.NPN = 8; S.G = F.G; S.c = F.bid; S.base = base;
            pg8::EpiGlu<1> E{(bf16*)(ws + WS_ACT), 1024, F.a->in[I_B1] + (size_t)l * 32 * 2048, 2048, 1024}; pg8::gemm_phase(F.lds, F.tid, 1024, S, E); STAGE_END(sb + 11)
        STAGE(sb + 12) LAS int* base = load_moe_base(F, l);
            pg8::SchedMoe S; S.A = (const char*)(ws + WS_ACT); S.Bt = (const char*)(wl + WO_W2); S.tstep = (size_t)256 * 1024 * 2; S.estride = (size_t)1024 * 1024 * 2; S.NPN = 4; S.G = F.G; S.c = F.bid; S.base = base;
            pg8::EpiBf16 E{(bf16*)(ws + WS_XS), 1024, F.a->in[I_B2] + (size_t)l * 32 * 1024, 1024}; pg8::gemm_phase(F.lds, F.tid, 1024, S, E); STAGE_END(sb + 12)
    }
    lq = DEPTH;
    STAGE(NSTAGES - 1)
#ifndef PROBE_T
        stage_norm1(F, l);
#endif
#ifdef PROBE_T
        { const unsigned long long* st = (const unsigned long long*)(F.a->ws + WS_CTL + CW_STAMP * 4); const float cval = (float)(long long)(st[PROBE_B] - st[PROBE_A]) * (1.0f / (100.0f * PROBE_DIV));
          __syncthreads(); for (size_t i = (size_t)F.bid * NTHREADS + F.tid; i < (size_t)T_LAT * D; i += (size_t)F.G * NTHREADS) F.a->out[i] = cval; }
#endif
    }
#undef IN
#undef SEAM
}

extern "C" void kernel_launch(void* const* d_in, const int* in_sizes, int n_in, void* d_out, int out_size, void* d_ws, size_t ws_size, hipStream_t stream) {
    static int grid = 0;
    if (grid == 0) {
        if (n_in != 51 || out_size != T_LAT * D || ws_size < WS_END) { fprintf(stderr, "kernel_launch: unexpected shapes (n_in %d out %d ws %zu, need %zu)\n", n_in, out_size, ws_size, (size_t)WS_END); grid = -1; return; }
        int dev = 0, cus = 0, per_cu = 0;
        if (hipGetDevice(&dev) != hipSuccess || hipDeviceGetAttribute(&cus, hipDeviceAttributeMultiprocessorCount, dev) != hipSuccess) { grid = -1; return; }
        if (hipFuncSetAttribute((const void*)mk_fwd, hipFuncAttributeMaxDynamicSharedMemorySize, LDS_BYTES) != hipSuccess) { fprintf(stderr, "kernel_launch: hipFuncSetAttribute failed\n"); grid = -1; return; }
        if (hipOccupancyMaxActiveBlocksPerMultiprocessor(&per_cu, (const void*)mk_fwd, NTHREADS, LDS_BYTES) != hipSuccess || per_cu < 1) fprintf(stderr, "kernel_launch: occupancy query says %d\n", per_cu);
        (void)hipGetLastError();
        grid = cus;
    }
    if (grid < 0) return;
    if (hipMemsetAsync((char*)d_ws + WS_CTL, 0, CTL_ZERO_BYTES, stream) != hipSuccess) return;
    Args a{};
    for (int i = 0; i < 51; ++i) a.in[i] = (const float*)d_in[i];
    a.out = (float*)d_out; a.ws = (unsigned char*)d_ws;
#if MK_PER_STAGE
    for (int s = 0; s < NSTAGES; ++s) { a.ph_lo = s; a.ph_hi = s + 1; int reps = 1;
#ifdef PROBE_SET
        { const int ls = (s == 0 || s == NSTAGES - 1) ? -1 : (s - 1) % NSTAGE_L;
          if (PROBE_SET >= 1 && PROBE_SET <= 13 && ls == PROBE_SET - 1 && ls != 5 && ls != 8 && !(ls == 0 && s > 1)) reps = 3;
          if (PROBE_SET == 14 && s == 0) reps = 3; }
#endif
        for (int r = 0; r < reps; ++r) hipLaunchKernelGGL(mk_fwd, dim3(grid), dim3(NTHREADS), LDS_BYTES, stream, a); }
#else
    a.ph_lo = 0; a.ph_hi = NSTAGES; hipLaunchKernelGGL(mk_fwd, dim3(grid), dim3(NTHREADS), LDS_BYTES, stream, a);
#endif
}
```

```cpp
#include <hip/hip_runtime.h>
#include <cstdio>
#include <cstdint>

#ifndef DUPK
#define DUPK 0
#endif
#define REPN(k) ((DUPK == (k)) ? 3 : 1)
#ifndef REP_GEMM
#define REP_GEMM 1
#endif
#ifndef REP_LIGHT
#define REP_LIGHT 1
#endif
#ifndef REP_PRO
#define REP_PRO 1
#endif
#ifndef S3_SPLIT
#define S3_SPLIT 60
#endif
#ifndef MK_PER_STAGE
#define MK_PER_STAGE 0
#endif

#define GAS __attribute__((address_space(1)))
#define LAS __attribute__((address_space(3)))
typedef unsigned short bf16;
typedef unsigned v4u __attribute__((ext_vector_type(4)));
typedef unsigned v2u __attribute__((ext_vector_type(2)));
typedef float f32x4 __attribute__((ext_vector_type(4)));
typedef float f32x2 __attribute__((ext_vector_type(2)));
typedef short bf16x8 __attribute__((ext_vector_type(8)));

constexpr int D = 1024, BATCH = 8, SEQ = 4096, CTXL = 256, DEPTH = 2;
constexpr int T_LAT = BATCH * SEQ, T_CTX = BATCH * CTXL, T_ALL = T_LAT + T_CTX;
constexpr int IN_COLS = 6912, HY_OFF = 0, RW_OFF = 1536, S5_OFF = 3328, GATE_OFF = 3840;
constexpr int NE = 32, TOPK = 4;
constexpr int MAXSLOT = 147456;
constexpr int NWAVES = 8, NTHREADS = 512;
constexpr int HY_MARG = 128, HY_ROWB = 8720, HY_RLEN = 8272, HY_RLENC = 592;
constexpr int HY_R1_OFF = 8 * HY_ROWB, HY_R2_OFF = HY_R1_OFF + HY_RLEN * 2;

constexpr size_t MiB = 1ull << 20;
constexpr size_t WS_CTL = 0, CTL_ZERO_BYTES = 1 * MiB;
constexpr size_t WS_MOD = 1 * MiB;
constexpr size_t WS_BLKCNT = 2 * MiB;
constexpr size_t WS_META = 2 * MiB + 512 * 1024;
constexpr size_t WS_ROWOF = 480 * MiB;
constexpr int CW_CNT = 24576;
constexpr size_t WS_EIDX = 3 * MiB, WS_GATE = 4 * MiB, WS_POS = 5 * MiB;
constexpr size_t WS_WTS = 8 * MiB, WL_STRIDE = 214 * MiB;
constexpr size_t WO_WIN = 0, WO_RWCAT = 14 * MiB, WO_GLU = 16 * MiB, WO_WBR = 17 * MiB, WO_WOUT = 20 * MiB, WO_W1 = 22 * MiB, WO_W2 = 150 * MiB;
constexpr size_t WS_GF = 436 * MiB, GF_STRIDE = 20 * MiB, GF_CTX = 17 * MiB;
constexpr size_t WS_X = 504 * MiB;
constexpr size_t WS_H = 640 * MiB;
constexpr size_t WS_BIG = 708 * MiB;
constexpr size_t WS_Z = WS_BIG;
constexpr size_t WS_SCN = 1167 * MiB;
constexpr size_t WS_MTMP = WS_SCN;
constexpr size_t WS_P = 1473 * MiB;
constexpr size_t WS_ARW = 1643 * MiB;
constexpr size_t WS_YDIR = 1660 * MiB;
constexpr size_t WS_YP = 1898 * MiB;
constexpr size_t WS_UT = 1796 * MiB;
constexpr size_t WS_AS5 = 2000 * MiB;
constexpr size_t WS_YHY = 1898 * MiB, WS_YRW = 1932 * MiB, WS_YS5 = 1966 * MiB;
constexpr size_t WS_XS = WS_BIG;
constexpr size_t WS_ACT = WS_BIG + 288 * MiB;
constexpr size_t WS_END = 2034 * MiB;
constexpr int CW_BAR = 4096;

constexpr int RING_BYTES = 131072;
constexpr int LDSCTL_OFF = RING_BYTES;
constexpr int LDS_BYTES = 163840;

typedef __bf16 bf16x2_t __attribute__((ext_vector_type(2)));
__device__ __forceinline__ unsigned pk2(float lo, float hi) { const bf16x2_t v = __builtin_convertvector((f32x2){lo, hi}, bf16x2_t); return __builtin_bit_cast(unsigned, v); }
__device__ __forceinline__ unsigned f2bf(float f) { return pk2(f, 0.f) & 0xffffu; }
__device__ __forceinline__ float bf2f(bf16 b) { return __builtin_bit_cast(float, ((unsigned)b) << 16); }
__device__ __forceinline__ float bflo(unsigned w) { return __builtin_bit_cast(float, w << 16); }
__device__ __forceinline__ float bfhi(unsigned w) { return __builtin_bit_cast(float, w & 0xffff0000u); }
__device__ __forceinline__ float sigm(float x) { return __builtin_amdgcn_rcpf(1.f + __expf(-x)); }
__device__ __forceinline__ float tanh_fast(float x) { const float e = __expf(2.f * x); return 1.f - 2.f * __builtin_amdgcn_rcpf(e + 1.f); }
#define LDS_WAIT() asm volatile("s_waitcnt lgkmcnt(0)" ::: "memory")
__device__ __forceinline__ float dpp_f(float x, const int ctrl_sel) {
    const int v = __builtin_bit_cast(int, x);
    int r;
    if (ctrl_sel == 0) r = __builtin_amdgcn_update_dpp(0, v, 0xB1, 0xF, 0xF, true);
    else if (ctrl_sel == 1) r = __builtin_amdgcn_update_dpp(0, v, 0x4E, 0xF, 0xF, true);
    else r = __builtin_amdgcn_update_dpp(0, v, 0x141, 0xF, 0xF, true);
    return __builtin_bit_cast(float, r);
}
__device__ __forceinline__ float red32(float x) {
    x += dpp_f(x, 0); x += dpp_f(x, 1); x += dpp_f(x, 2);
    x += __builtin_bit_cast(float, __builtin_amdgcn_update_dpp(0, __builtin_bit_cast(int, x), 0x128, 0xF, 0xF, true));
    x += __builtin_bit_cast(float, __builtin_amdgcn_ds_swizzle(__builtin_bit_cast(int, x), 0x401F));
    return x;
}
__device__ __forceinline__ float wave_sum(float v) {
    v = red32(v);
    return __builtin_bit_cast(float, __builtin_amdgcn_readlane(__builtin_bit_cast(int, v), 0)) + __builtin_bit_cast(float, __builtin_amdgcn_readlane(__builtin_bit_cast(int, v), 32));
}
__device__ __forceinline__ int xch32(int v, const int step) {
    if (step == 0) return __builtin_amdgcn_update_dpp(0, v, 0xB1, 0xF, 0xF, true);
    if (step == 1) return __builtin_amdgcn_update_dpp(0, v, 0x4E, 0xF, 0xF, true);
    if (step == 2) return __builtin_amdgcn_update_dpp(0, v, 0x141, 0xF, 0xF, true);
    if (step == 3) return __builtin_amdgcn_update_dpp(0, v, 0x128, 0xF, 0xF, true);
    return __builtin_amdgcn_ds_swizzle(v, 0x401F);
}
__device__ __forceinline__ float red8(float x) { x += dpp_f(x, 0); x += dpp_f(x, 1); x += dpp_f(x, 2); return x; }

#define XB_TMO      128
#define XB_XCNT(j)  (256  + 64 * (j))
#define XB_XSUB(j)  (1280 + 64 * (j))
#define XB_XGEN(j)  (2304 + 64 * (j))
#define XB_TOP      3328
#define XB_TOPGEN   3392
#define XCD_BAR_WORDS 3456
#define XB_SPIN_CAP (1u << 22)
__device__ __forceinline__ unsigned xb_ld(unsigned* p)              { return __hip_atomic_load(p, __ATOMIC_RELAXED, __HIP_MEMORY_SCOPE_AGENT); }
__device__ __forceinline__ unsigned xb_add(unsigned* p, unsigned v) { return __hip_atomic_fetch_add(p, v, __ATOMIC_RELAXED, __HIP_MEMORY_SCOPE_AGENT); }
__device__ __forceinline__ unsigned xb_xcc_id() { return (unsigned)__builtin_amdgcn_s_getreg((3 << 11) | 20) & 0xFu; }
#define XB_SPIN(cond, bar) do { unsigned _sp = 0; while (cond) { __builtin_amdgcn_s_sleep(1); \
    if ((++_sp & 255u) == 0u) { if (xb_ld(&(bar)[XB_TMO])) break; if (_sp > XB_SPIN_CAP) { atomicAdd(&(bar)[XB_TMO], 1u); break; } } } } while (0)
struct XcdBarrier { unsigned* bar; unsigned x; volatile LAS unsigned* st; };
__device__ __forceinline__ XcdBarrier xcd_barrier_post(unsigned* bar, volatile LAS unsigned* st) {
    XcdBarrier b; b.bar = bar; b.x = xb_xcc_id(); b.st = st;
    if (threadIdx.x == 0) (void)xb_add(&bar[XB_XCNT(b.x)], 1u);
    return b;
}
__device__ __forceinline__ void xcd_barrier_complete(unsigned* bar, unsigned x, unsigned& nloc, unsigned& nx) {
    const unsigned G = gridDim.x * gridDim.y * gridDim.z;
    unsigned sum, cnt, mine, sp = 0u;
    for (;;) {
        sum = 0u; cnt = 0u; mine = 0u;
#pragma unroll
        for (unsigned j = 0; j < 16; ++j) { const unsigned c = xb_ld(&bar[XB_XCNT(j)]); sum += c; cnt += (c > 0u) ? 1u : 0u; mine = (j == x) ? c : mine; }
        if (sum == G) break;
        __builtin_amdgcn_s_sleep(1);
        if ((++sp & 255u) == 0u) { if (xb_ld(&bar[XB_TMO])) break; if (sp > XB_SPIN_CAP) { atomicAdd(&bar[XB_TMO], 1u); break; } }
    }
    nloc = mine > 0u ? mine : 1u; nx = cnt > 0u ? cnt : 1u;
}
__device__ __forceinline__ void xcd_barrier(const XcdBarrier& b) {
    asm volatile("s_waitcnt vmcnt(0)" ::: "memory");
    __syncthreads();
    if (threadIdx.x == 0) {
        unsigned* bar = b.bar;
        __builtin_amdgcn_s_waitcnt(0);
        unsigned nloc = b.st[0], nx = b.st[1];
        if (nloc == 0u) { xcd_barrier_complete(bar, b.x, nloc, nx); b.st[0] = nloc; b.st[1] = nx; }
        const unsigned old = xb_add(&bar[XB_XSUB(b.x)], 1u);
        const unsigned gen = old / nloc;
        if (old + 1u == (gen + 1u) * nloc) {
            __builtin_amdgcn_fence(__ATOMIC_RELEASE, "agent");
            asm volatile("s_waitcnt vmcnt(0)" ::: "memory");
            const unsigned og = xb_add(&bar[XB_TOP], 1u);
            const unsigned tg = og / nx;
            if (og + 1u == (tg + 1u) * nx) xb_add(&bar[XB_TOPGEN], 1u);
            else XB_SPIN(xb_ld(&bar[XB_TOPGEN]) == tg, bar);
            __builtin_amdgcn_fence(__ATOMIC_ACQUIRE, "agent");
            xb_add(&bar[XB_XGEN(b.x)], 1u);
            asm volatile("s_waitcnt vmcnt(0)" ::: "memory");
        } else {
            XB_SPIN(xb_ld(&bar[XB_XGEN(b.x)]) == gen, bar);
            __builtin_amdgcn_fence(__ATOMIC_ACQUIRE, "agent");
            asm volatile("s_waitcnt vmcnt(0)" ::: "memory");
        }
    }
    __syncthreads();
}

namespace pg8 {
constexpr int MOE_CAP = 34816;
constexpr int BM = 256, BK = 64, HALF = 128, HTB = HALF * BK * 2, STAGE_BYTES = 8 * HTB, NXCD = 8, WGM = 8, ROWTAB_OFF = 131072 + 4096;
__host__ __device__ __forceinline__ int lds_byte(int r, int c) { const int st = (r >> 4) * 2 + (c >> 5), rr = r & 15, cc = c & 31, ob = rr * 64 + cc * 2; return st * 1024 + (ob ^ (((ob >> 9) & 1) << 5)); }
__host__ __device__ __forceinline__ void stage_rc(int b, int& R, int& C) { const int st = b / 1024, sb = b % 1024, swz = sb ^ (((sb >> 9) & 1) << 5); R = (st >> 1) * 16 + swz / 64; C = (st & 1) * 32 + (swz % 64) / 2; }
__host__ __device__ __forceinline__ int perm32(int rho) { const int n = rho >> 4, i = rho & 15; return 8 * (i >> 2) + 4 * n + (i & 3); }
struct Unit { int pm, pn, e; };
__device__ __forceinline__ unsigned cvt_pk_bf16(float lo, float hi) { return pk2(lo, hi); }

__device__ __forceinline__ void tile_of(int L, int nM, int nN, int& pm, int& pn) {
    const int nwg = nM * nN; int wgid = L;
    { const int q = nwg / NXCD, r = nwg % NXCD, xcd = wgid % NXCD, off = wgid / NXCD; wgid = (xcd < r ? xcd * (q + 1) : r * (q + 1) + (xcd - r) * q) + off; }
    const int nig = WGM * nN, gid = wgid / nig, fm = gid * WGM, gsz = (nM - fm) < WGM ? (nM - fm) : WGM;
    pm = fm + ((wgid % nig) % gsz); pn = (wgid % nig) / gsz;
}
struct SchedStatic {
    static constexpr bool GATHER = false;
    const char* A; const char* Bt; size_t tstep; int nM, nN, G, c;
    __device__ __forceinline__ void init(const void* A_, const void* Bt_, int M, int N, int K, int G_, int c_) { A = (const char*)A_; Bt = (const char*)Bt_; tstep = (size_t)BM * K * 2; nM = M / BM; nN = N / BM; G = G_; c = c_; }
    __device__ __forceinline__ bool next(int i, Unit& u) const { const long L = (long)i * G + c; if (L >= (long)nM * nN) return false; tile_of((int)L, nM, nN, u.pm, u.pn); u.e = 0; return true; }
    __device__ __forceinline__ const char* aptr(const Unit& u) const { return A + (size_t)u.pm * tstep; }
    __device__ __forceinline__ const char* bptr(const Unit& u) const { return Bt + (size_t)u.pn * tstep; }
};
struct SchedWin {
    static constexpr bool GATHER = false;
    const char* A; const char* Bt; size_t tstep; int G, c, part;
    __device__ __forceinline__ bool next(int i, Unit& u) const {
        const int L = i * G + c, nmf = part ? 128 : 136, nfull = nmf * 27; u.e = 0;
        if (L < nfull) { tile_of(L, nmf, 27, u.pm, u.pn); return true; }
        const int L2 = L - nfull; if (!part || L2 >= 8 * 9) return false;
        u.pm = 128 + L2 / 9; u.pn = 6 + L2 % 9; return true; }
    __device__ __forceinline__ const char* aptr(const Unit& u) const { return A + (size_t)u.pm * tstep; }
    __device__ __forceinline__ const char* bptr(const Unit& u) const { return Bt + (size_t)u.pn * tstep; }
};
struct SchedP {
    static constexpr bool GATHER = false;
    const char* A; const char* Bt; size_t tstep; int nM, G, c;
    __device__ __forceinline__ bool next(int i, Unit& u) const { const long L = (long)i * G + c; if (L >= (long)nM * 10) return false; tile_of((int)L, nM, 10, u.pm, u.pn); u.e = 0; return true; }
    __device__ __forceinline__ const char* aptr(const Unit& u) const { return A + (size_t)u.pm * tstep + (u.pn < 8 ? 0 : 256); }
    __device__ __forceinline__ const char* bptr(const Unit& u) const { return Bt + (size_t)u.pn * tstep + (u.pn < 8 ? 0 : 256); }
};
struct SchedMerge {
    static constexpr bool GATHER = false;
    const char* A0; const char* A1; const char* A2; const char* Bt; size_t tstep, bstride; int nM, nN, G, c;
    __device__ __forceinline__ bool next(int i, Unit& u) const { const int j = i / 3, br = i - 3 * j; const long L = (long)j * G + c; if (L >= (long)nM * nN) return false; tile_of((int)L, nM, nN, u.pm, u.pn); u.e = br; return true; }
    __device__ __forceinline__ const char* aptr(const Unit& u) const { return (u.e == 0 ? A0 : (u.e == 1 ? A1 : A2)) + (size_t)u.pm * tstep; }
    __device__ __forceinline__ const char* bptr(const Unit& u) const { return Bt + (size_t)u.e * bstride + (size_t)u.pn * tstep; }
};
struct SchedMoe {
    static constexpr bool GATHER = false;
    const char* A; const char* Bt; size_t tstep, estride; int NPN, G, c; const LAS int* base;
    __device__ __forceinline__ bool next(int i, Unit& u) const {
        const int ntiles = base[32] >> 8; const int per = G >> 3;
        const long L = (long)i * G + (((G & 7) == 0) ? (c & 7) * per + (c >> 3) : c);
        if (L >= (long)ntiles * NPN) return false;
        u.pm = (int)(L / NPN); u.pn = (int)(L % NPN); const int r0 = u.pm << 8; int e = 0;
#pragma unroll 1
        for (int k = 1; k < 32; ++k) e += (r0 >= base[k]) ? 1 : 0;
        u.e = e; return true;
    }
    __device__ __forceinline__ const char* aptr(const Unit& u) const { return A + (size_t)u.pm * tstep; }
    __device__ __forceinline__ const char* bptr(const Unit& u) const { return Bt + (size_t)u.e * estride + (size_t)u.pn * tstep; }
};
struct SchedMoeG : SchedMoe {
    static constexpr bool GATHER = true;
    const unsigned* rowof;
    __device__ __forceinline__ const char* aptr(const Unit&) const { return A; }
    __device__ __forceinline__ const unsigned* rowptr(const Unit& u) const { return rowof + (size_t)u.e * MOE_CAP + ((u.pm << 8) - base[u.e]); }
    __device__ __forceinline__ int valid(const Unit& u) const { return base[64 + u.e] - ((u.pm << 8) - base[u.e]); }
};

template <class Epi, class Sched>
__device__ __forceinline__ void gemm_phase(LAS unsigned char* lds, const int tid, const int K, const Sched& S, const Epi& E, const int ntk = 0) {
    const int wid = __builtin_amdgcn_readfirstlane(tid >> 6), lane = tid & 63, wr = wid >> 2, wc = wid & 3, fr = lane & 15, fq = lane >> 4;
    const int nt = ntk ? ntk : K / BK;
    unsigned voffA[2], voffB[2];
#pragma unroll
    for (int i = 0; i < 2; ++i) { int R, C; stage_rc(tid * 16 + i * 8192, R, C); const int Rb = Epi::PERM ? ((R & ~31) + perm32(R & 31)) : R;
        voffA[i] = (unsigned)(R * K + C) * 2u; voffB[i] = (unsigned)(Rb * K + C) * 2u; }
    const size_t kstep = (size_t)(BK * 2);
    const size_t hstep = (size_t)HALF * K * 2;
    const unsigned ldsw = (unsigned)wid * 1024u;
    const int aoff = lds_byte(wr * 64 + fr, fq * 8), boff = lds_byte(wc * 32 + fr, fq * 8);
#define PG8_SA(b, h) (((b) * 2 + (h)) * HTB)
#define PG8_SB(b, h) ((4 + (b) * 2 + (h)) * HTB)
#define PG8_STAGE(bufoff, gbase, voff) do { _Pragma("unroll") for (int _i = 0; _i < 2; ++_i) \
        __builtin_amdgcn_global_load_lds((const unsigned*)((const char*)(gbase) + (voff)[_i]), (LAS unsigned*)(lds + (bufoff) + ldsw + _i * 8192), 16, 0, 0); } while (0)
#define PG8_STAGEA(bufoff, kp, h) do { if constexpr (Sched::GATHER) { _Pragma("unroll") for (int _i = 0; _i < 2; ++_i) \
        __builtin_amdgcn_global_load_lds((const unsigned*)((const char*)(kp) + g[2 * (h) + _i]), (LAS unsigned*)(lds + (bufoff) + ldsw + _i * 8192), 16, 0, 0); } \
        else { PG8_STAGE(bufoff, (kp) + (h) * hstep, voffA); } } while (0)
#define PG8_GLOAD(un_, buf) do { const LAS unsigned* rt_ = (const LAS unsigned*)(lds + ROWTAB_OFF + (buf) * 1024) + gR0; const int nv_ = S.valid(un_); \
        _Pragma("unroll") for (int _j = 0; _j < 4; ++_j) g[_j] = ((gR0 + 64 * _j < nv_) ? rt_[64 * _j] : 0u) + gCb; } while (0)
#define PG8_GDMA(un_, buf) do { if (wid == 0) { unsigned lo_ = (unsigned)threadIdx.x; asm volatile("" : "+v"(lo_)); lo_ = (lo_ & 63u) * 16u; \
        __builtin_amdgcn_global_load_lds((const unsigned*)((const char*)S.rowptr(un_) + lo_), (LAS unsigned*)(lds + ROWTAB_OFF + (buf) * 1024), 16, 0, 0); } } while (0)
#define PG8_LDA(dst, b, h) do { _Pragma("unroll") for (int m = 0; m < 4; ++m) _Pragma("unroll") for (int k = 0; k < 2; ++k) dst[m][k] = *(const LAS bf16x8*)(lds + PG8_SA(b, h) + aoff + m * 2048 + k * 1024); } while (0)
#define PG8_LDB(dst, b, h) do { _Pragma("unroll") for (int n = 0; n < 2; ++n) _Pragma("unroll") for (int k = 0; k < 2; ++k) dst[n][k] = *(const LAS bf16x8*)(lds + PG8_SB(b, h) + boff + n * 2048 + k * 1024); } while (0)
#define PG8_MMA(ai, bj, At, Bt) do { __builtin_amdgcn_s_setprio(1); _Pragma("unroll") for (int m = 0; m < 4; ++m) _Pragma("unroll") for (int n = 0; n < 2; ++n) _Pragma("unroll") for (int k = 0; k < 2; ++k) \
        acc[ai][bj][m][n] = __builtin_amdgcn_mfma_f32_16x16x32_bf16(Bt[n][k], At[m][k], acc[ai][bj][m][n], 0, 0, 0); __builtin_amdgcn_s_setprio(0); } while (0)
#define PG8_WAIT_V(n) asm volatile("s_waitcnt vmcnt(" #n ")" ::: "memory")
#define PG8_WAIT_L(n) asm volatile("s_waitcnt lgkmcnt(" #n ")" ::: "memory")
#define PG8_BAR __builtin_amdgcn_s_barrier()
#define PG8_SCHED __builtin_amdgcn_sched_barrier(0)
    Unit cur, nxt; int ui = 0;
    if (!S.next(0, cur)) return;
    f32x4 acc[2][2][4][2];
#pragma unroll
    for (int a = 0; a < 2; ++a)
#pragma unroll
        for (int b = 0; b < 2; ++b)
#pragma unroll
            for (int m = 0; m < 4; ++m)
#pragma unroll
                for (int n = 0; n < 2; ++n) acc[a][b][m][n] = (f32x4){0.f, 0.f, 0.f, 0.f};
    bf16x8 At[4][2], B0[2][2], B1[2][2];
    const char* cA = S.aptr(cur); const char* cB = S.bptr(cur);
    unsigned g[4] = {0u, 0u, 0u, 0u}; int gR0 = 0; unsigned gCb = 0u;
    if constexpr (Sched::GATHER) { int R, C; stage_rc(tid * 16, R, C); gR0 = R; gCb = (unsigned)C * 2u;
        PG8_GDMA(cur, 0); PG8_WAIT_V(0); PG8_BAR; PG8_GLOAD(cur, 0); }
    PG8_STAGE(PG8_SB(0, 0), cB, voffB); PG8_STAGE(PG8_SB(0, 1), cB + hstep, voffB); PG8_STAGEA(PG8_SA(0, 0), cA, 0); PG8_STAGEA(PG8_SA(0, 1), cA, 1);
    if (wr == 1) PG8_BAR;
    PG8_WAIT_V(2); PG8_BAR;
    PG8_STAGE(PG8_SB(1, 0), cB + kstep, voffB); PG8_STAGEA(PG8_SA(1, 0), cA + kstep, 0); PG8_STAGE(PG8_SB(1, 1), cB + hstep + kstep, voffB);
    PG8_WAIT_V(6); PG8_BAR;
    for (;;) {
        const bool has_next = S.next(ui + 1, nxt);
        const char* nA = has_next ? S.aptr(nxt) : cA; const char* nB = has_next ? S.bptr(nxt) : cB;
        if constexpr (Sched::GATHER) { if (has_next) PG8_GDMA(nxt, (ui + 1) & 1); }
        for (int t = 0; t < nt; t += 2) {
            const bool last = (t == nt - 2);
            const char* a1 = cA + (size_t)(t + 1) * kstep;
            const char* a2 = last ? nA : cA + (size_t)(t + 2) * kstep; const char* b2 = last ? nB : cB + (size_t)(t + 2) * kstep;
            const char* a3 = a2 + kstep; const char* b3 = b2 + kstep;
            PG8_LDB(B0, 0, 0); PG8_LDB(B1, 0, 1); PG8_SCHED; PG8_LDA(At, 0, 0); PG8_STAGEA(PG8_SA(1, 1), a1, 1);
            PG8_WAIT_V(8); PG8_WAIT_L(0); PG8_BAR; PG8_MMA(0, 0, At, B0); PG8_MMA(0, 1, At, B1); PG8_BAR; PG8_SCHED;
            if constexpr (Sched::GATHER) { if (last && has_next) PG8_GLOAD(nxt, (ui + 1) & 1); PG8_SCHED; }
            PG8_LDA(At, 0, 1); PG8_STAGE(PG8_SB(0, 0), b2, voffB); PG8_STAGE(PG8_SB(0, 1), b2 + hstep, voffB); PG8_STAGEA(PG8_SA(0, 0), a2, 0);
            PG8_WAIT_V(8); PG8_WAIT_L(0); PG8_BAR; PG8_MMA(1, 0, At, B0); PG8_MMA(1, 1, At, B1); PG8_BAR; PG8_SCHED;
            PG8_LDB(B0, 1, 0); PG8_LDB(B1, 1, 1); PG8_SCHED; PG8_LDA(At, 1, 0); PG8_STAGEA(PG8_SA(0, 1), a2, 1);
            PG8_WAIT_V(8); PG8_WAIT_L(0); PG8_BAR; PG8_MMA(0, 0, At, B0); PG8_MMA(0, 1, At, B1); PG8_BAR; PG8_SCHED;
            PG8_LDA(At, 1, 1); PG8_STAGE(PG8_SB(1, 0), b3, voffB); PG8_STAGE(PG8_SB(1, 1), b3 + hstep, voffB); PG8_STAGEA(PG8_SA(1, 0), a3, 0);
            PG8_WAIT_V(8); PG8_WAIT_L(0); PG8_BAR; PG8_MMA(1, 0, At, B0); PG8_MMA(1, 1, At, B1); PG8_BAR; PG8_SCHED;
        }
        if (wr == 0) PG8_BAR;
        { int t2_ = (int)threadIdx.x; asm volatile("" : "+v"(t2_)); E(acc, cur, wr, wc, t2_ & 15, (t2_ >> 4) & 3); }
        if (!has_next) break;
#pragma unroll
        for (int a = 0; a < 2; ++a)
#pragma unroll
            for (int b = 0; b < 2; ++b)
#pragma unroll
                for (int m = 0; m < 4; ++m)
#pragma unroll
                    for (int n = 0; n < 2; ++n) acc[a][b][m][n] = (f32x4){0.f, 0.f, 0.f, 0.f};
        cur = nxt; cA = nA; cB = nB; ++ui;
        if (wr == 1) PG8_BAR;
    }
    PG8_WAIT_V(0);
    PG8_BAR;
#undef PG8_SA
#undef PG8_SB
#undef PG8_STAGE
#undef PG8_STAGEA
#undef PG8_GLOAD
#undef PG8_GDMA
#undef PG8_LDA
#undef PG8_LDB
#undef PG8_MMA
#undef PG8_WAIT_V
#undef PG8_WAIT_L
#undef PG8_BAR
#undef PG8_SCHED
}

struct EpiBf16 {
    static constexpr bool PERM = true;
    bf16* O; int ldc; const float* bias; int bias_stride;
    __device__ __forceinline__ void operator()(const f32x4 (&acc)[2][2][4][2], const Unit& u, int wr, int wc, int fr, int fq) const {
        const int row0 = u.pm * BM + wr * 64 + fr, col0 = u.pn * BM + wc * 32 + 8 * fq;
        f32x4 bv[2][2];
#pragma unroll
        for (int bj = 0; bj < 2; ++bj)
#pragma unroll
            for (int n = 0; n < 2; ++n) bv[bj][n] = bias ? *(const f32x4*)(bias + (size_t)u.e * bias_stride + col0 + bj * HALF + 4 * n) : (f32x4){0.f, 0.f, 0.f, 0.f};
#pragma unroll
        for (int ai = 0; ai < 2; ++ai)
#pragma unroll
            for (int m = 0; m < 4; ++m) { bf16* rowp = O + (size_t)(row0 + ai * HALF + m * 16) * ldc + col0;
#pragma unroll
                for (int bj = 0; bj < 2; ++bj) { const f32x4 v0 = acc[ai][bj][m][0] + bv[bj][0], v1 = acc[ai][bj][m][1] + bv[bj][1];
                    v4u w; w.x = cvt_pk_bf16(v0[0], v0[1]); w.y = cvt_pk_bf16(v0[2], v0[3]); w.z = cvt_pk_bf16(v1[0], v1[1]); w.w = cvt_pk_bf16(v1[2], v1[3]);
                    *(v4u*)(rowp + bj * HALF) = w; } }
    }
};
template <int MODE> struct EpiGlu {
    static constexpr bool PERM = true;
    bf16* O; int ldc; const float* bias; int bias_stride, hs;
    __device__ __forceinline__ void operator()(const f32x4 (&acc)[2][2][4][2], const Unit& u, int wr, int wc, int fr, int fq) const {
        const int row0 = u.pm * BM + wr * 64 + fr, col0 = u.pn * HALF + wc * 32 + 8 * fq;
        const float* bp = bias + (size_t)u.e * bias_stride + col0;
        f32x4 ba[2], bb[2];
#pragma unroll
        for (int n = 0; n < 2; ++n) { ba[n] = *(const f32x4*)(bp + 4 * n); bb[n] = *(const f32x4*)(bp + hs + 4 * n); }
#pragma unroll
        for (int ai = 0; ai < 2; ++ai)
#pragma unroll
            for (int m = 0; m < 4; ++m) { bf16* rowp = O + (size_t)(row0 + ai * HALF + m * 16) * ldc + col0;
                float o[8];
#pragma unroll
                for (int n = 0; n < 2; ++n) { const f32x4 a = acc[ai][0][m][n] + ba[n], b = acc[ai][1][m][n] + bb[n];
#pragma unroll
                    for (int j = 0; j < 4; ++j) {
                        if (MODE == 0) o[4 * n + j] = a[j] * sigm(b[j]);
                        else { const float g = fminf(a[j], 7.f), up = fminf(fmaxf(b[j], -7.f), 7.f); o[4 * n + j] = (up + 1.f) * g * sigm(1.702f * g); } } }
                v4u w; w.x = cvt_pk_bf16(o[0], o[1]); w.y = cvt_pk_bf16(o[2], o[3]); w.z = cvt_pk_bf16(o[4], o[5]); w.w = cvt_pk_bf16(o[6], o[7]);
                *(v4u*)rowp = w; }
    }
};
struct EpiMerge {
    static constexpr bool PERM = true;
    bf16* mtmp; bf16* Mo; const bf16* zg;
    __device__ __forceinline__ void operator()(const f32x4 (&acc)[2][2][4][2], const Unit& u, int wr, int wc, int fr, int fq) const {
        const int row0 = u.pm * BM + wr * 64 + fr, col0 = u.pn * BM + wc * 32 + 8 * fq;
#pragma unroll
        for (int ai = 0; ai < 2; ++ai)
#pragma unroll
            for (int m = 0; m < 4; ++m) { const size_t r = (size_t)(row0 + ai * HALF + m * 16);
#pragma unroll
                for (int bj = 0; bj < 2; ++bj) { const int c = col0 + bj * HALF;
                    const v4u gz = *(const v4u*)(zg + r * IN_COLS + u.e * 1024 + c);
                    float g[8] = {bflo(gz.x), bfhi(gz.x), bflo(gz.y), bfhi(gz.y), bflo(gz.z), bfhi(gz.z), bflo(gz.w), bfhi(gz.w)};
                    f32x4 t0, t1; bf16* tp = mtmp + r * 1024 + c;
                    if (u.e == 0) { t0 = (f32x4){0.f, 0.f, 0.f, 0.f}; t1 = t0; } else { const v4u pv = *(const v4u*)tp; t0 = (f32x4){bflo(pv.x), bfhi(pv.x), bflo(pv.y), bfhi(pv.y)}; t1 = (f32x4){bflo(pv.z), bfhi(pv.z), bflo(pv.w), bfhi(pv.w)}; }
#pragma unroll
                    for (int j = 0; j < 4; ++j) { t0[j] += sigm(g[j]) * acc[ai][bj][m][0][j]; t1[j] += sigm(g[4 + j]) * acc[ai][bj][m][1][j]; }
                    if (u.e < 2) { v4u w; w.x = cvt_pk_bf16(t0[0], t0[1]); w.y = cvt_pk_bf16(t0[2], t0[3]); w.z = cvt_pk_bf16(t1[0], t1[1]); w.w = cvt_pk_bf16(t1[2], t1[3]); *(v4u*)tp = w; }
                    else { v4u w; w.x = cvt_pk_bf16(t0[0], t0[1]); w.y = cvt_pk_bf16(t0[2], t0[3]); w.z = cvt_pk_bf16(t1[0], t1[1]); w.w = cvt_pk_bf16(t1[2], t1[3]);
                        *(v4u*)(Mo + r * 1024 + c) = w; } } }
    }
};
struct EpiResid {
    static constexpr bool PERM = false;
    float* X; const float* gmod;
    __device__ __forceinline__ void operator()(const f32x4 (&acc)[2][2][4][2], const Unit& u, int wr, int wc, int fr, int fq) const {
        const int row0 = u.pm * BM + wr * 64 + fr, col0 = u.pn * BM + wc * 32 + 4 * fq;
        const int r00 = u.pm * BM; const int w = r00 < T_LAT ? (r00 >> 12) : 8;
        f32x4 gv[2][2];
#pragma unroll
        for (int bj = 0; bj < 2; ++bj)
#pragma unroll
            for (int n = 0; n < 2; ++n) gv[bj][n] = *(const f32x4*)(gmod + (size_t)w * 6144 + col0 + bj * HALF + n * 16);
#pragma unroll
        for (int ai = 0; ai < 2; ++ai)
#pragma unroll
            for (int m = 0; m < 4; ++m) { float* rowp = X + (size_t)(row0 + ai * HALF + m * 16) * 1024 + col0;
#pragma unroll
                for (int bj = 0; bj < 2; ++bj)
#pragma unroll
                    for (int n = 0; n < 2; ++n) { f32x4* p = (f32x4*)(rowp + bj * HALF + n * 16); *p = *p + gv[bj][n] * acc[ai][bj][m][n]; } }
    }
};
}

struct Args { const float* in[51]; float* out; unsigned char* ws; int ph_lo, ph_hi; };
enum { I_X = 0, I_C, I_CTX, I_CCTX, I_ADAW, I_ADAB, I_N1G, I_N2G, I_WIN, I_HYCW, I_HYCB, I_HYW1, I_HYB1, I_HYF1, I_HYW2, I_HYB2, I_HYF2, I_HYW3, I_HYB3, I_HYBIAS,
       I_RWCW, I_RWCB, I_RWWUP, I_RWW0, I_RWAUP, I_RWA0, I_RWGUP, I_RWKK, I_RWKA, I_RWRK, I_RWLNG, I_RWLNB, I_S5ARE, I_S5AIM, I_S5LDT, I_S5BRE, I_S5BIM, I_S5CRE, I_S5CIM, I_S5D,
       I_S5GLUW, I_S5GLUB, I_WBR, I_WOUT, I_RTW, I_RTB, I_W1, I_B1, I_W2, I_B2, I_FING };

typedef const __attribute__((address_space(4))) Args* CArgsP;
__device__ __forceinline__ CArgsP kargs() { CArgsP p = (CArgsP)__builtin_amdgcn_kernarg_segment_ptr(); asm volatile("" : "+s"(p)); return p; }
__device__ __forceinline__ int opaque(int v) { asm volatile("" : "+s"(v)); return v; }
__device__ __forceinline__ int opaque_v(int v) { asm volatile("" : "+v"(v)); return v; }
struct Ctx { CArgsP a; LAS unsigned char* lds; int tid, lane, wave, bid, G; };

__device__ __forceinline__ void row_seq(int row, int& base, int& pos, int& n) {
    if (row < T_LAT) { base = row & ~(SEQ - 1); pos = row & (SEQ - 1); n = SEQ; }
    else { const int r = row - T_LAT; base = T_LAT + (r & ~(CTXL - 1)); pos = r & (CTXL - 1); n = CTXL; }
}
__device__ __forceinline__ float conv3z(const bf16* zc, int pos, int n, float w0, float w1, float w2, float b) {
    const float zm = pos > 0 ? bf2f(zc[(size_t)(pos - 1) * IN_COLS]) : 0.f, z0 = bf2f(zc[(size_t)pos * IN_COLS]), zp = pos < n - 1 ? bf2f(zc[(size_t)(pos + 1) * IN_COLS]) : 0.f;
    return zm * w0 + z0 * w1 + zp * w2 + b;
}

template <int MODE>
__device__ __forceinline__ void transpose_item(const float* W, int K, int N, bf16* WT, int Hs, LAS float* scr, int item, int lane) {
    const int nblk = N / 32, kb = item / nblk, nb = item % nblk, k0 = 64 * kb, n0 = 32 * nb;
#pragma unroll 8
    for (int i = 0; i < 32; ++i) { const int kk = 2 * i + (lane >> 5); scr[kk * 33 + (lane & 31)] = W[(size_t)(k0 + kk) * N + n0 + (lane & 31)]; }
    LDS_WAIT(); asm volatile("" ::: "memory");
    const int c = lane & 7;
#pragma unroll
    for (int j = 0; j < 4; ++j) { const int n = (lane >> 3) + 8 * j; const LAS float* s = scr + (8 * c) * 33 + n;
        v4u o; o.x = pk2(s[0 * 33], s[1 * 33]); o.y = pk2(s[2 * 33], s[3 * 33]); o.z = pk2(s[4 * 33], s[5 * 33]); o.w = pk2(s[6 * 33], s[7 * 33]);
        int dr = n0 + n;
        if (MODE == 1) { const int nc = n0 + n; const int jx = nc < Hs ? nc : nc - Hs; dr = (jx >> 7) * 256 + (nc < Hs ? 0 : 128) + (jx & 127); }
        *(v4u*)(WT + (size_t)dr * K + k0 + 8 * c) = o; }
    LDS_WAIT(); asm volatile("" ::: "memory");
}

__device__ __forceinline__ void p0_prologue(const Ctx& F) {
    const auto& a = *F.a; unsigned char* ws = a.ws;
    const int gw = F.bid * NWAVES + F.wave, NGW = F.G * NWAVES, lane = F.lane;
    {
        LAS float* condl = (LAS float*)F.lds; LAS float* psum = (LAS float*)(F.lds + 40960);
        for (int i = F.tid; i < 9 * 1024; i += NTHREADS) { const int w = i >> 10, k = i & 1023; const float cv = (w < 8) ? a.in[I_C][w * 1024 + k] : a.in[I_CCTX][k]; condl[i] = cv / (1.f + expf(-cv)); }
        __syncthreads();
        float* MOD = (float*)(ws + WS_MOD);
        for (int it = F.bid; it < 2 * 96; it += F.G) {
            const int l = it / 96, cg = it % 96, col = cg * 64 + lane;
            float acc[9];
#pragma unroll
            for (int w = 0; w < 9; ++w) acc[w] = 0.f;
            const float* wp = a.in[I_ADAW] + ((size_t)l * 1024 + F.wave * 128) * 6144 + col;
#pragma unroll 1
            for (int k0 = 0; k0 < 128; k0 += 16) { float wv[16];
#pragma unroll
                for (int k = 0; k < 16; ++k) wv[k] = wp[(size_t)(k0 + k) * 6144];
#pragma unroll
                for (int k = 0; k < 16; ++k)
#pragma unroll
                    for (int w = 0; w < 9; ++w) acc[w] += condl[w * 1024 + F.wave * 128 + k0 + k] * wv[k]; }
#pragma unroll
            for (int w = 0; w < 9; ++w) psum[(F.wave * 9 + w) * 64 + lane] = acc[w];
            __syncthreads();
            if (F.wave == 0) {
#pragma unroll
                for (int w = 0; w < 9; ++w) { float s = 0.f;
#pragma unroll
                    for (int wv = 0; wv < 8; ++wv) s += psum[(wv * 9 + w) * 64 + lane];
                    MOD[(size_t)(l * 9 + w) * 6144 + col] = s + a.in[I_ADAB][l * 6144 + col]; }
            }
            __syncthreads();
        }
    }
    {
        LAS float* scr = (LAS float*)(F.lds + F.wave * 16384);
        constexpr int IT_W1 = 16 * 64, IT_W2 = 16 * 32, IT_WIN = 16 * 216, IT_GLU = 8 * 32, IT_WBR = 8 * 32, IT_WOUT = 16 * 32;
        constexpr int N_W1 = 64 * IT_W1, N_W2 = 64 * IT_W2, N_WIN = 2 * IT_WIN, N_GLU = 2 * IT_GLU, N_WBR = 6 * IT_WBR, N_WOUT = 2 * IT_WOUT;
        constexpr int NITEMS = N_W1 + N_W2 + N_WIN + N_GLU + N_WBR + N_WOUT;
        for (int it = gw; it < NITEMS; it += NGW) {
            int r = it;
            if (r < N_W1) { const int mtx = r / IT_W1, l = mtx >> 5, e = mtx & 31; transpose_item<1>(a.in[I_W1] + (size_t)mtx * 1024 * 2048, 1024, 2048, (bf16*)(ws + WS_WTS + l * WL_STRIDE + WO_W1) + (size_t)e * 2048 * 1024, 1024, scr, r % IT_W1, lane); continue; } r -= N_W1;
            if (r < N_W2) { const int mtx = r / IT_W2, l = mtx >> 5, e = mtx & 31; transpose_item<0>(a.in[I_W2] + (size_t)mtx * 1024 * 1024, 1024, 1024, (bf16*)(ws + WS_WTS + l * WL_STRIDE + WO_W2) + (size_t)e * 1024 * 1024, 0, scr, r % IT_W2, lane); continue; } r -= N_W2;
            if (r < N_WIN) { const int l = r / IT_WIN; transpose_item<0>(a.in[I_WIN] + (size_t)l * 1024 * IN_COLS, 1024, IN_COLS, (bf16*)(ws + WS_WTS + l * WL_STRIDE + WO_WIN), 0, scr, r % IT_WIN, lane); continue; } r -= N_WIN;
            if (r < N_GLU) { const int l = r / IT_GLU; transpose_item<1>(a.in[I_S5GLUW] + (size_t)l * 512 * 1024, 512, 1024, (bf16*)(ws + WS_WTS + l * WL_STRIDE + WO_GLU), 512, scr, r % IT_GLU, lane); continue; } r -= N_GLU;
            if (r < N_WBR) { const int mtx = r / IT_WBR, l = mtx / 3, br = mtx % 3; transpose_item<0>(a.in[I_WBR] + (size_t)mtx * 512 * 1024, 512, 1024, (bf16*)(ws + WS_WTS + l * WL_STRIDE + WO_WBR) + (size_t)br * 1024 * 512, 0, scr, r % IT_WBR, lane); continue; } r -= N_WBR;
            { const int l = r / IT_WOUT; transpose_item<0>(a.in[I_WOUT] + (size_t)l * 1024 * 1024, 1024, 1024, (bf16*)(ws + WS_WTS + l * WL_STRIDE + WO_WOUT), 0, scr, r % IT_WOUT, lane); }
        }
        for (int i = F.bid * NTHREADS + F.tid; i < 2 * 2560 * 256; i += F.G * NTHREADS) {
            const int l = i / (2560 * 256), r = i % (2560 * 256), n = r >> 8, k = r & 255; float v = 0.f;
            if (n < 1024) { if (k < 64) v = a.in[I_RWWUP][(((size_t)l * 2 + (n >> 9)) * 64 + k) * 512 + (n & 511)]; }
            else if (n < 2048) { if (k >= 64 && k < 128) v = a.in[I_RWAUP][(((size_t)l * 2 + ((n - 1024) >> 9)) * 64 + (k - 64)) * 512 + (n & 511)]; }
            else { if (k >= 128) v = a.in[I_RWGUP][((size_t)l * 128 + (k - 128)) * 512 + (n - 2048)]; }
            ((bf16*)(ws + WS_WTS + l * WL_STRIDE + WO_RWCAT))[r] = (bf16)f2bf(v);
        }
    }
    __syncthreads();
    {
        LAS float* feats = (LAS float*)F.lds; LAS float* h1 = feats + 8 * 33; LAS float* h2 = h1 + 8 * 64;
        constexpr int NIT = 2 * (512 + 32);
        for (int it = F.bid; it < NIT; it += F.G) {
            const int l = it / 544, r = it % 544, nsel = r >= 512, n = nsel ? CTXL : SEQ, p0 = (nsel ? r - 512 : r) * 8;
            if (l == DEPTH - 1 && nsel) continue;
            if (F.tid < 8 * 33) { const int p = F.tid / 33, i = F.tid % 33, pos = p0 + p; float f;
                if (i == 0) f = (float)pos / (float)(n - 1);
                else { const int k = (i - 1) & 15; const float band = 1e-4f + (float)k * ((15.0f - 1e-4f) / 15.0f); const float ang = (6.283185307179586f * (float)pos / (float)n) * band; f = (i <= 16) ? cosf(ang) : -sinf(ang); }
                feats[p * 33 + i] = f; }
            __syncthreads();
            { const int p = F.tid >> 6, j = F.tid & 63; float s = a.in[I_HYB1][l * 64 + j]; const float* w1p = a.in[I_HYW1] + (size_t)l * 33 * 64 + j;
#pragma unroll
                for (int i = 0; i < 33; ++i) s += feats[p * 33 + i] * w1p[i * 64];
                h1[p * 64 + j] = sinf(a.in[I_HYF1][l * 64 + j] * s); }
            __syncthreads();
            { const int p = F.tid >> 6, j = F.tid & 63; float s = a.in[I_HYB2][l * 64 + j];
                const float* w2p = a.in[I_HYW2] + (size_t)l * 64 * 64 + j;
#pragma unroll 16
                for (int i = 0; i < 64; ++i) s += h1[p * 64 + i] * w2p[i * 64];
                h2[p * 64 + j] = sinf(a.in[I_HYF2][l * 64 + j] * s); }
            __syncthreads();
            float acc[4][8];
#pragma unroll
            for (int q = 0; q < 4; ++q)
#pragma unroll
                for (int p = 0; p < 8; ++p) acc[q][p] = 0.f;
            const float* w3 = a.in[I_HYW3] + (size_t)l * 64 * 2048 + F.tid;
#pragma unroll 8
            for (int i = 0; i < 64; ++i) { float wv[4];
#pragma unroll
                for (int q = 0; q < 4; ++q) wv[q] = w3[(size_t)i * 2048 + q * 512];
#pragma unroll
                for (int p = 0; p < 8; ++p) { const float hv = h2[p * 64 + i];
#pragma unroll
                    for (int q = 0; q < 4; ++q) acc[q][p] += hv * wv[q]; } }
            const int c = F.tid; const float dstart = logf(0.01f) / 1.5f, dstop = logf(0.01f) / 0.3f; const float delta = fabsf(dstart + (float)c * ((dstop - dstart) / 511.0f));
            const int RL = nsel ? HY_RLENC : HY_RLEN, off = n + 47; const float rn1 = 1.0f / (float)(n - 1);
            bf16* Rb = (bf16*)(ws + WS_GF + l * GF_STRIDE + (nsel ? GF_CTX : 0));
#pragma unroll
            for (int q = 0; q < 4; ++q) { const int o = q >> 1, side = q & 1; const float b3 = a.in[I_HYB3][l * 2048 + q * 512 + c];
                bf16* Rc = Rb + ((size_t)o * 512 + c) * RL;
#pragma unroll
                for (int p = 0; p < 8; ++p) { const int pos = p0 + p; const float t = (float)pos * rn1; const float val = (acc[q][p] + b3) * __expf(-t * delta);
                    if (side == 0) Rc[off - pos] = (bf16)f2bf(val);
                    else if (pos >= 1) Rc[off + pos] = (bf16)f2bf(val); }
                if (p0 == 0 && side == 0) { for (int m = 0; m < 48; ++m) Rc[m] = 0; for (int m = off + n; m < RL; ++m) Rc[m] = 0; } }
            __syncthreads();
        }
    }
}

__device__ __forceinline__ void stage_xinit_norm1(const Ctx& F) {
    const auto& a = *F.a; unsigned char* ws = a.ws; const int lane = F.lane;
    const int gw = F.bid * NWAVES + F.wave, NGW = F.G * NWAVES;
    float* X = (float*)(ws + WS_X); bf16* H = (bf16*)(ws + WS_H); const float* MOD = (const float*)(ws + WS_MOD);
    f32x4 ngv[4];
#pragma unroll
    for (int j = 0; j < 4; ++j) ngv[j] = ((const f32x4*)a.in[I_N1G] + lane)[64 * j];
    const int nt = (SEQ - gw + NGW - 1) / NGW > 0 ? (SEQ - gw + NGW - 1) / NGW : 0;
    const int nc = (T_CTX - gw + NGW - 1) / NGW > 0 ? (T_CTX - gw + NGW - 1) / NGW : 0;
    const int nrow = nt * BATCH + nc;
    f32x4 xn[4], shn[4], scn[4];
#define XN_LOAD(k_) do { const int k2_ = (k_); int row_, w_; const float* src_; \
        if (k2_ < nt * BATCH) { const int t_ = gw + (k2_ >> 3) * NGW, b_ = k2_ & 7; row_ = b_ * SEQ + t_; w_ = b_; src_ = a.in[I_X] + (size_t)row_ * D; } \
        else { const int r_ = gw + (k2_ - nt * BATCH) * NGW; row_ = T_LAT + r_; w_ = 8; src_ = a.in[I_CTX] + (size_t)r_ * D; } \
        _Pragma("unroll") for (int j = 0; j < 4; ++j) { xn[j] = ((const f32x4*)src_ + lane)[64 * j]; shn[j] = ((const f32x4*)(MOD + (size_t)w_ * 6144) + lane)[64 * j]; scn[j] = ((const f32x4*)(MOD + (size_t)w_ * 6144 + 1024) + lane)[64 * j]; } } while (0)
    if (nrow > 0) XN_LOAD(0);
    f32x4 pe[4];
#pragma unroll
    for (int j = 0; j < 4; ++j) pe[j] = (f32x4){0.f, 0.f, 0.f, 0.f};
#pragma unroll 1
    for (int k = 0; k < nrow; ++k) {
        const bool lat = k < nt * BATCH;
        int row;
        if (lat) { const int t = gw + (k >> 3) * NGW, b = k & 7; row = b * SEQ + t;
            if (b == 0) { const float pr = (float)(t >> 6), pc = (float)(t & 63);
#pragma unroll
                for (int j = 0; j < 4; ++j)
#pragma unroll
                    for (int e = 0; e < 4; ++e) { const float om = __builtin_amdgcn_exp2f((float)(4 * lane + e) * (-13.287712379549449f / 256.0f)); const float ang = ((j < 2) ? pr : pc) * om; pe[j][e] = (j & 1) ? __cosf(ang) : __sinf(ang); } } }
        else row = T_LAT + gw + (k - nt * BATCH) * NGW;
        f32x4 v[4], sh[4], sc[4];
#pragma unroll
        for (int j = 0; j < 4; ++j) { v[j] = lat ? xn[j] + pe[j] : xn[j]; sh[j] = shn[j]; sc[j] = scn[j]; }
        if (k + 1 < nrow) XN_LOAD(k + 1);
        f32x4* xo = (f32x4*)(X + (size_t)row * D) + lane;
        float ss = 0.f;
#pragma unroll
        for (int j = 0; j < 4; ++j) { xo[64 * j] = v[j]; ss += (v[j][0] * v[j][0] + v[j][1] * v[j][1]) + (v[j][2] * v[j][2] + v[j][3] * v[j][3]); }
        const float rstd = __builtin_amdgcn_rsqf(wave_sum(ss) * (1.f / D) + 1e-6f);
        v2u* ho = (v2u*)(H + (size_t)row * D) + lane;
#pragma unroll
        for (int j = 0; j < 4; ++j) { const f32x4 h = v[j] * rstd * ngv[j] * (sc[j] + 1.0f) + sh[j]; v2u o; o.x = pk2(h[0], h[1]); o.y = pk2(h[2], h[3]); ho[64 * j] = o; }
    }
#undef XN_LOAD
}

__device__ __forceinline__ void stage_norm1(const Ctx& F, int l) {
    const auto& a = *F.a; unsigned char* ws = a.ws; const int lane = F.lane;
    const int gw = F.bid * NWAVES + F.wave, NGW = F.G * NWAVES;
    float* X = (float*)(ws + WS_X); bf16* H = (bf16*)(ws + WS_H); const float* MOD = (const float*)(ws + WS_MOD);
    const bf16* YS = (const bf16*)(ws + WS_XS); const int* POS = (const int*)(ws + WS_POS); const float* GATE = (const float*)(ws + WS_GATE);
    const int nrows = (l == DEPTH) ? T_LAT : T_ALL;
    f32x4 ngv[4];
    { const f32x4* ngp = (l == DEPTH) ? (const f32x4*)a.in[I_FING] + lane : (const f32x4*)(a.in[I_N1G] + l * D) + lane;
#pragma unroll
      for (int j = 0; j < 4; ++j) ngv[j] = ngp[64 * j]; }
    f32x4 vn[4]; v2u ysn[4][4]; int4 pnn = make_int4(0, 0, 0, 0); f32x4 gn = (f32x4){0.f, 0.f, 0.f, 0.f}, gnn = gn;
#pragma unroll
    for (int k = 0; k < 4; ++k)
#pragma unroll
        for (int j = 0; j < 4; ++j) ysn[k][j] = (v2u){0u, 0u};
#define N1_LDYS(p4_) do { const int pk_[4] = {(p4_).x, (p4_).y, (p4_).z, (p4_).w}; _Pragma("unroll") for (int k = 0; k < 4; ++k) { const v2u* yr_ = (const v2u*)(YS + (size_t)pk_[k] * D) + lane; \
        _Pragma("unroll") for (int j = 0; j < 4; ++j) ysn[k][j] = yr_[64 * j]; } } while (0)
    if (gw < nrows) {
#pragma unroll
        for (int j = 0; j < 4; ++j) vn[j] = ((const f32x4*)(X + (size_t)gw * D) + lane)[64 * j];
        if (l > 0) { const int4 p0 = *(const int4*)(POS + gw * 4); gn = *(const f32x4*)(GATE + gw * 4);
            if (gw + NGW < nrows) { pnn = *(const int4*)(POS + (gw + NGW) * 4); gnn = *(const f32x4*)(GATE + (gw + NGW) * 4); }
            N1_LDYS(p0); } }
#pragma unroll 1
    for (int row = gw; row < nrows; row += NGW) {
        const int w = row < T_LAT ? (row >> 12) : 8;
        f32x4* xr = (f32x4*)(X + (size_t)row * D) + lane;
        f32x4 v[4]; v2u ysc[4][4];
#pragma unroll
        for (int j = 0; j < 4; ++j) v[j] = vn[j];
#pragma unroll
        for (int k = 0; k < 4; ++k)
#pragma unroll
            for (int j = 0; j < 4; ++j) ysc[k][j] = ysn[k][j];
        const f32x4 gc = gn; const int4 pnx = pnn; gn = gnn;
        const int rn = row + NGW, rnn = row + 2 * NGW;
        if (rn < nrows) {
#pragma unroll
            for (int j = 0; j < 4; ++j) vn[j] = ((const f32x4*)(X + (size_t)rn * D) + lane)[64 * j];
            if (l > 0) N1_LDYS(pnx); }
        if (l > 0 && rnn < nrows) { pnn = *(const int4*)(POS + rnn * 4); gnn = *(const f32x4*)(GATE + rnn * 4); }
        f32x4 m0[4], m1[4], m2[4];
        if (l < DEPTH) {
#pragma unroll
            for (int j = 0; j < 4; ++j) { m0[j] = ((const f32x4*)(MOD + (size_t)(l * 9 + w) * 6144) + lane)[64 * j]; m1[j] = ((const f32x4*)(MOD + (size_t)(l * 9 + w) * 6144 + 1024) + lane)[64 * j]; } }
        if (l > 0) {
#pragma unroll
            for (int j = 0; j < 4; ++j) m2[j] = ((const f32x4*)(MOD + (size_t)((l - 1) * 9 + w) * 6144 + 5120) + lane)[64 * j];
            f32x4 mo[4];
#pragma unroll
            for (int j = 0; j < 4; ++j) mo[j] = (f32x4){0.f, 0.f, 0.f, 0.f};
#pragma unroll
            for (int k = 0; k < TOPK; ++k) { const float g = gc[k];
#pragma unroll
                for (int j = 0; j < 4; ++j) { const v2u y = ysc[k][j]; mo[j][0] += g * bflo(y.x); mo[j][1] += g * bfhi(y.x); mo[j][2] += g * bflo(y.y); mo[j][3] += g * bfhi(y.y); } }
#pragma unroll
            for (int j = 0; j < 4; ++j) { v[j] = v[j] + m2[j] * mo[j]; if (l < DEPTH) xr[64 * j] = v[j]; }
        }
        float ss = 0.f;
#pragma unroll
        for (int j = 0; j < 4; ++j) ss += (v[j][0] * v[j][0] + v[j][1] * v[j][1]) + (v[j][2] * v[j][2] + v[j][3] * v[j][3]);
        const float rstd = __builtin_amdgcn_rsqf(wave_sum(ss) * (1.f / D) + 1e-6f);
        if (l == DEPTH) {
            f32x4* o = (f32x4*)(a.out + (size_t)row * D) + lane;
#pragma unroll
            for (int j = 0; j < 4; ++j) o[64 * j] = v[j] * rstd * ngv[j];
        } else {
            v2u* ho = (v2u*)(H + (size_t)row * D) + lane;
#pragma unroll
            for (int j = 0; j < 4; ++j) { const f32x4 h = v[j] * rstd * ngv[j] * (m1[j] + 1.0f) + m0[j]; v2u o; o.x = pk2(h[0], h[1]); o.y = pk2(h[2], h[3]); ho[64 * j] = o; }
        }
    }
#undef N1_LDYS
}

__device__ __forceinline__ void stage_rw_prep1(const Ctx& F, int l, int wv, int nwv) {
    const auto& a = *F.a; unsigned char* ws = a.ws;
    const bf16* __restrict__ Z = (const bf16*)(ws + WS_Z); bf16* __restrict__ ARW = (bf16*)(ws + WS_ARW);
    const int j = 4 * (F.tid & 63), col = 1536 + j;
    const float* cw = a.in[I_RWCW] + (size_t)l * 3 * 1792;
    const f32x4 w0 = *(const f32x4*)(cw + col), w1 = *(const f32x4*)(cw + 1792 + col), w2 = *(const f32x4*)(cw + 2 * 1792 + col), cb = *(const f32x4*)(a.in[I_RWCB] + l * 1792 + col);
#pragma unroll 4
    for (int row = wv; row < T_ALL; row += nwv) {
        int base, pos, n; row_seq(row, base, pos, n);
        const bf16* zc = Z + (size_t)row * IN_COLS + RW_OFF + col;
        const v2u z0 = *(const v2u*)zc;
        v2u zm = (v2u){0u, 0u}, zp = (v2u){0u, 0u};
        if (pos > 0) zm = *(const v2u*)(zc - IN_COLS);
        if (pos < n - 1) zp = *(const v2u*)(zc + IN_COLS);
        f32x4 v = (f32x4){bflo(zm.x), bfhi(zm.x), bflo(zm.y), bfhi(zm.y)} * w0 + (f32x4){bflo(z0.x), bfhi(z0.x), bflo(z0.y), bfhi(z0.y)} * w1 + (f32x4){bflo(zp.x), bfhi(zp.x), bflo(zp.y), bfhi(zp.y)} * w2 + cb;
#pragma unroll
        for (int e2 = 0; e2 < 4; ++e2) { if (j < 64) v[e2] = tanh_fast(v[e2]); else if (j >= 128) v[e2] = sigm(v[e2]); }
        v2u o; o.x = pk2(v[0], v[1]); o.y = pk2(v[2], v[3]);
        *(v2u*)(ARW + (size_t)row * 256 + j) = o;
    }
}

__device__ __forceinline__ void stage_rw_prep2(const Ctx& F, int l) {
    const auto& a = *F.a; unsigned char* ws = a.ws; const int lane = F.lane;
    const bf16* Z = (const bf16*)(ws + WS_Z); const bf16* P = (const bf16*)(ws + WS_P); bf16* SCN = (bf16*)(ws + WS_SCN);
    const int gw = F.bid * NWAVES + F.wave, NGW = F.G * NWAVES;
    constexpr int TR = 17, NRT = T_ALL / TR;
    const float* cw = a.in[I_RWCW] + (size_t)l * 3 * 1792; const float* cbp = a.in[I_RWCB] + l * 1792;
    for (int tile = gw; tile < NRT * 4; tile += NGW) {
        const int rt = tile % NRT, hp = tile / NRT, row0 = rt * TR, c0 = hp * 128 + 2 * lane;
        f32x2 w[3][3], cb[3];
#pragma unroll
        for (int s = 0; s < 3; ++s) { cb[s] = *(const f32x2*)(cbp + s * 512 + c0);
#pragma unroll
            for (int j = 0; j < 3; ++j) w[s][j] = *(const f32x2*)(cw + j * 1792 + s * 512 + c0); }
        const f32x2 KKw = *(const f32x2*)(a.in[I_RWKK] + l * 512 + c0), KAw = *(const f32x2*)(a.in[I_RWKA] + l * 512 + c0);
        f32x2 W0[2], A0[2];
#pragma unroll
        for (int d = 0; d < 2; ++d) { W0[d] = *(const f32x2*)(a.in[I_RWW0] + (l * 2 + d) * 512 + c0); A0[d] = *(const f32x2*)(a.in[I_RWA0] + (l * 2 + d) * 512 + c0); }
        const unsigned* zb = (const unsigned*)(Z + RW_OFF + c0);
        unsigned zw[8][3], pw_[8][4];
#define P2_LDZ(j_) do { const int rr_ = row0 + (j_); if (rr_ >= 0 && rr_ < T_ALL) { _Pragma("unroll") for (int s = 0; s < 3; ++s) zw[((j_) + 1) & 7][s] = zb[(size_t)rr_ * (IN_COLS / 2) + s * 256]; } \
        else { _Pragma("unroll") for (int s = 0; s < 3; ++s) zw[((j_) + 1) & 7][s] = 0u; } } while (0)
#define P2_LDP(j_) do { const unsigned* pr_ = (const unsigned*)(P + (size_t)(row0 + (j_)) * 2560 + c0); pw_[(j_) & 7][0] = pr_[0]; pw_[(j_) & 7][1] = pr_[512]; pw_[(j_) & 7][2] = pr_[256]; pw_[(j_) & 7][3] = pr_[768]; } while (0)
        P2_LDZ(-1); P2_LDZ(0); P2_LDZ(1); P2_LDZ(2); P2_LDZ(3); P2_LDP(0); P2_LDP(1); P2_LDP(2);
#pragma unroll
        for (int i = 0; i < TR; ++i) {
            const int row = row0 + i; int base, pos, n; row_seq(row, base, pos, n);
            if (i + 4 <= TR) P2_LDZ(i + 4);
            if (i + 3 < TR) P2_LDP(i + 3);
            unsigned zm[3], z0[3], zp[3], pc_[4];
#pragma unroll
            for (int s = 0; s < 3; ++s) { zm[s] = zw[i & 7][s]; z0[s] = zw[(i + 1) & 7][s]; zp[s] = zw[(i + 2) & 7][s]; }
#pragma unroll
            for (int e = 0; e < 4; ++e) pc_[e] = pw_[i & 7][e];
            const float mlo = pos > 0 ? 1.f : 0.f, mhi = pos < n - 1 ? 1.f : 0.f;
            f32x2 u[3];
#pragma unroll
            for (int s = 0; s < 3; ++s) u[s] = (f32x2){bflo(zm[s]), bfhi(zm[s])} * mlo * w[s][0] + (f32x2){bflo(z0[s]), bfhi(z0[s])} * w[s][1] + (f32x2){bflo(zp[s]), bfhi(zp[s])} * mhi * w[s][2] + cb[s];
            const f32x2 r = u[0], k = u[1], v = u[2];
            f32x2 kk = k * KKw;
            const float ss = red32(kk[0] * kk[0] + kk[1] * kk[1]);
            kk = kk * (__builtin_amdgcn_rsqf(fmaxf(ss, 1e-24f)));
            unsigned* o = (unsigned*)(SCN + (size_t)row * 9 * 512 + c0);
            o[0] = pk2(r[0], r[1]); o[256] = pk2(v[0], v[1]); o[2 * 256] = pk2(kk[0], kk[1]);
#pragma unroll
            for (int d = 0; d < 2; ++d) {
                const unsigned pw = pc_[2 * d], pa = pc_[2 * d + 1];
                float ld[2], kd[2], be[2];
#pragma unroll
                for (int e = 0; e < 2; ++e) {
                    const float uu = W0[d][e] + (e ? bfhi(pw) : bflo(pw));
                    ld[e] = -0.60653065971263342f * sigm(uu);
                    const float av = sigm(A0[d][e] + (e ? bfhi(pa) : bflo(pa)));
                    kd[e] = k[e] * (1.f + (av - 1.f) * KAw[e]); be[e] = kk[e] * av; }
                o[(3 + 3 * d) * 256] = pk2(ld[0], ld[1]); o[(4 + 3 * d) * 256] = pk2(kd[0], kd[1]); o[(5 + 3 * d) * 256] = pk2(be[0], be[1]);
            }
        }
    }
}
#undef P2_LDZ
#undef P2_LDP

__device__ __forceinline__ int seq_row(int b, int d, int sidx) {
    if (sidx < CTXL) { const int t = d ? (CTXL - 1 - sidx) : sidx; return T_LAT + b * CTXL + t; }
    const int tl = sidx - CTXL; const int t = d ? (SEQ - 1 - tl) : tl; return b * SEQ + t;
}

constexpr int CW_WORK = 16384;
constexpr int CW_STAMP = 20480;
#ifdef PROBE_T
#ifndef PROBE_BID
#define PROBE_BID 0
#endif
#define PT(k) do { if (F.bid == PROBE_BID && F.tid == 0 && l == 0) ((unsigned long long*)(F.a->ws + WS_CTL + CW_STAMP * 4))[k] = __builtin_amdgcn_s_memrealtime(); } while (0)
#else
#define PT(k) do { } while (0)
#endif
__device__ __forceinline__ void rw_scan_item(const Ctx& F, int l, int it2) {
    const int it = it2 >> 1, half = it2 & 1;
    const auto& a = *F.a; unsigned char* ws = a.ws; const int tid = F.tid, lane = F.lane;
    const bf16* SCN = (const bf16*)(ws + WS_SCN); float* YD = (float*)(ws + WS_YDIR);
    LAS float* sbuf = (LAS float*)F.lds;
    LAS float* ybuf = (LAS float*)(F.lds + 49152);
    const bool comp = F.wave < 4;
    const int lt = tid & 255, ls = lt >> 4, lj = lt & 15;
    const int vl = lane >> 3, kq = lane & 7, vrow = half * 32 + (F.wave & 3) * 8 + vl;
    constexpr int NCH = (CTXL + SEQ) / 16;
    const int d = it & 1, h = (it >> 1) & 7, b = it >> 4;
    f32x2 S[4];
#pragma unroll
    for (int q = 0; q < 4; ++q) S[q] = (f32x2){0.f, 0.f};
    v2u ldr[6];
#define RW_ISSUE(c) do { const int row_ = seq_row(b, d, (c) * 16 + ls); const v2u* p_ = (const v2u*)(SCN + (size_t)row_ * 9 * 512 + h * 64) + lj; \
        ldr[0] = p_[2 * 128]; ldr[1] = p_[(3 + 3 * d) * 128]; ldr[2] = p_[(5 + 3 * d) * 128]; ldr[3] = p_[(4 + 3 * d) * 128]; ldr[4] = p_[0]; ldr[5] = p_[128]; } while (0)
#define RW_WRITE(bufi) do { LAS float* o_ = sbuf + (((bufi) * 16 + ls) * 6) * 64 + 4 * lj; \
        *(LAS f32x4*)(o_) = (f32x4){-bflo(ldr[0].x), -bfhi(ldr[0].x), -bflo(ldr[0].y), -bfhi(ldr[0].y)}; \
        *(LAS f32x4*)(o_ + 64) = (f32x4){__expf(bflo(ldr[1].x)), __expf(bfhi(ldr[1].x)), __expf(bflo(ldr[1].y)), __expf(bfhi(ldr[1].y))}; \
        *(LAS f32x4*)(o_ + 128) = (f32x4){bflo(ldr[2].x), bfhi(ldr[2].x), bflo(ldr[2].y), bfhi(ldr[2].y)}; *(LAS f32x4*)(o_ + 192) = (f32x4){bflo(ldr[3].x), bfhi(ldr[3].x), bflo(ldr[3].y), bfhi(ldr[3].y)}; \
        *(LAS f32x4*)(o_ + 256) = (f32x4){bflo(ldr[4].x), bfhi(ldr[4].x), bflo(ldr[4].y), bfhi(ldr[4].y)}; *(LAS f32x4*)(o_ + 320) = (f32x4){bflo(ldr[5].x), bfhi(ldr[5].x), bflo(ldr[5].y), bfhi(ldr[5].y)}; } while (0)
#define RW_FLUSH(c) do { const int row_ = seq_row(b, d, (c) * 16 + ls); \
        *(f32x2*)(YD + ((size_t)d * T_ALL + row_) * 512 + h * 64 + half * 32 + 2 * lj) = *(const LAS f32x2*)(ybuf + ((((c) & 1) * 16 + ls) * 64) + half * 32 + 2 * lj); } while (0)
    if (!comp) { RW_ISSUE(0); RW_WRITE(0); RW_ISSUE(1); }
    __syncthreads();
#pragma unroll 1
    for (int c = 0; c < NCH; ++c) {
        const int bi = c & 1;
        if (!comp) {
            if (c + 1 < NCH) RW_WRITE(bi ^ 1);
            if (c + 2 < NCH) RW_ISSUE(c + 2);
            if (c > 0) RW_FLUSH(c - 1);
        } else {
        float yv[16];
        f32x4 opA[10], opB[10]; float vvA, vvB;
#define RW_LD(op, vvx, s_) do { const LAS float* sp_ = sbuf + ((bi * 16 + (s_)) * 6) * 64 + 8 * kq; \
            _Pragma("unroll") for (int q_ = 0; q_ < 5; ++q_) { op[2 * q_] = *(const LAS f32x4*)(sp_ + 64 * q_); op[2 * q_ + 1] = *(const LAS f32x4*)(sp_ + 64 * q_ + 4); } \
            vvx = sbuf[((bi * 16 + (s_)) * 6 + 5) * 64 + vrow]; } while (0)
#define RW_COMP(op, vvx, s_) do { \
            const f32x4 a0 = op[0], a1 = op[1], w0 = op[2], w1 = op[3], b0 = op[4], b1 = op[5], k0 = op[6], k1 = op[7], r0 = op[8], r1 = op[9]; \
            const f32x2 vv2 = (f32x2){vvx, vvx}; \
            const f32x2 p0 = S[1] * (f32x2){a0[2], a0[3]} + S[0] * (f32x2){a0[0], a0[1]}; \
            const f32x2 p1 = S[3] * (f32x2){a1[2], a1[3]} + S[2] * (f32x2){a1[0], a1[1]}; \
            const f32x2 t0 = S[0] * (f32x2){w0[0], w0[1]} + vv2 * (f32x2){k0[0], k0[1]}; \
            const f32x2 t1 = S[1] * (f32x2){w0[2], w0[3]} + vv2 * (f32x2){k0[2], k0[3]}; \
            const f32x2 t2 = S[2] * (f32x2){w1[0], w1[1]} + vv2 * (f32x2){k1[0], k1[1]}; \
            const f32x2 t3 = S[3] * (f32x2){w1[2], w1[3]} + vv2 * (f32x2){k1[2], k1[3]}; \
            const f32x2 ac = p0 + p1; \
            const float sa = red8(ac[0] + ac[1]); \
            const f32x2 sa2 = (f32x2){sa, sa}; \
            S[0] = sa2 * (f32x2){b0[0], b0[1]} + t0; S[1] = sa2 * (f32x2){b0[2], b0[3]} + t1; \
            S[2] = sa2 * (f32x2){b1[0], b1[1]} + t2; S[3] = sa2 * (f32x2){b1[2], b1[3]} + t3; \
            const f32x2 q0 = S[1] * (f32x2){r0[2], r0[3]} + S[0] * (f32x2){r0[0], r0[1]}; \
            const f32x2 q1 = S[3] * (f32x2){r1[2], r1[3]} + S[2] * (f32x2){r1[0], r1[1]}; \
            const f32x2 yc = q0 + q1; \
            yv[s_] = red8(yc[0] + yc[1]); } while (0)
        RW_LD(opA, vvA, 0);
#pragma unroll
        for (int s = 0; s < 16; s += 2) {
            RW_LD(opB, vvB, s + 1);
            __builtin_amdgcn_sched_barrier(0);
            RW_COMP(opA, vvA, s);
            __builtin_amdgcn_sched_barrier(0);
            if (s + 2 < 16) RW_LD(opA, vvA, s + 2);
            __builtin_amdgcn_sched_barrier(0);
            RW_COMP(opB, vvB, s + 1);
            __builtin_amdgcn_sched_barrier(0);
        }
#undef RW_LD
#undef RW_COMP
#pragma unroll
        for (int s = 0; s < 16; ++s) if ((s & 7) == kq) ybuf[((bi * 16 + s) * 64) + vrow] = yv[s];
        }
        __syncthreads();
    }
    if (!comp) RW_FLUSH(NCH - 1);
    __syncthreads();
#undef RW_ISSUE
#undef RW_WRITE
#undef RW_FLUSH
}

constexpr size_t WS_RWSCR = WS_YHY;
constexpr int RWS_QY = 0, RWS_YV = 2048, RWS_PZ = 4096, RWS_ZV = 12288, RWS_SLOT = 20480;
typedef __bf16 bf16x8n __attribute__((ext_vector_type(8)));
__device__ __forceinline__ f32x4 mma16(const bf16x8 a, const bf16x8 b, const f32x4 c) { return __builtin_amdgcn_mfma_f32_16x16x32_bf16(a, b, c, 0, 0, 0); }
__device__ __forceinline__ float dpp_shr(float x, const int n) {
    const int v = __builtin_bit_cast(int, x); int r;
    if (n == 1) r = __builtin_amdgcn_update_dpp(0, v, 0x111, 0xF, 0xF, true); else if (n == 2) r = __builtin_amdgcn_update_dpp(0, v, 0x112, 0xF, 0xF, true);
    else if (n == 4) r = __builtin_amdgcn_update_dpp(0, v, 0x114, 0xF, 0xF, true); else r = __builtin_amdgcn_update_dpp(0, v, 0x118, 0xF, 0xF, true);
    return __builtin_bit_cast(float, r);
}
__device__ __forceinline__ v4u pack8(const float (&x)[8]) { v4u o; o.x = pk2(x[0], x[1]); o.y = pk2(x[2], x[3]); o.z = pk2(x[4], x[5]); o.w = pk2(x[6], x[7]); return o; }
__device__ __forceinline__ void unpack8(const v4u u, float (&x)[8]) { x[0] = bflo(u.x); x[1] = bfhi(u.x); x[2] = bflo(u.y); x[3] = bfhi(u.y); x[4] = bflo(u.z); x[5] = bfhi(u.z); x[6] = bflo(u.w); x[7] = bfhi(u.w); }
constexpr int LDS_ZERO16 = 131072 + 3072;
typedef short bf16x4s __attribute__((ext_vector_type(4)));
__device__ __forceinline__ bf16x4s frag16k(const LAS bf16* m, int rowbase, int lane) { return __builtin_bit_cast(bf16x4s, *(const LAS v2u*)(m + (rowbase + (lane & 15)) * 16 + 4 * (lane >> 4))); }
__device__ __forceinline__ f32x4 mma16(const bf16x4s a, const bf16x4s b, const f32x4 c) { return __builtin_amdgcn_mfma_f32_16x16x16bf16_1k(a, b, c, 0, 0, 0); }
#define frag16(m_, rb_, ln_) frag16k(m_, rb_, ln_)
__device__ __forceinline__ void st_colmaj(LAS bf16* m, int colbase, const f32x4 d, int lane) {
    v2u o; o.x = pk2(d[0], d[1]); o.y = pk2(d[2], d[3]); *(LAS v2u*)(m + (colbase + (lane & 15)) * 16 + 4 * (lane >> 4)) = o; }
__device__ __forceinline__ void st_rowmaj(LAS bf16* m, const f32x4 d, int lane) {
#pragma unroll
    for (int r = 0; r < 4; ++r) m[(4 * (lane >> 4) + r) * 16 + (lane & 15)] = (bf16)f2bf(d[r]); }
template <int KS0, int KS1>
__device__ __forceinline__ void rw_chunk_load(const Ctx& F, int b, int h, int d, int cidx, v4u (&raw)[12]) {
    const int lane = opaque_v(F.lane), t = lane & 15, kg = lane >> 4;
    const bf16* base = (const bf16*)(F.a->ws + WS_SCN) + (size_t)seq_row(b, d, 16 * cidx + t) * 9 * 512 + h * 64;
#pragma unroll
    for (int ks = KS0; ks < KS1; ++ks) { const int off = 32 * ks + 8 * kg;
        raw[6 * ks + 0] = *(const v4u*)(base + (3 + 3 * d) * 512 + off); raw[6 * ks + 1] = *(const v4u*)(base + 2 * 512 + off); raw[6 * ks + 2] = *(const v4u*)(base + off);
        raw[6 * ks + 3] = *(const v4u*)(base + (5 + 3 * d) * 512 + off); raw[6 * ks + 4] = *(const v4u*)(base + (4 + 3 * d) * 512 + off); raw[6 * ks + 5] = *(const v4u*)(base + 512 + off); }
}
__device__ __forceinline__ void rw_chunk_task2(const Ctx& F, const v4u (&raw)[12], LAS unsigned char* wl, f32x4 (&yv)[4], f32x4 (&zv)[4][4]) {
    const int lane = opaque_v(F.lane), t = lane & 15, kg = lane >> 4;
    LAS bf16* ATt = (LAS bf16*)(wl); LAS bf16* RBr = (LAS bf16*)(wl + 2048); LAS bf16* BHt = (LAS bf16*)(wl + 4096); LAS bf16* KHt = (LAS bf16*)(wl + 6144); LAS bf16* VTt = (LAS bf16*)(wl + 8192);
    LAS bf16* WAt = (LAS bf16*)(wl + 10240); LAS bf16* N_r = (LAS bf16*)(wl + 12288); LAS bf16* N_c = (LAS bf16*)(wl + 12800); LAS bf16* T_r = (LAS bf16*)(wl + 13312);
    LAS bf16* AK_r = (LAS bf16*)(wl + 13824); LAS bf16* RB2 = (LAS bf16*)(wl + 14336); LAS bf16* RK_r = (LAS bf16*)(wl + 14848); LAS float* GCl = (LAS float*)(wl + 15360);
    bf16x8 fAb[2], fRb[2], fBb[2], fKb[2];
#pragma unroll
    for (int ks = 0; ks < 2; ++ks) {
        const int off = 32 * ks + 8 * kg;
        float ea[8], er[8], eb[8], eh[8];
        { const v4u uld = raw[6 * ks + 0]; float ld[8]; unpack8(uld, ld);
#pragma unroll
          for (int j = 0; j < 8; ++j) { float c = ld[j]; c += dpp_shr(c, 1); c += dpp_shr(c, 2); c += dpp_shr(c, 4); c += dpp_shr(c, 8);
              const float tot = __builtin_bit_cast(float, __builtin_amdgcn_ds_bpermute((lane | 15) << 2, __builtin_bit_cast(int, c)));
              ea[j] = __expf(c - ld[j]); er[j] = __expf(c); eb[j] = __expf(-c); const float et_ = __expf(tot); eh[j] = et_ * eb[j];
              if (t == 0) GCl[off + j] = et_; } }
        { const v4u u = raw[6 * ks + 1]; float x[8]; unpack8(u, x);
#pragma unroll
          for (int j = 0; j < 8; ++j) { x[j] = -x[j] * ea[j]; ATt[(off + j) * 16 + t] = (bf16)f2bf(x[j]); }
          const v4u p = pack8(x); fAb[ks] = __builtin_bit_cast(bf16x8, p); }
        { const v4u u = raw[6 * ks + 2]; float x[8]; unpack8(u, x);
#pragma unroll
          for (int j = 0; j < 8; ++j) x[j] = x[j] * er[j];
          const v4u p = pack8(x); fRb[ks] = __builtin_bit_cast(bf16x8, p); *(LAS v4u*)(RBr + t * 64 + off) = p; }
        { const v4u u = raw[6 * ks + 3]; float x[8], y[8]; unpack8(u, x);
#pragma unroll
          for (int j = 0; j < 8; ++j) { y[j] = x[j] * eb[j]; BHt[(off + j) * 16 + t] = (bf16)f2bf(x[j] * eh[j]); }
          const v4u p = pack8(y); fBb[ks] = __builtin_bit_cast(bf16x8, p); }
        { const v4u u = raw[6 * ks + 4]; float x[8], y[8]; unpack8(u, x);
#pragma unroll
          for (int j = 0; j < 8; ++j) { y[j] = x[j] * eb[j]; KHt[(off + j) * 16 + t] = (bf16)f2bf(x[j] * eh[j]); }
          const v4u p = pack8(y); fKb[ks] = __builtin_bit_cast(bf16x8, p); }
        { const v4u u = raw[6 * ks + 5];
          const bf16 e0 = (bf16)(u.x & 0xffff), e1 = (bf16)(u.x >> 16), e2 = (bf16)(u.y & 0xffff), e3 = (bf16)(u.y >> 16), e4 = (bf16)(u.z & 0xffff), e5 = (bf16)(u.z >> 16), e6 = (bf16)(u.w & 0xffff), e7 = (bf16)(u.w >> 16);
          VTt[(off + 0) * 16 + t] = e0; VTt[(off + 1) * 16 + t] = e1; VTt[(off + 2) * 16 + t] = e2; VTt[(off + 3) * 16 + t] = e3; VTt[(off + 4) * 16 + t] = e4; VTt[(off + 5) * 16 + t] = e5; VTt[(off + 6) * 16 + t] = e6; VTt[(off + 7) * 16 + t] = e7; }
        __builtin_amdgcn_sched_barrier(0);
    }
    asm volatile("" ::: "memory");
    const f32x4 z4 = (f32x4){0.f, 0.f, 0.f, 0.f};
    f32x4 n0 = mma16(fAb[1], fBb[1], mma16(fAb[0], fBb[0], z4)), aak = mma16(fAb[1], fKb[1], mma16(fAb[0], fKb[0], z4));
    f32x4 arb = mma16(fRb[1], fBb[1], mma16(fRb[0], fBb[0], z4)), ark = mma16(fRb[1], fKb[1], mma16(fRb[0], fKb[0], z4));
#pragma unroll
    for (int r = 0; r < 4; ++r) { const int tt = 4 * kg + r; if (!(t < tt)) { n0[r] = 0.f; aak[r] = 0.f; } if (!(t <= tt)) { arb[r] = 0.f; ark[r] = 0.f; } }
    st_rowmaj(AK_r, aak, lane); st_rowmaj(RB2, arb, lane); st_rowmaj(RK_r, ark, lane); asm volatile("" ::: "memory");
    f32x4 accT = n0;
#pragma unroll
    for (int r = 0; r < 4; ++r) accT[r] += (4 * kg + r == t) ? 1.f : 0.f;
    f32x4 nn = n0;
#pragma unroll
    for (int itn = 0; itn < 3; ++itn) {
        st_rowmaj(N_r, nn, lane); st_colmaj(N_c, 0, nn, lane); st_rowmaj(T_r, accT, lane); asm volatile("" ::: "memory");
        const auto fa = frag16(N_r, 0, lane), fb = frag16(N_c, 0, lane), ft = frag16(T_r, 0, lane);
        nn = mma16(fa, fb, z4); asm volatile("" ::: "memory");
        st_colmaj(N_c, 0, nn, lane); asm volatile("" ::: "memory");
        const auto fb2 = frag16(N_c, 0, lane);
        accT = mma16(ft, fb2, accT); asm volatile("" ::: "memory");
    }
    st_rowmaj(T_r, accT, lane); asm volatile("" ::: "memory");
    const auto fT = frag16(T_r, 0, lane), fAK = frag16(AK_r, 0, lane), fARB = frag16(RB2, 0, lane), fARK = frag16(RK_r, 0, lane);
#pragma unroll
    for (int kt = 0; kt < 4; ++kt) { const f32x4 dd = mma16(fT, frag16(ATt, 16 * kt, lane), z4); st_colmaj(WAt, 16 * kt, dd, lane); } asm volatile("" ::: "memory");
    f32x4 qy[4];
    { const auto fArbT = frag16(RB2, 0, lane);
#pragma unroll
      for (int kt = 0; kt < 4; ++kt) { const v2u ri = *(const LAS v2u*)(RBr + t * 64 + 16 * kt + 4 * kg);
          qy[kt] = mma16(frag16(WAt, 16 * kt, lane), fArbT, (f32x4){bflo(ri.x), bfhi(ri.x), bflo(ri.y), bfhi(ri.y)}); } }
    asm volatile("" ::: "memory");
#pragma unroll
    for (int vt = 0; vt < 4; ++vt) { const f32x4 dd = mma16(fAK, frag16(VTt, 16 * vt, lane), z4); st_colmaj(ATt, 16 * vt, dd, lane); } asm volatile("" ::: "memory");
    LAS bf16* UVt = RBr;
#pragma unroll
    for (int vt = 0; vt < 4; ++vt) { const f32x4 dd = mma16(fT, frag16(ATt, 16 * vt, lane), z4); st_colmaj(UVt, 16 * vt, dd, lane); } asm volatile("" ::: "memory");
#pragma unroll
    for (int vt = 0; vt < 4; ++vt) { const auto fU = frag16(UVt, 16 * vt, lane), fV = frag16(VTt, 16 * vt, lane);
        yv[vt] = mma16(fARK, fV, mma16(fARB, fU, z4));
#pragma unroll
        for (int ktp = 0; ktp < 4; ++ktp) zv[vt][ktp] = mma16(frag16(KHt, 16 * ktp, lane), fV, mma16(frag16(BHt, 16 * ktp, lane), fU, z4)); }
    f32x4 pz[4][4];
#pragma unroll
    for (int ktp = 0; ktp < 4; ++ktp) { const auto fBh = frag16(BHt, 16 * ktp, lane);
#pragma unroll
        for (int kt = 0; kt < 4; ++kt) { f32x4 dd = mma16(frag16(WAt, 16 * kt, lane), fBh, z4);
            if (kt == ktp) {
#pragma unroll
                for (int r = 0; r < 4; ++r) if (4 * kg + r == t) dd[r] += GCl[16 * kt + t]; }
            pz[ktp][kt] = dd; } }
    asm volatile("s_waitcnt lgkmcnt(0)" ::: "memory");
#pragma unroll
    for (int ktp = 0; ktp < 4; ++ktp) { LAS bf16* reg = (LAS bf16*)(wl + (ktp < 2 ? ktp * 2048 : (ktp + 1) * 2048));
#pragma unroll
        for (int kt = 0; kt < 4; ++kt) { v2u o; o.x = pk2(pz[ktp][kt][0], pz[ktp][kt][1]); o.y = pk2(pz[ktp][kt][2], pz[ktp][kt][3]); *(LAS v2u*)(reg + t * 64 + 16 * kt + 4 * kg) = o; } }
#pragma unroll
    for (int kt = 0; kt < 4; ++kt) { v2u o; o.x = pk2(qy[kt][0], qy[kt][1]); o.y = pk2(qy[kt][2], qy[kt][3]); *(LAS v2u*)(BHt + t * 64 + 16 * kt + 4 * kg) = o; }
    asm volatile("s_waitcnt lgkmcnt(0)" ::: "memory");
}
constexpr int RWZ_OFF = LDSCTL_OFF + 8192, RWF_OFF = LDSCTL_OFF + 2048;
__device__ __forceinline__ void rw_chunk_item2(const Ctx& F, int l, int it, size_t yoff = WS_YDIR) {
    const auto& a = *F.a; unsigned char* ws = a.ws; const int lane = opaque_v(F.lane), t = lane & 15, kg = lane >> 4;
    const int d = it & 1, h = (it >> 1) & 7, b = it >> 4;
    float* YD = (float*)(ws + yoff);
    LAS unsigned char* wl = F.lds + F.wave * 15616;
    LAS bf16* ZS = (LAS bf16*)(F.lds + RWZ_OFF);
    volatile LAS int* flag = (volatile LAS int*)(F.lds + RWF_OFF);
    for (int i = F.tid; i < 2048; i += NTHREADS) ((LAS unsigned*)ZS)[i] = 0u;
    if (F.tid == 0) *flag = 0;
    __syncthreads();
    constexpr int NCHK = (CTXL + SEQ) / 16;
    v4u raw[12];
    rw_chunk_load<0, 2>(F, b, h, d, F.wave, raw);
#pragma unroll 1
    for (int c = F.wave; c < NCHK; c += NWAVES) {
        f32x4 yv[4], zv[4][4];
        rw_chunk_task2(F, raw, wl, yv, zv);
        if (c + NWAVES < NCHK) rw_chunk_load<0, 2>(F, b, h, d, c + NWAVES, raw);
        while (*flag < c) __builtin_amdgcn_s_sleep(1);
        asm volatile("" ::: "memory");
        const LAS bf16* Zc = ZS + (c & 1) * 4096; LAS bf16* Zn = ZS + ((c + 1) & 1) * 4096;
        bf16x8 zb[4][2];
#pragma unroll
        for (int vb = 0; vb < 4; ++vb)
#pragma unroll
            for (int ks = 0; ks < 2; ++ks) zb[vb][ks] = *(const LAS bf16x8*)(Zc + (16 * vb + t) * 64 + 32 * ks + 8 * kg);
        { const LAS bf16* Qr = (const LAS bf16*)(wl + 4096); const bf16x8 q0 = *(const LAS bf16x8*)(Qr + t * 64 + 8 * kg), q1 = *(const LAS bf16x8*)(Qr + t * 64 + 32 + 8 * kg);
#pragma unroll
          for (int vb = 0; vb < 4; ++vb) { const f32x4 y = mma16(q1, zb[vb][1], mma16(q0, zb[vb][0], yv[vb]));
#pragma unroll
              for (int r = 0; r < 4; ++r) { const int row = seq_row(b, d, c * 16 + 4 * kg + r); YD[((size_t)d * T_ALL + row) * 512 + h * 64 + 16 * vb + t] = y[r]; } } }
#pragma unroll
        for (int ktp = 0; ktp < 4; ++ktp) { const LAS bf16* Pr = (const LAS bf16*)(wl + (ktp < 2 ? ktp * 2048 : (ktp + 1) * 2048));
            const bf16x8 p0 = *(const LAS bf16x8*)(Pr + t * 64 + 8 * kg), p1 = *(const LAS bf16x8*)(Pr + t * 64 + 32 + 8 * kg);
#pragma unroll
            for (int vb = 0; vb < 4; ++vb) { const f32x4 z = mma16(p1, zb[vb][1], mma16(p0, zb[vb][0], zv[vb][ktp]));
                v2u o; o.x = pk2(z[0], z[1]); o.y = pk2(z[2], z[3]); *(LAS v2u*)(Zn + (16 * vb + t) * 64 + 16 * ktp + 4 * kg) = o; } }
        asm volatile("s_waitcnt lgkmcnt(0)" ::: "memory");
        if (lane == 0) *flag = c + 1;
        asm volatile("s_waitcnt lgkmcnt(0)" ::: "memory");
    }
    __syncthreads();
}

__device__ __forceinline__ void stage_rw_readout(const Ctx& F, int l) {
    const auto& a = *F.a; unsigned char* ws = a.ws; const int lane = F.lane;
    const bf16* SCN = (const bf16*)(ws + WS_SCN); const bf16* P = (const bf16*)(ws + WS_P); const float* YD = (const float*)(ws + WS_YDIR); bf16* YRW = (bf16*)(ws + WS_YRW);
    const int gw = F.bid * NWAVES + F.wave, NGW = F.G * NWAVES;
    constexpr int TR = 17, NRT = T_ALL / TR;
    for (int tile = gw; tile < NRT * 4; tile += NGW) {
        const int rt = tile % NRT, hp = tile / NRT, row0 = rt * TR, c0 = hp * 128 + 2 * lane;
        const f32x2 rk = *(const f32x2*)(a.in[I_RWRK] + l * 512 + c0), lng = *(const f32x2*)(a.in[I_RWLNG] + l * 512 + c0), lnb = *(const f32x2*)(a.in[I_RWLNB] + l * 512 + c0);
        unsigned sw_[8][5]; f32x2 yw_[8][2];
#define RO_LD(j_) do { const int rr_ = row0 + (j_); const unsigned* sp_ = (const unsigned*)(SCN + (size_t)rr_ * 9 * 512 + c0); \
        sw_[(j_) & 7][0] = sp_[0]; sw_[(j_) & 7][1] = sp_[256]; sw_[(j_) & 7][2] = sp_[4 * 256]; sw_[(j_) & 7][3] = sp_[7 * 256]; sw_[(j_) & 7][4] = *(const unsigned*)(P + (size_t)rr_ * 2560 + 2048 + c0); \
        yw_[(j_) & 7][0] = *(const f32x2*)(YD + (size_t)rr_ * 512 + c0); yw_[(j_) & 7][1] = *(const f32x2*)(YD + ((size_t)T_ALL + rr_) * 512 + c0); } while (0)
        RO_LD(0); RO_LD(1); RO_LD(2);
#pragma unroll
        for (int i = 0; i < TR; ++i) {
            const int row = row0 + i;
            if (i + 3 < TR) RO_LD(i + 3);
            const unsigned ru = sw_[i & 7][0], vu = sw_[i & 7][1], k0u = sw_[i & 7][2], k1u = sw_[i & 7][3], gu = sw_[i & 7][4];
            const f32x2 y0 = yw_[i & 7][0], y1 = yw_[i & 7][1];
            const float bon = red32(bflo(ru) * (bflo(k0u) + bflo(k1u)) * rk[0] + bfhi(ru) * (bfhi(k0u) + bfhi(k1u)) * rk[1]);
            f32x2 y = y0 + y1 + (f32x2){bflo(vu), bfhi(vu)} * bon;
            const float mu = red32(y[0] + y[1]) * (1.f / 64.f);
            y = y - mu;
            const float var = red32(y[0] * y[0] + y[1] * y[1]) * (1.f / 64.f);
            const f32x2 yn = y * (__builtin_amdgcn_rsqf(var + 64e-5f));
            const f32x2 ov = (yn * lng + lnb) * (f32x2){bflo(gu), bfhi(gu)};
            *(unsigned*)(YRW + (size_t)row * 512 + c0) = pk2(ov[0], ov[1]);
        }
    }
}
#undef RO_LD

constexpr size_t WS_S5E = 6 * MiB;
constexpr int S5_NSEG = 4, S5_SEGLEN = (CTXL + SEQ) / S5_NSEG;
__device__ __forceinline__ void s5_disc(const float are, const float aim, const float dt, float& lbr, float& lbi, float& cr, float& ci) {
    const float mag = expf(are * dt); lbr = mag * cosf(aim * dt); lbi = mag * sinf(aim * dt);
    const float den = are * are + aim * aim, nr = lbr - 1.0f; cr = (nr * are + lbi * aim) / den; ci = (lbi * are - nr * aim) / den;
}
template <int PASS>
__device__ __forceinline__ void stage_s5_scan(const Ctx& F, int l, int item = -1) {
    const auto& a = *F.a; unsigned char* ws = a.ws; const int lane = F.lane;
    const bf16* Z = (const bf16*)(ws + WS_Z); bf16* YP = (bf16*)(ws + WS_YP); f32x2* S5E = (f32x2*)(ws + WS_S5E);
    LAS unsigned char* wl = F.lds + F.wave * 16384;
    LAS float* buL = (LAS float*)wl;
    LAS bf16* Hs = (LAS bf16*)(wl + 8704);
    const int fr = lane & 15, kg = lane >> 4;
    for (int itx = (item < 0 ? F.bid : item) * NWAVES + F.wave; itx < BATCH * 32 * 2 * S5_NSEG; itx += (item < 0 ? NWAVES * F.G : BATCH * 32 * 2 * S5_NSEG)) {
        const int seg = itx & (S5_NSEG - 1), it = itx >> 2;
        if (PASS == 0 && seg == S5_NSEG - 1) continue;
        const int d = it & 1, g = (it >> 1) & 31, b = it >> 6, p = lane;
        const float dt = expf(a.in[I_S5LDT][(l * 2 + d) * 32 + g]);
        const float* arep = a.in[I_S5ARE] + ((size_t)(l * 2 + d) * 32 + g) * 64; const float* aimp = a.in[I_S5AIM] + ((size_t)(l * 2 + d) * 32 + g) * 64;
        float lbr, lbi, cr_, ci_; s5_disc(arep[p], aimp[p], dt, lbr, lbi, cr_, ci_);
        bf16x8 afr[2][4];
#pragma unroll
        for (int tl = 0; tl < 4; ++tl) { const int pp = 16 * tl + fr; float r0_, r1_, cr, ci; s5_disc(arep[pp], aimp[pp], dt, r0_, r1_, cr, ci);
            v4u pr = (v4u){0u, 0u, 0u, 0u}, pi = (v4u){0u, 0u, 0u, 0u};
            if (kg < 2) { const float* br = a.in[I_S5BRE] + (((size_t)l * 32 + g) * 64 + pp) * 16 + 8 * kg; const float* bi = a.in[I_S5BIM] + (((size_t)l * 32 + g) * 64 + pp) * 16 + 8 * kg;
                const f32x4 x0 = *(const f32x4*)br, x1 = *(const f32x4*)(br + 4), y0 = *(const f32x4*)bi, y1 = *(const f32x4*)(bi + 4);
                pr.x = pk2(cr * x0[0] - ci * y0[0], cr * x0[1] - ci * y0[1]); pr.y = pk2(cr * x0[2] - ci * y0[2], cr * x0[3] - ci * y0[3]);
                pr.z = pk2(cr * x1[0] - ci * y1[0], cr * x1[1] - ci * y1[1]); pr.w = pk2(cr * x1[2] - ci * y1[2], cr * x1[3] - ci * y1[3]);
                pi.x = pk2(cr * y0[0] + ci * x0[0], cr * y0[1] + ci * x0[1]); pi.y = pk2(cr * y0[2] + ci * x0[2], cr * y0[3] + ci * x0[3]);
                pi.z = pk2(cr * y1[0] + ci * x1[0], cr * y1[1] + ci * x1[1]); pi.w = pk2(cr * y1[2] + ci * x1[2], cr * y1[3] + ci * x1[3]); }
            afr[0][tl] = __builtin_bit_cast(bf16x8, pr); afr[1][tl] = __builtin_bit_cast(bf16x8, pi); }
        bf16x8 cf[4];
        f32x2 hst = (f32x2){0.f, 0.f};
        if (PASS == 1) {
#pragma unroll
            for (int kk = 0; kk < 4; ++kk) { const int p0 = 16 * kk + 4 * kg;
                const f32x4 c0 = *(const f32x4*)(a.in[I_S5CRE] + (((size_t)l * 32 + g) * 16 + fr) * 64 + p0), c1 = *(const f32x4*)(a.in[I_S5CIM] + (((size_t)l * 32 + g) * 16 + fr) * 64 + p0);
                v4u pk; pk.x = pk2(c0[0], -c1[0]); pk.y = pk2(c0[1], -c1[1]); pk.z = pk2(c0[2], -c1[2]); pk.w = pk2(c0[3], -c1[3]);
                cf[kk] = __builtin_bit_cast(bf16x8, pk); }
            float pr_ = lbr, pi_ = lbi, l64r = 1.f, l64i = 0.f;
#pragma unroll 1
            for (int q = 0; q < 10; ++q) { const float nr2 = pr_ * pr_ - pi_ * pi_, ni2 = 2.f * pr_ * pi_; pr_ = nr2; pi_ = ni2; if (q == 5) { l64r = pr_; l64i = pi_; } }
            const float lLr = pr_ * l64r - pi_ * l64i, lLi = pr_ * l64i + pi_ * l64r;
#pragma unroll 1
            for (int sgi = 0; sgi < seg; ++sgi) { const f32x2 ev = S5E[((size_t)it * S5_NSEG + sgi) * 64 + p];
                hst = (f32x2){lLr * hst[0] - lLi * hst[1] + ev[0], lLr * hst[1] + lLi * hst[0] + ev[1]}; }
        }
        const f32x2 lbr2 = (f32x2){lbr, lbr}, lbi2 = (f32x2){lbi, lbi};
        const int sbeg = seg * S5_SEGLEN, send = sbeg + S5_SEGLEN;
        v4u u0 = (v4u){0u, 0u, 0u, 0u}, u1 = u0, u2 = u0, u3 = u0;
#define S5_LOADU(dst_, s0_) do { const int sx_ = ((s0_) < send) ? (s0_) : (send - 16); const int row_ = seq_row(b, d, sx_ + fr); dst_ = *(const v4u*)(Z + (size_t)row_ * IN_COLS + S5_OFF + g * 16 + (kg & 1) * 8); } while (0)
#define S5_CHUNK(ux_, sc_) do { \
            { const v4u um_ = (kg < 2) ? ux_ : (v4u){0u, 0u, 0u, 0u}; const bf16x8 ufr = __builtin_bit_cast(bf16x8, um_); \
              _Pragma("unroll") for (int c = 0; c < 2; ++c) _Pragma("unroll") for (int tl = 0; tl < 4; ++tl) { \
                const f32x4 dd = __builtin_amdgcn_mfma_f32_16x16x32_bf16(afr[c][tl], ufr, (f32x4){0.f, 0.f, 0.f, 0.f}, 0, 0, 0); *(LAS f32x4*)(buL + (c * 16 + fr) * 68 + 16 * tl + 4 * kg) = dd; } } \
            S5_LOADU(ux_, (sc_) + 64); \
            LDS_WAIT(); asm volatile("" ::: "memory"); \
            f32x2 bu[16]; \
            _Pragma("unroll") for (int s = 0; s < 16; ++s) bu[s] = (f32x2){buL[s * 68 + p], buL[(16 + s) * 68 + p]}; \
            _Pragma("unroll") for (int s = 0; s < 16; ++s) { const float tr_ = __builtin_fmaf(-lbi, hst[1], bu[s][0]), ti_ = __builtin_fmaf(lbi, hst[0], bu[s][1]); \
                hst = (f32x2){__builtin_fmaf(lbr, hst[0], tr_), __builtin_fmaf(lbr, hst[1], ti_)}; \
                if (PASS == 1) *(LAS unsigned*)(Hs + s * 136 + 2 * p) = pg8::cvt_pk_bf16(hst[0], hst[1]); } \
            if (PASS == 1) { LDS_WAIT(); asm volatile("" ::: "memory"); \
                f32x4 acc = (f32x4){0.f, 0.f, 0.f, 0.f}; \
                _Pragma("unroll") for (int kk = 0; kk < 4; ++kk) { const bf16x8 af = *(const LAS bf16x8*)(Hs + fr * 136 + 32 * kk + 8 * kg); acc = __builtin_amdgcn_mfma_f32_16x16x32_bf16(af, cf[kk], acc, 0, 0, 0); } \
                { const int rowq_ = seq_row(b, d, (sc_) + 4 * kg); bf16* yq_ = YP + ((size_t)d * T_ALL + rowq_) * 512 + g * 16 + fr; const int st_ = d ? -512 : 512; \
                  _Pragma("unroll") for (int r = 0; r < 4; ++r) yq_[r * st_] = (bf16)f2bf(acc[r]); } } \
            LDS_WAIT(); asm volatile("" ::: "memory"); } while (0)
        S5_LOADU(u0, sbeg); S5_LOADU(u1, sbeg + 16); S5_LOADU(u2, sbeg + 32); S5_LOADU(u3, sbeg + 48);
#pragma unroll 1
        for (int s0 = sbeg; s0 < send; s0 += 64) { S5_CHUNK(u0, s0); S5_CHUNK(u1, s0 + 16); S5_CHUNK(u2, s0 + 32); S5_CHUNK(u3, s0 + 48); }
#undef S5_CHUNK
        if (PASS == 0) S5E[((size_t)it * S5_NSEG + seg) * 64 + p] = hst;
#undef S5_LOADU
    }
}

__device__ __forceinline__ void stage_s5_prep(const Ctx& F, int l, int nrows) {
    const auto& a = *F.a; unsigned char* ws = a.ws;
    const bf16* __restrict__ Z = (const bf16*)(ws + WS_Z); const bf16* __restrict__ YP = (const bf16*)(ws + WS_YP); bf16* __restrict__ AS5 = (bf16*)(ws + WS_AS5);
    const int c = 4 * (F.tid & 127), rq = F.tid >> 7;
    const f32x4 dsk = *(const f32x4*)(a.in[I_S5D] + l * 512 + c);
#pragma unroll 4
    for (int row = F.bid * 4 + rq; row < nrows; row += F.G * 4) {
        const v2u uz = *(const v2u*)(Z + (size_t)row * IN_COLS + S5_OFF + c);
        const v2u q0 = *(const v2u*)(YP + (size_t)row * 512 + c), q1 = *(const v2u*)(YP + ((size_t)T_ALL + row) * 512 + c);
        const f32x4 y0 = (f32x4){bflo(q0.x), bfhi(q0.x), bflo(q0.y), bfhi(q0.y)}, y1 = (f32x4){bflo(q1.x), bfhi(q1.x), bflo(q1.y), bfhi(q1.y)};
        const f32x4 u = (f32x4){bflo(uz.x), bfhi(uz.x), bflo(uz.y), bfhi(uz.y)};
        const f32x4 y = y0 + y1 + u * dsk;
        float ge[4];
#pragma unroll
        for (int j = 0; j < 4; ++j) ge[j] = 0.5f * y[j] * (1.f + tanh_fast(0.7978845608028654f * (y[j] + 0.044715f * y[j] * y[j] * y[j])));
        v2u o; o.x = pk2(ge[0], ge[1]); o.y = pk2(ge[2], ge[3]);
        *(v2u*)(AS5 + (size_t)row * 512 + c) = o;
    }
}

__device__ __forceinline__ void stage_hy_pre(const Ctx& F, int l, int tile0, int tile1, int gw, int NGW) {
    const auto& a = *F.a; unsigned char* ws = a.ws; const int lane = F.lane;
    const bf16* Z = (const bf16*)(ws + WS_Z); bf16* UT = (bf16*)(ws + WS_UT);
    LAS unsigned char* tl = F.lds + F.wave * 16384;
    const float* cw = a.in[I_HYCW] + (size_t)l * 3 * 1536; const float* cbp = a.in[I_HYCB] + l * 1536;
    const int q = lane >> 3, k = lane & 7, ntile = tile1;
    v4u v[8], hv;
#define HYPRE_LOAD(tile_) do { const int rt_ = (tile_) / 24, ct_ = (tile_) % 24, row0_ = rt_ * 64; int base_, pos0_, n_; row_seq(row0_, base_, pos0_, n_); \
        const bf16* zt_ = Z + (size_t)row0_ * IN_COLS + HY_OFF + ct_ * 64 + 8 * k; hv = (v4u){0u, 0u, 0u, 0u}; \
        _Pragma("unroll") for (int i = 0; i < 8; ++i) v[i] = *(const v4u*)(zt_ + (size_t)(8 * i + q) * IN_COLS); \
        if (q == 0 && pos0_ > 0) hv = *(const v4u*)(zt_ - (size_t)IN_COLS); \
        if (q == 1 && pos0_ + 64 < n_) hv = *(const v4u*)(zt_ + (size_t)64 * IN_COLS); } while (0)
    if (tile0 + gw < ntile) HYPRE_LOAD(tile0 + gw);
#pragma unroll 1
    for (int tile = tile0 + gw; tile < ntile; tile += NGW) {
        const int rt = tile / 24, ct = tile % 24, row0 = rt * 64, c0 = ct * 64;
        f32x4 wv[8];
#pragma unroll
        for (int i = 0; i < 8; ++i) { const int col = c0 + 8 * i + q; wv[i] = (f32x4){cw[col], cw[1536 + col], cw[2 * 1536 + col], cbp[col]}; }
#pragma unroll
        for (int i = 0; i < 8; ++i) { LAS unsigned* p = (LAS unsigned*)(tl + (1 + 8 * i + q) * 132 + 16 * k); p[0] = v[i].x; p[1] = v[i].y; p[2] = v[i].z; p[3] = v[i].w; }
        if (q < 2) { LAS unsigned* p = (LAS unsigned*)(tl + (q ? 65 : 0) * 132 + 16 * k); p[0] = hv.x; p[1] = hv.y; p[2] = hv.z; p[3] = hv.w; }
        if (tile + NGW < ntile) HYPRE_LOAD(tile + NGW);
        LDS_WAIT(); asm volatile("" ::: "memory");
#pragma unroll 2
        for (int i = 0; i < 8; ++i) {
            const int ch = 8 * i + q, col = c0 + ch;
            const LAS unsigned short* s = (const LAS unsigned short*)(tl + (8 * k) * 132 + ch * 2);
            float z[10];
#pragma unroll
            for (int t = 0; t < 10; ++t) z[t] = __builtin_bit_cast(float, (unsigned)s[t * 66] << 16);
            float o[8];
#pragma unroll
            for (int t = 0; t < 8; ++t) o[t] = wv[i][0] * z[t] + wv[i][1] * z[t + 1] + wv[i][2] * z[t + 2] + wv[i][3];
            v4u w; w.x = pk2(o[0], o[1]); w.y = pk2(o[2], o[3]); w.z = pk2(o[4], o[5]); w.w = pk2(o[6], o[7]);
            *(v4u*)(UT + (size_t)col * T_ALL + row0 + 8 * k) = w;
        }
        LDS_WAIT(); asm volatile("" ::: "memory");
    }
#undef HYPRE_LOAD
}
__device__ __forceinline__ void stage_hy_post(const Ctx& F, int l, int nrows) {
    const auto& a = *F.a; unsigned char* ws = a.ws; const int lane = F.lane;
    const bf16* YT = (const bf16*)(ws + WS_UT) + (size_t)1024 * T_ALL; bf16* YHY = (bf16*)(ws + WS_YHY);
    LAS unsigned char* tl = F.lds + F.wave * 16384;
    const int gw = F.bid * NWAVES + F.wave, NGW = F.G * NWAVES;
    const int q = lane >> 3, k = lane & 7, ntile = (nrows / 64) * 8;
    v4u v[8];
#define HYPOST_LOAD(tile_) do { const bf16* yp_ = YT + (size_t)(((tile_) & 7) * 64 + q) * T_ALL + ((tile_) >> 3) * 64 + 8 * k; \
        _Pragma("unroll") for (int i = 0; i < 8; ++i) v[i] = *(const v4u*)(yp_ + (size_t)(8 * i) * T_ALL); } while (0)
    if (gw < ntile) HYPOST_LOAD(gw);
#pragma unroll 1
    for (int tile = gw; tile < ntile; tile += NGW) {
        const int rt = tile >> 3, ct = tile & 7, row0 = rt * 64, c0 = ct * 64;
#pragma unroll
        for (int i = 0; i < 8; ++i) { LAS unsigned* p = (LAS unsigned*)(tl + (8 * i + q) * 132 + 16 * k); p[0] = v[i].x; p[1] = v[i].y; p[2] = v[i].z; p[3] = v[i].w; }
        if (tile + NGW < ntile) HYPOST_LOAD(tile + NGW);
        LDS_WAIT(); asm volatile("" ::: "memory");
#pragma unroll
        for (int i = 0; i < 8; ++i) { const int r = 8 * i + q;
            const LAS unsigned short* s = (const LAS unsigned short*)(tl + (8 * k) * 132 + r * 2);
            unsigned e[8];
#pragma unroll
            for (int j = 0; j < 8; ++j) e[j] = s[j * 66];
            v4u w; w.x = e[0] | (e[1] << 16); w.y = e[2] | (e[3] << 16); w.z = e[4] | (e[5] << 16); w.w = e[6] | (e[7] << 16);
            *(v4u*)(YHY + (size_t)(row0 + r) * 512 + c0 + 8 * k) = w; }
        LDS_WAIT(); asm volatile("" ::: "memory");
    }
#undef HYPOST_LOAD
}
typedef float f32x16 __attribute__((ext_vector_type(16)));
__device__ __forceinline__ void hyena_item(const Ctx& F, int l, int c, int isctx) {
    const auto& a = *F.a; unsigned char* ws = a.ws; const int tid = F.tid, lane = F.lane;
    const int n = isctx ? CTXL : SEQ, rowbase = isctx ? T_LAT : 0, RL = isctx ? HY_RLENC : HY_RLEN, off = n + 47;
    const bf16* UT = (const bf16*)(ws + WS_UT);
    const bf16* x1g = UT + (size_t)c * T_ALL + rowbase; const bf16* x2g = UT + (size_t)(512 + c) * T_ALL + rowbase; bf16* vg = (bf16*)UT + (size_t)(1024 + c) * T_ALL + rowbase;
    const bf16* Rg = (const bf16*)(ws + WS_GF + l * GF_STRIDE + (isctx ? GF_CTX : 0)) + (size_t)c * RL;
    LAS unsigned char* XB = F.lds; LAS unsigned char* R1 = F.lds + HY_R1_OFF; LAS unsigned char* R2 = F.lds + HY_R2_OFF;
    { const int cpb = n / 8;
      for (int q = tid; q < 8 * cpb; q += NTHREADS) { const int b = q / cpb, ch = q % cpb; *(LAS v4u*)(XB + b * HY_ROWB + 2 * HY_MARG + 16 * ch) = *(const v4u*)(vg + (size_t)b * n + 8 * ch); }
      if (tid < 256) { const int b = tid >> 5, side = (tid >> 4) & 1, ch = tid & 15; const unsigned zz = (unsigned)opaque_v(0); *(LAS v4u*)(XB + b * HY_ROWB + (side ? 2 * (HY_MARG + n) : 0) + 16 * ch) = (v4u){zz, zz, zz, zz}; }
      const int rch = RL / 8;
      for (int q = tid; q < rch; q += NTHREADS) { *(LAS v4u*)(R1 + 16 * q) = *(const v4u*)(Rg + 8 * q); *(LAS v4u*)(R2 + 16 * q) = *(const v4u*)(Rg + (size_t)512 * RL + 8 * q); } }
    __syncthreads();
    const int i = lane & 31, kg = lane >> 5, jb = lane & 3, bb = (lane & 31) >> 2;
    const int rsh = (off - i) & 7, rd = rsh >> 1; const bool s1 = rd & 1, s2 = rd & 2; const unsigned sh = (rsh & 1) ? 16u : 0u;
    const int aconst = 2 * (off - i + 8 * kg - rsh), bconst = bb * HY_ROWB + 2 * (HY_MARG + 32 * jb + 8 * kg);
    const int T0w = 512 * F.wave; const int ntile = (n - T0w) >= 512 ? 4 : ((n - T0w) > 0 ? (n - T0w) / 128 : 0);
    const float bias0 = a.in[I_HYBIAS][(l * 2 + 0) * 512 + c], bias1 = a.in[I_HYBIAS][(l * 2 + 1) * 512 + c];
    f32x16 acc[4];
    v2u y1p[4][4];
#define HY_AFRAG(wa, wb, afr) do { \
        const unsigned a0 = s1 ? wa.y : wa.x, a1 = s1 ? wa.z : wa.y, a2 = s1 ? wa.w : wa.z, a3 = s1 ? wb.x : wa.w, a4 = s1 ? wb.y : wb.x, a5 = s1 ? wb.z : wb.y, a6 = s1 ? wb.w : wb.z; \
        const unsigned b0 = s2 ? a2 : a0, b1 = s2 ? a3 : a1, b2 = s2 ? a4 : a2, b3 = s2 ? a5 : a3, b4 = s2 ? a6 : a4; \
        v4u af_; af_.x = __builtin_amdgcn_alignbit(b1, b0, sh); af_.y = __builtin_amdgcn_alignbit(b2, b1, sh); af_.z = __builtin_amdgcn_alignbit(b3, b2, sh); af_.w = __builtin_amdgcn_alignbit(b4, b3, sh); \
        afr = __builtin_bit_cast(bf16x8, af_); } while (0)
#define HY_STEP_COND(RB, d) do { \
        const v4u wa = *(const LAS v4u*)((RB) + aconst - 2 * (d)), wb = *(const LAS v4u*)((RB) + aconst - 2 * (d) + 16); bf16x8 afr; HY_AFRAG(wa, wb, afr); \
        _Pragma("unroll") for (int m = 0; m < 4; ++m) { const int T0 = T0w + 128 * m; \
            if (m < ntile && (d) >= T0 - n + 16 && (d) <= T0 + 96) { const bf16x8 bfr = *(const LAS bf16x8*)(XB + bconst + 2 * (T0 - (d))); \
                acc[m] = __builtin_amdgcn_mfma_f32_32x32x16_bf16(afr, bfr, acc[m], 0, 0, 0); } } } while (0)
#define HY_LOAD(RB, d, wa, wb, bq) do { wa = *(const LAS v4u*)((RB) + aconst - 2 * (d)); wb = *(const LAS v4u*)((RB) + aconst - 2 * (d) + 16); \
        _Pragma("unroll") for (int m = 0; m < 4; ++m) bq[m] = *(const LAS bf16x8*)(XB + bconst + 2 * (T0w + 128 * m - (d))); } while (0)
#define HY_MMA(wa, wb, bq) do { bf16x8 afr; HY_AFRAG(wa, wb, afr); \
        _Pragma("unroll") for (int m = 0; m < 4; ++m) acc[m] = __builtin_amdgcn_mfma_f32_32x32x16_bf16(afr, bq[m], acc[m], 0, 0, 0); } while (0)
#define HY_CONV(RB) do { \
        _Pragma("unroll") for (int m = 0; m < 4; ++m) _Pragma("unroll") for (int e = 0; e < 16; ++e) acc[m][e] = 0.f; \
        if (ntile == 4) { \
            const int dA = T0w - n + 16, dB = T0w + 384 - n + 16, dC = T0w + 96, dD = T0w + 384 + 96;     \
            _Pragma("unroll 1") for (int d = dA; d < dB; d += 16) HY_STEP_COND(RB, d); \
            { v4u waA, wbA, waB, wbB; bf16x8 bqA[4], bqB[4]; \
              HY_LOAD(RB, dB, waA, wbA, bqA); \
              _Pragma("unroll 1") for (int d = dB; d <= dC; d += 32) { \
                  if (d + 16 <= dC) HY_LOAD(RB, d + 16, waB, wbB, bqB); \
                  __builtin_amdgcn_sched_barrier(0); \
                  HY_MMA(waA, wbA, bqA); \
                  __builtin_amdgcn_sched_barrier(0); \
                  if (d + 32 <= dC) HY_LOAD(RB, d + 32, waA, wbA, bqA); \
                  __builtin_amdgcn_sched_barrier(0); \
                  if (d + 16 <= dC) HY_MMA(waB, wbB, bqB); \
                  __builtin_amdgcn_sched_barrier(0); } } \
            _Pragma("unroll 1") for (int d = dC + 16; d <= dD; d += 16) HY_STEP_COND(RB, d); \
        } else if (ntile > 0) { const int dhi = T0w + 128 * (ntile - 1) + 96; \
            _Pragma("unroll 1") for (int d = T0w - n + 16; d <= dhi; d += 16) HY_STEP_COND(RB, d); } } while (0)
    HY_CONV(R1);
#pragma unroll
    for (int m = 0; m < 4; ++m) if (m < ntile) {
#pragma unroll
        for (int rg = 0; rg < 4; ++rg) { const int t4 = T0w + 128 * m + 32 * jb + 8 * rg + 4 * kg;
            const v2u xv = *(const v2u*)(x1g + (size_t)bb * n + t4); const v2u vv = *(const LAS v2u*)(XB + bb * HY_ROWB + 2 * (HY_MARG + t4));
            const float y0 = bflo(xv.x) * (acc[m][4 * rg + 0] + bias0 * bflo(vv.x)), y1 = bfhi(xv.x) * (acc[m][4 * rg + 1] + bias0 * bfhi(vv.x));
            const float y2 = bflo(xv.y) * (acc[m][4 * rg + 2] + bias0 * bflo(vv.y)), y3 = bfhi(xv.y) * (acc[m][4 * rg + 3] + bias0 * bfhi(vv.y));
            y1p[m][rg].x = pk2(y0, y1); y1p[m][rg].y = pk2(y2, y3); } }
    __syncthreads();
#pragma unroll
    for (int m = 0; m < 4; ++m) if (m < ntile) {
#pragma unroll
        for (int rg = 0; rg < 4; ++rg) { const int t4 = T0w + 128 * m + 32 * jb + 8 * rg + 4 * kg; *(LAS v2u*)(XB + bb * HY_ROWB + 2 * (HY_MARG + t4)) = y1p[m][rg]; } }
    __syncthreads();
    HY_CONV(R2);
#pragma unroll
    for (int m = 0; m < 4; ++m) if (m < ntile) {
#pragma unroll
        for (int rg = 0; rg < 4; ++rg) { const int t4 = T0w + 128 * m + 32 * jb + 8 * rg + 4 * kg;
            const v2u xv = *(const v2u*)(x2g + (size_t)bb * n + t4); const v2u yv = y1p[m][rg];
            const float o0 = bflo(xv.x) * (acc[m][4 * rg + 0] + bias1 * bflo(yv.x)), o1 = bfhi(xv.x) * (acc[m][4 * rg + 1] + bias1 * bfhi(yv.x));
            const float o2 = bflo(xv.y) * (acc[m][4 * rg + 2] + bias1 * bflo(yv.y)), o3 = bfhi(xv.y) * (acc[m][4 * rg + 3] + bias1 * bfhi(yv.y));
            v2u ov; ov.x = pk2(o0, o1); ov.y = pk2(o2, o3); *(v2u*)(vg + (size_t)bb * n + t4) = ov; } }
    __syncthreads();
#undef HY_CONV
#undef HY_AFRAG
#undef HY_STEP_COND
#undef HY_LOAD
#undef HY_MMA
}
__device__ __forceinline__ void stage_mixer(const Ctx& F, int l) {
    unsigned* ctr = (unsigned*)(F.a->ws + WS_CTL) + CW_WORK + 64 * l;
    LAS int* itb = (LAS int*)(F.lds + LDSCTL_OFF + 512);
    constexpr int NS5 = BATCH * 32 * 2 * S5_NSEG / NWAVES;
    const int nit = 128 + NS5 + 512 + (l == 0 ? 512 : 0);
#ifdef PROBE_STATIC
    return;
#endif
    for (;;) {
        if (F.tid == 0) *itb = (int)__hip_atomic_fetch_add(ctr, 1u, __ATOMIC_RELAXED, __HIP_MEMORY_SCOPE_AGENT);
        __syncthreads();
        const int it = *itb;
        __syncthreads();
        if (it >= nit) break;
        Ctx Fi; Fi.a = kargs(); Fi.tid = opaque_v((int)threadIdx.x); Fi.lane = Fi.tid & 63; Fi.wave = __builtin_amdgcn_readfirstlane(Fi.tid >> 6); Fi.bid = opaque((int)blockIdx.x); Fi.G = opaque((int)gridDim.x);
        Fi.lds = (LAS unsigned char*)((LAS unsigned char*)0 + opaque(0)) + (F.lds - (LAS unsigned char*)0);
#ifdef PROBE_T
        if (l == 0 && F.tid == 0 && it == 5) ((unsigned long long*)(F.a->ws + WS_CTL + CW_STAMP * 4))[21] = __builtin_amdgcn_s_memrealtime();
        if (l == 0 && F.tid == 0 && it == 300) ((unsigned long long*)(F.a->ws + WS_CTL + CW_STAMP * 4))[23] = __builtin_amdgcn_s_memrealtime();
#endif
        if (it < 128) { for (int rep = 0; rep < ((DUPK == 9) ? 2 : 1); ++rep) rw_chunk_item2(Fi, opaque(l), it); }
        else if (it < 128 + NS5) stage_s5_scan<1>(Fi, opaque(l), it - 128);
        else if (it < 640 + NS5) hyena_item(Fi, opaque(l), it - 128 - NS5, 0);
        else hyena_item(Fi, opaque(l), it - 640 - NS5, 1);
#ifdef PROBE_T
        if (l == 0 && F.tid == 0 && it == 5) ((unsigned long long*)(F.a->ws + WS_CTL + CW_STAMP * 4))[22] = __builtin_amdgcn_s_memrealtime();
        if (l == 0 && F.tid == 0 && it == 300) ((unsigned long long*)(F.a->ws + WS_CTL + CW_STAMP * 4))[24] = __builtin_amdgcn_s_memrealtime();
#endif
    }
}

typedef float f32x16r __attribute__((ext_vector_type(16)));
__device__ __forceinline__ void stage_norm2_router(const Ctx& F, int l, int nrows) {
    const auto& a = *F.a; unsigned char* ws = a.ws; const int lane = F.lane;
    const float* X = (const float*)(ws + WS_X); bf16* H = (bf16*)(ws + WS_H); const float* MOD = (const float*)(ws + WS_MOD);
    int* EIDX = (int*)(ws + WS_EIDX); float* GATE = (float*)(ws + WS_GATE); int* POS = (int*)(ws + WS_POS); unsigned* ROWOF = (unsigned*)(ws + WS_ROWOF);
    LAS int* lex = (LAS int*)(F.lds + 40960); LAS int* lrk = lex + 2048; LAS int* offl = lrk + 2048;
    LAS float* lg = (LAS float*)(F.lds + F.wave * 4352);
    LAS int* hist = (LAS int*)(F.lds + LDSCTL_OFF + 1024);
    if (F.tid < 32) hist[F.tid] = 0;
    __syncthreads();
    const int rpb = (nrows + F.G - 1) / F.G, r0 = F.bid * rpb, r1 = (r0 + rpb < nrows) ? r0 + rpb : nrows;
    const float* rw = a.in[I_RTW] + (size_t)l * 1024 * 32;
    const int i = lane & 31, kk = lane >> 5;
    const f32x4* ng = (const f32x4*)(a.in[I_N2G] + l * D) + kk;
    for (int rb = r0 + F.wave * 32; rb < r1; rb += NWAVES * 32) {
        const int nrow = (r1 - rb) < 32 ? (r1 - rb) : 32; const bool live = i < nrow;
        const int row = live ? rb + i : r1 - 1; const int w = row < T_LAT ? (row >> 12) : 8;
        const f32x4* xr = (const f32x4*)(X + (size_t)row * D) + kk;
        float ss = 0.f;
#pragma unroll 16
        for (int q = 0; q < 128; ++q) { const f32x4 v = xr[2 * q]; ss += (v[0] * v[0] + v[1] * v[1]) + (v[2] * v[2] + v[3] * v[3]); }
        ss += __builtin_bit_cast(float, __builtin_amdgcn_ds_bpermute((lane ^ 32) << 2, __builtin_bit_cast(int, ss)));
        const float rstd = __builtin_amdgcn_rsqf(ss * (1.f / D) + 1e-6f);
        const f32x4* sh = (const f32x4*)(MOD + (size_t)(l * 9 + w) * 6144 + 3072) + kk; const f32x4* sc = (const f32x4*)(MOD + (size_t)(l * 9 + w) * 6144 + 4096) + kk;
        v2u* ho = (v2u*)(H + (size_t)row * D) + kk;
        f32x16r acc;
#pragma unroll
        for (int e = 0; e < 16; ++e) acc[e] = 0.f;
        const float* wp = rw + (size_t)(4 * kk) * 32 + i;
        f32x4 xn[4], gn_[4], cn_[4], sn_[4], wn_[4];
#define RT_LOAD(q0_) do { _Pragma("unroll") for (int u_ = 0; u_ < 4; ++u_) { const int q_ = (q0_) + u_; xn[u_] = xr[2 * q_]; gn_[u_] = ng[2 * q_]; cn_[u_] = sc[2 * q_]; sn_[u_] = sh[2 * q_]; \
            wn_[u_] = (f32x4){wp[(size_t)(8 * q_) * 32], wp[(size_t)(8 * q_ + 1) * 32], wp[(size_t)(8 * q_ + 2) * 32], wp[(size_t)(8 * q_ + 3) * 32]}; } } while (0)
        RT_LOAD(0);
#pragma unroll 1
        for (int q0 = 0; q0 < 128; q0 += 4) {
            f32x4 xc[4], gc_[4], cc_[4], sc_[4], wc_[4];
#pragma unroll
            for (int u = 0; u < 4; ++u) { xc[u] = xn[u]; gc_[u] = gn_[u]; cc_[u] = cn_[u]; sc_[u] = sn_[u]; wc_[u] = wn_[u]; }
            if (q0 + 4 < 128) RT_LOAD(q0 + 4);
#pragma unroll
            for (int u = 0; u < 4; ++u) { const int q = q0 + u;
                const f32x4 h4 = xc[u] * rstd * gc_[u] * (cc_[u] + 1.0f) + sc_[u];
                if (live) { v2u o; o.x = pk2(h4[0], h4[1]); o.y = pk2(h4[2], h4[3]); ho[2 * q] = o; }
                acc = __builtin_amdgcn_mfma_f32_32x32x2f32(h4[0], wc_[u][0], acc, 0, 0, 0);
                acc = __builtin_amdgcn_mfma_f32_32x32x2f32(h4[1], wc_[u][1], acc, 0, 0, 0);
                acc = __builtin_amdgcn_mfma_f32_32x32x2f32(h4[2], wc_[u][2], acc, 0, 0, 0);
                acc = __builtin_amdgcn_mfma_f32_32x32x2f32(h4[3], wc_[u][3], acc, 0, 0, 0); }
        }
#undef RT_LOAD
        const float rbias = a.in[I_RTB][l * 32 + i];
#pragma unroll
        for (int r = 0; r < 16; ++r) { const int ri = (r & 3) + 8 * (r >> 2) + 4 * kk; lg[ri * 33 + i] = acc[r] + rbias; }
        LDS_WAIT(); asm volatile("" ::: "memory");
        if (lane < nrow) {
            LAS float* lr = lg + lane * 33; const int orow = rb + lane;
            float tv[4]; int ti[4];
#pragma unroll
            for (int r = 0; r < 4; ++r) { float bv = -INFINITY; int bi = 0;
#pragma unroll 8
                for (int e = 0; e < 32; ++e) { const float v = lr[e]; if (v > bv) { bv = v; bi = e; } }
                tv[r] = bv; ti[r] = bi; lr[bi] = -INFINITY; }
            const float e1 = expf(tv[1] - tv[0]), e2 = expf(tv[2] - tv[0]), e3 = expf(tv[3] - tv[0]); const float inv = 1.0f / (1.0f + e1 + e2 + e3);
            *(int4*)(EIDX + orow * 4) = make_int4(ti[0], ti[1], ti[2], ti[3]); *(f32x4*)(GATE + orow * 4) = (f32x4){inv, e1 * inv, e2 * inv, e3 * inv};
#pragma unroll
            for (int r = 0; r < 4; ++r) { const int rk = __hip_atomic_fetch_add(&hist[ti[r]], 1, __ATOMIC_RELAXED, __HIP_MEMORY_SCOPE_WORKGROUP); lex[(orow - r0) * 4 + r] = ti[r]; lrk[(orow - r0) * 4 + r] = rk; }
        }
        LDS_WAIT(); asm volatile("" ::: "memory");
    }
    __syncthreads();
    if (F.tid < 32) { const int c = hist[F.tid]; offl[F.tid] = c ? (int)__hip_atomic_fetch_add((unsigned*)(ws + WS_CTL) + CW_CNT + 64 * l + F.tid, (unsigned)c, __ATOMIC_RELAXED, __HIP_MEMORY_SCOPE_AGENT) : 0; }
    __syncthreads();
    for (int i = F.tid; i < (r1 > r0 ? (r1 - r0) * 4 : 0); i += NTHREADS) { const int e = lex[i], pos = offl[e] + lrk[i];
        POS[r0 * 4 + i] = pos; ROWOF[(size_t)e * pg8::MOE_CAP + pos] = (unsigned)(r0 + (i >> 2)) * (unsigned)(D * 2); }
    __syncthreads();
}

__device__ __forceinline__ LAS int* load_moe_base(const Ctx& F, int l) {
    LAS int* base = (LAS int*)(F.lds + LDSCTL_OFF + 256);
    if (F.tid < 32) base[64 + F.tid] = (int)__hip_atomic_load((unsigned*)(F.a->ws + WS_CTL) + CW_CNT + 64 * l + F.tid, __ATOMIC_RELAXED, __HIP_MEMORY_SCOPE_AGENT);
    __syncthreads();
    if (F.tid == 0) { int acc = 0; for (int e = 0; e < 32; ++e) { base[e] = acc; acc += (base[64 + e] + 255) & ~255; } base[32] = acc; }
    __syncthreads();
    return base;
}
__device__ __forceinline__ void moe_fix_pos(const Ctx& F, int nrows, const LAS int* base) {
    unsigned char* ws = F.a->ws; const int* EIDX = (const int*)(ws + WS_EIDX); int* POS = (int*)(ws + WS_POS);
    const int rpb = (nrows + F.G - 1) / F.G, r0 = F.bid * rpb, r1 = (r0 + rpb < nrows) ? r0 + rpb : nrows;
    for (int i = F.tid; i < (r1 > r0 ? (r1 - r0) * 4 : 0); i += NTHREADS) POS[r0 * 4 + i] += base[EIDX[r0 * 4 + i]];
}

constexpr int NSTAGE_L = 13, NSTAGES = 1 + DEPTH * NSTAGE_L + 1;
__global__ void __launch_bounds__(NTHREADS, 2) mk_fwd(Args args) {
    extern __shared__ __attribute__((aligned(16))) unsigned char lds_raw[];
    Ctx F; F.a = kargs(); F.lds = (LAS unsigned char*)lds_raw; F.tid = threadIdx.x; F.lane = F.tid & 63; F.wave = __builtin_amdgcn_readfirstlane(F.tid >> 6); F.bid = blockIdx.x; F.G = gridDim.x;
    volatile LAS unsigned* MISC = (volatile LAS unsigned*)(F.lds + LDSCTL_OFF);
    for (int u = F.tid; u < (LDS_BYTES - LDSCTL_OFF) / 4; u += NTHREADS) ((LAS unsigned*)(F.lds + LDSCTL_OFF))[u] = 0u;
    __syncthreads();
#if MK_PER_STAGE
#define GRID_BAR() do { } while (0)
#else
    (void)xcd_barrier_post((unsigned*)(F.a->ws + WS_CTL) + CW_BAR, MISC + 8);
#define GRID_BAR() do { XcdBarrier b_; b_.bar = (unsigned*)(kargs()->ws + WS_CTL) + CW_BAR; b_.x = xb_xcc_id(); b_.st = (volatile LAS unsigned*)((LAS unsigned char*)lds_raw + LDSCTL_OFF + opaque(32)); xcd_barrier(b_); } while (0)
#endif
#ifndef ONLY_S
#define ONLY_S -1
#endif
#define STG_SEL(k) (ONLY_S < 0 || ONLY_S == (((k) == 0) ? 0 : ((k) == NSTAGES - 1 ? 14 : (((k) - 1) % NSTAGE_L) + 1)))
#if MK_PER_STAGE
#define IN(k) (STG_SEL(k) && kargs()->ph_lo == (k))
#else
#define IN(k) STG_SEL(k)
#endif
#if MK_PER_STAGE
#define SEAM(k) do { } while (0)
#else
#define SEAM(k) do { if ((k) + 1 < NSTAGES) GRID_BAR(); } while (0)
#endif
#define STAGE(k) if (IN(k)) { F.a = kargs(); F.tid = opaque_v((int)threadIdx.x); F.lane = F.tid & 63; F.wave = __builtin_amdgcn_readfirstlane(F.tid >> 6); F.bid = opaque((int)blockIdx.x); F.G = opaque((int)gridDim.x); F.lds = (LAS unsigned char*)lds_raw + opaque(0); unsigned char* ws = F.a->ws; const int l = opaque(lq); unsigned char* wl = ws + WS_WTS + (size_t)l * WL_STRIDE; (void)wl; (void)ws;
#define STAGE_END(k) } SEAM(k);
    int lq = 0;
    STAGE(0) p0_prologue(F); STAGE_END(0)
    for (lq = 0; lq < DEPTH; ++lq) {
        const int sb = 1 + lq * NSTAGE_L;
        const int nrl = opaque((lq == DEPTH - 1) ? T_LAT : T_ALL);
        STAGE(sb + 0) if (l == 0) stage_xinit_norm1(F); else stage_norm1(F, l); STAGE_END(sb + 0)
        STAGE(sb + 1) pg8::SchedWin S; S.A = (const char*)(ws + WS_H); S.Bt = (const char*)(wl + WO_WIN); S.tstep = (size_t)256 * 1024 * 2; S.G = F.G; S.c = F.bid; S.part = (nrl != T_ALL); pg8::EpiBf16 E{(bf16*)(ws + WS_Z), IN_COLS, nullptr, 0};
            pg8::gemm_phase(F.lds, F.tid, 1024, S, E); STAGE_END(sb + 1)
        STAGE(sb + 2) { const int nht = (nrl / 64) * 24, hsplit = (nht * S3_SPLIT / 100) & ~7;
            if ((F.wave & 3) == 3) { const int pw = F.bid * 2 + (F.wave >> 2), npw = F.G * 2; stage_rw_prep1(F, l, pw, npw); stage_hy_pre(F, l, 0, hsplit, pw, npw); }
            else stage_s5_scan<0>(F, l);
            stage_hy_pre(F, l, hsplit, nht, F.bid * NWAVES + F.wave, F.G * NWAVES); } STAGE_END(sb + 2)
        STAGE(sb + 3) { pg8::SchedP S; S.A = (const char*)(ws + WS_ARW); S.Bt = (const char*)(wl + WO_RWCAT); S.tstep = (size_t)256 * 256 * 2; S.nM = T_ALL / 256; S.G = F.G; S.c = F.bid; pg8::EpiBf16 E{(bf16*)(ws + WS_P), 2560, nullptr, 0}; pg8::gemm_phase(F.lds, F.tid, 256, S, E, 2); }
            F.tid = opaque_v((int)threadIdx.x); F.lane = F.tid & 63;
            STAGE_END(sb + 3)
        STAGE(sb + 4) for (int rep = 0; rep < REPN(5); ++rep) stage_rw_prep2(F, l); STAGE_END(sb + 4)
        STAGE(sb + 5) PT(10); stage_mixer(F, l); PT(11); STAGE_END(sb + 5) STAGE(sb + 5) PT(12); }
        STAGE(sb + 6) stage_s5_prep(F, l, nrl); STAGE_END(sb + 6)
        STAGE(sb + 7) { pg8::SchedStatic S; S.init(ws + WS_AS5, wl + WO_GLU, nrl, 1024, 512, F.G, F.bid); pg8::EpiGlu<0> E{(bf16*)(ws + WS_YS5), 512, F.a->in[I_S5GLUB] + l * 1024, 0, 512}; PT(13); pg8::gemm_phase(F.lds, F.tid, 512, S, E); PT(14); }
            for (int rep = 0; rep < REPN(7); ++rep) stage_rw_readout(F, l); for (int rep = 0; rep < REPN(8); ++rep) stage_hy_post(F, l, nrl); STAGE_END(sb + 7)
        STAGE(sb + 8) pg8::SchedMerge S; S.A0 = (const char*)(ws + WS_YHY); S.A1 = (const char*)(ws + WS_YRW); S.A2 = (const char*)(ws + WS_YS5); S.Bt = (const char*)(wl + WO_WBR); S.tstep = (size_t)256 * 512 * 2; S.bstride = (size_t)1024 * 512 * 2;
            S.nM = nrl / 256; S.nN = 4; S.G = F.G; S.c = F.bid;
            pg8::EpiMerge E{(bf16*)(ws + WS_MTMP), (bf16*)(ws + WS_H), (const bf16*)(ws + WS_Z) + GATE_OFF}; pg8::gemm_phase(F.lds, F.tid, 512, S, E); STAGE_END(sb + 8)
        STAGE(sb + 9) pg8::SchedStatic S; S.init(ws + WS_H, wl + WO_WOUT, nrl, 1024, 1024, F.G, F.bid); pg8::EpiResid E{(float*)(ws + WS_X), (const float*)(ws + WS_MOD) + (size_t)l * 9 * 6144 + 2048};
            pg8::gemm_phase(F.lds, F.tid, 1024, S, E); STAGE_END(sb + 9)
        STAGE(sb + 10) PT(17); stage_norm2_router(F, l, nrl); PT(18); STAGE_END(sb + 10)
        STAGE(sb + 11) LAS int* base = load_moe_base(F, l); moe_fix_pos(F, nrl, base);
            pg8::SchedMoeG S; S.A = (const char*)(ws + WS_H); S.rowof = (const unsigned*)(ws + WS_ROWOF); S.Bt = (const char*)(wl + WO_W1); S.tstep = (size_t)256 * 1024 * 2; S.estride = (size_t)2048 * 1024 * 2; S.NPN = 8; S.G = F.G; S.c = F.bid; S.base = base;
            pg8::EpiGlu<1> E{(bf16*)(ws + WS_ACT), 1024, F.a->in[I_B1] + (size_t)l * 32 * 2048, 2048, 1024}; pg8::gemm_phase(F.lds, F.tid, 1024, S, E); STAGE_END(sb + 11)
        STAGE(sb + 12) LAS int* base = load_moe_base(F, l);
            pg8::SchedMoe S; S.A = (const char*)(ws + WS_ACT); S.Bt = (const char*)(wl + WO_W2); S.tstep = (size_t)256 * 1024 * 2; S.estride = (size_t)1024 * 1024 * 2; S.NPN = 4; S.G = F.G; S.c = F.bid; S.base = base;
            pg8::EpiBf16 E{(bf16*)(ws + WS_XS), 1024, F.a->in[I_B2] + (size_t)l * 32 * 1024, 1024}; pg8::gemm_phase(F.lds, F.tid, 1024, S, E); STAGE_END(sb + 12)
    }
    lq = DEPTH;
    STAGE(NSTAGES - 1)
#ifndef PROBE_T
        stage_norm1(F, l);
#endif
#ifdef PROBE_T
        { const unsigned long long* st = (const unsigned long long*)(F.a->ws + WS_CTL + CW_STAMP * 4); const float cval = (float)(long long)(st[PROBE_B] - st[PROBE_A]) * (1.0f / (100.0f * PROBE_DIV));
          __syncthreads(); for (size_t i = (size_t)F.bid * NTHREADS + F.tid; i < (size_t)T_LAT * D; i += (size_t)F.G * NTHREADS) F.a->out[i] = cval; }
#endif
    }
#undef IN
#undef SEAM
}

extern "C" void kernel_launch(void* const* d_in, const int* in_sizes, int n_in, void* d_out, int out_size, void* d_ws, size_t ws_size, hipStream_t stream) {
    static int grid = 0;
    if (grid == 0) {
        if (n_in != 51 || out_size != T_LAT * D || ws_size < WS_END) { fprintf(stderr, "kernel_launch: unexpected shapes (n_in %d out %d ws %zu, need %zu)\n", n_in, out_size, ws_size, (size_t)WS_END); grid = -1; return; }
        int dev = 0, cus = 0, per_cu = 0;
        if (hipGetDevice(&dev) != hipSuccess || hipDeviceGetAttribute(&cus, hipDeviceAttributeMultiprocessorCount, dev) != hipSuccess) { grid = -1; return; }
        if (hipFuncSetAttribute((const void*)mk_fwd, hipFuncAttributeMaxDynamicSharedMemorySize, LDS_BYTES) != hipSuccess) { fprintf(stderr, "kernel_launch: hipFuncSetAttribute failed\n"); grid = -1; return; }
        if (hipOccupancyMaxActiveBlocksPerMultiprocessor(&per_cu, (const void*)mk_fwd, NTHREADS, LDS_BYTES) != hipSuccess || per_cu < 1) fprintf(stderr, "kernel_launch: occupancy query says %d\n", per_cu);
        (void)hipGetLastError();
        grid = cus;
    }
    if (grid < 0) return;
    if (hipMemsetAsync((char*)d_ws + WS_CTL, 0, CTL_ZERO_BYTES, stream) != hipSuccess) return;
    Args a{};
    for (int i = 0; i < 51; ++i) a.in[i] = (const float*)d_in[i];
    a.out = (float*)d_out; a.ws = (unsigned char*)d_ws;
#if MK_PER_STAGE
    for (int s = 0; s < NSTAGES; ++s) { a.ph_lo = s; a.ph_hi = s + 1; int reps = 1;
#ifdef PROBE_SET
        { const int ls = (s == 0 || s == NSTAGES - 1) ? -1 : (s - 1) % NSTAGE_L;
          if (PROBE_SET >= 1 && PROBE_SET <= 13 && ls == PROBE_SET - 1 && ls != 5 && ls != 8 && !(ls == 0 && s > 1)) reps = 3;
          if (PROBE_SET == 14 && s == 0) reps = 3; }
#endif
        for (int r = 0; r < reps; ++r) hipLaunchKernelGGL(mk_fwd, dim3(grid), dim3(NTHREADS), LDS_BYTES, stream, a); }
#else
    a.ph_lo = 0; a.ph_hi = NSTAGES; hipLaunchKernelGGL(mk_fwd, dim3(grid), dim3(NTHREADS), LDS_BYTES, stream, a);
#endif
}
```
